# Optimizing an MI355X kernel written in HIP

```python
import math
import jax, jax.numpy as jnp
from jax import lax
import numpy as np

D_MODEL = 1024
BATCH = 4
SEQ = 8192
DEPTH = 4

CTX_LEN = 256
GRID_W = 64
D_MIX = D_MODEL
SHORT_CONV = 3
A_HEADS = 8
A_HEAD_DIM = 64
A_INNER = A_HEADS * A_HEAD_DIM
A_GROUPS = 2
A_STATE = 64
A_XBC = A_INNER + 2 * A_GROUPS * A_STATE
A_CHUNK = 64
B_HEADS = 4
B_QK_DIM = 64
B_V_DIM = 128
B_QK = B_HEADS * B_QK_DIM
B_INNER = B_HEADS * B_V_DIM
B_CHUNK = 64
MLSTM_EPS = 1e-6
C_HEADS = 4
C_HEAD_DIM = 128
C_INNER = C_HEADS * C_HEAD_DIM
C_CHUNK = 16
D_HEADS = 8
D_HEAD_DIM = 64
D_INNER = D_HEADS * D_HEAD_DIM
D_W_LORA = 64
D_A_LORA = 64
D_G_LORA = 128
RWKV_EPS = 64e-5
P_A = A_INNER + A_XBC + 2 * A_HEADS
P_B = 2 * B_QK + 2 * B_INNER + 4 * B_HEADS
P_EVEN = P_A + P_B
P_C = 5 * C_INNER
P_D = 3 * D_INNER + 2 * D_W_LORA + D_A_LORA + D_G_LORA
P_ODD = P_C + P_D
N_EVEN = (DEPTH + 1) // 2
N_ODD = DEPTH // 2
N_EXPERTS = 32
N_EXPERT_GROUPS = 8
EXPERTS_PER_GROUP = N_EXPERTS // N_EXPERT_GROUPS
TOP_K = 2
D_EXPERT = 512
MOE_BLOCK = 128
DEEPNORM_ALPHA = (2 * DEPTH) ** 0.25
DEEPNORM_BETA = (8 * DEPTH) ** -0.25
LN_EPS = 1e-5
M_INIT = -1e30

kernel_name = 'hybrid_ssd_mlstm_hgrn2_rwkv7_moe_flow_trunk'


def layer_norm(x, g, b):
    xf = x.astype(jnp.float32)
    mu = xf.mean(-1, keepdims=True)
    var = jnp.mean(jnp.square(xf - mu), -1, keepdims=True)
    return ((xf - mu) * lax.rsqrt(var + LN_EPS)).astype(x.dtype) * g + b


def rms_norm(x, w, eps=1e-6):
    xf = x.astype(jnp.float32)
    return (xf * lax.rsqrt(jnp.mean(xf * xf, -1, keepdims=True) + eps)).astype(x.dtype) * w


def head_norm(y, eps, center):
    yf = y.astype(jnp.float32)
    if center:
        yf = yf - yf.mean(-1, keepdims=True)
    yf = yf * lax.rsqrt(jnp.mean(yf * yf, -1, keepdims=True) + eps)
    return yf.reshape(y.shape[0], y.shape[1], -1).astype(y.dtype)


def centred_dwconv(x, w, b):
    y = lax.conv_general_dilated(x, w[:, None, :], window_strides=(1,), padding='SAME',
                                 dimension_numbers=('NWC', 'WIO', 'NWC'), feature_group_count=x.shape[-1])
    return y + b


def centred_token_shift(p):
    prev = jnp.pad(p[:, :-1], ((0, 0), (1, 0), (0, 0)))
    nxt = jnp.pad(p[:, 1:], ((0, 0), (0, 1), (0, 0)))
    return 0.5 * (prev + nxt)


def to_col_major(u, rows):
    b, s, d = u.shape
    return u.reshape(b, rows, GRID_W, d).transpose(0, 2, 1, 3).reshape(b, s, d)


def from_col_major(u, rows):
    b, s, d = u.shape
    return u.reshape(b, GRID_W, rows, d).transpose(0, 2, 1, 3).reshape(b, s, d)


def _chunk(a, L):
    b, t, h, d = a.shape
    return a.astype(jnp.float32).reshape(b, t // L, L, h, d).transpose(0, 3, 1, 2, 4)


def _unchunk(a, dtype):
    b, h, n, L, d = a.shape
    return a.transpose(0, 2, 3, 1, 4).reshape(b, n * L, h, d).astype(dtype)


def _flip_t(a):
    return jnp.flip(a, axis=1)


def prefix_bidirectional(scan_fn, ctx_fwd, lat_fwd, ctx_bwd, lat_bwd):
    yc_f, s_f = scan_fn(*ctx_fwd, None)
    yl_f, _ = scan_fn(*lat_fwd, s_f)
    yc_b, s_b = scan_fn(*[_flip_t(a) for a in ctx_bwd], None)
    yl_b, _ = scan_fn(*[_flip_t(a) for a in lat_bwd], s_b)
    return yc_f + _flip_t(yc_b), yl_f + _flip_t(yl_b)


def segsum(a):
    L = a.shape[-1]
    cs = jnp.cumsum(a, axis=-1)
    return jnp.where(jnp.tril(jnp.ones((L, L), bool)), cs[..., :, None] - cs[..., None, :], -jnp.inf)


def ssd_scan(x, log_a, bm, cm, state):
    b, t, h, p = x.shape
    g, n = bm.shape[2], bm.shape[3]
    r = h // g
    L = A_CHUNK
    nc = t // L
    xf = x.astype(jnp.float32).reshape(b, nc, L, g, r, p)
    bf = bm.astype(jnp.float32).reshape(b, nc, L, g, n)
    cf = cm.astype(jnp.float32).reshape(b, nc, L, g, n)
    la = log_a.astype(jnp.float32).reshape(b, nc, L, g, r).transpose(0, 3, 4, 1, 2)
    la_cum = jnp.cumsum(la, axis=-1)
    cb = jnp.einsum('bclgn,bcsgn->bgcls', cf, bf)
    attn = cb[:, :, None] * jnp.exp(segsum(la))
    y_diag = jnp.einsum('bgrcls,bcsgrp->bclgrp', attn, xf)
    decay_end = jnp.exp(la_cum[..., -1:] - la_cum).transpose(0, 3, 4, 1, 2)
    chunk_states = jnp.einsum('bcsgn,bcsgrp->bcgrpn', bf, xf * decay_end[..., None])
    if state is None:
        state = jnp.zeros((b, h, p, n), jnp.float32)
    states = jnp.concatenate([state.reshape(b, 1, g, r, p, n), chunk_states], axis=1)
    chunk_decay = jnp.exp(segsum(jnp.pad(la_cum[..., -1], ((0, 0), (0, 0), (0, 0), (1, 0)))))
    new_states = jnp.einsum('bgrzc,bcgrpn->bzgrpn', chunk_decay, states)
    prev_states, final = new_states[:, :-1], new_states[:, -1]
    y_off = jnp.einsum('bclgn,bcgrpn->bclgrp', cf, prev_states) * jnp.exp(la_cum).transpose(0, 3, 4, 1, 2)[..., None]
    return (y_diag + y_off).reshape(b, t, h, p).astype(x.dtype), final.reshape(b, h, p, n)


def mlstm_scan(q, k, v, log_i, log_f, state):
    b, t, h, dk = q.shape
    dv = v.shape[-1]
    L = B_CHUNK
    qc = _chunk(q, L) * dk ** -0.5
    kc = _chunk(k, L)
    vc = _chunk(v, L)
    li = _chunk(log_i[..., None], L)[..., 0]
    fcum = jnp.cumsum(_chunk(log_f[..., None], L)[..., 0], axis=-1)
    ftot = fcum[..., -1]
    w_end = ftot[..., None] - fcum + li
    m_loc = w_end.max(-1)
    e_end = jnp.exp(w_end - m_loc[..., None])
    c_loc = jnp.einsum('bhnsk,bhnsv->bhnkv', kc * e_end[..., None], vc)
    n_loc = jnp.einsum('bhns,bhnsk->bhnk', e_end, kc)
    if state is None:
        state = (jnp.zeros((b, h, dk, dv), jnp.float32), jnp.zeros((b, h, dk), jnp.float32),
                 jnp.full((b, h), M_INIT, jnp.float32))

    def step(carry, inp):
        cmat, nvec, mst = carry
        ft, ml, cl, nl = inp
        m_new = jnp.maximum(ft + mst, ml)
        sp = jnp.exp(ft + mst - m_new)
        sl = jnp.exp(ml - m_new)
        c_new = sp[..., None, None] * cmat + sl[..., None, None] * cl
        n_new = sp[..., None] * nvec + sl[..., None] * nl
        return (c_new, n_new, m_new), (cmat, nvec, mst)

    xs = tuple(jnp.moveaxis(a, 2, 0) for a in (ftot, m_loc, c_loc, n_loc))
    final, (c_prev, n_prev, m_prev) = lax.scan(step, state, xs)
    c_prev = jnp.moveaxis(c_prev, 0, 2)
    n_prev = jnp.moveaxis(n_prev, 0, 2)
    m_prev = jnp.moveaxis(m_prev, 0, 2)
    causal = jnp.tril(jnp.ones((L, L), bool))
    log_d = jnp.where(causal, fcum[..., :, None] - fcum[..., None, :] + li[..., None, :], -jnp.inf)
    log_inter = fcum + m_prev[..., None]
    m_row = jnp.maximum(log_d.max(-1), log_inter)
    s = jnp.einsum('bhnld,bhnsd->bhnls', qc, kc) * jnp.exp(log_d - m_row[..., None])
    inter = jnp.exp(log_inter - m_row)
    num = jnp.einsum('bhnls,bhnsv->bhnlv', s, vc) + inter[..., None] * jnp.einsum('bhnld,bhndv->bhnlv', qc, c_prev)
    den = s.sum(-1) + inter * jnp.einsum('bhnld,bhnd->bhnl', qc, n_prev)
    hout = num / jnp.maximum(jnp.abs(den), jnp.exp(-m_row))[..., None]
    return _unchunk(hout, v.dtype), final


def gla_scan(q, k, v, log_f, state):
    b, t, h, dk = q.shape
    dv = v.shape[-1]
    L = C_CHUNK
    qc, kc, vc = _chunk(q, L), _chunk(k, L), _chunk(v, L)
    lam = jnp.cumsum(_chunk(log_f, L), axis=3)
    lam_end = lam[:, :, :, -1:]
    q_in = qc * jnp.exp(lam)
    att = jnp.einsum('bhnld,bhnsd->bhnls', q_in, kc * jnp.exp(-lam))
    att = jnp.where(jnp.tril(jnp.ones((L, L), bool)), att, 0.0)
    y_intra = jnp.einsum('bhnls,bhnsv->bhnlv', att, vc)
    k_end = kc * jnp.exp(lam_end - lam)
    if state is None:
        state = jnp.zeros((b, h, dk, dv), jnp.float32)

    def step(s, inp):
        qi, ke, vv, dec = inp
        y = jnp.einsum('bhld,bhdv->bhlv', qi, s)
        s = dec[..., None] * s + jnp.einsum('bhld,bhlv->bhdv', ke, vv)
        return s, y

    xs = tuple(jnp.moveaxis(a, 2, 0) for a in (q_in, k_end, vc, jnp.exp(lam_end[:, :, :, 0])))
    final, y_inter = lax.scan(step, state, xs)
    return _unchunk(y_intra + jnp.moveaxis(y_inter, 0, 2), v.dtype), final


def rwkv7_scan(r, w, k, v, a, bvec, state):
    b, t, h, d = r.shape
    if state is None:
        state = jnp.zeros((b, h, d, d), jnp.float32)

    def step(s, inp):
        rt, wt, kt, vt, at, bt = inp
        sa = jnp.einsum('bhvk,bhk->bhv', s, at)
        s = s * wt[:, :, None, :] + sa[..., None] * bt[:, :, None, :] + vt[..., None] * kt[:, :, None, :]
        return s, jnp.einsum('bhvk,bhk->bhv', s, rt)

    xs = tuple(jnp.moveaxis(u.astype(jnp.float32), 1, 0) for u in (r, w, k, v, a, bvec))
    final, y = lax.scan(step, state, xs)
    return jnp.moveaxis(y, 0, 1).astype(r.dtype), final


def ssd_prepare(p, conv_w, conv_b, dt_bias, a_log):
    b, t, _ = p.shape
    z = p[..., :A_INNER]
    xbc = jax.nn.silu(centred_dwconv(p[..., A_INNER:A_INNER + A_XBC], conv_w, conv_b))
    xs = xbc[..., :A_INNER].reshape(b, t, A_HEADS, A_HEAD_DIM)
    bm = xbc[..., A_INNER:A_INNER + A_GROUPS * A_STATE].reshape(b, t, A_GROUPS, A_STATE)
    cm = xbc[..., A_INNER + A_GROUPS * A_STATE:].reshape(b, t, A_GROUPS, A_STATE)
    dt = jax.nn.softplus(p[..., A_INNER + A_XBC:].reshape(b, t, 2, A_HEADS) + dt_bias)
    a = -jnp.exp(a_log)
    fwd = (xs * dt[:, :, 0, :, None], dt[:, :, 0] * a[0], bm, cm)
    bwd = (xs * dt[:, :, 1, :, None], dt[:, :, 1] * a[1], bm, cm)
    return (z, xs), fwd, bwd


def ssd_output(y, z, xs, d_skip, norm_w):
    b, t = y.shape[:2]
    y = (y + d_skip[:, None] * xs).reshape(b, t, A_INNER)
    return rms_norm(y * jax.nn.silu(z), norm_w)


def mlstm_prepare(p, conv_w, conv_b, i_bias, f_bias):
    b, t, _ = p.shape
    qk = jax.nn.silu(centred_dwconv(p[..., :2 * B_QK], conv_w, conv_b))
    q = qk[..., :B_QK].reshape(b, t, B_HEADS, B_QK_DIM)
    k = qk[..., B_QK:].reshape(b, t, B_HEADS, B_QK_DIM)
    v = p[..., 2 * B_QK:2 * B_QK + B_INNER].reshape(b, t, B_HEADS, B_V_DIM)
    o = p[..., 2 * B_QK + B_INNER:2 * B_QK + 2 * B_INNER]
    gates = p[..., 2 * B_QK + 2 * B_INNER:].reshape(b, t, 2, 2, B_HEADS)
    log_i = gates[:, :, 0] + i_bias
    log_f = jax.nn.log_sigmoid(gates[:, :, 1] + f_bias)
    fwd = (q, k, v, log_i[:, :, 0], log_f[:, :, 0])
    bwd = (q, k, v, log_i[:, :, 1], log_f[:, :, 1])
    return o, fwd, bwd


def mlstm_output(h, o, norm_w):
    return jax.nn.sigmoid(o) * head_norm(h, MLSTM_EPS, True) * norm_w


def hgrn2_prepare(p, lb, f_bias):
    b, t, _ = p.shape
    hd = lambda u: u.reshape(b, t, C_HEADS, C_HEAD_DIM)
    q = jax.nn.silu(p[..., :C_INNER])
    f_pre = p[..., C_INNER:3 * C_INNER].reshape(b, t, 2, C_INNER) + f_bias
    log_f = jnp.log(lb + (1 - lb) * jax.nn.sigmoid(f_pre))
    k = (1 - lb) * jax.nn.sigmoid(-f_pre)
    i = p[..., 3 * C_INNER:4 * C_INNER]
    g = p[..., 4 * C_INNER:]
    fwd = (hd(q), hd(k[:, :, 0]), hd(i), hd(log_f[:, :, 0]))
    bwd = (hd(q), hd(k[:, :, 1]), hd(i), hd(log_f[:, :, 1]))
    return g, fwd, bwd


def hgrn2_output(o, g, norm_w):
    return head_norm(o, 1e-6, False) * norm_w * jax.nn.silu(g)


def rwkv7_prepare(p, mu, w0, w2, a0, a2, g2, k_k, k_a):
    b, t, _ = p.shape
    hd = lambda u: u.reshape(b, t, D_HEADS, D_HEAD_DIM)
    p = p + mu * (centred_token_shift(p) - p)
    r = p[..., :D_INNER]
    k = p[..., D_INNER:2 * D_INNER]
    v = p[..., 2 * D_INNER:3 * D_INNER]
    o = 3 * D_INNER
    wl = p[..., o:o + 2 * D_W_LORA].reshape(b, t, 2, D_W_LORA)
    al = p[..., o + 2 * D_W_LORA:o + 2 * D_W_LORA + D_A_LORA]
    gl = p[..., o + 2 * D_W_LORA + D_A_LORA:]
    w = w0 + jnp.einsum('btdr,drc->btdc', jnp.tanh(wl), w2)
    decay = jnp.exp(-jnp.exp(-jax.nn.softplus(-w) - 0.5))
    a = jax.nn.sigmoid(a0 + al @ a2)
    g = jax.nn.sigmoid(gl) @ g2
    kk = hd(k * k_k).astype(jnp.float32)
    kk = (kk * lax.rsqrt(jnp.maximum(jnp.sum(kk * kk, -1, keepdims=True), 1e-12))).astype(p.dtype)
    k = hd(k * (1 + (a - 1) * k_a))
    r, v, a = hd(r), hd(v), hd(a)
    fwd = (r, hd(decay[:, :, 0]), k, v, -kk, kk * a)
    bwd = (r, hd(decay[:, :, 1]), k, v, -kk, kk * a)
    return (r, k, v, g), fwd, bwd


def rwkv7_output(y, r, k, v, g, r_k, ln_w, ln_b):
    b, t = y.shape[:2]
    bonus = (jnp.sum(r * k * r_k, axis=-1, keepdims=True) * v).reshape(b, t, D_INNER)
    return (head_norm(y, RWKV_EPS, True) * ln_w + ln_b + bonus) * g


def even_mixer(pc, pl, ssd_p, mlstm_p, ctx_out):
    conv_w, conv_b, dt_bias, a_log, d_skip, norm_a = ssd_p
    conv_bw, conv_bb, i_bias, f_bias, norm_b = mlstm_p
    ac = ssd_prepare(pc[..., :P_A], conv_w, conv_b, dt_bias, a_log)
    al = ssd_prepare(pl[..., :P_A], conv_w, conv_b, dt_bias, a_log)
    ya_c, ya_l = prefix_bidirectional(ssd_scan, ac[1], al[1], ac[2], al[2])
    bc = mlstm_prepare(pc[..., P_A:], conv_bw, conv_bb, i_bias, f_bias)
    bl = mlstm_prepare(pl[..., P_A:], conv_bw, conv_bb, i_bias, f_bias)
    yb_c, yb_l = prefix_bidirectional(mlstm_scan, bc[1], bl[1], bc[2], bl[2])
    feat_l = jnp.concatenate([ssd_output(ya_l, *al[0], d_skip, norm_a), mlstm_output(yb_l, bl[0], norm_b)], axis=-1)
    feat_c = None
    if ctx_out:
        feat_c = jnp.concatenate([ssd_output(ya_c, *ac[0], d_skip, norm_a), mlstm_output(yb_c, bc[0], norm_b)], axis=-1)
    return feat_c, feat_l


def odd_mixer(pc, pl, lb, hgrn_p, rwkv_p, ctx_out):
    f_bias, norm_c = hgrn_p
    mu, w0, w2, a0, a2, g2, k_k, k_a, r_k, ln_w, ln_b = rwkv_p
    hc = hgrn2_prepare(pc[..., :P_C], lb, f_bias)
    hl = hgrn2_prepare(pl[..., :P_C], lb, f_bias)
    yc_c, yc_l = prefix_bidirectional(gla_scan, hc[1], hl[1], hc[2], hl[2])
    rc = rwkv7_prepare(pc[..., P_C:], mu, w0, w2, a0, a2, g2, k_k, k_a)
    rl = rwkv7_prepare(pl[..., P_C:], mu, w0, w2, a0, a2, g2, k_k, k_a)
    yd_c, yd_l = prefix_bidirectional(rwkv7_scan, rc[1], rl[1], rc[2], rl[2])
    feat_l = jnp.concatenate([hgrn2_output(yc_l, hl[0], norm_c), rwkv7_output(yd_l, *rl[0], r_k, ln_w, ln_b)], axis=-1)
    feat_c = None
    if ctx_out:
        feat_c = jnp.concatenate([hgrn2_output(yc_c, hc[0], norm_c), rwkv7_output(yd_c, *rc[0], r_k, ln_w, ln_b)], axis=-1)
    return feat_c, feat_l


def moe_ffn(h, router_w, router_bias, w_gate, w_up, w_down):
    t, d = h.shape
    scores = jax.nn.sigmoid((h @ router_w).astype(jnp.float32))
    grp = (scores + router_bias.astype(jnp.float32)).reshape(t, N_EXPERT_GROUPS, EXPERTS_PER_GROUP)
    g_idx = jnp.argmax(lax.top_k(grp, TOP_K)[0].sum(-1), axis=-1)
    in_grp = jnp.take_along_axis(grp, g_idx[:, None, None], axis=1)[:, 0]
    _, local = lax.top_k(in_grp, TOP_K)
    expert = g_idx[:, None] * EXPERTS_PER_GROUP + local
    wts = jnp.take_along_axis(scores, expert, axis=1)
    wts = (wts / wts.sum(-1, keepdims=True)).astype(h.dtype)
    n_assign = t * TOP_K
    flat_e = expert.reshape(n_assign)
    order = jnp.argsort(flat_e)
    e_s = flat_e[order]
    tok_s = order // TOP_K
    w_s = wts.reshape(n_assign)[order]
    counts = jnp.bincount(flat_e, length=N_EXPERTS)
    starts = jnp.cumsum(counts) - counts
    padded = (counts + MOE_BLOCK - 1) // MOE_BLOCK * MOE_BLOCK
    pends = jnp.cumsum(padded)
    pstarts = pends - padded
    dest = pstarts[e_s] + (jnp.arange(n_assign) - starts[e_s])
    n_blocks = -(-n_assign // MOE_BLOCK) + N_EXPERTS
    xp = jnp.zeros((n_blocks * MOE_BLOCK, d), h.dtype).at[dest].set(h[tok_s])
    blk_e = jnp.minimum(jnp.searchsorted(pends, jnp.arange(n_blocks) * MOE_BLOCK, side='right'), N_EXPERTS - 1)

    def expert_block(args):
        xb, e = args
        return (jax.nn.silu(xb @ w_gate[e]) * (xb @ w_up[e])) @ w_down[e]

    yp = lax.map(expert_block, (xp.reshape(n_blocks, MOE_BLOCK, d), blk_e)).reshape(-1, d)
    return jnp.zeros_like(h).at[tok_s].add(yp[dest] * w_s[:, None])


def setup_inputs(seed: int = 0) -> dict:
    key = jax.random.key(seed)
    ks = iter(jax.random.split(key, 48))
    nrm = lambda shape, scale: jax.random.normal(next(ks), shape, jnp.float32) * scale
    unif = lambda shape, lo, hi: jax.random.uniform(next(ks), shape, jnp.float32, lo, hi)
    D = D_MODEL
    inp = {}
    inp['x'] = nrm((BATCH, SEQ, D), 1.0)
    inp['c'] = nrm((BATCH, D), 1.0)
    inp['ctx'] = nrm((BATCH, CTX_LEN, D), 1.0)
    inp['c_ctx'] = nrm((D,), 1.0)
    inp['mod_w'] = nrm((DEPTH, D, 6 * D), 0.5 * D ** -0.5)
    inp['mod_b'] = nrm((DEPTH, 6 * D), 0.02)
    inp['ln_g'] = 1.0 + nrm((DEPTH, 2, D), 0.02)
    inp['ln_b'] = nrm((DEPTH, 2, D), 0.02)
    inp['ev_w_in'] = nrm((N_EVEN, D, P_EVEN), D ** -0.5)
    inp['ev_w_out'] = nrm((N_EVEN, D_MIX, D), DEEPNORM_BETA * D_MIX ** -0.5)
    inp['ssd_conv_w'] = nrm((N_EVEN, SHORT_CONV, A_XBC), SHORT_CONV ** -0.5)
    inp['ssd_conv_b'] = nrm((N_EVEN, A_XBC), 0.02)
    dt0 = jnp.exp(unif((N_EVEN, 2, A_HEADS), math.log(1e-3), math.log(1e-1)))
    inp['ssd_dt_bias'] = dt0 + jnp.log(-jnp.expm1(-dt0))
    inp['ssd_a_log'] = jnp.log(unif((N_EVEN, 2, A_HEADS), 1.0, 16.0))
    inp['ssd_d'] = 1.0 + nrm((N_EVEN, A_HEADS), 0.02)
    inp['ssd_norm_w'] = 1.0 + nrm((N_EVEN, A_INNER), 0.02)
    inp['mlstm_conv_w'] = nrm((N_EVEN, SHORT_CONV, 2 * B_QK), SHORT_CONV ** -0.5)
    inp['mlstm_conv_b'] = nrm((N_EVEN, 2 * B_QK), 0.02)
    inp['mlstm_i_bias'] = nrm((N_EVEN, 2, B_HEADS), 0.1)
    inp['mlstm_f_bias'] = jnp.linspace(3.0, 6.0, B_HEADS) + nrm((N_EVEN, 2, B_HEADS), 0.1)
    inp['mlstm_norm_w'] = 1.0 + nrm((N_EVEN, B_INNER), 0.02)
    inp['od_w_in'] = nrm((N_ODD, D, P_ODD), D ** -0.5)
    inp['od_w_out'] = nrm((N_ODD, D_MIX, D), DEEPNORM_BETA * D_MIX ** -0.5)
    inp['hgrn_lb_logits'] = nrm((DEPTH, C_INNER), 0.1)
    inp['hgrn_f_bias'] = nrm((N_ODD, 2, C_INNER), 0.1)
    inp['hgrn_norm_w'] = 1.0 + nrm((N_ODD, C_INNER), 0.02)
    inp['rwkv_mu'] = unif((N_ODD, P_D), 0.0, 1.0)
    inp['rwkv_w0'] = unif((N_ODD, 2, D_INNER), -4.0, 0.0)
    inp['rwkv_w2'] = nrm((N_ODD, 2, D_W_LORA, D_INNER), 0.5 * D_W_LORA ** -0.5)
    inp['rwkv_a0'] = nrm((N_ODD, D_INNER), 0.1)
    inp['rwkv_a2'] = nrm((N_ODD, D_A_LORA, D_INNER), 0.5 * D_A_LORA ** -0.5)
    inp['rwkv_g2'] = nrm((N_ODD, D_G_LORA, D_INNER), D_G_LORA ** -0.5)
    inp['rwkv_k_k'] = 0.85 + nrm((N_ODD, D_INNER), 0.02)
    inp['rwkv_k_a'] = 1.0 + nrm((N_ODD, D_INNER), 0.02)
    inp['rwkv_r_k'] = nrm((N_ODD, D_HEADS, D_HEAD_DIM), 0.1)
    inp['rwkv_ln_w'] = 1.0 + nrm((N_ODD, D_INNER), 0.02)
    inp['rwkv_ln_b'] = nrm((N_ODD, D_INNER), 0.02)
    inp['router_w'] = nrm((D, N_EXPERTS), D ** -0.5)
    inp['router_bias'] = nrm((N_EXPERTS,), 0.01)
    inp['exp_w_gate'] = nrm((DEPTH, N_EXPERTS, D, D_EXPERT), D ** -0.5)
    inp['exp_w_up'] = nrm((DEPTH, N_EXPERTS, D, D_EXPERT), D ** -0.5)
    inp['exp_w_down'] = nrm((DEPTH, N_EXPERTS, D_EXPERT, D), DEEPNORM_BETA * D_EXPERT ** -0.5)
    return inp


def reference(x, c, ctx, c_ctx, mod_w, mod_b, ln_g, ln_b,
              ev_w_in, ev_w_out, ssd_conv_w, ssd_conv_b, ssd_dt_bias, ssd_a_log, ssd_d, ssd_norm_w,
              mlstm_conv_w, mlstm_conv_b, mlstm_i_bias, mlstm_f_bias, mlstm_norm_w,
              od_w_in, od_w_out, hgrn_lb_logits, hgrn_f_bias, hgrn_norm_w,
              rwkv_mu, rwkv_w0, rwkv_w2, rwkv_a0, rwkv_a2, rwkv_g2, rwkv_k_k, rwkv_k_a, rwkv_r_k,
              rwkv_ln_w, rwkv_ln_b, router_w, router_bias, exp_w_gate, exp_w_up, exp_w_down):
    bsz, seq, _ = x.shape
    rows = seq // GRID_W
    lb_all = jnp.cumsum(jax.nn.softmax(hgrn_lb_logits.astype(jnp.float32), axis=0), axis=0)
    lb_all = (lb_all - lb_all[0]).astype(x.dtype)
    s_c = jax.nn.silu(c)
    s_cc = jax.nn.silu(c_ctx)
    xl, xc = x, ctx
    for layer in range(DEPTH):
        i = layer // 2
        ctx_out = layer < DEPTH - 1
        sh1, sc1, g1, sh2, sc2, g2 = jnp.split(s_c @ mod_w[layer] + mod_b[layer], 6, axis=-1)
        csh1, csc1, cg1, csh2, csc2, cg2 = jnp.split(s_cc @ mod_w[layer] + mod_b[layer], 6, axis=-1)
        ul = xl * (1 + sc1[:, None]) + sh1[:, None]
        uc = xc * (1 + csc1) + csh1
        if layer % 2 == 0:
            fc, fl = even_mixer(uc @ ev_w_in[i], ul @ ev_w_in[i],
                                (ssd_conv_w[i], ssd_conv_b[i], ssd_dt_bias[i], ssd_a_log[i], ssd_d[i], ssd_norm_w[i]),
                                (mlstm_conv_w[i], mlstm_conv_b[i], mlstm_i_bias[i], mlstm_f_bias[i], mlstm_norm_w[i]),
                                ctx_out)
            w_out = ev_w_out[i]
        else:
            fc, fl = odd_mixer(uc @ od_w_in[i], to_col_major(ul, rows) @ od_w_in[i], lb_all[layer],
                               (hgrn_f_bias[i], hgrn_norm_w[i]),
                               (rwkv_mu[i], rwkv_w0[i], rwkv_w2[i], rwkv_a0[i], rwkv_a2[i], rwkv_g2[i],
                                rwkv_k_k[i], rwkv_k_a[i], rwkv_r_k[i], rwkv_ln_w[i], rwkv_ln_b[i]),
                               ctx_out)
            fl = from_col_major(fl, rows)
            w_out = od_w_out[i]
        xl = layer_norm(DEEPNORM_ALPHA * xl + g1[:, None] * (fl @ w_out), ln_g[layer, 0], ln_b[layer, 0])
        hl = xl * (1 + sc2[:, None]) + sh2[:, None]
        if ctx_out:
            xc = layer_norm(DEEPNORM_ALPHA * xc + cg1 * (fc @ w_out), ln_g[layer, 0], ln_b[layer, 0])
            hc = xc * (1 + csc2) + csh2
            n_c = hc.shape[0] * hc.shape[1]
            f = moe_ffn(jnp.concatenate([hc.reshape(n_c, D_MODEL), hl.reshape(-1, D_MODEL)], axis=0),
                        router_w, router_bias, exp_w_gate[layer], exp_w_up[layer], exp_w_down[layer])
            xc = layer_norm(DEEPNORM_ALPHA * xc + cg2 * f[:n_c].reshape(xc.shape), ln_g[layer, 1], ln_b[layer, 1])
            f_l = f[n_c:]
        else:
            f_l = moe_ffn(hl.reshape(-1, D_MODEL), router_w, router_bias,
                          exp_w_gate[layer], exp_w_up[layer], exp_w_down[layer])
        xl = layer_norm(DEEPNORM_ALPHA * xl + g2[:, None] * f_l.reshape(xl.shape), ln_g[layer, 1], ln_b[layer, 1])
    return xl
```

```cpp
#include <hip/hip_runtime.h>
#include <stdint.h>
#include <stdio.h>
#include <string.h>

#ifndef MK_PER_PHASE
#define MK_PER_PHASE 1
#endif

typedef unsigned short bf16_t;
typedef short bf16x8 __attribute__((ext_vector_type(8)));
typedef float f32x4 __attribute__((ext_vector_type(4)));
typedef unsigned u32x4 __attribute__((ext_vector_type(4)));
typedef unsigned u32x2 __attribute__((ext_vector_type(2)));
#define LAS __attribute__((address_space(3)))
#define CAS __attribute__((address_space(4)))

constexpr int D = 1024, NB = 4, SEQ = 8192, CTXL = 256, DEPTH = 4;
constexpr int NCTX = NB * CTXL;
constexpr int NROWS = NCTX + NB * SEQ;
constexpr int P_EVEN = 2848, P_ODD = 4416, LDP_EVEN = 2944, LDP_ODD = 4480;
constexpr int NEXP = 32, DEXP = 512, LISTCAP = NROWS;
constexpr float ALPHA = 1.681792830507429f;
constexpr int NT = 512;
constexpr int TCH = 32;
constexpr int NSTEPS = CTXL + SEQ;
constexpr int LDS_BYTES = 136 * 1024;

constexpr size_t al256(size_t x) { return (x + 255) & ~(size_t)255; }
constexpr size_t WS_BAR = 0;
constexpr size_t WS_CNT = 16384;
constexpr size_t WS_ZERO_BYTES = 16384 + 1024;
constexpr size_t WS_MODV = al256(WS_ZERO_BYTES);
constexpr size_t WS_LB = WS_MODV + al256((size_t)4 * 5 * 6144 * 4);
constexpr size_t WS_XC = WS_LB + al256(4 * 512 * 4);
constexpr size_t WS_WTS = WS_XC + (size_t)NCTX * D * 4;
constexpr size_t WS_LIST = WS_WTS + al256((size_t)2 * NROWS * 4);
constexpr size_t WS_WINT = WS_LIST + al256((size_t)NEXP * LISTCAP * 4);
constexpr size_t WINT_L0 = 0, WINT_L1 = (size_t)LDP_EVEN * D, WINT_L2 = WINT_L1 + (size_t)LDP_ODD * D, WINT_L3 = WINT_L2 + (size_t)LDP_EVEN * D, WINT_END = WINT_L3 + (size_t)LDP_ODD * D;
constexpr size_t WS_WOUTT = WS_WINT + WINT_END * 2;
constexpr size_t WS_LORAT = WS_WOUTT + (size_t)4 * D * D * 2;
constexpr size_t LORA_PER = (size_t)512 * 320;
constexpr size_t WS_EXPGU = WS_LORAT + al256(2 * LORA_PER * 2);
constexpr size_t WS_EXPD = WS_EXPGU + (size_t)NEXP * 1024 * 1024 * 2;
constexpr size_t WS_ACT = WS_EXPD + (size_t)NEXP * 1024 * 512 * 2;
constexpr size_t ROWB = (size_t)NROWS * D * 2;
constexpr size_t WS_FEAT = WS_ACT + ROWB;
constexpr size_t WS_YF = WS_FEAT + ROWB;
constexpr size_t WS_YB = WS_YF + ROWB;
constexpr size_t WS_P = WS_YB + ROWB;
constexpr size_t P_BYTES = (size_t)NROWS * LDP_ODD * 2;
constexpr size_t WS_YO = WS_P;
constexpr size_t WS_HID = WS_P + ROWB;
constexpr size_t WS_YP = WS_HID + ROWB;
static_assert(WS_YP + 2 * ROWB <= WS_P + P_BYTES, "MoE buffers must fit in the P region");
constexpr size_t HALFB = (size_t)NROWS * 512 * 2;
constexpr size_t WS_RWR = WS_P + P_BYTES;
constexpr size_t WS_RWK = WS_RWR + HALFB;
constexpr size_t WS_RWV = WS_RWK + HALFB;
constexpr size_t WS_RWKK = WS_RWV + HALFB;
constexpr size_t WS_RWB = WS_RWKK + HALFB;
constexpr size_t WS_RWG = WS_RWB + HALFB;
constexpr size_t WS_RWDEC = WS_RWG + HALFB;
constexpr size_t WS_LA = WS_RWDEC + (size_t)2 * NROWS * 512 * 4;
constexpr size_t WS_END = WS_LA + (size_t)NROWS * 320 * 2;
static_assert(WS_END <= (size_t)280602384 * 4, "workspace map exceeds the guaranteed ws_size");

struct Params {
    const float *x, *c, *ctx, *c_ctx, *mod_w, *mod_b, *ln_g, *ln_b;
    const float *ev_w_in, *ev_w_out, *ssd_conv_w, *ssd_conv_b, *ssd_dt_bias, *ssd_a_log, *ssd_d, *ssd_norm_w;
    const float *ml_conv_w, *ml_conv_b, *ml_i_bias, *ml_f_bias, *ml_norm_w;
    const float *od_w_in, *od_w_out, *hg_lb_logits, *hg_f_bias, *hg_norm_w;
    const float *rw_mu, *rw_w0, *rw_w2, *rw_a0, *rw_a2, *rw_g2, *rw_k_k, *rw_k_a, *rw_r_k, *rw_ln_w, *rw_ln_b;
    const float *router_w, *router_bias, *exp_w_gate, *exp_w_up, *exp_w_down;
    float* out;
    unsigned char* ws;
    int ph_lo, ph_hi, dbg, pad_;
};
typedef const CAS Params* KP;

__device__ __forceinline__ int ltid() { int t = threadIdx.x; asm volatile("" : "+v"(t)); return t; }
__device__ __forceinline__ float bf2f(bf16_t h) { return __uint_as_float(((unsigned)h) << 16); }
__device__ __forceinline__ float bflo(unsigned u) { return __uint_as_float(u << 16); }
__device__ __forceinline__ float bfhi(unsigned u) { return __uint_as_float(u & 0xffff0000u); }
typedef __bf16 bf16v2_t __attribute__((ext_vector_type(2)));
typedef float f32x2 __attribute__((ext_vector_type(2)));
__device__ __forceinline__ unsigned pk2(float lo, float hi) { const f32x2 v = {lo, hi}; return __builtin_bit_cast(unsigned, __builtin_convertvector(v, bf16v2_t)); }
__device__ __forceinline__ bf16_t f2bf(float f) { return (bf16_t)(pk2(f, 0.f) & 0xffffu); }
__device__ __forceinline__ void unpack8(const u32x4& u, float* f) {
    f[0] = bflo(u.x); f[1] = bfhi(u.x); f[2] = bflo(u.y); f[3] = bfhi(u.y); f[4] = bflo(u.z); f[5] = bfhi(u.z); f[6] = bflo(u.w); f[7] = bfhi(u.w);
}
__device__ __forceinline__ u32x4 pack8(const float* f) { u32x4 u; u.x = pk2(f[0], f[1]); u.y = pk2(f[2], f[3]); u.z = pk2(f[4], f[5]); u.w = pk2(f[6], f[7]); return u; }
__device__ __forceinline__ float sigmoidf_(float x) { return 1.f / (1.f + __expf(-x)); }
__device__ __forceinline__ float siluf_(float x) { return x / (1.f + __expf(-x)); }
__device__ __forceinline__ float softplusf_(float x) { return x > 20.f ? x : log1pf(__expf(x)); }
__device__ __forceinline__ float logsigmoidf_(float x) { return fminf(x, 0.f) - log1pf(__expf(-fabsf(x))); }
__device__ __forceinline__ float wave_sum(float v) {
#pragma unroll
    for (int o = 1; o < 64; o <<= 1) v += __shfl_xor(v, o);
    return v;
}
template <int W> __device__ __forceinline__ float group_sum(float v) {
#pragma unroll
    for (int o = 1; o < W; o <<= 1) v += __shfl_xor(v, o);
    return v;
}
template <int CTRL> __device__ __forceinline__ float dppmov(float v) {
    return __builtin_bit_cast(float, __builtin_amdgcn_update_dpp(0, __builtin_bit_cast(int, v), CTRL, 0xf, 0xf, true));
}
__device__ __forceinline__ float allreduce16(float v) {
    v += dppmov<0xB1>(v);
    v += dppmov<0x4E>(v);
    v += dppmov<0x141>(v);
    v += dppmov<0x140>(v);
    return v;
}

#define XB_TMO      128
#define XB_XCNT(j)  (256  + 64 * (j))
#define XB_XSUB(j)  (1280 + 64 * (j))
#define XB_XGEN(j)  (2304 + 64 * (j))
#define XB_TOP      3328
#define XB_TOPGEN   3392
#define XCD_BAR_WORDS 3456
#define XB_SPIN_CAP (1u << 22)
__device__ __forceinline__ unsigned xb_ld(unsigned* p)              { return __hip_atomic_load(p, __ATOMIC_RELAXED, __HIP_MEMORY_SCOPE_AGENT); }
__device__ __forceinline__ unsigned xb_add(unsigned* p, unsigned v) { return __hip_atomic_fetch_add(p, v, __ATOMIC_RELAXED, __HIP_MEMORY_SCOPE_AGENT); }
__device__ __forceinline__ unsigned xb_xcc_id() { return (unsigned)__builtin_amdgcn_s_getreg((3 << 11) | 20) & 0xFu; }
#define XB_SPIN(cond, bar) do { unsigned _sp = 0; while (cond) { __builtin_amdgcn_s_sleep(1); \
    if ((++_sp & 255u) == 0u) { if (xb_ld(&(bar)[XB_TMO])) break; if (_sp > XB_SPIN_CAP) { atomicAdd(&(bar)[XB_TMO], 1u); break; } } } } while (0)
struct XcdBarrier { unsigned* bar; unsigned x; volatile LAS unsigned* st; };
__device__ __forceinline__ XcdBarrier xcd_barrier_post(unsigned* bar, volatile LAS unsigned* st) {
    XcdBarrier b; b.bar = bar; b.x = xb_xcc_id(); b.st = st;
    if (threadIdx.x == 0) (void)xb_add(&bar[XB_XCNT(b.x)], 1u);
    return b;
}
__device__ __forceinline__ void xcd_barrier_complete(unsigned* bar, unsigned x, unsigned& nloc, unsigned& nx) {
    const unsigned G = gridDim.x * gridDim.y * gridDim.z;
    unsigned sum, cnt, mine, sp = 0u;
    for (;;) {
        sum = 0u; cnt = 0u; mine = 0u;
#pragma unroll
        for (unsigned j = 0; j < 16; ++j) { const unsigned c = xb_ld(&bar[XB_XCNT(j)]); sum += c; cnt += (c > 0u) ? 1u : 0u; mine = (j == x) ? c : mine; }
        if (sum == G) break;
        __builtin_amdgcn_s_sleep(1);
        if ((++sp & 255u) == 0u) { if (xb_ld(&bar[XB_TMO])) break; if (sp > XB_SPIN_CAP) { atomicAdd(&bar[XB_TMO], 1u); break; } }
    }
    nloc = mine > 0u ? mine : 1u; nx = cnt > 0u ? cnt : 1u;
}
__device__ __forceinline__ void xcd_barrier(const XcdBarrier& b) {
    asm volatile("s_waitcnt vmcnt(0)" ::: "memory");
    __syncthreads();
    if (threadIdx.x == 0) {
        unsigned* bar = b.bar;
        __builtin_amdgcn_s_waitcnt(0);
        unsigned nloc = b.st[0], nx = b.st[1];
        if (nloc == 0u) { xcd_barrier_complete(bar, b.x, nloc, nx); b.st[0] = nloc; b.st[1] = nx; }
        const unsigned old = xb_add(&bar[XB_XSUB(b.x)], 1u);
        const unsigned gen = old / nloc;
        if (old + 1u == (gen + 1u) * nloc) {
            __builtin_amdgcn_fence(__ATOMIC_RELEASE, "agent");
            asm volatile("s_waitcnt vmcnt(0)" ::: "memory");
            const unsigned og = xb_add(&bar[XB_TOP], 1u);
            const unsigned tg = og / nx;
            if (og + 1u == (tg + 1u) * nx) xb_add(&bar[XB_TOPGEN], 1u);
            else XB_SPIN(xb_ld(&bar[XB_TOPGEN]) == tg, bar);
            __builtin_amdgcn_fence(__ATOMIC_ACQUIRE, "agent");
            xb_add(&bar[XB_XGEN(b.x)], 1u);
            asm volatile("s_waitcnt vmcnt(0)" ::: "memory");
        } else {
            XB_SPIN(xb_ld(&bar[XB_XGEN(b.x)]) == gen, bar);
            __builtin_amdgcn_fence(__ATOMIC_ACQUIRE, "agent");
            asm volatile("s_waitcnt vmcnt(0)" ::: "memory");
        }
    }
    __syncthreads();
}

__device__ __forceinline__ int row_mod(int r) { return r < NCTX ? 4 : ((r - NCTX) >> 13); }
__device__ __forceinline__ void row_seg(int r, int& t, int& len) { if (r < NCTX) { t = r & 255; len = CTXL; } else { t = (r - NCTX) & 8191; len = SEQ; } }
__device__ __forceinline__ int scan_row(int tg, int b, int dir, int odd) {
    if (tg < CTXL) { const int t = dir ? (CTXL - 1 - tg) : tg; return b * CTXL + t; }
    int sg = tg - CTXL; if (dir) sg = SEQ - 1 - sg;
    const int s = odd ? (((sg & 127) << 6) + (sg >> 7)) : sg;
    return NCTX + b * SEQ + s;
}
__device__ __forceinline__ const float* modvec(const unsigned char* ws, int layer, int m, int which) {
    return (const float*)(ws + WS_MODV) + ((size_t)(layer * 5 + m) * 6 + which) * D;
}

constexpr int G_BM = 256, G_BN = 128, G_BK = 64;
constexpr int G_ABYTES = G_BM * G_BK * 2, G_BBYTES = G_BN * G_BK * 2, G_BUF = G_ABYTES + G_BBYTES;
__device__ __forceinline__ int swz(int o) { return o ^ (((o >> 9) & 1) << 5); }

template <class RowSrc, class Epi>
__device__ __forceinline__ void gemm_tile(const bf16_t* __restrict__ A, int lda, const RowSrc& rs, const bf16_t* __restrict__ Bt, int ldb, int n0, int K, const Epi& epi, LAS char* lds) {
    const int tid = ltid(), lane = tid & 63, wid = tid >> 6, wm = wid >> 1, wn = wid & 1;
    const bf16_t* ap[4]; int aoff[4];
#pragma unroll
    for (int i = 0; i < 4; ++i) {
        const int c = tid + NT * i, row = c >> 3, kc = c & 7;
        ap[i] = A + (size_t)rs.src(row) * lda + kc * 8;
        aoff[i] = ((row >> 4) * 2 + (kc >> 2)) * 1024 + swz((row & 15) * 64 + (kc & 3) * 16);
    }
    const bf16_t* bp[2]; int boff[2];
#pragma unroll
    for (int i = 0; i < 2; ++i) {
        const int c = tid + NT * i, row = c >> 3, kc = c & 7;
        bp[i] = Bt + (size_t)(n0 + row) * ldb + kc * 8;
        boff[i] = G_ABYTES + ((row >> 4) * 2 + (kc >> 2)) * 1024 + swz((row & 15) * 64 + (kc & 3) * 16);
    }
    f32x4 acc[4][4];
#pragma unroll
    for (int i = 0; i < 4; ++i)
#pragma unroll
        for (int j = 0; j < 4; ++j) acc[i][j] = (f32x4){0.f, 0.f, 0.f, 0.f};
    u32x4 ra[4], rb[2];
#pragma unroll
    for (int i = 0; i < 4; ++i) ra[i] = *(const u32x4*)(ap[i]);
#pragma unroll
    for (int i = 0; i < 2; ++i) rb[i] = *(const u32x4*)(bp[i]);
#pragma unroll
    for (int i = 0; i < 4; ++i) *(LAS u32x4*)(lds + aoff[i]) = ra[i];
#pragma unroll
    for (int i = 0; i < 2; ++i) *(LAS u32x4*)(lds + boff[i]) = rb[i];
    __syncthreads();
    const int KT = K / G_BK;
    const int fragoff = swz((lane & 15) * 64 + (lane >> 4) * 16);
    for (int kt = 0; kt < KT; ++kt) {
        LAS char* cur = lds + (kt & 1) * G_BUF;
        LAS char* nxt = lds + ((kt + 1) & 1) * G_BUF;
        const bool more = (kt + 1 < KT);
        if (more) {
#pragma unroll
            for (int i = 0; i < 4; ++i) ra[i] = *(const u32x4*)(ap[i] + (kt + 1) * G_BK);
#pragma unroll
            for (int i = 0; i < 2; ++i) rb[i] = *(const u32x4*)(bp[i] + (kt + 1) * G_BK);
        }
#pragma unroll
        for (int ks = 0; ks < 2; ++ks) {
            bf16x8 af[4], bfr[4];
#pragma unroll
            for (int mi = 0; mi < 4; ++mi) af[mi] = *(LAS bf16x8*)(cur + ((wm * 4 + mi) * 2 + ks) * 1024 + fragoff);
#pragma unroll
            for (int ni = 0; ni < 4; ++ni) bfr[ni] = *(LAS bf16x8*)(cur + G_ABYTES + ((wn * 4 + ni) * 2 + ks) * 1024 + fragoff);
#pragma unroll
            for (int mi = 0; mi < 4; ++mi)
#pragma unroll
                for (int ni = 0; ni < 4; ++ni) acc[mi][ni] = __builtin_amdgcn_mfma_f32_16x16x32_bf16(bfr[ni], af[mi], acc[mi][ni], 0, 0, 0);
        }
        if (more) {
#pragma unroll
            for (int i = 0; i < 4; ++i) *(LAS u32x4*)(nxt + aoff[i]) = ra[i];
#pragma unroll
            for (int i = 0; i < 2; ++i) *(LAS u32x4*)(nxt + boff[i]) = rb[i];
        }
        __syncthreads();
    }
    epi(acc, wm * 64 + (lane & 15), wn * 64 + 4 * (lane >> 4));
}

struct RowLinear { int m0; __device__ __forceinline__ int src(int r) const { return m0 + r; } };
struct RowList {
    const int* list; int cnt; int shift;
    __device__ __forceinline__ int src(int r) const { const int a = list[r < cnt ? r : 0]; return a >> shift; }
};
struct EpiStoreBf16 {
    bf16_t* C; int ldc; int m0; int n0; int N;
    __device__ __forceinline__ void operator()(const f32x4 (&acc)[4][4], int rbase, int cbase) const {
#pragma unroll
        for (int mi = 0; mi < 4; ++mi) {
            bf16_t* rowp = C + (size_t)(m0 + rbase + mi * 16) * ldc + n0 + cbase;
#pragma unroll
            for (int ni = 0; ni < 4; ++ni) {
                if (n0 + cbase + ni * 16 < N) { u32x2 v; v.x = pk2(acc[mi][ni][0], acc[mi][ni][1]); v.y = pk2(acc[mi][ni][2], acc[mi][ni][3]); *(u32x2*)(rowp + ni * 16) = v; }
            }
        }
    }
};
struct EpiSwiGLU {
    bf16_t* H; const int* list; int cnt; int n0;
    __device__ __forceinline__ void operator()(const f32x4 (&acc)[4][4], int rbase, int cbase) const {
#pragma unroll
        for (int mi = 0; mi < 4; ++mi) {
            const int r = rbase + mi * 16;
            if (r < cnt) {
                const int a = list[r];
                const int wnb = cbase & ~63, q4 = cbase & 63;
                bf16_t* rowp = H + (size_t)a * DEXP + ((n0 + wnb) >> 1) + q4;
#pragma unroll
                for (int q = 0; q < 2; ++q) {
                    float o[4];
#pragma unroll
                    for (int j = 0; j < 4; ++j) o[j] = siluf_(acc[mi][2 * q][j]) * acc[mi][2 * q + 1][j];
                    u32x2 v; v.x = pk2(o[0], o[1]); v.y = pk2(o[2], o[3]); *(u32x2*)(rowp + q * 16) = v;
                }
            }
        }
    }
};
struct EpiScatterBf16 {
    bf16_t* C; const int* list; int cnt; int n0;
    __device__ __forceinline__ void operator()(const f32x4 (&acc)[4][4], int rbase, int cbase) const {
#pragma unroll
        for (int mi = 0; mi < 4; ++mi) {
            const int r = rbase + mi * 16;
            if (r < cnt) {
                bf16_t* rowp = C + (size_t)list[r] * D + n0 + cbase;
#pragma unroll
                for (int ni = 0; ni < 4; ++ni) { u32x2 v; v.x = pk2(acc[mi][ni][0], acc[mi][ni][1]); v.y = pk2(acc[mi][ni][2], acc[mi][ni][3]); *(u32x2*)(rowp + ni * 16) = v; }
            }
        }
    }
};
struct EpiDecay {
    float* Dc; const float* w0; int m0; int n0;
    __device__ __forceinline__ void operator()(const f32x4 (&acc)[4][4], int rbase, int cbase) const {
#pragma unroll
        for (int ni = 0; ni < 4; ++ni) {
            const int col = n0 + cbase + ni * 16;
            const f32x4 w0v = *(const f32x4*)(w0 + col);
#pragma unroll
            for (int mi = 0; mi < 4; ++mi) {
                f32x4 o;
#pragma unroll
                for (int j = 0; j < 4; ++j) { const float w = w0v[j] + acc[mi][ni][j]; o[j] = __expf(-__expf(-softplusf_(-w) - 0.5f)); }
                *(f32x4*)(Dc + (size_t)(m0 + rbase + mi * 16) * 512 + col) = o;
            }
        }
    }
};
struct EpiAK {
    bf16_t* Kb; const bf16_t* KKb; bf16_t* Bb; const float* a0; const float* k_a; int m0; int n0;
    __device__ __forceinline__ void operator()(const f32x4 (&acc)[4][4], int rbase, int cbase) const {
#pragma unroll
        for (int ni = 0; ni < 4; ++ni) {
            const int col = n0 + cbase + ni * 16;
            const f32x4 a0v = *(const f32x4*)(a0 + col), kav = *(const f32x4*)(k_a + col);
#pragma unroll
            for (int mi = 0; mi < 4; ++mi) {
                const size_t off = (size_t)(m0 + rbase + mi * 16) * 512 + col;
                const u32x2 kr = *(const u32x2*)(Kb + off), kkr = *(const u32x2*)(KKb + off);
                const float kf[4] = {bflo(kr.x), bfhi(kr.x), bflo(kr.y), bfhi(kr.y)}, kkf[4] = {bflo(kkr.x), bfhi(kkr.x), bflo(kkr.y), bfhi(kkr.y)};
                float k2[4], bb[4];
#pragma unroll
                for (int j = 0; j < 4; ++j) { const float a = sigmoidf_(a0v[j] + acc[mi][ni][j]); k2[j] = kf[j] * (1.f + (a - 1.f) * kav[j]); bb[j] = kkf[j] * a; }
                u32x2 v; v.x = pk2(k2[0], k2[1]); v.y = pk2(k2[2], k2[3]); *(u32x2*)(Kb + off) = v;
                v.x = pk2(bb[0], bb[1]); v.y = pk2(bb[2], bb[3]); *(u32x2*)(Bb + off) = v;
            }
        }
    }
};

__device__ __forceinline__ void transpose_item(const float* __restrict__ W, int K, int N, bf16_t* __restrict__ WT, int mode, LAS float* scr, int item, int lane) {
    const int nblk = N / 32, kb = item / nblk, nb = item % nblk, k0 = 64 * kb, n0 = 32 * nb;
#pragma unroll 8
    for (int i = 0; i < 32; ++i) { const int kk = 2 * i + (lane >> 5); scr[kk * 33 + (lane & 31)] = W[(size_t)(k0 + kk) * N + n0 + (lane & 31)]; }
    asm volatile("s_waitcnt lgkmcnt(0)" ::: "memory");
    const int c = lane & 7;
#pragma unroll
    for (int j = 0; j < 4; ++j) {
        const int nl = (lane >> 3) + 8 * j; const LAS float* s = scr + (8 * c) * 33 + nl;
        u32x4 o; o.x = pk2(s[0 * 33], s[1 * 33]); o.y = pk2(s[2 * 33], s[3 * 33]); o.z = pk2(s[4 * 33], s[5 * 33]); o.w = pk2(s[6 * 33], s[7 * 33]);
        const int n = n0 + nl;
        const int nd = mode == 0 ? n : (32 * (n >> 4) + (n & 15) + (mode == 2 ? 16 : 0));
        *(u32x4*)(WT + (size_t)nd * K + k0 + 8 * c) = o;
    }
    asm volatile("s_waitcnt lgkmcnt(0)" ::: "memory");
}

__device__ __forceinline__ void phase_prologue0(KP Pk, LAS char* lds) {
    asm volatile("" : "+s"(Pk));
    const CAS Params& P = *Pk;
    const int tid = ltid(), lane = tid & 63, wid = tid >> 6;
    const int gw = blockIdx.x * 8 + wid, NGW = gridDim.x * 8;
    LAS float* scr = (LAS float*)(lds + wid * 8448);
    bf16_t* winT = (bf16_t*)(P.ws + WS_WINT);
    bf16_t* woutT = (bf16_t*)(P.ws + WS_WOUTT);
    bf16_t* loraT = (bf16_t*)(P.ws + WS_LORAT);
    constexpr int I_EV = 16 * (P_EVEN / 32), I_OD = 16 * (P_ODD / 32), I_O = 16 * 32, I_L64 = 16, I_L128 = 32;
    constexpr int I_LORA = 3 * I_L64 + I_L128;
    constexpr int NIT = 2 * I_EV + 2 * I_OD + 4 * I_O + 2 * I_LORA;
    for (int it = gw; it < NIT; it += NGW) {
        int r = it;
        if (r < 2 * I_EV) { const int i = r / I_EV; transpose_item(P.ev_w_in + (size_t)i * D * P_EVEN, D, P_EVEN, winT + (i ? WINT_L2 : WINT_L0), 0, scr, r % I_EV, lane); continue; } r -= 2 * I_EV;
        if (r < 2 * I_OD) { const int i = r / I_OD; transpose_item(P.od_w_in + (size_t)i * D * P_ODD, D, P_ODD, winT + (i ? WINT_L3 : WINT_L1), 0, scr, r % I_OD, lane); continue; } r -= 2 * I_OD;
        if (r < 4 * I_O) { const int l = r / I_O; const float* src = (l & 1) ? P.od_w_out + (size_t)(l >> 1) * D * D : P.ev_w_out + (size_t)(l >> 1) * D * D;
            transpose_item(src, D, D, woutT + (size_t)l * D * D, 0, scr, r % I_O, lane); continue; } r -= 4 * I_O;
        { const int i = r / I_LORA; int q = r % I_LORA; bf16_t* dst = loraT + (size_t)i * LORA_PER;
          if (q < I_L64) { transpose_item(P.rw_w2 + (size_t)(i * 2 + 0) * 64 * 512, 64, 512, dst, 0, scr, q, lane); continue; } q -= I_L64;
          if (q < I_L64) { transpose_item(P.rw_w2 + (size_t)(i * 2 + 1) * 64 * 512, 64, 512, dst + 512 * 64, 0, scr, q, lane); continue; } q -= I_L64;
          if (q < I_L64) { transpose_item(P.rw_a2 + (size_t)i * 64 * 512, 64, 512, dst + 2 * 512 * 64, 0, scr, q, lane); continue; } q -= I_L64;
          transpose_item(P.rw_g2 + (size_t)i * 128 * 512, 128, 512, dst + 3 * 512 * 64, 0, scr, q, lane); }
    }
    {
        const int gt = blockIdx.x * NT + tid, NG = gridDim.x * NT;
        constexpr int PADE = (LDP_EVEN - P_EVEN) * D / 8, PADO = (LDP_ODD - P_ODD) * D / 8;
        for (int i = gt; i < 2 * PADE + 2 * PADO; i += NG) {
            int r = i; bf16_t* dst;
            if (r < 2 * PADE) { const int l = r / PADE; dst = winT + (l ? WINT_L2 : WINT_L0) + (size_t)P_EVEN * D + (size_t)(r % PADE) * 8; }
            else { r -= 2 * PADE; const int l = r / PADO; dst = winT + (l ? WINT_L3 : WINT_L1) + (size_t)P_ODD * D + (size_t)(r % PADO) * 8; }
            *(u32x4*)dst = (u32x4){0u, 0u, 0u, 0u};
        }
    }
    {
        const int gt = blockIdx.x * NT + tid, NG = gridDim.x * NT;
        float* xc = (float*)(P.ws + WS_XC);
        for (int i = gt; i < NCTX * D / 4; i += NG) ((f32x4*)xc)[i] = ((const f32x4*)P.ctx)[i];
        float* lb = (float*)(P.ws + WS_LB);
        for (int ch = gt; ch < 512; ch += NG) {
            float lg[4], mx = -1e30f;
#pragma unroll
            for (int l = 0; l < 4; ++l) { lg[l] = P.hg_lb_logits[l * 512 + ch]; mx = fmaxf(mx, lg[l]); }
            float e[4], s = 0.f;
#pragma unroll
            for (int l = 0; l < 4; ++l) { e[l] = expf(lg[l] - mx); s += e[l]; }
            float cum = 0.f;
#pragma unroll
            for (int l = 0; l < 4; ++l) { if (l > 0) cum += e[l] / s; lb[l * 512 + ch] = cum; }
        }
    }
    __syncthreads();
    {
        LAS float* sc = (LAS float*)lds;
        LAS float* red = (LAS float*)(lds + 5 * 1024 * 4);
        for (int i = tid; i < 5 * D; i += NT) { const int m = i >> 10, k = i & 1023; const float v = m < 4 ? P.c[m * D + k] : P.c_ctx[k]; sc[i] = siluf_(v); }
        __syncthreads();
        float* modv = (float*)(P.ws + WS_MODV);
        const int col = tid & 127, kq = tid >> 7;
        for (int item = blockIdx.x; item < 4 * 48; item += gridDim.x) {
            const int l = item / 48, j = (item % 48) * 128 + col;
            const float* w = P.mod_w + (size_t)l * D * 6144 + j;
            float a[5] = {0.f, 0.f, 0.f, 0.f, 0.f};
#pragma unroll 8
            for (int k = kq * 256; k < kq * 256 + 256; ++k) {
                const float wv = w[(size_t)k * 6144];
#pragma unroll
                for (int m = 0; m < 5; ++m) a[m] += sc[m * 1024 + k] * wv;
            }
#pragma unroll
            for (int m = 0; m < 5; ++m) red[(kq * 128 + col) * 5 + m] = a[m];
            __syncthreads();
            if (kq == 0) {
                const float bias = P.mod_b[l * 6144 + j];
#pragma unroll
                for (int m = 0; m < 5; ++m) {
                    const float s = red[(0 * 128 + col) * 5 + m] + red[(1 * 128 + col) * 5 + m] + red[(2 * 128 + col) * 5 + m] + red[(3 * 128 + col) * 5 + m];
                    modv[(size_t)(l * 5 + m) * 6144 + j] = s + bias;
                }
            }
            __syncthreads();
        }
    }
}

__device__ __forceinline__ void phase_prologue1(KP Pk) {
    asm volatile("" : "+s"(Pk));
    const CAS Params& P = *Pk;
    const int tid = ltid(), lane = tid & 63, wid = tid >> 6;
    bf16_t* act = (bf16_t*)(P.ws + WS_ACT);
    for (int r = blockIdx.x * 8 + wid; r < NROWS; r += gridDim.x * 8) {
        const int m = row_mod(r);
        const float* src = r < NCTX ? P.ctx + (size_t)r * D : P.x + (size_t)(r - NCTX) * D;
        const float* sh = modvec(P.ws, 0, m, 0); const float* sc = modvec(P.ws, 0, m, 1);
#pragma unroll
        for (int i = 0; i < 4; ++i) {
            const int c = 4 * lane + 256 * i;
            const f32x4 v = *(const f32x4*)(src + c), s1 = *(const f32x4*)(sc + c), h1 = *(const f32x4*)(sh + c);
            if (r >= NCTX) *(f32x4*)(P.out + (size_t)(r - NCTX) * D + c) = v;
            u32x2 o; o.x = pk2(v[0] * (1.f + s1[0]) + h1[0], v[1] * (1.f + s1[1]) + h1[1]); o.y = pk2(v[2] * (1.f + s1[2]) + h1[2], v[3] * (1.f + s1[3]) + h1[3]);
            *(u32x2*)(act + (size_t)r * D + c) = o;
        }
    }
}

__device__ __forceinline__ void phase_inproj(KP Pk, int layer, LAS char* lds) {
    asm volatile("" : "+s"(Pk));
    const CAS Params& P = *Pk;
    const int odd = layer & 1, ldp = odd ? LDP_ODD : LDP_EVEN, N = odd ? P_ODD : P_EVEN, NTL = ldp / G_BN;
    const bf16_t* act = (const bf16_t*)(P.ws + WS_ACT);
    const size_t woff = layer == 0 ? WINT_L0 : layer == 1 ? WINT_L1 : layer == 2 ? WINT_L2 : WINT_L3;
    const bf16_t* Bt = (const bf16_t*)(P.ws + WS_WINT) + woff;
    bf16_t* Pb = (bf16_t*)(P.ws + WS_P);
    const int ntiles = (NROWS / G_BM) * NTL;
    for (int t = blockIdx.x; t < ntiles; t += gridDim.x) {
        const int mt = t / NTL, nt = t % NTL;
        RowLinear rs{mt * G_BM};
        EpiStoreBf16 epi{Pb, ldp, mt * G_BM, nt * G_BN, N};
        gemm_tile(act, D, rs, Bt, D, nt * G_BN, D, epi, lds);
    }
}
__device__ __forceinline__ void phase_outproj(KP Pk, int layer, LAS char* lds) {
    asm volatile("" : "+s"(Pk));
    const CAS Params& P = *Pk;
    const bf16_t* feat = (const bf16_t*)(P.ws + WS_FEAT);
    const bf16_t* Bt = (const bf16_t*)(P.ws + WS_WOUTT) + (size_t)layer * D * D;
    bf16_t* yo = (bf16_t*)(P.ws + (P.dbg ? WS_HID : WS_YO));
    const int mt0 = (layer == DEPTH - 1) ? NCTX / G_BM : 0;
    const int ntiles = (NROWS / G_BM - mt0) * (D / G_BN);
    for (int t = blockIdx.x; t < ntiles; t += gridDim.x) {
        const int mt = mt0 + t / (D / G_BN), nt = t % (D / G_BN);
        RowLinear rs{mt * G_BM};
        EpiStoreBf16 epi{yo, D, mt * G_BM, nt * G_BN, D};
        gemm_tile(feat, D, rs, Bt, D, nt * G_BN, D, epi, lds);
    }
}
__device__ __forceinline__ void phase_prep2(KP Pk, int layer, LAS char* lds) {
    asm volatile("" : "+s"(Pk));
    const CAS Params& P = *Pk;
    const int i = layer >> 1;
    const bf16_t* la = (const bf16_t*)(P.ws + WS_LA);
    const bf16_t* lt = (const bf16_t*)(P.ws + WS_LORAT) + (size_t)i * LORA_PER;
    constexpr int MT = NROWS / G_BM, NTL = 512 / G_BN;
    const int ntiles = 4 * MT * NTL;
    for (int t = blockIdx.x; t < ntiles; t += gridDim.x) {
        const int which = t / (MT * NTL), r = t % (MT * NTL), mt = r / NTL, nt = r % NTL;
        RowLinear rs{mt * G_BM};
        if (which < 2) {
            EpiDecay epi{(float*)(P.ws + WS_RWDEC) + (size_t)which * NROWS * 512, P.rw_w0 + (size_t)(i * 2 + which) * 512, mt * G_BM, nt * G_BN};
            gemm_tile(la + which * 64, 320, rs, lt + (size_t)which * 512 * 64, 64, nt * G_BN, 64, epi, lds);
        } else if (which == 2) {
            EpiAK epi{(bf16_t*)(P.ws + WS_RWK), (const bf16_t*)(P.ws + WS_RWKK), (bf16_t*)(P.ws + WS_RWB), P.rw_a0 + i * 512, P.rw_k_a + i * 512, mt * G_BM, nt * G_BN};
            gemm_tile(la + 128, 320, rs, lt + (size_t)2 * 512 * 64, 64, nt * G_BN, 64, epi, lds);
        } else {
            EpiStoreBf16 epi{(bf16_t*)(P.ws + WS_RWG), 512, mt * G_BM, nt * G_BN, 512};
            gemm_tile(la + 192, 320, rs, lt + (size_t)3 * 512 * 64, 128, nt * G_BN, 128, epi, lds);
        }
    }
}
__device__ __forceinline__ void moe_tiles(const unsigned char* ws, int layer, LAS int* tstart, LAS int* tcnt) {
    if (threadIdx.x == 0) {
        const int* cnt = (const int*)(ws + WS_CNT) + layer * 32;
        int acc = 0;
        for (int e = 0; e < NEXP; ++e) { const int c = cnt[e]; tcnt[e] = c; tstart[e] = acc; acc += (c + G_BM - 1) / G_BM; }
        tstart[NEXP] = acc;
    }
    __syncthreads();
}
__device__ __forceinline__ void phase_moe1(KP Pk, int layer, LAS char* lds) {
    asm volatile("" : "+s"(Pk));
    const CAS Params& P = *Pk;
    LAS int* tstart = (LAS int*)(lds + 2 * G_BUF); LAS int* tcnt = tstart + 40;
    moe_tiles(P.ws, layer, tstart, tcnt);
    const bf16_t* act = (const bf16_t*)(P.ws + WS_ACT);
    const bf16_t* gu = (const bf16_t*)(P.ws + WS_EXPGU);
    bf16_t* hid = (bf16_t*)(P.ws + WS_HID);
    const int* list = (const int*)(P.ws + WS_LIST);
    const int ntiles = tstart[NEXP] * 8;
    for (int t = blockIdx.x; t < ntiles; t += gridDim.x) {
        const int tm = t >> 3, nt = t & 7;
        int e = 0;
#pragma unroll 1
        while (tstart[e + 1] <= tm) ++e;
        const int mt = tm - tstart[e], cnt = tcnt[e] - mt * G_BM;
        const int* lp = list + (size_t)e * LISTCAP + mt * G_BM;
        RowList rs{lp, cnt, 1};
        EpiSwiGLU epi{hid, lp, cnt, nt * G_BN};
        gemm_tile(act, D, rs, gu + (size_t)e * 1024 * 1024, D, nt * G_BN, D, epi, lds);
    }
}
__device__ __forceinline__ void phase_moe2(KP Pk, int layer, LAS char* lds) {
    asm volatile("" : "+s"(Pk));
    const CAS Params& P = *Pk;
    LAS int* tstart = (LAS int*)(lds + 2 * G_BUF); LAS int* tcnt = tstart + 40;
    moe_tiles(P.ws, layer, tstart, tcnt);
    const bf16_t* hid = (const bf16_t*)(P.ws + WS_HID);
    const bf16_t* dw = (const bf16_t*)(P.ws + WS_EXPD);
    bf16_t* yp = (bf16_t*)(P.ws + WS_YP);
    const int* list = (const int*)(P.ws + WS_LIST);
    const int ntiles = tstart[NEXP] * 8;
    for (int t = blockIdx.x; t < ntiles; t += gridDim.x) {
        const int tm = t >> 3, nt = t & 7;
        int e = 0;
#pragma unroll 1
        while (tstart[e + 1] <= tm) ++e;
        const int mt = tm - tstart[e], cnt = tcnt[e] - mt * G_BM;
        const int* lp = list + (size_t)e * LISTCAP + mt * G_BM;
        RowList rs{lp, cnt, 0};
        EpiScatterBf16 epi{yp, lp, cnt, nt * G_BN};
        gemm_tile(hid, DEXP, rs, dw + (size_t)e * 1024 * 512, DEXP, nt * G_BN, DEXP, epi, lds);
    }
}

constexpr int NCHUNK = NSTEPS / TCH;

constexpr int SSD_F = 32 + 64 + 64;
constexpr int SSD_BUF = TCH * SSD_F + 3 * TCH;
__device__ __forceinline__ void scan_ssd(KP Pk, int layer, int unit, LAS char* lds) {
    asm volatile("" : "+s"(Pk));
    const CAS Params& P = *Pk;
    const int tid = ltid(), i_ = layer >> 1;
    const int seq = unit >> 1, half = unit & 1, b = seq >> 4, h = (seq >> 1) & 7, dir = seq & 1, grp = h >> 2;
    LAS float* cw = (LAS float*)lds;
    LAS float* bufs = cw + 4 * 160;
    const bf16_t* Pb = (const bf16_t*)(P.ws + WS_P);
    bf16_t* Y = (bf16_t*)(P.ws + (dir ? WS_YB : WS_YF));
    for (int i = tid; i < 4 * 160; i += NT) {
        const int tap = i / 160, lc = i % 160, g = lc >> 3, e = lc & 7;
        const int ch = g < 4 ? (h * 64 + half * 32 + 8 * g + e) : g < 12 ? (512 + grp * 64 + 8 * (g - 4) + e) : (640 + grp * 64 + 8 * (g - 12) + e);
        cw[i] = tap < 3 ? P.ssd_conv_w[(size_t)(i_ * 3 + tap) * 768 + ch] : P.ssd_conv_b[i_ * 768 + ch];
    }
    const float dtb = P.ssd_dt_bias[(i_ * 2 + dir) * 8 + h], aco = -expf(P.ssd_a_log[(i_ * 2 + dir) * 8 + h]);
    int tj[2], tg_[2], tcol[2]; bool tv[2];
#pragma unroll
    for (int s = 0; s < 2; ++s) {
        const int task = tid + NT * s; tv[s] = task < 640; tj[s] = task / 20; tg_[s] = task % 20;
        const int g = tg_[s];
        tcol[s] = g < 4 ? (512 + h * 64 + half * 32 + 8 * g) : g < 12 ? (1024 + grp * 64 + 8 * (g - 4)) : (1152 + grp * 64 + 8 * (g - 12));
    }
    u32x4 rp[2], rc[2], rn[2]; float rdt = 0.f; int rrow = 0;
    auto load = [&](int c) {
#pragma unroll
        for (int s = 0; s < 2; ++s) {
            rp[s] = rc[s] = rn[s] = (u32x4){0u, 0u, 0u, 0u};
            if (tv[s]) {
                const int row = scan_row(c * TCH + tj[s], b, dir, 0); int t, len; row_seg(row, t, len);
                const bf16_t* p = Pb + (size_t)row * LDP_EVEN + tcol[s];
                rc[s] = *(const u32x4*)p;
                if (t > 0) rp[s] = *(const u32x4*)(p - LDP_EVEN);
                if (t < len - 1) rn[s] = *(const u32x4*)(p + LDP_EVEN);
            }
        }
        if (tid < TCH) { rrow = scan_row(c * TCH + tid, b, dir, 0); rdt = bf2f(Pb[(size_t)rrow * LDP_EVEN + 1280 + dir * 8 + h]); }
    };
    auto store = [&](int c) {
        LAS float* buf = bufs + (c & 1) * SSD_BUF;
#pragma unroll
        for (int s = 0; s < 2; ++s) {
            if (tv[s]) {
                float fp[8], fc[8], fn[8], o[8]; unpack8(rp[s], fp); unpack8(rc[s], fc); unpack8(rn[s], fn);
                const int lc = tg_[s] * 8;
#pragma unroll
                for (int e = 0; e < 8; ++e) o[e] = siluf_(cw[lc + e] * fp[e] + cw[160 + lc + e] * fc[e] + cw[320 + lc + e] * fn[e] + cw[480 + lc + e]);
                LAS float* dst = buf + tj[s] * SSD_F + lc;
                *(LAS f32x4*)dst = (f32x4){o[0], o[1], o[2], o[3]}; *(LAS f32x4*)(dst + 4) = (f32x4){o[4], o[5], o[6], o[7]};
            }
        }
        if (tid < TCH) {
            const float dt = softplusf_(rdt + dtb);
            buf[TCH * SSD_F + tid] = __expf(dt * aco); buf[TCH * SSD_F + TCH + tid] = dt; ((LAS int*)buf)[TCH * SSD_F + 2 * TCH + tid] = rrow;
        }
    };
    const int prow = tid >> 4, q = tid & 15;
    float hs[4] = {0.f, 0.f, 0.f, 0.f};
    __syncthreads();
    load(0); store(0); __syncthreads();
    for (int c = 0; c < NCHUNK; ++c) {
        if (c + 1 < NCHUNK) load(c + 1);
        LAS float* buf = bufs + (c & 1) * SSD_BUF;
#pragma unroll 4
        for (int j = 0; j < TCH; ++j) {
            const LAS float* st = buf + j * SSD_F;
            const float dA = buf[TCH * SSD_F + j], dt = buf[TCH * SSD_F + TCH + j];
            const float xv = st[prow] * dt;
            const f32x4 B4 = *(const LAS f32x4*)(st + 32 + 4 * q), C4 = *(const LAS f32x4*)(st + 96 + 4 * q);
            float y = 0.f;
#pragma unroll
            for (int e = 0; e < 4; ++e) { hs[e] = dA * hs[e] + xv * B4[e]; y += C4[e] * hs[e]; }
            y = allreduce16(y);
            if (q == 0) { const int row = ((const LAS int*)buf)[TCH * SSD_F + 2 * TCH + j]; Y[(size_t)row * D + h * 64 + half * 32 + prow] = f2bf(y); }
        }
        if (c + 1 < NCHUNK) store(c + 1);
        __syncthreads();
    }
}

constexpr int ML_F = 64 + 64 + 32;
constexpr int ML_BUF = TCH * ML_F + 4 * TCH;
__device__ __forceinline__ void scan_mlstm(KP Pk, int layer, int unit, LAS char* lds) {
    asm volatile("" : "+s"(Pk));
    const CAS Params& P = *Pk;
    const int tid = ltid(), i_ = layer >> 1;
    const int seq = unit >> 2, quarter = unit & 3, b = seq >> 3, h = (seq >> 1) & 3, dir = seq & 1;
    LAS float* cw = (LAS float*)lds;
    LAS float* bufs = cw + 4 * 128;
    const bf16_t* Pb = (const bf16_t*)(P.ws + WS_P);
    bf16_t* Y = (bf16_t*)(P.ws + (dir ? WS_YB : WS_YF));
    for (int i = tid; i < 4 * 128; i += NT) {
        const int tap = i >> 7, lc = i & 127;
        const int ch = lc < 64 ? (h * 64 + lc) : (256 + h * 64 + lc - 64);
        cw[i] = tap < 3 ? P.ml_conv_w[(size_t)(i_ * 3 + tap) * 512 + ch] : P.ml_conv_b[i_ * 512 + ch];
    }
    const float ib = P.ml_i_bias[(i_ * 2 + dir) * 4 + h], fb = P.ml_f_bias[(i_ * 2 + dir) * 4 + h];
    int tj[2], tg_[2], tcol[2]; bool tv[2];
#pragma unroll
    for (int s = 0; s < 2; ++s) {
        const int task = tid + NT * s; tv[s] = task < 640; tj[s] = task / 20; tg_[s] = task % 20;
        const int g = tg_[s];
        tcol[s] = 1296 + (g < 8 ? (h * 64 + 8 * g) : g < 16 ? (256 + h * 64 + 8 * (g - 8)) : (512 + h * 128 + quarter * 32 + 8 * (g - 16)));
    }
    u32x4 rp[2], rc[2], rn[2]; float rgi = 0.f, rgf = 0.f; int rrow = 0;
    float mcarry = -1e30f;
    auto load = [&](int c) {
#pragma unroll
        for (int s = 0; s < 2; ++s) {
            rp[s] = rc[s] = rn[s] = (u32x4){0u, 0u, 0u, 0u};
            if (tv[s]) {
                const int row = scan_row(c * TCH + tj[s], b, dir, 0); int t, len; row_seg(row, t, len);
                const bf16_t* p = Pb + (size_t)row * LDP_EVEN + tcol[s];
                rc[s] = *(const u32x4*)p;
                if (tg_[s] < 16) { if (t > 0) rp[s] = *(const u32x4*)(p - LDP_EVEN); if (t < len - 1) rn[s] = *(const u32x4*)(p + LDP_EVEN); }
            }
        }
        if (tid < TCH) {
            rrow = scan_row(c * TCH + tid, b, dir, 0);
            const bf16_t* g = Pb + (size_t)rrow * LDP_EVEN + 1296 + 1536;
            rgi = bf2f(g[dir * 4 + h]); rgf = bf2f(g[8 + dir * 4 + h]);
        }
    };
    auto store = [&](int c) {
        LAS float* buf = bufs + (c & 1) * ML_BUF;
#pragma unroll
        for (int s = 0; s < 2; ++s) {
            if (tv[s]) {
                float fp[8], fc[8], fn[8], o[8]; unpack8(rp[s], fp); unpack8(rc[s], fc); unpack8(rn[s], fn);
                const int g = tg_[s], lc = g * 8;
                if (g < 16) {
                    const float scl = g < 8 ? 0.125f : 1.f;
#pragma unroll
                    for (int e = 0; e < 8; ++e) o[e] = scl * siluf_(cw[lc + e] * fp[e] + cw[128 + lc + e] * fc[e] + cw[256 + lc + e] * fn[e] + cw[384 + lc + e]);
                } else {
#pragma unroll
                    for (int e = 0; e < 8; ++e) o[e] = fc[e];
                }
                LAS float* dst = buf + tj[s] * ML_F + lc;
                *(LAS f32x4*)dst = (f32x4){o[0], o[1], o[2], o[3]}; *(LAS f32x4*)(dst + 4) = (f32x4){o[4], o[5], o[6], o[7]};
            }
        }
        if (tid < 64) {
            const int l = tid & 31;
            const float li = rgi + ib, lf = logsigmoidf_(rgf + fb);
            float F = lf;
#pragma unroll
            for (int o = 1; o < 32; o <<= 1) { const float t = __shfl_up(F, o, 32); if (l >= o) F += t; }
            float cm = li - F;
#pragma unroll
            for (int o = 1; o < 32; o <<= 1) { const float t = __shfl_up(cm, o, 32); if (l >= o) cm = fmaxf(cm, t); }
            const float m = F + fmaxf(mcarry, cm);
            float mprev = __shfl_up(m, 1, 32); if (l == 0) mprev = mcarry;
            const float sp = __expf(lf + mprev - m), sl = __expf(li - m), em = __expf(-m);
            if (tid < TCH) { buf[TCH * ML_F + tid] = sp; buf[TCH * ML_F + TCH + tid] = sl; buf[TCH * ML_F + 2 * TCH + tid] = em; ((LAS int*)buf)[TCH * ML_F + 3 * TCH + tid] = rrow; }
            mcarry = __shfl(m, 31, 32);
        }
    };
    const int col = tid >> 4, q = tid & 15;
    float Cs[4] = {0.f, 0.f, 0.f, 0.f}, ns[4] = {0.f, 0.f, 0.f, 0.f};
    __syncthreads();
    load(0); store(0); __syncthreads();
    for (int c = 0; c < NCHUNK; ++c) {
        if (c + 1 < NCHUNK) load(c + 1);
        LAS float* buf = bufs + (c & 1) * ML_BUF;
#pragma unroll 4
        for (int j = 0; j < TCH; ++j) {
            const LAS float* st = buf + j * ML_F;
            const float sp = buf[TCH * ML_F + j], sl = buf[TCH * ML_F + TCH + j], em = buf[TCH * ML_F + 2 * TCH + j];
            const f32x4 q4 = *(const LAS f32x4*)(st + 4 * q), k4 = *(const LAS f32x4*)(st + 64 + 4 * q);
            const float vv = st[128 + col];
            float num = 0.f, den = 0.f;
#pragma unroll
            for (int e = 0; e < 4; ++e) { const float sk = sl * k4[e]; Cs[e] = sp * Cs[e] + sk * vv; ns[e] = sp * ns[e] + sk; num += q4[e] * Cs[e]; den += q4[e] * ns[e]; }
            num = allreduce16(num); den = allreduce16(den);
            if (q == 0) { const int row = ((const LAS int*)buf)[TCH * ML_F + 3 * TCH + j]; Y[(size_t)row * D + 512 + h * 128 + quarter * 32 + col] = f2bf(num / fmaxf(fabsf(den), em)); }
        }
        if (c + 1 < NCHUNK) store(c + 1);
        __syncthreads();
    }
}

constexpr int HG_F = 128 + 128 + 32;
constexpr int HG_BUF = TCH * HG_F + TCH;
__device__ __forceinline__ void scan_hgrn(KP Pk, int layer, int unit, LAS char* lds) {
    asm volatile("" : "+s"(Pk));
    const CAS Params& P = *Pk;
    const int tid = ltid(), i_ = layer >> 1;
    const int seq = unit >> 2, quarter = unit & 3, b = seq >> 3, h = (seq >> 1) & 3, dir = seq & 1;
    LAS float* cst = (LAS float*)lds;
    LAS float* bufs = cst + 256;
    const bf16_t* Pb = (const bf16_t*)(P.ws + WS_P);
    bf16_t* Y = (bf16_t*)(P.ws + (dir ? WS_YB : WS_YF));
    if (tid < 128) cst[tid] = ((const float*)(P.ws + WS_LB))[layer * 512 + h * 128 + tid];
    else if (tid < 256) cst[tid] = P.hg_f_bias[(size_t)(i_ * 2 + dir) * 512 + h * 128 + tid - 128];
    int tj[3], tg_[3], tcol[3]; bool tv[3];
#pragma unroll
    for (int s = 0; s < 3; ++s) {
        const int task = tid + NT * s; tv[s] = task < TCH * 36; tj[s] = task / 36; tg_[s] = task % 36;
        const int g = tg_[s];
        tcol[s] = g < 16 ? (512 + dir * 512 + h * 128 + 8 * g) : g < 32 ? (h * 128 + 8 * (g - 16)) : (1536 + h * 128 + quarter * 32 + 8 * (g - 32));
    }
    u32x4 rc[3]; int rrow = 0;
    auto load = [&](int c) {
#pragma unroll
        for (int s = 0; s < 3; ++s) {
            rc[s] = (u32x4){0u, 0u, 0u, 0u};
            if (tv[s]) { const int row = scan_row(c * TCH + tj[s], b, dir, 1); rc[s] = *(const u32x4*)(Pb + (size_t)row * LDP_ODD + tcol[s]); }
        }
        if (tid < TCH) rrow = scan_row(c * TCH + tid, b, dir, 1);
    };
    auto store = [&](int c) {
        LAS float* buf = bufs + (c & 1) * HG_BUF;
#pragma unroll
        for (int s = 0; s < 3; ++s) {
            if (tv[s]) {
                float fc[8], o[8]; unpack8(rc[s], fc);
                const int g = tg_[s], lc = g * 8;
                if (g < 16) {
#pragma unroll
                    for (int e = 0; e < 8; ++e) { const float lbv = cst[lc + e]; o[e] = lbv + (1.f - lbv) * sigmoidf_(fc[e] + cst[128 + lc + e]); }
                } else if (g < 32) {
#pragma unroll
                    for (int e = 0; e < 8; ++e) o[e] = siluf_(fc[e]);
                } else {
#pragma unroll
                    for (int e = 0; e < 8; ++e) o[e] = fc[e];
                }
                LAS float* dst = buf + tj[s] * HG_F + lc;
                *(LAS f32x4*)dst = (f32x4){o[0], o[1], o[2], o[3]}; *(LAS f32x4*)(dst + 4) = (f32x4){o[4], o[5], o[6], o[7]};
            }
        }
        if (tid < TCH) ((LAS int*)buf)[TCH * HG_F + tid] = rrow;
    };
    const int col = tid >> 4, q = tid & 15;
    float S[8];
#pragma unroll
    for (int e = 0; e < 8; ++e) S[e] = 0.f;
    __syncthreads();
    load(0); store(0); __syncthreads();
    for (int c = 0; c < NCHUNK; ++c) {
        if (c + 1 < NCHUNK) load(c + 1);
        LAS float* buf = bufs + (c & 1) * HG_BUF;
#pragma unroll 4
        for (int j = 0; j < TCH; ++j) {
            const LAS float* st = buf + j * HG_F;
            const f32x4 f0 = *(const LAS f32x4*)(st + 8 * q), f1 = *(const LAS f32x4*)(st + 8 * q + 4);
            const f32x4 q0 = *(const LAS f32x4*)(st + 128 + 8 * q), q1 = *(const LAS f32x4*)(st + 128 + 8 * q + 4);
            const float vv = st[256 + col];
            float o = 0.f;
#pragma unroll
            for (int e = 0; e < 4; ++e) { S[e] = f0[e] * (S[e] - vv) + vv; o += q0[e] * S[e]; S[4 + e] = f1[e] * (S[4 + e] - vv) + vv; o += q1[e] * S[4 + e]; }
            o = allreduce16(o);
            if (q == 0) { const int row = ((const LAS int*)buf)[TCH * HG_F + j]; Y[(size_t)row * D + h * 128 + quarter * 32 + col] = f2bf(o); }
        }
        if (c + 1 < NCHUNK) store(c + 1);
        __syncthreads();
    }
}

constexpr int RW_F = 5 * 64 + 32;
constexpr int RW_BUF = TCH * RW_F + TCH;
__device__ __forceinline__ void scan_rwkv(KP Pk, int layer, int unit, LAS char* lds) {
    asm volatile("" : "+s"(Pk));
    const CAS Params& P = *Pk;
    const int tid = ltid();
    const int seq = unit >> 1, half = unit & 1, b = seq >> 4, h = (seq >> 1) & 7, dir = seq & 1;
    LAS float* bufs = (LAS float*)lds;
    bf16_t* Y = (bf16_t*)(P.ws + (dir ? WS_YB : WS_YF));
    const float* dec = (const float*)(P.ws + WS_RWDEC) + (size_t)dir * NROWS * 512;
    int tj[4], tg_[4]; bool tv[4]; const unsigned char* tbase[4]; int tlds[4];
#pragma unroll
    for (int s = 0; s < 4; ++s) {
        const int task = tid + NT * s; tv[s] = task < TCH * 52; tj[s] = task / 52; tg_[s] = task % 52;
        const int g = tg_[s];
        if (g < 8)       { tbase[s] = P.ws + WS_RWR  + (size_t)(h * 64 + 8 * g) * 2;              tlds[s] = 256 + 8 * g; }
        else if (g < 16) { tbase[s] = P.ws + WS_RWK  + (size_t)(h * 64 + 8 * (g - 8)) * 2;        tlds[s] = 192 + 8 * (g - 8); }
        else if (g < 24) { tbase[s] = P.ws + WS_RWKK + (size_t)(h * 64 + 8 * (g - 16)) * 2;       tlds[s] = 64 + 8 * (g - 16); }
        else if (g < 32) { tbase[s] = P.ws + WS_RWB  + (size_t)(h * 64 + 8 * (g - 24)) * 2;       tlds[s] = 128 + 8 * (g - 24); }
        else if (g < 36) { tbase[s] = P.ws + WS_RWV  + (size_t)(h * 64 + half * 32 + 8 * (g - 32)) * 2; tlds[s] = 320 + 8 * (g - 32); }
        else             { tbase[s] = (const unsigned char*)(dec + h * 64 + 4 * (g - 36));        tlds[s] = 4 * (g - 36); }
    }
    u32x4 rc[4]; int rrow = 0;
    auto load = [&](int c) {
#pragma unroll
        for (int s = 0; s < 4; ++s) {
            rc[s] = (u32x4){0u, 0u, 0u, 0u};
            if (tv[s]) { const int row = scan_row(c * TCH + tj[s], b, dir, 1); rc[s] = *(const u32x4*)(tbase[s] + (size_t)row * (tg_[s] < 36 ? 1024 : 2048)); }
        }
        if (tid < TCH) rrow = scan_row(c * TCH + tid, b, dir, 1);
    };
    auto store = [&](int c) {
        LAS float* buf = bufs + (c & 1) * RW_BUF;
#pragma unroll
        for (int s = 0; s < 4; ++s) {
            if (tv[s]) {
                LAS float* dst = buf + tj[s] * RW_F + tlds[s];
                const int g = tg_[s];
                if (g >= 36) { *(LAS u32x4*)dst = rc[s]; }
                else {
                    float f[8]; unpack8(rc[s], f);
                    const float sg = (g >= 16 && g < 24) ? -1.f : 1.f;
                    *(LAS f32x4*)dst = (f32x4){sg * f[0], sg * f[1], sg * f[2], sg * f[3]}; *(LAS f32x4*)(dst + 4) = (f32x4){sg * f[4], sg * f[5], sg * f[6], sg * f[7]};
                }
            }
        }
        if (tid < TCH) ((LAS int*)buf)[TCH * RW_F + tid] = rrow;
    };
    const int vrow = tid >> 4, q = tid & 15;
    float S[4] = {0.f, 0.f, 0.f, 0.f};
    load(0); store(0); __syncthreads();
    for (int c = 0; c < NCHUNK; ++c) {
        if (c + 1 < NCHUNK) load(c + 1);
        LAS float* buf = bufs + (c & 1) * RW_BUF;
#pragma unroll 4
        for (int j = 0; j < TCH; ++j) {
            const LAS float* st = buf + j * RW_F;
            const f32x4 w4 = *(const LAS f32x4*)(st + 4 * q), a4 = *(const LAS f32x4*)(st + 64 + 4 * q), b4 = *(const LAS f32x4*)(st + 128 + 4 * q);
            const f32x4 k4 = *(const LAS f32x4*)(st + 192 + 4 * q), r4 = *(const LAS f32x4*)(st + 256 + 4 * q);
            const float vv = st[320 + vrow];
            float sa = S[0] * a4[0] + S[1] * a4[1] + S[2] * a4[2] + S[3] * a4[3];
            sa = allreduce16(sa);
            float y = 0.f;
#pragma unroll
            for (int e = 0; e < 4; ++e) { S[e] = S[e] * w4[e] + (sa * b4[e] + vv * k4[e]); y += S[e] * r4[e]; }
            y = allreduce16(y);
            if (q == 0) { const int row = ((const LAS int*)buf)[TCH * RW_F + j]; Y[(size_t)row * D + 512 + h * 64 + half * 32 + vrow] = f2bf(y); }
        }
        if (c + 1 < NCHUNK) store(c + 1);
        __syncthreads();
    }
}

__device__ __forceinline__ void phase_prep1(KP Pk, int layer) {
    asm volatile("" : "+s"(Pk));
    const CAS Params& P = *Pk;
    const int tid = ltid(), lane = tid & 63, wid = tid >> 6, i_ = layer >> 1;
    const bf16_t* Pb = (const bf16_t*)(P.ws + WS_P);
    bf16_t* R = (bf16_t*)(P.ws + WS_RWR); bf16_t* K = (bf16_t*)(P.ws + WS_RWK); bf16_t* V = (bf16_t*)(P.ws + WS_RWV); bf16_t* KK = (bf16_t*)(P.ws + WS_RWKK);
    bf16_t* LA = (bf16_t*)(P.ws + WS_LA);
    const float* mu = P.rw_mu + (size_t)i_ * 1856;
    for (int r = blockIdx.x * 8 + wid; r < NROWS; r += gridDim.x * 8) {
        int rprev = -1, rnext = -1;
        if (r < NCTX) { const int t = r & 255; if (t > 0) rprev = r - 1; if (t < CTXL - 1) rnext = r + 1; }
        else {
            const int bs = (r - NCTX) >> 13, s = (r - NCTX) & 8191, sg = ((s & 63) << 7) + (s >> 6);
            if (sg > 0) { const int g2 = sg - 1; rprev = NCTX + bs * SEQ + ((g2 & 127) << 6) + (g2 >> 7); }
            if (sg < SEQ - 1) { const int g2 = sg + 1; rnext = NCTX + bs * SEQ + ((g2 & 127) << 6) + (g2 >> 7); }
        }
        const bf16_t* pc = Pb + (size_t)r * LDP_ODD + 2560;
        const bf16_t* pp = Pb + (size_t)(rprev < 0 ? r : rprev) * LDP_ODD + 2560;
        const bf16_t* pn = Pb + (size_t)(rnext < 0 ? r : rnext) * LDP_ODD + 2560;
        const float mp = rprev < 0 ? 0.f : 0.5f, mn = rnext < 0 ? 0.f : 0.5f;
        auto mix8 = [&](int col, float* o) {
            float fc[8], fp[8], fn[8];
            unpack8(*(const u32x4*)(pc + col), fc); unpack8(*(const u32x4*)(pp + col), fp); unpack8(*(const u32x4*)(pn + col), fn);
#pragma unroll
            for (int e = 0; e < 8; ++e) o[e] = fc[e] + mu[col + e] * (mp * fp[e] + mn * fn[e] - fc[e]);
        };
        float o[8];
        mix8(8 * lane, o); *(u32x4*)(R + (size_t)r * 512 + 8 * lane) = pack8(o);
        mix8(1024 + 8 * lane, o); *(u32x4*)(V + (size_t)r * 512 + 8 * lane) = pack8(o);
        mix8(512 + 8 * lane, o); *(u32x4*)(K + (size_t)r * 512 + 8 * lane) = pack8(o);
        {
            float kk[8], ss = 0.f;
#pragma unroll
            for (int e = 0; e < 8; ++e) { kk[e] = o[e] * P.rw_k_k[i_ * 512 + 8 * lane + e]; ss += kk[e] * kk[e]; }
            ss = group_sum<8>(ss);
            const float rn = rsqrtf(fmaxf(ss, 1e-12f));
#pragma unroll
            for (int e = 0; e < 8; ++e) kk[e] *= rn;
            *(u32x4*)(KK + (size_t)r * 512 + 8 * lane) = pack8(kk);
        }
        if (lane < 40) {
            mix8(1536 + 8 * lane, o);
            if (lane < 16) {
#pragma unroll
                for (int e = 0; e < 8; ++e) o[e] = tanhf(o[e]);
            } else if (lane >= 24) {
#pragma unroll
                for (int e = 0; e < 8; ++e) o[e] = sigmoidf_(o[e]);
            }
            *(u32x4*)(LA + (size_t)r * 320 + 8 * lane) = pack8(o);
        }
    }
}

__device__ __forceinline__ void phase_out_even(KP Pk, int layer) {
    asm volatile("" : "+s"(Pk));
    const CAS Params& P = *Pk;
    const int tid = ltid(), lane = tid & 63, wid = tid >> 6, i_ = layer >> 1;
    const bf16_t* Pb = (const bf16_t*)(P.ws + WS_P);
    const bf16_t* Yf = (const bf16_t*)(P.ws + WS_YF); const bf16_t* Yb = (const bf16_t*)(P.ws + WS_YB);
    bf16_t* feat = (bf16_t*)(P.ws + WS_FEAT);
    const int r0 = (layer == DEPTH - 1) ? NCTX : 0;
    float cwv[4][8], nwa[8], nwb[8];
#pragma unroll
    for (int e = 0; e < 8; ++e) {
#pragma unroll
        for (int t = 0; t < 3; ++t) cwv[t][e] = P.ssd_conv_w[(size_t)(i_ * 3 + t) * 768 + 8 * lane + e];
        cwv[3][e] = P.ssd_conv_b[i_ * 768 + 8 * lane + e];
        nwa[e] = P.ssd_norm_w[i_ * 512 + 8 * lane + e]; nwb[e] = P.ml_norm_w[i_ * 512 + 8 * lane + e];
    }
    const float dsk = P.ssd_d[i_ * 8 + (lane >> 3)];
    for (int r = r0 + blockIdx.x * 8 + wid; r < NROWS; r += gridDim.x * 8) {
        int t, len; row_seg(r, t, len);
        const bf16_t* pr = Pb + (size_t)r * LDP_EVEN;
        float y[8];
        {
            float a[8], bb[8], fc[8], fp[8], fn[8], z[8];
            unpack8(*(const u32x4*)(Yf + (size_t)r * D + 8 * lane), a); unpack8(*(const u32x4*)(Yb + (size_t)r * D + 8 * lane), bb);
            unpack8(*(const u32x4*)(pr + 512 + 8 * lane), fc); unpack8(*(const u32x4*)(pr + 8 * lane), z);
            const u32x4 zero = (u32x4){0u, 0u, 0u, 0u};
            unpack8(t > 0 ? *(const u32x4*)(pr - LDP_EVEN + 512 + 8 * lane) : zero, fp);
            unpack8(t < len - 1 ? *(const u32x4*)(pr + LDP_EVEN + 512 + 8 * lane) : zero, fn);
            float ss = 0.f;
#pragma unroll
            for (int e = 0; e < 8; ++e) {
                const float xs = siluf_(cwv[0][e] * fp[e] + cwv[1][e] * fc[e] + cwv[2][e] * fn[e] + cwv[3][e]);
                y[e] = (a[e] + bb[e] + dsk * xs) * siluf_(z[e]); ss += y[e] * y[e];
            }
            ss = wave_sum(ss);
            const float rn = rsqrtf(ss * (1.f / 512.f) + 1e-6f);
#pragma unroll
            for (int e = 0; e < 8; ++e) y[e] = y[e] * rn * nwa[e];
            *(u32x4*)(feat + (size_t)r * D + 8 * lane) = pack8(y);
        }
        {
            float a[8], bb[8], o[8];
            unpack8(*(const u32x4*)(Yf + (size_t)r * D + 512 + 8 * lane), a); unpack8(*(const u32x4*)(Yb + (size_t)r * D + 512 + 8 * lane), bb);
            unpack8(*(const u32x4*)(pr + 2320 + 8 * lane), o);
            float s = 0.f;
#pragma unroll
            for (int e = 0; e < 8; ++e) { y[e] = a[e] + bb[e]; s += y[e]; }
            const float mean = group_sum<16>(s) * (1.f / 128.f);
            float ss = 0.f;
#pragma unroll
            for (int e = 0; e < 8; ++e) { y[e] -= mean; ss += y[e] * y[e]; }
            const float rn = rsqrtf(group_sum<16>(ss) * (1.f / 128.f) + 1e-6f);
#pragma unroll
            for (int e = 0; e < 8; ++e) y[e] = sigmoidf_(o[e]) * (y[e] * rn) * nwb[e];
            *(u32x4*)(feat + (size_t)r * D + 512 + 8 * lane) = pack8(y);
        }
    }
}
__device__ __forceinline__ void phase_out_odd(KP Pk, int layer) {
    asm volatile("" : "+s"(Pk));
    const CAS Params& P = *Pk;
    const int tid = ltid(), lane = tid & 63, wid = tid >> 6, i_ = layer >> 1;
    const bf16_t* Pb = (const bf16_t*)(P.ws + WS_P);
    const bf16_t* Yf = (const bf16_t*)(P.ws + WS_YF); const bf16_t* Yb = (const bf16_t*)(P.ws + WS_YB);
    const bf16_t* R = (const bf16_t*)(P.ws + WS_RWR); const bf16_t* K = (const bf16_t*)(P.ws + WS_RWK); const bf16_t* V = (const bf16_t*)(P.ws + WS_RWV); const bf16_t* G = (const bf16_t*)(P.ws + WS_RWG);
    bf16_t* feat = (bf16_t*)(P.ws + WS_FEAT);
    const int r0 = (layer == DEPTH - 1) ? NCTX : 0;
    float nwc[8], rk[8], lw[8], lbv[8];
#pragma unroll
    for (int e = 0; e < 8; ++e) {
        nwc[e] = P.hg_norm_w[i_ * 512 + 8 * lane + e]; rk[e] = P.rw_r_k[i_ * 512 + 8 * lane + e];
        lw[e] = P.rw_ln_w[i_ * 512 + 8 * lane + e]; lbv[e] = P.rw_ln_b[i_ * 512 + 8 * lane + e];
    }
    for (int r = r0 + blockIdx.x * 8 + wid; r < NROWS; r += gridDim.x * 8) {
        float y[8];
        {
            float a[8], bb[8], g[8];
            unpack8(*(const u32x4*)(Yf + (size_t)r * D + 8 * lane), a); unpack8(*(const u32x4*)(Yb + (size_t)r * D + 8 * lane), bb);
            unpack8(*(const u32x4*)(Pb + (size_t)r * LDP_ODD + 2048 + 8 * lane), g);
            float ss = 0.f;
#pragma unroll
            for (int e = 0; e < 8; ++e) { y[e] = a[e] + bb[e]; ss += y[e] * y[e]; }
            const float rn = rsqrtf(group_sum<16>(ss) * (1.f / 128.f) + 1e-6f);
#pragma unroll
            for (int e = 0; e < 8; ++e) y[e] = y[e] * rn * nwc[e] * siluf_(g[e]);
            *(u32x4*)(feat + (size_t)r * D + 8 * lane) = pack8(y);
        }
        {
            float a[8], bb[8], rr[8], kk[8], vv[8], g[8];
            unpack8(*(const u32x4*)(Yf + (size_t)r * D + 512 + 8 * lane), a); unpack8(*(const u32x4*)(Yb + (size_t)r * D + 512 + 8 * lane), bb);
            unpack8(*(const u32x4*)(R + (size_t)r * 512 + 8 * lane), rr); unpack8(*(const u32x4*)(K + (size_t)r * 512 + 8 * lane), kk);
            unpack8(*(const u32x4*)(V + (size_t)r * 512 + 8 * lane), vv); unpack8(*(const u32x4*)(G + (size_t)r * 512 + 8 * lane), g);
            float s = 0.f, bs = 0.f;
#pragma unroll
            for (int e = 0; e < 8; ++e) { y[e] = a[e] + bb[e]; s += y[e]; bs += rr[e] * kk[e] * rk[e]; }
            const float mean = group_sum<8>(s) * (1.f / 64.f); bs = group_sum<8>(bs);
            float ss = 0.f;
#pragma unroll
            for (int e = 0; e < 8; ++e) { y[e] -= mean; ss += y[e] * y[e]; }
            const float rn = rsqrtf(group_sum<8>(ss) * (1.f / 64.f) + 64e-5f);
#pragma unroll
            for (int e = 0; e < 8; ++e) y[e] = (y[e] * rn * lw[e] + lbv[e] + bs * vv[e]) * g[e];
            *(u32x4*)(feat + (size_t)r * D + 512 + 8 * lane) = pack8(y);
        }
    }
}

__device__ __forceinline__ void phase_ln1(KP Pk, int layer, LAS char* lds) {
    asm volatile("" : "+s"(Pk));
    const CAS Params& P = *Pk;
    const int tid = ltid(), lane = tid & 63, wid = tid >> 6;
    {
        LAS float* scr = (LAS float*)(lds + wid * 8448);
        const int gw = blockIdx.x * 8 + wid, NGW = gridDim.x * 8;
        bf16_t* gu = (bf16_t*)(P.ws + WS_EXPGU); bf16_t* dw = (bf16_t*)(P.ws + WS_EXPD);
        constexpr int IG = 16 * 16, IDN = 8 * 32;
        for (int it = gw; it < NEXP * (2 * IG + IDN); it += NGW) {
            const int e = it / (2 * IG + IDN); int r = it % (2 * IG + IDN);
            const size_t eo = (size_t)(layer * NEXP + e);
            if (r < IG) { transpose_item(P.exp_w_gate + eo * D * DEXP, D, DEXP, gu + (size_t)e * 1024 * 1024, 1, scr, r, lane); continue; } r -= IG;
            if (r < IG) { transpose_item(P.exp_w_up + eo * D * DEXP, D, DEXP, gu + (size_t)e * 1024 * 1024, 2, scr, r, lane); continue; } r -= IG;
            transpose_item(P.exp_w_down + eo * DEXP * D, DEXP, D, dw + (size_t)e * 1024 * 512, 0, scr, r, lane);
        }
    }
    __syncthreads();
    LAS float* rwT = (LAS float*)lds;
    LAS float* scs = (LAS float*)(lds + 32 * 1024 * 4) + wid * 32;
    for (int i = tid; i < D * NEXP; i += NT) { const int col = i >> 5, e = i & 31; rwT[e * 1024 + col] = P.router_w[i]; }
    __syncthreads();
    const bf16_t* yo = (const bf16_t*)(P.ws + WS_YO);
    bf16_t* act = (bf16_t*)(P.ws + WS_ACT);
    float* xc = (float*)(P.ws + WS_XC);
    int* cnt = (int*)(P.ws + WS_CNT) + layer * 32;
    int* list = (int*)(P.ws + WS_LIST);
    float* wts = (float*)(P.ws + WS_WTS);
    const float* lg = P.ln_g + (size_t)(layer * 2 + 0) * D; const float* lb = P.ln_b + (size_t)(layer * 2 + 0) * D;
    const int r0 = (layer == DEPTH - 1) ? NCTX : 0;
    for (int r = r0 + blockIdx.x * 8 + wid; r < NROWS; r += gridDim.x * 8) {
        const int m = row_mod(r);
        float* xr = r < NCTX ? xc + (size_t)r * D : P.out + (size_t)(r - NCTX) * D;
        const float* g1 = modvec(P.ws, layer, m, 2); const float* sh2 = modvec(P.ws, layer, m, 3); const float* sc2 = modvec(P.ws, layer, m, 4);
        f32x4 v[4]; float s = 0.f;
#pragma unroll
        for (int i = 0; i < 4; ++i) {
            const int c = 4 * lane + 256 * i;
            const f32x4 xv = *(const f32x4*)(xr + c), gv = *(const f32x4*)(g1 + c);
            const u32x2 yv = *(const u32x2*)(yo + (size_t)r * D + c);
            v[i][0] = ALPHA * xv[0] + gv[0] * bflo(yv.x); v[i][1] = ALPHA * xv[1] + gv[1] * bfhi(yv.x);
            v[i][2] = ALPHA * xv[2] + gv[2] * bflo(yv.y); v[i][3] = ALPHA * xv[3] + gv[3] * bfhi(yv.y);
            s += (v[i][0] + v[i][1]) + (v[i][2] + v[i][3]);
        }
        const float mean = wave_sum(s) * (1.f / D);
        float s2 = 0.f;
#pragma unroll
        for (int i = 0; i < 4; ++i) { v[i] = v[i] - mean; s2 += (v[i][0] * v[i][0] + v[i][1] * v[i][1]) + (v[i][2] * v[i][2] + v[i][3] * v[i][3]); }
        const float rstd = rsqrtf(wave_sum(s2) * (1.f / D) + 1e-5f);
        float acc[32];
#pragma unroll
        for (int e = 0; e < 32; ++e) acc[e] = 0.f;
#pragma unroll
        for (int i = 0; i < 4; ++i) {
            const int c = 4 * lane + 256 * i;
            const f32x4 gg = *(const f32x4*)(lg + c), bb = *(const f32x4*)(lb + c), s2v = *(const f32x4*)(sc2 + c), h2v = *(const f32x4*)(sh2 + c);
            f32x4 xn, hv;
#pragma unroll
            for (int j = 0; j < 4; ++j) { xn[j] = v[i][j] * rstd * gg[j] + bb[j]; hv[j] = xn[j] * (1.f + s2v[j]) + h2v[j]; }
            *(f32x4*)(xr + c) = xn;
            u32x2 o; o.x = pk2(hv[0], hv[1]); o.y = pk2(hv[2], hv[3]); *(u32x2*)(act + (size_t)r * D + c) = o;
#pragma unroll
            for (int e = 0; e < 32; ++e) { const f32x4 w = *(const LAS f32x4*)(rwT + e * 1024 + c); acc[e] += (hv[0] * w[0] + hv[1] * w[1]) + (hv[2] * w[2] + hv[3] * w[3]); }
        }
#pragma unroll
        for (int st = 0; st < 5; ++st) {
            const int half = 16 >> st, msk = 32 >> st;
            const bool up = (lane & msk) != 0;
#pragma unroll
            for (int j = 0; j < 16; ++j) {
                if (j < half) {
                    const float keep = up ? acc[j + half] : acc[j], send = up ? acc[j] : acc[j + half];
                    acc[j] = keep + __shfl_xor(send, msk);
                }
            }
        }
        acc[0] += __shfl_xor(acc[0], 1);
        {
            const int e = (lane >> 1) & 31;
            const int eidx = ((e >> 4) & 1) * 16 + ((e >> 3) & 1) * 8 + ((e >> 2) & 1) * 4 + ((e >> 1) & 1) * 2 + (e & 1);
            if ((lane & 1) == 0) scs[eidx] = acc[0];
        }
        asm volatile("s_waitcnt lgkmcnt(0)" ::: "memory");
        float best = -1e30f; int bg = 0;
#pragma unroll
        for (int g = 0; g < 8; ++g) {
            float m1 = -1e30f, m2 = -1e30f;
#pragma unroll
            for (int k = 0; k < 4; ++k) { const float vsc = sigmoidf_(scs[g * 4 + k]) + P.router_bias[g * 4 + k]; if (vsc > m1) { m2 = m1; m1 = vsc; } else if (vsc > m2) m2 = vsc; }
            const float gs = m1 + m2;
            if (gs > best) { best = gs; bg = g; }
        }
        float sv[4], bv[4];
#pragma unroll
        for (int k = 0; k < 4; ++k) { sv[k] = sigmoidf_(scs[bg * 4 + k]); bv[k] = sv[k] + P.router_bias[bg * 4 + k]; }
        int i1 = 0; float b1 = bv[0];
#pragma unroll
        for (int k = 1; k < 4; ++k) if (bv[k] > b1) { b1 = bv[k]; i1 = k; }
        int i2 = -1; float b2 = -1e30f;
#pragma unroll
        for (int k = 0; k < 4; ++k) if (k != i1 && bv[k] > b2) { b2 = bv[k]; i2 = k; }
        float s1 = sv[0], s2s = sv[0];
#pragma unroll
        for (int k = 1; k < 4; ++k) { if (i1 == k) s1 = sv[k]; if (i2 == k) s2s = sv[k]; }
        if (lane == 0) {
            const int e0 = bg * 4 + i1, e1 = bg * 4 + i2;
            const float inv = 1.f / (s1 + s2s);
            const int p0 = atomicAdd(&cnt[e0], 1), p1 = atomicAdd(&cnt[e1], 1);
            list[(size_t)e0 * LISTCAP + p0] = 2 * r; list[(size_t)e1 * LISTCAP + p1] = 2 * r + 1;
            wts[2 * r] = s1 * inv; wts[2 * r + 1] = s2s * inv;
        }
    }
}

__device__ __forceinline__ void phase_ln2(KP Pk, int layer) {
    asm volatile("" : "+s"(Pk));
    const CAS Params& P = *Pk;
    const int tid = ltid(), lane = tid & 63, wid = tid >> 6;
    const bf16_t* yp = (const bf16_t*)(P.ws + WS_YP);
    const float* wts = (const float*)(P.ws + WS_WTS);
    bf16_t* act = (bf16_t*)(P.ws + WS_ACT);
    float* xc = (float*)(P.ws + WS_XC);
    const float* lg = P.ln_g + (size_t)(layer * 2 + 1) * D; const float* lb = P.ln_b + (size_t)(layer * 2 + 1) * D;
    const bool last = (layer == DEPTH - 1);
    const int r0 = last ? NCTX : 0;
    for (int r = r0 + blockIdx.x * 8 + wid; r < NROWS; r += gridDim.x * 8) {
        const int m = row_mod(r);
        float* xr = r < NCTX ? xc + (size_t)r * D : P.out + (size_t)(r - NCTX) * D;
        const float* g2 = modvec(P.ws, layer, m, 5);
        const float w0 = wts[2 * r], w1 = wts[2 * r + 1];
        f32x4 v[4]; float s = 0.f;
#pragma unroll
        for (int i = 0; i < 4; ++i) {
            const int c = 4 * lane + 256 * i;
            const f32x4 xv = *(const f32x4*)(xr + c), gv = *(const f32x4*)(g2 + c);
            const u32x2 y0 = *(const u32x2*)(yp + (size_t)(2 * r) * D + c), y1 = *(const u32x2*)(yp + (size_t)(2 * r + 1) * D + c);
            v[i][0] = ALPHA * xv[0] + gv[0] * (w0 * bflo(y0.x) + w1 * bflo(y1.x)); v[i][1] = ALPHA * xv[1] + gv[1] * (w0 * bfhi(y0.x) + w1 * bfhi(y1.x));
            v[i][2] = ALPHA * xv[2] + gv[2] * (w0 * bflo(y0.y) + w1 * bflo(y1.y)); v[i][3] = ALPHA * xv[3] + gv[3] * (w0 * bfhi(y0.y) + w1 * bfhi(y1.y));
            s += (v[i][0] + v[i][1]) + (v[i][2] + v[i][3]);
        }
        const float mean = wave_sum(s) * (1.f / D);
        float s2 = 0.f;
#pragma unroll
        for (int i = 0; i < 4; ++i) { v[i] = v[i] - mean; s2 += (v[i][0] * v[i][0] + v[i][1] * v[i][1]) + (v[i][2] * v[i][2] + v[i][3] * v[i][3]); }
        const float rstd = rsqrtf(wave_sum(s2) * (1.f / D) + 1e-5f);
        const float* sh1 = last ? lg : modvec(P.ws, layer + 1, m, 0); const float* sc1 = last ? lg : modvec(P.ws, layer + 1, m, 1);
#pragma unroll
        for (int i = 0; i < 4; ++i) {
            const int c = 4 * lane + 256 * i;
            const f32x4 gg = *(const f32x4*)(lg + c), bb = *(const f32x4*)(lb + c);
            f32x4 xn;
#pragma unroll
            for (int j = 0; j < 4; ++j) xn[j] = v[i][j] * rstd * gg[j] + bb[j];
            *(f32x4*)(xr + c) = xn;
            if (!last) {
                const f32x4 s1v = *(const f32x4*)(sc1 + c), h1v = *(const f32x4*)(sh1 + c);
                u32x2 o; o.x = pk2(xn[0] * (1.f + s1v[0]) + h1v[0], xn[1] * (1.f + s1v[1]) + h1v[1]); o.y = pk2(xn[2] * (1.f + s1v[2]) + h1v[2], xn[3] * (1.f + s1v[3]) + h1v[3]);
                *(u32x2*)(act + (size_t)r * D + c) = o;
            }
        }
    }
}

constexpr int NPHASE = 2 + 10 * DEPTH;
__global__ void __launch_bounds__(NT, 2) fwd_kernel(Params P) {
    extern __shared__ __attribute__((aligned(16))) char lds_raw[];
    LAS char* lds = (LAS char*)lds_raw;
    volatile LAS unsigned* xbw = (volatile LAS unsigned*)(lds + LDS_BYTES - 16);
    KP Pk = (KP)__builtin_amdgcn_kernarg_segment_ptr();
    const bool multi = (P.ph_hi - P.ph_lo) > 1;
    XcdBarrier bar; bar.bar = (unsigned*)(P.ws + WS_BAR); bar.x = 0; bar.st = xbw;
    if (multi) {
        if (threadIdx.x == 0) { xbw[0] = 0u; xbw[1] = 0u; xbw[2] = 0u; xbw[3] = 0u; }
        __syncthreads();
        bar = xcd_barrier_post((unsigned*)(P.ws + WS_BAR), xbw);
    }
#define PHASE(id, body) do { if (P.ph_lo <= (id) && (id) < P.ph_hi) { body; if ((id) + 1 < P.ph_hi) xcd_barrier(bar); } } while (0)
    PHASE(0, phase_prologue0(Pk, lds));
    PHASE(1, phase_prologue1(Pk));
    for (int l = 0; l < DEPTH; ++l) {
        const int pb = 2 + 10 * l, odd = l & 1;
        PHASE(pb + 0, phase_inproj(Pk, l, lds));
        if (odd) {
            PHASE(pb + 1, phase_prep1(Pk, l));
            PHASE(pb + 2, phase_prep2(Pk, l, lds));
            PHASE(pb + 3, { if (blockIdx.x < 128) scan_hgrn(Pk, l, blockIdx.x, lds); else if (blockIdx.x < 256) scan_rwkv(Pk, l, blockIdx.x - 128, lds); });
            PHASE(pb + 4, phase_out_odd(Pk, l));
        } else {
            PHASE(pb + 3, { if (blockIdx.x < 128) scan_ssd(Pk, l, blockIdx.x, lds); else if (blockIdx.x < 256) scan_mlstm(Pk, l, blockIdx.x - 128, lds); });
            PHASE(pb + 4, phase_out_even(Pk, l));
        }
        PHASE(pb + 5, phase_outproj(Pk, l, lds));
        PHASE(pb + 6, phase_ln1(Pk, l, lds));
        PHASE(pb + 7, phase_moe1(Pk, l, lds));
        PHASE(pb + 8, phase_moe2(Pk, l, lds));
        PHASE(pb + 9, phase_ln2(Pk, l));
    }
#undef PHASE
}


#ifndef MK_STOP
#define MK_STOP NPHASE
#endif
#ifndef MK_DUMP
#define MK_DUMP 0
#endif
#ifndef MK_DUMP_N
#define MK_DUMP_N (1u << 30)
#endif
#ifndef MK_DUMP_LD
#define MK_DUMP_LD 1024
#endif
#ifndef MK_DUMP_C0
#define MK_DUMP_C0 0
#endif
__global__ void diff_kernel(const bf16_t* a, const bf16_t* b, float* out, size_t n) {
    for (size_t i = (size_t)blockIdx.x * blockDim.x + threadIdx.x; i < n; i += (size_t)gridDim.x * blockDim.x) out[i] = 1e6f * (bf2f(a[i]) - bf2f(b[i]));
}
__global__ void dump_kernel(const bf16_t* src, float* out, size_t n) {
    for (size_t i = (size_t)blockIdx.x * blockDim.x + threadIdx.x; i < n; i += (size_t)gridDim.x * blockDim.x) out[i] = i < (size_t)MK_DUMP_N ? bf2f(src[(i >> 10) * MK_DUMP_LD + MK_DUMP_C0 + (i & 1023)]) : 0.f;
}
extern "C" void kernel_launch(void* const* d_in, const int* in_sizes, int n_in, void* d_out, int out_size, void* d_ws, size_t ws_size, hipStream_t stream) {
    static int ready = 0;
    if (ready == 0) {
        ready = 1;
        if (n_in != 42 || out_size != NB * SEQ * D || ws_size < WS_END) { fprintf(stderr, "kernel_launch: unexpected shapes (n_in %d out %d ws %zu need %zu)\n", n_in, out_size, ws_size, (size_t)WS_END); ready = -1; }
        if (hipFuncSetAttribute((const void*)fwd_kernel, hipFuncAttributeMaxDynamicSharedMemorySize, LDS_BYTES) != hipSuccess) { fprintf(stderr, "kernel_launch: hipFuncSetAttribute failed\n"); ready = -1; }
    }
    if (ready < 0) return;
    (void)in_sizes;
    hipMemsetAsync((char*)d_ws + WS_BAR, 0, WS_ZERO_BYTES, stream);
    Params p;
    memset(&p, 0, sizeof(p));
    const float** fp = (const float**)&p;
    for (int i = 0; i < 42; ++i) fp[i] = (const float*)d_in[i];
    p.out = (float*)d_out; p.ws = (unsigned char*)d_ws;
#if MK_PER_PHASE
    for (int ph = 0; ph < MK_STOP; ++ph) {
        const int local = ph < 2 ? -1 : (ph - 2) % 10, layer = ph < 2 ? 0 : (ph - 2) / 10;
        if ((local == 1 || local == 2) && !(layer & 1)) continue;
        p.ph_lo = ph; p.ph_hi = ph + 1;
        hipLaunchKernelGGL(fwd_kernel, dim3(256), dim3(NT), LDS_BYTES, stream, p);
    }
#ifdef MK_DIFF
    p.ph_lo = 7; p.ph_hi = 8; p.dbg = 1;
    hipLaunchKernelGGL(fwd_kernel, dim3(256), dim3(NT), LDS_BYTES, stream, p);
    hipLaunchKernelGGL(diff_kernel, dim3(1024), dim3(256), 0, stream, (const bf16_t*)((unsigned char*)d_ws + WS_YO), (const bf16_t*)((unsigned char*)d_ws + WS_HID), (float*)d_out, (size_t)NB * SEQ * D);
#else
    if (MK_DUMP) hipLaunchKernelGGL(dump_kernel, dim3(1024), dim3(256), 0, stream, (const bf16_t*)((unsigned char*)d_ws + (size_t)MK_DUMP), (float*)d_out, (size_t)NB * SEQ * D);
#endif
#else
    p.ph_lo = 0; p.ph_hi = NPHASE;
    hipLaunchKernelGGL(fwd_kernel, dim3(256), dim3(NT), LDS_BYTES, stream, p);
#endif
}
```

```cpp
#include <hip/hip_runtime.h>
#include <stdint.h>
#include <stdio.h>
#include <string.h>

#ifndef MK_PER_PHASE
#define MK_PER_PHASE 0
#endif

typedef unsigned short bf16_t;
typedef short bf16x8 __attribute__((ext_vector_type(8)));
typedef float f32x4 __attribute__((ext_vector_type(4)));
typedef unsigned u32x4 __attribute__((ext_vector_type(4)));
typedef unsigned u32x2 __attribute__((ext_vector_type(2)));
#define LAS __attribute__((address_space(3)))
#define CAS __attribute__((address_space(4)))

constexpr int D = 1024, NB = 4, SEQ = 8192, CTXL = 256, DEPTH = 4;
constexpr int NCTX = NB * CTXL;
constexpr int NROWS = NCTX + NB * SEQ;
constexpr int P_EVEN = 2848, P_ODD = 4416, LDP_EVEN = 3072, LDP_ODD = 4608;
constexpr int NEXP = 32, DEXP = 512, LISTCAP = NROWS;
constexpr float ALPHA = 1.681792830507429f;
constexpr int NT = 512;
constexpr int TCH = 32;
constexpr int NSTEPS = CTXL + SEQ;
constexpr int LDS_BYTES = 136 * 1024;

constexpr size_t al256(size_t x) { return (x + 255) & ~(size_t)255; }
constexpr size_t WS_BAR = 0;
constexpr size_t WS_CNT = 16384;
constexpr int CNT_STRIDE = 64;
constexpr size_t WS_ZERO_BYTES = 16384 + (size_t)4 * 32 * CNT_STRIDE * 4;
constexpr size_t WS_MODV = al256(WS_ZERO_BYTES);
constexpr size_t WS_LB = WS_MODV + al256((size_t)4 * 5 * 6144 * 4);
constexpr size_t WS_XC = WS_LB + al256(4 * 512 * 4);
constexpr size_t WS_WTS = WS_XC + (size_t)NCTX * D * 4;
constexpr size_t WS_LIST = WS_WTS + al256((size_t)2 * NROWS * 4);
constexpr size_t WS_WINT = WS_LIST + al256((size_t)NEXP * LISTCAP * 4);
constexpr size_t WINT_L0 = 0, WINT_L1 = (size_t)LDP_EVEN * D, WINT_L2 = WINT_L1 + (size_t)LDP_ODD * D, WINT_L3 = WINT_L2 + (size_t)LDP_EVEN * D, WINT_END = WINT_L3 + (size_t)LDP_ODD * D;
constexpr size_t WS_WOUTT = WS_WINT + WINT_END * 2;
constexpr size_t WS_LORAT = WS_WOUTT + (size_t)4 * D * D * 2;
constexpr size_t LORA_PER = (size_t)512 * 320;
constexpr size_t WS_EXPGU = WS_LORAT + al256(2 * LORA_PER * 2);
constexpr size_t WS_EXPD = WS_EXPGU + (size_t)NEXP * 1024 * 1024 * 2;
constexpr size_t WS_ACT = WS_EXPD + (size_t)NEXP * 1024 * 512 * 2;
constexpr size_t ROWB = (size_t)NROWS * D * 2;
constexpr size_t WS_FEAT = WS_ACT + ROWB;
constexpr size_t WS_YF = WS_FEAT + ROWB;
constexpr size_t WS_YB = WS_YF + ROWB;
constexpr size_t WS_P = WS_YB + ROWB;
constexpr size_t P_BYTES = (size_t)NROWS * LDP_ODD * 2;
constexpr size_t WS_YO = WS_P;
constexpr size_t WS_HID = WS_P + ROWB;
constexpr size_t WS_YP = WS_HID + ROWB;
static_assert(WS_YP + 2 * ROWB <= WS_P + P_BYTES, "MoE buffers must fit in the P region");
constexpr size_t HALFB = (size_t)NROWS * 512 * 2;
constexpr size_t WS_RWR = WS_P + P_BYTES;
constexpr size_t WS_RWK = WS_RWR + HALFB;
constexpr size_t WS_RWV = WS_RWK + HALFB;
constexpr size_t WS_RWKK = WS_RWV + HALFB;
constexpr size_t WS_RWB = WS_RWKK + HALFB;
constexpr size_t WS_RWG = WS_RWB + HALFB;
constexpr size_t WS_RWDEC = WS_RWG + HALFB;
constexpr size_t WS_LA = WS_RWDEC + (size_t)2 * NROWS * 512 * 4;
constexpr size_t WS_END = WS_LA + (size_t)NROWS * 320 * 2;
static_assert(WS_END <= (size_t)280602384 * 4, "workspace map exceeds the guaranteed ws_size");

struct Params {
    const float *x, *c, *ctx, *c_ctx, *mod_w, *mod_b, *ln_g, *ln_b;
    const float *ev_w_in, *ev_w_out, *ssd_conv_w, *ssd_conv_b, *ssd_dt_bias, *ssd_a_log, *ssd_d, *ssd_norm_w;
    const float *ml_conv_w, *ml_conv_b, *ml_i_bias, *ml_f_bias, *ml_norm_w;
    const float *od_w_in, *od_w_out, *hg_lb_logits, *hg_f_bias, *hg_norm_w;
    const float *rw_mu, *rw_w0, *rw_w2, *rw_a0, *rw_a2, *rw_g2, *rw_k_k, *rw_k_a, *rw_r_k, *rw_ln_w, *rw_ln_b;
    const float *router_w, *router_bias, *exp_w_gate, *exp_w_up, *exp_w_down;
    float* out;
    unsigned char* ws;
    int ph_lo, ph_hi, dbg, pad_;
};
typedef const CAS Params* KP;

__device__ __forceinline__ int ltid() { int t = threadIdx.x; asm volatile("" : "+v"(t)); return t; }
__device__ __forceinline__ float bf2f(bf16_t h) { return __uint_as_float(((unsigned)h) << 16); }
__device__ __forceinline__ float bflo(unsigned u) { return __uint_as_float(u << 16); }
__device__ __forceinline__ float bfhi(unsigned u) { return __uint_as_float(u & 0xffff0000u); }
typedef __bf16 bf16v2_t __attribute__((ext_vector_type(2)));
typedef float f32x2 __attribute__((ext_vector_type(2)));
__device__ __forceinline__ unsigned pk2(float lo, float hi) { const f32x2 v = {lo, hi}; return __builtin_bit_cast(unsigned, __builtin_convertvector(v, bf16v2_t)); }
__device__ __forceinline__ bf16_t f2bf(float f) { return (bf16_t)(pk2(f, 0.f) & 0xffffu); }
__device__ __forceinline__ void unpack8(const u32x4& u, float* f) {
    f[0] = bflo(u.x); f[1] = bfhi(u.x); f[2] = bflo(u.y); f[3] = bfhi(u.y); f[4] = bflo(u.z); f[5] = bfhi(u.z); f[6] = bflo(u.w); f[7] = bfhi(u.w);
}
__device__ __forceinline__ u32x4 pack8(const float* f) { u32x4 u; u.x = pk2(f[0], f[1]); u.y = pk2(f[2], f[3]); u.z = pk2(f[4], f[5]); u.w = pk2(f[6], f[7]); return u; }
__device__ __forceinline__ float sigmoidf_(float x) { return 1.f / (1.f + __expf(-x)); }
__device__ __forceinline__ float siluf_(float x) { return x / (1.f + __expf(-x)); }
__device__ __forceinline__ float softplusf_(float x) { return x > 20.f ? x : log1pf(__expf(x)); }
__device__ __forceinline__ float logsigmoidf_(float x) { return fminf(x, 0.f) - log1pf(__expf(-fabsf(x))); }
__device__ __forceinline__ float wave_sum(float v) {
#pragma unroll
    for (int o = 1; o < 64; o <<= 1) v += __shfl_xor(v, o);
    return v;
}
template <int W> __device__ __forceinline__ float group_sum(float v) {
#pragma unroll
    for (int o = 1; o < W; o <<= 1) v += __shfl_xor(v, o);
    return v;
}
template <int CTRL> __device__ __forceinline__ float dppmov(float v) {
    return __builtin_bit_cast(float, __builtin_amdgcn_update_dpp(0, __builtin_bit_cast(int, v), CTRL, 0xf, 0xf, true));
}
__device__ __forceinline__ float allreduce16(float v) {
    v += dppmov<0xB1>(v);
    v += dppmov<0x4E>(v);
    v += dppmov<0x141>(v);
    v += dppmov<0x140>(v);
    return v;
}

#define XB_TMO      128
#define XB_XCNT(j)  (256  + 64 * (j))
#define XB_XSUB(j)  (1280 + 64 * (j))
#define XB_XGEN(j)  (2304 + 64 * (j))
#define XB_TOP      3328
#define XB_TOPGEN   3392
#define XCD_BAR_WORDS 3456
#define XB_SPIN_CAP (1u << 22)
__device__ __forceinline__ unsigned xb_ld(unsigned* p)              { return __hip_atomic_load(p, __ATOMIC_RELAXED, __HIP_MEMORY_SCOPE_AGENT); }
__device__ __forceinline__ unsigned xb_add(unsigned* p, unsigned v) { return __hip_atomic_fetch_add(p, v, __ATOMIC_RELAXED, __HIP_MEMORY_SCOPE_AGENT); }
__device__ __forceinline__ unsigned xb_xcc_id() { return (unsigned)__builtin_amdgcn_s_getreg((3 << 11) | 20) & 0xFu; }
#define XB_SPIN(cond, bar) do { unsigned _sp = 0; while (cond) { __builtin_amdgcn_s_sleep(1); \
    if ((++_sp & 255u) == 0u) { if (xb_ld(&(bar)[XB_TMO])) break; if (_sp > XB_SPIN_CAP) { atomicAdd(&(bar)[XB_TMO], 1u); break; } } } } while (0)
struct XcdBarrier { unsigned* bar; unsigned x; volatile LAS unsigned* st; };
__device__ __forceinline__ XcdBarrier xcd_barrier_post(unsigned* bar, volatile LAS unsigned* st) {
    XcdBarrier b; b.bar = bar; b.x = xb_xcc_id(); b.st = st;
    if (threadIdx.x == 0) (void)xb_add(&bar[XB_XCNT(b.x)], 1u);
    return b;
}
__device__ __forceinline__ void xcd_barrier_complete(unsigned* bar, unsigned x, unsigned& nloc, unsigned& nx) {
    const unsigned G = gridDim.x * gridDim.y * gridDim.z;
    unsigned sum, cnt, mine, sp = 0u;
    for (;;) {
        sum = 0u; cnt = 0u; mine = 0u;
#pragma unroll
        for (unsigned j = 0; j < 16; ++j) { const unsigned c = xb_ld(&bar[XB_XCNT(j)]); sum += c; cnt += (c > 0u) ? 1u : 0u; mine = (j == x) ? c : mine; }
        if (sum == G) break;
        __builtin_amdgcn_s_sleep(1);
        if ((++sp & 255u) == 0u) { if (xb_ld(&bar[XB_TMO])) break; if (sp > XB_SPIN_CAP) { atomicAdd(&bar[XB_TMO], 1u); break; } }
    }
    nloc = mine > 0u ? mine : 1u; nx = cnt > 0u ? cnt : 1u;
}
__device__ __forceinline__ void xcd_barrier(const XcdBarrier& b) {
    asm volatile("s_waitcnt vmcnt(0)" ::: "memory");
    __syncthreads();
    if (threadIdx.x == 0) {
        unsigned* bar = b.bar;
        __builtin_amdgcn_s_waitcnt(0);
        unsigned nloc = b.st[0], nx = b.st[1];
        if (nloc == 0u) { xcd_barrier_complete(bar, b.x, nloc, nx); b.st[0] = nloc; b.st[1] = nx; }
        const unsigned old = xb_add(&bar[XB_XSUB(b.x)], 1u);
        const unsigned gen = old / nloc;
        if (old + 1u == (gen + 1u) * nloc) {
            __builtin_amdgcn_fence(__ATOMIC_RELEASE, "agent");
            asm volatile("s_waitcnt vmcnt(0)" ::: "memory");
            const unsigned og = xb_add(&bar[XB_TOP], 1u);
            const unsigned tg = og / nx;
            if (og + 1u == (tg + 1u) * nx) xb_add(&bar[XB_TOPGEN], 1u);
            else XB_SPIN(xb_ld(&bar[XB_TOPGEN]) == tg, bar);
            __builtin_amdgcn_fence(__ATOMIC_ACQUIRE, "agent");
            xb_add(&bar[XB_XGEN(b.x)], 1u);
            asm volatile("s_waitcnt vmcnt(0)" ::: "memory");
        } else {
            XB_SPIN(xb_ld(&bar[XB_XGEN(b.x)]) == gen, bar);
            __builtin_amdgcn_fence(__ATOMIC_ACQUIRE, "agent");
            asm volatile("s_waitcnt vmcnt(0)" ::: "memory");
        }
    }
    __syncthreads();
}

__device__ __forceinline__ int row_mod(int r) { return r < NCTX ? 4 : ((r - NCTX) >> 13); }
__device__ __forceinline__ void row_seg(int r, int& t, int& len) { if (r < NCTX) { t = r & 255; len = CTXL; } else { t = (r - NCTX) & 8191; len = SEQ; } }
__device__ __forceinline__ int scan_row(int tg, int b, int dir, int odd) {
    if (tg < CTXL) { const int t = dir ? (CTXL - 1 - tg) : tg; return b * CTXL + t; }
    int sg = tg - CTXL; if (dir) sg = SEQ - 1 - sg;
    const int s = odd ? (((sg & 127) << 6) + (sg >> 7)) : sg;
    return NCTX + b * SEQ + s;
}
__device__ __forceinline__ const float* modvec(const unsigned char* ws, int layer, int m, int which) {
    return (const float*)(ws + WS_MODV) + ((size_t)(layer * 5 + m) * 6 + which) * D;
}

constexpr int G_BM = 256, G_BN = 128, G_BK = 64;
constexpr int G_ABYTES = G_BM * G_BK * 2, G_BBYTES = G_BN * G_BK * 2, G_BUF = G_ABYTES + G_BBYTES;
__device__ __forceinline__ int swz(int o) { return o ^ (((o >> 9) & 1) << 5); }

template <class RowSrc, class Epi>
__device__ __forceinline__ void gemm_tile(const bf16_t* __restrict__ A, int lda, const RowSrc& rs, const bf16_t* __restrict__ Bt, int ldb, int n0, int K, const Epi& epi, LAS char* lds) {
    const int tid = ltid(), lane = tid & 63, wid = tid >> 6, wm = wid >> 1, wn = wid & 1;
    const bf16_t* ap[4]; int aoff[4];
#pragma unroll
    for (int i = 0; i < 4; ++i) {
        const int c = tid + NT * i, row = c >> 3, kc = c & 7;
        ap[i] = A + (size_t)rs.src(row) * lda + kc * 8;
        aoff[i] = ((row >> 4) * 2 + (kc >> 2)) * 1024 + swz((row & 15) * 64 + (kc & 3) * 16);
    }
    const bf16_t* bp[2]; int boff[2];
#pragma unroll
    for (int i = 0; i < 2; ++i) {
        const int c = tid + NT * i, row = c >> 3, kc = c & 7;
        bp[i] = Bt + (size_t)(n0 + row) * ldb + kc * 8;
        boff[i] = G_ABYTES + ((row >> 4) * 2 + (kc >> 2)) * 1024 + swz((row & 15) * 64 + (kc & 3) * 16);
    }
    f32x4 acc[4][4];
#pragma unroll
    for (int i = 0; i < 4; ++i)
#pragma unroll
        for (int j = 0; j < 4; ++j) acc[i][j] = (f32x4){0.f, 0.f, 0.f, 0.f};
    u32x4 ra[2][4], rb[2][2];
    const int KT = K / G_BK;
    const int fragoff = swz((lane & 15) * 64 + (lane >> 4) * 16);
#define G_LOAD(set, kt_) do { _Pragma("unroll") for (int i = 0; i < 4; ++i) ra[set][i] = *(const u32x4*)(ap[i] + (kt_) * G_BK); \
                              _Pragma("unroll") for (int i = 0; i < 2; ++i) rb[set][i] = *(const u32x4*)(bp[i] + (kt_) * G_BK); } while (0)
#define G_STORE(set, buf) do { _Pragma("unroll") for (int i = 0; i < 4; ++i) *(LAS u32x4*)((buf) + aoff[i]) = ra[set][i]; \
                               _Pragma("unroll") for (int i = 0; i < 2; ++i) *(LAS u32x4*)((buf) + boff[i]) = rb[set][i]; } while (0)
#define G_COMPUTE(cur) do { bf16x8 af[2][4], bfr[2][4]; \
        _Pragma("unroll") for (int ks = 0; ks < 2; ++ks) { \
            _Pragma("unroll") for (int ni = 0; ni < 4; ++ni) bfr[ks][ni] = *(LAS bf16x8*)((cur) + G_ABYTES + ((wn * 4 + ni) * 2 + ks) * 1024 + fragoff); \
            _Pragma("unroll") for (int mi = 0; mi < 4; ++mi) af[ks][mi] = *(LAS bf16x8*)((cur) + ((wm * 4 + mi) * 2 + ks) * 1024 + fragoff); } \
        __builtin_amdgcn_sched_barrier(0); \
        _Pragma("unroll") for (int ks = 0; ks < 2; ++ks) _Pragma("unroll") for (int mi = 0; mi < 4; ++mi) _Pragma("unroll") for (int ni = 0; ni < 4; ++ni) \
            acc[mi][ni] = __builtin_amdgcn_mfma_f32_16x16x32_bf16(bfr[ks][ni], af[ks][mi], acc[mi][ni], 0, 0, 0); \
        __builtin_amdgcn_sched_barrier(0); } while (0)
    G_LOAD(0, 0);
    G_STORE(0, lds);
    if (KT > 1) G_LOAD(0, 1);
    if (KT > 2) G_LOAD(1, 2);
    __syncthreads();
    for (int kt = 0; kt < KT; kt += 2) {
        G_COMPUTE(lds);
        if (kt + 1 < KT) G_STORE(0, lds + G_BUF);
        if (kt + 3 < KT) G_LOAD(0, kt + 3);
        __syncthreads();
        if (kt + 1 < KT) {
            G_COMPUTE(lds + G_BUF);
            if (kt + 2 < KT) G_STORE(1, lds);
            if (kt + 4 < KT) G_LOAD(1, kt + 4);
            __syncthreads();
        }
    }
#undef G_LOAD
#undef G_STORE
#undef G_COMPUTE
    epi(acc, wm * 64 + (lane & 15), wn * 64 + 4 * (lane >> 4));
}

constexpr int G2_BN = 256, G2_BBYTES = G2_BN * G_BK * 2, G2_BUF = G_ABYTES + G2_BBYTES;
template <class RowSrc, class Epi>
__device__ __forceinline__ void gemm_tile256(const bf16_t* __restrict__ A, int lda, const RowSrc& rs, const bf16_t* __restrict__ Bt, int ldb, int n0, int K, const Epi& epi, LAS char* lds) {
    const int tid = ltid(), lane = tid & 63, wid = tid >> 6, wm = wid >> 1, wn = wid & 1;
    const int r0 = tid >> 3, kc = tid & 7;
    const int aoff0 = ((r0 >> 4) * 2 + (kc >> 2)) * 1024 + swz((r0 & 15) * 64 + (kc & 3) * 16);
    int aeo[4];
#pragma unroll
    for (int i = 0; i < 4; ++i) aeo[i] = rs.src(r0 + 64 * i) * lda + kc * 8;
    const bf16_t* bp0 = Bt + (size_t)(n0 + r0) * ldb + kc * 8;
    const int bstep = 64 * ldb;
    f32x4 acc[4][8];
#pragma unroll
    for (int i = 0; i < 4; ++i)
#pragma unroll
        for (int j = 0; j < 8; ++j) acc[i][j] = (f32x4){0.f, 0.f, 0.f, 0.f};
    u32x4 ra[4], rb[4];
#pragma unroll
    for (int i = 0; i < 4; ++i) { ra[i] = *(const u32x4*)(A + aeo[i]); rb[i] = *(const u32x4*)(bp0 + i * bstep); }
#pragma unroll
    for (int i = 0; i < 4; ++i) { *(LAS u32x4*)(lds + aoff0 + i * 8192) = ra[i]; *(LAS u32x4*)(lds + G_ABYTES + aoff0 + i * 8192) = rb[i]; }
    __syncthreads();
    const int KT = K / G_BK;
    const int fragoff = swz((lane & 15) * 64 + (lane >> 4) * 16);
    for (int kt = 0; kt < KT; ++kt) {
        LAS char* cur = lds + (kt & 1) * G2_BUF;
        LAS char* nxt = lds + ((kt + 1) & 1) * G2_BUF;
        const bool more = (kt + 1 < KT);
        if (more) {
#pragma unroll
            for (int i = 0; i < 4; ++i) { ra[i] = *(const u32x4*)(A + aeo[i] + (kt + 1) * G_BK); rb[i] = *(const u32x4*)(bp0 + i * bstep + (kt + 1) * G_BK); }
        }
#pragma unroll
        for (int ks = 0; ks < 2; ++ks) {
            bf16x8 af[4];
#pragma unroll
            for (int mi = 0; mi < 4; ++mi) af[mi] = *(LAS bf16x8*)(cur + ((wm * 4 + mi) * 2 + ks) * 1024 + fragoff);
#pragma unroll
            for (int nh = 0; nh < 2; ++nh) {
                bf16x8 bfr[4];
#pragma unroll
                for (int ni = 0; ni < 4; ++ni) bfr[ni] = *(LAS bf16x8*)(cur + G_ABYTES + ((wn * 8 + nh * 4 + ni) * 2 + ks) * 1024 + fragoff);
                __builtin_amdgcn_sched_barrier(0);
#pragma unroll
                for (int mi = 0; mi < 4; ++mi)
#pragma unroll
                    for (int ni = 0; ni < 4; ++ni) acc[mi][nh * 4 + ni] = __builtin_amdgcn_mfma_f32_16x16x32_bf16(bfr[ni], af[mi], acc[mi][nh * 4 + ni], 0, 0, 0);
                __builtin_amdgcn_sched_barrier(0);
            }
        }
        if (more) {
#pragma unroll
            for (int i = 0; i < 4; ++i) { *(LAS u32x4*)(nxt + aoff0 + i * 8192) = ra[i]; *(LAS u32x4*)(nxt + G_ABYTES + aoff0 + i * 8192) = rb[i]; }
        }
        __syncthreads();
    }
    epi(acc, wm * 64 + (lane & 15), wn * 128 + 4 * (lane >> 4));
}

struct RowLinear { int m0; __device__ __forceinline__ int src(int r) const { return m0 + r; } };
struct RowList {
    const int* list; int cnt; int shift;
    __device__ __forceinline__ int src(int r) const { const int a = list[r < cnt ? r : 0]; return a >> shift; }
};
struct EpiStoreBf16 {
    bf16_t* C; int ldc; int m0; int n0; int N;
    template <int NI> __device__ __forceinline__ void operator()(const f32x4 (&acc)[4][NI], int rbase, int cbase) const {
#pragma unroll
        for (int mi = 0; mi < 4; ++mi) {
            bf16_t* rowp = C + (size_t)(m0 + rbase + mi * 16) * ldc + n0 + cbase;
#pragma unroll
            for (int ni = 0; ni < NI; ++ni) {
                if (n0 + cbase + ni * 16 < N) { u32x2 v; v.x = pk2(acc[mi][ni][0], acc[mi][ni][1]); v.y = pk2(acc[mi][ni][2], acc[mi][ni][3]); *(u32x2*)(rowp + ni * 16) = v; }
            }
        }
    }
};
struct EpiSwiGLU {
    bf16_t* H; const int* list; int cnt; int n0;
    template <int NI> __device__ __forceinline__ void operator()(const f32x4 (&acc)[4][NI], int rbase, int cbase) const {
#pragma unroll
        for (int mi = 0; mi < 4; ++mi) {
            const int r = rbase + mi * 16;
            if (r < cnt) {
                const int a = list[r];
                const int wnb = cbase & ~63, q4 = cbase & 63;
                bf16_t* rowp = H + (size_t)a * DEXP + ((n0 + wnb) >> 1) + q4;
#pragma unroll
                for (int q = 0; q < NI / 2; ++q) {
                    float o[4];
#pragma unroll
                    for (int j = 0; j < 4; ++j) o[j] = siluf_(acc[mi][2 * q][j]) * acc[mi][2 * q + 1][j];
                    u32x2 v; v.x = pk2(o[0], o[1]); v.y = pk2(o[2], o[3]); *(u32x2*)(rowp + q * 16) = v;
                }
            }
        }
    }
};
struct EpiScatterBf16 {
    bf16_t* C; const int* list; int cnt; int n0;
    template <int NI> __device__ __forceinline__ void operator()(const f32x4 (&acc)[4][NI], int rbase, int cbase) const {
#pragma unroll
        for (int mi = 0; mi < 4; ++mi) {
            const int r = rbase + mi * 16;
            if (r < cnt) {
                bf16_t* rowp = C + (size_t)list[r] * D + n0 + cbase;
#pragma unroll
                for (int ni = 0; ni < NI; ++ni) { u32x2 v; v.x = pk2(acc[mi][ni][0], acc[mi][ni][1]); v.y = pk2(acc[mi][ni][2], acc[mi][ni][3]); *(u32x2*)(rowp + ni * 16) = v; }
            }
        }
    }
};
struct EpiDecay {
    float* Dc; const float* w0; int m0; int n0;
    template <int NI> __device__ __forceinline__ void operator()(const f32x4 (&acc)[4][NI], int rbase, int cbase) const {
#pragma unroll
        for (int ni = 0; ni < NI; ++ni) {
            const int col = n0 + cbase + ni * 16;
            const f32x4 w0v = *(const f32x4*)(w0 + col);
#pragma unroll
            for (int mi = 0; mi < 4; ++mi) {
                f32x4 o;
#pragma unroll
                for (int j = 0; j < 4; ++j) { const float w = w0v[j] + acc[mi][ni][j]; o[j] = __expf(-__expf(-softplusf_(-w) - 0.5f)); }
                *(f32x4*)(Dc + (size_t)(m0 + rbase + mi * 16) * 512 + col) = o;
            }
        }
    }
};
struct EpiAK {
    bf16_t* Kb; const bf16_t* KKb; bf16_t* Bb; const float* a0; const float* k_a; int m0; int n0;
    template <int NI> __device__ __forceinline__ void operator()(const f32x4 (&acc)[4][NI], int rbase, int cbase) const {
#pragma unroll
        for (int ni = 0; ni < NI; ++ni) {
            const int col = n0 + cbase + ni * 16;
            const f32x4 a0v = *(const f32x4*)(a0 + col), kav = *(const f32x4*)(k_a + col);
#pragma unroll
            for (int mi = 0; mi < 4; ++mi) {
                const size_t off = (size_t)(m0 + rbase + mi * 16) * 512 + col;
                const u32x2 kr = *(const u32x2*)(Kb + off), kkr = *(const u32x2*)(KKb + off);
                const float kf[4] = {bflo(kr.x), bfhi(kr.x), bflo(kr.y), bfhi(kr.y)}, kkf[4] = {bflo(kkr.x), bfhi(kkr.x), bflo(kkr.y), bfhi(kkr.y)};
                float k2[4], bb[4];
#pragma unroll
                for (int j = 0; j < 4; ++j) { const float a = sigmoidf_(a0v[j] + acc[mi][ni][j]); k2[j] = kf[j] * (1.f + (a - 1.f) * kav[j]); bb[j] = kkf[j] * a; }
                u32x2 v; v.x = pk2(k2[0], k2[1]); v.y = pk2(k2[2], k2[3]); *(u32x2*)(Kb + off) = v;
                v.x = pk2(bb[0], bb[1]); v.y = pk2(bb[2], bb[3]); *(u32x2*)(Bb + off) = v;
            }
        }
    }
};

__device__ __forceinline__ void transpose_item(const float* __restrict__ W, int K, int N, bf16_t* __restrict__ WT, int mode, LAS float* scr, int item, int lane) {
    const int nblk = N / 32, kb = item / nblk, nb = item % nblk, k0 = 64 * kb, n0 = 32 * nb;
#pragma unroll 8
    for (int i = 0; i < 32; ++i) { const int kk = 2 * i + (lane >> 5); scr[kk * 33 + (lane & 31)] = W[(size_t)(k0 + kk) * N + n0 + (lane & 31)]; }
    asm volatile("s_waitcnt lgkmcnt(0)" ::: "memory");
    const int c = lane & 7;
#pragma unroll
    for (int j = 0; j < 4; ++j) {
        const int nl = (lane >> 3) + 8 * j; const LAS float* s = scr + (8 * c) * 33 + nl;
        u32x4 o; o.x = pk2(s[0 * 33], s[1 * 33]); o.y = pk2(s[2 * 33], s[3 * 33]); o.z = pk2(s[4 * 33], s[5 * 33]); o.w = pk2(s[6 * 33], s[7 * 33]);
        const int n = n0 + nl;
        const int nd = mode == 0 ? n : (32 * (n >> 4) + (n & 15) + (mode == 2 ? 16 : 0));
        *(u32x4*)(WT + (size_t)nd * K + k0 + 8 * c) = o;
    }
    asm volatile("s_waitcnt lgkmcnt(0)" ::: "memory");
}

__device__ __forceinline__ void phase_prologue0(KP Pk, LAS char* lds) {
    asm volatile("" : "+s"(Pk));
    const CAS Params& P = *Pk;
    const int tid = ltid(), lane = tid & 63, wid = tid >> 6;
    const int gw = blockIdx.x * 8 + wid, NGW = gridDim.x * 8;
    LAS float* scr = (LAS float*)(lds + wid * 8448);
    bf16_t* winT = (bf16_t*)(P.ws + WS_WINT);
    bf16_t* woutT = (bf16_t*)(P.ws + WS_WOUTT);
    bf16_t* loraT = (bf16_t*)(P.ws + WS_LORAT);
    constexpr int I_EV = 16 * (P_EVEN / 32), I_OD = 16 * (P_ODD / 32), I_O = 16 * 32, I_L64 = 16, I_L128 = 32;
    constexpr int I_LORA = 3 * I_L64 + I_L128;
    constexpr int NIT = 2 * I_EV + 2 * I_OD + 4 * I_O + 2 * I_LORA;
    for (int it = gw; it < NIT; it += NGW) {
        int r = it;
        if (r < 2 * I_EV) { const int i = r / I_EV; transpose_item(P.ev_w_in + (size_t)i * D * P_EVEN, D, P_EVEN, winT + (i ? WINT_L2 : WINT_L0), 0, scr, r % I_EV, lane); continue; } r -= 2 * I_EV;
        if (r < 2 * I_OD) { const int i = r / I_OD; transpose_item(P.od_w_in + (size_t)i * D * P_ODD, D, P_ODD, winT + (i ? WINT_L3 : WINT_L1), 0, scr, r % I_OD, lane); continue; } r -= 2 * I_OD;
        if (r < 4 * I_O) { const int l = r / I_O; const float* src = (l & 1) ? P.od_w_out + (size_t)(l >> 1) * D * D : P.ev_w_out + (size_t)(l >> 1) * D * D;
            transpose_item(src, D, D, woutT + (size_t)l * D * D, 0, scr, r % I_O, lane); continue; } r -= 4 * I_O;
        { const int i = r / I_LORA; int q = r % I_LORA; bf16_t* dst = loraT + (size_t)i * LORA_PER;
          if (q < I_L64) { transpose_item(P.rw_w2 + (size_t)(i * 2 + 0) * 64 * 512, 64, 512, dst, 0, scr, q, lane); continue; } q -= I_L64;
          if (q < I_L64) { transpose_item(P.rw_w2 + (size_t)(i * 2 + 1) * 64 * 512, 64, 512, dst + 512 * 64, 0, scr, q, lane); continue; } q -= I_L64;
          if (q < I_L64) { transpose_item(P.rw_a2 + (size_t)i * 64 * 512, 64, 512, dst + 2 * 512 * 64, 0, scr, q, lane); continue; } q -= I_L64;
          transpose_item(P.rw_g2 + (size_t)i * 128 * 512, 128, 512, dst + 3 * 512 * 64, 0, scr, q, lane); }
    }
    {
        const int gt = blockIdx.x * NT + tid, NG = gridDim.x * NT;
        constexpr int PADE = (LDP_EVEN - P_EVEN) * D / 8, PADO = (LDP_ODD - P_ODD) * D / 8;
        for (int i = gt; i < 2 * PADE + 2 * PADO; i += NG) {
            int r = i; bf16_t* dst;
            if (r < 2 * PADE) { const int l = r / PADE; dst = winT + (l ? WINT_L2 : WINT_L0) + (size_t)P_EVEN * D + (size_t)(r % PADE) * 8; }
            else { r -= 2 * PADE; const int l = r / PADO; dst = winT + (l ? WINT_L3 : WINT_L1) + (size_t)P_ODD * D + (size_t)(r % PADO) * 8; }
            *(u32x4*)dst = (u32x4){0u, 0u, 0u, 0u};
        }
    }
    {
        const int gt = blockIdx.x * NT + tid, NG = gridDim.x * NT;
        float* xc = (float*)(P.ws + WS_XC);
        for (int i = gt; i < NCTX * D / 4; i += NG) ((f32x4*)xc)[i] = ((const f32x4*)P.ctx)[i];
        float* lb = (float*)(P.ws + WS_LB);
        for (int ch = gt; ch < 512; ch += NG) {
            float lg[4], mx = -1e30f;
#pragma unroll
            for (int l = 0; l < 4; ++l) { lg[l] = P.hg_lb_logits[l * 512 + ch]; mx = fmaxf(mx, lg[l]); }
            float e[4], s = 0.f;
#pragma unroll
            for (int l = 0; l < 4; ++l) { e[l] = expf(lg[l] - mx); s += e[l]; }
            float cum = 0.f;
#pragma unroll
            for (int l = 0; l < 4; ++l) { if (l > 0) cum += e[l] / s; lb[l * 512 + ch] = cum; }
        }
    }
    __syncthreads();
    {
        LAS float* sc = (LAS float*)lds;
        LAS float* red = (LAS float*)(lds + 5 * 1024 * 4);
        for (int i = tid; i < 5 * D; i += NT) { const int m = i >> 10, k = i & 1023; const float v = m < 4 ? P.c[m * D + k] : P.c_ctx[k]; sc[i] = siluf_(v); }
        __syncthreads();
        float* modv = (float*)(P.ws + WS_MODV);
        const int col = tid & 127, kq = tid >> 7;
        for (int item = blockIdx.x; item < 4 * 48; item += gridDim.x) {
            const int l = item / 48, j = (item % 48) * 128 + col;
            const float* w = P.mod_w + (size_t)l * D * 6144 + j;
            float a[5] = {0.f, 0.f, 0.f, 0.f, 0.f};
#pragma unroll 8
            for (int k = kq * 256; k < kq * 256 + 256; ++k) {
                const float wv = w[(size_t)k * 6144];
#pragma unroll
                for (int m = 0; m < 5; ++m) a[m] += sc[m * 1024 + k] * wv;
            }
#pragma unroll
            for (int m = 0; m < 5; ++m) red[(kq * 128 + col) * 5 + m] = a[m];
            __syncthreads();
            if (kq == 0) {
                const float bias = P.mod_b[l * 6144 + j];
#pragma unroll
                for (int m = 0; m < 5; ++m) {
                    const float s = red[(0 * 128 + col) * 5 + m] + red[(1 * 128 + col) * 5 + m] + red[(2 * 128 + col) * 5 + m] + red[(3 * 128 + col) * 5 + m];
                    modv[(size_t)(l * 5 + m) * 6144 + j] = s + bias;
                }
            }
            __syncthreads();
        }
    }
}

__device__ __forceinline__ void phase_prologue1(KP Pk) {
    asm volatile("" : "+s"(Pk));
    const CAS Params& P = *Pk;
    const int tid = ltid(), lane = tid & 63, wid = tid >> 6;
    bf16_t* act = (bf16_t*)(P.ws + WS_ACT);
    for (int r = blockIdx.x * 8 + wid; r < NROWS; r += gridDim.x * 8) {
        const int m = row_mod(r);
        const float* src = r < NCTX ? P.ctx + (size_t)r * D : P.x + (size_t)(r - NCTX) * D;
        const float* sh = modvec(P.ws, 0, m, 0); const float* sc = modvec(P.ws, 0, m, 1);
#pragma unroll
        for (int i = 0; i < 4; ++i) {
            const int c = 4 * lane + 256 * i;
            const f32x4 v = *(const f32x4*)(src + c), s1 = *(const f32x4*)(sc + c), h1 = *(const f32x4*)(sh + c);
            if (r >= NCTX) *(f32x4*)(P.out + (size_t)(r - NCTX) * D + c) = v;
            u32x2 o; o.x = pk2(v[0] * (1.f + s1[0]) + h1[0], v[1] * (1.f + s1[1]) + h1[1]); o.y = pk2(v[2] * (1.f + s1[2]) + h1[2], v[3] * (1.f + s1[3]) + h1[3]);
            *(u32x2*)(act + (size_t)r * D + c) = o;
        }
    }
}

__device__ __forceinline__ void phase_inproj(KP Pk, int layer, LAS char* lds) {
    asm volatile("" : "+s"(Pk));
    const CAS Params& P = *Pk;
    const int odd = layer & 1, ldp = odd ? LDP_ODD : LDP_EVEN, N = odd ? P_ODD : P_EVEN, NTL = ldp / G2_BN;
    const bf16_t* act = (const bf16_t*)(P.ws + WS_ACT);
    const size_t woff = layer == 0 ? WINT_L0 : layer == 1 ? WINT_L1 : layer == 2 ? WINT_L2 : WINT_L3;
    const bf16_t* Bt = (const bf16_t*)(P.ws + WS_WINT) + woff;
    bf16_t* Pb = (bf16_t*)(P.ws + WS_P);
    constexpr int NP = NROWS / G_BM, PG = 4;
    const int xcd = blockIdx.x & 7, jb = blockIdx.x >> 3, nb = (gridDim.x + 7 - xcd) >> 3;
    const int npx = NP / 8 + (xcd < NP % 8 ? 1 : 0), p0 = xcd * (NP / 8) + (xcd < NP % 8 ? xcd : NP % 8);
    for (int u = jb; u < npx * NTL; u += nb) {
        const int g = u / (PG * NTL), gc = (npx - g * PG) < PG ? (npx - g * PG) : PG, w = u - g * PG * NTL;
        const int nt = w / gc, mt = p0 + g * PG + w % gc;
        RowLinear rs{mt * G_BM};
        EpiStoreBf16 epi{Pb, ldp, mt * G_BM, nt * G2_BN, N};
        gemm_tile256(act, D, rs, Bt, D, nt * G2_BN, D, epi, lds);
    }
}
__device__ __forceinline__ void phase_outproj(KP Pk, int layer, LAS char* lds) {
    asm volatile("" : "+s"(Pk));
    const CAS Params& P = *Pk;
    const bf16_t* feat = (const bf16_t*)(P.ws + WS_FEAT);
    const bf16_t* Bt = (const bf16_t*)(P.ws + WS_WOUTT) + (size_t)layer * D * D;
    bf16_t* yo = (bf16_t*)(P.ws + (P.dbg ? WS_HID : WS_YO));
    const int mt0 = (layer == DEPTH - 1) ? NCTX / G_BM : 0;
    const int ntiles = (NROWS / G_BM - mt0) * (D / G_BN);
    for (int t = blockIdx.x; t < ntiles; t += gridDim.x) {
        const int mt = mt0 + t / (D / G_BN), nt = t % (D / G_BN);
        RowLinear rs{mt * G_BM};
        EpiStoreBf16 epi{yo, D, mt * G_BM, nt * G_BN, D};
        gemm_tile(feat, D, rs, Bt, D, nt * G_BN, D, epi, lds);
    }
}
__device__ __forceinline__ void phase_prep2(KP Pk, int layer, LAS char* lds) {
    asm volatile("" : "+s"(Pk));
    const CAS Params& P = *Pk;
    const int i = layer >> 1;
    const bf16_t* la = (const bf16_t*)(P.ws + WS_LA);
    const bf16_t* lt = (const bf16_t*)(P.ws + WS_LORAT) + (size_t)i * LORA_PER;
    constexpr int MT = NROWS / G_BM, NTL = 512 / G_BN;
    const int ntiles = 4 * MT * NTL;
    for (int t = blockIdx.x; t < ntiles; t += gridDim.x) {
        const int which = t / (MT * NTL), r = t % (MT * NTL), mt = r / NTL, nt = r % NTL;
        RowLinear rs{mt * G_BM};
        if (which < 2) {
            EpiDecay epi{(float*)(P.ws + WS_RWDEC) + (size_t)which * NROWS * 512, P.rw_w0 + (size_t)(i * 2 + which) * 512, mt * G_BM, nt * G_BN};
            gemm_tile(la + which * 64, 320, rs, lt + (size_t)which * 512 * 64, 64, nt * G_BN, 64, epi, lds);
        } else if (which == 2) {
            EpiAK epi{(bf16_t*)(P.ws + WS_RWK), (const bf16_t*)(P.ws + WS_RWKK), (bf16_t*)(P.ws + WS_RWB), P.rw_a0 + i * 512, P.rw_k_a + i * 512, mt * G_BM, nt * G_BN};
            gemm_tile(la + 128, 320, rs, lt + (size_t)2 * 512 * 64, 64, nt * G_BN, 64, epi, lds);
        } else {
            EpiStoreBf16 epi{(bf16_t*)(P.ws + WS_RWG), 512, mt * G_BM, nt * G_BN, 512};
            gemm_tile(la + 192, 320, rs, lt + (size_t)3 * 512 * 64, 128, nt * G_BN, 128, epi, lds);
        }
    }
}
__device__ __forceinline__ void moe_tiles(const unsigned char* ws, int layer, LAS int* tstart, LAS int* tcnt) {
    if (threadIdx.x == 0) {
        const int* cnt = (const int*)(ws + WS_CNT) + layer * 32 * CNT_STRIDE;
        int acc = 0;
        for (int e = 0; e < NEXP; ++e) { const int c = cnt[e * CNT_STRIDE]; tcnt[e] = c; tstart[e] = acc; acc += (c + G_BM - 1) / G_BM; }
        tstart[NEXP] = acc;
    }
    __syncthreads();
}
__device__ __forceinline__ void phase_moe1(KP Pk, int layer, LAS char* lds) {
    asm volatile("" : "+s"(Pk));
    const CAS Params& P = *Pk;
    LAS int* tstart = (LAS int*)(lds + 2 * G2_BUF); LAS int* tcnt = tstart + 40;
    moe_tiles(P.ws, layer, tstart, tcnt);
    const bf16_t* act = (const bf16_t*)(P.ws + WS_ACT);
    const bf16_t* gu = (const bf16_t*)(P.ws + WS_EXPGU);
    bf16_t* hid = (bf16_t*)(P.ws + WS_HID);
    const int* list = (const int*)(P.ws + WS_LIST);
    const int ntiles = tstart[NEXP] * 4;
    for (int t = blockIdx.x; t < ntiles; t += gridDim.x) {
        const int tm = t >> 2, nt = t & 3;
        int e = 0;
#pragma unroll 1
        while (tstart[e + 1] <= tm) ++e;
        const int mt = tm - tstart[e], cnt = tcnt[e] - mt * G_BM;
        const int* lp = list + (size_t)e * LISTCAP + mt * G_BM;
        RowList rs{lp, cnt, 1};
        EpiSwiGLU epi{hid, lp, cnt, nt * G2_BN};
        gemm_tile256(act, D, rs, gu + (size_t)e * 1024 * 1024, D, nt * G2_BN, D, epi, lds);
    }
}
__device__ __forceinline__ void phase_moe2(KP Pk, int layer, LAS char* lds) {
    asm volatile("" : "+s"(Pk));
    const CAS Params& P = *Pk;
    LAS int* tstart = (LAS int*)(lds + 2 * G2_BUF); LAS int* tcnt = tstart + 40;
    moe_tiles(P.ws, layer, tstart, tcnt);
    const bf16_t* hid = (const bf16_t*)(P.ws + WS_HID);
    const bf16_t* dw = (const bf16_t*)(P.ws + WS_EXPD);
    bf16_t* yp = (bf16_t*)(P.ws + WS_YP);
    const int* list = (const int*)(P.ws + WS_LIST);
    const int ntiles = tstart[NEXP] * 4;
    for (int t = blockIdx.x; t < ntiles; t += gridDim.x) {
        const int tm = t >> 2, nt = t & 3;
        int e = 0;
#pragma unroll 1
        while (tstart[e + 1] <= tm) ++e;
        const int mt = tm - tstart[e], cnt = tcnt[e] - mt * G_BM;
        const int* lp = list + (size_t)e * LISTCAP + mt * G_BM;
        RowList rs{lp, cnt, 0};
        EpiScatterBf16 epi{yp, lp, cnt, nt * G2_BN};
        gemm_tile256(hid, DEXP, rs, dw + (size_t)e * 1024 * 512, DEXP, nt * G2_BN, DEXP, epi, lds);
    }
}

constexpr int NCHUNK = NSTEPS / TCH;

constexpr int SSD_F = 32 + 64 + 64;
constexpr int SSD_BUF = TCH * SSD_F + 3 * TCH;
__device__ __forceinline__ void scan_ssd(KP Pk, int layer, int unit, LAS char* lds) {
    asm volatile("" : "+s"(Pk));
    const CAS Params& P = *Pk;
    const int tid = ltid(), i_ = layer >> 1;
    const int seq = unit >> 1, half = unit & 1, b = seq >> 4, h = (seq >> 1) & 7, dir = seq & 1, grp = h >> 2;
    LAS float* cw = (LAS float*)lds;
    LAS float* bufs = cw + 4 * 160;
    const bf16_t* Pb = (const bf16_t*)(P.ws + WS_P);
    bf16_t* Y = (bf16_t*)(P.ws + (dir ? WS_YB : WS_YF));
    for (int i = tid; i < 4 * 160; i += NT) {
        const int tap = i / 160, lc = i % 160, g = lc >> 3, e = lc & 7;
        const int ch = g < 4 ? (h * 64 + half * 32 + 8 * g + e) : g < 12 ? (512 + grp * 64 + 8 * (g - 4) + e) : (640 + grp * 64 + 8 * (g - 12) + e);
        cw[i] = tap < 3 ? P.ssd_conv_w[(size_t)(i_ * 3 + tap) * 768 + ch] : P.ssd_conv_b[i_ * 768 + ch];
    }
    const float dtb = P.ssd_dt_bias[(i_ * 2 + dir) * 8 + h], aco = -expf(P.ssd_a_log[(i_ * 2 + dir) * 8 + h]);
    int tj[2], tg_[2], tcol[2]; bool tv[2];
#pragma unroll
    for (int s = 0; s < 2; ++s) {
        const int task = tid + NT * s; tv[s] = task < 640; tj[s] = task / 20; tg_[s] = task % 20;
        const int g = tg_[s];
        tcol[s] = g < 4 ? (512 + h * 64 + half * 32 + 8 * g) : g < 12 ? (1024 + grp * 64 + 8 * (g - 4)) : (1152 + grp * 64 + 8 * (g - 12));
    }
    u32x4 rp[2], rc[2], rn[2]; float rdt = 0.f; int rrow = 0;
    auto load = [&](int c) {
#pragma unroll
        for (int s = 0; s < 2; ++s) {
            rp[s] = rc[s] = rn[s] = (u32x4){0u, 0u, 0u, 0u};
            if (tv[s]) {
                const int row = scan_row(c * TCH + tj[s], b, dir, 0); int t, len; row_seg(row, t, len);
                const bf16_t* p = Pb + (size_t)row * LDP_EVEN + tcol[s];
                rc[s] = *(const u32x4*)p;
                if (t > 0) rp[s] = *(const u32x4*)(p - LDP_EVEN);
                if (t < len - 1) rn[s] = *(const u32x4*)(p + LDP_EVEN);
            }
        }
        if (tid < TCH) { rrow = scan_row(c * TCH + tid, b, dir, 0); rdt = bf2f(Pb[(size_t)rrow * LDP_EVEN + 1280 + dir * 8 + h]); }
    };
    auto store = [&](int c) {
        LAS float* buf = bufs + (c & 1) * SSD_BUF;
#pragma unroll
        for (int s = 0; s < 2; ++s) {
            if (tv[s]) {
                float fp[8], fc[8], fn[8], o[8]; unpack8(rp[s], fp); unpack8(rc[s], fc); unpack8(rn[s], fn);
                const int lc = tg_[s] * 8;
#pragma unroll
                for (int e = 0; e < 8; ++e) o[e] = siluf_(cw[lc + e] * fp[e] + cw[160 + lc + e] * fc[e] + cw[320 + lc + e] * fn[e] + cw[480 + lc + e]);
                LAS float* dst = buf + tj[s] * SSD_F + lc;
                *(LAS f32x4*)dst = (f32x4){o[0], o[1], o[2], o[3]}; *(LAS f32x4*)(dst + 4) = (f32x4){o[4], o[5], o[6], o[7]};
            }
        }
        if (tid < TCH) {
            const float dt = softplusf_(rdt + dtb);
            buf[TCH * SSD_F + tid] = __expf(dt * aco); buf[TCH * SSD_F + TCH + tid] = dt; ((LAS int*)buf)[TCH * SSD_F + 2 * TCH + tid] = rrow;
        }
    };
    const int prow = tid >> 4, q = tid & 15;
    float hs[4] = {0.f, 0.f, 0.f, 0.f};
    __syncthreads();
    load(0); store(0); __syncthreads();
    for (int c = 0; c < NCHUNK; ++c) {
        if (c + 1 < NCHUNK) load(c + 1);
        LAS float* buf = bufs + (c & 1) * SSD_BUF;
        {
            const LAS float* xp = buf + prow;
            const LAS float* bp = buf + 32 + 4 * q;
            const LAS float* aux = buf + TCH * SSD_F;
            f32x4 B4 = *(const LAS f32x4*)bp, C4 = *(const LAS f32x4*)(bp + 64); float xr = xp[0];
#pragma unroll 1
            for (int jh = 0; jh < 2; ++jh) {
                float ysel = 0.f;
                f32x4 dA4, dt4;
#pragma unroll
                for (int j = 0; j < 16; ++j) {
                    const int jj = jh * 16 + j;
                    if ((j & 3) == 0) { dA4 = *(const LAS f32x4*)(aux + jj); dt4 = *(const LAS f32x4*)(aux + TCH + jj); }
                    const f32x4 Bc = B4, Cc = C4; const float xc = xr;
                    if (j < 15 || jh == 0) { B4 = *(const LAS f32x4*)(bp + (jj + 1) * SSD_F); C4 = *(const LAS f32x4*)(bp + 64 + (jj + 1) * SSD_F); xr = xp[(jj + 1) * SSD_F]; }
                    const float dA = dA4[j & 3], xv = xc * dt4[j & 3];
                    float y = 0.f;
#pragma unroll
                    for (int e = 0; e < 4; ++e) { hs[e] = dA * hs[e] + xv * Bc[e]; y += Cc[e] * hs[e]; }
                    y = allreduce16(y);
                    ysel = (q == j) ? y : ysel;
                }
                const int row = ((const LAS int*)aux)[2 * TCH + jh * 16 + q];
                Y[(size_t)row * D + h * 64 + half * 32 + prow] = f2bf(ysel);
            }
        }
        if (c + 1 < NCHUNK) store(c + 1);
        __syncthreads();
    }
}

constexpr int ML_F = 64 + 64 + 32;
constexpr int ML_BUF = TCH * ML_F + 4 * TCH;
__device__ __forceinline__ void scan_mlstm(KP Pk, int layer, int unit, LAS char* lds) {
    asm volatile("" : "+s"(Pk));
    const CAS Params& P = *Pk;
    const int tid = ltid(), i_ = layer >> 1;
    const int seq = unit >> 2, quarter = unit & 3, b = seq >> 3, h = (seq >> 1) & 3, dir = seq & 1;
    LAS float* cw = (LAS float*)lds;
    LAS float* bufs = cw + 4 * 128;
    const bf16_t* Pb = (const bf16_t*)(P.ws + WS_P);
    bf16_t* Y = (bf16_t*)(P.ws + (dir ? WS_YB : WS_YF));
    for (int i = tid; i < 4 * 128; i += NT) {
        const int tap = i >> 7, lc = i & 127;
        const int ch = lc < 64 ? (h * 64 + lc) : (256 + h * 64 + lc - 64);
        cw[i] = tap < 3 ? P.ml_conv_w[(size_t)(i_ * 3 + tap) * 512 + ch] : P.ml_conv_b[i_ * 512 + ch];
    }
    const float ib = P.ml_i_bias[(i_ * 2 + dir) * 4 + h], fb = P.ml_f_bias[(i_ * 2 + dir) * 4 + h];
    int tj[2], tg_[2], tcol[2]; bool tv[2];
#pragma unroll
    for (int s = 0; s < 2; ++s) {
        const int task = tid + NT * s; tv[s] = task < 640; tj[s] = task / 20; tg_[s] = task % 20;
        const int g = tg_[s];
        tcol[s] = 1296 + (g < 8 ? (h * 64 + 8 * g) : g < 16 ? (256 + h * 64 + 8 * (g - 8)) : (512 + h * 128 + quarter * 32 + 8 * (g - 16)));
    }
    u32x4 rp[2], rc[2], rn[2]; float rgi = 0.f, rgf = 0.f; int rrow = 0;
    float mcarry = -1e30f;
    auto load = [&](int c) {
#pragma unroll
        for (int s = 0; s < 2; ++s) {
            rp[s] = rc[s] = rn[s] = (u32x4){0u, 0u, 0u, 0u};
            if (tv[s]) {
                const int row = scan_row(c * TCH + tj[s], b, dir, 0); int t, len; row_seg(row, t, len);
                const bf16_t* p = Pb + (size_t)row * LDP_EVEN + tcol[s];
                rc[s] = *(const u32x4*)p;
                if (tg_[s] < 16) { if (t > 0) rp[s] = *(const u32x4*)(p - LDP_EVEN); if (t < len - 1) rn[s] = *(const u32x4*)(p + LDP_EVEN); }
            }
        }
        if (tid < TCH) {
            rrow = scan_row(c * TCH + tid, b, dir, 0);
            const bf16_t* g = Pb + (size_t)rrow * LDP_EVEN + 1296 + 1536;
            rgi = bf2f(g[dir * 4 + h]); rgf = bf2f(g[8 + dir * 4 + h]);
        }
    };
    auto store = [&](int c) {
        LAS float* buf = bufs + (c & 1) * ML_BUF;
#pragma unroll
        for (int s = 0; s < 2; ++s) {
            if (tv[s]) {
                float fp[8], fc[8], fn[8], o[8]; unpack8(rp[s], fp); unpack8(rc[s], fc); unpack8(rn[s], fn);
                const int g = tg_[s], lc = g * 8;
                if (g < 16) {
                    const float scl = g < 8 ? 0.125f : 1.f;
#pragma unroll
                    for (int e = 0; e < 8; ++e) o[e] = scl * siluf_(cw[lc + e] * fp[e] + cw[128 + lc + e] * fc[e] + cw[256 + lc + e] * fn[e] + cw[384 + lc + e]);
                } else {
#pragma unroll
                    for (int e = 0; e < 8; ++e) o[e] = fc[e];
                }
                LAS float* dst = buf + tj[s] * ML_F + lc;
                *(LAS f32x4*)dst = (f32x4){o[0], o[1], o[2], o[3]}; *(LAS f32x4*)(dst + 4) = (f32x4){o[4], o[5], o[6], o[7]};
            }
        }
        if (tid < 64) {
            const int l = tid & 31;
            const float li = rgi + ib, lf = logsigmoidf_(rgf + fb);
            float F = lf;
#pragma unroll
            for (int o = 1; o < 32; o <<= 1) { const float t = __shfl_up(F, o, 32); if (l >= o) F += t; }
            float cm = li - F;
#pragma unroll
            for (int o = 1; o < 32; o <<= 1) { const float t = __shfl_up(cm, o, 32); if (l >= o) cm = fmaxf(cm, t); }
            const float m = F + fmaxf(mcarry, cm);
            float mprev = __shfl_up(m, 1, 32); if (l == 0) mprev = mcarry;
            const float sp = __expf(lf + mprev - m), sl = __expf(li - m), em = __expf(-m);
            if (tid < TCH) { buf[TCH * ML_F + tid] = sp; buf[TCH * ML_F + TCH + tid] = sl; buf[TCH * ML_F + 2 * TCH + tid] = em; ((LAS int*)buf)[TCH * ML_F + 3 * TCH + tid] = rrow; }
            mcarry = __shfl(m, 31, 32);
        }
    };
    const int col = tid >> 4, q = tid & 15;
    float Cs[4] = {0.f, 0.f, 0.f, 0.f}, ns[4] = {0.f, 0.f, 0.f, 0.f};
    __syncthreads();
    load(0); store(0); __syncthreads();
    for (int c = 0; c < NCHUNK; ++c) {
        if (c + 1 < NCHUNK) load(c + 1);
        LAS float* buf = bufs + (c & 1) * ML_BUF;
        {
            const LAS float* qp = buf + 4 * q;
            const LAS float* vp = buf + 128 + col;
            const LAS float* aux = buf + TCH * ML_F;
            f32x4 q4 = *(const LAS f32x4*)qp, k4 = *(const LAS f32x4*)(qp + 64); float vr = vp[0];
#pragma unroll 1
            for (int jh = 0; jh < 2; ++jh) {
                float nsel = 0.f, dsel = 1.f;
                f32x4 sp4, sl4;
#pragma unroll
                for (int j = 0; j < 16; ++j) {
                    const int jj = jh * 16 + j;
                    if ((j & 3) == 0) { sp4 = *(const LAS f32x4*)(aux + jj); sl4 = *(const LAS f32x4*)(aux + TCH + jj); }
                    const f32x4 qc = q4, kc = k4; const float vv = vr;
                    if (j < 15 || jh == 0) { q4 = *(const LAS f32x4*)(qp + (jj + 1) * ML_F); k4 = *(const LAS f32x4*)(qp + 64 + (jj + 1) * ML_F); vr = vp[(jj + 1) * ML_F]; }
                    const float sp = sp4[j & 3], sl = sl4[j & 3];
                    float num = 0.f, den = 0.f;
#pragma unroll
                    for (int e = 0; e < 4; ++e) { const float sk = sl * kc[e]; Cs[e] = sp * Cs[e] + sk * vv; ns[e] = sp * ns[e] + sk; num += qc[e] * Cs[e]; den += qc[e] * ns[e]; }
                    num = allreduce16(num); den = allreduce16(den);
                    nsel = (q == j) ? num : nsel; dsel = (q == j) ? den : dsel;
                }
                const float em = aux[2 * TCH + jh * 16 + q];
                const int row = ((const LAS int*)aux)[3 * TCH + jh * 16 + q];
                Y[(size_t)row * D + 512 + h * 128 + quarter * 32 + col] = f2bf(nsel / fmaxf(fabsf(dsel), em));
            }
        }
        if (c + 1 < NCHUNK) store(c + 1);
        __syncthreads();
    }
}

constexpr int HG_F = 128 + 128 + 32;
constexpr int HG_BUF = TCH * HG_F + TCH;
__device__ __forceinline__ void scan_hgrn(KP Pk, int layer, int unit, LAS char* lds) {
    asm volatile("" : "+s"(Pk));
    const CAS Params& P = *Pk;
    const int tid = ltid(), i_ = layer >> 1;
    const int seq = unit >> 2, quarter = unit & 3, b = seq >> 3, h = (seq >> 1) & 3, dir = seq & 1;
    LAS float* cst = (LAS float*)lds;
    LAS float* bufs = cst + 256;
    const bf16_t* Pb = (const bf16_t*)(P.ws + WS_P);
    bf16_t* Y = (bf16_t*)(P.ws + (dir ? WS_YB : WS_YF));
    if (tid < 128) cst[tid] = ((const float*)(P.ws + WS_LB))[layer * 512 + h * 128 + tid];
    else if (tid < 256) cst[tid] = P.hg_f_bias[(size_t)(i_ * 2 + dir) * 512 + h * 128 + tid - 128];
    int tj[3], tg_[3], tcol[3]; bool tv[3];
#pragma unroll
    for (int s = 0; s < 3; ++s) {
        const int task = tid + NT * s; tv[s] = task < TCH * 36; tj[s] = task / 36; tg_[s] = task % 36;
        const int g = tg_[s];
        tcol[s] = g < 16 ? (512 + dir * 512 + h * 128 + 8 * g) : g < 32 ? (h * 128 + 8 * (g - 16)) : (1536 + h * 128 + quarter * 32 + 8 * (g - 32));
    }
    u32x4 rc[3]; int rrow = 0;
    auto load = [&](int c) {
#pragma unroll
        for (int s = 0; s < 3; ++s) {
            rc[s] = (u32x4){0u, 0u, 0u, 0u};
            if (tv[s]) { const int row = scan_row(c * TCH + tj[s], b, dir, 1); rc[s] = *(const u32x4*)(Pb + (size_t)row * LDP_ODD + tcol[s]); }
        }
        if (tid < TCH) rrow = scan_row(c * TCH + tid, b, dir, 1);
    };
    auto store = [&](int c) {
        LAS float* buf = bufs + (c & 1) * HG_BUF;
#pragma unroll
        for (int s = 0; s < 3; ++s) {
            if (tv[s]) {
                float fc[8], o[8]; unpack8(rc[s], fc);
                const int g = tg_[s], lc = g * 8;
                if (g < 16) {
#pragma unroll
                    for (int e = 0; e < 8; ++e) { const float lbv = cst[lc + e]; o[e] = lbv + (1.f - lbv) * sigmoidf_(fc[e] + cst[128 + lc + e]); }
                } else if (g < 32) {
#pragma unroll
                    for (int e = 0; e < 8; ++e) o[e] = siluf_(fc[e]);
                } else {
#pragma unroll
                    for (int e = 0; e < 8; ++e) o[e] = fc[e];
                }
                LAS float* dst = buf + tj[s] * HG_F + lc;
                *(LAS f32x4*)dst = (f32x4){o[0], o[1], o[2], o[3]}; *(LAS f32x4*)(dst + 4) = (f32x4){o[4], o[5], o[6], o[7]};
            }
        }
        if (tid < TCH) ((LAS int*)buf)[TCH * HG_F + tid] = rrow;
    };
    const int col = tid >> 4, q = tid & 15;
    float S[8];
#pragma unroll
    for (int e = 0; e < 8; ++e) S[e] = 0.f;
    __syncthreads();
    load(0); store(0); __syncthreads();
    for (int c = 0; c < NCHUNK; ++c) {
        if (c + 1 < NCHUNK) load(c + 1);
        LAS float* buf = bufs + (c & 1) * HG_BUF;
        {
            const LAS float* fp = buf + 4 * q;
            const LAS float* vp = buf + 256 + col;
            f32x4 f0 = *(const LAS f32x4*)fp, f1 = *(const LAS f32x4*)(fp + 64), q0 = *(const LAS f32x4*)(fp + 128), q1 = *(const LAS f32x4*)(fp + 192); float vr = vp[0];
#pragma unroll 1
            for (int jh = 0; jh < 2; ++jh) {
                float ysel = 0.f;
#pragma unroll
                for (int j = 0; j < 16; ++j) {
                    const int jj = jh * 16 + j;
                    const f32x4 f0c = f0, f1c = f1, q0c = q0, q1c = q1; const float vv = vr;
                    if (j < 15 || jh == 0) {
                        const LAS float* np = fp + (jj + 1) * HG_F;
                        f0 = *(const LAS f32x4*)np; f1 = *(const LAS f32x4*)(np + 64); q0 = *(const LAS f32x4*)(np + 128); q1 = *(const LAS f32x4*)(np + 192); vr = vp[(jj + 1) * HG_F];
                    }
                    float o = 0.f;
#pragma unroll
                    for (int e = 0; e < 4; ++e) { S[e] = f0c[e] * (S[e] - vv) + vv; o += q0c[e] * S[e]; S[4 + e] = f1c[e] * (S[4 + e] - vv) + vv; o += q1c[e] * S[4 + e]; }
                    o = allreduce16(o);
                    ysel = (q == j) ? o : ysel;
                }
                const int row = ((const LAS int*)buf)[TCH * HG_F + jh * 16 + q];
                Y[(size_t)row * D + h * 128 + quarter * 32 + col] = f2bf(ysel);
            }
        }
        if (c + 1 < NCHUNK) store(c + 1);
        __syncthreads();
    }
}

constexpr int RW_F = 5 * 64 + 32;
constexpr int RW_BUF = TCH * RW_F + TCH;
__device__ __forceinline__ void scan_rwkv(KP Pk, int layer, int unit, LAS char* lds) {
    asm volatile("" : "+s"(Pk));
    const CAS Params& P = *Pk;
    const int tid = ltid();
    const int seq = unit >> 1, half = unit & 1, b = seq >> 4, h = (seq >> 1) & 7, dir = seq & 1;
    LAS float* bufs = (LAS float*)lds;
    bf16_t* Y = (bf16_t*)(P.ws + (dir ? WS_YB : WS_YF));
    const float* dec = (const float*)(P.ws + WS_RWDEC) + (size_t)dir * NROWS * 512;
    int tj[4], tg_[4]; bool tv[4]; const unsigned char* tbase[4]; int tlds[4];
#pragma unroll
    for (int s = 0; s < 4; ++s) {
        const int task = tid + NT * s; tv[s] = task < TCH * 52; tj[s] = task / 52; tg_[s] = task % 52;
        const int g = tg_[s];
        if (g < 8)       { tbase[s] = P.ws + WS_RWR  + (size_t)(h * 64 + 8 * g) * 2;              tlds[s] = 256 + 8 * g; }
        else if (g < 16) { tbase[s] = P.ws + WS_RWK  + (size_t)(h * 64 + 8 * (g - 8)) * 2;        tlds[s] = 192 + 8 * (g - 8); }
        else if (g < 24) { tbase[s] = P.ws + WS_RWKK + (size_t)(h * 64 + 8 * (g - 16)) * 2;       tlds[s] = 64 + 8 * (g - 16); }
        else if (g < 32) { tbase[s] = P.ws + WS_RWB  + (size_t)(h * 64 + 8 * (g - 24)) * 2;       tlds[s] = 128 + 8 * (g - 24); }
        else if (g < 36) { tbase[s] = P.ws + WS_RWV  + (size_t)(h * 64 + half * 32 + 8 * (g - 32)) * 2; tlds[s] = 320 + 8 * (g - 32); }
        else             { tbase[s] = (const unsigned char*)(dec + h * 64 + 4 * (g - 36));        tlds[s] = 4 * (g - 36); }
    }
    u32x4 rc[4]; int rrow = 0;
    auto load = [&](int c) {
#pragma unroll
        for (int s = 0; s < 4; ++s) {
            rc[s] = (u32x4){0u, 0u, 0u, 0u};
            if (tv[s]) { const int row = scan_row(c * TCH + tj[s], b, dir, 1); rc[s] = *(const u32x4*)(tbase[s] + (size_t)row * (tg_[s] < 36 ? 1024 : 2048)); }
        }
        if (tid < TCH) rrow = scan_row(c * TCH + tid, b, dir, 1);
    };
    auto store = [&](int c) {
        LAS float* buf = bufs + (c & 1) * RW_BUF;
#pragma unroll
        for (int s = 0; s < 4; ++s) {
            if (tv[s]) {
                LAS float* dst = buf + tj[s] * RW_F + tlds[s];
                const int g = tg_[s];
                if (g >= 36) { *(LAS u32x4*)dst = rc[s]; }
                else {
                    float f[8]; unpack8(rc[s], f);
                    const float sg = (g >= 16 && g < 24) ? -1.f : 1.f;
                    *(LAS f32x4*)dst = (f32x4){sg * f[0], sg * f[1], sg * f[2], sg * f[3]}; *(LAS f32x4*)(dst + 4) = (f32x4){sg * f[4], sg * f[5], sg * f[6], sg * f[7]};
                }
            }
        }
        if (tid < TCH) ((LAS int*)buf)[TCH * RW_F + tid] = rrow;
    };
    const int vrow = tid >> 4, q = tid & 15;
    float S[4] = {0.f, 0.f, 0.f, 0.f};
    load(0); store(0); __syncthreads();
    for (int c = 0; c < NCHUNK; ++c) {
        if (c + 1 < NCHUNK) load(c + 1);
        LAS float* buf = bufs + (c & 1) * RW_BUF;
        {
            const LAS float* wp = buf + 4 * q;
            const LAS float* vp = buf + 320 + vrow;
            f32x4 w4 = *(const LAS f32x4*)wp, a4 = *(const LAS f32x4*)(wp + 64), b4 = *(const LAS f32x4*)(wp + 128), k4 = *(const LAS f32x4*)(wp + 192), r4 = *(const LAS f32x4*)(wp + 256); float vr = vp[0];
#pragma unroll 1
            for (int jh = 0; jh < 2; ++jh) {
                float ysel = 0.f;
#pragma unroll
                for (int j = 0; j < 16; ++j) {
                    const int jj = jh * 16 + j;
                    const f32x4 wc = w4, ac = a4, bc = b4, kc = k4, rc = r4; const float vv = vr;
                    if (j < 15 || jh == 0) {
                        const LAS float* np = wp + (jj + 1) * RW_F;
                        w4 = *(const LAS f32x4*)np; a4 = *(const LAS f32x4*)(np + 64); b4 = *(const LAS f32x4*)(np + 128); k4 = *(const LAS f32x4*)(np + 192); r4 = *(const LAS f32x4*)(np + 256); vr = vp[(jj + 1) * RW_F];
                    }
                    float sa = S[0] * ac[0] + S[1] * ac[1] + S[2] * ac[2] + S[3] * ac[3];
                    sa = allreduce16(sa);
                    float y = 0.f;
#pragma unroll
                    for (int e = 0; e < 4; ++e) { S[e] = S[e] * wc[e] + (sa * bc[e] + vv * kc[e]); y += S[e] * rc[e]; }
                    y = allreduce16(y);
                    ysel = (q == j) ? y : ysel;
                }
                const int row = ((const LAS int*)buf)[TCH * RW_F + jh * 16 + q];
                Y[(size_t)row * D + 512 + h * 64 + half * 32 + vrow] = f2bf(ysel);
            }
        }
        if (c + 1 < NCHUNK) store(c + 1);
        __syncthreads();
    }
}

constexpr size_t WS_EXBC = WS_RWR;
constexpr size_t WS_EQK = WS_EXBC + (size_t)NROWS * 768 * 2;
constexpr size_t WS_EGT = WS_EQK + (size_t)NROWS * 512 * 2;
static_assert(WS_EGT + (size_t)NROWS * 32 * 4 <= WS_LA, "even-layer prepare buffers must fit in the RWKV region");

__device__ __forceinline__ void phase_prep_even(KP Pk, int layer) {
    asm volatile("" : "+s"(Pk));
    const CAS Params& P = *Pk;
    const int tid = ltid(), lane = tid & 63, wid = tid >> 6, i_ = layer >> 1;
    const bf16_t* Pb = (const bf16_t*)(P.ws + WS_P);
    bf16_t* XBC = (bf16_t*)(P.ws + WS_EXBC); bf16_t* QK = (bf16_t*)(P.ws + WS_EQK); float* GT = (float*)(P.ws + WS_EGT);
    float cw0[4][8], cw1[4][8], cwq[4][8];
#pragma unroll
    for (int e = 0; e < 8; ++e) {
#pragma unroll
        for (int t = 0; t < 3; ++t) {
            cw0[t][e] = P.ssd_conv_w[(size_t)(i_ * 3 + t) * 768 + 8 * lane + e];
            cw1[t][e] = P.ssd_conv_w[(size_t)(i_ * 3 + t) * 768 + 512 + 8 * (lane & 31) + e];
            cwq[t][e] = P.ml_conv_w[(size_t)(i_ * 3 + t) * 512 + 8 * lane + e];
        }
        cw0[3][e] = P.ssd_conv_b[i_ * 768 + 8 * lane + e]; cw1[3][e] = P.ssd_conv_b[i_ * 768 + 512 + 8 * (lane & 31) + e]; cwq[3][e] = P.ml_conv_b[i_ * 512 + 8 * lane + e];
    }
    float gbias = 0.f;
    if (lane < 16) gbias = P.ssd_dt_bias[i_ * 16 + lane]; else if (lane < 24) gbias = P.ml_i_bias[i_ * 8 + lane - 16]; else if (lane < 32) gbias = P.ml_f_bias[i_ * 8 + lane - 24];
    const float qscl = lane < 32 ? 0.125f : 1.f;
    for (int r = blockIdx.x * 8 + wid; r < NROWS; r += gridDim.x * 8) {
        int t, len; row_seg(r, t, len);
        const bf16_t* pr = Pb + (size_t)r * LDP_EVEN;
        const bool hp = t > 0, hn = t < len - 1;
        const u32x4 zero = (u32x4){0u, 0u, 0u, 0u};
        float fc[8], fp[8], fn[8], o[8];
        {
            const int col = 512 + 8 * lane;
            unpack8(*(const u32x4*)(pr + col), fc); unpack8(hp ? *(const u32x4*)(pr - LDP_EVEN + col) : zero, fp); unpack8(hn ? *(const u32x4*)(pr + LDP_EVEN + col) : zero, fn);
#pragma unroll
            for (int e = 0; e < 8; ++e) o[e] = siluf_(cw0[0][e] * fp[e] + cw0[1][e] * fc[e] + cw0[2][e] * fn[e] + cw0[3][e]);
            *(u32x4*)(XBC + (size_t)r * 768 + 8 * lane) = pack8(o);
        }
        if (lane < 32) {
            const int col = 1024 + 8 * lane;
            unpack8(*(const u32x4*)(pr + col), fc); unpack8(hp ? *(const u32x4*)(pr - LDP_EVEN + col) : zero, fp); unpack8(hn ? *(const u32x4*)(pr + LDP_EVEN + col) : zero, fn);
#pragma unroll
            for (int e = 0; e < 8; ++e) o[e] = siluf_(cw1[0][e] * fp[e] + cw1[1][e] * fc[e] + cw1[2][e] * fn[e] + cw1[3][e]);
            *(u32x4*)(XBC + (size_t)r * 768 + 512 + 8 * lane) = pack8(o);
        }
        {
            const int col = 1296 + 8 * lane;
            unpack8(*(const u32x4*)(pr + col), fc); unpack8(hp ? *(const u32x4*)(pr - LDP_EVEN + col) : zero, fp); unpack8(hn ? *(const u32x4*)(pr + LDP_EVEN + col) : zero, fn);
#pragma unroll
            for (int e = 0; e < 8; ++e) o[e] = qscl * siluf_(cwq[0][e] * fp[e] + cwq[1][e] * fc[e] + cwq[2][e] * fn[e] + cwq[3][e]);
            *(u32x4*)(QK + (size_t)r * 512 + 8 * lane) = pack8(o);
        }
        if (lane < 32) {
            const int col = lane < 16 ? 1280 + lane : 2832 + (lane - 16);
            const float x = bf2f(pr[col]) + gbias;
            GT[(size_t)r * 32 + lane] = lane < 16 ? softplusf_(x) : lane < 24 ? x : logsigmoidf_(x);
        }
    }
}

constexpr int CL = 64, NCH64 = NSTEPS / CL, LDT = 72, LDTB = LDT * 2;
__device__ __forceinline__ bf16x8 ldfrag(const LAS char* tile, int ldb, int row0, int k0, int lane) {
    return *(const LAS bf16x8*)(tile + (row0 + (lane & 15)) * ldb + (k0 + 8 * (lane >> 4)) * 2);
}
__device__ __forceinline__ void st4bf(LAS char* p, const f32x4& v) { u32x2 o; o.x = pk2(v[0], v[1]); o.y = pk2(v[2], v[3]); *(LAS u32x2*)p = o; }

constexpr int SS_BT = 0, SS_CT = SS_BT + 64 * LDTB, SS_BDT = SS_CT + 64 * LDTB, SS_XT = SS_BDT + 64 * LDTB, SS_CUM = SS_XT + 32 * LDTB, SS_DTV = SS_CUM + 256, SS_ROWS = SS_DTV + 256, SS_STG = SS_ROWS + 256;
constexpr int SS_M = 2 * SS_STG, SS_HB = SS_M + 64 * LDTB, SS_END = SS_HB + 32 * LDTB;
static_assert(SS_END <= LDS_BYTES - 16, "SSD LDS map");
__device__ __forceinline__ void scan_ssd_c(KP Pk, int layer, int unit, LAS char* lds) {
    asm volatile("" : "+s"(Pk));
    const CAS Params& P = *Pk;
    const int tid = ltid(), lane = tid & 63, wid = tid >> 6, q = lane >> 4, r16 = lane & 15, i_ = layer >> 1;
    const int seq = unit >> 1, half = unit & 1, b = seq >> 4, h = (seq >> 1) & 7, dir = seq & 1, grp = h >> 2;
    const bf16_t* XBC = (const bf16_t*)(P.ws + WS_EXBC);
    const float* GT = (const float*)(P.ws + WS_EGT);
    bf16_t* Y = (bf16_t*)(P.ws + (dir ? WS_YB : WS_YF));
    const float aco = -expf(P.ssd_a_log[(i_ * 2 + dir) * 8 + h]);
    int tj[3], tg_[3], tcol[3]; bool tv[3];
#pragma unroll
    for (int s = 0; s < 3; ++s) {
        const int task = tid + NT * s; tv[s] = task < CL * 20; tj[s] = task / 20; tg_[s] = task % 20;
        const int g = tg_[s];
        tcol[s] = g < 4 ? (h * 64 + half * 32 + 8 * g) : g < 12 ? (512 + grp * 64 + 8 * (g - 4)) : (640 + grp * 64 + 8 * (g - 12));
    }
    u32x4 rc[3]; float rdt = 0.f; int rrow = 0;
    auto load = [&](int c) {
#pragma unroll
        for (int s = 0; s < 3; ++s) {
            rc[s] = (u32x4){0u, 0u, 0u, 0u};
            if (tv[s]) { const int row = scan_row(c * CL + tj[s], b, dir, 0); rc[s] = *(const u32x4*)(XBC + (size_t)row * 768 + tcol[s]); }
        }
        if (tid < CL) { rrow = scan_row(c * CL + tid, b, dir, 0); rdt = GT[(size_t)rrow * 32 + dir * 8 + h]; }
    };
    auto store1 = [&](int c) {
        if (tid < CL) {
            LAS char* stg = lds + (c & 1) * SS_STG;
            float cum = rdt * aco;
#pragma unroll
            for (int o = 1; o < 64; o <<= 1) { const float t = __shfl_up(cum, o); if (lane >= o) cum += t; }
            ((LAS float*)(stg + SS_CUM))[tid] = cum; ((LAS float*)(stg + SS_DTV))[tid] = rdt; ((LAS int*)(stg + SS_ROWS))[tid] = rrow;
        }
    };
    auto store2 = [&](int c) {
        LAS char* stg = lds + (c & 1) * SS_STG;
        const LAS float* cum = (const LAS float*)(stg + SS_CUM);
        const float cumL = cum[CL - 1];
#pragma unroll
        for (int s = 0; s < 3; ++s) {
            if (tv[s]) {
                float f[8]; unpack8(rc[s], f);
                const int j = tj[s], g = tg_[s];
                if (g < 4) {
                    const float dt = ((const LAS float*)(stg + SS_DTV))[j];
#pragma unroll
                    for (int e = 0; e < 8; ++e) *(LAS bf16_t*)(stg + SS_XT + (8 * g + e) * LDTB + j * 2) = f2bf(f[e] * dt);
                } else if (g < 12) {
                    const int n0 = 8 * (g - 4);
                    *(LAS u32x4*)(stg + SS_BT + j * LDTB + n0 * 2) = rc[s];
                    const float sc = __expf(cumL - cum[j]);
#pragma unroll
                    for (int e = 0; e < 8; ++e) *(LAS bf16_t*)(stg + SS_BDT + (n0 + e) * LDTB + j * 2) = f2bf(f[e] * sc);
                } else {
                    *(LAS u32x4*)(stg + SS_CT + j * LDTB + 8 * (g - 12) * 2) = rc[s];
                }
            }
        }
    };
    for (int i = tid; i < 32 * LDTB / 4; i += NT) ((LAS unsigned*)(lds + SS_HB))[i] = 0u;
    f32x4 hacc = (f32x4){0.f, 0.f, 0.f, 0.f};
    load(0); store1(0); __syncthreads(); store2(0); __syncthreads();
    for (int c = 0; c < NCH64; ++c) {
        if (c + 1 < NCH64) load(c + 1);
        LAS char* stg = lds + (c & 1) * SS_STG;
        const LAS float* cum = (const LAS float*)(stg + SS_CUM);
        {
            const int lt = wid >> 1;
#pragma unroll
            for (int u = 0; u < 2; ++u) {
                const int st = (wid & 1) * 2 + u;
                f32x4 acc = (f32x4){0.f, 0.f, 0.f, 0.f};
                if (st <= lt) {
#pragma unroll
                    for (int k0 = 0; k0 < 64; k0 += 32) acc = __builtin_amdgcn_mfma_f32_16x16x32_bf16(ldfrag(stg + SS_BT, LDTB, st * 16, k0, lane), ldfrag(stg + SS_CT, LDTB, lt * 16, k0, lane), acc, 0, 0, 0);
                    const int l = lt * 16 + r16, s0 = st * 16 + 4 * q;
                    const float cl = cum[l]; const f32x4 cs = *(const LAS f32x4*)(cum + s0);
#pragma unroll
                    for (int j = 0; j < 4; ++j) acc[j] = (s0 + j <= l) ? acc[j] * __expf(cl - cs[j]) : 0.f;
                }
                st4bf(lds + SS_M + (lt * 16 + r16) * LDTB + (st * 16 + 4 * q) * 2, acc);
            }
        }
        __syncthreads();
        {
            const int lt = wid >> 1, pt = wid & 1;
            f32x4 ya = (f32x4){0.f, 0.f, 0.f, 0.f}, oa = (f32x4){0.f, 0.f, 0.f, 0.f};
#pragma unroll
            for (int k0 = 0; k0 < 64; k0 += 32) {
                ya = __builtin_amdgcn_mfma_f32_16x16x32_bf16(ldfrag(stg + SS_XT, LDTB, pt * 16, k0, lane), ldfrag(lds + SS_M, LDTB, lt * 16, k0, lane), ya, 0, 0, 0);
                oa = __builtin_amdgcn_mfma_f32_16x16x32_bf16(ldfrag(lds + SS_HB, LDTB, pt * 16, k0, lane), ldfrag(stg + SS_CT, LDTB, lt * 16, k0, lane), oa, 0, 0, 0);
            }
            const int l = lt * 16 + r16;
            const float el = __expf(cum[l]);
            const int row = ((const LAS int*)(stg + SS_ROWS))[l];
            u32x2 o; o.x = pk2(ya[0] + el * oa[0], ya[1] + el * oa[1]); o.y = pk2(ya[2] + el * oa[2], ya[3] + el * oa[3]);
            *(u32x2*)(Y + (size_t)row * D + h * 64 + half * 32 + pt * 16 + 4 * q) = o;
            const int ptile = wid >> 2, ntile = wid & 3;
            f32x4 sa = (f32x4){0.f, 0.f, 0.f, 0.f};
#pragma unroll
            for (int k0 = 0; k0 < 64; k0 += 32) sa = __builtin_amdgcn_mfma_f32_16x16x32_bf16(ldfrag(stg + SS_BDT, LDTB, ntile * 16, k0, lane), ldfrag(stg + SS_XT, LDTB, ptile * 16, k0, lane), sa, 0, 0, 0);
            const float dtot = __expf(cum[CL - 1]);
#pragma unroll
            for (int j = 0; j < 4; ++j) hacc[j] = hacc[j] * dtot + sa[j];
        }
        __syncthreads();
        st4bf(lds + SS_HB + ((wid >> 2) * 16 + r16) * LDTB + ((wid & 3) * 16 + 4 * q) * 2, hacc);
        if (c + 1 < NCH64) { store1(c + 1); __syncthreads(); store2(c + 1); }
        __syncthreads();
    }
}

constexpr int MS_QT = 0, MS_KT = MS_QT + 64 * LDTB, MS_KET = MS_KT + 64 * LDTB, MS_VT = MS_KET + 64 * LDTB, MS_SC = MS_VT + 32 * LDTB;
constexpr int MS_STG = MS_SC + 8 * 256;
constexpr int MS_W = 2 * MS_STG, MS_CB = MS_W + 64 * LDTB, MS_ONE = MS_CB + 32 * LDTB, MS_NV = MS_ONE + 16 * LDTB, MS_QN = MS_NV + 256, MS_END = MS_QN + 256;
static_assert(MS_END <= LDS_BYTES - 16, "mLSTM LDS map");
__device__ __forceinline__ void scan_mlstm_c(KP Pk, int layer, int unit, LAS char* lds) {
    asm volatile("" : "+s"(Pk));
    const CAS Params& P = *Pk;
    const int tid = ltid(), lane = tid & 63, wid = tid >> 6, q = lane >> 4, r16 = lane & 15;
    const int seq = unit >> 2, quarter = unit & 3, b = seq >> 3, h = (seq >> 1) & 3, dir = seq & 1;
    const bf16_t* QK = (const bf16_t*)(P.ws + WS_EQK);
    const bf16_t* Pb = (const bf16_t*)(P.ws + WS_P);
    const float* GT = (const float*)(P.ws + WS_EGT);
    bf16_t* Y = (bf16_t*)(P.ws + (dir ? WS_YB : WS_YF));
    int tj[3], tg_[3]; bool tv[3];
#pragma unroll
    for (int s = 0; s < 3; ++s) { const int task = tid + NT * s; tv[s] = task < CL * 20; tj[s] = task / 20; tg_[s] = task % 20; }
    u32x4 rc[3]; float rli = 0.f, rlf = 0.f; int rrow = 0;
    float mprev = -1e30f;
    auto load = [&](int c) {
#pragma unroll
        for (int s = 0; s < 3; ++s) {
            rc[s] = (u32x4){0u, 0u, 0u, 0u};
            if (tv[s]) {
                const int row = scan_row(c * CL + tj[s], b, dir, 0); const int g = tg_[s];
                rc[s] = g < 16 ? *(const u32x4*)(QK + (size_t)row * 512 + (g < 8 ? h * 64 + 8 * g : 256 + h * 64 + 8 * (g - 8)))
                               : *(const u32x4*)(Pb + (size_t)row * LDP_EVEN + 1808 + h * 128 + quarter * 32 + 8 * (g - 16));
            }
        }
        if (tid < CL) { rrow = scan_row(c * CL + tid, b, dir, 0); rli = GT[(size_t)rrow * 32 + 16 + dir * 4 + h]; rlf = GT[(size_t)rrow * 32 + 24 + dir * 4 + h]; }
    };
    auto store1 = [&](int c) {
        if (tid < CL) {
            LAS float* sc = (LAS float*)(lds + (c & 1) * MS_STG + MS_SC);
            float fcum = rlf;
#pragma unroll
            for (int o = 1; o < 64; o <<= 1) { const float t = __shfl_up(fcum, o); if (lane >= o) fcum += t; }
            const float ftot = __shfl(fcum, 63);
            const float g = rli - fcum;
            float pm = g;
#pragma unroll
            for (int o = 1; o < 64; o <<= 1) { const float t = __shfl_up(pm, o); if (lane >= o) pm = fmaxf(pm, t); }
            const float wend = ftot + g;
            float mloc = wend;
#pragma unroll
            for (int o = 1; o < 64; o <<= 1) mloc = fmaxf(mloc, __shfl_xor(mloc, o));
            const float eend = __expf(wend - mloc);
            const float linter = fcum + mprev;
            const float mrow = fmaxf(fcum + pm, linter);
            sc[0 * 64 + tid] = fcum - mrow; sc[1 * 64 + tid] = g; sc[2 * 64 + tid] = __expf(linter - mrow); sc[3 * 64 + tid] = __expf(-mrow); sc[4 * 64 + tid] = eend;
            ((LAS int*)sc)[5 * 64 + tid] = rrow;
            const float mnew = fmaxf(ftot + mprev, mloc);
            if (tid == 0) { sc[6 * 64 + 0] = __expf(ftot + mprev - mnew); sc[6 * 64 + 1] = __expf(mloc - mnew); }
            mprev = mnew;
        }
    };
    auto store2 = [&](int c) {
        LAS char* stg = lds + (c & 1) * MS_STG;
        const LAS float* sc = (const LAS float*)(stg + MS_SC);
#pragma unroll
        for (int s = 0; s < 3; ++s) {
            if (tv[s]) {
                float f[8]; unpack8(rc[s], f);
                const int j = tj[s], g = tg_[s];
                if (g < 8) { *(LAS u32x4*)(stg + MS_QT + j * LDTB + 8 * g * 2) = rc[s]; }
                else if (g < 16) {
                    const int k0 = 8 * (g - 8);
                    *(LAS u32x4*)(stg + MS_KT + j * LDTB + k0 * 2) = rc[s];
                    const float ee = sc[4 * 64 + j];
#pragma unroll
                    for (int e = 0; e < 8; ++e) *(LAS bf16_t*)(stg + MS_KET + (k0 + e) * LDTB + j * 2) = f2bf(f[e] * ee);
                } else {
                    const int v0 = 8 * (g - 16);
#pragma unroll
                    for (int e = 0; e < 8; ++e) { const unsigned wv = rc[s][e >> 1]; *(LAS bf16_t*)(stg + MS_VT + (v0 + e) * LDTB + j * 2) = (bf16_t)((e & 1) ? (wv >> 16) : (wv & 0xffffu)); }
                }
            }
        }
    };
    for (int i = tid; i < 32 * LDTB / 4; i += NT) ((LAS unsigned*)(lds + MS_CB))[i] = 0u;
    for (int i = tid; i < 16 * LDTB / 4; i += NT) ((LAS unsigned*)(lds + MS_ONE))[i] = 0x3f803f80u;
    if (tid < 64) ((LAS float*)(lds + MS_NV))[tid] = 0.f;
    f32x4 cacc = (f32x4){0.f, 0.f, 0.f, 0.f};
    load(0); store1(0); __syncthreads(); store2(0); __syncthreads();
    for (int c = 0; c < NCH64; ++c) {
        if (c + 1 < NCH64) load(c + 1);
        LAS char* stg = lds + (c & 1) * MS_STG;
        const LAS float* sc = (const LAS float*)(stg + MS_SC);
        LAS float* nv = (LAS float*)(lds + MS_NV);
        LAS float* qn = (LAS float*)(lds + MS_QN);
        {
            const int lt = wid >> 1;
#pragma unroll
            for (int u = 0; u < 2; ++u) {
                const int st = (wid & 1) * 2 + u;
                f32x4 acc = (f32x4){0.f, 0.f, 0.f, 0.f};
                if (st <= lt) {
#pragma unroll
                    for (int k0 = 0; k0 < 64; k0 += 32) acc = __builtin_amdgcn_mfma_f32_16x16x32_bf16(ldfrag(stg + MS_KT, LDTB, st * 16, k0, lane), ldfrag(stg + MS_QT, LDTB, lt * 16, k0, lane), acc, 0, 0, 0);
                    const int l = lt * 16 + r16, s0 = st * 16 + 4 * q;
                    const float rt = sc[l]; const f32x4 gs = *(const LAS f32x4*)(sc + 64 + s0);
#pragma unroll
                    for (int j = 0; j < 4; ++j) acc[j] = (s0 + j <= l) ? acc[j] * __expf(rt + gs[j]) : 0.f;
                }
                st4bf(lds + MS_W + (lt * 16 + r16) * LDTB + (st * 16 + 4 * q) * 2, acc);
            }
            if (wid == 0) {
                float a = 0.f;
#pragma unroll
                for (int k0 = 0; k0 < 64; k0 += 8) {
                    const u32x4 tq = *(const LAS u32x4*)(stg + MS_QT + lane * LDTB + k0 * 2); float f[8]; unpack8(tq, f);
#pragma unroll
                    for (int e = 0; e < 8; ++e) a += f[e] * nv[k0 + e];
                }
                qn[lane] = a;
            }
        }
        __syncthreads();
        {
            const int lt = wid >> 1, vt = wid & 1;
            f32x4 na = (f32x4){0.f, 0.f, 0.f, 0.f}, ca = (f32x4){0.f, 0.f, 0.f, 0.f}, da = (f32x4){0.f, 0.f, 0.f, 0.f};
#pragma unroll
            for (int k0 = 0; k0 < 64; k0 += 32) {
                const bf16x8 wf = ldfrag(lds + MS_W, LDTB, lt * 16, k0, lane);
                na = __builtin_amdgcn_mfma_f32_16x16x32_bf16(ldfrag(stg + MS_VT, LDTB, vt * 16, k0, lane), wf, na, 0, 0, 0);
                da = __builtin_amdgcn_mfma_f32_16x16x32_bf16(ldfrag(lds + MS_ONE, LDTB, 0, k0, lane), wf, da, 0, 0, 0);
                ca = __builtin_amdgcn_mfma_f32_16x16x32_bf16(ldfrag(lds + MS_CB, LDTB, vt * 16, k0, lane), ldfrag(stg + MS_QT, LDTB, lt * 16, k0, lane), ca, 0, 0, 0);
            }
            const int l = lt * 16 + r16;
            const float inter = sc[2 * 64 + l], emr = sc[3 * 64 + l];
            const float den = da[0] + inter * qn[l];
            const float inv = 1.f / fmaxf(fabsf(den), emr);
            const int row = ((const LAS int*)sc)[5 * 64 + l];
            u32x2 o; o.x = pk2((na[0] + inter * ca[0]) * inv, (na[1] + inter * ca[1]) * inv); o.y = pk2((na[2] + inter * ca[2]) * inv, (na[3] + inter * ca[3]) * inv);
            *(u32x2*)(Y + (size_t)row * D + 512 + h * 128 + quarter * 32 + vt * 16 + 4 * q) = o;
            const int vtile = wid >> 2, ktile = wid & 3;
            f32x4 sa = (f32x4){0.f, 0.f, 0.f, 0.f};
#pragma unroll
            for (int k0 = 0; k0 < 64; k0 += 32) sa = __builtin_amdgcn_mfma_f32_16x16x32_bf16(ldfrag(stg + MS_KET, LDTB, ktile * 16, k0, lane), ldfrag(stg + MS_VT, LDTB, vtile * 16, k0, lane), sa, 0, 0, 0);
            const float sp = sc[6 * 64 + 0], sl = sc[6 * 64 + 1];
#pragma unroll
            for (int j = 0; j < 4; ++j) cacc[j] = cacc[j] * sp + sl * sa[j];
        }
        __syncthreads();
        st4bf(lds + MS_CB + ((wid >> 2) * 16 + r16) * LDTB + ((wid & 3) * 16 + 4 * q) * 2, cacc);
        if (wid == 1) {
            float a = 0.f;
            for (int s = 0; s < CL; ++s) a += sc[4 * 64 + s] * bf2f(*(const LAS bf16_t*)(stg + MS_KT + s * LDTB + lane * 2));
            nv[lane] = nv[lane] * sc[6 * 64 + 0] + sc[6 * 64 + 1] * a;
        }
        if (c + 1 < NCH64) { store1(c + 1); __syncthreads(); store2(c + 1); }
        __syncthreads();
    }
}

constexpr int HC_RAWF = 0;
constexpr int HC_RAWQ = HC_RAWF + 64 * 128 * 4;
constexpr int HC_SUB = HC_RAWQ + 64 * 128 * 2;
constexpr int HL_QD = 136 * 2;
constexpr int HL_T = 24 * 2;
constexpr int HS_QI = 0, HS_KO = HS_QI + 16 * HL_QD, HS_KET = HS_KO + 16 * HL_QD, HS_ATT = HS_KET + 128 * HL_T, HS_VT = HS_ATT + 16 * HL_T, HS_DEC = HS_VT + 32 * HL_T, HS_SIZE = HS_DEC + 512;
constexpr int HC_SB = HC_SUB + 4 * HS_SIZE;
constexpr int HC_ROWS = HC_SB + 2 * 32 * HL_QD, HC_CST = HC_ROWS + 256, HC_END = HC_CST + 1024;
static_assert(HC_END <= LDS_BYTES - 16, "HGRN2 LDS map");
static_assert(HS_SIZE % 16 == 0 && HC_SB % 16 == 0, "alignment");
__device__ __forceinline__ bf16x8 ldfrag16(const LAS char* tile, int ldb, int row0, int lane) {
    bf16x8 v = *(const LAS bf16x8*)(tile + (row0 + (lane & 15)) * ldb + ((lane >> 4) & 1) * 16);
    if (lane >= 32) v = (bf16x8){0, 0, 0, 0, 0, 0, 0, 0};
    return v;
}
__device__ __forceinline__ void scan_hgrn_c(KP Pk, int layer, int unit, LAS char* lds) {
    asm volatile("" : "+s"(Pk));
    const CAS Params& P = *Pk;
    const int tid = ltid(), lane = tid & 63, wid = tid >> 6, q = lane >> 4, r16 = lane & 15, i_ = layer >> 1;
    const int seq = unit >> 2, quarter = unit & 3, b = seq >> 3, h = (seq >> 1) & 3, dir = seq & 1;
    const bf16_t* Pb = (const bf16_t*)(P.ws + WS_P);
    bf16_t* Y = (bf16_t*)(P.ws + (dir ? WS_YB : WS_YF));
    LAS float* cst = (LAS float*)(lds + HC_CST);
    if (tid < 128) cst[tid] = ((const float*)(P.ws + WS_LB))[layer * 512 + h * 128 + tid];
    else if (tid < 256) cst[tid] = P.hg_f_bias[(size_t)(i_ * 2 + dir) * 512 + h * 128 + tid - 128];
    for (int i = tid; i < 2 * 32 * HL_QD / 4; i += NT) ((LAS unsigned*)(lds + HC_SB))[i] = 0u;
    int tj[5], tg_[5], tcol[5]; bool tv[5];
#pragma unroll
    for (int s = 0; s < 5; ++s) {
        const int task = tid + NT * s; tv[s] = task < 64 * 36; tj[s] = task / 36; tg_[s] = task % 36;
        const int g = tg_[s];
        tcol[s] = g < 16 ? (512 + dir * 512 + h * 128 + 8 * g) : g < 32 ? (h * 128 + 8 * (g - 16)) : (1536 + h * 128 + quarter * 32 + 8 * (g - 32));
    }
    u32x4 rc[5]; int rrow = 0;
    auto load = [&](int c) {
#pragma unroll
        for (int s = 0; s < 5; ++s) {
            rc[s] = (u32x4){0u, 0u, 0u, 0u};
            if (tv[s]) { const int row = scan_row(c * 64 + tj[s], b, dir, 1); rc[s] = *(const u32x4*)(Pb + (size_t)row * LDP_ODD + tcol[s]); }
        }
        if (tid < 64) rrow = scan_row(c * 64 + tid, b, dir, 1);
    };
    auto storeA = [&]() {
#pragma unroll
        for (int s = 0; s < 5; ++s) {
            if (tv[s]) {
                float f[8]; unpack8(rc[s], f);
                const int j = tj[s], g = tg_[s];
                if (g < 16) {
                    float o[8];
#pragma unroll
                    for (int e = 0; e < 8; ++e) { const float lbv = cst[8 * g + e]; o[e] = lbv + (1.f - lbv) * sigmoidf_(f[e] + cst[128 + 8 * g + e]); }
                    LAS float* dst = (LAS float*)(lds + HC_RAWF) + j * 128 + 8 * g;
                    *(LAS f32x4*)dst = (f32x4){o[0], o[1], o[2], o[3]}; *(LAS f32x4*)(dst + 4) = (f32x4){o[4], o[5], o[6], o[7]};
                } else if (g < 32) {
                    float o[8];
#pragma unroll
                    for (int e = 0; e < 8; ++e) o[e] = siluf_(f[e]);
                    *(LAS u32x4*)(lds + HC_RAWQ + (j * 128 + 8 * (g - 16)) * 2) = pack8(o);
                } else {
                    const int v0 = 8 * (g - 32);
                    LAS char* vt = lds + HC_SUB + (j >> 4) * HS_SIZE + HS_VT;
#pragma unroll
                    for (int e = 0; e < 8; ++e) { const unsigned wv = rc[s][e >> 1]; *(LAS bf16_t*)(vt + (v0 + e) * HL_T + (j & 15) * 2) = (bf16_t)((e & 1) ? (wv >> 16) : (wv & 0xffffu)); }
                }
            }
        }
        if (tid < 64) ((LAS int*)(lds + HC_ROWS))[tid] = rrow;
    };
    auto storeB = [&]() {
        const int d = tid & 127, sb = tid >> 7;
        LAS char* st = lds + HC_SUB + sb * HS_SIZE;
        const LAS float* rf = (const LAS float*)(lds + HC_RAWF) + (sb * 16) * 128 + d;
        const LAS bf16_t* rq = (const LAS bf16_t*)(lds + HC_RAWQ) + (sb * 16) * 128 + d;
        float lam = 0.f, lams[16], kfs[16];
#pragma unroll
        for (int t = 0; t < 16; ++t) {
            const float f = rf[t * 128];
            lam += __logf(f);
            const float kf = 1.f - f;
            lams[t] = lam; kfs[t] = kf;
            *(LAS bf16_t*)(st + HS_QI + t * HL_QD + d * 2) = f2bf(bf2f(rq[t * 128]) * __expf(lam));
            *(LAS bf16_t*)(st + HS_KO + t * HL_QD + d * 2) = f2bf(kf * __expf(-lam));
        }
        float ke[16];
#pragma unroll
        for (int t = 0; t < 16; ++t) ke[t] = kfs[t] * __expf(lam - lams[t]);
        *(LAS u32x4*)(st + HS_KET + d * HL_T) = pack8(ke); *(LAS u32x4*)(st + HS_KET + d * HL_T + 16) = pack8(ke + 8);
        ((LAS float*)(st + HS_DEC))[d] = __expf(lam);
    };
    f32x4 sacc[2];
    sacc[0] = sacc[1] = (f32x4){0.f, 0.f, 0.f, 0.f};
    __syncthreads();
    load(0);
    for (int c = 0; c < NSTEPS / 64; ++c) {
        storeA();
        __syncthreads();
        storeB();
        if (c + 1 < NSTEPS / 64) load(c + 1);
        __syncthreads();
        if (wid < 4) {
            LAS char* st = lds + HC_SUB + wid * HS_SIZE;
            f32x4 acc = (f32x4){0.f, 0.f, 0.f, 0.f};
#pragma unroll
            for (int k0 = 0; k0 < 128; k0 += 32) acc = __builtin_amdgcn_mfma_f32_16x16x32_bf16(ldfrag(st + HS_KO, HL_QD, 0, k0, lane), ldfrag(st + HS_QI, HL_QD, 0, k0, lane), acc, 0, 0, 0);
#pragma unroll
            for (int j = 0; j < 4; ++j) acc[j] = (4 * q + j <= r16) ? acc[j] : 0.f;
            st4bf(st + HS_ATT + r16 * HL_T + 4 * q * 2, acc);
        }
        __syncthreads();
#pragma unroll 1
        for (int sb = 0; sb < 4; ++sb) {
            LAS char* st = lds + HC_SUB + sb * HS_SIZE;
            const LAS char* sbr = lds + HC_SB + (sb & 1) * 32 * HL_QD;
            LAS char* sbw = lds + HC_SB + ((sb + 1) & 1) * 32 * HL_QD;
            if (wid < 2) {
                f32x4 ya = __builtin_amdgcn_mfma_f32_16x16x32_bf16(ldfrag16(st + HS_VT, HL_T, wid * 16, lane), ldfrag16(st + HS_ATT, HL_T, 0, lane), (f32x4){0.f, 0.f, 0.f, 0.f}, 0, 0, 0);
#pragma unroll
                for (int k0 = 0; k0 < 128; k0 += 32) ya = __builtin_amdgcn_mfma_f32_16x16x32_bf16(ldfrag(sbr, HL_QD, wid * 16, k0, lane), ldfrag(st + HS_QI, HL_QD, 0, k0, lane), ya, 0, 0, 0);
                const int row = ((const LAS int*)(lds + HC_ROWS))[sb * 16 + r16];
                u32x2 o; o.x = pk2(ya[0], ya[1]); o.y = pk2(ya[2], ya[3]);
                *(u32x2*)(Y + (size_t)row * D + h * 128 + quarter * 32 + wid * 16 + 4 * q) = o;
            }
            {
                const int vt = wid >> 2;
                const bf16x8 vf = ldfrag16(st + HS_VT, HL_T, vt * 16, lane);
#pragma unroll
                for (int u = 0; u < 2; ++u) {
                    const int dt = (wid & 3) * 2 + u;
                    const f32x4 a = __builtin_amdgcn_mfma_f32_16x16x32_bf16(ldfrag16(st + HS_KET, HL_T, dt * 16, lane), vf, (f32x4){0.f, 0.f, 0.f, 0.f}, 0, 0, 0);
                    const f32x4 dc = *(const LAS f32x4*)((const LAS float*)(st + HS_DEC) + dt * 16 + 4 * q);
#pragma unroll
                    for (int j = 0; j < 4; ++j) sacc[u][j] = sacc[u][j] * dc[j] + a[j];
                    st4bf(sbw + (vt * 16 + r16) * HL_QD + (dt * 16 + 4 * q) * 2, sacc[u]);
                }
            }
            __syncthreads();
        }
    }
}

__device__ __forceinline__ void phase_prep1(KP Pk, int layer) {
    asm volatile("" : "+s"(Pk));
    const CAS Params& P = *Pk;
    const int tid = ltid(), lane = tid & 63, wid = tid >> 6, i_ = layer >> 1;
    const bf16_t* Pb = (const bf16_t*)(P.ws + WS_P);
    bf16_t* R = (bf16_t*)(P.ws + WS_RWR); bf16_t* K = (bf16_t*)(P.ws + WS_RWK); bf16_t* V = (bf16_t*)(P.ws + WS_RWV); bf16_t* KK = (bf16_t*)(P.ws + WS_RWKK);
    bf16_t* LA = (bf16_t*)(P.ws + WS_LA);
    const float* mu = P.rw_mu + (size_t)i_ * 1856;
    for (int r = blockIdx.x * 8 + wid; r < NROWS; r += gridDim.x * 8) {
        int rprev = -1, rnext = -1;
        if (r < NCTX) { const int t = r & 255; if (t > 0) rprev = r - 1; if (t < CTXL - 1) rnext = r + 1; }
        else {
            const int bs = (r - NCTX) >> 13, s = (r - NCTX) & 8191, sg = ((s & 63) << 7) + (s >> 6);
            if (sg > 0) { const int g2 = sg - 1; rprev = NCTX + bs * SEQ + ((g2 & 127) << 6) + (g2 >> 7); }
            if (sg < SEQ - 1) { const int g2 = sg + 1; rnext = NCTX + bs * SEQ + ((g2 & 127) << 6) + (g2 >> 7); }
        }
        const bf16_t* pc = Pb + (size_t)r * LDP_ODD + 2560;
        const bf16_t* pp = Pb + (size_t)(rprev < 0 ? r : rprev) * LDP_ODD + 2560;
        const bf16_t* pn = Pb + (size_t)(rnext < 0 ? r : rnext) * LDP_ODD + 2560;
        const float mp = rprev < 0 ? 0.f : 0.5f, mn = rnext < 0 ? 0.f : 0.5f;
        auto mix8 = [&](int col, float* o) {
            float fc[8], fp[8], fn[8];
            unpack8(*(const u32x4*)(pc + col), fc); unpack8(*(const u32x4*)(pp + col), fp); unpack8(*(const u32x4*)(pn + col), fn);
#pragma unroll
            for (int e = 0; e < 8; ++e) o[e] = fc[e] + mu[col + e] * (mp * fp[e] + mn * fn[e] - fc[e]);
        };
        float o[8];
        mix8(8 * lane, o); *(u32x4*)(R + (size_t)r * 512 + 8 * lane) = pack8(o);
        mix8(1024 + 8 * lane, o); *(u32x4*)(V + (size_t)r * 512 + 8 * lane) = pack8(o);
        mix8(512 + 8 * lane, o); *(u32x4*)(K + (size_t)r * 512 + 8 * lane) = pack8(o);
        {
            float kk[8], ss = 0.f;
#pragma unroll
            for (int e = 0; e < 8; ++e) { kk[e] = o[e] * P.rw_k_k[i_ * 512 + 8 * lane + e]; ss += kk[e] * kk[e]; }
            ss = group_sum<8>(ss);
            const float rn = rsqrtf(fmaxf(ss, 1e-12f));
#pragma unroll
            for (int e = 0; e < 8; ++e) kk[e] *= rn;
            *(u32x4*)(KK + (size_t)r * 512 + 8 * lane) = pack8(kk);
        }
        if (lane < 40) {
            mix8(1536 + 8 * lane, o);
            if (lane < 16) {
#pragma unroll
                for (int e = 0; e < 8; ++e) o[e] = tanhf(o[e]);
            } else if (lane >= 24) {
#pragma unroll
                for (int e = 0; e < 8; ++e) o[e] = sigmoidf_(o[e]);
            }
            *(u32x4*)(LA + (size_t)r * 320 + 8 * lane) = pack8(o);
        }
    }
}

__device__ __forceinline__ void phase_out_even(KP Pk, int layer) {
    asm volatile("" : "+s"(Pk));
    const CAS Params& P = *Pk;
    const int tid = ltid(), lane = tid & 63, wid = tid >> 6, i_ = layer >> 1;
    const bf16_t* Pb = (const bf16_t*)(P.ws + WS_P);
    const bf16_t* Yf = (const bf16_t*)(P.ws + WS_YF); const bf16_t* Yb = (const bf16_t*)(P.ws + WS_YB);
    bf16_t* feat = (bf16_t*)(P.ws + WS_FEAT);
    const int r0 = (layer == DEPTH - 1) ? NCTX : 0;
    const bf16_t* XBC = (const bf16_t*)(P.ws + WS_EXBC);
    float nwa[8], nwb[8];
#pragma unroll
    for (int e = 0; e < 8; ++e) { nwa[e] = P.ssd_norm_w[i_ * 512 + 8 * lane + e]; nwb[e] = P.ml_norm_w[i_ * 512 + 8 * lane + e]; }
    const float dsk = P.ssd_d[i_ * 8 + (lane >> 3)];
    for (int r = r0 + blockIdx.x * 8 + wid; r < NROWS; r += gridDim.x * 8) {
        const bf16_t* pr = Pb + (size_t)r * LDP_EVEN;
        float y[8];
        {
            float a[8], bb[8], xsv[8], z[8];
            unpack8(*(const u32x4*)(Yf + (size_t)r * D + 8 * lane), a); unpack8(*(const u32x4*)(Yb + (size_t)r * D + 8 * lane), bb);
            unpack8(*(const u32x4*)(XBC + (size_t)r * 768 + 8 * lane), xsv); unpack8(*(const u32x4*)(pr + 8 * lane), z);
            float ss = 0.f;
#pragma unroll
            for (int e = 0; e < 8; ++e) {
                y[e] = (a[e] + bb[e] + dsk * xsv[e]) * siluf_(z[e]); ss += y[e] * y[e];
            }
            ss = wave_sum(ss);
            const float rn = rsqrtf(ss * (1.f / 512.f) + 1e-6f);
#pragma unroll
            for (int e = 0; e < 8; ++e) y[e] = y[e] * rn * nwa[e];
            *(u32x4*)(feat + (size_t)r * D + 8 * lane) = pack8(y);
        }
        {
            float a[8], bb[8], o[8];
            unpack8(*(const u32x4*)(Yf + (size_t)r * D + 512 + 8 * lane), a); unpack8(*(const u32x4*)(Yb + (size_t)r * D + 512 + 8 * lane), bb);
            unpack8(*(const u32x4*)(pr + 2320 + 8 * lane), o);
            float s = 0.f;
#pragma unroll
            for (int e = 0; e < 8; ++e) { y[e] = a[e] + bb[e]; s += y[e]; }
            const float mean = group_sum<16>(s) * (1.f / 128.f);
            float ss = 0.f;
#pragma unroll
            for (int e = 0; e < 8; ++e) { y[e] -= mean; ss += y[e] * y[e]; }
            const float rn = rsqrtf(group_sum<16>(ss) * (1.f / 128.f) + 1e-6f);
#pragma unroll
            for (int e = 0; e < 8; ++e) y[e] = sigmoidf_(o[e]) * (y[e] * rn) * nwb[e];
            *(u32x4*)(feat + (size_t)r * D + 512 + 8 * lane) = pack8(y);
        }
    }
}
__device__ __forceinline__ void phase_out_odd(KP Pk, int layer) {
    asm volatile("" : "+s"(Pk));
    const CAS Params& P = *Pk;
    const int tid = ltid(), lane = tid & 63, wid = tid >> 6, i_ = layer >> 1;
    const bf16_t* Pb = (const bf16_t*)(P.ws + WS_P);
    const bf16_t* Yf = (const bf16_t*)(P.ws + WS_YF); const bf16_t* Yb = (const bf16_t*)(P.ws + WS_YB);
    const bf16_t* R = (const bf16_t*)(P.ws + WS_RWR); const bf16_t* K = (const bf16_t*)(P.ws + WS_RWK); const bf16_t* V = (const bf16_t*)(P.ws + WS_RWV); const bf16_t* G = (const bf16_t*)(P.ws + WS_RWG);
    bf16_t* feat = (bf16_t*)(P.ws + WS_FEAT);
    const int r0 = (layer == DEPTH - 1) ? NCTX : 0;
    float nwc[8], rk[8], lw[8], lbv[8];
#pragma unroll
    for (int e = 0; e < 8; ++e) {
        nwc[e] = P.hg_norm_w[i_ * 512 + 8 * lane + e]; rk[e] = P.rw_r_k[i_ * 512 + 8 * lane + e];
        lw[e] = P.rw_ln_w[i_ * 512 + 8 * lane + e]; lbv[e] = P.rw_ln_b[i_ * 512 + 8 * lane + e];
    }
    for (int r = r0 + blockIdx.x * 8 + wid; r < NROWS; r += gridDim.x * 8) {
        float y[8];
        {
            float a[8], bb[8], g[8];
            unpack8(*(const u32x4*)(Yf + (size_t)r * D + 8 * lane), a); unpack8(*(const u32x4*)(Yb + (size_t)r * D + 8 * lane), bb);
            unpack8(*(const u32x4*)(Pb + (size_t)r * LDP_ODD + 2048 + 8 * lane), g);
            float ss = 0.f;
#pragma unroll
            for (int e = 0; e < 8; ++e) { y[e] = a[e] + bb[e]; ss += y[e] * y[e]; }
            const float rn = rsqrtf(group_sum<16>(ss) * (1.f / 128.f) + 1e-6f);
#pragma unroll
            for (int e = 0; e < 8; ++e) y[e] = y[e] * rn * nwc[e] * siluf_(g[e]);
            *(u32x4*)(feat + (size_t)r * D + 8 * lane) = pack8(y);
        }
        {
            float a[8], bb[8], rr[8], kk[8], vv[8], g[8];
            unpack8(*(const u32x4*)(Yf + (size_t)r * D + 512 + 8 * lane), a); unpack8(*(const u32x4*)(Yb + (size_t)r * D + 512 + 8 * lane), bb);
            unpack8(*(const u32x4*)(R + (size_t)r * 512 + 8 * lane), rr); unpack8(*(const u32x4*)(K + (size_t)r * 512 + 8 * lane), kk);
            unpack8(*(const u32x4*)(V + (size_t)r * 512 + 8 * lane), vv); unpack8(*(const u32x4*)(G + (size_t)r * 512 + 8 * lane), g);
            float s = 0.f, bs = 0.f;
#pragma unroll
            for (int e = 0; e < 8; ++e) { y[e] = a[e] + bb[e]; s += y[e]; bs += rr[e] * kk[e] * rk[e]; }
            const float mean = group_sum<8>(s) * (1.f / 64.f); bs = group_sum<8>(bs);
            float ss = 0.f;
#pragma unroll
            for (int e = 0; e < 8; ++e) { y[e] -= mean; ss += y[e] * y[e]; }
            const float rn = rsqrtf(group_sum<8>(ss) * (1.f / 64.f) + 64e-5f);
#pragma unroll
            for (int e = 0; e < 8; ++e) y[e] = (y[e] * rn * lw[e] + lbv[e] + bs * vv[e]) * g[e];
            *(u32x4*)(feat + (size_t)r * D + 512 + 8 * lane) = pack8(y);
        }
    }
}

#ifndef MK_DOUBLE
#define MK_DOUBLE 0
#endif
#define REP(bit, body) do { body; if (MK_DOUBLE & (bit)) { body; } } while (0)
__device__ __forceinline__ void phase_expconv(KP Pk, int layer, LAS char* lds) {
    asm volatile("" : "+s"(Pk));
    const CAS Params& P = *Pk;
    const int tid = ltid(), lane = tid & 63, wid = tid >> 6;
    {
        LAS float* scr = (LAS float*)(lds + wid * 8448);
        const int gw = blockIdx.x * 8 + wid, NGW = gridDim.x * 8;
        bf16_t* gu = (bf16_t*)(P.ws + WS_EXPGU); bf16_t* dw = (bf16_t*)(P.ws + WS_EXPD);
        constexpr int IG = 16 * 16, IDN = 8 * 32;
        for (int it = gw; it < NEXP * (2 * IG + IDN); it += NGW) {
            const int e = it / (2 * IG + IDN); int r = it % (2 * IG + IDN);
            const size_t eo = (size_t)(layer * NEXP + e);
            if (r < IG) { transpose_item(P.exp_w_gate + eo * D * DEXP, D, DEXP, gu + (size_t)e * 1024 * 1024, 1, scr, r, lane); continue; } r -= IG;
            if (r < IG) { transpose_item(P.exp_w_up + eo * D * DEXP, D, DEXP, gu + (size_t)e * 1024 * 1024, 2, scr, r, lane); continue; } r -= IG;
            transpose_item(P.exp_w_down + eo * DEXP * D, DEXP, D, dw + (size_t)e * 1024 * 512, 0, scr, r, lane);
        }
    }
}
__device__ __forceinline__ void phase_ln1(KP Pk, int layer, LAS char* lds) {
    asm volatile("" : "+s"(Pk));
    const CAS Params& P = *Pk;
    const int tid = ltid(), lane = tid & 63, wid = tid >> 6;
    REP(8, phase_expconv(Pk, layer, lds));
    __syncthreads();
    LAS float* rwT = (LAS float*)lds;
    LAS float* scs = (LAS float*)(lds + 32 * 1024 * 4) + wid * 32;
    LAS int* lcnt = (LAS int*)(lds + 32 * 1024 * 4 + 1024);
    LAS int* lbase = lcnt + 32;
    LAS int* asg = lcnt + 64;
    if (tid < 32) lcnt[tid] = 0;
    for (int i = tid; i < D * NEXP; i += NT) { const int col = i >> 5, e = i & 31; rwT[e * 1024 + col] = P.router_w[i]; }
    __syncthreads();
    const bf16_t* yo = (const bf16_t*)(P.ws + WS_YO);
    bf16_t* act = (bf16_t*)(P.ws + WS_ACT);
    float* xc = (float*)(P.ws + WS_XC);
    int* cnt = (int*)(P.ws + WS_CNT) + layer * 32 * CNT_STRIDE;
    int* list = (int*)(P.ws + WS_LIST);
    float* wts = (float*)(P.ws + WS_WTS);
    const float* lg = P.ln_g + (size_t)(layer * 2 + 0) * D; const float* lb = P.ln_b + (size_t)(layer * 2 + 0) * D;
    const int r0 = (layer == DEPTH - 1) ? NCTX : 0;
    for (int r = r0 + blockIdx.x * 8 + wid; r < NROWS; r += gridDim.x * 8) {
        const int m = row_mod(r);
        float* xr = r < NCTX ? xc + (size_t)r * D : P.out + (size_t)(r - NCTX) * D;
        const float* g1 = modvec(P.ws, layer, m, 2); const float* sh2 = modvec(P.ws, layer, m, 3); const float* sc2 = modvec(P.ws, layer, m, 4);
        f32x4 v[4]; float s = 0.f;
#pragma unroll
        for (int i = 0; i < 4; ++i) {
            const int c = 4 * lane + 256 * i;
            const f32x4 xv = *(const f32x4*)(xr + c), gv = *(const f32x4*)(g1 + c);
            const u32x2 yv = *(const u32x2*)(yo + (size_t)r * D + c);
            v[i][0] = ALPHA * xv[0] + gv[0] * bflo(yv.x); v[i][1] = ALPHA * xv[1] + gv[1] * bfhi(yv.x);
            v[i][2] = ALPHA * xv[2] + gv[2] * bflo(yv.y); v[i][3] = ALPHA * xv[3] + gv[3] * bfhi(yv.y);
            s += (v[i][0] + v[i][1]) + (v[i][2] + v[i][3]);
        }
        const float mean = wave_sum(s) * (1.f / D);
        float s2 = 0.f;
#pragma unroll
        for (int i = 0; i < 4; ++i) { v[i] = v[i] - mean; s2 += (v[i][0] * v[i][0] + v[i][1] * v[i][1]) + (v[i][2] * v[i][2] + v[i][3] * v[i][3]); }
        const float rstd = rsqrtf(wave_sum(s2) * (1.f / D) + 1e-5f);
        float acc[32];
#pragma unroll
        for (int e = 0; e < 32; ++e) acc[e] = 0.f;
#pragma unroll
        for (int i = 0; i < 4; ++i) {
            const int c = 4 * lane + 256 * i;
            const f32x4 gg = *(const f32x4*)(lg + c), bb = *(const f32x4*)(lb + c), s2v = *(const f32x4*)(sc2 + c), h2v = *(const f32x4*)(sh2 + c);
            f32x4 xn, hv;
#pragma unroll
            for (int j = 0; j < 4; ++j) { xn[j] = v[i][j] * rstd * gg[j] + bb[j]; hv[j] = xn[j] * (1.f + s2v[j]) + h2v[j]; }
            *(f32x4*)(xr + c) = xn;
            u32x2 o; o.x = pk2(hv[0], hv[1]); o.y = pk2(hv[2], hv[3]); *(u32x2*)(act + (size_t)r * D + c) = o;
#pragma unroll
            for (int e = 0; e < 32; ++e) { const f32x4 w = *(const LAS f32x4*)(rwT + e * 1024 + c); acc[e] += (hv[0] * w[0] + hv[1] * w[1]) + (hv[2] * w[2] + hv[3] * w[3]); }
        }
#pragma unroll
        for (int st = 0; st < 5; ++st) {
            const int half = 16 >> st, msk = 32 >> st;
            const bool up = (lane & msk) != 0;
#pragma unroll
            for (int j = 0; j < 16; ++j) {
                if (j < half) {
                    const float keep = up ? acc[j + half] : acc[j], send = up ? acc[j] : acc[j + half];
                    acc[j] = keep + __shfl_xor(send, msk);
                }
            }
        }
        acc[0] += __shfl_xor(acc[0], 1);
        {
            const int e = (lane >> 1) & 31;
            const int eidx = ((e >> 4) & 1) * 16 + ((e >> 3) & 1) * 8 + ((e >> 2) & 1) * 4 + ((e >> 1) & 1) * 2 + (e & 1);
            if ((lane & 1) == 0) scs[eidx] = acc[0];
        }
        asm volatile("s_waitcnt lgkmcnt(0)" ::: "memory");
        float best = -1e30f; int bg = 0;
#pragma unroll
        for (int g = 0; g < 8; ++g) {
            float m1 = -1e30f, m2 = -1e30f;
#pragma unroll
            for (int k = 0; k < 4; ++k) { const float vsc = sigmoidf_(scs[g * 4 + k]) + P.router_bias[g * 4 + k]; if (vsc > m1) { m2 = m1; m1 = vsc; } else if (vsc > m2) m2 = vsc; }
            const float gs = m1 + m2;
            if (gs > best) { best = gs; bg = g; }
        }
        float sv[4], bv[4];
#pragma unroll
        for (int k = 0; k < 4; ++k) { sv[k] = sigmoidf_(scs[bg * 4 + k]); bv[k] = sv[k] + P.router_bias[bg * 4 + k]; }
        int i1 = 0; float b1 = bv[0];
#pragma unroll
        for (int k = 1; k < 4; ++k) if (bv[k] > b1) { b1 = bv[k]; i1 = k; }
        int i2 = -1; float b2 = -1e30f;
#pragma unroll
        for (int k = 0; k < 4; ++k) if (k != i1 && bv[k] > b2) { b2 = bv[k]; i2 = k; }
        float s1 = sv[0], s2s = sv[0];
#pragma unroll
        for (int k = 1; k < 4; ++k) { if (i1 == k) s1 = sv[k]; if (i2 == k) s2s = sv[k]; }
        if (lane == 0) {
            const int e0 = bg * 4 + i1, e1 = bg * 4 + i2;
            const float inv = 1.f / (s1 + s2s);
            const int li = ((r - r0 - blockIdx.x * 8 - wid) / (int)(gridDim.x * 8)) * 8 + wid;
            const int p0 = __hip_atomic_fetch_add(&lcnt[e0], 1, __ATOMIC_RELAXED, __HIP_MEMORY_SCOPE_WORKGROUP);
            const int p1 = __hip_atomic_fetch_add(&lcnt[e1], 1, __ATOMIC_RELAXED, __HIP_MEMORY_SCOPE_WORKGROUP);
            asg[2 * li] = (e0 << 16) | p0; asg[2 * li + 1] = (e1 << 16) | p1;
            wts[2 * r] = s1 * inv; wts[2 * r + 1] = s2s * inv;
        }
    }
    __syncthreads();
    if (tid < 32) lbase[tid] = atomicAdd(&cnt[tid * CNT_STRIDE], lcnt[tid]);
    __syncthreads();
    for (int idx = tid; idx < 2 * 136; idx += NT) {
        const int li = idx >> 1, k = idx & 1, it = li >> 3, w = li & 7;
        const int r = r0 + blockIdx.x * 8 + w + it * (int)(gridDim.x * 8);
        if (r < NROWS) { const int v = asg[idx], e = v >> 16, lp = v & 0xffff; list[(size_t)e * LISTCAP + lbase[e] + lp] = 2 * r + k; }
    }
}

__device__ __forceinline__ void phase_ln2(KP Pk, int layer) {
    asm volatile("" : "+s"(Pk));
    const CAS Params& P = *Pk;
    const int tid = ltid(), lane = tid & 63, wid = tid >> 6;
    const bf16_t* yp = (const bf16_t*)(P.ws + WS_YP);
    const float* wts = (const float*)(P.ws + WS_WTS);
    bf16_t* act = (bf16_t*)(P.ws + WS_ACT);
    float* xc = (float*)(P.ws + WS_XC);
    const float* lg = P.ln_g + (size_t)(layer * 2 + 1) * D; const float* lb = P.ln_b + (size_t)(layer * 2 + 1) * D;
    const bool last = (layer == DEPTH - 1);
    const int r0 = last ? NCTX : 0;
    for (int r = r0 + blockIdx.x * 8 + wid; r < NROWS; r += gridDim.x * 8) {
        const int m = row_mod(r);
        float* xr = r < NCTX ? xc + (size_t)r * D : P.out + (size_t)(r - NCTX) * D;
        const float* g2 = modvec(P.ws, layer, m, 5);
        const float w0 = wts[2 * r], w1 = wts[2 * r + 1];
        f32x4 v[4]; float s = 0.f;
#pragma unroll
        for (int i = 0; i < 4; ++i) {
            const int c = 4 * lane + 256 * i;
            const f32x4 xv = *(const f32x4*)(xr + c), gv = *(const f32x4*)(g2 + c);
            const u32x2 y0 = *(const u32x2*)(yp + (size_t)(2 * r) * D + c), y1 = *(const u32x2*)(yp + (size_t)(2 * r + 1) * D + c);
            v[i][0] = ALPHA * xv[0] + gv[0] * (w0 * bflo(y0.x) + w1 * bflo(y1.x)); v[i][1] = ALPHA * xv[1] + gv[1] * (w0 * bfhi(y0.x) + w1 * bfhi(y1.x));
            v[i][2] = ALPHA * xv[2] + gv[2] * (w0 * bflo(y0.y) + w1 * bflo(y1.y)); v[i][3] = ALPHA * xv[3] + gv[3] * (w0 * bfhi(y0.y) + w1 * bfhi(y1.y));
            s += (v[i][0] + v[i][1]) + (v[i][2] + v[i][3]);
        }
        const float mean = wave_sum(s) * (1.f / D);
        float s2 = 0.f;
#pragma unroll
        for (int i = 0; i < 4; ++i) { v[i] = v[i] - mean; s2 += (v[i][0] * v[i][0] + v[i][1] * v[i][1]) + (v[i][2] * v[i][2] + v[i][3] * v[i][3]); }
        const float rstd = rsqrtf(wave_sum(s2) * (1.f / D) + 1e-5f);
        const float* sh1 = last ? lg : modvec(P.ws, layer + 1, m, 0); const float* sc1 = last ? lg : modvec(P.ws, layer + 1, m, 1);
#pragma unroll
        for (int i = 0; i < 4; ++i) {
            const int c = 4 * lane + 256 * i;
            const f32x4 gg = *(const f32x4*)(lg + c), bb = *(const f32x4*)(lb + c);
            f32x4 xn;
#pragma unroll
            for (int j = 0; j < 4; ++j) xn[j] = v[i][j] * rstd * gg[j] + bb[j];
            *(f32x4*)(xr + c) = xn;
            if (!last) {
                const f32x4 s1v = *(const f32x4*)(sc1 + c), h1v = *(const f32x4*)(sh1 + c);
                u32x2 o; o.x = pk2(xn[0] * (1.f + s1v[0]) + h1v[0], xn[1] * (1.f + s1v[1]) + h1v[1]); o.y = pk2(xn[2] * (1.f + s1v[2]) + h1v[2], xn[3] * (1.f + s1v[3]) + h1v[3]);
                *(u32x2*)(act + (size_t)r * D + c) = o;
            }
        }
    }
}

constexpr int NPHASE = 2 + 10 * DEPTH;
__global__ void __launch_bounds__(NT, 2) fwd_kernel(Params P) {
    extern __shared__ __attribute__((aligned(16))) char lds_raw[];
    LAS char* lds = (LAS char*)lds_raw;
    volatile LAS unsigned* xbw = (volatile LAS unsigned*)(lds + LDS_BYTES - 16);
    KP Pk = (KP)__builtin_amdgcn_kernarg_segment_ptr();
    const bool multi = (P.ph_hi - P.ph_lo) > 1;
    XcdBarrier bar; bar.bar = (unsigned*)(P.ws + WS_BAR); bar.x = 0; bar.st = xbw;
    if (multi) {
        if (threadIdx.x == 0) { xbw[0] = 0u; xbw[1] = 0u; xbw[2] = 0u; xbw[3] = 0u; }
        __syncthreads();
        bar = xcd_barrier_post((unsigned*)(P.ws + WS_BAR), xbw);
    }
#define PHASE(id, body) do { if (P.ph_lo <= (id) && (id) < P.ph_hi) { body; if ((id) + 1 < P.ph_hi) xcd_barrier(bar); } } while (0)
    PHASE(0, REP(16, phase_prologue0(Pk, lds)));
    PHASE(1, REP(16, phase_prologue1(Pk)));
    for (int l = 0; l < DEPTH; ++l) {
        const int pb = 2 + 10 * l, odd = l & 1;
        PHASE(pb + 0, REP(1, phase_inproj(Pk, l, lds)));
        if (odd) {
            PHASE(pb + 1, REP(4, phase_prep1(Pk, l)));
            PHASE(pb + 2, phase_prep2(Pk, l, lds));
            PHASE(pb + 3, REP(32, { if (blockIdx.x < 128) REP(64, scan_hgrn_c(Pk, l, blockIdx.x, lds)); else if (blockIdx.x < 256) REP(128, scan_rwkv(Pk, l, blockIdx.x - 128, lds)); }));
            PHASE(pb + 4, REP(4, phase_out_odd(Pk, l)));
        } else {
            PHASE(pb + 1, REP(4, phase_prep_even(Pk, l)));
            PHASE(pb + 3, REP(2, { if (blockIdx.x < 128) scan_ssd_c(Pk, l, blockIdx.x, lds); else if (blockIdx.x < 256) scan_mlstm_c(Pk, l, blockIdx.x - 128, lds); }));
            PHASE(pb + 4, REP(4, phase_out_even(Pk, l)));
        }
        PHASE(pb + 5, REP(256, phase_outproj(Pk, l, lds)));
        PHASE(pb + 6, phase_ln1(Pk, l, lds));
        PHASE(pb + 7, REP(512, phase_moe1(Pk, l, lds)));
        PHASE(pb + 8, REP(1024, phase_moe2(Pk, l, lds)));
        PHASE(pb + 9, phase_ln2(Pk, l));
    }
#undef PHASE
}


#ifndef MK_STOP
#define MK_STOP NPHASE
#endif
#ifndef MK_DUMP
#define MK_DUMP 0
#endif
#ifndef MK_DUMP_N
#define MK_DUMP_N (1u << 30)
#endif
#ifndef MK_DUMP_LD
#define MK_DUMP_LD 1024
#endif
#ifndef MK_DUMP_C0
#define MK_DUMP_C0 0
#endif
__global__ void diff_kernel(const bf16_t* a, const bf16_t* b, float* out, size_t n) {
    for (size_t i = (size_t)blockIdx.x * blockDim.x + threadIdx.x; i < n; i += (size_t)gridDim.x * blockDim.x) out[i] = 1e6f * (bf2f(a[i]) - bf2f(b[i]));
}
__global__ void dump_kernel(const bf16_t* src, float* out, size_t n) {
    for (size_t i = (size_t)blockIdx.x * blockDim.x + threadIdx.x; i < n; i += (size_t)gridDim.x * blockDim.x) out[i] = i < (size_t)MK_DUMP_N ? bf2f(src[(i >> 10) * MK_DUMP_LD + MK_DUMP_C0 + (i & 1023)]) : 0.f;
}
extern "C" void kernel_launch(void* const* d_in, const int* in_sizes, int n_in, void* d_out, int out_size, void* d_ws, size_t ws_size, hipStream_t stream) {
    static int ready = 0;
    if (ready == 0) {
        ready = 1;
        if (n_in != 42 || out_size != NB * SEQ * D || ws_size < WS_END) { fprintf(stderr, "kernel_launch: unexpected shapes (n_in %d out %d ws %zu need %zu)\n", n_in, out_size, ws_size, (size_t)WS_END); ready = -1; }
        if (hipFuncSetAttribute((const void*)fwd_kernel, hipFuncAttributeMaxDynamicSharedMemorySize, LDS_BYTES) != hipSuccess) { fprintf(stderr, "kernel_launch: hipFuncSetAttribute failed\n"); ready = -1; }
    }
    if (ready < 0) return;
    (void)in_sizes;
    hipMemsetAsync((char*)d_ws + WS_BAR, 0, WS_ZERO_BYTES, stream);
    Params p;
    memset(&p, 0, sizeof(p));
    const float** fp = (const float**)&p;
    for (int i = 0; i < 42; ++i) fp[i] = (const float*)d_in[i];
    p.out = (float*)d_out; p.ws = (unsigned char*)d_ws;
#if MK_PER_PHASE
    for (int ph = 0; ph < MK_STOP; ++ph) {
        const int local = ph < 2 ? -1 : (ph - 2) % 10, layer = ph < 2 ? 0 : (ph - 2) / 10;
        if (local == 2 && !(layer & 1)) continue;
        p.ph_lo = ph; p.ph_hi = ph + 1;
        hipLaunchKernelGGL(fwd_kernel, dim3(256), dim3(NT), LDS_BYTES, stream, p);
    }
#ifdef MK_DIFF
    p.ph_lo = 7; p.ph_hi = 8; p.dbg = 1;
    hipLaunchKernelGGL(fwd_kernel, dim3(256), dim3(NT), LDS_BYTES, stream, p);
    hipLaunchKernelGGL(diff_kernel, dim3(1024), dim3(256), 0, stream, (const bf16_t*)((unsigned char*)d_ws + WS_YO), (const bf16_t*)((unsigned char*)d_ws + WS_HID), (float*)d_out, (size_t)NB * SEQ * D);
#else
    if (MK_DUMP) hipLaunchKernelGGL(dump_kernel, dim3(1024), dim3(256), 0, stream, (const bf16_t*)((unsigned char*)d_ws + (size_t)MK_DUMP), (float*)d_out, (size_t)NB * SEQ * D);
#endif
#else
    p.ph_lo = 0; p.ph_hi = NPHASE;
    hipLaunchKernelGGL(fwd_kernel, dim3(256), dim3(NT), LDS_BYTES, stream, p);
#endif
}
```

```cpp
#include <hip/hip_runtime.h>
#include <stdint.h>
#include <stdio.h>
#include <string.h>

#ifndef MK_PER_PHASE
#define MK_PER_PHASE 0
#endif

typedef unsigned short bf16_t;
typedef short bf16x8 __attribute__((ext_vector_type(8)));
typedef float f32x4 __attribute__((ext_vector_type(4)));
typedef unsigned u32x4 __attribute__((ext_vector_type(4)));
typedef unsigned u32x2 __attribute__((ext_vector_type(2)));
#define LAS __attribute__((address_space(3)))
#define CAS __attribute__((address_space(4)))

constexpr int D = 1024, NB = 4, SEQ = 8192, CTXL = 256, DEPTH = 4;
constexpr int NCTX = NB * CTXL;
constexpr int NROWS = NCTX + NB * SEQ;
constexpr int P_EVEN = 2848, P_ODD = 4416, LDP_EVEN = 3072, LDP_ODD = 4608;
constexpr int NEXP = 32, DEXP = 512, LISTCAP = NROWS;
constexpr float ALPHA = 1.681792830507429f;
constexpr int NT = 512;
constexpr int TCH = 32;
constexpr int NSTEPS = CTXL + SEQ;
constexpr int LDS_BYTES = 160 * 1024;

constexpr size_t al256(size_t x) { return (x + 255) & ~(size_t)255; }
constexpr size_t WS_BAR = 0;
constexpr size_t WS_CNT = 16384;
constexpr int CNT_STRIDE = 64;
constexpr size_t WS_ZERO_BYTES = 16384 + (size_t)4 * 32 * CNT_STRIDE * 4;
constexpr size_t WS_MODV = al256(WS_ZERO_BYTES);
constexpr size_t WS_LB = WS_MODV + al256((size_t)4 * 5 * 6144 * 4);
constexpr size_t WS_XC = WS_LB + al256(4 * 512 * 4);
constexpr size_t WS_WTS = WS_XC + (size_t)NCTX * D * 4;
constexpr size_t WS_LIST = WS_WTS + al256((size_t)2 * NROWS * 4);
constexpr size_t WS_WINT = WS_LIST + al256((size_t)NEXP * LISTCAP * 4);
constexpr size_t WINT_L0 = 0, WINT_L1 = (size_t)LDP_EVEN * D, WINT_L2 = WINT_L1 + (size_t)LDP_ODD * D, WINT_L3 = WINT_L2 + (size_t)LDP_EVEN * D, WINT_END = WINT_L3 + (size_t)LDP_ODD * D;
constexpr size_t WS_WOUTT = WS_WINT + WINT_END * 2;
constexpr size_t WS_LORAT = WS_WOUTT + (size_t)4 * D * D * 2;
constexpr size_t LORA_PER = (size_t)512 * 320;
constexpr size_t WS_EXPGU = WS_LORAT + al256(2 * LORA_PER * 2);
constexpr size_t WS_EXPD = WS_EXPGU + (size_t)NEXP * 1024 * 1024 * 2;
constexpr size_t WS_ACT = WS_EXPD + (size_t)NEXP * 1024 * 512 * 2;
constexpr size_t ROWB = (size_t)NROWS * D * 2;
constexpr size_t WS_FEAT = WS_ACT + ROWB;
constexpr size_t WS_YF = WS_FEAT + ROWB;
constexpr size_t WS_YB = WS_YF + ROWB;
constexpr size_t WS_P = WS_YB + ROWB;
constexpr size_t P_BYTES = (size_t)NROWS * LDP_ODD * 2;
constexpr size_t WS_YO = WS_P;
constexpr size_t WS_HID = WS_P + ROWB;
constexpr size_t WS_YP = WS_HID + ROWB;
static_assert(WS_YP + 2 * ROWB <= WS_P + P_BYTES, "MoE buffers must fit in the P region");
constexpr size_t HALFB = (size_t)NROWS * 512 * 2;
constexpr size_t WS_RWR = WS_P + P_BYTES;
constexpr size_t WS_RWK = WS_RWR + HALFB;
constexpr size_t WS_RWV = WS_RWK + HALFB;
constexpr size_t WS_RWKK = WS_RWV + HALFB;
constexpr size_t WS_RWB = WS_RWKK + HALFB;
constexpr size_t WS_RWG = WS_RWB + HALFB;
constexpr size_t WS_RWDEC = WS_RWG + HALFB;
constexpr size_t WS_LA = WS_RWDEC + (size_t)2 * NROWS * 512 * 4;
constexpr size_t WS_END = WS_LA + (size_t)NROWS * 320 * 2;
static_assert(WS_END <= (size_t)280602384 * 4, "workspace map exceeds the guaranteed ws_size");

struct Params {
    const float *x, *c, *ctx, *c_ctx, *mod_w, *mod_b, *ln_g, *ln_b;
    const float *ev_w_in, *ev_w_out, *ssd_conv_w, *ssd_conv_b, *ssd_dt_bias, *ssd_a_log, *ssd_d, *ssd_norm_w;
    const float *ml_conv_w, *ml_conv_b, *ml_i_bias, *ml_f_bias, *ml_norm_w;
    const float *od_w_in, *od_w_out, *hg_lb_logits, *hg_f_bias, *hg_norm_w;
    const float *rw_mu, *rw_w0, *rw_w2, *rw_a0, *rw_a2, *rw_g2, *rw_k_k, *rw_k_a, *rw_r_k, *rw_ln_w, *rw_ln_b;
    const float *router_w, *router_bias, *exp_w_gate, *exp_w_up, *exp_w_down;
    float* out;
    unsigned char* ws;
    int ph_lo, ph_hi, dbg, pad_;
};
typedef const CAS Params* KP;

__device__ __forceinline__ int ltid() { int t = threadIdx.x; asm volatile("" : "+v"(t)); return t; }
__device__ __forceinline__ float bf2f(bf16_t h) { return __uint_as_float(((unsigned)h) << 16); }
__device__ __forceinline__ float bflo(unsigned u) { return __uint_as_float(u << 16); }
__device__ __forceinline__ float bfhi(unsigned u) { return __uint_as_float(u & 0xffff0000u); }
typedef __bf16 bf16v2_t __attribute__((ext_vector_type(2)));
typedef float f32x2 __attribute__((ext_vector_type(2)));
__device__ __forceinline__ unsigned pk2(float lo, float hi) { const f32x2 v = {lo, hi}; return __builtin_bit_cast(unsigned, __builtin_convertvector(v, bf16v2_t)); }
__device__ __forceinline__ bf16_t f2bf(float f) { return (bf16_t)(pk2(f, 0.f) & 0xffffu); }
__device__ __forceinline__ void unpack8(const u32x4& u, float* f) {
    f[0] = bflo(u.x); f[1] = bfhi(u.x); f[2] = bflo(u.y); f[3] = bfhi(u.y); f[4] = bflo(u.z); f[5] = bfhi(u.z); f[6] = bflo(u.w); f[7] = bfhi(u.w);
}
__device__ __forceinline__ u32x4 pack8(const float* f) { u32x4 u; u.x = pk2(f[0], f[1]); u.y = pk2(f[2], f[3]); u.z = pk2(f[4], f[5]); u.w = pk2(f[6], f[7]); return u; }
__device__ __forceinline__ float sigmoidf_(float x) { return 1.f / (1.f + __expf(-x)); }
__device__ __forceinline__ float siluf_(float x) { return x / (1.f + __expf(-x)); }
__device__ __forceinline__ float softplusf_(float x) { return x > 20.f ? x : log1pf(__expf(x)); }
__device__ __forceinline__ float logsigmoidf_(float x) { return fminf(x, 0.f) - log1pf(__expf(-fabsf(x))); }
__device__ __forceinline__ float wave_sum(float v) {
#pragma unroll
    for (int o = 1; o < 64; o <<= 1) v += __shfl_xor(v, o);
    return v;
}
template <int W> __device__ __forceinline__ float group_sum(float v) {
#pragma unroll
    for (int o = 1; o < W; o <<= 1) v += __shfl_xor(v, o);
    return v;
}
template <int CTRL> __device__ __forceinline__ float dppmov(float v) {
    return __builtin_bit_cast(float, __builtin_amdgcn_update_dpp(0, __builtin_bit_cast(int, v), CTRL, 0xf, 0xf, true));
}
__device__ __forceinline__ float allreduce16(float v) {
    v += dppmov<0xB1>(v);
    v += dppmov<0x4E>(v);
    v += dppmov<0x141>(v);
    v += dppmov<0x140>(v);
    return v;
}

#define XB_TMO      128
#define XB_XCNT(j)  (256  + 64 * (j))
#define XB_XSUB(j)  (1280 + 64 * (j))
#define XB_XGEN(j)  (2304 + 64 * (j))
#define XB_TOP      3328
#define XB_TOPGEN   3392
#define XCD_BAR_WORDS 3456
#define XB_SPIN_CAP (1u << 22)
__device__ __forceinline__ unsigned xb_ld(unsigned* p)              { return __hip_atomic_load(p, __ATOMIC_RELAXED, __HIP_MEMORY_SCOPE_AGENT); }
__device__ __forceinline__ unsigned xb_add(unsigned* p, unsigned v) { return __hip_atomic_fetch_add(p, v, __ATOMIC_RELAXED, __HIP_MEMORY_SCOPE_AGENT); }
__device__ __forceinline__ unsigned xb_xcc_id() { return (unsigned)__builtin_amdgcn_s_getreg((3 << 11) | 20) & 0xFu; }
#define XB_SPIN(cond, bar) do { unsigned _sp = 0; while (cond) { __builtin_amdgcn_s_sleep(1); \
    if ((++_sp & 255u) == 0u) { if (xb_ld(&(bar)[XB_TMO])) break; if (_sp > XB_SPIN_CAP) { atomicAdd(&(bar)[XB_TMO], 1u); break; } } } } while (0)
struct XcdBarrier { unsigned* bar; unsigned x; volatile LAS unsigned* st; };
__device__ __forceinline__ XcdBarrier xcd_barrier_post(unsigned* bar, volatile LAS unsigned* st) {
    XcdBarrier b; b.bar = bar; b.x = xb_xcc_id(); b.st = st;
    if (threadIdx.x == 0) (void)xb_add(&bar[XB_XCNT(b.x)], 1u);
    return b;
}
__device__ __forceinline__ void xcd_barrier_complete(unsigned* bar, unsigned x, unsigned& nloc, unsigned& nx) {
    const unsigned G = gridDim.x * gridDim.y * gridDim.z;
    unsigned sum, cnt, mine, sp = 0u;
    for (;;) {
        sum = 0u; cnt = 0u; mine = 0u;
#pragma unroll
        for (unsigned j = 0; j < 16; ++j) { const unsigned c = xb_ld(&bar[XB_XCNT(j)]); sum += c; cnt += (c > 0u) ? 1u : 0u; mine = (j == x) ? c : mine; }
        if (sum == G) break;
        __builtin_amdgcn_s_sleep(1);
        if ((++sp & 255u) == 0u) { if (xb_ld(&bar[XB_TMO])) break; if (sp > XB_SPIN_CAP) { atomicAdd(&bar[XB_TMO], 1u); break; } }
    }
    nloc = mine > 0u ? mine : 1u; nx = cnt > 0u ? cnt : 1u;
}
__device__ __forceinline__ void xcd_barrier(const XcdBarrier& b) {
    asm volatile("s_waitcnt vmcnt(0)" ::: "memory");
    __syncthreads();
    if (threadIdx.x == 0) {
        unsigned* bar = b.bar;
        __builtin_amdgcn_s_waitcnt(0);
        unsigned nloc = b.st[0], nx = b.st[1];
        if (nloc == 0u) { xcd_barrier_complete(bar, b.x, nloc, nx); b.st[0] = nloc; b.st[1] = nx; }
        const unsigned old = xb_add(&bar[XB_XSUB(b.x)], 1u);
        const unsigned gen = old / nloc;
        if (old + 1u == (gen + 1u) * nloc) {
            __builtin_amdgcn_fence(__ATOMIC_RELEASE, "agent");
            asm volatile("s_waitcnt vmcnt(0)" ::: "memory");
            const unsigned og = xb_add(&bar[XB_TOP], 1u);
            const unsigned tg = og / nx;
            if (og + 1u == (tg + 1u) * nx) xb_add(&bar[XB_TOPGEN], 1u);
            else XB_SPIN(xb_ld(&bar[XB_TOPGEN]) == tg, bar);
            __builtin_amdgcn_fence(__ATOMIC_ACQUIRE, "agent");
            xb_add(&bar[XB_XGEN(b.x)], 1u);
            asm volatile("s_waitcnt vmcnt(0)" ::: "memory");
        } else {
            XB_SPIN(xb_ld(&bar[XB_XGEN(b.x)]) == gen, bar);
            __builtin_amdgcn_fence(__ATOMIC_ACQUIRE, "agent");
            asm volatile("s_waitcnt vmcnt(0)" ::: "memory");
        }
    }
    __syncthreads();
}

__device__ __forceinline__ int row_mod(int r) { return r < NCTX ? 4 : ((r - NCTX) >> 13); }
__device__ __forceinline__ void row_seg(int r, int& t, int& len) { if (r < NCTX) { t = r & 255; len = CTXL; } else { t = (r - NCTX) & 8191; len = SEQ; } }
__device__ __forceinline__ int scan_row(int tg, int b, int dir, int odd) {
    if (tg < CTXL) { const int t = dir ? (CTXL - 1 - tg) : tg; return b * CTXL + t; }
    int sg = tg - CTXL; if (dir) sg = SEQ - 1 - sg;
    const int s = odd ? (((sg & 127) << 6) + (sg >> 7)) : sg;
    return NCTX + b * SEQ + s;
}
__device__ __forceinline__ const float* modvec(const unsigned char* ws, int layer, int m, int which) {
    return (const float*)(ws + WS_MODV) + ((size_t)(layer * 5 + m) * 6 + which) * D;
}

constexpr int G_BM = 256, G_BN = 128, G_BK = 64;
constexpr int G_ABYTES = G_BM * G_BK * 2, G_BBYTES = G_BN * G_BK * 2, G_BUF = G_ABYTES + G_BBYTES;
__device__ __forceinline__ int swz(int o) { return o ^ (((o >> 9) & 1) << 5); }

template <class RowSrc, class Epi>
__device__ __forceinline__ void gemm_tile(const bf16_t* __restrict__ A, int lda, const RowSrc& rs, const bf16_t* __restrict__ Bt, int ldb, int n0, int K, const Epi& epi, LAS char* lds) {
    const int tid = ltid(), lane = tid & 63, wid = tid >> 6, wm = wid >> 1, wn = wid & 1;
    const bf16_t* ap[4]; int aoff[4];
#pragma unroll
    for (int i = 0; i < 4; ++i) {
        const int c = tid + NT * i, row = c >> 3, kc = c & 7;
        ap[i] = A + (size_t)rs.src(row) * lda + kc * 8;
        aoff[i] = ((row >> 4) * 2 + (kc >> 2)) * 1024 + swz((row & 15) * 64 + (kc & 3) * 16);
    }
    const bf16_t* bp[2]; int boff[2];
#pragma unroll
    for (int i = 0; i < 2; ++i) {
        const int c = tid + NT * i, row = c >> 3, kc = c & 7;
        bp[i] = Bt + (size_t)(n0 + row) * ldb + kc * 8;
        boff[i] = G_ABYTES + ((row >> 4) * 2 + (kc >> 2)) * 1024 + swz((row & 15) * 64 + (kc & 3) * 16);
    }
    f32x4 acc[4][4];
#pragma unroll
    for (int i = 0; i < 4; ++i)
#pragma unroll
        for (int j = 0; j < 4; ++j) acc[i][j] = (f32x4){0.f, 0.f, 0.f, 0.f};
    u32x4 ra[2][4], rb[2][2];
    const int KT = K / G_BK;
    const int fragoff = swz((lane & 15) * 64 + (lane >> 4) * 16);
#define G_LOAD(set, kt_) do { _Pragma("unroll") for (int i = 0; i < 4; ++i) ra[set][i] = *(const u32x4*)(ap[i] + (kt_) * G_BK); \
                              _Pragma("unroll") for (int i = 0; i < 2; ++i) rb[set][i] = *(const u32x4*)(bp[i] + (kt_) * G_BK); } while (0)
#define G_STORE(set, buf) do { _Pragma("unroll") for (int i = 0; i < 4; ++i) *(LAS u32x4*)((buf) + aoff[i]) = ra[set][i]; \
                               _Pragma("unroll") for (int i = 0; i < 2; ++i) *(LAS u32x4*)((buf) + boff[i]) = rb[set][i]; } while (0)
#define G_COMPUTE(cur) do { bf16x8 af[2][4], bfr[2][4]; \
        _Pragma("unroll") for (int ks = 0; ks < 2; ++ks) { \
            _Pragma("unroll") for (int ni = 0; ni < 4; ++ni) bfr[ks][ni] = *(LAS bf16x8*)((cur) + G_ABYTES + ((wn * 4 + ni) * 2 + ks) * 1024 + fragoff); \
            _Pragma("unroll") for (int mi = 0; mi < 4; ++mi) af[ks][mi] = *(LAS bf16x8*)((cur) + ((wm * 4 + mi) * 2 + ks) * 1024 + fragoff); } \
        __builtin_amdgcn_sched_barrier(0); \
        _Pragma("unroll") for (int ks = 0; ks < 2; ++ks) _Pragma("unroll") for (int mi = 0; mi < 4; ++mi) _Pragma("unroll") for (int ni = 0; ni < 4; ++ni) \
            acc[mi][ni] = __builtin_amdgcn_mfma_f32_16x16x32_bf16(bfr[ks][ni], af[ks][mi], acc[mi][ni], 0, 0, 0); \
        __builtin_amdgcn_sched_barrier(0); } while (0)
    G_LOAD(0, 0);
    G_STORE(0, lds);
    if (KT > 1) G_LOAD(0, 1);
    if (KT > 2) G_LOAD(1, 2);
    __syncthreads();
    for (int kt = 0; kt < KT; kt += 2) {
        G_COMPUTE(lds);
        if (kt + 1 < KT) G_STORE(0, lds + G_BUF);
        if (kt + 3 < KT) G_LOAD(0, kt + 3);
        __syncthreads();
        if (kt + 1 < KT) {
            G_COMPUTE(lds + G_BUF);
            if (kt + 2 < KT) G_STORE(1, lds);
            if (kt + 4 < KT) G_LOAD(1, kt + 4);
            __syncthreads();
        }
    }
#undef G_LOAD
#undef G_STORE
#undef G_COMPUTE
    epi(acc, wm * 64 + (lane & 15), wn * 64 + 4 * (lane >> 4));
}

constexpr int G2_BN = 256, G2_BBYTES = G2_BN * G_BK * 2, G2_BUF = G_ABYTES + G2_BBYTES;
template <class RowSrc, class Epi>
__device__ __forceinline__ void gemm_tile256(const bf16_t* __restrict__ A, int lda, const RowSrc& rs, const bf16_t* __restrict__ Bt, int ldb, int n0, int K, const Epi& epi, LAS char* lds) {
    const int tid = ltid(), lane = tid & 63, wid = tid >> 6, wm = wid >> 1, wn = wid & 1;
    const int r0 = tid >> 3, kc = tid & 7;
    const int aoff0 = ((r0 >> 4) * 2 + (kc >> 2)) * 1024 + swz((r0 & 15) * 64 + (kc & 3) * 16);
    int aeo[4];
#pragma unroll
    for (int i = 0; i < 4; ++i) aeo[i] = rs.src(r0 + 64 * i) * lda + kc * 8;
    const bf16_t* bp0 = Bt + (size_t)(n0 + r0) * ldb + kc * 8;
    const int bstep = 64 * ldb;
    f32x4 acc[4][8];
#pragma unroll
    for (int i = 0; i < 4; ++i)
#pragma unroll
        for (int j = 0; j < 8; ++j) acc[i][j] = (f32x4){0.f, 0.f, 0.f, 0.f};
    u32x4 ra[4], rb[4];
#pragma unroll
    for (int i = 0; i < 4; ++i) { ra[i] = *(const u32x4*)(A + aeo[i]); rb[i] = *(const u32x4*)(bp0 + i * bstep); }
#pragma unroll
    for (int i = 0; i < 4; ++i) { *(LAS u32x4*)(lds + aoff0 + i * 8192) = ra[i]; *(LAS u32x4*)(lds + G_ABYTES + aoff0 + i * 8192) = rb[i]; }
    __syncthreads();
    const int KT = K / G_BK;
    const int fragoff = swz((lane & 15) * 64 + (lane >> 4) * 16);
    for (int kt = 0; kt < KT; ++kt) {
        LAS char* cur = lds + (kt & 1) * G2_BUF;
        LAS char* nxt = lds + ((kt + 1) & 1) * G2_BUF;
        const bool more = (kt + 1 < KT);
        if (more) {
#pragma unroll
            for (int i = 0; i < 4; ++i) { ra[i] = *(const u32x4*)(A + aeo[i] + (kt + 1) * G_BK); rb[i] = *(const u32x4*)(bp0 + i * bstep + (kt + 1) * G_BK); }
        }
#pragma unroll
        for (int ks = 0; ks < 2; ++ks) {
            bf16x8 af[4];
#pragma unroll
            for (int mi = 0; mi < 4; ++mi) af[mi] = *(LAS bf16x8*)(cur + ((wm * 4 + mi) * 2 + ks) * 1024 + fragoff);
#pragma unroll
            for (int nh = 0; nh < 2; ++nh) {
                bf16x8 bfr[4];
#pragma unroll
                for (int ni = 0; ni < 4; ++ni) bfr[ni] = *(LAS bf16x8*)(cur + G_ABYTES + ((wn * 8 + nh * 4 + ni) * 2 + ks) * 1024 + fragoff);
                __builtin_amdgcn_sched_barrier(0);
#pragma unroll
                for (int mi = 0; mi < 4; ++mi)
#pragma unroll
                    for (int ni = 0; ni < 4; ++ni) acc[mi][nh * 4 + ni] = __builtin_amdgcn_mfma_f32_16x16x32_bf16(bfr[ni], af[mi], acc[mi][nh * 4 + ni], 0, 0, 0);
                __builtin_amdgcn_sched_barrier(0);
            }
        }
        if (more) {
#pragma unroll
            for (int i = 0; i < 4; ++i) { *(LAS u32x4*)(nxt + aoff0 + i * 8192) = ra[i]; *(LAS u32x4*)(nxt + G_ABYTES + aoff0 + i * 8192) = rb[i]; }
        }
        __syncthreads();
    }
    epi(acc, wm * 64 + (lane & 15), wn * 128 + 4 * (lane >> 4));
}

struct RowLinear { int m0; __device__ __forceinline__ int src(int r) const { return m0 + r; } };
struct RowList {
    const int* list; int cnt; int shift;
    __device__ __forceinline__ int src(int r) const { const int a = list[r < cnt ? r : 0]; return a >> shift; }
};
struct EpiStoreBf16 {
    bf16_t* C; int ldc; int m0; int n0; int N;
    template <int NI> __device__ __forceinline__ void operator()(const f32x4 (&acc)[4][NI], int rbase, int cbase) const {
#pragma unroll
        for (int mi = 0; mi < 4; ++mi) {
            bf16_t* rowp = C + (size_t)(m0 + rbase + mi * 16) * ldc + n0 + cbase;
#pragma unroll
            for (int ni = 0; ni < NI; ++ni) {
                if (n0 + cbase + ni * 16 < N) { u32x2 v; v.x = pk2(acc[mi][ni][0], acc[mi][ni][1]); v.y = pk2(acc[mi][ni][2], acc[mi][ni][3]); *(u32x2*)(rowp + ni * 16) = v; }
            }
        }
    }
};
struct EpiSwiGLU {
    bf16_t* H; const int* list; int cnt; int n0;
    template <int NI> __device__ __forceinline__ void operator()(const f32x4 (&acc)[4][NI], int rbase, int cbase) const {
#pragma unroll
        for (int mi = 0; mi < 4; ++mi) {
            const int r = rbase + mi * 16;
            if (r < cnt) {
                const int a = list[r];
                const int wnb = cbase & ~63, q4 = cbase & 63;
                bf16_t* rowp = H + (size_t)a * DEXP + ((n0 + wnb) >> 1) + q4;
#pragma unroll
                for (int q = 0; q < NI / 2; ++q) {
                    float o[4];
#pragma unroll
                    for (int j = 0; j < 4; ++j) o[j] = siluf_(acc[mi][2 * q][j]) * acc[mi][2 * q + 1][j];
                    u32x2 v; v.x = pk2(o[0], o[1]); v.y = pk2(o[2], o[3]); *(u32x2*)(rowp + q * 16) = v;
                }
            }
        }
    }
};
struct EpiScatterBf16 {
    bf16_t* C; const int* list; int cnt; int n0;
    template <int NI> __device__ __forceinline__ void operator()(const f32x4 (&acc)[4][NI], int rbase, int cbase) const {
#pragma unroll
        for (int mi = 0; mi < 4; ++mi) {
            const int r = rbase + mi * 16;
            if (r < cnt) {
                bf16_t* rowp = C + (size_t)list[r] * D + n0 + cbase;
#pragma unroll
                for (int ni = 0; ni < NI; ++ni) { u32x2 v; v.x = pk2(acc[mi][ni][0], acc[mi][ni][1]); v.y = pk2(acc[mi][ni][2], acc[mi][ni][3]); *(u32x2*)(rowp + ni * 16) = v; }
            }
        }
    }
};
struct EpiDecay {
    float* Dc; const float* w0; int m0; int n0;
    template <int NI> __device__ __forceinline__ void operator()(const f32x4 (&acc)[4][NI], int rbase, int cbase) const {
#pragma unroll
        for (int ni = 0; ni < NI; ++ni) {
            const int col = n0 + cbase + ni * 16;
            const f32x4 w0v = *(const f32x4*)(w0 + col);
#pragma unroll
            for (int mi = 0; mi < 4; ++mi) {
                f32x4 o;
#pragma unroll
                for (int j = 0; j < 4; ++j) { const float w = w0v[j] + acc[mi][ni][j]; o[j] = __expf(-__expf(-softplusf_(-w) - 0.5f)); }
                *(f32x4*)(Dc + (size_t)(m0 + rbase + mi * 16) * 512 + col) = o;
            }
        }
    }
};
struct EpiAK {
    bf16_t* Kb; const bf16_t* KKb; bf16_t* Bb; const float* a0; const float* k_a; int m0; int n0;
    template <int NI> __device__ __forceinline__ void operator()(const f32x4 (&acc)[4][NI], int rbase, int cbase) const {
#pragma unroll
        for (int ni = 0; ni < NI; ++ni) {
            const int col = n0 + cbase + ni * 16;
            const f32x4 a0v = *(const f32x4*)(a0 + col), kav = *(const f32x4*)(k_a + col);
#pragma unroll
            for (int mi = 0; mi < 4; ++mi) {
                const size_t off = (size_t)(m0 + rbase + mi * 16) * 512 + col;
                const u32x2 kr = *(const u32x2*)(Kb + off), kkr = *(const u32x2*)(KKb + off);
                const float kf[4] = {bflo(kr.x), bfhi(kr.x), bflo(kr.y), bfhi(kr.y)}, kkf[4] = {bflo(kkr.x), bfhi(kkr.x), bflo(kkr.y), bfhi(kkr.y)};
                float k2[4], bb[4];
#pragma unroll
                for (int j = 0; j < 4; ++j) { const float a = sigmoidf_(a0v[j] + acc[mi][ni][j]); k2[j] = kf[j] * (1.f + (a - 1.f) * kav[j]); bb[j] = kkf[j] * a; }
                u32x2 v; v.x = pk2(k2[0], k2[1]); v.y = pk2(k2[2], k2[3]); *(u32x2*)(Kb + off) = v;
                v.x = pk2(bb[0], bb[1]); v.y = pk2(bb[2], bb[3]); *(u32x2*)(Bb + off) = v;
            }
        }
    }
};

namespace pg8 {
#define PG8_LAS __attribute__((address_space(3)))
constexpr int BM = 256, BK = 64, HALF = 128, HTB = HALF * BK * 2, STAGE_BYTES = 8 * HTB, NXCD = 8, WGM = 8;
__host__ __device__ __forceinline__ int lds_byte(int r, int c) { const int st = (r >> 4) * 2 + (c >> 5), rr = r & 15, cc = c & 31, ob = rr * 64 + cc * 2; return st * 1024 + (ob ^ (((ob >> 9) & 1) << 5)); }
__host__ __device__ __forceinline__ void stage_rc(int b, int& R, int& C) { const int st = b / 1024, sb = b % 1024, swz = sb ^ (((sb >> 9) & 1) << 5); R = (st >> 1) * 16 + swz / 64; C = (st & 1) * 32 + (swz % 64) / 2; }
__host__ __device__ __forceinline__ int perm32(int rho) { const int n = rho >> 4, i = rho & 15; return 8 * (i >> 2) + 4 * n + (i & 3); }
struct Unit { int pm, pn; };
struct Gemm { const bf16_t* A; const bf16_t* Bt; int M, N, K; };
struct StaticOrder {
    int nM, nN, nwg, G, c;
    __host__ __device__ void init(int M, int N, int G_, int c_) { nM = M / BM; nN = N / BM; nwg = nM * nN; G = G_; c = c_; }
    __host__ __device__ bool next(int i, Unit& u) const {
        const long L = (long)i * G + c; if (L >= nwg) return false;
        int wgid = (int)L; { const int q = nwg / NXCD, r = nwg % NXCD, xcd = wgid % NXCD, off = wgid / NXCD; wgid = (xcd < r ? xcd * (q + 1) : r * (q + 1) + (xcd - r) * q) + off; }
        const int nig = WGM * nN, gid = wgid / nig, fm = gid * WGM, gsz = (nM - fm) < WGM ? (nM - fm) : WGM;
        u.pm = fm + ((wgid % nig) % gsz); u.pn = (wgid % nig) / gsz; return true;
    }
    __device__ __forceinline__ void a_ready(const Unit&) const {}
    __device__ __forceinline__ void done(const Unit&) const {}
};
struct EpiStoreP {
    static constexpr bool PERM = true, AFTER_DRAIN = false;
    bf16_t* O; int ldc;
    __device__ __forceinline__ void operator()(const f32x4 (&acc)[2][2][4][2], const Unit& u, int wr, int wc, int fr, int fq) const {
        const int row0 = u.pm * BM + wr * 64 + fr, col0 = u.pn * BM + wc * 32 + 8 * fq;
#pragma unroll
        for (int ai = 0; ai < 2; ++ai)
#pragma unroll
            for (int m = 0; m < 4; ++m) { bf16_t* rowp = O + (size_t)(row0 + ai * HALF + m * 16) * ldc + col0;
#pragma unroll
                for (int bj = 0; bj < 2; ++bj) { const f32x4 v0 = acc[ai][bj][m][0], v1 = acc[ai][bj][m][1];
                    u32x4 w; w.x = pk2(v0[0], v0[1]); w.y = pk2(v0[2], v0[3]); w.z = pk2(v1[0], v1[1]); w.w = pk2(v1[2], v1[3]);
                    *(u32x4*)(rowp + bj * HALF) = w; } }
    }
};
template <class Epi, class Sched>
__device__ __forceinline__ void gemm_phase(PG8_LAS unsigned char* lds, const Gemm g, const Sched& S, const Epi& E) {
    const int tid = ltid(), wid = __builtin_amdgcn_readfirstlane(tid >> 6), lane = tid & 63, wr = wid >> 2, wc = wid & 3, fr = lane & 15, fq = lane >> 4;
    const int K = g.K, nt = K / BK;
    unsigned voffA[2], voffB[2];
#pragma unroll
    for (int i = 0; i < 2; ++i) { int R, C; stage_rc(tid * 16 + i * 8192, R, C); const int Rb = Epi::PERM ? ((R & ~31) + perm32(R & 31)) : R;
        voffA[i] = (unsigned)(R * K + C) * 2u; voffB[i] = (unsigned)(Rb * K + C) * 2u; }
    const size_t kstep = (size_t)(BK * 2);
    const size_t hstep = (size_t)HALF * K * 2;
    const size_t tstep = 2 * hstep;
    const unsigned ldsw = (unsigned)wid * 1024u;
    const int aoff = lds_byte(wr * 64 + fr, fq * 8), boff = lds_byte(wc * 32 + fr, fq * 8);
#define PG8_SA(b, h) (((b) * 2 + (h)) * HTB)
#define PG8_SB(b, h) ((4 + (b) * 2 + (h)) * HTB)
#define PG8_STAGE(bufoff, gbase, voff) do { _Pragma("unroll") for (int _i = 0; _i < 2; ++_i) \
        __builtin_amdgcn_global_load_lds((const unsigned*)((const char*)(gbase) + (voff)[_i]), (PG8_LAS unsigned*)(lds + (bufoff) + ldsw + _i * 8192), 16, 0, 0); } while (0)
#define PG8_LDA(dst, b, h) do { _Pragma("unroll") for (int m = 0; m < 4; ++m) _Pragma("unroll") for (int k = 0; k < 2; ++k) dst[m][k] = *(const PG8_LAS bf16x8*)(lds + PG8_SA(b, h) + aoff + m * 2048 + k * 1024); } while (0)
#define PG8_LDB(dst, b, h) do { _Pragma("unroll") for (int n = 0; n < 2; ++n) _Pragma("unroll") for (int k = 0; k < 2; ++k) dst[n][k] = *(const PG8_LAS bf16x8*)(lds + PG8_SB(b, h) + boff + n * 2048 + k * 1024); } while (0)
#define PG8_MMA(ai, bj, At, Bt) do { __builtin_amdgcn_s_setprio(1); _Pragma("unroll") for (int m = 0; m < 4; ++m) _Pragma("unroll") for (int n = 0; n < 2; ++n) _Pragma("unroll") for (int k = 0; k < 2; ++k) \
        acc[ai][bj][m][n] = __builtin_amdgcn_mfma_f32_16x16x32_bf16(Bt[n][k], At[m][k], acc[ai][bj][m][n], 0, 0, 0); __builtin_amdgcn_s_setprio(0); } while (0)
#define PG8_WAIT_V(n) asm volatile("s_waitcnt vmcnt(" #n ")" ::: "memory")
#define PG8_WAIT_L(n) asm volatile("s_waitcnt lgkmcnt(" #n ")" ::: "memory")
#define PG8_BAR __builtin_amdgcn_s_barrier()
#define PG8_SCHED __builtin_amdgcn_sched_barrier(0)
    Unit cur, nxt; int ui = 0;
    if (!S.next(0, cur)) return;
    f32x4 acc[2][2][4][2];
#pragma unroll
    for (int a = 0; a < 2; ++a)
#pragma unroll
        for (int b = 0; b < 2; ++b)
#pragma unroll
            for (int m = 0; m < 4; ++m)
#pragma unroll
                for (int n = 0; n < 2; ++n) acc[a][b][m][n] = (f32x4){0.f, 0.f, 0.f, 0.f};
    bf16x8 At[4][2], B0[2][2], B1[2][2];
    const char* cA = (const char*)g.A + (size_t)cur.pm * tstep; const char* cB = (const char*)g.Bt + (size_t)cur.pn * tstep;
    S.a_ready(cur);
    PG8_STAGE(PG8_SB(0, 0), cB, voffB); PG8_STAGE(PG8_SA(0, 0), cA, voffA); PG8_STAGE(PG8_SB(0, 1), cB + hstep, voffB); PG8_STAGE(PG8_SA(0, 1), cA + hstep, voffA);
    if (wr == 1) PG8_BAR;
    PG8_WAIT_V(4); PG8_BAR;
    PG8_STAGE(PG8_SB(1, 0), cB + kstep, voffB); PG8_STAGE(PG8_SA(1, 0), cA + kstep, voffA); PG8_STAGE(PG8_SB(1, 1), cB + hstep + kstep, voffB);
    PG8_WAIT_V(6); PG8_BAR;
    for (;;) {
        const bool has_next = S.next(ui + 1, nxt);
        const char* nA = has_next ? (const char*)g.A + (size_t)nxt.pm * tstep : cA; const char* nB = has_next ? (const char*)g.Bt + (size_t)nxt.pn * tstep : cB;
        for (int t = 0; t < nt; t += 2) {
            const bool last = (t == nt - 2);
            const char* a1 = cA + (size_t)(t + 1) * kstep;
            const char* a2 = last ? nA : cA + (size_t)(t + 2) * kstep; const char* b2 = last ? nB : cB + (size_t)(t + 2) * kstep;
            const char* a3 = a2 + kstep; const char* b3 = b2 + kstep;
            if (last && has_next) S.a_ready(nxt);
            PG8_LDB(B0, 0, 0); PG8_SCHED; PG8_LDA(At, 0, 0); PG8_STAGE(PG8_SA(1, 1), a1 + hstep, voffA);
            PG8_WAIT_L(8); PG8_BAR; PG8_WAIT_L(0); PG8_MMA(0, 0, At, B0); PG8_BAR; PG8_SCHED;
            PG8_LDB(B1, 0, 1); PG8_STAGE(PG8_SB(0, 0), b2, voffB);
            PG8_BAR; PG8_WAIT_L(0); PG8_MMA(0, 1, At, B1); PG8_BAR;
            PG8_LDA(At, 0, 1); PG8_STAGE(PG8_SA(0, 0), a2, voffA);
            PG8_BAR; PG8_WAIT_L(0); PG8_MMA(1, 0, At, B0); PG8_BAR; PG8_SCHED;
            PG8_STAGE(PG8_SB(0, 1), b2 + hstep, voffB);
            PG8_WAIT_V(6); PG8_BAR; PG8_MMA(1, 1, At, B1); PG8_BAR;
            PG8_LDB(B0, 1, 0); PG8_SCHED; PG8_LDA(At, 1, 0); PG8_STAGE(PG8_SA(0, 1), a2 + hstep, voffA);
            PG8_WAIT_L(8); PG8_BAR; PG8_WAIT_L(0); PG8_MMA(0, 0, At, B0); PG8_BAR; PG8_SCHED;
            PG8_LDB(B1, 1, 1); PG8_STAGE(PG8_SB(1, 0), b3, voffB);
            PG8_BAR; PG8_WAIT_L(0); PG8_MMA(0, 1, At, B1); PG8_BAR;
            PG8_LDA(At, 1, 1); PG8_STAGE(PG8_SA(1, 0), a3, voffA);
            PG8_BAR; PG8_WAIT_L(0); PG8_MMA(1, 0, At, B0); PG8_BAR; PG8_SCHED;
            PG8_STAGE(PG8_SB(1, 1), b3 + hstep, voffB);
            PG8_WAIT_V(6); PG8_BAR; PG8_MMA(1, 1, At, B1); PG8_BAR;
        }
            if constexpr (!Epi::AFTER_DRAIN) { E(acc, cur, wr, wc, fr, fq); S.done(cur); }
            if (!has_next) break;
#pragma unroll
        for (int a = 0; a < 2; ++a)
#pragma unroll
            for (int b = 0; b < 2; ++b)
#pragma unroll
                for (int m = 0; m < 4; ++m)
#pragma unroll
                    for (int n = 0; n < 2; ++n) acc[a][b][m][n] = (f32x4){0.f, 0.f, 0.f, 0.f};
        cur = nxt; cA = nA; cB = nB; ++ui;
    }
    PG8_WAIT_V(0);
    if (wr == 0) PG8_BAR;
    PG8_BAR;
    if constexpr (Epi::AFTER_DRAIN) { E.fused(acc, cur, wr, wc, fr, fq, lds, wid, lane); S.done(cur); }
#undef PG8_SA
#undef PG8_SB
#undef PG8_STAGE
#undef PG8_LDA
#undef PG8_LDB
#undef PG8_MMA
#undef PG8_WAIT_V
#undef PG8_WAIT_L
#undef PG8_BAR
#undef PG8_SCHED
}
struct UnitG { int pm, pn; const char* bbase; const int* list; const PG8_LAS int* ltab; int cnt; int shift; };
struct MoeOrder {
    const PG8_LAS int* tstart; const PG8_LAS int* tcnt; const PG8_LAS int* ltabs; const int* lists; const char* bt; size_t estride; int ncol, shift, G, c;
    __device__ __forceinline__ bool next(int i, UnitG& u) const {
        const int t = i * G + c; if (t >= tstart[32] * ncol) return false;
        const int tm = t / ncol; int e = 0;
#pragma unroll 1
        while (tstart[e + 1] <= tm) ++e;
        e = __builtin_amdgcn_readfirstlane(e);
        const int ts = __builtin_amdgcn_readfirstlane(tstart[e]), tc = __builtin_amdgcn_readfirstlane(tcnt[e]);
        u.pm = tm - ts; u.pn = t - tm * ncol; u.bbase = bt + (size_t)e * estride; u.list = lists + (size_t)e * LISTCAP + u.pm * BM; u.cnt = tc - u.pm * BM; u.shift = shift; u.ltab = ltabs + i * BM;
        return true;
    }
    __device__ __forceinline__ void a_ready(const UnitG&) const {}
    __device__ __forceinline__ void done(const UnitG&) const {}
};
struct EpiSwiGLUG {
    static constexpr bool PERM = false, AFTER_DRAIN = false;
    bf16_t* H;
    __device__ __forceinline__ void operator()(const f32x4 (&acc)[2][2][4][2], const UnitG& u, int wr, int wc, int fr, int fq) const {
#pragma unroll
        for (int ai = 0; ai < 2; ++ai)
#pragma unroll
            for (int m = 0; m < 4; ++m) { const int r = ai * HALF + wr * 64 + m * 16 + fr;
                if (r < u.cnt) { bf16_t* rowp = H + (size_t)u.ltab[r] * DEXP + ((u.pn * BM + wc * 32) >> 1) + 4 * fq;
#pragma unroll
                    for (int bj = 0; bj < 2; ++bj) { const f32x4 gt = acc[ai][bj][m][0], up = acc[ai][bj][m][1];
                        u32x2 w; w.x = pk2(siluf_(gt[0]) * up[0], siluf_(gt[1]) * up[1]); w.y = pk2(siluf_(gt[2]) * up[2], siluf_(gt[3]) * up[3]);
                        *(u32x2*)(rowp + bj * (HALF / 2)) = w; } } }
    }
};
struct EpiScatterG {
    static constexpr bool PERM = true, AFTER_DRAIN = false;
    bf16_t* O;
    __device__ __forceinline__ void operator()(const f32x4 (&acc)[2][2][4][2], const UnitG& u, int wr, int wc, int fr, int fq) const {
#pragma unroll
        for (int ai = 0; ai < 2; ++ai)
#pragma unroll
            for (int m = 0; m < 4; ++m) { const int r = ai * HALF + wr * 64 + m * 16 + fr;
                if (r < u.cnt) { bf16_t* rowp = O + (size_t)u.ltab[r] * D + u.pn * BM + wc * 32 + 8 * fq;
#pragma unroll
                    for (int bj = 0; bj < 2; ++bj) { const f32x4 v0 = acc[ai][bj][m][0], v1 = acc[ai][bj][m][1];
                        u32x4 w; w.x = pk2(v0[0], v0[1]); w.y = pk2(v0[2], v0[3]); w.z = pk2(v1[0], v1[1]); w.w = pk2(v1[2], v1[3]);
                        *(u32x4*)(rowp + bj * HALF) = w; } } }
    }
};
template <class Epi, class Sched>
__device__ __forceinline__ void gemm_phase_g(PG8_LAS unsigned char* lds, const Gemm g, const Sched& S, const Epi& E) {
    const int tid = ltid(), wid = __builtin_amdgcn_readfirstlane(tid >> 6), lane = tid & 63, wr = wid >> 2, wc = wid & 3, fr = lane & 15, fq = lane >> 4;
    const int K = g.K, nt = K / BK;
    unsigned voffB[2]; int RA[2], CA2[2];
#pragma unroll
    for (int i = 0; i < 2; ++i) { int R, C; stage_rc(tid * 16 + i * 8192, R, C); const int Rb = Epi::PERM ? ((R & ~31) + perm32(R & 31)) : R;
        RA[i] = R; CA2[i] = C * 2; voffB[i] = (unsigned)(Rb * K + C) * 2u; }
    const unsigned rowb = (unsigned)K * 2u;
#define PG8_AOFFS(u, dst) do { _Pragma("unroll") for (int _h = 0; _h < 2; ++_h) _Pragma("unroll") for (int _i = 0; _i < 2; ++_i) { const int _r = _h * HALF + RA[_i]; \
        dst[_h][_i] = (unsigned)((u).ltab[_r] >> (u).shift) * rowb + (unsigned)CA2[_i]; } } while (0)
#define PG8_STAGE_A(bufoff, AO, koff) do { _Pragma("unroll") for (int _i = 0; _i < 2; ++_i) \
        __builtin_amdgcn_global_load_lds((const unsigned*)((const char*)g.A + (size_t)(AO)[_i] + (size_t)(koff)), (PG8_LAS unsigned*)(lds + (bufoff) + ldsw + _i * 8192), 16, 0, 0); } while (0)
    const size_t kstep = (size_t)(BK * 2);
    const size_t hstep = (size_t)HALF * K * 2;
    const size_t tstep = 2 * hstep;
    const unsigned ldsw = (unsigned)wid * 1024u;
    const int aoff = lds_byte(wr * 64 + fr, fq * 8), boff = lds_byte(wc * 32 + fr, fq * 8);
#define PG8_SA(b, h) (((b) * 2 + (h)) * HTB)
#define PG8_SB(b, h) ((4 + (b) * 2 + (h)) * HTB)
#define PG8_STAGE(bufoff, gbase, voff) do { _Pragma("unroll") for (int _i = 0; _i < 2; ++_i) \
        __builtin_amdgcn_global_load_lds((const unsigned*)((const char*)(gbase) + (voff)[_i]), (PG8_LAS unsigned*)(lds + (bufoff) + ldsw + _i * 8192), 16, 0, 0); } while (0)
#define PG8_LDA(dst, b, h) do { _Pragma("unroll") for (int m = 0; m < 4; ++m) _Pragma("unroll") for (int k = 0; k < 2; ++k) dst[m][k] = *(const PG8_LAS bf16x8*)(lds + PG8_SA(b, h) + aoff + m * 2048 + k * 1024); } while (0)
#define PG8_LDB(dst, b, h) do { _Pragma("unroll") for (int n = 0; n < 2; ++n) _Pragma("unroll") for (int k = 0; k < 2; ++k) dst[n][k] = *(const PG8_LAS bf16x8*)(lds + PG8_SB(b, h) + boff + n * 2048 + k * 1024); } while (0)
#define PG8_MMA(ai, bj, At, Bt) do { __builtin_amdgcn_s_setprio(1); _Pragma("unroll") for (int m = 0; m < 4; ++m) _Pragma("unroll") for (int n = 0; n < 2; ++n) _Pragma("unroll") for (int k = 0; k < 2; ++k) \
        acc[ai][bj][m][n] = __builtin_amdgcn_mfma_f32_16x16x32_bf16(Bt[n][k], At[m][k], acc[ai][bj][m][n], 0, 0, 0); __builtin_amdgcn_s_setprio(0); } while (0)
#define PG8_WAIT_V(n) asm volatile("s_waitcnt vmcnt(" #n ")" ::: "memory")
#define PG8_WAIT_L(n) asm volatile("s_waitcnt lgkmcnt(" #n ")" ::: "memory")
#define PG8_BAR __builtin_amdgcn_s_barrier()
#define PG8_SCHED __builtin_amdgcn_sched_barrier(0)
    UnitG cur, nxt; int ui = 0;
    if (!S.next(0, cur)) return;
    f32x4 acc[2][2][4][2];
#pragma unroll
    for (int a = 0; a < 2; ++a)
#pragma unroll
        for (int b = 0; b < 2; ++b)
#pragma unroll
            for (int m = 0; m < 4; ++m)
#pragma unroll
                for (int n = 0; n < 2; ++n) acc[a][b][m][n] = (f32x4){0.f, 0.f, 0.f, 0.f};
    bf16x8 At[4][2], B0[2][2], B1[2][2];
    unsigned ca[2][2], na[2][2]; PG8_AOFFS(cur, ca); const char* cB = cur.bbase + (size_t)cur.pn * tstep;
    S.a_ready(cur);
    PG8_STAGE(PG8_SB(0, 0), cB, voffB); PG8_STAGE_A(PG8_SA(0, 0), ca[0], 0); PG8_STAGE(PG8_SB(0, 1), cB + hstep, voffB); PG8_STAGE_A(PG8_SA(0, 1), ca[1], 0);
    if (wr == 1) PG8_BAR;
    PG8_WAIT_V(4); PG8_BAR;
    PG8_STAGE(PG8_SB(1, 0), cB + kstep, voffB); PG8_STAGE_A(PG8_SA(1, 0), ca[0], kstep); PG8_STAGE(PG8_SB(1, 1), cB + hstep + kstep, voffB);
    PG8_WAIT_V(6); PG8_BAR;
    for (;;) {
        const bool has_next = S.next(ui + 1, nxt);
        if (has_next) PG8_AOFFS(nxt, na); else { na[0][0] = ca[0][0]; na[0][1] = ca[0][1]; na[1][0] = ca[1][0]; na[1][1] = ca[1][1]; }
        const char* nB = has_next ? nxt.bbase + (size_t)nxt.pn * tstep : cB;
        for (int t = 0; t < nt; t += 2) {
            const bool last = (t == nt - 2);
            const size_t k1 = (size_t)(t + 1) * kstep, k2 = last ? 0 : (size_t)(t + 2) * kstep;
            unsigned a2o[2][2];
#pragma unroll
            for (int _h = 0; _h < 2; ++_h)
#pragma unroll
                for (int _i = 0; _i < 2; ++_i) a2o[_h][_i] = last ? na[_h][_i] : ca[_h][_i];
            const char* b2 = last ? nB : cB + (size_t)(t + 2) * kstep; const char* b3 = b2 + kstep;
            if (last && has_next) S.a_ready(nxt);
            PG8_LDB(B0, 0, 0); PG8_SCHED; PG8_LDA(At, 0, 0); PG8_STAGE_A(PG8_SA(1, 1), ca[1], k1);
            PG8_WAIT_L(8); PG8_BAR; PG8_WAIT_L(0); PG8_MMA(0, 0, At, B0); PG8_BAR; PG8_SCHED;
            PG8_LDB(B1, 0, 1); PG8_STAGE(PG8_SB(0, 0), b2, voffB);
            PG8_BAR; PG8_WAIT_L(0); PG8_MMA(0, 1, At, B1); PG8_BAR;
            PG8_LDA(At, 0, 1); PG8_STAGE_A(PG8_SA(0, 0), a2o[0], k2);
            PG8_BAR; PG8_WAIT_L(0); PG8_MMA(1, 0, At, B0); PG8_BAR; PG8_SCHED;
            PG8_STAGE(PG8_SB(0, 1), b2 + hstep, voffB);
            PG8_WAIT_V(6); PG8_BAR; PG8_MMA(1, 1, At, B1); PG8_BAR;
            PG8_LDB(B0, 1, 0); PG8_SCHED; PG8_LDA(At, 1, 0); PG8_STAGE_A(PG8_SA(0, 1), a2o[1], k2);
            PG8_WAIT_L(8); PG8_BAR; PG8_WAIT_L(0); PG8_MMA(0, 0, At, B0); PG8_BAR; PG8_SCHED;
            PG8_LDB(B1, 1, 1); PG8_STAGE(PG8_SB(1, 0), b3, voffB);
            PG8_BAR; PG8_WAIT_L(0); PG8_MMA(0, 1, At, B1); PG8_BAR;
            PG8_LDA(At, 1, 1); PG8_STAGE_A(PG8_SA(1, 0), a2o[0], k2 + kstep);
            PG8_BAR; PG8_WAIT_L(0); PG8_MMA(1, 0, At, B0); PG8_BAR; PG8_SCHED;
            PG8_STAGE(PG8_SB(1, 1), b3 + hstep, voffB);
            PG8_WAIT_V(6); PG8_BAR; PG8_MMA(1, 1, At, B1); PG8_BAR;
        }
            if constexpr (!Epi::AFTER_DRAIN) { E(acc, cur, wr, wc, fr, fq); S.done(cur); }
            if (!has_next) break;
#pragma unroll
        for (int a = 0; a < 2; ++a)
#pragma unroll
            for (int b = 0; b < 2; ++b)
#pragma unroll
                for (int m = 0; m < 4; ++m)
#pragma unroll
                    for (int n = 0; n < 2; ++n) acc[a][b][m][n] = (f32x4){0.f, 0.f, 0.f, 0.f};
        cur = nxt; ca[0][0] = na[0][0]; ca[0][1] = na[0][1]; ca[1][0] = na[1][0]; ca[1][1] = na[1][1]; cB = nB; ++ui;
    }
    PG8_WAIT_V(0);
    if (wr == 0) PG8_BAR;
    PG8_BAR;
    if constexpr (Epi::AFTER_DRAIN) { E.fused(acc, cur, wr, wc, fr, fq, lds, wid, lane); S.done(cur); }
#undef PG8_SA
#undef PG8_AOFFS
#undef PG8_STAGE_A
#undef PG8_SB
#undef PG8_STAGE
#undef PG8_LDA
#undef PG8_LDB
#undef PG8_MMA
#undef PG8_WAIT_V
#undef PG8_WAIT_L
#undef PG8_BAR
#undef PG8_SCHED
}
}

__device__ __forceinline__ void transpose_item(const float* __restrict__ W, int K, int N, bf16_t* __restrict__ WT, int mode, LAS float* scr, int item, int lane) {
    const int nblk = N / 32, kb = item / nblk, nb = item % nblk, k0 = 64 * kb, n0 = 32 * nb;
#pragma unroll 8
    for (int i = 0; i < 32; ++i) { const int kk = 2 * i + (lane >> 5); scr[kk * 33 + (lane & 31)] = W[(size_t)(k0 + kk) * N + n0 + (lane & 31)]; }
    asm volatile("s_waitcnt lgkmcnt(0)" ::: "memory");
    const int c = lane & 7;
#pragma unroll
    for (int j = 0; j < 4; ++j) {
        const int nl = (lane >> 3) + 8 * j; const LAS float* s = scr + (8 * c) * 33 + nl;
        u32x4 o; o.x = pk2(s[0 * 33], s[1 * 33]); o.y = pk2(s[2 * 33], s[3 * 33]); o.z = pk2(s[4 * 33], s[5 * 33]); o.w = pk2(s[6 * 33], s[7 * 33]);
        const int n = n0 + nl;
        const int nd = mode == 0 ? n : (32 * (n >> 4) + (n & 15) + (mode == 2 ? 16 : 0));
        *(u32x4*)(WT + (size_t)nd * K + k0 + 8 * c) = o;
    }
    asm volatile("s_waitcnt lgkmcnt(0)" ::: "memory");
}

__device__ __forceinline__ void phase_prologue0(KP Pk, LAS char* lds) {
    asm volatile("" : "+s"(Pk));
    const CAS Params& P = *Pk;
    const int tid = ltid(), lane = tid & 63, wid = tid >> 6;
    const int gw = blockIdx.x * 8 + wid, NGW = gridDim.x * 8;
    LAS float* scr = (LAS float*)(lds + wid * 8448);
    bf16_t* winT = (bf16_t*)(P.ws + WS_WINT);
    bf16_t* woutT = (bf16_t*)(P.ws + WS_WOUTT);
    bf16_t* loraT = (bf16_t*)(P.ws + WS_LORAT);
    constexpr int I_EV = 16 * (P_EVEN / 32), I_OD = 16 * (P_ODD / 32), I_O = 16 * 32, I_L64 = 16, I_L128 = 32;
    constexpr int I_LORA = 3 * I_L64 + I_L128;
    constexpr int NIT = 2 * I_EV + 2 * I_OD + 4 * I_O + 2 * I_LORA;
    for (int it = gw; it < NIT; it += NGW) {
        int r = it;
        if (r < 2 * I_EV) { const int i = r / I_EV; transpose_item(P.ev_w_in + (size_t)i * D * P_EVEN, D, P_EVEN, winT + (i ? WINT_L2 : WINT_L0), 0, scr, r % I_EV, lane); continue; } r -= 2 * I_EV;
        if (r < 2 * I_OD) { const int i = r / I_OD; transpose_item(P.od_w_in + (size_t)i * D * P_ODD, D, P_ODD, winT + (i ? WINT_L3 : WINT_L1), 0, scr, r % I_OD, lane); continue; } r -= 2 * I_OD;
        if (r < 4 * I_O) { const int l = r / I_O; const float* src = (l & 1) ? P.od_w_out + (size_t)(l >> 1) * D * D : P.ev_w_out + (size_t)(l >> 1) * D * D;
            transpose_item(src, D, D, woutT + (size_t)l * D * D, 0, scr, r % I_O, lane); continue; } r -= 4 * I_O;
        { const int i = r / I_LORA; int q = r % I_LORA; bf16_t* dst = loraT + (size_t)i * LORA_PER;
          if (q < I_L64) { transpose_item(P.rw_w2 + (size_t)(i * 2 + 0) * 64 * 512, 64, 512, dst, 0, scr, q, lane); continue; } q -= I_L64;
          if (q < I_L64) { transpose_item(P.rw_w2 + (size_t)(i * 2 + 1) * 64 * 512, 64, 512, dst + 512 * 64, 0, scr, q, lane); continue; } q -= I_L64;
          if (q < I_L64) { transpose_item(P.rw_a2 + (size_t)i * 64 * 512, 64, 512, dst + 2 * 512 * 64, 0, scr, q, lane); continue; } q -= I_L64;
          transpose_item(P.rw_g2 + (size_t)i * 128 * 512, 128, 512, dst + 3 * 512 * 64, 0, scr, q, lane); }
    }
    {
        const int gt = blockIdx.x * NT + tid, NG = gridDim.x * NT;
        constexpr int PADE = (LDP_EVEN - P_EVEN) * D / 8, PADO = (LDP_ODD - P_ODD) * D / 8;
        for (int i = gt; i < 2 * PADE + 2 * PADO; i += NG) {
            int r = i; bf16_t* dst;
            if (r < 2 * PADE) { const int l = r / PADE; dst = winT + (l ? WINT_L2 : WINT_L0) + (size_t)P_EVEN * D + (size_t)(r % PADE) * 8; }
            else { r -= 2 * PADE; const int l = r / PADO; dst = winT + (l ? WINT_L3 : WINT_L1) + (size_t)P_ODD * D + (size_t)(r % PADO) * 8; }
            *(u32x4*)dst = (u32x4){0u, 0u, 0u, 0u};
        }
    }
    {
        const int gt = blockIdx.x * NT + tid, NG = gridDim.x * NT;
        float* xc = (float*)(P.ws + WS_XC);
        for (int i = gt; i < NCTX * D / 4; i += NG) ((f32x4*)xc)[i] = ((const f32x4*)P.ctx)[i];
        float* lb = (float*)(P.ws + WS_LB);
        for (int ch = gt; ch < 512; ch += NG) {
            float lg[4], mx = -1e30f;
#pragma unroll
            for (int l = 0; l < 4; ++l) { lg[l] = P.hg_lb_logits[l * 512 + ch]; mx = fmaxf(mx, lg[l]); }
            float e[4], s = 0.f;
#pragma unroll
            for (int l = 0; l < 4; ++l) { e[l] = expf(lg[l] - mx); s += e[l]; }
            float cum = 0.f;
#pragma unroll
            for (int l = 0; l < 4; ++l) { if (l > 0) cum += e[l] / s; lb[l * 512 + ch] = cum; }
        }
    }
    __syncthreads();
    {
        LAS float* sc = (LAS float*)lds;
        LAS float* red = (LAS float*)(lds + 5 * 1024 * 4);
        for (int i = tid; i < 5 * D; i += NT) { const int m = i >> 10, k = i & 1023; const float v = m < 4 ? P.c[m * D + k] : P.c_ctx[k]; sc[i] = siluf_(v); }
        __syncthreads();
        float* modv = (float*)(P.ws + WS_MODV);
        const int col = tid & 127, kq = tid >> 7;
        for (int item = blockIdx.x; item < 4 * 48; item += gridDim.x) {
            const int l = item / 48, j = (item % 48) * 128 + col;
            const float* w = P.mod_w + (size_t)l * D * 6144 + j;
            float a[5] = {0.f, 0.f, 0.f, 0.f, 0.f};
#pragma unroll 8
            for (int k = kq * 256; k < kq * 256 + 256; ++k) {
                const float wv = w[(size_t)k * 6144];
#pragma unroll
                for (int m = 0; m < 5; ++m) a[m] += sc[m * 1024 + k] * wv;
            }
#pragma unroll
            for (int m = 0; m < 5; ++m) red[(kq * 128 + col) * 5 + m] = a[m];
            __syncthreads();
            if (kq == 0) {
                const float bias = P.mod_b[l * 6144 + j];
#pragma unroll
                for (int m = 0; m < 5; ++m) {
                    const float s = red[(0 * 128 + col) * 5 + m] + red[(1 * 128 + col) * 5 + m] + red[(2 * 128 + col) * 5 + m] + red[(3 * 128 + col) * 5 + m];
                    modv[(size_t)(l * 5 + m) * 6144 + j] = s + bias;
                }
            }
            __syncthreads();
        }
    }
}

__device__ __forceinline__ void phase_prologue1(KP Pk) {
    asm volatile("" : "+s"(Pk));
    const CAS Params& P = *Pk;
    const int tid = ltid(), lane = tid & 63, wid = tid >> 6;
    bf16_t* act = (bf16_t*)(P.ws + WS_ACT);
    for (int r = blockIdx.x * 8 + wid; r < NROWS; r += gridDim.x * 8) {
        const int m = row_mod(r);
        const float* src = r < NCTX ? P.ctx + (size_t)r * D : P.x + (size_t)(r - NCTX) * D;
        const float* sh = modvec(P.ws, 0, m, 0); const float* sc = modvec(P.ws, 0, m, 1);
#pragma unroll
        for (int i = 0; i < 4; ++i) {
            const int c = 4 * lane + 256 * i;
            const f32x4 v = *(const f32x4*)(src + c), s1 = *(const f32x4*)(sc + c), h1 = *(const f32x4*)(sh + c);
            if (r >= NCTX) *(f32x4*)(P.out + (size_t)(r - NCTX) * D + c) = v;
            u32x2 o; o.x = pk2(v[0] * (1.f + s1[0]) + h1[0], v[1] * (1.f + s1[1]) + h1[1]); o.y = pk2(v[2] * (1.f + s1[2]) + h1[2], v[3] * (1.f + s1[3]) + h1[3]);
            *(u32x2*)(act + (size_t)r * D + c) = o;
        }
    }
}

__device__ __forceinline__ void phase_inproj(KP Pk, int layer, LAS char* lds) {
    asm volatile("" : "+s"(Pk));
    const CAS Params& P = *Pk;
    const int odd = layer & 1, ldp = odd ? LDP_ODD : LDP_EVEN;
    const size_t woff = layer == 0 ? WINT_L0 : layer == 1 ? WINT_L1 : layer == 2 ? WINT_L2 : WINT_L3;
    pg8::Gemm g{(const bf16_t*)(P.ws + WS_ACT), (const bf16_t*)(P.ws + WS_WINT) + woff, NROWS, ldp, D};
    pg8::StaticOrder S; S.init(NROWS, ldp, (int)gridDim.x, (int)blockIdx.x);
    pg8::EpiStoreP E{(bf16_t*)(P.ws + WS_P), ldp};
    pg8::gemm_phase((PG8_LAS unsigned char*)lds, g, S, E);
}
__device__ __forceinline__ void phase_outproj(KP Pk, int layer, LAS char* lds) {
    asm volatile("" : "+s"(Pk));
    const CAS Params& P = *Pk;
    const int r0 = (layer == DEPTH - 1) ? NCTX : 0;
    pg8::Gemm g{(const bf16_t*)(P.ws + WS_FEAT) + (size_t)r0 * D, (const bf16_t*)(P.ws + WS_WOUTT) + (size_t)layer * D * D, NROWS - r0, D, D};
    pg8::StaticOrder S; S.init(NROWS - r0, D, (int)gridDim.x, (int)blockIdx.x);
    pg8::EpiStoreP E{(bf16_t*)(P.ws + WS_YO) + (size_t)r0 * D, D};
    pg8::gemm_phase((PG8_LAS unsigned char*)lds, g, S, E);
}
__device__ __forceinline__ void phase_prep2(KP Pk, int layer, LAS char* lds) {
    asm volatile("" : "+s"(Pk));
    const CAS Params& P = *Pk;
    const int i = layer >> 1;
    const bf16_t* la = (const bf16_t*)(P.ws + WS_LA);
    const bf16_t* lt = (const bf16_t*)(P.ws + WS_LORAT) + (size_t)i * LORA_PER;
    constexpr int MT = NROWS / G_BM, NTL = 512 / G_BN;
    const int ntiles = 4 * MT * NTL;
    for (int t = blockIdx.x; t < ntiles; t += gridDim.x) {
        const int which = t / (MT * NTL), r = t % (MT * NTL), mt = r / NTL, nt = r % NTL;
        RowLinear rs{mt * G_BM};
        if (which < 2) {
            EpiDecay epi{(float*)(P.ws + WS_RWDEC) + (size_t)which * NROWS * 512, P.rw_w0 + (size_t)(i * 2 + which) * 512, mt * G_BM, nt * G_BN};
            gemm_tile(la + which * 64, 320, rs, lt + (size_t)which * 512 * 64, 64, nt * G_BN, 64, epi, lds);
        } else if (which == 2) {
            EpiAK epi{(bf16_t*)(P.ws + WS_RWK), (const bf16_t*)(P.ws + WS_RWKK), (bf16_t*)(P.ws + WS_RWB), P.rw_a0 + i * 512, P.rw_k_a + i * 512, mt * G_BM, nt * G_BN};
            gemm_tile(la + 128, 320, rs, lt + (size_t)2 * 512 * 64, 64, nt * G_BN, 64, epi, lds);
        } else {
            EpiStoreBf16 epi{(bf16_t*)(P.ws + WS_RWG), 512, mt * G_BM, nt * G_BN, 512};
            gemm_tile(la + 192, 320, rs, lt + (size_t)3 * 512 * 64, 128, nt * G_BN, 128, epi, lds);
        }
    }
}
__device__ __forceinline__ void moe_tiles(const unsigned char* ws, int layer, LAS int* tstart, LAS int* tcnt) {
    if (threadIdx.x == 0) {
        const int* cnt = (const int*)(ws + WS_CNT) + layer * 32 * CNT_STRIDE;
        int acc = 0;
        for (int e = 0; e < NEXP; ++e) { const int c = cnt[e * CNT_STRIDE]; tcnt[e] = c; tstart[e] = acc; acc += (c + G_BM - 1) / G_BM; }
        tstart[NEXP] = acc;
    }
    __syncthreads();
}
__device__ __forceinline__ void phase_moe1(KP Pk, int layer, LAS char* lds) {
    asm volatile("" : "+s"(Pk));
    const CAS Params& P = *Pk;
    LAS int* tstart = (LAS int*)(lds + pg8::STAGE_BYTES); LAS int* tcnt = tstart + 40;
    moe_tiles(P.ws, layer, tstart, tcnt);
    pg8::Gemm g{(const bf16_t*)(P.ws + WS_ACT), (const bf16_t*)(P.ws + WS_EXPGU), 0, 1024, D};
    LAS int* ltabs = tstart + 128;
    pg8::MoeOrder S{tstart, tcnt, ltabs, (const int*)(P.ws + WS_LIST), (const char*)(P.ws + WS_EXPGU), (size_t)1024 * 1024 * 2, 4, 1, (int)gridDim.x, (int)blockIdx.x};
    pg8::EpiSwiGLUG E{(bf16_t*)(P.ws + WS_HID)};
    for (int i = 0; i < 8; ++i) {
        pg8::UnitG u; if (!S.next(i, u)) break;
        const int tl = ltid();
        if (tl < pg8::BM) ltabs[i * pg8::BM + tl] = u.list[tl < u.cnt ? tl : 0];
    }
    __syncthreads();
    pg8::gemm_phase_g((PG8_LAS unsigned char*)lds, g, S, E);
    __syncthreads();
}
__device__ __forceinline__ void phase_moe2(KP Pk, int layer, LAS char* lds) {
    asm volatile("" : "+s"(Pk));
    const CAS Params& P = *Pk;
    LAS int* tstart = (LAS int*)(lds + pg8::STAGE_BYTES); LAS int* tcnt = tstart + 40;
    moe_tiles(P.ws, layer, tstart, tcnt);
    pg8::Gemm g{(const bf16_t*)(P.ws + WS_HID), (const bf16_t*)(P.ws + WS_EXPD), 0, 1024, DEXP};
    LAS int* ltabs = tstart + 128;
    pg8::MoeOrder S{tstart, tcnt, ltabs, (const int*)(P.ws + WS_LIST), (const char*)(P.ws + WS_EXPD), (size_t)1024 * 512 * 2, 4, 0, (int)gridDim.x, (int)blockIdx.x};
    pg8::EpiScatterG E{(bf16_t*)(P.ws + WS_YP)};
    for (int i = 0; i < 8; ++i) {
        pg8::UnitG u; if (!S.next(i, u)) break;
        const int tl = ltid();
        if (tl < pg8::BM) ltabs[i * pg8::BM + tl] = u.list[tl < u.cnt ? tl : 0];
    }
    __syncthreads();
    pg8::gemm_phase_g((PG8_LAS unsigned char*)lds, g, S, E);
    __syncthreads();
}

constexpr int NCHUNK = NSTEPS / TCH;

constexpr int SSD_F = 32 + 64 + 64;
constexpr int SSD_BUF = TCH * SSD_F + 3 * TCH;
__device__ __forceinline__ void scan_ssd(KP Pk, int layer, int unit, LAS char* lds) {
    asm volatile("" : "+s"(Pk));
    const CAS Params& P = *Pk;
    const int tid = ltid(), i_ = layer >> 1;
    const int seq = unit >> 1, half = unit & 1, b = seq >> 4, h = (seq >> 1) & 7, dir = seq & 1, grp = h >> 2;
    LAS float* cw = (LAS float*)lds;
    LAS float* bufs = cw + 4 * 160;
    const bf16_t* Pb = (const bf16_t*)(P.ws + WS_P);
    bf16_t* Y = (bf16_t*)(P.ws + (dir ? WS_YB : WS_YF));
    for (int i = tid; i < 4 * 160; i += NT) {
        const int tap = i / 160, lc = i % 160, g = lc >> 3, e = lc & 7;
        const int ch = g < 4 ? (h * 64 + half * 32 + 8 * g + e) : g < 12 ? (512 + grp * 64 + 8 * (g - 4) + e) : (640 + grp * 64 + 8 * (g - 12) + e);
        cw[i] = tap < 3 ? P.ssd_conv_w[(size_t)(i_ * 3 + tap) * 768 + ch] : P.ssd_conv_b[i_ * 768 + ch];
    }
    const float dtb = P.ssd_dt_bias[(i_ * 2 + dir) * 8 + h], aco = -expf(P.ssd_a_log[(i_ * 2 + dir) * 8 + h]);
    int tj[2], tg_[2], tcol[2]; bool tv[2];
#pragma unroll
    for (int s = 0; s < 2; ++s) {
        const int task = tid + NT * s; tv[s] = task < 640; tj[s] = task / 20; tg_[s] = task % 20;
        const int g = tg_[s];
        tcol[s] = g < 4 ? (512 + h * 64 + half * 32 + 8 * g) : g < 12 ? (1024 + grp * 64 + 8 * (g - 4)) : (1152 + grp * 64 + 8 * (g - 12));
    }
    u32x4 rp[2], rc[2], rn[2]; float rdt = 0.f; int rrow = 0;
    auto load = [&](int c) {
#pragma unroll
        for (int s = 0; s < 2; ++s) {
            rp[s] = rc[s] = rn[s] = (u32x4){0u, 0u, 0u, 0u};
            if (tv[s]) {
                const int row = scan_row(c * TCH + tj[s], b, dir, 0); int t, len; row_seg(row, t, len);
                const bf16_t* p = Pb + (size_t)row * LDP_EVEN + tcol[s];
                rc[s] = *(const u32x4*)p;
                if (t > 0) rp[s] = *(const u32x4*)(p - LDP_EVEN);
                if (t < len - 1) rn[s] = *(const u32x4*)(p + LDP_EVEN);
            }
        }
        if (tid < TCH) { rrow = scan_row(c * TCH + tid, b, dir, 0); rdt = bf2f(Pb[(size_t)rrow * LDP_EVEN + 1280 + dir * 8 + h]); }
    };
    auto store = [&](int c) {
        LAS float* buf = bufs + (c & 1) * SSD_BUF;
#pragma unroll
        for (int s = 0; s < 2; ++s) {
            if (tv[s]) {
                float fp[8], fc[8], fn[8], o[8]; unpack8(rp[s], fp); unpack8(rc[s], fc); unpack8(rn[s], fn);
                const int lc = tg_[s] * 8;
#pragma unroll
                for (int e = 0; e < 8; ++e) o[e] = siluf_(cw[lc + e] * fp[e] + cw[160 + lc + e] * fc[e] + cw[320 + lc + e] * fn[e] + cw[480 + lc + e]);
                LAS float* dst = buf + tj[s] * SSD_F + lc;
                *(LAS f32x4*)dst = (f32x4){o[0], o[1], o[2], o[3]}; *(LAS f32x4*)(dst + 4) = (f32x4){o[4], o[5], o[6], o[7]};
            }
        }
        if (tid < TCH) {
            const float dt = softplusf_(rdt + dtb);
            buf[TCH * SSD_F + tid] = __expf(dt * aco); buf[TCH * SSD_F + TCH + tid] = dt; ((LAS int*)buf)[TCH * SSD_F + 2 * TCH + tid] = rrow;
        }
    };
    const int prow = tid >> 4, q = tid & 15;
    float hs[4] = {0.f, 0.f, 0.f, 0.f};
    __syncthreads();
    load(0); store(0); __syncthreads();
    for (int c = 0; c < NCHUNK; ++c) {
        if (c + 1 < NCHUNK) load(c + 1);
        LAS float* buf = bufs + (c & 1) * SSD_BUF;
        {
            const LAS float* xp = buf + prow;
            const LAS float* bp = buf + 32 + 4 * q;
            const LAS float* aux = buf + TCH * SSD_F;
            f32x4 B4 = *(const LAS f32x4*)bp, C4 = *(const LAS f32x4*)(bp + 64); float xr = xp[0];
#pragma unroll 1
            for (int jh = 0; jh < 2; ++jh) {
                float ysel = 0.f;
                f32x4 dA4, dt4;
#pragma unroll
                for (int j = 0; j < 16; ++j) {
                    const int jj = jh * 16 + j;
                    if ((j & 3) == 0) { dA4 = *(const LAS f32x4*)(aux + jj); dt4 = *(const LAS f32x4*)(aux + TCH + jj); }
                    const f32x4 Bc = B4, Cc = C4; const float xc = xr;
                    if (j < 15 || jh == 0) { B4 = *(const LAS f32x4*)(bp + (jj + 1) * SSD_F); C4 = *(const LAS f32x4*)(bp + 64 + (jj + 1) * SSD_F); xr = xp[(jj + 1) * SSD_F]; }
                    const float dA = dA4[j & 3], xv = xc * dt4[j & 3];
                    float y = 0.f;
#pragma unroll
                    for (int e = 0; e < 4; ++e) { hs[e] = dA * hs[e] + xv * Bc[e]; y += Cc[e] * hs[e]; }
                    y = allreduce16(y);
                    ysel = (q == j) ? y : ysel;
                }
                const int row = ((const LAS int*)aux)[2 * TCH + jh * 16 + q];
                Y[(size_t)row * D + h * 64 + half * 32 + prow] = f2bf(ysel);
            }
        }
        if (c + 1 < NCHUNK) store(c + 1);
        __syncthreads();
    }
}

constexpr int ML_F = 64 + 64 + 32;
constexpr int ML_BUF = TCH * ML_F + 4 * TCH;
__device__ __forceinline__ void scan_mlstm(KP Pk, int layer, int unit, LAS char* lds) {
    asm volatile("" : "+s"(Pk));
    const CAS Params& P = *Pk;
    const int tid = ltid(), i_ = layer >> 1;
    const int seq = unit >> 2, quarter = unit & 3, b = seq >> 3, h = (seq >> 1) & 3, dir = seq & 1;
    LAS float* cw = (LAS float*)lds;
    LAS float* bufs = cw + 4 * 128;
    const bf16_t* Pb = (const bf16_t*)(P.ws + WS_P);
    bf16_t* Y = (bf16_t*)(P.ws + (dir ? WS_YB : WS_YF));
    for (int i = tid; i < 4 * 128; i += NT) {
        const int tap = i >> 7, lc = i & 127;
        const int ch = lc < 64 ? (h * 64 + lc) : (256 + h * 64 + lc - 64);
        cw[i] = tap < 3 ? P.ml_conv_w[(size_t)(i_ * 3 + tap) * 512 + ch] : P.ml_conv_b[i_ * 512 + ch];
    }
    const float ib = P.ml_i_bias[(i_ * 2 + dir) * 4 + h], fb = P.ml_f_bias[(i_ * 2 + dir) * 4 + h];
    int tj[2], tg_[2], tcol[2]; bool tv[2];
#pragma unroll
    for (int s = 0; s < 2; ++s) {
        const int task = tid + NT * s; tv[s] = task < 640; tj[s] = task / 20; tg_[s] = task % 20;
        const int g = tg_[s];
        tcol[s] = 1296 + (g < 8 ? (h * 64 + 8 * g) : g < 16 ? (256 + h * 64 + 8 * (g - 8)) : (512 + h * 128 + quarter * 32 + 8 * (g - 16)));
    }
    u32x4 rp[2], rc[2], rn[2]; float rgi = 0.f, rgf = 0.f; int rrow = 0;
    float mcarry = -1e30f;
    auto load = [&](int c) {
#pragma unroll
        for (int s = 0; s < 2; ++s) {
            rp[s] = rc[s] = rn[s] = (u32x4){0u, 0u, 0u, 0u};
            if (tv[s]) {
                const int row = scan_row(c * TCH + tj[s], b, dir, 0); int t, len; row_seg(row, t, len);
                const bf16_t* p = Pb + (size_t)row * LDP_EVEN + tcol[s];
                rc[s] = *(const u32x4*)p;
                if (tg_[s] < 16) { if (t > 0) rp[s] = *(const u32x4*)(p - LDP_EVEN); if (t < len - 1) rn[s] = *(const u32x4*)(p + LDP_EVEN); }
            }
        }
        if (tid < TCH) {
            rrow = scan_row(c * TCH + tid, b, dir, 0);
            const bf16_t* g = Pb + (size_t)rrow * LDP_EVEN + 1296 + 1536;
            rgi = bf2f(g[dir * 4 + h]); rgf = bf2f(g[8 + dir * 4 + h]);
        }
    };
    auto store = [&](int c) {
        LAS float* buf = bufs + (c & 1) * ML_BUF;
#pragma unroll
        for (int s = 0; s < 2; ++s) {
            if (tv[s]) {
                float fp[8], fc[8], fn[8], o[8]; unpack8(rp[s], fp); unpack8(rc[s], fc); unpack8(rn[s], fn);
                const int g = tg_[s], lc = g * 8;
                if (g < 16) {
                    const float scl = g < 8 ? 0.125f : 1.f;
#pragma unroll
                    for (int e = 0; e < 8; ++e) o[e] = scl * siluf_(cw[lc + e] * fp[e] + cw[128 + lc + e] * fc[e] + cw[256 + lc + e] * fn[e] + cw[384 + lc + e]);
                } else {
#pragma unroll
                    for (int e = 0; e < 8; ++e) o[e] = fc[e];
                }
                LAS float* dst = buf + tj[s] * ML_F + lc;
                *(LAS f32x4*)dst = (f32x4){o[0], o[1], o[2], o[3]}; *(LAS f32x4*)(dst + 4) = (f32x4){o[4], o[5], o[6], o[7]};
            }
        }
        if (tid < 64) {
            const int l = tid & 31;
            const float li = rgi + ib, lf = logsigmoidf_(rgf + fb);
            float F = lf;
#pragma unroll
            for (int o = 1; o < 32; o <<= 1) { const float t = __shfl_up(F, o, 32); if (l >= o) F += t; }
            float cm = li - F;
#pragma unroll
            for (int o = 1; o < 32; o <<= 1) { const float t = __shfl_up(cm, o, 32); if (l >= o) cm = fmaxf(cm, t); }
            const float m = F + fmaxf(mcarry, cm);
            float mprev = __shfl_up(m, 1, 32); if (l == 0) mprev = mcarry;
            const float sp = __expf(lf + mprev - m), sl = __expf(li - m), em = __expf(-m);
            if (tid < TCH) { buf[TCH * ML_F + tid] = sp; buf[TCH * ML_F + TCH + tid] = sl; buf[TCH * ML_F + 2 * TCH + tid] = em; ((LAS int*)buf)[TCH * ML_F + 3 * TCH + tid] = rrow; }
            mcarry = __shfl(m, 31, 32);
        }
    };
    const int col = tid >> 4, q = tid & 15;
    float Cs[4] = {0.f, 0.f, 0.f, 0.f}, ns[4] = {0.f, 0.f, 0.f, 0.f};
    __syncthreads();
    load(0); store(0); __syncthreads();
    for (int c = 0; c < NCHUNK; ++c) {
        if (c + 1 < NCHUNK) load(c + 1);
        LAS float* buf = bufs + (c & 1) * ML_BUF;
        {
            const LAS float* qp = buf + 4 * q;
            const LAS float* vp = buf + 128 + col;
            const LAS float* aux = buf + TCH * ML_F;
            f32x4 q4 = *(const LAS f32x4*)qp, k4 = *(const LAS f32x4*)(qp + 64); float vr = vp[0];
#pragma unroll 1
            for (int jh = 0; jh < 2; ++jh) {
                float nsel = 0.f, dsel = 1.f;
                f32x4 sp4, sl4;
#pragma unroll
                for (int j = 0; j < 16; ++j) {
                    const int jj = jh * 16 + j;
                    if ((j & 3) == 0) { sp4 = *(const LAS f32x4*)(aux + jj); sl4 = *(const LAS f32x4*)(aux + TCH + jj); }
                    const f32x4 qc = q4, kc = k4; const float vv = vr;
                    if (j < 15 || jh == 0) { q4 = *(const LAS f32x4*)(qp + (jj + 1) * ML_F); k4 = *(const LAS f32x4*)(qp + 64 + (jj + 1) * ML_F); vr = vp[(jj + 1) * ML_F]; }
                    const float sp = sp4[j & 3], sl = sl4[j & 3];
                    float num = 0.f, den = 0.f;
#pragma unroll
                    for (int e = 0; e < 4; ++e) { const float sk = sl * kc[e]; Cs[e] = sp * Cs[e] + sk * vv; ns[e] = sp * ns[e] + sk; num += qc[e] * Cs[e]; den += qc[e] * ns[e]; }
                    num = allreduce16(num); den = allreduce16(den);
                    nsel = (q == j) ? num : nsel; dsel = (q == j) ? den : dsel;
                }
                const float em = aux[2 * TCH + jh * 16 + q];
                const int row = ((const LAS int*)aux)[3 * TCH + jh * 16 + q];
                Y[(size_t)row * D + 512 + h * 128 + quarter * 32 + col] = f2bf(nsel / fmaxf(fabsf(dsel), em));
            }
        }
        if (c + 1 < NCHUNK) store(c + 1);
        __syncthreads();
    }
}

constexpr int HG_F = 128 + 128 + 32;
constexpr int HG_BUF = TCH * HG_F + TCH;
__device__ __forceinline__ void scan_hgrn(KP Pk, int layer, int unit, LAS char* lds) {
    asm volatile("" : "+s"(Pk));
    const CAS Params& P = *Pk;
    const int tid = ltid(), i_ = layer >> 1;
    const int seq = unit >> 2, quarter = unit & 3, b = seq >> 3, h = (seq >> 1) & 3, dir = seq & 1;
    LAS float* cst = (LAS float*)lds;
    LAS float* bufs = cst + 256;
    const bf16_t* Pb = (const bf16_t*)(P.ws + WS_P);
    bf16_t* Y = (bf16_t*)(P.ws + (dir ? WS_YB : WS_YF));
    if (tid < 128) cst[tid] = ((const float*)(P.ws + WS_LB))[layer * 512 + h * 128 + tid];
    else if (tid < 256) cst[tid] = P.hg_f_bias[(size_t)(i_ * 2 + dir) * 512 + h * 128 + tid - 128];
    int tj[3], tg_[3], tcol[3]; bool tv[3];
#pragma unroll
    for (int s = 0; s < 3; ++s) {
        const int task = tid + NT * s; tv[s] = task < TCH * 36; tj[s] = task / 36; tg_[s] = task % 36;
        const int g = tg_[s];
        tcol[s] = g < 16 ? (512 + dir * 512 + h * 128 + 8 * g) : g < 32 ? (h * 128 + 8 * (g - 16)) : (1536 + h * 128 + quarter * 32 + 8 * (g - 32));
    }
    u32x4 rc[3]; int rrow = 0;
    auto load = [&](int c) {
#pragma unroll
        for (int s = 0; s < 3; ++s) {
            rc[s] = (u32x4){0u, 0u, 0u, 0u};
            if (tv[s]) { const int row = scan_row(c * TCH + tj[s], b, dir, 1); rc[s] = *(const u32x4*)(Pb + (size_t)row * LDP_ODD + tcol[s]); }
        }
        if (tid < TCH) rrow = scan_row(c * TCH + tid, b, dir, 1);
    };
    auto store = [&](int c) {
        LAS float* buf = bufs + (c & 1) * HG_BUF;
#pragma unroll
        for (int s = 0; s < 3; ++s) {
            if (tv[s]) {
                float fc[8], o[8]; unpack8(rc[s], fc);
                const int g = tg_[s], lc = g * 8;
                if (g < 16) {
#pragma unroll
                    for (int e = 0; e < 8; ++e) { const float lbv = cst[lc + e]; o[e] = lbv + (1.f - lbv) * sigmoidf_(fc[e] + cst[128 + lc + e]); }
                } else if (g < 32) {
#pragma unroll
                    for (int e = 0; e < 8; ++e) o[e] = siluf_(fc[e]);
                } else {
#pragma unroll
                    for (int e = 0; e < 8; ++e) o[e] = fc[e];
                }
                LAS float* dst = buf + tj[s] * HG_F + lc;
                *(LAS f32x4*)dst = (f32x4){o[0], o[1], o[2], o[3]}; *(LAS f32x4*)(dst + 4) = (f32x4){o[4], o[5], o[6], o[7]};
            }
        }
        if (tid < TCH) ((LAS int*)buf)[TCH * HG_F + tid] = rrow;
    };
    const int col = tid >> 4, q = tid & 15;
    float S[8];
#pragma unroll
    for (int e = 0; e < 8; ++e) S[e] = 0.f;
    __syncthreads();
    load(0); store(0); __syncthreads();
    for (int c = 0; c < NCHUNK; ++c) {
        if (c + 1 < NCHUNK) load(c + 1);
        LAS float* buf = bufs + (c & 1) * HG_BUF;
        {
            const LAS float* fp = buf + 4 * q;
            const LAS float* vp = buf + 256 + col;
            f32x4 f0 = *(const LAS f32x4*)fp, f1 = *(const LAS f32x4*)(fp + 64), q0 = *(const LAS f32x4*)(fp + 128), q1 = *(const LAS f32x4*)(fp + 192); float vr = vp[0];
#pragma unroll 1
            for (int jh = 0; jh < 2; ++jh) {
                float ysel = 0.f;
#pragma unroll
                for (int j = 0; j < 16; ++j) {
                    const int jj = jh * 16 + j;
                    const f32x4 f0c = f0, f1c = f1, q0c = q0, q1c = q1; const float vv = vr;
                    if (j < 15 || jh == 0) {
                        const LAS float* np = fp + (jj + 1) * HG_F;
                        f0 = *(const LAS f32x4*)np; f1 = *(const LAS f32x4*)(np + 64); q0 = *(const LAS f32x4*)(np + 128); q1 = *(const LAS f32x4*)(np + 192); vr = vp[(jj + 1) * HG_F];
                    }
                    float o = 0.f;
#pragma unroll
                    for (int e = 0; e < 4; ++e) { S[e] = f0c[e] * (S[e] - vv) + vv; o += q0c[e] * S[e]; S[4 + e] = f1c[e] * (S[4 + e] - vv) + vv; o += q1c[e] * S[4 + e]; }
                    o = allreduce16(o);
                    ysel = (q == j) ? o : ysel;
                }
                const int row = ((const LAS int*)buf)[TCH * HG_F + jh * 16 + q];
                Y[(size_t)row * D + h * 128 + quarter * 32 + col] = f2bf(ysel);
            }
        }
        if (c + 1 < NCHUNK) store(c + 1);
        __syncthreads();
    }
}

constexpr int RW_F = 5 * 64 + 32;
constexpr int RW_BUF = TCH * RW_F + TCH;
__device__ __forceinline__ void scan_rwkv(KP Pk, int layer, int unit, LAS char* lds) {
    asm volatile("" : "+s"(Pk));
    const CAS Params& P = *Pk;
    const int tid = ltid();
    const int seq = unit >> 1, half = unit & 1, b = seq >> 4, h = (seq >> 1) & 7, dir = seq & 1;
    LAS float* bufs = (LAS float*)lds;
    bf16_t* Y = (bf16_t*)(P.ws + (dir ? WS_YB : WS_YF));
    const float* dec = (const float*)(P.ws + WS_RWDEC) + (size_t)dir * NROWS * 512;
    int tj[4], tg_[4]; bool tv[4]; const unsigned char* tbase[4]; int tlds[4];
#pragma unroll
    for (int s = 0; s < 4; ++s) {
        const int task = tid + NT * s; tv[s] = task < TCH * 52; tj[s] = task / 52; tg_[s] = task % 52;
        const int g = tg_[s];
        if (g < 8)       { tbase[s] = P.ws + WS_RWR  + (size_t)(h * 64 + 8 * g) * 2;              tlds[s] = 256 + 8 * g; }
        else if (g < 16) { tbase[s] = P.ws + WS_RWK  + (size_t)(h * 64 + 8 * (g - 8)) * 2;        tlds[s] = 192 + 8 * (g - 8); }
        else if (g < 24) { tbase[s] = P.ws + WS_RWKK + (size_t)(h * 64 + 8 * (g - 16)) * 2;       tlds[s] = 64 + 8 * (g - 16); }
        else if (g < 32) { tbase[s] = P.ws + WS_RWB  + (size_t)(h * 64 + 8 * (g - 24)) * 2;       tlds[s] = 128 + 8 * (g - 24); }
        else if (g < 36) { tbase[s] = P.ws + WS_RWV  + (size_t)(h * 64 + half * 32 + 8 * (g - 32)) * 2; tlds[s] = 320 + 8 * (g - 32); }
        else             { tbase[s] = (const unsigned char*)(dec + h * 64 + 4 * (g - 36));        tlds[s] = 4 * (g - 36); }
    }
    u32x4 rc[4]; int rrow = 0;
    auto load = [&](int c) {
#pragma unroll
        for (int s = 0; s < 4; ++s) {
            rc[s] = (u32x4){0u, 0u, 0u, 0u};
            if (tv[s]) { const int row = scan_row(c * TCH + tj[s], b, dir, 1); rc[s] = *(const u32x4*)(tbase[s] + (size_t)row * (tg_[s] < 36 ? 1024 : 2048)); }
        }
        if (tid < TCH) rrow = scan_row(c * TCH + tid, b, dir, 1);
    };
    auto store = [&](int c) {
        LAS float* buf = bufs + (c & 1) * RW_BUF;
#pragma unroll
        for (int s = 0; s < 4; ++s) {
            if (tv[s]) {
                LAS float* dst = buf + tj[s] * RW_F + tlds[s];
                const int g = tg_[s];
                if (g >= 36) { *(LAS u32x4*)dst = rc[s]; }
                else {
                    float f[8]; unpack8(rc[s], f);
                    const float sg = (g >= 16 && g < 24) ? -1.f : 1.f;
                    *(LAS f32x4*)dst = (f32x4){sg * f[0], sg * f[1], sg * f[2], sg * f[3]}; *(LAS f32x4*)(dst + 4) = (f32x4){sg * f[4], sg * f[5], sg * f[6], sg * f[7]};
                }
            }
        }
        if (tid < TCH) ((LAS int*)buf)[TCH * RW_F + tid] = rrow;
    };
    const int vrow = tid >> 4, q = tid & 15;
    float S[4] = {0.f, 0.f, 0.f, 0.f};
    load(0); store(0); __syncthreads();
    for (int c = 0; c < NCHUNK; ++c) {
        if (c + 1 < NCHUNK) load(c + 1);
        LAS float* buf = bufs + (c & 1) * RW_BUF;
        {
            const LAS float* wp = buf + 4 * q;
            const LAS float* vp = buf + 320 + vrow;
            f32x4 w4 = *(const LAS f32x4*)wp, a4 = *(const LAS f32x4*)(wp + 64), b4 = *(const LAS f32x4*)(wp + 128), k4 = *(const LAS f32x4*)(wp + 192), r4 = *(const LAS f32x4*)(wp + 256); float vr = vp[0];
#pragma unroll 1
            for (int jh = 0; jh < 2; ++jh) {
                float ysel = 0.f;
#pragma unroll
                for (int j = 0; j < 16; ++j) {
                    const int jj = jh * 16 + j;
                    const f32x4 wc = w4, ac = a4, bc = b4, kc = k4, rc = r4; const float vv = vr;
                    if (j < 15 || jh == 0) {
                        const LAS float* np = wp + (jj + 1) * RW_F;
                        w4 = *(const LAS f32x4*)np; a4 = *(const LAS f32x4*)(np + 64); b4 = *(const LAS f32x4*)(np + 128); k4 = *(const LAS f32x4*)(np + 192); r4 = *(const LAS f32x4*)(np + 256); vr = vp[(jj + 1) * RW_F];
                    }
                    float sa = S[0] * ac[0] + S[1] * ac[1] + S[2] * ac[2] + S[3] * ac[3];
                    sa = allreduce16(sa);
                    float y = 0.f;
#pragma unroll
                    for (int e = 0; e < 4; ++e) { S[e] = S[e] * wc[e] + (sa * bc[e] + vv * kc[e]); y += S[e] * rc[e]; }
                    y = allreduce16(y);
                    ysel = (q == j) ? y : ysel;
                }
                const int row = ((const LAS int*)buf)[TCH * RW_F + jh * 16 + q];
                Y[(size_t)row * D + 512 + h * 64 + half * 32 + vrow] = f2bf(ysel);
            }
        }
        if (c + 1 < NCHUNK) store(c + 1);
        __syncthreads();
    }
}

constexpr size_t WS_EXBC = WS_RWR;
constexpr size_t WS_EQK = WS_EXBC + (size_t)NROWS * 768 * 2;
constexpr size_t WS_EGT = WS_EQK + (size_t)NROWS * 512 * 2;
static_assert(WS_EGT + (size_t)NROWS * 32 * 4 <= WS_LA, "even-layer prepare buffers must fit in the RWKV region");

__device__ __forceinline__ void phase_prep_even(KP Pk, int layer) {
    asm volatile("" : "+s"(Pk));
    const CAS Params& P = *Pk;
    const int tid = ltid(), lane = tid & 63, wid = tid >> 6, i_ = layer >> 1;
    const bf16_t* Pb = (const bf16_t*)(P.ws + WS_P);
    bf16_t* XBC = (bf16_t*)(P.ws + WS_EXBC); bf16_t* QK = (bf16_t*)(P.ws + WS_EQK); float* GT = (float*)(P.ws + WS_EGT);
    float cw0[4][8], cw1[4][8], cwq[4][8];
#pragma unroll
    for (int e = 0; e < 8; ++e) {
#pragma unroll
        for (int t = 0; t < 3; ++t) {
            cw0[t][e] = P.ssd_conv_w[(size_t)(i_ * 3 + t) * 768 + 8 * lane + e];
            cw1[t][e] = P.ssd_conv_w[(size_t)(i_ * 3 + t) * 768 + 512 + 8 * (lane & 31) + e];
            cwq[t][e] = P.ml_conv_w[(size_t)(i_ * 3 + t) * 512 + 8 * lane + e];
        }
        cw0[3][e] = P.ssd_conv_b[i_ * 768 + 8 * lane + e]; cw1[3][e] = P.ssd_conv_b[i_ * 768 + 512 + 8 * (lane & 31) + e]; cwq[3][e] = P.ml_conv_b[i_ * 512 + 8 * lane + e];
    }
    float gbias = 0.f;
    if (lane < 16) gbias = P.ssd_dt_bias[i_ * 16 + lane]; else if (lane < 24) gbias = P.ml_i_bias[i_ * 8 + lane - 16]; else if (lane < 32) gbias = P.ml_f_bias[i_ * 8 + lane - 24];
    const float qscl = lane < 32 ? 0.125f : 1.f;
    for (int r = blockIdx.x * 8 + wid; r < NROWS; r += gridDim.x * 8) {
        int t, len; row_seg(r, t, len);
        const bf16_t* pr = Pb + (size_t)r * LDP_EVEN;
        const bool hp = t > 0, hn = t < len - 1;
        const u32x4 zero = (u32x4){0u, 0u, 0u, 0u};
        float fc[8], fp[8], fn[8], o[8];
        {
            const int col = 512 + 8 * lane;
            unpack8(*(const u32x4*)(pr + col), fc); unpack8(hp ? *(const u32x4*)(pr - LDP_EVEN + col) : zero, fp); unpack8(hn ? *(const u32x4*)(pr + LDP_EVEN + col) : zero, fn);
#pragma unroll
            for (int e = 0; e < 8; ++e) o[e] = siluf_(cw0[0][e] * fp[e] + cw0[1][e] * fc[e] + cw0[2][e] * fn[e] + cw0[3][e]);
            *(u32x4*)(XBC + (size_t)r * 768 + 8 * lane) = pack8(o);
        }
        if (lane < 32) {
            const int col = 1024 + 8 * lane;
            unpack8(*(const u32x4*)(pr + col), fc); unpack8(hp ? *(const u32x4*)(pr - LDP_EVEN + col) : zero, fp); unpack8(hn ? *(const u32x4*)(pr + LDP_EVEN + col) : zero, fn);
#pragma unroll
            for (int e = 0; e < 8; ++e) o[e] = siluf_(cw1[0][e] * fp[e] + cw1[1][e] * fc[e] + cw1[2][e] * fn[e] + cw1[3][e]);
            *(u32x4*)(XBC + (size_t)r * 768 + 512 + 8 * lane) = pack8(o);
        }
        {
            const int col = 1296 + 8 * lane;
            unpack8(*(const u32x4*)(pr + col), fc); unpack8(hp ? *(const u32x4*)(pr - LDP_EVEN + col) : zero, fp); unpack8(hn ? *(const u32x4*)(pr + LDP_EVEN + col) : zero, fn);
#pragma unroll
            for (int e = 0; e < 8; ++e) o[e] = qscl * siluf_(cwq[0][e] * fp[e] + cwq[1][e] * fc[e] + cwq[2][e] * fn[e] + cwq[3][e]);
            *(u32x4*)(QK + (size_t)r * 512 + 8 * lane) = pack8(o);
        }
        if (lane < 32) {
            const int col = lane < 16 ? 1280 + lane : 2832 + (lane - 16);
            const float x = bf2f(pr[col]) + gbias;
            GT[(size_t)r * 32 + lane] = lane < 16 ? softplusf_(x) : lane < 24 ? x : logsigmoidf_(x);
        }
    }
}

constexpr int CL = 64, NCH64 = NSTEPS / CL, LDT = 72, LDTB = LDT * 2;
__device__ __forceinline__ bf16x8 ldfrag(const LAS char* tile, int ldb, int row0, int k0, int lane) {
    return *(const LAS bf16x8*)(tile + (row0 + (lane & 15)) * ldb + (k0 + 8 * (lane >> 4)) * 2);
}
__device__ __forceinline__ void st4bf(LAS char* p, const f32x4& v) { u32x2 o; o.x = pk2(v[0], v[1]); o.y = pk2(v[2], v[3]); *(LAS u32x2*)p = o; }

constexpr int SS_BT = 0, SS_CT = SS_BT + 64 * LDTB, SS_BDT = SS_CT + 64 * LDTB, SS_XT = SS_BDT + 64 * LDTB, SS_CUM = SS_XT + 32 * LDTB, SS_DTV = SS_CUM + 256, SS_ROWS = SS_DTV + 256, SS_STG = SS_ROWS + 256;
constexpr int SS_M = 2 * SS_STG, SS_HB = SS_M + 64 * LDTB, SS_END = SS_HB + 32 * LDTB;
static_assert(SS_END <= LDS_BYTES - 16, "SSD LDS map");
__device__ __forceinline__ void scan_ssd_c(KP Pk, int layer, int unit, LAS char* lds) {
    asm volatile("" : "+s"(Pk));
    const CAS Params& P = *Pk;
    const int tid = ltid(), lane = tid & 63, wid = tid >> 6, q = lane >> 4, r16 = lane & 15, i_ = layer >> 1;
    const int seq = unit >> 1, half = unit & 1, b = seq >> 4, h = (seq >> 1) & 7, dir = seq & 1, grp = h >> 2;
    const bf16_t* XBC = (const bf16_t*)(P.ws + WS_EXBC);
    const float* GT = (const float*)(P.ws + WS_EGT);
    bf16_t* Y = (bf16_t*)(P.ws + (dir ? WS_YB : WS_YF));
    const float aco = -expf(P.ssd_a_log[(i_ * 2 + dir) * 8 + h]);
    int tj[3], tg_[3], tcol[3]; bool tv[3];
#pragma unroll
    for (int s = 0; s < 3; ++s) {
        const int task = tid + NT * s; tv[s] = task < CL * 20; tj[s] = task / 20; tg_[s] = task % 20;
        const int g = tg_[s];
        tcol[s] = g < 4 ? (h * 64 + half * 32 + 8 * g) : g < 12 ? (512 + grp * 64 + 8 * (g - 4)) : (640 + grp * 64 + 8 * (g - 12));
    }
    u32x4 rc[3]; float rdt = 0.f; int rrow = 0;
    auto load = [&](int c) {
#pragma unroll
        for (int s = 0; s < 3; ++s) {
            rc[s] = (u32x4){0u, 0u, 0u, 0u};
            if (tv[s]) { const int row = scan_row(c * CL + tj[s], b, dir, 0); rc[s] = *(const u32x4*)(XBC + (size_t)row * 768 + tcol[s]); }
        }
        if (tid < CL) { rrow = scan_row(c * CL + tid, b, dir, 0); rdt = GT[(size_t)rrow * 32 + dir * 8 + h]; }
    };
    auto store1 = [&](int c) {
        if (tid < CL) {
            LAS char* stg = lds + (c & 1) * SS_STG;
            float cum = rdt * aco;
#pragma unroll
            for (int o = 1; o < 64; o <<= 1) { const float t = __shfl_up(cum, o); if (lane >= o) cum += t; }
            ((LAS float*)(stg + SS_CUM))[tid] = cum; ((LAS float*)(stg + SS_DTV))[tid] = rdt; ((LAS int*)(stg + SS_ROWS))[tid] = rrow;
        }
    };
    auto store2 = [&](int c) {
        LAS char* stg = lds + (c & 1) * SS_STG;
        const LAS float* cum = (const LAS float*)(stg + SS_CUM);
        const float cumL = cum[CL - 1];
#pragma unroll
        for (int s = 0; s < 3; ++s) {
            if (tv[s]) {
                float f[8]; unpack8(rc[s], f);
                const int j = tj[s], g = tg_[s];
                if (g < 4) {
                    const float dt = ((const LAS float*)(stg + SS_DTV))[j];
#pragma unroll
                    for (int e = 0; e < 8; ++e) *(LAS bf16_t*)(stg + SS_XT + (8 * g + e) * LDTB + j * 2) = f2bf(f[e] * dt);
                } else if (g < 12) {
                    const int n0 = 8 * (g - 4);
                    *(LAS u32x4*)(stg + SS_BT + j * LDTB + n0 * 2) = rc[s];
                    const float sc = __expf(cumL - cum[j]);
#pragma unroll
                    for (int e = 0; e < 8; ++e) *(LAS bf16_t*)(stg + SS_BDT + (n0 + e) * LDTB + j * 2) = f2bf(f[e] * sc);
                } else {
                    *(LAS u32x4*)(stg + SS_CT + j * LDTB + 8 * (g - 12) * 2) = rc[s];
                }
            }
        }
    };
    for (int i = tid; i < 32 * LDTB / 4; i += NT) ((LAS unsigned*)(lds + SS_HB))[i] = 0u;
    f32x4 hacc = (f32x4){0.f, 0.f, 0.f, 0.f};
    load(0); store1(0); __syncthreads(); store2(0); __syncthreads();
    for (int c = 0; c < NCH64; ++c) {
        if (c + 1 < NCH64) load(c + 1);
        LAS char* stg = lds + (c & 1) * SS_STG;
        const LAS float* cum = (const LAS float*)(stg + SS_CUM);
        {
            const int lt = wid >> 1;
#pragma unroll
            for (int u = 0; u < 2; ++u) {
                const int st = (wid & 1) * 2 + u;
                f32x4 acc = (f32x4){0.f, 0.f, 0.f, 0.f};
                if (st <= lt) {
#pragma unroll
                    for (int k0 = 0; k0 < 64; k0 += 32) acc = __builtin_amdgcn_mfma_f32_16x16x32_bf16(ldfrag(stg + SS_BT, LDTB, st * 16, k0, lane), ldfrag(stg + SS_CT, LDTB, lt * 16, k0, lane), acc, 0, 0, 0);
                    const int l = lt * 16 + r16, s0 = st * 16 + 4 * q;
                    const float cl = cum[l]; const f32x4 cs = *(const LAS f32x4*)(cum + s0);
#pragma unroll
                    for (int j = 0; j < 4; ++j) acc[j] = (s0 + j <= l) ? acc[j] * __expf(cl - cs[j]) : 0.f;
                }
                st4bf(lds + SS_M + (lt * 16 + r16) * LDTB + (st * 16 + 4 * q) * 2, acc);
            }
        }
        __syncthreads();
        {
            const int lt = wid >> 1, pt = wid & 1;
            f32x4 ya = (f32x4){0.f, 0.f, 0.f, 0.f}, oa = (f32x4){0.f, 0.f, 0.f, 0.f};
#pragma unroll
            for (int k0 = 0; k0 < 64; k0 += 32) {
                ya = __builtin_amdgcn_mfma_f32_16x16x32_bf16(ldfrag(stg + SS_XT, LDTB, pt * 16, k0, lane), ldfrag(lds + SS_M, LDTB, lt * 16, k0, lane), ya, 0, 0, 0);
                oa = __builtin_amdgcn_mfma_f32_16x16x32_bf16(ldfrag(lds + SS_HB, LDTB, pt * 16, k0, lane), ldfrag(stg + SS_CT, LDTB, lt * 16, k0, lane), oa, 0, 0, 0);
            }
            const int l = lt * 16 + r16;
            const float el = __expf(cum[l]);
            const int row = ((const LAS int*)(stg + SS_ROWS))[l];
            u32x2 o; o.x = pk2(ya[0] + el * oa[0], ya[1] + el * oa[1]); o.y = pk2(ya[2] + el * oa[2], ya[3] + el * oa[3]);
            *(u32x2*)(Y + (size_t)row * D + h * 64 + half * 32 + pt * 16 + 4 * q) = o;
            const int ptile = wid >> 2, ntile = wid & 3;
            f32x4 sa = (f32x4){0.f, 0.f, 0.f, 0.f};
#pragma unroll
            for (int k0 = 0; k0 < 64; k0 += 32) sa = __builtin_amdgcn_mfma_f32_16x16x32_bf16(ldfrag(stg + SS_BDT, LDTB, ntile * 16, k0, lane), ldfrag(stg + SS_XT, LDTB, ptile * 16, k0, lane), sa, 0, 0, 0);
            const float dtot = __expf(cum[CL - 1]);
#pragma unroll
            for (int j = 0; j < 4; ++j) hacc[j] = hacc[j] * dtot + sa[j];
        }
        __syncthreads();
        st4bf(lds + SS_HB + ((wid >> 2) * 16 + r16) * LDTB + ((wid & 3) * 16 + 4 * q) * 2, hacc);
        if (c + 1 < NCH64) { store1(c + 1); __syncthreads(); store2(c + 1); }
        __syncthreads();
    }
}

constexpr int MS_QT = 0, MS_KT = MS_QT + 64 * LDTB, MS_KET = MS_KT + 64 * LDTB, MS_VT = MS_KET + 64 * LDTB, MS_SC = MS_VT + 32 * LDTB;
constexpr int MS_STG = MS_SC + 8 * 256;
constexpr int MS_W = 2 * MS_STG, MS_CB = MS_W + 64 * LDTB, MS_ONE = MS_CB + 32 * LDTB, MS_NV = MS_ONE + 16 * LDTB, MS_QN = MS_NV + 256, MS_END = MS_QN + 256;
static_assert(MS_END <= LDS_BYTES - 16, "mLSTM LDS map");
__device__ __forceinline__ void scan_mlstm_c(KP Pk, int layer, int unit, LAS char* lds) {
    asm volatile("" : "+s"(Pk));
    const CAS Params& P = *Pk;
    const int tid = ltid(), lane = tid & 63, wid = tid >> 6, q = lane >> 4, r16 = lane & 15;
    const int seq = unit >> 2, quarter = unit & 3, b = seq >> 3, h = (seq >> 1) & 3, dir = seq & 1;
    const bf16_t* QK = (const bf16_t*)(P.ws + WS_EQK);
    const bf16_t* Pb = (const bf16_t*)(P.ws + WS_P);
    const float* GT = (const float*)(P.ws + WS_EGT);
    bf16_t* Y = (bf16_t*)(P.ws + (dir ? WS_YB : WS_YF));
    int tj[3], tg_[3]; bool tv[3];
#pragma unroll
    for (int s = 0; s < 3; ++s) { const int task = tid + NT * s; tv[s] = task < CL * 20; tj[s] = task / 20; tg_[s] = task % 20; }
    u32x4 rc[3]; float rli = 0.f, rlf = 0.f; int rrow = 0;
    float mprev = -1e30f;
    auto load = [&](int c) {
#pragma unroll
        for (int s = 0; s < 3; ++s) {
            rc[s] = (u32x4){0u, 0u, 0u, 0u};
            if (tv[s]) {
                const int row = scan_row(c * CL + tj[s], b, dir, 0); const int g = tg_[s];
                rc[s] = g < 16 ? *(const u32x4*)(QK + (size_t)row * 512 + (g < 8 ? h * 64 + 8 * g : 256 + h * 64 + 8 * (g - 8)))
                               : *(const u32x4*)(Pb + (size_t)row * LDP_EVEN + 1808 + h * 128 + quarter * 32 + 8 * (g - 16));
            }
        }
        if (tid < CL) { rrow = scan_row(c * CL + tid, b, dir, 0); rli = GT[(size_t)rrow * 32 + 16 + dir * 4 + h]; rlf = GT[(size_t)rrow * 32 + 24 + dir * 4 + h]; }
    };
    auto store1 = [&](int c) {
        if (tid < CL) {
            LAS float* sc = (LAS float*)(lds + (c & 1) * MS_STG + MS_SC);
            float fcum = rlf;
#pragma unroll
            for (int o = 1; o < 64; o <<= 1) { const float t = __shfl_up(fcum, o); if (lane >= o) fcum += t; }
            const float ftot = __shfl(fcum, 63);
            const float g = rli - fcum;
            float pm = g;
#pragma unroll
            for (int o = 1; o < 64; o <<= 1) { const float t = __shfl_up(pm, o); if (lane >= o) pm = fmaxf(pm, t); }
            const float wend = ftot + g;
            float mloc = wend;
#pragma unroll
            for (int o = 1; o < 64; o <<= 1) mloc = fmaxf(mloc, __shfl_xor(mloc, o));
            const float eend = __expf(wend - mloc);
            const float linter = fcum + mprev;
            const float mrow = fmaxf(fcum + pm, linter);
            sc[0 * 64 + tid] = fcum - mrow; sc[1 * 64 + tid] = g; sc[2 * 64 + tid] = __expf(linter - mrow); sc[3 * 64 + tid] = __expf(-mrow); sc[4 * 64 + tid] = eend;
            ((LAS int*)sc)[5 * 64 + tid] = rrow;
            const float mnew = fmaxf(ftot + mprev, mloc);
            if (tid == 0) { sc[6 * 64 + 0] = __expf(ftot + mprev - mnew); sc[6 * 64 + 1] = __expf(mloc - mnew); }
            mprev = mnew;
        }
    };
    auto store2 = [&](int c) {
        LAS char* stg = lds + (c & 1) * MS_STG;
        const LAS float* sc = (const LAS float*)(stg + MS_SC);
#pragma unroll
        for (int s = 0; s < 3; ++s) {
            if (tv[s]) {
                float f[8]; unpack8(rc[s], f);
                const int j = tj[s], g = tg_[s];
                if (g < 8) { *(LAS u32x4*)(stg + MS_QT + j * LDTB + 8 * g * 2) = rc[s]; }
                else if (g < 16) {
                    const int k0 = 8 * (g - 8);
                    *(LAS u32x4*)(stg + MS_KT + j * LDTB + k0 * 2) = rc[s];
                    const float ee = sc[4 * 64 + j];
#pragma unroll
                    for (int e = 0; e < 8; ++e) *(LAS bf16_t*)(stg + MS_KET + (k0 + e) * LDTB + j * 2) = f2bf(f[e] * ee);
                } else {
                    const int v0 = 8 * (g - 16);
#pragma unroll
                    for (int e = 0; e < 8; ++e) { const unsigned wv = rc[s][e >> 1]; *(LAS bf16_t*)(stg + MS_VT + (v0 + e) * LDTB + j * 2) = (bf16_t)((e & 1) ? (wv >> 16) : (wv & 0xffffu)); }
                }
            }
        }
    };
    for (int i = tid; i < 32 * LDTB / 4; i += NT) ((LAS unsigned*)(lds + MS_CB))[i] = 0u;
    for (int i = tid; i < 16 * LDTB / 4; i += NT) ((LAS unsigned*)(lds + MS_ONE))[i] = 0x3f803f80u;
    if (tid < 64) ((LAS float*)(lds + MS_NV))[tid] = 0.f;
    f32x4 cacc = (f32x4){0.f, 0.f, 0.f, 0.f};
    load(0); store1(0); __syncthreads(); store2(0); __syncthreads();
    for (int c = 0; c < NCH64; ++c) {
        if (c + 1 < NCH64) load(c + 1);
        LAS char* stg = lds + (c & 1) * MS_STG;
        const LAS float* sc = (const LAS float*)(stg + MS_SC);
        LAS float* nv = (LAS float*)(lds + MS_NV);
        LAS float* qn = (LAS float*)(lds + MS_QN);
        {
            const int lt = wid >> 1;
#pragma unroll
            for (int u = 0; u < 2; ++u) {
                const int st = (wid & 1) * 2 + u;
                f32x4 acc = (f32x4){0.f, 0.f, 0.f, 0.f};
                if (st <= lt) {
#pragma unroll
                    for (int k0 = 0; k0 < 64; k0 += 32) acc = __builtin_amdgcn_mfma_f32_16x16x32_bf16(ldfrag(stg + MS_KT, LDTB, st * 16, k0, lane), ldfrag(stg + MS_QT, LDTB, lt * 16, k0, lane), acc, 0, 0, 0);
                    const int l = lt * 16 + r16, s0 = st * 16 + 4 * q;
                    const float rt = sc[l]; const f32x4 gs = *(const LAS f32x4*)(sc + 64 + s0);
#pragma unroll
                    for (int j = 0; j < 4; ++j) acc[j] = (s0 + j <= l) ? acc[j] * __expf(rt + gs[j]) : 0.f;
                }
                st4bf(lds + MS_W + (lt * 16 + r16) * LDTB + (st * 16 + 4 * q) * 2, acc);
            }
            if (wid == 0) {
                float a = 0.f;
#pragma unroll
                for (int k0 = 0; k0 < 64; k0 += 8) {
                    const u32x4 tq = *(const LAS u32x4*)(stg + MS_QT + lane * LDTB + k0 * 2); float f[8]; unpack8(tq, f);
#pragma unroll
                    for (int e = 0; e < 8; ++e) a += f[e] * nv[k0 + e];
                }
                qn[lane] = a;
            }
        }
        __syncthreads();
        {
            const int lt = wid >> 1, vt = wid & 1;
            f32x4 na = (f32x4){0.f, 0.f, 0.f, 0.f}, ca = (f32x4){0.f, 0.f, 0.f, 0.f}, da = (f32x4){0.f, 0.f, 0.f, 0.f};
#pragma unroll
            for (int k0 = 0; k0 < 64; k0 += 32) {
                const bf16x8 wf = ldfrag(lds + MS_W, LDTB, lt * 16, k0, lane);
                na = __builtin_amdgcn_mfma_f32_16x16x32_bf16(ldfrag(stg + MS_VT, LDTB, vt * 16, k0, lane), wf, na, 0, 0, 0);
                da = __builtin_amdgcn_mfma_f32_16x16x32_bf16(ldfrag(lds + MS_ONE, LDTB, 0, k0, lane), wf, da, 0, 0, 0);
                ca = __builtin_amdgcn_mfma_f32_16x16x32_bf16(ldfrag(lds + MS_CB, LDTB, vt * 16, k0, lane), ldfrag(stg + MS_QT, LDTB, lt * 16, k0, lane), ca, 0, 0, 0);
            }
            const int l = lt * 16 + r16;
            const float inter = sc[2 * 64 + l], emr = sc[3 * 64 + l];
            const float den = da[0] + inter * qn[l];
            const float inv = 1.f / fmaxf(fabsf(den), emr);
            const int row = ((const LAS int*)sc)[5 * 64 + l];
            u32x2 o; o.x = pk2((na[0] + inter * ca[0]) * inv, (na[1] + inter * ca[1]) * inv); o.y = pk2((na[2] + inter * ca[2]) * inv, (na[3] + inter * ca[3]) * inv);
            *(u32x2*)(Y + (size_t)row * D + 512 + h * 128 + quarter * 32 + vt * 16 + 4 * q) = o;
            const int vtile = wid >> 2, ktile = wid & 3;
            f32x4 sa = (f32x4){0.f, 0.f, 0.f, 0.f};
#pragma unroll
            for (int k0 = 0; k0 < 64; k0 += 32) sa = __builtin_amdgcn_mfma_f32_16x16x32_bf16(ldfrag(stg + MS_KET, LDTB, ktile * 16, k0, lane), ldfrag(stg + MS_VT, LDTB, vtile * 16, k0, lane), sa, 0, 0, 0);
            const float sp = sc[6 * 64 + 0], sl = sc[6 * 64 + 1];
#pragma unroll
            for (int j = 0; j < 4; ++j) cacc[j] = cacc[j] * sp + sl * sa[j];
        }
        __syncthreads();
        st4bf(lds + MS_CB + ((wid >> 2) * 16 + r16) * LDTB + ((wid & 3) * 16 + 4 * q) * 2, cacc);
        if (wid == 1) {
            float a = 0.f;
            for (int s = 0; s < CL; ++s) a += sc[4 * 64 + s] * bf2f(*(const LAS bf16_t*)(stg + MS_KT + s * LDTB + lane * 2));
            nv[lane] = nv[lane] * sc[6 * 64 + 0] + sc[6 * 64 + 1] * a;
        }
        if (c + 1 < NCH64) { store1(c + 1); __syncthreads(); store2(c + 1); }
        __syncthreads();
    }
}

constexpr int HC_RAWF = 0;
constexpr int HC_RAWQ = HC_RAWF + 64 * 128 * 4;
constexpr int HC_SUB = HC_RAWQ + 64 * 128 * 2;
constexpr int HL_QD = 136 * 2;
constexpr int HL_T = 24 * 2;
constexpr int HS_QI = 0, HS_KO = HS_QI + 16 * HL_QD, HS_KET = HS_KO + 16 * HL_QD, HS_ATT = HS_KET + 128 * HL_T, HS_VT = HS_ATT + 16 * HL_T, HS_DEC = HS_VT + 32 * HL_T, HS_SIZE = HS_DEC + 512;
constexpr int HC_SB = HC_SUB + 4 * HS_SIZE;
constexpr int HC_ROWS = HC_SB + 2 * 32 * HL_QD, HC_CST = HC_ROWS + 256, HC_END = HC_CST + 1024;
static_assert(HC_END <= LDS_BYTES - 16, "HGRN2 LDS map");
static_assert(HS_SIZE % 16 == 0 && HC_SB % 16 == 0, "alignment");
__device__ __forceinline__ bf16x8 ldfrag16(const LAS char* tile, int ldb, int row0, int lane) {
    bf16x8 v = *(const LAS bf16x8*)(tile + (row0 + (lane & 15)) * ldb + ((lane >> 4) & 1) * 16);
    if (lane >= 32) v = (bf16x8){0, 0, 0, 0, 0, 0, 0, 0};
    return v;
}
__device__ __forceinline__ void scan_hgrn_c(KP Pk, int layer, int unit, LAS char* lds) {
    asm volatile("" : "+s"(Pk));
    const CAS Params& P = *Pk;
    const int tid = ltid(), lane = tid & 63, wid = tid >> 6, q = lane >> 4, r16 = lane & 15, i_ = layer >> 1;
    const int seq = unit >> 2, quarter = unit & 3, b = seq >> 3, h = (seq >> 1) & 3, dir = seq & 1;
    const bf16_t* Pb = (const bf16_t*)(P.ws + WS_P);
    bf16_t* Y = (bf16_t*)(P.ws + (dir ? WS_YB : WS_YF));
    LAS float* cst = (LAS float*)(lds + HC_CST);
    if (tid < 128) cst[tid] = ((const float*)(P.ws + WS_LB))[layer * 512 + h * 128 + tid];
    else if (tid < 256) cst[tid] = P.hg_f_bias[(size_t)(i_ * 2 + dir) * 512 + h * 128 + tid - 128];
    for (int i = tid; i < 2 * 32 * HL_QD / 4; i += NT) ((LAS unsigned*)(lds + HC_SB))[i] = 0u;
    int tj[5], tg_[5], tcol[5]; bool tv[5];
#pragma unroll
    for (int s = 0; s < 5; ++s) {
        const int task = tid + NT * s; tv[s] = task < 64 * 36; tj[s] = task / 36; tg_[s] = task % 36;
        const int g = tg_[s];
        tcol[s] = g < 16 ? (512 + dir * 512 + h * 128 + 8 * g) : g < 32 ? (h * 128 + 8 * (g - 16)) : (1536 + h * 128 + quarter * 32 + 8 * (g - 32));
    }
    u32x4 rc[5]; int rrow = 0;
    auto load = [&](int c) {
#pragma unroll
        for (int s = 0; s < 5; ++s) {
            rc[s] = (u32x4){0u, 0u, 0u, 0u};
            if (tv[s]) { const int row = scan_row(c * 64 + tj[s], b, dir, 1); rc[s] = *(const u32x4*)(Pb + (size_t)row * LDP_ODD + tcol[s]); }
        }
        if (tid < 64) rrow = scan_row(c * 64 + tid, b, dir, 1);
    };
    auto storeA = [&]() {
#pragma unroll
        for (int s = 0; s < 5; ++s) {
            if (tv[s]) {
                float f[8]; unpack8(rc[s], f);
                const int j = tj[s], g = tg_[s];
                if (g < 16) {
                    float o[8];
#pragma unroll
                    for (int e = 0; e < 8; ++e) { const float lbv = cst[8 * g + e]; o[e] = lbv + (1.f - lbv) * sigmoidf_(f[e] + cst[128 + 8 * g + e]); }
                    LAS float* dst = (LAS float*)(lds + HC_RAWF) + j * 128 + 8 * g;
                    *(LAS f32x4*)dst = (f32x4){o[0], o[1], o[2], o[3]}; *(LAS f32x4*)(dst + 4) = (f32x4){o[4], o[5], o[6], o[7]};
                } else if (g < 32) {
                    float o[8];
#pragma unroll
                    for (int e = 0; e < 8; ++e) o[e] = siluf_(f[e]);
                    *(LAS u32x4*)(lds + HC_RAWQ + (j * 128 + 8 * (g - 16)) * 2) = pack8(o);
                } else {
                    const int v0 = 8 * (g - 32);
                    LAS char* vt = lds + HC_SUB + (j >> 4) * HS_SIZE + HS_VT;
#pragma unroll
                    for (int e = 0; e < 8; ++e) { const unsigned wv = rc[s][e >> 1]; *(LAS bf16_t*)(vt + (v0 + e) * HL_T + (j & 15) * 2) = (bf16_t)((e & 1) ? (wv >> 16) : (wv & 0xffffu)); }
                }
            }
        }
        if (tid < 64) ((LAS int*)(lds + HC_ROWS))[tid] = rrow;
    };
    auto storeB = [&]() {
        const int d = tid & 127, sb = tid >> 7;
        LAS char* st = lds + HC_SUB + sb * HS_SIZE;
        const LAS float* rf = (const LAS float*)(lds + HC_RAWF) + (sb * 16) * 128 + d;
        const LAS bf16_t* rq = (const LAS bf16_t*)(lds + HC_RAWQ) + (sb * 16) * 128 + d;
        float lam = 0.f, lams[16], kfs[16];
#pragma unroll
        for (int t = 0; t < 16; ++t) {
            const float f = rf[t * 128];
            lam += __logf(f);
            const float kf = 1.f - f;
            lams[t] = lam; kfs[t] = kf;
            *(LAS bf16_t*)(st + HS_QI + t * HL_QD + d * 2) = f2bf(bf2f(rq[t * 128]) * __expf(lam));
            *(LAS bf16_t*)(st + HS_KO + t * HL_QD + d * 2) = f2bf(kf * __expf(-lam));
        }
        float ke[16];
#pragma unroll
        for (int t = 0; t < 16; ++t) ke[t] = kfs[t] * __expf(lam - lams[t]);
        *(LAS u32x4*)(st + HS_KET + d * HL_T) = pack8(ke); *(LAS u32x4*)(st + HS_KET + d * HL_T + 16) = pack8(ke + 8);
        ((LAS float*)(st + HS_DEC))[d] = __expf(lam);
    };
    f32x4 sacc[2];
    sacc[0] = sacc[1] = (f32x4){0.f, 0.f, 0.f, 0.f};
    __syncthreads();
    load(0);
    for (int c = 0; c < NSTEPS / 64; ++c) {
        storeA();
        __syncthreads();
        storeB();
        if (c + 1 < NSTEPS / 64) load(c + 1);
        __syncthreads();
        if (wid < 4) {
            LAS char* st = lds + HC_SUB + wid * HS_SIZE;
            f32x4 acc = (f32x4){0.f, 0.f, 0.f, 0.f};
#pragma unroll
            for (int k0 = 0; k0 < 128; k0 += 32) acc = __builtin_amdgcn_mfma_f32_16x16x32_bf16(ldfrag(st + HS_KO, HL_QD, 0, k0, lane), ldfrag(st + HS_QI, HL_QD, 0, k0, lane), acc, 0, 0, 0);
#pragma unroll
            for (int j = 0; j < 4; ++j) acc[j] = (4 * q + j <= r16) ? acc[j] : 0.f;
            st4bf(st + HS_ATT + r16 * HL_T + 4 * q * 2, acc);
        }
        __syncthreads();
#pragma unroll 1
        for (int sb = 0; sb < 4; ++sb) {
            LAS char* st = lds + HC_SUB + sb * HS_SIZE;
            const LAS char* sbr = lds + HC_SB + (sb & 1) * 32 * HL_QD;
            LAS char* sbw = lds + HC_SB + ((sb + 1) & 1) * 32 * HL_QD;
            if (wid < 2) {
                f32x4 ya = __builtin_amdgcn_mfma_f32_16x16x32_bf16(ldfrag16(st + HS_VT, HL_T, wid * 16, lane), ldfrag16(st + HS_ATT, HL_T, 0, lane), (f32x4){0.f, 0.f, 0.f, 0.f}, 0, 0, 0);
#pragma unroll
                for (int k0 = 0; k0 < 128; k0 += 32) ya = __builtin_amdgcn_mfma_f32_16x16x32_bf16(ldfrag(sbr, HL_QD, wid * 16, k0, lane), ldfrag(st + HS_QI, HL_QD, 0, k0, lane), ya, 0, 0, 0);
                const int row = ((const LAS int*)(lds + HC_ROWS))[sb * 16 + r16];
                u32x2 o; o.x = pk2(ya[0], ya[1]); o.y = pk2(ya[2], ya[3]);
                *(u32x2*)(Y + (size_t)row * D + h * 128 + quarter * 32 + wid * 16 + 4 * q) = o;
            }
            {
                const int vt = wid >> 2;
                const bf16x8 vf = ldfrag16(st + HS_VT, HL_T, vt * 16, lane);
#pragma unroll
                for (int u = 0; u < 2; ++u) {
                    const int dt = (wid & 3) * 2 + u;
                    const f32x4 a = __builtin_amdgcn_mfma_f32_16x16x32_bf16(ldfrag16(st + HS_KET, HL_T, dt * 16, lane), vf, (f32x4){0.f, 0.f, 0.f, 0.f}, 0, 0, 0);
                    const f32x4 dc = *(const LAS f32x4*)((const LAS float*)(st + HS_DEC) + dt * 16 + 4 * q);
#pragma unroll
                    for (int j = 0; j < 4; ++j) sacc[u][j] = sacc[u][j] * dc[j] + a[j];
                    st4bf(sbw + (vt * 16 + r16) * HL_QD + (dt * 16 + 4 * q) * 2, sacc[u]);
                }
            }
            __syncthreads();
        }
    }
}

constexpr int RC_RAWW = 0;
constexpr int RC_RAWA = RC_RAWW + 64 * 64 * 4;
constexpr int RC_RAWB = RC_RAWA + 64 * 64 * 2, RC_RAWK = RC_RAWB + 64 * 64 * 2, RC_RAWR = RC_RAWK + 64 * 64 * 2;
constexpr int RC_SUB = RC_RAWR + 64 * 64 * 2;
constexpr int RL_C = 72 * 2, RL_32 = 40 * 2, RL_16 = 24 * 2;
constexpr int RS_AT = 0, RS_RT = RS_AT + 16 * RL_C, RS_KT = RS_RT + 16 * RL_C, RS_BT = RS_KT + 16 * RL_C, RS_KBH = RS_BT + 16 * RL_C, RS_AAK = RS_KBH + 64 * RL_32,
              RS_ARKB = RS_AAK + 16 * RL_16, RS_T = RS_ARKB + 16 * RL_32, RS_AABF = RS_T + 16 * RL_16, RS_GL = RS_AABF + 16 * 16 * 4, RS_VU = RS_GL + 256, RS_SIZE = RS_VU + 32 * RL_32;
constexpr int RC_SB = RC_SUB + 4 * RS_SIZE;
constexpr int RC_RHT = RC_SB + 32 * RL_C;
constexpr int RC_ROWS = RC_RHT + 32 * RL_16, RC_END = RC_ROWS + 256;
static_assert(RC_END <= LDS_BYTES - 16, "RWKV LDS map");
static_assert(RS_SIZE % 16 == 0 && RC_SB % 16 == 0 && RC_RHT % 16 == 0, "alignment");
__device__ __forceinline__ void scan_rwkv_c(KP Pk, int layer, int unit, LAS char* lds) {
    asm volatile("" : "+s"(Pk));
    const CAS Params& P = *Pk;
    const int tid = ltid(), lane = tid & 63, wid = tid >> 6, q = lane >> 4, r16 = lane & 15;
    const int seq = unit >> 1, half = unit & 1, b = seq >> 4, h = (seq >> 1) & 7, dir = seq & 1;
    bf16_t* Y = (bf16_t*)(P.ws + (dir ? WS_YB : WS_YF));
    const float* dec = (const float*)(P.ws + WS_RWDEC) + (size_t)dir * NROWS * 512;
    for (int i = tid; i < 32 * RL_C / 4; i += NT) ((LAS unsigned*)(lds + RC_SB))[i] = 0u;
    const unsigned char* const wsb = P.ws;
    u32x4 rc[7]; int rrow = 0;
    auto load = [&](int c) {
        int tl = tid; asm volatile("" : "+v"(tl));
#pragma unroll
        for (int s = 0; s < 7; ++s) {
            const int task = tl + NT * s, j = task / 52, g = task - 52 * j;
            rc[s] = (u32x4){0u, 0u, 0u, 0u};
            if (task < 64 * 52) {
                const int row = scan_row(c * 64 + j, b, dir, 1);
                const unsigned char* p;
                if (g < 8)       p = wsb + WS_RWR  + ((size_t)row * 512 + h * 64 + 8 * g) * 2;
                else if (g < 16) p = wsb + WS_RWK  + ((size_t)row * 512 + h * 64 + 8 * (g - 8)) * 2;
                else if (g < 24) p = wsb + WS_RWKK + ((size_t)row * 512 + h * 64 + 8 * (g - 16)) * 2;
                else if (g < 32) p = wsb + WS_RWB  + ((size_t)row * 512 + h * 64 + 8 * (g - 24)) * 2;
                else if (g < 36) p = wsb + WS_RWV  + ((size_t)row * 512 + h * 64 + half * 32 + 8 * (g - 32)) * 2;
                else             p = (const unsigned char*)(dec + (size_t)row * 512 + h * 64 + 4 * (g - 36));
                rc[s] = *(const u32x4*)p;
            }
        }
        if (tid < 64) rrow = scan_row(c * 64 + tid, b, dir, 1);
    };
    auto storeA = [&]() {
        int tl = tid; asm volatile("" : "+v"(tl));
#pragma unroll
        for (int s = 0; s < 7; ++s) {
            const int task = tl + NT * s, j = task / 52, g = task - 52 * j;
            if (task < 64 * 52) {
                if (g < 8)       *(LAS u32x4*)(lds + RC_RAWR + (j * 64 + 8 * g) * 2) = rc[s];
                else if (g < 16) *(LAS u32x4*)(lds + RC_RAWK + (j * 64 + 8 * (g - 8)) * 2) = rc[s];
                else if (g < 24) *(LAS u32x4*)(lds + RC_RAWA + (j * 64 + 8 * (g - 16)) * 2) = rc[s];
                else if (g < 32) *(LAS u32x4*)(lds + RC_RAWB + (j * 64 + 8 * (g - 24)) * 2) = rc[s];
                else if (g < 36) {
                    LAS char* vu = lds + RC_SUB + (j >> 4) * RS_SIZE + RS_VU;
                    const int v0 = 8 * (g - 32);
#pragma unroll
                    for (int e = 0; e < 8; ++e) { const unsigned wv = rc[s][e >> 1]; *(LAS bf16_t*)(vu + (v0 + e) * RL_32 + (j & 15) * 2) = (bf16_t)((e & 1) ? (wv >> 16) : (wv & 0xffffu)); }
                } else *(LAS u32x4*)(lds + RC_RAWW + (j * 64 + 4 * (g - 36)) * 4) = rc[s];
            }
        }
        if (tid < 64) ((LAS int*)(lds + RC_ROWS))[tid] = rrow;
    };
    auto storeB = [&]() {
        const int c = tid & 63, sb = (tid >> 6) & 3, role = tid >> 8;
        LAS char* st = lds + RC_SUB + sb * RS_SIZE;
        const LAS float* rw = (const LAS float*)(lds + RC_RAWW) + (sb * 16) * 64 + c;
        float g = 1.f;
        if (role == 0) {
            const LAS bf16_t* ra = (const LAS bf16_t*)(lds + RC_RAWA) + (sb * 16) * 64 + c;
            const LAS bf16_t* rr = (const LAS bf16_t*)(lds + RC_RAWR) + (sb * 16) * 64 + c;
#pragma unroll
            for (int t = 0; t < 16; ++t) {
                const float gp = g; g *= rw[t * 64];
                *(LAS bf16_t*)(st + RS_AT + t * RL_C + c * 2) = f2bf(-bf2f(ra[t * 64]) * gp);
                *(LAS bf16_t*)(st + RS_RT + t * RL_C + c * 2) = f2bf(bf2f(rr[t * 64]) * g);
            }
        } else {
            const LAS bf16_t* rk = (const LAS bf16_t*)(lds + RC_RAWK) + (sb * 16) * 64 + c;
            const LAS bf16_t* rb = (const LAS bf16_t*)(lds + RC_RAWB) + (sb * 16) * 64 + c;
            float ks[16], bs[16];
#pragma unroll
            for (int t = 0; t < 16; ++t) {
                g *= rw[t * 64];
                const float inv = 1.f / g;
                ks[t] = bf2f(rk[t * 64]) * inv; bs[t] = bf2f(rb[t * 64]) * inv;
                *(LAS bf16_t*)(st + RS_KT + t * RL_C + c * 2) = f2bf(ks[t]);
                *(LAS bf16_t*)(st + RS_BT + t * RL_C + c * 2) = f2bf(bs[t]);
            }
#pragma unroll
            for (int t = 0; t < 16; ++t) { ks[t] *= g; bs[t] *= g; }
            LAS char* row = st + RS_KBH + c * RL_32;
            *(LAS u32x4*)row = pack8(ks); *(LAS u32x4*)(row + 16) = pack8(ks + 8); *(LAS u32x4*)(row + 32) = pack8(bs); *(LAS u32x4*)(row + 48) = pack8(bs + 8);
            ((LAS float*)(st + RS_GL))[c] = g;
        }
    };
    f32x4 sacc[4];
#pragma unroll
    for (int i = 0; i < 4; ++i) sacc[i] = (f32x4){0.f, 0.f, 0.f, 0.f};
    __syncthreads();
    load(0);
    for (int c = 0; c < NSTEPS / 64; ++c) {
        storeA();
        __syncthreads();
        storeB();
        if (c + 1 < NSTEPS / 64) load(c + 1);
        __syncthreads();
#pragma unroll
        for (int u = 0; u < 2; ++u) {
            const int task = wid + 8 * u, m = task & 3, sb = task >> 2;
            LAS char* st = lds + RC_SUB + sb * RS_SIZE;
            const LAS char* ta = st + ((m == 0 || m == 3) ? RS_BT : RS_KT);
            const LAS char* tb = st + (m < 2 ? RS_AT : RS_RT);
            f32x4 acc = (f32x4){0.f, 0.f, 0.f, 0.f};
#pragma unroll
            for (int k0 = 0; k0 < 64; k0 += 32) acc = __builtin_amdgcn_mfma_f32_16x16x32_bf16(ldfrag(ta, RL_C, 0, k0, lane), ldfrag(tb, RL_C, 0, k0, lane), acc, 0, 0, 0);
#pragma unroll
            for (int j = 0; j < 4; ++j) { const int s = 4 * q + j; acc[j] = (m < 2 ? (s < r16) : (s <= r16)) ? acc[j] : 0.f; }
            if (m == 0) *(LAS f32x4*)((LAS float*)(st + RS_AABF) + r16 * 16 + 4 * q) = acc;
            else if (m == 1) st4bf(st + RS_AAK + r16 * RL_16 + 4 * q * 2, acc);
            else if (m == 2) st4bf(st + RS_ARKB + r16 * RL_32 + 4 * q * 2, acc);
            else st4bf(st + RS_ARKB + r16 * RL_32 + (16 + 4 * q) * 2, acc);
        }
        __syncthreads();
        if (wid < 4) {
            LAS char* st = lds + RC_SUB + wid * RS_SIZE;
            const LAS float* A = (const LAS float*)(st + RS_AABF);
            const int j = lane & 15;
            float tc[16];
#pragma unroll
            for (int t = 0; t < 16; ++t) {
                float val = (t == j) ? 1.f : 0.f;
                const f32x4 a0 = *(const LAS f32x4*)(A + t * 16), a1 = *(const LAS f32x4*)(A + t * 16 + 4), a2 = *(const LAS f32x4*)(A + t * 16 + 8), a3 = *(const LAS f32x4*)(A + t * 16 + 12);
                const float ar[16] = {a0[0], a0[1], a0[2], a0[3], a1[0], a1[1], a1[2], a1[3], a2[0], a2[1], a2[2], a2[3], a3[0], a3[1], a3[2], a3[3]};
#pragma unroll
                for (int s = 0; s < 16; ++s) if (s < t) val += ar[s] * tc[s];
                tc[t] = val;
            }
            if (lane < 16) {
#pragma unroll
                for (int t = 0; t < 16; ++t) *(LAS bf16_t*)(st + RS_T + t * RL_16 + j * 2) = f2bf(tc[t]);
            }
        }
        __syncthreads();
        if (wid < 2) {
            LAS char* sbt = lds + RC_SB + wid * 16 * RL_C;
            LAS char* rht = lds + RC_RHT + wid * 16 * RL_16;
#pragma unroll 1
            for (int sb = 0; sb < 4; ++sb) {
                LAS char* st = lds + RC_SUB + sb * RS_SIZE;
                LAS char* vu = st + RS_VU + wid * 16 * RL_32;
                f32x4 acc = __builtin_amdgcn_mfma_f32_16x16x32_bf16(ldfrag16(st + RS_AAK, RL_16, 0, lane), ldfrag16(vu, RL_32, 0, lane), (f32x4){0.f, 0.f, 0.f, 0.f}, 0, 0, 0);
#pragma unroll
                for (int k0 = 0; k0 < 64; k0 += 32) acc = __builtin_amdgcn_mfma_f32_16x16x32_bf16(ldfrag(st + RS_AT, RL_C, 0, k0, lane), ldfrag(sbt, RL_C, 0, k0, lane), acc, 0, 0, 0);
                st4bf(rht + r16 * RL_16 + 4 * q * 2, acc);
                asm volatile("s_waitcnt lgkmcnt(0)" ::: "memory");
                acc = __builtin_amdgcn_mfma_f32_16x16x32_bf16(ldfrag16(st + RS_T, RL_16, 0, lane), ldfrag16(rht, RL_16, 0, lane), (f32x4){0.f, 0.f, 0.f, 0.f}, 0, 0, 0);
                st4bf(vu + r16 * RL_32 + (16 + 4 * q) * 2, acc);
                asm volatile("s_waitcnt lgkmcnt(0)" ::: "memory");
                const bf16x8 vuf = ldfrag(vu, RL_32, 0, 0, lane);
                f32x4 ya = __builtin_amdgcn_mfma_f32_16x16x32_bf16(vuf, ldfrag(st + RS_ARKB, RL_32, 0, 0, lane), (f32x4){0.f, 0.f, 0.f, 0.f}, 0, 0, 0);
#pragma unroll
                for (int k0 = 0; k0 < 64; k0 += 32) ya = __builtin_amdgcn_mfma_f32_16x16x32_bf16(ldfrag(sbt, RL_C, 0, k0, lane), ldfrag(st + RS_RT, RL_C, 0, k0, lane), ya, 0, 0, 0);
                {
                    const int row = ((const LAS int*)(lds + RC_ROWS))[sb * 16 + r16];
                    u32x2 o; o.x = pk2(ya[0], ya[1]); o.y = pk2(ya[2], ya[3]);
                    *(u32x2*)(Y + (size_t)row * D + 512 + h * 64 + half * 32 + wid * 16 + 4 * q) = o;
                }
                asm volatile("s_waitcnt lgkmcnt(0)" ::: "memory");
#pragma unroll
                for (int kt = 0; kt < 4; ++kt) {
                    const f32x4 a = __builtin_amdgcn_mfma_f32_16x16x32_bf16(ldfrag(st + RS_KBH, RL_32, kt * 16, 0, lane), vuf, (f32x4){0.f, 0.f, 0.f, 0.f}, 0, 0, 0);
                    const f32x4 gl = *(const LAS f32x4*)((const LAS float*)(st + RS_GL) + kt * 16 + 4 * q);
#pragma unroll
                    for (int j = 0; j < 4; ++j) sacc[kt][j] = sacc[kt][j] * gl[j] + a[j];
                    st4bf(sbt + r16 * RL_C + (kt * 16 + 4 * q) * 2, sacc[kt]);
                }
                asm volatile("s_waitcnt lgkmcnt(0)" ::: "memory");
            }
        }
        __syncthreads();
    }
}

__device__ __forceinline__ void phase_prep1(KP Pk, int layer) {
    asm volatile("" : "+s"(Pk));
    const CAS Params& P = *Pk;
    const int tid = ltid(), lane = tid & 63, wid = tid >> 6, i_ = layer >> 1;
    const bf16_t* Pb = (const bf16_t*)(P.ws + WS_P);
    bf16_t* R = (bf16_t*)(P.ws + WS_RWR); bf16_t* K = (bf16_t*)(P.ws + WS_RWK); bf16_t* V = (bf16_t*)(P.ws + WS_RWV); bf16_t* KK = (bf16_t*)(P.ws + WS_RWKK);
    bf16_t* LA = (bf16_t*)(P.ws + WS_LA);
    const float* mu = P.rw_mu + (size_t)i_ * 1856;
    for (int r = blockIdx.x * 8 + wid; r < NROWS; r += gridDim.x * 8) {
        int rprev = -1, rnext = -1;
        if (r < NCTX) { const int t = r & 255; if (t > 0) rprev = r - 1; if (t < CTXL - 1) rnext = r + 1; }
        else {
            const int bs = (r - NCTX) >> 13, s = (r - NCTX) & 8191, sg = ((s & 63) << 7) + (s >> 6);
            if (sg > 0) { const int g2 = sg - 1; rprev = NCTX + bs * SEQ + ((g2 & 127) << 6) + (g2 >> 7); }
            if (sg < SEQ - 1) { const int g2 = sg + 1; rnext = NCTX + bs * SEQ + ((g2 & 127) << 6) + (g2 >> 7); }
        }
        const bf16_t* pc = Pb + (size_t)r * LDP_ODD + 2560;
        const bf16_t* pp = Pb + (size_t)(rprev < 0 ? r : rprev) * LDP_ODD + 2560;
        const bf16_t* pn = Pb + (size_t)(rnext < 0 ? r : rnext) * LDP_ODD + 2560;
        const float mp = rprev < 0 ? 0.f : 0.5f, mn = rnext < 0 ? 0.f : 0.5f;
        auto mix8 = [&](int col, float* o) {
            float fc[8], fp[8], fn[8];
            unpack8(*(const u32x4*)(pc + col), fc); unpack8(*(const u32x4*)(pp + col), fp); unpack8(*(const u32x4*)(pn + col), fn);
#pragma unroll
            for (int e = 0; e < 8; ++e) o[e] = fc[e] + mu[col + e] * (mp * fp[e] + mn * fn[e] - fc[e]);
        };
        float o[8];
        mix8(8 * lane, o); *(u32x4*)(R + (size_t)r * 512 + 8 * lane) = pack8(o);
        mix8(1024 + 8 * lane, o); *(u32x4*)(V + (size_t)r * 512 + 8 * lane) = pack8(o);
        mix8(512 + 8 * lane, o); *(u32x4*)(K + (size_t)r * 512 + 8 * lane) = pack8(o);
        {
            float kk[8], ss = 0.f;
#pragma unroll
            for (int e = 0; e < 8; ++e) { kk[e] = o[e] * P.rw_k_k[i_ * 512 + 8 * lane + e]; ss += kk[e] * kk[e]; }
            ss = group_sum<8>(ss);
            const float rn = rsqrtf(fmaxf(ss, 1e-12f));
#pragma unroll
            for (int e = 0; e < 8; ++e) kk[e] *= rn;
            *(u32x4*)(KK + (size_t)r * 512 + 8 * lane) = pack8(kk);
        }
        if (lane < 40) {
            mix8(1536 + 8 * lane, o);
            if (lane < 16) {
#pragma unroll
                for (int e = 0; e < 8; ++e) o[e] = tanhf(o[e]);
            } else if (lane >= 24) {
#pragma unroll
                for (int e = 0; e < 8; ++e) o[e] = sigmoidf_(o[e]);
            }
            *(u32x4*)(LA + (size_t)r * 320 + 8 * lane) = pack8(o);
        }
    }
}

__device__ __forceinline__ void phase_out_even(KP Pk, int layer) {
    asm volatile("" : "+s"(Pk));
    const CAS Params& P = *Pk;
    const int tid = ltid(), lane = tid & 63, wid = tid >> 6, i_ = layer >> 1;
    const bf16_t* Pb = (const bf16_t*)(P.ws + WS_P);
    const bf16_t* Yf = (const bf16_t*)(P.ws + WS_YF); const bf16_t* Yb = (const bf16_t*)(P.ws + WS_YB);
    bf16_t* feat = (bf16_t*)(P.ws + WS_FEAT);
    const int r0 = (layer == DEPTH - 1) ? NCTX : 0;
    const bf16_t* XBC = (const bf16_t*)(P.ws + WS_EXBC);
    float nwa[8], nwb[8];
#pragma unroll
    for (int e = 0; e < 8; ++e) { nwa[e] = P.ssd_norm_w[i_ * 512 + 8 * lane + e]; nwb[e] = P.ml_norm_w[i_ * 512 + 8 * lane + e]; }
    const float dsk = P.ssd_d[i_ * 8 + (lane >> 3)];
    for (int r = r0 + blockIdx.x * 8 + wid; r < NROWS; r += gridDim.x * 8) {
        const bf16_t* pr = Pb + (size_t)r * LDP_EVEN;
        float y[8];
        {
            float a[8], bb[8], xsv[8], z[8];
            unpack8(*(const u32x4*)(Yf + (size_t)r * D + 8 * lane), a); unpack8(*(const u32x4*)(Yb + (size_t)r * D + 8 * lane), bb);
            unpack8(*(const u32x4*)(XBC + (size_t)r * 768 + 8 * lane), xsv); unpack8(*(const u32x4*)(pr + 8 * lane), z);
            float ss = 0.f;
#pragma unroll
            for (int e = 0; e < 8; ++e) {
                y[e] = (a[e] + bb[e] + dsk * xsv[e]) * siluf_(z[e]); ss += y[e] * y[e];
            }
            ss = wave_sum(ss);
            const float rn = rsqrtf(ss * (1.f / 512.f) + 1e-6f);
#pragma unroll
            for (int e = 0; e < 8; ++e) y[e] = y[e] * rn * nwa[e];
            *(u32x4*)(feat + (size_t)r * D + 8 * lane) = pack8(y);
        }
        {
            float a[8], bb[8], o[8];
            unpack8(*(const u32x4*)(Yf + (size_t)r * D + 512 + 8 * lane), a); unpack8(*(const u32x4*)(Yb + (size_t)r * D + 512 + 8 * lane), bb);
            unpack8(*(const u32x4*)(pr + 2320 + 8 * lane), o);
            float s = 0.f;
#pragma unroll
            for (int e = 0; e < 8; ++e) { y[e] = a[e] + bb[e]; s += y[e]; }
            const float mean = group_sum<16>(s) * (1.f / 128.f);
            float ss = 0.f;
#pragma unroll
            for (int e = 0; e < 8; ++e) { y[e] -= mean; ss += y[e] * y[e]; }
            const float rn = rsqrtf(group_sum<16>(ss) * (1.f / 128.f) + 1e-6f);
#pragma unroll
            for (int e = 0; e < 8; ++e) y[e] = sigmoidf_(o[e]) * (y[e] * rn) * nwb[e];
            *(u32x4*)(feat + (size_t)r * D + 512 + 8 * lane) = pack8(y);
        }
    }
}
__device__ __forceinline__ void phase_out_odd(KP Pk, int layer) {
    asm volatile("" : "+s"(Pk));
    const CAS Params& P = *Pk;
    const int tid = ltid(), lane = tid & 63, wid = tid >> 6, i_ = layer >> 1;
    const bf16_t* Pb = (const bf16_t*)(P.ws + WS_P);
    const bf16_t* Yf = (const bf16_t*)(P.ws + WS_YF); const bf16_t* Yb = (const bf16_t*)(P.ws + WS_YB);
    const bf16_t* R = (const bf16_t*)(P.ws + WS_RWR); const bf16_t* K = (const bf16_t*)(P.ws + WS_RWK); const bf16_t* V = (const bf16_t*)(P.ws + WS_RWV); const bf16_t* G = (const bf16_t*)(P.ws + WS_RWG);
    bf16_t* feat = (bf16_t*)(P.ws + WS_FEAT);
    const int r0 = (layer == DEPTH - 1) ? NCTX : 0;
    float nwc[8], rk[8], lw[8], lbv[8];
#pragma unroll
    for (int e = 0; e < 8; ++e) {
        nwc[e] = P.hg_norm_w[i_ * 512 + 8 * lane + e]; rk[e] = P.rw_r_k[i_ * 512 + 8 * lane + e];
        lw[e] = P.rw_ln_w[i_ * 512 + 8 * lane + e]; lbv[e] = P.rw_ln_b[i_ * 512 + 8 * lane + e];
    }
    for (int r = r0 + blockIdx.x * 8 + wid; r < NROWS; r += gridDim.x * 8) {
        float y[8];
        {
            float a[8], bb[8], g[8];
            unpack8(*(const u32x4*)(Yf + (size_t)r * D + 8 * lane), a); unpack8(*(const u32x4*)(Yb + (size_t)r * D + 8 * lane), bb);
            unpack8(*(const u32x4*)(Pb + (size_t)r * LDP_ODD + 2048 + 8 * lane), g);
            float ss = 0.f;
#pragma unroll
            for (int e = 0; e < 8; ++e) { y[e] = a[e] + bb[e]; ss += y[e] * y[e]; }
            const float rn = rsqrtf(group_sum<16>(ss) * (1.f / 128.f) + 1e-6f);
#pragma unroll
            for (int e = 0; e < 8; ++e) y[e] = y[e] * rn * nwc[e] * siluf_(g[e]);
            *(u32x4*)(feat + (size_t)r * D + 8 * lane) = pack8(y);
        }
        {
            float a[8], bb[8], rr[8], kk[8], vv[8], g[8];
            unpack8(*(const u32x4*)(Yf + (size_t)r * D + 512 + 8 * lane), a); unpack8(*(const u32x4*)(Yb + (size_t)r * D + 512 + 8 * lane), bb);
            unpack8(*(const u32x4*)(R + (size_t)r * 512 + 8 * lane), rr); unpack8(*(const u32x4*)(K + (size_t)r * 512 + 8 * lane), kk);
            unpack8(*(const u32x4*)(V + (size_t)r * 512 + 8 * lane), vv); unpack8(*(const u32x4*)(G + (size_t)r * 512 + 8 * lane), g);
            float s = 0.f, bs = 0.f;
#pragma unroll
            for (int e = 0; e < 8; ++e) { y[e] = a[e] + bb[e]; s += y[e]; bs += rr[e] * kk[e] * rk[e]; }
            const float mean = group_sum<8>(s) * (1.f / 64.f); bs = group_sum<8>(bs);
            float ss = 0.f;
#pragma unroll
            for (int e = 0; e < 8; ++e) { y[e] -= mean; ss += y[e] * y[e]; }
            const float rn = rsqrtf(group_sum<8>(ss) * (1.f / 64.f) + 64e-5f);
#pragma unroll
            for (int e = 0; e < 8; ++e) y[e] = (y[e] * rn * lw[e] + lbv[e] + bs * vv[e]) * g[e];
            *(u32x4*)(feat + (size_t)r * D + 512 + 8 * lane) = pack8(y);
        }
    }
}

#ifndef MK_DOUBLE
#define MK_DOUBLE 0
#endif
#define REP(bit, body) do { body; if (MK_DOUBLE & (bit)) { body; } } while (0)
__device__ __forceinline__ void phase_expconv(KP Pk, int layer, LAS char* lds) {
    asm volatile("" : "+s"(Pk));
    const CAS Params& P = *Pk;
    const int tid = ltid(), lane = tid & 63, wid = tid >> 6;
    {
        LAS float* scr = (LAS float*)(lds + wid * 8448);
        const int gw = blockIdx.x * 8 + wid, NGW = gridDim.x * 8;
        bf16_t* gu = (bf16_t*)(P.ws + WS_EXPGU); bf16_t* dw = (bf16_t*)(P.ws + WS_EXPD);
        constexpr int IG = 16 * 16, IDN = 8 * 32;
        for (int it = gw; it < NEXP * (2 * IG + IDN); it += NGW) {
            const int e = it / (2 * IG + IDN); int r = it % (2 * IG + IDN);
            const size_t eo = (size_t)(layer * NEXP + e);
            if (r < IG) { transpose_item(P.exp_w_gate + eo * D * DEXP, D, DEXP, gu + (size_t)e * 1024 * 1024, 1, scr, r, lane); continue; } r -= IG;
            if (r < IG) { transpose_item(P.exp_w_up + eo * D * DEXP, D, DEXP, gu + (size_t)e * 1024 * 1024, 2, scr, r, lane); continue; } r -= IG;
            transpose_item(P.exp_w_down + eo * DEXP * D, DEXP, D, dw + (size_t)e * 1024 * 512, 0, scr, r, lane);
        }
    }
}
__device__ __forceinline__ void phase_ln1(KP Pk, int layer, LAS char* lds) {
    asm volatile("" : "+s"(Pk));
    const CAS Params& P = *Pk;
    const int tid = ltid(), lane = tid & 63, wid = tid >> 6;
    REP(8, phase_expconv(Pk, layer, lds));
    __syncthreads();
    LAS float* rwT = (LAS float*)lds;
    LAS float* scs = (LAS float*)(lds + 32 * 1024 * 4) + wid * 32;
    LAS int* lcnt = (LAS int*)(lds + 32 * 1024 * 4 + 1024);
    LAS int* lbase = lcnt + 32;
    LAS int* asg = lcnt + 64;
    if (tid < 32) lcnt[tid] = 0;
    for (int i = tid; i < D * NEXP; i += NT) { const int col = i >> 5, e = i & 31; rwT[e * 1024 + col] = P.router_w[i]; }
    __syncthreads();
    const bf16_t* yo = (const bf16_t*)(P.ws + WS_YO);
    bf16_t* act = (bf16_t*)(P.ws + WS_ACT);
    float* xc = (float*)(P.ws + WS_XC);
    int* cnt = (int*)(P.ws + WS_CNT) + layer * 32 * CNT_STRIDE;
    int* list = (int*)(P.ws + WS_LIST);
    float* wts = (float*)(P.ws + WS_WTS);
    const float* lg = P.ln_g + (size_t)(layer * 2 + 0) * D; const float* lb = P.ln_b + (size_t)(layer * 2 + 0) * D;
    const int r0 = (layer == DEPTH - 1) ? NCTX : 0;
    for (int r = r0 + blockIdx.x * 8 + wid; r < NROWS; r += gridDim.x * 8) {
        const int m = row_mod(r);
        float* xr = r < NCTX ? xc + (size_t)r * D : P.out + (size_t)(r - NCTX) * D;
        const float* g1 = modvec(P.ws, layer, m, 2); const float* sh2 = modvec(P.ws, layer, m, 3); const float* sc2 = modvec(P.ws, layer, m, 4);
        f32x4 v[4]; float s = 0.f;
#pragma unroll
        for (int i = 0; i < 4; ++i) {
            const int c = 4 * lane + 256 * i;
            const f32x4 xv = *(const f32x4*)(xr + c), gv = *(const f32x4*)(g1 + c);
            const u32x2 yv = *(const u32x2*)(yo + (size_t)r * D + c);
            v[i][0] = ALPHA * xv[0] + gv[0] * bflo(yv.x); v[i][1] = ALPHA * xv[1] + gv[1] * bfhi(yv.x);
            v[i][2] = ALPHA * xv[2] + gv[2] * bflo(yv.y); v[i][3] = ALPHA * xv[3] + gv[3] * bfhi(yv.y);
            s += (v[i][0] + v[i][1]) + (v[i][2] + v[i][3]);
        }
        const float mean = wave_sum(s) * (1.f / D);
        float s2 = 0.f;
#pragma unroll
        for (int i = 0; i < 4; ++i) { v[i] = v[i] - mean; s2 += (v[i][0] * v[i][0] + v[i][1] * v[i][1]) + (v[i][2] * v[i][2] + v[i][3] * v[i][3]); }
        const float rstd = rsqrtf(wave_sum(s2) * (1.f / D) + 1e-5f);
        float acc[32];
#pragma unroll
        for (int e = 0; e < 32; ++e) acc[e] = 0.f;
#pragma unroll
        for (int i = 0; i < 4; ++i) {
            const int c = 4 * lane + 256 * i;
            const f32x4 gg = *(const f32x4*)(lg + c), bb = *(const f32x4*)(lb + c), s2v = *(const f32x4*)(sc2 + c), h2v = *(const f32x4*)(sh2 + c);
            f32x4 xn, hv;
#pragma unroll
            for (int j = 0; j < 4; ++j) { xn[j] = v[i][j] * rstd * gg[j] + bb[j]; hv[j] = xn[j] * (1.f + s2v[j]) + h2v[j]; }
            *(f32x4*)(xr + c) = xn;
            u32x2 o; o.x = pk2(hv[0], hv[1]); o.y = pk2(hv[2], hv[3]); *(u32x2*)(act + (size_t)r * D + c) = o;
#pragma unroll
            for (int e = 0; e < 32; ++e) { const f32x4 w = *(const LAS f32x4*)(rwT + e * 1024 + c); acc[e] += (hv[0] * w[0] + hv[1] * w[1]) + (hv[2] * w[2] + hv[3] * w[3]); }
        }
#pragma unroll
        for (int st = 0; st < 5; ++st) {
            const int half = 16 >> st, msk = 32 >> st;
            const bool up = (lane & msk) != 0;
#pragma unroll
            for (int j = 0; j < 16; ++j) {
                if (j < half) {
                    const float keep = up ? acc[j + half] : acc[j], send = up ? acc[j] : acc[j + half];
                    acc[j] = keep + __shfl_xor(send, msk);
                }
            }
        }
        acc[0] += __shfl_xor(acc[0], 1);
        {
            const int e = (lane >> 1) & 31;
            const int eidx = ((e >> 4) & 1) * 16 + ((e >> 3) & 1) * 8 + ((e >> 2) & 1) * 4 + ((e >> 1) & 1) * 2 + (e & 1);
            if ((lane & 1) == 0) scs[eidx] = acc[0];
        }
        asm volatile("s_waitcnt lgkmcnt(0)" ::: "memory");
        float best = -1e30f; int bg = 0;
#pragma unroll
        for (int g = 0; g < 8; ++g) {
            float m1 = -1e30f, m2 = -1e30f;
#pragma unroll
            for (int k = 0; k < 4; ++k) { const float vsc = sigmoidf_(scs[g * 4 + k]) + P.router_bias[g * 4 + k]; if (vsc > m1) { m2 = m1; m1 = vsc; } else if (vsc > m2) m2 = vsc; }
            const float gs = m1 + m2;
            if (gs > best) { best = gs; bg = g; }
        }
        float sv[4], bv[4];
#pragma unroll
        for (int k = 0; k < 4; ++k) { sv[k] = sigmoidf_(scs[bg * 4 + k]); bv[k] = sv[k] + P.router_bias[bg * 4 + k]; }
        int i1 = 0; float b1 = bv[0];
#pragma unroll
        for (int k = 1; k < 4; ++k) if (bv[k] > b1) { b1 = bv[k]; i1 = k; }
        int i2 = -1; float b2 = -1e30f;
#pragma unroll
        for (int k = 0; k < 4; ++k) if (k != i1 && bv[k] > b2) { b2 = bv[k]; i2 = k; }
        float s1 = sv[0], s2s = sv[0];
#pragma unroll
        for (int k = 1; k < 4; ++k) { if (i1 == k) s1 = sv[k]; if (i2 == k) s2s = sv[k]; }
        if (lane == 0) {
            const int e0 = bg * 4 + i1, e1 = bg * 4 + i2;
            const float inv = 1.f / (s1 + s2s);
            const int li = ((r - r0 - blockIdx.x * 8 - wid) / (int)(gridDim.x * 8)) * 8 + wid;
            const int p0 = __hip_atomic_fetch_add(&lcnt[e0], 1, __ATOMIC_RELAXED, __HIP_MEMORY_SCOPE_WORKGROUP);
            const int p1 = __hip_atomic_fetch_add(&lcnt[e1], 1, __ATOMIC_RELAXED, __HIP_MEMORY_SCOPE_WORKGROUP);
            asg[2 * li] = (e0 << 16) | p0; asg[2 * li + 1] = (e1 << 16) | p1;
            wts[2 * r] = s1 * inv; wts[2 * r + 1] = s2s * inv;
        }
    }
    __syncthreads();
    if (tid < 32) lbase[tid] = atomicAdd(&cnt[tid * CNT_STRIDE], lcnt[tid]);
    __syncthreads();
    for (int idx = tid; idx < 2 * 136; idx += NT) {
        const int li = idx >> 1, k = idx & 1, it = li >> 3, w = li & 7;
        const int r = r0 + blockIdx.x * 8 + w + it * (int)(gridDim.x * 8);
        if (r < NROWS) { const int v = asg[idx], e = v >> 16, lp = v & 0xffff; list[(size_t)e * LISTCAP + lbase[e] + lp] = 2 * r + k; }
    }
}

__device__ __forceinline__ void phase_ln2(KP Pk, int layer) {
    asm volatile("" : "+s"(Pk));
    const CAS Params& P = *Pk;
    const int tid = ltid(), lane = tid & 63, wid = tid >> 6;
    const bf16_t* yp = (const bf16_t*)(P.ws + WS_YP);
    const float* wts = (const float*)(P.ws + WS_WTS);
    bf16_t* act = (bf16_t*)(P.ws + WS_ACT);
    float* xc = (float*)(P.ws + WS_XC);
    const float* lg = P.ln_g + (size_t)(layer * 2 + 1) * D; const float* lb = P.ln_b + (size_t)(layer * 2 + 1) * D;
    const bool last = (layer == DEPTH - 1);
    const int r0 = last ? NCTX : 0;
    for (int r = r0 + blockIdx.x * 8 + wid; r < NROWS; r += gridDim.x * 8) {
        const int m = row_mod(r);
        float* xr = r < NCTX ? xc + (size_t)r * D : P.out + (size_t)(r - NCTX) * D;
        const float* g2 = modvec(P.ws, layer, m, 5);
        const float w0 = wts[2 * r], w1 = wts[2 * r + 1];
        f32x4 v[4]; float s = 0.f;
#pragma unroll
        for (int i = 0; i < 4; ++i) {
            const int c = 4 * lane + 256 * i;
            const f32x4 xv = *(const f32x4*)(xr + c), gv = *(const f32x4*)(g2 + c);
            const u32x2 y0 = *(const u32x2*)(yp + (size_t)(2 * r) * D + c), y1 = *(const u32x2*)(yp + (size_t)(2 * r + 1) * D + c);
            v[i][0] = ALPHA * xv[0] + gv[0] * (w0 * bflo(y0.x) + w1 * bflo(y1.x)); v[i][1] = ALPHA * xv[1] + gv[1] * (w0 * bfhi(y0.x) + w1 * bfhi(y1.x));
            v[i][2] = ALPHA * xv[2] + gv[2] * (w0 * bflo(y0.y) + w1 * bflo(y1.y)); v[i][3] = ALPHA * xv[3] + gv[3] * (w0 * bfhi(y0.y) + w1 * bfhi(y1.y));
            s += (v[i][0] + v[i][1]) + (v[i][2] + v[i][3]);
        }
        const float mean = wave_sum(s) * (1.f / D);
        float s2 = 0.f;
#pragma unroll
        for (int i = 0; i < 4; ++i) { v[i] = v[i] - mean; s2 += (v[i][0] * v[i][0] + v[i][1] * v[i][1]) + (v[i][2] * v[i][2] + v[i][3] * v[i][3]); }
        const float rstd = rsqrtf(wave_sum(s2) * (1.f / D) + 1e-5f);
        const float* sh1 = last ? lg : modvec(P.ws, layer + 1, m, 0); const float* sc1 = last ? lg : modvec(P.ws, layer + 1, m, 1);
#pragma unroll
        for (int i = 0; i < 4; ++i) {
            const int c = 4 * lane + 256 * i;
            const f32x4 gg = *(const f32x4*)(lg + c), bb = *(const f32x4*)(lb + c);
            f32x4 xn;
#pragma unroll
            for (int j = 0; j < 4; ++j) xn[j] = v[i][j] * rstd * gg[j] + bb[j];
            *(f32x4*)(xr + c) = xn;
            if (!last) {
                const f32x4 s1v = *(const f32x4*)(sc1 + c), h1v = *(const f32x4*)(sh1 + c);
                u32x2 o; o.x = pk2(xn[0] * (1.f + s1v[0]) + h1v[0], xn[1] * (1.f + s1v[1]) + h1v[1]); o.y = pk2(xn[2] * (1.f + s1v[2]) + h1v[2], xn[3] * (1.f + s1v[3]) + h1v[3]);
                *(u32x2*)(act + (size_t)r * D + c) = o;
            }
        }
    }
}

constexpr int NPHASE = 2 + 10 * DEPTH;
__global__ void __launch_bounds__(NT, 2) fwd_kernel(Params P) {
    extern __shared__ __attribute__((aligned(16))) char lds_raw[];
    LAS char* lds = (LAS char*)lds_raw;
    volatile LAS unsigned* xbw = (volatile LAS unsigned*)(lds + LDS_BYTES - 16);
    KP Pk = (KP)__builtin_amdgcn_kernarg_segment_ptr();
    const bool multi = (P.ph_hi - P.ph_lo) > 1;
    XcdBarrier bar; bar.bar = (unsigned*)(P.ws + WS_BAR); bar.x = 0; bar.st = xbw;
    if (multi) {
        if (threadIdx.x == 0) { xbw[0] = 0u; xbw[1] = 0u; xbw[2] = 0u; xbw[3] = 0u; }
        __syncthreads();
        bar = xcd_barrier_post((unsigned*)(P.ws + WS_BAR), xbw);
    }
#define PHASE(id, body) do { if (P.ph_lo <= (id) && (id) < P.ph_hi) { body; if ((id) + 1 < P.ph_hi) xcd_barrier(bar); } } while (0)
    PHASE(0, REP(16, phase_prologue0(Pk, lds)));
    PHASE(1, REP(16, phase_prologue1(Pk)));
    for (int l = 0; l < DEPTH; ++l) {
        const int pb = 2 + 10 * l, odd = l & 1;
        PHASE(pb + 0, REP(1, phase_inproj(Pk, l, lds)));
        if (odd) {
            PHASE(pb + 1, REP(4, phase_prep1(Pk, l)));
            PHASE(pb + 2, phase_prep2(Pk, l, lds));
            PHASE(pb + 3, REP(32, { if (blockIdx.x < 128) REP(64, scan_hgrn_c(Pk, l, blockIdx.x, lds)); else if (blockIdx.x < 256) REP(128, scan_rwkv(Pk, l, blockIdx.x - 128, lds)); }));
            PHASE(pb + 4, REP(4, phase_out_odd(Pk, l)));
        } else {
            PHASE(pb + 1, REP(4, phase_prep_even(Pk, l)));
            PHASE(pb + 3, REP(2, { if (blockIdx.x < 128) scan_ssd_c(Pk, l, blockIdx.x, lds); else if (blockIdx.x < 256) scan_mlstm_c(Pk, l, blockIdx.x - 128, lds); }));
            PHASE(pb + 4, REP(4, phase_out_even(Pk, l)));
        }
        PHASE(pb + 5, REP(256, phase_outproj(Pk, l, lds)));
        PHASE(pb + 6, phase_ln1(Pk, l, lds));
        PHASE(pb + 7, REP(512, phase_moe1(Pk, l, lds)));
        PHASE(pb + 8, REP(1024, phase_moe2(Pk, l, lds)));
        PHASE(pb + 9, phase_ln2(Pk, l));
    }
#undef PHASE
}


#ifndef MK_STOP
#define MK_STOP NPHASE
#endif
#ifndef MK_DUMP
#define MK_DUMP 0
#endif
#ifndef MK_DUMP_N
#define MK_DUMP_N (1u << 30)
#endif
#ifndef MK_DUMP_LD
#define MK_DUMP_LD 1024
#endif
#ifndef MK_DUMP_C0
#define MK_DUMP_C0 0
#endif
__global__ void diff_kernel(const bf16_t* a, const bf16_t* b, float* out, size_t n) {
    for (size_t i = (size_t)blockIdx.x * blockDim.x + threadIdx.x; i < n; i += (size_t)gridDim.x * blockDim.x) out[i] = 1e6f * (bf2f(a[i]) - bf2f(b[i]));
}
__global__ void dump_kernel(const bf16_t* src, float* out, size_t n) {
    for (size_t i = (size_t)blockIdx.x * blockDim.x + threadIdx.x; i < n; i += (size_t)gridDim.x * blockDim.x) out[i] = i < (size_t)MK_DUMP_N ? bf2f(src[(i >> 10) * MK_DUMP_LD + MK_DUMP_C0 + (i & 1023)]) : 0.f;
}
extern "C" void kernel_launch(void* const* d_in, const int* in_sizes, int n_in, void* d_out, int out_size, void* d_ws, size_t ws_size, hipStream_t stream) {
    static int ready = 0;
    if (ready == 0) {
        ready = 1;
        if (n_in != 42 || out_size != NB * SEQ * D || ws_size < WS_END) { fprintf(stderr, "kernel_launch: unexpected shapes (n_in %d out %d ws %zu need %zu)\n", n_in, out_size, ws_size, (size_t)WS_END); ready = -1; }
        if (hipFuncSetAttribute((const void*)fwd_kernel, hipFuncAttributeMaxDynamicSharedMemorySize, LDS_BYTES) != hipSuccess) { fprintf(stderr, "kernel_launch: hipFuncSetAttribute failed\n"); ready = -1; }
    }
    if (ready < 0) return;
    (void)in_sizes;
    hipMemsetAsync((char*)d_ws + WS_BAR, 0, WS_ZERO_BYTES, stream);
    Params p;
    memset(&p, 0, sizeof(p));
    const float** fp = (const float**)&p;
    for (int i = 0; i < 42; ++i) fp[i] = (const float*)d_in[i];
    p.out = (float*)d_out; p.ws = (unsigned char*)d_ws;
#if MK_PER_PHASE
    for (int ph = 0; ph < MK_STOP; ++ph) {
        const int local = ph < 2 ? -1 : (ph - 2) % 10, layer = ph < 2 ? 0 : (ph - 2) / 10;
        if (local == 2 && !(layer & 1)) continue;
        p.ph_lo = ph; p.ph_hi = ph + 1;
        hipLaunchKernelGGL(fwd_kernel, dim3(256), dim3(NT), LDS_BYTES, stream, p);
    }
#ifdef MK_DIFF
    p.ph_lo = 7; p.ph_hi = 8; p.dbg = 1;
    hipLaunchKernelGGL(fwd_kernel, dim3(256), dim3(NT), LDS_BYTES, stream, p);
    hipLaunchKernelGGL(diff_kernel, dim3(1024), dim3(256), 0, stream, (const bf16_t*)((unsigned char*)d_ws + WS_YO), (const bf16_t*)((unsigned char*)d_ws + WS_HID), (float*)d_out, (size_t)NB * SEQ * D);
#else
    if (MK_DUMP) hipLaunchKernelGGL(dump_kernel, dim3(1024), dim3(256), 0, stream, (const bf16_t*)((unsigned char*)d_ws + (size_t)MK_DUMP), (float*)d_out, (size_t)NB * SEQ * D);
#endif
#else
    p.ph_lo = 0; p.ph_hi = NPHASE;
    hipLaunchKernelGGL(fwd_kernel, dim3(256), dim3(NT), LDS_BYTES, stream, p);
#endif
}
```

```cpp
#include <hip/hip_runtime.h>
#include <stdint.h>
#include <stdio.h>
#include <string.h>

#ifndef MK_PER_PHASE
#define MK_PER_PHASE 0
#endif

typedef unsigned short bf16_t;
typedef short bf16x8 __attribute__((ext_vector_type(8)));
typedef float f32x4 __attribute__((ext_vector_type(4)));
typedef unsigned u32x4 __attribute__((ext_vector_type(4)));
typedef unsigned u32x2 __attribute__((ext_vector_type(2)));
#define LAS __attribute__((address_space(3)))
#define CAS __attribute__((address_space(4)))

constexpr int D = 1024, NB = 4, SEQ = 8192, CTXL = 256, DEPTH = 4;
constexpr int NCTX = NB * CTXL;
constexpr int NROWS = NCTX + NB * SEQ;
constexpr int P_EVEN = 2848, P_ODD = 4416, LDP_EVEN = 3072, LDP_ODD = 4608;
constexpr int NEXP = 32, DEXP = 512, LISTCAP = NROWS;
constexpr float ALPHA = 1.681792830507429f;
constexpr int NT = 512;
constexpr int TCH = 32;
constexpr int NSTEPS = CTXL + SEQ;
constexpr int LDS_BYTES = 160 * 1024;

constexpr size_t al256(size_t x) { return (x + 255) & ~(size_t)255; }
constexpr size_t WS_BAR = 0;
constexpr size_t WS_CNT = 16384;
constexpr int CNT_STRIDE = 64;
constexpr size_t WS_ZERO_BYTES = 16384 + (size_t)4 * 32 * CNT_STRIDE * 4;
constexpr size_t WS_MODV = al256(WS_ZERO_BYTES);
constexpr size_t WS_LB = WS_MODV + al256((size_t)4 * 5 * 6144 * 4);
constexpr size_t WS_XC = WS_LB + al256(4 * 512 * 4);
constexpr size_t WS_WTS = WS_XC + (size_t)NCTX * D * 4;
constexpr size_t WS_LIST = WS_WTS + al256((size_t)2 * NROWS * 4);
constexpr size_t WS_WINT = WS_LIST + al256((size_t)NEXP * LISTCAP * 4);
constexpr size_t WINT_L0 = 0, WINT_L1 = (size_t)LDP_EVEN * D, WINT_L2 = WINT_L1 + (size_t)LDP_ODD * D, WINT_L3 = WINT_L2 + (size_t)LDP_EVEN * D, WINT_END = WINT_L3 + (size_t)LDP_ODD * D;
constexpr size_t WS_WOUTT = WS_WINT + WINT_END * 2;
constexpr size_t WS_LORAT = WS_WOUTT + (size_t)4 * D * D * 2;
constexpr size_t LORA_PER = (size_t)512 * 320;
constexpr size_t WS_EXPGU = WS_LORAT + al256(2 * LORA_PER * 2);
constexpr size_t WS_EXPD = WS_EXPGU + (size_t)NEXP * 1024 * 1024 * 2;
constexpr size_t WS_ACT = WS_EXPD + (size_t)NEXP * 1024 * 512 * 2;
constexpr size_t ROWB = (size_t)NROWS * D * 2;
constexpr size_t WS_FEAT = WS_ACT + ROWB;
constexpr size_t WS_YF = WS_FEAT + ROWB;
constexpr size_t WS_YB = WS_YF + ROWB;
constexpr size_t WS_P = WS_YB + ROWB;
constexpr size_t P_BYTES = (size_t)NROWS * LDP_ODD * 2;
constexpr size_t WS_YO = WS_P;
constexpr size_t WS_HID = WS_P + ROWB;
constexpr size_t WS_YP = WS_HID + ROWB;
static_assert(WS_YP + 2 * ROWB <= WS_P + P_BYTES, "MoE buffers must fit in the P region");
constexpr size_t HALFB = (size_t)NROWS * 512 * 2;
constexpr size_t WS_RWR = WS_P + P_BYTES;
constexpr size_t WS_RWK = WS_RWR + HALFB;
constexpr size_t WS_RWV = WS_RWK + HALFB;
constexpr size_t WS_RWKK = WS_RWV + HALFB;
constexpr size_t WS_RWB = WS_RWKK + HALFB;
constexpr size_t WS_RWG = WS_RWB + HALFB;
constexpr size_t WS_RWDEC = WS_RWG + HALFB;
constexpr size_t WS_LA = WS_RWDEC + (size_t)2 * NROWS * 512 * 4;
constexpr size_t WS_END = WS_LA + (size_t)NROWS * 320 * 2;
static_assert(WS_END <= (size_t)280602384 * 4, "workspace map exceeds the guaranteed ws_size");

struct Params {
    const float *x, *c, *ctx, *c_ctx, *mod_w, *mod_b, *ln_g, *ln_b;
    const float *ev_w_in, *ev_w_out, *ssd_conv_w, *ssd_conv_b, *ssd_dt_bias, *ssd_a_log, *ssd_d, *ssd_norm_w;
    const float *ml_conv_w, *ml_conv_b, *ml_i_bias, *ml_f_bias, *ml_norm_w;
    const float *od_w_in, *od_w_out, *hg_lb_logits, *hg_f_bias, *hg_norm_w;
    const float *rw_mu, *rw_w0, *rw_w2, *rw_a0, *rw_a2, *rw_g2, *rw_k_k, *rw_k_a, *rw_r_k, *rw_ln_w, *rw_ln_b;
    const float *router_w, *router_bias, *exp_w_gate, *exp_w_up, *exp_w_down;
    float* out;
    unsigned char* ws;
    int ph_lo, ph_hi, dbg, pad_;
};
typedef const CAS Params* KP;

__device__ __forceinline__ int ltid() { int t = threadIdx.x; asm volatile("" : "+v"(t)); return t; }
__device__ __forceinline__ float bf2f(bf16_t h) { return __uint_as_float(((unsigned)h) << 16); }
__device__ __forceinline__ float bflo(unsigned u) { return __uint_as_float(u << 16); }
__device__ __forceinline__ float bfhi(unsigned u) { return __uint_as_float(u & 0xffff0000u); }
typedef __bf16 bf16v2_t __attribute__((ext_vector_type(2)));
typedef float f32x2 __attribute__((ext_vector_type(2)));
__device__ __forceinline__ unsigned pk2(float lo, float hi) { const f32x2 v = {lo, hi}; return __builtin_bit_cast(unsigned, __builtin_convertvector(v, bf16v2_t)); }
__device__ __forceinline__ bf16_t f2bf(float f) { return (bf16_t)(pk2(f, 0.f) & 0xffffu); }
__device__ __forceinline__ void unpack8(const u32x4& u, float* f) {
    f[0] = bflo(u.x); f[1] = bfhi(u.x); f[2] = bflo(u.y); f[3] = bfhi(u.y); f[4] = bflo(u.z); f[5] = bfhi(u.z); f[6] = bflo(u.w); f[7] = bfhi(u.w);
}
__device__ __forceinline__ u32x4 pack8(const float* f) { u32x4 u; u.x = pk2(f[0], f[1]); u.y = pk2(f[2], f[3]); u.z = pk2(f[4], f[5]); u.w = pk2(f[6], f[7]); return u; }
__device__ __forceinline__ float sigmoidf_(float x) { return __builtin_amdgcn_rcpf(1.f + __expf(-x)); }
__device__ __forceinline__ float siluf_(float x) { return x * __builtin_amdgcn_rcpf(1.f + __expf(-x)); }
__device__ __forceinline__ float softplus_fast(float x) { return x > 20.f ? x : __logf(1.f + __expf(x)); }
__device__ __forceinline__ float tanh_fast(float x) { return 1.f - 2.f * __builtin_amdgcn_rcpf(1.f + __expf(2.f * x)); }
__device__ __forceinline__ float softplusf_(float x) { return x > 20.f ? x : log1pf(__expf(x)); }
__device__ __forceinline__ float logsigmoidf_(float x) { return fminf(x, 0.f) - log1pf(__expf(-fabsf(x))); }
__device__ __forceinline__ float wave_sum(float v) {
#pragma unroll
    for (int o = 1; o < 64; o <<= 1) v += __shfl_xor(v, o);
    return v;
}
template <int W> __device__ __forceinline__ float group_sum(float v) {
#pragma unroll
    for (int o = 1; o < W; o <<= 1) v += __shfl_xor(v, o);
    return v;
}
template <int CTRL> __device__ __forceinline__ float dppmov(float v) {
    return __builtin_bit_cast(float, __builtin_amdgcn_update_dpp(0, __builtin_bit_cast(int, v), CTRL, 0xf, 0xf, true));
}
__device__ __forceinline__ float allreduce16(float v) {
    v += dppmov<0xB1>(v);
    v += dppmov<0x4E>(v);
    v += dppmov<0x141>(v);
    v += dppmov<0x140>(v);
    return v;
}

#define XB_TMO      128
#define XB_XCNT(j)  (256  + 64 * (j))
#define XB_XSUB(j)  (1280 + 64 * (j))
#define XB_XGEN(j)  (2304 + 64 * (j))
#define XB_TOP      3328
#define XB_TOPGEN   3392
#define XCD_BAR_WORDS 3456
#define XB_SPIN_CAP (1u << 22)
__device__ __forceinline__ unsigned xb_ld(unsigned* p)              { return __hip_atomic_load(p, __ATOMIC_RELAXED, __HIP_MEMORY_SCOPE_AGENT); }
__device__ __forceinline__ unsigned xb_add(unsigned* p, unsigned v) { return __hip_atomic_fetch_add(p, v, __ATOMIC_RELAXED, __HIP_MEMORY_SCOPE_AGENT); }
__device__ __forceinline__ unsigned xb_xcc_id() { return (unsigned)__builtin_amdgcn_s_getreg((3 << 11) | 20) & 0xFu; }
#define XB_SPIN(cond, bar) do { unsigned _sp = 0; while (cond) { __builtin_amdgcn_s_sleep(1); \
    if ((++_sp & 255u) == 0u) { if (xb_ld(&(bar)[XB_TMO])) break; if (_sp > XB_SPIN_CAP) { atomicAdd(&(bar)[XB_TMO], 1u); break; } } } } while (0)
struct XcdBarrier { unsigned* bar; unsigned x; volatile LAS unsigned* st; };
__device__ __forceinline__ XcdBarrier xcd_barrier_post(unsigned* bar, volatile LAS unsigned* st) {
    XcdBarrier b; b.bar = bar; b.x = xb_xcc_id(); b.st = st;
    if (threadIdx.x == 0) (void)xb_add(&bar[XB_XCNT(b.x)], 1u);
    return b;
}
__device__ __forceinline__ void xcd_barrier_complete(unsigned* bar, unsigned x, unsigned& nloc, unsigned& nx) {
    const unsigned G = gridDim.x * gridDim.y * gridDim.z;
    unsigned sum, cnt, mine, sp = 0u;
    for (;;) {
        sum = 0u; cnt = 0u; mine = 0u;
#pragma unroll
        for (unsigned j = 0; j < 16; ++j) { const unsigned c = xb_ld(&bar[XB_XCNT(j)]); sum += c; cnt += (c > 0u) ? 1u : 0u; mine = (j == x) ? c : mine; }
        if (sum == G) break;
        __builtin_amdgcn_s_sleep(1);
        if ((++sp & 255u) == 0u) { if (xb_ld(&bar[XB_TMO])) break; if (sp > XB_SPIN_CAP) { atomicAdd(&bar[XB_TMO], 1u); break; } }
    }
    nloc = mine > 0u ? mine : 1u; nx = cnt > 0u ? cnt : 1u;
}
__device__ __forceinline__ void xcd_barrier(const XcdBarrier& b) {
    asm volatile("s_waitcnt vmcnt(0)" ::: "memory");
    __syncthreads();
    if (threadIdx.x == 0) {
        unsigned* bar = b.bar;
        __builtin_amdgcn_s_waitcnt(0);
        unsigned nloc = b.st[0], nx = b.st[1];
        if (nloc == 0u) { xcd_barrier_complete(bar, b.x, nloc, nx); b.st[0] = nloc; b.st[1] = nx; }
        const unsigned old = xb_add(&bar[XB_XSUB(b.x)], 1u);
        const unsigned gen = old / nloc;
        if (old + 1u == (gen + 1u) * nloc) {
            __builtin_amdgcn_fence(__ATOMIC_RELEASE, "agent");
            asm volatile("s_waitcnt vmcnt(0)" ::: "memory");
            const unsigned og = xb_add(&bar[XB_TOP], 1u);
            const unsigned tg = og / nx;
            if (og + 1u == (tg + 1u) * nx) xb_add(&bar[XB_TOPGEN], 1u);
            else XB_SPIN(xb_ld(&bar[XB_TOPGEN]) == tg, bar);
            __builtin_amdgcn_fence(__ATOMIC_ACQUIRE, "agent");
            xb_add(&bar[XB_XGEN(b.x)], 1u);
            asm volatile("s_waitcnt vmcnt(0)" ::: "memory");
        } else {
            XB_SPIN(xb_ld(&bar[XB_XGEN(b.x)]) == gen, bar);
            __builtin_amdgcn_fence(__ATOMIC_ACQUIRE, "agent");
            asm volatile("s_waitcnt vmcnt(0)" ::: "memory");
        }
    }
    __syncthreads();
}

__device__ __forceinline__ int row_mod(int r) { return r < NCTX ? 4 : ((r - NCTX) >> 13); }
__device__ __forceinline__ void row_seg(int r, int& t, int& len) { if (r < NCTX) { t = r & 255; len = CTXL; } else { t = (r - NCTX) & 8191; len = SEQ; } }
__device__ __forceinline__ int scan_row(int tg, int b, int dir, int odd) {
    if (tg < CTXL) { const int t = dir ? (CTXL - 1 - tg) : tg; return b * CTXL + t; }
    int sg = tg - CTXL; if (dir) sg = SEQ - 1 - sg;
    const int s = odd ? (((sg & 127) << 6) + (sg >> 7)) : sg;
    return NCTX + b * SEQ + s;
}
__device__ __forceinline__ const float* modvec(const unsigned char* ws, int layer, int m, int which) {
    return (const float*)(ws + WS_MODV) + ((size_t)(layer * 5 + m) * 6 + which) * D;
}

constexpr int G_BM = 256, G_BN = 128, G_BK = 64;
constexpr int G_ABYTES = G_BM * G_BK * 2, G_BBYTES = G_BN * G_BK * 2, G_BUF = G_ABYTES + G_BBYTES;
__device__ __forceinline__ int swz(int o) { return o ^ (((o >> 9) & 1) << 5); }

template <class RowSrc, class Epi>
__device__ __forceinline__ void gemm_tile(const bf16_t* __restrict__ A, int lda, const RowSrc& rs, const bf16_t* __restrict__ Bt, int ldb, int n0, int K, const Epi& epi, LAS char* lds) {
    const int tid = ltid(), lane = tid & 63, wid = tid >> 6, wm = wid >> 1, wn = wid & 1;
    const bf16_t* ap[4]; int aoff[4];
#pragma unroll
    for (int i = 0; i < 4; ++i) {
        const int c = tid + NT * i, row = c >> 3, kc = c & 7;
        ap[i] = A + (size_t)rs.src(row) * lda + kc * 8;
        aoff[i] = ((row >> 4) * 2 + (kc >> 2)) * 1024 + swz((row & 15) * 64 + (kc & 3) * 16);
    }
    const bf16_t* bp[2]; int boff[2];
#pragma unroll
    for (int i = 0; i < 2; ++i) {
        const int c = tid + NT * i, row = c >> 3, kc = c & 7;
        bp[i] = Bt + (size_t)(n0 + row) * ldb + kc * 8;
        boff[i] = G_ABYTES + ((row >> 4) * 2 + (kc >> 2)) * 1024 + swz((row & 15) * 64 + (kc & 3) * 16);
    }
    f32x4 acc[4][4];
#pragma unroll
    for (int i = 0; i < 4; ++i)
#pragma unroll
        for (int j = 0; j < 4; ++j) acc[i][j] = (f32x4){0.f, 0.f, 0.f, 0.f};
    u32x4 ra[2][4], rb[2][2];
    const int KT = K / G_BK;
    const int fragoff = swz((lane & 15) * 64 + (lane >> 4) * 16);
#define G_LOAD(set, kt_) do { _Pragma("unroll") for (int i = 0; i < 4; ++i) ra[set][i] = *(const u32x4*)(ap[i] + (kt_) * G_BK); \
                              _Pragma("unroll") for (int i = 0; i < 2; ++i) rb[set][i] = *(const u32x4*)(bp[i] + (kt_) * G_BK); } while (0)
#define G_STORE(set, buf) do { _Pragma("unroll") for (int i = 0; i < 4; ++i) *(LAS u32x4*)((buf) + aoff[i]) = ra[set][i]; \
                               _Pragma("unroll") for (int i = 0; i < 2; ++i) *(LAS u32x4*)((buf) + boff[i]) = rb[set][i]; } while (0)
#define G_COMPUTE(cur) do { bf16x8 af[2][4], bfr[2][4]; \
        _Pragma("unroll") for (int ks = 0; ks < 2; ++ks) { \
            _Pragma("unroll") for (int ni = 0; ni < 4; ++ni) bfr[ks][ni] = *(LAS bf16x8*)((cur) + G_ABYTES + ((wn * 4 + ni) * 2 + ks) * 1024 + fragoff); \
            _Pragma("unroll") for (int mi = 0; mi < 4; ++mi) af[ks][mi] = *(LAS bf16x8*)((cur) + ((wm * 4 + mi) * 2 + ks) * 1024 + fragoff); } \
        __builtin_amdgcn_sched_barrier(0); \
        _Pragma("unroll") for (int ks = 0; ks < 2; ++ks) _Pragma("unroll") for (int mi = 0; mi < 4; ++mi) _Pragma("unroll") for (int ni = 0; ni < 4; ++ni) \
            acc[mi][ni] = __builtin_amdgcn_mfma_f32_16x16x32_bf16(bfr[ks][ni], af[ks][mi], acc[mi][ni], 0, 0, 0); \
        __builtin_amdgcn_sched_barrier(0); } while (0)
    G_LOAD(0, 0);
    G_STORE(0, lds);
    if (KT > 1) G_LOAD(0, 1);
    if (KT > 2) G_LOAD(1, 2);
    __syncthreads();
    for (int kt = 0; kt < KT; kt += 2) {
        G_COMPUTE(lds);
        if (kt + 1 < KT) G_STORE(0, lds + G_BUF);
        if (kt + 3 < KT) G_LOAD(0, kt + 3);
        __syncthreads();
        if (kt + 1 < KT) {
            G_COMPUTE(lds + G_BUF);
            if (kt + 2 < KT) G_STORE(1, lds);
            if (kt + 4 < KT) G_LOAD(1, kt + 4);
            __syncthreads();
        }
    }
#undef G_LOAD
#undef G_STORE
#undef G_COMPUTE
    epi(acc, wm * 64 + (lane & 15), wn * 64 + 4 * (lane >> 4));
}

constexpr int G2_BN = 256, G2_BBYTES = G2_BN * G_BK * 2, G2_BUF = G_ABYTES + G2_BBYTES;
template <class RowSrc, class Epi>
__device__ __forceinline__ void gemm_tile256(const bf16_t* __restrict__ A, int lda, const RowSrc& rs, const bf16_t* __restrict__ Bt, int ldb, int n0, int K, const Epi& epi, LAS char* lds) {
    const int tid = ltid(), lane = tid & 63, wid = tid >> 6, wm = wid >> 1, wn = wid & 1;
    const int r0 = tid >> 3, kc = tid & 7;
    const int aoff0 = ((r0 >> 4) * 2 + (kc >> 2)) * 1024 + swz((r0 & 15) * 64 + (kc & 3) * 16);
    int aeo[4];
#pragma unroll
    for (int i = 0; i < 4; ++i) aeo[i] = rs.src(r0 + 64 * i) * lda + kc * 8;
    const bf16_t* bp0 = Bt + (size_t)(n0 + r0) * ldb + kc * 8;
    const int bstep = 64 * ldb;
    f32x4 acc[4][8];
#pragma unroll
    for (int i = 0; i < 4; ++i)
#pragma unroll
        for (int j = 0; j < 8; ++j) acc[i][j] = (f32x4){0.f, 0.f, 0.f, 0.f};
    u32x4 ra[4], rb[4];
#pragma unroll
    for (int i = 0; i < 4; ++i) { ra[i] = *(const u32x4*)(A + aeo[i]); rb[i] = *(const u32x4*)(bp0 + i * bstep); }
#pragma unroll
    for (int i = 0; i < 4; ++i) { *(LAS u32x4*)(lds + aoff0 + i * 8192) = ra[i]; *(LAS u32x4*)(lds + G_ABYTES + aoff0 + i * 8192) = rb[i]; }
    __syncthreads();
    const int KT = K / G_BK;
    const int fragoff = swz((lane & 15) * 64 + (lane >> 4) * 16);
    for (int kt = 0; kt < KT; ++kt) {
        LAS char* cur = lds + (kt & 1) * G2_BUF;
        LAS char* nxt = lds + ((kt + 1) & 1) * G2_BUF;
        const bool more = (kt + 1 < KT);
        if (more) {
#pragma unroll
            for (int i = 0; i < 4; ++i) { ra[i] = *(const u32x4*)(A + aeo[i] + (kt + 1) * G_BK); rb[i] = *(const u32x4*)(bp0 + i * bstep + (kt + 1) * G_BK); }
        }
#pragma unroll
        for (int ks = 0; ks < 2; ++ks) {
            bf16x8 af[4];
#pragma unroll
            for (int mi = 0; mi < 4; ++mi) af[mi] = *(LAS bf16x8*)(cur + ((wm * 4 + mi) * 2 + ks) * 1024 + fragoff);
#pragma unroll
            for (int nh = 0; nh < 2; ++nh) {
                bf16x8 bfr[4];
#pragma unroll
                for (int ni = 0; ni < 4; ++ni) bfr[ni] = *(LAS bf16x8*)(cur + G_ABYTES + ((wn * 8 + nh * 4 + ni) * 2 + ks) * 1024 + fragoff);
                __builtin_amdgcn_sched_barrier(0);
#pragma unroll
                for (int mi = 0; mi < 4; ++mi)
#pragma unroll
                    for (int ni = 0; ni < 4; ++ni) acc[mi][nh * 4 + ni] = __builtin_amdgcn_mfma_f32_16x16x32_bf16(bfr[ni], af[mi], acc[mi][nh * 4 + ni], 0, 0, 0);
                __builtin_amdgcn_sched_barrier(0);
            }
        }
        if (more) {
#pragma unroll
            for (int i = 0; i < 4; ++i) { *(LAS u32x4*)(nxt + aoff0 + i * 8192) = ra[i]; *(LAS u32x4*)(nxt + G_ABYTES + aoff0 + i * 8192) = rb[i]; }
        }
        __syncthreads();
    }
    epi(acc, wm * 64 + (lane & 15), wn * 128 + 4 * (lane >> 4));
}

struct RowLinear { int m0; __device__ __forceinline__ int src(int r) const { return m0 + r; } };
struct RowList {
    const int* list; int cnt; int shift;
    __device__ __forceinline__ int src(int r) const { const int a = list[r < cnt ? r : 0]; return a >> shift; }
};
struct EpiStoreBf16 {
    bf16_t* C; int ldc; int m0; int n0; int N;
    template <int NI> __device__ __forceinline__ void operator()(const f32x4 (&acc)[4][NI], int rbase, int cbase) const {
#pragma unroll
        for (int mi = 0; mi < 4; ++mi) {
            bf16_t* rowp = C + (size_t)(m0 + rbase + mi * 16) * ldc + n0 + cbase;
#pragma unroll
            for (int ni = 0; ni < NI; ++ni) {
                if (n0 + cbase + ni * 16 < N) { u32x2 v; v.x = pk2(acc[mi][ni][0], acc[mi][ni][1]); v.y = pk2(acc[mi][ni][2], acc[mi][ni][3]); *(u32x2*)(rowp + ni * 16) = v; }
            }
        }
    }
};
struct EpiSwiGLU {
    bf16_t* H; const int* list; int cnt; int n0;
    template <int NI> __device__ __forceinline__ void operator()(const f32x4 (&acc)[4][NI], int rbase, int cbase) const {
#pragma unroll
        for (int mi = 0; mi < 4; ++mi) {
            const int r = rbase + mi * 16;
            if (r < cnt) {
                const int a = list[r];
                const int wnb = cbase & ~63, q4 = cbase & 63;
                bf16_t* rowp = H + (size_t)a * DEXP + ((n0 + wnb) >> 1) + q4;
#pragma unroll
                for (int q = 0; q < NI / 2; ++q) {
                    float o[4];
#pragma unroll
                    for (int j = 0; j < 4; ++j) o[j] = siluf_(acc[mi][2 * q][j]) * acc[mi][2 * q + 1][j];
                    u32x2 v; v.x = pk2(o[0], o[1]); v.y = pk2(o[2], o[3]); *(u32x2*)(rowp + q * 16) = v;
                }
            }
        }
    }
};
struct EpiScatterBf16 {
    bf16_t* C; const int* list; int cnt; int n0;
    template <int NI> __device__ __forceinline__ void operator()(const f32x4 (&acc)[4][NI], int rbase, int cbase) const {
#pragma unroll
        for (int mi = 0; mi < 4; ++mi) {
            const int r = rbase + mi * 16;
            if (r < cnt) {
                bf16_t* rowp = C + (size_t)list[r] * D + n0 + cbase;
#pragma unroll
                for (int ni = 0; ni < NI; ++ni) { u32x2 v; v.x = pk2(acc[mi][ni][0], acc[mi][ni][1]); v.y = pk2(acc[mi][ni][2], acc[mi][ni][3]); *(u32x2*)(rowp + ni * 16) = v; }
            }
        }
    }
};
struct EpiDecay {
    float* Dc; const float* w0; int m0; int n0;
    template <int NI> __device__ __forceinline__ void operator()(const f32x4 (&acc)[4][NI], int rbase, int cbase) const {
#pragma unroll
        for (int ni = 0; ni < NI; ++ni) {
            const int col = n0 + cbase + ni * 16;
            const f32x4 w0v = *(const f32x4*)(w0 + col);
#pragma unroll
            for (int mi = 0; mi < 4; ++mi) {
                f32x4 o;
#pragma unroll
                for (int j = 0; j < 4; ++j) { const float w = w0v[j] + acc[mi][ni][j]; o[j] = __expf(-__expf(-softplus_fast(-w) - 0.5f)); }
                *(f32x4*)(Dc + (size_t)(m0 + rbase + mi * 16) * 512 + col) = o;
            }
        }
    }
};
struct EpiAK {
    bf16_t* Kb; const bf16_t* KKb; bf16_t* Bb; const float* a0; const float* k_a; int m0; int n0;
    template <int NI> __device__ __forceinline__ void operator()(const f32x4 (&acc)[4][NI], int rbase, int cbase) const {
#pragma unroll
        for (int ni = 0; ni < NI; ++ni) {
            const int col = n0 + cbase + ni * 16;
            const f32x4 a0v = *(const f32x4*)(a0 + col), kav = *(const f32x4*)(k_a + col);
#pragma unroll
            for (int mi = 0; mi < 4; ++mi) {
                const size_t off = (size_t)(m0 + rbase + mi * 16) * 512 + col;
                const u32x2 kr = *(const u32x2*)(Kb + off), kkr = *(const u32x2*)(KKb + off);
                const float kf[4] = {bflo(kr.x), bfhi(kr.x), bflo(kr.y), bfhi(kr.y)}, kkf[4] = {bflo(kkr.x), bfhi(kkr.x), bflo(kkr.y), bfhi(kkr.y)};
                float k2[4], bb[4];
#pragma unroll
                for (int j = 0; j < 4; ++j) { const float a = sigmoidf_(a0v[j] + acc[mi][ni][j]); k2[j] = kf[j] * (1.f + (a - 1.f) * kav[j]); bb[j] = kkf[j] * a; }
                u32x2 v; v.x = pk2(k2[0], k2[1]); v.y = pk2(k2[2], k2[3]); *(u32x2*)(Kb + off) = v;
                v.x = pk2(bb[0], bb[1]); v.y = pk2(bb[2], bb[3]); *(u32x2*)(Bb + off) = v;
            }
        }
    }
};

namespace pg8 {
#define PG8_LAS __attribute__((address_space(3)))
constexpr int BM = 256, BK = 64, HALF = 128, HTB = HALF * BK * 2, STAGE_BYTES = 8 * HTB, NXCD = 8, WGM = 8;
__host__ __device__ __forceinline__ int lds_byte(int r, int c) { const int st = (r >> 4) * 2 + (c >> 5), rr = r & 15, cc = c & 31, ob = rr * 64 + cc * 2; return st * 1024 + (ob ^ (((ob >> 9) & 1) << 5)); }
__host__ __device__ __forceinline__ void stage_rc(int b, int& R, int& C) { const int st = b / 1024, sb = b % 1024, swz = sb ^ (((sb >> 9) & 1) << 5); R = (st >> 1) * 16 + swz / 64; C = (st & 1) * 32 + (swz % 64) / 2; }
__host__ __device__ __forceinline__ int perm32(int rho) { const int n = rho >> 4, i = rho & 15; return 8 * (i >> 2) + 4 * n + (i & 3); }
struct Unit { int pm, pn; };
struct Gemm { const bf16_t* A; const bf16_t* Bt; int M, N, K; };
struct StaticOrder {
    int nM, nN, nwg, G, c;
    __host__ __device__ void init(int M, int N, int G_, int c_) { nM = M / BM; nN = N / BM; nwg = nM * nN; G = G_; c = c_; }
    __host__ __device__ bool next(int i, Unit& u) const {
        const long L = (long)i * G + c; if (L >= nwg) return false;
        int wgid = (int)L; { const int q = nwg / NXCD, r = nwg % NXCD, xcd = wgid % NXCD, off = wgid / NXCD; wgid = (xcd < r ? xcd * (q + 1) : r * (q + 1) + (xcd - r) * q) + off; }
        const int nig = WGM * nN, gid = wgid / nig, fm = gid * WGM, gsz = (nM - fm) < WGM ? (nM - fm) : WGM;
        u.pm = fm + ((wgid % nig) % gsz); u.pn = (wgid % nig) / gsz; return true;
    }
    __device__ __forceinline__ void a_ready(const Unit&) const {}
    __device__ __forceinline__ void done(const Unit&) const {}
};
struct EpiStoreP {
    static constexpr bool PERM = true, AFTER_DRAIN = false;
    bf16_t* O; int ldc;
    __device__ __forceinline__ void operator()(const f32x4 (&acc)[2][2][4][2], const Unit& u, int wr, int wc, int fr, int fq) const {
        const int row0 = u.pm * BM + wr * 64 + fr, col0 = u.pn * BM + wc * 32 + 8 * fq;
#pragma unroll
        for (int ai = 0; ai < 2; ++ai)
#pragma unroll
            for (int m = 0; m < 4; ++m) { bf16_t* rowp = O + (size_t)(row0 + ai * HALF + m * 16) * ldc + col0;
#pragma unroll
                for (int bj = 0; bj < 2; ++bj) { const f32x4 v0 = acc[ai][bj][m][0], v1 = acc[ai][bj][m][1];
                    u32x4 w; w.x = pk2(v0[0], v0[1]); w.y = pk2(v0[2], v0[3]); w.z = pk2(v1[0], v1[1]); w.w = pk2(v1[2], v1[3]);
                    *(u32x4*)(rowp + bj * HALF) = w; } }
    }
};
template <class Epi, class Sched>
__device__ __forceinline__ void gemm_phase(PG8_LAS unsigned char* lds, const Gemm g, const Sched& S, const Epi& E) {
    const int tid = ltid(), wid = __builtin_amdgcn_readfirstlane(tid >> 6), lane = tid & 63, wr = wid >> 2, wc = wid & 3, fr = lane & 15, fq = lane >> 4;
    const int K = g.K, nt = K / BK;
    unsigned voffA[2], voffB[2];
#pragma unroll
    for (int i = 0; i < 2; ++i) { int R, C; stage_rc(tid * 16 + i * 8192, R, C); const int Rb = Epi::PERM ? ((R & ~31) + perm32(R & 31)) : R;
        voffA[i] = (unsigned)(R * K + C) * 2u; voffB[i] = (unsigned)(Rb * K + C) * 2u; }
    const size_t kstep = (size_t)(BK * 2);
    const size_t hstep = (size_t)HALF * K * 2;
    const size_t tstep = 2 * hstep;
    const unsigned ldsw = (unsigned)wid * 1024u;
    const int aoff = lds_byte(wr * 64 + fr, fq * 8), boff = lds_byte(wc * 32 + fr, fq * 8);
#define PG8_SA(b, h) (((b) * 2 + (h)) * HTB)
#define PG8_SB(b, h) ((4 + (b) * 2 + (h)) * HTB)
#define PG8_STAGE(bufoff, gbase, voff) do { _Pragma("unroll") for (int _i = 0; _i < 2; ++_i) \
        __builtin_amdgcn_global_load_lds((const unsigned*)((const char*)(gbase) + (voff)[_i]), (PG8_LAS unsigned*)(lds + (bufoff) + ldsw + _i * 8192), 16, 0, 0); } while (0)
#define PG8_LDA(dst, b, h) do { _Pragma("unroll") for (int m = 0; m < 4; ++m) _Pragma("unroll") for (int k = 0; k < 2; ++k) dst[m][k] = *(const PG8_LAS bf16x8*)(lds + PG8_SA(b, h) + aoff + m * 2048 + k * 1024); } while (0)
#define PG8_LDB(dst, b, h) do { _Pragma("unroll") for (int n = 0; n < 2; ++n) _Pragma("unroll") for (int k = 0; k < 2; ++k) dst[n][k] = *(const PG8_LAS bf16x8*)(lds + PG8_SB(b, h) + boff + n * 2048 + k * 1024); } while (0)
#define PG8_MMA(ai, bj, At, Bt) do { __builtin_amdgcn_s_setprio(1); _Pragma("unroll") for (int m = 0; m < 4; ++m) _Pragma("unroll") for (int n = 0; n < 2; ++n) _Pragma("unroll") for (int k = 0; k < 2; ++k) \
        acc[ai][bj][m][n] = __builtin_amdgcn_mfma_f32_16x16x32_bf16(Bt[n][k], At[m][k], acc[ai][bj][m][n], 0, 0, 0); __builtin_amdgcn_s_setprio(0); } while (0)
#define PG8_WAIT_V(n) asm volatile("s_waitcnt vmcnt(" #n ")" ::: "memory")
#define PG8_WAIT_L(n) asm volatile("s_waitcnt lgkmcnt(" #n ")" ::: "memory")
#define PG8_BAR __builtin_amdgcn_s_barrier()
#define PG8_SCHED __builtin_amdgcn_sched_barrier(0)
    Unit cur, nxt; int ui = 0;
    if (!S.next(0, cur)) return;
    f32x4 acc[2][2][4][2];
#pragma unroll
    for (int a = 0; a < 2; ++a)
#pragma unroll
        for (int b = 0; b < 2; ++b)
#pragma unroll
            for (int m = 0; m < 4; ++m)
#pragma unroll
                for (int n = 0; n < 2; ++n) acc[a][b][m][n] = (f32x4){0.f, 0.f, 0.f, 0.f};
    bf16x8 At[4][2], B0[2][2], B1[2][2];
    const char* cA = (const char*)g.A + (size_t)cur.pm * tstep; const char* cB = (const char*)g.Bt + (size_t)cur.pn * tstep;
    S.a_ready(cur);
    PG8_STAGE(PG8_SB(0, 0), cB, voffB); PG8_STAGE(PG8_SA(0, 0), cA, voffA); PG8_STAGE(PG8_SB(0, 1), cB + hstep, voffB); PG8_STAGE(PG8_SA(0, 1), cA + hstep, voffA);
    if (wr == 1) PG8_BAR;
    PG8_WAIT_V(4); PG8_BAR;
    PG8_STAGE(PG8_SB(1, 0), cB + kstep, voffB); PG8_STAGE(PG8_SA(1, 0), cA + kstep, voffA); PG8_STAGE(PG8_SB(1, 1), cB + hstep + kstep, voffB);
    PG8_WAIT_V(6); PG8_BAR;
    for (;;) {
        const bool has_next = S.next(ui + 1, nxt);
        const char* nA = has_next ? (const char*)g.A + (size_t)nxt.pm * tstep : cA; const char* nB = has_next ? (const char*)g.Bt + (size_t)nxt.pn * tstep : cB;
        for (int t = 0; t < nt; t += 2) {
            const bool last = (t == nt - 2);
            const char* a1 = cA + (size_t)(t + 1) * kstep;
            const char* a2 = last ? nA : cA + (size_t)(t + 2) * kstep; const char* b2 = last ? nB : cB + (size_t)(t + 2) * kstep;
            const char* a3 = a2 + kstep; const char* b3 = b2 + kstep;
            if (last && has_next) S.a_ready(nxt);
            PG8_LDB(B0, 0, 0); PG8_SCHED; PG8_LDA(At, 0, 0); PG8_STAGE(PG8_SA(1, 1), a1 + hstep, voffA);
            PG8_WAIT_L(8); PG8_BAR; PG8_WAIT_L(0); PG8_MMA(0, 0, At, B0); PG8_BAR; PG8_SCHED;
            PG8_LDB(B1, 0, 1); PG8_STAGE(PG8_SB(0, 0), b2, voffB);
            PG8_BAR; PG8_WAIT_L(0); PG8_MMA(0, 1, At, B1); PG8_BAR;
            PG8_LDA(At, 0, 1); PG8_STAGE(PG8_SA(0, 0), a2, voffA);
            PG8_BAR; PG8_WAIT_L(0); PG8_MMA(1, 0, At, B0); PG8_BAR; PG8_SCHED;
            PG8_STAGE(PG8_SB(0, 1), b2 + hstep, voffB);
            PG8_WAIT_V(6); PG8_BAR; PG8_MMA(1, 1, At, B1); PG8_BAR;
            PG8_LDB(B0, 1, 0); PG8_SCHED; PG8_LDA(At, 1, 0); PG8_STAGE(PG8_SA(0, 1), a2 + hstep, voffA);
            PG8_WAIT_L(8); PG8_BAR; PG8_WAIT_L(0); PG8_MMA(0, 0, At, B0); PG8_BAR; PG8_SCHED;
            PG8_LDB(B1, 1, 1); PG8_STAGE(PG8_SB(1, 0), b3, voffB);
            PG8_BAR; PG8_WAIT_L(0); PG8_MMA(0, 1, At, B1); PG8_BAR;
            PG8_LDA(At, 1, 1); PG8_STAGE(PG8_SA(1, 0), a3, voffA);
            PG8_BAR; PG8_WAIT_L(0); PG8_MMA(1, 0, At, B0); PG8_BAR; PG8_SCHED;
            PG8_STAGE(PG8_SB(1, 1), b3 + hstep, voffB);
            PG8_WAIT_V(6); PG8_BAR; PG8_MMA(1, 1, At, B1); PG8_BAR;
        }
            if constexpr (!Epi::AFTER_DRAIN) { E(acc, cur, wr, wc, fr, fq); S.done(cur); }
            if (!has_next) break;
#pragma unroll
        for (int a = 0; a < 2; ++a)
#pragma unroll
            for (int b = 0; b < 2; ++b)
#pragma unroll
                for (int m = 0; m < 4; ++m)
#pragma unroll
                    for (int n = 0; n < 2; ++n) acc[a][b][m][n] = (f32x4){0.f, 0.f, 0.f, 0.f};
        cur = nxt; cA = nA; cB = nB; ++ui;
    }
    PG8_WAIT_V(0);
    if (wr == 0) PG8_BAR;
    PG8_BAR;
    if constexpr (Epi::AFTER_DRAIN) { E.fused(acc, cur, wr, wc, fr, fq, lds, wid, lane); S.done(cur); }
#undef PG8_SA
#undef PG8_SB
#undef PG8_STAGE
#undef PG8_LDA
#undef PG8_LDB
#undef PG8_MMA
#undef PG8_WAIT_V
#undef PG8_WAIT_L
#undef PG8_BAR
#undef PG8_SCHED
}
struct UnitG { int pm, pn; const char* bbase; const int* list; const PG8_LAS int* ltab; int cnt; int shift; };
struct MoeOrder {
    const PG8_LAS int* tstart; const PG8_LAS int* tcnt; const PG8_LAS int* ltabs; const int* lists; const char* bt; size_t estride; int ncol, shift, G, c;
    __device__ __forceinline__ bool next(int i, UnitG& u) const {
        const int t = i * G + c; if (t >= tstart[32] * ncol) return false;
        const int tm = t / ncol; int e = 0;
#pragma unroll 1
        while (tstart[e + 1] <= tm) ++e;
        e = __builtin_amdgcn_readfirstlane(e);
        const int ts = __builtin_amdgcn_readfirstlane(tstart[e]), tc = __builtin_amdgcn_readfirstlane(tcnt[e]);
        u.pm = tm - ts; u.pn = t - tm * ncol; u.bbase = bt + (size_t)e * estride; u.list = lists + (size_t)e * LISTCAP + u.pm * BM; u.cnt = tc - u.pm * BM; u.shift = shift; u.ltab = ltabs + i * BM;
        return true;
    }
    __device__ __forceinline__ void a_ready(const UnitG&) const {}
    __device__ __forceinline__ void done(const UnitG&) const {}
};
struct EpiSwiGLUG {
    static constexpr bool PERM = false, AFTER_DRAIN = false;
    bf16_t* H;
    __device__ __forceinline__ void operator()(const f32x4 (&acc)[2][2][4][2], const UnitG& u, int wr, int wc, int fr, int fq) const {
#pragma unroll
        for (int ai = 0; ai < 2; ++ai)
#pragma unroll
            for (int m = 0; m < 4; ++m) { const int r = ai * HALF + wr * 64 + m * 16 + fr;
                if (r < u.cnt) { bf16_t* rowp = H + (size_t)u.ltab[r] * DEXP + ((u.pn * BM + wc * 32) >> 1) + 4 * fq;
#pragma unroll
                    for (int bj = 0; bj < 2; ++bj) { const f32x4 gt = acc[ai][bj][m][0], up = acc[ai][bj][m][1];
                        u32x2 w; w.x = pk2(siluf_(gt[0]) * up[0], siluf_(gt[1]) * up[1]); w.y = pk2(siluf_(gt[2]) * up[2], siluf_(gt[3]) * up[3]);
                        *(u32x2*)(rowp + bj * (HALF / 2)) = w; } } }
    }
};
struct EpiScatterG {
    static constexpr bool PERM = true, AFTER_DRAIN = false;
    bf16_t* O;
    __device__ __forceinline__ void operator()(const f32x4 (&acc)[2][2][4][2], const UnitG& u, int wr, int wc, int fr, int fq) const {
#pragma unroll
        for (int ai = 0; ai < 2; ++ai)
#pragma unroll
            for (int m = 0; m < 4; ++m) { const int r = ai * HALF + wr * 64 + m * 16 + fr;
                if (r < u.cnt) { bf16_t* rowp = O + (size_t)u.ltab[r] * D + u.pn * BM + wc * 32 + 8 * fq;
#pragma unroll
                    for (int bj = 0; bj < 2; ++bj) { const f32x4 v0 = acc[ai][bj][m][0], v1 = acc[ai][bj][m][1];
                        u32x4 w; w.x = pk2(v0[0], v0[1]); w.y = pk2(v0[2], v0[3]); w.z = pk2(v1[0], v1[1]); w.w = pk2(v1[2], v1[3]);
                        *(u32x4*)(rowp + bj * HALF) = w; } } }
    }
};
template <class Epi, class Sched>
__device__ __forceinline__ void gemm_phase_g(PG8_LAS unsigned char* lds, const Gemm g, const Sched& S, const Epi& E) {
    const int tid = ltid(), wid = __builtin_amdgcn_readfirstlane(tid >> 6), lane = tid & 63, wr = wid >> 2, wc = wid & 3, fr = lane & 15, fq = lane >> 4;
    const int K = g.K, nt = K / BK;
    unsigned voffB[2]; int RA[2], CA2[2];
#pragma unroll
    for (int i = 0; i < 2; ++i) { int R, C; stage_rc(tid * 16 + i * 8192, R, C); const int Rb = Epi::PERM ? ((R & ~31) + perm32(R & 31)) : R;
        RA[i] = R; CA2[i] = C * 2; voffB[i] = (unsigned)(Rb * K + C) * 2u; }
    const unsigned rowb = (unsigned)K * 2u;
#define PG8_AOFFS(u, dst) do { _Pragma("unroll") for (int _h = 0; _h < 2; ++_h) _Pragma("unroll") for (int _i = 0; _i < 2; ++_i) { const int _r = _h * HALF + RA[_i]; \
        dst[_h][_i] = (unsigned)((u).ltab[_r] >> (u).shift) * rowb + (unsigned)CA2[_i]; } } while (0)
#define PG8_STAGE_A(bufoff, AO, koff) do { _Pragma("unroll") for (int _i = 0; _i < 2; ++_i) \
        __builtin_amdgcn_global_load_lds((const unsigned*)((const char*)g.A + (size_t)(AO)[_i] + (size_t)(koff)), (PG8_LAS unsigned*)(lds + (bufoff) + ldsw + _i * 8192), 16, 0, 0); } while (0)
    const size_t kstep = (size_t)(BK * 2);
    const size_t hstep = (size_t)HALF * K * 2;
    const size_t tstep = 2 * hstep;
    const unsigned ldsw = (unsigned)wid * 1024u;
    const int aoff = lds_byte(wr * 64 + fr, fq * 8), boff = lds_byte(wc * 32 + fr, fq * 8);
#define PG8_SA(b, h) (((b) * 2 + (h)) * HTB)
#define PG8_SB(b, h) ((4 + (b) * 2 + (h)) * HTB)
#define PG8_STAGE(bufoff, gbase, voff) do { _Pragma("unroll") for (int _i = 0; _i < 2; ++_i) \
        __builtin_amdgcn_global_load_lds((const unsigned*)((const char*)(gbase) + (voff)[_i]), (PG8_LAS unsigned*)(lds + (bufoff) + ldsw + _i * 8192), 16, 0, 0); } while (0)
#define PG8_LDA(dst, b, h) do { _Pragma("unroll") for (int m = 0; m < 4; ++m) _Pragma("unroll") for (int k = 0; k < 2; ++k) dst[m][k] = *(const PG8_LAS bf16x8*)(lds + PG8_SA(b, h) + aoff + m * 2048 + k * 1024); } while (0)
#define PG8_LDB(dst, b, h) do { _Pragma("unroll") for (int n = 0; n < 2; ++n) _Pragma("unroll") for (int k = 0; k < 2; ++k) dst[n][k] = *(const PG8_LAS bf16x8*)(lds + PG8_SB(b, h) + boff + n * 2048 + k * 1024); } while (0)
#define PG8_MMA(ai, bj, At, Bt) do { __builtin_amdgcn_s_setprio(1); _Pragma("unroll") for (int m = 0; m < 4; ++m) _Pragma("unroll") for (int n = 0; n < 2; ++n) _Pragma("unroll") for (int k = 0; k < 2; ++k) \
        acc[ai][bj][m][n] = __builtin_amdgcn_mfma_f32_16x16x32_bf16(Bt[n][k], At[m][k], acc[ai][bj][m][n], 0, 0, 0); __builtin_amdgcn_s_setprio(0); } while (0)
#define PG8_WAIT_V(n) asm volatile("s_waitcnt vmcnt(" #n ")" ::: "memory")
#define PG8_WAIT_L(n) asm volatile("s_waitcnt lgkmcnt(" #n ")" ::: "memory")
#define PG8_BAR __builtin_amdgcn_s_barrier()
#define PG8_SCHED __builtin_amdgcn_sched_barrier(0)
    UnitG cur, nxt; int ui = 0;
    if (!S.next(0, cur)) return;
    f32x4 acc[2][2][4][2];
#pragma unroll
    for (int a = 0; a < 2; ++a)
#pragma unroll
        for (int b = 0; b < 2; ++b)
#pragma unroll
            for (int m = 0; m < 4; ++m)
#pragma unroll
                for (int n = 0; n < 2; ++n) acc[a][b][m][n] = (f32x4){0.f, 0.f, 0.f, 0.f};
    bf16x8 At[4][2], B0[2][2], B1[2][2];
    unsigned ca[2][2], na[2][2]; PG8_AOFFS(cur, ca); const char* cB = cur.bbase + (size_t)cur.pn * tstep;
    S.a_ready(cur);
    PG8_STAGE(PG8_SB(0, 0), cB, voffB); PG8_STAGE_A(PG8_SA(0, 0), ca[0], 0); PG8_STAGE(PG8_SB(0, 1), cB + hstep, voffB); PG8_STAGE_A(PG8_SA(0, 1), ca[1], 0);
    if (wr == 1) PG8_BAR;
    PG8_WAIT_V(4); PG8_BAR;
    PG8_STAGE(PG8_SB(1, 0), cB + kstep, voffB); PG8_STAGE_A(PG8_SA(1, 0), ca[0], kstep); PG8_STAGE(PG8_SB(1, 1), cB + hstep + kstep, voffB);
    PG8_WAIT_V(6); PG8_BAR;
    for (;;) {
        const bool has_next = S.next(ui + 1, nxt);
        if (has_next) PG8_AOFFS(nxt, na); else { na[0][0] = ca[0][0]; na[0][1] = ca[0][1]; na[1][0] = ca[1][0]; na[1][1] = ca[1][1]; }
        const char* nB = has_next ? nxt.bbase + (size_t)nxt.pn * tstep : cB;
        for (int t = 0; t < nt; t += 2) {
            const bool last = (t == nt - 2);
            const size_t k1 = (size_t)(t + 1) * kstep, k2 = last ? 0 : (size_t)(t + 2) * kstep;
            unsigned a2o[2][2];
#pragma unroll
            for (int _h = 0; _h < 2; ++_h)
#pragma unroll
                for (int _i = 0; _i < 2; ++_i) a2o[_h][_i] = last ? na[_h][_i] : ca[_h][_i];
            const char* b2 = last ? nB : cB + (size_t)(t + 2) * kstep; const char* b3 = b2 + kstep;
            if (last && has_next) S.a_ready(nxt);
            PG8_LDB(B0, 0, 0); PG8_SCHED; PG8_LDA(At, 0, 0); PG8_STAGE_A(PG8_SA(1, 1), ca[1], k1);
            PG8_WAIT_L(8); PG8_BAR; PG8_WAIT_L(0); PG8_MMA(0, 0, At, B0); PG8_BAR; PG8_SCHED;
            PG8_LDB(B1, 0, 1); PG8_STAGE(PG8_SB(0, 0), b2, voffB);
            PG8_BAR; PG8_WAIT_L(0); PG8_MMA(0, 1, At, B1); PG8_BAR;
            PG8_LDA(At, 0, 1); PG8_STAGE_A(PG8_SA(0, 0), a2o[0], k2);
            PG8_BAR; PG8_WAIT_L(0); PG8_MMA(1, 0, At, B0); PG8_BAR; PG8_SCHED;
            PG8_STAGE(PG8_SB(0, 1), b2 + hstep, voffB);
            PG8_WAIT_V(6); PG8_BAR; PG8_MMA(1, 1, At, B1); PG8_BAR;
            PG8_LDB(B0, 1, 0); PG8_SCHED; PG8_LDA(At, 1, 0); PG8_STAGE_A(PG8_SA(0, 1), a2o[1], k2);
            PG8_WAIT_L(8); PG8_BAR; PG8_WAIT_L(0); PG8_MMA(0, 0, At, B0); PG8_BAR; PG8_SCHED;
            PG8_LDB(B1, 1, 1); PG8_STAGE(PG8_SB(1, 0), b3, voffB);
            PG8_BAR; PG8_WAIT_L(0); PG8_MMA(0, 1, At, B1); PG8_BAR;
            PG8_LDA(At, 1, 1); PG8_STAGE_A(PG8_SA(1, 0), a2o[0], k2 + kstep);
            PG8_BAR; PG8_WAIT_L(0); PG8_MMA(1, 0, At, B0); PG8_BAR; PG8_SCHED;
            PG8_STAGE(PG8_SB(1, 1), b3 + hstep, voffB);
            PG8_WAIT_V(6); PG8_BAR; PG8_MMA(1, 1, At, B1); PG8_BAR;
        }
            if constexpr (!Epi::AFTER_DRAIN) { E(acc, cur, wr, wc, fr, fq); S.done(cur); }
            if (!has_next) break;
#pragma unroll
        for (int a = 0; a < 2; ++a)
#pragma unroll
            for (int b = 0; b < 2; ++b)
#pragma unroll
                for (int m = 0; m < 4; ++m)
#pragma unroll
                    for (int n = 0; n < 2; ++n) acc[a][b][m][n] = (f32x4){0.f, 0.f, 0.f, 0.f};
        cur = nxt; ca[0][0] = na[0][0]; ca[0][1] = na[0][1]; ca[1][0] = na[1][0]; ca[1][1] = na[1][1]; cB = nB; ++ui;
    }
    PG8_WAIT_V(0);
    if (wr == 0) PG8_BAR;
    PG8_BAR;
    if constexpr (Epi::AFTER_DRAIN) { E.fused(acc, cur, wr, wc, fr, fq, lds, wid, lane); S.done(cur); }
#undef PG8_SA
#undef PG8_AOFFS
#undef PG8_STAGE_A
#undef PG8_SB
#undef PG8_STAGE
#undef PG8_LDA
#undef PG8_LDB
#undef PG8_MMA
#undef PG8_WAIT_V
#undef PG8_WAIT_L
#undef PG8_BAR
#undef PG8_SCHED
}
}

__device__ __forceinline__ void transpose_item(const float* __restrict__ W, int K, int N, bf16_t* __restrict__ WT, int mode, LAS float* scr, int item, int lane) {
    const int nblk = N / 32, kb = item / nblk, nb = item % nblk, k0 = 64 * kb, n0 = 32 * nb;
#pragma unroll 8
    for (int i = 0; i < 32; ++i) { const int kk = 2 * i + (lane >> 5); scr[kk * 33 + (lane & 31)] = W[(size_t)(k0 + kk) * N + n0 + (lane & 31)]; }
    asm volatile("s_waitcnt lgkmcnt(0)" ::: "memory");
    const int c = lane & 7;
#pragma unroll
    for (int j = 0; j < 4; ++j) {
        const int nl = (lane >> 3) + 8 * j; const LAS float* s = scr + (8 * c) * 33 + nl;
        u32x4 o; o.x = pk2(s[0 * 33], s[1 * 33]); o.y = pk2(s[2 * 33], s[3 * 33]); o.z = pk2(s[4 * 33], s[5 * 33]); o.w = pk2(s[6 * 33], s[7 * 33]);
        const int n = n0 + nl;
        const int nd = mode == 0 ? n : (32 * (n >> 4) + (n & 15) + (mode == 2 ? 16 : 0));
        *(u32x4*)(WT + (size_t)nd * K + k0 + 8 * c) = o;
    }
    asm volatile("s_waitcnt lgkmcnt(0)" ::: "memory");
}

__device__ __forceinline__ void phase_prologue0(KP Pk, LAS char* lds) {
    asm volatile("" : "+s"(Pk));
    const CAS Params& P = *Pk;
    const int tid = ltid(), lane = tid & 63, wid = tid >> 6;
    const int gw = blockIdx.x * 8 + wid, NGW = gridDim.x * 8;
    LAS float* scr = (LAS float*)(lds + wid * 8448);
    bf16_t* winT = (bf16_t*)(P.ws + WS_WINT);
    bf16_t* woutT = (bf16_t*)(P.ws + WS_WOUTT);
    bf16_t* loraT = (bf16_t*)(P.ws + WS_LORAT);
    constexpr int I_EV = 16 * (P_EVEN / 32), I_OD = 16 * (P_ODD / 32), I_O = 16 * 32, I_L64 = 16, I_L128 = 32;
    constexpr int I_LORA = 3 * I_L64 + I_L128;
    constexpr int NIT = 2 * I_EV + 2 * I_OD + 4 * I_O + 2 * I_LORA;
    for (int it = gw; it < NIT; it += NGW) {
        int r = it;
        if (r < 2 * I_EV) { const int i = r / I_EV; transpose_item(P.ev_w_in + (size_t)i * D * P_EVEN, D, P_EVEN, winT + (i ? WINT_L2 : WINT_L0), 0, scr, r % I_EV, lane); continue; } r -= 2 * I_EV;
        if (r < 2 * I_OD) { const int i = r / I_OD; transpose_item(P.od_w_in + (size_t)i * D * P_ODD, D, P_ODD, winT + (i ? WINT_L3 : WINT_L1), 0, scr, r % I_OD, lane); continue; } r -= 2 * I_OD;
        if (r < 4 * I_O) { const int l = r / I_O; const float* src = (l & 1) ? P.od_w_out + (size_t)(l >> 1) * D * D : P.ev_w_out + (size_t)(l >> 1) * D * D;
            transpose_item(src, D, D, woutT + (size_t)l * D * D, 0, scr, r % I_O, lane); continue; } r -= 4 * I_O;
        { const int i = r / I_LORA; int q = r % I_LORA; bf16_t* dst = loraT + (size_t)i * LORA_PER;
          if (q < I_L64) { transpose_item(P.rw_w2 + (size_t)(i * 2 + 0) * 64 * 512, 64, 512, dst, 0, scr, q, lane); continue; } q -= I_L64;
          if (q < I_L64) { transpose_item(P.rw_w2 + (size_t)(i * 2 + 1) * 64 * 512, 64, 512, dst + 512 * 64, 0, scr, q, lane); continue; } q -= I_L64;
          if (q < I_L64) { transpose_item(P.rw_a2 + (size_t)i * 64 * 512, 64, 512, dst + 2 * 512 * 64, 0, scr, q, lane); continue; } q -= I_L64;
          transpose_item(P.rw_g2 + (size_t)i * 128 * 512, 128, 512, dst + 3 * 512 * 64, 0, scr, q, lane); }
    }
    {
        const int gt = blockIdx.x * NT + tid, NG = gridDim.x * NT;
        constexpr int PADE = (LDP_EVEN - P_EVEN) * D / 8, PADO = (LDP_ODD - P_ODD) * D / 8;
        for (int i = gt; i < 2 * PADE + 2 * PADO; i += NG) {
            int r = i; bf16_t* dst;
            if (r < 2 * PADE) { const int l = r / PADE; dst = winT + (l ? WINT_L2 : WINT_L0) + (size_t)P_EVEN * D + (size_t)(r % PADE) * 8; }
            else { r -= 2 * PADE; const int l = r / PADO; dst = winT + (l ? WINT_L3 : WINT_L1) + (size_t)P_ODD * D + (size_t)(r % PADO) * 8; }
            *(u32x4*)dst = (u32x4){0u, 0u, 0u, 0u};
        }
    }
    {
        const int gt = blockIdx.x * NT + tid, NG = gridDim.x * NT;
        float* xc = (float*)(P.ws + WS_XC);
        for (int i = gt; i < NCTX * D / 4; i += NG) ((f32x4*)xc)[i] = ((const f32x4*)P.ctx)[i];
        float* lb = (float*)(P.ws + WS_LB);
        for (int ch = gt; ch < 512; ch += NG) {
            float lg[4], mx = -1e30f;
#pragma unroll
            for (int l = 0; l < 4; ++l) { lg[l] = P.hg_lb_logits[l * 512 + ch]; mx = fmaxf(mx, lg[l]); }
            float e[4], s = 0.f;
#pragma unroll
            for (int l = 0; l < 4; ++l) { e[l] = expf(lg[l] - mx); s += e[l]; }
            float cum = 0.f;
#pragma unroll
            for (int l = 0; l < 4; ++l) { if (l > 0) cum += e[l] / s; lb[l * 512 + ch] = cum; }
        }
    }
    __syncthreads();
    {
        LAS float* sc = (LAS float*)lds;
        LAS float* red = (LAS float*)(lds + 5 * 1024 * 4);
        for (int i = tid; i < 5 * D; i += NT) { const int m = i >> 10, k = i & 1023; const float v = m < 4 ? P.c[m * D + k] : P.c_ctx[k]; sc[i] = siluf_(v); }
        __syncthreads();
        float* modv = (float*)(P.ws + WS_MODV);
        const int col = tid & 127, kq = tid >> 7;
        for (int item = blockIdx.x; item < 4 * 48; item += gridDim.x) {
            const int l = item / 48, j = (item % 48) * 128 + col;
            const float* w = P.mod_w + (size_t)l * D * 6144 + j;
            float a[5] = {0.f, 0.f, 0.f, 0.f, 0.f};
#pragma unroll 8
            for (int k = kq * 256; k < kq * 256 + 256; ++k) {
                const float wv = w[(size_t)k * 6144];
#pragma unroll
                for (int m = 0; m < 5; ++m) a[m] += sc[m * 1024 + k] * wv;
            }
#pragma unroll
            for (int m = 0; m < 5; ++m) red[(kq * 128 + col) * 5 + m] = a[m];
            __syncthreads();
            if (kq == 0) {
                const float bias = P.mod_b[l * 6144 + j];
#pragma unroll
                for (int m = 0; m < 5; ++m) {
                    const float s = red[(0 * 128 + col) * 5 + m] + red[(1 * 128 + col) * 5 + m] + red[(2 * 128 + col) * 5 + m] + red[(3 * 128 + col) * 5 + m];
                    modv[(size_t)(l * 5 + m) * 6144 + j] = s + bias;
                }
            }
            __syncthreads();
        }
    }
}

__device__ __forceinline__ void phase_prologue1(KP Pk) {
    asm volatile("" : "+s"(Pk));
    const CAS Params& P = *Pk;
    const int tid = ltid(), lane = tid & 63, wid = tid >> 6;
    bf16_t* act = (bf16_t*)(P.ws + WS_ACT);
    for (int r = blockIdx.x * 8 + wid; r < NROWS; r += gridDim.x * 8) {
        const int m = row_mod(r);
        const float* src = r < NCTX ? P.ctx + (size_t)r * D : P.x + (size_t)(r - NCTX) * D;
        const float* sh = modvec(P.ws, 0, m, 0); const float* sc = modvec(P.ws, 0, m, 1);
#pragma unroll
        for (int i = 0; i < 4; ++i) {
            const int c = 4 * lane + 256 * i;
            const f32x4 v = *(const f32x4*)(src + c), s1 = *(const f32x4*)(sc + c), h1 = *(const f32x4*)(sh + c);
            if (r >= NCTX) *(f32x4*)(P.out + (size_t)(r - NCTX) * D + c) = v;
            u32x2 o; o.x = pk2(v[0] * (1.f + s1[0]) + h1[0], v[1] * (1.f + s1[1]) + h1[1]); o.y = pk2(v[2] * (1.f + s1[2]) + h1[2], v[3] * (1.f + s1[3]) + h1[3]);
            *(u32x2*)(act + (size_t)r * D + c) = o;
        }
    }
}

__device__ __forceinline__ void phase_inproj(KP Pk, int layer, LAS char* lds) {
    asm volatile("" : "+s"(Pk));
    const CAS Params& P = *Pk;
    const int odd = layer & 1, ldp = odd ? LDP_ODD : LDP_EVEN;
    const size_t woff = layer == 0 ? WINT_L0 : layer == 1 ? WINT_L1 : layer == 2 ? WINT_L2 : WINT_L3;
    pg8::Gemm g{(const bf16_t*)(P.ws + WS_ACT), (const bf16_t*)(P.ws + WS_WINT) + woff, NROWS, ldp, D};
    pg8::StaticOrder S; S.init(NROWS, ldp, (int)gridDim.x, (int)blockIdx.x);
    pg8::EpiStoreP E{(bf16_t*)(P.ws + WS_P), ldp};
    pg8::gemm_phase((PG8_LAS unsigned char*)lds, g, S, E);
}
__device__ __forceinline__ void phase_outproj(KP Pk, int layer, LAS char* lds) {
    asm volatile("" : "+s"(Pk));
    const CAS Params& P = *Pk;
    const int r0 = (layer == DEPTH - 1) ? NCTX : 0;
    pg8::Gemm g{(const bf16_t*)(P.ws + WS_FEAT) + (size_t)r0 * D, (const bf16_t*)(P.ws + WS_WOUTT) + (size_t)layer * D * D, NROWS - r0, D, D};
    pg8::StaticOrder S; S.init(NROWS - r0, D, (int)gridDim.x, (int)blockIdx.x);
    pg8::EpiStoreP E{(bf16_t*)(P.ws + WS_YO) + (size_t)r0 * D, D};
    pg8::gemm_phase((PG8_LAS unsigned char*)lds, g, S, E);
}
__device__ __forceinline__ void phase_prep2(KP Pk, int layer, LAS char* lds) {
    asm volatile("" : "+s"(Pk));
    const CAS Params& P = *Pk;
    const int i = layer >> 1;
    const bf16_t* la = (const bf16_t*)(P.ws + WS_LA);
    const bf16_t* lt = (const bf16_t*)(P.ws + WS_LORAT) + (size_t)i * LORA_PER;
    constexpr int MT = NROWS / G_BM, NTL = 512 / G_BN;
    const int ntiles = 4 * MT * NTL;
    for (int t = blockIdx.x; t < ntiles; t += gridDim.x) {
        const int which = t / (MT * NTL), r = t % (MT * NTL), mt = r / NTL, nt = r % NTL;
        RowLinear rs{mt * G_BM};
        if (which < 2) {
            EpiDecay epi{(float*)(P.ws + WS_RWDEC) + (size_t)which * NROWS * 512, P.rw_w0 + (size_t)(i * 2 + which) * 512, mt * G_BM, nt * G_BN};
            gemm_tile(la + which * 64, 320, rs, lt + (size_t)which * 512 * 64, 64, nt * G_BN, 64, epi, lds);
        } else if (which == 2) {
            EpiAK epi{(bf16_t*)(P.ws + WS_RWK), (const bf16_t*)(P.ws + WS_RWKK), (bf16_t*)(P.ws + WS_RWB), P.rw_a0 + i * 512, P.rw_k_a + i * 512, mt * G_BM, nt * G_BN};
            gemm_tile(la + 128, 320, rs, lt + (size_t)2 * 512 * 64, 64, nt * G_BN, 64, epi, lds);
        } else {
            EpiStoreBf16 epi{(bf16_t*)(P.ws + WS_RWG), 512, mt * G_BM, nt * G_BN, 512};
            gemm_tile(la + 192, 320, rs, lt + (size_t)3 * 512 * 64, 128, nt * G_BN, 128, epi, lds);
        }
    }
}
__device__ __forceinline__ void moe_tiles(const unsigned char* ws, int layer, LAS int* tstart, LAS int* tcnt) {
    if (threadIdx.x == 0) {
        const int* cnt = (const int*)(ws + WS_CNT) + layer * 32 * CNT_STRIDE;
        int acc = 0;
        for (int e = 0; e < NEXP; ++e) { const int c = cnt[e * CNT_STRIDE]; tcnt[e] = c; tstart[e] = acc; acc += (c + G_BM - 1) / G_BM; }
        tstart[NEXP] = acc;
    }
    __syncthreads();
}
__device__ __forceinline__ void phase_moe1(KP Pk, int layer, LAS char* lds) {
    asm volatile("" : "+s"(Pk));
    const CAS Params& P = *Pk;
    LAS int* tstart = (LAS int*)(lds + pg8::STAGE_BYTES); LAS int* tcnt = tstart + 40;
    moe_tiles(P.ws, layer, tstart, tcnt);
    pg8::Gemm g{(const bf16_t*)(P.ws + WS_ACT), (const bf16_t*)(P.ws + WS_EXPGU), 0, 1024, D};
    LAS int* ltabs = tstart + 128;
    pg8::MoeOrder S{tstart, tcnt, ltabs, (const int*)(P.ws + WS_LIST), (const char*)(P.ws + WS_EXPGU), (size_t)1024 * 1024 * 2, 4, 1, (int)gridDim.x, (int)blockIdx.x};
    pg8::EpiSwiGLUG E{(bf16_t*)(P.ws + WS_HID)};
    for (int i = 0; i < 8; ++i) {
        pg8::UnitG u; if (!S.next(i, u)) break;
        const int tl = ltid();
        if (tl < pg8::BM) ltabs[i * pg8::BM + tl] = u.list[tl < u.cnt ? tl : 0];
    }
    __syncthreads();
    pg8::gemm_phase_g((PG8_LAS unsigned char*)lds, g, S, E);
    __syncthreads();
}
__device__ __forceinline__ void phase_moe2(KP Pk, int layer, LAS char* lds) {
    asm volatile("" : "+s"(Pk));
    const CAS Params& P = *Pk;
    LAS int* tstart = (LAS int*)(lds + pg8::STAGE_BYTES); LAS int* tcnt = tstart + 40;
    moe_tiles(P.ws, layer, tstart, tcnt);
    pg8::Gemm g{(const bf16_t*)(P.ws + WS_HID), (const bf16_t*)(P.ws + WS_EXPD), 0, 1024, DEXP};
    LAS int* ltabs = tstart + 128;
    pg8::MoeOrder S{tstart, tcnt, ltabs, (const int*)(P.ws + WS_LIST), (const char*)(P.ws + WS_EXPD), (size_t)1024 * 512 * 2, 4, 0, (int)gridDim.x, (int)blockIdx.x};
    pg8::EpiScatterG E{(bf16_t*)(P.ws + WS_YP)};
    for (int i = 0; i < 8; ++i) {
        pg8::UnitG u; if (!S.next(i, u)) break;
        const int tl = ltid();
        if (tl < pg8::BM) ltabs[i * pg8::BM + tl] = u.list[tl < u.cnt ? tl : 0];
    }
    __syncthreads();
    pg8::gemm_phase_g((PG8_LAS unsigned char*)lds, g, S, E);
    __syncthreads();
}

constexpr int NCHUNK = NSTEPS / TCH;

constexpr int SSD_F = 32 + 64 + 64;
constexpr int SSD_BUF = TCH * SSD_F + 3 * TCH;
__device__ __forceinline__ void scan_ssd(KP Pk, int layer, int unit, LAS char* lds) {
    asm volatile("" : "+s"(Pk));
    const CAS Params& P = *Pk;
    const int tid = ltid(), i_ = layer >> 1;
    const int seq = unit >> 1, half = unit & 1, b = seq >> 4, h = (seq >> 1) & 7, dir = seq & 1, grp = h >> 2;
    LAS float* cw = (LAS float*)lds;
    LAS float* bufs = cw + 4 * 160;
    const bf16_t* Pb = (const bf16_t*)(P.ws + WS_P);
    bf16_t* Y = (bf16_t*)(P.ws + (dir ? WS_YB : WS_YF));
    for (int i = tid; i < 4 * 160; i += NT) {
        const int tap = i / 160, lc = i % 160, g = lc >> 3, e = lc & 7;
        const int ch = g < 4 ? (h * 64 + half * 32 + 8 * g + e) : g < 12 ? (512 + grp * 64 + 8 * (g - 4) + e) : (640 + grp * 64 + 8 * (g - 12) + e);
        cw[i] = tap < 3 ? P.ssd_conv_w[(size_t)(i_ * 3 + tap) * 768 + ch] : P.ssd_conv_b[i_ * 768 + ch];
    }
    const float dtb = P.ssd_dt_bias[(i_ * 2 + dir) * 8 + h], aco = -expf(P.ssd_a_log[(i_ * 2 + dir) * 8 + h]);
    int tj[2], tg_[2], tcol[2]; bool tv[2];
#pragma unroll
    for (int s = 0; s < 2; ++s) {
        const int task = tid + NT * s; tv[s] = task < 640; tj[s] = task / 20; tg_[s] = task % 20;
        const int g = tg_[s];
        tcol[s] = g < 4 ? (512 + h * 64 + half * 32 + 8 * g) : g < 12 ? (1024 + grp * 64 + 8 * (g - 4)) : (1152 + grp * 64 + 8 * (g - 12));
    }
    u32x4 rp[2], rc[2], rn[2]; float rdt = 0.f; int rrow = 0;
    auto load = [&](int c) {
#pragma unroll
        for (int s = 0; s < 2; ++s) {
            rp[s] = rc[s] = rn[s] = (u32x4){0u, 0u, 0u, 0u};
            if (tv[s]) {
                const int row = scan_row(c * TCH + tj[s], b, dir, 0); int t, len; row_seg(row, t, len);
                const bf16_t* p = Pb + (size_t)row * LDP_EVEN + tcol[s];
                rc[s] = *(const u32x4*)p;
                if (t > 0) rp[s] = *(const u32x4*)(p - LDP_EVEN);
                if (t < len - 1) rn[s] = *(const u32x4*)(p + LDP_EVEN);
            }
        }
        if (tid < TCH) { rrow = scan_row(c * TCH + tid, b, dir, 0); rdt = bf2f(Pb[(size_t)rrow * LDP_EVEN + 1280 + dir * 8 + h]); }
    };
    auto store = [&](int c) {
        LAS float* buf = bufs + (c & 1) * SSD_BUF;
#pragma unroll
        for (int s = 0; s < 2; ++s) {
            if (tv[s]) {
                float fp[8], fc[8], fn[8], o[8]; unpack8(rp[s], fp); unpack8(rc[s], fc); unpack8(rn[s], fn);
                const int lc = tg_[s] * 8;
#pragma unroll
                for (int e = 0; e < 8; ++e) o[e] = siluf_(cw[lc + e] * fp[e] + cw[160 + lc + e] * fc[e] + cw[320 + lc + e] * fn[e] + cw[480 + lc + e]);
                LAS float* dst = buf + tj[s] * SSD_F + lc;
                *(LAS f32x4*)dst = (f32x4){o[0], o[1], o[2], o[3]}; *(LAS f32x4*)(dst + 4) = (f32x4){o[4], o[5], o[6], o[7]};
            }
        }
        if (tid < TCH) {
            const float dt = softplusf_(rdt + dtb);
            buf[TCH * SSD_F + tid] = __expf(dt * aco); buf[TCH * SSD_F + TCH + tid] = dt; ((LAS int*)buf)[TCH * SSD_F + 2 * TCH + tid] = rrow;
        }
    };
    const int prow = tid >> 4, q = tid & 15;
    float hs[4] = {0.f, 0.f, 0.f, 0.f};
    __syncthreads();
    load(0); store(0); __syncthreads();
    for (int c = 0; c < NCHUNK; ++c) {
        if (c + 1 < NCHUNK) load(c + 1);
        LAS float* buf = bufs + (c & 1) * SSD_BUF;
        {
            const LAS float* xp = buf + prow;
            const LAS float* bp = buf + 32 + 4 * q;
            const LAS float* aux = buf + TCH * SSD_F;
            f32x4 B4 = *(const LAS f32x4*)bp, C4 = *(const LAS f32x4*)(bp + 64); float xr = xp[0];
#pragma unroll 1
            for (int jh = 0; jh < 2; ++jh) {
                float ysel = 0.f;
                f32x4 dA4, dt4;
#pragma unroll
                for (int j = 0; j < 16; ++j) {
                    const int jj = jh * 16 + j;
                    if ((j & 3) == 0) { dA4 = *(const LAS f32x4*)(aux + jj); dt4 = *(const LAS f32x4*)(aux + TCH + jj); }
                    const f32x4 Bc = B4, Cc = C4; const float xc = xr;
                    if (j < 15 || jh == 0) { B4 = *(const LAS f32x4*)(bp + (jj + 1) * SSD_F); C4 = *(const LAS f32x4*)(bp + 64 + (jj + 1) * SSD_F); xr = xp[(jj + 1) * SSD_F]; }
                    const float dA = dA4[j & 3], xv = xc * dt4[j & 3];
                    float y = 0.f;
#pragma unroll
                    for (int e = 0; e < 4; ++e) { hs[e] = dA * hs[e] + xv * Bc[e]; y += Cc[e] * hs[e]; }
                    y = allreduce16(y);
                    ysel = (q == j) ? y : ysel;
                }
                const int row = ((const LAS int*)aux)[2 * TCH + jh * 16 + q];
                Y[(size_t)row * D + h * 64 + half * 32 + prow] = f2bf(ysel);
            }
        }
        if (c + 1 < NCHUNK) store(c + 1);
        __syncthreads();
    }
}

constexpr int ML_F = 64 + 64 + 32;
constexpr int ML_BUF = TCH * ML_F + 4 * TCH;
__device__ __forceinline__ void scan_mlstm(KP Pk, int layer, int unit, LAS char* lds) {
    asm volatile("" : "+s"(Pk));
    const CAS Params& P = *Pk;
    const int tid = ltid(), i_ = layer >> 1;
    const int seq = unit >> 2, quarter = unit & 3, b = seq >> 3, h = (seq >> 1) & 3, dir = seq & 1;
    LAS float* cw = (LAS float*)lds;
    LAS float* bufs = cw + 4 * 128;
    const bf16_t* Pb = (const bf16_t*)(P.ws + WS_P);
    bf16_t* Y = (bf16_t*)(P.ws + (dir ? WS_YB : WS_YF));
    for (int i = tid; i < 4 * 128; i += NT) {
        const int tap = i >> 7, lc = i & 127;
        const int ch = lc < 64 ? (h * 64 + lc) : (256 + h * 64 + lc - 64);
        cw[i] = tap < 3 ? P.ml_conv_w[(size_t)(i_ * 3 + tap) * 512 + ch] : P.ml_conv_b[i_ * 512 + ch];
    }
    const float ib = P.ml_i_bias[(i_ * 2 + dir) * 4 + h], fb = P.ml_f_bias[(i_ * 2 + dir) * 4 + h];
    int tj[2], tg_[2], tcol[2]; bool tv[2];
#pragma unroll
    for (int s = 0; s < 2; ++s) {
        const int task = tid + NT * s; tv[s] = task < 640; tj[s] = task / 20; tg_[s] = task % 20;
        const int g = tg_[s];
        tcol[s] = 1296 + (g < 8 ? (h * 64 + 8 * g) : g < 16 ? (256 + h * 64 + 8 * (g - 8)) : (512 + h * 128 + quarter * 32 + 8 * (g - 16)));
    }
    u32x4 rp[2], rc[2], rn[2]; float rgi = 0.f, rgf = 0.f; int rrow = 0;
    float mcarry = -1e30f;
    auto load = [&](int c) {
#pragma unroll
        for (int s = 0; s < 2; ++s) {
            rp[s] = rc[s] = rn[s] = (u32x4){0u, 0u, 0u, 0u};
            if (tv[s]) {
                const int row = scan_row(c * TCH + tj[s], b, dir, 0); int t, len; row_seg(row, t, len);
                const bf16_t* p = Pb + (size_t)row * LDP_EVEN + tcol[s];
                rc[s] = *(const u32x4*)p;
                if (tg_[s] < 16) { if (t > 0) rp[s] = *(const u32x4*)(p - LDP_EVEN); if (t < len - 1) rn[s] = *(const u32x4*)(p + LDP_EVEN); }
            }
        }
        if (tid < TCH) {
            rrow = scan_row(c * TCH + tid, b, dir, 0);
            const bf16_t* g = Pb + (size_t)rrow * LDP_EVEN + 1296 + 1536;
            rgi = bf2f(g[dir * 4 + h]); rgf = bf2f(g[8 + dir * 4 + h]);
        }
    };
    auto store = [&](int c) {
        LAS float* buf = bufs + (c & 1) * ML_BUF;
#pragma unroll
        for (int s = 0; s < 2; ++s) {
            if (tv[s]) {
                float fp[8], fc[8], fn[8], o[8]; unpack8(rp[s], fp); unpack8(rc[s], fc); unpack8(rn[s], fn);
                const int g = tg_[s], lc = g * 8;
                if (g < 16) {
                    const float scl = g < 8 ? 0.125f : 1.f;
#pragma unroll
                    for (int e = 0; e < 8; ++e) o[e] = scl * siluf_(cw[lc + e] * fp[e] + cw[128 + lc + e] * fc[e] + cw[256 + lc + e] * fn[e] + cw[384 + lc + e]);
                } else {
#pragma unroll
                    for (int e = 0; e < 8; ++e) o[e] = fc[e];
                }
                LAS float* dst = buf + tj[s] * ML_F + lc;
                *(LAS f32x4*)dst = (f32x4){o[0], o[1], o[2], o[3]}; *(LAS f32x4*)(dst + 4) = (f32x4){o[4], o[5], o[6], o[7]};
            }
        }
        if (tid < 64) {
            const int l = tid & 31;
            const float li = rgi + ib, lf = logsigmoidf_(rgf + fb);
            float F = lf;
#pragma unroll
            for (int o = 1; o < 32; o <<= 1) { const float t = __shfl_up(F, o, 32); if (l >= o) F += t; }
            float cm = li - F;
#pragma unroll
            for (int o = 1; o < 32; o <<= 1) { const float t = __shfl_up(cm, o, 32); if (l >= o) cm = fmaxf(cm, t); }
            const float m = F + fmaxf(mcarry, cm);
            float mprev = __shfl_up(m, 1, 32); if (l == 0) mprev = mcarry;
            const float sp = __expf(lf + mprev - m), sl = __expf(li - m), em = __expf(-m);
            if (tid < TCH) { buf[TCH * ML_F + tid] = sp; buf[TCH * ML_F + TCH + tid] = sl; buf[TCH * ML_F + 2 * TCH + tid] = em; ((LAS int*)buf)[TCH * ML_F + 3 * TCH + tid] = rrow; }
            mcarry = __shfl(m, 31, 32);
        }
    };
    const int col = tid >> 4, q = tid & 15;
    float Cs[4] = {0.f, 0.f, 0.f, 0.f}, ns[4] = {0.f, 0.f, 0.f, 0.f};
    __syncthreads();
    load(0); store(0); __syncthreads();
    for (int c = 0; c < NCHUNK; ++c) {
        if (c + 1 < NCHUNK) load(c + 1);
        LAS float* buf = bufs + (c & 1) * ML_BUF;
        {
            const LAS float* qp = buf + 4 * q;
            const LAS float* vp = buf + 128 + col;
            const LAS float* aux = buf + TCH * ML_F;
            f32x4 q4 = *(const LAS f32x4*)qp, k4 = *(const LAS f32x4*)(qp + 64); float vr = vp[0];
#pragma unroll 1
            for (int jh = 0; jh < 2; ++jh) {
                float nsel = 0.f, dsel = 1.f;
                f32x4 sp4, sl4;
#pragma unroll
                for (int j = 0; j < 16; ++j) {
                    const int jj = jh * 16 + j;
                    if ((j & 3) == 0) { sp4 = *(const LAS f32x4*)(aux + jj); sl4 = *(const LAS f32x4*)(aux + TCH + jj); }
                    const f32x4 qc = q4, kc = k4; const float vv = vr;
                    if (j < 15 || jh == 0) { q4 = *(const LAS f32x4*)(qp + (jj + 1) * ML_F); k4 = *(const LAS f32x4*)(qp + 64 + (jj + 1) * ML_F); vr = vp[(jj + 1) * ML_F]; }
                    const float sp = sp4[j & 3], sl = sl4[j & 3];
                    float num = 0.f, den = 0.f;
#pragma unroll
                    for (int e = 0; e < 4; ++e) { const float sk = sl * kc[e]; Cs[e] = sp * Cs[e] + sk * vv; ns[e] = sp * ns[e] + sk; num += qc[e] * Cs[e]; den += qc[e] * ns[e]; }
                    num = allreduce16(num); den = allreduce16(den);
                    nsel = (q == j) ? num : nsel; dsel = (q == j) ? den : dsel;
                }
                const float em = aux[2 * TCH + jh * 16 + q];
                const int row = ((const LAS int*)aux)[3 * TCH + jh * 16 + q];
                Y[(size_t)row * D + 512 + h * 128 + quarter * 32 + col] = f2bf(nsel * __builtin_amdgcn_rcpf(fmaxf(fabsf(dsel), em)));
            }
        }
        if (c + 1 < NCHUNK) store(c + 1);
        __syncthreads();
    }
}

constexpr int HG_F = 128 + 128 + 32;
constexpr int HG_BUF = TCH * HG_F + TCH;
__device__ __forceinline__ void scan_hgrn(KP Pk, int layer, int unit, LAS char* lds) {
    asm volatile("" : "+s"(Pk));
    const CAS Params& P = *Pk;
    const int tid = ltid(), i_ = layer >> 1;
    const int seq = unit >> 2, quarter = unit & 3, b = seq >> 3, h = (seq >> 1) & 3, dir = seq & 1;
    LAS float* cst = (LAS float*)lds;
    LAS float* bufs = cst + 256;
    const bf16_t* Pb = (const bf16_t*)(P.ws + WS_P);
    bf16_t* Y = (bf16_t*)(P.ws + (dir ? WS_YB : WS_YF));
    if (tid < 128) cst[tid] = ((const float*)(P.ws + WS_LB))[layer * 512 + h * 128 + tid];
    else if (tid < 256) cst[tid] = P.hg_f_bias[(size_t)(i_ * 2 + dir) * 512 + h * 128 + tid - 128];
    int tj[3], tg_[3], tcol[3]; bool tv[3];
#pragma unroll
    for (int s = 0; s < 3; ++s) {
        const int task = tid + NT * s; tv[s] = task < TCH * 36; tj[s] = task / 36; tg_[s] = task % 36;
        const int g = tg_[s];
        tcol[s] = g < 16 ? (512 + dir * 512 + h * 128 + 8 * g) : g < 32 ? (h * 128 + 8 * (g - 16)) : (1536 + h * 128 + quarter * 32 + 8 * (g - 32));
    }
    u32x4 rc[3]; int rrow = 0;
    auto load = [&](int c) {
#pragma unroll
        for (int s = 0; s < 3; ++s) {
            rc[s] = (u32x4){0u, 0u, 0u, 0u};
            if (tv[s]) { const int row = scan_row(c * TCH + tj[s], b, dir, 1); rc[s] = *(const u32x4*)(Pb + (size_t)row * LDP_ODD + tcol[s]); }
        }
        if (tid < TCH) rrow = scan_row(c * TCH + tid, b, dir, 1);
    };
    auto store = [&](int c) {
        LAS float* buf = bufs + (c & 1) * HG_BUF;
#pragma unroll
        for (int s = 0; s < 3; ++s) {
            if (tv[s]) {
                float fc[8], o[8]; unpack8(rc[s], fc);
                const int g = tg_[s], lc = g * 8;
                if (g < 16) {
#pragma unroll
                    for (int e = 0; e < 8; ++e) { const float lbv = cst[lc + e]; o[e] = lbv + (1.f - lbv) * sigmoidf_(fc[e] + cst[128 + lc + e]); }
                } else if (g < 32) {
#pragma unroll
                    for (int e = 0; e < 8; ++e) o[e] = siluf_(fc[e]);
                } else {
#pragma unroll
                    for (int e = 0; e < 8; ++e) o[e] = fc[e];
                }
                LAS float* dst = buf + tj[s] * HG_F + lc;
                *(LAS f32x4*)dst = (f32x4){o[0], o[1], o[2], o[3]}; *(LAS f32x4*)(dst + 4) = (f32x4){o[4], o[5], o[6], o[7]};
            }
        }
        if (tid < TCH) ((LAS int*)buf)[TCH * HG_F + tid] = rrow;
    };
    const int col = tid >> 4, q = tid & 15;
    float S[8];
#pragma unroll
    for (int e = 0; e < 8; ++e) S[e] = 0.f;
    __syncthreads();
    load(0); store(0); __syncthreads();
    for (int c = 0; c < NCHUNK; ++c) {
        if (c + 1 < NCHUNK) load(c + 1);
        LAS float* buf = bufs + (c & 1) * HG_BUF;
        {
            const LAS float* fp = buf + 4 * q;
            const LAS float* vp = buf + 256 + col;
            f32x4 f0 = *(const LAS f32x4*)fp, f1 = *(const LAS f32x4*)(fp + 64), q0 = *(const LAS f32x4*)(fp + 128), q1 = *(const LAS f32x4*)(fp + 192); float vr = vp[0];
#pragma unroll 1
            for (int jh = 0; jh < 2; ++jh) {
                float ysel = 0.f;
#pragma unroll
                for (int j = 0; j < 16; ++j) {
                    const int jj = jh * 16 + j;
                    const f32x4 f0c = f0, f1c = f1, q0c = q0, q1c = q1; const float vv = vr;
                    if (j < 15 || jh == 0) {
                        const LAS float* np = fp + (jj + 1) * HG_F;
                        f0 = *(const LAS f32x4*)np; f1 = *(const LAS f32x4*)(np + 64); q0 = *(const LAS f32x4*)(np + 128); q1 = *(const LAS f32x4*)(np + 192); vr = vp[(jj + 1) * HG_F];
                    }
                    float o = 0.f;
#pragma unroll
                    for (int e = 0; e < 4; ++e) { S[e] = f0c[e] * (S[e] - vv) + vv; o += q0c[e] * S[e]; S[4 + e] = f1c[e] * (S[4 + e] - vv) + vv; o += q1c[e] * S[4 + e]; }
                    o = allreduce16(o);
                    ysel = (q == j) ? o : ysel;
                }
                const int row = ((const LAS int*)buf)[TCH * HG_F + jh * 16 + q];
                Y[(size_t)row * D + h * 128 + quarter * 32 + col] = f2bf(ysel);
            }
        }
        if (c + 1 < NCHUNK) store(c + 1);
        __syncthreads();
    }
}

constexpr int RW_F = 5 * 64 + 32;
constexpr int RW_BUF = TCH * RW_F + TCH;
__device__ __forceinline__ void scan_rwkv(KP Pk, int layer, int unit, LAS char* lds) {
    asm volatile("" : "+s"(Pk));
    const CAS Params& P = *Pk;
    const int tid = ltid();
    const int seq = unit >> 1, half = unit & 1, b = seq >> 4, h = (seq >> 1) & 7, dir = seq & 1;
    LAS float* bufs = (LAS float*)lds;
    bf16_t* Y = (bf16_t*)(P.ws + (dir ? WS_YB : WS_YF));
    const float* dec = (const float*)(P.ws + WS_RWDEC) + (size_t)dir * NROWS * 512;
    int tj[4], tg_[4]; bool tv[4]; const unsigned char* tbase[4]; int tlds[4];
#pragma unroll
    for (int s = 0; s < 4; ++s) {
        const int task = tid + NT * s; tv[s] = task < TCH * 52; tj[s] = task / 52; tg_[s] = task % 52;
        const int g = tg_[s];
        if (g < 8)       { tbase[s] = P.ws + WS_RWR  + (size_t)(h * 64 + 8 * g) * 2;              tlds[s] = 256 + 8 * g; }
        else if (g < 16) { tbase[s] = P.ws + WS_RWK  + (size_t)(h * 64 + 8 * (g - 8)) * 2;        tlds[s] = 192 + 8 * (g - 8); }
        else if (g < 24) { tbase[s] = P.ws + WS_RWKK + (size_t)(h * 64 + 8 * (g - 16)) * 2;       tlds[s] = 64 + 8 * (g - 16); }
        else if (g < 32) { tbase[s] = P.ws + WS_RWB  + (size_t)(h * 64 + 8 * (g - 24)) * 2;       tlds[s] = 128 + 8 * (g - 24); }
        else if (g < 36) { tbase[s] = P.ws + WS_RWV  + (size_t)(h * 64 + half * 32 + 8 * (g - 32)) * 2; tlds[s] = 320 + 8 * (g - 32); }
        else             { tbase[s] = (const unsigned char*)(dec + h * 64 + 4 * (g - 36));        tlds[s] = 4 * (g - 36); }
    }
    u32x4 rc[4]; int rrow = 0;
    auto load = [&](int c) {
#pragma unroll
        for (int s = 0; s < 4; ++s) {
            rc[s] = (u32x4){0u, 0u, 0u, 0u};
            if (tv[s]) { const int row = scan_row(c * TCH + tj[s], b, dir, 1); rc[s] = *(const u32x4*)(tbase[s] + (size_t)row * (tg_[s] < 36 ? 1024 : 2048)); }
        }
        if (tid < TCH) rrow = scan_row(c * TCH + tid, b, dir, 1);
    };
    auto store = [&](int c) {
        LAS float* buf = bufs + (c & 1) * RW_BUF;
#pragma unroll
        for (int s = 0; s < 4; ++s) {
            if (tv[s]) {
                LAS float* dst = buf + tj[s] * RW_F + tlds[s];
                const int g = tg_[s];
                if (g >= 36) { *(LAS u32x4*)dst = rc[s]; }
                else {
                    float f[8]; unpack8(rc[s], f);
                    const float sg = (g >= 16 && g < 24) ? -1.f : 1.f;
                    *(LAS f32x4*)dst = (f32x4){sg * f[0], sg * f[1], sg * f[2], sg * f[3]}; *(LAS f32x4*)(dst + 4) = (f32x4){sg * f[4], sg * f[5], sg * f[6], sg * f[7]};
                }
            }
        }
        if (tid < TCH) ((LAS int*)buf)[TCH * RW_F + tid] = rrow;
    };
    const int vrow = tid >> 4, q = tid & 15;
    float S[4] = {0.f, 0.f, 0.f, 0.f};
    load(0); store(0); __syncthreads();
    for (int c = 0; c < NCHUNK; ++c) {
        if (c + 1 < NCHUNK) load(c + 1);
        LAS float* buf = bufs + (c & 1) * RW_BUF;
        {
            const LAS float* wp = buf + 4 * q;
            const LAS float* vp = buf + 320 + vrow;
            f32x4 w4 = *(const LAS f32x4*)wp, a4 = *(const LAS f32x4*)(wp + 64), b4 = *(const LAS f32x4*)(wp + 128), k4 = *(const LAS f32x4*)(wp + 192), r4 = *(const LAS f32x4*)(wp + 256); float vr = vp[0];
#pragma unroll 1
            for (int jh = 0; jh < 2; ++jh) {
                float ysel = 0.f;
#pragma unroll
                for (int j = 0; j < 16; ++j) {
                    const int jj = jh * 16 + j;
                    const f32x4 wc = w4, ac = a4, bc = b4, kc = k4, rc = r4; const float vv = vr;
                    if (j < 15 || jh == 0) {
                        const LAS float* np = wp + (jj + 1) * RW_F;
                        w4 = *(const LAS f32x4*)np; a4 = *(const LAS f32x4*)(np + 64); b4 = *(const LAS f32x4*)(np + 128); k4 = *(const LAS f32x4*)(np + 192); r4 = *(const LAS f32x4*)(np + 256); vr = vp[(jj + 1) * RW_F];
                    }
                    float sa = S[0] * ac[0] + S[1] * ac[1] + S[2] * ac[2] + S[3] * ac[3];
                    sa = allreduce16(sa);
                    float y = 0.f;
#pragma unroll
                    for (int e = 0; e < 4; ++e) { S[e] = S[e] * wc[e] + (sa * bc[e] + vv * kc[e]); y += S[e] * rc[e]; }
                    y = allreduce16(y);
                    ysel = (q == j) ? y : ysel;
                }
                const int row = ((const LAS int*)buf)[TCH * RW_F + jh * 16 + q];
                Y[(size_t)row * D + 512 + h * 64 + half * 32 + vrow] = f2bf(ysel);
            }
        }
        if (c + 1 < NCHUNK) store(c + 1);
        __syncthreads();
    }
}

constexpr size_t WS_EXBC = WS_RWR;
constexpr size_t WS_EQK = WS_EXBC + (size_t)NROWS * 768 * 2;
constexpr size_t WS_EGT = WS_EQK + (size_t)NROWS * 512 * 2;
static_assert(WS_EGT + (size_t)NROWS * 32 * 4 <= WS_LA, "even-layer prepare buffers must fit in the RWKV region");

__device__ __forceinline__ void phase_prep_even(KP Pk, int layer) {
    asm volatile("" : "+s"(Pk));
    const CAS Params& P = *Pk;
    const int tid = ltid(), lane = tid & 63, wid = tid >> 6, i_ = layer >> 1;
    const bf16_t* Pb = (const bf16_t*)(P.ws + WS_P);
    bf16_t* XBC = (bf16_t*)(P.ws + WS_EXBC); bf16_t* QK = (bf16_t*)(P.ws + WS_EQK); float* GT = (float*)(P.ws + WS_EGT);
    float cw0[4][8], cw1[4][8], cwq[4][8];
#pragma unroll
    for (int e = 0; e < 8; ++e) {
#pragma unroll
        for (int t = 0; t < 3; ++t) {
            cw0[t][e] = P.ssd_conv_w[(size_t)(i_ * 3 + t) * 768 + 8 * lane + e];
            cw1[t][e] = P.ssd_conv_w[(size_t)(i_ * 3 + t) * 768 + 512 + 8 * (lane & 31) + e];
            cwq[t][e] = P.ml_conv_w[(size_t)(i_ * 3 + t) * 512 + 8 * lane + e];
        }
        cw0[3][e] = P.ssd_conv_b[i_ * 768 + 8 * lane + e]; cw1[3][e] = P.ssd_conv_b[i_ * 768 + 512 + 8 * (lane & 31) + e]; cwq[3][e] = P.ml_conv_b[i_ * 512 + 8 * lane + e];
    }
    float gbias = 0.f;
    if (lane < 16) gbias = P.ssd_dt_bias[i_ * 16 + lane]; else if (lane < 24) gbias = P.ml_i_bias[i_ * 8 + lane - 16]; else if (lane < 32) gbias = P.ml_f_bias[i_ * 8 + lane - 24];
    const float qscl = lane < 32 ? 0.125f : 1.f;
    for (int r = blockIdx.x * 8 + wid; r < NROWS; r += gridDim.x * 8) {
        int t, len; row_seg(r, t, len);
        const bf16_t* pr = Pb + (size_t)r * LDP_EVEN;
        const bool hp = t > 0, hn = t < len - 1;
        const u32x4 zero = (u32x4){0u, 0u, 0u, 0u};
        float fc[8], fp[8], fn[8], o[8];
        {
            const int col = 512 + 8 * lane;
            unpack8(*(const u32x4*)(pr + col), fc); unpack8(hp ? *(const u32x4*)(pr - LDP_EVEN + col) : zero, fp); unpack8(hn ? *(const u32x4*)(pr + LDP_EVEN + col) : zero, fn);
#pragma unroll
            for (int e = 0; e < 8; ++e) o[e] = siluf_(cw0[0][e] * fp[e] + cw0[1][e] * fc[e] + cw0[2][e] * fn[e] + cw0[3][e]);
            *(u32x4*)(XBC + (size_t)r * 768 + 8 * lane) = pack8(o);
        }
        if (lane < 32) {
            const int col = 1024 + 8 * lane;
            unpack8(*(const u32x4*)(pr + col), fc); unpack8(hp ? *(const u32x4*)(pr - LDP_EVEN + col) : zero, fp); unpack8(hn ? *(const u32x4*)(pr + LDP_EVEN + col) : zero, fn);
#pragma unroll
            for (int e = 0; e < 8; ++e) o[e] = siluf_(cw1[0][e] * fp[e] + cw1[1][e] * fc[e] + cw1[2][e] * fn[e] + cw1[3][e]);
            *(u32x4*)(XBC + (size_t)r * 768 + 512 + 8 * lane) = pack8(o);
        }
        {
            const int col = 1296 + 8 * lane;
            unpack8(*(const u32x4*)(pr + col), fc); unpack8(hp ? *(const u32x4*)(pr - LDP_EVEN + col) : zero, fp); unpack8(hn ? *(const u32x4*)(pr + LDP_EVEN + col) : zero, fn);
#pragma unroll
            for (int e = 0; e < 8; ++e) o[e] = qscl * siluf_(cwq[0][e] * fp[e] + cwq[1][e] * fc[e] + cwq[2][e] * fn[e] + cwq[3][e]);
            *(u32x4*)(QK + (size_t)r * 512 + 8 * lane) = pack8(o);
        }
        if (lane < 32) {
            const int col = lane < 16 ? 1280 + lane : 2832 + (lane - 16);
            const float x = bf2f(pr[col]) + gbias;
            GT[(size_t)r * 32 + lane] = lane < 16 ? softplusf_(x) : lane < 24 ? x : logsigmoidf_(x);
        }
    }
}

constexpr int CL = 64, NCH64 = NSTEPS / CL, LDT = 72, LDTB = LDT * 2;
__device__ __forceinline__ bf16x8 ldfrag(const LAS char* tile, int ldb, int row0, int k0, int lane) {
    return *(const LAS bf16x8*)(tile + (row0 + (lane & 15)) * ldb + (k0 + 8 * (lane >> 4)) * 2);
}
__device__ __forceinline__ void st4bf(LAS char* p, const f32x4& v) { u32x2 o; o.x = pk2(v[0], v[1]); o.y = pk2(v[2], v[3]); *(LAS u32x2*)p = o; }

constexpr int SS_BT = 0, SS_CT = SS_BT + 64 * LDTB, SS_BDT = SS_CT + 64 * LDTB, SS_XT = SS_BDT + 64 * LDTB, SS_CUM = SS_XT + 32 * LDTB, SS_DTV = SS_CUM + 256, SS_ROWS = SS_DTV + 256, SS_STG = SS_ROWS + 256;
constexpr int SS_M = 2 * SS_STG, SS_HB = SS_M + 64 * LDTB, SS_END = SS_HB + 32 * LDTB;
static_assert(SS_END <= LDS_BYTES - 16, "SSD LDS map");
__device__ __forceinline__ void scan_ssd_c(KP Pk, int layer, int unit, LAS char* lds) {
    asm volatile("" : "+s"(Pk));
    const CAS Params& P = *Pk;
    const int tid = ltid(), lane = tid & 63, wid = tid >> 6, q = lane >> 4, r16 = lane & 15, i_ = layer >> 1;
    const int seq = unit >> 1, half = unit & 1, b = seq >> 4, h = (seq >> 1) & 7, dir = seq & 1, grp = h >> 2;
    const bf16_t* XBC = (const bf16_t*)(P.ws + WS_EXBC);
    const float* GT = (const float*)(P.ws + WS_EGT);
    bf16_t* Y = (bf16_t*)(P.ws + (dir ? WS_YB : WS_YF));
    const float aco = -expf(P.ssd_a_log[(i_ * 2 + dir) * 8 + h]);
    int tj[3], tg_[3], tcol[3]; bool tv[3];
#pragma unroll
    for (int s = 0; s < 3; ++s) {
        const int task = tid + NT * s; tv[s] = task < CL * 20; tj[s] = task / 20; tg_[s] = task % 20;
        const int g = tg_[s];
        tcol[s] = g < 4 ? (h * 64 + half * 32 + 8 * g) : g < 12 ? (512 + grp * 64 + 8 * (g - 4)) : (640 + grp * 64 + 8 * (g - 12));
    }
    u32x4 rc[3]; float rdt = 0.f; int rrow = 0;
    auto load = [&](int c) {
#pragma unroll
        for (int s = 0; s < 3; ++s) {
            rc[s] = (u32x4){0u, 0u, 0u, 0u};
            if (tv[s]) { const int row = scan_row(c * CL + tj[s], b, dir, 0); rc[s] = *(const u32x4*)(XBC + (size_t)row * 768 + tcol[s]); }
        }
        if (tid < CL) { rrow = scan_row(c * CL + tid, b, dir, 0); rdt = GT[(size_t)rrow * 32 + dir * 8 + h]; }
    };
    auto store1 = [&](int c) {
        if (tid < CL) {
            LAS char* stg = lds + (c & 1) * SS_STG;
            float cum = rdt * aco;
#pragma unroll
            for (int o = 1; o < 64; o <<= 1) { const float t = __shfl_up(cum, o); if (lane >= o) cum += t; }
            ((LAS float*)(stg + SS_CUM))[tid] = cum; ((LAS float*)(stg + SS_DTV))[tid] = rdt; ((LAS int*)(stg + SS_ROWS))[tid] = rrow;
        }
    };
    auto store2 = [&](int c) {
        LAS char* stg = lds + (c & 1) * SS_STG;
        const LAS float* cum = (const LAS float*)(stg + SS_CUM);
        const float cumL = cum[CL - 1];
#pragma unroll
        for (int s = 0; s < 3; ++s) {
            if (tv[s]) {
                float f[8]; unpack8(rc[s], f);
                const int j = tj[s], g = tg_[s];
                if (g < 4) {
                    const float dt = ((const LAS float*)(stg + SS_DTV))[j];
#pragma unroll
                    for (int e = 0; e < 8; ++e) *(LAS bf16_t*)(stg + SS_XT + (8 * g + e) * LDTB + j * 2) = f2bf(f[e] * dt);
                } else if (g < 12) {
                    const int n0 = 8 * (g - 4);
                    *(LAS u32x4*)(stg + SS_BT + j * LDTB + n0 * 2) = rc[s];
                    const float sc = __expf(cumL - cum[j]);
#pragma unroll
                    for (int e = 0; e < 8; ++e) *(LAS bf16_t*)(stg + SS_BDT + (n0 + e) * LDTB + j * 2) = f2bf(f[e] * sc);
                } else {
                    *(LAS u32x4*)(stg + SS_CT + j * LDTB + 8 * (g - 12) * 2) = rc[s];
                }
            }
        }
    };
    for (int i = tid; i < 32 * LDTB / 4; i += NT) ((LAS unsigned*)(lds + SS_HB))[i] = 0u;
    f32x4 hacc = (f32x4){0.f, 0.f, 0.f, 0.f};
    load(0); store1(0); __syncthreads(); store2(0); __syncthreads();
    for (int c = 0; c < NCH64; ++c) {
        if (c + 1 < NCH64) load(c + 1);
        LAS char* stg = lds + (c & 1) * SS_STG;
        const LAS float* cum = (const LAS float*)(stg + SS_CUM);
        {
            const int lt = wid >> 1;
#pragma unroll
            for (int u = 0; u < 2; ++u) {
                const int st = (wid & 1) * 2 + u;
                f32x4 acc = (f32x4){0.f, 0.f, 0.f, 0.f};
                if (st <= lt) {
#pragma unroll
                    for (int k0 = 0; k0 < 64; k0 += 32) acc = __builtin_amdgcn_mfma_f32_16x16x32_bf16(ldfrag(stg + SS_BT, LDTB, st * 16, k0, lane), ldfrag(stg + SS_CT, LDTB, lt * 16, k0, lane), acc, 0, 0, 0);
                    const int l = lt * 16 + r16, s0 = st * 16 + 4 * q;
                    const float cl = cum[l]; const f32x4 cs = *(const LAS f32x4*)(cum + s0);
#pragma unroll
                    for (int j = 0; j < 4; ++j) acc[j] = (s0 + j <= l) ? acc[j] * __expf(cl - cs[j]) : 0.f;
                }
                st4bf(lds + SS_M + (lt * 16 + r16) * LDTB + (st * 16 + 4 * q) * 2, acc);
            }
        }
        __syncthreads();
        {
            const int lt = wid >> 1, pt = wid & 1;
            f32x4 ya = (f32x4){0.f, 0.f, 0.f, 0.f}, oa = (f32x4){0.f, 0.f, 0.f, 0.f};
#pragma unroll
            for (int k0 = 0; k0 < 64; k0 += 32) {
                ya = __builtin_amdgcn_mfma_f32_16x16x32_bf16(ldfrag(stg + SS_XT, LDTB, pt * 16, k0, lane), ldfrag(lds + SS_M, LDTB, lt * 16, k0, lane), ya, 0, 0, 0);
                oa = __builtin_amdgcn_mfma_f32_16x16x32_bf16(ldfrag(lds + SS_HB, LDTB, pt * 16, k0, lane), ldfrag(stg + SS_CT, LDTB, lt * 16, k0, lane), oa, 0, 0, 0);
            }
            const int l = lt * 16 + r16;
            const float el = __expf(cum[l]);
            const int row = ((const LAS int*)(stg + SS_ROWS))[l];
            u32x2 o; o.x = pk2(ya[0] + el * oa[0], ya[1] + el * oa[1]); o.y = pk2(ya[2] + el * oa[2], ya[3] + el * oa[3]);
            *(u32x2*)(Y + (size_t)row * D + h * 64 + half * 32 + pt * 16 + 4 * q) = o;
            const int ptile = wid >> 2, ntile = wid & 3;
            f32x4 sa = (f32x4){0.f, 0.f, 0.f, 0.f};
#pragma unroll
            for (int k0 = 0; k0 < 64; k0 += 32) sa = __builtin_amdgcn_mfma_f32_16x16x32_bf16(ldfrag(stg + SS_BDT, LDTB, ntile * 16, k0, lane), ldfrag(stg + SS_XT, LDTB, ptile * 16, k0, lane), sa, 0, 0, 0);
            const float dtot = __expf(cum[CL - 1]);
#pragma unroll
            for (int j = 0; j < 4; ++j) hacc[j] = hacc[j] * dtot + sa[j];
        }
        __syncthreads();
        st4bf(lds + SS_HB + ((wid >> 2) * 16 + r16) * LDTB + ((wid & 3) * 16 + 4 * q) * 2, hacc);
        if (c + 1 < NCH64) { store1(c + 1); __syncthreads(); store2(c + 1); }
        __syncthreads();
    }
}

constexpr int MS_QT = 0, MS_KT = MS_QT + 64 * LDTB, MS_KET = MS_KT + 64 * LDTB, MS_VT = MS_KET + 64 * LDTB, MS_SC = MS_VT + 32 * LDTB;
constexpr int MS_STG = MS_SC + 8 * 256;
constexpr int MS_W = 2 * MS_STG, MS_CB = MS_W + 64 * LDTB, MS_ONE = MS_CB + 32 * LDTB, MS_NV = MS_ONE + 16 * LDTB, MS_QN = MS_NV + 256, MS_END = MS_QN + 256;
static_assert(MS_END <= LDS_BYTES - 16, "mLSTM LDS map");
__device__ __forceinline__ void scan_mlstm_c(KP Pk, int layer, int unit, LAS char* lds) {
    asm volatile("" : "+s"(Pk));
    const CAS Params& P = *Pk;
    const int tid = ltid(), lane = tid & 63, wid = tid >> 6, q = lane >> 4, r16 = lane & 15;
    const int seq = unit >> 2, quarter = unit & 3, b = seq >> 3, h = (seq >> 1) & 3, dir = seq & 1;
    const bf16_t* QK = (const bf16_t*)(P.ws + WS_EQK);
    const bf16_t* Pb = (const bf16_t*)(P.ws + WS_P);
    const float* GT = (const float*)(P.ws + WS_EGT);
    bf16_t* Y = (bf16_t*)(P.ws + (dir ? WS_YB : WS_YF));
    int tj[3], tg_[3]; bool tv[3];
#pragma unroll
    for (int s = 0; s < 3; ++s) { const int task = tid + NT * s; tv[s] = task < CL * 20; tj[s] = task / 20; tg_[s] = task % 20; }
    u32x4 rc[3]; float rli = 0.f, rlf = 0.f; int rrow = 0;
    float mprev = -1e30f;
    auto load = [&](int c) {
#pragma unroll
        for (int s = 0; s < 3; ++s) {
            rc[s] = (u32x4){0u, 0u, 0u, 0u};
            if (tv[s]) {
                const int row = scan_row(c * CL + tj[s], b, dir, 0); const int g = tg_[s];
                rc[s] = g < 16 ? *(const u32x4*)(QK + (size_t)row * 512 + (g < 8 ? h * 64 + 8 * g : 256 + h * 64 + 8 * (g - 8)))
                               : *(const u32x4*)(Pb + (size_t)row * LDP_EVEN + 1808 + h * 128 + quarter * 32 + 8 * (g - 16));
            }
        }
        if (tid < CL) { rrow = scan_row(c * CL + tid, b, dir, 0); rli = GT[(size_t)rrow * 32 + 16 + dir * 4 + h]; rlf = GT[(size_t)rrow * 32 + 24 + dir * 4 + h]; }
    };
    auto store1 = [&](int c) {
        if (tid < CL) {
            LAS float* sc = (LAS float*)(lds + (c & 1) * MS_STG + MS_SC);
            float fcum = rlf;
#pragma unroll
            for (int o = 1; o < 64; o <<= 1) { const float t = __shfl_up(fcum, o); if (lane >= o) fcum += t; }
            const float ftot = __shfl(fcum, 63);
            const float g = rli - fcum;
            float pm = g;
#pragma unroll
            for (int o = 1; o < 64; o <<= 1) { const float t = __shfl_up(pm, o); if (lane >= o) pm = fmaxf(pm, t); }
            const float wend = ftot + g;
            float mloc = wend;
#pragma unroll
            for (int o = 1; o < 64; o <<= 1) mloc = fmaxf(mloc, __shfl_xor(mloc, o));
            const float eend = __expf(wend - mloc);
            const float linter = fcum + mprev;
            const float mrow = fmaxf(fcum + pm, linter);
            sc[0 * 64 + tid] = fcum - mrow; sc[1 * 64 + tid] = g; sc[2 * 64 + tid] = __expf(linter - mrow); sc[3 * 64 + tid] = __expf(-mrow); sc[4 * 64 + tid] = eend;
            ((LAS int*)sc)[5 * 64 + tid] = rrow;
            const float mnew = fmaxf(ftot + mprev, mloc);
            if (tid == 0) { sc[6 * 64 + 0] = __expf(ftot + mprev - mnew); sc[6 * 64 + 1] = __expf(mloc - mnew); }
            mprev = mnew;
        }
    };
    auto store2 = [&](int c) {
        LAS char* stg = lds + (c & 1) * MS_STG;
        const LAS float* sc = (const LAS float*)(stg + MS_SC);
#pragma unroll
        for (int s = 0; s < 3; ++s) {
            if (tv[s]) {
                float f[8]; unpack8(rc[s], f);
                const int j = tj[s], g = tg_[s];
                if (g < 8) { *(LAS u32x4*)(stg + MS_QT + j * LDTB + 8 * g * 2) = rc[s]; }
                else if (g < 16) {
                    const int k0 = 8 * (g - 8);
                    *(LAS u32x4*)(stg + MS_KT + j * LDTB + k0 * 2) = rc[s];
                    const float ee = sc[4 * 64 + j];
#pragma unroll
                    for (int e = 0; e < 8; ++e) *(LAS bf16_t*)(stg + MS_KET + (k0 + e) * LDTB + j * 2) = f2bf(f[e] * ee);
                } else {
                    const int v0 = 8 * (g - 16);
#pragma unroll
                    for (int e = 0; e < 8; ++e) { const unsigned wv = rc[s][e >> 1]; *(LAS bf16_t*)(stg + MS_VT + (v0 + e) * LDTB + j * 2) = (bf16_t)((e & 1) ? (wv >> 16) : (wv & 0xffffu)); }
                }
            }
        }
    };
    for (int i = tid; i < 32 * LDTB / 4; i += NT) ((LAS unsigned*)(lds + MS_CB))[i] = 0u;
    for (int i = tid; i < 16 * LDTB / 4; i += NT) ((LAS unsigned*)(lds + MS_ONE))[i] = 0x3f803f80u;
    if (tid < 64) ((LAS float*)(lds + MS_NV))[tid] = 0.f;
    f32x4 cacc = (f32x4){0.f, 0.f, 0.f, 0.f};
    load(0); store1(0); __syncthreads(); store2(0); __syncthreads();
    for (int c = 0; c < NCH64; ++c) {
        if (c + 1 < NCH64) load(c + 1);
        LAS char* stg = lds + (c & 1) * MS_STG;
        const LAS float* sc = (const LAS float*)(stg + MS_SC);
        LAS float* nv = (LAS float*)(lds + MS_NV);
        LAS float* qn = (LAS float*)(lds + MS_QN);
        {
            const int lt = wid >> 1;
#pragma unroll
            for (int u = 0; u < 2; ++u) {
                const int st = (wid & 1) * 2 + u;
                f32x4 acc = (f32x4){0.f, 0.f, 0.f, 0.f};
                if (st <= lt) {
#pragma unroll
                    for (int k0 = 0; k0 < 64; k0 += 32) acc = __builtin_amdgcn_mfma_f32_16x16x32_bf16(ldfrag(stg + MS_KT, LDTB, st * 16, k0, lane), ldfrag(stg + MS_QT, LDTB, lt * 16, k0, lane), acc, 0, 0, 0);
                    const int l = lt * 16 + r16, s0 = st * 16 + 4 * q;
                    const float rt = sc[l]; const f32x4 gs = *(const LAS f32x4*)(sc + 64 + s0);
#pragma unroll
                    for (int j = 0; j < 4; ++j) acc[j] = (s0 + j <= l) ? acc[j] * __expf(rt + gs[j]) : 0.f;
                }
                st4bf(lds + MS_W + (lt * 16 + r16) * LDTB + (st * 16 + 4 * q) * 2, acc);
            }
            if (wid == 0) {
                float a = 0.f;
#pragma unroll
                for (int k0 = 0; k0 < 64; k0 += 8) {
                    const u32x4 tq = *(const LAS u32x4*)(stg + MS_QT + lane * LDTB + k0 * 2); float f[8]; unpack8(tq, f);
#pragma unroll
                    for (int e = 0; e < 8; ++e) a += f[e] * nv[k0 + e];
                }
                qn[lane] = a;
            }
        }
        __syncthreads();
        {
            const int lt = wid >> 1, vt = wid & 1;
            f32x4 na = (f32x4){0.f, 0.f, 0.f, 0.f}, ca = (f32x4){0.f, 0.f, 0.f, 0.f}, da = (f32x4){0.f, 0.f, 0.f, 0.f};
#pragma unroll
            for (int k0 = 0; k0 < 64; k0 += 32) {
                const bf16x8 wf = ldfrag(lds + MS_W, LDTB, lt * 16, k0, lane);
                na = __builtin_amdgcn_mfma_f32_16x16x32_bf16(ldfrag(stg + MS_VT, LDTB, vt * 16, k0, lane), wf, na, 0, 0, 0);
                da = __builtin_amdgcn_mfma_f32_16x16x32_bf16(ldfrag(lds + MS_ONE, LDTB, 0, k0, lane), wf, da, 0, 0, 0);
                ca = __builtin_amdgcn_mfma_f32_16x16x32_bf16(ldfrag(lds + MS_CB, LDTB, vt * 16, k0, lane), ldfrag(stg + MS_QT, LDTB, lt * 16, k0, lane), ca, 0, 0, 0);
            }
            const int l = lt * 16 + r16;
            const float inter = sc[2 * 64 + l], emr = sc[3 * 64 + l];
            const float den = da[0] + inter * qn[l];
            const float inv = __builtin_amdgcn_rcpf(fmaxf(fabsf(den), emr));
            const int row = ((const LAS int*)sc)[5 * 64 + l];
            u32x2 o; o.x = pk2((na[0] + inter * ca[0]) * inv, (na[1] + inter * ca[1]) * inv); o.y = pk2((na[2] + inter * ca[2]) * inv, (na[3] + inter * ca[3]) * inv);
            *(u32x2*)(Y + (size_t)row * D + 512 + h * 128 + quarter * 32 + vt * 16 + 4 * q) = o;
            const int vtile = wid >> 2, ktile = wid & 3;
            f32x4 sa = (f32x4){0.f, 0.f, 0.f, 0.f};
#pragma unroll
            for (int k0 = 0; k0 < 64; k0 += 32) sa = __builtin_amdgcn_mfma_f32_16x16x32_bf16(ldfrag(stg + MS_KET, LDTB, ktile * 16, k0, lane), ldfrag(stg + MS_VT, LDTB, vtile * 16, k0, lane), sa, 0, 0, 0);
            const float sp = sc[6 * 64 + 0], sl = sc[6 * 64 + 1];
#pragma unroll
            for (int j = 0; j < 4; ++j) cacc[j] = cacc[j] * sp + sl * sa[j];
        }
        __syncthreads();
        st4bf(lds + MS_CB + ((wid >> 2) * 16 + r16) * LDTB + ((wid & 3) * 16 + 4 * q) * 2, cacc);
        if (wid == 1) {
            float a = 0.f;
            for (int s = 0; s < CL; ++s) a += sc[4 * 64 + s] * bf2f(*(const LAS bf16_t*)(stg + MS_KT + s * LDTB + lane * 2));
            nv[lane] = nv[lane] * sc[6 * 64 + 0] + sc[6 * 64 + 1] * a;
        }
        if (c + 1 < NCH64) { store1(c + 1); __syncthreads(); store2(c + 1); }
        __syncthreads();
    }
}

constexpr int HC_RAWF = 0;
constexpr int HC_RAWQ = HC_RAWF + 64 * 128 * 4;
constexpr int HC_SUB = HC_RAWQ + 64 * 128 * 2;
constexpr int HL_QD = 136 * 2;
constexpr int HL_T = 24 * 2;
constexpr int HS_QI = 0, HS_KO = HS_QI + 16 * HL_QD, HS_KET = HS_KO + 16 * HL_QD, HS_ATT = HS_KET + 128 * HL_T, HS_VT = HS_ATT + 16 * HL_T, HS_DEC = HS_VT + 32 * HL_T, HS_SIZE = HS_DEC + 512;
constexpr int HC_SB = HC_SUB + 4 * HS_SIZE;
constexpr int HC_ROWS = HC_SB + 2 * 32 * HL_QD, HC_CST = HC_ROWS + 256, HC_END = HC_CST + 1024;
static_assert(HC_END <= LDS_BYTES - 16, "HGRN2 LDS map");
static_assert(HS_SIZE % 16 == 0 && HC_SB % 16 == 0, "alignment");
__device__ __forceinline__ bf16x8 ldfrag16(const LAS char* tile, int ldb, int row0, int lane) {
    bf16x8 v = *(const LAS bf16x8*)(tile + (row0 + (lane & 15)) * ldb + ((lane >> 4) & 1) * 16);
    if (lane >= 32) v = (bf16x8){0, 0, 0, 0, 0, 0, 0, 0};
    return v;
}
__device__ __forceinline__ void scan_hgrn_c(KP Pk, int layer, int unit, LAS char* lds) {
    asm volatile("" : "+s"(Pk));
    const CAS Params& P = *Pk;
    const int tid = ltid(), lane = tid & 63, wid = tid >> 6, q = lane >> 4, r16 = lane & 15, i_ = layer >> 1;
    const int seq = unit >> 2, quarter = unit & 3, b = seq >> 3, h = (seq >> 1) & 3, dir = seq & 1;
    const bf16_t* Pb = (const bf16_t*)(P.ws + WS_P);
    bf16_t* Y = (bf16_t*)(P.ws + (dir ? WS_YB : WS_YF));
    LAS float* cst = (LAS float*)(lds + HC_CST);
    if (tid < 128) cst[tid] = ((const float*)(P.ws + WS_LB))[layer * 512 + h * 128 + tid];
    else if (tid < 256) cst[tid] = P.hg_f_bias[(size_t)(i_ * 2 + dir) * 512 + h * 128 + tid - 128];
    for (int i = tid; i < 2 * 32 * HL_QD / 4; i += NT) ((LAS unsigned*)(lds + HC_SB))[i] = 0u;
    int tj[5], tg_[5], tcol[5]; bool tv[5];
#pragma unroll
    for (int s = 0; s < 5; ++s) {
        const int task = tid + NT * s; tv[s] = task < 64 * 36; tj[s] = task / 36; tg_[s] = task % 36;
        const int g = tg_[s];
        tcol[s] = g < 16 ? (512 + dir * 512 + h * 128 + 8 * g) : g < 32 ? (h * 128 + 8 * (g - 16)) : (1536 + h * 128 + quarter * 32 + 8 * (g - 32));
    }
    u32x4 rc[5]; int rrow = 0;
    auto load = [&](int c) {
#pragma unroll
        for (int s = 0; s < 5; ++s) {
            rc[s] = (u32x4){0u, 0u, 0u, 0u};
            if (tv[s]) { const int row = scan_row(c * 64 + tj[s], b, dir, 1); rc[s] = *(const u32x4*)(Pb + (size_t)row * LDP_ODD + tcol[s]); }
        }
        if (tid < 64) rrow = scan_row(c * 64 + tid, b, dir, 1);
    };
    auto storeA = [&]() {
#pragma unroll
        for (int s = 0; s < 5; ++s) {
            if (tv[s]) {
                float f[8]; unpack8(rc[s], f);
                const int j = tj[s], g = tg_[s];
                if (g < 16) {
                    float o[8];
#pragma unroll
                    for (int e = 0; e < 8; ++e) { const float lbv = cst[8 * g + e]; o[e] = lbv + (1.f - lbv) * sigmoidf_(f[e] + cst[128 + 8 * g + e]); }
                    LAS float* dst = (LAS float*)(lds + HC_RAWF) + j * 128 + 8 * g;
                    *(LAS f32x4*)dst = (f32x4){o[0], o[1], o[2], o[3]}; *(LAS f32x4*)(dst + 4) = (f32x4){o[4], o[5], o[6], o[7]};
                } else if (g < 32) {
                    float o[8];
#pragma unroll
                    for (int e = 0; e < 8; ++e) o[e] = siluf_(f[e]);
                    *(LAS u32x4*)(lds + HC_RAWQ + (j * 128 + 8 * (g - 16)) * 2) = pack8(o);
                } else {
                    const int v0 = 8 * (g - 32);
                    LAS char* vt = lds + HC_SUB + (j >> 4) * HS_SIZE + HS_VT;
#pragma unroll
                    for (int e = 0; e < 8; ++e) { const unsigned wv = rc[s][e >> 1]; *(LAS bf16_t*)(vt + (v0 + e) * HL_T + (j & 15) * 2) = (bf16_t)((e & 1) ? (wv >> 16) : (wv & 0xffffu)); }
                }
            }
        }
        if (tid < 64) ((LAS int*)(lds + HC_ROWS))[tid] = rrow;
    };
    auto storeB = [&]() {
        const int d = tid & 127, sb = tid >> 7;
        LAS char* st = lds + HC_SUB + sb * HS_SIZE;
        const LAS float* rf = (const LAS float*)(lds + HC_RAWF) + (sb * 16) * 128 + d;
        const LAS bf16_t* rq = (const LAS bf16_t*)(lds + HC_RAWQ) + (sb * 16) * 128 + d;
        float lam = 0.f, lams[16], kfs[16];
#pragma unroll
        for (int t = 0; t < 16; ++t) {
            const float f = rf[t * 128];
            lam += __logf(f);
            const float kf = 1.f - f;
            lams[t] = lam; kfs[t] = kf;
            *(LAS bf16_t*)(st + HS_QI + t * HL_QD + d * 2) = f2bf(bf2f(rq[t * 128]) * __expf(lam));
            *(LAS bf16_t*)(st + HS_KO + t * HL_QD + d * 2) = f2bf(kf * __expf(-lam));
        }
        float ke[16];
#pragma unroll
        for (int t = 0; t < 16; ++t) ke[t] = kfs[t] * __expf(lam - lams[t]);
        *(LAS u32x4*)(st + HS_KET + d * HL_T) = pack8(ke); *(LAS u32x4*)(st + HS_KET + d * HL_T + 16) = pack8(ke + 8);
        ((LAS float*)(st + HS_DEC))[d] = __expf(lam);
    };
    f32x4 sacc[2];
    sacc[0] = sacc[1] = (f32x4){0.f, 0.f, 0.f, 0.f};
    __syncthreads();
    load(0);
    for (int c = 0; c < NSTEPS / 64; ++c) {
        storeA();
        __syncthreads();
        storeB();
        if (c + 1 < NSTEPS / 64) load(c + 1);
        __syncthreads();
        if (wid < 4) {
            LAS char* st = lds + HC_SUB + wid * HS_SIZE;
            f32x4 acc = (f32x4){0.f, 0.f, 0.f, 0.f};
#pragma unroll
            for (int k0 = 0; k0 < 128; k0 += 32) acc = __builtin_amdgcn_mfma_f32_16x16x32_bf16(ldfrag(st + HS_KO, HL_QD, 0, k0, lane), ldfrag(st + HS_QI, HL_QD, 0, k0, lane), acc, 0, 0, 0);
#pragma unroll
            for (int j = 0; j < 4; ++j) acc[j] = (4 * q + j <= r16) ? acc[j] : 0.f;
            st4bf(st + HS_ATT + r16 * HL_T + 4 * q * 2, acc);
        }
        __syncthreads();
#pragma unroll 1
        for (int sb = 0; sb < 4; ++sb) {
            LAS char* st = lds + HC_SUB + sb * HS_SIZE;
            const LAS char* sbr = lds + HC_SB + (sb & 1) * 32 * HL_QD;
            LAS char* sbw = lds + HC_SB + ((sb + 1) & 1) * 32 * HL_QD;
            if (wid < 2) {
                f32x4 ya = __builtin_amdgcn_mfma_f32_16x16x32_bf16(ldfrag16(st + HS_VT, HL_T, wid * 16, lane), ldfrag16(st + HS_ATT, HL_T, 0, lane), (f32x4){0.f, 0.f, 0.f, 0.f}, 0, 0, 0);
#pragma unroll
                for (int k0 = 0; k0 < 128; k0 += 32) ya = __builtin_amdgcn_mfma_f32_16x16x32_bf16(ldfrag(sbr, HL_QD, wid * 16, k0, lane), ldfrag(st + HS_QI, HL_QD, 0, k0, lane), ya, 0, 0, 0);
                const int row = ((const LAS int*)(lds + HC_ROWS))[sb * 16 + r16];
                u32x2 o; o.x = pk2(ya[0], ya[1]); o.y = pk2(ya[2], ya[3]);
                *(u32x2*)(Y + (size_t)row * D + h * 128 + quarter * 32 + wid * 16 + 4 * q) = o;
            }
            {
                const int vt = wid >> 2;
                const bf16x8 vf = ldfrag16(st + HS_VT, HL_T, vt * 16, lane);
#pragma unroll
                for (int u = 0; u < 2; ++u) {
                    const int dt = (wid & 3) * 2 + u;
                    const f32x4 a = __builtin_amdgcn_mfma_f32_16x16x32_bf16(ldfrag16(st + HS_KET, HL_T, dt * 16, lane), vf, (f32x4){0.f, 0.f, 0.f, 0.f}, 0, 0, 0);
                    const f32x4 dc = *(const LAS f32x4*)((const LAS float*)(st + HS_DEC) + dt * 16 + 4 * q);
#pragma unroll
                    for (int j = 0; j < 4; ++j) sacc[u][j] = sacc[u][j] * dc[j] + a[j];
                    st4bf(sbw + (vt * 16 + r16) * HL_QD + (dt * 16 + 4 * q) * 2, sacc[u]);
                }
            }
            __syncthreads();
        }
    }
}

constexpr int RC_RAWW = 0;
constexpr int RC_RAWA = RC_RAWW + 64 * 64 * 4;
constexpr int RC_RAWB = RC_RAWA + 64 * 64 * 2, RC_RAWK = RC_RAWB + 64 * 64 * 2, RC_RAWR = RC_RAWK + 64 * 64 * 2;
constexpr int RC_SUB = RC_RAWR + 64 * 64 * 2;
constexpr int RL_C = 72 * 2, RL_32 = 40 * 2, RL_16 = 24 * 2;
constexpr int RS_AT = 0, RS_RT = RS_AT + 16 * RL_C, RS_KT = RS_RT + 16 * RL_C, RS_BT = RS_KT + 16 * RL_C, RS_KBH = RS_BT + 16 * RL_C, RS_AAK = RS_KBH + 64 * RL_32,
              RS_ARKB = RS_AAK + 16 * RL_16, RS_T = RS_ARKB + 16 * RL_32, RS_AABF = RS_T + 16 * RL_16, RS_GL = RS_AABF + 16 * 16 * 4, RS_VU = RS_GL + 256, RS_SIZE = RS_VU + 32 * RL_32;
constexpr int RC_SB = RC_SUB + 4 * RS_SIZE;
constexpr int RC_RHT = RC_SB + 32 * RL_C;
constexpr int RC_ROWS = RC_RHT + 32 * RL_16, RC_END = RC_ROWS + 256;
static_assert(RC_END <= LDS_BYTES - 16, "RWKV LDS map");
static_assert(RS_SIZE % 16 == 0 && RC_SB % 16 == 0 && RC_RHT % 16 == 0, "alignment");
__device__ __forceinline__ void scan_rwkv_c(KP Pk, int layer, int unit, LAS char* lds) {
    asm volatile("" : "+s"(Pk));
    const CAS Params& P = *Pk;
    const int tid = ltid(), lane = tid & 63, wid = tid >> 6, q = lane >> 4, r16 = lane & 15;
    const int seq = unit >> 1, half = unit & 1, b = seq >> 4, h = (seq >> 1) & 7, dir = seq & 1;
    bf16_t* Y = (bf16_t*)(P.ws + (dir ? WS_YB : WS_YF));
    const float* dec = (const float*)(P.ws + WS_RWDEC) + (size_t)dir * NROWS * 512;
    for (int i = tid; i < 32 * RL_C / 4; i += NT) ((LAS unsigned*)(lds + RC_SB))[i] = 0u;
    const unsigned char* const wsb = P.ws;
    u32x4 rc[7]; int rrow = 0;
    auto load = [&](int c) {
        int tl = tid; asm volatile("" : "+v"(tl));
#pragma unroll
        for (int s = 0; s < 7; ++s) {
            const int task = tl + NT * s, j = task / 52, g = task - 52 * j;
            rc[s] = (u32x4){0u, 0u, 0u, 0u};
            if (task < 64 * 52) {
                const int row = scan_row(c * 64 + j, b, dir, 1);
                const unsigned char* p;
                if (g < 8)       p = wsb + WS_RWR  + ((size_t)row * 512 + h * 64 + 8 * g) * 2;
                else if (g < 16) p = wsb + WS_RWK  + ((size_t)row * 512 + h * 64 + 8 * (g - 8)) * 2;
                else if (g < 24) p = wsb + WS_RWKK + ((size_t)row * 512 + h * 64 + 8 * (g - 16)) * 2;
                else if (g < 32) p = wsb + WS_RWB  + ((size_t)row * 512 + h * 64 + 8 * (g - 24)) * 2;
                else if (g < 36) p = wsb + WS_RWV  + ((size_t)row * 512 + h * 64 + half * 32 + 8 * (g - 32)) * 2;
                else             p = (const unsigned char*)(dec + (size_t)row * 512 + h * 64 + 4 * (g - 36));
                rc[s] = *(const u32x4*)p;
            }
        }
        if (tid < 64) rrow = scan_row(c * 64 + tid, b, dir, 1);
    };
    auto storeA = [&]() {
        int tl = tid; asm volatile("" : "+v"(tl));
#pragma unroll
        for (int s = 0; s < 7; ++s) {
            const int task = tl + NT * s, j = task / 52, g = task - 52 * j;
            if (task < 64 * 52) {
                if (g < 8)       *(LAS u32x4*)(lds + RC_RAWR + (j * 64 + 8 * g) * 2) = rc[s];
                else if (g < 16) *(LAS u32x4*)(lds + RC_RAWK + (j * 64 + 8 * (g - 8)) * 2) = rc[s];
                else if (g < 24) *(LAS u32x4*)(lds + RC_RAWA + (j * 64 + 8 * (g - 16)) * 2) = rc[s];
                else if (g < 32) *(LAS u32x4*)(lds + RC_RAWB + (j * 64 + 8 * (g - 24)) * 2) = rc[s];
                else if (g < 36) {
                    LAS char* vu = lds + RC_SUB + (j >> 4) * RS_SIZE + RS_VU;
                    const int v0 = 8 * (g - 32);
#pragma unroll
                    for (int e = 0; e < 8; ++e) { const unsigned wv = rc[s][e >> 1]; *(LAS bf16_t*)(vu + (v0 + e) * RL_32 + (j & 15) * 2) = (bf16_t)((e & 1) ? (wv >> 16) : (wv & 0xffffu)); }
                } else *(LAS u32x4*)(lds + RC_RAWW + (j * 64 + 4 * (g - 36)) * 4) = rc[s];
            }
        }
        if (tid < 64) ((LAS int*)(lds + RC_ROWS))[tid] = rrow;
    };
    auto storeB = [&]() {
        const int c = tid & 63, sb = (tid >> 6) & 3, role = tid >> 8;
        LAS char* st = lds + RC_SUB + sb * RS_SIZE;
        const LAS float* rw = (const LAS float*)(lds + RC_RAWW) + (sb * 16) * 64 + c;
        float g = 1.f;
        if (role == 0) {
            const LAS bf16_t* ra = (const LAS bf16_t*)(lds + RC_RAWA) + (sb * 16) * 64 + c;
            const LAS bf16_t* rr = (const LAS bf16_t*)(lds + RC_RAWR) + (sb * 16) * 64 + c;
#pragma unroll
            for (int t = 0; t < 16; ++t) {
                const float gp = g; g *= rw[t * 64];
                *(LAS bf16_t*)(st + RS_AT + t * RL_C + c * 2) = f2bf(-bf2f(ra[t * 64]) * gp);
                *(LAS bf16_t*)(st + RS_RT + t * RL_C + c * 2) = f2bf(bf2f(rr[t * 64]) * g);
            }
        } else {
            const LAS bf16_t* rk = (const LAS bf16_t*)(lds + RC_RAWK) + (sb * 16) * 64 + c;
            const LAS bf16_t* rb = (const LAS bf16_t*)(lds + RC_RAWB) + (sb * 16) * 64 + c;
            float ks[16], bs[16];
#pragma unroll
            for (int t = 0; t < 16; ++t) {
                g *= rw[t * 64];
                const float inv = 1.f / g;
                ks[t] = bf2f(rk[t * 64]) * inv; bs[t] = bf2f(rb[t * 64]) * inv;
                *(LAS bf16_t*)(st + RS_KT + t * RL_C + c * 2) = f2bf(ks[t]);
                *(LAS bf16_t*)(st + RS_BT + t * RL_C + c * 2) = f2bf(bs[t]);
            }
#pragma unroll
            for (int t = 0; t < 16; ++t) { ks[t] *= g; bs[t] *= g; }
            LAS char* row = st + RS_KBH + c * RL_32;
            *(LAS u32x4*)row = pack8(ks); *(LAS u32x4*)(row + 16) = pack8(ks + 8); *(LAS u32x4*)(row + 32) = pack8(bs); *(LAS u32x4*)(row + 48) = pack8(bs + 8);
            ((LAS float*)(st + RS_GL))[c] = g;
        }
    };
    f32x4 sacc[4];
#pragma unroll
    for (int i = 0; i < 4; ++i) sacc[i] = (f32x4){0.f, 0.f, 0.f, 0.f};
    __syncthreads();
    load(0);
    for (int c = 0; c < NSTEPS / 64; ++c) {
        storeA();
        __syncthreads();
        storeB();
        if (c + 1 < NSTEPS / 64) load(c + 1);
        __syncthreads();
#pragma unroll
        for (int u = 0; u < 2; ++u) {
            const int task = wid + 8 * u, m = task & 3, sb = task >> 2;
            LAS char* st = lds + RC_SUB + sb * RS_SIZE;
            const LAS char* ta = st + ((m == 0 || m == 3) ? RS_BT : RS_KT);
            const LAS char* tb = st + (m < 2 ? RS_AT : RS_RT);
            f32x4 acc = (f32x4){0.f, 0.f, 0.f, 0.f};
#pragma unroll
            for (int k0 = 0; k0 < 64; k0 += 32) acc = __builtin_amdgcn_mfma_f32_16x16x32_bf16(ldfrag(ta, RL_C, 0, k0, lane), ldfrag(tb, RL_C, 0, k0, lane), acc, 0, 0, 0);
#pragma unroll
            for (int j = 0; j < 4; ++j) { const int s = 4 * q + j; acc[j] = (m < 2 ? (s < r16) : (s <= r16)) ? acc[j] : 0.f; }
            if (m == 0) *(LAS f32x4*)((LAS float*)(st + RS_AABF) + r16 * 16 + 4 * q) = acc;
            else if (m == 1) st4bf(st + RS_AAK + r16 * RL_16 + 4 * q * 2, acc);
            else if (m == 2) st4bf(st + RS_ARKB + r16 * RL_32 + 4 * q * 2, acc);
            else st4bf(st + RS_ARKB + r16 * RL_32 + (16 + 4 * q) * 2, acc);
        }
        __syncthreads();
        if (wid < 4) {
            LAS char* st = lds + RC_SUB + wid * RS_SIZE;
            const LAS float* A = (const LAS float*)(st + RS_AABF);
            const int j = lane & 15;
            float tc[16];
#pragma unroll
            for (int t = 0; t < 16; ++t) {
                float val = (t == j) ? 1.f : 0.f;
                const f32x4 a0 = *(const LAS f32x4*)(A + t * 16), a1 = *(const LAS f32x4*)(A + t * 16 + 4), a2 = *(const LAS f32x4*)(A + t * 16 + 8), a3 = *(const LAS f32x4*)(A + t * 16 + 12);
                const float ar[16] = {a0[0], a0[1], a0[2], a0[3], a1[0], a1[1], a1[2], a1[3], a2[0], a2[1], a2[2], a2[3], a3[0], a3[1], a3[2], a3[3]};
#pragma unroll
                for (int s = 0; s < 16; ++s) if (s < t) val += ar[s] * tc[s];
                tc[t] = val;
            }
            if (lane < 16) {
#pragma unroll
                for (int t = 0; t < 16; ++t) *(LAS bf16_t*)(st + RS_T + t * RL_16 + j * 2) = f2bf(tc[t]);
            }
        }
        __syncthreads();
        if (wid < 2) {
            LAS char* sbt = lds + RC_SB + wid * 16 * RL_C;
            LAS char* rht = lds + RC_RHT + wid * 16 * RL_16;
#pragma unroll 1
            for (int sb = 0; sb < 4; ++sb) {
                LAS char* st = lds + RC_SUB + sb * RS_SIZE;
                LAS char* vu = st + RS_VU + wid * 16 * RL_32;
                f32x4 acc = __builtin_amdgcn_mfma_f32_16x16x32_bf16(ldfrag16(st + RS_AAK, RL_16, 0, lane), ldfrag16(vu, RL_32, 0, lane), (f32x4){0.f, 0.f, 0.f, 0.f}, 0, 0, 0);
#pragma unroll
                for (int k0 = 0; k0 < 64; k0 += 32) acc = __builtin_amdgcn_mfma_f32_16x16x32_bf16(ldfrag(st + RS_AT, RL_C, 0, k0, lane), ldfrag(sbt, RL_C, 0, k0, lane), acc, 0, 0, 0);
                st4bf(rht + r16 * RL_16 + 4 * q * 2, acc);
                asm volatile("s_waitcnt lgkmcnt(0)" ::: "memory");
                acc = __builtin_amdgcn_mfma_f32_16x16x32_bf16(ldfrag16(st + RS_T, RL_16, 0, lane), ldfrag16(rht, RL_16, 0, lane), (f32x4){0.f, 0.f, 0.f, 0.f}, 0, 0, 0);
                st4bf(vu + r16 * RL_32 + (16 + 4 * q) * 2, acc);
                asm volatile("s_waitcnt lgkmcnt(0)" ::: "memory");
                const bf16x8 vuf = ldfrag(vu, RL_32, 0, 0, lane);
                f32x4 ya = __builtin_amdgcn_mfma_f32_16x16x32_bf16(vuf, ldfrag(st + RS_ARKB, RL_32, 0, 0, lane), (f32x4){0.f, 0.f, 0.f, 0.f}, 0, 0, 0);
#pragma unroll
                for (int k0 = 0; k0 < 64; k0 += 32) ya = __builtin_amdgcn_mfma_f32_16x16x32_bf16(ldfrag(sbt, RL_C, 0, k0, lane), ldfrag(st + RS_RT, RL_C, 0, k0, lane), ya, 0, 0, 0);
                {
                    const int row = ((const LAS int*)(lds + RC_ROWS))[sb * 16 + r16];
                    u32x2 o; o.x = pk2(ya[0], ya[1]); o.y = pk2(ya[2], ya[3]);
                    *(u32x2*)(Y + (size_t)row * D + 512 + h * 64 + half * 32 + wid * 16 + 4 * q) = o;
                }
                asm volatile("s_waitcnt lgkmcnt(0)" ::: "memory");
#pragma unroll
                for (int kt = 0; kt < 4; ++kt) {
                    const f32x4 a = __builtin_amdgcn_mfma_f32_16x16x32_bf16(ldfrag(st + RS_KBH, RL_32, kt * 16, 0, lane), vuf, (f32x4){0.f, 0.f, 0.f, 0.f}, 0, 0, 0);
                    const f32x4 gl = *(const LAS f32x4*)((const LAS float*)(st + RS_GL) + kt * 16 + 4 * q);
#pragma unroll
                    for (int j = 0; j < 4; ++j) sacc[kt][j] = sacc[kt][j] * gl[j] + a[j];
                    st4bf(sbt + r16 * RL_C + (kt * 16 + 4 * q) * 2, sacc[kt]);
                }
                asm volatile("s_waitcnt lgkmcnt(0)" ::: "memory");
            }
        }
        __syncthreads();
    }
}

__device__ __forceinline__ void phase_prep1(KP Pk, int layer) {
    asm volatile("" : "+s"(Pk));
    const CAS Params& P = *Pk;
    const int tid = ltid(), lane = tid & 63, wid = tid >> 6, i_ = layer >> 1;
    const bf16_t* Pb = (const bf16_t*)(P.ws + WS_P);
    bf16_t* R = (bf16_t*)(P.ws + WS_RWR); bf16_t* K = (bf16_t*)(P.ws + WS_RWK); bf16_t* V = (bf16_t*)(P.ws + WS_RWV); bf16_t* KK = (bf16_t*)(P.ws + WS_RWKK);
    bf16_t* LA = (bf16_t*)(P.ws + WS_LA);
    const float* mu = P.rw_mu + (size_t)i_ * 1856;
    for (int r = blockIdx.x * 8 + wid; r < NROWS; r += gridDim.x * 8) {
        int rprev = -1, rnext = -1;
        if (r < NCTX) { const int t = r & 255; if (t > 0) rprev = r - 1; if (t < CTXL - 1) rnext = r + 1; }
        else {
            const int bs = (r - NCTX) >> 13, s = (r - NCTX) & 8191, sg = ((s & 63) << 7) + (s >> 6);
            if (sg > 0) { const int g2 = sg - 1; rprev = NCTX + bs * SEQ + ((g2 & 127) << 6) + (g2 >> 7); }
            if (sg < SEQ - 1) { const int g2 = sg + 1; rnext = NCTX + bs * SEQ + ((g2 & 127) << 6) + (g2 >> 7); }
        }
        const bf16_t* pc = Pb + (size_t)r * LDP_ODD + 2560;
        const bf16_t* pp = Pb + (size_t)(rprev < 0 ? r : rprev) * LDP_ODD + 2560;
        const bf16_t* pn = Pb + (size_t)(rnext < 0 ? r : rnext) * LDP_ODD + 2560;
        const float mp = rprev < 0 ? 0.f : 0.5f, mn = rnext < 0 ? 0.f : 0.5f;
        auto mix8 = [&](int col, float* o) {
            float fc[8], fp[8], fn[8];
            unpack8(*(const u32x4*)(pc + col), fc); unpack8(*(const u32x4*)(pp + col), fp); unpack8(*(const u32x4*)(pn + col), fn);
#pragma unroll
            for (int e = 0; e < 8; ++e) o[e] = fc[e] + mu[col + e] * (mp * fp[e] + mn * fn[e] - fc[e]);
        };
        float o[8];
        mix8(8 * lane, o); *(u32x4*)(R + (size_t)r * 512 + 8 * lane) = pack8(o);
        mix8(1024 + 8 * lane, o); *(u32x4*)(V + (size_t)r * 512 + 8 * lane) = pack8(o);
        mix8(512 + 8 * lane, o); *(u32x4*)(K + (size_t)r * 512 + 8 * lane) = pack8(o);
        {
            float kk[8], ss = 0.f;
#pragma unroll
            for (int e = 0; e < 8; ++e) { kk[e] = o[e] * P.rw_k_k[i_ * 512 + 8 * lane + e]; ss += kk[e] * kk[e]; }
            ss = group_sum<8>(ss);
            const float rn = rsqrtf(fmaxf(ss, 1e-12f));
#pragma unroll
            for (int e = 0; e < 8; ++e) kk[e] *= rn;
            *(u32x4*)(KK + (size_t)r * 512 + 8 * lane) = pack8(kk);
        }
        if (lane < 40) {
            mix8(1536 + 8 * lane, o);
            if (lane < 16) {
#pragma unroll
                for (int e = 0; e < 8; ++e) o[e] = tanh_fast(o[e]);
            } else if (lane >= 24) {
#pragma unroll
                for (int e = 0; e < 8; ++e) o[e] = sigmoidf_(o[e]);
            }
            *(u32x4*)(LA + (size_t)r * 320 + 8 * lane) = pack8(o);
        }
    }
}

__device__ __forceinline__ void phase_out_even(KP Pk, int layer) {
    asm volatile("" : "+s"(Pk));
    const CAS Params& P = *Pk;
    const int tid = ltid(), lane = tid & 63, wid = tid >> 6, i_ = layer >> 1;
    const bf16_t* Pb = (const bf16_t*)(P.ws + WS_P);
    const bf16_t* Yf = (const bf16_t*)(P.ws + WS_YF); const bf16_t* Yb = (const bf16_t*)(P.ws + WS_YB);
    bf16_t* feat = (bf16_t*)(P.ws + WS_FEAT);
    const int r0 = (layer == DEPTH - 1) ? NCTX : 0;
    const bf16_t* XBC = (const bf16_t*)(P.ws + WS_EXBC);
    float nwa[8], nwb[8];
#pragma unroll
    for (int e = 0; e < 8; ++e) { nwa[e] = P.ssd_norm_w[i_ * 512 + 8 * lane + e]; nwb[e] = P.ml_norm_w[i_ * 512 + 8 * lane + e]; }
    const float dsk = P.ssd_d[i_ * 8 + (lane >> 3)];
    for (int r = r0 + blockIdx.x * 8 + wid; r < NROWS; r += gridDim.x * 8) {
        const bf16_t* pr = Pb + (size_t)r * LDP_EVEN;
        float y[8];
        {
            float a[8], bb[8], xsv[8], z[8];
            unpack8(*(const u32x4*)(Yf + (size_t)r * D + 8 * lane), a); unpack8(*(const u32x4*)(Yb + (size_t)r * D + 8 * lane), bb);
            unpack8(*(const u32x4*)(XBC + (size_t)r * 768 + 8 * lane), xsv); unpack8(*(const u32x4*)(pr + 8 * lane), z);
            float ss = 0.f;
#pragma unroll
            for (int e = 0; e < 8; ++e) {
                y[e] = (a[e] + bb[e] + dsk * xsv[e]) * siluf_(z[e]); ss += y[e] * y[e];
            }
            ss = wave_sum(ss);
            const float rn = rsqrtf(ss * (1.f / 512.f) + 1e-6f);
#pragma unroll
            for (int e = 0; e < 8; ++e) y[e] = y[e] * rn * nwa[e];
            *(u32x4*)(feat + (size_t)r * D + 8 * lane) = pack8(y);
        }
        {
            float a[8], bb[8], o[8];
            unpack8(*(const u32x4*)(Yf + (size_t)r * D + 512 + 8 * lane), a); unpack8(*(const u32x4*)(Yb + (size_t)r * D + 512 + 8 * lane), bb);
            unpack8(*(const u32x4*)(pr + 2320 + 8 * lane), o);
            float s = 0.f;
#pragma unroll
            for (int e = 0; e < 8; ++e) { y[e] = a[e] + bb[e]; s += y[e]; }
            const float mean = group_sum<16>(s) * (1.f / 128.f);
            float ss = 0.f;
#pragma unroll
            for (int e = 0; e < 8; ++e) { y[e] -= mean; ss += y[e] * y[e]; }
            const float rn = rsqrtf(group_sum<16>(ss) * (1.f / 128.f) + 1e-6f);
#pragma unroll
            for (int e = 0; e < 8; ++e) y[e] = sigmoidf_(o[e]) * (y[e] * rn) * nwb[e];
            *(u32x4*)(feat + (size_t)r * D + 512 + 8 * lane) = pack8(y);
        }
    }
}
__device__ __forceinline__ void phase_out_odd(KP Pk, int layer) {
    asm volatile("" : "+s"(Pk));
    const CAS Params& P = *Pk;
    const int tid = ltid(), lane = tid & 63, wid = tid >> 6, i_ = layer >> 1;
    const bf16_t* Pb = (const bf16_t*)(P.ws + WS_P);
    const bf16_t* Yf = (const bf16_t*)(P.ws + WS_YF); const bf16_t* Yb = (const bf16_t*)(P.ws + WS_YB);
    const bf16_t* R = (const bf16_t*)(P.ws + WS_RWR); const bf16_t* K = (const bf16_t*)(P.ws + WS_RWK); const bf16_t* V = (const bf16_t*)(P.ws + WS_RWV); const bf16_t* G = (const bf16_t*)(P.ws + WS_RWG);
    bf16_t* feat = (bf16_t*)(P.ws + WS_FEAT);
    const int r0 = (layer == DEPTH - 1) ? NCTX : 0;
    float nwc[8], rk[8], lw[8], lbv[8];
#pragma unroll
    for (int e = 0; e < 8; ++e) {
        nwc[e] = P.hg_norm_w[i_ * 512 + 8 * lane + e]; rk[e] = P.rw_r_k[i_ * 512 + 8 * lane + e];
        lw[e] = P.rw_ln_w[i_ * 512 + 8 * lane + e]; lbv[e] = P.rw_ln_b[i_ * 512 + 8 * lane + e];
    }
    for (int r = r0 + blockIdx.x * 8 + wid; r < NROWS; r += gridDim.x * 8) {
        float y[8];
        {
            float a[8], bb[8], g[8];
            unpack8(*(const u32x4*)(Yf + (size_t)r * D + 8 * lane), a); unpack8(*(const u32x4*)(Yb + (size_t)r * D + 8 * lane), bb);
            unpack8(*(const u32x4*)(Pb + (size_t)r * LDP_ODD + 2048 + 8 * lane), g);
            float ss = 0.f;
#pragma unroll
            for (int e = 0; e < 8; ++e) { y[e] = a[e] + bb[e]; ss += y[e] * y[e]; }
            const float rn = rsqrtf(group_sum<16>(ss) * (1.f / 128.f) + 1e-6f);
#pragma unroll
            for (int e = 0; e < 8; ++e) y[e] = y[e] * rn * nwc[e] * siluf_(g[e]);
            *(u32x4*)(feat + (size_t)r * D + 8 * lane) = pack8(y);
        }
        {
            float a[8], bb[8], rr[8], kk[8], vv[8], g[8];
            unpack8(*(const u32x4*)(Yf + (size_t)r * D + 512 + 8 * lane), a); unpack8(*(const u32x4*)(Yb + (size_t)r * D + 512 + 8 * lane), bb);
            unpack8(*(const u32x4*)(R + (size_t)r * 512 + 8 * lane), rr); unpack8(*(const u32x4*)(K + (size_t)r * 512 + 8 * lane), kk);
            unpack8(*(const u32x4*)(V + (size_t)r * 512 + 8 * lane), vv); unpack8(*(const u32x4*)(G + (size_t)r * 512 + 8 * lane), g);
            float s = 0.f, bs = 0.f;
#pragma unroll
            for (int e = 0; e < 8; ++e) { y[e] = a[e] + bb[e]; s += y[e]; bs += rr[e] * kk[e] * rk[e]; }
            const float mean = group_sum<8>(s) * (1.f / 64.f); bs = group_sum<8>(bs);
            float ss = 0.f;
#pragma unroll
            for (int e = 0; e < 8; ++e) { y[e] -= mean; ss += y[e] * y[e]; }
            const float rn = rsqrtf(group_sum<8>(ss) * (1.f / 64.f) + 64e-5f);
#pragma unroll
            for (int e = 0; e < 8; ++e) y[e] = (y[e] * rn * lw[e] + lbv[e] + bs * vv[e]) * g[e];
            *(u32x4*)(feat + (size_t)r * D + 512 + 8 * lane) = pack8(y);
        }
    }
}

#ifndef MK_DOUBLE
#define MK_DOUBLE 0
#endif
#define REP(bit, body) do { body; if (MK_DOUBLE & (bit)) { body; } } while (0)
__device__ __forceinline__ void phase_expconv(KP Pk, int layer, LAS char* lds) {
    asm volatile("" : "+s"(Pk));
    const CAS Params& P = *Pk;
    const int tid = ltid(), lane = tid & 63, wid = tid >> 6;
    {
        LAS float* scr = (LAS float*)(lds + wid * 8448);
        const int gw = blockIdx.x * 8 + wid, NGW = gridDim.x * 8;
        bf16_t* gu = (bf16_t*)(P.ws + WS_EXPGU); bf16_t* dw = (bf16_t*)(P.ws + WS_EXPD);
        constexpr int IG = 16 * 16, IDN = 8 * 32;
        for (int it = gw; it < NEXP * (2 * IG + IDN); it += NGW) {
            const int e = it / (2 * IG + IDN); int r = it % (2 * IG + IDN);
            const size_t eo = (size_t)(layer * NEXP + e);
            if (r < IG) { transpose_item(P.exp_w_gate + eo * D * DEXP, D, DEXP, gu + (size_t)e * 1024 * 1024, 1, scr, r, lane); continue; } r -= IG;
            if (r < IG) { transpose_item(P.exp_w_up + eo * D * DEXP, D, DEXP, gu + (size_t)e * 1024 * 1024, 2, scr, r, lane); continue; } r -= IG;
            transpose_item(P.exp_w_down + eo * DEXP * D, DEXP, D, dw + (size_t)e * 1024 * 512, 0, scr, r, lane);
        }
    }
}
__device__ __forceinline__ void phase_ln1(KP Pk, int layer, LAS char* lds) {
    asm volatile("" : "+s"(Pk));
    const CAS Params& P = *Pk;
    const int tid = ltid(), lane = tid & 63, wid = tid >> 6;
    REP(8, phase_expconv(Pk, layer, lds));
    __syncthreads();
    LAS float* rwT = (LAS float*)lds;
    LAS float* scs = (LAS float*)(lds + 32 * 1024 * 4) + wid * 32;
    LAS int* lcnt = (LAS int*)(lds + 32 * 1024 * 4 + 1024);
    LAS int* lbase = lcnt + 32;
    LAS int* asg = lcnt + 64;
    if (tid < 32) lcnt[tid] = 0;
    for (int i = tid; i < D * NEXP; i += NT) { const int col = i >> 5, e = i & 31; rwT[e * 1024 + col] = P.router_w[i]; }
    __syncthreads();
    const bf16_t* yo = (const bf16_t*)(P.ws + WS_YO);
    bf16_t* act = (bf16_t*)(P.ws + WS_ACT);
    float* xc = (float*)(P.ws + WS_XC);
    int* cnt = (int*)(P.ws + WS_CNT) + layer * 32 * CNT_STRIDE;
    int* list = (int*)(P.ws + WS_LIST);
    float* wts = (float*)(P.ws + WS_WTS);
    const float* lg = P.ln_g + (size_t)(layer * 2 + 0) * D; const float* lb = P.ln_b + (size_t)(layer * 2 + 0) * D;
    const int r0 = (layer == DEPTH - 1) ? NCTX : 0;
    for (int r = r0 + blockIdx.x * 8 + wid; r < NROWS; r += gridDim.x * 8) {
        const int m = row_mod(r);
        float* xr = r < NCTX ? xc + (size_t)r * D : P.out + (size_t)(r - NCTX) * D;
        const float* g1 = modvec(P.ws, layer, m, 2); const float* sh2 = modvec(P.ws, layer, m, 3); const float* sc2 = modvec(P.ws, layer, m, 4);
        f32x4 v[4]; float s = 0.f;
#pragma unroll
        for (int i = 0; i < 4; ++i) {
            const int c = 4 * lane + 256 * i;
            const f32x4 xv = *(const f32x4*)(xr + c), gv = *(const f32x4*)(g1 + c);
            const u32x2 yv = *(const u32x2*)(yo + (size_t)r * D + c);
            v[i][0] = ALPHA * xv[0] + gv[0] * bflo(yv.x); v[i][1] = ALPHA * xv[1] + gv[1] * bfhi(yv.x);
            v[i][2] = ALPHA * xv[2] + gv[2] * bflo(yv.y); v[i][3] = ALPHA * xv[3] + gv[3] * bfhi(yv.y);
            s += (v[i][0] + v[i][1]) + (v[i][2] + v[i][3]);
        }
        const float mean = wave_sum(s) * (1.f / D);
        float s2 = 0.f;
#pragma unroll
        for (int i = 0; i < 4; ++i) { v[i] = v[i] - mean; s2 += (v[i][0] * v[i][0] + v[i][1] * v[i][1]) + (v[i][2] * v[i][2] + v[i][3] * v[i][3]); }
        const float rstd = rsqrtf(wave_sum(s2) * (1.f / D) + 1e-5f);
        float acc[32];
#pragma unroll
        for (int e = 0; e < 32; ++e) acc[e] = 0.f;
#pragma unroll
        for (int i = 0; i < 4; ++i) {
            const int c = 4 * lane + 256 * i;
            const f32x4 gg = *(const f32x4*)(lg + c), bb = *(const f32x4*)(lb + c), s2v = *(const f32x4*)(sc2 + c), h2v = *(const f32x4*)(sh2 + c);
            f32x4 xn, hv;
#pragma unroll
            for (int j = 0; j < 4; ++j) { xn[j] = v[i][j] * rstd * gg[j] + bb[j]; hv[j] = xn[j] * (1.f + s2v[j]) + h2v[j]; }
            *(f32x4*)(xr + c) = xn;
            u32x2 o; o.x = pk2(hv[0], hv[1]); o.y = pk2(hv[2], hv[3]); *(u32x2*)(act + (size_t)r * D + c) = o;
#pragma unroll
            for (int e = 0; e < 32; ++e) { const f32x4 w = *(const LAS f32x4*)(rwT + e * 1024 + c); acc[e] += (hv[0] * w[0] + hv[1] * w[1]) + (hv[2] * w[2] + hv[3] * w[3]); }
        }
#pragma unroll
        for (int st = 0; st < 5; ++st) {
            const int half = 16 >> st, msk = 32 >> st;
            const bool up = (lane & msk) != 0;
#pragma unroll
            for (int j = 0; j < 16; ++j) {
                if (j < half) {
                    const float keep = up ? acc[j + half] : acc[j], send = up ? acc[j] : acc[j + half];
                    acc[j] = keep + __shfl_xor(send, msk);
                }
            }
        }
        acc[0] += __shfl_xor(acc[0], 1);
        {
            const int e = (lane >> 1) & 31;
            const int eidx = ((e >> 4) & 1) * 16 + ((e >> 3) & 1) * 8 + ((e >> 2) & 1) * 4 + ((e >> 1) & 1) * 2 + (e & 1);
            if ((lane & 1) == 0) scs[eidx] = acc[0];
        }
        asm volatile("s_waitcnt lgkmcnt(0)" ::: "memory");
        float best = -1e30f; int bg = 0;
#pragma unroll
        for (int g = 0; g < 8; ++g) {
            float m1 = -1e30f, m2 = -1e30f;
#pragma unroll
            for (int k = 0; k < 4; ++k) { const float vsc = sigmoidf_(scs[g * 4 + k]) + P.router_bias[g * 4 + k]; if (vsc > m1) { m2 = m1; m1 = vsc; } else if (vsc > m2) m2 = vsc; }
            const float gs = m1 + m2;
            if (gs > best) { best = gs; bg = g; }
        }
        float sv[4], bv[4];
#pragma unroll
        for (int k = 0; k < 4; ++k) { sv[k] = sigmoidf_(scs[bg * 4 + k]); bv[k] = sv[k] + P.router_bias[bg * 4 + k]; }
        int i1 = 0; float b1 = bv[0];
#pragma unroll
        for (int k = 1; k < 4; ++k) if (bv[k] > b1) { b1 = bv[k]; i1 = k; }
        int i2 = -1; float b2 = -1e30f;
#pragma unroll
        for (int k = 0; k < 4; ++k) if (k != i1 && bv[k] > b2) { b2 = bv[k]; i2 = k; }
        float s1 = sv[0], s2s = sv[0];
#pragma unroll
        for (int k = 1; k < 4; ++k) { if (i1 == k) s1 = sv[k]; if (i2 == k) s2s = sv[k]; }
        if (lane == 0) {
            const int e0 = bg * 4 + i1, e1 = bg * 4 + i2;
            const float inv = 1.f / (s1 + s2s);
            const int li = ((r - r0 - blockIdx.x * 8 - wid) / (int)(gridDim.x * 8)) * 8 + wid;
            const int p0 = __hip_atomic_fetch_add(&lcnt[e0], 1, __ATOMIC_RELAXED, __HIP_MEMORY_SCOPE_WORKGROUP);
            const int p1 = __hip_atomic_fetch_add(&lcnt[e1], 1, __ATOMIC_RELAXED, __HIP_MEMORY_SCOPE_WORKGROUP);
            asg[2 * li] = (e0 << 16) | p0; asg[2 * li + 1] = (e1 << 16) | p1;
            wts[2 * r] = s1 * inv; wts[2 * r + 1] = s2s * inv;
        }
    }
    __syncthreads();
    if (tid < 32) lbase[tid] = atomicAdd(&cnt[tid * CNT_STRIDE], lcnt[tid]);
    __syncthreads();
    for (int idx = tid; idx < 2 * 136; idx += NT) {
        const int li = idx >> 1, k = idx & 1, it = li >> 3, w = li & 7;
        const int r = r0 + blockIdx.x * 8 + w + it * (int)(gridDim.x * 8);
        if (r < NROWS) { const int v = asg[idx], e = v >> 16, lp = v & 0xffff; list[(size_t)e * LISTCAP + lbase[e] + lp] = 2 * r + k; }
    }
}

__device__ __forceinline__ void phase_ln2(KP Pk, int layer) {
    asm volatile("" : "+s"(Pk));
    const CAS Params& P = *Pk;
    const int tid = ltid(), lane = tid & 63, wid = tid >> 6;
    const bf16_t* yp = (const bf16_t*)(P.ws + WS_YP);
    const float* wts = (const float*)(P.ws + WS_WTS);
    bf16_t* act = (bf16_t*)(P.ws + WS_ACT);
    float* xc = (float*)(P.ws + WS_XC);
    const float* lg = P.ln_g + (size_t)(layer * 2 + 1) * D; const float* lb = P.ln_b + (size_t)(layer * 2 + 1) * D;
    const bool last = (layer == DEPTH - 1);
    const int r0 = last ? NCTX : 0;
    for (int r = r0 + blockIdx.x * 8 + wid; r < NROWS; r += gridDim.x * 8) {
        const int m = row_mod(r);
        float* xr = r < NCTX ? xc + (size_t)r * D : P.out + (size_t)(r - NCTX) * D;
        const float* g2 = modvec(P.ws, layer, m, 5);
        const float w0 = wts[2 * r], w1 = wts[2 * r + 1];
        f32x4 v[4]; float s = 0.f;
#pragma unroll
        for (int i = 0; i < 4; ++i) {
            const int c = 4 * lane + 256 * i;
            const f32x4 xv = *(const f32x4*)(xr + c), gv = *(const f32x4*)(g2 + c);
            const u32x2 y0 = *(const u32x2*)(yp + (size_t)(2 * r) * D + c), y1 = *(const u32x2*)(yp + (size_t)(2 * r + 1) * D + c);
            v[i][0] = ALPHA * xv[0] + gv[0] * (w0 * bflo(y0.x) + w1 * bflo(y1.x)); v[i][1] = ALPHA * xv[1] + gv[1] * (w0 * bfhi(y0.x) + w1 * bfhi(y1.x));
            v[i][2] = ALPHA * xv[2] + gv[2] * (w0 * bflo(y0.y) + w1 * bflo(y1.y)); v[i][3] = ALPHA * xv[3] + gv[3] * (w0 * bfhi(y0.y) + w1 * bfhi(y1.y));
            s += (v[i][0] + v[i][1]) + (v[i][2] + v[i][3]);
        }
        const float mean = wave_sum(s) * (1.f / D);
        float s2 = 0.f;
#pragma unroll
        for (int i = 0; i < 4; ++i) { v[i] = v[i] - mean; s2 += (v[i][0] * v[i][0] + v[i][1] * v[i][1]) + (v[i][2] * v[i][2] + v[i][3] * v[i][3]); }
        const float rstd = rsqrtf(wave_sum(s2) * (1.f / D) + 1e-5f);
        const float* sh1 = last ? lg : modvec(P.ws, layer + 1, m, 0); const float* sc1 = last ? lg : modvec(P.ws, layer + 1, m, 1);
#pragma unroll
        for (int i = 0; i < 4; ++i) {
            const int c = 4 * lane + 256 * i;
            const f32x4 gg = *(const f32x4*)(lg + c), bb = *(const f32x4*)(lb + c);
            f32x4 xn;
#pragma unroll
            for (int j = 0; j < 4; ++j) xn[j] = v[i][j] * rstd * gg[j] + bb[j];
            *(f32x4*)(xr + c) = xn;
            if (!last) {
                const f32x4 s1v = *(const f32x4*)(sc1 + c), h1v = *(const f32x4*)(sh1 + c);
                u32x2 o; o.x = pk2(xn[0] * (1.f + s1v[0]) + h1v[0], xn[1] * (1.f + s1v[1]) + h1v[1]); o.y = pk2(xn[2] * (1.f + s1v[2]) + h1v[2], xn[3] * (1.f + s1v[3]) + h1v[3]);
                *(u32x2*)(act + (size_t)r * D + c) = o;
            }
        }
    }
}

constexpr int NPHASE = 2 + 10 * DEPTH;
__global__ void __launch_bounds__(NT, 2) fwd_kernel(Params P) {
    extern __shared__ __attribute__((aligned(16))) char lds_raw[];
    LAS char* lds = (LAS char*)lds_raw;
    volatile LAS unsigned* xbw = (volatile LAS unsigned*)(lds + LDS_BYTES - 16);
    KP Pk = (KP)__builtin_amdgcn_kernarg_segment_ptr();
    const bool multi = (P.ph_hi - P.ph_lo) > 1;
    XcdBarrier bar; bar.bar = (unsigned*)(P.ws + WS_BAR); bar.x = 0; bar.st = xbw;
    if (multi) {
        if (threadIdx.x == 0) { xbw[0] = 0u; xbw[1] = 0u; xbw[2] = 0u; xbw[3] = 0u; }
        __syncthreads();
        bar = xcd_barrier_post((unsigned*)(P.ws + WS_BAR), xbw);
    }
#define PHASE(id, body) do { if (P.ph_lo <= (id) && (id) < P.ph_hi) { body; if ((id) + 1 < P.ph_hi) xcd_barrier(bar); } } while (0)
    PHASE(0, REP(16, phase_prologue0(Pk, lds)));
    PHASE(1, REP(16, phase_prologue1(Pk)));
    for (int l = 0; l < DEPTH; ++l) {
        const int pb = 2 + 10 * l, odd = l & 1;
        PHASE(pb + 0, REP(1, phase_inproj(Pk, l, lds)));
        if (odd) {
            PHASE(pb + 1, REP(4, phase_prep1(Pk, l)));
            PHASE(pb + 2, phase_prep2(Pk, l, lds));
            PHASE(pb + 3, REP(32, { if (blockIdx.x < 128) REP(64, scan_hgrn_c(Pk, l, blockIdx.x, lds)); else if (blockIdx.x < 256) REP(128, scan_rwkv(Pk, l, blockIdx.x - 128, lds)); }));
            PHASE(pb + 4, REP(4, phase_out_odd(Pk, l)));
        } else {
            PHASE(pb + 1, REP(4, phase_prep_even(Pk, l)));
            PHASE(pb + 3, REP(2, { if (blockIdx.x < 128) scan_ssd_c(Pk, l, blockIdx.x, lds); else if (blockIdx.x < 256) scan_mlstm_c(Pk, l, blockIdx.x - 128, lds); }));
            PHASE(pb + 4, REP(4, phase_out_even(Pk, l)));
        }
        PHASE(pb + 5, REP(256, phase_outproj(Pk, l, lds)));
        PHASE(pb + 6, phase_ln1(Pk, l, lds));
        PHASE(pb + 7, REP(512, phase_moe1(Pk, l, lds)));
        PHASE(pb + 8, REP(1024, phase_moe2(Pk, l, lds)));
        PHASE(pb + 9, phase_ln2(Pk, l));
    }
#undef PHASE
}


#ifndef MK_STOP
#define MK_STOP NPHASE
#endif
#ifndef MK_DUMP
#define MK_DUMP 0
#endif
#ifndef MK_DUMP_N
#define MK_DUMP_N (1u << 30)
#endif
#ifndef MK_DUMP_LD
#define MK_DUMP_LD 1024
#endif
#ifndef MK_DUMP_C0
#define MK_DUMP_C0 0
#endif
__global__ void diff_kernel(const bf16_t* a, const bf16_t* b, float* out, size_t n) {
    for (size_t i = (size_t)blockIdx.x * blockDim.x + threadIdx.x; i < n; i += (size_t)gridDim.x * blockDim.x) out[i] = 1e6f * (bf2f(a[i]) - bf2f(b[i]));
}
__global__ void dump_kernel(const bf16_t* src, float* out, size_t n) {
    for (size_t i = (size_t)blockIdx.x * blockDim.x + threadIdx.x; i < n; i += (size_t)gridDim.x * blockDim.x) out[i] = i < (size_t)MK_DUMP_N ? bf2f(src[(i >> 10) * MK_DUMP_LD + MK_DUMP_C0 + (i & 1023)]) : 0.f;
}
extern "C" void kernel_launch(void* const* d_in, const int* in_sizes, int n_in, void* d_out, int out_size, void* d_ws, size_t ws_size, hipStream_t stream) {
    static int ready = 0;
    if (ready == 0) {
        ready = 1;
        if (n_in != 42 || out_size != NB * SEQ * D || ws_size < WS_END) { fprintf(stderr, "kernel_launch: unexpected shapes (n_in %d out %d ws %zu need %zu)\n", n_in, out_size, ws_size, (size_t)WS_END); ready = -1; }
        if (hipFuncSetAttribute((const void*)fwd_kernel, hipFuncAttributeMaxDynamicSharedMemorySize, LDS_BYTES) != hipSuccess) { fprintf(stderr, "kernel_launch: hipFuncSetAttribute failed\n"); ready = -1; }
    }
    if (ready < 0) return;
    (void)in_sizes;
    hipMemsetAsync((char*)d_ws + WS_BAR, 0, WS_ZERO_BYTES, stream);
    Params p;
    memset(&p, 0, sizeof(p));
    const float** fp = (const float**)&p;
    for (int i = 0; i < 42; ++i) fp[i] = (const float*)d_in[i];
    p.out = (float*)d_out; p.ws = (unsigned char*)d_ws;
#if MK_PER_PHASE
    for (int ph = 0; ph < MK_STOP; ++ph) {
        const int local = ph < 2 ? -1 : (ph - 2) % 10, layer = ph < 2 ? 0 : (ph - 2) / 10;
        if (local == 2 && !(layer & 1)) continue;
        p.ph_lo = ph; p.ph_hi = ph + 1;
        hipLaunchKernelGGL(fwd_kernel, dim3(256), dim3(NT), LDS_BYTES, stream, p);
    }
#ifdef MK_DIFF
    p.ph_lo = 7; p.ph_hi = 8; p.dbg = 1;
    hipLaunchKernelGGL(fwd_kernel, dim3(256), dim3(NT), LDS_BYTES, stream, p);
    hipLaunchKernelGGL(diff_kernel, dim3(1024), dim3(256), 0, stream, (const bf16_t*)((unsigned char*)d_ws + WS_YO), (const bf16_t*)((unsigned char*)d_ws + WS_HID), (float*)d_out, (size_t)NB * SEQ * D);
#else
    if (MK_DUMP) hipLaunchKernelGGL(dump_kernel, dim3(1024), dim3(256), 0, stream, (const bf16_t*)((unsigned char*)d_ws + (size_t)MK_DUMP), (float*)d_out, (size_t)NB * SEQ * D);
#endif
#else
    p.ph_lo = 0; p.ph_hi = NPHASE;
    hipLaunchKernelGGL(fwd_kernel, dim3(256), dim3(NT), LDS_BYTES, stream, p);
#endif
}
```

```cpp
#include <hip/hip_runtime.h>
#include <stdint.h>
#include <stdio.h>
#include <string.h>

#ifndef MK_PER_PHASE
#define MK_PER_PHASE 0
#endif

typedef unsigned short bf16_t;
typedef short bf16x8 __attribute__((ext_vector_type(8)));
typedef float f32x4 __attribute__((ext_vector_type(4)));
typedef unsigned u32x4 __attribute__((ext_vector_type(4)));
typedef unsigned u32x2 __attribute__((ext_vector_type(2)));
#define LAS __attribute__((address_space(3)))
#define CAS __attribute__((address_space(4)))

constexpr int D = 1024, NB = 4, SEQ = 8192, CTXL = 256, DEPTH = 4;
constexpr int NCTX = NB * CTXL;
constexpr int NROWS = NCTX + NB * SEQ;
constexpr int P_EVEN = 2848, P_ODD = 4416, LDP_EVEN = 3072, LDP_ODD = 4608;
constexpr int NEXP = 32, DEXP = 512, LISTCAP = NROWS;
constexpr float ALPHA = 1.681792830507429f;
constexpr int NT = 512;
constexpr int TCH = 32;
constexpr int NSTEPS = CTXL + SEQ;
constexpr int LDS_BYTES = 160 * 1024;

constexpr size_t al256(size_t x) { return (x + 255) & ~(size_t)255; }
constexpr size_t WS_BAR = 0;
constexpr size_t WS_CNT = 16384;
constexpr int CNT_STRIDE = 64;
constexpr size_t WS_ZERO_BYTES = 16384 + (size_t)4 * 32 * CNT_STRIDE * 4;
constexpr size_t WS_MODV = al256(WS_ZERO_BYTES);
constexpr size_t WS_LB = WS_MODV + al256((size_t)4 * 5 * 6144 * 4);
constexpr size_t WS_XC = WS_LB + al256(4 * 512 * 4);
constexpr size_t WS_WTS = WS_XC + (size_t)NCTX * D * 4;
constexpr size_t WS_LIST = WS_WTS + al256((size_t)2 * NROWS * 4);
constexpr size_t WS_WINT = WS_LIST + al256((size_t)NEXP * LISTCAP * 4);
constexpr size_t WINT_L0 = 0, WINT_L1 = (size_t)LDP_EVEN * D, WINT_L2 = WINT_L1 + (size_t)LDP_ODD * D, WINT_L3 = WINT_L2 + (size_t)LDP_EVEN * D, WINT_END = WINT_L3 + (size_t)LDP_ODD * D;
constexpr size_t WS_WOUTT = WS_WINT + WINT_END * 2;
constexpr size_t WS_LORAT = WS_WOUTT + (size_t)4 * D * D * 2;
constexpr size_t LORA_PER = (size_t)512 * 320;
constexpr size_t WS_EXPGU = WS_LORAT + al256(2 * LORA_PER * 2);
constexpr size_t WS_EXPD = WS_EXPGU + (size_t)NEXP * 1024 * 1024 * 2;
constexpr size_t WS_ACT = WS_EXPD + (size_t)NEXP * 1024 * 512 * 2;
constexpr size_t ROWB = (size_t)NROWS * D * 2;
constexpr size_t WS_FEAT = WS_ACT + ROWB;
constexpr size_t WS_YF = WS_FEAT + ROWB;
constexpr size_t WS_YB = WS_YF + ROWB;
constexpr size_t WS_P = WS_YB + ROWB;
constexpr size_t P_BYTES = (size_t)NROWS * LDP_ODD * 2;
constexpr size_t WS_YO = WS_P;
constexpr size_t WS_HID = WS_P + ROWB;
constexpr size_t WS_YP = WS_HID + ROWB;
static_assert(WS_YP + 2 * ROWB <= WS_P + P_BYTES, "MoE buffers must fit in the P region");
constexpr size_t HALFB = (size_t)NROWS * 512 * 2;
constexpr size_t WS_RWR = WS_P + P_BYTES;
constexpr size_t WS_RWK = WS_RWR + HALFB;
constexpr size_t WS_RWV = WS_RWK + HALFB;
constexpr size_t WS_RWKK = WS_RWV + HALFB;
constexpr size_t WS_RWB = WS_RWKK + HALFB;
constexpr size_t WS_RWG = WS_RWB + HALFB;
constexpr size_t WS_RWDEC = WS_RWG + HALFB;
constexpr size_t WS_LA = WS_RWDEC + (size_t)2 * NROWS * 512 * 4;
constexpr size_t WS_END = WS_LA + (size_t)NROWS * 320 * 2;
static_assert(WS_END <= (size_t)280602384 * 4, "workspace map exceeds the guaranteed ws_size");

struct Params {
    const float *x, *c, *ctx, *c_ctx, *mod_w, *mod_b, *ln_g, *ln_b;
    const float *ev_w_in, *ev_w_out, *ssd_conv_w, *ssd_conv_b, *ssd_dt_bias, *ssd_a_log, *ssd_d, *ssd_norm_w;
    const float *ml_conv_w, *ml_conv_b, *ml_i_bias, *ml_f_bias, *ml_norm_w;
    const float *od_w_in, *od_w_out, *hg_lb_logits, *hg_f_bias, *hg_norm_w;
    const float *rw_mu, *rw_w0, *rw_w2, *rw_a0, *rw_a2, *rw_g2, *rw_k_k, *rw_k_a, *rw_r_k, *rw_ln_w, *rw_ln_b;
    const float *router_w, *router_bias, *exp_w_gate, *exp_w_up, *exp_w_down;
    float* out;
    unsigned char* ws;
    int ph_lo, ph_hi, dbg, pad_;
};
typedef const CAS Params* KP;

__device__ __forceinline__ int ltid(int wv) { int l; asm volatile("v_mbcnt_lo_u32_b32 %0, -1, 0\n\tv_mbcnt_hi_u32_b32 %0, -1, %0" : "=v"(l)); return wv * 64 + l; }
__device__ __forceinline__ float bf2f(bf16_t h) { return __uint_as_float(((unsigned)h) << 16); }
__device__ __forceinline__ float bflo(unsigned u) { return __uint_as_float(u << 16); }
__device__ __forceinline__ float bfhi(unsigned u) { return __uint_as_float(u & 0xffff0000u); }
typedef __bf16 bf16v2_t __attribute__((ext_vector_type(2)));
typedef float f32x2 __attribute__((ext_vector_type(2)));
__device__ __forceinline__ unsigned pk2(float lo, float hi) { const f32x2 v = {lo, hi}; return __builtin_bit_cast(unsigned, __builtin_convertvector(v, bf16v2_t)); }
__device__ __forceinline__ bf16_t f2bf(float f) { return (bf16_t)(pk2(f, 0.f) & 0xffffu); }
__device__ __forceinline__ void unpack8(const u32x4& u, float* f) {
    f[0] = bflo(u.x); f[1] = bfhi(u.x); f[2] = bflo(u.y); f[3] = bfhi(u.y); f[4] = bflo(u.z); f[5] = bfhi(u.z); f[6] = bflo(u.w); f[7] = bfhi(u.w);
}
__device__ __forceinline__ u32x4 pack8(const float* f) { u32x4 u; u.x = pk2(f[0], f[1]); u.y = pk2(f[2], f[3]); u.z = pk2(f[4], f[5]); u.w = pk2(f[6], f[7]); return u; }
__device__ __forceinline__ float sigmoidf_(float x) { return __builtin_amdgcn_rcpf(1.f + __expf(-x)); }
__device__ __forceinline__ float siluf_(float x) { return x * __builtin_amdgcn_rcpf(1.f + __expf(-x)); }
__device__ __forceinline__ float softplus_fast(float x) { return x > 20.f ? x : __logf(1.f + __expf(x)); }
__device__ __forceinline__ float tanh_fast(float x) { return 1.f - 2.f * __builtin_amdgcn_rcpf(1.f + __expf(2.f * x)); }
__device__ __forceinline__ float softplusf_(float x) { return x > 20.f ? x : __logf(1.f + __expf(x)); }
__device__ __forceinline__ float logsigmoidf_(float x) { return fminf(x, 0.f) - __logf(1.f + __expf(-fabsf(x))); }
__device__ __forceinline__ float wave_sum(float v) {
#pragma unroll
    for (int o = 1; o < 64; o <<= 1) v += __shfl_xor(v, o);
    return v;
}
template <int W> __device__ __forceinline__ float group_sum(float v) {
#pragma unroll
    for (int o = 1; o < W; o <<= 1) v += __shfl_xor(v, o);
    return v;
}
template <int CTRL> __device__ __forceinline__ float dppmov(float v) {
    return __builtin_bit_cast(float, __builtin_amdgcn_update_dpp(0, __builtin_bit_cast(int, v), CTRL, 0xf, 0xf, true));
}
__device__ __forceinline__ float allreduce16(float v) {
    v += dppmov<0xB1>(v);
    v += dppmov<0x4E>(v);
    v += dppmov<0x141>(v);
    v += dppmov<0x140>(v);
    return v;
}

#define XB_TMO      128
#define XB_XCNT(j)  (256  + 64 * (j))
#define XB_XSUB(j)  (1280 + 64 * (j))
#define XB_XGEN(j)  (2304 + 64 * (j))
#define XB_TOP      3328
#define XB_TOPGEN   3392
#define XCD_BAR_WORDS 3456
#define XB_SPIN_CAP (1u << 22)
__device__ __forceinline__ unsigned xb_ld(unsigned* p)              { return __hip_atomic_load(p, __ATOMIC_RELAXED, __HIP_MEMORY_SCOPE_AGENT); }
__device__ __forceinline__ unsigned xb_add(unsigned* p, unsigned v) { return __hip_atomic_fetch_add(p, v, __ATOMIC_RELAXED, __HIP_MEMORY_SCOPE_AGENT); }
__device__ __forceinline__ unsigned xb_xcc_id() { return (unsigned)__builtin_amdgcn_s_getreg((3 << 11) | 20) & 0xFu; }
#define XB_SPIN(cond, bar) do { unsigned _sp = 0; while (cond) { __builtin_amdgcn_s_sleep(1); \
    if ((++_sp & 255u) == 0u) { if (xb_ld(&(bar)[XB_TMO])) break; if (_sp > XB_SPIN_CAP) { atomicAdd(&(bar)[XB_TMO], 1u); break; } } } } while (0)
struct XcdBarrier { unsigned* bar; unsigned x; volatile LAS unsigned* st; };
__device__ __forceinline__ XcdBarrier xcd_barrier_post(int wv, unsigned* bar, volatile LAS unsigned* st) {
    XcdBarrier b; b.bar = bar; b.x = xb_xcc_id(); b.st = st;
    if (ltid(wv) == 0) (void)xb_add(&bar[XB_XCNT(b.x)], 1u);
    return b;
}
__device__ __forceinline__ void xcd_barrier_complete(unsigned* bar, unsigned x, unsigned& nloc, unsigned& nx) {
    const unsigned G = gridDim.x * gridDim.y * gridDim.z;
    unsigned sum, cnt, mine, sp = 0u;
    for (;;) {
        sum = 0u; cnt = 0u; mine = 0u;
#pragma unroll
        for (unsigned j = 0; j < 16; ++j) { const unsigned c = xb_ld(&bar[XB_XCNT(j)]); sum += c; cnt += (c > 0u) ? 1u : 0u; mine = (j == x) ? c : mine; }
        if (sum == G) break;
        __builtin_amdgcn_s_sleep(1);
        if ((++sp & 255u) == 0u) { if (xb_ld(&bar[XB_TMO])) break; if (sp > XB_SPIN_CAP) { atomicAdd(&bar[XB_TMO], 1u); break; } }
    }
    nloc = mine > 0u ? mine : 1u; nx = cnt > 0u ? cnt : 1u;
}
__device__ __forceinline__ void xcd_barrier(int wv, const XcdBarrier& b) {
    asm volatile("s_waitcnt vmcnt(0)" ::: "memory");
    __syncthreads();
    if (ltid(wv) == 0) {
        unsigned* bar = b.bar;
        asm volatile("" : "+s"(bar));
        __builtin_amdgcn_s_waitcnt(0);
        unsigned nloc = b.st[0], nx = b.st[1];
        if (nloc == 0u) { xcd_barrier_complete(bar, b.x, nloc, nx); b.st[0] = nloc; b.st[1] = nx; }
        const unsigned old = xb_add(&bar[XB_XSUB(b.x)], 1u);
        const unsigned gen = old / nloc;
        if (old + 1u == (gen + 1u) * nloc) {
            __builtin_amdgcn_fence(__ATOMIC_RELEASE, "agent");
            asm volatile("s_waitcnt vmcnt(0)" ::: "memory");
            const unsigned og = xb_add(&bar[XB_TOP], 1u);
            const unsigned tg = og / nx;
            if (og + 1u == (tg + 1u) * nx) xb_add(&bar[XB_TOPGEN], 1u);
            else XB_SPIN(xb_ld(&bar[XB_TOPGEN]) == tg, bar);
            __builtin_amdgcn_fence(__ATOMIC_ACQUIRE, "agent");
            xb_add(&bar[XB_XGEN(b.x)], 1u);
            asm volatile("s_waitcnt vmcnt(0)" ::: "memory");
        } else {
            XB_SPIN(xb_ld(&bar[XB_XGEN(b.x)]) == gen, bar);
            __builtin_amdgcn_fence(__ATOMIC_ACQUIRE, "agent");
            asm volatile("s_waitcnt vmcnt(0)" ::: "memory");
        }
    }
    __syncthreads();
}

__device__ __forceinline__ int row_mod(int r) { return r < NCTX ? 4 : ((r - NCTX) >> 13); }
__device__ __forceinline__ void row_seg(int r, int& t, int& len) { if (r < NCTX) { t = r & 255; len = CTXL; } else { t = (r - NCTX) & 8191; len = SEQ; } }
__device__ __forceinline__ int scan_row(int tg, int b, int dir, int odd) {
    if (tg < CTXL) { const int t = dir ? (CTXL - 1 - tg) : tg; return b * CTXL + t; }
    int sg = tg - CTXL; if (dir) sg = SEQ - 1 - sg;
    const int s = odd ? (((sg & 127) << 6) + (sg >> 7)) : sg;
    return NCTX + b * SEQ + s;
}
__device__ __forceinline__ const float* modvec(const unsigned char* ws, int layer, int m, int which) {
    return (const float*)(ws + WS_MODV) + ((size_t)(layer * 5 + m) * 6 + which) * D;
}

constexpr int G_BM = 256, G_BN = 128, G_BK = 64;
constexpr int G_ABYTES = G_BM * G_BK * 2, G_BBYTES = G_BN * G_BK * 2, G_BUF = G_ABYTES + G_BBYTES;
__device__ __forceinline__ int swz(int o) { return o ^ (((o >> 9) & 1) << 5); }

template <class RowSrc, class Epi>
__device__ __forceinline__ void gemm_tile(int wv, const bf16_t* __restrict__ A, int lda, const RowSrc& rs, const bf16_t* __restrict__ Bt, int ldb, int n0, int K, const Epi& epi, LAS char* lds) {
    const int tid = ltid(wv), lane = tid & 63, wid = tid >> 6, wm = wid >> 1, wn = wid & 1;
    const bf16_t* ap[4]; int aoff[4];
#pragma unroll
    for (int i = 0; i < 4; ++i) {
        const int c = tid + NT * i, row = c >> 3, kc = c & 7;
        ap[i] = A + (size_t)rs.src(row) * lda + kc * 8;
        aoff[i] = ((row >> 4) * 2 + (kc >> 2)) * 1024 + swz((row & 15) * 64 + (kc & 3) * 16);
    }
    const bf16_t* bp[2]; int boff[2];
#pragma unroll
    for (int i = 0; i < 2; ++i) {
        const int c = tid + NT * i, row = c >> 3, kc = c & 7;
        bp[i] = Bt + (size_t)(n0 + row) * ldb + kc * 8;
        boff[i] = G_ABYTES + ((row >> 4) * 2 + (kc >> 2)) * 1024 + swz((row & 15) * 64 + (kc & 3) * 16);
    }
    f32x4 acc[4][4];
#pragma unroll
    for (int i = 0; i < 4; ++i)
#pragma unroll
        for (int j = 0; j < 4; ++j) acc[i][j] = (f32x4){0.f, 0.f, 0.f, 0.f};
    u32x4 ra[2][4], rb[2][2];
    const int KT = K / G_BK;
    const int fragoff = swz((lane & 15) * 64 + (lane >> 4) * 16);
#define G_LOAD(set, kt_) do { _Pragma("unroll") for (int i = 0; i < 4; ++i) ra[set][i] = *(const u32x4*)(ap[i] + (kt_) * G_BK); \
                              _Pragma("unroll") for (int i = 0; i < 2; ++i) rb[set][i] = *(const u32x4*)(bp[i] + (kt_) * G_BK); } while (0)
#define G_STORE(set, buf) do { _Pragma("unroll") for (int i = 0; i < 4; ++i) *(LAS u32x4*)((buf) + aoff[i]) = ra[set][i]; \
                               _Pragma("unroll") for (int i = 0; i < 2; ++i) *(LAS u32x4*)((buf) + boff[i]) = rb[set][i]; } while (0)
#define G_COMPUTE(cur) do { bf16x8 af[2][4], bfr[2][4]; \
        _Pragma("unroll") for (int ks = 0; ks < 2; ++ks) { \
            _Pragma("unroll") for (int ni = 0; ni < 4; ++ni) bfr[ks][ni] = *(LAS bf16x8*)((cur) + G_ABYTES + ((wn * 4 + ni) * 2 + ks) * 1024 + fragoff); \
            _Pragma("unroll") for (int mi = 0; mi < 4; ++mi) af[ks][mi] = *(LAS bf16x8*)((cur) + ((wm * 4 + mi) * 2 + ks) * 1024 + fragoff); } \
        __builtin_amdgcn_sched_barrier(0); \
        _Pragma("unroll") for (int ks = 0; ks < 2; ++ks) _Pragma("unroll") for (int mi = 0; mi < 4; ++mi) _Pragma("unroll") for (int ni = 0; ni < 4; ++ni) \
            acc[mi][ni] = __builtin_amdgcn_mfma_f32_16x16x32_bf16(bfr[ks][ni], af[ks][mi], acc[mi][ni], 0, 0, 0); \
        __builtin_amdgcn_sched_barrier(0); } while (0)
    G_LOAD(0, 0);
    G_STORE(0, lds);
    if (KT > 1) G_LOAD(0, 1);
    if (KT > 2) G_LOAD(1, 2);
    __syncthreads();
    for (int kt = 0; kt < KT; kt += 2) {
        G_COMPUTE(lds);
        if (kt + 1 < KT) G_STORE(0, lds + G_BUF);
        if (kt + 3 < KT) G_LOAD(0, kt + 3);
        __syncthreads();
        if (kt + 1 < KT) {
            G_COMPUTE(lds + G_BUF);
            if (kt + 2 < KT) G_STORE(1, lds);
            if (kt + 4 < KT) G_LOAD(1, kt + 4);
            __syncthreads();
        }
    }
#undef G_LOAD
#undef G_STORE
#undef G_COMPUTE
    epi(acc, wm * 64 + (lane & 15), wn * 64 + 4 * (lane >> 4));
}

constexpr int G2_BN = 256, G2_BBYTES = G2_BN * G_BK * 2, G2_BUF = G_ABYTES + G2_BBYTES;
template <class RowSrc, class Epi>
__device__ __forceinline__ void gemm_tile256(int wv, const bf16_t* __restrict__ A, int lda, const RowSrc& rs, const bf16_t* __restrict__ Bt, int ldb, int n0, int K, const Epi& epi, LAS char* lds) {
    const int tid = ltid(wv), lane = tid & 63, wid = tid >> 6, wm = wid >> 1, wn = wid & 1;
    const int r0 = tid >> 3, kc = tid & 7;
    const int aoff0 = ((r0 >> 4) * 2 + (kc >> 2)) * 1024 + swz((r0 & 15) * 64 + (kc & 3) * 16);
    int aeo[4];
#pragma unroll
    for (int i = 0; i < 4; ++i) aeo[i] = rs.src(r0 + 64 * i) * lda + kc * 8;
    const bf16_t* bp0 = Bt + (size_t)(n0 + r0) * ldb + kc * 8;
    const int bstep = 64 * ldb;
    f32x4 acc[4][8];
#pragma unroll
    for (int i = 0; i < 4; ++i)
#pragma unroll
        for (int j = 0; j < 8; ++j) acc[i][j] = (f32x4){0.f, 0.f, 0.f, 0.f};
    u32x4 ra[4], rb[4];
#pragma unroll
    for (int i = 0; i < 4; ++i) { ra[i] = *(const u32x4*)(A + aeo[i]); rb[i] = *(const u32x4*)(bp0 + i * bstep); }
#pragma unroll
    for (int i = 0; i < 4; ++i) { *(LAS u32x4*)(lds + aoff0 + i * 8192) = ra[i]; *(LAS u32x4*)(lds + G_ABYTES + aoff0 + i * 8192) = rb[i]; }
    __syncthreads();
    const int KT = K / G_BK;
    const int fragoff = swz((lane & 15) * 64 + (lane >> 4) * 16);
    for (int kt = 0; kt < KT; ++kt) {
        LAS char* cur = lds + (kt & 1) * G2_BUF;
        LAS char* nxt = lds + ((kt + 1) & 1) * G2_BUF;
        const bool more = (kt + 1 < KT);
        if (more) {
#pragma unroll
            for (int i = 0; i < 4; ++i) { ra[i] = *(const u32x4*)(A + aeo[i] + (kt + 1) * G_BK); rb[i] = *(const u32x4*)(bp0 + i * bstep + (kt + 1) * G_BK); }
        }
#pragma unroll
        for (int ks = 0; ks < 2; ++ks) {
            bf16x8 af[4];
#pragma unroll
            for (int mi = 0; mi < 4; ++mi) af[mi] = *(LAS bf16x8*)(cur + ((wm * 4 + mi) * 2 + ks) * 1024 + fragoff);
#pragma unroll
            for (int nh = 0; nh < 2; ++nh) {
                bf16x8 bfr[4];
#pragma unroll
                for (int ni = 0; ni < 4; ++ni) bfr[ni] = *(LAS bf16x8*)(cur + G_ABYTES + ((wn * 8 + nh * 4 + ni) * 2 + ks) * 1024 + fragoff);
                __builtin_amdgcn_sched_barrier(0);
#pragma unroll
                for (int mi = 0; mi < 4; ++mi)
#pragma unroll
                    for (int ni = 0; ni < 4; ++ni) acc[mi][nh * 4 + ni] = __builtin_amdgcn_mfma_f32_16x16x32_bf16(bfr[ni], af[mi], acc[mi][nh * 4 + ni], 0, 0, 0);
                __builtin_amdgcn_sched_barrier(0);
            }
        }
        if (more) {
#pragma unroll
            for (int i = 0; i < 4; ++i) { *(LAS u32x4*)(nxt + aoff0 + i * 8192) = ra[i]; *(LAS u32x4*)(nxt + G_ABYTES + aoff0 + i * 8192) = rb[i]; }
        }
        __syncthreads();
    }
    epi(acc, wm * 64 + (lane & 15), wn * 128 + 4 * (lane >> 4));
}

struct RowLinear { int m0; __device__ __forceinline__ int src(int r) const { return m0 + r; } };
struct RowList {
    const int* list; int cnt; int shift;
    __device__ __forceinline__ int src(int r) const { const int a = list[r < cnt ? r : 0]; return a >> shift; }
};
struct EpiStoreBf16 {
    bf16_t* C; int ldc; int m0; int n0; int N;
    template <int NI> __device__ __forceinline__ void operator()(const f32x4 (&acc)[4][NI], int rbase, int cbase) const {
#pragma unroll
        for (int mi = 0; mi < 4; ++mi) {
            bf16_t* rowp = C + (size_t)(m0 + rbase + mi * 16) * ldc + n0 + cbase;
#pragma unroll
            for (int ni = 0; ni < NI; ++ni) {
                if (n0 + cbase + ni * 16 < N) { u32x2 v; v.x = pk2(acc[mi][ni][0], acc[mi][ni][1]); v.y = pk2(acc[mi][ni][2], acc[mi][ni][3]); *(u32x2*)(rowp + ni * 16) = v; }
            }
        }
    }
};
struct EpiSwiGLU {
    bf16_t* H; const int* list; int cnt; int n0;
    template <int NI> __device__ __forceinline__ void operator()(const f32x4 (&acc)[4][NI], int rbase, int cbase) const {
#pragma unroll
        for (int mi = 0; mi < 4; ++mi) {
            const int r = rbase + mi * 16;
            if (r < cnt) {
                const int a = list[r];
                const int wnb = cbase & ~63, q4 = cbase & 63;
                bf16_t* rowp = H + (size_t)a * DEXP + ((n0 + wnb) >> 1) + q4;
#pragma unroll
                for (int q = 0; q < NI / 2; ++q) {
                    float o[4];
#pragma unroll
                    for (int j = 0; j < 4; ++j) o[j] = siluf_(acc[mi][2 * q][j]) * acc[mi][2 * q + 1][j];
                    u32x2 v; v.x = pk2(o[0], o[1]); v.y = pk2(o[2], o[3]); *(u32x2*)(rowp + q * 16) = v;
                }
            }
        }
    }
};
struct EpiScatterBf16 {
    bf16_t* C; const int* list; int cnt; int n0;
    template <int NI> __device__ __forceinline__ void operator()(const f32x4 (&acc)[4][NI], int rbase, int cbase) const {
#pragma unroll
        for (int mi = 0; mi < 4; ++mi) {
            const int r = rbase + mi * 16;
            if (r < cnt) {
                bf16_t* rowp = C + (size_t)list[r] * D + n0 + cbase;
#pragma unroll
                for (int ni = 0; ni < NI; ++ni) { u32x2 v; v.x = pk2(acc[mi][ni][0], acc[mi][ni][1]); v.y = pk2(acc[mi][ni][2], acc[mi][ni][3]); *(u32x2*)(rowp + ni * 16) = v; }
            }
        }
    }
};
struct EpiDecay {
    float* Dc; const float* w0; int m0; int n0;
    template <int NI> __device__ __forceinline__ void operator()(const f32x4 (&acc)[4][NI], int rbase, int cbase) const {
#pragma unroll
        for (int ni = 0; ni < NI; ++ni) {
            const int col = n0 + cbase + ni * 16;
            const f32x4 w0v = *(const f32x4*)(w0 + col);
#pragma unroll
            for (int mi = 0; mi < 4; ++mi) {
                f32x4 o;
#pragma unroll
                for (int j = 0; j < 4; ++j) { const float w = w0v[j] + acc[mi][ni][j]; o[j] = __expf(-__expf(-softplus_fast(-w) - 0.5f)); }
                *(f32x4*)(Dc + (size_t)(m0 + rbase + mi * 16) * 512 + col) = o;
            }
        }
    }
};
struct EpiAK {
    bf16_t* Kb; const bf16_t* KKb; bf16_t* Bb; const float* a0; const float* k_a; int m0; int n0;
    template <int NI> __device__ __forceinline__ void operator()(const f32x4 (&acc)[4][NI], int rbase, int cbase) const {
#pragma unroll
        for (int ni = 0; ni < NI; ++ni) {
            const int col = n0 + cbase + ni * 16;
            const f32x4 a0v = *(const f32x4*)(a0 + col), kav = *(const f32x4*)(k_a + col);
#pragma unroll
            for (int mi = 0; mi < 4; ++mi) {
                const size_t off = (size_t)(m0 + rbase + mi * 16) * 512 + col;
                const u32x2 kr = *(const u32x2*)(Kb + off), kkr = *(const u32x2*)(KKb + off);
                const float kf[4] = {bflo(kr.x), bfhi(kr.x), bflo(kr.y), bfhi(kr.y)}, kkf[4] = {bflo(kkr.x), bfhi(kkr.x), bflo(kkr.y), bfhi(kkr.y)};
                float k2[4], bb[4];
#pragma unroll
                for (int j = 0; j < 4; ++j) { const float a = sigmoidf_(a0v[j] + acc[mi][ni][j]); k2[j] = kf[j] * (1.f + (a - 1.f) * kav[j]); bb[j] = kkf[j] * a; }
                u32x2 v; v.x = pk2(k2[0], k2[1]); v.y = pk2(k2[2], k2[3]); *(u32x2*)(Kb + off) = v;
                v.x = pk2(bb[0], bb[1]); v.y = pk2(bb[2], bb[3]); *(u32x2*)(Bb + off) = v;
            }
        }
    }
};

namespace pg8 {
#define PG8_LAS __attribute__((address_space(3)))
constexpr int BM = 256, BK = 64, HALF = 128, HTB = HALF * BK * 2, STAGE_BYTES = 8 * HTB, NXCD = 8, WGM = 8;
__host__ __device__ __forceinline__ int lds_byte(int r, int c) { const int st = (r >> 4) * 2 + (c >> 5), rr = r & 15, cc = c & 31, ob = rr * 64 + cc * 2; return st * 1024 + (ob ^ (((ob >> 9) & 1) << 5)); }
__host__ __device__ __forceinline__ void stage_rc(int b, int& R, int& C) { const int st = b / 1024, sb = b % 1024, swz = sb ^ (((sb >> 9) & 1) << 5); R = (st >> 1) * 16 + swz / 64; C = (st & 1) * 32 + (swz % 64) / 2; }
__host__ __device__ __forceinline__ int perm32(int rho) { const int n = rho >> 4, i = rho & 15; return 8 * (i >> 2) + 4 * n + (i & 3); }
struct Unit { int pm, pn; };
struct Gemm { const bf16_t* A; const bf16_t* Bt; int M, N, K; };
struct StaticOrder {
    int nM, nN, nwg, G, c;
    __host__ __device__ void init(int M, int N, int G_, int c_) { nM = M / BM; nN = N / BM; nwg = nM * nN; G = G_; c = c_; }
    __host__ __device__ bool next(int i, Unit& u) const {
        const long L = (long)i * G + c; if (L >= nwg) return false;
        int wgid = (int)L; { const int q = nwg / NXCD, r = nwg % NXCD, xcd = wgid % NXCD, off = wgid / NXCD; wgid = (xcd < r ? xcd * (q + 1) : r * (q + 1) + (xcd - r) * q) + off; }
        const int nig = WGM * nN, gid = wgid / nig, fm = gid * WGM, gsz = (nM - fm) < WGM ? (nM - fm) : WGM;
        u.pm = fm + ((wgid % nig) % gsz); u.pn = (wgid % nig) / gsz; return true;
    }
    __device__ __forceinline__ void a_ready(const Unit&) const {}
    __device__ __forceinline__ void done(const Unit&) const {}
};
struct EpiStoreP {
    static constexpr bool PERM = true, AFTER_DRAIN = false;
    bf16_t* O; int ldc;
    __device__ __forceinline__ void operator()(const f32x4 (&acc)[2][2][4][2], const Unit& u, int wr, int wc, int fr, int fq) const {
        const int row0 = u.pm * BM + wr * 64 + fr, col0 = u.pn * BM + wc * 32 + 8 * fq;
#pragma unroll
        for (int ai = 0; ai < 2; ++ai)
#pragma unroll
            for (int m = 0; m < 4; ++m) { bf16_t* rowp = O + (size_t)(row0 + ai * HALF + m * 16) * ldc + col0;
#pragma unroll
                for (int bj = 0; bj < 2; ++bj) { const f32x4 v0 = acc[ai][bj][m][0], v1 = acc[ai][bj][m][1];
                    u32x4 w; w.x = pk2(v0[0], v0[1]); w.y = pk2(v0[2], v0[3]); w.z = pk2(v1[0], v1[1]); w.w = pk2(v1[2], v1[3]);
                    *(u32x4*)(rowp + bj * HALF) = w; } }
    }
};
template <class Epi, class Sched>
__device__ __forceinline__ void gemm_phase(int wv, PG8_LAS unsigned char* lds, const Gemm g, const Sched& S, const Epi& E) {
    const int tid = ltid(wv), wid = __builtin_amdgcn_readfirstlane(tid >> 6), lane = tid & 63, wr = wid >> 2, wc = wid & 3, fr = lane & 15, fq = lane >> 4;
    const int K = g.K, nt = K / BK;
    unsigned voffA[2], voffB[2];
#pragma unroll
    for (int i = 0; i < 2; ++i) { int R, C; stage_rc(tid * 16 + i * 8192, R, C); const int Rb = Epi::PERM ? ((R & ~31) + perm32(R & 31)) : R;
        voffA[i] = (unsigned)(R * K + C) * 2u; voffB[i] = (unsigned)(Rb * K + C) * 2u; }
    const size_t kstep = (size_t)(BK * 2);
    const size_t hstep = (size_t)HALF * K * 2;
    const size_t tstep = 2 * hstep;
    const unsigned ldsw = (unsigned)wid * 1024u;
    const int aoff = lds_byte(wr * 64 + fr, fq * 8), boff = lds_byte(wc * 32 + fr, fq * 8);
#define PG8_SA(b, h) (((b) * 2 + (h)) * HTB)
#define PG8_SB(b, h) ((4 + (b) * 2 + (h)) * HTB)
#define PG8_STAGE(bufoff, gbase, voff) do { _Pragma("unroll") for (int _i = 0; _i < 2; ++_i) \
        __builtin_amdgcn_global_load_lds((const unsigned*)((const char*)(gbase) + (voff)[_i]), (PG8_LAS unsigned*)(lds + (bufoff) + ldsw + _i * 8192), 16, 0, 0); } while (0)
#define PG8_LDA(dst, b, h) do { _Pragma("unroll") for (int m = 0; m < 4; ++m) _Pragma("unroll") for (int k = 0; k < 2; ++k) dst[m][k] = *(const PG8_LAS bf16x8*)(lds + PG8_SA(b, h) + aoff + m * 2048 + k * 1024); } while (0)
#define PG8_LDB(dst, b, h) do { _Pragma("unroll") for (int n = 0; n < 2; ++n) _Pragma("unroll") for (int k = 0; k < 2; ++k) dst[n][k] = *(const PG8_LAS bf16x8*)(lds + PG8_SB(b, h) + boff + n * 2048 + k * 1024); } while (0)
#define PG8_MMA(ai, bj, At, Bt) do { __builtin_amdgcn_s_setprio(1); _Pragma("unroll") for (int m = 0; m < 4; ++m) _Pragma("unroll") for (int n = 0; n < 2; ++n) _Pragma("unroll") for (int k = 0; k < 2; ++k) \
        acc[ai][bj][m][n] = __builtin_amdgcn_mfma_f32_16x16x32_bf16(Bt[n][k], At[m][k], acc[ai][bj][m][n], 0, 0, 0); __builtin_amdgcn_s_setprio(0); } while (0)
#define PG8_WAIT_V(n) asm volatile("s_waitcnt vmcnt(" #n ")" ::: "memory")
#define PG8_WAIT_L(n) asm volatile("s_waitcnt lgkmcnt(" #n ")" ::: "memory")
#define PG8_BAR __builtin_amdgcn_s_barrier()
#define PG8_SCHED __builtin_amdgcn_sched_barrier(0)
    Unit cur, nxt; int ui = 0;
    if (!S.next(0, cur)) return;
    f32x4 acc[2][2][4][2];
#pragma unroll
    for (int a = 0; a < 2; ++a)
#pragma unroll
        for (int b = 0; b < 2; ++b)
#pragma unroll
            for (int m = 0; m < 4; ++m)
#pragma unroll
                for (int n = 0; n < 2; ++n) acc[a][b][m][n] = (f32x4){0.f, 0.f, 0.f, 0.f};
    bf16x8 At[4][2], B0[2][2], B1[2][2];
    const char* cA = (const char*)g.A + (size_t)cur.pm * tstep; const char* cB = (const char*)g.Bt + (size_t)cur.pn * tstep;
    S.a_ready(cur);
    PG8_STAGE(PG8_SB(0, 0), cB, voffB); PG8_STAGE(PG8_SA(0, 0), cA, voffA); PG8_STAGE(PG8_SB(0, 1), cB + hstep, voffB); PG8_STAGE(PG8_SA(0, 1), cA + hstep, voffA);
    if (wr == 1) PG8_BAR;
    PG8_WAIT_V(4); PG8_BAR;
    PG8_STAGE(PG8_SB(1, 0), cB + kstep, voffB); PG8_STAGE(PG8_SA(1, 0), cA + kstep, voffA); PG8_STAGE(PG8_SB(1, 1), cB + hstep + kstep, voffB);
    PG8_WAIT_V(6); PG8_BAR;
    for (;;) {
        const bool has_next = S.next(ui + 1, nxt);
        const char* nA = has_next ? (const char*)g.A + (size_t)nxt.pm * tstep : cA; const char* nB = has_next ? (const char*)g.Bt + (size_t)nxt.pn * tstep : cB;
        for (int t = 0; t < nt; t += 2) {
            const bool last = (t == nt - 2);
            const char* a1 = cA + (size_t)(t + 1) * kstep;
            const char* a2 = last ? nA : cA + (size_t)(t + 2) * kstep; const char* b2 = last ? nB : cB + (size_t)(t + 2) * kstep;
            const char* a3 = a2 + kstep; const char* b3 = b2 + kstep;
            if (last && has_next) S.a_ready(nxt);
            PG8_LDB(B0, 0, 0); PG8_SCHED; PG8_LDA(At, 0, 0); PG8_STAGE(PG8_SA(1, 1), a1 + hstep, voffA);
            PG8_WAIT_L(8); PG8_BAR; PG8_WAIT_L(0); PG8_MMA(0, 0, At, B0); PG8_BAR; PG8_SCHED;
            PG8_LDB(B1, 0, 1); PG8_STAGE(PG8_SB(0, 0), b2, voffB);
            PG8_BAR; PG8_WAIT_L(0); PG8_MMA(0, 1, At, B1); PG8_BAR;
            PG8_LDA(At, 0, 1); PG8_STAGE(PG8_SA(0, 0), a2, voffA);
            PG8_BAR; PG8_WAIT_L(0); PG8_MMA(1, 0, At, B0); PG8_BAR; PG8_SCHED;
            PG8_STAGE(PG8_SB(0, 1), b2 + hstep, voffB);
            PG8_WAIT_V(6); PG8_BAR; PG8_MMA(1, 1, At, B1); PG8_BAR;
            PG8_LDB(B0, 1, 0); PG8_SCHED; PG8_LDA(At, 1, 0); PG8_STAGE(PG8_SA(0, 1), a2 + hstep, voffA);
            PG8_WAIT_L(8); PG8_BAR; PG8_WAIT_L(0); PG8_MMA(0, 0, At, B0); PG8_BAR; PG8_SCHED;
            PG8_LDB(B1, 1, 1); PG8_STAGE(PG8_SB(1, 0), b3, voffB);
            PG8_BAR; PG8_WAIT_L(0); PG8_MMA(0, 1, At, B1); PG8_BAR;
            PG8_LDA(At, 1, 1); PG8_STAGE(PG8_SA(1, 0), a3, voffA);
            PG8_BAR; PG8_WAIT_L(0); PG8_MMA(1, 0, At, B0); PG8_BAR; PG8_SCHED;
            PG8_STAGE(PG8_SB(1, 1), b3 + hstep, voffB);
            PG8_WAIT_V(6); PG8_BAR; PG8_MMA(1, 1, At, B1); PG8_BAR;
        }
            if constexpr (!Epi::AFTER_DRAIN) { E(acc, cur, wr, wc, fr, fq); S.done(cur); }
            if (!has_next) break;
#pragma unroll
        for (int a = 0; a < 2; ++a)
#pragma unroll
            for (int b = 0; b < 2; ++b)
#pragma unroll
                for (int m = 0; m < 4; ++m)
#pragma unroll
                    for (int n = 0; n < 2; ++n) acc[a][b][m][n] = (f32x4){0.f, 0.f, 0.f, 0.f};
        cur = nxt; cA = nA; cB = nB; ++ui;
    }
    PG8_WAIT_V(0);
    if (wr == 0) PG8_BAR;
    PG8_BAR;
    if constexpr (Epi::AFTER_DRAIN) { E.fused(acc, cur, wr, wc, fr, fq, lds, wid, lane); S.done(cur); }
#undef PG8_SA
#undef PG8_SB
#undef PG8_STAGE
#undef PG8_LDA
#undef PG8_LDB
#undef PG8_MMA
#undef PG8_WAIT_V
#undef PG8_WAIT_L
#undef PG8_BAR
#undef PG8_SCHED
}
struct UnitG { int pm, pn; const char* bbase; const PG8_LAS int* ltab; int cnt; int e; };
struct MoeOrder {
    const PG8_LAS int* tstart; const PG8_LAS int* tcnt; const PG8_LAS int* ltabs; const int* lists; const char* bt; size_t estride; int ncol, shift, G, c;
    __device__ __forceinline__ bool next(int i, UnitG& u) const {
        const int t = i * G + c; if (t >= tstart[32] * ncol) return false;
        const int tm = t / ncol; int e = 0;
#pragma unroll 1
        while (tstart[e + 1] <= tm) ++e;
        e = __builtin_amdgcn_readfirstlane(e);
        const int ts = __builtin_amdgcn_readfirstlane(tstart[e]), tc = __builtin_amdgcn_readfirstlane(tcnt[e]);
        u.pm = tm - ts; u.pn = t - tm * ncol; u.bbase = bt + (size_t)e * estride; u.e = e; u.cnt = tc - u.pm * BM; u.ltab = ltabs + i * BM;
        return true;
    }
    __device__ __forceinline__ void a_ready(const UnitG&) const {}
    __device__ __forceinline__ void done(const UnitG&) const {}
};
struct EpiSwiGLUG {
    static constexpr bool PERM = false, AFTER_DRAIN = false;
    bf16_t* H;
    __device__ __forceinline__ void operator()(const f32x4 (&acc)[2][2][4][2], const UnitG& u, int wr, int wc, int fr, int fq) const {
#pragma unroll
        for (int ai = 0; ai < 2; ++ai)
#pragma unroll
            for (int m = 0; m < 4; ++m) { const int r = ai * HALF + wr * 64 + m * 16 + fr;
                if (r < u.cnt) { bf16_t* rowp = H + (size_t)u.ltab[r] * DEXP + ((u.pn * BM + wc * 32) >> 1) + 4 * fq;
#pragma unroll
                    for (int bj = 0; bj < 2; ++bj) { const f32x4 gt = acc[ai][bj][m][0], up = acc[ai][bj][m][1];
                        u32x2 w; w.x = pk2(siluf_(gt[0]) * up[0], siluf_(gt[1]) * up[1]); w.y = pk2(siluf_(gt[2]) * up[2], siluf_(gt[3]) * up[3]);
                        *(u32x2*)(rowp + bj * (HALF / 2)) = w; } } }
    }
};
struct EpiScatterG {
    static constexpr bool PERM = true, AFTER_DRAIN = false;
    bf16_t* O;
    __device__ __forceinline__ void operator()(const f32x4 (&acc)[2][2][4][2], const UnitG& u, int wr, int wc, int fr, int fq) const {
#pragma unroll
        for (int ai = 0; ai < 2; ++ai)
#pragma unroll
            for (int m = 0; m < 4; ++m) { const int r = ai * HALF + wr * 64 + m * 16 + fr;
                if (r < u.cnt) { bf16_t* rowp = O + (size_t)u.ltab[r] * D + u.pn * BM + wc * 32 + 8 * fq;
#pragma unroll
                    for (int bj = 0; bj < 2; ++bj) { const f32x4 v0 = acc[ai][bj][m][0], v1 = acc[ai][bj][m][1];
                        u32x4 w; w.x = pk2(v0[0], v0[1]); w.y = pk2(v0[2], v0[3]); w.z = pk2(v1[0], v1[1]); w.w = pk2(v1[2], v1[3]);
                        *(u32x4*)(rowp + bj * HALF) = w; } } }
    }
};
template <class Epi, class Sched>
__device__ __forceinline__ void gemm_phase_g(int wv, PG8_LAS unsigned char* lds, const Gemm g, const Sched& S, const Epi& E) {
    const int tid = ltid(wv), wid = __builtin_amdgcn_readfirstlane(tid >> 6), lane = tid & 63, wr = wid >> 2, wc = wid & 3, fr = lane & 15, fq = lane >> 4;
    const int K = g.K, nt = K / BK;
    unsigned voffB[2];
#pragma unroll
    for (int i = 0; i < 2; ++i) { int R, C; stage_rc(tid * 16 + i * 8192, R, C); const int Rb = Epi::PERM ? ((R & ~31) + perm32(R & 31)) : R;
        voffB[i] = (unsigned)(Rb * K + C) * 2u; }
    const unsigned rowb = (unsigned)K * 2u;
#define PG8_AOFFS(u, dst) do { const int _t = ltid(wv); _Pragma("unroll") for (int _i = 0; _i < 2; ++_i) { int _R, _C; stage_rc(_t * 16 + _i * 8192, _R, _C); \
        _Pragma("unroll") for (int _h = 0; _h < 2; ++_h) dst[_h][_i] = (unsigned)((u).ltab[_h * HALF + _R] >> S.shift) * rowb + (unsigned)(_C * 2); } } while (0)
#define PG8_STAGE_A(bufoff, AO, koff) do { _Pragma("unroll") for (int _i = 0; _i < 2; ++_i) \
        __builtin_amdgcn_global_load_lds((const unsigned*)((const char*)g.A + (size_t)(AO)[_i] + (size_t)(koff)), (PG8_LAS unsigned*)(lds + (bufoff) + ldsw + _i * 8192), 16, 0, 0); } while (0)
    const size_t kstep = (size_t)(BK * 2);
    const size_t hstep = (size_t)HALF * K * 2;
    const size_t tstep = 2 * hstep;
    const unsigned ldsw = (unsigned)wid * 1024u;
    const int aoff = lds_byte(wr * 64 + fr, fq * 8), boff = lds_byte(wc * 32 + fr, fq * 8);
#define PG8_SA(b, h) (((b) * 2 + (h)) * HTB)
#define PG8_SB(b, h) ((4 + (b) * 2 + (h)) * HTB)
#define PG8_STAGE(bufoff, gbase, voff) do { _Pragma("unroll") for (int _i = 0; _i < 2; ++_i) \
        __builtin_amdgcn_global_load_lds((const unsigned*)((const char*)(gbase) + (voff)[_i]), (PG8_LAS unsigned*)(lds + (bufoff) + ldsw + _i * 8192), 16, 0, 0); } while (0)
#define PG8_LDA(dst, b, h) do { _Pragma("unroll") for (int m = 0; m < 4; ++m) _Pragma("unroll") for (int k = 0; k < 2; ++k) dst[m][k] = *(const PG8_LAS bf16x8*)(lds + PG8_SA(b, h) + aoff + m * 2048 + k * 1024); } while (0)
#define PG8_LDB(dst, b, h) do { _Pragma("unroll") for (int n = 0; n < 2; ++n) _Pragma("unroll") for (int k = 0; k < 2; ++k) dst[n][k] = *(const PG8_LAS bf16x8*)(lds + PG8_SB(b, h) + boff + n * 2048 + k * 1024); } while (0)
#define PG8_MMA(ai, bj, At, Bt) do { __builtin_amdgcn_s_setprio(1); _Pragma("unroll") for (int m = 0; m < 4; ++m) _Pragma("unroll") for (int n = 0; n < 2; ++n) _Pragma("unroll") for (int k = 0; k < 2; ++k) \
        acc[ai][bj][m][n] = __builtin_amdgcn_mfma_f32_16x16x32_bf16(Bt[n][k], At[m][k], acc[ai][bj][m][n], 0, 0, 0); __builtin_amdgcn_s_setprio(0); } while (0)
#define PG8_WAIT_V(n) asm volatile("s_waitcnt vmcnt(" #n ")" ::: "memory")
#define PG8_WAIT_L(n) asm volatile("s_waitcnt lgkmcnt(" #n ")" ::: "memory")
#define PG8_BAR __builtin_amdgcn_s_barrier()
#define PG8_SCHED __builtin_amdgcn_sched_barrier(0)
    UnitG cur, nxt; int ui = 0;
    if (!S.next(0, cur)) return;
    f32x4 acc[2][2][4][2];
#pragma unroll
    for (int a = 0; a < 2; ++a)
#pragma unroll
        for (int b = 0; b < 2; ++b)
#pragma unroll
            for (int m = 0; m < 4; ++m)
#pragma unroll
                for (int n = 0; n < 2; ++n) acc[a][b][m][n] = (f32x4){0.f, 0.f, 0.f, 0.f};
    bf16x8 At[4][2], B0[2][2], B1[2][2];
    unsigned ca[2][2]; PG8_AOFFS(cur, ca); const char* cB = cur.bbase + (size_t)cur.pn * tstep;
    S.a_ready(cur);
    PG8_STAGE(PG8_SB(0, 0), cB, voffB); PG8_STAGE_A(PG8_SA(0, 0), ca[0], 0); PG8_STAGE(PG8_SB(0, 1), cB + hstep, voffB); PG8_STAGE_A(PG8_SA(0, 1), ca[1], 0);
    if (wr == 1) PG8_BAR;
    PG8_WAIT_V(4); PG8_BAR;
    PG8_STAGE(PG8_SB(1, 0), cB + kstep, voffB); PG8_STAGE_A(PG8_SA(1, 0), ca[0], kstep); PG8_STAGE(PG8_SB(1, 1), cB + hstep + kstep, voffB);
    PG8_WAIT_V(6); PG8_BAR;
    for (;;) {
        const bool has_next = S.next(ui + 1, nxt);
        const char* nB = has_next ? nxt.bbase + (size_t)nxt.pn * tstep : cB;
        for (int t = 0; t < nt; t += 2) {
            const bool last = (t == nt - 2);
            const size_t k1 = (size_t)(t + 1) * kstep, k2 = last ? 0 : (size_t)(t + 2) * kstep;
            unsigned a2o[2][2];
            if (last && has_next) PG8_AOFFS(nxt, a2o); else { a2o[0][0] = ca[0][0]; a2o[0][1] = ca[0][1]; a2o[1][0] = ca[1][0]; a2o[1][1] = ca[1][1]; }
            const char* b2 = last ? nB : cB + (size_t)(t + 2) * kstep; const char* b3 = b2 + kstep;
            if (last && has_next) S.a_ready(nxt);
            PG8_LDB(B0, 0, 0); PG8_SCHED; PG8_LDA(At, 0, 0); PG8_STAGE_A(PG8_SA(1, 1), ca[1], k1);
            PG8_WAIT_L(8); PG8_BAR; PG8_WAIT_L(0); PG8_MMA(0, 0, At, B0); PG8_BAR; PG8_SCHED;
            PG8_LDB(B1, 0, 1); PG8_STAGE(PG8_SB(0, 0), b2, voffB);
            PG8_BAR; PG8_WAIT_L(0); PG8_MMA(0, 1, At, B1); PG8_BAR;
            PG8_LDA(At, 0, 1); PG8_STAGE_A(PG8_SA(0, 0), a2o[0], k2);
            PG8_BAR; PG8_WAIT_L(0); PG8_MMA(1, 0, At, B0); PG8_BAR; PG8_SCHED;
            PG8_STAGE(PG8_SB(0, 1), b2 + hstep, voffB);
            PG8_WAIT_V(6); PG8_BAR; PG8_MMA(1, 1, At, B1); PG8_BAR;
            PG8_LDB(B0, 1, 0); PG8_SCHED; PG8_LDA(At, 1, 0); PG8_STAGE_A(PG8_SA(0, 1), a2o[1], k2);
            PG8_WAIT_L(8); PG8_BAR; PG8_WAIT_L(0); PG8_MMA(0, 0, At, B0); PG8_BAR; PG8_SCHED;
            PG8_LDB(B1, 1, 1); PG8_STAGE(PG8_SB(1, 0), b3, voffB);
            PG8_BAR; PG8_WAIT_L(0); PG8_MMA(0, 1, At, B1); PG8_BAR;
            PG8_LDA(At, 1, 1); PG8_STAGE_A(PG8_SA(1, 0), a2o[0], k2 + kstep);
            PG8_BAR; PG8_WAIT_L(0); PG8_MMA(1, 0, At, B0); PG8_BAR; PG8_SCHED;
            PG8_STAGE(PG8_SB(1, 1), b3 + hstep, voffB);
            PG8_WAIT_V(6); PG8_BAR; PG8_MMA(1, 1, At, B1); PG8_BAR;
            if (last) { ca[0][0] = a2o[0][0]; ca[0][1] = a2o[0][1]; ca[1][0] = a2o[1][0]; ca[1][1] = a2o[1][1]; }
        }
            if constexpr (!Epi::AFTER_DRAIN) { E(acc, cur, wr, wc, fr, fq); S.done(cur); }
            if (!has_next) break;
#pragma unroll
        for (int a = 0; a < 2; ++a)
#pragma unroll
            for (int b = 0; b < 2; ++b)
#pragma unroll
                for (int m = 0; m < 4; ++m)
#pragma unroll
                    for (int n = 0; n < 2; ++n) acc[a][b][m][n] = (f32x4){0.f, 0.f, 0.f, 0.f};
        cur = nxt; cB = nB; ++ui;
    }
    PG8_WAIT_V(0);
    if (wr == 0) PG8_BAR;
    PG8_BAR;
    if constexpr (Epi::AFTER_DRAIN) { E.fused(acc, cur, wr, wc, fr, fq, lds, wid, lane); S.done(cur); }
#undef PG8_SA
#undef PG8_AOFFS
#undef PG8_STAGE_A
#undef PG8_SB
#undef PG8_STAGE
#undef PG8_LDA
#undef PG8_LDB
#undef PG8_MMA
#undef PG8_WAIT_V
#undef PG8_WAIT_L
#undef PG8_BAR
#undef PG8_SCHED
}
}

__device__ __forceinline__ void transpose_item(const float* __restrict__ W, int K, int N, bf16_t* __restrict__ WT, int mode, LAS float* scr, int item, int lane) {
    const int nblk = N / 32, kb = item / nblk, nb = item % nblk, k0 = 64 * kb, n0 = 32 * nb;
#pragma unroll 8
    for (int i = 0; i < 32; ++i) { const int kk = 2 * i + (lane >> 5); scr[kk * 33 + (lane & 31)] = W[(size_t)(k0 + kk) * N + n0 + (lane & 31)]; }
    asm volatile("s_waitcnt lgkmcnt(0)" ::: "memory");
    const int c = lane & 7;
#pragma unroll
    for (int j = 0; j < 4; ++j) {
        const int nl = (lane >> 3) + 8 * j; const LAS float* s = scr + (8 * c) * 33 + nl;
        u32x4 o; o.x = pk2(s[0 * 33], s[1 * 33]); o.y = pk2(s[2 * 33], s[3 * 33]); o.z = pk2(s[4 * 33], s[5 * 33]); o.w = pk2(s[6 * 33], s[7 * 33]);
        const int n = n0 + nl;
        const int nd = mode == 0 ? n : (32 * (n >> 4) + (n & 15) + (mode == 2 ? 16 : 0));
        *(u32x4*)(WT + (size_t)nd * K + k0 + 8 * c) = o;
    }
    asm volatile("s_waitcnt lgkmcnt(0)" ::: "memory");
}

__device__ __forceinline__ void phase_prologue0(int wv, KP Pk, LAS char* lds) {
    asm volatile("" : "+s"(Pk));
    const CAS Params& P = *Pk;
    const int tid = ltid(wv), lane = tid & 63, wid = tid >> 6;
    const int gw = blockIdx.x * 8 + wid, NGW = gridDim.x * 8;
    LAS float* scr = (LAS float*)(lds + wid * 8448);
    bf16_t* winT = (bf16_t*)(P.ws + WS_WINT);
    bf16_t* woutT = (bf16_t*)(P.ws + WS_WOUTT);
    bf16_t* loraT = (bf16_t*)(P.ws + WS_LORAT);
    constexpr int I_EV = 16 * (P_EVEN / 32), I_OD = 16 * (P_ODD / 32), I_O = 16 * 32, I_L64 = 16, I_L128 = 32;
    constexpr int I_LORA = 3 * I_L64 + I_L128;
    constexpr int NIT = 2 * I_EV + 2 * I_OD + 4 * I_O + 2 * I_LORA;
    for (int it = gw; it < NIT; it += NGW) {
        int r = it;
        if (r < 2 * I_EV) { const int i = r / I_EV; transpose_item(P.ev_w_in + (size_t)i * D * P_EVEN, D, P_EVEN, winT + (i ? WINT_L2 : WINT_L0), 0, scr, r % I_EV, lane); continue; } r -= 2 * I_EV;
        if (r < 2 * I_OD) { const int i = r / I_OD; transpose_item(P.od_w_in + (size_t)i * D * P_ODD, D, P_ODD, winT + (i ? WINT_L3 : WINT_L1), 0, scr, r % I_OD, lane); continue; } r -= 2 * I_OD;
        if (r < 4 * I_O) { const int l = r / I_O; const float* src = (l & 1) ? P.od_w_out + (size_t)(l >> 1) * D * D : P.ev_w_out + (size_t)(l >> 1) * D * D;
            transpose_item(src, D, D, woutT + (size_t)l * D * D, 0, scr, r % I_O, lane); continue; } r -= 4 * I_O;
        { const int i = r / I_LORA; int q = r % I_LORA; bf16_t* dst = loraT + (size_t)i * LORA_PER;
          if (q < I_L64) { transpose_item(P.rw_w2 + (size_t)(i * 2 + 0) * 64 * 512, 64, 512, dst, 0, scr, q, lane); continue; } q -= I_L64;
          if (q < I_L64) { transpose_item(P.rw_w2 + (size_t)(i * 2 + 1) * 64 * 512, 64, 512, dst + 512 * 64, 0, scr, q, lane); continue; } q -= I_L64;
          if (q < I_L64) { transpose_item(P.rw_a2 + (size_t)i * 64 * 512, 64, 512, dst + 2 * 512 * 64, 0, scr, q, lane); continue; } q -= I_L64;
          transpose_item(P.rw_g2 + (size_t)i * 128 * 512, 128, 512, dst + 3 * 512 * 64, 0, scr, q, lane); }
    }
    {
        const int gt = blockIdx.x * NT + tid, NG = gridDim.x * NT;
        constexpr int PADE = (LDP_EVEN - P_EVEN) * D / 8, PADO = (LDP_ODD - P_ODD) * D / 8;
        for (int i = gt; i < 2 * PADE + 2 * PADO; i += NG) {
            int r = i; bf16_t* dst;
            if (r < 2 * PADE) { const int l = r / PADE; dst = winT + (l ? WINT_L2 : WINT_L0) + (size_t)P_EVEN * D + (size_t)(r % PADE) * 8; }
            else { r -= 2 * PADE; const int l = r / PADO; dst = winT + (l ? WINT_L3 : WINT_L1) + (size_t)P_ODD * D + (size_t)(r % PADO) * 8; }
            *(u32x4*)dst = (u32x4){0u, 0u, 0u, 0u};
        }
    }
    {
        const int gt = blockIdx.x * NT + tid, NG = gridDim.x * NT;
        float* xc = (float*)(P.ws + WS_XC);
        for (int i = gt; i < NCTX * D / 4; i += NG) ((f32x4*)xc)[i] = ((const f32x4*)P.ctx)[i];
        float* lb = (float*)(P.ws + WS_LB);
        for (int ch = gt; ch < 512; ch += NG) {
            float lg[4], mx = -1e30f;
#pragma unroll
            for (int l = 0; l < 4; ++l) { lg[l] = P.hg_lb_logits[l * 512 + ch]; mx = fmaxf(mx, lg[l]); }
            float e[4], s = 0.f;
#pragma unroll
            for (int l = 0; l < 4; ++l) { e[l] = __expf(lg[l] - mx); s += e[l]; }
            float cum = 0.f;
#pragma unroll
            for (int l = 0; l < 4; ++l) { if (l > 0) cum += e[l] / s; lb[l * 512 + ch] = cum; }
        }
    }
    __syncthreads();
    {
        LAS float* sc = (LAS float*)lds;
        LAS float* red = (LAS float*)(lds + 5 * 1024 * 4);
        for (int i = tid; i < 5 * D; i += NT) { const int m = i >> 10, k = i & 1023; const float v = m < 4 ? P.c[m * D + k] : P.c_ctx[k]; sc[i] = siluf_(v); }
        __syncthreads();
        float* modv = (float*)(P.ws + WS_MODV);
        const int col = tid & 127, kq = tid >> 7;
        for (int item = blockIdx.x; item < 4 * 48; item += gridDim.x) {
            const int l = item / 48, j = (item % 48) * 128 + col;
            const float* w = P.mod_w + (size_t)l * D * 6144 + j;
            float a[5] = {0.f, 0.f, 0.f, 0.f, 0.f};
#pragma unroll 8
            for (int k = kq * 256; k < kq * 256 + 256; ++k) {
                const float wv = w[(size_t)k * 6144];
#pragma unroll
                for (int m = 0; m < 5; ++m) a[m] += sc[m * 1024 + k] * wv;
            }
#pragma unroll
            for (int m = 0; m < 5; ++m) red[(kq * 128 + col) * 5 + m] = a[m];
            __syncthreads();
            if (kq == 0) {
                const float bias = P.mod_b[l * 6144 + j];
#pragma unroll
                for (int m = 0; m < 5; ++m) {
                    const float s = red[(0 * 128 + col) * 5 + m] + red[(1 * 128 + col) * 5 + m] + red[(2 * 128 + col) * 5 + m] + red[(3 * 128 + col) * 5 + m];
                    modv[(size_t)(l * 5 + m) * 6144 + j] = s + bias;
                }
            }
            __syncthreads();
        }
    }
}

__device__ __forceinline__ void phase_prologue1(int wv, KP Pk) {
    asm volatile("" : "+s"(Pk));
    const CAS Params& P = *Pk;
    const int tid = ltid(wv), lane = tid & 63, wid = tid >> 6;
    bf16_t* act = (bf16_t*)(P.ws + WS_ACT);
    for (int r = blockIdx.x * 8 + wid; r < NROWS; r += gridDim.x * 8) {
        const int m = row_mod(r);
        const float* src = r < NCTX ? P.ctx + (size_t)r * D : P.x + (size_t)(r - NCTX) * D;
        const float* sh = modvec(P.ws, 0, m, 0); const float* sc = modvec(P.ws, 0, m, 1);
#pragma unroll
        for (int i = 0; i < 4; ++i) {
            const int c = 4 * lane + 256 * i;
            const f32x4 v = *(const f32x4*)(src + c), s1 = *(const f32x4*)(sc + c), h1 = *(const f32x4*)(sh + c);
            if (r >= NCTX) *(f32x4*)(P.out + (size_t)(r - NCTX) * D + c) = v;
            u32x2 o; o.x = pk2(v[0] * (1.f + s1[0]) + h1[0], v[1] * (1.f + s1[1]) + h1[1]); o.y = pk2(v[2] * (1.f + s1[2]) + h1[2], v[3] * (1.f + s1[3]) + h1[3]);
            *(u32x2*)(act + (size_t)r * D + c) = o;
        }
    }
}

__device__ __forceinline__ void phase_inproj(int wv, KP Pk, int layer, LAS char* lds) {
    asm volatile("" : "+s"(Pk));
    const CAS Params& P = *Pk;
    const int odd = layer & 1, ldp = odd ? LDP_ODD : LDP_EVEN;
    const size_t woff = layer == 0 ? WINT_L0 : layer == 1 ? WINT_L1 : layer == 2 ? WINT_L2 : WINT_L3;
    pg8::Gemm g{(const bf16_t*)(P.ws + WS_ACT), (const bf16_t*)(P.ws + WS_WINT) + woff, NROWS, ldp, D};
    pg8::StaticOrder S; S.init(NROWS, ldp, (int)gridDim.x, (int)blockIdx.x);
    pg8::EpiStoreP E{(bf16_t*)(P.ws + WS_P), ldp};
    pg8::gemm_phase(wv, (PG8_LAS unsigned char*)lds, g, S, E);
}
__device__ __forceinline__ void phase_outproj(int wv, KP Pk, int layer, LAS char* lds) {
    asm volatile("" : "+s"(Pk));
    const CAS Params& P = *Pk;
    const int r0 = (layer == DEPTH - 1) ? NCTX : 0;
    pg8::Gemm g{(const bf16_t*)(P.ws + WS_FEAT) + (size_t)r0 * D, (const bf16_t*)(P.ws + WS_WOUTT) + (size_t)layer * D * D, NROWS - r0, D, D};
    pg8::StaticOrder S; S.init(NROWS - r0, D, (int)gridDim.x, (int)blockIdx.x);
    pg8::EpiStoreP E{(bf16_t*)(P.ws + WS_YO) + (size_t)r0 * D, D};
    pg8::gemm_phase(wv, (PG8_LAS unsigned char*)lds, g, S, E);
}
__device__ __forceinline__ void phase_prep2(int wv, KP Pk, int layer, LAS char* lds) {
    asm volatile("" : "+s"(Pk));
    const CAS Params& P = *Pk;
    const int i = layer >> 1;
    const bf16_t* la = (const bf16_t*)(P.ws + WS_LA);
    const bf16_t* lt = (const bf16_t*)(P.ws + WS_LORAT) + (size_t)i * LORA_PER;
    constexpr int MT = NROWS / G_BM, NTL = 512 / G_BN;
    const int ntiles = 4 * MT * NTL;
    for (int t = blockIdx.x; t < ntiles; t += gridDim.x) {
        const int which = t / (MT * NTL), r = t % (MT * NTL), mt = r / NTL, nt = r % NTL;
        RowLinear rs{mt * G_BM};
        if (which < 2) {
            EpiDecay epi{(float*)(P.ws + WS_RWDEC) + (size_t)which * NROWS * 512, P.rw_w0 + (size_t)(i * 2 + which) * 512, mt * G_BM, nt * G_BN};
            gemm_tile(wv, la + which * 64, 320, rs, lt + (size_t)which * 512 * 64, 64, nt * G_BN, 64, epi, lds);
        } else if (which == 2) {
            EpiAK epi{(bf16_t*)(P.ws + WS_RWK), (const bf16_t*)(P.ws + WS_RWKK), (bf16_t*)(P.ws + WS_RWB), P.rw_a0 + i * 512, P.rw_k_a + i * 512, mt * G_BM, nt * G_BN};
            gemm_tile(wv, la + 128, 320, rs, lt + (size_t)2 * 512 * 64, 64, nt * G_BN, 64, epi, lds);
        } else {
            EpiStoreBf16 epi{(bf16_t*)(P.ws + WS_RWG), 512, mt * G_BM, nt * G_BN, 512};
            gemm_tile(wv, la + 192, 320, rs, lt + (size_t)3 * 512 * 64, 128, nt * G_BN, 128, epi, lds);
        }
    }
}
__device__ __forceinline__ void moe_tiles(const unsigned char* ws, int layer, LAS int* tstart, LAS int* tcnt) {
    if (threadIdx.x == 0) {
        const int* cnt = (const int*)(ws + WS_CNT) + layer * 32 * CNT_STRIDE;
        int acc = 0;
        for (int e = 0; e < NEXP; ++e) { const int c = cnt[e * CNT_STRIDE]; tcnt[e] = c; tstart[e] = acc; acc += (c + G_BM - 1) / G_BM; }
        tstart[NEXP] = acc;
    }
    __syncthreads();
}
__device__ __forceinline__ void phase_moe1(int wv, KP Pk, int layer, LAS char* lds) {
    asm volatile("" : "+s"(Pk));
    const CAS Params& P = *Pk;
    LAS int* tstart = (LAS int*)(lds + pg8::STAGE_BYTES); LAS int* tcnt = tstart + 40;
    moe_tiles(P.ws, layer, tstart, tcnt);
    pg8::Gemm g{(const bf16_t*)(P.ws + WS_ACT), (const bf16_t*)(P.ws + WS_EXPGU), 0, 1024, D};
    LAS int* ltabs = tstart + 128;
    pg8::MoeOrder S{tstart, tcnt, ltabs, (const int*)(P.ws + WS_LIST), (const char*)(P.ws + WS_EXPGU), (size_t)1024 * 1024 * 2, 4, 1, (int)gridDim.x, (int)blockIdx.x};
    pg8::EpiSwiGLUG E{(bf16_t*)(P.ws + WS_HID)};
    for (int i = 0; i < 8; ++i) {
        pg8::UnitG u; if (!S.next(i, u)) break;
        const int tl = ltid(wv);
        const int* ul = (const int*)(P.ws + WS_LIST) + (size_t)u.e * LISTCAP + u.pm * pg8::BM;
        if (tl < pg8::BM) ltabs[i * pg8::BM + tl] = ul[tl < u.cnt ? tl : 0];
    }
    __syncthreads();
    pg8::gemm_phase_g(wv, (PG8_LAS unsigned char*)lds, g, S, E);
    __syncthreads();
}
__device__ __forceinline__ void phase_moe2(int wv, KP Pk, int layer, LAS char* lds) {
    asm volatile("" : "+s"(Pk));
    const CAS Params& P = *Pk;
    LAS int* tstart = (LAS int*)(lds + pg8::STAGE_BYTES); LAS int* tcnt = tstart + 40;
    moe_tiles(P.ws, layer, tstart, tcnt);
    pg8::Gemm g{(const bf16_t*)(P.ws + WS_HID), (const bf16_t*)(P.ws + WS_EXPD), 0, 1024, DEXP};
    LAS int* ltabs = tstart + 128;
    pg8::MoeOrder S{tstart, tcnt, ltabs, (const int*)(P.ws + WS_LIST), (const char*)(P.ws + WS_EXPD), (size_t)1024 * 512 * 2, 4, 0, (int)gridDim.x, (int)blockIdx.x};
    pg8::EpiScatterG E{(bf16_t*)(P.ws + WS_YP)};
    for (int i = 0; i < 8; ++i) {
        pg8::UnitG u; if (!S.next(i, u)) break;
        const int tl = ltid(wv);
        const int* ul = (const int*)(P.ws + WS_LIST) + (size_t)u.e * LISTCAP + u.pm * pg8::BM;
        if (tl < pg8::BM) ltabs[i * pg8::BM + tl] = ul[tl < u.cnt ? tl : 0];
    }
    __syncthreads();
    pg8::gemm_phase_g(wv, (PG8_LAS unsigned char*)lds, g, S, E);
    __syncthreads();
}

constexpr int NCHUNK = NSTEPS / TCH;

constexpr int SSD_F = 32 + 64 + 64;
constexpr int SSD_BUF = TCH * SSD_F + 3 * TCH;
__device__ __forceinline__ void scan_ssd(int wv, KP Pk, int layer, int unit, LAS char* lds) {
    asm volatile("" : "+s"(Pk));
    const CAS Params& P = *Pk;
    const int tid = ltid(wv), i_ = layer >> 1;
    const int seq = unit >> 1, half = unit & 1, b = seq >> 4, h = (seq >> 1) & 7, dir = seq & 1, grp = h >> 2;
    LAS float* cw = (LAS float*)lds;
    LAS float* bufs = cw + 4 * 160;
    const bf16_t* Pb = (const bf16_t*)(P.ws + WS_P);
    bf16_t* Y = (bf16_t*)(P.ws + (dir ? WS_YB : WS_YF));
    for (int i = tid; i < 4 * 160; i += NT) {
        const int tap = i / 160, lc = i % 160, g = lc >> 3, e = lc & 7;
        const int ch = g < 4 ? (h * 64 + half * 32 + 8 * g + e) : g < 12 ? (512 + grp * 64 + 8 * (g - 4) + e) : (640 + grp * 64 + 8 * (g - 12) + e);
        cw[i] = tap < 3 ? P.ssd_conv_w[(size_t)(i_ * 3 + tap) * 768 + ch] : P.ssd_conv_b[i_ * 768 + ch];
    }
    const float dtb = P.ssd_dt_bias[(i_ * 2 + dir) * 8 + h], aco = -__expf(P.ssd_a_log[(i_ * 2 + dir) * 8 + h]);
    int tj[2], tg_[2], tcol[2]; bool tv[2];
#pragma unroll
    for (int s = 0; s < 2; ++s) {
        const int task = tid + NT * s; tv[s] = task < 640; tj[s] = task / 20; tg_[s] = task % 20;
        const int g = tg_[s];
        tcol[s] = g < 4 ? (512 + h * 64 + half * 32 + 8 * g) : g < 12 ? (1024 + grp * 64 + 8 * (g - 4)) : (1152 + grp * 64 + 8 * (g - 12));
    }
    u32x4 rp[2], rc[2], rn[2]; float rdt = 0.f; int rrow = 0;
    auto load = [&](int c) {
#pragma unroll
        for (int s = 0; s < 2; ++s) {
            rp[s] = rc[s] = rn[s] = (u32x4){0u, 0u, 0u, 0u};
            if (tv[s]) {
                const int row = scan_row(c * TCH + tj[s], b, dir, 0); int t, len; row_seg(row, t, len);
                const bf16_t* p = Pb + (size_t)row * LDP_EVEN + tcol[s];
                rc[s] = *(const u32x4*)p;
                if (t > 0) rp[s] = *(const u32x4*)(p - LDP_EVEN);
                if (t < len - 1) rn[s] = *(const u32x4*)(p + LDP_EVEN);
            }
        }
        if (tid < TCH) { rrow = scan_row(c * TCH + tid, b, dir, 0); rdt = bf2f(Pb[(size_t)rrow * LDP_EVEN + 1280 + dir * 8 + h]); }
    };
    auto store = [&](int c) {
        LAS float* buf = bufs + (c & 1) * SSD_BUF;
#pragma unroll
        for (int s = 0; s < 2; ++s) {
            if (tv[s]) {
                float fp[8], fc[8], fn[8], o[8]; unpack8(rp[s], fp); unpack8(rc[s], fc); unpack8(rn[s], fn);
                const int lc = tg_[s] * 8;
#pragma unroll
                for (int e = 0; e < 8; ++e) o[e] = siluf_(cw[lc + e] * fp[e] + cw[160 + lc + e] * fc[e] + cw[320 + lc + e] * fn[e] + cw[480 + lc + e]);
                LAS float* dst = buf + tj[s] * SSD_F + lc;
                *(LAS f32x4*)dst = (f32x4){o[0], o[1], o[2], o[3]}; *(LAS f32x4*)(dst + 4) = (f32x4){o[4], o[5], o[6], o[7]};
            }
        }
        if (tid < TCH) {
            const float dt = softplusf_(rdt + dtb);
            buf[TCH * SSD_F + tid] = __expf(dt * aco); buf[TCH * SSD_F + TCH + tid] = dt; ((LAS int*)buf)[TCH * SSD_F + 2 * TCH + tid] = rrow;
        }
    };
    const int prow = tid >> 4, q = tid & 15;
    float hs[4] = {0.f, 0.f, 0.f, 0.f};
    __syncthreads();
    load(0); store(0); __syncthreads();
    for (int c = 0; c < NCHUNK; ++c) {
        if (c + 1 < NCHUNK) load(c + 1);
        LAS float* buf = bufs + (c & 1) * SSD_BUF;
        {
            const LAS float* xp = buf + prow;
            const LAS float* bp = buf + 32 + 4 * q;
            const LAS float* aux = buf + TCH * SSD_F;
            f32x4 B4 = *(const LAS f32x4*)bp, C4 = *(const LAS f32x4*)(bp + 64); float xr = xp[0];
#pragma unroll 1
            for (int jh = 0; jh < 2; ++jh) {
                float ysel = 0.f;
                f32x4 dA4, dt4;
#pragma unroll
                for (int j = 0; j < 16; ++j) {
                    const int jj = jh * 16 + j;
                    if ((j & 3) == 0) { dA4 = *(const LAS f32x4*)(aux + jj); dt4 = *(const LAS f32x4*)(aux + TCH + jj); }
                    const f32x4 Bc = B4, Cc = C4; const float xc = xr;
                    if (j < 15 || jh == 0) { B4 = *(const LAS f32x4*)(bp + (jj + 1) * SSD_F); C4 = *(const LAS f32x4*)(bp + 64 + (jj + 1) * SSD_F); xr = xp[(jj + 1) * SSD_F]; }
                    const float dA = dA4[j & 3], xv = xc * dt4[j & 3];
                    float y = 0.f;
#pragma unroll
                    for (int e = 0; e < 4; ++e) { hs[e] = dA * hs[e] + xv * Bc[e]; y += Cc[e] * hs[e]; }
                    y = allreduce16(y);
                    ysel = (q == j) ? y : ysel;
                }
                const int row = ((const LAS int*)aux)[2 * TCH + jh * 16 + q];
                Y[(size_t)row * D + h * 64 + half * 32 + prow] = f2bf(ysel);
            }
        }
        if (c + 1 < NCHUNK) store(c + 1);
        __syncthreads();
    }
}

constexpr int ML_F = 64 + 64 + 32;
constexpr int ML_BUF = TCH * ML_F + 4 * TCH;
__device__ __forceinline__ void scan_mlstm(int wv, KP Pk, int layer, int unit, LAS char* lds) {
    asm volatile("" : "+s"(Pk));
    const CAS Params& P = *Pk;
    const int tid = ltid(wv), i_ = layer >> 1;
    const int seq = unit >> 2, quarter = unit & 3, b = seq >> 3, h = (seq >> 1) & 3, dir = seq & 1;
    LAS float* cw = (LAS float*)lds;
    LAS float* bufs = cw + 4 * 128;
    const bf16_t* Pb = (const bf16_t*)(P.ws + WS_P);
    bf16_t* Y = (bf16_t*)(P.ws + (dir ? WS_YB : WS_YF));
    for (int i = tid; i < 4 * 128; i += NT) {
        const int tap = i >> 7, lc = i & 127;
        const int ch = lc < 64 ? (h * 64 + lc) : (256 + h * 64 + lc - 64);
        cw[i] = tap < 3 ? P.ml_conv_w[(size_t)(i_ * 3 + tap) * 512 + ch] : P.ml_conv_b[i_ * 512 + ch];
    }
    const float ib = P.ml_i_bias[(i_ * 2 + dir) * 4 + h], fb = P.ml_f_bias[(i_ * 2 + dir) * 4 + h];
    int tj[2], tg_[2], tcol[2]; bool tv[2];
#pragma unroll
    for (int s = 0; s < 2; ++s) {
        const int task = tid + NT * s; tv[s] = task < 640; tj[s] = task / 20; tg_[s] = task % 20;
        const int g = tg_[s];
        tcol[s] = 1296 + (g < 8 ? (h * 64 + 8 * g) : g < 16 ? (256 + h * 64 + 8 * (g - 8)) : (512 + h * 128 + quarter * 32 + 8 * (g - 16)));
    }
    u32x4 rp[2], rc[2], rn[2]; float rgi = 0.f, rgf = 0.f; int rrow = 0;
    float mcarry = -1e30f;
    auto load = [&](int c) {
#pragma unroll
        for (int s = 0; s < 2; ++s) {
            rp[s] = rc[s] = rn[s] = (u32x4){0u, 0u, 0u, 0u};
            if (tv[s]) {
                const int row = scan_row(c * TCH + tj[s], b, dir, 0); int t, len; row_seg(row, t, len);
                const bf16_t* p = Pb + (size_t)row * LDP_EVEN + tcol[s];
                rc[s] = *(const u32x4*)p;
                if (tg_[s] < 16) { if (t > 0) rp[s] = *(const u32x4*)(p - LDP_EVEN); if (t < len - 1) rn[s] = *(const u32x4*)(p + LDP_EVEN); }
            }
        }
        if (tid < TCH) {
            rrow = scan_row(c * TCH + tid, b, dir, 0);
            const bf16_t* g = Pb + (size_t)rrow * LDP_EVEN + 1296 + 1536;
            rgi = bf2f(g[dir * 4 + h]); rgf = bf2f(g[8 + dir * 4 + h]);
        }
    };
    auto store = [&](int c) {
        LAS float* buf = bufs + (c & 1) * ML_BUF;
#pragma unroll
        for (int s = 0; s < 2; ++s) {
            if (tv[s]) {
                float fp[8], fc[8], fn[8], o[8]; unpack8(rp[s], fp); unpack8(rc[s], fc); unpack8(rn[s], fn);
                const int g = tg_[s], lc = g * 8;
                if (g < 16) {
                    const float scl = g < 8 ? 0.125f : 1.f;
#pragma unroll
                    for (int e = 0; e < 8; ++e) o[e] = scl * siluf_(cw[lc + e] * fp[e] + cw[128 + lc + e] * fc[e] + cw[256 + lc + e] * fn[e] + cw[384 + lc + e]);
                } else {
#pragma unroll
                    for (int e = 0; e < 8; ++e) o[e] = fc[e];
                }
                LAS float* dst = buf + tj[s] * ML_F + lc;
                *(LAS f32x4*)dst = (f32x4){o[0], o[1], o[2], o[3]}; *(LAS f32x4*)(dst + 4) = (f32x4){o[4], o[5], o[6], o[7]};
            }
        }
        if (tid < 64) {
            const int l = tid & 31;
            const float li = rgi + ib, lf = logsigmoidf_(rgf + fb);
            float F = lf;
#pragma unroll
            for (int o = 1; o < 32; o <<= 1) { const float t = __shfl_up(F, o, 32); if (l >= o) F += t; }
            float cm = li - F;
#pragma unroll
            for (int o = 1; o < 32; o <<= 1) { const float t = __shfl_up(cm, o, 32); if (l >= o) cm = fmaxf(cm, t); }
            const float m = F + fmaxf(mcarry, cm);
            float mprev = __shfl_up(m, 1, 32); if (l == 0) mprev = mcarry;
            const float sp = __expf(lf + mprev - m), sl = __expf(li - m), em = __expf(-m);
            if (tid < TCH) { buf[TCH * ML_F + tid] = sp; buf[TCH * ML_F + TCH + tid] = sl; buf[TCH * ML_F + 2 * TCH + tid] = em; ((LAS int*)buf)[TCH * ML_F + 3 * TCH + tid] = rrow; }
            mcarry = __shfl(m, 31, 32);
        }
    };
    const int col = tid >> 4, q = tid & 15;
    float Cs[4] = {0.f, 0.f, 0.f, 0.f}, ns[4] = {0.f, 0.f, 0.f, 0.f};
    __syncthreads();
    load(0); store(0); __syncthreads();
    for (int c = 0; c < NCHUNK; ++c) {
        if (c + 1 < NCHUNK) load(c + 1);
        LAS float* buf = bufs + (c & 1) * ML_BUF;
        {
            const LAS float* qp = buf + 4 * q;
            const LAS float* vp = buf + 128 + col;
            const LAS float* aux = buf + TCH * ML_F;
            f32x4 q4 = *(const LAS f32x4*)qp, k4 = *(const LAS f32x4*)(qp + 64); float vr = vp[0];
#pragma unroll 1
            for (int jh = 0; jh < 2; ++jh) {
                float nsel = 0.f, dsel = 1.f;
                f32x4 sp4, sl4;
#pragma unroll
                for (int j = 0; j < 16; ++j) {
                    const int jj = jh * 16 + j;
                    if ((j & 3) == 0) { sp4 = *(const LAS f32x4*)(aux + jj); sl4 = *(const LAS f32x4*)(aux + TCH + jj); }
                    const f32x4 qc = q4, kc = k4; const float vv = vr;
                    if (j < 15 || jh == 0) { q4 = *(const LAS f32x4*)(qp + (jj + 1) * ML_F); k4 = *(const LAS f32x4*)(qp + 64 + (jj + 1) * ML_F); vr = vp[(jj + 1) * ML_F]; }
                    const float sp = sp4[j & 3], sl = sl4[j & 3];
                    float num = 0.f, den = 0.f;
#pragma unroll
                    for (int e = 0; e < 4; ++e) { const float sk = sl * kc[e]; Cs[e] = sp * Cs[e] + sk * vv; ns[e] = sp * ns[e] + sk; num += qc[e] * Cs[e]; den += qc[e] * ns[e]; }
                    num = allreduce16(num); den = allreduce16(den);
                    nsel = (q == j) ? num : nsel; dsel = (q == j) ? den : dsel;
                }
                const float em = aux[2 * TCH + jh * 16 + q];
                const int row = ((const LAS int*)aux)[3 * TCH + jh * 16 + q];
                Y[(size_t)row * D + 512 + h * 128 + quarter * 32 + col] = f2bf(nsel * __builtin_amdgcn_rcpf(fmaxf(fabsf(dsel), em)));
            }
        }
        if (c + 1 < NCHUNK) store(c + 1);
        __syncthreads();
    }
}

constexpr int HG_F = 128 + 128 + 32;
constexpr int HG_BUF = TCH * HG_F + TCH;
__device__ __forceinline__ void scan_hgrn(int wv, KP Pk, int layer, int unit, LAS char* lds) {
    asm volatile("" : "+s"(Pk));
    const CAS Params& P = *Pk;
    const int tid = ltid(wv), i_ = layer >> 1;
    const int seq = unit >> 2, quarter = unit & 3, b = seq >> 3, h = (seq >> 1) & 3, dir = seq & 1;
    LAS float* cst = (LAS float*)lds;
    LAS float* bufs = cst + 256;
    const bf16_t* Pb = (const bf16_t*)(P.ws + WS_P);
    bf16_t* Y = (bf16_t*)(P.ws + (dir ? WS_YB : WS_YF));
    if (tid < 128) cst[tid] = ((const float*)(P.ws + WS_LB))[layer * 512 + h * 128 + tid];
    else if (tid < 256) cst[tid] = P.hg_f_bias[(size_t)(i_ * 2 + dir) * 512 + h * 128 + tid - 128];
    int tj[3], tg_[3], tcol[3]; bool tv[3];
#pragma unroll
    for (int s = 0; s < 3; ++s) {
        const int task = tid + NT * s; tv[s] = task < TCH * 36; tj[s] = task / 36; tg_[s] = task % 36;
        const int g = tg_[s];
        tcol[s] = g < 16 ? (512 + dir * 512 + h * 128 + 8 * g) : g < 32 ? (h * 128 + 8 * (g - 16)) : (1536 + h * 128 + quarter * 32 + 8 * (g - 32));
    }
    u32x4 rc[3]; int rrow = 0;
    auto load = [&](int c) {
#pragma unroll
        for (int s = 0; s < 3; ++s) {
            rc[s] = (u32x4){0u, 0u, 0u, 0u};
            if (tv[s]) { const int row = scan_row(c * TCH + tj[s], b, dir, 1); rc[s] = *(const u32x4*)(Pb + (size_t)row * LDP_ODD + tcol[s]); }
        }
        if (tid < TCH) rrow = scan_row(c * TCH + tid, b, dir, 1);
    };
    auto store = [&](int c) {
        LAS float* buf = bufs + (c & 1) * HG_BUF;
#pragma unroll
        for (int s = 0; s < 3; ++s) {
            if (tv[s]) {
                float fc[8], o[8]; unpack8(rc[s], fc);
                const int g = tg_[s], lc = g * 8;
                if (g < 16) {
#pragma unroll
                    for (int e = 0; e < 8; ++e) { const float lbv = cst[lc + e]; o[e] = lbv + (1.f - lbv) * sigmoidf_(fc[e] + cst[128 + lc + e]); }
                } else if (g < 32) {
#pragma unroll
                    for (int e = 0; e < 8; ++e) o[e] = siluf_(fc[e]);
                } else {
#pragma unroll
                    for (int e = 0; e < 8; ++e) o[e] = fc[e];
                }
                LAS float* dst = buf + tj[s] * HG_F + lc;
                *(LAS f32x4*)dst = (f32x4){o[0], o[1], o[2], o[3]}; *(LAS f32x4*)(dst + 4) = (f32x4){o[4], o[5], o[6], o[7]};
            }
        }
        if (tid < TCH) ((LAS int*)buf)[TCH * HG_F + tid] = rrow;
    };
    const int col = tid >> 4, q = tid & 15;
    float S[8];
#pragma unroll
    for (int e = 0; e < 8; ++e) S[e] = 0.f;
    __syncthreads();
    load(0); store(0); __syncthreads();
    for (int c = 0; c < NCHUNK; ++c) {
        if (c + 1 < NCHUNK) load(c + 1);
        LAS float* buf = bufs + (c & 1) * HG_BUF;
        {
            const LAS float* fp = buf + 4 * q;
            const LAS float* vp = buf + 256 + col;
            f32x4 f0 = *(const LAS f32x4*)fp, f1 = *(const LAS f32x4*)(fp + 64), q0 = *(const LAS f32x4*)(fp + 128), q1 = *(const LAS f32x4*)(fp + 192); float vr = vp[0];
#pragma unroll 1
            for (int jh = 0; jh < 2; ++jh) {
                float ysel = 0.f;
#pragma unroll
                for (int j = 0; j < 16; ++j) {
                    const int jj = jh * 16 + j;
                    const f32x4 f0c = f0, f1c = f1, q0c = q0, q1c = q1; const float vv = vr;
                    if (j < 15 || jh == 0) {
                        const LAS float* np = fp + (jj + 1) * HG_F;
                        f0 = *(const LAS f32x4*)np; f1 = *(const LAS f32x4*)(np + 64); q0 = *(const LAS f32x4*)(np + 128); q1 = *(const LAS f32x4*)(np + 192); vr = vp[(jj + 1) * HG_F];
                    }
                    float o = 0.f;
#pragma unroll
                    for (int e = 0; e < 4; ++e) { S[e] = f0c[e] * (S[e] - vv) + vv; o += q0c[e] * S[e]; S[4 + e] = f1c[e] * (S[4 + e] - vv) + vv; o += q1c[e] * S[4 + e]; }
                    o = allreduce16(o);
                    ysel = (q == j) ? o : ysel;
                }
                const int row = ((const LAS int*)buf)[TCH * HG_F + jh * 16 + q];
                Y[(size_t)row * D + h * 128 + quarter * 32 + col] = f2bf(ysel);
            }
        }
        if (c + 1 < NCHUNK) store(c + 1);
        __syncthreads();
    }
}

constexpr int RW_F = 5 * 64 + 32;
constexpr int RW_BUF = TCH * RW_F + TCH;
__device__ __forceinline__ void scan_rwkv(int wv, KP Pk, int layer, int unit, LAS char* lds) {
    asm volatile("" : "+s"(Pk));
    const CAS Params& P = *Pk;
    const int tid = ltid(wv);
    const int seq = unit >> 1, half = unit & 1, b = seq >> 4, h = (seq >> 1) & 7, dir = seq & 1;
    LAS float* bufs = (LAS float*)lds;
    bf16_t* Y = (bf16_t*)(P.ws + (dir ? WS_YB : WS_YF));
    const float* dec = (const float*)(P.ws + WS_RWDEC) + (size_t)dir * NROWS * 512;
    int tj[4], tg_[4]; bool tv[4]; const unsigned char* tbase[4]; int tlds[4];
#pragma unroll
    for (int s = 0; s < 4; ++s) {
        const int task = tid + NT * s; tv[s] = task < TCH * 52; tj[s] = task / 52; tg_[s] = task % 52;
        const int g = tg_[s];
        if (g < 8)       { tbase[s] = P.ws + WS_RWR  + (size_t)(h * 64 + 8 * g) * 2;              tlds[s] = 256 + 8 * g; }
        else if (g < 16) { tbase[s] = P.ws + WS_RWK  + (size_t)(h * 64 + 8 * (g - 8)) * 2;        tlds[s] = 192 + 8 * (g - 8); }
        else if (g < 24) { tbase[s] = P.ws + WS_RWKK + (size_t)(h * 64 + 8 * (g - 16)) * 2;       tlds[s] = 64 + 8 * (g - 16); }
        else if (g < 32) { tbase[s] = P.ws + WS_RWB  + (size_t)(h * 64 + 8 * (g - 24)) * 2;       tlds[s] = 128 + 8 * (g - 24); }
        else if (g < 36) { tbase[s] = P.ws + WS_RWV  + (size_t)(h * 64 + half * 32 + 8 * (g - 32)) * 2; tlds[s] = 320 + 8 * (g - 32); }
        else             { tbase[s] = (const unsigned char*)(dec + h * 64 + 4 * (g - 36));        tlds[s] = 4 * (g - 36); }
    }
    u32x4 rc[4]; int rrow = 0;
    auto load = [&](int c) {
#pragma unroll
        for (int s = 0; s < 4; ++s) {
            rc[s] = (u32x4){0u, 0u, 0u, 0u};
            if (tv[s]) { const int row = scan_row(c * TCH + tj[s], b, dir, 1); rc[s] = *(const u32x4*)(tbase[s] + (size_t)row * (tg_[s] < 36 ? 1024 : 2048)); }
        }
        if (tid < TCH) rrow = scan_row(c * TCH + tid, b, dir, 1);
    };
    auto store = [&](int c) {
        LAS float* buf = bufs + (c & 1) * RW_BUF;
#pragma unroll
        for (int s = 0; s < 4; ++s) {
            if (tv[s]) {
                LAS float* dst = buf + tj[s] * RW_F + tlds[s];
                const int g = tg_[s];
                if (g >= 36) { *(LAS u32x4*)dst = rc[s]; }
                else {
                    float f[8]; unpack8(rc[s], f);
                    const float sg = (g >= 16 && g < 24) ? -1.f : 1.f;
                    *(LAS f32x4*)dst = (f32x4){sg * f[0], sg * f[1], sg * f[2], sg * f[3]}; *(LAS f32x4*)(dst + 4) = (f32x4){sg * f[4], sg * f[5], sg * f[6], sg * f[7]};
                }
            }
        }
        if (tid < TCH) ((LAS int*)buf)[TCH * RW_F + tid] = rrow;
    };
    const int vrow = tid >> 4, q = tid & 15;
    float S[4] = {0.f, 0.f, 0.f, 0.f};
    load(0); store(0); __syncthreads();
    for (int c = 0; c < NCHUNK; ++c) {
        if (c + 1 < NCHUNK) load(c + 1);
        LAS float* buf = bufs + (c & 1) * RW_BUF;
        {
            const LAS float* wp = buf + 4 * q;
            const LAS float* vp = buf + 320 + vrow;
            f32x4 w4 = *(const LAS f32x4*)wp, a4 = *(const LAS f32x4*)(wp + 64), b4 = *(const LAS f32x4*)(wp + 128), k4 = *(const LAS f32x4*)(wp + 192), r4 = *(const LAS f32x4*)(wp + 256); float vr = vp[0];
#pragma unroll 1
            for (int jh = 0; jh < 2; ++jh) {
                float ysel = 0.f;
#pragma unroll
                for (int j = 0; j < 16; ++j) {
                    const int jj = jh * 16 + j;
                    const f32x4 wc = w4, ac = a4, bc = b4, kc = k4, rc = r4; const float vv = vr;
                    if (j < 15 || jh == 0) {
                        const LAS float* np = wp + (jj + 1) * RW_F;
                        w4 = *(const LAS f32x4*)np; a4 = *(const LAS f32x4*)(np + 64); b4 = *(const LAS f32x4*)(np + 128); k4 = *(const LAS f32x4*)(np + 192); r4 = *(const LAS f32x4*)(np + 256); vr = vp[(jj + 1) * RW_F];
                    }
                    float sa = S[0] * ac[0] + S[1] * ac[1] + S[2] * ac[2] + S[3] * ac[3];
                    sa = allreduce16(sa);
                    float y = 0.f;
#pragma unroll
                    for (int e = 0; e < 4; ++e) { S[e] = S[e] * wc[e] + (sa * bc[e] + vv * kc[e]); y += S[e] * rc[e]; }
                    y = allreduce16(y);
                    ysel = (q == j) ? y : ysel;
                }
                const int row = ((const LAS int*)buf)[TCH * RW_F + jh * 16 + q];
                Y[(size_t)row * D + 512 + h * 64 + half * 32 + vrow] = f2bf(ysel);
            }
        }
        if (c + 1 < NCHUNK) store(c + 1);
        __syncthreads();
    }
}

constexpr size_t WS_EXBC = WS_RWR;
constexpr size_t WS_EQK = WS_EXBC + (size_t)NROWS * 768 * 2;
constexpr size_t WS_EGT = WS_EQK + (size_t)NROWS * 512 * 2;
static_assert(WS_EGT + (size_t)NROWS * 32 * 4 <= WS_LA, "even-layer prepare buffers must fit in the RWKV region");

__device__ __forceinline__ void phase_prep_even(int wv, KP Pk, int layer) {
    asm volatile("" : "+s"(Pk));
    const CAS Params& P = *Pk;
    const int tid = ltid(wv), lane = tid & 63, wid = tid >> 6, i_ = layer >> 1;
    const bf16_t* Pb = (const bf16_t*)(P.ws + WS_P);
    bf16_t* XBC = (bf16_t*)(P.ws + WS_EXBC); bf16_t* QK = (bf16_t*)(P.ws + WS_EQK); float* GT = (float*)(P.ws + WS_EGT);
    float cw0[4][8], cw1[4][8], cwq[4][8];
#pragma unroll
    for (int e = 0; e < 8; ++e) {
#pragma unroll
        for (int t = 0; t < 3; ++t) {
            cw0[t][e] = P.ssd_conv_w[(size_t)(i_ * 3 + t) * 768 + 8 * lane + e];
            cw1[t][e] = P.ssd_conv_w[(size_t)(i_ * 3 + t) * 768 + 512 + 8 * (lane & 31) + e];
            cwq[t][e] = P.ml_conv_w[(size_t)(i_ * 3 + t) * 512 + 8 * lane + e];
        }
        cw0[3][e] = P.ssd_conv_b[i_ * 768 + 8 * lane + e]; cw1[3][e] = P.ssd_conv_b[i_ * 768 + 512 + 8 * (lane & 31) + e]; cwq[3][e] = P.ml_conv_b[i_ * 512 + 8 * lane + e];
    }
    float gbias = 0.f;
    if (lane < 16) gbias = P.ssd_dt_bias[i_ * 16 + lane]; else if (lane < 24) gbias = P.ml_i_bias[i_ * 8 + lane - 16]; else if (lane < 32) gbias = P.ml_f_bias[i_ * 8 + lane - 24];
    const float qscl = lane < 32 ? 0.125f : 1.f;
    for (int r = blockIdx.x * 8 + wid; r < NROWS; r += gridDim.x * 8) {
        int t, len; row_seg(r, t, len);
        const bf16_t* pr = Pb + (size_t)r * LDP_EVEN;
        const bool hp = t > 0, hn = t < len - 1;
        const u32x4 zero = (u32x4){0u, 0u, 0u, 0u};
        float fc[8], fp[8], fn[8], o[8];
        {
            const int col = 512 + 8 * lane;
            unpack8(*(const u32x4*)(pr + col), fc); unpack8(hp ? *(const u32x4*)(pr - LDP_EVEN + col) : zero, fp); unpack8(hn ? *(const u32x4*)(pr + LDP_EVEN + col) : zero, fn);
#pragma unroll
            for (int e = 0; e < 8; ++e) o[e] = siluf_(cw0[0][e] * fp[e] + cw0[1][e] * fc[e] + cw0[2][e] * fn[e] + cw0[3][e]);
            *(u32x4*)(XBC + (size_t)r * 768 + 8 * lane) = pack8(o);
        }
        if (lane < 32) {
            const int col = 1024 + 8 * lane;
            unpack8(*(const u32x4*)(pr + col), fc); unpack8(hp ? *(const u32x4*)(pr - LDP_EVEN + col) : zero, fp); unpack8(hn ? *(const u32x4*)(pr + LDP_EVEN + col) : zero, fn);
#pragma unroll
            for (int e = 0; e < 8; ++e) o[e] = siluf_(cw1[0][e] * fp[e] + cw1[1][e] * fc[e] + cw1[2][e] * fn[e] + cw1[3][e]);
            *(u32x4*)(XBC + (size_t)r * 768 + 512 + 8 * lane) = pack8(o);
        }
        {
            const int col = 1296 + 8 * lane;
            unpack8(*(const u32x4*)(pr + col), fc); unpack8(hp ? *(const u32x4*)(pr - LDP_EVEN + col) : zero, fp); unpack8(hn ? *(const u32x4*)(pr + LDP_EVEN + col) : zero, fn);
#pragma unroll
            for (int e = 0; e < 8; ++e) o[e] = qscl * siluf_(cwq[0][e] * fp[e] + cwq[1][e] * fc[e] + cwq[2][e] * fn[e] + cwq[3][e]);
            *(u32x4*)(QK + (size_t)r * 512 + 8 * lane) = pack8(o);
        }
        if (lane < 32) {
            const int col = lane < 16 ? 1280 + lane : 2832 + (lane - 16);
            const float x = bf2f(pr[col]) + gbias;
            GT[(size_t)r * 32 + lane] = lane < 16 ? softplusf_(x) : lane < 24 ? x : logsigmoidf_(x);
        }
    }
}

constexpr int CL = 64, NCH64 = NSTEPS / CL, LDT = 72, LDTB = LDT * 2;
__device__ __forceinline__ bf16x8 ldfrag(const LAS char* tile, int ldb, int row0, int k0, int lane) {
    return *(const LAS bf16x8*)(tile + (row0 + (lane & 15)) * ldb + (k0 + 8 * (lane >> 4)) * 2);
}
__device__ __forceinline__ void st4bf(LAS char* p, const f32x4& v) { u32x2 o; o.x = pk2(v[0], v[1]); o.y = pk2(v[2], v[3]); *(LAS u32x2*)p = o; }

constexpr int SS_BT = 0, SS_CT = SS_BT + 64 * LDTB, SS_BDT = SS_CT + 64 * LDTB, SS_XT = SS_BDT + 64 * LDTB, SS_CUM = SS_XT + 32 * LDTB, SS_DTV = SS_CUM + 256, SS_ROWS = SS_DTV + 256, SS_STG = SS_ROWS + 256;
constexpr int SS_M = 2 * SS_STG, SS_HB = SS_M + 64 * LDTB, SS_END = SS_HB + 32 * LDTB;
static_assert(SS_END <= LDS_BYTES - 16, "SSD LDS map");
__device__ __forceinline__ void scan_ssd_c(int wv, KP Pk, int layer, int unit, LAS char* lds) {
    asm volatile("" : "+s"(Pk));
    const CAS Params& P = *Pk;
    const int tid = ltid(wv), lane = tid & 63, wid = tid >> 6, q = lane >> 4, r16 = lane & 15, i_ = layer >> 1;
    const int seq = unit >> 1, half = unit & 1, b = seq >> 4, h = (seq >> 1) & 7, dir = seq & 1, grp = h >> 2;
    const bf16_t* XBC = (const bf16_t*)(P.ws + WS_EXBC);
    const float* GT = (const float*)(P.ws + WS_EGT);
    bf16_t* Y = (bf16_t*)(P.ws + (dir ? WS_YB : WS_YF));
    const float aco = -__expf(P.ssd_a_log[(i_ * 2 + dir) * 8 + h]);
    int tj[3], tg_[3], tcol[3]; bool tv[3];
#pragma unroll
    for (int s = 0; s < 3; ++s) {
        const int task = tid + NT * s; tv[s] = task < CL * 20; tj[s] = task / 20; tg_[s] = task % 20;
        const int g = tg_[s];
        tcol[s] = g < 4 ? (h * 64 + half * 32 + 8 * g) : g < 12 ? (512 + grp * 64 + 8 * (g - 4)) : (640 + grp * 64 + 8 * (g - 12));
    }
    u32x4 rc[3]; float rdt = 0.f; int rrow = 0;
    auto load = [&](int c) {
#pragma unroll
        for (int s = 0; s < 3; ++s) {
            rc[s] = (u32x4){0u, 0u, 0u, 0u};
            if (tv[s]) { const int row = scan_row(c * CL + tj[s], b, dir, 0); rc[s] = *(const u32x4*)(XBC + (size_t)row * 768 + tcol[s]); }
        }
        if (tid < CL) { rrow = scan_row(c * CL + tid, b, dir, 0); rdt = GT[(size_t)rrow * 32 + dir * 8 + h]; }
    };
    auto store1 = [&](int c) {
        if (tid < CL) {
            LAS char* stg = lds + (c & 1) * SS_STG;
            float cum = rdt * aco;
#pragma unroll
            for (int o = 1; o < 64; o <<= 1) { const float t = __shfl_up(cum, o); if (lane >= o) cum += t; }
            ((LAS float*)(stg + SS_CUM))[tid] = cum; ((LAS float*)(stg + SS_DTV))[tid] = rdt; ((LAS int*)(stg + SS_ROWS))[tid] = rrow;
        }
    };
    auto store2 = [&](int c) {
        LAS char* stg = lds + (c & 1) * SS_STG;
        const LAS float* cum = (const LAS float*)(stg + SS_CUM);
        const float cumL = cum[CL - 1];
#pragma unroll
        for (int s = 0; s < 3; ++s) {
            if (tv[s]) {
                float f[8]; unpack8(rc[s], f);
                const int j = tj[s], g = tg_[s];
                if (g < 4) {
                    const float dt = ((const LAS float*)(stg + SS_DTV))[j];
#pragma unroll
                    for (int e = 0; e < 8; ++e) *(LAS bf16_t*)(stg + SS_XT + (8 * g + e) * LDTB + j * 2) = f2bf(f[e] * dt);
                } else if (g < 12) {
                    const int n0 = 8 * (g - 4);
                    *(LAS u32x4*)(stg + SS_BT + j * LDTB + n0 * 2) = rc[s];
                    const float sc = __expf(cumL - cum[j]);
#pragma unroll
                    for (int e = 0; e < 8; ++e) *(LAS bf16_t*)(stg + SS_BDT + (n0 + e) * LDTB + j * 2) = f2bf(f[e] * sc);
                } else {
                    *(LAS u32x4*)(stg + SS_CT + j * LDTB + 8 * (g - 12) * 2) = rc[s];
                }
            }
        }
    };
    for (int i = tid; i < 32 * LDTB / 4; i += NT) ((LAS unsigned*)(lds + SS_HB))[i] = 0u;
    f32x4 hacc = (f32x4){0.f, 0.f, 0.f, 0.f};
    load(0); store1(0); __syncthreads(); store2(0); __syncthreads();
    for (int c = 0; c < NCH64; ++c) {
        if (c + 1 < NCH64) load(c + 1);
        LAS char* stg = lds + (c & 1) * SS_STG;
        const LAS float* cum = (const LAS float*)(stg + SS_CUM);
        {
            const int lt = wid >> 1;
#pragma unroll
            for (int u = 0; u < 2; ++u) {
                const int st = (wid & 1) * 2 + u;
                f32x4 acc = (f32x4){0.f, 0.f, 0.f, 0.f};
                if (st <= lt) {
#pragma unroll
                    for (int k0 = 0; k0 < 64; k0 += 32) acc = __builtin_amdgcn_mfma_f32_16x16x32_bf16(ldfrag(stg + SS_BT, LDTB, st * 16, k0, lane), ldfrag(stg + SS_CT, LDTB, lt * 16, k0, lane), acc, 0, 0, 0);
                    const int l = lt * 16 + r16, s0 = st * 16 + 4 * q;
                    const float cl = cum[l]; const f32x4 cs = *(const LAS f32x4*)(cum + s0);
#pragma unroll
                    for (int j = 0; j < 4; ++j) acc[j] = (s0 + j <= l) ? acc[j] * __expf(cl - cs[j]) : 0.f;
                }
                st4bf(lds + SS_M + (lt * 16 + r16) * LDTB + (st * 16 + 4 * q) * 2, acc);
            }
        }
        __syncthreads();
        {
            const int lt = wid >> 1, pt = wid & 1;
            f32x4 ya = (f32x4){0.f, 0.f, 0.f, 0.f}, oa = (f32x4){0.f, 0.f, 0.f, 0.f};
#pragma unroll
            for (int k0 = 0; k0 < 64; k0 += 32) {
                ya = __builtin_amdgcn_mfma_f32_16x16x32_bf16(ldfrag(stg + SS_XT, LDTB, pt * 16, k0, lane), ldfrag(lds + SS_M, LDTB, lt * 16, k0, lane), ya, 0, 0, 0);
                oa = __builtin_amdgcn_mfma_f32_16x16x32_bf16(ldfrag(lds + SS_HB, LDTB, pt * 16, k0, lane), ldfrag(stg + SS_CT, LDTB, lt * 16, k0, lane), oa, 0, 0, 0);
            }
            const int l = lt * 16 + r16;
            const float el = __expf(cum[l]);
            const int row = ((const LAS int*)(stg + SS_ROWS))[l];
            u32x2 o; o.x = pk2(ya[0] + el * oa[0], ya[1] + el * oa[1]); o.y = pk2(ya[2] + el * oa[2], ya[3] + el * oa[3]);
            *(u32x2*)(Y + (size_t)row * D + h * 64 + half * 32 + pt * 16 + 4 * q) = o;
            const int ptile = wid >> 2, ntile = wid & 3;
            f32x4 sa = (f32x4){0.f, 0.f, 0.f, 0.f};
#pragma unroll
            for (int k0 = 0; k0 < 64; k0 += 32) sa = __builtin_amdgcn_mfma_f32_16x16x32_bf16(ldfrag(stg + SS_BDT, LDTB, ntile * 16, k0, lane), ldfrag(stg + SS_XT, LDTB, ptile * 16, k0, lane), sa, 0, 0, 0);
            const float dtot = __expf(cum[CL - 1]);
#pragma unroll
            for (int j = 0; j < 4; ++j) hacc[j] = hacc[j] * dtot + sa[j];
        }
        __syncthreads();
        st4bf(lds + SS_HB + ((wid >> 2) * 16 + r16) * LDTB + ((wid & 3) * 16 + 4 * q) * 2, hacc);
        if (c + 1 < NCH64) { store1(c + 1); __syncthreads(); store2(c + 1); }
        __syncthreads();
    }
}

constexpr int MS_QT = 0, MS_KT = MS_QT + 64 * LDTB, MS_KET = MS_KT + 64 * LDTB, MS_VT = MS_KET + 64 * LDTB, MS_SC = MS_VT + 32 * LDTB;
constexpr int MS_STG = MS_SC + 8 * 256;
constexpr int MS_W = 2 * MS_STG, MS_CB = MS_W + 64 * LDTB, MS_ONE = MS_CB + 32 * LDTB, MS_NV = MS_ONE + 16 * LDTB, MS_QN = MS_NV + 256, MS_END = MS_QN + 256;
static_assert(MS_END <= LDS_BYTES - 16, "mLSTM LDS map");
__device__ __forceinline__ void scan_mlstm_c(int wv, KP Pk, int layer, int unit, LAS char* lds) {
    asm volatile("" : "+s"(Pk));
    const CAS Params& P = *Pk;
    const int tid = ltid(wv), lane = tid & 63, wid = tid >> 6, q = lane >> 4, r16 = lane & 15;
    const int seq = unit >> 2, quarter = unit & 3, b = seq >> 3, h = (seq >> 1) & 3, dir = seq & 1;
    const bf16_t* QK = (const bf16_t*)(P.ws + WS_EQK);
    const bf16_t* Pb = (const bf16_t*)(P.ws + WS_P);
    const float* GT = (const float*)(P.ws + WS_EGT);
    bf16_t* Y = (bf16_t*)(P.ws + (dir ? WS_YB : WS_YF));
    int tj[3], tg_[3]; bool tv[3];
#pragma unroll
    for (int s = 0; s < 3; ++s) { const int task = tid + NT * s; tv[s] = task < CL * 20; tj[s] = task / 20; tg_[s] = task % 20; }
    u32x4 rc[3]; float rli = 0.f, rlf = 0.f; int rrow = 0;
    float mprev = -1e30f;
    auto load = [&](int c) {
#pragma unroll
        for (int s = 0; s < 3; ++s) {
            rc[s] = (u32x4){0u, 0u, 0u, 0u};
            if (tv[s]) {
                const int row = scan_row(c * CL + tj[s], b, dir, 0); const int g = tg_[s];
                rc[s] = g < 16 ? *(const u32x4*)(QK + (size_t)row * 512 + (g < 8 ? h * 64 + 8 * g : 256 + h * 64 + 8 * (g - 8)))
                               : *(const u32x4*)(Pb + (size_t)row * LDP_EVEN + 1808 + h * 128 + quarter * 32 + 8 * (g - 16));
            }
        }
        if (tid < CL) { rrow = scan_row(c * CL + tid, b, dir, 0); rli = GT[(size_t)rrow * 32 + 16 + dir * 4 + h]; rlf = GT[(size_t)rrow * 32 + 24 + dir * 4 + h]; }
    };
    auto store1 = [&](int c) {
        if (tid < CL) {
            LAS float* sc = (LAS float*)(lds + (c & 1) * MS_STG + MS_SC);
            float fcum = rlf;
#pragma unroll
            for (int o = 1; o < 64; o <<= 1) { const float t = __shfl_up(fcum, o); if (lane >= o) fcum += t; }
            const float ftot = __shfl(fcum, 63);
            const float g = rli - fcum;
            float pm = g;
#pragma unroll
            for (int o = 1; o < 64; o <<= 1) { const float t = __shfl_up(pm, o); if (lane >= o) pm = fmaxf(pm, t); }
            const float wend = ftot + g;
            float mloc = wend;
#pragma unroll
            for (int o = 1; o < 64; o <<= 1) mloc = fmaxf(mloc, __shfl_xor(mloc, o));
            const float eend = __expf(wend - mloc);
            const float linter = fcum + mprev;
            const float mrow = fmaxf(fcum + pm, linter);
            sc[0 * 64 + tid] = fcum - mrow; sc[1 * 64 + tid] = g; sc[2 * 64 + tid] = __expf(linter - mrow); sc[3 * 64 + tid] = __expf(-mrow); sc[4 * 64 + tid] = eend;
            ((LAS int*)sc)[5 * 64 + tid] = rrow;
            const float mnew = fmaxf(ftot + mprev, mloc);
            if (tid == 0) { sc[6 * 64 + 0] = __expf(ftot + mprev - mnew); sc[6 * 64 + 1] = __expf(mloc - mnew); }
            mprev = mnew;
        }
    };
    auto store2 = [&](int c) {
        LAS char* stg = lds + (c & 1) * MS_STG;
        const LAS float* sc = (const LAS float*)(stg + MS_SC);
#pragma unroll
        for (int s = 0; s < 3; ++s) {
            if (tv[s]) {
                float f[8]; unpack8(rc[s], f);
                const int j = tj[s], g = tg_[s];
                if (g < 8) { *(LAS u32x4*)(stg + MS_QT + j * LDTB + 8 * g * 2) = rc[s]; }
                else if (g < 16) {
                    const int k0 = 8 * (g - 8);
                    *(LAS u32x4*)(stg + MS_KT + j * LDTB + k0 * 2) = rc[s];
                    const float ee = sc[4 * 64 + j];
#pragma unroll
                    for (int e = 0; e < 8; ++e) *(LAS bf16_t*)(stg + MS_KET + (k0 + e) * LDTB + j * 2) = f2bf(f[e] * ee);
                } else {
                    const int v0 = 8 * (g - 16);
#pragma unroll
                    for (int e = 0; e < 8; ++e) { const unsigned wv = rc[s][e >> 1]; *(LAS bf16_t*)(stg + MS_VT + (v0 + e) * LDTB + j * 2) = (bf16_t)((e & 1) ? (wv >> 16) : (wv & 0xffffu)); }
                }
            }
        }
    };
    for (int i = tid; i < 32 * LDTB / 4; i += NT) ((LAS unsigned*)(lds + MS_CB))[i] = 0u;
    for (int i = tid; i < 16 * LDTB / 4; i += NT) ((LAS unsigned*)(lds + MS_ONE))[i] = 0x3f803f80u;
    if (tid < 64) ((LAS float*)(lds + MS_NV))[tid] = 0.f;
    f32x4 cacc = (f32x4){0.f, 0.f, 0.f, 0.f};
    load(0); store1(0); __syncthreads(); store2(0); __syncthreads();
    for (int c = 0; c < NCH64; ++c) {
        if (c + 1 < NCH64) load(c + 1);
        LAS char* stg = lds + (c & 1) * MS_STG;
        const LAS float* sc = (const LAS float*)(stg + MS_SC);
        LAS float* nv = (LAS float*)(lds + MS_NV);
        LAS float* qn = (LAS float*)(lds + MS_QN);
        {
            const int lt = wid >> 1;
#pragma unroll
            for (int u = 0; u < 2; ++u) {
                const int st = (wid & 1) * 2 + u;
                f32x4 acc = (f32x4){0.f, 0.f, 0.f, 0.f};
                if (st <= lt) {
#pragma unroll
                    for (int k0 = 0; k0 < 64; k0 += 32) acc = __builtin_amdgcn_mfma_f32_16x16x32_bf16(ldfrag(stg + MS_KT, LDTB, st * 16, k0, lane), ldfrag(stg + MS_QT, LDTB, lt * 16, k0, lane), acc, 0, 0, 0);
                    const int l = lt * 16 + r16, s0 = st * 16 + 4 * q;
                    const float rt = sc[l]; const f32x4 gs = *(const LAS f32x4*)(sc + 64 + s0);
#pragma unroll
                    for (int j = 0; j < 4; ++j) acc[j] = (s0 + j <= l) ? acc[j] * __expf(rt + gs[j]) : 0.f;
                }
                st4bf(lds + MS_W + (lt * 16 + r16) * LDTB + (st * 16 + 4 * q) * 2, acc);
            }
            if (wid == 0) {
                float a = 0.f;
#pragma unroll
                for (int k0 = 0; k0 < 64; k0 += 8) {
                    const u32x4 tq = *(const LAS u32x4*)(stg + MS_QT + lane * LDTB + k0 * 2); float f[8]; unpack8(tq, f);
#pragma unroll
                    for (int e = 0; e < 8; ++e) a += f[e] * nv[k0 + e];
                }
                qn[lane] = a;
            }
        }
        __syncthreads();
        {
            const int lt = wid >> 1, vt = wid & 1;
            f32x4 na = (f32x4){0.f, 0.f, 0.f, 0.f}, ca = (f32x4){0.f, 0.f, 0.f, 0.f}, da = (f32x4){0.f, 0.f, 0.f, 0.f};
#pragma unroll
            for (int k0 = 0; k0 < 64; k0 += 32) {
                const bf16x8 wf = ldfrag(lds + MS_W, LDTB, lt * 16, k0, lane);
                na = __builtin_amdgcn_mfma_f32_16x16x32_bf16(ldfrag(stg + MS_VT, LDTB, vt * 16, k0, lane), wf, na, 0, 0, 0);
                da = __builtin_amdgcn_mfma_f32_16x16x32_bf16(ldfrag(lds + MS_ONE, LDTB, 0, k0, lane), wf, da, 0, 0, 0);
                ca = __builtin_amdgcn_mfma_f32_16x16x32_bf16(ldfrag(lds + MS_CB, LDTB, vt * 16, k0, lane), ldfrag(stg + MS_QT, LDTB, lt * 16, k0, lane), ca, 0, 0, 0);
            }
            const int l = lt * 16 + r16;
            const float inter = sc[2 * 64 + l], emr = sc[3 * 64 + l];
            const float den = da[0] + inter * qn[l];
            const float inv = __builtin_amdgcn_rcpf(fmaxf(fabsf(den), emr));
            const int row = ((const LAS int*)sc)[5 * 64 + l];
            u32x2 o; o.x = pk2((na[0] + inter * ca[0]) * inv, (na[1] + inter * ca[1]) * inv); o.y = pk2((na[2] + inter * ca[2]) * inv, (na[3] + inter * ca[3]) * inv);
            *(u32x2*)(Y + (size_t)row * D + 512 + h * 128 + quarter * 32 + vt * 16 + 4 * q) = o;
            const int vtile = wid >> 2, ktile = wid & 3;
            f32x4 sa = (f32x4){0.f, 0.f, 0.f, 0.f};
#pragma unroll
            for (int k0 = 0; k0 < 64; k0 += 32) sa = __builtin_amdgcn_mfma_f32_16x16x32_bf16(ldfrag(stg + MS_KET, LDTB, ktile * 16, k0, lane), ldfrag(stg + MS_VT, LDTB, vtile * 16, k0, lane), sa, 0, 0, 0);
            const float sp = sc[6 * 64 + 0], sl = sc[6 * 64 + 1];
#pragma unroll
            for (int j = 0; j < 4; ++j) cacc[j] = cacc[j] * sp + sl * sa[j];
        }
        __syncthreads();
        st4bf(lds + MS_CB + ((wid >> 2) * 16 + r16) * LDTB + ((wid & 3) * 16 + 4 * q) * 2, cacc);
        if (wid == 1) {
            float a = 0.f;
            for (int s = 0; s < CL; ++s) a += sc[4 * 64 + s] * bf2f(*(const LAS bf16_t*)(stg + MS_KT + s * LDTB + lane * 2));
            nv[lane] = nv[lane] * sc[6 * 64 + 0] + sc[6 * 64 + 1] * a;
        }
        if (c + 1 < NCH64) { store1(c + 1); __syncthreads(); store2(c + 1); }
        __syncthreads();
    }
}

constexpr size_t WS_XSS = WS_EGT + al256((size_t)NROWS * 32 * 4);
constexpr size_t XSS_BYTES = (size_t)64 * NCH64 * 64 * 64 * 2;
constexpr size_t WS_XSD = WS_XSS + XSS_BYTES;
constexpr size_t WS_XMC = WS_XSD + al256((size_t)64 * NCH64 * 4);
constexpr size_t XMC_BYTES = (size_t)32 * NCH64 * 128 * 64 * 2;
constexpr size_t WS_XMN = WS_XMC + XMC_BYTES;
constexpr size_t WS_XMS = WS_XMN + (size_t)32 * NCH64 * 64 * 4;
constexpr size_t WS_XMT = WS_XMS + al256((size_t)32 * NCH64 * 4 * 4);
constexpr size_t WS_XEND = WS_XMT + (size_t)32 * NCH64 * 3 * 64 * 4;
static_assert(WS_XEND <= WS_END, "even-layer chunk-state buffers must fit in the RWKV region");
constexpr int NSSD_ITEMS = 64 * NCH64, NML_ITEMS = 32 * NCH64;

__device__ __forceinline__ float wave_cumsum(float v, int lane) {
#pragma unroll
    for (int o = 1; o < 64; o <<= 1) { const float t = __shfl_up(v, o); if (lane >= o) v += t; }
    return v;
}
__device__ __forceinline__ float wave_cummax(float v, int lane) {
#pragma unroll
    for (int o = 1; o < 64; o <<= 1) { const float t = __shfl_up(v, o); if (lane >= o) v = fmaxf(v, t); }
    return v;
}
__device__ __forceinline__ float wave_max(float v) {
#pragma unroll
    for (int o = 1; o < 64; o <<= 1) v = fmaxf(v, __shfl_xor(v, o));
    return v;
}

constexpr int X1S_BDT = 0, X1S_XT = X1S_BDT + 64 * LDTB, X1S_CUM = X1S_XT + 64 * LDTB, X1S_DTV = X1S_CUM + 256, X1S_END = X1S_DTV + 256;
constexpr int X1M_KET = 0, X1M_VT = X1M_KET + 64 * LDTB, X1M_ONE = X1M_VT + 128 * LDTB, X1M_EE = X1M_ONE + 16 * LDTB, X1M_END = X1M_EE + 256;
__device__ __forceinline__ void phase_ex1(int wv, KP Pk, int layer, LAS char* lds) {
    asm volatile("" : "+s"(Pk));
    const CAS Params& P = *Pk;
    const int tid = ltid(wv), lane = tid & 63, wid = tid >> 6, q = lane >> 4, r16 = lane & 15, i_ = layer >> 1;
    const bf16_t* XBC = (const bf16_t*)(P.ws + WS_EXBC); const bf16_t* QK = (const bf16_t*)(P.ws + WS_EQK); const bf16_t* Pb = (const bf16_t*)(P.ws + WS_P);
    const float* GT = (const float*)(P.ws + WS_EGT);
    {
        bf16_t* Hst = (bf16_t*)(P.ws + WS_XSS); float* Dst = (float*)(P.ws + WS_XSD);
        u32x4 rc[2]; float rdt = 0.f;
        auto geom = [&](int it, int& b, int& h, int& dir, int& c) { const int sq = it / NCH64; c = it - sq * NCH64; b = sq >> 4; h = (sq >> 1) & 7; dir = sq & 1; };
        auto load = [&](int it) {
            int b, h, dir, c; geom(it, b, h, dir, c);
            int tl = tid; asm volatile("" : "+v"(tl));
#pragma unroll
            for (int s = 0; s < 2; ++s) {
                const int task = tl + NT * s, j = task >> 4, g = task & 15;
                const int row = scan_row(c * CL + j, b, dir, 0);
                rc[s] = *(const u32x4*)(XBC + (size_t)row * 768 + (g < 8 ? h * 64 + 8 * g : 512 + (h >> 2) * 64 + 8 * (g - 8)));
            }
            if (tl < CL) { const int row = scan_row(c * CL + tl, b, dir, 0); rdt = GT[(size_t)row * 32 + dir * 8 + h]; }
        };
        int it = blockIdx.x;
        if (it < NSSD_ITEMS) load(it);
        for (; it < NSSD_ITEMS; it += gridDim.x) {
            int b, h, dir, c; geom(it, b, h, dir, c);
            const float aco = -__expf(P.ssd_a_log[(i_ * 2 + dir) * 8 + h]);
            if (tid < CL) {
                const float cum = wave_cumsum(rdt * aco, lane);
                ((LAS float*)(lds + X1S_CUM))[tid] = cum; ((LAS float*)(lds + X1S_DTV))[tid] = rdt;
            }
            __syncthreads();
            {
                const LAS float* cum = (const LAS float*)(lds + X1S_CUM);
                const float cumL = cum[CL - 1];
                int tl = tid; asm volatile("" : "+v"(tl));
#pragma unroll
                for (int s = 0; s < 2; ++s) {
                    const int task = tl + NT * s, j = task >> 4, g = task & 15;
                    float f[8]; unpack8(rc[s], f);
                    if (g < 8) {
                        const float dt = ((const LAS float*)(lds + X1S_DTV))[j];
#pragma unroll
                        for (int e = 0; e < 8; ++e) *(LAS bf16_t*)(lds + X1S_XT + (8 * g + e) * LDTB + j * 2) = f2bf(f[e] * dt);
                    } else {
                        const float sc = __expf(cumL - cum[j]);
#pragma unroll
                        for (int e = 0; e < 8; ++e) *(LAS bf16_t*)(lds + X1S_BDT + (8 * (g - 8) + e) * LDTB + j * 2) = f2bf(f[e] * sc);
                    }
                }
                if (tid == 0) Dst[it] = __expf(cumL);
            }
            if (it + (int)gridDim.x < NSSD_ITEMS) load(it + gridDim.x);
            __syncthreads();
            {
                const int pt = wid >> 1;
#pragma unroll
                for (int u = 0; u < 2; ++u) {
                    const int nt = (wid & 1) * 2 + u;
                    f32x4 sa = (f32x4){0.f, 0.f, 0.f, 0.f};
#pragma unroll
                    for (int k0 = 0; k0 < 64; k0 += 32) sa = __builtin_amdgcn_mfma_f32_16x16x32_bf16(ldfrag(lds + X1S_BDT, LDTB, nt * 16, k0, lane), ldfrag(lds + X1S_XT, LDTB, pt * 16, k0, lane), sa, 0, 0, 0);
                    u32x2 o; o.x = pk2(sa[0], sa[1]); o.y = pk2(sa[2], sa[3]);
                    *(u32x2*)(Hst + ((size_t)it * 64 + pt * 16 + r16) * 64 + nt * 16 + 4 * q) = o;
                }
            }
            __syncthreads();
        }
    }
    {
        bf16_t* Cst = (bf16_t*)(P.ws + WS_XMC); float* Nst = (float*)(P.ws + WS_XMN); float* Sst = (float*)(P.ws + WS_XMS); float* Tst = (float*)(P.ws + WS_XMT);
        for (int i = tid; i < 16 * LDTB / 4; i += NT) ((LAS unsigned*)(lds + X1M_ONE))[i] = 0x3f803f80u;
        u32x4 rc[3]; float rli = 0.f, rlf = 0.f;
        auto geom = [&](int it, int& b, int& h, int& dir, int& c) { const int sq = it / NCH64; c = it - sq * NCH64; b = sq >> 3; h = (sq >> 1) & 3; dir = sq & 1; };
        auto load = [&](int it) {
            int b, h, dir, c; geom(it, b, h, dir, c);
            int tl = tid; asm volatile("" : "+v"(tl));
#pragma unroll
            for (int s = 0; s < 3; ++s) {
                const int task = tl + NT * s, j = task / 24, g = task - 24 * j;
                const int row = scan_row(c * CL + j, b, dir, 0);
                rc[s] = g < 8 ? *(const u32x4*)(QK + (size_t)row * 512 + 256 + h * 64 + 8 * g) : *(const u32x4*)(Pb + (size_t)row * LDP_EVEN + 1808 + h * 128 + 8 * (g - 8));
            }
            if (tl < CL) { const int row = scan_row(c * CL + tl, b, dir, 0); rli = GT[(size_t)row * 32 + 16 + dir * 4 + h]; rlf = GT[(size_t)row * 32 + 24 + dir * 4 + h]; }
        };
        int it = blockIdx.x;
        if (it < NML_ITEMS) load(it);
        __syncthreads();
        for (; it < NML_ITEMS; it += gridDim.x) {
            if (tid < CL) {
                const float fcum = wave_cumsum(rlf, lane);
                const float ftot = __shfl(fcum, 63);
                const float g = rli - fcum, pm = wave_cummax(g, lane);
                const float wend = ftot + g, mloc = wave_max(wend);
                ((LAS float*)(lds + X1M_EE))[tid] = __expf(wend - mloc);
                float* tp = Tst + (size_t)it * 192;
                tp[tid] = fcum; tp[64 + tid] = g; tp[128 + tid] = pm;
                if (tid == 0) { Sst[(size_t)it * 4 + 0] = ftot; Sst[(size_t)it * 4 + 1] = mloc; }
            }
            __syncthreads();
            {
                const LAS float* ee = (const LAS float*)(lds + X1M_EE);
                int tl = tid; asm volatile("" : "+v"(tl));
#pragma unroll
                for (int s = 0; s < 3; ++s) {
                    const int task = tl + NT * s, j = task / 24, g = task - 24 * j;
                    if (g < 8) {
                        float f[8]; unpack8(rc[s], f);
                        const float e1 = ee[j];
#pragma unroll
                        for (int e = 0; e < 8; ++e) *(LAS bf16_t*)(lds + X1M_KET + (8 * g + e) * LDTB + j * 2) = f2bf(f[e] * e1);
                    } else {
                        const int v0 = 8 * (g - 8);
#pragma unroll
                        for (int e = 0; e < 8; ++e) { const unsigned wv = rc[s][e >> 1]; *(LAS bf16_t*)(lds + X1M_VT + (v0 + e) * LDTB + j * 2) = (bf16_t)((e & 1) ? (wv >> 16) : (wv & 0xffffu)); }
                    }
                }
            }
            if (it + (int)gridDim.x < NML_ITEMS) load(it + gridDim.x);
            __syncthreads();
            {
                const bf16x8 vf0 = ldfrag(lds + X1M_VT, LDTB, wid * 16, 0, lane), vf1 = ldfrag(lds + X1M_VT, LDTB, wid * 16, 32, lane);
#pragma unroll
                for (int kt = 0; kt < 4; ++kt) {
                    f32x4 sa = __builtin_amdgcn_mfma_f32_16x16x32_bf16(ldfrag(lds + X1M_KET, LDTB, kt * 16, 0, lane), vf0, (f32x4){0.f, 0.f, 0.f, 0.f}, 0, 0, 0);
                    sa = __builtin_amdgcn_mfma_f32_16x16x32_bf16(ldfrag(lds + X1M_KET, LDTB, kt * 16, 32, lane), vf1, sa, 0, 0, 0);
                    u32x2 o; o.x = pk2(sa[0], sa[1]); o.y = pk2(sa[2], sa[3]);
                    *(u32x2*)(Cst + ((size_t)it * 128 + wid * 16 + r16) * 64 + kt * 16 + 4 * q) = o;
                }
                if (wid < 4) {
                    f32x4 na = __builtin_amdgcn_mfma_f32_16x16x32_bf16(ldfrag(lds + X1M_KET, LDTB, wid * 16, 0, lane), ldfrag(lds + X1M_ONE, LDTB, 0, 0, lane), (f32x4){0.f, 0.f, 0.f, 0.f}, 0, 0, 0);
                    na = __builtin_amdgcn_mfma_f32_16x16x32_bf16(ldfrag(lds + X1M_KET, LDTB, wid * 16, 32, lane), ldfrag(lds + X1M_ONE, LDTB, 0, 32, lane), na, 0, 0, 0);
                    if (r16 == 0) *(f32x4*)(Nst + (size_t)it * 64 + wid * 16 + 4 * q) = na;
                }
            }
            __syncthreads();
        }
    }
}

__device__ __forceinline__ void phase_ex2(int wv, KP Pk, int layer) {
    asm volatile("" : "+s"(Pk));
    const CAS Params& P = *Pk;
    const int tid = ltid(wv);
    (void)layer;
    if (blockIdx.x < 128) {
        const int gt = blockIdx.x * NT + tid, sq = gt >> 10, rem = gt & 1023;
        bf16_t* Hst = (bf16_t*)(P.ws + WS_XSS) + (size_t)sq * NCH64 * 4096 + rem * 4;
        const float* Dst = (const float*)(P.ws + WS_XSD) + sq * NCH64;
        float h0 = 0.f, h1 = 0.f, h2 = 0.f, h3 = 0.f;
#pragma unroll 4
        for (int c = 0; c < NCH64; ++c) {
            const u32x2 loc = *(const u32x2*)(Hst + (size_t)c * 4096);
            const float d = Dst[c];
            u32x2 o; o.x = pk2(h0, h1); o.y = pk2(h2, h3);
            *(u32x2*)(Hst + (size_t)c * 4096) = o;
            h0 = d * h0 + bflo(loc.x); h1 = d * h1 + bfhi(loc.x); h2 = d * h2 + bflo(loc.y); h3 = d * h3 + bfhi(loc.y);
        }
    } else if (blockIdx.x < 256) {
        const int gt = (blockIdx.x - 128) * NT + tid, sq = gt >> 11, rem = gt & 2047;
        bf16_t* Cst = (bf16_t*)(P.ws + WS_XMC) + (size_t)sq * NCH64 * 8192 + rem * 4;
        float* Nst = (float*)(P.ws + WS_XMN) + (size_t)sq * NCH64 * 64 + (rem & 15) * 4;
        float* Sst = (float*)(P.ws + WS_XMS) + (size_t)sq * NCH64 * 4;
        const bool own_n = rem < 16, own_m = rem == 0;
        float c0 = 0.f, c1 = 0.f, c2 = 0.f, c3 = 0.f, m = -1e30f;
        f32x4 nn = (f32x4){0.f, 0.f, 0.f, 0.f};
#pragma unroll 2
        for (int c = 0; c < NCH64; ++c) {
            const u32x2 loc = *(const u32x2*)(Cst + (size_t)c * 8192);
            const float ftot = Sst[c * 4 + 0], mloc = Sst[c * 4 + 1];
            const float mnew = fmaxf(ftot + m, mloc), sp = __expf(ftot + m - mnew), sl = __expf(mloc - mnew);
            u32x2 o; o.x = pk2(c0, c1); o.y = pk2(c2, c3);
            *(u32x2*)(Cst + (size_t)c * 8192) = o;
            c0 = sp * c0 + sl * bflo(loc.x); c1 = sp * c1 + sl * bfhi(loc.x); c2 = sp * c2 + sl * bflo(loc.y); c3 = sp * c3 + sl * bfhi(loc.y);
            if (own_n) { const f32x4 nl = *(const f32x4*)(Nst + (size_t)c * 64); *(f32x4*)(Nst + (size_t)c * 64) = nn; nn = nn * sp + nl * sl; }
            if (own_m) Sst[c * 4 + 2] = m;
            m = mnew;
        }
    }
}

constexpr int X3S_BT = 0, X3S_CT = X3S_BT + 64 * LDTB, X3S_XT = X3S_CT + 64 * LDTB, X3S_HB = X3S_XT + 64 * LDTB, X3S_M = X3S_HB + 64 * LDTB, X3S_CUM = X3S_M + 64 * LDTB, X3S_DTV = X3S_CUM + 256, X3S_ROWS = X3S_DTV + 256, X3S_END = X3S_ROWS + 256;
constexpr int X3M_QT = 0, X3M_KT = X3M_QT + 64 * LDTB, X3M_VT = X3M_KT + 64 * LDTB, X3M_CB = X3M_VT + 128 * LDTB, X3M_W = X3M_CB + 128 * LDTB, X3M_ONE = X3M_W + 64 * LDTB, X3M_NB = X3M_ONE + 16 * LDTB,
              X3M_SC = X3M_NB + 16 * LDTB, X3M_END = X3M_SC + 6 * 256;
static_assert(X3M_END <= LDS_BYTES - 16 && X3S_END <= LDS_BYTES - 16, "EX3 LDS maps");
__device__ __forceinline__ void phase_ex3(int wv, KP Pk, int layer, LAS char* lds) {
    asm volatile("" : "+s"(Pk));
    const CAS Params& P = *Pk;
    const int tid = ltid(wv), lane = tid & 63, wid = tid >> 6, q = lane >> 4, r16 = lane & 15, i_ = layer >> 1;
    const bf16_t* XBC = (const bf16_t*)(P.ws + WS_EXBC); const bf16_t* QK = (const bf16_t*)(P.ws + WS_EQK); const bf16_t* Pb = (const bf16_t*)(P.ws + WS_P);
    const float* GT = (const float*)(P.ws + WS_EGT);
    {
        const bf16_t* Hst = (const bf16_t*)(P.ws + WS_XSS);
        u32x4 rc[3], rh; float rdt = 0.f; int rrow = 0;
        auto geom = [&](int it, int& b, int& h, int& dir, int& c) { const int sq = it / NCH64; c = it - sq * NCH64; b = sq >> 4; h = (sq >> 1) & 7; dir = sq & 1; };
        auto load = [&](int it) {
            int b, h, dir, c; geom(it, b, h, dir, c);
            int tl = tid; asm volatile("" : "+v"(tl));
#pragma unroll
            for (int s = 0; s < 3; ++s) {
                const int task = tl + NT * s, j = task / 24, g = task - 24 * j;
                const int row = scan_row(c * CL + j, b, dir, 0);
                rc[s] = *(const u32x4*)(XBC + (size_t)row * 768 + (g < 8 ? h * 64 + 8 * g : g < 16 ? 512 + (h >> 2) * 64 + 8 * (g - 8) : 640 + (h >> 2) * 64 + 8 * (g - 16)));
            }
            rh = *(const u32x4*)(Hst + (size_t)it * 4096 + tl * 8);
            if (tl < CL) { rrow = scan_row(c * CL + tl, b, dir, 0); rdt = GT[(size_t)rrow * 32 + dir * 8 + h]; }
        };
        int it = blockIdx.x;
        if (it < NSSD_ITEMS) load(it);
        __syncthreads();
        for (; it < NSSD_ITEMS; it += gridDim.x) {
            int b, h, dir, c; geom(it, b, h, dir, c);
            bf16_t* Y = (bf16_t*)(P.ws + (dir ? WS_YB : WS_YF));
            const float aco = -__expf(P.ssd_a_log[(i_ * 2 + dir) * 8 + h]);
            if (tid < CL) {
                const float cum = wave_cumsum(rdt * aco, lane);
                ((LAS float*)(lds + X3S_CUM))[tid] = cum; ((LAS float*)(lds + X3S_DTV))[tid] = rdt; ((LAS int*)(lds + X3S_ROWS))[tid] = rrow;
            }
            __syncthreads();
            {
                int tl = tid; asm volatile("" : "+v"(tl));
#pragma unroll
                for (int s = 0; s < 3; ++s) {
                    const int task = tl + NT * s, j = task / 24, g = task - 24 * j;
                    if (g < 8) {
                        float f[8]; unpack8(rc[s], f);
                        const float dt = ((const LAS float*)(lds + X3S_DTV))[j];
#pragma unroll
                        for (int e = 0; e < 8; ++e) *(LAS bf16_t*)(lds + X3S_XT + (8 * g + e) * LDTB + j * 2) = f2bf(f[e] * dt);
                    } else if (g < 16) *(LAS u32x4*)(lds + X3S_BT + j * LDTB + 8 * (g - 8) * 2) = rc[s];
                    else *(LAS u32x4*)(lds + X3S_CT + j * LDTB + 8 * (g - 16) * 2) = rc[s];
                }
                *(LAS u32x4*)(lds + X3S_HB + (tl >> 3) * LDTB + (tl & 7) * 16) = rh;
            }
            if (it + (int)gridDim.x < NSSD_ITEMS) load(it + gridDim.x);
            __syncthreads();
            const LAS float* cum = (const LAS float*)(lds + X3S_CUM);
            {
                const int lt = wid >> 1;
#pragma unroll
                for (int u = 0; u < 2; ++u) {
                    const int st = (wid & 1) * 2 + u;
                    f32x4 acc = (f32x4){0.f, 0.f, 0.f, 0.f};
                    if (st <= lt) {
#pragma unroll
                        for (int k0 = 0; k0 < 64; k0 += 32) acc = __builtin_amdgcn_mfma_f32_16x16x32_bf16(ldfrag(lds + X3S_BT, LDTB, st * 16, k0, lane), ldfrag(lds + X3S_CT, LDTB, lt * 16, k0, lane), acc, 0, 0, 0);
                        const int l = lt * 16 + r16, s0 = st * 16 + 4 * q;
                        const float cl = cum[l]; const f32x4 cs = *(const LAS f32x4*)(cum + s0);
#pragma unroll
                        for (int j = 0; j < 4; ++j) acc[j] = (s0 + j <= l) ? acc[j] * __expf(cl - cs[j]) : 0.f;
                    }
                    st4bf(lds + X3S_M + (lt * 16 + r16) * LDTB + (st * 16 + 4 * q) * 2, acc);
                }
            }
            __syncthreads();
            {
                const int lt = wid >> 1, l = lt * 16 + r16;
                const float el = __expf(cum[l]);
                const int row = ((const LAS int*)(lds + X3S_ROWS))[l];
                const bf16x8 mf0 = ldfrag(lds + X3S_M, LDTB, lt * 16, 0, lane), mf1 = ldfrag(lds + X3S_M, LDTB, lt * 16, 32, lane);
                const bf16x8 cf0 = ldfrag(lds + X3S_CT, LDTB, lt * 16, 0, lane), cf1 = ldfrag(lds + X3S_CT, LDTB, lt * 16, 32, lane);
#pragma unroll
                for (int u = 0; u < 2; ++u) {
                    const int pt = (wid & 1) * 2 + u;
                    f32x4 ya = __builtin_amdgcn_mfma_f32_16x16x32_bf16(ldfrag(lds + X3S_XT, LDTB, pt * 16, 0, lane), mf0, (f32x4){0.f, 0.f, 0.f, 0.f}, 0, 0, 0);
                    ya = __builtin_amdgcn_mfma_f32_16x16x32_bf16(ldfrag(lds + X3S_XT, LDTB, pt * 16, 32, lane), mf1, ya, 0, 0, 0);
                    f32x4 oa = __builtin_amdgcn_mfma_f32_16x16x32_bf16(ldfrag(lds + X3S_HB, LDTB, pt * 16, 0, lane), cf0, (f32x4){0.f, 0.f, 0.f, 0.f}, 0, 0, 0);
                    oa = __builtin_amdgcn_mfma_f32_16x16x32_bf16(ldfrag(lds + X3S_HB, LDTB, pt * 16, 32, lane), cf1, oa, 0, 0, 0);
                    u32x2 o; o.x = pk2(ya[0] + el * oa[0], ya[1] + el * oa[1]); o.y = pk2(ya[2] + el * oa[2], ya[3] + el * oa[3]);
                    *(u32x2*)(Y + (size_t)row * D + h * 64 + pt * 16 + 4 * q) = o;
                }
            }
            __syncthreads();
        }
    }
    {
        const bf16_t* Cst = (const bf16_t*)(P.ws + WS_XMC); const float* Nst = (const float*)(P.ws + WS_XMN); const float* Sst = (const float*)(P.ws + WS_XMS); const float* Tst = (const float*)(P.ws + WS_XMT);
        for (int i = tid; i < 16 * LDTB / 4; i += NT) ((LAS unsigned*)(lds + X3M_ONE))[i] = 0x3f803f80u;
        u32x4 rc[4], rcb[2]; float rfc = 0.f, rg = 0.f, rpm = 0.f, rmp = 0.f, rn = 0.f; int rrow = 0;
        auto geom = [&](int it, int& b, int& h, int& dir, int& c) { const int sq = it / NCH64; c = it - sq * NCH64; b = sq >> 3; h = (sq >> 1) & 3; dir = sq & 1; };
        auto load = [&](int it) {
            int b, h, dir, c; geom(it, b, h, dir, c);
            int tl = tid; asm volatile("" : "+v"(tl));
#pragma unroll
            for (int s = 0; s < 4; ++s) {
                const int task = tl + NT * s, j = task >> 5, g = task & 31;
                const int row = scan_row(c * CL + j, b, dir, 0);
                rc[s] = g < 16 ? *(const u32x4*)(QK + (size_t)row * 512 + (g < 8 ? h * 64 + 8 * g : 256 + h * 64 + 8 * (g - 8))) : *(const u32x4*)(Pb + (size_t)row * LDP_EVEN + 1808 + h * 128 + 8 * (g - 16));
            }
#pragma unroll
            for (int s = 0; s < 2; ++s) rcb[s] = *(const u32x4*)(Cst + (size_t)it * 8192 + (tl + NT * s) * 8);
            if (tl < CL) {
                rrow = scan_row(c * CL + tl, b, dir, 0);
                const float* tp = Tst + (size_t)it * 192;
                rfc = tp[tl]; rg = tp[64 + tl]; rpm = tp[128 + tl]; rmp = Sst[(size_t)it * 4 + 2]; rn = Nst[(size_t)it * 64 + tl];
            }
        };
        int it = blockIdx.x;
        if (it < NML_ITEMS) load(it);
        __syncthreads();
        for (; it < NML_ITEMS; it += gridDim.x) {
            int b, h, dir, c; geom(it, b, h, dir, c);
            bf16_t* Y = (bf16_t*)(P.ws + (dir ? WS_YB : WS_YF));
            LAS float* sc = (LAS float*)(lds + X3M_SC);
            {
                int tl = tid; asm volatile("" : "+v"(tl));
#pragma unroll
                for (int s = 0; s < 4; ++s) {
                    const int task = tl + NT * s, j = task >> 5, g = task & 31;
                    if (g < 8) *(LAS u32x4*)(lds + X3M_QT + j * LDTB + 8 * g * 2) = rc[s];
                    else if (g < 16) *(LAS u32x4*)(lds + X3M_KT + j * LDTB + 8 * (g - 8) * 2) = rc[s];
                    else {
                        const int v0 = 8 * (g - 16);
#pragma unroll
                        for (int e = 0; e < 8; ++e) { const unsigned wv = rc[s][e >> 1]; *(LAS bf16_t*)(lds + X3M_VT + (v0 + e) * LDTB + j * 2) = (bf16_t)((e & 1) ? (wv >> 16) : (wv & 0xffffu)); }
                    }
                }
#pragma unroll
                for (int s = 0; s < 2; ++s) { const int ch = tl + NT * s; *(LAS u32x4*)(lds + X3M_CB + (ch >> 3) * LDTB + (ch & 7) * 16) = rcb[s]; }
                if (tl < CL) {
                    const float linter = rfc + rmp, mrow = fmaxf(rfc + rpm, linter);
                    sc[tl] = rfc - mrow; sc[64 + tl] = rg; sc[128 + tl] = __expf(linter - mrow); sc[192 + tl] = __expf(-mrow); ((LAS int*)sc)[256 + tl] = rrow;
                    const bf16_t nb = f2bf(rn);
#pragma unroll
                    for (int r = 0; r < 16; ++r) *(LAS bf16_t*)(lds + X3M_NB + r * LDTB + tl * 2) = nb;
                }
            }
            if (it + (int)gridDim.x < NML_ITEMS) load(it + gridDim.x);
            __syncthreads();
            {
                const int lt = wid >> 1;
#pragma unroll
                for (int u = 0; u < 2; ++u) {
                    const int st = (wid & 1) * 2 + u;
                    f32x4 acc = (f32x4){0.f, 0.f, 0.f, 0.f};
                    if (st <= lt) {
#pragma unroll
                        for (int k0 = 0; k0 < 64; k0 += 32) acc = __builtin_amdgcn_mfma_f32_16x16x32_bf16(ldfrag(lds + X3M_KT, LDTB, st * 16, k0, lane), ldfrag(lds + X3M_QT, LDTB, lt * 16, k0, lane), acc, 0, 0, 0);
                        const int l = lt * 16 + r16, s0 = st * 16 + 4 * q;
                        const float rt = sc[l]; const f32x4 gs = *(const LAS f32x4*)(sc + 64 + s0);
#pragma unroll
                        for (int j = 0; j < 4; ++j) acc[j] = (s0 + j <= l) ? acc[j] * __expf(rt + gs[j]) : 0.f;
                    }
                    st4bf(lds + X3M_W + (lt * 16 + r16) * LDTB + (st * 16 + 4 * q) * 2, acc);
                }
            }
            __syncthreads();
            {
                const int lt = wid >> 1, l = lt * 16 + r16;
                const bf16x8 wf0 = ldfrag(lds + X3M_W, LDTB, lt * 16, 0, lane), wf1 = ldfrag(lds + X3M_W, LDTB, lt * 16, 32, lane);
                const bf16x8 qf0 = ldfrag(lds + X3M_QT, LDTB, lt * 16, 0, lane), qf1 = ldfrag(lds + X3M_QT, LDTB, lt * 16, 32, lane);
                f32x4 da = __builtin_amdgcn_mfma_f32_16x16x32_bf16(ldfrag(lds + X3M_ONE, LDTB, 0, 0, lane), wf0, (f32x4){0.f, 0.f, 0.f, 0.f}, 0, 0, 0);
                da = __builtin_amdgcn_mfma_f32_16x16x32_bf16(ldfrag(lds + X3M_ONE, LDTB, 0, 32, lane), wf1, da, 0, 0, 0);
                f32x4 qn = __builtin_amdgcn_mfma_f32_16x16x32_bf16(ldfrag(lds + X3M_NB, LDTB, 0, 0, lane), qf0, (f32x4){0.f, 0.f, 0.f, 0.f}, 0, 0, 0);
                qn = __builtin_amdgcn_mfma_f32_16x16x32_bf16(ldfrag(lds + X3M_NB, LDTB, 0, 32, lane), qf1, qn, 0, 0, 0);
                const float inter = sc[128 + l], emr = sc[192 + l];
                const float inv = __builtin_amdgcn_rcpf(fmaxf(fabsf(da[0] + inter * qn[0]), emr));
                const int row = ((const LAS int*)sc)[256 + l];
#pragma unroll
                for (int u = 0; u < 4; ++u) {
                    const int vt = (wid & 1) * 4 + u;
                    f32x4 na = __builtin_amdgcn_mfma_f32_16x16x32_bf16(ldfrag(lds + X3M_VT, LDTB, vt * 16, 0, lane), wf0, (f32x4){0.f, 0.f, 0.f, 0.f}, 0, 0, 0);
                    na = __builtin_amdgcn_mfma_f32_16x16x32_bf16(ldfrag(lds + X3M_VT, LDTB, vt * 16, 32, lane), wf1, na, 0, 0, 0);
                    f32x4 ca = __builtin_amdgcn_mfma_f32_16x16x32_bf16(ldfrag(lds + X3M_CB, LDTB, vt * 16, 0, lane), qf0, (f32x4){0.f, 0.f, 0.f, 0.f}, 0, 0, 0);
                    ca = __builtin_amdgcn_mfma_f32_16x16x32_bf16(ldfrag(lds + X3M_CB, LDTB, vt * 16, 32, lane), qf1, ca, 0, 0, 0);
                    u32x2 o; o.x = pk2((na[0] + inter * ca[0]) * inv, (na[1] + inter * ca[1]) * inv); o.y = pk2((na[2] + inter * ca[2]) * inv, (na[3] + inter * ca[3]) * inv);
                    *(u32x2*)(Y + (size_t)row * D + 512 + h * 128 + vt * 16 + 4 * q) = o;
                }
            }
            __syncthreads();
        }
    }
}

constexpr int HC_RAWF = 0;
constexpr int HC_RAWQ = HC_RAWF + 64 * 128 * 4;
constexpr int HC_SUB = HC_RAWQ + 64 * 128 * 2;
constexpr int HL_QD = 136 * 2;
constexpr int HL_T = 24 * 2;
constexpr int HS_QI = 0, HS_KO = HS_QI + 16 * HL_QD, HS_KET = HS_KO + 16 * HL_QD, HS_ATT = HS_KET + 128 * HL_T, HS_VT = HS_ATT + 16 * HL_T, HS_DEC = HS_VT + 32 * HL_T, HS_SIZE = HS_DEC + 512;
constexpr int HC_SB = HC_SUB + 4 * HS_SIZE;
constexpr int HC_ROWS = HC_SB + 2 * 32 * HL_QD, HC_CST = HC_ROWS + 256, HC_END = HC_CST + 1024;
static_assert(HC_END <= LDS_BYTES - 16, "HGRN2 LDS map");
static_assert(HS_SIZE % 16 == 0 && HC_SB % 16 == 0, "alignment");
__device__ __forceinline__ bf16x8 ldfrag16(const LAS char* tile, int ldb, int row0, int lane) {
    bf16x8 v = *(const LAS bf16x8*)(tile + (row0 + (lane & 15)) * ldb + ((lane >> 4) & 1) * 16);
    if (lane >= 32) v = (bf16x8){0, 0, 0, 0, 0, 0, 0, 0};
    return v;
}
__device__ __forceinline__ void scan_hgrn_c(int wv, KP Pk, int layer, int unit, LAS char* lds) {
    asm volatile("" : "+s"(Pk));
    const CAS Params& P = *Pk;
    const int tid = ltid(wv), lane = tid & 63, wid = tid >> 6, q = lane >> 4, r16 = lane & 15, i_ = layer >> 1;
    const int seq = unit >> 2, quarter = unit & 3, b = seq >> 3, h = (seq >> 1) & 3, dir = seq & 1;
    const bf16_t* Pb = (const bf16_t*)(P.ws + WS_P);
    bf16_t* Y = (bf16_t*)(P.ws + (dir ? WS_YB : WS_YF));
    LAS float* cst = (LAS float*)(lds + HC_CST);
    if (tid < 128) cst[tid] = ((const float*)(P.ws + WS_LB))[layer * 512 + h * 128 + tid];
    else if (tid < 256) cst[tid] = P.hg_f_bias[(size_t)(i_ * 2 + dir) * 512 + h * 128 + tid - 128];
    for (int i = tid; i < 2 * 32 * HL_QD / 4; i += NT) ((LAS unsigned*)(lds + HC_SB))[i] = 0u;
    int tj[5], tg_[5], tcol[5]; bool tv[5];
#pragma unroll
    for (int s = 0; s < 5; ++s) {
        const int task = tid + NT * s; tv[s] = task < 64 * 36; tj[s] = task / 36; tg_[s] = task % 36;
        const int g = tg_[s];
        tcol[s] = g < 16 ? (512 + dir * 512 + h * 128 + 8 * g) : g < 32 ? (h * 128 + 8 * (g - 16)) : (1536 + h * 128 + quarter * 32 + 8 * (g - 32));
    }
    u32x4 rc[5]; int rrow = 0;
    auto load = [&](int c) {
#pragma unroll
        for (int s = 0; s < 5; ++s) {
            rc[s] = (u32x4){0u, 0u, 0u, 0u};
            if (tv[s]) { const int row = scan_row(c * 64 + tj[s], b, dir, 1); rc[s] = *(const u32x4*)(Pb + (size_t)row * LDP_ODD + tcol[s]); }
        }
        if (tid < 64) rrow = scan_row(c * 64 + tid, b, dir, 1);
    };
    auto storeA = [&]() {
#pragma unroll
        for (int s = 0; s < 5; ++s) {
            if (tv[s]) {
                float f[8]; unpack8(rc[s], f);
                const int j = tj[s], g = tg_[s];
                if (g < 16) {
                    float o[8];
#pragma unroll
                    for (int e = 0; e < 8; ++e) { const float lbv = cst[8 * g + e]; o[e] = lbv + (1.f - lbv) * sigmoidf_(f[e] + cst[128 + 8 * g + e]); }
                    LAS float* dst = (LAS float*)(lds + HC_RAWF) + j * 128 + 8 * g;
                    *(LAS f32x4*)dst = (f32x4){o[0], o[1], o[2], o[3]}; *(LAS f32x4*)(dst + 4) = (f32x4){o[4], o[5], o[6], o[7]};
                } else if (g < 32) {
                    float o[8];
#pragma unroll
                    for (int e = 0; e < 8; ++e) o[e] = siluf_(f[e]);
                    *(LAS u32x4*)(lds + HC_RAWQ + (j * 128 + 8 * (g - 16)) * 2) = pack8(o);
                } else {
                    const int v0 = 8 * (g - 32);
                    LAS char* vt = lds + HC_SUB + (j >> 4) * HS_SIZE + HS_VT;
#pragma unroll
                    for (int e = 0; e < 8; ++e) { const unsigned wv = rc[s][e >> 1]; *(LAS bf16_t*)(vt + (v0 + e) * HL_T + (j & 15) * 2) = (bf16_t)((e & 1) ? (wv >> 16) : (wv & 0xffffu)); }
                }
            }
        }
        if (tid < 64) ((LAS int*)(lds + HC_ROWS))[tid] = rrow;
    };
    auto storeB = [&]() {
        const int d = tid & 127, sb = tid >> 7;
        LAS char* st = lds + HC_SUB + sb * HS_SIZE;
        const LAS float* rf = (const LAS float*)(lds + HC_RAWF) + (sb * 16) * 128 + d;
        const LAS bf16_t* rq = (const LAS bf16_t*)(lds + HC_RAWQ) + (sb * 16) * 128 + d;
        float lam = 0.f, lams[16], kfs[16];
#pragma unroll
        for (int t = 0; t < 16; ++t) {
            const float f = rf[t * 128];
            lam += __logf(f);
            const float kf = 1.f - f;
            lams[t] = lam; kfs[t] = kf;
            *(LAS bf16_t*)(st + HS_QI + t * HL_QD + d * 2) = f2bf(bf2f(rq[t * 128]) * __expf(lam));
            *(LAS bf16_t*)(st + HS_KO + t * HL_QD + d * 2) = f2bf(kf * __expf(-lam));
        }
        float ke[16];
#pragma unroll
        for (int t = 0; t < 16; ++t) ke[t] = kfs[t] * __expf(lam - lams[t]);
        *(LAS u32x4*)(st + HS_KET + d * HL_T) = pack8(ke); *(LAS u32x4*)(st + HS_KET + d * HL_T + 16) = pack8(ke + 8);
        ((LAS float*)(st + HS_DEC))[d] = __expf(lam);
    };
    f32x4 sacc[2];
    sacc[0] = sacc[1] = (f32x4){0.f, 0.f, 0.f, 0.f};
    __syncthreads();
    load(0);
    for (int c = 0; c < NSTEPS / 64; ++c) {
        storeA();
        __syncthreads();
        storeB();
        if (c + 1 < NSTEPS / 64) load(c + 1);
        __syncthreads();
        if (wid < 4) {
            LAS char* st = lds + HC_SUB + wid * HS_SIZE;
            f32x4 acc = (f32x4){0.f, 0.f, 0.f, 0.f};
#pragma unroll
            for (int k0 = 0; k0 < 128; k0 += 32) acc = __builtin_amdgcn_mfma_f32_16x16x32_bf16(ldfrag(st + HS_KO, HL_QD, 0, k0, lane), ldfrag(st + HS_QI, HL_QD, 0, k0, lane), acc, 0, 0, 0);
#pragma unroll
            for (int j = 0; j < 4; ++j) acc[j] = (4 * q + j <= r16) ? acc[j] : 0.f;
            st4bf(st + HS_ATT + r16 * HL_T + 4 * q * 2, acc);
        }
        __syncthreads();
#pragma unroll 1
        for (int sb = 0; sb < 4; ++sb) {
            LAS char* st = lds + HC_SUB + sb * HS_SIZE;
            const LAS char* sbr = lds + HC_SB + (sb & 1) * 32 * HL_QD;
            LAS char* sbw = lds + HC_SB + ((sb + 1) & 1) * 32 * HL_QD;
            if (wid < 2) {
                f32x4 ya = __builtin_amdgcn_mfma_f32_16x16x32_bf16(ldfrag16(st + HS_VT, HL_T, wid * 16, lane), ldfrag16(st + HS_ATT, HL_T, 0, lane), (f32x4){0.f, 0.f, 0.f, 0.f}, 0, 0, 0);
#pragma unroll
                for (int k0 = 0; k0 < 128; k0 += 32) ya = __builtin_amdgcn_mfma_f32_16x16x32_bf16(ldfrag(sbr, HL_QD, wid * 16, k0, lane), ldfrag(st + HS_QI, HL_QD, 0, k0, lane), ya, 0, 0, 0);
                const int row = ((const LAS int*)(lds + HC_ROWS))[sb * 16 + r16];
                u32x2 o; o.x = pk2(ya[0], ya[1]); o.y = pk2(ya[2], ya[3]);
                *(u32x2*)(Y + (size_t)row * D + h * 128 + quarter * 32 + wid * 16 + 4 * q) = o;
            }
            {
                const int vt = wid >> 2;
                const bf16x8 vf = ldfrag16(st + HS_VT, HL_T, vt * 16, lane);
#pragma unroll
                for (int u = 0; u < 2; ++u) {
                    const int dt = (wid & 3) * 2 + u;
                    const f32x4 a = __builtin_amdgcn_mfma_f32_16x16x32_bf16(ldfrag16(st + HS_KET, HL_T, dt * 16, lane), vf, (f32x4){0.f, 0.f, 0.f, 0.f}, 0, 0, 0);
                    const f32x4 dc = *(const LAS f32x4*)((const LAS float*)(st + HS_DEC) + dt * 16 + 4 * q);
#pragma unroll
                    for (int j = 0; j < 4; ++j) sacc[u][j] = sacc[u][j] * dc[j] + a[j];
                    st4bf(sbw + (vt * 16 + r16) * HL_QD + (dt * 16 + 4 * q) * 2, sacc[u]);
                }
            }
            __syncthreads();
        }
    }
}

constexpr int RC_RAWW = 0;
constexpr int RC_RAWA = RC_RAWW + 64 * 64 * 4;
constexpr int RC_RAWB = RC_RAWA + 64 * 64 * 2, RC_RAWK = RC_RAWB + 64 * 64 * 2, RC_RAWR = RC_RAWK + 64 * 64 * 2;
constexpr int RC_SUB = RC_RAWR + 64 * 64 * 2;
constexpr int RL_C = 72 * 2, RL_32 = 40 * 2, RL_16 = 24 * 2;
constexpr int RS_AT = 0, RS_RT = RS_AT + 16 * RL_C, RS_KT = RS_RT + 16 * RL_C, RS_BT = RS_KT + 16 * RL_C, RS_KBH = RS_BT + 16 * RL_C, RS_AAK = RS_KBH + 64 * RL_32,
              RS_ARKB = RS_AAK + 16 * RL_16, RS_T = RS_ARKB + 16 * RL_32, RS_AABF = RS_T + 16 * RL_16, RS_GL = RS_AABF + 16 * 16 * 4, RS_VU = RS_GL + 256, RS_SIZE = RS_VU + 32 * RL_32;
constexpr int RC_SB = RC_SUB + 4 * RS_SIZE;
constexpr int RC_RHT = RC_SB + 32 * RL_C;
constexpr int RC_ROWS = RC_RHT + 32 * RL_16, RC_END = RC_ROWS + 256;
static_assert(RC_END <= LDS_BYTES - 16, "RWKV LDS map");
static_assert(RS_SIZE % 16 == 0 && RC_SB % 16 == 0 && RC_RHT % 16 == 0, "alignment");
__device__ __forceinline__ void scan_rwkv_c(int wv, KP Pk, int layer, int unit, LAS char* lds) {
    asm volatile("" : "+s"(Pk));
    const CAS Params& P = *Pk;
    const int tid = ltid(wv), lane = tid & 63, wid = tid >> 6, q = lane >> 4, r16 = lane & 15;
    const int seq = unit >> 1, half = unit & 1, b = seq >> 4, h = (seq >> 1) & 7, dir = seq & 1;
    bf16_t* Y = (bf16_t*)(P.ws + (dir ? WS_YB : WS_YF));
    const float* dec = (const float*)(P.ws + WS_RWDEC) + (size_t)dir * NROWS * 512;
    for (int i = tid; i < 32 * RL_C / 4; i += NT) ((LAS unsigned*)(lds + RC_SB))[i] = 0u;
    const unsigned char* const wsb = P.ws;
    u32x4 rc[7]; int rrow = 0;
    auto load = [&](int c) {
        int tl = tid; asm volatile("" : "+v"(tl));
#pragma unroll
        for (int s = 0; s < 7; ++s) {
            const int task = tl + NT * s, j = task / 52, g = task - 52 * j;
            rc[s] = (u32x4){0u, 0u, 0u, 0u};
            if (task < 64 * 52) {
                const int row = scan_row(c * 64 + j, b, dir, 1);
                const unsigned char* p;
                if (g < 8)       p = wsb + WS_RWR  + ((size_t)row * 512 + h * 64 + 8 * g) * 2;
                else if (g < 16) p = wsb + WS_RWK  + ((size_t)row * 512 + h * 64 + 8 * (g - 8)) * 2;
                else if (g < 24) p = wsb + WS_RWKK + ((size_t)row * 512 + h * 64 + 8 * (g - 16)) * 2;
                else if (g < 32) p = wsb + WS_RWB  + ((size_t)row * 512 + h * 64 + 8 * (g - 24)) * 2;
                else if (g < 36) p = wsb + WS_RWV  + ((size_t)row * 512 + h * 64 + half * 32 + 8 * (g - 32)) * 2;
                else             p = (const unsigned char*)(dec + (size_t)row * 512 + h * 64 + 4 * (g - 36));
                rc[s] = *(const u32x4*)p;
            }
        }
        if (tid < 64) rrow = scan_row(c * 64 + tid, b, dir, 1);
    };
    auto storeA = [&]() {
        int tl = tid; asm volatile("" : "+v"(tl));
#pragma unroll
        for (int s = 0; s < 7; ++s) {
            const int task = tl + NT * s, j = task / 52, g = task - 52 * j;
            if (task < 64 * 52) {
                if (g < 8)       *(LAS u32x4*)(lds + RC_RAWR + (j * 64 + 8 * g) * 2) = rc[s];
                else if (g < 16) *(LAS u32x4*)(lds + RC_RAWK + (j * 64 + 8 * (g - 8)) * 2) = rc[s];
                else if (g < 24) *(LAS u32x4*)(lds + RC_RAWA + (j * 64 + 8 * (g - 16)) * 2) = rc[s];
                else if (g < 32) *(LAS u32x4*)(lds + RC_RAWB + (j * 64 + 8 * (g - 24)) * 2) = rc[s];
                else if (g < 36) {
                    LAS char* vu = lds + RC_SUB + (j >> 4) * RS_SIZE + RS_VU;
                    const int v0 = 8 * (g - 32);
#pragma unroll
                    for (int e = 0; e < 8; ++e) { const unsigned wv = rc[s][e >> 1]; *(LAS bf16_t*)(vu + (v0 + e) * RL_32 + (j & 15) * 2) = (bf16_t)((e & 1) ? (wv >> 16) : (wv & 0xffffu)); }
                } else *(LAS u32x4*)(lds + RC_RAWW + (j * 64 + 4 * (g - 36)) * 4) = rc[s];
            }
        }
        if (tid < 64) ((LAS int*)(lds + RC_ROWS))[tid] = rrow;
    };
    auto storeB = [&]() {
        const int c = tid & 63, sb = (tid >> 6) & 3, role = tid >> 8;
        LAS char* st = lds + RC_SUB + sb * RS_SIZE;
        const LAS float* rw = (const LAS float*)(lds + RC_RAWW) + (sb * 16) * 64 + c;
        float g = 1.f;
        if (role == 0) {
            const LAS bf16_t* ra = (const LAS bf16_t*)(lds + RC_RAWA) + (sb * 16) * 64 + c;
            const LAS bf16_t* rr = (const LAS bf16_t*)(lds + RC_RAWR) + (sb * 16) * 64 + c;
#pragma unroll
            for (int t = 0; t < 16; ++t) {
                const float gp = g; g *= rw[t * 64];
                *(LAS bf16_t*)(st + RS_AT + t * RL_C + c * 2) = f2bf(-bf2f(ra[t * 64]) * gp);
                *(LAS bf16_t*)(st + RS_RT + t * RL_C + c * 2) = f2bf(bf2f(rr[t * 64]) * g);
            }
        } else {
            const LAS bf16_t* rk = (const LAS bf16_t*)(lds + RC_RAWK) + (sb * 16) * 64 + c;
            const LAS bf16_t* rb = (const LAS bf16_t*)(lds + RC_RAWB) + (sb * 16) * 64 + c;
            float ks[16], bs[16];
#pragma unroll
            for (int t = 0; t < 16; ++t) {
                g *= rw[t * 64];
                const float inv = 1.f / g;
                ks[t] = bf2f(rk[t * 64]) * inv; bs[t] = bf2f(rb[t * 64]) * inv;
                *(LAS bf16_t*)(st + RS_KT + t * RL_C + c * 2) = f2bf(ks[t]);
                *(LAS bf16_t*)(st + RS_BT + t * RL_C + c * 2) = f2bf(bs[t]);
            }
#pragma unroll
            for (int t = 0; t < 16; ++t) { ks[t] *= g; bs[t] *= g; }
            LAS char* row = st + RS_KBH + c * RL_32;
            *(LAS u32x4*)row = pack8(ks); *(LAS u32x4*)(row + 16) = pack8(ks + 8); *(LAS u32x4*)(row + 32) = pack8(bs); *(LAS u32x4*)(row + 48) = pack8(bs + 8);
            ((LAS float*)(st + RS_GL))[c] = g;
        }
    };
    f32x4 sacc[4];
#pragma unroll
    for (int i = 0; i < 4; ++i) sacc[i] = (f32x4){0.f, 0.f, 0.f, 0.f};
    __syncthreads();
    load(0);
    for (int c = 0; c < NSTEPS / 64; ++c) {
        storeA();
        __syncthreads();
        storeB();
        if (c + 1 < NSTEPS / 64) load(c + 1);
        __syncthreads();
#pragma unroll
        for (int u = 0; u < 2; ++u) {
            const int task = wid + 8 * u, m = task & 3, sb = task >> 2;
            LAS char* st = lds + RC_SUB + sb * RS_SIZE;
            const LAS char* ta = st + ((m == 0 || m == 3) ? RS_BT : RS_KT);
            const LAS char* tb = st + (m < 2 ? RS_AT : RS_RT);
            f32x4 acc = (f32x4){0.f, 0.f, 0.f, 0.f};
#pragma unroll
            for (int k0 = 0; k0 < 64; k0 += 32) acc = __builtin_amdgcn_mfma_f32_16x16x32_bf16(ldfrag(ta, RL_C, 0, k0, lane), ldfrag(tb, RL_C, 0, k0, lane), acc, 0, 0, 0);
#pragma unroll
            for (int j = 0; j < 4; ++j) { const int s = 4 * q + j; acc[j] = (m < 2 ? (s < r16) : (s <= r16)) ? acc[j] : 0.f; }
            if (m == 0) *(LAS f32x4*)((LAS float*)(st + RS_AABF) + r16 * 16 + 4 * q) = acc;
            else if (m == 1) st4bf(st + RS_AAK + r16 * RL_16 + 4 * q * 2, acc);
            else if (m == 2) st4bf(st + RS_ARKB + r16 * RL_32 + 4 * q * 2, acc);
            else st4bf(st + RS_ARKB + r16 * RL_32 + (16 + 4 * q) * 2, acc);
        }
        __syncthreads();
        if (wid < 4) {
            LAS char* st = lds + RC_SUB + wid * RS_SIZE;
            const LAS float* A = (const LAS float*)(st + RS_AABF);
            const int j = lane & 15;
            float tc[16];
#pragma unroll
            for (int t = 0; t < 16; ++t) {
                float val = (t == j) ? 1.f : 0.f;
                const f32x4 a0 = *(const LAS f32x4*)(A + t * 16), a1 = *(const LAS f32x4*)(A + t * 16 + 4), a2 = *(const LAS f32x4*)(A + t * 16 + 8), a3 = *(const LAS f32x4*)(A + t * 16 + 12);
                const float ar[16] = {a0[0], a0[1], a0[2], a0[3], a1[0], a1[1], a1[2], a1[3], a2[0], a2[1], a2[2], a2[3], a3[0], a3[1], a3[2], a3[3]};
#pragma unroll
                for (int s = 0; s < 16; ++s) if (s < t) val += ar[s] * tc[s];
                tc[t] = val;
            }
            if (lane < 16) {
#pragma unroll
                for (int t = 0; t < 16; ++t) *(LAS bf16_t*)(st + RS_T + t * RL_16 + j * 2) = f2bf(tc[t]);
            }
        }
        __syncthreads();
        if (wid < 2) {
            LAS char* sbt = lds + RC_SB + wid * 16 * RL_C;
            LAS char* rht = lds + RC_RHT + wid * 16 * RL_16;
#pragma unroll 1
            for (int sb = 0; sb < 4; ++sb) {
                LAS char* st = lds + RC_SUB + sb * RS_SIZE;
                LAS char* vu = st + RS_VU + wid * 16 * RL_32;
                f32x4 acc = __builtin_amdgcn_mfma_f32_16x16x32_bf16(ldfrag16(st + RS_AAK, RL_16, 0, lane), ldfrag16(vu, RL_32, 0, lane), (f32x4){0.f, 0.f, 0.f, 0.f}, 0, 0, 0);
#pragma unroll
                for (int k0 = 0; k0 < 64; k0 += 32) acc = __builtin_amdgcn_mfma_f32_16x16x32_bf16(ldfrag(st + RS_AT, RL_C, 0, k0, lane), ldfrag(sbt, RL_C, 0, k0, lane), acc, 0, 0, 0);
                st4bf(rht + r16 * RL_16 + 4 * q * 2, acc);
                asm volatile("s_waitcnt lgkmcnt(0)" ::: "memory");
                acc = __builtin_amdgcn_mfma_f32_16x16x32_bf16(ldfrag16(st + RS_T, RL_16, 0, lane), ldfrag16(rht, RL_16, 0, lane), (f32x4){0.f, 0.f, 0.f, 0.f}, 0, 0, 0);
                st4bf(vu + r16 * RL_32 + (16 + 4 * q) * 2, acc);
                asm volatile("s_waitcnt lgkmcnt(0)" ::: "memory");
                const bf16x8 vuf = ldfrag(vu, RL_32, 0, 0, lane);
                f32x4 ya = __builtin_amdgcn_mfma_f32_16x16x32_bf16(vuf, ldfrag(st + RS_ARKB, RL_32, 0, 0, lane), (f32x4){0.f, 0.f, 0.f, 0.f}, 0, 0, 0);
#pragma unroll
                for (int k0 = 0; k0 < 64; k0 += 32) ya = __builtin_amdgcn_mfma_f32_16x16x32_bf16(ldfrag(sbt, RL_C, 0, k0, lane), ldfrag(st + RS_RT, RL_C, 0, k0, lane), ya, 0, 0, 0);
                {
                    const int row = ((const LAS int*)(lds + RC_ROWS))[sb * 16 + r16];
                    u32x2 o; o.x = pk2(ya[0], ya[1]); o.y = pk2(ya[2], ya[3]);
                    *(u32x2*)(Y + (size_t)row * D + 512 + h * 64 + half * 32 + wid * 16 + 4 * q) = o;
                }
                asm volatile("s_waitcnt lgkmcnt(0)" ::: "memory");
#pragma unroll
                for (int kt = 0; kt < 4; ++kt) {
                    const f32x4 a = __builtin_amdgcn_mfma_f32_16x16x32_bf16(ldfrag(st + RS_KBH, RL_32, kt * 16, 0, lane), vuf, (f32x4){0.f, 0.f, 0.f, 0.f}, 0, 0, 0);
                    const f32x4 gl = *(const LAS f32x4*)((const LAS float*)(st + RS_GL) + kt * 16 + 4 * q);
#pragma unroll
                    for (int j = 0; j < 4; ++j) sacc[kt][j] = sacc[kt][j] * gl[j] + a[j];
                    st4bf(sbt + r16 * RL_C + (kt * 16 + 4 * q) * 2, sacc[kt]);
                }
                asm volatile("s_waitcnt lgkmcnt(0)" ::: "memory");
            }
        }
        __syncthreads();
    }
}

__device__ __forceinline__ float allreduce8(float v) {
    v += dppmov<0xB1>(v); v += dppmov<0x4E>(v); v += dppmov<0x141>(v);
    return v;
}
__device__ __forceinline__ void scan_rwkv2(int wv, KP Pk, int layer, int unit, LAS char* lds) {
    asm volatile("" : "+s"(Pk));
    const CAS Params& P = *Pk;
    const int tid = ltid(wv);
    const int seq = unit >> 1, half = unit & 1, b = seq >> 4, h = (seq >> 1) & 7, dir = seq & 1;
    (void)layer;
    LAS float* bufs = (LAS float*)lds;
    bf16_t* Y = (bf16_t*)(P.ws + (dir ? WS_YB : WS_YF));
    const float* dec = (const float*)(P.ws + WS_RWDEC) + (size_t)dir * NROWS * 512;
    const unsigned char* const wsb = P.ws;
    const bool stager = tid >= 256;
    auto stage = [&](int c) {
        int tl = tid - 256; asm volatile("" : "+v"(tl));
        LAS float* buf = bufs + (c & 1) * RW_BUF;
        u32x4 rc[7];
#pragma unroll
        for (int s = 0; s < 7; ++s) {
            const int task = tl + 256 * s, j = task / 52, g = task - 52 * j;
            rc[s] = (u32x4){0u, 0u, 0u, 0u};
            if (task < TCH * 52) {
                const int row = scan_row(c * TCH + j, b, dir, 1);
                const unsigned char* p;
                if (g < 8)       p = wsb + WS_RWR  + ((size_t)row * 512 + h * 64 + 8 * g) * 2;
                else if (g < 16) p = wsb + WS_RWK  + ((size_t)row * 512 + h * 64 + 8 * (g - 8)) * 2;
                else if (g < 24) p = wsb + WS_RWKK + ((size_t)row * 512 + h * 64 + 8 * (g - 16)) * 2;
                else if (g < 32) p = wsb + WS_RWB  + ((size_t)row * 512 + h * 64 + 8 * (g - 24)) * 2;
                else if (g < 36) p = wsb + WS_RWV  + ((size_t)row * 512 + h * 64 + half * 32 + 8 * (g - 32)) * 2;
                else             p = (const unsigned char*)(dec + (size_t)row * 512 + h * 64 + 4 * (g - 36));
                rc[s] = *(const u32x4*)p;
            }
        }
        if (tl < TCH) ((LAS int*)buf)[TCH * RW_F + tl] = scan_row(c * TCH + tl, b, dir, 1);
#pragma unroll
        for (int s = 0; s < 7; ++s) {
            const int task = tl + 256 * s, j = task / 52, g = task - 52 * j;
            if (task < TCH * 52) {
                const int lo = g < 8 ? 256 + 8 * g : g < 16 ? 192 + 8 * (g - 8) : g < 24 ? 64 + 8 * (g - 16) : g < 32 ? 128 + 8 * (g - 24) : g < 36 ? 320 + 8 * (g - 32) : 4 * (g - 36);
                LAS float* dst = buf + j * RW_F + lo;
                if (g >= 36) *(LAS u32x4*)dst = rc[s];
                else {
                    float f[8]; unpack8(rc[s], f);
                    const float sg = (g >= 16 && g < 24) ? -1.f : 1.f;
                    *(LAS f32x4*)dst = (f32x4){sg * f[0], sg * f[1], sg * f[2], sg * f[3]}; *(LAS f32x4*)(dst + 4) = (f32x4){sg * f[4], sg * f[5], sg * f[6], sg * f[7]};
                }
            }
        }
    };
    const int vrow = (tid >> 3) & 31, q8 = tid & 7;
    float S[8];
#pragma unroll
    for (int e = 0; e < 8; ++e) S[e] = 0.f;
    if (stager) stage(0);
    __syncthreads();
    for (int c = 0; c < NCHUNK; ++c) {
        if (stager) { if (c + 1 < NCHUNK) stage(c + 1); }
        else {
            const LAS float* buf = bufs + (c & 1) * RW_BUF;
            const LAS float* wp = buf + 4 * q8;
            const LAS float* vp = buf + 320 + vrow;
            f32x4 w0 = *(const LAS f32x4*)wp, w1 = *(const LAS f32x4*)(wp + 32), a0 = *(const LAS f32x4*)(wp + 64), a1 = *(const LAS f32x4*)(wp + 96), b0 = *(const LAS f32x4*)(wp + 128), b1 = *(const LAS f32x4*)(wp + 160),
                  k0 = *(const LAS f32x4*)(wp + 192), k1 = *(const LAS f32x4*)(wp + 224), r0 = *(const LAS f32x4*)(wp + 256), r1 = *(const LAS f32x4*)(wp + 288);
            float vr = vp[0];
            float ysel = 0.f;
#pragma unroll 2
            for (int jj = 0; jj < TCH; ++jj) {
                const f32x4 wc0 = w0, wc1 = w1, ac0 = a0, ac1 = a1, bc0 = b0, bc1 = b1, kc0 = k0, kc1 = k1, rc0 = r0, rc1 = r1; const float vv = vr;
                if (jj + 1 < TCH) {
                    const LAS float* np = wp + (jj + 1) * RW_F;
                    w0 = *(const LAS f32x4*)np; w1 = *(const LAS f32x4*)(np + 32); a0 = *(const LAS f32x4*)(np + 64); a1 = *(const LAS f32x4*)(np + 96); b0 = *(const LAS f32x4*)(np + 128); b1 = *(const LAS f32x4*)(np + 160);
                    k0 = *(const LAS f32x4*)(np + 192); k1 = *(const LAS f32x4*)(np + 224); r0 = *(const LAS f32x4*)(np + 256); r1 = *(const LAS f32x4*)(np + 288); vr = vp[(jj + 1) * RW_F];
                }
                float sa = 0.f;
#pragma unroll
                for (int e = 0; e < 4; ++e) sa += S[e] * ac0[e] + S[4 + e] * ac1[e];
                sa = allreduce8(sa);
                float y = 0.f;
#pragma unroll
                for (int e = 0; e < 4; ++e) {
                    S[e] = S[e] * wc0[e] + (sa * bc0[e] + vv * kc0[e]); y += S[e] * rc0[e];
                    S[4 + e] = S[4 + e] * wc1[e] + (sa * bc1[e] + vv * kc1[e]); y += S[4 + e] * rc1[e];
                }
                y = allreduce8(y);
                ysel = (q8 == (jj & 7)) ? y : ysel;
                if ((jj & 7) == 7) {
                    const int row = ((const LAS int*)buf)[TCH * RW_F + (jj - 7) + q8];
                    Y[(size_t)row * D + 512 + h * 64 + half * 32 + vrow] = f2bf(ysel);
                }
            }
        }
        __syncthreads();
    }
}
__device__ __forceinline__ void scan_hgrn2(int wv, KP Pk, int layer, int unit, LAS char* lds) {
    asm volatile("" : "+s"(Pk));
    const CAS Params& P = *Pk;
    const int tid = ltid(wv), i_ = layer >> 1;
    const int seq = unit >> 2, quarter = unit & 3, b = seq >> 3, h = (seq >> 1) & 3, dir = seq & 1;
    LAS float* cst = (LAS float*)lds;
    LAS float* bufs = cst + 256;
    const bf16_t* Pb = (const bf16_t*)(P.ws + WS_P);
    bf16_t* Y = (bf16_t*)(P.ws + (dir ? WS_YB : WS_YF));
    if (tid < 128) cst[tid] = ((const float*)(P.ws + WS_LB))[layer * 512 + h * 128 + tid];
    else if (tid < 256) cst[tid] = P.hg_f_bias[(size_t)(i_ * 2 + dir) * 512 + h * 128 + tid - 128];
    const bool stager = tid >= 256;
    auto stage = [&](int c) {
        int tl = tid - 256; asm volatile("" : "+v"(tl));
        LAS float* buf = bufs + (c & 1) * HG_BUF;
        u32x4 rc[5];
#pragma unroll
        for (int s = 0; s < 5; ++s) {
            const int task = tl + 256 * s, j = task / 36, g = task - 36 * j;
            rc[s] = (u32x4){0u, 0u, 0u, 0u};
            if (task < TCH * 36) {
                const int row = scan_row(c * TCH + j, b, dir, 1);
                const int col = g < 16 ? (512 + dir * 512 + h * 128 + 8 * g) : g < 32 ? (h * 128 + 8 * (g - 16)) : (1536 + h * 128 + quarter * 32 + 8 * (g - 32));
                rc[s] = *(const u32x4*)(Pb + (size_t)row * LDP_ODD + col);
            }
        }
        if (tl < TCH) ((LAS int*)buf)[TCH * HG_F + tl] = scan_row(c * TCH + tl, b, dir, 1);
#pragma unroll
        for (int s = 0; s < 5; ++s) {
            const int task = tl + 256 * s, j = task / 36, g = task - 36 * j;
            if (task < TCH * 36) {
                float fc[8], o[8]; unpack8(rc[s], fc);
                const int lc = g * 8;
                if (g < 16) {
#pragma unroll
                    for (int e = 0; e < 8; ++e) { const float lbv = cst[lc + e]; o[e] = lbv + (1.f - lbv) * sigmoidf_(fc[e] + cst[128 + lc + e]); }
                } else if (g < 32) {
#pragma unroll
                    for (int e = 0; e < 8; ++e) o[e] = siluf_(fc[e]);
                } else {
#pragma unroll
                    for (int e = 0; e < 8; ++e) o[e] = fc[e];
                }
                LAS float* dst = buf + j * HG_F + lc;
                *(LAS f32x4*)dst = (f32x4){o[0], o[1], o[2], o[3]}; *(LAS f32x4*)(dst + 4) = (f32x4){o[4], o[5], o[6], o[7]};
            }
        }
    };
    const int col = (tid >> 3) & 31, q8 = tid & 7;
    float S[16];
#pragma unroll
    for (int e = 0; e < 16; ++e) S[e] = 0.f;
    __syncthreads();
    if (stager) stage(0);
    __syncthreads();
    for (int c = 0; c < NCHUNK; ++c) {
        if (stager) { if (c + 1 < NCHUNK) stage(c + 1); }
        else {
            const LAS float* buf = bufs + (c & 1) * HG_BUF;
            const LAS float* fp = buf + 4 * q8;
            const LAS float* vp = buf + 256 + col;
            f32x4 f[4], qv[4]; float vr = vp[0];
#pragma unroll
            for (int m = 0; m < 4; ++m) { f[m] = *(const LAS f32x4*)(fp + 32 * m); qv[m] = *(const LAS f32x4*)(fp + 128 + 32 * m); }
            float ysel = 0.f;
#pragma unroll 2
            for (int jj = 0; jj < TCH; ++jj) {
                f32x4 fc[4], qc[4]; const float vv = vr;
#pragma unroll
                for (int m = 0; m < 4; ++m) { fc[m] = f[m]; qc[m] = qv[m]; }
                if (jj + 1 < TCH) {
                    const LAS float* np = fp + (jj + 1) * HG_F;
#pragma unroll
                    for (int m = 0; m < 4; ++m) { f[m] = *(const LAS f32x4*)(np + 32 * m); qv[m] = *(const LAS f32x4*)(np + 128 + 32 * m); }
                    vr = vp[(jj + 1) * HG_F];
                }
                float o = 0.f;
#pragma unroll
                for (int m = 0; m < 4; ++m)
#pragma unroll
                    for (int e = 0; e < 4; ++e) { S[4 * m + e] = fc[m][e] * (S[4 * m + e] - vv) + vv; o += qc[m][e] * S[4 * m + e]; }
                o = allreduce8(o);
                ysel = (q8 == (jj & 7)) ? o : ysel;
                if ((jj & 7) == 7) {
                    const int row = ((const LAS int*)buf)[TCH * HG_F + (jj - 7) + q8];
                    Y[(size_t)row * D + h * 128 + quarter * 32 + col] = f2bf(ysel);
                }
            }
        }
        __syncthreads();
    }
}

__device__ __forceinline__ void phase_prep1(int wv, KP Pk, int layer) {
    asm volatile("" : "+s"(Pk));
    const CAS Params& P = *Pk;
    const int tid = ltid(wv), lane = tid & 63, wid = tid >> 6, i_ = layer >> 1;
    const bf16_t* Pb = (const bf16_t*)(P.ws + WS_P);
    bf16_t* R = (bf16_t*)(P.ws + WS_RWR); bf16_t* K = (bf16_t*)(P.ws + WS_RWK); bf16_t* V = (bf16_t*)(P.ws + WS_RWV); bf16_t* KK = (bf16_t*)(P.ws + WS_RWKK);
    bf16_t* LA = (bf16_t*)(P.ws + WS_LA);
    const float* mu = P.rw_mu + (size_t)i_ * 1856;
    for (int r = blockIdx.x * 8 + wid; r < NROWS; r += gridDim.x * 8) {
        int rprev = -1, rnext = -1;
        if (r < NCTX) { const int t = r & 255; if (t > 0) rprev = r - 1; if (t < CTXL - 1) rnext = r + 1; }
        else {
            const int bs = (r - NCTX) >> 13, s = (r - NCTX) & 8191, sg = ((s & 63) << 7) + (s >> 6);
            if (sg > 0) { const int g2 = sg - 1; rprev = NCTX + bs * SEQ + ((g2 & 127) << 6) + (g2 >> 7); }
            if (sg < SEQ - 1) { const int g2 = sg + 1; rnext = NCTX + bs * SEQ + ((g2 & 127) << 6) + (g2 >> 7); }
        }
        const bf16_t* pc = Pb + (size_t)r * LDP_ODD + 2560;
        const bf16_t* pp = Pb + (size_t)(rprev < 0 ? r : rprev) * LDP_ODD + 2560;
        const bf16_t* pn = Pb + (size_t)(rnext < 0 ? r : rnext) * LDP_ODD + 2560;
        const float mp = rprev < 0 ? 0.f : 0.5f, mn = rnext < 0 ? 0.f : 0.5f;
        auto mix8 = [&](int col, float* o) {
            float fc[8], fp[8], fn[8];
            unpack8(*(const u32x4*)(pc + col), fc); unpack8(*(const u32x4*)(pp + col), fp); unpack8(*(const u32x4*)(pn + col), fn);
#pragma unroll
            for (int e = 0; e < 8; ++e) o[e] = fc[e] + mu[col + e] * (mp * fp[e] + mn * fn[e] - fc[e]);
        };
        float o[8];
        mix8(8 * lane, o); *(u32x4*)(R + (size_t)r * 512 + 8 * lane) = pack8(o);
        mix8(1024 + 8 * lane, o); *(u32x4*)(V + (size_t)r * 512 + 8 * lane) = pack8(o);
        mix8(512 + 8 * lane, o); *(u32x4*)(K + (size_t)r * 512 + 8 * lane) = pack8(o);
        {
            float kk[8], ss = 0.f;
#pragma unroll
            for (int e = 0; e < 8; ++e) { kk[e] = o[e] * P.rw_k_k[i_ * 512 + 8 * lane + e]; ss += kk[e] * kk[e]; }
            ss = group_sum<8>(ss);
            const float rn = rsqrtf(fmaxf(ss, 1e-12f));
#pragma unroll
            for (int e = 0; e < 8; ++e) kk[e] *= rn;
            *(u32x4*)(KK + (size_t)r * 512 + 8 * lane) = pack8(kk);
        }
        if (lane < 40) {
            mix8(1536 + 8 * lane, o);
            if (lane < 16) {
#pragma unroll
                for (int e = 0; e < 8; ++e) o[e] = tanh_fast(o[e]);
            } else if (lane >= 24) {
#pragma unroll
                for (int e = 0; e < 8; ++e) o[e] = sigmoidf_(o[e]);
            }
            *(u32x4*)(LA + (size_t)r * 320 + 8 * lane) = pack8(o);
        }
    }
}

__device__ __forceinline__ void phase_out_even(int wv, KP Pk, int layer) {
    asm volatile("" : "+s"(Pk));
    const CAS Params& P = *Pk;
    const int tid = ltid(wv), lane = tid & 63, wid = tid >> 6, i_ = layer >> 1;
    const bf16_t* Pb = (const bf16_t*)(P.ws + WS_P);
    const bf16_t* Yf = (const bf16_t*)(P.ws + WS_YF); const bf16_t* Yb = (const bf16_t*)(P.ws + WS_YB);
    bf16_t* feat = (bf16_t*)(P.ws + WS_FEAT);
    const int r0 = (layer == DEPTH - 1) ? NCTX : 0;
    const bf16_t* XBC = (const bf16_t*)(P.ws + WS_EXBC);
    float nwa[8], nwb[8];
#pragma unroll
    for (int e = 0; e < 8; ++e) { nwa[e] = P.ssd_norm_w[i_ * 512 + 8 * lane + e]; nwb[e] = P.ml_norm_w[i_ * 512 + 8 * lane + e]; }
    const float dsk = P.ssd_d[i_ * 8 + (lane >> 3)];
    for (int r = r0 + blockIdx.x * 8 + wid; r < NROWS; r += gridDim.x * 8) {
        const bf16_t* pr = Pb + (size_t)r * LDP_EVEN;
        float y[8];
        {
            float a[8], bb[8], xsv[8], z[8];
            unpack8(*(const u32x4*)(Yf + (size_t)r * D + 8 * lane), a); unpack8(*(const u32x4*)(Yb + (size_t)r * D + 8 * lane), bb);
            unpack8(*(const u32x4*)(XBC + (size_t)r * 768 + 8 * lane), xsv); unpack8(*(const u32x4*)(pr + 8 * lane), z);
            float ss = 0.f;
#pragma unroll
            for (int e = 0; e < 8; ++e) {
                y[e] = (a[e] + bb[e] + dsk * xsv[e]) * siluf_(z[e]); ss += y[e] * y[e];
            }
            ss = wave_sum(ss);
            const float rn = rsqrtf(ss * (1.f / 512.f) + 1e-6f);
#pragma unroll
            for (int e = 0; e < 8; ++e) y[e] = y[e] * rn * nwa[e];
            *(u32x4*)(feat + (size_t)r * D + 8 * lane) = pack8(y);
        }
        {
            float a[8], bb[8], o[8];
            unpack8(*(const u32x4*)(Yf + (size_t)r * D + 512 + 8 * lane), a); unpack8(*(const u32x4*)(Yb + (size_t)r * D + 512 + 8 * lane), bb);
            unpack8(*(const u32x4*)(pr + 2320 + 8 * lane), o);
            float s = 0.f;
#pragma unroll
            for (int e = 0; e < 8; ++e) { y[e] = a[e] + bb[e]; s += y[e]; }
            const float mean = group_sum<16>(s) * (1.f / 128.f);
            float ss = 0.f;
#pragma unroll
            for (int e = 0; e < 8; ++e) { y[e] -= mean; ss += y[e] * y[e]; }
            const float rn = rsqrtf(group_sum<16>(ss) * (1.f / 128.f) + 1e-6f);
#pragma unroll
            for (int e = 0; e < 8; ++e) y[e] = sigmoidf_(o[e]) * (y[e] * rn) * nwb[e];
            *(u32x4*)(feat + (size_t)r * D + 512 + 8 * lane) = pack8(y);
        }
    }
}
__device__ __forceinline__ void phase_out_odd(int wv, KP Pk, int layer) {
    asm volatile("" : "+s"(Pk));
    const CAS Params& P = *Pk;
    const int tid = ltid(wv), lane = tid & 63, wid = tid >> 6, i_ = layer >> 1;
    const bf16_t* Pb = (const bf16_t*)(P.ws + WS_P);
    const bf16_t* Yf = (const bf16_t*)(P.ws + WS_YF); const bf16_t* Yb = (const bf16_t*)(P.ws + WS_YB);
    const bf16_t* R = (const bf16_t*)(P.ws + WS_RWR); const bf16_t* K = (const bf16_t*)(P.ws + WS_RWK); const bf16_t* V = (const bf16_t*)(P.ws + WS_RWV); const bf16_t* G = (const bf16_t*)(P.ws + WS_RWG);
    bf16_t* feat = (bf16_t*)(P.ws + WS_FEAT);
    const int r0 = (layer == DEPTH - 1) ? NCTX : 0;
    float nwc[8], rk[8], lw[8], lbv[8];
#pragma unroll
    for (int e = 0; e < 8; ++e) {
        nwc[e] = P.hg_norm_w[i_ * 512 + 8 * lane + e]; rk[e] = P.rw_r_k[i_ * 512 + 8 * lane + e];
        lw[e] = P.rw_ln_w[i_ * 512 + 8 * lane + e]; lbv[e] = P.rw_ln_b[i_ * 512 + 8 * lane + e];
    }
    for (int r = r0 + blockIdx.x * 8 + wid; r < NROWS; r += gridDim.x * 8) {
        float y[8];
        {
            float a[8], bb[8], g[8];
            unpack8(*(const u32x4*)(Yf + (size_t)r * D + 8 * lane), a); unpack8(*(const u32x4*)(Yb + (size_t)r * D + 8 * lane), bb);
            unpack8(*(const u32x4*)(Pb + (size_t)r * LDP_ODD + 2048 + 8 * lane), g);
            float ss = 0.f;
#pragma unroll
            for (int e = 0; e < 8; ++e) { y[e] = a[e] + bb[e]; ss += y[e] * y[e]; }
            const float rn = rsqrtf(group_sum<16>(ss) * (1.f / 128.f) + 1e-6f);
#pragma unroll
            for (int e = 0; e < 8; ++e) y[e] = y[e] * rn * nwc[e] * siluf_(g[e]);
            *(u32x4*)(feat + (size_t)r * D + 8 * lane) = pack8(y);
        }
        {
            float a[8], bb[8], rr[8], kk[8], vv[8], g[8];
            unpack8(*(const u32x4*)(Yf + (size_t)r * D + 512 + 8 * lane), a); unpack8(*(const u32x4*)(Yb + (size_t)r * D + 512 + 8 * lane), bb);
            unpack8(*(const u32x4*)(R + (size_t)r * 512 + 8 * lane), rr); unpack8(*(const u32x4*)(K + (size_t)r * 512 + 8 * lane), kk);
            unpack8(*(const u32x4*)(V + (size_t)r * 512 + 8 * lane), vv); unpack8(*(const u32x4*)(G + (size_t)r * 512 + 8 * lane), g);
            float s = 0.f, bs = 0.f;
#pragma unroll
            for (int e = 0; e < 8; ++e) { y[e] = a[e] + bb[e]; s += y[e]; bs += rr[e] * kk[e] * rk[e]; }
            const float mean = group_sum<8>(s) * (1.f / 64.f); bs = group_sum<8>(bs);
            float ss = 0.f;
#pragma unroll
            for (int e = 0; e < 8; ++e) { y[e] -= mean; ss += y[e] * y[e]; }
            const float rn = rsqrtf(group_sum<8>(ss) * (1.f / 64.f) + 64e-5f);
#pragma unroll
            for (int e = 0; e < 8; ++e) y[e] = (y[e] * rn * lw[e] + lbv[e] + bs * vv[e]) * g[e];
            *(u32x4*)(feat + (size_t)r * D + 512 + 8 * lane) = pack8(y);
        }
    }
}

#ifndef MK_DOUBLE
#define MK_DOUBLE 0
#endif
#define REP(bit, body) do { body; if (MK_DOUBLE & (bit)) { body; } } while (0)
__device__ __forceinline__ void phase_expconv(int wv, KP Pk, int layer, LAS char* lds) {
    asm volatile("" : "+s"(Pk));
    const CAS Params& P = *Pk;
    const int tid = ltid(wv), lane = tid & 63, wid = tid >> 6;
    {
        LAS float* scr = (LAS float*)(lds + wid * 8448);
        const int gw = blockIdx.x * 8 + wid, NGW = gridDim.x * 8;
        bf16_t* gu = (bf16_t*)(P.ws + WS_EXPGU); bf16_t* dw = (bf16_t*)(P.ws + WS_EXPD);
        constexpr int IG = 16 * 16, IDN = 8 * 32;
        for (int it = gw; it < NEXP * (2 * IG + IDN); it += NGW) {
            const int e = it / (2 * IG + IDN); int r = it % (2 * IG + IDN);
            const size_t eo = (size_t)(layer * NEXP + e);
            if (r < IG) { transpose_item(P.exp_w_gate + eo * D * DEXP, D, DEXP, gu + (size_t)e * 1024 * 1024, 1, scr, r, lane); continue; } r -= IG;
            if (r < IG) { transpose_item(P.exp_w_up + eo * D * DEXP, D, DEXP, gu + (size_t)e * 1024 * 1024, 2, scr, r, lane); continue; } r -= IG;
            transpose_item(P.exp_w_down + eo * DEXP * D, DEXP, D, dw + (size_t)e * 1024 * 512, 0, scr, r, lane);
        }
    }
}
__device__ __forceinline__ void phase_ln1(int wv, KP Pk, int layer, LAS char* lds) {
    asm volatile("" : "+s"(Pk));
    const CAS Params& P = *Pk;
    const int tid = ltid(wv), lane = tid & 63, wid = tid >> 6;
    REP(8, phase_expconv(wv, Pk, layer, lds));
    __syncthreads();
    LAS float* rwT = (LAS float*)lds;
    LAS float* scs = (LAS float*)(lds + 32 * 1024 * 4) + wid * 32;
    LAS int* lcnt = (LAS int*)(lds + 32 * 1024 * 4 + 1024);
    LAS int* lbase = lcnt + 32;
    LAS int* asg = lcnt + 64;
    if (tid < 32) lcnt[tid] = 0;
    for (int i = tid; i < D * NEXP; i += NT) { const int col = i >> 5, e = i & 31; rwT[e * 1024 + col] = P.router_w[i]; }
    __syncthreads();
    const bf16_t* yo = (const bf16_t*)(P.ws + WS_YO);
    bf16_t* act = (bf16_t*)(P.ws + WS_ACT);
    float* xc = (float*)(P.ws + WS_XC);
    int* cnt = (int*)(P.ws + WS_CNT) + layer * 32 * CNT_STRIDE;
    int* list = (int*)(P.ws + WS_LIST);
    float* wts = (float*)(P.ws + WS_WTS);
    const float* lg = P.ln_g + (size_t)(layer * 2 + 0) * D; const float* lb = P.ln_b + (size_t)(layer * 2 + 0) * D;
    const int r0 = (layer == DEPTH - 1) ? NCTX : 0;
    for (int r = r0 + blockIdx.x * 8 + wid; r < NROWS; r += gridDim.x * 8) {
        const int m = row_mod(r);
        float* xr = r < NCTX ? xc + (size_t)r * D : P.out + (size_t)(r - NCTX) * D;
        const float* g1 = modvec(P.ws, layer, m, 2); const float* sh2 = modvec(P.ws, layer, m, 3); const float* sc2 = modvec(P.ws, layer, m, 4);
        f32x4 v[4]; float s = 0.f;
#pragma unroll
        for (int i = 0; i < 4; ++i) {
            const int c = 4 * lane + 256 * i;
            const f32x4 xv = *(const f32x4*)(xr + c), gv = *(const f32x4*)(g1 + c);
            const u32x2 yv = *(const u32x2*)(yo + (size_t)r * D + c);
            v[i][0] = ALPHA * xv[0] + gv[0] * bflo(yv.x); v[i][1] = ALPHA * xv[1] + gv[1] * bfhi(yv.x);
            v[i][2] = ALPHA * xv[2] + gv[2] * bflo(yv.y); v[i][3] = ALPHA * xv[3] + gv[3] * bfhi(yv.y);
            s += (v[i][0] + v[i][1]) + (v[i][2] + v[i][3]);
        }
        const float mean = wave_sum(s) * (1.f / D);
        float s2 = 0.f;
#pragma unroll
        for (int i = 0; i < 4; ++i) { v[i] = v[i] - mean; s2 += (v[i][0] * v[i][0] + v[i][1] * v[i][1]) + (v[i][2] * v[i][2] + v[i][3] * v[i][3]); }
        const float rstd = rsqrtf(wave_sum(s2) * (1.f / D) + 1e-5f);
        float acc[32];
#pragma unroll
        for (int e = 0; e < 32; ++e) acc[e] = 0.f;
#pragma unroll
        for (int i = 0; i < 4; ++i) {
            const int c = 4 * lane + 256 * i;
            const f32x4 gg = *(const f32x4*)(lg + c), bb = *(const f32x4*)(lb + c), s2v = *(const f32x4*)(sc2 + c), h2v = *(const f32x4*)(sh2 + c);
            f32x4 xn, hv;
#pragma unroll
            for (int j = 0; j < 4; ++j) { xn[j] = v[i][j] * rstd * gg[j] + bb[j]; hv[j] = xn[j] * (1.f + s2v[j]) + h2v[j]; }
            *(f32x4*)(xr + c) = xn;
            u32x2 o; o.x = pk2(hv[0], hv[1]); o.y = pk2(hv[2], hv[3]); *(u32x2*)(act + (size_t)r * D + c) = o;
#pragma unroll
            for (int e = 0; e < 32; ++e) { const f32x4 w = *(const LAS f32x4*)(rwT + e * 1024 + c); acc[e] += (hv[0] * w[0] + hv[1] * w[1]) + (hv[2] * w[2] + hv[3] * w[3]); }
        }
#pragma unroll
        for (int st = 0; st < 5; ++st) {
            const int half = 16 >> st, msk = 32 >> st;
            const bool up = (lane & msk) != 0;
#pragma unroll
            for (int j = 0; j < 16; ++j) {
                if (j < half) {
                    const float keep = up ? acc[j + half] : acc[j], send = up ? acc[j] : acc[j + half];
                    acc[j] = keep + __shfl_xor(send, msk);
                }
            }
        }
        acc[0] += __shfl_xor(acc[0], 1);
        {
            const int e = (lane >> 1) & 31;
            const int eidx = ((e >> 4) & 1) * 16 + ((e >> 3) & 1) * 8 + ((e >> 2) & 1) * 4 + ((e >> 1) & 1) * 2 + (e & 1);
            if ((lane & 1) == 0) scs[eidx] = acc[0];
        }
        asm volatile("s_waitcnt lgkmcnt(0)" ::: "memory");
        float best = -1e30f; int bg = 0;
#pragma unroll
        for (int g = 0; g < 8; ++g) {
            float m1 = -1e30f, m2 = -1e30f;
#pragma unroll
            for (int k = 0; k < 4; ++k) { const float vsc = sigmoidf_(scs[g * 4 + k]) + P.router_bias[g * 4 + k]; if (vsc > m1) { m2 = m1; m1 = vsc; } else if (vsc > m2) m2 = vsc; }
            const float gs = m1 + m2;
            if (gs > best) { best = gs; bg = g; }
        }
        float sv[4], bv[4];
#pragma unroll
        for (int k = 0; k < 4; ++k) { sv[k] = sigmoidf_(scs[bg * 4 + k]); bv[k] = sv[k] + P.router_bias[bg * 4 + k]; }
        int i1 = 0; float b1 = bv[0];
#pragma unroll
        for (int k = 1; k < 4; ++k) if (bv[k] > b1) { b1 = bv[k]; i1 = k; }
        int i2 = -1; float b2 = -1e30f;
#pragma unroll
        for (int k = 0; k < 4; ++k) if (k != i1 && bv[k] > b2) { b2 = bv[k]; i2 = k; }
        float s1 = sv[0], s2s = sv[0];
#pragma unroll
        for (int k = 1; k < 4; ++k) { if (i1 == k) s1 = sv[k]; if (i2 == k) s2s = sv[k]; }
        if (lane == 0) {
            const int e0 = bg * 4 + i1, e1 = bg * 4 + i2;
            const float inv = 1.f / (s1 + s2s);
            const int li = ((r - r0 - blockIdx.x * 8 - wid) / (int)(gridDim.x * 8)) * 8 + wid;
            const int p0 = __hip_atomic_fetch_add(&lcnt[e0], 1, __ATOMIC_RELAXED, __HIP_MEMORY_SCOPE_WORKGROUP);
            const int p1 = __hip_atomic_fetch_add(&lcnt[e1], 1, __ATOMIC_RELAXED, __HIP_MEMORY_SCOPE_WORKGROUP);
            asg[2 * li] = (e0 << 16) | p0; asg[2 * li + 1] = (e1 << 16) | p1;
            wts[2 * r] = s1 * inv; wts[2 * r + 1] = s2s * inv;
        }
    }
    __syncthreads();
    if (tid < 32) lbase[tid] = atomicAdd(&cnt[tid * CNT_STRIDE], lcnt[tid]);
    __syncthreads();
    for (int idx = tid; idx < 2 * 136; idx += NT) {
        const int li = idx >> 1, k = idx & 1, it = li >> 3, w = li & 7;
        const int r = r0 + blockIdx.x * 8 + w + it * (int)(gridDim.x * 8);
        if (r < NROWS) { const int v = asg[idx], e = v >> 16, lp = v & 0xffff; list[(size_t)e * LISTCAP + lbase[e] + lp] = 2 * r + k; }
    }
}

__device__ __forceinline__ void phase_ln2(int wv, KP Pk, int layer) {
    asm volatile("" : "+s"(Pk));
    const CAS Params& P = *Pk;
    const int tid = ltid(wv), lane = tid & 63, wid = tid >> 6;
    const bf16_t* yp = (const bf16_t*)(P.ws + WS_YP);
    const float* wts = (const float*)(P.ws + WS_WTS);
    bf16_t* act = (bf16_t*)(P.ws + WS_ACT);
    float* xc = (float*)(P.ws + WS_XC);
    const float* lg = P.ln_g + (size_t)(layer * 2 + 1) * D; const float* lb = P.ln_b + (size_t)(layer * 2 + 1) * D;
    const bool last = (layer == DEPTH - 1);
    const int r0 = last ? NCTX : 0;
    for (int r = r0 + blockIdx.x * 8 + wid; r < NROWS; r += gridDim.x * 8) {
        const int m = row_mod(r);
        float* xr = r < NCTX ? xc + (size_t)r * D : P.out + (size_t)(r - NCTX) * D;
        const float* g2 = modvec(P.ws, layer, m, 5);
        const float w0 = wts[2 * r], w1 = wts[2 * r + 1];
        f32x4 v[4]; float s = 0.f;
#pragma unroll
        for (int i = 0; i < 4; ++i) {
            const int c = 4 * lane + 256 * i;
            const f32x4 xv = *(const f32x4*)(xr + c), gv = *(const f32x4*)(g2 + c);
            const u32x2 y0 = *(const u32x2*)(yp + (size_t)(2 * r) * D + c), y1 = *(const u32x2*)(yp + (size_t)(2 * r + 1) * D + c);
            v[i][0] = ALPHA * xv[0] + gv[0] * (w0 * bflo(y0.x) + w1 * bflo(y1.x)); v[i][1] = ALPHA * xv[1] + gv[1] * (w0 * bfhi(y0.x) + w1 * bfhi(y1.x));
            v[i][2] = ALPHA * xv[2] + gv[2] * (w0 * bflo(y0.y) + w1 * bflo(y1.y)); v[i][3] = ALPHA * xv[3] + gv[3] * (w0 * bfhi(y0.y) + w1 * bfhi(y1.y));
            s += (v[i][0] + v[i][1]) + (v[i][2] + v[i][3]);
        }
        const float mean = wave_sum(s) * (1.f / D);
        float s2 = 0.f;
#pragma unroll
        for (int i = 0; i < 4; ++i) { v[i] = v[i] - mean; s2 += (v[i][0] * v[i][0] + v[i][1] * v[i][1]) + (v[i][2] * v[i][2] + v[i][3] * v[i][3]); }
        const float rstd = rsqrtf(wave_sum(s2) * (1.f / D) + 1e-5f);
        const float* sh1 = last ? lg : modvec(P.ws, layer + 1, m, 0); const float* sc1 = last ? lg : modvec(P.ws, layer + 1, m, 1);
#pragma unroll
        for (int i = 0; i < 4; ++i) {
            const int c = 4 * lane + 256 * i;
            const f32x4 gg = *(const f32x4*)(lg + c), bb = *(const f32x4*)(lb + c);
            f32x4 xn;
#pragma unroll
            for (int j = 0; j < 4; ++j) xn[j] = v[i][j] * rstd * gg[j] + bb[j];
            *(f32x4*)(xr + c) = xn;
            if (!last) {
                const f32x4 s1v = *(const f32x4*)(sc1 + c), h1v = *(const f32x4*)(sh1 + c);
                u32x2 o; o.x = pk2(xn[0] * (1.f + s1v[0]) + h1v[0], xn[1] * (1.f + s1v[1]) + h1v[1]); o.y = pk2(xn[2] * (1.f + s1v[2]) + h1v[2], xn[3] * (1.f + s1v[3]) + h1v[3]);
                *(u32x2*)(act + (size_t)r * D + c) = o;
            }
        }
    }
}

constexpr int NPHASE = 2 + 11 * DEPTH;
__global__ void __launch_bounds__(NT, 2) fwd_kernel(Params P) {
    extern __shared__ __attribute__((aligned(16))) char lds_raw[];
    LAS char* lds = (LAS char*)lds_raw;
    volatile LAS unsigned* xbw = (volatile LAS unsigned*)(lds + LDS_BYTES - 16);
    KP Pk = (KP)__builtin_amdgcn_kernarg_segment_ptr();
    const int wv = __builtin_amdgcn_readfirstlane((int)(threadIdx.x >> 6));
    const bool multi = (P.ph_hi - P.ph_lo) > 1;
    XcdBarrier bar; bar.bar = (unsigned*)(P.ws + WS_BAR); bar.x = 0; bar.st = xbw;
    if (multi) {
        if (ltid(wv) == 0) { xbw[0] = 0u; xbw[1] = 0u; xbw[2] = 0u; xbw[3] = 0u; }
        __syncthreads();
        bar = xcd_barrier_post(wv, (unsigned*)(P.ws + WS_BAR), xbw);
    }
#define PHASE(id, body) do { if (P.ph_lo <= (id) && (id) < P.ph_hi) { body; if ((id) + 1 < P.ph_hi) xcd_barrier(wv, bar); } } while (0)
    PHASE(0, REP(16, phase_prologue0(wv, Pk, lds)));
    PHASE(1, REP(16, phase_prologue1(wv, Pk)));
    for (int l = 0; l < DEPTH; ++l) {
        const int pb = 2 + 11 * l, odd = l & 1;
        PHASE(pb + 0, REP(1, phase_inproj(wv, Pk, l, lds)));
        if (odd) {
            PHASE(pb + 1, REP(4, phase_prep1(wv, Pk, l)));
            PHASE(pb + 2, phase_prep2(wv, Pk, l, lds));
            PHASE(pb + 3, REP(32, { if (blockIdx.x < 128) REP(64, scan_hgrn_c(wv, Pk, l, blockIdx.x, lds)); else if (blockIdx.x < 256) REP(128, scan_rwkv(wv, Pk, l, blockIdx.x - 128, lds)); }));
            PHASE(pb + 5, REP(4, phase_out_odd(wv, Pk, l)));
        } else {
            PHASE(pb + 1, REP(4, phase_prep_even(wv, Pk, l)));
            PHASE(pb + 2, REP(2, phase_ex1(wv, Pk, l, lds)));
            PHASE(pb + 3, phase_ex2(wv, Pk, l));
            PHASE(pb + 4, REP(2, phase_ex3(wv, Pk, l, lds)));
            PHASE(pb + 5, REP(4, phase_out_even(wv, Pk, l)));
        }
        PHASE(pb + 6, REP(256, phase_outproj(wv, Pk, l, lds)));
        PHASE(pb + 7, phase_ln1(wv, Pk, l, lds));
        PHASE(pb + 8, REP(512, phase_moe1(wv, Pk, l, lds)));
        PHASE(pb + 9, REP(1024, phase_moe2(wv, Pk, l, lds)));
        PHASE(pb + 10, phase_ln2(wv, Pk, l));
    }
#undef PHASE
}


#ifndef MK_STOP
#define MK_STOP NPHASE
#endif
#ifndef MK_DUMP
#define MK_DUMP 0
#endif
#ifndef MK_DUMP_N
#define MK_DUMP_N (1u << 30)
#endif
#ifndef MK_DUMP_LD
#define MK_DUMP_LD 1024
#endif
#ifndef MK_DUMP_C0
#define MK_DUMP_C0 0
#endif
__global__ void diff_kernel(const bf16_t* a, const bf16_t* b, float* out, size_t n) {
    for (size_t i = (size_t)blockIdx.x * blockDim.x + threadIdx.x; i < n; i += (size_t)gridDim.x * blockDim.x) out[i] = 1e6f * (bf2f(a[i]) - bf2f(b[i]));
}
__global__ void dump_kernel(const bf16_t* src, float* out, size_t n) {
    for (size_t i = (size_t)blockIdx.x * blockDim.x + threadIdx.x; i < n; i += (size_t)gridDim.x * blockDim.x) out[i] = i < (size_t)MK_DUMP_N ? bf2f(src[(i >> 10) * MK_DUMP_LD + MK_DUMP_C0 + (i & 1023)]) : 0.f;
}
extern "C" void kernel_launch(void* const* d_in, const int* in_sizes, int n_in, void* d_out, int out_size, void* d_ws, size_t ws_size, hipStream_t stream) {
    static int ready = 0;
    if (ready == 0) {
        ready = 1;
        if (n_in != 42 || out_size != NB * SEQ * D || ws_size < WS_END) { fprintf(stderr, "kernel_launch: unexpected shapes (n_in %d out %d ws %zu need %zu)\n", n_in, out_size, ws_size, (size_t)WS_END); ready = -1; }
        if (hipFuncSetAttribute((const void*)fwd_kernel, hipFuncAttributeMaxDynamicSharedMemorySize, LDS_BYTES) != hipSuccess) { fprintf(stderr, "kernel_launch: hipFuncSetAttribute failed\n"); ready = -1; }
    }
    if (ready < 0) return;
    (void)in_sizes;
    hipMemsetAsync((char*)d_ws + WS_BAR, 0, WS_ZERO_BYTES, stream);
    Params p;
    memset(&p, 0, sizeof(p));
    const float** fp = (const float**)&p;
    for (int i = 0; i < 42; ++i) fp[i] = (const float*)d_in[i];
    p.out = (float*)d_out; p.ws = (unsigned char*)d_ws;
#if MK_PER_PHASE
    for (int ph = 0; ph < MK_STOP; ++ph) {
        const int local = ph < 2 ? -1 : (ph - 2) % 11, layer = ph < 2 ? 0 : (ph - 2) / 11;
        if (local == 4 && (layer & 1)) continue;
        p.ph_lo = ph; p.ph_hi = ph + 1;
        hipLaunchKernelGGL(fwd_kernel, dim3(256), dim3(NT), LDS_BYTES, stream, p);
    }
#ifdef MK_DIFF
    p.ph_lo = 7; p.ph_hi = 8; p.dbg = 1;
    hipLaunchKernelGGL(fwd_kernel, dim3(256), dim3(NT), LDS_BYTES, stream, p);
    hipLaunchKernelGGL(diff_kernel, dim3(1024), dim3(256), 0, stream, (const bf16_t*)((unsigned char*)d_ws + WS_YO), (const bf16_t*)((unsigned char*)d_ws + WS_HID), (float*)d_out, (size_t)NB * SEQ * D);
#else
    if (MK_DUMP) hipLaunchKernelGGL(dump_kernel, dim3(1024), dim3(256), 0, stream, (const bf16_t*)((unsigned char*)d_ws + (size_t)MK_DUMP), (float*)d_out, (size_t)NB * SEQ * D);
#endif
#else
    p.ph_lo = 0; p.ph_hi = NPHASE;
    hipLaunchKernelGGL(fwd_kernel, dim3(256), dim3(NT), LDS_BYTES, stream, p);
#endif
}
```

```cpp
#include <hip/hip_runtime.h>
#include <stdint.h>
#include <stdio.h>
#include <string.h>

#ifndef MK_PER_PHASE
#define MK_PER_PHASE 0
#endif

typedef unsigned short bf16_t;
typedef short bf16x8 __attribute__((ext_vector_type(8)));
typedef float f32x4 __attribute__((ext_vector_type(4)));
typedef unsigned u32x4 __attribute__((ext_vector_type(4)));
typedef unsigned u32x2 __attribute__((ext_vector_type(2)));
#define LAS __attribute__((address_space(3)))
#define CAS __attribute__((address_space(4)))

constexpr int D = 1024, NB = 4, SEQ = 8192, CTXL = 256, DEPTH = 4;
constexpr int NCTX = NB * CTXL;
constexpr int NROWS = NCTX + NB * SEQ;
constexpr int P_EVEN = 2848, P_ODD = 4416, LDP_EVEN = 3072, LDP_ODD = 4608;
constexpr int NEXP = 32, DEXP = 512, LISTCAP = NROWS;
constexpr float ALPHA = 1.681792830507429f;
constexpr int NT = 512;
constexpr int TCH = 32;
constexpr int NSTEPS = CTXL + SEQ;
constexpr int LDS_BYTES = 160 * 1024;

constexpr size_t al256(size_t x) { return (x + 255) & ~(size_t)255; }
constexpr size_t WS_BAR = 0;
constexpr size_t WS_CNT = 16384;
constexpr int CNT_STRIDE = 64;
constexpr size_t WS_ZERO_BYTES = 16384 + (size_t)4 * 32 * CNT_STRIDE * 4;
constexpr size_t WS_MODV = al256(WS_ZERO_BYTES);
constexpr size_t WS_LB = WS_MODV + al256((size_t)4 * 5 * 6144 * 4);
constexpr size_t WS_XC = WS_LB + al256(4 * 512 * 4);
constexpr size_t WS_WTS = WS_XC + (size_t)NCTX * D * 4;
constexpr size_t WS_LIST = WS_WTS + al256((size_t)2 * NROWS * 4);
constexpr size_t WS_WINT = WS_LIST + al256((size_t)NEXP * LISTCAP * 4);
constexpr size_t WINT_L0 = 0, WINT_L1 = (size_t)LDP_EVEN * D, WINT_L2 = WINT_L1 + (size_t)LDP_ODD * D, WINT_L3 = WINT_L2 + (size_t)LDP_EVEN * D, WINT_END = WINT_L3 + (size_t)LDP_ODD * D;
constexpr size_t WS_WOUTT = WS_WINT + WINT_END * 2;
constexpr size_t WS_LORAT = WS_WOUTT + (size_t)4 * D * D * 2;
constexpr size_t LORA_PER = (size_t)512 * 320;
constexpr size_t WS_EXPGU = WS_LORAT + al256(2 * LORA_PER * 2);
constexpr size_t WS_EXPD = WS_EXPGU + (size_t)NEXP * 1024 * 1024 * 2;
constexpr size_t WS_ACT = WS_EXPD + (size_t)NEXP * 1024 * 512 * 2;
constexpr size_t ROWB = (size_t)NROWS * D * 2;
constexpr size_t WS_FEAT = WS_ACT + ROWB;
constexpr size_t WS_YF = WS_FEAT + ROWB;
constexpr size_t WS_YB = WS_YF + ROWB;
constexpr size_t WS_P = WS_YB + ROWB;
constexpr size_t P_BYTES = (size_t)NROWS * LDP_ODD * 2;
constexpr size_t WS_YO = WS_P;
constexpr size_t WS_HID = WS_P + ROWB;
constexpr size_t WS_YP = WS_HID + ROWB;
static_assert(WS_YP + 2 * ROWB <= WS_P + P_BYTES, "MoE buffers must fit in the P region");
constexpr size_t HALFB = (size_t)NROWS * 512 * 2;
constexpr size_t WS_RWR = WS_P + P_BYTES;
constexpr size_t WS_RWK = WS_RWR + HALFB;
constexpr size_t WS_RWV = WS_RWK + HALFB;
constexpr size_t WS_RWKK = WS_RWV + HALFB;
constexpr size_t WS_RWB = WS_RWKK + HALFB;
constexpr size_t WS_RWG = WS_RWB + HALFB;
constexpr size_t WS_RWDEC = WS_RWG + HALFB;
constexpr size_t WS_LA = WS_RWDEC + (size_t)2 * NROWS * 512 * 4;
constexpr size_t WS_END = WS_LA + (size_t)NROWS * 320 * 2;
static_assert(WS_END <= (size_t)280602384 * 4, "workspace map exceeds the guaranteed ws_size");

struct Params {
    const float *x, *c, *ctx, *c_ctx, *mod_w, *mod_b, *ln_g, *ln_b;
    const float *ev_w_in, *ev_w_out, *ssd_conv_w, *ssd_conv_b, *ssd_dt_bias, *ssd_a_log, *ssd_d, *ssd_norm_w;
    const float *ml_conv_w, *ml_conv_b, *ml_i_bias, *ml_f_bias, *ml_norm_w;
    const float *od_w_in, *od_w_out, *hg_lb_logits, *hg_f_bias, *hg_norm_w;
    const float *rw_mu, *rw_w0, *rw_w2, *rw_a0, *rw_a2, *rw_g2, *rw_k_k, *rw_k_a, *rw_r_k, *rw_ln_w, *rw_ln_b;
    const float *router_w, *router_bias, *exp_w_gate, *exp_w_up, *exp_w_down;
    float* out;
    unsigned char* ws;
    int ph_lo, ph_hi, dbg, pad_;
};
typedef const CAS Params* KP;

__device__ __forceinline__ int ltid(int wv) { int l; asm volatile("v_mbcnt_lo_u32_b32 %0, -1, 0\n\tv_mbcnt_hi_u32_b32 %0, -1, %0" : "=v"(l)); return wv * 64 + l; }
__device__ __forceinline__ float bf2f(bf16_t h) { return __uint_as_float(((unsigned)h) << 16); }
__device__ __forceinline__ float bflo(unsigned u) { return __uint_as_float(u << 16); }
__device__ __forceinline__ float bfhi(unsigned u) { return __uint_as_float(u & 0xffff0000u); }
typedef __bf16 bf16v2_t __attribute__((ext_vector_type(2)));
typedef float f32x2 __attribute__((ext_vector_type(2)));
__device__ __forceinline__ unsigned pk2(float lo, float hi) { const f32x2 v = {lo, hi}; return __builtin_bit_cast(unsigned, __builtin_convertvector(v, bf16v2_t)); }
__device__ __forceinline__ bf16_t f2bf(float f) { return (bf16_t)(pk2(f, 0.f) & 0xffffu); }
__device__ __forceinline__ void unpack8(const u32x4& u, float* f) {
    f[0] = bflo(u.x); f[1] = bfhi(u.x); f[2] = bflo(u.y); f[3] = bfhi(u.y); f[4] = bflo(u.z); f[5] = bfhi(u.z); f[6] = bflo(u.w); f[7] = bfhi(u.w);
}
__device__ __forceinline__ u32x4 pack8(const float* f) { u32x4 u; u.x = pk2(f[0], f[1]); u.y = pk2(f[2], f[3]); u.z = pk2(f[4], f[5]); u.w = pk2(f[6], f[7]); return u; }
__device__ __forceinline__ float sigmoidf_(float x) { return __builtin_amdgcn_rcpf(1.f + __expf(-x)); }
__device__ __forceinline__ float siluf_(float x) { return x * __builtin_amdgcn_rcpf(1.f + __expf(-x)); }
__device__ __forceinline__ float softplus_fast(float x) { return x > 20.f ? x : __logf(1.f + __expf(x)); }
__device__ __forceinline__ float tanh_fast(float x) { return 1.f - 2.f * __builtin_amdgcn_rcpf(1.f + __expf(2.f * x)); }
__device__ __forceinline__ float softplusf_(float x) { return x > 20.f ? x : __logf(1.f + __expf(x)); }
__device__ __forceinline__ float logsigmoidf_(float x) { return fminf(x, 0.f) - __logf(1.f + __expf(-fabsf(x))); }
template <int CTRL> __device__ __forceinline__ float dppmov(float v) {
    return __builtin_bit_cast(float, __builtin_amdgcn_update_dpp(0, __builtin_bit_cast(int, v), CTRL, 0xf, 0xf, true));
}
__device__ __forceinline__ float allreduce16(float v) {
    v += dppmov<0xB1>(v);
    v += dppmov<0x4E>(v);
    v += dppmov<0x141>(v);
    v += dppmov<0x140>(v);
    return v;
}
__device__ __forceinline__ float allreduce8_(float v) { v += dppmov<0xB1>(v); v += dppmov<0x4E>(v); v += dppmov<0x141>(v); return v; }
__device__ __forceinline__ float wave_sum(float v) {
    v = allreduce16(v);
    const float r0 = __builtin_bit_cast(float, __builtin_amdgcn_readlane(__builtin_bit_cast(int, v), 0)), r1 = __builtin_bit_cast(float, __builtin_amdgcn_readlane(__builtin_bit_cast(int, v), 16));
    const float r2 = __builtin_bit_cast(float, __builtin_amdgcn_readlane(__builtin_bit_cast(int, v), 32)), r3 = __builtin_bit_cast(float, __builtin_amdgcn_readlane(__builtin_bit_cast(int, v), 48));
    return (r0 + r1) + (r2 + r3);
}
template <int W> __device__ __forceinline__ float group_sum(float v) {
    if (W == 8) return allreduce8_(v);
    return allreduce16(v);
}

#define XB_TMO      128
#define XB_XCNT(j)  (256  + 64 * (j))
#define XB_XSUB(j)  (1280 + 64 * (j))
#define XB_XGEN(j)  (2304 + 64 * (j))
#define XB_TOP      3328
#define XB_TOPGEN   3392
#define XCD_BAR_WORDS 3456
#define XB_SPIN_CAP (1u << 22)
__device__ __forceinline__ unsigned xb_ld(unsigned* p)              { return __hip_atomic_load(p, __ATOMIC_RELAXED, __HIP_MEMORY_SCOPE_AGENT); }
__device__ __forceinline__ unsigned xb_add(unsigned* p, unsigned v) { return __hip_atomic_fetch_add(p, v, __ATOMIC_RELAXED, __HIP_MEMORY_SCOPE_AGENT); }
__device__ __forceinline__ unsigned xb_xcc_id() { return (unsigned)__builtin_amdgcn_s_getreg((3 << 11) | 20) & 0xFu; }
#define XB_SPIN(cond, bar) do { unsigned _sp = 0; while (cond) { __builtin_amdgcn_s_sleep(1); \
    if ((++_sp & 255u) == 0u) { if (xb_ld(&(bar)[XB_TMO])) break; if (_sp > XB_SPIN_CAP) { atomicAdd(&(bar)[XB_TMO], 1u); break; } } } } while (0)
struct XcdBarrier { unsigned* bar; unsigned x; volatile LAS unsigned* st; };
__device__ __forceinline__ XcdBarrier xcd_barrier_post(int wv, unsigned* bar, volatile LAS unsigned* st) {
    XcdBarrier b; b.bar = bar; b.x = xb_xcc_id(); b.st = st;
    if (ltid(wv) == 0) (void)xb_add(&bar[XB_XCNT(b.x)], 1u);
    return b;
}
__device__ __forceinline__ void xcd_barrier_complete(unsigned* bar, unsigned x, unsigned& nloc, unsigned& nx) {
    const unsigned G = gridDim.x * gridDim.y * gridDim.z;
    unsigned sum, cnt, mine, sp = 0u;
    for (;;) {
        sum = 0u; cnt = 0u; mine = 0u;
#pragma unroll
        for (unsigned j = 0; j < 16; ++j) { const unsigned c = xb_ld(&bar[XB_XCNT(j)]); sum += c; cnt += (c > 0u) ? 1u : 0u; mine = (j == x) ? c : mine; }
        if (sum == G) break;
        __builtin_amdgcn_s_sleep(1);
        if ((++sp & 255u) == 0u) { if (xb_ld(&bar[XB_TMO])) break; if (sp > XB_SPIN_CAP) { atomicAdd(&bar[XB_TMO], 1u); break; } }
    }
    nloc = mine > 0u ? mine : 1u; nx = cnt > 0u ? cnt : 1u;
}
__device__ __forceinline__ void xcd_barrier(int wv, const XcdBarrier& b) {
    asm volatile("s_waitcnt vmcnt(0)" ::: "memory");
    __syncthreads();
    if (ltid(wv) == 0) {
        unsigned* bar = b.bar;
        asm volatile("" : "+s"(bar));
        __builtin_amdgcn_s_waitcnt(0);
        unsigned nloc = b.st[0], nx = b.st[1];
        if (nloc == 0u) { xcd_barrier_complete(bar, b.x, nloc, nx); b.st[0] = nloc; b.st[1] = nx; }
        const unsigned old = xb_add(&bar[XB_XSUB(b.x)], 1u);
        const unsigned gen = old / nloc;
        if (old + 1u == (gen + 1u) * nloc) {
            __builtin_amdgcn_fence(__ATOMIC_RELEASE, "agent");
            asm volatile("s_waitcnt vmcnt(0)" ::: "memory");
            const unsigned og = xb_add(&bar[XB_TOP], 1u);
            const unsigned tg = og / nx;
            if (og + 1u == (tg + 1u) * nx) xb_add(&bar[XB_TOPGEN], 1u);
            else XB_SPIN(xb_ld(&bar[XB_TOPGEN]) == tg, bar);
            __builtin_amdgcn_fence(__ATOMIC_ACQUIRE, "agent");
            xb_add(&bar[XB_XGEN(b.x)], 1u);
            asm volatile("s_waitcnt vmcnt(0)" ::: "memory");
        } else {
            XB_SPIN(xb_ld(&bar[XB_XGEN(b.x)]) == gen, bar);
            __builtin_amdgcn_fence(__ATOMIC_ACQUIRE, "agent");
            asm volatile("s_waitcnt vmcnt(0)" ::: "memory");
        }
    }
    __syncthreads();
}

__device__ __forceinline__ int row_mod(int r) { return r < NCTX ? 4 : ((r - NCTX) >> 13); }
__device__ __forceinline__ void row_seg(int r, int& t, int& len) { if (r < NCTX) { t = r & 255; len = CTXL; } else { t = (r - NCTX) & 8191; len = SEQ; } }
__device__ __forceinline__ int scan_row(int tg, int b, int dir, int odd) {
    if (tg < CTXL) { const int t = dir ? (CTXL - 1 - tg) : tg; return b * CTXL + t; }
    int sg = tg - CTXL; if (dir) sg = SEQ - 1 - sg;
    const int s = odd ? (((sg & 127) << 6) + (sg >> 7)) : sg;
    return NCTX + b * SEQ + s;
}
__device__ __forceinline__ const float* modvec(const unsigned char* ws, int layer, int m, int which) {
    return (const float*)(ws + WS_MODV) + ((size_t)(layer * 5 + m) * 6 + which) * D;
}

constexpr int G_BM = 256, G_BN = 128, G_BK = 64;
constexpr int G_ABYTES = G_BM * G_BK * 2, G_BBYTES = G_BN * G_BK * 2, G_BUF = G_ABYTES + G_BBYTES;
__device__ __forceinline__ int swz(int o) { return o ^ (((o >> 9) & 1) << 5); }

template <class RowSrc, class Epi>
__device__ __forceinline__ void gemm_tile(int wv, const bf16_t* __restrict__ A, int lda, const RowSrc& rs, const bf16_t* __restrict__ Bt, int ldb, int n0, int K, const Epi& epi, LAS char* lds) {
    const int tid = ltid(wv), lane = tid & 63, wid = tid >> 6, wm = wid >> 1, wn = wid & 1;
    const bf16_t* ap[4]; int aoff[4];
#pragma unroll
    for (int i = 0; i < 4; ++i) {
        const int c = tid + NT * i, row = c >> 3, kc = c & 7;
        ap[i] = A + (size_t)rs.src(row) * lda + kc * 8;
        aoff[i] = ((row >> 4) * 2 + (kc >> 2)) * 1024 + swz((row & 15) * 64 + (kc & 3) * 16);
    }
    const bf16_t* bp[2]; int boff[2];
#pragma unroll
    for (int i = 0; i < 2; ++i) {
        const int c = tid + NT * i, row = c >> 3, kc = c & 7;
        bp[i] = Bt + (size_t)(n0 + row) * ldb + kc * 8;
        boff[i] = G_ABYTES + ((row >> 4) * 2 + (kc >> 2)) * 1024 + swz((row & 15) * 64 + (kc & 3) * 16);
    }
    f32x4 acc[4][4];
#pragma unroll
    for (int i = 0; i < 4; ++i)
#pragma unroll
        for (int j = 0; j < 4; ++j) acc[i][j] = (f32x4){0.f, 0.f, 0.f, 0.f};
    u32x4 ra[2][4], rb[2][2];
    const int KT = K / G_BK;
    const int fragoff = swz((lane & 15) * 64 + (lane >> 4) * 16);
#define G_LOAD(set, kt_) do { _Pragma("unroll") for (int i = 0; i < 4; ++i) ra[set][i] = *(const u32x4*)(ap[i] + (kt_) * G_BK); \
                              _Pragma("unroll") for (int i = 0; i < 2; ++i) rb[set][i] = *(const u32x4*)(bp[i] + (kt_) * G_BK); } while (0)
#define G_STORE(set, buf) do { _Pragma("unroll") for (int i = 0; i < 4; ++i) *(LAS u32x4*)((buf) + aoff[i]) = ra[set][i]; \
                               _Pragma("unroll") for (int i = 0; i < 2; ++i) *(LAS u32x4*)((buf) + boff[i]) = rb[set][i]; } while (0)
#define G_COMPUTE(cur) do { bf16x8 af[2][4], bfr[2][4]; \
        _Pragma("unroll") for (int ks = 0; ks < 2; ++ks) { \
            _Pragma("unroll") for (int ni = 0; ni < 4; ++ni) bfr[ks][ni] = *(LAS bf16x8*)((cur) + G_ABYTES + ((wn * 4 + ni) * 2 + ks) * 1024 + fragoff); \
            _Pragma("unroll") for (int mi = 0; mi < 4; ++mi) af[ks][mi] = *(LAS bf16x8*)((cur) + ((wm * 4 + mi) * 2 + ks) * 1024 + fragoff); } \
        __builtin_amdgcn_sched_barrier(0); \
        _Pragma("unroll") for (int ks = 0; ks < 2; ++ks) _Pragma("unroll") for (int mi = 0; mi < 4; ++mi) _Pragma("unroll") for (int ni = 0; ni < 4; ++ni) \
            acc[mi][ni] = __builtin_amdgcn_mfma_f32_16x16x32_bf16(bfr[ks][ni], af[ks][mi], acc[mi][ni], 0, 0, 0); \
        __builtin_amdgcn_sched_barrier(0); } while (0)
    G_LOAD(0, 0);
    G_STORE(0, lds);
    if (KT > 1) G_LOAD(0, 1);
    if (KT > 2) G_LOAD(1, 2);
    __syncthreads();
    for (int kt = 0; kt < KT; kt += 2) {
        G_COMPUTE(lds);
        if (kt + 1 < KT) G_STORE(0, lds + G_BUF);
        if (kt + 3 < KT) G_LOAD(0, kt + 3);
        __syncthreads();
        if (kt + 1 < KT) {
            G_COMPUTE(lds + G_BUF);
            if (kt + 2 < KT) G_STORE(1, lds);
            if (kt + 4 < KT) G_LOAD(1, kt + 4);
            __syncthreads();
        }
    }
#undef G_LOAD
#undef G_STORE
#undef G_COMPUTE
    epi(acc, wm * 64 + (lane & 15), wn * 64 + 4 * (lane >> 4));
}

constexpr int G2_BN = 256, G2_BBYTES = G2_BN * G_BK * 2, G2_BUF = G_ABYTES + G2_BBYTES;
template <class RowSrc, class Epi>
__device__ __forceinline__ void gemm_tile256(int wv, const bf16_t* __restrict__ A, int lda, const RowSrc& rs, const bf16_t* __restrict__ Bt, int ldb, int n0, int K, const Epi& epi, LAS char* lds) {
    const int tid = ltid(wv), lane = tid & 63, wid = tid >> 6, wm = wid >> 1, wn = wid & 1;
    const int r0 = tid >> 3, kc = tid & 7;
    const int aoff0 = ((r0 >> 4) * 2 + (kc >> 2)) * 1024 + swz((r0 & 15) * 64 + (kc & 3) * 16);
    int aeo[4];
#pragma unroll
    for (int i = 0; i < 4; ++i) aeo[i] = rs.src(r0 + 64 * i) * lda + kc * 8;
    const bf16_t* bp0 = Bt + (size_t)(n0 + r0) * ldb + kc * 8;
    const int bstep = 64 * ldb;
    f32x4 acc[4][8];
#pragma unroll
    for (int i = 0; i < 4; ++i)
#pragma unroll
        for (int j = 0; j < 8; ++j) acc[i][j] = (f32x4){0.f, 0.f, 0.f, 0.f};
    u32x4 ra[4], rb[4];
#pragma unroll
    for (int i = 0; i < 4; ++i) { ra[i] = *(const u32x4*)(A + aeo[i]); rb[i] = *(const u32x4*)(bp0 + i * bstep); }
#pragma unroll
    for (int i = 0; i < 4; ++i) { *(LAS u32x4*)(lds + aoff0 + i * 8192) = ra[i]; *(LAS u32x4*)(lds + G_ABYTES + aoff0 + i * 8192) = rb[i]; }
    __syncthreads();
    const int KT = K / G_BK;
    const int fragoff = swz((lane & 15) * 64 + (lane >> 4) * 16);
    for (int kt = 0; kt < KT; ++kt) {
        LAS char* cur = lds + (kt & 1) * G2_BUF;
        LAS char* nxt = lds + ((kt + 1) & 1) * G2_BUF;
        const bool more = (kt + 1 < KT);
        if (more) {
#pragma unroll
            for (int i = 0; i < 4; ++i) { ra[i] = *(const u32x4*)(A + aeo[i] + (kt + 1) * G_BK); rb[i] = *(const u32x4*)(bp0 + i * bstep + (kt + 1) * G_BK); }
        }
#pragma unroll
        for (int ks = 0; ks < 2; ++ks) {
            bf16x8 af[4];
#pragma unroll
            for (int mi = 0; mi < 4; ++mi) af[mi] = *(LAS bf16x8*)(cur + ((wm * 4 + mi) * 2 + ks) * 1024 + fragoff);
#pragma unroll
            for (int nh = 0; nh < 2; ++nh) {
                bf16x8 bfr[4];
#pragma unroll
                for (int ni = 0; ni < 4; ++ni) bfr[ni] = *(LAS bf16x8*)(cur + G_ABYTES + ((wn * 8 + nh * 4 + ni) * 2 + ks) * 1024 + fragoff);
                __builtin_amdgcn_sched_barrier(0);
#pragma unroll
                for (int mi = 0; mi < 4; ++mi)
#pragma unroll
                    for (int ni = 0; ni < 4; ++ni) acc[mi][nh * 4 + ni] = __builtin_amdgcn_mfma_f32_16x16x32_bf16(bfr[ni], af[mi], acc[mi][nh * 4 + ni], 0, 0, 0);
                __builtin_amdgcn_sched_barrier(0);
            }
        }
        if (more) {
#pragma unroll
            for (int i = 0; i < 4; ++i) { *(LAS u32x4*)(nxt + aoff0 + i * 8192) = ra[i]; *(LAS u32x4*)(nxt + G_ABYTES + aoff0 + i * 8192) = rb[i]; }
        }
        __syncthreads();
    }
    epi(acc, wm * 64 + (lane & 15), wn * 128 + 4 * (lane >> 4));
}

struct RowLinear { int m0; __device__ __forceinline__ int src(int r) const { return m0 + r; } };
struct RowList {
    const int* list; int cnt; int shift;
    __device__ __forceinline__ int src(int r) const { const int a = list[r < cnt ? r : 0]; return a >> shift; }
};
struct EpiStoreBf16 {
    bf16_t* C; int ldc; int m0; int n0; int N;
    template <int NI> __device__ __forceinline__ void operator()(const f32x4 (&acc)[4][NI], int rbase, int cbase) const {
#pragma unroll
        for (int mi = 0; mi < 4; ++mi) {
            bf16_t* rowp = C + (size_t)(m0 + rbase + mi * 16) * ldc + n0 + cbase;
#pragma unroll
            for (int ni = 0; ni < NI; ++ni) {
                if (n0 + cbase + ni * 16 < N) { u32x2 v; v.x = pk2(acc[mi][ni][0], acc[mi][ni][1]); v.y = pk2(acc[mi][ni][2], acc[mi][ni][3]); *(u32x2*)(rowp + ni * 16) = v; }
            }
        }
    }
};
struct EpiSwiGLU {
    bf16_t* H; const int* list; int cnt; int n0;
    template <int NI> __device__ __forceinline__ void operator()(const f32x4 (&acc)[4][NI], int rbase, int cbase) const {
#pragma unroll
        for (int mi = 0; mi < 4; ++mi) {
            const int r = rbase + mi * 16;
            if (r < cnt) {
                const int a = list[r];
                const int wnb = cbase & ~63, q4 = cbase & 63;
                bf16_t* rowp = H + (size_t)a * DEXP + ((n0 + wnb) >> 1) + q4;
#pragma unroll
                for (int q = 0; q < NI / 2; ++q) {
                    float o[4];
#pragma unroll
                    for (int j = 0; j < 4; ++j) o[j] = siluf_(acc[mi][2 * q][j]) * acc[mi][2 * q + 1][j];
                    u32x2 v; v.x = pk2(o[0], o[1]); v.y = pk2(o[2], o[3]); *(u32x2*)(rowp + q * 16) = v;
                }
            }
        }
    }
};
struct EpiScatterBf16 {
    bf16_t* C; const int* list; int cnt; int n0;
    template <int NI> __device__ __forceinline__ void operator()(const f32x4 (&acc)[4][NI], int rbase, int cbase) const {
#pragma unroll
        for (int mi = 0; mi < 4; ++mi) {
            const int r = rbase + mi * 16;
            if (r < cnt) {
                bf16_t* rowp = C + (size_t)list[r] * D + n0 + cbase;
#pragma unroll
                for (int ni = 0; ni < NI; ++ni) { u32x2 v; v.x = pk2(acc[mi][ni][0], acc[mi][ni][1]); v.y = pk2(acc[mi][ni][2], acc[mi][ni][3]); *(u32x2*)(rowp + ni * 16) = v; }
            }
        }
    }
};
struct EpiDecay {
    float* Dc; const float* w0; int m0; int n0;
    template <int NI> __device__ __forceinline__ void operator()(const f32x4 (&acc)[4][NI], int rbase, int cbase) const {
#pragma unroll
        for (int ni = 0; ni < NI; ++ni) {
            const int col = n0 + cbase + ni * 16;
            const f32x4 w0v = *(const f32x4*)(w0 + col);
#pragma unroll
            for (int mi = 0; mi < 4; ++mi) {
                f32x4 o;
#pragma unroll
                for (int j = 0; j < 4; ++j) { const float w = w0v[j] + acc[mi][ni][j]; o[j] = __expf(-__expf(-softplus_fast(-w) - 0.5f)); }
                *(f32x4*)(Dc + (size_t)(m0 + rbase + mi * 16) * 512 + col) = o;
            }
        }
    }
};
struct EpiAK {
    bf16_t* Kb; const bf16_t* KKb; bf16_t* Bb; const float* a0; const float* k_a; int m0; int n0;
    template <int NI> __device__ __forceinline__ void operator()(const f32x4 (&acc)[4][NI], int rbase, int cbase) const {
#pragma unroll
        for (int ni = 0; ni < NI; ++ni) {
            const int col = n0 + cbase + ni * 16;
            const f32x4 a0v = *(const f32x4*)(a0 + col), kav = *(const f32x4*)(k_a + col);
#pragma unroll
            for (int mi = 0; mi < 4; ++mi) {
                const size_t off = (size_t)(m0 + rbase + mi * 16) * 512 + col;
                const u32x2 kr = *(const u32x2*)(Kb + off), kkr = *(const u32x2*)(KKb + off);
                const float kf[4] = {bflo(kr.x), bfhi(kr.x), bflo(kr.y), bfhi(kr.y)}, kkf[4] = {bflo(kkr.x), bfhi(kkr.x), bflo(kkr.y), bfhi(kkr.y)};
                float k2[4], bb[4];
#pragma unroll
                for (int j = 0; j < 4; ++j) { const float a = sigmoidf_(a0v[j] + acc[mi][ni][j]); k2[j] = kf[j] * (1.f + (a - 1.f) * kav[j]); bb[j] = kkf[j] * a; }
                u32x2 v; v.x = pk2(k2[0], k2[1]); v.y = pk2(k2[2], k2[3]); *(u32x2*)(Kb + off) = v;
                v.x = pk2(bb[0], bb[1]); v.y = pk2(bb[2], bb[3]); *(u32x2*)(Bb + off) = v;
            }
        }
    }
};

namespace pg8 {
#define PG8_LAS __attribute__((address_space(3)))
constexpr int BM = 256, BK = 64, HALF = 128, HTB = HALF * BK * 2, STAGE_BYTES = 8 * HTB, NXCD = 8, WGM = 8;
__host__ __device__ __forceinline__ int lds_byte(int r, int c) { const int st = (r >> 4) * 2 + (c >> 5), rr = r & 15, cc = c & 31, ob = rr * 64 + cc * 2; return st * 1024 + (ob ^ (((ob >> 9) & 1) << 5)); }
__host__ __device__ __forceinline__ void stage_rc(int b, int& R, int& C) { const int st = b / 1024, sb = b % 1024, swz = sb ^ (((sb >> 9) & 1) << 5); R = (st >> 1) * 16 + swz / 64; C = (st & 1) * 32 + (swz % 64) / 2; }
__host__ __device__ __forceinline__ int perm32(int rho) { const int n = rho >> 4, i = rho & 15; return 8 * (i >> 2) + 4 * n + (i & 3); }
struct Unit { int pm, pn; };
struct Gemm { const bf16_t* A; const bf16_t* Bt; int M, N, K; };
struct StaticOrder {
    int nM, nN, nwg, G, c;
    __host__ __device__ void init(int M, int N, int G_, int c_) { nM = M / BM; nN = N / BM; nwg = nM * nN; G = G_; c = c_; }
    __host__ __device__ bool next(int i, Unit& u) const {
        const long L = (long)i * G + c; if (L >= nwg) return false;
        int wgid = (int)L; { const int q = nwg / NXCD, r = nwg % NXCD, xcd = wgid % NXCD, off = wgid / NXCD; wgid = (xcd < r ? xcd * (q + 1) : r * (q + 1) + (xcd - r) * q) + off; }
        const int nig = WGM * nN, gid = wgid / nig, fm = gid * WGM, gsz = (nM - fm) < WGM ? (nM - fm) : WGM;
        u.pm = fm + ((wgid % nig) % gsz); u.pn = (wgid % nig) / gsz; return true;
    }
    __device__ __forceinline__ void a_ready(const Unit&) const {}
    __device__ __forceinline__ void done(const Unit&) const {}
};
struct EpiStoreP {
    static constexpr bool PERM = true, AFTER_DRAIN = false;
    bf16_t* O; int ldc;
    __device__ __forceinline__ void operator()(const f32x4 (&acc)[2][2][4][2], const Unit& u, int wr, int wc, int fr, int fq) const {
        const int row0 = u.pm * BM + wr * 64 + fr, col0 = u.pn * BM + wc * 32 + 8 * fq;
#pragma unroll
        for (int ai = 0; ai < 2; ++ai)
#pragma unroll
            for (int m = 0; m < 4; ++m) { bf16_t* rowp = O + (size_t)(row0 + ai * HALF + m * 16) * ldc + col0;
#pragma unroll
                for (int bj = 0; bj < 2; ++bj) { const f32x4 v0 = acc[ai][bj][m][0], v1 = acc[ai][bj][m][1];
                    u32x4 w; w.x = pk2(v0[0], v0[1]); w.y = pk2(v0[2], v0[3]); w.z = pk2(v1[0], v1[1]); w.w = pk2(v1[2], v1[3]);
                    *(u32x4*)(rowp + bj * HALF) = w; } }
    }
};
template <class Epi, class Sched>
__device__ __forceinline__ void gemm_phase(int wv, PG8_LAS unsigned char* lds, const Gemm g, const Sched& S, const Epi& E) {
    const int tid = ltid(wv), wid = __builtin_amdgcn_readfirstlane(tid >> 6), lane = tid & 63, wr = wid >> 2, wc = wid & 3, fr = lane & 15, fq = lane >> 4;
    const int K = g.K, nt = K / BK;
    unsigned voffA[2], voffB[2];
#pragma unroll
    for (int i = 0; i < 2; ++i) { int R, C; stage_rc(tid * 16 + i * 8192, R, C); const int Rb = Epi::PERM ? ((R & ~31) + perm32(R & 31)) : R;
        voffA[i] = (unsigned)(R * K + C) * 2u; voffB[i] = (unsigned)(Rb * K + C) * 2u; }
    const size_t kstep = (size_t)(BK * 2);
    const size_t hstep = (size_t)HALF * K * 2;
    const size_t tstep = 2 * hstep;
    const unsigned ldsw = (unsigned)wid * 1024u;
    const int aoff = lds_byte(wr * 64 + fr, fq * 8), boff = lds_byte(wc * 32 + fr, fq * 8);
#define PG8_SA(b, h) (((b) * 2 + (h)) * HTB)
#define PG8_SB(b, h) ((4 + (b) * 2 + (h)) * HTB)
#define PG8_STAGE(bufoff, gbase, voff) do { _Pragma("unroll") for (int _i = 0; _i < 2; ++_i) \
        __builtin_amdgcn_global_load_lds((const unsigned*)((const char*)(gbase) + (voff)[_i]), (PG8_LAS unsigned*)(lds + (bufoff) + ldsw + _i * 8192), 16, 0, 0); } while (0)
#define PG8_LDA(dst, b, h) do { _Pragma("unroll") for (int m = 0; m < 4; ++m) _Pragma("unroll") for (int k = 0; k < 2; ++k) dst[m][k] = *(const PG8_LAS bf16x8*)(lds + PG8_SA(b, h) + aoff + m * 2048 + k * 1024); } while (0)
#define PG8_LDB(dst, b, h) do { _Pragma("unroll") for (int n = 0; n < 2; ++n) _Pragma("unroll") for (int k = 0; k < 2; ++k) dst[n][k] = *(const PG8_LAS bf16x8*)(lds + PG8_SB(b, h) + boff + n * 2048 + k * 1024); } while (0)
#define PG8_MMA(ai, bj, At, Bt) do { __builtin_amdgcn_s_setprio(1); _Pragma("unroll") for (int m = 0; m < 4; ++m) _Pragma("unroll") for (int n = 0; n < 2; ++n) _Pragma("unroll") for (int k = 0; k < 2; ++k) \
        acc[ai][bj][m][n] = __builtin_amdgcn_mfma_f32_16x16x32_bf16(Bt[n][k], At[m][k], acc[ai][bj][m][n], 0, 0, 0); __builtin_amdgcn_s_setprio(0); } while (0)
#define PG8_WAIT_V(n) asm volatile("s_waitcnt vmcnt(" #n ")" ::: "memory")
#define PG8_WAIT_L(n) asm volatile("s_waitcnt lgkmcnt(" #n ")" ::: "memory")
#define PG8_BAR __builtin_amdgcn_s_barrier()
#define PG8_SCHED __builtin_amdgcn_sched_barrier(0)
    Unit cur, nxt; int ui = 0;
    if (!S.next(0, cur)) return;
    f32x4 acc[2][2][4][2];
#pragma unroll
    for (int a = 0; a < 2; ++a)
#pragma unroll
        for (int b = 0; b < 2; ++b)
#pragma unroll
            for (int m = 0; m < 4; ++m)
#pragma unroll
                for (int n = 0; n < 2; ++n) acc[a][b][m][n] = (f32x4){0.f, 0.f, 0.f, 0.f};
    bf16x8 At[4][2], B0[2][2], B1[2][2];
    const char* cA = (const char*)g.A + (size_t)cur.pm * tstep; const char* cB = (const char*)g.Bt + (size_t)cur.pn * tstep;
    S.a_ready(cur);
    PG8_STAGE(PG8_SB(0, 0), cB, voffB); PG8_STAGE(PG8_SA(0, 0), cA, voffA); PG8_STAGE(PG8_SB(0, 1), cB + hstep, voffB); PG8_STAGE(PG8_SA(0, 1), cA + hstep, voffA);
    if (wr == 1) PG8_BAR;
    PG8_WAIT_V(4); PG8_BAR;
    PG8_STAGE(PG8_SB(1, 0), cB + kstep, voffB); PG8_STAGE(PG8_SA(1, 0), cA + kstep, voffA); PG8_STAGE(PG8_SB(1, 1), cB + hstep + kstep, voffB);
    PG8_WAIT_V(6); PG8_BAR;
    for (;;) {
        const bool has_next = S.next(ui + 1, nxt);
        const char* nA = has_next ? (const char*)g.A + (size_t)nxt.pm * tstep : cA; const char* nB = has_next ? (const char*)g.Bt + (size_t)nxt.pn * tstep : cB;
        for (int t = 0; t < nt; t += 2) {
            const bool last = (t == nt - 2);
            const char* a1 = cA + (size_t)(t + 1) * kstep;
            const char* a2 = last ? nA : cA + (size_t)(t + 2) * kstep; const char* b2 = last ? nB : cB + (size_t)(t + 2) * kstep;
            const char* a3 = a2 + kstep; const char* b3 = b2 + kstep;
            if (last && has_next) S.a_ready(nxt);
            PG8_LDB(B0, 0, 0); PG8_SCHED; PG8_LDA(At, 0, 0); PG8_STAGE(PG8_SA(1, 1), a1 + hstep, voffA);
            PG8_WAIT_L(8); PG8_BAR; PG8_WAIT_L(0); PG8_MMA(0, 0, At, B0); PG8_BAR; PG8_SCHED;
            PG8_LDB(B1, 0, 1); PG8_STAGE(PG8_SB(0, 0), b2, voffB);
            PG8_BAR; PG8_WAIT_L(0); PG8_MMA(0, 1, At, B1); PG8_BAR;
            PG8_LDA(At, 0, 1); PG8_STAGE(PG8_SA(0, 0), a2, voffA);
            PG8_BAR; PG8_WAIT_L(0); PG8_MMA(1, 0, At, B0); PG8_BAR; PG8_SCHED;
            PG8_STAGE(PG8_SB(0, 1), b2 + hstep, voffB);
            PG8_WAIT_V(6); PG8_BAR; PG8_MMA(1, 1, At, B1); PG8_BAR;
            PG8_LDB(B0, 1, 0); PG8_SCHED; PG8_LDA(At, 1, 0); PG8_STAGE(PG8_SA(0, 1), a2 + hstep, voffA);
            PG8_WAIT_L(8); PG8_BAR; PG8_WAIT_L(0); PG8_MMA(0, 0, At, B0); PG8_BAR; PG8_SCHED;
            PG8_LDB(B1, 1, 1); PG8_STAGE(PG8_SB(1, 0), b3, voffB);
            PG8_BAR; PG8_WAIT_L(0); PG8_MMA(0, 1, At, B1); PG8_BAR;
            PG8_LDA(At, 1, 1); PG8_STAGE(PG8_SA(1, 0), a3, voffA);
            PG8_BAR; PG8_WAIT_L(0); PG8_MMA(1, 0, At, B0); PG8_BAR; PG8_SCHED;
            PG8_STAGE(PG8_SB(1, 1), b3 + hstep, voffB);
            PG8_WAIT_V(6); PG8_BAR; PG8_MMA(1, 1, At, B1); PG8_BAR;
        }
            if constexpr (!Epi::AFTER_DRAIN) { E(acc, cur, wr, wc, fr, fq); S.done(cur); }
            if (!has_next) break;
#pragma unroll
        for (int a = 0; a < 2; ++a)
#pragma unroll
            for (int b = 0; b < 2; ++b)
#pragma unroll
                for (int m = 0; m < 4; ++m)
#pragma unroll
                    for (int n = 0; n < 2; ++n) acc[a][b][m][n] = (f32x4){0.f, 0.f, 0.f, 0.f};
        cur = nxt; cA = nA; cB = nB; ++ui;
    }
    PG8_WAIT_V(0);
    if (wr == 0) PG8_BAR;
    PG8_BAR;
    if constexpr (Epi::AFTER_DRAIN) { E.fused(acc, cur, wr, wc, fr, fq, lds, wid, lane); S.done(cur); }
#undef PG8_SA
#undef PG8_SB
#undef PG8_STAGE
#undef PG8_LDA
#undef PG8_LDB
#undef PG8_MMA
#undef PG8_WAIT_V
#undef PG8_WAIT_L
#undef PG8_BAR
#undef PG8_SCHED
}
struct UnitG { int pm, pn; const char* bbase; const PG8_LAS int* ltab; int cnt; int e; };
struct MoeOrder {
    const PG8_LAS int* tstart; const PG8_LAS int* tcnt; const PG8_LAS int* ltabs; const int* lists; const char* bt; size_t estride; int ncol, shift, G, c;
    __device__ __forceinline__ bool next(int i, UnitG& u) const {
        const int t = i * G + c; if (t >= tstart[32] * ncol) return false;
        const int tm = t / ncol; int e = 0;
#pragma unroll 1
        while (tstart[e + 1] <= tm) ++e;
        e = __builtin_amdgcn_readfirstlane(e);
        const int ts = __builtin_amdgcn_readfirstlane(tstart[e]), tc = __builtin_amdgcn_readfirstlane(tcnt[e]);
        u.pm = tm - ts; u.pn = t - tm * ncol; u.bbase = bt + (size_t)e * estride; u.e = e; u.cnt = tc - u.pm * BM; u.ltab = ltabs + i * BM;
        return true;
    }
    __device__ __forceinline__ void a_ready(const UnitG&) const {}
    __device__ __forceinline__ void done(const UnitG&) const {}
};
struct EpiSwiGLUG {
    static constexpr bool PERM = false, AFTER_DRAIN = false;
    bf16_t* H;
    __device__ __forceinline__ void operator()(const f32x4 (&acc)[2][2][4][2], const UnitG& u, int wr, int wc, int fr, int fq) const {
#pragma unroll
        for (int ai = 0; ai < 2; ++ai)
#pragma unroll
            for (int m = 0; m < 4; ++m) { const int r = ai * HALF + wr * 64 + m * 16 + fr;
                if (r < u.cnt) { bf16_t* rowp = H + (size_t)u.ltab[r] * DEXP + ((u.pn * BM + wc * 32) >> 1) + 4 * fq;
#pragma unroll
                    for (int bj = 0; bj < 2; ++bj) { const f32x4 gt = acc[ai][bj][m][0], up = acc[ai][bj][m][1];
                        u32x2 w; w.x = pk2(siluf_(gt[0]) * up[0], siluf_(gt[1]) * up[1]); w.y = pk2(siluf_(gt[2]) * up[2], siluf_(gt[3]) * up[3]);
                        *(u32x2*)(rowp + bj * (HALF / 2)) = w; } } }
    }
};
struct EpiScatterG {
    static constexpr bool PERM = true, AFTER_DRAIN = false;
    bf16_t* O;
    __device__ __forceinline__ void operator()(const f32x4 (&acc)[2][2][4][2], const UnitG& u, int wr, int wc, int fr, int fq) const {
#pragma unroll
        for (int ai = 0; ai < 2; ++ai)
#pragma unroll
            for (int m = 0; m < 4; ++m) { const int r = ai * HALF + wr * 64 + m * 16 + fr;
                if (r < u.cnt) { bf16_t* rowp = O + (size_t)u.ltab[r] * D + u.pn * BM + wc * 32 + 8 * fq;
#pragma unroll
                    for (int bj = 0; bj < 2; ++bj) { const f32x4 v0 = acc[ai][bj][m][0], v1 = acc[ai][bj][m][1];
                        u32x4 w; w.x = pk2(v0[0], v0[1]); w.y = pk2(v0[2], v0[3]); w.z = pk2(v1[0], v1[1]); w.w = pk2(v1[2], v1[3]);
                        *(u32x4*)(rowp + bj * HALF) = w; } } }
    }
};
template <class Epi, class Sched>
__device__ __forceinline__ void gemm_phase_g(int wv, PG8_LAS unsigned char* lds, const Gemm g, const Sched& S, const Epi& E) {
    const int tid = ltid(wv), wid = __builtin_amdgcn_readfirstlane(tid >> 6), lane = tid & 63, wr = wid >> 2, wc = wid & 3, fr = lane & 15, fq = lane >> 4;
    const int K = g.K, nt = K / BK;
    unsigned voffB[2];
#pragma unroll
    for (int i = 0; i < 2; ++i) { int R, C; stage_rc(tid * 16 + i * 8192, R, C); const int Rb = Epi::PERM ? ((R & ~31) + perm32(R & 31)) : R;
        voffB[i] = (unsigned)(Rb * K + C) * 2u; }
    const unsigned rowb = (unsigned)K * 2u;
#define PG8_AOFFS(u, dst) do { const int _t = ltid(wv); _Pragma("unroll") for (int _i = 0; _i < 2; ++_i) { int _R, _C; stage_rc(_t * 16 + _i * 8192, _R, _C); \
        _Pragma("unroll") for (int _h = 0; _h < 2; ++_h) dst[_h][_i] = (unsigned)((u).ltab[_h * HALF + _R] >> S.shift) * rowb + (unsigned)(_C * 2); } } while (0)
#define PG8_STAGE_A(bufoff, AO, koff) do { _Pragma("unroll") for (int _i = 0; _i < 2; ++_i) \
        __builtin_amdgcn_global_load_lds((const unsigned*)((const char*)g.A + (size_t)(AO)[_i] + (size_t)(koff)), (PG8_LAS unsigned*)(lds + (bufoff) + ldsw + _i * 8192), 16, 0, 0); } while (0)
    const size_t kstep = (size_t)(BK * 2);
    const size_t hstep = (size_t)HALF * K * 2;
    const size_t tstep = 2 * hstep;
    const unsigned ldsw = (unsigned)wid * 1024u;
    const int aoff = lds_byte(wr * 64 + fr, fq * 8), boff = lds_byte(wc * 32 + fr, fq * 8);
#define PG8_SA(b, h) (((b) * 2 + (h)) * HTB)
#define PG8_SB(b, h) ((4 + (b) * 2 + (h)) * HTB)
#define PG8_STAGE(bufoff, gbase, voff) do { _Pragma("unroll") for (int _i = 0; _i < 2; ++_i) \
        __builtin_amdgcn_global_load_lds((const unsigned*)((const char*)(gbase) + (voff)[_i]), (PG8_LAS unsigned*)(lds + (bufoff) + ldsw + _i * 8192), 16, 0, 0); } while (0)
#define PG8_LDA(dst, b, h) do { _Pragma("unroll") for (int m = 0; m < 4; ++m) _Pragma("unroll") for (int k = 0; k < 2; ++k) dst[m][k] = *(const PG8_LAS bf16x8*)(lds + PG8_SA(b, h) + aoff + m * 2048 + k * 1024); } while (0)
#define PG8_LDB(dst, b, h) do { _Pragma("unroll") for (int n = 0; n < 2; ++n) _Pragma("unroll") for (int k = 0; k < 2; ++k) dst[n][k] = *(const PG8_LAS bf16x8*)(lds + PG8_SB(b, h) + boff + n * 2048 + k * 1024); } while (0)
#define PG8_MMA(ai, bj, At, Bt) do { __builtin_amdgcn_s_setprio(1); _Pragma("unroll") for (int m = 0; m < 4; ++m) _Pragma("unroll") for (int n = 0; n < 2; ++n) _Pragma("unroll") for (int k = 0; k < 2; ++k) \
        acc[ai][bj][m][n] = __builtin_amdgcn_mfma_f32_16x16x32_bf16(Bt[n][k], At[m][k], acc[ai][bj][m][n], 0, 0, 0); __builtin_amdgcn_s_setprio(0); } while (0)
#define PG8_WAIT_V(n) asm volatile("s_waitcnt vmcnt(" #n ")" ::: "memory")
#define PG8_WAIT_L(n) asm volatile("s_waitcnt lgkmcnt(" #n ")" ::: "memory")
#define PG8_BAR __builtin_amdgcn_s_barrier()
#define PG8_SCHED __builtin_amdgcn_sched_barrier(0)
    UnitG cur, nxt; int ui = 0;
    if (!S.next(0, cur)) return;
    f32x4 acc[2][2][4][2];
#pragma unroll
    for (int a = 0; a < 2; ++a)
#pragma unroll
        for (int b = 0; b < 2; ++b)
#pragma unroll
            for (int m = 0; m < 4; ++m)
#pragma unroll
                for (int n = 0; n < 2; ++n) acc[a][b][m][n] = (f32x4){0.f, 0.f, 0.f, 0.f};
    bf16x8 At[4][2], B0[2][2], B1[2][2];
    unsigned ca[2][2]; PG8_AOFFS(cur, ca); const char* cB = cur.bbase + (size_t)cur.pn * tstep;
    S.a_ready(cur);
    PG8_STAGE(PG8_SB(0, 0), cB, voffB); PG8_STAGE_A(PG8_SA(0, 0), ca[0], 0); PG8_STAGE(PG8_SB(0, 1), cB + hstep, voffB); PG8_STAGE_A(PG8_SA(0, 1), ca[1], 0);
    if (wr == 1) PG8_BAR;
    PG8_WAIT_V(4); PG8_BAR;
    PG8_STAGE(PG8_SB(1, 0), cB + kstep, voffB); PG8_STAGE_A(PG8_SA(1, 0), ca[0], kstep); PG8_STAGE(PG8_SB(1, 1), cB + hstep + kstep, voffB);
    PG8_WAIT_V(6); PG8_BAR;
    for (;;) {
        const bool has_next = S.next(ui + 1, nxt);
        const char* nB = has_next ? nxt.bbase + (size_t)nxt.pn * tstep : cB;
        for (int t = 0; t < nt; t += 2) {
            const bool last = (t == nt - 2);
            const size_t k1 = (size_t)(t + 1) * kstep, k2 = last ? 0 : (size_t)(t + 2) * kstep;
            unsigned a2o[2][2];
            if (last && has_next) PG8_AOFFS(nxt, a2o); else { a2o[0][0] = ca[0][0]; a2o[0][1] = ca[0][1]; a2o[1][0] = ca[1][0]; a2o[1][1] = ca[1][1]; }
            const char* b2 = last ? nB : cB + (size_t)(t + 2) * kstep; const char* b3 = b2 + kstep;
            if (last && has_next) S.a_ready(nxt);
            PG8_LDB(B0, 0, 0); PG8_SCHED; PG8_LDA(At, 0, 0); PG8_STAGE_A(PG8_SA(1, 1), ca[1], k1);
            PG8_WAIT_L(8); PG8_BAR; PG8_WAIT_L(0); PG8_MMA(0, 0, At, B0); PG8_BAR; PG8_SCHED;
            PG8_LDB(B1, 0, 1); PG8_STAGE(PG8_SB(0, 0), b2, voffB);
            PG8_BAR; PG8_WAIT_L(0); PG8_MMA(0, 1, At, B1); PG8_BAR;
            PG8_LDA(At, 0, 1); PG8_STAGE_A(PG8_SA(0, 0), a2o[0], k2);
            PG8_BAR; PG8_WAIT_L(0); PG8_MMA(1, 0, At, B0); PG8_BAR; PG8_SCHED;
            PG8_STAGE(PG8_SB(0, 1), b2 + hstep, voffB);
            PG8_WAIT_V(6); PG8_BAR; PG8_MMA(1, 1, At, B1); PG8_BAR;
            PG8_LDB(B0, 1, 0); PG8_SCHED; PG8_LDA(At, 1, 0); PG8_STAGE_A(PG8_SA(0, 1), a2o[1], k2);
            PG8_WAIT_L(8); PG8_BAR; PG8_WAIT_L(0); PG8_MMA(0, 0, At, B0); PG8_BAR; PG8_SCHED;
            PG8_LDB(B1, 1, 1); PG8_STAGE(PG8_SB(1, 0), b3, voffB);
            PG8_BAR; PG8_WAIT_L(0); PG8_MMA(0, 1, At, B1); PG8_BAR;
            PG8_LDA(At, 1, 1); PG8_STAGE_A(PG8_SA(1, 0), a2o[0], k2 + kstep);
            PG8_BAR; PG8_WAIT_L(0); PG8_MMA(1, 0, At, B0); PG8_BAR; PG8_SCHED;
            PG8_STAGE(PG8_SB(1, 1), b3 + hstep, voffB);
            PG8_WAIT_V(6); PG8_BAR; PG8_MMA(1, 1, At, B1); PG8_BAR;
            if (last) { ca[0][0] = a2o[0][0]; ca[0][1] = a2o[0][1]; ca[1][0] = a2o[1][0]; ca[1][1] = a2o[1][1]; }
        }
            if constexpr (!Epi::AFTER_DRAIN) { E(acc, cur, wr, wc, fr, fq); S.done(cur); }
            if (!has_next) break;
#pragma unroll
        for (int a = 0; a < 2; ++a)
#pragma unroll
            for (int b = 0; b < 2; ++b)
#pragma unroll
                for (int m = 0; m < 4; ++m)
#pragma unroll
                    for (int n = 0; n < 2; ++n) acc[a][b][m][n] = (f32x4){0.f, 0.f, 0.f, 0.f};
        cur = nxt; cB = nB; ++ui;
    }
    PG8_WAIT_V(0);
    if (wr == 0) PG8_BAR;
    PG8_BAR;
    if constexpr (Epi::AFTER_DRAIN) { E.fused(acc, cur, wr, wc, fr, fq, lds, wid, lane); S.done(cur); }
#undef PG8_SA
#undef PG8_AOFFS
#undef PG8_STAGE_A
#undef PG8_SB
#undef PG8_STAGE
#undef PG8_LDA
#undef PG8_LDB
#undef PG8_MMA
#undef PG8_WAIT_V
#undef PG8_WAIT_L
#undef PG8_BAR
#undef PG8_SCHED
}
}

__device__ __forceinline__ void transpose_item(const float* __restrict__ W, int K, int N, bf16_t* __restrict__ WT, int mode, LAS float* scr, int item, int lane) {
    const int nblk = N / 32, kb = item / nblk, nb = item % nblk, k0 = 64 * kb, n0 = 32 * nb;
#pragma unroll 8
    for (int i = 0; i < 32; ++i) { const int kk = 2 * i + (lane >> 5); scr[kk * 33 + (lane & 31)] = W[(size_t)(k0 + kk) * N + n0 + (lane & 31)]; }
    asm volatile("s_waitcnt lgkmcnt(0)" ::: "memory");
    const int c = lane & 7;
#pragma unroll
    for (int j = 0; j < 4; ++j) {
        const int nl = (lane >> 3) + 8 * j; const LAS float* s = scr + (8 * c) * 33 + nl;
        u32x4 o; o.x = pk2(s[0 * 33], s[1 * 33]); o.y = pk2(s[2 * 33], s[3 * 33]); o.z = pk2(s[4 * 33], s[5 * 33]); o.w = pk2(s[6 * 33], s[7 * 33]);
        const int n = n0 + nl;
        const int nd = mode == 0 ? n : (32 * (n >> 4) + (n & 15) + (mode == 2 ? 16 : 0));
        *(u32x4*)(WT + (size_t)nd * K + k0 + 8 * c) = o;
    }
    asm volatile("s_waitcnt lgkmcnt(0)" ::: "memory");
}

__device__ __forceinline__ void phase_prologue0(int wv, KP Pk, LAS char* lds) {
    asm volatile("" : "+s"(Pk));
    const CAS Params& P = *Pk;
    const int tid = ltid(wv), lane = tid & 63, wid = tid >> 6;
    const int gw = blockIdx.x * 8 + wid, NGW = gridDim.x * 8;
    LAS float* scr = (LAS float*)(lds + wid * 8448);
    bf16_t* winT = (bf16_t*)(P.ws + WS_WINT);
    bf16_t* woutT = (bf16_t*)(P.ws + WS_WOUTT);
    bf16_t* loraT = (bf16_t*)(P.ws + WS_LORAT);
    constexpr int I_EV = 16 * (P_EVEN / 32), I_OD = 16 * (P_ODD / 32), I_O = 16 * 32, I_L64 = 16, I_L128 = 32;
    constexpr int I_LORA = 3 * I_L64 + I_L128;
    constexpr int NIT = 2 * I_EV + 2 * I_OD + 4 * I_O + 2 * I_LORA;
    for (int it = gw; it < NIT; it += NGW) {
        int r = it;
        if (r < 2 * I_EV) { const int i = r / I_EV; transpose_item(P.ev_w_in + (size_t)i * D * P_EVEN, D, P_EVEN, winT + (i ? WINT_L2 : WINT_L0), 0, scr, r % I_EV, lane); continue; } r -= 2 * I_EV;
        if (r < 2 * I_OD) { const int i = r / I_OD; transpose_item(P.od_w_in + (size_t)i * D * P_ODD, D, P_ODD, winT + (i ? WINT_L3 : WINT_L1), 0, scr, r % I_OD, lane); continue; } r -= 2 * I_OD;
        if (r < 4 * I_O) { const int l = r / I_O; const float* src = (l & 1) ? P.od_w_out + (size_t)(l >> 1) * D * D : P.ev_w_out + (size_t)(l >> 1) * D * D;
            transpose_item(src, D, D, woutT + (size_t)l * D * D, 0, scr, r % I_O, lane); continue; } r -= 4 * I_O;
        { const int i = r / I_LORA; int q = r % I_LORA; bf16_t* dst = loraT + (size_t)i * LORA_PER;
          if (q < I_L64) { transpose_item(P.rw_w2 + (size_t)(i * 2 + 0) * 64 * 512, 64, 512, dst, 0, scr, q, lane); continue; } q -= I_L64;
          if (q < I_L64) { transpose_item(P.rw_w2 + (size_t)(i * 2 + 1) * 64 * 512, 64, 512, dst + 512 * 64, 0, scr, q, lane); continue; } q -= I_L64;
          if (q < I_L64) { transpose_item(P.rw_a2 + (size_t)i * 64 * 512, 64, 512, dst + 2 * 512 * 64, 0, scr, q, lane); continue; } q -= I_L64;
          transpose_item(P.rw_g2 + (size_t)i * 128 * 512, 128, 512, dst + 3 * 512 * 64, 0, scr, q, lane); }
    }
    {
        const int gt = blockIdx.x * NT + tid, NG = gridDim.x * NT;
        constexpr int PADE = (LDP_EVEN - P_EVEN) * D / 8, PADO = (LDP_ODD - P_ODD) * D / 8;
        for (int i = gt; i < 2 * PADE + 2 * PADO; i += NG) {
            int r = i; bf16_t* dst;
            if (r < 2 * PADE) { const int l = r / PADE; dst = winT + (l ? WINT_L2 : WINT_L0) + (size_t)P_EVEN * D + (size_t)(r % PADE) * 8; }
            else { r -= 2 * PADE; const int l = r / PADO; dst = winT + (l ? WINT_L3 : WINT_L1) + (size_t)P_ODD * D + (size_t)(r % PADO) * 8; }
            *(u32x4*)dst = (u32x4){0u, 0u, 0u, 0u};
        }
    }
    {
        const int gt = blockIdx.x * NT + tid, NG = gridDim.x * NT;
        float* xc = (float*)(P.ws + WS_XC);
        for (int i = gt; i < NCTX * D / 4; i += NG) ((f32x4*)xc)[i] = ((const f32x4*)P.ctx)[i];
        float* lb = (float*)(P.ws + WS_LB);
        for (int ch = gt; ch < 512; ch += NG) {
            float lg[4], mx = -1e30f;
#pragma unroll
            for (int l = 0; l < 4; ++l) { lg[l] = P.hg_lb_logits[l * 512 + ch]; mx = fmaxf(mx, lg[l]); }
            float e[4], s = 0.f;
#pragma unroll
            for (int l = 0; l < 4; ++l) { e[l] = __expf(lg[l] - mx); s += e[l]; }
            float cum = 0.f;
#pragma unroll
            for (int l = 0; l < 4; ++l) { if (l > 0) cum += e[l] / s; lb[l * 512 + ch] = cum; }
        }
    }
    __syncthreads();
    {
        LAS float* sc = (LAS float*)lds;
        LAS float* red = (LAS float*)(lds + 5 * 1024 * 4);
        for (int i = tid; i < 5 * D; i += NT) { const int m = i >> 10, k = i & 1023; const float v = m < 4 ? P.c[m * D + k] : P.c_ctx[k]; sc[i] = siluf_(v); }
        __syncthreads();
        float* modv = (float*)(P.ws + WS_MODV);
        const int col = tid & 127, kq = tid >> 7;
        for (int item = blockIdx.x; item < 4 * 48; item += gridDim.x) {
            const int l = item / 48, j = (item % 48) * 128 + col;
            const float* w = P.mod_w + (size_t)l * D * 6144 + j;
            float a[5] = {0.f, 0.f, 0.f, 0.f, 0.f};
#pragma unroll 8
            for (int k = kq * 256; k < kq * 256 + 256; ++k) {
                const float wv = w[(size_t)k * 6144];
#pragma unroll
                for (int m = 0; m < 5; ++m) a[m] += sc[m * 1024 + k] * wv;
            }
#pragma unroll
            for (int m = 0; m < 5; ++m) red[(kq * 128 + col) * 5 + m] = a[m];
            __syncthreads();
            if (kq == 0) {
                const float bias = P.mod_b[l * 6144 + j];
#pragma unroll
                for (int m = 0; m < 5; ++m) {
                    const float s = red[(0 * 128 + col) * 5 + m] + red[(1 * 128 + col) * 5 + m] + red[(2 * 128 + col) * 5 + m] + red[(3 * 128 + col) * 5 + m];
                    modv[(size_t)(l * 5 + m) * 6144 + j] = s + bias;
                }
            }
            __syncthreads();
        }
    }
}

__device__ __forceinline__ void phase_prologue1(int wv, KP Pk) {
    asm volatile("" : "+s"(Pk));
    const CAS Params& P = *Pk;
    const int tid = ltid(wv), lane = tid & 63, wid = tid >> 6;
    bf16_t* act = (bf16_t*)(P.ws + WS_ACT);
    for (int r = blockIdx.x * 8 + wid; r < NROWS; r += gridDim.x * 8) {
        const int m = row_mod(r);
        const float* src = r < NCTX ? P.ctx + (size_t)r * D : P.x + (size_t)(r - NCTX) * D;
        const float* sh = modvec(P.ws, 0, m, 0); const float* sc = modvec(P.ws, 0, m, 1);
#pragma unroll
        for (int i = 0; i < 4; ++i) {
            const int c = 4 * lane + 256 * i;
            const f32x4 v = *(const f32x4*)(src + c), s1 = *(const f32x4*)(sc + c), h1 = *(const f32x4*)(sh + c);
            if (r >= NCTX) *(f32x4*)(P.out + (size_t)(r - NCTX) * D + c) = v;
            u32x2 o; o.x = pk2(v[0] * (1.f + s1[0]) + h1[0], v[1] * (1.f + s1[1]) + h1[1]); o.y = pk2(v[2] * (1.f + s1[2]) + h1[2], v[3] * (1.f + s1[3]) + h1[3]);
            *(u32x2*)(act + (size_t)r * D + c) = o;
        }
    }
}

__device__ __forceinline__ void phase_inproj(int wv, KP Pk, int layer, LAS char* lds) {
    asm volatile("" : "+s"(Pk));
    const CAS Params& P = *Pk;
    const int odd = layer & 1, ldp = odd ? LDP_ODD : LDP_EVEN;
    const size_t woff = layer == 0 ? WINT_L0 : layer == 1 ? WINT_L1 : layer == 2 ? WINT_L2 : WINT_L3;
    pg8::Gemm g{(const bf16_t*)(P.ws + WS_ACT), (const bf16_t*)(P.ws + WS_WINT) + woff, NROWS, ldp, D};
    pg8::StaticOrder S; S.init(NROWS, ldp, (int)gridDim.x, (int)blockIdx.x);
    pg8::EpiStoreP E{(bf16_t*)(P.ws + WS_P), ldp};
    pg8::gemm_phase(wv, (PG8_LAS unsigned char*)lds, g, S, E);
}
__device__ __forceinline__ void phase_outproj(int wv, KP Pk, int layer, LAS char* lds) {
    asm volatile("" : "+s"(Pk));
    const CAS Params& P = *Pk;
    const int r0 = (layer == DEPTH - 1) ? NCTX : 0;
    pg8::Gemm g{(const bf16_t*)(P.ws + WS_FEAT) + (size_t)r0 * D, (const bf16_t*)(P.ws + WS_WOUTT) + (size_t)layer * D * D, NROWS - r0, D, D};
    pg8::StaticOrder S; S.init(NROWS - r0, D, (int)gridDim.x, (int)blockIdx.x);
    pg8::EpiStoreP E{(bf16_t*)(P.ws + WS_YO) + (size_t)r0 * D, D};
    pg8::gemm_phase(wv, (PG8_LAS unsigned char*)lds, g, S, E);
}
__device__ __forceinline__ void phase_prep2(int wv, KP Pk, int layer, LAS char* lds) {
    asm volatile("" : "+s"(Pk));
    const CAS Params& P = *Pk;
    const int i = layer >> 1;
    const bf16_t* la = (const bf16_t*)(P.ws + WS_LA);
    const bf16_t* lt = (const bf16_t*)(P.ws + WS_LORAT) + (size_t)i * LORA_PER;
    constexpr int MT = NROWS / G_BM, NTL = 512 / G_BN;
    const int ntiles = 4 * MT * NTL;
    for (int t = blockIdx.x; t < ntiles; t += gridDim.x) {
        const int which = t / (MT * NTL), r = t % (MT * NTL), mt = r / NTL, nt = r % NTL;
        RowLinear rs{mt * G_BM};
        if (which < 2) {
            EpiDecay epi{(float*)(P.ws + WS_RWDEC) + (size_t)which * NROWS * 512, P.rw_w0 + (size_t)(i * 2 + which) * 512, mt * G_BM, nt * G_BN};
            gemm_tile(wv, la + which * 64, 320, rs, lt + (size_t)which * 512 * 64, 64, nt * G_BN, 64, epi, lds);
        } else if (which == 2) {
            EpiAK epi{(bf16_t*)(P.ws + WS_RWK), (const bf16_t*)(P.ws + WS_RWKK), (bf16_t*)(P.ws + WS_RWB), P.rw_a0 + i * 512, P.rw_k_a + i * 512, mt * G_BM, nt * G_BN};
            gemm_tile(wv, la + 128, 320, rs, lt + (size_t)2 * 512 * 64, 64, nt * G_BN, 64, epi, lds);
        } else {
            EpiStoreBf16 epi{(bf16_t*)(P.ws + WS_RWG), 512, mt * G_BM, nt * G_BN, 512};
            gemm_tile(wv, la + 192, 320, rs, lt + (size_t)3 * 512 * 64, 128, nt * G_BN, 128, epi, lds);
        }
    }
}
__device__ __forceinline__ void moe_tiles(int wv, const unsigned char* ws, int layer, LAS int* tstart, LAS int* tcnt) {
    const int tid = ltid(wv);
    if (tid < 64) {
        const int* cnt = (const int*)(ws + WS_CNT) + layer * 32 * CNT_STRIDE;
        const int c = tid < NEXP ? cnt[tid * CNT_STRIDE] : 0;
        int incl = (c + G_BM - 1) / G_BM;
#pragma unroll
        for (int o = 1; o < 32; o <<= 1) { const int t = __shfl_up(incl, o); if (tid >= o) incl += t; }
        if (tid < NEXP) { tcnt[tid] = c; tstart[tid] = incl - (c + G_BM - 1) / G_BM; }
        if (tid == NEXP - 1) tstart[NEXP] = incl;
    }
    __syncthreads();
}
__device__ __forceinline__ void phase_moe1(int wv, KP Pk, int layer, LAS char* lds) {
    asm volatile("" : "+s"(Pk));
    const CAS Params& P = *Pk;
    LAS int* tstart = (LAS int*)(lds + pg8::STAGE_BYTES); LAS int* tcnt = tstart + 40;
    moe_tiles(wv, P.ws, layer, tstart, tcnt);
    pg8::Gemm g{(const bf16_t*)(P.ws + WS_ACT), (const bf16_t*)(P.ws + WS_EXPGU), 0, 1024, D};
    LAS int* ltabs = tstart + 128;
    pg8::MoeOrder S{tstart, tcnt, ltabs, (const int*)(P.ws + WS_LIST), (const char*)(P.ws + WS_EXPGU), (size_t)1024 * 1024 * 2, 4, 1, (int)gridDim.x, (int)blockIdx.x};
    pg8::EpiSwiGLUG E{(bf16_t*)(P.ws + WS_HID)};
    for (int i = 0; i < 8; ++i) {
        pg8::UnitG u; if (!S.next(i, u)) break;
        const int tl = ltid(wv);
        const int* ul = (const int*)(P.ws + WS_LIST) + (size_t)u.e * LISTCAP + u.pm * pg8::BM;
        if (tl < pg8::BM) ltabs[i * pg8::BM + tl] = ul[tl < u.cnt ? tl : 0];
    }
    __syncthreads();
    pg8::gemm_phase_g(wv, (PG8_LAS unsigned char*)lds, g, S, E);
    __syncthreads();
}
__device__ __forceinline__ void phase_moe2(int wv, KP Pk, int layer, LAS char* lds) {
    asm volatile("" : "+s"(Pk));
    const CAS Params& P = *Pk;
    LAS int* tstart = (LAS int*)(lds + pg8::STAGE_BYTES); LAS int* tcnt = tstart + 40;
    moe_tiles(wv, P.ws, layer, tstart, tcnt);
    pg8::Gemm g{(const bf16_t*)(P.ws + WS_HID), (const bf16_t*)(P.ws + WS_EXPD), 0, 1024, DEXP};
    LAS int* ltabs = tstart + 128;
    pg8::MoeOrder S{tstart, tcnt, ltabs, (const int*)(P.ws + WS_LIST), (const char*)(P.ws + WS_EXPD), (size_t)1024 * 512 * 2, 4, 0, (int)gridDim.x, (int)blockIdx.x};
    pg8::EpiScatterG E{(bf16_t*)(P.ws + WS_YP)};
    for (int i = 0; i < 8; ++i) {
        pg8::UnitG u; if (!S.next(i, u)) break;
        const int tl = ltid(wv);
        const int* ul = (const int*)(P.ws + WS_LIST) + (size_t)u.e * LISTCAP + u.pm * pg8::BM;
        if (tl < pg8::BM) ltabs[i * pg8::BM + tl] = ul[tl < u.cnt ? tl : 0];
    }
    __syncthreads();
    pg8::gemm_phase_g(wv, (PG8_LAS unsigned char*)lds, g, S, E);
    __syncthreads();
}

constexpr int NCHUNK = NSTEPS / TCH;

constexpr int SSD_F = 32 + 64 + 64;
constexpr int SSD_BUF = TCH * SSD_F + 3 * TCH;
__device__ __forceinline__ void scan_ssd(int wv, KP Pk, int layer, int unit, LAS char* lds) {
    asm volatile("" : "+s"(Pk));
    const CAS Params& P = *Pk;
    const int tid = ltid(wv), i_ = layer >> 1;
    const int seq = unit >> 1, half = unit & 1, b = seq >> 4, h = (seq >> 1) & 7, dir = seq & 1, grp = h >> 2;
    LAS float* cw = (LAS float*)lds;
    LAS float* bufs = cw + 4 * 160;
    const bf16_t* Pb = (const bf16_t*)(P.ws + WS_P);
    bf16_t* Y = (bf16_t*)(P.ws + (dir ? WS_YB : WS_YF));
    for (int i = tid; i < 4 * 160; i += NT) {
        const int tap = i / 160, lc = i % 160, g = lc >> 3, e = lc & 7;
        const int ch = g < 4 ? (h * 64 + half * 32 + 8 * g + e) : g < 12 ? (512 + grp * 64 + 8 * (g - 4) + e) : (640 + grp * 64 + 8 * (g - 12) + e);
        cw[i] = tap < 3 ? P.ssd_conv_w[(size_t)(i_ * 3 + tap) * 768 + ch] : P.ssd_conv_b[i_ * 768 + ch];
    }
    const float dtb = P.ssd_dt_bias[(i_ * 2 + dir) * 8 + h], aco = -__expf(P.ssd_a_log[(i_ * 2 + dir) * 8 + h]);
    int tj[2], tg_[2], tcol[2]; bool tv[2];
#pragma unroll
    for (int s = 0; s < 2; ++s) {
        const int task = tid + NT * s; tv[s] = task < 640; tj[s] = task / 20; tg_[s] = task % 20;
        const int g = tg_[s];
        tcol[s] = g < 4 ? (512 + h * 64 + half * 32 + 8 * g) : g < 12 ? (1024 + grp * 64 + 8 * (g - 4)) : (1152 + grp * 64 + 8 * (g - 12));
    }
    u32x4 rp[2], rc[2], rn[2]; float rdt = 0.f; int rrow = 0;
    auto load = [&](int c) {
#pragma unroll
        for (int s = 0; s < 2; ++s) {
            rp[s] = rc[s] = rn[s] = (u32x4){0u, 0u, 0u, 0u};
            if (tv[s]) {
                const int row = scan_row(c * TCH + tj[s], b, dir, 0); int t, len; row_seg(row, t, len);
                const bf16_t* p = Pb + (size_t)row * LDP_EVEN + tcol[s];
                rc[s] = *(const u32x4*)p;
                if (t > 0) rp[s] = *(const u32x4*)(p - LDP_EVEN);
                if (t < len - 1) rn[s] = *(const u32x4*)(p + LDP_EVEN);
            }
        }
        if (tid < TCH) { rrow = scan_row(c * TCH + tid, b, dir, 0); rdt = bf2f(Pb[(size_t)rrow * LDP_EVEN + 1280 + dir * 8 + h]); }
    };
    auto store = [&](int c) {
        LAS float* buf = bufs + (c & 1) * SSD_BUF;
#pragma unroll
        for (int s = 0; s < 2; ++s) {
            if (tv[s]) {
                float fp[8], fc[8], fn[8], o[8]; unpack8(rp[s], fp); unpack8(rc[s], fc); unpack8(rn[s], fn);
                const int lc = tg_[s] * 8;
#pragma unroll
                for (int e = 0; e < 8; ++e) o[e] = siluf_(cw[lc + e] * fp[e] + cw[160 + lc + e] * fc[e] + cw[320 + lc + e] * fn[e] + cw[480 + lc + e]);
                LAS float* dst = buf + tj[s] * SSD_F + lc;
                *(LAS f32x4*)dst = (f32x4){o[0], o[1], o[2], o[3]}; *(LAS f32x4*)(dst + 4) = (f32x4){o[4], o[5], o[6], o[7]};
            }
        }
        if (tid < TCH) {
            const float dt = softplusf_(rdt + dtb);
            buf[TCH * SSD_F + tid] = __expf(dt * aco); buf[TCH * SSD_F + TCH + tid] = dt; ((LAS int*)buf)[TCH * SSD_F + 2 * TCH + tid] = rrow;
        }
    };
    const int prow = tid >> 4, q = tid & 15;
    float hs[4] = {0.f, 0.f, 0.f, 0.f};
    __syncthreads();
    load(0); store(0); __syncthreads();
    for (int c = 0; c < NCHUNK; ++c) {
        if (c + 1 < NCHUNK) load(c + 1);
        LAS float* buf = bufs + (c & 1) * SSD_BUF;
        {
            const LAS float* xp = buf + prow;
            const LAS float* bp = buf + 32 + 4 * q;
            const LAS float* aux = buf + TCH * SSD_F;
            f32x4 B4 = *(const LAS f32x4*)bp, C4 = *(const LAS f32x4*)(bp + 64); float xr = xp[0];
#pragma unroll 1
            for (int jh = 0; jh < 2; ++jh) {
                float ysel = 0.f;
                f32x4 dA4, dt4;
#pragma unroll
                for (int j = 0; j < 16; ++j) {
                    const int jj = jh * 16 + j;
                    if ((j & 3) == 0) { dA4 = *(const LAS f32x4*)(aux + jj); dt4 = *(const LAS f32x4*)(aux + TCH + jj); }
                    const f32x4 Bc = B4, Cc = C4; const float xc = xr;
                    if (j < 15 || jh == 0) { B4 = *(const LAS f32x4*)(bp + (jj + 1) * SSD_F); C4 = *(const LAS f32x4*)(bp + 64 + (jj + 1) * SSD_F); xr = xp[(jj + 1) * SSD_F]; }
                    const float dA = dA4[j & 3], xv = xc * dt4[j & 3];
                    float y = 0.f;
#pragma unroll
                    for (int e = 0; e < 4; ++e) { hs[e] = dA * hs[e] + xv * Bc[e]; y += Cc[e] * hs[e]; }
                    y = allreduce16(y);
                    ysel = (q == j) ? y : ysel;
                }
                const int row = ((const LAS int*)aux)[2 * TCH + jh * 16 + q];
                Y[(size_t)row * D + h * 64 + half * 32 + prow] = f2bf(ysel);
            }
        }
        if (c + 1 < NCHUNK) store(c + 1);
        __syncthreads();
    }
}

constexpr int ML_F = 64 + 64 + 32;
constexpr int ML_BUF = TCH * ML_F + 4 * TCH;
__device__ __forceinline__ void scan_mlstm(int wv, KP Pk, int layer, int unit, LAS char* lds) {
    asm volatile("" : "+s"(Pk));
    const CAS Params& P = *Pk;
    const int tid = ltid(wv), i_ = layer >> 1;
    const int seq = unit >> 2, quarter = unit & 3, b = seq >> 3, h = (seq >> 1) & 3, dir = seq & 1;
    LAS float* cw = (LAS float*)lds;
    LAS float* bufs = cw + 4 * 128;
    const bf16_t* Pb = (const bf16_t*)(P.ws + WS_P);
    bf16_t* Y = (bf16_t*)(P.ws + (dir ? WS_YB : WS_YF));
    for (int i = tid; i < 4 * 128; i += NT) {
        const int tap = i >> 7, lc = i & 127;
        const int ch = lc < 64 ? (h * 64 + lc) : (256 + h * 64 + lc - 64);
        cw[i] = tap < 3 ? P.ml_conv_w[(size_t)(i_ * 3 + tap) * 512 + ch] : P.ml_conv_b[i_ * 512 + ch];
    }
    const float ib = P.ml_i_bias[(i_ * 2 + dir) * 4 + h], fb = P.ml_f_bias[(i_ * 2 + dir) * 4 + h];
    int tj[2], tg_[2], tcol[2]; bool tv[2];
#pragma unroll
    for (int s = 0; s < 2; ++s) {
        const int task = tid + NT * s; tv[s] = task < 640; tj[s] = task / 20; tg_[s] = task % 20;
        const int g = tg_[s];
        tcol[s] = 1296 + (g < 8 ? (h * 64 + 8 * g) : g < 16 ? (256 + h * 64 + 8 * (g - 8)) : (512 + h * 128 + quarter * 32 + 8 * (g - 16)));
    }
    u32x4 rp[2], rc[2], rn[2]; float rgi = 0.f, rgf = 0.f; int rrow = 0;
    float mcarry = -1e30f;
    auto load = [&](int c) {
#pragma unroll
        for (int s = 0; s < 2; ++s) {
            rp[s] = rc[s] = rn[s] = (u32x4){0u, 0u, 0u, 0u};
            if (tv[s]) {
                const int row = scan_row(c * TCH + tj[s], b, dir, 0); int t, len; row_seg(row, t, len);
                const bf16_t* p = Pb + (size_t)row * LDP_EVEN + tcol[s];
                rc[s] = *(const u32x4*)p;
                if (tg_[s] < 16) { if (t > 0) rp[s] = *(const u32x4*)(p - LDP_EVEN); if (t < len - 1) rn[s] = *(const u32x4*)(p + LDP_EVEN); }
            }
        }
        if (tid < TCH) {
            rrow = scan_row(c * TCH + tid, b, dir, 0);
            const bf16_t* g = Pb + (size_t)rrow * LDP_EVEN + 1296 + 1536;
            rgi = bf2f(g[dir * 4 + h]); rgf = bf2f(g[8 + dir * 4 + h]);
        }
    };
    auto store = [&](int c) {
        LAS float* buf = bufs + (c & 1) * ML_BUF;
#pragma unroll
        for (int s = 0; s < 2; ++s) {
            if (tv[s]) {
                float fp[8], fc[8], fn[8], o[8]; unpack8(rp[s], fp); unpack8(rc[s], fc); unpack8(rn[s], fn);
                const int g = tg_[s], lc = g * 8;
                if (g < 16) {
                    const float scl = g < 8 ? 0.125f : 1.f;
#pragma unroll
                    for (int e = 0; e < 8; ++e) o[e] = scl * siluf_(cw[lc + e] * fp[e] + cw[128 + lc + e] * fc[e] + cw[256 + lc + e] * fn[e] + cw[384 + lc + e]);
                } else {
#pragma unroll
                    for (int e = 0; e < 8; ++e) o[e] = fc[e];
                }
                LAS float* dst = buf + tj[s] * ML_F + lc;
                *(LAS f32x4*)dst = (f32x4){o[0], o[1], o[2], o[3]}; *(LAS f32x4*)(dst + 4) = (f32x4){o[4], o[5], o[6], o[7]};
            }
        }
        if (tid < 64) {
            const int l = tid & 31;
            const float li = rgi + ib, lf = logsigmoidf_(rgf + fb);
            float F = lf;
#pragma unroll
            for (int o = 1; o < 32; o <<= 1) { const float t = __shfl_up(F, o, 32); if (l >= o) F += t; }
            float cm = li - F;
#pragma unroll
            for (int o = 1; o < 32; o <<= 1) { const float t = __shfl_up(cm, o, 32); if (l >= o) cm = fmaxf(cm, t); }
            const float m = F + fmaxf(mcarry, cm);
            float mprev = __shfl_up(m, 1, 32); if (l == 0) mprev = mcarry;
            const float sp = __expf(lf + mprev - m), sl = __expf(li - m), em = __expf(-m);
            if (tid < TCH) { buf[TCH * ML_F + tid] = sp; buf[TCH * ML_F + TCH + tid] = sl; buf[TCH * ML_F + 2 * TCH + tid] = em; ((LAS int*)buf)[TCH * ML_F + 3 * TCH + tid] = rrow; }
            mcarry = __shfl(m, 31, 32);
        }
    };
    const int col = tid >> 4, q = tid & 15;
    float Cs[4] = {0.f, 0.f, 0.f, 0.f}, ns[4] = {0.f, 0.f, 0.f, 0.f};
    __syncthreads();
    load(0); store(0); __syncthreads();
    for (int c = 0; c < NCHUNK; ++c) {
        if (c + 1 < NCHUNK) load(c + 1);
        LAS float* buf = bufs + (c & 1) * ML_BUF;
        {
            const LAS float* qp = buf + 4 * q;
            const LAS float* vp = buf + 128 + col;
            const LAS float* aux = buf + TCH * ML_F;
            f32x4 q4 = *(const LAS f32x4*)qp, k4 = *(const LAS f32x4*)(qp + 64); float vr = vp[0];
#pragma unroll 1
            for (int jh = 0; jh < 2; ++jh) {
                float nsel = 0.f, dsel = 1.f;
                f32x4 sp4, sl4;
#pragma unroll
                for (int j = 0; j < 16; ++j) {
                    const int jj = jh * 16 + j;
                    if ((j & 3) == 0) { sp4 = *(const LAS f32x4*)(aux + jj); sl4 = *(const LAS f32x4*)(aux + TCH + jj); }
                    const f32x4 qc = q4, kc = k4; const float vv = vr;
                    if (j < 15 || jh == 0) { q4 = *(const LAS f32x4*)(qp + (jj + 1) * ML_F); k4 = *(const LAS f32x4*)(qp + 64 + (jj + 1) * ML_F); vr = vp[(jj + 1) * ML_F]; }
                    const float sp = sp4[j & 3], sl = sl4[j & 3];
                    float num = 0.f, den = 0.f;
#pragma unroll
                    for (int e = 0; e < 4; ++e) { const float sk = sl * kc[e]; Cs[e] = sp * Cs[e] + sk * vv; ns[e] = sp * ns[e] + sk; num += qc[e] * Cs[e]; den += qc[e] * ns[e]; }
                    num = allreduce16(num); den = allreduce16(den);
                    nsel = (q == j) ? num : nsel; dsel = (q == j) ? den : dsel;
                }
                const float em = aux[2 * TCH + jh * 16 + q];
                const int row = ((const LAS int*)aux)[3 * TCH + jh * 16 + q];
                Y[(size_t)row * D + 512 + h * 128 + quarter * 32 + col] = f2bf(nsel * __builtin_amdgcn_rcpf(fmaxf(fabsf(dsel), em)));
            }
        }
        if (c + 1 < NCHUNK) store(c + 1);
        __syncthreads();
    }
}

constexpr int HG_F = 128 + 128 + 32;
constexpr int HG_BUF = TCH * HG_F + TCH;
__device__ __forceinline__ void scan_hgrn(int wv, KP Pk, int layer, int unit, LAS char* lds) {
    asm volatile("" : "+s"(Pk));
    const CAS Params& P = *Pk;
    const int tid = ltid(wv), i_ = layer >> 1;
    const int seq = unit >> 2, quarter = unit & 3, b = seq >> 3, h = (seq >> 1) & 3, dir = seq & 1;
    LAS float* cst = (LAS float*)lds;
    LAS float* bufs = cst + 256;
    const bf16_t* Pb = (const bf16_t*)(P.ws + WS_P);
    bf16_t* Y = (bf16_t*)(P.ws + (dir ? WS_YB : WS_YF));
    if (tid < 128) cst[tid] = ((const float*)(P.ws + WS_LB))[layer * 512 + h * 128 + tid];
    else if (tid < 256) cst[tid] = P.hg_f_bias[(size_t)(i_ * 2 + dir) * 512 + h * 128 + tid - 128];
    int tj[3], tg_[3], tcol[3]; bool tv[3];
#pragma unroll
    for (int s = 0; s < 3; ++s) {
        const int task = tid + NT * s; tv[s] = task < TCH * 36; tj[s] = task / 36; tg_[s] = task % 36;
        const int g = tg_[s];
        tcol[s] = g < 16 ? (512 + dir * 512 + h * 128 + 8 * g) : g < 32 ? (h * 128 + 8 * (g - 16)) : (1536 + h * 128 + quarter * 32 + 8 * (g - 32));
    }
    u32x4 rc[3]; int rrow = 0;
    auto load = [&](int c) {
#pragma unroll
        for (int s = 0; s < 3; ++s) {
            rc[s] = (u32x4){0u, 0u, 0u, 0u};
            if (tv[s]) { const int row = scan_row(c * TCH + tj[s], b, dir, 1); rc[s] = *(const u32x4*)(Pb + (size_t)row * LDP_ODD + tcol[s]); }
        }
        if (tid < TCH) rrow = scan_row(c * TCH + tid, b, dir, 1);
    };
    auto store = [&](int c) {
        LAS float* buf = bufs + (c & 1) * HG_BUF;
#pragma unroll
        for (int s = 0; s < 3; ++s) {
            if (tv[s]) {
                float fc[8], o[8]; unpack8(rc[s], fc);
                const int g = tg_[s], lc = g * 8;
                if (g < 16) {
#pragma unroll
                    for (int e = 0; e < 8; ++e) { const float lbv = cst[lc + e]; o[e] = lbv + (1.f - lbv) * sigmoidf_(fc[e] + cst[128 + lc + e]); }
                } else if (g < 32) {
#pragma unroll
                    for (int e = 0; e < 8; ++e) o[e] = siluf_(fc[e]);
                } else {
#pragma unroll
                    for (int e = 0; e < 8; ++e) o[e] = fc[e];
                }
                LAS float* dst = buf + tj[s] * HG_F + lc;
                *(LAS f32x4*)dst = (f32x4){o[0], o[1], o[2], o[3]}; *(LAS f32x4*)(dst + 4) = (f32x4){o[4], o[5], o[6], o[7]};
            }
        }
        if (tid < TCH) ((LAS int*)buf)[TCH * HG_F + tid] = rrow;
    };
    const int col = tid >> 4, q = tid & 15;
    float S[8];
#pragma unroll
    for (int e = 0; e < 8; ++e) S[e] = 0.f;
    __syncthreads();
    load(0); store(0); __syncthreads();
    for (int c = 0; c < NCHUNK; ++c) {
        if (c + 1 < NCHUNK) load(c + 1);
        LAS float* buf = bufs + (c & 1) * HG_BUF;
        {
            const LAS float* fp = buf + 4 * q;
            const LAS float* vp = buf + 256 + col;
            f32x4 f0 = *(const LAS f32x4*)fp, f1 = *(const LAS f32x4*)(fp + 64), q0 = *(const LAS f32x4*)(fp + 128), q1 = *(const LAS f32x4*)(fp + 192); float vr = vp[0];
#pragma unroll 1
            for (int jh = 0; jh < 2; ++jh) {
                float ysel = 0.f;
#pragma unroll
                for (int j = 0; j < 16; ++j) {
                    const int jj = jh * 16 + j;
                    const f32x4 f0c = f0, f1c = f1, q0c = q0, q1c = q1; const float vv = vr;
                    if (j < 15 || jh == 0) {
                        const LAS float* np = fp + (jj + 1) * HG_F;
                        f0 = *(const LAS f32x4*)np; f1 = *(const LAS f32x4*)(np + 64); q0 = *(const LAS f32x4*)(np + 128); q1 = *(const LAS f32x4*)(np + 192); vr = vp[(jj + 1) * HG_F];
                    }
                    float o = 0.f;
#pragma unroll
                    for (int e = 0; e < 4; ++e) { S[e] = f0c[e] * (S[e] - vv) + vv; o += q0c[e] * S[e]; S[4 + e] = f1c[e] * (S[4 + e] - vv) + vv; o += q1c[e] * S[4 + e]; }
                    o = allreduce16(o);
                    ysel = (q == j) ? o : ysel;
                }
                const int row = ((const LAS int*)buf)[TCH * HG_F + jh * 16 + q];
                Y[(size_t)row * D + h * 128 + quarter * 32 + col] = f2bf(ysel);
            }
        }
        if (c + 1 < NCHUNK) store(c + 1);
        __syncthreads();
    }
}

constexpr int RW_F = 5 * 64 + 32;
constexpr int RW_BUF = TCH * RW_F + TCH;
__device__ __forceinline__ void scan_rwkv(int wv, KP Pk, int layer, int unit, LAS char* lds) {
    asm volatile("" : "+s"(Pk));
    const CAS Params& P = *Pk;
    const int tid = ltid(wv);
    const int seq = unit >> 1, half = unit & 1, b = seq >> 4, h = (seq >> 1) & 7, dir = seq & 1;
    LAS float* bufs = (LAS float*)lds;
    bf16_t* Y = (bf16_t*)(P.ws + (dir ? WS_YB : WS_YF));
    const float* dec = (const float*)(P.ws + WS_RWDEC) + (size_t)dir * NROWS * 512;
    int tj[4], tg_[4]; bool tv[4]; const unsigned char* tbase[4]; int tlds[4];
#pragma unroll
    for (int s = 0; s < 4; ++s) {
        const int task = tid + NT * s; tv[s] = task < TCH * 52; tj[s] = task / 52; tg_[s] = task % 52;
        const int g = tg_[s];
        if (g < 8)       { tbase[s] = P.ws + WS_RWR  + (size_t)(h * 64 + 8 * g) * 2;              tlds[s] = 256 + 8 * g; }
        else if (g < 16) { tbase[s] = P.ws + WS_RWK  + (size_t)(h * 64 + 8 * (g - 8)) * 2;        tlds[s] = 192 + 8 * (g - 8); }
        else if (g < 24) { tbase[s] = P.ws + WS_RWKK + (size_t)(h * 64 + 8 * (g - 16)) * 2;       tlds[s] = 64 + 8 * (g - 16); }
        else if (g < 32) { tbase[s] = P.ws + WS_RWB  + (size_t)(h * 64 + 8 * (g - 24)) * 2;       tlds[s] = 128 + 8 * (g - 24); }
        else if (g < 36) { tbase[s] = P.ws + WS_RWV  + (size_t)(h * 64 + half * 32 + 8 * (g - 32)) * 2; tlds[s] = 320 + 8 * (g - 32); }
        else             { tbase[s] = (const unsigned char*)(dec + h * 64 + 4 * (g - 36));        tlds[s] = 4 * (g - 36); }
    }
    u32x4 rc[4]; int rrow = 0;
    auto load = [&](int c) {
#pragma unroll
        for (int s = 0; s < 4; ++s) {
            rc[s] = (u32x4){0u, 0u, 0u, 0u};
            if (tv[s]) { const int row = scan_row(c * TCH + tj[s], b, dir, 1); rc[s] = *(const u32x4*)(tbase[s] + (size_t)row * (tg_[s] < 36 ? 1024 : 2048)); }
        }
        if (tid < TCH) rrow = scan_row(c * TCH + tid, b, dir, 1);
    };
    auto store = [&](int c) {
        LAS float* buf = bufs + (c & 1) * RW_BUF;
#pragma unroll
        for (int s = 0; s < 4; ++s) {
            if (tv[s]) {
                LAS float* dst = buf + tj[s] * RW_F + tlds[s];
                const int g = tg_[s];
                if (g >= 36) { *(LAS u32x4*)dst = rc[s]; }
                else {
                    float f[8]; unpack8(rc[s], f);
                    const float sg = (g >= 16 && g < 24) ? -1.f : 1.f;
                    *(LAS f32x4*)dst = (f32x4){sg * f[0], sg * f[1], sg * f[2], sg * f[3]}; *(LAS f32x4*)(dst + 4) = (f32x4){sg * f[4], sg * f[5], sg * f[6], sg * f[7]};
                }
            }
        }
        if (tid < TCH) ((LAS int*)buf)[TCH * RW_F + tid] = rrow;
    };
    const int vrow = tid >> 4, q = tid & 15;
    float S[4] = {0.f, 0.f, 0.f, 0.f};
    load(0); store(0); __syncthreads();
    for (int c = 0; c < NCHUNK; ++c) {
        if (c + 1 < NCHUNK) load(c + 1);
        LAS float* buf = bufs + (c & 1) * RW_BUF;
        {
            const LAS float* wp = buf + 4 * q;
            const LAS float* vp = buf + 320 + vrow;
            f32x4 w4 = *(const LAS f32x4*)wp, a4 = *(const LAS f32x4*)(wp + 64), b4 = *(const LAS f32x4*)(wp + 128), k4 = *(const LAS f32x4*)(wp + 192), r4 = *(const LAS f32x4*)(wp + 256); float vr = vp[0];
#pragma unroll 1
            for (int jh = 0; jh < 2; ++jh) {
                float ysel = 0.f;
#pragma unroll
                for (int j = 0; j < 16; ++j) {
                    const int jj = jh * 16 + j;
                    const f32x4 wc = w4, ac = a4, bc = b4, kc = k4, rc = r4; const float vv = vr;
                    if (j < 15 || jh == 0) {
                        const LAS float* np = wp + (jj + 1) * RW_F;
                        w4 = *(const LAS f32x4*)np; a4 = *(const LAS f32x4*)(np + 64); b4 = *(const LAS f32x4*)(np + 128); k4 = *(const LAS f32x4*)(np + 192); r4 = *(const LAS f32x4*)(np + 256); vr = vp[(jj + 1) * RW_F];
                    }
                    float sa = S[0] * ac[0] + S[1] * ac[1] + S[2] * ac[2] + S[3] * ac[3];
                    sa = allreduce16(sa);
                    float y = 0.f;
#pragma unroll
                    for (int e = 0; e < 4; ++e) { S[e] = S[e] * wc[e] + (sa * bc[e] + vv * kc[e]); y += S[e] * rc[e]; }
                    y = allreduce16(y);
                    ysel = (q == j) ? y : ysel;
                }
                const int row = ((const LAS int*)buf)[TCH * RW_F + jh * 16 + q];
                Y[(size_t)row * D + 512 + h * 64 + half * 32 + vrow] = f2bf(ysel);
            }
        }
        if (c + 1 < NCHUNK) store(c + 1);
        __syncthreads();
    }
}

constexpr size_t WS_EXBC = WS_RWR;
constexpr size_t WS_EQK = WS_EXBC + (size_t)NROWS * 768 * 2;
constexpr size_t WS_EGT = WS_EQK + (size_t)NROWS * 512 * 2;
static_assert(WS_EGT + (size_t)NROWS * 32 * 4 <= WS_LA, "even-layer prepare buffers must fit in the RWKV region");

__device__ __forceinline__ void phase_prep_even(int wv, KP Pk, int layer) {
    asm volatile("" : "+s"(Pk));
    const CAS Params& P = *Pk;
    const int tid = ltid(wv), lane = tid & 63, wid = tid >> 6, i_ = layer >> 1;
    const bf16_t* Pb = (const bf16_t*)(P.ws + WS_P);
    bf16_t* XBC = (bf16_t*)(P.ws + WS_EXBC); bf16_t* QK = (bf16_t*)(P.ws + WS_EQK); float* GT = (float*)(P.ws + WS_EGT);
    float cw0[4][8], cw1[4][8], cwq[4][8];
#pragma unroll
    for (int e = 0; e < 8; ++e) {
#pragma unroll
        for (int t = 0; t < 3; ++t) {
            cw0[t][e] = P.ssd_conv_w[(size_t)(i_ * 3 + t) * 768 + 8 * lane + e];
            cw1[t][e] = P.ssd_conv_w[(size_t)(i_ * 3 + t) * 768 + 512 + 8 * (lane & 31) + e];
            cwq[t][e] = P.ml_conv_w[(size_t)(i_ * 3 + t) * 512 + 8 * lane + e];
        }
        cw0[3][e] = P.ssd_conv_b[i_ * 768 + 8 * lane + e]; cw1[3][e] = P.ssd_conv_b[i_ * 768 + 512 + 8 * (lane & 31) + e]; cwq[3][e] = P.ml_conv_b[i_ * 512 + 8 * lane + e];
    }
    float gbias = 0.f;
    if (lane < 16) gbias = P.ssd_dt_bias[i_ * 16 + lane]; else if (lane < 24) gbias = P.ml_i_bias[i_ * 8 + lane - 16]; else if (lane < 32) gbias = P.ml_f_bias[i_ * 8 + lane - 24];
    const float qscl = lane < 32 ? 0.125f : 1.f;
    for (int r = blockIdx.x * 8 + wid; r < NROWS; r += gridDim.x * 8) {
        int t, len; row_seg(r, t, len);
        const bf16_t* pr = Pb + (size_t)r * LDP_EVEN;
        const bool hp = t > 0, hn = t < len - 1;
        const u32x4 zero = (u32x4){0u, 0u, 0u, 0u};
        float fc[8], fp[8], fn[8], o[8];
        {
            const int col = 512 + 8 * lane;
            unpack8(*(const u32x4*)(pr + col), fc); unpack8(hp ? *(const u32x4*)(pr - LDP_EVEN + col) : zero, fp); unpack8(hn ? *(const u32x4*)(pr + LDP_EVEN + col) : zero, fn);
#pragma unroll
            for (int e = 0; e < 8; ++e) o[e] = siluf_(cw0[0][e] * fp[e] + cw0[1][e] * fc[e] + cw0[2][e] * fn[e] + cw0[3][e]);
            *(u32x4*)(XBC + (size_t)r * 768 + 8 * lane) = pack8(o);
        }
        if (lane < 32) {
            const int col = 1024 + 8 * lane;
            unpack8(*(const u32x4*)(pr + col), fc); unpack8(hp ? *(const u32x4*)(pr - LDP_EVEN + col) : zero, fp); unpack8(hn ? *(const u32x4*)(pr + LDP_EVEN + col) : zero, fn);
#pragma unroll
            for (int e = 0; e < 8; ++e) o[e] = siluf_(cw1[0][e] * fp[e] + cw1[1][e] * fc[e] + cw1[2][e] * fn[e] + cw1[3][e]);
            *(u32x4*)(XBC + (size_t)r * 768 + 512 + 8 * lane) = pack8(o);
        }
        {
            const int col = 1296 + 8 * lane;
            unpack8(*(const u32x4*)(pr + col), fc); unpack8(hp ? *(const u32x4*)(pr - LDP_EVEN + col) : zero, fp); unpack8(hn ? *(const u32x4*)(pr + LDP_EVEN + col) : zero, fn);
#pragma unroll
            for (int e = 0; e < 8; ++e) o[e] = qscl * siluf_(cwq[0][e] * fp[e] + cwq[1][e] * fc[e] + cwq[2][e] * fn[e] + cwq[3][e]);
            *(u32x4*)(QK + (size_t)r * 512 + 8 * lane) = pack8(o);
        }
        if (lane < 32) {
            const int col = lane < 16 ? 1280 + lane : 2832 + (lane - 16);
            const float x = bf2f(pr[col]) + gbias;
            GT[(size_t)r * 32 + lane] = lane < 16 ? softplusf_(x) : lane < 24 ? x : logsigmoidf_(x);
        }
    }
}

constexpr int CL = 64, NCH64 = NSTEPS / CL, LDT = 72, LDTB = LDT * 2;
__device__ __forceinline__ bf16x8 ldfrag(const LAS char* tile, int ldb, int row0, int k0, int lane) {
    return *(const LAS bf16x8*)(tile + (row0 + (lane & 15)) * ldb + (k0 + 8 * (lane >> 4)) * 2);
}
__device__ __forceinline__ void st4bf(LAS char* p, const f32x4& v) { u32x2 o; o.x = pk2(v[0], v[1]); o.y = pk2(v[2], v[3]); *(LAS u32x2*)p = o; }

constexpr int SS_BT = 0, SS_CT = SS_BT + 64 * LDTB, SS_BDT = SS_CT + 64 * LDTB, SS_XT = SS_BDT + 64 * LDTB, SS_CUM = SS_XT + 32 * LDTB, SS_DTV = SS_CUM + 256, SS_ROWS = SS_DTV + 256, SS_STG = SS_ROWS + 256;
constexpr int SS_M = 2 * SS_STG, SS_HB = SS_M + 64 * LDTB, SS_END = SS_HB + 32 * LDTB;
static_assert(SS_END <= LDS_BYTES - 16, "SSD LDS map");
__device__ __forceinline__ void scan_ssd_c(int wv, KP Pk, int layer, int unit, LAS char* lds) {
    asm volatile("" : "+s"(Pk));
    const CAS Params& P = *Pk;
    const int tid = ltid(wv), lane = tid & 63, wid = tid >> 6, q = lane >> 4, r16 = lane & 15, i_ = layer >> 1;
    const int seq = unit >> 1, half = unit & 1, b = seq >> 4, h = (seq >> 1) & 7, dir = seq & 1, grp = h >> 2;
    const bf16_t* XBC = (const bf16_t*)(P.ws + WS_EXBC);
    const float* GT = (const float*)(P.ws + WS_EGT);
    bf16_t* Y = (bf16_t*)(P.ws + (dir ? WS_YB : WS_YF));
    const float aco = -__expf(P.ssd_a_log[(i_ * 2 + dir) * 8 + h]);
    int tj[3], tg_[3], tcol[3]; bool tv[3];
#pragma unroll
    for (int s = 0; s < 3; ++s) {
        const int task = tid + NT * s; tv[s] = task < CL * 20; tj[s] = task / 20; tg_[s] = task % 20;
        const int g = tg_[s];
        tcol[s] = g < 4 ? (h * 64 + half * 32 + 8 * g) : g < 12 ? (512 + grp * 64 + 8 * (g - 4)) : (640 + grp * 64 + 8 * (g - 12));
    }
    u32x4 rc[3]; float rdt = 0.f; int rrow = 0;
    auto load = [&](int c) {
#pragma unroll
        for (int s = 0; s < 3; ++s) {
            rc[s] = (u32x4){0u, 0u, 0u, 0u};
            if (tv[s]) { const int row = scan_row(c * CL + tj[s], b, dir, 0); rc[s] = *(const u32x4*)(XBC + (size_t)row * 768 + tcol[s]); }
        }
        if (tid < CL) { rrow = scan_row(c * CL + tid, b, dir, 0); rdt = GT[(size_t)rrow * 32 + dir * 8 + h]; }
    };
    auto store1 = [&](int c) {
        if (tid < CL) {
            LAS char* stg = lds + (c & 1) * SS_STG;
            float cum = rdt * aco;
#pragma unroll
            for (int o = 1; o < 64; o <<= 1) { const float t = __shfl_up(cum, o); if (lane >= o) cum += t; }
            ((LAS float*)(stg + SS_CUM))[tid] = cum; ((LAS float*)(stg + SS_DTV))[tid] = rdt; ((LAS int*)(stg + SS_ROWS))[tid] = rrow;
        }
    };
    auto store2 = [&](int c) {
        LAS char* stg = lds + (c & 1) * SS_STG;
        const LAS float* cum = (const LAS float*)(stg + SS_CUM);
        const float cumL = cum[CL - 1];
#pragma unroll
        for (int s = 0; s < 3; ++s) {
            if (tv[s]) {
                float f[8]; unpack8(rc[s], f);
                const int j = tj[s], g = tg_[s];
                if (g < 4) {
                    const float dt = ((const LAS float*)(stg + SS_DTV))[j];
#pragma unroll
                    for (int e = 0; e < 8; ++e) *(LAS bf16_t*)(stg + SS_XT + (8 * g + e) * LDTB + j * 2) = f2bf(f[e] * dt);
                } else if (g < 12) {
                    const int n0 = 8 * (g - 4);
                    *(LAS u32x4*)(stg + SS_BT + j * LDTB + n0 * 2) = rc[s];
                    const float sc = __expf(cumL - cum[j]);
#pragma unroll
                    for (int e = 0; e < 8; ++e) *(LAS bf16_t*)(stg + SS_BDT + (n0 + e) * LDTB + j * 2) = f2bf(f[e] * sc);
                } else {
                    *(LAS u32x4*)(stg + SS_CT + j * LDTB + 8 * (g - 12) * 2) = rc[s];
                }
            }
        }
    };
    for (int i = tid; i < 32 * LDTB / 4; i += NT) ((LAS unsigned*)(lds + SS_HB))[i] = 0u;
    f32x4 hacc = (f32x4){0.f, 0.f, 0.f, 0.f};
    load(0); store1(0); __syncthreads(); store2(0); __syncthreads();
    for (int c = 0; c < NCH64; ++c) {
        if (c + 1 < NCH64) load(c + 1);
        LAS char* stg = lds + (c & 1) * SS_STG;
        const LAS float* cum = (const LAS float*)(stg + SS_CUM);
        {
            const int lt = wid >> 1;
#pragma unroll
            for (int u = 0; u < 2; ++u) {
                const int st = (wid & 1) * 2 + u;
                f32x4 acc = (f32x4){0.f, 0.f, 0.f, 0.f};
                if (st <= lt) {
#pragma unroll
                    for (int k0 = 0; k0 < 64; k0 += 32) acc = __builtin_amdgcn_mfma_f32_16x16x32_bf16(ldfrag(stg + SS_BT, LDTB, st * 16, k0, lane), ldfrag(stg + SS_CT, LDTB, lt * 16, k0, lane), acc, 0, 0, 0);
                    const int l = lt * 16 + r16, s0 = st * 16 + 4 * q;
                    const float cl = cum[l]; const f32x4 cs = *(const LAS f32x4*)(cum + s0);
#pragma unroll
                    for (int j = 0; j < 4; ++j) acc[j] = (s0 + j <= l) ? acc[j] * __expf(cl - cs[j]) : 0.f;
                }
                st4bf(lds + SS_M + (lt * 16 + r16) * LDTB + (st * 16 + 4 * q) * 2, acc);
            }
        }
        __syncthreads();
        {
            const int lt = wid >> 1, pt = wid & 1;
            f32x4 ya = (f32x4){0.f, 0.f, 0.f, 0.f}, oa = (f32x4){0.f, 0.f, 0.f, 0.f};
#pragma unroll
            for (int k0 = 0; k0 < 64; k0 += 32) {
                ya = __builtin_amdgcn_mfma_f32_16x16x32_bf16(ldfrag(stg + SS_XT, LDTB, pt * 16, k0, lane), ldfrag(lds + SS_M, LDTB, lt * 16, k0, lane), ya, 0, 0, 0);
                oa = __builtin_amdgcn_mfma_f32_16x16x32_bf16(ldfrag(lds + SS_HB, LDTB, pt * 16, k0, lane), ldfrag(stg + SS_CT, LDTB, lt * 16, k0, lane), oa, 0, 0, 0);
            }
            const int l = lt * 16 + r16;
            const float el = __expf(cum[l]);
            const int row = ((const LAS int*)(stg + SS_ROWS))[l];
            u32x2 o; o.x = pk2(ya[0] + el * oa[0], ya[1] + el * oa[1]); o.y = pk2(ya[2] + el * oa[2], ya[3] + el * oa[3]);
            *(u32x2*)(Y + (size_t)row * D + h * 64 + half * 32 + pt * 16 + 4 * q) = o;
            const int ptile = wid >> 2, ntile = wid & 3;
            f32x4 sa = (f32x4){0.f, 0.f, 0.f, 0.f};
#pragma unroll
            for (int k0 = 0; k0 < 64; k0 += 32) sa = __builtin_amdgcn_mfma_f32_16x16x32_bf16(ldfrag(stg + SS_BDT, LDTB, ntile * 16, k0, lane), ldfrag(stg + SS_XT, LDTB, ptile * 16, k0, lane), sa, 0, 0, 0);
            const float dtot = __expf(cum[CL - 1]);
#pragma unroll
            for (int j = 0; j < 4; ++j) hacc[j] = hacc[j] * dtot + sa[j];
        }
        __syncthreads();
        st4bf(lds + SS_HB + ((wid >> 2) * 16 + r16) * LDTB + ((wid & 3) * 16 + 4 * q) * 2, hacc);
        if (c + 1 < NCH64) { store1(c + 1); __syncthreads(); store2(c + 1); }
        __syncthreads();
    }
}

constexpr int MS_QT = 0, MS_KT = MS_QT + 64 * LDTB, MS_KET = MS_KT + 64 * LDTB, MS_VT = MS_KET + 64 * LDTB, MS_SC = MS_VT + 32 * LDTB;
constexpr int MS_STG = MS_SC + 8 * 256;
constexpr int MS_W = 2 * MS_STG, MS_CB = MS_W + 64 * LDTB, MS_ONE = MS_CB + 32 * LDTB, MS_NV = MS_ONE + 16 * LDTB, MS_QN = MS_NV + 256, MS_END = MS_QN + 256;
static_assert(MS_END <= LDS_BYTES - 16, "mLSTM LDS map");
__device__ __forceinline__ void scan_mlstm_c(int wv, KP Pk, int layer, int unit, LAS char* lds) {
    asm volatile("" : "+s"(Pk));
    const CAS Params& P = *Pk;
    const int tid = ltid(wv), lane = tid & 63, wid = tid >> 6, q = lane >> 4, r16 = lane & 15;
    const int seq = unit >> 2, quarter = unit & 3, b = seq >> 3, h = (seq >> 1) & 3, dir = seq & 1;
    const bf16_t* QK = (const bf16_t*)(P.ws + WS_EQK);
    const bf16_t* Pb = (const bf16_t*)(P.ws + WS_P);
    const float* GT = (const float*)(P.ws + WS_EGT);
    bf16_t* Y = (bf16_t*)(P.ws + (dir ? WS_YB : WS_YF));
    int tj[3], tg_[3]; bool tv[3];
#pragma unroll
    for (int s = 0; s < 3; ++s) { const int task = tid + NT * s; tv[s] = task < CL * 20; tj[s] = task / 20; tg_[s] = task % 20; }
    u32x4 rc[3]; float rli = 0.f, rlf = 0.f; int rrow = 0;
    float mprev = -1e30f;
    auto load = [&](int c) {
#pragma unroll
        for (int s = 0; s < 3; ++s) {
            rc[s] = (u32x4){0u, 0u, 0u, 0u};
            if (tv[s]) {
                const int row = scan_row(c * CL + tj[s], b, dir, 0); const int g = tg_[s];
                rc[s] = g < 16 ? *(const u32x4*)(QK + (size_t)row * 512 + (g < 8 ? h * 64 + 8 * g : 256 + h * 64 + 8 * (g - 8)))
                               : *(const u32x4*)(Pb + (size_t)row * LDP_EVEN + 1808 + h * 128 + quarter * 32 + 8 * (g - 16));
            }
        }
        if (tid < CL) { rrow = scan_row(c * CL + tid, b, dir, 0); rli = GT[(size_t)rrow * 32 + 16 + dir * 4 + h]; rlf = GT[(size_t)rrow * 32 + 24 + dir * 4 + h]; }
    };
    auto store1 = [&](int c) {
        if (tid < CL) {
            LAS float* sc = (LAS float*)(lds + (c & 1) * MS_STG + MS_SC);
            float fcum = rlf;
#pragma unroll
            for (int o = 1; o < 64; o <<= 1) { const float t = __shfl_up(fcum, o); if (lane >= o) fcum += t; }
            const float ftot = __shfl(fcum, 63);
            const float g = rli - fcum;
            float pm = g;
#pragma unroll
            for (int o = 1; o < 64; o <<= 1) { const float t = __shfl_up(pm, o); if (lane >= o) pm = fmaxf(pm, t); }
            const float wend = ftot + g;
            float mloc = wend;
#pragma unroll
            for (int o = 1; o < 64; o <<= 1) mloc = fmaxf(mloc, __shfl_xor(mloc, o));
            const float eend = __expf(wend - mloc);
            const float linter = fcum + mprev;
            const float mrow = fmaxf(fcum + pm, linter);
            sc[0 * 64 + tid] = fcum - mrow; sc[1 * 64 + tid] = g; sc[2 * 64 + tid] = __expf(linter - mrow); sc[3 * 64 + tid] = __expf(-mrow); sc[4 * 64 + tid] = eend;
            ((LAS int*)sc)[5 * 64 + tid] = rrow;
            const float mnew = fmaxf(ftot + mprev, mloc);
            if (tid == 0) { sc[6 * 64 + 0] = __expf(ftot + mprev - mnew); sc[6 * 64 + 1] = __expf(mloc - mnew); }
            mprev = mnew;
        }
    };
    auto store2 = [&](int c) {
        LAS char* stg = lds + (c & 1) * MS_STG;
        const LAS float* sc = (const LAS float*)(stg + MS_SC);
#pragma unroll
        for (int s = 0; s < 3; ++s) {
            if (tv[s]) {
                float f[8]; unpack8(rc[s], f);
                const int j = tj[s], g = tg_[s];
                if (g < 8) { *(LAS u32x4*)(stg + MS_QT + j * LDTB + 8 * g * 2) = rc[s]; }
                else if (g < 16) {
                    const int k0 = 8 * (g - 8);
                    *(LAS u32x4*)(stg + MS_KT + j * LDTB + k0 * 2) = rc[s];
                    const float ee = sc[4 * 64 + j];
#pragma unroll
                    for (int e = 0; e < 8; ++e) *(LAS bf16_t*)(stg + MS_KET + (k0 + e) * LDTB + j * 2) = f2bf(f[e] * ee);
                } else {
                    const int v0 = 8 * (g - 16);
#pragma unroll
                    for (int e = 0; e < 8; ++e) { const unsigned wv = rc[s][e >> 1]; *(LAS bf16_t*)(stg + MS_VT + (v0 + e) * LDTB + j * 2) = (bf16_t)((e & 1) ? (wv >> 16) : (wv & 0xffffu)); }
                }
            }
        }
    };
    for (int i = tid; i < 32 * LDTB / 4; i += NT) ((LAS unsigned*)(lds + MS_CB))[i] = 0u;
    for (int i = tid; i < 16 * LDTB / 4; i += NT) ((LAS unsigned*)(lds + MS_ONE))[i] = 0x3f803f80u;
    if (tid < 64) ((LAS float*)(lds + MS_NV))[tid] = 0.f;
    f32x4 cacc = (f32x4){0.f, 0.f, 0.f, 0.f};
    load(0); store1(0); __syncthreads(); store2(0); __syncthreads();
    for (int c = 0; c < NCH64; ++c) {
        if (c + 1 < NCH64) load(c + 1);
        LAS char* stg = lds + (c & 1) * MS_STG;
        const LAS float* sc = (const LAS float*)(stg + MS_SC);
        LAS float* nv = (LAS float*)(lds + MS_NV);
        LAS float* qn = (LAS float*)(lds + MS_QN);
        {
            const int lt = wid >> 1;
#pragma unroll
            for (int u = 0; u < 2; ++u) {
                const int st = (wid & 1) * 2 + u;
                f32x4 acc = (f32x4){0.f, 0.f, 0.f, 0.f};
                if (st <= lt) {
#pragma unroll
                    for (int k0 = 0; k0 < 64; k0 += 32) acc = __builtin_amdgcn_mfma_f32_16x16x32_bf16(ldfrag(stg + MS_KT, LDTB, st * 16, k0, lane), ldfrag(stg + MS_QT, LDTB, lt * 16, k0, lane), acc, 0, 0, 0);
                    const int l = lt * 16 + r16, s0 = st * 16 + 4 * q;
                    const float rt = sc[l]; const f32x4 gs = *(const LAS f32x4*)(sc + 64 + s0);
#pragma unroll
                    for (int j = 0; j < 4; ++j) acc[j] = (s0 + j <= l) ? acc[j] * __expf(rt + gs[j]) : 0.f;
                }
                st4bf(lds + MS_W + (lt * 16 + r16) * LDTB + (st * 16 + 4 * q) * 2, acc);
            }
            if (wid == 0) {
                float a = 0.f;
#pragma unroll
                for (int k0 = 0; k0 < 64; k0 += 8) {
                    const u32x4 tq = *(const LAS u32x4*)(stg + MS_QT + lane * LDTB + k0 * 2); float f[8]; unpack8(tq, f);
#pragma unroll
                    for (int e = 0; e < 8; ++e) a += f[e] * nv[k0 + e];
                }
                qn[lane] = a;
            }
        }
        __syncthreads();
        {
            const int lt = wid >> 1, vt = wid & 1;
            f32x4 na = (f32x4){0.f, 0.f, 0.f, 0.f}, ca = (f32x4){0.f, 0.f, 0.f, 0.f}, da = (f32x4){0.f, 0.f, 0.f, 0.f};
#pragma unroll
            for (int k0 = 0; k0 < 64; k0 += 32) {
                const bf16x8 wf = ldfrag(lds + MS_W, LDTB, lt * 16, k0, lane);
                na = __builtin_amdgcn_mfma_f32_16x16x32_bf16(ldfrag(stg + MS_VT, LDTB, vt * 16, k0, lane), wf, na, 0, 0, 0);
                da = __builtin_amdgcn_mfma_f32_16x16x32_bf16(ldfrag(lds + MS_ONE, LDTB, 0, k0, lane), wf, da, 0, 0, 0);
                ca = __builtin_amdgcn_mfma_f32_16x16x32_bf16(ldfrag(lds + MS_CB, LDTB, vt * 16, k0, lane), ldfrag(stg + MS_QT, LDTB, lt * 16, k0, lane), ca, 0, 0, 0);
            }
            const int l = lt * 16 + r16;
            const float inter = sc[2 * 64 + l], emr = sc[3 * 64 + l];
            const float den = da[0] + inter * qn[l];
            const float inv = __builtin_amdgcn_rcpf(fmaxf(fabsf(den), emr));
            const int row = ((const LAS int*)sc)[5 * 64 + l];
            u32x2 o; o.x = pk2((na[0] + inter * ca[0]) * inv, (na[1] + inter * ca[1]) * inv); o.y = pk2((na[2] + inter * ca[2]) * inv, (na[3] + inter * ca[3]) * inv);
            *(u32x2*)(Y + (size_t)row * D + 512 + h * 128 + quarter * 32 + vt * 16 + 4 * q) = o;
            const int vtile = wid >> 2, ktile = wid & 3;
            f32x4 sa = (f32x4){0.f, 0.f, 0.f, 0.f};
#pragma unroll
            for (int k0 = 0; k0 < 64; k0 += 32) sa = __builtin_amdgcn_mfma_f32_16x16x32_bf16(ldfrag(stg + MS_KET, LDTB, ktile * 16, k0, lane), ldfrag(stg + MS_VT, LDTB, vtile * 16, k0, lane), sa, 0, 0, 0);
            const float sp = sc[6 * 64 + 0], sl = sc[6 * 64 + 1];
#pragma unroll
            for (int j = 0; j < 4; ++j) cacc[j] = cacc[j] * sp + sl * sa[j];
        }
        __syncthreads();
        st4bf(lds + MS_CB + ((wid >> 2) * 16 + r16) * LDTB + ((wid & 3) * 16 + 4 * q) * 2, cacc);
        if (wid == 1) {
            float a = 0.f;
            for (int s = 0; s < CL; ++s) a += sc[4 * 64 + s] * bf2f(*(const LAS bf16_t*)(stg + MS_KT + s * LDTB + lane * 2));
            nv[lane] = nv[lane] * sc[6 * 64 + 0] + sc[6 * 64 + 1] * a;
        }
        if (c + 1 < NCH64) { store1(c + 1); __syncthreads(); store2(c + 1); }
        __syncthreads();
    }
}

constexpr size_t WS_XSS = WS_EGT + al256((size_t)NROWS * 32 * 4);
constexpr size_t XSS_BYTES = (size_t)64 * NCH64 * 64 * 64 * 2;
constexpr size_t WS_XSD = WS_XSS + XSS_BYTES;
constexpr size_t WS_XMC = WS_XSD + al256((size_t)64 * NCH64 * 4);
constexpr size_t XMC_BYTES = (size_t)32 * NCH64 * 128 * 64 * 2;
constexpr size_t WS_XMN = WS_XMC + XMC_BYTES;
constexpr size_t WS_XMS = WS_XMN + (size_t)32 * NCH64 * 64 * 4;
constexpr size_t WS_XMT = WS_XMS + al256((size_t)32 * NCH64 * 4 * 4);
constexpr size_t WS_XEND = WS_XMT + (size_t)32 * NCH64 * 3 * 64 * 4;
static_assert(WS_XEND <= WS_END, "even-layer chunk-state buffers must fit in the RWKV region");
constexpr int NSSD_ITEMS = 64 * NCH64, NML_ITEMS = 32 * NCH64;

__device__ __forceinline__ float wave_cumsum(float v, int lane) {
#pragma unroll
    for (int o = 1; o < 64; o <<= 1) { const float t = __shfl_up(v, o); if (lane >= o) v += t; }
    return v;
}
__device__ __forceinline__ float wave_cummax(float v, int lane) {
#pragma unroll
    for (int o = 1; o < 64; o <<= 1) { const float t = __shfl_up(v, o); if (lane >= o) v = fmaxf(v, t); }
    return v;
}
__device__ __forceinline__ float wave_max(float v) {
#pragma unroll
    for (int o = 1; o < 64; o <<= 1) v = fmaxf(v, __shfl_xor(v, o));
    return v;
}

constexpr int X1S_BDT = 0, X1S_XT = X1S_BDT + 64 * LDTB, X1S_CUM = X1S_XT + 64 * LDTB, X1S_DTV = X1S_CUM + 256, X1S_END = X1S_DTV + 256;
constexpr int X1M_KET = 0, X1M_VT = X1M_KET + 64 * LDTB, X1M_ONE = X1M_VT + 128 * LDTB, X1M_EE = X1M_ONE + 16 * LDTB, X1M_END = X1M_EE + 256;
__device__ __forceinline__ void phase_ex1(int wv, KP Pk, int layer, LAS char* lds) {
    asm volatile("" : "+s"(Pk));
    const CAS Params& P = *Pk;
    const int tid = ltid(wv), lane = tid & 63, wid = tid >> 6, q = lane >> 4, r16 = lane & 15, i_ = layer >> 1;
    const bf16_t* XBC = (const bf16_t*)(P.ws + WS_EXBC); const bf16_t* QK = (const bf16_t*)(P.ws + WS_EQK); const bf16_t* Pb = (const bf16_t*)(P.ws + WS_P);
    const float* GT = (const float*)(P.ws + WS_EGT);
    {
        bf16_t* Hst = (bf16_t*)(P.ws + WS_XSS); float* Dst = (float*)(P.ws + WS_XSD);
        u32x4 rc[2]; float rdt = 0.f;
        auto geom = [&](int it, int& b, int& h, int& dir, int& c) { const int sq = it / NCH64; c = it - sq * NCH64; b = sq >> 4; h = (sq >> 1) & 7; dir = sq & 1; };
        auto load = [&](int it) {
            int b, h, dir, c; geom(it, b, h, dir, c);
            int tl = tid; asm volatile("" : "+v"(tl));
#pragma unroll
            for (int s = 0; s < 2; ++s) {
                const int task = tl + NT * s, j = task >> 4, g = task & 15;
                const int row = scan_row(c * CL + j, b, dir, 0);
                rc[s] = *(const u32x4*)(XBC + (size_t)row * 768 + (g < 8 ? h * 64 + 8 * g : 512 + (h >> 2) * 64 + 8 * (g - 8)));
            }
            if (tl < CL) { const int row = scan_row(c * CL + tl, b, dir, 0); rdt = GT[(size_t)row * 32 + dir * 8 + h]; }
        };
        int it = blockIdx.x;
        if (it < NSSD_ITEMS) load(it);
        for (; it < NSSD_ITEMS; it += gridDim.x) {
            int b, h, dir, c; geom(it, b, h, dir, c);
            const float aco = -__expf(P.ssd_a_log[(i_ * 2 + dir) * 8 + h]);
            if (tid < CL) {
                const float cum = wave_cumsum(rdt * aco, lane);
                ((LAS float*)(lds + X1S_CUM))[tid] = cum; ((LAS float*)(lds + X1S_DTV))[tid] = rdt;
            }
            __syncthreads();
            {
                const LAS float* cum = (const LAS float*)(lds + X1S_CUM);
                const float cumL = cum[CL - 1];
                int tl = tid; asm volatile("" : "+v"(tl));
#pragma unroll
                for (int s = 0; s < 2; ++s) {
                    const int task = tl + NT * s, j = task >> 4, g = task & 15;
                    float f[8]; unpack8(rc[s], f);
                    if (g < 8) {
                        const float dt = ((const LAS float*)(lds + X1S_DTV))[j];
#pragma unroll
                        for (int e = 0; e < 8; ++e) *(LAS bf16_t*)(lds + X1S_XT + (8 * g + e) * LDTB + j * 2) = f2bf(f[e] * dt);
                    } else {
                        const float sc = __expf(cumL - cum[j]);
#pragma unroll
                        for (int e = 0; e < 8; ++e) *(LAS bf16_t*)(lds + X1S_BDT + (8 * (g - 8) + e) * LDTB + j * 2) = f2bf(f[e] * sc);
                    }
                }
                if (tid == 0) Dst[it] = __expf(cumL);
            }
            if (it + (int)gridDim.x < NSSD_ITEMS) load(it + gridDim.x);
            __syncthreads();
            {
                const int pt = wid >> 1;
#pragma unroll
                for (int u = 0; u < 2; ++u) {
                    const int nt = (wid & 1) * 2 + u;
                    f32x4 sa = (f32x4){0.f, 0.f, 0.f, 0.f};
#pragma unroll
                    for (int k0 = 0; k0 < 64; k0 += 32) sa = __builtin_amdgcn_mfma_f32_16x16x32_bf16(ldfrag(lds + X1S_BDT, LDTB, nt * 16, k0, lane), ldfrag(lds + X1S_XT, LDTB, pt * 16, k0, lane), sa, 0, 0, 0);
                    u32x2 o; o.x = pk2(sa[0], sa[1]); o.y = pk2(sa[2], sa[3]);
                    *(u32x2*)(Hst + ((size_t)it * 64 + pt * 16 + r16) * 64 + nt * 16 + 4 * q) = o;
                }
            }
            __syncthreads();
        }
    }
    {
        bf16_t* Cst = (bf16_t*)(P.ws + WS_XMC); float* Nst = (float*)(P.ws + WS_XMN); float* Sst = (float*)(P.ws + WS_XMS); float* Tst = (float*)(P.ws + WS_XMT);
        for (int i = tid; i < 16 * LDTB / 4; i += NT) ((LAS unsigned*)(lds + X1M_ONE))[i] = 0x3f803f80u;
        u32x4 rc[3]; float rli = 0.f, rlf = 0.f;
        auto geom = [&](int it, int& b, int& h, int& dir, int& c) { const int sq = it / NCH64; c = it - sq * NCH64; b = sq >> 3; h = (sq >> 1) & 3; dir = sq & 1; };
        auto load = [&](int it) {
            int b, h, dir, c; geom(it, b, h, dir, c);
            int tl = tid; asm volatile("" : "+v"(tl));
#pragma unroll
            for (int s = 0; s < 3; ++s) {
                const int task = tl + NT * s, j = task / 24, g = task - 24 * j;
                const int row = scan_row(c * CL + j, b, dir, 0);
                rc[s] = g < 8 ? *(const u32x4*)(QK + (size_t)row * 512 + 256 + h * 64 + 8 * g) : *(const u32x4*)(Pb + (size_t)row * LDP_EVEN + 1808 + h * 128 + 8 * (g - 8));
            }
            if (tl < CL) { const int row = scan_row(c * CL + tl, b, dir, 0); rli = GT[(size_t)row * 32 + 16 + dir * 4 + h]; rlf = GT[(size_t)row * 32 + 24 + dir * 4 + h]; }
        };
        int it = blockIdx.x;
        if (it < NML_ITEMS) load(it);
        __syncthreads();
        for (; it < NML_ITEMS; it += gridDim.x) {
            if (tid < CL) {
                const float fcum = wave_cumsum(rlf, lane);
                const float ftot = __shfl(fcum, 63);
                const float g = rli - fcum, pm = wave_cummax(g, lane);
                const float wend = ftot + g, mloc = wave_max(wend);
                ((LAS float*)(lds + X1M_EE))[tid] = __expf(wend - mloc);
                float* tp = Tst + (size_t)it * 192;
                tp[tid] = fcum; tp[64 + tid] = g; tp[128 + tid] = pm;
                if (tid == 0) { Sst[(size_t)it * 4 + 0] = ftot; Sst[(size_t)it * 4 + 1] = mloc; }
            }
            __syncthreads();
            {
                const LAS float* ee = (const LAS float*)(lds + X1M_EE);
                int tl = tid; asm volatile("" : "+v"(tl));
#pragma unroll
                for (int s = 0; s < 3; ++s) {
                    const int task = tl + NT * s, j = task / 24, g = task - 24 * j;
                    if (g < 8) {
                        float f[8]; unpack8(rc[s], f);
                        const float e1 = ee[j];
#pragma unroll
                        for (int e = 0; e < 8; ++e) *(LAS bf16_t*)(lds + X1M_KET + (8 * g + e) * LDTB + j * 2) = f2bf(f[e] * e1);
                    } else {
                        const int v0 = 8 * (g - 8);
#pragma unroll
                        for (int e = 0; e < 8; ++e) { const unsigned wv = rc[s][e >> 1]; *(LAS bf16_t*)(lds + X1M_VT + (v0 + e) * LDTB + j * 2) = (bf16_t)((e & 1) ? (wv >> 16) : (wv & 0xffffu)); }
                    }
                }
            }
            if (it + (int)gridDim.x < NML_ITEMS) load(it + gridDim.x);
            __syncthreads();
            {
                const bf16x8 vf0 = ldfrag(lds + X1M_VT, LDTB, wid * 16, 0, lane), vf1 = ldfrag(lds + X1M_VT, LDTB, wid * 16, 32, lane);
#pragma unroll
                for (int kt = 0; kt < 4; ++kt) {
                    f32x4 sa = __builtin_amdgcn_mfma_f32_16x16x32_bf16(ldfrag(lds + X1M_KET, LDTB, kt * 16, 0, lane), vf0, (f32x4){0.f, 0.f, 0.f, 0.f}, 0, 0, 0);
                    sa = __builtin_amdgcn_mfma_f32_16x16x32_bf16(ldfrag(lds + X1M_KET, LDTB, kt * 16, 32, lane), vf1, sa, 0, 0, 0);
                    u32x2 o; o.x = pk2(sa[0], sa[1]); o.y = pk2(sa[2], sa[3]);
                    *(u32x2*)(Cst + ((size_t)it * 128 + wid * 16 + r16) * 64 + kt * 16 + 4 * q) = o;
                }
                if (wid < 4) {
                    f32x4 na = __builtin_amdgcn_mfma_f32_16x16x32_bf16(ldfrag(lds + X1M_KET, LDTB, wid * 16, 0, lane), ldfrag(lds + X1M_ONE, LDTB, 0, 0, lane), (f32x4){0.f, 0.f, 0.f, 0.f}, 0, 0, 0);
                    na = __builtin_amdgcn_mfma_f32_16x16x32_bf16(ldfrag(lds + X1M_KET, LDTB, wid * 16, 32, lane), ldfrag(lds + X1M_ONE, LDTB, 0, 32, lane), na, 0, 0, 0);
                    if (r16 == 0) *(f32x4*)(Nst + (size_t)it * 64 + wid * 16 + 4 * q) = na;
                }
            }
            __syncthreads();
        }
    }
}

__device__ __forceinline__ void phase_ex2(int wv, KP Pk, int layer) {
    asm volatile("" : "+s"(Pk));
    const CAS Params& P = *Pk;
    const int tid = ltid(wv);
    (void)layer;
    if (blockIdx.x < 128) {
        const int gt = blockIdx.x * NT + tid, sq = gt >> 10, rem = gt & 1023;
        bf16_t* Hst = (bf16_t*)(P.ws + WS_XSS) + (size_t)sq * NCH64 * 4096 + rem * 4;
        const float* Dst = (const float*)(P.ws + WS_XSD) + sq * NCH64;
        float h0 = 0.f, h1 = 0.f, h2 = 0.f, h3 = 0.f;
#pragma unroll 4
        for (int c = 0; c < NCH64; ++c) {
            const u32x2 loc = *(const u32x2*)(Hst + (size_t)c * 4096);
            const float d = Dst[c];
            u32x2 o; o.x = pk2(h0, h1); o.y = pk2(h2, h3);
            *(u32x2*)(Hst + (size_t)c * 4096) = o;
            h0 = d * h0 + bflo(loc.x); h1 = d * h1 + bfhi(loc.x); h2 = d * h2 + bflo(loc.y); h3 = d * h3 + bfhi(loc.y);
        }
    } else if (blockIdx.x < 256) {
        const int gt = (blockIdx.x - 128) * NT + tid, sq = gt >> 11, rem = gt & 2047;
        bf16_t* Cst = (bf16_t*)(P.ws + WS_XMC) + (size_t)sq * NCH64 * 8192 + rem * 4;
        float* Nst = (float*)(P.ws + WS_XMN) + (size_t)sq * NCH64 * 64 + (rem & 15) * 4;
        float* Sst = (float*)(P.ws + WS_XMS) + (size_t)sq * NCH64 * 4;
        const bool own_n = rem < 16, own_m = rem == 0;
        float c0 = 0.f, c1 = 0.f, c2 = 0.f, c3 = 0.f, m = -1e30f;
        f32x4 nn = (f32x4){0.f, 0.f, 0.f, 0.f};
#pragma unroll 2
        for (int c = 0; c < NCH64; ++c) {
            const u32x2 loc = *(const u32x2*)(Cst + (size_t)c * 8192);
            const float ftot = Sst[c * 4 + 0], mloc = Sst[c * 4 + 1];
            const float mnew = fmaxf(ftot + m, mloc), sp = __expf(ftot + m - mnew), sl = __expf(mloc - mnew);
            u32x2 o; o.x = pk2(c0, c1); o.y = pk2(c2, c3);
            *(u32x2*)(Cst + (size_t)c * 8192) = o;
            c0 = sp * c0 + sl * bflo(loc.x); c1 = sp * c1 + sl * bfhi(loc.x); c2 = sp * c2 + sl * bflo(loc.y); c3 = sp * c3 + sl * bfhi(loc.y);
            if (own_n) { const f32x4 nl = *(const f32x4*)(Nst + (size_t)c * 64); *(f32x4*)(Nst + (size_t)c * 64) = nn; nn = nn * sp + nl * sl; }
            if (own_m) Sst[c * 4 + 2] = m;
            m = mnew;
        }
    }
}

constexpr int X3S_BT = 0, X3S_CT = X3S_BT + 64 * LDTB, X3S_XT = X3S_CT + 64 * LDTB, X3S_HB = X3S_XT + 64 * LDTB, X3S_M = X3S_HB + 64 * LDTB, X3S_CUM = X3S_M + 64 * LDTB, X3S_DTV = X3S_CUM + 256, X3S_ROWS = X3S_DTV + 256, X3S_END = X3S_ROWS + 256;
constexpr int X3M_QT = 0, X3M_KT = X3M_QT + 64 * LDTB, X3M_VT = X3M_KT + 64 * LDTB, X3M_CB = X3M_VT + 128 * LDTB, X3M_W = X3M_CB + 128 * LDTB, X3M_ONE = X3M_W + 64 * LDTB, X3M_NB = X3M_ONE + 16 * LDTB,
              X3M_SC = X3M_NB + 16 * LDTB, X3M_END = X3M_SC + 6 * 256;
static_assert(X3M_END <= LDS_BYTES - 16 && X3S_END <= LDS_BYTES - 16, "EX3 LDS maps");
__device__ __forceinline__ void phase_ex3(int wv, KP Pk, int layer, LAS char* lds) {
    asm volatile("" : "+s"(Pk));
    const CAS Params& P = *Pk;
    const int tid = ltid(wv), lane = tid & 63, wid = tid >> 6, q = lane >> 4, r16 = lane & 15, i_ = layer >> 1;
    const bf16_t* XBC = (const bf16_t*)(P.ws + WS_EXBC); const bf16_t* QK = (const bf16_t*)(P.ws + WS_EQK); const bf16_t* Pb = (const bf16_t*)(P.ws + WS_P);
    const float* GT = (const float*)(P.ws + WS_EGT);
    {
        const bf16_t* Hst = (const bf16_t*)(P.ws + WS_XSS);
        u32x4 rc[3], rh; float rdt = 0.f; int rrow = 0;
        auto geom = [&](int it, int& b, int& h, int& dir, int& c) { const int sq = it / NCH64; c = it - sq * NCH64; b = sq >> 4; h = (sq >> 1) & 7; dir = sq & 1; };
        auto load = [&](int it) {
            int b, h, dir, c; geom(it, b, h, dir, c);
            int tl = tid; asm volatile("" : "+v"(tl));
#pragma unroll
            for (int s = 0; s < 3; ++s) {
                const int task = tl + NT * s, j = task / 24, g = task - 24 * j;
                const int row = scan_row(c * CL + j, b, dir, 0);
                rc[s] = *(const u32x4*)(XBC + (size_t)row * 768 + (g < 8 ? h * 64 + 8 * g : g < 16 ? 512 + (h >> 2) * 64 + 8 * (g - 8) : 640 + (h >> 2) * 64 + 8 * (g - 16)));
            }
            rh = *(const u32x4*)(Hst + (size_t)it * 4096 + tl * 8);
            if (tl < CL) { rrow = scan_row(c * CL + tl, b, dir, 0); rdt = GT[(size_t)rrow * 32 + dir * 8 + h]; }
        };
        int it = blockIdx.x;
        if (it < NSSD_ITEMS) load(it);
        __syncthreads();
        for (; it < NSSD_ITEMS; it += gridDim.x) {
            int b, h, dir, c; geom(it, b, h, dir, c);
            bf16_t* Y = (bf16_t*)(P.ws + (dir ? WS_YB : WS_YF));
            const float aco = -__expf(P.ssd_a_log[(i_ * 2 + dir) * 8 + h]);
            if (tid < CL) {
                const float cum = wave_cumsum(rdt * aco, lane);
                ((LAS float*)(lds + X3S_CUM))[tid] = cum; ((LAS float*)(lds + X3S_DTV))[tid] = rdt; ((LAS int*)(lds + X3S_ROWS))[tid] = rrow;
            }
            __syncthreads();
            {
                int tl = tid; asm volatile("" : "+v"(tl));
#pragma unroll
                for (int s = 0; s < 3; ++s) {
                    const int task = tl + NT * s, j = task / 24, g = task - 24 * j;
                    if (g < 8) {
                        float f[8]; unpack8(rc[s], f);
                        const float dt = ((const LAS float*)(lds + X3S_DTV))[j];
#pragma unroll
                        for (int e = 0; e < 8; ++e) *(LAS bf16_t*)(lds + X3S_XT + (8 * g + e) * LDTB + j * 2) = f2bf(f[e] * dt);
                    } else if (g < 16) *(LAS u32x4*)(lds + X3S_BT + j * LDTB + 8 * (g - 8) * 2) = rc[s];
                    else *(LAS u32x4*)(lds + X3S_CT + j * LDTB + 8 * (g - 16) * 2) = rc[s];
                }
                *(LAS u32x4*)(lds + X3S_HB + (tl >> 3) * LDTB + (tl & 7) * 16) = rh;
            }
            if (it + (int)gridDim.x < NSSD_ITEMS) load(it + gridDim.x);
            __syncthreads();
            const LAS float* cum = (const LAS float*)(lds + X3S_CUM);
            {
                const int lt = wid >> 1;
#pragma unroll
                for (int u = 0; u < 2; ++u) {
                    const int st = (wid & 1) * 2 + u;
                    f32x4 acc = (f32x4){0.f, 0.f, 0.f, 0.f};
                    if (st <= lt) {
#pragma unroll
                        for (int k0 = 0; k0 < 64; k0 += 32) acc = __builtin_amdgcn_mfma_f32_16x16x32_bf16(ldfrag(lds + X3S_BT, LDTB, st * 16, k0, lane), ldfrag(lds + X3S_CT, LDTB, lt * 16, k0, lane), acc, 0, 0, 0);
                        const int l = lt * 16 + r16, s0 = st * 16 + 4 * q;
                        const float cl = cum[l]; const f32x4 cs = *(const LAS f32x4*)(cum + s0);
#pragma unroll
                        for (int j = 0; j < 4; ++j) acc[j] = (s0 + j <= l) ? acc[j] * __expf(cl - cs[j]) : 0.f;
                    }
                    st4bf(lds + X3S_M + (lt * 16 + r16) * LDTB + (st * 16 + 4 * q) * 2, acc);
                }
            }
            __syncthreads();
            {
                const int lt = wid >> 1, l = lt * 16 + r16;
                const float el = __expf(cum[l]);
                const int row = ((const LAS int*)(lds + X3S_ROWS))[l];
                const bf16x8 mf0 = ldfrag(lds + X3S_M, LDTB, lt * 16, 0, lane), mf1 = ldfrag(lds + X3S_M, LDTB, lt * 16, 32, lane);
                const bf16x8 cf0 = ldfrag(lds + X3S_CT, LDTB, lt * 16, 0, lane), cf1 = ldfrag(lds + X3S_CT, LDTB, lt * 16, 32, lane);
#pragma unroll
                for (int u = 0; u < 2; ++u) {
                    const int pt = (wid & 1) * 2 + u;
                    f32x4 ya = __builtin_amdgcn_mfma_f32_16x16x32_bf16(ldfrag(lds + X3S_XT, LDTB, pt * 16, 0, lane), mf0, (f32x4){0.f, 0.f, 0.f, 0.f}, 0, 0, 0);
                    ya = __builtin_amdgcn_mfma_f32_16x16x32_bf16(ldfrag(lds + X3S_XT, LDTB, pt * 16, 32, lane), mf1, ya, 0, 0, 0);
                    f32x4 oa = __builtin_amdgcn_mfma_f32_16x16x32_bf16(ldfrag(lds + X3S_HB, LDTB, pt * 16, 0, lane), cf0, (f32x4){0.f, 0.f, 0.f, 0.f}, 0, 0, 0);
                    oa = __builtin_amdgcn_mfma_f32_16x16x32_bf16(ldfrag(lds + X3S_HB, LDTB, pt * 16, 32, lane), cf1, oa, 0, 0, 0);
                    u32x2 o; o.x = pk2(ya[0] + el * oa[0], ya[1] + el * oa[1]); o.y = pk2(ya[2] + el * oa[2], ya[3] + el * oa[3]);
                    *(u32x2*)(Y + (size_t)row * D + h * 64 + pt * 16 + 4 * q) = o;
                }
            }
            __syncthreads();
        }
    }
    {
        const bf16_t* Cst = (const bf16_t*)(P.ws + WS_XMC); const float* Nst = (const float*)(P.ws + WS_XMN); const float* Sst = (const float*)(P.ws + WS_XMS); const float* Tst = (const float*)(P.ws + WS_XMT);
        for (int i = tid; i < 16 * LDTB / 4; i += NT) ((LAS unsigned*)(lds + X3M_ONE))[i] = 0x3f803f80u;
        u32x4 rc[4], rcb[2]; float rfc = 0.f, rg = 0.f, rpm = 0.f, rmp = 0.f, rn = 0.f; int rrow = 0;
        auto geom = [&](int it, int& b, int& h, int& dir, int& c) { const int sq = it / NCH64; c = it - sq * NCH64; b = sq >> 3; h = (sq >> 1) & 3; dir = sq & 1; };
        auto load = [&](int it) {
            int b, h, dir, c; geom(it, b, h, dir, c);
            int tl = tid; asm volatile("" : "+v"(tl));
#pragma unroll
            for (int s = 0; s < 4; ++s) {
                const int task = tl + NT * s, j = task >> 5, g = task & 31;
                const int row = scan_row(c * CL + j, b, dir, 0);
                rc[s] = g < 16 ? *(const u32x4*)(QK + (size_t)row * 512 + (g < 8 ? h * 64 + 8 * g : 256 + h * 64 + 8 * (g - 8))) : *(const u32x4*)(Pb + (size_t)row * LDP_EVEN + 1808 + h * 128 + 8 * (g - 16));
            }
#pragma unroll
            for (int s = 0; s < 2; ++s) rcb[s] = *(const u32x4*)(Cst + (size_t)it * 8192 + (tl + NT * s) * 8);
            if (tl < CL) {
                rrow = scan_row(c * CL + tl, b, dir, 0);
                const float* tp = Tst + (size_t)it * 192;
                rfc = tp[tl]; rg = tp[64 + tl]; rpm = tp[128 + tl]; rmp = Sst[(size_t)it * 4 + 2]; rn = Nst[(size_t)it * 64 + tl];
            }
        };
        int it = blockIdx.x;
        if (it < NML_ITEMS) load(it);
        __syncthreads();
        for (; it < NML_ITEMS; it += gridDim.x) {
            int b, h, dir, c; geom(it, b, h, dir, c);
            bf16_t* Y = (bf16_t*)(P.ws + (dir ? WS_YB : WS_YF));
            LAS float* sc = (LAS float*)(lds + X3M_SC);
            {
                int tl = tid; asm volatile("" : "+v"(tl));
#pragma unroll
                for (int s = 0; s < 4; ++s) {
                    const int task = tl + NT * s, j = task >> 5, g = task & 31;
                    if (g < 8) *(LAS u32x4*)(lds + X3M_QT + j * LDTB + 8 * g * 2) = rc[s];
                    else if (g < 16) *(LAS u32x4*)(lds + X3M_KT + j * LDTB + 8 * (g - 8) * 2) = rc[s];
                    else {
                        const int v0 = 8 * (g - 16);
#pragma unroll
                        for (int e = 0; e < 8; ++e) { const unsigned wv = rc[s][e >> 1]; *(LAS bf16_t*)(lds + X3M_VT + (v0 + e) * LDTB + j * 2) = (bf16_t)((e & 1) ? (wv >> 16) : (wv & 0xffffu)); }
                    }
                }
#pragma unroll
                for (int s = 0; s < 2; ++s) { const int ch = tl + NT * s; *(LAS u32x4*)(lds + X3M_CB + (ch >> 3) * LDTB + (ch & 7) * 16) = rcb[s]; }
                if (tl < CL) {
                    const float linter = rfc + rmp, mrow = fmaxf(rfc + rpm, linter);
                    sc[tl] = rfc - mrow; sc[64 + tl] = rg; sc[128 + tl] = __expf(linter - mrow); sc[192 + tl] = __expf(-mrow); ((LAS int*)sc)[256 + tl] = rrow;
                    const bf16_t nb = f2bf(rn);
#pragma unroll
                    for (int r = 0; r < 16; ++r) *(LAS bf16_t*)(lds + X3M_NB + r * LDTB + tl * 2) = nb;
                }
            }
            if (it + (int)gridDim.x < NML_ITEMS) load(it + gridDim.x);
            __syncthreads();
            {
                const int lt = wid >> 1;
#pragma unroll
                for (int u = 0; u < 2; ++u) {
                    const int st = (wid & 1) * 2 + u;
                    f32x4 acc = (f32x4){0.f, 0.f, 0.f, 0.f};
                    if (st <= lt) {
#pragma unroll
                        for (int k0 = 0; k0 < 64; k0 += 32) acc = __builtin_amdgcn_mfma_f32_16x16x32_bf16(ldfrag(lds + X3M_KT, LDTB, st * 16, k0, lane), ldfrag(lds + X3M_QT, LDTB, lt * 16, k0, lane), acc, 0, 0, 0);
                        const int l = lt * 16 + r16, s0 = st * 16 + 4 * q;
                        const float rt = sc[l]; const f32x4 gs = *(const LAS f32x4*)(sc + 64 + s0);
#pragma unroll
                        for (int j = 0; j < 4; ++j) acc[j] = (s0 + j <= l) ? acc[j] * __expf(rt + gs[j]) : 0.f;
                    }
                    st4bf(lds + X3M_W + (lt * 16 + r16) * LDTB + (st * 16 + 4 * q) * 2, acc);
                }
            }
            __syncthreads();
            {
                const int lt = wid >> 1, l = lt * 16 + r16;
                const bf16x8 wf0 = ldfrag(lds + X3M_W, LDTB, lt * 16, 0, lane), wf1 = ldfrag(lds + X3M_W, LDTB, lt * 16, 32, lane);
                const bf16x8 qf0 = ldfrag(lds + X3M_QT, LDTB, lt * 16, 0, lane), qf1 = ldfrag(lds + X3M_QT, LDTB, lt * 16, 32, lane);
                f32x4 da = __builtin_amdgcn_mfma_f32_16x16x32_bf16(ldfrag(lds + X3M_ONE, LDTB, 0, 0, lane), wf0, (f32x4){0.f, 0.f, 0.f, 0.f}, 0, 0, 0);
                da = __builtin_amdgcn_mfma_f32_16x16x32_bf16(ldfrag(lds + X3M_ONE, LDTB, 0, 32, lane), wf1, da, 0, 0, 0);
                f32x4 qn = __builtin_amdgcn_mfma_f32_16x16x32_bf16(ldfrag(lds + X3M_NB, LDTB, 0, 0, lane), qf0, (f32x4){0.f, 0.f, 0.f, 0.f}, 0, 0, 0);
                qn = __builtin_amdgcn_mfma_f32_16x16x32_bf16(ldfrag(lds + X3M_NB, LDTB, 0, 32, lane), qf1, qn, 0, 0, 0);
                const float inter = sc[128 + l], emr = sc[192 + l];
                const float inv = __builtin_amdgcn_rcpf(fmaxf(fabsf(da[0] + inter * qn[0]), emr));
                const int row = ((const LAS int*)sc)[256 + l];
#pragma unroll
                for (int u = 0; u < 4; ++u) {
                    const int vt = (wid & 1) * 4 + u;
                    f32x4 na = __builtin_amdgcn_mfma_f32_16x16x32_bf16(ldfrag(lds + X3M_VT, LDTB, vt * 16, 0, lane), wf0, (f32x4){0.f, 0.f, 0.f, 0.f}, 0, 0, 0);
                    na = __builtin_amdgcn_mfma_f32_16x16x32_bf16(ldfrag(lds + X3M_VT, LDTB, vt * 16, 32, lane), wf1, na, 0, 0, 0);
                    f32x4 ca = __builtin_amdgcn_mfma_f32_16x16x32_bf16(ldfrag(lds + X3M_CB, LDTB, vt * 16, 0, lane), qf0, (f32x4){0.f, 0.f, 0.f, 0.f}, 0, 0, 0);
                    ca = __builtin_amdgcn_mfma_f32_16x16x32_bf16(ldfrag(lds + X3M_CB, LDTB, vt * 16, 32, lane), qf1, ca, 0, 0, 0);
                    u32x2 o; o.x = pk2((na[0] + inter * ca[0]) * inv, (na[1] + inter * ca[1]) * inv); o.y = pk2((na[2] + inter * ca[2]) * inv, (na[3] + inter * ca[3]) * inv);
                    *(u32x2*)(Y + (size_t)row * D + 512 + h * 128 + vt * 16 + 4 * q) = o;
                }
            }
            __syncthreads();
        }
    }
}

constexpr int HC_RAWF = 0;
constexpr int HC_RAWQ = HC_RAWF + 64 * 128 * 4;
constexpr int HC_SUB = HC_RAWQ + 64 * 128 * 2;
constexpr int HL_QD = 136 * 2;
constexpr int HL_T = 24 * 2;
constexpr int HS_QI = 0, HS_KO = HS_QI + 16 * HL_QD, HS_KET = HS_KO + 16 * HL_QD, HS_ATT = HS_KET + 128 * HL_T, HS_VT = HS_ATT + 16 * HL_T, HS_DEC = HS_VT + 32 * HL_T, HS_SIZE = HS_DEC + 512;
constexpr int HC_SB = HC_SUB + 4 * HS_SIZE;
constexpr int HC_ROWS = HC_SB + 2 * 32 * HL_QD, HC_CST = HC_ROWS + 256, HC_END = HC_CST + 1024;
static_assert(HC_END <= LDS_BYTES - 16, "HGRN2 LDS map");
static_assert(HS_SIZE % 16 == 0 && HC_SB % 16 == 0, "alignment");
__device__ __forceinline__ bf16x8 ldfrag16(const LAS char* tile, int ldb, int row0, int lane) {
    bf16x8 v = *(const LAS bf16x8*)(tile + (row0 + (lane & 15)) * ldb + ((lane >> 4) & 1) * 16);
    if (lane >= 32) v = (bf16x8){0, 0, 0, 0, 0, 0, 0, 0};
    return v;
}
__device__ __forceinline__ void scan_hgrn_c(int wv, KP Pk, int layer, int unit, LAS char* lds) {
    asm volatile("" : "+s"(Pk));
    const CAS Params& P = *Pk;
    const int tid = ltid(wv), lane = tid & 63, wid = tid >> 6, q = lane >> 4, r16 = lane & 15, i_ = layer >> 1;
    const int seq = unit >> 2, quarter = unit & 3, b = seq >> 3, h = (seq >> 1) & 3, dir = seq & 1;
    const bf16_t* Pb = (const bf16_t*)(P.ws + WS_P);
    bf16_t* Y = (bf16_t*)(P.ws + (dir ? WS_YB : WS_YF));
    LAS float* cst = (LAS float*)(lds + HC_CST);
    if (tid < 128) cst[tid] = ((const float*)(P.ws + WS_LB))[layer * 512 + h * 128 + tid];
    else if (tid < 256) cst[tid] = P.hg_f_bias[(size_t)(i_ * 2 + dir) * 512 + h * 128 + tid - 128];
    for (int i = tid; i < 2 * 32 * HL_QD / 4; i += NT) ((LAS unsigned*)(lds + HC_SB))[i] = 0u;
    int tj[5], tg_[5], tcol[5]; bool tv[5];
#pragma unroll
    for (int s = 0; s < 5; ++s) {
        const int task = tid + NT * s; tv[s] = task < 64 * 36; tj[s] = task / 36; tg_[s] = task % 36;
        const int g = tg_[s];
        tcol[s] = g < 16 ? (512 + dir * 512 + h * 128 + 8 * g) : g < 32 ? (h * 128 + 8 * (g - 16)) : (1536 + h * 128 + quarter * 32 + 8 * (g - 32));
    }
    u32x4 rc[5]; int rrow = 0;
    auto load = [&](int c) {
#pragma unroll
        for (int s = 0; s < 5; ++s) {
            rc[s] = (u32x4){0u, 0u, 0u, 0u};
            if (tv[s]) { const int row = scan_row(c * 64 + tj[s], b, dir, 1); rc[s] = *(const u32x4*)(Pb + (size_t)row * LDP_ODD + tcol[s]); }
        }
        if (tid < 64) rrow = scan_row(c * 64 + tid, b, dir, 1);
    };
    auto storeA = [&]() {
#pragma unroll
        for (int s = 0; s < 5; ++s) {
            if (tv[s]) {
                float f[8]; unpack8(rc[s], f);
                const int j = tj[s], g = tg_[s];
                if (g < 16) {
                    float o[8];
#pragma unroll
                    for (int e = 0; e < 8; ++e) { const float lbv = cst[8 * g + e]; o[e] = lbv + (1.f - lbv) * sigmoidf_(f[e] + cst[128 + 8 * g + e]); }
                    LAS float* dst = (LAS float*)(lds + HC_RAWF) + j * 128 + 8 * g;
                    *(LAS f32x4*)dst = (f32x4){o[0], o[1], o[2], o[3]}; *(LAS f32x4*)(dst + 4) = (f32x4){o[4], o[5], o[6], o[7]};
                } else if (g < 32) {
                    float o[8];
#pragma unroll
                    for (int e = 0; e < 8; ++e) o[e] = siluf_(f[e]);
                    *(LAS u32x4*)(lds + HC_RAWQ + (j * 128 + 8 * (g - 16)) * 2) = pack8(o);
                } else {
                    const int v0 = 8 * (g - 32);
                    LAS char* vt = lds + HC_SUB + (j >> 4) * HS_SIZE + HS_VT;
#pragma unroll
                    for (int e = 0; e < 8; ++e) { const unsigned wv = rc[s][e >> 1]; *(LAS bf16_t*)(vt + (v0 + e) * HL_T + (j & 15) * 2) = (bf16_t)((e & 1) ? (wv >> 16) : (wv & 0xffffu)); }
                }
            }
        }
        if (tid < 64) ((LAS int*)(lds + HC_ROWS))[tid] = rrow;
    };
    auto storeB = [&]() {
        const int d = tid & 127, sb = tid >> 7;
        LAS char* st = lds + HC_SUB + sb * HS_SIZE;
        const LAS float* rf = (const LAS float*)(lds + HC_RAWF) + (sb * 16) * 128 + d;
        const LAS bf16_t* rq = (const LAS bf16_t*)(lds + HC_RAWQ) + (sb * 16) * 128 + d;
        float lam = 0.f, lams[16], kfs[16];
#pragma unroll
        for (int t = 0; t < 16; ++t) {
            const float f = rf[t * 128];
            lam += __logf(f);
            const float kf = 1.f - f;
            lams[t] = lam; kfs[t] = kf;
            *(LAS bf16_t*)(st + HS_QI + t * HL_QD + d * 2) = f2bf(bf2f(rq[t * 128]) * __expf(lam));
            *(LAS bf16_t*)(st + HS_KO + t * HL_QD + d * 2) = f2bf(kf * __expf(-lam));
        }
        float ke[16];
#pragma unroll
        for (int t = 0; t < 16; ++t) ke[t] = kfs[t] * __expf(lam - lams[t]);
        *(LAS u32x4*)(st + HS_KET + d * HL_T) = pack8(ke); *(LAS u32x4*)(st + HS_KET + d * HL_T + 16) = pack8(ke + 8);
        ((LAS float*)(st + HS_DEC))[d] = __expf(lam);
    };
    f32x4 sacc[2];
    sacc[0] = sacc[1] = (f32x4){0.f, 0.f, 0.f, 0.f};
    __syncthreads();
    load(0);
    for (int c = 0; c < NSTEPS / 64; ++c) {
        storeA();
        __syncthreads();
        storeB();
        if (c + 1 < NSTEPS / 64) load(c + 1);
        __syncthreads();
        if (wid < 4) {
            LAS char* st = lds + HC_SUB + wid * HS_SIZE;
            f32x4 acc = (f32x4){0.f, 0.f, 0.f, 0.f};
#pragma unroll
            for (int k0 = 0; k0 < 128; k0 += 32) acc = __builtin_amdgcn_mfma_f32_16x16x32_bf16(ldfrag(st + HS_KO, HL_QD, 0, k0, lane), ldfrag(st + HS_QI, HL_QD, 0, k0, lane), acc, 0, 0, 0);
#pragma unroll
            for (int j = 0; j < 4; ++j) acc[j] = (4 * q + j <= r16) ? acc[j] : 0.f;
            st4bf(st + HS_ATT + r16 * HL_T + 4 * q * 2, acc);
        }
        __syncthreads();
#pragma unroll 1
        for (int sb = 0; sb < 4; ++sb) {
            LAS char* st = lds + HC_SUB + sb * HS_SIZE;
            const LAS char* sbr = lds + HC_SB + (sb & 1) * 32 * HL_QD;
            LAS char* sbw = lds + HC_SB + ((sb + 1) & 1) * 32 * HL_QD;
            if (wid < 2) {
                f32x4 ya = __builtin_amdgcn_mfma_f32_16x16x32_bf16(ldfrag16(st + HS_VT, HL_T, wid * 16, lane), ldfrag16(st + HS_ATT, HL_T, 0, lane), (f32x4){0.f, 0.f, 0.f, 0.f}, 0, 0, 0);
#pragma unroll
                for (int k0 = 0; k0 < 128; k0 += 32) ya = __builtin_amdgcn_mfma_f32_16x16x32_bf16(ldfrag(sbr, HL_QD, wid * 16, k0, lane), ldfrag(st + HS_QI, HL_QD, 0, k0, lane), ya, 0, 0, 0);
                const int row = ((const LAS int*)(lds + HC_ROWS))[sb * 16 + r16];
                u32x2 o; o.x = pk2(ya[0], ya[1]); o.y = pk2(ya[2], ya[3]);
                *(u32x2*)(Y + (size_t)row * D + h * 128 + quarter * 32 + wid * 16 + 4 * q) = o;
            }
            {
                const int vt = wid >> 2;
                const bf16x8 vf = ldfrag16(st + HS_VT, HL_T, vt * 16, lane);
#pragma unroll
                for (int u = 0; u < 2; ++u) {
                    const int dt = (wid & 3) * 2 + u;
                    const f32x4 a = __builtin_amdgcn_mfma_f32_16x16x32_bf16(ldfrag16(st + HS_KET, HL_T, dt * 16, lane), vf, (f32x4){0.f, 0.f, 0.f, 0.f}, 0, 0, 0);
                    const f32x4 dc = *(const LAS f32x4*)((const LAS float*)(st + HS_DEC) + dt * 16 + 4 * q);
#pragma unroll
                    for (int j = 0; j < 4; ++j) sacc[u][j] = sacc[u][j] * dc[j] + a[j];
                    st4bf(sbw + (vt * 16 + r16) * HL_QD + (dt * 16 + 4 * q) * 2, sacc[u]);
                }
            }
            __syncthreads();
        }
    }
}

constexpr int RC_RAWW = 0;
constexpr int RC_RAWA = RC_RAWW + 64 * 64 * 4;
constexpr int RC_RAWB = RC_RAWA + 64 * 64 * 2, RC_RAWK = RC_RAWB + 64 * 64 * 2, RC_RAWR = RC_RAWK + 64 * 64 * 2;
constexpr int RC_SUB = RC_RAWR + 64 * 64 * 2;
constexpr int RL_C = 72 * 2, RL_32 = 40 * 2, RL_16 = 24 * 2;
constexpr int RS_AT = 0, RS_RT = RS_AT + 16 * RL_C, RS_KT = RS_RT + 16 * RL_C, RS_BT = RS_KT + 16 * RL_C, RS_KBH = RS_BT + 16 * RL_C, RS_AAK = RS_KBH + 64 * RL_32,
              RS_ARKB = RS_AAK + 16 * RL_16, RS_T = RS_ARKB + 16 * RL_32, RS_AABF = RS_T + 16 * RL_16, RS_GL = RS_AABF + 16 * 16 * 4, RS_VU = RS_GL + 256, RS_SIZE = RS_VU + 32 * RL_32;
constexpr int RC_SB = RC_SUB + 4 * RS_SIZE;
constexpr int RC_RHT = RC_SB + 32 * RL_C;
constexpr int RC_ROWS = RC_RHT + 32 * RL_16, RC_END = RC_ROWS + 256;
static_assert(RC_END <= LDS_BYTES - 16, "RWKV LDS map");
static_assert(RS_SIZE % 16 == 0 && RC_SB % 16 == 0 && RC_RHT % 16 == 0, "alignment");
__device__ __forceinline__ void scan_rwkv_c(int wv, KP Pk, int layer, int unit, LAS char* lds) {
    asm volatile("" : "+s"(Pk));
    const CAS Params& P = *Pk;
    const int tid = ltid(wv), lane = tid & 63, wid = tid >> 6, q = lane >> 4, r16 = lane & 15;
    const int seq = unit >> 1, half = unit & 1, b = seq >> 4, h = (seq >> 1) & 7, dir = seq & 1;
    bf16_t* Y = (bf16_t*)(P.ws + (dir ? WS_YB : WS_YF));
    const float* dec = (const float*)(P.ws + WS_RWDEC) + (size_t)dir * NROWS * 512;
    for (int i = tid; i < 32 * RL_C / 4; i += NT) ((LAS unsigned*)(lds + RC_SB))[i] = 0u;
    const unsigned char* const wsb = P.ws;
    u32x4 rc[7]; int rrow = 0;
    auto load = [&](int c) {
        int tl = tid; asm volatile("" : "+v"(tl));
#pragma unroll
        for (int s = 0; s < 7; ++s) {
            const int task = tl + NT * s, j = task / 52, g = task - 52 * j;
            rc[s] = (u32x4){0u, 0u, 0u, 0u};
            if (task < 64 * 52) {
                const int row = scan_row(c * 64 + j, b, dir, 1);
                const unsigned char* p;
                if (g < 8)       p = wsb + WS_RWR  + ((size_t)row * 512 + h * 64 + 8 * g) * 2;
                else if (g < 16) p = wsb + WS_RWK  + ((size_t)row * 512 + h * 64 + 8 * (g - 8)) * 2;
                else if (g < 24) p = wsb + WS_RWKK + ((size_t)row * 512 + h * 64 + 8 * (g - 16)) * 2;
                else if (g < 32) p = wsb + WS_RWB  + ((size_t)row * 512 + h * 64 + 8 * (g - 24)) * 2;
                else if (g < 36) p = wsb + WS_RWV  + ((size_t)row * 512 + h * 64 + half * 32 + 8 * (g - 32)) * 2;
                else             p = (const unsigned char*)(dec + (size_t)row * 512 + h * 64 + 4 * (g - 36));
                rc[s] = *(const u32x4*)p;
            }
        }
        if (tid < 64) rrow = scan_row(c * 64 + tid, b, dir, 1);
    };
    auto storeA = [&]() {
        int tl = tid; asm volatile("" : "+v"(tl));
#pragma unroll
        for (int s = 0; s < 7; ++s) {
            const int task = tl + NT * s, j = task / 52, g = task - 52 * j;
            if (task < 64 * 52) {
                if (g < 8)       *(LAS u32x4*)(lds + RC_RAWR + (j * 64 + 8 * g) * 2) = rc[s];
                else if (g < 16) *(LAS u32x4*)(lds + RC_RAWK + (j * 64 + 8 * (g - 8)) * 2) = rc[s];
                else if (g < 24) *(LAS u32x4*)(lds + RC_RAWA + (j * 64 + 8 * (g - 16)) * 2) = rc[s];
                else if (g < 32) *(LAS u32x4*)(lds + RC_RAWB + (j * 64 + 8 * (g - 24)) * 2) = rc[s];
                else if (g < 36) {
                    LAS char* vu = lds + RC_SUB + (j >> 4) * RS_SIZE + RS_VU;
                    const int v0 = 8 * (g - 32);
#pragma unroll
                    for (int e = 0; e < 8; ++e) { const unsigned wv = rc[s][e >> 1]; *(LAS bf16_t*)(vu + (v0 + e) * RL_32 + (j & 15) * 2) = (bf16_t)((e & 1) ? (wv >> 16) : (wv & 0xffffu)); }
                } else *(LAS u32x4*)(lds + RC_RAWW + (j * 64 + 4 * (g - 36)) * 4) = rc[s];
            }
        }
        if (tid < 64) ((LAS int*)(lds + RC_ROWS))[tid] = rrow;
    };
    auto storeB = [&]() {
        const int c = tid & 63, sb = (tid >> 6) & 3, role = tid >> 8;
        LAS char* st = lds + RC_SUB + sb * RS_SIZE;
        const LAS float* rw = (const LAS float*)(lds + RC_RAWW) + (sb * 16) * 64 + c;
        float g = 1.f;
        if (role == 0) {
            const LAS bf16_t* ra = (const LAS bf16_t*)(lds + RC_RAWA) + (sb * 16) * 64 + c;
            const LAS bf16_t* rr = (const LAS bf16_t*)(lds + RC_RAWR) + (sb * 16) * 64 + c;
#pragma unroll
            for (int t = 0; t < 16; ++t) {
                const float gp = g; g *= rw[t * 64];
                *(LAS bf16_t*)(st + RS_AT + t * RL_C + c * 2) = f2bf(-bf2f(ra[t * 64]) * gp);
                *(LAS bf16_t*)(st + RS_RT + t * RL_C + c * 2) = f2bf(bf2f(rr[t * 64]) * g);
            }
        } else {
            const LAS bf16_t* rk = (const LAS bf16_t*)(lds + RC_RAWK) + (sb * 16) * 64 + c;
            const LAS bf16_t* rb = (const LAS bf16_t*)(lds + RC_RAWB) + (sb * 16) * 64 + c;
            float ks[16], bs[16];
#pragma unroll
            for (int t = 0; t < 16; ++t) {
                g *= rw[t * 64];
                const float inv = 1.f / g;
                ks[t] = bf2f(rk[t * 64]) * inv; bs[t] = bf2f(rb[t * 64]) * inv;
                *(LAS bf16_t*)(st + RS_KT + t * RL_C + c * 2) = f2bf(ks[t]);
                *(LAS bf16_t*)(st + RS_BT + t * RL_C + c * 2) = f2bf(bs[t]);
            }
#pragma unroll
            for (int t = 0; t < 16; ++t) { ks[t] *= g; bs[t] *= g; }
            LAS char* row = st + RS_KBH + c * RL_32;
            *(LAS u32x4*)row = pack8(ks); *(LAS u32x4*)(row + 16) = pack8(ks + 8); *(LAS u32x4*)(row + 32) = pack8(bs); *(LAS u32x4*)(row + 48) = pack8(bs + 8);
            ((LAS float*)(st + RS_GL))[c] = g;
        }
    };
    f32x4 sacc[4];
#pragma unroll
    for (int i = 0; i < 4; ++i) sacc[i] = (f32x4){0.f, 0.f, 0.f, 0.f};
    __syncthreads();
    load(0);
    for (int c = 0; c < NSTEPS / 64; ++c) {
        storeA();
        __syncthreads();
        storeB();
        if (c + 1 < NSTEPS / 64) load(c + 1);
        __syncthreads();
#pragma unroll
        for (int u = 0; u < 2; ++u) {
            const int task = wid + 8 * u, m = task & 3, sb = task >> 2;
            LAS char* st = lds + RC_SUB + sb * RS_SIZE;
            const LAS char* ta = st + ((m == 0 || m == 3) ? RS_BT : RS_KT);
            const LAS char* tb = st + (m < 2 ? RS_AT : RS_RT);
            f32x4 acc = (f32x4){0.f, 0.f, 0.f, 0.f};
#pragma unroll
            for (int k0 = 0; k0 < 64; k0 += 32) acc = __builtin_amdgcn_mfma_f32_16x16x32_bf16(ldfrag(ta, RL_C, 0, k0, lane), ldfrag(tb, RL_C, 0, k0, lane), acc, 0, 0, 0);
#pragma unroll
            for (int j = 0; j < 4; ++j) { const int s = 4 * q + j; acc[j] = (m < 2 ? (s < r16) : (s <= r16)) ? acc[j] : 0.f; }
            if (m == 0) *(LAS f32x4*)((LAS float*)(st + RS_AABF) + r16 * 16 + 4 * q) = acc;
            else if (m == 1) st4bf(st + RS_AAK + r16 * RL_16 + 4 * q * 2, acc);
            else if (m == 2) st4bf(st + RS_ARKB + r16 * RL_32 + 4 * q * 2, acc);
            else st4bf(st + RS_ARKB + r16 * RL_32 + (16 + 4 * q) * 2, acc);
        }
        __syncthreads();
        if (wid < 4) {
            LAS char* st = lds + RC_SUB + wid * RS_SIZE;
            const LAS float* A = (const LAS float*)(st + RS_AABF);
            const int j = lane & 15;
            float tc[16];
#pragma unroll
            for (int t = 0; t < 16; ++t) {
                float val = (t == j) ? 1.f : 0.f;
                const f32x4 a0 = *(const LAS f32x4*)(A + t * 16), a1 = *(const LAS f32x4*)(A + t * 16 + 4), a2 = *(const LAS f32x4*)(A + t * 16 + 8), a3 = *(const LAS f32x4*)(A + t * 16 + 12);
                const float ar[16] = {a0[0], a0[1], a0[2], a0[3], a1[0], a1[1], a1[2], a1[3], a2[0], a2[1], a2[2], a2[3], a3[0], a3[1], a3[2], a3[3]};
#pragma unroll
                for (int s = 0; s < 16; ++s) if (s < t) val += ar[s] * tc[s];
                tc[t] = val;
            }
            if (lane < 16) {
#pragma unroll
                for (int t = 0; t < 16; ++t) *(LAS bf16_t*)(st + RS_T + t * RL_16 + j * 2) = f2bf(tc[t]);
            }
        }
        __syncthreads();
        if (wid < 2) {
            LAS char* sbt = lds + RC_SB + wid * 16 * RL_C;
            LAS char* rht = lds + RC_RHT + wid * 16 * RL_16;
#pragma unroll 1
            for (int sb = 0; sb < 4; ++sb) {
                LAS char* st = lds + RC_SUB + sb * RS_SIZE;
                LAS char* vu = st + RS_VU + wid * 16 * RL_32;
                f32x4 acc = __builtin_amdgcn_mfma_f32_16x16x32_bf16(ldfrag16(st + RS_AAK, RL_16, 0, lane), ldfrag16(vu, RL_32, 0, lane), (f32x4){0.f, 0.f, 0.f, 0.f}, 0, 0, 0);
#pragma unroll
                for (int k0 = 0; k0 < 64; k0 += 32) acc = __builtin_amdgcn_mfma_f32_16x16x32_bf16(ldfrag(st + RS_AT, RL_C, 0, k0, lane), ldfrag(sbt, RL_C, 0, k0, lane), acc, 0, 0, 0);
                st4bf(rht + r16 * RL_16 + 4 * q * 2, acc);
                asm volatile("s_waitcnt lgkmcnt(0)" ::: "memory");
                acc = __builtin_amdgcn_mfma_f32_16x16x32_bf16(ldfrag16(st + RS_T, RL_16, 0, lane), ldfrag16(rht, RL_16, 0, lane), (f32x4){0.f, 0.f, 0.f, 0.f}, 0, 0, 0);
                st4bf(vu + r16 * RL_32 + (16 + 4 * q) * 2, acc);
                asm volatile("s_waitcnt lgkmcnt(0)" ::: "memory");
                const bf16x8 vuf = ldfrag(vu, RL_32, 0, 0, lane);
                f32x4 ya = __builtin_amdgcn_mfma_f32_16x16x32_bf16(vuf, ldfrag(st + RS_ARKB, RL_32, 0, 0, lane), (f32x4){0.f, 0.f, 0.f, 0.f}, 0, 0, 0);
#pragma unroll
                for (int k0 = 0; k0 < 64; k0 += 32) ya = __builtin_amdgcn_mfma_f32_16x16x32_bf16(ldfrag(sbt, RL_C, 0, k0, lane), ldfrag(st + RS_RT, RL_C, 0, k0, lane), ya, 0, 0, 0);
                {
                    const int row = ((const LAS int*)(lds + RC_ROWS))[sb * 16 + r16];
                    u32x2 o; o.x = pk2(ya[0], ya[1]); o.y = pk2(ya[2], ya[3]);
                    *(u32x2*)(Y + (size_t)row * D + 512 + h * 64 + half * 32 + wid * 16 + 4 * q) = o;
                }
                asm volatile("s_waitcnt lgkmcnt(0)" ::: "memory");
#pragma unroll
                for (int kt = 0; kt < 4; ++kt) {
                    const f32x4 a = __builtin_amdgcn_mfma_f32_16x16x32_bf16(ldfrag(st + RS_KBH, RL_32, kt * 16, 0, lane), vuf, (f32x4){0.f, 0.f, 0.f, 0.f}, 0, 0, 0);
                    const f32x4 gl = *(const LAS f32x4*)((const LAS float*)(st + RS_GL) + kt * 16 + 4 * q);
#pragma unroll
                    for (int j = 0; j < 4; ++j) sacc[kt][j] = sacc[kt][j] * gl[j] + a[j];
                    st4bf(sbt + r16 * RL_C + (kt * 16 + 4 * q) * 2, sacc[kt]);
                }
                asm volatile("s_waitcnt lgkmcnt(0)" ::: "memory");
            }
        }
        __syncthreads();
    }
}

__device__ __forceinline__ float allreduce8(float v) {
    v += dppmov<0xB1>(v); v += dppmov<0x4E>(v); v += dppmov<0x141>(v);
    return v;
}
__device__ __forceinline__ void scan_rwkv2(int wv, KP Pk, int layer, int unit, LAS char* lds) {
    asm volatile("" : "+s"(Pk));
    const CAS Params& P = *Pk;
    const int tid = ltid(wv);
    const int seq = unit >> 1, half = unit & 1, b = seq >> 4, h = (seq >> 1) & 7, dir = seq & 1;
    (void)layer;
    LAS float* bufs = (LAS float*)lds;
    bf16_t* Y = (bf16_t*)(P.ws + (dir ? WS_YB : WS_YF));
    const float* dec = (const float*)(P.ws + WS_RWDEC) + (size_t)dir * NROWS * 512;
    const unsigned char* const wsb = P.ws;
    const bool stager = tid >= 256;
    auto stage = [&](int c) {
        int tl = tid - 256; asm volatile("" : "+v"(tl));
        LAS float* buf = bufs + (c & 1) * RW_BUF;
        u32x4 rc[7];
#pragma unroll
        for (int s = 0; s < 7; ++s) {
            const int task = tl + 256 * s, j = task / 52, g = task - 52 * j;
            rc[s] = (u32x4){0u, 0u, 0u, 0u};
            if (task < TCH * 52) {
                const int row = scan_row(c * TCH + j, b, dir, 1);
                const unsigned char* p;
                if (g < 8)       p = wsb + WS_RWR  + ((size_t)row * 512 + h * 64 + 8 * g) * 2;
                else if (g < 16) p = wsb + WS_RWK  + ((size_t)row * 512 + h * 64 + 8 * (g - 8)) * 2;
                else if (g < 24) p = wsb + WS_RWKK + ((size_t)row * 512 + h * 64 + 8 * (g - 16)) * 2;
                else if (g < 32) p = wsb + WS_RWB  + ((size_t)row * 512 + h * 64 + 8 * (g - 24)) * 2;
                else if (g < 36) p = wsb + WS_RWV  + ((size_t)row * 512 + h * 64 + half * 32 + 8 * (g - 32)) * 2;
                else             p = (const unsigned char*)(dec + (size_t)row * 512 + h * 64 + 4 * (g - 36));
                rc[s] = *(const u32x4*)p;
            }
        }
        if (tl < TCH) ((LAS int*)buf)[TCH * RW_F + tl] = scan_row(c * TCH + tl, b, dir, 1);
#pragma unroll
        for (int s = 0; s < 7; ++s) {
            const int task = tl + 256 * s, j = task / 52, g = task - 52 * j;
            if (task < TCH * 52) {
                const int lo = g < 8 ? 256 + 8 * g : g < 16 ? 192 + 8 * (g - 8) : g < 24 ? 64 + 8 * (g - 16) : g < 32 ? 128 + 8 * (g - 24) : g < 36 ? 320 + 8 * (g - 32) : 4 * (g - 36);
                LAS float* dst = buf + j * RW_F + lo;
                if (g >= 36) *(LAS u32x4*)dst = rc[s];
                else {
                    float f[8]; unpack8(rc[s], f);
                    const float sg = (g >= 16 && g < 24) ? -1.f : 1.f;
                    *(LAS f32x4*)dst = (f32x4){sg * f[0], sg * f[1], sg * f[2], sg * f[3]}; *(LAS f32x4*)(dst + 4) = (f32x4){sg * f[4], sg * f[5], sg * f[6], sg * f[7]};
                }
            }
        }
    };
    const int vrow = (tid >> 3) & 31, q8 = tid & 7;
    float S[8];
#pragma unroll
    for (int e = 0; e < 8; ++e) S[e] = 0.f;
    if (stager) stage(0);
    __syncthreads();
    for (int c = 0; c < NCHUNK; ++c) {
        if (stager) { if (c + 1 < NCHUNK) stage(c + 1); }
        else {
            const LAS float* buf = bufs + (c & 1) * RW_BUF;
            const LAS float* wp = buf + 4 * q8;
            const LAS float* vp = buf + 320 + vrow;
            f32x4 w0 = *(const LAS f32x4*)wp, w1 = *(const LAS f32x4*)(wp + 32), a0 = *(const LAS f32x4*)(wp + 64), a1 = *(const LAS f32x4*)(wp + 96), b0 = *(const LAS f32x4*)(wp + 128), b1 = *(const LAS f32x4*)(wp + 160),
                  k0 = *(const LAS f32x4*)(wp + 192), k1 = *(const LAS f32x4*)(wp + 224), r0 = *(const LAS f32x4*)(wp + 256), r1 = *(const LAS f32x4*)(wp + 288);
            float vr = vp[0];
            float ysel = 0.f;
#pragma unroll 2
            for (int jj = 0; jj < TCH; ++jj) {
                const f32x4 wc0 = w0, wc1 = w1, ac0 = a0, ac1 = a1, bc0 = b0, bc1 = b1, kc0 = k0, kc1 = k1, rc0 = r0, rc1 = r1; const float vv = vr;
                if (jj + 1 < TCH) {
                    const LAS float* np = wp + (jj + 1) * RW_F;
                    w0 = *(const LAS f32x4*)np; w1 = *(const LAS f32x4*)(np + 32); a0 = *(const LAS f32x4*)(np + 64); a1 = *(const LAS f32x4*)(np + 96); b0 = *(const LAS f32x4*)(np + 128); b1 = *(const LAS f32x4*)(np + 160);
                    k0 = *(const LAS f32x4*)(np + 192); k1 = *(const LAS f32x4*)(np + 224); r0 = *(const LAS f32x4*)(np + 256); r1 = *(const LAS f32x4*)(np + 288); vr = vp[(jj + 1) * RW_F];
                }
                float sa = 0.f;
#pragma unroll
                for (int e = 0; e < 4; ++e) sa += S[e] * ac0[e] + S[4 + e] * ac1[e];
                sa = allreduce8(sa);
                float y = 0.f;
#pragma unroll
                for (int e = 0; e < 4; ++e) {
                    S[e] = S[e] * wc0[e] + (sa * bc0[e] + vv * kc0[e]); y += S[e] * rc0[e];
                    S[4 + e] = S[4 + e] * wc1[e] + (sa * bc1[e] + vv * kc1[e]); y += S[4 + e] * rc1[e];
                }
                y = allreduce8(y);
                ysel = (q8 == (jj & 7)) ? y : ysel;
                if ((jj & 7) == 7) {
                    const int row = ((const LAS int*)buf)[TCH * RW_F + (jj - 7) + q8];
                    Y[(size_t)row * D + 512 + h * 64 + half * 32 + vrow] = f2bf(ysel);
                }
            }
        }
        __syncthreads();
    }
}
__device__ __forceinline__ void scan_hgrn2(int wv, KP Pk, int layer, int unit, LAS char* lds) {
    asm volatile("" : "+s"(Pk));
    const CAS Params& P = *Pk;
    const int tid = ltid(wv), i_ = layer >> 1;
    const int seq = unit >> 2, quarter = unit & 3, b = seq >> 3, h = (seq >> 1) & 3, dir = seq & 1;
    LAS float* cst = (LAS float*)lds;
    LAS float* bufs = cst + 256;
    const bf16_t* Pb = (const bf16_t*)(P.ws + WS_P);
    bf16_t* Y = (bf16_t*)(P.ws + (dir ? WS_YB : WS_YF));
    if (tid < 128) cst[tid] = ((const float*)(P.ws + WS_LB))[layer * 512 + h * 128 + tid];
    else if (tid < 256) cst[tid] = P.hg_f_bias[(size_t)(i_ * 2 + dir) * 512 + h * 128 + tid - 128];
    const bool stager = tid >= 256;
    auto stage = [&](int c) {
        int tl = tid - 256; asm volatile("" : "+v"(tl));
        LAS float* buf = bufs + (c & 1) * HG_BUF;
        u32x4 rc[5];
#pragma unroll
        for (int s = 0; s < 5; ++s) {
            const int task = tl + 256 * s, j = task / 36, g = task - 36 * j;
            rc[s] = (u32x4){0u, 0u, 0u, 0u};
            if (task < TCH * 36) {
                const int row = scan_row(c * TCH + j, b, dir, 1);
                const int col = g < 16 ? (512 + dir * 512 + h * 128 + 8 * g) : g < 32 ? (h * 128 + 8 * (g - 16)) : (1536 + h * 128 + quarter * 32 + 8 * (g - 32));
                rc[s] = *(const u32x4*)(Pb + (size_t)row * LDP_ODD + col);
            }
        }
        if (tl < TCH) ((LAS int*)buf)[TCH * HG_F + tl] = scan_row(c * TCH + tl, b, dir, 1);
#pragma unroll
        for (int s = 0; s < 5; ++s) {
            const int task = tl + 256 * s, j = task / 36, g = task - 36 * j;
            if (task < TCH * 36) {
                float fc[8], o[8]; unpack8(rc[s], fc);
                const int lc = g * 8;
                if (g < 16) {
#pragma unroll
                    for (int e = 0; e < 8; ++e) { const float lbv = cst[lc + e]; o[e] = lbv + (1.f - lbv) * sigmoidf_(fc[e] + cst[128 + lc + e]); }
                } else if (g < 32) {
#pragma unroll
                    for (int e = 0; e < 8; ++e) o[e] = siluf_(fc[e]);
                } else {
#pragma unroll
                    for (int e = 0; e < 8; ++e) o[e] = fc[e];
                }
                LAS float* dst = buf + j * HG_F + lc;
                *(LAS f32x4*)dst = (f32x4){o[0], o[1], o[2], o[3]}; *(LAS f32x4*)(dst + 4) = (f32x4){o[4], o[5], o[6], o[7]};
            }
        }
    };
    const int col = (tid >> 3) & 31, q8 = tid & 7;
    float S[16];
#pragma unroll
    for (int e = 0; e < 16; ++e) S[e] = 0.f;
    __syncthreads();
    if (stager) stage(0);
    __syncthreads();
    for (int c = 0; c < NCHUNK; ++c) {
        if (stager) { if (c + 1 < NCHUNK) stage(c + 1); }
        else {
            const LAS float* buf = bufs + (c & 1) * HG_BUF;
            const LAS float* fp = buf + 4 * q8;
            const LAS float* vp = buf + 256 + col;
            f32x4 f[4], qv[4]; float vr = vp[0];
#pragma unroll
            for (int m = 0; m < 4; ++m) { f[m] = *(const LAS f32x4*)(fp + 32 * m); qv[m] = *(const LAS f32x4*)(fp + 128 + 32 * m); }
            float ysel = 0.f;
#pragma unroll 2
            for (int jj = 0; jj < TCH; ++jj) {
                f32x4 fc[4], qc[4]; const float vv = vr;
#pragma unroll
                for (int m = 0; m < 4; ++m) { fc[m] = f[m]; qc[m] = qv[m]; }
                if (jj + 1 < TCH) {
                    const LAS float* np = fp + (jj + 1) * HG_F;
#pragma unroll
                    for (int m = 0; m < 4; ++m) { f[m] = *(const LAS f32x4*)(np + 32 * m); qv[m] = *(const LAS f32x4*)(np + 128 + 32 * m); }
                    vr = vp[(jj + 1) * HG_F];
                }
                float o = 0.f;
#pragma unroll
                for (int m = 0; m < 4; ++m)
#pragma unroll
                    for (int e = 0; e < 4; ++e) { S[4 * m + e] = fc[m][e] * (S[4 * m + e] - vv) + vv; o += qc[m][e] * S[4 * m + e]; }
                o = allreduce8(o);
                ysel = (q8 == (jj & 7)) ? o : ysel;
                if ((jj & 7) == 7) {
                    const int row = ((const LAS int*)buf)[TCH * HG_F + (jj - 7) + q8];
                    Y[(size_t)row * D + h * 128 + quarter * 32 + col] = f2bf(ysel);
                }
            }
        }
        __syncthreads();
    }
}

__device__ __forceinline__ void phase_prep1(int wv, KP Pk, int layer) {
    asm volatile("" : "+s"(Pk));
    const CAS Params& P = *Pk;
    const int tid = ltid(wv), lane = tid & 63, wid = tid >> 6, i_ = layer >> 1;
    const bf16_t* Pb = (const bf16_t*)(P.ws + WS_P);
    bf16_t* R = (bf16_t*)(P.ws + WS_RWR); bf16_t* K = (bf16_t*)(P.ws + WS_RWK); bf16_t* V = (bf16_t*)(P.ws + WS_RWV); bf16_t* KK = (bf16_t*)(P.ws + WS_RWKK);
    bf16_t* LA = (bf16_t*)(P.ws + WS_LA);
    const float* mu = P.rw_mu + (size_t)i_ * 1856;
    float mur[8], muv[8], muk[8], mul_[8], kkw[8];
#pragma unroll
    for (int e = 0; e < 8; ++e) { mur[e] = mu[8 * lane + e]; muv[e] = mu[1024 + 8 * lane + e]; muk[e] = mu[512 + 8 * lane + e]; mul_[e] = lane < 40 ? mu[1536 + 8 * lane + e] : 0.f; kkw[e] = P.rw_k_k[i_ * 512 + 8 * lane + e]; }
    for (int r = blockIdx.x * 8 + wid; r < NROWS; r += gridDim.x * 8) {
        int rprev = -1, rnext = -1;
        if (r < NCTX) { const int t = r & 255; if (t > 0) rprev = r - 1; if (t < CTXL - 1) rnext = r + 1; }
        else {
            const int bs = (r - NCTX) >> 13, s = (r - NCTX) & 8191, sg = ((s & 63) << 7) + (s >> 6);
            if (sg > 0) { const int g2 = sg - 1; rprev = NCTX + bs * SEQ + ((g2 & 127) << 6) + (g2 >> 7); }
            if (sg < SEQ - 1) { const int g2 = sg + 1; rnext = NCTX + bs * SEQ + ((g2 & 127) << 6) + (g2 >> 7); }
        }
        const bf16_t* pc = Pb + (size_t)r * LDP_ODD + 2560;
        const bf16_t* pp = Pb + (size_t)(rprev < 0 ? r : rprev) * LDP_ODD + 2560;
        const bf16_t* pn = Pb + (size_t)(rnext < 0 ? r : rnext) * LDP_ODD + 2560;
        const float mp = rprev < 0 ? 0.f : 0.5f, mn = rnext < 0 ? 0.f : 0.5f;
        auto mix8 = [&](int col, const float* muc, float* o) {
            float fc[8], fp[8], fn[8];
            unpack8(*(const u32x4*)(pc + col), fc); unpack8(*(const u32x4*)(pp + col), fp); unpack8(*(const u32x4*)(pn + col), fn);
#pragma unroll
            for (int e = 0; e < 8; ++e) o[e] = fc[e] + muc[e] * (mp * fp[e] + mn * fn[e] - fc[e]);
        };
        float o[8];
        mix8(8 * lane, mur, o); *(u32x4*)(R + (size_t)r * 512 + 8 * lane) = pack8(o);
        mix8(1024 + 8 * lane, muv, o); *(u32x4*)(V + (size_t)r * 512 + 8 * lane) = pack8(o);
        mix8(512 + 8 * lane, muk, o); *(u32x4*)(K + (size_t)r * 512 + 8 * lane) = pack8(o);
        {
            float kk[8], ss = 0.f;
#pragma unroll
            for (int e = 0; e < 8; ++e) { kk[e] = o[e] * kkw[e]; ss += kk[e] * kk[e]; }
            ss = group_sum<8>(ss);
            const float rn = rsqrtf(fmaxf(ss, 1e-12f));
#pragma unroll
            for (int e = 0; e < 8; ++e) kk[e] *= rn;
            *(u32x4*)(KK + (size_t)r * 512 + 8 * lane) = pack8(kk);
        }
        if (lane < 40) {
            mix8(1536 + 8 * lane, mul_, o);
            if (lane < 16) {
#pragma unroll
                for (int e = 0; e < 8; ++e) o[e] = tanh_fast(o[e]);
            } else if (lane >= 24) {
#pragma unroll
                for (int e = 0; e < 8; ++e) o[e] = sigmoidf_(o[e]);
            }
            *(u32x4*)(LA + (size_t)r * 320 + 8 * lane) = pack8(o);
        }
    }
}

__device__ __forceinline__ void phase_out_even(int wv, KP Pk, int layer) {
    asm volatile("" : "+s"(Pk));
    const CAS Params& P = *Pk;
    const int tid = ltid(wv), lane = tid & 63, wid = tid >> 6, i_ = layer >> 1;
    const bf16_t* Pb = (const bf16_t*)(P.ws + WS_P);
    const bf16_t* Yf = (const bf16_t*)(P.ws + WS_YF); const bf16_t* Yb = (const bf16_t*)(P.ws + WS_YB);
    bf16_t* feat = (bf16_t*)(P.ws + WS_FEAT);
    const int r0 = (layer == DEPTH - 1) ? NCTX : 0;
    const bf16_t* XBC = (const bf16_t*)(P.ws + WS_EXBC);
    float nwa[8], nwb[8];
#pragma unroll
    for (int e = 0; e < 8; ++e) { nwa[e] = P.ssd_norm_w[i_ * 512 + 8 * lane + e]; nwb[e] = P.ml_norm_w[i_ * 512 + 8 * lane + e]; }
    const float dsk = P.ssd_d[i_ * 8 + (lane >> 3)];
    for (int r = r0 + blockIdx.x * 8 + wid; r < NROWS; r += gridDim.x * 8) {
        const bf16_t* pr = Pb + (size_t)r * LDP_EVEN;
        float y[8];
        {
            float a[8], bb[8], xsv[8], z[8];
            unpack8(*(const u32x4*)(Yf + (size_t)r * D + 8 * lane), a); unpack8(*(const u32x4*)(Yb + (size_t)r * D + 8 * lane), bb);
            unpack8(*(const u32x4*)(XBC + (size_t)r * 768 + 8 * lane), xsv); unpack8(*(const u32x4*)(pr + 8 * lane), z);
            float ss = 0.f;
#pragma unroll
            for (int e = 0; e < 8; ++e) {
                y[e] = (a[e] + bb[e] + dsk * xsv[e]) * siluf_(z[e]); ss += y[e] * y[e];
            }
            ss = wave_sum(ss);
            const float rn = rsqrtf(ss * (1.f / 512.f) + 1e-6f);
#pragma unroll
            for (int e = 0; e < 8; ++e) y[e] = y[e] * rn * nwa[e];
            *(u32x4*)(feat + (size_t)r * D + 8 * lane) = pack8(y);
        }
        {
            float a[8], bb[8], o[8];
            unpack8(*(const u32x4*)(Yf + (size_t)r * D + 512 + 8 * lane), a); unpack8(*(const u32x4*)(Yb + (size_t)r * D + 512 + 8 * lane), bb);
            unpack8(*(const u32x4*)(pr + 2320 + 8 * lane), o);
            float s = 0.f;
#pragma unroll
            for (int e = 0; e < 8; ++e) { y[e] = a[e] + bb[e]; s += y[e]; }
            const float mean = group_sum<16>(s) * (1.f / 128.f);
            float ss = 0.f;
#pragma unroll
            for (int e = 0; e < 8; ++e) { y[e] -= mean; ss += y[e] * y[e]; }
            const float rn = rsqrtf(group_sum<16>(ss) * (1.f / 128.f) + 1e-6f);
#pragma unroll
            for (int e = 0; e < 8; ++e) y[e] = sigmoidf_(o[e]) * (y[e] * rn) * nwb[e];
            *(u32x4*)(feat + (size_t)r * D + 512 + 8 * lane) = pack8(y);
        }
    }
}
__device__ __forceinline__ void phase_out_odd(int wv, KP Pk, int layer) {
    asm volatile("" : "+s"(Pk));
    const CAS Params& P = *Pk;
    const int tid = ltid(wv), lane = tid & 63, wid = tid >> 6, i_ = layer >> 1;
    const bf16_t* Pb = (const bf16_t*)(P.ws + WS_P);
    const bf16_t* Yf = (const bf16_t*)(P.ws + WS_YF); const bf16_t* Yb = (const bf16_t*)(P.ws + WS_YB);
    const bf16_t* R = (const bf16_t*)(P.ws + WS_RWR); const bf16_t* K = (const bf16_t*)(P.ws + WS_RWK); const bf16_t* V = (const bf16_t*)(P.ws + WS_RWV); const bf16_t* G = (const bf16_t*)(P.ws + WS_RWG);
    bf16_t* feat = (bf16_t*)(P.ws + WS_FEAT);
    const int r0 = (layer == DEPTH - 1) ? NCTX : 0;
    float nwc[8], rk[8], lw[8], lbv[8];
#pragma unroll
    for (int e = 0; e < 8; ++e) {
        nwc[e] = P.hg_norm_w[i_ * 512 + 8 * lane + e]; rk[e] = P.rw_r_k[i_ * 512 + 8 * lane + e];
        lw[e] = P.rw_ln_w[i_ * 512 + 8 * lane + e]; lbv[e] = P.rw_ln_b[i_ * 512 + 8 * lane + e];
    }
    for (int r = r0 + blockIdx.x * 8 + wid; r < NROWS; r += gridDim.x * 8) {
        float y[8];
        {
            float a[8], bb[8], g[8];
            unpack8(*(const u32x4*)(Yf + (size_t)r * D + 8 * lane), a); unpack8(*(const u32x4*)(Yb + (size_t)r * D + 8 * lane), bb);
            unpack8(*(const u32x4*)(Pb + (size_t)r * LDP_ODD + 2048 + 8 * lane), g);
            float ss = 0.f;
#pragma unroll
            for (int e = 0; e < 8; ++e) { y[e] = a[e] + bb[e]; ss += y[e] * y[e]; }
            const float rn = rsqrtf(group_sum<16>(ss) * (1.f / 128.f) + 1e-6f);
#pragma unroll
            for (int e = 0; e < 8; ++e) y[e] = y[e] * rn * nwc[e] * siluf_(g[e]);
            *(u32x4*)(feat + (size_t)r * D + 8 * lane) = pack8(y);
        }
        {
            float a[8], bb[8], rr[8], kk[8], vv[8], g[8];
            unpack8(*(const u32x4*)(Yf + (size_t)r * D + 512 + 8 * lane), a); unpack8(*(const u32x4*)(Yb + (size_t)r * D + 512 + 8 * lane), bb);
            unpack8(*(const u32x4*)(R + (size_t)r * 512 + 8 * lane), rr); unpack8(*(const u32x4*)(K + (size_t)r * 512 + 8 * lane), kk);
            unpack8(*(const u32x4*)(V + (size_t)r * 512 + 8 * lane), vv); unpack8(*(const u32x4*)(G + (size_t)r * 512 + 8 * lane), g);
            float s = 0.f, bs = 0.f;
#pragma unroll
            for (int e = 0; e < 8; ++e) { y[e] = a[e] + bb[e]; s += y[e]; bs += rr[e] * kk[e] * rk[e]; }
            const float mean = group_sum<8>(s) * (1.f / 64.f); bs = group_sum<8>(bs);
            float ss = 0.f;
#pragma unroll
            for (int e = 0; e < 8; ++e) { y[e] -= mean; ss += y[e] * y[e]; }
            const float rn = rsqrtf(group_sum<8>(ss) * (1.f / 64.f) + 64e-5f);
#pragma unroll
            for (int e = 0; e < 8; ++e) y[e] = (y[e] * rn * lw[e] + lbv[e] + bs * vv[e]) * g[e];
            *(u32x4*)(feat + (size_t)r * D + 512 + 8 * lane) = pack8(y);
        }
    }
}

#ifndef MK_DOUBLE
#define MK_DOUBLE 0
#endif
#define REP(bit, body) do { body; if (MK_DOUBLE & (bit)) { body; } } while (0)
__device__ __forceinline__ void phase_expconv(int wv, KP Pk, int layer, LAS char* lds) {
    asm volatile("" : "+s"(Pk));
    const CAS Params& P = *Pk;
    const int tid = ltid(wv), lane = tid & 63, wid = tid >> 6;
    {
        LAS float* scr = (LAS float*)(lds + wid * 8448);
        const int gw = blockIdx.x * 8 + wid, NGW = gridDim.x * 8;
        bf16_t* gu = (bf16_t*)(P.ws + WS_EXPGU); bf16_t* dw = (bf16_t*)(P.ws + WS_EXPD);
        constexpr int IG = 16 * 16, IDN = 8 * 32;
        for (int it = gw; it < NEXP * (2 * IG + IDN); it += NGW) {
            const int e = it / (2 * IG + IDN); int r = it % (2 * IG + IDN);
            const size_t eo = (size_t)(layer * NEXP + e);
            if (r < IG) { transpose_item(P.exp_w_gate + eo * D * DEXP, D, DEXP, gu + (size_t)e * 1024 * 1024, 1, scr, r, lane); continue; } r -= IG;
            if (r < IG) { transpose_item(P.exp_w_up + eo * D * DEXP, D, DEXP, gu + (size_t)e * 1024 * 1024, 2, scr, r, lane); continue; } r -= IG;
            transpose_item(P.exp_w_down + eo * DEXP * D, DEXP, D, dw + (size_t)e * 1024 * 512, 0, scr, r, lane);
        }
    }
}
__device__ __forceinline__ void phase_ln1(int wv, KP Pk, int layer, LAS char* lds, bool dry = false) {
    asm volatile("" : "+s"(Pk));
    const CAS Params& P = *Pk;
    const int tid = ltid(wv), lane = tid & 63, wid = tid >> 6;
    if (!dry) REP(8, phase_expconv(wv, Pk, layer, lds));
    __syncthreads();
    LAS float* rwT = (LAS float*)lds;
    LAS float* scs = (LAS float*)(lds + 32 * 1024 * 4) + wid * 32;
    LAS int* lcnt = (LAS int*)(lds + 32 * 1024 * 4 + 1024);
    LAS int* lbase = lcnt + 32;
    LAS int* asg = lcnt + 64;
    if (tid < 32) lcnt[tid] = 0;
    for (int i = tid; i < D * NEXP; i += NT) { const int col = i >> 5, e = i & 31; rwT[e * 1024 + col] = P.router_w[i]; }
    __syncthreads();
    const bf16_t* yo = (const bf16_t*)(P.ws + WS_YO);
    bf16_t* act = (bf16_t*)(P.ws + (dry ? WS_FEAT : WS_ACT));
    float* xc = (float*)(P.ws + WS_XC);
    int* cnt = (int*)(P.ws + WS_CNT) + layer * 32 * CNT_STRIDE;
    int* list = (int*)(P.ws + WS_LIST);
    float* wts = (float*)(P.ws + WS_WTS);
    const float* lg = P.ln_g + (size_t)(layer * 2 + 0) * D; const float* lb = P.ln_b + (size_t)(layer * 2 + 0) * D;
    const int r0 = (layer == DEPTH - 1) ? NCTX : 0, stride = gridDim.x * 8;
    f32x4 g1v[4], s2c[4], h2c[4];
#pragma unroll
    for (int i = 0; i < 4; ++i) g1v[i] = s2c[i] = h2c[i] = (f32x4){0.f, 0.f, 0.f, 0.f};
    LAS float* rbias = (LAS float*)(asg + 2 * 136);
    if (tid < 32) rbias[tid] = P.router_bias[tid];
    __syncthreads();
    int mcur = -1;
    f32x4 nx[4]; u32x2 nyo[4];
    auto fetch = [&](int rr) {
        const float* xq = rr < NCTX ? xc + (size_t)rr * D : P.out + (size_t)(rr - NCTX) * D;
#pragma unroll
        for (int i = 0; i < 4; ++i) { const int c = 4 * lane + 256 * i; nx[i] = *(const f32x4*)(xq + c); nyo[i] = *(const u32x2*)(yo + (size_t)rr * D + c); }
    };
    for (int r = r0 + blockIdx.x * 8 + wid; r < NROWS; r += stride) {
        fetch(r);
        const int m = row_mod(r);
        float* xr = r < NCTX ? xc + (size_t)r * D : P.out + (size_t)(r - NCTX) * D;
        if (m != mcur) {
            mcur = m;
            const float* g1 = modvec(P.ws, layer, m, 2); const float* sh2 = modvec(P.ws, layer, m, 3); const float* sc2 = modvec(P.ws, layer, m, 4);
#pragma unroll
            for (int i = 0; i < 4; ++i) { const int c = 4 * lane + 256 * i; g1v[i] = *(const f32x4*)(g1 + c); s2c[i] = *(const f32x4*)(sc2 + c); h2c[i] = *(const f32x4*)(sh2 + c); }
        }
        f32x4 v[4]; float s = 0.f;
#pragma unroll
        for (int i = 0; i < 4; ++i) {
            const f32x4 xv = nx[i], gv = g1v[i]; const u32x2 yv = nyo[i];
            v[i][0] = ALPHA * xv[0] + gv[0] * bflo(yv.x); v[i][1] = ALPHA * xv[1] + gv[1] * bfhi(yv.x);
            v[i][2] = ALPHA * xv[2] + gv[2] * bflo(yv.y); v[i][3] = ALPHA * xv[3] + gv[3] * bfhi(yv.y);
            s += (v[i][0] + v[i][1]) + (v[i][2] + v[i][3]);
        }
        const float mean = wave_sum(s) * (1.f / D);
        float s2 = 0.f;
#pragma unroll
        for (int i = 0; i < 4; ++i) { v[i] = v[i] - mean; s2 += (v[i][0] * v[i][0] + v[i][1] * v[i][1]) + (v[i][2] * v[i][2] + v[i][3] * v[i][3]); }
        const float rstd = rsqrtf(wave_sum(s2) * (1.f / D) + 1e-5f);
        float acc[32];
#pragma unroll
        for (int e = 0; e < 32; ++e) acc[e] = 0.f;
#pragma unroll
        for (int i = 0; i < 4; ++i) {
            const int c = 4 * lane + 256 * i;
            const f32x4 gg = *(const f32x4*)(lg + c), bb = *(const f32x4*)(lb + c), s2v = s2c[i], h2v = h2c[i];
            f32x4 xn, hv;
#pragma unroll
            for (int j = 0; j < 4; ++j) { xn[j] = v[i][j] * rstd * gg[j] + bb[j]; hv[j] = xn[j] * (1.f + s2v[j]) + h2v[j]; }
            *(f32x4*)((dry ? (float*)(P.ws + WS_YF) + (size_t)r * D : xr) + c) = xn;
            u32x2 o; o.x = pk2(hv[0], hv[1]); o.y = pk2(hv[2], hv[3]); *(u32x2*)(act + (size_t)r * D + c) = o;
#pragma unroll
            for (int e = 0; e < 32; ++e) { const f32x4 w = *(const LAS f32x4*)(rwT + e * 1024 + c); acc[e] += (hv[0] * w[0] + hv[1] * w[1]) + (hv[2] * w[2] + hv[3] * w[3]); }
        }
#pragma unroll
        for (int st = 0; st < 5; ++st) {
            const int half = 16 >> st, msk = 32 >> st;
            const bool up = (lane & msk) != 0;
#pragma unroll
            for (int j = 0; j < 16; ++j) {
                if (j < half) {
                    const float keep = up ? acc[j + half] : acc[j], send = up ? acc[j] : acc[j + half];
                    acc[j] = keep + __shfl_xor(send, msk);
                }
            }
        }
        acc[0] += __shfl_xor(acc[0], 1);
        {
            const int e = (lane >> 1) & 31;
            const int eidx = ((e >> 4) & 1) * 16 + ((e >> 3) & 1) * 8 + ((e >> 2) & 1) * 4 + ((e >> 1) & 1) * 2 + (e & 1);
            if ((lane & 1) == 0) scs[eidx] = acc[0];
        }
        asm volatile("s_waitcnt lgkmcnt(0)" ::: "memory");
        float best = -1e30f; int bg = 0;
#pragma unroll
        for (int g = 0; g < 8; ++g) {
            float m1 = -1e30f, m2 = -1e30f;
#pragma unroll
            for (int k = 0; k < 4; ++k) { const float vsc = sigmoidf_(scs[g * 4 + k]) + rbias[g * 4 + k]; if (vsc > m1) { m2 = m1; m1 = vsc; } else if (vsc > m2) m2 = vsc; }
            const float gs = m1 + m2;
            if (gs > best) { best = gs; bg = g; }
        }
        float sv[4], bv[4];
#pragma unroll
        for (int k = 0; k < 4; ++k) { sv[k] = sigmoidf_(scs[bg * 4 + k]); bv[k] = sv[k] + rbias[bg * 4 + k]; }
        int i1 = 0; float b1 = bv[0];
#pragma unroll
        for (int k = 1; k < 4; ++k) if (bv[k] > b1) { b1 = bv[k]; i1 = k; }
        int i2 = -1; float b2 = -1e30f;
#pragma unroll
        for (int k = 0; k < 4; ++k) if (k != i1 && bv[k] > b2) { b2 = bv[k]; i2 = k; }
        float s1 = sv[0], s2s = sv[0];
#pragma unroll
        for (int k = 1; k < 4; ++k) { if (i1 == k) s1 = sv[k]; if (i2 == k) s2s = sv[k]; }
        if (lane == 0 && !dry) {
            const int e0 = bg * 4 + i1, e1 = bg * 4 + i2;
            const float inv = 1.f / (s1 + s2s);
            const int li = ((r - r0 - blockIdx.x * 8 - wid) / (int)(gridDim.x * 8)) * 8 + wid;
            const int p0 = __hip_atomic_fetch_add(&lcnt[e0], 1, __ATOMIC_RELAXED, __HIP_MEMORY_SCOPE_WORKGROUP);
            const int p1 = __hip_atomic_fetch_add(&lcnt[e1], 1, __ATOMIC_RELAXED, __HIP_MEMORY_SCOPE_WORKGROUP);
            asg[2 * li] = (e0 << 16) | p0; asg[2 * li + 1] = (e1 << 16) | p1;
            wts[2 * r] = s1 * inv; wts[2 * r + 1] = s2s * inv;
        }
    }
    __syncthreads();
    if (dry) return;
    if (tid < 32) lbase[tid] = atomicAdd(&cnt[tid * CNT_STRIDE], lcnt[tid]);
    __syncthreads();
    for (int idx = tid; idx < 2 * 136; idx += NT) {
        const int li = idx >> 1, k = idx & 1, it = li >> 3, w = li & 7;
        const int r = r0 + blockIdx.x * 8 + w + it * (int)(gridDim.x * 8);
        if (r < NROWS) { const int v = asg[idx], e = v >> 16, lp = v & 0xffff; list[(size_t)e * LISTCAP + lbase[e] + lp] = 2 * r + k; }
    }
}

__device__ __forceinline__ void phase_ln2(int wv, KP Pk, int layer, bool dry = false) {
    asm volatile("" : "+s"(Pk));
    const CAS Params& P = *Pk;
    const int tid = ltid(wv), lane = tid & 63, wid = tid >> 6;
    const bf16_t* yp = (const bf16_t*)(P.ws + WS_YP);
    const float* wts = (const float*)(P.ws + WS_WTS);
    bf16_t* act = (bf16_t*)(P.ws + (dry ? WS_FEAT : WS_ACT));
    float* xc = (float*)(P.ws + WS_XC);
    const float* lg = P.ln_g + (size_t)(layer * 2 + 1) * D; const float* lb = P.ln_b + (size_t)(layer * 2 + 1) * D;
    const bool last = (layer == DEPTH - 1);
    const int r0 = last ? NCTX : 0, stride = gridDim.x * 8;
    f32x4 cg[4], cb[4], g2v[4], s1v[4], h1v[4];
#pragma unroll
    for (int i = 0; i < 4; ++i) { cg[i] = *(const f32x4*)(lg + 4 * lane + 256 * i); cb[i] = *(const f32x4*)(lb + 4 * lane + 256 * i); g2v[i] = s1v[i] = h1v[i] = (f32x4){0.f, 0.f, 0.f, 0.f}; }
    int mcur = -1;
    f32x4 nx[4]; u32x2 ny0[4], ny1[4]; float nw0 = 0.f, nw1 = 0.f;
    auto fetch = [&](int r) {
        const float* xr = r < NCTX ? xc + (size_t)r * D : P.out + (size_t)(r - NCTX) * D;
#pragma unroll
        for (int i = 0; i < 4; ++i) {
            const int c = 4 * lane + 256 * i;
            nx[i] = *(const f32x4*)(xr + c); ny0[i] = *(const u32x2*)(yp + (size_t)(2 * r) * D + c); ny1[i] = *(const u32x2*)(yp + (size_t)(2 * r + 1) * D + c);
        }
        nw0 = wts[2 * r]; nw1 = wts[2 * r + 1];
    };
    int r = r0 + blockIdx.x * 8 + wid;
    if (r < NROWS) fetch(r);
    for (; r < NROWS; r += stride) {
        const int m = row_mod(r);
        float* xr = r < NCTX ? xc + (size_t)r * D : P.out + (size_t)(r - NCTX) * D;
        if (m != mcur) {
            mcur = m;
            const float* g2 = modvec(P.ws, layer, m, 5); const float* sh1 = last ? lg : modvec(P.ws, layer + 1, m, 0); const float* sc1 = last ? lg : modvec(P.ws, layer + 1, m, 1);
#pragma unroll
            for (int i = 0; i < 4; ++i) { const int c = 4 * lane + 256 * i; g2v[i] = *(const f32x4*)(g2 + c); s1v[i] = *(const f32x4*)(sc1 + c); h1v[i] = *(const f32x4*)(sh1 + c); }
        }
        f32x4 v[4]; float s = 0.f;
        const float w0 = nw0, w1 = nw1;
#pragma unroll
        for (int i = 0; i < 4; ++i) {
            const f32x4 xv = nx[i], gv = g2v[i]; const u32x2 y0 = ny0[i], y1 = ny1[i];
            v[i][0] = ALPHA * xv[0] + gv[0] * (w0 * bflo(y0.x) + w1 * bflo(y1.x)); v[i][1] = ALPHA * xv[1] + gv[1] * (w0 * bfhi(y0.x) + w1 * bfhi(y1.x));
            v[i][2] = ALPHA * xv[2] + gv[2] * (w0 * bflo(y0.y) + w1 * bflo(y1.y)); v[i][3] = ALPHA * xv[3] + gv[3] * (w0 * bfhi(y0.y) + w1 * bfhi(y1.y));
            s += (v[i][0] + v[i][1]) + (v[i][2] + v[i][3]);
        }
        if (r + stride < NROWS) fetch(r + stride);
        const float mean = wave_sum(s) * (1.f / D);
        float s2 = 0.f;
#pragma unroll
        for (int i = 0; i < 4; ++i) { v[i] = v[i] - mean; s2 += (v[i][0] * v[i][0] + v[i][1] * v[i][1]) + (v[i][2] * v[i][2] + v[i][3] * v[i][3]); }
        const float rstd = rsqrtf(wave_sum(s2) * (1.f / D) + 1e-5f);
#pragma unroll
        for (int i = 0; i < 4; ++i) {
            const int c = 4 * lane + 256 * i;
            f32x4 xn;
#pragma unroll
            for (int j = 0; j < 4; ++j) xn[j] = v[i][j] * rstd * cg[i][j] + cb[i][j];
            *(f32x4*)((dry ? (float*)(P.ws + WS_YF) + (size_t)r * D : xr) + c) = xn;
            if (!last) {
                u32x2 o; o.x = pk2(xn[0] * (1.f + s1v[i][0]) + h1v[i][0], xn[1] * (1.f + s1v[i][1]) + h1v[i][1]); o.y = pk2(xn[2] * (1.f + s1v[i][2]) + h1v[i][2], xn[3] * (1.f + s1v[i][3]) + h1v[i][3]);
                *(u32x2*)(act + (size_t)r * D + c) = o;
            }
        }
    }
}

constexpr int NPHASE = 2 + 11 * DEPTH;
__global__ void __launch_bounds__(NT, 2) fwd_kernel(Params P) {
    extern __shared__ __attribute__((aligned(16))) char lds_raw[];
    LAS char* lds = (LAS char*)lds_raw;
    volatile LAS unsigned* xbw = (volatile LAS unsigned*)(lds + LDS_BYTES - 16);
    KP Pk = (KP)__builtin_amdgcn_kernarg_segment_ptr();
    const int wv = __builtin_amdgcn_readfirstlane((int)(threadIdx.x >> 6));
    const bool multi = (P.ph_hi - P.ph_lo) > 1;
    XcdBarrier bar; bar.bar = (unsigned*)(P.ws + WS_BAR); bar.x = 0; bar.st = xbw;
    if (multi) {
        if (ltid(wv) == 0) { xbw[0] = 0u; xbw[1] = 0u; xbw[2] = 0u; xbw[3] = 0u; }
        __syncthreads();
        bar = xcd_barrier_post(wv, (unsigned*)(P.ws + WS_BAR), xbw);
    }
#define PHASE(id, body) do { if (P.ph_lo <= (id) && (id) < P.ph_hi) { body; if ((id) + 1 < P.ph_hi) xcd_barrier(wv, bar); if (MK_DOUBLE & 2048) xcd_barrier(wv, bar); } } while (0)
    PHASE(0, REP(16, phase_prologue0(wv, Pk, lds)));
    PHASE(1, REP(16, phase_prologue1(wv, Pk)));
    for (int l = 0; l < DEPTH; ++l) {
        const int pb = 2 + 11 * l, odd = l & 1;
        PHASE(pb + 0, REP(1, phase_inproj(wv, Pk, l, lds)));
        if (odd) {
            PHASE(pb + 1, REP(4, phase_prep1(wv, Pk, l)));
            PHASE(pb + 2, phase_prep2(wv, Pk, l, lds));
            PHASE(pb + 3, REP(32, { if (blockIdx.x < 128) REP(64, scan_hgrn_c(wv, Pk, l, blockIdx.x, lds)); else if (blockIdx.x < 256) REP(128, scan_rwkv(wv, Pk, l, blockIdx.x - 128, lds)); }));
            PHASE(pb + 5, REP(4, phase_out_odd(wv, Pk, l)));
        } else {
            PHASE(pb + 1, REP(4, phase_prep_even(wv, Pk, l)));
            PHASE(pb + 2, REP(2, phase_ex1(wv, Pk, l, lds)));
            PHASE(pb + 3, phase_ex2(wv, Pk, l));
            PHASE(pb + 4, REP(2, phase_ex3(wv, Pk, l, lds)));
            PHASE(pb + 5, REP(4, phase_out_even(wv, Pk, l)));
        }
        PHASE(pb + 6, REP(256, phase_outproj(wv, Pk, l, lds)));
        PHASE(pb + 7, { if (MK_DOUBLE & 4096) phase_ln1(wv, Pk, l, lds, true); phase_ln1(wv, Pk, l, lds); });
        PHASE(pb + 8, REP(512, phase_moe1(wv, Pk, l, lds)));
        PHASE(pb + 9, REP(1024, phase_moe2(wv, Pk, l, lds)));
        PHASE(pb + 10, { if (MK_DOUBLE & 8192) phase_ln2(wv, Pk, l, true); phase_ln2(wv, Pk, l); });
    }
#undef PHASE
}


#ifndef MK_STOP
#define MK_STOP NPHASE
#endif
#ifndef MK_DUMP
#define MK_DUMP 0
#endif
#ifndef MK_DUMP_N
#define MK_DUMP_N (1u << 30)
#endif
#ifndef MK_DUMP_LD
#define MK_DUMP_LD 1024
#endif
#ifndef MK_DUMP_C0
#define MK_DUMP_C0 0
#endif
__global__ void diff_kernel(const bf16_t* a, const bf16_t* b, float* out, size_t n) {
    for (size_t i = (size_t)blockIdx.x * blockDim.x + threadIdx.x; i < n; i += (size_t)gridDim.x * blockDim.x) out[i] = 1e6f * (bf2f(a[i]) - bf2f(b[i]));
}
__global__ void dump_kernel(const bf16_t* src, float* out, size_t n) {
    for (size_t i = (size_t)blockIdx.x * blockDim.x + threadIdx.x; i < n; i += (size_t)gridDim.x * blockDim.x) out[i] = i < (size_t)MK_DUMP_N ? bf2f(src[(i >> 10) * MK_DUMP_LD + MK_DUMP_C0 + (i & 1023)]) : 0.f;
}
extern "C" void kernel_launch(void* const* d_in, const int* in_sizes, int n_in, void* d_out, int out_size, void* d_ws, size_t ws_size, hipStream_t stream) {
    static int ready = 0;
    if (ready == 0) {
        ready = 1;
        if (n_in != 42 || out_size != NB * SEQ * D || ws_size < WS_END) { fprintf(stderr, "kernel_launch: unexpected shapes (n_in %d out %d ws %zu need %zu)\n", n_in, out_size, ws_size, (size_t)WS_END); ready = -1; }
        if (hipFuncSetAttribute((const void*)fwd_kernel, hipFuncAttributeMaxDynamicSharedMemorySize, LDS_BYTES) != hipSuccess) { fprintf(stderr, "kernel_launch: hipFuncSetAttribute failed\n"); ready = -1; }
    }
    if (ready < 0) return;
    (void)in_sizes;
    hipMemsetAsync((char*)d_ws + WS_BAR, 0, WS_ZERO_BYTES, stream);
    Params p;
    memset(&p, 0, sizeof(p));
    const float** fp = (const float**)&p;
    for (int i = 0; i < 42; ++i) fp[i] = (const float*)d_in[i];
    p.out = (float*)d_out; p.ws = (unsigned char*)d_ws;
#if MK_PER_PHASE
    for (int ph = 0; ph < MK_STOP; ++ph) {
        const int local = ph < 2 ? -1 : (ph - 2) % 11, layer = ph < 2 ? 0 : (ph - 2) / 11;
        if (local == 4 && (layer & 1)) continue;
        p.ph_lo = ph; p.ph_hi = ph + 1;
        hipLaunchKernelGGL(fwd_kernel, dim3(256), dim3(NT), LDS_BYTES, stream, p);
    }
#ifdef MK_DIFF
    p.ph_lo = 7; p.ph_hi = 8; p.dbg = 1;
    hipLaunchKernelGGL(fwd_kernel, dim3(256), dim3(NT), LDS_BYTES, stream, p);
    hipLaunchKernelGGL(diff_kernel, dim3(1024), dim3(256), 0, stream, (const bf16_t*)((unsigned char*)d_ws + WS_YO), (const bf16_t*)((unsigned char*)d_ws + WS_HID), (float*)d_out, (size_t)NB * SEQ * D);
#else
    if (MK_DUMP) hipLaunchKernelGGL(dump_kernel, dim3(1024), dim3(256), 0, stream, (const bf16_t*)((unsigned char*)d_ws + (size_t)MK_DUMP), (float*)d_out, (size_t)NB * SEQ * D);
#endif
#else
    p.ph_lo = 0; p.ph_hi = NPHASE;
    hipLaunchKernelGGL(fwd_kernel, dim3(256), dim3(NT), LDS_BYTES, stream, p);
#endif
}
```

```cpp
#include <hip/hip_runtime.h>
#include <stdint.h>
#include <stdio.h>
#include <string.h>

#ifndef MK_PER_PHASE
#define MK_PER_PHASE 0
#endif

typedef unsigned short bf16_t;
typedef short bf16x8 __attribute__((ext_vector_type(8)));
typedef float f32x4 __attribute__((ext_vector_type(4)));
typedef unsigned u32x4 __attribute__((ext_vector_type(4)));
typedef unsigned u32x2 __attribute__((ext_vector_type(2)));
#define LAS __attribute__((address_space(3)))
#define CAS __attribute__((address_space(4)))

constexpr int D = 1024, NB = 4, SEQ = 8192, CTXL = 256, DEPTH = 4;
constexpr int NCTX = NB * CTXL;
constexpr int NROWS = NCTX + NB * SEQ;
constexpr int P_EVEN = 2848, P_ODD = 4416, LDP_EVEN = 3072, LDP_ODD = 4608;
constexpr int NEXP = 32, DEXP = 512, LISTCAP = NROWS;
constexpr float ALPHA = 1.681792830507429f;
constexpr int NT = 512;
constexpr int TCH = 32;
constexpr int NSTEPS = CTXL + SEQ;
constexpr int LDS_BYTES = 160 * 1024;

constexpr size_t al256(size_t x) { return (x + 255) & ~(size_t)255; }
constexpr size_t WS_BAR = 0;
constexpr size_t WS_CNT = 16384;
constexpr int CNT_STRIDE = 64;
constexpr size_t WS_ZERO_BYTES = 16384 + (size_t)4 * 32 * CNT_STRIDE * 4;
constexpr size_t WS_MODV = al256(WS_ZERO_BYTES);
constexpr size_t WS_LB = WS_MODV + al256((size_t)4 * 5 * 6144 * 4);
constexpr size_t WS_XC = WS_LB + al256(4 * 512 * 4);
constexpr size_t WS_WTS = WS_XC + (size_t)NCTX * D * 4;
constexpr size_t WS_LIST = WS_WTS + al256((size_t)2 * NROWS * 4);
constexpr size_t WS_WINT = WS_LIST + al256((size_t)NEXP * LISTCAP * 4);
constexpr size_t WINT_L0 = 0, WINT_L1 = (size_t)LDP_EVEN * D, WINT_L2 = WINT_L1 + (size_t)LDP_ODD * D, WINT_L3 = WINT_L2 + (size_t)LDP_EVEN * D, WINT_END = WINT_L3 + (size_t)LDP_ODD * D;
constexpr size_t WS_WOUTT = WS_WINT + WINT_END * 2;
constexpr size_t WS_LORAT = WS_WOUTT + (size_t)4 * D * D * 2;
constexpr size_t LORA_PER = (size_t)512 * 320;
constexpr size_t WS_EXPGU = WS_LORAT + al256(2 * LORA_PER * 2);
constexpr size_t WS_EXPD = WS_EXPGU + (size_t)NEXP * 1024 * 1024 * 2;
constexpr size_t WS_ACT = WS_EXPD + (size_t)NEXP * 1024 * 512 * 2;
constexpr size_t ROWB = (size_t)NROWS * D * 2;
constexpr size_t WS_FEAT = WS_ACT + ROWB;
constexpr size_t WS_YF = WS_FEAT + ROWB;
constexpr size_t WS_YB = WS_YF + ROWB;
constexpr size_t WS_P = WS_YB + ROWB;
constexpr size_t P_BYTES = (size_t)NROWS * LDP_ODD * 2;
constexpr size_t WS_YO = WS_P;
constexpr size_t WS_HID = WS_P + ROWB;
constexpr size_t WS_YP = WS_HID + ROWB;
static_assert(WS_YP + 2 * ROWB <= WS_P + P_BYTES, "MoE buffers must fit in the P region");
constexpr size_t HALFB = (size_t)NROWS * 512 * 2;
constexpr size_t WS_RWR = WS_P + P_BYTES;
constexpr size_t WS_RWK = WS_RWR + HALFB;
constexpr size_t WS_RWV = WS_RWK + HALFB;
constexpr size_t WS_RWKK = WS_RWV + HALFB;
constexpr size_t WS_RWB = WS_RWKK + HALFB;
constexpr size_t WS_RWG = WS_RWB + HALFB;
constexpr size_t WS_RWDEC = WS_RWG + HALFB;
constexpr size_t WS_LA = WS_RWDEC + (size_t)2 * NROWS * 512 * 4;
constexpr size_t WS_END = WS_LA + (size_t)NROWS * 320 * 2;
static_assert(WS_END <= (size_t)280602384 * 4, "workspace map exceeds the guaranteed ws_size");

struct Params {
    const float *x, *c, *ctx, *c_ctx, *mod_w, *mod_b, *ln_g, *ln_b;
    const float *ev_w_in, *ev_w_out, *ssd_conv_w, *ssd_conv_b, *ssd_dt_bias, *ssd_a_log, *ssd_d, *ssd_norm_w;
    const float *ml_conv_w, *ml_conv_b, *ml_i_bias, *ml_f_bias, *ml_norm_w;
    const float *od_w_in, *od_w_out, *hg_lb_logits, *hg_f_bias, *hg_norm_w;
    const float *rw_mu, *rw_w0, *rw_w2, *rw_a0, *rw_a2, *rw_g2, *rw_k_k, *rw_k_a, *rw_r_k, *rw_ln_w, *rw_ln_b;
    const float *router_w, *router_bias, *exp_w_gate, *exp_w_up, *exp_w_down;
    float* out;
    unsigned char* ws;
    int ph_lo, ph_hi, dbg, pad_;
};
typedef const CAS Params* KP;

__device__ __forceinline__ int ltid(int wv) { int l; asm volatile("v_mbcnt_lo_u32_b32 %0, -1, 0\n\tv_mbcnt_hi_u32_b32 %0, -1, %0" : "=v"(l)); return wv * 64 + l; }
__device__ __forceinline__ float bf2f(bf16_t h) { return __uint_as_float(((unsigned)h) << 16); }
__device__ __forceinline__ float bflo(unsigned u) { return __uint_as_float(u << 16); }
__device__ __forceinline__ float bfhi(unsigned u) { return __uint_as_float(u & 0xffff0000u); }
typedef __bf16 bf16v2_t __attribute__((ext_vector_type(2)));
typedef float f32x2 __attribute__((ext_vector_type(2)));
__device__ __forceinline__ unsigned pk2(float lo, float hi) { const f32x2 v = {lo, hi}; return __builtin_bit_cast(unsigned, __builtin_convertvector(v, bf16v2_t)); }
__device__ __forceinline__ bf16_t f2bf(float f) { return (bf16_t)(pk2(f, 0.f) & 0xffffu); }
__device__ __forceinline__ void unpack8(const u32x4& u, float* f) {
    f[0] = bflo(u.x); f[1] = bfhi(u.x); f[2] = bflo(u.y); f[3] = bfhi(u.y); f[4] = bflo(u.z); f[5] = bfhi(u.z); f[6] = bflo(u.w); f[7] = bfhi(u.w);
}
__device__ __forceinline__ u32x4 pack8(const float* f) { u32x4 u; u.x = pk2(f[0], f[1]); u.y = pk2(f[2], f[3]); u.z = pk2(f[4], f[5]); u.w = pk2(f[6], f[7]); return u; }
__device__ __forceinline__ float sigmoidf_(float x) { return __builtin_amdgcn_rcpf(1.f + __expf(-x)); }
__device__ __forceinline__ float siluf_(float x) { return x * __builtin_amdgcn_rcpf(1.f + __expf(-x)); }
__device__ __forceinline__ float softplus_fast(float x) { return x > 20.f ? x : __logf(1.f + __expf(x)); }
__device__ __forceinline__ float tanh_fast(float x) { return 1.f - 2.f * __builtin_amdgcn_rcpf(1.f + __expf(2.f * x)); }
__device__ __forceinline__ float softplusf_(float x) { return x > 20.f ? x : __logf(1.f + __expf(x)); }
__device__ __forceinline__ float logsigmoidf_(float x) { return fminf(x, 0.f) - __logf(1.f + __expf(-fabsf(x))); }
template <int CTRL> __device__ __forceinline__ float dppmov(float v) {
    return __builtin_bit_cast(float, __builtin_amdgcn_update_dpp(0, __builtin_bit_cast(int, v), CTRL, 0xf, 0xf, true));
}
__device__ __forceinline__ float allreduce16(float v) {
    v += dppmov<0xB1>(v);
    v += dppmov<0x4E>(v);
    v += dppmov<0x141>(v);
    v += dppmov<0x140>(v);
    return v;
}
__device__ __forceinline__ float allreduce8_(float v) { v += dppmov<0xB1>(v); v += dppmov<0x4E>(v); v += dppmov<0x141>(v); return v; }
__device__ __forceinline__ float wave_sum(float v) {
    v = allreduce16(v);
    const float r0 = __builtin_bit_cast(float, __builtin_amdgcn_readlane(__builtin_bit_cast(int, v), 0)), r1 = __builtin_bit_cast(float, __builtin_amdgcn_readlane(__builtin_bit_cast(int, v), 16));
    const float r2 = __builtin_bit_cast(float, __builtin_amdgcn_readlane(__builtin_bit_cast(int, v), 32)), r3 = __builtin_bit_cast(float, __builtin_amdgcn_readlane(__builtin_bit_cast(int, v), 48));
    return (r0 + r1) + (r2 + r3);
}
template <int W> __device__ __forceinline__ float group_sum(float v) {
    if (W == 8) return allreduce8_(v);
    return allreduce16(v);
}

#define XB_TMO      128
#define XB_XCNT(j)  (256  + 64 * (j))
#define XB_XSUB(j)  (1280 + 64 * (j))
#define XB_XGEN(j)  (2304 + 64 * (j))
#define XB_TOP      3328
#define XB_TOPGEN   3392
#define XCD_BAR_WORDS 3456
#define XB_SPIN_CAP (1u << 22)
__device__ __forceinline__ unsigned xb_ld(unsigned* p)              { return __hip_atomic_load(p, __ATOMIC_RELAXED, __HIP_MEMORY_SCOPE_AGENT); }
__device__ __forceinline__ unsigned xb_add(unsigned* p, unsigned v) { return __hip_atomic_fetch_add(p, v, __ATOMIC_RELAXED, __HIP_MEMORY_SCOPE_AGENT); }
__device__ __forceinline__ unsigned xb_xcc_id() { return (unsigned)__builtin_amdgcn_s_getreg((3 << 11) | 20) & 0xFu; }
#define XB_SPIN(cond, bar) do { unsigned _sp = 0; while (cond) { __builtin_amdgcn_s_sleep(1); \
    if ((++_sp & 255u) == 0u) { if (xb_ld(&(bar)[XB_TMO])) break; if (_sp > XB_SPIN_CAP) { atomicAdd(&(bar)[XB_TMO], 1u); break; } } } } while (0)
struct XcdBarrier { unsigned* bar; unsigned x; volatile LAS unsigned* st; };
__device__ __forceinline__ XcdBarrier xcd_barrier_post(int wv, unsigned* bar, volatile LAS unsigned* st) {
    XcdBarrier b; b.bar = bar; b.x = xb_xcc_id(); b.st = st;
    if (ltid(wv) == 0) (void)xb_add(&bar[XB_XCNT(b.x)], 1u);
    return b;
}
__device__ __forceinline__ void xcd_barrier_complete(unsigned* bar, unsigned x, unsigned& nloc, unsigned& nx) {
    const unsigned G = gridDim.x * gridDim.y * gridDim.z;
    unsigned sum, cnt, mine, sp = 0u;
    for (;;) {
        sum = 0u; cnt = 0u; mine = 0u;
#pragma unroll
        for (unsigned j = 0; j < 16; ++j) { const unsigned c = xb_ld(&bar[XB_XCNT(j)]); sum += c; cnt += (c > 0u) ? 1u : 0u; mine = (j == x) ? c : mine; }
        if (sum == G) break;
        __builtin_amdgcn_s_sleep(1);
        if ((++sp & 255u) == 0u) { if (xb_ld(&bar[XB_TMO])) break; if (sp > XB_SPIN_CAP) { atomicAdd(&bar[XB_TMO], 1u); break; } }
    }
    nloc = mine > 0u ? mine : 1u; nx = cnt > 0u ? cnt : 1u;
}
__device__ __forceinline__ void xcd_barrier(int wv, const XcdBarrier& b) {
    asm volatile("s_waitcnt vmcnt(0)" ::: "memory");
    __syncthreads();
    if (ltid(wv) == 0) {
        unsigned* bar = b.bar;
        asm volatile("" : "+s"(bar));
        __builtin_amdgcn_s_waitcnt(0);
        unsigned nloc = b.st[0], nx = b.st[1];
        if (nloc == 0u) { xcd_barrier_complete(bar, b.x, nloc, nx); b.st[0] = nloc; b.st[1] = nx; }
        const unsigned old = xb_add(&bar[XB_XSUB(b.x)], 1u);
        const unsigned gen = old / nloc;
        if (old + 1u == (gen + 1u) * nloc) {
            __builtin_amdgcn_fence(__ATOMIC_RELEASE, "agent");
            asm volatile("s_waitcnt vmcnt(0)" ::: "memory");
            const unsigned og = xb_add(&bar[XB_TOP], 1u);
            const unsigned tg = og / nx;
            if (og + 1u == (tg + 1u) * nx) xb_add(&bar[XB_TOPGEN], 1u);
            else XB_SPIN(xb_ld(&bar[XB_TOPGEN]) == tg, bar);
            __builtin_amdgcn_fence(__ATOMIC_ACQUIRE, "agent");
            xb_add(&bar[XB_XGEN(b.x)], 1u);
            asm volatile("s_waitcnt vmcnt(0)" ::: "memory");
        } else {
            XB_SPIN(xb_ld(&bar[XB_XGEN(b.x)]) == gen, bar);
            __builtin_amdgcn_fence(__ATOMIC_ACQUIRE, "agent");
            asm volatile("s_waitcnt vmcnt(0)" ::: "memory");
        }
    }
    __syncthreads();
}

__device__ __forceinline__ int row_mod(int r) { return r < NCTX ? 4 : ((r - NCTX) >> 13); }
__device__ __forceinline__ void row_seg(int r, int& t, int& len) { if (r < NCTX) { t = r & 255; len = CTXL; } else { t = (r - NCTX) & 8191; len = SEQ; } }
__device__ __forceinline__ int scan_row(int tg, int b, int dir, int odd) {
    if (tg < CTXL) { const int t = dir ? (CTXL - 1 - tg) : tg; return b * CTXL + t; }
    int sg = tg - CTXL; if (dir) sg = SEQ - 1 - sg;
    const int s = odd ? (((sg & 127) << 6) + (sg >> 7)) : sg;
    return NCTX + b * SEQ + s;
}
__device__ __forceinline__ const float* modvec(const unsigned char* ws, int layer, int m, int which) {
    return (const float*)(ws + WS_MODV) + ((size_t)(layer * 5 + m) * 6 + which) * D;
}

constexpr int G_BM = 256, G_BN = 128, G_BK = 64;
constexpr int G_ABYTES = G_BM * G_BK * 2, G_BBYTES = G_BN * G_BK * 2, G_BUF = G_ABYTES + G_BBYTES;
__device__ __forceinline__ int swz(int o) { return o ^ (((o >> 9) & 1) << 5); }

template <class RowSrc, class Epi>
__device__ __forceinline__ void gemm_tile(int wv, const bf16_t* __restrict__ A, int lda, const RowSrc& rs, const bf16_t* __restrict__ Bt, int ldb, int n0, int K, const Epi& epi, LAS char* lds) {
    const int tid = ltid(wv), lane = tid & 63, wid = tid >> 6, wm = wid >> 1, wn = wid & 1;
    const bf16_t* ap[4]; int aoff[4];
#pragma unroll
    for (int i = 0; i < 4; ++i) {
        const int c = tid + NT * i, row = c >> 3, kc = c & 7;
        ap[i] = A + (size_t)rs.src(row) * lda + kc * 8;
        aoff[i] = ((row >> 4) * 2 + (kc >> 2)) * 1024 + swz((row & 15) * 64 + (kc & 3) * 16);
    }
    const bf16_t* bp[2]; int boff[2];
#pragma unroll
    for (int i = 0; i < 2; ++i) {
        const int c = tid + NT * i, row = c >> 3, kc = c & 7;
        bp[i] = Bt + (size_t)(n0 + row) * ldb + kc * 8;
        boff[i] = G_ABYTES + ((row >> 4) * 2 + (kc >> 2)) * 1024 + swz((row & 15) * 64 + (kc & 3) * 16);
    }
    f32x4 acc[4][4];
#pragma unroll
    for (int i = 0; i < 4; ++i)
#pragma unroll
        for (int j = 0; j < 4; ++j) acc[i][j] = (f32x4){0.f, 0.f, 0.f, 0.f};
    u32x4 ra[2][4], rb[2][2];
    const int KT = K / G_BK;
    const int fragoff = swz((lane & 15) * 64 + (lane >> 4) * 16);
#define G_LOAD(set, kt_) do { _Pragma("unroll") for (int i = 0; i < 4; ++i) ra[set][i] = *(const u32x4*)(ap[i] + (kt_) * G_BK); \
                              _Pragma("unroll") for (int i = 0; i < 2; ++i) rb[set][i] = *(const u32x4*)(bp[i] + (kt_) * G_BK); } while (0)
#define G_STORE(set, buf) do { _Pragma("unroll") for (int i = 0; i < 4; ++i) *(LAS u32x4*)((buf) + aoff[i]) = ra[set][i]; \
                               _Pragma("unroll") for (int i = 0; i < 2; ++i) *(LAS u32x4*)((buf) + boff[i]) = rb[set][i]; } while (0)
#define G_COMPUTE(cur) do { bf16x8 af[2][4], bfr[2][4]; \
        _Pragma("unroll") for (int ks = 0; ks < 2; ++ks) { \
            _Pragma("unroll") for (int ni = 0; ni < 4; ++ni) bfr[ks][ni] = *(LAS bf16x8*)((cur) + G_ABYTES + ((wn * 4 + ni) * 2 + ks) * 1024 + fragoff); \
            _Pragma("unroll") for (int mi = 0; mi < 4; ++mi) af[ks][mi] = *(LAS bf16x8*)((cur) + ((wm * 4 + mi) * 2 + ks) * 1024 + fragoff); } \
        __builtin_amdgcn_sched_barrier(0); \
        _Pragma("unroll") for (int ks = 0; ks < 2; ++ks) _Pragma("unroll") for (int mi = 0; mi < 4; ++mi) _Pragma("unroll") for (int ni = 0; ni < 4; ++ni) \
            acc[mi][ni] = __builtin_amdgcn_mfma_f32_16x16x32_bf16(bfr[ks][ni], af[ks][mi], acc[mi][ni], 0, 0, 0); \
        __builtin_amdgcn_sched_barrier(0); } while (0)
    G_LOAD(0, 0);
    G_STORE(0, lds);
    if (KT > 1) G_LOAD(0, 1);
    if (KT > 2) G_LOAD(1, 2);
    __syncthreads();
    for (int kt = 0; kt < KT; kt += 2) {
        G_COMPUTE(lds);
        if (kt + 1 < KT) G_STORE(0, lds + G_BUF);
        if (kt + 3 < KT) G_LOAD(0, kt + 3);
        __syncthreads();
        if (kt + 1 < KT) {
            G_COMPUTE(lds + G_BUF);
            if (kt + 2 < KT) G_STORE(1, lds);
            if (kt + 4 < KT) G_LOAD(1, kt + 4);
            __syncthreads();
        }
    }
#undef G_LOAD
#undef G_STORE
#undef G_COMPUTE
    epi(acc, wm * 64 + (lane & 15), wn * 64 + 4 * (lane >> 4));
}

constexpr int G2_BN = 256, G2_BBYTES = G2_BN * G_BK * 2, G2_BUF = G_ABYTES + G2_BBYTES;

struct RowLinear { int m0; __device__ __forceinline__ int src(int r) const { return m0 + r; } };
struct RowList {
    const int* list; int cnt; int shift;
    __device__ __forceinline__ int src(int r) const { const int a = list[r < cnt ? r : 0]; return a >> shift; }
};
struct EpiStoreBf16 {
    bf16_t* C; int ldc; int m0; int n0; int N;
    template <int NI> __device__ __forceinline__ void operator()(const f32x4 (&acc)[4][NI], int rbase, int cbase) const {
#pragma unroll
        for (int mi = 0; mi < 4; ++mi) {
            bf16_t* rowp = C + (size_t)(m0 + rbase + mi * 16) * ldc + n0 + cbase;
#pragma unroll
            for (int ni = 0; ni < NI; ++ni) {
                if (n0 + cbase + ni * 16 < N) { u32x2 v; v.x = pk2(acc[mi][ni][0], acc[mi][ni][1]); v.y = pk2(acc[mi][ni][2], acc[mi][ni][3]); *(u32x2*)(rowp + ni * 16) = v; }
            }
        }
    }
};
struct EpiSwiGLU {
    bf16_t* H; const int* list; int cnt; int n0;
    template <int NI> __device__ __forceinline__ void operator()(const f32x4 (&acc)[4][NI], int rbase, int cbase) const {
#pragma unroll
        for (int mi = 0; mi < 4; ++mi) {
            const int r = rbase + mi * 16;
            if (r < cnt) {
                const int a = list[r];
                const int wnb = cbase & ~63, q4 = cbase & 63;
                bf16_t* rowp = H + (size_t)a * DEXP + ((n0 + wnb) >> 1) + q4;
#pragma unroll
                for (int q = 0; q < NI / 2; ++q) {
                    float o[4];
#pragma unroll
                    for (int j = 0; j < 4; ++j) o[j] = siluf_(acc[mi][2 * q][j]) * acc[mi][2 * q + 1][j];
                    u32x2 v; v.x = pk2(o[0], o[1]); v.y = pk2(o[2], o[3]); *(u32x2*)(rowp + q * 16) = v;
                }
            }
        }
    }
};
struct EpiScatterBf16 {
    bf16_t* C; const int* list; int cnt; int n0;
    template <int NI> __device__ __forceinline__ void operator()(const f32x4 (&acc)[4][NI], int rbase, int cbase) const {
#pragma unroll
        for (int mi = 0; mi < 4; ++mi) {
            const int r = rbase + mi * 16;
            if (r < cnt) {
                bf16_t* rowp = C + (size_t)list[r] * D + n0 + cbase;
#pragma unroll
                for (int ni = 0; ni < NI; ++ni) { u32x2 v; v.x = pk2(acc[mi][ni][0], acc[mi][ni][1]); v.y = pk2(acc[mi][ni][2], acc[mi][ni][3]); *(u32x2*)(rowp + ni * 16) = v; }
            }
        }
    }
};
struct EpiDecay {
    float* Dc; const float* w0; int m0; int n0;
    template <int NI> __device__ __forceinline__ void operator()(const f32x4 (&acc)[4][NI], int rbase, int cbase) const {
#pragma unroll
        for (int ni = 0; ni < NI; ++ni) {
            const int col = n0 + cbase + ni * 16;
            const f32x4 w0v = *(const f32x4*)(w0 + col);
#pragma unroll
            for (int mi = 0; mi < 4; ++mi) {
                f32x4 o;
#pragma unroll
                for (int j = 0; j < 4; ++j) { const float w = w0v[j] + acc[mi][ni][j]; o[j] = __expf(-__expf(-softplus_fast(-w) - 0.5f)); }
                *(f32x4*)(Dc + (size_t)(m0 + rbase + mi * 16) * 512 + col) = o;
            }
        }
    }
};
struct EpiAK {
    bf16_t* Kb; const bf16_t* KKb; bf16_t* Bb; const float* a0; const float* k_a; int m0; int n0;
    template <int NI> __device__ __forceinline__ void operator()(const f32x4 (&acc)[4][NI], int rbase, int cbase) const {
#pragma unroll
        for (int ni = 0; ni < NI; ++ni) {
            const int col = n0 + cbase + ni * 16;
            const f32x4 a0v = *(const f32x4*)(a0 + col), kav = *(const f32x4*)(k_a + col);
#pragma unroll
            for (int mi = 0; mi < 4; ++mi) {
                const size_t off = (size_t)(m0 + rbase + mi * 16) * 512 + col;
                const u32x2 kr = *(const u32x2*)(Kb + off), kkr = *(const u32x2*)(KKb + off);
                const float kf[4] = {bflo(kr.x), bfhi(kr.x), bflo(kr.y), bfhi(kr.y)}, kkf[4] = {bflo(kkr.x), bfhi(kkr.x), bflo(kkr.y), bfhi(kkr.y)};
                float k2[4], bb[4];
#pragma unroll
                for (int j = 0; j < 4; ++j) { const float a = sigmoidf_(a0v[j] + acc[mi][ni][j]); k2[j] = kf[j] * (1.f + (a - 1.f) * kav[j]); bb[j] = kkf[j] * a; }
                u32x2 v; v.x = pk2(k2[0], k2[1]); v.y = pk2(k2[2], k2[3]); *(u32x2*)(Kb + off) = v;
                v.x = pk2(bb[0], bb[1]); v.y = pk2(bb[2], bb[3]); *(u32x2*)(Bb + off) = v;
            }
        }
    }
};

namespace pg8 {
#define PG8_LAS __attribute__((address_space(3)))
constexpr int BM = 256, BK = 64, HALF = 128, HTB = HALF * BK * 2, STAGE_BYTES = 8 * HTB, NXCD = 8, WGM = 8;
__host__ __device__ __forceinline__ int lds_byte(int r, int c) { const int st = (r >> 4) * 2 + (c >> 5), rr = r & 15, cc = c & 31, ob = rr * 64 + cc * 2; return st * 1024 + (ob ^ (((ob >> 9) & 1) << 5)); }
__host__ __device__ __forceinline__ void stage_rc(int b, int& R, int& C) { const int st = b / 1024, sb = b % 1024, swz = sb ^ (((sb >> 9) & 1) << 5); R = (st >> 1) * 16 + swz / 64; C = (st & 1) * 32 + (swz % 64) / 2; }
__host__ __device__ __forceinline__ int perm32(int rho) { const int n = rho >> 4, i = rho & 15; return 8 * (i >> 2) + 4 * n + (i & 3); }
struct Unit { int pm, pn; };
struct Gemm { const bf16_t* A; const bf16_t* Bt; int M, N, K; };
struct StaticOrder {
    int nM, nN, nwg, G, c;
    __host__ __device__ void init(int M, int N, int G_, int c_) { nM = M / BM; nN = N / BM; nwg = nM * nN; G = G_; c = c_; }
    __host__ __device__ bool next(int i, Unit& u) const {
        const long L = (long)i * G + c; if (L >= nwg) return false;
        int wgid = (int)L; { const int q = nwg / NXCD, r = nwg % NXCD, xcd = wgid % NXCD, off = wgid / NXCD; wgid = (xcd < r ? xcd * (q + 1) : r * (q + 1) + (xcd - r) * q) + off; }
        const int nig = WGM * nN, gid = wgid / nig, fm = gid * WGM, gsz = (nM - fm) < WGM ? (nM - fm) : WGM;
        u.pm = fm + ((wgid % nig) % gsz); u.pn = (wgid % nig) / gsz; return true;
    }
    __device__ __forceinline__ void a_ready(const Unit&) const {}
    __device__ __forceinline__ void done(const Unit&) const {}
};
struct EpiStoreP {
    static constexpr bool PERM = true, AFTER_DRAIN = false;
    bf16_t* O; int ldc;
    __device__ __forceinline__ void operator()(const f32x4 (&acc)[2][2][4][2], const Unit& u, int wr, int wc, int fr, int fq) const {
        const int row0 = u.pm * BM + wr * 64 + fr, col0 = u.pn * BM + wc * 32 + 8 * fq;
#pragma unroll
        for (int ai = 0; ai < 2; ++ai)
#pragma unroll
            for (int m = 0; m < 4; ++m) { bf16_t* rowp = O + (size_t)(row0 + ai * HALF + m * 16) * ldc + col0;
#pragma unroll
                for (int bj = 0; bj < 2; ++bj) { const f32x4 v0 = acc[ai][bj][m][0], v1 = acc[ai][bj][m][1];
                    u32x4 w; w.x = pk2(v0[0], v0[1]); w.y = pk2(v0[2], v0[3]); w.z = pk2(v1[0], v1[1]); w.w = pk2(v1[2], v1[3]);
                    *(u32x4*)(rowp + bj * HALF) = w; } }
    }
};
template <class Epi, class Sched>
__device__ __forceinline__ void gemm_phase(int wv, PG8_LAS unsigned char* lds, const Gemm g, const Sched& S, const Epi& E) {
    const int tid = ltid(wv), wid = __builtin_amdgcn_readfirstlane(tid >> 6), lane = tid & 63, wr = wid >> 2, wc = wid & 3, fr = lane & 15, fq = lane >> 4;
    const int K = g.K, nt = K / BK;
    unsigned voffA[2], voffB[2];
#pragma unroll
    for (int i = 0; i < 2; ++i) { int R, C; stage_rc(tid * 16 + i * 8192, R, C); const int Rb = Epi::PERM ? ((R & ~31) + perm32(R & 31)) : R;
        voffA[i] = (unsigned)(R * K + C) * 2u; voffB[i] = (unsigned)(Rb * K + C) * 2u; }
    const size_t kstep = (size_t)(BK * 2);
    const size_t hstep = (size_t)HALF * K * 2;
    const size_t tstep = 2 * hstep;
    const unsigned ldsw = (unsigned)wid * 1024u;
    const int aoff = lds_byte(wr * 64 + fr, fq * 8), boff = lds_byte(wc * 32 + fr, fq * 8);
#define PG8_SA(b, h) (((b) * 2 + (h)) * HTB)
#define PG8_SB(b, h) ((4 + (b) * 2 + (h)) * HTB)
#define PG8_STAGE(bufoff, gbase, voff) do { _Pragma("unroll") for (int _i = 0; _i < 2; ++_i) \
        __builtin_amdgcn_global_load_lds((const unsigned*)((const char*)(gbase) + (voff)[_i]), (PG8_LAS unsigned*)(lds + (bufoff) + ldsw + _i * 8192), 16, 0, 0); } while (0)
#define PG8_LDA(dst, b, h) do { _Pragma("unroll") for (int m = 0; m < 4; ++m) _Pragma("unroll") for (int k = 0; k < 2; ++k) dst[m][k] = *(const PG8_LAS bf16x8*)(lds + PG8_SA(b, h) + aoff + m * 2048 + k * 1024); } while (0)
#define PG8_LDB(dst, b, h) do { _Pragma("unroll") for (int n = 0; n < 2; ++n) _Pragma("unroll") for (int k = 0; k < 2; ++k) dst[n][k] = *(const PG8_LAS bf16x8*)(lds + PG8_SB(b, h) + boff + n * 2048 + k * 1024); } while (0)
#define PG8_MMA(ai, bj, At, Bt) do { __builtin_amdgcn_s_setprio(1); _Pragma("unroll") for (int m = 0; m < 4; ++m) _Pragma("unroll") for (int n = 0; n < 2; ++n) _Pragma("unroll") for (int k = 0; k < 2; ++k) \
        acc[ai][bj][m][n] = __builtin_amdgcn_mfma_f32_16x16x32_bf16(Bt[n][k], At[m][k], acc[ai][bj][m][n], 0, 0, 0); __builtin_amdgcn_s_setprio(0); } while (0)
#define PG8_WAIT_V(n) asm volatile("s_waitcnt vmcnt(" #n ")" ::: "memory")
#define PG8_WAIT_L(n) asm volatile("s_waitcnt lgkmcnt(" #n ")" ::: "memory")
#define PG8_BAR __builtin_amdgcn_s_barrier()
#define PG8_SCHED __builtin_amdgcn_sched_barrier(0)
    Unit cur, nxt; int ui = 0;
    if (!S.next(0, cur)) return;
    f32x4 acc[2][2][4][2];
#pragma unroll
    for (int a = 0; a < 2; ++a)
#pragma unroll
        for (int b = 0; b < 2; ++b)
#pragma unroll
            for (int m = 0; m < 4; ++m)
#pragma unroll
                for (int n = 0; n < 2; ++n) acc[a][b][m][n] = (f32x4){0.f, 0.f, 0.f, 0.f};
    bf16x8 At[4][2], B0[2][2], B1[2][2];
    const char* cA = (const char*)g.A + (size_t)cur.pm * tstep; const char* cB = (const char*)g.Bt + (size_t)cur.pn * tstep;
    S.a_ready(cur);
    PG8_STAGE(PG8_SB(0, 0), cB, voffB); PG8_STAGE(PG8_SA(0, 0), cA, voffA); PG8_STAGE(PG8_SB(0, 1), cB + hstep, voffB); PG8_STAGE(PG8_SA(0, 1), cA + hstep, voffA);
    if (wr == 1) PG8_BAR;
    PG8_WAIT_V(4); PG8_BAR;
    PG8_STAGE(PG8_SB(1, 0), cB + kstep, voffB); PG8_STAGE(PG8_SA(1, 0), cA + kstep, voffA); PG8_STAGE(PG8_SB(1, 1), cB + hstep + kstep, voffB);
    PG8_WAIT_V(6); PG8_BAR;
    for (;;) {
        const bool has_next = S.next(ui + 1, nxt);
        const char* nA = has_next ? (const char*)g.A + (size_t)nxt.pm * tstep : cA; const char* nB = has_next ? (const char*)g.Bt + (size_t)nxt.pn * tstep : cB;
        for (int t = 0; t < nt; t += 2) {
            const bool last = (t == nt - 2);
            const char* a1 = cA + (size_t)(t + 1) * kstep;
            const char* a2 = last ? nA : cA + (size_t)(t + 2) * kstep; const char* b2 = last ? nB : cB + (size_t)(t + 2) * kstep;
            const char* a3 = a2 + kstep; const char* b3 = b2 + kstep;
            if (last && has_next) S.a_ready(nxt);
            PG8_LDB(B0, 0, 0); PG8_SCHED; PG8_LDA(At, 0, 0); PG8_STAGE(PG8_SA(1, 1), a1 + hstep, voffA);
            PG8_WAIT_L(8); PG8_BAR; PG8_WAIT_L(0); PG8_MMA(0, 0, At, B0); PG8_BAR; PG8_SCHED;
            PG8_LDB(B1, 0, 1); PG8_STAGE(PG8_SB(0, 0), b2, voffB);
            PG8_BAR; PG8_WAIT_L(0); PG8_MMA(0, 1, At, B1); PG8_BAR;
            PG8_LDA(At, 0, 1); PG8_STAGE(PG8_SA(0, 0), a2, voffA);
            PG8_BAR; PG8_WAIT_L(0); PG8_MMA(1, 0, At, B0); PG8_BAR; PG8_SCHED;
            PG8_STAGE(PG8_SB(0, 1), b2 + hstep, voffB);
            PG8_WAIT_V(6); PG8_BAR; PG8_MMA(1, 1, At, B1); PG8_BAR;
            PG8_LDB(B0, 1, 0); PG8_SCHED; PG8_LDA(At, 1, 0); PG8_STAGE(PG8_SA(0, 1), a2 + hstep, voffA);
            PG8_WAIT_L(8); PG8_BAR; PG8_WAIT_L(0); PG8_MMA(0, 0, At, B0); PG8_BAR; PG8_SCHED;
            PG8_LDB(B1, 1, 1); PG8_STAGE(PG8_SB(1, 0), b3, voffB);
            PG8_BAR; PG8_WAIT_L(0); PG8_MMA(0, 1, At, B1); PG8_BAR;
            PG8_LDA(At, 1, 1); PG8_STAGE(PG8_SA(1, 0), a3, voffA);
            PG8_BAR; PG8_WAIT_L(0); PG8_MMA(1, 0, At, B0); PG8_BAR; PG8_SCHED;
            PG8_STAGE(PG8_SB(1, 1), b3 + hstep, voffB);
            PG8_WAIT_V(6); PG8_BAR; PG8_MMA(1, 1, At, B1); PG8_BAR;
        }
            if constexpr (!Epi::AFTER_DRAIN) { E(acc, cur, wr, wc, fr, fq); S.done(cur); }
            if (!has_next) break;
#pragma unroll
        for (int a = 0; a < 2; ++a)
#pragma unroll
            for (int b = 0; b < 2; ++b)
#pragma unroll
                for (int m = 0; m < 4; ++m)
#pragma unroll
                    for (int n = 0; n < 2; ++n) acc[a][b][m][n] = (f32x4){0.f, 0.f, 0.f, 0.f};
        cur = nxt; cA = nA; cB = nB; ++ui;
    }
    PG8_WAIT_V(0);
    if (wr == 0) PG8_BAR;
    PG8_BAR;
    if constexpr (Epi::AFTER_DRAIN) { E.fused(acc, cur, wr, wc, fr, fq, lds, wid, lane); S.done(cur); }
#undef PG8_SA
#undef PG8_SB
#undef PG8_STAGE
#undef PG8_LDA
#undef PG8_LDB
#undef PG8_MMA
#undef PG8_WAIT_V
#undef PG8_WAIT_L
#undef PG8_BAR
#undef PG8_SCHED
}
struct UnitG { int pm, pn; const char* bbase; const PG8_LAS int* ltab; int cnt; int e; };
struct MoeOrder {
    const PG8_LAS int* tstart; const PG8_LAS int* tcnt; const PG8_LAS int* ltabs; const int* lists; const char* bt; size_t estride; int ncol, shift, G, c;
    __device__ __forceinline__ bool next(int i, UnitG& u) const {
        const int t = i * G + c; if (t >= tstart[32] * ncol) return false;
        const int tm = t / ncol; int e = 0;
#pragma unroll 1
        while (tstart[e + 1] <= tm) ++e;
        e = __builtin_amdgcn_readfirstlane(e);
        const int ts = __builtin_amdgcn_readfirstlane(tstart[e]), tc = __builtin_amdgcn_readfirstlane(tcnt[e]);
        u.pm = tm - ts; u.pn = t - tm * ncol; u.bbase = bt + (size_t)e * estride; u.e = e; u.cnt = tc - u.pm * BM; u.ltab = ltabs + i * BM;
        return true;
    }
    __device__ __forceinline__ void a_ready(const UnitG&) const {}
    __device__ __forceinline__ void done(const UnitG&) const {}
};
struct EpiSwiGLUG {
    static constexpr bool PERM = false, AFTER_DRAIN = false;
    bf16_t* H;
    __device__ __forceinline__ void operator()(const f32x4 (&acc)[2][2][4][2], const UnitG& u, int wr, int wc, int fr, int fq) const {
#pragma unroll
        for (int ai = 0; ai < 2; ++ai)
#pragma unroll
            for (int m = 0; m < 4; ++m) { const int r = ai * HALF + wr * 64 + m * 16 + fr;
                if (r < u.cnt) { bf16_t* rowp = H + (size_t)u.ltab[r] * DEXP + ((u.pn * BM + wc * 32) >> 1) + 4 * fq;
#pragma unroll
                    for (int bj = 0; bj < 2; ++bj) { const f32x4 gt = acc[ai][bj][m][0], up = acc[ai][bj][m][1];
                        u32x2 w; w.x = pk2(siluf_(gt[0]) * up[0], siluf_(gt[1]) * up[1]); w.y = pk2(siluf_(gt[2]) * up[2], siluf_(gt[3]) * up[3]);
                        *(u32x2*)(rowp + bj * (HALF / 2)) = w; } } }
    }
};
struct EpiScatterG {
    static constexpr bool PERM = true, AFTER_DRAIN = false;
    bf16_t* O;
    __device__ __forceinline__ void operator()(const f32x4 (&acc)[2][2][4][2], const UnitG& u, int wr, int wc, int fr, int fq) const {
#pragma unroll
        for (int ai = 0; ai < 2; ++ai)
#pragma unroll
            for (int m = 0; m < 4; ++m) { const int r = ai * HALF + wr * 64 + m * 16 + fr;
                if (r < u.cnt) { bf16_t* rowp = O + (size_t)u.ltab[r] * D + u.pn * BM + wc * 32 + 8 * fq;
#pragma unroll
                    for (int bj = 0; bj < 2; ++bj) { const f32x4 v0 = acc[ai][bj][m][0], v1 = acc[ai][bj][m][1];
                        u32x4 w; w.x = pk2(v0[0], v0[1]); w.y = pk2(v0[2], v0[3]); w.z = pk2(v1[0], v1[1]); w.w = pk2(v1[2], v1[3]);
                        *(u32x4*)(rowp + bj * HALF) = w; } } }
    }
};
template <class Epi, class Sched>
__device__ __forceinline__ void gemm_phase_g(int wv, PG8_LAS unsigned char* lds, const Gemm g, const Sched& S, const Epi& E) {
    const int tid = ltid(wv), wid = __builtin_amdgcn_readfirstlane(tid >> 6), lane = tid & 63, wr = wid >> 2, wc = wid & 3, fr = lane & 15, fq = lane >> 4;
    const int K = g.K, nt = K / BK;
    unsigned voffB[2];
#pragma unroll
    for (int i = 0; i < 2; ++i) { int R, C; stage_rc(tid * 16 + i * 8192, R, C); const int Rb = Epi::PERM ? ((R & ~31) + perm32(R & 31)) : R;
        voffB[i] = (unsigned)(Rb * K + C) * 2u; }
    const unsigned rowb = (unsigned)K * 2u;
#define PG8_AOFFS(u, dst) do { const int _t = ltid(wv); _Pragma("unroll") for (int _i = 0; _i < 2; ++_i) { int _R, _C; stage_rc(_t * 16 + _i * 8192, _R, _C); \
        _Pragma("unroll") for (int _h = 0; _h < 2; ++_h) dst[_h][_i] = (unsigned)((u).ltab[_h * HALF + _R] >> S.shift) * rowb + (unsigned)(_C * 2); } } while (0)
#define PG8_STAGE_A(bufoff, AO, koff) do { _Pragma("unroll") for (int _i = 0; _i < 2; ++_i) \
        __builtin_amdgcn_global_load_lds((const unsigned*)((const char*)g.A + (size_t)(AO)[_i] + (size_t)(koff)), (PG8_LAS unsigned*)(lds + (bufoff) + ldsw + _i * 8192), 16, 0, 0); } while (0)
    const size_t kstep = (size_t)(BK * 2);
    const size_t hstep = (size_t)HALF * K * 2;
    const size_t tstep = 2 * hstep;
    const unsigned ldsw = (unsigned)wid * 1024u;
    const int aoff = lds_byte(wr * 64 + fr, fq * 8), boff = lds_byte(wc * 32 + fr, fq * 8);
#define PG8_SA(b, h) (((b) * 2 + (h)) * HTB)
#define PG8_SB(b, h) ((4 + (b) * 2 + (h)) * HTB)
#define PG8_STAGE(bufoff, gbase, voff) do { _Pragma("unroll") for (int _i = 0; _i < 2; ++_i) \
        __builtin_amdgcn_global_load_lds((const unsigned*)((const char*)(gbase) + (voff)[_i]), (PG8_LAS unsigned*)(lds + (bufoff) + ldsw + _i * 8192), 16, 0, 0); } while (0)
#define PG8_LDA(dst, b, h) do { _Pragma("unroll") for (int m = 0; m < 4; ++m) _Pragma("unroll") for (int k = 0; k < 2; ++k) dst[m][k] = *(const PG8_LAS bf16x8*)(lds + PG8_SA(b, h) + aoff + m * 2048 + k * 1024); } while (0)
#define PG8_LDB(dst, b, h) do { _Pragma("unroll") for (int n = 0; n < 2; ++n) _Pragma("unroll") for (int k = 0; k < 2; ++k) dst[n][k] = *(const PG8_LAS bf16x8*)(lds + PG8_SB(b, h) + boff + n * 2048 + k * 1024); } while (0)
#define PG8_MMA(ai, bj, At, Bt) do { __builtin_amdgcn_s_setprio(1); _Pragma("unroll") for (int m = 0; m < 4; ++m) _Pragma("unroll") for (int n = 0; n < 2; ++n) _Pragma("unroll") for (int k = 0; k < 2; ++k) \
        acc[ai][bj][m][n] = __builtin_amdgcn_mfma_f32_16x16x32_bf16(Bt[n][k], At[m][k], acc[ai][bj][m][n], 0, 0, 0); __builtin_amdgcn_s_setprio(0); } while (0)
#define PG8_WAIT_V(n) asm volatile("s_waitcnt vmcnt(" #n ")" ::: "memory")
#define PG8_WAIT_L(n) asm volatile("s_waitcnt lgkmcnt(" #n ")" ::: "memory")
#define PG8_BAR __builtin_amdgcn_s_barrier()
#define PG8_SCHED __builtin_amdgcn_sched_barrier(0)
    UnitG cur, nxt; int ui = 0;
    if (!S.next(0, cur)) return;
    f32x4 acc[2][2][4][2];
#pragma unroll
    for (int a = 0; a < 2; ++a)
#pragma unroll
        for (int b = 0; b < 2; ++b)
#pragma unroll
            for (int m = 0; m < 4; ++m)
#pragma unroll
                for (int n = 0; n < 2; ++n) acc[a][b][m][n] = (f32x4){0.f, 0.f, 0.f, 0.f};
    bf16x8 At[4][2], B0[2][2], B1[2][2];
    unsigned ca[2][2]; PG8_AOFFS(cur, ca); const char* cB = cur.bbase + (size_t)cur.pn * tstep;
    S.a_ready(cur);
    PG8_STAGE(PG8_SB(0, 0), cB, voffB); PG8_STAGE_A(PG8_SA(0, 0), ca[0], 0); PG8_STAGE(PG8_SB(0, 1), cB + hstep, voffB); PG8_STAGE_A(PG8_SA(0, 1), ca[1], 0);
    if (wr == 1) PG8_BAR;
    PG8_WAIT_V(4); PG8_BAR;
    PG8_STAGE(PG8_SB(1, 0), cB + kstep, voffB); PG8_STAGE_A(PG8_SA(1, 0), ca[0], kstep); PG8_STAGE(PG8_SB(1, 1), cB + hstep + kstep, voffB);
    PG8_WAIT_V(6); PG8_BAR;
    for (;;) {
        const bool has_next = S.next(ui + 1, nxt);
        const char* nB = has_next ? nxt.bbase + (size_t)nxt.pn * tstep : cB;
        for (int t = 0; t < nt; t += 2) {
            const bool last = (t == nt - 2);
            const size_t k1 = (size_t)(t + 1) * kstep, k2 = last ? 0 : (size_t)(t + 2) * kstep;
            unsigned a2o[2][2];
            if (last && has_next) PG8_AOFFS(nxt, a2o); else { a2o[0][0] = ca[0][0]; a2o[0][1] = ca[0][1]; a2o[1][0] = ca[1][0]; a2o[1][1] = ca[1][1]; }
            const char* b2 = last ? nB : cB + (size_t)(t + 2) * kstep; const char* b3 = b2 + kstep;
            if (last && has_next) S.a_ready(nxt);
            PG8_LDB(B0, 0, 0); PG8_SCHED; PG8_LDA(At, 0, 0); PG8_STAGE_A(PG8_SA(1, 1), ca[1], k1);
            PG8_WAIT_L(8); PG8_BAR; PG8_WAIT_L(0); PG8_MMA(0, 0, At, B0); PG8_BAR; PG8_SCHED;
            PG8_LDB(B1, 0, 1); PG8_STAGE(PG8_SB(0, 0), b2, voffB);
            PG8_BAR; PG8_WAIT_L(0); PG8_MMA(0, 1, At, B1); PG8_BAR;
            PG8_LDA(At, 0, 1); PG8_STAGE_A(PG8_SA(0, 0), a2o[0], k2);
            PG8_BAR; PG8_WAIT_L(0); PG8_MMA(1, 0, At, B0); PG8_BAR; PG8_SCHED;
            PG8_STAGE(PG8_SB(0, 1), b2 + hstep, voffB);
            PG8_WAIT_V(6); PG8_BAR; PG8_MMA(1, 1, At, B1); PG8_BAR;
            PG8_LDB(B0, 1, 0); PG8_SCHED; PG8_LDA(At, 1, 0); PG8_STAGE_A(PG8_SA(0, 1), a2o[1], k2);
            PG8_WAIT_L(8); PG8_BAR; PG8_WAIT_L(0); PG8_MMA(0, 0, At, B0); PG8_BAR; PG8_SCHED;
            PG8_LDB(B1, 1, 1); PG8_STAGE(PG8_SB(1, 0), b3, voffB);
            PG8_BAR; PG8_WAIT_L(0); PG8_MMA(0, 1, At, B1); PG8_BAR;
            PG8_LDA(At, 1, 1); PG8_STAGE_A(PG8_SA(1, 0), a2o[0], k2 + kstep);
            PG8_BAR; PG8_WAIT_L(0); PG8_MMA(1, 0, At, B0); PG8_BAR; PG8_SCHED;
            PG8_STAGE(PG8_SB(1, 1), b3 + hstep, voffB);
            PG8_WAIT_V(6); PG8_BAR; PG8_MMA(1, 1, At, B1); PG8_BAR;
            if (last) { ca[0][0] = a2o[0][0]; ca[0][1] = a2o[0][1]; ca[1][0] = a2o[1][0]; ca[1][1] = a2o[1][1]; }
        }
            if constexpr (!Epi::AFTER_DRAIN) { E(acc, cur, wr, wc, fr, fq); S.done(cur); }
            if (!has_next) break;
#pragma unroll
        for (int a = 0; a < 2; ++a)
#pragma unroll
            for (int b = 0; b < 2; ++b)
#pragma unroll
                for (int m = 0; m < 4; ++m)
#pragma unroll
                    for (int n = 0; n < 2; ++n) acc[a][b][m][n] = (f32x4){0.f, 0.f, 0.f, 0.f};
        cur = nxt; cB = nB; ++ui;
    }
    PG8_WAIT_V(0);
    if (wr == 0) PG8_BAR;
    PG8_BAR;
    if constexpr (Epi::AFTER_DRAIN) { E.fused(acc, cur, wr, wc, fr, fq, lds, wid, lane); S.done(cur); }
#undef PG8_SA
#undef PG8_AOFFS
#undef PG8_STAGE_A
#undef PG8_SB
#undef PG8_STAGE
#undef PG8_LDA
#undef PG8_LDB
#undef PG8_MMA
#undef PG8_WAIT_V
#undef PG8_WAIT_L
#undef PG8_BAR
#undef PG8_SCHED
}
}

__device__ __forceinline__ void transpose_item(const float* __restrict__ W, int K, int N, bf16_t* __restrict__ WT, int mode, LAS float* scr, int item, int lane) {
    const int nblk = N / 32, kb = item / nblk, nb = item % nblk, k0 = 64 * kb, n0 = 32 * nb;
#pragma unroll 8
    for (int i = 0; i < 32; ++i) { const int kk = 2 * i + (lane >> 5); scr[kk * 33 + (lane & 31)] = W[(size_t)(k0 + kk) * N + n0 + (lane & 31)]; }
    asm volatile("s_waitcnt lgkmcnt(0)" ::: "memory");
    const int c = lane & 7;
#pragma unroll
    for (int j = 0; j < 4; ++j) {
        const int nl = (lane >> 3) + 8 * j; const LAS float* s = scr + (8 * c) * 33 + nl;
        u32x4 o; o.x = pk2(s[0 * 33], s[1 * 33]); o.y = pk2(s[2 * 33], s[3 * 33]); o.z = pk2(s[4 * 33], s[5 * 33]); o.w = pk2(s[6 * 33], s[7 * 33]);
        const int n = n0 + nl;
        const int nd = mode == 0 ? n : (32 * (n >> 4) + (n & 15) + (mode == 2 ? 16 : 0));
        *(u32x4*)(WT + (size_t)nd * K + k0 + 8 * c) = o;
    }
    asm volatile("s_waitcnt lgkmcnt(0)" ::: "memory");
}

__device__ __forceinline__ void phase_prologue0(int wv, KP Pk, LAS char* lds) {
    asm volatile("" : "+s"(Pk));
    const CAS Params& P = *Pk;
    const int tid = ltid(wv), lane = tid & 63, wid = tid >> 6;
    const int gw = blockIdx.x * 8 + wid, NGW = gridDim.x * 8;
    LAS float* scr = (LAS float*)(lds + wid * 8448);
    bf16_t* winT = (bf16_t*)(P.ws + WS_WINT);
    bf16_t* woutT = (bf16_t*)(P.ws + WS_WOUTT);
    bf16_t* loraT = (bf16_t*)(P.ws + WS_LORAT);
    constexpr int I_EV = 16 * (P_EVEN / 32), I_OD = 16 * (P_ODD / 32), I_O = 16 * 32, I_L64 = 16, I_L128 = 32;
    constexpr int I_LORA = 3 * I_L64 + I_L128;
    constexpr int NIT = 2 * I_EV + 2 * I_OD + 4 * I_O + 2 * I_LORA;
    for (int it = gw; it < NIT; it += NGW) {
        int r = it;
        if (r < 2 * I_EV) { const int i = r / I_EV; transpose_item(P.ev_w_in + (size_t)i * D * P_EVEN, D, P_EVEN, winT + (i ? WINT_L2 : WINT_L0), 0, scr, r % I_EV, lane); continue; } r -= 2 * I_EV;
        if (r < 2 * I_OD) { const int i = r / I_OD; transpose_item(P.od_w_in + (size_t)i * D * P_ODD, D, P_ODD, winT + (i ? WINT_L3 : WINT_L1), 0, scr, r % I_OD, lane); continue; } r -= 2 * I_OD;
        if (r < 4 * I_O) { const int l = r / I_O; const float* src = (l & 1) ? P.od_w_out + (size_t)(l >> 1) * D * D : P.ev_w_out + (size_t)(l >> 1) * D * D;
            transpose_item(src, D, D, woutT + (size_t)l * D * D, 0, scr, r % I_O, lane); continue; } r -= 4 * I_O;
        { const int i = r / I_LORA; int q = r % I_LORA; bf16_t* dst = loraT + (size_t)i * LORA_PER;
          if (q < I_L64) { transpose_item(P.rw_w2 + (size_t)(i * 2 + 0) * 64 * 512, 64, 512, dst, 0, scr, q, lane); continue; } q -= I_L64;
          if (q < I_L64) { transpose_item(P.rw_w2 + (size_t)(i * 2 + 1) * 64 * 512, 64, 512, dst + 512 * 64, 0, scr, q, lane); continue; } q -= I_L64;
          if (q < I_L64) { transpose_item(P.rw_a2 + (size_t)i * 64 * 512, 64, 512, dst + 2 * 512 * 64, 0, scr, q, lane); continue; } q -= I_L64;
          transpose_item(P.rw_g2 + (size_t)i * 128 * 512, 128, 512, dst + 3 * 512 * 64, 0, scr, q, lane); }
    }
    {
        const int gt = blockIdx.x * NT + tid, NG = gridDim.x * NT;
        constexpr int PADE = (LDP_EVEN - P_EVEN) * D / 8, PADO = (LDP_ODD - P_ODD) * D / 8;
        for (int i = gt; i < 2 * PADE + 2 * PADO; i += NG) {
            int r = i; bf16_t* dst;
            if (r < 2 * PADE) { const int l = r / PADE; dst = winT + (l ? WINT_L2 : WINT_L0) + (size_t)P_EVEN * D + (size_t)(r % PADE) * 8; }
            else { r -= 2 * PADE; const int l = r / PADO; dst = winT + (l ? WINT_L3 : WINT_L1) + (size_t)P_ODD * D + (size_t)(r % PADO) * 8; }
            *(u32x4*)dst = (u32x4){0u, 0u, 0u, 0u};
        }
    }
    {
        const int gt = blockIdx.x * NT + tid, NG = gridDim.x * NT;
        float* lb = (float*)(P.ws + WS_LB);
        for (int ch = gt; ch < 512; ch += NG) {
            float lg[4], mx = -1e30f;
#pragma unroll
            for (int l = 0; l < 4; ++l) { lg[l] = P.hg_lb_logits[l * 512 + ch]; mx = fmaxf(mx, lg[l]); }
            float e[4], s = 0.f;
#pragma unroll
            for (int l = 0; l < 4; ++l) { e[l] = __expf(lg[l] - mx); s += e[l]; }
            float cum = 0.f;
#pragma unroll
            for (int l = 0; l < 4; ++l) { if (l > 0) cum += e[l] / s; lb[l * 512 + ch] = cum; }
        }
    }
    __syncthreads();
    {
        LAS float* sc = (LAS float*)lds;
        LAS float* red = (LAS float*)(lds + 5 * 1024 * 4);
        for (int i = tid; i < 5 * D; i += NT) { const int m = i >> 10, k = i & 1023; const float v = m < 4 ? P.c[m * D + k] : P.c_ctx[k]; sc[i] = siluf_(v); }
        __syncthreads();
        float* modv = (float*)(P.ws + WS_MODV);
        const int col = tid & 127, kq = tid >> 7;
        for (int item = blockIdx.x; item < 4 * 48; item += gridDim.x) {
            const int l = item / 48, j = (item % 48) * 128 + col;
            const float* w = P.mod_w + (size_t)l * D * 6144 + j;
            float a[5] = {0.f, 0.f, 0.f, 0.f, 0.f};
#pragma unroll 8
            for (int k = kq * 256; k < kq * 256 + 256; ++k) {
                const float wv = w[(size_t)k * 6144];
#pragma unroll
                for (int m = 0; m < 5; ++m) a[m] += sc[m * 1024 + k] * wv;
            }
#pragma unroll
            for (int m = 0; m < 5; ++m) red[(kq * 128 + col) * 5 + m] = a[m];
            __syncthreads();
            if (kq == 0) {
                const float bias = P.mod_b[l * 6144 + j];
#pragma unroll
                for (int m = 0; m < 5; ++m) {
                    const float s = red[(0 * 128 + col) * 5 + m] + red[(1 * 128 + col) * 5 + m] + red[(2 * 128 + col) * 5 + m] + red[(3 * 128 + col) * 5 + m];
                    modv[(size_t)(l * 5 + m) * 6144 + j] = s + bias;
                }
            }
            __syncthreads();
        }
    }
}

__device__ __forceinline__ void phase_prologue1(int wv, KP Pk) {
    asm volatile("" : "+s"(Pk));
    const CAS Params& P = *Pk;
    const int tid = ltid(wv), lane = tid & 63, wid = tid >> 6;
    bf16_t* act = (bf16_t*)(P.ws + WS_ACT);
    for (int r = blockIdx.x * 8 + wid; r < NROWS; r += gridDim.x * 8) {
        const int m = row_mod(r);
        const float* src = r < NCTX ? P.ctx + (size_t)r * D : P.x + (size_t)(r - NCTX) * D;
        const float* sh = modvec(P.ws, 0, m, 0); const float* sc = modvec(P.ws, 0, m, 1);
#pragma unroll
        for (int i = 0; i < 4; ++i) {
            const int c = 4 * lane + 256 * i;
            const f32x4 v = *(const f32x4*)(src + c), s1 = *(const f32x4*)(sc + c), h1 = *(const f32x4*)(sh + c);
            u32x2 o; o.x = pk2(v[0] * (1.f + s1[0]) + h1[0], v[1] * (1.f + s1[1]) + h1[1]); o.y = pk2(v[2] * (1.f + s1[2]) + h1[2], v[3] * (1.f + s1[3]) + h1[3]);
            *(u32x2*)(act + (size_t)r * D + c) = o;
        }
    }
}

__device__ __forceinline__ void phase_inproj(int wv, KP Pk, int layer, LAS char* lds) {
    asm volatile("" : "+s"(Pk));
    const CAS Params& P = *Pk;
    const int odd = layer & 1, ldp = odd ? LDP_ODD : LDP_EVEN;
    const size_t woff = layer == 0 ? WINT_L0 : layer == 1 ? WINT_L1 : layer == 2 ? WINT_L2 : WINT_L3;
    pg8::Gemm g{(const bf16_t*)(P.ws + WS_ACT), (const bf16_t*)(P.ws + WS_WINT) + woff, NROWS, ldp, D};
    pg8::StaticOrder S; S.init(NROWS, ldp, (int)gridDim.x, (int)blockIdx.x);
    pg8::EpiStoreP E{(bf16_t*)(P.ws + WS_P), ldp};
    pg8::gemm_phase(wv, (PG8_LAS unsigned char*)lds, g, S, E);
}
__device__ __forceinline__ void phase_outproj(int wv, KP Pk, int layer, LAS char* lds) {
    asm volatile("" : "+s"(Pk));
    const CAS Params& P = *Pk;
    const int r0 = (layer == DEPTH - 1) ? NCTX : 0;
    pg8::Gemm g{(const bf16_t*)(P.ws + WS_FEAT) + (size_t)r0 * D, (const bf16_t*)(P.ws + WS_WOUTT) + (size_t)layer * D * D, NROWS - r0, D, D};
    pg8::StaticOrder S; S.init(NROWS - r0, D, (int)gridDim.x, (int)blockIdx.x);
    pg8::EpiStoreP E{(bf16_t*)(P.ws + WS_YO) + (size_t)r0 * D, D};
    pg8::gemm_phase(wv, (PG8_LAS unsigned char*)lds, g, S, E);
}
__device__ __forceinline__ void phase_prep2(int wv, KP Pk, int layer, LAS char* lds) {
    asm volatile("" : "+s"(Pk));
    const CAS Params& P = *Pk;
    const int i = layer >> 1;
    const bf16_t* la = (const bf16_t*)(P.ws + WS_LA);
    const bf16_t* lt = (const bf16_t*)(P.ws + WS_LORAT) + (size_t)i * LORA_PER;
    constexpr int MT = NROWS / G_BM, NTL = 512 / G_BN;
    const int ntiles = 4 * MT * NTL;
    for (int t = blockIdx.x; t < ntiles; t += gridDim.x) {
        const int which = t / (MT * NTL), r = t % (MT * NTL), mt = r / NTL, nt = r % NTL;
        RowLinear rs{mt * G_BM};
        if (which < 2) {
            EpiDecay epi{(float*)(P.ws + WS_RWDEC) + (size_t)which * NROWS * 512, P.rw_w0 + (size_t)(i * 2 + which) * 512, mt * G_BM, nt * G_BN};
            gemm_tile(wv, la + which * 64, 320, rs, lt + (size_t)which * 512 * 64, 64, nt * G_BN, 64, epi, lds);
        } else if (which == 2) {
            EpiAK epi{(bf16_t*)(P.ws + WS_RWK), (const bf16_t*)(P.ws + WS_RWKK), (bf16_t*)(P.ws + WS_RWB), P.rw_a0 + i * 512, P.rw_k_a + i * 512, mt * G_BM, nt * G_BN};
            gemm_tile(wv, la + 128, 320, rs, lt + (size_t)2 * 512 * 64, 64, nt * G_BN, 64, epi, lds);
        } else {
            EpiStoreBf16 epi{(bf16_t*)(P.ws + WS_RWG), 512, mt * G_BM, nt * G_BN, 512};
            gemm_tile(wv, la + 192, 320, rs, lt + (size_t)3 * 512 * 64, 128, nt * G_BN, 128, epi, lds);
        }
    }
}
__device__ __forceinline__ void moe_tiles(int wv, const unsigned char* ws, int layer, LAS int* tstart, LAS int* tcnt) {
    const int tid = ltid(wv);
    if (tid < 64) {
        const int* cnt = (const int*)(ws + WS_CNT) + layer * 32 * CNT_STRIDE;
        const int c = tid < NEXP ? cnt[tid * CNT_STRIDE] : 0;
        int incl = (c + G_BM - 1) / G_BM;
#pragma unroll
        for (int o = 1; o < 32; o <<= 1) { const int t = __shfl_up(incl, o); if (tid >= o) incl += t; }
        if (tid < NEXP) { tcnt[tid] = c; tstart[tid] = incl - (c + G_BM - 1) / G_BM; }
        if (tid == NEXP - 1) tstart[NEXP] = incl;
    }
    __syncthreads();
}
__device__ __forceinline__ void phase_moe1(int wv, KP Pk, int layer, LAS char* lds) {
    asm volatile("" : "+s"(Pk));
    const CAS Params& P = *Pk;
    LAS int* tstart = (LAS int*)(lds + pg8::STAGE_BYTES); LAS int* tcnt = tstart + 40;
    moe_tiles(wv, P.ws, layer, tstart, tcnt);
    pg8::Gemm g{(const bf16_t*)(P.ws + WS_ACT), (const bf16_t*)(P.ws + WS_EXPGU), 0, 1024, D};
    LAS int* ltabs = tstart + 128;
    pg8::MoeOrder S{tstart, tcnt, ltabs, (const int*)(P.ws + WS_LIST), (const char*)(P.ws + WS_EXPGU), (size_t)1024 * 1024 * 2, 4, 1, (int)gridDim.x, (int)blockIdx.x};
    pg8::EpiSwiGLUG E{(bf16_t*)(P.ws + WS_HID)};
    for (int i = 0; i < 8; ++i) {
        pg8::UnitG u; if (!S.next(i, u)) break;
        const int tl = ltid(wv);
        const int* ul = (const int*)(P.ws + WS_LIST) + (size_t)u.e * LISTCAP + u.pm * pg8::BM;
        if (tl < pg8::BM) ltabs[i * pg8::BM + tl] = ul[tl < u.cnt ? tl : 0];
    }
    __syncthreads();
    pg8::gemm_phase_g(wv, (PG8_LAS unsigned char*)lds, g, S, E);
    __syncthreads();
}
__device__ __forceinline__ void phase_moe2(int wv, KP Pk, int layer, LAS char* lds) {
    asm volatile("" : "+s"(Pk));
    const CAS Params& P = *Pk;
    LAS int* tstart = (LAS int*)(lds + pg8::STAGE_BYTES); LAS int* tcnt = tstart + 40;
    moe_tiles(wv, P.ws, layer, tstart, tcnt);
    pg8::Gemm g{(const bf16_t*)(P.ws + WS_HID), (const bf16_t*)(P.ws + WS_EXPD), 0, 1024, DEXP};
    LAS int* ltabs = tstart + 128;
    pg8::MoeOrder S{tstart, tcnt, ltabs, (const int*)(P.ws + WS_LIST), (const char*)(P.ws + WS_EXPD), (size_t)1024 * 512 * 2, 4, 0, (int)gridDim.x, (int)blockIdx.x};
    pg8::EpiScatterG E{(bf16_t*)(P.ws + WS_YP)};
    for (int i = 0; i < 8; ++i) {
        pg8::UnitG u; if (!S.next(i, u)) break;
        const int tl = ltid(wv);
        const int* ul = (const int*)(P.ws + WS_LIST) + (size_t)u.e * LISTCAP + u.pm * pg8::BM;
        if (tl < pg8::BM) ltabs[i * pg8::BM + tl] = ul[tl < u.cnt ? tl : 0];
    }
    __syncthreads();
    pg8::gemm_phase_g(wv, (PG8_LAS unsigned char*)lds, g, S, E);
    __syncthreads();
}

constexpr int NCHUNK = NSTEPS / TCH;

constexpr int SSD_F = 32 + 64 + 64;
constexpr int SSD_BUF = TCH * SSD_F + 3 * TCH;

constexpr int ML_F = 64 + 64 + 32;
constexpr int ML_BUF = TCH * ML_F + 4 * TCH;

constexpr int HG_F = 128 + 128 + 32;
constexpr int HG_BUF = TCH * HG_F + TCH;

constexpr int RW_F = 5 * 64 + 32;
constexpr int RW_BUF = TCH * RW_F + TCH;
__device__ __forceinline__ void scan_rwkv(int wv, KP Pk, int layer, int unit, LAS char* lds) {
    asm volatile("" : "+s"(Pk));
    const CAS Params& P = *Pk;
    const int tid = ltid(wv);
    const int seq = unit >> 1, half = unit & 1, b = seq >> 4, h = (seq >> 1) & 7, dir = seq & 1;
    LAS float* bufs = (LAS float*)lds;
    bf16_t* Y = (bf16_t*)(P.ws + (dir ? WS_YB : WS_YF));
    const float* dec = (const float*)(P.ws + WS_RWDEC) + (size_t)dir * NROWS * 512;
    int tj[4], tg_[4]; bool tv[4]; const unsigned char* tbase[4]; int tlds[4];
#pragma unroll
    for (int s = 0; s < 4; ++s) {
        const int task = tid + NT * s; tv[s] = task < TCH * 52; tj[s] = task / 52; tg_[s] = task % 52;
        const int g = tg_[s];
        if (g < 8)       { tbase[s] = P.ws + WS_RWR  + (size_t)(h * 64 + 8 * g) * 2;              tlds[s] = 256 + 8 * g; }
        else if (g < 16) { tbase[s] = P.ws + WS_RWK  + (size_t)(h * 64 + 8 * (g - 8)) * 2;        tlds[s] = 192 + 8 * (g - 8); }
        else if (g < 24) { tbase[s] = P.ws + WS_RWKK + (size_t)(h * 64 + 8 * (g - 16)) * 2;       tlds[s] = 64 + 8 * (g - 16); }
        else if (g < 32) { tbase[s] = P.ws + WS_RWB  + (size_t)(h * 64 + 8 * (g - 24)) * 2;       tlds[s] = 128 + 8 * (g - 24); }
        else if (g < 36) { tbase[s] = P.ws + WS_RWV  + (size_t)(h * 64 + half * 32 + 8 * (g - 32)) * 2; tlds[s] = 320 + 8 * (g - 32); }
        else             { tbase[s] = (const unsigned char*)(dec + h * 64 + 4 * (g - 36));        tlds[s] = 4 * (g - 36); }
    }
    u32x4 rc[4]; int rrow = 0;
    auto load = [&](int c) {
#pragma unroll
        for (int s = 0; s < 4; ++s) {
            rc[s] = (u32x4){0u, 0u, 0u, 0u};
            if (tv[s]) { const int row = scan_row(c * TCH + tj[s], b, dir, 1); rc[s] = *(const u32x4*)(tbase[s] + (size_t)row * (tg_[s] < 36 ? 1024 : 2048)); }
        }
        if (tid < TCH) rrow = scan_row(c * TCH + tid, b, dir, 1);
    };
    auto store = [&](int c) {
        LAS float* buf = bufs + (c & 1) * RW_BUF;
#pragma unroll
        for (int s = 0; s < 4; ++s) {
            if (tv[s]) {
                LAS float* dst = buf + tj[s] * RW_F + tlds[s];
                const int g = tg_[s];
                if (g >= 36) { *(LAS u32x4*)dst = rc[s]; }
                else {
                    float f[8]; unpack8(rc[s], f);
                    const float sg = (g >= 16 && g < 24) ? -1.f : 1.f;
                    *(LAS f32x4*)dst = (f32x4){sg * f[0], sg * f[1], sg * f[2], sg * f[3]}; *(LAS f32x4*)(dst + 4) = (f32x4){sg * f[4], sg * f[5], sg * f[6], sg * f[7]};
                }
            }
        }
        if (tid < TCH) ((LAS int*)buf)[TCH * RW_F + tid] = rrow;
    };
    const int vrow = tid >> 4, q = tid & 15;
    float S[4] = {0.f, 0.f, 0.f, 0.f};
    load(0); store(0); __syncthreads();
    for (int c = 0; c < NCHUNK; ++c) {
        if (c + 1 < NCHUNK) load(c + 1);
        LAS float* buf = bufs + (c & 1) * RW_BUF;
        {
            const LAS float* wp = buf + 4 * q;
            const LAS float* vp = buf + 320 + vrow;
            f32x4 w4 = *(const LAS f32x4*)wp, a4 = *(const LAS f32x4*)(wp + 64), b4 = *(const LAS f32x4*)(wp + 128), k4 = *(const LAS f32x4*)(wp + 192), r4 = *(const LAS f32x4*)(wp + 256); float vr = vp[0];
#pragma unroll 1
            for (int jh = 0; jh < 2; ++jh) {
                float ysel = 0.f;
#pragma unroll
                for (int j = 0; j < 16; ++j) {
                    const int jj = jh * 16 + j;
                    const f32x4 wc = w4, ac = a4, bc = b4, kc = k4, rc = r4; const float vv = vr;
                    if (j < 15 || jh == 0) {
                        const LAS float* np = wp + (jj + 1) * RW_F;
                        w4 = *(const LAS f32x4*)np; a4 = *(const LAS f32x4*)(np + 64); b4 = *(const LAS f32x4*)(np + 128); k4 = *(const LAS f32x4*)(np + 192); r4 = *(const LAS f32x4*)(np + 256); vr = vp[(jj + 1) * RW_F];
                    }
                    float sa = S[0] * ac[0] + S[1] * ac[1] + S[2] * ac[2] + S[3] * ac[3];
                    sa = allreduce16(sa);
                    float y = 0.f;
#pragma unroll
                    for (int e = 0; e < 4; ++e) { S[e] = S[e] * wc[e] + (sa * bc[e] + vv * kc[e]); y += S[e] * rc[e]; }
                    y = allreduce16(y);
                    ysel = (q == j) ? y : ysel;
                }
                const int row = ((const LAS int*)buf)[TCH * RW_F + jh * 16 + q];
                Y[(size_t)row * D + 512 + h * 64 + half * 32 + vrow] = f2bf(ysel);
            }
        }
        if (c + 1 < NCHUNK) store(c + 1);
        __syncthreads();
    }
}

constexpr size_t WS_EXBC = WS_RWR;
constexpr size_t WS_EQK = WS_EXBC + (size_t)NROWS * 768 * 2;
constexpr size_t WS_EGT = WS_EQK + (size_t)NROWS * 512 * 2;
static_assert(WS_EGT + (size_t)NROWS * 32 * 4 <= WS_LA, "even-layer prepare buffers must fit in the RWKV region");

__device__ __forceinline__ void phase_prep_even(int wv, KP Pk, int layer) {
    asm volatile("" : "+s"(Pk));
    const CAS Params& P = *Pk;
    const int tid = ltid(wv), lane = tid & 63, wid = tid >> 6, i_ = layer >> 1;
    const bf16_t* Pb = (const bf16_t*)(P.ws + WS_P);
    bf16_t* XBC = (bf16_t*)(P.ws + WS_EXBC); bf16_t* QK = (bf16_t*)(P.ws + WS_EQK); float* GT = (float*)(P.ws + WS_EGT);
    float cw0[4][8], cw1[4][8], cwq[4][8];
#pragma unroll
    for (int e = 0; e < 8; ++e) {
#pragma unroll
        for (int t = 0; t < 3; ++t) {
            cw0[t][e] = P.ssd_conv_w[(size_t)(i_ * 3 + t) * 768 + 8 * lane + e];
            cw1[t][e] = P.ssd_conv_w[(size_t)(i_ * 3 + t) * 768 + 512 + 8 * (lane & 31) + e];
            cwq[t][e] = P.ml_conv_w[(size_t)(i_ * 3 + t) * 512 + 8 * lane + e];
        }
        cw0[3][e] = P.ssd_conv_b[i_ * 768 + 8 * lane + e]; cw1[3][e] = P.ssd_conv_b[i_ * 768 + 512 + 8 * (lane & 31) + e]; cwq[3][e] = P.ml_conv_b[i_ * 512 + 8 * lane + e];
    }
    float gbias = 0.f;
    if (lane < 16) gbias = P.ssd_dt_bias[i_ * 16 + lane]; else if (lane < 24) gbias = P.ml_i_bias[i_ * 8 + lane - 16]; else if (lane < 32) gbias = P.ml_f_bias[i_ * 8 + lane - 24];
    const float qscl = lane < 32 ? 0.125f : 1.f;
    for (int r = blockIdx.x * 8 + wid; r < NROWS; r += gridDim.x * 8) {
        int t, len; row_seg(r, t, len);
        const bf16_t* pr = Pb + (size_t)r * LDP_EVEN;
        const bool hp = t > 0, hn = t < len - 1;
        const u32x4 zero = (u32x4){0u, 0u, 0u, 0u};
        float fc[8], fp[8], fn[8], o[8];
        {
            const int col = 512 + 8 * lane;
            unpack8(*(const u32x4*)(pr + col), fc); unpack8(hp ? *(const u32x4*)(pr - LDP_EVEN + col) : zero, fp); unpack8(hn ? *(const u32x4*)(pr + LDP_EVEN + col) : zero, fn);
#pragma unroll
            for (int e = 0; e < 8; ++e) o[e] = siluf_(cw0[0][e] * fp[e] + cw0[1][e] * fc[e] + cw0[2][e] * fn[e] + cw0[3][e]);
            *(u32x4*)(XBC + (size_t)r * 768 + 8 * lane) = pack8(o);
        }
        if (lane < 32) {
            const int col = 1024 + 8 * lane;
            unpack8(*(const u32x4*)(pr + col), fc); unpack8(hp ? *(const u32x4*)(pr - LDP_EVEN + col) : zero, fp); unpack8(hn ? *(const u32x4*)(pr + LDP_EVEN + col) : zero, fn);
#pragma unroll
            for (int e = 0; e < 8; ++e) o[e] = siluf_(cw1[0][e] * fp[e] + cw1[1][e] * fc[e] + cw1[2][e] * fn[e] + cw1[3][e]);
            *(u32x4*)(XBC + (size_t)r * 768 + 512 + 8 * lane) = pack8(o);
        }
        {
            const int col = 1296 + 8 * lane;
            unpack8(*(const u32x4*)(pr + col), fc); unpack8(hp ? *(const u32x4*)(pr - LDP_EVEN + col) : zero, fp); unpack8(hn ? *(const u32x4*)(pr + LDP_EVEN + col) : zero, fn);
#pragma unroll
            for (int e = 0; e < 8; ++e) o[e] = qscl * siluf_(cwq[0][e] * fp[e] + cwq[1][e] * fc[e] + cwq[2][e] * fn[e] + cwq[3][e]);
            *(u32x4*)(QK + (size_t)r * 512 + 8 * lane) = pack8(o);
        }
        if (lane < 32) {
            const int col = lane < 16 ? 1280 + lane : 2832 + (lane - 16);
            const float x = bf2f(pr[col]) + gbias;
            GT[(size_t)r * 32 + lane] = lane < 16 ? softplusf_(x) : lane < 24 ? x : logsigmoidf_(x);
        }
    }
}

constexpr int CL = 64, NCH64 = NSTEPS / CL, LDT = 72, LDTB = LDT * 2;
__device__ __forceinline__ bf16x8 ldfrag(const LAS char* tile, int ldb, int row0, int k0, int lane) {
    return *(const LAS bf16x8*)(tile + (row0 + (lane & 15)) * ldb + (k0 + 8 * (lane >> 4)) * 2);
}
__device__ __forceinline__ void st4bf(LAS char* p, const f32x4& v) { u32x2 o; o.x = pk2(v[0], v[1]); o.y = pk2(v[2], v[3]); *(LAS u32x2*)p = o; }

constexpr int SS_BT = 0, SS_CT = SS_BT + 64 * LDTB, SS_BDT = SS_CT + 64 * LDTB, SS_XT = SS_BDT + 64 * LDTB, SS_CUM = SS_XT + 32 * LDTB, SS_DTV = SS_CUM + 256, SS_ROWS = SS_DTV + 256, SS_STG = SS_ROWS + 256;
constexpr int SS_M = 2 * SS_STG, SS_HB = SS_M + 64 * LDTB, SS_END = SS_HB + 32 * LDTB;
static_assert(SS_END <= LDS_BYTES - 16, "SSD LDS map");

constexpr int MS_QT = 0, MS_KT = MS_QT + 64 * LDTB, MS_KET = MS_KT + 64 * LDTB, MS_VT = MS_KET + 64 * LDTB, MS_SC = MS_VT + 32 * LDTB;
constexpr int MS_STG = MS_SC + 8 * 256;
constexpr int MS_W = 2 * MS_STG, MS_CB = MS_W + 64 * LDTB, MS_ONE = MS_CB + 32 * LDTB, MS_NV = MS_ONE + 16 * LDTB, MS_QN = MS_NV + 256, MS_END = MS_QN + 256;
static_assert(MS_END <= LDS_BYTES - 16, "mLSTM LDS map");

constexpr size_t WS_XSS = WS_EGT + al256((size_t)NROWS * 32 * 4);
constexpr size_t XSS_BYTES = (size_t)64 * NCH64 * 64 * 64 * 2;
constexpr size_t WS_XSD = WS_XSS + XSS_BYTES;
constexpr size_t WS_XMC = WS_XSD + al256((size_t)64 * NCH64 * 4);
constexpr size_t XMC_BYTES = (size_t)32 * NCH64 * 128 * 64 * 2;
constexpr size_t WS_XMN = WS_XMC + XMC_BYTES;
constexpr size_t WS_XMS = WS_XMN + (size_t)32 * NCH64 * 64 * 4;
constexpr size_t WS_XMT = WS_XMS + al256((size_t)32 * NCH64 * 4 * 4);
constexpr size_t WS_XEND = WS_XMT + (size_t)32 * NCH64 * 3 * 64 * 4;
static_assert(WS_XEND <= WS_END, "even-layer chunk-state buffers must fit in the RWKV region");
constexpr int NSSD_ITEMS = 64 * NCH64, NML_ITEMS = 32 * NCH64;

template <int CTRL, int RM, int BM> __device__ __forceinline__ float dppx(float old, float v) {
    return __builtin_bit_cast(float, __builtin_amdgcn_update_dpp(__builtin_bit_cast(int, old), __builtin_bit_cast(int, v), CTRL, RM, BM, false));
}
__device__ __forceinline__ float wave_cumsum(float v, int) {
    float t = v;
    t += dppx<0x111, 0xf, 0xf>(0.f, v); t += dppx<0x112, 0xf, 0xf>(0.f, v); t += dppx<0x113, 0xf, 0xf>(0.f, v);
    { const float u = dppx<0x114, 0xf, 0xe>(0.f, t); t += u; }
    { const float u = dppx<0x118, 0xf, 0xc>(0.f, t); t += u; }
    { const float u = dppx<0x142, 0xa, 0xf>(0.f, t); t += u; }
    { const float u = dppx<0x143, 0xc, 0xf>(0.f, t); t += u; }
    return t;
}
__device__ __forceinline__ float wave_cummax(float v, int) {
    const float ninf = -__builtin_huge_valf();
    float t = v;
    t = fmaxf(t, dppx<0x111, 0xf, 0xf>(ninf, v)); t = fmaxf(t, dppx<0x112, 0xf, 0xf>(ninf, v)); t = fmaxf(t, dppx<0x113, 0xf, 0xf>(ninf, v));
    { const float u = dppx<0x114, 0xf, 0xe>(ninf, t); t = fmaxf(t, u); }
    { const float u = dppx<0x118, 0xf, 0xc>(ninf, t); t = fmaxf(t, u); }
    { const float u = dppx<0x142, 0xa, 0xf>(ninf, t); t = fmaxf(t, u); }
    { const float u = dppx<0x143, 0xc, 0xf>(ninf, t); t = fmaxf(t, u); }
    return t;
}
__device__ __forceinline__ float wave_max(float v) {
    const float t = wave_cummax(v, 0);
    return __builtin_bit_cast(float, __builtin_amdgcn_readlane(__builtin_bit_cast(int, t), 63));
}

constexpr int X1S_BDT = 0, X1S_XT = X1S_BDT + 64 * LDTB, X1S_CUM = X1S_XT + 64 * LDTB, X1S_DTV = X1S_CUM + 256, X1S_END = X1S_DTV + 256;
constexpr int X1M_KET = 0, X1M_VT = X1M_KET + 64 * LDTB, X1M_ONE = X1M_VT + 128 * LDTB, X1M_EE = X1M_ONE + 16 * LDTB, X1M_END = X1M_EE + 256;
__device__ __forceinline__ void phase_ex1(int wv, KP Pk, int layer, LAS char* lds) {
    asm volatile("" : "+s"(Pk));
    const CAS Params& P = *Pk;
    const int tid = ltid(wv), lane = tid & 63, wid = tid >> 6, q = lane >> 4, r16 = lane & 15, i_ = layer >> 1;
    const bf16_t* XBC = (const bf16_t*)(P.ws + WS_EXBC); const bf16_t* QK = (const bf16_t*)(P.ws + WS_EQK); const bf16_t* Pb = (const bf16_t*)(P.ws + WS_P);
    const float* GT = (const float*)(P.ws + WS_EGT);
    {
        bf16_t* Hst = (bf16_t*)(P.ws + WS_XSS); float* Dst = (float*)(P.ws + WS_XSD);
        u32x4 rc[2]; float rdt = 0.f;
        auto geom = [&](int it, int& b, int& h, int& dir, int& c) { const int sq = it / NCH64; c = it - sq * NCH64; b = sq >> 4; h = (sq >> 1) & 7; dir = sq & 1; };
        auto load = [&](int it) {
            int b, h, dir, c; geom(it, b, h, dir, c);
            int tl = tid; asm volatile("" : "+v"(tl));
#pragma unroll
            for (int s = 0; s < 2; ++s) {
                const int task = tl + NT * s, j = task >> 4, g = task & 15;
                const int row = scan_row(c * CL + j, b, dir, 0);
                rc[s] = *(const u32x4*)(XBC + (size_t)row * 768 + (g < 8 ? h * 64 + 8 * g : 512 + (h >> 2) * 64 + 8 * (g - 8)));
            }
            if (tl < CL) { const int row = scan_row(c * CL + tl, b, dir, 0); rdt = GT[(size_t)row * 32 + dir * 8 + h]; }
        };
        int it = blockIdx.x;
        if (it < NSSD_ITEMS) load(it);
        for (; it < NSSD_ITEMS; it += gridDim.x) {
            int b, h, dir, c; geom(it, b, h, dir, c);
            const float aco = -__expf(P.ssd_a_log[(i_ * 2 + dir) * 8 + h]);
            if (tid < CL) {
                const float cum = wave_cumsum(rdt * aco, lane);
                ((LAS float*)(lds + X1S_CUM))[tid] = cum; ((LAS float*)(lds + X1S_DTV))[tid] = rdt;
            }
            __syncthreads();
            {
                const LAS float* cum = (const LAS float*)(lds + X1S_CUM);
                const float cumL = cum[CL - 1];
                int tl = tid; asm volatile("" : "+v"(tl));
#pragma unroll
                for (int s = 0; s < 2; ++s) {
                    const int task = tl + NT * s, j = task >> 4, g = task & 15;
                    float f[8]; unpack8(rc[s], f);
                    if (g < 8) {
                        const float dt = ((const LAS float*)(lds + X1S_DTV))[j];
#pragma unroll
                        for (int e = 0; e < 8; ++e) *(LAS bf16_t*)(lds + X1S_XT + (8 * g + e) * LDTB + j * 2) = f2bf(f[e] * dt);
                    } else {
                        const float sc = __expf(cumL - cum[j]);
#pragma unroll
                        for (int e = 0; e < 8; ++e) *(LAS bf16_t*)(lds + X1S_BDT + (8 * (g - 8) + e) * LDTB + j * 2) = f2bf(f[e] * sc);
                    }
                }
                if (tid == 0) Dst[it] = __expf(cumL);
            }
            if (it + (int)gridDim.x < NSSD_ITEMS) load(it + gridDim.x);
            __syncthreads();
            {
                const int pt = wid >> 1;
#pragma unroll
                for (int u = 0; u < 2; ++u) {
                    const int nt = (wid & 1) * 2 + u;
                    f32x4 sa = (f32x4){0.f, 0.f, 0.f, 0.f};
#pragma unroll
                    for (int k0 = 0; k0 < 64; k0 += 32) sa = __builtin_amdgcn_mfma_f32_16x16x32_bf16(ldfrag(lds + X1S_BDT, LDTB, nt * 16, k0, lane), ldfrag(lds + X1S_XT, LDTB, pt * 16, k0, lane), sa, 0, 0, 0);
                    u32x2 o; o.x = pk2(sa[0], sa[1]); o.y = pk2(sa[2], sa[3]);
                    *(u32x2*)(Hst + ((size_t)it * 64 + pt * 16 + r16) * 64 + nt * 16 + 4 * q) = o;
                }
            }
            __syncthreads();
        }
    }
    {
        bf16_t* Cst = (bf16_t*)(P.ws + WS_XMC); float* Nst = (float*)(P.ws + WS_XMN); float* Sst = (float*)(P.ws + WS_XMS); float* Tst = (float*)(P.ws + WS_XMT);
        for (int i = tid; i < 16 * LDTB / 4; i += NT) ((LAS unsigned*)(lds + X1M_ONE))[i] = 0x3f803f80u;
        u32x4 rc[3]; float rli = 0.f, rlf = 0.f;
        auto geom = [&](int it, int& b, int& h, int& dir, int& c) { const int sq = it / NCH64; c = it - sq * NCH64; b = sq >> 3; h = (sq >> 1) & 3; dir = sq & 1; };
        auto load = [&](int it) {
            int b, h, dir, c; geom(it, b, h, dir, c);
            int tl = tid; asm volatile("" : "+v"(tl));
#pragma unroll
            for (int s = 0; s < 3; ++s) {
                const int task = tl + NT * s, j = task / 24, g = task - 24 * j;
                const int row = scan_row(c * CL + j, b, dir, 0);
                rc[s] = g < 8 ? *(const u32x4*)(QK + (size_t)row * 512 + 256 + h * 64 + 8 * g) : *(const u32x4*)(Pb + (size_t)row * LDP_EVEN + 1808 + h * 128 + 8 * (g - 8));
            }
            if (tl < CL) { const int row = scan_row(c * CL + tl, b, dir, 0); rli = GT[(size_t)row * 32 + 16 + dir * 4 + h]; rlf = GT[(size_t)row * 32 + 24 + dir * 4 + h]; }
        };
        int it = blockIdx.x;
        if (it < NML_ITEMS) load(it);
        __syncthreads();
        for (; it < NML_ITEMS; it += gridDim.x) {
            if (tid < CL) {
                const float fcum = wave_cumsum(rlf, lane);
                const float ftot = __builtin_bit_cast(float, __builtin_amdgcn_readlane(__builtin_bit_cast(int, fcum), 63));
                const float g = rli - fcum, pm = wave_cummax(g, lane);
                const float wend = ftot + g, mloc = wave_max(wend);
                ((LAS float*)(lds + X1M_EE))[tid] = __expf(wend - mloc);
                float* tp = Tst + (size_t)it * 192;
                tp[tid] = fcum; tp[64 + tid] = g; tp[128 + tid] = pm;
                if (tid == 0) { Sst[(size_t)it * 4 + 0] = ftot; Sst[(size_t)it * 4 + 1] = mloc; }
            }
            __syncthreads();
            {
                const LAS float* ee = (const LAS float*)(lds + X1M_EE);
                int tl = tid; asm volatile("" : "+v"(tl));
#pragma unroll
                for (int s = 0; s < 3; ++s) {
                    const int task = tl + NT * s, j = task / 24, g = task - 24 * j;
                    if (g < 8) {
                        float f[8]; unpack8(rc[s], f);
                        const float e1 = ee[j];
#pragma unroll
                        for (int e = 0; e < 8; ++e) *(LAS bf16_t*)(lds + X1M_KET + (8 * g + e) * LDTB + j * 2) = f2bf(f[e] * e1);
                    } else {
                        const int v0 = 8 * (g - 8);
#pragma unroll
                        for (int e = 0; e < 8; ++e) { const unsigned wv = rc[s][e >> 1]; *(LAS bf16_t*)(lds + X1M_VT + (v0 + e) * LDTB + j * 2) = (bf16_t)((e & 1) ? (wv >> 16) : (wv & 0xffffu)); }
                    }
                }
            }
            if (it + (int)gridDim.x < NML_ITEMS) load(it + gridDim.x);
            __syncthreads();
            {
                const bf16x8 vf0 = ldfrag(lds + X1M_VT, LDTB, wid * 16, 0, lane), vf1 = ldfrag(lds + X1M_VT, LDTB, wid * 16, 32, lane);
#pragma unroll
                for (int kt = 0; kt < 4; ++kt) {
                    f32x4 sa = __builtin_amdgcn_mfma_f32_16x16x32_bf16(ldfrag(lds + X1M_KET, LDTB, kt * 16, 0, lane), vf0, (f32x4){0.f, 0.f, 0.f, 0.f}, 0, 0, 0);
                    sa = __builtin_amdgcn_mfma_f32_16x16x32_bf16(ldfrag(lds + X1M_KET, LDTB, kt * 16, 32, lane), vf1, sa, 0, 0, 0);
                    u32x2 o; o.x = pk2(sa[0], sa[1]); o.y = pk2(sa[2], sa[3]);
                    *(u32x2*)(Cst + ((size_t)it * 128 + wid * 16 + r16) * 64 + kt * 16 + 4 * q) = o;
                }
                if (wid < 4) {
                    f32x4 na = __builtin_amdgcn_mfma_f32_16x16x32_bf16(ldfrag(lds + X1M_KET, LDTB, wid * 16, 0, lane), ldfrag(lds + X1M_ONE, LDTB, 0, 0, lane), (f32x4){0.f, 0.f, 0.f, 0.f}, 0, 0, 0);
                    na = __builtin_amdgcn_mfma_f32_16x16x32_bf16(ldfrag(lds + X1M_KET, LDTB, wid * 16, 32, lane), ldfrag(lds + X1M_ONE, LDTB, 0, 32, lane), na, 0, 0, 0);
                    if (r16 == 0) *(f32x4*)(Nst + (size_t)it * 64 + wid * 16 + 4 * q) = na;
                }
            }
            __syncthreads();
        }
    }
}

__device__ __forceinline__ void phase_ex2(int wv, KP Pk, int layer) {
    asm volatile("" : "+s"(Pk));
    const CAS Params& P = *Pk;
    const int tid = ltid(wv);
    (void)layer;
    if (blockIdx.x < 128) {
        const int gt = blockIdx.x * NT + tid, sq = gt >> 10, rem = gt & 1023;
        bf16_t* Hst = (bf16_t*)(P.ws + WS_XSS) + (size_t)sq * NCH64 * 4096 + rem * 4;
        const float* Dst = (const float*)(P.ws + WS_XSD) + sq * NCH64;
        float h0 = 0.f, h1 = 0.f, h2 = 0.f, h3 = 0.f;
#pragma unroll 4
        for (int c = 0; c < NCH64; ++c) {
            const u32x2 loc = *(const u32x2*)(Hst + (size_t)c * 4096);
            const float d = Dst[c];
            u32x2 o; o.x = pk2(h0, h1); o.y = pk2(h2, h3);
            *(u32x2*)(Hst + (size_t)c * 4096) = o;
            h0 = d * h0 + bflo(loc.x); h1 = d * h1 + bfhi(loc.x); h2 = d * h2 + bflo(loc.y); h3 = d * h3 + bfhi(loc.y);
        }
    } else if (blockIdx.x < 256) {
        const int gt = (blockIdx.x - 128) * NT + tid, sq = gt >> 11, rem = gt & 2047;
        bf16_t* Cst = (bf16_t*)(P.ws + WS_XMC) + (size_t)sq * NCH64 * 8192 + rem * 4;
        float* Nst = (float*)(P.ws + WS_XMN) + (size_t)sq * NCH64 * 64 + (rem & 15) * 4;
        float* Sst = (float*)(P.ws + WS_XMS) + (size_t)sq * NCH64 * 4;
        const bool own_n = rem < 16, own_m = rem == 0;
        float c0 = 0.f, c1 = 0.f, c2 = 0.f, c3 = 0.f, m = -1e30f;
        f32x4 nn = (f32x4){0.f, 0.f, 0.f, 0.f};
#pragma unroll 2
        for (int c = 0; c < NCH64; ++c) {
            const u32x2 loc = *(const u32x2*)(Cst + (size_t)c * 8192);
            const float ftot = Sst[c * 4 + 0], mloc = Sst[c * 4 + 1];
            const float mnew = fmaxf(ftot + m, mloc), sp = __expf(ftot + m - mnew), sl = __expf(mloc - mnew);
            u32x2 o; o.x = pk2(c0, c1); o.y = pk2(c2, c3);
            *(u32x2*)(Cst + (size_t)c * 8192) = o;
            c0 = sp * c0 + sl * bflo(loc.x); c1 = sp * c1 + sl * bfhi(loc.x); c2 = sp * c2 + sl * bflo(loc.y); c3 = sp * c3 + sl * bfhi(loc.y);
            if (own_n) { const f32x4 nl = *(const f32x4*)(Nst + (size_t)c * 64); *(f32x4*)(Nst + (size_t)c * 64) = nn; nn = nn * sp + nl * sl; }
            if (own_m) Sst[c * 4 + 2] = m;
            m = mnew;
        }
    }
}

constexpr int X3S_BT = 0, X3S_CT = X3S_BT + 64 * LDTB, X3S_XT = X3S_CT + 64 * LDTB, X3S_HB = X3S_XT + 64 * LDTB, X3S_M = X3S_HB + 64 * LDTB, X3S_CUM = X3S_M + 64 * LDTB, X3S_DTV = X3S_CUM + 256, X3S_ROWS = X3S_DTV + 256, X3S_END = X3S_ROWS + 256;
constexpr int X3M_QT = 0, X3M_KT = X3M_QT + 64 * LDTB, X3M_VT = X3M_KT + 64 * LDTB, X3M_CB = X3M_VT + 128 * LDTB, X3M_W = X3M_CB + 128 * LDTB, X3M_ONE = X3M_W + 64 * LDTB, X3M_NB = X3M_ONE + 16 * LDTB,
              X3M_SC = X3M_NB + 16 * LDTB, X3M_END = X3M_SC + 6 * 256;
static_assert(X3M_END <= LDS_BYTES - 16 && X3S_END <= LDS_BYTES - 16, "EX3 LDS maps");
__device__ __forceinline__ void phase_ex3(int wv, KP Pk, int layer, LAS char* lds) {
    asm volatile("" : "+s"(Pk));
    const CAS Params& P = *Pk;
    const int tid = ltid(wv), lane = tid & 63, wid = tid >> 6, q = lane >> 4, r16 = lane & 15, i_ = layer >> 1;
    const bf16_t* XBC = (const bf16_t*)(P.ws + WS_EXBC); const bf16_t* QK = (const bf16_t*)(P.ws + WS_EQK); const bf16_t* Pb = (const bf16_t*)(P.ws + WS_P);
    const float* GT = (const float*)(P.ws + WS_EGT);
    {
        const bf16_t* Hst = (const bf16_t*)(P.ws + WS_XSS);
        u32x4 rc[3], rh; float rdt = 0.f; int rrow = 0;
        auto geom = [&](int it, int& b, int& h, int& dir, int& c) { const int sq = it / NCH64; c = it - sq * NCH64; b = sq >> 4; h = (sq >> 1) & 7; dir = sq & 1; };
        auto load = [&](int it) {
            int b, h, dir, c; geom(it, b, h, dir, c);
            int tl = tid; asm volatile("" : "+v"(tl));
#pragma unroll
            for (int s = 0; s < 3; ++s) {
                const int task = tl + NT * s, j = task / 24, g = task - 24 * j;
                const int row = scan_row(c * CL + j, b, dir, 0);
                rc[s] = *(const u32x4*)(XBC + (size_t)row * 768 + (g < 8 ? h * 64 + 8 * g : g < 16 ? 512 + (h >> 2) * 64 + 8 * (g - 8) : 640 + (h >> 2) * 64 + 8 * (g - 16)));
            }
            rh = *(const u32x4*)(Hst + (size_t)it * 4096 + tl * 8);
            if (tl < CL) { rrow = scan_row(c * CL + tl, b, dir, 0); rdt = GT[(size_t)rrow * 32 + dir * 8 + h]; }
        };
        int it = blockIdx.x;
        if (it < NSSD_ITEMS) load(it);
        __syncthreads();
        for (; it < NSSD_ITEMS; it += gridDim.x) {
            int b, h, dir, c; geom(it, b, h, dir, c);
            bf16_t* Y = (bf16_t*)(P.ws + (dir ? WS_YB : WS_YF));
            const float aco = -__expf(P.ssd_a_log[(i_ * 2 + dir) * 8 + h]);
            if (tid < CL) {
                const float cum = wave_cumsum(rdt * aco, lane);
                ((LAS float*)(lds + X3S_CUM))[tid] = cum; ((LAS float*)(lds + X3S_DTV))[tid] = rdt; ((LAS int*)(lds + X3S_ROWS))[tid] = rrow;
            }
            __syncthreads();
            {
                int tl = tid; asm volatile("" : "+v"(tl));
#pragma unroll
                for (int s = 0; s < 3; ++s) {
                    const int task = tl + NT * s, j = task / 24, g = task - 24 * j;
                    if (g < 8) {
                        float f[8]; unpack8(rc[s], f);
                        const float dt = ((const LAS float*)(lds + X3S_DTV))[j];
#pragma unroll
                        for (int e = 0; e < 8; ++e) *(LAS bf16_t*)(lds + X3S_XT + (8 * g + e) * LDTB + j * 2) = f2bf(f[e] * dt);
                    } else if (g < 16) *(LAS u32x4*)(lds + X3S_BT + j * LDTB + 8 * (g - 8) * 2) = rc[s];
                    else *(LAS u32x4*)(lds + X3S_CT + j * LDTB + 8 * (g - 16) * 2) = rc[s];
                }
                *(LAS u32x4*)(lds + X3S_HB + (tl >> 3) * LDTB + (tl & 7) * 16) = rh;
            }
            if (it + (int)gridDim.x < NSSD_ITEMS) load(it + gridDim.x);
            __syncthreads();
            const LAS float* cum = (const LAS float*)(lds + X3S_CUM);
            {
                const int lt = wid >> 1;
#pragma unroll
                for (int u = 0; u < 2; ++u) {
                    const int st = (wid & 1) * 2 + u;
                    f32x4 acc = (f32x4){0.f, 0.f, 0.f, 0.f};
                    if (st <= lt) {
#pragma unroll
                        for (int k0 = 0; k0 < 64; k0 += 32) acc = __builtin_amdgcn_mfma_f32_16x16x32_bf16(ldfrag(lds + X3S_BT, LDTB, st * 16, k0, lane), ldfrag(lds + X3S_CT, LDTB, lt * 16, k0, lane), acc, 0, 0, 0);
                        const int l = lt * 16 + r16, s0 = st * 16 + 4 * q;
                        const float cl = cum[l]; const f32x4 cs = *(const LAS f32x4*)(cum + s0);
#pragma unroll
                        for (int j = 0; j < 4; ++j) acc[j] = (s0 + j <= l) ? acc[j] * __expf(cl - cs[j]) : 0.f;
                    }
                    st4bf(lds + X3S_M + (lt * 16 + r16) * LDTB + (st * 16 + 4 * q) * 2, acc);
                }
            }
            __syncthreads();
            {
                const int lt = wid >> 1, l = lt * 16 + r16;
                const float el = __expf(cum[l]);
                const int row = ((const LAS int*)(lds + X3S_ROWS))[l];
                const bf16x8 mf0 = ldfrag(lds + X3S_M, LDTB, lt * 16, 0, lane), mf1 = ldfrag(lds + X3S_M, LDTB, lt * 16, 32, lane);
                const bf16x8 cf0 = ldfrag(lds + X3S_CT, LDTB, lt * 16, 0, lane), cf1 = ldfrag(lds + X3S_CT, LDTB, lt * 16, 32, lane);
#pragma unroll
                for (int u = 0; u < 2; ++u) {
                    const int pt = (wid & 1) * 2 + u;
                    f32x4 ya = __builtin_amdgcn_mfma_f32_16x16x32_bf16(ldfrag(lds + X3S_XT, LDTB, pt * 16, 0, lane), mf0, (f32x4){0.f, 0.f, 0.f, 0.f}, 0, 0, 0);
                    ya = __builtin_amdgcn_mfma_f32_16x16x32_bf16(ldfrag(lds + X3S_XT, LDTB, pt * 16, 32, lane), mf1, ya, 0, 0, 0);
                    f32x4 oa = __builtin_amdgcn_mfma_f32_16x16x32_bf16(ldfrag(lds + X3S_HB, LDTB, pt * 16, 0, lane), cf0, (f32x4){0.f, 0.f, 0.f, 0.f}, 0, 0, 0);
                    oa = __builtin_amdgcn_mfma_f32_16x16x32_bf16(ldfrag(lds + X3S_HB, LDTB, pt * 16, 32, lane), cf1, oa, 0, 0, 0);
                    u32x2 o; o.x = pk2(ya[0] + el * oa[0], ya[1] + el * oa[1]); o.y = pk2(ya[2] + el * oa[2], ya[3] + el * oa[3]);
                    *(u32x2*)(Y + (size_t)row * D + h * 64 + pt * 16 + 4 * q) = o;
                }
            }
            __syncthreads();
        }
    }
    {
        const bf16_t* Cst = (const bf16_t*)(P.ws + WS_XMC); const float* Nst = (const float*)(P.ws + WS_XMN); const float* Sst = (const float*)(P.ws + WS_XMS); const float* Tst = (const float*)(P.ws + WS_XMT);
        for (int i = tid; i < 16 * LDTB / 4; i += NT) ((LAS unsigned*)(lds + X3M_ONE))[i] = 0x3f803f80u;
        u32x4 rc[4], rcb[2]; float rfc = 0.f, rg = 0.f, rpm = 0.f, rmp = 0.f, rn = 0.f; int rrow = 0;
        auto geom = [&](int it, int& b, int& h, int& dir, int& c) { const int sq = it / NCH64; c = it - sq * NCH64; b = sq >> 3; h = (sq >> 1) & 3; dir = sq & 1; };
        auto load = [&](int it) {
            int b, h, dir, c; geom(it, b, h, dir, c);
            int tl = tid; asm volatile("" : "+v"(tl));
#pragma unroll
            for (int s = 0; s < 4; ++s) {
                const int task = tl + NT * s, j = task >> 5, g = task & 31;
                const int row = scan_row(c * CL + j, b, dir, 0);
                rc[s] = g < 16 ? *(const u32x4*)(QK + (size_t)row * 512 + (g < 8 ? h * 64 + 8 * g : 256 + h * 64 + 8 * (g - 8))) : *(const u32x4*)(Pb + (size_t)row * LDP_EVEN + 1808 + h * 128 + 8 * (g - 16));
            }
#pragma unroll
            for (int s = 0; s < 2; ++s) rcb[s] = *(const u32x4*)(Cst + (size_t)it * 8192 + (tl + NT * s) * 8);
            if (tl < CL) {
                rrow = scan_row(c * CL + tl, b, dir, 0);
                const float* tp = Tst + (size_t)it * 192;
                rfc = tp[tl]; rg = tp[64 + tl]; rpm = tp[128 + tl]; rmp = Sst[(size_t)it * 4 + 2]; rn = Nst[(size_t)it * 64 + tl];
            }
        };
        int it = blockIdx.x;
        if (it < NML_ITEMS) load(it);
        __syncthreads();
        for (; it < NML_ITEMS; it += gridDim.x) {
            int b, h, dir, c; geom(it, b, h, dir, c);
            bf16_t* Y = (bf16_t*)(P.ws + (dir ? WS_YB : WS_YF));
            LAS float* sc = (LAS float*)(lds + X3M_SC);
            {
                int tl = tid; asm volatile("" : "+v"(tl));
#pragma unroll
                for (int s = 0; s < 4; ++s) {
                    const int task = tl + NT * s, j = task >> 5, g = task & 31;
                    if (g < 8) *(LAS u32x4*)(lds + X3M_QT + j * LDTB + 8 * g * 2) = rc[s];
                    else if (g < 16) *(LAS u32x4*)(lds + X3M_KT + j * LDTB + 8 * (g - 8) * 2) = rc[s];
                    else {
                        const int v0 = 8 * (g - 16);
#pragma unroll
                        for (int e = 0; e < 8; ++e) { const unsigned wv = rc[s][e >> 1]; *(LAS bf16_t*)(lds + X3M_VT + (v0 + e) * LDTB + j * 2) = (bf16_t)((e & 1) ? (wv >> 16) : (wv & 0xffffu)); }
                    }
                }
#pragma unroll
                for (int s = 0; s < 2; ++s) { const int ch = tl + NT * s; *(LAS u32x4*)(lds + X3M_CB + (ch >> 3) * LDTB + (ch & 7) * 16) = rcb[s]; }
                if (tl < CL) {
                    const float linter = rfc + rmp, mrow = fmaxf(rfc + rpm, linter);
                    sc[tl] = rfc - mrow; sc[64 + tl] = rg; sc[128 + tl] = __expf(linter - mrow); sc[192 + tl] = __expf(-mrow); ((LAS int*)sc)[256 + tl] = rrow;
                    const bf16_t nb = f2bf(rn);
#pragma unroll
                    for (int r = 0; r < 16; ++r) *(LAS bf16_t*)(lds + X3M_NB + r * LDTB + tl * 2) = nb;
                }
            }
            if (it + (int)gridDim.x < NML_ITEMS) load(it + gridDim.x);
            __syncthreads();
            {
                const int lt = wid >> 1;
#pragma unroll
                for (int u = 0; u < 2; ++u) {
                    const int st = (wid & 1) * 2 + u;
                    f32x4 acc = (f32x4){0.f, 0.f, 0.f, 0.f};
                    if (st <= lt) {
#pragma unroll
                        for (int k0 = 0; k0 < 64; k0 += 32) acc = __builtin_amdgcn_mfma_f32_16x16x32_bf16(ldfrag(lds + X3M_KT, LDTB, st * 16, k0, lane), ldfrag(lds + X3M_QT, LDTB, lt * 16, k0, lane), acc, 0, 0, 0);
                        const int l = lt * 16 + r16, s0 = st * 16 + 4 * q;
                        const float rt = sc[l]; const f32x4 gs = *(const LAS f32x4*)(sc + 64 + s0);
#pragma unroll
                        for (int j = 0; j < 4; ++j) acc[j] = (s0 + j <= l) ? acc[j] * __expf(rt + gs[j]) : 0.f;
                    }
                    st4bf(lds + X3M_W + (lt * 16 + r16) * LDTB + (st * 16 + 4 * q) * 2, acc);
                }
            }
            __syncthreads();
            {
                const int lt = wid >> 1, l = lt * 16 + r16;
                const bf16x8 wf0 = ldfrag(lds + X3M_W, LDTB, lt * 16, 0, lane), wf1 = ldfrag(lds + X3M_W, LDTB, lt * 16, 32, lane);
                const bf16x8 qf0 = ldfrag(lds + X3M_QT, LDTB, lt * 16, 0, lane), qf1 = ldfrag(lds + X3M_QT, LDTB, lt * 16, 32, lane);
                f32x4 da = __builtin_amdgcn_mfma_f32_16x16x32_bf16(ldfrag(lds + X3M_ONE, LDTB, 0, 0, lane), wf0, (f32x4){0.f, 0.f, 0.f, 0.f}, 0, 0, 0);
                da = __builtin_amdgcn_mfma_f32_16x16x32_bf16(ldfrag(lds + X3M_ONE, LDTB, 0, 32, lane), wf1, da, 0, 0, 0);
                f32x4 qn = __builtin_amdgcn_mfma_f32_16x16x32_bf16(ldfrag(lds + X3M_NB, LDTB, 0, 0, lane), qf0, (f32x4){0.f, 0.f, 0.f, 0.f}, 0, 0, 0);
                qn = __builtin_amdgcn_mfma_f32_16x16x32_bf16(ldfrag(lds + X3M_NB, LDTB, 0, 32, lane), qf1, qn, 0, 0, 0);
                const float inter = sc[128 + l], emr = sc[192 + l];
                const float inv = __builtin_amdgcn_rcpf(fmaxf(fabsf(da[0] + inter * qn[0]), emr));
                const int row = ((const LAS int*)sc)[256 + l];
#pragma unroll
                for (int u = 0; u < 4; ++u) {
                    const int vt = (wid & 1) * 4 + u;
                    f32x4 na = __builtin_amdgcn_mfma_f32_16x16x32_bf16(ldfrag(lds + X3M_VT, LDTB, vt * 16, 0, lane), wf0, (f32x4){0.f, 0.f, 0.f, 0.f}, 0, 0, 0);
                    na = __builtin_amdgcn_mfma_f32_16x16x32_bf16(ldfrag(lds + X3M_VT, LDTB, vt * 16, 32, lane), wf1, na, 0, 0, 0);
                    f32x4 ca = __builtin_amdgcn_mfma_f32_16x16x32_bf16(ldfrag(lds + X3M_CB, LDTB, vt * 16, 0, lane), qf0, (f32x4){0.f, 0.f, 0.f, 0.f}, 0, 0, 0);
                    ca = __builtin_amdgcn_mfma_f32_16x16x32_bf16(ldfrag(lds + X3M_CB, LDTB, vt * 16, 32, lane), qf1, ca, 0, 0, 0);
                    u32x2 o; o.x = pk2((na[0] + inter * ca[0]) * inv, (na[1] + inter * ca[1]) * inv); o.y = pk2((na[2] + inter * ca[2]) * inv, (na[3] + inter * ca[3]) * inv);
                    *(u32x2*)(Y + (size_t)row * D + 512 + h * 128 + vt * 16 + 4 * q) = o;
                }
            }
            __syncthreads();
        }
    }
}

constexpr int HC_RAWF = 0;
constexpr int HC_RAWQ = HC_RAWF + 64 * 128 * 4;
constexpr int HC_SUB = HC_RAWQ + 64 * 128 * 2;
constexpr int HL_QD = 136 * 2;
constexpr int HL_T = 24 * 2;
constexpr int HS_QI = 0, HS_KO = HS_QI + 16 * HL_QD, HS_KET = HS_KO + 16 * HL_QD, HS_ATT = HS_KET + 128 * HL_T, HS_VT = HS_ATT + 16 * HL_T, HS_DEC = HS_VT + 32 * HL_T, HS_SIZE = HS_DEC + 512;
constexpr int HC_SB = HC_SUB + 4 * HS_SIZE;
constexpr int HC_ROWS = HC_SB + 2 * 32 * HL_QD, HC_CST = HC_ROWS + 256, HC_END = HC_CST + 1024;
static_assert(HC_END <= LDS_BYTES - 16, "HGRN2 LDS map");
static_assert(HS_SIZE % 16 == 0 && HC_SB % 16 == 0, "alignment");
__device__ __forceinline__ bf16x8 ldfrag16(const LAS char* tile, int ldb, int row0, int lane) {
    bf16x8 v = *(const LAS bf16x8*)(tile + (row0 + (lane & 15)) * ldb + ((lane >> 4) & 1) * 16);
    if (lane >= 32) v = (bf16x8){0, 0, 0, 0, 0, 0, 0, 0};
    return v;
}
__device__ __forceinline__ void scan_hgrn_c(int wv, KP Pk, int layer, int unit, LAS char* lds) {
    asm volatile("" : "+s"(Pk));
    const CAS Params& P = *Pk;
    const int tid = ltid(wv), lane = tid & 63, wid = tid >> 6, q = lane >> 4, r16 = lane & 15, i_ = layer >> 1;
    const int seq = unit >> 2, quarter = unit & 3, b = seq >> 3, h = (seq >> 1) & 3, dir = seq & 1;
    const bf16_t* Pb = (const bf16_t*)(P.ws + WS_P);
    bf16_t* Y = (bf16_t*)(P.ws + (dir ? WS_YB : WS_YF));
    LAS float* cst = (LAS float*)(lds + HC_CST);
    if (tid < 128) cst[tid] = ((const float*)(P.ws + WS_LB))[layer * 512 + h * 128 + tid];
    else if (tid < 256) cst[tid] = P.hg_f_bias[(size_t)(i_ * 2 + dir) * 512 + h * 128 + tid - 128];
    for (int i = tid; i < 2 * 32 * HL_QD / 4; i += NT) ((LAS unsigned*)(lds + HC_SB))[i] = 0u;
    int tj[5], tg_[5], tcol[5]; bool tv[5];
#pragma unroll
    for (int s = 0; s < 5; ++s) {
        const int task = tid + NT * s; tv[s] = task < 64 * 36; tj[s] = task / 36; tg_[s] = task % 36;
        const int g = tg_[s];
        tcol[s] = g < 16 ? (512 + dir * 512 + h * 128 + 8 * g) : g < 32 ? (h * 128 + 8 * (g - 16)) : (1536 + h * 128 + quarter * 32 + 8 * (g - 32));
    }
    u32x4 rc[5]; int rrow = 0;
    auto load = [&](int c) {
#pragma unroll
        for (int s = 0; s < 5; ++s) {
            rc[s] = (u32x4){0u, 0u, 0u, 0u};
            if (tv[s]) { const int row = scan_row(c * 64 + tj[s], b, dir, 1); rc[s] = *(const u32x4*)(Pb + (size_t)row * LDP_ODD + tcol[s]); }
        }
        if (tid < 64) rrow = scan_row(c * 64 + tid, b, dir, 1);
    };
    auto storeA = [&]() {
#pragma unroll
        for (int s = 0; s < 5; ++s) {
            if (tv[s]) {
                float f[8]; unpack8(rc[s], f);
                const int j = tj[s], g = tg_[s];
                if (g < 16) {
                    float o[8];
#pragma unroll
                    for (int e = 0; e < 8; ++e) { const float lbv = cst[8 * g + e]; o[e] = lbv + (1.f - lbv) * sigmoidf_(f[e] + cst[128 + 8 * g + e]); }
                    LAS float* dst = (LAS float*)(lds + HC_RAWF) + j * 128 + 8 * g;
                    *(LAS f32x4*)dst = (f32x4){o[0], o[1], o[2], o[3]}; *(LAS f32x4*)(dst + 4) = (f32x4){o[4], o[5], o[6], o[7]};
                } else if (g < 32) {
                    float o[8];
#pragma unroll
                    for (int e = 0; e < 8; ++e) o[e] = siluf_(f[e]);
                    *(LAS u32x4*)(lds + HC_RAWQ + (j * 128 + 8 * (g - 16)) * 2) = pack8(o);
                } else {
                    const int v0 = 8 * (g - 32);
                    LAS char* vt = lds + HC_SUB + (j >> 4) * HS_SIZE + HS_VT;
#pragma unroll
                    for (int e = 0; e < 8; ++e) { const unsigned wv = rc[s][e >> 1]; *(LAS bf16_t*)(vt + (v0 + e) * HL_T + (j & 15) * 2) = (bf16_t)((e & 1) ? (wv >> 16) : (wv & 0xffffu)); }
                }
            }
        }
        if (tid < 64) ((LAS int*)(lds + HC_ROWS))[tid] = rrow;
    };
    auto storeB = [&]() {
        const int d = tid & 127, sb = tid >> 7;
        LAS char* st = lds + HC_SUB + sb * HS_SIZE;
        const LAS float* rf = (const LAS float*)(lds + HC_RAWF) + (sb * 16) * 128 + d;
        const LAS bf16_t* rq = (const LAS bf16_t*)(lds + HC_RAWQ) + (sb * 16) * 128 + d;
        float lam = 0.f, lams[16], kfs[16];
#pragma unroll
        for (int t = 0; t < 16; ++t) {
            const float f = rf[t * 128];
            lam += __logf(f);
            const float kf = 1.f - f;
            lams[t] = lam; kfs[t] = kf;
            *(LAS bf16_t*)(st + HS_QI + t * HL_QD + d * 2) = f2bf(bf2f(rq[t * 128]) * __expf(lam));
            *(LAS bf16_t*)(st + HS_KO + t * HL_QD + d * 2) = f2bf(kf * __expf(-lam));
        }
        float ke[16];
#pragma unroll
        for (int t = 0; t < 16; ++t) ke[t] = kfs[t] * __expf(lam - lams[t]);
        *(LAS u32x4*)(st + HS_KET + d * HL_T) = pack8(ke); *(LAS u32x4*)(st + HS_KET + d * HL_T + 16) = pack8(ke + 8);
        ((LAS float*)(st + HS_DEC))[d] = __expf(lam);
    };
    f32x4 sacc[2];
    sacc[0] = sacc[1] = (f32x4){0.f, 0.f, 0.f, 0.f};
    __syncthreads();
    load(0);
    for (int c = 0; c < NSTEPS / 64; ++c) {
        storeA();
        __syncthreads();
        storeB();
        if (c + 1 < NSTEPS / 64) load(c + 1);
        __syncthreads();
        if (wid < 4) {
            LAS char* st = lds + HC_SUB + wid * HS_SIZE;
            f32x4 acc = (f32x4){0.f, 0.f, 0.f, 0.f};
#pragma unroll
            for (int k0 = 0; k0 < 128; k0 += 32) acc = __builtin_amdgcn_mfma_f32_16x16x32_bf16(ldfrag(st + HS_KO, HL_QD, 0, k0, lane), ldfrag(st + HS_QI, HL_QD, 0, k0, lane), acc, 0, 0, 0);
#pragma unroll
            for (int j = 0; j < 4; ++j) acc[j] = (4 * q + j <= r16) ? acc[j] : 0.f;
            st4bf(st + HS_ATT + r16 * HL_T + 4 * q * 2, acc);
        }
        __syncthreads();
#pragma unroll 1
        for (int sb = 0; sb < 4; ++sb) {
            LAS char* st = lds + HC_SUB + sb * HS_SIZE;
            const LAS char* sbr = lds + HC_SB + (sb & 1) * 32 * HL_QD;
            LAS char* sbw = lds + HC_SB + ((sb + 1) & 1) * 32 * HL_QD;
            if (wid < 2) {
                f32x4 ya = __builtin_amdgcn_mfma_f32_16x16x32_bf16(ldfrag16(st + HS_VT, HL_T, wid * 16, lane), ldfrag16(st + HS_ATT, HL_T, 0, lane), (f32x4){0.f, 0.f, 0.f, 0.f}, 0, 0, 0);
#pragma unroll
                for (int k0 = 0; k0 < 128; k0 += 32) ya = __builtin_amdgcn_mfma_f32_16x16x32_bf16(ldfrag(sbr, HL_QD, wid * 16, k0, lane), ldfrag(st + HS_QI, HL_QD, 0, k0, lane), ya, 0, 0, 0);
                const int row = ((const LAS int*)(lds + HC_ROWS))[sb * 16 + r16];
                u32x2 o; o.x = pk2(ya[0], ya[1]); o.y = pk2(ya[2], ya[3]);
                *(u32x2*)(Y + (size_t)row * D + h * 128 + quarter * 32 + wid * 16 + 4 * q) = o;
            }
            {
                const int vt = wid >> 2;
                const bf16x8 vf = ldfrag16(st + HS_VT, HL_T, vt * 16, lane);
#pragma unroll
                for (int u = 0; u < 2; ++u) {
                    const int dt = (wid & 3) * 2 + u;
                    const f32x4 a = __builtin_amdgcn_mfma_f32_16x16x32_bf16(ldfrag16(st + HS_KET, HL_T, dt * 16, lane), vf, (f32x4){0.f, 0.f, 0.f, 0.f}, 0, 0, 0);
                    const f32x4 dc = *(const LAS f32x4*)((const LAS float*)(st + HS_DEC) + dt * 16 + 4 * q);
#pragma unroll
                    for (int j = 0; j < 4; ++j) sacc[u][j] = sacc[u][j] * dc[j] + a[j];
                    st4bf(sbw + (vt * 16 + r16) * HL_QD + (dt * 16 + 4 * q) * 2, sacc[u]);
                }
            }
            __syncthreads();
        }
    }
}

constexpr int RC_RAWW = 0;
constexpr int RC_RAWA = RC_RAWW + 64 * 64 * 4;
constexpr int RC_RAWB = RC_RAWA + 64 * 64 * 2, RC_RAWK = RC_RAWB + 64 * 64 * 2, RC_RAWR = RC_RAWK + 64 * 64 * 2;
constexpr int RC_SUB = RC_RAWR + 64 * 64 * 2;
constexpr int RL_C = 72 * 2, RL_32 = 40 * 2, RL_16 = 24 * 2;
constexpr int RS_AT = 0, RS_RT = RS_AT + 16 * RL_C, RS_KT = RS_RT + 16 * RL_C, RS_BT = RS_KT + 16 * RL_C, RS_KBH = RS_BT + 16 * RL_C, RS_AAK = RS_KBH + 64 * RL_32,
              RS_ARKB = RS_AAK + 16 * RL_16, RS_T = RS_ARKB + 16 * RL_32, RS_AABF = RS_T + 16 * RL_16, RS_GL = RS_AABF + 16 * 16 * 4, RS_VU = RS_GL + 256, RS_SIZE = RS_VU + 32 * RL_32;
constexpr int RC_SB = RC_SUB + 4 * RS_SIZE;
constexpr int RC_RHT = RC_SB + 32 * RL_C;
constexpr int RC_ROWS = RC_RHT + 32 * RL_16, RC_END = RC_ROWS + 256;
static_assert(RC_END <= LDS_BYTES - 16, "RWKV LDS map");
static_assert(RS_SIZE % 16 == 0 && RC_SB % 16 == 0 && RC_RHT % 16 == 0, "alignment");

__device__ __forceinline__ float allreduce8(float v) {
    v += dppmov<0xB1>(v); v += dppmov<0x4E>(v); v += dppmov<0x141>(v);
    return v;
}

__device__ __forceinline__ void phase_prep1(int wv, KP Pk, int layer) {
    asm volatile("" : "+s"(Pk));
    const CAS Params& P = *Pk;
    const int tid = ltid(wv), lane = tid & 63, wid = tid >> 6, i_ = layer >> 1;
    const bf16_t* Pb = (const bf16_t*)(P.ws + WS_P);
    bf16_t* R = (bf16_t*)(P.ws + WS_RWR); bf16_t* K = (bf16_t*)(P.ws + WS_RWK); bf16_t* V = (bf16_t*)(P.ws + WS_RWV); bf16_t* KK = (bf16_t*)(P.ws + WS_RWKK);
    bf16_t* LA = (bf16_t*)(P.ws + WS_LA);
    const float* mu = P.rw_mu + (size_t)i_ * 1856;
    float mur[8], muv[8], muk[8], mul_[8], kkw[8];
#pragma unroll
    for (int e = 0; e < 8; ++e) { mur[e] = mu[8 * lane + e]; muv[e] = mu[1024 + 8 * lane + e]; muk[e] = mu[512 + 8 * lane + e]; mul_[e] = lane < 40 ? mu[1536 + 8 * lane + e] : 0.f; kkw[e] = P.rw_k_k[i_ * 512 + 8 * lane + e]; }
    for (int r = blockIdx.x * 8 + wid; r < NROWS; r += gridDim.x * 8) {
        int rprev = -1, rnext = -1;
        if (r < NCTX) { const int t = r & 255; if (t > 0) rprev = r - 1; if (t < CTXL - 1) rnext = r + 1; }
        else {
            const int bs = (r - NCTX) >> 13, s = (r - NCTX) & 8191, sg = ((s & 63) << 7) + (s >> 6);
            if (sg > 0) { const int g2 = sg - 1; rprev = NCTX + bs * SEQ + ((g2 & 127) << 6) + (g2 >> 7); }
            if (sg < SEQ - 1) { const int g2 = sg + 1; rnext = NCTX + bs * SEQ + ((g2 & 127) << 6) + (g2 >> 7); }
        }
        const bf16_t* pc = Pb + (size_t)r * LDP_ODD + 2560;
        const bf16_t* pp = Pb + (size_t)(rprev < 0 ? r : rprev) * LDP_ODD + 2560;
        const bf16_t* pn = Pb + (size_t)(rnext < 0 ? r : rnext) * LDP_ODD + 2560;
        const float mp = rprev < 0 ? 0.f : 0.5f, mn = rnext < 0 ? 0.f : 0.5f;
        auto mix8 = [&](int col, const float* muc, float* o) {
            float fc[8], fp[8], fn[8];
            unpack8(*(const u32x4*)(pc + col), fc); unpack8(*(const u32x4*)(pp + col), fp); unpack8(*(const u32x4*)(pn + col), fn);
#pragma unroll
            for (int e = 0; e < 8; ++e) o[e] = fc[e] + muc[e] * (mp * fp[e] + mn * fn[e] - fc[e]);
        };
        float o[8];
        mix8(8 * lane, mur, o); *(u32x4*)(R + (size_t)r * 512 + 8 * lane) = pack8(o);
        mix8(1024 + 8 * lane, muv, o); *(u32x4*)(V + (size_t)r * 512 + 8 * lane) = pack8(o);
        mix8(512 + 8 * lane, muk, o); *(u32x4*)(K + (size_t)r * 512 + 8 * lane) = pack8(o);
        {
            float kk[8], ss = 0.f;
#pragma unroll
            for (int e = 0; e < 8; ++e) { kk[e] = o[e] * kkw[e]; ss += kk[e] * kk[e]; }
            ss = group_sum<8>(ss);
            const float rn = rsqrtf(fmaxf(ss, 1e-12f));
#pragma unroll
            for (int e = 0; e < 8; ++e) kk[e] *= rn;
            *(u32x4*)(KK + (size_t)r * 512 + 8 * lane) = pack8(kk);
        }
        if (lane < 40) {
            mix8(1536 + 8 * lane, mul_, o);
            if (lane < 16) {
#pragma unroll
                for (int e = 0; e < 8; ++e) o[e] = tanh_fast(o[e]);
            } else if (lane >= 24) {
#pragma unroll
                for (int e = 0; e < 8; ++e) o[e] = sigmoidf_(o[e]);
            }
            *(u32x4*)(LA + (size_t)r * 320 + 8 * lane) = pack8(o);
        }
    }
}

__device__ __forceinline__ void phase_out_even(int wv, KP Pk, int layer) {
    asm volatile("" : "+s"(Pk));
    const CAS Params& P = *Pk;
    const int tid = ltid(wv), lane = tid & 63, wid = tid >> 6, i_ = layer >> 1;
    const bf16_t* Pb = (const bf16_t*)(P.ws + WS_P);
    const bf16_t* Yf = (const bf16_t*)(P.ws + WS_YF); const bf16_t* Yb = (const bf16_t*)(P.ws + WS_YB);
    bf16_t* feat = (bf16_t*)(P.ws + WS_FEAT);
    const int r0 = (layer == DEPTH - 1) ? NCTX : 0;
    const bf16_t* XBC = (const bf16_t*)(P.ws + WS_EXBC);
    float nwa[8], nwb[8];
#pragma unroll
    for (int e = 0; e < 8; ++e) { nwa[e] = P.ssd_norm_w[i_ * 512 + 8 * lane + e]; nwb[e] = P.ml_norm_w[i_ * 512 + 8 * lane + e]; }
    const float dsk = P.ssd_d[i_ * 8 + (lane >> 3)];
    for (int r = r0 + blockIdx.x * 8 + wid; r < NROWS; r += gridDim.x * 8) {
        const bf16_t* pr = Pb + (size_t)r * LDP_EVEN;
        float y[8];
        {
            float a[8], bb[8], xsv[8], z[8];
            unpack8(*(const u32x4*)(Yf + (size_t)r * D + 8 * lane), a); unpack8(*(const u32x4*)(Yb + (size_t)r * D + 8 * lane), bb);
            unpack8(*(const u32x4*)(XBC + (size_t)r * 768 + 8 * lane), xsv); unpack8(*(const u32x4*)(pr + 8 * lane), z);
            float ss = 0.f;
#pragma unroll
            for (int e = 0; e < 8; ++e) {
                y[e] = (a[e] + bb[e] + dsk * xsv[e]) * siluf_(z[e]); ss += y[e] * y[e];
            }
            ss = wave_sum(ss);
            const float rn = rsqrtf(ss * (1.f / 512.f) + 1e-6f);
#pragma unroll
            for (int e = 0; e < 8; ++e) y[e] = y[e] * rn * nwa[e];
            *(u32x4*)(feat + (size_t)r * D + 8 * lane) = pack8(y);
        }
        {
            float a[8], bb[8], o[8];
            unpack8(*(const u32x4*)(Yf + (size_t)r * D + 512 + 8 * lane), a); unpack8(*(const u32x4*)(Yb + (size_t)r * D + 512 + 8 * lane), bb);
            unpack8(*(const u32x4*)(pr + 2320 + 8 * lane), o);
            float s = 0.f;
#pragma unroll
            for (int e = 0; e < 8; ++e) { y[e] = a[e] + bb[e]; s += y[e]; }
            const float mean = group_sum<16>(s) * (1.f / 128.f);
            float ss = 0.f;
#pragma unroll
            for (int e = 0; e < 8; ++e) { y[e] -= mean; ss += y[e] * y[e]; }
            const float rn = rsqrtf(group_sum<16>(ss) * (1.f / 128.f) + 1e-6f);
#pragma unroll
            for (int e = 0; e < 8; ++e) y[e] = sigmoidf_(o[e]) * (y[e] * rn) * nwb[e];
            *(u32x4*)(feat + (size_t)r * D + 512 + 8 * lane) = pack8(y);
        }
    }
}
__device__ __forceinline__ void phase_out_odd(int wv, KP Pk, int layer) {
    asm volatile("" : "+s"(Pk));
    const CAS Params& P = *Pk;
    const int tid = ltid(wv), lane = tid & 63, wid = tid >> 6, i_ = layer >> 1;
    const bf16_t* Pb = (const bf16_t*)(P.ws + WS_P);
    const bf16_t* Yf = (const bf16_t*)(P.ws + WS_YF); const bf16_t* Yb = (const bf16_t*)(P.ws + WS_YB);
    const bf16_t* R = (const bf16_t*)(P.ws + WS_RWR); const bf16_t* K = (const bf16_t*)(P.ws + WS_RWK); const bf16_t* V = (const bf16_t*)(P.ws + WS_RWV); const bf16_t* G = (const bf16_t*)(P.ws + WS_RWG);
    bf16_t* feat = (bf16_t*)(P.ws + WS_FEAT);
    const int r0 = (layer == DEPTH - 1) ? NCTX : 0;
    float nwc[8], rk[8], lw[8], lbv[8];
#pragma unroll
    for (int e = 0; e < 8; ++e) {
        nwc[e] = P.hg_norm_w[i_ * 512 + 8 * lane + e]; rk[e] = P.rw_r_k[i_ * 512 + 8 * lane + e];
        lw[e] = P.rw_ln_w[i_ * 512 + 8 * lane + e]; lbv[e] = P.rw_ln_b[i_ * 512 + 8 * lane + e];
    }
    for (int r = r0 + blockIdx.x * 8 + wid; r < NROWS; r += gridDim.x * 8) {
        float y[8];
        {
            float a[8], bb[8], g[8];
            unpack8(*(const u32x4*)(Yf + (size_t)r * D + 8 * lane), a); unpack8(*(const u32x4*)(Yb + (size_t)r * D + 8 * lane), bb);
            unpack8(*(const u32x4*)(Pb + (size_t)r * LDP_ODD + 2048 + 8 * lane), g);
            float ss = 0.f;
#pragma unroll
            for (int e = 0; e < 8; ++e) { y[e] = a[e] + bb[e]; ss += y[e] * y[e]; }
            const float rn = rsqrtf(group_sum<16>(ss) * (1.f / 128.f) + 1e-6f);
#pragma unroll
            for (int e = 0; e < 8; ++e) y[e] = y[e] * rn * nwc[e] * siluf_(g[e]);
            *(u32x4*)(feat + (size_t)r * D + 8 * lane) = pack8(y);
        }
        {
            float a[8], bb[8], rr[8], kk[8], vv[8], g[8];
            unpack8(*(const u32x4*)(Yf + (size_t)r * D + 512 + 8 * lane), a); unpack8(*(const u32x4*)(Yb + (size_t)r * D + 512 + 8 * lane), bb);
            unpack8(*(const u32x4*)(R + (size_t)r * 512 + 8 * lane), rr); unpack8(*(const u32x4*)(K + (size_t)r * 512 + 8 * lane), kk);
            unpack8(*(const u32x4*)(V + (size_t)r * 512 + 8 * lane), vv); unpack8(*(const u32x4*)(G + (size_t)r * 512 + 8 * lane), g);
            float s = 0.f, bs = 0.f;
#pragma unroll
            for (int e = 0; e < 8; ++e) { y[e] = a[e] + bb[e]; s += y[e]; bs += rr[e] * kk[e] * rk[e]; }
            const float mean = group_sum<8>(s) * (1.f / 64.f); bs = group_sum<8>(bs);
            float ss = 0.f;
#pragma unroll
            for (int e = 0; e < 8; ++e) { y[e] -= mean; ss += y[e] * y[e]; }
            const float rn = rsqrtf(group_sum<8>(ss) * (1.f / 64.f) + 64e-5f);
#pragma unroll
            for (int e = 0; e < 8; ++e) y[e] = (y[e] * rn * lw[e] + lbv[e] + bs * vv[e]) * g[e];
            *(u32x4*)(feat + (size_t)r * D + 512 + 8 * lane) = pack8(y);
        }
    }
}

#ifndef MK_DOUBLE
#define MK_DOUBLE 0
#endif
#define REP(bit, body) do { body; if (MK_DOUBLE & (bit)) { body; } } while (0)
__device__ __forceinline__ void phase_expconv(int wv, KP Pk, int layer, LAS char* lds) {
    asm volatile("" : "+s"(Pk));
    const CAS Params& P = *Pk;
    const int tid = ltid(wv), lane = tid & 63, wid = tid >> 6;
    {
        LAS float* scr = (LAS float*)(lds + wid * 8448);
        const int gw = blockIdx.x * 8 + wid, NGW = gridDim.x * 8;
        bf16_t* gu = (bf16_t*)(P.ws + WS_EXPGU); bf16_t* dw = (bf16_t*)(P.ws + WS_EXPD);
        constexpr int IG = 16 * 16, IDN = 8 * 32;
        for (int it = gw; it < NEXP * (2 * IG + IDN); it += NGW) {
            const int e = it / (2 * IG + IDN); int r = it % (2 * IG + IDN);
            const size_t eo = (size_t)(layer * NEXP + e);
            if (r < IG) { transpose_item(P.exp_w_gate + eo * D * DEXP, D, DEXP, gu + (size_t)e * 1024 * 1024, 1, scr, r, lane); continue; } r -= IG;
            if (r < IG) { transpose_item(P.exp_w_up + eo * D * DEXP, D, DEXP, gu + (size_t)e * 1024 * 1024, 2, scr, r, lane); continue; } r -= IG;
            transpose_item(P.exp_w_down + eo * DEXP * D, DEXP, D, dw + (size_t)e * 1024 * 512, 0, scr, r, lane);
        }
    }
}
__device__ __forceinline__ void phase_ln1(int wv, KP Pk, int layer, LAS char* lds, bool dry = false) {
    asm volatile("" : "+s"(Pk));
    const CAS Params& P = *Pk;
    const int tid = ltid(wv), lane = tid & 63, wid = tid >> 6;
    if (!dry) REP(8, phase_expconv(wv, Pk, layer, lds));
    __syncthreads();
    LAS float* rwT = (LAS float*)lds;
    LAS float* scs = (LAS float*)(lds + 32 * 1024 * 4) + wid * 32;
    LAS int* lcnt = (LAS int*)(lds + 32 * 1024 * 4 + 1024);
    LAS int* lbase = lcnt + 32;
    LAS int* asg = lcnt + 64;
    if (tid < 32) lcnt[tid] = 0;
    for (int i = tid; i < D * NEXP; i += NT) { const int col = i >> 5, e = i & 31; rwT[e * 1024 + col] = P.router_w[i]; }
    __syncthreads();
    const bf16_t* yo = (const bf16_t*)(P.ws + WS_YO);
    bf16_t* act = (bf16_t*)(P.ws + (dry ? WS_FEAT : WS_ACT));
    float* xc = (float*)(P.ws + WS_XC);
    int* cnt = (int*)(P.ws + WS_CNT) + layer * 32 * CNT_STRIDE;
    int* list = (int*)(P.ws + WS_LIST);
    float* wts = (float*)(P.ws + WS_WTS);
    const float* lg = P.ln_g + (size_t)(layer * 2 + 0) * D; const float* lb = P.ln_b + (size_t)(layer * 2 + 0) * D;
    const int r0 = (layer == DEPTH - 1) ? NCTX : 0, stride = gridDim.x * 8;
    f32x4 g1v[4], s2c[4], h2c[4];
#pragma unroll
    for (int i = 0; i < 4; ++i) g1v[i] = s2c[i] = h2c[i] = (f32x4){0.f, 0.f, 0.f, 0.f};
    LAS float* rbias = (LAS float*)(asg + 2 * 136);
    if (tid < 32) rbias[tid] = P.router_bias[tid];
    __syncthreads();
    int mcur = -1;
    f32x4 nx[4]; u32x2 nyo[4];
    auto fetch = [&](int rr) {
        const float* xq = layer == 0 ? (rr < NCTX ? P.ctx + (size_t)rr * D : P.x + (size_t)(rr - NCTX) * D)
                                     : (rr < NCTX ? xc + (size_t)rr * D : P.out + (size_t)(rr - NCTX) * D);
#pragma unroll
        for (int i = 0; i < 4; ++i) { const int c = 4 * lane + 256 * i; nx[i] = *(const f32x4*)(xq + c); nyo[i] = *(const u32x2*)(yo + (size_t)rr * D + c); }
    };
    for (int r = r0 + blockIdx.x * 8 + wid; r < NROWS; r += stride) {
        fetch(r);
        const int m = row_mod(r);
        float* xr = r < NCTX ? xc + (size_t)r * D : P.out + (size_t)(r - NCTX) * D;
        if (m != mcur) {
            mcur = m;
            const float* g1 = modvec(P.ws, layer, m, 2); const float* sh2 = modvec(P.ws, layer, m, 3); const float* sc2 = modvec(P.ws, layer, m, 4);
#pragma unroll
            for (int i = 0; i < 4; ++i) { const int c = 4 * lane + 256 * i; g1v[i] = *(const f32x4*)(g1 + c); s2c[i] = *(const f32x4*)(sc2 + c); h2c[i] = *(const f32x4*)(sh2 + c); }
        }
        f32x4 v[4]; float s = 0.f;
#pragma unroll
        for (int i = 0; i < 4; ++i) {
            const f32x4 xv = nx[i], gv = g1v[i]; const u32x2 yv = nyo[i];
            v[i][0] = ALPHA * xv[0] + gv[0] * bflo(yv.x); v[i][1] = ALPHA * xv[1] + gv[1] * bfhi(yv.x);
            v[i][2] = ALPHA * xv[2] + gv[2] * bflo(yv.y); v[i][3] = ALPHA * xv[3] + gv[3] * bfhi(yv.y);
            s += (v[i][0] + v[i][1]) + (v[i][2] + v[i][3]);
        }
        const float mean = wave_sum(s) * (1.f / D);
        float s2 = 0.f;
#pragma unroll
        for (int i = 0; i < 4; ++i) { v[i] = v[i] - mean; s2 += (v[i][0] * v[i][0] + v[i][1] * v[i][1]) + (v[i][2] * v[i][2] + v[i][3] * v[i][3]); }
        const float rstd = rsqrtf(wave_sum(s2) * (1.f / D) + 1e-5f);
        float acc[32];
#pragma unroll
        for (int e = 0; e < 32; ++e) acc[e] = 0.f;
#pragma unroll
        for (int i = 0; i < 4; ++i) {
            const int c = 4 * lane + 256 * i;
            const f32x4 gg = *(const f32x4*)(lg + c), bb = *(const f32x4*)(lb + c), s2v = s2c[i], h2v = h2c[i];
            f32x4 xn, hv;
#pragma unroll
            for (int j = 0; j < 4; ++j) { xn[j] = v[i][j] * rstd * gg[j] + bb[j]; hv[j] = xn[j] * (1.f + s2v[j]) + h2v[j]; }
            *(f32x4*)((dry ? (float*)(P.ws + WS_YF) + (size_t)r * D : xr) + c) = xn;
            u32x2 o; o.x = pk2(hv[0], hv[1]); o.y = pk2(hv[2], hv[3]); *(u32x2*)(act + (size_t)r * D + c) = o;
#pragma unroll
            for (int e = 0; e < 32; ++e) { const f32x4 w = *(const LAS f32x4*)(rwT + e * 1024 + c); acc[e] += (hv[0] * w[0] + hv[1] * w[1]) + (hv[2] * w[2] + hv[3] * w[3]); }
        }
#pragma unroll
        for (int st = 0; st < 5; ++st) {
            const int half = 16 >> st, msk = 32 >> st;
            const bool up = (lane & msk) != 0;
#pragma unroll
            for (int j = 0; j < 16; ++j) {
                if (j < half) {
                    const float keep = up ? acc[j + half] : acc[j], send = up ? acc[j] : acc[j + half];
                    acc[j] = keep + __shfl_xor(send, msk);
                }
            }
        }
        acc[0] += __shfl_xor(acc[0], 1);
        {
            const int e = (lane >> 1) & 31;
            const int eidx = ((e >> 4) & 1) * 16 + ((e >> 3) & 1) * 8 + ((e >> 2) & 1) * 4 + ((e >> 1) & 1) * 2 + (e & 1);
            if ((lane & 1) == 0) scs[eidx] = acc[0];
        }
        asm volatile("s_waitcnt lgkmcnt(0)" ::: "memory");
        float best = -1e30f; int bg = 0;
#pragma unroll
        for (int g = 0; g < 8; ++g) {
            float m1 = -1e30f, m2 = -1e30f;
#pragma unroll
            for (int k = 0; k < 4; ++k) { const float vsc = sigmoidf_(scs[g * 4 + k]) + rbias[g * 4 + k]; if (vsc > m1) { m2 = m1; m1 = vsc; } else if (vsc > m2) m2 = vsc; }
            const float gs = m1 + m2;
            if (gs > best) { best = gs; bg = g; }
        }
        float sv[4], bv[4];
#pragma unroll
        for (int k = 0; k < 4; ++k) { sv[k] = sigmoidf_(scs[bg * 4 + k]); bv[k] = sv[k] + rbias[bg * 4 + k]; }
        int i1 = 0; float b1 = bv[0];
#pragma unroll
        for (int k = 1; k < 4; ++k) if (bv[k] > b1) { b1 = bv[k]; i1 = k; }
        int i2 = -1; float b2 = -1e30f;
#pragma unroll
        for (int k = 0; k < 4; ++k) if (k != i1 && bv[k] > b2) { b2 = bv[k]; i2 = k; }
        float s1 = sv[0], s2s = sv[0];
#pragma unroll
        for (int k = 1; k < 4; ++k) { if (i1 == k) s1 = sv[k]; if (i2 == k) s2s = sv[k]; }
        if (lane == 0 && !dry) {
            const int e0 = bg * 4 + i1, e1 = bg * 4 + i2;
            const float inv = 1.f / (s1 + s2s);
            const int li = ((r - r0 - blockIdx.x * 8 - wid) / (int)(gridDim.x * 8)) * 8 + wid;
            const int p0 = __hip_atomic_fetch_add(&lcnt[e0], 1, __ATOMIC_RELAXED, __HIP_MEMORY_SCOPE_WORKGROUP);
            const int p1 = __hip_atomic_fetch_add(&lcnt[e1], 1, __ATOMIC_RELAXED, __HIP_MEMORY_SCOPE_WORKGROUP);
            asg[2 * li] = (e0 << 16) | p0; asg[2 * li + 1] = (e1 << 16) | p1;
            wts[2 * r] = s1 * inv; wts[2 * r + 1] = s2s * inv;
        }
    }
    __syncthreads();
    if (dry) return;
    if (tid < 32) lbase[tid] = atomicAdd(&cnt[tid * CNT_STRIDE], lcnt[tid]);
    __syncthreads();
    for (int idx = tid; idx < 2 * 136; idx += NT) {
        const int li = idx >> 1, k = idx & 1, it = li >> 3, w = li & 7;
        const int r = r0 + blockIdx.x * 8 + w + it * (int)(gridDim.x * 8);
        if (r < NROWS) { const int v = asg[idx], e = v >> 16, lp = v & 0xffff; list[(size_t)e * LISTCAP + lbase[e] + lp] = 2 * r + k; }
    }
}

__device__ __forceinline__ void phase_ln2(int wv, KP Pk, int layer, bool dry = false) {
    asm volatile("" : "+s"(Pk));
    const CAS Params& P = *Pk;
    const int tid = ltid(wv), lane = tid & 63, wid = tid >> 6;
    const bf16_t* yp = (const bf16_t*)(P.ws + WS_YP);
    const float* wts = (const float*)(P.ws + WS_WTS);
    bf16_t* act = (bf16_t*)(P.ws + (dry ? WS_FEAT : WS_ACT));
    float* xc = (float*)(P.ws + WS_XC);
    const float* lg = P.ln_g + (size_t)(layer * 2 + 1) * D; const float* lb = P.ln_b + (size_t)(layer * 2 + 1) * D;
    const bool last = (layer == DEPTH - 1);
    const int r0 = last ? NCTX : 0, stride = gridDim.x * 8;
    f32x4 cg[4], cb[4], g2v[4], s1v[4], h1v[4];
#pragma unroll
    for (int i = 0; i < 4; ++i) { cg[i] = *(const f32x4*)(lg + 4 * lane + 256 * i); cb[i] = *(const f32x4*)(lb + 4 * lane + 256 * i); g2v[i] = s1v[i] = h1v[i] = (f32x4){0.f, 0.f, 0.f, 0.f}; }
    int mcur = -1;
    f32x4 nx[4]; u32x2 ny0[4], ny1[4]; float nw0 = 0.f, nw1 = 0.f;
    auto fetch = [&](int r) {
        const float* xr = r < NCTX ? xc + (size_t)r * D : P.out + (size_t)(r - NCTX) * D;
#pragma unroll
        for (int i = 0; i < 4; ++i) {
            const int c = 4 * lane + 256 * i;
            nx[i] = *(const f32x4*)(xr + c); ny0[i] = *(const u32x2*)(yp + (size_t)(2 * r) * D + c); ny1[i] = *(const u32x2*)(yp + (size_t)(2 * r + 1) * D + c);
        }
        nw0 = wts[2 * r]; nw1 = wts[2 * r + 1];
    };
    int r = r0 + blockIdx.x * 8 + wid;
    if (r < NROWS) fetch(r);
    for (; r < NROWS; r += stride) {
        const int m = row_mod(r);
        float* xr = r < NCTX ? xc + (size_t)r * D : P.out + (size_t)(r - NCTX) * D;
        if (m != mcur) {
            mcur = m;
            const float* g2 = modvec(P.ws, layer, m, 5); const float* sh1 = last ? lg : modvec(P.ws, layer + 1, m, 0); const float* sc1 = last ? lg : modvec(P.ws, layer + 1, m, 1);
#pragma unroll
            for (int i = 0; i < 4; ++i) { const int c = 4 * lane + 256 * i; g2v[i] = *(const f32x4*)(g2 + c); s1v[i] = *(const f32x4*)(sc1 + c); h1v[i] = *(const f32x4*)(sh1 + c); }
        }
        f32x4 v[4]; float s = 0.f;
        const float w0 = nw0, w1 = nw1;
#pragma unroll
        for (int i = 0; i < 4; ++i) {
            const f32x4 xv = nx[i], gv = g2v[i]; const u32x2 y0 = ny0[i], y1 = ny1[i];
            v[i][0] = ALPHA * xv[0] + gv[0] * (w0 * bflo(y0.x) + w1 * bflo(y1.x)); v[i][1] = ALPHA * xv[1] + gv[1] * (w0 * bfhi(y0.x) + w1 * bfhi(y1.x));
            v[i][2] = ALPHA * xv[2] + gv[2] * (w0 * bflo(y0.y) + w1 * bflo(y1.y)); v[i][3] = ALPHA * xv[3] + gv[3] * (w0 * bfhi(y0.y) + w1 * bfhi(y1.y));
            s += (v[i][0] + v[i][1]) + (v[i][2] + v[i][3]);
        }
        if (r + stride < NROWS) fetch(r + stride);
        const float mean = wave_sum(s) * (1.f / D);
        float s2 = 0.f;
#pragma unroll
        for (int i = 0; i < 4; ++i) { v[i] = v[i] - mean; s2 += (v[i][0] * v[i][0] + v[i][1] * v[i][1]) + (v[i][2] * v[i][2] + v[i][3] * v[i][3]); }
        const float rstd = rsqrtf(wave_sum(s2) * (1.f / D) + 1e-5f);
#pragma unroll
        for (int i = 0; i < 4; ++i) {
            const int c = 4 * lane + 256 * i;
            f32x4 xn;
#pragma unroll
            for (int j = 0; j < 4; ++j) xn[j] = v[i][j] * rstd * cg[i][j] + cb[i][j];
            *(f32x4*)((dry ? (float*)(P.ws + WS_YF) + (size_t)r * D : xr) + c) = xn;
            if (!last) {
                u32x2 o; o.x = pk2(xn[0] * (1.f + s1v[i][0]) + h1v[i][0], xn[1] * (1.f + s1v[i][1]) + h1v[i][1]); o.y = pk2(xn[2] * (1.f + s1v[i][2]) + h1v[i][2], xn[3] * (1.f + s1v[i][3]) + h1v[i][3]);
                *(u32x2*)(act + (size_t)r * D + c) = o;
            }
        }
    }
}

constexpr int NPHASE = 2 + 11 * DEPTH;
__global__ void __launch_bounds__(NT, 2) fwd_kernel(Params P) {
    extern __shared__ __attribute__((aligned(16))) char lds_raw[];
    LAS char* lds = (LAS char*)lds_raw;
    volatile LAS unsigned* xbw = (volatile LAS unsigned*)(lds + LDS_BYTES - 16);
    KP Pk = (KP)__builtin_amdgcn_kernarg_segment_ptr();
    const int wv = __builtin_amdgcn_readfirstlane((int)(threadIdx.x >> 6));
    const bool multi = (P.ph_hi - P.ph_lo) > 1;
    XcdBarrier bar; bar.bar = (unsigned*)(P.ws + WS_BAR); bar.x = 0; bar.st = xbw;
    if (multi) {
        if (ltid(wv) == 0) { xbw[0] = 0u; xbw[1] = 0u; xbw[2] = 0u; xbw[3] = 0u; }
        __syncthreads();
        bar = xcd_barrier_post(wv, (unsigned*)(P.ws + WS_BAR), xbw);
    }
#define PHASE(id, body) do { if (P.ph_lo <= (id) && (id) < P.ph_hi) { body; if ((id) + 1 < P.ph_hi) xcd_barrier(wv, bar); if (MK_DOUBLE & 2048) xcd_barrier(wv, bar); } } while (0)
    PHASE(0, REP(16, phase_prologue0(wv, Pk, lds)));
    PHASE(1, REP(16, phase_prologue1(wv, Pk)));
    for (int l = 0; l < DEPTH; ++l) {
        const int pb = 2 + 11 * l, odd = l & 1;
        PHASE(pb + 0, REP(1, phase_inproj(wv, Pk, l, lds)));
        if (odd) {
            PHASE(pb + 1, REP(4, phase_prep1(wv, Pk, l)));
            PHASE(pb + 2, phase_prep2(wv, Pk, l, lds));
            PHASE(pb + 3, REP(32, { if (blockIdx.x < 128) REP(64, scan_hgrn_c(wv, Pk, l, blockIdx.x, lds)); else if (blockIdx.x < 256) REP(128, scan_rwkv(wv, Pk, l, blockIdx.x - 128, lds)); }));
            PHASE(pb + 5, REP(4, phase_out_odd(wv, Pk, l)));
        } else {
            PHASE(pb + 1, REP(4, phase_prep_even(wv, Pk, l)));
            PHASE(pb + 2, REP(2, phase_ex1(wv, Pk, l, lds)));
            PHASE(pb + 3, phase_ex2(wv, Pk, l));
            PHASE(pb + 4, REP(2, phase_ex3(wv, Pk, l, lds)));
            PHASE(pb + 5, REP(4, phase_out_even(wv, Pk, l)));
        }
        PHASE(pb + 6, REP(256, phase_outproj(wv, Pk, l, lds)));
        PHASE(pb + 7, { if (MK_DOUBLE & 4096) phase_ln1(wv, Pk, l, lds, true); phase_ln1(wv, Pk, l, lds); });
        PHASE(pb + 8, REP(512, phase_moe1(wv, Pk, l, lds)));
        PHASE(pb + 9, REP(1024, phase_moe2(wv, Pk, l, lds)));
        PHASE(pb + 10, { if (MK_DOUBLE & 8192) phase_ln2(wv, Pk, l, true); phase_ln2(wv, Pk, l); });
    }
#undef PHASE
}


#ifndef MK_STOP
#define MK_STOP NPHASE
#endif
#ifndef MK_DUMP
#define MK_DUMP 0
#endif
#ifndef MK_DUMP_N
#define MK_DUMP_N (1u << 30)
#endif
#ifndef MK_DUMP_LD
#define MK_DUMP_LD 1024
#endif
#ifndef MK_DUMP_C0
#define MK_DUMP_C0 0
#endif
__global__ void diff_kernel(const bf16_t* a, const bf16_t* b, float* out, size_t n) {
    for (size_t i = (size_t)blockIdx.x * blockDim.x + threadIdx.x; i < n; i += (size_t)gridDim.x * blockDim.x) out[i] = 1e6f * (bf2f(a[i]) - bf2f(b[i]));
}
__global__ void dump_kernel(const bf16_t* src, float* out, size_t n) {
    for (size_t i = (size_t)blockIdx.x * blockDim.x + threadIdx.x; i < n; i += (size_t)gridDim.x * blockDim.x) out[i] = i < (size_t)MK_DUMP_N ? bf2f(src[(i >> 10) * MK_DUMP_LD + MK_DUMP_C0 + (i & 1023)]) : 0.f;
}
extern "C" void kernel_launch(void* const* d_in, const int* in_sizes, int n_in, void* d_out, int out_size, void* d_ws, size_t ws_size, hipStream_t stream) {
    static int ready = 0;
    if (ready == 0) {
        ready = 1;
        if (n_in != 42 || out_size != NB * SEQ * D || ws_size < WS_END) { fprintf(stderr, "kernel_launch: unexpected shapes (n_in %d out %d ws %zu need %zu)\n", n_in, out_size, ws_size, (size_t)WS_END); ready = -1; }
        if (hipFuncSetAttribute((const void*)fwd_kernel, hipFuncAttributeMaxDynamicSharedMemorySize, LDS_BYTES) != hipSuccess) { fprintf(stderr, "kernel_launch: hipFuncSetAttribute failed\n"); ready = -1; }
    }
    if (ready < 0) return;
    (void)in_sizes;
    hipMemsetAsync((char*)d_ws + WS_BAR, 0, WS_ZERO_BYTES, stream);
    Params p;
    memset(&p, 0, sizeof(p));
    const float** fp = (const float**)&p;
    for (int i = 0; i < 42; ++i) fp[i] = (const float*)d_in[i];
    p.out = (float*)d_out; p.ws = (unsigned char*)d_ws;
#if MK_PER_PHASE
    for (int ph = 0; ph < MK_STOP; ++ph) {
        const int local = ph < 2 ? -1 : (ph - 2) % 11, layer = ph < 2 ? 0 : (ph - 2) / 11;
        if (local == 4 && (layer & 1)) continue;
        p.ph_lo = ph; p.ph_hi = ph + 1;
        hipLaunchKernelGGL(fwd_kernel, dim3(256), dim3(NT), LDS_BYTES, stream, p);
    }
#ifdef MK_DIFF
    p.ph_lo = 7; p.ph_hi = 8; p.dbg = 1;
    hipLaunchKernelGGL(fwd_kernel, dim3(256), dim3(NT), LDS_BYTES, stream, p);
    hipLaunchKernelGGL(diff_kernel, dim3(1024), dim3(256), 0, stream, (const bf16_t*)((unsigned char*)d_ws + WS_YO), (const bf16_t*)((unsigned char*)d_ws + WS_HID), (float*)d_out, (size_t)NB * SEQ * D);
#else
    if (MK_DUMP) hipLaunchKernelGGL(dump_kernel, dim3(1024), dim3(256), 0, stream, (const bf16_t*)((unsigned char*)d_ws + (size_t)MK_DUMP), (float*)d_out, (size_t)NB * SEQ * D);
#endif
#else
    p.ph_lo = 0; p.ph_hi = NPHASE;
    hipLaunchKernelGGL(fwd_kernel, dim3(256), dim3(NT), LDS_BYTES, stream, p);
#endif
}
```

```cpp
#include <hip/hip_runtime.h>
#include <stdint.h>
#include <stdio.h>
#include <string.h>

#ifndef MK_PER_PHASE
#define MK_PER_PHASE 0
#endif

typedef unsigned short bf16_t;
typedef short bf16x8 __attribute__((ext_vector_type(8)));
typedef float f32x4 __attribute__((ext_vector_type(4)));
typedef unsigned u32x4 __attribute__((ext_vector_type(4)));
typedef unsigned u32x2 __attribute__((ext_vector_type(2)));
#define LAS __attribute__((address_space(3)))
#define CAS __attribute__((address_space(4)))

constexpr int D = 1024, NB = 4, SEQ = 8192, CTXL = 256, DEPTH = 4;
constexpr int NCTX = NB * CTXL;
constexpr int NROWS = NCTX + NB * SEQ;
constexpr int P_EVEN = 2848, P_ODD = 4416, LDP_EVEN = 3072, LDP_ODD = 4608;
constexpr int NEXP = 32, DEXP = 512, LISTCAP = NROWS;
constexpr float ALPHA = 1.681792830507429f;
constexpr int NT = 512;
constexpr int TCH = 32;
constexpr int NSTEPS = CTXL + SEQ;
constexpr int LDS_BYTES = 160 * 1024;

constexpr size_t al256(size_t x) { return (x + 255) & ~(size_t)255; }
constexpr size_t WS_BAR = 0;
constexpr size_t WS_CNT = 16384;
constexpr int CNT_STRIDE = 64;
constexpr size_t WS_ZERO_BYTES = 16384 + (size_t)4 * 32 * CNT_STRIDE * 4;
constexpr size_t WS_MODV = al256(WS_ZERO_BYTES);
constexpr size_t WS_LB = WS_MODV + al256((size_t)4 * 5 * 6144 * 4);
constexpr size_t WS_XC = WS_LB + al256(4 * 512 * 4);
constexpr size_t WS_WTS = WS_XC + (size_t)NCTX * D * 4;
constexpr size_t WS_LIST = WS_WTS + al256((size_t)2 * NROWS * 4);
constexpr size_t WS_WINT = WS_LIST + al256((size_t)NEXP * LISTCAP * 4);
constexpr size_t WINT_L0 = 0, WINT_L1 = (size_t)LDP_EVEN * D, WINT_L2 = WINT_L1 + (size_t)LDP_ODD * D, WINT_L3 = WINT_L2 + (size_t)LDP_EVEN * D, WINT_END = WINT_L3 + (size_t)LDP_ODD * D;
constexpr size_t WS_WOUTT = WS_WINT + WINT_END * 2;
constexpr size_t WS_LORAT = WS_WOUTT + (size_t)4 * D * D * 2;
constexpr size_t LORA_PER = (size_t)512 * 320;
constexpr size_t WS_EXPGU = WS_LORAT + al256(2 * LORA_PER * 2);
constexpr size_t WS_EXPD = WS_EXPGU + (size_t)NEXP * 1024 * 1024 * 2;
constexpr size_t WS_ACT = WS_EXPD + (size_t)NEXP * 1024 * 512 * 2;
constexpr size_t ROWB = (size_t)NROWS * D * 2;
constexpr size_t WS_FEAT = WS_ACT + ROWB;
constexpr size_t WS_YF = WS_FEAT + ROWB;
constexpr size_t WS_YB = WS_YF + ROWB;
constexpr size_t WS_P = WS_YB + ROWB;
constexpr size_t P_BYTES = (size_t)NROWS * LDP_ODD * 2;
constexpr size_t WS_YO = WS_P;
constexpr size_t WS_HID = WS_P + ROWB;
constexpr size_t WS_YP = WS_HID + ROWB;
static_assert(WS_YP + 2 * ROWB <= WS_P + P_BYTES, "MoE buffers must fit in the P region");
constexpr size_t HALFB = (size_t)NROWS * 512 * 2;
constexpr size_t WS_RWR = WS_P + P_BYTES;
constexpr size_t WS_RWK = WS_RWR + HALFB;
constexpr size_t WS_RWV = WS_RWK + HALFB;
constexpr size_t WS_RWKK = WS_RWV + HALFB;
constexpr size_t WS_RWB = WS_RWKK + HALFB;
constexpr size_t WS_RWG = WS_RWB + HALFB;
constexpr size_t WS_RWDEC = WS_RWG + HALFB;
constexpr size_t WS_LA = WS_RWDEC + (size_t)2 * NROWS * 512 * 4;
constexpr size_t WS_END = WS_LA + (size_t)NROWS * 320 * 2;
static_assert(WS_END <= (size_t)280602384 * 4, "workspace map exceeds the guaranteed ws_size");

struct Params {
    const float *x, *c, *ctx, *c_ctx, *mod_w, *mod_b, *ln_g, *ln_b;
    const float *ev_w_in, *ev_w_out, *ssd_conv_w, *ssd_conv_b, *ssd_dt_bias, *ssd_a_log, *ssd_d, *ssd_norm_w;
    const float *ml_conv_w, *ml_conv_b, *ml_i_bias, *ml_f_bias, *ml_norm_w;
    const float *od_w_in, *od_w_out, *hg_lb_logits, *hg_f_bias, *hg_norm_w;
    const float *rw_mu, *rw_w0, *rw_w2, *rw_a0, *rw_a2, *rw_g2, *rw_k_k, *rw_k_a, *rw_r_k, *rw_ln_w, *rw_ln_b;
    const float *router_w, *router_bias, *exp_w_gate, *exp_w_up, *exp_w_down;
    float* out;
    unsigned char* ws;
    int ph_lo, ph_hi, dbg, pad_;
};
typedef const CAS Params* KP;

__device__ __forceinline__ int ltid(int wv) { int l; asm volatile("v_mbcnt_lo_u32_b32 %0, -1, 0\n\tv_mbcnt_hi_u32_b32 %0, -1, %0" : "=v"(l)); return wv * 64 + l; }
__device__ __forceinline__ float bf2f(bf16_t h) { return __uint_as_float(((unsigned)h) << 16); }
__device__ __forceinline__ float bflo(unsigned u) { return __uint_as_float(u << 16); }
__device__ __forceinline__ float bfhi(unsigned u) { return __uint_as_float(u & 0xffff0000u); }
typedef __bf16 bf16v2_t __attribute__((ext_vector_type(2)));
typedef float f32x2 __attribute__((ext_vector_type(2)));
__device__ __forceinline__ unsigned pk2(float lo, float hi) { const f32x2 v = {lo, hi}; return __builtin_bit_cast(unsigned, __builtin_convertvector(v, bf16v2_t)); }
__device__ __forceinline__ bf16_t f2bf(float f) { return (bf16_t)(pk2(f, 0.f) & 0xffffu); }
__device__ __forceinline__ void unpack8(const u32x4& u, float* f) {
    f[0] = bflo(u.x); f[1] = bfhi(u.x); f[2] = bflo(u.y); f[3] = bfhi(u.y); f[4] = bflo(u.z); f[5] = bfhi(u.z); f[6] = bflo(u.w); f[7] = bfhi(u.w);
}
__device__ __forceinline__ u32x4 pack8(const float* f) { u32x4 u; u.x = pk2(f[0], f[1]); u.y = pk2(f[2], f[3]); u.z = pk2(f[4], f[5]); u.w = pk2(f[6], f[7]); return u; }
__device__ __forceinline__ float sigmoidf_(float x) { return __builtin_amdgcn_rcpf(1.f + __expf(-x)); }
__device__ __forceinline__ float siluf_(float x) { return x * __builtin_amdgcn_rcpf(1.f + __expf(-x)); }
__device__ __forceinline__ float softplus_fast(float x) { return x > 20.f ? x : __logf(1.f + __expf(x)); }
__device__ __forceinline__ float tanh_fast(float x) { return 1.f - 2.f * __builtin_amdgcn_rcpf(1.f + __expf(2.f * x)); }
__device__ __forceinline__ float softplusf_(float x) { return x > 20.f ? x : __logf(1.f + __expf(x)); }
__device__ __forceinline__ float logsigmoidf_(float x) { return fminf(x, 0.f) - __logf(1.f + __expf(-fabsf(x))); }
template <int CTRL> __device__ __forceinline__ float dppmov(float v) {
    return __builtin_bit_cast(float, __builtin_amdgcn_update_dpp(0, __builtin_bit_cast(int, v), CTRL, 0xf, 0xf, true));
}
__device__ __forceinline__ float allreduce16(float v) {
    v += dppmov<0xB1>(v);
    v += dppmov<0x4E>(v);
    v += dppmov<0x141>(v);
    v += dppmov<0x140>(v);
    return v;
}
__device__ __forceinline__ float allreduce8_(float v) { v += dppmov<0xB1>(v); v += dppmov<0x4E>(v); v += dppmov<0x141>(v); return v; }
__device__ __forceinline__ float wave_sum(float v) {
    v = allreduce16(v);
    const float r0 = __builtin_bit_cast(float, __builtin_amdgcn_readlane(__builtin_bit_cast(int, v), 0)), r1 = __builtin_bit_cast(float, __builtin_amdgcn_readlane(__builtin_bit_cast(int, v), 16));
    const float r2 = __builtin_bit_cast(float, __builtin_amdgcn_readlane(__builtin_bit_cast(int, v), 32)), r3 = __builtin_bit_cast(float, __builtin_amdgcn_readlane(__builtin_bit_cast(int, v), 48));
    return (r0 + r1) + (r2 + r3);
}
template <int W> __device__ __forceinline__ float group_sum(float v) {
    if (W == 8) return allreduce8_(v);
    return allreduce16(v);
}

#define XB_TMO      128
#define XB_XCNT(j)  (256  + 64 * (j))
#define XB_XSUB(j)  (1280 + 64 * (j))
#define XB_XGEN(j)  (2304 + 64 * (j))
#define XB_TOP      3328
#define XB_TOPGEN   3392
#define XCD_BAR_WORDS 3456
#define XB_SPIN_CAP (1u << 22)
__device__ __forceinline__ unsigned xb_ld(unsigned* p)              { return __hip_atomic_load(p, __ATOMIC_RELAXED, __HIP_MEMORY_SCOPE_AGENT); }
__device__ __forceinline__ unsigned xb_add(unsigned* p, unsigned v) { return __hip_atomic_fetch_add(p, v, __ATOMIC_RELAXED, __HIP_MEMORY_SCOPE_AGENT); }
__device__ __forceinline__ unsigned xb_xcc_id() { return (unsigned)__builtin_amdgcn_s_getreg((3 << 11) | 20) & 0xFu; }
#define XB_SPIN(cond, bar) do { unsigned _sp = 0; while (cond) { __builtin_amdgcn_s_sleep(1); \
    if ((++_sp & 255u) == 0u) { if (xb_ld(&(bar)[XB_TMO])) break; if (_sp > XB_SPIN_CAP) { atomicAdd(&(bar)[XB_TMO], 1u); break; } } } } while (0)
struct XcdBarrier { unsigned* bar; unsigned x; volatile LAS unsigned* st; };
__device__ __forceinline__ XcdBarrier xcd_barrier_post(int wv, unsigned* bar, volatile LAS unsigned* st) {
    XcdBarrier b; b.bar = bar; b.x = xb_xcc_id(); b.st = st;
    if (ltid(wv) == 0) (void)xb_add(&bar[XB_XCNT(b.x)], 1u);
    return b;
}
__device__ __forceinline__ void xcd_barrier_complete(unsigned* bar, unsigned x, unsigned& nloc, unsigned& nx) {
    const unsigned G = gridDim.x * gridDim.y * gridDim.z;
    unsigned sum, cnt, mine, sp = 0u;
    for (;;) {
        sum = 0u; cnt = 0u; mine = 0u;
#pragma unroll
        for (unsigned j = 0; j < 16; ++j) { const unsigned c = xb_ld(&bar[XB_XCNT(j)]); sum += c; cnt += (c > 0u) ? 1u : 0u; mine = (j == x) ? c : mine; }
        if (sum == G) break;
        __builtin_amdgcn_s_sleep(1);
        if ((++sp & 255u) == 0u) { if (xb_ld(&bar[XB_TMO])) break; if (sp > XB_SPIN_CAP) { atomicAdd(&bar[XB_TMO], 1u); break; } }
    }
    nloc = mine > 0u ? mine : 1u; nx = cnt > 0u ? cnt : 1u;
}
__device__ __forceinline__ void xcd_barrier(int wv, const XcdBarrier& b) {
    asm volatile("s_waitcnt vmcnt(0)" ::: "memory");
    __syncthreads();
    if (ltid(wv) == 0) {
        unsigned* bar = b.bar;
        asm volatile("" : "+s"(bar));
        __builtin_amdgcn_s_waitcnt(0);
        unsigned nloc = b.st[0], nx = b.st[1];
        if (nloc == 0u) { xcd_barrier_complete(bar, b.x, nloc, nx); b.st[0] = nloc; b.st[1] = nx; }
        const unsigned old = xb_add(&bar[XB_XSUB(b.x)], 1u);
        const unsigned gen = old / nloc;
        if (old + 1u == (gen + 1u) * nloc) {
            __builtin_amdgcn_fence(__ATOMIC_RELEASE, "agent");
            asm volatile("s_waitcnt vmcnt(0)" ::: "memory");
            const unsigned og = xb_add(&bar[XB_TOP], 1u);
            const unsigned tg = og / nx;
            if (og + 1u == (tg + 1u) * nx) xb_add(&bar[XB_TOPGEN], 1u);
            else XB_SPIN(xb_ld(&bar[XB_TOPGEN]) == tg, bar);
            __builtin_amdgcn_fence(__ATOMIC_ACQUIRE, "agent");
            xb_add(&bar[XB_XGEN(b.x)], 1u);
            asm volatile("s_waitcnt vmcnt(0)" ::: "memory");
        } else {
            XB_SPIN(xb_ld(&bar[XB_XGEN(b.x)]) == gen, bar);
            __builtin_amdgcn_fence(__ATOMIC_ACQUIRE, "agent");
            asm volatile("s_waitcnt vmcnt(0)" ::: "memory");
        }
    }
    __syncthreads();
}

__device__ __forceinline__ int row_mod(int r) { return r < NCTX ? 4 : ((r - NCTX) >> 13); }
__device__ __forceinline__ void row_seg(int r, int& t, int& len) { if (r < NCTX) { t = r & 255; len = CTXL; } else { t = (r - NCTX) & 8191; len = SEQ; } }
__device__ __forceinline__ int scan_row(int tg, int b, int dir, int odd) {
    if (tg < CTXL) { const int t = dir ? (CTXL - 1 - tg) : tg; return b * CTXL + t; }
    int sg = tg - CTXL; if (dir) sg = SEQ - 1 - sg;
    const int s = odd ? (((sg & 127) << 6) + (sg >> 7)) : sg;
    return NCTX + b * SEQ + s;
}
__device__ __forceinline__ const float* modvec(const unsigned char* ws, int layer, int m, int which) {
    return (const float*)(ws + WS_MODV) + ((size_t)(layer * 5 + m) * 6 + which) * D;
}

constexpr int G_BM = 256, G_BN = 128, G_BK = 64;
constexpr int G_ABYTES = G_BM * G_BK * 2, G_BBYTES = G_BN * G_BK * 2, G_BUF = G_ABYTES + G_BBYTES;
__device__ __forceinline__ int swz(int o) { return o ^ (((o >> 9) & 1) << 5); }

template <class RowSrc, class Epi>
__device__ __forceinline__ void gemm_tile(int wv, const bf16_t* __restrict__ A, int lda, const RowSrc& rs, const bf16_t* __restrict__ Bt, int ldb, int n0, int K, const Epi& epi, LAS char* lds) {
    const int tid = ltid(wv), lane = tid & 63, wid = tid >> 6, wm = wid >> 1, wn = wid & 1;
    const bf16_t* ap[4]; int aoff[4];
#pragma unroll
    for (int i = 0; i < 4; ++i) {
        const int c = tid + NT * i, row = c >> 3, kc = c & 7;
        ap[i] = A + (size_t)rs.src(row) * lda + kc * 8;
        aoff[i] = ((row >> 4) * 2 + (kc >> 2)) * 1024 + swz((row & 15) * 64 + (kc & 3) * 16);
    }
    const bf16_t* bp[2]; int boff[2];
#pragma unroll
    for (int i = 0; i < 2; ++i) {
        const int c = tid + NT * i, row = c >> 3, kc = c & 7;
        bp[i] = Bt + (size_t)(n0 + row) * ldb + kc * 8;
        boff[i] = G_ABYTES + ((row >> 4) * 2 + (kc >> 2)) * 1024 + swz((row & 15) * 64 + (kc & 3) * 16);
    }
    f32x4 acc[4][4];
#pragma unroll
    for (int i = 0; i < 4; ++i)
#pragma unroll
        for (int j = 0; j < 4; ++j) acc[i][j] = (f32x4){0.f, 0.f, 0.f, 0.f};
    u32x4 ra[2][4], rb[2][2];
    const int KT = K / G_BK;
    const int fragoff = swz((lane & 15) * 64 + (lane >> 4) * 16);
#define G_LOAD(set, kt_) do { _Pragma("unroll") for (int i = 0; i < 4; ++i) ra[set][i] = *(const u32x4*)(ap[i] + (kt_) * G_BK); \
                              _Pragma("unroll") for (int i = 0; i < 2; ++i) rb[set][i] = *(const u32x4*)(bp[i] + (kt_) * G_BK); } while (0)
#define G_STORE(set, buf) do { _Pragma("unroll") for (int i = 0; i < 4; ++i) *(LAS u32x4*)((buf) + aoff[i]) = ra[set][i]; \
                               _Pragma("unroll") for (int i = 0; i < 2; ++i) *(LAS u32x4*)((buf) + boff[i]) = rb[set][i]; } while (0)
#define G_COMPUTE(cur) do { bf16x8 af[2][4], bfr[2][4]; \
        _Pragma("unroll") for (int ks = 0; ks < 2; ++ks) { \
            _Pragma("unroll") for (int ni = 0; ni < 4; ++ni) bfr[ks][ni] = *(LAS bf16x8*)((cur) + G_ABYTES + ((wn * 4 + ni) * 2 + ks) * 1024 + fragoff); \
            _Pragma("unroll") for (int mi = 0; mi < 4; ++mi) af[ks][mi] = *(LAS bf16x8*)((cur) + ((wm * 4 + mi) * 2 + ks) * 1024 + fragoff); } \
        __builtin_amdgcn_sched_barrier(0); \
        _Pragma("unroll") for (int ks = 0; ks < 2; ++ks) _Pragma("unroll") for (int mi = 0; mi < 4; ++mi) _Pragma("unroll") for (int ni = 0; ni < 4; ++ni) \
            acc[mi][ni] = __builtin_amdgcn_mfma_f32_16x16x32_bf16(bfr[ks][ni], af[ks][mi], acc[mi][ni], 0, 0, 0); \
        __builtin_amdgcn_sched_barrier(0); } while (0)
    G_LOAD(0, 0);
    G_STORE(0, lds);
    if (KT > 1) G_LOAD(0, 1);
    if (KT > 2) G_LOAD(1, 2);
    __syncthreads();
    for (int kt = 0; kt < KT; kt += 2) {
        G_COMPUTE(lds);
        if (kt + 1 < KT) G_STORE(0, lds + G_BUF);
        if (kt + 3 < KT) G_LOAD(0, kt + 3);
        __syncthreads();
        if (kt + 1 < KT) {
            G_COMPUTE(lds + G_BUF);
            if (kt + 2 < KT) G_STORE(1, lds);
            if (kt + 4 < KT) G_LOAD(1, kt + 4);
            __syncthreads();
        }
    }
#undef G_LOAD
#undef G_STORE
#undef G_COMPUTE
    epi(acc, wm * 64 + (lane & 15), wn * 64 + 4 * (lane >> 4));
}

constexpr int G2_BN = 256, G2_BBYTES = G2_BN * G_BK * 2, G2_BUF = G_ABYTES + G2_BBYTES;

struct RowLinear { int m0; __device__ __forceinline__ int src(int r) const { return m0 + r; } };
struct RowList {
    const int* list; int cnt; int shift;
    __device__ __forceinline__ int src(int r) const { const int a = list[r < cnt ? r : 0]; return a >> shift; }
};
struct EpiStoreBf16 {
    bf16_t* C; int ldc; int m0; int n0; int N;
    template <int NI> __device__ __forceinline__ void operator()(const f32x4 (&acc)[4][NI], int rbase, int cbase) const {
#pragma unroll
        for (int mi = 0; mi < 4; ++mi) {
            bf16_t* rowp = C + (size_t)(m0 + rbase + mi * 16) * ldc + n0 + cbase;
#pragma unroll
            for (int ni = 0; ni < NI; ++ni) {
                if (n0 + cbase + ni * 16 < N) { u32x2 v; v.x = pk2(acc[mi][ni][0], acc[mi][ni][1]); v.y = pk2(acc[mi][ni][2], acc[mi][ni][3]); *(u32x2*)(rowp + ni * 16) = v; }
            }
        }
    }
};
struct EpiSwiGLU {
    bf16_t* H; const int* list; int cnt; int n0;
    template <int NI> __device__ __forceinline__ void operator()(const f32x4 (&acc)[4][NI], int rbase, int cbase) const {
#pragma unroll
        for (int mi = 0; mi < 4; ++mi) {
            const int r = rbase + mi * 16;
            if (r < cnt) {
                const int a = list[r];
                const int wnb = cbase & ~63, q4 = cbase & 63;
                bf16_t* rowp = H + (size_t)a * DEXP + ((n0 + wnb) >> 1) + q4;
#pragma unroll
                for (int q = 0; q < NI / 2; ++q) {
                    float o[4];
#pragma unroll
                    for (int j = 0; j < 4; ++j) o[j] = siluf_(acc[mi][2 * q][j]) * acc[mi][2 * q + 1][j];
                    u32x2 v; v.x = pk2(o[0], o[1]); v.y = pk2(o[2], o[3]); *(u32x2*)(rowp + q * 16) = v;
                }
            }
        }
    }
};
struct EpiScatterBf16 {
    bf16_t* C; const int* list; int cnt; int n0;
    template <int NI> __device__ __forceinline__ void operator()(const f32x4 (&acc)[4][NI], int rbase, int cbase) const {
#pragma unroll
        for (int mi = 0; mi < 4; ++mi) {
            const int r = rbase + mi * 16;
            if (r < cnt) {
                bf16_t* rowp = C + (size_t)list[r] * D + n0 + cbase;
#pragma unroll
                for (int ni = 0; ni < NI; ++ni) { u32x2 v; v.x = pk2(acc[mi][ni][0], acc[mi][ni][1]); v.y = pk2(acc[mi][ni][2], acc[mi][ni][3]); *(u32x2*)(rowp + ni * 16) = v; }
            }
        }
    }
};
struct EpiDecay {
    float* Dc; const float* w0; int m0; int n0;
    template <int NI> __device__ __forceinline__ void operator()(const f32x4 (&acc)[4][NI], int rbase, int cbase) const {
#pragma unroll
        for (int ni = 0; ni < NI; ++ni) {
            const int col = n0 + cbase + ni * 16;
            const f32x4 w0v = *(const f32x4*)(w0 + col);
#pragma unroll
            for (int mi = 0; mi < 4; ++mi) {
                f32x4 o;
#pragma unroll
                for (int j = 0; j < 4; ++j) { const float w = w0v[j] + acc[mi][ni][j]; o[j] = __expf(-__expf(-softplus_fast(-w) - 0.5f)); }
                *(f32x4*)(Dc + (size_t)(m0 + rbase + mi * 16) * 512 + col) = o;
            }
        }
    }
};
struct EpiAK {
    bf16_t* Kb; const bf16_t* KKb; bf16_t* Bb; const float* a0; const float* k_a; int m0; int n0;
    template <int NI> __device__ __forceinline__ void operator()(const f32x4 (&acc)[4][NI], int rbase, int cbase) const {
#pragma unroll
        for (int ni = 0; ni < NI; ++ni) {
            const int col = n0 + cbase + ni * 16;
            const f32x4 a0v = *(const f32x4*)(a0 + col), kav = *(const f32x4*)(k_a + col);
#pragma unroll
            for (int mi = 0; mi < 4; ++mi) {
                const size_t off = (size_t)(m0 + rbase + mi * 16) * 512 + col;
                const u32x2 kr = *(const u32x2*)(Kb + off), kkr = *(const u32x2*)(KKb + off);
                const float kf[4] = {bflo(kr.x), bfhi(kr.x), bflo(kr.y), bfhi(kr.y)}, kkf[4] = {bflo(kkr.x), bfhi(kkr.x), bflo(kkr.y), bfhi(kkr.y)};
                float k2[4], bb[4];
#pragma unroll
                for (int j = 0; j < 4; ++j) { const float a = sigmoidf_(a0v[j] + acc[mi][ni][j]); k2[j] = kf[j] * (1.f + (a - 1.f) * kav[j]); bb[j] = kkf[j] * a; }
                u32x2 v; v.x = pk2(k2[0], k2[1]); v.y = pk2(k2[2], k2[3]); *(u32x2*)(Kb + off) = v;
                v.x = pk2(bb[0], bb[1]); v.y = pk2(bb[2], bb[3]); *(u32x2*)(Bb + off) = v;
            }
        }
    }
};

namespace pg8 {
#define PG8_LAS __attribute__((address_space(3)))
constexpr int BM = 256, BK = 64, HALF = 128, HTB = HALF * BK * 2, STAGE_BYTES = 8 * HTB, NXCD = 8, WGM = 8;
__host__ __device__ __forceinline__ int lds_byte(int r, int c) { const int st = (r >> 4) * 2 + (c >> 5), rr = r & 15, cc = c & 31, ob = rr * 64 + cc * 2; return st * 1024 + (ob ^ (((ob >> 9) & 1) << 5)); }
__host__ __device__ __forceinline__ void stage_rc(int b, int& R, int& C) { const int st = b / 1024, sb = b % 1024, swz = sb ^ (((sb >> 9) & 1) << 5); R = (st >> 1) * 16 + swz / 64; C = (st & 1) * 32 + (swz % 64) / 2; }
__host__ __device__ __forceinline__ int perm32(int rho) { const int n = rho >> 4, i = rho & 15; return 8 * (i >> 2) + 4 * n + (i & 3); }
struct Unit { int pm, pn; };
struct Gemm { const bf16_t* A; const bf16_t* Bt; int M, N, K; };
struct StaticOrder {
    int nM, nN, nwg, G, c;
    __host__ __device__ void init(int M, int N, int G_, int c_) { nM = M / BM; nN = N / BM; nwg = nM * nN; G = G_; c = c_; }
    __host__ __device__ bool next(int i, Unit& u) const {
        const long L = (long)i * G + c; if (L >= nwg) return false;
        int wgid = (int)L; { const int q = nwg / NXCD, r = nwg % NXCD, xcd = wgid % NXCD, off = wgid / NXCD; wgid = (xcd < r ? xcd * (q + 1) : r * (q + 1) + (xcd - r) * q) + off; }
        const int nig = WGM * nN, gid = wgid / nig, fm = gid * WGM, gsz = (nM - fm) < WGM ? (nM - fm) : WGM;
        u.pm = fm + ((wgid % nig) % gsz); u.pn = (wgid % nig) / gsz; return true;
    }
    __device__ __forceinline__ void a_ready(const Unit&) const {}
    __device__ __forceinline__ void done(const Unit&) const {}
};
struct EpiStoreP {
    static constexpr bool PERM = true, AFTER_DRAIN = false;
    bf16_t* O; int ldc;
    __device__ __forceinline__ void operator()(const f32x4 (&acc)[2][2][4][2], const Unit& u, int wr, int wc, int fr, int fq) const {
        const int row0 = u.pm * BM + wr * 64 + fr, col0 = u.pn * BM + wc * 32 + 8 * fq;
#pragma unroll
        for (int ai = 0; ai < 2; ++ai)
#pragma unroll
            for (int m = 0; m < 4; ++m) { bf16_t* rowp = O + (size_t)(row0 + ai * HALF + m * 16) * ldc + col0;
#pragma unroll
                for (int bj = 0; bj < 2; ++bj) { const f32x4 v0 = acc[ai][bj][m][0], v1 = acc[ai][bj][m][1];
                    u32x4 w; w.x = pk2(v0[0], v0[1]); w.y = pk2(v0[2], v0[3]); w.z = pk2(v1[0], v1[1]); w.w = pk2(v1[2], v1[3]);
                    *(u32x4*)(rowp + bj * HALF) = w; } }
    }
};
template <class Epi, class Sched>
__device__ __forceinline__ void gemm_phase(int wv, PG8_LAS unsigned char* lds, const Gemm g, const Sched& S, const Epi& E) {
    const int tid = ltid(wv), wid = __builtin_amdgcn_readfirstlane(tid >> 6), lane = tid & 63, wr = wid >> 2, wc = wid & 3, fr = lane & 15, fq = lane >> 4;
    const int K = g.K, nt = K / BK;
    unsigned voffA[2], voffB[2];
#pragma unroll
    for (int i = 0; i < 2; ++i) { int R, C; stage_rc(tid * 16 + i * 8192, R, C); const int Rb = Epi::PERM ? ((R & ~31) + perm32(R & 31)) : R;
        voffA[i] = (unsigned)(R * K + C) * 2u; voffB[i] = (unsigned)(Rb * K + C) * 2u; }
    const size_t kstep = (size_t)(BK * 2);
    const size_t hstep = (size_t)HALF * K * 2;
    const size_t tstep = 2 * hstep;
    const unsigned ldsw = (unsigned)wid * 1024u;
    const int aoff = lds_byte(wr * 64 + fr, fq * 8), boff = lds_byte(wc * 32 + fr, fq * 8);
#define PG8_SA(b, h) (((b) * 2 + (h)) * HTB)
#define PG8_SB(b, h) ((4 + (b) * 2 + (h)) * HTB)
#define PG8_STAGE(bufoff, gbase, voff) do { _Pragma("unroll") for (int _i = 0; _i < 2; ++_i) \
        __builtin_amdgcn_global_load_lds((const unsigned*)((const char*)(gbase) + (voff)[_i]), (PG8_LAS unsigned*)(lds + (bufoff) + ldsw + _i * 8192), 16, 0, 0); } while (0)
#define PG8_LDA(dst, b, h) do { _Pragma("unroll") for (int m = 0; m < 4; ++m) _Pragma("unroll") for (int k = 0; k < 2; ++k) dst[m][k] = *(const PG8_LAS bf16x8*)(lds + PG8_SA(b, h) + aoff + m * 2048 + k * 1024); } while (0)
#define PG8_LDB(dst, b, h) do { _Pragma("unroll") for (int n = 0; n < 2; ++n) _Pragma("unroll") for (int k = 0; k < 2; ++k) dst[n][k] = *(const PG8_LAS bf16x8*)(lds + PG8_SB(b, h) + boff + n * 2048 + k * 1024); } while (0)
#define PG8_MMA(ai, bj, At, Bt) do { __builtin_amdgcn_s_setprio(1); _Pragma("unroll") for (int m = 0; m < 4; ++m) _Pragma("unroll") for (int n = 0; n < 2; ++n) _Pragma("unroll") for (int k = 0; k < 2; ++k) \
        acc[ai][bj][m][n] = __builtin_amdgcn_mfma_f32_16x16x32_bf16(Bt[n][k], At[m][k], acc[ai][bj][m][n], 0, 0, 0); __builtin_amdgcn_s_setprio(0); } while (0)
#define PG8_WAIT_V(n) asm volatile("s_waitcnt vmcnt(" #n ")" ::: "memory")
#define PG8_WAIT_L(n) asm volatile("s_waitcnt lgkmcnt(" #n ")" ::: "memory")
#define PG8_BAR __builtin_amdgcn_s_barrier()
#define PG8_SCHED __builtin_amdgcn_sched_barrier(0)
    Unit cur, nxt; int ui = 0;
    if (!S.next(0, cur)) return;
    f32x4 acc[2][2][4][2];
#pragma unroll
    for (int a = 0; a < 2; ++a)
#pragma unroll
        for (int b = 0; b < 2; ++b)
#pragma unroll
            for (int m = 0; m < 4; ++m)
#pragma unroll
                for (int n = 0; n < 2; ++n) acc[a][b][m][n] = (f32x4){0.f, 0.f, 0.f, 0.f};
    bf16x8 At[4][2], B0[2][2], B1[2][2];
    const char* cA = (const char*)g.A + (size_t)cur.pm * tstep; const char* cB = (const char*)g.Bt + (size_t)cur.pn * tstep;
    S.a_ready(cur);
    PG8_STAGE(PG8_SB(0, 0), cB, voffB); PG8_STAGE(PG8_SA(0, 0), cA, voffA); PG8_STAGE(PG8_SB(0, 1), cB + hstep, voffB); PG8_STAGE(PG8_SA(0, 1), cA + hstep, voffA);
    if (wr == 1) PG8_BAR;
    PG8_WAIT_V(4); PG8_BAR;
    PG8_STAGE(PG8_SB(1, 0), cB + kstep, voffB); PG8_STAGE(PG8_SA(1, 0), cA + kstep, voffA); PG8_STAGE(PG8_SB(1, 1), cB + hstep + kstep, voffB);
    PG8_WAIT_V(6); PG8_BAR;
    for (;;) {
        const bool has_next = S.next(ui + 1, nxt);
        const char* nA = has_next ? (const char*)g.A + (size_t)nxt.pm * tstep : cA; const char* nB = has_next ? (const char*)g.Bt + (size_t)nxt.pn * tstep : cB;
        for (int t = 0; t < nt; t += 2) {
            const bool last = (t == nt - 2);
            const char* a1 = cA + (size_t)(t + 1) * kstep;
            const char* a2 = last ? nA : cA + (size_t)(t + 2) * kstep; const char* b2 = last ? nB : cB + (size_t)(t + 2) * kstep;
            const char* a3 = a2 + kstep; const char* b3 = b2 + kstep;
            if (last && has_next) S.a_ready(nxt);
            PG8_LDB(B0, 0, 0); PG8_SCHED; PG8_LDA(At, 0, 0); PG8_STAGE(PG8_SA(1, 1), a1 + hstep, voffA);
            PG8_WAIT_L(8); PG8_BAR; PG8_WAIT_L(0); PG8_MMA(0, 0, At, B0); PG8_BAR; PG8_SCHED;
            PG8_LDB(B1, 0, 1); PG8_STAGE(PG8_SB(0, 0), b2, voffB);
            PG8_BAR; PG8_WAIT_L(0); PG8_MMA(0, 1, At, B1); PG8_BAR;
            PG8_LDA(At, 0, 1); PG8_STAGE(PG8_SA(0, 0), a2, voffA);
            PG8_BAR; PG8_WAIT_L(0); PG8_MMA(1, 0, At, B0); PG8_BAR; PG8_SCHED;
            PG8_STAGE(PG8_SB(0, 1), b2 + hstep, voffB);
            PG8_WAIT_V(6); PG8_BAR; PG8_MMA(1, 1, At, B1); PG8_BAR;
            PG8_LDB(B0, 1, 0); PG8_SCHED; PG8_LDA(At, 1, 0); PG8_STAGE(PG8_SA(0, 1), a2 + hstep, voffA);
            PG8_WAIT_L(8); PG8_BAR; PG8_WAIT_L(0); PG8_MMA(0, 0, At, B0); PG8_BAR; PG8_SCHED;
            PG8_LDB(B1, 1, 1); PG8_STAGE(PG8_SB(1, 0), b3, voffB);
            PG8_BAR; PG8_WAIT_L(0); PG8_MMA(0, 1, At, B1); PG8_BAR;
            PG8_LDA(At, 1, 1); PG8_STAGE(PG8_SA(1, 0), a3, voffA);
            PG8_BAR; PG8_WAIT_L(0); PG8_MMA(1, 0, At, B0); PG8_BAR; PG8_SCHED;
            PG8_STAGE(PG8_SB(1, 1), b3 + hstep, voffB);
            PG8_WAIT_V(6); PG8_BAR; PG8_MMA(1, 1, At, B1); PG8_BAR;
        }
            if constexpr (!Epi::AFTER_DRAIN) { E(acc, cur, wr, wc, fr, fq); S.done(cur); }
            if (!has_next) break;
#pragma unroll
        for (int a = 0; a < 2; ++a)
#pragma unroll
            for (int b = 0; b < 2; ++b)
#pragma unroll
                for (int m = 0; m < 4; ++m)
#pragma unroll
                    for (int n = 0; n < 2; ++n) acc[a][b][m][n] = (f32x4){0.f, 0.f, 0.f, 0.f};
        cur = nxt; cA = nA; cB = nB; ++ui;
    }
    PG8_WAIT_V(0);
    if (wr == 0) PG8_BAR;
    PG8_BAR;
    if constexpr (Epi::AFTER_DRAIN) { E.fused(acc, cur, wr, wc, fr, fq, lds, wid, lane); S.done(cur); }
#undef PG8_SA
#undef PG8_SB
#undef PG8_STAGE
#undef PG8_LDA
#undef PG8_LDB
#undef PG8_MMA
#undef PG8_WAIT_V
#undef PG8_WAIT_L
#undef PG8_BAR
#undef PG8_SCHED
}
struct UnitG { int pm, pn; const char* bbase; const PG8_LAS int* ltab; int cnt; int e; };
struct MoeOrder {
    const PG8_LAS int* tstart; const PG8_LAS int* tcnt; const PG8_LAS int* ltabs; const int* lists; const char* bt; size_t estride; int ncol, shift, G, c;
    __device__ __forceinline__ bool next(int i, UnitG& u) const {
        const int t = i * G + c; if (t >= tstart[32] * ncol) return false;
        const int tm = t / ncol; int e = 0;
#pragma unroll 1
        while (tstart[e + 1] <= tm) ++e;
        e = __builtin_amdgcn_readfirstlane(e);
        const int ts = __builtin_amdgcn_readfirstlane(tstart[e]), tc = __builtin_amdgcn_readfirstlane(tcnt[e]);
        u.pm = tm - ts; u.pn = t - tm * ncol; u.bbase = bt + (size_t)e * estride; u.e = e; u.cnt = tc - u.pm * BM; u.ltab = ltabs + i * BM;
        return true;
    }
    __device__ __forceinline__ void a_ready(const UnitG&) const {}
    __device__ __forceinline__ void done(const UnitG&) const {}
};
struct EpiSwiGLUG {
    static constexpr bool PERM = false, AFTER_DRAIN = false;
    bf16_t* H;
    __device__ __forceinline__ void operator()(const f32x4 (&acc)[2][2][4][2], const UnitG& u, int wr, int wc, int fr, int fq) const {
#pragma unroll
        for (int ai = 0; ai < 2; ++ai)
#pragma unroll
            for (int m = 0; m < 4; ++m) { const int r = ai * HALF + wr * 64 + m * 16 + fr;
                if (r < u.cnt) { bf16_t* rowp = H + (size_t)u.ltab[r] * DEXP + ((u.pn * BM + wc * 32) >> 1) + 4 * fq;
#pragma unroll
                    for (int bj = 0; bj < 2; ++bj) { const f32x4 gt = acc[ai][bj][m][0], up = acc[ai][bj][m][1];
                        u32x2 w; w.x = pk2(siluf_(gt[0]) * up[0], siluf_(gt[1]) * up[1]); w.y = pk2(siluf_(gt[2]) * up[2], siluf_(gt[3]) * up[3]);
                        *(u32x2*)(rowp + bj * (HALF / 2)) = w; } } }
    }
};
struct EpiScatterG {
    static constexpr bool PERM = true, AFTER_DRAIN = false;
    bf16_t* O;
    __device__ __forceinline__ void operator()(const f32x4 (&acc)[2][2][4][2], const UnitG& u, int wr, int wc, int fr, int fq) const {
#pragma unroll
        for (int ai = 0; ai < 2; ++ai)
#pragma unroll
            for (int m = 0; m < 4; ++m) { const int r = ai * HALF + wr * 64 + m * 16 + fr;
                if (r < u.cnt) { bf16_t* rowp = O + (size_t)u.ltab[r] * D + u.pn * BM + wc * 32 + 8 * fq;
#pragma unroll
                    for (int bj = 0; bj < 2; ++bj) { const f32x4 v0 = acc[ai][bj][m][0], v1 = acc[ai][bj][m][1];
                        u32x4 w; w.x = pk2(v0[0], v0[1]); w.y = pk2(v0[2], v0[3]); w.z = pk2(v1[0], v1[1]); w.w = pk2(v1[2], v1[3]);
                        *(u32x4*)(rowp + bj * HALF) = w; } } }
    }
};
template <class Epi, class Sched>
__device__ __forceinline__ void gemm_phase_g(int wv, PG8_LAS unsigned char* lds, const Gemm g, const Sched& S, const Epi& E) {
    const int tid = ltid(wv), wid = __builtin_amdgcn_readfirstlane(tid >> 6), lane = tid & 63, wr = wid >> 2, wc = wid & 3, fr = lane & 15, fq = lane >> 4;
    const int K = g.K, nt = K / BK;
    unsigned voffB[2];
#pragma unroll
    for (int i = 0; i < 2; ++i) { int R, C; stage_rc(tid * 16 + i * 8192, R, C); const int Rb = Epi::PERM ? ((R & ~31) + perm32(R & 31)) : R;
        voffB[i] = (unsigned)(Rb * K + C) * 2u; }
    const unsigned rowb = (unsigned)K * 2u;
#define PG8_AOFFS(u, dst) do { const int _t = ltid(wv); _Pragma("unroll") for (int _i = 0; _i < 2; ++_i) { int _R, _C; stage_rc(_t * 16 + _i * 8192, _R, _C); \
        _Pragma("unroll") for (int _h = 0; _h < 2; ++_h) dst[_h][_i] = (unsigned)((u).ltab[_h * HALF + _R] >> S.shift) * rowb + (unsigned)(_C * 2); } } while (0)
#define PG8_STAGE_A(bufoff, AO, koff) do { _Pragma("unroll") for (int _i = 0; _i < 2; ++_i) \
        __builtin_amdgcn_global_load_lds((const unsigned*)((const char*)g.A + (size_t)(AO)[_i] + (size_t)(koff)), (PG8_LAS unsigned*)(lds + (bufoff) + ldsw + _i * 8192), 16, 0, 0); } while (0)
    const size_t kstep = (size_t)(BK * 2);
    const size_t hstep = (size_t)HALF * K * 2;
    const size_t tstep = 2 * hstep;
    const unsigned ldsw = (unsigned)wid * 1024u;
    const int aoff = lds_byte(wr * 64 + fr, fq * 8), boff = lds_byte(wc * 32 + fr, fq * 8);
#define PG8_SA(b, h) (((b) * 2 + (h)) * HTB)
#define PG8_SB(b, h) ((4 + (b) * 2 + (h)) * HTB)
#define PG8_STAGE(bufoff, gbase, voff) do { _Pragma("unroll") for (int _i = 0; _i < 2; ++_i) \
        __builtin_amdgcn_global_load_lds((const unsigned*)((const char*)(gbase) + (voff)[_i]), (PG8_LAS unsigned*)(lds + (bufoff) + ldsw + _i * 8192), 16, 0, 0); } while (0)
#define PG8_LDA(dst, b, h) do { _Pragma("unroll") for (int m = 0; m < 4; ++m) _Pragma("unroll") for (int k = 0; k < 2; ++k) dst[m][k] = *(const PG8_LAS bf16x8*)(lds + PG8_SA(b, h) + aoff + m * 2048 + k * 1024); } while (0)
#define PG8_LDB(dst, b, h) do { _Pragma("unroll") for (int n = 0; n < 2; ++n) _Pragma("unroll") for (int k = 0; k < 2; ++k) dst[n][k] = *(const PG8_LAS bf16x8*)(lds + PG8_SB(b, h) + boff + n * 2048 + k * 1024); } while (0)
#define PG8_MMA(ai, bj, At, Bt) do { __builtin_amdgcn_s_setprio(1); _Pragma("unroll") for (int m = 0; m < 4; ++m) _Pragma("unroll") for (int n = 0; n < 2; ++n) _Pragma("unroll") for (int k = 0; k < 2; ++k) \
        acc[ai][bj][m][n] = __builtin_amdgcn_mfma_f32_16x16x32_bf16(Bt[n][k], At[m][k], acc[ai][bj][m][n], 0, 0, 0); __builtin_amdgcn_s_setprio(0); } while (0)
#define PG8_WAIT_V(n) asm volatile("s_waitcnt vmcnt(" #n ")" ::: "memory")
#define PG8_WAIT_L(n) asm volatile("s_waitcnt lgkmcnt(" #n ")" ::: "memory")
#define PG8_BAR __builtin_amdgcn_s_barrier()
#define PG8_SCHED __builtin_amdgcn_sched_barrier(0)
    UnitG cur, nxt; int ui = 0;
    if (!S.next(0, cur)) return;
    f32x4 acc[2][2][4][2];
#pragma unroll
    for (int a = 0; a < 2; ++a)
#pragma unroll
        for (int b = 0; b < 2; ++b)
#pragma unroll
            for (int m = 0; m < 4; ++m)
#pragma unroll
                for (int n = 0; n < 2; ++n) acc[a][b][m][n] = (f32x4){0.f, 0.f, 0.f, 0.f};
    bf16x8 At[4][2], B0[2][2], B1[2][2];
    unsigned ca[2][2]; PG8_AOFFS(cur, ca); const char* cB = cur.bbase + (size_t)cur.pn * tstep;
    S.a_ready(cur);
    PG8_STAGE(PG8_SB(0, 0), cB, voffB); PG8_STAGE_A(PG8_SA(0, 0), ca[0], 0); PG8_STAGE(PG8_SB(0, 1), cB + hstep, voffB); PG8_STAGE_A(PG8_SA(0, 1), ca[1], 0);
    if (wr == 1) PG8_BAR;
    PG8_WAIT_V(4); PG8_BAR;
    PG8_STAGE(PG8_SB(1, 0), cB + kstep, voffB); PG8_STAGE_A(PG8_SA(1, 0), ca[0], kstep); PG8_STAGE(PG8_SB(1, 1), cB + hstep + kstep, voffB);
    PG8_WAIT_V(6); PG8_BAR;
    for (;;) {
        const bool has_next = S.next(ui + 1, nxt);
        const char* nB = has_next ? nxt.bbase + (size_t)nxt.pn * tstep : cB;
        for (int t = 0; t < nt; t += 2) {
            const bool last = (t == nt - 2);
            const size_t k1 = (size_t)(t + 1) * kstep, k2 = last ? 0 : (size_t)(t + 2) * kstep;
            unsigned a2o[2][2];
            if (last && has_next) PG8_AOFFS(nxt, a2o); else { a2o[0][0] = ca[0][0]; a2o[0][1] = ca[0][1]; a2o[1][0] = ca[1][0]; a2o[1][1] = ca[1][1]; }
            const char* b2 = last ? nB : cB + (size_t)(t + 2) * kstep; const char* b3 = b2 + kstep;
            if (last && has_next) S.a_ready(nxt);
            PG8_LDB(B0, 0, 0); PG8_SCHED; PG8_LDA(At, 0, 0); PG8_STAGE_A(PG8_SA(1, 1), ca[1], k1);
            PG8_WAIT_L(8); PG8_BAR; PG8_WAIT_L(0); PG8_MMA(0, 0, At, B0); PG8_BAR; PG8_SCHED;
            PG8_LDB(B1, 0, 1); PG8_STAGE(PG8_SB(0, 0), b2, voffB);
            PG8_BAR; PG8_WAIT_L(0); PG8_MMA(0, 1, At, B1); PG8_BAR;
            PG8_LDA(At, 0, 1); PG8_STAGE_A(PG8_SA(0, 0), a2o[0], k2);
            PG8_BAR; PG8_WAIT_L(0); PG8_MMA(1, 0, At, B0); PG8_BAR; PG8_SCHED;
            PG8_STAGE(PG8_SB(0, 1), b2 + hstep, voffB);
            PG8_WAIT_V(6); PG8_BAR; PG8_MMA(1, 1, At, B1); PG8_BAR;
            PG8_LDB(B0, 1, 0); PG8_SCHED; PG8_LDA(At, 1, 0); PG8_STAGE_A(PG8_SA(0, 1), a2o[1], k2);
            PG8_WAIT_L(8); PG8_BAR; PG8_WAIT_L(0); PG8_MMA(0, 0, At, B0); PG8_BAR; PG8_SCHED;
            PG8_LDB(B1, 1, 1); PG8_STAGE(PG8_SB(1, 0), b3, voffB);
            PG8_BAR; PG8_WAIT_L(0); PG8_MMA(0, 1, At, B1); PG8_BAR;
            PG8_LDA(At, 1, 1); PG8_STAGE_A(PG8_SA(1, 0), a2o[0], k2 + kstep);
            PG8_BAR; PG8_WAIT_L(0); PG8_MMA(1, 0, At, B0); PG8_BAR; PG8_SCHED;
            PG8_STAGE(PG8_SB(1, 1), b3 + hstep, voffB);
            PG8_WAIT_V(6); PG8_BAR; PG8_MMA(1, 1, At, B1); PG8_BAR;
            if (last) { ca[0][0] = a2o[0][0]; ca[0][1] = a2o[0][1]; ca[1][0] = a2o[1][0]; ca[1][1] = a2o[1][1]; }
        }
            if constexpr (!Epi::AFTER_DRAIN) { E(acc, cur, wr, wc, fr, fq); S.done(cur); }
            if (!has_next) break;
#pragma unroll
        for (int a = 0; a < 2; ++a)
#pragma unroll
            for (int b = 0; b < 2; ++b)
#pragma unroll
                for (int m = 0; m < 4; ++m)
#pragma unroll
                    for (int n = 0; n < 2; ++n) acc[a][b][m][n] = (f32x4){0.f, 0.f, 0.f, 0.f};
        cur = nxt; cB = nB; ++ui;
    }
    PG8_WAIT_V(0);
    if (wr == 0) PG8_BAR;
    PG8_BAR;
    if constexpr (Epi::AFTER_DRAIN) { E.fused(acc, cur, wr, wc, fr, fq, lds, wid, lane); S.done(cur); }
#undef PG8_SA
#undef PG8_AOFFS
#undef PG8_STAGE_A
#undef PG8_SB
#undef PG8_STAGE
#undef PG8_LDA
#undef PG8_LDB
#undef PG8_MMA
#undef PG8_WAIT_V
#undef PG8_WAIT_L
#undef PG8_BAR
#undef PG8_SCHED
}
}

__device__ __forceinline__ void transpose_item(const float* __restrict__ W, int K, int N, bf16_t* __restrict__ WT, int mode, LAS float* scr, int item, int lane) {
    const int nblk = N / 32, kb = item / nblk, nb = item % nblk, k0 = 64 * kb, n0 = 32 * nb;
#pragma unroll 8
    for (int i = 0; i < 32; ++i) { const int kk = 2 * i + (lane >> 5); scr[kk * 33 + (lane & 31)] = W[(size_t)(k0 + kk) * N + n0 + (lane & 31)]; }
    asm volatile("s_waitcnt lgkmcnt(0)" ::: "memory");
    const int c = lane & 7;
#pragma unroll
    for (int j = 0; j < 4; ++j) {
        const int nl = (lane >> 3) + 8 * j; const LAS float* s = scr + (8 * c) * 33 + nl;
        u32x4 o; o.x = pk2(s[0 * 33], s[1 * 33]); o.y = pk2(s[2 * 33], s[3 * 33]); o.z = pk2(s[4 * 33], s[5 * 33]); o.w = pk2(s[6 * 33], s[7 * 33]);
        const int n = n0 + nl;
        const int nd = mode == 0 ? n : (32 * (n >> 4) + (n & 15) + (mode == 2 ? 16 : 0));
        *(u32x4*)(WT + (size_t)nd * K + k0 + 8 * c) = o;
    }
    asm volatile("s_waitcnt lgkmcnt(0)" ::: "memory");
}

__device__ __forceinline__ void phase_prologue0(int wv, KP Pk, LAS char* lds) {
    asm volatile("" : "+s"(Pk));
    const CAS Params& P = *Pk;
    const int tid = ltid(wv), lane = tid & 63, wid = tid >> 6;
    const int gw = blockIdx.x * 8 + wid, NGW = gridDim.x * 8;
    LAS float* scr = (LAS float*)(lds + wid * 8448);
    bf16_t* winT = (bf16_t*)(P.ws + WS_WINT);
    bf16_t* woutT = (bf16_t*)(P.ws + WS_WOUTT);
    bf16_t* loraT = (bf16_t*)(P.ws + WS_LORAT);
    constexpr int I_EV = 16 * (P_EVEN / 32), I_OD = 16 * (P_ODD / 32), I_O = 16 * 32, I_L64 = 16, I_L128 = 32;
    constexpr int I_LORA = 3 * I_L64 + I_L128;
    constexpr int NIT = 2 * I_EV + 2 * I_OD + 4 * I_O + 2 * I_LORA;
    for (int it = gw; it < NIT; it += NGW) {
        int r = it;
        if (r < 2 * I_EV) { const int i = r / I_EV; transpose_item(P.ev_w_in + (size_t)i * D * P_EVEN, D, P_EVEN, winT + (i ? WINT_L2 : WINT_L0), 0, scr, r % I_EV, lane); continue; } r -= 2 * I_EV;
        if (r < 2 * I_OD) { const int i = r / I_OD; transpose_item(P.od_w_in + (size_t)i * D * P_ODD, D, P_ODD, winT + (i ? WINT_L3 : WINT_L1), 0, scr, r % I_OD, lane); continue; } r -= 2 * I_OD;
        if (r < 4 * I_O) { const int l = r / I_O; const float* src = (l & 1) ? P.od_w_out + (size_t)(l >> 1) * D * D : P.ev_w_out + (size_t)(l >> 1) * D * D;
            transpose_item(src, D, D, woutT + (size_t)l * D * D, 0, scr, r % I_O, lane); continue; } r -= 4 * I_O;
        { const int i = r / I_LORA; int q = r % I_LORA; bf16_t* dst = loraT + (size_t)i * LORA_PER;
          if (q < I_L64) { transpose_item(P.rw_w2 + (size_t)(i * 2 + 0) * 64 * 512, 64, 512, dst, 0, scr, q, lane); continue; } q -= I_L64;
          if (q < I_L64) { transpose_item(P.rw_w2 + (size_t)(i * 2 + 1) * 64 * 512, 64, 512, dst + 512 * 64, 0, scr, q, lane); continue; } q -= I_L64;
          if (q < I_L64) { transpose_item(P.rw_a2 + (size_t)i * 64 * 512, 64, 512, dst + 2 * 512 * 64, 0, scr, q, lane); continue; } q -= I_L64;
          transpose_item(P.rw_g2 + (size_t)i * 128 * 512, 128, 512, dst + 3 * 512 * 64, 0, scr, q, lane); }
    }
    {
        const int gt = blockIdx.x * NT + tid, NG = gridDim.x * NT;
        constexpr int PADE = (LDP_EVEN - P_EVEN) * D / 8, PADO = (LDP_ODD - P_ODD) * D / 8;
        for (int i = gt; i < 2 * PADE + 2 * PADO; i += NG) {
            int r = i; bf16_t* dst;
            if (r < 2 * PADE) { const int l = r / PADE; dst = winT + (l ? WINT_L2 : WINT_L0) + (size_t)P_EVEN * D + (size_t)(r % PADE) * 8; }
            else { r -= 2 * PADE; const int l = r / PADO; dst = winT + (l ? WINT_L3 : WINT_L1) + (size_t)P_ODD * D + (size_t)(r % PADO) * 8; }
            *(u32x4*)dst = (u32x4){0u, 0u, 0u, 0u};
        }
    }
    {
        const int gt = blockIdx.x * NT + tid, NG = gridDim.x * NT;
        float* lb = (float*)(P.ws + WS_LB);
        for (int ch = gt; ch < 512; ch += NG) {
            float lg[4], mx = -1e30f;
#pragma unroll
            for (int l = 0; l < 4; ++l) { lg[l] = P.hg_lb_logits[l * 512 + ch]; mx = fmaxf(mx, lg[l]); }
            float e[4], s = 0.f;
#pragma unroll
            for (int l = 0; l < 4; ++l) { e[l] = __expf(lg[l] - mx); s += e[l]; }
            float cum = 0.f;
#pragma unroll
            for (int l = 0; l < 4; ++l) { if (l > 0) cum += e[l] / s; lb[l * 512 + ch] = cum; }
        }
    }
    __syncthreads();
    {
        LAS float* sc = (LAS float*)lds;
        LAS float* red = (LAS float*)(lds + 5 * 1024 * 4);
        for (int i = tid; i < 5 * D; i += NT) { const int m = i >> 10, k = i & 1023; const float v = m < 4 ? P.c[m * D + k] : P.c_ctx[k]; sc[i] = siluf_(v); }
        __syncthreads();
        float* modv = (float*)(P.ws + WS_MODV);
        const int col = tid & 127, kq = tid >> 7;
        for (int item = blockIdx.x; item < 4 * 48; item += gridDim.x) {
            const int l = item / 48, j = (item % 48) * 128 + col;
            const float* w = P.mod_w + (size_t)l * D * 6144 + j;
            float a[5] = {0.f, 0.f, 0.f, 0.f, 0.f};
#pragma unroll 8
            for (int k = kq * 256; k < kq * 256 + 256; ++k) {
                const float wv = w[(size_t)k * 6144];
#pragma unroll
                for (int m = 0; m < 5; ++m) a[m] += sc[m * 1024 + k] * wv;
            }
#pragma unroll
            for (int m = 0; m < 5; ++m) red[(kq * 128 + col) * 5 + m] = a[m];
            __syncthreads();
            if (kq == 0) {
                const float bias = P.mod_b[l * 6144 + j];
#pragma unroll
                for (int m = 0; m < 5; ++m) {
                    const float s = red[(0 * 128 + col) * 5 + m] + red[(1 * 128 + col) * 5 + m] + red[(2 * 128 + col) * 5 + m] + red[(3 * 128 + col) * 5 + m];
                    modv[(size_t)(l * 5 + m) * 6144 + j] = s + bias;
                }
            }
            __syncthreads();
        }
    }
}

__device__ __forceinline__ void phase_prologue1(int wv, KP Pk) {
    asm volatile("" : "+s"(Pk));
    const CAS Params& P = *Pk;
    const int tid = ltid(wv), lane = tid & 63, wid = tid >> 6;
    bf16_t* act = (bf16_t*)(P.ws + WS_ACT);
    for (int r = blockIdx.x * 8 + wid; r < NROWS; r += gridDim.x * 8) {
        const int m = row_mod(r);
        const float* src = r < NCTX ? P.ctx + (size_t)r * D : P.x + (size_t)(r - NCTX) * D;
        const float* sh = modvec(P.ws, 0, m, 0); const float* sc = modvec(P.ws, 0, m, 1);
#pragma unroll
        for (int i = 0; i < 4; ++i) {
            const int c = 4 * lane + 256 * i;
            const f32x4 v = *(const f32x4*)(src + c), s1 = *(const f32x4*)(sc + c), h1 = *(const f32x4*)(sh + c);
            u32x2 o; o.x = pk2(v[0] * (1.f + s1[0]) + h1[0], v[1] * (1.f + s1[1]) + h1[1]); o.y = pk2(v[2] * (1.f + s1[2]) + h1[2], v[3] * (1.f + s1[3]) + h1[3]);
            *(u32x2*)(act + (size_t)r * D + c) = o;
        }
    }
}

__device__ __forceinline__ void phase_inproj(int wv, KP Pk, int layer, LAS char* lds) {
    asm volatile("" : "+s"(Pk));
    const CAS Params& P = *Pk;
    const int odd = layer & 1, ldp = odd ? LDP_ODD : LDP_EVEN;
    const size_t woff = layer == 0 ? WINT_L0 : layer == 1 ? WINT_L1 : layer == 2 ? WINT_L2 : WINT_L3;
    pg8::Gemm g{(const bf16_t*)(P.ws + WS_ACT), (const bf16_t*)(P.ws + WS_WINT) + woff, NROWS, ldp, D};
    pg8::StaticOrder S; S.init(NROWS, ldp, (int)gridDim.x, (int)blockIdx.x);
    pg8::EpiStoreP E{(bf16_t*)(P.ws + WS_P), ldp};
    pg8::gemm_phase(wv, (PG8_LAS unsigned char*)lds, g, S, E);
}
__device__ __forceinline__ void phase_outproj(int wv, KP Pk, int layer, LAS char* lds) {
    asm volatile("" : "+s"(Pk));
    const CAS Params& P = *Pk;
    const int r0 = (layer == DEPTH - 1) ? NCTX : 0;
    pg8::Gemm g{(const bf16_t*)(P.ws + WS_FEAT) + (size_t)r0 * D, (const bf16_t*)(P.ws + WS_WOUTT) + (size_t)layer * D * D, NROWS - r0, D, D};
    pg8::StaticOrder S; S.init(NROWS - r0, D, (int)gridDim.x, (int)blockIdx.x);
    pg8::EpiStoreP E{(bf16_t*)(P.ws + WS_YO) + (size_t)r0 * D, D};
    pg8::gemm_phase(wv, (PG8_LAS unsigned char*)lds, g, S, E);
}
__device__ __forceinline__ void phase_prep2(int wv, KP Pk, int layer, LAS char* lds) {
    asm volatile("" : "+s"(Pk));
    const CAS Params& P = *Pk;
    const int i = layer >> 1;
    const bf16_t* la = (const bf16_t*)(P.ws + WS_LA);
    const bf16_t* lt = (const bf16_t*)(P.ws + WS_LORAT) + (size_t)i * LORA_PER;
    constexpr int MT = NROWS / G_BM, NTL = 512 / G_BN;
    const int ntiles = 4 * MT * NTL;
    for (int t = blockIdx.x; t < ntiles; t += gridDim.x) {
        const int which = t / (MT * NTL), r = t % (MT * NTL), mt = r / NTL, nt = r % NTL;
        RowLinear rs{mt * G_BM};
        if (which < 2) {
            EpiDecay epi{(float*)(P.ws + WS_RWDEC) + (size_t)which * NROWS * 512, P.rw_w0 + (size_t)(i * 2 + which) * 512, mt * G_BM, nt * G_BN};
            gemm_tile(wv, la + which * 64, 320, rs, lt + (size_t)which * 512 * 64, 64, nt * G_BN, 64, epi, lds);
        } else if (which == 2) {
            EpiAK epi{(bf16_t*)(P.ws + WS_RWK), (const bf16_t*)(P.ws + WS_RWKK), (bf16_t*)(P.ws + WS_RWB), P.rw_a0 + i * 512, P.rw_k_a + i * 512, mt * G_BM, nt * G_BN};
            gemm_tile(wv, la + 128, 320, rs, lt + (size_t)2 * 512 * 64, 64, nt * G_BN, 64, epi, lds);
        } else {
            EpiStoreBf16 epi{(bf16_t*)(P.ws + WS_RWG), 512, mt * G_BM, nt * G_BN, 512};
            gemm_tile(wv, la + 192, 320, rs, lt + (size_t)3 * 512 * 64, 128, nt * G_BN, 128, epi, lds);
        }
    }
}
__device__ __forceinline__ void moe_tiles(int wv, const unsigned char* ws, int layer, LAS int* tstart, LAS int* tcnt) {
    const int tid = ltid(wv);
    if (tid < 64) {
        const int* cnt = (const int*)(ws + WS_CNT) + layer * 32 * CNT_STRIDE;
        const int c = tid < NEXP ? cnt[tid * CNT_STRIDE] : 0;
        int incl = (c + G_BM - 1) / G_BM;
#pragma unroll
        for (int o = 1; o < 32; o <<= 1) { const int t = __shfl_up(incl, o); if (tid >= o) incl += t; }
        if (tid < NEXP) { tcnt[tid] = c; tstart[tid] = incl - (c + G_BM - 1) / G_BM; }
        if (tid == NEXP - 1) tstart[NEXP] = incl;
    }
    __syncthreads();
}
__device__ __forceinline__ void phase_moe1(int wv, KP Pk, int layer, LAS char* lds) {
    asm volatile("" : "+s"(Pk));
    const CAS Params& P = *Pk;
    LAS int* tstart = (LAS int*)(lds + pg8::STAGE_BYTES); LAS int* tcnt = tstart + 40;
    moe_tiles(wv, P.ws, layer, tstart, tcnt);
    pg8::Gemm g{(const bf16_t*)(P.ws + WS_ACT), (const bf16_t*)(P.ws + WS_EXPGU), 0, 1024, D};
    LAS int* ltabs = tstart + 128;
    pg8::MoeOrder S{tstart, tcnt, ltabs, (const int*)(P.ws + WS_LIST), (const char*)(P.ws + WS_EXPGU), (size_t)1024 * 1024 * 2, 4, 1, (int)gridDim.x, (int)blockIdx.x};
    pg8::EpiSwiGLUG E{(bf16_t*)(P.ws + WS_HID)};
    for (int i = 0; i < 8; ++i) {
        pg8::UnitG u; if (!S.next(i, u)) break;
        const int tl = ltid(wv);
        const int* ul = (const int*)(P.ws + WS_LIST) + (size_t)u.e * LISTCAP + u.pm * pg8::BM;
        if (tl < pg8::BM) ltabs[i * pg8::BM + tl] = ul[tl < u.cnt ? tl : 0];
    }
    __syncthreads();
    pg8::gemm_phase_g(wv, (PG8_LAS unsigned char*)lds, g, S, E);
    __syncthreads();
}
__device__ __forceinline__ void phase_moe2(int wv, KP Pk, int layer, LAS char* lds) {
    asm volatile("" : "+s"(Pk));
    const CAS Params& P = *Pk;
    LAS int* tstart = (LAS int*)(lds + pg8::STAGE_BYTES); LAS int* tcnt = tstart + 40;
    moe_tiles(wv, P.ws, layer, tstart, tcnt);
    pg8::Gemm g{(const bf16_t*)(P.ws + WS_HID), (const bf16_t*)(P.ws + WS_EXPD), 0, 1024, DEXP};
    LAS int* ltabs = tstart + 128;
    pg8::MoeOrder S{tstart, tcnt, ltabs, (const int*)(P.ws + WS_LIST), (const char*)(P.ws + WS_EXPD), (size_t)1024 * 512 * 2, 4, 0, (int)gridDim.x, (int)blockIdx.x};
    pg8::EpiScatterG E{(bf16_t*)(P.ws + WS_YP)};
    for (int i = 0; i < 8; ++i) {
        pg8::UnitG u; if (!S.next(i, u)) break;
        const int tl = ltid(wv);
        const int* ul = (const int*)(P.ws + WS_LIST) + (size_t)u.e * LISTCAP + u.pm * pg8::BM;
        if (tl < pg8::BM) ltabs[i * pg8::BM + tl] = ul[tl < u.cnt ? tl : 0];
    }
    __syncthreads();
    pg8::gemm_phase_g(wv, (PG8_LAS unsigned char*)lds, g, S, E);
    __syncthreads();
}

constexpr int NCHUNK = NSTEPS / TCH;

constexpr int SSD_F = 32 + 64 + 64;
constexpr int SSD_BUF = TCH * SSD_F + 3 * TCH;

constexpr int ML_F = 64 + 64 + 32;
constexpr int ML_BUF = TCH * ML_F + 4 * TCH;

constexpr int HG_F = 128 + 128 + 32;
constexpr int HG_BUF = TCH * HG_F + TCH;

constexpr int RW_F = 5 * 64 + 32;
constexpr int RW_BUF = TCH * RW_F + TCH;
__device__ __forceinline__ void scan_rwkv(int wv, KP Pk, int layer, int unit, LAS char* lds) {
    asm volatile("" : "+s"(Pk));
    const CAS Params& P = *Pk;
    const int tid = ltid(wv);
    const int seq = unit >> 1, half = unit & 1, b = seq >> 4, h = (seq >> 1) & 7, dir = seq & 1;
    LAS float* bufs = (LAS float*)lds;
    bf16_t* Y = (bf16_t*)(P.ws + (dir ? WS_YB : WS_YF));
    const float* dec = (const float*)(P.ws + WS_RWDEC) + (size_t)dir * NROWS * 512;
    int tj[4], tg_[4]; bool tv[4]; const unsigned char* tbase[4]; int tlds[4];
#pragma unroll
    for (int s = 0; s < 4; ++s) {
        const int task = tid + NT * s; tv[s] = task < TCH * 52; tj[s] = task / 52; tg_[s] = task % 52;
        const int g = tg_[s];
        if (g < 8)       { tbase[s] = P.ws + WS_RWR  + (size_t)(h * 64 + 8 * g) * 2;              tlds[s] = 256 + 8 * g; }
        else if (g < 16) { tbase[s] = P.ws + WS_RWK  + (size_t)(h * 64 + 8 * (g - 8)) * 2;        tlds[s] = 192 + 8 * (g - 8); }
        else if (g < 24) { tbase[s] = P.ws + WS_RWKK + (size_t)(h * 64 + 8 * (g - 16)) * 2;       tlds[s] = 64 + 8 * (g - 16); }
        else if (g < 32) { tbase[s] = P.ws + WS_RWB  + (size_t)(h * 64 + 8 * (g - 24)) * 2;       tlds[s] = 128 + 8 * (g - 24); }
        else if (g < 36) { tbase[s] = P.ws + WS_RWV  + (size_t)(h * 64 + half * 32 + 8 * (g - 32)) * 2; tlds[s] = 320 + 8 * (g - 32); }
        else             { tbase[s] = (const unsigned char*)(dec + h * 64 + 4 * (g - 36));        tlds[s] = 4 * (g - 36); }
    }
    u32x4 rc[4]; int rrow = 0;
    auto load = [&](int c) {
#pragma unroll
        for (int s = 0; s < 4; ++s) {
            rc[s] = (u32x4){0u, 0u, 0u, 0u};
            if (tv[s]) { const int row = scan_row(c * TCH + tj[s], b, dir, 1); rc[s] = *(const u32x4*)(tbase[s] + (size_t)row * (tg_[s] < 36 ? 1024 : 2048)); }
        }
        if (tid < TCH) rrow = scan_row(c * TCH + tid, b, dir, 1);
    };
    auto store = [&](int c) {
        LAS float* buf = bufs + (c & 1) * RW_BUF;
#pragma unroll
        for (int s = 0; s < 4; ++s) {
            if (tv[s]) {
                LAS float* dst = buf + tj[s] * RW_F + tlds[s];
                const int g = tg_[s];
                if (g >= 36) { *(LAS u32x4*)dst = rc[s]; }
                else {
                    float f[8]; unpack8(rc[s], f);
                    const float sg = (g >= 16 && g < 24) ? -1.f : 1.f;
                    *(LAS f32x4*)dst = (f32x4){sg * f[0], sg * f[1], sg * f[2], sg * f[3]}; *(LAS f32x4*)(dst + 4) = (f32x4){sg * f[4], sg * f[5], sg * f[6], sg * f[7]};
                }
            }
        }
        if (tid < TCH) ((LAS int*)buf)[TCH * RW_F + tid] = rrow;
    };
    const int vrow = tid >> 4, q = tid & 15;
    float S[4] = {0.f, 0.f, 0.f, 0.f};
    load(0); store(0); __syncthreads();
    for (int c = 0; c < NCHUNK; ++c) {
        if (c + 1 < NCHUNK) load(c + 1);
        LAS float* buf = bufs + (c & 1) * RW_BUF;
        {
            const LAS float* wp = buf + 4 * q;
            const LAS float* vp = buf + 320 + vrow;
            f32x4 w4 = *(const LAS f32x4*)wp, a4 = *(const LAS f32x4*)(wp + 64), b4 = *(const LAS f32x4*)(wp + 128), k4 = *(const LAS f32x4*)(wp + 192), r4 = *(const LAS f32x4*)(wp + 256); float vr = vp[0];
#pragma unroll 1
            for (int jh = 0; jh < 2; ++jh) {
                float ysel = 0.f;
#pragma unroll
                for (int j = 0; j < 16; ++j) {
                    const int jj = jh * 16 + j;
                    const f32x4 wc = w4, ac = a4, bc = b4, kc = k4, rc = r4; const float vv = vr;
                    if (j < 15 || jh == 0) {
                        const LAS float* np = wp + (jj + 1) * RW_F;
                        w4 = *(const LAS f32x4*)np; a4 = *(const LAS f32x4*)(np + 64); b4 = *(const LAS f32x4*)(np + 128); k4 = *(const LAS f32x4*)(np + 192); r4 = *(const LAS f32x4*)(np + 256); vr = vp[(jj + 1) * RW_F];
                    }
                    float sa = S[0] * ac[0] + S[1] * ac[1] + S[2] * ac[2] + S[3] * ac[3];
                    sa = allreduce16(sa);
                    float y = 0.f;
#pragma unroll
                    for (int e = 0; e < 4; ++e) { S[e] = S[e] * wc[e] + (sa * bc[e] + vv * kc[e]); y += S[e] * rc[e]; }
                    y = allreduce16(y);
                    ysel = (q == j) ? y : ysel;
                }
                const int row = ((const LAS int*)buf)[TCH * RW_F + jh * 16 + q];
                Y[(size_t)row * D + 512 + h * 64 + half * 32 + vrow] = f2bf(ysel);
            }
        }
        if (c + 1 < NCHUNK) store(c + 1);
        __syncthreads();
    }
}

constexpr size_t WS_EXBC = WS_RWR;
constexpr size_t WS_EQK = WS_EXBC + (size_t)NROWS * 768 * 2;
constexpr size_t WS_EGT = WS_EQK + (size_t)NROWS * 512 * 2;
static_assert(WS_EGT + (size_t)NROWS * 32 * 4 <= WS_LA, "even-layer prepare buffers must fit in the RWKV region");

__device__ __forceinline__ void phase_prep_even(int wv, KP Pk, int layer) {
    asm volatile("" : "+s"(Pk));
    const CAS Params& P = *Pk;
    const int tid = ltid(wv), lane = tid & 63, wid = tid >> 6, i_ = layer >> 1;
    const bf16_t* Pb = (const bf16_t*)(P.ws + WS_P);
    bf16_t* XBC = (bf16_t*)(P.ws + WS_EXBC); bf16_t* QK = (bf16_t*)(P.ws + WS_EQK); float* GT = (float*)(P.ws + WS_EGT);
    float cw0[4][8], cw1[4][8], cwq[4][8];
#pragma unroll
    for (int e = 0; e < 8; ++e) {
#pragma unroll
        for (int t = 0; t < 3; ++t) {
            cw0[t][e] = P.ssd_conv_w[(size_t)(i_ * 3 + t) * 768 + 8 * lane + e];
            cw1[t][e] = P.ssd_conv_w[(size_t)(i_ * 3 + t) * 768 + 512 + 8 * (lane & 31) + e];
            cwq[t][e] = P.ml_conv_w[(size_t)(i_ * 3 + t) * 512 + 8 * lane + e];
        }
        cw0[3][e] = P.ssd_conv_b[i_ * 768 + 8 * lane + e]; cw1[3][e] = P.ssd_conv_b[i_ * 768 + 512 + 8 * (lane & 31) + e]; cwq[3][e] = P.ml_conv_b[i_ * 512 + 8 * lane + e];
    }
    float gbias = 0.f;
    if (lane < 16) gbias = P.ssd_dt_bias[i_ * 16 + lane]; else if (lane < 24) gbias = P.ml_i_bias[i_ * 8 + lane - 16]; else if (lane < 32) gbias = P.ml_f_bias[i_ * 8 + lane - 24];
    const float qscl = lane < 32 ? 0.125f : 1.f;
    for (int r = blockIdx.x * 8 + wid; r < NROWS; r += gridDim.x * 8) {
        int t, len; row_seg(r, t, len);
        const bf16_t* pr = Pb + (size_t)r * LDP_EVEN;
        const bool hp = t > 0, hn = t < len - 1;
        const u32x4 zero = (u32x4){0u, 0u, 0u, 0u};
        float fc[8], fp[8], fn[8], o[8];
        {
            const int col = 512 + 8 * lane;
            unpack8(*(const u32x4*)(pr + col), fc); unpack8(hp ? *(const u32x4*)(pr - LDP_EVEN + col) : zero, fp); unpack8(hn ? *(const u32x4*)(pr + LDP_EVEN + col) : zero, fn);
#pragma unroll
            for (int e = 0; e < 8; ++e) o[e] = siluf_(cw0[0][e] * fp[e] + cw0[1][e] * fc[e] + cw0[2][e] * fn[e] + cw0[3][e]);
            *(u32x4*)(XBC + (size_t)r * 768 + 8 * lane) = pack8(o);
        }
        if (lane < 32) {
            const int col = 1024 + 8 * lane;
            unpack8(*(const u32x4*)(pr + col), fc); unpack8(hp ? *(const u32x4*)(pr - LDP_EVEN + col) : zero, fp); unpack8(hn ? *(const u32x4*)(pr + LDP_EVEN + col) : zero, fn);
#pragma unroll
            for (int e = 0; e < 8; ++e) o[e] = siluf_(cw1[0][e] * fp[e] + cw1[1][e] * fc[e] + cw1[2][e] * fn[e] + cw1[3][e]);
            *(u32x4*)(XBC + (size_t)r * 768 + 512 + 8 * lane) = pack8(o);
        }
        {
            const int col = 1296 + 8 * lane;
            unpack8(*(const u32x4*)(pr + col), fc); unpack8(hp ? *(const u32x4*)(pr - LDP_EVEN + col) : zero, fp); unpack8(hn ? *(const u32x4*)(pr + LDP_EVEN + col) : zero, fn);
#pragma unroll
            for (int e = 0; e < 8; ++e) o[e] = qscl * siluf_(cwq[0][e] * fp[e] + cwq[1][e] * fc[e] + cwq[2][e] * fn[e] + cwq[3][e]);
            *(u32x4*)(QK + (size_t)r * 512 + 8 * lane) = pack8(o);
        }
        if (lane < 32) {
            const int col = lane < 16 ? 1280 + lane : 2832 + (lane - 16);
            const float x = bf2f(pr[col]) + gbias;
            GT[(size_t)r * 32 + lane] = lane < 16 ? softplusf_(x) : lane < 24 ? x : logsigmoidf_(x);
        }
    }
}

constexpr int CL = 64, NCH64 = NSTEPS / CL, LDT = 72, LDTB = LDT * 2;
__device__ __forceinline__ bf16x8 ldfrag(const LAS char* tile, int ldb, int row0, int k0, int lane) {
    return *(const LAS bf16x8*)(tile + (row0 + (lane & 15)) * ldb + (k0 + 8 * (lane >> 4)) * 2);
}
__device__ __forceinline__ void st4bf(LAS char* p, const f32x4& v) { u32x2 o; o.x = pk2(v[0], v[1]); o.y = pk2(v[2], v[3]); *(LAS u32x2*)p = o; }

constexpr int SS_BT = 0, SS_CT = SS_BT + 64 * LDTB, SS_BDT = SS_CT + 64 * LDTB, SS_XT = SS_BDT + 64 * LDTB, SS_CUM = SS_XT + 32 * LDTB, SS_DTV = SS_CUM + 256, SS_ROWS = SS_DTV + 256, SS_STG = SS_ROWS + 256;
constexpr int SS_M = 2 * SS_STG, SS_HB = SS_M + 64 * LDTB, SS_END = SS_HB + 32 * LDTB;
static_assert(SS_END <= LDS_BYTES - 16, "SSD LDS map");

constexpr int MS_QT = 0, MS_KT = MS_QT + 64 * LDTB, MS_KET = MS_KT + 64 * LDTB, MS_VT = MS_KET + 64 * LDTB, MS_SC = MS_VT + 32 * LDTB;
constexpr int MS_STG = MS_SC + 8 * 256;
constexpr int MS_W = 2 * MS_STG, MS_CB = MS_W + 64 * LDTB, MS_ONE = MS_CB + 32 * LDTB, MS_NV = MS_ONE + 16 * LDTB, MS_QN = MS_NV + 256, MS_END = MS_QN + 256;
static_assert(MS_END <= LDS_BYTES - 16, "mLSTM LDS map");

constexpr size_t WS_XSS = WS_EGT + al256((size_t)NROWS * 32 * 4);
constexpr size_t XSS_BYTES = (size_t)64 * NCH64 * 64 * 64 * 2;
constexpr size_t WS_XSD = WS_XSS + XSS_BYTES;
constexpr size_t WS_XMC = WS_XSD + al256((size_t)64 * NCH64 * 4);
constexpr size_t XMC_BYTES = (size_t)32 * NCH64 * 128 * 64 * 2;
constexpr size_t WS_XMN = WS_XMC + XMC_BYTES;
constexpr size_t WS_XMS = WS_XMN + (size_t)32 * NCH64 * 64 * 4;
constexpr size_t WS_XMT = WS_XMS + al256((size_t)32 * NCH64 * 4 * 4);
constexpr size_t WS_XEND = WS_XMT + (size_t)32 * NCH64 * 3 * 64 * 4;
static_assert(WS_XEND <= WS_END, "even-layer chunk-state buffers must fit in the RWKV region");
constexpr int NSSD_ITEMS = 64 * NCH64, NML_ITEMS = 32 * NCH64;

template <int CTRL, int RM, int BM> __device__ __forceinline__ float dppx(float old, float v) {
    return __builtin_bit_cast(float, __builtin_amdgcn_update_dpp(__builtin_bit_cast(int, old), __builtin_bit_cast(int, v), CTRL, RM, BM, false));
}
__device__ __forceinline__ float wave_cumsum(float v, int) {
    float t = v;
    t += dppx<0x111, 0xf, 0xf>(0.f, v); t += dppx<0x112, 0xf, 0xf>(0.f, v); t += dppx<0x113, 0xf, 0xf>(0.f, v);
    { const float u = dppx<0x114, 0xf, 0xe>(0.f, t); t += u; }
    { const float u = dppx<0x118, 0xf, 0xc>(0.f, t); t += u; }
    { const float u = dppx<0x142, 0xa, 0xf>(0.f, t); t += u; }
    { const float u = dppx<0x143, 0xc, 0xf>(0.f, t); t += u; }
    return t;
}
__device__ __forceinline__ float wave_cummax(float v, int) {
    const float ninf = -__builtin_huge_valf();
    float t = v;
    t = fmaxf(t, dppx<0x111, 0xf, 0xf>(ninf, v)); t = fmaxf(t, dppx<0x112, 0xf, 0xf>(ninf, v)); t = fmaxf(t, dppx<0x113, 0xf, 0xf>(ninf, v));
    { const float u = dppx<0x114, 0xf, 0xe>(ninf, t); t = fmaxf(t, u); }
    { const float u = dppx<0x118, 0xf, 0xc>(ninf, t); t = fmaxf(t, u); }
    { const float u = dppx<0x142, 0xa, 0xf>(ninf, t); t = fmaxf(t, u); }
    { const float u = dppx<0x143, 0xc, 0xf>(ninf, t); t = fmaxf(t, u); }
    return t;
}
__device__ __forceinline__ float wave_max(float v) {
    const float t = wave_cummax(v, 0);
    return __builtin_bit_cast(float, __builtin_amdgcn_readlane(__builtin_bit_cast(int, t), 63));
}

constexpr int X1S_BDT = 0, X1S_XT = X1S_BDT + 64 * LDTB, X1S_CUM = X1S_XT + 64 * LDTB, X1S_DTV = X1S_CUM + 256, X1S_END = X1S_DTV + 256;
constexpr int X1M_KET = 0, X1M_VT = X1M_KET + 64 * LDTB, X1M_ONE = X1M_VT + 128 * LDTB, X1M_EE = X1M_ONE + 16 * LDTB, X1M_END = X1M_EE + 256;
__device__ __forceinline__ void phase_ex1(int wv, KP Pk, int layer, LAS char* lds) {
    asm volatile("" : "+s"(Pk));
    const CAS Params& P = *Pk;
    const int tid = ltid(wv), lane = tid & 63, wid = tid >> 6, q = lane >> 4, r16 = lane & 15, i_ = layer >> 1;
    const bf16_t* XBC = (const bf16_t*)(P.ws + WS_EXBC); const bf16_t* QK = (const bf16_t*)(P.ws + WS_EQK); const bf16_t* Pb = (const bf16_t*)(P.ws + WS_P);
    const float* GT = (const float*)(P.ws + WS_EGT);
    {
        bf16_t* Hst = (bf16_t*)(P.ws + WS_XSS); float* Dst = (float*)(P.ws + WS_XSD);
        u32x4 rc[2]; float rdt = 0.f;
        auto geom = [&](int it, int& b, int& h, int& dir, int& c) { const int sq = it / NCH64; c = it - sq * NCH64; b = sq >> 4; h = (sq >> 1) & 7; dir = sq & 1; };
        auto load = [&](int it) {
            int b, h, dir, c; geom(it, b, h, dir, c);
            int tl = tid; asm volatile("" : "+v"(tl));
#pragma unroll
            for (int s = 0; s < 2; ++s) {
                const int task = tl + NT * s, j = task >> 4, g = task & 15;
                const int row = scan_row(c * CL + j, b, dir, 0);
                rc[s] = *(const u32x4*)(XBC + (size_t)row * 768 + (g < 8 ? h * 64 + 8 * g : 512 + (h >> 2) * 64 + 8 * (g - 8)));
            }
            if (tl < CL) { const int row = scan_row(c * CL + tl, b, dir, 0); rdt = GT[(size_t)row * 32 + dir * 8 + h]; }
        };
        int it = blockIdx.x;
        if (it < NSSD_ITEMS) load(it);
        for (; it < NSSD_ITEMS; it += gridDim.x) {
            int b, h, dir, c; geom(it, b, h, dir, c);
            const float aco = -__expf(P.ssd_a_log[(i_ * 2 + dir) * 8 + h]);
            if (tid < CL) {
                const float cum = wave_cumsum(rdt * aco, lane);
                ((LAS float*)(lds + X1S_CUM))[tid] = cum; ((LAS float*)(lds + X1S_DTV))[tid] = rdt;
            }
            __syncthreads();
            {
                const LAS float* cum = (const LAS float*)(lds + X1S_CUM);
                const float cumL = cum[CL - 1];
                int tl = tid; asm volatile("" : "+v"(tl));
#pragma unroll
                for (int s = 0; s < 2; ++s) {
                    const int task = tl + NT * s, j = task >> 4, g = task & 15;
                    float f[8]; unpack8(rc[s], f);
                    if (g < 8) {
                        const float dt = ((const LAS float*)(lds + X1S_DTV))[j];
#pragma unroll
                        for (int e = 0; e < 8; ++e) *(LAS bf16_t*)(lds + X1S_XT + (8 * g + e) * LDTB + j * 2) = f2bf(f[e] * dt);
                    } else {
                        const float sc = __expf(cumL - cum[j]);
#pragma unroll
                        for (int e = 0; e < 8; ++e) *(LAS bf16_t*)(lds + X1S_BDT + (8 * (g - 8) + e) * LDTB + j * 2) = f2bf(f[e] * sc);
                    }
                }
                if (tid == 0) Dst[it] = __expf(cumL);
            }
            if (it + (int)gridDim.x < NSSD_ITEMS) load(it + gridDim.x);
            __syncthreads();
            {
                const int pt = wid >> 1;
#pragma unroll
                for (int u = 0; u < 2; ++u) {
                    const int nt = (wid & 1) * 2 + u;
                    f32x4 sa = (f32x4){0.f, 0.f, 0.f, 0.f};
#pragma unroll
                    for (int k0 = 0; k0 < 64; k0 += 32) sa = __builtin_amdgcn_mfma_f32_16x16x32_bf16(ldfrag(lds + X1S_BDT, LDTB, nt * 16, k0, lane), ldfrag(lds + X1S_XT, LDTB, pt * 16, k0, lane), sa, 0, 0, 0);
                    u32x2 o; o.x = pk2(sa[0], sa[1]); o.y = pk2(sa[2], sa[3]);
                    *(u32x2*)(Hst + ((size_t)it * 64 + pt * 16 + r16) * 64 + nt * 16 + 4 * q) = o;
                }
            }
            __syncthreads();
        }
    }
    {
        bf16_t* Cst = (bf16_t*)(P.ws + WS_XMC); float* Nst = (float*)(P.ws + WS_XMN); float* Sst = (float*)(P.ws + WS_XMS); float* Tst = (float*)(P.ws + WS_XMT);
        for (int i = tid; i < 16 * LDTB / 4; i += NT) ((LAS unsigned*)(lds + X1M_ONE))[i] = 0x3f803f80u;
        u32x4 rc[3]; float rli = 0.f, rlf = 0.f;
        auto geom = [&](int it, int& b, int& h, int& dir, int& c) { const int sq = it / NCH64; c = it - sq * NCH64; b = sq >> 3; h = (sq >> 1) & 3; dir = sq & 1; };
        auto load = [&](int it) {
            int b, h, dir, c; geom(it, b, h, dir, c);
            int tl = tid; asm volatile("" : "+v"(tl));
#pragma unroll
            for (int s = 0; s < 3; ++s) {
                const int task = tl + NT * s, j = task / 24, g = task - 24 * j;
                const int row = scan_row(c * CL + j, b, dir, 0);
                rc[s] = g < 8 ? *(const u32x4*)(QK + (size_t)row * 512 + 256 + h * 64 + 8 * g) : *(const u32x4*)(Pb + (size_t)row * LDP_EVEN + 1808 + h * 128 + 8 * (g - 8));
            }
            if (tl < CL) { const int row = scan_row(c * CL + tl, b, dir, 0); rli = GT[(size_t)row * 32 + 16 + dir * 4 + h]; rlf = GT[(size_t)row * 32 + 24 + dir * 4 + h]; }
        };
        int it = blockIdx.x;
        if (it < NML_ITEMS) load(it);
        __syncthreads();
        for (; it < NML_ITEMS; it += gridDim.x) {
            if (tid < CL) {
                const float fcum = wave_cumsum(rlf, lane);
                const float ftot = __builtin_bit_cast(float, __builtin_amdgcn_readlane(__builtin_bit_cast(int, fcum), 63));
                const float g = rli - fcum, pm = wave_cummax(g, lane);
                const float wend = ftot + g, mloc = wave_max(wend);
                ((LAS float*)(lds + X1M_EE))[tid] = __expf(wend - mloc);
                float* tp = Tst + (size_t)it * 192;
                tp[tid] = fcum; tp[64 + tid] = g; tp[128 + tid] = pm;
                if (tid == 0) { Sst[(size_t)it * 4 + 0] = ftot; Sst[(size_t)it * 4 + 1] = mloc; }
            }
            __syncthreads();
            {
                const LAS float* ee = (const LAS float*)(lds + X1M_EE);
                int tl = tid; asm volatile("" : "+v"(tl));
#pragma unroll
                for (int s = 0; s < 3; ++s) {
                    const int task = tl + NT * s, j = task / 24, g = task - 24 * j;
                    if (g < 8) {
                        float f[8]; unpack8(rc[s], f);
                        const float e1 = ee[j];
#pragma unroll
                        for (int e = 0; e < 8; ++e) *(LAS bf16_t*)(lds + X1M_KET + (8 * g + e) * LDTB + j * 2) = f2bf(f[e] * e1);
                    } else {
                        const int v0 = 8 * (g - 8);
#pragma unroll
                        for (int e = 0; e < 8; ++e) { const unsigned wv = rc[s][e >> 1]; *(LAS bf16_t*)(lds + X1M_VT + (v0 + e) * LDTB + j * 2) = (bf16_t)((e & 1) ? (wv >> 16) : (wv & 0xffffu)); }
                    }
                }
            }
            if (it + (int)gridDim.x < NML_ITEMS) load(it + gridDim.x);
            __syncthreads();
            {
                const bf16x8 vf0 = ldfrag(lds + X1M_VT, LDTB, wid * 16, 0, lane), vf1 = ldfrag(lds + X1M_VT, LDTB, wid * 16, 32, lane);
#pragma unroll
                for (int kt = 0; kt < 4; ++kt) {
                    f32x4 sa = __builtin_amdgcn_mfma_f32_16x16x32_bf16(ldfrag(lds + X1M_KET, LDTB, kt * 16, 0, lane), vf0, (f32x4){0.f, 0.f, 0.f, 0.f}, 0, 0, 0);
                    sa = __builtin_amdgcn_mfma_f32_16x16x32_bf16(ldfrag(lds + X1M_KET, LDTB, kt * 16, 32, lane), vf1, sa, 0, 0, 0);
                    u32x2 o; o.x = pk2(sa[0], sa[1]); o.y = pk2(sa[2], sa[3]);
                    *(u32x2*)(Cst + ((size_t)it * 128 + wid * 16 + r16) * 64 + kt * 16 + 4 * q) = o;
                }
                if (wid < 4) {
                    f32x4 na = __builtin_amdgcn_mfma_f32_16x16x32_bf16(ldfrag(lds + X1M_KET, LDTB, wid * 16, 0, lane), ldfrag(lds + X1M_ONE, LDTB, 0, 0, lane), (f32x4){0.f, 0.f, 0.f, 0.f}, 0, 0, 0);
                    na = __builtin_amdgcn_mfma_f32_16x16x32_bf16(ldfrag(lds + X1M_KET, LDTB, wid * 16, 32, lane), ldfrag(lds + X1M_ONE, LDTB, 0, 32, lane), na, 0, 0, 0);
                    if (r16 == 0) *(f32x4*)(Nst + (size_t)it * 64 + wid * 16 + 4 * q) = na;
                }
            }
            __syncthreads();
        }
    }
}

__device__ __forceinline__ void phase_ex2(int wv, KP Pk, int layer) {
    asm volatile("" : "+s"(Pk));
    const CAS Params& P = *Pk;
    const int tid = ltid(wv);
    (void)layer;
    if (blockIdx.x < 128) {
        const int gt = blockIdx.x * NT + tid, sq = gt >> 10, rem = gt & 1023;
        bf16_t* Hst = (bf16_t*)(P.ws + WS_XSS) + (size_t)sq * NCH64 * 4096 + rem * 4;
        const float* Dst = (const float*)(P.ws + WS_XSD) + sq * NCH64;
        float h0 = 0.f, h1 = 0.f, h2 = 0.f, h3 = 0.f;
#pragma unroll 4
        for (int c = 0; c < NCH64; ++c) {
            const u32x2 loc = *(const u32x2*)(Hst + (size_t)c * 4096);
            const float d = Dst[c];
            u32x2 o; o.x = pk2(h0, h1); o.y = pk2(h2, h3);
            *(u32x2*)(Hst + (size_t)c * 4096) = o;
            h0 = d * h0 + bflo(loc.x); h1 = d * h1 + bfhi(loc.x); h2 = d * h2 + bflo(loc.y); h3 = d * h3 + bfhi(loc.y);
        }
    } else if (blockIdx.x < 256) {
        const int gt = (blockIdx.x - 128) * NT + tid, sq = gt >> 11, rem = gt & 2047;
        bf16_t* Cst = (bf16_t*)(P.ws + WS_XMC) + (size_t)sq * NCH64 * 8192 + rem * 4;
        float* Nst = (float*)(P.ws + WS_XMN) + (size_t)sq * NCH64 * 64 + (rem & 15) * 4;
        float* Sst = (float*)(P.ws + WS_XMS) + (size_t)sq * NCH64 * 4;
        const bool own_n = rem < 16, own_m = rem == 0;
        float c0 = 0.f, c1 = 0.f, c2 = 0.f, c3 = 0.f, m = -1e30f;
        f32x4 nn = (f32x4){0.f, 0.f, 0.f, 0.f};
#pragma unroll 2
        for (int c = 0; c < NCH64; ++c) {
            const u32x2 loc = *(const u32x2*)(Cst + (size_t)c * 8192);
            const float ftot = Sst[c * 4 + 0], mloc = Sst[c * 4 + 1];
            const float mnew = fmaxf(ftot + m, mloc), sp = __expf(ftot + m - mnew), sl = __expf(mloc - mnew);
            u32x2 o; o.x = pk2(c0, c1); o.y = pk2(c2, c3);
            *(u32x2*)(Cst + (size_t)c * 8192) = o;
            c0 = sp * c0 + sl * bflo(loc.x); c1 = sp * c1 + sl * bfhi(loc.x); c2 = sp * c2 + sl * bflo(loc.y); c3 = sp * c3 + sl * bfhi(loc.y);
            if (own_n) { const f32x4 nl = *(const f32x4*)(Nst + (size_t)c * 64); *(f32x4*)(Nst + (size_t)c * 64) = nn; nn = nn * sp + nl * sl; }
            if (own_m) Sst[c * 4 + 2] = m;
            m = mnew;
        }
    }
}

constexpr int X3S_BT = 0, X3S_CT = X3S_BT + 64 * LDTB, X3S_XT = X3S_CT + 64 * LDTB, X3S_HB = X3S_XT + 64 * LDTB, X3S_M = X3S_HB + 64 * LDTB, X3S_CUM = X3S_M + 64 * LDTB, X3S_DTV = X3S_CUM + 256, X3S_ROWS = X3S_DTV + 256, X3S_END = X3S_ROWS + 256;
constexpr int X3M_QT = 0, X3M_KT = X3M_QT + 64 * LDTB, X3M_VT = X3M_KT + 64 * LDTB, X3M_CB = X3M_VT + 128 * LDTB, X3M_W = X3M_CB + 128 * LDTB, X3M_ONE = X3M_W + 64 * LDTB, X3M_NB = X3M_ONE + 16 * LDTB,
              X3M_SC = X3M_NB + 16 * LDTB, X3M_END = X3M_SC + 6 * 256;
static_assert(X3M_END <= LDS_BYTES - 16 && X3S_END <= LDS_BYTES - 16, "EX3 LDS maps");
__device__ __forceinline__ void phase_ex3(int wv, KP Pk, int layer, LAS char* lds) {
    asm volatile("" : "+s"(Pk));
    const CAS Params& P = *Pk;
    const int tid = ltid(wv), lane = tid & 63, wid = tid >> 6, q = lane >> 4, r16 = lane & 15, i_ = layer >> 1;
    const bf16_t* XBC = (const bf16_t*)(P.ws + WS_EXBC); const bf16_t* QK = (const bf16_t*)(P.ws + WS_EQK); const bf16_t* Pb = (const bf16_t*)(P.ws + WS_P);
    const float* GT = (const float*)(P.ws + WS_EGT);
    {
        const bf16_t* Hst = (const bf16_t*)(P.ws + WS_XSS);
        u32x4 rc[3], rh; float rdt = 0.f; int rrow = 0;
        auto geom = [&](int it, int& b, int& h, int& dir, int& c) { const int sq = it / NCH64; c = it - sq * NCH64; b = sq >> 4; h = (sq >> 1) & 7; dir = sq & 1; };
        auto load = [&](int it) {
            int b, h, dir, c; geom(it, b, h, dir, c);
            int tl = tid; asm volatile("" : "+v"(tl));
#pragma unroll
            for (int s = 0; s < 3; ++s) {
                const int task = tl + NT * s, j = task / 24, g = task - 24 * j;
                const int row = scan_row(c * CL + j, b, dir, 0);
                rc[s] = *(const u32x4*)(XBC + (size_t)row * 768 + (g < 8 ? h * 64 + 8 * g : g < 16 ? 512 + (h >> 2) * 64 + 8 * (g - 8) : 640 + (h >> 2) * 64 + 8 * (g - 16)));
            }
            rh = *(const u32x4*)(Hst + (size_t)it * 4096 + tl * 8);
            if (tl < CL) { rrow = scan_row(c * CL + tl, b, dir, 0); rdt = GT[(size_t)rrow * 32 + dir * 8 + h]; }
        };
        int it = blockIdx.x;
        if (it < NSSD_ITEMS) load(it);
        __syncthreads();
        for (; it < NSSD_ITEMS; it += gridDim.x) {
            int b, h, dir, c; geom(it, b, h, dir, c);
            bf16_t* Y = (bf16_t*)(P.ws + (dir ? WS_YB : WS_YF));
            const float aco = -__expf(P.ssd_a_log[(i_ * 2 + dir) * 8 + h]);
            if (tid < CL) {
                const float cum = wave_cumsum(rdt * aco, lane);
                ((LAS float*)(lds + X3S_CUM))[tid] = cum; ((LAS float*)(lds + X3S_DTV))[tid] = rdt; ((LAS int*)(lds + X3S_ROWS))[tid] = rrow;
            }
            __syncthreads();
            {
                int tl = tid; asm volatile("" : "+v"(tl));
#pragma unroll
                for (int s = 0; s < 3; ++s) {
                    const int task = tl + NT * s, j = task / 24, g = task - 24 * j;
                    if (g < 8) {
                        float f[8]; unpack8(rc[s], f);
                        const float dt = ((const LAS float*)(lds + X3S_DTV))[j];
#pragma unroll
                        for (int e = 0; e < 8; ++e) *(LAS bf16_t*)(lds + X3S_XT + (8 * g + e) * LDTB + j * 2) = f2bf(f[e] * dt);
                    } else if (g < 16) *(LAS u32x4*)(lds + X3S_BT + j * LDTB + 8 * (g - 8) * 2) = rc[s];
                    else *(LAS u32x4*)(lds + X3S_CT + j * LDTB + 8 * (g - 16) * 2) = rc[s];
                }
                *(LAS u32x4*)(lds + X3S_HB + (tl >> 3) * LDTB + (tl & 7) * 16) = rh;
            }
            if (it + (int)gridDim.x < NSSD_ITEMS) load(it + gridDim.x);
            __syncthreads();
            const LAS float* cum = (const LAS float*)(lds + X3S_CUM);
            {
                const int lt = wid >> 1;
#pragma unroll
                for (int u = 0; u < 2; ++u) {
                    const int st = (wid & 1) * 2 + u;
                    f32x4 acc = (f32x4){0.f, 0.f, 0.f, 0.f};
                    if (st <= lt) {
#pragma unroll
                        for (int k0 = 0; k0 < 64; k0 += 32) acc = __builtin_amdgcn_mfma_f32_16x16x32_bf16(ldfrag(lds + X3S_BT, LDTB, st * 16, k0, lane), ldfrag(lds + X3S_CT, LDTB, lt * 16, k0, lane), acc, 0, 0, 0);
                        const int l = lt * 16 + r16, s0 = st * 16 + 4 * q;
                        const float cl = cum[l]; const f32x4 cs = *(const LAS f32x4*)(cum + s0);
#pragma unroll
                        for (int j = 0; j < 4; ++j) acc[j] = (s0 + j <= l) ? acc[j] * __expf(cl - cs[j]) : 0.f;
                    }
                    st4bf(lds + X3S_M + (lt * 16 + r16) * LDTB + (st * 16 + 4 * q) * 2, acc);
                }
            }
            __syncthreads();
            {
                const int lt = wid >> 1, l = lt * 16 + r16;
                const float el = __expf(cum[l]);
                const int row = ((const LAS int*)(lds + X3S_ROWS))[l];
                const bf16x8 mf0 = ldfrag(lds + X3S_M, LDTB, lt * 16, 0, lane), mf1 = ldfrag(lds + X3S_M, LDTB, lt * 16, 32, lane);
                const bf16x8 cf0 = ldfrag(lds + X3S_CT, LDTB, lt * 16, 0, lane), cf1 = ldfrag(lds + X3S_CT, LDTB, lt * 16, 32, lane);
#pragma unroll
                for (int u = 0; u < 2; ++u) {
                    const int pt = (wid & 1) * 2 + u;
                    f32x4 ya = __builtin_amdgcn_mfma_f32_16x16x32_bf16(ldfrag(lds + X3S_XT, LDTB, pt * 16, 0, lane), mf0, (f32x4){0.f, 0.f, 0.f, 0.f}, 0, 0, 0);
                    ya = __builtin_amdgcn_mfma_f32_16x16x32_bf16(ldfrag(lds + X3S_XT, LDTB, pt * 16, 32, lane), mf1, ya, 0, 0, 0);
                    f32x4 oa = __builtin_amdgcn_mfma_f32_16x16x32_bf16(ldfrag(lds + X3S_HB, LDTB, pt * 16, 0, lane), cf0, (f32x4){0.f, 0.f, 0.f, 0.f}, 0, 0, 0);
                    oa = __builtin_amdgcn_mfma_f32_16x16x32_bf16(ldfrag(lds + X3S_HB, LDTB, pt * 16, 32, lane), cf1, oa, 0, 0, 0);
                    u32x2 o; o.x = pk2(ya[0] + el * oa[0], ya[1] + el * oa[1]); o.y = pk2(ya[2] + el * oa[2], ya[3] + el * oa[3]);
                    *(u32x2*)(Y + (size_t)row * D + h * 64 + pt * 16 + 4 * q) = o;
                }
            }
            __syncthreads();
        }
    }
    {
        const bf16_t* Cst = (const bf16_t*)(P.ws + WS_XMC); const float* Nst = (const float*)(P.ws + WS_XMN); const float* Sst = (const float*)(P.ws + WS_XMS); const float* Tst = (const float*)(P.ws + WS_XMT);
        for (int i = tid; i < 16 * LDTB / 4; i += NT) ((LAS unsigned*)(lds + X3M_ONE))[i] = 0x3f803f80u;
        u32x4 rc[4], rcb[2]; float rfc = 0.f, rg = 0.f, rpm = 0.f, rmp = 0.f, rn = 0.f; int rrow = 0;
        auto geom = [&](int it, int& b, int& h, int& dir, int& c) { const int sq = it / NCH64; c = it - sq * NCH64; b = sq >> 3; h = (sq >> 1) & 3; dir = sq & 1; };
        auto load = [&](int it) {
            int b, h, dir, c; geom(it, b, h, dir, c);
            int tl = tid; asm volatile("" : "+v"(tl));
#pragma unroll
            for (int s = 0; s < 4; ++s) {
                const int task = tl + NT * s, j = task >> 5, g = task & 31;
                const int row = scan_row(c * CL + j, b, dir, 0);
                rc[s] = g < 16 ? *(const u32x4*)(QK + (size_t)row * 512 + (g < 8 ? h * 64 + 8 * g : 256 + h * 64 + 8 * (g - 8))) : *(const u32x4*)(Pb + (size_t)row * LDP_EVEN + 1808 + h * 128 + 8 * (g - 16));
            }
#pragma unroll
            for (int s = 0; s < 2; ++s) rcb[s] = *(const u32x4*)(Cst + (size_t)it * 8192 + (tl + NT * s) * 8);
            if (tl < CL) {
                rrow = scan_row(c * CL + tl, b, dir, 0);
                const float* tp = Tst + (size_t)it * 192;
                rfc = tp[tl]; rg = tp[64 + tl]; rpm = tp[128 + tl]; rmp = Sst[(size_t)it * 4 + 2]; rn = Nst[(size_t)it * 64 + tl];
            }
        };
        int it = blockIdx.x;
        if (it < NML_ITEMS) load(it);
        __syncthreads();
        for (; it < NML_ITEMS; it += gridDim.x) {
            int b, h, dir, c; geom(it, b, h, dir, c);
            bf16_t* Y = (bf16_t*)(P.ws + (dir ? WS_YB : WS_YF));
            LAS float* sc = (LAS float*)(lds + X3M_SC);
            {
                int tl = tid; asm volatile("" : "+v"(tl));
#pragma unroll
                for (int s = 0; s < 4; ++s) {
                    const int task = tl + NT * s, j = task >> 5, g = task & 31;
                    if (g < 8) *(LAS u32x4*)(lds + X3M_QT + j * LDTB + 8 * g * 2) = rc[s];
                    else if (g < 16) *(LAS u32x4*)(lds + X3M_KT + j * LDTB + 8 * (g - 8) * 2) = rc[s];
                    else {
                        const int v0 = 8 * (g - 16);
#pragma unroll
                        for (int e = 0; e < 8; ++e) { const unsigned wv = rc[s][e >> 1]; *(LAS bf16_t*)(lds + X3M_VT + (v0 + e) * LDTB + j * 2) = (bf16_t)((e & 1) ? (wv >> 16) : (wv & 0xffffu)); }
                    }
                }
#pragma unroll
                for (int s = 0; s < 2; ++s) { const int ch = tl + NT * s; *(LAS u32x4*)(lds + X3M_CB + (ch >> 3) * LDTB + (ch & 7) * 16) = rcb[s]; }
                if (tl < CL) {
                    const float linter = rfc + rmp, mrow = fmaxf(rfc + rpm, linter);
                    sc[tl] = rfc - mrow; sc[64 + tl] = rg; sc[128 + tl] = __expf(linter - mrow); sc[192 + tl] = __expf(-mrow); ((LAS int*)sc)[256 + tl] = rrow;
                    const bf16_t nb = f2bf(rn);
#pragma unroll
                    for (int r = 0; r < 16; ++r) *(LAS bf16_t*)(lds + X3M_NB + r * LDTB + tl * 2) = nb;
                }
            }
            if (it + (int)gridDim.x < NML_ITEMS) load(it + gridDim.x);
            __syncthreads();
            {
                const int lt = wid >> 1;
#pragma unroll
                for (int u = 0; u < 2; ++u) {
                    const int st = (wid & 1) * 2 + u;
                    f32x4 acc = (f32x4){0.f, 0.f, 0.f, 0.f};
                    if (st <= lt) {
#pragma unroll
                        for (int k0 = 0; k0 < 64; k0 += 32) acc = __builtin_amdgcn_mfma_f32_16x16x32_bf16(ldfrag(lds + X3M_KT, LDTB, st * 16, k0, lane), ldfrag(lds + X3M_QT, LDTB, lt * 16, k0, lane), acc, 0, 0, 0);
                        const int l = lt * 16 + r16, s0 = st * 16 + 4 * q;
                        const float rt = sc[l]; const f32x4 gs = *(const LAS f32x4*)(sc + 64 + s0);
#pragma unroll
                        for (int j = 0; j < 4; ++j) acc[j] = (s0 + j <= l) ? acc[j] * __expf(rt + gs[j]) : 0.f;
                    }
                    st4bf(lds + X3M_W + (lt * 16 + r16) * LDTB + (st * 16 + 4 * q) * 2, acc);
                }
            }
            __syncthreads();
            {
                const int lt = wid >> 1, l = lt * 16 + r16;
                const bf16x8 wf0 = ldfrag(lds + X3M_W, LDTB, lt * 16, 0, lane), wf1 = ldfrag(lds + X3M_W, LDTB, lt * 16, 32, lane);
                const bf16x8 qf0 = ldfrag(lds + X3M_QT, LDTB, lt * 16, 0, lane), qf1 = ldfrag(lds + X3M_QT, LDTB, lt * 16, 32, lane);
                f32x4 da = __builtin_amdgcn_mfma_f32_16x16x32_bf16(ldfrag(lds + X3M_ONE, LDTB, 0, 0, lane), wf0, (f32x4){0.f, 0.f, 0.f, 0.f}, 0, 0, 0);
                da = __builtin_amdgcn_mfma_f32_16x16x32_bf16(ldfrag(lds + X3M_ONE, LDTB, 0, 32, lane), wf1, da, 0, 0, 0);
                f32x4 qn = __builtin_amdgcn_mfma_f32_16x16x32_bf16(ldfrag(lds + X3M_NB, LDTB, 0, 0, lane), qf0, (f32x4){0.f, 0.f, 0.f, 0.f}, 0, 0, 0);
                qn = __builtin_amdgcn_mfma_f32_16x16x32_bf16(ldfrag(lds + X3M_NB, LDTB, 0, 32, lane), qf1, qn, 0, 0, 0);
                const float inter = sc[128 + l], emr = sc[192 + l];
                const float inv = __builtin_amdgcn_rcpf(fmaxf(fabsf(da[0] + inter * qn[0]), emr));
                const int row = ((const LAS int*)sc)[256 + l];
#pragma unroll
                for (int u = 0; u < 4; ++u) {
                    const int vt = (wid & 1) * 4 + u;
                    f32x4 na = __builtin_amdgcn_mfma_f32_16x16x32_bf16(ldfrag(lds + X3M_VT, LDTB, vt * 16, 0, lane), wf0, (f32x4){0.f, 0.f, 0.f, 0.f}, 0, 0, 0);
                    na = __builtin_amdgcn_mfma_f32_16x16x32_bf16(ldfrag(lds + X3M_VT, LDTB, vt * 16, 32, lane), wf1, na, 0, 0, 0);
                    f32x4 ca = __builtin_amdgcn_mfma_f32_16x16x32_bf16(ldfrag(lds + X3M_CB, LDTB, vt * 16, 0, lane), qf0, (f32x4){0.f, 0.f, 0.f, 0.f}, 0, 0, 0);
                    ca = __builtin_amdgcn_mfma_f32_16x16x32_bf16(ldfrag(lds + X3M_CB, LDTB, vt * 16, 32, lane), qf1, ca, 0, 0, 0);
                    u32x2 o; o.x = pk2((na[0] + inter * ca[0]) * inv, (na[1] + inter * ca[1]) * inv); o.y = pk2((na[2] + inter * ca[2]) * inv, (na[3] + inter * ca[3]) * inv);
                    *(u32x2*)(Y + (size_t)row * D + 512 + h * 128 + vt * 16 + 4 * q) = o;
                }
            }
            __syncthreads();
        }
    }
}

constexpr int HC_RAWF = 0;
constexpr int HC_RAWQ = HC_RAWF + 64 * 128 * 4;
constexpr int HC_SUB = HC_RAWQ + 64 * 128 * 2;
constexpr int HL_QD = 136 * 2;
constexpr int HL_T = 24 * 2;
constexpr int HS_QI = 0, HS_KO = HS_QI + 16 * HL_QD, HS_KET = HS_KO + 16 * HL_QD, HS_ATT = HS_KET + 128 * HL_T, HS_VT = HS_ATT + 16 * HL_T, HS_DEC = HS_VT + 32 * HL_T, HS_SIZE = HS_DEC + 512;
constexpr int HC_SB = HC_SUB + 4 * HS_SIZE;
constexpr int HC_ROWS = HC_SB + 2 * 32 * HL_QD, HC_CST = HC_ROWS + 256, HC_END = HC_CST + 1024;
static_assert(HC_END <= LDS_BYTES - 16, "HGRN2 LDS map");
static_assert(HS_SIZE % 16 == 0 && HC_SB % 16 == 0, "alignment");
__device__ __forceinline__ bf16x8 ldfrag16(const LAS char* tile, int ldb, int row0, int lane) {
    bf16x8 v = *(const LAS bf16x8*)(tile + (row0 + (lane & 15)) * ldb + ((lane >> 4) & 1) * 16);
    if (lane >= 32) v = (bf16x8){0, 0, 0, 0, 0, 0, 0, 0};
    return v;
}
__device__ __forceinline__ void scan_hgrn_c(int wv, KP Pk, int layer, int unit, LAS char* lds) {
    asm volatile("" : "+s"(Pk));
    const CAS Params& P = *Pk;
    const int tid = ltid(wv), lane = tid & 63, wid = tid >> 6, q = lane >> 4, r16 = lane & 15, i_ = layer >> 1;
    const int seq = unit >> 2, quarter = unit & 3, b = seq >> 3, h = (seq >> 1) & 3, dir = seq & 1;
    const bf16_t* Pb = (const bf16_t*)(P.ws + WS_P);
    bf16_t* Y = (bf16_t*)(P.ws + (dir ? WS_YB : WS_YF));
    LAS float* cst = (LAS float*)(lds + HC_CST);
    if (tid < 128) cst[tid] = ((const float*)(P.ws + WS_LB))[layer * 512 + h * 128 + tid];
    else if (tid < 256) cst[tid] = P.hg_f_bias[(size_t)(i_ * 2 + dir) * 512 + h * 128 + tid - 128];
    for (int i = tid; i < 2 * 32 * HL_QD / 4; i += NT) ((LAS unsigned*)(lds + HC_SB))[i] = 0u;
    int tj[5], tg_[5], tcol[5]; bool tv[5];
#pragma unroll
    for (int s = 0; s < 5; ++s) {
        const int task = tid + NT * s; tv[s] = task < 64 * 36; tj[s] = task / 36; tg_[s] = task % 36;
        const int g = tg_[s];
        tcol[s] = g < 16 ? (512 + dir * 512 + h * 128 + 8 * g) : g < 32 ? (h * 128 + 8 * (g - 16)) : (1536 + h * 128 + quarter * 32 + 8 * (g - 32));
    }
    u32x4 rc[5]; int rrow = 0;
    auto load = [&](int c) {
#pragma unroll
        for (int s = 0; s < 5; ++s) {
            rc[s] = (u32x4){0u, 0u, 0u, 0u};
            if (tv[s]) { const int row = scan_row(c * 64 + tj[s], b, dir, 1); rc[s] = *(const u32x4*)(Pb + (size_t)row * LDP_ODD + tcol[s]); }
        }
        if (tid < 64) rrow = scan_row(c * 64 + tid, b, dir, 1);
    };
    auto storeA = [&]() {
#pragma unroll
        for (int s = 0; s < 5; ++s) {
            if (tv[s]) {
                float f[8]; unpack8(rc[s], f);
                const int j = tj[s], g = tg_[s];
                if (g < 16) {
                    float o[8];
#pragma unroll
                    for (int e = 0; e < 8; ++e) { const float lbv = cst[8 * g + e]; o[e] = lbv + (1.f - lbv) * sigmoidf_(f[e] + cst[128 + 8 * g + e]); }
                    LAS float* dst = (LAS float*)(lds + HC_RAWF) + j * 128 + 8 * g;
                    *(LAS f32x4*)dst = (f32x4){o[0], o[1], o[2], o[3]}; *(LAS f32x4*)(dst + 4) = (f32x4){o[4], o[5], o[6], o[7]};
                } else if (g < 32) {
                    float o[8];
#pragma unroll
                    for (int e = 0; e < 8; ++e) o[e] = siluf_(f[e]);
                    *(LAS u32x4*)(lds + HC_RAWQ + (j * 128 + 8 * (g - 16)) * 2) = pack8(o);
                } else {
                    const int v0 = 8 * (g - 32);
                    LAS char* vt = lds + HC_SUB + (j >> 4) * HS_SIZE + HS_VT;
#pragma unroll
                    for (int e = 0; e < 8; ++e) { const unsigned wv = rc[s][e >> 1]; *(LAS bf16_t*)(vt + (v0 + e) * HL_T + (j & 15) * 2) = (bf16_t)((e & 1) ? (wv >> 16) : (wv & 0xffffu)); }
                }
            }
        }
        if (tid < 64) ((LAS int*)(lds + HC_ROWS))[tid] = rrow;
    };
    auto storeB = [&]() {
        const int d = tid & 127, sb = tid >> 7;
        LAS char* st = lds + HC_SUB + sb * HS_SIZE;
        const LAS float* rf = (const LAS float*)(lds + HC_RAWF) + (sb * 16) * 128 + d;
        const LAS bf16_t* rq = (const LAS bf16_t*)(lds + HC_RAWQ) + (sb * 16) * 128 + d;
        float lam = 0.f, lams[16], kfs[16];
#pragma unroll
        for (int t = 0; t < 16; ++t) {
            const float f = rf[t * 128];
            lam += __logf(f);
            const float kf = 1.f - f;
            lams[t] = lam; kfs[t] = kf;
            *(LAS bf16_t*)(st + HS_QI + t * HL_QD + d * 2) = f2bf(bf2f(rq[t * 128]) * __expf(lam));
            *(LAS bf16_t*)(st + HS_KO + t * HL_QD + d * 2) = f2bf(kf * __expf(-lam));
        }
        float ke[16];
#pragma unroll
        for (int t = 0; t < 16; ++t) ke[t] = kfs[t] * __expf(lam - lams[t]);
        *(LAS u32x4*)(st + HS_KET + d * HL_T) = pack8(ke); *(LAS u32x4*)(st + HS_KET + d * HL_T + 16) = pack8(ke + 8);
        ((LAS float*)(st + HS_DEC))[d] = __expf(lam);
    };
    f32x4 sacc[2];
    sacc[0] = sacc[1] = (f32x4){0.f, 0.f, 0.f, 0.f};
    __syncthreads();
    load(0);
    for (int c = 0; c < NSTEPS / 64; ++c) {
        storeA();
        __syncthreads();
        storeB();
        if (c + 1 < NSTEPS / 64) load(c + 1);
        __syncthreads();
        if (wid < 4) {
            LAS char* st = lds + HC_SUB + wid * HS_SIZE;
            f32x4 acc = (f32x4){0.f, 0.f, 0.f, 0.f};
#pragma unroll
            for (int k0 = 0; k0 < 128; k0 += 32) acc = __builtin_amdgcn_mfma_f32_16x16x32_bf16(ldfrag(st + HS_KO, HL_QD, 0, k0, lane), ldfrag(st + HS_QI, HL_QD, 0, k0, lane), acc, 0, 0, 0);
#pragma unroll
            for (int j = 0; j < 4; ++j) acc[j] = (4 * q + j <= r16) ? acc[j] : 0.f;
            st4bf(st + HS_ATT + r16 * HL_T + 4 * q * 2, acc);
        }
        __syncthreads();
#pragma unroll 1
        for (int sb = 0; sb < 4; ++sb) {
            LAS char* st = lds + HC_SUB + sb * HS_SIZE;
            const LAS char* sbr = lds + HC_SB + (sb & 1) * 32 * HL_QD;
            LAS char* sbw = lds + HC_SB + ((sb + 1) & 1) * 32 * HL_QD;
            if (wid < 2) {
                f32x4 ya = __builtin_amdgcn_mfma_f32_16x16x32_bf16(ldfrag16(st + HS_VT, HL_T, wid * 16, lane), ldfrag16(st + HS_ATT, HL_T, 0, lane), (f32x4){0.f, 0.f, 0.f, 0.f}, 0, 0, 0);
#pragma unroll
                for (int k0 = 0; k0 < 128; k0 += 32) ya = __builtin_amdgcn_mfma_f32_16x16x32_bf16(ldfrag(sbr, HL_QD, wid * 16, k0, lane), ldfrag(st + HS_QI, HL_QD, 0, k0, lane), ya, 0, 0, 0);
                const int row = ((const LAS int*)(lds + HC_ROWS))[sb * 16 + r16];
                u32x2 o; o.x = pk2(ya[0], ya[1]); o.y = pk2(ya[2], ya[3]);
                *(u32x2*)(Y + (size_t)row * D + h * 128 + quarter * 32 + wid * 16 + 4 * q) = o;
            }
            {
                const int vt = wid >> 2;
                const bf16x8 vf = ldfrag16(st + HS_VT, HL_T, vt * 16, lane);
#pragma unroll
                for (int u = 0; u < 2; ++u) {
                    const int dt = (wid & 3) * 2 + u;
                    const f32x4 a = __builtin_amdgcn_mfma_f32_16x16x32_bf16(ldfrag16(st + HS_KET, HL_T, dt * 16, lane), vf, (f32x4){0.f, 0.f, 0.f, 0.f}, 0, 0, 0);
                    const f32x4 dc = *(const LAS f32x4*)((const LAS float*)(st + HS_DEC) + dt * 16 + 4 * q);
#pragma unroll
                    for (int j = 0; j < 4; ++j) sacc[u][j] = sacc[u][j] * dc[j] + a[j];
                    st4bf(sbw + (vt * 16 + r16) * HL_QD + (dt * 16 + 4 * q) * 2, sacc[u]);
                }
            }
            __syncthreads();
        }
    }
}

constexpr int RC_RAWW = 0;
constexpr int RC_RAWA = RC_RAWW + 64 * 64 * 4;
constexpr int RC_RAWB = RC_RAWA + 64 * 64 * 2, RC_RAWK = RC_RAWB + 64 * 64 * 2, RC_RAWR = RC_RAWK + 64 * 64 * 2;
constexpr int RC_SUB = RC_RAWR + 64 * 64 * 2;
constexpr int RL_C = 72 * 2, RL_32 = 40 * 2, RL_16 = 24 * 2;
constexpr int RS_AT = 0, RS_RT = RS_AT + 16 * RL_C, RS_KT = RS_RT + 16 * RL_C, RS_BT = RS_KT + 16 * RL_C, RS_KBH = RS_BT + 16 * RL_C, RS_AAK = RS_KBH + 64 * RL_32,
              RS_ARKB = RS_AAK + 16 * RL_16, RS_T = RS_ARKB + 16 * RL_32, RS_AABF = RS_T + 16 * RL_16, RS_GL = RS_AABF + 16 * 16 * 4, RS_VU = RS_GL + 256, RS_SIZE = RS_VU + 32 * RL_32;
constexpr int RC_SB = RC_SUB + 4 * RS_SIZE;
constexpr int RC_RHT = RC_SB + 32 * RL_C;
constexpr int RC_ROWS = RC_RHT + 32 * RL_16, RC_END = RC_ROWS + 256;
static_assert(RC_END <= LDS_BYTES - 16, "RWKV LDS map");
static_assert(RS_SIZE % 16 == 0 && RC_SB % 16 == 0 && RC_RHT % 16 == 0, "alignment");

__device__ __forceinline__ float allreduce8(float v) {
    v += dppmov<0xB1>(v); v += dppmov<0x4E>(v); v += dppmov<0x141>(v);
    return v;
}

__device__ __forceinline__ void phase_prep1(int wv, KP Pk, int layer) {
    asm volatile("" : "+s"(Pk));
    const CAS Params& P = *Pk;
    const int tid = ltid(wv), lane = tid & 63, wid = tid >> 6, i_ = layer >> 1;
    const bf16_t* Pb = (const bf16_t*)(P.ws + WS_P);
    bf16_t* R = (bf16_t*)(P.ws + WS_RWR); bf16_t* K = (bf16_t*)(P.ws + WS_RWK); bf16_t* V = (bf16_t*)(P.ws + WS_RWV); bf16_t* KK = (bf16_t*)(P.ws + WS_RWKK);
    bf16_t* LA = (bf16_t*)(P.ws + WS_LA);
    const float* mu = P.rw_mu + (size_t)i_ * 1856;
    float mur[8], muv[8], muk[8], mul_[8], kkw[8];
#pragma unroll
    for (int e = 0; e < 8; ++e) { mur[e] = mu[8 * lane + e]; muv[e] = mu[1024 + 8 * lane + e]; muk[e] = mu[512 + 8 * lane + e]; mul_[e] = lane < 40 ? mu[1536 + 8 * lane + e] : 0.f; kkw[e] = P.rw_k_k[i_ * 512 + 8 * lane + e]; }
    for (int r = blockIdx.x * 8 + wid; r < NROWS; r += gridDim.x * 8) {
        int rprev = -1, rnext = -1;
        if (r < NCTX) { const int t = r & 255; if (t > 0) rprev = r - 1; if (t < CTXL - 1) rnext = r + 1; }
        else {
            const int bs = (r - NCTX) >> 13, s = (r - NCTX) & 8191, sg = ((s & 63) << 7) + (s >> 6);
            if (sg > 0) { const int g2 = sg - 1; rprev = NCTX + bs * SEQ + ((g2 & 127) << 6) + (g2 >> 7); }
            if (sg < SEQ - 1) { const int g2 = sg + 1; rnext = NCTX + bs * SEQ + ((g2 & 127) << 6) + (g2 >> 7); }
        }
        const bf16_t* pc = Pb + (size_t)r * LDP_ODD + 2560;
        const bf16_t* pp = Pb + (size_t)(rprev < 0 ? r : rprev) * LDP_ODD + 2560;
        const bf16_t* pn = Pb + (size_t)(rnext < 0 ? r : rnext) * LDP_ODD + 2560;
        const float mp = rprev < 0 ? 0.f : 0.5f, mn = rnext < 0 ? 0.f : 0.5f;
        auto mix8 = [&](int col, const float* muc, float* o) {
            float fc[8], fp[8], fn[8];
            unpack8(*(const u32x4*)(pc + col), fc); unpack8(*(const u32x4*)(pp + col), fp); unpack8(*(const u32x4*)(pn + col), fn);
#pragma unroll
            for (int e = 0; e < 8; ++e) o[e] = fc[e] + muc[e] * (mp * fp[e] + mn * fn[e] - fc[e]);
        };
        float o[8];
        mix8(8 * lane, mur, o); *(u32x4*)(R + (size_t)r * 512 + 8 * lane) = pack8(o);
        mix8(1024 + 8 * lane, muv, o); *(u32x4*)(V + (size_t)r * 512 + 8 * lane) = pack8(o);
        mix8(512 + 8 * lane, muk, o); *(u32x4*)(K + (size_t)r * 512 + 8 * lane) = pack8(o);
        {
            float kk[8], ss = 0.f;
#pragma unroll
            for (int e = 0; e < 8; ++e) { kk[e] = o[e] * kkw[e]; ss += kk[e] * kk[e]; }
            ss = group_sum<8>(ss);
            const float rn = rsqrtf(fmaxf(ss, 1e-12f));
#pragma unroll
            for (int e = 0; e < 8; ++e) kk[e] *= rn;
            *(u32x4*)(KK + (size_t)r * 512 + 8 * lane) = pack8(kk);
        }
        if (lane < 40) {
            mix8(1536 + 8 * lane, mul_, o);
            if (lane < 16) {
#pragma unroll
                for (int e = 0; e < 8; ++e) o[e] = tanh_fast(o[e]);
            } else if (lane >= 24) {
#pragma unroll
                for (int e = 0; e < 8; ++e) o[e] = sigmoidf_(o[e]);
            }
            *(u32x4*)(LA + (size_t)r * 320 + 8 * lane) = pack8(o);
        }
    }
}

__device__ __forceinline__ void phase_out_even(int wv, KP Pk, int layer) {
    asm volatile("" : "+s"(Pk));
    const CAS Params& P = *Pk;
    const int tid = ltid(wv), lane = tid & 63, wid = tid >> 6, i_ = layer >> 1;
    const bf16_t* Pb = (const bf16_t*)(P.ws + WS_P);
    const bf16_t* Yf = (const bf16_t*)(P.ws + WS_YF); const bf16_t* Yb = (const bf16_t*)(P.ws + WS_YB);
    bf16_t* feat = (bf16_t*)(P.ws + WS_FEAT);
    const int r0 = (layer == DEPTH - 1) ? NCTX : 0;
    const bf16_t* XBC = (const bf16_t*)(P.ws + WS_EXBC);
    float nwa[8], nwb[8];
#pragma unroll
    for (int e = 0; e < 8; ++e) { nwa[e] = P.ssd_norm_w[i_ * 512 + 8 * lane + e]; nwb[e] = P.ml_norm_w[i_ * 512 + 8 * lane + e]; }
    const float dsk = P.ssd_d[i_ * 8 + (lane >> 3)];
    for (int r = r0 + blockIdx.x * 8 + wid; r < NROWS; r += gridDim.x * 8) {
        const bf16_t* pr = Pb + (size_t)r * LDP_EVEN;
        float y[8];
        {
            float a[8], bb[8], xsv[8], z[8];
            unpack8(*(const u32x4*)(Yf + (size_t)r * D + 8 * lane), a); unpack8(*(const u32x4*)(Yb + (size_t)r * D + 8 * lane), bb);
            unpack8(*(const u32x4*)(XBC + (size_t)r * 768 + 8 * lane), xsv); unpack8(*(const u32x4*)(pr + 8 * lane), z);
            float ss = 0.f;
#pragma unroll
            for (int e = 0; e < 8; ++e) {
                y[e] = (a[e] + bb[e] + dsk * xsv[e]) * siluf_(z[e]); ss += y[e] * y[e];
            }
            ss = wave_sum(ss);
            const float rn = rsqrtf(ss * (1.f / 512.f) + 1e-6f);
#pragma unroll
            for (int e = 0; e < 8; ++e) y[e] = y[e] * rn * nwa[e];
            *(u32x4*)(feat + (size_t)r * D + 8 * lane) = pack8(y);
        }
        {
            float a[8], bb[8], o[8];
            unpack8(*(const u32x4*)(Yf + (size_t)r * D + 512 + 8 * lane), a); unpack8(*(const u32x4*)(Yb + (size_t)r * D + 512 + 8 * lane), bb);
            unpack8(*(const u32x4*)(pr + 2320 + 8 * lane), o);
            float s = 0.f;
#pragma unroll
            for (int e = 0; e < 8; ++e) { y[e] = a[e] + bb[e]; s += y[e]; }
            const float mean = group_sum<16>(s) * (1.f / 128.f);
            float ss = 0.f;
#pragma unroll
            for (int e = 0; e < 8; ++e) { y[e] -= mean; ss += y[e] * y[e]; }
            const float rn = rsqrtf(group_sum<16>(ss) * (1.f / 128.f) + 1e-6f);
#pragma unroll
            for (int e = 0; e < 8; ++e) y[e] = sigmoidf_(o[e]) * (y[e] * rn) * nwb[e];
            *(u32x4*)(feat + (size_t)r * D + 512 + 8 * lane) = pack8(y);
        }
    }
}
__device__ __forceinline__ void phase_out_odd(int wv, KP Pk, int layer) {
    asm volatile("" : "+s"(Pk));
    const CAS Params& P = *Pk;
    const int tid = ltid(wv), lane = tid & 63, wid = tid >> 6, i_ = layer >> 1;
    const bf16_t* Pb = (const bf16_t*)(P.ws + WS_P);
    const bf16_t* Yf = (const bf16_t*)(P.ws + WS_YF); const bf16_t* Yb = (const bf16_t*)(P.ws + WS_YB);
    const bf16_t* R = (const bf16_t*)(P.ws + WS_RWR); const bf16_t* K = (const bf16_t*)(P.ws + WS_RWK); const bf16_t* V = (const bf16_t*)(P.ws + WS_RWV); const bf16_t* G = (const bf16_t*)(P.ws + WS_RWG);
    bf16_t* feat = (bf16_t*)(P.ws + WS_FEAT);
    const int r0 = (layer == DEPTH - 1) ? NCTX : 0;
    float nwc[8], rk[8], lw[8], lbv[8];
#pragma unroll
    for (int e = 0; e < 8; ++e) {
        nwc[e] = P.hg_norm_w[i_ * 512 + 8 * lane + e]; rk[e] = P.rw_r_k[i_ * 512 + 8 * lane + e];
        lw[e] = P.rw_ln_w[i_ * 512 + 8 * lane + e]; lbv[e] = P.rw_ln_b[i_ * 512 + 8 * lane + e];
    }
    for (int r = r0 + blockIdx.x * 8 + wid; r < NROWS; r += gridDim.x * 8) {
        float y[8];
        {
            float a[8], bb[8], g[8];
            unpack8(*(const u32x4*)(Yf + (size_t)r * D + 8 * lane), a); unpack8(*(const u32x4*)(Yb + (size_t)r * D + 8 * lane), bb);
            unpack8(*(const u32x4*)(Pb + (size_t)r * LDP_ODD + 2048 + 8 * lane), g);
            float ss = 0.f;
#pragma unroll
            for (int e = 0; e < 8; ++e) { y[e] = a[e] + bb[e]; ss += y[e] * y[e]; }
            const float rn = rsqrtf(group_sum<16>(ss) * (1.f / 128.f) + 1e-6f);
#pragma unroll
            for (int e = 0; e < 8; ++e) y[e] = y[e] * rn * nwc[e] * siluf_(g[e]);
            *(u32x4*)(feat + (size_t)r * D + 8 * lane) = pack8(y);
        }
        {
            float a[8], bb[8], rr[8], kk[8], vv[8], g[8];
            unpack8(*(const u32x4*)(Yf + (size_t)r * D + 512 + 8 * lane), a); unpack8(*(const u32x4*)(Yb + (size_t)r * D + 512 + 8 * lane), bb);
            unpack8(*(const u32x4*)(R + (size_t)r * 512 + 8 * lane), rr); unpack8(*(const u32x4*)(K + (size_t)r * 512 + 8 * lane), kk);
            unpack8(*(const u32x4*)(V + (size_t)r * 512 + 8 * lane), vv); unpack8(*(const u32x4*)(G + (size_t)r * 512 + 8 * lane), g);
            float s = 0.f, bs = 0.f;
#pragma unroll
            for (int e = 0; e < 8; ++e) { y[e] = a[e] + bb[e]; s += y[e]; bs += rr[e] * kk[e] * rk[e]; }
            const float mean = group_sum<8>(s) * (1.f / 64.f); bs = group_sum<8>(bs);
            float ss = 0.f;
#pragma unroll
            for (int e = 0; e < 8; ++e) { y[e] -= mean; ss += y[e] * y[e]; }
            const float rn = rsqrtf(group_sum<8>(ss) * (1.f / 64.f) + 64e-5f);
#pragma unroll
            for (int e = 0; e < 8; ++e) y[e] = (y[e] * rn * lw[e] + lbv[e] + bs * vv[e]) * g[e];
            *(u32x4*)(feat + (size_t)r * D + 512 + 8 * lane) = pack8(y);
        }
    }
}

#ifndef MK_DOUBLE
#define MK_DOUBLE 0
#endif
#define REP(bit, body) do { body; if (MK_DOUBLE & (bit)) { body; } } while (0)
__device__ __forceinline__ void phase_expconv(int wv, KP Pk, int layer, LAS char* lds) {
    asm volatile("" : "+s"(Pk));
    const CAS Params& P = *Pk;
    const int tid = ltid(wv), lane = tid & 63, wid = tid >> 6;
    {
        LAS float* scr = (LAS float*)(lds + wid * 8448);
        const int gw = blockIdx.x * 8 + wid, NGW = gridDim.x * 8;
        bf16_t* gu = (bf16_t*)(P.ws + WS_EXPGU); bf16_t* dw = (bf16_t*)(P.ws + WS_EXPD);
        constexpr int IG = 16 * 16, IDN = 8 * 32;
        for (int it = gw; it < NEXP * (2 * IG + IDN); it += NGW) {
            const int e = it / (2 * IG + IDN); int r = it % (2 * IG + IDN);
            const size_t eo = (size_t)(layer * NEXP + e);
            if (r < IG) { transpose_item(P.exp_w_gate + eo * D * DEXP, D, DEXP, gu + (size_t)e * 1024 * 1024, 1, scr, r, lane); continue; } r -= IG;
            if (r < IG) { transpose_item(P.exp_w_up + eo * D * DEXP, D, DEXP, gu + (size_t)e * 1024 * 1024, 2, scr, r, lane); continue; } r -= IG;
            transpose_item(P.exp_w_down + eo * DEXP * D, DEXP, D, dw + (size_t)e * 1024 * 512, 0, scr, r, lane);
        }
    }
}
constexpr int L1_AST = 1028;
constexpr int L1_PST = 33;
constexpr int L1_A = 0, L1_PART = L1_A + 16 * L1_AST * 4, L1_SM = L1_PART + 8 * 16 * L1_PST * 4, L1_END = L1_SM + (64 + 2 * 144 + 32) * 4;
static_assert(L1_END <= LDS_BYTES - 16, "LN1 LDS map");
__device__ __forceinline__ void phase_ln1(int wv, KP Pk, int layer, LAS char* lds, bool dry = false) {
    asm volatile("" : "+s"(Pk));
    const CAS Params& P = *Pk;
    const int tid = ltid(wv), lane = tid & 63;
    if (!dry) REP(8, phase_expconv(wv, Pk, layer, lds));
    __syncthreads();
    LAS float* At = (LAS float*)(lds + L1_A);
    LAS float* part = (LAS float*)(lds + L1_PART);
    LAS int* lcnt = (LAS int*)(lds + L1_SM);
    LAS int* lbase = lcnt + 32;
    LAS int* asg = lcnt + 64;
    LAS float* rbias = (LAS float*)(asg + 2 * 144);
    if (tid < 32) { lcnt[tid] = 0; rbias[tid] = P.router_bias[tid]; }
    float breg[8][4][2];
    {
        const float* rw = P.router_w + (size_t)(128 * wv + 4 * (lane >> 4)) * NEXP + (lane & 15);
#pragma unroll
        for (int j = 0; j < 8; ++j)
#pragma unroll
            for (int i = 0; i < 4; ++i) { breg[j][i][0] = rw[(16 * j + i) * NEXP]; breg[j][i][1] = rw[(16 * j + i) * NEXP + 16]; }
    }
    __syncthreads();
    const bf16_t* yo = (const bf16_t*)(P.ws + WS_YO);
    bf16_t* act = (bf16_t*)(P.ws + (dry ? WS_FEAT : WS_ACT));
    float* xc = (float*)(P.ws + WS_XC);
    int* cnt = (int*)(P.ws + WS_CNT) + layer * 32 * CNT_STRIDE;
    int* list = (int*)(P.ws + WS_LIST);
    float* wts = (float*)(P.ws + WS_WTS);
    const float* lg = P.ln_g + (size_t)(layer * 2 + 0) * D; const float* lb = P.ln_b + (size_t)(layer * 2 + 0) * D;
    const int r0 = (layer == DEPTH - 1) ? NCTX : 0, ntiles = (NROWS - r0) / 16, G = gridDim.x;
    f32x4 g1v[4], s2c[4], h2c[4];
#pragma unroll
    for (int i = 0; i < 4; ++i) g1v[i] = s2c[i] = h2c[i] = (f32x4){0.f, 0.f, 0.f, 0.f};
    int mcur = -1;
    f32x4 nx[2][4]; u32x2 nyo[2][4];
    auto fetch = [&](int s, int rr) {
        const float* xq = layer == 0 ? (rr < NCTX ? P.ctx + (size_t)rr * D : P.x + (size_t)(rr - NCTX) * D)
                                     : (rr < NCTX ? xc + (size_t)rr * D : P.out + (size_t)(rr - NCTX) * D);
#pragma unroll
        for (int i = 0; i < 4; ++i) { const int c = 4 * lane + 256 * i; nx[s][i] = *(const f32x4*)(xq + c); nyo[s][i] = *(const u32x2*)(yo + (size_t)rr * D + c); }
    };
    int tile = blockIdx.x;
    if (tile < ntiles) { fetch(0, r0 + tile * 16 + 2 * wv); fetch(1, r0 + tile * 16 + 2 * wv + 1); }
    for (int it = 0; tile < ntiles; ++it, tile += G) {
        const int rb = r0 + tile * 16 + 2 * wv;
        const int m = row_mod(rb);
        if (m != mcur) {
            mcur = m;
            const float* g1 = modvec(P.ws, layer, m, 2); const float* sh2 = modvec(P.ws, layer, m, 3); const float* sc2 = modvec(P.ws, layer, m, 4);
#pragma unroll
            for (int i = 0; i < 4; ++i) { const int c = 4 * lane + 256 * i; g1v[i] = *(const f32x4*)(g1 + c); s2c[i] = *(const f32x4*)(sc2 + c); h2c[i] = *(const f32x4*)(sh2 + c); }
        }
#pragma unroll
        for (int s = 0; s < 2; ++s) {
            const int r = rb + s;
            float* xr = r < NCTX ? xc + (size_t)r * D : P.out + (size_t)(r - NCTX) * D;
            f32x4 v[4]; float sm = 0.f;
#pragma unroll
            for (int i = 0; i < 4; ++i) {
                const f32x4 xv = nx[s][i], gv = g1v[i]; const u32x2 yv = nyo[s][i];
                v[i][0] = ALPHA * xv[0] + gv[0] * bflo(yv.x); v[i][1] = ALPHA * xv[1] + gv[1] * bfhi(yv.x);
                v[i][2] = ALPHA * xv[2] + gv[2] * bflo(yv.y); v[i][3] = ALPHA * xv[3] + gv[3] * bfhi(yv.y);
                sm += (v[i][0] + v[i][1]) + (v[i][2] + v[i][3]);
            }
            if (tile + G < ntiles) fetch(s, r + G * 16);
            const float mean = wave_sum(sm) * (1.f / D);
            float s2 = 0.f;
#pragma unroll
            for (int i = 0; i < 4; ++i) { v[i] = v[i] - mean; s2 += (v[i][0] * v[i][0] + v[i][1] * v[i][1]) + (v[i][2] * v[i][2] + v[i][3] * v[i][3]); }
            const float rstd = rsqrtf(wave_sum(s2) * (1.f / D) + 1e-5f);
            LAS float* arow = At + (2 * wv + s) * L1_AST;
#pragma unroll
            for (int i = 0; i < 4; ++i) {
                const int c = 4 * lane + 256 * i;
                const f32x4 gg = *(const f32x4*)(lg + c), bb = *(const f32x4*)(lb + c), s2v = s2c[i], h2v = h2c[i];
                f32x4 xn, hv;
#pragma unroll
                for (int j = 0; j < 4; ++j) { xn[j] = v[i][j] * rstd * gg[j] + bb[j]; hv[j] = xn[j] * (1.f + s2v[j]) + h2v[j]; }
                *(f32x4*)((dry ? (float*)(P.ws + WS_YF) + (size_t)r * D : xr) + c) = xn;
                u32x2 o; o.x = pk2(hv[0], hv[1]); o.y = pk2(hv[2], hv[3]); *(u32x2*)(act + (size_t)r * D + c) = o;
                *(LAS f32x4*)(arow + c) = hv;
            }
        }
        __syncthreads();
        {
            f32x4 ra0 = (f32x4){0.f, 0.f, 0.f, 0.f}, ra1 = ra0;
            const LAS float* ap = At + (lane & 15) * L1_AST + 128 * wv + 4 * (lane >> 4);
#pragma unroll
            for (int j = 0; j < 8; ++j) {
                const f32x4 a4 = *(const LAS f32x4*)(ap + 16 * j);
#pragma unroll
                for (int i = 0; i < 4; ++i) {
                    ra0 = __builtin_amdgcn_mfma_f32_16x16x4f32(a4[i], breg[j][i][0], ra0, 0, 0, 0);
                    ra1 = __builtin_amdgcn_mfma_f32_16x16x4f32(a4[i], breg[j][i][1], ra1, 0, 0, 0);
                }
            }
            LAS float* pw = part + wv * 16 * L1_PST + (4 * (lane >> 4)) * L1_PST + (lane & 15);
#pragma unroll
            for (int j = 0; j < 4; ++j) { pw[j * L1_PST] = ra0[j]; pw[j * L1_PST + 16] = ra1[j]; }
        }
        __syncthreads();
        {
            const int half = lane >> 5, e = lane & 31;
            const LAS float* pp = part + (2 * wv + half) * L1_PST + e;
            float sc_ = 0.f;
#pragma unroll
            for (int k = 0; k < 8; ++k) sc_ += pp[k * 16 * L1_PST];
            const float sg = sigmoidf_(sc_), vb = sg + rbias[e];
            float bv[4], sv[4];
            bv[0] = dppmov<0x00>(vb); bv[1] = dppmov<0x55>(vb); bv[2] = dppmov<0xAA>(vb); bv[3] = dppmov<0xFF>(vb);
            sv[0] = dppmov<0x00>(sg); sv[1] = dppmov<0x55>(sg); sv[2] = dppmov<0xAA>(sg); sv[3] = dppmov<0xFF>(sg);
            float m1 = -1e30f, m2 = -1e30f;
#pragma unroll
            for (int k = 0; k < 4; ++k) { const float vsc = bv[k]; if (vsc > m1) { m2 = m1; m1 = vsc; } else if (vsc > m2) m2 = vsc; }
            float best = m1 + m2; int bg = e >> 2;
#pragma unroll
            for (int msk = 4; msk <= 16; msk <<= 1) {
                const float ob = __shfl_xor(best, msk); const int og = __shfl_xor(bg, msk);
                const bool take = (ob > best) || (ob == best && og < bg);
                best = take ? ob : best; bg = take ? og : bg;
            }
            int i1 = 0; float b1 = bv[0];
#pragma unroll
            for (int k = 1; k < 4; ++k) if (bv[k] > b1) { b1 = bv[k]; i1 = k; }
            int i2 = -1; float b2 = -1e30f;
#pragma unroll
            for (int k = 0; k < 4; ++k) if (k != i1 && bv[k] > b2) { b2 = bv[k]; i2 = k; }
            float s1 = sv[0], s2s = sv[0];
#pragma unroll
            for (int k = 1; k < 4; ++k) { if (i1 == k) s1 = sv[k]; if (i2 == k) s2s = sv[k]; }
            if (e == 4 * bg && !dry) {
                const int r = rb + half;
                const int e0 = bg * 4 + i1, e1 = bg * 4 + i2;
                const float inv = 1.f / (s1 + s2s);
                const int li = it * 16 + 2 * wv + half;
                const int p0 = __hip_atomic_fetch_add(&lcnt[e0], 1, __ATOMIC_RELAXED, __HIP_MEMORY_SCOPE_WORKGROUP);
                const int p1 = __hip_atomic_fetch_add(&lcnt[e1], 1, __ATOMIC_RELAXED, __HIP_MEMORY_SCOPE_WORKGROUP);
                asg[2 * li] = (e0 << 16) | p0; asg[2 * li + 1] = (e1 << 16) | p1;
                wts[2 * r] = s1 * inv; wts[2 * r + 1] = s2s * inv;
            }
        }
    }
    __syncthreads();
    if (dry) return;
    if (tid < 32) lbase[tid] = atomicAdd(&cnt[tid * CNT_STRIDE], lcnt[tid]);
    __syncthreads();
    for (int idx = tid; idx < 2 * 144; idx += NT) {
        const int li = idx >> 1, k = idx & 1, t = (li >> 4) * G + blockIdx.x;
        if (t < ntiles) { const int r = r0 + t * 16 + (li & 15); const int v = asg[idx], e = v >> 16, lp = v & 0xffff; list[(size_t)e * LISTCAP + lbase[e] + lp] = 2 * r + k; }
    }
}

__device__ __forceinline__ void phase_ln2(int wv, KP Pk, int layer, bool dry = false) {
    asm volatile("" : "+s"(Pk));
    const CAS Params& P = *Pk;
    const int tid = ltid(wv), lane = tid & 63, wid = tid >> 6;
    const bf16_t* yp = (const bf16_t*)(P.ws + WS_YP);
    const float* wts = (const float*)(P.ws + WS_WTS);
    bf16_t* act = (bf16_t*)(P.ws + (dry ? WS_FEAT : WS_ACT));
    float* xc = (float*)(P.ws + WS_XC);
    const float* lg = P.ln_g + (size_t)(layer * 2 + 1) * D; const float* lb = P.ln_b + (size_t)(layer * 2 + 1) * D;
    const bool last = (layer == DEPTH - 1);
    const int r0 = last ? NCTX : 0, stride = gridDim.x * 8;
    f32x4 cg[4], cb[4], g2v[4], s1v[4], h1v[4];
#pragma unroll
    for (int i = 0; i < 4; ++i) { cg[i] = *(const f32x4*)(lg + 4 * lane + 256 * i); cb[i] = *(const f32x4*)(lb + 4 * lane + 256 * i); g2v[i] = s1v[i] = h1v[i] = (f32x4){0.f, 0.f, 0.f, 0.f}; }
    int mcur = -1;
    f32x4 nx[4]; u32x2 ny0[4], ny1[4]; float nw0 = 0.f, nw1 = 0.f;
    auto fetch = [&](int r) {
        const float* xr = r < NCTX ? xc + (size_t)r * D : P.out + (size_t)(r - NCTX) * D;
#pragma unroll
        for (int i = 0; i < 4; ++i) {
            const int c = 4 * lane + 256 * i;
            nx[i] = *(const f32x4*)(xr + c); ny0[i] = *(const u32x2*)(yp + (size_t)(2 * r) * D + c); ny1[i] = *(const u32x2*)(yp + (size_t)(2 * r + 1) * D + c);
        }
        nw0 = wts[2 * r]; nw1 = wts[2 * r + 1];
    };
    int r = r0 + blockIdx.x * 8 + wid;
    if (r < NROWS) fetch(r);
    for (; r < NROWS; r += stride) {
        const int m = row_mod(r);
        float* xr = r < NCTX ? xc + (size_t)r * D : P.out + (size_t)(r - NCTX) * D;
        if (m != mcur) {
            mcur = m;
            const float* g2 = modvec(P.ws, layer, m, 5); const float* sh1 = last ? lg : modvec(P.ws, layer + 1, m, 0); const float* sc1 = last ? lg : modvec(P.ws, layer + 1, m, 1);
#pragma unroll
            for (int i = 0; i < 4; ++i) { const int c = 4 * lane + 256 * i; g2v[i] = *(const f32x4*)(g2 + c); s1v[i] = *(const f32x4*)(sc1 + c); h1v[i] = *(const f32x4*)(sh1 + c); }
        }
        f32x4 v[4]; float s = 0.f;
        const float w0 = nw0, w1 = nw1;
#pragma unroll
        for (int i = 0; i < 4; ++i) {
            const f32x4 xv = nx[i], gv = g2v[i]; const u32x2 y0 = ny0[i], y1 = ny1[i];
            v[i][0] = ALPHA * xv[0] + gv[0] * (w0 * bflo(y0.x) + w1 * bflo(y1.x)); v[i][1] = ALPHA * xv[1] + gv[1] * (w0 * bfhi(y0.x) + w1 * bfhi(y1.x));
            v[i][2] = ALPHA * xv[2] + gv[2] * (w0 * bflo(y0.y) + w1 * bflo(y1.y)); v[i][3] = ALPHA * xv[3] + gv[3] * (w0 * bfhi(y0.y) + w1 * bfhi(y1.y));
            s += (v[i][0] + v[i][1]) + (v[i][2] + v[i][3]);
        }
        if (r + stride < NROWS) fetch(r + stride);
        const float mean = wave_sum(s) * (1.f / D);
        float s2 = 0.f;
#pragma unroll
        for (int i = 0; i < 4; ++i) { v[i] = v[i] - mean; s2 += (v[i][0] * v[i][0] + v[i][1] * v[i][1]) + (v[i][2] * v[i][2] + v[i][3] * v[i][3]); }
        const float rstd = rsqrtf(wave_sum(s2) * (1.f / D) + 1e-5f);
#pragma unroll
        for (int i = 0; i < 4; ++i) {
            const int c = 4 * lane + 256 * i;
            f32x4 xn;
#pragma unroll
            for (int j = 0; j < 4; ++j) xn[j] = v[i][j] * rstd * cg[i][j] + cb[i][j];
            *(f32x4*)((dry ? (float*)(P.ws + WS_YF) + (size_t)r * D : xr) + c) = xn;
            if (!last) {
                u32x2 o; o.x = pk2(xn[0] * (1.f + s1v[i][0]) + h1v[i][0], xn[1] * (1.f + s1v[i][1]) + h1v[i][1]); o.y = pk2(xn[2] * (1.f + s1v[i][2]) + h1v[i][2], xn[3] * (1.f + s1v[i][3]) + h1v[i][3]);
                *(u32x2*)(act + (size_t)r * D + c) = o;
            }
        }
    }
}

constexpr int NPHASE = 2 + 11 * DEPTH;
__global__ void __launch_bounds__(NT, 2) fwd_kernel(Params P) {
    extern __shared__ __attribute__((aligned(16))) char lds_raw[];
    LAS char* lds = (LAS char*)lds_raw;
    volatile LAS unsigned* xbw = (volatile LAS unsigned*)(lds + LDS_BYTES - 16);
    KP Pk = (KP)__builtin_amdgcn_kernarg_segment_ptr();
    const int wv = __builtin_amdgcn_readfirstlane((int)(threadIdx.x >> 6));
    const bool multi = (P.ph_hi - P.ph_lo) > 1;
    XcdBarrier bar; bar.bar = (unsigned*)(P.ws + WS_BAR); bar.x = 0; bar.st = xbw;
    if (multi) {
        if (ltid(wv) == 0) { xbw[0] = 0u; xbw[1] = 0u; xbw[2] = 0u; xbw[3] = 0u; }
        __syncthreads();
        bar = xcd_barrier_post(wv, (unsigned*)(P.ws + WS_BAR), xbw);
    }
#define PHASE(id, body) do { if (P.ph_lo <= (id) && (id) < P.ph_hi) { body; if ((id) + 1 < P.ph_hi) xcd_barrier(wv, bar); if (MK_DOUBLE & 2048) xcd_barrier(wv, bar); } } while (0)
    PHASE(0, REP(16, phase_prologue0(wv, Pk, lds)));
    PHASE(1, REP(16, phase_prologue1(wv, Pk)));
    for (int l = 0; l < DEPTH; ++l) {
        const int pb = 2 + 11 * l, odd = l & 1;
        PHASE(pb + 0, REP(1, phase_inproj(wv, Pk, l, lds)));
        if (odd) {
            PHASE(pb + 1, REP(4, phase_prep1(wv, Pk, l)));
            PHASE(pb + 2, phase_prep2(wv, Pk, l, lds));
            PHASE(pb + 3, REP(32, { if (blockIdx.x < 128) REP(64, scan_hgrn_c(wv, Pk, l, blockIdx.x, lds)); else if (blockIdx.x < 256) REP(128, scan_rwkv(wv, Pk, l, blockIdx.x - 128, lds)); }));
            PHASE(pb + 5, REP(4, phase_out_odd(wv, Pk, l)));
        } else {
            PHASE(pb + 1, REP(4, phase_prep_even(wv, Pk, l)));
            PHASE(pb + 2, REP(2, phase_ex1(wv, Pk, l, lds)));
            PHASE(pb + 3, phase_ex2(wv, Pk, l));
            PHASE(pb + 4, REP(2, phase_ex3(wv, Pk, l, lds)));
            PHASE(pb + 5, REP(4, phase_out_even(wv, Pk, l)));
        }
        PHASE(pb + 6, REP(256, phase_outproj(wv, Pk, l, lds)));
        PHASE(pb + 7, { if (MK_DOUBLE & 4096) phase_ln1(wv, Pk, l, lds, true); phase_ln1(wv, Pk, l, lds); });
        PHASE(pb + 8, REP(512, phase_moe1(wv, Pk, l, lds)));
        PHASE(pb + 9, REP(1024, phase_moe2(wv, Pk, l, lds)));
        PHASE(pb + 10, { if (MK_DOUBLE & 8192) phase_ln2(wv, Pk, l, true); phase_ln2(wv, Pk, l); });
    }
#undef PHASE
}


#ifndef MK_STOP
#define MK_STOP NPHASE
#endif
#ifndef MK_DUMP
#define MK_DUMP 0
#endif
#ifndef MK_DUMP_N
#define MK_DUMP_N (1u << 30)
#endif
#ifndef MK_DUMP_LD
#define MK_DUMP_LD 1024
#endif
#ifndef MK_DUMP_C0
#define MK_DUMP_C0 0
#endif
__global__ void diff_kernel(const bf16_t* a, const bf16_t* b, float* out, size_t n) {
    for (size_t i = (size_t)blockIdx.x * blockDim.x + threadIdx.x; i < n; i += (size_t)gridDim.x * blockDim.x) out[i] = 1e6f * (bf2f(a[i]) - bf2f(b[i]));
}
__global__ void dump_kernel(const bf16_t* src, float* out, size_t n) {
    for (size_t i = (size_t)blockIdx.x * blockDim.x + threadIdx.x; i < n; i += (size_t)gridDim.x * blockDim.x) out[i] = i < (size_t)MK_DUMP_N ? bf2f(src[(i >> 10) * MK_DUMP_LD + MK_DUMP_C0 + (i & 1023)]) : 0.f;
}
extern "C" void kernel_launch(void* const* d_in, const int* in_sizes, int n_in, void* d_out, int out_size, void* d_ws, size_t ws_size, hipStream_t stream) {
    static int ready = 0;
    if (ready == 0) {
        ready = 1;
        if (n_in != 42 || out_size != NB * SEQ * D || ws_size < WS_END) { fprintf(stderr, "kernel_launch: unexpected shapes (n_in %d out %d ws %zu need %zu)\n", n_in, out_size, ws_size, (size_t)WS_END); ready = -1; }
        if (hipFuncSetAttribute((const void*)fwd_kernel, hipFuncAttributeMaxDynamicSharedMemorySize, LDS_BYTES) != hipSuccess) { fprintf(stderr, "kernel_launch: hipFuncSetAttribute failed\n"); ready = -1; }
    }
    if (ready < 0) return;
    (void)in_sizes;
    hipMemsetAsync((char*)d_ws + WS_BAR, 0, WS_ZERO_BYTES, stream);
    Params p;
    memset(&p, 0, sizeof(p));
    const float** fp = (const float**)&p;
    for (int i = 0; i < 42; ++i) fp[i] = (const float*)d_in[i];
    p.out = (float*)d_out; p.ws = (unsigned char*)d_ws;
#if MK_PER_PHASE
    for (int ph = 0; ph < MK_STOP; ++ph) {
        const int local = ph < 2 ? -1 : (ph - 2) % 11, layer = ph < 2 ? 0 : (ph - 2) / 11;
        if (local == 4 && (layer & 1)) continue;
        p.ph_lo = ph; p.ph_hi = ph + 1;
        hipLaunchKernelGGL(fwd_kernel, dim3(256), dim3(NT), LDS_BYTES, stream, p);
    }
#ifdef MK_DIFF
    p.ph_lo = 7; p.ph_hi = 8; p.dbg = 1;
    hipLaunchKernelGGL(fwd_kernel, dim3(256), dim3(NT), LDS_BYTES, stream, p);
    hipLaunchKernelGGL(diff_kernel, dim3(1024), dim3(256), 0, stream, (const bf16_t*)((unsigned char*)d_ws + WS_YO), (const bf16_t*)((unsigned char*)d_ws + WS_HID), (float*)d_out, (size_t)NB * SEQ * D);
#else
    if (MK_DUMP) hipLaunchKernelGGL(dump_kernel, dim3(1024), dim3(256), 0, stream, (const bf16_t*)((unsigned char*)d_ws + (size_t)MK_DUMP), (float*)d_out, (size_t)NB * SEQ * D);
#endif
#else
    p.ph_lo = 0; p.ph_hi = NPHASE;
    hipLaunchKernelGGL(fwd_kernel, dim3(256), dim3(NT), LDS_BYTES, stream, p);
#endif
}
```

```cpp
#include <hip/hip_runtime.h>
#include <stdint.h>
#include <stdio.h>
#include <string.h>

#ifndef MK_PER_PHASE
#define MK_PER_PHASE 0
#endif

typedef unsigned short bf16_t;
typedef short bf16x8 __attribute__((ext_vector_type(8)));
typedef float f32x4 __attribute__((ext_vector_type(4)));
typedef unsigned u32x4 __attribute__((ext_vector_type(4)));
typedef unsigned u32x2 __attribute__((ext_vector_type(2)));
#define LAS __attribute__((address_space(3)))
#define CAS __attribute__((address_space(4)))

constexpr int D = 1024, NB = 4, SEQ = 8192, CTXL = 256, DEPTH = 4;
constexpr int NCTX = NB * CTXL;
constexpr int NROWS = NCTX + NB * SEQ;
constexpr int P_EVEN = 2848, P_ODD = 4416, LDP_EVEN = 3072, LDP_ODD = 4608;
constexpr int NEXP = 32, DEXP = 512, LISTCAP = NROWS;
constexpr float ALPHA = 1.681792830507429f;
constexpr int NT = 512;
constexpr int TCH = 32;
constexpr int NSTEPS = CTXL + SEQ;
constexpr int LDS_BYTES = 160 * 1024;

constexpr size_t al256(size_t x) { return (x + 255) & ~(size_t)255; }
constexpr size_t WS_BAR = 0;
constexpr size_t WS_CNT = 16384;
constexpr int CNT_STRIDE = 64;
constexpr size_t WS_ZERO_BYTES = 16384 + (size_t)4 * 32 * CNT_STRIDE * 4;
constexpr size_t WS_MODV = al256(WS_ZERO_BYTES);
constexpr size_t WS_LB = WS_MODV + al256((size_t)4 * 5 * 6144 * 4);
constexpr size_t WS_XC = WS_LB + al256(4 * 512 * 4);
constexpr size_t WS_WTS = WS_XC + (size_t)NCTX * D * 4;
constexpr size_t WS_LIST = WS_WTS + al256((size_t)2 * NROWS * 4);
constexpr size_t WS_WINT = WS_LIST + al256((size_t)NEXP * LISTCAP * 4);
constexpr size_t WINT_L0 = 0, WINT_L1 = (size_t)LDP_EVEN * D, WINT_L2 = WINT_L1 + (size_t)LDP_ODD * D, WINT_L3 = WINT_L2 + (size_t)LDP_EVEN * D, WINT_END = WINT_L3 + (size_t)LDP_ODD * D;
constexpr size_t WS_WOUTT = WS_WINT + WINT_END * 2;
constexpr size_t WS_LORAT = WS_WOUTT + (size_t)4 * D * D * 2;
constexpr size_t LORA_PER = (size_t)512 * 320;
constexpr size_t WS_EXPGU = WS_LORAT + al256(2 * LORA_PER * 2);
constexpr size_t WS_EXPD = WS_EXPGU + (size_t)NEXP * 1024 * 1024 * 2;
constexpr size_t WS_ACT = WS_EXPD + (size_t)NEXP * 1024 * 512 * 2;
constexpr size_t ROWB = (size_t)NROWS * D * 2;
constexpr size_t WS_FEAT = WS_ACT + ROWB;
constexpr size_t WS_YF = WS_FEAT + ROWB;
constexpr size_t WS_YB = WS_YF + ROWB;
constexpr size_t WS_P = WS_YB + ROWB;
constexpr size_t P_BYTES = (size_t)NROWS * LDP_ODD * 2;
constexpr size_t WS_YO = WS_P;
constexpr size_t WS_HID = WS_P + ROWB;
constexpr size_t WS_YP = WS_HID + ROWB;
static_assert(WS_YP + 2 * ROWB <= WS_P + P_BYTES, "MoE buffers must fit in the P region");
constexpr size_t HALFB = (size_t)NROWS * 512 * 2;
constexpr size_t WS_RWR = WS_P + P_BYTES;
constexpr size_t WS_RWK = WS_RWR + HALFB;
constexpr size_t WS_RWV = WS_RWK + HALFB;
constexpr size_t WS_RWKK = WS_RWV + HALFB;
constexpr size_t WS_RWB = WS_RWKK + HALFB;
constexpr size_t WS_RWG = WS_RWB + HALFB;
constexpr size_t WS_RWDEC = WS_RWG + HALFB;
constexpr size_t WS_LA = WS_RWDEC + (size_t)2 * NROWS * 512 * 4;
constexpr size_t WS_END = WS_LA + (size_t)NROWS * 320 * 2;
static_assert(WS_END <= (size_t)280602384 * 4, "workspace map exceeds the guaranteed ws_size");

struct Params {
    const float *x, *c, *ctx, *c_ctx, *mod_w, *mod_b, *ln_g, *ln_b;
    const float *ev_w_in, *ev_w_out, *ssd_conv_w, *ssd_conv_b, *ssd_dt_bias, *ssd_a_log, *ssd_d, *ssd_norm_w;
    const float *ml_conv_w, *ml_conv_b, *ml_i_bias, *ml_f_bias, *ml_norm_w;
    const float *od_w_in, *od_w_out, *hg_lb_logits, *hg_f_bias, *hg_norm_w;
    const float *rw_mu, *rw_w0, *rw_w2, *rw_a0, *rw_a2, *rw_g2, *rw_k_k, *rw_k_a, *rw_r_k, *rw_ln_w, *rw_ln_b;
    const float *router_w, *router_bias, *exp_w_gate, *exp_w_up, *exp_w_down;
    float* out;
    unsigned char* ws;
    int ph_lo, ph_hi, dbg, pad_;
};
typedef const CAS Params* KP;

__device__ __forceinline__ int ltid(int wv) { int l; asm volatile("v_mbcnt_lo_u32_b32 %0, -1, 0\n\tv_mbcnt_hi_u32_b32 %0, -1, %0" : "=v"(l)); return wv * 64 + l; }
__device__ __forceinline__ float bf2f(bf16_t h) { return __uint_as_float(((unsigned)h) << 16); }
__device__ __forceinline__ float bflo(unsigned u) { return __uint_as_float(u << 16); }
__device__ __forceinline__ float bfhi(unsigned u) { return __uint_as_float(u & 0xffff0000u); }
typedef __bf16 bf16v2_t __attribute__((ext_vector_type(2)));
typedef float f32x2 __attribute__((ext_vector_type(2)));
__device__ __forceinline__ unsigned pk2(float lo, float hi) { const f32x2 v = {lo, hi}; return __builtin_bit_cast(unsigned, __builtin_convertvector(v, bf16v2_t)); }
__device__ __forceinline__ bf16_t f2bf(float f) { return (bf16_t)(pk2(f, 0.f) & 0xffffu); }
__device__ __forceinline__ void unpack8(const u32x4& u, float* f) {
    f[0] = bflo(u.x); f[1] = bfhi(u.x); f[2] = bflo(u.y); f[3] = bfhi(u.y); f[4] = bflo(u.z); f[5] = bfhi(u.z); f[6] = bflo(u.w); f[7] = bfhi(u.w);
}
__device__ __forceinline__ u32x4 pack8(const float* f) { u32x4 u; u.x = pk2(f[0], f[1]); u.y = pk2(f[2], f[3]); u.z = pk2(f[4], f[5]); u.w = pk2(f[6], f[7]); return u; }
__device__ __forceinline__ float sigmoidf_(float x) { return __builtin_amdgcn_rcpf(1.f + __expf(-x)); }
__device__ __forceinline__ float siluf_(float x) { return x * __builtin_amdgcn_rcpf(1.f + __expf(-x)); }
__device__ __forceinline__ float softplus_fast(float x) { return x > 20.f ? x : __logf(1.f + __expf(x)); }
__device__ __forceinline__ float tanh_fast(float x) { return 1.f - 2.f * __builtin_amdgcn_rcpf(1.f + __expf(2.f * x)); }
__device__ __forceinline__ float softplusf_(float x) { return x > 20.f ? x : __logf(1.f + __expf(x)); }
__device__ __forceinline__ float logsigmoidf_(float x) { return fminf(x, 0.f) - __logf(1.f + __expf(-fabsf(x))); }
template <int CTRL> __device__ __forceinline__ float dppmov(float v) {
    return __builtin_bit_cast(float, __builtin_amdgcn_update_dpp(0, __builtin_bit_cast(int, v), CTRL, 0xf, 0xf, true));
}
__device__ __forceinline__ float allreduce16(float v) {
    v += dppmov<0xB1>(v);
    v += dppmov<0x4E>(v);
    v += dppmov<0x141>(v);
    v += dppmov<0x140>(v);
    return v;
}
__device__ __forceinline__ float allreduce8_(float v) { v += dppmov<0xB1>(v); v += dppmov<0x4E>(v); v += dppmov<0x141>(v); return v; }
__device__ __forceinline__ float wave_sum(float v) {
    v = allreduce16(v);
    const float r0 = __builtin_bit_cast(float, __builtin_amdgcn_readlane(__builtin_bit_cast(int, v), 0)), r1 = __builtin_bit_cast(float, __builtin_amdgcn_readlane(__builtin_bit_cast(int, v), 16));
    const float r2 = __builtin_bit_cast(float, __builtin_amdgcn_readlane(__builtin_bit_cast(int, v), 32)), r3 = __builtin_bit_cast(float, __builtin_amdgcn_readlane(__builtin_bit_cast(int, v), 48));
    return (r0 + r1) + (r2 + r3);
}
template <int W> __device__ __forceinline__ float group_sum(float v) {
    if (W == 8) return allreduce8_(v);
    return allreduce16(v);
}

#define XB_TMO      128
#define XB_XCNT(j)  (256  + 64 * (j))
#define XB_XSUB(j)  (1280 + 64 * (j))
#define XB_XGEN(j)  (2304 + 64 * (j))
#define XB_TOP      3328
#define XB_TOPGEN   3392
#define XCD_BAR_WORDS 3456
#define XB_SPIN_CAP (1u << 22)
__device__ __forceinline__ unsigned xb_ld(unsigned* p)              { return __hip_atomic_load(p, __ATOMIC_RELAXED, __HIP_MEMORY_SCOPE_AGENT); }
__device__ __forceinline__ unsigned xb_add(unsigned* p, unsigned v) { return __hip_atomic_fetch_add(p, v, __ATOMIC_RELAXED, __HIP_MEMORY_SCOPE_AGENT); }
__device__ __forceinline__ unsigned xb_xcc_id() { return (unsigned)__builtin_amdgcn_s_getreg((3 << 11) | 20) & 0xFu; }
#define XB_SPIN(cond, bar) do { unsigned _sp = 0; while (cond) { __builtin_amdgcn_s_sleep(1); \
    if ((++_sp & 255u) == 0u) { if (xb_ld(&(bar)[XB_TMO])) break; if (_sp > XB_SPIN_CAP) { atomicAdd(&(bar)[XB_TMO], 1u); break; } } } } while (0)
struct XcdBarrier { unsigned* bar; unsigned x; volatile LAS unsigned* st; };
__device__ __forceinline__ XcdBarrier xcd_barrier_post(int wv, unsigned* bar, volatile LAS unsigned* st) {
    XcdBarrier b; b.bar = bar; b.x = xb_xcc_id(); b.st = st;
    if (ltid(wv) == 0) (void)xb_add(&bar[XB_XCNT(b.x)], 1u);
    return b;
}
__device__ __forceinline__ void xcd_barrier_complete(unsigned* bar, unsigned x, unsigned& nloc, unsigned& nx) {
    const unsigned G = gridDim.x * gridDim.y * gridDim.z;
    unsigned sum, cnt, mine, sp = 0u;
    for (;;) {
        sum = 0u; cnt = 0u; mine = 0u;
#pragma unroll
        for (unsigned j = 0; j < 16; ++j) { const unsigned c = xb_ld(&bar[XB_XCNT(j)]); sum += c; cnt += (c > 0u) ? 1u : 0u; mine = (j == x) ? c : mine; }
        if (sum == G) break;
        __builtin_amdgcn_s_sleep(1);
        if ((++sp & 255u) == 0u) { if (xb_ld(&bar[XB_TMO])) break; if (sp > XB_SPIN_CAP) { atomicAdd(&bar[XB_TMO], 1u); break; } }
    }
    nloc = mine > 0u ? mine : 1u; nx = cnt > 0u ? cnt : 1u;
}
__device__ __forceinline__ void xcd_barrier(int wv, const XcdBarrier& b) {
    asm volatile("s_waitcnt vmcnt(0)" ::: "memory");
    __syncthreads();
    if (ltid(wv) == 0) {
        unsigned* bar = b.bar;
        asm volatile("" : "+s"(bar));
        __builtin_amdgcn_s_waitcnt(0);
        unsigned nloc = b.st[0], nx = b.st[1];
        if (nloc == 0u) { xcd_barrier_complete(bar, b.x, nloc, nx); b.st[0] = nloc; b.st[1] = nx; }
        const unsigned old = xb_add(&bar[XB_XSUB(b.x)], 1u);
        const unsigned gen = old / nloc;
        if (old + 1u == (gen + 1u) * nloc) {
            __builtin_amdgcn_fence(__ATOMIC_RELEASE, "agent");
            asm volatile("s_waitcnt vmcnt(0)" ::: "memory");
            const unsigned og = xb_add(&bar[XB_TOP], 1u);
            const unsigned tg = og / nx;
            if (og + 1u == (tg + 1u) * nx) xb_add(&bar[XB_TOPGEN], 1u);
            else XB_SPIN(xb_ld(&bar[XB_TOPGEN]) == tg, bar);
            __builtin_amdgcn_fence(__ATOMIC_ACQUIRE, "agent");
            xb_add(&bar[XB_XGEN(b.x)], 1u);
            asm volatile("s_waitcnt vmcnt(0)" ::: "memory");
        } else {
            XB_SPIN(xb_ld(&bar[XB_XGEN(b.x)]) == gen, bar);
            __builtin_amdgcn_fence(__ATOMIC_ACQUIRE, "agent");
            asm volatile("s_waitcnt vmcnt(0)" ::: "memory");
        }
    }
    __syncthreads();
}

__device__ __forceinline__ int row_mod(int r) { return r < NCTX ? 4 : ((r - NCTX) >> 13); }
__device__ __forceinline__ void row_seg(int r, int& t, int& len) { if (r < NCTX) { t = r & 255; len = CTXL; } else { t = (r - NCTX) & 8191; len = SEQ; } }
__device__ __forceinline__ int scan_row(int tg, int b, int dir, int odd) {
    if (tg < CTXL) { const int t = dir ? (CTXL - 1 - tg) : tg; return b * CTXL + t; }
    int sg = tg - CTXL; if (dir) sg = SEQ - 1 - sg;
    const int s = odd ? (((sg & 127) << 6) + (sg >> 7)) : sg;
    return NCTX + b * SEQ + s;
}
__device__ __forceinline__ const float* modvec(const unsigned char* ws, int layer, int m, int which) {
    return (const float*)(ws + WS_MODV) + ((size_t)(layer * 5 + m) * 6 + which) * D;
}

constexpr int G_BM = 256, G_BN = 128, G_BK = 64;
constexpr int G_ABYTES = G_BM * G_BK * 2, G_BBYTES = G_BN * G_BK * 2, G_BUF = G_ABYTES + G_BBYTES;
__device__ __forceinline__ int swz(int o) { return o ^ (((o >> 9) & 1) << 5); }

template <class RowSrc, class Epi>
__device__ __forceinline__ void gemm_tile(int wv, const bf16_t* __restrict__ A, int lda, const RowSrc& rs, const bf16_t* __restrict__ Bt, int ldb, int n0, int K, const Epi& epi, LAS char* lds) {
    const int tid = ltid(wv), lane = tid & 63, wid = tid >> 6, wm = wid >> 1, wn = wid & 1;
    const bf16_t* ap[4]; int aoff[4];
#pragma unroll
    for (int i = 0; i < 4; ++i) {
        const int c = tid + NT * i, row = c >> 3, kc = c & 7;
        ap[i] = A + (size_t)rs.src(row) * lda + kc * 8;
        aoff[i] = ((row >> 4) * 2 + (kc >> 2)) * 1024 + swz((row & 15) * 64 + (kc & 3) * 16);
    }
    const bf16_t* bp[2]; int boff[2];
#pragma unroll
    for (int i = 0; i < 2; ++i) {
        const int c = tid + NT * i, row = c >> 3, kc = c & 7;
        bp[i] = Bt + (size_t)(n0 + row) * ldb + kc * 8;
        boff[i] = G_ABYTES + ((row >> 4) * 2 + (kc >> 2)) * 1024 + swz((row & 15) * 64 + (kc & 3) * 16);
    }
    f32x4 acc[4][4];
#pragma unroll
    for (int i = 0; i < 4; ++i)
#pragma unroll
        for (int j = 0; j < 4; ++j) acc[i][j] = (f32x4){0.f, 0.f, 0.f, 0.f};
    u32x4 ra[2][4], rb[2][2];
    const int KT = K / G_BK;
    const int fragoff = swz((lane & 15) * 64 + (lane >> 4) * 16);
#define G_LOAD(set, kt_) do { _Pragma("unroll") for (int i = 0; i < 4; ++i) ra[set][i] = *(const u32x4*)(ap[i] + (kt_) * G_BK); \
                              _Pragma("unroll") for (int i = 0; i < 2; ++i) rb[set][i] = *(const u32x4*)(bp[i] + (kt_) * G_BK); } while (0)
#define G_STORE(set, buf) do { _Pragma("unroll") for (int i = 0; i < 4; ++i) *(LAS u32x4*)((buf) + aoff[i]) = ra[set][i]; \
                               _Pragma("unroll") for (int i = 0; i < 2; ++i) *(LAS u32x4*)((buf) + boff[i]) = rb[set][i]; } while (0)
#define G_COMPUTE(cur) do { bf16x8 af[2][4], bfr[2][4]; \
        _Pragma("unroll") for (int ks = 0; ks < 2; ++ks) { \
            _Pragma("unroll") for (int ni = 0; ni < 4; ++ni) bfr[ks][ni] = *(LAS bf16x8*)((cur) + G_ABYTES + ((wn * 4 + ni) * 2 + ks) * 1024 + fragoff); \
            _Pragma("unroll") for (int mi = 0; mi < 4; ++mi) af[ks][mi] = *(LAS bf16x8*)((cur) + ((wm * 4 + mi) * 2 + ks) * 1024 + fragoff); } \
        __builtin_amdgcn_sched_barrier(0); \
        _Pragma("unroll") for (int ks = 0; ks < 2; ++ks) _Pragma("unroll") for (int mi = 0; mi < 4; ++mi) _Pragma("unroll") for (int ni = 0; ni < 4; ++ni) \
            acc[mi][ni] = __builtin_amdgcn_mfma_f32_16x16x32_bf16(bfr[ks][ni], af[ks][mi], acc[mi][ni], 0, 0, 0); \
        __builtin_amdgcn_sched_barrier(0); } while (0)
    G_LOAD(0, 0);
    G_STORE(0, lds);
    if (KT > 1) G_LOAD(0, 1);
    if (KT > 2) G_LOAD(1, 2);
    __syncthreads();
    for (int kt = 0; kt < KT; kt += 2) {
        G_COMPUTE(lds);
        if (kt + 1 < KT) G_STORE(0, lds + G_BUF);
        if (kt + 3 < KT) G_LOAD(0, kt + 3);
        __syncthreads();
        if (kt + 1 < KT) {
            G_COMPUTE(lds + G_BUF);
            if (kt + 2 < KT) G_STORE(1, lds);
            if (kt + 4 < KT) G_LOAD(1, kt + 4);
            __syncthreads();
        }
    }
#undef G_LOAD
#undef G_STORE
#undef G_COMPUTE
    epi(acc, wm * 64 + (lane & 15), wn * 64 + 4 * (lane >> 4));
}

constexpr int G2_BN = 256, G2_BBYTES = G2_BN * G_BK * 2, G2_BUF = G_ABYTES + G2_BBYTES;

struct RowLinear { int m0; __device__ __forceinline__ int src(int r) const { return m0 + r; } };
struct RowList {
    const int* list; int cnt; int shift;
    __device__ __forceinline__ int src(int r) const { const int a = list[r < cnt ? r : 0]; return a >> shift; }
};
struct EpiStoreBf16 {
    bf16_t* C; int ldc; int m0; int n0; int N;
    template <int NI> __device__ __forceinline__ void operator()(const f32x4 (&acc)[4][NI], int rbase, int cbase) const {
#pragma unroll
        for (int mi = 0; mi < 4; ++mi) {
            bf16_t* rowp = C + (size_t)(m0 + rbase + mi * 16) * ldc + n0 + cbase;
#pragma unroll
            for (int ni = 0; ni < NI; ++ni) {
                if (n0 + cbase + ni * 16 < N) { u32x2 v; v.x = pk2(acc[mi][ni][0], acc[mi][ni][1]); v.y = pk2(acc[mi][ni][2], acc[mi][ni][3]); *(u32x2*)(rowp + ni * 16) = v; }
            }
        }
    }
};
struct EpiSwiGLU {
    bf16_t* H; const int* list; int cnt; int n0;
    template <int NI> __device__ __forceinline__ void operator()(const f32x4 (&acc)[4][NI], int rbase, int cbase) const {
#pragma unroll
        for (int mi = 0; mi < 4; ++mi) {
            const int r = rbase + mi * 16;
            if (r < cnt) {
                const int a = list[r];
                const int wnb = cbase & ~63, q4 = cbase & 63;
                bf16_t* rowp = H + (size_t)a * DEXP + ((n0 + wnb) >> 1) + q4;
#pragma unroll
                for (int q = 0; q < NI / 2; ++q) {
                    float o[4];
#pragma unroll
                    for (int j = 0; j < 4; ++j) o[j] = siluf_(acc[mi][2 * q][j]) * acc[mi][2 * q + 1][j];
                    u32x2 v; v.x = pk2(o[0], o[1]); v.y = pk2(o[2], o[3]); *(u32x2*)(rowp + q * 16) = v;
                }
            }
        }
    }
};
struct EpiScatterBf16 {
    bf16_t* C; const int* list; int cnt; int n0;
    template <int NI> __device__ __forceinline__ void operator()(const f32x4 (&acc)[4][NI], int rbase, int cbase) const {
#pragma unroll
        for (int mi = 0; mi < 4; ++mi) {
            const int r = rbase + mi * 16;
            if (r < cnt) {
                bf16_t* rowp = C + (size_t)list[r] * D + n0 + cbase;
#pragma unroll
                for (int ni = 0; ni < NI; ++ni) { u32x2 v; v.x = pk2(acc[mi][ni][0], acc[mi][ni][1]); v.y = pk2(acc[mi][ni][2], acc[mi][ni][3]); *(u32x2*)(rowp + ni * 16) = v; }
            }
        }
    }
};
struct EpiDecay {
    float* Dc; const float* w0; int m0; int n0;
    template <int NI> __device__ __forceinline__ void operator()(const f32x4 (&acc)[4][NI], int rbase, int cbase) const {
#pragma unroll
        for (int ni = 0; ni < NI; ++ni) {
            const int col = n0 + cbase + ni * 16;
            const f32x4 w0v = *(const f32x4*)(w0 + col);
#pragma unroll
            for (int mi = 0; mi < 4; ++mi) {
                f32x4 o;
#pragma unroll
                for (int j = 0; j < 4; ++j) { const float w = w0v[j] + acc[mi][ni][j]; o[j] = __expf(-__expf(-softplus_fast(-w) - 0.5f)); }
                *(f32x4*)(Dc + (size_t)(m0 + rbase + mi * 16) * 512 + col) = o;
            }
        }
    }
};
struct EpiAK {
    bf16_t* Kb; const bf16_t* KKb; bf16_t* Bb; const float* a0; const float* k_a; int m0; int n0;
    template <int NI> __device__ __forceinline__ void operator()(const f32x4 (&acc)[4][NI], int rbase, int cbase) const {
#pragma unroll
        for (int ni = 0; ni < NI; ++ni) {
            const int col = n0 + cbase + ni * 16;
            const f32x4 a0v = *(const f32x4*)(a0 + col), kav = *(const f32x4*)(k_a + col);
#pragma unroll
            for (int mi = 0; mi < 4; ++mi) {
                const size_t off = (size_t)(m0 + rbase + mi * 16) * 512 + col;
                const u32x2 kr = *(const u32x2*)(Kb + off), kkr = *(const u32x2*)(KKb + off);
                const float kf[4] = {bflo(kr.x), bfhi(kr.x), bflo(kr.y), bfhi(kr.y)}, kkf[4] = {bflo(kkr.x), bfhi(kkr.x), bflo(kkr.y), bfhi(kkr.y)};
                float k2[4], bb[4];
#pragma unroll
                for (int j = 0; j < 4; ++j) { const float a = sigmoidf_(a0v[j] + acc[mi][ni][j]); k2[j] = kf[j] * (1.f + (a - 1.f) * kav[j]); bb[j] = kkf[j] * a; }
                u32x2 v; v.x = pk2(k2[0], k2[1]); v.y = pk2(k2[2], k2[3]); *(u32x2*)(Kb + off) = v;
                v.x = pk2(bb[0], bb[1]); v.y = pk2(bb[2], bb[3]); *(u32x2*)(Bb + off) = v;
            }
        }
    }
};

namespace pg8 {
#define PG8_LAS __attribute__((address_space(3)))
constexpr int BM = 256, BK = 64, HALF = 128, HTB = HALF * BK * 2, STAGE_BYTES = 8 * HTB, NXCD = 8, WGM = 8;
__host__ __device__ __forceinline__ int lds_byte(int r, int c) { const int st = (r >> 4) * 2 + (c >> 5), rr = r & 15, cc = c & 31, ob = rr * 64 + cc * 2; return st * 1024 + (ob ^ (((ob >> 9) & 1) << 5)); }
__host__ __device__ __forceinline__ void stage_rc(int b, int& R, int& C) { const int st = b / 1024, sb = b % 1024, swz = sb ^ (((sb >> 9) & 1) << 5); R = (st >> 1) * 16 + swz / 64; C = (st & 1) * 32 + (swz % 64) / 2; }
__host__ __device__ __forceinline__ int perm32(int rho) { const int n = rho >> 4, i = rho & 15; return 8 * (i >> 2) + 4 * n + (i & 3); }
struct Unit { int pm, pn; };
struct Gemm { const bf16_t* A; const bf16_t* Bt; int M, N, K; };
struct StaticOrder {
    int nM, nN, nwg, G, c;
    __host__ __device__ void init(int M, int N, int G_, int c_) { nM = M / BM; nN = N / BM; nwg = nM * nN; G = G_; c = c_; }
    __host__ __device__ bool next(int i, Unit& u) const {
        const long L = (long)i * G + c; if (L >= nwg) return false;
        int wgid = (int)L; { const int q = nwg / NXCD, r = nwg % NXCD, xcd = wgid % NXCD, off = wgid / NXCD; wgid = (xcd < r ? xcd * (q + 1) : r * (q + 1) + (xcd - r) * q) + off; }
        const int nig = WGM * nN, gid = wgid / nig, fm = gid * WGM, gsz = (nM - fm) < WGM ? (nM - fm) : WGM;
        u.pm = fm + ((wgid % nig) % gsz); u.pn = (wgid % nig) / gsz; return true;
    }
    __device__ __forceinline__ void a_ready(const Unit&) const {}
    __device__ __forceinline__ void done(const Unit&) const {}
};
struct EpiStoreP {
    static constexpr bool PERM = true, AFTER_DRAIN = false;
    bf16_t* O; int ldc;
    __device__ __forceinline__ void operator()(const f32x4 (&acc)[2][2][4][2], const Unit& u, int wr, int wc, int fr, int fq) const {
        const int row0 = u.pm * BM + wr * 64 + fr, col0 = u.pn * BM + wc * 32 + 8 * fq;
#pragma unroll
        for (int ai = 0; ai < 2; ++ai)
#pragma unroll
            for (int m = 0; m < 4; ++m) { bf16_t* rowp = O + (size_t)(row0 + ai * HALF + m * 16) * ldc + col0;
#pragma unroll
                for (int bj = 0; bj < 2; ++bj) { const f32x4 v0 = acc[ai][bj][m][0], v1 = acc[ai][bj][m][1];
                    u32x4 w; w.x = pk2(v0[0], v0[1]); w.y = pk2(v0[2], v0[3]); w.z = pk2(v1[0], v1[1]); w.w = pk2(v1[2], v1[3]);
                    *(u32x4*)(rowp + bj * HALF) = w; } }
    }
};
template <class Epi, class Sched>
__device__ __forceinline__ void gemm_phase(int wv, PG8_LAS unsigned char* lds, const Gemm g, const Sched& S, const Epi& E) {
    const int tid = ltid(wv), wid = __builtin_amdgcn_readfirstlane(tid >> 6), lane = tid & 63, wr = wid >> 2, wc = wid & 3, fr = lane & 15, fq = lane >> 4;
    const int K = g.K, nt = K / BK;
    unsigned voffA[2], voffB[2];
#pragma unroll
    for (int i = 0; i < 2; ++i) { int R, C; stage_rc(tid * 16 + i * 8192, R, C); const int Rb = Epi::PERM ? ((R & ~31) + perm32(R & 31)) : R;
        voffA[i] = (unsigned)(R * K + C) * 2u; voffB[i] = (unsigned)(Rb * K + C) * 2u; }
    const size_t kstep = (size_t)(BK * 2);
    const size_t hstep = (size_t)HALF * K * 2;
    const size_t tstep = 2 * hstep;
    const unsigned ldsw = (unsigned)wid * 1024u;
    const int aoff = lds_byte(wr * 64 + fr, fq * 8), boff = lds_byte(wc * 32 + fr, fq * 8);
#define PG8_SA(b, h) (((b) * 2 + (h)) * HTB)
#define PG8_SB(b, h) ((4 + (b) * 2 + (h)) * HTB)
#define PG8_STAGE(bufoff, gbase, voff) do { _Pragma("unroll") for (int _i = 0; _i < 2; ++_i) \
        __builtin_amdgcn_global_load_lds((const unsigned*)((const char*)(gbase) + (voff)[_i]), (PG8_LAS unsigned*)(lds + (bufoff) + ldsw + _i * 8192), 16, 0, 0); } while (0)
#define PG8_LDA(dst, b, h) do { _Pragma("unroll") for (int m = 0; m < 4; ++m) _Pragma("unroll") for (int k = 0; k < 2; ++k) dst[m][k] = *(const PG8_LAS bf16x8*)(lds + PG8_SA(b, h) + aoff + m * 2048 + k * 1024); } while (0)
#define PG8_LDB(dst, b, h) do { _Pragma("unroll") for (int n = 0; n < 2; ++n) _Pragma("unroll") for (int k = 0; k < 2; ++k) dst[n][k] = *(const PG8_LAS bf16x8*)(lds + PG8_SB(b, h) + boff + n * 2048 + k * 1024); } while (0)
#define PG8_MMA(ai, bj, At, Bt) do { __builtin_amdgcn_s_setprio(1); _Pragma("unroll") for (int m = 0; m < 4; ++m) _Pragma("unroll") for (int n = 0; n < 2; ++n) _Pragma("unroll") for (int k = 0; k < 2; ++k) \
        acc[ai][bj][m][n] = __builtin_amdgcn_mfma_f32_16x16x32_bf16(Bt[n][k], At[m][k], acc[ai][bj][m][n], 0, 0, 0); __builtin_amdgcn_s_setprio(0); } while (0)
#define PG8_WAIT_V(n) asm volatile("s_waitcnt vmcnt(" #n ")" ::: "memory")
#define PG8_WAIT_L(n) asm volatile("s_waitcnt lgkmcnt(" #n ")" ::: "memory")
#define PG8_BAR __builtin_amdgcn_s_barrier()
#define PG8_SCHED __builtin_amdgcn_sched_barrier(0)
    Unit cur, nxt; int ui = 0;
    if (!S.next(0, cur)) return;
    f32x4 acc[2][2][4][2];
#pragma unroll
    for (int a = 0; a < 2; ++a)
#pragma unroll
        for (int b = 0; b < 2; ++b)
#pragma unroll
            for (int m = 0; m < 4; ++m)
#pragma unroll
                for (int n = 0; n < 2; ++n) acc[a][b][m][n] = (f32x4){0.f, 0.f, 0.f, 0.f};
    bf16x8 At[4][2], B0[2][2], B1[2][2];
    const char* cA = (const char*)g.A + (size_t)cur.pm * tstep; const char* cB = (const char*)g.Bt + (size_t)cur.pn * tstep;
    S.a_ready(cur);
    PG8_STAGE(PG8_SB(0, 0), cB, voffB); PG8_STAGE(PG8_SA(0, 0), cA, voffA); PG8_STAGE(PG8_SB(0, 1), cB + hstep, voffB); PG8_STAGE(PG8_SA(0, 1), cA + hstep, voffA);
    if (wr == 1) PG8_BAR;
    PG8_WAIT_V(4); PG8_BAR;
    PG8_STAGE(PG8_SB(1, 0), cB + kstep, voffB); PG8_STAGE(PG8_SA(1, 0), cA + kstep, voffA); PG8_STAGE(PG8_SB(1, 1), cB + hstep + kstep, voffB);
    PG8_WAIT_V(6); PG8_BAR;
    for (;;) {
        const bool has_next = S.next(ui + 1, nxt);
        const char* nA = has_next ? (const char*)g.A + (size_t)nxt.pm * tstep : cA; const char* nB = has_next ? (const char*)g.Bt + (size_t)nxt.pn * tstep : cB;
        for (int t = 0; t < nt; t += 2) {
            const bool last = (t == nt - 2);
            const char* a1 = cA + (size_t)(t + 1) * kstep;
            const char* a2 = last ? nA : cA + (size_t)(t + 2) * kstep; const char* b2 = last ? nB : cB + (size_t)(t + 2) * kstep;
            const char* a3 = a2 + kstep; const char* b3 = b2 + kstep;
            if (last && has_next) S.a_ready(nxt);
            PG8_LDB(B0, 0, 0); PG8_SCHED; PG8_LDA(At, 0, 0); PG8_STAGE(PG8_SA(1, 1), a1 + hstep, voffA);
            PG8_WAIT_L(8); PG8_BAR; PG8_WAIT_L(0); PG8_MMA(0, 0, At, B0); PG8_BAR; PG8_SCHED;
            PG8_LDB(B1, 0, 1); PG8_STAGE(PG8_SB(0, 0), b2, voffB);
            PG8_BAR; PG8_WAIT_L(0); PG8_MMA(0, 1, At, B1); PG8_BAR;
            PG8_LDA(At, 0, 1); PG8_STAGE(PG8_SA(0, 0), a2, voffA);
            PG8_BAR; PG8_WAIT_L(0); PG8_MMA(1, 0, At, B0); PG8_BAR; PG8_SCHED;
            PG8_STAGE(PG8_SB(0, 1), b2 + hstep, voffB);
            PG8_WAIT_V(6); PG8_BAR; PG8_MMA(1, 1, At, B1); PG8_BAR;
            PG8_LDB(B0, 1, 0); PG8_SCHED; PG8_LDA(At, 1, 0); PG8_STAGE(PG8_SA(0, 1), a2 + hstep, voffA);
            PG8_WAIT_L(8); PG8_BAR; PG8_WAIT_L(0); PG8_MMA(0, 0, At, B0); PG8_BAR; PG8_SCHED;
            PG8_LDB(B1, 1, 1); PG8_STAGE(PG8_SB(1, 0), b3, voffB);
            PG8_BAR; PG8_WAIT_L(0); PG8_MMA(0, 1, At, B1); PG8_BAR;
            PG8_LDA(At, 1, 1); PG8_STAGE(PG8_SA(1, 0), a3, voffA);
            PG8_BAR; PG8_WAIT_L(0); PG8_MMA(1, 0, At, B0); PG8_BAR; PG8_SCHED;
            PG8_STAGE(PG8_SB(1, 1), b3 + hstep, voffB);
            PG8_WAIT_V(6); PG8_BAR; PG8_MMA(1, 1, At, B1); PG8_BAR;
        }
            if constexpr (!Epi::AFTER_DRAIN) { E(acc, cur, wr, wc, fr, fq); S.done(cur); }
            if (!has_next) break;
#pragma unroll
        for (int a = 0; a < 2; ++a)
#pragma unroll
            for (int b = 0; b < 2; ++b)
#pragma unroll
                for (int m = 0; m < 4; ++m)
#pragma unroll
                    for (int n = 0; n < 2; ++n) acc[a][b][m][n] = (f32x4){0.f, 0.f, 0.f, 0.f};
        cur = nxt; cA = nA; cB = nB; ++ui;
    }
    PG8_WAIT_V(0);
    if (wr == 0) PG8_BAR;
    PG8_BAR;
    if constexpr (Epi::AFTER_DRAIN) { E.fused(acc, cur, wr, wc, fr, fq, lds, wid, lane); S.done(cur); }
#undef PG8_SA
#undef PG8_SB
#undef PG8_STAGE
#undef PG8_LDA
#undef PG8_LDB
#undef PG8_MMA
#undef PG8_WAIT_V
#undef PG8_WAIT_L
#undef PG8_BAR
#undef PG8_SCHED
}
struct UnitG { int pm, pn; const char* bbase; const PG8_LAS int* ltab; int cnt; int e; };
struct MoeOrder {
    const PG8_LAS int* tstart; const PG8_LAS int* tcnt; const PG8_LAS int* ltabs; const int* lists; const char* bt; size_t estride; int ncol, shift, G, c;
    __device__ __forceinline__ bool next(int i, UnitG& u) const {
        const int t = i * G + c; if (t >= tstart[32] * ncol) return false;
        const int tm = t / ncol; int e = 0;
#pragma unroll 1
        while (tstart[e + 1] <= tm) ++e;
        e = __builtin_amdgcn_readfirstlane(e);
        const int ts = __builtin_amdgcn_readfirstlane(tstart[e]), tc = __builtin_amdgcn_readfirstlane(tcnt[e]);
        u.pm = tm - ts; u.pn = t - tm * ncol; u.bbase = bt + (size_t)e * estride; u.e = e; u.cnt = tc - u.pm * BM; u.ltab = ltabs + i * BM;
        return true;
    }
    __device__ __forceinline__ void a_ready(const UnitG&) const {}
    __device__ __forceinline__ void done(const UnitG&) const {}
};
struct EpiSwiGLUG {
    static constexpr bool PERM = false, AFTER_DRAIN = false;
    bf16_t* H;
    __device__ __forceinline__ void operator()(const f32x4 (&acc)[2][2][4][2], const UnitG& u, int wr, int wc, int fr, int fq) const {
#pragma unroll
        for (int ai = 0; ai < 2; ++ai)
#pragma unroll
            for (int m = 0; m < 4; ++m) { const int r = ai * HALF + wr * 64 + m * 16 + fr;
                if (r < u.cnt) { bf16_t* rowp = H + (size_t)u.ltab[r] * DEXP + ((u.pn * BM + wc * 32) >> 1) + 4 * fq;
#pragma unroll
                    for (int bj = 0; bj < 2; ++bj) { const f32x4 gt = acc[ai][bj][m][0], up = acc[ai][bj][m][1];
                        u32x2 w; w.x = pk2(siluf_(gt[0]) * up[0], siluf_(gt[1]) * up[1]); w.y = pk2(siluf_(gt[2]) * up[2], siluf_(gt[3]) * up[3]);
                        *(u32x2*)(rowp + bj * (HALF / 2)) = w; } } }
    }
};
struct EpiScatterG {
    static constexpr bool PERM = true, AFTER_DRAIN = false;
    bf16_t* O;
    __device__ __forceinline__ void operator()(const f32x4 (&acc)[2][2][4][2], const UnitG& u, int wr, int wc, int fr, int fq) const {
#pragma unroll
        for (int ai = 0; ai < 2; ++ai)
#pragma unroll
            for (int m = 0; m < 4; ++m) { const int r = ai * HALF + wr * 64 + m * 16 + fr;
                if (r < u.cnt) { bf16_t* rowp = O + (size_t)u.ltab[r] * D + u.pn * BM + wc * 32 + 8 * fq;
#pragma unroll
                    for (int bj = 0; bj < 2; ++bj) { const f32x4 v0 = acc[ai][bj][m][0], v1 = acc[ai][bj][m][1];
                        u32x4 w; w.x = pk2(v0[0], v0[1]); w.y = pk2(v0[2], v0[3]); w.z = pk2(v1[0], v1[1]); w.w = pk2(v1[2], v1[3]);
                        *(u32x4*)(rowp + bj * HALF) = w; } } }
    }
};
template <class Epi, class Sched>
__device__ __forceinline__ void gemm_phase_g(int wv, PG8_LAS unsigned char* lds, const Gemm g, const Sched& S, const Epi& E) {
    const int tid = ltid(wv), wid = __builtin_amdgcn_readfirstlane(tid >> 6), lane = tid & 63, wr = wid >> 2, wc = wid & 3, fr = lane & 15, fq = lane >> 4;
    const int K = g.K, nt = K / BK;
    unsigned voffB[2];
#pragma unroll
    for (int i = 0; i < 2; ++i) { int R, C; stage_rc(tid * 16 + i * 8192, R, C); const int Rb = Epi::PERM ? ((R & ~31) + perm32(R & 31)) : R;
        voffB[i] = (unsigned)(Rb * K + C) * 2u; }
    const unsigned rowb = (unsigned)K * 2u;
#define PG8_AOFFS(u, dst) do { const int _t = ltid(wv); _Pragma("unroll") for (int _i = 0; _i < 2; ++_i) { int _R, _C; stage_rc(_t * 16 + _i * 8192, _R, _C); \
        _Pragma("unroll") for (int _h = 0; _h < 2; ++_h) dst[_h][_i] = (unsigned)((u).ltab[_h * HALF + _R] >> S.shift) * rowb + (unsigned)(_C * 2); } } while (0)
#define PG8_STAGE_A(bufoff, AO, koff) do { _Pragma("unroll") for (int _i = 0; _i < 2; ++_i) \
        __builtin_amdgcn_global_load_lds((const unsigned*)((const char*)g.A + (size_t)(AO)[_i] + (size_t)(koff)), (PG8_LAS unsigned*)(lds + (bufoff) + ldsw + _i * 8192), 16, 0, 0); } while (0)
    const size_t kstep = (size_t)(BK * 2);
    const size_t hstep = (size_t)HALF * K * 2;
    const size_t tstep = 2 * hstep;
    const unsigned ldsw = (unsigned)wid * 1024u;
    const int aoff = lds_byte(wr * 64 + fr, fq * 8), boff = lds_byte(wc * 32 + fr, fq * 8);
#define PG8_SA(b, h) (((b) * 2 + (h)) * HTB)
#define PG8_SB(b, h) ((4 + (b) * 2 + (h)) * HTB)
#define PG8_STAGE(bufoff, gbase, voff) do { _Pragma("unroll") for (int _i = 0; _i < 2; ++_i) \
        __builtin_amdgcn_global_load_lds((const unsigned*)((const char*)(gbase) + (voff)[_i]), (PG8_LAS unsigned*)(lds + (bufoff) + ldsw + _i * 8192), 16, 0, 0); } while (0)
#define PG8_LDA(dst, b, h) do { _Pragma("unroll") for (int m = 0; m < 4; ++m) _Pragma("unroll") for (int k = 0; k < 2; ++k) dst[m][k] = *(const PG8_LAS bf16x8*)(lds + PG8_SA(b, h) + aoff + m * 2048 + k * 1024); } while (0)
#define PG8_LDB(dst, b, h) do { _Pragma("unroll") for (int n = 0; n < 2; ++n) _Pragma("unroll") for (int k = 0; k < 2; ++k) dst[n][k] = *(const PG8_LAS bf16x8*)(lds + PG8_SB(b, h) + boff + n * 2048 + k * 1024); } while (0)
#define PG8_MMA(ai, bj, At, Bt) do { __builtin_amdgcn_s_setprio(1); _Pragma("unroll") for (int m = 0; m < 4; ++m) _Pragma("unroll") for (int n = 0; n < 2; ++n) _Pragma("unroll") for (int k = 0; k < 2; ++k) \
        acc[ai][bj][m][n] = __builtin_amdgcn_mfma_f32_16x16x32_bf16(Bt[n][k], At[m][k], acc[ai][bj][m][n], 0, 0, 0); __builtin_amdgcn_s_setprio(0); } while (0)
#define PG8_WAIT_V(n) asm volatile("s_waitcnt vmcnt(" #n ")" ::: "memory")
#define PG8_WAIT_L(n) asm volatile("s_waitcnt lgkmcnt(" #n ")" ::: "memory")
#define PG8_BAR __builtin_amdgcn_s_barrier()
#define PG8_SCHED __builtin_amdgcn_sched_barrier(0)
    UnitG cur, nxt; int ui = 0;
    if (!S.next(0, cur)) return;
    f32x4 acc[2][2][4][2];
#pragma unroll
    for (int a = 0; a < 2; ++a)
#pragma unroll
        for (int b = 0; b < 2; ++b)
#pragma unroll
            for (int m = 0; m < 4; ++m)
#pragma unroll
                for (int n = 0; n < 2; ++n) acc[a][b][m][n] = (f32x4){0.f, 0.f, 0.f, 0.f};
    bf16x8 At[4][2], B0[2][2], B1[2][2];
    unsigned ca[2][2]; PG8_AOFFS(cur, ca); const char* cB = cur.bbase + (size_t)cur.pn * tstep;
    S.a_ready(cur);
    PG8_STAGE(PG8_SB(0, 0), cB, voffB); PG8_STAGE_A(PG8_SA(0, 0), ca[0], 0); PG8_STAGE(PG8_SB(0, 1), cB + hstep, voffB); PG8_STAGE_A(PG8_SA(0, 1), ca[1], 0);
    if (wr == 1) PG8_BAR;
    PG8_WAIT_V(4); PG8_BAR;
    PG8_STAGE(PG8_SB(1, 0), cB + kstep, voffB); PG8_STAGE_A(PG8_SA(1, 0), ca[0], kstep); PG8_STAGE(PG8_SB(1, 1), cB + hstep + kstep, voffB);
    PG8_WAIT_V(6); PG8_BAR;
    for (;;) {
        const bool has_next = S.next(ui + 1, nxt);
        const char* nB = has_next ? nxt.bbase + (size_t)nxt.pn * tstep : cB;
        for (int t = 0; t < nt; t += 2) {
            const bool last = (t == nt - 2);
            const size_t k1 = (size_t)(t + 1) * kstep, k2 = last ? 0 : (size_t)(t + 2) * kstep;
            unsigned a2o[2][2];
            if (last && has_next) PG8_AOFFS(nxt, a2o); else { a2o[0][0] = ca[0][0]; a2o[0][1] = ca[0][1]; a2o[1][0] = ca[1][0]; a2o[1][1] = ca[1][1]; }
            const char* b2 = last ? nB : cB + (size_t)(t + 2) * kstep; const char* b3 = b2 + kstep;
            if (last && has_next) S.a_ready(nxt);
            PG8_LDB(B0, 0, 0); PG8_SCHED; PG8_LDA(At, 0, 0); PG8_STAGE_A(PG8_SA(1, 1), ca[1], k1);
            PG8_WAIT_L(8); PG8_BAR; PG8_WAIT_L(0); PG8_MMA(0, 0, At, B0); PG8_BAR; PG8_SCHED;
            PG8_LDB(B1, 0, 1); PG8_STAGE(PG8_SB(0, 0), b2, voffB);
            PG8_BAR; PG8_WAIT_L(0); PG8_MMA(0, 1, At, B1); PG8_BAR;
            PG8_LDA(At, 0, 1); PG8_STAGE_A(PG8_SA(0, 0), a2o[0], k2);
            PG8_BAR; PG8_WAIT_L(0); PG8_MMA(1, 0, At, B0); PG8_BAR; PG8_SCHED;
            PG8_STAGE(PG8_SB(0, 1), b2 + hstep, voffB);
            PG8_WAIT_V(6); PG8_BAR; PG8_MMA(1, 1, At, B1); PG8_BAR;
            PG8_LDB(B0, 1, 0); PG8_SCHED; PG8_LDA(At, 1, 0); PG8_STAGE_A(PG8_SA(0, 1), a2o[1], k2);
            PG8_WAIT_L(8); PG8_BAR; PG8_WAIT_L(0); PG8_MMA(0, 0, At, B0); PG8_BAR; PG8_SCHED;
            PG8_LDB(B1, 1, 1); PG8_STAGE(PG8_SB(1, 0), b3, voffB);
            PG8_BAR; PG8_WAIT_L(0); PG8_MMA(0, 1, At, B1); PG8_BAR;
            PG8_LDA(At, 1, 1); PG8_STAGE_A(PG8_SA(1, 0), a2o[0], k2 + kstep);
            PG8_BAR; PG8_WAIT_L(0); PG8_MMA(1, 0, At, B0); PG8_BAR; PG8_SCHED;
            PG8_STAGE(PG8_SB(1, 1), b3 + hstep, voffB);
            PG8_WAIT_V(6); PG8_BAR; PG8_MMA(1, 1, At, B1); PG8_BAR;
            if (last) { ca[0][0] = a2o[0][0]; ca[0][1] = a2o[0][1]; ca[1][0] = a2o[1][0]; ca[1][1] = a2o[1][1]; }
        }
            if constexpr (!Epi::AFTER_DRAIN) { E(acc, cur, wr, wc, fr, fq); S.done(cur); }
            if (!has_next) break;
#pragma unroll
        for (int a = 0; a < 2; ++a)
#pragma unroll
            for (int b = 0; b < 2; ++b)
#pragma unroll
                for (int m = 0; m < 4; ++m)
#pragma unroll
                    for (int n = 0; n < 2; ++n) acc[a][b][m][n] = (f32x4){0.f, 0.f, 0.f, 0.f};
        cur = nxt; cB = nB; ++ui;
    }
    PG8_WAIT_V(0);
    if (wr == 0) PG8_BAR;
    PG8_BAR;
    if constexpr (Epi::AFTER_DRAIN) { E.fused(acc, cur, wr, wc, fr, fq, lds, wid, lane); S.done(cur); }
#undef PG8_SA
#undef PG8_AOFFS
#undef PG8_STAGE_A
#undef PG8_SB
#undef PG8_STAGE
#undef PG8_LDA
#undef PG8_LDB
#undef PG8_MMA
#undef PG8_WAIT_V
#undef PG8_WAIT_L
#undef PG8_BAR
#undef PG8_SCHED
}
}

__device__ __forceinline__ void transpose_item(const float* __restrict__ W, int K, int N, bf16_t* __restrict__ WT, int mode, LAS float* scr, int item, int lane) {
    const int nblk = N / 32, kb = item / nblk, nb = item % nblk, k0 = 64 * kb, n0 = 32 * nb;
#pragma unroll 8
    for (int i = 0; i < 32; ++i) { const int kk = 2 * i + (lane >> 5); scr[kk * 33 + (lane & 31)] = W[(size_t)(k0 + kk) * N + n0 + (lane & 31)]; }
    asm volatile("s_waitcnt lgkmcnt(0)" ::: "memory");
    const int c = lane & 7;
#pragma unroll
    for (int j = 0; j < 4; ++j) {
        const int nl = (lane >> 3) + 8 * j; const LAS float* s = scr + (8 * c) * 33 + nl;
        u32x4 o; o.x = pk2(s[0 * 33], s[1 * 33]); o.y = pk2(s[2 * 33], s[3 * 33]); o.z = pk2(s[4 * 33], s[5 * 33]); o.w = pk2(s[6 * 33], s[7 * 33]);
        const int n = n0 + nl;
        const int nd = mode == 0 ? n : (32 * (n >> 4) + (n & 15) + (mode == 2 ? 16 : 0));
        *(u32x4*)(WT + (size_t)nd * K + k0 + 8 * c) = o;
    }
    asm volatile("s_waitcnt lgkmcnt(0)" ::: "memory");
}

__device__ __forceinline__ void phase_prologue0(int wv, KP Pk, LAS char* lds) {
    asm volatile("" : "+s"(Pk));
    const CAS Params& P = *Pk;
    const int tid = ltid(wv), lane = tid & 63, wid = tid >> 6;
    const int gw = blockIdx.x * 8 + wid, NGW = gridDim.x * 8;
    LAS float* scr = (LAS float*)(lds + wid * 8448);
    bf16_t* winT = (bf16_t*)(P.ws + WS_WINT);
    bf16_t* woutT = (bf16_t*)(P.ws + WS_WOUTT);
    bf16_t* loraT = (bf16_t*)(P.ws + WS_LORAT);
    constexpr int I_EV = 16 * (P_EVEN / 32), I_OD = 16 * (P_ODD / 32), I_O = 16 * 32, I_L64 = 16, I_L128 = 32;
    constexpr int I_LORA = 3 * I_L64 + I_L128;
    constexpr int NIT = 2 * I_EV + 2 * I_OD + 4 * I_O + 2 * I_LORA;
    for (int it = gw; it < NIT; it += NGW) {
        int r = it;
        if (r < 2 * I_EV) { const int i = r / I_EV; transpose_item(P.ev_w_in + (size_t)i * D * P_EVEN, D, P_EVEN, winT + (i ? WINT_L2 : WINT_L0), 0, scr, r % I_EV, lane); continue; } r -= 2 * I_EV;
        if (r < 2 * I_OD) { const int i = r / I_OD; transpose_item(P.od_w_in + (size_t)i * D * P_ODD, D, P_ODD, winT + (i ? WINT_L3 : WINT_L1), 0, scr, r % I_OD, lane); continue; } r -= 2 * I_OD;
        if (r < 4 * I_O) { const int l = r / I_O; const float* src = (l & 1) ? P.od_w_out + (size_t)(l >> 1) * D * D : P.ev_w_out + (size_t)(l >> 1) * D * D;
            transpose_item(src, D, D, woutT + (size_t)l * D * D, 0, scr, r % I_O, lane); continue; } r -= 4 * I_O;
        { const int i = r / I_LORA; int q = r % I_LORA; bf16_t* dst = loraT + (size_t)i * LORA_PER;
          if (q < I_L64) { transpose_item(P.rw_w2 + (size_t)(i * 2 + 0) * 64 * 512, 64, 512, dst, 0, scr, q, lane); continue; } q -= I_L64;
          if (q < I_L64) { transpose_item(P.rw_w2 + (size_t)(i * 2 + 1) * 64 * 512, 64, 512, dst + 512 * 64, 0, scr, q, lane); continue; } q -= I_L64;
          if (q < I_L64) { transpose_item(P.rw_a2 + (size_t)i * 64 * 512, 64, 512, dst + 2 * 512 * 64, 0, scr, q, lane); continue; } q -= I_L64;
          transpose_item(P.rw_g2 + (size_t)i * 128 * 512, 128, 512, dst + 3 * 512 * 64, 0, scr, q, lane); }
    }
    {
        const int gt = blockIdx.x * NT + tid, NG = gridDim.x * NT;
        constexpr int PADE = (LDP_EVEN - P_EVEN) * D / 8, PADO = (LDP_ODD - P_ODD) * D / 8;
        for (int i = gt; i < 2 * PADE + 2 * PADO; i += NG) {
            int r = i; bf16_t* dst;
            if (r < 2 * PADE) { const int l = r / PADE; dst = winT + (l ? WINT_L2 : WINT_L0) + (size_t)P_EVEN * D + (size_t)(r % PADE) * 8; }
            else { r -= 2 * PADE; const int l = r / PADO; dst = winT + (l ? WINT_L3 : WINT_L1) + (size_t)P_ODD * D + (size_t)(r % PADO) * 8; }
            *(u32x4*)dst = (u32x4){0u, 0u, 0u, 0u};
        }
    }
    {
        const int gt = blockIdx.x * NT + tid, NG = gridDim.x * NT;
        float* lb = (float*)(P.ws + WS_LB);
        for (int ch = gt; ch < 512; ch += NG) {
            float lg[4], mx = -1e30f;
#pragma unroll
            for (int l = 0; l < 4; ++l) { lg[l] = P.hg_lb_logits[l * 512 + ch]; mx = fmaxf(mx, lg[l]); }
            float e[4], s = 0.f;
#pragma unroll
            for (int l = 0; l < 4; ++l) { e[l] = __expf(lg[l] - mx); s += e[l]; }
            float cum = 0.f;
#pragma unroll
            for (int l = 0; l < 4; ++l) { if (l > 0) cum += e[l] / s; lb[l * 512 + ch] = cum; }
        }
    }
    __syncthreads();
    {
        LAS float* sc = (LAS float*)lds;
        LAS float* red = (LAS float*)(lds + 5 * 1024 * 4);
        for (int i = tid; i < 5 * D; i += NT) { const int m = i >> 10, k = i & 1023; const float v = m < 4 ? P.c[m * D + k] : P.c_ctx[k]; sc[i] = siluf_(v); }
        __syncthreads();
        float* modv = (float*)(P.ws + WS_MODV);
        const int col = tid & 127, kq = tid >> 7;
        for (int item = blockIdx.x; item < 4 * 48; item += gridDim.x) {
            const int l = item / 48, j = (item % 48) * 128 + col;
            const float* w = P.mod_w + (size_t)l * D * 6144 + j;
            float a[5] = {0.f, 0.f, 0.f, 0.f, 0.f};
#pragma unroll 8
            for (int k = kq * 256; k < kq * 256 + 256; ++k) {
                const float wv = w[(size_t)k * 6144];
#pragma unroll
                for (int m = 0; m < 5; ++m) a[m] += sc[m * 1024 + k] * wv;
            }
#pragma unroll
            for (int m = 0; m < 5; ++m) red[(kq * 128 + col) * 5 + m] = a[m];
            __syncthreads();
            if (kq == 0) {
                const float bias = P.mod_b[l * 6144 + j];
#pragma unroll
                for (int m = 0; m < 5; ++m) {
                    const float s = red[(0 * 128 + col) * 5 + m] + red[(1 * 128 + col) * 5 + m] + red[(2 * 128 + col) * 5 + m] + red[(3 * 128 + col) * 5 + m];
                    modv[(size_t)(l * 5 + m) * 6144 + j] = s + bias;
                }
            }
            __syncthreads();
        }
    }
}

__device__ __forceinline__ void phase_prologue1(int wv, KP Pk) {
    asm volatile("" : "+s"(Pk));
    const CAS Params& P = *Pk;
    const int tid = ltid(wv), lane = tid & 63, wid = tid >> 6;
    bf16_t* act = (bf16_t*)(P.ws + WS_ACT);
    for (int r = blockIdx.x * 8 + wid; r < NROWS; r += gridDim.x * 8) {
        const int m = row_mod(r);
        const float* src = r < NCTX ? P.ctx + (size_t)r * D : P.x + (size_t)(r - NCTX) * D;
        const float* sh = modvec(P.ws, 0, m, 0); const float* sc = modvec(P.ws, 0, m, 1);
#pragma unroll
        for (int i = 0; i < 4; ++i) {
            const int c = 4 * lane + 256 * i;
            const f32x4 v = *(const f32x4*)(src + c), s1 = *(const f32x4*)(sc + c), h1 = *(const f32x4*)(sh + c);
            u32x2 o; o.x = pk2(v[0] * (1.f + s1[0]) + h1[0], v[1] * (1.f + s1[1]) + h1[1]); o.y = pk2(v[2] * (1.f + s1[2]) + h1[2], v[3] * (1.f + s1[3]) + h1[3]);
            *(u32x2*)(act + (size_t)r * D + c) = o;
        }
    }
}

__device__ __forceinline__ void phase_inproj(int wv, KP Pk, int layer, LAS char* lds) {
    asm volatile("" : "+s"(Pk));
    const CAS Params& P = *Pk;
    const int odd = layer & 1, ldp = odd ? LDP_ODD : LDP_EVEN;
    const size_t woff = layer == 0 ? WINT_L0 : layer == 1 ? WINT_L1 : layer == 2 ? WINT_L2 : WINT_L3;
    pg8::Gemm g{(const bf16_t*)(P.ws + WS_ACT), (const bf16_t*)(P.ws + WS_WINT) + woff, NROWS, ldp, D};
    pg8::StaticOrder S; S.init(NROWS, ldp, (int)gridDim.x, (int)blockIdx.x);
    pg8::EpiStoreP E{(bf16_t*)(P.ws + WS_P), ldp};
    pg8::gemm_phase(wv, (PG8_LAS unsigned char*)lds, g, S, E);
}
__device__ __forceinline__ void phase_outproj(int wv, KP Pk, int layer, LAS char* lds) {
    asm volatile("" : "+s"(Pk));
    const CAS Params& P = *Pk;
    const int r0 = (layer == DEPTH - 1) ? NCTX : 0;
    pg8::Gemm g{(const bf16_t*)(P.ws + WS_FEAT) + (size_t)r0 * D, (const bf16_t*)(P.ws + WS_WOUTT) + (size_t)layer * D * D, NROWS - r0, D, D};
    pg8::StaticOrder S; S.init(NROWS - r0, D, (int)gridDim.x, (int)blockIdx.x);
    pg8::EpiStoreP E{(bf16_t*)(P.ws + WS_YO) + (size_t)r0 * D, D};
    pg8::gemm_phase(wv, (PG8_LAS unsigned char*)lds, g, S, E);
}
__device__ __forceinline__ void phase_prep2(int wv, KP Pk, int layer, LAS char* lds) {
    asm volatile("" : "+s"(Pk));
    const CAS Params& P = *Pk;
    const int i = layer >> 1;
    const bf16_t* la = (const bf16_t*)(P.ws + WS_LA);
    const bf16_t* lt = (const bf16_t*)(P.ws + WS_LORAT) + (size_t)i * LORA_PER;
    constexpr int MT = NROWS / G_BM, NTL = 512 / G_BN;
    const int ntiles = 4 * MT * NTL;
    for (int t = blockIdx.x; t < ntiles; t += gridDim.x) {
        const int which = t / (MT * NTL), r = t % (MT * NTL), mt = r / NTL, nt = r % NTL;
        RowLinear rs{mt * G_BM};
        if (which < 2) {
            EpiDecay epi{(float*)(P.ws + WS_RWDEC) + (size_t)which * NROWS * 512, P.rw_w0 + (size_t)(i * 2 + which) * 512, mt * G_BM, nt * G_BN};
            gemm_tile(wv, la + which * 64, 320, rs, lt + (size_t)which * 512 * 64, 64, nt * G_BN, 64, epi, lds);
        } else if (which == 2) {
            EpiAK epi{(bf16_t*)(P.ws + WS_RWK), (const bf16_t*)(P.ws + WS_RWKK), (bf16_t*)(P.ws + WS_RWB), P.rw_a0 + i * 512, P.rw_k_a + i * 512, mt * G_BM, nt * G_BN};
            gemm_tile(wv, la + 128, 320, rs, lt + (size_t)2 * 512 * 64, 64, nt * G_BN, 64, epi, lds);
        } else {
            EpiStoreBf16 epi{(bf16_t*)(P.ws + WS_RWG), 512, mt * G_BM, nt * G_BN, 512};
            gemm_tile(wv, la + 192, 320, rs, lt + (size_t)3 * 512 * 64, 128, nt * G_BN, 128, epi, lds);
        }
    }
}
__device__ __forceinline__ void moe_tiles(int wv, const unsigned char* ws, int layer, LAS int* tstart, LAS int* tcnt) {
    const int tid = ltid(wv);
    if (tid < 64) {
        const int* cnt = (const int*)(ws + WS_CNT) + layer * 32 * CNT_STRIDE;
        const int c = tid < NEXP ? cnt[tid * CNT_STRIDE] : 0;
        int incl = (c + G_BM - 1) / G_BM;
#pragma unroll
        for (int o = 1; o < 32; o <<= 1) { const int t = __shfl_up(incl, o); if (tid >= o) incl += t; }
        if (tid < NEXP) { tcnt[tid] = c; tstart[tid] = incl - (c + G_BM - 1) / G_BM; }
        if (tid == NEXP - 1) tstart[NEXP] = incl;
    }
    __syncthreads();
}
__device__ __forceinline__ void phase_moe1(int wv, KP Pk, int layer, LAS char* lds) {
    asm volatile("" : "+s"(Pk));
    const CAS Params& P = *Pk;
    LAS int* tstart = (LAS int*)(lds + pg8::STAGE_BYTES); LAS int* tcnt = tstart + 40;
    moe_tiles(wv, P.ws, layer, tstart, tcnt);
    pg8::Gemm g{(const bf16_t*)(P.ws + WS_ACT), (const bf16_t*)(P.ws + WS_EXPGU), 0, 1024, D};
    LAS int* ltabs = tstart + 128;
    pg8::MoeOrder S{tstart, tcnt, ltabs, (const int*)(P.ws + WS_LIST), (const char*)(P.ws + WS_EXPGU), (size_t)1024 * 1024 * 2, 4, 1, (int)gridDim.x, (int)blockIdx.x};
    pg8::EpiSwiGLUG E{(bf16_t*)(P.ws + WS_HID)};
    for (int i = 0; i < 8; ++i) {
        pg8::UnitG u; if (!S.next(i, u)) break;
        const int tl = ltid(wv);
        const int* ul = (const int*)(P.ws + WS_LIST) + (size_t)u.e * LISTCAP + u.pm * pg8::BM;
        if (tl < pg8::BM) ltabs[i * pg8::BM + tl] = ul[tl < u.cnt ? tl : 0];
    }
    __syncthreads();
    pg8::gemm_phase_g(wv, (PG8_LAS unsigned char*)lds, g, S, E);
    __syncthreads();
}
__device__ __forceinline__ void phase_moe2(int wv, KP Pk, int layer, LAS char* lds) {
    asm volatile("" : "+s"(Pk));
    const CAS Params& P = *Pk;
    LAS int* tstart = (LAS int*)(lds + pg8::STAGE_BYTES); LAS int* tcnt = tstart + 40;
    moe_tiles(wv, P.ws, layer, tstart, tcnt);
    pg8::Gemm g{(const bf16_t*)(P.ws + WS_HID), (const bf16_t*)(P.ws + WS_EXPD), 0, 1024, DEXP};
    LAS int* ltabs = tstart + 128;
    pg8::MoeOrder S{tstart, tcnt, ltabs, (const int*)(P.ws + WS_LIST), (const char*)(P.ws + WS_EXPD), (size_t)1024 * 512 * 2, 4, 0, (int)gridDim.x, (int)blockIdx.x};
    pg8::EpiScatterG E{(bf16_t*)(P.ws + WS_YP)};
    for (int i = 0; i < 8; ++i) {
        pg8::UnitG u; if (!S.next(i, u)) break;
        const int tl = ltid(wv);
        const int* ul = (const int*)(P.ws + WS_LIST) + (size_t)u.e * LISTCAP + u.pm * pg8::BM;
        if (tl < pg8::BM) ltabs[i * pg8::BM + tl] = ul[tl < u.cnt ? tl : 0];
    }
    __syncthreads();
    pg8::gemm_phase_g(wv, (PG8_LAS unsigned char*)lds, g, S, E);
    __syncthreads();
}

constexpr int NCHUNK = NSTEPS / TCH;

constexpr int SSD_F = 32 + 64 + 64;
constexpr int SSD_BUF = TCH * SSD_F + 3 * TCH;

constexpr int ML_F = 64 + 64 + 32;
constexpr int ML_BUF = TCH * ML_F + 4 * TCH;

constexpr int HG_F = 128 + 128 + 32;
constexpr int HG_BUF = TCH * HG_F + TCH;

constexpr int RW_F = 5 * 64 + 32;
constexpr int RW_BUF = TCH * RW_F + TCH;
__device__ __forceinline__ void scan_rwkv(int wv, KP Pk, int layer, int unit, LAS char* lds) {
    asm volatile("" : "+s"(Pk));
    const CAS Params& P = *Pk;
    const int tid = ltid(wv);
    const int seq = unit >> 1, half = unit & 1, b = seq >> 4, h = (seq >> 1) & 7, dir = seq & 1;
    LAS float* bufs = (LAS float*)lds;
    bf16_t* Y = (bf16_t*)(P.ws + (dir ? WS_YB : WS_YF));
    const float* dec = (const float*)(P.ws + WS_RWDEC) + (size_t)dir * NROWS * 512;
    int tj[4], tg_[4]; bool tv[4]; const unsigned char* tbase[4]; int tlds[4];
#pragma unroll
    for (int s = 0; s < 4; ++s) {
        const int task = tid + NT * s; tv[s] = task < TCH * 52; tj[s] = task / 52; tg_[s] = task % 52;
        const int g = tg_[s];
        if (g < 8)       { tbase[s] = P.ws + WS_RWR  + (size_t)(h * 64 + 8 * g) * 2;              tlds[s] = 256 + 8 * g; }
        else if (g < 16) { tbase[s] = P.ws + WS_RWK  + (size_t)(h * 64 + 8 * (g - 8)) * 2;        tlds[s] = 192 + 8 * (g - 8); }
        else if (g < 24) { tbase[s] = P.ws + WS_RWKK + (size_t)(h * 64 + 8 * (g - 16)) * 2;       tlds[s] = 64 + 8 * (g - 16); }
        else if (g < 32) { tbase[s] = P.ws + WS_RWB  + (size_t)(h * 64 + 8 * (g - 24)) * 2;       tlds[s] = 128 + 8 * (g - 24); }
        else if (g < 36) { tbase[s] = P.ws + WS_RWV  + (size_t)(h * 64 + half * 32 + 8 * (g - 32)) * 2; tlds[s] = 320 + 8 * (g - 32); }
        else             { tbase[s] = (const unsigned char*)(dec + h * 64 + 4 * (g - 36));        tlds[s] = 4 * (g - 36); }
    }
    u32x4 rc[4]; int rrow = 0;
    auto load = [&](int c) {
#pragma unroll
        for (int s = 0; s < 4; ++s) {
            rc[s] = (u32x4){0u, 0u, 0u, 0u};
            if (tv[s]) { const int row = scan_row(c * TCH + tj[s], b, dir, 1); rc[s] = *(const u32x4*)(tbase[s] + (size_t)row * (tg_[s] < 36 ? 1024 : 2048)); }
        }
        if (tid < TCH) rrow = scan_row(c * TCH + tid, b, dir, 1);
    };
    auto store = [&](int c) {
        LAS float* buf = bufs + (c & 1) * RW_BUF;
#pragma unroll
        for (int s = 0; s < 4; ++s) {
            if (tv[s]) {
                LAS float* dst = buf + tj[s] * RW_F + tlds[s];
                const int g = tg_[s];
                if (g >= 36) { *(LAS u32x4*)dst = rc[s]; }
                else {
                    float f[8]; unpack8(rc[s], f);
                    const float sg = (g >= 16 && g < 24) ? -1.f : 1.f;
                    *(LAS f32x4*)dst = (f32x4){sg * f[0], sg * f[1], sg * f[2], sg * f[3]}; *(LAS f32x4*)(dst + 4) = (f32x4){sg * f[4], sg * f[5], sg * f[6], sg * f[7]};
                }
            }
        }
        if (tid < TCH) ((LAS int*)buf)[TCH * RW_F + tid] = rrow;
    };
    const int vrow = tid >> 4, q = tid & 15;
    float S[4] = {0.f, 0.f, 0.f, 0.f};
    load(0); store(0); __syncthreads();
    for (int c = 0; c < NCHUNK; ++c) {
        if (c + 1 < NCHUNK) load(c + 1);
        LAS float* buf = bufs + (c & 1) * RW_BUF;
        {
            const LAS float* wp = buf + 4 * q;
            const LAS float* vp = buf + 320 + vrow;
            f32x4 w4 = *(const LAS f32x4*)wp, a4 = *(const LAS f32x4*)(wp + 64), b4 = *(const LAS f32x4*)(wp + 128), k4 = *(const LAS f32x4*)(wp + 192), r4 = *(const LAS f32x4*)(wp + 256); float vr = vp[0];
#pragma unroll 1
            for (int jh = 0; jh < 2; ++jh) {
                float ysel = 0.f;
#pragma unroll
                for (int j = 0; j < 16; ++j) {
                    const int jj = jh * 16 + j;
                    const f32x4 wc = w4, ac = a4, bc = b4, kc = k4, rc = r4; const float vv = vr;
                    if (j < 15 || jh == 0) {
                        const LAS float* np = wp + (jj + 1) * RW_F;
                        w4 = *(const LAS f32x4*)np; a4 = *(const LAS f32x4*)(np + 64); b4 = *(const LAS f32x4*)(np + 128); k4 = *(const LAS f32x4*)(np + 192); r4 = *(const LAS f32x4*)(np + 256); vr = vp[(jj + 1) * RW_F];
                    }
                    float sa = S[0] * ac[0] + S[1] * ac[1] + S[2] * ac[2] + S[3] * ac[3];
                    sa = allreduce16(sa);
                    float y = 0.f;
#pragma unroll
                    for (int e = 0; e < 4; ++e) { S[e] = S[e] * wc[e] + (sa * bc[e] + vv * kc[e]); y += S[e] * rc[e]; }
                    y = allreduce16(y);
                    ysel = (q == j) ? y : ysel;
                }
                const int row = ((const LAS int*)buf)[TCH * RW_F + jh * 16 + q];
                Y[(size_t)row * D + 512 + h * 64 + half * 32 + vrow] = f2bf(ysel);
            }
        }
        if (c + 1 < NCHUNK) store(c + 1);
        __syncthreads();
    }
}

constexpr size_t WS_EXBC = WS_RWR;
constexpr size_t WS_EQK = WS_EXBC + (size_t)NROWS * 768 * 2;
constexpr size_t WS_EGT = WS_EQK + (size_t)NROWS * 512 * 2;
static_assert(WS_EGT + (size_t)NROWS * 32 * 4 <= WS_LA, "even-layer prepare buffers must fit in the RWKV region");

__device__ __forceinline__ void phase_prep_even(int wv, KP Pk, int layer) {
    asm volatile("" : "+s"(Pk));
    const CAS Params& P = *Pk;
    const int tid = ltid(wv), lane = tid & 63, wid = tid >> 6, i_ = layer >> 1;
    const bf16_t* Pb = (const bf16_t*)(P.ws + WS_P);
    bf16_t* XBC = (bf16_t*)(P.ws + WS_EXBC); bf16_t* QK = (bf16_t*)(P.ws + WS_EQK); float* GT = (float*)(P.ws + WS_EGT);
    float cw0[4][8], cw1[4][8], cwq[4][8];
#pragma unroll
    for (int e = 0; e < 8; ++e) {
#pragma unroll
        for (int t = 0; t < 3; ++t) {
            cw0[t][e] = P.ssd_conv_w[(size_t)(i_ * 3 + t) * 768 + 8 * lane + e];
            cw1[t][e] = P.ssd_conv_w[(size_t)(i_ * 3 + t) * 768 + 512 + 8 * (lane & 31) + e];
            cwq[t][e] = P.ml_conv_w[(size_t)(i_ * 3 + t) * 512 + 8 * lane + e];
        }
        cw0[3][e] = P.ssd_conv_b[i_ * 768 + 8 * lane + e]; cw1[3][e] = P.ssd_conv_b[i_ * 768 + 512 + 8 * (lane & 31) + e]; cwq[3][e] = P.ml_conv_b[i_ * 512 + 8 * lane + e];
    }
    float gbias = 0.f;
    if (lane < 16) gbias = P.ssd_dt_bias[i_ * 16 + lane]; else if (lane < 24) gbias = P.ml_i_bias[i_ * 8 + lane - 16]; else if (lane < 32) gbias = P.ml_f_bias[i_ * 8 + lane - 24];
    const float qscl = lane < 32 ? 0.125f : 1.f;
    for (int r = blockIdx.x * 8 + wid; r < NROWS; r += gridDim.x * 8) {
        int t, len; row_seg(r, t, len);
        const bf16_t* pr = Pb + (size_t)r * LDP_EVEN;
        const bool hp = t > 0, hn = t < len - 1;
        const u32x4 zero = (u32x4){0u, 0u, 0u, 0u};
        float fc[8], fp[8], fn[8], o[8];
        {
            const int col = 512 + 8 * lane;
            unpack8(*(const u32x4*)(pr + col), fc); unpack8(hp ? *(const u32x4*)(pr - LDP_EVEN + col) : zero, fp); unpack8(hn ? *(const u32x4*)(pr + LDP_EVEN + col) : zero, fn);
#pragma unroll
            for (int e = 0; e < 8; ++e) o[e] = siluf_(cw0[0][e] * fp[e] + cw0[1][e] * fc[e] + cw0[2][e] * fn[e] + cw0[3][e]);
            *(u32x4*)(XBC + (size_t)r * 768 + 8 * lane) = pack8(o);
        }
        if (lane < 32) {
            const int col = 1024 + 8 * lane;
            unpack8(*(const u32x4*)(pr + col), fc); unpack8(hp ? *(const u32x4*)(pr - LDP_EVEN + col) : zero, fp); unpack8(hn ? *(const u32x4*)(pr + LDP_EVEN + col) : zero, fn);
#pragma unroll
            for (int e = 0; e < 8; ++e) o[e] = siluf_(cw1[0][e] * fp[e] + cw1[1][e] * fc[e] + cw1[2][e] * fn[e] + cw1[3][e]);
            *(u32x4*)(XBC + (size_t)r * 768 + 512 + 8 * lane) = pack8(o);
        }
        {
            const int col = 1296 + 8 * lane;
            unpack8(*(const u32x4*)(pr + col), fc); unpack8(hp ? *(const u32x4*)(pr - LDP_EVEN + col) : zero, fp); unpack8(hn ? *(const u32x4*)(pr + LDP_EVEN + col) : zero, fn);
#pragma unroll
            for (int e = 0; e < 8; ++e) o[e] = qscl * siluf_(cwq[0][e] * fp[e] + cwq[1][e] * fc[e] + cwq[2][e] * fn[e] + cwq[3][e]);
            *(u32x4*)(QK + (size_t)r * 512 + 8 * lane) = pack8(o);
        }
        if (lane < 32) {
            const int col = lane < 16 ? 1280 + lane : 2832 + (lane - 16);
            const float x = bf2f(pr[col]) + gbias;
            GT[(size_t)r * 32 + lane] = lane < 16 ? softplusf_(x) : lane < 24 ? x : logsigmoidf_(x);
        }
    }
}

constexpr int CL = 64, NCH64 = NSTEPS / CL, LDT = 72, LDTB = LDT * 2;
__device__ __forceinline__ bf16x8 ldfrag(const LAS char* tile, int ldb, int row0, int k0, int lane) {
    return *(const LAS bf16x8*)(tile + (row0 + (lane & 15)) * ldb + (k0 + 8 * (lane >> 4)) * 2);
}
constexpr int LDTS = 160;
__device__ __forceinline__ int swz_off(int row, int byteoff) { return row * LDTS + (byteoff ^ (((row >> 3) & 7) << 4)); }
__device__ __forceinline__ bf16x8 ldfrag_sw(const LAS char* tile, int row0, int k0, int lane) {
    const int row = row0 + (lane & 15);
    return *(const LAS bf16x8*)(tile + swz_off(row, (k0 + 8 * (lane >> 4)) * 2));
}
__device__ __forceinline__ void st4bf(LAS char* p, const f32x4& v) { u32x2 o; o.x = pk2(v[0], v[1]); o.y = pk2(v[2], v[3]); *(LAS u32x2*)p = o; }

constexpr int SS_BT = 0, SS_CT = SS_BT + 64 * LDTB, SS_BDT = SS_CT + 64 * LDTB, SS_XT = SS_BDT + 64 * LDTB, SS_CUM = SS_XT + 32 * LDTB, SS_DTV = SS_CUM + 256, SS_ROWS = SS_DTV + 256, SS_STG = SS_ROWS + 256;
constexpr int SS_M = 2 * SS_STG, SS_HB = SS_M + 64 * LDTB, SS_END = SS_HB + 32 * LDTB;
static_assert(SS_END <= LDS_BYTES - 16, "SSD LDS map");

constexpr int MS_QT = 0, MS_KT = MS_QT + 64 * LDTB, MS_KET = MS_KT + 64 * LDTB, MS_VT = MS_KET + 64 * LDTB, MS_SC = MS_VT + 32 * LDTB;
constexpr int MS_STG = MS_SC + 8 * 256;
constexpr int MS_W = 2 * MS_STG, MS_CB = MS_W + 64 * LDTB, MS_ONE = MS_CB + 32 * LDTB, MS_NV = MS_ONE + 16 * LDTB, MS_QN = MS_NV + 256, MS_END = MS_QN + 256;
static_assert(MS_END <= LDS_BYTES - 16, "mLSTM LDS map");

constexpr size_t WS_XSS = WS_EGT + al256((size_t)NROWS * 32 * 4);
constexpr size_t XSS_BYTES = (size_t)64 * NCH64 * 64 * 64 * 2;
constexpr size_t WS_XSD = WS_XSS + XSS_BYTES;
constexpr size_t WS_XMC = WS_XSD + al256((size_t)64 * NCH64 * 4);
constexpr size_t XMC_BYTES = (size_t)32 * NCH64 * 128 * 64 * 2;
constexpr size_t WS_XMN = WS_XMC + XMC_BYTES;
constexpr size_t WS_XMS = WS_XMN + (size_t)32 * NCH64 * 64 * 4;
constexpr size_t WS_XMT = WS_XMS + al256((size_t)32 * NCH64 * 4 * 4);
constexpr size_t WS_XEND = WS_XMT + (size_t)32 * NCH64 * 3 * 64 * 4;
static_assert(WS_XEND <= WS_END, "even-layer chunk-state buffers must fit in the RWKV region");
constexpr int NSSD_ITEMS = 64 * NCH64, NML_ITEMS = 32 * NCH64;

template <int CTRL, int RM, int BM> __device__ __forceinline__ float dppx(float old, float v) {
    return __builtin_bit_cast(float, __builtin_amdgcn_update_dpp(__builtin_bit_cast(int, old), __builtin_bit_cast(int, v), CTRL, RM, BM, false));
}
__device__ __forceinline__ float wave_cumsum(float v, int) {
    float t = v;
    t += dppx<0x111, 0xf, 0xf>(0.f, v); t += dppx<0x112, 0xf, 0xf>(0.f, v); t += dppx<0x113, 0xf, 0xf>(0.f, v);
    { const float u = dppx<0x114, 0xf, 0xe>(0.f, t); t += u; }
    { const float u = dppx<0x118, 0xf, 0xc>(0.f, t); t += u; }
    { const float u = dppx<0x142, 0xa, 0xf>(0.f, t); t += u; }
    { const float u = dppx<0x143, 0xc, 0xf>(0.f, t); t += u; }
    return t;
}
__device__ __forceinline__ float wave_cummax(float v, int) {
    const float ninf = -__builtin_huge_valf();
    float t = v;
    t = fmaxf(t, dppx<0x111, 0xf, 0xf>(ninf, v)); t = fmaxf(t, dppx<0x112, 0xf, 0xf>(ninf, v)); t = fmaxf(t, dppx<0x113, 0xf, 0xf>(ninf, v));
    { const float u = dppx<0x114, 0xf, 0xe>(ninf, t); t = fmaxf(t, u); }
    { const float u = dppx<0x118, 0xf, 0xc>(ninf, t); t = fmaxf(t, u); }
    { const float u = dppx<0x142, 0xa, 0xf>(ninf, t); t = fmaxf(t, u); }
    { const float u = dppx<0x143, 0xc, 0xf>(ninf, t); t = fmaxf(t, u); }
    return t;
}
__device__ __forceinline__ float wave_max(float v) {
    const float t = wave_cummax(v, 0);
    return __builtin_bit_cast(float, __builtin_amdgcn_readlane(__builtin_bit_cast(int, t), 63));
}

constexpr int X1S_BDT = 0, X1S_XT = X1S_BDT + 64 * LDTS, X1S_CUM = X1S_XT + 64 * LDTS, X1S_DTV = X1S_CUM + 256, X1S_END = X1S_DTV + 256;
constexpr int X1M_KET = 0, X1M_VT = X1M_KET + 64 * LDTS, X1M_ONE = X1M_VT + 128 * LDTS, X1M_EE = X1M_ONE + 16 * LDTB, X1M_END = X1M_EE + 256;
__device__ __forceinline__ void phase_ex1(int wv, KP Pk, int layer, LAS char* lds) {
    asm volatile("" : "+s"(Pk));
    const CAS Params& P = *Pk;
    const int tid = ltid(wv), lane = tid & 63, wid = tid >> 6, q = lane >> 4, r16 = lane & 15, i_ = layer >> 1;
    const bf16_t* XBC = (const bf16_t*)(P.ws + WS_EXBC); const bf16_t* QK = (const bf16_t*)(P.ws + WS_EQK); const bf16_t* Pb = (const bf16_t*)(P.ws + WS_P);
    const float* GT = (const float*)(P.ws + WS_EGT);
    {
        bf16_t* Hst = (bf16_t*)(P.ws + WS_XSS); float* Dst = (float*)(P.ws + WS_XSD);
        u32x4 rc[2]; float rdt = 0.f;
        auto geom = [&](int it, int& b, int& h, int& dir, int& c) { const int sq = it / NCH64; c = it - sq * NCH64; b = sq >> 4; h = (sq >> 1) & 7; dir = sq & 1; };
        auto load = [&](int it) {
            int b, h, dir, c; geom(it, b, h, dir, c);
            int tl = tid; asm volatile("" : "+v"(tl));
#pragma unroll
            for (int s = 0; s < 2; ++s) {
                const int task = tl + NT * s, j = task >> 4, g = task & 15;
                const int row = scan_row(c * CL + j, b, dir, 0);
                rc[s] = *(const u32x4*)(XBC + (size_t)row * 768 + (g < 8 ? h * 64 + 8 * g : 512 + (h >> 2) * 64 + 8 * (g - 8)));
            }
            if (tl < CL) { const int row = scan_row(c * CL + tl, b, dir, 0); rdt = GT[(size_t)row * 32 + dir * 8 + h]; }
        };
        int it = blockIdx.x;
        if (it < NSSD_ITEMS) load(it);
        for (; it < NSSD_ITEMS; it += gridDim.x) {
            int b, h, dir, c; geom(it, b, h, dir, c);
            const float aco = -__expf(P.ssd_a_log[(i_ * 2 + dir) * 8 + h]);
            if (tid < CL) {
                const float cum = wave_cumsum(rdt * aco, lane);
                ((LAS float*)(lds + X1S_CUM))[tid] = cum; ((LAS float*)(lds + X1S_DTV))[tid] = rdt;
            }
            __syncthreads();
            {
                const LAS float* cum = (const LAS float*)(lds + X1S_CUM);
                const float cumL = cum[CL - 1];
                int tl = tid; asm volatile("" : "+v"(tl));
#pragma unroll
                for (int s = 0; s < 2; ++s) {
                    const int task = tl + NT * s, j = task >> 4, g = task & 15;
                    float f[8]; unpack8(rc[s], f);
                    if (g < 8) {
                        const float dt = ((const LAS float*)(lds + X1S_DTV))[j];
#pragma unroll
                        for (int e = 0; e < 8; ++e) *(LAS bf16_t*)(lds + X1S_XT + swz_off(8 * g + e, j * 2)) = f2bf(f[e] * dt);
                    } else {
                        const float sc = __expf(cumL - cum[j]);
#pragma unroll
                        for (int e = 0; e < 8; ++e) *(LAS bf16_t*)(lds + X1S_BDT + swz_off(8 * (g - 8) + e, j * 2)) = f2bf(f[e] * sc);
                    }
                }
                if (tid == 0) Dst[it] = __expf(cumL);
            }
            if (it + (int)gridDim.x < NSSD_ITEMS) load(it + gridDim.x);
            __syncthreads();
            {
                const int pt = wid >> 1;
#pragma unroll
                for (int u = 0; u < 2; ++u) {
                    const int nt = (wid & 1) * 2 + u;
                    f32x4 sa = (f32x4){0.f, 0.f, 0.f, 0.f};
#pragma unroll
                    for (int k0 = 0; k0 < 64; k0 += 32) sa = __builtin_amdgcn_mfma_f32_16x16x32_bf16(ldfrag_sw(lds + X1S_BDT, nt * 16, k0, lane), ldfrag_sw(lds + X1S_XT, pt * 16, k0, lane), sa, 0, 0, 0);
                    u32x2 o; o.x = pk2(sa[0], sa[1]); o.y = pk2(sa[2], sa[3]);
                    *(u32x2*)(Hst + ((size_t)it * 64 + pt * 16 + r16) * 64 + nt * 16 + 4 * q) = o;
                }
            }
            __syncthreads();
        }
    }
    {
        bf16_t* Cst = (bf16_t*)(P.ws + WS_XMC); float* Nst = (float*)(P.ws + WS_XMN); float* Sst = (float*)(P.ws + WS_XMS); float* Tst = (float*)(P.ws + WS_XMT);
        for (int i = tid; i < 16 * LDTB / 4; i += NT) ((LAS unsigned*)(lds + X1M_ONE))[i] = 0x3f803f80u;
        u32x4 rc[3]; float rli = 0.f, rlf = 0.f;
        auto geom = [&](int it, int& b, int& h, int& dir, int& c) { const int sq = it / NCH64; c = it - sq * NCH64; b = sq >> 3; h = (sq >> 1) & 3; dir = sq & 1; };
        auto load = [&](int it) {
            int b, h, dir, c; geom(it, b, h, dir, c);
            int tl = tid; asm volatile("" : "+v"(tl));
#pragma unroll
            for (int s = 0; s < 3; ++s) {
                const int task = tl + NT * s, j = task / 24, g = task - 24 * j;
                const int row = scan_row(c * CL + j, b, dir, 0);
                rc[s] = g < 8 ? *(const u32x4*)(QK + (size_t)row * 512 + 256 + h * 64 + 8 * g) : *(const u32x4*)(Pb + (size_t)row * LDP_EVEN + 1808 + h * 128 + 8 * (g - 8));
            }
            if (tl < CL) { const int row = scan_row(c * CL + tl, b, dir, 0); rli = GT[(size_t)row * 32 + 16 + dir * 4 + h]; rlf = GT[(size_t)row * 32 + 24 + dir * 4 + h]; }
        };
        int it = blockIdx.x;
        if (it < NML_ITEMS) load(it);
        __syncthreads();
        for (; it < NML_ITEMS; it += gridDim.x) {
            if (tid < CL) {
                const float fcum = wave_cumsum(rlf, lane);
                const float ftot = __builtin_bit_cast(float, __builtin_amdgcn_readlane(__builtin_bit_cast(int, fcum), 63));
                const float g = rli - fcum, pm = wave_cummax(g, lane);
                const float wend = ftot + g, mloc = wave_max(wend);
                ((LAS float*)(lds + X1M_EE))[tid] = __expf(wend - mloc);
                float* tp = Tst + (size_t)it * 192;
                tp[tid] = fcum; tp[64 + tid] = g; tp[128 + tid] = pm;
                if (tid == 0) { Sst[(size_t)it * 4 + 0] = ftot; Sst[(size_t)it * 4 + 1] = mloc; }
            }
            __syncthreads();
            {
                const LAS float* ee = (const LAS float*)(lds + X1M_EE);
                int tl = tid; asm volatile("" : "+v"(tl));
#pragma unroll
                for (int s = 0; s < 3; ++s) {
                    const int task = tl + NT * s, j = task / 24, g = task - 24 * j;
                    if (g < 8) {
                        float f[8]; unpack8(rc[s], f);
                        const float e1 = ee[j];
#pragma unroll
                        for (int e = 0; e < 8; ++e) *(LAS bf16_t*)(lds + X1M_KET + swz_off(8 * g + e, j * 2)) = f2bf(f[e] * e1);
                    } else {
                        const int v0 = 8 * (g - 8);
#pragma unroll
                        for (int e = 0; e < 8; ++e) { const unsigned wv = rc[s][e >> 1]; *(LAS bf16_t*)(lds + X1M_VT + swz_off(v0 + e, j * 2)) = (bf16_t)((e & 1) ? (wv >> 16) : (wv & 0xffffu)); }
                    }
                }
            }
            if (it + (int)gridDim.x < NML_ITEMS) load(it + gridDim.x);
            __syncthreads();
            {
                const bf16x8 vf0 = ldfrag_sw(lds + X1M_VT, wid * 16, 0, lane), vf1 = ldfrag_sw(lds + X1M_VT, wid * 16, 32, lane);
#pragma unroll
                for (int kt = 0; kt < 4; ++kt) {
                    f32x4 sa = __builtin_amdgcn_mfma_f32_16x16x32_bf16(ldfrag_sw(lds + X1M_KET, kt * 16, 0, lane), vf0, (f32x4){0.f, 0.f, 0.f, 0.f}, 0, 0, 0);
                    sa = __builtin_amdgcn_mfma_f32_16x16x32_bf16(ldfrag_sw(lds + X1M_KET, kt * 16, 32, lane), vf1, sa, 0, 0, 0);
                    u32x2 o; o.x = pk2(sa[0], sa[1]); o.y = pk2(sa[2], sa[3]);
                    *(u32x2*)(Cst + ((size_t)it * 128 + wid * 16 + r16) * 64 + kt * 16 + 4 * q) = o;
                }
                if (wid < 4) {
                    f32x4 na = __builtin_amdgcn_mfma_f32_16x16x32_bf16(ldfrag_sw(lds + X1M_KET, wid * 16, 0, lane), ldfrag(lds + X1M_ONE, LDTB, 0, 0, lane), (f32x4){0.f, 0.f, 0.f, 0.f}, 0, 0, 0);
                    na = __builtin_amdgcn_mfma_f32_16x16x32_bf16(ldfrag_sw(lds + X1M_KET, wid * 16, 32, lane), ldfrag(lds + X1M_ONE, LDTB, 0, 32, lane), na, 0, 0, 0);
                    if (r16 == 0) *(f32x4*)(Nst + (size_t)it * 64 + wid * 16 + 4 * q) = na;
                }
            }
            __syncthreads();
        }
    }
}

__device__ __forceinline__ void phase_ex2(int wv, KP Pk, int layer) {
    asm volatile("" : "+s"(Pk));
    const CAS Params& P = *Pk;
    const int tid = ltid(wv);
    (void)layer;
    if (blockIdx.x < 128) {
        const int gt = blockIdx.x * NT + tid, sq = gt >> 10, rem = gt & 1023;
        bf16_t* Hst = (bf16_t*)(P.ws + WS_XSS) + (size_t)sq * NCH64 * 4096 + rem * 4;
        const float* Dst = (const float*)(P.ws + WS_XSD) + sq * NCH64;
        float h0 = 0.f, h1 = 0.f, h2 = 0.f, h3 = 0.f;
#pragma unroll 4
        for (int c = 0; c < NCH64; ++c) {
            const u32x2 loc = *(const u32x2*)(Hst + (size_t)c * 4096);
            const float d = Dst[c];
            u32x2 o; o.x = pk2(h0, h1); o.y = pk2(h2, h3);
            *(u32x2*)(Hst + (size_t)c * 4096) = o;
            h0 = d * h0 + bflo(loc.x); h1 = d * h1 + bfhi(loc.x); h2 = d * h2 + bflo(loc.y); h3 = d * h3 + bfhi(loc.y);
        }
    } else if (blockIdx.x < 256) {
        const int gt = (blockIdx.x - 128) * NT + tid, sq = gt >> 11, rem = gt & 2047;
        bf16_t* Cst = (bf16_t*)(P.ws + WS_XMC) + (size_t)sq * NCH64 * 8192 + rem * 4;
        float* Nst = (float*)(P.ws + WS_XMN) + (size_t)sq * NCH64 * 64 + (rem & 15) * 4;
        float* Sst = (float*)(P.ws + WS_XMS) + (size_t)sq * NCH64 * 4;
        const bool own_n = rem < 16, own_m = rem == 0;
        float c0 = 0.f, c1 = 0.f, c2 = 0.f, c3 = 0.f, m = -1e30f;
        f32x4 nn = (f32x4){0.f, 0.f, 0.f, 0.f};
#pragma unroll 2
        for (int c = 0; c < NCH64; ++c) {
            const u32x2 loc = *(const u32x2*)(Cst + (size_t)c * 8192);
            const float ftot = Sst[c * 4 + 0], mloc = Sst[c * 4 + 1];
            const float mnew = fmaxf(ftot + m, mloc), sp = __expf(ftot + m - mnew), sl = __expf(mloc - mnew);
            u32x2 o; o.x = pk2(c0, c1); o.y = pk2(c2, c3);
            *(u32x2*)(Cst + (size_t)c * 8192) = o;
            c0 = sp * c0 + sl * bflo(loc.x); c1 = sp * c1 + sl * bfhi(loc.x); c2 = sp * c2 + sl * bflo(loc.y); c3 = sp * c3 + sl * bfhi(loc.y);
            if (own_n) { const f32x4 nl = *(const f32x4*)(Nst + (size_t)c * 64); *(f32x4*)(Nst + (size_t)c * 64) = nn; nn = nn * sp + nl * sl; }
            if (own_m) Sst[c * 4 + 2] = m;
            m = mnew;
        }
    }
}

constexpr int X3S_BT = 0, X3S_CT = X3S_BT + 64 * LDTB, X3S_XT = X3S_CT + 64 * LDTB, X3S_HB = X3S_XT + 64 * LDTS, X3S_M = X3S_HB + 64 * LDTB, X3S_CUM = X3S_M + 64 * LDTB, X3S_DTV = X3S_CUM + 256, X3S_ROWS = X3S_DTV + 256, X3S_END = X3S_ROWS + 256;
constexpr int X3M_QT = 0, X3M_KT = X3M_QT + 64 * LDTB, X3M_VT = X3M_KT + 64 * LDTB, X3M_CB = X3M_VT + 128 * LDTS, X3M_W = X3M_CB + 128 * LDTB, X3M_ONE = X3M_W + 64 * LDTB, X3M_NB = X3M_ONE + 16 * LDTB,
              X3M_SC = X3M_NB + 16 * LDTB, X3M_END = X3M_SC + 6 * 256;
static_assert(X3M_END <= LDS_BYTES - 16 && X3S_END <= LDS_BYTES - 16, "EX3 LDS maps");
__device__ __forceinline__ void phase_ex3(int wv, KP Pk, int layer, LAS char* lds) {
    asm volatile("" : "+s"(Pk));
    const CAS Params& P = *Pk;
    const int tid = ltid(wv), lane = tid & 63, wid = tid >> 6, q = lane >> 4, r16 = lane & 15, i_ = layer >> 1;
    const bf16_t* XBC = (const bf16_t*)(P.ws + WS_EXBC); const bf16_t* QK = (const bf16_t*)(P.ws + WS_EQK); const bf16_t* Pb = (const bf16_t*)(P.ws + WS_P);
    const float* GT = (const float*)(P.ws + WS_EGT);
    {
        const bf16_t* Hst = (const bf16_t*)(P.ws + WS_XSS);
        u32x4 rc[3], rh; float rdt = 0.f; int rrow = 0;
        auto geom = [&](int it, int& b, int& h, int& dir, int& c) { const int sq = it / NCH64; c = it - sq * NCH64; b = sq >> 4; h = (sq >> 1) & 7; dir = sq & 1; };
        auto load = [&](int it) {
            int b, h, dir, c; geom(it, b, h, dir, c);
            int tl = tid; asm volatile("" : "+v"(tl));
#pragma unroll
            for (int s = 0; s < 3; ++s) {
                const int task = tl + NT * s, j = task / 24, g = task - 24 * j;
                const int row = scan_row(c * CL + j, b, dir, 0);
                rc[s] = *(const u32x4*)(XBC + (size_t)row * 768 + (g < 8 ? h * 64 + 8 * g : g < 16 ? 512 + (h >> 2) * 64 + 8 * (g - 8) : 640 + (h >> 2) * 64 + 8 * (g - 16)));
            }
            rh = *(const u32x4*)(Hst + (size_t)it * 4096 + tl * 8);
            if (tl < CL) { rrow = scan_row(c * CL + tl, b, dir, 0); rdt = GT[(size_t)rrow * 32 + dir * 8 + h]; }
        };
        int it = blockIdx.x;
        if (it < NSSD_ITEMS) load(it);
        __syncthreads();
        for (; it < NSSD_ITEMS; it += gridDim.x) {
            int b, h, dir, c; geom(it, b, h, dir, c);
            bf16_t* Y = (bf16_t*)(P.ws + (dir ? WS_YB : WS_YF));
            const float aco = -__expf(P.ssd_a_log[(i_ * 2 + dir) * 8 + h]);
            if (tid < CL) {
                const float cum = wave_cumsum(rdt * aco, lane);
                ((LAS float*)(lds + X3S_CUM))[tid] = cum; ((LAS float*)(lds + X3S_DTV))[tid] = rdt; ((LAS int*)(lds + X3S_ROWS))[tid] = rrow;
            }
            __syncthreads();
            {
                int tl = tid; asm volatile("" : "+v"(tl));
#pragma unroll
                for (int s = 0; s < 3; ++s) {
                    const int task = tl + NT * s, j = task / 24, g = task - 24 * j;
                    if (g < 8) {
                        float f[8]; unpack8(rc[s], f);
                        const float dt = ((const LAS float*)(lds + X3S_DTV))[j];
#pragma unroll
                        for (int e = 0; e < 8; ++e) *(LAS bf16_t*)(lds + X3S_XT + swz_off(8 * g + e, j * 2)) = f2bf(f[e] * dt);
                    } else if (g < 16) *(LAS u32x4*)(lds + X3S_BT + j * LDTB + 8 * (g - 8) * 2) = rc[s];
                    else *(LAS u32x4*)(lds + X3S_CT + j * LDTB + 8 * (g - 16) * 2) = rc[s];
                }
                *(LAS u32x4*)(lds + X3S_HB + (tl >> 3) * LDTB + (tl & 7) * 16) = rh;
            }
            if (it + (int)gridDim.x < NSSD_ITEMS) load(it + gridDim.x);
            __syncthreads();
            const LAS float* cum = (const LAS float*)(lds + X3S_CUM);
            {
                const int lt = wid >> 1;
#pragma unroll
                for (int u = 0; u < 2; ++u) {
                    const int st = (wid & 1) * 2 + u;
                    f32x4 acc = (f32x4){0.f, 0.f, 0.f, 0.f};
                    if (st <= lt) {
#pragma unroll
                        for (int k0 = 0; k0 < 64; k0 += 32) acc = __builtin_amdgcn_mfma_f32_16x16x32_bf16(ldfrag(lds + X3S_BT, LDTB, st * 16, k0, lane), ldfrag(lds + X3S_CT, LDTB, lt * 16, k0, lane), acc, 0, 0, 0);
                        const int l = lt * 16 + r16, s0 = st * 16 + 4 * q;
                        const float cl = cum[l]; const f32x4 cs = *(const LAS f32x4*)(cum + s0);
#pragma unroll
                        for (int j = 0; j < 4; ++j) acc[j] = (s0 + j <= l) ? acc[j] * __expf(cl - cs[j]) : 0.f;
                    }
                    st4bf(lds + X3S_M + (lt * 16 + r16) * LDTB + (st * 16 + 4 * q) * 2, acc);
                }
            }
            __syncthreads();
            {
                const int lt = wid >> 1, l = lt * 16 + r16;
                const float el = __expf(cum[l]);
                const int row = ((const LAS int*)(lds + X3S_ROWS))[l];
                const bf16x8 mf0 = ldfrag(lds + X3S_M, LDTB, lt * 16, 0, lane), mf1 = ldfrag(lds + X3S_M, LDTB, lt * 16, 32, lane);
                const bf16x8 cf0 = ldfrag(lds + X3S_CT, LDTB, lt * 16, 0, lane), cf1 = ldfrag(lds + X3S_CT, LDTB, lt * 16, 32, lane);
#pragma unroll
                for (int u = 0; u < 2; ++u) {
                    const int pt = (wid & 1) * 2 + u;
                    f32x4 ya = __builtin_amdgcn_mfma_f32_16x16x32_bf16(ldfrag_sw(lds + X3S_XT, pt * 16, 0, lane), mf0, (f32x4){0.f, 0.f, 0.f, 0.f}, 0, 0, 0);
                    ya = __builtin_amdgcn_mfma_f32_16x16x32_bf16(ldfrag_sw(lds + X3S_XT, pt * 16, 32, lane), mf1, ya, 0, 0, 0);
                    f32x4 oa = __builtin_amdgcn_mfma_f32_16x16x32_bf16(ldfrag(lds + X3S_HB, LDTB, pt * 16, 0, lane), cf0, (f32x4){0.f, 0.f, 0.f, 0.f}, 0, 0, 0);
                    oa = __builtin_amdgcn_mfma_f32_16x16x32_bf16(ldfrag(lds + X3S_HB, LDTB, pt * 16, 32, lane), cf1, oa, 0, 0, 0);
                    u32x2 o; o.x = pk2(ya[0] + el * oa[0], ya[1] + el * oa[1]); o.y = pk2(ya[2] + el * oa[2], ya[3] + el * oa[3]);
                    *(u32x2*)(Y + (size_t)row * D + h * 64 + pt * 16 + 4 * q) = o;
                }
            }
            __syncthreads();
        }
    }
    {
        const bf16_t* Cst = (const bf16_t*)(P.ws + WS_XMC); const float* Nst = (const float*)(P.ws + WS_XMN); const float* Sst = (const float*)(P.ws + WS_XMS); const float* Tst = (const float*)(P.ws + WS_XMT);
        for (int i = tid; i < 16 * LDTB / 4; i += NT) ((LAS unsigned*)(lds + X3M_ONE))[i] = 0x3f803f80u;
        u32x4 rc[4], rcb[2]; float rfc = 0.f, rg = 0.f, rpm = 0.f, rmp = 0.f, rn = 0.f; int rrow = 0;
        auto geom = [&](int it, int& b, int& h, int& dir, int& c) { const int sq = it / NCH64; c = it - sq * NCH64; b = sq >> 3; h = (sq >> 1) & 3; dir = sq & 1; };
        auto load = [&](int it) {
            int b, h, dir, c; geom(it, b, h, dir, c);
            int tl = tid; asm volatile("" : "+v"(tl));
#pragma unroll
            for (int s = 0; s < 4; ++s) {
                const int task = tl + NT * s, j = task >> 5, g = task & 31;
                const int row = scan_row(c * CL + j, b, dir, 0);
                rc[s] = g < 16 ? *(const u32x4*)(QK + (size_t)row * 512 + (g < 8 ? h * 64 + 8 * g : 256 + h * 64 + 8 * (g - 8))) : *(const u32x4*)(Pb + (size_t)row * LDP_EVEN + 1808 + h * 128 + 8 * (g - 16));
            }
#pragma unroll
            for (int s = 0; s < 2; ++s) rcb[s] = *(const u32x4*)(Cst + (size_t)it * 8192 + (tl + NT * s) * 8);
            if (tl < CL) {
                rrow = scan_row(c * CL + tl, b, dir, 0);
                const float* tp = Tst + (size_t)it * 192;
                rfc = tp[tl]; rg = tp[64 + tl]; rpm = tp[128 + tl]; rmp = Sst[(size_t)it * 4 + 2]; rn = Nst[(size_t)it * 64 + tl];
            }
        };
        int it = blockIdx.x;
        if (it < NML_ITEMS) load(it);
        __syncthreads();
        for (; it < NML_ITEMS; it += gridDim.x) {
            int b, h, dir, c; geom(it, b, h, dir, c);
            bf16_t* Y = (bf16_t*)(P.ws + (dir ? WS_YB : WS_YF));
            LAS float* sc = (LAS float*)(lds + X3M_SC);
            {
                int tl = tid; asm volatile("" : "+v"(tl));
#pragma unroll
                for (int s = 0; s < 4; ++s) {
                    const int task = tl + NT * s, j = task >> 5, g = task & 31;
                    if (g < 8) *(LAS u32x4*)(lds + X3M_QT + j * LDTB + 8 * g * 2) = rc[s];
                    else if (g < 16) *(LAS u32x4*)(lds + X3M_KT + j * LDTB + 8 * (g - 8) * 2) = rc[s];
                    else {
                        const int v0 = 8 * (g - 16);
#pragma unroll
                        for (int e = 0; e < 8; ++e) { const unsigned wv = rc[s][e >> 1]; *(LAS bf16_t*)(lds + X3M_VT + swz_off(v0 + e, j * 2)) = (bf16_t)((e & 1) ? (wv >> 16) : (wv & 0xffffu)); }
                    }
                }
#pragma unroll
                for (int s = 0; s < 2; ++s) { const int ch = tl + NT * s; *(LAS u32x4*)(lds + X3M_CB + (ch >> 3) * LDTB + (ch & 7) * 16) = rcb[s]; }
                if (tl < CL) {
                    const float linter = rfc + rmp, mrow = fmaxf(rfc + rpm, linter);
                    sc[tl] = rfc - mrow; sc[64 + tl] = rg; sc[128 + tl] = __expf(linter - mrow); sc[192 + tl] = __expf(-mrow); ((LAS int*)sc)[256 + tl] = rrow;
                    const bf16_t nb = f2bf(rn);
#pragma unroll
                    for (int r = 0; r < 16; ++r) *(LAS bf16_t*)(lds + X3M_NB + r * LDTB + tl * 2) = nb;
                }
            }
            if (it + (int)gridDim.x < NML_ITEMS) load(it + gridDim.x);
            __syncthreads();
            {
                const int lt = wid >> 1;
#pragma unroll
                for (int u = 0; u < 2; ++u) {
                    const int st = (wid & 1) * 2 + u;
                    f32x4 acc = (f32x4){0.f, 0.f, 0.f, 0.f};
                    if (st <= lt) {
#pragma unroll
                        for (int k0 = 0; k0 < 64; k0 += 32) acc = __builtin_amdgcn_mfma_f32_16x16x32_bf16(ldfrag(lds + X3M_KT, LDTB, st * 16, k0, lane), ldfrag(lds + X3M_QT, LDTB, lt * 16, k0, lane), acc, 0, 0, 0);
                        const int l = lt * 16 + r16, s0 = st * 16 + 4 * q;
                        const float rt = sc[l]; const f32x4 gs = *(const LAS f32x4*)(sc + 64 + s0);
#pragma unroll
                        for (int j = 0; j < 4; ++j) acc[j] = (s0 + j <= l) ? acc[j] * __expf(rt + gs[j]) : 0.f;
                    }
                    st4bf(lds + X3M_W + (lt * 16 + r16) * LDTB + (st * 16 + 4 * q) * 2, acc);
                }
            }
            __syncthreads();
            {
                const int lt = wid >> 1, l = lt * 16 + r16;
                const bf16x8 wf0 = ldfrag(lds + X3M_W, LDTB, lt * 16, 0, lane), wf1 = ldfrag(lds + X3M_W, LDTB, lt * 16, 32, lane);
                const bf16x8 qf0 = ldfrag(lds + X3M_QT, LDTB, lt * 16, 0, lane), qf1 = ldfrag(lds + X3M_QT, LDTB, lt * 16, 32, lane);
                f32x4 da = __builtin_amdgcn_mfma_f32_16x16x32_bf16(ldfrag(lds + X3M_ONE, LDTB, 0, 0, lane), wf0, (f32x4){0.f, 0.f, 0.f, 0.f}, 0, 0, 0);
                da = __builtin_amdgcn_mfma_f32_16x16x32_bf16(ldfrag(lds + X3M_ONE, LDTB, 0, 32, lane), wf1, da, 0, 0, 0);
                f32x4 qn = __builtin_amdgcn_mfma_f32_16x16x32_bf16(ldfrag(lds + X3M_NB, LDTB, 0, 0, lane), qf0, (f32x4){0.f, 0.f, 0.f, 0.f}, 0, 0, 0);
                qn = __builtin_amdgcn_mfma_f32_16x16x32_bf16(ldfrag(lds + X3M_NB, LDTB, 0, 32, lane), qf1, qn, 0, 0, 0);
                const float inter = sc[128 + l], emr = sc[192 + l];
                const float inv = __builtin_amdgcn_rcpf(fmaxf(fabsf(da[0] + inter * qn[0]), emr));
                const int row = ((const LAS int*)sc)[256 + l];
#pragma unroll
                for (int u = 0; u < 4; ++u) {
                    const int vt = (wid & 1) * 4 + u;
                    f32x4 na = __builtin_amdgcn_mfma_f32_16x16x32_bf16(ldfrag_sw(lds + X3M_VT, vt * 16, 0, lane), wf0, (f32x4){0.f, 0.f, 0.f, 0.f}, 0, 0, 0);
                    na = __builtin_amdgcn_mfma_f32_16x16x32_bf16(ldfrag_sw(lds + X3M_VT, vt * 16, 32, lane), wf1, na, 0, 0, 0);
                    f32x4 ca = __builtin_amdgcn_mfma_f32_16x16x32_bf16(ldfrag(lds + X3M_CB, LDTB, vt * 16, 0, lane), qf0, (f32x4){0.f, 0.f, 0.f, 0.f}, 0, 0, 0);
                    ca = __builtin_amdgcn_mfma_f32_16x16x32_bf16(ldfrag(lds + X3M_CB, LDTB, vt * 16, 32, lane), qf1, ca, 0, 0, 0);
                    u32x2 o; o.x = pk2((na[0] + inter * ca[0]) * inv, (na[1] + inter * ca[1]) * inv); o.y = pk2((na[2] + inter * ca[2]) * inv, (na[3] + inter * ca[3]) * inv);
                    *(u32x2*)(Y + (size_t)row * D + 512 + h * 128 + vt * 16 + 4 * q) = o;
                }
            }
            __syncthreads();
        }
    }
}

constexpr int HC_RAWF = 0;
constexpr int HC_RAWQ = HC_RAWF + 64 * 128 * 4;
constexpr int HC_SUB = HC_RAWQ + 64 * 128 * 2;
constexpr int HL_QD = 136 * 2;
constexpr int HL_T = 24 * 2;
constexpr int HS_QI = 0, HS_KO = HS_QI + 16 * HL_QD, HS_KET = HS_KO + 16 * HL_QD, HS_ATT = HS_KET + 128 * HL_T, HS_VT = HS_ATT + 16 * HL_T, HS_DEC = HS_VT + 32 * HL_T, HS_SIZE = HS_DEC + 512;
constexpr int HC_SB = HC_SUB + 4 * HS_SIZE;
constexpr int HC_ROWS = HC_SB + 2 * 32 * HL_QD, HC_CST = HC_ROWS + 256, HC_END = HC_CST + 1024;
static_assert(HC_END <= LDS_BYTES - 16, "HGRN2 LDS map");
static_assert(HS_SIZE % 16 == 0 && HC_SB % 16 == 0, "alignment");
__device__ __forceinline__ bf16x8 ldfrag16(const LAS char* tile, int ldb, int row0, int lane) {
    bf16x8 v = *(const LAS bf16x8*)(tile + (row0 + (lane & 15)) * ldb + ((lane >> 4) & 1) * 16);
    if (lane >= 32) v = (bf16x8){0, 0, 0, 0, 0, 0, 0, 0};
    return v;
}
__device__ __forceinline__ void scan_hgrn_c(int wv, KP Pk, int layer, int unit, LAS char* lds) {
    asm volatile("" : "+s"(Pk));
    const CAS Params& P = *Pk;
    const int tid = ltid(wv), lane = tid & 63, wid = tid >> 6, q = lane >> 4, r16 = lane & 15, i_ = layer >> 1;
    const int seq = unit >> 2, quarter = unit & 3, b = seq >> 3, h = (seq >> 1) & 3, dir = seq & 1;
    const bf16_t* Pb = (const bf16_t*)(P.ws + WS_P);
    bf16_t* Y = (bf16_t*)(P.ws + (dir ? WS_YB : WS_YF));
    LAS float* cst = (LAS float*)(lds + HC_CST);
    if (tid < 128) cst[tid] = ((const float*)(P.ws + WS_LB))[layer * 512 + h * 128 + tid];
    else if (tid < 256) cst[tid] = P.hg_f_bias[(size_t)(i_ * 2 + dir) * 512 + h * 128 + tid - 128];
    for (int i = tid; i < 2 * 32 * HL_QD / 4; i += NT) ((LAS unsigned*)(lds + HC_SB))[i] = 0u;
    int tj[5], tg_[5], tcol[5]; bool tv[5];
#pragma unroll
    for (int s = 0; s < 5; ++s) {
        const int task = tid + NT * s; tv[s] = task < 64 * 36; tj[s] = task / 36; tg_[s] = task % 36;
        const int g = tg_[s];
        tcol[s] = g < 16 ? (512 + dir * 512 + h * 128 + 8 * g) : g < 32 ? (h * 128 + 8 * (g - 16)) : (1536 + h * 128 + quarter * 32 + 8 * (g - 32));
    }
    u32x4 rc[5]; int rrow = 0;
    auto load = [&](int c) {
#pragma unroll
        for (int s = 0; s < 5; ++s) {
            rc[s] = (u32x4){0u, 0u, 0u, 0u};
            if (tv[s]) { const int row = scan_row(c * 64 + tj[s], b, dir, 1); rc[s] = *(const u32x4*)(Pb + (size_t)row * LDP_ODD + tcol[s]); }
        }
        if (tid < 64) rrow = scan_row(c * 64 + tid, b, dir, 1);
    };
    auto storeA = [&]() {
#pragma unroll
        for (int s = 0; s < 5; ++s) {
            if (tv[s]) {
                float f[8]; unpack8(rc[s], f);
                const int j = tj[s], g = tg_[s];
                if (g < 16) {
                    float o[8];
#pragma unroll
                    for (int e = 0; e < 8; ++e) { const float lbv = cst[8 * g + e]; o[e] = lbv + (1.f - lbv) * sigmoidf_(f[e] + cst[128 + 8 * g + e]); }
                    LAS float* dst = (LAS float*)(lds + HC_RAWF) + j * 128 + 8 * g;
                    *(LAS f32x4*)dst = (f32x4){o[0], o[1], o[2], o[3]}; *(LAS f32x4*)(dst + 4) = (f32x4){o[4], o[5], o[6], o[7]};
                } else if (g < 32) {
                    float o[8];
#pragma unroll
                    for (int e = 0; e < 8; ++e) o[e] = siluf_(f[e]);
                    *(LAS u32x4*)(lds + HC_RAWQ + (j * 128 + 8 * (g - 16)) * 2) = pack8(o);
                } else {
                    const int v0 = 8 * (g - 32);
                    LAS char* vt = lds + HC_SUB + (j >> 4) * HS_SIZE + HS_VT;
#pragma unroll
                    for (int e = 0; e < 8; ++e) { const unsigned wv = rc[s][e >> 1]; *(LAS bf16_t*)(vt + (v0 + e) * HL_T + (j & 15) * 2) = (bf16_t)((e & 1) ? (wv >> 16) : (wv & 0xffffu)); }
                }
            }
        }
        if (tid < 64) ((LAS int*)(lds + HC_ROWS))[tid] = rrow;
    };
    auto storeB = [&]() {
        const int d = tid & 127, sb = tid >> 7;
        LAS char* st = lds + HC_SUB + sb * HS_SIZE;
        const LAS float* rf = (const LAS float*)(lds + HC_RAWF) + (sb * 16) * 128 + d;
        const LAS bf16_t* rq = (const LAS bf16_t*)(lds + HC_RAWQ) + (sb * 16) * 128 + d;
        float lam = 0.f, lams[16], kfs[16];
#pragma unroll
        for (int t = 0; t < 16; ++t) {
            const float f = rf[t * 128];
            lam += __logf(f);
            const float kf = 1.f - f;
            lams[t] = lam; kfs[t] = kf;
            *(LAS bf16_t*)(st + HS_QI + t * HL_QD + d * 2) = f2bf(bf2f(rq[t * 128]) * __expf(lam));
            *(LAS bf16_t*)(st + HS_KO + t * HL_QD + d * 2) = f2bf(kf * __expf(-lam));
        }
        float ke[16];
#pragma unroll
        for (int t = 0; t < 16; ++t) ke[t] = kfs[t] * __expf(lam - lams[t]);
        *(LAS u32x4*)(st + HS_KET + d * HL_T) = pack8(ke); *(LAS u32x4*)(st + HS_KET + d * HL_T + 16) = pack8(ke + 8);
        ((LAS float*)(st + HS_DEC))[d] = __expf(lam);
    };
    f32x4 sacc[2];
    sacc[0] = sacc[1] = (f32x4){0.f, 0.f, 0.f, 0.f};
    __syncthreads();
    load(0);
    for (int c = 0; c < NSTEPS / 64; ++c) {
        storeA();
        __syncthreads();
        storeB();
        if (c + 1 < NSTEPS / 64) load(c + 1);
        __syncthreads();
        if (wid < 4) {
            LAS char* st = lds + HC_SUB + wid * HS_SIZE;
            f32x4 acc = (f32x4){0.f, 0.f, 0.f, 0.f};
#pragma unroll
            for (int k0 = 0; k0 < 128; k0 += 32) acc = __builtin_amdgcn_mfma_f32_16x16x32_bf16(ldfrag(st + HS_KO, HL_QD, 0, k0, lane), ldfrag(st + HS_QI, HL_QD, 0, k0, lane), acc, 0, 0, 0);
#pragma unroll
            for (int j = 0; j < 4; ++j) acc[j] = (4 * q + j <= r16) ? acc[j] : 0.f;
            st4bf(st + HS_ATT + r16 * HL_T + 4 * q * 2, acc);
        }
        __syncthreads();
#pragma unroll 1
        for (int sb = 0; sb < 4; ++sb) {
            LAS char* st = lds + HC_SUB + sb * HS_SIZE;
            const LAS char* sbr = lds + HC_SB + (sb & 1) * 32 * HL_QD;
            LAS char* sbw = lds + HC_SB + ((sb + 1) & 1) * 32 * HL_QD;
            if (wid < 2) {
                f32x4 ya = __builtin_amdgcn_mfma_f32_16x16x32_bf16(ldfrag16(st + HS_VT, HL_T, wid * 16, lane), ldfrag16(st + HS_ATT, HL_T, 0, lane), (f32x4){0.f, 0.f, 0.f, 0.f}, 0, 0, 0);
#pragma unroll
                for (int k0 = 0; k0 < 128; k0 += 32) ya = __builtin_amdgcn_mfma_f32_16x16x32_bf16(ldfrag(sbr, HL_QD, wid * 16, k0, lane), ldfrag(st + HS_QI, HL_QD, 0, k0, lane), ya, 0, 0, 0);
                const int row = ((const LAS int*)(lds + HC_ROWS))[sb * 16 + r16];
                u32x2 o; o.x = pk2(ya[0], ya[1]); o.y = pk2(ya[2], ya[3]);
                *(u32x2*)(Y + (size_t)row * D + h * 128 + quarter * 32 + wid * 16 + 4 * q) = o;
            }
            {
                const int vt = wid >> 2;
                const bf16x8 vf = ldfrag16(st + HS_VT, HL_T, vt * 16, lane);
#pragma unroll
                for (int u = 0; u < 2; ++u) {
                    const int dt = (wid & 3) * 2 + u;
                    const f32x4 a = __builtin_amdgcn_mfma_f32_16x16x32_bf16(ldfrag16(st + HS_KET, HL_T, dt * 16, lane), vf, (f32x4){0.f, 0.f, 0.f, 0.f}, 0, 0, 0);
                    const f32x4 dc = *(const LAS f32x4*)((const LAS float*)(st + HS_DEC) + dt * 16 + 4 * q);
#pragma unroll
                    for (int j = 0; j < 4; ++j) sacc[u][j] = sacc[u][j] * dc[j] + a[j];
                    st4bf(sbw + (vt * 16 + r16) * HL_QD + (dt * 16 + 4 * q) * 2, sacc[u]);
                }
            }
            __syncthreads();
        }
    }
}

constexpr int RC_RAWW = 0;
constexpr int RC_RAWA = RC_RAWW + 64 * 64 * 4;
constexpr int RC_RAWB = RC_RAWA + 64 * 64 * 2, RC_RAWK = RC_RAWB + 64 * 64 * 2, RC_RAWR = RC_RAWK + 64 * 64 * 2;
constexpr int RC_SUB = RC_RAWR + 64 * 64 * 2;
constexpr int RL_C = 72 * 2, RL_32 = 40 * 2, RL_16 = 24 * 2;
constexpr int RS_AT = 0, RS_RT = RS_AT + 16 * RL_C, RS_KT = RS_RT + 16 * RL_C, RS_BT = RS_KT + 16 * RL_C, RS_KBH = RS_BT + 16 * RL_C, RS_AAK = RS_KBH + 64 * RL_32,
              RS_ARKB = RS_AAK + 16 * RL_16, RS_T = RS_ARKB + 16 * RL_32, RS_AABF = RS_T + 16 * RL_16, RS_GL = RS_AABF + 16 * 16 * 4, RS_VU = RS_GL + 256, RS_SIZE = RS_VU + 32 * RL_32;
constexpr int RC_SB = RC_SUB + 4 * RS_SIZE;
constexpr int RC_RHT = RC_SB + 32 * RL_C;
constexpr int RC_ROWS = RC_RHT + 32 * RL_16, RC_END = RC_ROWS + 256;
static_assert(RC_END <= LDS_BYTES - 16, "RWKV LDS map");
static_assert(RS_SIZE % 16 == 0 && RC_SB % 16 == 0 && RC_RHT % 16 == 0, "alignment");

__device__ __forceinline__ float allreduce8(float v) {
    v += dppmov<0xB1>(v); v += dppmov<0x4E>(v); v += dppmov<0x141>(v);
    return v;
}

__device__ __forceinline__ void phase_prep1(int wv, KP Pk, int layer) {
    asm volatile("" : "+s"(Pk));
    const CAS Params& P = *Pk;
    const int tid = ltid(wv), lane = tid & 63, wid = tid >> 6, i_ = layer >> 1;
    const bf16_t* Pb = (const bf16_t*)(P.ws + WS_P);
    bf16_t* R = (bf16_t*)(P.ws + WS_RWR); bf16_t* K = (bf16_t*)(P.ws + WS_RWK); bf16_t* V = (bf16_t*)(P.ws + WS_RWV); bf16_t* KK = (bf16_t*)(P.ws + WS_RWKK);
    bf16_t* LA = (bf16_t*)(P.ws + WS_LA);
    const float* mu = P.rw_mu + (size_t)i_ * 1856;
    float mur[8], muv[8], muk[8], mul_[8], kkw[8];
#pragma unroll
    for (int e = 0; e < 8; ++e) { mur[e] = mu[8 * lane + e]; muv[e] = mu[1024 + 8 * lane + e]; muk[e] = mu[512 + 8 * lane + e]; mul_[e] = lane < 40 ? mu[1536 + 8 * lane + e] : 0.f; kkw[e] = P.rw_k_k[i_ * 512 + 8 * lane + e]; }
    for (int r = blockIdx.x * 8 + wid; r < NROWS; r += gridDim.x * 8) {
        int rprev = -1, rnext = -1;
        if (r < NCTX) { const int t = r & 255; if (t > 0) rprev = r - 1; if (t < CTXL - 1) rnext = r + 1; }
        else {
            const int bs = (r - NCTX) >> 13, s = (r - NCTX) & 8191, sg = ((s & 63) << 7) + (s >> 6);
            if (sg > 0) { const int g2 = sg - 1; rprev = NCTX + bs * SEQ + ((g2 & 127) << 6) + (g2 >> 7); }
            if (sg < SEQ - 1) { const int g2 = sg + 1; rnext = NCTX + bs * SEQ + ((g2 & 127) << 6) + (g2 >> 7); }
        }
        const bf16_t* pc = Pb + (size_t)r * LDP_ODD + 2560;
        const bf16_t* pp = Pb + (size_t)(rprev < 0 ? r : rprev) * LDP_ODD + 2560;
        const bf16_t* pn = Pb + (size_t)(rnext < 0 ? r : rnext) * LDP_ODD + 2560;
        const float mp = rprev < 0 ? 0.f : 0.5f, mn = rnext < 0 ? 0.f : 0.5f;
        auto mix8 = [&](int col, const float* muc, float* o) {
            float fc[8], fp[8], fn[8];
            unpack8(*(const u32x4*)(pc + col), fc); unpack8(*(const u32x4*)(pp + col), fp); unpack8(*(const u32x4*)(pn + col), fn);
#pragma unroll
            for (int e = 0; e < 8; ++e) o[e] = fc[e] + muc[e] * (mp * fp[e] + mn * fn[e] - fc[e]);
        };
        float o[8];
        mix8(8 * lane, mur, o); *(u32x4*)(R + (size_t)r * 512 + 8 * lane) = pack8(o);
        mix8(1024 + 8 * lane, muv, o); *(u32x4*)(V + (size_t)r * 512 + 8 * lane) = pack8(o);
        mix8(512 + 8 * lane, muk, o); *(u32x4*)(K + (size_t)r * 512 + 8 * lane) = pack8(o);
        {
            float kk[8], ss = 0.f;
#pragma unroll
            for (int e = 0; e < 8; ++e) { kk[e] = o[e] * kkw[e]; ss += kk[e] * kk[e]; }
            ss = group_sum<8>(ss);
            const float rn = rsqrtf(fmaxf(ss, 1e-12f));
#pragma unroll
            for (int e = 0; e < 8; ++e) kk[e] *= rn;
            *(u32x4*)(KK + (size_t)r * 512 + 8 * lane) = pack8(kk);
        }
        if (lane < 40) {
            mix8(1536 + 8 * lane, mul_, o);
            if (lane < 16) {
#pragma unroll
                for (int e = 0; e < 8; ++e) o[e] = tanh_fast(o[e]);
            } else if (lane >= 24) {
#pragma unroll
                for (int e = 0; e < 8; ++e) o[e] = sigmoidf_(o[e]);
            }
            *(u32x4*)(LA + (size_t)r * 320 + 8 * lane) = pack8(o);
        }
    }
}

__device__ __forceinline__ void phase_out_even(int wv, KP Pk, int layer) {
    asm volatile("" : "+s"(Pk));
    const CAS Params& P = *Pk;
    const int tid = ltid(wv), lane = tid & 63, wid = tid >> 6, i_ = layer >> 1;
    const bf16_t* Pb = (const bf16_t*)(P.ws + WS_P);
    const bf16_t* Yf = (const bf16_t*)(P.ws + WS_YF); const bf16_t* Yb = (const bf16_t*)(P.ws + WS_YB);
    bf16_t* feat = (bf16_t*)(P.ws + WS_FEAT);
    const int r0 = (layer == DEPTH - 1) ? NCTX : 0;
    const bf16_t* XBC = (const bf16_t*)(P.ws + WS_EXBC);
    float nwa[8], nwb[8];
#pragma unroll
    for (int e = 0; e < 8; ++e) { nwa[e] = P.ssd_norm_w[i_ * 512 + 8 * lane + e]; nwb[e] = P.ml_norm_w[i_ * 512 + 8 * lane + e]; }
    const float dsk = P.ssd_d[i_ * 8 + (lane >> 3)];
    for (int r = r0 + blockIdx.x * 8 + wid; r < NROWS; r += gridDim.x * 8) {
        const bf16_t* pr = Pb + (size_t)r * LDP_EVEN;
        float y[8];
        {
            float a[8], bb[8], xsv[8], z[8];
            unpack8(*(const u32x4*)(Yf + (size_t)r * D + 8 * lane), a); unpack8(*(const u32x4*)(Yb + (size_t)r * D + 8 * lane), bb);
            unpack8(*(const u32x4*)(XBC + (size_t)r * 768 + 8 * lane), xsv); unpack8(*(const u32x4*)(pr + 8 * lane), z);
            float ss = 0.f;
#pragma unroll
            for (int e = 0; e < 8; ++e) {
                y[e] = (a[e] + bb[e] + dsk * xsv[e]) * siluf_(z[e]); ss += y[e] * y[e];
            }
            ss = wave_sum(ss);
            const float rn = rsqrtf(ss * (1.f / 512.f) + 1e-6f);
#pragma unroll
            for (int e = 0; e < 8; ++e) y[e] = y[e] * rn * nwa[e];
            *(u32x4*)(feat + (size_t)r * D + 8 * lane) = pack8(y);
        }
        {
            float a[8], bb[8], o[8];
            unpack8(*(const u32x4*)(Yf + (size_t)r * D + 512 + 8 * lane), a); unpack8(*(const u32x4*)(Yb + (size_t)r * D + 512 + 8 * lane), bb);
            unpack8(*(const u32x4*)(pr + 2320 + 8 * lane), o);
            float s = 0.f;
#pragma unroll
            for (int e = 0; e < 8; ++e) { y[e] = a[e] + bb[e]; s += y[e]; }
            const float mean = group_sum<16>(s) * (1.f / 128.f);
            float ss = 0.f;
#pragma unroll
            for (int e = 0; e < 8; ++e) { y[e] -= mean; ss += y[e] * y[e]; }
            const float rn = rsqrtf(group_sum<16>(ss) * (1.f / 128.f) + 1e-6f);
#pragma unroll
            for (int e = 0; e < 8; ++e) y[e] = sigmoidf_(o[e]) * (y[e] * rn) * nwb[e];
            *(u32x4*)(feat + (size_t)r * D + 512 + 8 * lane) = pack8(y);
        }
    }
}
__device__ __forceinline__ void phase_out_odd(int wv, KP Pk, int layer) {
    asm volatile("" : "+s"(Pk));
    const CAS Params& P = *Pk;
    const int tid = ltid(wv), lane = tid & 63, wid = tid >> 6, i_ = layer >> 1;
    const bf16_t* Pb = (const bf16_t*)(P.ws + WS_P);
    const bf16_t* Yf = (const bf16_t*)(P.ws + WS_YF); const bf16_t* Yb = (const bf16_t*)(P.ws + WS_YB);
    const bf16_t* R = (const bf16_t*)(P.ws + WS_RWR); const bf16_t* K = (const bf16_t*)(P.ws + WS_RWK); const bf16_t* V = (const bf16_t*)(P.ws + WS_RWV); const bf16_t* G = (const bf16_t*)(P.ws + WS_RWG);
    bf16_t* feat = (bf16_t*)(P.ws + WS_FEAT);
    const int r0 = (layer == DEPTH - 1) ? NCTX : 0;
    float nwc[8], rk[8], lw[8], lbv[8];
#pragma unroll
    for (int e = 0; e < 8; ++e) {
        nwc[e] = P.hg_norm_w[i_ * 512 + 8 * lane + e]; rk[e] = P.rw_r_k[i_ * 512 + 8 * lane + e];
        lw[e] = P.rw_ln_w[i_ * 512 + 8 * lane + e]; lbv[e] = P.rw_ln_b[i_ * 512 + 8 * lane + e];
    }
    for (int r = r0 + blockIdx.x * 8 + wid; r < NROWS; r += gridDim.x * 8) {
        float y[8];
        {
            float a[8], bb[8], g[8];
            unpack8(*(const u32x4*)(Yf + (size_t)r * D + 8 * lane), a); unpack8(*(const u32x4*)(Yb + (size_t)r * D + 8 * lane), bb);
            unpack8(*(const u32x4*)(Pb + (size_t)r * LDP_ODD + 2048 + 8 * lane), g);
            float ss = 0.f;
#pragma unroll
            for (int e = 0; e < 8; ++e) { y[e] = a[e] + bb[e]; ss += y[e] * y[e]; }
            const float rn = rsqrtf(group_sum<16>(ss) * (1.f / 128.f) + 1e-6f);
#pragma unroll
            for (int e = 0; e < 8; ++e) y[e] = y[e] * rn * nwc[e] * siluf_(g[e]);
            *(u32x4*)(feat + (size_t)r * D + 8 * lane) = pack8(y);
        }
        {
            float a[8], bb[8], rr[8], kk[8], vv[8], g[8];
            unpack8(*(const u32x4*)(Yf + (size_t)r * D + 512 + 8 * lane), a); unpack8(*(const u32x4*)(Yb + (size_t)r * D + 512 + 8 * lane), bb);
            unpack8(*(const u32x4*)(R + (size_t)r * 512 + 8 * lane), rr); unpack8(*(const u32x4*)(K + (size_t)r * 512 + 8 * lane), kk);
            unpack8(*(const u32x4*)(V + (size_t)r * 512 + 8 * lane), vv); unpack8(*(const u32x4*)(G + (size_t)r * 512 + 8 * lane), g);
            float s = 0.f, bs = 0.f;
#pragma unroll
            for (int e = 0; e < 8; ++e) { y[e] = a[e] + bb[e]; s += y[e]; bs += rr[e] * kk[e] * rk[e]; }
            const float mean = group_sum<8>(s) * (1.f / 64.f); bs = group_sum<8>(bs);
            float ss = 0.f;
#pragma unroll
            for (int e = 0; e < 8; ++e) { y[e] -= mean; ss += y[e] * y[e]; }
            const float rn = rsqrtf(group_sum<8>(ss) * (1.f / 64.f) + 64e-5f);
#pragma unroll
            for (int e = 0; e < 8; ++e) y[e] = (y[e] * rn * lw[e] + lbv[e] + bs * vv[e]) * g[e];
            *(u32x4*)(feat + (size_t)r * D + 512 + 8 * lane) = pack8(y);
        }
    }
}

#ifndef MK_DOUBLE
#define MK_DOUBLE 0
#endif
#define REP(bit, body) do { body; if (MK_DOUBLE & (bit)) { body; } } while (0)
__device__ __forceinline__ void phase_expconv(int wv, KP Pk, int layer, LAS char* lds) {
    asm volatile("" : "+s"(Pk));
    const CAS Params& P = *Pk;
    const int tid = ltid(wv), lane = tid & 63, wid = tid >> 6;
    {
        LAS float* scr = (LAS float*)(lds + wid * 8448);
        const int gw = blockIdx.x * 8 + wid, NGW = gridDim.x * 8;
        bf16_t* gu = (bf16_t*)(P.ws + WS_EXPGU); bf16_t* dw = (bf16_t*)(P.ws + WS_EXPD);
        constexpr int IG = 16 * 16, IDN = 8 * 32;
        for (int it = gw; it < NEXP * (2 * IG + IDN); it += NGW) {
            const int e = it / (2 * IG + IDN); int r = it % (2 * IG + IDN);
            const size_t eo = (size_t)(layer * NEXP + e);
            if (r < IG) { transpose_item(P.exp_w_gate + eo * D * DEXP, D, DEXP, gu + (size_t)e * 1024 * 1024, 1, scr, r, lane); continue; } r -= IG;
            if (r < IG) { transpose_item(P.exp_w_up + eo * D * DEXP, D, DEXP, gu + (size_t)e * 1024 * 1024, 2, scr, r, lane); continue; } r -= IG;
            transpose_item(P.exp_w_down + eo * DEXP * D, DEXP, D, dw + (size_t)e * 1024 * 512, 0, scr, r, lane);
        }
    }
}
constexpr int L1_AST = 1028;
constexpr int L1_PST = 33;
constexpr int L1_A = 0, L1_PART = L1_A + 16 * L1_AST * 4, L1_SM = L1_PART + 8 * 16 * L1_PST * 4, L1_END = L1_SM + (64 + 2 * 144 + 32) * 4;
static_assert(L1_END <= LDS_BYTES - 16, "LN1 LDS map");
__device__ __forceinline__ void phase_ln1(int wv, KP Pk, int layer, LAS char* lds, bool dry = false) {
    asm volatile("" : "+s"(Pk));
    const CAS Params& P = *Pk;
    const int tid = ltid(wv), lane = tid & 63;
    if (!dry) REP(8, phase_expconv(wv, Pk, layer, lds));
    __syncthreads();
    LAS float* At = (LAS float*)(lds + L1_A);
    LAS float* part = (LAS float*)(lds + L1_PART);
    LAS int* lcnt = (LAS int*)(lds + L1_SM);
    LAS int* lbase = lcnt + 32;
    LAS int* asg = lcnt + 64;
    LAS float* rbias = (LAS float*)(asg + 2 * 144);
    if (tid < 32) { lcnt[tid] = 0; rbias[tid] = P.router_bias[tid]; }
    float breg[8][4][2];
    {
        const float* rw = P.router_w + (size_t)(128 * wv + 4 * (lane >> 4)) * NEXP + (lane & 15);
#pragma unroll
        for (int j = 0; j < 8; ++j)
#pragma unroll
            for (int i = 0; i < 4; ++i) { breg[j][i][0] = rw[(16 * j + i) * NEXP]; breg[j][i][1] = rw[(16 * j + i) * NEXP + 16]; }
    }
    __syncthreads();
    const bf16_t* yo = (const bf16_t*)(P.ws + WS_YO);
    bf16_t* act = (bf16_t*)(P.ws + (dry ? WS_FEAT : WS_ACT));
    float* xc = (float*)(P.ws + WS_XC);
    int* cnt = (int*)(P.ws + WS_CNT) + layer * 32 * CNT_STRIDE;
    int* list = (int*)(P.ws + WS_LIST);
    float* wts = (float*)(P.ws + WS_WTS);
    const float* lg = P.ln_g + (size_t)(layer * 2 + 0) * D; const float* lb = P.ln_b + (size_t)(layer * 2 + 0) * D;
    const int r0 = (layer == DEPTH - 1) ? NCTX : 0, ntiles = (NROWS - r0) / 16, G = gridDim.x;
    f32x4 g1v[4], s2c[4], h2c[4];
#pragma unroll
    for (int i = 0; i < 4; ++i) g1v[i] = s2c[i] = h2c[i] = (f32x4){0.f, 0.f, 0.f, 0.f};
    int mcur = -1;
    f32x4 nx[2][4]; u32x2 nyo[2][4];
    auto fetch = [&](int s, int rr) {
        const float* xq = layer == 0 ? (rr < NCTX ? P.ctx + (size_t)rr * D : P.x + (size_t)(rr - NCTX) * D)
                                     : (rr < NCTX ? xc + (size_t)rr * D : P.out + (size_t)(rr - NCTX) * D);
#pragma unroll
        for (int i = 0; i < 4; ++i) { const int c = 4 * lane + 256 * i; nx[s][i] = *(const f32x4*)(xq + c); nyo[s][i] = *(const u32x2*)(yo + (size_t)rr * D + c); }
    };
    int tile = blockIdx.x;
    if (tile < ntiles) { fetch(0, r0 + tile * 16 + 2 * wv); fetch(1, r0 + tile * 16 + 2 * wv + 1); }
    for (int it = 0; tile < ntiles; ++it, tile += G) {
        const int rb = r0 + tile * 16 + 2 * wv;
        const int m = row_mod(rb);
        if (m != mcur) {
            mcur = m;
            const float* g1 = modvec(P.ws, layer, m, 2); const float* sh2 = modvec(P.ws, layer, m, 3); const float* sc2 = modvec(P.ws, layer, m, 4);
#pragma unroll
            for (int i = 0; i < 4; ++i) { const int c = 4 * lane + 256 * i; g1v[i] = *(const f32x4*)(g1 + c); s2c[i] = *(const f32x4*)(sc2 + c); h2c[i] = *(const f32x4*)(sh2 + c); }
        }
#pragma unroll
        for (int s = 0; s < 2; ++s) {
            const int r = rb + s;
            float* xr = r < NCTX ? xc + (size_t)r * D : P.out + (size_t)(r - NCTX) * D;
            f32x4 v[4]; float sm = 0.f;
#pragma unroll
            for (int i = 0; i < 4; ++i) {
                const f32x4 xv = nx[s][i], gv = g1v[i]; const u32x2 yv = nyo[s][i];
                v[i][0] = ALPHA * xv[0] + gv[0] * bflo(yv.x); v[i][1] = ALPHA * xv[1] + gv[1] * bfhi(yv.x);
                v[i][2] = ALPHA * xv[2] + gv[2] * bflo(yv.y); v[i][3] = ALPHA * xv[3] + gv[3] * bfhi(yv.y);
                sm += (v[i][0] + v[i][1]) + (v[i][2] + v[i][3]);
            }
            if (tile + G < ntiles) fetch(s, r + G * 16);
            const float mean = wave_sum(sm) * (1.f / D);
            float s2 = 0.f;
#pragma unroll
            for (int i = 0; i < 4; ++i) { v[i] = v[i] - mean; s2 += (v[i][0] * v[i][0] + v[i][1] * v[i][1]) + (v[i][2] * v[i][2] + v[i][3] * v[i][3]); }
            const float rstd = rsqrtf(wave_sum(s2) * (1.f / D) + 1e-5f);
            LAS float* arow = At + (2 * wv + s) * L1_AST;
#pragma unroll
            for (int i = 0; i < 4; ++i) {
                const int c = 4 * lane + 256 * i;
                const f32x4 gg = *(const f32x4*)(lg + c), bb = *(const f32x4*)(lb + c), s2v = s2c[i], h2v = h2c[i];
                f32x4 xn, hv;
#pragma unroll
                for (int j = 0; j < 4; ++j) { xn[j] = v[i][j] * rstd * gg[j] + bb[j]; hv[j] = xn[j] * (1.f + s2v[j]) + h2v[j]; }
                *(f32x4*)((dry ? (float*)(P.ws + WS_YF) + (size_t)r * D : xr) + c) = xn;
                u32x2 o; o.x = pk2(hv[0], hv[1]); o.y = pk2(hv[2], hv[3]); *(u32x2*)(act + (size_t)r * D + c) = o;
                *(LAS f32x4*)(arow + c) = hv;
            }
        }
        __syncthreads();
        {
            f32x4 ra0 = (f32x4){0.f, 0.f, 0.f, 0.f}, ra1 = ra0;
            const LAS float* ap = At + (lane & 15) * L1_AST + 128 * wv + 4 * (lane >> 4);
#pragma unroll
            for (int j = 0; j < 8; ++j) {
                const f32x4 a4 = *(const LAS f32x4*)(ap + 16 * j);
#pragma unroll
                for (int i = 0; i < 4; ++i) {
                    ra0 = __builtin_amdgcn_mfma_f32_16x16x4f32(a4[i], breg[j][i][0], ra0, 0, 0, 0);
                    ra1 = __builtin_amdgcn_mfma_f32_16x16x4f32(a4[i], breg[j][i][1], ra1, 0, 0, 0);
                }
            }
            LAS float* pw = part + wv * 16 * L1_PST + (4 * (lane >> 4)) * L1_PST + (lane & 15);
#pragma unroll
            for (int j = 0; j < 4; ++j) { pw[j * L1_PST] = ra0[j]; pw[j * L1_PST + 16] = ra1[j]; }
        }
        __syncthreads();
        {
            const int half = lane >> 5, e = lane & 31;
            const LAS float* pp = part + (2 * wv + half) * L1_PST + e;
            float sc_ = 0.f;
#pragma unroll
            for (int k = 0; k < 8; ++k) sc_ += pp[k * 16 * L1_PST];
            const float sg = sigmoidf_(sc_), vb = sg + rbias[e];
            float bv[4], sv[4];
            bv[0] = dppmov<0x00>(vb); bv[1] = dppmov<0x55>(vb); bv[2] = dppmov<0xAA>(vb); bv[3] = dppmov<0xFF>(vb);
            sv[0] = dppmov<0x00>(sg); sv[1] = dppmov<0x55>(sg); sv[2] = dppmov<0xAA>(sg); sv[3] = dppmov<0xFF>(sg);
            float m1 = -1e30f, m2 = -1e30f;
#pragma unroll
            for (int k = 0; k < 4; ++k) { const float vsc = bv[k]; if (vsc > m1) { m2 = m1; m1 = vsc; } else if (vsc > m2) m2 = vsc; }
            float best = m1 + m2; int bg = e >> 2;
#pragma unroll
            for (int msk = 4; msk <= 16; msk <<= 1) {
                const float ob = __shfl_xor(best, msk); const int og = __shfl_xor(bg, msk);
                const bool take = (ob > best) || (ob == best && og < bg);
                best = take ? ob : best; bg = take ? og : bg;
            }
            int i1 = 0; float b1 = bv[0];
#pragma unroll
            for (int k = 1; k < 4; ++k) if (bv[k] > b1) { b1 = bv[k]; i1 = k; }
            int i2 = -1; float b2 = -1e30f;
#pragma unroll
            for (int k = 0; k < 4; ++k) if (k != i1 && bv[k] > b2) { b2 = bv[k]; i2 = k; }
            float s1 = sv[0], s2s = sv[0];
#pragma unroll
            for (int k = 1; k < 4; ++k) { if (i1 == k) s1 = sv[k]; if (i2 == k) s2s = sv[k]; }
            if (e == 4 * bg && !dry) {
                const int r = rb + half;
                const int e0 = bg * 4 + i1, e1 = bg * 4 + i2;
                const float inv = 1.f / (s1 + s2s);
                const int li = it * 16 + 2 * wv + half;
                const int p0 = __hip_atomic_fetch_add(&lcnt[e0], 1, __ATOMIC_RELAXED, __HIP_MEMORY_SCOPE_WORKGROUP);
                const int p1 = __hip_atomic_fetch_add(&lcnt[e1], 1, __ATOMIC_RELAXED, __HIP_MEMORY_SCOPE_WORKGROUP);
                asg[2 * li] = (e0 << 16) | p0; asg[2 * li + 1] = (e1 << 16) | p1;
                wts[2 * r] = s1 * inv; wts[2 * r + 1] = s2s * inv;
            }
        }
    }
    __syncthreads();
    if (dry) return;
    if (tid < 32) lbase[tid] = atomicAdd(&cnt[tid * CNT_STRIDE], lcnt[tid]);
    __syncthreads();
    for (int idx = tid; idx < 2 * 144; idx += NT) {
        const int li = idx >> 1, k = idx & 1, t = (li >> 4) * G + blockIdx.x;
        if (t < ntiles) { const int r = r0 + t * 16 + (li & 15); const int v = asg[idx], e = v >> 16, lp = v & 0xffff; list[(size_t)e * LISTCAP + lbase[e] + lp] = 2 * r + k; }
    }
}

__device__ __forceinline__ void phase_ln2(int wv, KP Pk, int layer, bool dry = false) {
    asm volatile("" : "+s"(Pk));
    const CAS Params& P = *Pk;
    const int tid = ltid(wv), lane = tid & 63, wid = tid >> 6;
    const bf16_t* yp = (const bf16_t*)(P.ws + WS_YP);
    const float* wts = (const float*)(P.ws + WS_WTS);
    bf16_t* act = (bf16_t*)(P.ws + (dry ? WS_FEAT : WS_ACT));
    float* xc = (float*)(P.ws + WS_XC);
    const float* lg = P.ln_g + (size_t)(layer * 2 + 1) * D; const float* lb = P.ln_b + (size_t)(layer * 2 + 1) * D;
    const bool last = (layer == DEPTH - 1);
    const int r0 = last ? NCTX : 0, stride = gridDim.x * 8;
    f32x4 cg[4], cb[4], g2v[4], s1v[4], h1v[4];
#pragma unroll
    for (int i = 0; i < 4; ++i) { cg[i] = *(const f32x4*)(lg + 4 * lane + 256 * i); cb[i] = *(const f32x4*)(lb + 4 * lane + 256 * i); g2v[i] = s1v[i] = h1v[i] = (f32x4){0.f, 0.f, 0.f, 0.f}; }
    int mcur = -1;
    f32x4 nx[4]; u32x2 ny0[4], ny1[4]; float nw0 = 0.f, nw1 = 0.f;
    auto fetch = [&](int r) {
        const float* xr = r < NCTX ? xc + (size_t)r * D : P.out + (size_t)(r - NCTX) * D;
#pragma unroll
        for (int i = 0; i < 4; ++i) {
            const int c = 4 * lane + 256 * i;
            nx[i] = *(const f32x4*)(xr + c); ny0[i] = *(const u32x2*)(yp + (size_t)(2 * r) * D + c); ny1[i] = *(const u32x2*)(yp + (size_t)(2 * r + 1) * D + c);
        }
        nw0 = wts[2 * r]; nw1 = wts[2 * r + 1];
    };
    int r = r0 + blockIdx.x * 8 + wid;
    if (r < NROWS) fetch(r);
    for (; r < NROWS; r += stride) {
        const int m = row_mod(r);
        float* xr = r < NCTX ? xc + (size_t)r * D : P.out + (size_t)(r - NCTX) * D;
        if (m != mcur) {
            mcur = m;
            const float* g2 = modvec(P.ws, layer, m, 5); const float* sh1 = last ? lg : modvec(P.ws, layer + 1, m, 0); const float* sc1 = last ? lg : modvec(P.ws, layer + 1, m, 1);
#pragma unroll
            for (int i = 0; i < 4; ++i) { const int c = 4 * lane + 256 * i; g2v[i] = *(const f32x4*)(g2 + c); s1v[i] = *(const f32x4*)(sc1 + c); h1v[i] = *(const f32x4*)(sh1 + c); }
        }
        f32x4 v[4]; float s = 0.f;
        const float w0 = nw0, w1 = nw1;
#pragma unroll
        for (int i = 0; i < 4; ++i) {
            const f32x4 xv = nx[i], gv = g2v[i]; const u32x2 y0 = ny0[i], y1 = ny1[i];
            v[i][0] = ALPHA * xv[0] + gv[0] * (w0 * bflo(y0.x) + w1 * bflo(y1.x)); v[i][1] = ALPHA * xv[1] + gv[1] * (w0 * bfhi(y0.x) + w1 * bfhi(y1.x));
            v[i][2] = ALPHA * xv[2] + gv[2] * (w0 * bflo(y0.y) + w1 * bflo(y1.y)); v[i][3] = ALPHA * xv[3] + gv[3] * (w0 * bfhi(y0.y) + w1 * bfhi(y1.y));
            s += (v[i][0] + v[i][1]) + (v[i][2] + v[i][3]);
        }
        if (r + stride < NROWS) fetch(r + stride);
        const float mean = wave_sum(s) * (1.f / D);
        float s2 = 0.f;
#pragma unroll
        for (int i = 0; i < 4; ++i) { v[i] = v[i] - mean; s2 += (v[i][0] * v[i][0] + v[i][1] * v[i][1]) + (v[i][2] * v[i][2] + v[i][3] * v[i][3]); }
        const float rstd = rsqrtf(wave_sum(s2) * (1.f / D) + 1e-5f);
#pragma unroll
        for (int i = 0; i < 4; ++i) {
            const int c = 4 * lane + 256 * i;
            f32x4 xn;
#pragma unroll
            for (int j = 0; j < 4; ++j) xn[j] = v[i][j] * rstd * cg[i][j] + cb[i][j];
            *(f32x4*)((dry ? (float*)(P.ws + WS_YF) + (size_t)r * D : xr) + c) = xn;
            if (!last) {
                u32x2 o; o.x = pk2(xn[0] * (1.f + s1v[i][0]) + h1v[i][0], xn[1] * (1.f + s1v[i][1]) + h1v[i][1]); o.y = pk2(xn[2] * (1.f + s1v[i][2]) + h1v[i][2], xn[3] * (1.f + s1v[i][3]) + h1v[i][3]);
                *(u32x2*)(act + (size_t)r * D + c) = o;
            }
        }
    }
}

constexpr int NPHASE = 2 + 11 * DEPTH;
__global__ void __launch_bounds__(NT, 2) fwd_kernel(Params P) {
    extern __shared__ __attribute__((aligned(16))) char lds_raw[];
    LAS char* lds = (LAS char*)lds_raw;
    volatile LAS unsigned* xbw = (volatile LAS unsigned*)(lds + LDS_BYTES - 16);
    KP Pk = (KP)__builtin_amdgcn_kernarg_segment_ptr();
    const int wv = __builtin_amdgcn_readfirstlane((int)(threadIdx.x >> 6));
    const bool multi = (P.ph_hi - P.ph_lo) > 1;
    XcdBarrier bar; bar.bar = (unsigned*)(P.ws + WS_BAR); bar.x = 0; bar.st = xbw;
    if (multi) {
        if (ltid(wv) == 0) { xbw[0] = 0u; xbw[1] = 0u; xbw[2] = 0u; xbw[3] = 0u; }
        __syncthreads();
        bar = xcd_barrier_post(wv, (unsigned*)(P.ws + WS_BAR), xbw);
    }
#define PHASE(id, body) do { if (P.ph_lo <= (id) && (id) < P.ph_hi) { body; if ((id) + 1 < P.ph_hi) xcd_barrier(wv, bar); if (MK_DOUBLE & 2048) xcd_barrier(wv, bar); } } while (0)
    PHASE(0, REP(16, phase_prologue0(wv, Pk, lds)));
    PHASE(1, REP(16, phase_prologue1(wv, Pk)));
    for (int l = 0; l < DEPTH; ++l) {
        const int pb = 2 + 11 * l, odd = l & 1;
        PHASE(pb + 0, REP(1, phase_inproj(wv, Pk, l, lds)));
        if (odd) {
            PHASE(pb + 1, REP(4, phase_prep1(wv, Pk, l)));
            PHASE(pb + 2, phase_prep2(wv, Pk, l, lds));
            PHASE(pb + 3, REP(32, { if (blockIdx.x < 128) REP(64, scan_hgrn_c(wv, Pk, l, blockIdx.x, lds)); else if (blockIdx.x < 256) REP(128, scan_rwkv(wv, Pk, l, blockIdx.x - 128, lds)); }));
            PHASE(pb + 5, REP(4, phase_out_odd(wv, Pk, l)));
        } else {
            PHASE(pb + 1, REP(4, phase_prep_even(wv, Pk, l)));
            PHASE(pb + 2, REP(2, phase_ex1(wv, Pk, l, lds)));
            PHASE(pb + 3, phase_ex2(wv, Pk, l));
            PHASE(pb + 4, REP(2, phase_ex3(wv, Pk, l, lds)));
            PHASE(pb + 5, REP(4, phase_out_even(wv, Pk, l)));
        }
        PHASE(pb + 6, REP(256, phase_outproj(wv, Pk, l, lds)));
        PHASE(pb + 7, { if (MK_DOUBLE & 4096) phase_ln1(wv, Pk, l, lds, true); phase_ln1(wv, Pk, l, lds); });
        PHASE(pb + 8, REP(512, phase_moe1(wv, Pk, l, lds)));
        PHASE(pb + 9, REP(1024, phase_moe2(wv, Pk, l, lds)));
        PHASE(pb + 10, { if (MK_DOUBLE & 8192) phase_ln2(wv, Pk, l, true); phase_ln2(wv, Pk, l); });
    }
#undef PHASE
}


#ifndef MK_STOP
#define MK_STOP NPHASE
#endif
#ifndef MK_DUMP
#define MK_DUMP 0
#endif
#ifndef MK_DUMP_N
#define MK_DUMP_N (1u << 30)
#endif
#ifndef MK_DUMP_LD
#define MK_DUMP_LD 1024
#endif
#ifndef MK_DUMP_C0
#define MK_DUMP_C0 0
#endif
__global__ void diff_kernel(const bf16_t* a, const bf16_t* b, float* out, size_t n) {
    for (size_t i = (size_t)blockIdx.x * blockDim.x + threadIdx.x; i < n; i += (size_t)gridDim.x * blockDim.x) out[i] = 1e6f * (bf2f(a[i]) - bf2f(b[i]));
}
__global__ void dump_kernel(const bf16_t* src, float* out, size_t n) {
    for (size_t i = (size_t)blockIdx.x * blockDim.x + threadIdx.x; i < n; i += (size_t)gridDim.x * blockDim.x) out[i] = i < (size_t)MK_DUMP_N ? bf2f(src[(i >> 10) * MK_DUMP_LD + MK_DUMP_C0 + (i & 1023)]) : 0.f;
}
extern "C" void kernel_launch(void* const* d_in, const int* in_sizes, int n_in, void* d_out, int out_size, void* d_ws, size_t ws_size, hipStream_t stream) {
    static int ready = 0;
    if (ready == 0) {
        ready = 1;
        if (n_in != 42 || out_size != NB * SEQ * D || ws_size < WS_END) { fprintf(stderr, "kernel_launch: unexpected shapes (n_in %d out %d ws %zu need %zu)\n", n_in, out_size, ws_size, (size_t)WS_END); ready = -1; }
        if (hipFuncSetAttribute((const void*)fwd_kernel, hipFuncAttributeMaxDynamicSharedMemorySize, LDS_BYTES) != hipSuccess) { fprintf(stderr, "kernel_launch: hipFuncSetAttribute failed\n"); ready = -1; }
    }
    if (ready < 0) return;
    (void)in_sizes;
    hipMemsetAsync((char*)d_ws + WS_BAR, 0, WS_ZERO_BYTES, stream);
    Params p;
    memset(&p, 0, sizeof(p));
    const float** fp = (const float**)&p;
    for (int i = 0; i < 42; ++i) fp[i] = (const float*)d_in[i];
    p.out = (float*)d_out; p.ws = (unsigned char*)d_ws;
#if MK_PER_PHASE
    for (int ph = 0; ph < MK_STOP; ++ph) {
        const int local = ph < 2 ? -1 : (ph - 2) % 11, layer = ph < 2 ? 0 : (ph - 2) / 11;
        if (local == 4 && (layer & 1)) continue;
        p.ph_lo = ph; p.ph_hi = ph + 1;
        hipLaunchKernelGGL(fwd_kernel, dim3(256), dim3(NT), LDS_BYTES, stream, p);
    }
#ifdef MK_DIFF
    p.ph_lo = 7; p.ph_hi = 8; p.dbg = 1;
    hipLaunchKernelGGL(fwd_kernel, dim3(256), dim3(NT), LDS_BYTES, stream, p);
    hipLaunchKernelGGL(diff_kernel, dim3(1024), dim3(256), 0, stream, (const bf16_t*)((unsigned char*)d_ws + WS_YO), (const bf16_t*)((unsigned char*)d_ws + WS_HID), (float*)d_out, (size_t)NB * SEQ * D);
#else
    if (MK_DUMP) hipLaunchKernelGGL(dump_kernel, dim3(1024), dim3(256), 0, stream, (const bf16_t*)((unsigned char*)d_ws + (size_t)MK_DUMP), (float*)d_out, (size_t)NB * SEQ * D);
#endif
#else
    p.ph_lo = 0; p.ph_hi = NPHASE;
    hipLaunchKernelGGL(fwd_kernel, dim3(256), dim3(NT), LDS_BYTES, stream, p);
#endif
}
```

```cpp
#include <hip/hip_runtime.h>
#include <stdint.h>
#include <stdio.h>
#include <string.h>

#ifndef MK_PER_PHASE
#define MK_PER_PHASE 0
#endif

typedef unsigned short bf16_t;
typedef short bf16x8 __attribute__((ext_vector_type(8)));
typedef float f32x4 __attribute__((ext_vector_type(4)));
typedef unsigned u32x4 __attribute__((ext_vector_type(4)));
typedef unsigned u32x2 __attribute__((ext_vector_type(2)));
#define LAS __attribute__((address_space(3)))
#define CAS __attribute__((address_space(4)))

constexpr int D = 1024, NB = 4, SEQ = 8192, CTXL = 256, DEPTH = 4;
constexpr int NCTX = NB * CTXL;
constexpr int NROWS = NCTX + NB * SEQ;
constexpr int P_EVEN = 2848, P_ODD = 4416, LDP_EVEN = 3072, LDP_ODD = 4608;
constexpr int NEXP = 32, DEXP = 512, LISTCAP = NROWS;
constexpr float ALPHA = 1.681792830507429f;
constexpr int NT = 512;
constexpr int TCH = 32;
constexpr int NSTEPS = CTXL + SEQ;
constexpr int LDS_BYTES = 160 * 1024;

constexpr size_t al256(size_t x) { return (x + 255) & ~(size_t)255; }
constexpr size_t WS_BAR = 0;
constexpr size_t WS_CNT = 16384;
constexpr int CNT_STRIDE = 64;
constexpr size_t WS_ZERO_BYTES = 16384 + (size_t)4 * 32 * CNT_STRIDE * 4;
constexpr size_t WS_MODV = al256(WS_ZERO_BYTES);
constexpr size_t WS_LB = WS_MODV + al256((size_t)4 * 5 * 6144 * 4);
constexpr size_t WS_XC = WS_LB + al256(4 * 512 * 4);
constexpr size_t WS_WTS = WS_XC + (size_t)NCTX * D * 4;
constexpr size_t WS_LIST = WS_WTS + al256((size_t)2 * NROWS * 4);
constexpr size_t WS_WINT = WS_LIST + al256((size_t)NEXP * LISTCAP * 4);
constexpr size_t WINT_L0 = 0, WINT_L1 = (size_t)LDP_EVEN * D, WINT_L2 = WINT_L1 + (size_t)LDP_ODD * D, WINT_L3 = WINT_L2 + (size_t)LDP_EVEN * D, WINT_END = WINT_L3 + (size_t)LDP_ODD * D;
constexpr size_t WS_WOUTT = WS_WINT + WINT_END * 2;
constexpr size_t WS_LORAT = WS_WOUTT + (size_t)4 * D * D * 2;
constexpr size_t LORA_PER = (size_t)512 * 320;
constexpr size_t WS_EXPGU = WS_LORAT + al256(2 * LORA_PER * 2);
constexpr size_t WS_EXPD = WS_EXPGU + (size_t)NEXP * 1024 * 1024 * 2;
constexpr size_t WS_ACT = WS_EXPD + (size_t)NEXP * 1024 * 512 * 2;
constexpr size_t ROWB = (size_t)NROWS * D * 2;
constexpr size_t WS_FEAT = WS_ACT + ROWB;
constexpr size_t WS_YF = WS_FEAT + ROWB;
constexpr size_t WS_YB = WS_YF + ROWB;
constexpr size_t WS_P = WS_YB + ROWB;
constexpr size_t P_BYTES = (size_t)NROWS * LDP_ODD * 2;
constexpr size_t WS_YO = WS_P;
constexpr size_t WS_HID = WS_P + ROWB;
constexpr size_t WS_YP = WS_HID + ROWB;
static_assert(WS_YP + 2 * ROWB <= WS_P + P_BYTES, "MoE buffers must fit in the P region");
constexpr size_t HALFB = (size_t)NROWS * 512 * 2;
constexpr size_t WS_RWR = WS_P + P_BYTES;
constexpr size_t WS_RWK = WS_RWR + HALFB;
constexpr size_t WS_RWV = WS_RWK + HALFB;
constexpr size_t WS_RWKK = WS_RWV + HALFB;
constexpr size_t WS_RWB = WS_RWKK + HALFB;
constexpr size_t WS_RWG = WS_RWB + HALFB;
constexpr size_t WS_RWDEC = WS_RWG + HALFB;
constexpr size_t WS_LA = WS_RWDEC + (size_t)2 * NROWS * 512 * 4;
constexpr size_t WS_END = WS_LA + (size_t)NROWS * 320 * 2;
static_assert(WS_END <= (size_t)280602384 * 4, "workspace map exceeds the guaranteed ws_size");

struct Params {
    const float *x, *c, *ctx, *c_ctx, *mod_w, *mod_b, *ln_g, *ln_b;
    const float *ev_w_in, *ev_w_out, *ssd_conv_w, *ssd_conv_b, *ssd_dt_bias, *ssd_a_log, *ssd_d, *ssd_norm_w;
    const float *ml_conv_w, *ml_conv_b, *ml_i_bias, *ml_f_bias, *ml_norm_w;
    const float *od_w_in, *od_w_out, *hg_lb_logits, *hg_f_bias, *hg_norm_w;
    const float *rw_mu, *rw_w0, *rw_w2, *rw_a0, *rw_a2, *rw_g2, *rw_k_k, *rw_k_a, *rw_r_k, *rw_ln_w, *rw_ln_b;
    const float *router_w, *router_bias, *exp_w_gate, *exp_w_up, *exp_w_down;
    float* out;
    unsigned char* ws;
    int ph_lo, ph_hi, dbg, pad_;
};
typedef const CAS Params* KP;

__device__ __forceinline__ int ltid(int wv) { int l; asm volatile("v_mbcnt_lo_u32_b32 %0, -1, 0\n\tv_mbcnt_hi_u32_b32 %0, -1, %0" : "=v"(l)); return wv * 64 + l; }
__device__ __forceinline__ float bf2f(bf16_t h) { return __uint_as_float(((unsigned)h) << 16); }
__device__ __forceinline__ float bflo(unsigned u) { return __uint_as_float(u << 16); }
__device__ __forceinline__ float bfhi(unsigned u) { return __uint_as_float(u & 0xffff0000u); }
typedef __bf16 bf16v2_t __attribute__((ext_vector_type(2)));
typedef float f32x2 __attribute__((ext_vector_type(2)));
__device__ __forceinline__ unsigned pk2(float lo, float hi) { const f32x2 v = {lo, hi}; return __builtin_bit_cast(unsigned, __builtin_convertvector(v, bf16v2_t)); }
__device__ __forceinline__ bf16_t f2bf(float f) { return (bf16_t)(pk2(f, 0.f) & 0xffffu); }
__device__ __forceinline__ void unpack8(const u32x4& u, float* f) {
    f[0] = bflo(u.x); f[1] = bfhi(u.x); f[2] = bflo(u.y); f[3] = bfhi(u.y); f[4] = bflo(u.z); f[5] = bfhi(u.z); f[6] = bflo(u.w); f[7] = bfhi(u.w);
}
__device__ __forceinline__ u32x4 pack8(const float* f) { u32x4 u; u.x = pk2(f[0], f[1]); u.y = pk2(f[2], f[3]); u.z = pk2(f[4], f[5]); u.w = pk2(f[6], f[7]); return u; }
__device__ __forceinline__ float sigmoidf_(float x) { return __builtin_amdgcn_rcpf(1.f + __expf(-x)); }
__device__ __forceinline__ float siluf_(float x) { return x * __builtin_amdgcn_rcpf(1.f + __expf(-x)); }
__device__ __forceinline__ float softplus_fast(float x) { return x > 20.f ? x : __logf(1.f + __expf(x)); }
__device__ __forceinline__ float tanh_fast(float x) { return 1.f - 2.f * __builtin_amdgcn_rcpf(1.f + __expf(2.f * x)); }
__device__ __forceinline__ float softplusf_(float x) { return x > 20.f ? x : __logf(1.f + __expf(x)); }
__device__ __forceinline__ float logsigmoidf_(float x) { return fminf(x, 0.f) - __logf(1.f + __expf(-fabsf(x))); }
template <int CTRL> __device__ __forceinline__ float dppmov(float v) {
    return __builtin_bit_cast(float, __builtin_amdgcn_update_dpp(0, __builtin_bit_cast(int, v), CTRL, 0xf, 0xf, true));
}
__device__ __forceinline__ float allreduce16(float v) {
    v += dppmov<0xB1>(v);
    v += dppmov<0x4E>(v);
    v += dppmov<0x141>(v);
    v += dppmov<0x140>(v);
    return v;
}
__device__ __forceinline__ float allreduce8_(float v) { v += dppmov<0xB1>(v); v += dppmov<0x4E>(v); v += dppmov<0x141>(v); return v; }
__device__ __forceinline__ float wave_sum(float v) {
    v = allreduce16(v);
    const float r0 = __builtin_bit_cast(float, __builtin_amdgcn_readlane(__builtin_bit_cast(int, v), 0)), r1 = __builtin_bit_cast(float, __builtin_amdgcn_readlane(__builtin_bit_cast(int, v), 16));
    const float r2 = __builtin_bit_cast(float, __builtin_amdgcn_readlane(__builtin_bit_cast(int, v), 32)), r3 = __builtin_bit_cast(float, __builtin_amdgcn_readlane(__builtin_bit_cast(int, v), 48));
    return (r0 + r1) + (r2 + r3);
}
template <int W> __device__ __forceinline__ float group_sum(float v) {
    if (W == 8) return allreduce8_(v);
    return allreduce16(v);
}

#define XB_TMO      128
#define XB_XCNT(j)  (256  + 64 * (j))
#define XB_XSUB(j)  (1280 + 64 * (j))
#define XB_XGEN(j)  (2304 + 64 * (j))
#define XB_TOP      3328
#define XB_TOPGEN   3392
#define XCD_BAR_WORDS 3456
#define XB_SPIN_CAP (1u << 22)
__device__ __forceinline__ unsigned xb_ld(unsigned* p)              { return __hip_atomic_load(p, __ATOMIC_RELAXED, __HIP_MEMORY_SCOPE_AGENT); }
__device__ __forceinline__ unsigned xb_add(unsigned* p, unsigned v) { return __hip_atomic_fetch_add(p, v, __ATOMIC_RELAXED, __HIP_MEMORY_SCOPE_AGENT); }
__device__ __forceinline__ unsigned xb_xcc_id() { return (unsigned)__builtin_amdgcn_s_getreg((3 << 11) | 20) & 0xFu; }
#define XB_SPIN(cond, bar) do { unsigned _sp = 0; while (cond) { __builtin_amdgcn_s_sleep(1); \
    if ((++_sp & 255u) == 0u) { if (xb_ld(&(bar)[XB_TMO])) break; if (_sp > XB_SPIN_CAP) { atomicAdd(&(bar)[XB_TMO], 1u); break; } } } } while (0)
struct XcdBarrier { unsigned* bar; unsigned x; volatile LAS unsigned* st; };
__device__ __forceinline__ XcdBarrier xcd_barrier_post(int wv, unsigned* bar, volatile LAS unsigned* st) {
    XcdBarrier b; b.bar = bar; b.x = xb_xcc_id(); b.st = st;
    if (ltid(wv) == 0) (void)xb_add(&bar[XB_XCNT(b.x)], 1u);
    return b;
}
__device__ __forceinline__ void xcd_barrier_complete(unsigned* bar, unsigned x, unsigned& nloc, unsigned& nx) {
    const unsigned G = gridDim.x * gridDim.y * gridDim.z;
    unsigned sum, cnt, mine, sp = 0u;
    for (;;) {
        sum = 0u; cnt = 0u; mine = 0u;
#pragma unroll
        for (unsigned j = 0; j < 16; ++j) { const unsigned c = xb_ld(&bar[XB_XCNT(j)]); sum += c; cnt += (c > 0u) ? 1u : 0u; mine = (j == x) ? c : mine; }
        if (sum == G) break;
        __builtin_amdgcn_s_sleep(1);
        if ((++sp & 255u) == 0u) { if (xb_ld(&bar[XB_TMO])) break; if (sp > XB_SPIN_CAP) { atomicAdd(&bar[XB_TMO], 1u); break; } }
    }
    nloc = mine > 0u ? mine : 1u; nx = cnt > 0u ? cnt : 1u;
}
__device__ __forceinline__ void xcd_barrier(int wv, const XcdBarrier& b) {
    asm volatile("s_waitcnt vmcnt(0)" ::: "memory");
    __syncthreads();
    if (ltid(wv) == 0) {
        unsigned* bar = b.bar;
        asm volatile("" : "+s"(bar));
        __builtin_amdgcn_s_waitcnt(0);
        unsigned nloc = b.st[0], nx = b.st[1];
        if (nloc == 0u) { xcd_barrier_complete(bar, b.x, nloc, nx); b.st[0] = nloc; b.st[1] = nx; }
        const unsigned old = xb_add(&bar[XB_XSUB(b.x)], 1u);
        const unsigned gen = old / nloc;
        if (old + 1u == (gen + 1u) * nloc) {
            __builtin_amdgcn_fence(__ATOMIC_RELEASE, "agent");
            asm volatile("s_waitcnt vmcnt(0)" ::: "memory");
            const unsigned og = xb_add(&bar[XB_TOP], 1u);
            const unsigned tg = og / nx;
            if (og + 1u == (tg + 1u) * nx) xb_add(&bar[XB_TOPGEN], 1u);
            else XB_SPIN(xb_ld(&bar[XB_TOPGEN]) == tg, bar);
            __builtin_amdgcn_fence(__ATOMIC_ACQUIRE, "agent");
            xb_add(&bar[XB_XGEN(b.x)], 1u);
            asm volatile("s_waitcnt vmcnt(0)" ::: "memory");
        } else {
            XB_SPIN(xb_ld(&bar[XB_XGEN(b.x)]) == gen, bar);
            __builtin_amdgcn_fence(__ATOMIC_ACQUIRE, "agent");
            asm volatile("s_waitcnt vmcnt(0)" ::: "memory");
        }
    }
    __syncthreads();
}

__device__ __forceinline__ int row_mod(int r) { return r < NCTX ? 4 : ((r - NCTX) >> 13); }
__device__ __forceinline__ void row_seg(int r, int& t, int& len) { if (r < NCTX) { t = r & 255; len = CTXL; } else { t = (r - NCTX) & 8191; len = SEQ; } }
__device__ __forceinline__ int scan_row(int tg, int b, int dir, int odd) {
    if (tg < CTXL) { const int t = dir ? (CTXL - 1 - tg) : tg; return b * CTXL + t; }
    int sg = tg - CTXL; if (dir) sg = SEQ - 1 - sg;
    const int s = odd ? (((sg & 127) << 6) + (sg >> 7)) : sg;
    return NCTX + b * SEQ + s;
}
__device__ __forceinline__ const float* modvec(const unsigned char* ws, int layer, int m, int which) {
    return (const float*)(ws + WS_MODV) + ((size_t)(layer * 5 + m) * 6 + which) * D;
}

constexpr int G_BM = 256, G_BN = 128, G_BK = 64;
constexpr int G_ABYTES = G_BM * G_BK * 2, G_BBYTES = G_BN * G_BK * 2, G_BUF = G_ABYTES + G_BBYTES;
__device__ __forceinline__ int swz(int o) { return o ^ (((o >> 9) & 1) << 5); }

template <class RowSrc, class Epi>
__device__ __forceinline__ void gemm_tile(int wv, const bf16_t* __restrict__ A, int lda, const RowSrc& rs, const bf16_t* __restrict__ Bt, int ldb, int n0, int K, const Epi& epi, LAS char* lds) {
    const int tid = ltid(wv), lane = tid & 63, wid = tid >> 6, wm = wid >> 1, wn = wid & 1;
    const bf16_t* ap[4]; int aoff[4];
#pragma unroll
    for (int i = 0; i < 4; ++i) {
        const int c = tid + NT * i, row = c >> 3, kc = c & 7;
        ap[i] = A + (size_t)rs.src(row) * lda + kc * 8;
        aoff[i] = ((row >> 4) * 2 + (kc >> 2)) * 1024 + swz((row & 15) * 64 + (kc & 3) * 16);
    }
    const bf16_t* bp[2]; int boff[2];
#pragma unroll
    for (int i = 0; i < 2; ++i) {
        const int c = tid + NT * i, row = c >> 3, kc = c & 7;
        bp[i] = Bt + (size_t)(n0 + row) * ldb + kc * 8;
        boff[i] = G_ABYTES + ((row >> 4) * 2 + (kc >> 2)) * 1024 + swz((row & 15) * 64 + (kc & 3) * 16);
    }
    f32x4 acc[4][4];
#pragma unroll
    for (int i = 0; i < 4; ++i)
#pragma unroll
        for (int j = 0; j < 4; ++j) acc[i][j] = (f32x4){0.f, 0.f, 0.f, 0.f};
    u32x4 ra[2][4], rb[2][2];
    const int KT = K / G_BK;
    const int fragoff = swz((lane & 15) * 64 + (lane >> 4) * 16);
#define G_LOAD(set, kt_) do { _Pragma("unroll") for (int i = 0; i < 4; ++i) ra[set][i] = *(const u32x4*)(ap[i] + (kt_) * G_BK); \
                              _Pragma("unroll") for (int i = 0; i < 2; ++i) rb[set][i] = *(const u32x4*)(bp[i] + (kt_) * G_BK); } while (0)
#define G_STORE(set, buf) do { _Pragma("unroll") for (int i = 0; i < 4; ++i) *(LAS u32x4*)((buf) + aoff[i]) = ra[set][i]; \
                               _Pragma("unroll") for (int i = 0; i < 2; ++i) *(LAS u32x4*)((buf) + boff[i]) = rb[set][i]; } while (0)
#define G_COMPUTE(cur) do { bf16x8 af[2][4], bfr[2][4]; \
        _Pragma("unroll") for (int ks = 0; ks < 2; ++ks) { \
            _Pragma("unroll") for (int ni = 0; ni < 4; ++ni) bfr[ks][ni] = *(LAS bf16x8*)((cur) + G_ABYTES + ((wn * 4 + ni) * 2 + ks) * 1024 + fragoff); \
            _Pragma("unroll") for (int mi = 0; mi < 4; ++mi) af[ks][mi] = *(LAS bf16x8*)((cur) + ((wm * 4 + mi) * 2 + ks) * 1024 + fragoff); } \
        __builtin_amdgcn_sched_barrier(0); \
        _Pragma("unroll") for (int ks = 0; ks < 2; ++ks) _Pragma("unroll") for (int mi = 0; mi < 4; ++mi) _Pragma("unroll") for (int ni = 0; ni < 4; ++ni) \
            acc[mi][ni] = __builtin_amdgcn_mfma_f32_16x16x32_bf16(bfr[ks][ni], af[ks][mi], acc[mi][ni], 0, 0, 0); \
        __builtin_amdgcn_sched_barrier(0); } while (0)
    G_LOAD(0, 0);
    G_STORE(0, lds);
    if (KT > 1) G_LOAD(0, 1);
    if (KT > 2) G_LOAD(1, 2);
    __syncthreads();
    for (int kt = 0; kt < KT; kt += 2) {
        G_COMPUTE(lds);
        if (kt + 1 < KT) G_STORE(0, lds + G_BUF);
        if (kt + 3 < KT) G_LOAD(0, kt + 3);
        __syncthreads();
        if (kt + 1 < KT) {
            G_COMPUTE(lds + G_BUF);
            if (kt + 2 < KT) G_STORE(1, lds);
            if (kt + 4 < KT) G_LOAD(1, kt + 4);
            __syncthreads();
        }
    }
#undef G_LOAD
#undef G_STORE
#undef G_COMPUTE
    epi(acc, wm * 64 + (lane & 15), wn * 64 + 4 * (lane >> 4));
}

constexpr int G2_BN = 256, G2_BBYTES = G2_BN * G_BK * 2, G2_BUF = G_ABYTES + G2_BBYTES;

struct RowLinear { int m0; __device__ __forceinline__ int src(int r) const { return m0 + r; } };
struct RowList {
    const int* list; int cnt; int shift;
    __device__ __forceinline__ int src(int r) const { const int a = list[r < cnt ? r : 0]; return a >> shift; }
};
struct EpiStoreBf16 {
    bf16_t* C; int ldc; int m0; int n0; int N;
    template <int NI> __device__ __forceinline__ void operator()(const f32x4 (&acc)[4][NI], int rbase, int cbase) const {
#pragma unroll
        for (int mi = 0; mi < 4; ++mi) {
            bf16_t* rowp = C + (size_t)(m0 + rbase + mi * 16) * ldc + n0 + cbase;
#pragma unroll
            for (int ni = 0; ni < NI; ++ni) {
                if (n0 + cbase + ni * 16 < N) { u32x2 v; v.x = pk2(acc[mi][ni][0], acc[mi][ni][1]); v.y = pk2(acc[mi][ni][2], acc[mi][ni][3]); *(u32x2*)(rowp + ni * 16) = v; }
            }
        }
    }
};
struct EpiSwiGLU {
    bf16_t* H; const int* list; int cnt; int n0;
    template <int NI> __device__ __forceinline__ void operator()(const f32x4 (&acc)[4][NI], int rbase, int cbase) const {
#pragma unroll
        for (int mi = 0; mi < 4; ++mi) {
            const int r = rbase + mi * 16;
            if (r < cnt) {
                const int a = list[r];
                const int wnb = cbase & ~63, q4 = cbase & 63;
                bf16_t* rowp = H + (size_t)a * DEXP + ((n0 + wnb) >> 1) + q4;
#pragma unroll
                for (int q = 0; q < NI / 2; ++q) {
                    float o[4];
#pragma unroll
                    for (int j = 0; j < 4; ++j) o[j] = siluf_(acc[mi][2 * q][j]) * acc[mi][2 * q + 1][j];
                    u32x2 v; v.x = pk2(o[0], o[1]); v.y = pk2(o[2], o[3]); *(u32x2*)(rowp + q * 16) = v;
                }
            }
        }
    }
};
struct EpiScatterBf16 {
    bf16_t* C; const int* list; int cnt; int n0;
    template <int NI> __device__ __forceinline__ void operator()(const f32x4 (&acc)[4][NI], int rbase, int cbase) const {
#pragma unroll
        for (int mi = 0; mi < 4; ++mi) {
            const int r = rbase + mi * 16;
            if (r < cnt) {
                bf16_t* rowp = C + (size_t)list[r] * D + n0 + cbase;
#pragma unroll
                for (int ni = 0; ni < NI; ++ni) { u32x2 v; v.x = pk2(acc[mi][ni][0], acc[mi][ni][1]); v.y = pk2(acc[mi][ni][2], acc[mi][ni][3]); *(u32x2*)(rowp + ni * 16) = v; }
            }
        }
    }
};
struct EpiDecay {
    float* Dc; const float* w0; int m0; int n0;
    template <int NI> __device__ __forceinline__ void operator()(const f32x4 (&acc)[4][NI], int rbase, int cbase) const {
#pragma unroll
        for (int ni = 0; ni < NI; ++ni) {
            const int col = n0 + cbase + ni * 16;
            const f32x4 w0v = *(const f32x4*)(w0 + col);
#pragma unroll
            for (int mi = 0; mi < 4; ++mi) {
                f32x4 o;
#pragma unroll
                for (int j = 0; j < 4; ++j) { const float w = w0v[j] + acc[mi][ni][j]; o[j] = __expf(-__expf(-softplus_fast(-w) - 0.5f)); }
                *(f32x4*)(Dc + (size_t)(m0 + rbase + mi * 16) * 512 + col) = o;
            }
        }
    }
};
struct EpiAK {
    bf16_t* Kb; const bf16_t* KKb; bf16_t* Bb; const float* a0; const float* k_a; int m0; int n0;
    template <int NI> __device__ __forceinline__ void operator()(const f32x4 (&acc)[4][NI], int rbase, int cbase) const {
#pragma unroll
        for (int ni = 0; ni < NI; ++ni) {
            const int col = n0 + cbase + ni * 16;
            const f32x4 a0v = *(const f32x4*)(a0 + col), kav = *(const f32x4*)(k_a + col);
#pragma unroll
            for (int mi = 0; mi < 4; ++mi) {
                const size_t off = (size_t)(m0 + rbase + mi * 16) * 512 + col;
                const u32x2 kr = *(const u32x2*)(Kb + off), kkr = *(const u32x2*)(KKb + off);
                const float kf[4] = {bflo(kr.x), bfhi(kr.x), bflo(kr.y), bfhi(kr.y)}, kkf[4] = {bflo(kkr.x), bfhi(kkr.x), bflo(kkr.y), bfhi(kkr.y)};
                float k2[4], bb[4];
#pragma unroll
                for (int j = 0; j < 4; ++j) { const float a = sigmoidf_(a0v[j] + acc[mi][ni][j]); k2[j] = kf[j] * (1.f + (a - 1.f) * kav[j]); bb[j] = kkf[j] * a; }
                u32x2 v; v.x = pk2(k2[0], k2[1]); v.y = pk2(k2[2], k2[3]); *(u32x2*)(Kb + off) = v;
                v.x = pk2(bb[0], bb[1]); v.y = pk2(bb[2], bb[3]); *(u32x2*)(Bb + off) = v;
            }
        }
    }
};

namespace pg8 {
#define PG8_LAS __attribute__((address_space(3)))
constexpr int BM = 256, BK = 64, HALF = 128, HTB = HALF * BK * 2, STAGE_BYTES = 8 * HTB, NXCD = 8, WGM = 8;
__host__ __device__ __forceinline__ int lds_byte(int r, int c) { const int st = (r >> 4) * 2 + (c >> 5), rr = r & 15, cc = c & 31, ob = rr * 64 + cc * 2; return st * 1024 + (ob ^ (((ob >> 9) & 1) << 5)); }
__host__ __device__ __forceinline__ void stage_rc(int b, int& R, int& C) { const int st = b / 1024, sb = b % 1024, swz = sb ^ (((sb >> 9) & 1) << 5); R = (st >> 1) * 16 + swz / 64; C = (st & 1) * 32 + (swz % 64) / 2; }
__host__ __device__ __forceinline__ int perm32(int rho) { const int n = rho >> 4, i = rho & 15; return 8 * (i >> 2) + 4 * n + (i & 3); }
struct Unit { int pm, pn; };
struct Gemm { const bf16_t* A; const bf16_t* Bt; int M, N, K; };
struct StaticOrder {
    int nM, nN, nwg, G, c;
    __host__ __device__ void init(int M, int N, int G_, int c_) { nM = M / BM; nN = N / BM; nwg = nM * nN; G = G_; c = c_; }
    __host__ __device__ bool next(int i, Unit& u) const {
        const long L = (long)i * G + c; if (L >= nwg) return false;
        int wgid = (int)L; { const int q = nwg / NXCD, r = nwg % NXCD, xcd = wgid % NXCD, off = wgid / NXCD; wgid = (xcd < r ? xcd * (q + 1) : r * (q + 1) + (xcd - r) * q) + off; }
        const int nig = WGM * nN, gid = wgid / nig, fm = gid * WGM, gsz = (nM - fm) < WGM ? (nM - fm) : WGM;
        u.pm = fm + ((wgid % nig) % gsz); u.pn = (wgid % nig) / gsz; return true;
    }
    __device__ __forceinline__ void a_ready(const Unit&) const {}
    __device__ __forceinline__ void done(const Unit&) const {}
};
struct EpiStoreP {
    static constexpr bool PERM = true, AFTER_DRAIN = false;
    bf16_t* O; int ldc;
    __device__ __forceinline__ void operator()(const f32x4 (&acc)[2][2][4][2], const Unit& u, int wr, int wc, int fr, int fq) const {
        const int row0 = u.pm * BM + wr * 64 + fr, col0 = u.pn * BM + wc * 32 + 8 * fq;
#pragma unroll
        for (int ai = 0; ai < 2; ++ai)
#pragma unroll
            for (int m = 0; m < 4; ++m) { bf16_t* rowp = O + (size_t)(row0 + ai * HALF + m * 16) * ldc + col0;
#pragma unroll
                for (int bj = 0; bj < 2; ++bj) { const f32x4 v0 = acc[ai][bj][m][0], v1 = acc[ai][bj][m][1];
                    u32x4 w; w.x = pk2(v0[0], v0[1]); w.y = pk2(v0[2], v0[3]); w.z = pk2(v1[0], v1[1]); w.w = pk2(v1[2], v1[3]);
                    *(u32x4*)(rowp + bj * HALF) = w; } }
    }
};
template <class Epi, class Sched>
__device__ __forceinline__ void gemm_phase(int wv, PG8_LAS unsigned char* lds, const Gemm g, const Sched& S, const Epi& E) {
    const int tid = ltid(wv), wid = __builtin_amdgcn_readfirstlane(tid >> 6), lane = tid & 63, wr = wid >> 2, wc = wid & 3, fr = lane & 15, fq = lane >> 4;
    const int K = g.K, nt = K / BK;
    unsigned voffA[2], voffB[2];
#pragma unroll
    for (int i = 0; i < 2; ++i) { int R, C; stage_rc(tid * 16 + i * 8192, R, C); const int Rb = Epi::PERM ? ((R & ~31) + perm32(R & 31)) : R;
        voffA[i] = (unsigned)(R * K + C) * 2u; voffB[i] = (unsigned)(Rb * K + C) * 2u; }
    const size_t kstep = (size_t)(BK * 2);
    const size_t hstep = (size_t)HALF * K * 2;
    const size_t tstep = 2 * hstep;
    const unsigned ldsw = (unsigned)wid * 1024u;
    const int aoff = lds_byte(wr * 64 + fr, fq * 8), boff = lds_byte(wc * 32 + fr, fq * 8);
#define PG8_SA(b, h) (((b) * 2 + (h)) * HTB)
#define PG8_SB(b, h) ((4 + (b) * 2 + (h)) * HTB)
#define PG8_STAGE(bufoff, gbase, voff) do { _Pragma("unroll") for (int _i = 0; _i < 2; ++_i) \
        __builtin_amdgcn_global_load_lds((const unsigned*)((const char*)(gbase) + (voff)[_i]), (PG8_LAS unsigned*)(lds + (bufoff) + ldsw + _i * 8192), 16, 0, 0); } while (0)
#define PG8_LDA(dst, b, h) do { _Pragma("unroll") for (int m = 0; m < 4; ++m) _Pragma("unroll") for (int k = 0; k < 2; ++k) dst[m][k] = *(const PG8_LAS bf16x8*)(lds + PG8_SA(b, h) + aoff + m * 2048 + k * 1024); } while (0)
#define PG8_LDB(dst, b, h) do { _Pragma("unroll") for (int n = 0; n < 2; ++n) _Pragma("unroll") for (int k = 0; k < 2; ++k) dst[n][k] = *(const PG8_LAS bf16x8*)(lds + PG8_SB(b, h) + boff + n * 2048 + k * 1024); } while (0)
#define PG8_MMA(ai, bj, At, Bt) do { __builtin_amdgcn_s_setprio(1); _Pragma("unroll") for (int m = 0; m < 4; ++m) _Pragma("unroll") for (int n = 0; n < 2; ++n) _Pragma("unroll") for (int k = 0; k < 2; ++k) \
        acc[ai][bj][m][n] = __builtin_amdgcn_mfma_f32_16x16x32_bf16(Bt[n][k], At[m][k], acc[ai][bj][m][n], 0, 0, 0); __builtin_amdgcn_s_setprio(0); } while (0)
#define PG8_WAIT_V(n) asm volatile("s_waitcnt vmcnt(" #n ")" ::: "memory")
#define PG8_WAIT_L(n) asm volatile("s_waitcnt lgkmcnt(" #n ")" ::: "memory")
#define PG8_BAR __builtin_amdgcn_s_barrier()
#define PG8_SCHED __builtin_amdgcn_sched_barrier(0)
    Unit cur, nxt; int ui = 0;
    if (!S.next(0, cur)) return;
    f32x4 acc[2][2][4][2];
#pragma unroll
    for (int a = 0; a < 2; ++a)
#pragma unroll
        for (int b = 0; b < 2; ++b)
#pragma unroll
            for (int m = 0; m < 4; ++m)
#pragma unroll
                for (int n = 0; n < 2; ++n) acc[a][b][m][n] = (f32x4){0.f, 0.f, 0.f, 0.f};
    bf16x8 At[4][2], B0[2][2], B1[2][2];
    const char* cA = (const char*)g.A + (size_t)cur.pm * tstep; const char* cB = (const char*)g.Bt + (size_t)cur.pn * tstep;
    S.a_ready(cur);
    PG8_STAGE(PG8_SB(0, 0), cB, voffB); PG8_STAGE(PG8_SA(0, 0), cA, voffA); PG8_STAGE(PG8_SB(0, 1), cB + hstep, voffB); PG8_STAGE(PG8_SA(0, 1), cA + hstep, voffA);
    if (wr == 1) PG8_BAR;
    PG8_WAIT_V(4); PG8_BAR;
    PG8_STAGE(PG8_SB(1, 0), cB + kstep, voffB); PG8_STAGE(PG8_SA(1, 0), cA + kstep, voffA); PG8_STAGE(PG8_SB(1, 1), cB + hstep + kstep, voffB);
    PG8_WAIT_V(6); PG8_BAR;
    for (;;) {
        const bool has_next = S.next(ui + 1, nxt);
        const char* nA = has_next ? (const char*)g.A + (size_t)nxt.pm * tstep : cA; const char* nB = has_next ? (const char*)g.Bt + (size_t)nxt.pn * tstep : cB;
        for (int t = 0; t < nt; t += 2) {
            const bool last = (t == nt - 2);
            const char* a1 = cA + (size_t)(t + 1) * kstep;
            const char* a2 = last ? nA : cA + (size_t)(t + 2) * kstep; const char* b2 = last ? nB : cB + (size_t)(t + 2) * kstep;
            const char* a3 = a2 + kstep; const char* b3 = b2 + kstep;
            if (last && has_next) S.a_ready(nxt);
            PG8_LDB(B0, 0, 0); PG8_SCHED; PG8_LDA(At, 0, 0); PG8_STAGE(PG8_SA(1, 1), a1 + hstep, voffA);
            PG8_WAIT_L(8); PG8_BAR; PG8_WAIT_L(0); PG8_MMA(0, 0, At, B0); PG8_BAR; PG8_SCHED;
            PG8_LDB(B1, 0, 1); PG8_STAGE(PG8_SB(0, 0), b2, voffB);
            PG8_BAR; PG8_WAIT_L(0); PG8_MMA(0, 1, At, B1); PG8_BAR;
            PG8_LDA(At, 0, 1); PG8_STAGE(PG8_SA(0, 0), a2, voffA);
            PG8_BAR; PG8_WAIT_L(0); PG8_MMA(1, 0, At, B0); PG8_BAR; PG8_SCHED;
            PG8_STAGE(PG8_SB(0, 1), b2 + hstep, voffB);
            PG8_WAIT_V(6); PG8_BAR; PG8_MMA(1, 1, At, B1); PG8_BAR;
            PG8_LDB(B0, 1, 0); PG8_SCHED; PG8_LDA(At, 1, 0); PG8_STAGE(PG8_SA(0, 1), a2 + hstep, voffA);
            PG8_WAIT_L(8); PG8_BAR; PG8_WAIT_L(0); PG8_MMA(0, 0, At, B0); PG8_BAR; PG8_SCHED;
            PG8_LDB(B1, 1, 1); PG8_STAGE(PG8_SB(1, 0), b3, voffB);
            PG8_BAR; PG8_WAIT_L(0); PG8_MMA(0, 1, At, B1); PG8_BAR;
            PG8_LDA(At, 1, 1); PG8_STAGE(PG8_SA(1, 0), a3, voffA);
            PG8_BAR; PG8_WAIT_L(0); PG8_MMA(1, 0, At, B0); PG8_BAR; PG8_SCHED;
            PG8_STAGE(PG8_SB(1, 1), b3 + hstep, voffB);
            PG8_WAIT_V(6); PG8_BAR; PG8_MMA(1, 1, At, B1); PG8_BAR;
        }
            if constexpr (!Epi::AFTER_DRAIN) { E(acc, cur, wr, wc, fr, fq); S.done(cur); }
            if (!has_next) break;
#pragma unroll
        for (int a = 0; a < 2; ++a)
#pragma unroll
            for (int b = 0; b < 2; ++b)
#pragma unroll
                for (int m = 0; m < 4; ++m)
#pragma unroll
                    for (int n = 0; n < 2; ++n) acc[a][b][m][n] = (f32x4){0.f, 0.f, 0.f, 0.f};
        cur = nxt; cA = nA; cB = nB; ++ui;
    }
    PG8_WAIT_V(0);
    if (wr == 0) PG8_BAR;
    PG8_BAR;
    if constexpr (Epi::AFTER_DRAIN) { E.fused(acc, cur, wr, wc, fr, fq, lds, wid, lane); S.done(cur); }
#undef PG8_SA
#undef PG8_SB
#undef PG8_STAGE
#undef PG8_LDA
#undef PG8_LDB
#undef PG8_MMA
#undef PG8_WAIT_V
#undef PG8_WAIT_L
#undef PG8_BAR
#undef PG8_SCHED
}
struct UnitG { int pm, pn; const char* bbase; const PG8_LAS int* ltab; int cnt; int e; };
struct MoeOrder {
    const PG8_LAS int* tstart; const PG8_LAS int* tcnt; const PG8_LAS int* ltabs; const int* lists; const char* bt; size_t estride; int ncol, shift, G, c;
    __device__ __forceinline__ bool next(int i, UnitG& u) const {
        const int t = i * G + c; if (t >= tstart[32] * ncol) return false;
        const int tm = t / ncol; int e = 0;
#pragma unroll 1
        while (tstart[e + 1] <= tm) ++e;
        e = __builtin_amdgcn_readfirstlane(e);
        const int ts = __builtin_amdgcn_readfirstlane(tstart[e]), tc = __builtin_amdgcn_readfirstlane(tcnt[e]);
        u.pm = tm - ts; u.pn = t - tm * ncol; u.bbase = bt + (size_t)e * estride; u.e = e; u.cnt = tc - u.pm * BM; u.ltab = ltabs + i * BM;
        return true;
    }
    __device__ __forceinline__ void a_ready(const UnitG&) const {}
    __device__ __forceinline__ void done(const UnitG&) const {}
};
struct EpiSwiGLUG {
    static constexpr bool PERM = false, AFTER_DRAIN = false;
    bf16_t* H;
    __device__ __forceinline__ void operator()(const f32x4 (&acc)[2][2][4][2], const UnitG& u, int wr, int wc, int fr, int fq) const {
#pragma unroll
        for (int ai = 0; ai < 2; ++ai)
#pragma unroll
            for (int m = 0; m < 4; ++m) { const int r = ai * HALF + wr * 64 + m * 16 + fr;
                if (r < u.cnt) { bf16_t* rowp = H + (size_t)u.ltab[r] * DEXP + ((u.pn * BM + wc * 32) >> 1) + 4 * fq;
#pragma unroll
                    for (int bj = 0; bj < 2; ++bj) { const f32x4 gt = acc[ai][bj][m][0], up = acc[ai][bj][m][1];
                        u32x2 w; w.x = pk2(siluf_(gt[0]) * up[0], siluf_(gt[1]) * up[1]); w.y = pk2(siluf_(gt[2]) * up[2], siluf_(gt[3]) * up[3]);
                        *(u32x2*)(rowp + bj * (HALF / 2)) = w; } } }
    }
};
struct EpiScatterG {
    static constexpr bool PERM = true, AFTER_DRAIN = false;
    bf16_t* O;
    __device__ __forceinline__ void operator()(const f32x4 (&acc)[2][2][4][2], const UnitG& u, int wr, int wc, int fr, int fq) const {
#pragma unroll
        for (int ai = 0; ai < 2; ++ai)
#pragma unroll
            for (int m = 0; m < 4; ++m) { const int r = ai * HALF + wr * 64 + m * 16 + fr;
                if (r < u.cnt) { bf16_t* rowp = O + (size_t)u.ltab[r] * D + u.pn * BM + wc * 32 + 8 * fq;
#pragma unroll
                    for (int bj = 0; bj < 2; ++bj) { const f32x4 v0 = acc[ai][bj][m][0], v1 = acc[ai][bj][m][1];
                        u32x4 w; w.x = pk2(v0[0], v0[1]); w.y = pk2(v0[2], v0[3]); w.z = pk2(v1[0], v1[1]); w.w = pk2(v1[2], v1[3]);
                        *(u32x4*)(rowp + bj * HALF) = w; } } }
    }
};
template <class Epi, class Sched>
__device__ __forceinline__ void gemm_phase_g(int wv, PG8_LAS unsigned char* lds, const Gemm g, const Sched& S, const Epi& E) {
    const int tid = ltid(wv), wid = __builtin_amdgcn_readfirstlane(tid >> 6), lane = tid & 63, wr = wid >> 2, wc = wid & 3, fr = lane & 15, fq = lane >> 4;
    const int K = g.K, nt = K / BK;
    unsigned voffB[2];
#pragma unroll
    for (int i = 0; i < 2; ++i) { int R, C; stage_rc(tid * 16 + i * 8192, R, C); const int Rb = Epi::PERM ? ((R & ~31) + perm32(R & 31)) : R;
        voffB[i] = (unsigned)(Rb * K + C) * 2u; }
    const unsigned rowb = (unsigned)K * 2u;
#define PG8_AOFFS(u, dst) do { const int _t = ltid(wv); _Pragma("unroll") for (int _i = 0; _i < 2; ++_i) { int _R, _C; stage_rc(_t * 16 + _i * 8192, _R, _C); \
        _Pragma("unroll") for (int _h = 0; _h < 2; ++_h) dst[_h][_i] = (unsigned)((u).ltab[_h * HALF + _R] >> S.shift) * rowb + (unsigned)(_C * 2); } } while (0)
#define PG8_STAGE_A(bufoff, AO, koff) do { _Pragma("unroll") for (int _i = 0; _i < 2; ++_i) \
        __builtin_amdgcn_global_load_lds((const unsigned*)((const char*)g.A + (size_t)(AO)[_i] + (size_t)(koff)), (PG8_LAS unsigned*)(lds + (bufoff) + ldsw + _i * 8192), 16, 0, 0); } while (0)
    const size_t kstep = (size_t)(BK * 2);
    const size_t hstep = (size_t)HALF * K * 2;
    const size_t tstep = 2 * hstep;
    const unsigned ldsw = (unsigned)wid * 1024u;
    const int aoff = lds_byte(wr * 64 + fr, fq * 8), boff = lds_byte(wc * 32 + fr, fq * 8);
#define PG8_SA(b, h) (((b) * 2 + (h)) * HTB)
#define PG8_SB(b, h) ((4 + (b) * 2 + (h)) * HTB)
#define PG8_STAGE(bufoff, gbase, voff) do { _Pragma("unroll") for (int _i = 0; _i < 2; ++_i) \
        __builtin_amdgcn_global_load_lds((const unsigned*)((const char*)(gbase) + (voff)[_i]), (PG8_LAS unsigned*)(lds + (bufoff) + ldsw + _i * 8192), 16, 0, 0); } while (0)
#define PG8_LDA(dst, b, h) do { _Pragma("unroll") for (int m = 0; m < 4; ++m) _Pragma("unroll") for (int k = 0; k < 2; ++k) dst[m][k] = *(const PG8_LAS bf16x8*)(lds + PG8_SA(b, h) + aoff + m * 2048 + k * 1024); } while (0)
#define PG8_LDB(dst, b, h) do { _Pragma("unroll") for (int n = 0; n < 2; ++n) _Pragma("unroll") for (int k = 0; k < 2; ++k) dst[n][k] = *(const PG8_LAS bf16x8*)(lds + PG8_SB(b, h) + boff + n * 2048 + k * 1024); } while (0)
#define PG8_MMA(ai, bj, At, Bt) do { __builtin_amdgcn_s_setprio(1); _Pragma("unroll") for (int m = 0; m < 4; ++m) _Pragma("unroll") for (int n = 0; n < 2; ++n) _Pragma("unroll") for (int k = 0; k < 2; ++k) \
        acc[ai][bj][m][n] = __builtin_amdgcn_mfma_f32_16x16x32_bf16(Bt[n][k], At[m][k], acc[ai][bj][m][n], 0, 0, 0); __builtin_amdgcn_s_setprio(0); } while (0)
#define PG8_WAIT_V(n) asm volatile("s_waitcnt vmcnt(" #n ")" ::: "memory")
#define PG8_WAIT_L(n) asm volatile("s_waitcnt lgkmcnt(" #n ")" ::: "memory")
#define PG8_BAR __builtin_amdgcn_s_barrier()
#define PG8_SCHED __builtin_amdgcn_sched_barrier(0)
    UnitG cur, nxt; int ui = 0;
    if (!S.next(0, cur)) return;
    f32x4 acc[2][2][4][2];
#pragma unroll
    for (int a = 0; a < 2; ++a)
#pragma unroll
        for (int b = 0; b < 2; ++b)
#pragma unroll
            for (int m = 0; m < 4; ++m)
#pragma unroll
                for (int n = 0; n < 2; ++n) acc[a][b][m][n] = (f32x4){0.f, 0.f, 0.f, 0.f};
    bf16x8 At[4][2], B0[2][2], B1[2][2];
    unsigned ca[2][2]; PG8_AOFFS(cur, ca); const char* cB = cur.bbase + (size_t)cur.pn * tstep;
    S.a_ready(cur);
    PG8_STAGE(PG8_SB(0, 0), cB, voffB); PG8_STAGE_A(PG8_SA(0, 0), ca[0], 0); PG8_STAGE(PG8_SB(0, 1), cB + hstep, voffB); PG8_STAGE_A(PG8_SA(0, 1), ca[1], 0);
    if (wr == 1) PG8_BAR;
    PG8_WAIT_V(4); PG8_BAR;
    PG8_STAGE(PG8_SB(1, 0), cB + kstep, voffB); PG8_STAGE_A(PG8_SA(1, 0), ca[0], kstep); PG8_STAGE(PG8_SB(1, 1), cB + hstep + kstep, voffB);
    PG8_WAIT_V(6); PG8_BAR;
    for (;;) {
        const bool has_next = S.next(ui + 1, nxt);
        const char* nB = has_next ? nxt.bbase + (size_t)nxt.pn * tstep : cB;
        for (int t = 0; t < nt; t += 2) {
            const bool last = (t == nt - 2);
            const size_t k1 = (size_t)(t + 1) * kstep, k2 = last ? 0 : (size_t)(t + 2) * kstep;
            unsigned a2o[2][2];
            if (last && has_next) PG8_AOFFS(nxt, a2o); else { a2o[0][0] = ca[0][0]; a2o[0][1] = ca[0][1]; a2o[1][0] = ca[1][0]; a2o[1][1] = ca[1][1]; }
            const char* b2 = last ? nB : cB + (size_t)(t + 2) * kstep; const char* b3 = b2 + kstep;
            if (last && has_next) S.a_ready(nxt);
            PG8_LDB(B0, 0, 0); PG8_SCHED; PG8_LDA(At, 0, 0); PG8_STAGE_A(PG8_SA(1, 1), ca[1], k1);
            PG8_WAIT_L(8); PG8_BAR; PG8_WAIT_L(0); PG8_MMA(0, 0, At, B0); PG8_BAR; PG8_SCHED;
            PG8_LDB(B1, 0, 1); PG8_STAGE(PG8_SB(0, 0), b2, voffB);
            PG8_BAR; PG8_WAIT_L(0); PG8_MMA(0, 1, At, B1); PG8_BAR;
            PG8_LDA(At, 0, 1); PG8_STAGE_A(PG8_SA(0, 0), a2o[0], k2);
            PG8_BAR; PG8_WAIT_L(0); PG8_MMA(1, 0, At, B0); PG8_BAR; PG8_SCHED;
            PG8_STAGE(PG8_SB(0, 1), b2 + hstep, voffB);
            PG8_WAIT_V(6); PG8_BAR; PG8_MMA(1, 1, At, B1); PG8_BAR;
            PG8_LDB(B0, 1, 0); PG8_SCHED; PG8_LDA(At, 1, 0); PG8_STAGE_A(PG8_SA(0, 1), a2o[1], k2);
            PG8_WAIT_L(8); PG8_BAR; PG8_WAIT_L(0); PG8_MMA(0, 0, At, B0); PG8_BAR; PG8_SCHED;
            PG8_LDB(B1, 1, 1); PG8_STAGE(PG8_SB(1, 0), b3, voffB);
            PG8_BAR; PG8_WAIT_L(0); PG8_MMA(0, 1, At, B1); PG8_BAR;
            PG8_LDA(At, 1, 1); PG8_STAGE_A(PG8_SA(1, 0), a2o[0], k2 + kstep);
            PG8_BAR; PG8_WAIT_L(0); PG8_MMA(1, 0, At, B0); PG8_BAR; PG8_SCHED;
            PG8_STAGE(PG8_SB(1, 1), b3 + hstep, voffB);
            PG8_WAIT_V(6); PG8_BAR; PG8_MMA(1, 1, At, B1); PG8_BAR;
            if (last) { ca[0][0] = a2o[0][0]; ca[0][1] = a2o[0][1]; ca[1][0] = a2o[1][0]; ca[1][1] = a2o[1][1]; }
        }
            if constexpr (!Epi::AFTER_DRAIN) { E(acc, cur, wr, wc, fr, fq); S.done(cur); }
            if (!has_next) break;
#pragma unroll
        for (int a = 0; a < 2; ++a)
#pragma unroll
            for (int b = 0; b < 2; ++b)
#pragma unroll
                for (int m = 0; m < 4; ++m)
#pragma unroll
                    for (int n = 0; n < 2; ++n) acc[a][b][m][n] = (f32x4){0.f, 0.f, 0.f, 0.f};
        cur = nxt; cB = nB; ++ui;
    }
    PG8_WAIT_V(0);
    if (wr == 0) PG8_BAR;
    PG8_BAR;
    if constexpr (Epi::AFTER_DRAIN) { E.fused(acc, cur, wr, wc, fr, fq, lds, wid, lane); S.done(cur); }
#undef PG8_SA
#undef PG8_AOFFS
#undef PG8_STAGE_A
#undef PG8_SB
#undef PG8_STAGE
#undef PG8_LDA
#undef PG8_LDB
#undef PG8_MMA
#undef PG8_WAIT_V
#undef PG8_WAIT_L
#undef PG8_BAR
#undef PG8_SCHED
}
}

__device__ __forceinline__ void transpose_item(const float* __restrict__ W, int K, int N, bf16_t* __restrict__ WT, int mode, LAS float* scr, int item, int lane) {
    const int nblk = N / 32, kb = item / nblk, nb = item % nblk, k0 = 64 * kb, n0 = 32 * nb;
#pragma unroll 8
    for (int i = 0; i < 32; ++i) { const int kk = 2 * i + (lane >> 5); scr[kk * 33 + (lane & 31)] = W[(size_t)(k0 + kk) * N + n0 + (lane & 31)]; }
    asm volatile("s_waitcnt lgkmcnt(0)" ::: "memory");
    const int c = lane & 7;
#pragma unroll
    for (int j = 0; j < 4; ++j) {
        const int nl = (lane >> 3) + 8 * j; const LAS float* s = scr + (8 * c) * 33 + nl;
        u32x4 o; o.x = pk2(s[0 * 33], s[1 * 33]); o.y = pk2(s[2 * 33], s[3 * 33]); o.z = pk2(s[4 * 33], s[5 * 33]); o.w = pk2(s[6 * 33], s[7 * 33]);
        const int n = n0 + nl;
        const int nd = mode == 0 ? n : (32 * (n >> 4) + (n & 15) + (mode == 2 ? 16 : 0));
        *(u32x4*)(WT + (size_t)nd * K + k0 + 8 * c) = o;
    }
    asm volatile("s_waitcnt lgkmcnt(0)" ::: "memory");
}

__device__ __forceinline__ void phase_prologue0(int wv, KP Pk, LAS char* lds) {
    asm volatile("" : "+s"(Pk));
    const CAS Params& P = *Pk;
    const int tid = ltid(wv), lane = tid & 63, wid = tid >> 6;
    const int gw = blockIdx.x * 8 + wid, NGW = gridDim.x * 8;
    LAS float* scr = (LAS float*)(lds + wid * 8448);
    bf16_t* winT = (bf16_t*)(P.ws + WS_WINT);
    bf16_t* woutT = (bf16_t*)(P.ws + WS_WOUTT);
    bf16_t* loraT = (bf16_t*)(P.ws + WS_LORAT);
    constexpr int I_EV = 16 * (P_EVEN / 32), I_OD = 16 * (P_ODD / 32), I_O = 16 * 32, I_L64 = 16, I_L128 = 32;
    constexpr int I_LORA = 3 * I_L64 + I_L128;
    constexpr int NIT = 2 * I_EV + 2 * I_OD + 4 * I_O + 2 * I_LORA;
    for (int it = gw; it < NIT; it += NGW) {
        int r = it;
        if (r < 2 * I_EV) { const int i = r / I_EV; transpose_item(P.ev_w_in + (size_t)i * D * P_EVEN, D, P_EVEN, winT + (i ? WINT_L2 : WINT_L0), 0, scr, r % I_EV, lane); continue; } r -= 2 * I_EV;
        if (r < 2 * I_OD) { const int i = r / I_OD; transpose_item(P.od_w_in + (size_t)i * D * P_ODD, D, P_ODD, winT + (i ? WINT_L3 : WINT_L1), 0, scr, r % I_OD, lane); continue; } r -= 2 * I_OD;
        if (r < 4 * I_O) { const int l = r / I_O; const float* src = (l & 1) ? P.od_w_out + (size_t)(l >> 1) * D * D : P.ev_w_out + (size_t)(l >> 1) * D * D;
            transpose_item(src, D, D, woutT + (size_t)l * D * D, 0, scr, r % I_O, lane); continue; } r -= 4 * I_O;
        { const int i = r / I_LORA; int q = r % I_LORA; bf16_t* dst = loraT + (size_t)i * LORA_PER;
          if (q < I_L64) { transpose_item(P.rw_w2 + (size_t)(i * 2 + 0) * 64 * 512, 64, 512, dst, 0, scr, q, lane); continue; } q -= I_L64;
          if (q < I_L64) { transpose_item(P.rw_w2 + (size_t)(i * 2 + 1) * 64 * 512, 64, 512, dst + 512 * 64, 0, scr, q, lane); continue; } q -= I_L64;
          if (q < I_L64) { transpose_item(P.rw_a2 + (size_t)i * 64 * 512, 64, 512, dst + 2 * 512 * 64, 0, scr, q, lane); continue; } q -= I_L64;
          transpose_item(P.rw_g2 + (size_t)i * 128 * 512, 128, 512, dst + 3 * 512 * 64, 0, scr, q, lane); }
    }
    {
        const int gt = blockIdx.x * NT + tid, NG = gridDim.x * NT;
        constexpr int PADE = (LDP_EVEN - P_EVEN) * D / 8, PADO = (LDP_ODD - P_ODD) * D / 8;
        for (int i = gt; i < 2 * PADE + 2 * PADO; i += NG) {
            int r = i; bf16_t* dst;
            if (r < 2 * PADE) { const int l = r / PADE; dst = winT + (l ? WINT_L2 : WINT_L0) + (size_t)P_EVEN * D + (size_t)(r % PADE) * 8; }
            else { r -= 2 * PADE; const int l = r / PADO; dst = winT + (l ? WINT_L3 : WINT_L1) + (size_t)P_ODD * D + (size_t)(r % PADO) * 8; }
            *(u32x4*)dst = (u32x4){0u, 0u, 0u, 0u};
        }
    }
    {
        const int gt = blockIdx.x * NT + tid, NG = gridDim.x * NT;
        float* lb = (float*)(P.ws + WS_LB);
        for (int ch = gt; ch < 512; ch += NG) {
            float lg[4], mx = -1e30f;
#pragma unroll
            for (int l = 0; l < 4; ++l) { lg[l] = P.hg_lb_logits[l * 512 + ch]; mx = fmaxf(mx, lg[l]); }
            float e[4], s = 0.f;
#pragma unroll
            for (int l = 0; l < 4; ++l) { e[l] = __expf(lg[l] - mx); s += e[l]; }
            float cum = 0.f;
#pragma unroll
            for (int l = 0; l < 4; ++l) { if (l > 0) cum += e[l] / s; lb[l * 512 + ch] = cum; }
        }
    }
    __syncthreads();
    {
        LAS float* sc = (LAS float*)lds;
        LAS float* red = (LAS float*)(lds + 5 * 1024 * 4);
        for (int i = tid; i < 5 * D; i += NT) { const int m = i >> 10, k = i & 1023; const float v = m < 4 ? P.c[m * D + k] : P.c_ctx[k]; sc[i] = siluf_(v); }
        __syncthreads();
        float* modv = (float*)(P.ws + WS_MODV);
        const int col = tid & 127, kq = tid >> 7;
        for (int item = blockIdx.x; item < 4 * 48; item += gridDim.x) {
            const int l = item / 48, j = (item % 48) * 128 + col;
            const float* w = P.mod_w + (size_t)l * D * 6144 + j;
            float a[5] = {0.f, 0.f, 0.f, 0.f, 0.f};
#pragma unroll 8
            for (int k = kq * 256; k < kq * 256 + 256; ++k) {
                const float wv = w[(size_t)k * 6144];
#pragma unroll
                for (int m = 0; m < 5; ++m) a[m] += sc[m * 1024 + k] * wv;
            }
#pragma unroll
            for (int m = 0; m < 5; ++m) red[(kq * 128 + col) * 5 + m] = a[m];
            __syncthreads();
            if (kq == 0) {
                const float bias = P.mod_b[l * 6144 + j];
#pragma unroll
                for (int m = 0; m < 5; ++m) {
                    const float s = red[(0 * 128 + col) * 5 + m] + red[(1 * 128 + col) * 5 + m] + red[(2 * 128 + col) * 5 + m] + red[(3 * 128 + col) * 5 + m];
                    modv[(size_t)(l * 5 + m) * 6144 + j] = s + bias;
                }
            }
            __syncthreads();
        }
    }
}

__device__ __forceinline__ void phase_prologue1(int wv, KP Pk) {
    asm volatile("" : "+s"(Pk));
    const CAS Params& P = *Pk;
    const int tid = ltid(wv), lane = tid & 63, wid = tid >> 6;
    bf16_t* act = (bf16_t*)(P.ws + WS_ACT);
    for (int r = blockIdx.x * 8 + wid; r < NROWS; r += gridDim.x * 8) {
        const int m = row_mod(r);
        const float* src = r < NCTX ? P.ctx + (size_t)r * D : P.x + (size_t)(r - NCTX) * D;
        const float* sh = modvec(P.ws, 0, m, 0); const float* sc = modvec(P.ws, 0, m, 1);
#pragma unroll
        for (int i = 0; i < 4; ++i) {
            const int c = 4 * lane + 256 * i;
            const f32x4 v = *(const f32x4*)(src + c), s1 = *(const f32x4*)(sc + c), h1 = *(const f32x4*)(sh + c);
            u32x2 o; o.x = pk2(v[0] * (1.f + s1[0]) + h1[0], v[1] * (1.f + s1[1]) + h1[1]); o.y = pk2(v[2] * (1.f + s1[2]) + h1[2], v[3] * (1.f + s1[3]) + h1[3]);
            *(u32x2*)(act + (size_t)r * D + c) = o;
        }
    }
}

__device__ __forceinline__ void phase_inproj(int wv, KP Pk, int layer, LAS char* lds) {
    asm volatile("" : "+s"(Pk));
    const CAS Params& P = *Pk;
    const int odd = layer & 1, ldp = odd ? LDP_ODD : LDP_EVEN;
    const size_t woff = layer == 0 ? WINT_L0 : layer == 1 ? WINT_L1 : layer == 2 ? WINT_L2 : WINT_L3;
    pg8::Gemm g{(const bf16_t*)(P.ws + WS_ACT), (const bf16_t*)(P.ws + WS_WINT) + woff, NROWS, ldp, D};
    pg8::StaticOrder S; S.init(NROWS, ldp, (int)gridDim.x, (int)blockIdx.x);
    pg8::EpiStoreP E{(bf16_t*)(P.ws + WS_P), ldp};
    pg8::gemm_phase(wv, (PG8_LAS unsigned char*)lds, g, S, E);
}
__device__ __forceinline__ void phase_outproj(int wv, KP Pk, int layer, LAS char* lds) {
    asm volatile("" : "+s"(Pk));
    const CAS Params& P = *Pk;
    const int r0 = (layer == DEPTH - 1) ? NCTX : 0;
    pg8::Gemm g{(const bf16_t*)(P.ws + WS_FEAT) + (size_t)r0 * D, (const bf16_t*)(P.ws + WS_WOUTT) + (size_t)layer * D * D, NROWS - r0, D, D};
    pg8::StaticOrder S; S.init(NROWS - r0, D, (int)gridDim.x, (int)blockIdx.x);
    pg8::EpiStoreP E{(bf16_t*)(P.ws + WS_YO) + (size_t)r0 * D, D};
    pg8::gemm_phase(wv, (PG8_LAS unsigned char*)lds, g, S, E);
}
__device__ __forceinline__ void phase_prep2(int wv, KP Pk, int layer, LAS char* lds) {
    asm volatile("" : "+s"(Pk));
    const CAS Params& P = *Pk;
    const int i = layer >> 1;
    const bf16_t* la = (const bf16_t*)(P.ws + WS_LA);
    const bf16_t* lt = (const bf16_t*)(P.ws + WS_LORAT) + (size_t)i * LORA_PER;
    constexpr int MT = NROWS / G_BM, NTL = 512 / G_BN;
    const int ntiles = 4 * MT * NTL;
    for (int t = blockIdx.x; t < ntiles; t += gridDim.x) {
        const int which = t / (MT * NTL), r = t % (MT * NTL), mt = r / NTL, nt = r % NTL;
        RowLinear rs{mt * G_BM};
        if (which < 2) {
            EpiDecay epi{(float*)(P.ws + WS_RWDEC) + (size_t)which * NROWS * 512, P.rw_w0 + (size_t)(i * 2 + which) * 512, mt * G_BM, nt * G_BN};
            gemm_tile(wv, la + which * 64, 320, rs, lt + (size_t)which * 512 * 64, 64, nt * G_BN, 64, epi, lds);
        } else if (which == 2) {
            EpiAK epi{(bf16_t*)(P.ws + WS_RWK), (const bf16_t*)(P.ws + WS_RWKK), (bf16_t*)(P.ws + WS_RWB), P.rw_a0 + i * 512, P.rw_k_a + i * 512, mt * G_BM, nt * G_BN};
            gemm_tile(wv, la + 128, 320, rs, lt + (size_t)2 * 512 * 64, 64, nt * G_BN, 64, epi, lds);
        } else {
            EpiStoreBf16 epi{(bf16_t*)(P.ws + WS_RWG), 512, mt * G_BM, nt * G_BN, 512};
            gemm_tile(wv, la + 192, 320, rs, lt + (size_t)3 * 512 * 64, 128, nt * G_BN, 128, epi, lds);
        }
    }
}
__device__ __forceinline__ void moe_tiles(int wv, const unsigned char* ws, int layer, LAS int* tstart, LAS int* tcnt) {
    const int tid = ltid(wv);
    if (tid < 64) {
        const int* cnt = (const int*)(ws + WS_CNT) + layer * 32 * CNT_STRIDE;
        const int c = tid < NEXP ? cnt[tid * CNT_STRIDE] : 0;
        int incl = (c + G_BM - 1) / G_BM;
#pragma unroll
        for (int o = 1; o < 32; o <<= 1) { const int t = __shfl_up(incl, o); if (tid >= o) incl += t; }
        if (tid < NEXP) { tcnt[tid] = c; tstart[tid] = incl - (c + G_BM - 1) / G_BM; }
        if (tid == NEXP - 1) tstart[NEXP] = incl;
    }
    __syncthreads();
}
__device__ __forceinline__ void phase_moe1(int wv, KP Pk, int layer, LAS char* lds) {
    asm volatile("" : "+s"(Pk));
    const CAS Params& P = *Pk;
    LAS int* tstart = (LAS int*)(lds + pg8::STAGE_BYTES); LAS int* tcnt = tstart + 40;
    moe_tiles(wv, P.ws, layer, tstart, tcnt);
    pg8::Gemm g{(const bf16_t*)(P.ws + WS_ACT), (const bf16_t*)(P.ws + WS_EXPGU), 0, 1024, D};
    LAS int* ltabs = tstart + 128;
    pg8::MoeOrder S{tstart, tcnt, ltabs, (const int*)(P.ws + WS_LIST), (const char*)(P.ws + WS_EXPGU), (size_t)1024 * 1024 * 2, 4, 1, (int)gridDim.x, (int)blockIdx.x};
    pg8::EpiSwiGLUG E{(bf16_t*)(P.ws + WS_HID)};
    for (int i = 0; i < 8; ++i) {
        pg8::UnitG u; if (!S.next(i, u)) break;
        const int tl = ltid(wv);
        const int* ul = (const int*)(P.ws + WS_LIST) + (size_t)u.e * LISTCAP + u.pm * pg8::BM;
        if (tl < pg8::BM) ltabs[i * pg8::BM + tl] = ul[tl < u.cnt ? tl : 0];
    }
    __syncthreads();
    pg8::gemm_phase_g(wv, (PG8_LAS unsigned char*)lds, g, S, E);
    __syncthreads();
}
__device__ __forceinline__ void phase_moe2(int wv, KP Pk, int layer, LAS char* lds) {
    asm volatile("" : "+s"(Pk));
    const CAS Params& P = *Pk;
    LAS int* tstart = (LAS int*)(lds + pg8::STAGE_BYTES); LAS int* tcnt = tstart + 40;
    moe_tiles(wv, P.ws, layer, tstart, tcnt);
    pg8::Gemm g{(const bf16_t*)(P.ws + WS_HID), (const bf16_t*)(P.ws + WS_EXPD), 0, 1024, DEXP};
    LAS int* ltabs = tstart + 128;
    pg8::MoeOrder S{tstart, tcnt, ltabs, (const int*)(P.ws + WS_LIST), (const char*)(P.ws + WS_EXPD), (size_t)1024 * 512 * 2, 4, 0, (int)gridDim.x, (int)blockIdx.x};
    pg8::EpiScatterG E{(bf16_t*)(P.ws + WS_YP)};
    for (int i = 0; i < 8; ++i) {
        pg8::UnitG u; if (!S.next(i, u)) break;
        const int tl = ltid(wv);
        const int* ul = (const int*)(P.ws + WS_LIST) + (size_t)u.e * LISTCAP + u.pm * pg8::BM;
        if (tl < pg8::BM) ltabs[i * pg8::BM + tl] = ul[tl < u.cnt ? tl : 0];
    }
    __syncthreads();
    pg8::gemm_phase_g(wv, (PG8_LAS unsigned char*)lds, g, S, E);
    __syncthreads();
}

constexpr int NCHUNK = NSTEPS / TCH;

constexpr int SSD_F = 32 + 64 + 64;
constexpr int SSD_BUF = TCH * SSD_F + 3 * TCH;

constexpr int ML_F = 64 + 64 + 32;
constexpr int ML_BUF = TCH * ML_F + 4 * TCH;

constexpr int HG_F = 128 + 128 + 32;
constexpr int HG_BUF = TCH * HG_F + TCH;

constexpr int RW_F = 5 * 64 + 32;
constexpr int RW_BUF = TCH * RW_F + TCH;
__device__ __forceinline__ void scan_rwkv(int wv, KP Pk, int layer, int unit, LAS char* lds) {
    asm volatile("" : "+s"(Pk));
    const CAS Params& P = *Pk;
    const int tid = ltid(wv);
    const int seq = unit >> 1, half = unit & 1, b = seq >> 4, h = (seq >> 1) & 7, dir = seq & 1;
    LAS float* bufs = (LAS float*)lds;
    bf16_t* Y = (bf16_t*)(P.ws + (dir ? WS_YB : WS_YF));
    const float* dec = (const float*)(P.ws + WS_RWDEC) + (size_t)dir * NROWS * 512;
    int tj[4], tg_[4]; bool tv[4]; const unsigned char* tbase[4]; int tlds[4];
#pragma unroll
    for (int s = 0; s < 4; ++s) {
        const int task = tid + NT * s; tv[s] = task < TCH * 52; tj[s] = task / 52; tg_[s] = task % 52;
        const int g = tg_[s];
        if (g < 8)       { tbase[s] = P.ws + WS_RWR  + (size_t)(h * 64 + 8 * g) * 2;              tlds[s] = 256 + 8 * g; }
        else if (g < 16) { tbase[s] = P.ws + WS_RWK  + (size_t)(h * 64 + 8 * (g - 8)) * 2;        tlds[s] = 192 + 8 * (g - 8); }
        else if (g < 24) { tbase[s] = P.ws + WS_RWKK + (size_t)(h * 64 + 8 * (g - 16)) * 2;       tlds[s] = 64 + 8 * (g - 16); }
        else if (g < 32) { tbase[s] = P.ws + WS_RWB  + (size_t)(h * 64 + 8 * (g - 24)) * 2;       tlds[s] = 128 + 8 * (g - 24); }
        else if (g < 36) { tbase[s] = P.ws + WS_RWV  + (size_t)(h * 64 + half * 32 + 8 * (g - 32)) * 2; tlds[s] = 320 + 8 * (g - 32); }
        else             { tbase[s] = (const unsigned char*)(dec + h * 64 + 4 * (g - 36));        tlds[s] = 4 * (g - 36); }
    }
    u32x4 rc[4]; int rrow = 0;
    auto load = [&](int c) {
#pragma unroll
        for (int s = 0; s < 4; ++s) {
            rc[s] = (u32x4){0u, 0u, 0u, 0u};
            if (tv[s]) { const int row = scan_row(c * TCH + tj[s], b, dir, 1); rc[s] = *(const u32x4*)(tbase[s] + (size_t)row * (tg_[s] < 36 ? 1024 : 2048)); }
        }
        if (tid < TCH) rrow = scan_row(c * TCH + tid, b, dir, 1);
    };
    auto store = [&](int c) {
        LAS float* buf = bufs + (c & 1) * RW_BUF;
#pragma unroll
        for (int s = 0; s < 4; ++s) {
            if (tv[s]) {
                LAS float* dst = buf + tj[s] * RW_F + tlds[s];
                const int g = tg_[s];
                if (g >= 36) { *(LAS u32x4*)dst = rc[s]; }
                else {
                    float f[8]; unpack8(rc[s], f);
                    const float sg = (g >= 16 && g < 24) ? -1.f : 1.f;
                    *(LAS f32x4*)dst = (f32x4){sg * f[0], sg * f[1], sg * f[2], sg * f[3]}; *(LAS f32x4*)(dst + 4) = (f32x4){sg * f[4], sg * f[5], sg * f[6], sg * f[7]};
                }
            }
        }
        if (tid < TCH) ((LAS int*)buf)[TCH * RW_F + tid] = rrow;
    };
    const int vrow = tid >> 4, q = tid & 15;
    float S[4] = {0.f, 0.f, 0.f, 0.f};
    load(0); store(0); __syncthreads();
    for (int c = 0; c < NCHUNK; ++c) {
        if (c + 1 < NCHUNK) load(c + 1);
        LAS float* buf = bufs + (c & 1) * RW_BUF;
        {
            const LAS float* wp = buf + 4 * q;
            const LAS float* vp = buf + 320 + vrow;
            f32x4 w4 = *(const LAS f32x4*)wp, a4 = *(const LAS f32x4*)(wp + 64), b4 = *(const LAS f32x4*)(wp + 128), k4 = *(const LAS f32x4*)(wp + 192), r4 = *(const LAS f32x4*)(wp + 256); float vr = vp[0];
#pragma unroll 1
            for (int jh = 0; jh < 2; ++jh) {
                float ysel = 0.f;
#pragma unroll
                for (int j = 0; j < 16; ++j) {
                    const int jj = jh * 16 + j;
                    const f32x4 wc = w4, ac = a4, bc = b4, kc = k4, rc = r4; const float vv = vr;
                    if (j < 15 || jh == 0) {
                        const LAS float* np = wp + (jj + 1) * RW_F;
                        w4 = *(const LAS f32x4*)np; a4 = *(const LAS f32x4*)(np + 64); b4 = *(const LAS f32x4*)(np + 128); k4 = *(const LAS f32x4*)(np + 192); r4 = *(const LAS f32x4*)(np + 256); vr = vp[(jj + 1) * RW_F];
                    }
                    float sa = S[0] * ac[0] + S[1] * ac[1] + S[2] * ac[2] + S[3] * ac[3];
                    sa = allreduce16(sa);
                    float y = 0.f;
#pragma unroll
                    for (int e = 0; e < 4; ++e) { S[e] = S[e] * wc[e] + (sa * bc[e] + vv * kc[e]); y += S[e] * rc[e]; }
                    y = allreduce16(y);
                    ysel = (q == j) ? y : ysel;
                }
                const int row = ((const LAS int*)buf)[TCH * RW_F + jh * 16 + q];
                Y[(size_t)row * D + 512 + h * 64 + half * 32 + vrow] = f2bf(ysel);
            }
        }
        if (c + 1 < NCHUNK) store(c + 1);
        __syncthreads();
    }
}

constexpr size_t WS_EXBC = WS_RWR;
constexpr size_t WS_EQK = WS_EXBC + (size_t)NROWS * 768 * 2;
constexpr size_t WS_EGT = WS_EQK + (size_t)NROWS * 512 * 2;
static_assert(WS_EGT + (size_t)NROWS * 32 * 4 <= WS_LA, "even-layer prepare buffers must fit in the RWKV region");

__device__ __forceinline__ void phase_prep_even(int wv, KP Pk, int layer) {
    asm volatile("" : "+s"(Pk));
    const CAS Params& P = *Pk;
    const int tid = ltid(wv), lane = tid & 63, wid = tid >> 6, i_ = layer >> 1;
    const bf16_t* Pb = (const bf16_t*)(P.ws + WS_P);
    bf16_t* XBC = (bf16_t*)(P.ws + WS_EXBC); bf16_t* QK = (bf16_t*)(P.ws + WS_EQK); float* GT = (float*)(P.ws + WS_EGT);
    float cw0[4][8], cw1[4][8], cwq[4][8];
#pragma unroll
    for (int e = 0; e < 8; ++e) {
#pragma unroll
        for (int t = 0; t < 3; ++t) {
            cw0[t][e] = P.ssd_conv_w[(size_t)(i_ * 3 + t) * 768 + 8 * lane + e];
            cw1[t][e] = P.ssd_conv_w[(size_t)(i_ * 3 + t) * 768 + 512 + 8 * (lane & 31) + e];
            cwq[t][e] = P.ml_conv_w[(size_t)(i_ * 3 + t) * 512 + 8 * lane + e];
        }
        cw0[3][e] = P.ssd_conv_b[i_ * 768 + 8 * lane + e]; cw1[3][e] = P.ssd_conv_b[i_ * 768 + 512 + 8 * (lane & 31) + e]; cwq[3][e] = P.ml_conv_b[i_ * 512 + 8 * lane + e];
    }
    float gbias = 0.f;
    if (lane < 16) gbias = P.ssd_dt_bias[i_ * 16 + lane]; else if (lane < 24) gbias = P.ml_i_bias[i_ * 8 + lane - 16]; else if (lane < 32) gbias = P.ml_f_bias[i_ * 8 + lane - 24];
    const float qscl = lane < 32 ? 0.125f : 1.f;
    for (int r = blockIdx.x * 8 + wid; r < NROWS; r += gridDim.x * 8) {
        int t, len; row_seg(r, t, len);
        const bf16_t* pr = Pb + (size_t)r * LDP_EVEN;
        const bool hp = t > 0, hn = t < len - 1;
        const u32x4 zero = (u32x4){0u, 0u, 0u, 0u};
        float fc[8], fp[8], fn[8], o[8];
        {
            const int col = 512 + 8 * lane;
            unpack8(*(const u32x4*)(pr + col), fc); unpack8(hp ? *(const u32x4*)(pr - LDP_EVEN + col) : zero, fp); unpack8(hn ? *(const u32x4*)(pr + LDP_EVEN + col) : zero, fn);
#pragma unroll
            for (int e = 0; e < 8; ++e) o[e] = siluf_(cw0[0][e] * fp[e] + cw0[1][e] * fc[e] + cw0[2][e] * fn[e] + cw0[3][e]);
            *(u32x4*)(XBC + (size_t)r * 768 + 8 * lane) = pack8(o);
        }
        if (lane < 32) {
            const int col = 1024 + 8 * lane;
            unpack8(*(const u32x4*)(pr + col), fc); unpack8(hp ? *(const u32x4*)(pr - LDP_EVEN + col) : zero, fp); unpack8(hn ? *(const u32x4*)(pr + LDP_EVEN + col) : zero, fn);
#pragma unroll
            for (int e = 0; e < 8; ++e) o[e] = siluf_(cw1[0][e] * fp[e] + cw1[1][e] * fc[e] + cw1[2][e] * fn[e] + cw1[3][e]);
            *(u32x4*)(XBC + (size_t)r * 768 + 512 + 8 * lane) = pack8(o);
        }
        {
            const int col = 1296 + 8 * lane;
            unpack8(*(const u32x4*)(pr + col), fc); unpack8(hp ? *(const u32x4*)(pr - LDP_EVEN + col) : zero, fp); unpack8(hn ? *(const u32x4*)(pr + LDP_EVEN + col) : zero, fn);
#pragma unroll
            for (int e = 0; e < 8; ++e) o[e] = qscl * siluf_(cwq[0][e] * fp[e] + cwq[1][e] * fc[e] + cwq[2][e] * fn[e] + cwq[3][e]);
            *(u32x4*)(QK + (size_t)r * 512 + 8 * lane) = pack8(o);
        }
        if (lane < 32) {
            const int col = lane < 16 ? 1280 + lane : 2832 + (lane - 16);
            const float x = bf2f(pr[col]) + gbias;
            GT[(size_t)r * 32 + lane] = lane < 16 ? softplusf_(x) : lane < 24 ? x : logsigmoidf_(x);
        }
    }
}

constexpr int CL = 64, NCH64 = NSTEPS / CL, LDT = 72, LDTB = LDT * 2;
__device__ __forceinline__ bf16x8 ldfrag(const LAS char* tile, int ldb, int row0, int k0, int lane) {
    return *(const LAS bf16x8*)(tile + (row0 + (lane & 15)) * ldb + (k0 + 8 * (lane >> 4)) * 2);
}
constexpr int LDTS = 160;
__device__ __forceinline__ int swz_off(int row, int byteoff) { return row * LDTS + (byteoff ^ (((row >> 3) & 7) << 4)); }
__device__ __forceinline__ bf16x8 ldfrag_sw(const LAS char* tile, int row0, int k0, int lane) {
    const int row = row0 + (lane & 15);
    return *(const LAS bf16x8*)(tile + swz_off(row, (k0 + 8 * (lane >> 4)) * 2));
}
__device__ __forceinline__ void st4bf(LAS char* p, const f32x4& v) { u32x2 o; o.x = pk2(v[0], v[1]); o.y = pk2(v[2], v[3]); *(LAS u32x2*)p = o; }

constexpr int SS_BT = 0, SS_CT = SS_BT + 64 * LDTB, SS_BDT = SS_CT + 64 * LDTB, SS_XT = SS_BDT + 64 * LDTB, SS_CUM = SS_XT + 32 * LDTB, SS_DTV = SS_CUM + 256, SS_ROWS = SS_DTV + 256, SS_STG = SS_ROWS + 256;
constexpr int SS_M = 2 * SS_STG, SS_HB = SS_M + 64 * LDTB, SS_END = SS_HB + 32 * LDTB;
static_assert(SS_END <= LDS_BYTES - 16, "SSD LDS map");

constexpr int MS_QT = 0, MS_KT = MS_QT + 64 * LDTB, MS_KET = MS_KT + 64 * LDTB, MS_VT = MS_KET + 64 * LDTB, MS_SC = MS_VT + 32 * LDTB;
constexpr int MS_STG = MS_SC + 8 * 256;
constexpr int MS_W = 2 * MS_STG, MS_CB = MS_W + 64 * LDTB, MS_ONE = MS_CB + 32 * LDTB, MS_NV = MS_ONE + 16 * LDTB, MS_QN = MS_NV + 256, MS_END = MS_QN + 256;
static_assert(MS_END <= LDS_BYTES - 16, "mLSTM LDS map");

constexpr size_t WS_XSS = WS_EGT + al256((size_t)NROWS * 32 * 4);
constexpr size_t XSS_BYTES = (size_t)64 * NCH64 * 64 * 64 * 2;
constexpr size_t WS_XSD = WS_XSS + XSS_BYTES;
constexpr size_t WS_XMC = WS_XSD + al256((size_t)64 * NCH64 * 4);
constexpr size_t XMC_BYTES = (size_t)32 * NCH64 * 128 * 64 * 2;
constexpr size_t WS_XMN = WS_XMC + XMC_BYTES;
constexpr size_t WS_XMS = WS_XMN + (size_t)32 * NCH64 * 64 * 4;
constexpr size_t WS_XMT = WS_XMS + al256((size_t)32 * NCH64 * 4 * 4);
constexpr size_t WS_XEND = WS_XMT + (size_t)32 * NCH64 * 3 * 64 * 4;
static_assert(WS_XEND <= WS_END, "even-layer chunk-state buffers must fit in the RWKV region");
constexpr int NSSD_ITEMS = 64 * NCH64, NML_ITEMS = 32 * NCH64;

template <int CTRL, int RM, int BM> __device__ __forceinline__ float dppx(float old, float v) {
    return __builtin_bit_cast(float, __builtin_amdgcn_update_dpp(__builtin_bit_cast(int, old), __builtin_bit_cast(int, v), CTRL, RM, BM, false));
}
__device__ __forceinline__ float wave_cumsum(float v, int) {
    float t = v;
    t += dppx<0x111, 0xf, 0xf>(0.f, v); t += dppx<0x112, 0xf, 0xf>(0.f, v); t += dppx<0x113, 0xf, 0xf>(0.f, v);
    { const float u = dppx<0x114, 0xf, 0xe>(0.f, t); t += u; }
    { const float u = dppx<0x118, 0xf, 0xc>(0.f, t); t += u; }
    { const float u = dppx<0x142, 0xa, 0xf>(0.f, t); t += u; }
    { const float u = dppx<0x143, 0xc, 0xf>(0.f, t); t += u; }
    return t;
}
__device__ __forceinline__ float wave_cummax(float v, int) {
    const float ninf = -__builtin_huge_valf();
    float t = v;
    t = fmaxf(t, dppx<0x111, 0xf, 0xf>(ninf, v)); t = fmaxf(t, dppx<0x112, 0xf, 0xf>(ninf, v)); t = fmaxf(t, dppx<0x113, 0xf, 0xf>(ninf, v));
    { const float u = dppx<0x114, 0xf, 0xe>(ninf, t); t = fmaxf(t, u); }
    { const float u = dppx<0x118, 0xf, 0xc>(ninf, t); t = fmaxf(t, u); }
    { const float u = dppx<0x142, 0xa, 0xf>(ninf, t); t = fmaxf(t, u); }
    { const float u = dppx<0x143, 0xc, 0xf>(ninf, t); t = fmaxf(t, u); }
    return t;
}
__device__ __forceinline__ float wave_max(float v) {
    const float t = wave_cummax(v, 0);
    return __builtin_bit_cast(float, __builtin_amdgcn_readlane(__builtin_bit_cast(int, t), 63));
}

constexpr int X1S_BDT = 0, X1S_XT = X1S_BDT + 64 * LDTS, X1S_CUM = X1S_XT + 64 * LDTS, X1S_DTV = X1S_CUM + 256, X1S_END = X1S_DTV + 256;
constexpr int X1M_KET = 0, X1M_VT = X1M_KET + 64 * LDTS, X1M_ONE = X1M_VT + 128 * LDTS, X1M_EE = X1M_ONE + 16 * LDTB, X1M_END = X1M_EE + 256;
__device__ __forceinline__ void phase_ex1(int wv, KP Pk, int layer, LAS char* lds) {
    asm volatile("" : "+s"(Pk));
    const CAS Params& P = *Pk;
    const int tid = ltid(wv), lane = tid & 63, wid = tid >> 6, q = lane >> 4, r16 = lane & 15, i_ = layer >> 1;
    const bf16_t* XBC = (const bf16_t*)(P.ws + WS_EXBC); const bf16_t* QK = (const bf16_t*)(P.ws + WS_EQK); const bf16_t* Pb = (const bf16_t*)(P.ws + WS_P);
    const float* GT = (const float*)(P.ws + WS_EGT);
    {
        bf16_t* Hst = (bf16_t*)(P.ws + WS_XSS); float* Dst = (float*)(P.ws + WS_XSD);
        u32x4 rc[2]; float rdt = 0.f;
        auto geom = [&](int it, int& b, int& h, int& dir, int& c) { const int sq = it / NCH64; c = it - sq * NCH64; b = sq >> 4; h = (sq >> 1) & 7; dir = sq & 1; };
        auto load = [&](int it) {
            int b, h, dir, c; geom(it, b, h, dir, c);
            int tl = tid; asm volatile("" : "+v"(tl));
#pragma unroll
            for (int s = 0; s < 2; ++s) {
                const int task = tl + NT * s, j = task >> 4, g = task & 15;
                const int row = scan_row(c * CL + j, b, dir, 0);
                rc[s] = *(const u32x4*)(XBC + (size_t)row * 768 + (g < 8 ? h * 64 + 8 * g : 512 + (h >> 2) * 64 + 8 * (g - 8)));
            }
            if (tl < CL) { const int row = scan_row(c * CL + tl, b, dir, 0); rdt = GT[(size_t)row * 32 + dir * 8 + h]; }
        };
        int it = blockIdx.x;
        if (it < NSSD_ITEMS) load(it);
        for (; it < NSSD_ITEMS; it += gridDim.x) {
            int b, h, dir, c; geom(it, b, h, dir, c);
            const float aco = -__expf(P.ssd_a_log[(i_ * 2 + dir) * 8 + h]);
            if (tid < CL) {
                const float cum = wave_cumsum(rdt * aco, lane);
                ((LAS float*)(lds + X1S_CUM))[tid] = cum; ((LAS float*)(lds + X1S_DTV))[tid] = rdt;
            }
            __syncthreads();
            {
                const LAS float* cum = (const LAS float*)(lds + X1S_CUM);
                const float cumL = cum[CL - 1];
                int tl = tid; asm volatile("" : "+v"(tl));
#pragma unroll
                for (int s = 0; s < 2; ++s) {
                    const int task = tl + NT * s, j = task >> 4, g = task & 15;
                    float f[8]; unpack8(rc[s], f);
                    if (g < 8) {
                        const float dt = ((const LAS float*)(lds + X1S_DTV))[j];
#pragma unroll
                        for (int e = 0; e < 8; ++e) *(LAS bf16_t*)(lds + X1S_XT + swz_off(8 * g + e, j * 2)) = f2bf(f[e] * dt);
                    } else {
                        const float sc = __expf(cumL - cum[j]);
#pragma unroll
                        for (int e = 0; e < 8; ++e) *(LAS bf16_t*)(lds + X1S_BDT + swz_off(8 * (g - 8) + e, j * 2)) = f2bf(f[e] * sc);
                    }
                }
                if (tid == 0) Dst[it] = __expf(cumL);
            }
            if (it + (int)gridDim.x < NSSD_ITEMS) load(it + gridDim.x);
            __syncthreads();
            {
                const int pt = wid >> 1;
#pragma unroll
                for (int u = 0; u < 2; ++u) {
                    const int nt = (wid & 1) * 2 + u;
                    f32x4 sa = (f32x4){0.f, 0.f, 0.f, 0.f};
#pragma unroll
                    for (int k0 = 0; k0 < 64; k0 += 32) sa = __builtin_amdgcn_mfma_f32_16x16x32_bf16(ldfrag_sw(lds + X1S_BDT, nt * 16, k0, lane), ldfrag_sw(lds + X1S_XT, pt * 16, k0, lane), sa, 0, 0, 0);
                    u32x2 o; o.x = pk2(sa[0], sa[1]); o.y = pk2(sa[2], sa[3]);
                    *(u32x2*)(Hst + ((size_t)it * 64 + pt * 16 + r16) * 64 + nt * 16 + 4 * q) = o;
                }
            }
            __syncthreads();
        }
    }
    {
        bf16_t* Cst = (bf16_t*)(P.ws + WS_XMC); float* Nst = (float*)(P.ws + WS_XMN); float* Sst = (float*)(P.ws + WS_XMS); float* Tst = (float*)(P.ws + WS_XMT);
        for (int i = tid; i < 16 * LDTB / 4; i += NT) ((LAS unsigned*)(lds + X1M_ONE))[i] = 0x3f803f80u;
        u32x4 rc[3]; float rli = 0.f, rlf = 0.f;
        auto geom = [&](int it, int& b, int& h, int& dir, int& c) { const int sq = it / NCH64; c = it - sq * NCH64; b = sq >> 3; h = (sq >> 1) & 3; dir = sq & 1; };
        auto load = [&](int it) {
            int b, h, dir, c; geom(it, b, h, dir, c);
            int tl = tid; asm volatile("" : "+v"(tl));
#pragma unroll
            for (int s = 0; s < 3; ++s) {
                const int task = tl + NT * s, j = task / 24, g = task - 24 * j;
                const int row = scan_row(c * CL + j, b, dir, 0);
                rc[s] = g < 8 ? *(const u32x4*)(QK + (size_t)row * 512 + 256 + h * 64 + 8 * g) : *(const u32x4*)(Pb + (size_t)row * LDP_EVEN + 1808 + h * 128 + 8 * (g - 8));
            }
            if (tl < CL) { const int row = scan_row(c * CL + tl, b, dir, 0); rli = GT[(size_t)row * 32 + 16 + dir * 4 + h]; rlf = GT[(size_t)row * 32 + 24 + dir * 4 + h]; }
        };
        int it = blockIdx.x;
        if (it < NML_ITEMS) load(it);
        __syncthreads();
        for (; it < NML_ITEMS; it += gridDim.x) {
            if (tid < CL) {
                const float fcum = wave_cumsum(rlf, lane);
                const float ftot = __builtin_bit_cast(float, __builtin_amdgcn_readlane(__builtin_bit_cast(int, fcum), 63));
                const float g = rli - fcum, pm = wave_cummax(g, lane);
                const float wend = ftot + g, mloc = wave_max(wend);
                ((LAS float*)(lds + X1M_EE))[tid] = __expf(wend - mloc);
                float* tp = Tst + (size_t)it * 192;
                tp[tid] = fcum; tp[64 + tid] = g; tp[128 + tid] = pm;
                if (tid == 0) { Sst[(size_t)it * 4 + 0] = ftot; Sst[(size_t)it * 4 + 1] = mloc; }
            }
            __syncthreads();
            {
                const LAS float* ee = (const LAS float*)(lds + X1M_EE);
                int tl = tid; asm volatile("" : "+v"(tl));
#pragma unroll
                for (int s = 0; s < 3; ++s) {
                    const int task = tl + NT * s, j = task / 24, g = task - 24 * j;
                    if (g < 8) {
                        float f[8]; unpack8(rc[s], f);
                        const float e1 = ee[j];
#pragma unroll
                        for (int e = 0; e < 8; ++e) *(LAS bf16_t*)(lds + X1M_KET + swz_off(8 * g + e, j * 2)) = f2bf(f[e] * e1);
                    } else {
                        const int v0 = 8 * (g - 8);
#pragma unroll
                        for (int e = 0; e < 8; ++e) { const unsigned wv = rc[s][e >> 1]; *(LAS bf16_t*)(lds + X1M_VT + swz_off(v0 + e, j * 2)) = (bf16_t)((e & 1) ? (wv >> 16) : (wv & 0xffffu)); }
                    }
                }
            }
            if (it + (int)gridDim.x < NML_ITEMS) load(it + gridDim.x);
            __syncthreads();
            {
                const bf16x8 vf0 = ldfrag_sw(lds + X1M_VT, wid * 16, 0, lane), vf1 = ldfrag_sw(lds + X1M_VT, wid * 16, 32, lane);
#pragma unroll
                for (int kt = 0; kt < 4; ++kt) {
                    f32x4 sa = __builtin_amdgcn_mfma_f32_16x16x32_bf16(ldfrag_sw(lds + X1M_KET, kt * 16, 0, lane), vf0, (f32x4){0.f, 0.f, 0.f, 0.f}, 0, 0, 0);
                    sa = __builtin_amdgcn_mfma_f32_16x16x32_bf16(ldfrag_sw(lds + X1M_KET, kt * 16, 32, lane), vf1, sa, 0, 0, 0);
                    u32x2 o; o.x = pk2(sa[0], sa[1]); o.y = pk2(sa[2], sa[3]);
                    *(u32x2*)(Cst + ((size_t)it * 128 + wid * 16 + r16) * 64 + kt * 16 + 4 * q) = o;
                }
                if (wid < 4) {
                    f32x4 na = __builtin_amdgcn_mfma_f32_16x16x32_bf16(ldfrag_sw(lds + X1M_KET, wid * 16, 0, lane), ldfrag(lds + X1M_ONE, LDTB, 0, 0, lane), (f32x4){0.f, 0.f, 0.f, 0.f}, 0, 0, 0);
                    na = __builtin_amdgcn_mfma_f32_16x16x32_bf16(ldfrag_sw(lds + X1M_KET, wid * 16, 32, lane), ldfrag(lds + X1M_ONE, LDTB, 0, 32, lane), na, 0, 0, 0);
                    if (r16 == 0) *(f32x4*)(Nst + (size_t)it * 64 + wid * 16 + 4 * q) = na;
                }
            }
            __syncthreads();
        }
    }
}

constexpr int EX2_UB = 12;
static_assert(NCH64 % EX2_UB == 0, "EX2 batches");
__device__ __forceinline__ void phase_ex2(int wv, KP Pk, int layer) {
    asm volatile("" : "+s"(Pk));
    const CAS Params& P = *Pk;
    const int tid = ltid(wv);
    (void)layer;
    if (blockIdx.x < 128) {
        const int gt = blockIdx.x * NT + tid, sq = gt >> 10, rem = gt & 1023;
        bf16_t* Hst = (bf16_t*)(P.ws + WS_XSS) + (size_t)sq * NCH64 * 4096 + rem * 4;
        const float* Dst = (const float*)(P.ws + WS_XSD) + sq * NCH64;
        float h0 = 0.f, h1 = 0.f, h2 = 0.f, h3 = 0.f;
#pragma unroll 1
        for (int c0 = 0; c0 < NCH64; c0 += EX2_UB) {
            u32x2 loc[EX2_UB]; float dd[EX2_UB];
            bf16_t* hp = Hst + (size_t)c0 * 4096;
#pragma unroll
            for (int u = 0; u < EX2_UB; ++u) { loc[u] = *(const u32x2*)(hp + (size_t)u * 4096); dd[u] = Dst[c0 + u]; }
#pragma unroll
            for (int u = 0; u < EX2_UB; ++u) {
                u32x2 o; o.x = pk2(h0, h1); o.y = pk2(h2, h3);
                *(u32x2*)(hp + (size_t)u * 4096) = o;
                const float d = dd[u];
                h0 = d * h0 + bflo(loc[u].x); h1 = d * h1 + bfhi(loc[u].x); h2 = d * h2 + bflo(loc[u].y); h3 = d * h3 + bfhi(loc[u].y);
            }
        }
    } else if (blockIdx.x < 256) {
        const int gt = (blockIdx.x - 128) * NT + tid, sq = gt >> 11, rem = gt & 2047;
        bf16_t* Cst = (bf16_t*)(P.ws + WS_XMC) + (size_t)sq * NCH64 * 8192 + rem * 4;
        float* Nst = (float*)(P.ws + WS_XMN) + (size_t)sq * NCH64 * 64 + (rem & 15) * 4;
        float* Sst = (float*)(P.ws + WS_XMS) + (size_t)sq * NCH64 * 4;
        const bool own_n = rem < 16, own_m = rem == 0;
        float c0_ = 0.f, c1 = 0.f, c2 = 0.f, c3 = 0.f, m = -1e30f;
        f32x4 nn = (f32x4){0.f, 0.f, 0.f, 0.f};
#pragma unroll 1
        for (int cb = 0; cb < NCH64; cb += EX2_UB) {
            u32x2 loc[EX2_UB]; float ft[EX2_UB], ml[EX2_UB]; f32x4 nl[EX2_UB];
            bf16_t* cp = Cst + (size_t)cb * 8192; float* np = Nst + (size_t)cb * 64; float* sp_ = Sst + cb * 4;
#pragma unroll
            for (int u = 0; u < EX2_UB; ++u) {
                loc[u] = *(const u32x2*)(cp + (size_t)u * 8192); ft[u] = sp_[u * 4 + 0]; ml[u] = sp_[u * 4 + 1];
                nl[u] = (f32x4){0.f, 0.f, 0.f, 0.f};
                if (own_n) nl[u] = *(const f32x4*)(np + (size_t)u * 64);
            }
#pragma unroll
            for (int u = 0; u < EX2_UB; ++u) {
                const float ftot = ft[u], mloc = ml[u];
                const float mnew = fmaxf(ftot + m, mloc), sp = __expf(ftot + m - mnew), sl = __expf(mloc - mnew);
                u32x2 o; o.x = pk2(c0_, c1); o.y = pk2(c2, c3);
                *(u32x2*)(cp + (size_t)u * 8192) = o;
                c0_ = sp * c0_ + sl * bflo(loc[u].x); c1 = sp * c1 + sl * bfhi(loc[u].x); c2 = sp * c2 + sl * bflo(loc[u].y); c3 = sp * c3 + sl * bfhi(loc[u].y);
                if (own_n) { *(f32x4*)(np + (size_t)u * 64) = nn; nn = nn * sp + nl[u] * sl; }
                if (own_m) sp_[u * 4 + 2] = m;
                m = mnew;
            }
        }
    }
}

constexpr int X3S_BT = 0, X3S_CT = X3S_BT + 64 * LDTB, X3S_XT = X3S_CT + 64 * LDTB, X3S_HB = X3S_XT + 64 * LDTS, X3S_M = X3S_HB + 64 * LDTB, X3S_CUM = X3S_M + 64 * LDTB, X3S_DTV = X3S_CUM + 256, X3S_ROWS = X3S_DTV + 256, X3S_END = X3S_ROWS + 256;
constexpr int X3M_QT = 0, X3M_KT = X3M_QT + 64 * LDTB, X3M_VT = X3M_KT + 64 * LDTB, X3M_CB = X3M_VT + 128 * LDTS, X3M_W = X3M_CB + 128 * LDTB, X3M_ONE = X3M_W + 64 * LDTB, X3M_NB = X3M_ONE + 16 * LDTB,
              X3M_SC = X3M_NB + 16 * LDTB, X3M_END = X3M_SC + 6 * 256;
static_assert(X3M_END <= LDS_BYTES - 16 && X3S_END <= LDS_BYTES - 16, "EX3 LDS maps");
__device__ __forceinline__ void phase_ex3(int wv, KP Pk, int layer, LAS char* lds) {
    asm volatile("" : "+s"(Pk));
    const CAS Params& P = *Pk;
    const int tid = ltid(wv), lane = tid & 63, wid = tid >> 6, q = lane >> 4, r16 = lane & 15, i_ = layer >> 1;
    const bf16_t* XBC = (const bf16_t*)(P.ws + WS_EXBC); const bf16_t* QK = (const bf16_t*)(P.ws + WS_EQK); const bf16_t* Pb = (const bf16_t*)(P.ws + WS_P);
    const float* GT = (const float*)(P.ws + WS_EGT);
    {
        const bf16_t* Hst = (const bf16_t*)(P.ws + WS_XSS);
        u32x4 rc[3], rh; float rdt = 0.f; int rrow = 0;
        auto geom = [&](int it, int& b, int& h, int& dir, int& c) { const int sq = it / NCH64; c = it - sq * NCH64; b = sq >> 4; h = (sq >> 1) & 7; dir = sq & 1; };
        auto load = [&](int it) {
            int b, h, dir, c; geom(it, b, h, dir, c);
            int tl = tid; asm volatile("" : "+v"(tl));
#pragma unroll
            for (int s = 0; s < 3; ++s) {
                const int task = tl + NT * s, j = task / 24, g = task - 24 * j;
                const int row = scan_row(c * CL + j, b, dir, 0);
                rc[s] = *(const u32x4*)(XBC + (size_t)row * 768 + (g < 8 ? h * 64 + 8 * g : g < 16 ? 512 + (h >> 2) * 64 + 8 * (g - 8) : 640 + (h >> 2) * 64 + 8 * (g - 16)));
            }
            rh = *(const u32x4*)(Hst + (size_t)it * 4096 + tl * 8);
            if (tl < CL) { rrow = scan_row(c * CL + tl, b, dir, 0); rdt = GT[(size_t)rrow * 32 + dir * 8 + h]; }
        };
        int it = blockIdx.x;
        if (it < NSSD_ITEMS) load(it);
        __syncthreads();
        for (; it < NSSD_ITEMS; it += gridDim.x) {
            int b, h, dir, c; geom(it, b, h, dir, c);
            bf16_t* Y = (bf16_t*)(P.ws + (dir ? WS_YB : WS_YF));
            const float aco = -__expf(P.ssd_a_log[(i_ * 2 + dir) * 8 + h]);
            if (tid < CL) {
                const float cum = wave_cumsum(rdt * aco, lane);
                ((LAS float*)(lds + X3S_CUM))[tid] = cum; ((LAS float*)(lds + X3S_DTV))[tid] = rdt; ((LAS int*)(lds + X3S_ROWS))[tid] = rrow;
            }
            __syncthreads();
            {
                int tl = tid; asm volatile("" : "+v"(tl));
#pragma unroll
                for (int s = 0; s < 3; ++s) {
                    const int task = tl + NT * s, j = task / 24, g = task - 24 * j;
                    if (g < 8) {
                        float f[8]; unpack8(rc[s], f);
                        const float dt = ((const LAS float*)(lds + X3S_DTV))[j];
#pragma unroll
                        for (int e = 0; e < 8; ++e) *(LAS bf16_t*)(lds + X3S_XT + swz_off(8 * g + e, j * 2)) = f2bf(f[e] * dt);
                    } else if (g < 16) *(LAS u32x4*)(lds + X3S_BT + j * LDTB + 8 * (g - 8) * 2) = rc[s];
                    else *(LAS u32x4*)(lds + X3S_CT + j * LDTB + 8 * (g - 16) * 2) = rc[s];
                }
                *(LAS u32x4*)(lds + X3S_HB + (tl >> 3) * LDTB + (tl & 7) * 16) = rh;
            }
            if (it + (int)gridDim.x < NSSD_ITEMS) load(it + gridDim.x);
            __syncthreads();
            const LAS float* cum = (const LAS float*)(lds + X3S_CUM);
            {
                const int lt = wid >> 1;
#pragma unroll
                for (int u = 0; u < 2; ++u) {
                    const int st = (wid & 1) * 2 + u;
                    f32x4 acc = (f32x4){0.f, 0.f, 0.f, 0.f};
                    if (st <= lt) {
#pragma unroll
                        for (int k0 = 0; k0 < 64; k0 += 32) acc = __builtin_amdgcn_mfma_f32_16x16x32_bf16(ldfrag(lds + X3S_BT, LDTB, st * 16, k0, lane), ldfrag(lds + X3S_CT, LDTB, lt * 16, k0, lane), acc, 0, 0, 0);
                        const int l = lt * 16 + r16, s0 = st * 16 + 4 * q;
                        const float cl = cum[l]; const f32x4 cs = *(const LAS f32x4*)(cum + s0);
#pragma unroll
                        for (int j = 0; j < 4; ++j) acc[j] = (s0 + j <= l) ? acc[j] * __expf(cl - cs[j]) : 0.f;
                    }
                    st4bf(lds + X3S_M + (lt * 16 + r16) * LDTB + (st * 16 + 4 * q) * 2, acc);
                }
            }
            __syncthreads();
            {
                const int lt = wid >> 1, l = lt * 16 + r16;
                const float el = __expf(cum[l]);
                const int row = ((const LAS int*)(lds + X3S_ROWS))[l];
                const bf16x8 mf0 = ldfrag(lds + X3S_M, LDTB, lt * 16, 0, lane), mf1 = ldfrag(lds + X3S_M, LDTB, lt * 16, 32, lane);
                const bf16x8 cf0 = ldfrag(lds + X3S_CT, LDTB, lt * 16, 0, lane), cf1 = ldfrag(lds + X3S_CT, LDTB, lt * 16, 32, lane);
#pragma unroll
                for (int u = 0; u < 2; ++u) {
                    const int pt = (wid & 1) * 2 + u;
                    f32x4 ya = __builtin_amdgcn_mfma_f32_16x16x32_bf16(ldfrag_sw(lds + X3S_XT, pt * 16, 0, lane), mf0, (f32x4){0.f, 0.f, 0.f, 0.f}, 0, 0, 0);
                    ya = __builtin_amdgcn_mfma_f32_16x16x32_bf16(ldfrag_sw(lds + X3S_XT, pt * 16, 32, lane), mf1, ya, 0, 0, 0);
                    f32x4 oa = __builtin_amdgcn_mfma_f32_16x16x32_bf16(ldfrag(lds + X3S_HB, LDTB, pt * 16, 0, lane), cf0, (f32x4){0.f, 0.f, 0.f, 0.f}, 0, 0, 0);
                    oa = __builtin_amdgcn_mfma_f32_16x16x32_bf16(ldfrag(lds + X3S_HB, LDTB, pt * 16, 32, lane), cf1, oa, 0, 0, 0);
                    u32x2 o; o.x = pk2(ya[0] + el * oa[0], ya[1] + el * oa[1]); o.y = pk2(ya[2] + el * oa[2], ya[3] + el * oa[3]);
                    *(u32x2*)(Y + (size_t)row * D + h * 64 + pt * 16 + 4 * q) = o;
                }
            }
            __syncthreads();
        }
    }
    {
        const bf16_t* Cst = (const bf16_t*)(P.ws + WS_XMC); const float* Nst = (const float*)(P.ws + WS_XMN); const float* Sst = (const float*)(P.ws + WS_XMS); const float* Tst = (const float*)(P.ws + WS_XMT);
        for (int i = tid; i < 16 * LDTB / 4; i += NT) ((LAS unsigned*)(lds + X3M_ONE))[i] = 0x3f803f80u;
        u32x4 rc[4], rcb[2]; float rfc = 0.f, rg = 0.f, rpm = 0.f, rmp = 0.f, rn = 0.f; int rrow = 0;
        auto geom = [&](int it, int& b, int& h, int& dir, int& c) { const int sq = it / NCH64; c = it - sq * NCH64; b = sq >> 3; h = (sq >> 1) & 3; dir = sq & 1; };
        auto load = [&](int it) {
            int b, h, dir, c; geom(it, b, h, dir, c);
            int tl = tid; asm volatile("" : "+v"(tl));
#pragma unroll
            for (int s = 0; s < 4; ++s) {
                const int task = tl + NT * s, j = task >> 5, g = task & 31;
                const int row = scan_row(c * CL + j, b, dir, 0);
                rc[s] = g < 16 ? *(const u32x4*)(QK + (size_t)row * 512 + (g < 8 ? h * 64 + 8 * g : 256 + h * 64 + 8 * (g - 8))) : *(const u32x4*)(Pb + (size_t)row * LDP_EVEN + 1808 + h * 128 + 8 * (g - 16));
            }
#pragma unroll
            for (int s = 0; s < 2; ++s) rcb[s] = *(const u32x4*)(Cst + (size_t)it * 8192 + (tl + NT * s) * 8);
            if (tl < CL) {
                rrow = scan_row(c * CL + tl, b, dir, 0);
                const float* tp = Tst + (size_t)it * 192;
                rfc = tp[tl]; rg = tp[64 + tl]; rpm = tp[128 + tl]; rmp = Sst[(size_t)it * 4 + 2]; rn = Nst[(size_t)it * 64 + tl];
            }
        };
        int it = blockIdx.x;
        if (it < NML_ITEMS) load(it);
        __syncthreads();
        for (; it < NML_ITEMS; it += gridDim.x) {
            int b, h, dir, c; geom(it, b, h, dir, c);
            bf16_t* Y = (bf16_t*)(P.ws + (dir ? WS_YB : WS_YF));
            LAS float* sc = (LAS float*)(lds + X3M_SC);
            {
                int tl = tid; asm volatile("" : "+v"(tl));
#pragma unroll
                for (int s = 0; s < 4; ++s) {
                    const int task = tl + NT * s, j = task >> 5, g = task & 31;
                    if (g < 8) *(LAS u32x4*)(lds + X3M_QT + j * LDTB + 8 * g * 2) = rc[s];
                    else if (g < 16) *(LAS u32x4*)(lds + X3M_KT + j * LDTB + 8 * (g - 8) * 2) = rc[s];
                    else {
                        const int v0 = 8 * (g - 16);
#pragma unroll
                        for (int e = 0; e < 8; ++e) { const unsigned wv = rc[s][e >> 1]; *(LAS bf16_t*)(lds + X3M_VT + swz_off(v0 + e, j * 2)) = (bf16_t)((e & 1) ? (wv >> 16) : (wv & 0xffffu)); }
                    }
                }
#pragma unroll
                for (int s = 0; s < 2; ++s) { const int ch = tl + NT * s; *(LAS u32x4*)(lds + X3M_CB + (ch >> 3) * LDTB + (ch & 7) * 16) = rcb[s]; }
                if (tl < CL) {
                    const float linter = rfc + rmp, mrow = fmaxf(rfc + rpm, linter);
                    sc[tl] = rfc - mrow; sc[64 + tl] = rg; sc[128 + tl] = __expf(linter - mrow); sc[192 + tl] = __expf(-mrow); ((LAS int*)sc)[256 + tl] = rrow;
                    const bf16_t nb = f2bf(rn);
#pragma unroll
                    for (int r = 0; r < 16; ++r) *(LAS bf16_t*)(lds + X3M_NB + r * LDTB + tl * 2) = nb;
                }
            }
            if (it + (int)gridDim.x < NML_ITEMS) load(it + gridDim.x);
            __syncthreads();
            {
                const int lt = wid >> 1;
#pragma unroll
                for (int u = 0; u < 2; ++u) {
                    const int st = (wid & 1) * 2 + u;
                    f32x4 acc = (f32x4){0.f, 0.f, 0.f, 0.f};
                    if (st <= lt) {
#pragma unroll
                        for (int k0 = 0; k0 < 64; k0 += 32) acc = __builtin_amdgcn_mfma_f32_16x16x32_bf16(ldfrag(lds + X3M_KT, LDTB, st * 16, k0, lane), ldfrag(lds + X3M_QT, LDTB, lt * 16, k0, lane), acc, 0, 0, 0);
                        const int l = lt * 16 + r16, s0 = st * 16 + 4 * q;
                        const float rt = sc[l]; const f32x4 gs = *(const LAS f32x4*)(sc + 64 + s0);
#pragma unroll
                        for (int j = 0; j < 4; ++j) acc[j] = (s0 + j <= l) ? acc[j] * __expf(rt + gs[j]) : 0.f;
                    }
                    st4bf(lds + X3M_W + (lt * 16 + r16) * LDTB + (st * 16 + 4 * q) * 2, acc);
                }
            }
            __syncthreads();
            {
                const int lt = wid >> 1, l = lt * 16 + r16;
                const bf16x8 wf0 = ldfrag(lds + X3M_W, LDTB, lt * 16, 0, lane), wf1 = ldfrag(lds + X3M_W, LDTB, lt * 16, 32, lane);
                const bf16x8 qf0 = ldfrag(lds + X3M_QT, LDTB, lt * 16, 0, lane), qf1 = ldfrag(lds + X3M_QT, LDTB, lt * 16, 32, lane);
                f32x4 da = __builtin_amdgcn_mfma_f32_16x16x32_bf16(ldfrag(lds + X3M_ONE, LDTB, 0, 0, lane), wf0, (f32x4){0.f, 0.f, 0.f, 0.f}, 0, 0, 0);
                da = __builtin_amdgcn_mfma_f32_16x16x32_bf16(ldfrag(lds + X3M_ONE, LDTB, 0, 32, lane), wf1, da, 0, 0, 0);
                f32x4 qn = __builtin_amdgcn_mfma_f32_16x16x32_bf16(ldfrag(lds + X3M_NB, LDTB, 0, 0, lane), qf0, (f32x4){0.f, 0.f, 0.f, 0.f}, 0, 0, 0);
                qn = __builtin_amdgcn_mfma_f32_16x16x32_bf16(ldfrag(lds + X3M_NB, LDTB, 0, 32, lane), qf1, qn, 0, 0, 0);
                const float inter = sc[128 + l], emr = sc[192 + l];
                const float inv = __builtin_amdgcn_rcpf(fmaxf(fabsf(da[0] + inter * qn[0]), emr));
                const int row = ((const LAS int*)sc)[256 + l];
#pragma unroll
                for (int u = 0; u < 4; ++u) {
                    const int vt = (wid & 1) * 4 + u;
                    f32x4 na = __builtin_amdgcn_mfma_f32_16x16x32_bf16(ldfrag_sw(lds + X3M_VT, vt * 16, 0, lane), wf0, (f32x4){0.f, 0.f, 0.f, 0.f}, 0, 0, 0);
                    na = __builtin_amdgcn_mfma_f32_16x16x32_bf16(ldfrag_sw(lds + X3M_VT, vt * 16, 32, lane), wf1, na, 0, 0, 0);
                    f32x4 ca = __builtin_amdgcn_mfma_f32_16x16x32_bf16(ldfrag(lds + X3M_CB, LDTB, vt * 16, 0, lane), qf0, (f32x4){0.f, 0.f, 0.f, 0.f}, 0, 0, 0);
                    ca = __builtin_amdgcn_mfma_f32_16x16x32_bf16(ldfrag(lds + X3M_CB, LDTB, vt * 16, 32, lane), qf1, ca, 0, 0, 0);
                    u32x2 o; o.x = pk2((na[0] + inter * ca[0]) * inv, (na[1] + inter * ca[1]) * inv); o.y = pk2((na[2] + inter * ca[2]) * inv, (na[3] + inter * ca[3]) * inv);
                    *(u32x2*)(Y + (size_t)row * D + 512 + h * 128 + vt * 16 + 4 * q) = o;
                }
            }
            __syncthreads();
        }
    }
}

constexpr int HC_RAWF = 0;
constexpr int HC_RAWQ = HC_RAWF + 64 * 128 * 4;
constexpr int HC_SUB = HC_RAWQ + 64 * 128 * 2;
constexpr int HL_QD = 136 * 2;
constexpr int HL_T = 24 * 2;
constexpr int HS_QI = 0, HS_KO = HS_QI + 16 * HL_QD, HS_KET = HS_KO + 16 * HL_QD, HS_ATT = HS_KET + 128 * HL_T, HS_VT = HS_ATT + 16 * HL_T, HS_DEC = HS_VT + 32 * HL_T, HS_SIZE = HS_DEC + 512;
constexpr int HC_SB = HC_SUB + 4 * HS_SIZE;
constexpr int HC_ROWS = HC_SB + 2 * 32 * HL_QD, HC_CST = HC_ROWS + 256, HC_END = HC_CST + 1024;
static_assert(HC_END <= LDS_BYTES - 16, "HGRN2 LDS map");
static_assert(HS_SIZE % 16 == 0 && HC_SB % 16 == 0, "alignment");
__device__ __forceinline__ bf16x8 ldfrag16(const LAS char* tile, int ldb, int row0, int lane) {
    bf16x8 v = *(const LAS bf16x8*)(tile + (row0 + (lane & 15)) * ldb + ((lane >> 4) & 1) * 16);
    if (lane >= 32) v = (bf16x8){0, 0, 0, 0, 0, 0, 0, 0};
    return v;
}
__device__ __forceinline__ void scan_hgrn_c(int wv, KP Pk, int layer, int unit, LAS char* lds) {
    asm volatile("" : "+s"(Pk));
    const CAS Params& P = *Pk;
    const int tid = ltid(wv), lane = tid & 63, wid = tid >> 6, q = lane >> 4, r16 = lane & 15, i_ = layer >> 1;
    const int seq = unit >> 2, quarter = unit & 3, b = seq >> 3, h = (seq >> 1) & 3, dir = seq & 1;
    const bf16_t* Pb = (const bf16_t*)(P.ws + WS_P);
    bf16_t* Y = (bf16_t*)(P.ws + (dir ? WS_YB : WS_YF));
    LAS float* cst = (LAS float*)(lds + HC_CST);
    if (tid < 128) cst[tid] = ((const float*)(P.ws + WS_LB))[layer * 512 + h * 128 + tid];
    else if (tid < 256) cst[tid] = P.hg_f_bias[(size_t)(i_ * 2 + dir) * 512 + h * 128 + tid - 128];
    for (int i = tid; i < 2 * 32 * HL_QD / 4; i += NT) ((LAS unsigned*)(lds + HC_SB))[i] = 0u;
    int tj[5], tg_[5], tcol[5]; bool tv[5];
#pragma unroll
    for (int s = 0; s < 5; ++s) {
        const int task = tid + NT * s; tv[s] = task < 64 * 36; tj[s] = task / 36; tg_[s] = task % 36;
        const int g = tg_[s];
        tcol[s] = g < 16 ? (512 + dir * 512 + h * 128 + 8 * g) : g < 32 ? (h * 128 + 8 * (g - 16)) : (1536 + h * 128 + quarter * 32 + 8 * (g - 32));
    }
    u32x4 rc[5]; int rrow = 0;
    auto load = [&](int c) {
#pragma unroll
        for (int s = 0; s < 5; ++s) {
            rc[s] = (u32x4){0u, 0u, 0u, 0u};
            if (tv[s]) { const int row = scan_row(c * 64 + tj[s], b, dir, 1); rc[s] = *(const u32x4*)(Pb + (size_t)row * LDP_ODD + tcol[s]); }
        }
        if (tid < 64) rrow = scan_row(c * 64 + tid, b, dir, 1);
    };
    auto storeA = [&]() {
#pragma unroll
        for (int s = 0; s < 5; ++s) {
            if (tv[s]) {
                float f[8]; unpack8(rc[s], f);
                const int j = tj[s], g = tg_[s];
                if (g < 16) {
                    float o[8];
#pragma unroll
                    for (int e = 0; e < 8; ++e) { const float lbv = cst[8 * g + e]; o[e] = lbv + (1.f - lbv) * sigmoidf_(f[e] + cst[128 + 8 * g + e]); }
                    LAS float* dst = (LAS float*)(lds + HC_RAWF) + j * 128 + 8 * g;
                    *(LAS f32x4*)dst = (f32x4){o[0], o[1], o[2], o[3]}; *(LAS f32x4*)(dst + 4) = (f32x4){o[4], o[5], o[6], o[7]};
                } else if (g < 32) {
                    float o[8];
#pragma unroll
                    for (int e = 0; e < 8; ++e) o[e] = siluf_(f[e]);
                    *(LAS u32x4*)(lds + HC_RAWQ + (j * 128 + 8 * (g - 16)) * 2) = pack8(o);
                } else {
                    const int v0 = 8 * (g - 32);
                    LAS char* vt = lds + HC_SUB + (j >> 4) * HS_SIZE + HS_VT;
#pragma unroll
                    for (int e = 0; e < 8; ++e) { const unsigned wv = rc[s][e >> 1]; *(LAS bf16_t*)(vt + (v0 + e) * HL_T + (j & 15) * 2) = (bf16_t)((e & 1) ? (wv >> 16) : (wv & 0xffffu)); }
                }
            }
        }
        if (tid < 64) ((LAS int*)(lds + HC_ROWS))[tid] = rrow;
    };
    auto storeB = [&]() {
        const int d = tid & 127, sb = tid >> 7;
        LAS char* st = lds + HC_SUB + sb * HS_SIZE;
        const LAS float* rf = (const LAS float*)(lds + HC_RAWF) + (sb * 16) * 128 + d;
        const LAS bf16_t* rq = (const LAS bf16_t*)(lds + HC_RAWQ) + (sb * 16) * 128 + d;
        float lam = 0.f, lams[16], kfs[16];
#pragma unroll
        for (int t = 0; t < 16; ++t) {
            const float f = rf[t * 128];
            lam += __logf(f);
            const float kf = 1.f - f;
            lams[t] = lam; kfs[t] = kf;
            *(LAS bf16_t*)(st + HS_QI + t * HL_QD + d * 2) = f2bf(bf2f(rq[t * 128]) * __expf(lam));
            *(LAS bf16_t*)(st + HS_KO + t * HL_QD + d * 2) = f2bf(kf * __expf(-lam));
        }
        float ke[16];
#pragma unroll
        for (int t = 0; t < 16; ++t) ke[t] = kfs[t] * __expf(lam - lams[t]);
        *(LAS u32x4*)(st + HS_KET + d * HL_T) = pack8(ke); *(LAS u32x4*)(st + HS_KET + d * HL_T + 16) = pack8(ke + 8);
        ((LAS float*)(st + HS_DEC))[d] = __expf(lam);
    };
    f32x4 sacc[2];
    sacc[0] = sacc[1] = (f32x4){0.f, 0.f, 0.f, 0.f};
    __syncthreads();
    load(0);
    for (int c = 0; c < NSTEPS / 64; ++c) {
        storeA();
        __syncthreads();
        storeB();
        if (c + 1 < NSTEPS / 64) load(c + 1);
        __syncthreads();
        if (wid < 4) {
            LAS char* st = lds + HC_SUB + wid * HS_SIZE;
            f32x4 acc = (f32x4){0.f, 0.f, 0.f, 0.f};
#pragma unroll
            for (int k0 = 0; k0 < 128; k0 += 32) acc = __builtin_amdgcn_mfma_f32_16x16x32_bf16(ldfrag(st + HS_KO, HL_QD, 0, k0, lane), ldfrag(st + HS_QI, HL_QD, 0, k0, lane), acc, 0, 0, 0);
#pragma unroll
            for (int j = 0; j < 4; ++j) acc[j] = (4 * q + j <= r16) ? acc[j] : 0.f;
            st4bf(st + HS_ATT + r16 * HL_T + 4 * q * 2, acc);
        }
        __syncthreads();
#pragma unroll 1
        for (int sb = 0; sb < 4; ++sb) {
            LAS char* st = lds + HC_SUB + sb * HS_SIZE;
            const LAS char* sbr = lds + HC_SB + (sb & 1) * 32 * HL_QD;
            LAS char* sbw = lds + HC_SB + ((sb + 1) & 1) * 32 * HL_QD;
            if (wid < 2) {
                f32x4 ya = __builtin_amdgcn_mfma_f32_16x16x32_bf16(ldfrag16(st + HS_VT, HL_T, wid * 16, lane), ldfrag16(st + HS_ATT, HL_T, 0, lane), (f32x4){0.f, 0.f, 0.f, 0.f}, 0, 0, 0);
#pragma unroll
                for (int k0 = 0; k0 < 128; k0 += 32) ya = __builtin_amdgcn_mfma_f32_16x16x32_bf16(ldfrag(sbr, HL_QD, wid * 16, k0, lane), ldfrag(st + HS_QI, HL_QD, 0, k0, lane), ya, 0, 0, 0);
                const int row = ((const LAS int*)(lds + HC_ROWS))[sb * 16 + r16];
                u32x2 o; o.x = pk2(ya[0], ya[1]); o.y = pk2(ya[2], ya[3]);
                *(u32x2*)(Y + (size_t)row * D + h * 128 + quarter * 32 + wid * 16 + 4 * q) = o;
            }
            {
                const int vt = wid >> 2;
                const bf16x8 vf = ldfrag16(st + HS_VT, HL_T, vt * 16, lane);
#pragma unroll
                for (int u = 0; u < 2; ++u) {
                    const int dt = (wid & 3) * 2 + u;
                    const f32x4 a = __builtin_amdgcn_mfma_f32_16x16x32_bf16(ldfrag16(st + HS_KET, HL_T, dt * 16, lane), vf, (f32x4){0.f, 0.f, 0.f, 0.f}, 0, 0, 0);
                    const f32x4 dc = *(const LAS f32x4*)((const LAS float*)(st + HS_DEC) + dt * 16 + 4 * q);
#pragma unroll
                    for (int j = 0; j < 4; ++j) sacc[u][j] = sacc[u][j] * dc[j] + a[j];
                    st4bf(sbw + (vt * 16 + r16) * HL_QD + (dt * 16 + 4 * q) * 2, sacc[u]);
                }
            }
            __syncthreads();
        }
    }
}

constexpr int RC_RAWW = 0;
constexpr int RC_RAWA = RC_RAWW + 64 * 64 * 4;
constexpr int RC_RAWB = RC_RAWA + 64 * 64 * 2, RC_RAWK = RC_RAWB + 64 * 64 * 2, RC_RAWR = RC_RAWK + 64 * 64 * 2;
constexpr int RC_SUB = RC_RAWR + 64 * 64 * 2;
constexpr int RL_C = 72 * 2, RL_32 = 40 * 2, RL_16 = 24 * 2;
constexpr int RS_AT = 0, RS_RT = RS_AT + 16 * RL_C, RS_KT = RS_RT + 16 * RL_C, RS_BT = RS_KT + 16 * RL_C, RS_KBH = RS_BT + 16 * RL_C, RS_AAK = RS_KBH + 64 * RL_32,
              RS_ARKB = RS_AAK + 16 * RL_16, RS_T = RS_ARKB + 16 * RL_32, RS_AABF = RS_T + 16 * RL_16, RS_GL = RS_AABF + 16 * 16 * 4, RS_VU = RS_GL + 256, RS_SIZE = RS_VU + 32 * RL_32;
constexpr int RC_SB = RC_SUB + 4 * RS_SIZE;
constexpr int RC_RHT = RC_SB + 32 * RL_C;
constexpr int RC_ROWS = RC_RHT + 32 * RL_16, RC_END = RC_ROWS + 256;
static_assert(RC_END <= LDS_BYTES - 16, "RWKV LDS map");
static_assert(RS_SIZE % 16 == 0 && RC_SB % 16 == 0 && RC_RHT % 16 == 0, "alignment");

__device__ __forceinline__ float allreduce8(float v) {
    v += dppmov<0xB1>(v); v += dppmov<0x4E>(v); v += dppmov<0x141>(v);
    return v;
}

__device__ __forceinline__ void phase_prep1(int wv, KP Pk, int layer) {
    asm volatile("" : "+s"(Pk));
    const CAS Params& P = *Pk;
    const int tid = ltid(wv), lane = tid & 63, wid = tid >> 6, i_ = layer >> 1;
    const bf16_t* Pb = (const bf16_t*)(P.ws + WS_P);
    bf16_t* R = (bf16_t*)(P.ws + WS_RWR); bf16_t* K = (bf16_t*)(P.ws + WS_RWK); bf16_t* V = (bf16_t*)(P.ws + WS_RWV); bf16_t* KK = (bf16_t*)(P.ws + WS_RWKK);
    bf16_t* LA = (bf16_t*)(P.ws + WS_LA);
    const float* mu = P.rw_mu + (size_t)i_ * 1856;
    float mur[8], muv[8], muk[8], mul_[8], kkw[8];
#pragma unroll
    for (int e = 0; e < 8; ++e) { mur[e] = mu[8 * lane + e]; muv[e] = mu[1024 + 8 * lane + e]; muk[e] = mu[512 + 8 * lane + e]; mul_[e] = lane < 40 ? mu[1536 + 8 * lane + e] : 0.f; kkw[e] = P.rw_k_k[i_ * 512 + 8 * lane + e]; }
    for (int r = blockIdx.x * 8 + wid; r < NROWS; r += gridDim.x * 8) {
        int rprev = -1, rnext = -1;
        if (r < NCTX) { const int t = r & 255; if (t > 0) rprev = r - 1; if (t < CTXL - 1) rnext = r + 1; }
        else {
            const int bs = (r - NCTX) >> 13, s = (r - NCTX) & 8191, sg = ((s & 63) << 7) + (s >> 6);
            if (sg > 0) { const int g2 = sg - 1; rprev = NCTX + bs * SEQ + ((g2 & 127) << 6) + (g2 >> 7); }
            if (sg < SEQ - 1) { const int g2 = sg + 1; rnext = NCTX + bs * SEQ + ((g2 & 127) << 6) + (g2 >> 7); }
        }
        const bf16_t* pc = Pb + (size_t)r * LDP_ODD + 2560;
        const bf16_t* pp = Pb + (size_t)(rprev < 0 ? r : rprev) * LDP_ODD + 2560;
        const bf16_t* pn = Pb + (size_t)(rnext < 0 ? r : rnext) * LDP_ODD + 2560;
        const float mp = rprev < 0 ? 0.f : 0.5f, mn = rnext < 0 ? 0.f : 0.5f;
        auto mix8 = [&](int col, const float* muc, float* o) {
            float fc[8], fp[8], fn[8];
            unpack8(*(const u32x4*)(pc + col), fc); unpack8(*(const u32x4*)(pp + col), fp); unpack8(*(const u32x4*)(pn + col), fn);
#pragma unroll
            for (int e = 0; e < 8; ++e) o[e] = fc[e] + muc[e] * (mp * fp[e] + mn * fn[e] - fc[e]);
        };
        float o[8];
        mix8(8 * lane, mur, o); *(u32x4*)(R + (size_t)r * 512 + 8 * lane) = pack8(o);
        mix8(1024 + 8 * lane, muv, o); *(u32x4*)(V + (size_t)r * 512 + 8 * lane) = pack8(o);
        mix8(512 + 8 * lane, muk, o); *(u32x4*)(K + (size_t)r * 512 + 8 * lane) = pack8(o);
        {
            float kk[8], ss = 0.f;
#pragma unroll
            for (int e = 0; e < 8; ++e) { kk[e] = o[e] * kkw[e]; ss += kk[e] * kk[e]; }
            ss = group_sum<8>(ss);
            const float rn = rsqrtf(fmaxf(ss, 1e-12f));
#pragma unroll
            for (int e = 0; e < 8; ++e) kk[e] *= rn;
            *(u32x4*)(KK + (size_t)r * 512 + 8 * lane) = pack8(kk);
        }
        if (lane < 40) {
            mix8(1536 + 8 * lane, mul_, o);
            if (lane < 16) {
#pragma unroll
                for (int e = 0; e < 8; ++e) o[e] = tanh_fast(o[e]);
            } else if (lane >= 24) {
#pragma unroll
                for (int e = 0; e < 8; ++e) o[e] = sigmoidf_(o[e]);
            }
            *(u32x4*)(LA + (size_t)r * 320 + 8 * lane) = pack8(o);
        }
    }
}

__device__ __forceinline__ void phase_out_even(int wv, KP Pk, int layer) {
    asm volatile("" : "+s"(Pk));
    const CAS Params& P = *Pk;
    const int tid = ltid(wv), lane = tid & 63, wid = tid >> 6, i_ = layer >> 1;
    const bf16_t* Pb = (const bf16_t*)(P.ws + WS_P);
    const bf16_t* Yf = (const bf16_t*)(P.ws + WS_YF); const bf16_t* Yb = (const bf16_t*)(P.ws + WS_YB);
    bf16_t* feat = (bf16_t*)(P.ws + WS_FEAT);
    const int r0 = (layer == DEPTH - 1) ? NCTX : 0;
    const bf16_t* XBC = (const bf16_t*)(P.ws + WS_EXBC);
    float nwa[8], nwb[8];
#pragma unroll
    for (int e = 0; e < 8; ++e) { nwa[e] = P.ssd_norm_w[i_ * 512 + 8 * lane + e]; nwb[e] = P.ml_norm_w[i_ * 512 + 8 * lane + e]; }
    const float dsk = P.ssd_d[i_ * 8 + (lane >> 3)];
    for (int r = r0 + blockIdx.x * 8 + wid; r < NROWS; r += gridDim.x * 8) {
        const bf16_t* pr = Pb + (size_t)r * LDP_EVEN;
        float y[8];
        {
            float a[8], bb[8], xsv[8], z[8];
            unpack8(*(const u32x4*)(Yf + (size_t)r * D + 8 * lane), a); unpack8(*(const u32x4*)(Yb + (size_t)r * D + 8 * lane), bb);
            unpack8(*(const u32x4*)(XBC + (size_t)r * 768 + 8 * lane), xsv); unpack8(*(const u32x4*)(pr + 8 * lane), z);
            float ss = 0.f;
#pragma unroll
            for (int e = 0; e < 8; ++e) {
                y[e] = (a[e] + bb[e] + dsk * xsv[e]) * siluf_(z[e]); ss += y[e] * y[e];
            }
            ss = wave_sum(ss);
            const float rn = rsqrtf(ss * (1.f / 512.f) + 1e-6f);
#pragma unroll
            for (int e = 0; e < 8; ++e) y[e] = y[e] * rn * nwa[e];
            *(u32x4*)(feat + (size_t)r * D + 8 * lane) = pack8(y);
        }
        {
            float a[8], bb[8], o[8];
            unpack8(*(const u32x4*)(Yf + (size_t)r * D + 512 + 8 * lane), a); unpack8(*(const u32x4*)(Yb + (size_t)r * D + 512 + 8 * lane), bb);
            unpack8(*(const u32x4*)(pr + 2320 + 8 * lane), o);
            float s = 0.f;
#pragma unroll
            for (int e = 0; e < 8; ++e) { y[e] = a[e] + bb[e]; s += y[e]; }
            const float mean = group_sum<16>(s) * (1.f / 128.f);
            float ss = 0.f;
#pragma unroll
            for (int e = 0; e < 8; ++e) { y[e] -= mean; ss += y[e] * y[e]; }
            const float rn = rsqrtf(group_sum<16>(ss) * (1.f / 128.f) + 1e-6f);
#pragma unroll
            for (int e = 0; e < 8; ++e) y[e] = sigmoidf_(o[e]) * (y[e] * rn) * nwb[e];
            *(u32x4*)(feat + (size_t)r * D + 512 + 8 * lane) = pack8(y);
        }
    }
}
__device__ __forceinline__ void phase_out_odd(int wv, KP Pk, int layer) {
    asm volatile("" : "+s"(Pk));
    const CAS Params& P = *Pk;
    const int tid = ltid(wv), lane = tid & 63, wid = tid >> 6, i_ = layer >> 1;
    const bf16_t* Pb = (const bf16_t*)(P.ws + WS_P);
    const bf16_t* Yf = (const bf16_t*)(P.ws + WS_YF); const bf16_t* Yb = (const bf16_t*)(P.ws + WS_YB);
    const bf16_t* R = (const bf16_t*)(P.ws + WS_RWR); const bf16_t* K = (const bf16_t*)(P.ws + WS_RWK); const bf16_t* V = (const bf16_t*)(P.ws + WS_RWV); const bf16_t* G = (const bf16_t*)(P.ws + WS_RWG);
    bf16_t* feat = (bf16_t*)(P.ws + WS_FEAT);
    const int r0 = (layer == DEPTH - 1) ? NCTX : 0;
    float nwc[8], rk[8], lw[8], lbv[8];
#pragma unroll
    for (int e = 0; e < 8; ++e) {
        nwc[e] = P.hg_norm_w[i_ * 512 + 8 * lane + e]; rk[e] = P.rw_r_k[i_ * 512 + 8 * lane + e];
        lw[e] = P.rw_ln_w[i_ * 512 + 8 * lane + e]; lbv[e] = P.rw_ln_b[i_ * 512 + 8 * lane + e];
    }
    for (int r = r0 + blockIdx.x * 8 + wid; r < NROWS; r += gridDim.x * 8) {
        float y[8];
        {
            float a[8], bb[8], g[8];
            unpack8(*(const u32x4*)(Yf + (size_t)r * D + 8 * lane), a); unpack8(*(const u32x4*)(Yb + (size_t)r * D + 8 * lane), bb);
            unpack8(*(const u32x4*)(Pb + (size_t)r * LDP_ODD + 2048 + 8 * lane), g);
            float ss = 0.f;
#pragma unroll
            for (int e = 0; e < 8; ++e) { y[e] = a[e] + bb[e]; ss += y[e] * y[e]; }
            const float rn = rsqrtf(group_sum<16>(ss) * (1.f / 128.f) + 1e-6f);
#pragma unroll
            for (int e = 0; e < 8; ++e) y[e] = y[e] * rn * nwc[e] * siluf_(g[e]);
            *(u32x4*)(feat + (size_t)r * D + 8 * lane) = pack8(y);
        }
        {
            float a[8], bb[8], rr[8], kk[8], vv[8], g[8];
            unpack8(*(const u32x4*)(Yf + (size_t)r * D + 512 + 8 * lane), a); unpack8(*(const u32x4*)(Yb + (size_t)r * D + 512 + 8 * lane), bb);
            unpack8(*(const u32x4*)(R + (size_t)r * 512 + 8 * lane), rr); unpack8(*(const u32x4*)(K + (size_t)r * 512 + 8 * lane), kk);
            unpack8(*(const u32x4*)(V + (size_t)r * 512 + 8 * lane), vv); unpack8(*(const u32x4*)(G + (size_t)r * 512 + 8 * lane), g);
            float s = 0.f, bs = 0.f;
#pragma unroll
            for (int e = 0; e < 8; ++e) { y[e] = a[e] + bb[e]; s += y[e]; bs += rr[e] * kk[e] * rk[e]; }
            const float mean = group_sum<8>(s) * (1.f / 64.f); bs = group_sum<8>(bs);
            float ss = 0.f;
#pragma unroll
            for (int e = 0; e < 8; ++e) { y[e] -= mean; ss += y[e] * y[e]; }
            const float rn = rsqrtf(group_sum<8>(ss) * (1.f / 64.f) + 64e-5f);
#pragma unroll
            for (int e = 0; e < 8; ++e) y[e] = (y[e] * rn * lw[e] + lbv[e] + bs * vv[e]) * g[e];
            *(u32x4*)(feat + (size_t)r * D + 512 + 8 * lane) = pack8(y);
        }
    }
}

#ifndef MK_DOUBLE
#define MK_DOUBLE 0
#endif
#define REP(bit, body) do { body; if (MK_DOUBLE & (bit)) { body; } } while (0)
__device__ __forceinline__ void phase_expconv(int wv, KP Pk, int layer, LAS char* lds) {
    asm volatile("" : "+s"(Pk));
    const CAS Params& P = *Pk;
    const int tid = ltid(wv), lane = tid & 63, wid = tid >> 6;
    {
        LAS float* scr = (LAS float*)(lds + wid * 8448);
        const int gw = blockIdx.x * 8 + wid, NGW = gridDim.x * 8;
        bf16_t* gu = (bf16_t*)(P.ws + WS_EXPGU); bf16_t* dw = (bf16_t*)(P.ws + WS_EXPD);
        constexpr int IG = 16 * 16, IDN = 8 * 32;
        for (int it = gw; it < NEXP * (2 * IG + IDN); it += NGW) {
            const int e = it / (2 * IG + IDN); int r = it % (2 * IG + IDN);
            const size_t eo = (size_t)(layer * NEXP + e);
            if (r < IG) { transpose_item(P.exp_w_gate + eo * D * DEXP, D, DEXP, gu + (size_t)e * 1024 * 1024, 1, scr, r, lane); continue; } r -= IG;
            if (r < IG) { transpose_item(P.exp_w_up + eo * D * DEXP, D, DEXP, gu + (size_t)e * 1024 * 1024, 2, scr, r, lane); continue; } r -= IG;
            transpose_item(P.exp_w_down + eo * DEXP * D, DEXP, D, dw + (size_t)e * 1024 * 512, 0, scr, r, lane);
        }
    }
}
constexpr int L1_AST = 1028;
constexpr int L1_PST = 33;
constexpr int L1_A = 0, L1_PART = L1_A + 16 * L1_AST * 4, L1_SM = L1_PART + 8 * 16 * L1_PST * 4, L1_END = L1_SM + (64 + 2 * 144 + 32) * 4;
static_assert(L1_END <= LDS_BYTES - 16, "LN1 LDS map");
__device__ __forceinline__ void phase_ln1(int wv, KP Pk, int layer, LAS char* lds, bool dry = false) {
    asm volatile("" : "+s"(Pk));
    const CAS Params& P = *Pk;
    const int tid = ltid(wv), lane = tid & 63;
    if (!dry) REP(8, phase_expconv(wv, Pk, layer, lds));
    __syncthreads();
    LAS float* At = (LAS float*)(lds + L1_A);
    LAS float* part = (LAS float*)(lds + L1_PART);
    LAS int* lcnt = (LAS int*)(lds + L1_SM);
    LAS int* lbase = lcnt + 32;
    LAS int* asg = lcnt + 64;
    LAS float* rbias = (LAS float*)(asg + 2 * 144);
    if (tid < 32) { lcnt[tid] = 0; rbias[tid] = P.router_bias[tid]; }
    float breg[8][4][2];
    {
        const float* rw = P.router_w + (size_t)(128 * wv + 4 * (lane >> 4)) * NEXP + (lane & 15);
#pragma unroll
        for (int j = 0; j < 8; ++j)
#pragma unroll
            for (int i = 0; i < 4; ++i) { breg[j][i][0] = rw[(16 * j + i) * NEXP]; breg[j][i][1] = rw[(16 * j + i) * NEXP + 16]; }
    }
    __syncthreads();
    const bf16_t* yo = (const bf16_t*)(P.ws + WS_YO);
    bf16_t* act = (bf16_t*)(P.ws + (dry ? WS_FEAT : WS_ACT));
    bf16_t* xcb = (bf16_t*)(P.ws + WS_XC); bf16_t* xob = (bf16_t*)P.out;
    const bool lastl = (layer == DEPTH - 1);
    int* cnt = (int*)(P.ws + WS_CNT) + layer * 32 * CNT_STRIDE;
    int* list = (int*)(P.ws + WS_LIST);
    float* wts = (float*)(P.ws + WS_WTS);
    const float* lg = P.ln_g + (size_t)(layer * 2 + 0) * D; const float* lb = P.ln_b + (size_t)(layer * 2 + 0) * D;
    const int r0 = (layer == DEPTH - 1) ? NCTX : 0, ntiles = (NROWS - r0) / 16, G = gridDim.x;
    f32x4 g1v[4], s2c[4], h2c[4];
#pragma unroll
    for (int i = 0; i < 4; ++i) g1v[i] = s2c[i] = h2c[i] = (f32x4){0.f, 0.f, 0.f, 0.f};
    int mcur = -1;
    f32x4 nx[2][4]; u32x2 nyo[2][4];
    auto fetch = [&](int s, int rr) {
        if (layer == 0) {
            const float* xq = rr < NCTX ? P.ctx + (size_t)rr * D : P.x + (size_t)(rr - NCTX) * D;
#pragma unroll
            for (int i = 0; i < 4; ++i) nx[s][i] = *(const f32x4*)(xq + 4 * lane + 256 * i);
        } else {
            const bf16_t* xq = rr < NCTX ? xcb + (size_t)rr * D : xob + (size_t)(rr - NCTX) * D;
#pragma unroll
            for (int i = 0; i < 4; ++i) { const u32x2 t = *(const u32x2*)(xq + 4 * lane + 256 * i); nx[s][i] = (f32x4){__uint_as_float(t.x), __uint_as_float(t.y), 0.f, 0.f}; }
        }
#pragma unroll
        for (int i = 0; i < 4; ++i) { const int c = 4 * lane + 256 * i; nyo[s][i] = *(const u32x2*)(yo + (size_t)rr * D + c); }
    };
    int tile = blockIdx.x;
    if (tile < ntiles) { fetch(0, r0 + tile * 16 + 2 * wv); fetch(1, r0 + tile * 16 + 2 * wv + 1); }
    for (int it = 0; tile < ntiles; ++it, tile += G) {
        const int rb = r0 + tile * 16 + 2 * wv;
        const int m = row_mod(rb);
        if (m != mcur) {
            mcur = m;
            const float* g1 = modvec(P.ws, layer, m, 2); const float* sh2 = modvec(P.ws, layer, m, 3); const float* sc2 = modvec(P.ws, layer, m, 4);
#pragma unroll
            for (int i = 0; i < 4; ++i) { const int c = 4 * lane + 256 * i; g1v[i] = *(const f32x4*)(g1 + c); s2c[i] = *(const f32x4*)(sc2 + c); h2c[i] = *(const f32x4*)(sh2 + c); }
        }
#pragma unroll
        for (int s = 0; s < 2; ++s) {
            const int r = rb + s;
            bf16_t* xr = dry ? (bf16_t*)(P.ws + WS_YF) + (size_t)r * D : lastl ? (bf16_t*)(P.ws + WS_FEAT) + (size_t)r * D : r < NCTX ? xcb + (size_t)r * D : xob + (size_t)(r - NCTX) * D;
            f32x4 v[4]; float sm = 0.f;
#pragma unroll
            for (int i = 0; i < 4; ++i) {
                f32x4 xv = nx[s][i]; const f32x4 gv = g1v[i]; const u32x2 yv = nyo[s][i];
                if (layer != 0) { const unsigned b0 = __float_as_uint(xv[0]), b1 = __float_as_uint(xv[1]); xv = (f32x4){bflo(b0), bfhi(b0), bflo(b1), bfhi(b1)}; }
                v[i][0] = ALPHA * xv[0] + gv[0] * bflo(yv.x); v[i][1] = ALPHA * xv[1] + gv[1] * bfhi(yv.x);
                v[i][2] = ALPHA * xv[2] + gv[2] * bflo(yv.y); v[i][3] = ALPHA * xv[3] + gv[3] * bfhi(yv.y);
                sm += (v[i][0] + v[i][1]) + (v[i][2] + v[i][3]);
            }
            if (tile + G < ntiles) fetch(s, r + G * 16);
            const float mean = wave_sum(sm) * (1.f / D);
            float s2 = 0.f;
#pragma unroll
            for (int i = 0; i < 4; ++i) { v[i] = v[i] - mean; s2 += (v[i][0] * v[i][0] + v[i][1] * v[i][1]) + (v[i][2] * v[i][2] + v[i][3] * v[i][3]); }
            const float rstd = rsqrtf(wave_sum(s2) * (1.f / D) + 1e-5f);
            LAS float* arow = At + (2 * wv + s) * L1_AST;
#pragma unroll
            for (int i = 0; i < 4; ++i) {
                const int c = 4 * lane + 256 * i;
                const f32x4 gg = *(const f32x4*)(lg + c), bb = *(const f32x4*)(lb + c), s2v = s2c[i], h2v = h2c[i];
                f32x4 xn, hv;
#pragma unroll
                for (int j = 0; j < 4; ++j) { xn[j] = v[i][j] * rstd * gg[j] + bb[j]; hv[j] = xn[j] * (1.f + s2v[j]) + h2v[j]; }
                { u32x2 ox; ox.x = pk2(xn[0], xn[1]); ox.y = pk2(xn[2], xn[3]); *(u32x2*)(xr + c) = ox; }
                u32x2 o; o.x = pk2(hv[0], hv[1]); o.y = pk2(hv[2], hv[3]); *(u32x2*)(act + (size_t)r * D + c) = o;
                *(LAS f32x4*)(arow + c) = hv;
            }
        }
        __syncthreads();
        {
            f32x4 ra0 = (f32x4){0.f, 0.f, 0.f, 0.f}, ra1 = ra0;
            const LAS float* ap = At + (lane & 15) * L1_AST + 128 * wv + 4 * (lane >> 4);
#pragma unroll
            for (int j = 0; j < 8; ++j) {
                const f32x4 a4 = *(const LAS f32x4*)(ap + 16 * j);
#pragma unroll
                for (int i = 0; i < 4; ++i) {
                    ra0 = __builtin_amdgcn_mfma_f32_16x16x4f32(a4[i], breg[j][i][0], ra0, 0, 0, 0);
                    ra1 = __builtin_amdgcn_mfma_f32_16x16x4f32(a4[i], breg[j][i][1], ra1, 0, 0, 0);
                }
            }
            LAS float* pw = part + wv * 16 * L1_PST + (4 * (lane >> 4)) * L1_PST + (lane & 15);
#pragma unroll
            for (int j = 0; j < 4; ++j) { pw[j * L1_PST] = ra0[j]; pw[j * L1_PST + 16] = ra1[j]; }
        }
        __syncthreads();
        {
            const int half = lane >> 5, e = lane & 31;
            const LAS float* pp = part + (2 * wv + half) * L1_PST + e;
            float sc_ = 0.f;
#pragma unroll
            for (int k = 0; k < 8; ++k) sc_ += pp[k * 16 * L1_PST];
            const float sg = sigmoidf_(sc_), vb = sg + rbias[e];
            float bv[4], sv[4];
            bv[0] = dppmov<0x00>(vb); bv[1] = dppmov<0x55>(vb); bv[2] = dppmov<0xAA>(vb); bv[3] = dppmov<0xFF>(vb);
            sv[0] = dppmov<0x00>(sg); sv[1] = dppmov<0x55>(sg); sv[2] = dppmov<0xAA>(sg); sv[3] = dppmov<0xFF>(sg);
            float m1 = -1e30f, m2 = -1e30f;
#pragma unroll
            for (int k = 0; k < 4; ++k) { const float vsc = bv[k]; if (vsc > m1) { m2 = m1; m1 = vsc; } else if (vsc > m2) m2 = vsc; }
            float best = m1 + m2; int bg = e >> 2;
#pragma unroll
            for (int msk = 4; msk <= 16; msk <<= 1) {
                const float ob = __shfl_xor(best, msk); const int og = __shfl_xor(bg, msk);
                const bool take = (ob > best) || (ob == best && og < bg);
                best = take ? ob : best; bg = take ? og : bg;
            }
            int i1 = 0; float b1 = bv[0];
#pragma unroll
            for (int k = 1; k < 4; ++k) if (bv[k] > b1) { b1 = bv[k]; i1 = k; }
            int i2 = -1; float b2 = -1e30f;
#pragma unroll
            for (int k = 0; k < 4; ++k) if (k != i1 && bv[k] > b2) { b2 = bv[k]; i2 = k; }
            float s1 = sv[0], s2s = sv[0];
#pragma unroll
            for (int k = 1; k < 4; ++k) { if (i1 == k) s1 = sv[k]; if (i2 == k) s2s = sv[k]; }
            if (e == 4 * bg && !dry) {
                const int r = rb + half;
                const int e0 = bg * 4 + i1, e1 = bg * 4 + i2;
                const float inv = 1.f / (s1 + s2s);
                const int li = it * 16 + 2 * wv + half;
                const int p0 = __hip_atomic_fetch_add(&lcnt[e0], 1, __ATOMIC_RELAXED, __HIP_MEMORY_SCOPE_WORKGROUP);
                const int p1 = __hip_atomic_fetch_add(&lcnt[e1], 1, __ATOMIC_RELAXED, __HIP_MEMORY_SCOPE_WORKGROUP);
                asg[2 * li] = (e0 << 16) | p0; asg[2 * li + 1] = (e1 << 16) | p1;
                wts[2 * r] = s1 * inv; wts[2 * r + 1] = s2s * inv;
            }
        }
    }
    __syncthreads();
    if (dry) return;
    if (tid < 32) lbase[tid] = atomicAdd(&cnt[tid * CNT_STRIDE], lcnt[tid]);
    __syncthreads();
    for (int idx = tid; idx < 2 * 144; idx += NT) {
        const int li = idx >> 1, k = idx & 1, t = (li >> 4) * G + blockIdx.x;
        if (t < ntiles) { const int r = r0 + t * 16 + (li & 15); const int v = asg[idx], e = v >> 16, lp = v & 0xffff; list[(size_t)e * LISTCAP + lbase[e] + lp] = 2 * r + k; }
    }
}

__device__ __forceinline__ void phase_ln2(int wv, KP Pk, int layer, bool dry = false) {
    asm volatile("" : "+s"(Pk));
    const CAS Params& P = *Pk;
    const int tid = ltid(wv), lane = tid & 63, wid = tid >> 6;
    const bf16_t* yp = (const bf16_t*)(P.ws + WS_YP);
    const float* wts = (const float*)(P.ws + WS_WTS);
    bf16_t* act = (bf16_t*)(P.ws + (dry ? WS_FEAT : WS_ACT));
    bf16_t* xcb = (bf16_t*)(P.ws + WS_XC); bf16_t* xob = (bf16_t*)P.out;
    const float* lg = P.ln_g + (size_t)(layer * 2 + 1) * D; const float* lb = P.ln_b + (size_t)(layer * 2 + 1) * D;
    const bool last = (layer == DEPTH - 1);
    const int r0 = last ? NCTX : 0, stride = gridDim.x * 8;
    f32x4 cg[4], cb[4], g2v[4], s1v[4], h1v[4];
#pragma unroll
    for (int i = 0; i < 4; ++i) { cg[i] = *(const f32x4*)(lg + 4 * lane + 256 * i); cb[i] = *(const f32x4*)(lb + 4 * lane + 256 * i); g2v[i] = s1v[i] = h1v[i] = (f32x4){0.f, 0.f, 0.f, 0.f}; }
    int mcur = -1;
    u32x2 nx[4]; u32x2 ny0[4], ny1[4]; float nw0 = 0.f, nw1 = 0.f;
    auto fetch = [&](int r) {
        const bf16_t* xr = last ? (const bf16_t*)(P.ws + WS_FEAT) + (size_t)r * D : r < NCTX ? xcb + (size_t)r * D : xob + (size_t)(r - NCTX) * D;
#pragma unroll
        for (int i = 0; i < 4; ++i) {
            const int c = 4 * lane + 256 * i;
            nx[i] = *(const u32x2*)(xr + c); ny0[i] = *(const u32x2*)(yp + (size_t)(2 * r) * D + c); ny1[i] = *(const u32x2*)(yp + (size_t)(2 * r + 1) * D + c);
        }
        nw0 = wts[2 * r]; nw1 = wts[2 * r + 1];
    };
    int r = r0 + blockIdx.x * 8 + wid;
    if (r < NROWS) fetch(r);
    for (; r < NROWS; r += stride) {
        const int m = row_mod(r);
        if (m != mcur) {
            mcur = m;
            const float* g2 = modvec(P.ws, layer, m, 5); const float* sh1 = last ? lg : modvec(P.ws, layer + 1, m, 0); const float* sc1 = last ? lg : modvec(P.ws, layer + 1, m, 1);
#pragma unroll
            for (int i = 0; i < 4; ++i) { const int c = 4 * lane + 256 * i; g2v[i] = *(const f32x4*)(g2 + c); s1v[i] = *(const f32x4*)(sc1 + c); h1v[i] = *(const f32x4*)(sh1 + c); }
        }
        f32x4 v[4]; float s = 0.f;
        const float w0 = nw0, w1 = nw1;
#pragma unroll
        for (int i = 0; i < 4; ++i) {
            const f32x4 xv = (f32x4){bflo(nx[i].x), bfhi(nx[i].x), bflo(nx[i].y), bfhi(nx[i].y)}, gv = g2v[i]; const u32x2 y0 = ny0[i], y1 = ny1[i];
            v[i][0] = ALPHA * xv[0] + gv[0] * (w0 * bflo(y0.x) + w1 * bflo(y1.x)); v[i][1] = ALPHA * xv[1] + gv[1] * (w0 * bfhi(y0.x) + w1 * bfhi(y1.x));
            v[i][2] = ALPHA * xv[2] + gv[2] * (w0 * bflo(y0.y) + w1 * bflo(y1.y)); v[i][3] = ALPHA * xv[3] + gv[3] * (w0 * bfhi(y0.y) + w1 * bfhi(y1.y));
            s += (v[i][0] + v[i][1]) + (v[i][2] + v[i][3]);
        }
        if (r + stride < NROWS) fetch(r + stride);
        const float mean = wave_sum(s) * (1.f / D);
        float s2 = 0.f;
#pragma unroll
        for (int i = 0; i < 4; ++i) { v[i] = v[i] - mean; s2 += (v[i][0] * v[i][0] + v[i][1] * v[i][1]) + (v[i][2] * v[i][2] + v[i][3] * v[i][3]); }
        const float rstd = rsqrtf(wave_sum(s2) * (1.f / D) + 1e-5f);
#pragma unroll
        for (int i = 0; i < 4; ++i) {
            const int c = 4 * lane + 256 * i;
            f32x4 xn;
#pragma unroll
            for (int j = 0; j < 4; ++j) xn[j] = v[i][j] * rstd * cg[i][j] + cb[i][j];
            if (dry) *(f32x4*)((float*)(P.ws + WS_YF) + (size_t)r * D + c) = xn;
            else if (last) *(f32x4*)(P.out + (size_t)(r - NCTX) * D + c) = xn;
            else { u32x2 ox; ox.x = pk2(xn[0], xn[1]); ox.y = pk2(xn[2], xn[3]); *(u32x2*)((r < NCTX ? xcb + (size_t)r * D : xob + (size_t)(r - NCTX) * D) + c) = ox; }
            if (!last) {
                u32x2 o; o.x = pk2(xn[0] * (1.f + s1v[i][0]) + h1v[i][0], xn[1] * (1.f + s1v[i][1]) + h1v[i][1]); o.y = pk2(xn[2] * (1.f + s1v[i][2]) + h1v[i][2], xn[3] * (1.f + s1v[i][3]) + h1v[i][3]);
                *(u32x2*)(act + (size_t)r * D + c) = o;
            }
        }
    }
}

constexpr int NPHASE = 2 + 11 * DEPTH;
__global__ void __launch_bounds__(NT, 2) fwd_kernel(Params P) {
    extern __shared__ __attribute__((aligned(16))) char lds_raw[];
    LAS char* lds = (LAS char*)lds_raw;
    volatile LAS unsigned* xbw = (volatile LAS unsigned*)(lds + LDS_BYTES - 16);
    KP Pk = (KP)__builtin_amdgcn_kernarg_segment_ptr();
    const int wv = __builtin_amdgcn_readfirstlane((int)(threadIdx.x >> 6));
    const bool multi = (P.ph_hi - P.ph_lo) > 1;
    XcdBarrier bar; bar.bar = (unsigned*)(P.ws + WS_BAR); bar.x = 0; bar.st = xbw;
    if (multi) {
        if (ltid(wv) == 0) { xbw[0] = 0u; xbw[1] = 0u; xbw[2] = 0u; xbw[3] = 0u; }
        __syncthreads();
        bar = xcd_barrier_post(wv, (unsigned*)(P.ws + WS_BAR), xbw);
    }
#define PHASE(id, body) do { if (P.ph_lo <= (id) && (id) < P.ph_hi) { body; if ((id) + 1 < P.ph_hi) xcd_barrier(wv, bar); if (MK_DOUBLE & 2048) xcd_barrier(wv, bar); } } while (0)
    PHASE(0, REP(16, phase_prologue0(wv, Pk, lds)));
    PHASE(1, REP(16, phase_prologue1(wv, Pk)));
    for (int l = 0; l < DEPTH; ++l) {
        const int pb = 2 + 11 * l, odd = l & 1;
        PHASE(pb + 0, REP(1, phase_inproj(wv, Pk, l, lds)));
        if (odd) {
            PHASE(pb + 1, REP(4, phase_prep1(wv, Pk, l)));
            PHASE(pb + 2, phase_prep2(wv, Pk, l, lds));
            PHASE(pb + 3, REP(32, { if (blockIdx.x < 128) REP(64, scan_hgrn_c(wv, Pk, l, blockIdx.x, lds)); else if (blockIdx.x < 256) REP(128, scan_rwkv(wv, Pk, l, blockIdx.x - 128, lds)); }));
            PHASE(pb + 5, REP(4, phase_out_odd(wv, Pk, l)));
        } else {
            PHASE(pb + 1, REP(4, phase_prep_even(wv, Pk, l)));
            PHASE(pb + 2, REP(2, phase_ex1(wv, Pk, l, lds)));
            PHASE(pb + 3, phase_ex2(wv, Pk, l));
            PHASE(pb + 4, REP(2, phase_ex3(wv, Pk, l, lds)));
            PHASE(pb + 5, REP(4, phase_out_even(wv, Pk, l)));
        }
        PHASE(pb + 6, REP(256, phase_outproj(wv, Pk, l, lds)));
        PHASE(pb + 7, { if (MK_DOUBLE & 4096) phase_ln1(wv, Pk, l, lds, true); phase_ln1(wv, Pk, l, lds); });
        PHASE(pb + 8, REP(512, phase_moe1(wv, Pk, l, lds)));
        PHASE(pb + 9, REP(1024, phase_moe2(wv, Pk, l, lds)));
        PHASE(pb + 10, { if (MK_DOUBLE & 8192) phase_ln2(wv, Pk, l, true); phase_ln2(wv, Pk, l); });
    }
#undef PHASE
}


#ifndef MK_STOP
#define MK_STOP NPHASE
#endif
#ifndef MK_DUMP
#define MK_DUMP 0
#endif
#ifndef MK_DUMP_N
#define MK_DUMP_N (1u << 30)
#endif
#ifndef MK_DUMP_LD
#define MK_DUMP_LD 1024
#endif
#ifndef MK_DUMP_C0
#define MK_DUMP_C0 0
#endif
__global__ void diff_kernel(const bf16_t* a, const bf16_t* b, float* out, size_t n) {
    for (size_t i = (size_t)blockIdx.x * blockDim.x + threadIdx.x; i < n; i += (size_t)gridDim.x * blockDim.x) out[i] = 1e6f * (bf2f(a[i]) - bf2f(b[i]));
}
__global__ void dump_kernel(const bf16_t* src, float* out, size_t n) {
    for (size_t i = (size_t)blockIdx.x * blockDim.x + threadIdx.x; i < n; i += (size_t)gridDim.x * blockDim.x) out[i] = i < (size_t)MK_DUMP_N ? bf2f(src[(i >> 10) * MK_DUMP_LD + MK_DUMP_C0 + (i & 1023)]) : 0.f;
}
extern "C" void kernel_launch(void* const* d_in, const int* in_sizes, int n_in, void* d_out, int out_size, void* d_ws, size_t ws_size, hipStream_t stream) {
    static int ready = 0;
    if (ready == 0) {
        ready = 1;
        if (n_in != 42 || out_size != NB * SEQ * D || ws_size < WS_END) { fprintf(stderr, "kernel_launch: unexpected shapes (n_in %d out %d ws %zu need %zu)\n", n_in, out_size, ws_size, (size_t)WS_END); ready = -1; }
        if (hipFuncSetAttribute((const void*)fwd_kernel, hipFuncAttributeMaxDynamicSharedMemorySize, LDS_BYTES) != hipSuccess) { fprintf(stderr, "kernel_launch: hipFuncSetAttribute failed\n"); ready = -1; }
    }
    if (ready < 0) return;
    (void)in_sizes;
    hipMemsetAsync((char*)d_ws + WS_BAR, 0, WS_ZERO_BYTES, stream);
    Params p;
    memset(&p, 0, sizeof(p));
    const float** fp = (const float**)&p;
    for (int i = 0; i < 42; ++i) fp[i] = (const float*)d_in[i];
    p.out = (float*)d_out; p.ws = (unsigned char*)d_ws;
#if MK_PER_PHASE
    for (int ph = 0; ph < MK_STOP; ++ph) {
        const int local = ph < 2 ? -1 : (ph - 2) % 11, layer = ph < 2 ? 0 : (ph - 2) / 11;
        if (local == 4 && (layer & 1)) continue;
        p.ph_lo = ph; p.ph_hi = ph + 1;
        hipLaunchKernelGGL(fwd_kernel, dim3(256), dim3(NT), LDS_BYTES, stream, p);
    }
#ifdef MK_DIFF
    p.ph_lo = 7; p.ph_hi = 8; p.dbg = 1;
    hipLaunchKernelGGL(fwd_kernel, dim3(256), dim3(NT), LDS_BYTES, stream, p);
    hipLaunchKernelGGL(diff_kernel, dim3(1024), dim3(256), 0, stream, (const bf16_t*)((unsigned char*)d_ws + WS_YO), (const bf16_t*)((unsigned char*)d_ws + WS_HID), (float*)d_out, (size_t)NB * SEQ * D);
#else
    if (MK_DUMP) hipLaunchKernelGGL(dump_kernel, dim3(1024), dim3(256), 0, stream, (const bf16_t*)((unsigned char*)d_ws + (size_t)MK_DUMP), (float*)d_out, (size_t)NB * SEQ * D);
#endif
#else
    p.ph_lo = 0; p.ph_hi = NPHASE;
    hipLaunchKernelGGL(fwd_kernel, dim3(256), dim3(NT), LDS_BYTES, stream, p);
#endif
}
```

```cpp
#include <hip/hip_runtime.h>
#include <stdint.h>
#include <stdio.h>
#include <string.h>

#ifndef MK_PER_PHASE
#define MK_PER_PHASE 0
#endif

typedef unsigned short bf16_t;
typedef short bf16x8 __attribute__((ext_vector_type(8)));
typedef float f32x4 __attribute__((ext_vector_type(4)));
typedef unsigned u32x4 __attribute__((ext_vector_type(4)));
typedef unsigned u32x2 __attribute__((ext_vector_type(2)));
#define LAS __attribute__((address_space(3)))
#define CAS __attribute__((address_space(4)))

constexpr int D = 1024, NB = 4, SEQ = 8192, CTXL = 256, DEPTH = 4;
constexpr int NCTX = NB * CTXL;
constexpr int NROWS = NCTX + NB * SEQ;
constexpr int P_EVEN = 2848, P_ODD = 4416, LDP_EVEN = 3072, LDP_ODD = 4608;
constexpr int NEXP = 32, DEXP = 512, LISTCAP = NROWS;
constexpr float ALPHA = 1.681792830507429f;
constexpr int NT = 512;
constexpr int TCH = 32;
constexpr int NSTEPS = CTXL + SEQ;
constexpr int LDS_BYTES = 160 * 1024;

constexpr size_t al256(size_t x) { return (x + 255) & ~(size_t)255; }
constexpr size_t WS_BAR = 0;
constexpr size_t WS_CNT = 16384;
constexpr int CNT_STRIDE = 64;
constexpr size_t WS_ZERO_BYTES = 16384 + (size_t)4 * 32 * CNT_STRIDE * 4;
constexpr size_t WS_MODV = al256(WS_ZERO_BYTES);
constexpr size_t WS_LB = WS_MODV + al256((size_t)4 * 5 * 6144 * 4);
constexpr size_t WS_XC = WS_LB + al256(4 * 512 * 4);
constexpr size_t WS_WTS = WS_XC + (size_t)NCTX * D * 4;
constexpr size_t WS_LIST = WS_WTS + al256((size_t)2 * NROWS * 4);
constexpr size_t WS_WINT = WS_LIST + al256((size_t)NEXP * LISTCAP * 4);
constexpr size_t WINT_L0 = 0, WINT_L1 = (size_t)LDP_EVEN * D, WINT_L2 = WINT_L1 + (size_t)LDP_ODD * D, WINT_L3 = WINT_L2 + (size_t)LDP_EVEN * D, WINT_END = WINT_L3 + (size_t)LDP_ODD * D;
constexpr size_t WS_WOUTT = WS_WINT + WINT_END * 2;
constexpr size_t WS_LORAT = WS_WOUTT + (size_t)4 * D * D * 2;
constexpr size_t LORA_PER = (size_t)512 * 320;
constexpr size_t WS_EXPGU = WS_LORAT + al256(2 * LORA_PER * 2);
constexpr size_t WS_EXPD = WS_EXPGU + (size_t)NEXP * 1024 * 1024 * 2;
constexpr size_t WS_ACT = WS_EXPD + (size_t)NEXP * 1024 * 512 * 2;
constexpr size_t ROWB = (size_t)NROWS * D * 2;
constexpr size_t WS_FEAT = WS_ACT + ROWB;
constexpr size_t WS_YF = WS_FEAT + ROWB;
constexpr size_t WS_YB = WS_YF + ROWB;
constexpr size_t WS_P = WS_YB + ROWB;
constexpr size_t P_BYTES = (size_t)NROWS * LDP_ODD * 2;
constexpr size_t WS_YO = WS_P;
constexpr size_t WS_HID = WS_P + ROWB;
constexpr size_t WS_YP = WS_HID + ROWB;
static_assert(WS_YP + 2 * ROWB <= WS_P + P_BYTES, "MoE buffers must fit in the P region");
constexpr size_t HALFB = (size_t)NROWS * 512 * 2;
constexpr size_t WS_RWR = WS_P + P_BYTES;
constexpr size_t WS_RWK = WS_RWR + HALFB;
constexpr size_t WS_RWV = WS_RWK + HALFB;
constexpr size_t WS_RWKK = WS_RWV + HALFB;
constexpr size_t WS_RWB = WS_RWKK + HALFB;
constexpr size_t WS_RWG = WS_RWB + HALFB;
constexpr size_t WS_RWDEC = WS_RWG + HALFB;
constexpr size_t WS_LA = WS_RWDEC + (size_t)2 * NROWS * 512 * 4;
constexpr size_t WS_END = WS_LA + (size_t)NROWS * 320 * 2;
static_assert(WS_END <= (size_t)280602384 * 4, "workspace map exceeds the guaranteed ws_size");

struct Params {
    const float *x, *c, *ctx, *c_ctx, *mod_w, *mod_b, *ln_g, *ln_b;
    const float *ev_w_in, *ev_w_out, *ssd_conv_w, *ssd_conv_b, *ssd_dt_bias, *ssd_a_log, *ssd_d, *ssd_norm_w;
    const float *ml_conv_w, *ml_conv_b, *ml_i_bias, *ml_f_bias, *ml_norm_w;
    const float *od_w_in, *od_w_out, *hg_lb_logits, *hg_f_bias, *hg_norm_w;
    const float *rw_mu, *rw_w0, *rw_w2, *rw_a0, *rw_a2, *rw_g2, *rw_k_k, *rw_k_a, *rw_r_k, *rw_ln_w, *rw_ln_b;
    const float *router_w, *router_bias, *exp_w_gate, *exp_w_up, *exp_w_down;
    float* out;
    unsigned char* ws;
    int ph_lo, ph_hi, dbg, pad_;
};
typedef const CAS Params* KP;

__device__ __forceinline__ int ltid(int wv) { int l; asm volatile("v_mbcnt_lo_u32_b32 %0, -1, 0\n\tv_mbcnt_hi_u32_b32 %0, -1, %0" : "=v"(l)); return wv * 64 + l; }
__device__ __forceinline__ float bf2f(bf16_t h) { return __uint_as_float(((unsigned)h) << 16); }
__device__ __forceinline__ float bflo(unsigned u) { return __uint_as_float(u << 16); }
__device__ __forceinline__ float bfhi(unsigned u) { return __uint_as_float(u & 0xffff0000u); }
typedef __bf16 bf16v2_t __attribute__((ext_vector_type(2)));
typedef float f32x2 __attribute__((ext_vector_type(2)));
__device__ __forceinline__ unsigned pk2(float lo, float hi) { const f32x2 v = {lo, hi}; return __builtin_bit_cast(unsigned, __builtin_convertvector(v, bf16v2_t)); }
__device__ __forceinline__ bf16_t f2bf(float f) { return (bf16_t)(pk2(f, 0.f) & 0xffffu); }
__device__ __forceinline__ void unpack8(const u32x4& u, float* f) {
    f[0] = bflo(u.x); f[1] = bfhi(u.x); f[2] = bflo(u.y); f[3] = bfhi(u.y); f[4] = bflo(u.z); f[5] = bfhi(u.z); f[6] = bflo(u.w); f[7] = bfhi(u.w);
}
__device__ __forceinline__ u32x4 pack8(const float* f) { u32x4 u; u.x = pk2(f[0], f[1]); u.y = pk2(f[2], f[3]); u.z = pk2(f[4], f[5]); u.w = pk2(f[6], f[7]); return u; }
__device__ __forceinline__ float sigmoidf_(float x) { return __builtin_amdgcn_rcpf(1.f + __expf(-x)); }
__device__ __forceinline__ float siluf_(float x) { return x * __builtin_amdgcn_rcpf(1.f + __expf(-x)); }
__device__ __forceinline__ float softplus_fast(float x) { return x > 20.f ? x : __logf(1.f + __expf(x)); }
__device__ __forceinline__ float tanh_fast(float x) { return 1.f - 2.f * __builtin_amdgcn_rcpf(1.f + __expf(2.f * x)); }
__device__ __forceinline__ float softplusf_(float x) { return x > 20.f ? x : __logf(1.f + __expf(x)); }
__device__ __forceinline__ float logsigmoidf_(float x) { return fminf(x, 0.f) - __logf(1.f + __expf(-fabsf(x))); }
template <int CTRL> __device__ __forceinline__ float dppmov(float v) {
    return __builtin_bit_cast(float, __builtin_amdgcn_update_dpp(0, __builtin_bit_cast(int, v), CTRL, 0xf, 0xf, true));
}
__device__ __forceinline__ float allreduce16(float v) {
    v += dppmov<0xB1>(v);
    v += dppmov<0x4E>(v);
    v += dppmov<0x141>(v);
    v += dppmov<0x140>(v);
    return v;
}
__device__ __forceinline__ float allreduce8_(float v) { v += dppmov<0xB1>(v); v += dppmov<0x4E>(v); v += dppmov<0x141>(v); return v; }
__device__ __forceinline__ float wave_sum(float v) {
    v = allreduce16(v);
    const float r0 = __builtin_bit_cast(float, __builtin_amdgcn_readlane(__builtin_bit_cast(int, v), 0)), r1 = __builtin_bit_cast(float, __builtin_amdgcn_readlane(__builtin_bit_cast(int, v), 16));
    const float r2 = __builtin_bit_cast(float, __builtin_amdgcn_readlane(__builtin_bit_cast(int, v), 32)), r3 = __builtin_bit_cast(float, __builtin_amdgcn_readlane(__builtin_bit_cast(int, v), 48));
    return (r0 + r1) + (r2 + r3);
}
template <int W> __device__ __forceinline__ float group_sum(float v) {
    if (W == 8) return allreduce8_(v);
    return allreduce16(v);
}

#define XB_TMO      128
#define XB_XCNT(j)  (256  + 64 * (j))
#define XB_XSUB(j)  (1280 + 64 * (j))
#define XB_XGEN(j)  (2304 + 64 * (j))
#define XB_TOP      3328
#define XB_TOPGEN   3392
#define XCD_BAR_WORDS 3456
#define XB_SPIN_CAP (1u << 22)
__device__ __forceinline__ unsigned xb_ld(unsigned* p)              { return __hip_atomic_load(p, __ATOMIC_RELAXED, __HIP_MEMORY_SCOPE_AGENT); }
__device__ __forceinline__ unsigned xb_add(unsigned* p, unsigned v) { return __hip_atomic_fetch_add(p, v, __ATOMIC_RELAXED, __HIP_MEMORY_SCOPE_AGENT); }
__device__ __forceinline__ unsigned xb_xcc_id() { return (unsigned)__builtin_amdgcn_s_getreg((3 << 11) | 20) & 0xFu; }
#define XB_SPIN(cond, bar) do { unsigned _sp = 0; while (cond) { __builtin_amdgcn_s_sleep(1); \
    if ((++_sp & 255u) == 0u) { if (xb_ld(&(bar)[XB_TMO])) break; if (_sp > XB_SPIN_CAP) { atomicAdd(&(bar)[XB_TMO], 1u); break; } } } } while (0)
struct XcdBarrier { unsigned* bar; unsigned x; volatile LAS unsigned* st; };
__device__ __forceinline__ XcdBarrier xcd_barrier_post(int wv, unsigned* bar, volatile LAS unsigned* st) {
    XcdBarrier b; b.bar = bar; b.x = xb_xcc_id(); b.st = st;
    if (ltid(wv) == 0) (void)xb_add(&bar[XB_XCNT(b.x)], 1u);
    return b;
}
__device__ __forceinline__ void xcd_barrier_complete(unsigned* bar, unsigned x, unsigned& nloc, unsigned& nx) {
    const unsigned G = gridDim.x * gridDim.y * gridDim.z;
    unsigned sum, cnt, mine, sp = 0u;
    for (;;) {
        sum = 0u; cnt = 0u; mine = 0u;
#pragma unroll
        for (unsigned j = 0; j < 16; ++j) { const unsigned c = xb_ld(&bar[XB_XCNT(j)]); sum += c; cnt += (c > 0u) ? 1u : 0u; mine = (j == x) ? c : mine; }
        if (sum == G) break;
        __builtin_amdgcn_s_sleep(1);
        if ((++sp & 255u) == 0u) { if (xb_ld(&bar[XB_TMO])) break; if (sp > XB_SPIN_CAP) { atomicAdd(&bar[XB_TMO], 1u); break; } }
    }
    nloc = mine > 0u ? mine : 1u; nx = cnt > 0u ? cnt : 1u;
}
__device__ __forceinline__ void xcd_barrier(int wv, const XcdBarrier& b) {
    asm volatile("s_waitcnt vmcnt(0)" ::: "memory");
    __syncthreads();
    if (ltid(wv) == 0) {
        unsigned* bar = b.bar;
        asm volatile("" : "+s"(bar));
        __builtin_amdgcn_s_waitcnt(0);
        unsigned nloc = b.st[0], nx = b.st[1];
        if (nloc == 0u) { xcd_barrier_complete(bar, b.x, nloc, nx); b.st[0] = nloc; b.st[1] = nx; }
        const unsigned old = xb_add(&bar[XB_XSUB(b.x)], 1u);
        const unsigned gen = old / nloc;
        if (old + 1u == (gen + 1u) * nloc) {
            __builtin_amdgcn_fence(__ATOMIC_RELEASE, "agent");
            asm volatile("s_waitcnt vmcnt(0)" ::: "memory");
            const unsigned og = xb_add(&bar[XB_TOP], 1u);
            const unsigned tg = og / nx;
            if (og + 1u == (tg + 1u) * nx) xb_add(&bar[XB_TOPGEN], 1u);
            else XB_SPIN(xb_ld(&bar[XB_TOPGEN]) == tg, bar);
            __builtin_amdgcn_fence(__ATOMIC_ACQUIRE, "agent");
            xb_add(&bar[XB_XGEN(b.x)], 1u);
            asm volatile("s_waitcnt vmcnt(0)" ::: "memory");
        } else {
            XB_SPIN(xb_ld(&bar[XB_XGEN(b.x)]) == gen, bar);
            __builtin_amdgcn_fence(__ATOMIC_ACQUIRE, "agent");
            asm volatile("s_waitcnt vmcnt(0)" ::: "memory");
        }
    }
    __syncthreads();
}

__device__ __forceinline__ int row_mod(int r) { return r < NCTX ? 4 : ((r - NCTX) >> 13); }
__device__ __forceinline__ void row_seg(int r, int& t, int& len) { if (r < NCTX) { t = r & 255; len = CTXL; } else { t = (r - NCTX) & 8191; len = SEQ; } }
__device__ __forceinline__ int scan_row(int tg, int b, int dir, int odd) {
    if (tg < CTXL) { const int t = dir ? (CTXL - 1 - tg) : tg; return b * CTXL + t; }
    int sg = tg - CTXL; if (dir) sg = SEQ - 1 - sg;
    const int s = odd ? (((sg & 127) << 6) + (sg >> 7)) : sg;
    return NCTX + b * SEQ + s;
}
__device__ __forceinline__ const float* modvec(const unsigned char* ws, int layer, int m, int which) {
    return (const float*)(ws + WS_MODV) + ((size_t)(layer * 5 + m) * 6 + which) * D;
}

constexpr int G_BM = 256, G_BN = 128, G_BK = 64;
constexpr int G_ABYTES = G_BM * G_BK * 2, G_BBYTES = G_BN * G_BK * 2, G_BUF = G_ABYTES + G_BBYTES;
__device__ __forceinline__ int swz(int o) { return o ^ (((o >> 9) & 1) << 5); }

template <class RowSrc, class Epi>
__device__ __forceinline__ void gemm_tile(int wv, const bf16_t* __restrict__ A, int lda, const RowSrc& rs, const bf16_t* __restrict__ Bt, int ldb, int n0, int K, const Epi& epi, LAS char* lds) {
    const int tid = ltid(wv), lane = tid & 63, wid = tid >> 6, wm = wid >> 1, wn = wid & 1;
    const bf16_t* ap[4]; int aoff[4];
#pragma unroll
    for (int i = 0; i < 4; ++i) {
        const int c = tid + NT * i, row = c >> 3, kc = c & 7;
        ap[i] = A + (size_t)rs.src(row) * lda + kc * 8;
        aoff[i] = ((row >> 4) * 2 + (kc >> 2)) * 1024 + swz((row & 15) * 64 + (kc & 3) * 16);
    }
    const bf16_t* bp[2]; int boff[2];
#pragma unroll
    for (int i = 0; i < 2; ++i) {
        const int c = tid + NT * i, row = c >> 3, kc = c & 7;
        bp[i] = Bt + (size_t)(n0 + row) * ldb + kc * 8;
        boff[i] = G_ABYTES + ((row >> 4) * 2 + (kc >> 2)) * 1024 + swz((row & 15) * 64 + (kc & 3) * 16);
    }
    f32x4 acc[4][4];
#pragma unroll
    for (int i = 0; i < 4; ++i)
#pragma unroll
        for (int j = 0; j < 4; ++j) acc[i][j] = (f32x4){0.f, 0.f, 0.f, 0.f};
    u32x4 ra[2][4], rb[2][2];
    const int KT = K / G_BK;
    const int fragoff = swz((lane & 15) * 64 + (lane >> 4) * 16);
#define G_LOAD(set, kt_) do { _Pragma("unroll") for (int i = 0; i < 4; ++i) ra[set][i] = *(const u32x4*)(ap[i] + (kt_) * G_BK); \
                              _Pragma("unroll") for (int i = 0; i < 2; ++i) rb[set][i] = *(const u32x4*)(bp[i] + (kt_) * G_BK); } while (0)
#define G_STORE(set, buf) do { _Pragma("unroll") for (int i = 0; i < 4; ++i) *(LAS u32x4*)((buf) + aoff[i]) = ra[set][i]; \
                               _Pragma("unroll") for (int i = 0; i < 2; ++i) *(LAS u32x4*)((buf) + boff[i]) = rb[set][i]; } while (0)
#define G_COMPUTE(cur) do { bf16x8 af[2][4], bfr[2][4]; \
        _Pragma("unroll") for (int ks = 0; ks < 2; ++ks) { \
            _Pragma("unroll") for (int ni = 0; ni < 4; ++ni) bfr[ks][ni] = *(LAS bf16x8*)((cur) + G_ABYTES + ((wn * 4 + ni) * 2 + ks) * 1024 + fragoff); \
            _Pragma("unroll") for (int mi = 0; mi < 4; ++mi) af[ks][mi] = *(LAS bf16x8*)((cur) + ((wm * 4 + mi) * 2 + ks) * 1024 + fragoff); } \
        __builtin_amdgcn_sched_barrier(0); \
        _Pragma("unroll") for (int ks = 0; ks < 2; ++ks) _Pragma("unroll") for (int mi = 0; mi < 4; ++mi) _Pragma("unroll") for (int ni = 0; ni < 4; ++ni) \
            acc[mi][ni] = __builtin_amdgcn_mfma_f32_16x16x32_bf16(bfr[ks][ni], af[ks][mi], acc[mi][ni], 0, 0, 0); \
        __builtin_amdgcn_sched_barrier(0); } while (0)
    G_LOAD(0, 0);
    G_STORE(0, lds);
    if (KT > 1) G_LOAD(0, 1);
    if (KT > 2) G_LOAD(1, 2);
    __syncthreads();
    for (int kt = 0; kt < KT; kt += 2) {
        G_COMPUTE(lds);
        if (kt + 1 < KT) G_STORE(0, lds + G_BUF);
        if (kt + 3 < KT) G_LOAD(0, kt + 3);
        __syncthreads();
        if (kt + 1 < KT) {
            G_COMPUTE(lds + G_BUF);
            if (kt + 2 < KT) G_STORE(1, lds);
            if (kt + 4 < KT) G_LOAD(1, kt + 4);
            __syncthreads();
        }
    }
#undef G_LOAD
#undef G_STORE
#undef G_COMPUTE
    epi(acc, wm * 64 + (lane & 15), wn * 64 + 4 * (lane >> 4));
}

constexpr int G2_BN = 256, G2_BBYTES = G2_BN * G_BK * 2, G2_BUF = G_ABYTES + G2_BBYTES;

struct RowLinear { int m0; __device__ __forceinline__ int src(int r) const { return m0 + r; } };
struct RowList {
    const int* list; int cnt; int shift;
    __device__ __forceinline__ int src(int r) const { const int a = list[r < cnt ? r : 0]; return a >> shift; }
};
struct EpiStoreBf16 {
    bf16_t* C; int ldc; int m0; int n0; int N;
    template <int NI> __device__ __forceinline__ void operator()(const f32x4 (&acc)[4][NI], int rbase, int cbase) const {
#pragma unroll
        for (int mi = 0; mi < 4; ++mi) {
            bf16_t* rowp = C + (size_t)(m0 + rbase + mi * 16) * ldc + n0 + cbase;
#pragma unroll
            for (int ni = 0; ni < NI; ++ni) {
                if (n0 + cbase + ni * 16 < N) { u32x2 v; v.x = pk2(acc[mi][ni][0], acc[mi][ni][1]); v.y = pk2(acc[mi][ni][2], acc[mi][ni][3]); *(u32x2*)(rowp + ni * 16) = v; }
            }
        }
    }
};
struct EpiSwiGLU {
    bf16_t* H; const int* list; int cnt; int n0;
    template <int NI> __device__ __forceinline__ void operator()(const f32x4 (&acc)[4][NI], int rbase, int cbase) const {
#pragma unroll
        for (int mi = 0; mi < 4; ++mi) {
            const int r = rbase + mi * 16;
            if (r < cnt) {
                const int a = list[r];
                const int wnb = cbase & ~63, q4 = cbase & 63;
                bf16_t* rowp = H + (size_t)a * DEXP + ((n0 + wnb) >> 1) + q4;
#pragma unroll
                for (int q = 0; q < NI / 2; ++q) {
                    float o[4];
#pragma unroll
                    for (int j = 0; j < 4; ++j) o[j] = siluf_(acc[mi][2 * q][j]) * acc[mi][2 * q + 1][j];
                    u32x2 v; v.x = pk2(o[0], o[1]); v.y = pk2(o[2], o[3]); *(u32x2*)(rowp + q * 16) = v;
                }
            }
        }
    }
};
struct EpiScatterBf16 {
    bf16_t* C; const int* list; int cnt; int n0;
    template <int NI> __device__ __forceinline__ void operator()(const f32x4 (&acc)[4][NI], int rbase, int cbase) const {
#pragma unroll
        for (int mi = 0; mi < 4; ++mi) {
            const int r = rbase + mi * 16;
            if (r < cnt) {
                bf16_t* rowp = C + (size_t)list[r] * D + n0 + cbase;
#pragma unroll
                for (int ni = 0; ni < NI; ++ni) { u32x2 v; v.x = pk2(acc[mi][ni][0], acc[mi][ni][1]); v.y = pk2(acc[mi][ni][2], acc[mi][ni][3]); *(u32x2*)(rowp + ni * 16) = v; }
            }
        }
    }
};
struct EpiDecay {
    float* Dc; const float* w0; int m0; int n0;
    template <int NI> __device__ __forceinline__ void operator()(const f32x4 (&acc)[4][NI], int rbase, int cbase) const {
#pragma unroll
        for (int ni = 0; ni < NI; ++ni) {
            const int col = n0 + cbase + ni * 16;
            const f32x4 w0v = *(const f32x4*)(w0 + col);
#pragma unroll
            for (int mi = 0; mi < 4; ++mi) {
                f32x4 o;
#pragma unroll
                for (int j = 0; j < 4; ++j) { const float w = w0v[j] + acc[mi][ni][j]; o[j] = __expf(-__expf(-softplus_fast(-w) - 0.5f)); }
                *(f32x4*)(Dc + (size_t)(m0 + rbase + mi * 16) * 512 + col) = o;
            }
        }
    }
};
struct EpiAK {
    bf16_t* Kb; const bf16_t* KKb; bf16_t* Bb; const float* a0; const float* k_a; int m0; int n0;
    template <int NI> __device__ __forceinline__ void operator()(const f32x4 (&acc)[4][NI], int rbase, int cbase) const {
#pragma unroll
        for (int ni = 0; ni < NI; ++ni) {
            const int col = n0 + cbase + ni * 16;
            const f32x4 a0v = *(const f32x4*)(a0 + col), kav = *(const f32x4*)(k_a + col);
#pragma unroll
            for (int mi = 0; mi < 4; ++mi) {
                const size_t off = (size_t)(m0 + rbase + mi * 16) * 512 + col;
                const u32x2 kr = *(const u32x2*)(Kb + off), kkr = *(const u32x2*)(KKb + off);
                const float kf[4] = {bflo(kr.x), bfhi(kr.x), bflo(kr.y), bfhi(kr.y)}, kkf[4] = {bflo(kkr.x), bfhi(kkr.x), bflo(kkr.y), bfhi(kkr.y)};
                float k2[4], bb[4];
#pragma unroll
                for (int j = 0; j < 4; ++j) { const float a = sigmoidf_(a0v[j] + acc[mi][ni][j]); k2[j] = kf[j] * (1.f + (a - 1.f) * kav[j]); bb[j] = kkf[j] * a; }
                u32x2 v; v.x = pk2(k2[0], k2[1]); v.y = pk2(k2[2], k2[3]); *(u32x2*)(Kb + off) = v;
                v.x = pk2(bb[0], bb[1]); v.y = pk2(bb[2], bb[3]); *(u32x2*)(Bb + off) = v;
            }
        }
    }
};

namespace pg8 {
#define PG8_LAS __attribute__((address_space(3)))
constexpr int BM = 256, BK = 64, HALF = 128, HTB = HALF * BK * 2, STAGE_BYTES = 8 * HTB, NXCD = 8, WGM = 8;
__host__ __device__ __forceinline__ int lds_byte(int r, int c) { const int st = (r >> 4) * 2 + (c >> 5), rr = r & 15, cc = c & 31, ob = rr * 64 + cc * 2; return st * 1024 + (ob ^ (((ob >> 9) & 1) << 5)); }
__host__ __device__ __forceinline__ void stage_rc(int b, int& R, int& C) { const int st = b / 1024, sb = b % 1024, swz = sb ^ (((sb >> 9) & 1) << 5); R = (st >> 1) * 16 + swz / 64; C = (st & 1) * 32 + (swz % 64) / 2; }
__host__ __device__ __forceinline__ int perm32(int rho) { const int n = rho >> 4, i = rho & 15; return 8 * (i >> 2) + 4 * n + (i & 3); }
struct Unit { int pm, pn; };
struct Gemm { const bf16_t* A; const bf16_t* Bt; int M, N, K; };
struct StaticOrder {
    int nM, nN, nwg, G, c;
    __host__ __device__ void init(int M, int N, int G_, int c_) { nM = M / BM; nN = N / BM; nwg = nM * nN; G = G_; c = c_; }
    __host__ __device__ bool next(int i, Unit& u) const {
        const long L = (long)i * G + c; if (L >= nwg) return false;
        int wgid = (int)L; { const int q = nwg / NXCD, r = nwg % NXCD, xcd = wgid % NXCD, off = wgid / NXCD; wgid = (xcd < r ? xcd * (q + 1) : r * (q + 1) + (xcd - r) * q) + off; }
        const int nig = WGM * nN, gid = wgid / nig, fm = gid * WGM, gsz = (nM - fm) < WGM ? (nM - fm) : WGM;
        u.pm = fm + ((wgid % nig) % gsz); u.pn = (wgid % nig) / gsz; return true;
    }
    __device__ __forceinline__ void a_ready(const Unit&) const {}
    __device__ __forceinline__ void done(const Unit&) const {}
};
struct EpiStoreP {
    static constexpr bool PERM = true, AFTER_DRAIN = false;
    bf16_t* O; int ldc;
    __device__ __forceinline__ void operator()(const f32x4 (&acc)[2][2][4][2], const Unit& u, int wr, int wc, int fr, int fq) const {
        const int row0 = u.pm * BM + wr * 64 + fr, col0 = u.pn * BM + wc * 32 + 8 * fq;
#pragma unroll
        for (int ai = 0; ai < 2; ++ai)
#pragma unroll
            for (int m = 0; m < 4; ++m) { bf16_t* rowp = O + (size_t)(row0 + ai * HALF + m * 16) * ldc + col0;
#pragma unroll
                for (int bj = 0; bj < 2; ++bj) { const f32x4 v0 = acc[ai][bj][m][0], v1 = acc[ai][bj][m][1];
                    u32x4 w; w.x = pk2(v0[0], v0[1]); w.y = pk2(v0[2], v0[3]); w.z = pk2(v1[0], v1[1]); w.w = pk2(v1[2], v1[3]);
                    *(u32x4*)(rowp + bj * HALF) = w; } }
    }
};
template <class Epi, class Sched>
__device__ __forceinline__ void gemm_phase(int wv, PG8_LAS unsigned char* lds, const Gemm g, const Sched& S, const Epi& E) {
    const int tid = ltid(wv), wid = __builtin_amdgcn_readfirstlane(tid >> 6), lane = tid & 63, wr = wid >> 2, wc = wid & 3, fr = lane & 15, fq = lane >> 4;
    const int K = g.K, nt = K / BK;
    unsigned voffA[2], voffB[2];
#pragma unroll
    for (int i = 0; i < 2; ++i) { int R, C; stage_rc(tid * 16 + i * 8192, R, C); const int Rb = Epi::PERM ? ((R & ~31) + perm32(R & 31)) : R;
        voffA[i] = (unsigned)(R * K + C) * 2u; voffB[i] = (unsigned)(Rb * K + C) * 2u; }
    const size_t kstep = (size_t)(BK * 2);
    const size_t hstep = (size_t)HALF * K * 2;
    const size_t tstep = 2 * hstep;
    const unsigned ldsw = (unsigned)wid * 1024u;
    const int aoff = lds_byte(wr * 64 + fr, fq * 8), boff = lds_byte(wc * 32 + fr, fq * 8);
#define PG8_SA(b, h) (((b) * 2 + (h)) * HTB)
#define PG8_SB(b, h) ((4 + (b) * 2 + (h)) * HTB)
#define PG8_STAGE(bufoff, gbase, voff) do { _Pragma("unroll") for (int _i = 0; _i < 2; ++_i) \
        __builtin_amdgcn_global_load_lds((const unsigned*)((const char*)(gbase) + (voff)[_i]), (PG8_LAS unsigned*)(lds + (bufoff) + ldsw + _i * 8192), 16, 0, 0); } while (0)
#define PG8_LDA(dst, b, h) do { _Pragma("unroll") for (int m = 0; m < 4; ++m) _Pragma("unroll") for (int k = 0; k < 2; ++k) dst[m][k] = *(const PG8_LAS bf16x8*)(lds + PG8_SA(b, h) + aoff + m * 2048 + k * 1024); } while (0)
#define PG8_LDB(dst, b, h) do { _Pragma("unroll") for (int n = 0; n < 2; ++n) _Pragma("unroll") for (int k = 0; k < 2; ++k) dst[n][k] = *(const PG8_LAS bf16x8*)(lds + PG8_SB(b, h) + boff + n * 2048 + k * 1024); } while (0)
#define PG8_MMA(ai, bj, At, Bt) do { __builtin_amdgcn_s_setprio(1); _Pragma("unroll") for (int m = 0; m < 4; ++m) _Pragma("unroll") for (int n = 0; n < 2; ++n) _Pragma("unroll") for (int k = 0; k < 2; ++k) \
        acc[ai][bj][m][n] = __builtin_amdgcn_mfma_f32_16x16x32_bf16(Bt[n][k], At[m][k], acc[ai][bj][m][n], 0, 0, 0); __builtin_amdgcn_s_setprio(0); } while (0)
#define PG8_WAIT_V(n) asm volatile("s_waitcnt vmcnt(" #n ")" ::: "memory")
#define PG8_WAIT_L(n) asm volatile("s_waitcnt lgkmcnt(" #n ")" ::: "memory")
#define PG8_BAR __builtin_amdgcn_s_barrier()
#define PG8_SCHED __builtin_amdgcn_sched_barrier(0)
    Unit cur, nxt; int ui = 0;
    if (!S.next(0, cur)) return;
    f32x4 acc[2][2][4][2];
#pragma unroll
    for (int a = 0; a < 2; ++a)
#pragma unroll
        for (int b = 0; b < 2; ++b)
#pragma unroll
            for (int m = 0; m < 4; ++m)
#pragma unroll
                for (int n = 0; n < 2; ++n) acc[a][b][m][n] = (f32x4){0.f, 0.f, 0.f, 0.f};
    bf16x8 At[4][2], B0[2][2], B1[2][2];
    const char* cA = (const char*)g.A + (size_t)cur.pm * tstep; const char* cB = (const char*)g.Bt + (size_t)cur.pn * tstep;
    S.a_ready(cur);
    PG8_STAGE(PG8_SB(0, 0), cB, voffB); PG8_STAGE(PG8_SA(0, 0), cA, voffA); PG8_STAGE(PG8_SB(0, 1), cB + hstep, voffB); PG8_STAGE(PG8_SA(0, 1), cA + hstep, voffA);
    if (wr == 1) PG8_BAR;
    PG8_WAIT_V(4); PG8_BAR;
    PG8_STAGE(PG8_SB(1, 0), cB + kstep, voffB); PG8_STAGE(PG8_SA(1, 0), cA + kstep, voffA); PG8_STAGE(PG8_SB(1, 1), cB + hstep + kstep, voffB);
    PG8_WAIT_V(6); PG8_BAR;
    for (;;) {
        const bool has_next = S.next(ui + 1, nxt);
        const char* nA = has_next ? (const char*)g.A + (size_t)nxt.pm * tstep : cA; const char* nB = has_next ? (const char*)g.Bt + (size_t)nxt.pn * tstep : cB;
        for (int t = 0; t < nt; t += 2) {
            const bool last = (t == nt - 2);
            const char* a1 = cA + (size_t)(t + 1) * kstep;
            const char* a2 = last ? nA : cA + (size_t)(t + 2) * kstep; const char* b2 = last ? nB : cB + (size_t)(t + 2) * kstep;
            const char* a3 = a2 + kstep; const char* b3 = b2 + kstep;
            if (last && has_next) S.a_ready(nxt);
            PG8_LDB(B0, 0, 0); PG8_SCHED; PG8_LDA(At, 0, 0); PG8_STAGE(PG8_SA(1, 1), a1 + hstep, voffA);
            PG8_WAIT_L(8); PG8_BAR; PG8_WAIT_L(0); PG8_MMA(0, 0, At, B0); PG8_BAR; PG8_SCHED;
            PG8_LDB(B1, 0, 1); PG8_STAGE(PG8_SB(0, 0), b2, voffB);
            PG8_BAR; PG8_WAIT_L(0); PG8_MMA(0, 1, At, B1); PG8_BAR;
            PG8_LDA(At, 0, 1); PG8_STAGE(PG8_SA(0, 0), a2, voffA);
            PG8_BAR; PG8_WAIT_L(0); PG8_MMA(1, 0, At, B0); PG8_BAR; PG8_SCHED;
            PG8_STAGE(PG8_SB(0, 1), b2 + hstep, voffB);
            PG8_WAIT_V(6); PG8_BAR; PG8_MMA(1, 1, At, B1); PG8_BAR;
            PG8_LDB(B0, 1, 0); PG8_SCHED; PG8_LDA(At, 1, 0); PG8_STAGE(PG8_SA(0, 1), a2 + hstep, voffA);
            PG8_WAIT_L(8); PG8_BAR; PG8_WAIT_L(0); PG8_MMA(0, 0, At, B0); PG8_BAR; PG8_SCHED;
            PG8_LDB(B1, 1, 1); PG8_STAGE(PG8_SB(1, 0), b3, voffB);
            PG8_BAR; PG8_WAIT_L(0); PG8_MMA(0, 1, At, B1); PG8_BAR;
            PG8_LDA(At, 1, 1); PG8_STAGE(PG8_SA(1, 0), a3, voffA);
            PG8_BAR; PG8_WAIT_L(0); PG8_MMA(1, 0, At, B0); PG8_BAR; PG8_SCHED;
            PG8_STAGE(PG8_SB(1, 1), b3 + hstep, voffB);
            PG8_WAIT_V(6); PG8_BAR; PG8_MMA(1, 1, At, B1); PG8_BAR;
        }
            if constexpr (!Epi::AFTER_DRAIN) { E(acc, cur, wr, wc, fr, fq); S.done(cur); }
            if (!has_next) break;
#pragma unroll
        for (int a = 0; a < 2; ++a)
#pragma unroll
            for (int b = 0; b < 2; ++b)
#pragma unroll
                for (int m = 0; m < 4; ++m)
#pragma unroll
                    for (int n = 0; n < 2; ++n) acc[a][b][m][n] = (f32x4){0.f, 0.f, 0.f, 0.f};
        cur = nxt; cA = nA; cB = nB; ++ui;
    }
    PG8_WAIT_V(0);
    if (wr == 0) PG8_BAR;
    PG8_BAR;
    if constexpr (Epi::AFTER_DRAIN) { E.fused(acc, cur, wr, wc, fr, fq, lds, wid, lane); S.done(cur); }
#undef PG8_SA
#undef PG8_SB
#undef PG8_STAGE
#undef PG8_LDA
#undef PG8_LDB
#undef PG8_MMA
#undef PG8_WAIT_V
#undef PG8_WAIT_L
#undef PG8_BAR
#undef PG8_SCHED
}
struct UnitG { int pm, pn; const char* bbase; const PG8_LAS int* ltab; int cnt; int e; };
struct MoeOrder {
    const PG8_LAS int* tstart; const PG8_LAS int* tcnt; const PG8_LAS int* ltabs; const int* lists; const char* bt; size_t estride; int ncol, shift, G, c;
    __device__ __forceinline__ bool next(int i, UnitG& u) const {
        const int t = i * G + c; if (t >= tstart[32] * ncol) return false;
        const int tm = t / ncol; int e = 0;
#pragma unroll 1
        while (tstart[e + 1] <= tm) ++e;
        e = __builtin_amdgcn_readfirstlane(e);
        const int ts = __builtin_amdgcn_readfirstlane(tstart[e]), tc = __builtin_amdgcn_readfirstlane(tcnt[e]);
        u.pm = tm - ts; u.pn = t - tm * ncol; u.bbase = bt + (size_t)e * estride; u.e = e; u.cnt = tc - u.pm * BM; u.ltab = ltabs + i * BM;
        return true;
    }
    __device__ __forceinline__ void a_ready(const UnitG&) const {}
    __device__ __forceinline__ void done(const UnitG&) const {}
};
struct EpiSwiGLUG {
    static constexpr bool PERM = false, AFTER_DRAIN = false;
    bf16_t* H;
    __device__ __forceinline__ void operator()(const f32x4 (&acc)[2][2][4][2], const UnitG& u, int wr, int wc, int fr, int fq) const {
#pragma unroll
        for (int ai = 0; ai < 2; ++ai)
#pragma unroll
            for (int m = 0; m < 4; ++m) { const int r = ai * HALF + wr * 64 + m * 16 + fr;
                if (r < u.cnt) { bf16_t* rowp = H + (size_t)u.ltab[r] * DEXP + ((u.pn * BM + wc * 32) >> 1) + 4 * fq;
#pragma unroll
                    for (int bj = 0; bj < 2; ++bj) { const f32x4 gt = acc[ai][bj][m][0], up = acc[ai][bj][m][1];
                        u32x2 w; w.x = pk2(siluf_(gt[0]) * up[0], siluf_(gt[1]) * up[1]); w.y = pk2(siluf_(gt[2]) * up[2], siluf_(gt[3]) * up[3]);
                        *(u32x2*)(rowp + bj * (HALF / 2)) = w; } } }
    }
};
struct EpiScatterG {
    static constexpr bool PERM = true, AFTER_DRAIN = false;
    bf16_t* O;
    __device__ __forceinline__ void operator()(const f32x4 (&acc)[2][2][4][2], const UnitG& u, int wr, int wc, int fr, int fq) const {
#pragma unroll
        for (int ai = 0; ai < 2; ++ai)
#pragma unroll
            for (int m = 0; m < 4; ++m) { const int r = ai * HALF + wr * 64 + m * 16 + fr;
                if (r < u.cnt) { bf16_t* rowp = O + (size_t)u.ltab[r] * D + u.pn * BM + wc * 32 + 8 * fq;
#pragma unroll
                    for (int bj = 0; bj < 2; ++bj) { const f32x4 v0 = acc[ai][bj][m][0], v1 = acc[ai][bj][m][1];
                        u32x4 w; w.x = pk2(v0[0], v0[1]); w.y = pk2(v0[2], v0[3]); w.z = pk2(v1[0], v1[1]); w.w = pk2(v1[2], v1[3]);
                        *(u32x4*)(rowp + bj * HALF) = w; } } }
    }
};
template <class Epi, class Sched>
__device__ __forceinline__ void gemm_phase_g(int wv, PG8_LAS unsigned char* lds, const Gemm g, const Sched& S, const Epi& E) {
    const int tid = ltid(wv), wid = __builtin_amdgcn_readfirstlane(tid >> 6), lane = tid & 63, wr = wid >> 2, wc = wid & 3, fr = lane & 15, fq = lane >> 4;
    const int K = g.K, nt = K / BK;
    unsigned voffB[2];
#pragma unroll
    for (int i = 0; i < 2; ++i) { int R, C; stage_rc(tid * 16 + i * 8192, R, C); const int Rb = Epi::PERM ? ((R & ~31) + perm32(R & 31)) : R;
        voffB[i] = (unsigned)(Rb * K + C) * 2u; }
    const unsigned rowb = (unsigned)K * 2u;
#define PG8_AOFFS(u, dst) do { const int _t = ltid(wv); _Pragma("unroll") for (int _i = 0; _i < 2; ++_i) { int _R, _C; stage_rc(_t * 16 + _i * 8192, _R, _C); \
        _Pragma("unroll") for (int _h = 0; _h < 2; ++_h) dst[_h][_i] = (unsigned)((u).ltab[_h * HALF + _R] >> S.shift) * rowb + (unsigned)(_C * 2); } } while (0)
#define PG8_STAGE_A(bufoff, AO, koff) do { _Pragma("unroll") for (int _i = 0; _i < 2; ++_i) \
        __builtin_amdgcn_global_load_lds((const unsigned*)((const char*)g.A + (size_t)(AO)[_i] + (size_t)(koff)), (PG8_LAS unsigned*)(lds + (bufoff) + ldsw + _i * 8192), 16, 0, 0); } while (0)
    const size_t kstep = (size_t)(BK * 2);
    const size_t hstep = (size_t)HALF * K * 2;
    const size_t tstep = 2 * hstep;
    const unsigned ldsw = (unsigned)wid * 1024u;
    const int aoff = lds_byte(wr * 64 + fr, fq * 8), boff = lds_byte(wc * 32 + fr, fq * 8);
#define PG8_SA(b, h) (((b) * 2 + (h)) * HTB)
#define PG8_SB(b, h) ((4 + (b) * 2 + (h)) * HTB)
#define PG8_STAGE(bufoff, gbase, voff) do { _Pragma("unroll") for (int _i = 0; _i < 2; ++_i) \
        __builtin_amdgcn_global_load_lds((const unsigned*)((const char*)(gbase) + (voff)[_i]), (PG8_LAS unsigned*)(lds + (bufoff) + ldsw + _i * 8192), 16, 0, 0); } while (0)
#define PG8_LDA(dst, b, h) do { _Pragma("unroll") for (int m = 0; m < 4; ++m) _Pragma("unroll") for (int k = 0; k < 2; ++k) dst[m][k] = *(const PG8_LAS bf16x8*)(lds + PG8_SA(b, h) + aoff + m * 2048 + k * 1024); } while (0)
#define PG8_LDB(dst, b, h) do { _Pragma("unroll") for (int n = 0; n < 2; ++n) _Pragma("unroll") for (int k = 0; k < 2; ++k) dst[n][k] = *(const PG8_LAS bf16x8*)(lds + PG8_SB(b, h) + boff + n * 2048 + k * 1024); } while (0)
#define PG8_MMA(ai, bj, At, Bt) do { __builtin_amdgcn_s_setprio(1); _Pragma("unroll") for (int m = 0; m < 4; ++m) _Pragma("unroll") for (int n = 0; n < 2; ++n) _Pragma("unroll") for (int k = 0; k < 2; ++k) \
        acc[ai][bj][m][n] = __builtin_amdgcn_mfma_f32_16x16x32_bf16(Bt[n][k], At[m][k], acc[ai][bj][m][n], 0, 0, 0); __builtin_amdgcn_s_setprio(0); } while (0)
#define PG8_WAIT_V(n) asm volatile("s_waitcnt vmcnt(" #n ")" ::: "memory")
#define PG8_WAIT_L(n) asm volatile("s_waitcnt lgkmcnt(" #n ")" ::: "memory")
#define PG8_BAR __builtin_amdgcn_s_barrier()
#define PG8_SCHED __builtin_amdgcn_sched_barrier(0)
    UnitG cur, nxt; int ui = 0;
    if (!S.next(0, cur)) return;
    f32x4 acc[2][2][4][2];
#pragma unroll
    for (int a = 0; a < 2; ++a)
#pragma unroll
        for (int b = 0; b < 2; ++b)
#pragma unroll
            for (int m = 0; m < 4; ++m)
#pragma unroll
                for (int n = 0; n < 2; ++n) acc[a][b][m][n] = (f32x4){0.f, 0.f, 0.f, 0.f};
    bf16x8 At[4][2], B0[2][2], B1[2][2];
    unsigned ca[2][2]; PG8_AOFFS(cur, ca); const char* cB = cur.bbase + (size_t)cur.pn * tstep;
    S.a_ready(cur);
    PG8_STAGE(PG8_SB(0, 0), cB, voffB); PG8_STAGE_A(PG8_SA(0, 0), ca[0], 0); PG8_STAGE(PG8_SB(0, 1), cB + hstep, voffB); PG8_STAGE_A(PG8_SA(0, 1), ca[1], 0);
    if (wr == 1) PG8_BAR;
    PG8_WAIT_V(4); PG8_BAR;
    PG8_STAGE(PG8_SB(1, 0), cB + kstep, voffB); PG8_STAGE_A(PG8_SA(1, 0), ca[0], kstep); PG8_STAGE(PG8_SB(1, 1), cB + hstep + kstep, voffB);
    PG8_WAIT_V(6); PG8_BAR;
    for (;;) {
        const bool has_next = S.next(ui + 1, nxt);
        const char* nB = has_next ? nxt.bbase + (size_t)nxt.pn * tstep : cB;
        for (int t = 0; t < nt; t += 2) {
            const bool last = (t == nt - 2);
            const size_t k1 = (size_t)(t + 1) * kstep, k2 = last ? 0 : (size_t)(t + 2) * kstep;
            unsigned a2o[2][2];
            if (last && has_next) PG8_AOFFS(nxt, a2o); else { a2o[0][0] = ca[0][0]; a2o[0][1] = ca[0][1]; a2o[1][0] = ca[1][0]; a2o[1][1] = ca[1][1]; }
            const char* b2 = last ? nB : cB + (size_t)(t + 2) * kstep; const char* b3 = b2 + kstep;
            if (last && has_next) S.a_ready(nxt);
            PG8_LDB(B0, 0, 0); PG8_SCHED; PG8_LDA(At, 0, 0); PG8_STAGE_A(PG8_SA(1, 1), ca[1], k1);
            PG8_WAIT_L(8); PG8_BAR; PG8_WAIT_L(0); PG8_MMA(0, 0, At, B0); PG8_BAR; PG8_SCHED;
            PG8_LDB(B1, 0, 1); PG8_STAGE(PG8_SB(0, 0), b2, voffB);
            PG8_BAR; PG8_WAIT_L(0); PG8_MMA(0, 1, At, B1); PG8_BAR;
            PG8_LDA(At, 0, 1); PG8_STAGE_A(PG8_SA(0, 0), a2o[0], k2);
            PG8_BAR; PG8_WAIT_L(0); PG8_MMA(1, 0, At, B0); PG8_BAR; PG8_SCHED;
            PG8_STAGE(PG8_SB(0, 1), b2 + hstep, voffB);
            PG8_WAIT_V(6); PG8_BAR; PG8_MMA(1, 1, At, B1); PG8_BAR;
            PG8_LDB(B0, 1, 0); PG8_SCHED; PG8_LDA(At, 1, 0); PG8_STAGE_A(PG8_SA(0, 1), a2o[1], k2);
            PG8_WAIT_L(8); PG8_BAR; PG8_WAIT_L(0); PG8_MMA(0, 0, At, B0); PG8_BAR; PG8_SCHED;
            PG8_LDB(B1, 1, 1); PG8_STAGE(PG8_SB(1, 0), b3, voffB);
            PG8_BAR; PG8_WAIT_L(0); PG8_MMA(0, 1, At, B1); PG8_BAR;
            PG8_LDA(At, 1, 1); PG8_STAGE_A(PG8_SA(1, 0), a2o[0], k2 + kstep);
            PG8_BAR; PG8_WAIT_L(0); PG8_MMA(1, 0, At, B0); PG8_BAR; PG8_SCHED;
            PG8_STAGE(PG8_SB(1, 1), b3 + hstep, voffB);
            PG8_WAIT_V(6); PG8_BAR; PG8_MMA(1, 1, At, B1); PG8_BAR;
            if (last) { ca[0][0] = a2o[0][0]; ca[0][1] = a2o[0][1]; ca[1][0] = a2o[1][0]; ca[1][1] = a2o[1][1]; }
        }
            if constexpr (!Epi::AFTER_DRAIN) { E(acc, cur, wr, wc, fr, fq); S.done(cur); }
            if (!has_next) break;
#pragma unroll
        for (int a = 0; a < 2; ++a)
#pragma unroll
            for (int b = 0; b < 2; ++b)
#pragma unroll
                for (int m = 0; m < 4; ++m)
#pragma unroll
                    for (int n = 0; n < 2; ++n) acc[a][b][m][n] = (f32x4){0.f, 0.f, 0.f, 0.f};
        cur = nxt; cB = nB; ++ui;
    }
    PG8_WAIT_V(0);
    if (wr == 0) PG8_BAR;
    PG8_BAR;
    if constexpr (Epi::AFTER_DRAIN) { E.fused(acc, cur, wr, wc, fr, fq, lds, wid, lane); S.done(cur); }
#undef PG8_SA
#undef PG8_AOFFS
#undef PG8_STAGE_A
#undef PG8_SB
#undef PG8_STAGE
#undef PG8_LDA
#undef PG8_LDB
#undef PG8_MMA
#undef PG8_WAIT_V
#undef PG8_WAIT_L
#undef PG8_BAR
#undef PG8_SCHED
}
}

__device__ __forceinline__ void transpose_item(const float* __restrict__ W, int K, int N, bf16_t* __restrict__ WT, int mode, LAS float* scr, int item, int lane) {
    const int nblk = N / 32, kb = item / nblk, nb = item % nblk, k0 = 64 * kb, n0 = 32 * nb;
    {
        const float* wp = W + (size_t)(k0 + (lane >> 5)) * N + n0 + (lane & 31);
        float t[32];
#pragma unroll
        for (int i = 0; i < 32; ++i) t[i] = wp[(size_t)(2 * i) * N];
#pragma unroll
        for (int i = 0; i < 32; ++i) scr[(2 * i + (lane >> 5)) * 33 + (lane & 31)] = t[i];
    }
    asm volatile("s_waitcnt lgkmcnt(0)" ::: "memory");
    const int c = lane & 7;
#pragma unroll
    for (int j = 0; j < 4; ++j) {
        const int nl = (lane >> 3) + 8 * j; const LAS float* s = scr + (8 * c) * 33 + nl;
        u32x4 o; o.x = pk2(s[0 * 33], s[1 * 33]); o.y = pk2(s[2 * 33], s[3 * 33]); o.z = pk2(s[4 * 33], s[5 * 33]); o.w = pk2(s[6 * 33], s[7 * 33]);
        const int n = n0 + nl;
        const int nd = mode == 0 ? n : (32 * (n >> 4) + (n & 15) + (mode == 2 ? 16 : 0));
        *(u32x4*)(WT + (size_t)nd * K + k0 + 8 * c) = o;
    }
    asm volatile("s_waitcnt lgkmcnt(0)" ::: "memory");
}

constexpr int EXC_IG = 16 * 16, EXC_IDN = 8 * 32, EXC_PER = 2 * EXC_IG + EXC_IDN, EXC_ITEMS = NEXP * EXC_PER;
__device__ __forceinline__ int exc_s0(int layer) { return (layer & 1) ? 6144 : 8192; }
__device__ __forceinline__ int exc_s1(int layer) { return layer == DEPTH - 1 ? 0 : 5120; }
__device__ __forceinline__ void expconv_items(const CAS Params& P, int layer, LAS char* lds, int lo, int hi, int worker, int nworkers, int wid, int lane) {
    LAS float* scr = (LAS float*)(lds + wid * 8448);
    bf16_t* gu = (bf16_t*)(P.ws + WS_EXPGU); bf16_t* dw = (bf16_t*)(P.ws + WS_EXPD);
    for (int it = lo + worker; it < hi; it += nworkers) {
        const int e = it / EXC_PER; int r = it % EXC_PER;
        const size_t eo = (size_t)(layer * NEXP + e);
        if (r < EXC_IG) { transpose_item(P.exp_w_gate + eo * D * DEXP, D, DEXP, gu + (size_t)e * 1024 * 1024, 1, scr, r, lane); continue; } r -= EXC_IG;
        if (r < EXC_IG) { transpose_item(P.exp_w_up + eo * D * DEXP, D, DEXP, gu + (size_t)e * 1024 * 1024, 2, scr, r, lane); continue; } r -= EXC_IG;
        transpose_item(P.exp_w_down + eo * DEXP * D, DEXP, D, dw + (size_t)e * 1024 * 512, 0, scr, r, lane);
    }
}
__device__ __forceinline__ void expconv_tail(int wv, const CAS Params& P, int layer, LAS char* lds, int nwg, int lo, int hi) {
    const int G = gridDim.x, rem = nwg % G;
    if (rem != 0 && (int)blockIdx.x >= rem && lo < hi) {
        const int tid = ltid(wv);
        __syncthreads();
        expconv_items(P, layer, lds, lo, hi, ((int)blockIdx.x - rem) * 8 + (tid >> 6), (G - rem) * 8, tid >> 6, tid & 63);
    }
}

__device__ __forceinline__ void phase_prologue0(int wv, KP Pk, LAS char* lds) {
    asm volatile("" : "+s"(Pk));
    const CAS Params& P = *Pk;
    const int tid = ltid(wv), lane = tid & 63, wid = tid >> 6;
    const int gw = blockIdx.x * 8 + wid, NGW = gridDim.x * 8;
    LAS float* scr = (LAS float*)(lds + wid * 8448);
    bf16_t* winT = (bf16_t*)(P.ws + WS_WINT);
    bf16_t* woutT = (bf16_t*)(P.ws + WS_WOUTT);
    bf16_t* loraT = (bf16_t*)(P.ws + WS_LORAT);
    constexpr int I_EV = 16 * (P_EVEN / 32), I_OD = 16 * (P_ODD / 32), I_O = 16 * 32, I_L64 = 16, I_L128 = 32;
    constexpr int I_LORA = 3 * I_L64 + I_L128;
    constexpr int NIT = 2 * I_EV + 2 * I_OD + 4 * I_O + 2 * I_LORA;
    for (int it = gw; it < NIT; it += NGW) {
        int r = it;
        if (r < 2 * I_EV) { const int i = r / I_EV; transpose_item(P.ev_w_in + (size_t)i * D * P_EVEN, D, P_EVEN, winT + (i ? WINT_L2 : WINT_L0), 0, scr, r % I_EV, lane); continue; } r -= 2 * I_EV;
        if (r < 2 * I_OD) { const int i = r / I_OD; transpose_item(P.od_w_in + (size_t)i * D * P_ODD, D, P_ODD, winT + (i ? WINT_L3 : WINT_L1), 0, scr, r % I_OD, lane); continue; } r -= 2 * I_OD;
        if (r < 4 * I_O) { const int l = r / I_O; const float* src = (l & 1) ? P.od_w_out + (size_t)(l >> 1) * D * D : P.ev_w_out + (size_t)(l >> 1) * D * D;
            transpose_item(src, D, D, woutT + (size_t)l * D * D, 0, scr, r % I_O, lane); continue; } r -= 4 * I_O;
        { const int i = r / I_LORA; int q = r % I_LORA; bf16_t* dst = loraT + (size_t)i * LORA_PER;
          if (q < I_L64) { transpose_item(P.rw_w2 + (size_t)(i * 2 + 0) * 64 * 512, 64, 512, dst, 0, scr, q, lane); continue; } q -= I_L64;
          if (q < I_L64) { transpose_item(P.rw_w2 + (size_t)(i * 2 + 1) * 64 * 512, 64, 512, dst + 512 * 64, 0, scr, q, lane); continue; } q -= I_L64;
          if (q < I_L64) { transpose_item(P.rw_a2 + (size_t)i * 64 * 512, 64, 512, dst + 2 * 512 * 64, 0, scr, q, lane); continue; } q -= I_L64;
          transpose_item(P.rw_g2 + (size_t)i * 128 * 512, 128, 512, dst + 3 * 512 * 64, 0, scr, q, lane); }
    }
    {
        const int gt = blockIdx.x * NT + tid, NG = gridDim.x * NT;
        constexpr int PADE = (LDP_EVEN - P_EVEN) * D / 8, PADO = (LDP_ODD - P_ODD) * D / 8;
        for (int i = gt; i < 2 * PADE + 2 * PADO; i += NG) {
            int r = i; bf16_t* dst;
            if (r < 2 * PADE) { const int l = r / PADE; dst = winT + (l ? WINT_L2 : WINT_L0) + (size_t)P_EVEN * D + (size_t)(r % PADE) * 8; }
            else { r -= 2 * PADE; const int l = r / PADO; dst = winT + (l ? WINT_L3 : WINT_L1) + (size_t)P_ODD * D + (size_t)(r % PADO) * 8; }
            *(u32x4*)dst = (u32x4){0u, 0u, 0u, 0u};
        }
    }
    {
        const int gt = blockIdx.x * NT + tid, NG = gridDim.x * NT;
        float* lb = (float*)(P.ws + WS_LB);
        for (int ch = gt; ch < 512; ch += NG) {
            float lg[4], mx = -1e30f;
#pragma unroll
            for (int l = 0; l < 4; ++l) { lg[l] = P.hg_lb_logits[l * 512 + ch]; mx = fmaxf(mx, lg[l]); }
            float e[4], s = 0.f;
#pragma unroll
            for (int l = 0; l < 4; ++l) { e[l] = __expf(lg[l] - mx); s += e[l]; }
            float cum = 0.f;
#pragma unroll
            for (int l = 0; l < 4; ++l) { if (l > 0) cum += e[l] / s; lb[l * 512 + ch] = cum; }
        }
    }
    __syncthreads();
    {
        LAS float* sc = (LAS float*)lds;
        LAS float* red = (LAS float*)(lds + 5 * 1024 * 4);
        for (int i = tid; i < 5 * D; i += NT) { const int m = i >> 10, k = i & 1023; const float v = m < 4 ? P.c[m * D + k] : P.c_ctx[k]; sc[i] = siluf_(v); }
        __syncthreads();
        float* modv = (float*)(P.ws + WS_MODV);
        const int col = tid & 127, kq = tid >> 7;
        for (int item = blockIdx.x; item < 4 * 48; item += gridDim.x) {
            const int l = item / 48, j = (item % 48) * 128 + col;
            const float* w = P.mod_w + (size_t)l * D * 6144 + j;
            float a[5] = {0.f, 0.f, 0.f, 0.f, 0.f};
#pragma unroll 8
            for (int k = kq * 256; k < kq * 256 + 256; ++k) {
                const float wv = w[(size_t)k * 6144];
#pragma unroll
                for (int m = 0; m < 5; ++m) a[m] += sc[m * 1024 + k] * wv;
            }
#pragma unroll
            for (int m = 0; m < 5; ++m) red[(kq * 128 + col) * 5 + m] = a[m];
            __syncthreads();
            if (kq == 0) {
                const float bias = P.mod_b[l * 6144 + j];
#pragma unroll
                for (int m = 0; m < 5; ++m) {
                    const float s = red[(0 * 128 + col) * 5 + m] + red[(1 * 128 + col) * 5 + m] + red[(2 * 128 + col) * 5 + m] + red[(3 * 128 + col) * 5 + m];
                    modv[(size_t)(l * 5 + m) * 6144 + j] = s + bias;
                }
            }
            __syncthreads();
        }
    }
}

__device__ __forceinline__ void phase_prologue1(int wv, KP Pk) {
    asm volatile("" : "+s"(Pk));
    const CAS Params& P = *Pk;
    const int tid = ltid(wv), lane = tid & 63, wid = tid >> 6;
    bf16_t* act = (bf16_t*)(P.ws + WS_ACT);
    for (int r = blockIdx.x * 8 + wid; r < NROWS; r += gridDim.x * 8) {
        const int m = row_mod(r);
        const float* src = r < NCTX ? P.ctx + (size_t)r * D : P.x + (size_t)(r - NCTX) * D;
        const float* sh = modvec(P.ws, 0, m, 0); const float* sc = modvec(P.ws, 0, m, 1);
#pragma unroll
        for (int i = 0; i < 4; ++i) {
            const int c = 4 * lane + 256 * i;
            const f32x4 v = *(const f32x4*)(src + c), s1 = *(const f32x4*)(sc + c), h1 = *(const f32x4*)(sh + c);
            u32x2 o; o.x = pk2(v[0] * (1.f + s1[0]) + h1[0], v[1] * (1.f + s1[1]) + h1[1]); o.y = pk2(v[2] * (1.f + s1[2]) + h1[2], v[3] * (1.f + s1[3]) + h1[3]);
            *(u32x2*)(act + (size_t)r * D + c) = o;
        }
    }
}

__device__ __forceinline__ void phase_inproj(int wv, KP Pk, int layer, LAS char* lds) {
    asm volatile("" : "+s"(Pk));
    const CAS Params& P = *Pk;
    const int odd = layer & 1, ldp = odd ? LDP_ODD : LDP_EVEN;
    const size_t woff = layer == 0 ? WINT_L0 : layer == 1 ? WINT_L1 : layer == 2 ? WINT_L2 : WINT_L3;
    pg8::Gemm g{(const bf16_t*)(P.ws + WS_ACT), (const bf16_t*)(P.ws + WS_WINT) + woff, NROWS, ldp, D};
    pg8::StaticOrder S; S.init(NROWS, ldp, (int)gridDim.x, (int)blockIdx.x);
    pg8::EpiStoreP E{(bf16_t*)(P.ws + WS_P), ldp};
    pg8::gemm_phase(wv, (PG8_LAS unsigned char*)lds, g, S, E);
    expconv_tail(wv, P, layer, lds, (NROWS / 256) * (ldp / 256), 0, exc_s0(layer));
}
__device__ __forceinline__ void phase_outproj(int wv, KP Pk, int layer, LAS char* lds) {
    asm volatile("" : "+s"(Pk));
    const CAS Params& P = *Pk;
    const int r0 = (layer == DEPTH - 1) ? NCTX : 0;
    pg8::Gemm g{(const bf16_t*)(P.ws + WS_FEAT) + (size_t)r0 * D, (const bf16_t*)(P.ws + WS_WOUTT) + (size_t)layer * D * D, NROWS - r0, D, D};
    pg8::StaticOrder S; S.init(NROWS - r0, D, (int)gridDim.x, (int)blockIdx.x);
    pg8::EpiStoreP E{(bf16_t*)(P.ws + WS_YO) + (size_t)r0 * D, D};
    pg8::gemm_phase(wv, (PG8_LAS unsigned char*)lds, g, S, E);
    expconv_tail(wv, P, layer, lds, ((NROWS - r0) / 256) * (D / 256), exc_s0(layer), exc_s0(layer) + exc_s1(layer));
}
__device__ __forceinline__ void phase_prep2(int wv, KP Pk, int layer, LAS char* lds) {
    asm volatile("" : "+s"(Pk));
    const CAS Params& P = *Pk;
    const int i = layer >> 1;
    const bf16_t* la = (const bf16_t*)(P.ws + WS_LA);
    const bf16_t* lt = (const bf16_t*)(P.ws + WS_LORAT) + (size_t)i * LORA_PER;
    constexpr int MT = NROWS / G_BM, NTL = 512 / G_BN;
    const int ntiles = 4 * MT * NTL;
    for (int t = blockIdx.x; t < ntiles; t += gridDim.x) {
        const int which = t / (MT * NTL), r = t % (MT * NTL), mt = r / NTL, nt = r % NTL;
        RowLinear rs{mt * G_BM};
        if (which < 2) {
            EpiDecay epi{(float*)(P.ws + WS_RWDEC) + (size_t)which * NROWS * 512, P.rw_w0 + (size_t)(i * 2 + which) * 512, mt * G_BM, nt * G_BN};
            gemm_tile(wv, la + which * 64, 320, rs, lt + (size_t)which * 512 * 64, 64, nt * G_BN, 64, epi, lds);
        } else if (which == 2) {
            EpiAK epi{(bf16_t*)(P.ws + WS_RWK), (const bf16_t*)(P.ws + WS_RWKK), (bf16_t*)(P.ws + WS_RWB), P.rw_a0 + i * 512, P.rw_k_a + i * 512, mt * G_BM, nt * G_BN};
            gemm_tile(wv, la + 128, 320, rs, lt + (size_t)2 * 512 * 64, 64, nt * G_BN, 64, epi, lds);
        } else {
            EpiStoreBf16 epi{(bf16_t*)(P.ws + WS_RWG), 512, mt * G_BM, nt * G_BN, 512};
            gemm_tile(wv, la + 192, 320, rs, lt + (size_t)3 * 512 * 64, 128, nt * G_BN, 128, epi, lds);
        }
    }
}
__device__ __forceinline__ void moe_tiles(int wv, const unsigned char* ws, int layer, LAS int* tstart, LAS int* tcnt) {
    const int tid = ltid(wv);
    if (tid < 64) {
        const int* cnt = (const int*)(ws + WS_CNT) + layer * 32 * CNT_STRIDE;
        const int c = tid < NEXP ? cnt[tid * CNT_STRIDE] : 0;
        int incl = (c + G_BM - 1) / G_BM;
#pragma unroll
        for (int o = 1; o < 32; o <<= 1) { const int t = __shfl_up(incl, o); if (tid >= o) incl += t; }
        if (tid < NEXP) { tcnt[tid] = c; tstart[tid] = incl - (c + G_BM - 1) / G_BM; }
        if (tid == NEXP - 1) tstart[NEXP] = incl;
    }
    __syncthreads();
}
__device__ __forceinline__ void phase_moe1(int wv, KP Pk, int layer, LAS char* lds) {
    asm volatile("" : "+s"(Pk));
    const CAS Params& P = *Pk;
    LAS int* tstart = (LAS int*)(lds + pg8::STAGE_BYTES); LAS int* tcnt = tstart + 40;
    moe_tiles(wv, P.ws, layer, tstart, tcnt);
    pg8::Gemm g{(const bf16_t*)(P.ws + WS_ACT), (const bf16_t*)(P.ws + WS_EXPGU), 0, 1024, D};
    LAS int* ltabs = tstart + 128;
    pg8::MoeOrder S{tstart, tcnt, ltabs, (const int*)(P.ws + WS_LIST), (const char*)(P.ws + WS_EXPGU), (size_t)1024 * 1024 * 2, 4, 1, (int)gridDim.x, (int)blockIdx.x};
    pg8::EpiSwiGLUG E{(bf16_t*)(P.ws + WS_HID)};
    for (int i = 0; i < 8; ++i) {
        pg8::UnitG u; if (!S.next(i, u)) break;
        const int tl = ltid(wv);
        const int* ul = (const int*)(P.ws + WS_LIST) + (size_t)u.e * LISTCAP + u.pm * pg8::BM;
        if (tl < pg8::BM) ltabs[i * pg8::BM + tl] = ul[tl < u.cnt ? tl : 0];
    }
    __syncthreads();
    pg8::gemm_phase_g(wv, (PG8_LAS unsigned char*)lds, g, S, E);
    __syncthreads();
}
__device__ __forceinline__ void phase_moe2(int wv, KP Pk, int layer, LAS char* lds) {
    asm volatile("" : "+s"(Pk));
    const CAS Params& P = *Pk;
    LAS int* tstart = (LAS int*)(lds + pg8::STAGE_BYTES); LAS int* tcnt = tstart + 40;
    moe_tiles(wv, P.ws, layer, tstart, tcnt);
    pg8::Gemm g{(const bf16_t*)(P.ws + WS_HID), (const bf16_t*)(P.ws + WS_EXPD), 0, 1024, DEXP};
    LAS int* ltabs = tstart + 128;
    pg8::MoeOrder S{tstart, tcnt, ltabs, (const int*)(P.ws + WS_LIST), (const char*)(P.ws + WS_EXPD), (size_t)1024 * 512 * 2, 4, 0, (int)gridDim.x, (int)blockIdx.x};
    pg8::EpiScatterG E{(bf16_t*)(P.ws + WS_YP)};
    for (int i = 0; i < 8; ++i) {
        pg8::UnitG u; if (!S.next(i, u)) break;
        const int tl = ltid(wv);
        const int* ul = (const int*)(P.ws + WS_LIST) + (size_t)u.e * LISTCAP + u.pm * pg8::BM;
        if (tl < pg8::BM) ltabs[i * pg8::BM + tl] = ul[tl < u.cnt ? tl : 0];
    }
    __syncthreads();
    pg8::gemm_phase_g(wv, (PG8_LAS unsigned char*)lds, g, S, E);
    __syncthreads();
}

constexpr int NCHUNK = NSTEPS / TCH;

constexpr int SSD_F = 32 + 64 + 64;
constexpr int SSD_BUF = TCH * SSD_F + 3 * TCH;

constexpr int ML_F = 64 + 64 + 32;
constexpr int ML_BUF = TCH * ML_F + 4 * TCH;

constexpr int HG_F = 128 + 128 + 32;
constexpr int HG_BUF = TCH * HG_F + TCH;

constexpr int RW_F = 5 * 64 + 32;
constexpr int RW_BUF = TCH * RW_F + TCH;
__device__ __forceinline__ void scan_rwkv(int wv, KP Pk, int layer, int unit, LAS char* lds) {
    asm volatile("" : "+s"(Pk));
    const CAS Params& P = *Pk;
    const int tid = ltid(wv);
    const int seq = unit >> 1, half = unit & 1, b = seq >> 4, h = (seq >> 1) & 7, dir = seq & 1;
    LAS float* bufs = (LAS float*)lds;
    bf16_t* Y = (bf16_t*)(P.ws + (dir ? WS_YB : WS_YF));
    const float* dec = (const float*)(P.ws + WS_RWDEC) + (size_t)dir * NROWS * 512;
    int tj[4], tg_[4]; bool tv[4]; const unsigned char* tbase[4]; int tlds[4];
#pragma unroll
    for (int s = 0; s < 4; ++s) {
        const int task = tid + NT * s; tv[s] = task < TCH * 52; tj[s] = task / 52; tg_[s] = task % 52;
        const int g = tg_[s];
        if (g < 8)       { tbase[s] = P.ws + WS_RWR  + (size_t)(h * 64 + 8 * g) * 2;              tlds[s] = 256 + 8 * g; }
        else if (g < 16) { tbase[s] = P.ws + WS_RWK  + (size_t)(h * 64 + 8 * (g - 8)) * 2;        tlds[s] = 192 + 8 * (g - 8); }
        else if (g < 24) { tbase[s] = P.ws + WS_RWKK + (size_t)(h * 64 + 8 * (g - 16)) * 2;       tlds[s] = 64 + 8 * (g - 16); }
        else if (g < 32) { tbase[s] = P.ws + WS_RWB  + (size_t)(h * 64 + 8 * (g - 24)) * 2;       tlds[s] = 128 + 8 * (g - 24); }
        else if (g < 36) { tbase[s] = P.ws + WS_RWV  + (size_t)(h * 64 + half * 32 + 8 * (g - 32)) * 2; tlds[s] = 320 + 8 * (g - 32); }
        else             { tbase[s] = (const unsigned char*)(dec + h * 64 + 4 * (g - 36));        tlds[s] = 4 * (g - 36); }
    }
    u32x4 rc[4]; int rrow = 0;
    auto load = [&](int c) {
#pragma unroll
        for (int s = 0; s < 4; ++s) {
            rc[s] = (u32x4){0u, 0u, 0u, 0u};
            if (tv[s]) { const int row = scan_row(c * TCH + tj[s], b, dir, 1); rc[s] = *(const u32x4*)(tbase[s] + (size_t)row * (tg_[s] < 36 ? 1024 : 2048)); }
        }
        if (tid < TCH) rrow = scan_row(c * TCH + tid, b, dir, 1);
    };
    auto store = [&](int c) {
        LAS float* buf = bufs + (c & 1) * RW_BUF;
#pragma unroll
        for (int s = 0; s < 4; ++s) {
            if (tv[s]) {
                LAS float* dst = buf + tj[s] * RW_F + tlds[s];
                const int g = tg_[s];
                if (g >= 36) { *(LAS u32x4*)dst = rc[s]; }
                else {
                    float f[8]; unpack8(rc[s], f);
                    const float sg = (g >= 16 && g < 24) ? -1.f : 1.f;
                    *(LAS f32x4*)dst = (f32x4){sg * f[0], sg * f[1], sg * f[2], sg * f[3]}; *(LAS f32x4*)(dst + 4) = (f32x4){sg * f[4], sg * f[5], sg * f[6], sg * f[7]};
                }
            }
        }
        if (tid < TCH) ((LAS int*)buf)[TCH * RW_F + tid] = rrow;
    };
    const int vrow = tid >> 4, q = tid & 15;
    float S[4] = {0.f, 0.f, 0.f, 0.f};
    load(0); store(0); __syncthreads();
    for (int c = 0; c < NCHUNK; ++c) {
        if (c + 1 < NCHUNK) load(c + 1);
        LAS float* buf = bufs + (c & 1) * RW_BUF;
        {
            const LAS float* wp = buf + 4 * q;
            const LAS float* vp = buf + 320 + vrow;
            f32x4 w4 = *(const LAS f32x4*)wp, a4 = *(const LAS f32x4*)(wp + 64), b4 = *(const LAS f32x4*)(wp + 128), k4 = *(const LAS f32x4*)(wp + 192), r4 = *(const LAS f32x4*)(wp + 256); float vr = vp[0];
#pragma unroll 1
            for (int jh = 0; jh < 2; ++jh) {
                float ysel = 0.f;
#pragma unroll
                for (int j = 0; j < 16; ++j) {
                    const int jj = jh * 16 + j;
                    const f32x4 wc = w4, ac = a4, bc = b4, kc = k4, rc = r4; const float vv = vr;
                    if (j < 15 || jh == 0) {
                        const LAS float* np = wp + (jj + 1) * RW_F;
                        w4 = *(const LAS f32x4*)np; a4 = *(const LAS f32x4*)(np + 64); b4 = *(const LAS f32x4*)(np + 128); k4 = *(const LAS f32x4*)(np + 192); r4 = *(const LAS f32x4*)(np + 256); vr = vp[(jj + 1) * RW_F];
                    }
                    float sa = S[0] * ac[0] + S[1] * ac[1] + S[2] * ac[2] + S[3] * ac[3];
                    sa = allreduce16(sa);
                    float y = 0.f;
#pragma unroll
                    for (int e = 0; e < 4; ++e) { S[e] = S[e] * wc[e] + (sa * bc[e] + vv * kc[e]); y += S[e] * rc[e]; }
                    y = allreduce16(y);
                    ysel = (q == j) ? y : ysel;
                }
                const int row = ((const LAS int*)buf)[TCH * RW_F + jh * 16 + q];
                Y[(size_t)row * D + 512 + h * 64 + half * 32 + vrow] = f2bf(ysel);
            }
        }
        if (c + 1 < NCHUNK) store(c + 1);
        __syncthreads();
    }
}

constexpr size_t WS_EXBC = WS_RWR;
constexpr size_t WS_EQK = WS_EXBC + (size_t)NROWS * 768 * 2;
constexpr size_t WS_EGT = WS_EQK + (size_t)NROWS * 512 * 2;
static_assert(WS_EGT + (size_t)NROWS * 32 * 4 <= WS_LA, "even-layer prepare buffers must fit in the RWKV region");

__device__ __forceinline__ void phase_prep_even(int wv, KP Pk, int layer) {
    asm volatile("" : "+s"(Pk));
    const CAS Params& P = *Pk;
    const int tid = ltid(wv), lane = tid & 63, wid = tid >> 6, i_ = layer >> 1;
    const bf16_t* Pb = (const bf16_t*)(P.ws + WS_P);
    bf16_t* XBC = (bf16_t*)(P.ws + WS_EXBC); bf16_t* QK = (bf16_t*)(P.ws + WS_EQK); float* GT = (float*)(P.ws + WS_EGT);
    float cw0[4][8], cw1[4][8], cwq[4][8];
#pragma unroll
    for (int e = 0; e < 8; ++e) {
#pragma unroll
        for (int t = 0; t < 3; ++t) {
            cw0[t][e] = P.ssd_conv_w[(size_t)(i_ * 3 + t) * 768 + 8 * lane + e];
            cw1[t][e] = P.ssd_conv_w[(size_t)(i_ * 3 + t) * 768 + 512 + 8 * (lane & 31) + e];
            cwq[t][e] = P.ml_conv_w[(size_t)(i_ * 3 + t) * 512 + 8 * lane + e];
        }
        cw0[3][e] = P.ssd_conv_b[i_ * 768 + 8 * lane + e]; cw1[3][e] = P.ssd_conv_b[i_ * 768 + 512 + 8 * (lane & 31) + e]; cwq[3][e] = P.ml_conv_b[i_ * 512 + 8 * lane + e];
    }
    float gbias = 0.f;
    if (lane < 16) gbias = P.ssd_dt_bias[i_ * 16 + lane]; else if (lane < 24) gbias = P.ml_i_bias[i_ * 8 + lane - 16]; else if (lane < 32) gbias = P.ml_f_bias[i_ * 8 + lane - 24];
    const float qscl = lane < 32 ? 0.125f : 1.f;
    for (int r = blockIdx.x * 8 + wid; r < NROWS; r += gridDim.x * 8) {
        int t, len; row_seg(r, t, len);
        const bf16_t* pr = Pb + (size_t)r * LDP_EVEN;
        const bool hp = t > 0, hn = t < len - 1;
        const u32x4 zero = (u32x4){0u, 0u, 0u, 0u};
        float fc[8], fp[8], fn[8], o[8];
        {
            const int col = 512 + 8 * lane;
            unpack8(*(const u32x4*)(pr + col), fc); unpack8(hp ? *(const u32x4*)(pr - LDP_EVEN + col) : zero, fp); unpack8(hn ? *(const u32x4*)(pr + LDP_EVEN + col) : zero, fn);
#pragma unroll
            for (int e = 0; e < 8; ++e) o[e] = siluf_(cw0[0][e] * fp[e] + cw0[1][e] * fc[e] + cw0[2][e] * fn[e] + cw0[3][e]);
            *(u32x4*)(XBC + (size_t)r * 768 + 8 * lane) = pack8(o);
        }
        if (lane < 32) {
            const int col = 1024 + 8 * lane;
            unpack8(*(const u32x4*)(pr + col), fc); unpack8(hp ? *(const u32x4*)(pr - LDP_EVEN + col) : zero, fp); unpack8(hn ? *(const u32x4*)(pr + LDP_EVEN + col) : zero, fn);
#pragma unroll
            for (int e = 0; e < 8; ++e) o[e] = siluf_(cw1[0][e] * fp[e] + cw1[1][e] * fc[e] + cw1[2][e] * fn[e] + cw1[3][e]);
            *(u32x4*)(XBC + (size_t)r * 768 + 512 + 8 * lane) = pack8(o);
        }
        {
            const int col = 1296 + 8 * lane;
            unpack8(*(const u32x4*)(pr + col), fc); unpack8(hp ? *(const u32x4*)(pr - LDP_EVEN + col) : zero, fp); unpack8(hn ? *(const u32x4*)(pr + LDP_EVEN + col) : zero, fn);
#pragma unroll
            for (int e = 0; e < 8; ++e) o[e] = qscl * siluf_(cwq[0][e] * fp[e] + cwq[1][e] * fc[e] + cwq[2][e] * fn[e] + cwq[3][e]);
            *(u32x4*)(QK + (size_t)r * 512 + 8 * lane) = pack8(o);
        }
        if (lane < 32) {
            const int col = lane < 16 ? 1280 + lane : 2832 + (lane - 16);
            const float x = bf2f(pr[col]) + gbias;
            GT[(size_t)r * 32 + lane] = lane < 16 ? softplusf_(x) : lane < 24 ? x : logsigmoidf_(x);
        }
    }
}

constexpr int CL = 64, NCH64 = NSTEPS / CL, LDT = 72, LDTB = LDT * 2;
__device__ __forceinline__ bf16x8 ldfrag(const LAS char* tile, int ldb, int row0, int k0, int lane) {
    return *(const LAS bf16x8*)(tile + (row0 + (lane & 15)) * ldb + (k0 + 8 * (lane >> 4)) * 2);
}
constexpr int LDTS = 160;
__device__ __forceinline__ int swz_off(int row, int byteoff) { return row * LDTS + (byteoff ^ (((row >> 3) & 7) << 4)); }
__device__ __forceinline__ bf16x8 ldfrag_sw(const LAS char* tile, int row0, int k0, int lane) {
    const int row = row0 + (lane & 15);
    return *(const LAS bf16x8*)(tile + swz_off(row, (k0 + 8 * (lane >> 4)) * 2));
}
__device__ __forceinline__ void st4bf(LAS char* p, const f32x4& v) { u32x2 o; o.x = pk2(v[0], v[1]); o.y = pk2(v[2], v[3]); *(LAS u32x2*)p = o; }

constexpr int SS_BT = 0, SS_CT = SS_BT + 64 * LDTB, SS_BDT = SS_CT + 64 * LDTB, SS_XT = SS_BDT + 64 * LDTB, SS_CUM = SS_XT + 32 * LDTB, SS_DTV = SS_CUM + 256, SS_ROWS = SS_DTV + 256, SS_STG = SS_ROWS + 256;
constexpr int SS_M = 2 * SS_STG, SS_HB = SS_M + 64 * LDTB, SS_END = SS_HB + 32 * LDTB;
static_assert(SS_END <= LDS_BYTES - 16, "SSD LDS map");

constexpr int MS_QT = 0, MS_KT = MS_QT + 64 * LDTB, MS_KET = MS_KT + 64 * LDTB, MS_VT = MS_KET + 64 * LDTB, MS_SC = MS_VT + 32 * LDTB;
constexpr int MS_STG = MS_SC + 8 * 256;
constexpr int MS_W = 2 * MS_STG, MS_CB = MS_W + 64 * LDTB, MS_ONE = MS_CB + 32 * LDTB, MS_NV = MS_ONE + 16 * LDTB, MS_QN = MS_NV + 256, MS_END = MS_QN + 256;
static_assert(MS_END <= LDS_BYTES - 16, "mLSTM LDS map");

constexpr size_t WS_XSS = WS_EGT + al256((size_t)NROWS * 32 * 4);
constexpr size_t XSS_BYTES = (size_t)64 * NCH64 * 64 * 64 * 2;
constexpr size_t WS_XSD = WS_XSS + XSS_BYTES;
constexpr size_t WS_XMC = WS_XSD + al256((size_t)64 * NCH64 * 4);
constexpr size_t XMC_BYTES = (size_t)32 * NCH64 * 128 * 64 * 2;
constexpr size_t WS_XMN = WS_XMC + XMC_BYTES;
constexpr size_t WS_XMS = WS_XMN + (size_t)32 * NCH64 * 64 * 4;
constexpr size_t WS_XMT = WS_XMS + al256((size_t)32 * NCH64 * 4 * 4);
constexpr size_t WS_XEND = WS_XMT + (size_t)32 * NCH64 * 3 * 64 * 4;
static_assert(WS_XEND <= WS_END, "even-layer chunk-state buffers must fit in the RWKV region");
constexpr int NSSD_ITEMS = 64 * NCH64, NML_ITEMS = 32 * NCH64;

template <int CTRL, int RM, int BM> __device__ __forceinline__ float dppx(float old, float v) {
    return __builtin_bit_cast(float, __builtin_amdgcn_update_dpp(__builtin_bit_cast(int, old), __builtin_bit_cast(int, v), CTRL, RM, BM, false));
}
__device__ __forceinline__ float wave_cumsum(float v, int) {
    float t = v;
    t += dppx<0x111, 0xf, 0xf>(0.f, v); t += dppx<0x112, 0xf, 0xf>(0.f, v); t += dppx<0x113, 0xf, 0xf>(0.f, v);
    { const float u = dppx<0x114, 0xf, 0xe>(0.f, t); t += u; }
    { const float u = dppx<0x118, 0xf, 0xc>(0.f, t); t += u; }
    { const float u = dppx<0x142, 0xa, 0xf>(0.f, t); t += u; }
    { const float u = dppx<0x143, 0xc, 0xf>(0.f, t); t += u; }
    return t;
}
__device__ __forceinline__ float wave_cummax(float v, int) {
    const float ninf = -__builtin_huge_valf();
    float t = v;
    t = fmaxf(t, dppx<0x111, 0xf, 0xf>(ninf, v)); t = fmaxf(t, dppx<0x112, 0xf, 0xf>(ninf, v)); t = fmaxf(t, dppx<0x113, 0xf, 0xf>(ninf, v));
    { const float u = dppx<0x114, 0xf, 0xe>(ninf, t); t = fmaxf(t, u); }
    { const float u = dppx<0x118, 0xf, 0xc>(ninf, t); t = fmaxf(t, u); }
    { const float u = dppx<0x142, 0xa, 0xf>(ninf, t); t = fmaxf(t, u); }
    { const float u = dppx<0x143, 0xc, 0xf>(ninf, t); t = fmaxf(t, u); }
    return t;
}
__device__ __forceinline__ float wave_max(float v) {
    const float t = wave_cummax(v, 0);
    return __builtin_bit_cast(float, __builtin_amdgcn_readlane(__builtin_bit_cast(int, t), 63));
}

constexpr int X1S_BDT = 0, X1S_XT = X1S_BDT + 64 * LDTS, X1S_CUM = X1S_XT + 64 * LDTS, X1S_DTV = X1S_CUM + 256, X1S_END = X1S_DTV + 256;
constexpr int X1M_KET = 0, X1M_VT = X1M_KET + 64 * LDTS, X1M_ONE = X1M_VT + 128 * LDTS, X1M_EE = X1M_ONE + 16 * LDTB, X1M_END = X1M_EE + 256;
__device__ __forceinline__ void phase_ex1(int wv, KP Pk, int layer, LAS char* lds) {
    asm volatile("" : "+s"(Pk));
    const CAS Params& P = *Pk;
    const int tid = ltid(wv), lane = tid & 63, wid = tid >> 6, q = lane >> 4, r16 = lane & 15, i_ = layer >> 1;
    const bf16_t* XBC = (const bf16_t*)(P.ws + WS_EXBC); const bf16_t* QK = (const bf16_t*)(P.ws + WS_EQK); const bf16_t* Pb = (const bf16_t*)(P.ws + WS_P);
    const float* GT = (const float*)(P.ws + WS_EGT);
    {
        bf16_t* Hst = (bf16_t*)(P.ws + WS_XSS); float* Dst = (float*)(P.ws + WS_XSD);
        u32x4 rc[2]; float rdt = 0.f;
        auto geom = [&](int it, int& b, int& h, int& dir, int& c) { const int sq = it / NCH64; c = it - sq * NCH64; b = sq >> 4; h = (sq >> 1) & 7; dir = sq & 1; };
        auto load = [&](int it) {
            int b, h, dir, c; geom(it, b, h, dir, c);
            int tl = tid; asm volatile("" : "+v"(tl));
#pragma unroll
            for (int s = 0; s < 2; ++s) {
                const int task = tl + NT * s, j = task >> 4, g = task & 15;
                const int row = scan_row(c * CL + j, b, dir, 0);
                rc[s] = *(const u32x4*)(XBC + (size_t)row * 768 + (g < 8 ? h * 64 + 8 * g : 512 + (h >> 2) * 64 + 8 * (g - 8)));
            }
            if (tl < CL) { const int row = scan_row(c * CL + tl, b, dir, 0); rdt = GT[(size_t)row * 32 + dir * 8 + h]; }
        };
        int it = blockIdx.x;
        if (it < NSSD_ITEMS) load(it);
        for (; it < NSSD_ITEMS; it += gridDim.x) {
            int b, h, dir, c; geom(it, b, h, dir, c);
            const float aco = -__expf(P.ssd_a_log[(i_ * 2 + dir) * 8 + h]);
            if (tid < CL) {
                const float cum = wave_cumsum(rdt * aco, lane);
                ((LAS float*)(lds + X1S_CUM))[tid] = cum; ((LAS float*)(lds + X1S_DTV))[tid] = rdt;
            }
            __syncthreads();
            {
                const LAS float* cum = (const LAS float*)(lds + X1S_CUM);
                const float cumL = cum[CL - 1];
                int tl = tid; asm volatile("" : "+v"(tl));
#pragma unroll
                for (int s = 0; s < 2; ++s) {
                    const int task = tl + NT * s, j = task >> 4, g = task & 15;
                    float f[8]; unpack8(rc[s], f);
                    if (g < 8) {
                        const float dt = ((const LAS float*)(lds + X1S_DTV))[j];
#pragma unroll
                        for (int e = 0; e < 8; ++e) *(LAS bf16_t*)(lds + X1S_XT + swz_off(8 * g + e, j * 2)) = f2bf(f[e] * dt);
                    } else {
                        const float sc = __expf(cumL - cum[j]);
#pragma unroll
                        for (int e = 0; e < 8; ++e) *(LAS bf16_t*)(lds + X1S_BDT + swz_off(8 * (g - 8) + e, j * 2)) = f2bf(f[e] * sc);
                    }
                }
                if (tid == 0) Dst[it] = __expf(cumL);
            }
            if (it + (int)gridDim.x < NSSD_ITEMS) load(it + gridDim.x);
            __syncthreads();
            {
                const int pt = wid >> 1;
#pragma unroll
                for (int u = 0; u < 2; ++u) {
                    const int nt = (wid & 1) * 2 + u;
                    f32x4 sa = (f32x4){0.f, 0.f, 0.f, 0.f};
#pragma unroll
                    for (int k0 = 0; k0 < 64; k0 += 32) sa = __builtin_amdgcn_mfma_f32_16x16x32_bf16(ldfrag_sw(lds + X1S_BDT, nt * 16, k0, lane), ldfrag_sw(lds + X1S_XT, pt * 16, k0, lane), sa, 0, 0, 0);
                    u32x2 o; o.x = pk2(sa[0], sa[1]); o.y = pk2(sa[2], sa[3]);
                    *(u32x2*)(Hst + ((size_t)it * 64 + pt * 16 + r16) * 64 + nt * 16 + 4 * q) = o;
                }
            }
            __syncthreads();
        }
    }
    {
        bf16_t* Cst = (bf16_t*)(P.ws + WS_XMC); float* Nst = (float*)(P.ws + WS_XMN); float* Sst = (float*)(P.ws + WS_XMS); float* Tst = (float*)(P.ws + WS_XMT);
        for (int i = tid; i < 16 * LDTB / 4; i += NT) ((LAS unsigned*)(lds + X1M_ONE))[i] = 0x3f803f80u;
        u32x4 rc[3]; float rli = 0.f, rlf = 0.f;
        auto geom = [&](int it, int& b, int& h, int& dir, int& c) { const int sq = it / NCH64; c = it - sq * NCH64; b = sq >> 3; h = (sq >> 1) & 3; dir = sq & 1; };
        auto load = [&](int it) {
            int b, h, dir, c; geom(it, b, h, dir, c);
            int tl = tid; asm volatile("" : "+v"(tl));
#pragma unroll
            for (int s = 0; s < 3; ++s) {
                const int task = tl + NT * s, j = task / 24, g = task - 24 * j;
                const int row = scan_row(c * CL + j, b, dir, 0);
                rc[s] = g < 8 ? *(const u32x4*)(QK + (size_t)row * 512 + 256 + h * 64 + 8 * g) : *(const u32x4*)(Pb + (size_t)row * LDP_EVEN + 1808 + h * 128 + 8 * (g - 8));
            }
            if (tl < CL) { const int row = scan_row(c * CL + tl, b, dir, 0); rli = GT[(size_t)row * 32 + 16 + dir * 4 + h]; rlf = GT[(size_t)row * 32 + 24 + dir * 4 + h]; }
        };
        int it = blockIdx.x;
        if (it < NML_ITEMS) load(it);
        __syncthreads();
        for (; it < NML_ITEMS; it += gridDim.x) {
            if (tid < CL) {
                const float fcum = wave_cumsum(rlf, lane);
                const float ftot = __builtin_bit_cast(float, __builtin_amdgcn_readlane(__builtin_bit_cast(int, fcum), 63));
                const float g = rli - fcum, pm = wave_cummax(g, lane);
                const float wend = ftot + g, mloc = wave_max(wend);
                ((LAS float*)(lds + X1M_EE))[tid] = __expf(wend - mloc);
                float* tp = Tst + (size_t)it * 192;
                tp[tid] = fcum; tp[64 + tid] = g; tp[128 + tid] = pm;
                if (tid == 0) { Sst[(size_t)it * 4 + 0] = ftot; Sst[(size_t)it * 4 + 1] = mloc; }
            }
            __syncthreads();
            {
                const LAS float* ee = (const LAS float*)(lds + X1M_EE);
                int tl = tid; asm volatile("" : "+v"(tl));
#pragma unroll
                for (int s = 0; s < 3; ++s) {
                    const int task = tl + NT * s, j = task / 24, g = task - 24 * j;
                    if (g < 8) {
                        float f[8]; unpack8(rc[s], f);
                        const float e1 = ee[j];
#pragma unroll
                        for (int e = 0; e < 8; ++e) *(LAS bf16_t*)(lds + X1M_KET + swz_off(8 * g + e, j * 2)) = f2bf(f[e] * e1);
                    } else {
                        const int v0 = 8 * (g - 8);
#pragma unroll
                        for (int e = 0; e < 8; ++e) { const unsigned wv = rc[s][e >> 1]; *(LAS bf16_t*)(lds + X1M_VT + swz_off(v0 + e, j * 2)) = (bf16_t)((e & 1) ? (wv >> 16) : (wv & 0xffffu)); }
                    }
                }
            }
            if (it + (int)gridDim.x < NML_ITEMS) load(it + gridDim.x);
            __syncthreads();
            {
                const bf16x8 vf0 = ldfrag_sw(lds + X1M_VT, wid * 16, 0, lane), vf1 = ldfrag_sw(lds + X1M_VT, wid * 16, 32, lane);
#pragma unroll
                for (int kt = 0; kt < 4; ++kt) {
                    f32x4 sa = __builtin_amdgcn_mfma_f32_16x16x32_bf16(ldfrag_sw(lds + X1M_KET, kt * 16, 0, lane), vf0, (f32x4){0.f, 0.f, 0.f, 0.f}, 0, 0, 0);
                    sa = __builtin_amdgcn_mfma_f32_16x16x32_bf16(ldfrag_sw(lds + X1M_KET, kt * 16, 32, lane), vf1, sa, 0, 0, 0);
                    u32x2 o; o.x = pk2(sa[0], sa[1]); o.y = pk2(sa[2], sa[3]);
                    *(u32x2*)(Cst + ((size_t)it * 128 + wid * 16 + r16) * 64 + kt * 16 + 4 * q) = o;
                }
                if (wid < 4) {
                    f32x4 na = __builtin_amdgcn_mfma_f32_16x16x32_bf16(ldfrag_sw(lds + X1M_KET, wid * 16, 0, lane), ldfrag(lds + X1M_ONE, LDTB, 0, 0, lane), (f32x4){0.f, 0.f, 0.f, 0.f}, 0, 0, 0);
                    na = __builtin_amdgcn_mfma_f32_16x16x32_bf16(ldfrag_sw(lds + X1M_KET, wid * 16, 32, lane), ldfrag(lds + X1M_ONE, LDTB, 0, 32, lane), na, 0, 0, 0);
                    if (r16 == 0) *(f32x4*)(Nst + (size_t)it * 64 + wid * 16 + 4 * q) = na;
                }
            }
            __syncthreads();
        }
    }
}

constexpr int EX2_UB = 12;
static_assert(NCH64 % EX2_UB == 0, "EX2 batches");
__device__ __forceinline__ void phase_ex2(int wv, KP Pk, int layer) {
    asm volatile("" : "+s"(Pk));
    const CAS Params& P = *Pk;
    const int tid = ltid(wv);
    (void)layer;
    if (blockIdx.x < 128) {
        const int gt = blockIdx.x * NT + tid, sq = gt >> 10, rem = gt & 1023;
        bf16_t* Hst = (bf16_t*)(P.ws + WS_XSS) + (size_t)sq * NCH64 * 4096 + rem * 4;
        const float* Dst = (const float*)(P.ws + WS_XSD) + sq * NCH64;
        float h0 = 0.f, h1 = 0.f, h2 = 0.f, h3 = 0.f;
#pragma unroll 1
        for (int c0 = 0; c0 < NCH64; c0 += EX2_UB) {
            u32x2 loc[EX2_UB]; float dd[EX2_UB];
            bf16_t* hp = Hst + (size_t)c0 * 4096;
#pragma unroll
            for (int u = 0; u < EX2_UB; ++u) { loc[u] = *(const u32x2*)(hp + (size_t)u * 4096); dd[u] = Dst[c0 + u]; }
#pragma unroll
            for (int u = 0; u < EX2_UB; ++u) {
                u32x2 o; o.x = pk2(h0, h1); o.y = pk2(h2, h3);
                *(u32x2*)(hp + (size_t)u * 4096) = o;
                const float d = dd[u];
                h0 = d * h0 + bflo(loc[u].x); h1 = d * h1 + bfhi(loc[u].x); h2 = d * h2 + bflo(loc[u].y); h3 = d * h3 + bfhi(loc[u].y);
            }
        }
    } else if (blockIdx.x < 256) {
        const int gt = (blockIdx.x - 128) * NT + tid, sq = gt >> 11, rem = gt & 2047;
        bf16_t* Cst = (bf16_t*)(P.ws + WS_XMC) + (size_t)sq * NCH64 * 8192 + rem * 4;
        float* Nst = (float*)(P.ws + WS_XMN) + (size_t)sq * NCH64 * 64 + (rem & 15) * 4;
        float* Sst = (float*)(P.ws + WS_XMS) + (size_t)sq * NCH64 * 4;
        const bool own_n = rem < 16, own_m = rem == 0;
        float c0_ = 0.f, c1 = 0.f, c2 = 0.f, c3 = 0.f, m = -1e30f;
        f32x4 nn = (f32x4){0.f, 0.f, 0.f, 0.f};
#pragma unroll 1
        for (int cb = 0; cb < NCH64; cb += EX2_UB) {
            u32x2 loc[EX2_UB]; float ft[EX2_UB], ml[EX2_UB]; f32x4 nl[EX2_UB];
            bf16_t* cp = Cst + (size_t)cb * 8192; float* np = Nst + (size_t)cb * 64; float* sp_ = Sst + cb * 4;
#pragma unroll
            for (int u = 0; u < EX2_UB; ++u) {
                loc[u] = *(const u32x2*)(cp + (size_t)u * 8192); ft[u] = sp_[u * 4 + 0]; ml[u] = sp_[u * 4 + 1];
                nl[u] = (f32x4){0.f, 0.f, 0.f, 0.f};
                if (own_n) nl[u] = *(const f32x4*)(np + (size_t)u * 64);
            }
#pragma unroll
            for (int u = 0; u < EX2_UB; ++u) {
                const float ftot = ft[u], mloc = ml[u];
                const float mnew = fmaxf(ftot + m, mloc), sp = __expf(ftot + m - mnew), sl = __expf(mloc - mnew);
                u32x2 o; o.x = pk2(c0_, c1); o.y = pk2(c2, c3);
                *(u32x2*)(cp + (size_t)u * 8192) = o;
                c0_ = sp * c0_ + sl * bflo(loc[u].x); c1 = sp * c1 + sl * bfhi(loc[u].x); c2 = sp * c2 + sl * bflo(loc[u].y); c3 = sp * c3 + sl * bfhi(loc[u].y);
                if (own_n) { *(f32x4*)(np + (size_t)u * 64) = nn; nn = nn * sp + nl[u] * sl; }
                if (own_m) sp_[u * 4 + 2] = m;
                m = mnew;
            }
        }
    }
}

constexpr int X3S_BT = 0, X3S_CT = X3S_BT + 64 * LDTB, X3S_XT = X3S_CT + 64 * LDTB, X3S_HB = X3S_XT + 64 * LDTS, X3S_M = X3S_HB + 64 * LDTB, X3S_CUM = X3S_M + 64 * LDTB, X3S_DTV = X3S_CUM + 256, X3S_ROWS = X3S_DTV + 256, X3S_END = X3S_ROWS + 256;
constexpr int X3M_QT = 0, X3M_KT = X3M_QT + 64 * LDTB, X3M_VT = X3M_KT + 64 * LDTB, X3M_CB = X3M_VT + 128 * LDTS, X3M_W = X3M_CB + 128 * LDTB, X3M_ONE = X3M_W + 64 * LDTB, X3M_NB = X3M_ONE + 16 * LDTB,
              X3M_SC = X3M_NB + 16 * LDTB, X3M_END = X3M_SC + 6 * 256;
static_assert(X3M_END <= LDS_BYTES - 16 && X3S_END <= LDS_BYTES - 16, "EX3 LDS maps");
__device__ __forceinline__ void phase_ex3(int wv, KP Pk, int layer, LAS char* lds) {
    asm volatile("" : "+s"(Pk));
    const CAS Params& P = *Pk;
    const int tid = ltid(wv), lane = tid & 63, wid = tid >> 6, q = lane >> 4, r16 = lane & 15, i_ = layer >> 1;
    const bf16_t* XBC = (const bf16_t*)(P.ws + WS_EXBC); const bf16_t* QK = (const bf16_t*)(P.ws + WS_EQK); const bf16_t* Pb = (const bf16_t*)(P.ws + WS_P);
    const float* GT = (const float*)(P.ws + WS_EGT);
    {
        const bf16_t* Hst = (const bf16_t*)(P.ws + WS_XSS);
        u32x4 rc[3], rh; float rdt = 0.f; int rrow = 0;
        auto geom = [&](int it, int& b, int& h, int& dir, int& c) { const int sq = it / NCH64; c = it - sq * NCH64; b = sq >> 4; h = (sq >> 1) & 7; dir = sq & 1; };
        auto load = [&](int it) {
            int b, h, dir, c; geom(it, b, h, dir, c);
            int tl = tid; asm volatile("" : "+v"(tl));
#pragma unroll
            for (int s = 0; s < 3; ++s) {
                const int task = tl + NT * s, j = task / 24, g = task - 24 * j;
                const int row = scan_row(c * CL + j, b, dir, 0);
                rc[s] = *(const u32x4*)(XBC + (size_t)row * 768 + (g < 8 ? h * 64 + 8 * g : g < 16 ? 512 + (h >> 2) * 64 + 8 * (g - 8) : 640 + (h >> 2) * 64 + 8 * (g - 16)));
            }
            rh = *(const u32x4*)(Hst + (size_t)it * 4096 + tl * 8);
            if (tl < CL) { rrow = scan_row(c * CL + tl, b, dir, 0); rdt = GT[(size_t)rrow * 32 + dir * 8 + h]; }
        };
        int it = blockIdx.x;
        if (it < NSSD_ITEMS) load(it);
        __syncthreads();
        for (; it < NSSD_ITEMS; it += gridDim.x) {
            int b, h, dir, c; geom(it, b, h, dir, c);
            bf16_t* Y = (bf16_t*)(P.ws + (dir ? WS_YB : WS_YF));
            const float aco = -__expf(P.ssd_a_log[(i_ * 2 + dir) * 8 + h]);
            if (tid < CL) {
                const float cum = wave_cumsum(rdt * aco, lane);
                ((LAS float*)(lds + X3S_CUM))[tid] = cum; ((LAS float*)(lds + X3S_DTV))[tid] = rdt; ((LAS int*)(lds + X3S_ROWS))[tid] = rrow;
            }
            __syncthreads();
            {
                int tl = tid; asm volatile("" : "+v"(tl));
#pragma unroll
                for (int s = 0; s < 3; ++s) {
                    const int task = tl + NT * s, j = task / 24, g = task - 24 * j;
                    if (g < 8) {
                        float f[8]; unpack8(rc[s], f);
                        const float dt = ((const LAS float*)(lds + X3S_DTV))[j];
#pragma unroll
                        for (int e = 0; e < 8; ++e) *(LAS bf16_t*)(lds + X3S_XT + swz_off(8 * g + e, j * 2)) = f2bf(f[e] * dt);
                    } else if (g < 16) *(LAS u32x4*)(lds + X3S_BT + j * LDTB + 8 * (g - 8) * 2) = rc[s];
                    else *(LAS u32x4*)(lds + X3S_CT + j * LDTB + 8 * (g - 16) * 2) = rc[s];
                }
                *(LAS u32x4*)(lds + X3S_HB + (tl >> 3) * LDTB + (tl & 7) * 16) = rh;
            }
            if (it + (int)gridDim.x < NSSD_ITEMS) load(it + gridDim.x);
            __syncthreads();
            const LAS float* cum = (const LAS float*)(lds + X3S_CUM);
            {
                const int lt = wid >> 1;
#pragma unroll
                for (int u = 0; u < 2; ++u) {
                    const int st = (wid & 1) * 2 + u;
                    f32x4 acc = (f32x4){0.f, 0.f, 0.f, 0.f};
                    if (st <= lt) {
#pragma unroll
                        for (int k0 = 0; k0 < 64; k0 += 32) acc = __builtin_amdgcn_mfma_f32_16x16x32_bf16(ldfrag(lds + X3S_BT, LDTB, st * 16, k0, lane), ldfrag(lds + X3S_CT, LDTB, lt * 16, k0, lane), acc, 0, 0, 0);
                        const int l = lt * 16 + r16, s0 = st * 16 + 4 * q;
                        const float cl = cum[l]; const f32x4 cs = *(const LAS f32x4*)(cum + s0);
#pragma unroll
                        for (int j = 0; j < 4; ++j) acc[j] = (s0 + j <= l) ? acc[j] * __expf(cl - cs[j]) : 0.f;
                    }
                    st4bf(lds + X3S_M + (lt * 16 + r16) * LDTB + (st * 16 + 4 * q) * 2, acc);
                }
            }
            __syncthreads();
            {
                const int lt = wid >> 1, l = lt * 16 + r16;
                const float el = __expf(cum[l]);
                const int row = ((const LAS int*)(lds + X3S_ROWS))[l];
                const bf16x8 mf0 = ldfrag(lds + X3S_M, LDTB, lt * 16, 0, lane), mf1 = ldfrag(lds + X3S_M, LDTB, lt * 16, 32, lane);
                const bf16x8 cf0 = ldfrag(lds + X3S_CT, LDTB, lt * 16, 0, lane), cf1 = ldfrag(lds + X3S_CT, LDTB, lt * 16, 32, lane);
#pragma unroll
                for (int u = 0; u < 2; ++u) {
                    const int pt = (wid & 1) * 2 + u;
                    f32x4 ya = __builtin_amdgcn_mfma_f32_16x16x32_bf16(ldfrag_sw(lds + X3S_XT, pt * 16, 0, lane), mf0, (f32x4){0.f, 0.f, 0.f, 0.f}, 0, 0, 0);
                    ya = __builtin_amdgcn_mfma_f32_16x16x32_bf16(ldfrag_sw(lds + X3S_XT, pt * 16, 32, lane), mf1, ya, 0, 0, 0);
                    f32x4 oa = __builtin_amdgcn_mfma_f32_16x16x32_bf16(ldfrag(lds + X3S_HB, LDTB, pt * 16, 0, lane), cf0, (f32x4){0.f, 0.f, 0.f, 0.f}, 0, 0, 0);
                    oa = __builtin_amdgcn_mfma_f32_16x16x32_bf16(ldfrag(lds + X3S_HB, LDTB, pt * 16, 32, lane), cf1, oa, 0, 0, 0);
                    u32x2 o; o.x = pk2(ya[0] + el * oa[0], ya[1] + el * oa[1]); o.y = pk2(ya[2] + el * oa[2], ya[3] + el * oa[3]);
                    *(u32x2*)(Y + (size_t)row * D + h * 64 + pt * 16 + 4 * q) = o;
                }
            }
            __syncthreads();
        }
    }
    {
        const bf16_t* Cst = (const bf16_t*)(P.ws + WS_XMC); const float* Nst = (const float*)(P.ws + WS_XMN); const float* Sst = (const float*)(P.ws + WS_XMS); const float* Tst = (const float*)(P.ws + WS_XMT);
        for (int i = tid; i < 16 * LDTB / 4; i += NT) ((LAS unsigned*)(lds + X3M_ONE))[i] = 0x3f803f80u;
        u32x4 rc[4], rcb[2]; float rfc = 0.f, rg = 0.f, rpm = 0.f, rmp = 0.f, rn = 0.f; int rrow = 0;
        auto geom = [&](int it, int& b, int& h, int& dir, int& c) { const int sq = it / NCH64; c = it - sq * NCH64; b = sq >> 3; h = (sq >> 1) & 3; dir = sq & 1; };
        auto load = [&](int it) {
            int b, h, dir, c; geom(it, b, h, dir, c);
            int tl = tid; asm volatile("" : "+v"(tl));
#pragma unroll
            for (int s = 0; s < 4; ++s) {
                const int task = tl + NT * s, j = task >> 5, g = task & 31;
                const int row = scan_row(c * CL + j, b, dir, 0);
                rc[s] = g < 16 ? *(const u32x4*)(QK + (size_t)row * 512 + (g < 8 ? h * 64 + 8 * g : 256 + h * 64 + 8 * (g - 8))) : *(const u32x4*)(Pb + (size_t)row * LDP_EVEN + 1808 + h * 128 + 8 * (g - 16));
            }
#pragma unroll
            for (int s = 0; s < 2; ++s) rcb[s] = *(const u32x4*)(Cst + (size_t)it * 8192 + (tl + NT * s) * 8);
            if (tl < CL) {
                rrow = scan_row(c * CL + tl, b, dir, 0);
                const float* tp = Tst + (size_t)it * 192;
                rfc = tp[tl]; rg = tp[64 + tl]; rpm = tp[128 + tl]; rmp = Sst[(size_t)it * 4 + 2]; rn = Nst[(size_t)it * 64 + tl];
            }
        };
        int it = blockIdx.x;
        if (it < NML_ITEMS) load(it);
        __syncthreads();
        for (; it < NML_ITEMS; it += gridDim.x) {
            int b, h, dir, c; geom(it, b, h, dir, c);
            bf16_t* Y = (bf16_t*)(P.ws + (dir ? WS_YB : WS_YF));
            LAS float* sc = (LAS float*)(lds + X3M_SC);
            {
                int tl = tid; asm volatile("" : "+v"(tl));
#pragma unroll
                for (int s = 0; s < 4; ++s) {
                    const int task = tl + NT * s, j = task >> 5, g = task & 31;
                    if (g < 8) *(LAS u32x4*)(lds + X3M_QT + j * LDTB + 8 * g * 2) = rc[s];
                    else if (g < 16) *(LAS u32x4*)(lds + X3M_KT + j * LDTB + 8 * (g - 8) * 2) = rc[s];
                    else {
                        const int v0 = 8 * (g - 16);
#pragma unroll
                        for (int e = 0; e < 8; ++e) { const unsigned wv = rc[s][e >> 1]; *(LAS bf16_t*)(lds + X3M_VT + swz_off(v0 + e, j * 2)) = (bf16_t)((e & 1) ? (wv >> 16) : (wv & 0xffffu)); }
                    }
                }
#pragma unroll
                for (int s = 0; s < 2; ++s) { const int ch = tl + NT * s; *(LAS u32x4*)(lds + X3M_CB + (ch >> 3) * LDTB + (ch & 7) * 16) = rcb[s]; }
                if (tl < CL) {
                    const float linter = rfc + rmp, mrow = fmaxf(rfc + rpm, linter);
                    sc[tl] = rfc - mrow; sc[64 + tl] = rg; sc[128 + tl] = __expf(linter - mrow); sc[192 + tl] = __expf(-mrow); ((LAS int*)sc)[256 + tl] = rrow;
                    const bf16_t nb = f2bf(rn);
#pragma unroll
                    for (int r = 0; r < 16; ++r) *(LAS bf16_t*)(lds + X3M_NB + r * LDTB + tl * 2) = nb;
                }
            }
            if (it + (int)gridDim.x < NML_ITEMS) load(it + gridDim.x);
            __syncthreads();
            {
                const int lt = wid >> 1;
#pragma unroll
                for (int u = 0; u < 2; ++u) {
                    const int st = (wid & 1) * 2 + u;
                    f32x4 acc = (f32x4){0.f, 0.f, 0.f, 0.f};
                    if (st <= lt) {
#pragma unroll
                        for (int k0 = 0; k0 < 64; k0 += 32) acc = __builtin_amdgcn_mfma_f32_16x16x32_bf16(ldfrag(lds + X3M_KT, LDTB, st * 16, k0, lane), ldfrag(lds + X3M_QT, LDTB, lt * 16, k0, lane), acc, 0, 0, 0);
                        const int l = lt * 16 + r16, s0 = st * 16 + 4 * q;
                        const float rt = sc[l]; const f32x4 gs = *(const LAS f32x4*)(sc + 64 + s0);
#pragma unroll
                        for (int j = 0; j < 4; ++j) acc[j] = (s0 + j <= l) ? acc[j] * __expf(rt + gs[j]) : 0.f;
                    }
                    st4bf(lds + X3M_W + (lt * 16 + r16) * LDTB + (st * 16 + 4 * q) * 2, acc);
                }
            }
            __syncthreads();
            {
                const int lt = wid >> 1, l = lt * 16 + r16;
                const bf16x8 wf0 = ldfrag(lds + X3M_W, LDTB, lt * 16, 0, lane), wf1 = ldfrag(lds + X3M_W, LDTB, lt * 16, 32, lane);
                const bf16x8 qf0 = ldfrag(lds + X3M_QT, LDTB, lt * 16, 0, lane), qf1 = ldfrag(lds + X3M_QT, LDTB, lt * 16, 32, lane);
                f32x4 da = __builtin_amdgcn_mfma_f32_16x16x32_bf16(ldfrag(lds + X3M_ONE, LDTB, 0, 0, lane), wf0, (f32x4){0.f, 0.f, 0.f, 0.f}, 0, 0, 0);
                da = __builtin_amdgcn_mfma_f32_16x16x32_bf16(ldfrag(lds + X3M_ONE, LDTB, 0, 32, lane), wf1, da, 0, 0, 0);
                f32x4 qn = __builtin_amdgcn_mfma_f32_16x16x32_bf16(ldfrag(lds + X3M_NB, LDTB, 0, 0, lane), qf0, (f32x4){0.f, 0.f, 0.f, 0.f}, 0, 0, 0);
                qn = __builtin_amdgcn_mfma_f32_16x16x32_bf16(ldfrag(lds + X3M_NB, LDTB, 0, 32, lane), qf1, qn, 0, 0, 0);
                const float inter = sc[128 + l], emr = sc[192 + l];
                const float inv = __builtin_amdgcn_rcpf(fmaxf(fabsf(da[0] + inter * qn[0]), emr));
                const int row = ((const LAS int*)sc)[256 + l];
#pragma unroll
                for (int u = 0; u < 4; ++u) {
                    const int vt = (wid & 1) * 4 + u;
                    f32x4 na = __builtin_amdgcn_mfma_f32_16x16x32_bf16(ldfrag_sw(lds + X3M_VT, vt * 16, 0, lane), wf0, (f32x4){0.f, 0.f, 0.f, 0.f}, 0, 0, 0);
                    na = __builtin_amdgcn_mfma_f32_16x16x32_bf16(ldfrag_sw(lds + X3M_VT, vt * 16, 32, lane), wf1, na, 0, 0, 0);
                    f32x4 ca = __builtin_amdgcn_mfma_f32_16x16x32_bf16(ldfrag(lds + X3M_CB, LDTB, vt * 16, 0, lane), qf0, (f32x4){0.f, 0.f, 0.f, 0.f}, 0, 0, 0);
                    ca = __builtin_amdgcn_mfma_f32_16x16x32_bf16(ldfrag(lds + X3M_CB, LDTB, vt * 16, 32, lane), qf1, ca, 0, 0, 0);
                    u32x2 o; o.x = pk2((na[0] + inter * ca[0]) * inv, (na[1] + inter * ca[1]) * inv); o.y = pk2((na[2] + inter * ca[2]) * inv, (na[3] + inter * ca[3]) * inv);
                    *(u32x2*)(Y + (size_t)row * D + 512 + h * 128 + vt * 16 + 4 * q) = o;
                }
            }
            __syncthreads();
        }
    }
}

constexpr int HC_RAWF = 0;
constexpr int HC_RAWQ = HC_RAWF + 64 * 128 * 4;
constexpr int HC_SUB = HC_RAWQ + 64 * 128 * 2;
constexpr int HL_QD = 136 * 2;
constexpr int HL_T = 24 * 2;
constexpr int HS_QI = 0, HS_KO = HS_QI + 16 * HL_QD, HS_KET = HS_KO + 16 * HL_QD, HS_ATT = HS_KET + 128 * HL_T, HS_VT = HS_ATT + 16 * HL_T, HS_DEC = HS_VT + 32 * HL_T, HS_SIZE = HS_DEC + 512;
constexpr int HC_SB = HC_SUB + 4 * HS_SIZE;
constexpr int HC_ROWS = HC_SB + 2 * 32 * HL_QD, HC_CST = HC_ROWS + 256, HC_END = HC_CST + 1024;
static_assert(HC_END <= LDS_BYTES - 16, "HGRN2 LDS map");
static_assert(HS_SIZE % 16 == 0 && HC_SB % 16 == 0, "alignment");
__device__ __forceinline__ bf16x8 ldfrag16(const LAS char* tile, int ldb, int row0, int lane) {
    bf16x8 v = *(const LAS bf16x8*)(tile + (row0 + (lane & 15)) * ldb + ((lane >> 4) & 1) * 16);
    if (lane >= 32) v = (bf16x8){0, 0, 0, 0, 0, 0, 0, 0};
    return v;
}
__device__ __forceinline__ void scan_hgrn_c(int wv, KP Pk, int layer, int unit, LAS char* lds) {
    asm volatile("" : "+s"(Pk));
    const CAS Params& P = *Pk;
    const int tid = ltid(wv), lane = tid & 63, wid = tid >> 6, q = lane >> 4, r16 = lane & 15, i_ = layer >> 1;
    const int seq = unit >> 2, quarter = unit & 3, b = seq >> 3, h = (seq >> 1) & 3, dir = seq & 1;
    const bf16_t* Pb = (const bf16_t*)(P.ws + WS_P);
    bf16_t* Y = (bf16_t*)(P.ws + (dir ? WS_YB : WS_YF));
    LAS float* cst = (LAS float*)(lds + HC_CST);
    if (tid < 128) cst[tid] = ((const float*)(P.ws + WS_LB))[layer * 512 + h * 128 + tid];
    else if (tid < 256) cst[tid] = P.hg_f_bias[(size_t)(i_ * 2 + dir) * 512 + h * 128 + tid - 128];
    for (int i = tid; i < 2 * 32 * HL_QD / 4; i += NT) ((LAS unsigned*)(lds + HC_SB))[i] = 0u;
    int tj[5], tg_[5], tcol[5]; bool tv[5];
#pragma unroll
    for (int s = 0; s < 5; ++s) {
        const int task = tid + NT * s; tv[s] = task < 64 * 36; tj[s] = task / 36; tg_[s] = task % 36;
        const int g = tg_[s];
        tcol[s] = g < 16 ? (512 + dir * 512 + h * 128 + 8 * g) : g < 32 ? (h * 128 + 8 * (g - 16)) : (1536 + h * 128 + quarter * 32 + 8 * (g - 32));
    }
    u32x4 rc[5]; int rrow = 0;
    auto load = [&](int c) {
#pragma unroll
        for (int s = 0; s < 5; ++s) {
            rc[s] = (u32x4){0u, 0u, 0u, 0u};
            if (tv[s]) { const int row = scan_row(c * 64 + tj[s], b, dir, 1); rc[s] = *(const u32x4*)(Pb + (size_t)row * LDP_ODD + tcol[s]); }
        }
        if (tid < 64) rrow = scan_row(c * 64 + tid, b, dir, 1);
    };
    auto storeA = [&]() {
#pragma unroll
        for (int s = 0; s < 5; ++s) {
            if (tv[s]) {
                float f[8]; unpack8(rc[s], f);
                const int j = tj[s], g = tg_[s];
                if (g < 16) {
                    float o[8];
#pragma unroll
                    for (int e = 0; e < 8; ++e) { const float lbv = cst[8 * g + e]; o[e] = lbv + (1.f - lbv) * sigmoidf_(f[e] + cst[128 + 8 * g + e]); }
                    LAS float* dst = (LAS float*)(lds + HC_RAWF) + j * 128 + 8 * g;
                    *(LAS f32x4*)dst = (f32x4){o[0], o[1], o[2], o[3]}; *(LAS f32x4*)(dst + 4) = (f32x4){o[4], o[5], o[6], o[7]};
                } else if (g < 32) {
                    float o[8];
#pragma unroll
                    for (int e = 0; e < 8; ++e) o[e] = siluf_(f[e]);
                    *(LAS u32x4*)(lds + HC_RAWQ + (j * 128 + 8 * (g - 16)) * 2) = pack8(o);
                } else {
                    const int v0 = 8 * (g - 32);
                    LAS char* vt = lds + HC_SUB + (j >> 4) * HS_SIZE + HS_VT;
#pragma unroll
                    for (int e = 0; e < 8; ++e) { const unsigned wv = rc[s][e >> 1]; *(LAS bf16_t*)(vt + (v0 + e) * HL_T + (j & 15) * 2) = (bf16_t)((e & 1) ? (wv >> 16) : (wv & 0xffffu)); }
                }
            }
        }
        if (tid < 64) ((LAS int*)(lds + HC_ROWS))[tid] = rrow;
    };
    auto storeB = [&]() {
        const int d = tid & 127, sb = tid >> 7;
        LAS char* st = lds + HC_SUB + sb * HS_SIZE;
        const LAS float* rf = (const LAS float*)(lds + HC_RAWF) + (sb * 16) * 128 + d;
        const LAS bf16_t* rq = (const LAS bf16_t*)(lds + HC_RAWQ) + (sb * 16) * 128 + d;
        float lam = 0.f, lams[16], kfs[16];
#pragma unroll
        for (int t = 0; t < 16; ++t) {
            const float f = rf[t * 128];
            lam += __logf(f);
            const float kf = 1.f - f;
            lams[t] = lam; kfs[t] = kf;
            *(LAS bf16_t*)(st + HS_QI + t * HL_QD + d * 2) = f2bf(bf2f(rq[t * 128]) * __expf(lam));
            *(LAS bf16_t*)(st + HS_KO + t * HL_QD + d * 2) = f2bf(kf * __expf(-lam));
        }
        float ke[16];
#pragma unroll
        for (int t = 0; t < 16; ++t) ke[t] = kfs[t] * __expf(lam - lams[t]);
        *(LAS u32x4*)(st + HS_KET + d * HL_T) = pack8(ke); *(LAS u32x4*)(st + HS_KET + d * HL_T + 16) = pack8(ke + 8);
        ((LAS float*)(st + HS_DEC))[d] = __expf(lam);
    };
    f32x4 sacc[2];
    sacc[0] = sacc[1] = (f32x4){0.f, 0.f, 0.f, 0.f};
    __syncthreads();
    load(0);
    for (int c = 0; c < NSTEPS / 64; ++c) {
        storeA();
        __syncthreads();
        storeB();
        if (c + 1 < NSTEPS / 64) load(c + 1);
        __syncthreads();
        if (wid < 4) {
            LAS char* st = lds + HC_SUB + wid * HS_SIZE;
            f32x4 acc = (f32x4){0.f, 0.f, 0.f, 0.f};
#pragma unroll
            for (int k0 = 0; k0 < 128; k0 += 32) acc = __builtin_amdgcn_mfma_f32_16x16x32_bf16(ldfrag(st + HS_KO, HL_QD, 0, k0, lane), ldfrag(st + HS_QI, HL_QD, 0, k0, lane), acc, 0, 0, 0);
#pragma unroll
            for (int j = 0; j < 4; ++j) acc[j] = (4 * q + j <= r16) ? acc[j] : 0.f;
            st4bf(st + HS_ATT + r16 * HL_T + 4 * q * 2, acc);
        }
        __syncthreads();
#pragma unroll 1
        for (int sb = 0; sb < 4; ++sb) {
            LAS char* st = lds + HC_SUB + sb * HS_SIZE;
            const LAS char* sbr = lds + HC_SB + (sb & 1) * 32 * HL_QD;
            LAS char* sbw = lds + HC_SB + ((sb + 1) & 1) * 32 * HL_QD;
            if (wid < 2) {
                f32x4 ya = __builtin_amdgcn_mfma_f32_16x16x32_bf16(ldfrag16(st + HS_VT, HL_T, wid * 16, lane), ldfrag16(st + HS_ATT, HL_T, 0, lane), (f32x4){0.f, 0.f, 0.f, 0.f}, 0, 0, 0);
#pragma unroll
                for (int k0 = 0; k0 < 128; k0 += 32) ya = __builtin_amdgcn_mfma_f32_16x16x32_bf16(ldfrag(sbr, HL_QD, wid * 16, k0, lane), ldfrag(st + HS_QI, HL_QD, 0, k0, lane), ya, 0, 0, 0);
                const int row = ((const LAS int*)(lds + HC_ROWS))[sb * 16 + r16];
                u32x2 o; o.x = pk2(ya[0], ya[1]); o.y = pk2(ya[2], ya[3]);
                *(u32x2*)(Y + (size_t)row * D + h * 128 + quarter * 32 + wid * 16 + 4 * q) = o;
            }
            {
                const int vt = wid >> 2;
                const bf16x8 vf = ldfrag16(st + HS_VT, HL_T, vt * 16, lane);
#pragma unroll
                for (int u = 0; u < 2; ++u) {
                    const int dt = (wid & 3) * 2 + u;
                    const f32x4 a = __builtin_amdgcn_mfma_f32_16x16x32_bf16(ldfrag16(st + HS_KET, HL_T, dt * 16, lane), vf, (f32x4){0.f, 0.f, 0.f, 0.f}, 0, 0, 0);
                    const f32x4 dc = *(const LAS f32x4*)((const LAS float*)(st + HS_DEC) + dt * 16 + 4 * q);
#pragma unroll
                    for (int j = 0; j < 4; ++j) sacc[u][j] = sacc[u][j] * dc[j] + a[j];
                    st4bf(sbw + (vt * 16 + r16) * HL_QD + (dt * 16 + 4 * q) * 2, sacc[u]);
                }
            }
            __syncthreads();
        }
    }
}

constexpr int RC_RAWW = 0;
constexpr int RC_RAWA = RC_RAWW + 64 * 64 * 4;
constexpr int RC_RAWB = RC_RAWA + 64 * 64 * 2, RC_RAWK = RC_RAWB + 64 * 64 * 2, RC_RAWR = RC_RAWK + 64 * 64 * 2;
constexpr int RC_SUB = RC_RAWR + 64 * 64 * 2;
constexpr int RL_C = 72 * 2, RL_32 = 40 * 2, RL_16 = 24 * 2;
constexpr int RS_AT = 0, RS_RT = RS_AT + 16 * RL_C, RS_KT = RS_RT + 16 * RL_C, RS_BT = RS_KT + 16 * RL_C, RS_KBH = RS_BT + 16 * RL_C, RS_AAK = RS_KBH + 64 * RL_32,
              RS_ARKB = RS_AAK + 16 * RL_16, RS_T = RS_ARKB + 16 * RL_32, RS_AABF = RS_T + 16 * RL_16, RS_GL = RS_AABF + 16 * 16 * 4, RS_VU = RS_GL + 256, RS_SIZE = RS_VU + 32 * RL_32;
constexpr int RC_SB = RC_SUB + 4 * RS_SIZE;
constexpr int RC_RHT = RC_SB + 32 * RL_C;
constexpr int RC_ROWS = RC_RHT + 32 * RL_16, RC_END = RC_ROWS + 256;
static_assert(RC_END <= LDS_BYTES - 16, "RWKV LDS map");
static_assert(RS_SIZE % 16 == 0 && RC_SB % 16 == 0 && RC_RHT % 16 == 0, "alignment");

__device__ __forceinline__ float allreduce8(float v) {
    v += dppmov<0xB1>(v); v += dppmov<0x4E>(v); v += dppmov<0x141>(v);
    return v;
}

__device__ __forceinline__ void phase_prep1(int wv, KP Pk, int layer) {
    asm volatile("" : "+s"(Pk));
    const CAS Params& P = *Pk;
    const int tid = ltid(wv), lane = tid & 63, wid = tid >> 6, i_ = layer >> 1;
    const bf16_t* Pb = (const bf16_t*)(P.ws + WS_P);
    bf16_t* R = (bf16_t*)(P.ws + WS_RWR); bf16_t* K = (bf16_t*)(P.ws + WS_RWK); bf16_t* V = (bf16_t*)(P.ws + WS_RWV); bf16_t* KK = (bf16_t*)(P.ws + WS_RWKK);
    bf16_t* LA = (bf16_t*)(P.ws + WS_LA);
    const float* mu = P.rw_mu + (size_t)i_ * 1856;
    float mur[8], muv[8], muk[8], mul_[8], kkw[8];
#pragma unroll
    for (int e = 0; e < 8; ++e) { mur[e] = mu[8 * lane + e]; muv[e] = mu[1024 + 8 * lane + e]; muk[e] = mu[512 + 8 * lane + e]; mul_[e] = lane < 40 ? mu[1536 + 8 * lane + e] : 0.f; kkw[e] = P.rw_k_k[i_ * 512 + 8 * lane + e]; }
    for (int r = blockIdx.x * 8 + wid; r < NROWS; r += gridDim.x * 8) {
        int rprev = -1, rnext = -1;
        if (r < NCTX) { const int t = r & 255; if (t > 0) rprev = r - 1; if (t < CTXL - 1) rnext = r + 1; }
        else {
            const int bs = (r - NCTX) >> 13, s = (r - NCTX) & 8191, sg = ((s & 63) << 7) + (s >> 6);
            if (sg > 0) { const int g2 = sg - 1; rprev = NCTX + bs * SEQ + ((g2 & 127) << 6) + (g2 >> 7); }
            if (sg < SEQ - 1) { const int g2 = sg + 1; rnext = NCTX + bs * SEQ + ((g2 & 127) << 6) + (g2 >> 7); }
        }
        const bf16_t* pc = Pb + (size_t)r * LDP_ODD + 2560;
        const bf16_t* pp = Pb + (size_t)(rprev < 0 ? r : rprev) * LDP_ODD + 2560;
        const bf16_t* pn = Pb + (size_t)(rnext < 0 ? r : rnext) * LDP_ODD + 2560;
        const float mp = rprev < 0 ? 0.f : 0.5f, mn = rnext < 0 ? 0.f : 0.5f;
        auto mix8 = [&](int col, const float* muc, float* o) {
            float fc[8], fp[8], fn[8];
            unpack8(*(const u32x4*)(pc + col), fc); unpack8(*(const u32x4*)(pp + col), fp); unpack8(*(const u32x4*)(pn + col), fn);
#pragma unroll
            for (int e = 0; e < 8; ++e) o[e] = fc[e] + muc[e] * (mp * fp[e] + mn * fn[e] - fc[e]);
        };
        float o[8];
        mix8(8 * lane, mur, o); *(u32x4*)(R + (size_t)r * 512 + 8 * lane) = pack8(o);
        mix8(1024 + 8 * lane, muv, o); *(u32x4*)(V + (size_t)r * 512 + 8 * lane) = pack8(o);
        mix8(512 + 8 * lane, muk, o); *(u32x4*)(K + (size_t)r * 512 + 8 * lane) = pack8(o);
        {
            float kk[8], ss = 0.f;
#pragma unroll
            for (int e = 0; e < 8; ++e) { kk[e] = o[e] * kkw[e]; ss += kk[e] * kk[e]; }
            ss = group_sum<8>(ss);
            const float rn = rsqrtf(fmaxf(ss, 1e-12f));
#pragma unroll
            for (int e = 0; e < 8; ++e) kk[e] *= rn;
            *(u32x4*)(KK + (size_t)r * 512 + 8 * lane) = pack8(kk);
        }
        if (lane < 40) {
            mix8(1536 + 8 * lane, mul_, o);
            if (lane < 16) {
#pragma unroll
                for (int e = 0; e < 8; ++e) o[e] = tanh_fast(o[e]);
            } else if (lane >= 24) {
#pragma unroll
                for (int e = 0; e < 8; ++e) o[e] = sigmoidf_(o[e]);
            }
            *(u32x4*)(LA + (size_t)r * 320 + 8 * lane) = pack8(o);
        }
    }
}

__device__ __forceinline__ void phase_out_even(int wv, KP Pk, int layer) {
    asm volatile("" : "+s"(Pk));
    const CAS Params& P = *Pk;
    const int tid = ltid(wv), lane = tid & 63, wid = tid >> 6, i_ = layer >> 1;
    const bf16_t* Pb = (const bf16_t*)(P.ws + WS_P);
    const bf16_t* Yf = (const bf16_t*)(P.ws + WS_YF); const bf16_t* Yb = (const bf16_t*)(P.ws + WS_YB);
    bf16_t* feat = (bf16_t*)(P.ws + WS_FEAT);
    const int r0 = (layer == DEPTH - 1) ? NCTX : 0;
    const bf16_t* XBC = (const bf16_t*)(P.ws + WS_EXBC);
    float nwa[8], nwb[8];
#pragma unroll
    for (int e = 0; e < 8; ++e) { nwa[e] = P.ssd_norm_w[i_ * 512 + 8 * lane + e]; nwb[e] = P.ml_norm_w[i_ * 512 + 8 * lane + e]; }
    const float dsk = P.ssd_d[i_ * 8 + (lane >> 3)];
    for (int r = r0 + blockIdx.x * 8 + wid; r < NROWS; r += gridDim.x * 8) {
        const bf16_t* pr = Pb + (size_t)r * LDP_EVEN;
        float y[8];
        {
            float a[8], bb[8], xsv[8], z[8];
            unpack8(*(const u32x4*)(Yf + (size_t)r * D + 8 * lane), a); unpack8(*(const u32x4*)(Yb + (size_t)r * D + 8 * lane), bb);
            unpack8(*(const u32x4*)(XBC + (size_t)r * 768 + 8 * lane), xsv); unpack8(*(const u32x4*)(pr + 8 * lane), z);
            float ss = 0.f;
#pragma unroll
            for (int e = 0; e < 8; ++e) {
                y[e] = (a[e] + bb[e] + dsk * xsv[e]) * siluf_(z[e]); ss += y[e] * y[e];
            }
            ss = wave_sum(ss);
            const float rn = rsqrtf(ss * (1.f / 512.f) + 1e-6f);
#pragma unroll
            for (int e = 0; e < 8; ++e) y[e] = y[e] * rn * nwa[e];
            *(u32x4*)(feat + (size_t)r * D + 8 * lane) = pack8(y);
        }
        {
            float a[8], bb[8], o[8];
            unpack8(*(const u32x4*)(Yf + (size_t)r * D + 512 + 8 * lane), a); unpack8(*(const u32x4*)(Yb + (size_t)r * D + 512 + 8 * lane), bb);
            unpack8(*(const u32x4*)(pr + 2320 + 8 * lane), o);
            float s = 0.f;
#pragma unroll
            for (int e = 0; e < 8; ++e) { y[e] = a[e] + bb[e]; s += y[e]; }
            const float mean = group_sum<16>(s) * (1.f / 128.f);
            float ss = 0.f;
#pragma unroll
            for (int e = 0; e < 8; ++e) { y[e] -= mean; ss += y[e] * y[e]; }
            const float rn = rsqrtf(group_sum<16>(ss) * (1.f / 128.f) + 1e-6f);
#pragma unroll
            for (int e = 0; e < 8; ++e) y[e] = sigmoidf_(o[e]) * (y[e] * rn) * nwb[e];
            *(u32x4*)(feat + (size_t)r * D + 512 + 8 * lane) = pack8(y);
        }
    }
}
__device__ __forceinline__ void phase_out_odd(int wv, KP Pk, int layer) {
    asm volatile("" : "+s"(Pk));
    const CAS Params& P = *Pk;
    const int tid = ltid(wv), lane = tid & 63, wid = tid >> 6, i_ = layer >> 1;
    const bf16_t* Pb = (const bf16_t*)(P.ws + WS_P);
    const bf16_t* Yf = (const bf16_t*)(P.ws + WS_YF); const bf16_t* Yb = (const bf16_t*)(P.ws + WS_YB);
    const bf16_t* R = (const bf16_t*)(P.ws + WS_RWR); const bf16_t* K = (const bf16_t*)(P.ws + WS_RWK); const bf16_t* V = (const bf16_t*)(P.ws + WS_RWV); const bf16_t* G = (const bf16_t*)(P.ws + WS_RWG);
    bf16_t* feat = (bf16_t*)(P.ws + WS_FEAT);
    const int r0 = (layer == DEPTH - 1) ? NCTX : 0;
    float nwc[8], rk[8], lw[8], lbv[8];
#pragma unroll
    for (int e = 0; e < 8; ++e) {
        nwc[e] = P.hg_norm_w[i_ * 512 + 8 * lane + e]; rk[e] = P.rw_r_k[i_ * 512 + 8 * lane + e];
        lw[e] = P.rw_ln_w[i_ * 512 + 8 * lane + e]; lbv[e] = P.rw_ln_b[i_ * 512 + 8 * lane + e];
    }
    for (int r = r0 + blockIdx.x * 8 + wid; r < NROWS; r += gridDim.x * 8) {
        float y[8];
        {
            float a[8], bb[8], g[8];
            unpack8(*(const u32x4*)(Yf + (size_t)r * D + 8 * lane), a); unpack8(*(const u32x4*)(Yb + (size_t)r * D + 8 * lane), bb);
            unpack8(*(const u32x4*)(Pb + (size_t)r * LDP_ODD + 2048 + 8 * lane), g);
            float ss = 0.f;
#pragma unroll
            for (int e = 0; e < 8; ++e) { y[e] = a[e] + bb[e]; ss += y[e] * y[e]; }
            const float rn = rsqrtf(group_sum<16>(ss) * (1.f / 128.f) + 1e-6f);
#pragma unroll
            for (int e = 0; e < 8; ++e) y[e] = y[e] * rn * nwc[e] * siluf_(g[e]);
            *(u32x4*)(feat + (size_t)r * D + 8 * lane) = pack8(y);
        }
        {
            float a[8], bb[8], rr[8], kk[8], vv[8], g[8];
            unpack8(*(const u32x4*)(Yf + (size_t)r * D + 512 + 8 * lane), a); unpack8(*(const u32x4*)(Yb + (size_t)r * D + 512 + 8 * lane), bb);
            unpack8(*(const u32x4*)(R + (size_t)r * 512 + 8 * lane), rr); unpack8(*(const u32x4*)(K + (size_t)r * 512 + 8 * lane), kk);
            unpack8(*(const u32x4*)(V + (size_t)r * 512 + 8 * lane), vv); unpack8(*(const u32x4*)(G + (size_t)r * 512 + 8 * lane), g);
            float s = 0.f, bs = 0.f;
#pragma unroll
            for (int e = 0; e < 8; ++e) { y[e] = a[e] + bb[e]; s += y[e]; bs += rr[e] * kk[e] * rk[e]; }
            const float mean = group_sum<8>(s) * (1.f / 64.f); bs = group_sum<8>(bs);
            float ss = 0.f;
#pragma unroll
            for (int e = 0; e < 8; ++e) { y[e] -= mean; ss += y[e] * y[e]; }
            const float rn = rsqrtf(group_sum<8>(ss) * (1.f / 64.f) + 64e-5f);
#pragma unroll
            for (int e = 0; e < 8; ++e) y[e] = (y[e] * rn * lw[e] + lbv[e] + bs * vv[e]) * g[e];
            *(u32x4*)(feat + (size_t)r * D + 512 + 8 * lane) = pack8(y);
        }
    }
}

#ifndef MK_DOUBLE
#define MK_DOUBLE 0
#endif
#define REP(bit, body) do { body; if (MK_DOUBLE & (bit)) { body; } } while (0)
__device__ __forceinline__ void phase_expconv(int wv, KP Pk, int layer, LAS char* lds) {
    asm volatile("" : "+s"(Pk));
    const CAS Params& P = *Pk;
    const int tid = ltid(wv);
    expconv_items(P, layer, lds, exc_s0(layer) + exc_s1(layer), EXC_ITEMS, (int)blockIdx.x * 8 + (tid >> 6), (int)gridDim.x * 8, tid >> 6, tid & 63);
}
constexpr int L1_AST = 1028;
constexpr int L1_PST = 33;
constexpr int L1_A = 0, L1_PART = L1_A + 16 * L1_AST * 4, L1_SM = L1_PART + 8 * 16 * L1_PST * 4, L1_END = L1_SM + (64 + 2 * 144 + 32) * 4;
static_assert(L1_END <= LDS_BYTES - 16, "LN1 LDS map");
__device__ __forceinline__ void phase_ln1(int wv, KP Pk, int layer, LAS char* lds, bool dry = false) {
    asm volatile("" : "+s"(Pk));
    const CAS Params& P = *Pk;
    const int tid = ltid(wv), lane = tid & 63;
    if (!dry) REP(8, phase_expconv(wv, Pk, layer, lds));
    __syncthreads();
    LAS float* At = (LAS float*)(lds + L1_A);
    LAS float* part = (LAS float*)(lds + L1_PART);
    LAS int* lcnt = (LAS int*)(lds + L1_SM);
    LAS int* lbase = lcnt + 32;
    LAS int* asg = lcnt + 64;
    LAS float* rbias = (LAS float*)(asg + 2 * 144);
    if (tid < 32) { lcnt[tid] = 0; rbias[tid] = P.router_bias[tid]; }
    float breg[8][4][2];
    {
        const float* rw = P.router_w + (size_t)(128 * wv + 4 * (lane >> 4)) * NEXP + (lane & 15);
#pragma unroll
        for (int j = 0; j < 8; ++j)
#pragma unroll
            for (int i = 0; i < 4; ++i) { breg[j][i][0] = rw[(16 * j + i) * NEXP]; breg[j][i][1] = rw[(16 * j + i) * NEXP + 16]; }
    }
    __syncthreads();
    const bf16_t* yo = (const bf16_t*)(P.ws + WS_YO);
    bf16_t* act = (bf16_t*)(P.ws + (dry ? WS_FEAT : WS_ACT));
    bf16_t* xcb = (bf16_t*)(P.ws + WS_XC); bf16_t* xob = (bf16_t*)P.out;
    const bool lastl = (layer == DEPTH - 1);
    int* cnt = (int*)(P.ws + WS_CNT) + layer * 32 * CNT_STRIDE;
    int* list = (int*)(P.ws + WS_LIST);
    float* wts = (float*)(P.ws + WS_WTS);
    const float* lg = P.ln_g + (size_t)(layer * 2 + 0) * D; const float* lb = P.ln_b + (size_t)(layer * 2 + 0) * D;
    const int r0 = (layer == DEPTH - 1) ? NCTX : 0, ntiles = (NROWS - r0) / 16, G = gridDim.x;
    f32x4 g1v[4], s2c[4], h2c[4];
#pragma unroll
    for (int i = 0; i < 4; ++i) g1v[i] = s2c[i] = h2c[i] = (f32x4){0.f, 0.f, 0.f, 0.f};
    int mcur = -1;
    f32x4 nx[2][4]; u32x2 nyo[2][4];
    auto fetch = [&](int s, int rr) {
        if (layer == 0) {
            const float* xq = rr < NCTX ? P.ctx + (size_t)rr * D : P.x + (size_t)(rr - NCTX) * D;
#pragma unroll
            for (int i = 0; i < 4; ++i) nx[s][i] = *(const f32x4*)(xq + 4 * lane + 256 * i);
        } else {
            const bf16_t* xq = rr < NCTX ? xcb + (size_t)rr * D : xob + (size_t)(rr - NCTX) * D;
#pragma unroll
            for (int i = 0; i < 4; ++i) { const u32x2 t = *(const u32x2*)(xq + 4 * lane + 256 * i); nx[s][i] = (f32x4){__uint_as_float(t.x), __uint_as_float(t.y), 0.f, 0.f}; }
        }
#pragma unroll
        for (int i = 0; i < 4; ++i) { const int c = 4 * lane + 256 * i; nyo[s][i] = *(const u32x2*)(yo + (size_t)rr * D + c); }
    };
    int tile = blockIdx.x;
    if (tile < ntiles) { fetch(0, r0 + tile * 16 + 2 * wv); fetch(1, r0 + tile * 16 + 2 * wv + 1); }
    for (int it = 0; tile < ntiles; ++it, tile += G) {
        const int rb = r0 + tile * 16 + 2 * wv;
        const int m = row_mod(rb);
        if (m != mcur) {
            mcur = m;
            const float* g1 = modvec(P.ws, layer, m, 2); const float* sh2 = modvec(P.ws, layer, m, 3); const float* sc2 = modvec(P.ws, layer, m, 4);
#pragma unroll
            for (int i = 0; i < 4; ++i) { const int c = 4 * lane + 256 * i; g1v[i] = *(const f32x4*)(g1 + c); s2c[i] = *(const f32x4*)(sc2 + c); h2c[i] = *(const f32x4*)(sh2 + c); }
        }
#pragma unroll
        for (int s = 0; s < 2; ++s) {
            const int r = rb + s;
            bf16_t* xr = dry ? (bf16_t*)(P.ws + WS_YF) + (size_t)r * D : lastl ? (bf16_t*)(P.ws + WS_FEAT) + (size_t)r * D : r < NCTX ? xcb + (size_t)r * D : xob + (size_t)(r - NCTX) * D;
            f32x4 v[4]; float sm = 0.f;
#pragma unroll
            for (int i = 0; i < 4; ++i) {
                f32x4 xv = nx[s][i]; const f32x4 gv = g1v[i]; const u32x2 yv = nyo[s][i];
                if (layer != 0) { const unsigned b0 = __float_as_uint(xv[0]), b1 = __float_as_uint(xv[1]); xv = (f32x4){bflo(b0), bfhi(b0), bflo(b1), bfhi(b1)}; }
                v[i][0] = ALPHA * xv[0] + gv[0] * bflo(yv.x); v[i][1] = ALPHA * xv[1] + gv[1] * bfhi(yv.x);
                v[i][2] = ALPHA * xv[2] + gv[2] * bflo(yv.y); v[i][3] = ALPHA * xv[3] + gv[3] * bfhi(yv.y);
                sm += (v[i][0] + v[i][1]) + (v[i][2] + v[i][3]);
            }
            if (tile + G < ntiles) fetch(s, r + G * 16);
            const float mean = wave_sum(sm) * (1.f / D);
            float s2 = 0.f;
#pragma unroll
            for (int i = 0; i < 4; ++i) { v[i] = v[i] - mean; s2 += (v[i][0] * v[i][0] + v[i][1] * v[i][1]) + (v[i][2] * v[i][2] + v[i][3] * v[i][3]); }
            const float rstd = rsqrtf(wave_sum(s2) * (1.f / D) + 1e-5f);
            LAS float* arow = At + (2 * wv + s) * L1_AST;
#pragma unroll
            for (int i = 0; i < 4; ++i) {
                const int c = 4 * lane + 256 * i;
                const f32x4 gg = *(const f32x4*)(lg + c), bb = *(const f32x4*)(lb + c), s2v = s2c[i], h2v = h2c[i];
                f32x4 xn, hv;
#pragma unroll
                for (int j = 0; j < 4; ++j) { xn[j] = v[i][j] * rstd * gg[j] + bb[j]; hv[j] = xn[j] * (1.f + s2v[j]) + h2v[j]; }
                { u32x2 ox; ox.x = pk2(xn[0], xn[1]); ox.y = pk2(xn[2], xn[3]); *(u32x2*)(xr + c) = ox; }
                u32x2 o; o.x = pk2(hv[0], hv[1]); o.y = pk2(hv[2], hv[3]); *(u32x2*)(act + (size_t)r * D + c) = o;
                *(LAS f32x4*)(arow + c) = hv;
            }
        }
        __syncthreads();
        {
            f32x4 ra0 = (f32x4){0.f, 0.f, 0.f, 0.f}, ra1 = ra0;
            const LAS float* ap = At + (lane & 15) * L1_AST + 128 * wv + 4 * (lane >> 4);
#pragma unroll
            for (int j = 0; j < 8; ++j) {
                const f32x4 a4 = *(const LAS f32x4*)(ap + 16 * j);
#pragma unroll
                for (int i = 0; i < 4; ++i) {
                    ra0 = __builtin_amdgcn_mfma_f32_16x16x4f32(a4[i], breg[j][i][0], ra0, 0, 0, 0);
                    ra1 = __builtin_amdgcn_mfma_f32_16x16x4f32(a4[i], breg[j][i][1], ra1, 0, 0, 0);
                }
            }
            LAS float* pw = part + wv * 16 * L1_PST + (4 * (lane >> 4)) * L1_PST + (lane & 15);
#pragma unroll
            for (int j = 0; j < 4; ++j) { pw[j * L1_PST] = ra0[j]; pw[j * L1_PST + 16] = ra1[j]; }
        }
        __syncthreads();
        {
            const int half = lane >> 5, e = lane & 31;
            const LAS float* pp = part + (2 * wv + half) * L1_PST + e;
            float sc_ = 0.f;
#pragma unroll
            for (int k = 0; k < 8; ++k) sc_ += pp[k * 16 * L1_PST];
            const float sg = sigmoidf_(sc_), vb = sg + rbias[e];
            float bv[4], sv[4];
            bv[0] = dppmov<0x00>(vb); bv[1] = dppmov<0x55>(vb); bv[2] = dppmov<0xAA>(vb); bv[3] = dppmov<0xFF>(vb);
            sv[0] = dppmov<0x00>(sg); sv[1] = dppmov<0x55>(sg); sv[2] = dppmov<0xAA>(sg); sv[3] = dppmov<0xFF>(sg);
            float m1 = -1e30f, m2 = -1e30f;
#pragma unroll
            for (int k = 0; k < 4; ++k) { const float vsc = bv[k]; if (vsc > m1) { m2 = m1; m1 = vsc; } else if (vsc > m2) m2 = vsc; }
            float best = m1 + m2; int bg = e >> 2;
#pragma unroll
            for (int msk = 4; msk <= 16; msk <<= 1) {
                const float ob = __shfl_xor(best, msk); const int og = __shfl_xor(bg, msk);
                const bool take = (ob > best) || (ob == best && og < bg);
                best = take ? ob : best; bg = take ? og : bg;
            }
            int i1 = 0; float b1 = bv[0];
#pragma unroll
            for (int k = 1; k < 4; ++k) if (bv[k] > b1) { b1 = bv[k]; i1 = k; }
            int i2 = -1; float b2 = -1e30f;
#pragma unroll
            for (int k = 0; k < 4; ++k) if (k != i1 && bv[k] > b2) { b2 = bv[k]; i2 = k; }
            float s1 = sv[0], s2s = sv[0];
#pragma unroll
            for (int k = 1; k < 4; ++k) { if (i1 == k) s1 = sv[k]; if (i2 == k) s2s = sv[k]; }
            if (e == 4 * bg && !dry) {
                const int r = rb + half;
                const int e0 = bg * 4 + i1, e1 = bg * 4 + i2;
                const float inv = 1.f / (s1 + s2s);
                const int li = it * 16 + 2 * wv + half;
                const int p0 = __hip_atomic_fetch_add(&lcnt[e0], 1, __ATOMIC_RELAXED, __HIP_MEMORY_SCOPE_WORKGROUP);
                const int p1 = __hip_atomic_fetch_add(&lcnt[e1], 1, __ATOMIC_RELAXED, __HIP_MEMORY_SCOPE_WORKGROUP);
                asg[2 * li] = (e0 << 16) | p0; asg[2 * li + 1] = (e1 << 16) | p1;
                wts[2 * r] = s1 * inv; wts[2 * r + 1] = s2s * inv;
            }
        }
    }
    __syncthreads();
    if (dry) return;
    if (tid < 32) lbase[tid] = atomicAdd(&cnt[tid * CNT_STRIDE], lcnt[tid]);
    __syncthreads();
    for (int idx = tid; idx < 2 * 144; idx += NT) {
        const int li = idx >> 1, k = idx & 1, t = (li >> 4) * G + blockIdx.x;
        if (t < ntiles) { const int r = r0 + t * 16 + (li & 15); const int v = asg[idx], e = v >> 16, lp = v & 0xffff; list[(size_t)e * LISTCAP + lbase[e] + lp] = 2 * r + k; }
    }
}

__device__ __forceinline__ void phase_ln2(int wv, KP Pk, int layer, bool dry = false) {
    asm volatile("" : "+s"(Pk));
    const CAS Params& P = *Pk;
    const int tid = ltid(wv), lane = tid & 63, wid = tid >> 6;
    const bf16_t* yp = (const bf16_t*)(P.ws + WS_YP);
    const float* wts = (const float*)(P.ws + WS_WTS);
    bf16_t* act = (bf16_t*)(P.ws + (dry ? WS_FEAT : WS_ACT));
    bf16_t* xcb = (bf16_t*)(P.ws + WS_XC); bf16_t* xob = (bf16_t*)P.out;
    const float* lg = P.ln_g + (size_t)(layer * 2 + 1) * D; const float* lb = P.ln_b + (size_t)(layer * 2 + 1) * D;
    const bool last = (layer == DEPTH - 1);
    const int r0 = last ? NCTX : 0, stride = gridDim.x * 8;
    f32x4 cg[4], cb[4], g2v[4], s1v[4], h1v[4];
#pragma unroll
    for (int i = 0; i < 4; ++i) { cg[i] = *(const f32x4*)(lg + 4 * lane + 256 * i); cb[i] = *(const f32x4*)(lb + 4 * lane + 256 * i); g2v[i] = s1v[i] = h1v[i] = (f32x4){0.f, 0.f, 0.f, 0.f}; }
    int mcur = -1;
    u32x2 nx[4]; u32x2 ny0[4], ny1[4]; float nw0 = 0.f, nw1 = 0.f;
    auto fetch = [&](int r) {
        const bf16_t* xr = last ? (const bf16_t*)(P.ws + WS_FEAT) + (size_t)r * D : r < NCTX ? xcb + (size_t)r * D : xob + (size_t)(r - NCTX) * D;
#pragma unroll
        for (int i = 0; i < 4; ++i) {
            const int c = 4 * lane + 256 * i;
            nx[i] = *(const u32x2*)(xr + c); ny0[i] = *(const u32x2*)(yp + (size_t)(2 * r) * D + c); ny1[i] = *(const u32x2*)(yp + (size_t)(2 * r + 1) * D + c);
        }
        nw0 = wts[2 * r]; nw1 = wts[2 * r + 1];
    };
    int r = r0 + blockIdx.x * 8 + wid;
    if (r < NROWS) fetch(r);
    for (; r < NROWS; r += stride) {
        const int m = row_mod(r);
        if (m != mcur) {
            mcur = m;
            const float* g2 = modvec(P.ws, layer, m, 5); const float* sh1 = last ? lg : modvec(P.ws, layer + 1, m, 0); const float* sc1 = last ? lg : modvec(P.ws, layer + 1, m, 1);
#pragma unroll
            for (int i = 0; i < 4; ++i) { const int c = 4 * lane + 256 * i; g2v[i] = *(const f32x4*)(g2 + c); s1v[i] = *(const f32x4*)(sc1 + c); h1v[i] = *(const f32x4*)(sh1 + c); }
        }
        f32x4 v[4]; float s = 0.f;
        const float w0 = nw0, w1 = nw1;
#pragma unroll
        for (int i = 0; i < 4; ++i) {
            const f32x4 xv = (f32x4){bflo(nx[i].x), bfhi(nx[i].x), bflo(nx[i].y), bfhi(nx[i].y)}, gv = g2v[i]; const u32x2 y0 = ny0[i], y1 = ny1[i];
            v[i][0] = ALPHA * xv[0] + gv[0] * (w0 * bflo(y0.x) + w1 * bflo(y1.x)); v[i][1] = ALPHA * xv[1] + gv[1] * (w0 * bfhi(y0.x) + w1 * bfhi(y1.x));
            v[i][2] = ALPHA * xv[2] + gv[2] * (w0 * bflo(y0.y) + w1 * bflo(y1.y)); v[i][3] = ALPHA * xv[3] + gv[3] * (w0 * bfhi(y0.y) + w1 * bfhi(y1.y));
            s += (v[i][0] + v[i][1]) + (v[i][2] + v[i][3]);
        }
        if (r + stride < NROWS) fetch(r + stride);
        const float mean = wave_sum(s) * (1.f / D);
        float s2 = 0.f;
#pragma unroll
        for (int i = 0; i < 4; ++i) { v[i] = v[i] - mean; s2 += (v[i][0] * v[i][0] + v[i][1] * v[i][1]) + (v[i][2] * v[i][2] + v[i][3] * v[i][3]); }
        const float rstd = rsqrtf(wave_sum(s2) * (1.f / D) + 1e-5f);
#pragma unroll
        for (int i = 0; i < 4; ++i) {
            const int c = 4 * lane + 256 * i;
            f32x4 xn;
#pragma unroll
            for (int j = 0; j < 4; ++j) xn[j] = v[i][j] * rstd * cg[i][j] + cb[i][j];
            if (dry) *(f32x4*)((float*)(P.ws + WS_YF) + (size_t)r * D + c) = xn;
            else if (last) *(f32x4*)(P.out + (size_t)(r - NCTX) * D + c) = xn;
            else { u32x2 ox; ox.x = pk2(xn[0], xn[1]); ox.y = pk2(xn[2], xn[3]); *(u32x2*)((r < NCTX ? xcb + (size_t)r * D : xob + (size_t)(r - NCTX) * D) + c) = ox; }
            if (!last) {
                u32x2 o; o.x = pk2(xn[0] * (1.f + s1v[i][0]) + h1v[i][0], xn[1] * (1.f + s1v[i][1]) + h1v[i][1]); o.y = pk2(xn[2] * (1.f + s1v[i][2]) + h1v[i][2], xn[3] * (1.f + s1v[i][3]) + h1v[i][3]);
                *(u32x2*)(act + (size_t)r * D + c) = o;
            }
        }
    }
}

constexpr int NPHASE = 2 + 11 * DEPTH;
__global__ void __launch_bounds__(NT, 2) fwd_kernel(Params P) {
    extern __shared__ __attribute__((aligned(16))) char lds_raw[];
    LAS char* lds = (LAS char*)lds_raw;
    volatile LAS unsigned* xbw = (volatile LAS unsigned*)(lds + LDS_BYTES - 16);
    KP Pk = (KP)__builtin_amdgcn_kernarg_segment_ptr();
    const int wv = __builtin_amdgcn_readfirstlane((int)(threadIdx.x >> 6));
    const bool multi = (P.ph_hi - P.ph_lo) > 1;
    XcdBarrier bar; bar.bar = (unsigned*)(P.ws + WS_BAR); bar.x = 0; bar.st = xbw;
    if (multi) {
        if (ltid(wv) == 0) { xbw[0] = 0u; xbw[1] = 0u; xbw[2] = 0u; xbw[3] = 0u; }
        __syncthreads();
        bar = xcd_barrier_post(wv, (unsigned*)(P.ws + WS_BAR), xbw);
    }
#define PHASE(id, body) do { if (P.ph_lo <= (id) && (id) < P.ph_hi) { body; if ((id) + 1 < P.ph_hi) xcd_barrier(wv, bar); if (MK_DOUBLE & 2048) xcd_barrier(wv, bar); } } while (0)
    PHASE(0, REP(16, phase_prologue0(wv, Pk, lds)));
    PHASE(1, REP(16, phase_prologue1(wv, Pk)));
    for (int l = 0; l < DEPTH; ++l) {
        const int pb = 2 + 11 * l, odd = l & 1;
        PHASE(pb + 0, REP(1, phase_inproj(wv, Pk, l, lds)));
        if (odd) {
            PHASE(pb + 1, REP(4, phase_prep1(wv, Pk, l)));
            PHASE(pb + 2, phase_prep2(wv, Pk, l, lds));
            PHASE(pb + 3, REP(32, { if (blockIdx.x < 128) REP(64, scan_hgrn_c(wv, Pk, l, blockIdx.x, lds)); else if (blockIdx.x < 256) REP(128, scan_rwkv(wv, Pk, l, blockIdx.x - 128, lds)); }));
            PHASE(pb + 5, REP(4, phase_out_odd(wv, Pk, l)));
        } else {
            PHASE(pb + 1, REP(4, phase_prep_even(wv, Pk, l)));
            PHASE(pb + 2, REP(2, phase_ex1(wv, Pk, l, lds)));
            PHASE(pb + 3, phase_ex2(wv, Pk, l));
            PHASE(pb + 4, REP(2, phase_ex3(wv, Pk, l, lds)));
            PHASE(pb + 5, REP(4, phase_out_even(wv, Pk, l)));
        }
        PHASE(pb + 6, REP(256, phase_outproj(wv, Pk, l, lds)));
        PHASE(pb + 7, { if (MK_DOUBLE & 4096) phase_ln1(wv, Pk, l, lds, true); phase_ln1(wv, Pk, l, lds); });
        PHASE(pb + 8, REP(512, phase_moe1(wv, Pk, l, lds)));
        PHASE(pb + 9, REP(1024, phase_moe2(wv, Pk, l, lds)));
        PHASE(pb + 10, { if (MK_DOUBLE & 8192) phase_ln2(wv, Pk, l, true); phase_ln2(wv, Pk, l); });
    }
#undef PHASE
}


#ifndef MK_STOP
#define MK_STOP NPHASE
#endif
#ifndef MK_DUMP
#define MK_DUMP 0
#endif
#ifndef MK_DUMP_N
#define MK_DUMP_N (1u << 30)
#endif
#ifndef MK_DUMP_LD
#define MK_DUMP_LD 1024
#endif
#ifndef MK_DUMP_C0
#define MK_DUMP_C0 0
#endif
__global__ void diff_kernel(const bf16_t* a, const bf16_t* b, float* out, size_t n) {
    for (size_t i = (size_t)blockIdx.x * blockDim.x + threadIdx.x; i < n; i += (size_t)gridDim.x * blockDim.x) out[i] = 1e6f * (bf2f(a[i]) - bf2f(b[i]));
}
__global__ void dump_kernel(const bf16_t* src, float* out, size_t n) {
    for (size_t i = (size_t)blockIdx.x * blockDim.x + threadIdx.x; i < n; i += (size_t)gridDim.x * blockDim.x) out[i] = i < (size_t)MK_DUMP_N ? bf2f(src[(i >> 10) * MK_DUMP_LD + MK_DUMP_C0 + (i & 1023)]) : 0.f;
}
extern "C" void kernel_launch(void* const* d_in, const int* in_sizes, int n_in, void* d_out, int out_size, void* d_ws, size_t ws_size, hipStream_t stream) {
    static int ready = 0;
    if (ready == 0) {
        ready = 1;
        if (n_in != 42 || out_size != NB * SEQ * D || ws_size < WS_END) { fprintf(stderr, "kernel_launch: unexpected shapes (n_in %d out %d ws %zu need %zu)\n", n_in, out_size, ws_size, (size_t)WS_END); ready = -1; }
        if (hipFuncSetAttribute((const void*)fwd_kernel, hipFuncAttributeMaxDynamicSharedMemorySize, LDS_BYTES) != hipSuccess) { fprintf(stderr, "kernel_launch: hipFuncSetAttribute failed\n"); ready = -1; }
    }
    if (ready < 0) return;
    (void)in_sizes;
    hipMemsetAsync((char*)d_ws + WS_BAR, 0, WS_ZERO_BYTES, stream);
    Params p;
    memset(&p, 0, sizeof(p));
    const float** fp = (const float**)&p;
    for (int i = 0; i < 42; ++i) fp[i] = (const float*)d_in[i];
    p.out = (float*)d_out; p.ws = (unsigned char*)d_ws;
#if MK_PER_PHASE
    for (int ph = 0; ph < MK_STOP; ++ph) {
        const int local = ph < 2 ? -1 : (ph - 2) % 11, layer = ph < 2 ? 0 : (ph - 2) / 11;
        if (local == 4 && (layer & 1)) continue;
        p.ph_lo = ph; p.ph_hi = ph + 1;
        hipLaunchKernelGGL(fwd_kernel, dim3(256), dim3(NT), LDS_BYTES, stream, p);
    }
#ifdef MK_DIFF
    p.ph_lo = 7; p.ph_hi = 8; p.dbg = 1;
    hipLaunchKernelGGL(fwd_kernel, dim3(256), dim3(NT), LDS_BYTES, stream, p);
    hipLaunchKernelGGL(diff_kernel, dim3(1024), dim3(256), 0, stream, (const bf16_t*)((unsigned char*)d_ws + WS_YO), (const bf16_t*)((unsigned char*)d_ws + WS_HID), (float*)d_out, (size_t)NB * SEQ * D);
#else
    if (MK_DUMP) hipLaunchKernelGGL(dump_kernel, dim3(1024), dim3(256), 0, stream, (const bf16_t*)((unsigned char*)d_ws + (size_t)MK_DUMP), (float*)d_out, (size_t)NB * SEQ * D);
#endif
#else
    p.ph_lo = 0; p.ph_hi = NPHASE;
    hipLaunchKernelGGL(fwd_kernel, dim3(256), dim3(NT), LDS_BYTES, stream, p);
#endif
}
```

```cpp
#include <hip/hip_runtime.h>
#include <stdint.h>
#include <stdio.h>
#include <string.h>

#ifndef MK_PER_PHASE
#define MK_PER_PHASE 0
#endif

typedef unsigned short bf16_t;
typedef short bf16x8 __attribute__((ext_vector_type(8)));
typedef float f32x4 __attribute__((ext_vector_type(4)));
typedef unsigned u32x4 __attribute__((ext_vector_type(4)));
typedef unsigned u32x2 __attribute__((ext_vector_type(2)));
#define LAS __attribute__((address_space(3)))
#define CAS __attribute__((address_space(4)))

constexpr int D = 1024, NB = 4, SEQ = 8192, CTXL = 256, DEPTH = 4;
constexpr int NCTX = NB * CTXL;
constexpr int NROWS = NCTX + NB * SEQ;
constexpr int P_EVEN = 2848, P_ODD = 4416, LDP_EVEN = 3072, LDP_ODD = 4608;
constexpr int NEXP = 32, DEXP = 512, LISTCAP = NROWS;
constexpr float ALPHA = 1.681792830507429f;
constexpr int NT = 512;
constexpr int TCH = 32;
constexpr int NSTEPS = CTXL + SEQ;
constexpr int LDS_BYTES = 160 * 1024;

constexpr size_t al256(size_t x) { return (x + 255) & ~(size_t)255; }
constexpr size_t WS_BAR = 0;
constexpr size_t WS_CNT = 16384;
constexpr int CNT_STRIDE = 64;
constexpr size_t WS_ZERO_BYTES = 16384 + (size_t)4 * 32 * CNT_STRIDE * 4;
constexpr size_t WS_MODV = al256(WS_ZERO_BYTES);
constexpr size_t WS_LB = WS_MODV + al256((size_t)4 * 5 * 6144 * 4);
constexpr size_t WS_XC = WS_LB + al256(4 * 512 * 4);
constexpr size_t WS_WTS = WS_XC + (size_t)NCTX * D * 4;
constexpr size_t WS_LIST = WS_WTS + al256((size_t)2 * NROWS * 4);
constexpr size_t WS_WINT = WS_LIST + al256((size_t)NEXP * LISTCAP * 4);
constexpr size_t WINT_L0 = 0, WINT_L1 = (size_t)LDP_EVEN * D, WINT_L2 = WINT_L1 + (size_t)LDP_ODD * D, WINT_L3 = WINT_L2 + (size_t)LDP_EVEN * D, WINT_END = WINT_L3 + (size_t)LDP_ODD * D;
constexpr size_t WS_WOUTT = WS_WINT + WINT_END * 2;
constexpr size_t WS_LORAT = WS_WOUTT + (size_t)4 * D * D * 2;
constexpr size_t LORA_PER = (size_t)512 * 320;
constexpr size_t WS_EXPGU = WS_LORAT + al256(2 * LORA_PER * 2);
constexpr size_t WS_EXPD = WS_EXPGU + (size_t)NEXP * 1024 * 1024 * 2;
constexpr size_t WS_ACT = WS_EXPD + (size_t)NEXP * 1024 * 512 * 2;
constexpr size_t ROWB = (size_t)NROWS * D * 2;
constexpr size_t WS_FEAT = WS_ACT + ROWB;
constexpr size_t WS_YF = WS_FEAT + ROWB;
constexpr size_t WS_YB = WS_YF + ROWB;
constexpr size_t WS_P = WS_YB + ROWB;
constexpr size_t P_BYTES = (size_t)NROWS * LDP_ODD * 2;
constexpr size_t WS_YO = WS_P;
constexpr size_t WS_HID = WS_P + ROWB;
constexpr size_t WS_YP = WS_HID + ROWB;
static_assert(WS_YP + 2 * ROWB <= WS_P + P_BYTES, "MoE buffers must fit in the P region");
constexpr size_t HALFB = (size_t)NROWS * 512 * 2;
constexpr size_t WS_RWR = WS_P + P_BYTES;
constexpr size_t WS_RWK = WS_RWR + HALFB;
constexpr size_t WS_RWV = WS_RWK + HALFB;
constexpr size_t WS_RWKK = WS_RWV + HALFB;
constexpr size_t WS_RWB = WS_RWKK + HALFB;
constexpr size_t WS_RWG = WS_RWB + HALFB;
constexpr size_t WS_RWDEC = WS_RWG + HALFB;
constexpr size_t WS_LA = WS_RWDEC + (size_t)2 * NROWS * 512 * 4;
constexpr size_t WS_END = WS_LA + (size_t)NROWS * 320 * 2;
static_assert(WS_END <= (size_t)280602384 * 4, "workspace map exceeds the guaranteed ws_size");

struct Params {
    const float *x, *c, *ctx, *c_ctx, *mod_w, *mod_b, *ln_g, *ln_b;
    const float *ev_w_in, *ev_w_out, *ssd_conv_w, *ssd_conv_b, *ssd_dt_bias, *ssd_a_log, *ssd_d, *ssd_norm_w;
    const float *ml_conv_w, *ml_conv_b, *ml_i_bias, *ml_f_bias, *ml_norm_w;
    const float *od_w_in, *od_w_out, *hg_lb_logits, *hg_f_bias, *hg_norm_w;
    const float *rw_mu, *rw_w0, *rw_w2, *rw_a0, *rw_a2, *rw_g2, *rw_k_k, *rw_k_a, *rw_r_k, *rw_ln_w, *rw_ln_b;
    const float *router_w, *router_bias, *exp_w_gate, *exp_w_up, *exp_w_down;
    float* out;
    unsigned char* ws;
    int ph_lo, ph_hi, dbg, pad_;
};
typedef const CAS Params* KP;

__device__ __forceinline__ int ltid(int wv) { int l; asm volatile("v_mbcnt_lo_u32_b32 %0, -1, 0\n\tv_mbcnt_hi_u32_b32 %0, -1, %0" : "=v"(l)); return wv * 64 + l; }
__device__ __forceinline__ float bf2f(bf16_t h) { return __uint_as_float(((unsigned)h) << 16); }
__device__ __forceinline__ float bflo(unsigned u) { return __uint_as_float(u << 16); }
__device__ __forceinline__ float bfhi(unsigned u) { return __uint_as_float(u & 0xffff0000u); }
typedef __bf16 bf16v2_t __attribute__((ext_vector_type(2)));
typedef float f32x2 __attribute__((ext_vector_type(2)));
__device__ __forceinline__ unsigned pk2(float lo, float hi) { const f32x2 v = {lo, hi}; return __builtin_bit_cast(unsigned, __builtin_convertvector(v, bf16v2_t)); }
__device__ __forceinline__ bf16_t f2bf(float f) { return (bf16_t)(pk2(f, 0.f) & 0xffffu); }
__device__ __forceinline__ void unpack8(const u32x4& u, float* f) {
    f[0] = bflo(u.x); f[1] = bfhi(u.x); f[2] = bflo(u.y); f[3] = bfhi(u.y); f[4] = bflo(u.z); f[5] = bfhi(u.z); f[6] = bflo(u.w); f[7] = bfhi(u.w);
}
__device__ __forceinline__ u32x4 pack8(const float* f) { u32x4 u; u.x = pk2(f[0], f[1]); u.y = pk2(f[2], f[3]); u.z = pk2(f[4], f[5]); u.w = pk2(f[6], f[7]); return u; }
__device__ __forceinline__ float sigmoidf_(float x) { return __builtin_amdgcn_rcpf(1.f + __expf(-x)); }
__device__ __forceinline__ float siluf_(float x) { return x * __builtin_amdgcn_rcpf(1.f + __expf(-x)); }
__device__ __forceinline__ float softplus_fast(float x) { return x > 20.f ? x : __logf(1.f + __expf(x)); }
__device__ __forceinline__ float tanh_fast(float x) { return 1.f - 2.f * __builtin_amdgcn_rcpf(1.f + __expf(2.f * x)); }
__device__ __forceinline__ float softplusf_(float x) { return x > 20.f ? x : __logf(1.f + __expf(x)); }
__device__ __forceinline__ float logsigmoidf_(float x) { return fminf(x, 0.f) - __logf(1.f + __expf(-fabsf(x))); }
template <int CTRL> __device__ __forceinline__ float dppmov(float v) {
    return __builtin_bit_cast(float, __builtin_amdgcn_update_dpp(0, __builtin_bit_cast(int, v), CTRL, 0xf, 0xf, true));
}
__device__ __forceinline__ float allreduce16(float v) {
    v += dppmov<0xB1>(v);
    v += dppmov<0x4E>(v);
    v += dppmov<0x141>(v);
    v += dppmov<0x140>(v);
    return v;
}
__device__ __forceinline__ float allreduce8_(float v) { v += dppmov<0xB1>(v); v += dppmov<0x4E>(v); v += dppmov<0x141>(v); return v; }
__device__ __forceinline__ float wave_sum(float v) {
    v = allreduce16(v);
    const float r0 = __builtin_bit_cast(float, __builtin_amdgcn_readlane(__builtin_bit_cast(int, v), 0)), r1 = __builtin_bit_cast(float, __builtin_amdgcn_readlane(__builtin_bit_cast(int, v), 16));
    const float r2 = __builtin_bit_cast(float, __builtin_amdgcn_readlane(__builtin_bit_cast(int, v), 32)), r3 = __builtin_bit_cast(float, __builtin_amdgcn_readlane(__builtin_bit_cast(int, v), 48));
    return (r0 + r1) + (r2 + r3);
}
template <int W> __device__ __forceinline__ float group_sum(float v) {
    if (W == 8) return allreduce8_(v);
    return allreduce16(v);
}

#define XB_TMO      128
#define XB_XCNT(j)  (256  + 64 * (j))
#define XB_XSUB(j)  (1280 + 64 * (j))
#define XB_XGEN(j)  (2304 + 64 * (j))
#define XB_TOP      3328
#define XB_TOPGEN   3392
#define XCD_BAR_WORDS 3456
#define XB_SPIN_CAP (1u << 22)
__device__ __forceinline__ unsigned xb_ld(unsigned* p)              { return __hip_atomic_load(p, __ATOMIC_RELAXED, __HIP_MEMORY_SCOPE_AGENT); }
__device__ __forceinline__ unsigned xb_add(unsigned* p, unsigned v) { return __hip_atomic_fetch_add(p, v, __ATOMIC_RELAXED, __HIP_MEMORY_SCOPE_AGENT); }
__device__ __forceinline__ unsigned xb_xcc_id() { return (unsigned)__builtin_amdgcn_s_getreg((3 << 11) | 20) & 0xFu; }
#define XB_SPIN(cond, bar) do { unsigned _sp = 0; while (cond) { __builtin_amdgcn_s_sleep(1); \
    if ((++_sp & 255u) == 0u) { if (xb_ld(&(bar)[XB_TMO])) break; if (_sp > XB_SPIN_CAP) { atomicAdd(&(bar)[XB_TMO], 1u); break; } } } } while (0)
struct XcdBarrier { unsigned* bar; unsigned x; volatile LAS unsigned* st; };
__device__ __forceinline__ XcdBarrier xcd_barrier_post(int wv, unsigned* bar, volatile LAS unsigned* st) {
    XcdBarrier b; b.bar = bar; b.x = xb_xcc_id(); b.st = st;
    if (ltid(wv) == 0) (void)xb_add(&bar[XB_XCNT(b.x)], 1u);
    return b;
}
__device__ __forceinline__ void xcd_barrier_complete(unsigned* bar, unsigned x, unsigned& nloc, unsigned& nx) {
    const unsigned G = gridDim.x * gridDim.y * gridDim.z;
    unsigned sum, cnt, mine, sp = 0u;
    for (;;) {
        sum = 0u; cnt = 0u; mine = 0u;
#pragma unroll
        for (unsigned j = 0; j < 16; ++j) { const unsigned c = xb_ld(&bar[XB_XCNT(j)]); sum += c; cnt += (c > 0u) ? 1u : 0u; mine = (j == x) ? c : mine; }
        if (sum == G) break;
        __builtin_amdgcn_s_sleep(1);
        if ((++sp & 255u) == 0u) { if (xb_ld(&bar[XB_TMO])) break; if (sp > XB_SPIN_CAP) { atomicAdd(&bar[XB_TMO], 1u); break; } }
    }
    nloc = mine > 0u ? mine : 1u; nx = cnt > 0u ? cnt : 1u;
}
__device__ __forceinline__ void xcd_barrier(int wv, const XcdBarrier& b) {
    asm volatile("s_waitcnt vmcnt(0)" ::: "memory");
    __syncthreads();
    if (ltid(wv) == 0) {
        unsigned* bar = b.bar;
        asm volatile("" : "+s"(bar));
        __builtin_amdgcn_s_waitcnt(0);
        unsigned nloc = b.st[0], nx = b.st[1];
        if (nloc == 0u) { xcd_barrier_complete(bar, b.x, nloc, nx); b.st[0] = nloc; b.st[1] = nx; }
        const unsigned old = xb_add(&bar[XB_XSUB(b.x)], 1u);
        const unsigned gen = old / nloc;
        if (old + 1u == (gen + 1u) * nloc) {
            __builtin_amdgcn_fence(__ATOMIC_RELEASE, "agent");
            asm volatile("s_waitcnt vmcnt(0)" ::: "memory");
            const unsigned og = xb_add(&bar[XB_TOP], 1u);
            const unsigned tg = og / nx;
            if (og + 1u == (tg + 1u) * nx) xb_add(&bar[XB_TOPGEN], 1u);
            else XB_SPIN(xb_ld(&bar[XB_TOPGEN]) == tg, bar);
            __builtin_amdgcn_fence(__ATOMIC_ACQUIRE, "agent");
            xb_add(&bar[XB_XGEN(b.x)], 1u);
            asm volatile("s_waitcnt vmcnt(0)" ::: "memory");
        } else {
            XB_SPIN(xb_ld(&bar[XB_XGEN(b.x)]) == gen, bar);
            __builtin_amdgcn_fence(__ATOMIC_ACQUIRE, "agent");
            asm volatile("s_waitcnt vmcnt(0)" ::: "memory");
        }
    }
    __syncthreads();
}

__device__ __forceinline__ int row_mod(int r) { return r < NCTX ? 4 : ((r - NCTX) >> 13); }
__device__ __forceinline__ void row_seg(int r, int& t, int& len) { if (r < NCTX) { t = r & 255; len = CTXL; } else { t = (r - NCTX) & 8191; len = SEQ; } }
__device__ __forceinline__ int scan_row(int tg, int b, int dir, int odd) {
    if (tg < CTXL) { const int t = dir ? (CTXL - 1 - tg) : tg; return b * CTXL + t; }
    int sg = tg - CTXL; if (dir) sg = SEQ - 1 - sg;
    const int s = odd ? (((sg & 127) << 6) + (sg >> 7)) : sg;
    return NCTX + b * SEQ + s;
}
__device__ __forceinline__ const float* modvec(const unsigned char* ws, int layer, int m, int which) {
    return (const float*)(ws + WS_MODV) + ((size_t)(layer * 5 + m) * 6 + which) * D;
}

constexpr int G_BM = 256, G_BN = 128, G_BK = 64;
constexpr int G_ABYTES = G_BM * G_BK * 2, G_BBYTES = G_BN * G_BK * 2, G_BUF = G_ABYTES + G_BBYTES;
__device__ __forceinline__ int swz(int o) { return o ^ (((o >> 9) & 1) << 5); }

template <class RowSrc, class Epi>
__device__ __forceinline__ void gemm_tile(int wv, const bf16_t* __restrict__ A, int lda, const RowSrc& rs, const bf16_t* __restrict__ Bt, int ldb, int n0, int K, const Epi& epi, LAS char* lds) {
    const int tid = ltid(wv), lane = tid & 63, wid = tid >> 6, wm = wid >> 1, wn = wid & 1;
    const bf16_t* ap[4]; int aoff[4];
#pragma unroll
    for (int i = 0; i < 4; ++i) {
        const int c = tid + NT * i, row = c >> 3, kc = c & 7;
        ap[i] = A + (size_t)rs.src(row) * lda + kc * 8;
        aoff[i] = ((row >> 4) * 2 + (kc >> 2)) * 1024 + swz((row & 15) * 64 + (kc & 3) * 16);
    }
    const bf16_t* bp[2]; int boff[2];
#pragma unroll
    for (int i = 0; i < 2; ++i) {
        const int c = tid + NT * i, row = c >> 3, kc = c & 7;
        bp[i] = Bt + (size_t)(n0 + row) * ldb + kc * 8;
        boff[i] = G_ABYTES + ((row >> 4) * 2 + (kc >> 2)) * 1024 + swz((row & 15) * 64 + (kc & 3) * 16);
    }
    f32x4 acc[4][4];
#pragma unroll
    for (int i = 0; i < 4; ++i)
#pragma unroll
        for (int j = 0; j < 4; ++j) acc[i][j] = (f32x4){0.f, 0.f, 0.f, 0.f};
    u32x4 ra[2][4], rb[2][2];
    const int KT = K / G_BK;
    const int fragoff = swz((lane & 15) * 64 + (lane >> 4) * 16);
#define G_LOAD(set, kt_) do { _Pragma("unroll") for (int i = 0; i < 4; ++i) ra[set][i] = *(const u32x4*)(ap[i] + (kt_) * G_BK); \
                              _Pragma("unroll") for (int i = 0; i < 2; ++i) rb[set][i] = *(const u32x4*)(bp[i] + (kt_) * G_BK); } while (0)
#define G_STORE(set, buf) do { _Pragma("unroll") for (int i = 0; i < 4; ++i) *(LAS u32x4*)((buf) + aoff[i]) = ra[set][i]; \
                               _Pragma("unroll") for (int i = 0; i < 2; ++i) *(LAS u32x4*)((buf) + boff[i]) = rb[set][i]; } while (0)
#define G_COMPUTE(cur) do { bf16x8 af[2][4], bfr[2][4]; \
        _Pragma("unroll") for (int ks = 0; ks < 2; ++ks) { \
            _Pragma("unroll") for (int ni = 0; ni < 4; ++ni) bfr[ks][ni] = *(LAS bf16x8*)((cur) + G_ABYTES + ((wn * 4 + ni) * 2 + ks) * 1024 + fragoff); \
            _Pragma("unroll") for (int mi = 0; mi < 4; ++mi) af[ks][mi] = *(LAS bf16x8*)((cur) + ((wm * 4 + mi) * 2 + ks) * 1024 + fragoff); } \
        __builtin_amdgcn_sched_barrier(0); \
        _Pragma("unroll") for (int ks = 0; ks < 2; ++ks) _Pragma("unroll") for (int mi = 0; mi < 4; ++mi) _Pragma("unroll") for (int ni = 0; ni < 4; ++ni) \
            acc[mi][ni] = __builtin_amdgcn_mfma_f32_16x16x32_bf16(bfr[ks][ni], af[ks][mi], acc[mi][ni], 0, 0, 0); \
        __builtin_amdgcn_sched_barrier(0); } while (0)
    G_LOAD(0, 0);
    G_STORE(0, lds);
    if (KT > 1) G_LOAD(0, 1);
    if (KT > 2) G_LOAD(1, 2);
    __syncthreads();
    for (int kt = 0; kt < KT; kt += 2) {
        G_COMPUTE(lds);
        if (kt + 1 < KT) G_STORE(0, lds + G_BUF);
        if (kt + 3 < KT) G_LOAD(0, kt + 3);
        __syncthreads();
        if (kt + 1 < KT) {
            G_COMPUTE(lds + G_BUF);
            if (kt + 2 < KT) G_STORE(1, lds);
            if (kt + 4 < KT) G_LOAD(1, kt + 4);
            __syncthreads();
        }
    }
#undef G_LOAD
#undef G_STORE
#undef G_COMPUTE
    epi(acc, wm * 64 + (lane & 15), wn * 64 + 4 * (lane >> 4));
}

constexpr int G2_BN = 256, G2_BBYTES = G2_BN * G_BK * 2, G2_BUF = G_ABYTES + G2_BBYTES;

struct RowLinear { int m0; __device__ __forceinline__ int src(int r) const { return m0 + r; } };
struct RowList {
    const int* list; int cnt; int shift;
    __device__ __forceinline__ int src(int r) const { const int a = list[r < cnt ? r : 0]; return a >> shift; }
};
struct EpiStoreBf16 {
    bf16_t* C; int ldc; int m0; int n0; int N;
    template <int NI> __device__ __forceinline__ void operator()(const f32x4 (&acc)[4][NI], int rbase, int cbase) const {
#pragma unroll
        for (int mi = 0; mi < 4; ++mi) {
            bf16_t* rowp = C + (size_t)(m0 + rbase + mi * 16) * ldc + n0 + cbase;
#pragma unroll
            for (int ni = 0; ni < NI; ++ni) {
                if (n0 + cbase + ni * 16 < N) { u32x2 v; v.x = pk2(acc[mi][ni][0], acc[mi][ni][1]); v.y = pk2(acc[mi][ni][2], acc[mi][ni][3]); *(u32x2*)(rowp + ni * 16) = v; }
            }
        }
    }
};
struct EpiSwiGLU {
    bf16_t* H; const int* list; int cnt; int n0;
    template <int NI> __device__ __forceinline__ void operator()(const f32x4 (&acc)[4][NI], int rbase, int cbase) const {
#pragma unroll
        for (int mi = 0; mi < 4; ++mi) {
            const int r = rbase + mi * 16;
            if (r < cnt) {
                const int a = list[r];
                const int wnb = cbase & ~63, q4 = cbase & 63;
                bf16_t* rowp = H + (size_t)a * DEXP + ((n0 + wnb) >> 1) + q4;
#pragma unroll
                for (int q = 0; q < NI / 2; ++q) {
                    float o[4];
#pragma unroll
                    for (int j = 0; j < 4; ++j) o[j] = siluf_(acc[mi][2 * q][j]) * acc[mi][2 * q + 1][j];
                    u32x2 v; v.x = pk2(o[0], o[1]); v.y = pk2(o[2], o[3]); *(u32x2*)(rowp + q * 16) = v;
                }
            }
        }
    }
};
struct EpiScatterBf16 {
    bf16_t* C; const int* list; int cnt; int n0;
    template <int NI> __device__ __forceinline__ void operator()(const f32x4 (&acc)[4][NI], int rbase, int cbase) const {
#pragma unroll
        for (int mi = 0; mi < 4; ++mi) {
            const int r = rbase + mi * 16;
            if (r < cnt) {
                bf16_t* rowp = C + (size_t)list[r] * D + n0 + cbase;
#pragma unroll
                for (int ni = 0; ni < NI; ++ni) { u32x2 v; v.x = pk2(acc[mi][ni][0], acc[mi][ni][1]); v.y = pk2(acc[mi][ni][2], acc[mi][ni][3]); *(u32x2*)(rowp + ni * 16) = v; }
            }
        }
    }
};
struct EpiDecay {
    float* Dc; const float* w0; int m0; int n0;
    template <int NI> __device__ __forceinline__ void operator()(const f32x4 (&acc)[4][NI], int rbase, int cbase) const {
#pragma unroll
        for (int ni = 0; ni < NI; ++ni) {
            const int col = n0 + cbase + ni * 16;
            const f32x4 w0v = *(const f32x4*)(w0 + col);
#pragma unroll
            for (int mi = 0; mi < 4; ++mi) {
                f32x4 o;
#pragma unroll
                for (int j = 0; j < 4; ++j) { const float w = w0v[j] + acc[mi][ni][j]; o[j] = __expf(-__expf(-softplus_fast(-w) - 0.5f)); }
                *(f32x4*)(Dc + (size_t)(m0 + rbase + mi * 16) * 512 + col) = o;
            }
        }
    }
};
struct EpiAK {
    bf16_t* Kb; const bf16_t* KKb; bf16_t* Bb; const float* a0; const float* k_a; int m0; int n0;
    template <int NI> __device__ __forceinline__ void operator()(const f32x4 (&acc)[4][NI], int rbase, int cbase) const {
#pragma unroll
        for (int ni = 0; ni < NI; ++ni) {
            const int col = n0 + cbase + ni * 16;
            const f32x4 a0v = *(const f32x4*)(a0 + col), kav = *(const f32x4*)(k_a + col);
#pragma unroll
            for (int mi = 0; mi < 4; ++mi) {
                const size_t off = (size_t)(m0 + rbase + mi * 16) * 512 + col;
                const u32x2 kr = *(const u32x2*)(Kb + off), kkr = *(const u32x2*)(KKb + off);
                const float kf[4] = {bflo(kr.x), bfhi(kr.x), bflo(kr.y), bfhi(kr.y)}, kkf[4] = {bflo(kkr.x), bfhi(kkr.x), bflo(kkr.y), bfhi(kkr.y)};
                float k2[4], bb[4];
#pragma unroll
                for (int j = 0; j < 4; ++j) { const float a = sigmoidf_(a0v[j] + acc[mi][ni][j]); k2[j] = kf[j] * (1.f + (a - 1.f) * kav[j]); bb[j] = kkf[j] * a; }
                u32x2 v; v.x = pk2(k2[0], k2[1]); v.y = pk2(k2[2], k2[3]); *(u32x2*)(Kb + off) = v;
                v.x = pk2(bb[0], bb[1]); v.y = pk2(bb[2], bb[3]); *(u32x2*)(Bb + off) = v;
            }
        }
    }
};

namespace pg8 {
#define PG8_LAS __attribute__((address_space(3)))
constexpr int BM = 256, BK = 64, HALF = 128, HTB = HALF * BK * 2, STAGE_BYTES = 8 * HTB, NXCD = 8, WGM = 8;
__host__ __device__ __forceinline__ int lds_byte(int r, int c) { const int st = (r >> 4) * 2 + (c >> 5), rr = r & 15, cc = c & 31, ob = rr * 64 + cc * 2; return st * 1024 + (ob ^ (((ob >> 9) & 1) << 5)); }
__host__ __device__ __forceinline__ void stage_rc(int b, int& R, int& C) { const int st = b / 1024, sb = b % 1024, swz = sb ^ (((sb >> 9) & 1) << 5); R = (st >> 1) * 16 + swz / 64; C = (st & 1) * 32 + (swz % 64) / 2; }
__host__ __device__ __forceinline__ int perm32(int rho) { const int n = rho >> 4, i = rho & 15; return 8 * (i >> 2) + 4 * n + (i & 3); }
struct Unit { int pm, pn; };
struct Gemm { const bf16_t* A; const bf16_t* Bt; int M, N, K; };
struct StaticOrder {
    int nM, nN, nwg, G, c;
    __host__ __device__ void init(int M, int N, int G_, int c_) { nM = M / BM; nN = N / BM; nwg = nM * nN; G = G_; c = c_; }
    __host__ __device__ bool next(int i, Unit& u) const {
        const long L = (long)i * G + c; if (L >= nwg) return false;
        int wgid = (int)L; { const int q = nwg / NXCD, r = nwg % NXCD, xcd = wgid % NXCD, off = wgid / NXCD; wgid = (xcd < r ? xcd * (q + 1) : r * (q + 1) + (xcd - r) * q) + off; }
        const int nig = WGM * nN, gid = wgid / nig, fm = gid * WGM, gsz = (nM - fm) < WGM ? (nM - fm) : WGM;
        u.pm = fm + ((wgid % nig) % gsz); u.pn = (wgid % nig) / gsz; return true;
    }
    __device__ __forceinline__ void a_ready(const Unit&) const {}
    __device__ __forceinline__ void done(const Unit&) const {}
};
struct EpiStoreP {
    static constexpr bool PERM = true, AFTER_DRAIN = false;
    bf16_t* O; int ldc;
    __device__ __forceinline__ void operator()(const f32x4 (&acc)[2][2][4][2], const Unit& u, int wr, int wc, int fr, int fq) const {
        const int row0 = u.pm * BM + wr * 64 + fr, col0 = u.pn * BM + wc * 32 + 8 * fq;
#pragma unroll
        for (int ai = 0; ai < 2; ++ai)
#pragma unroll
            for (int m = 0; m < 4; ++m) { bf16_t* rowp = O + (size_t)(row0 + ai * HALF + m * 16) * ldc + col0;
#pragma unroll
                for (int bj = 0; bj < 2; ++bj) { const f32x4 v0 = acc[ai][bj][m][0], v1 = acc[ai][bj][m][1];
                    u32x4 w; w.x = pk2(v0[0], v0[1]); w.y = pk2(v0[2], v0[3]); w.z = pk2(v1[0], v1[1]); w.w = pk2(v1[2], v1[3]);
                    *(u32x4*)(rowp + bj * HALF) = w; } }
    }
};
template <class Epi, class Sched>
__device__ __forceinline__ void gemm_phase(int wv, PG8_LAS unsigned char* lds, const Gemm g, const Sched& S, const Epi& E) {
    const int tid = ltid(wv), wid = __builtin_amdgcn_readfirstlane(tid >> 6), lane = tid & 63, wr = wid >> 2, wc = wid & 3, fr = lane & 15, fq = lane >> 4;
    const int K = g.K, nt = K / BK;
    unsigned voffA[2], voffB[2];
#pragma unroll
    for (int i = 0; i < 2; ++i) { int R, C; stage_rc(tid * 16 + i * 8192, R, C); const int Rb = Epi::PERM ? ((R & ~31) + perm32(R & 31)) : R;
        voffA[i] = (unsigned)(R * K + C) * 2u; voffB[i] = (unsigned)(Rb * K + C) * 2u; }
    const size_t kstep = (size_t)(BK * 2);
    const size_t hstep = (size_t)HALF * K * 2;
    const size_t tstep = 2 * hstep;
    const unsigned ldsw = (unsigned)wid * 1024u;
    const int aoff = lds_byte(wr * 64 + fr, fq * 8), boff = lds_byte(wc * 32 + fr, fq * 8);
#define PG8_SA(b, h) (((b) * 2 + (h)) * HTB)
#define PG8_SB(b, h) ((4 + (b) * 2 + (h)) * HTB)
#define PG8_STAGE(bufoff, gbase, voff) do { _Pragma("unroll") for (int _i = 0; _i < 2; ++_i) \
        __builtin_amdgcn_global_load_lds((const unsigned*)((const char*)(gbase) + (voff)[_i]), (PG8_LAS unsigned*)(lds + (bufoff) + ldsw + _i * 8192), 16, 0, 0); } while (0)
#define PG8_LDA(dst, b, h) do { _Pragma("unroll") for (int m = 0; m < 4; ++m) _Pragma("unroll") for (int k = 0; k < 2; ++k) dst[m][k] = *(const PG8_LAS bf16x8*)(lds + PG8_SA(b, h) + aoff + m * 2048 + k * 1024); } while (0)
#define PG8_LDB(dst, b, h) do { _Pragma("unroll") for (int n = 0; n < 2; ++n) _Pragma("unroll") for (int k = 0; k < 2; ++k) dst[n][k] = *(const PG8_LAS bf16x8*)(lds + PG8_SB(b, h) + boff + n * 2048 + k * 1024); } while (0)
#define PG8_MMA(ai, bj, At, Bt) do { __builtin_amdgcn_s_setprio(1); _Pragma("unroll") for (int m = 0; m < 4; ++m) _Pragma("unroll") for (int n = 0; n < 2; ++n) _Pragma("unroll") for (int k = 0; k < 2; ++k) \
        acc[ai][bj][m][n] = __builtin_amdgcn_mfma_f32_16x16x32_bf16(Bt[n][k], At[m][k], acc[ai][bj][m][n], 0, 0, 0); __builtin_amdgcn_s_setprio(0); } while (0)
#define PG8_WAIT_V(n) asm volatile("s_waitcnt vmcnt(" #n ")" ::: "memory")
#define PG8_WAIT_L(n) asm volatile("s_waitcnt lgkmcnt(" #n ")" ::: "memory")
#define PG8_BAR __builtin_amdgcn_s_barrier()
#define PG8_SCHED __builtin_amdgcn_sched_barrier(0)
    Unit cur, nxt; int ui = 0;
    if (!S.next(0, cur)) return;
    f32x4 acc[2][2][4][2];
#pragma unroll
    for (int a = 0; a < 2; ++a)
#pragma unroll
        for (int b = 0; b < 2; ++b)
#pragma unroll
            for (int m = 0; m < 4; ++m)
#pragma unroll
                for (int n = 0; n < 2; ++n) acc[a][b][m][n] = (f32x4){0.f, 0.f, 0.f, 0.f};
    bf16x8 At[4][2], B0[2][2], B1[2][2];
    const char* cA = (const char*)g.A + (size_t)cur.pm * tstep; const char* cB = (const char*)g.Bt + (size_t)cur.pn * tstep;
    S.a_ready(cur);
    PG8_STAGE(PG8_SB(0, 0), cB, voffB); PG8_STAGE(PG8_SA(0, 0), cA, voffA); PG8_STAGE(PG8_SB(0, 1), cB + hstep, voffB); PG8_STAGE(PG8_SA(0, 1), cA + hstep, voffA);
    if (wr == 1) PG8_BAR;
    PG8_WAIT_V(4); PG8_BAR;
    PG8_STAGE(PG8_SB(1, 0), cB + kstep, voffB); PG8_STAGE(PG8_SA(1, 0), cA + kstep, voffA); PG8_STAGE(PG8_SB(1, 1), cB + hstep + kstep, voffB);
    PG8_WAIT_V(6); PG8_BAR;
    for (;;) {
        const bool has_next = S.next(ui + 1, nxt);
        const char* nA = has_next ? (const char*)g.A + (size_t)nxt.pm * tstep : cA; const char* nB = has_next ? (const char*)g.Bt + (size_t)nxt.pn * tstep : cB;
        for (int t = 0; t < nt; t += 2) {
            const bool last = (t == nt - 2);
            const char* a1 = cA + (size_t)(t + 1) * kstep;
            const char* a2 = last ? nA : cA + (size_t)(t + 2) * kstep; const char* b2 = last ? nB : cB + (size_t)(t + 2) * kstep;
            const char* a3 = a2 + kstep; const char* b3 = b2 + kstep;
            if (last && has_next) S.a_ready(nxt);
            PG8_LDB(B0, 0, 0); PG8_SCHED; PG8_LDA(At, 0, 0); PG8_STAGE(PG8_SA(1, 1), a1 + hstep, voffA);
            PG8_WAIT_L(8); PG8_BAR; PG8_WAIT_L(0); PG8_MMA(0, 0, At, B0); PG8_BAR; PG8_SCHED;
            PG8_LDB(B1, 0, 1); PG8_STAGE(PG8_SB(0, 0), b2, voffB);
            PG8_BAR; PG8_WAIT_L(0); PG8_MMA(0, 1, At, B1); PG8_BAR;
            PG8_LDA(At, 0, 1); PG8_STAGE(PG8_SA(0, 0), a2, voffA);
            PG8_BAR; PG8_WAIT_L(0); PG8_MMA(1, 0, At, B0); PG8_BAR; PG8_SCHED;
            PG8_STAGE(PG8_SB(0, 1), b2 + hstep, voffB);
            PG8_WAIT_V(6); PG8_BAR; PG8_MMA(1, 1, At, B1); PG8_BAR;
            PG8_LDB(B0, 1, 0); PG8_SCHED; PG8_LDA(At, 1, 0); PG8_STAGE(PG8_SA(0, 1), a2 + hstep, voffA);
            PG8_WAIT_L(8); PG8_BAR; PG8_WAIT_L(0); PG8_MMA(0, 0, At, B0); PG8_BAR; PG8_SCHED;
            PG8_LDB(B1, 1, 1); PG8_STAGE(PG8_SB(1, 0), b3, voffB);
            PG8_BAR; PG8_WAIT_L(0); PG8_MMA(0, 1, At, B1); PG8_BAR;
            PG8_LDA(At, 1, 1); PG8_STAGE(PG8_SA(1, 0), a3, voffA);
            PG8_BAR; PG8_WAIT_L(0); PG8_MMA(1, 0, At, B0); PG8_BAR; PG8_SCHED;
            PG8_STAGE(PG8_SB(1, 1), b3 + hstep, voffB);
            PG8_WAIT_V(6); PG8_BAR; PG8_MMA(1, 1, At, B1); PG8_BAR;
        }
            if constexpr (!Epi::AFTER_DRAIN) { E(acc, cur, wr, wc, fr, fq); S.done(cur); }
            if (!has_next) break;
#pragma unroll
        for (int a = 0; a < 2; ++a)
#pragma unroll
            for (int b = 0; b < 2; ++b)
#pragma unroll
                for (int m = 0; m < 4; ++m)
#pragma unroll
                    for (int n = 0; n < 2; ++n) acc[a][b][m][n] = (f32x4){0.f, 0.f, 0.f, 0.f};
        cur = nxt; cA = nA; cB = nB; ++ui;
    }
    PG8_WAIT_V(0);
    if (wr == 0) PG8_BAR;
    PG8_BAR;
    if constexpr (Epi::AFTER_DRAIN) { E.fused(acc, cur, wr, wc, fr, fq, lds, wid, lane); S.done(cur); }
#undef PG8_SA
#undef PG8_SB
#undef PG8_STAGE
#undef PG8_LDA
#undef PG8_LDB
#undef PG8_MMA
#undef PG8_WAIT_V
#undef PG8_WAIT_L
#undef PG8_BAR
#undef PG8_SCHED
}
struct UnitG { int pm, pn; const char* bbase; const PG8_LAS int* ltab; int cnt; int e; };
struct MoeOrder {
    const PG8_LAS int* tstart; const PG8_LAS int* tcnt; const PG8_LAS int* ltabs; const int* lists; const char* bt; size_t estride; int ncol, shift, G, c;
    __device__ __forceinline__ bool next(int i, UnitG& u) const {
        const int t = i * G + c; if (t >= tstart[32] * ncol) return false;
        const int tm = t / ncol; int e = 0;
#pragma unroll 1
        while (tstart[e + 1] <= tm) ++e;
        e = __builtin_amdgcn_readfirstlane(e);
        const int ts = __builtin_amdgcn_readfirstlane(tstart[e]), tc = __builtin_amdgcn_readfirstlane(tcnt[e]);
        u.pm = tm - ts; u.pn = t - tm * ncol; u.bbase = bt + (size_t)e * estride; u.e = e; u.cnt = tc - u.pm * BM; u.ltab = ltabs + i * BM;
        return true;
    }
    __device__ __forceinline__ void a_ready(const UnitG&) const {}
    __device__ __forceinline__ void done(const UnitG&) const {}
};
struct EpiSwiGLUG {
    static constexpr bool PERM = false, AFTER_DRAIN = false;
    bf16_t* H;
    __device__ __forceinline__ void operator()(const f32x4 (&acc)[2][2][4][2], const UnitG& u, int wr, int wc, int fr, int fq) const {
#pragma unroll
        for (int ai = 0; ai < 2; ++ai)
#pragma unroll
            for (int m = 0; m < 4; ++m) { const int r = ai * HALF + wr * 64 + m * 16 + fr;
                if (r < u.cnt) { bf16_t* rowp = H + (size_t)u.ltab[r] * DEXP + ((u.pn * BM + wc * 32) >> 1) + 4 * fq;
#pragma unroll
                    for (int bj = 0; bj < 2; ++bj) { const f32x4 gt = acc[ai][bj][m][0], up = acc[ai][bj][m][1];
                        u32x2 w; w.x = pk2(siluf_(gt[0]) * up[0], siluf_(gt[1]) * up[1]); w.y = pk2(siluf_(gt[2]) * up[2], siluf_(gt[3]) * up[3]);
                        *(u32x2*)(rowp + bj * (HALF / 2)) = w; } } }
    }
};
struct EpiScatterG {
    static constexpr bool PERM = true, AFTER_DRAIN = false;
    bf16_t* O;
    __device__ __forceinline__ void operator()(const f32x4 (&acc)[2][2][4][2], const UnitG& u, int wr, int wc, int fr, int fq) const {
#pragma unroll
        for (int ai = 0; ai < 2; ++ai)
#pragma unroll
            for (int m = 0; m < 4; ++m) { const int r = ai * HALF + wr * 64 + m * 16 + fr;
                if (r < u.cnt) { bf16_t* rowp = O + (size_t)u.ltab[r] * D + u.pn * BM + wc * 32 + 8 * fq;
#pragma unroll
                    for (int bj = 0; bj < 2; ++bj) { const f32x4 v0 = acc[ai][bj][m][0], v1 = acc[ai][bj][m][1];
                        u32x4 w; w.x = pk2(v0[0], v0[1]); w.y = pk2(v0[2], v0[3]); w.z = pk2(v1[0], v1[1]); w.w = pk2(v1[2], v1[3]);
                        *(u32x4*)(rowp + bj * HALF) = w; } } }
    }
};
template <class Epi, class Sched>
__device__ __forceinline__ void gemm_phase_g(int wv, PG8_LAS unsigned char* lds, const Gemm g, const Sched& S, const Epi& E) {
    const int tid = ltid(wv), wid = __builtin_amdgcn_readfirstlane(tid >> 6), lane = tid & 63, wr = wid >> 2, wc = wid & 3, fr = lane & 15, fq = lane >> 4;
    const int K = g.K, nt = K / BK;
    unsigned voffB[2];
#pragma unroll
    for (int i = 0; i < 2; ++i) { int R, C; stage_rc(tid * 16 + i * 8192, R, C); const int Rb = Epi::PERM ? ((R & ~31) + perm32(R & 31)) : R;
        voffB[i] = (unsigned)(Rb * K + C) * 2u; }
    const unsigned rowb = (unsigned)K * 2u;
#define PG8_AOFFS(u, dst) do { const int _t = ltid(wv); _Pragma("unroll") for (int _i = 0; _i < 2; ++_i) { int _R, _C; stage_rc(_t * 16 + _i * 8192, _R, _C); \
        _Pragma("unroll") for (int _h = 0; _h < 2; ++_h) dst[_h][_i] = (unsigned)((u).ltab[_h * HALF + _R] >> S.shift) * rowb + (unsigned)(_C * 2); } } while (0)
#define PG8_STAGE_A(bufoff, AO, koff) do { _Pragma("unroll") for (int _i = 0; _i < 2; ++_i) \
        __builtin_amdgcn_global_load_lds((const unsigned*)((const char*)g.A + (size_t)(AO)[_i] + (size_t)(koff)), (PG8_LAS unsigned*)(lds + (bufoff) + ldsw + _i * 8192), 16, 0, 0); } while (0)
    const size_t kstep = (size_t)(BK * 2);
    const size_t hstep = (size_t)HALF * K * 2;
    const size_t tstep = 2 * hstep;
    const unsigned ldsw = (unsigned)wid * 1024u;
    const int aoff = lds_byte(wr * 64 + fr, fq * 8), boff = lds_byte(wc * 32 + fr, fq * 8);
#define PG8_SA(b, h) (((b) * 2 + (h)) * HTB)
#define PG8_SB(b, h) ((4 + (b) * 2 + (h)) * HTB)
#define PG8_STAGE(bufoff, gbase, voff) do { _Pragma("unroll") for (int _i = 0; _i < 2; ++_i) \
        __builtin_amdgcn_global_load_lds((const unsigned*)((const char*)(gbase) + (voff)[_i]), (PG8_LAS unsigned*)(lds + (bufoff) + ldsw + _i * 8192), 16, 0, 0); } while (0)
#define PG8_LDA(dst, b, h) do { _Pragma("unroll") for (int m = 0; m < 4; ++m) _Pragma("unroll") for (int k = 0; k < 2; ++k) dst[m][k] = *(const PG8_LAS bf16x8*)(lds + PG8_SA(b, h) + aoff + m * 2048 + k * 1024); } while (0)
#define PG8_LDB(dst, b, h) do { _Pragma("unroll") for (int n = 0; n < 2; ++n) _Pragma("unroll") for (int k = 0; k < 2; ++k) dst[n][k] = *(const PG8_LAS bf16x8*)(lds + PG8_SB(b, h) + boff + n * 2048 + k * 1024); } while (0)
#define PG8_MMA(ai, bj, At, Bt) do { __builtin_amdgcn_s_setprio(1); _Pragma("unroll") for (int m = 0; m < 4; ++m) _Pragma("unroll") for (int n = 0; n < 2; ++n) _Pragma("unroll") for (int k = 0; k < 2; ++k) \
        acc[ai][bj][m][n] = __builtin_amdgcn_mfma_f32_16x16x32_bf16(Bt[n][k], At[m][k], acc[ai][bj][m][n], 0, 0, 0); __builtin_amdgcn_s_setprio(0); } while (0)
#define PG8_WAIT_V(n) asm volatile("s_waitcnt vmcnt(" #n ")" ::: "memory")
#define PG8_WAIT_L(n) asm volatile("s_waitcnt lgkmcnt(" #n ")" ::: "memory")
#define PG8_BAR __builtin_amdgcn_s_barrier()
#define PG8_SCHED __builtin_amdgcn_sched_barrier(0)
    UnitG cur, nxt; int ui = 0;
    if (!S.next(0, cur)) return;
    f32x4 acc[2][2][4][2];
#pragma unroll
    for (int a = 0; a < 2; ++a)
#pragma unroll
        for (int b = 0; b < 2; ++b)
#pragma unroll
            for (int m = 0; m < 4; ++m)
#pragma unroll
                for (int n = 0; n < 2; ++n) acc[a][b][m][n] = (f32x4){0.f, 0.f, 0.f, 0.f};
    bf16x8 At[4][2], B0[2][2], B1[2][2];
    unsigned ca[2][2]; PG8_AOFFS(cur, ca); const char* cB = cur.bbase + (size_t)cur.pn * tstep;
    S.a_ready(cur);
    PG8_STAGE(PG8_SB(0, 0), cB, voffB); PG8_STAGE_A(PG8_SA(0, 0), ca[0], 0); PG8_STAGE(PG8_SB(0, 1), cB + hstep, voffB); PG8_STAGE_A(PG8_SA(0, 1), ca[1], 0);
    if (wr == 1) PG8_BAR;
    PG8_WAIT_V(4); PG8_BAR;
    PG8_STAGE(PG8_SB(1, 0), cB + kstep, voffB); PG8_STAGE_A(PG8_SA(1, 0), ca[0], kstep); PG8_STAGE(PG8_SB(1, 1), cB + hstep + kstep, voffB);
    PG8_WAIT_V(6); PG8_BAR;
    for (;;) {
        const bool has_next = S.next(ui + 1, nxt);
        const char* nB = has_next ? nxt.bbase + (size_t)nxt.pn * tstep : cB;
        for (int t = 0; t < nt; t += 2) {
            const bool last = (t == nt - 2);
            const size_t k1 = (size_t)(t + 1) * kstep, k2 = last ? 0 : (size_t)(t + 2) * kstep;
            unsigned a2o[2][2];
            if (last && has_next) PG8_AOFFS(nxt, a2o); else { a2o[0][0] = ca[0][0]; a2o[0][1] = ca[0][1]; a2o[1][0] = ca[1][0]; a2o[1][1] = ca[1][1]; }
            const char* b2 = last ? nB : cB + (size_t)(t + 2) * kstep; const char* b3 = b2 + kstep;
            if (last && has_next) S.a_ready(nxt);
            PG8_LDB(B0, 0, 0); PG8_SCHED; PG8_LDA(At, 0, 0); PG8_STAGE_A(PG8_SA(1, 1), ca[1], k1);
            PG8_WAIT_L(8); PG8_BAR; PG8_WAIT_L(0); PG8_MMA(0, 0, At, B0); PG8_BAR; PG8_SCHED;
            PG8_LDB(B1, 0, 1); PG8_STAGE(PG8_SB(0, 0), b2, voffB);
            PG8_BAR; PG8_WAIT_L(0); PG8_MMA(0, 1, At, B1); PG8_BAR;
            PG8_LDA(At, 0, 1); PG8_STAGE_A(PG8_SA(0, 0), a2o[0], k2);
            PG8_BAR; PG8_WAIT_L(0); PG8_MMA(1, 0, At, B0); PG8_BAR; PG8_SCHED;
            PG8_STAGE(PG8_SB(0, 1), b2 + hstep, voffB);
            PG8_WAIT_V(6); PG8_BAR; PG8_MMA(1, 1, At, B1); PG8_BAR;
            PG8_LDB(B0, 1, 0); PG8_SCHED; PG8_LDA(At, 1, 0); PG8_STAGE_A(PG8_SA(0, 1), a2o[1], k2);
            PG8_WAIT_L(8); PG8_BAR; PG8_WAIT_L(0); PG8_MMA(0, 0, At, B0); PG8_BAR; PG8_SCHED;
            PG8_LDB(B1, 1, 1); PG8_STAGE(PG8_SB(1, 0), b3, voffB);
            PG8_BAR; PG8_WAIT_L(0); PG8_MMA(0, 1, At, B1); PG8_BAR;
            PG8_LDA(At, 1, 1); PG8_STAGE_A(PG8_SA(1, 0), a2o[0], k2 + kstep);
            PG8_BAR; PG8_WAIT_L(0); PG8_MMA(1, 0, At, B0); PG8_BAR; PG8_SCHED;
            PG8_STAGE(PG8_SB(1, 1), b3 + hstep, voffB);
            PG8_WAIT_V(6); PG8_BAR; PG8_MMA(1, 1, At, B1); PG8_BAR;
            if (last) { ca[0][0] = a2o[0][0]; ca[0][1] = a2o[0][1]; ca[1][0] = a2o[1][0]; ca[1][1] = a2o[1][1]; }
        }
            if constexpr (!Epi::AFTER_DRAIN) { E(acc, cur, wr, wc, fr, fq); S.done(cur); }
            if (!has_next) break;
#pragma unroll
        for (int a = 0; a < 2; ++a)
#pragma unroll
            for (int b = 0; b < 2; ++b)
#pragma unroll
                for (int m = 0; m < 4; ++m)
#pragma unroll
                    for (int n = 0; n < 2; ++n) acc[a][b][m][n] = (f32x4){0.f, 0.f, 0.f, 0.f};
        cur = nxt; cB = nB; ++ui;
    }
    PG8_WAIT_V(0);
    if (wr == 0) PG8_BAR;
    PG8_BAR;
    if constexpr (Epi::AFTER_DRAIN) { E.fused(acc, cur, wr, wc, fr, fq, lds, wid, lane); S.done(cur); }
#undef PG8_SA
#undef PG8_AOFFS
#undef PG8_STAGE_A
#undef PG8_SB
#undef PG8_STAGE
#undef PG8_LDA
#undef PG8_LDB
#undef PG8_MMA
#undef PG8_WAIT_V
#undef PG8_WAIT_L
#undef PG8_BAR
#undef PG8_SCHED
}
}

__device__ __forceinline__ void transpose_item(const float* __restrict__ W, int K, int N, bf16_t* __restrict__ WT, int mode, LAS float* scr, int item, int lane) {
    const int nblk = N / 32, kb = item / nblk, nb = item % nblk, k0 = 64 * kb, n0 = 32 * nb;
    {
        const float* wp = W + (size_t)(k0 + (lane >> 5)) * N + n0 + (lane & 31);
        float t[32];
#pragma unroll
        for (int i = 0; i < 32; ++i) t[i] = wp[(size_t)(2 * i) * N];
#pragma unroll
        for (int i = 0; i < 32; ++i) scr[(2 * i + (lane >> 5)) * 33 + (lane & 31)] = t[i];
    }
    asm volatile("s_waitcnt lgkmcnt(0)" ::: "memory");
    const int c = lane & 7;
#pragma unroll
    for (int j = 0; j < 4; ++j) {
        const int nl = (lane >> 3) + 8 * j; const LAS float* s = scr + (8 * c) * 33 + nl;
        u32x4 o; o.x = pk2(s[0 * 33], s[1 * 33]); o.y = pk2(s[2 * 33], s[3 * 33]); o.z = pk2(s[4 * 33], s[5 * 33]); o.w = pk2(s[6 * 33], s[7 * 33]);
        const int n = n0 + nl;
        const int nd = mode == 0 ? n : (32 * (n >> 4) + (n & 15) + (mode == 2 ? 16 : 0));
        *(u32x4*)(WT + (size_t)nd * K + k0 + 8 * c) = o;
    }
    asm volatile("s_waitcnt lgkmcnt(0)" ::: "memory");
}

constexpr int EXC_IG = 16 * 16, EXC_IDN = 8 * 32, EXC_PER = 2 * EXC_IG + EXC_IDN, EXC_ITEMS = NEXP * EXC_PER;
__device__ __forceinline__ int exc_s0(int layer) { return (layer & 1) ? 8192 : 10240; }
__device__ __forceinline__ int exc_s1(int layer) { return layer == DEPTH - 1 ? 0 : 7168; }
__device__ __forceinline__ void expconv_items(const CAS Params& P, int layer, LAS char* lds, int lo, int hi, int worker, int nworkers, int wid, int lane) {
    LAS float* scr = (LAS float*)(lds + wid * 8448);
    bf16_t* gu = (bf16_t*)(P.ws + WS_EXPGU); bf16_t* dw = (bf16_t*)(P.ws + WS_EXPD);
    for (int it = lo + worker; it < hi; it += nworkers) {
        const int e = it / EXC_PER; int r = it % EXC_PER;
        const size_t eo = (size_t)(layer * NEXP + e);
        if (r < EXC_IG) { transpose_item(P.exp_w_gate + eo * D * DEXP, D, DEXP, gu + (size_t)e * 1024 * 1024, 1, scr, r, lane); continue; } r -= EXC_IG;
        if (r < EXC_IG) { transpose_item(P.exp_w_up + eo * D * DEXP, D, DEXP, gu + (size_t)e * 1024 * 1024, 2, scr, r, lane); continue; } r -= EXC_IG;
        transpose_item(P.exp_w_down + eo * DEXP * D, DEXP, D, dw + (size_t)e * 1024 * 512, 0, scr, r, lane);
    }
}
__device__ __forceinline__ void expconv_tail(int wv, const CAS Params& P, int layer, LAS char* lds, int nwg, int lo, int hi) {
    const int G = gridDim.x, rem = nwg % G;
    if (rem != 0 && (int)blockIdx.x >= rem && lo < hi) {
        const int tid = ltid(wv);
        __syncthreads();
        expconv_items(P, layer, lds, lo, hi, ((int)blockIdx.x - rem) * 8 + (tid >> 6), (G - rem) * 8, tid >> 6, tid & 63);
    }
}

__device__ __forceinline__ void phase_prologue0(int wv, KP Pk, LAS char* lds) {
    asm volatile("" : "+s"(Pk));
    const CAS Params& P = *Pk;
    const int tid = ltid(wv), lane = tid & 63, wid = tid >> 6;
    const int gw = blockIdx.x * 8 + wid, NGW = gridDim.x * 8;
    LAS float* scr = (LAS float*)(lds + wid * 8448);
    bf16_t* winT = (bf16_t*)(P.ws + WS_WINT);
    bf16_t* woutT = (bf16_t*)(P.ws + WS_WOUTT);
    bf16_t* loraT = (bf16_t*)(P.ws + WS_LORAT);
    constexpr int I_EV = 16 * (P_EVEN / 32), I_OD = 16 * (P_ODD / 32), I_O = 16 * 32, I_L64 = 16, I_L128 = 32;
    constexpr int I_LORA = 3 * I_L64 + I_L128;
    constexpr int NIT = 2 * I_EV + 2 * I_OD + 4 * I_O + 2 * I_LORA;
    for (int it = gw; it < NIT; it += NGW) {
        int r = it;
        if (r < 2 * I_EV) { const int i = r / I_EV; transpose_item(P.ev_w_in + (size_t)i * D * P_EVEN, D, P_EVEN, winT + (i ? WINT_L2 : WINT_L0), 0, scr, r % I_EV, lane); continue; } r -= 2 * I_EV;
        if (r < 2 * I_OD) { const int i = r / I_OD; transpose_item(P.od_w_in + (size_t)i * D * P_ODD, D, P_ODD, winT + (i ? WINT_L3 : WINT_L1), 0, scr, r % I_OD, lane); continue; } r -= 2 * I_OD;
        if (r < 4 * I_O) { const int l = r / I_O; const float* src = (l & 1) ? P.od_w_out + (size_t)(l >> 1) * D * D : P.ev_w_out + (size_t)(l >> 1) * D * D;
            transpose_item(src, D, D, woutT + (size_t)l * D * D, 0, scr, r % I_O, lane); continue; } r -= 4 * I_O;
        { const int i = r / I_LORA; int q = r % I_LORA; bf16_t* dst = loraT + (size_t)i * LORA_PER;
          if (q < I_L64) { transpose_item(P.rw_w2 + (size_t)(i * 2 + 0) * 64 * 512, 64, 512, dst, 0, scr, q, lane); continue; } q -= I_L64;
          if (q < I_L64) { transpose_item(P.rw_w2 + (size_t)(i * 2 + 1) * 64 * 512, 64, 512, dst + 512 * 64, 0, scr, q, lane); continue; } q -= I_L64;
          if (q < I_L64) { transpose_item(P.rw_a2 + (size_t)i * 64 * 512, 64, 512, dst + 2 * 512 * 64, 0, scr, q, lane); continue; } q -= I_L64;
          transpose_item(P.rw_g2 + (size_t)i * 128 * 512, 128, 512, dst + 3 * 512 * 64, 0, scr, q, lane); }
    }
    {
        const int gt = blockIdx.x * NT + tid, NG = gridDim.x * NT;
        constexpr int PADE = (LDP_EVEN - P_EVEN) * D / 8, PADO = (LDP_ODD - P_ODD) * D / 8;
        for (int i = gt; i < 2 * PADE + 2 * PADO; i += NG) {
            int r = i; bf16_t* dst;
            if (r < 2 * PADE) { const int l = r / PADE; dst = winT + (l ? WINT_L2 : WINT_L0) + (size_t)P_EVEN * D + (size_t)(r % PADE) * 8; }
            else { r -= 2 * PADE; const int l = r / PADO; dst = winT + (l ? WINT_L3 : WINT_L1) + (size_t)P_ODD * D + (size_t)(r % PADO) * 8; }
            *(u32x4*)dst = (u32x4){0u, 0u, 0u, 0u};
        }
    }
    {
        const int gt = blockIdx.x * NT + tid, NG = gridDim.x * NT;
        float* lb = (float*)(P.ws + WS_LB);
        for (int ch = gt; ch < 512; ch += NG) {
            float lg[4], mx = -1e30f;
#pragma unroll
            for (int l = 0; l < 4; ++l) { lg[l] = P.hg_lb_logits[l * 512 + ch]; mx = fmaxf(mx, lg[l]); }
            float e[4], s = 0.f;
#pragma unroll
            for (int l = 0; l < 4; ++l) { e[l] = __expf(lg[l] - mx); s += e[l]; }
            float cum = 0.f;
#pragma unroll
            for (int l = 0; l < 4; ++l) { if (l > 0) cum += e[l] / s; lb[l * 512 + ch] = cum; }
        }
    }
    __syncthreads();
    {
        LAS float* sc = (LAS float*)lds;
        LAS float* red = (LAS float*)(lds + 5 * 1024 * 4);
        for (int i = tid; i < 5 * D; i += NT) { const int m = i >> 10, k = i & 1023; const float v = m < 4 ? P.c[m * D + k] : P.c_ctx[k]; sc[i] = siluf_(v); }
        __syncthreads();
        float* modv = (float*)(P.ws + WS_MODV);
        const int col = tid & 127, kq = tid >> 7;
        for (int item = blockIdx.x; item < 4 * 48; item += gridDim.x) {
            const int l = item / 48, j = (item % 48) * 128 + col;
            const float* w = P.mod_w + (size_t)l * D * 6144 + j;
            float a[5] = {0.f, 0.f, 0.f, 0.f, 0.f};
#pragma unroll 8
            for (int k = kq * 256; k < kq * 256 + 256; ++k) {
                const float wv = w[(size_t)k * 6144];
#pragma unroll
                for (int m = 0; m < 5; ++m) a[m] += sc[m * 1024 + k] * wv;
            }
#pragma unroll
            for (int m = 0; m < 5; ++m) red[(kq * 128 + col) * 5 + m] = a[m];
            __syncthreads();
            if (kq == 0) {
                const float bias = P.mod_b[l * 6144 + j];
#pragma unroll
                for (int m = 0; m < 5; ++m) {
                    const float s = red[(0 * 128 + col) * 5 + m] + red[(1 * 128 + col) * 5 + m] + red[(2 * 128 + col) * 5 + m] + red[(3 * 128 + col) * 5 + m];
                    modv[(size_t)(l * 5 + m) * 6144 + j] = s + bias;
                }
            }
            __syncthreads();
        }
    }
}

__device__ __forceinline__ void phase_prologue1(int wv, KP Pk) {
    asm volatile("" : "+s"(Pk));
    const CAS Params& P = *Pk;
    const int tid = ltid(wv), lane = tid & 63, wid = tid >> 6;
    bf16_t* act = (bf16_t*)(P.ws + WS_ACT);
    for (int r = blockIdx.x * 8 + wid; r < NROWS; r += gridDim.x * 8) {
        const int m = row_mod(r);
        const float* src = r < NCTX ? P.ctx + (size_t)r * D : P.x + (size_t)(r - NCTX) * D;
        const float* sh = modvec(P.ws, 0, m, 0); const float* sc = modvec(P.ws, 0, m, 1);
#pragma unroll
        for (int i = 0; i < 4; ++i) {
            const int c = 4 * lane + 256 * i;
            const f32x4 v = *(const f32x4*)(src + c), s1 = *(const f32x4*)(sc + c), h1 = *(const f32x4*)(sh + c);
            u32x2 o; o.x = pk2(v[0] * (1.f + s1[0]) + h1[0], v[1] * (1.f + s1[1]) + h1[1]); o.y = pk2(v[2] * (1.f + s1[2]) + h1[2], v[3] * (1.f + s1[3]) + h1[3]);
            *(u32x2*)(act + (size_t)r * D + c) = o;
        }
    }
}

__device__ __forceinline__ void phase_inproj(int wv, KP Pk, int layer, LAS char* lds) {
    asm volatile("" : "+s"(Pk));
    const CAS Params& P = *Pk;
    const int odd = layer & 1, ldp = odd ? LDP_ODD : LDP_EVEN;
    const size_t woff = layer == 0 ? WINT_L0 : layer == 1 ? WINT_L1 : layer == 2 ? WINT_L2 : WINT_L3;
    pg8::Gemm g{(const bf16_t*)(P.ws + WS_ACT), (const bf16_t*)(P.ws + WS_WINT) + woff, NROWS, ldp, D};
    pg8::StaticOrder S; S.init(NROWS, ldp, (int)gridDim.x, (int)blockIdx.x);
    pg8::EpiStoreP E{(bf16_t*)(P.ws + WS_P), ldp};
    pg8::gemm_phase(wv, (PG8_LAS unsigned char*)lds, g, S, E);
    expconv_tail(wv, P, layer, lds, (NROWS / 256) * (ldp / 256), 0, exc_s0(layer));
}
__device__ __forceinline__ void phase_outproj(int wv, KP Pk, int layer, LAS char* lds) {
    asm volatile("" : "+s"(Pk));
    const CAS Params& P = *Pk;
    const int r0 = (layer == DEPTH - 1) ? NCTX : 0;
    pg8::Gemm g{(const bf16_t*)(P.ws + WS_FEAT) + (size_t)r0 * D, (const bf16_t*)(P.ws + WS_WOUTT) + (size_t)layer * D * D, NROWS - r0, D, D};
    pg8::StaticOrder S; S.init(NROWS - r0, D, (int)gridDim.x, (int)blockIdx.x);
    pg8::EpiStoreP E{(bf16_t*)(P.ws + WS_YO) + (size_t)r0 * D, D};
    pg8::gemm_phase(wv, (PG8_LAS unsigned char*)lds, g, S, E);
    expconv_tail(wv, P, layer, lds, ((NROWS - r0) / 256) * (D / 256), exc_s0(layer), exc_s0(layer) + exc_s1(layer));
}
__device__ __forceinline__ void phase_prep2(int wv, KP Pk, int layer, LAS char* lds) {
    asm volatile("" : "+s"(Pk));
    const CAS Params& P = *Pk;
    const int i = layer >> 1;
    const bf16_t* la = (const bf16_t*)(P.ws + WS_LA);
    const bf16_t* lt = (const bf16_t*)(P.ws + WS_LORAT) + (size_t)i * LORA_PER;
    constexpr int MT = NROWS / G_BM, NTL = 512 / G_BN;
    const int ntiles = 4 * MT * NTL;
    for (int t = blockIdx.x; t < ntiles; t += gridDim.x) {
        const int which = t / (MT * NTL), r = t % (MT * NTL), mt = r / NTL, nt = r % NTL;
        RowLinear rs{mt * G_BM};
        if (which < 2) {
            EpiDecay epi{(float*)(P.ws + WS_RWDEC) + (size_t)which * NROWS * 512, P.rw_w0 + (size_t)(i * 2 + which) * 512, mt * G_BM, nt * G_BN};
            gemm_tile(wv, la + which * 64, 320, rs, lt + (size_t)which * 512 * 64, 64, nt * G_BN, 64, epi, lds);
        } else if (which == 2) {
            EpiAK epi{(bf16_t*)(P.ws + WS_RWK), (const bf16_t*)(P.ws + WS_RWKK), (bf16_t*)(P.ws + WS_RWB), P.rw_a0 + i * 512, P.rw_k_a + i * 512, mt * G_BM, nt * G_BN};
            gemm_tile(wv, la + 128, 320, rs, lt + (size_t)2 * 512 * 64, 64, nt * G_BN, 64, epi, lds);
        } else {
            EpiStoreBf16 epi{(bf16_t*)(P.ws + WS_RWG), 512, mt * G_BM, nt * G_BN, 512};
            gemm_tile(wv, la + 192, 320, rs, lt + (size_t)3 * 512 * 64, 128, nt * G_BN, 128, epi, lds);
        }
    }
}
__device__ __forceinline__ void moe_tiles(int wv, const unsigned char* ws, int layer, LAS int* tstart, LAS int* tcnt) {
    const int tid = ltid(wv);
    if (tid < 64) {
        const int* cnt = (const int*)(ws + WS_CNT) + layer * 32 * CNT_STRIDE;
        const int c = tid < NEXP ? cnt[tid * CNT_STRIDE] : 0;
        int incl = (c + G_BM - 1) / G_BM;
#pragma unroll
        for (int o = 1; o < 32; o <<= 1) { const int t = __shfl_up(incl, o); if (tid >= o) incl += t; }
        if (tid < NEXP) { tcnt[tid] = c; tstart[tid] = incl - (c + G_BM - 1) / G_BM; }
        if (tid == NEXP - 1) tstart[NEXP] = incl;
    }
    __syncthreads();
}
__device__ __forceinline__ void phase_moe1(int wv, KP Pk, int layer, LAS char* lds) {
    asm volatile("" : "+s"(Pk));
    const CAS Params& P = *Pk;
    LAS int* tstart = (LAS int*)(lds + pg8::STAGE_BYTES); LAS int* tcnt = tstart + 40;
    moe_tiles(wv, P.ws, layer, tstart, tcnt);
    pg8::Gemm g{(const bf16_t*)(P.ws + WS_ACT), (const bf16_t*)(P.ws + WS_EXPGU), 0, 1024, D};
    LAS int* ltabs = tstart + 128;
    pg8::MoeOrder S{tstart, tcnt, ltabs, (const int*)(P.ws + WS_LIST), (const char*)(P.ws + WS_EXPGU), (size_t)1024 * 1024 * 2, 4, 1, (int)gridDim.x, (int)blockIdx.x};
    pg8::EpiSwiGLUG E{(bf16_t*)(P.ws + WS_HID)};
    for (int i = 0; i < 8; ++i) {
        pg8::UnitG u; if (!S.next(i, u)) break;
        const int tl = ltid(wv);
        const int* ul = (const int*)(P.ws + WS_LIST) + (size_t)u.e * LISTCAP + u.pm * pg8::BM;
        if (tl < pg8::BM) ltabs[i * pg8::BM + tl] = ul[tl < u.cnt ? tl : 0];
    }
    __syncthreads();
    pg8::gemm_phase_g(wv, (PG8_LAS unsigned char*)lds, g, S, E);
    __syncthreads();
}
__device__ __forceinline__ void phase_moe2(int wv, KP Pk, int layer, LAS char* lds) {
    asm volatile("" : "+s"(Pk));
    const CAS Params& P = *Pk;
    LAS int* tstart = (LAS int*)(lds + pg8::STAGE_BYTES); LAS int* tcnt = tstart + 40;
    moe_tiles(wv, P.ws, layer, tstart, tcnt);
    pg8::Gemm g{(const bf16_t*)(P.ws + WS_HID), (const bf16_t*)(P.ws + WS_EXPD), 0, 1024, DEXP};
    LAS int* ltabs = tstart + 128;
    pg8::MoeOrder S{tstart, tcnt, ltabs, (const int*)(P.ws + WS_LIST), (const char*)(P.ws + WS_EXPD), (size_t)1024 * 512 * 2, 4, 0, (int)gridDim.x, (int)blockIdx.x};
    pg8::EpiScatterG E{(bf16_t*)(P.ws + WS_YP)};
    for (int i = 0; i < 8; ++i) {
        pg8::UnitG u; if (!S.next(i, u)) break;
        const int tl = ltid(wv);
        const int* ul = (const int*)(P.ws + WS_LIST) + (size_t)u.e * LISTCAP + u.pm * pg8::BM;
        if (tl < pg8::BM) ltabs[i * pg8::BM + tl] = ul[tl < u.cnt ? tl : 0];
    }
    __syncthreads();
    pg8::gemm_phase_g(wv, (PG8_LAS unsigned char*)lds, g, S, E);
    __syncthreads();
}

constexpr int NCHUNK = NSTEPS / TCH;

constexpr int SSD_F = 32 + 64 + 64;
constexpr int SSD_BUF = TCH * SSD_F + 3 * TCH;

constexpr int ML_F = 64 + 64 + 32;
constexpr int ML_BUF = TCH * ML_F + 4 * TCH;

constexpr int HG_F = 128 + 128 + 32;
constexpr int HG_BUF = TCH * HG_F + TCH;

constexpr int RW_F = 5 * 64 + 32;
constexpr int RW_BUF = TCH * RW_F + TCH;
__device__ __forceinline__ void scan_rwkv(int wv, KP Pk, int layer, int unit, LAS char* lds) {
    asm volatile("" : "+s"(Pk));
    const CAS Params& P = *Pk;
    const int tid = ltid(wv);
    const int seq = unit >> 1, half = unit & 1, b = seq >> 4, h = (seq >> 1) & 7, dir = seq & 1;
    LAS float* bufs = (LAS float*)lds;
    bf16_t* Y = (bf16_t*)(P.ws + (dir ? WS_YB : WS_YF));
    const float* dec = (const float*)(P.ws + WS_RWDEC) + (size_t)dir * NROWS * 512;
    int tj[4], tg_[4]; bool tv[4]; const unsigned char* tbase[4]; int tlds[4];
#pragma unroll
    for (int s = 0; s < 4; ++s) {
        const int task = tid + NT * s; tv[s] = task < TCH * 52; tj[s] = task / 52; tg_[s] = task % 52;
        const int g = tg_[s];
        if (g < 8)       { tbase[s] = P.ws + WS_RWR  + (size_t)(h * 64 + 8 * g) * 2;              tlds[s] = 256 + 8 * g; }
        else if (g < 16) { tbase[s] = P.ws + WS_RWK  + (size_t)(h * 64 + 8 * (g - 8)) * 2;        tlds[s] = 192 + 8 * (g - 8); }
        else if (g < 24) { tbase[s] = P.ws + WS_RWKK + (size_t)(h * 64 + 8 * (g - 16)) * 2;       tlds[s] = 64 + 8 * (g - 16); }
        else if (g < 32) { tbase[s] = P.ws + WS_RWB  + (size_t)(h * 64 + 8 * (g - 24)) * 2;       tlds[s] = 128 + 8 * (g - 24); }
        else if (g < 36) { tbase[s] = P.ws + WS_RWV  + (size_t)(h * 64 + half * 32 + 8 * (g - 32)) * 2; tlds[s] = 320 + 8 * (g - 32); }
        else             { tbase[s] = (const unsigned char*)(dec + h * 64 + 4 * (g - 36));        tlds[s] = 4 * (g - 36); }
    }
    u32x4 rc[4]; int rrow = 0;
    auto load = [&](int c) {
#pragma unroll
        for (int s = 0; s < 4; ++s) {
            rc[s] = (u32x4){0u, 0u, 0u, 0u};
            if (tv[s]) { const int row = scan_row(c * TCH + tj[s], b, dir, 1); rc[s] = *(const u32x4*)(tbase[s] + (size_t)row * (tg_[s] < 36 ? 1024 : 2048)); }
        }
        if (tid < TCH) rrow = scan_row(c * TCH + tid, b, dir, 1);
    };
    auto store = [&](int c) {
        LAS float* buf = bufs + (c & 1) * RW_BUF;
#pragma unroll
        for (int s = 0; s < 4; ++s) {
            if (tv[s]) {
                LAS float* dst = buf + tj[s] * RW_F + tlds[s];
                const int g = tg_[s];
                if (g >= 36) { *(LAS u32x4*)dst = rc[s]; }
                else {
                    float f[8]; unpack8(rc[s], f);
                    const float sg = (g >= 16 && g < 24) ? -1.f : 1.f;
                    *(LAS f32x4*)dst = (f32x4){sg * f[0], sg * f[1], sg * f[2], sg * f[3]}; *(LAS f32x4*)(dst + 4) = (f32x4){sg * f[4], sg * f[5], sg * f[6], sg * f[7]};
                }
            }
        }
        if (tid < TCH) ((LAS int*)buf)[TCH * RW_F + tid] = rrow;
    };
    const int vrow = tid >> 4, q = tid & 15;
    float S[4] = {0.f, 0.f, 0.f, 0.f};
    load(0); store(0); __syncthreads();
    for (int c = 0; c < NCHUNK; ++c) {
        if (c + 1 < NCHUNK) load(c + 1);
        LAS float* buf = bufs + (c & 1) * RW_BUF;
        {
            const LAS float* wp = buf + 4 * q;
            const LAS float* vp = buf + 320 + vrow;
            f32x4 w4 = *(const LAS f32x4*)wp, a4 = *(const LAS f32x4*)(wp + 64), b4 = *(const LAS f32x4*)(wp + 128), k4 = *(const LAS f32x4*)(wp + 192), r4 = *(const LAS f32x4*)(wp + 256); float vr = vp[0];
#pragma unroll 1
            for (int jh = 0; jh < 2; ++jh) {
                float ysel = 0.f;
#pragma unroll
                for (int j = 0; j < 16; ++j) {
                    const int jj = jh * 16 + j;
                    const f32x4 wc = w4, ac = a4, bc = b4, kc = k4, rc = r4; const float vv = vr;
                    if (j < 15 || jh == 0) {
                        const LAS float* np = wp + (jj + 1) * RW_F;
                        w4 = *(const LAS f32x4*)np; a4 = *(const LAS f32x4*)(np + 64); b4 = *(const LAS f32x4*)(np + 128); k4 = *(const LAS f32x4*)(np + 192); r4 = *(const LAS f32x4*)(np + 256); vr = vp[(jj + 1) * RW_F];
                    }
                    float sa = S[0] * ac[0] + S[1] * ac[1] + S[2] * ac[2] + S[3] * ac[3];
                    sa = allreduce16(sa);
                    float y = 0.f;
#pragma unroll
                    for (int e = 0; e < 4; ++e) { S[e] = S[e] * wc[e] + (sa * bc[e] + vv * kc[e]); y += S[e] * rc[e]; }
                    y = allreduce16(y);
                    ysel = (q == j) ? y : ysel;
                }
                const int row = ((const LAS int*)buf)[TCH * RW_F + jh * 16 + q];
                Y[(size_t)row * D + 512 + h * 64 + half * 32 + vrow] = f2bf(ysel);
            }
        }
        if (c + 1 < NCHUNK) store(c + 1);
        __syncthreads();
    }
}

constexpr size_t WS_EXBC = WS_RWR;
constexpr size_t WS_EQK = WS_EXBC + (size_t)NROWS * 768 * 2;
constexpr size_t WS_EGT = WS_EQK + (size_t)NROWS * 512 * 2;
static_assert(WS_EGT + (size_t)NROWS * 32 * 4 <= WS_LA, "even-layer prepare buffers must fit in the RWKV region");

__device__ __forceinline__ void phase_prep_even(int wv, KP Pk, int layer) {
    asm volatile("" : "+s"(Pk));
    const CAS Params& P = *Pk;
    const int tid = ltid(wv), lane = tid & 63, wid = tid >> 6, i_ = layer >> 1;
    const bf16_t* Pb = (const bf16_t*)(P.ws + WS_P);
    bf16_t* XBC = (bf16_t*)(P.ws + WS_EXBC); bf16_t* QK = (bf16_t*)(P.ws + WS_EQK); float* GT = (float*)(P.ws + WS_EGT);
    float cw0[4][8], cw1[4][8], cwq[4][8];
#pragma unroll
    for (int e = 0; e < 8; ++e) {
#pragma unroll
        for (int t = 0; t < 3; ++t) {
            cw0[t][e] = P.ssd_conv_w[(size_t)(i_ * 3 + t) * 768 + 8 * lane + e];
            cw1[t][e] = P.ssd_conv_w[(size_t)(i_ * 3 + t) * 768 + 512 + 8 * (lane & 31) + e];
            cwq[t][e] = P.ml_conv_w[(size_t)(i_ * 3 + t) * 512 + 8 * lane + e];
        }
        cw0[3][e] = P.ssd_conv_b[i_ * 768 + 8 * lane + e]; cw1[3][e] = P.ssd_conv_b[i_ * 768 + 512 + 8 * (lane & 31) + e]; cwq[3][e] = P.ml_conv_b[i_ * 512 + 8 * lane + e];
    }
    float gbias = 0.f;
    if (lane < 16) gbias = P.ssd_dt_bias[i_ * 16 + lane]; else if (lane < 24) gbias = P.ml_i_bias[i_ * 8 + lane - 16]; else if (lane < 32) gbias = P.ml_f_bias[i_ * 8 + lane - 24];
    const float qscl = lane < 32 ? 0.125f : 1.f;
    for (int r = blockIdx.x * 8 + wid; r < NROWS; r += gridDim.x * 8) {
        int t, len; row_seg(r, t, len);
        const bf16_t* pr = Pb + (size_t)r * LDP_EVEN;
        const bool hp = t > 0, hn = t < len - 1;
        const u32x4 zero = (u32x4){0u, 0u, 0u, 0u};
        float fc[8], fp[8], fn[8], o[8];
        {
            const int col = 512 + 8 * lane;
            unpack8(*(const u32x4*)(pr + col), fc); unpack8(hp ? *(const u32x4*)(pr - LDP_EVEN + col) : zero, fp); unpack8(hn ? *(const u32x4*)(pr + LDP_EVEN + col) : zero, fn);
#pragma unroll
            for (int e = 0; e < 8; ++e) o[e] = siluf_(cw0[0][e] * fp[e] + cw0[1][e] * fc[e] + cw0[2][e] * fn[e] + cw0[3][e]);
            *(u32x4*)(XBC + (size_t)r * 768 + 8 * lane) = pack8(o);
        }
        if (lane < 32) {
            const int col = 1024 + 8 * lane;
            unpack8(*(const u32x4*)(pr + col), fc); unpack8(hp ? *(const u32x4*)(pr - LDP_EVEN + col) : zero, fp); unpack8(hn ? *(const u32x4*)(pr + LDP_EVEN + col) : zero, fn);
#pragma unroll
            for (int e = 0; e < 8; ++e) o[e] = siluf_(cw1[0][e] * fp[e] + cw1[1][e] * fc[e] + cw1[2][e] * fn[e] + cw1[3][e]);
            *(u32x4*)(XBC + (size_t)r * 768 + 512 + 8 * lane) = pack8(o);
        }
        {
            const int col = 1296 + 8 * lane;
            unpack8(*(const u32x4*)(pr + col), fc); unpack8(hp ? *(const u32x4*)(pr - LDP_EVEN + col) : zero, fp); unpack8(hn ? *(const u32x4*)(pr + LDP_EVEN + col) : zero, fn);
#pragma unroll
            for (int e = 0; e < 8; ++e) o[e] = qscl * siluf_(cwq[0][e] * fp[e] + cwq[1][e] * fc[e] + cwq[2][e] * fn[e] + cwq[3][e]);
            *(u32x4*)(QK + (size_t)r * 512 + 8 * lane) = pack8(o);
        }
        if (lane < 32) {
            const int col = lane < 16 ? 1280 + lane : 2832 + (lane - 16);
            const float x = bf2f(pr[col]) + gbias;
            GT[(size_t)r * 32 + lane] = lane < 16 ? softplusf_(x) : lane < 24 ? x : logsigmoidf_(x);
        }
    }
}

constexpr int CL = 64, NCH64 = NSTEPS / CL, LDT = 72, LDTB = LDT * 2;
__device__ __forceinline__ bf16x8 ldfrag(const LAS char* tile, int ldb, int row0, int k0, int lane) {
    return *(const LAS bf16x8*)(tile + (row0 + (lane & 15)) * ldb + (k0 + 8 * (lane >> 4)) * 2);
}
constexpr int LDTS = 160;
__device__ __forceinline__ int swz_off(int row, int byteoff) { return row * LDTS + (byteoff ^ (((row >> 3) & 7) << 4)); }
__device__ __forceinline__ bf16x8 ldfrag_sw(const LAS char* tile, int row0, int k0, int lane) {
    const int row = row0 + (lane & 15);
    return *(const LAS bf16x8*)(tile + swz_off(row, (k0 + 8 * (lane >> 4)) * 2));
}
__device__ __forceinline__ void st4bf(LAS char* p, const f32x4& v) { u32x2 o; o.x = pk2(v[0], v[1]); o.y = pk2(v[2], v[3]); *(LAS u32x2*)p = o; }

constexpr int SS_BT = 0, SS_CT = SS_BT + 64 * LDTB, SS_BDT = SS_CT + 64 * LDTB, SS_XT = SS_BDT + 64 * LDTB, SS_CUM = SS_XT + 32 * LDTB, SS_DTV = SS_CUM + 256, SS_ROWS = SS_DTV + 256, SS_STG = SS_ROWS + 256;
constexpr int SS_M = 2 * SS_STG, SS_HB = SS_M + 64 * LDTB, SS_END = SS_HB + 32 * LDTB;
static_assert(SS_END <= LDS_BYTES - 16, "SSD LDS map");

constexpr int MS_QT = 0, MS_KT = MS_QT + 64 * LDTB, MS_KET = MS_KT + 64 * LDTB, MS_VT = MS_KET + 64 * LDTB, MS_SC = MS_VT + 32 * LDTB;
constexpr int MS_STG = MS_SC + 8 * 256;
constexpr int MS_W = 2 * MS_STG, MS_CB = MS_W + 64 * LDTB, MS_ONE = MS_CB + 32 * LDTB, MS_NV = MS_ONE + 16 * LDTB, MS_QN = MS_NV + 256, MS_END = MS_QN + 256;
static_assert(MS_END <= LDS_BYTES - 16, "mLSTM LDS map");

constexpr size_t WS_XSS = WS_EGT + al256((size_t)NROWS * 32 * 4);
constexpr size_t XSS_BYTES = (size_t)64 * NCH64 * 64 * 64 * 2;
constexpr size_t WS_XSD = WS_XSS + XSS_BYTES;
constexpr size_t WS_XMC = WS_XSD + al256((size_t)64 * NCH64 * 4);
constexpr size_t XMC_BYTES = (size_t)32 * NCH64 * 128 * 64 * 2;
constexpr size_t WS_XMN = WS_XMC + XMC_BYTES;
constexpr size_t WS_XMS = WS_XMN + (size_t)32 * NCH64 * 64 * 4;
constexpr size_t WS_XMT = WS_XMS + al256((size_t)32 * NCH64 * 4 * 4);
constexpr size_t WS_XEND = WS_XMT + (size_t)32 * NCH64 * 3 * 64 * 4;
static_assert(WS_XEND <= WS_END, "even-layer chunk-state buffers must fit in the RWKV region");
constexpr int NSSD_ITEMS = 64 * NCH64, NML_ITEMS = 32 * NCH64;

template <int CTRL, int RM, int BM> __device__ __forceinline__ float dppx(float old, float v) {
    return __builtin_bit_cast(float, __builtin_amdgcn_update_dpp(__builtin_bit_cast(int, old), __builtin_bit_cast(int, v), CTRL, RM, BM, false));
}
__device__ __forceinline__ float wave_cumsum(float v, int) {
    float t = v;
    t += dppx<0x111, 0xf, 0xf>(0.f, v); t += dppx<0x112, 0xf, 0xf>(0.f, v); t += dppx<0x113, 0xf, 0xf>(0.f, v);
    { const float u = dppx<0x114, 0xf, 0xe>(0.f, t); t += u; }
    { const float u = dppx<0x118, 0xf, 0xc>(0.f, t); t += u; }
    { const float u = dppx<0x142, 0xa, 0xf>(0.f, t); t += u; }
    { const float u = dppx<0x143, 0xc, 0xf>(0.f, t); t += u; }
    return t;
}
__device__ __forceinline__ float wave_cummax(float v, int) {
    const float ninf = -__builtin_huge_valf();
    float t = v;
    t = fmaxf(t, dppx<0x111, 0xf, 0xf>(ninf, v)); t = fmaxf(t, dppx<0x112, 0xf, 0xf>(ninf, v)); t = fmaxf(t, dppx<0x113, 0xf, 0xf>(ninf, v));
    { const float u = dppx<0x114, 0xf, 0xe>(ninf, t); t = fmaxf(t, u); }
    { const float u = dppx<0x118, 0xf, 0xc>(ninf, t); t = fmaxf(t, u); }
    { const float u = dppx<0x142, 0xa, 0xf>(ninf, t); t = fmaxf(t, u); }
    { const float u = dppx<0x143, 0xc, 0xf>(ninf, t); t = fmaxf(t, u); }
    return t;
}
__device__ __forceinline__ float wave_max(float v) {
    const float t = wave_cummax(v, 0);
    return __builtin_bit_cast(float, __builtin_amdgcn_readlane(__builtin_bit_cast(int, t), 63));
}

constexpr int X1S_BDT = 0, X1S_XT = X1S_BDT + 64 * LDTS, X1S_CUM = X1S_XT + 64 * LDTS, X1S_DTV = X1S_CUM + 256, X1S_END = X1S_DTV + 256;
constexpr int X1M_KET = 0, X1M_VT = X1M_KET + 64 * LDTS, X1M_ONE = X1M_VT + 128 * LDTS, X1M_EE = X1M_ONE + 16 * LDTB, X1M_END = X1M_EE + 256;
__device__ __forceinline__ void phase_ex1(int wv, KP Pk, int layer, LAS char* lds) {
    asm volatile("" : "+s"(Pk));
    const CAS Params& P = *Pk;
    const int tid = ltid(wv), lane = tid & 63, wid = tid >> 6, q = lane >> 4, r16 = lane & 15, i_ = layer >> 1;
    const bf16_t* XBC = (const bf16_t*)(P.ws + WS_EXBC); const bf16_t* QK = (const bf16_t*)(P.ws + WS_EQK); const bf16_t* Pb = (const bf16_t*)(P.ws + WS_P);
    const float* GT = (const float*)(P.ws + WS_EGT);
    {
        bf16_t* Hst = (bf16_t*)(P.ws + WS_XSS); float* Dst = (float*)(P.ws + WS_XSD);
        u32x4 rc[2]; float rdt = 0.f;
        auto geom = [&](int it, int& b, int& h, int& dir, int& c) { const int sq = it / NCH64; c = it - sq * NCH64; b = sq >> 4; h = (sq >> 1) & 7; dir = sq & 1; };
        auto load = [&](int it) {
            int b, h, dir, c; geom(it, b, h, dir, c);
            int tl = tid; asm volatile("" : "+v"(tl));
#pragma unroll
            for (int s = 0; s < 2; ++s) {
                const int task = tl + NT * s, j = task >> 4, g = task & 15;
                const int row = scan_row(c * CL + j, b, dir, 0);
                rc[s] = *(const u32x4*)(XBC + (size_t)row * 768 + (g < 8 ? h * 64 + 8 * g : 512 + (h >> 2) * 64 + 8 * (g - 8)));
            }
            if (tl < CL) { const int row = scan_row(c * CL + tl, b, dir, 0); rdt = GT[(size_t)row * 32 + dir * 8 + h]; }
        };
        int it = blockIdx.x;
        if (it < NSSD_ITEMS) load(it);
        for (; it < NSSD_ITEMS; it += gridDim.x) {
            int b, h, dir, c; geom(it, b, h, dir, c);
            const float aco = -__expf(P.ssd_a_log[(i_ * 2 + dir) * 8 + h]);
            if (tid < CL) {
                const float cum = wave_cumsum(rdt * aco, lane);
                ((LAS float*)(lds + X1S_CUM))[tid] = cum; ((LAS float*)(lds + X1S_DTV))[tid] = rdt;
            }
            __syncthreads();
            {
                const LAS float* cum = (const LAS float*)(lds + X1S_CUM);
                const float cumL = cum[CL - 1];
                int tl = tid; asm volatile("" : "+v"(tl));
#pragma unroll
                for (int s = 0; s < 2; ++s) {
                    const int task = tl + NT * s, j = task >> 4, g = task & 15;
                    float f[8]; unpack8(rc[s], f);
                    if (g < 8) {
                        const float dt = ((const LAS float*)(lds + X1S_DTV))[j];
#pragma unroll
                        for (int e = 0; e < 8; ++e) *(LAS bf16_t*)(lds + X1S_XT + swz_off(8 * g + e, j * 2)) = f2bf(f[e] * dt);
                    } else {
                        const float sc = __expf(cumL - cum[j]);
#pragma unroll
                        for (int e = 0; e < 8; ++e) *(LAS bf16_t*)(lds + X1S_BDT + swz_off(8 * (g - 8) + e, j * 2)) = f2bf(f[e] * sc);
                    }
                }
                if (tid == 0) Dst[it] = __expf(cumL);
            }
            if (it + (int)gridDim.x < NSSD_ITEMS) load(it + gridDim.x);
            __syncthreads();
            {
                const int pt = wid >> 1;
#pragma unroll
                for (int u = 0; u < 2; ++u) {
                    const int nt = (wid & 1) * 2 + u;
                    f32x4 sa = (f32x4){0.f, 0.f, 0.f, 0.f};
#pragma unroll
                    for (int k0 = 0; k0 < 64; k0 += 32) sa = __builtin_amdgcn_mfma_f32_16x16x32_bf16(ldfrag_sw(lds + X1S_BDT, nt * 16, k0, lane), ldfrag_sw(lds + X1S_XT, pt * 16, k0, lane), sa, 0, 0, 0);
                    u32x2 o; o.x = pk2(sa[0], sa[1]); o.y = pk2(sa[2], sa[3]);
                    *(u32x2*)(Hst + ((size_t)it * 64 + pt * 16 + r16) * 64 + nt * 16 + 4 * q) = o;
                }
            }
            __syncthreads();
        }
    }
    {
        bf16_t* Cst = (bf16_t*)(P.ws + WS_XMC); float* Nst = (float*)(P.ws + WS_XMN); float* Sst = (float*)(P.ws + WS_XMS); float* Tst = (float*)(P.ws + WS_XMT);
        for (int i = tid; i < 16 * LDTB / 4; i += NT) ((LAS unsigned*)(lds + X1M_ONE))[i] = 0x3f803f80u;
        u32x4 rc[3]; float rli = 0.f, rlf = 0.f;
        auto geom = [&](int it, int& b, int& h, int& dir, int& c) { const int sq = it / NCH64; c = it - sq * NCH64; b = sq >> 3; h = (sq >> 1) & 3; dir = sq & 1; };
        auto load = [&](int it) {
            int b, h, dir, c; geom(it, b, h, dir, c);
            int tl = tid; asm volatile("" : "+v"(tl));
#pragma unroll
            for (int s = 0; s < 3; ++s) {
                const int task = tl + NT * s, j = task / 24, g = task - 24 * j;
                const int row = scan_row(c * CL + j, b, dir, 0);
                rc[s] = g < 8 ? *(const u32x4*)(QK + (size_t)row * 512 + 256 + h * 64 + 8 * g) : *(const u32x4*)(Pb + (size_t)row * LDP_EVEN + 1808 + h * 128 + 8 * (g - 8));
            }
            if (tl < CL) { const int row = scan_row(c * CL + tl, b, dir, 0); rli = GT[(size_t)row * 32 + 16 + dir * 4 + h]; rlf = GT[(size_t)row * 32 + 24 + dir * 4 + h]; }
        };
        int it = blockIdx.x;
        if (it < NML_ITEMS) load(it);
        __syncthreads();
        for (; it < NML_ITEMS; it += gridDim.x) {
            if (tid < CL) {
                const float fcum = wave_cumsum(rlf, lane);
                const float ftot = __builtin_bit_cast(float, __builtin_amdgcn_readlane(__builtin_bit_cast(int, fcum), 63));
                const float g = rli - fcum, pm = wave_cummax(g, lane);
                const float wend = ftot + g, mloc = wave_max(wend);
                ((LAS float*)(lds + X1M_EE))[tid] = __expf(wend - mloc);
                float* tp = Tst + (size_t)it * 192;
                tp[tid] = fcum; tp[64 + tid] = g; tp[128 + tid] = pm;
                if (tid == 0) { Sst[(size_t)it * 4 + 0] = ftot; Sst[(size_t)it * 4 + 1] = mloc; }
            }
            __syncthreads();
            {
                const LAS float* ee = (const LAS float*)(lds + X1M_EE);
                int tl = tid; asm volatile("" : "+v"(tl));
#pragma unroll
                for (int s = 0; s < 3; ++s) {
                    const int task = tl + NT * s, j = task / 24, g = task - 24 * j;
                    if (g < 8) {
                        float f[8]; unpack8(rc[s], f);
                        const float e1 = ee[j];
#pragma unroll
                        for (int e = 0; e < 8; ++e) *(LAS bf16_t*)(lds + X1M_KET + swz_off(8 * g + e, j * 2)) = f2bf(f[e] * e1);
                    } else {
                        const int v0 = 8 * (g - 8);
#pragma unroll
                        for (int e = 0; e < 8; ++e) { const unsigned wv = rc[s][e >> 1]; *(LAS bf16_t*)(lds + X1M_VT + swz_off(v0 + e, j * 2)) = (bf16_t)((e & 1) ? (wv >> 16) : (wv & 0xffffu)); }
                    }
                }
            }
            if (it + (int)gridDim.x < NML_ITEMS) load(it + gridDim.x);
            __syncthreads();
            {
                const bf16x8 vf0 = ldfrag_sw(lds + X1M_VT, wid * 16, 0, lane), vf1 = ldfrag_sw(lds + X1M_VT, wid * 16, 32, lane);
#pragma unroll
                for (int kt = 0; kt < 4; ++kt) {
                    f32x4 sa = __builtin_amdgcn_mfma_f32_16x16x32_bf16(ldfrag_sw(lds + X1M_KET, kt * 16, 0, lane), vf0, (f32x4){0.f, 0.f, 0.f, 0.f}, 0, 0, 0);
                    sa = __builtin_amdgcn_mfma_f32_16x16x32_bf16(ldfrag_sw(lds + X1M_KET, kt * 16, 32, lane), vf1, sa, 0, 0, 0);
                    u32x2 o; o.x = pk2(sa[0], sa[1]); o.y = pk2(sa[2], sa[3]);
                    *(u32x2*)(Cst + ((size_t)it * 128 + wid * 16 + r16) * 64 + kt * 16 + 4 * q) = o;
                }
                if (wid < 4) {
                    f32x4 na = __builtin_amdgcn_mfma_f32_16x16x32_bf16(ldfrag_sw(lds + X1M_KET, wid * 16, 0, lane), ldfrag(lds + X1M_ONE, LDTB, 0, 0, lane), (f32x4){0.f, 0.f, 0.f, 0.f}, 0, 0, 0);
                    na = __builtin_amdgcn_mfma_f32_16x16x32_bf16(ldfrag_sw(lds + X1M_KET, wid * 16, 32, lane), ldfrag(lds + X1M_ONE, LDTB, 0, 32, lane), na, 0, 0, 0);
                    if (r16 == 0) *(f32x4*)(Nst + (size_t)it * 64 + wid * 16 + 4 * q) = na;
                }
            }
            __syncthreads();
        }
    }
}

constexpr int EX2_UB = 12;
static_assert(NCH64 % EX2_UB == 0, "EX2 batches");
__device__ __forceinline__ void phase_ex2(int wv, KP Pk, int layer) {
    asm volatile("" : "+s"(Pk));
    const CAS Params& P = *Pk;
    const int tid = ltid(wv);
    (void)layer;
    if (blockIdx.x < 128) {
        const int gt = blockIdx.x * NT + tid, sq = gt >> 10, rem = gt & 1023;
        bf16_t* Hst = (bf16_t*)(P.ws + WS_XSS) + (size_t)sq * NCH64 * 4096 + rem * 4;
        const float* Dst = (const float*)(P.ws + WS_XSD) + sq * NCH64;
        float h0 = 0.f, h1 = 0.f, h2 = 0.f, h3 = 0.f;
#pragma unroll 1
        for (int c0 = 0; c0 < NCH64; c0 += EX2_UB) {
            u32x2 loc[EX2_UB]; float dd[EX2_UB];
            bf16_t* hp = Hst + (size_t)c0 * 4096;
#pragma unroll
            for (int u = 0; u < EX2_UB; ++u) { loc[u] = *(const u32x2*)(hp + (size_t)u * 4096); dd[u] = Dst[c0 + u]; }
#pragma unroll
            for (int u = 0; u < EX2_UB; ++u) {
                u32x2 o; o.x = pk2(h0, h1); o.y = pk2(h2, h3);
                *(u32x2*)(hp + (size_t)u * 4096) = o;
                const float d = dd[u];
                h0 = d * h0 + bflo(loc[u].x); h1 = d * h1 + bfhi(loc[u].x); h2 = d * h2 + bflo(loc[u].y); h3 = d * h3 + bfhi(loc[u].y);
            }
        }
    } else if (blockIdx.x < 256) {
        const int gt = (blockIdx.x - 128) * NT + tid, sq = gt >> 11, rem = gt & 2047;
        bf16_t* Cst = (bf16_t*)(P.ws + WS_XMC) + (size_t)sq * NCH64 * 8192 + rem * 4;
        float* Nst = (float*)(P.ws + WS_XMN) + (size_t)sq * NCH64 * 64 + (rem & 15) * 4;
        float* Sst = (float*)(P.ws + WS_XMS) + (size_t)sq * NCH64 * 4;
        const bool own_n = rem < 16, own_m = rem == 0;
        float c0_ = 0.f, c1 = 0.f, c2 = 0.f, c3 = 0.f, m = -1e30f;
        f32x4 nn = (f32x4){0.f, 0.f, 0.f, 0.f};
#pragma unroll 1
        for (int cb = 0; cb < NCH64; cb += EX2_UB) {
            u32x2 loc[EX2_UB]; float ft[EX2_UB], ml[EX2_UB]; f32x4 nl[EX2_UB];
            bf16_t* cp = Cst + (size_t)cb * 8192; float* np = Nst + (size_t)cb * 64; float* sp_ = Sst + cb * 4;
#pragma unroll
            for (int u = 0; u < EX2_UB; ++u) {
                loc[u] = *(const u32x2*)(cp + (size_t)u * 8192); ft[u] = sp_[u * 4 + 0]; ml[u] = sp_[u * 4 + 1];
                nl[u] = (f32x4){0.f, 0.f, 0.f, 0.f};
                if (own_n) nl[u] = *(const f32x4*)(np + (size_t)u * 64);
            }
#pragma unroll
            for (int u = 0; u < EX2_UB; ++u) {
                const float ftot = ft[u], mloc = ml[u];
                const float mnew = fmaxf(ftot + m, mloc), sp = __expf(ftot + m - mnew), sl = __expf(mloc - mnew);
                u32x2 o; o.x = pk2(c0_, c1); o.y = pk2(c2, c3);
                *(u32x2*)(cp + (size_t)u * 8192) = o;
                c0_ = sp * c0_ + sl * bflo(loc[u].x); c1 = sp * c1 + sl * bfhi(loc[u].x); c2 = sp * c2 + sl * bflo(loc[u].y); c3 = sp * c3 + sl * bfhi(loc[u].y);
                if (own_n) { *(f32x4*)(np + (size_t)u * 64) = nn; nn = nn * sp + nl[u] * sl; }
                if (own_m) sp_[u * 4 + 2] = m;
                m = mnew;
            }
        }
    }
}

constexpr int X3S_BT = 0, X3S_CT = X3S_BT + 64 * LDTB, X3S_XT = X3S_CT + 64 * LDTB, X3S_HB = X3S_XT + 64 * LDTS, X3S_M = X3S_HB + 64 * LDTB, X3S_CUM = X3S_M + 64 * LDTB, X3S_DTV = X3S_CUM + 256, X3S_ROWS = X3S_DTV + 256, X3S_END = X3S_ROWS + 256;
constexpr int X3M_QT = 0, X3M_KT = X3M_QT + 64 * LDTB, X3M_VT = X3M_KT + 64 * LDTB, X3M_CB = X3M_VT + 128 * LDTS, X3M_W = X3M_CB + 128 * LDTB, X3M_ONE = X3M_W + 64 * LDTB, X3M_NB = X3M_ONE + 16 * LDTB,
              X3M_SC = X3M_NB + 16 * LDTB, X3M_END = X3M_SC + 6 * 256;
static_assert(X3M_END <= LDS_BYTES - 16 && X3S_END <= LDS_BYTES - 16, "EX3 LDS maps");
__device__ __forceinline__ void phase_ex3(int wv, KP Pk, int layer, LAS char* lds) {
    asm volatile("" : "+s"(Pk));
    const CAS Params& P = *Pk;
    const int tid = ltid(wv), lane = tid & 63, wid = tid >> 6, q = lane >> 4, r16 = lane & 15, i_ = layer >> 1;
    const bf16_t* XBC = (const bf16_t*)(P.ws + WS_EXBC); const bf16_t* QK = (const bf16_t*)(P.ws + WS_EQK); const bf16_t* Pb = (const bf16_t*)(P.ws + WS_P);
    const float* GT = (const float*)(P.ws + WS_EGT);
    {
        const bf16_t* Hst = (const bf16_t*)(P.ws + WS_XSS);
        u32x4 rc[3], rh; float rdt = 0.f; int rrow = 0;
        auto geom = [&](int it, int& b, int& h, int& dir, int& c) { const int sq = it / NCH64; c = it - sq * NCH64; b = sq >> 4; h = (sq >> 1) & 7; dir = sq & 1; };
        auto load = [&](int it) {
            int b, h, dir, c; geom(it, b, h, dir, c);
            int tl = tid; asm volatile("" : "+v"(tl));
#pragma unroll
            for (int s = 0; s < 3; ++s) {
                const int task = tl + NT * s, j = task / 24, g = task - 24 * j;
                const int row = scan_row(c * CL + j, b, dir, 0);
                rc[s] = *(const u32x4*)(XBC + (size_t)row * 768 + (g < 8 ? h * 64 + 8 * g : g < 16 ? 512 + (h >> 2) * 64 + 8 * (g - 8) : 640 + (h >> 2) * 64 + 8 * (g - 16)));
            }
            rh = *(const u32x4*)(Hst + (size_t)it * 4096 + tl * 8);
            if (tl < CL) { rrow = scan_row(c * CL + tl, b, dir, 0); rdt = GT[(size_t)rrow * 32 + dir * 8 + h]; }
        };
        int it = blockIdx.x;
        if (it < NSSD_ITEMS) load(it);
        __syncthreads();
        for (; it < NSSD_ITEMS; it += gridDim.x) {
            int b, h, dir, c; geom(it, b, h, dir, c);
            bf16_t* Y = (bf16_t*)(P.ws + (dir ? WS_YB : WS_YF));
            const float aco = -__expf(P.ssd_a_log[(i_ * 2 + dir) * 8 + h]);
            if (tid < CL) {
                const float cum = wave_cumsum(rdt * aco, lane);
                ((LAS float*)(lds + X3S_CUM))[tid] = cum; ((LAS float*)(lds + X3S_DTV))[tid] = rdt; ((LAS int*)(lds + X3S_ROWS))[tid] = rrow;
            }
            __syncthreads();
            {
                int tl = tid; asm volatile("" : "+v"(tl));
#pragma unroll
                for (int s = 0; s < 3; ++s) {
                    const int task = tl + NT * s, j = task / 24, g = task - 24 * j;
                    if (g < 8) {
                        float f[8]; unpack8(rc[s], f);
                        const float dt = ((const LAS float*)(lds + X3S_DTV))[j];
#pragma unroll
                        for (int e = 0; e < 8; ++e) *(LAS bf16_t*)(lds + X3S_XT + swz_off(8 * g + e, j * 2)) = f2bf(f[e] * dt);
                    } else if (g < 16) *(LAS u32x4*)(lds + X3S_BT + j * LDTB + 8 * (g - 8) * 2) = rc[s];
                    else *(LAS u32x4*)(lds + X3S_CT + j * LDTB + 8 * (g - 16) * 2) = rc[s];
                }
                *(LAS u32x4*)(lds + X3S_HB + (tl >> 3) * LDTB + (tl & 7) * 16) = rh;
            }
            if (it + (int)gridDim.x < NSSD_ITEMS) load(it + gridDim.x);
            __syncthreads();
            const LAS float* cum = (const LAS float*)(lds + X3S_CUM);
            {
                const int lt = wid >> 1;
#pragma unroll
                for (int u = 0; u < 2; ++u) {
                    const int st = (wid & 1) * 2 + u;
                    f32x4 acc = (f32x4){0.f, 0.f, 0.f, 0.f};
                    if (st <= lt) {
#pragma unroll
                        for (int k0 = 0; k0 < 64; k0 += 32) acc = __builtin_amdgcn_mfma_f32_16x16x32_bf16(ldfrag(lds + X3S_BT, LDTB, st * 16, k0, lane), ldfrag(lds + X3S_CT, LDTB, lt * 16, k0, lane), acc, 0, 0, 0);
                        const int l = lt * 16 + r16, s0 = st * 16 + 4 * q;
                        const float cl = cum[l]; const f32x4 cs = *(const LAS f32x4*)(cum + s0);
#pragma unroll
                        for (int j = 0; j < 4; ++j) acc[j] = (s0 + j <= l) ? acc[j] * __expf(cl - cs[j]) : 0.f;
                    }
                    st4bf(lds + X3S_M + (lt * 16 + r16) * LDTB + (st * 16 + 4 * q) * 2, acc);
                }
            }
            __syncthreads();
            {
                const int lt = wid >> 1, l = lt * 16 + r16;
                const float el = __expf(cum[l]);
                const int row = ((const LAS int*)(lds + X3S_ROWS))[l];
                const bf16x8 mf0 = ldfrag(lds + X3S_M, LDTB, lt * 16, 0, lane), mf1 = ldfrag(lds + X3S_M, LDTB, lt * 16, 32, lane);
                const bf16x8 cf0 = ldfrag(lds + X3S_CT, LDTB, lt * 16, 0, lane), cf1 = ldfrag(lds + X3S_CT, LDTB, lt * 16, 32, lane);
#pragma unroll
                for (int u = 0; u < 2; ++u) {
                    const int pt = (wid & 1) * 2 + u;
                    f32x4 ya = __builtin_amdgcn_mfma_f32_16x16x32_bf16(ldfrag_sw(lds + X3S_XT, pt * 16, 0, lane), mf0, (f32x4){0.f, 0.f, 0.f, 0.f}, 0, 0, 0);
                    ya = __builtin_amdgcn_mfma_f32_16x16x32_bf16(ldfrag_sw(lds + X3S_XT, pt * 16, 32, lane), mf1, ya, 0, 0, 0);
                    f32x4 oa = __builtin_amdgcn_mfma_f32_16x16x32_bf16(ldfrag(lds + X3S_HB, LDTB, pt * 16, 0, lane), cf0, (f32x4){0.f, 0.f, 0.f, 0.f}, 0, 0, 0);
                    oa = __builtin_amdgcn_mfma_f32_16x16x32_bf16(ldfrag(lds + X3S_HB, LDTB, pt * 16, 32, lane), cf1, oa, 0, 0, 0);
                    u32x2 o; o.x = pk2(ya[0] + el * oa[0], ya[1] + el * oa[1]); o.y = pk2(ya[2] + el * oa[2], ya[3] + el * oa[3]);
                    *(u32x2*)(Y + (size_t)row * D + h * 64 + pt * 16 + 4 * q) = o;
                }
            }
            __syncthreads();
        }
    }
    {
        const bf16_t* Cst = (const bf16_t*)(P.ws + WS_XMC); const float* Nst = (const float*)(P.ws + WS_XMN); const float* Sst = (const float*)(P.ws + WS_XMS); const float* Tst = (const float*)(P.ws + WS_XMT);
        for (int i = tid; i < 16 * LDTB / 4; i += NT) ((LAS unsigned*)(lds + X3M_ONE))[i] = 0x3f803f80u;
        u32x4 rc[4], rcb[2]; float rfc = 0.f, rg = 0.f, rpm = 0.f, rmp = 0.f, rn = 0.f; int rrow = 0;
        auto geom = [&](int it, int& b, int& h, int& dir, int& c) { const int sq = it / NCH64; c = it - sq * NCH64; b = sq >> 3; h = (sq >> 1) & 3; dir = sq & 1; };
        auto load = [&](int it) {
            int b, h, dir, c; geom(it, b, h, dir, c);
            int tl = tid; asm volatile("" : "+v"(tl));
#pragma unroll
            for (int s = 0; s < 4; ++s) {
                const int task = tl + NT * s, j = task >> 5, g = task & 31;
                const int row = scan_row(c * CL + j, b, dir, 0);
                rc[s] = g < 16 ? *(const u32x4*)(QK + (size_t)row * 512 + (g < 8 ? h * 64 + 8 * g : 256 + h * 64 + 8 * (g - 8))) : *(const u32x4*)(Pb + (size_t)row * LDP_EVEN + 1808 + h * 128 + 8 * (g - 16));
            }
#pragma unroll
            for (int s = 0; s < 2; ++s) rcb[s] = *(const u32x4*)(Cst + (size_t)it * 8192 + (tl + NT * s) * 8);
            if (tl < CL) {
                rrow = scan_row(c * CL + tl, b, dir, 0);
                const float* tp = Tst + (size_t)it * 192;
                rfc = tp[tl]; rg = tp[64 + tl]; rpm = tp[128 + tl]; rmp = Sst[(size_t)it * 4 + 2]; rn = Nst[(size_t)it * 64 + tl];
            }
        };
        int it = blockIdx.x;
        if (it < NML_ITEMS) load(it);
        __syncthreads();
        for (; it < NML_ITEMS; it += gridDim.x) {
            int b, h, dir, c; geom(it, b, h, dir, c);
            bf16_t* Y = (bf16_t*)(P.ws + (dir ? WS_YB : WS_YF));
            LAS float* sc = (LAS float*)(lds + X3M_SC);
            {
                int tl = tid; asm volatile("" : "+v"(tl));
#pragma unroll
                for (int s = 0; s < 4; ++s) {
                    const int task = tl + NT * s, j = task >> 5, g = task & 31;
                    if (g < 8) *(LAS u32x4*)(lds + X3M_QT + j * LDTB + 8 * g * 2) = rc[s];
                    else if (g < 16) *(LAS u32x4*)(lds + X3M_KT + j * LDTB + 8 * (g - 8) * 2) = rc[s];
                    else {
                        const int v0 = 8 * (g - 16);
#pragma unroll
                        for (int e = 0; e < 8; ++e) { const unsigned wv = rc[s][e >> 1]; *(LAS bf16_t*)(lds + X3M_VT + swz_off(v0 + e, j * 2)) = (bf16_t)((e & 1) ? (wv >> 16) : (wv & 0xffffu)); }
                    }
                }
#pragma unroll
                for (int s = 0; s < 2; ++s) { const int ch = tl + NT * s; *(LAS u32x4*)(lds + X3M_CB + (ch >> 3) * LDTB + (ch & 7) * 16) = rcb[s]; }
                if (tl < CL) {
                    const float linter = rfc + rmp, mrow = fmaxf(rfc + rpm, linter);
                    sc[tl] = rfc - mrow; sc[64 + tl] = rg; sc[128 + tl] = __expf(linter - mrow); sc[192 + tl] = __expf(-mrow); ((LAS int*)sc)[256 + tl] = rrow;
                    const bf16_t nb = f2bf(rn);
#pragma unroll
                    for (int r = 0; r < 16; ++r) *(LAS bf16_t*)(lds + X3M_NB + r * LDTB + tl * 2) = nb;
                }
            }
            if (it + (int)gridDim.x < NML_ITEMS) load(it + gridDim.x);
            __syncthreads();
            {
                const int lt = wid >> 1;
#pragma unroll
                for (int u = 0; u < 2; ++u) {
                    const int st = (wid & 1) * 2 + u;
                    f32x4 acc = (f32x4){0.f, 0.f, 0.f, 0.f};
                    if (st <= lt) {
#pragma unroll
                        for (int k0 = 0; k0 < 64; k0 += 32) acc = __builtin_amdgcn_mfma_f32_16x16x32_bf16(ldfrag(lds + X3M_KT, LDTB, st * 16, k0, lane), ldfrag(lds + X3M_QT, LDTB, lt * 16, k0, lane), acc, 0, 0, 0);
                        const int l = lt * 16 + r16, s0 = st * 16 + 4 * q;
                        const float rt = sc[l]; const f32x4 gs = *(const LAS f32x4*)(sc + 64 + s0);
#pragma unroll
                        for (int j = 0; j < 4; ++j) acc[j] = (s0 + j <= l) ? acc[j] * __expf(rt + gs[j]) : 0.f;
                    }
                    st4bf(lds + X3M_W + (lt * 16 + r16) * LDTB + (st * 16 + 4 * q) * 2, acc);
                }
            }
            __syncthreads();
            {
                const int lt = wid >> 1, l = lt * 16 + r16;
                const bf16x8 wf0 = ldfrag(lds + X3M_W, LDTB, lt * 16, 0, lane), wf1 = ldfrag(lds + X3M_W, LDTB, lt * 16, 32, lane);
                const bf16x8 qf0 = ldfrag(lds + X3M_QT, LDTB, lt * 16, 0, lane), qf1 = ldfrag(lds + X3M_QT, LDTB, lt * 16, 32, lane);
                f32x4 da = __builtin_amdgcn_mfma_f32_16x16x32_bf16(ldfrag(lds + X3M_ONE, LDTB, 0, 0, lane), wf0, (f32x4){0.f, 0.f, 0.f, 0.f}, 0, 0, 0);
                da = __builtin_amdgcn_mfma_f32_16x16x32_bf16(ldfrag(lds + X3M_ONE, LDTB, 0, 32, lane), wf1, da, 0, 0, 0);
                f32x4 qn = __builtin_amdgcn_mfma_f32_16x16x32_bf16(ldfrag(lds + X3M_NB, LDTB, 0, 0, lane), qf0, (f32x4){0.f, 0.f, 0.f, 0.f}, 0, 0, 0);
                qn = __builtin_amdgcn_mfma_f32_16x16x32_bf16(ldfrag(lds + X3M_NB, LDTB, 0, 32, lane), qf1, qn, 0, 0, 0);
                const float inter = sc[128 + l], emr = sc[192 + l];
                const float inv = __builtin_amdgcn_rcpf(fmaxf(fabsf(da[0] + inter * qn[0]), emr));
                const int row = ((const LAS int*)sc)[256 + l];
#pragma unroll
                for (int u = 0; u < 4; ++u) {
                    const int vt = (wid & 1) * 4 + u;
                    f32x4 na = __builtin_amdgcn_mfma_f32_16x16x32_bf16(ldfrag_sw(lds + X3M_VT, vt * 16, 0, lane), wf0, (f32x4){0.f, 0.f, 0.f, 0.f}, 0, 0, 0);
                    na = __builtin_amdgcn_mfma_f32_16x16x32_bf16(ldfrag_sw(lds + X3M_VT, vt * 16, 32, lane), wf1, na, 0, 0, 0);
                    f32x4 ca = __builtin_amdgcn_mfma_f32_16x16x32_bf16(ldfrag(lds + X3M_CB, LDTB, vt * 16, 0, lane), qf0, (f32x4){0.f, 0.f, 0.f, 0.f}, 0, 0, 0);
                    ca = __builtin_amdgcn_mfma_f32_16x16x32_bf16(ldfrag(lds + X3M_CB, LDTB, vt * 16, 32, lane), qf1, ca, 0, 0, 0);
                    u32x2 o; o.x = pk2((na[0] + inter * ca[0]) * inv, (na[1] + inter * ca[1]) * inv); o.y = pk2((na[2] + inter * ca[2]) * inv, (na[3] + inter * ca[3]) * inv);
                    *(u32x2*)(Y + (size_t)row * D + 512 + h * 128 + vt * 16 + 4 * q) = o;
                }
            }
            __syncthreads();
        }
    }
}

constexpr int HC_RAWF = 0;
constexpr int HC_RAWQ = HC_RAWF + 64 * 128 * 4;
constexpr int HC_SUB = HC_RAWQ + 64 * 128 * 2;
constexpr int HL_QD = 136 * 2;
constexpr int HL_T = 24 * 2;
constexpr int HS_QI = 0, HS_KO = HS_QI + 16 * HL_QD, HS_KET = HS_KO + 16 * HL_QD, HS_ATT = HS_KET + 128 * HL_T, HS_VT = HS_ATT + 16 * HL_T, HS_DEC = HS_VT + 32 * HL_T, HS_SIZE = HS_DEC + 512;
constexpr int HC_SB = HC_SUB + 4 * HS_SIZE;
constexpr int HC_ROWS = HC_SB + 2 * 32 * HL_QD, HC_CST = HC_ROWS + 256, HC_END = HC_CST + 1024;
static_assert(HC_END <= LDS_BYTES - 16, "HGRN2 LDS map");
static_assert(HS_SIZE % 16 == 0 && HC_SB % 16 == 0, "alignment");
__device__ __forceinline__ bf16x8 ldfrag16(const LAS char* tile, int ldb, int row0, int lane) {
    bf16x8 v = *(const LAS bf16x8*)(tile + (row0 + (lane & 15)) * ldb + ((lane >> 4) & 1) * 16);
    if (lane >= 32) v = (bf16x8){0, 0, 0, 0, 0, 0, 0, 0};
    return v;
}
__device__ __forceinline__ void scan_hgrn_c(int wv, KP Pk, int layer, int unit, LAS char* lds) {
    asm volatile("" : "+s"(Pk));
    const CAS Params& P = *Pk;
    const int tid = ltid(wv), lane = tid & 63, wid = tid >> 6, q = lane >> 4, r16 = lane & 15, i_ = layer >> 1;
    const int seq = unit >> 2, quarter = unit & 3, b = seq >> 3, h = (seq >> 1) & 3, dir = seq & 1;
    const bf16_t* Pb = (const bf16_t*)(P.ws + WS_P);
    bf16_t* Y = (bf16_t*)(P.ws + (dir ? WS_YB : WS_YF));
    LAS float* cst = (LAS float*)(lds + HC_CST);
    if (tid < 128) cst[tid] = ((const float*)(P.ws + WS_LB))[layer * 512 + h * 128 + tid];
    else if (tid < 256) cst[tid] = P.hg_f_bias[(size_t)(i_ * 2 + dir) * 512 + h * 128 + tid - 128];
    for (int i = tid; i < 2 * 32 * HL_QD / 4; i += NT) ((LAS unsigned*)(lds + HC_SB))[i] = 0u;
    int tj[5], tg_[5], tcol[5]; bool tv[5];
#pragma unroll
    for (int s = 0; s < 5; ++s) {
        const int task = tid + NT * s; tv[s] = task < 64 * 36; tj[s] = task / 36; tg_[s] = task % 36;
        const int g = tg_[s];
        tcol[s] = g < 16 ? (512 + dir * 512 + h * 128 + 8 * g) : g < 32 ? (h * 128 + 8 * (g - 16)) : (1536 + h * 128 + quarter * 32 + 8 * (g - 32));
    }
    u32x4 rc[5]; int rrow = 0;
    auto load = [&](int c) {
#pragma unroll
        for (int s = 0; s < 5; ++s) {
            rc[s] = (u32x4){0u, 0u, 0u, 0u};
            if (tv[s]) { const int row = scan_row(c * 64 + tj[s], b, dir, 1); rc[s] = *(const u32x4*)(Pb + (size_t)row * LDP_ODD + tcol[s]); }
        }
        if (tid < 64) rrow = scan_row(c * 64 + tid, b, dir, 1);
    };
    auto storeA = [&]() {
#pragma unroll
        for (int s = 0; s < 5; ++s) {
            if (tv[s]) {
                float f[8]; unpack8(rc[s], f);
                const int j = tj[s], g = tg_[s];
                if (g < 16) {
                    float o[8];
#pragma unroll
                    for (int e = 0; e < 8; ++e) { const float lbv = cst[8 * g + e]; o[e] = lbv + (1.f - lbv) * sigmoidf_(f[e] + cst[128 + 8 * g + e]); }
                    LAS float* dst = (LAS float*)(lds + HC_RAWF) + j * 128 + 8 * g;
                    *(LAS f32x4*)dst = (f32x4){o[0], o[1], o[2], o[3]}; *(LAS f32x4*)(dst + 4) = (f32x4){o[4], o[5], o[6], o[7]};
                } else if (g < 32) {
                    float o[8];
#pragma unroll
                    for (int e = 0; e < 8; ++e) o[e] = siluf_(f[e]);
                    *(LAS u32x4*)(lds + HC_RAWQ + (j * 128 + 8 * (g - 16)) * 2) = pack8(o);
                } else {
                    const int v0 = 8 * (g - 32);
                    LAS char* vt = lds + HC_SUB + (j >> 4) * HS_SIZE + HS_VT;
#pragma unroll
                    for (int e = 0; e < 8; ++e) { const unsigned wv = rc[s][e >> 1]; *(LAS bf16_t*)(vt + (v0 + e) * HL_T + (j & 15) * 2) = (bf16_t)((e & 1) ? (wv >> 16) : (wv & 0xffffu)); }
                }
            }
        }
        if (tid < 64) ((LAS int*)(lds + HC_ROWS))[tid] = rrow;
    };
    auto storeB = [&]() {
        const int d = tid & 127, sb = tid >> 7;
        LAS char* st = lds + HC_SUB + sb * HS_SIZE;
        const LAS float* rf = (const LAS float*)(lds + HC_RAWF) + (sb * 16) * 128 + d;
        const LAS bf16_t* rq = (const LAS bf16_t*)(lds + HC_RAWQ) + (sb * 16) * 128 + d;
        float lam = 0.f, lams[16], kfs[16];
#pragma unroll
        for (int t = 0; t < 16; ++t) {
            const float f = rf[t * 128];
            lam += __logf(f);
            const float kf = 1.f - f;
            lams[t] = lam; kfs[t] = kf;
            *(LAS bf16_t*)(st + HS_QI + t * HL_QD + d * 2) = f2bf(bf2f(rq[t * 128]) * __expf(lam));
            *(LAS bf16_t*)(st + HS_KO + t * HL_QD + d * 2) = f2bf(kf * __expf(-lam));
        }
        float ke[16];
#pragma unroll
        for (int t = 0; t < 16; ++t) ke[t] = kfs[t] * __expf(lam - lams[t]);
        *(LAS u32x4*)(st + HS_KET + d * HL_T) = pack8(ke); *(LAS u32x4*)(st + HS_KET + d * HL_T + 16) = pack8(ke + 8);
        ((LAS float*)(st + HS_DEC))[d] = __expf(lam);
    };
    f32x4 sacc[2];
    sacc[0] = sacc[1] = (f32x4){0.f, 0.f, 0.f, 0.f};
    __syncthreads();
    load(0);
    for (int c = 0; c < NSTEPS / 64; ++c) {
        storeA();
        __syncthreads();
        storeB();
        if (c + 1 < NSTEPS / 64) load(c + 1);
        __syncthreads();
        if (wid < 4) {
            LAS char* st = lds + HC_SUB + wid * HS_SIZE;
            f32x4 acc = (f32x4){0.f, 0.f, 0.f, 0.f};
#pragma unroll
            for (int k0 = 0; k0 < 128; k0 += 32) acc = __builtin_amdgcn_mfma_f32_16x16x32_bf16(ldfrag(st + HS_KO, HL_QD, 0, k0, lane), ldfrag(st + HS_QI, HL_QD, 0, k0, lane), acc, 0, 0, 0);
#pragma unroll
            for (int j = 0; j < 4; ++j) acc[j] = (4 * q + j <= r16) ? acc[j] : 0.f;
            st4bf(st + HS_ATT + r16 * HL_T + 4 * q * 2, acc);
        }
        __syncthreads();
#pragma unroll 1
        for (int sb = 0; sb < 4; ++sb) {
            LAS char* st = lds + HC_SUB + sb * HS_SIZE;
            const LAS char* sbr = lds + HC_SB + (sb & 1) * 32 * HL_QD;
            LAS char* sbw = lds + HC_SB + ((sb + 1) & 1) * 32 * HL_QD;
            if (wid < 2) {
                f32x4 ya = __builtin_amdgcn_mfma_f32_16x16x32_bf16(ldfrag16(st + HS_VT, HL_T, wid * 16, lane), ldfrag16(st + HS_ATT, HL_T, 0, lane), (f32x4){0.f, 0.f, 0.f, 0.f}, 0, 0, 0);
#pragma unroll
                for (int k0 = 0; k0 < 128; k0 += 32) ya = __builtin_amdgcn_mfma_f32_16x16x32_bf16(ldfrag(sbr, HL_QD, wid * 16, k0, lane), ldfrag(st + HS_QI, HL_QD, 0, k0, lane), ya, 0, 0, 0);
                const int row = ((const LAS int*)(lds + HC_ROWS))[sb * 16 + r16];
                u32x2 o; o.x = pk2(ya[0], ya[1]); o.y = pk2(ya[2], ya[3]);
                *(u32x2*)(Y + (size_t)row * D + h * 128 + quarter * 32 + wid * 16 + 4 * q) = o;
            }
            {
                const int vt = wid >> 2;
                const bf16x8 vf = ldfrag16(st + HS_VT, HL_T, vt * 16, lane);
#pragma unroll
                for (int u = 0; u < 2; ++u) {
                    const int dt = (wid & 3) * 2 + u;
                    const f32x4 a = __builtin_amdgcn_mfma_f32_16x16x32_bf16(ldfrag16(st + HS_KET, HL_T, dt * 16, lane), vf, (f32x4){0.f, 0.f, 0.f, 0.f}, 0, 0, 0);
                    const f32x4 dc = *(const LAS f32x4*)((const LAS float*)(st + HS_DEC) + dt * 16 + 4 * q);
#pragma unroll
                    for (int j = 0; j < 4; ++j) sacc[u][j] = sacc[u][j] * dc[j] + a[j];
                    st4bf(sbw + (vt * 16 + r16) * HL_QD + (dt * 16 + 4 * q) * 2, sacc[u]);
                }
            }
            __syncthreads();
        }
    }
}

constexpr int RC_RAWW = 0;
constexpr int RC_RAWA = RC_RAWW + 64 * 64 * 4;
constexpr int RC_RAWB = RC_RAWA + 64 * 64 * 2, RC_RAWK = RC_RAWB + 64 * 64 * 2, RC_RAWR = RC_RAWK + 64 * 64 * 2;
constexpr int RC_SUB = RC_RAWR + 64 * 64 * 2;
constexpr int RL_C = 72 * 2, RL_32 = 40 * 2, RL_16 = 24 * 2;
constexpr int RS_AT = 0, RS_RT = RS_AT + 16 * RL_C, RS_KT = RS_RT + 16 * RL_C, RS_BT = RS_KT + 16 * RL_C, RS_KBH = RS_BT + 16 * RL_C, RS_AAK = RS_KBH + 64 * RL_32,
              RS_ARKB = RS_AAK + 16 * RL_16, RS_T = RS_ARKB + 16 * RL_32, RS_AABF = RS_T + 16 * RL_16, RS_GL = RS_AABF + 16 * 16 * 4, RS_VU = RS_GL + 256, RS_SIZE = RS_VU + 32 * RL_32;
constexpr int RC_SB = RC_SUB + 4 * RS_SIZE;
constexpr int RC_RHT = RC_SB + 32 * RL_C;
constexpr int RC_ROWS = RC_RHT + 32 * RL_16, RC_END = RC_ROWS + 256;
static_assert(RC_END <= LDS_BYTES - 16, "RWKV LDS map");
static_assert(RS_SIZE % 16 == 0 && RC_SB % 16 == 0 && RC_RHT % 16 == 0, "alignment");

__device__ __forceinline__ float allreduce8(float v) {
    v += dppmov<0xB1>(v); v += dppmov<0x4E>(v); v += dppmov<0x141>(v);
    return v;
}

__device__ __forceinline__ void phase_prep1(int wv, KP Pk, int layer) {
    asm volatile("" : "+s"(Pk));
    const CAS Params& P = *Pk;
    const int tid = ltid(wv), lane = tid & 63, wid = tid >> 6, i_ = layer >> 1;
    const bf16_t* Pb = (const bf16_t*)(P.ws + WS_P);
    bf16_t* R = (bf16_t*)(P.ws + WS_RWR); bf16_t* K = (bf16_t*)(P.ws + WS_RWK); bf16_t* V = (bf16_t*)(P.ws + WS_RWV); bf16_t* KK = (bf16_t*)(P.ws + WS_RWKK);
    bf16_t* LA = (bf16_t*)(P.ws + WS_LA);
    const float* mu = P.rw_mu + (size_t)i_ * 1856;
    float mur[8], muv[8], muk[8], mul_[8], kkw[8];
#pragma unroll
    for (int e = 0; e < 8; ++e) { mur[e] = mu[8 * lane + e]; muv[e] = mu[1024 + 8 * lane + e]; muk[e] = mu[512 + 8 * lane + e]; mul_[e] = lane < 40 ? mu[1536 + 8 * lane + e] : 0.f; kkw[e] = P.rw_k_k[i_ * 512 + 8 * lane + e]; }
    for (int r = blockIdx.x * 8 + wid; r < NROWS; r += gridDim.x * 8) {
        int rprev = -1, rnext = -1;
        if (r < NCTX) { const int t = r & 255; if (t > 0) rprev = r - 1; if (t < CTXL - 1) rnext = r + 1; }
        else {
            const int bs = (r - NCTX) >> 13, s = (r - NCTX) & 8191, sg = ((s & 63) << 7) + (s >> 6);
            if (sg > 0) { const int g2 = sg - 1; rprev = NCTX + bs * SEQ + ((g2 & 127) << 6) + (g2 >> 7); }
            if (sg < SEQ - 1) { const int g2 = sg + 1; rnext = NCTX + bs * SEQ + ((g2 & 127) << 6) + (g2 >> 7); }
        }
        const bf16_t* pc = Pb + (size_t)r * LDP_ODD + 2560;
        const bf16_t* pp = Pb + (size_t)(rprev < 0 ? r : rprev) * LDP_ODD + 2560;
        const bf16_t* pn = Pb + (size_t)(rnext < 0 ? r : rnext) * LDP_ODD + 2560;
        const float mp = rprev < 0 ? 0.f : 0.5f, mn = rnext < 0 ? 0.f : 0.5f;
        auto mix8 = [&](int col, const float* muc, float* o) {
            float fc[8], fp[8], fn[8];
            unpack8(*(const u32x4*)(pc + col), fc); unpack8(*(const u32x4*)(pp + col), fp); unpack8(*(const u32x4*)(pn + col), fn);
#pragma unroll
            for (int e = 0; e < 8; ++e) o[e] = fc[e] + muc[e] * (mp * fp[e] + mn * fn[e] - fc[e]);
        };
        float o[8];
        mix8(8 * lane, mur, o); *(u32x4*)(R + (size_t)r * 512 + 8 * lane) = pack8(o);
        mix8(1024 + 8 * lane, muv, o); *(u32x4*)(V + (size_t)r * 512 + 8 * lane) = pack8(o);
        mix8(512 + 8 * lane, muk, o); *(u32x4*)(K + (size_t)r * 512 + 8 * lane) = pack8(o);
        {
            float kk[8], ss = 0.f;
#pragma unroll
            for (int e = 0; e < 8; ++e) { kk[e] = o[e] * kkw[e]; ss += kk[e] * kk[e]; }
            ss = group_sum<8>(ss);
            const float rn = rsqrtf(fmaxf(ss, 1e-12f));
#pragma unroll
            for (int e = 0; e < 8; ++e) kk[e] *= rn;
            *(u32x4*)(KK + (size_t)r * 512 + 8 * lane) = pack8(kk);
        }
        if (lane < 40) {
            mix8(1536 + 8 * lane, mul_, o);
            if (lane < 16) {
#pragma unroll
                for (int e = 0; e < 8; ++e) o[e] = tanh_fast(o[e]);
            } else if (lane >= 24) {
#pragma unroll
                for (int e = 0; e < 8; ++e) o[e] = sigmoidf_(o[e]);
            }
            *(u32x4*)(LA + (size_t)r * 320 + 8 * lane) = pack8(o);
        }
    }
}

__device__ __forceinline__ void phase_out_even(int wv, KP Pk, int layer) {
    asm volatile("" : "+s"(Pk));
    const CAS Params& P = *Pk;
    const int tid = ltid(wv), lane = tid & 63, wid = tid >> 6, i_ = layer >> 1;
    const bf16_t* Pb = (const bf16_t*)(P.ws + WS_P);
    const bf16_t* Yf = (const bf16_t*)(P.ws + WS_YF); const bf16_t* Yb = (const bf16_t*)(P.ws + WS_YB);
    bf16_t* feat = (bf16_t*)(P.ws + WS_FEAT);
    const int r0 = (layer == DEPTH - 1) ? NCTX : 0;
    const bf16_t* XBC = (const bf16_t*)(P.ws + WS_EXBC);
    float nwa[8], nwb[8];
#pragma unroll
    for (int e = 0; e < 8; ++e) { nwa[e] = P.ssd_norm_w[i_ * 512 + 8 * lane + e]; nwb[e] = P.ml_norm_w[i_ * 512 + 8 * lane + e]; }
    const float dsk = P.ssd_d[i_ * 8 + (lane >> 3)];
    for (int r = r0 + blockIdx.x * 8 + wid; r < NROWS; r += gridDim.x * 8) {
        const bf16_t* pr = Pb + (size_t)r * LDP_EVEN;
        float y[8];
        {
            float a[8], bb[8], xsv[8], z[8];
            unpack8(*(const u32x4*)(Yf + (size_t)r * D + 8 * lane), a); unpack8(*(const u32x4*)(Yb + (size_t)r * D + 8 * lane), bb);
            unpack8(*(const u32x4*)(XBC + (size_t)r * 768 + 8 * lane), xsv); unpack8(*(const u32x4*)(pr + 8 * lane), z);
            float ss = 0.f;
#pragma unroll
            for (int e = 0; e < 8; ++e) {
                y[e] = (a[e] + bb[e] + dsk * xsv[e]) * siluf_(z[e]); ss += y[e] * y[e];
            }
            ss = wave_sum(ss);
            const float rn = rsqrtf(ss * (1.f / 512.f) + 1e-6f);
#pragma unroll
            for (int e = 0; e < 8; ++e) y[e] = y[e] * rn * nwa[e];
            *(u32x4*)(feat + (size_t)r * D + 8 * lane) = pack8(y);
        }
        {
            float a[8], bb[8], o[8];
            unpack8(*(const u32x4*)(Yf + (size_t)r * D + 512 + 8 * lane), a); unpack8(*(const u32x4*)(Yb + (size_t)r * D + 512 + 8 * lane), bb);
            unpack8(*(const u32x4*)(pr + 2320 + 8 * lane), o);
            float s = 0.f;
#pragma unroll
            for (int e = 0; e < 8; ++e) { y[e] = a[e] + bb[e]; s += y[e]; }
            const float mean = group_sum<16>(s) * (1.f / 128.f);
            float ss = 0.f;
#pragma unroll
            for (int e = 0; e < 8; ++e) { y[e] -= mean; ss += y[e] * y[e]; }
            const float rn = rsqrtf(group_sum<16>(ss) * (1.f / 128.f) + 1e-6f);
#pragma unroll
            for (int e = 0; e < 8; ++e) y[e] = sigmoidf_(o[e]) * (y[e] * rn) * nwb[e];
            *(u32x4*)(feat + (size_t)r * D + 512 + 8 * lane) = pack8(y);
        }
    }
}
__device__ __forceinline__ void phase_out_odd(int wv, KP Pk, int layer) {
    asm volatile("" : "+s"(Pk));
    const CAS Params& P = *Pk;
    const int tid = ltid(wv), lane = tid & 63, wid = tid >> 6, i_ = layer >> 1;
    const bf16_t* Pb = (const bf16_t*)(P.ws + WS_P);
    const bf16_t* Yf = (const bf16_t*)(P.ws + WS_YF); const bf16_t* Yb = (const bf16_t*)(P.ws + WS_YB);
    const bf16_t* R = (const bf16_t*)(P.ws + WS_RWR); const bf16_t* K = (const bf16_t*)(P.ws + WS_RWK); const bf16_t* V = (const bf16_t*)(P.ws + WS_RWV); const bf16_t* G = (const bf16_t*)(P.ws + WS_RWG);
    bf16_t* feat = (bf16_t*)(P.ws + WS_FEAT);
    const int r0 = (layer == DEPTH - 1) ? NCTX : 0;
    float nwc[8], rk[8], lw[8], lbv[8];
#pragma unroll
    for (int e = 0; e < 8; ++e) {
        nwc[e] = P.hg_norm_w[i_ * 512 + 8 * lane + e]; rk[e] = P.rw_r_k[i_ * 512 + 8 * lane + e];
        lw[e] = P.rw_ln_w[i_ * 512 + 8 * lane + e]; lbv[e] = P.rw_ln_b[i_ * 512 + 8 * lane + e];
    }
    for (int r = r0 + blockIdx.x * 8 + wid; r < NROWS; r += gridDim.x * 8) {
        float y[8];
        {
            float a[8], bb[8], g[8];
            unpack8(*(const u32x4*)(Yf + (size_t)r * D + 8 * lane), a); unpack8(*(const u32x4*)(Yb + (size_t)r * D + 8 * lane), bb);
            unpack8(*(const u32x4*)(Pb + (size_t)r * LDP_ODD + 2048 + 8 * lane), g);
            float ss = 0.f;
#pragma unroll
            for (int e = 0; e < 8; ++e) { y[e] = a[e] + bb[e]; ss += y[e] * y[e]; }
            const float rn = rsqrtf(group_sum<16>(ss) * (1.f / 128.f) + 1e-6f);
#pragma unroll
            for (int e = 0; e < 8; ++e) y[e] = y[e] * rn * nwc[e] * siluf_(g[e]);
            *(u32x4*)(feat + (size_t)r * D + 8 * lane) = pack8(y);
        }
        {
            float a[8], bb[8], rr[8], kk[8], vv[8], g[8];
            unpack8(*(const u32x4*)(Yf + (size_t)r * D + 512 + 8 * lane), a); unpack8(*(const u32x4*)(Yb + (size_t)r * D + 512 + 8 * lane), bb);
            unpack8(*(const u32x4*)(R + (size_t)r * 512 + 8 * lane), rr); unpack8(*(const u32x4*)(K + (size_t)r * 512 + 8 * lane), kk);
            unpack8(*(const u32x4*)(V + (size_t)r * 512 + 8 * lane), vv); unpack8(*(const u32x4*)(G + (size_t)r * 512 + 8 * lane), g);
            float s = 0.f, bs = 0.f;
#pragma unroll
            for (int e = 0; e < 8; ++e) { y[e] = a[e] + bb[e]; s += y[e]; bs += rr[e] * kk[e] * rk[e]; }
            const float mean = group_sum<8>(s) * (1.f / 64.f); bs = group_sum<8>(bs);
            float ss = 0.f;
#pragma unroll
            for (int e = 0; e < 8; ++e) { y[e] -= mean; ss += y[e] * y[e]; }
            const float rn = rsqrtf(group_sum<8>(ss) * (1.f / 64.f) + 64e-5f);
#pragma unroll
            for (int e = 0; e < 8; ++e) y[e] = (y[e] * rn * lw[e] + lbv[e] + bs * vv[e]) * g[e];
            *(u32x4*)(feat + (size_t)r * D + 512 + 8 * lane) = pack8(y);
        }
    }
}

#ifndef MK_DOUBLE
#define MK_DOUBLE 0
#endif
#define REP(bit, body) do { body; if (MK_DOUBLE & (bit)) { body; } } while (0)
__device__ __forceinline__ void phase_expconv(int wv, KP Pk, int layer, LAS char* lds) {
    asm volatile("" : "+s"(Pk));
    const CAS Params& P = *Pk;
    const int tid = ltid(wv);
    expconv_items(P, layer, lds, exc_s0(layer) + exc_s1(layer), EXC_ITEMS, (int)blockIdx.x * 8 + (tid >> 6), (int)gridDim.x * 8, tid >> 6, tid & 63);
}
constexpr int L1_AST = 1028;
constexpr int L1_PST = 33;
constexpr int L1_A = 0, L1_PART = L1_A + 16 * L1_AST * 4, L1_SM = L1_PART + 8 * 16 * L1_PST * 4, L1_END = L1_SM + (64 + 2 * 144 + 32) * 4;
static_assert(L1_END <= LDS_BYTES - 16, "LN1 LDS map");
__device__ __forceinline__ void phase_ln1(int wv, KP Pk, int layer, LAS char* lds, bool dry = false) {
    asm volatile("" : "+s"(Pk));
    const CAS Params& P = *Pk;
    const int tid = ltid(wv), lane = tid & 63;
    if (!dry) REP(8, phase_expconv(wv, Pk, layer, lds));
    __syncthreads();
    LAS float* At = (LAS float*)(lds + L1_A);
    LAS float* part = (LAS float*)(lds + L1_PART);
    LAS int* lcnt = (LAS int*)(lds + L1_SM);
    LAS int* lbase = lcnt + 32;
    LAS int* asg = lcnt + 64;
    LAS float* rbias = (LAS float*)(asg + 2 * 144);
    if (tid < 32) { lcnt[tid] = 0; rbias[tid] = P.router_bias[tid]; }
    float breg[8][4][2];
    {
        const float* rw = P.router_w + (size_t)(128 * wv + 4 * (lane >> 4)) * NEXP + (lane & 15);
#pragma unroll
        for (int j = 0; j < 8; ++j)
#pragma unroll
            for (int i = 0; i < 4; ++i) { breg[j][i][0] = rw[(16 * j + i) * NEXP]; breg[j][i][1] = rw[(16 * j + i) * NEXP + 16]; }
    }
    __syncthreads();
    const bf16_t* yo = (const bf16_t*)(P.ws + WS_YO);
    bf16_t* act = (bf16_t*)(P.ws + (dry ? WS_FEAT : WS_ACT));
    bf16_t* xcb = (bf16_t*)(P.ws + WS_XC); bf16_t* xob = (bf16_t*)P.out;
    const bool lastl = (layer == DEPTH - 1);
    int* cnt = (int*)(P.ws + WS_CNT) + layer * 32 * CNT_STRIDE;
    int* list = (int*)(P.ws + WS_LIST);
    float* wts = (float*)(P.ws + WS_WTS);
    const float* lg = P.ln_g + (size_t)(layer * 2 + 0) * D; const float* lb = P.ln_b + (size_t)(layer * 2 + 0) * D;
    const int r0 = (layer == DEPTH - 1) ? NCTX : 0, ntiles = (NROWS - r0) / 16, G = gridDim.x;
    f32x4 g1v[4], s2c[4], h2c[4];
#pragma unroll
    for (int i = 0; i < 4; ++i) g1v[i] = s2c[i] = h2c[i] = (f32x4){0.f, 0.f, 0.f, 0.f};
    int mcur = -1;
    f32x4 nx[2][4]; u32x2 nyo[2][4];
    auto fetch = [&](int s, int rr) {
        if (layer == 0) {
            const float* xq = rr < NCTX ? P.ctx + (size_t)rr * D : P.x + (size_t)(rr - NCTX) * D;
#pragma unroll
            for (int i = 0; i < 4; ++i) nx[s][i] = *(const f32x4*)(xq + 4 * lane + 256 * i);
        } else {
            const bf16_t* xq = rr < NCTX ? xcb + (size_t)rr * D : xob + (size_t)(rr - NCTX) * D;
#pragma unroll
            for (int i = 0; i < 4; ++i) { const u32x2 t = *(const u32x2*)(xq + 4 * lane + 256 * i); nx[s][i] = (f32x4){__uint_as_float(t.x), __uint_as_float(t.y), 0.f, 0.f}; }
        }
#pragma unroll
        for (int i = 0; i < 4; ++i) { const int c = 4 * lane + 256 * i; nyo[s][i] = *(const u32x2*)(yo + (size_t)rr * D + c); }
    };
    int tile = blockIdx.x;
    if (tile < ntiles) { fetch(0, r0 + tile * 16 + 2 * wv); fetch(1, r0 + tile * 16 + 2 * wv + 1); }
    for (int it = 0; tile < ntiles; ++it, tile += G) {
        const int rb = r0 + tile * 16 + 2 * wv;
        const int m = row_mod(rb);
        if (m != mcur) {
            mcur = m;
            const float* g1 = modvec(P.ws, layer, m, 2); const float* sh2 = modvec(P.ws, layer, m, 3); const float* sc2 = modvec(P.ws, layer, m, 4);
#pragma unroll
            for (int i = 0; i < 4; ++i) { const int c = 4 * lane + 256 * i; g1v[i] = *(const f32x4*)(g1 + c); s2c[i] = *(const f32x4*)(sc2 + c); h2c[i] = *(const f32x4*)(sh2 + c); }
        }
#pragma unroll
        for (int s = 0; s < 2; ++s) {
            const int r = rb + s;
            bf16_t* xr = dry ? (bf16_t*)(P.ws + WS_YF) + (size_t)r * D : lastl ? (bf16_t*)(P.ws + WS_FEAT) + (size_t)r * D : r < NCTX ? xcb + (size_t)r * D : xob + (size_t)(r - NCTX) * D;
            f32x4 v[4]; float sm = 0.f;
#pragma unroll
            for (int i = 0; i < 4; ++i) {
                f32x4 xv = nx[s][i]; const f32x4 gv = g1v[i]; const u32x2 yv = nyo[s][i];
                if (layer != 0) { const unsigned b0 = __float_as_uint(xv[0]), b1 = __float_as_uint(xv[1]); xv = (f32x4){bflo(b0), bfhi(b0), bflo(b1), bfhi(b1)}; }
                v[i][0] = ALPHA * xv[0] + gv[0] * bflo(yv.x); v[i][1] = ALPHA * xv[1] + gv[1] * bfhi(yv.x);
                v[i][2] = ALPHA * xv[2] + gv[2] * bflo(yv.y); v[i][3] = ALPHA * xv[3] + gv[3] * bfhi(yv.y);
                sm += (v[i][0] + v[i][1]) + (v[i][2] + v[i][3]);
            }
            if (tile + G < ntiles) fetch(s, r + G * 16);
            const float mean = wave_sum(sm) * (1.f / D);
            float s2 = 0.f;
#pragma unroll
            for (int i = 0; i < 4; ++i) { v[i] = v[i] - mean; s2 += (v[i][0] * v[i][0] + v[i][1] * v[i][1]) + (v[i][2] * v[i][2] + v[i][3] * v[i][3]); }
            const float rstd = rsqrtf(wave_sum(s2) * (1.f / D) + 1e-5f);
            LAS float* arow = At + (2 * wv + s) * L1_AST;
#pragma unroll
            for (int i = 0; i < 4; ++i) {
                const int c = 4 * lane + 256 * i;
                const f32x4 gg = *(const f32x4*)(lg + c), bb = *(const f32x4*)(lb + c), s2v = s2c[i], h2v = h2c[i];
                f32x4 xn, hv;
#pragma unroll
                for (int j = 0; j < 4; ++j) { xn[j] = v[i][j] * rstd * gg[j] + bb[j]; hv[j] = xn[j] * (1.f + s2v[j]) + h2v[j]; }
                { u32x2 ox; ox.x = pk2(xn[0], xn[1]); ox.y = pk2(xn[2], xn[3]); *(u32x2*)(xr + c) = ox; }
                u32x2 o; o.x = pk2(hv[0], hv[1]); o.y = pk2(hv[2], hv[3]); *(u32x2*)(act + (size_t)r * D + c) = o;
                *(LAS f32x4*)(arow + c) = hv;
            }
        }
        __syncthreads();
        {
            f32x4 ra0 = (f32x4){0.f, 0.f, 0.f, 0.f}, ra1 = ra0;
            const LAS float* ap = At + (lane & 15) * L1_AST + 128 * wv + 4 * (lane >> 4);
#pragma unroll
            for (int j = 0; j < 8; ++j) {
                const f32x4 a4 = *(const LAS f32x4*)(ap + 16 * j);
#pragma unroll
                for (int i = 0; i < 4; ++i) {
                    ra0 = __builtin_amdgcn_mfma_f32_16x16x4f32(a4[i], breg[j][i][0], ra0, 0, 0, 0);
                    ra1 = __builtin_amdgcn_mfma_f32_16x16x4f32(a4[i], breg[j][i][1], ra1, 0, 0, 0);
                }
            }
            LAS float* pw = part + wv * 16 * L1_PST + (4 * (lane >> 4)) * L1_PST + (lane & 15);
#pragma unroll
            for (int j = 0; j < 4; ++j) { pw[j * L1_PST] = ra0[j]; pw[j * L1_PST + 16] = ra1[j]; }
        }
        __syncthreads();
        {
            const int half = lane >> 5, e = lane & 31;
            const LAS float* pp = part + (2 * wv + half) * L1_PST + e;
            float sc_ = 0.f;
#pragma unroll
            for (int k = 0; k < 8; ++k) sc_ += pp[k * 16 * L1_PST];
            const float sg = sigmoidf_(sc_), vb = sg + rbias[e];
            float bv[4], sv[4];
            bv[0] = dppmov<0x00>(vb); bv[1] = dppmov<0x55>(vb); bv[2] = dppmov<0xAA>(vb); bv[3] = dppmov<0xFF>(vb);
            sv[0] = dppmov<0x00>(sg); sv[1] = dppmov<0x55>(sg); sv[2] = dppmov<0xAA>(sg); sv[3] = dppmov<0xFF>(sg);
            float m1 = -1e30f, m2 = -1e30f;
#pragma unroll
            for (int k = 0; k < 4; ++k) { const float vsc = bv[k]; if (vsc > m1) { m2 = m1; m1 = vsc; } else if (vsc > m2) m2 = vsc; }
            float best = m1 + m2; int bg = e >> 2;
#pragma unroll
            for (int msk = 4; msk <= 16; msk <<= 1) {
                const float ob = __shfl_xor(best, msk); const int og = __shfl_xor(bg, msk);
                const bool take = (ob > best) || (ob == best && og < bg);
                best = take ? ob : best; bg = take ? og : bg;
            }
            int i1 = 0; float b1 = bv[0];
#pragma unroll
            for (int k = 1; k < 4; ++k) if (bv[k] > b1) { b1 = bv[k]; i1 = k; }
            int i2 = -1; float b2 = -1e30f;
#pragma unroll
            for (int k = 0; k < 4; ++k) if (k != i1 && bv[k] > b2) { b2 = bv[k]; i2 = k; }
            float s1 = sv[0], s2s = sv[0];
#pragma unroll
            for (int k = 1; k < 4; ++k) { if (i1 == k) s1 = sv[k]; if (i2 == k) s2s = sv[k]; }
            if (e == 4 * bg && !dry) {
                const int r = rb + half;
                const int e0 = bg * 4 + i1, e1 = bg * 4 + i2;
                const float inv = 1.f / (s1 + s2s);
                const int li = it * 16 + 2 * wv + half;
                const int p0 = __hip_atomic_fetch_add(&lcnt[e0], 1, __ATOMIC_RELAXED, __HIP_MEMORY_SCOPE_WORKGROUP);
                const int p1 = __hip_atomic_fetch_add(&lcnt[e1], 1, __ATOMIC_RELAXED, __HIP_MEMORY_SCOPE_WORKGROUP);
                asg[2 * li] = (e0 << 16) | p0; asg[2 * li + 1] = (e1 << 16) | p1;
                wts[2 * r] = s1 * inv; wts[2 * r + 1] = s2s * inv;
            }
        }
    }
    __syncthreads();
    if (dry) return;
    if (tid < 32) lbase[tid] = atomicAdd(&cnt[tid * CNT_STRIDE], lcnt[tid]);
    __syncthreads();
    for (int idx = tid; idx < 2 * 144; idx += NT) {
        const int li = idx >> 1, k = idx & 1, t = (li >> 4) * G + blockIdx.x;
        if (t < ntiles) { const int r = r0 + t * 16 + (li & 15); const int v = asg[idx], e = v >> 16, lp = v & 0xffff; list[(size_t)e * LISTCAP + lbase[e] + lp] = 2 * r + k; }
    }
}

__device__ __forceinline__ void phase_ln2(int wv, KP Pk, int layer, bool dry = false) {
    asm volatile("" : "+s"(Pk));
    const CAS Params& P = *Pk;
    const int tid = ltid(wv), lane = tid & 63, wid = tid >> 6;
    const bf16_t* yp = (const bf16_t*)(P.ws + WS_YP);
    const float* wts = (const float*)(P.ws + WS_WTS);
    bf16_t* act = (bf16_t*)(P.ws + (dry ? WS_FEAT : WS_ACT));
    bf16_t* xcb = (bf16_t*)(P.ws + WS_XC); bf16_t* xob = (bf16_t*)P.out;
    const float* lg = P.ln_g + (size_t)(layer * 2 + 1) * D; const float* lb = P.ln_b + (size_t)(layer * 2 + 1) * D;
    const bool last = (layer == DEPTH - 1);
    const int r0 = last ? NCTX : 0, stride = gridDim.x * 8;
    f32x4 cg[4], cb[4], g2v[4], s1v[4], h1v[4];
#pragma unroll
    for (int i = 0; i < 4; ++i) { cg[i] = *(const f32x4*)(lg + 4 * lane + 256 * i); cb[i] = *(const f32x4*)(lb + 4 * lane + 256 * i); g2v[i] = s1v[i] = h1v[i] = (f32x4){0.f, 0.f, 0.f, 0.f}; }
    int mcur = -1;
    u32x2 nx[4]; u32x2 ny0[4], ny1[4]; float nw0 = 0.f, nw1 = 0.f;
    auto fetch = [&](int r) {
        const bf16_t* xr = last ? (const bf16_t*)(P.ws + WS_FEAT) + (size_t)r * D : r < NCTX ? xcb + (size_t)r * D : xob + (size_t)(r - NCTX) * D;
#pragma unroll
        for (int i = 0; i < 4; ++i) {
            const int c = 4 * lane + 256 * i;
            nx[i] = *(const u32x2*)(xr + c); ny0[i] = *(const u32x2*)(yp + (size_t)(2 * r) * D + c); ny1[i] = *(const u32x2*)(yp + (size_t)(2 * r + 1) * D + c);
        }
        nw0 = wts[2 * r]; nw1 = wts[2 * r + 1];
    };
    int r = r0 + blockIdx.x * 8 + wid;
    if (r < NROWS) fetch(r);
    for (; r < NROWS; r += stride) {
        const int m = row_mod(r);
        if (m != mcur) {
            mcur = m;
            const float* g2 = modvec(P.ws, layer, m, 5); const float* sh1 = last ? lg : modvec(P.ws, layer + 1, m, 0); const float* sc1 = last ? lg : modvec(P.ws, layer + 1, m, 1);
#pragma unroll
            for (int i = 0; i < 4; ++i) { const int c = 4 * lane + 256 * i; g2v[i] = *(const f32x4*)(g2 + c); s1v[i] = *(const f32x4*)(sc1 + c); h1v[i] = *(const f32x4*)(sh1 + c); }
        }
        f32x4 v[4]; float s = 0.f;
        const float w0 = nw0, w1 = nw1;
#pragma unroll
        for (int i = 0; i < 4; ++i) {
            const f32x4 xv = (f32x4){bflo(nx[i].x), bfhi(nx[i].x), bflo(nx[i].y), bfhi(nx[i].y)}, gv = g2v[i]; const u32x2 y0 = ny0[i], y1 = ny1[i];
            v[i][0] = ALPHA * xv[0] + gv[0] * (w0 * bflo(y0.x) + w1 * bflo(y1.x)); v[i][1] = ALPHA * xv[1] + gv[1] * (w0 * bfhi(y0.x) + w1 * bfhi(y1.x));
            v[i][2] = ALPHA * xv[2] + gv[2] * (w0 * bflo(y0.y) + w1 * bflo(y1.y)); v[i][3] = ALPHA * xv[3] + gv[3] * (w0 * bfhi(y0.y) + w1 * bfhi(y1.y));
            s += (v[i][0] + v[i][1]) + (v[i][2] + v[i][3]);
        }
        if (r + stride < NROWS) fetch(r + stride);
        const float mean = wave_sum(s) * (1.f / D);
        float s2 = 0.f;
#pragma unroll
        for (int i = 0; i < 4; ++i) { v[i] = v[i] - mean; s2 += (v[i][0] * v[i][0] + v[i][1] * v[i][1]) + (v[i][2] * v[i][2] + v[i][3] * v[i][3]); }
        const float rstd = rsqrtf(wave_sum(s2) * (1.f / D) + 1e-5f);
#pragma unroll
        for (int i = 0; i < 4; ++i) {
            const int c = 4 * lane + 256 * i;
            f32x4 xn;
#pragma unroll
            for (int j = 0; j < 4; ++j) xn[j] = v[i][j] * rstd * cg[i][j] + cb[i][j];
            if (dry) *(f32x4*)((float*)(P.ws + WS_YF) + (size_t)r * D + c) = xn;
            else if (last) *(f32x4*)(P.out + (size_t)(r - NCTX) * D + c) = xn;
            else { u32x2 ox; ox.x = pk2(xn[0], xn[1]); ox.y = pk2(xn[2], xn[3]); *(u32x2*)((r < NCTX ? xcb + (size_t)r * D : xob + (size_t)(r - NCTX) * D) + c) = ox; }
            if (!last) {
                u32x2 o; o.x = pk2(xn[0] * (1.f + s1v[i][0]) + h1v[i][0], xn[1] * (1.f + s1v[i][1]) + h1v[i][1]); o.y = pk2(xn[2] * (1.f + s1v[i][2]) + h1v[i][2], xn[3] * (1.f + s1v[i][3]) + h1v[i][3]);
                *(u32x2*)(act + (size_t)r * D + c) = o;
            }
        }
    }
}

constexpr int NPHASE = 2 + 11 * DEPTH;
__global__ void __launch_bounds__(NT, 2) fwd_kernel(Params P) {
    extern __shared__ __attribute__((aligned(16))) char lds_raw[];
    LAS char* lds = (LAS char*)lds_raw;
    volatile LAS unsigned* xbw = (volatile LAS unsigned*)(lds + LDS_BYTES - 16);
    KP Pk = (KP)__builtin_amdgcn_kernarg_segment_ptr();
    const int wv = __builtin_amdgcn_readfirstlane((int)(threadIdx.x >> 6));
    const bool multi = (P.ph_hi - P.ph_lo) > 1;
    XcdBarrier bar; bar.bar = (unsigned*)(P.ws + WS_BAR); bar.x = 0; bar.st = xbw;
    if (multi) {
        if (ltid(wv) == 0) { xbw[0] = 0u; xbw[1] = 0u; xbw[2] = 0u; xbw[3] = 0u; }
        __syncthreads();
        bar = xcd_barrier_post(wv, (unsigned*)(P.ws + WS_BAR), xbw);
    }
#define PHASE(id, body) do { if (P.ph_lo <= (id) && (id) < P.ph_hi) { body; if ((id) + 1 < P.ph_hi) xcd_barrier(wv, bar); if (MK_DOUBLE & 2048) xcd_barrier(wv, bar); } } while (0)
    PHASE(0, REP(16, phase_prologue0(wv, Pk, lds)));
    PHASE(1, REP(16, phase_prologue1(wv, Pk)));
    for (int l = 0; l < DEPTH; ++l) {
        const int pb = 2 + 11 * l, odd = l & 1;
        PHASE(pb + 0, REP(1, phase_inproj(wv, Pk, l, lds)));
        if (odd) {
            PHASE(pb + 1, REP(4, phase_prep1(wv, Pk, l)));
            PHASE(pb + 2, phase_prep2(wv, Pk, l, lds));
            PHASE(pb + 3, REP(32, { if (blockIdx.x < 128) REP(64, scan_hgrn_c(wv, Pk, l, blockIdx.x, lds)); else if (blockIdx.x < 256) REP(128, scan_rwkv(wv, Pk, l, blockIdx.x - 128, lds)); }));
            PHASE(pb + 5, REP(4, phase_out_odd(wv, Pk, l)));
        } else {
            PHASE(pb + 1, REP(4, phase_prep_even(wv, Pk, l)));
            PHASE(pb + 2, REP(2, phase_ex1(wv, Pk, l, lds)));
            PHASE(pb + 3, phase_ex2(wv, Pk, l));
            PHASE(pb + 4, REP(2, phase_ex3(wv, Pk, l, lds)));
            PHASE(pb + 5, REP(4, phase_out_even(wv, Pk, l)));
        }
        PHASE(pb + 6, REP(256, phase_outproj(wv, Pk, l, lds)));
        PHASE(pb + 7, { if (MK_DOUBLE & 4096) phase_ln1(wv, Pk, l, lds, true); phase_ln1(wv, Pk, l, lds); });
        PHASE(pb + 8, REP(512, phase_moe1(wv, Pk, l, lds)));
        PHASE(pb + 9, REP(1024, phase_moe2(wv, Pk, l, lds)));
        PHASE(pb + 10, { if (MK_DOUBLE & 8192) phase_ln2(wv, Pk, l, true); phase_ln2(wv, Pk, l); });
    }
#undef PHASE
}


#ifndef MK_STOP
#define MK_STOP NPHASE
#endif
#ifndef MK_DUMP
#define MK_DUMP 0
#endif
#ifndef MK_DUMP_N
#define MK_DUMP_N (1u << 30)
#endif
#ifndef MK_DUMP_LD
#define MK_DUMP_LD 1024
#endif
#ifndef MK_DUMP_C0
#define MK_DUMP_C0 0
#endif
__global__ void diff_kernel(const bf16_t* a, const bf16_t* b, float* out, size_t n) {
    for (size_t i = (size_t)blockIdx.x * blockDim.x + threadIdx.x; i < n; i += (size_t)gridDim.x * blockDim.x) out[i] = 1e6f * (bf2f(a[i]) - bf2f(b[i]));
}
__global__ void dump_kernel(const bf16_t* src, float* out, size_t n) {
    for (size_t i = (size_t)blockIdx.x * blockDim.x + threadIdx.x; i < n; i += (size_t)gridDim.x * blockDim.x) out[i] = i < (size_t)MK_DUMP_N ? bf2f(src[(i >> 10) * MK_DUMP_LD + MK_DUMP_C0 + (i & 1023)]) : 0.f;
}
extern "C" void kernel_launch(void* const* d_in, const int* in_sizes, int n_in, void* d_out, int out_size, void* d_ws, size_t ws_size, hipStream_t stream) {
    static int ready = 0;
    if (ready == 0) {
        ready = 1;
        if (n_in != 42 || out_size != NB * SEQ * D || ws_size < WS_END) { fprintf(stderr, "kernel_launch: unexpected shapes (n_in %d out %d ws %zu need %zu)\n", n_in, out_size, ws_size, (size_t)WS_END); ready = -1; }
        if (hipFuncSetAttribute((const void*)fwd_kernel, hipFuncAttributeMaxDynamicSharedMemorySize, LDS_BYTES) != hipSuccess) { fprintf(stderr, "kernel_launch: hipFuncSetAttribute failed\n"); ready = -1; }
    }
    if (ready < 0) return;
    (void)in_sizes;
    hipMemsetAsync((char*)d_ws + WS_BAR, 0, WS_ZERO_BYTES, stream);
    Params p;
    memset(&p, 0, sizeof(p));
    const float** fp = (const float**)&p;
    for (int i = 0; i < 42; ++i) fp[i] = (const float*)d_in[i];
    p.out = (float*)d_out; p.ws = (unsigned char*)d_ws;
#if MK_PER_PHASE
    for (int ph = 0; ph < MK_STOP; ++ph) {
        const int local = ph < 2 ? -1 : (ph - 2) % 11, layer = ph < 2 ? 0 : (ph - 2) / 11;
        if (local == 4 && (layer & 1)) continue;
        p.ph_lo = ph; p.ph_hi = ph + 1;
        hipLaunchKernelGGL(fwd_kernel, dim3(256), dim3(NT), LDS_BYTES, stream, p);
    }
#ifdef MK_DIFF
    p.ph_lo = 7; p.ph_hi = 8; p.dbg = 1;
    hipLaunchKernelGGL(fwd_kernel, dim3(256), dim3(NT), LDS_BYTES, stream, p);
    hipLaunchKernelGGL(diff_kernel, dim3(1024), dim3(256), 0, stream, (const bf16_t*)((unsigned char*)d_ws + WS_YO), (const bf16_t*)((unsigned char*)d_ws + WS_HID), (float*)d_out, (size_t)NB * SEQ * D);
#else
    if (MK_DUMP) hipLaunchKernelGGL(dump_kernel, dim3(1024), dim3(256), 0, stream, (const bf16_t*)((unsigned char*)d_ws + (size_t)MK_DUMP), (float*)d_out, (size_t)NB * SEQ * D);
#endif
#else
    p.ph_lo = 0; p.ph_hi = NPHASE;
    hipLaunchKernelGGL(fwd_kernel, dim3(256), dim3(NT), LDS_BYTES, stream, p);
#endif
}
```

```cpp
#include <hip/hip_runtime.h>
#include <stdint.h>
#include <stdio.h>
#include <string.h>

#ifndef MK_PER_PHASE
#define MK_PER_PHASE 0
#endif

typedef unsigned short bf16_t;
typedef short bf16x8 __attribute__((ext_vector_type(8)));
typedef float f32x4 __attribute__((ext_vector_type(4)));
typedef unsigned u32x4 __attribute__((ext_vector_type(4)));
typedef unsigned u32x2 __attribute__((ext_vector_type(2)));
#define LAS __attribute__((address_space(3)))
#define CAS __attribute__((address_space(4)))

constexpr int D = 1024, NB = 4, SEQ = 8192, CTXL = 256, DEPTH = 4;
constexpr int NCTX = NB * CTXL;
constexpr int NROWS = NCTX + NB * SEQ;
constexpr int P_EVEN = 2848, P_ODD = 4416, LDP_EVEN = 3072, LDP_ODD = 4608;
constexpr int NEXP = 32, DEXP = 512, LISTCAP = NROWS;
constexpr float ALPHA = 1.681792830507429f;
constexpr int NT = 512;
constexpr int TCH = 32;
constexpr int NSTEPS = CTXL + SEQ;
constexpr int LDS_BYTES = 160 * 1024;

constexpr size_t al256(size_t x) { return (x + 255) & ~(size_t)255; }
constexpr size_t WS_BAR = 0;
constexpr size_t WS_CNT = 16384;
constexpr int CNT_STRIDE = 64;
constexpr size_t WS_ZERO_BYTES = 16384 + (size_t)4 * 32 * CNT_STRIDE * 4;
constexpr size_t WS_MODV = al256(WS_ZERO_BYTES);
constexpr size_t WS_LB = WS_MODV + al256((size_t)4 * 5 * 6144 * 4);
constexpr size_t WS_XC = WS_LB + al256(4 * 512 * 4);
constexpr size_t WS_WTS = WS_XC + (size_t)NCTX * D * 4;
constexpr size_t WS_LIST = WS_WTS + al256((size_t)2 * NROWS * 4);
constexpr size_t WS_WINT = WS_LIST + al256((size_t)NEXP * LISTCAP * 4);
constexpr size_t WINT_L0 = 0, WINT_L1 = (size_t)LDP_EVEN * D, WINT_L2 = WINT_L1 + (size_t)LDP_ODD * D, WINT_L3 = WINT_L2 + (size_t)LDP_EVEN * D, WINT_END = WINT_L3 + (size_t)LDP_ODD * D;
constexpr size_t WS_WOUTT = WS_WINT + WINT_END * 2;
constexpr size_t WS_LORAT = WS_WOUTT + (size_t)4 * D * D * 2;
constexpr size_t LORA_PER = (size_t)512 * 320;
constexpr size_t WS_EXPGU = WS_LORAT + al256(2 * LORA_PER * 2);
constexpr size_t WS_EXPD = WS_EXPGU + (size_t)NEXP * 1024 * 1024 * 2;
constexpr size_t WS_ACT = WS_EXPD + (size_t)NEXP * 1024 * 512 * 2;
constexpr size_t ROWB = (size_t)NROWS * D * 2;
constexpr size_t WS_FEAT = WS_ACT + ROWB;
constexpr size_t WS_YF = WS_FEAT + ROWB;
constexpr size_t WS_YB = WS_YF + ROWB;
constexpr size_t WS_P = WS_YB + ROWB;
constexpr size_t P_BYTES = (size_t)NROWS * LDP_ODD * 2;
constexpr size_t WS_YO = WS_P;
constexpr size_t WS_HID = WS_P + ROWB;
constexpr size_t WS_YP = WS_HID + ROWB;
static_assert(WS_YP + 2 * ROWB <= WS_P + P_BYTES, "MoE buffers must fit in the P region");
constexpr size_t HALFB = (size_t)NROWS * 512 * 2;
constexpr size_t WS_RWR = WS_P + P_BYTES;
constexpr size_t WS_RWK = WS_RWR + HALFB;
constexpr size_t WS_RWV = WS_RWK + HALFB;
constexpr size_t WS_RWKK = WS_RWV + HALFB;
constexpr size_t WS_RWB = WS_RWKK + HALFB;
constexpr size_t WS_RWG = WS_RWB + HALFB;
constexpr size_t WS_RWDEC = WS_RWG + HALFB;
constexpr size_t WS_LA = WS_RWDEC + (size_t)2 * NROWS * 512 * 4;
constexpr size_t WS_END = WS_LA + (size_t)NROWS * 320 * 2;
static_assert(WS_END <= (size_t)280602384 * 4, "workspace map exceeds the guaranteed ws_size");

struct Params {
    const float *x, *c, *ctx, *c_ctx, *mod_w, *mod_b, *ln_g, *ln_b;
    const float *ev_w_in, *ev_w_out, *ssd_conv_w, *ssd_conv_b, *ssd_dt_bias, *ssd_a_log, *ssd_d, *ssd_norm_w;
    const float *ml_conv_w, *ml_conv_b, *ml_i_bias, *ml_f_bias, *ml_norm_w;
    const float *od_w_in, *od_w_out, *hg_lb_logits, *hg_f_bias, *hg_norm_w;
    const float *rw_mu, *rw_w0, *rw_w2, *rw_a0, *rw_a2, *rw_g2, *rw_k_k, *rw_k_a, *rw_r_k, *rw_ln_w, *rw_ln_b;
    const float *router_w, *router_bias, *exp_w_gate, *exp_w_up, *exp_w_down;
    float* out;
    unsigned char* ws;
    int ph_lo, ph_hi, dbg, pad_;
};
typedef const CAS Params* KP;

__device__ __forceinline__ int ltid(int wv) { int l; asm volatile("v_mbcnt_lo_u32_b32 %0, -1, 0\n\tv_mbcnt_hi_u32_b32 %0, -1, %0" : "=v"(l)); return wv * 64 + l; }
__device__ __forceinline__ float bf2f(bf16_t h) { return __uint_as_float(((unsigned)h) << 16); }
__device__ __forceinline__ float bflo(unsigned u) { return __uint_as_float(u << 16); }
__device__ __forceinline__ float bfhi(unsigned u) { return __uint_as_float(u & 0xffff0000u); }
typedef __bf16 bf16v2_t __attribute__((ext_vector_type(2)));
typedef float f32x2 __attribute__((ext_vector_type(2)));
__device__ __forceinline__ unsigned pk2(float lo, float hi) { const f32x2 v = {lo, hi}; return __builtin_bit_cast(unsigned, __builtin_convertvector(v, bf16v2_t)); }
__device__ __forceinline__ bf16_t f2bf(float f) { return (bf16_t)(pk2(f, 0.f) & 0xffffu); }
__device__ __forceinline__ void unpack8(const u32x4& u, float* f) {
    f[0] = bflo(u.x); f[1] = bfhi(u.x); f[2] = bflo(u.y); f[3] = bfhi(u.y); f[4] = bflo(u.z); f[5] = bfhi(u.z); f[6] = bflo(u.w); f[7] = bfhi(u.w);
}
__device__ __forceinline__ u32x4 pack8(const float* f) { u32x4 u; u.x = pk2(f[0], f[1]); u.y = pk2(f[2], f[3]); u.z = pk2(f[4], f[5]); u.w = pk2(f[6], f[7]); return u; }
__device__ __forceinline__ float sigmoidf_(float x) { return __builtin_amdgcn_rcpf(1.f + __expf(-x)); }
__device__ __forceinline__ float siluf_(float x) { return x * __builtin_amdgcn_rcpf(1.f + __expf(-x)); }
__device__ __forceinline__ float softplus_fast(float x) { return x > 20.f ? x : __logf(1.f + __expf(x)); }
__device__ __forceinline__ float tanh_fast(float x) { return 1.f - 2.f * __builtin_amdgcn_rcpf(1.f + __expf(2.f * x)); }
__device__ __forceinline__ float softplusf_(float x) { return x > 20.f ? x : __logf(1.f + __expf(x)); }
__device__ __forceinline__ float logsigmoidf_(float x) { return fminf(x, 0.f) - __logf(1.f + __expf(-fabsf(x))); }
template <int CTRL> __device__ __forceinline__ float dppmov(float v) {
    return __builtin_bit_cast(float, __builtin_amdgcn_update_dpp(0, __builtin_bit_cast(int, v), CTRL, 0xf, 0xf, true));
}
__device__ __forceinline__ float allreduce16(float v) {
    v += dppmov<0xB1>(v);
    v += dppmov<0x4E>(v);
    v += dppmov<0x141>(v);
    v += dppmov<0x140>(v);
    return v;
}
__device__ __forceinline__ float allreduce8_(float v) { v += dppmov<0xB1>(v); v += dppmov<0x4E>(v); v += dppmov<0x141>(v); return v; }
__device__ __forceinline__ float wave_sum(float v) {
    v = allreduce16(v);
    const float r0 = __builtin_bit_cast(float, __builtin_amdgcn_readlane(__builtin_bit_cast(int, v), 0)), r1 = __builtin_bit_cast(float, __builtin_amdgcn_readlane(__builtin_bit_cast(int, v), 16));
    const float r2 = __builtin_bit_cast(float, __builtin_amdgcn_readlane(__builtin_bit_cast(int, v), 32)), r3 = __builtin_bit_cast(float, __builtin_amdgcn_readlane(__builtin_bit_cast(int, v), 48));
    return (r0 + r1) + (r2 + r3);
}
template <int W> __device__ __forceinline__ float group_sum(float v) {
    if (W == 8) return allreduce8_(v);
    return allreduce16(v);
}

#define XB_TMO      128
#define XB_XCNT(j)  (256  + 64 * (j))
#define XB_XSUB(j)  (1280 + 64 * (j))
#define XB_XGEN(j)  (2304 + 64 * (j))
#define XB_TOP      3328
#define XB_TOPGEN   3392
#define XCD_BAR_WORDS 3456
#define XB_SPIN_CAP (1u << 22)
__device__ __forceinline__ unsigned xb_ld(unsigned* p)              { return __hip_atomic_load(p, __ATOMIC_RELAXED, __HIP_MEMORY_SCOPE_AGENT); }
__device__ __forceinline__ unsigned xb_add(unsigned* p, unsigned v) { return __hip_atomic_fetch_add(p, v, __ATOMIC_RELAXED, __HIP_MEMORY_SCOPE_AGENT); }
__device__ __forceinline__ unsigned xb_xcc_id() { return (unsigned)__builtin_amdgcn_s_getreg((3 << 11) | 20) & 0xFu; }
#define XB_SPIN(cond, bar) do { unsigned _sp = 0; while (cond) { __builtin_amdgcn_s_sleep(1); \
    if ((++_sp & 255u) == 0u) { if (xb_ld(&(bar)[XB_TMO])) break; if (_sp > XB_SPIN_CAP) { atomicAdd(&(bar)[XB_TMO], 1u); break; } } } } while (0)
struct XcdBarrier { unsigned* bar; unsigned x; volatile LAS unsigned* st; };
__device__ __forceinline__ XcdBarrier xcd_barrier_post(int wv, unsigned* bar, volatile LAS unsigned* st) {
    XcdBarrier b; b.bar = bar; b.x = xb_xcc_id(); b.st = st;
    if (ltid(wv) == 0) (void)xb_add(&bar[XB_XCNT(b.x)], 1u);
    return b;
}
__device__ __forceinline__ void xcd_barrier_complete(unsigned* bar, unsigned x, unsigned& nloc, unsigned& nx) {
    const unsigned G = gridDim.x * gridDim.y * gridDim.z;
    unsigned sum, cnt, mine, sp = 0u;
    for (;;) {
        sum = 0u; cnt = 0u; mine = 0u;
#pragma unroll
        for (unsigned j = 0; j < 16; ++j) { const unsigned c = xb_ld(&bar[XB_XCNT(j)]); sum += c; cnt += (c > 0u) ? 1u : 0u; mine = (j == x) ? c : mine; }
        if (sum == G) break;
        __builtin_amdgcn_s_sleep(1);
        if ((++sp & 255u) == 0u) { if (xb_ld(&bar[XB_TMO])) break; if (sp > XB_SPIN_CAP) { atomicAdd(&bar[XB_TMO], 1u); break; } }
    }
    nloc = mine > 0u ? mine : 1u; nx = cnt > 0u ? cnt : 1u;
}
__device__ __forceinline__ void xcd_barrier(int wv, const XcdBarrier& b) {
    asm volatile("s_waitcnt vmcnt(0)" ::: "memory");
    __syncthreads();
    if (ltid(wv) == 0) {
        unsigned* bar = b.bar;
        asm volatile("" : "+s"(bar));
        __builtin_amdgcn_s_waitcnt(0);
        unsigned nloc = b.st[0], nx = b.st[1];
        if (nloc == 0u) { xcd_barrier_complete(bar, b.x, nloc, nx); b.st[0] = nloc; b.st[1] = nx; }
        const unsigned old = xb_add(&bar[XB_XSUB(b.x)], 1u);
        const unsigned gen = old / nloc;
        if (old + 1u == (gen + 1u) * nloc) {
            __builtin_amdgcn_fence(__ATOMIC_RELEASE, "agent");
            asm volatile("s_waitcnt vmcnt(0)" ::: "memory");
            const unsigned og = xb_add(&bar[XB_TOP], 1u);
            const unsigned tg = og / nx;
            if (og + 1u == (tg + 1u) * nx) xb_add(&bar[XB_TOPGEN], 1u);
            else XB_SPIN(xb_ld(&bar[XB_TOPGEN]) == tg, bar);
            __builtin_amdgcn_fence(__ATOMIC_ACQUIRE, "agent");
            xb_add(&bar[XB_XGEN(b.x)], 1u);
            asm volatile("s_waitcnt vmcnt(0)" ::: "memory");
        } else {
            XB_SPIN(xb_ld(&bar[XB_XGEN(b.x)]) == gen, bar);
            __builtin_amdgcn_fence(__ATOMIC_ACQUIRE, "agent");
            asm volatile("s_waitcnt vmcnt(0)" ::: "memory");
        }
    }
    __syncthreads();
}

__device__ __forceinline__ int row_mod(int r) { return r < NCTX ? 4 : ((r - NCTX) >> 13); }
__device__ __forceinline__ void row_seg(int r, int& t, int& len) { if (r < NCTX) { t = r & 255; len = CTXL; } else { t = (r - NCTX) & 8191; len = SEQ; } }
__device__ __forceinline__ int scan_row(int tg, int b, int dir, int odd) {
    if (tg < CTXL) { const int t = dir ? (CTXL - 1 - tg) : tg; return b * CTXL + t; }
    int sg = tg - CTXL; if (dir) sg = SEQ - 1 - sg;
    const int s = odd ? (((sg & 127) << 6) + (sg >> 7)) : sg;
    return NCTX + b * SEQ + s;
}
__device__ __forceinline__ const float* modvec(const unsigned char* ws, int layer, int m, int which) {
    return (const float*)(ws + WS_MODV) + ((size_t)(layer * 5 + m) * 6 + which) * D;
}

constexpr int G_BM = 256, G_BN = 128, G_BK = 64;
constexpr int G_ABYTES = G_BM * G_BK * 2, G_BBYTES = G_BN * G_BK * 2, G_BUF = G_ABYTES + G_BBYTES;
__device__ __forceinline__ int swz(int o) { return o ^ (((o >> 9) & 1) << 5); }

template <class RowSrc, class Epi>
__device__ __forceinline__ void gemm_tile(int wv, const bf16_t* __restrict__ A, int lda, const RowSrc& rs, const bf16_t* __restrict__ Bt, int ldb, int n0, int K, const Epi& epi, LAS char* lds) {
    const int tid = ltid(wv), lane = tid & 63, wid = tid >> 6, wm = wid >> 1, wn = wid & 1;
    const bf16_t* ap[4]; int aoff[4];
#pragma unroll
    for (int i = 0; i < 4; ++i) {
        const int c = tid + NT * i, row = c >> 3, kc = c & 7;
        ap[i] = A + (size_t)rs.src(row) * lda + kc * 8;
        aoff[i] = ((row >> 4) * 2 + (kc >> 2)) * 1024 + swz((row & 15) * 64 + (kc & 3) * 16);
    }
    const bf16_t* bp[2]; int boff[2];
#pragma unroll
    for (int i = 0; i < 2; ++i) {
        const int c = tid + NT * i, row = c >> 3, kc = c & 7;
        bp[i] = Bt + (size_t)(n0 + row) * ldb + kc * 8;
        boff[i] = G_ABYTES + ((row >> 4) * 2 + (kc >> 2)) * 1024 + swz((row & 15) * 64 + (kc & 3) * 16);
    }
    f32x4 acc[4][4];
#pragma unroll
    for (int i = 0; i < 4; ++i)
#pragma unroll
        for (int j = 0; j < 4; ++j) acc[i][j] = (f32x4){0.f, 0.f, 0.f, 0.f};
    u32x4 ra[2][4], rb[2][2];
    const int KT = K / G_BK;
    const int fragoff = swz((lane & 15) * 64 + (lane >> 4) * 16);
#define G_LOAD(set, kt_) do { _Pragma("unroll") for (int i = 0; i < 4; ++i) ra[set][i] = *(const u32x4*)(ap[i] + (kt_) * G_BK); \
                              _Pragma("unroll") for (int i = 0; i < 2; ++i) rb[set][i] = *(const u32x4*)(bp[i] + (kt_) * G_BK); } while (0)
#define G_STORE(set, buf) do { _Pragma("unroll") for (int i = 0; i < 4; ++i) *(LAS u32x4*)((buf) + aoff[i]) = ra[set][i]; \
                               _Pragma("unroll") for (int i = 0; i < 2; ++i) *(LAS u32x4*)((buf) + boff[i]) = rb[set][i]; } while (0)
#define G_COMPUTE(cur) do { bf16x8 af[2][4], bfr[2][4]; \
        _Pragma("unroll") for (int ks = 0; ks < 2; ++ks) { \
            _Pragma("unroll") for (int ni = 0; ni < 4; ++ni) bfr[ks][ni] = *(LAS bf16x8*)((cur) + G_ABYTES + ((wn * 4 + ni) * 2 + ks) * 1024 + fragoff); \
            _Pragma("unroll") for (int mi = 0; mi < 4; ++mi) af[ks][mi] = *(LAS bf16x8*)((cur) + ((wm * 4 + mi) * 2 + ks) * 1024 + fragoff); } \
        __builtin_amdgcn_sched_barrier(0); \
        _Pragma("unroll") for (int ks = 0; ks < 2; ++ks) _Pragma("unroll") for (int mi = 0; mi < 4; ++mi) _Pragma("unroll") for (int ni = 0; ni < 4; ++ni) \
            acc[mi][ni] = __builtin_amdgcn_mfma_f32_16x16x32_bf16(bfr[ks][ni], af[ks][mi], acc[mi][ni], 0, 0, 0); \
        __builtin_amdgcn_sched_barrier(0); } while (0)
    G_LOAD(0, 0);
    G_STORE(0, lds);
    if (KT > 1) G_LOAD(0, 1);
    if (KT > 2) G_LOAD(1, 2);
    __syncthreads();
    for (int kt = 0; kt < KT; kt += 2) {
        G_COMPUTE(lds);
        if (kt + 1 < KT) G_STORE(0, lds + G_BUF);
        if (kt + 3 < KT) G_LOAD(0, kt + 3);
        __syncthreads();
        if (kt + 1 < KT) {
            G_COMPUTE(lds + G_BUF);
            if (kt + 2 < KT) G_STORE(1, lds);
            if (kt + 4 < KT) G_LOAD(1, kt + 4);
            __syncthreads();
        }
    }
#undef G_LOAD
#undef G_STORE
#undef G_COMPUTE
    epi(acc, wm * 64 + (lane & 15), wn * 64 + 4 * (lane >> 4));
}

constexpr int G2_BN = 256, G2_BBYTES = G2_BN * G_BK * 2, G2_BUF = G_ABYTES + G2_BBYTES;

struct RowLinear { int m0; __device__ __forceinline__ int src(int r) const { return m0 + r; } };
struct RowList {
    const int* list; int cnt; int shift;
    __device__ __forceinline__ int src(int r) const { const int a = list[r < cnt ? r : 0]; return a >> shift; }
};
struct EpiStoreBf16 {
    bf16_t* C; int ldc; int m0; int n0; int N;
    template <int NI> __device__ __forceinline__ void operator()(const f32x4 (&acc)[4][NI], int rbase, int cbase) const {
#pragma unroll
        for (int mi = 0; mi < 4; ++mi) {
            bf16_t* rowp = C + (size_t)(m0 + rbase + mi * 16) * ldc + n0 + cbase;
#pragma unroll
            for (int ni = 0; ni < NI; ++ni) {
                if (n0 + cbase + ni * 16 < N) { u32x2 v; v.x = pk2(acc[mi][ni][0], acc[mi][ni][1]); v.y = pk2(acc[mi][ni][2], acc[mi][ni][3]); *(u32x2*)(rowp + ni * 16) = v; }
            }
        }
    }
};
struct EpiSwiGLU {
    bf16_t* H; const int* list; int cnt; int n0;
    template <int NI> __device__ __forceinline__ void operator()(const f32x4 (&acc)[4][NI], int rbase, int cbase) const {
#pragma unroll
        for (int mi = 0; mi < 4; ++mi) {
            const int r = rbase + mi * 16;
            if (r < cnt) {
                const int a = list[r];
                const int wnb = cbase & ~63, q4 = cbase & 63;
                bf16_t* rowp = H + (size_t)a * DEXP + ((n0 + wnb) >> 1) + q4;
#pragma unroll
                for (int q = 0; q < NI / 2; ++q) {
                    float o[4];
#pragma unroll
                    for (int j = 0; j < 4; ++j) o[j] = siluf_(acc[mi][2 * q][j]) * acc[mi][2 * q + 1][j];
                    u32x2 v; v.x = pk2(o[0], o[1]); v.y = pk2(o[2], o[3]); *(u32x2*)(rowp + q * 16) = v;
                }
            }
        }
    }
};
struct EpiScatterBf16 {
    bf16_t* C; const int* list; int cnt; int n0;
    template <int NI> __device__ __forceinline__ void operator()(const f32x4 (&acc)[4][NI], int rbase, int cbase) const {
#pragma unroll
        for (int mi = 0; mi < 4; ++mi) {
            const int r = rbase + mi * 16;
            if (r < cnt) {
                bf16_t* rowp = C + (size_t)list[r] * D + n0 + cbase;
#pragma unroll
                for (int ni = 0; ni < NI; ++ni) { u32x2 v; v.x = pk2(acc[mi][ni][0], acc[mi][ni][1]); v.y = pk2(acc[mi][ni][2], acc[mi][ni][3]); *(u32x2*)(rowp + ni * 16) = v; }
            }
        }
    }
};
struct EpiDecay {
    float* Dc; const float* w0; int m0; int n0;
    template <int NI> __device__ __forceinline__ void operator()(const f32x4 (&acc)[4][NI], int rbase, int cbase) const {
#pragma unroll
        for (int ni = 0; ni < NI; ++ni) {
            const int col = n0 + cbase + ni * 16;
            const f32x4 w0v = *(const f32x4*)(w0 + col);
#pragma unroll
            for (int mi = 0; mi < 4; ++mi) {
                f32x4 o;
#pragma unroll
                for (int j = 0; j < 4; ++j) { const float w = w0v[j] + acc[mi][ni][j]; o[j] = __expf(-__expf(-softplus_fast(-w) - 0.5f)); }
                *(f32x4*)(Dc + (size_t)(m0 + rbase + mi * 16) * 512 + col) = o;
            }
        }
    }
};
struct EpiAK {
    bf16_t* Kb; const bf16_t* KKb; bf16_t* Bb; const float* a0; const float* k_a; int m0; int n0;
    template <int NI> __device__ __forceinline__ void operator()(const f32x4 (&acc)[4][NI], int rbase, int cbase) const {
#pragma unroll
        for (int ni = 0; ni < NI; ++ni) {
            const int col = n0 + cbase + ni * 16;
            const f32x4 a0v = *(const f32x4*)(a0 + col), kav = *(const f32x4*)(k_a + col);
#pragma unroll
            for (int mi = 0; mi < 4; ++mi) {
                const size_t off = (size_t)(m0 + rbase + mi * 16) * 512 + col;
                const u32x2 kr = *(const u32x2*)(Kb + off), kkr = *(const u32x2*)(KKb + off);
                const float kf[4] = {bflo(kr.x), bfhi(kr.x), bflo(kr.y), bfhi(kr.y)}, kkf[4] = {bflo(kkr.x), bfhi(kkr.x), bflo(kkr.y), bfhi(kkr.y)};
                float k2[4], bb[4];
#pragma unroll
                for (int j = 0; j < 4; ++j) { const float a = sigmoidf_(a0v[j] + acc[mi][ni][j]); k2[j] = kf[j] * (1.f + (a - 1.f) * kav[j]); bb[j] = kkf[j] * a; }
                u32x2 v; v.x = pk2(k2[0], k2[1]); v.y = pk2(k2[2], k2[3]); *(u32x2*)(Kb + off) = v;
                v.x = pk2(bb[0], bb[1]); v.y = pk2(bb[2], bb[3]); *(u32x2*)(Bb + off) = v;
            }
        }
    }
};

namespace pg8 {
#define PG8_LAS __attribute__((address_space(3)))
constexpr int BM = 256, BK = 64, HALF = 128, HTB = HALF * BK * 2, STAGE_BYTES = 8 * HTB, NXCD = 8, WGM = 8;
__host__ __device__ __forceinline__ int lds_byte(int r, int c) { const int st = (r >> 4) * 2 + (c >> 5), rr = r & 15, cc = c & 31, ob = rr * 64 + cc * 2; return st * 1024 + (ob ^ (((ob >> 9) & 1) << 5)); }
__host__ __device__ __forceinline__ void stage_rc(int b, int& R, int& C) { const int st = b / 1024, sb = b % 1024, swz = sb ^ (((sb >> 9) & 1) << 5); R = (st >> 1) * 16 + swz / 64; C = (st & 1) * 32 + (swz % 64) / 2; }
__host__ __device__ __forceinline__ int perm32(int rho) { const int n = rho >> 4, i = rho & 15; return 8 * (i >> 2) + 4 * n + (i & 3); }
struct Unit { int pm, pn; };
struct Gemm { const bf16_t* A; const bf16_t* Bt; int M, N, K; };
struct StaticOrder {
    int nM, nN, nwg, G, c;
    __host__ __device__ void init(int M, int N, int G_, int c_) { nM = M / BM; nN = N / BM; nwg = nM * nN; G = G_; c = c_; }
    __host__ __device__ bool next(int i, Unit& u) const {
        const long L = (long)i * G + c; if (L >= nwg) return false;
        int wgid = (int)L; { const int q = nwg / NXCD, r = nwg % NXCD, xcd = wgid % NXCD, off = wgid / NXCD; wgid = (xcd < r ? xcd * (q + 1) : r * (q + 1) + (xcd - r) * q) + off; }
        const int nig = WGM * nN, gid = wgid / nig, fm = gid * WGM, gsz = (nM - fm) < WGM ? (nM - fm) : WGM;
        u.pm = fm + ((wgid % nig) % gsz); u.pn = (wgid % nig) / gsz; return true;
    }
    __device__ __forceinline__ void a_ready(const Unit&) const {}
    __device__ __forceinline__ void done(const Unit&) const {}
};
struct EpiStoreP {
    static constexpr bool PERM = true, AFTER_DRAIN = false;
    bf16_t* O; int ldc;
    __device__ __forceinline__ void operator()(const f32x4 (&acc)[2][2][4][2], const Unit& u, int wr, int wc, int fr, int fq) const {
        const int row0 = u.pm * BM + wr * 64 + fr, col0 = u.pn * BM + wc * 32 + 8 * fq;
#pragma unroll
        for (int ai = 0; ai < 2; ++ai)
#pragma unroll
            for (int m = 0; m < 4; ++m) { bf16_t* rowp = O + (size_t)(row0 + ai * HALF + m * 16) * ldc + col0;
#pragma unroll
                for (int bj = 0; bj < 2; ++bj) { const f32x4 v0 = acc[ai][bj][m][0], v1 = acc[ai][bj][m][1];
                    u32x4 w; w.x = pk2(v0[0], v0[1]); w.y = pk2(v0[2], v0[3]); w.z = pk2(v1[0], v1[1]); w.w = pk2(v1[2], v1[3]);
                    *(u32x4*)(rowp + bj * HALF) = w; } }
    }
};
template <class Epi, class Sched>
__device__ __forceinline__ void gemm_phase(int wv, PG8_LAS unsigned char* lds, const Gemm g, const Sched& S, const Epi& E) {
    const int tid = ltid(wv), wid = __builtin_amdgcn_readfirstlane(tid >> 6), lane = tid & 63, wr = wid >> 2, wc = wid & 3, fr = lane & 15, fq = lane >> 4;
    const int K = g.K, nt = K / BK;
    unsigned voffA[2], voffB[2];
#pragma unroll
    for (int i = 0; i < 2; ++i) { int R, C; stage_rc(tid * 16 + i * 8192, R, C); const int Rb = Epi::PERM ? ((R & ~31) + perm32(R & 31)) : R;
        voffA[i] = (unsigned)(R * K + C) * 2u; voffB[i] = (unsigned)(Rb * K + C) * 2u; }
    const size_t kstep = (size_t)(BK * 2);
    const size_t hstep = (size_t)HALF * K * 2;
    const size_t tstep = 2 * hstep;
    const unsigned ldsw = (unsigned)wid * 1024u;
    const int aoff = lds_byte(wr * 64 + fr, fq * 8), boff = lds_byte(wc * 32 + fr, fq * 8);
#define PG8_SA(b, h) (((b) * 2 + (h)) * HTB)
#define PG8_SB(b, h) ((4 + (b) * 2 + (h)) * HTB)
#define PG8_STAGE(bufoff, gbase, voff) do { _Pragma("unroll") for (int _i = 0; _i < 2; ++_i) \
        __builtin_amdgcn_global_load_lds((const unsigned*)((const char*)(gbase) + (voff)[_i]), (PG8_LAS unsigned*)(lds + (bufoff) + ldsw + _i * 8192), 16, 0, 0); } while (0)
#define PG8_LDA(dst, b, h) do { _Pragma("unroll") for (int m = 0; m < 4; ++m) _Pragma("unroll") for (int k = 0; k < 2; ++k) dst[m][k] = *(const PG8_LAS bf16x8*)(lds + PG8_SA(b, h) + aoff + m * 2048 + k * 1024); } while (0)
#define PG8_LDB(dst, b, h) do { _Pragma("unroll") for (int n = 0; n < 2; ++n) _Pragma("unroll") for (int k = 0; k < 2; ++k) dst[n][k] = *(const PG8_LAS bf16x8*)(lds + PG8_SB(b, h) + boff + n * 2048 + k * 1024); } while (0)
#define PG8_MMA(ai, bj, At, Bt) do { __builtin_amdgcn_s_setprio(1); _Pragma("unroll") for (int m = 0; m < 4; ++m) _Pragma("unroll") for (int n = 0; n < 2; ++n) _Pragma("unroll") for (int k = 0; k < 2; ++k) \
        acc[ai][bj][m][n] = __builtin_amdgcn_mfma_f32_16x16x32_bf16(Bt[n][k], At[m][k], acc[ai][bj][m][n], 0, 0, 0); __builtin_amdgcn_s_setprio(0); } while (0)
#define PG8_WAIT_V(n) asm volatile("s_waitcnt vmcnt(" #n ")" ::: "memory")
#define PG8_WAIT_L(n) asm volatile("s_waitcnt lgkmcnt(" #n ")" ::: "memory")
#define PG8_BAR __builtin_amdgcn_s_barrier()
#define PG8_SCHED __builtin_amdgcn_sched_barrier(0)
    Unit cur, nxt; int ui = 0;
    if (!S.next(0, cur)) return;
    f32x4 acc[2][2][4][2];
#pragma unroll
    for (int a = 0; a < 2; ++a)
#pragma unroll
        for (int b = 0; b < 2; ++b)
#pragma unroll
            for (int m = 0; m < 4; ++m)
#pragma unroll
                for (int n = 0; n < 2; ++n) acc[a][b][m][n] = (f32x4){0.f, 0.f, 0.f, 0.f};
    bf16x8 At[4][2], B0[2][2], B1[2][2];
    const char* cA = (const char*)g.A + (size_t)cur.pm * tstep; const char* cB = (const char*)g.Bt + (size_t)cur.pn * tstep;
    S.a_ready(cur);
    PG8_STAGE(PG8_SB(0, 0), cB, voffB); PG8_STAGE(PG8_SA(0, 0), cA, voffA); PG8_STAGE(PG8_SB(0, 1), cB + hstep, voffB); PG8_STAGE(PG8_SA(0, 1), cA + hstep, voffA);
    if (wr == 1) PG8_BAR;
    PG8_WAIT_V(4); PG8_BAR;
    PG8_STAGE(PG8_SB(1, 0), cB + kstep, voffB); PG8_STAGE(PG8_SA(1, 0), cA + kstep, voffA); PG8_STAGE(PG8_SB(1, 1), cB + hstep + kstep, voffB);
    PG8_WAIT_V(6); PG8_BAR;
    for (;;) {
        const bool has_next = S.next(ui + 1, nxt);
        const char* nA = has_next ? (const char*)g.A + (size_t)nxt.pm * tstep : cA; const char* nB = has_next ? (const char*)g.Bt + (size_t)nxt.pn * tstep : cB;
        for (int t = 0; t < nt; t += 2) {
            const bool last = (t == nt - 2);
            const char* a1 = cA + (size_t)(t + 1) * kstep;
            const char* a2 = last ? nA : cA + (size_t)(t + 2) * kstep; const char* b2 = last ? nB : cB + (size_t)(t + 2) * kstep;
            const char* a3 = a2 + kstep; const char* b3 = b2 + kstep;
            if (last && has_next) S.a_ready(nxt);
            PG8_LDB(B0, 0, 0); PG8_SCHED; PG8_LDA(At, 0, 0); PG8_STAGE(PG8_SA(1, 1), a1 + hstep, voffA);
            PG8_WAIT_L(8); PG8_BAR; PG8_WAIT_L(0); PG8_MMA(0, 0, At, B0); PG8_BAR; PG8_SCHED;
            PG8_LDB(B1, 0, 1); PG8_STAGE(PG8_SB(0, 0), b2, voffB);
            PG8_BAR; PG8_WAIT_L(0); PG8_MMA(0, 1, At, B1); PG8_BAR;
            PG8_LDA(At, 0, 1); PG8_STAGE(PG8_SA(0, 0), a2, voffA);
            PG8_BAR; PG8_WAIT_L(0); PG8_MMA(1, 0, At, B0); PG8_BAR; PG8_SCHED;
            PG8_STAGE(PG8_SB(0, 1), b2 + hstep, voffB);
            PG8_WAIT_V(6); PG8_BAR; PG8_MMA(1, 1, At, B1); PG8_BAR;
            PG8_LDB(B0, 1, 0); PG8_SCHED; PG8_LDA(At, 1, 0); PG8_STAGE(PG8_SA(0, 1), a2 + hstep, voffA);
            PG8_WAIT_L(8); PG8_BAR; PG8_WAIT_L(0); PG8_MMA(0, 0, At, B0); PG8_BAR; PG8_SCHED;
            PG8_LDB(B1, 1, 1); PG8_STAGE(PG8_SB(1, 0), b3, voffB);
            PG8_BAR; PG8_WAIT_L(0); PG8_MMA(0, 1, At, B1); PG8_BAR;
            PG8_LDA(At, 1, 1); PG8_STAGE(PG8_SA(1, 0), a3, voffA);
            PG8_BAR; PG8_WAIT_L(0); PG8_MMA(1, 0, At, B0); PG8_BAR; PG8_SCHED;
            PG8_STAGE(PG8_SB(1, 1), b3 + hstep, voffB);
            PG8_WAIT_V(6); PG8_BAR; PG8_MMA(1, 1, At, B1); PG8_BAR;
        }
            if constexpr (!Epi::AFTER_DRAIN) { E(acc, cur, wr, wc, fr, fq); S.done(cur); }
            if (!has_next) break;
#pragma unroll
        for (int a = 0; a < 2; ++a)
#pragma unroll
            for (int b = 0; b < 2; ++b)
#pragma unroll
                for (int m = 0; m < 4; ++m)
#pragma unroll
                    for (int n = 0; n < 2; ++n) acc[a][b][m][n] = (f32x4){0.f, 0.f, 0.f, 0.f};
        cur = nxt; cA = nA; cB = nB; ++ui;
    }
    PG8_WAIT_V(0);
    if (wr == 0) PG8_BAR;
    PG8_BAR;
    if constexpr (Epi::AFTER_DRAIN) { E.fused(acc, cur, wr, wc, fr, fq, lds, wid, lane); S.done(cur); }
#undef PG8_SA
#undef PG8_SB
#undef PG8_STAGE
#undef PG8_LDA
#undef PG8_LDB
#undef PG8_MMA
#undef PG8_WAIT_V
#undef PG8_WAIT_L
#undef PG8_BAR
#undef PG8_SCHED
}
struct UnitG { int pm, pn; const char* bbase; const PG8_LAS int* ltab; int cnt; int e; };
struct MoeOrder {
    const PG8_LAS int* tstart; const PG8_LAS int* tcnt; const PG8_LAS int* ltabs; const int* lists; const char* bt; size_t estride; int ncol, shift, G, c;
    __device__ __forceinline__ bool next(int i, UnitG& u) const {
        const int t = i * G + c; if (t >= tstart[32] * ncol) return false;
        const int tm = t / ncol; int e = 0;
#pragma unroll 1
        while (tstart[e + 1] <= tm) ++e;
        e = __builtin_amdgcn_readfirstlane(e);
        const int ts = __builtin_amdgcn_readfirstlane(tstart[e]), tc = __builtin_amdgcn_readfirstlane(tcnt[e]);
        u.pm = tm - ts; u.pn = t - tm * ncol; u.bbase = bt + (size_t)e * estride; u.e = e; u.cnt = tc - u.pm * BM; u.ltab = ltabs + i * BM;
        return true;
    }
    __device__ __forceinline__ void a_ready(const UnitG&) const {}
    __device__ __forceinline__ void done(const UnitG&) const {}
};
struct EpiSwiGLUG {
    static constexpr bool PERM = false, AFTER_DRAIN = false;
    bf16_t* H;
    __device__ __forceinline__ void operator()(const f32x4 (&acc)[2][2][4][2], const UnitG& u, int wr, int wc, int fr, int fq) const {
#pragma unroll
        for (int ai = 0; ai < 2; ++ai)
#pragma unroll
            for (int m = 0; m < 4; ++m) { const int r = ai * HALF + wr * 64 + m * 16 + fr;
                if (r < u.cnt) { bf16_t* rowp = H + (size_t)u.ltab[r] * DEXP + ((u.pn * BM + wc * 32) >> 1) + 4 * fq;
#pragma unroll
                    for (int bj = 0; bj < 2; ++bj) { const f32x4 gt = acc[ai][bj][m][0], up = acc[ai][bj][m][1];
                        u32x2 w; w.x = pk2(siluf_(gt[0]) * up[0], siluf_(gt[1]) * up[1]); w.y = pk2(siluf_(gt[2]) * up[2], siluf_(gt[3]) * up[3]);
                        *(u32x2*)(rowp + bj * (HALF / 2)) = w; } } }
    }
};
struct EpiScatterG {
    static constexpr bool PERM = true, AFTER_DRAIN = false;
    bf16_t* O;
    __device__ __forceinline__ void operator()(const f32x4 (&acc)[2][2][4][2], const UnitG& u, int wr, int wc, int fr, int fq) const {
#pragma unroll
        for (int ai = 0; ai < 2; ++ai)
#pragma unroll
            for (int m = 0; m < 4; ++m) { const int r = ai * HALF + wr * 64 + m * 16 + fr;
                if (r < u.cnt) { bf16_t* rowp = O + (size_t)u.ltab[r] * D + u.pn * BM + wc * 32 + 8 * fq;
#pragma unroll
                    for (int bj = 0; bj < 2; ++bj) { const f32x4 v0 = acc[ai][bj][m][0], v1 = acc[ai][bj][m][1];
                        u32x4 w; w.x = pk2(v0[0], v0[1]); w.y = pk2(v0[2], v0[3]); w.z = pk2(v1[0], v1[1]); w.w = pk2(v1[2], v1[3]);
                        *(u32x4*)(rowp + bj * HALF) = w; } } }
    }
};
template <class Epi, class Sched>
__device__ __forceinline__ void gemm_phase_g(int wv, PG8_LAS unsigned char* lds, const Gemm g, const Sched& S, const Epi& E) {
    const int tid = ltid(wv), wid = __builtin_amdgcn_readfirstlane(tid >> 6), lane = tid & 63, wr = wid >> 2, wc = wid & 3, fr = lane & 15, fq = lane >> 4;
    const int K = g.K, nt = K / BK;
    unsigned voffB[2];
#pragma unroll
    for (int i = 0; i < 2; ++i) { int R, C; stage_rc(tid * 16 + i * 8192, R, C); const int Rb = Epi::PERM ? ((R & ~31) + perm32(R & 31)) : R;
        voffB[i] = (unsigned)(Rb * K + C) * 2u; }
    const unsigned rowb = (unsigned)K * 2u;
#define PG8_AOFFS(u, dst) do { const int _t = ltid(wv); _Pragma("unroll") for (int _i = 0; _i < 2; ++_i) { int _R, _C; stage_rc(_t * 16 + _i * 8192, _R, _C); \
        _Pragma("unroll") for (int _h = 0; _h < 2; ++_h) dst[_h][_i] = (unsigned)((u).ltab[_h * HALF + _R] >> S.shift) * rowb + (unsigned)(_C * 2); } } while (0)
#define PG8_STAGE_A(bufoff, AO, koff) do { _Pragma("unroll") for (int _i = 0; _i < 2; ++_i) \
        __builtin_amdgcn_global_load_lds((const unsigned*)((const char*)g.A + (size_t)(AO)[_i] + (size_t)(koff)), (PG8_LAS unsigned*)(lds + (bufoff) + ldsw + _i * 8192), 16, 0, 0); } while (0)
    const size_t kstep = (size_t)(BK * 2);
    const size_t hstep = (size_t)HALF * K * 2;
    const size_t tstep = 2 * hstep;
    const unsigned ldsw = (unsigned)wid * 1024u;
    const int aoff = lds_byte(wr * 64 + fr, fq * 8), boff = lds_byte(wc * 32 + fr, fq * 8);
#define PG8_SA(b, h) (((b) * 2 + (h)) * HTB)
#define PG8_SB(b, h) ((4 + (b) * 2 + (h)) * HTB)
#define PG8_STAGE(bufoff, gbase, voff) do { _Pragma("unroll") for (int _i = 0; _i < 2; ++_i) \
        __builtin_amdgcn_global_load_lds((const unsigned*)((const char*)(gbase) + (voff)[_i]), (PG8_LAS unsigned*)(lds + (bufoff) + ldsw + _i * 8192), 16, 0, 0); } while (0)
#define PG8_LDA(dst, b, h) do { _Pragma("unroll") for (int m = 0; m < 4; ++m) _Pragma("unroll") for (int k = 0; k < 2; ++k) dst[m][k] = *(const PG8_LAS bf16x8*)(lds + PG8_SA(b, h) + aoff + m * 2048 + k * 1024); } while (0)
#define PG8_LDB(dst, b, h) do { _Pragma("unroll") for (int n = 0; n < 2; ++n) _Pragma("unroll") for (int k = 0; k < 2; ++k) dst[n][k] = *(const PG8_LAS bf16x8*)(lds + PG8_SB(b, h) + boff + n * 2048 + k * 1024); } while (0)
#define PG8_MMA(ai, bj, At, Bt) do { __builtin_amdgcn_s_setprio(1); _Pragma("unroll") for (int m = 0; m < 4; ++m) _Pragma("unroll") for (int n = 0; n < 2; ++n) _Pragma("unroll") for (int k = 0; k < 2; ++k) \
        acc[ai][bj][m][n] = __builtin_amdgcn_mfma_f32_16x16x32_bf16(Bt[n][k], At[m][k], acc[ai][bj][m][n], 0, 0, 0); __builtin_amdgcn_s_setprio(0); } while (0)
#define PG8_WAIT_V(n) asm volatile("s_waitcnt vmcnt(" #n ")" ::: "memory")
#define PG8_WAIT_L(n) asm volatile("s_waitcnt lgkmcnt(" #n ")" ::: "memory")
#define PG8_BAR __builtin_amdgcn_s_barrier()
#define PG8_SCHED __builtin_amdgcn_sched_barrier(0)
    UnitG cur, nxt; int ui = 0;
    if (!S.next(0, cur)) return;
    f32x4 acc[2][2][4][2];
#pragma unroll
    for (int a = 0; a < 2; ++a)
#pragma unroll
        for (int b = 0; b < 2; ++b)
#pragma unroll
            for (int m = 0; m < 4; ++m)
#pragma unroll
                for (int n = 0; n < 2; ++n) acc[a][b][m][n] = (f32x4){0.f, 0.f, 0.f, 0.f};
    bf16x8 At[4][2], B0[2][2], B1[2][2];
    unsigned ca[2][2]; PG8_AOFFS(cur, ca); const char* cB = cur.bbase + (size_t)cur.pn * tstep;
    S.a_ready(cur);
    PG8_STAGE(PG8_SB(0, 0), cB, voffB); PG8_STAGE_A(PG8_SA(0, 0), ca[0], 0); PG8_STAGE(PG8_SB(0, 1), cB + hstep, voffB); PG8_STAGE_A(PG8_SA(0, 1), ca[1], 0);
    if (wr == 1) PG8_BAR;
    PG8_WAIT_V(4); PG8_BAR;
    PG8_STAGE(PG8_SB(1, 0), cB + kstep, voffB); PG8_STAGE_A(PG8_SA(1, 0), ca[0], kstep); PG8_STAGE(PG8_SB(1, 1), cB + hstep + kstep, voffB);
    PG8_WAIT_V(6); PG8_BAR;
    for (;;) {
        const bool has_next = S.next(ui + 1, nxt);
        const char* nB = has_next ? nxt.bbase + (size_t)nxt.pn * tstep : cB;
        for (int t = 0; t < nt; t += 2) {
            const bool last = (t == nt - 2);
            const size_t k1 = (size_t)(t + 1) * kstep, k2 = last ? 0 : (size_t)(t + 2) * kstep;
            unsigned a2o[2][2];
            if (last && has_next) PG8_AOFFS(nxt, a2o); else { a2o[0][0] = ca[0][0]; a2o[0][1] = ca[0][1]; a2o[1][0] = ca[1][0]; a2o[1][1] = ca[1][1]; }
            const char* b2 = last ? nB : cB + (size_t)(t + 2) * kstep; const char* b3 = b2 + kstep;
            if (last && has_next) S.a_ready(nxt);
            PG8_LDB(B0, 0, 0); PG8_SCHED; PG8_LDA(At, 0, 0); PG8_STAGE_A(PG8_SA(1, 1), ca[1], k1);
            PG8_WAIT_L(8); PG8_BAR; PG8_WAIT_L(0); PG8_MMA(0, 0, At, B0); PG8_BAR; PG8_SCHED;
            PG8_LDB(B1, 0, 1); PG8_STAGE(PG8_SB(0, 0), b2, voffB);
            PG8_BAR; PG8_WAIT_L(0); PG8_MMA(0, 1, At, B1); PG8_BAR;
            PG8_LDA(At, 0, 1); PG8_STAGE_A(PG8_SA(0, 0), a2o[0], k2);
            PG8_BAR; PG8_WAIT_L(0); PG8_MMA(1, 0, At, B0); PG8_BAR; PG8_SCHED;
            PG8_STAGE(PG8_SB(0, 1), b2 + hstep, voffB);
            PG8_WAIT_V(6); PG8_BAR; PG8_MMA(1, 1, At, B1); PG8_BAR;
            PG8_LDB(B0, 1, 0); PG8_SCHED; PG8_LDA(At, 1, 0); PG8_STAGE_A(PG8_SA(0, 1), a2o[1], k2);
            PG8_WAIT_L(8); PG8_BAR; PG8_WAIT_L(0); PG8_MMA(0, 0, At, B0); PG8_BAR; PG8_SCHED;
            PG8_LDB(B1, 1, 1); PG8_STAGE(PG8_SB(1, 0), b3, voffB);
            PG8_BAR; PG8_WAIT_L(0); PG8_MMA(0, 1, At, B1); PG8_BAR;
            PG8_LDA(At, 1, 1); PG8_STAGE_A(PG8_SA(1, 0), a2o[0], k2 + kstep);
            PG8_BAR; PG8_WAIT_L(0); PG8_MMA(1, 0, At, B0); PG8_BAR; PG8_SCHED;
            PG8_STAGE(PG8_SB(1, 1), b3 + hstep, voffB);
            PG8_WAIT_V(6); PG8_BAR; PG8_MMA(1, 1, At, B1); PG8_BAR;
            if (last) { ca[0][0] = a2o[0][0]; ca[0][1] = a2o[0][1]; ca[1][0] = a2o[1][0]; ca[1][1] = a2o[1][1]; }
        }
            if constexpr (!Epi::AFTER_DRAIN) { E(acc, cur, wr, wc, fr, fq); S.done(cur); }
            if (!has_next) break;
#pragma unroll
        for (int a = 0; a < 2; ++a)
#pragma unroll
            for (int b = 0; b < 2; ++b)
#pragma unroll
                for (int m = 0; m < 4; ++m)
#pragma unroll
                    for (int n = 0; n < 2; ++n) acc[a][b][m][n] = (f32x4){0.f, 0.f, 0.f, 0.f};
        cur = nxt; cB = nB; ++ui;
    }
    PG8_WAIT_V(0);
    if (wr == 0) PG8_BAR;
    PG8_BAR;
    if constexpr (Epi::AFTER_DRAIN) { E.fused(acc, cur, wr, wc, fr, fq, lds, wid, lane); S.done(cur); }
#undef PG8_SA
#undef PG8_AOFFS
#undef PG8_STAGE_A
#undef PG8_SB
#undef PG8_STAGE
#undef PG8_LDA
#undef PG8_LDB
#undef PG8_MMA
#undef PG8_WAIT_V
#undef PG8_WAIT_L
#undef PG8_BAR
#undef PG8_SCHED
}
}

__device__ __forceinline__ void transpose_item(const float* __restrict__ W, int K, int N, bf16_t* __restrict__ WT, int mode, LAS float* scr, int item, int lane) {
    const int nblk = N / 32, kb = item / nblk, nb = item % nblk, k0 = 64 * kb, n0 = 32 * nb;
    {
        const float* wp = W + (size_t)(k0 + (lane >> 5)) * N + n0 + (lane & 31);
        float t[32];
#pragma unroll
        for (int i = 0; i < 32; ++i) t[i] = wp[(size_t)(2 * i) * N];
#pragma unroll
        for (int i = 0; i < 32; ++i) scr[(2 * i + (lane >> 5)) * 33 + (lane & 31)] = t[i];
    }
    asm volatile("s_waitcnt lgkmcnt(0)" ::: "memory");
    const int c = lane & 7;
#pragma unroll
    for (int j = 0; j < 4; ++j) {
        const int nl = (lane >> 3) + 8 * j; const LAS float* s = scr + (8 * c) * 33 + nl;
        u32x4 o; o.x = pk2(s[0 * 33], s[1 * 33]); o.y = pk2(s[2 * 33], s[3 * 33]); o.z = pk2(s[4 * 33], s[5 * 33]); o.w = pk2(s[6 * 33], s[7 * 33]);
        const int n = n0 + nl;
        const int nd = mode == 0 ? n : (32 * (n >> 4) + (n & 15) + (mode == 2 ? 16 : 0));
        *(u32x4*)(WT + (size_t)nd * K + k0 + 8 * c) = o;
    }
    asm volatile("s_waitcnt lgkmcnt(0)" ::: "memory");
}

constexpr int EXC_IG = 16 * 16, EXC_IDN = 8 * 32, EXC_PER = 2 * EXC_IG + EXC_IDN, EXC_ITEMS = NEXP * EXC_PER;
__device__ __forceinline__ int exc_s0(int layer) { return (layer & 1) ? 8192 : 10240; }
__device__ __forceinline__ int exc_s1(int layer) { return layer == DEPTH - 1 ? 0 : 7168; }
__device__ __forceinline__ void expconv_items(const CAS Params& P, int layer, LAS char* lds, int lo, int hi, int worker, int nworkers, int wid, int lane) {
    LAS float* scr = (LAS float*)(lds + wid * 8448);
    bf16_t* gu = (bf16_t*)(P.ws + WS_EXPGU); bf16_t* dw = (bf16_t*)(P.ws + WS_EXPD);
    for (int it = lo + worker; it < hi; it += nworkers) {
        const int e = it / EXC_PER; int r = it % EXC_PER;
        const size_t eo = (size_t)(layer * NEXP + e);
        if (r < EXC_IG) { transpose_item(P.exp_w_gate + eo * D * DEXP, D, DEXP, gu + (size_t)e * 1024 * 1024, 1, scr, r, lane); continue; } r -= EXC_IG;
        if (r < EXC_IG) { transpose_item(P.exp_w_up + eo * D * DEXP, D, DEXP, gu + (size_t)e * 1024 * 1024, 2, scr, r, lane); continue; } r -= EXC_IG;
        transpose_item(P.exp_w_down + eo * DEXP * D, DEXP, D, dw + (size_t)e * 1024 * 512, 0, scr, r, lane);
    }
}
__device__ __forceinline__ void expconv_tail(int wv, const CAS Params& P, int layer, LAS char* lds, int nwg, int lo, int hi) {
    const int G = gridDim.x, rem = nwg % G;
    if (rem != 0 && (int)blockIdx.x >= rem && lo < hi) {
        const int tid = ltid(wv);
        __syncthreads();
        expconv_items(P, layer, lds, lo, hi, ((int)blockIdx.x - rem) * 8 + (tid >> 6), (G - rem) * 8, tid >> 6, tid & 63);
    }
}

__device__ __forceinline__ void phase_prologue0(int wv, KP Pk, LAS char* lds) {
    asm volatile("" : "+s"(Pk));
    const CAS Params& P = *Pk;
    const int tid = ltid(wv), lane = tid & 63, wid = tid >> 6;
    const int gw = blockIdx.x * 8 + wid, NGW = gridDim.x * 8;
    LAS float* scr = (LAS float*)(lds + wid * 8448);
    bf16_t* winT = (bf16_t*)(P.ws + WS_WINT);
    bf16_t* woutT = (bf16_t*)(P.ws + WS_WOUTT);
    bf16_t* loraT = (bf16_t*)(P.ws + WS_LORAT);
    constexpr int I_EV = 16 * (P_EVEN / 32), I_OD = 16 * (P_ODD / 32), I_O = 16 * 32, I_L64 = 16, I_L128 = 32;
    constexpr int I_LORA = 3 * I_L64 + I_L128;
    constexpr int NIT = 2 * I_EV + 2 * I_OD + 4 * I_O + 2 * I_LORA;
    for (int it = gw; it < NIT; it += NGW) {
        int r = it;
        if (r < 2 * I_EV) { const int i = r / I_EV; transpose_item(P.ev_w_in + (size_t)i * D * P_EVEN, D, P_EVEN, winT + (i ? WINT_L2 : WINT_L0), 0, scr, r % I_EV, lane); continue; } r -= 2 * I_EV;
        if (r < 2 * I_OD) { const int i = r / I_OD; transpose_item(P.od_w_in + (size_t)i * D * P_ODD, D, P_ODD, winT + (i ? WINT_L3 : WINT_L1), 0, scr, r % I_OD, lane); continue; } r -= 2 * I_OD;
        if (r < 4 * I_O) { const int l = r / I_O; const float* src = (l & 1) ? P.od_w_out + (size_t)(l >> 1) * D * D : P.ev_w_out + (size_t)(l >> 1) * D * D;
            transpose_item(src, D, D, woutT + (size_t)l * D * D, 0, scr, r % I_O, lane); continue; } r -= 4 * I_O;
        { const int i = r / I_LORA; int q = r % I_LORA; bf16_t* dst = loraT + (size_t)i * LORA_PER;
          if (q < I_L64) { transpose_item(P.rw_w2 + (size_t)(i * 2 + 0) * 64 * 512, 64, 512, dst, 0, scr, q, lane); continue; } q -= I_L64;
          if (q < I_L64) { transpose_item(P.rw_w2 + (size_t)(i * 2 + 1) * 64 * 512, 64, 512, dst + 512 * 64, 0, scr, q, lane); continue; } q -= I_L64;
          if (q < I_L64) { transpose_item(P.rw_a2 + (size_t)i * 64 * 512, 64, 512, dst + 2 * 512 * 64, 0, scr, q, lane); continue; } q -= I_L64;
          transpose_item(P.rw_g2 + (size_t)i * 128 * 512, 128, 512, dst + 3 * 512 * 64, 0, scr, q, lane); }
    }
    {
        const int gt = blockIdx.x * NT + tid, NG = gridDim.x * NT;
        constexpr int PADE = (LDP_EVEN - P_EVEN) * D / 8, PADO = (LDP_ODD - P_ODD) * D / 8;
        for (int i = gt; i < 2 * PADE + 2 * PADO; i += NG) {
            int r = i; bf16_t* dst;
            if (r < 2 * PADE) { const int l = r / PADE; dst = winT + (l ? WINT_L2 : WINT_L0) + (size_t)P_EVEN * D + (size_t)(r % PADE) * 8; }
            else { r -= 2 * PADE; const int l = r / PADO; dst = winT + (l ? WINT_L3 : WINT_L1) + (size_t)P_ODD * D + (size_t)(r % PADO) * 8; }
            *(u32x4*)dst = (u32x4){0u, 0u, 0u, 0u};
        }
    }
    {
        const int gt = blockIdx.x * NT + tid, NG = gridDim.x * NT;
        float* lb = (float*)(P.ws + WS_LB);
        for (int ch = gt; ch < 512; ch += NG) {
            float lg[4], mx = -1e30f;
#pragma unroll
            for (int l = 0; l < 4; ++l) { lg[l] = P.hg_lb_logits[l * 512 + ch]; mx = fmaxf(mx, lg[l]); }
            float e[4], s = 0.f;
#pragma unroll
            for (int l = 0; l < 4; ++l) { e[l] = __expf(lg[l] - mx); s += e[l]; }
            float cum = 0.f;
#pragma unroll
            for (int l = 0; l < 4; ++l) { if (l > 0) cum += e[l] / s; lb[l * 512 + ch] = cum; }
        }
    }
    __syncthreads();
    {
        LAS float* sc = (LAS float*)lds;
        LAS float* red = (LAS float*)(lds + 5 * 1024 * 4);
        for (int i = tid; i < 5 * D; i += NT) { const int m = i >> 10, k = i & 1023; const float v = m < 4 ? P.c[m * D + k] : P.c_ctx[k]; sc[i] = siluf_(v); }
        __syncthreads();
        float* modv = (float*)(P.ws + WS_MODV);
        const int col = tid & 127, kq = tid >> 7;
        for (int item = blockIdx.x; item < 4 * 48; item += gridDim.x) {
            const int l = item / 48, j = (item % 48) * 128 + col;
            const float* w = P.mod_w + (size_t)l * D * 6144 + j;
            float a[5] = {0.f, 0.f, 0.f, 0.f, 0.f};
#pragma unroll 8
            for (int k = kq * 256; k < kq * 256 + 256; ++k) {
                const float wv = w[(size_t)k * 6144];
#pragma unroll
                for (int m = 0; m < 5; ++m) a[m] += sc[m * 1024 + k] * wv;
            }
#pragma unroll
            for (int m = 0; m < 5; ++m) red[(kq * 128 + col) * 5 + m] = a[m];
            __syncthreads();
            if (kq == 0) {
                const float bias = P.mod_b[l * 6144 + j];
#pragma unroll
                for (int m = 0; m < 5; ++m) {
                    const float s = red[(0 * 128 + col) * 5 + m] + red[(1 * 128 + col) * 5 + m] + red[(2 * 128 + col) * 5 + m] + red[(3 * 128 + col) * 5 + m];
                    modv[(size_t)(l * 5 + m) * 6144 + j] = s + bias;
                }
            }
            __syncthreads();
        }
    }
}

__device__ __forceinline__ void phase_prologue1(int wv, KP Pk) {
    asm volatile("" : "+s"(Pk));
    const CAS Params& P = *Pk;
    const int tid = ltid(wv), lane = tid & 63, wid = tid >> 6;
    bf16_t* act = (bf16_t*)(P.ws + WS_ACT);
    for (int r = blockIdx.x * 8 + wid; r < NROWS; r += gridDim.x * 8) {
        const int m = row_mod(r);
        const float* src = r < NCTX ? P.ctx + (size_t)r * D : P.x + (size_t)(r - NCTX) * D;
        const float* sh = modvec(P.ws, 0, m, 0); const float* sc = modvec(P.ws, 0, m, 1);
#pragma unroll
        for (int i = 0; i < 4; ++i) {
            const int c = 4 * lane + 256 * i;
            const f32x4 v = *(const f32x4*)(src + c), s1 = *(const f32x4*)(sc + c), h1 = *(const f32x4*)(sh + c);
            u32x2 o; o.x = pk2(v[0] * (1.f + s1[0]) + h1[0], v[1] * (1.f + s1[1]) + h1[1]); o.y = pk2(v[2] * (1.f + s1[2]) + h1[2], v[3] * (1.f + s1[3]) + h1[3]);
            *(u32x2*)(act + (size_t)r * D + c) = o;
        }
    }
}

__device__ __forceinline__ void phase_inproj(int wv, KP Pk, int layer, LAS char* lds) {
    asm volatile("" : "+s"(Pk));
    const CAS Params& P = *Pk;
    const int odd = layer & 1, ldp = odd ? LDP_ODD : LDP_EVEN;
    const size_t woff = layer == 0 ? WINT_L0 : layer == 1 ? WINT_L1 : layer == 2 ? WINT_L2 : WINT_L3;
    pg8::Gemm g{(const bf16_t*)(P.ws + WS_ACT), (const bf16_t*)(P.ws + WS_WINT) + woff, NROWS, ldp, D};
    pg8::StaticOrder S; S.init(NROWS, ldp, (int)gridDim.x, (int)blockIdx.x);
    pg8::EpiStoreP E{(bf16_t*)(P.ws + WS_P), ldp};
    pg8::gemm_phase(wv, (PG8_LAS unsigned char*)lds, g, S, E);
    expconv_tail(wv, P, layer, lds, (NROWS / 256) * (ldp / 256), 0, exc_s0(layer));
}
__device__ __forceinline__ void phase_outproj(int wv, KP Pk, int layer, LAS char* lds) {
    asm volatile("" : "+s"(Pk));
    const CAS Params& P = *Pk;
    const int r0 = (layer == DEPTH - 1) ? NCTX : 0;
    pg8::Gemm g{(const bf16_t*)(P.ws + WS_FEAT) + (size_t)r0 * D, (const bf16_t*)(P.ws + WS_WOUTT) + (size_t)layer * D * D, NROWS - r0, D, D};
    pg8::StaticOrder S; S.init(NROWS - r0, D, (int)gridDim.x, (int)blockIdx.x);
    pg8::EpiStoreP E{(bf16_t*)(P.ws + WS_YO) + (size_t)r0 * D, D};
    pg8::gemm_phase(wv, (PG8_LAS unsigned char*)lds, g, S, E);
    expconv_tail(wv, P, layer, lds, ((NROWS - r0) / 256) * (D / 256), exc_s0(layer), exc_s0(layer) + exc_s1(layer));
}
__device__ __forceinline__ void phase_prep2(int wv, KP Pk, int layer, LAS char* lds) {
    asm volatile("" : "+s"(Pk));
    const CAS Params& P = *Pk;
    const int i = layer >> 1;
    const bf16_t* la = (const bf16_t*)(P.ws + WS_LA);
    const bf16_t* lt = (const bf16_t*)(P.ws + WS_LORAT) + (size_t)i * LORA_PER;
    constexpr int MT = NROWS / G_BM, NTL = 512 / G_BN;
    const int ntiles = 4 * MT * NTL;
    for (int t = blockIdx.x; t < ntiles; t += gridDim.x) {
        const int which = t / (MT * NTL), r = t % (MT * NTL), mt = r / NTL, nt = r % NTL;
        RowLinear rs{mt * G_BM};
        if (which < 2) {
            EpiDecay epi{(float*)(P.ws + WS_RWDEC) + (size_t)which * NROWS * 512, P.rw_w0 + (size_t)(i * 2 + which) * 512, mt * G_BM, nt * G_BN};
            gemm_tile(wv, la + which * 64, 320, rs, lt + (size_t)which * 512 * 64, 64, nt * G_BN, 64, epi, lds);
        } else if (which == 2) {
            EpiAK epi{(bf16_t*)(P.ws + WS_RWK), (const bf16_t*)(P.ws + WS_RWKK), (bf16_t*)(P.ws + WS_RWB), P.rw_a0 + i * 512, P.rw_k_a + i * 512, mt * G_BM, nt * G_BN};
            gemm_tile(wv, la + 128, 320, rs, lt + (size_t)2 * 512 * 64, 64, nt * G_BN, 64, epi, lds);
        } else {
            EpiStoreBf16 epi{(bf16_t*)(P.ws + WS_RWG), 512, mt * G_BM, nt * G_BN, 512};
            gemm_tile(wv, la + 192, 320, rs, lt + (size_t)3 * 512 * 64, 128, nt * G_BN, 128, epi, lds);
        }
    }
}
__device__ __forceinline__ void moe_tiles(int wv, const unsigned char* ws, int layer, LAS int* tstart, LAS int* tcnt) {
    const int tid = ltid(wv);
    if (tid < 64) {
        const int* cnt = (const int*)(ws + WS_CNT) + layer * 32 * CNT_STRIDE;
        const int c = tid < NEXP ? cnt[tid * CNT_STRIDE] : 0;
        int incl = (c + G_BM - 1) / G_BM;
#pragma unroll
        for (int o = 1; o < 32; o <<= 1) { const int t = __shfl_up(incl, o); if (tid >= o) incl += t; }
        if (tid < NEXP) { tcnt[tid] = c; tstart[tid] = incl - (c + G_BM - 1) / G_BM; }
        if (tid == NEXP - 1) tstart[NEXP] = incl;
    }
    __syncthreads();
}
__device__ __forceinline__ void phase_moe1(int wv, KP Pk, int layer, LAS char* lds) {
    asm volatile("" : "+s"(Pk));
    const CAS Params& P = *Pk;
    LAS int* tstart = (LAS int*)(lds + pg8::STAGE_BYTES); LAS int* tcnt = tstart + 40;
    moe_tiles(wv, P.ws, layer, tstart, tcnt);
    pg8::Gemm g{(const bf16_t*)(P.ws + WS_ACT), (const bf16_t*)(P.ws + WS_EXPGU), 0, 1024, D};
    LAS int* ltabs = tstart + 128;
    pg8::MoeOrder S{tstart, tcnt, ltabs, (const int*)(P.ws + WS_LIST), (const char*)(P.ws + WS_EXPGU), (size_t)1024 * 1024 * 2, 4, 1, (int)gridDim.x, (int)blockIdx.x};
    pg8::EpiSwiGLUG E{(bf16_t*)(P.ws + WS_HID)};
    for (int i = 0; i < 8; ++i) {
        pg8::UnitG u; if (!S.next(i, u)) break;
        const int tl = ltid(wv);
        const int* ul = (const int*)(P.ws + WS_LIST) + (size_t)u.e * LISTCAP + u.pm * pg8::BM;
        if (tl < pg8::BM) ltabs[i * pg8::BM + tl] = ul[tl < u.cnt ? tl : 0];
    }
    __syncthreads();
    pg8::gemm_phase_g(wv, (PG8_LAS unsigned char*)lds, g, S, E);
    __syncthreads();
}
__device__ __forceinline__ void phase_moe2(int wv, KP Pk, int layer, LAS char* lds) {
    asm volatile("" : "+s"(Pk));
    const CAS Params& P = *Pk;
    LAS int* tstart = (LAS int*)(lds + pg8::STAGE_BYTES); LAS int* tcnt = tstart + 40;
    moe_tiles(wv, P.ws, layer, tstart, tcnt);
    pg8::Gemm g{(const bf16_t*)(P.ws + WS_HID), (const bf16_t*)(P.ws + WS_EXPD), 0, 1024, DEXP};
    LAS int* ltabs = tstart + 128;
    pg8::MoeOrder S{tstart, tcnt, ltabs, (const int*)(P.ws + WS_LIST), (const char*)(P.ws + WS_EXPD), (size_t)1024 * 512 * 2, 4, 0, (int)gridDim.x, (int)blockIdx.x};
    pg8::EpiScatterG E{(bf16_t*)(P.ws + WS_YP)};
    for (int i = 0; i < 8; ++i) {
        pg8::UnitG u; if (!S.next(i, u)) break;
        const int tl = ltid(wv);
        const int* ul = (const int*)(P.ws + WS_LIST) + (size_t)u.e * LISTCAP + u.pm * pg8::BM;
        if (tl < pg8::BM) ltabs[i * pg8::BM + tl] = ul[tl < u.cnt ? tl : 0];
    }
    __syncthreads();
    pg8::gemm_phase_g(wv, (PG8_LAS unsigned char*)lds, g, S, E);
    __syncthreads();
}

constexpr int NCHUNK = NSTEPS / TCH;

constexpr int SSD_F = 32 + 64 + 64;
constexpr int SSD_BUF = TCH * SSD_F + 3 * TCH;

constexpr int ML_F = 64 + 64 + 32;
constexpr int ML_BUF = TCH * ML_F + 4 * TCH;

constexpr int HG_F = 128 + 128 + 32;
constexpr int HG_BUF = TCH * HG_F + TCH;

constexpr int RW_F = 5 * 64 + 32;
constexpr int RW_BUF = TCH * RW_F + TCH;
__device__ __forceinline__ void scan_rwkv(int wv, KP Pk, int layer, int unit, LAS char* lds) {
    asm volatile("" : "+s"(Pk));
    const CAS Params& P = *Pk;
    const int tid = ltid(wv);
    const int seq = unit >> 1, half = unit & 1, b = seq >> 4, h = (seq >> 1) & 7, dir = seq & 1;
    LAS float* bufs = (LAS float*)lds;
    bf16_t* Y = (bf16_t*)(P.ws + (dir ? WS_YB : WS_YF));
    const float* dec = (const float*)(P.ws + WS_RWDEC) + (size_t)dir * NROWS * 512;
    int tj[4], tg_[4]; bool tv[4]; const unsigned char* tbase[4]; int tlds[4];
#pragma unroll
    for (int s = 0; s < 4; ++s) {
        const int task = tid + NT * s; tv[s] = task < TCH * 52; tj[s] = task / 52; tg_[s] = task % 52;
        const int g = tg_[s];
        if (g < 8)       { tbase[s] = P.ws + WS_RWR  + (size_t)(h * 64 + 8 * g) * 2;              tlds[s] = 256 + 8 * g; }
        else if (g < 16) { tbase[s] = P.ws + WS_RWK  + (size_t)(h * 64 + 8 * (g - 8)) * 2;        tlds[s] = 192 + 8 * (g - 8); }
        else if (g < 24) { tbase[s] = P.ws + WS_RWKK + (size_t)(h * 64 + 8 * (g - 16)) * 2;       tlds[s] = 64 + 8 * (g - 16); }
        else if (g < 32) { tbase[s] = P.ws + WS_RWB  + (size_t)(h * 64 + 8 * (g - 24)) * 2;       tlds[s] = 128 + 8 * (g - 24); }
        else if (g < 36) { tbase[s] = P.ws + WS_RWV  + (size_t)(h * 64 + half * 32 + 8 * (g - 32)) * 2; tlds[s] = 320 + 8 * (g - 32); }
        else             { tbase[s] = (const unsigned char*)(dec + h * 64 + 4 * (g - 36));        tlds[s] = 4 * (g - 36); }
    }
    u32x4 rc[4]; int rrow = 0;
    auto load = [&](int c) {
#pragma unroll
        for (int s = 0; s < 4; ++s) {
            rc[s] = (u32x4){0u, 0u, 0u, 0u};
            if (tv[s]) { const int row = scan_row(c * TCH + tj[s], b, dir, 1); rc[s] = *(const u32x4*)(tbase[s] + (size_t)row * (tg_[s] < 36 ? 1024 : 2048)); }
        }
        if (tid < TCH) rrow = scan_row(c * TCH + tid, b, dir, 1);
    };
    auto store = [&](int c) {
        LAS float* buf = bufs + (c & 1) * RW_BUF;
#pragma unroll
        for (int s = 0; s < 4; ++s) {
            if (tv[s]) {
                LAS float* dst = buf + tj[s] * RW_F + tlds[s];
                const int g = tg_[s];
                if (g >= 36) { *(LAS u32x4*)dst = rc[s]; }
                else {
                    float f[8]; unpack8(rc[s], f);
                    const float sg = (g >= 16 && g < 24) ? -1.f : 1.f;
                    *(LAS f32x4*)dst = (f32x4){sg * f[0], sg * f[1], sg * f[2], sg * f[3]}; *(LAS f32x4*)(dst + 4) = (f32x4){sg * f[4], sg * f[5], sg * f[6], sg * f[7]};
                }
            }
        }
        if (tid < TCH) ((LAS int*)buf)[TCH * RW_F + tid] = rrow;
    };
    const int vrow = tid >> 4, q = tid & 15;
    float S[4] = {0.f, 0.f, 0.f, 0.f};
    LAS float* ypw = bufs + 2 * RW_BUF + (tid >> 6) * (2 * 16 * 68);
    int prow = -1, gpar = 0;
    load(0); store(0); __syncthreads();
    for (int c = 0; c < NCHUNK; ++c) {
        if (c + 1 < NCHUNK) load(c + 1);
        LAS float* buf = bufs + (c & 1) * RW_BUF;
        {
            const LAS float* wp = buf + 4 * q;
            const LAS float* vp = buf + 320 + vrow;
            f32x4 w4 = *(const LAS f32x4*)wp, a4 = *(const LAS f32x4*)(wp + 64), b4 = *(const LAS f32x4*)(wp + 128), k4 = *(const LAS f32x4*)(wp + 192), r4 = *(const LAS f32x4*)(wp + 256); float vr = vp[0];
#pragma unroll 1
            for (int jh = 0; jh < 2; ++jh) {
                const LAS float* rp = ypw + (gpar ^ 1) * (16 * 68) + q * 68 + ((tid >> 4) & 3) * 16;
                const f32x4 p0 = *(const LAS f32x4*)rp, p1 = *(const LAS f32x4*)(rp + 4), p2 = *(const LAS f32x4*)(rp + 8), p3 = *(const LAS f32x4*)(rp + 12);
                LAS float* wpz = ypw + gpar * (16 * 68) + (tid & 63);
#pragma unroll
                for (int j = 0; j < 16; ++j) {
                    const int jj = jh * 16 + j;
                    const f32x4 wc = w4, ac = a4, bc = b4, kc = k4, rc = r4; const float vv = vr;
                    if (j < 15 || jh == 0) {
                        const LAS float* np = wp + (jj + 1) * RW_F;
                        w4 = *(const LAS f32x4*)np; a4 = *(const LAS f32x4*)(np + 64); b4 = *(const LAS f32x4*)(np + 128); k4 = *(const LAS f32x4*)(np + 192); r4 = *(const LAS f32x4*)(np + 256); vr = vp[(jj + 1) * RW_F];
                    }
                    float sa = S[0] * ac[0] + S[1] * ac[1] + S[2] * ac[2] + S[3] * ac[3];
                    sa = allreduce16(sa);
                    float y = 0.f;
#pragma unroll
                    for (int e = 0; e < 4; ++e) { S[e] = S[e] * wc[e] + (sa * bc[e] + vv * kc[e]); y += S[e] * rc[e]; }
                    wpz[j * 68] = y;
                }
                if (prow >= 0) {
                    const f32x4 t = (p0 + p1) + (p2 + p3);
                    Y[(size_t)prow * D + 512 + h * 64 + half * 32 + vrow] = f2bf((t[0] + t[1]) + (t[2] + t[3]));
                }
                prow = ((const LAS int*)buf)[TCH * RW_F + jh * 16 + q];
                gpar ^= 1;
            }
        }
        if (c + 1 < NCHUNK) store(c + 1);
        __syncthreads();
    }
    {
        const LAS float* rp = ypw + (gpar ^ 1) * (16 * 68) + q * 68 + ((tid >> 4) & 3) * 16;
        const f32x4 t = (*(const LAS f32x4*)rp + *(const LAS f32x4*)(rp + 4)) + (*(const LAS f32x4*)(rp + 8) + *(const LAS f32x4*)(rp + 12));
        Y[(size_t)prow * D + 512 + h * 64 + half * 32 + vrow] = f2bf((t[0] + t[1]) + (t[2] + t[3]));
    }
}

constexpr size_t WS_EXBC = WS_RWR;
constexpr size_t WS_EQK = WS_EXBC + (size_t)NROWS * 768 * 2;
constexpr size_t WS_EGT = WS_EQK + (size_t)NROWS * 512 * 2;
static_assert(WS_EGT + (size_t)NROWS * 32 * 4 <= WS_LA, "even-layer prepare buffers must fit in the RWKV region");

__device__ __forceinline__ void phase_prep_even(int wv, KP Pk, int layer) {
    asm volatile("" : "+s"(Pk));
    const CAS Params& P = *Pk;
    const int tid = ltid(wv), lane = tid & 63, wid = tid >> 6, i_ = layer >> 1;
    const bf16_t* Pb = (const bf16_t*)(P.ws + WS_P);
    bf16_t* XBC = (bf16_t*)(P.ws + WS_EXBC); bf16_t* QK = (bf16_t*)(P.ws + WS_EQK); float* GT = (float*)(P.ws + WS_EGT);
    float cw0[4][8], cw1[4][8], cwq[4][8];
#pragma unroll
    for (int e = 0; e < 8; ++e) {
#pragma unroll
        for (int t = 0; t < 3; ++t) {
            cw0[t][e] = P.ssd_conv_w[(size_t)(i_ * 3 + t) * 768 + 8 * lane + e];
            cw1[t][e] = P.ssd_conv_w[(size_t)(i_ * 3 + t) * 768 + 512 + 8 * (lane & 31) + e];
            cwq[t][e] = P.ml_conv_w[(size_t)(i_ * 3 + t) * 512 + 8 * lane + e];
        }
        cw0[3][e] = P.ssd_conv_b[i_ * 768 + 8 * lane + e]; cw1[3][e] = P.ssd_conv_b[i_ * 768 + 512 + 8 * (lane & 31) + e]; cwq[3][e] = P.ml_conv_b[i_ * 512 + 8 * lane + e];
    }
    float gbias = 0.f;
    if (lane < 16) gbias = P.ssd_dt_bias[i_ * 16 + lane]; else if (lane < 24) gbias = P.ml_i_bias[i_ * 8 + lane - 16]; else if (lane < 32) gbias = P.ml_f_bias[i_ * 8 + lane - 24];
    const float qscl = lane < 32 ? 0.125f : 1.f;
    for (int r = blockIdx.x * 8 + wid; r < NROWS; r += gridDim.x * 8) {
        int t, len; row_seg(r, t, len);
        const bf16_t* pr = Pb + (size_t)r * LDP_EVEN;
        const bool hp = t > 0, hn = t < len - 1;
        const u32x4 zero = (u32x4){0u, 0u, 0u, 0u};
        float fc[8], fp[8], fn[8], o[8];
        {
            const int col = 512 + 8 * lane;
            unpack8(*(const u32x4*)(pr + col), fc); unpack8(hp ? *(const u32x4*)(pr - LDP_EVEN + col) : zero, fp); unpack8(hn ? *(const u32x4*)(pr + LDP_EVEN + col) : zero, fn);
#pragma unroll
            for (int e = 0; e < 8; ++e) o[e] = siluf_(cw0[0][e] * fp[e] + cw0[1][e] * fc[e] + cw0[2][e] * fn[e] + cw0[3][e]);
            *(u32x4*)(XBC + (size_t)r * 768 + 8 * lane) = pack8(o);
        }
        if (lane < 32) {
            const int col = 1024 + 8 * lane;
            unpack8(*(const u32x4*)(pr + col), fc); unpack8(hp ? *(const u32x4*)(pr - LDP_EVEN + col) : zero, fp); unpack8(hn ? *(const u32x4*)(pr + LDP_EVEN + col) : zero, fn);
#pragma unroll
            for (int e = 0; e < 8; ++e) o[e] = siluf_(cw1[0][e] * fp[e] + cw1[1][e] * fc[e] + cw1[2][e] * fn[e] + cw1[3][e]);
            *(u32x4*)(XBC + (size_t)r * 768 + 512 + 8 * lane) = pack8(o);
        }
        {
            const int col = 1296 + 8 * lane;
            unpack8(*(const u32x4*)(pr + col), fc); unpack8(hp ? *(const u32x4*)(pr - LDP_EVEN + col) : zero, fp); unpack8(hn ? *(const u32x4*)(pr + LDP_EVEN + col) : zero, fn);
#pragma unroll
            for (int e = 0; e < 8; ++e) o[e] = qscl * siluf_(cwq[0][e] * fp[e] + cwq[1][e] * fc[e] + cwq[2][e] * fn[e] + cwq[3][e]);
            *(u32x4*)(QK + (size_t)r * 512 + 8 * lane) = pack8(o);
        }
        if (lane < 32) {
            const int col = lane < 16 ? 1280 + lane : 2832 + (lane - 16);
            const float x = bf2f(pr[col]) + gbias;
            GT[(size_t)r * 32 + lane] = lane < 16 ? softplusf_(x) : lane < 24 ? x : logsigmoidf_(x);
        }
    }
}

constexpr int CL = 64, NCH64 = NSTEPS / CL, LDT = 72, LDTB = LDT * 2;
__device__ __forceinline__ bf16x8 ldfrag(const LAS char* tile, int ldb, int row0, int k0, int lane) {
    return *(const LAS bf16x8*)(tile + (row0 + (lane & 15)) * ldb + (k0 + 8 * (lane >> 4)) * 2);
}
constexpr int LDTS = 160;
__device__ __forceinline__ int swz_off(int row, int byteoff) { return row * LDTS + (byteoff ^ (((row >> 3) & 7) << 4)); }
__device__ __forceinline__ bf16x8 ldfrag_sw(const LAS char* tile, int row0, int k0, int lane) {
    const int row = row0 + (lane & 15);
    return *(const LAS bf16x8*)(tile + swz_off(row, (k0 + 8 * (lane >> 4)) * 2));
}
__device__ __forceinline__ void st4bf(LAS char* p, const f32x4& v) { u32x2 o; o.x = pk2(v[0], v[1]); o.y = pk2(v[2], v[3]); *(LAS u32x2*)p = o; }

constexpr int SS_BT = 0, SS_CT = SS_BT + 64 * LDTB, SS_BDT = SS_CT + 64 * LDTB, SS_XT = SS_BDT + 64 * LDTB, SS_CUM = SS_XT + 32 * LDTB, SS_DTV = SS_CUM + 256, SS_ROWS = SS_DTV + 256, SS_STG = SS_ROWS + 256;
constexpr int SS_M = 2 * SS_STG, SS_HB = SS_M + 64 * LDTB, SS_END = SS_HB + 32 * LDTB;
static_assert(SS_END <= LDS_BYTES - 16, "SSD LDS map");

constexpr int MS_QT = 0, MS_KT = MS_QT + 64 * LDTB, MS_KET = MS_KT + 64 * LDTB, MS_VT = MS_KET + 64 * LDTB, MS_SC = MS_VT + 32 * LDTB;
constexpr int MS_STG = MS_SC + 8 * 256;
constexpr int MS_W = 2 * MS_STG, MS_CB = MS_W + 64 * LDTB, MS_ONE = MS_CB + 32 * LDTB, MS_NV = MS_ONE + 16 * LDTB, MS_QN = MS_NV + 256, MS_END = MS_QN + 256;
static_assert(MS_END <= LDS_BYTES - 16, "mLSTM LDS map");

constexpr size_t WS_XSS = WS_EGT + al256((size_t)NROWS * 32 * 4);
constexpr size_t XSS_BYTES = (size_t)64 * NCH64 * 64 * 64 * 2;
constexpr size_t WS_XSD = WS_XSS + XSS_BYTES;
constexpr size_t WS_XMC = WS_XSD + al256((size_t)64 * NCH64 * 4);
constexpr size_t XMC_BYTES = (size_t)32 * NCH64 * 128 * 64 * 2;
constexpr size_t WS_XMN = WS_XMC + XMC_BYTES;
constexpr size_t WS_XMS = WS_XMN + (size_t)32 * NCH64 * 64 * 4;
constexpr size_t WS_XMT = WS_XMS + al256((size_t)32 * NCH64 * 4 * 4);
constexpr size_t WS_XEND = WS_XMT + (size_t)32 * NCH64 * 3 * 64 * 4;
static_assert(WS_XEND <= WS_END, "even-layer chunk-state buffers must fit in the RWKV region");
constexpr int NSSD_ITEMS = 64 * NCH64, NML_ITEMS = 32 * NCH64;

template <int CTRL, int RM, int BM> __device__ __forceinline__ float dppx(float old, float v) {
    return __builtin_bit_cast(float, __builtin_amdgcn_update_dpp(__builtin_bit_cast(int, old), __builtin_bit_cast(int, v), CTRL, RM, BM, false));
}
__device__ __forceinline__ float wave_cumsum(float v, int) {
    float t = v;
    t += dppx<0x111, 0xf, 0xf>(0.f, v); t += dppx<0x112, 0xf, 0xf>(0.f, v); t += dppx<0x113, 0xf, 0xf>(0.f, v);
    { const float u = dppx<0x114, 0xf, 0xe>(0.f, t); t += u; }
    { const float u = dppx<0x118, 0xf, 0xc>(0.f, t); t += u; }
    { const float u = dppx<0x142, 0xa, 0xf>(0.f, t); t += u; }
    { const float u = dppx<0x143, 0xc, 0xf>(0.f, t); t += u; }
    return t;
}
__device__ __forceinline__ float wave_cummax(float v, int) {
    const float ninf = -__builtin_huge_valf();
    float t = v;
    t = fmaxf(t, dppx<0x111, 0xf, 0xf>(ninf, v)); t = fmaxf(t, dppx<0x112, 0xf, 0xf>(ninf, v)); t = fmaxf(t, dppx<0x113, 0xf, 0xf>(ninf, v));
    { const float u = dppx<0x114, 0xf, 0xe>(ninf, t); t = fmaxf(t, u); }
    { const float u = dppx<0x118, 0xf, 0xc>(ninf, t); t = fmaxf(t, u); }
    { const float u = dppx<0x142, 0xa, 0xf>(ninf, t); t = fmaxf(t, u); }
    { const float u = dppx<0x143, 0xc, 0xf>(ninf, t); t = fmaxf(t, u); }
    return t;
}
__device__ __forceinline__ float wave_max(float v) {
    const float t = wave_cummax(v, 0);
    return __builtin_bit_cast(float, __builtin_amdgcn_readlane(__builtin_bit_cast(int, t), 63));
}

constexpr int X1S_BDT = 0, X1S_XT = X1S_BDT + 64 * LDTS, X1S_CUM = X1S_XT + 64 * LDTS, X1S_DTV = X1S_CUM + 256, X1S_END = X1S_DTV + 256;
constexpr int X1M_KET = 0, X1M_VT = X1M_KET + 64 * LDTS, X1M_ONE = X1M_VT + 128 * LDTS, X1M_EE = X1M_ONE + 16 * LDTB, X1M_END = X1M_EE + 256;
__device__ __forceinline__ void phase_ex1(int wv, KP Pk, int layer, LAS char* lds) {
    asm volatile("" : "+s"(Pk));
    const CAS Params& P = *Pk;
    const int tid = ltid(wv), lane = tid & 63, wid = tid >> 6, q = lane >> 4, r16 = lane & 15, i_ = layer >> 1;
    const bf16_t* XBC = (const bf16_t*)(P.ws + WS_EXBC); const bf16_t* QK = (const bf16_t*)(P.ws + WS_EQK); const bf16_t* Pb = (const bf16_t*)(P.ws + WS_P);
    const float* GT = (const float*)(P.ws + WS_EGT);
    {
        bf16_t* Hst = (bf16_t*)(P.ws + WS_XSS); float* Dst = (float*)(P.ws + WS_XSD);
        u32x4 rc[2]; float rdt = 0.f;
        auto geom = [&](int it, int& b, int& h, int& dir, int& c) { const int sq = it / NCH64; c = it - sq * NCH64; b = sq >> 4; h = (sq >> 1) & 7; dir = sq & 1; };
        auto load = [&](int it) {
            int b, h, dir, c; geom(it, b, h, dir, c);
            int tl = tid; asm volatile("" : "+v"(tl));
#pragma unroll
            for (int s = 0; s < 2; ++s) {
                const int task = tl + NT * s, j = task >> 4, g = task & 15;
                const int row = scan_row(c * CL + j, b, dir, 0);
                rc[s] = *(const u32x4*)(XBC + (size_t)row * 768 + (g < 8 ? h * 64 + 8 * g : 512 + (h >> 2) * 64 + 8 * (g - 8)));
            }
            if (tl < CL) { const int row = scan_row(c * CL + tl, b, dir, 0); rdt = GT[(size_t)row * 32 + dir * 8 + h]; }
        };
        int it = blockIdx.x;
        if (it < NSSD_ITEMS) load(it);
        for (; it < NSSD_ITEMS; it += gridDim.x) {
            int b, h, dir, c; geom(it, b, h, dir, c);
            const float aco = -__expf(P.ssd_a_log[(i_ * 2 + dir) * 8 + h]);
            if (tid < CL) {
                const float cum = wave_cumsum(rdt * aco, lane);
                ((LAS float*)(lds + X1S_CUM))[tid] = cum; ((LAS float*)(lds + X1S_DTV))[tid] = rdt;
            }
            __syncthreads();
            {
                const LAS float* cum = (const LAS float*)(lds + X1S_CUM);
                const float cumL = cum[CL - 1];
                int tl = tid; asm volatile("" : "+v"(tl));
#pragma unroll
                for (int s = 0; s < 2; ++s) {
                    const int task = tl + NT * s, j = task >> 4, g = task & 15;
                    float f[8]; unpack8(rc[s], f);
                    if (g < 8) {
                        const float dt = ((const LAS float*)(lds + X1S_DTV))[j];
#pragma unroll
                        for (int e = 0; e < 8; ++e) *(LAS bf16_t*)(lds + X1S_XT + swz_off(8 * g + e, j * 2)) = f2bf(f[e] * dt);
                    } else {
                        const float sc = __expf(cumL - cum[j]);
#pragma unroll
                        for (int e = 0; e < 8; ++e) *(LAS bf16_t*)(lds + X1S_BDT + swz_off(8 * (g - 8) + e, j * 2)) = f2bf(f[e] * sc);
                    }
                }
                if (tid == 0) Dst[it] = __expf(cumL);
            }
            if (it + (int)gridDim.x < NSSD_ITEMS) load(it + gridDim.x);
            __syncthreads();
            {
                const int pt = wid >> 1;
#pragma unroll
                for (int u = 0; u < 2; ++u) {
                    const int nt = (wid & 1) * 2 + u;
                    f32x4 sa = (f32x4){0.f, 0.f, 0.f, 0.f};
#pragma unroll
                    for (int k0 = 0; k0 < 64; k0 += 32) sa = __builtin_amdgcn_mfma_f32_16x16x32_bf16(ldfrag_sw(lds + X1S_BDT, nt * 16, k0, lane), ldfrag_sw(lds + X1S_XT, pt * 16, k0, lane), sa, 0, 0, 0);
                    u32x2 o; o.x = pk2(sa[0], sa[1]); o.y = pk2(sa[2], sa[3]);
                    *(u32x2*)(Hst + ((size_t)it * 64 + pt * 16 + r16) * 64 + nt * 16 + 4 * q) = o;
                }
            }
            __syncthreads();
        }
    }
    {
        bf16_t* Cst = (bf16_t*)(P.ws + WS_XMC); float* Nst = (float*)(P.ws + WS_XMN); float* Sst = (float*)(P.ws + WS_XMS); float* Tst = (float*)(P.ws + WS_XMT);
        for (int i = tid; i < 16 * LDTB / 4; i += NT) ((LAS unsigned*)(lds + X1M_ONE))[i] = 0x3f803f80u;
        u32x4 rc[3]; float rli = 0.f, rlf = 0.f;
        auto geom = [&](int it, int& b, int& h, int& dir, int& c) { const int sq = it / NCH64; c = it - sq * NCH64; b = sq >> 3; h = (sq >> 1) & 3; dir = sq & 1; };
        auto load = [&](int it) {
            int b, h, dir, c; geom(it, b, h, dir, c);
            int tl = tid; asm volatile("" : "+v"(tl));
#pragma unroll
            for (int s = 0; s < 3; ++s) {
                const int task = tl + NT * s, j = task / 24, g = task - 24 * j;
                const int row = scan_row(c * CL + j, b, dir, 0);
                rc[s] = g < 8 ? *(const u32x4*)(QK + (size_t)row * 512 + 256 + h * 64 + 8 * g) : *(const u32x4*)(Pb + (size_t)row * LDP_EVEN + 1808 + h * 128 + 8 * (g - 8));
            }
            if (tl < CL) { const int row = scan_row(c * CL + tl, b, dir, 0); rli = GT[(size_t)row * 32 + 16 + dir * 4 + h]; rlf = GT[(size_t)row * 32 + 24 + dir * 4 + h]; }
        };
        int it = blockIdx.x;
        if (it < NML_ITEMS) load(it);
        __syncthreads();
        for (; it < NML_ITEMS; it += gridDim.x) {
            if (tid < CL) {
                const float fcum = wave_cumsum(rlf, lane);
                const float ftot = __builtin_bit_cast(float, __builtin_amdgcn_readlane(__builtin_bit_cast(int, fcum), 63));
                const float g = rli - fcum, pm = wave_cummax(g, lane);
                const float wend = ftot + g, mloc = wave_max(wend);
                ((LAS float*)(lds + X1M_EE))[tid] = __expf(wend - mloc);
                float* tp = Tst + (size_t)it * 192;
                tp[tid] = fcum; tp[64 + tid] = g; tp[128 + tid] = pm;
                if (tid == 0) { Sst[(size_t)it * 4 + 0] = ftot; Sst[(size_t)it * 4 + 1] = mloc; }
            }
            __syncthreads();
            {
                const LAS float* ee = (const LAS float*)(lds + X1M_EE);
                int tl = tid; asm volatile("" : "+v"(tl));
#pragma unroll
                for (int s = 0; s < 3; ++s) {
                    const int task = tl + NT * s, j = task / 24, g = task - 24 * j;
                    if (g < 8) {
                        float f[8]; unpack8(rc[s], f);
                        const float e1 = ee[j];
#pragma unroll
                        for (int e = 0; e < 8; ++e) *(LAS bf16_t*)(lds + X1M_KET + swz_off(8 * g + e, j * 2)) = f2bf(f[e] * e1);
                    } else {
                        const int v0 = 8 * (g - 8);
#pragma unroll
                        for (int e = 0; e < 8; ++e) { const unsigned wv = rc[s][e >> 1]; *(LAS bf16_t*)(lds + X1M_VT + swz_off(v0 + e, j * 2)) = (bf16_t)((e & 1) ? (wv >> 16) : (wv & 0xffffu)); }
                    }
                }
            }
            if (it + (int)gridDim.x < NML_ITEMS) load(it + gridDim.x);
            __syncthreads();
            {
                const bf16x8 vf0 = ldfrag_sw(lds + X1M_VT, wid * 16, 0, lane), vf1 = ldfrag_sw(lds + X1M_VT, wid * 16, 32, lane);
#pragma unroll
                for (int kt = 0; kt < 4; ++kt) {
                    f32x4 sa = __builtin_amdgcn_mfma_f32_16x16x32_bf16(ldfrag_sw(lds + X1M_KET, kt * 16, 0, lane), vf0, (f32x4){0.f, 0.f, 0.f, 0.f}, 0, 0, 0);
                    sa = __builtin_amdgcn_mfma_f32_16x16x32_bf16(ldfrag_sw(lds + X1M_KET, kt * 16, 32, lane), vf1, sa, 0, 0, 0);
                    u32x2 o; o.x = pk2(sa[0], sa[1]); o.y = pk2(sa[2], sa[3]);
                    *(u32x2*)(Cst + ((size_t)it * 128 + wid * 16 + r16) * 64 + kt * 16 + 4 * q) = o;
                }
                if (wid < 4) {
                    f32x4 na = __builtin_amdgcn_mfma_f32_16x16x32_bf16(ldfrag_sw(lds + X1M_KET, wid * 16, 0, lane), ldfrag(lds + X1M_ONE, LDTB, 0, 0, lane), (f32x4){0.f, 0.f, 0.f, 0.f}, 0, 0, 0);
                    na = __builtin_amdgcn_mfma_f32_16x16x32_bf16(ldfrag_sw(lds + X1M_KET, wid * 16, 32, lane), ldfrag(lds + X1M_ONE, LDTB, 0, 32, lane), na, 0, 0, 0);
                    if (r16 == 0) *(f32x4*)(Nst + (size_t)it * 64 + wid * 16 + 4 * q) = na;
                }
            }
            __syncthreads();
        }
    }
}

constexpr int EX2_UB = 12;
static_assert(NCH64 % EX2_UB == 0, "EX2 batches");
__device__ __forceinline__ void phase_ex2(int wv, KP Pk, int layer) {
    asm volatile("" : "+s"(Pk));
    const CAS Params& P = *Pk;
    const int tid = ltid(wv);
    (void)layer;
    if (blockIdx.x < 128) {
        const int gt = blockIdx.x * NT + tid, sq = gt >> 10, rem = gt & 1023;
        bf16_t* Hst = (bf16_t*)(P.ws + WS_XSS) + (size_t)sq * NCH64 * 4096 + rem * 4;
        const float* Dst = (const float*)(P.ws + WS_XSD) + sq * NCH64;
        float h0 = 0.f, h1 = 0.f, h2 = 0.f, h3 = 0.f;
#pragma unroll 1
        for (int c0 = 0; c0 < NCH64; c0 += EX2_UB) {
            u32x2 loc[EX2_UB]; float dd[EX2_UB];
            bf16_t* hp = Hst + (size_t)c0 * 4096;
#pragma unroll
            for (int u = 0; u < EX2_UB; ++u) { loc[u] = *(const u32x2*)(hp + (size_t)u * 4096); dd[u] = Dst[c0 + u]; }
#pragma unroll
            for (int u = 0; u < EX2_UB; ++u) {
                u32x2 o; o.x = pk2(h0, h1); o.y = pk2(h2, h3);
                *(u32x2*)(hp + (size_t)u * 4096) = o;
                const float d = dd[u];
                h0 = d * h0 + bflo(loc[u].x); h1 = d * h1 + bfhi(loc[u].x); h2 = d * h2 + bflo(loc[u].y); h3 = d * h3 + bfhi(loc[u].y);
            }
        }
    } else if (blockIdx.x < 256) {
        const int gt = (blockIdx.x - 128) * NT + tid, sq = gt >> 11, rem = gt & 2047;
        bf16_t* Cst = (bf16_t*)(P.ws + WS_XMC) + (size_t)sq * NCH64 * 8192 + rem * 4;
        float* Nst = (float*)(P.ws + WS_XMN) + (size_t)sq * NCH64 * 64 + (rem & 15) * 4;
        float* Sst = (float*)(P.ws + WS_XMS) + (size_t)sq * NCH64 * 4;
        const bool own_n = rem < 16, own_m = rem == 0;
        float c0_ = 0.f, c1 = 0.f, c2 = 0.f, c3 = 0.f, m = -1e30f;
        f32x4 nn = (f32x4){0.f, 0.f, 0.f, 0.f};
#pragma unroll 1
        for (int cb = 0; cb < NCH64; cb += EX2_UB) {
            u32x2 loc[EX2_UB]; float ft[EX2_UB], ml[EX2_UB]; f32x4 nl[EX2_UB];
            bf16_t* cp = Cst + (size_t)cb * 8192; float* np = Nst + (size_t)cb * 64; float* sp_ = Sst + cb * 4;
#pragma unroll
            for (int u = 0; u < EX2_UB; ++u) {
                loc[u] = *(const u32x2*)(cp + (size_t)u * 8192); ft[u] = sp_[u * 4 + 0]; ml[u] = sp_[u * 4 + 1];
                nl[u] = (f32x4){0.f, 0.f, 0.f, 0.f};
                if (own_n) nl[u] = *(const f32x4*)(np + (size_t)u * 64);
            }
#pragma unroll
            for (int u = 0; u < EX2_UB; ++u) {
                const float ftot = ft[u], mloc = ml[u];
                const float mnew = fmaxf(ftot + m, mloc), sp = __expf(ftot + m - mnew), sl = __expf(mloc - mnew);
                u32x2 o; o.x = pk2(c0_, c1); o.y = pk2(c2, c3);
                *(u32x2*)(cp + (size_t)u * 8192) = o;
                c0_ = sp * c0_ + sl * bflo(loc[u].x); c1 = sp * c1 + sl * bfhi(loc[u].x); c2 = sp * c2 + sl * bflo(loc[u].y); c3 = sp * c3 + sl * bfhi(loc[u].y);
                if (own_n) { *(f32x4*)(np + (size_t)u * 64) = nn; nn = nn * sp + nl[u] * sl; }
                if (own_m) sp_[u * 4 + 2] = m;
                m = mnew;
            }
        }
    }
}

constexpr int X3S_BT = 0, X3S_CT = X3S_BT + 64 * LDTB, X3S_XT = X3S_CT + 64 * LDTB, X3S_HB = X3S_XT + 64 * LDTS, X3S_M = X3S_HB + 64 * LDTB, X3S_CUM = X3S_M + 64 * LDTB, X3S_DTV = X3S_CUM + 256, X3S_ROWS = X3S_DTV + 256, X3S_END = X3S_ROWS + 256;
constexpr int X3M_QT = 0, X3M_KT = X3M_QT + 64 * LDTB, X3M_VT = X3M_KT + 64 * LDTB, X3M_CB = X3M_VT + 128 * LDTS, X3M_W = X3M_CB + 128 * LDTB, X3M_ONE = X3M_W + 64 * LDTB, X3M_NB = X3M_ONE + 16 * LDTB,
              X3M_SC = X3M_NB + 16 * LDTB, X3M_END = X3M_SC + 6 * 256;
static_assert(X3M_END <= LDS_BYTES - 16 && X3S_END <= LDS_BYTES - 16, "EX3 LDS maps");
__device__ __forceinline__ void phase_ex3(int wv, KP Pk, int layer, LAS char* lds) {
    asm volatile("" : "+s"(Pk));
    const CAS Params& P = *Pk;
    const int tid = ltid(wv), lane = tid & 63, wid = tid >> 6, q = lane >> 4, r16 = lane & 15, i_ = layer >> 1;
    const bf16_t* XBC = (const bf16_t*)(P.ws + WS_EXBC); const bf16_t* QK = (const bf16_t*)(P.ws + WS_EQK); const bf16_t* Pb = (const bf16_t*)(P.ws + WS_P);
    const float* GT = (const float*)(P.ws + WS_EGT);
    {
        const bf16_t* Hst = (const bf16_t*)(P.ws + WS_XSS);
        u32x4 rc[3], rh; float rdt = 0.f; int rrow = 0;
        auto geom = [&](int it, int& b, int& h, int& dir, int& c) { const int sq = it / NCH64; c = it - sq * NCH64; b = sq >> 4; h = (sq >> 1) & 7; dir = sq & 1; };
        auto load = [&](int it) {
            int b, h, dir, c; geom(it, b, h, dir, c);
            int tl = tid; asm volatile("" : "+v"(tl));
#pragma unroll
            for (int s = 0; s < 3; ++s) {
                const int task = tl + NT * s, j = task / 24, g = task - 24 * j;
                const int row = scan_row(c * CL + j, b, dir, 0);
                rc[s] = *(const u32x4*)(XBC + (size_t)row * 768 + (g < 8 ? h * 64 + 8 * g : g < 16 ? 512 + (h >> 2) * 64 + 8 * (g - 8) : 640 + (h >> 2) * 64 + 8 * (g - 16)));
            }
            rh = *(const u32x4*)(Hst + (size_t)it * 4096 + tl * 8);
            if (tl < CL) { rrow = scan_row(c * CL + tl, b, dir, 0); rdt = GT[(size_t)rrow * 32 + dir * 8 + h]; }
        };
        int it = blockIdx.x;
        if (it < NSSD_ITEMS) load(it);
        __syncthreads();
        for (; it < NSSD_ITEMS; it += gridDim.x) {
            int b, h, dir, c; geom(it, b, h, dir, c);
            bf16_t* Y = (bf16_t*)(P.ws + (dir ? WS_YB : WS_YF));
            const float aco = -__expf(P.ssd_a_log[(i_ * 2 + dir) * 8 + h]);
            if (tid < CL) {
                const float cum = wave_cumsum(rdt * aco, lane);
                ((LAS float*)(lds + X3S_CUM))[tid] = cum; ((LAS float*)(lds + X3S_DTV))[tid] = rdt; ((LAS int*)(lds + X3S_ROWS))[tid] = rrow;
            }
            __syncthreads();
            {
                int tl = tid; asm volatile("" : "+v"(tl));
#pragma unroll
                for (int s = 0; s < 3; ++s) {
                    const int task = tl + NT * s, j = task / 24, g = task - 24 * j;
                    if (g < 8) {
                        float f[8]; unpack8(rc[s], f);
                        const float dt = ((const LAS float*)(lds + X3S_DTV))[j];
#pragma unroll
                        for (int e = 0; e < 8; ++e) *(LAS bf16_t*)(lds + X3S_XT + swz_off(8 * g + e, j * 2)) = f2bf(f[e] * dt);
                    } else if (g < 16) *(LAS u32x4*)(lds + X3S_BT + j * LDTB + 8 * (g - 8) * 2) = rc[s];
                    else *(LAS u32x4*)(lds + X3S_CT + j * LDTB + 8 * (g - 16) * 2) = rc[s];
                }
                *(LAS u32x4*)(lds + X3S_HB + (tl >> 3) * LDTB + (tl & 7) * 16) = rh;
            }
            if (it + (int)gridDim.x < NSSD_ITEMS) load(it + gridDim.x);
            __syncthreads();
            const LAS float* cum = (const LAS float*)(lds + X3S_CUM);
            {
                const int lt = wid >> 1;
#pragma unroll
                for (int u = 0; u < 2; ++u) {
                    const int st = (wid & 1) * 2 + u;
                    f32x4 acc = (f32x4){0.f, 0.f, 0.f, 0.f};
                    if (st <= lt) {
#pragma unroll
                        for (int k0 = 0; k0 < 64; k0 += 32) acc = __builtin_amdgcn_mfma_f32_16x16x32_bf16(ldfrag(lds + X3S_BT, LDTB, st * 16, k0, lane), ldfrag(lds + X3S_CT, LDTB, lt * 16, k0, lane), acc, 0, 0, 0);
                        const int l = lt * 16 + r16, s0 = st * 16 + 4 * q;
                        const float cl = cum[l]; const f32x4 cs = *(const LAS f32x4*)(cum + s0);
#pragma unroll
                        for (int j = 0; j < 4; ++j) acc[j] = (s0 + j <= l) ? acc[j] * __expf(cl - cs[j]) : 0.f;
                    }
                    st4bf(lds + X3S_M + (lt * 16 + r16) * LDTB + (st * 16 + 4 * q) * 2, acc);
                }
            }
            __syncthreads();
            {
                const int lt = wid >> 1, l = lt * 16 + r16;
                const float el = __expf(cum[l]);
                const int row = ((const LAS int*)(lds + X3S_ROWS))[l];
                const bf16x8 mf0 = ldfrag(lds + X3S_M, LDTB, lt * 16, 0, lane), mf1 = ldfrag(lds + X3S_M, LDTB, lt * 16, 32, lane);
                const bf16x8 cf0 = ldfrag(lds + X3S_CT, LDTB, lt * 16, 0, lane), cf1 = ldfrag(lds + X3S_CT, LDTB, lt * 16, 32, lane);
#pragma unroll
                for (int u = 0; u < 2; ++u) {
                    const int pt = (wid & 1) * 2 + u;
                    f32x4 ya = __builtin_amdgcn_mfma_f32_16x16x32_bf16(ldfrag_sw(lds + X3S_XT, pt * 16, 0, lane), mf0, (f32x4){0.f, 0.f, 0.f, 0.f}, 0, 0, 0);
                    ya = __builtin_amdgcn_mfma_f32_16x16x32_bf16(ldfrag_sw(lds + X3S_XT, pt * 16, 32, lane), mf1, ya, 0, 0, 0);
                    f32x4 oa = __builtin_amdgcn_mfma_f32_16x16x32_bf16(ldfrag(lds + X3S_HB, LDTB, pt * 16, 0, lane), cf0, (f32x4){0.f, 0.f, 0.f, 0.f}, 0, 0, 0);
                    oa = __builtin_amdgcn_mfma_f32_16x16x32_bf16(ldfrag(lds + X3S_HB, LDTB, pt * 16, 32, lane), cf1, oa, 0, 0, 0);
                    u32x2 o; o.x = pk2(ya[0] + el * oa[0], ya[1] + el * oa[1]); o.y = pk2(ya[2] + el * oa[2], ya[3] + el * oa[3]);
                    *(u32x2*)(Y + (size_t)row * D + h * 64 + pt * 16 + 4 * q) = o;
                }
            }
            __syncthreads();
        }
    }
    {
        const bf16_t* Cst = (const bf16_t*)(P.ws + WS_XMC); const float* Nst = (const float*)(P.ws + WS_XMN); const float* Sst = (const float*)(P.ws + WS_XMS); const float* Tst = (const float*)(P.ws + WS_XMT);
        for (int i = tid; i < 16 * LDTB / 4; i += NT) ((LAS unsigned*)(lds + X3M_ONE))[i] = 0x3f803f80u;
        u32x4 rc[4], rcb[2]; float rfc = 0.f, rg = 0.f, rpm = 0.f, rmp = 0.f, rn = 0.f; int rrow = 0;
        auto geom = [&](int it, int& b, int& h, int& dir, int& c) { const int sq = it / NCH64; c = it - sq * NCH64; b = sq >> 3; h = (sq >> 1) & 3; dir = sq & 1; };
        auto load = [&](int it) {
            int b, h, dir, c; geom(it, b, h, dir, c);
            int tl = tid; asm volatile("" : "+v"(tl));
#pragma unroll
            for (int s = 0; s < 4; ++s) {
                const int task = tl + NT * s, j = task >> 5, g = task & 31;
                const int row = scan_row(c * CL + j, b, dir, 0);
                rc[s] = g < 16 ? *(const u32x4*)(QK + (size_t)row * 512 + (g < 8 ? h * 64 + 8 * g : 256 + h * 64 + 8 * (g - 8))) : *(const u32x4*)(Pb + (size_t)row * LDP_EVEN + 1808 + h * 128 + 8 * (g - 16));
            }
#pragma unroll
            for (int s = 0; s < 2; ++s) rcb[s] = *(const u32x4*)(Cst + (size_t)it * 8192 + (tl + NT * s) * 8);
            if (tl < CL) {
                rrow = scan_row(c * CL + tl, b, dir, 0);
                const float* tp = Tst + (size_t)it * 192;
                rfc = tp[tl]; rg = tp[64 + tl]; rpm = tp[128 + tl]; rmp = Sst[(size_t)it * 4 + 2]; rn = Nst[(size_t)it * 64 + tl];
            }
        };
        int it = blockIdx.x;
        if (it < NML_ITEMS) load(it);
        __syncthreads();
        for (; it < NML_ITEMS; it += gridDim.x) {
            int b, h, dir, c; geom(it, b, h, dir, c);
            bf16_t* Y = (bf16_t*)(P.ws + (dir ? WS_YB : WS_YF));
            LAS float* sc = (LAS float*)(lds + X3M_SC);
            {
                int tl = tid; asm volatile("" : "+v"(tl));
#pragma unroll
                for (int s = 0; s < 4; ++s) {
                    const int task = tl + NT * s, j = task >> 5, g = task & 31;
                    if (g < 8) *(LAS u32x4*)(lds + X3M_QT + j * LDTB + 8 * g * 2) = rc[s];
                    else if (g < 16) *(LAS u32x4*)(lds + X3M_KT + j * LDTB + 8 * (g - 8) * 2) = rc[s];
                    else {
                        const int v0 = 8 * (g - 16);
#pragma unroll
                        for (int e = 0; e < 8; ++e) { const unsigned wv = rc[s][e >> 1]; *(LAS bf16_t*)(lds + X3M_VT + swz_off(v0 + e, j * 2)) = (bf16_t)((e & 1) ? (wv >> 16) : (wv & 0xffffu)); }
                    }
                }
#pragma unroll
                for (int s = 0; s < 2; ++s) { const int ch = tl + NT * s; *(LAS u32x4*)(lds + X3M_CB + (ch >> 3) * LDTB + (ch & 7) * 16) = rcb[s]; }
                if (tl < CL) {
                    const float linter = rfc + rmp, mrow = fmaxf(rfc + rpm, linter);
                    sc[tl] = rfc - mrow; sc[64 + tl] = rg; sc[128 + tl] = __expf(linter - mrow); sc[192 + tl] = __expf(-mrow); ((LAS int*)sc)[256 + tl] = rrow;
                    const bf16_t nb = f2bf(rn);
#pragma unroll
                    for (int r = 0; r < 16; ++r) *(LAS bf16_t*)(lds + X3M_NB + r * LDTB + tl * 2) = nb;
                }
            }
            if (it + (int)gridDim.x < NML_ITEMS) load(it + gridDim.x);
            __syncthreads();
            {
                const int lt = wid >> 1;
#pragma unroll
                for (int u = 0; u < 2; ++u) {
                    const int st = (wid & 1) * 2 + u;
                    f32x4 acc = (f32x4){0.f, 0.f, 0.f, 0.f};
                    if (st <= lt) {
#pragma unroll
                        for (int k0 = 0; k0 < 64; k0 += 32) acc = __builtin_amdgcn_mfma_f32_16x16x32_bf16(ldfrag(lds + X3M_KT, LDTB, st * 16, k0, lane), ldfrag(lds + X3M_QT, LDTB, lt * 16, k0, lane), acc, 0, 0, 0);
                        const int l = lt * 16 + r16, s0 = st * 16 + 4 * q;
                        const float rt = sc[l]; const f32x4 gs = *(const LAS f32x4*)(sc + 64 + s0);
#pragma unroll
                        for (int j = 0; j < 4; ++j) acc[j] = (s0 + j <= l) ? acc[j] * __expf(rt + gs[j]) : 0.f;
                    }
                    st4bf(lds + X3M_W + (lt * 16 + r16) * LDTB + (st * 16 + 4 * q) * 2, acc);
                }
            }
            __syncthreads();
            {
                const int lt = wid >> 1, l = lt * 16 + r16;
                const bf16x8 wf0 = ldfrag(lds + X3M_W, LDTB, lt * 16, 0, lane), wf1 = ldfrag(lds + X3M_W, LDTB, lt * 16, 32, lane);
                const bf16x8 qf0 = ldfrag(lds + X3M_QT, LDTB, lt * 16, 0, lane), qf1 = ldfrag(lds + X3M_QT, LDTB, lt * 16, 32, lane);
                f32x4 da = __builtin_amdgcn_mfma_f32_16x16x32_bf16(ldfrag(lds + X3M_ONE, LDTB, 0, 0, lane), wf0, (f32x4){0.f, 0.f, 0.f, 0.f}, 0, 0, 0);
                da = __builtin_amdgcn_mfma_f32_16x16x32_bf16(ldfrag(lds + X3M_ONE, LDTB, 0, 32, lane), wf1, da, 0, 0, 0);
                f32x4 qn = __builtin_amdgcn_mfma_f32_16x16x32_bf16(ldfrag(lds + X3M_NB, LDTB, 0, 0, lane), qf0, (f32x4){0.f, 0.f, 0.f, 0.f}, 0, 0, 0);
                qn = __builtin_amdgcn_mfma_f32_16x16x32_bf16(ldfrag(lds + X3M_NB, LDTB, 0, 32, lane), qf1, qn, 0, 0, 0);
                const float inter = sc[128 + l], emr = sc[192 + l];
                const float inv = __builtin_amdgcn_rcpf(fmaxf(fabsf(da[0] + inter * qn[0]), emr));
                const int row = ((const LAS int*)sc)[256 + l];
#pragma unroll
                for (int u = 0; u < 4; ++u) {
                    const int vt = (wid & 1) * 4 + u;
                    f32x4 na = __builtin_amdgcn_mfma_f32_16x16x32_bf16(ldfrag_sw(lds + X3M_VT, vt * 16, 0, lane), wf0, (f32x4){0.f, 0.f, 0.f, 0.f}, 0, 0, 0);
                    na = __builtin_amdgcn_mfma_f32_16x16x32_bf16(ldfrag_sw(lds + X3M_VT, vt * 16, 32, lane), wf1, na, 0, 0, 0);
                    f32x4 ca = __builtin_amdgcn_mfma_f32_16x16x32_bf16(ldfrag(lds + X3M_CB, LDTB, vt * 16, 0, lane), qf0, (f32x4){0.f, 0.f, 0.f, 0.f}, 0, 0, 0);
                    ca = __builtin_amdgcn_mfma_f32_16x16x32_bf16(ldfrag(lds + X3M_CB, LDTB, vt * 16, 32, lane), qf1, ca, 0, 0, 0);
                    u32x2 o; o.x = pk2((na[0] + inter * ca[0]) * inv, (na[1] + inter * ca[1]) * inv); o.y = pk2((na[2] + inter * ca[2]) * inv, (na[3] + inter * ca[3]) * inv);
                    *(u32x2*)(Y + (size_t)row * D + 512 + h * 128 + vt * 16 + 4 * q) = o;
                }
            }
            __syncthreads();
        }
    }
}

constexpr int HC_RAWF = 0;
constexpr int HC_RAWQ = HC_RAWF + 64 * 128 * 4;
constexpr int HC_SUB = HC_RAWQ + 64 * 128 * 2;
constexpr int HL_QD = 136 * 2;
constexpr int HL_T = 24 * 2;
constexpr int HS_QI = 0, HS_KO = HS_QI + 16 * HL_QD, HS_KET = HS_KO + 16 * HL_QD, HS_ATT = HS_KET + 128 * HL_T, HS_VT = HS_ATT + 16 * HL_T, HS_DEC = HS_VT + 32 * HL_T, HS_SIZE = HS_DEC + 512;
constexpr int HC_SB = HC_SUB + 4 * HS_SIZE;
constexpr int HC_ROWS = HC_SB + 2 * 32 * HL_QD, HC_CST = HC_ROWS + 256, HC_END = HC_CST + 1024;
static_assert(HC_END <= LDS_BYTES - 16, "HGRN2 LDS map");
static_assert(HS_SIZE % 16 == 0 && HC_SB % 16 == 0, "alignment");
__device__ __forceinline__ bf16x8 ldfrag16(const LAS char* tile, int ldb, int row0, int lane) {
    bf16x8 v = *(const LAS bf16x8*)(tile + (row0 + (lane & 15)) * ldb + ((lane >> 4) & 1) * 16);
    if (lane >= 32) v = (bf16x8){0, 0, 0, 0, 0, 0, 0, 0};
    return v;
}
__device__ __forceinline__ void scan_hgrn_c(int wv, KP Pk, int layer, int unit, LAS char* lds) {
    asm volatile("" : "+s"(Pk));
    const CAS Params& P = *Pk;
    const int tid = ltid(wv), lane = tid & 63, wid = tid >> 6, q = lane >> 4, r16 = lane & 15, i_ = layer >> 1;
    const int seq = unit >> 2, quarter = unit & 3, b = seq >> 3, h = (seq >> 1) & 3, dir = seq & 1;
    const bf16_t* Pb = (const bf16_t*)(P.ws + WS_P);
    bf16_t* Y = (bf16_t*)(P.ws + (dir ? WS_YB : WS_YF));
    LAS float* cst = (LAS float*)(lds + HC_CST);
    if (tid < 128) cst[tid] = ((const float*)(P.ws + WS_LB))[layer * 512 + h * 128 + tid];
    else if (tid < 256) cst[tid] = P.hg_f_bias[(size_t)(i_ * 2 + dir) * 512 + h * 128 + tid - 128];
    for (int i = tid; i < 2 * 32 * HL_QD / 4; i += NT) ((LAS unsigned*)(lds + HC_SB))[i] = 0u;
    int tj[5], tg_[5], tcol[5]; bool tv[5];
#pragma unroll
    for (int s = 0; s < 5; ++s) {
        const int task = tid + NT * s; tv[s] = task < 64 * 36; tj[s] = task / 36; tg_[s] = task % 36;
        const int g = tg_[s];
        tcol[s] = g < 16 ? (512 + dir * 512 + h * 128 + 8 * g) : g < 32 ? (h * 128 + 8 * (g - 16)) : (1536 + h * 128 + quarter * 32 + 8 * (g - 32));
    }
    u32x4 rc[5]; int rrow = 0;
    auto load = [&](int c) {
#pragma unroll
        for (int s = 0; s < 5; ++s) {
            rc[s] = (u32x4){0u, 0u, 0u, 0u};
            if (tv[s]) { const int row = scan_row(c * 64 + tj[s], b, dir, 1); rc[s] = *(const u32x4*)(Pb + (size_t)row * LDP_ODD + tcol[s]); }
        }
        if (tid < 64) rrow = scan_row(c * 64 + tid, b, dir, 1);
    };
    auto storeA = [&]() {
#pragma unroll
        for (int s = 0; s < 5; ++s) {
            if (tv[s]) {
                float f[8]; unpack8(rc[s], f);
                const int j = tj[s], g = tg_[s];
                if (g < 16) {
                    float o[8];
#pragma unroll
                    for (int e = 0; e < 8; ++e) { const float lbv = cst[8 * g + e]; o[e] = lbv + (1.f - lbv) * sigmoidf_(f[e] + cst[128 + 8 * g + e]); }
                    LAS float* dst = (LAS float*)(lds + HC_RAWF) + j * 128 + 8 * g;
                    *(LAS f32x4*)dst = (f32x4){o[0], o[1], o[2], o[3]}; *(LAS f32x4*)(dst + 4) = (f32x4){o[4], o[5], o[6], o[7]};
                } else if (g < 32) {
                    float o[8];
#pragma unroll
                    for (int e = 0; e < 8; ++e) o[e] = siluf_(f[e]);
                    *(LAS u32x4*)(lds + HC_RAWQ + (j * 128 + 8 * (g - 16)) * 2) = pack8(o);
                } else {
                    const int v0 = 8 * (g - 32);
                    LAS char* vt = lds + HC_SUB + (j >> 4) * HS_SIZE + HS_VT;
#pragma unroll
                    for (int e = 0; e < 8; ++e) { const unsigned wv = rc[s][e >> 1]; *(LAS bf16_t*)(vt + (v0 + e) * HL_T + (j & 15) * 2) = (bf16_t)((e & 1) ? (wv >> 16) : (wv & 0xffffu)); }
                }
            }
        }
        if (tid < 64) ((LAS int*)(lds + HC_ROWS))[tid] = rrow;
    };
    auto storeB = [&]() {
        const int d = tid & 127, sb = tid >> 7;
        LAS char* st = lds + HC_SUB + sb * HS_SIZE;
        const LAS float* rf = (const LAS float*)(lds + HC_RAWF) + (sb * 16) * 128 + d;
        const LAS bf16_t* rq = (const LAS bf16_t*)(lds + HC_RAWQ) + (sb * 16) * 128 + d;
        float lam = 0.f, lams[16], kfs[16];
#pragma unroll
        for (int t = 0; t < 16; ++t) {
            const float f = rf[t * 128];
            lam += __logf(f);
            const float kf = 1.f - f;
            lams[t] = lam; kfs[t] = kf;
            *(LAS bf16_t*)(st + HS_QI + t * HL_QD + d * 2) = f2bf(bf2f(rq[t * 128]) * __expf(lam));
            *(LAS bf16_t*)(st + HS_KO + t * HL_QD + d * 2) = f2bf(kf * __expf(-lam));
        }
        float ke[16];
#pragma unroll
        for (int t = 0; t < 16; ++t) ke[t] = kfs[t] * __expf(lam - lams[t]);
        *(LAS u32x4*)(st + HS_KET + d * HL_T) = pack8(ke); *(LAS u32x4*)(st + HS_KET + d * HL_T + 16) = pack8(ke + 8);
        ((LAS float*)(st + HS_DEC))[d] = __expf(lam);
    };
    f32x4 sacc[2];
    sacc[0] = sacc[1] = (f32x4){0.f, 0.f, 0.f, 0.f};
    __syncthreads();
    load(0);
    for (int c = 0; c < NSTEPS / 64; ++c) {
        storeA();
        __syncthreads();
        storeB();
        if (c + 1 < NSTEPS / 64) load(c + 1);
        __syncthreads();
        if (wid < 4) {
            LAS char* st = lds + HC_SUB + wid * HS_SIZE;
            f32x4 acc = (f32x4){0.f, 0.f, 0.f, 0.f};
#pragma unroll
            for (int k0 = 0; k0 < 128; k0 += 32) acc = __builtin_amdgcn_mfma_f32_16x16x32_bf16(ldfrag(st + HS_KO, HL_QD, 0, k0, lane), ldfrag(st + HS_QI, HL_QD, 0, k0, lane), acc, 0, 0, 0);
#pragma unroll
            for (int j = 0; j < 4; ++j) acc[j] = (4 * q + j <= r16) ? acc[j] : 0.f;
            st4bf(st + HS_ATT + r16 * HL_T + 4 * q * 2, acc);
        }
        __syncthreads();
#pragma unroll 1
        for (int sb = 0; sb < 4; ++sb) {
            LAS char* st = lds + HC_SUB + sb * HS_SIZE;
            const LAS char* sbr = lds + HC_SB + (sb & 1) * 32 * HL_QD;
            LAS char* sbw = lds + HC_SB + ((sb + 1) & 1) * 32 * HL_QD;
            if (wid < 2) {
                f32x4 ya = __builtin_amdgcn_mfma_f32_16x16x32_bf16(ldfrag16(st + HS_VT, HL_T, wid * 16, lane), ldfrag16(st + HS_ATT, HL_T, 0, lane), (f32x4){0.f, 0.f, 0.f, 0.f}, 0, 0, 0);
#pragma unroll
                for (int k0 = 0; k0 < 128; k0 += 32) ya = __builtin_amdgcn_mfma_f32_16x16x32_bf16(ldfrag(sbr, HL_QD, wid * 16, k0, lane), ldfrag(st + HS_QI, HL_QD, 0, k0, lane), ya, 0, 0, 0);
                const int row = ((const LAS int*)(lds + HC_ROWS))[sb * 16 + r16];
                u32x2 o; o.x = pk2(ya[0], ya[1]); o.y = pk2(ya[2], ya[3]);
                *(u32x2*)(Y + (size_t)row * D + h * 128 + quarter * 32 + wid * 16 + 4 * q) = o;
            }
            {
                const int vt = wid >> 2;
                const bf16x8 vf = ldfrag16(st + HS_VT, HL_T, vt * 16, lane);
#pragma unroll
                for (int u = 0; u < 2; ++u) {
                    const int dt = (wid & 3) * 2 + u;
                    const f32x4 a = __builtin_amdgcn_mfma_f32_16x16x32_bf16(ldfrag16(st + HS_KET, HL_T, dt * 16, lane), vf, (f32x4){0.f, 0.f, 0.f, 0.f}, 0, 0, 0);
                    const f32x4 dc = *(const LAS f32x4*)((const LAS float*)(st + HS_DEC) + dt * 16 + 4 * q);
#pragma unroll
                    for (int j = 0; j < 4; ++j) sacc[u][j] = sacc[u][j] * dc[j] + a[j];
                    st4bf(sbw + (vt * 16 + r16) * HL_QD + (dt * 16 + 4 * q) * 2, sacc[u]);
                }
            }
            __syncthreads();
        }
    }
}

constexpr int RC_RAWW = 0;
constexpr int RC_RAWA = RC_RAWW + 64 * 64 * 4;
constexpr int RC_RAWB = RC_RAWA + 64 * 64 * 2, RC_RAWK = RC_RAWB + 64 * 64 * 2, RC_RAWR = RC_RAWK + 64 * 64 * 2;
constexpr int RC_SUB = RC_RAWR + 64 * 64 * 2;
constexpr int RL_C = 72 * 2, RL_32 = 40 * 2, RL_16 = 24 * 2;
constexpr int RS_AT = 0, RS_RT = RS_AT + 16 * RL_C, RS_KT = RS_RT + 16 * RL_C, RS_BT = RS_KT + 16 * RL_C, RS_KBH = RS_BT + 16 * RL_C, RS_AAK = RS_KBH + 64 * RL_32,
              RS_ARKB = RS_AAK + 16 * RL_16, RS_T = RS_ARKB + 16 * RL_32, RS_AABF = RS_T + 16 * RL_16, RS_GL = RS_AABF + 16 * 16 * 4, RS_VU = RS_GL + 256, RS_SIZE = RS_VU + 32 * RL_32;
constexpr int RC_SB = RC_SUB + 4 * RS_SIZE;
constexpr int RC_RHT = RC_SB + 32 * RL_C;
constexpr int RC_ROWS = RC_RHT + 32 * RL_16, RC_END = RC_ROWS + 256;
static_assert(RC_END <= LDS_BYTES - 16, "RWKV LDS map");
static_assert(RS_SIZE % 16 == 0 && RC_SB % 16 == 0 && RC_RHT % 16 == 0, "alignment");

__device__ __forceinline__ float allreduce8(float v) {
    v += dppmov<0xB1>(v); v += dppmov<0x4E>(v); v += dppmov<0x141>(v);
    return v;
}

__device__ __forceinline__ void phase_prep1(int wv, KP Pk, int layer) {
    asm volatile("" : "+s"(Pk));
    const CAS Params& P = *Pk;
    const int tid = ltid(wv), lane = tid & 63, wid = tid >> 6, i_ = layer >> 1;
    const bf16_t* Pb = (const bf16_t*)(P.ws + WS_P);
    bf16_t* R = (bf16_t*)(P.ws + WS_RWR); bf16_t* K = (bf16_t*)(P.ws + WS_RWK); bf16_t* V = (bf16_t*)(P.ws + WS_RWV); bf16_t* KK = (bf16_t*)(P.ws + WS_RWKK);
    bf16_t* LA = (bf16_t*)(P.ws + WS_LA);
    const float* mu = P.rw_mu + (size_t)i_ * 1856;
    float mur[8], muv[8], muk[8], mul_[8], kkw[8];
#pragma unroll
    for (int e = 0; e < 8; ++e) { mur[e] = mu[8 * lane + e]; muv[e] = mu[1024 + 8 * lane + e]; muk[e] = mu[512 + 8 * lane + e]; mul_[e] = lane < 40 ? mu[1536 + 8 * lane + e] : 0.f; kkw[e] = P.rw_k_k[i_ * 512 + 8 * lane + e]; }
    for (int r = blockIdx.x * 8 + wid; r < NROWS; r += gridDim.x * 8) {
        int rprev = -1, rnext = -1;
        if (r < NCTX) { const int t = r & 255; if (t > 0) rprev = r - 1; if (t < CTXL - 1) rnext = r + 1; }
        else {
            const int bs = (r - NCTX) >> 13, s = (r - NCTX) & 8191, sg = ((s & 63) << 7) + (s >> 6);
            if (sg > 0) { const int g2 = sg - 1; rprev = NCTX + bs * SEQ + ((g2 & 127) << 6) + (g2 >> 7); }
            if (sg < SEQ - 1) { const int g2 = sg + 1; rnext = NCTX + bs * SEQ + ((g2 & 127) << 6) + (g2 >> 7); }
        }
        const bf16_t* pc = Pb + (size_t)r * LDP_ODD + 2560;
        const bf16_t* pp = Pb + (size_t)(rprev < 0 ? r : rprev) * LDP_ODD + 2560;
        const bf16_t* pn = Pb + (size_t)(rnext < 0 ? r : rnext) * LDP_ODD + 2560;
        const float mp = rprev < 0 ? 0.f : 0.5f, mn = rnext < 0 ? 0.f : 0.5f;
        auto mix8 = [&](int col, const float* muc, float* o) {
            float fc[8], fp[8], fn[8];
            unpack8(*(const u32x4*)(pc + col), fc); unpack8(*(const u32x4*)(pp + col), fp); unpack8(*(const u32x4*)(pn + col), fn);
#pragma unroll
            for (int e = 0; e < 8; ++e) o[e] = fc[e] + muc[e] * (mp * fp[e] + mn * fn[e] - fc[e]);
        };
        float o[8];
        mix8(8 * lane, mur, o); *(u32x4*)(R + (size_t)r * 512 + 8 * lane) = pack8(o);
        mix8(1024 + 8 * lane, muv, o); *(u32x4*)(V + (size_t)r * 512 + 8 * lane) = pack8(o);
        mix8(512 + 8 * lane, muk, o); *(u32x4*)(K + (size_t)r * 512 + 8 * lane) = pack8(o);
        {
            float kk[8], ss = 0.f;
#pragma unroll
            for (int e = 0; e < 8; ++e) { kk[e] = o[e] * kkw[e]; ss += kk[e] * kk[e]; }
            ss = group_sum<8>(ss);
            const float rn = rsqrtf(fmaxf(ss, 1e-12f));
#pragma unroll
            for (int e = 0; e < 8; ++e) kk[e] *= rn;
            *(u32x4*)(KK + (size_t)r * 512 + 8 * lane) = pack8(kk);
        }
        if (lane < 40) {
            mix8(1536 + 8 * lane, mul_, o);
            if (lane < 16) {
#pragma unroll
                for (int e = 0; e < 8; ++e) o[e] = tanh_fast(o[e]);
            } else if (lane >= 24) {
#pragma unroll
                for (int e = 0; e < 8; ++e) o[e] = sigmoidf_(o[e]);
            }
            *(u32x4*)(LA + (size_t)r * 320 + 8 * lane) = pack8(o);
        }
    }
}

__device__ __forceinline__ void phase_out_even(int wv, KP Pk, int layer) {
    asm volatile("" : "+s"(Pk));
    const CAS Params& P = *Pk;
    const int tid = ltid(wv), lane = tid & 63, wid = tid >> 6, i_ = layer >> 1;
    const bf16_t* Pb = (const bf16_t*)(P.ws + WS_P);
    const bf16_t* Yf = (const bf16_t*)(P.ws + WS_YF); const bf16_t* Yb = (const bf16_t*)(P.ws + WS_YB);
    bf16_t* feat = (bf16_t*)(P.ws + WS_FEAT);
    const int r0 = (layer == DEPTH - 1) ? NCTX : 0;
    const bf16_t* XBC = (const bf16_t*)(P.ws + WS_EXBC);
    float nwa[8], nwb[8];
#pragma unroll
    for (int e = 0; e < 8; ++e) { nwa[e] = P.ssd_norm_w[i_ * 512 + 8 * lane + e]; nwb[e] = P.ml_norm_w[i_ * 512 + 8 * lane + e]; }
    const float dsk = P.ssd_d[i_ * 8 + (lane >> 3)];
    for (int r = r0 + blockIdx.x * 8 + wid; r < NROWS; r += gridDim.x * 8) {
        const bf16_t* pr = Pb + (size_t)r * LDP_EVEN;
        float y[8];
        {
            float a[8], bb[8], xsv[8], z[8];
            unpack8(*(const u32x4*)(Yf + (size_t)r * D + 8 * lane), a); unpack8(*(const u32x4*)(Yb + (size_t)r * D + 8 * lane), bb);
            unpack8(*(const u32x4*)(XBC + (size_t)r * 768 + 8 * lane), xsv); unpack8(*(const u32x4*)(pr + 8 * lane), z);
            float ss = 0.f;
#pragma unroll
            for (int e = 0; e < 8; ++e) {
                y[e] = (a[e] + bb[e] + dsk * xsv[e]) * siluf_(z[e]); ss += y[e] * y[e];
            }
            ss = wave_sum(ss);
            const float rn = rsqrtf(ss * (1.f / 512.f) + 1e-6f);
#pragma unroll
            for (int e = 0; e < 8; ++e) y[e] = y[e] * rn * nwa[e];
            *(u32x4*)(feat + (size_t)r * D + 8 * lane) = pack8(y);
        }
        {
            float a[8], bb[8], o[8];
            unpack8(*(const u32x4*)(Yf + (size_t)r * D + 512 + 8 * lane), a); unpack8(*(const u32x4*)(Yb + (size_t)r * D + 512 + 8 * lane), bb);
            unpack8(*(const u32x4*)(pr + 2320 + 8 * lane), o);
            float s = 0.f;
#pragma unroll
            for (int e = 0; e < 8; ++e) { y[e] = a[e] + bb[e]; s += y[e]; }
            const float mean = group_sum<16>(s) * (1.f / 128.f);
            float ss = 0.f;
#pragma unroll
            for (int e = 0; e < 8; ++e) { y[e] -= mean; ss += y[e] * y[e]; }
            const float rn = rsqrtf(group_sum<16>(ss) * (1.f / 128.f) + 1e-6f);
#pragma unroll
            for (int e = 0; e < 8; ++e) y[e] = sigmoidf_(o[e]) * (y[e] * rn) * nwb[e];
            *(u32x4*)(feat + (size_t)r * D + 512 + 8 * lane) = pack8(y);
        }
    }
}
__device__ __forceinline__ void phase_out_odd(int wv, KP Pk, int layer) {
    asm volatile("" : "+s"(Pk));
    const CAS Params& P = *Pk;
    const int tid = ltid(wv), lane = tid & 63, wid = tid >> 6, i_ = layer >> 1;
    const bf16_t* Pb = (const bf16_t*)(P.ws + WS_P);
    const bf16_t* Yf = (const bf16_t*)(P.ws + WS_YF); const bf16_t* Yb = (const bf16_t*)(P.ws + WS_YB);
    const bf16_t* R = (const bf16_t*)(P.ws + WS_RWR); const bf16_t* K = (const bf16_t*)(P.ws + WS_RWK); const bf16_t* V = (const bf16_t*)(P.ws + WS_RWV); const bf16_t* G = (const bf16_t*)(P.ws + WS_RWG);
    bf16_t* feat = (bf16_t*)(P.ws + WS_FEAT);
    const int r0 = (layer == DEPTH - 1) ? NCTX : 0;
    float nwc[8], rk[8], lw[8], lbv[8];
#pragma unroll
    for (int e = 0; e < 8; ++e) {
        nwc[e] = P.hg_norm_w[i_ * 512 + 8 * lane + e]; rk[e] = P.rw_r_k[i_ * 512 + 8 * lane + e];
        lw[e] = P.rw_ln_w[i_ * 512 + 8 * lane + e]; lbv[e] = P.rw_ln_b[i_ * 512 + 8 * lane + e];
    }
    for (int r = r0 + blockIdx.x * 8 + wid; r < NROWS; r += gridDim.x * 8) {
        float y[8];
        {
            float a[8], bb[8], g[8];
            unpack8(*(const u32x4*)(Yf + (size_t)r * D + 8 * lane), a); unpack8(*(const u32x4*)(Yb + (size_t)r * D + 8 * lane), bb);
            unpack8(*(const u32x4*)(Pb + (size_t)r * LDP_ODD + 2048 + 8 * lane), g);
            float ss = 0.f;
#pragma unroll
            for (int e = 0; e < 8; ++e) { y[e] = a[e] + bb[e]; ss += y[e] * y[e]; }
            const float rn = rsqrtf(group_sum<16>(ss) * (1.f / 128.f) + 1e-6f);
#pragma unroll
            for (int e = 0; e < 8; ++e) y[e] = y[e] * rn * nwc[e] * siluf_(g[e]);
            *(u32x4*)(feat + (size_t)r * D + 8 * lane) = pack8(y);
        }
        {
            float a[8], bb[8], rr[8], kk[8], vv[8], g[8];
            unpack8(*(const u32x4*)(Yf + (size_t)r * D + 512 + 8 * lane), a); unpack8(*(const u32x4*)(Yb + (size_t)r * D + 512 + 8 * lane), bb);
            unpack8(*(const u32x4*)(R + (size_t)r * 512 + 8 * lane), rr); unpack8(*(const u32x4*)(K + (size_t)r * 512 + 8 * lane), kk);
            unpack8(*(const u32x4*)(V + (size_t)r * 512 + 8 * lane), vv); unpack8(*(const u32x4*)(G + (size_t)r * 512 + 8 * lane), g);
            float s = 0.f, bs = 0.f;
#pragma unroll
            for (int e = 0; e < 8; ++e) { y[e] = a[e] + bb[e]; s += y[e]; bs += rr[e] * kk[e] * rk[e]; }
            const float mean = group_sum<8>(s) * (1.f / 64.f); bs = group_sum<8>(bs);
            float ss = 0.f;
#pragma unroll
            for (int e = 0; e < 8; ++e) { y[e] -= mean; ss += y[e] * y[e]; }
            const float rn = rsqrtf(group_sum<8>(ss) * (1.f / 64.f) + 64e-5f);
#pragma unroll
            for (int e = 0; e < 8; ++e) y[e] = (y[e] * rn * lw[e] + lbv[e] + bs * vv[e]) * g[e];
            *(u32x4*)(feat + (size_t)r * D + 512 + 8 * lane) = pack8(y);
        }
    }
}

#ifndef MK_DOUBLE
#define MK_DOUBLE 0
#endif
#define REP(bit, body) do { body; if (MK_DOUBLE & (bit)) { body; } } while (0)
__device__ __forceinline__ void phase_expconv(int wv, KP Pk, int layer, LAS char* lds) {
    asm volatile("" : "+s"(Pk));
    const CAS Params& P = *Pk;
    const int tid = ltid(wv);
    expconv_items(P, layer, lds, exc_s0(layer) + exc_s1(layer), EXC_ITEMS, (int)blockIdx.x * 8 + (tid >> 6), (int)gridDim.x * 8, tid >> 6, tid & 63);
}
constexpr int L1_AST = 1028;
constexpr int L1_PST = 33;
constexpr int L1_A = 0, L1_PART = L1_A + 16 * L1_AST * 4, L1_SM = L1_PART + 8 * 16 * L1_PST * 4, L1_END = L1_SM + (64 + 2 * 144 + 32) * 4;
static_assert(L1_END <= LDS_BYTES - 16, "LN1 LDS map");
__device__ __forceinline__ void phase_ln1(int wv, KP Pk, int layer, LAS char* lds, bool dry = false) {
    asm volatile("" : "+s"(Pk));
    const CAS Params& P = *Pk;
    const int tid = ltid(wv), lane = tid & 63;
    if (!dry) REP(8, phase_expconv(wv, Pk, layer, lds));
    __syncthreads();
    LAS float* At = (LAS float*)(lds + L1_A);
    LAS float* part = (LAS float*)(lds + L1_PART);
    LAS int* lcnt = (LAS int*)(lds + L1_SM);
    LAS int* lbase = lcnt + 32;
    LAS int* asg = lcnt + 64;
    LAS float* rbias = (LAS float*)(asg + 2 * 144);
    if (tid < 32) { lcnt[tid] = 0; rbias[tid] = P.router_bias[tid]; }
    float breg[8][4][2];
    {
        const float* rw = P.router_w + (size_t)(128 * wv + 4 * (lane >> 4)) * NEXP + (lane & 15);
#pragma unroll
        for (int j = 0; j < 8; ++j)
#pragma unroll
            for (int i = 0; i < 4; ++i) { breg[j][i][0] = rw[(16 * j + i) * NEXP]; breg[j][i][1] = rw[(16 * j + i) * NEXP + 16]; }
    }
    __syncthreads();
    const bf16_t* yo = (const bf16_t*)(P.ws + WS_YO);
    bf16_t* act = (bf16_t*)(P.ws + (dry ? WS_FEAT : WS_ACT));
    bf16_t* xcb = (bf16_t*)(P.ws + WS_XC); bf16_t* xob = (bf16_t*)P.out;
    const bool lastl = (layer == DEPTH - 1);
    int* cnt = (int*)(P.ws + WS_CNT) + layer * 32 * CNT_STRIDE;
    int* list = (int*)(P.ws + WS_LIST);
    float* wts = (float*)(P.ws + WS_WTS);
    const float* lg = P.ln_g + (size_t)(layer * 2 + 0) * D; const float* lb = P.ln_b + (size_t)(layer * 2 + 0) * D;
    const int r0 = (layer == DEPTH - 1) ? NCTX : 0, ntiles = (NROWS - r0) / 16, G = gridDim.x;
    f32x4 g1v[4], s2c[4], h2c[4];
#pragma unroll
    for (int i = 0; i < 4; ++i) g1v[i] = s2c[i] = h2c[i] = (f32x4){0.f, 0.f, 0.f, 0.f};
    int mcur = -1;
    f32x4 nx[2][4]; u32x2 nyo[2][4];
    auto fetch = [&](int s, int rr) {
        if (layer == 0) {
            const float* xq = rr < NCTX ? P.ctx + (size_t)rr * D : P.x + (size_t)(rr - NCTX) * D;
#pragma unroll
            for (int i = 0; i < 4; ++i) nx[s][i] = *(const f32x4*)(xq + 4 * lane + 256 * i);
        } else {
            const bf16_t* xq = rr < NCTX ? xcb + (size_t)rr * D : xob + (size_t)(rr - NCTX) * D;
#pragma unroll
            for (int i = 0; i < 4; ++i) { const u32x2 t = *(const u32x2*)(xq + 4 * lane + 256 * i); nx[s][i] = (f32x4){__uint_as_float(t.x), __uint_as_float(t.y), 0.f, 0.f}; }
        }
#pragma unroll
        for (int i = 0; i < 4; ++i) { const int c = 4 * lane + 256 * i; nyo[s][i] = *(const u32x2*)(yo + (size_t)rr * D + c); }
    };
    int tile = blockIdx.x;
    if (tile < ntiles) { fetch(0, r0 + tile * 16 + 2 * wv); fetch(1, r0 + tile * 16 + 2 * wv + 1); }
    for (int it = 0; tile < ntiles; ++it, tile += G) {
        const int rb = r0 + tile * 16 + 2 * wv;
        const int m = row_mod(rb);
        if (m != mcur) {
            mcur = m;
            const float* g1 = modvec(P.ws, layer, m, 2); const float* sh2 = modvec(P.ws, layer, m, 3); const float* sc2 = modvec(P.ws, layer, m, 4);
#pragma unroll
            for (int i = 0; i < 4; ++i) { const int c = 4 * lane + 256 * i; g1v[i] = *(const f32x4*)(g1 + c); s2c[i] = *(const f32x4*)(sc2 + c); h2c[i] = *(const f32x4*)(sh2 + c); }
        }
#pragma unroll
        for (int s = 0; s < 2; ++s) {
            const int r = rb + s;
            bf16_t* xr = dry ? (bf16_t*)(P.ws + WS_YF) + (size_t)r * D : lastl ? (bf16_t*)(P.ws + WS_FEAT) + (size_t)r * D : r < NCTX ? xcb + (size_t)r * D : xob + (size_t)(r - NCTX) * D;
            f32x4 v[4]; float sm = 0.f;
#pragma unroll
            for (int i = 0; i < 4; ++i) {
                f32x4 xv = nx[s][i]; const f32x4 gv = g1v[i]; const u32x2 yv = nyo[s][i];
                if (layer != 0) { const unsigned b0 = __float_as_uint(xv[0]), b1 = __float_as_uint(xv[1]); xv = (f32x4){bflo(b0), bfhi(b0), bflo(b1), bfhi(b1)}; }
                v[i][0] = ALPHA * xv[0] + gv[0] * bflo(yv.x); v[i][1] = ALPHA * xv[1] + gv[1] * bfhi(yv.x);
                v[i][2] = ALPHA * xv[2] + gv[2] * bflo(yv.y); v[i][3] = ALPHA * xv[3] + gv[3] * bfhi(yv.y);
                sm += (v[i][0] + v[i][1]) + (v[i][2] + v[i][3]);
            }
            if (tile + G < ntiles) fetch(s, r + G * 16);
            const float mean = wave_sum(sm) * (1.f / D);
            float s2 = 0.f;
#pragma unroll
            for (int i = 0; i < 4; ++i) { v[i] = v[i] - mean; s2 += (v[i][0] * v[i][0] + v[i][1] * v[i][1]) + (v[i][2] * v[i][2] + v[i][3] * v[i][3]); }
            const float rstd = rsqrtf(wave_sum(s2) * (1.f / D) + 1e-5f);
            LAS float* arow = At + (2 * wv + s) * L1_AST;
#pragma unroll
            for (int i = 0; i < 4; ++i) {
                const int c = 4 * lane + 256 * i;
                const f32x4 gg = *(const f32x4*)(lg + c), bb = *(const f32x4*)(lb + c), s2v = s2c[i], h2v = h2c[i];
                f32x4 xn, hv;
#pragma unroll
                for (int j = 0; j < 4; ++j) { xn[j] = v[i][j] * rstd * gg[j] + bb[j]; hv[j] = xn[j] * (1.f + s2v[j]) + h2v[j]; }
                { u32x2 ox; ox.x = pk2(xn[0], xn[1]); ox.y = pk2(xn[2], xn[3]); *(u32x2*)(xr + c) = ox; }
                u32x2 o; o.x = pk2(hv[0], hv[1]); o.y = pk2(hv[2], hv[3]); *(u32x2*)(act + (size_t)r * D + c) = o;
                *(LAS f32x4*)(arow + c) = hv;
            }
        }
        __syncthreads();
        {
            f32x4 ra0 = (f32x4){0.f, 0.f, 0.f, 0.f}, ra1 = ra0;
            const LAS float* ap = At + (lane & 15) * L1_AST + 128 * wv + 4 * (lane >> 4);
#pragma unroll
            for (int j = 0; j < 8; ++j) {
                const f32x4 a4 = *(const LAS f32x4*)(ap + 16 * j);
#pragma unroll
                for (int i = 0; i < 4; ++i) {
                    ra0 = __builtin_amdgcn_mfma_f32_16x16x4f32(a4[i], breg[j][i][0], ra0, 0, 0, 0);
                    ra1 = __builtin_amdgcn_mfma_f32_16x16x4f32(a4[i], breg[j][i][1], ra1, 0, 0, 0);
                }
            }
            LAS float* pw = part + wv * 16 * L1_PST + (4 * (lane >> 4)) * L1_PST + (lane & 15);
#pragma unroll
            for (int j = 0; j < 4; ++j) { pw[j * L1_PST] = ra0[j]; pw[j * L1_PST + 16] = ra1[j]; }
        }
        __syncthreads();
        {
            const int half = lane >> 5, e = lane & 31;
            const LAS float* pp = part + (2 * wv + half) * L1_PST + e;
            float sc_ = 0.f;
#pragma unroll
            for (int k = 0; k < 8; ++k) sc_ += pp[k * 16 * L1_PST];
            const float sg = sigmoidf_(sc_), vb = sg + rbias[e];
            float bv[4], sv[4];
            bv[0] = dppmov<0x00>(vb); bv[1] = dppmov<0x55>(vb); bv[2] = dppmov<0xAA>(vb); bv[3] = dppmov<0xFF>(vb);
            sv[0] = dppmov<0x00>(sg); sv[1] = dppmov<0x55>(sg); sv[2] = dppmov<0xAA>(sg); sv[3] = dppmov<0xFF>(sg);
            float m1 = -1e30f, m2 = -1e30f;
#pragma unroll
            for (int k = 0; k < 4; ++k) { const float vsc = bv[k]; if (vsc > m1) { m2 = m1; m1 = vsc; } else if (vsc > m2) m2 = vsc; }
            float best = m1 + m2; int bg = e >> 2;
#pragma unroll
            for (int msk = 4; msk <= 16; msk <<= 1) {
                const float ob = __shfl_xor(best, msk); const int og = __shfl_xor(bg, msk);
                const bool take = (ob > best) || (ob == best && og < bg);
                best = take ? ob : best; bg = take ? og : bg;
            }
            int i1 = 0; float b1 = bv[0];
#pragma unroll
            for (int k = 1; k < 4; ++k) if (bv[k] > b1) { b1 = bv[k]; i1 = k; }
            int i2 = -1; float b2 = -1e30f;
#pragma unroll
            for (int k = 0; k < 4; ++k) if (k != i1 && bv[k] > b2) { b2 = bv[k]; i2 = k; }
            float s1 = sv[0], s2s = sv[0];
#pragma unroll
            for (int k = 1; k < 4; ++k) { if (i1 == k) s1 = sv[k]; if (i2 == k) s2s = sv[k]; }
            if (e == 4 * bg && !dry) {
                const int r = rb + half;
                const int e0 = bg * 4 + i1, e1 = bg * 4 + i2;
                const float inv = 1.f / (s1 + s2s);
                const int li = it * 16 + 2 * wv + half;
                const int p0 = __hip_atomic_fetch_add(&lcnt[e0], 1, __ATOMIC_RELAXED, __HIP_MEMORY_SCOPE_WORKGROUP);
                const int p1 = __hip_atomic_fetch_add(&lcnt[e1], 1, __ATOMIC_RELAXED, __HIP_MEMORY_SCOPE_WORKGROUP);
                asg[2 * li] = (e0 << 16) | p0; asg[2 * li + 1] = (e1 << 16) | p1;
                wts[2 * r] = s1 * inv; wts[2 * r + 1] = s2s * inv;
            }
        }
    }
    __syncthreads();
    if (dry) return;
    if (tid < 32) lbase[tid] = atomicAdd(&cnt[tid * CNT_STRIDE], lcnt[tid]);
    __syncthreads();
    for (int idx = tid; idx < 2 * 144; idx += NT) {
        const int li = idx >> 1, k = idx & 1, t = (li >> 4) * G + blockIdx.x;
        if (t < ntiles) { const int r = r0 + t * 16 + (li & 15); const int v = asg[idx], e = v >> 16, lp = v & 0xffff; list[(size_t)e * LISTCAP + lbase[e] + lp] = 2 * r + k; }
    }
}

__device__ __forceinline__ void phase_ln2(int wv, KP Pk, int layer, bool dry = false) {
    asm volatile("" : "+s"(Pk));
    const CAS Params& P = *Pk;
    const int tid = ltid(wv), lane = tid & 63, wid = tid >> 6;
    const bf16_t* yp = (const bf16_t*)(P.ws + WS_YP);
    const float* wts = (const float*)(P.ws + WS_WTS);
    bf16_t* act = (bf16_t*)(P.ws + (dry ? WS_FEAT : WS_ACT));
    bf16_t* xcb = (bf16_t*)(P.ws + WS_XC); bf16_t* xob = (bf16_t*)P.out;
    const float* lg = P.ln_g + (size_t)(layer * 2 + 1) * D; const float* lb = P.ln_b + (size_t)(layer * 2 + 1) * D;
    const bool last = (layer == DEPTH - 1);
    const int r0 = last ? NCTX : 0, stride = gridDim.x * 8;
    f32x4 cg[4], cb[4], g2v[4], s1v[4], h1v[4];
#pragma unroll
    for (int i = 0; i < 4; ++i) { cg[i] = *(const f32x4*)(lg + 4 * lane + 256 * i); cb[i] = *(const f32x4*)(lb + 4 * lane + 256 * i); g2v[i] = s1v[i] = h1v[i] = (f32x4){0.f, 0.f, 0.f, 0.f}; }
    int mcur = -1;
    u32x2 nx[4]; u32x2 ny0[4], ny1[4]; float nw0 = 0.f, nw1 = 0.f;
    auto fetch = [&](int r) {
        const bf16_t* xr = last ? (const bf16_t*)(P.ws + WS_FEAT) + (size_t)r * D : r < NCTX ? xcb + (size_t)r * D : xob + (size_t)(r - NCTX) * D;
#pragma unroll
        for (int i = 0; i < 4; ++i) {
            const int c = 4 * lane + 256 * i;
            nx[i] = *(const u32x2*)(xr + c); ny0[i] = *(const u32x2*)(yp + (size_t)(2 * r) * D + c); ny1[i] = *(const u32x2*)(yp + (size_t)(2 * r + 1) * D + c);
        }
        nw0 = wts[2 * r]; nw1 = wts[2 * r + 1];
    };
    int r = r0 + blockIdx.x * 8 + wid;
    if (r < NROWS) fetch(r);
    for (; r < NROWS; r += stride) {
        const int m = row_mod(r);
        if (m != mcur) {
            mcur = m;
            const float* g2 = modvec(P.ws, layer, m, 5); const float* sh1 = last ? lg : modvec(P.ws, layer + 1, m, 0); const float* sc1 = last ? lg : modvec(P.ws, layer + 1, m, 1);
#pragma unroll
            for (int i = 0; i < 4; ++i) { const int c = 4 * lane + 256 * i; g2v[i] = *(const f32x4*)(g2 + c); s1v[i] = *(const f32x4*)(sc1 + c); h1v[i] = *(const f32x4*)(sh1 + c); }
        }
        f32x4 v[4]; float s = 0.f;
        const float w0 = nw0, w1 = nw1;
#pragma unroll
        for (int i = 0; i < 4; ++i) {
            const f32x4 xv = (f32x4){bflo(nx[i].x), bfhi(nx[i].x), bflo(nx[i].y), bfhi(nx[i].y)}, gv = g2v[i]; const u32x2 y0 = ny0[i], y1 = ny1[i];
            v[i][0] = ALPHA * xv[0] + gv[0] * (w0 * bflo(y0.x) + w1 * bflo(y1.x)); v[i][1] = ALPHA * xv[1] + gv[1] * (w0 * bfhi(y0.x) + w1 * bfhi(y1.x));
            v[i][2] = ALPHA * xv[2] + gv[2] * (w0 * bflo(y0.y) + w1 * bflo(y1.y)); v[i][3] = ALPHA * xv[3] + gv[3] * (w0 * bfhi(y0.y) + w1 * bfhi(y1.y));
            s += (v[i][0] + v[i][1]) + (v[i][2] + v[i][3]);
        }
        if (r + stride < NROWS) fetch(r + stride);
        const float mean = wave_sum(s) * (1.f / D);
        float s2 = 0.f;
#pragma unroll
        for (int i = 0; i < 4; ++i) { v[i] = v[i] - mean; s2 += (v[i][0] * v[i][0] + v[i][1] * v[i][1]) + (v[i][2] * v[i][2] + v[i][3] * v[i][3]); }
        const float rstd = rsqrtf(wave_sum(s2) * (1.f / D) + 1e-5f);
#pragma unroll
        for (int i = 0; i < 4; ++i) {
            const int c = 4 * lane + 256 * i;
            f32x4 xn;
#pragma unroll
            for (int j = 0; j < 4; ++j) xn[j] = v[i][j] * rstd * cg[i][j] + cb[i][j];
            if (dry) *(f32x4*)((float*)(P.ws + WS_YF) + (size_t)r * D + c) = xn;
            else if (last) *(f32x4*)(P.out + (size_t)(r - NCTX) * D + c) = xn;
            else { u32x2 ox; ox.x = pk2(xn[0], xn[1]); ox.y = pk2(xn[2], xn[3]); *(u32x2*)((r < NCTX ? xcb + (size_t)r * D : xob + (size_t)(r - NCTX) * D) + c) = ox; }
            if (!last) {
                u32x2 o; o.x = pk2(xn[0] * (1.f + s1v[i][0]) + h1v[i][0], xn[1] * (1.f + s1v[i][1]) + h1v[i][1]); o.y = pk2(xn[2] * (1.f + s1v[i][2]) + h1v[i][2], xn[3] * (1.f + s1v[i][3]) + h1v[i][3]);
                *(u32x2*)(act + (size_t)r * D + c) = o;
            }
        }
    }
}

constexpr int NPHASE = 2 + 11 * DEPTH;
__global__ void __launch_bounds__(NT, 2) fwd_kernel(Params P) {
    extern __shared__ __attribute__((aligned(16))) char lds_raw[];
    LAS char* lds = (LAS char*)lds_raw;
    volatile LAS unsigned* xbw = (volatile LAS unsigned*)(lds + LDS_BYTES - 16);
    KP Pk = (KP)__builtin_amdgcn_kernarg_segment_ptr();
    const int wv = __builtin_amdgcn_readfirstlane((int)(threadIdx.x >> 6));
    const bool multi = (P.ph_hi - P.ph_lo) > 1;
    XcdBarrier bar; bar.bar = (unsigned*)(P.ws + WS_BAR); bar.x = 0; bar.st = xbw;
    if (multi) {
        if (ltid(wv) == 0) { xbw[0] = 0u; xbw[1] = 0u; xbw[2] = 0u; xbw[3] = 0u; }
        __syncthreads();
        bar = xcd_barrier_post(wv, (unsigned*)(P.ws + WS_BAR), xbw);
    }
#define PHASE(id, body) do { if (P.ph_lo <= (id) && (id) < P.ph_hi) { body; if ((id) + 1 < P.ph_hi) xcd_barrier(wv, bar); if (MK_DOUBLE & 2048) xcd_barrier(wv, bar); } } while (0)
    PHASE(0, REP(16, phase_prologue0(wv, Pk, lds)));
    PHASE(1, REP(16, phase_prologue1(wv, Pk)));
    for (int l = 0; l < DEPTH; ++l) {
        const int pb = 2 + 11 * l, odd = l & 1;
        PHASE(pb + 0, REP(1, phase_inproj(wv, Pk, l, lds)));
        if (odd) {
            PHASE(pb + 1, REP(4, phase_prep1(wv, Pk, l)));
            PHASE(pb + 2, phase_prep2(wv, Pk, l, lds));
            PHASE(pb + 3, REP(32, { if (blockIdx.x < 128) REP(64, scan_hgrn_c(wv, Pk, l, blockIdx.x, lds)); else if (blockIdx.x < 256) REP(128, scan_rwkv(wv, Pk, l, blockIdx.x - 128, lds)); }));
            PHASE(pb + 5, REP(4, phase_out_odd(wv, Pk, l)));
        } else {
            PHASE(pb + 1, REP(4, phase_prep_even(wv, Pk, l)));
            PHASE(pb + 2, REP(2, phase_ex1(wv, Pk, l, lds)));
            PHASE(pb + 3, phase_ex2(wv, Pk, l));
            PHASE(pb + 4, REP(2, phase_ex3(wv, Pk, l, lds)));
            PHASE(pb + 5, REP(4, phase_out_even(wv, Pk, l)));
        }
        PHASE(pb + 6, REP(256, phase_outproj(wv, Pk, l, lds)));
        PHASE(pb + 7, { if (MK_DOUBLE & 4096) phase_ln1(wv, Pk, l, lds, true); phase_ln1(wv, Pk, l, lds); });
        PHASE(pb + 8, REP(512, phase_moe1(wv, Pk, l, lds)));
        PHASE(pb + 9, REP(1024, phase_moe2(wv, Pk, l, lds)));
        PHASE(pb + 10, { if (MK_DOUBLE & 8192) phase_ln2(wv, Pk, l, true); phase_ln2(wv, Pk, l); });
    }
#undef PHASE
}


#ifndef MK_STOP
#define MK_STOP NPHASE
#endif
#ifndef MK_DUMP
#define MK_DUMP 0
#endif
#ifndef MK_DUMP_N
#define MK_DUMP_N (1u << 30)
#endif
#ifndef MK_DUMP_LD
#define MK_DUMP_LD 1024
#endif
#ifndef MK_DUMP_C0
#define MK_DUMP_C0 0
#endif
__global__ void diff_kernel(const bf16_t* a, const bf16_t* b, float* out, size_t n) {
    for (size_t i = (size_t)blockIdx.x * blockDim.x + threadIdx.x; i < n; i += (size_t)gridDim.x * blockDim.x) out[i] = 1e6f * (bf2f(a[i]) - bf2f(b[i]));
}
__global__ void dump_kernel(const bf16_t* src, float* out, size_t n) {
    for (size_t i = (size_t)blockIdx.x * blockDim.x + threadIdx.x; i < n; i += (size_t)gridDim.x * blockDim.x) out[i] = i < (size_t)MK_DUMP_N ? bf2f(src[(i >> 10) * MK_DUMP_LD + MK_DUMP_C0 + (i & 1023)]) : 0.f;
}
extern "C" void kernel_launch(void* const* d_in, const int* in_sizes, int n_in, void* d_out, int out_size, void* d_ws, size_t ws_size, hipStream_t stream) {
    static int ready = 0;
    if (ready == 0) {
        ready = 1;
        if (n_in != 42 || out_size != NB * SEQ * D || ws_size < WS_END) { fprintf(stderr, "kernel_launch: unexpected shapes (n_in %d out %d ws %zu need %zu)\n", n_in, out_size, ws_size, (size_t)WS_END); ready = -1; }
        if (hipFuncSetAttribute((const void*)fwd_kernel, hipFuncAttributeMaxDynamicSharedMemorySize, LDS_BYTES) != hipSuccess) { fprintf(stderr, "kernel_launch: hipFuncSetAttribute failed\n"); ready = -1; }
    }
    if (ready < 0) return;
    (void)in_sizes;
    hipMemsetAsync((char*)d_ws + WS_BAR, 0, WS_ZERO_BYTES, stream);
    Params p;
    memset(&p, 0, sizeof(p));
    const float** fp = (const float**)&p;
    for (int i = 0; i < 42; ++i) fp[i] = (const float*)d_in[i];
    p.out = (float*)d_out; p.ws = (unsigned char*)d_ws;
#if MK_PER_PHASE
    for (int ph = 0; ph < MK_STOP; ++ph) {
        const int local = ph < 2 ? -1 : (ph - 2) % 11, layer = ph < 2 ? 0 : (ph - 2) / 11;
        if (local == 4 && (layer & 1)) continue;
        p.ph_lo = ph; p.ph_hi = ph + 1;
        hipLaunchKernelGGL(fwd_kernel, dim3(256), dim3(NT), LDS_BYTES, stream, p);
    }
#ifdef MK_DIFF
    p.ph_lo = 7; p.ph_hi = 8; p.dbg = 1;
    hipLaunchKernelGGL(fwd_kernel, dim3(256), dim3(NT), LDS_BYTES, stream, p);
    hipLaunchKernelGGL(diff_kernel, dim3(1024), dim3(256), 0, stream, (const bf16_t*)((unsigned char*)d_ws + WS_YO), (const bf16_t*)((unsigned char*)d_ws + WS_HID), (float*)d_out, (size_t)NB * SEQ * D);
#else
    if (MK_DUMP) hipLaunchKernelGGL(dump_kernel, dim3(1024), dim3(256), 0, stream, (const bf16_t*)((unsigned char*)d_ws + (size_t)MK_DUMP), (float*)d_out, (size_t)NB * SEQ * D);
#endif
#else
    p.ph_lo = 0; p.ph_hi = NPHASE;
    hipLaunchKernelGGL(fwd_kernel, dim3(256), dim3(NT), LDS_BYTES, stream, p);
#endif
}
```

```cpp
#include <hip/hip_runtime.h>
#include <stdint.h>
#include <stdio.h>
#include <string.h>

#ifndef MK_PER_PHASE
#define MK_PER_PHASE 0
#endif

typedef unsigned short bf16_t;
typedef short bf16x8 __attribute__((ext_vector_type(8)));
typedef float f32x4 __attribute__((ext_vector_type(4)));
typedef unsigned u32x4 __attribute__((ext_vector_type(4)));
typedef unsigned u32x2 __attribute__((ext_vector_type(2)));
#define LAS __attribute__((address_space(3)))
#define CAS __attribute__((address_space(4)))

constexpr int D = 1024, NB = 4, SEQ = 8192, CTXL = 256, DEPTH = 4;
constexpr int NCTX = NB * CTXL;
constexpr int NROWS = NCTX + NB * SEQ;
constexpr int P_EVEN = 2848, P_ODD = 4416, LDP_EVEN = 3072, LDP_ODD = 4608;
constexpr int NEXP = 32, DEXP = 512, LISTCAP = NROWS;
constexpr float ALPHA = 1.681792830507429f;
constexpr int NT = 512;
constexpr int TCH = 32;
constexpr int NSTEPS = CTXL + SEQ;
constexpr int LDS_BYTES = 160 * 1024;

constexpr size_t al256(size_t x) { return (x + 255) & ~(size_t)255; }
constexpr size_t WS_BAR = 0;
constexpr size_t WS_CNT = 16384;
constexpr int CNT_STRIDE = 64;
constexpr size_t WS_ZERO_BYTES = 16384 + (size_t)4 * 32 * CNT_STRIDE * 4;
constexpr size_t WS_MODV = al256(WS_ZERO_BYTES);
constexpr size_t WS_LB = WS_MODV + al256((size_t)4 * 5 * 6144 * 4);
constexpr size_t WS_XC = WS_LB + al256(4 * 512 * 4);
constexpr size_t WS_WTS = WS_XC + (size_t)NCTX * D * 4;
constexpr size_t WS_LIST = WS_WTS + al256((size_t)2 * NROWS * 4);
constexpr size_t WS_WINT = WS_LIST + al256((size_t)NEXP * LISTCAP * 4);
constexpr size_t WINT_L0 = 0, WINT_L1 = (size_t)LDP_EVEN * D, WINT_L2 = WINT_L1 + (size_t)LDP_ODD * D, WINT_L3 = WINT_L2 + (size_t)LDP_EVEN * D, WINT_END = WINT_L3 + (size_t)LDP_ODD * D;
constexpr size_t WS_WOUTT = WS_WINT + WINT_END * 2;
constexpr size_t WS_LORAT = WS_WOUTT + (size_t)4 * D * D * 2;
constexpr size_t LORA_PER = (size_t)512 * 320;
constexpr size_t WS_EXPGU = WS_LORAT + al256(2 * LORA_PER * 2);
constexpr size_t WS_EXPD = WS_EXPGU + (size_t)NEXP * 1024 * 1024 * 2;
constexpr size_t WS_ACT = WS_EXPD + (size_t)NEXP * 1024 * 512 * 2;
constexpr size_t ROWB = (size_t)NROWS * D * 2;
constexpr size_t WS_FEAT = WS_ACT + ROWB;
constexpr size_t WS_YF = WS_FEAT + ROWB;
constexpr size_t WS_YB = WS_YF + ROWB;
constexpr size_t WS_P = WS_YB + ROWB;
constexpr size_t P_BYTES = (size_t)NROWS * LDP_ODD * 2;
constexpr size_t WS_YO = WS_P;
constexpr size_t WS_HID = WS_P + ROWB;
constexpr size_t WS_YP = WS_HID + ROWB;
static_assert(WS_YP + 2 * ROWB <= WS_P + P_BYTES, "MoE buffers must fit in the P region");
constexpr size_t HALFB = (size_t)NROWS * 512 * 2;
constexpr size_t WS_RWR = WS_P + P_BYTES;
constexpr size_t WS_RWK = WS_RWR + HALFB;
constexpr size_t WS_RWV = WS_RWK + HALFB;
constexpr size_t WS_RWKK = WS_RWV + HALFB;
constexpr size_t WS_RWB = WS_RWKK + HALFB;
constexpr size_t WS_RWG = WS_RWB + HALFB;
constexpr size_t WS_RWDEC = WS_RWG + HALFB;
constexpr size_t WS_LA = WS_RWDEC + (size_t)2 * NROWS * 512 * 4;
constexpr size_t WS_END = WS_LA + (size_t)NROWS * 320 * 2;
static_assert(WS_END <= (size_t)280602384 * 4, "workspace map exceeds the guaranteed ws_size");

struct Params {
    const float *x, *c, *ctx, *c_ctx, *mod_w, *mod_b, *ln_g, *ln_b;
    const float *ev_w_in, *ev_w_out, *ssd_conv_w, *ssd_conv_b, *ssd_dt_bias, *ssd_a_log, *ssd_d, *ssd_norm_w;
    const float *ml_conv_w, *ml_conv_b, *ml_i_bias, *ml_f_bias, *ml_norm_w;
    const float *od_w_in, *od_w_out, *hg_lb_logits, *hg_f_bias, *hg_norm_w;
    const float *rw_mu, *rw_w0, *rw_w2, *rw_a0, *rw_a2, *rw_g2, *rw_k_k, *rw_k_a, *rw_r_k, *rw_ln_w, *rw_ln_b;
    const float *router_w, *router_bias, *exp_w_gate, *exp_w_up, *exp_w_down;
    float* out;
    unsigned char* ws;
    int ph_lo, ph_hi, dbg, pad_;
};
typedef const CAS Params* KP;

__device__ __forceinline__ int ltid(int wv) { int l; asm volatile("v_mbcnt_lo_u32_b32 %0, -1, 0\n\tv_mbcnt_hi_u32_b32 %0, -1, %0" : "=v"(l)); return wv * 64 + l; }
__device__ __forceinline__ float bf2f(bf16_t h) { return __uint_as_float(((unsigned)h) << 16); }
__device__ __forceinline__ float bflo(unsigned u) { return __uint_as_float(u << 16); }
__device__ __forceinline__ float bfhi(unsigned u) { return __uint_as_float(u & 0xffff0000u); }
typedef __bf16 bf16v2_t __attribute__((ext_vector_type(2)));
typedef float f32x2 __attribute__((ext_vector_type(2)));
__device__ __forceinline__ unsigned pk2(float lo, float hi) { const f32x2 v = {lo, hi}; return __builtin_bit_cast(unsigned, __builtin_convertvector(v, bf16v2_t)); }
__device__ __forceinline__ bf16_t f2bf(float f) { return (bf16_t)(pk2(f, 0.f) & 0xffffu); }
__device__ __forceinline__ void unpack8(const u32x4& u, float* f) {
    f[0] = bflo(u.x); f[1] = bfhi(u.x); f[2] = bflo(u.y); f[3] = bfhi(u.y); f[4] = bflo(u.z); f[5] = bfhi(u.z); f[6] = bflo(u.w); f[7] = bfhi(u.w);
}
__device__ __forceinline__ u32x4 pack8(const float* f) { u32x4 u; u.x = pk2(f[0], f[1]); u.y = pk2(f[2], f[3]); u.z = pk2(f[4], f[5]); u.w = pk2(f[6], f[7]); return u; }
__device__ __forceinline__ float sigmoidf_(float x) { return __builtin_amdgcn_rcpf(1.f + __expf(-x)); }
__device__ __forceinline__ float siluf_(float x) { return x * __builtin_amdgcn_rcpf(1.f + __expf(-x)); }
__device__ __forceinline__ float softplus_fast(float x) { return x > 20.f ? x : __logf(1.f + __expf(x)); }
__device__ __forceinline__ float tanh_fast(float x) { return 1.f - 2.f * __builtin_amdgcn_rcpf(1.f + __expf(2.f * x)); }
__device__ __forceinline__ float softplusf_(float x) { return x > 20.f ? x : __logf(1.f + __expf(x)); }
__device__ __forceinline__ float logsigmoidf_(float x) { return fminf(x, 0.f) - __logf(1.f + __expf(-fabsf(x))); }
template <int CTRL> __device__ __forceinline__ float dppmov(float v) {
    return __builtin_bit_cast(float, __builtin_amdgcn_update_dpp(0, __builtin_bit_cast(int, v), CTRL, 0xf, 0xf, true));
}
__device__ __forceinline__ float allreduce16(float v) {
    v += dppmov<0xB1>(v);
    v += dppmov<0x4E>(v);
    v += dppmov<0x141>(v);
    v += dppmov<0x140>(v);
    return v;
}
__device__ __forceinline__ float allreduce8_(float v) { v += dppmov<0xB1>(v); v += dppmov<0x4E>(v); v += dppmov<0x141>(v); return v; }
__device__ __forceinline__ float wave_sum(float v) {
    v = allreduce16(v);
    const float r0 = __builtin_bit_cast(float, __builtin_amdgcn_readlane(__builtin_bit_cast(int, v), 0)), r1 = __builtin_bit_cast(float, __builtin_amdgcn_readlane(__builtin_bit_cast(int, v), 16));
    const float r2 = __builtin_bit_cast(float, __builtin_amdgcn_readlane(__builtin_bit_cast(int, v), 32)), r3 = __builtin_bit_cast(float, __builtin_amdgcn_readlane(__builtin_bit_cast(int, v), 48));
    return (r0 + r1) + (r2 + r3);
}
template <int W> __device__ __forceinline__ float group_sum(float v) {
    if (W == 8) return allreduce8_(v);
    return allreduce16(v);
}

#define XB_TMO      128
#define XB_XCNT(j)  (256  + 64 * (j))
#define XB_XSUB(j)  (1280 + 64 * (j))
#define XB_XGEN(j)  (2304 + 64 * (j))
#define XB_TOP      3328
#define XB_TOPGEN   3392
#define XCD_BAR_WORDS 3456
#define XB_SPIN_CAP (1u << 22)
__device__ __forceinline__ unsigned xb_ld(unsigned* p)              { return __hip_atomic_load(p, __ATOMIC_RELAXED, __HIP_MEMORY_SCOPE_AGENT); }
__device__ __forceinline__ unsigned xb_add(unsigned* p, unsigned v) { return __hip_atomic_fetch_add(p, v, __ATOMIC_RELAXED, __HIP_MEMORY_SCOPE_AGENT); }
__device__ __forceinline__ unsigned xb_xcc_id() { return (unsigned)__builtin_amdgcn_s_getreg((3 << 11) | 20) & 0xFu; }
#define XB_SPIN(cond, bar) do { unsigned _sp = 0; while (cond) { __builtin_amdgcn_s_sleep(1); \
    if ((++_sp & 255u) == 0u) { if (xb_ld(&(bar)[XB_TMO])) break; if (_sp > XB_SPIN_CAP) { atomicAdd(&(bar)[XB_TMO], 1u); break; } } } } while (0)
struct XcdBarrier { unsigned* bar; unsigned x; volatile LAS unsigned* st; };
__device__ __forceinline__ XcdBarrier xcd_barrier_post(int wv, unsigned* bar, volatile LAS unsigned* st) {
    XcdBarrier b; b.bar = bar; b.x = xb_xcc_id(); b.st = st;
    if (ltid(wv) == 0) (void)xb_add(&bar[XB_XCNT(b.x)], 1u);
    return b;
}
__device__ __forceinline__ void xcd_barrier_complete(unsigned* bar, unsigned x, unsigned& nloc, unsigned& nx) {
    const unsigned G = gridDim.x * gridDim.y * gridDim.z;
    unsigned sum, cnt, mine, sp = 0u;
    for (;;) {
        sum = 0u; cnt = 0u; mine = 0u;
#pragma unroll
        for (unsigned j = 0; j < 16; ++j) { const unsigned c = xb_ld(&bar[XB_XCNT(j)]); sum += c; cnt += (c > 0u) ? 1u : 0u; mine = (j == x) ? c : mine; }
        if (sum == G) break;
        __builtin_amdgcn_s_sleep(1);
        if ((++sp & 255u) == 0u) { if (xb_ld(&bar[XB_TMO])) break; if (sp > XB_SPIN_CAP) { atomicAdd(&bar[XB_TMO], 1u); break; } }
    }
    nloc = mine > 0u ? mine : 1u; nx = cnt > 0u ? cnt : 1u;
}
__device__ __forceinline__ void xcd_barrier(int wv, const XcdBarrier& b) {
    asm volatile("s_waitcnt vmcnt(0)" ::: "memory");
    __syncthreads();
    if (ltid(wv) == 0) {
        unsigned* bar = b.bar;
        asm volatile("" : "+s"(bar));
        __builtin_amdgcn_s_waitcnt(0);
        unsigned nloc = b.st[0], nx = b.st[1];
        if (nloc == 0u) { xcd_barrier_complete(bar, b.x, nloc, nx); b.st[0] = nloc; b.st[1] = nx; }
        const unsigned old = xb_add(&bar[XB_XSUB(b.x)], 1u);
        const unsigned gen = old / nloc;
        if (old + 1u == (gen + 1u) * nloc) {
            __builtin_amdgcn_fence(__ATOMIC_RELEASE, "agent");
            asm volatile("s_waitcnt vmcnt(0)" ::: "memory");
            const unsigned og = xb_add(&bar[XB_TOP], 1u);
            const unsigned tg = og / nx;
            if (og + 1u == (tg + 1u) * nx) xb_add(&bar[XB_TOPGEN], 1u);
            else XB_SPIN(xb_ld(&bar[XB_TOPGEN]) == tg, bar);
            __builtin_amdgcn_fence(__ATOMIC_ACQUIRE, "agent");
            xb_add(&bar[XB_XGEN(b.x)], 1u);
            asm volatile("s_waitcnt vmcnt(0)" ::: "memory");
        } else {
            XB_SPIN(xb_ld(&bar[XB_XGEN(b.x)]) == gen, bar);
            __builtin_amdgcn_fence(__ATOMIC_ACQUIRE, "agent");
            asm volatile("s_waitcnt vmcnt(0)" ::: "memory");
        }
    }
    __syncthreads();
}

__device__ __forceinline__ int row_mod(int r) { return r < NCTX ? 4 : ((r - NCTX) >> 13); }
__device__ __forceinline__ void row_seg(int r, int& t, int& len) { if (r < NCTX) { t = r & 255; len = CTXL; } else { t = (r - NCTX) & 8191; len = SEQ; } }
__device__ __forceinline__ int scan_row(int tg, int b, int dir, int odd) {
    if (tg < CTXL) { const int t = dir ? (CTXL - 1 - tg) : tg; return b * CTXL + t; }
    int sg = tg - CTXL; if (dir) sg = SEQ - 1 - sg;
    const int s = odd ? (((sg & 127) << 6) + (sg >> 7)) : sg;
    return NCTX + b * SEQ + s;
}
__device__ __forceinline__ const float* modvec(const unsigned char* ws, int layer, int m, int which) {
    return (const float*)(ws + WS_MODV) + ((size_t)(layer * 5 + m) * 6 + which) * D;
}

constexpr int G_BM = 256, G_BN = 128, G_BK = 64;
constexpr int G_ABYTES = G_BM * G_BK * 2, G_BBYTES = G_BN * G_BK * 2, G_BUF = G_ABYTES + G_BBYTES;
__device__ __forceinline__ int swz(int o) { return o ^ (((o >> 9) & 1) << 5); }

template <class RowSrc, class Epi>
__device__ __forceinline__ void gemm_tile(int wv, const bf16_t* __restrict__ A, int lda, const RowSrc& rs, const bf16_t* __restrict__ Bt, int ldb, int n0, int K, const Epi& epi, LAS char* lds) {
    const int tid = ltid(wv), lane = tid & 63, wid = tid >> 6, wm = wid >> 1, wn = wid & 1;
    const bf16_t* ap[4]; int aoff[4];
#pragma unroll
    for (int i = 0; i < 4; ++i) {
        const int c = tid + NT * i, row = c >> 3, kc = c & 7;
        ap[i] = A + (size_t)rs.src(row) * lda + kc * 8;
        aoff[i] = ((row >> 4) * 2 + (kc >> 2)) * 1024 + swz((row & 15) * 64 + (kc & 3) * 16);
    }
    const bf16_t* bp[2]; int boff[2];
#pragma unroll
    for (int i = 0; i < 2; ++i) {
        const int c = tid + NT * i, row = c >> 3, kc = c & 7;
        bp[i] = Bt + (size_t)(n0 + row) * ldb + kc * 8;
        boff[i] = G_ABYTES + ((row >> 4) * 2 + (kc >> 2)) * 1024 + swz((row & 15) * 64 + (kc & 3) * 16);
    }
    f32x4 acc[4][4];
#pragma unroll
    for (int i = 0; i < 4; ++i)
#pragma unroll
        for (int j = 0; j < 4; ++j) acc[i][j] = (f32x4){0.f, 0.f, 0.f, 0.f};
    u32x4 ra[2][4], rb[2][2];
    const int KT = K / G_BK;
    const int fragoff = swz((lane & 15) * 64 + (lane >> 4) * 16);
#define G_LOAD(set, kt_) do { _Pragma("unroll") for (int i = 0; i < 4; ++i) ra[set][i] = *(const u32x4*)(ap[i] + (kt_) * G_BK); \
                              _Pragma("unroll") for (int i = 0; i < 2; ++i) rb[set][i] = *(const u32x4*)(bp[i] + (kt_) * G_BK); } while (0)
#define G_STORE(set, buf) do { _Pragma("unroll") for (int i = 0; i < 4; ++i) *(LAS u32x4*)((buf) + aoff[i]) = ra[set][i]; \
                               _Pragma("unroll") for (int i = 0; i < 2; ++i) *(LAS u32x4*)((buf) + boff[i]) = rb[set][i]; } while (0)
#define G_COMPUTE(cur) do { bf16x8 af[2][4], bfr[2][4]; \
        _Pragma("unroll") for (int ks = 0; ks < 2; ++ks) { \
            _Pragma("unroll") for (int ni = 0; ni < 4; ++ni) bfr[ks][ni] = *(LAS bf16x8*)((cur) + G_ABYTES + ((wn * 4 + ni) * 2 + ks) * 1024 + fragoff); \
            _Pragma("unroll") for (int mi = 0; mi < 4; ++mi) af[ks][mi] = *(LAS bf16x8*)((cur) + ((wm * 4 + mi) * 2 + ks) * 1024 + fragoff); } \
        __builtin_amdgcn_sched_barrier(0); \
        _Pragma("unroll") for (int ks = 0; ks < 2; ++ks) _Pragma("unroll") for (int mi = 0; mi < 4; ++mi) _Pragma("unroll") for (int ni = 0; ni < 4; ++ni) \
            acc[mi][ni] = __builtin_amdgcn_mfma_f32_16x16x32_bf16(bfr[ks][ni], af[ks][mi], acc[mi][ni], 0, 0, 0); \
        __builtin_amdgcn_sched_barrier(0); } while (0)
    G_LOAD(0, 0);
    G_STORE(0, lds);
    if (KT > 1) G_LOAD(0, 1);
    if (KT > 2) G_LOAD(1, 2);
    __syncthreads();
    for (int kt = 0; kt < KT; kt += 2) {
        G_COMPUTE(lds);
        if (kt + 1 < KT) G_STORE(0, lds + G_BUF);
        if (kt + 3 < KT) G_LOAD(0, kt + 3);
        __syncthreads();
        if (kt + 1 < KT) {
            G_COMPUTE(lds + G_BUF);
            if (kt + 2 < KT) G_STORE(1, lds);
            if (kt + 4 < KT) G_LOAD(1, kt + 4);
            __syncthreads();
        }
    }
#undef G_LOAD
#undef G_STORE
#undef G_COMPUTE
    epi(acc, wm * 64 + (lane & 15), wn * 64 + 4 * (lane >> 4));
}

constexpr int G2_BN = 256, G2_BBYTES = G2_BN * G_BK * 2, G2_BUF = G_ABYTES + G2_BBYTES;

struct RowLinear { int m0; __device__ __forceinline__ int src(int r) const { return m0 + r; } };
struct RowList {
    const int* list; int cnt; int shift;
    __device__ __forceinline__ int src(int r) const { const int a = list[r < cnt ? r : 0]; return a >> shift; }
};
struct EpiStoreBf16 {
    bf16_t* C; int ldc; int m0; int n0; int N;
    template <int NI> __device__ __forceinline__ void operator()(const f32x4 (&acc)[4][NI], int rbase, int cbase) const {
#pragma unroll
        for (int mi = 0; mi < 4; ++mi) {
            bf16_t* rowp = C + (size_t)(m0 + rbase + mi * 16) * ldc + n0 + cbase;
#pragma unroll
            for (int ni = 0; ni < NI; ++ni) {
                if (n0 + cbase + ni * 16 < N) { u32x2 v; v.x = pk2(acc[mi][ni][0], acc[mi][ni][1]); v.y = pk2(acc[mi][ni][2], acc[mi][ni][3]); *(u32x2*)(rowp + ni * 16) = v; }
            }
        }
    }
};
struct EpiSwiGLU {
    bf16_t* H; const int* list; int cnt; int n0;
    template <int NI> __device__ __forceinline__ void operator()(const f32x4 (&acc)[4][NI], int rbase, int cbase) const {
#pragma unroll
        for (int mi = 0; mi < 4; ++mi) {
            const int r = rbase + mi * 16;
            if (r < cnt) {
                const int a = list[r];
                const int wnb = cbase & ~63, q4 = cbase & 63;
                bf16_t* rowp = H + (size_t)a * DEXP + ((n0 + wnb) >> 1) + q4;
#pragma unroll
                for (int q = 0; q < NI / 2; ++q) {
                    float o[4];
#pragma unroll
                    for (int j = 0; j < 4; ++j) o[j] = siluf_(acc[mi][2 * q][j]) * acc[mi][2 * q + 1][j];
                    u32x2 v; v.x = pk2(o[0], o[1]); v.y = pk2(o[2], o[3]); *(u32x2*)(rowp + q * 16) = v;
                }
            }
        }
    }
};
struct EpiScatterBf16 {
    bf16_t* C; const int* list; int cnt; int n0;
    template <int NI> __device__ __forceinline__ void operator()(const f32x4 (&acc)[4][NI], int rbase, int cbase) const {
#pragma unroll
        for (int mi = 0; mi < 4; ++mi) {
            const int r = rbase + mi * 16;
            if (r < cnt) {
                bf16_t* rowp = C + (size_t)list[r] * D + n0 + cbase;
#pragma unroll
                for (int ni = 0; ni < NI; ++ni) { u32x2 v; v.x = pk2(acc[mi][ni][0], acc[mi][ni][1]); v.y = pk2(acc[mi][ni][2], acc[mi][ni][3]); *(u32x2*)(rowp + ni * 16) = v; }
            }
        }
    }
};
struct EpiDecay {
    float* Dc; const float* w0; int m0; int n0;
    template <int NI> __device__ __forceinline__ void operator()(const f32x4 (&acc)[4][NI], int rbase, int cbase) const {
#pragma unroll
        for (int ni = 0; ni < NI; ++ni) {
            const int col = n0 + cbase + ni * 16;
            const f32x4 w0v = *(const f32x4*)(w0 + col);
#pragma unroll
            for (int mi = 0; mi < 4; ++mi) {
                f32x4 o;
#pragma unroll
                for (int j = 0; j < 4; ++j) { const float w = w0v[j] + acc[mi][ni][j]; o[j] = __expf(-__expf(-softplus_fast(-w) - 0.5f)); }
                *(f32x4*)(Dc + (size_t)(m0 + rbase + mi * 16) * 512 + col) = o;
            }
        }
    }
};
struct EpiAK {
    bf16_t* Kb; const bf16_t* KKb; bf16_t* Bb; const float* a0; const float* k_a; int m0; int n0;
    template <int NI> __device__ __forceinline__ void operator()(const f32x4 (&acc)[4][NI], int rbase, int cbase) const {
#pragma unroll
        for (int ni = 0; ni < NI; ++ni) {
            const int col = n0 + cbase + ni * 16;
            const f32x4 a0v = *(const f32x4*)(a0 + col), kav = *(const f32x4*)(k_a + col);
#pragma unroll
            for (int mi = 0; mi < 4; ++mi) {
                const size_t off = (size_t)(m0 + rbase + mi * 16) * 512 + col;
                const u32x2 kr = *(const u32x2*)(Kb + off), kkr = *(const u32x2*)(KKb + off);
                const float kf[4] = {bflo(kr.x), bfhi(kr.x), bflo(kr.y), bfhi(kr.y)}, kkf[4] = {bflo(kkr.x), bfhi(kkr.x), bflo(kkr.y), bfhi(kkr.y)};
                float k2[4], bb[4];
#pragma unroll
                for (int j = 0; j < 4; ++j) { const float a = sigmoidf_(a0v[j] + acc[mi][ni][j]); k2[j] = kf[j] * (1.f + (a - 1.f) * kav[j]); bb[j] = kkf[j] * a; }
                u32x2 v; v.x = pk2(k2[0], k2[1]); v.y = pk2(k2[2], k2[3]); *(u32x2*)(Kb + off) = v;
                v.x = pk2(bb[0], bb[1]); v.y = pk2(bb[2], bb[3]); *(u32x2*)(Bb + off) = v;
            }
        }
    }
};

namespace pg8 {
#define PG8_LAS __attribute__((address_space(3)))
constexpr int BM = 256, BK = 64, HALF = 128, HTB = HALF * BK * 2, STAGE_BYTES = 8 * HTB, NXCD = 8, WGM = 8;
__host__ __device__ __forceinline__ int lds_byte(int r, int c) { const int st = (r >> 4) * 2 + (c >> 5), rr = r & 15, cc = c & 31, ob = rr * 64 + cc * 2; return st * 1024 + (ob ^ (((ob >> 9) & 1) << 5)); }
__host__ __device__ __forceinline__ void stage_rc(int b, int& R, int& C) { const int st = b / 1024, sb = b % 1024, swz = sb ^ (((sb >> 9) & 1) << 5); R = (st >> 1) * 16 + swz / 64; C = (st & 1) * 32 + (swz % 64) / 2; }
__host__ __device__ __forceinline__ int perm32(int rho) { const int n = rho >> 4, i = rho & 15; return 8 * (i >> 2) + 4 * n + (i & 3); }
struct Unit { int pm, pn; };
struct Gemm { const bf16_t* A; const bf16_t* Bt; int M, N, K; };
struct StaticOrder {
    int nM, nN, nwg, G, c;
    __host__ __device__ void init(int M, int N, int G_, int c_) { nM = M / BM; nN = N / BM; nwg = nM * nN; G = G_; c = c_; }
    __host__ __device__ bool next(int i, Unit& u) const {
        const long L = (long)i * G + c; if (L >= nwg) return false;
        int wgid = (int)L; { const int q = nwg / NXCD, r = nwg % NXCD, xcd = wgid % NXCD, off = wgid / NXCD; wgid = (xcd < r ? xcd * (q + 1) : r * (q + 1) + (xcd - r) * q) + off; }
        const int nig = WGM * nN, gid = wgid / nig, fm = gid * WGM, gsz = (nM - fm) < WGM ? (nM - fm) : WGM;
        u.pm = fm + ((wgid % nig) % gsz); u.pn = (wgid % nig) / gsz; return true;
    }
    __device__ __forceinline__ void a_ready(const Unit&) const {}
    __device__ __forceinline__ void done(const Unit&) const {}
};
struct EpiStoreP {
    static constexpr bool PERM = true, AFTER_DRAIN = false;
    bf16_t* O; int ldc;
    __device__ __forceinline__ void operator()(const f32x4 (&acc)[2][2][4][2], const Unit& u, int wr, int wc, int fr, int fq) const {
        const int row0 = u.pm * BM + wr * 64 + fr, col0 = u.pn * BM + wc * 32 + 8 * fq;
#pragma unroll
        for (int ai = 0; ai < 2; ++ai)
#pragma unroll
            for (int m = 0; m < 4; ++m) { bf16_t* rowp = O + (size_t)(row0 + ai * HALF + m * 16) * ldc + col0;
#pragma unroll
                for (int bj = 0; bj < 2; ++bj) { const f32x4 v0 = acc[ai][bj][m][0], v1 = acc[ai][bj][m][1];
                    u32x4 w; w.x = pk2(v0[0], v0[1]); w.y = pk2(v0[2], v0[3]); w.z = pk2(v1[0], v1[1]); w.w = pk2(v1[2], v1[3]);
                    *(u32x4*)(rowp + bj * HALF) = w; } }
    }
};
template <class Epi, class Sched>
__device__ __forceinline__ void gemm_phase(int wv, PG8_LAS unsigned char* lds, const Gemm g, const Sched& S, const Epi& E) {
    const int tid = ltid(wv), wid = __builtin_amdgcn_readfirstlane(tid >> 6), lane = tid & 63, wr = wid >> 2, wc = wid & 3, fr = lane & 15, fq = lane >> 4;
    const int K = g.K, nt = K / BK;
    unsigned voffA[2], voffB[2];
#pragma unroll
    for (int i = 0; i < 2; ++i) { int R, C; stage_rc(tid * 16 + i * 8192, R, C); const int Rb = Epi::PERM ? ((R & ~31) + perm32(R & 31)) : R;
        voffA[i] = (unsigned)(R * K + C) * 2u; voffB[i] = (unsigned)(Rb * K + C) * 2u; }
    const size_t kstep = (size_t)(BK * 2);
    const size_t hstep = (size_t)HALF * K * 2;
    const size_t tstep = 2 * hstep;
    const unsigned ldsw = (unsigned)wid * 1024u;
    const int aoff = lds_byte(wr * 64 + fr, fq * 8), boff = lds_byte(wc * 32 + fr, fq * 8);
#define PG8_SA(b, h) (((b) * 2 + (h)) * HTB)
#define PG8_SB(b, h) ((4 + (b) * 2 + (h)) * HTB)
#define PG8_STAGE(bufoff, gbase, voff) do { _Pragma("unroll") for (int _i = 0; _i < 2; ++_i) \
        __builtin_amdgcn_global_load_lds((const unsigned*)((const char*)(gbase) + (voff)[_i]), (PG8_LAS unsigned*)(lds + (bufoff) + ldsw + _i * 8192), 16, 0, 0); } while (0)
#define PG8_LDA(dst, b, h) do { _Pragma("unroll") for (int m = 0; m < 4; ++m) _Pragma("unroll") for (int k = 0; k < 2; ++k) dst[m][k] = *(const PG8_LAS bf16x8*)(lds + PG8_SA(b, h) + aoff + m * 2048 + k * 1024); } while (0)
#define PG8_LDB(dst, b, h) do { _Pragma("unroll") for (int n = 0; n < 2; ++n) _Pragma("unroll") for (int k = 0; k < 2; ++k) dst[n][k] = *(const PG8_LAS bf16x8*)(lds + PG8_SB(b, h) + boff + n * 2048 + k * 1024); } while (0)
#define PG8_MMA(ai, bj, At, Bt) do { __builtin_amdgcn_s_setprio(1); _Pragma("unroll") for (int m = 0; m < 4; ++m) _Pragma("unroll") for (int n = 0; n < 2; ++n) _Pragma("unroll") for (int k = 0; k < 2; ++k) \
        acc[ai][bj][m][n] = __builtin_amdgcn_mfma_f32_16x16x32_bf16(Bt[n][k], At[m][k], acc[ai][bj][m][n], 0, 0, 0); __builtin_amdgcn_s_setprio(0); } while (0)
#define PG8_WAIT_V(n) asm volatile("s_waitcnt vmcnt(" #n ")" ::: "memory")
#define PG8_WAIT_L(n) asm volatile("s_waitcnt lgkmcnt(" #n ")" ::: "memory")
#define PG8_BAR __builtin_amdgcn_s_barrier()
#define PG8_SCHED __builtin_amdgcn_sched_barrier(0)
    Unit cur, nxt; int ui = 0;
    if (!S.next(0, cur)) return;
    f32x4 acc[2][2][4][2];
#pragma unroll
    for (int a = 0; a < 2; ++a)
#pragma unroll
        for (int b = 0; b < 2; ++b)
#pragma unroll
            for (int m = 0; m < 4; ++m)
#pragma unroll
                for (int n = 0; n < 2; ++n) acc[a][b][m][n] = (f32x4){0.f, 0.f, 0.f, 0.f};
    bf16x8 At[4][2], B0[2][2], B1[2][2];
    const char* cA = (const char*)g.A + (size_t)cur.pm * tstep; const char* cB = (const char*)g.Bt + (size_t)cur.pn * tstep;
    S.a_ready(cur);
    PG8_STAGE(PG8_SB(0, 0), cB, voffB); PG8_STAGE(PG8_SA(0, 0), cA, voffA); PG8_STAGE(PG8_SB(0, 1), cB + hstep, voffB); PG8_STAGE(PG8_SA(0, 1), cA + hstep, voffA);
    if (wr == 1) PG8_BAR;
    PG8_WAIT_V(4); PG8_BAR;
    PG8_STAGE(PG8_SB(1, 0), cB + kstep, voffB); PG8_STAGE(PG8_SA(1, 0), cA + kstep, voffA); PG8_STAGE(PG8_SB(1, 1), cB + hstep + kstep, voffB);
    PG8_WAIT_V(6); PG8_BAR;
    for (;;) {
        const bool has_next = S.next(ui + 1, nxt);
        const char* nA = has_next ? (const char*)g.A + (size_t)nxt.pm * tstep : cA; const char* nB = has_next ? (const char*)g.Bt + (size_t)nxt.pn * tstep : cB;
        for (int t = 0; t < nt; t += 2) {
            const bool last = (t == nt - 2);
            const char* a1 = cA + (size_t)(t + 1) * kstep;
            const char* a2 = last ? nA : cA + (size_t)(t + 2) * kstep; const char* b2 = last ? nB : cB + (size_t)(t + 2) * kstep;
            const char* a3 = a2 + kstep; const char* b3 = b2 + kstep;
            if (last && has_next) S.a_ready(nxt);
            PG8_LDB(B0, 0, 0); PG8_SCHED; PG8_LDA(At, 0, 0); PG8_STAGE(PG8_SA(1, 1), a1 + hstep, voffA);
            PG8_WAIT_L(8); PG8_BAR; PG8_WAIT_L(0); PG8_MMA(0, 0, At, B0); PG8_BAR; PG8_SCHED;
            PG8_LDB(B1, 0, 1); PG8_STAGE(PG8_SB(0, 0), b2, voffB);
            PG8_BAR; PG8_WAIT_L(0); PG8_MMA(0, 1, At, B1); PG8_BAR;
            PG8_LDA(At, 0, 1); PG8_STAGE(PG8_SA(0, 0), a2, voffA);
            PG8_BAR; PG8_WAIT_L(0); PG8_MMA(1, 0, At, B0); PG8_BAR; PG8_SCHED;
            PG8_STAGE(PG8_SB(0, 1), b2 + hstep, voffB);
            PG8_WAIT_V(6); PG8_BAR; PG8_MMA(1, 1, At, B1); PG8_BAR;
            PG8_LDB(B0, 1, 0); PG8_SCHED; PG8_LDA(At, 1, 0); PG8_STAGE(PG8_SA(0, 1), a2 + hstep, voffA);
            PG8_WAIT_L(8); PG8_BAR; PG8_WAIT_L(0); PG8_MMA(0, 0, At, B0); PG8_BAR; PG8_SCHED;
            PG8_LDB(B1, 1, 1); PG8_STAGE(PG8_SB(1, 0), b3, voffB);
            PG8_BAR; PG8_WAIT_L(0); PG8_MMA(0, 1, At, B1); PG8_BAR;
            PG8_LDA(At, 1, 1); PG8_STAGE(PG8_SA(1, 0), a3, voffA);
            PG8_BAR; PG8_WAIT_L(0); PG8_MMA(1, 0, At, B0); PG8_BAR; PG8_SCHED;
            PG8_STAGE(PG8_SB(1, 1), b3 + hstep, voffB);
            PG8_WAIT_V(6); PG8_BAR; PG8_MMA(1, 1, At, B1); PG8_BAR;
        }
            if constexpr (!Epi::AFTER_DRAIN) { E(acc, cur, wr, wc, fr, fq); S.done(cur); }
            if (!has_next) break;
#pragma unroll
        for (int a = 0; a < 2; ++a)
#pragma unroll
            for (int b = 0; b < 2; ++b)
#pragma unroll
                for (int m = 0; m < 4; ++m)
#pragma unroll
                    for (int n = 0; n < 2; ++n) acc[a][b][m][n] = (f32x4){0.f, 0.f, 0.f, 0.f};
        cur = nxt; cA = nA; cB = nB; ++ui;
    }
    PG8_WAIT_V(0);
    if (wr == 0) PG8_BAR;
    PG8_BAR;
    if constexpr (Epi::AFTER_DRAIN) { E.fused(acc, cur, wr, wc, fr, fq, lds, wid, lane); S.done(cur); }
#undef PG8_SA
#undef PG8_SB
#undef PG8_STAGE
#undef PG8_LDA
#undef PG8_LDB
#undef PG8_MMA
#undef PG8_WAIT_V
#undef PG8_WAIT_L
#undef PG8_BAR
#undef PG8_SCHED
}
struct UnitG { int pm, pn; const char* bbase; const PG8_LAS int* ltab; int cnt; int e; };
struct MoeOrder {
    const PG8_LAS int* tstart; const PG8_LAS int* tcnt; const PG8_LAS int* ltabs; const int* lists; const char* bt; size_t estride; int ncol, shift, G, c;
    __device__ __forceinline__ bool next(int i, UnitG& u) const {
        const int t = i * G + c; if (t >= tstart[32] * ncol) return false;
        const int tm = t / ncol; int e = 0;
#pragma unroll 1
        while (tstart[e + 1] <= tm) ++e;
        e = __builtin_amdgcn_readfirstlane(e);
        const int ts = __builtin_amdgcn_readfirstlane(tstart[e]), tc = __builtin_amdgcn_readfirstlane(tcnt[e]);
        u.pm = tm - ts; u.pn = t - tm * ncol; u.bbase = bt + (size_t)e * estride; u.e = e; u.cnt = tc - u.pm * BM; u.ltab = ltabs + i * BM;
        return true;
    }
    __device__ __forceinline__ void a_ready(const UnitG&) const {}
    __device__ __forceinline__ void done(const UnitG&) const {}
};
struct EpiSwiGLUG {
    static constexpr bool PERM = false, AFTER_DRAIN = false;
    bf16_t* H;
    __device__ __forceinline__ void operator()(const f32x4 (&acc)[2][2][4][2], const UnitG& u, int wr, int wc, int fr, int fq) const {
#pragma unroll
        for (int ai = 0; ai < 2; ++ai)
#pragma unroll
            for (int m = 0; m < 4; ++m) { const int r = ai * HALF + wr * 64 + m * 16 + fr;
                if (r < u.cnt) { bf16_t* rowp = H + (size_t)u.ltab[r] * DEXP + ((u.pn * BM + wc * 32) >> 1) + 4 * fq;
#pragma unroll
                    for (int bj = 0; bj < 2; ++bj) { const f32x4 gt = acc[ai][bj][m][0], up = acc[ai][bj][m][1];
                        u32x2 w; w.x = pk2(siluf_(gt[0]) * up[0], siluf_(gt[1]) * up[1]); w.y = pk2(siluf_(gt[2]) * up[2], siluf_(gt[3]) * up[3]);
                        *(u32x2*)(rowp + bj * (HALF / 2)) = w; } } }
    }
};
struct EpiScatterG {
    static constexpr bool PERM = true, AFTER_DRAIN = false;
    bf16_t* O;
    __device__ __forceinline__ void operator()(const f32x4 (&acc)[2][2][4][2], const UnitG& u, int wr, int wc, int fr, int fq) const {
#pragma unroll
        for (int ai = 0; ai < 2; ++ai)
#pragma unroll
            for (int m = 0; m < 4; ++m) { const int r = ai * HALF + wr * 64 + m * 16 + fr;
                if (r < u.cnt) { bf16_t* rowp = O + (size_t)u.ltab[r] * D + u.pn * BM + wc * 32 + 8 * fq;
#pragma unroll
                    for (int bj = 0; bj < 2; ++bj) { const f32x4 v0 = acc[ai][bj][m][0], v1 = acc[ai][bj][m][1];
                        u32x4 w; w.x = pk2(v0[0], v0[1]); w.y = pk2(v0[2], v0[3]); w.z = pk2(v1[0], v1[1]); w.w = pk2(v1[2], v1[3]);
                        *(u32x4*)(rowp + bj * HALF) = w; } } }
    }
};
template <class Epi, class Sched>
__device__ __forceinline__ void gemm_phase_g(int wv, PG8_LAS unsigned char* lds, const Gemm g, const Sched& S, const Epi& E) {
    const int tid = ltid(wv), wid = __builtin_amdgcn_readfirstlane(tid >> 6), lane = tid & 63, wr = wid >> 2, wc = wid & 3, fr = lane & 15, fq = lane >> 4;
    const int K = g.K, nt = K / BK;
    unsigned voffB[2];
#pragma unroll
    for (int i = 0; i < 2; ++i) { int R, C; stage_rc(tid * 16 + i * 8192, R, C); const int Rb = Epi::PERM ? ((R & ~31) + perm32(R & 31)) : R;
        voffB[i] = (unsigned)(Rb * K + C) * 2u; }
    const unsigned rowb = (unsigned)K * 2u;
#define PG8_AOFFS(u, dst) do { const int _t = ltid(wv); _Pragma("unroll") for (int _i = 0; _i < 2; ++_i) { int _R, _C; stage_rc(_t * 16 + _i * 8192, _R, _C); \
        _Pragma("unroll") for (int _h = 0; _h < 2; ++_h) dst[_h][_i] = (unsigned)((u).ltab[_h * HALF + _R] >> S.shift) * rowb + (unsigned)(_C * 2); } } while (0)
#define PG8_STAGE_A(bufoff, AO, koff) do { _Pragma("unroll") for (int _i = 0; _i < 2; ++_i) \
        __builtin_amdgcn_global_load_lds((const unsigned*)((const char*)g.A + (size_t)(AO)[_i] + (size_t)(koff)), (PG8_LAS unsigned*)(lds + (bufoff) + ldsw + _i * 8192), 16, 0, 0); } while (0)
    const size_t kstep = (size_t)(BK * 2);
    const size_t hstep = (size_t)HALF * K * 2;
    const size_t tstep = 2 * hstep;
    const unsigned ldsw = (unsigned)wid * 1024u;
    const int aoff = lds_byte(wr * 64 + fr, fq * 8), boff = lds_byte(wc * 32 + fr, fq * 8);
#define PG8_SA(b, h) (((b) * 2 + (h)) * HTB)
#define PG8_SB(b, h) ((4 + (b) * 2 + (h)) * HTB)
#define PG8_STAGE(bufoff, gbase, voff) do { _Pragma("unroll") for (int _i = 0; _i < 2; ++_i) \
        __builtin_amdgcn_global_load_lds((const unsigned*)((const char*)(gbase) + (voff)[_i]), (PG8_LAS unsigned*)(lds + (bufoff) + ldsw + _i * 8192), 16, 0, 0); } while (0)
#define PG8_LDA(dst, b, h) do { _Pragma("unroll") for (int m = 0; m < 4; ++m) _Pragma("unroll") for (int k = 0; k < 2; ++k) dst[m][k] = *(const PG8_LAS bf16x8*)(lds + PG8_SA(b, h) + aoff + m * 2048 + k * 1024); } while (0)
#define PG8_LDB(dst, b, h) do { _Pragma("unroll") for (int n = 0; n < 2; ++n) _Pragma("unroll") for (int k = 0; k < 2; ++k) dst[n][k] = *(const PG8_LAS bf16x8*)(lds + PG8_SB(b, h) + boff + n * 2048 + k * 1024); } while (0)
#define PG8_MMA(ai, bj, At, Bt) do { __builtin_amdgcn_s_setprio(1); _Pragma("unroll") for (int m = 0; m < 4; ++m) _Pragma("unroll") for (int n = 0; n < 2; ++n) _Pragma("unroll") for (int k = 0; k < 2; ++k) \
        acc[ai][bj][m][n] = __builtin_amdgcn_mfma_f32_16x16x32_bf16(Bt[n][k], At[m][k], acc[ai][bj][m][n], 0, 0, 0); __builtin_amdgcn_s_setprio(0); } while (0)
#define PG8_WAIT_V(n) asm volatile("s_waitcnt vmcnt(" #n ")" ::: "memory")
#define PG8_WAIT_L(n) asm volatile("s_waitcnt lgkmcnt(" #n ")" ::: "memory")
#define PG8_BAR __builtin_amdgcn_s_barrier()
#define PG8_SCHED __builtin_amdgcn_sched_barrier(0)
    UnitG cur, nxt; int ui = 0;
    if (!S.next(0, cur)) return;
    f32x4 acc[2][2][4][2];
#pragma unroll
    for (int a = 0; a < 2; ++a)
#pragma unroll
        for (int b = 0; b < 2; ++b)
#pragma unroll
            for (int m = 0; m < 4; ++m)
#pragma unroll
                for (int n = 0; n < 2; ++n) acc[a][b][m][n] = (f32x4){0.f, 0.f, 0.f, 0.f};
    bf16x8 At[4][2], B0[2][2], B1[2][2];
    unsigned ca[2][2]; PG8_AOFFS(cur, ca); const char* cB = cur.bbase + (size_t)cur.pn * tstep;
    S.a_ready(cur);
    PG8_STAGE(PG8_SB(0, 0), cB, voffB); PG8_STAGE_A(PG8_SA(0, 0), ca[0], 0); PG8_STAGE(PG8_SB(0, 1), cB + hstep, voffB); PG8_STAGE_A(PG8_SA(0, 1), ca[1], 0);
    if (wr == 1) PG8_BAR;
    PG8_WAIT_V(4); PG8_BAR;
    PG8_STAGE(PG8_SB(1, 0), cB + kstep, voffB); PG8_STAGE_A(PG8_SA(1, 0), ca[0], kstep); PG8_STAGE(PG8_SB(1, 1), cB + hstep + kstep, voffB);
    PG8_WAIT_V(6); PG8_BAR;
    for (;;) {
        const bool has_next = S.next(ui + 1, nxt);
        const char* nB = has_next ? nxt.bbase + (size_t)nxt.pn * tstep : cB;
        for (int t = 0; t < nt; t += 2) {
            const bool last = (t == nt - 2);
            const size_t k1 = (size_t)(t + 1) * kstep, k2 = last ? 0 : (size_t)(t + 2) * kstep;
            unsigned a2o[2][2];
            if (last && has_next) PG8_AOFFS(nxt, a2o); else { a2o[0][0] = ca[0][0]; a2o[0][1] = ca[0][1]; a2o[1][0] = ca[1][0]; a2o[1][1] = ca[1][1]; }
            const char* b2 = last ? nB : cB + (size_t)(t + 2) * kstep; const char* b3 = b2 + kstep;
            if (last && has_next) S.a_ready(nxt);
            PG8_LDB(B0, 0, 0); PG8_SCHED; PG8_LDA(At, 0, 0); PG8_STAGE_A(PG8_SA(1, 1), ca[1], k1);
            PG8_WAIT_L(8); PG8_BAR; PG8_WAIT_L(0); PG8_MMA(0, 0, At, B0); PG8_BAR; PG8_SCHED;
            PG8_LDB(B1, 0, 1); PG8_STAGE(PG8_SB(0, 0), b2, voffB);
            PG8_BAR; PG8_WAIT_L(0); PG8_MMA(0, 1, At, B1); PG8_BAR;
            PG8_LDA(At, 0, 1); PG8_STAGE_A(PG8_SA(0, 0), a2o[0], k2);
            PG8_BAR; PG8_WAIT_L(0); PG8_MMA(1, 0, At, B0); PG8_BAR; PG8_SCHED;
            PG8_STAGE(PG8_SB(0, 1), b2 + hstep, voffB);
            PG8_WAIT_V(6); PG8_BAR; PG8_MMA(1, 1, At, B1); PG8_BAR;
            PG8_LDB(B0, 1, 0); PG8_SCHED; PG8_LDA(At, 1, 0); PG8_STAGE_A(PG8_SA(0, 1), a2o[1], k2);
            PG8_WAIT_L(8); PG8_BAR; PG8_WAIT_L(0); PG8_MMA(0, 0, At, B0); PG8_BAR; PG8_SCHED;
            PG8_LDB(B1, 1, 1); PG8_STAGE(PG8_SB(1, 0), b3, voffB);
            PG8_BAR; PG8_WAIT_L(0); PG8_MMA(0, 1, At, B1); PG8_BAR;
            PG8_LDA(At, 1, 1); PG8_STAGE_A(PG8_SA(1, 0), a2o[0], k2 + kstep);
            PG8_BAR; PG8_WAIT_L(0); PG8_MMA(1, 0, At, B0); PG8_BAR; PG8_SCHED;
            PG8_STAGE(PG8_SB(1, 1), b3 + hstep, voffB);
            PG8_WAIT_V(6); PG8_BAR; PG8_MMA(1, 1, At, B1); PG8_BAR;
            if (last) { ca[0][0] = a2o[0][0]; ca[0][1] = a2o[0][1]; ca[1][0] = a2o[1][0]; ca[1][1] = a2o[1][1]; }
        }
            if constexpr (!Epi::AFTER_DRAIN) { E(acc, cur, wr, wc, fr, fq); S.done(cur); }
            if (!has_next) break;
#pragma unroll
        for (int a = 0; a < 2; ++a)
#pragma unroll
            for (int b = 0; b < 2; ++b)
#pragma unroll
                for (int m = 0; m < 4; ++m)
#pragma unroll
                    for (int n = 0; n < 2; ++n) acc[a][b][m][n] = (f32x4){0.f, 0.f, 0.f, 0.f};
        cur = nxt; cB = nB; ++ui;
    }
    PG8_WAIT_V(0);
    if (wr == 0) PG8_BAR;
    PG8_BAR;
    if constexpr (Epi::AFTER_DRAIN) { E.fused(acc, cur, wr, wc, fr, fq, lds, wid, lane); S.done(cur); }
#undef PG8_SA
#undef PG8_AOFFS
#undef PG8_STAGE_A
#undef PG8_SB
#undef PG8_STAGE
#undef PG8_LDA
#undef PG8_LDB
#undef PG8_MMA
#undef PG8_WAIT_V
#undef PG8_WAIT_L
#undef PG8_BAR
#undef PG8_SCHED
}
}

__device__ __forceinline__ void transpose_item(const float* __restrict__ W, int K, int N, bf16_t* __restrict__ WT, int mode, LAS float* scr, int item, int lane) {
    const int nblk = N / 32, kb = item / nblk, nb = item % nblk, k0 = 64 * kb, n0 = 32 * nb;
    {
        const float* wp = W + (size_t)(k0 + (lane >> 5)) * N + n0 + (lane & 31);
        float t[32];
#pragma unroll
        for (int i = 0; i < 32; ++i) t[i] = wp[(size_t)(2 * i) * N];
#pragma unroll
        for (int i = 0; i < 32; ++i) scr[(2 * i + (lane >> 5)) * 33 + (lane & 31)] = t[i];
    }
    asm volatile("s_waitcnt lgkmcnt(0)" ::: "memory");
    const int c = lane & 7;
#pragma unroll
    for (int j = 0; j < 4; ++j) {
        const int nl = (lane >> 3) + 8 * j; const LAS float* s = scr + (8 * c) * 33 + nl;
        u32x4 o; o.x = pk2(s[0 * 33], s[1 * 33]); o.y = pk2(s[2 * 33], s[3 * 33]); o.z = pk2(s[4 * 33], s[5 * 33]); o.w = pk2(s[6 * 33], s[7 * 33]);
        const int n = n0 + nl;
        const int nd = mode == 0 ? n : (32 * (n >> 4) + (n & 15) + (mode == 2 ? 16 : 0));
        *(u32x4*)(WT + (size_t)nd * K + k0 + 8 * c) = o;
    }
    asm volatile("s_waitcnt lgkmcnt(0)" ::: "memory");
}

constexpr int EXC_IG = 16 * 16, EXC_IDN = 8 * 32, EXC_PER = 2 * EXC_IG + EXC_IDN, EXC_ITEMS = NEXP * EXC_PER;
__device__ __forceinline__ int exc_s0(int layer) { return (layer & 1) ? 8192 : 10240; }
__device__ __forceinline__ int exc_s1(int layer) { return layer == DEPTH - 1 ? 0 : 7168; }
__device__ __forceinline__ void expconv_items(const CAS Params& P, int layer, LAS char* lds, int lo, int hi, int worker, int nworkers, int wid, int lane) {
    LAS float* scr = (LAS float*)(lds + wid * 8448);
    bf16_t* gu = (bf16_t*)(P.ws + WS_EXPGU); bf16_t* dw = (bf16_t*)(P.ws + WS_EXPD);
    for (int it = lo + worker; it < hi; it += nworkers) {
        const int e = it / EXC_PER; int r = it % EXC_PER;
        const size_t eo = (size_t)(layer * NEXP + e);
        if (r < EXC_IG) { transpose_item(P.exp_w_gate + eo * D * DEXP, D, DEXP, gu + (size_t)e * 1024 * 1024, 1, scr, r, lane); continue; } r -= EXC_IG;
        if (r < EXC_IG) { transpose_item(P.exp_w_up + eo * D * DEXP, D, DEXP, gu + (size_t)e * 1024 * 1024, 2, scr, r, lane); continue; } r -= EXC_IG;
        transpose_item(P.exp_w_down + eo * DEXP * D, DEXP, D, dw + (size_t)e * 1024 * 512, 0, scr, r, lane);
    }
}
__device__ __forceinline__ void expconv_tail(int wv, const CAS Params& P, int layer, LAS char* lds, int nwg, int lo, int hi) {
    const int G = gridDim.x, rem = nwg % G;
    if (rem != 0 && (int)blockIdx.x >= rem && lo < hi) {
        const int tid = ltid(wv);
        __syncthreads();
        expconv_items(P, layer, lds, lo, hi, ((int)blockIdx.x - rem) * 8 + (tid >> 6), (G - rem) * 8, tid >> 6, tid & 63);
    }
}

__device__ __forceinline__ void phase_prologue0(int wv, KP Pk, LAS char* lds) {
    asm volatile("" : "+s"(Pk));
    const CAS Params& P = *Pk;
    const int tid = ltid(wv), lane = tid & 63, wid = tid >> 6;
    const int gw = blockIdx.x * 8 + wid, NGW = gridDim.x * 8;
    LAS float* scr = (LAS float*)(lds + wid * 8448);
    bf16_t* winT = (bf16_t*)(P.ws + WS_WINT);
    bf16_t* woutT = (bf16_t*)(P.ws + WS_WOUTT);
    bf16_t* loraT = (bf16_t*)(P.ws + WS_LORAT);
    constexpr int I_EV = 16 * (P_EVEN / 32), I_OD = 16 * (P_ODD / 32), I_O = 16 * 32, I_L64 = 16, I_L128 = 32;
    constexpr int I_LORA = 3 * I_L64 + I_L128;
    constexpr int NIT = 2 * I_EV + 2 * I_OD + 4 * I_O + 2 * I_LORA;
    for (int it = gw; it < NIT; it += NGW) {
        int r = it;
        if (r < 2 * I_EV) { const int i = r / I_EV; transpose_item(P.ev_w_in + (size_t)i * D * P_EVEN, D, P_EVEN, winT + (i ? WINT_L2 : WINT_L0), 0, scr, r % I_EV, lane); continue; } r -= 2 * I_EV;
        if (r < 2 * I_OD) { const int i = r / I_OD; transpose_item(P.od_w_in + (size_t)i * D * P_ODD, D, P_ODD, winT + (i ? WINT_L3 : WINT_L1), 0, scr, r % I_OD, lane); continue; } r -= 2 * I_OD;
        if (r < 4 * I_O) { const int l = r / I_O; const float* src = (l & 1) ? P.od_w_out + (size_t)(l >> 1) * D * D : P.ev_w_out + (size_t)(l >> 1) * D * D;
            transpose_item(src, D, D, woutT + (size_t)l * D * D, 0, scr, r % I_O, lane); continue; } r -= 4 * I_O;
        { const int i = r / I_LORA; int q = r % I_LORA; bf16_t* dst = loraT + (size_t)i * LORA_PER;
          if (q < I_L64) { transpose_item(P.rw_w2 + (size_t)(i * 2 + 0) * 64 * 512, 64, 512, dst, 0, scr, q, lane); continue; } q -= I_L64;
          if (q < I_L64) { transpose_item(P.rw_w2 + (size_t)(i * 2 + 1) * 64 * 512, 64, 512, dst + 512 * 64, 0, scr, q, lane); continue; } q -= I_L64;
          if (q < I_L64) { transpose_item(P.rw_a2 + (size_t)i * 64 * 512, 64, 512, dst + 2 * 512 * 64, 0, scr, q, lane); continue; } q -= I_L64;
          transpose_item(P.rw_g2 + (size_t)i * 128 * 512, 128, 512, dst + 3 * 512 * 64, 0, scr, q, lane); }
    }
    {
        const int gt = blockIdx.x * NT + tid, NG = gridDim.x * NT;
        constexpr int PADE = (LDP_EVEN - P_EVEN) * D / 8, PADO = (LDP_ODD - P_ODD) * D / 8;
        for (int i = gt; i < 2 * PADE + 2 * PADO; i += NG) {
            int r = i; bf16_t* dst;
            if (r < 2 * PADE) { const int l = r / PADE; dst = winT + (l ? WINT_L2 : WINT_L0) + (size_t)P_EVEN * D + (size_t)(r % PADE) * 8; }
            else { r -= 2 * PADE; const int l = r / PADO; dst = winT + (l ? WINT_L3 : WINT_L1) + (size_t)P_ODD * D + (size_t)(r % PADO) * 8; }
            *(u32x4*)dst = (u32x4){0u, 0u, 0u, 0u};
        }
    }
    {
        const int gt = blockIdx.x * NT + tid, NG = gridDim.x * NT;
        float* lb = (float*)(P.ws + WS_LB);
        for (int ch = gt; ch < 512; ch += NG) {
            float lg[4], mx = -1e30f;
#pragma unroll
            for (int l = 0; l < 4; ++l) { lg[l] = P.hg_lb_logits[l * 512 + ch]; mx = fmaxf(mx, lg[l]); }
            float e[4], s = 0.f;
#pragma unroll
            for (int l = 0; l < 4; ++l) { e[l] = __expf(lg[l] - mx); s += e[l]; }
            float cum = 0.f;
#pragma unroll
            for (int l = 0; l < 4; ++l) { if (l > 0) cum += e[l] / s; lb[l * 512 + ch] = cum; }
        }
    }
    __syncthreads();
    {
        LAS float* sc = (LAS float*)lds;
        LAS float* red = (LAS float*)(lds + 5 * 1024 * 4);
        for (int i = tid; i < 5 * D; i += NT) { const int m = i >> 10, k = i & 1023; const float v = m < 4 ? P.c[m * D + k] : P.c_ctx[k]; sc[i] = siluf_(v); }
        __syncthreads();
        float* modv = (float*)(P.ws + WS_MODV);
        const int col = tid & 127, kq = tid >> 7;
        for (int item = blockIdx.x; item < 4 * 48; item += gridDim.x) {
            const int l = item / 48, j = (item % 48) * 128 + col;
            const float* w = P.mod_w + (size_t)l * D * 6144 + j;
            float a[5] = {0.f, 0.f, 0.f, 0.f, 0.f};
#pragma unroll 8
            for (int k = kq * 256; k < kq * 256 + 256; ++k) {
                const float wv = w[(size_t)k * 6144];
#pragma unroll
                for (int m = 0; m < 5; ++m) a[m] += sc[m * 1024 + k] * wv;
            }
#pragma unroll
            for (int m = 0; m < 5; ++m) red[(kq * 128 + col) * 5 + m] = a[m];
            __syncthreads();
            if (kq == 0) {
                const float bias = P.mod_b[l * 6144 + j];
#pragma unroll
                for (int m = 0; m < 5; ++m) {
                    const float s = red[(0 * 128 + col) * 5 + m] + red[(1 * 128 + col) * 5 + m] + red[(2 * 128 + col) * 5 + m] + red[(3 * 128 + col) * 5 + m];
                    modv[(size_t)(l * 5 + m) * 6144 + j] = s + bias;
                }
            }
            __syncthreads();
        }
    }
}

__device__ __forceinline__ void phase_prologue1(int wv, KP Pk) {
    asm volatile("" : "+s"(Pk));
    const CAS Params& P = *Pk;
    const int tid = ltid(wv), lane = tid & 63, wid = tid >> 6;
    bf16_t* act = (bf16_t*)(P.ws + WS_ACT);
    for (int r = blockIdx.x * 8 + wid; r < NROWS; r += gridDim.x * 8) {
        const int m = row_mod(r);
        const float* src = r < NCTX ? P.ctx + (size_t)r * D : P.x + (size_t)(r - NCTX) * D;
        const float* sh = modvec(P.ws, 0, m, 0); const float* sc = modvec(P.ws, 0, m, 1);
#pragma unroll
        for (int i = 0; i < 4; ++i) {
            const int c = 4 * lane + 256 * i;
            const f32x4 v = *(const f32x4*)(src + c), s1 = *(const f32x4*)(sc + c), h1 = *(const f32x4*)(sh + c);
            u32x2 o; o.x = pk2(v[0] * (1.f + s1[0]) + h1[0], v[1] * (1.f + s1[1]) + h1[1]); o.y = pk2(v[2] * (1.f + s1[2]) + h1[2], v[3] * (1.f + s1[3]) + h1[3]);
            *(u32x2*)(act + (size_t)r * D + c) = o;
        }
    }
}

__device__ __forceinline__ void phase_inproj(int wv, KP Pk, int layer, LAS char* lds) {
    asm volatile("" : "+s"(Pk));
    const CAS Params& P = *Pk;
    const int odd = layer & 1, ldp = odd ? LDP_ODD : LDP_EVEN;
    const size_t woff = layer == 0 ? WINT_L0 : layer == 1 ? WINT_L1 : layer == 2 ? WINT_L2 : WINT_L3;
    pg8::Gemm g{(const bf16_t*)(P.ws + WS_ACT), (const bf16_t*)(P.ws + WS_WINT) + woff, NROWS, ldp, D};
    pg8::StaticOrder S; S.init(NROWS, ldp, (int)gridDim.x, (int)blockIdx.x);
    pg8::EpiStoreP E{(bf16_t*)(P.ws + WS_P), ldp};
    pg8::gemm_phase(wv, (PG8_LAS unsigned char*)lds, g, S, E);
    expconv_tail(wv, P, layer, lds, (NROWS / 256) * (ldp / 256), 0, exc_s0(layer));
}
__device__ __forceinline__ void phase_outproj(int wv, KP Pk, int layer, LAS char* lds) {
    asm volatile("" : "+s"(Pk));
    const CAS Params& P = *Pk;
    const int r0 = (layer == DEPTH - 1) ? NCTX : 0;
    pg8::Gemm g{(const bf16_t*)(P.ws + WS_FEAT) + (size_t)r0 * D, (const bf16_t*)(P.ws + WS_WOUTT) + (size_t)layer * D * D, NROWS - r0, D, D};
    pg8::StaticOrder S; S.init(NROWS - r0, D, (int)gridDim.x, (int)blockIdx.x);
    pg8::EpiStoreP E{(bf16_t*)(P.ws + WS_YO) + (size_t)r0 * D, D};
    pg8::gemm_phase(wv, (PG8_LAS unsigned char*)lds, g, S, E);
    expconv_tail(wv, P, layer, lds, ((NROWS - r0) / 256) * (D / 256), exc_s0(layer), exc_s0(layer) + exc_s1(layer));
}
__device__ __forceinline__ void phase_prep2(int wv, KP Pk, int layer, LAS char* lds) {
    asm volatile("" : "+s"(Pk));
    const CAS Params& P = *Pk;
    const int i = layer >> 1;
    const bf16_t* la = (const bf16_t*)(P.ws + WS_LA);
    const bf16_t* lt = (const bf16_t*)(P.ws + WS_LORAT) + (size_t)i * LORA_PER;
    constexpr int MT = NROWS / G_BM, NTL = 512 / G_BN;
    const int ntiles = 4 * MT * NTL;
    for (int t = blockIdx.x; t < ntiles; t += gridDim.x) {
        const int which = t / (MT * NTL), r = t % (MT * NTL), mt = r / NTL, nt = r % NTL;
        RowLinear rs{mt * G_BM};
        if (which < 2) {
            EpiDecay epi{(float*)(P.ws + WS_RWDEC) + (size_t)which * NROWS * 512, P.rw_w0 + (size_t)(i * 2 + which) * 512, mt * G_BM, nt * G_BN};
            gemm_tile(wv, la + which * 64, 320, rs, lt + (size_t)which * 512 * 64, 64, nt * G_BN, 64, epi, lds);
        } else if (which == 2) {
            EpiAK epi{(bf16_t*)(P.ws + WS_RWK), (const bf16_t*)(P.ws + WS_RWKK), (bf16_t*)(P.ws + WS_RWB), P.rw_a0 + i * 512, P.rw_k_a + i * 512, mt * G_BM, nt * G_BN};
            gemm_tile(wv, la + 128, 320, rs, lt + (size_t)2 * 512 * 64, 64, nt * G_BN, 64, epi, lds);
        } else {
            EpiStoreBf16 epi{(bf16_t*)(P.ws + WS_RWG), 512, mt * G_BM, nt * G_BN, 512};
            gemm_tile(wv, la + 192, 320, rs, lt + (size_t)3 * 512 * 64, 128, nt * G_BN, 128, epi, lds);
        }
    }
}
__device__ __forceinline__ void moe_tiles(int wv, const unsigned char* ws, int layer, LAS int* tstart, LAS int* tcnt) {
    const int tid = ltid(wv);
    if (tid < 64) {
        const int* cnt = (const int*)(ws + WS_CNT) + layer * 32 * CNT_STRIDE;
        const int c = tid < NEXP ? cnt[tid * CNT_STRIDE] : 0;
        int incl = (c + G_BM - 1) / G_BM;
#pragma unroll
        for (int o = 1; o < 32; o <<= 1) { const int t = __shfl_up(incl, o); if (tid >= o) incl += t; }
        if (tid < NEXP) { tcnt[tid] = c; tstart[tid] = incl - (c + G_BM - 1) / G_BM; }
        if (tid == NEXP - 1) tstart[NEXP] = incl;
    }
    __syncthreads();
}
__device__ __forceinline__ void phase_moe1(int wv, KP Pk, int layer, LAS char* lds) {
    asm volatile("" : "+s"(Pk));
    const CAS Params& P = *Pk;
    LAS int* tstart = (LAS int*)(lds + pg8::STAGE_BYTES); LAS int* tcnt = tstart + 40;
    moe_tiles(wv, P.ws, layer, tstart, tcnt);
    pg8::Gemm g{(const bf16_t*)(P.ws + WS_ACT), (const bf16_t*)(P.ws + WS_EXPGU), 0, 1024, D};
    LAS int* ltabs = tstart + 128;
    pg8::MoeOrder S{tstart, tcnt, ltabs, (const int*)(P.ws + WS_LIST), (const char*)(P.ws + WS_EXPGU), (size_t)1024 * 1024 * 2, 4, 1, (int)gridDim.x, (int)blockIdx.x};
    pg8::EpiSwiGLUG E{(bf16_t*)(P.ws + WS_HID)};
    for (int i = 0; i < 8; ++i) {
        pg8::UnitG u; if (!S.next(i, u)) break;
        const int tl = ltid(wv);
        const int* ul = (const int*)(P.ws + WS_LIST) + (size_t)u.e * LISTCAP + u.pm * pg8::BM;
        if (tl < pg8::BM) ltabs[i * pg8::BM + tl] = ul[tl < u.cnt ? tl : 0];
    }
    __syncthreads();
    pg8::gemm_phase_g(wv, (PG8_LAS unsigned char*)lds, g, S, E);
    __syncthreads();
}
__device__ __forceinline__ void phase_moe2(int wv, KP Pk, int layer, LAS char* lds) {
    asm volatile("" : "+s"(Pk));
    const CAS Params& P = *Pk;
    LAS int* tstart = (LAS int*)(lds + pg8::STAGE_BYTES); LAS int* tcnt = tstart + 40;
    moe_tiles(wv, P.ws, layer, tstart, tcnt);
    pg8::Gemm g{(const bf16_t*)(P.ws + WS_HID), (const bf16_t*)(P.ws + WS_EXPD), 0, 1024, DEXP};
    LAS int* ltabs = tstart + 128;
    pg8::MoeOrder S{tstart, tcnt, ltabs, (const int*)(P.ws + WS_LIST), (const char*)(P.ws + WS_EXPD), (size_t)1024 * 512 * 2, 4, 0, (int)gridDim.x, (int)blockIdx.x};
    pg8::EpiScatterG E{(bf16_t*)(P.ws + WS_YP)};
    for (int i = 0; i < 8; ++i) {
        pg8::UnitG u; if (!S.next(i, u)) break;
        const int tl = ltid(wv);
        const int* ul = (const int*)(P.ws + WS_LIST) + (size_t)u.e * LISTCAP + u.pm * pg8::BM;
        if (tl < pg8::BM) ltabs[i * pg8::BM + tl] = ul[tl < u.cnt ? tl : 0];
    }
    __syncthreads();
    pg8::gemm_phase_g(wv, (PG8_LAS unsigned char*)lds, g, S, E);
    __syncthreads();
}

constexpr int NCHUNK = NSTEPS / TCH;

constexpr int SSD_F = 32 + 64 + 64;
constexpr int SSD_BUF = TCH * SSD_F + 3 * TCH;

constexpr int ML_F = 64 + 64 + 32;
constexpr int ML_BUF = TCH * ML_F + 4 * TCH;

constexpr int HG_F = 128 + 128 + 32;
constexpr int HG_BUF = TCH * HG_F + TCH;

constexpr int RW_F = 5 * 64 + 32;
constexpr int RW_BUF = TCH * RW_F + TCH;
__device__ __forceinline__ void scan_rwkv(int wv, KP Pk, int layer, int unit, LAS char* lds) {
    asm volatile("" : "+s"(Pk));
    const CAS Params& P = *Pk;
    const int tid = ltid(wv);
    const int seq = unit >> 1, half = unit & 1, b = seq >> 4, h = (seq >> 1) & 7, dir = seq & 1;
    LAS float* bufs = (LAS float*)lds;
    bf16_t* Y = (bf16_t*)(P.ws + (dir ? WS_YB : WS_YF));
    const float* dec = (const float*)(P.ws + WS_RWDEC) + (size_t)dir * NROWS * 512;
    int tj[4], tg_[4]; bool tv[4]; const unsigned char* tbase[4]; int tlds[4];
#pragma unroll
    for (int s = 0; s < 4; ++s) {
        const int task = tid + NT * s; tv[s] = task < TCH * 52; tj[s] = task / 52; tg_[s] = task % 52;
        const int g = tg_[s];
        if (g < 8)       { tbase[s] = P.ws + WS_RWR  + (size_t)(h * 64 + 8 * g) * 2;              tlds[s] = 256 + 8 * g; }
        else if (g < 16) { tbase[s] = P.ws + WS_RWK  + (size_t)(h * 64 + 8 * (g - 8)) * 2;        tlds[s] = 192 + 8 * (g - 8); }
        else if (g < 24) { tbase[s] = P.ws + WS_RWKK + (size_t)(h * 64 + 8 * (g - 16)) * 2;       tlds[s] = 64 + 8 * (g - 16); }
        else if (g < 32) { tbase[s] = P.ws + WS_RWB  + (size_t)(h * 64 + 8 * (g - 24)) * 2;       tlds[s] = 128 + 8 * (g - 24); }
        else if (g < 36) { tbase[s] = P.ws + WS_RWV  + (size_t)(h * 64 + half * 32 + 8 * (g - 32)) * 2; tlds[s] = 320 + 8 * (g - 32); }
        else             { tbase[s] = (const unsigned char*)(dec + h * 64 + 4 * (g - 36));        tlds[s] = 4 * (g - 36); }
    }
    u32x4 rc[4]; int rrow = 0;
    auto load = [&](int c) {
#pragma unroll
        for (int s = 0; s < 4; ++s) {
            rc[s] = (u32x4){0u, 0u, 0u, 0u};
            if (tv[s]) { const int row = scan_row(c * TCH + tj[s], b, dir, 1); rc[s] = *(const u32x4*)(tbase[s] + (size_t)row * (tg_[s] < 36 ? 1024 : 2048)); }
        }
        if (tid < TCH) rrow = scan_row(c * TCH + tid, b, dir, 1);
    };
    auto store = [&](int c) {
        LAS float* buf = bufs + (c & 1) * RW_BUF;
#pragma unroll
        for (int s = 0; s < 4; ++s) {
            if (tv[s]) {
                LAS float* dst = buf + tj[s] * RW_F + tlds[s];
                const int g = tg_[s];
                if (g >= 36) { *(LAS u32x4*)dst = rc[s]; }
                else {
                    float f[8]; unpack8(rc[s], f);
                    const float sg = (g >= 16 && g < 24) ? -1.f : 1.f;
                    *(LAS f32x4*)dst = (f32x4){sg * f[0], sg * f[1], sg * f[2], sg * f[3]}; *(LAS f32x4*)(dst + 4) = (f32x4){sg * f[4], sg * f[5], sg * f[6], sg * f[7]};
                }
            }
        }
        if (tid < TCH) ((LAS int*)buf)[TCH * RW_F + tid] = rrow;
    };
    const int vrow = tid >> 4, q = tid & 15;
    f32x2 S01 = {0.f, 0.f}, S23 = {0.f, 0.f};
    LAS float* ypw = bufs + 2 * RW_BUF + (tid >> 6) * (2 * 16 * 68);
    int prow = -1, gpar = 0;
    load(0); store(0); __syncthreads();
    for (int c = 0; c < NCHUNK; ++c) {
        if (c + 1 < NCHUNK) load(c + 1);
        LAS float* buf = bufs + (c & 1) * RW_BUF;
        {
            const LAS float* wp = buf + 4 * q;
            const LAS float* vp = buf + 320 + vrow;
            f32x4 w4 = *(const LAS f32x4*)wp, a4 = *(const LAS f32x4*)(wp + 64), b4 = *(const LAS f32x4*)(wp + 128), k4 = *(const LAS f32x4*)(wp + 192), r4 = *(const LAS f32x4*)(wp + 256); float vr = vp[0];
#pragma unroll 1
            for (int jh = 0; jh < 2; ++jh) {
                const LAS float* rp = ypw + (gpar ^ 1) * (16 * 68) + q * 68 + ((tid >> 4) & 3) * 16;
                const f32x4 p0 = *(const LAS f32x4*)rp, p1 = *(const LAS f32x4*)(rp + 4), p2 = *(const LAS f32x4*)(rp + 8), p3 = *(const LAS f32x4*)(rp + 12);
                LAS float* wpz = ypw + gpar * (16 * 68) + (tid & 63);
#pragma unroll
                for (int j = 0; j < 16; ++j) {
                    const int jj = jh * 16 + j;
                    const f32x4 wc = w4, ac = a4, bc = b4, kc = k4, rc = r4; const float vv = vr;
                    if (j < 15 || jh == 0) {
                        const LAS float* np = wp + (jj + 1) * RW_F;
                        w4 = *(const LAS f32x4*)np; a4 = *(const LAS f32x4*)(np + 64); b4 = *(const LAS f32x4*)(np + 128); k4 = *(const LAS f32x4*)(np + 192); r4 = *(const LAS f32x4*)(np + 256); vr = vp[(jj + 1) * RW_F];
                    }
                    const f32x2 a01 = {ac[0], ac[1]}, a23 = {ac[2], ac[3]}, w01 = {wc[0], wc[1]}, w23 = {wc[2], wc[3]}, b01 = {bc[0], bc[1]}, b23 = {bc[2], bc[3]};
                    const f32x2 k01 = {kc[0], kc[1]}, k23 = {kc[2], kc[3]}, r01 = {rc[0], rc[1]}, r23 = {rc[2], rc[3]}, vv2 = {vv, vv};
                    f32x2 t = S01 * a01; t = S23 * a23 + t;
                    const f32x2 u01 = S01 * w01 + vv2 * k01, u23 = S23 * w23 + vv2 * k23;
                    const float sa = allreduce16(t.x + t.y);
                    const f32x2 sa2 = {sa, sa};
                    S01 = sa2 * b01 + u01; S23 = sa2 * b23 + u23;
                    f32x2 yv = S01 * r01; yv = S23 * r23 + yv;
                    wpz[j * 68] = yv.x + yv.y;
                }
                if (prow >= 0) {
                    const f32x4 t = (p0 + p1) + (p2 + p3);
                    Y[(size_t)prow * D + 512 + h * 64 + half * 32 + vrow] = f2bf((t[0] + t[1]) + (t[2] + t[3]));
                }
                prow = ((const LAS int*)buf)[TCH * RW_F + jh * 16 + q];
                gpar ^= 1;
            }
        }
        if (c + 1 < NCHUNK) store(c + 1);
        __syncthreads();
    }
    {
        const LAS float* rp = ypw + (gpar ^ 1) * (16 * 68) + q * 68 + ((tid >> 4) & 3) * 16;
        const f32x4 t = (*(const LAS f32x4*)rp + *(const LAS f32x4*)(rp + 4)) + (*(const LAS f32x4*)(rp + 8) + *(const LAS f32x4*)(rp + 12));
        Y[(size_t)prow * D + 512 + h * 64 + half * 32 + vrow] = f2bf((t[0] + t[1]) + (t[2] + t[3]));
    }
}

constexpr size_t WS_EXBC = WS_RWR;
constexpr size_t WS_EQK = WS_EXBC + (size_t)NROWS * 768 * 2;
constexpr size_t WS_EGT = WS_EQK + (size_t)NROWS * 512 * 2;
static_assert(WS_EGT + (size_t)NROWS * 32 * 4 <= WS_LA, "even-layer prepare buffers must fit in the RWKV region");

__device__ __forceinline__ void phase_prep_even(int wv, KP Pk, int layer) {
    asm volatile("" : "+s"(Pk));
    const CAS Params& P = *Pk;
    const int tid = ltid(wv), lane = tid & 63, wid = tid >> 6, i_ = layer >> 1;
    const bf16_t* Pb = (const bf16_t*)(P.ws + WS_P);
    bf16_t* XBC = (bf16_t*)(P.ws + WS_EXBC); bf16_t* QK = (bf16_t*)(P.ws + WS_EQK); float* GT = (float*)(P.ws + WS_EGT);
    float cw0[4][8], cw1[4][8], cwq[4][8];
#pragma unroll
    for (int e = 0; e < 8; ++e) {
#pragma unroll
        for (int t = 0; t < 3; ++t) {
            cw0[t][e] = P.ssd_conv_w[(size_t)(i_ * 3 + t) * 768 + 8 * lane + e];
            cw1[t][e] = P.ssd_conv_w[(size_t)(i_ * 3 + t) * 768 + 512 + 8 * (lane & 31) + e];
            cwq[t][e] = P.ml_conv_w[(size_t)(i_ * 3 + t) * 512 + 8 * lane + e];
        }
        cw0[3][e] = P.ssd_conv_b[i_ * 768 + 8 * lane + e]; cw1[3][e] = P.ssd_conv_b[i_ * 768 + 512 + 8 * (lane & 31) + e]; cwq[3][e] = P.ml_conv_b[i_ * 512 + 8 * lane + e];
    }
    float gbias = 0.f;
    if (lane < 16) gbias = P.ssd_dt_bias[i_ * 16 + lane]; else if (lane < 24) gbias = P.ml_i_bias[i_ * 8 + lane - 16]; else if (lane < 32) gbias = P.ml_f_bias[i_ * 8 + lane - 24];
    const float qscl = lane < 32 ? 0.125f : 1.f;
    for (int r = blockIdx.x * 8 + wid; r < NROWS; r += gridDim.x * 8) {
        int t, len; row_seg(r, t, len);
        const bf16_t* pr = Pb + (size_t)r * LDP_EVEN;
        const bool hp = t > 0, hn = t < len - 1;
        const u32x4 zero = (u32x4){0u, 0u, 0u, 0u};
        float fc[8], fp[8], fn[8], o[8];
        {
            const int col = 512 + 8 * lane;
            unpack8(*(const u32x4*)(pr + col), fc); unpack8(hp ? *(const u32x4*)(pr - LDP_EVEN + col) : zero, fp); unpack8(hn ? *(const u32x4*)(pr + LDP_EVEN + col) : zero, fn);
#pragma unroll
            for (int e = 0; e < 8; ++e) o[e] = siluf_(cw0[0][e] * fp[e] + cw0[1][e] * fc[e] + cw0[2][e] * fn[e] + cw0[3][e]);
            *(u32x4*)(XBC + (size_t)r * 768 + 8 * lane) = pack8(o);
        }
        if (lane < 32) {
            const int col = 1024 + 8 * lane;
            unpack8(*(const u32x4*)(pr + col), fc); unpack8(hp ? *(const u32x4*)(pr - LDP_EVEN + col) : zero, fp); unpack8(hn ? *(const u32x4*)(pr + LDP_EVEN + col) : zero, fn);
#pragma unroll
            for (int e = 0; e < 8; ++e) o[e] = siluf_(cw1[0][e] * fp[e] + cw1[1][e] * fc[e] + cw1[2][e] * fn[e] + cw1[3][e]);
            *(u32x4*)(XBC + (size_t)r * 768 + 512 + 8 * lane) = pack8(o);
        }
        {
            const int col = 1296 + 8 * lane;
            unpack8(*(const u32x4*)(pr + col), fc); unpack8(hp ? *(const u32x4*)(pr - LDP_EVEN + col) : zero, fp); unpack8(hn ? *(const u32x4*)(pr + LDP_EVEN + col) : zero, fn);
#pragma unroll
            for (int e = 0; e < 8; ++e) o[e] = qscl * siluf_(cwq[0][e] * fp[e] + cwq[1][e] * fc[e] + cwq[2][e] * fn[e] + cwq[3][e]);
            *(u32x4*)(QK + (size_t)r * 512 + 8 * lane) = pack8(o);
        }
        if (lane < 32) {
            const int col = lane < 16 ? 1280 + lane : 2832 + (lane - 16);
            const float x = bf2f(pr[col]) + gbias;
            GT[(size_t)r * 32 + lane] = lane < 16 ? softplusf_(x) : lane < 24 ? x : logsigmoidf_(x);
        }
    }
}

constexpr int CL = 64, NCH64 = NSTEPS / CL, LDT = 72, LDTB = LDT * 2;
__device__ __forceinline__ bf16x8 ldfrag(const LAS char* tile, int ldb, int row0, int k0, int lane) {
    return *(const LAS bf16x8*)(tile + (row0 + (lane & 15)) * ldb + (k0 + 8 * (lane >> 4)) * 2);
}
constexpr int LDTS = 160;
__device__ __forceinline__ int swz_off(int row, int byteoff) { return row * LDTS + (byteoff ^ (((row >> 3) & 7) << 4)); }
__device__ __forceinline__ bf16x8 ldfrag_sw(const LAS char* tile, int row0, int k0, int lane) {
    const int row = row0 + (lane & 15);
    return *(const LAS bf16x8*)(tile + swz_off(row, (k0 + 8 * (lane >> 4)) * 2));
}
__device__ __forceinline__ void st4bf(LAS char* p, const f32x4& v) { u32x2 o; o.x = pk2(v[0], v[1]); o.y = pk2(v[2], v[3]); *(LAS u32x2*)p = o; }

constexpr int SS_BT = 0, SS_CT = SS_BT + 64 * LDTB, SS_BDT = SS_CT + 64 * LDTB, SS_XT = SS_BDT + 64 * LDTB, SS_CUM = SS_XT + 32 * LDTB, SS_DTV = SS_CUM + 256, SS_ROWS = SS_DTV + 256, SS_STG = SS_ROWS + 256;
constexpr int SS_M = 2 * SS_STG, SS_HB = SS_M + 64 * LDTB, SS_END = SS_HB + 32 * LDTB;
static_assert(SS_END <= LDS_BYTES - 16, "SSD LDS map");

constexpr int MS_QT = 0, MS_KT = MS_QT + 64 * LDTB, MS_KET = MS_KT + 64 * LDTB, MS_VT = MS_KET + 64 * LDTB, MS_SC = MS_VT + 32 * LDTB;
constexpr int MS_STG = MS_SC + 8 * 256;
constexpr int MS_W = 2 * MS_STG, MS_CB = MS_W + 64 * LDTB, MS_ONE = MS_CB + 32 * LDTB, MS_NV = MS_ONE + 16 * LDTB, MS_QN = MS_NV + 256, MS_END = MS_QN + 256;
static_assert(MS_END <= LDS_BYTES - 16, "mLSTM LDS map");

constexpr size_t WS_XSS = WS_EGT + al256((size_t)NROWS * 32 * 4);
constexpr size_t XSS_BYTES = (size_t)64 * NCH64 * 64 * 64 * 2;
constexpr size_t WS_XSD = WS_XSS + XSS_BYTES;
constexpr size_t WS_XMC = WS_XSD + al256((size_t)64 * NCH64 * 4);
constexpr size_t XMC_BYTES = (size_t)32 * NCH64 * 128 * 64 * 2;
constexpr size_t WS_XMN = WS_XMC + XMC_BYTES;
constexpr size_t WS_XMS = WS_XMN + (size_t)32 * NCH64 * 64 * 4;
constexpr size_t WS_XMT = WS_XMS + al256((size_t)32 * NCH64 * 4 * 4);
constexpr size_t WS_XEND = WS_XMT + (size_t)32 * NCH64 * 3 * 64 * 4;
static_assert(WS_XEND <= WS_END, "even-layer chunk-state buffers must fit in the RWKV region");
constexpr int NSSD_ITEMS = 64 * NCH64, NML_ITEMS = 32 * NCH64;

template <int CTRL, int RM, int BM> __device__ __forceinline__ float dppx(float old, float v) {
    return __builtin_bit_cast(float, __builtin_amdgcn_update_dpp(__builtin_bit_cast(int, old), __builtin_bit_cast(int, v), CTRL, RM, BM, false));
}
__device__ __forceinline__ float wave_cumsum(float v, int) {
    float t = v;
    t += dppx<0x111, 0xf, 0xf>(0.f, v); t += dppx<0x112, 0xf, 0xf>(0.f, v); t += dppx<0x113, 0xf, 0xf>(0.f, v);
    { const float u = dppx<0x114, 0xf, 0xe>(0.f, t); t += u; }
    { const float u = dppx<0x118, 0xf, 0xc>(0.f, t); t += u; }
    { const float u = dppx<0x142, 0xa, 0xf>(0.f, t); t += u; }
    { const float u = dppx<0x143, 0xc, 0xf>(0.f, t); t += u; }
    return t;
}
__device__ __forceinline__ float wave_cummax(float v, int) {
    const float ninf = -__builtin_huge_valf();
    float t = v;
    t = fmaxf(t, dppx<0x111, 0xf, 0xf>(ninf, v)); t = fmaxf(t, dppx<0x112, 0xf, 0xf>(ninf, v)); t = fmaxf(t, dppx<0x113, 0xf, 0xf>(ninf, v));
    { const float u = dppx<0x114, 0xf, 0xe>(ninf, t); t = fmaxf(t, u); }
    { const float u = dppx<0x118, 0xf, 0xc>(ninf, t); t = fmaxf(t, u); }
    { const float u = dppx<0x142, 0xa, 0xf>(ninf, t); t = fmaxf(t, u); }
    { const float u = dppx<0x143, 0xc, 0xf>(ninf, t); t = fmaxf(t, u); }
    return t;
}
__device__ __forceinline__ float wave_max(float v) {
    const float t = wave_cummax(v, 0);
    return __builtin_bit_cast(float, __builtin_amdgcn_readlane(__builtin_bit_cast(int, t), 63));
}

constexpr int X1S_BDT = 0, X1S_XT = X1S_BDT + 64 * LDTS, X1S_CUM = X1S_XT + 64 * LDTS, X1S_DTV = X1S_CUM + 256, X1S_END = X1S_DTV + 256;
constexpr int X1M_KET = 0, X1M_VT = X1M_KET + 64 * LDTS, X1M_ONE = X1M_VT + 128 * LDTS, X1M_EE = X1M_ONE + 16 * LDTB, X1M_END = X1M_EE + 256;
__device__ __forceinline__ void phase_ex1(int wv, KP Pk, int layer, LAS char* lds) {
    asm volatile("" : "+s"(Pk));
    const CAS Params& P = *Pk;
    const int tid = ltid(wv), lane = tid & 63, wid = tid >> 6, q = lane >> 4, r16 = lane & 15, i_ = layer >> 1;
    const bf16_t* XBC = (const bf16_t*)(P.ws + WS_EXBC); const bf16_t* QK = (const bf16_t*)(P.ws + WS_EQK); const bf16_t* Pb = (const bf16_t*)(P.ws + WS_P);
    const float* GT = (const float*)(P.ws + WS_EGT);
    {
        bf16_t* Hst = (bf16_t*)(P.ws + WS_XSS); float* Dst = (float*)(P.ws + WS_XSD);
        u32x4 rc[2]; float rdt = 0.f;
        auto geom = [&](int it, int& b, int& h, int& dir, int& c) { const int sq = it / NCH64; c = it - sq * NCH64; b = sq >> 4; h = (sq >> 1) & 7; dir = sq & 1; };
        auto load = [&](int it) {
            int b, h, dir, c; geom(it, b, h, dir, c);
            int tl = tid; asm volatile("" : "+v"(tl));
#pragma unroll
            for (int s = 0; s < 2; ++s) {
                const int task = tl + NT * s, j = task >> 4, g = task & 15;
                const int row = scan_row(c * CL + j, b, dir, 0);
                rc[s] = *(const u32x4*)(XBC + (size_t)row * 768 + (g < 8 ? h * 64 + 8 * g : 512 + (h >> 2) * 64 + 8 * (g - 8)));
            }
            if (tl < CL) { const int row = scan_row(c * CL + tl, b, dir, 0); rdt = GT[(size_t)row * 32 + dir * 8 + h]; }
        };
        int it = blockIdx.x;
        if (it < NSSD_ITEMS) load(it);
        for (; it < NSSD_ITEMS; it += gridDim.x) {
            int b, h, dir, c; geom(it, b, h, dir, c);
            const float aco = -__expf(P.ssd_a_log[(i_ * 2 + dir) * 8 + h]);
            if (tid < CL) {
                const float cum = wave_cumsum(rdt * aco, lane);
                ((LAS float*)(lds + X1S_CUM))[tid] = cum; ((LAS float*)(lds + X1S_DTV))[tid] = rdt;
            }
            __syncthreads();
            {
                const LAS float* cum = (const LAS float*)(lds + X1S_CUM);
                const float cumL = cum[CL - 1];
                int tl = tid; asm volatile("" : "+v"(tl));
#pragma unroll
                for (int s = 0; s < 2; ++s) {
                    const int task = tl + NT * s, j = task >> 4, g = task & 15;
                    float f[8]; unpack8(rc[s], f);
                    if (g < 8) {
                        const float dt = ((const LAS float*)(lds + X1S_DTV))[j];
#pragma unroll
                        for (int e = 0; e < 8; ++e) *(LAS bf16_t*)(lds + X1S_XT + swz_off(8 * g + e, j * 2)) = f2bf(f[e] * dt);
                    } else {
                        const float sc = __expf(cumL - cum[j]);
#pragma unroll
                        for (int e = 0; e < 8; ++e) *(LAS bf16_t*)(lds + X1S_BDT + swz_off(8 * (g - 8) + e, j * 2)) = f2bf(f[e] * sc);
                    }
                }
                if (tid == 0) Dst[it] = __expf(cumL);
            }
            if (it + (int)gridDim.x < NSSD_ITEMS) load(it + gridDim.x);
            __syncthreads();
            {
                const int pt = wid >> 1;
#pragma unroll
                for (int u = 0; u < 2; ++u) {
                    const int nt = (wid & 1) * 2 + u;
                    f32x4 sa = (f32x4){0.f, 0.f, 0.f, 0.f};
#pragma unroll
                    for (int k0 = 0; k0 < 64; k0 += 32) sa = __builtin_amdgcn_mfma_f32_16x16x32_bf16(ldfrag_sw(lds + X1S_BDT, nt * 16, k0, lane), ldfrag_sw(lds + X1S_XT, pt * 16, k0, lane), sa, 0, 0, 0);
                    u32x2 o; o.x = pk2(sa[0], sa[1]); o.y = pk2(sa[2], sa[3]);
                    *(u32x2*)(Hst + ((size_t)it * 64 + pt * 16 + r16) * 64 + nt * 16 + 4 * q) = o;
                }
            }
            __syncthreads();
        }
    }
    {
        bf16_t* Cst = (bf16_t*)(P.ws + WS_XMC); float* Nst = (float*)(P.ws + WS_XMN); float* Sst = (float*)(P.ws + WS_XMS); float* Tst = (float*)(P.ws + WS_XMT);
        for (int i = tid; i < 16 * LDTB / 4; i += NT) ((LAS unsigned*)(lds + X1M_ONE))[i] = 0x3f803f80u;
        u32x4 rc[3]; float rli = 0.f, rlf = 0.f;
        auto geom = [&](int it, int& b, int& h, int& dir, int& c) { const int sq = it / NCH64; c = it - sq * NCH64; b = sq >> 3; h = (sq >> 1) & 3; dir = sq & 1; };
        auto load = [&](int it) {
            int b, h, dir, c; geom(it, b, h, dir, c);
            int tl = tid; asm volatile("" : "+v"(tl));
#pragma unroll
            for (int s = 0; s < 3; ++s) {
                const int task = tl + NT * s, j = task / 24, g = task - 24 * j;
                const int row = scan_row(c * CL + j, b, dir, 0);
                rc[s] = g < 8 ? *(const u32x4*)(QK + (size_t)row * 512 + 256 + h * 64 + 8 * g) : *(const u32x4*)(Pb + (size_t)row * LDP_EVEN + 1808 + h * 128 + 8 * (g - 8));
            }
            if (tl < CL) { const int row = scan_row(c * CL + tl, b, dir, 0); rli = GT[(size_t)row * 32 + 16 + dir * 4 + h]; rlf = GT[(size_t)row * 32 + 24 + dir * 4 + h]; }
        };
        int it = blockIdx.x;
        if (it < NML_ITEMS) load(it);
        __syncthreads();
        for (; it < NML_ITEMS; it += gridDim.x) {
            if (tid < CL) {
                const float fcum = wave_cumsum(rlf, lane);
                const float ftot = __builtin_bit_cast(float, __builtin_amdgcn_readlane(__builtin_bit_cast(int, fcum), 63));
                const float g = rli - fcum, pm = wave_cummax(g, lane);
                const float wend = ftot + g, mloc = wave_max(wend);
                ((LAS float*)(lds + X1M_EE))[tid] = __expf(wend - mloc);
                float* tp = Tst + (size_t)it * 192;
                tp[tid] = fcum; tp[64 + tid] = g; tp[128 + tid] = pm;
                if (tid == 0) { Sst[(size_t)it * 4 + 0] = ftot; Sst[(size_t)it * 4 + 1] = mloc; }
            }
            __syncthreads();
            {
                const LAS float* ee = (const LAS float*)(lds + X1M_EE);
                int tl = tid; asm volatile("" : "+v"(tl));
#pragma unroll
                for (int s = 0; s < 3; ++s) {
                    const int task = tl + NT * s, j = task / 24, g = task - 24 * j;
                    if (g < 8) {
                        float f[8]; unpack8(rc[s], f);
                        const float e1 = ee[j];
#pragma unroll
                        for (int e = 0; e < 8; ++e) *(LAS bf16_t*)(lds + X1M_KET + swz_off(8 * g + e, j * 2)) = f2bf(f[e] * e1);
                    } else {
                        const int v0 = 8 * (g - 8);
#pragma unroll
                        for (int e = 0; e < 8; ++e) { const unsigned wv = rc[s][e >> 1]; *(LAS bf16_t*)(lds + X1M_VT + swz_off(v0 + e, j * 2)) = (bf16_t)((e & 1) ? (wv >> 16) : (wv & 0xffffu)); }
                    }
                }
            }
            if (it + (int)gridDim.x < NML_ITEMS) load(it + gridDim.x);
            __syncthreads();
            {
                const bf16x8 vf0 = ldfrag_sw(lds + X1M_VT, wid * 16, 0, lane), vf1 = ldfrag_sw(lds + X1M_VT, wid * 16, 32, lane);
#pragma unroll
                for (int kt = 0; kt < 4; ++kt) {
                    f32x4 sa = __builtin_amdgcn_mfma_f32_16x16x32_bf16(ldfrag_sw(lds + X1M_KET, kt * 16, 0, lane), vf0, (f32x4){0.f, 0.f, 0.f, 0.f}, 0, 0, 0);
                    sa = __builtin_amdgcn_mfma_f32_16x16x32_bf16(ldfrag_sw(lds + X1M_KET, kt * 16, 32, lane), vf1, sa, 0, 0, 0);
                    u32x2 o; o.x = pk2(sa[0], sa[1]); o.y = pk2(sa[2], sa[3]);
                    *(u32x2*)(Cst + ((size_t)it * 128 + wid * 16 + r16) * 64 + kt * 16 + 4 * q) = o;
                }
                if (wid < 4) {
                    f32x4 na = __builtin_amdgcn_mfma_f32_16x16x32_bf16(ldfrag_sw(lds + X1M_KET, wid * 16, 0, lane), ldfrag(lds + X1M_ONE, LDTB, 0, 0, lane), (f32x4){0.f, 0.f, 0.f, 0.f}, 0, 0, 0);
                    na = __builtin_amdgcn_mfma_f32_16x16x32_bf16(ldfrag_sw(lds + X1M_KET, wid * 16, 32, lane), ldfrag(lds + X1M_ONE, LDTB, 0, 32, lane), na, 0, 0, 0);
                    if (r16 == 0) *(f32x4*)(Nst + (size_t)it * 64 + wid * 16 + 4 * q) = na;
                }
            }
            __syncthreads();
        }
    }
}

constexpr int EX2_UB = 12;
static_assert(NCH64 % EX2_UB == 0, "EX2 batches");
__device__ __forceinline__ void phase_ex2(int wv, KP Pk, int layer) {
    asm volatile("" : "+s"(Pk));
    const CAS Params& P = *Pk;
    const int tid = ltid(wv);
    (void)layer;
    if (blockIdx.x < 128) {
        const int gt = blockIdx.x * NT + tid, sq = gt >> 10, rem = gt & 1023;
        bf16_t* Hst = (bf16_t*)(P.ws + WS_XSS) + (size_t)sq * NCH64 * 4096 + rem * 4;
        const float* Dst = (const float*)(P.ws + WS_XSD) + sq * NCH64;
        float h0 = 0.f, h1 = 0.f, h2 = 0.f, h3 = 0.f;
#pragma unroll 1
        for (int c0 = 0; c0 < NCH64; c0 += EX2_UB) {
            u32x2 loc[EX2_UB]; float dd[EX2_UB];
            bf16_t* hp = Hst + (size_t)c0 * 4096;
#pragma unroll
            for (int u = 0; u < EX2_UB; ++u) { loc[u] = *(const u32x2*)(hp + (size_t)u * 4096); dd[u] = Dst[c0 + u]; }
#pragma unroll
            for (int u = 0; u < EX2_UB; ++u) {
                u32x2 o; o.x = pk2(h0, h1); o.y = pk2(h2, h3);
                *(u32x2*)(hp + (size_t)u * 4096) = o;
                const float d = dd[u];
                h0 = d * h0 + bflo(loc[u].x); h1 = d * h1 + bfhi(loc[u].x); h2 = d * h2 + bflo(loc[u].y); h3 = d * h3 + bfhi(loc[u].y);
            }
        }
    } else if (blockIdx.x < 256) {
        const int gt = (blockIdx.x - 128) * NT + tid, sq = gt >> 11, rem = gt & 2047;
        bf16_t* Cst = (bf16_t*)(P.ws + WS_XMC) + (size_t)sq * NCH64 * 8192 + rem * 4;
        float* Nst = (float*)(P.ws + WS_XMN) + (size_t)sq * NCH64 * 64 + (rem & 15) * 4;
        float* Sst = (float*)(P.ws + WS_XMS) + (size_t)sq * NCH64 * 4;
        const bool own_n = rem < 16, own_m = rem == 0;
        float c0_ = 0.f, c1 = 0.f, c2 = 0.f, c3 = 0.f, m = -1e30f;
        f32x4 nn = (f32x4){0.f, 0.f, 0.f, 0.f};
#pragma unroll 1
        for (int cb = 0; cb < NCH64; cb += EX2_UB) {
            u32x2 loc[EX2_UB]; float ft[EX2_UB], ml[EX2_UB]; f32x4 nl[EX2_UB];
            bf16_t* cp = Cst + (size_t)cb * 8192; float* np = Nst + (size_t)cb * 64; float* sp_ = Sst + cb * 4;
#pragma unroll
            for (int u = 0; u < EX2_UB; ++u) {
                loc[u] = *(const u32x2*)(cp + (size_t)u * 8192); ft[u] = sp_[u * 4 + 0]; ml[u] = sp_[u * 4 + 1];
                nl[u] = (f32x4){0.f, 0.f, 0.f, 0.f};
                if (own_n) nl[u] = *(const f32x4*)(np + (size_t)u * 64);
            }
#pragma unroll
            for (int u = 0; u < EX2_UB; ++u) {
                const float ftot = ft[u], mloc = ml[u];
                const float mnew = fmaxf(ftot + m, mloc), sp = __expf(ftot + m - mnew), sl = __expf(mloc - mnew);
                u32x2 o; o.x = pk2(c0_, c1); o.y = pk2(c2, c3);
                *(u32x2*)(cp + (size_t)u * 8192) = o;
                c0_ = sp * c0_ + sl * bflo(loc[u].x); c1 = sp * c1 + sl * bfhi(loc[u].x); c2 = sp * c2 + sl * bflo(loc[u].y); c3 = sp * c3 + sl * bfhi(loc[u].y);
                if (own_n) { *(f32x4*)(np + (size_t)u * 64) = nn; nn = nn * sp + nl[u] * sl; }
                if (own_m) sp_[u * 4 + 2] = m;
                m = mnew;
            }
        }
    }
}

constexpr int X3S_BT = 0, X3S_CT = X3S_BT + 64 * LDTB, X3S_XT = X3S_CT + 64 * LDTB, X3S_HB = X3S_XT + 64 * LDTS, X3S_M = X3S_HB + 64 * LDTB, X3S_CUM = X3S_M + 64 * LDTB, X3S_DTV = X3S_CUM + 256, X3S_ROWS = X3S_DTV + 256, X3S_END = X3S_ROWS + 256;
constexpr int X3M_QT = 0, X3M_KT = X3M_QT + 64 * LDTB, X3M_VT = X3M_KT + 64 * LDTB, X3M_CB = X3M_VT + 128 * LDTS, X3M_W = X3M_CB + 128 * LDTB, X3M_ONE = X3M_W + 64 * LDTB, X3M_NB = X3M_ONE + 16 * LDTB,
              X3M_SC = X3M_NB + 16 * LDTB, X3M_END = X3M_SC + 6 * 256;
static_assert(X3M_END <= LDS_BYTES - 16 && X3S_END <= LDS_BYTES - 16, "EX3 LDS maps");
__device__ __forceinline__ void phase_ex3(int wv, KP Pk, int layer, LAS char* lds) {
    asm volatile("" : "+s"(Pk));
    const CAS Params& P = *Pk;
    const int tid = ltid(wv), lane = tid & 63, wid = tid >> 6, q = lane >> 4, r16 = lane & 15, i_ = layer >> 1;
    const bf16_t* XBC = (const bf16_t*)(P.ws + WS_EXBC); const bf16_t* QK = (const bf16_t*)(P.ws + WS_EQK); const bf16_t* Pb = (const bf16_t*)(P.ws + WS_P);
    const float* GT = (const float*)(P.ws + WS_EGT);
    {
        const bf16_t* Hst = (const bf16_t*)(P.ws + WS_XSS);
        u32x4 rc[3], rh; float rdt = 0.f; int rrow = 0;
        auto geom = [&](int it, int& b, int& h, int& dir, int& c) { const int sq = it / NCH64; c = it - sq * NCH64; b = sq >> 4; h = (sq >> 1) & 7; dir = sq & 1; };
        auto load = [&](int it) {
            int b, h, dir, c; geom(it, b, h, dir, c);
            int tl = tid; asm volatile("" : "+v"(tl));
#pragma unroll
            for (int s = 0; s < 3; ++s) {
                const int task = tl + NT * s, j = task / 24, g = task - 24 * j;
                const int row = scan_row(c * CL + j, b, dir, 0);
                rc[s] = *(const u32x4*)(XBC + (size_t)row * 768 + (g < 8 ? h * 64 + 8 * g : g < 16 ? 512 + (h >> 2) * 64 + 8 * (g - 8) : 640 + (h >> 2) * 64 + 8 * (g - 16)));
            }
            rh = *(const u32x4*)(Hst + (size_t)it * 4096 + tl * 8);
            if (tl < CL) { rrow = scan_row(c * CL + tl, b, dir, 0); rdt = GT[(size_t)rrow * 32 + dir * 8 + h]; }
        };
        int it = blockIdx.x;
        if (it < NSSD_ITEMS) load(it);
        __syncthreads();
        for (; it < NSSD_ITEMS; it += gridDim.x) {
            int b, h, dir, c; geom(it, b, h, dir, c);
            bf16_t* Y = (bf16_t*)(P.ws + (dir ? WS_YB : WS_YF));
            const float aco = -__expf(P.ssd_a_log[(i_ * 2 + dir) * 8 + h]);
            if (tid < CL) {
                const float cum = wave_cumsum(rdt * aco, lane);
                ((LAS float*)(lds + X3S_CUM))[tid] = cum; ((LAS float*)(lds + X3S_DTV))[tid] = rdt; ((LAS int*)(lds + X3S_ROWS))[tid] = rrow;
            }
            __syncthreads();
            {
                int tl = tid; asm volatile("" : "+v"(tl));
#pragma unroll
                for (int s = 0; s < 3; ++s) {
                    const int task = tl + NT * s, j = task / 24, g = task - 24 * j;
                    if (g < 8) {
                        float f[8]; unpack8(rc[s], f);
                        const float dt = ((const LAS float*)(lds + X3S_DTV))[j];
#pragma unroll
                        for (int e = 0; e < 8; ++e) *(LAS bf16_t*)(lds + X3S_XT + swz_off(8 * g + e, j * 2)) = f2bf(f[e] * dt);
                    } else if (g < 16) *(LAS u32x4*)(lds + X3S_BT + j * LDTB + 8 * (g - 8) * 2) = rc[s];
                    else *(LAS u32x4*)(lds + X3S_CT + j * LDTB + 8 * (g - 16) * 2) = rc[s];
                }
                *(LAS u32x4*)(lds + X3S_HB + (tl >> 3) * LDTB + (tl & 7) * 16) = rh;
            }
            if (it + (int)gridDim.x < NSSD_ITEMS) load(it + gridDim.x);
            __syncthreads();
            const LAS float* cum = (const LAS float*)(lds + X3S_CUM);
            {
                const int lt = wid >> 1;
#pragma unroll
                for (int u = 0; u < 2; ++u) {
                    const int st = (wid & 1) * 2 + u;
                    f32x4 acc = (f32x4){0.f, 0.f, 0.f, 0.f};
                    if (st <= lt) {
#pragma unroll
                        for (int k0 = 0; k0 < 64; k0 += 32) acc = __builtin_amdgcn_mfma_f32_16x16x32_bf16(ldfrag(lds + X3S_BT, LDTB, st * 16, k0, lane), ldfrag(lds + X3S_CT, LDTB, lt * 16, k0, lane), acc, 0, 0, 0);
                        const int l = lt * 16 + r16, s0 = st * 16 + 4 * q;
                        const float cl = cum[l]; const f32x4 cs = *(const LAS f32x4*)(cum + s0);
#pragma unroll
                        for (int j = 0; j < 4; ++j) acc[j] = (s0 + j <= l) ? acc[j] * __expf(cl - cs[j]) : 0.f;
                    }
                    st4bf(lds + X3S_M + (lt * 16 + r16) * LDTB + (st * 16 + 4 * q) * 2, acc);
                }
            }
            __syncthreads();
            {
                const int lt = wid >> 1, l = lt * 16 + r16;
                const float el = __expf(cum[l]);
                const int row = ((const LAS int*)(lds + X3S_ROWS))[l];
                const bf16x8 mf0 = ldfrag(lds + X3S_M, LDTB, lt * 16, 0, lane), mf1 = ldfrag(lds + X3S_M, LDTB, lt * 16, 32, lane);
                const bf16x8 cf0 = ldfrag(lds + X3S_CT, LDTB, lt * 16, 0, lane), cf1 = ldfrag(lds + X3S_CT, LDTB, lt * 16, 32, lane);
#pragma unroll
                for (int u = 0; u < 2; ++u) {
                    const int pt = (wid & 1) * 2 + u;
                    f32x4 ya = __builtin_amdgcn_mfma_f32_16x16x32_bf16(ldfrag_sw(lds + X3S_XT, pt * 16, 0, lane), mf0, (f32x4){0.f, 0.f, 0.f, 0.f}, 0, 0, 0);
                    ya = __builtin_amdgcn_mfma_f32_16x16x32_bf16(ldfrag_sw(lds + X3S_XT, pt * 16, 32, lane), mf1, ya, 0, 0, 0);
                    f32x4 oa = __builtin_amdgcn_mfma_f32_16x16x32_bf16(ldfrag(lds + X3S_HB, LDTB, pt * 16, 0, lane), cf0, (f32x4){0.f, 0.f, 0.f, 0.f}, 0, 0, 0);
                    oa = __builtin_amdgcn_mfma_f32_16x16x32_bf16(ldfrag(lds + X3S_HB, LDTB, pt * 16, 32, lane), cf1, oa, 0, 0, 0);
                    u32x2 o; o.x = pk2(ya[0] + el * oa[0], ya[1] + el * oa[1]); o.y = pk2(ya[2] + el * oa[2], ya[3] + el * oa[3]);
                    *(u32x2*)(Y + (size_t)row * D + h * 64 + pt * 16 + 4 * q) = o;
                }
            }
            __syncthreads();
        }
    }
    {
        const bf16_t* Cst = (const bf16_t*)(P.ws + WS_XMC); const float* Nst = (const float*)(P.ws + WS_XMN); const float* Sst = (const float*)(P.ws + WS_XMS); const float* Tst = (const float*)(P.ws + WS_XMT);
        for (int i = tid; i < 16 * LDTB / 4; i += NT) ((LAS unsigned*)(lds + X3M_ONE))[i] = 0x3f803f80u;
        u32x4 rc[4], rcb[2]; float rfc = 0.f, rg = 0.f, rpm = 0.f, rmp = 0.f, rn = 0.f; int rrow = 0;
        auto geom = [&](int it, int& b, int& h, int& dir, int& c) { const int sq = it / NCH64; c = it - sq * NCH64; b = sq >> 3; h = (sq >> 1) & 3; dir = sq & 1; };
        auto load = [&](int it) {
            int b, h, dir, c; geom(it, b, h, dir, c);
            int tl = tid; asm volatile("" : "+v"(tl));
#pragma unroll
            for (int s = 0; s < 4; ++s) {
                const int task = tl + NT * s, j = task >> 5, g = task & 31;
                const int row = scan_row(c * CL + j, b, dir, 0);
                rc[s] = g < 16 ? *(const u32x4*)(QK + (size_t)row * 512 + (g < 8 ? h * 64 + 8 * g : 256 + h * 64 + 8 * (g - 8))) : *(const u32x4*)(Pb + (size_t)row * LDP_EVEN + 1808 + h * 128 + 8 * (g - 16));
            }
#pragma unroll
            for (int s = 0; s < 2; ++s) rcb[s] = *(const u32x4*)(Cst + (size_t)it * 8192 + (tl + NT * s) * 8);
            if (tl < CL) {
                rrow = scan_row(c * CL + tl, b, dir, 0);
                const float* tp = Tst + (size_t)it * 192;
                rfc = tp[tl]; rg = tp[64 + tl]; rpm = tp[128 + tl]; rmp = Sst[(size_t)it * 4 + 2]; rn = Nst[(size_t)it * 64 + tl];
            }
        };
        int it = blockIdx.x;
        if (it < NML_ITEMS) load(it);
        __syncthreads();
        for (; it < NML_ITEMS; it += gridDim.x) {
            int b, h, dir, c; geom(it, b, h, dir, c);
            bf16_t* Y = (bf16_t*)(P.ws + (dir ? WS_YB : WS_YF));
            LAS float* sc = (LAS float*)(lds + X3M_SC);
            {
                int tl = tid; asm volatile("" : "+v"(tl));
#pragma unroll
                for (int s = 0; s < 4; ++s) {
                    const int task = tl + NT * s, j = task >> 5, g = task & 31;
                    if (g < 8) *(LAS u32x4*)(lds + X3M_QT + j * LDTB + 8 * g * 2) = rc[s];
                    else if (g < 16) *(LAS u32x4*)(lds + X3M_KT + j * LDTB + 8 * (g - 8) * 2) = rc[s];
                    else {
                        const int v0 = 8 * (g - 16);
#pragma unroll
                        for (int e = 0; e < 8; ++e) { const unsigned wv = rc[s][e >> 1]; *(LAS bf16_t*)(lds + X3M_VT + swz_off(v0 + e, j * 2)) = (bf16_t)((e & 1) ? (wv >> 16) : (wv & 0xffffu)); }
                    }
                }
#pragma unroll
                for (int s = 0; s < 2; ++s) { const int ch = tl + NT * s; *(LAS u32x4*)(lds + X3M_CB + (ch >> 3) * LDTB + (ch & 7) * 16) = rcb[s]; }
                if (tl < CL) {
                    const float linter = rfc + rmp, mrow = fmaxf(rfc + rpm, linter);
                    sc[tl] = rfc - mrow; sc[64 + tl] = rg; sc[128 + tl] = __expf(linter - mrow); sc[192 + tl] = __expf(-mrow); ((LAS int*)sc)[256 + tl] = rrow;
                    const bf16_t nb = f2bf(rn);
#pragma unroll
                    for (int r = 0; r < 16; ++r) *(LAS bf16_t*)(lds + X3M_NB + r * LDTB + tl * 2) = nb;
                }
            }
            if (it + (int)gridDim.x < NML_ITEMS) load(it + gridDim.x);
            __syncthreads();
            {
                const int lt = wid >> 1;
#pragma unroll
                for (int u = 0; u < 2; ++u) {
                    const int st = (wid & 1) * 2 + u;
                    f32x4 acc = (f32x4){0.f, 0.f, 0.f, 0.f};
                    if (st <= lt) {
#pragma unroll
                        for (int k0 = 0; k0 < 64; k0 += 32) acc = __builtin_amdgcn_mfma_f32_16x16x32_bf16(ldfrag(lds + X3M_KT, LDTB, st * 16, k0, lane), ldfrag(lds + X3M_QT, LDTB, lt * 16, k0, lane), acc, 0, 0, 0);
                        const int l = lt * 16 + r16, s0 = st * 16 + 4 * q;
                        const float rt = sc[l]; const f32x4 gs = *(const LAS f32x4*)(sc + 64 + s0);
#pragma unroll
                        for (int j = 0; j < 4; ++j) acc[j] = (s0 + j <= l) ? acc[j] * __expf(rt + gs[j]) : 0.f;
                    }
                    st4bf(lds + X3M_W + (lt * 16 + r16) * LDTB + (st * 16 + 4 * q) * 2, acc);
                }
            }
            __syncthreads();
            {
                const int lt = wid >> 1, l = lt * 16 + r16;
                const bf16x8 wf0 = ldfrag(lds + X3M_W, LDTB, lt * 16, 0, lane), wf1 = ldfrag(lds + X3M_W, LDTB, lt * 16, 32, lane);
                const bf16x8 qf0 = ldfrag(lds + X3M_QT, LDTB, lt * 16, 0, lane), qf1 = ldfrag(lds + X3M_QT, LDTB, lt * 16, 32, lane);
                f32x4 da = __builtin_amdgcn_mfma_f32_16x16x32_bf16(ldfrag(lds + X3M_ONE, LDTB, 0, 0, lane), wf0, (f32x4){0.f, 0.f, 0.f, 0.f}, 0, 0, 0);
                da = __builtin_amdgcn_mfma_f32_16x16x32_bf16(ldfrag(lds + X3M_ONE, LDTB, 0, 32, lane), wf1, da, 0, 0, 0);
                f32x4 qn = __builtin_amdgcn_mfma_f32_16x16x32_bf16(ldfrag(lds + X3M_NB, LDTB, 0, 0, lane), qf0, (f32x4){0.f, 0.f, 0.f, 0.f}, 0, 0, 0);
                qn = __builtin_amdgcn_mfma_f32_16x16x32_bf16(ldfrag(lds + X3M_NB, LDTB, 0, 32, lane), qf1, qn, 0, 0, 0);
                const float inter = sc[128 + l], emr = sc[192 + l];
                const float inv = __builtin_amdgcn_rcpf(fmaxf(fabsf(da[0] + inter * qn[0]), emr));
                const int row = ((const LAS int*)sc)[256 + l];
#pragma unroll
                for (int u = 0; u < 4; ++u) {
                    const int vt = (wid & 1) * 4 + u;
                    f32x4 na = __builtin_amdgcn_mfma_f32_16x16x32_bf16(ldfrag_sw(lds + X3M_VT, vt * 16, 0, lane), wf0, (f32x4){0.f, 0.f, 0.f, 0.f}, 0, 0, 0);
                    na = __builtin_amdgcn_mfma_f32_16x16x32_bf16(ldfrag_sw(lds + X3M_VT, vt * 16, 32, lane), wf1, na, 0, 0, 0);
                    f32x4 ca = __builtin_amdgcn_mfma_f32_16x16x32_bf16(ldfrag(lds + X3M_CB, LDTB, vt * 16, 0, lane), qf0, (f32x4){0.f, 0.f, 0.f, 0.f}, 0, 0, 0);
                    ca = __builtin_amdgcn_mfma_f32_16x16x32_bf16(ldfrag(lds + X3M_CB, LDTB, vt * 16, 32, lane), qf1, ca, 0, 0, 0);
                    u32x2 o; o.x = pk2((na[0] + inter * ca[0]) * inv, (na[1] + inter * ca[1]) * inv); o.y = pk2((na[2] + inter * ca[2]) * inv, (na[3] + inter * ca[3]) * inv);
                    *(u32x2*)(Y + (size_t)row * D + 512 + h * 128 + vt * 16 + 4 * q) = o;
                }
            }
            __syncthreads();
        }
    }
}

constexpr int HC_RAWF = 0;
constexpr int HC_RAWQ = HC_RAWF + 64 * 128 * 4;
constexpr int HC_SUB = HC_RAWQ + 64 * 128 * 2;
constexpr int HL_QD = 136 * 2;
constexpr int HL_T = 24 * 2;
constexpr int HS_QI = 0, HS_KO = HS_QI + 16 * HL_QD, HS_KET = HS_KO + 16 * HL_QD, HS_ATT = HS_KET + 128 * HL_T, HS_VT = HS_ATT + 16 * HL_T, HS_DEC = HS_VT + 32 * HL_T, HS_SIZE = HS_DEC + 512;
constexpr int HC_SB = HC_SUB + 4 * HS_SIZE;
constexpr int HC_ROWS = HC_SB + 2 * 32 * HL_QD, HC_CST = HC_ROWS + 256, HC_END = HC_CST + 1024;
static_assert(HC_END <= LDS_BYTES - 16, "HGRN2 LDS map");
static_assert(HS_SIZE % 16 == 0 && HC_SB % 16 == 0, "alignment");
__device__ __forceinline__ bf16x8 ldfrag16(const LAS char* tile, int ldb, int row0, int lane) {
    bf16x8 v = *(const LAS bf16x8*)(tile + (row0 + (lane & 15)) * ldb + ((lane >> 4) & 1) * 16);
    if (lane >= 32) v = (bf16x8){0, 0, 0, 0, 0, 0, 0, 0};
    return v;
}
__device__ __forceinline__ void scan_hgrn_c(int wv, KP Pk, int layer, int unit, LAS char* lds) {
    asm volatile("" : "+s"(Pk));
    const CAS Params& P = *Pk;
    const int tid = ltid(wv), lane = tid & 63, wid = tid >> 6, q = lane >> 4, r16 = lane & 15, i_ = layer >> 1;
    const int seq = unit >> 2, quarter = unit & 3, b = seq >> 3, h = (seq >> 1) & 3, dir = seq & 1;
    const bf16_t* Pb = (const bf16_t*)(P.ws + WS_P);
    bf16_t* Y = (bf16_t*)(P.ws + (dir ? WS_YB : WS_YF));
    LAS float* cst = (LAS float*)(lds + HC_CST);
    if (tid < 128) cst[tid] = ((const float*)(P.ws + WS_LB))[layer * 512 + h * 128 + tid];
    else if (tid < 256) cst[tid] = P.hg_f_bias[(size_t)(i_ * 2 + dir) * 512 + h * 128 + tid - 128];
    for (int i = tid; i < 2 * 32 * HL_QD / 4; i += NT) ((LAS unsigned*)(lds + HC_SB))[i] = 0u;
    int tj[5], tg_[5], tcol[5]; bool tv[5];
#pragma unroll
    for (int s = 0; s < 5; ++s) {
        const int task = tid + NT * s; tv[s] = task < 64 * 36; tj[s] = task / 36; tg_[s] = task % 36;
        const int g = tg_[s];
        tcol[s] = g < 16 ? (512 + dir * 512 + h * 128 + 8 * g) : g < 32 ? (h * 128 + 8 * (g - 16)) : (1536 + h * 128 + quarter * 32 + 8 * (g - 32));
    }
    u32x4 rc[5]; int rrow = 0;
    auto load = [&](int c) {
#pragma unroll
        for (int s = 0; s < 5; ++s) {
            rc[s] = (u32x4){0u, 0u, 0u, 0u};
            if (tv[s]) { const int row = scan_row(c * 64 + tj[s], b, dir, 1); rc[s] = *(const u32x4*)(Pb + (size_t)row * LDP_ODD + tcol[s]); }
        }
        if (tid < 64) rrow = scan_row(c * 64 + tid, b, dir, 1);
    };
    auto storeA = [&]() {
#pragma unroll
        for (int s = 0; s < 5; ++s) {
            if (tv[s]) {
                float f[8]; unpack8(rc[s], f);
                const int j = tj[s], g = tg_[s];
                if (g < 16) {
                    float o[8];
#pragma unroll
                    for (int e = 0; e < 8; ++e) { const float lbv = cst[8 * g + e]; o[e] = lbv + (1.f - lbv) * sigmoidf_(f[e] + cst[128 + 8 * g + e]); }
                    LAS float* dst = (LAS float*)(lds + HC_RAWF) + j * 128 + 8 * g;
                    *(LAS f32x4*)dst = (f32x4){o[0], o[1], o[2], o[3]}; *(LAS f32x4*)(dst + 4) = (f32x4){o[4], o[5], o[6], o[7]};
                } else if (g < 32) {
                    float o[8];
#pragma unroll
                    for (int e = 0; e < 8; ++e) o[e] = siluf_(f[e]);
                    *(LAS u32x4*)(lds + HC_RAWQ + (j * 128 + 8 * (g - 16)) * 2) = pack8(o);
                } else {
                    const int v0 = 8 * (g - 32);
                    LAS char* vt = lds + HC_SUB + (j >> 4) * HS_SIZE + HS_VT;
#pragma unroll
                    for (int e = 0; e < 8; ++e) { const unsigned wv = rc[s][e >> 1]; *(LAS bf16_t*)(vt + (v0 + e) * HL_T + (j & 15) * 2) = (bf16_t)((e & 1) ? (wv >> 16) : (wv & 0xffffu)); }
                }
            }
        }
        if (tid < 64) ((LAS int*)(lds + HC_ROWS))[tid] = rrow;
    };
    auto storeB = [&]() {
        const int d = tid & 127, sb = tid >> 7;
        LAS char* st = lds + HC_SUB + sb * HS_SIZE;
        const LAS float* rf = (const LAS float*)(lds + HC_RAWF) + (sb * 16) * 128 + d;
        const LAS bf16_t* rq = (const LAS bf16_t*)(lds + HC_RAWQ) + (sb * 16) * 128 + d;
        float lam = 0.f, lams[16], kfs[16];
#pragma unroll
        for (int t = 0; t < 16; ++t) {
            const float f = rf[t * 128];
            lam += __logf(f);
            const float kf = 1.f - f;
            lams[t] = lam; kfs[t] = kf;
            *(LAS bf16_t*)(st + HS_QI + t * HL_QD + d * 2) = f2bf(bf2f(rq[t * 128]) * __expf(lam));
            *(LAS bf16_t*)(st + HS_KO + t * HL_QD + d * 2) = f2bf(kf * __expf(-lam));
        }
        float ke[16];
#pragma unroll
        for (int t = 0; t < 16; ++t) ke[t] = kfs[t] * __expf(lam - lams[t]);
        *(LAS u32x4*)(st + HS_KET + d * HL_T) = pack8(ke); *(LAS u32x4*)(st + HS_KET + d * HL_T + 16) = pack8(ke + 8);
        ((LAS float*)(st + HS_DEC))[d] = __expf(lam);
    };
    f32x4 sacc[2];
    sacc[0] = sacc[1] = (f32x4){0.f, 0.f, 0.f, 0.f};
    __syncthreads();
    load(0);
    for (int c = 0; c < NSTEPS / 64; ++c) {
        storeA();
        __syncthreads();
        storeB();
        if (c + 1 < NSTEPS / 64) load(c + 1);
        __syncthreads();
        if (wid < 4) {
            LAS char* st = lds + HC_SUB + wid * HS_SIZE;
            f32x4 acc = (f32x4){0.f, 0.f, 0.f, 0.f};
#pragma unroll
            for (int k0 = 0; k0 < 128; k0 += 32) acc = __builtin_amdgcn_mfma_f32_16x16x32_bf16(ldfrag(st + HS_KO, HL_QD, 0, k0, lane), ldfrag(st + HS_QI, HL_QD, 0, k0, lane), acc, 0, 0, 0);
#pragma unroll
            for (int j = 0; j < 4; ++j) acc[j] = (4 * q + j <= r16) ? acc[j] : 0.f;
            st4bf(st + HS_ATT + r16 * HL_T + 4 * q * 2, acc);
        }
        __syncthreads();
#pragma unroll 1
        for (int sb = 0; sb < 4; ++sb) {
            LAS char* st = lds + HC_SUB + sb * HS_SIZE;
            const LAS char* sbr = lds + HC_SB + (sb & 1) * 32 * HL_QD;
            LAS char* sbw = lds + HC_SB + ((sb + 1) & 1) * 32 * HL_QD;
            if (wid < 2) {
                f32x4 ya = __builtin_amdgcn_mfma_f32_16x16x32_bf16(ldfrag16(st + HS_VT, HL_T, wid * 16, lane), ldfrag16(st + HS_ATT, HL_T, 0, lane), (f32x4){0.f, 0.f, 0.f, 0.f}, 0, 0, 0);
#pragma unroll
                for (int k0 = 0; k0 < 128; k0 += 32) ya = __builtin_amdgcn_mfma_f32_16x16x32_bf16(ldfrag(sbr, HL_QD, wid * 16, k0, lane), ldfrag(st + HS_QI, HL_QD, 0, k0, lane), ya, 0, 0, 0);
                const int row = ((const LAS int*)(lds + HC_ROWS))[sb * 16 + r16];
                u32x2 o; o.x = pk2(ya[0], ya[1]); o.y = pk2(ya[2], ya[3]);
                *(u32x2*)(Y + (size_t)row * D + h * 128 + quarter * 32 + wid * 16 + 4 * q) = o;
            }
            {
                const int vt = wid >> 2;
                const bf16x8 vf = ldfrag16(st + HS_VT, HL_T, vt * 16, lane);
#pragma unroll
                for (int u = 0; u < 2; ++u) {
                    const int dt = (wid & 3) * 2 + u;
                    const f32x4 a = __builtin_amdgcn_mfma_f32_16x16x32_bf16(ldfrag16(st + HS_KET, HL_T, dt * 16, lane), vf, (f32x4){0.f, 0.f, 0.f, 0.f}, 0, 0, 0);
                    const f32x4 dc = *(const LAS f32x4*)((const LAS float*)(st + HS_DEC) + dt * 16 + 4 * q);
#pragma unroll
                    for (int j = 0; j < 4; ++j) sacc[u][j] = sacc[u][j] * dc[j] + a[j];
                    st4bf(sbw + (vt * 16 + r16) * HL_QD + (dt * 16 + 4 * q) * 2, sacc[u]);
                }
            }
            __syncthreads();
        }
    }
}

constexpr int RC_RAWW = 0;
constexpr int RC_RAWA = RC_RAWW + 64 * 64 * 4;
constexpr int RC_RAWB = RC_RAWA + 64 * 64 * 2, RC_RAWK = RC_RAWB + 64 * 64 * 2, RC_RAWR = RC_RAWK + 64 * 64 * 2;
constexpr int RC_SUB = RC_RAWR + 64 * 64 * 2;
constexpr int RL_C = 72 * 2, RL_32 = 40 * 2, RL_16 = 24 * 2;
constexpr int RS_AT = 0, RS_RT = RS_AT + 16 * RL_C, RS_KT = RS_RT + 16 * RL_C, RS_BT = RS_KT + 16 * RL_C, RS_KBH = RS_BT + 16 * RL_C, RS_AAK = RS_KBH + 64 * RL_32,
              RS_ARKB = RS_AAK + 16 * RL_16, RS_T = RS_ARKB + 16 * RL_32, RS_AABF = RS_T + 16 * RL_16, RS_GL = RS_AABF + 16 * 16 * 4, RS_VU = RS_GL + 256, RS_SIZE = RS_VU + 32 * RL_32;
constexpr int RC_SB = RC_SUB + 4 * RS_SIZE;
constexpr int RC_RHT = RC_SB + 32 * RL_C;
constexpr int RC_ROWS = RC_RHT + 32 * RL_16, RC_END = RC_ROWS + 256;
static_assert(RC_END <= LDS_BYTES - 16, "RWKV LDS map");
static_assert(RS_SIZE % 16 == 0 && RC_SB % 16 == 0 && RC_RHT % 16 == 0, "alignment");

__device__ __forceinline__ float allreduce8(float v) {
    v += dppmov<0xB1>(v); v += dppmov<0x4E>(v); v += dppmov<0x141>(v);
    return v;
}

__device__ __forceinline__ void phase_prep1(int wv, KP Pk, int layer) {
    asm volatile("" : "+s"(Pk));
    const CAS Params& P = *Pk;
    const int tid = ltid(wv), lane = tid & 63, wid = tid >> 6, i_ = layer >> 1;
    const bf16_t* Pb = (const bf16_t*)(P.ws + WS_P);
    bf16_t* R = (bf16_t*)(P.ws + WS_RWR); bf16_t* K = (bf16_t*)(P.ws + WS_RWK); bf16_t* V = (bf16_t*)(P.ws + WS_RWV); bf16_t* KK = (bf16_t*)(P.ws + WS_RWKK);
    bf16_t* LA = (bf16_t*)(P.ws + WS_LA);
    const float* mu = P.rw_mu + (size_t)i_ * 1856;
    float mur[8], muv[8], muk[8], mul_[8], kkw[8];
#pragma unroll
    for (int e = 0; e < 8; ++e) { mur[e] = mu[8 * lane + e]; muv[e] = mu[1024 + 8 * lane + e]; muk[e] = mu[512 + 8 * lane + e]; mul_[e] = lane < 40 ? mu[1536 + 8 * lane + e] : 0.f; kkw[e] = P.rw_k_k[i_ * 512 + 8 * lane + e]; }
    for (int r = blockIdx.x * 8 + wid; r < NROWS; r += gridDim.x * 8) {
        int rprev = -1, rnext = -1;
        if (r < NCTX) { const int t = r & 255; if (t > 0) rprev = r - 1; if (t < CTXL - 1) rnext = r + 1; }
        else {
            const int bs = (r - NCTX) >> 13, s = (r - NCTX) & 8191, sg = ((s & 63) << 7) + (s >> 6);
            if (sg > 0) { const int g2 = sg - 1; rprev = NCTX + bs * SEQ + ((g2 & 127) << 6) + (g2 >> 7); }
            if (sg < SEQ - 1) { const int g2 = sg + 1; rnext = NCTX + bs * SEQ + ((g2 & 127) << 6) + (g2 >> 7); }
        }
        const bf16_t* pc = Pb + (size_t)r * LDP_ODD + 2560;
        const bf16_t* pp = Pb + (size_t)(rprev < 0 ? r : rprev) * LDP_ODD + 2560;
        const bf16_t* pn = Pb + (size_t)(rnext < 0 ? r : rnext) * LDP_ODD + 2560;
        const float mp = rprev < 0 ? 0.f : 0.5f, mn = rnext < 0 ? 0.f : 0.5f;
        auto mix8 = [&](int col, const float* muc, float* o) {
            float fc[8], fp[8], fn[8];
            unpack8(*(const u32x4*)(pc + col), fc); unpack8(*(const u32x4*)(pp + col), fp); unpack8(*(const u32x4*)(pn + col), fn);
#pragma unroll
            for (int e = 0; e < 8; ++e) o[e] = fc[e] + muc[e] * (mp * fp[e] + mn * fn[e] - fc[e]);
        };
        float o[8];
        mix8(8 * lane, mur, o); *(u32x4*)(R + (size_t)r * 512 + 8 * lane) = pack8(o);
        mix8(1024 + 8 * lane, muv, o); *(u32x4*)(V + (size_t)r * 512 + 8 * lane) = pack8(o);
        mix8(512 + 8 * lane, muk, o); *(u32x4*)(K + (size_t)r * 512 + 8 * lane) = pack8(o);
        {
            float kk[8], ss = 0.f;
#pragma unroll
            for (int e = 0; e < 8; ++e) { kk[e] = o[e] * kkw[e]; ss += kk[e] * kk[e]; }
            ss = group_sum<8>(ss);
            const float rn = rsqrtf(fmaxf(ss, 1e-12f));
#pragma unroll
            for (int e = 0; e < 8; ++e) kk[e] *= rn;
            *(u32x4*)(KK + (size_t)r * 512 + 8 * lane) = pack8(kk);
        }
        if (lane < 40) {
            mix8(1536 + 8 * lane, mul_, o);
            if (lane < 16) {
#pragma unroll
                for (int e = 0; e < 8; ++e) o[e] = tanh_fast(o[e]);
            } else if (lane >= 24) {
#pragma unroll
                for (int e = 0; e < 8; ++e) o[e] = sigmoidf_(o[e]);
            }
            *(u32x4*)(LA + (size_t)r * 320 + 8 * lane) = pack8(o);
        }
    }
}

__device__ __forceinline__ void phase_out_even(int wv, KP Pk, int layer) {
    asm volatile("" : "+s"(Pk));
    const CAS Params& P = *Pk;
    const int tid = ltid(wv), lane = tid & 63, wid = tid >> 6, i_ = layer >> 1;
    const bf16_t* Pb = (const bf16_t*)(P.ws + WS_P);
    const bf16_t* Yf = (const bf16_t*)(P.ws + WS_YF); const bf16_t* Yb = (const bf16_t*)(P.ws + WS_YB);
    bf16_t* feat = (bf16_t*)(P.ws + WS_FEAT);
    const int r0 = (layer == DEPTH - 1) ? NCTX : 0;
    const bf16_t* XBC = (const bf16_t*)(P.ws + WS_EXBC);
    float nwa[8], nwb[8];
#pragma unroll
    for (int e = 0; e < 8; ++e) { nwa[e] = P.ssd_norm_w[i_ * 512 + 8 * lane + e]; nwb[e] = P.ml_norm_w[i_ * 512 + 8 * lane + e]; }
    const float dsk = P.ssd_d[i_ * 8 + (lane >> 3)];
    for (int r = r0 + blockIdx.x * 8 + wid; r < NROWS; r += gridDim.x * 8) {
        const bf16_t* pr = Pb + (size_t)r * LDP_EVEN;
        float y[8];
        {
            float a[8], bb[8], xsv[8], z[8];
            unpack8(*(const u32x4*)(Yf + (size_t)r * D + 8 * lane), a); unpack8(*(const u32x4*)(Yb + (size_t)r * D + 8 * lane), bb);
            unpack8(*(const u32x4*)(XBC + (size_t)r * 768 + 8 * lane), xsv); unpack8(*(const u32x4*)(pr + 8 * lane), z);
            float ss = 0.f;
#pragma unroll
            for (int e = 0; e < 8; ++e) {
                y[e] = (a[e] + bb[e] + dsk * xsv[e]) * siluf_(z[e]); ss += y[e] * y[e];
            }
            ss = wave_sum(ss);
            const float rn = rsqrtf(ss * (1.f / 512.f) + 1e-6f);
#pragma unroll
            for (int e = 0; e < 8; ++e) y[e] = y[e] * rn * nwa[e];
            *(u32x4*)(feat + (size_t)r * D + 8 * lane) = pack8(y);
        }
        {
            float a[8], bb[8], o[8];
            unpack8(*(const u32x4*)(Yf + (size_t)r * D + 512 + 8 * lane), a); unpack8(*(const u32x4*)(Yb + (size_t)r * D + 512 + 8 * lane), bb);
            unpack8(*(const u32x4*)(pr + 2320 + 8 * lane), o);
            float s = 0.f;
#pragma unroll
            for (int e = 0; e < 8; ++e) { y[e] = a[e] + bb[e]; s += y[e]; }
            const float mean = group_sum<16>(s) * (1.f / 128.f);
            float ss = 0.f;
#pragma unroll
            for (int e = 0; e < 8; ++e) { y[e] -= mean; ss += y[e] * y[e]; }
            const float rn = rsqrtf(group_sum<16>(ss) * (1.f / 128.f) + 1e-6f);
#pragma unroll
            for (int e = 0; e < 8; ++e) y[e] = sigmoidf_(o[e]) * (y[e] * rn) * nwb[e];
            *(u32x4*)(feat + (size_t)r * D + 512 + 8 * lane) = pack8(y);
        }
    }
}
__device__ __forceinline__ void phase_out_odd(int wv, KP Pk, int layer) {
    asm volatile("" : "+s"(Pk));
    const CAS Params& P = *Pk;
    const int tid = ltid(wv), lane = tid & 63, wid = tid >> 6, i_ = layer >> 1;
    const bf16_t* Pb = (const bf16_t*)(P.ws + WS_P);
    const bf16_t* Yf = (const bf16_t*)(P.ws + WS_YF); const bf16_t* Yb = (const bf16_t*)(P.ws + WS_YB);
    const bf16_t* R = (const bf16_t*)(P.ws + WS_RWR); const bf16_t* K = (const bf16_t*)(P.ws + WS_RWK); const bf16_t* V = (const bf16_t*)(P.ws + WS_RWV); const bf16_t* G = (const bf16_t*)(P.ws + WS_RWG);
    bf16_t* feat = (bf16_t*)(P.ws + WS_FEAT);
    const int r0 = (layer == DEPTH - 1) ? NCTX : 0;
    float nwc[8], rk[8], lw[8], lbv[8];
#pragma unroll
    for (int e = 0; e < 8; ++e) {
        nwc[e] = P.hg_norm_w[i_ * 512 + 8 * lane + e]; rk[e] = P.rw_r_k[i_ * 512 + 8 * lane + e];
        lw[e] = P.rw_ln_w[i_ * 512 + 8 * lane + e]; lbv[e] = P.rw_ln_b[i_ * 512 + 8 * lane + e];
    }
    for (int r = r0 + blockIdx.x * 8 + wid; r < NROWS; r += gridDim.x * 8) {
        float y[8];
        {
            float a[8], bb[8], g[8];
            unpack8(*(const u32x4*)(Yf + (size_t)r * D + 8 * lane), a); unpack8(*(const u32x4*)(Yb + (size_t)r * D + 8 * lane), bb);
            unpack8(*(const u32x4*)(Pb + (size_t)r * LDP_ODD + 2048 + 8 * lane), g);
            float ss = 0.f;
#pragma unroll
            for (int e = 0; e < 8; ++e) { y[e] = a[e] + bb[e]; ss += y[e] * y[e]; }
            const float rn = rsqrtf(group_sum<16>(ss) * (1.f / 128.f) + 1e-6f);
#pragma unroll
            for (int e = 0; e < 8; ++e) y[e] = y[e] * rn * nwc[e] * siluf_(g[e]);
            *(u32x4*)(feat + (size_t)r * D + 8 * lane) = pack8(y);
        }
        {
            float a[8], bb[8], rr[8], kk[8], vv[8], g[8];
            unpack8(*(const u32x4*)(Yf + (size_t)r * D + 512 + 8 * lane), a); unpack8(*(const u32x4*)(Yb + (size_t)r * D + 512 + 8 * lane), bb);
            unpack8(*(const u32x4*)(R + (size_t)r * 512 + 8 * lane), rr); unpack8(*(const u32x4*)(K + (size_t)r * 512 + 8 * lane), kk);
            unpack8(*(const u32x4*)(V + (size_t)r * 512 + 8 * lane), vv); unpack8(*(const u32x4*)(G + (size_t)r * 512 + 8 * lane), g);
            float s = 0.f, bs = 0.f;
#pragma unroll
            for (int e = 0; e < 8; ++e) { y[e] = a[e] + bb[e]; s += y[e]; bs += rr[e] * kk[e] * rk[e]; }
            const float mean = group_sum<8>(s) * (1.f / 64.f); bs = group_sum<8>(bs);
            float ss = 0.f;
#pragma unroll
            for (int e = 0; e < 8; ++e) { y[e] -= mean; ss += y[e] * y[e]; }
            const float rn = rsqrtf(group_sum<8>(ss) * (1.f / 64.f) + 64e-5f);
#pragma unroll
            for (int e = 0; e < 8; ++e) y[e] = (y[e] * rn * lw[e] + lbv[e] + bs * vv[e]) * g[e];
            *(u32x4*)(feat + (size_t)r * D + 512 + 8 * lane) = pack8(y);
        }
    }
}

#ifndef MK_DOUBLE
#define MK_DOUBLE 0
#endif
#define REP(bit, body) do { body; if (MK_DOUBLE & (bit)) { body; } } while (0)
__device__ __forceinline__ void phase_expconv(int wv, KP Pk, int layer, LAS char* lds) {
    asm volatile("" : "+s"(Pk));
    const CAS Params& P = *Pk;
    const int tid = ltid(wv);
    if (layer & 1) return;
    expconv_items(P, layer, lds, exc_s0(layer) + exc_s1(layer), EXC_ITEMS, (int)blockIdx.x * 8 + (tid >> 6), (int)gridDim.x * 8, tid >> 6, tid & 63);
}
__device__ __forceinline__ void expconv_after_scan(int wv, KP Pk, int layer, LAS char* lds) {
    asm volatile("" : "+s"(Pk));
    const CAS Params& P = *Pk;
    const int tid = ltid(wv);
    __syncthreads();
    expconv_items(P, layer, lds, exc_s0(layer) + exc_s1(layer), EXC_ITEMS, (int)blockIdx.x * 8 + (tid >> 6), 128 * 8, tid >> 6, tid & 63);
}
constexpr int L1_AST = 1028;
constexpr int L1_PST = 33;
constexpr int L1_A = 0, L1_PART = L1_A + 16 * L1_AST * 4, L1_SM = L1_PART + 8 * 16 * L1_PST * 4, L1_END = L1_SM + (64 + 2 * 144 + 32) * 4;
static_assert(L1_END <= LDS_BYTES - 16, "LN1 LDS map");
__device__ __forceinline__ void phase_ln1(int wv, KP Pk, int layer, LAS char* lds, bool dry = false) {
    asm volatile("" : "+s"(Pk));
    const CAS Params& P = *Pk;
    const int tid = ltid(wv), lane = tid & 63;
    if (!dry) REP(8, phase_expconv(wv, Pk, layer, lds));
    __syncthreads();
    LAS float* At = (LAS float*)(lds + L1_A);
    LAS float* part = (LAS float*)(lds + L1_PART);
    LAS int* lcnt = (LAS int*)(lds + L1_SM);
    LAS int* lbase = lcnt + 32;
    LAS int* asg = lcnt + 64;
    LAS float* rbias = (LAS float*)(asg + 2 * 144);
    if (tid < 32) { lcnt[tid] = 0; rbias[tid] = P.router_bias[tid]; }
    float breg[8][4][2];
    {
        const float* rw = P.router_w + (size_t)(128 * wv + 4 * (lane >> 4)) * NEXP + (lane & 15);
#pragma unroll
        for (int j = 0; j < 8; ++j)
#pragma unroll
            for (int i = 0; i < 4; ++i) { breg[j][i][0] = rw[(16 * j + i) * NEXP]; breg[j][i][1] = rw[(16 * j + i) * NEXP + 16]; }
    }
    __syncthreads();
    const bf16_t* yo = (const bf16_t*)(P.ws + WS_YO);
    bf16_t* act = (bf16_t*)(P.ws + (dry ? WS_FEAT : WS_ACT));
    bf16_t* xcb = (bf16_t*)(P.ws + WS_XC); bf16_t* xob = (bf16_t*)P.out;
    const bool lastl = (layer == DEPTH - 1);
    int* cnt = (int*)(P.ws + WS_CNT) + layer * 32 * CNT_STRIDE;
    int* list = (int*)(P.ws + WS_LIST);
    float* wts = (float*)(P.ws + WS_WTS);
    const float* lg = P.ln_g + (size_t)(layer * 2 + 0) * D; const float* lb = P.ln_b + (size_t)(layer * 2 + 0) * D;
    const int r0 = (layer == DEPTH - 1) ? NCTX : 0, ntiles = (NROWS - r0) / 16, G = gridDim.x;
    f32x4 g1v[4], s2c[4], h2c[4];
#pragma unroll
    for (int i = 0; i < 4; ++i) g1v[i] = s2c[i] = h2c[i] = (f32x4){0.f, 0.f, 0.f, 0.f};
    int mcur = -1;
    f32x4 nx[2][4]; u32x2 nyo[2][4];
    auto fetch = [&](int s, int rr) {
        if (layer == 0) {
            const float* xq = rr < NCTX ? P.ctx + (size_t)rr * D : P.x + (size_t)(rr - NCTX) * D;
#pragma unroll
            for (int i = 0; i < 4; ++i) nx[s][i] = *(const f32x4*)(xq + 4 * lane + 256 * i);
        } else {
            const bf16_t* xq = rr < NCTX ? xcb + (size_t)rr * D : xob + (size_t)(rr - NCTX) * D;
#pragma unroll
            for (int i = 0; i < 4; ++i) { const u32x2 t = *(const u32x2*)(xq + 4 * lane + 256 * i); nx[s][i] = (f32x4){__uint_as_float(t.x), __uint_as_float(t.y), 0.f, 0.f}; }
        }
#pragma unroll
        for (int i = 0; i < 4; ++i) { const int c = 4 * lane + 256 * i; nyo[s][i] = *(const u32x2*)(yo + (size_t)rr * D + c); }
    };
    int tile = blockIdx.x;
    if (tile < ntiles) { fetch(0, r0 + tile * 16 + 2 * wv); fetch(1, r0 + tile * 16 + 2 * wv + 1); }
    for (int it = 0; tile < ntiles; ++it, tile += G) {
        const int rb = r0 + tile * 16 + 2 * wv;
        const int m = row_mod(rb);
        if (m != mcur) {
            mcur = m;
            const float* g1 = modvec(P.ws, layer, m, 2); const float* sh2 = modvec(P.ws, layer, m, 3); const float* sc2 = modvec(P.ws, layer, m, 4);
#pragma unroll
            for (int i = 0; i < 4; ++i) { const int c = 4 * lane + 256 * i; g1v[i] = *(const f32x4*)(g1 + c); s2c[i] = *(const f32x4*)(sc2 + c); h2c[i] = *(const f32x4*)(sh2 + c); }
        }
#pragma unroll
        for (int s = 0; s < 2; ++s) {
            const int r = rb + s;
            bf16_t* xr = dry ? (bf16_t*)(P.ws + WS_YF) + (size_t)r * D : lastl ? (bf16_t*)(P.ws + WS_FEAT) + (size_t)r * D : r < NCTX ? xcb + (size_t)r * D : xob + (size_t)(r - NCTX) * D;
            f32x4 v[4]; float sm = 0.f;
#pragma unroll
            for (int i = 0; i < 4; ++i) {
                f32x4 xv = nx[s][i]; const f32x4 gv = g1v[i]; const u32x2 yv = nyo[s][i];
                if (layer != 0) { const unsigned b0 = __float_as_uint(xv[0]), b1 = __float_as_uint(xv[1]); xv = (f32x4){bflo(b0), bfhi(b0), bflo(b1), bfhi(b1)}; }
                v[i][0] = ALPHA * xv[0] + gv[0] * bflo(yv.x); v[i][1] = ALPHA * xv[1] + gv[1] * bfhi(yv.x);
                v[i][2] = ALPHA * xv[2] + gv[2] * bflo(yv.y); v[i][3] = ALPHA * xv[3] + gv[3] * bfhi(yv.y);
                sm += (v[i][0] + v[i][1]) + (v[i][2] + v[i][3]);
            }
            if (tile + G < ntiles) fetch(s, r + G * 16);
            const float mean = wave_sum(sm) * (1.f / D);
            float s2 = 0.f;
#pragma unroll
            for (int i = 0; i < 4; ++i) { v[i] = v[i] - mean; s2 += (v[i][0] * v[i][0] + v[i][1] * v[i][1]) + (v[i][2] * v[i][2] + v[i][3] * v[i][3]); }
            const float rstd = rsqrtf(wave_sum(s2) * (1.f / D) + 1e-5f);
            LAS float* arow = At + (2 * wv + s) * L1_AST;
#pragma unroll
            for (int i = 0; i < 4; ++i) {
                const int c = 4 * lane + 256 * i;
                const f32x4 gg = *(const f32x4*)(lg + c), bb = *(const f32x4*)(lb + c), s2v = s2c[i], h2v = h2c[i];
                f32x4 xn, hv;
#pragma unroll
                for (int j = 0; j < 4; ++j) { xn[j] = v[i][j] * rstd * gg[j] + bb[j]; hv[j] = xn[j] * (1.f + s2v[j]) + h2v[j]; }
                { u32x2 ox; ox.x = pk2(xn[0], xn[1]); ox.y = pk2(xn[2], xn[3]); *(u32x2*)(xr + c) = ox; }
                u32x2 o; o.x = pk2(hv[0], hv[1]); o.y = pk2(hv[2], hv[3]); *(u32x2*)(act + (size_t)r * D + c) = o;
                *(LAS f32x4*)(arow + c) = hv;
            }
        }
        __syncthreads();
        {
            f32x4 ra0 = (f32x4){0.f, 0.f, 0.f, 0.f}, ra1 = ra0;
            const LAS float* ap = At + (lane & 15) * L1_AST + 128 * wv + 4 * (lane >> 4);
#pragma unroll
            for (int j = 0; j < 8; ++j) {
                const f32x4 a4 = *(const LAS f32x4*)(ap + 16 * j);
#pragma unroll
                for (int i = 0; i < 4; ++i) {
                    ra0 = __builtin_amdgcn_mfma_f32_16x16x4f32(a4[i], breg[j][i][0], ra0, 0, 0, 0);
                    ra1 = __builtin_amdgcn_mfma_f32_16x16x4f32(a4[i], breg[j][i][1], ra1, 0, 0, 0);
                }
            }
            LAS float* pw = part + wv * 16 * L1_PST + (4 * (lane >> 4)) * L1_PST + (lane & 15);
#pragma unroll
            for (int j = 0; j < 4; ++j) { pw[j * L1_PST] = ra0[j]; pw[j * L1_PST + 16] = ra1[j]; }
        }
        __syncthreads();
        {
            const int half = lane >> 5, e = lane & 31;
            const LAS float* pp = part + (2 * wv + half) * L1_PST + e;
            float sc_ = 0.f;
#pragma unroll
            for (int k = 0; k < 8; ++k) sc_ += pp[k * 16 * L1_PST];
            const float sg = sigmoidf_(sc_), vb = sg + rbias[e];
            float bv[4], sv[4];
            bv[0] = dppmov<0x00>(vb); bv[1] = dppmov<0x55>(vb); bv[2] = dppmov<0xAA>(vb); bv[3] = dppmov<0xFF>(vb);
            sv[0] = dppmov<0x00>(sg); sv[1] = dppmov<0x55>(sg); sv[2] = dppmov<0xAA>(sg); sv[3] = dppmov<0xFF>(sg);
            float m1 = -1e30f, m2 = -1e30f;
#pragma unroll
            for (int k = 0; k < 4; ++k) { const float vsc = bv[k]; if (vsc > m1) { m2 = m1; m1 = vsc; } else if (vsc > m2) m2 = vsc; }
            float best = m1 + m2; int bg = e >> 2;
#pragma unroll
            for (int msk = 4; msk <= 16; msk <<= 1) {
                const float ob = __shfl_xor(best, msk); const int og = __shfl_xor(bg, msk);
                const bool take = (ob > best) || (ob == best && og < bg);
                best = take ? ob : best; bg = take ? og : bg;
            }
            int i1 = 0; float b1 = bv[0];
#pragma unroll
            for (int k = 1; k < 4; ++k) if (bv[k] > b1) { b1 = bv[k]; i1 = k; }
            int i2 = -1; float b2 = -1e30f;
#pragma unroll
            for (int k = 0; k < 4; ++k) if (k != i1 && bv[k] > b2) { b2 = bv[k]; i2 = k; }
            float s1 = sv[0], s2s = sv[0];
#pragma unroll
            for (int k = 1; k < 4; ++k) { if (i1 == k) s1 = sv[k]; if (i2 == k) s2s = sv[k]; }
            if (e == 4 * bg && !dry) {
                const int r = rb + half;
                const int e0 = bg * 4 + i1, e1 = bg * 4 + i2;
                const float inv = 1.f / (s1 + s2s);
                const int li = it * 16 + 2 * wv + half;
                const int p0 = __hip_atomic_fetch_add(&lcnt[e0], 1, __ATOMIC_RELAXED, __HIP_MEMORY_SCOPE_WORKGROUP);
                const int p1 = __hip_atomic_fetch_add(&lcnt[e1], 1, __ATOMIC_RELAXED, __HIP_MEMORY_SCOPE_WORKGROUP);
                asg[2 * li] = (e0 << 16) | p0; asg[2 * li + 1] = (e1 << 16) | p1;
                wts[2 * r] = s1 * inv; wts[2 * r + 1] = s2s * inv;
            }
        }
    }
    __syncthreads();
    if (dry) return;
    if (tid < 32) lbase[tid] = atomicAdd(&cnt[tid * CNT_STRIDE], lcnt[tid]);
    __syncthreads();
    for (int idx = tid; idx < 2 * 144; idx += NT) {
        const int li = idx >> 1, k = idx & 1, t = (li >> 4) * G + blockIdx.x;
        if (t < ntiles) { const int r = r0 + t * 16 + (li & 15); const int v = asg[idx], e = v >> 16, lp = v & 0xffff; list[(size_t)e * LISTCAP + lbase[e] + lp] = 2 * r + k; }
    }
}

__device__ __forceinline__ void phase_ln2(int wv, KP Pk, int layer, bool dry = false) {
    asm volatile("" : "+s"(Pk));
    const CAS Params& P = *Pk;
    const int tid = ltid(wv), lane = tid & 63, wid = tid >> 6;
    const bf16_t* yp = (const bf16_t*)(P.ws + WS_YP);
    const float* wts = (const float*)(P.ws + WS_WTS);
    bf16_t* act = (bf16_t*)(P.ws + (dry ? WS_FEAT : WS_ACT));
    bf16_t* xcb = (bf16_t*)(P.ws + WS_XC); bf16_t* xob = (bf16_t*)P.out;
    const float* lg = P.ln_g + (size_t)(layer * 2 + 1) * D; const float* lb = P.ln_b + (size_t)(layer * 2 + 1) * D;
    const bool last = (layer == DEPTH - 1);
    const int r0 = last ? NCTX : 0, stride = gridDim.x * 8;
    f32x4 cg[4], cb[4], g2v[4], s1v[4], h1v[4];
#pragma unroll
    for (int i = 0; i < 4; ++i) { cg[i] = *(const f32x4*)(lg + 4 * lane + 256 * i); cb[i] = *(const f32x4*)(lb + 4 * lane + 256 * i); g2v[i] = s1v[i] = h1v[i] = (f32x4){0.f, 0.f, 0.f, 0.f}; }
    int mcur = -1;
    u32x2 nx[4]; u32x2 ny0[4], ny1[4]; float nw0 = 0.f, nw1 = 0.f;
    auto fetch = [&](int r) {
        const bf16_t* xr = last ? (const bf16_t*)(P.ws + WS_FEAT) + (size_t)r * D : r < NCTX ? xcb + (size_t)r * D : xob + (size_t)(r - NCTX) * D;
#pragma unroll
        for (int i = 0; i < 4; ++i) {
            const int c = 4 * lane + 256 * i;
            nx[i] = *(const u32x2*)(xr + c); ny0[i] = *(const u32x2*)(yp + (size_t)(2 * r) * D + c); ny1[i] = *(const u32x2*)(yp + (size_t)(2 * r + 1) * D + c);
        }
        nw0 = wts[2 * r]; nw1 = wts[2 * r + 1];
    };
    int r = r0 + blockIdx.x * 8 + wid;
    if (r < NROWS) fetch(r);
    for (; r < NROWS; r += stride) {
        const int m = row_mod(r);
        if (m != mcur) {
            mcur = m;
            const float* g2 = modvec(P.ws, layer, m, 5); const float* sh1 = last ? lg : modvec(P.ws, layer + 1, m, 0); const float* sc1 = last ? lg : modvec(P.ws, layer + 1, m, 1);
#pragma unroll
            for (int i = 0; i < 4; ++i) { const int c = 4 * lane + 256 * i; g2v[i] = *(const f32x4*)(g2 + c); s1v[i] = *(const f32x4*)(sc1 + c); h1v[i] = *(const f32x4*)(sh1 + c); }
        }
        f32x4 v[4]; float s = 0.f;
        const float w0 = nw0, w1 = nw1;
#pragma unroll
        for (int i = 0; i < 4; ++i) {
            const f32x4 xv = (f32x4){bflo(nx[i].x), bfhi(nx[i].x), bflo(nx[i].y), bfhi(nx[i].y)}, gv = g2v[i]; const u32x2 y0 = ny0[i], y1 = ny1[i];
            v[i][0] = ALPHA * xv[0] + gv[0] * (w0 * bflo(y0.x) + w1 * bflo(y1.x)); v[i][1] = ALPHA * xv[1] + gv[1] * (w0 * bfhi(y0.x) + w1 * bfhi(y1.x));
            v[i][2] = ALPHA * xv[2] + gv[2] * (w0 * bflo(y0.y) + w1 * bflo(y1.y)); v[i][3] = ALPHA * xv[3] + gv[3] * (w0 * bfhi(y0.y) + w1 * bfhi(y1.y));
            s += (v[i][0] + v[i][1]) + (v[i][2] + v[i][3]);
        }
        if (r + stride < NROWS) fetch(r + stride);
        const float mean = wave_sum(s) * (1.f / D);
        float s2 = 0.f;
#pragma unroll
        for (int i = 0; i < 4; ++i) { v[i] = v[i] - mean; s2 += (v[i][0] * v[i][0] + v[i][1] * v[i][1]) + (v[i][2] * v[i][2] + v[i][3] * v[i][3]); }
        const float rstd = rsqrtf(wave_sum(s2) * (1.f / D) + 1e-5f);
#pragma unroll
        for (int i = 0; i < 4; ++i) {
            const int c = 4 * lane + 256 * i;
            f32x4 xn;
#pragma unroll
            for (int j = 0; j < 4; ++j) xn[j] = v[i][j] * rstd * cg[i][j] + cb[i][j];
            if (dry) *(f32x4*)((float*)(P.ws + WS_YF) + (size_t)r * D + c) = xn;
            else if (last) *(f32x4*)(P.out + (size_t)(r - NCTX) * D + c) = xn;
            else { u32x2 ox; ox.x = pk2(xn[0], xn[1]); ox.y = pk2(xn[2], xn[3]); *(u32x2*)((r < NCTX ? xcb + (size_t)r * D : xob + (size_t)(r - NCTX) * D) + c) = ox; }
            if (!last) {
                u32x2 o; o.x = pk2(xn[0] * (1.f + s1v[i][0]) + h1v[i][0], xn[1] * (1.f + s1v[i][1]) + h1v[i][1]); o.y = pk2(xn[2] * (1.f + s1v[i][2]) + h1v[i][2], xn[3] * (1.f + s1v[i][3]) + h1v[i][3]);
                *(u32x2*)(act + (size_t)r * D + c) = o;
            }
        }
    }
}

constexpr int NPHASE = 2 + 11 * DEPTH;
__global__ void __launch_bounds__(NT, 2) fwd_kernel(Params P) {
    extern __shared__ __attribute__((aligned(16))) char lds_raw[];
    LAS char* lds = (LAS char*)lds_raw;
    volatile LAS unsigned* xbw = (volatile LAS unsigned*)(lds + LDS_BYTES - 16);
    KP Pk = (KP)__builtin_amdgcn_kernarg_segment_ptr();
    const int wv = __builtin_amdgcn_readfirstlane((int)(threadIdx.x >> 6));
    const bool multi = (P.ph_hi - P.ph_lo) > 1;
    XcdBarrier bar; bar.bar = (unsigned*)(P.ws + WS_BAR); bar.x = 0; bar.st = xbw;
    if (multi) {
        if (ltid(wv) == 0) { xbw[0] = 0u; xbw[1] = 0u; xbw[2] = 0u; xbw[3] = 0u; }
        __syncthreads();
        bar = xcd_barrier_post(wv, (unsigned*)(P.ws + WS_BAR), xbw);
    }
#define PHASE(id, body) do { if (P.ph_lo <= (id) && (id) < P.ph_hi) { body; if ((id) + 1 < P.ph_hi) xcd_barrier(wv, bar); if (MK_DOUBLE & 2048) xcd_barrier(wv, bar); } } while (0)
    PHASE(0, REP(16, phase_prologue0(wv, Pk, lds)));
    PHASE(1, REP(16, phase_prologue1(wv, Pk)));
    for (int l = 0; l < DEPTH; ++l) {
        const int pb = 2 + 11 * l, odd = l & 1;
        PHASE(pb + 0, REP(1, phase_inproj(wv, Pk, l, lds)));
        if (odd) {
            PHASE(pb + 1, REP(4, phase_prep1(wv, Pk, l)));
            PHASE(pb + 2, phase_prep2(wv, Pk, l, lds));
            PHASE(pb + 3, REP(32, { if (blockIdx.x < 128) { REP(64, scan_hgrn_c(wv, Pk, l, blockIdx.x, lds)); expconv_after_scan(wv, Pk, l, lds); } else if (blockIdx.x < 256) REP(128, scan_rwkv(wv, Pk, l, blockIdx.x - 128, lds)); }));
            PHASE(pb + 5, REP(4, phase_out_odd(wv, Pk, l)));
        } else {
            PHASE(pb + 1, REP(4, phase_prep_even(wv, Pk, l)));
            PHASE(pb + 2, REP(2, phase_ex1(wv, Pk, l, lds)));
            PHASE(pb + 3, phase_ex2(wv, Pk, l));
            PHASE(pb + 4, REP(2, phase_ex3(wv, Pk, l, lds)));
            PHASE(pb + 5, REP(4, phase_out_even(wv, Pk, l)));
        }
        PHASE(pb + 6, REP(256, phase_outproj(wv, Pk, l, lds)));
        PHASE(pb + 7, { if (MK_DOUBLE & 4096) phase_ln1(wv, Pk, l, lds, true); phase_ln1(wv, Pk, l, lds); });
        PHASE(pb + 8, REP(512, phase_moe1(wv, Pk, l, lds)));
        PHASE(pb + 9, REP(1024, phase_moe2(wv, Pk, l, lds)));
        PHASE(pb + 10, { if (MK_DOUBLE & 8192) phase_ln2(wv, Pk, l, true); phase_ln2(wv, Pk, l); });
    }
#undef PHASE
}


#ifndef MK_STOP
#define MK_STOP NPHASE
#endif
#ifndef MK_DUMP
#define MK_DUMP 0
#endif
#ifndef MK_DUMP_N
#define MK_DUMP_N (1u << 30)
#endif
#ifndef MK_DUMP_LD
#define MK_DUMP_LD 1024
#endif
#ifndef MK_DUMP_C0
#define MK_DUMP_C0 0
#endif
__global__ void diff_kernel(const bf16_t* a, const bf16_t* b, float* out, size_t n) {
    for (size_t i = (size_t)blockIdx.x * blockDim.x + threadIdx.x; i < n; i += (size_t)gridDim.x * blockDim.x) out[i] = 1e6f * (bf2f(a[i]) - bf2f(b[i]));
}
__global__ void dump_kernel(const bf16_t* src, float* out, size_t n) {
    for (size_t i = (size_t)blockIdx.x * blockDim.x + threadIdx.x; i < n; i += (size_t)gridDim.x * blockDim.x) out[i] = i < (size_t)MK_DUMP_N ? bf2f(src[(i >> 10) * MK_DUMP_LD + MK_DUMP_C0 + (i & 1023)]) : 0.f;
}
extern "C" void kernel_launch(void* const* d_in, const int* in_sizes, int n_in, void* d_out, int out_size, void* d_ws, size_t ws_size, hipStream_t stream) {
    static int ready = 0;
    if (ready == 0) {
        ready = 1;
        if (n_in != 42 || out_size != NB * SEQ * D || ws_size < WS_END) { fprintf(stderr, "kernel_launch: unexpected shapes (n_in %d out %d ws %zu need %zu)\n", n_in, out_size, ws_size, (size_t)WS_END); ready = -1; }
        if (hipFuncSetAttribute((const void*)fwd_kernel, hipFuncAttributeMaxDynamicSharedMemorySize, LDS_BYTES) != hipSuccess) { fprintf(stderr, "kernel_launch: hipFuncSetAttribute failed\n"); ready = -1; }
    }
    if (ready < 0) return;
    (void)in_sizes;
    hipMemsetAsync((char*)d_ws + WS_BAR, 0, WS_ZERO_BYTES, stream);
    Params p;
    memset(&p, 0, sizeof(p));
    const float** fp = (const float**)&p;
    for (int i = 0; i < 42; ++i) fp[i] = (const float*)d_in[i];
    p.out = (float*)d_out; p.ws = (unsigned char*)d_ws;
#if MK_PER_PHASE
    for (int ph = 0; ph < MK_STOP; ++ph) {
        const int local = ph < 2 ? -1 : (ph - 2) % 11, layer = ph < 2 ? 0 : (ph - 2) / 11;
        if (local == 4 && (layer & 1)) continue;
        p.ph_lo = ph; p.ph_hi = ph + 1;
        hipLaunchKernelGGL(fwd_kernel, dim3(256), dim3(NT), LDS_BYTES, stream, p);
    }
#ifdef MK_DIFF
    p.ph_lo = 7; p.ph_hi = 8; p.dbg = 1;
    hipLaunchKernelGGL(fwd_kernel, dim3(256), dim3(NT), LDS_BYTES, stream, p);
    hipLaunchKernelGGL(diff_kernel, dim3(1024), dim3(256), 0, stream, (const bf16_t*)((unsigned char*)d_ws + WS_YO), (const bf16_t*)((unsigned char*)d_ws + WS_HID), (float*)d_out, (size_t)NB * SEQ * D);
#else
    if (MK_DUMP) hipLaunchKernelGGL(dump_kernel, dim3(1024), dim3(256), 0, stream, (const bf16_t*)((unsigned char*)d_ws + (size_t)MK_DUMP), (float*)d_out, (size_t)NB * SEQ * D);
#endif
#else
    p.ph_lo = 0; p.ph_hi = NPHASE;
    hipLaunchKernelGGL(fwd_kernel, dim3(256), dim3(NT), LDS_BYTES, stream, p);
#endif
}
```

```cpp
#include <hip/hip_runtime.h>
#include <stdint.h>
#include <stdio.h>
#include <string.h>

#ifndef MK_PER_PHASE
#define MK_PER_PHASE 0
#endif

typedef unsigned short bf16_t;
typedef short bf16x8 __attribute__((ext_vector_type(8)));
typedef float f32x4 __attribute__((ext_vector_type(4)));
typedef unsigned u32x4 __attribute__((ext_vector_type(4)));
typedef unsigned u32x2 __attribute__((ext_vector_type(2)));
#define LAS __attribute__((address_space(3)))
#define CAS __attribute__((address_space(4)))

constexpr int D = 1024, NB = 4, SEQ = 8192, CTXL = 256, DEPTH = 4;
constexpr int NCTX = NB * CTXL;
constexpr int NROWS = NCTX + NB * SEQ;
constexpr int P_EVEN = 2848, P_ODD = 4416, LDP_EVEN = 3072, LDP_ODD = 4608;
constexpr int NEXP = 32, DEXP = 512, LISTCAP = NROWS;
constexpr float ALPHA = 1.681792830507429f;
constexpr int NT = 512;
constexpr int TCH = 32;
constexpr int NSTEPS = CTXL + SEQ;
constexpr int LDS_BYTES = 160 * 1024;

constexpr size_t al256(size_t x) { return (x + 255) & ~(size_t)255; }
constexpr size_t WS_BAR = 0;
constexpr size_t WS_CNT = 16384;
constexpr int CNT_STRIDE = 64;
constexpr size_t WS_ZERO_BYTES = 16384 + (size_t)4 * 32 * CNT_STRIDE * 4;
constexpr size_t WS_MODV = al256(WS_ZERO_BYTES);
constexpr size_t WS_LB = WS_MODV + al256((size_t)4 * 5 * 6144 * 4);
constexpr size_t WS_XC = WS_LB + al256(4 * 512 * 4);
constexpr size_t WS_WTS = WS_XC + (size_t)NCTX * D * 4;
constexpr size_t WS_LIST = WS_WTS + al256((size_t)2 * NROWS * 4);
constexpr size_t WS_WINT = WS_LIST + al256((size_t)NEXP * LISTCAP * 4);
constexpr size_t WINT_L0 = 0, WINT_L1 = (size_t)LDP_EVEN * D, WINT_L2 = WINT_L1 + (size_t)LDP_ODD * D, WINT_L3 = WINT_L2 + (size_t)LDP_EVEN * D, WINT_END = WINT_L3 + (size_t)LDP_ODD * D;
constexpr size_t WS_WOUTT = WS_WINT + WINT_END * 2;
constexpr size_t WS_LORAT = WS_WOUTT + (size_t)4 * D * D * 2;
constexpr size_t LORA_PER = (size_t)512 * 320;
constexpr size_t WS_EXPGU = WS_LORAT + al256(2 * LORA_PER * 2);
constexpr size_t WS_EXPD = WS_EXPGU + (size_t)NEXP * 1024 * 1024 * 2;
constexpr size_t WS_ACT = WS_EXPD + (size_t)NEXP * 1024 * 512 * 2;
constexpr size_t ROWB = (size_t)NROWS * D * 2;
constexpr size_t WS_FEAT = WS_ACT + ROWB;
constexpr size_t WS_YF = WS_FEAT + ROWB;
constexpr size_t WS_YB = WS_YF + ROWB;
constexpr size_t WS_P = WS_YB + ROWB;
constexpr size_t P_BYTES = (size_t)NROWS * LDP_ODD * 2;
constexpr size_t WS_YO = WS_P;
constexpr size_t WS_HID = WS_P + ROWB;
constexpr size_t WS_YP = WS_HID + ROWB;
static_assert(WS_YP + 2 * ROWB <= WS_P + P_BYTES, "MoE buffers must fit in the P region");
constexpr size_t HALFB = (size_t)NROWS * 512 * 2;
constexpr size_t WS_RWR = WS_P + P_BYTES;
constexpr size_t WS_RWK = WS_RWR + HALFB;
constexpr size_t WS_RWV = WS_RWK + HALFB;
constexpr size_t WS_RWKK = WS_RWV + HALFB;
constexpr size_t WS_RWB = WS_RWKK + HALFB;
constexpr size_t WS_RWG = WS_RWB + HALFB;
constexpr size_t WS_RWDEC = WS_RWG + HALFB;
constexpr size_t WS_LA = WS_RWDEC + (size_t)2 * NROWS * 512 * 4;
constexpr size_t WS_END = WS_LA + (size_t)NROWS * 320 * 2;
static_assert(WS_END <= (size_t)280602384 * 4, "workspace map exceeds the guaranteed ws_size");

struct Params {
    const float *x, *c, *ctx, *c_ctx, *mod_w, *mod_b, *ln_g, *ln_b;
    const float *ev_w_in, *ev_w_out, *ssd_conv_w, *ssd_conv_b, *ssd_dt_bias, *ssd_a_log, *ssd_d, *ssd_norm_w;
    const float *ml_conv_w, *ml_conv_b, *ml_i_bias, *ml_f_bias, *ml_norm_w;
    const float *od_w_in, *od_w_out, *hg_lb_logits, *hg_f_bias, *hg_norm_w;
    const float *rw_mu, *rw_w0, *rw_w2, *rw_a0, *rw_a2, *rw_g2, *rw_k_k, *rw_k_a, *rw_r_k, *rw_ln_w, *rw_ln_b;
    const float *router_w, *router_bias, *exp_w_gate, *exp_w_up, *exp_w_down;
    float* out;
    unsigned char* ws;
    int ph_lo, ph_hi, dbg, pad_;
};
typedef const CAS Params* KP;

__device__ __forceinline__ int ltid(int wv) { int l; asm volatile("v_mbcnt_lo_u32_b32 %0, -1, 0\n\tv_mbcnt_hi_u32_b32 %0, -1, %0" : "=v"(l)); return wv * 64 + l; }
__device__ __forceinline__ float bf2f(bf16_t h) { return __uint_as_float(((unsigned)h) << 16); }
__device__ __forceinline__ float bflo(unsigned u) { return __uint_as_float(u << 16); }
__device__ __forceinline__ float bfhi(unsigned u) { return __uint_as_float(u & 0xffff0000u); }
typedef __bf16 bf16v2_t __attribute__((ext_vector_type(2)));
typedef float f32x2 __attribute__((ext_vector_type(2)));
__device__ __forceinline__ unsigned pk2(float lo, float hi) { const f32x2 v = {lo, hi}; return __builtin_bit_cast(unsigned, __builtin_convertvector(v, bf16v2_t)); }
__device__ __forceinline__ bf16_t f2bf(float f) { return (bf16_t)(pk2(f, 0.f) & 0xffffu); }
__device__ __forceinline__ void unpack8(const u32x4& u, float* f) {
    f[0] = bflo(u.x); f[1] = bfhi(u.x); f[2] = bflo(u.y); f[3] = bfhi(u.y); f[4] = bflo(u.z); f[5] = bfhi(u.z); f[6] = bflo(u.w); f[7] = bfhi(u.w);
}
__device__ __forceinline__ u32x4 pack8(const float* f) { u32x4 u; u.x = pk2(f[0], f[1]); u.y = pk2(f[2], f[3]); u.z = pk2(f[4], f[5]); u.w = pk2(f[6], f[7]); return u; }
__device__ __forceinline__ float sigmoidf_(float x) { return __builtin_amdgcn_rcpf(1.f + __expf(-x)); }
__device__ __forceinline__ float siluf_(float x) { return x * __builtin_amdgcn_rcpf(1.f + __expf(-x)); }
__device__ __forceinline__ float softplus_fast(float x) { return x > 20.f ? x : __logf(1.f + __expf(x)); }
__device__ __forceinline__ float tanh_fast(float x) { return 1.f - 2.f * __builtin_amdgcn_rcpf(1.f + __expf(2.f * x)); }
__device__ __forceinline__ float softplusf_(float x) { return x > 20.f ? x : __logf(1.f + __expf(x)); }
__device__ __forceinline__ float logsigmoidf_(float x) { return fminf(x, 0.f) - __logf(1.f + __expf(-fabsf(x))); }
template <int CTRL> __device__ __forceinline__ float dppmov(float v) {
    return __builtin_bit_cast(float, __builtin_amdgcn_update_dpp(0, __builtin_bit_cast(int, v), CTRL, 0xf, 0xf, true));
}
__device__ __forceinline__ float allreduce16(float v) {
    v += dppmov<0xB1>(v);
    v += dppmov<0x4E>(v);
    v += dppmov<0x141>(v);
    v += dppmov<0x140>(v);
    return v;
}
__device__ __forceinline__ float allreduce8_(float v) { v += dppmov<0xB1>(v); v += dppmov<0x4E>(v); v += dppmov<0x141>(v); return v; }
__device__ __forceinline__ float wave_sum(float v) {
    v = allreduce16(v);
    const float r0 = __builtin_bit_cast(float, __builtin_amdgcn_readlane(__builtin_bit_cast(int, v), 0)), r1 = __builtin_bit_cast(float, __builtin_amdgcn_readlane(__builtin_bit_cast(int, v), 16));
    const float r2 = __builtin_bit_cast(float, __builtin_amdgcn_readlane(__builtin_bit_cast(int, v), 32)), r3 = __builtin_bit_cast(float, __builtin_amdgcn_readlane(__builtin_bit_cast(int, v), 48));
    return (r0 + r1) + (r2 + r3);
}
template <int W> __device__ __forceinline__ float group_sum(float v) {
    if (W == 8) return allreduce8_(v);
    return allreduce16(v);
}

#define XB_TMO      128
#define XB_XCNT(j)  (256  + 64 * (j))
#define XB_XSUB(j)  (1280 + 64 * (j))
#define XB_XGEN(j)  (2304 + 64 * (j))
#define XB_TOP      3328
#define XB_TOPGEN   3392
#define XCD_BAR_WORDS 3456
#define XB_SPIN_CAP (1u << 22)
__device__ __forceinline__ unsigned xb_ld(unsigned* p)              { return __hip_atomic_load(p, __ATOMIC_RELAXED, __HIP_MEMORY_SCOPE_AGENT); }
__device__ __forceinline__ unsigned xb_add(unsigned* p, unsigned v) { return __hip_atomic_fetch_add(p, v, __ATOMIC_RELAXED, __HIP_MEMORY_SCOPE_AGENT); }
__device__ __forceinline__ unsigned xb_xcc_id() { return (unsigned)__builtin_amdgcn_s_getreg((3 << 11) | 20) & 0xFu; }
#define XB_SPIN(cond, bar) do { unsigned _sp = 0; while (cond) { __builtin_amdgcn_s_sleep(1); \
    if ((++_sp & 255u) == 0u) { if (xb_ld(&(bar)[XB_TMO])) break; if (_sp > XB_SPIN_CAP) { atomicAdd(&(bar)[XB_TMO], 1u); break; } } } } while (0)
struct XcdBarrier { unsigned* bar; unsigned x; volatile LAS unsigned* st; };
__device__ __forceinline__ XcdBarrier xcd_barrier_post(int wv, unsigned* bar, volatile LAS unsigned* st) {
    XcdBarrier b; b.bar = bar; b.x = xb_xcc_id(); b.st = st;
    if (ltid(wv) == 0) (void)xb_add(&bar[XB_XCNT(b.x)], 1u);
    return b;
}
__device__ __forceinline__ void xcd_barrier_complete(unsigned* bar, unsigned x, unsigned& nloc, unsigned& nx) {
    const unsigned G = gridDim.x * gridDim.y * gridDim.z;
    unsigned sum, cnt, mine, sp = 0u;
    for (;;) {
        sum = 0u; cnt = 0u; mine = 0u;
#pragma unroll
        for (unsigned j = 0; j < 16; ++j) { const unsigned c = xb_ld(&bar[XB_XCNT(j)]); sum += c; cnt += (c > 0u) ? 1u : 0u; mine = (j == x) ? c : mine; }
        if (sum == G) break;
        __builtin_amdgcn_s_sleep(1);
        if ((++sp & 255u) == 0u) { if (xb_ld(&bar[XB_TMO])) break; if (sp > XB_SPIN_CAP) { atomicAdd(&bar[XB_TMO], 1u); break; } }
    }
    nloc = mine > 0u ? mine : 1u; nx = cnt > 0u ? cnt : 1u;
}
__device__ __forceinline__ void xcd_barrier(int wv, const XcdBarrier& b) {
    asm volatile("s_waitcnt vmcnt(0)" ::: "memory");
    __syncthreads();
    if (ltid(wv) == 0) {
        unsigned* bar = b.bar;
        asm volatile("" : "+s"(bar));
        __builtin_amdgcn_s_waitcnt(0);
        unsigned nloc = b.st[0], nx = b.st[1];
        if (nloc == 0u) { xcd_barrier_complete(bar, b.x, nloc, nx); b.st[0] = nloc; b.st[1] = nx; }
        const unsigned old = xb_add(&bar[XB_XSUB(b.x)], 1u);
        const unsigned gen = old / nloc;
        if (old + 1u == (gen + 1u) * nloc) {
            __builtin_amdgcn_fence(__ATOMIC_RELEASE, "agent");
            asm volatile("s_waitcnt vmcnt(0)" ::: "memory");
            const unsigned og = xb_add(&bar[XB_TOP], 1u);
            const unsigned tg = og / nx;
            if (og + 1u == (tg + 1u) * nx) xb_add(&bar[XB_TOPGEN], 1u);
            else XB_SPIN(xb_ld(&bar[XB_TOPGEN]) == tg, bar);
            __builtin_amdgcn_fence(__ATOMIC_ACQUIRE, "agent");
            xb_add(&bar[XB_XGEN(b.x)], 1u);
            asm volatile("s_waitcnt vmcnt(0)" ::: "memory");
        } else {
            XB_SPIN(xb_ld(&bar[XB_XGEN(b.x)]) == gen, bar);
            __builtin_amdgcn_fence(__ATOMIC_ACQUIRE, "agent");
            asm volatile("s_waitcnt vmcnt(0)" ::: "memory");
        }
    }
    __syncthreads();
}

__device__ __forceinline__ int row_mod(int r) { return r < NCTX ? 4 : ((r - NCTX) >> 13); }
__device__ __forceinline__ void row_seg(int r, int& t, int& len) { if (r < NCTX) { t = r & 255; len = CTXL; } else { t = (r - NCTX) & 8191; len = SEQ; } }
__device__ __forceinline__ int scan_row(int tg, int b, int dir, int odd) {
    if (tg < CTXL) { const int t = dir ? (CTXL - 1 - tg) : tg; return b * CTXL + t; }
    int sg = tg - CTXL; if (dir) sg = SEQ - 1 - sg;
    const int s = odd ? (((sg & 127) << 6) + (sg >> 7)) : sg;
    return NCTX + b * SEQ + s;
}
__device__ __forceinline__ const float* modvec(const unsigned char* ws, int layer, int m, int which) {
    return (const float*)(ws + WS_MODV) + ((size_t)(layer * 5 + m) * 6 + which) * D;
}

constexpr int G_BM = 256, G_BN = 128, G_BK = 64;
constexpr int G_ABYTES = G_BM * G_BK * 2, G_BBYTES = G_BN * G_BK * 2, G_BUF = G_ABYTES + G_BBYTES;
__device__ __forceinline__ int swz(int o) { return o ^ (((o >> 9) & 1) << 5); }

template <class RowSrc, class Epi>
__device__ __forceinline__ void gemm_tile(int wv, const bf16_t* __restrict__ A, int lda, const RowSrc& rs, const bf16_t* __restrict__ Bt, int ldb, int n0, int K, const Epi& epi, LAS char* lds) {
    const int tid = ltid(wv), lane = tid & 63, wid = tid >> 6, wm = wid >> 1, wn = wid & 1;
    const bf16_t* ap[4]; int aoff[4];
#pragma unroll
    for (int i = 0; i < 4; ++i) {
        const int c = tid + NT * i, row = c >> 3, kc = c & 7;
        ap[i] = A + (size_t)rs.src(row) * lda + kc * 8;
        aoff[i] = ((row >> 4) * 2 + (kc >> 2)) * 1024 + swz((row & 15) * 64 + (kc & 3) * 16);
    }
    const bf16_t* bp[2]; int boff[2];
#pragma unroll
    for (int i = 0; i < 2; ++i) {
        const int c = tid + NT * i, row = c >> 3, kc = c & 7;
        bp[i] = Bt + (size_t)(n0 + row) * ldb + kc * 8;
        boff[i] = G_ABYTES + ((row >> 4) * 2 + (kc >> 2)) * 1024 + swz((row & 15) * 64 + (kc & 3) * 16);
    }
    f32x4 acc[4][4];
#pragma unroll
    for (int i = 0; i < 4; ++i)
#pragma unroll
        for (int j = 0; j < 4; ++j) acc[i][j] = (f32x4){0.f, 0.f, 0.f, 0.f};
    u32x4 ra[2][4], rb[2][2];
    const int KT = K / G_BK;
    const int fragoff = swz((lane & 15) * 64 + (lane >> 4) * 16);
#define G_LOAD(set, kt_) do { _Pragma("unroll") for (int i = 0; i < 4; ++i) ra[set][i] = *(const u32x4*)(ap[i] + (kt_) * G_BK); \
                              _Pragma("unroll") for (int i = 0; i < 2; ++i) rb[set][i] = *(const u32x4*)(bp[i] + (kt_) * G_BK); } while (0)
#define G_STORE(set, buf) do { _Pragma("unroll") for (int i = 0; i < 4; ++i) *(LAS u32x4*)((buf) + aoff[i]) = ra[set][i]; \
                               _Pragma("unroll") for (int i = 0; i < 2; ++i) *(LAS u32x4*)((buf) + boff[i]) = rb[set][i]; } while (0)
#define G_COMPUTE(cur) do { bf16x8 af[2][4], bfr[2][4]; \
        _Pragma("unroll") for (int ks = 0; ks < 2; ++ks) { \
            _Pragma("unroll") for (int ni = 0; ni < 4; ++ni) bfr[ks][ni] = *(LAS bf16x8*)((cur) + G_ABYTES + ((wn * 4 + ni) * 2 + ks) * 1024 + fragoff); \
            _Pragma("unroll") for (int mi = 0; mi < 4; ++mi) af[ks][mi] = *(LAS bf16x8*)((cur) + ((wm * 4 + mi) * 2 + ks) * 1024 + fragoff); } \
        __builtin_amdgcn_sched_barrier(0); \
        _Pragma("unroll") for (int ks = 0; ks < 2; ++ks) _Pragma("unroll") for (int mi = 0; mi < 4; ++mi) _Pragma("unroll") for (int ni = 0; ni < 4; ++ni) \
            acc[mi][ni] = __builtin_amdgcn_mfma_f32_16x16x32_bf16(bfr[ks][ni], af[ks][mi], acc[mi][ni], 0, 0, 0); \
        __builtin_amdgcn_sched_barrier(0); } while (0)
    G_LOAD(0, 0);
    G_STORE(0, lds);
    if (KT > 1) G_LOAD(0, 1);
    if (KT > 2) G_LOAD(1, 2);
    __syncthreads();
    for (int kt = 0; kt < KT; kt += 2) {
        G_COMPUTE(lds);
        if (kt + 1 < KT) G_STORE(0, lds + G_BUF);
        if (kt + 3 < KT) G_LOAD(0, kt + 3);
        __syncthreads();
        if (kt + 1 < KT) {
            G_COMPUTE(lds + G_BUF);
            if (kt + 2 < KT) G_STORE(1, lds);
            if (kt + 4 < KT) G_LOAD(1, kt + 4);
            __syncthreads();
        }
    }
#undef G_LOAD
#undef G_STORE
#undef G_COMPUTE
    epi(acc, wm * 64 + (lane & 15), wn * 64 + 4 * (lane >> 4));
}

constexpr int G2_BN = 256, G2_BBYTES = G2_BN * G_BK * 2, G2_BUF = G_ABYTES + G2_BBYTES;

struct RowLinear { int m0; __device__ __forceinline__ int src(int r) const { return m0 + r; } };
struct RowList {
    const int* list; int cnt; int shift;
    __device__ __forceinline__ int src(int r) const { const int a = list[r < cnt ? r : 0]; return a >> shift; }
};
struct EpiStoreBf16 {
    bf16_t* C; int ldc; int m0; int n0; int N;
    template <int NI> __device__ __forceinline__ void operator()(const f32x4 (&acc)[4][NI], int rbase, int cbase) const {
#pragma unroll
        for (int mi = 0; mi < 4; ++mi) {
            bf16_t* rowp = C + (size_t)(m0 + rbase + mi * 16) * ldc + n0 + cbase;
#pragma unroll
            for (int ni = 0; ni < NI; ++ni) {
                if (n0 + cbase + ni * 16 < N) { u32x2 v; v.x = pk2(acc[mi][ni][0], acc[mi][ni][1]); v.y = pk2(acc[mi][ni][2], acc[mi][ni][3]); *(u32x2*)(rowp + ni * 16) = v; }
            }
        }
    }
};
struct EpiSwiGLU {
    bf16_t* H; const int* list; int cnt; int n0;
    template <int NI> __device__ __forceinline__ void operator()(const f32x4 (&acc)[4][NI], int rbase, int cbase) const {
#pragma unroll
        for (int mi = 0; mi < 4; ++mi) {
            const int r = rbase + mi * 16;
            if (r < cnt) {
                const int a = list[r];
                const int wnb = cbase & ~63, q4 = cbase & 63;
                bf16_t* rowp = H + (size_t)a * DEXP + ((n0 + wnb) >> 1) + q4;
#pragma unroll
                for (int q = 0; q < NI / 2; ++q) {
                    float o[4];
#pragma unroll
                    for (int j = 0; j < 4; ++j) o[j] = siluf_(acc[mi][2 * q][j]) * acc[mi][2 * q + 1][j];
                    u32x2 v; v.x = pk2(o[0], o[1]); v.y = pk2(o[2], o[3]); *(u32x2*)(rowp + q * 16) = v;
                }
            }
        }
    }
};
struct EpiScatterBf16 {
    bf16_t* C; const int* list; int cnt; int n0;
    template <int NI> __device__ __forceinline__ void operator()(const f32x4 (&acc)[4][NI], int rbase, int cbase) const {
#pragma unroll
        for (int mi = 0; mi < 4; ++mi) {
            const int r = rbase + mi * 16;
            if (r < cnt) {
                bf16_t* rowp = C + (size_t)list[r] * D + n0 + cbase;
#pragma unroll
                for (int ni = 0; ni < NI; ++ni) { u32x2 v; v.x = pk2(acc[mi][ni][0], acc[mi][ni][1]); v.y = pk2(acc[mi][ni][2], acc[mi][ni][3]); *(u32x2*)(rowp + ni * 16) = v; }
            }
        }
    }
};
struct EpiDecay {
    float* Dc; const float* w0; int m0; int n0;
    template <int NI> __device__ __forceinline__ void operator()(const f32x4 (&acc)[4][NI], int rbase, int cbase) const {
#pragma unroll
        for (int ni = 0; ni < NI; ++ni) {
            const int col = n0 + cbase + ni * 16;
            const f32x4 w0v = *(const f32x4*)(w0 + col);
#pragma unroll
            for (int mi = 0; mi < 4; ++mi) {
                f32x4 o;
#pragma unroll
                for (int j = 0; j < 4; ++j) { const float w = w0v[j] + acc[mi][ni][j]; o[j] = __expf(-__expf(-softplus_fast(-w) - 0.5f)); }
                *(f32x4*)(Dc + (size_t)(m0 + rbase + mi * 16) * 512 + col) = o;
            }
        }
    }
};
struct EpiAK {
    bf16_t* Kb; const bf16_t* KKb; bf16_t* Bb; const float* a0; const float* k_a; int m0; int n0;
    template <int NI> __device__ __forceinline__ void operator()(const f32x4 (&acc)[4][NI], int rbase, int cbase) const {
#pragma unroll
        for (int ni = 0; ni < NI; ++ni) {
            const int col = n0 + cbase + ni * 16;
            const f32x4 a0v = *(const f32x4*)(a0 + col), kav = *(const f32x4*)(k_a + col);
#pragma unroll
            for (int mi = 0; mi < 4; ++mi) {
                const size_t off = (size_t)(m0 + rbase + mi * 16) * 512 + col;
                const u32x2 kr = *(const u32x2*)(Kb + off), kkr = *(const u32x2*)(KKb + off);
                const float kf[4] = {bflo(kr.x), bfhi(kr.x), bflo(kr.y), bfhi(kr.y)}, kkf[4] = {bflo(kkr.x), bfhi(kkr.x), bflo(kkr.y), bfhi(kkr.y)};
                float k2[4], bb[4];
#pragma unroll
                for (int j = 0; j < 4; ++j) { const float a = sigmoidf_(a0v[j] + acc[mi][ni][j]); k2[j] = kf[j] * (1.f + (a - 1.f) * kav[j]); bb[j] = kkf[j] * a; }
                u32x2 v; v.x = pk2(k2[0], k2[1]); v.y = pk2(k2[2], k2[3]); *(u32x2*)(Kb + off) = v;
                v.x = pk2(bb[0], bb[1]); v.y = pk2(bb[2], bb[3]); *(u32x2*)(Bb + off) = v;
            }
        }
    }
};

namespace pg8 {
#define PG8_LAS __attribute__((address_space(3)))
constexpr int BM = 256, BK = 64, HALF = 128, HTB = HALF * BK * 2, STAGE_BYTES = 8 * HTB, NXCD = 8, WGM = 8;
__host__ __device__ __forceinline__ int lds_byte(int r, int c) { const int st = (r >> 4) * 2 + (c >> 5), rr = r & 15, cc = c & 31, ob = rr * 64 + cc * 2; return st * 1024 + (ob ^ (((ob >> 9) & 1) << 5)); }
__host__ __device__ __forceinline__ void stage_rc(int b, int& R, int& C) { const int st = b / 1024, sb = b % 1024, swz = sb ^ (((sb >> 9) & 1) << 5); R = (st >> 1) * 16 + swz / 64; C = (st & 1) * 32 + (swz % 64) / 2; }
__host__ __device__ __forceinline__ int perm32(int rho) { const int n = rho >> 4, i = rho & 15; return 8 * (i >> 2) + 4 * n + (i & 3); }
struct Unit { int pm, pn; };
struct Gemm { const bf16_t* A; const bf16_t* Bt; int M, N, K; };
struct StaticOrder {
    int nM, nN, nwg, G, c;
    __host__ __device__ void init(int M, int N, int G_, int c_) { nM = M / BM; nN = N / BM; nwg = nM * nN; G = G_; c = c_; }
    __host__ __device__ bool next(int i, Unit& u) const {
        const long L = (long)i * G + c; if (L >= nwg) return false;
        int wgid = (int)L; { const int q = nwg / NXCD, r = nwg % NXCD, xcd = wgid % NXCD, off = wgid / NXCD; wgid = (xcd < r ? xcd * (q + 1) : r * (q + 1) + (xcd - r) * q) + off; }
        const int nig = WGM * nN, gid = wgid / nig, fm = gid * WGM, gsz = (nM - fm) < WGM ? (nM - fm) : WGM;
        u.pm = fm + ((wgid % nig) % gsz); u.pn = (wgid % nig) / gsz; return true;
    }
    __device__ __forceinline__ void a_ready(const Unit&) const {}
    __device__ __forceinline__ void done(const Unit&) const {}
};
struct EpiStoreP {
    static constexpr bool PERM = true, AFTER_DRAIN = false;
    bf16_t* O; int ldc;
    __device__ __forceinline__ void operator()(const f32x4 (&acc)[2][2][4][2], const Unit& u, int wr, int wc, int fr, int fq) const {
        const int row0 = u.pm * BM + wr * 64 + fr, col0 = u.pn * BM + wc * 32 + 8 * fq;
#pragma unroll
        for (int ai = 0; ai < 2; ++ai)
#pragma unroll
            for (int m = 0; m < 4; ++m) { bf16_t* rowp = O + (size_t)(row0 + ai * HALF + m * 16) * ldc + col0;
#pragma unroll
                for (int bj = 0; bj < 2; ++bj) { const f32x4 v0 = acc[ai][bj][m][0], v1 = acc[ai][bj][m][1];
                    u32x4 w; w.x = pk2(v0[0], v0[1]); w.y = pk2(v0[2], v0[3]); w.z = pk2(v1[0], v1[1]); w.w = pk2(v1[2], v1[3]);
                    *(u32x4*)(rowp + bj * HALF) = w; } }
    }
};
template <class Epi, class Sched>
__device__ __forceinline__ void gemm_phase(int wv, PG8_LAS unsigned char* lds, const Gemm g, const Sched& S, const Epi& E) {
    const int tid = ltid(wv), wid = __builtin_amdgcn_readfirstlane(tid >> 6), lane = tid & 63, wr = wid >> 2, wc = wid & 3, fr = lane & 15, fq = lane >> 4;
    const int K = g.K, nt = K / BK;
    unsigned voffA[2], voffB[2];
#pragma unroll
    for (int i = 0; i < 2; ++i) { int R, C; stage_rc(tid * 16 + i * 8192, R, C); const int Rb = Epi::PERM ? ((R & ~31) + perm32(R & 31)) : R;
        voffA[i] = (unsigned)(R * K + C) * 2u; voffB[i] = (unsigned)(Rb * K + C) * 2u; }
    const size_t kstep = (size_t)(BK * 2);
    const size_t hstep = (size_t)HALF * K * 2;
    const size_t tstep = 2 * hstep;
    const unsigned ldsw = (unsigned)wid * 1024u;
    const int aoff = lds_byte(wr * 64 + fr, fq * 8), boff = lds_byte(wc * 32 + fr, fq * 8);
#define PG8_SA(b, h) (((b) * 2 + (h)) * HTB)
#define PG8_SB(b, h) ((4 + (b) * 2 + (h)) * HTB)
#define PG8_STAGE(bufoff, gbase, voff) do { _Pragma("unroll") for (int _i = 0; _i < 2; ++_i) \
        __builtin_amdgcn_global_load_lds((const unsigned*)((const char*)(gbase) + (voff)[_i]), (PG8_LAS unsigned*)(lds + (bufoff) + ldsw + _i * 8192), 16, 0, 0); } while (0)
#define PG8_LDA(dst, b, h) do { _Pragma("unroll") for (int m = 0; m < 4; ++m) _Pragma("unroll") for (int k = 0; k < 2; ++k) dst[m][k] = *(const PG8_LAS bf16x8*)(lds + PG8_SA(b, h) + aoff + m * 2048 + k * 1024); } while (0)
#define PG8_LDB(dst, b, h) do { _Pragma("unroll") for (int n = 0; n < 2; ++n) _Pragma("unroll") for (int k = 0; k < 2; ++k) dst[n][k] = *(const PG8_LAS bf16x8*)(lds + PG8_SB(b, h) + boff + n * 2048 + k * 1024); } while (0)
#define PG8_MMA(ai, bj, At, Bt) do { __builtin_amdgcn_s_setprio(1); _Pragma("unroll") for (int m = 0; m < 4; ++m) _Pragma("unroll") for (int n = 0; n < 2; ++n) _Pragma("unroll") for (int k = 0; k < 2; ++k) \
        acc[ai][bj][m][n] = __builtin_amdgcn_mfma_f32_16x16x32_bf16(Bt[n][k], At[m][k], acc[ai][bj][m][n], 0, 0, 0); __builtin_amdgcn_s_setprio(0); } while (0)
#define PG8_WAIT_V(n) asm volatile("s_waitcnt vmcnt(" #n ")" ::: "memory")
#define PG8_WAIT_L(n) asm volatile("s_waitcnt lgkmcnt(" #n ")" ::: "memory")
#define PG8_BAR __builtin_amdgcn_s_barrier()
#define PG8_SCHED __builtin_amdgcn_sched_barrier(0)
    Unit cur, nxt; int ui = 0;
    if (!S.next(0, cur)) return;
    f32x4 acc[2][2][4][2];
#pragma unroll
    for (int a = 0; a < 2; ++a)
#pragma unroll
        for (int b = 0; b < 2; ++b)
#pragma unroll
            for (int m = 0; m < 4; ++m)
#pragma unroll
                for (int n = 0; n < 2; ++n) acc[a][b][m][n] = (f32x4){0.f, 0.f, 0.f, 0.f};
    bf16x8 At[4][2], B0[2][2], B1[2][2];
    const char* cA = (const char*)g.A + (size_t)cur.pm * tstep; const char* cB = (const char*)g.Bt + (size_t)cur.pn * tstep;
    S.a_ready(cur);
    PG8_STAGE(PG8_SB(0, 0), cB, voffB); PG8_STAGE(PG8_SA(0, 0), cA, voffA); PG8_STAGE(PG8_SB(0, 1), cB + hstep, voffB); PG8_STAGE(PG8_SA(0, 1), cA + hstep, voffA);
    if (wr == 1) PG8_BAR;
    PG8_WAIT_V(4); PG8_BAR;
    PG8_STAGE(PG8_SB(1, 0), cB + kstep, voffB); PG8_STAGE(PG8_SA(1, 0), cA + kstep, voffA); PG8_STAGE(PG8_SB(1, 1), cB + hstep + kstep, voffB);
    PG8_WAIT_V(6); PG8_BAR;
    for (;;) {
        const bool has_next = S.next(ui + 1, nxt);
        const char* nA = has_next ? (const char*)g.A + (size_t)nxt.pm * tstep : cA; const char* nB = has_next ? (const char*)g.Bt + (size_t)nxt.pn * tstep : cB;
        for (int t = 0; t < nt; t += 2) {
            const bool last = (t == nt - 2);
            const char* a1 = cA + (size_t)(t + 1) * kstep;
            const char* a2 = last ? nA : cA + (size_t)(t + 2) * kstep; const char* b2 = last ? nB : cB + (size_t)(t + 2) * kstep;
            const char* a3 = a2 + kstep; const char* b3 = b2 + kstep;
            if (last && has_next) S.a_ready(nxt);
            PG8_LDB(B0, 0, 0); PG8_SCHED; PG8_LDA(At, 0, 0); PG8_STAGE(PG8_SA(1, 1), a1 + hstep, voffA);
            PG8_WAIT_L(8); PG8_BAR; PG8_WAIT_L(0); PG8_MMA(0, 0, At, B0); PG8_BAR; PG8_SCHED;
            PG8_LDB(B1, 0, 1); PG8_STAGE(PG8_SB(0, 0), b2, voffB);
            PG8_BAR; PG8_WAIT_L(0); PG8_MMA(0, 1, At, B1); PG8_BAR;
            PG8_LDA(At, 0, 1); PG8_STAGE(PG8_SA(0, 0), a2, voffA);
            PG8_BAR; PG8_WAIT_L(0); PG8_MMA(1, 0, At, B0); PG8_BAR; PG8_SCHED;
            PG8_STAGE(PG8_SB(0, 1), b2 + hstep, voffB);
            PG8_WAIT_V(6); PG8_BAR; PG8_MMA(1, 1, At, B1); PG8_BAR;
            PG8_LDB(B0, 1, 0); PG8_SCHED; PG8_LDA(At, 1, 0); PG8_STAGE(PG8_SA(0, 1), a2 + hstep, voffA);
            PG8_WAIT_L(8); PG8_BAR; PG8_WAIT_L(0); PG8_MMA(0, 0, At, B0); PG8_BAR; PG8_SCHED;
            PG8_LDB(B1, 1, 1); PG8_STAGE(PG8_SB(1, 0), b3, voffB);
            PG8_BAR; PG8_WAIT_L(0); PG8_MMA(0, 1, At, B1); PG8_BAR;
            PG8_LDA(At, 1, 1); PG8_STAGE(PG8_SA(1, 0), a3, voffA);
            PG8_BAR; PG8_WAIT_L(0); PG8_MMA(1, 0, At, B0); PG8_BAR; PG8_SCHED;
            PG8_STAGE(PG8_SB(1, 1), b3 + hstep, voffB);
            PG8_WAIT_V(6); PG8_BAR; PG8_MMA(1, 1, At, B1); PG8_BAR;
        }
            if constexpr (!Epi::AFTER_DRAIN) { E(acc, cur, wr, wc, fr, fq); S.done(cur); }
            if (!has_next) break;
#pragma unroll
        for (int a = 0; a < 2; ++a)
#pragma unroll
            for (int b = 0; b < 2; ++b)
#pragma unroll
                for (int m = 0; m < 4; ++m)
#pragma unroll
                    for (int n = 0; n < 2; ++n) acc[a][b][m][n] = (f32x4){0.f, 0.f, 0.f, 0.f};
        cur = nxt; cA = nA; cB = nB; ++ui;
    }
    PG8_WAIT_V(0);
    if (wr == 0) PG8_BAR;
    PG8_BAR;
    if constexpr (Epi::AFTER_DRAIN) { E.fused(acc, cur, wr, wc, fr, fq, lds, wid, lane); S.done(cur); }
#undef PG8_SA
#undef PG8_SB
#undef PG8_STAGE
#undef PG8_LDA
#undef PG8_LDB
#undef PG8_MMA
#undef PG8_WAIT_V
#undef PG8_WAIT_L
#undef PG8_BAR
#undef PG8_SCHED
}
struct UnitG { int pm, pn; const char* bbase; const PG8_LAS int* ltab; int cnt; int e; };
struct MoeOrder {
    const PG8_LAS int* tstart; const PG8_LAS int* tcnt; const PG8_LAS int* ltabs; const int* lists; const char* bt; size_t estride; int ncol, shift, G, c;
    __device__ __forceinline__ bool next(int i, UnitG& u) const {
        const int t = i * G + c; if (t >= tstart[32] * ncol) return false;
        const int tm = t / ncol; int e = 0;
#pragma unroll 1
        while (tstart[e + 1] <= tm) ++e;
        e = __builtin_amdgcn_readfirstlane(e);
        const int ts = __builtin_amdgcn_readfirstlane(tstart[e]), tc = __builtin_amdgcn_readfirstlane(tcnt[e]);
        u.pm = tm - ts; u.pn = t - tm * ncol; u.bbase = bt + (size_t)e * estride; u.e = e; u.cnt = tc - u.pm * BM; u.ltab = ltabs + i * BM;
        return true;
    }
    __device__ __forceinline__ void a_ready(const UnitG&) const {}
    __device__ __forceinline__ void done(const UnitG&) const {}
};
struct EpiSwiGLUG {
    static constexpr bool PERM = false, AFTER_DRAIN = false;
    bf16_t* H;
    __device__ __forceinline__ void operator()(const f32x4 (&acc)[2][2][4][2], const UnitG& u, int wr, int wc, int fr, int fq) const {
#pragma unroll
        for (int ai = 0; ai < 2; ++ai)
#pragma unroll
            for (int m = 0; m < 4; ++m) { const int r = ai * HALF + wr * 64 + m * 16 + fr;
                if (r < u.cnt) { bf16_t* rowp = H + (size_t)u.ltab[r] * DEXP + ((u.pn * BM + wc * 32) >> 1) + 4 * fq;
#pragma unroll
                    for (int bj = 0; bj < 2; ++bj) { const f32x4 gt = acc[ai][bj][m][0], up = acc[ai][bj][m][1];
                        u32x2 w; w.x = pk2(siluf_(gt[0]) * up[0], siluf_(gt[1]) * up[1]); w.y = pk2(siluf_(gt[2]) * up[2], siluf_(gt[3]) * up[3]);
                        *(u32x2*)(rowp + bj * (HALF / 2)) = w; } } }
    }
};
struct EpiScatterG {
    static constexpr bool PERM = true, AFTER_DRAIN = false;
    bf16_t* O;
    __device__ __forceinline__ void operator()(const f32x4 (&acc)[2][2][4][2], const UnitG& u, int wr, int wc, int fr, int fq) const {
#pragma unroll
        for (int ai = 0; ai < 2; ++ai)
#pragma unroll
            for (int m = 0; m < 4; ++m) { const int r = ai * HALF + wr * 64 + m * 16 + fr;
                if (r < u.cnt) { bf16_t* rowp = O + (size_t)u.ltab[r] * D + u.pn * BM + wc * 32 + 8 * fq;
#pragma unroll
                    for (int bj = 0; bj < 2; ++bj) { const f32x4 v0 = acc[ai][bj][m][0], v1 = acc[ai][bj][m][1];
                        u32x4 w; w.x = pk2(v0[0], v0[1]); w.y = pk2(v0[2], v0[3]); w.z = pk2(v1[0], v1[1]); w.w = pk2(v1[2], v1[3]);
                        *(u32x4*)(rowp + bj * HALF) = w; } } }
    }
};
template <class Epi, class Sched>
__device__ __forceinline__ void gemm_phase_g(int wv, PG8_LAS unsigned char* lds, const Gemm g, const Sched& S, const Epi& E) {
    const int tid = ltid(wv), wid = __builtin_amdgcn_readfirstlane(tid >> 6), lane = tid & 63, wr = wid >> 2, wc = wid & 3, fr = lane & 15, fq = lane >> 4;
    const int K = g.K, nt = K / BK;
    unsigned voffB[2];
#pragma unroll
    for (int i = 0; i < 2; ++i) { int R, C; stage_rc(tid * 16 + i * 8192, R, C); const int Rb = Epi::PERM ? ((R & ~31) + perm32(R & 31)) : R;
        voffB[i] = (unsigned)(Rb * K + C) * 2u; }
    const unsigned rowb = (unsigned)K * 2u;
#define PG8_AOFFS(u, dst) do { const int _t = ltid(wv); _Pragma("unroll") for (int _i = 0; _i < 2; ++_i) { int _R, _C; stage_rc(_t * 16 + _i * 8192, _R, _C); \
        _Pragma("unroll") for (int _h = 0; _h < 2; ++_h) dst[_h][_i] = (unsigned)((u).ltab[_h * HALF + _R] >> S.shift) * rowb + (unsigned)(_C * 2); } } while (0)
#define PG8_STAGE_A(bufoff, AO, koff) do { _Pragma("unroll") for (int _i = 0; _i < 2; ++_i) \
        __builtin_amdgcn_global_load_lds((const unsigned*)((const char*)g.A + (size_t)(AO)[_i] + (size_t)(koff)), (PG8_LAS unsigned*)(lds + (bufoff) + ldsw + _i * 8192), 16, 0, 0); } while (0)
    const size_t kstep = (size_t)(BK * 2);
    const size_t hstep = (size_t)HALF * K * 2;
    const size_t tstep = 2 * hstep;
    const unsigned ldsw = (unsigned)wid * 1024u;
    const int aoff = lds_byte(wr * 64 + fr, fq * 8), boff = lds_byte(wc * 32 + fr, fq * 8);
#define PG8_SA(b, h) (((b) * 2 + (h)) * HTB)
#define PG8_SB(b, h) ((4 + (b) * 2 + (h)) * HTB)
#define PG8_STAGE(bufoff, gbase, voff) do { _Pragma("unroll") for (int _i = 0; _i < 2; ++_i) \
        __builtin_amdgcn_global_load_lds((const unsigned*)((const char*)(gbase) + (voff)[_i]), (PG8_LAS unsigned*)(lds + (bufoff) + ldsw + _i * 8192), 16, 0, 0); } while (0)
#define PG8_LDA(dst, b, h) do { _Pragma("unroll") for (int m = 0; m < 4; ++m) _Pragma("unroll") for (int k = 0; k < 2; ++k) dst[m][k] = *(const PG8_LAS bf16x8*)(lds + PG8_SA(b, h) + aoff + m * 2048 + k * 1024); } while (0)
#define PG8_LDB(dst, b, h) do { _Pragma("unroll") for (int n = 0; n < 2; ++n) _Pragma("unroll") for (int k = 0; k < 2; ++k) dst[n][k] = *(const PG8_LAS bf16x8*)(lds + PG8_SB(b, h) + boff + n * 2048 + k * 1024); } while (0)
#define PG8_MMA(ai, bj, At, Bt) do { __builtin_amdgcn_s_setprio(1); _Pragma("unroll") for (int m = 0; m < 4; ++m) _Pragma("unroll") for (int n = 0; n < 2; ++n) _Pragma("unroll") for (int k = 0; k < 2; ++k) \
        acc[ai][bj][m][n] = __builtin_amdgcn_mfma_f32_16x16x32_bf16(Bt[n][k], At[m][k], acc[ai][bj][m][n], 0, 0, 0); __builtin_amdgcn_s_setprio(0); } while (0)
#define PG8_WAIT_V(n) asm volatile("s_waitcnt vmcnt(" #n ")" ::: "memory")
#define PG8_WAIT_L(n) asm volatile("s_waitcnt lgkmcnt(" #n ")" ::: "memory")
#define PG8_BAR __builtin_amdgcn_s_barrier()
#define PG8_SCHED __builtin_amdgcn_sched_barrier(0)
    UnitG cur, nxt; int ui = 0;
    if (!S.next(0, cur)) return;
    f32x4 acc[2][2][4][2];
#pragma unroll
    for (int a = 0; a < 2; ++a)
#pragma unroll
        for (int b = 0; b < 2; ++b)
#pragma unroll
            for (int m = 0; m < 4; ++m)
#pragma unroll
                for (int n = 0; n < 2; ++n) acc[a][b][m][n] = (f32x4){0.f, 0.f, 0.f, 0.f};
    bf16x8 At[4][2], B0[2][2], B1[2][2];
    unsigned ca[2][2]; PG8_AOFFS(cur, ca); const char* cB = cur.bbase + (size_t)cur.pn * tstep;
    S.a_ready(cur);
    PG8_STAGE(PG8_SB(0, 0), cB, voffB); PG8_STAGE_A(PG8_SA(0, 0), ca[0], 0); PG8_STAGE(PG8_SB(0, 1), cB + hstep, voffB); PG8_STAGE_A(PG8_SA(0, 1), ca[1], 0);
    if (wr == 1) PG8_BAR;
    PG8_WAIT_V(4); PG8_BAR;
    PG8_STAGE(PG8_SB(1, 0), cB + kstep, voffB); PG8_STAGE_A(PG8_SA(1, 0), ca[0], kstep); PG8_STAGE(PG8_SB(1, 1), cB + hstep + kstep, voffB);
    PG8_WAIT_V(6); PG8_BAR;
    for (;;) {
        const bool has_next = S.next(ui + 1, nxt);
        const char* nB = has_next ? nxt.bbase + (size_t)nxt.pn * tstep : cB;
        for (int t = 0; t < nt; t += 2) {
            const bool last = (t == nt - 2);
            const size_t k1 = (size_t)(t + 1) * kstep, k2 = last ? 0 : (size_t)(t + 2) * kstep;
            unsigned a2o[2][2];
            if (last && has_next) PG8_AOFFS(nxt, a2o); else { a2o[0][0] = ca[0][0]; a2o[0][1] = ca[0][1]; a2o[1][0] = ca[1][0]; a2o[1][1] = ca[1][1]; }
            const char* b2 = last ? nB : cB + (size_t)(t + 2) * kstep; const char* b3 = b2 + kstep;
            if (last && has_next) S.a_ready(nxt);
            PG8_LDB(B0, 0, 0); PG8_SCHED; PG8_LDA(At, 0, 0); PG8_STAGE_A(PG8_SA(1, 1), ca[1], k1);
            PG8_WAIT_L(8); PG8_BAR; PG8_WAIT_L(0); PG8_MMA(0, 0, At, B0); PG8_BAR; PG8_SCHED;
            PG8_LDB(B1, 0, 1); PG8_STAGE(PG8_SB(0, 0), b2, voffB);
            PG8_BAR; PG8_WAIT_L(0); PG8_MMA(0, 1, At, B1); PG8_BAR;
            PG8_LDA(At, 0, 1); PG8_STAGE_A(PG8_SA(0, 0), a2o[0], k2);
            PG8_BAR; PG8_WAIT_L(0); PG8_MMA(1, 0, At, B0); PG8_BAR; PG8_SCHED;
            PG8_STAGE(PG8_SB(0, 1), b2 + hstep, voffB);
            PG8_WAIT_V(6); PG8_BAR; PG8_MMA(1, 1, At, B1); PG8_BAR;
            PG8_LDB(B0, 1, 0); PG8_SCHED; PG8_LDA(At, 1, 0); PG8_STAGE_A(PG8_SA(0, 1), a2o[1], k2);
            PG8_WAIT_L(8); PG8_BAR; PG8_WAIT_L(0); PG8_MMA(0, 0, At, B0); PG8_BAR; PG8_SCHED;
            PG8_LDB(B1, 1, 1); PG8_STAGE(PG8_SB(1, 0), b3, voffB);
            PG8_BAR; PG8_WAIT_L(0); PG8_MMA(0, 1, At, B1); PG8_BAR;
            PG8_LDA(At, 1, 1); PG8_STAGE_A(PG8_SA(1, 0), a2o[0], k2 + kstep);
            PG8_BAR; PG8_WAIT_L(0); PG8_MMA(1, 0, At, B0); PG8_BAR; PG8_SCHED;
            PG8_STAGE(PG8_SB(1, 1), b3 + hstep, voffB);
            PG8_WAIT_V(6); PG8_BAR; PG8_MMA(1, 1, At, B1); PG8_BAR;
            if (last) { ca[0][0] = a2o[0][0]; ca[0][1] = a2o[0][1]; ca[1][0] = a2o[1][0]; ca[1][1] = a2o[1][1]; }
        }
            if constexpr (!Epi::AFTER_DRAIN) { E(acc, cur, wr, wc, fr, fq); S.done(cur); }
            if (!has_next) break;
#pragma unroll
        for (int a = 0; a < 2; ++a)
#pragma unroll
            for (int b = 0; b < 2; ++b)
#pragma unroll
                for (int m = 0; m < 4; ++m)
#pragma unroll
                    for (int n = 0; n < 2; ++n) acc[a][b][m][n] = (f32x4){0.f, 0.f, 0.f, 0.f};
        cur = nxt; cB = nB; ++ui;
    }
    PG8_WAIT_V(0);
    if (wr == 0) PG8_BAR;
    PG8_BAR;
    if constexpr (Epi::AFTER_DRAIN) { E.fused(acc, cur, wr, wc, fr, fq, lds, wid, lane); S.done(cur); }
#undef PG8_SA
#undef PG8_AOFFS
#undef PG8_STAGE_A
#undef PG8_SB
#undef PG8_STAGE
#undef PG8_LDA
#undef PG8_LDB
#undef PG8_MMA
#undef PG8_WAIT_V
#undef PG8_WAIT_L
#undef PG8_BAR
#undef PG8_SCHED
}
}

__device__ __forceinline__ void transpose_item(const float* __restrict__ W, int K, int N, bf16_t* __restrict__ WT, int mode, LAS float* scr, int item, int lane) {
    const int nblk = N / 32, kb = item / nblk, nb = item % nblk, k0 = 64 * kb, n0 = 32 * nb;
    {
        const float* wp = W + (size_t)(k0 + (lane >> 5)) * N + n0 + (lane & 31);
        float t[32];
#pragma unroll
        for (int i = 0; i < 32; ++i) t[i] = wp[(size_t)(2 * i) * N];
#pragma unroll
        for (int i = 0; i < 32; ++i) scr[(2 * i + (lane >> 5)) * 33 + (lane & 31)] = t[i];
    }
    asm volatile("s_waitcnt lgkmcnt(0)" ::: "memory");
    const int c = lane & 7;
#pragma unroll
    for (int j = 0; j < 4; ++j) {
        const int nl = (lane >> 3) + 8 * j; const LAS float* s = scr + (8 * c) * 33 + nl;
        u32x4 o; o.x = pk2(s[0 * 33], s[1 * 33]); o.y = pk2(s[2 * 33], s[3 * 33]); o.z = pk2(s[4 * 33], s[5 * 33]); o.w = pk2(s[6 * 33], s[7 * 33]);
        const int n = n0 + nl;
        const int nd = mode == 0 ? n : (32 * (n >> 4) + (n & 15) + (mode == 2 ? 16 : 0));
        *(u32x4*)(WT + (size_t)nd * K + k0 + 8 * c) = o;
    }
    asm volatile("s_waitcnt lgkmcnt(0)" ::: "memory");
}

constexpr int EXC_IG = 16 * 16, EXC_IDN = 8 * 32, EXC_PER = 2 * EXC_IG + EXC_IDN, EXC_ITEMS = NEXP * EXC_PER;
__device__ __forceinline__ int exc_s0(int layer) { return (layer & 1) ? 8192 : 10240; }
__device__ __forceinline__ int exc_s1(int layer) { return layer == DEPTH - 1 ? 0 : 7168; }
__device__ __forceinline__ void expconv_items(const CAS Params& P, int layer, LAS char* lds, int lo, int hi, int worker, int nworkers, int wid, int lane) {
    LAS float* scr = (LAS float*)(lds + wid * 8448);
    bf16_t* gu = (bf16_t*)(P.ws + WS_EXPGU); bf16_t* dw = (bf16_t*)(P.ws + WS_EXPD);
    for (int it = lo + worker; it < hi; it += nworkers) {
        const int e = it / EXC_PER; int r = it % EXC_PER;
        const size_t eo = (size_t)(layer * NEXP + e);
        if (r < EXC_IG) { transpose_item(P.exp_w_gate + eo * D * DEXP, D, DEXP, gu + (size_t)e * 1024 * 1024, 1, scr, r, lane); continue; } r -= EXC_IG;
        if (r < EXC_IG) { transpose_item(P.exp_w_up + eo * D * DEXP, D, DEXP, gu + (size_t)e * 1024 * 1024, 2, scr, r, lane); continue; } r -= EXC_IG;
        transpose_item(P.exp_w_down + eo * DEXP * D, DEXP, D, dw + (size_t)e * 1024 * 512, 0, scr, r, lane);
    }
}
__device__ __forceinline__ void expconv_tail(int wv, const CAS Params& P, int layer, LAS char* lds, int nwg, int lo, int hi) {
    const int G = gridDim.x, rem = nwg % G;
    if (rem != 0 && (int)blockIdx.x >= rem && lo < hi) {
        const int tid = ltid(wv);
        __syncthreads();
        expconv_items(P, layer, lds, lo, hi, ((int)blockIdx.x - rem) * 8 + (tid >> 6), (G - rem) * 8, tid >> 6, tid & 63);
    }
}

__device__ __forceinline__ void phase_prologue0(int wv, KP Pk, LAS char* lds) {
    asm volatile("" : "+s"(Pk));
    const CAS Params& P = *Pk;
    const int tid = ltid(wv), lane = tid & 63, wid = tid >> 6;
    const int gw = blockIdx.x * 8 + wid, NGW = gridDim.x * 8;
    LAS float* scr = (LAS float*)(lds + wid * 8448);
    bf16_t* winT = (bf16_t*)(P.ws + WS_WINT);
    bf16_t* woutT = (bf16_t*)(P.ws + WS_WOUTT);
    bf16_t* loraT = (bf16_t*)(P.ws + WS_LORAT);
    constexpr int I_EV = 16 * (P_EVEN / 32), I_OD = 16 * (P_ODD / 32), I_O = 16 * 32, I_L64 = 16, I_L128 = 32;
    constexpr int I_LORA = 3 * I_L64 + I_L128;
    constexpr int NIT = 2 * I_EV + 2 * I_OD + 4 * I_O + 2 * I_LORA;
    for (int it = gw; it < NIT; it += NGW) {
        int r = it;
        if (r < 2 * I_EV) { const int i = r / I_EV; transpose_item(P.ev_w_in + (size_t)i * D * P_EVEN, D, P_EVEN, winT + (i ? WINT_L2 : WINT_L0), 0, scr, r % I_EV, lane); continue; } r -= 2 * I_EV;
        if (r < 2 * I_OD) { const int i = r / I_OD; transpose_item(P.od_w_in + (size_t)i * D * P_ODD, D, P_ODD, winT + (i ? WINT_L3 : WINT_L1), 0, scr, r % I_OD, lane); continue; } r -= 2 * I_OD;
        if (r < 4 * I_O) { const int l = r / I_O; const float* src = (l & 1) ? P.od_w_out + (size_t)(l >> 1) * D * D : P.ev_w_out + (size_t)(l >> 1) * D * D;
            transpose_item(src, D, D, woutT + (size_t)l * D * D, 0, scr, r % I_O, lane); continue; } r -= 4 * I_O;
        { const int i = r / I_LORA; int q = r % I_LORA; bf16_t* dst = loraT + (size_t)i * LORA_PER;
          if (q < I_L64) { transpose_item(P.rw_w2 + (size_t)(i * 2 + 0) * 64 * 512, 64, 512, dst, 0, scr, q, lane); continue; } q -= I_L64;
          if (q < I_L64) { transpose_item(P.rw_w2 + (size_t)(i * 2 + 1) * 64 * 512, 64, 512, dst + 512 * 64, 0, scr, q, lane); continue; } q -= I_L64;
          if (q < I_L64) { transpose_item(P.rw_a2 + (size_t)i * 64 * 512, 64, 512, dst + 2 * 512 * 64, 0, scr, q, lane); continue; } q -= I_L64;
          transpose_item(P.rw_g2 + (size_t)i * 128 * 512, 128, 512, dst + 3 * 512 * 64, 0, scr, q, lane); }
    }
    {
        const int gt = blockIdx.x * NT + tid, NG = gridDim.x * NT;
        constexpr int PADE = (LDP_EVEN - P_EVEN) * D / 8, PADO = (LDP_ODD - P_ODD) * D / 8;
        for (int i = gt; i < 2 * PADE + 2 * PADO; i += NG) {
            int r = i; bf16_t* dst;
            if (r < 2 * PADE) { const int l = r / PADE; dst = winT + (l ? WINT_L2 : WINT_L0) + (size_t)P_EVEN * D + (size_t)(r % PADE) * 8; }
            else { r -= 2 * PADE; const int l = r / PADO; dst = winT + (l ? WINT_L3 : WINT_L1) + (size_t)P_ODD * D + (size_t)(r % PADO) * 8; }
            *(u32x4*)dst = (u32x4){0u, 0u, 0u, 0u};
        }
    }
    {
        const int gt = blockIdx.x * NT + tid, NG = gridDim.x * NT;
        float* lb = (float*)(P.ws + WS_LB);
        for (int ch = gt; ch < 512; ch += NG) {
            float lg[4], mx = -1e30f;
#pragma unroll
            for (int l = 0; l < 4; ++l) { lg[l] = P.hg_lb_logits[l * 512 + ch]; mx = fmaxf(mx, lg[l]); }
            float e[4], s = 0.f;
#pragma unroll
            for (int l = 0; l < 4; ++l) { e[l] = __expf(lg[l] - mx); s += e[l]; }
            float cum = 0.f;
#pragma unroll
            for (int l = 0; l < 4; ++l) { if (l > 0) cum += e[l] / s; lb[l * 512 + ch] = cum; }
        }
    }
    __syncthreads();
    {
        LAS float* sc = (LAS float*)lds;
        LAS float* red = (LAS float*)(lds + 5 * 1024 * 4);
        for (int i = tid; i < 5 * D; i += NT) { const int m = i >> 10, k = i & 1023; const float v = m < 4 ? P.c[m * D + k] : P.c_ctx[k]; sc[i] = siluf_(v); }
        __syncthreads();
        float* modv = (float*)(P.ws + WS_MODV);
        const int col = tid & 127, kq = tid >> 7;
        for (int item = blockIdx.x; item < 4 * 48; item += gridDim.x) {
            const int l = item / 48, j = (item % 48) * 128 + col;
            const float* w = P.mod_w + (size_t)l * D * 6144 + j;
            float a[5] = {0.f, 0.f, 0.f, 0.f, 0.f};
#pragma unroll 8
            for (int k = kq * 256; k < kq * 256 + 256; ++k) {
                const float wv = w[(size_t)k * 6144];
#pragma unroll
                for (int m = 0; m < 5; ++m) a[m] += sc[m * 1024 + k] * wv;
            }
#pragma unroll
            for (int m = 0; m < 5; ++m) red[(kq * 128 + col) * 5 + m] = a[m];
            __syncthreads();
            if (kq == 0) {
                const float bias = P.mod_b[l * 6144 + j];
#pragma unroll
                for (int m = 0; m < 5; ++m) {
                    const float s = red[(0 * 128 + col) * 5 + m] + red[(1 * 128 + col) * 5 + m] + red[(2 * 128 + col) * 5 + m] + red[(3 * 128 + col) * 5 + m];
                    modv[(size_t)(l * 5 + m) * 6144 + j] = s + bias;
                }
            }
            __syncthreads();
        }
    }
}

__device__ __forceinline__ void phase_prologue1(int wv, KP Pk) {
    asm volatile("" : "+s"(Pk));
    const CAS Params& P = *Pk;
    const int tid = ltid(wv), lane = tid & 63, wid = tid >> 6;
    bf16_t* act = (bf16_t*)(P.ws + WS_ACT);
    for (int r = blockIdx.x * 8 + wid; r < NROWS; r += gridDim.x * 8) {
        const int m = row_mod(r);
        const float* src = r < NCTX ? P.ctx + (size_t)r * D : P.x + (size_t)(r - NCTX) * D;
        const float* sh = modvec(P.ws, 0, m, 0); const float* sc = modvec(P.ws, 0, m, 1);
#pragma unroll
        for (int i = 0; i < 4; ++i) {
            const int c = 4 * lane + 256 * i;
            const f32x4 v = *(const f32x4*)(src + c), s1 = *(const f32x4*)(sc + c), h1 = *(const f32x4*)(sh + c);
            u32x2 o; o.x = pk2(v[0] * (1.f + s1[0]) + h1[0], v[1] * (1.f + s1[1]) + h1[1]); o.y = pk2(v[2] * (1.f + s1[2]) + h1[2], v[3] * (1.f + s1[3]) + h1[3]);
            *(u32x2*)(act + (size_t)r * D + c) = o;
        }
    }
}

__device__ __forceinline__ void phase_inproj(int wv, KP Pk, int layer, LAS char* lds) {
    asm volatile("" : "+s"(Pk));
    const CAS Params& P = *Pk;
    const int odd = layer & 1, ldp = odd ? LDP_ODD : LDP_EVEN;
    const size_t woff = layer == 0 ? WINT_L0 : layer == 1 ? WINT_L1 : layer == 2 ? WINT_L2 : WINT_L3;
    pg8::Gemm g{(const bf16_t*)(P.ws + WS_ACT), (const bf16_t*)(P.ws + WS_WINT) + woff, NROWS, ldp, D};
    pg8::StaticOrder S; S.init(NROWS, ldp, (int)gridDim.x, (int)blockIdx.x);
    pg8::EpiStoreP E{(bf16_t*)(P.ws + WS_P), ldp};
    pg8::gemm_phase(wv, (PG8_LAS unsigned char*)lds, g, S, E);
    expconv_tail(wv, P, layer, lds, (NROWS / 256) * (ldp / 256), 0, exc_s0(layer));
}
__device__ __forceinline__ void phase_outproj(int wv, KP Pk, int layer, LAS char* lds) {
    asm volatile("" : "+s"(Pk));
    const CAS Params& P = *Pk;
    const int r0 = (layer == DEPTH - 1) ? NCTX : 0;
    pg8::Gemm g{(const bf16_t*)(P.ws + WS_FEAT) + (size_t)r0 * D, (const bf16_t*)(P.ws + WS_WOUTT) + (size_t)layer * D * D, NROWS - r0, D, D};
    pg8::StaticOrder S; S.init(NROWS - r0, D, (int)gridDim.x, (int)blockIdx.x);
    pg8::EpiStoreP E{(bf16_t*)(P.ws + WS_YO) + (size_t)r0 * D, D};
    pg8::gemm_phase(wv, (PG8_LAS unsigned char*)lds, g, S, E);
    expconv_tail(wv, P, layer, lds, ((NROWS - r0) / 256) * (D / 256), exc_s0(layer), exc_s0(layer) + exc_s1(layer));
}
__device__ __forceinline__ void phase_prep2(int wv, KP Pk, int layer, LAS char* lds) {
    asm volatile("" : "+s"(Pk));
    const CAS Params& P = *Pk;
    const int i = layer >> 1;
    const bf16_t* la = (const bf16_t*)(P.ws + WS_LA);
    const bf16_t* lt = (const bf16_t*)(P.ws + WS_LORAT) + (size_t)i * LORA_PER;
    constexpr int MT = NROWS / G_BM, NTL = 512 / G_BN;
    const int ntiles = 4 * MT * NTL;
    for (int t = blockIdx.x; t < ntiles; t += gridDim.x) {
        const int which = t / (MT * NTL), r = t % (MT * NTL), mt = r / NTL, nt = r % NTL;
        RowLinear rs{mt * G_BM};
        if (which < 2) {
            EpiDecay epi{(float*)(P.ws + WS_RWDEC) + (size_t)which * NROWS * 512, P.rw_w0 + (size_t)(i * 2 + which) * 512, mt * G_BM, nt * G_BN};
            gemm_tile(wv, la + which * 64, 320, rs, lt + (size_t)which * 512 * 64, 64, nt * G_BN, 64, epi, lds);
        } else if (which == 2) {
            EpiAK epi{(bf16_t*)(P.ws + WS_RWK), (const bf16_t*)(P.ws + WS_RWKK), (bf16_t*)(P.ws + WS_RWB), P.rw_a0 + i * 512, P.rw_k_a + i * 512, mt * G_BM, nt * G_BN};
            gemm_tile(wv, la + 128, 320, rs, lt + (size_t)2 * 512 * 64, 64, nt * G_BN, 64, epi, lds);
        } else {
            EpiStoreBf16 epi{(bf16_t*)(P.ws + WS_RWG), 512, mt * G_BM, nt * G_BN, 512};
            gemm_tile(wv, la + 192, 320, rs, lt + (size_t)3 * 512 * 64, 128, nt * G_BN, 128, epi, lds);
        }
    }
}
__device__ __forceinline__ void moe_tiles(int wv, const unsigned char* ws, int layer, LAS int* tstart, LAS int* tcnt) {
    const int tid = ltid(wv);
    if (tid < 64) {
        const int* cnt = (const int*)(ws + WS_CNT) + layer * 32 * CNT_STRIDE;
        const int c = tid < NEXP ? cnt[tid * CNT_STRIDE] : 0;
        int incl = (c + G_BM - 1) / G_BM;
#pragma unroll
        for (int o = 1; o < 32; o <<= 1) { const int t = __shfl_up(incl, o); if (tid >= o) incl += t; }
        if (tid < NEXP) { tcnt[tid] = c; tstart[tid] = incl - (c + G_BM - 1) / G_BM; }
        if (tid == NEXP - 1) tstart[NEXP] = incl;
    }
    __syncthreads();
}
__device__ __forceinline__ void phase_moe1(int wv, KP Pk, int layer, LAS char* lds) {
    asm volatile("" : "+s"(Pk));
    const CAS Params& P = *Pk;
    LAS int* tstart = (LAS int*)(lds + pg8::STAGE_BYTES); LAS int* tcnt = tstart + 40;
    moe_tiles(wv, P.ws, layer, tstart, tcnt);
    pg8::Gemm g{(const bf16_t*)(P.ws + WS_ACT), (const bf16_t*)(P.ws + WS_EXPGU), 0, 1024, D};
    LAS int* ltabs = tstart + 128;
    pg8::MoeOrder S{tstart, tcnt, ltabs, (const int*)(P.ws + WS_LIST), (const char*)(P.ws + WS_EXPGU), (size_t)1024 * 1024 * 2, 4, 1, (int)gridDim.x, (int)blockIdx.x};
    pg8::EpiSwiGLUG E{(bf16_t*)(P.ws + WS_HID)};
    for (int i = 0; i < 8; ++i) {
        pg8::UnitG u; if (!S.next(i, u)) break;
        const int tl = ltid(wv);
        const int* ul = (const int*)(P.ws + WS_LIST) + (size_t)u.e * LISTCAP + u.pm * pg8::BM;
        if (tl < pg8::BM) ltabs[i * pg8::BM + tl] = ul[tl < u.cnt ? tl : 0];
    }
    __syncthreads();
    pg8::gemm_phase_g(wv, (PG8_LAS unsigned char*)lds, g, S, E);
    __syncthreads();
}
__device__ __forceinline__ void phase_moe2(int wv, KP Pk, int layer, LAS char* lds) {
    asm volatile("" : "+s"(Pk));
    const CAS Params& P = *Pk;
    LAS int* tstart = (LAS int*)(lds + pg8::STAGE_BYTES); LAS int* tcnt = tstart + 40;
    moe_tiles(wv, P.ws, layer, tstart, tcnt);
    pg8::Gemm g{(const bf16_t*)(P.ws + WS_HID), (const bf16_t*)(P.ws + WS_EXPD), 0, 1024, DEXP};
    LAS int* ltabs = tstart + 128;
    pg8::MoeOrder S{tstart, tcnt, ltabs, (const int*)(P.ws + WS_LIST), (const char*)(P.ws + WS_EXPD), (size_t)1024 * 512 * 2, 4, 0, (int)gridDim.x, (int)blockIdx.x};
    pg8::EpiScatterG E{(bf16_t*)(P.ws + WS_YP)};
    for (int i = 0; i < 8; ++i) {
        pg8::UnitG u; if (!S.next(i, u)) break;
        const int tl = ltid(wv);
        const int* ul = (const int*)(P.ws + WS_LIST) + (size_t)u.e * LISTCAP + u.pm * pg8::BM;
        if (tl < pg8::BM) ltabs[i * pg8::BM + tl] = ul[tl < u.cnt ? tl : 0];
    }
    __syncthreads();
    pg8::gemm_phase_g(wv, (PG8_LAS unsigned char*)lds, g, S, E);
    __syncthreads();
}

constexpr int NCHUNK = NSTEPS / TCH;

constexpr int SSD_F = 32 + 64 + 64;
constexpr int SSD_BUF = TCH * SSD_F + 3 * TCH;

constexpr int ML_F = 64 + 64 + 32;
constexpr int ML_BUF = TCH * ML_F + 4 * TCH;

constexpr int HG_F = 128 + 128 + 32;
constexpr int HG_BUF = TCH * HG_F + TCH;

constexpr int RW_F = 5 * 64 + 32;
constexpr int RW_BUF = TCH * RW_F + TCH;
__device__ __forceinline__ void scan_rwkv(int wv, KP Pk, int layer, int unit, LAS char* lds) {
    asm volatile("" : "+s"(Pk));
    const CAS Params& P = *Pk;
    const int tid = ltid(wv);
    const int seq = unit >> 1, half = unit & 1, b = seq >> 4, h = (seq >> 1) & 7, dir = seq & 1;
    LAS float* bufs = (LAS float*)lds;
    bf16_t* Y = (bf16_t*)(P.ws + (dir ? WS_YB : WS_YF));
    const float* dec = (const float*)(P.ws + WS_RWDEC) + (size_t)dir * NROWS * 512;
    int tj[4], tg_[4]; bool tv[4]; const unsigned char* tbase[4]; int tlds[4];
#pragma unroll
    for (int s = 0; s < 4; ++s) {
        const int task = tid + NT * s; tv[s] = task < TCH * 52; tj[s] = task / 52; tg_[s] = task % 52;
        const int g = tg_[s];
        if (g < 8)       { tbase[s] = P.ws + WS_RWR  + (size_t)(h * 64 + 8 * g) * 2;              tlds[s] = 256 + 8 * g; }
        else if (g < 16) { tbase[s] = P.ws + WS_RWK  + (size_t)(h * 64 + 8 * (g - 8)) * 2;        tlds[s] = 192 + 8 * (g - 8); }
        else if (g < 24) { tbase[s] = P.ws + WS_RWKK + (size_t)(h * 64 + 8 * (g - 16)) * 2;       tlds[s] = 64 + 8 * (g - 16); }
        else if (g < 32) { tbase[s] = P.ws + WS_RWB  + (size_t)(h * 64 + 8 * (g - 24)) * 2;       tlds[s] = 128 + 8 * (g - 24); }
        else if (g < 36) { tbase[s] = P.ws + WS_RWV  + (size_t)(h * 64 + half * 32 + 8 * (g - 32)) * 2; tlds[s] = 320 + 8 * (g - 32); }
        else             { tbase[s] = (const unsigned char*)(dec + h * 64 + 4 * (g - 36));        tlds[s] = 4 * (g - 36); }
    }
    u32x4 rc[4]; int rrow = 0;
    auto load = [&](int c) {
#pragma unroll
        for (int s = 0; s < 4; ++s) {
            rc[s] = (u32x4){0u, 0u, 0u, 0u};
            if (tv[s]) { const int row = scan_row(c * TCH + tj[s], b, dir, 1); rc[s] = *(const u32x4*)(tbase[s] + (size_t)row * (tg_[s] < 36 ? 1024 : 2048)); }
        }
        if (tid < TCH) rrow = scan_row(c * TCH + tid, b, dir, 1);
    };
    auto store = [&](int c) {
        LAS float* buf = bufs + (c & 1) * RW_BUF;
#pragma unroll
        for (int s = 0; s < 4; ++s) {
            if (tv[s]) {
                LAS float* dst = buf + tj[s] * RW_F + tlds[s];
                const int g = tg_[s];
                if (g >= 36) { *(LAS u32x4*)dst = rc[s]; }
                else {
                    float f[8]; unpack8(rc[s], f);
                    const float sg = (g >= 16 && g < 24) ? -1.f : 1.f;
                    *(LAS f32x4*)dst = (f32x4){sg * f[0], sg * f[1], sg * f[2], sg * f[3]}; *(LAS f32x4*)(dst + 4) = (f32x4){sg * f[4], sg * f[5], sg * f[6], sg * f[7]};
                }
            }
        }
        if (tid < TCH) ((LAS int*)buf)[TCH * RW_F + tid] = rrow;
    };
    const int vrow = tid >> 4, q = tid & 15;
    f32x2 S01 = {0.f, 0.f}, S23 = {0.f, 0.f};
    LAS float* ypw = bufs + 2 * RW_BUF + (tid >> 6) * (2 * 16 * 68);
    int prow = -1, gpar = 0;
    load(0); store(0); __syncthreads();
    for (int c = 0; c < NCHUNK; ++c) {
        if (c + 1 < NCHUNK) load(c + 1);
        LAS float* buf = bufs + (c & 1) * RW_BUF;
        {
            const LAS float* wp = buf + 4 * q;
            const LAS float* vp = buf + 320 + vrow;
            f32x4 w4 = *(const LAS f32x4*)wp, a4 = *(const LAS f32x4*)(wp + 64), b4 = *(const LAS f32x4*)(wp + 128), k4 = *(const LAS f32x4*)(wp + 192), r4 = *(const LAS f32x4*)(wp + 256); float vr = vp[0];
#pragma unroll 1
            for (int jh = 0; jh < 2; ++jh) {
                const LAS float* rp = ypw + (gpar ^ 1) * (16 * 68) + q * 68 + ((tid >> 4) & 3) * 16;
                const f32x4 p0 = *(const LAS f32x4*)rp, p1 = *(const LAS f32x4*)(rp + 4), p2 = *(const LAS f32x4*)(rp + 8), p3 = *(const LAS f32x4*)(rp + 12);
                LAS float* wpz = ypw + gpar * (16 * 68) + (tid & 63);
#pragma unroll
                for (int j = 0; j < 16; ++j) {
                    const int jj = jh * 16 + j;
                    const f32x4 wc = w4, ac = a4, bc = b4, kc = k4, rc = r4; const float vv = vr;
                    if (j < 15 || jh == 0) {
                        const LAS float* np = wp + (jj + 1) * RW_F;
                        w4 = *(const LAS f32x4*)np; a4 = *(const LAS f32x4*)(np + 64); b4 = *(const LAS f32x4*)(np + 128); k4 = *(const LAS f32x4*)(np + 192); r4 = *(const LAS f32x4*)(np + 256); vr = vp[(jj + 1) * RW_F];
                    }
                    const f32x2 a01 = {ac[0], ac[1]}, a23 = {ac[2], ac[3]}, w01 = {wc[0], wc[1]}, w23 = {wc[2], wc[3]}, b01 = {bc[0], bc[1]}, b23 = {bc[2], bc[3]};
                    const f32x2 k01 = {kc[0], kc[1]}, k23 = {kc[2], kc[3]}, r01 = {rc[0], rc[1]}, r23 = {rc[2], rc[3]}, vv2 = {vv, vv};
                    f32x2 t = S01 * a01; t = S23 * a23 + t;
                    const f32x2 u01 = S01 * w01 + vv2 * k01, u23 = S23 * w23 + vv2 * k23;
                    const float sa = allreduce16(t.x + t.y);
                    const f32x2 sa2 = {sa, sa};
                    S01 = sa2 * b01 + u01; S23 = sa2 * b23 + u23;
                    f32x2 yv = S01 * r01; yv = S23 * r23 + yv;
                    wpz[j * 68] = yv.x + yv.y;
                }
                if (prow >= 0) {
                    const f32x4 t = (p0 + p1) + (p2 + p3);
                    Y[(size_t)prow * D + 512 + h * 64 + half * 32 + vrow] = f2bf((t[0] + t[1]) + (t[2] + t[3]));
                }
                prow = ((const LAS int*)buf)[TCH * RW_F + jh * 16 + q];
                gpar ^= 1;
            }
        }
        if (c + 1 < NCHUNK) store(c + 1);
        __syncthreads();
    }
    {
        const LAS float* rp = ypw + (gpar ^ 1) * (16 * 68) + q * 68 + ((tid >> 4) & 3) * 16;
        const f32x4 t = (*(const LAS f32x4*)rp + *(const LAS f32x4*)(rp + 4)) + (*(const LAS f32x4*)(rp + 8) + *(const LAS f32x4*)(rp + 12));
        Y[(size_t)prow * D + 512 + h * 64 + half * 32 + vrow] = f2bf((t[0] + t[1]) + (t[2] + t[3]));
    }
}

constexpr size_t WS_EXBC = WS_RWR;
constexpr size_t WS_EQK = WS_EXBC + (size_t)NROWS * 768 * 2;
constexpr size_t WS_EGT = WS_EQK + (size_t)NROWS * 512 * 2;
static_assert(WS_EGT + (size_t)NROWS * 32 * 4 <= WS_LA, "even-layer prepare buffers must fit in the RWKV region");

__device__ __forceinline__ void phase_prep_even(int wv, KP Pk, int layer) {
    asm volatile("" : "+s"(Pk));
    const CAS Params& P = *Pk;
    const int tid = ltid(wv), lane = tid & 63, wid = tid >> 6, i_ = layer >> 1;
    const bf16_t* Pb = (const bf16_t*)(P.ws + WS_P);
    bf16_t* XBC = (bf16_t*)(P.ws + WS_EXBC); bf16_t* QK = (bf16_t*)(P.ws + WS_EQK); float* GT = (float*)(P.ws + WS_EGT);
    float cw0[4][8], cw1[4][8], cwq[4][8];
#pragma unroll
    for (int e = 0; e < 8; ++e) {
#pragma unroll
        for (int t = 0; t < 3; ++t) {
            cw0[t][e] = P.ssd_conv_w[(size_t)(i_ * 3 + t) * 768 + 8 * lane + e];
            cw1[t][e] = P.ssd_conv_w[(size_t)(i_ * 3 + t) * 768 + 512 + 8 * (lane & 31) + e];
            cwq[t][e] = P.ml_conv_w[(size_t)(i_ * 3 + t) * 512 + 8 * lane + e];
        }
        cw0[3][e] = P.ssd_conv_b[i_ * 768 + 8 * lane + e]; cw1[3][e] = P.ssd_conv_b[i_ * 768 + 512 + 8 * (lane & 31) + e]; cwq[3][e] = P.ml_conv_b[i_ * 512 + 8 * lane + e];
    }
    float gbias = 0.f;
    if (lane < 16) gbias = P.ssd_dt_bias[i_ * 16 + lane]; else if (lane < 24) gbias = P.ml_i_bias[i_ * 8 + lane - 16]; else if (lane < 32) gbias = P.ml_f_bias[i_ * 8 + lane - 24];
    const float qscl = lane < 32 ? 0.125f : 1.f;
    const u32x4 zero = (u32x4){0u, 0u, 0u, 0u};
    u32x4 nA[3], nB[3], nC[3]; bf16_t ng = 0;
    auto fetch = [&](int rr) {
        int t, len; row_seg(rr, t, len);
        const bf16_t* pr = Pb + (size_t)rr * LDP_EVEN;
        const bool hp = t > 0, hn = t < len - 1;
        { const int col = 512 + 8 * lane; nA[0] = *(const u32x4*)(pr + col); nA[1] = hp ? *(const u32x4*)(pr - LDP_EVEN + col) : zero; nA[2] = hn ? *(const u32x4*)(pr + LDP_EVEN + col) : zero; }
        if (lane < 32) { const int col = 1024 + 8 * lane; nB[0] = *(const u32x4*)(pr + col); nB[1] = hp ? *(const u32x4*)(pr - LDP_EVEN + col) : zero; nB[2] = hn ? *(const u32x4*)(pr + LDP_EVEN + col) : zero; }
        { const int col = 1296 + 8 * lane; nC[0] = *(const u32x4*)(pr + col); nC[1] = hp ? *(const u32x4*)(pr - LDP_EVEN + col) : zero; nC[2] = hn ? *(const u32x4*)(pr + LDP_EVEN + col) : zero; }
        if (lane < 32) ng = pr[lane < 16 ? 1280 + lane : 2832 + (lane - 16)];
    };
    nB[0] = nB[1] = nB[2] = zero;
    const int stride = gridDim.x * 8;
    int r = blockIdx.x * 8 + wid;
    if (r < NROWS) fetch(r);
    for (; r < NROWS; r += stride) {
        const u32x4 cA0 = nA[0], cA1 = nA[1], cA2 = nA[2], cB0 = nB[0], cB1 = nB[1], cB2 = nB[2], cC0 = nC[0], cC1 = nC[1], cC2 = nC[2]; const bf16_t cg = ng;
        if (r + stride < NROWS) fetch(r + stride);
        float fc[8], fp[8], fn[8], o[8];
        {
            unpack8(cA0, fc); unpack8(cA1, fp); unpack8(cA2, fn);
#pragma unroll
            for (int e = 0; e < 8; ++e) o[e] = siluf_(cw0[0][e] * fp[e] + cw0[1][e] * fc[e] + cw0[2][e] * fn[e] + cw0[3][e]);
            *(u32x4*)(XBC + (size_t)r * 768 + 8 * lane) = pack8(o);
        }
        if (lane < 32) {
            unpack8(cB0, fc); unpack8(cB1, fp); unpack8(cB2, fn);
#pragma unroll
            for (int e = 0; e < 8; ++e) o[e] = siluf_(cw1[0][e] * fp[e] + cw1[1][e] * fc[e] + cw1[2][e] * fn[e] + cw1[3][e]);
            *(u32x4*)(XBC + (size_t)r * 768 + 512 + 8 * lane) = pack8(o);
        }
        {
            unpack8(cC0, fc); unpack8(cC1, fp); unpack8(cC2, fn);
#pragma unroll
            for (int e = 0; e < 8; ++e) o[e] = qscl * siluf_(cwq[0][e] * fp[e] + cwq[1][e] * fc[e] + cwq[2][e] * fn[e] + cwq[3][e]);
            *(u32x4*)(QK + (size_t)r * 512 + 8 * lane) = pack8(o);
        }
        if (lane < 32) {
            const float x = bf2f(cg) + gbias;
            GT[(size_t)r * 32 + lane] = lane < 16 ? softplusf_(x) : lane < 24 ? x : logsigmoidf_(x);
        }
    }
}

constexpr int CL = 64, NCH64 = NSTEPS / CL, LDT = 72, LDTB = LDT * 2;
__device__ __forceinline__ bf16x8 ldfrag(const LAS char* tile, int ldb, int row0, int k0, int lane) {
    return *(const LAS bf16x8*)(tile + (row0 + (lane & 15)) * ldb + (k0 + 8 * (lane >> 4)) * 2);
}
constexpr int LDTS = 160;
__device__ __forceinline__ int swz_off(int row, int byteoff) { return row * LDTS + (byteoff ^ (((row >> 3) & 7) << 4)); }
__device__ __forceinline__ bf16x8 ldfrag_sw(const LAS char* tile, int row0, int k0, int lane) {
    const int row = row0 + (lane & 15);
    return *(const LAS bf16x8*)(tile + swz_off(row, (k0 + 8 * (lane >> 4)) * 2));
}
__device__ __forceinline__ void st4bf(LAS char* p, const f32x4& v) { u32x2 o; o.x = pk2(v[0], v[1]); o.y = pk2(v[2], v[3]); *(LAS u32x2*)p = o; }

constexpr int SS_BT = 0, SS_CT = SS_BT + 64 * LDTB, SS_BDT = SS_CT + 64 * LDTB, SS_XT = SS_BDT + 64 * LDTB, SS_CUM = SS_XT + 32 * LDTB, SS_DTV = SS_CUM + 256, SS_ROWS = SS_DTV + 256, SS_STG = SS_ROWS + 256;
constexpr int SS_M = 2 * SS_STG, SS_HB = SS_M + 64 * LDTB, SS_END = SS_HB + 32 * LDTB;
static_assert(SS_END <= LDS_BYTES - 16, "SSD LDS map");

constexpr int MS_QT = 0, MS_KT = MS_QT + 64 * LDTB, MS_KET = MS_KT + 64 * LDTB, MS_VT = MS_KET + 64 * LDTB, MS_SC = MS_VT + 32 * LDTB;
constexpr int MS_STG = MS_SC + 8 * 256;
constexpr int MS_W = 2 * MS_STG, MS_CB = MS_W + 64 * LDTB, MS_ONE = MS_CB + 32 * LDTB, MS_NV = MS_ONE + 16 * LDTB, MS_QN = MS_NV + 256, MS_END = MS_QN + 256;
static_assert(MS_END <= LDS_BYTES - 16, "mLSTM LDS map");

constexpr size_t WS_XSS = WS_EGT + al256((size_t)NROWS * 32 * 4);
constexpr size_t XSS_BYTES = (size_t)64 * NCH64 * 64 * 64 * 2;
constexpr size_t WS_XSD = WS_XSS + XSS_BYTES;
constexpr size_t WS_XMC = WS_XSD + al256((size_t)64 * NCH64 * 4);
constexpr size_t XMC_BYTES = (size_t)32 * NCH64 * 128 * 64 * 2;
constexpr size_t WS_XMN = WS_XMC + XMC_BYTES;
constexpr size_t WS_XMS = WS_XMN + (size_t)32 * NCH64 * 64 * 4;
constexpr size_t WS_XMT = WS_XMS + al256((size_t)32 * NCH64 * 4 * 4);
constexpr size_t WS_XEND = WS_XMT + (size_t)32 * NCH64 * 3 * 64 * 4;
static_assert(WS_XEND <= WS_END, "even-layer chunk-state buffers must fit in the RWKV region");
constexpr int NSSD_ITEMS = 64 * NCH64, NML_ITEMS = 32 * NCH64;

template <int CTRL, int RM, int BM> __device__ __forceinline__ float dppx(float old, float v) {
    return __builtin_bit_cast(float, __builtin_amdgcn_update_dpp(__builtin_bit_cast(int, old), __builtin_bit_cast(int, v), CTRL, RM, BM, false));
}
__device__ __forceinline__ float wave_cumsum(float v, int) {
    float t = v;
    t += dppx<0x111, 0xf, 0xf>(0.f, v); t += dppx<0x112, 0xf, 0xf>(0.f, v); t += dppx<0x113, 0xf, 0xf>(0.f, v);
    { const float u = dppx<0x114, 0xf, 0xe>(0.f, t); t += u; }
    { const float u = dppx<0x118, 0xf, 0xc>(0.f, t); t += u; }
    { const float u = dppx<0x142, 0xa, 0xf>(0.f, t); t += u; }
    { const float u = dppx<0x143, 0xc, 0xf>(0.f, t); t += u; }
    return t;
}
__device__ __forceinline__ float wave_cummax(float v, int) {
    const float ninf = -__builtin_huge_valf();
    float t = v;
    t = fmaxf(t, dppx<0x111, 0xf, 0xf>(ninf, v)); t = fmaxf(t, dppx<0x112, 0xf, 0xf>(ninf, v)); t = fmaxf(t, dppx<0x113, 0xf, 0xf>(ninf, v));
    { const float u = dppx<0x114, 0xf, 0xe>(ninf, t); t = fmaxf(t, u); }
    { const float u = dppx<0x118, 0xf, 0xc>(ninf, t); t = fmaxf(t, u); }
    { const float u = dppx<0x142, 0xa, 0xf>(ninf, t); t = fmaxf(t, u); }
    { const float u = dppx<0x143, 0xc, 0xf>(ninf, t); t = fmaxf(t, u); }
    return t;
}
__device__ __forceinline__ float wave_max(float v) {
    const float t = wave_cummax(v, 0);
    return __builtin_bit_cast(float, __builtin_amdgcn_readlane(__builtin_bit_cast(int, t), 63));
}

constexpr int X1S_BDT = 0, X1S_XT = X1S_BDT + 64 * LDTS, X1S_CUM = X1S_XT + 64 * LDTS, X1S_DTV = X1S_CUM + 256, X1S_END = X1S_DTV + 256;
constexpr int X1M_KET = 0, X1M_VT = X1M_KET + 64 * LDTS, X1M_ONE = X1M_VT + 128 * LDTS, X1M_EE = X1M_ONE + 16 * LDTB, X1M_END = X1M_EE + 256;
__device__ __forceinline__ void phase_ex1(int wv, KP Pk, int layer, LAS char* lds) {
    asm volatile("" : "+s"(Pk));
    const CAS Params& P = *Pk;
    const int tid = ltid(wv), lane = tid & 63, wid = tid >> 6, q = lane >> 4, r16 = lane & 15, i_ = layer >> 1;
    const bf16_t* XBC = (const bf16_t*)(P.ws + WS_EXBC); const bf16_t* QK = (const bf16_t*)(P.ws + WS_EQK); const bf16_t* Pb = (const bf16_t*)(P.ws + WS_P);
    const float* GT = (const float*)(P.ws + WS_EGT);
    {
        bf16_t* Hst = (bf16_t*)(P.ws + WS_XSS); float* Dst = (float*)(P.ws + WS_XSD);
        u32x4 rc[2]; float rdt = 0.f;
        auto geom = [&](int it, int& b, int& h, int& dir, int& c) { const int sq = it / NCH64; c = it - sq * NCH64; b = sq >> 4; h = (sq >> 1) & 7; dir = sq & 1; };
        auto load = [&](int it) {
            int b, h, dir, c; geom(it, b, h, dir, c);
            int tl = tid; asm volatile("" : "+v"(tl));
#pragma unroll
            for (int s = 0; s < 2; ++s) {
                const int task = tl + NT * s, j = task >> 4, g = task & 15;
                const int row = scan_row(c * CL + j, b, dir, 0);
                rc[s] = *(const u32x4*)(XBC + (size_t)row * 768 + (g < 8 ? h * 64 + 8 * g : 512 + (h >> 2) * 64 + 8 * (g - 8)));
            }
            if (tl < CL) { const int row = scan_row(c * CL + tl, b, dir, 0); rdt = GT[(size_t)row * 32 + dir * 8 + h]; }
        };
        int it = blockIdx.x;
        if (it < NSSD_ITEMS) load(it);
        for (; it < NSSD_ITEMS; it += gridDim.x) {
            int b, h, dir, c; geom(it, b, h, dir, c);
            const float aco = -__expf(P.ssd_a_log[(i_ * 2 + dir) * 8 + h]);
            if (tid < CL) {
                const float cum = wave_cumsum(rdt * aco, lane);
                ((LAS float*)(lds + X1S_CUM))[tid] = cum; ((LAS float*)(lds + X1S_DTV))[tid] = rdt;
            }
            __syncthreads();
            {
                const LAS float* cum = (const LAS float*)(lds + X1S_CUM);
                const float cumL = cum[CL - 1];
                int tl = tid; asm volatile("" : "+v"(tl));
#pragma unroll
                for (int s = 0; s < 2; ++s) {
                    const int task = tl + NT * s, j = task >> 4, g = task & 15;
                    float f[8]; unpack8(rc[s], f);
                    if (g < 8) {
                        const float dt = ((const LAS float*)(lds + X1S_DTV))[j];
#pragma unroll
                        for (int e = 0; e < 8; ++e) *(LAS bf16_t*)(lds + X1S_XT + swz_off(8 * g + e, j * 2)) = f2bf(f[e] * dt);
                    } else {
                        const float sc = __expf(cumL - cum[j]);
#pragma unroll
                        for (int e = 0; e < 8; ++e) *(LAS bf16_t*)(lds + X1S_BDT + swz_off(8 * (g - 8) + e, j * 2)) = f2bf(f[e] * sc);
                    }
                }
                if (tid == 0) Dst[it] = __expf(cumL);
            }
            if (it + (int)gridDim.x < NSSD_ITEMS) load(it + gridDim.x);
            __syncthreads();
            {
                const int pt = wid >> 1;
#pragma unroll
                for (int u = 0; u < 2; ++u) {
                    const int nt = (wid & 1) * 2 + u;
                    f32x4 sa = (f32x4){0.f, 0.f, 0.f, 0.f};
#pragma unroll
                    for (int k0 = 0; k0 < 64; k0 += 32) sa = __builtin_amdgcn_mfma_f32_16x16x32_bf16(ldfrag_sw(lds + X1S_BDT, nt * 16, k0, lane), ldfrag_sw(lds + X1S_XT, pt * 16, k0, lane), sa, 0, 0, 0);
                    u32x2 o; o.x = pk2(sa[0], sa[1]); o.y = pk2(sa[2], sa[3]);
                    *(u32x2*)(Hst + ((size_t)it * 64 + pt * 16 + r16) * 64 + nt * 16 + 4 * q) = o;
                }
            }
            __syncthreads();
        }
    }
    {
        bf16_t* Cst = (bf16_t*)(P.ws + WS_XMC); float* Nst = (float*)(P.ws + WS_XMN); float* Sst = (float*)(P.ws + WS_XMS); float* Tst = (float*)(P.ws + WS_XMT);
        for (int i = tid; i < 16 * LDTB / 4; i += NT) ((LAS unsigned*)(lds + X1M_ONE))[i] = 0x3f803f80u;
        u32x4 rc[3]; float rli = 0.f, rlf = 0.f;
        auto geom = [&](int it, int& b, int& h, int& dir, int& c) { const int sq = it / NCH64; c = it - sq * NCH64; b = sq >> 3; h = (sq >> 1) & 3; dir = sq & 1; };
        auto load = [&](int it) {
            int b, h, dir, c; geom(it, b, h, dir, c);
            int tl = tid; asm volatile("" : "+v"(tl));
#pragma unroll
            for (int s = 0; s < 3; ++s) {
                const int task = tl + NT * s, j = task / 24, g = task - 24 * j;
                const int row = scan_row(c * CL + j, b, dir, 0);
                rc[s] = g < 8 ? *(const u32x4*)(QK + (size_t)row * 512 + 256 + h * 64 + 8 * g) : *(const u32x4*)(Pb + (size_t)row * LDP_EVEN + 1808 + h * 128 + 8 * (g - 8));
            }
            if (tl < CL) { const int row = scan_row(c * CL + tl, b, dir, 0); rli = GT[(size_t)row * 32 + 16 + dir * 4 + h]; rlf = GT[(size_t)row * 32 + 24 + dir * 4 + h]; }
        };
        int it = blockIdx.x;
        if (it < NML_ITEMS) load(it);
        __syncthreads();
        for (; it < NML_ITEMS; it += gridDim.x) {
            if (tid < CL) {
                const float fcum = wave_cumsum(rlf, lane);
                const float ftot = __builtin_bit_cast(float, __builtin_amdgcn_readlane(__builtin_bit_cast(int, fcum), 63));
                const float g = rli - fcum, pm = wave_cummax(g, lane);
                const float wend = ftot + g, mloc = wave_max(wend);
                ((LAS float*)(lds + X1M_EE))[tid] = __expf(wend - mloc);
                float* tp = Tst + (size_t)it * 192;
                tp[tid] = fcum; tp[64 + tid] = g; tp[128 + tid] = pm;
                if (tid == 0) { Sst[(size_t)it * 4 + 0] = ftot; Sst[(size_t)it * 4 + 1] = mloc; }
            }
            __syncthreads();
            {
                const LAS float* ee = (const LAS float*)(lds + X1M_EE);
                int tl = tid; asm volatile("" : "+v"(tl));
#pragma unroll
                for (int s = 0; s < 3; ++s) {
                    const int task = tl + NT * s, j = task / 24, g = task - 24 * j;
                    if (g < 8) {
                        float f[8]; unpack8(rc[s], f);
                        const float e1 = ee[j];
#pragma unroll
                        for (int e = 0; e < 8; ++e) *(LAS bf16_t*)(lds + X1M_KET + swz_off(8 * g + e, j * 2)) = f2bf(f[e] * e1);
                    } else {
                        const int v0 = 8 * (g - 8);
#pragma unroll
                        for (int e = 0; e < 8; ++e) { const unsigned wv = rc[s][e >> 1]; *(LAS bf16_t*)(lds + X1M_VT + swz_off(v0 + e, j * 2)) = (bf16_t)((e & 1) ? (wv >> 16) : (wv & 0xffffu)); }
                    }
                }
            }
            if (it + (int)gridDim.x < NML_ITEMS) load(it + gridDim.x);
            __syncthreads();
            {
                const bf16x8 vf0 = ldfrag_sw(lds + X1M_VT, wid * 16, 0, lane), vf1 = ldfrag_sw(lds + X1M_VT, wid * 16, 32, lane);
#pragma unroll
                for (int kt = 0; kt < 4; ++kt) {
                    f32x4 sa = __builtin_amdgcn_mfma_f32_16x16x32_bf16(ldfrag_sw(lds + X1M_KET, kt * 16, 0, lane), vf0, (f32x4){0.f, 0.f, 0.f, 0.f}, 0, 0, 0);
                    sa = __builtin_amdgcn_mfma_f32_16x16x32_bf16(ldfrag_sw(lds + X1M_KET, kt * 16, 32, lane), vf1, sa, 0, 0, 0);
                    u32x2 o; o.x = pk2(sa[0], sa[1]); o.y = pk2(sa[2], sa[3]);
                    *(u32x2*)(Cst + ((size_t)it * 128 + wid * 16 + r16) * 64 + kt * 16 + 4 * q) = o;
                }
                if (wid < 4) {
                    f32x4 na = __builtin_amdgcn_mfma_f32_16x16x32_bf16(ldfrag_sw(lds + X1M_KET, wid * 16, 0, lane), ldfrag(lds + X1M_ONE, LDTB, 0, 0, lane), (f32x4){0.f, 0.f, 0.f, 0.f}, 0, 0, 0);
                    na = __builtin_amdgcn_mfma_f32_16x16x32_bf16(ldfrag_sw(lds + X1M_KET, wid * 16, 32, lane), ldfrag(lds + X1M_ONE, LDTB, 0, 32, lane), na, 0, 0, 0);
                    if (r16 == 0) *(f32x4*)(Nst + (size_t)it * 64 + wid * 16 + 4 * q) = na;
                }
            }
            __syncthreads();
        }
    }
}

constexpr int EX2_UB = 12;
static_assert(NCH64 % EX2_UB == 0, "EX2 batches");
__device__ __forceinline__ void phase_ex2(int wv, KP Pk, int layer) {
    asm volatile("" : "+s"(Pk));
    const CAS Params& P = *Pk;
    const int tid = ltid(wv);
    (void)layer;
    if (blockIdx.x < 128) {
        const int gt = blockIdx.x * NT + tid, sq = gt >> 10, rem = gt & 1023;
        bf16_t* Hst = (bf16_t*)(P.ws + WS_XSS) + (size_t)sq * NCH64 * 4096 + rem * 4;
        const float* Dst = (const float*)(P.ws + WS_XSD) + sq * NCH64;
        float h0 = 0.f, h1 = 0.f, h2 = 0.f, h3 = 0.f;
#pragma unroll 1
        for (int c0 = 0; c0 < NCH64; c0 += EX2_UB) {
            u32x2 loc[EX2_UB]; float dd[EX2_UB];
            bf16_t* hp = Hst + (size_t)c0 * 4096;
#pragma unroll
            for (int u = 0; u < EX2_UB; ++u) { loc[u] = *(const u32x2*)(hp + (size_t)u * 4096); dd[u] = Dst[c0 + u]; }
#pragma unroll
            for (int u = 0; u < EX2_UB; ++u) {
                u32x2 o; o.x = pk2(h0, h1); o.y = pk2(h2, h3);
                *(u32x2*)(hp + (size_t)u * 4096) = o;
                const float d = dd[u];
                h0 = d * h0 + bflo(loc[u].x); h1 = d * h1 + bfhi(loc[u].x); h2 = d * h2 + bflo(loc[u].y); h3 = d * h3 + bfhi(loc[u].y);
            }
        }
    } else if (blockIdx.x < 256) {
        const int gt = (blockIdx.x - 128) * NT + tid, sq = gt >> 11, rem = gt & 2047;
        bf16_t* Cst = (bf16_t*)(P.ws + WS_XMC) + (size_t)sq * NCH64 * 8192 + rem * 4;
        float* Nst = (float*)(P.ws + WS_XMN) + (size_t)sq * NCH64 * 64 + (rem & 15) * 4;
        float* Sst = (float*)(P.ws + WS_XMS) + (size_t)sq * NCH64 * 4;
        const bool own_n = rem < 16, own_m = rem == 0;
        float c0_ = 0.f, c1 = 0.f, c2 = 0.f, c3 = 0.f, m = -1e30f;
        f32x4 nn = (f32x4){0.f, 0.f, 0.f, 0.f};
#pragma unroll 1
        for (int cb = 0; cb < NCH64; cb += EX2_UB) {
            u32x2 loc[EX2_UB]; float ft[EX2_UB], ml[EX2_UB]; f32x4 nl[EX2_UB];
            bf16_t* cp = Cst + (size_t)cb * 8192; float* np = Nst + (size_t)cb * 64; float* sp_ = Sst + cb * 4;
#pragma unroll
            for (int u = 0; u < EX2_UB; ++u) {
                loc[u] = *(const u32x2*)(cp + (size_t)u * 8192); ft[u] = sp_[u * 4 + 0]; ml[u] = sp_[u * 4 + 1];
                nl[u] = (f32x4){0.f, 0.f, 0.f, 0.f};
                if (own_n) nl[u] = *(const f32x4*)(np + (size_t)u * 64);
            }
#pragma unroll
            for (int u = 0; u < EX2_UB; ++u) {
                const float ftot = ft[u], mloc = ml[u];
                const float mnew = fmaxf(ftot + m, mloc), sp = __expf(ftot + m - mnew), sl = __expf(mloc - mnew);
                u32x2 o; o.x = pk2(c0_, c1); o.y = pk2(c2, c3);
                *(u32x2*)(cp + (size_t)u * 8192) = o;
                c0_ = sp * c0_ + sl * bflo(loc[u].x); c1 = sp * c1 + sl * bfhi(loc[u].x); c2 = sp * c2 + sl * bflo(loc[u].y); c3 = sp * c3 + sl * bfhi(loc[u].y);
                if (own_n) { *(f32x4*)(np + (size_t)u * 64) = nn; nn = nn * sp + nl[u] * sl; }
                if (own_m) sp_[u * 4 + 2] = m;
                m = mnew;
            }
        }
    }
}

constexpr int X3S_BT = 0, X3S_CT = X3S_BT + 64 * LDTB, X3S_XT = X3S_CT + 64 * LDTB, X3S_HB = X3S_XT + 64 * LDTS, X3S_M = X3S_HB + 64 * LDTB, X3S_CUM = X3S_M + 64 * LDTB, X3S_DTV = X3S_CUM + 256, X3S_ROWS = X3S_DTV + 256, X3S_END = X3S_ROWS + 256;
constexpr int X3M_QT = 0, X3M_KT = X3M_QT + 64 * LDTB, X3M_VT = X3M_KT + 64 * LDTB, X3M_CB = X3M_VT + 128 * LDTS, X3M_W = X3M_CB + 128 * LDTB, X3M_ONE = X3M_W + 64 * LDTB, X3M_NB = X3M_ONE + 16 * LDTB,
              X3M_SC = X3M_NB + 16 * LDTB, X3M_END = X3M_SC + 6 * 256;
static_assert(X3M_END <= LDS_BYTES - 16 && X3S_END <= LDS_BYTES - 16, "EX3 LDS maps");
__device__ __forceinline__ void phase_ex3(int wv, KP Pk, int layer, LAS char* lds) {
    asm volatile("" : "+s"(Pk));
    const CAS Params& P = *Pk;
    const int tid = ltid(wv), lane = tid & 63, wid = tid >> 6, q = lane >> 4, r16 = lane & 15, i_ = layer >> 1;
    const bf16_t* XBC = (const bf16_t*)(P.ws + WS_EXBC); const bf16_t* QK = (const bf16_t*)(P.ws + WS_EQK); const bf16_t* Pb = (const bf16_t*)(P.ws + WS_P);
    const float* GT = (const float*)(P.ws + WS_EGT);
    {
        const bf16_t* Hst = (const bf16_t*)(P.ws + WS_XSS);
        u32x4 rc[3], rh; float rdt = 0.f; int rrow = 0;
        auto geom = [&](int it, int& b, int& h, int& dir, int& c) { const int sq = it / NCH64; c = it - sq * NCH64; b = sq >> 4; h = (sq >> 1) & 7; dir = sq & 1; };
        auto load = [&](int it) {
            int b, h, dir, c; geom(it, b, h, dir, c);
            int tl = tid; asm volatile("" : "+v"(tl));
#pragma unroll
            for (int s = 0; s < 3; ++s) {
                const int task = tl + NT * s, j = task / 24, g = task - 24 * j;
                const int row = scan_row(c * CL + j, b, dir, 0);
                rc[s] = *(const u32x4*)(XBC + (size_t)row * 768 + (g < 8 ? h * 64 + 8 * g : g < 16 ? 512 + (h >> 2) * 64 + 8 * (g - 8) : 640 + (h >> 2) * 64 + 8 * (g - 16)));
            }
            rh = *(const u32x4*)(Hst + (size_t)it * 4096 + tl * 8);
            if (tl < CL) { rrow = scan_row(c * CL + tl, b, dir, 0); rdt = GT[(size_t)rrow * 32 + dir * 8 + h]; }
        };
        int it = blockIdx.x;
        if (it < NSSD_ITEMS) load(it);
        __syncthreads();
        for (; it < NSSD_ITEMS; it += gridDim.x) {
            int b, h, dir, c; geom(it, b, h, dir, c);
            bf16_t* Y = (bf16_t*)(P.ws + (dir ? WS_YB : WS_YF));
            const float aco = -__expf(P.ssd_a_log[(i_ * 2 + dir) * 8 + h]);
            if (tid < CL) {
                const float cum = wave_cumsum(rdt * aco, lane);
                ((LAS float*)(lds + X3S_CUM))[tid] = cum; ((LAS float*)(lds + X3S_DTV))[tid] = rdt; ((LAS int*)(lds + X3S_ROWS))[tid] = rrow;
            }
            __syncthreads();
            {
                int tl = tid; asm volatile("" : "+v"(tl));
#pragma unroll
                for (int s = 0; s < 3; ++s) {
                    const int task = tl + NT * s, j = task / 24, g = task - 24 * j;
                    if (g < 8) {
                        float f[8]; unpack8(rc[s], f);
                        const float dt = ((const LAS float*)(lds + X3S_DTV))[j];
#pragma unroll
                        for (int e = 0; e < 8; ++e) *(LAS bf16_t*)(lds + X3S_XT + swz_off(8 * g + e, j * 2)) = f2bf(f[e] * dt);
                    } else if (g < 16) *(LAS u32x4*)(lds + X3S_BT + j * LDTB + 8 * (g - 8) * 2) = rc[s];
                    else *(LAS u32x4*)(lds + X3S_CT + j * LDTB + 8 * (g - 16) * 2) = rc[s];
                }
                *(LAS u32x4*)(lds + X3S_HB + (tl >> 3) * LDTB + (tl & 7) * 16) = rh;
            }
            if (it + (int)gridDim.x < NSSD_ITEMS) load(it + gridDim.x);
            __syncthreads();
            const LAS float* cum = (const LAS float*)(lds + X3S_CUM);
            {
                const int lt = wid >> 1;
#pragma unroll
                for (int u = 0; u < 2; ++u) {
                    const int st = (wid & 1) * 2 + u;
                    f32x4 acc = (f32x4){0.f, 0.f, 0.f, 0.f};
                    if (st <= lt) {
#pragma unroll
                        for (int k0 = 0; k0 < 64; k0 += 32) acc = __builtin_amdgcn_mfma_f32_16x16x32_bf16(ldfrag(lds + X3S_BT, LDTB, st * 16, k0, lane), ldfrag(lds + X3S_CT, LDTB, lt * 16, k0, lane), acc, 0, 0, 0);
                        const int l = lt * 16 + r16, s0 = st * 16 + 4 * q;
                        const float cl = cum[l]; const f32x4 cs = *(const LAS f32x4*)(cum + s0);
#pragma unroll
                        for (int j = 0; j < 4; ++j) acc[j] = (s0 + j <= l) ? acc[j] * __expf(cl - cs[j]) : 0.f;
                    }
                    st4bf(lds + X3S_M + (lt * 16 + r16) * LDTB + (st * 16 + 4 * q) * 2, acc);
                }
            }
            __syncthreads();
            {
                const int lt = wid >> 1, l = lt * 16 + r16;
                const float el = __expf(cum[l]);
                const int row = ((const LAS int*)(lds + X3S_ROWS))[l];
                const bf16x8 mf0 = ldfrag(lds + X3S_M, LDTB, lt * 16, 0, lane), mf1 = ldfrag(lds + X3S_M, LDTB, lt * 16, 32, lane);
                const bf16x8 cf0 = ldfrag(lds + X3S_CT, LDTB, lt * 16, 0, lane), cf1 = ldfrag(lds + X3S_CT, LDTB, lt * 16, 32, lane);
#pragma unroll
                for (int u = 0; u < 2; ++u) {
                    const int pt = (wid & 1) * 2 + u;
                    f32x4 ya = __builtin_amdgcn_mfma_f32_16x16x32_bf16(ldfrag_sw(lds + X3S_XT, pt * 16, 0, lane), mf0, (f32x4){0.f, 0.f, 0.f, 0.f}, 0, 0, 0);
                    ya = __builtin_amdgcn_mfma_f32_16x16x32_bf16(ldfrag_sw(lds + X3S_XT, pt * 16, 32, lane), mf1, ya, 0, 0, 0);
                    f32x4 oa = __builtin_amdgcn_mfma_f32_16x16x32_bf16(ldfrag(lds + X3S_HB, LDTB, pt * 16, 0, lane), cf0, (f32x4){0.f, 0.f, 0.f, 0.f}, 0, 0, 0);
                    oa = __builtin_amdgcn_mfma_f32_16x16x32_bf16(ldfrag(lds + X3S_HB, LDTB, pt * 16, 32, lane), cf1, oa, 0, 0, 0);
                    u32x2 o; o.x = pk2(ya[0] + el * oa[0], ya[1] + el * oa[1]); o.y = pk2(ya[2] + el * oa[2], ya[3] + el * oa[3]);
                    *(u32x2*)(Y + (size_t)row * D + h * 64 + pt * 16 + 4 * q) = o;
                }
            }
            __syncthreads();
        }
    }
    {
        const bf16_t* Cst = (const bf16_t*)(P.ws + WS_XMC); const float* Nst = (const float*)(P.ws + WS_XMN); const float* Sst = (const float*)(P.ws + WS_XMS); const float* Tst = (const float*)(P.ws + WS_XMT);
        for (int i = tid; i < 16 * LDTB / 4; i += NT) ((LAS unsigned*)(lds + X3M_ONE))[i] = 0x3f803f80u;
        u32x4 rc[4], rcb[2]; float rfc = 0.f, rg = 0.f, rpm = 0.f, rmp = 0.f, rn = 0.f; int rrow = 0;
        auto geom = [&](int it, int& b, int& h, int& dir, int& c) { const int sq = it / NCH64; c = it - sq * NCH64; b = sq >> 3; h = (sq >> 1) & 3; dir = sq & 1; };
        auto load = [&](int it) {
            int b, h, dir, c; geom(it, b, h, dir, c);
            int tl = tid; asm volatile("" : "+v"(tl));
#pragma unroll
            for (int s = 0; s < 4; ++s) {
                const int task = tl + NT * s, j = task >> 5, g = task & 31;
                const int row = scan_row(c * CL + j, b, dir, 0);
                rc[s] = g < 16 ? *(const u32x4*)(QK + (size_t)row * 512 + (g < 8 ? h * 64 + 8 * g : 256 + h * 64 + 8 * (g - 8))) : *(const u32x4*)(Pb + (size_t)row * LDP_EVEN + 1808 + h * 128 + 8 * (g - 16));
            }
#pragma unroll
            for (int s = 0; s < 2; ++s) rcb[s] = *(const u32x4*)(Cst + (size_t)it * 8192 + (tl + NT * s) * 8);
            if (tl < CL) {
                rrow = scan_row(c * CL + tl, b, dir, 0);
                const float* tp = Tst + (size_t)it * 192;
                rfc = tp[tl]; rg = tp[64 + tl]; rpm = tp[128 + tl]; rmp = Sst[(size_t)it * 4 + 2]; rn = Nst[(size_t)it * 64 + tl];
            }
        };
        int it = blockIdx.x;
        if (it < NML_ITEMS) load(it);
        __syncthreads();
        for (; it < NML_ITEMS; it += gridDim.x) {
            int b, h, dir, c; geom(it, b, h, dir, c);
            bf16_t* Y = (bf16_t*)(P.ws + (dir ? WS_YB : WS_YF));
            LAS float* sc = (LAS float*)(lds + X3M_SC);
            {
                int tl = tid; asm volatile("" : "+v"(tl));
#pragma unroll
                for (int s = 0; s < 4; ++s) {
                    const int task = tl + NT * s, j = task >> 5, g = task & 31;
                    if (g < 8) *(LAS u32x4*)(lds + X3M_QT + j * LDTB + 8 * g * 2) = rc[s];
                    else if (g < 16) *(LAS u32x4*)(lds + X3M_KT + j * LDTB + 8 * (g - 8) * 2) = rc[s];
                    else {
                        const int v0 = 8 * (g - 16);
#pragma unroll
                        for (int e = 0; e < 8; ++e) { const unsigned wv = rc[s][e >> 1]; *(LAS bf16_t*)(lds + X3M_VT + swz_off(v0 + e, j * 2)) = (bf16_t)((e & 1) ? (wv >> 16) : (wv & 0xffffu)); }
                    }
                }
#pragma unroll
                for (int s = 0; s < 2; ++s) { const int ch = tl + NT * s; *(LAS u32x4*)(lds + X3M_CB + (ch >> 3) * LDTB + (ch & 7) * 16) = rcb[s]; }
                if (tl < CL) {
                    const float linter = rfc + rmp, mrow = fmaxf(rfc + rpm, linter);
                    sc[tl] = rfc - mrow; sc[64 + tl] = rg; sc[128 + tl] = __expf(linter - mrow); sc[192 + tl] = __expf(-mrow); ((LAS int*)sc)[256 + tl] = rrow;
                    const bf16_t nb = f2bf(rn);
#pragma unroll
                    for (int r = 0; r < 16; ++r) *(LAS bf16_t*)(lds + X3M_NB + r * LDTB + tl * 2) = nb;
                }
            }
            if (it + (int)gridDim.x < NML_ITEMS) load(it + gridDim.x);
            __syncthreads();
            {
                const int lt = wid >> 1;
#pragma unroll
                for (int u = 0; u < 2; ++u) {
                    const int st = (wid & 1) * 2 + u;
                    f32x4 acc = (f32x4){0.f, 0.f, 0.f, 0.f};
                    if (st <= lt) {
#pragma unroll
                        for (int k0 = 0; k0 < 64; k0 += 32) acc = __builtin_amdgcn_mfma_f32_16x16x32_bf16(ldfrag(lds + X3M_KT, LDTB, st * 16, k0, lane), ldfrag(lds + X3M_QT, LDTB, lt * 16, k0, lane), acc, 0, 0, 0);
                        const int l = lt * 16 + r16, s0 = st * 16 + 4 * q;
                        const float rt = sc[l]; const f32x4 gs = *(const LAS f32x4*)(sc + 64 + s0);
#pragma unroll
                        for (int j = 0; j < 4; ++j) acc[j] = (s0 + j <= l) ? acc[j] * __expf(rt + gs[j]) : 0.f;
                    }
                    st4bf(lds + X3M_W + (lt * 16 + r16) * LDTB + (st * 16 + 4 * q) * 2, acc);
                }
            }
            __syncthreads();
            {
                const int lt = wid >> 1, l = lt * 16 + r16;
                const bf16x8 wf0 = ldfrag(lds + X3M_W, LDTB, lt * 16, 0, lane), wf1 = ldfrag(lds + X3M_W, LDTB, lt * 16, 32, lane);
                const bf16x8 qf0 = ldfrag(lds + X3M_QT, LDTB, lt * 16, 0, lane), qf1 = ldfrag(lds + X3M_QT, LDTB, lt * 16, 32, lane);
                f32x4 da = __builtin_amdgcn_mfma_f32_16x16x32_bf16(ldfrag(lds + X3M_ONE, LDTB, 0, 0, lane), wf0, (f32x4){0.f, 0.f, 0.f, 0.f}, 0, 0, 0);
                da = __builtin_amdgcn_mfma_f32_16x16x32_bf16(ldfrag(lds + X3M_ONE, LDTB, 0, 32, lane), wf1, da, 0, 0, 0);
                f32x4 qn = __builtin_amdgcn_mfma_f32_16x16x32_bf16(ldfrag(lds + X3M_NB, LDTB, 0, 0, lane), qf0, (f32x4){0.f, 0.f, 0.f, 0.f}, 0, 0, 0);
                qn = __builtin_amdgcn_mfma_f32_16x16x32_bf16(ldfrag(lds + X3M_NB, LDTB, 0, 32, lane), qf1, qn, 0, 0, 0);
                const float inter = sc[128 + l], emr = sc[192 + l];
                const float inv = __builtin_amdgcn_rcpf(fmaxf(fabsf(da[0] + inter * qn[0]), emr));
                const int row = ((const LAS int*)sc)[256 + l];
#pragma unroll
                for (int u = 0; u < 4; ++u) {
                    const int vt = (wid & 1) * 4 + u;
                    f32x4 na = __builtin_amdgcn_mfma_f32_16x16x32_bf16(ldfrag_sw(lds + X3M_VT, vt * 16, 0, lane), wf0, (f32x4){0.f, 0.f, 0.f, 0.f}, 0, 0, 0);
                    na = __builtin_amdgcn_mfma_f32_16x16x32_bf16(ldfrag_sw(lds + X3M_VT, vt * 16, 32, lane), wf1, na, 0, 0, 0);
                    f32x4 ca = __builtin_amdgcn_mfma_f32_16x16x32_bf16(ldfrag(lds + X3M_CB, LDTB, vt * 16, 0, lane), qf0, (f32x4){0.f, 0.f, 0.f, 0.f}, 0, 0, 0);
                    ca = __builtin_amdgcn_mfma_f32_16x16x32_bf16(ldfrag(lds + X3M_CB, LDTB, vt * 16, 32, lane), qf1, ca, 0, 0, 0);
                    u32x2 o; o.x = pk2((na[0] + inter * ca[0]) * inv, (na[1] + inter * ca[1]) * inv); o.y = pk2((na[2] + inter * ca[2]) * inv, (na[3] + inter * ca[3]) * inv);
                    *(u32x2*)(Y + (size_t)row * D + 512 + h * 128 + vt * 16 + 4 * q) = o;
                }
            }
            __syncthreads();
        }
    }
}

constexpr int HC_RAWF = 0;
constexpr int HC_RAWQ = HC_RAWF + 64 * 128 * 4;
constexpr int HC_SUB = HC_RAWQ + 64 * 128 * 2;
constexpr int HL_QD = 136 * 2;
constexpr int HL_T = 24 * 2;
constexpr int HS_QI = 0, HS_KO = HS_QI + 16 * HL_QD, HS_KET = HS_KO + 16 * HL_QD, HS_ATT = HS_KET + 128 * HL_T, HS_VT = HS_ATT + 16 * HL_T, HS_DEC = HS_VT + 32 * HL_T, HS_SIZE = HS_DEC + 512;
constexpr int HC_SB = HC_SUB + 4 * HS_SIZE;
constexpr int HC_ROWS = HC_SB + 2 * 32 * HL_QD, HC_CST = HC_ROWS + 256, HC_END = HC_CST + 1024;
static_assert(HC_END <= LDS_BYTES - 16, "HGRN2 LDS map");
static_assert(HS_SIZE % 16 == 0 && HC_SB % 16 == 0, "alignment");
__device__ __forceinline__ bf16x8 ldfrag16(const LAS char* tile, int ldb, int row0, int lane) {
    bf16x8 v = *(const LAS bf16x8*)(tile + (row0 + (lane & 15)) * ldb + ((lane >> 4) & 1) * 16);
    if (lane >= 32) v = (bf16x8){0, 0, 0, 0, 0, 0, 0, 0};
    return v;
}
__device__ __forceinline__ void scan_hgrn_c(int wv, KP Pk, int layer, int unit, LAS char* lds) {
    asm volatile("" : "+s"(Pk));
    const CAS Params& P = *Pk;
    const int tid = ltid(wv), lane = tid & 63, wid = tid >> 6, q = lane >> 4, r16 = lane & 15, i_ = layer >> 1;
    const int seq = unit >> 2, quarter = unit & 3, b = seq >> 3, h = (seq >> 1) & 3, dir = seq & 1;
    const bf16_t* Pb = (const bf16_t*)(P.ws + WS_P);
    bf16_t* Y = (bf16_t*)(P.ws + (dir ? WS_YB : WS_YF));
    LAS float* cst = (LAS float*)(lds + HC_CST);
    if (tid < 128) cst[tid] = ((const float*)(P.ws + WS_LB))[layer * 512 + h * 128 + tid];
    else if (tid < 256) cst[tid] = P.hg_f_bias[(size_t)(i_ * 2 + dir) * 512 + h * 128 + tid - 128];
    for (int i = tid; i < 2 * 32 * HL_QD / 4; i += NT) ((LAS unsigned*)(lds + HC_SB))[i] = 0u;
    int tj[5], tg_[5], tcol[5]; bool tv[5];
#pragma unroll
    for (int s = 0; s < 5; ++s) {
        const int task = tid + NT * s; tv[s] = task < 64 * 36; tj[s] = task / 36; tg_[s] = task % 36;
        const int g = tg_[s];
        tcol[s] = g < 16 ? (512 + dir * 512 + h * 128 + 8 * g) : g < 32 ? (h * 128 + 8 * (g - 16)) : (1536 + h * 128 + quarter * 32 + 8 * (g - 32));
    }
    u32x4 rc[5]; int rrow = 0;
    auto load = [&](int c) {
#pragma unroll
        for (int s = 0; s < 5; ++s) {
            rc[s] = (u32x4){0u, 0u, 0u, 0u};
            if (tv[s]) { const int row = scan_row(c * 64 + tj[s], b, dir, 1); rc[s] = *(const u32x4*)(Pb + (size_t)row * LDP_ODD + tcol[s]); }
        }
        if (tid < 64) rrow = scan_row(c * 64 + tid, b, dir, 1);
    };
    auto storeA = [&]() {
#pragma unroll
        for (int s = 0; s < 5; ++s) {
            if (tv[s]) {
                float f[8]; unpack8(rc[s], f);
                const int j = tj[s], g = tg_[s];
                if (g < 16) {
                    float o[8];
#pragma unroll
                    for (int e = 0; e < 8; ++e) { const float lbv = cst[8 * g + e]; o[e] = lbv + (1.f - lbv) * sigmoidf_(f[e] + cst[128 + 8 * g + e]); }
                    LAS float* dst = (LAS float*)(lds + HC_RAWF) + j * 128 + 8 * g;
                    *(LAS f32x4*)dst = (f32x4){o[0], o[1], o[2], o[3]}; *(LAS f32x4*)(dst + 4) = (f32x4){o[4], o[5], o[6], o[7]};
                } else if (g < 32) {
                    float o[8];
#pragma unroll
                    for (int e = 0; e < 8; ++e) o[e] = siluf_(f[e]);
                    *(LAS u32x4*)(lds + HC_RAWQ + (j * 128 + 8 * (g - 16)) * 2) = pack8(o);
                } else {
                    const int v0 = 8 * (g - 32);
                    LAS char* vt = lds + HC_SUB + (j >> 4) * HS_SIZE + HS_VT;
#pragma unroll
                    for (int e = 0; e < 8; ++e) { const unsigned wv = rc[s][e >> 1]; *(LAS bf16_t*)(vt + (v0 + e) * HL_T + (j & 15) * 2) = (bf16_t)((e & 1) ? (wv >> 16) : (wv & 0xffffu)); }
                }
            }
        }
        if (tid < 64) ((LAS int*)(lds + HC_ROWS))[tid] = rrow;
    };
    auto storeB = [&]() {
        const int d = tid & 127, sb = tid >> 7;
        LAS char* st = lds + HC_SUB + sb * HS_SIZE;
        const LAS float* rf = (const LAS float*)(lds + HC_RAWF) + (sb * 16) * 128 + d;
        const LAS bf16_t* rq = (const LAS bf16_t*)(lds + HC_RAWQ) + (sb * 16) * 128 + d;
        float lam = 0.f, lams[16], kfs[16];
#pragma unroll
        for (int t = 0; t < 16; ++t) {
            const float f = rf[t * 128];
            lam += __logf(f);
            const float kf = 1.f - f;
            lams[t] = lam; kfs[t] = kf;
            *(LAS bf16_t*)(st + HS_QI + t * HL_QD + d * 2) = f2bf(bf2f(rq[t * 128]) * __expf(lam));
            *(LAS bf16_t*)(st + HS_KO + t * HL_QD + d * 2) = f2bf(kf * __expf(-lam));
        }
        float ke[16];
#pragma unroll
        for (int t = 0; t < 16; ++t) ke[t] = kfs[t] * __expf(lam - lams[t]);
        *(LAS u32x4*)(st + HS_KET + d * HL_T) = pack8(ke); *(LAS u32x4*)(st + HS_KET + d * HL_T + 16) = pack8(ke + 8);
        ((LAS float*)(st + HS_DEC))[d] = __expf(lam);
    };
    f32x4 sacc[2];
    sacc[0] = sacc[1] = (f32x4){0.f, 0.f, 0.f, 0.f};
    __syncthreads();
    load(0);
    for (int c = 0; c < NSTEPS / 64; ++c) {
        storeA();
        __syncthreads();
        storeB();
        if (c + 1 < NSTEPS / 64) load(c + 1);
        __syncthreads();
        if (wid < 4) {
            LAS char* st = lds + HC_SUB + wid * HS_SIZE;
            f32x4 acc = (f32x4){0.f, 0.f, 0.f, 0.f};
#pragma unroll
            for (int k0 = 0; k0 < 128; k0 += 32) acc = __builtin_amdgcn_mfma_f32_16x16x32_bf16(ldfrag(st + HS_KO, HL_QD, 0, k0, lane), ldfrag(st + HS_QI, HL_QD, 0, k0, lane), acc, 0, 0, 0);
#pragma unroll
            for (int j = 0; j < 4; ++j) acc[j] = (4 * q + j <= r16) ? acc[j] : 0.f;
            st4bf(st + HS_ATT + r16 * HL_T + 4 * q * 2, acc);
        }
        __syncthreads();
#pragma unroll 1
        for (int sb = 0; sb < 4; ++sb) {
            LAS char* st = lds + HC_SUB + sb * HS_SIZE;
            const LAS char* sbr = lds + HC_SB + (sb & 1) * 32 * HL_QD;
            LAS char* sbw = lds + HC_SB + ((sb + 1) & 1) * 32 * HL_QD;
            if (wid < 2) {
                f32x4 ya = __builtin_amdgcn_mfma_f32_16x16x32_bf16(ldfrag16(st + HS_VT, HL_T, wid * 16, lane), ldfrag16(st + HS_ATT, HL_T, 0, lane), (f32x4){0.f, 0.f, 0.f, 0.f}, 0, 0, 0);
#pragma unroll
                for (int k0 = 0; k0 < 128; k0 += 32) ya = __builtin_amdgcn_mfma_f32_16x16x32_bf16(ldfrag(sbr, HL_QD, wid * 16, k0, lane), ldfrag(st + HS_QI, HL_QD, 0, k0, lane), ya, 0, 0, 0);
                const int row = ((const LAS int*)(lds + HC_ROWS))[sb * 16 + r16];
                u32x2 o; o.x = pk2(ya[0], ya[1]); o.y = pk2(ya[2], ya[3]);
                *(u32x2*)(Y + (size_t)row * D + h * 128 + quarter * 32 + wid * 16 + 4 * q) = o;
            }
            {
                const int vt = wid >> 2;
                const bf16x8 vf = ldfrag16(st + HS_VT, HL_T, vt * 16, lane);
#pragma unroll
                for (int u = 0; u < 2; ++u) {
                    const int dt = (wid & 3) * 2 + u;
                    const f32x4 a = __builtin_amdgcn_mfma_f32_16x16x32_bf16(ldfrag16(st + HS_KET, HL_T, dt * 16, lane), vf, (f32x4){0.f, 0.f, 0.f, 0.f}, 0, 0, 0);
                    const f32x4 dc = *(const LAS f32x4*)((const LAS float*)(st + HS_DEC) + dt * 16 + 4 * q);
#pragma unroll
                    for (int j = 0; j < 4; ++j) sacc[u][j] = sacc[u][j] * dc[j] + a[j];
                    st4bf(sbw + (vt * 16 + r16) * HL_QD + (dt * 16 + 4 * q) * 2, sacc[u]);
                }
            }
            __syncthreads();
        }
    }
}

constexpr int RC_RAWW = 0;
constexpr int RC_RAWA = RC_RAWW + 64 * 64 * 4;
constexpr int RC_RAWB = RC_RAWA + 64 * 64 * 2, RC_RAWK = RC_RAWB + 64 * 64 * 2, RC_RAWR = RC_RAWK + 64 * 64 * 2;
constexpr int RC_SUB = RC_RAWR + 64 * 64 * 2;
constexpr int RL_C = 72 * 2, RL_32 = 40 * 2, RL_16 = 24 * 2;
constexpr int RS_AT = 0, RS_RT = RS_AT + 16 * RL_C, RS_KT = RS_RT + 16 * RL_C, RS_BT = RS_KT + 16 * RL_C, RS_KBH = RS_BT + 16 * RL_C, RS_AAK = RS_KBH + 64 * RL_32,
              RS_ARKB = RS_AAK + 16 * RL_16, RS_T = RS_ARKB + 16 * RL_32, RS_AABF = RS_T + 16 * RL_16, RS_GL = RS_AABF + 16 * 16 * 4, RS_VU = RS_GL + 256, RS_SIZE = RS_VU + 32 * RL_32;
constexpr int RC_SB = RC_SUB + 4 * RS_SIZE;
constexpr int RC_RHT = RC_SB + 32 * RL_C;
constexpr int RC_ROWS = RC_RHT + 32 * RL_16, RC_END = RC_ROWS + 256;
static_assert(RC_END <= LDS_BYTES - 16, "RWKV LDS map");
static_assert(RS_SIZE % 16 == 0 && RC_SB % 16 == 0 && RC_RHT % 16 == 0, "alignment");

__device__ __forceinline__ float allreduce8(float v) {
    v += dppmov<0xB1>(v); v += dppmov<0x4E>(v); v += dppmov<0x141>(v);
    return v;
}

__device__ __forceinline__ void phase_prep1(int wv, KP Pk, int layer) {
    asm volatile("" : "+s"(Pk));
    const CAS Params& P = *Pk;
    const int tid = ltid(wv), lane = tid & 63, wid = tid >> 6, i_ = layer >> 1;
    const bf16_t* Pb = (const bf16_t*)(P.ws + WS_P);
    bf16_t* R = (bf16_t*)(P.ws + WS_RWR); bf16_t* K = (bf16_t*)(P.ws + WS_RWK); bf16_t* V = (bf16_t*)(P.ws + WS_RWV); bf16_t* KK = (bf16_t*)(P.ws + WS_RWKK);
    bf16_t* LA = (bf16_t*)(P.ws + WS_LA);
    const float* mu = P.rw_mu + (size_t)i_ * 1856;
    float mur[8], muv[8], muk[8], mul_[8], kkw[8];
#pragma unroll
    for (int e = 0; e < 8; ++e) { mur[e] = mu[8 * lane + e]; muv[e] = mu[1024 + 8 * lane + e]; muk[e] = mu[512 + 8 * lane + e]; mul_[e] = lane < 40 ? mu[1536 + 8 * lane + e] : 0.f; kkw[e] = P.rw_k_k[i_ * 512 + 8 * lane + e]; }
    u32x4 nq[4][3]; float nmp = 0.f, nmn = 0.f;
    auto fetch = [&](int r) {
        int rprev = -1, rnext = -1;
        if (r < NCTX) { const int t = r & 255; if (t > 0) rprev = r - 1; if (t < CTXL - 1) rnext = r + 1; }
        else {
            const int bs = (r - NCTX) >> 13, s = (r - NCTX) & 8191, sg = ((s & 63) << 7) + (s >> 6);
            if (sg > 0) { const int g2 = sg - 1; rprev = NCTX + bs * SEQ + ((g2 & 127) << 6) + (g2 >> 7); }
            if (sg < SEQ - 1) { const int g2 = sg + 1; rnext = NCTX + bs * SEQ + ((g2 & 127) << 6) + (g2 >> 7); }
        }
        const bf16_t* pc = Pb + (size_t)r * LDP_ODD + 2560;
        const bf16_t* pp = Pb + (size_t)(rprev < 0 ? r : rprev) * LDP_ODD + 2560;
        const bf16_t* pn = Pb + (size_t)(rnext < 0 ? r : rnext) * LDP_ODD + 2560;
        nmp = rprev < 0 ? 0.f : 0.5f; nmn = rnext < 0 ? 0.f : 0.5f;
#pragma unroll
        for (int gq = 0; gq < 4; ++gq) {
            const int col = (gq == 0 ? 0 : gq == 1 ? 1024 : gq == 2 ? 512 : 1536) + 8 * lane;
            if (gq < 3 || lane < 40) { nq[gq][0] = *(const u32x4*)(pc + col); nq[gq][1] = *(const u32x4*)(pp + col); nq[gq][2] = *(const u32x4*)(pn + col); }
        }
    };
    nq[3][0] = nq[3][1] = nq[3][2] = (u32x4){0u, 0u, 0u, 0u};
    const int stride = gridDim.x * 8;
    int r = blockIdx.x * 8 + wid;
    if (r < NROWS) fetch(r);
    for (; r < NROWS; r += stride) {
        u32x4 cq[4][3];
#pragma unroll
        for (int gq = 0; gq < 4; ++gq)
#pragma unroll
            for (int k = 0; k < 3; ++k) cq[gq][k] = nq[gq][k];
        const float mp = nmp, mn = nmn;
        if (r + stride < NROWS) fetch(r + stride);
        auto mix8 = [&](const u32x4 (&c)[3], const float* muc, float* o) {
            float fc[8], fp[8], fn[8];
            unpack8(c[0], fc); unpack8(c[1], fp); unpack8(c[2], fn);
#pragma unroll
            for (int e = 0; e < 8; ++e) o[e] = fc[e] + muc[e] * (mp * fp[e] + mn * fn[e] - fc[e]);
        };
        float o[8];
        mix8(cq[0], mur, o); *(u32x4*)(R + (size_t)r * 512 + 8 * lane) = pack8(o);
        mix8(cq[1], muv, o); *(u32x4*)(V + (size_t)r * 512 + 8 * lane) = pack8(o);
        mix8(cq[2], muk, o); *(u32x4*)(K + (size_t)r * 512 + 8 * lane) = pack8(o);
        {
            float kk[8], ss = 0.f;
#pragma unroll
            for (int e = 0; e < 8; ++e) { kk[e] = o[e] * kkw[e]; ss += kk[e] * kk[e]; }
            ss = group_sum<8>(ss);
            const float rn = rsqrtf(fmaxf(ss, 1e-12f));
#pragma unroll
            for (int e = 0; e < 8; ++e) kk[e] *= rn;
            *(u32x4*)(KK + (size_t)r * 512 + 8 * lane) = pack8(kk);
        }
        if (lane < 40) {
            mix8(cq[3], mul_, o);
            if (lane < 16) {
#pragma unroll
                for (int e = 0; e < 8; ++e) o[e] = tanh_fast(o[e]);
            } else if (lane >= 24) {
#pragma unroll
                for (int e = 0; e < 8; ++e) o[e] = sigmoidf_(o[e]);
            }
            *(u32x4*)(LA + (size_t)r * 320 + 8 * lane) = pack8(o);
        }
    }
}

__device__ __forceinline__ void phase_out_even(int wv, KP Pk, int layer) {
    asm volatile("" : "+s"(Pk));
    const CAS Params& P = *Pk;
    const int tid = ltid(wv), lane = tid & 63, wid = tid >> 6, i_ = layer >> 1;
    const bf16_t* Pb = (const bf16_t*)(P.ws + WS_P);
    const bf16_t* Yf = (const bf16_t*)(P.ws + WS_YF); const bf16_t* Yb = (const bf16_t*)(P.ws + WS_YB);
    bf16_t* feat = (bf16_t*)(P.ws + WS_FEAT);
    const int r0 = (layer == DEPTH - 1) ? NCTX : 0;
    const bf16_t* XBC = (const bf16_t*)(P.ws + WS_EXBC);
    float nwa[8], nwb[8];
#pragma unroll
    for (int e = 0; e < 8; ++e) { nwa[e] = P.ssd_norm_w[i_ * 512 + 8 * lane + e]; nwb[e] = P.ml_norm_w[i_ * 512 + 8 * lane + e]; }
    const float dsk = P.ssd_d[i_ * 8 + (lane >> 3)];
    u32x4 n0, n1, n2, n3, n4, n5, n6;
    auto fetch = [&](int rr) {
        const bf16_t* pr = Pb + (size_t)rr * LDP_EVEN;
        n0 = *(const u32x4*)(Yf + (size_t)rr * D + 8 * lane); n1 = *(const u32x4*)(Yb + (size_t)rr * D + 8 * lane);
        n2 = *(const u32x4*)(XBC + (size_t)rr * 768 + 8 * lane); n3 = *(const u32x4*)(pr + 8 * lane);
        n4 = *(const u32x4*)(Yf + (size_t)rr * D + 512 + 8 * lane); n5 = *(const u32x4*)(Yb + (size_t)rr * D + 512 + 8 * lane); n6 = *(const u32x4*)(pr + 2320 + 8 * lane);
    };
    const int stride = gridDim.x * 8;
    int r = r0 + blockIdx.x * 8 + wid;
    if (r < NROWS) fetch(r);
    for (; r < NROWS; r += stride) {
        const u32x4 c0 = n0, c1 = n1, c2 = n2, c3 = n3, c4 = n4, c5 = n5, c6 = n6;
        if (r + stride < NROWS) fetch(r + stride);
        float y[8];
        {
            float a[8], bb[8], xsv[8], z[8];
            unpack8(c0, a); unpack8(c1, bb);
            unpack8(c2, xsv); unpack8(c3, z);
            float ss = 0.f;
#pragma unroll
            for (int e = 0; e < 8; ++e) {
                y[e] = (a[e] + bb[e] + dsk * xsv[e]) * siluf_(z[e]); ss += y[e] * y[e];
            }
            ss = wave_sum(ss);
            const float rn = rsqrtf(ss * (1.f / 512.f) + 1e-6f);
#pragma unroll
            for (int e = 0; e < 8; ++e) y[e] = y[e] * rn * nwa[e];
            *(u32x4*)(feat + (size_t)r * D + 8 * lane) = pack8(y);
        }
        {
            float a[8], bb[8], o[8];
            unpack8(c4, a); unpack8(c5, bb);
            unpack8(c6, o);
            float s = 0.f;
#pragma unroll
            for (int e = 0; e < 8; ++e) { y[e] = a[e] + bb[e]; s += y[e]; }
            const float mean = group_sum<16>(s) * (1.f / 128.f);
            float ss = 0.f;
#pragma unroll
            for (int e = 0; e < 8; ++e) { y[e] -= mean; ss += y[e] * y[e]; }
            const float rn = rsqrtf(group_sum<16>(ss) * (1.f / 128.f) + 1e-6f);
#pragma unroll
            for (int e = 0; e < 8; ++e) y[e] = sigmoidf_(o[e]) * (y[e] * rn) * nwb[e];
            *(u32x4*)(feat + (size_t)r * D + 512 + 8 * lane) = pack8(y);
        }
    }
}
__device__ __forceinline__ void phase_out_odd(int wv, KP Pk, int layer) {
    asm volatile("" : "+s"(Pk));
    const CAS Params& P = *Pk;
    const int tid = ltid(wv), lane = tid & 63, wid = tid >> 6, i_ = layer >> 1;
    const bf16_t* Pb = (const bf16_t*)(P.ws + WS_P);
    const bf16_t* Yf = (const bf16_t*)(P.ws + WS_YF); const bf16_t* Yb = (const bf16_t*)(P.ws + WS_YB);
    const bf16_t* R = (const bf16_t*)(P.ws + WS_RWR); const bf16_t* K = (const bf16_t*)(P.ws + WS_RWK); const bf16_t* V = (const bf16_t*)(P.ws + WS_RWV); const bf16_t* G = (const bf16_t*)(P.ws + WS_RWG);
    bf16_t* feat = (bf16_t*)(P.ws + WS_FEAT);
    const int r0 = (layer == DEPTH - 1) ? NCTX : 0;
    float nwc[8], rk[8], lw[8], lbv[8];
#pragma unroll
    for (int e = 0; e < 8; ++e) {
        nwc[e] = P.hg_norm_w[i_ * 512 + 8 * lane + e]; rk[e] = P.rw_r_k[i_ * 512 + 8 * lane + e];
        lw[e] = P.rw_ln_w[i_ * 512 + 8 * lane + e]; lbv[e] = P.rw_ln_b[i_ * 512 + 8 * lane + e];
    }
    u32x4 n0, n1, n2, n3, n4, n5, n6, n7, n8;
    auto fetch = [&](int rr) {
        n0 = *(const u32x4*)(Yf + (size_t)rr * D + 8 * lane); n1 = *(const u32x4*)(Yb + (size_t)rr * D + 8 * lane); n2 = *(const u32x4*)(Pb + (size_t)rr * LDP_ODD + 2048 + 8 * lane);
        n3 = *(const u32x4*)(Yf + (size_t)rr * D + 512 + 8 * lane); n4 = *(const u32x4*)(Yb + (size_t)rr * D + 512 + 8 * lane);
        n5 = *(const u32x4*)(R + (size_t)rr * 512 + 8 * lane); n6 = *(const u32x4*)(K + (size_t)rr * 512 + 8 * lane);
        n7 = *(const u32x4*)(V + (size_t)rr * 512 + 8 * lane); n8 = *(const u32x4*)(G + (size_t)rr * 512 + 8 * lane);
    };
    const int stride = gridDim.x * 8;
    int r = r0 + blockIdx.x * 8 + wid;
    if (r < NROWS) fetch(r);
    for (; r < NROWS; r += stride) {
        const u32x4 c0 = n0, c1 = n1, c2 = n2, c3 = n3, c4 = n4, c5 = n5, c6 = n6, c7 = n7, c8 = n8;
        if (r + stride < NROWS) fetch(r + stride);
        float y[8];
        {
            float a[8], bb[8], g[8];
            unpack8(c0, a); unpack8(c1, bb);
            unpack8(c2, g);
            float ss = 0.f;
#pragma unroll
            for (int e = 0; e < 8; ++e) { y[e] = a[e] + bb[e]; ss += y[e] * y[e]; }
            const float rn = rsqrtf(group_sum<16>(ss) * (1.f / 128.f) + 1e-6f);
#pragma unroll
            for (int e = 0; e < 8; ++e) y[e] = y[e] * rn * nwc[e] * siluf_(g[e]);
            *(u32x4*)(feat + (size_t)r * D + 8 * lane) = pack8(y);
        }
        {
            float a[8], bb[8], rr[8], kk[8], vv[8], g[8];
            unpack8(c3, a); unpack8(c4, bb);
            unpack8(c5, rr); unpack8(c6, kk);
            unpack8(c7, vv); unpack8(c8, g);
            float s = 0.f, bs = 0.f;
#pragma unroll
            for (int e = 0; e < 8; ++e) { y[e] = a[e] + bb[e]; s += y[e]; bs += rr[e] * kk[e] * rk[e]; }
            const float mean = group_sum<8>(s) * (1.f / 64.f); bs = group_sum<8>(bs);
            float ss = 0.f;
#pragma unroll
            for (int e = 0; e < 8; ++e) { y[e] -= mean; ss += y[e] * y[e]; }
            const float rn = rsqrtf(group_sum<8>(ss) * (1.f / 64.f) + 64e-5f);
#pragma unroll
            for (int e = 0; e < 8; ++e) y[e] = (y[e] * rn * lw[e] + lbv[e] + bs * vv[e]) * g[e];
            *(u32x4*)(feat + (size_t)r * D + 512 + 8 * lane) = pack8(y);
        }
    }
}

#ifndef MK_DOUBLE
#define MK_DOUBLE 0
#endif
#define REP(bit, body) do { body; if (MK_DOUBLE & (bit)) { body; } } while (0)
__device__ __forceinline__ void phase_expconv(int wv, KP Pk, int layer, LAS char* lds) {
    asm volatile("" : "+s"(Pk));
    const CAS Params& P = *Pk;
    const int tid = ltid(wv);
    if (layer & 1) return;
    expconv_items(P, layer, lds, exc_s0(layer) + exc_s1(layer), EXC_ITEMS, (int)blockIdx.x * 8 + (tid >> 6), (int)gridDim.x * 8, tid >> 6, tid & 63);
}
__device__ __forceinline__ void expconv_after_scan(int wv, KP Pk, int layer, LAS char* lds) {
    asm volatile("" : "+s"(Pk));
    const CAS Params& P = *Pk;
    const int tid = ltid(wv);
    __syncthreads();
    expconv_items(P, layer, lds, exc_s0(layer) + exc_s1(layer), EXC_ITEMS, (int)blockIdx.x * 8 + (tid >> 6), 128 * 8, tid >> 6, tid & 63);
}
constexpr int L1_AST = 1028;
constexpr int L1_PST = 33;
constexpr int L1_A = 0, L1_PART = L1_A + 16 * L1_AST * 4, L1_SM = L1_PART + 8 * 16 * L1_PST * 4, L1_END = L1_SM + (64 + 2 * 144 + 32) * 4;
static_assert(L1_END <= LDS_BYTES - 16, "LN1 LDS map");
__device__ __forceinline__ void phase_ln1(int wv, KP Pk, int layer, LAS char* lds, bool dry = false) {
    asm volatile("" : "+s"(Pk));
    const CAS Params& P = *Pk;
    const int tid = ltid(wv), lane = tid & 63;
    if (!dry) REP(8, phase_expconv(wv, Pk, layer, lds));
    __syncthreads();
    LAS float* At = (LAS float*)(lds + L1_A);
    LAS float* part = (LAS float*)(lds + L1_PART);
    LAS int* lcnt = (LAS int*)(lds + L1_SM);
    LAS int* lbase = lcnt + 32;
    LAS int* asg = lcnt + 64;
    LAS float* rbias = (LAS float*)(asg + 2 * 144);
    if (tid < 32) { lcnt[tid] = 0; rbias[tid] = P.router_bias[tid]; }
    float breg[8][4][2];
    {
        const float* rw = P.router_w + (size_t)(128 * wv + 4 * (lane >> 4)) * NEXP + (lane & 15);
#pragma unroll
        for (int j = 0; j < 8; ++j)
#pragma unroll
            for (int i = 0; i < 4; ++i) { breg[j][i][0] = rw[(16 * j + i) * NEXP]; breg[j][i][1] = rw[(16 * j + i) * NEXP + 16]; }
    }
    __syncthreads();
    const bf16_t* yo = (const bf16_t*)(P.ws + WS_YO);
    bf16_t* act = (bf16_t*)(P.ws + (dry ? WS_FEAT : WS_ACT));
    bf16_t* xcb = (bf16_t*)(P.ws + WS_XC); bf16_t* xob = (bf16_t*)P.out;
    const bool lastl = (layer == DEPTH - 1);
    int* cnt = (int*)(P.ws + WS_CNT) + layer * 32 * CNT_STRIDE;
    int* list = (int*)(P.ws + WS_LIST);
    float* wts = (float*)(P.ws + WS_WTS);
    const float* lg = P.ln_g + (size_t)(layer * 2 + 0) * D; const float* lb = P.ln_b + (size_t)(layer * 2 + 0) * D;
    const int r0 = (layer == DEPTH - 1) ? NCTX : 0, ntiles = (NROWS - r0) / 16, G = gridDim.x;
    f32x4 g1v[4], s2c[4], h2c[4];
#pragma unroll
    for (int i = 0; i < 4; ++i) g1v[i] = s2c[i] = h2c[i] = (f32x4){0.f, 0.f, 0.f, 0.f};
    int mcur = -1;
    f32x4 nx[2][4]; u32x2 nyo[2][4];
    auto fetch = [&](int s, int rr) {
        if (layer == 0) {
            const float* xq = rr < NCTX ? P.ctx + (size_t)rr * D : P.x + (size_t)(rr - NCTX) * D;
#pragma unroll
            for (int i = 0; i < 4; ++i) nx[s][i] = *(const f32x4*)(xq + 4 * lane + 256 * i);
        } else {
            const bf16_t* xq = rr < NCTX ? xcb + (size_t)rr * D : xob + (size_t)(rr - NCTX) * D;
#pragma unroll
            for (int i = 0; i < 4; ++i) { const u32x2 t = *(const u32x2*)(xq + 4 * lane + 256 * i); nx[s][i] = (f32x4){__uint_as_float(t.x), __uint_as_float(t.y), 0.f, 0.f}; }
        }
#pragma unroll
        for (int i = 0; i < 4; ++i) { const int c = 4 * lane + 256 * i; nyo[s][i] = *(const u32x2*)(yo + (size_t)rr * D + c); }
    };
    int tile = blockIdx.x;
    if (tile < ntiles) { fetch(0, r0 + tile * 16 + 2 * wv); fetch(1, r0 + tile * 16 + 2 * wv + 1); }
    for (int it = 0; tile < ntiles; ++it, tile += G) {
        const int rb = r0 + tile * 16 + 2 * wv;
        const int m = row_mod(rb);
        if (m != mcur) {
            mcur = m;
            const float* g1 = modvec(P.ws, layer, m, 2); const float* sh2 = modvec(P.ws, layer, m, 3); const float* sc2 = modvec(P.ws, layer, m, 4);
#pragma unroll
            for (int i = 0; i < 4; ++i) { const int c = 4 * lane + 256 * i; g1v[i] = *(const f32x4*)(g1 + c); s2c[i] = *(const f32x4*)(sc2 + c); h2c[i] = *(const f32x4*)(sh2 + c); }
        }
#pragma unroll
        for (int s = 0; s < 2; ++s) {
            const int r = rb + s;
            bf16_t* xr = dry ? (bf16_t*)(P.ws + WS_YF) + (size_t)r * D : lastl ? (bf16_t*)(P.ws + WS_FEAT) + (size_t)r * D : r < NCTX ? xcb + (size_t)r * D : xob + (size_t)(r - NCTX) * D;
            f32x4 v[4]; float sm = 0.f;
#pragma unroll
            for (int i = 0; i < 4; ++i) {
                f32x4 xv = nx[s][i]; const f32x4 gv = g1v[i]; const u32x2 yv = nyo[s][i];
                if (layer != 0) { const unsigned b0 = __float_as_uint(xv[0]), b1 = __float_as_uint(xv[1]); xv = (f32x4){bflo(b0), bfhi(b0), bflo(b1), bfhi(b1)}; }
                v[i][0] = ALPHA * xv[0] + gv[0] * bflo(yv.x); v[i][1] = ALPHA * xv[1] + gv[1] * bfhi(yv.x);
                v[i][2] = ALPHA * xv[2] + gv[2] * bflo(yv.y); v[i][3] = ALPHA * xv[3] + gv[3] * bfhi(yv.y);
                sm += (v[i][0] + v[i][1]) + (v[i][2] + v[i][3]);
            }
            if (tile + G < ntiles) fetch(s, r + G * 16);
            const float mean = wave_sum(sm) * (1.f / D);
            float s2 = 0.f;
#pragma unroll
            for (int i = 0; i < 4; ++i) { v[i] = v[i] - mean; s2 += (v[i][0] * v[i][0] + v[i][1] * v[i][1]) + (v[i][2] * v[i][2] + v[i][3] * v[i][3]); }
            const float rstd = rsqrtf(wave_sum(s2) * (1.f / D) + 1e-5f);
            LAS float* arow = At + (2 * wv + s) * L1_AST;
#pragma unroll
            for (int i = 0; i < 4; ++i) {
                const int c = 4 * lane + 256 * i;
                const f32x4 gg = *(const f32x4*)(lg + c), bb = *(const f32x4*)(lb + c), s2v = s2c[i], h2v = h2c[i];
                f32x4 xn, hv;
#pragma unroll
                for (int j = 0; j < 4; ++j) { xn[j] = v[i][j] * rstd * gg[j] + bb[j]; hv[j] = xn[j] * (1.f + s2v[j]) + h2v[j]; }
                { u32x2 ox; ox.x = pk2(xn[0], xn[1]); ox.y = pk2(xn[2], xn[3]); *(u32x2*)(xr + c) = ox; }
                u32x2 o; o.x = pk2(hv[0], hv[1]); o.y = pk2(hv[2], hv[3]); *(u32x2*)(act + (size_t)r * D + c) = o;
                *(LAS f32x4*)(arow + c) = hv;
            }
        }
        __syncthreads();
        {
            f32x4 ra0 = (f32x4){0.f, 0.f, 0.f, 0.f}, ra1 = ra0;
            const LAS float* ap = At + (lane & 15) * L1_AST + 128 * wv + 4 * (lane >> 4);
#pragma unroll
            for (int j = 0; j < 8; ++j) {
                const f32x4 a4 = *(const LAS f32x4*)(ap + 16 * j);
#pragma unroll
                for (int i = 0; i < 4; ++i) {
                    ra0 = __builtin_amdgcn_mfma_f32_16x16x4f32(a4[i], breg[j][i][0], ra0, 0, 0, 0);
                    ra1 = __builtin_amdgcn_mfma_f32_16x16x4f32(a4[i], breg[j][i][1], ra1, 0, 0, 0);
                }
            }
            LAS float* pw = part + wv * 16 * L1_PST + (4 * (lane >> 4)) * L1_PST + (lane & 15);
#pragma unroll
            for (int j = 0; j < 4; ++j) { pw[j * L1_PST] = ra0[j]; pw[j * L1_PST + 16] = ra1[j]; }
        }
        __syncthreads();
        {
            const int half = lane >> 5, e = lane & 31;
            const LAS float* pp = part + (2 * wv + half) * L1_PST + e;
            float sc_ = 0.f;
#pragma unroll
            for (int k = 0; k < 8; ++k) sc_ += pp[k * 16 * L1_PST];
            const float sg = sigmoidf_(sc_), vb = sg + rbias[e];
            float bv[4], sv[4];
            bv[0] = dppmov<0x00>(vb); bv[1] = dppmov<0x55>(vb); bv[2] = dppmov<0xAA>(vb); bv[3] = dppmov<0xFF>(vb);
            sv[0] = dppmov<0x00>(sg); sv[1] = dppmov<0x55>(sg); sv[2] = dppmov<0xAA>(sg); sv[3] = dppmov<0xFF>(sg);
            float m1 = -1e30f, m2 = -1e30f;
#pragma unroll
            for (int k = 0; k < 4; ++k) { const float vsc = bv[k]; if (vsc > m1) { m2 = m1; m1 = vsc; } else if (vsc > m2) m2 = vsc; }
            float best = m1 + m2; int bg = e >> 2;
#pragma unroll
            for (int msk = 4; msk <= 16; msk <<= 1) {
                const float ob = __shfl_xor(best, msk); const int og = __shfl_xor(bg, msk);
                const bool take = (ob > best) || (ob == best && og < bg);
                best = take ? ob : best; bg = take ? og : bg;
            }
            int i1 = 0; float b1 = bv[0];
#pragma unroll
            for (int k = 1; k < 4; ++k) if (bv[k] > b1) { b1 = bv[k]; i1 = k; }
            int i2 = -1; float b2 = -1e30f;
#pragma unroll
            for (int k = 0; k < 4; ++k) if (k != i1 && bv[k] > b2) { b2 = bv[k]; i2 = k; }
            float s1 = sv[0], s2s = sv[0];
#pragma unroll
            for (int k = 1; k < 4; ++k) { if (i1 == k) s1 = sv[k]; if (i2 == k) s2s = sv[k]; }
            if (e == 4 * bg && !dry) {
                const int r = rb + half;
                const int e0 = bg * 4 + i1, e1 = bg * 4 + i2;
                const float inv = 1.f / (s1 + s2s);
                const int li = it * 16 + 2 * wv + half;
                const int p0 = __hip_atomic_fetch_add(&lcnt[e0], 1, __ATOMIC_RELAXED, __HIP_MEMORY_SCOPE_WORKGROUP);
                const int p1 = __hip_atomic_fetch_add(&lcnt[e1], 1, __ATOMIC_RELAXED, __HIP_MEMORY_SCOPE_WORKGROUP);
                asg[2 * li] = (e0 << 16) | p0; asg[2 * li + 1] = (e1 << 16) | p1;
                wts[2 * r] = s1 * inv; wts[2 * r + 1] = s2s * inv;
            }
        }
    }
    __syncthreads();
    if (dry) return;
    if (tid < 32) lbase[tid] = atomicAdd(&cnt[tid * CNT_STRIDE], lcnt[tid]);
    __syncthreads();
    for (int idx = tid; idx < 2 * 144; idx += NT) {
        const int li = idx >> 1, k = idx & 1, t = (li >> 4) * G + blockIdx.x;
        if (t < ntiles) { const int r = r0 + t * 16 + (li & 15); const int v = asg[idx], e = v >> 16, lp = v & 0xffff; list[(size_t)e * LISTCAP + lbase[e] + lp] = 2 * r + k; }
    }
}

__device__ __forceinline__ void phase_ln2(int wv, KP Pk, int layer, bool dry = false) {
    asm volatile("" : "+s"(Pk));
    const CAS Params& P = *Pk;
    const int tid = ltid(wv), lane = tid & 63, wid = tid >> 6;
    const bf16_t* yp = (const bf16_t*)(P.ws + WS_YP);
    const float* wts = (const float*)(P.ws + WS_WTS);
    bf16_t* act = (bf16_t*)(P.ws + (dry ? WS_FEAT : WS_ACT));
    bf16_t* xcb = (bf16_t*)(P.ws + WS_XC); bf16_t* xob = (bf16_t*)P.out;
    const float* lg = P.ln_g + (size_t)(layer * 2 + 1) * D; const float* lb = P.ln_b + (size_t)(layer * 2 + 1) * D;
    const bool last = (layer == DEPTH - 1);
    const int r0 = last ? NCTX : 0, stride = gridDim.x * 8;
    f32x4 cg[4], cb[4], g2v[4], s1v[4], h1v[4];
#pragma unroll
    for (int i = 0; i < 4; ++i) { cg[i] = *(const f32x4*)(lg + 4 * lane + 256 * i); cb[i] = *(const f32x4*)(lb + 4 * lane + 256 * i); g2v[i] = s1v[i] = h1v[i] = (f32x4){0.f, 0.f, 0.f, 0.f}; }
    int mcur = -1;
    u32x2 nx[4]; u32x2 ny0[4], ny1[4]; float nw0 = 0.f, nw1 = 0.f;
    auto fetch = [&](int r) {
        const bf16_t* xr = last ? (const bf16_t*)(P.ws + WS_FEAT) + (size_t)r * D : r < NCTX ? xcb + (size_t)r * D : xob + (size_t)(r - NCTX) * D;
#pragma unroll
        for (int i = 0; i < 4; ++i) {
            const int c = 4 * lane + 256 * i;
            nx[i] = *(const u32x2*)(xr + c); ny0[i] = *(const u32x2*)(yp + (size_t)(2 * r) * D + c); ny1[i] = *(const u32x2*)(yp + (size_t)(2 * r + 1) * D + c);
        }
        nw0 = wts[2 * r]; nw1 = wts[2 * r + 1];
    };
    int r = r0 + blockIdx.x * 8 + wid;
    if (r < NROWS) fetch(r);
    for (; r < NROWS; r += stride) {
        const int m = row_mod(r);
        if (m != mcur) {
            mcur = m;
            const float* g2 = modvec(P.ws, layer, m, 5); const float* sh1 = last ? lg : modvec(P.ws, layer + 1, m, 0); const float* sc1 = last ? lg : modvec(P.ws, layer + 1, m, 1);
#pragma unroll
            for (int i = 0; i < 4; ++i) { const int c = 4 * lane + 256 * i; g2v[i] = *(const f32x4*)(g2 + c); s1v[i] = *(const f32x4*)(sc1 + c); h1v[i] = *(const f32x4*)(sh1 + c); }
        }
        f32x4 v[4]; float s = 0.f;
        const float w0 = nw0, w1 = nw1;
#pragma unroll
        for (int i = 0; i < 4; ++i) {
            const f32x4 xv = (f32x4){bflo(nx[i].x), bfhi(nx[i].x), bflo(nx[i].y), bfhi(nx[i].y)}, gv = g2v[i]; const u32x2 y0 = ny0[i], y1 = ny1[i];
            v[i][0] = ALPHA * xv[0] + gv[0] * (w0 * bflo(y0.x) + w1 * bflo(y1.x)); v[i][1] = ALPHA * xv[1] + gv[1] * (w0 * bfhi(y0.x) + w1 * bfhi(y1.x));
            v[i][2] = ALPHA * xv[2] + gv[2] * (w0 * bflo(y0.y) + w1 * bflo(y1.y)); v[i][3] = ALPHA * xv[3] + gv[3] * (w0 * bfhi(y0.y) + w1 * bfhi(y1.y));
            s += (v[i][0] + v[i][1]) + (v[i][2] + v[i][3]);
        }
        if (r + stride < NROWS) fetch(r + stride);
        const float mean = wave_sum(s) * (1.f / D);
        float s2 = 0.f;
#pragma unroll
        for (int i = 0; i < 4; ++i) { v[i] = v[i] - mean; s2 += (v[i][0] * v[i][0] + v[i][1] * v[i][1]) + (v[i][2] * v[i][2] + v[i][3] * v[i][3]); }
        const float rstd = rsqrtf(wave_sum(s2) * (1.f / D) + 1e-5f);
#pragma unroll
        for (int i = 0; i < 4; ++i) {
            const int c = 4 * lane + 256 * i;
            f32x4 xn;
#pragma unroll
            for (int j = 0; j < 4; ++j) xn[j] = v[i][j] * rstd * cg[i][j] + cb[i][j];
            if (dry) *(f32x4*)((float*)(P.ws + WS_YF) + (size_t)r * D + c) = xn;
            else if (last) *(f32x4*)(P.out + (size_t)(r - NCTX) * D + c) = xn;
            else { u32x2 ox; ox.x = pk2(xn[0], xn[1]); ox.y = pk2(xn[2], xn[3]); *(u32x2*)((r < NCTX ? xcb + (size_t)r * D : xob + (size_t)(r - NCTX) * D) + c) = ox; }
            if (!last) {
                u32x2 o; o.x = pk2(xn[0] * (1.f + s1v[i][0]) + h1v[i][0], xn[1] * (1.f + s1v[i][1]) + h1v[i][1]); o.y = pk2(xn[2] * (1.f + s1v[i][2]) + h1v[i][2], xn[3] * (1.f + s1v[i][3]) + h1v[i][3]);
                *(u32x2*)(act + (size_t)r * D + c) = o;
            }
        }
    }
}

constexpr int NPHASE = 2 + 11 * DEPTH;
__global__ void __launch_bounds__(NT, 2) fwd_kernel(Params P) {
    extern __shared__ __attribute__((aligned(16))) char lds_raw[];
    LAS char* lds = (LAS char*)lds_raw;
    volatile LAS unsigned* xbw = (volatile LAS unsigned*)(lds + LDS_BYTES - 16);
    KP Pk = (KP)__builtin_amdgcn_kernarg_segment_ptr();
    const int wv = __builtin_amdgcn_readfirstlane((int)(threadIdx.x >> 6));
    const bool multi = (P.ph_hi - P.ph_lo) > 1;
    XcdBarrier bar; bar.bar = (unsigned*)(P.ws + WS_BAR); bar.x = 0; bar.st = xbw;
    if (multi) {
        if (ltid(wv) == 0) { xbw[0] = 0u; xbw[1] = 0u; xbw[2] = 0u; xbw[3] = 0u; }
        __syncthreads();
        bar = xcd_barrier_post(wv, (unsigned*)(P.ws + WS_BAR), xbw);
    }
#define PHASE(id, body) do { if (P.ph_lo <= (id) && (id) < P.ph_hi) { body; if ((id) + 1 < P.ph_hi) xcd_barrier(wv, bar); if (MK_DOUBLE & 2048) xcd_barrier(wv, bar); } } while (0)
    PHASE(0, REP(16, phase_prologue0(wv, Pk, lds)));
    PHASE(1, REP(16, phase_prologue1(wv, Pk)));
    for (int l = 0; l < DEPTH; ++l) {
        const int pb = 2 + 11 * l, odd = l & 1;
        PHASE(pb + 0, REP(1, phase_inproj(wv, Pk, l, lds)));
        if (odd) {
            PHASE(pb + 1, REP(4, phase_prep1(wv, Pk, l)));
            PHASE(pb + 2, phase_prep2(wv, Pk, l, lds));
            PHASE(pb + 3, REP(32, { if (blockIdx.x < 128) { REP(64, scan_hgrn_c(wv, Pk, l, blockIdx.x, lds)); expconv_after_scan(wv, Pk, l, lds); } else if (blockIdx.x < 256) REP(128, scan_rwkv(wv, Pk, l, blockIdx.x - 128, lds)); }));
            PHASE(pb + 5, REP(4, phase_out_odd(wv, Pk, l)));
        } else {
            PHASE(pb + 1, REP(4, phase_prep_even(wv, Pk, l)));
            PHASE(pb + 2, REP(2, phase_ex1(wv, Pk, l, lds)));
            PHASE(pb + 3, phase_ex2(wv, Pk, l));
            PHASE(pb + 4, REP(2, phase_ex3(wv, Pk, l, lds)));
            PHASE(pb + 5, REP(4, phase_out_even(wv, Pk, l)));
        }
        PHASE(pb + 6, REP(256, phase_outproj(wv, Pk, l, lds)));
        PHASE(pb + 7, { if (MK_DOUBLE & 4096) phase_ln1(wv, Pk, l, lds, true); phase_ln1(wv, Pk, l, lds); });
        PHASE(pb + 8, REP(512, phase_moe1(wv, Pk, l, lds)));
        PHASE(pb + 9, REP(1024, phase_moe2(wv, Pk, l, lds)));
        PHASE(pb + 10, { if (MK_DOUBLE & 8192) phase_ln2(wv, Pk, l, true); phase_ln2(wv, Pk, l); });
    }
#undef PHASE
}


#ifndef MK_STOP
#define MK_STOP NPHASE
#endif
#ifndef MK_DUMP
#define MK_DUMP 0
#endif
#ifndef MK_DUMP_N
#define MK_DUMP_N (1u << 30)
#endif
#ifndef MK_DUMP_LD
#define MK_DUMP_LD 1024
#endif
#ifndef MK_DUMP_C0
#define MK_DUMP_C0 0
#endif
__global__ void diff_kernel(const bf16_t* a, const bf16_t* b, float* out, size_t n) {
    for (size_t i = (size_t)blockIdx.x * blockDim.x + threadIdx.x; i < n; i += (size_t)gridDim.x * blockDim.x) out[i] = 1e6f * (bf2f(a[i]) - bf2f(b[i]));
}
__global__ void dump_kernel(const bf16_t* src, float* out, size_t n) {
    for (size_t i = (size_t)blockIdx.x * blockDim.x + threadIdx.x; i < n; i += (size_t)gridDim.x * blockDim.x) out[i] = i < (size_t)MK_DUMP_N ? bf2f(src[(i >> 10) * MK_DUMP_LD + MK_DUMP_C0 + (i & 1023)]) : 0.f;
}
extern "C" void kernel_launch(void* const* d_in, const int* in_sizes, int n_in, void* d_out, int out_size, void* d_ws, size_t ws_size, hipStream_t stream) {
    static int ready = 0;
    if (ready == 0) {
        ready = 1;
        if (n_in != 42 || out_size != NB * SEQ * D || ws_size < WS_END) { fprintf(stderr, "kernel_launch: unexpected shapes (n_in %d out %d ws %zu need %zu)\n", n_in, out_size, ws_size, (size_t)WS_END); ready = -1; }
        if (hipFuncSetAttribute((const void*)fwd_kernel, hipFuncAttributeMaxDynamicSharedMemorySize, LDS_BYTES) != hipSuccess) { fprintf(stderr, "kernel_launch: hipFuncSetAttribute failed\n"); ready = -1; }
    }
    if (ready < 0) return;
    (void)in_sizes;
    hipMemsetAsync((char*)d_ws + WS_BAR, 0, WS_ZERO_BYTES, stream);
    Params p;
    memset(&p, 0, sizeof(p));
    const float** fp = (const float**)&p;
    for (int i = 0; i < 42; ++i) fp[i] = (const float*)d_in[i];
    p.out = (float*)d_out; p.ws = (unsigned char*)d_ws;
#if MK_PER_PHASE
    for (int ph = 0; ph < MK_STOP; ++ph) {
        const int local = ph < 2 ? -1 : (ph - 2) % 11, layer = ph < 2 ? 0 : (ph - 2) / 11;
        if (local == 4 && (layer & 1)) continue;
        p.ph_lo = ph; p.ph_hi = ph + 1;
        hipLaunchKernelGGL(fwd_kernel, dim3(256), dim3(NT), LDS_BYTES, stream, p);
    }
#ifdef MK_DIFF
    p.ph_lo = 7; p.ph_hi = 8; p.dbg = 1;
    hipLaunchKernelGGL(fwd_kernel, dim3(256), dim3(NT), LDS_BYTES, stream, p);
    hipLaunchKernelGGL(diff_kernel, dim3(1024), dim3(256), 0, stream, (const bf16_t*)((unsigned char*)d_ws + WS_YO), (const bf16_t*)((unsigned char*)d_ws + WS_HID), (float*)d_out, (size_t)NB * SEQ * D);
#else
    if (MK_DUMP) hipLaunchKernelGGL(dump_kernel, dim3(1024), dim3(256), 0, stream, (const bf16_t*)((unsigned char*)d_ws + (size_t)MK_DUMP), (float*)d_out, (size_t)NB * SEQ * D);
#endif
#else
    p.ph_lo = 0; p.ph_hi = NPHASE;
    hipLaunchKernelGGL(fwd_kernel, dim3(256), dim3(NT), LDS_BYTES, stream, p);
#endif
}
```

```cpp
#include <hip/hip_runtime.h>
#include <stdint.h>
#include <stdio.h>
#include <string.h>

#ifndef MK_PER_PHASE
#define MK_PER_PHASE 0
#endif

typedef unsigned short bf16_t;
typedef short bf16x8 __attribute__((ext_vector_type(8)));
typedef float f32x4 __attribute__((ext_vector_type(4)));
typedef unsigned u32x4 __attribute__((ext_vector_type(4)));
typedef unsigned u32x2 __attribute__((ext_vector_type(2)));
#define LAS __attribute__((address_space(3)))
#define CAS __attribute__((address_space(4)))

constexpr int D = 1024, NB = 4, SEQ = 8192, CTXL = 256, DEPTH = 4;
constexpr int NCTX = NB * CTXL;
constexpr int NROWS = NCTX + NB * SEQ;
constexpr int P_EVEN = 2848, P_ODD = 4416, LDP_EVEN = 3072, LDP_ODD = 4608;
constexpr int NEXP = 32, DEXP = 512, LISTCAP = NROWS;
constexpr float ALPHA = 1.681792830507429f;
constexpr int NT = 512;
constexpr int TCH = 32;
constexpr int NSTEPS = CTXL + SEQ;
constexpr int LDS_BYTES = 160 * 1024;

constexpr size_t al256(size_t x) { return (x + 255) & ~(size_t)255; }
constexpr size_t WS_BAR = 0;
constexpr size_t WS_CNT = 16384;
constexpr int CNT_STRIDE = 64;
constexpr size_t WS_ZERO_BYTES = 16384 + (size_t)4 * 32 * CNT_STRIDE * 4;
constexpr size_t WS_MODV = al256(WS_ZERO_BYTES);
constexpr size_t WS_LB = WS_MODV + al256((size_t)4 * 5 * 6144 * 4);
constexpr size_t WS_XC = WS_LB + al256(4 * 512 * 4);
constexpr size_t WS_WTS = WS_XC + (size_t)NCTX * D * 4;
constexpr size_t WS_LIST = WS_WTS + al256((size_t)2 * NROWS * 4);
constexpr size_t WS_WINT = WS_LIST + al256((size_t)NEXP * LISTCAP * 4);
constexpr size_t WINT_L0 = 0, WINT_L1 = (size_t)LDP_EVEN * D, WINT_L2 = WINT_L1 + (size_t)LDP_ODD * D, WINT_L3 = WINT_L2 + (size_t)LDP_EVEN * D, WINT_END = WINT_L3 + (size_t)LDP_ODD * D;
constexpr size_t WS_WOUTT = WS_WINT + WINT_END * 2;
constexpr size_t WS_LORAT = WS_WOUTT + (size_t)4 * D * D * 2;
constexpr size_t LORA_PER = (size_t)512 * 320;
constexpr size_t WS_EXPGU = WS_LORAT + al256(2 * LORA_PER * 2);
constexpr size_t WS_EXPD = WS_EXPGU + (size_t)NEXP * 1024 * 1024 * 2;
constexpr size_t WS_ACT = WS_EXPD + (size_t)NEXP * 1024 * 512 * 2;
constexpr size_t ROWB = (size_t)NROWS * D * 2;
constexpr size_t WS_FEAT = WS_ACT + ROWB;
constexpr size_t WS_YF = WS_FEAT + ROWB;
constexpr size_t WS_YB = WS_YF + ROWB;
constexpr size_t WS_P = WS_YB + ROWB;
constexpr size_t P_BYTES = (size_t)NROWS * LDP_ODD * 2;
constexpr size_t WS_YO = WS_P;
constexpr size_t WS_HID = WS_P + ROWB;
constexpr size_t WS_YP = WS_HID + ROWB;
static_assert(WS_YP + 2 * ROWB <= WS_P + P_BYTES, "MoE buffers must fit in the P region");
constexpr size_t HALFB = (size_t)NROWS * 512 * 2;
constexpr size_t WS_RWR = WS_P + P_BYTES;
constexpr size_t WS_RWK = WS_RWR + HALFB;
constexpr size_t WS_RWV = WS_RWK + HALFB;
constexpr size_t WS_RWKK = WS_RWV + HALFB;
constexpr size_t WS_RWB = WS_RWKK + HALFB;
constexpr size_t WS_RWG = WS_RWB + HALFB;
constexpr size_t WS_RWDEC = WS_RWG + HALFB;
constexpr size_t WS_LA = WS_RWDEC + (size_t)2 * NROWS * 512 * 4;
constexpr size_t WS_END = WS_LA + (size_t)NROWS * 320 * 2;
static_assert(WS_END <= (size_t)280602384 * 4, "workspace map exceeds the guaranteed ws_size");

struct Params {
    const float *x, *c, *ctx, *c_ctx, *mod_w, *mod_b, *ln_g, *ln_b;
    const float *ev_w_in, *ev_w_out, *ssd_conv_w, *ssd_conv_b, *ssd_dt_bias, *ssd_a_log, *ssd_d, *ssd_norm_w;
    const float *ml_conv_w, *ml_conv_b, *ml_i_bias, *ml_f_bias, *ml_norm_w;
    const float *od_w_in, *od_w_out, *hg_lb_logits, *hg_f_bias, *hg_norm_w;
    const float *rw_mu, *rw_w0, *rw_w2, *rw_a0, *rw_a2, *rw_g2, *rw_k_k, *rw_k_a, *rw_r_k, *rw_ln_w, *rw_ln_b;
    const float *router_w, *router_bias, *exp_w_gate, *exp_w_up, *exp_w_down;
    float* out;
    unsigned char* ws;
    int ph_lo, ph_hi, dbg, pad_;
};
typedef const CAS Params* KP;

__device__ __forceinline__ int ltid(int wv) { int l; asm volatile("v_mbcnt_lo_u32_b32 %0, -1, 0\n\tv_mbcnt_hi_u32_b32 %0, -1, %0" : "=v"(l)); return wv * 64 + l; }
__device__ __forceinline__ float bf2f(bf16_t h) { return __uint_as_float(((unsigned)h) << 16); }
__device__ __forceinline__ float bflo(unsigned u) { return __uint_as_float(u << 16); }
__device__ __forceinline__ float bfhi(unsigned u) { return __uint_as_float(u & 0xffff0000u); }
typedef __bf16 bf16v2_t __attribute__((ext_vector_type(2)));
typedef float f32x2 __attribute__((ext_vector_type(2)));
__device__ __forceinline__ unsigned pk2(float lo, float hi) { const f32x2 v = {lo, hi}; return __builtin_bit_cast(unsigned, __builtin_convertvector(v, bf16v2_t)); }
__device__ __forceinline__ bf16_t f2bf(float f) { return (bf16_t)(pk2(f, 0.f) & 0xffffu); }
__device__ __forceinline__ void unpack8(const u32x4& u, float* f) {
    f[0] = bflo(u.x); f[1] = bfhi(u.x); f[2] = bflo(u.y); f[3] = bfhi(u.y); f[4] = bflo(u.z); f[5] = bfhi(u.z); f[6] = bflo(u.w); f[7] = bfhi(u.w);
}
__device__ __forceinline__ u32x4 pack8(const float* f) { u32x4 u; u.x = pk2(f[0], f[1]); u.y = pk2(f[2], f[3]); u.z = pk2(f[4], f[5]); u.w = pk2(f[6], f[7]); return u; }
__device__ __forceinline__ float sigmoidf_(float x) { return __builtin_amdgcn_rcpf(1.f + __expf(-x)); }
__device__ __forceinline__ float siluf_(float x) { return x * __builtin_amdgcn_rcpf(1.f + __expf(-x)); }
__device__ __forceinline__ float softplus_fast(float x) { return x > 20.f ? x : __logf(1.f + __expf(x)); }
__device__ __forceinline__ float tanh_fast(float x) { return 1.f - 2.f * __builtin_amdgcn_rcpf(1.f + __expf(2.f * x)); }
__device__ __forceinline__ float softplusf_(float x) { return x > 20.f ? x : __logf(1.f + __expf(x)); }
__device__ __forceinline__ float logsigmoidf_(float x) { return fminf(x, 0.f) - __logf(1.f + __expf(-fabsf(x))); }
template <int CTRL> __device__ __forceinline__ float dppmov(float v) {
    return __builtin_bit_cast(float, __builtin_amdgcn_update_dpp(0, __builtin_bit_cast(int, v), CTRL, 0xf, 0xf, true));
}
__device__ __forceinline__ float allreduce16(float v) {
    v += dppmov<0xB1>(v);
    v += dppmov<0x4E>(v);
    v += dppmov<0x141>(v);
    v += dppmov<0x140>(v);
    return v;
}
__device__ __forceinline__ float allreduce8_(float v) { v += dppmov<0xB1>(v); v += dppmov<0x4E>(v); v += dppmov<0x141>(v); return v; }
__device__ __forceinline__ float wave_sum(float v) {
    v = allreduce16(v);
    const float r0 = __builtin_bit_cast(float, __builtin_amdgcn_readlane(__builtin_bit_cast(int, v), 0)), r1 = __builtin_bit_cast(float, __builtin_amdgcn_readlane(__builtin_bit_cast(int, v), 16));
    const float r2 = __builtin_bit_cast(float, __builtin_amdgcn_readlane(__builtin_bit_cast(int, v), 32)), r3 = __builtin_bit_cast(float, __builtin_amdgcn_readlane(__builtin_bit_cast(int, v), 48));
    return (r0 + r1) + (r2 + r3);
}
template <int W> __device__ __forceinline__ float group_sum(float v) {
    if (W == 8) return allreduce8_(v);
    return allreduce16(v);
}

#define XB_TMO      128
#define XB_XCNT(j)  (256  + 64 * (j))
#define XB_XSUB(j)  (1280 + 64 * (j))
#define XB_XGEN(j)  (2304 + 64 * (j))
#define XB_TOP      3328
#define XB_TOPGEN   3392
#define XCD_BAR_WORDS 3456
#define XB_SPIN_CAP (1u << 22)
__device__ __forceinline__ unsigned xb_ld(unsigned* p)              { return __hip_atomic_load(p, __ATOMIC_RELAXED, __HIP_MEMORY_SCOPE_AGENT); }
__device__ __forceinline__ unsigned xb_add(unsigned* p, unsigned v) { return __hip_atomic_fetch_add(p, v, __ATOMIC_RELAXED, __HIP_MEMORY_SCOPE_AGENT); }
__device__ __forceinline__ unsigned xb_xcc_id() { return (unsigned)__builtin_amdgcn_s_getreg((3 << 11) | 20) & 0xFu; }
#define XB_SPIN(cond, bar) do { unsigned _sp = 0; while (cond) { __builtin_amdgcn_s_sleep(1); \
    if ((++_sp & 255u) == 0u) { if (xb_ld(&(bar)[XB_TMO])) break; if (_sp > XB_SPIN_CAP) { atomicAdd(&(bar)[XB_TMO], 1u); break; } } } } while (0)
struct XcdBarrier { unsigned* bar; unsigned x; volatile LAS unsigned* st; };
__device__ __forceinline__ XcdBarrier xcd_barrier_post(int wv, unsigned* bar, volatile LAS unsigned* st) {
    XcdBarrier b; b.bar = bar; b.x = xb_xcc_id(); b.st = st;
    if (ltid(wv) == 0) (void)xb_add(&bar[XB_XCNT(b.x)], 1u);
    return b;
}
__device__ __forceinline__ void xcd_barrier_complete(unsigned* bar, unsigned x, unsigned& nloc, unsigned& nx) {
    const unsigned G = gridDim.x * gridDim.y * gridDim.z;
    unsigned sum, cnt, mine, sp = 0u;
    for (;;) {
        sum = 0u; cnt = 0u; mine = 0u;
#pragma unroll
        for (unsigned j = 0; j < 16; ++j) { const unsigned c = xb_ld(&bar[XB_XCNT(j)]); sum += c; cnt += (c > 0u) ? 1u : 0u; mine = (j == x) ? c : mine; }
        if (sum == G) break;
        __builtin_amdgcn_s_sleep(1);
        if ((++sp & 255u) == 0u) { if (xb_ld(&bar[XB_TMO])) break; if (sp > XB_SPIN_CAP) { atomicAdd(&bar[XB_TMO], 1u); break; } }
    }
    nloc = mine > 0u ? mine : 1u; nx = cnt > 0u ? cnt : 1u;
}
__device__ __forceinline__ void xcd_barrier(int wv, const XcdBarrier& b) {
    asm volatile("s_waitcnt vmcnt(0)" ::: "memory");
    __syncthreads();
    if (ltid(wv) == 0) {
        unsigned* bar = b.bar;
        asm volatile("" : "+s"(bar));
        __builtin_amdgcn_s_waitcnt(0);
        unsigned nloc = b.st[0], nx = b.st[1];
        if (nloc == 0u) { xcd_barrier_complete(bar, b.x, nloc, nx); b.st[0] = nloc; b.st[1] = nx; }
        const unsigned old = xb_add(&bar[XB_XSUB(b.x)], 1u);
        const unsigned gen = old / nloc;
        if (old + 1u == (gen + 1u) * nloc) {
            __builtin_amdgcn_fence(__ATOMIC_RELEASE, "agent");
            asm volatile("s_waitcnt vmcnt(0)" ::: "memory");
            const unsigned og = xb_add(&bar[XB_TOP], 1u);
            const unsigned tg = og / nx;
            if (og + 1u == (tg + 1u) * nx) xb_add(&bar[XB_TOPGEN], 1u);
            else XB_SPIN(xb_ld(&bar[XB_TOPGEN]) == tg, bar);
            __builtin_amdgcn_fence(__ATOMIC_ACQUIRE, "agent");
            xb_add(&bar[XB_XGEN(b.x)], 1u);
            asm volatile("s_waitcnt vmcnt(0)" ::: "memory");
        } else {
            XB_SPIN(xb_ld(&bar[XB_XGEN(b.x)]) == gen, bar);
            __builtin_amdgcn_fence(__ATOMIC_ACQUIRE, "agent");
            asm volatile("s_waitcnt vmcnt(0)" ::: "memory");
        }
    }
    __syncthreads();
}

__device__ __forceinline__ int row_mod(int r) { return r < NCTX ? 4 : ((r - NCTX) >> 13); }
__device__ __forceinline__ void row_seg(int r, int& t, int& len) { if (r < NCTX) { t = r & 255; len = CTXL; } else { t = (r - NCTX) & 8191; len = SEQ; } }
__device__ __forceinline__ int scan_row(int tg, int b, int dir, int odd) {
    if (tg < CTXL) { const int t = dir ? (CTXL - 1 - tg) : tg; return b * CTXL + t; }
    int sg = tg - CTXL; if (dir) sg = SEQ - 1 - sg;
    const int s = odd ? (((sg & 127) << 6) + (sg >> 7)) : sg;
    return NCTX + b * SEQ + s;
}
__device__ __forceinline__ const float* modvec(const unsigned char* ws, int layer, int m, int which) {
    return (const float*)(ws + WS_MODV) + ((size_t)(layer * 5 + m) * 6 + which) * D;
}

constexpr int G_BM = 256, G_BN = 128, G_BK = 64;
constexpr int G_ABYTES = G_BM * G_BK * 2, G_BBYTES = G_BN * G_BK * 2, G_BUF = G_ABYTES + G_BBYTES;
__device__ __forceinline__ int swz(int o) { return o ^ (((o >> 9) & 1) << 5); }

template <class RowSrc, class Epi>
__device__ __forceinline__ void gemm_tile(int wv, const bf16_t* __restrict__ A, int lda, const RowSrc& rs, const bf16_t* __restrict__ Bt, int ldb, int n0, int K, const Epi& epi, LAS char* lds) {
    const int tid = ltid(wv), lane = tid & 63, wid = tid >> 6, wm = wid >> 1, wn = wid & 1;
    const bf16_t* ap[4]; int aoff[4];
#pragma unroll
    for (int i = 0; i < 4; ++i) {
        const int c = tid + NT * i, row = c >> 3, kc = c & 7;
        ap[i] = A + (size_t)rs.src(row) * lda + kc * 8;
        aoff[i] = ((row >> 4) * 2 + (kc >> 2)) * 1024 + swz((row & 15) * 64 + (kc & 3) * 16);
    }
    const bf16_t* bp[2]; int boff[2];
#pragma unroll
    for (int i = 0; i < 2; ++i) {
        const int c = tid + NT * i, row = c >> 3, kc = c & 7;
        bp[i] = Bt + (size_t)(n0 + row) * ldb + kc * 8;
        boff[i] = G_ABYTES + ((row >> 4) * 2 + (kc >> 2)) * 1024 + swz((row & 15) * 64 + (kc & 3) * 16);
    }
    f32x4 acc[4][4];
#pragma unroll
    for (int i = 0; i < 4; ++i)
#pragma unroll
        for (int j = 0; j < 4; ++j) acc[i][j] = (f32x4){0.f, 0.f, 0.f, 0.f};
    u32x4 ra[2][4], rb[2][2];
    const int KT = K / G_BK;
    const int fragoff = swz((lane & 15) * 64 + (lane >> 4) * 16);
#define G_LOAD(set, kt_) do { _Pragma("unroll") for (int i = 0; i < 4; ++i) ra[set][i] = *(const u32x4*)(ap[i] + (kt_) * G_BK); \
                              _Pragma("unroll") for (int i = 0; i < 2; ++i) rb[set][i] = *(const u32x4*)(bp[i] + (kt_) * G_BK); } while (0)
#define G_STORE(set, buf) do { _Pragma("unroll") for (int i = 0; i < 4; ++i) *(LAS u32x4*)((buf) + aoff[i]) = ra[set][i]; \
                               _Pragma("unroll") for (int i = 0; i < 2; ++i) *(LAS u32x4*)((buf) + boff[i]) = rb[set][i]; } while (0)
#define G_COMPUTE(cur) do { bf16x8 af[2][4], bfr[2][4]; \
        _Pragma("unroll") for (int ks = 0; ks < 2; ++ks) { \
            _Pragma("unroll") for (int ni = 0; ni < 4; ++ni) bfr[ks][ni] = *(LAS bf16x8*)((cur) + G_ABYTES + ((wn * 4 + ni) * 2 + ks) * 1024 + fragoff); \
            _Pragma("unroll") for (int mi = 0; mi < 4; ++mi) af[ks][mi] = *(LAS bf16x8*)((cur) + ((wm * 4 + mi) * 2 + ks) * 1024 + fragoff); } \
        __builtin_amdgcn_sched_barrier(0); \
        _Pragma("unroll") for (int ks = 0; ks < 2; ++ks) _Pragma("unroll") for (int mi = 0; mi < 4; ++mi) _Pragma("unroll") for (int ni = 0; ni < 4; ++ni) \
            acc[mi][ni] = __builtin_amdgcn_mfma_f32_16x16x32_bf16(bfr[ks][ni], af[ks][mi], acc[mi][ni], 0, 0, 0); \
        __builtin_amdgcn_sched_barrier(0); } while (0)
    G_LOAD(0, 0);
    G_STORE(0, lds);
    if (KT > 1) G_LOAD(0, 1);
    if (KT > 2) G_LOAD(1, 2);
    __syncthreads();
    for (int kt = 0; kt < KT; kt += 2) {
        G_COMPUTE(lds);
        if (kt + 1 < KT) G_STORE(0, lds + G_BUF);
        if (kt + 3 < KT) G_LOAD(0, kt + 3);
        __syncthreads();
        if (kt + 1 < KT) {
            G_COMPUTE(lds + G_BUF);
            if (kt + 2 < KT) G_STORE(1, lds);
            if (kt + 4 < KT) G_LOAD(1, kt + 4);
            __syncthreads();
        }
    }
#undef G_LOAD
#undef G_STORE
#undef G_COMPUTE
    epi(acc, wm * 64 + (lane & 15), wn * 64 + 4 * (lane >> 4));
}

constexpr int G2_BN = 256, G2_BBYTES = G2_BN * G_BK * 2, G2_BUF = G_ABYTES + G2_BBYTES;

struct RowLinear { int m0; __device__ __forceinline__ int src(int r) const { return m0 + r; } };
struct RowList {
    const int* list; int cnt; int shift;
    __device__ __forceinline__ int src(int r) const { const int a = list[r < cnt ? r : 0]; return a >> shift; }
};
struct EpiStoreBf16 {
    bf16_t* C; int ldc; int m0; int n0; int N;
    template <int NI> __device__ __forceinline__ void operator()(const f32x4 (&acc)[4][NI], int rbase, int cbase) const {
#pragma unroll
        for (int mi = 0; mi < 4; ++mi) {
            bf16_t* rowp = C + (size_t)(m0 + rbase + mi * 16) * ldc + n0 + cbase;
#pragma unroll
            for (int ni = 0; ni < NI; ++ni) {
                if (n0 + cbase + ni * 16 < N) { u32x2 v; v.x = pk2(acc[mi][ni][0], acc[mi][ni][1]); v.y = pk2(acc[mi][ni][2], acc[mi][ni][3]); *(u32x2*)(rowp + ni * 16) = v; }
            }
        }
    }
};
struct EpiSwiGLU {
    bf16_t* H; const int* list; int cnt; int n0;
    template <int NI> __device__ __forceinline__ void operator()(const f32x4 (&acc)[4][NI], int rbase, int cbase) const {
#pragma unroll
        for (int mi = 0; mi < 4; ++mi) {
            const int r = rbase + mi * 16;
            if (r < cnt) {
                const int a = list[r];
                const int wnb = cbase & ~63, q4 = cbase & 63;
                bf16_t* rowp = H + (size_t)a * DEXP + ((n0 + wnb) >> 1) + q4;
#pragma unroll
                for (int q = 0; q < NI / 2; ++q) {
                    float o[4];
#pragma unroll
                    for (int j = 0; j < 4; ++j) o[j] = siluf_(acc[mi][2 * q][j]) * acc[mi][2 * q + 1][j];
                    u32x2 v; v.x = pk2(o[0], o[1]); v.y = pk2(o[2], o[3]); *(u32x2*)(rowp + q * 16) = v;
                }
            }
        }
    }
};
struct EpiScatterBf16 {
    bf16_t* C; const int* list; int cnt; int n0;
    template <int NI> __device__ __forceinline__ void operator()(const f32x4 (&acc)[4][NI], int rbase, int cbase) const {
#pragma unroll
        for (int mi = 0; mi < 4; ++mi) {
            const int r = rbase + mi * 16;
            if (r < cnt) {
                bf16_t* rowp = C + (size_t)list[r] * D + n0 + cbase;
#pragma unroll
                for (int ni = 0; ni < NI; ++ni) { u32x2 v; v.x = pk2(acc[mi][ni][0], acc[mi][ni][1]); v.y = pk2(acc[mi][ni][2], acc[mi][ni][3]); *(u32x2*)(rowp + ni * 16) = v; }
            }
        }
    }
};
struct EpiDecay {
    float* Dc; const float* w0; int m0; int n0;
    template <int NI> __device__ __forceinline__ void operator()(const f32x4 (&acc)[4][NI], int rbase, int cbase) const {
#pragma unroll
        for (int ni = 0; ni < NI; ++ni) {
            const int col = n0 + cbase + ni * 16;
            const f32x4 w0v = *(const f32x4*)(w0 + col);
#pragma unroll
            for (int mi = 0; mi < 4; ++mi) {
                f32x4 o;
#pragma unroll
                for (int j = 0; j < 4; ++j) { const float w = w0v[j] + acc[mi][ni][j]; o[j] = __expf(-__expf(-softplus_fast(-w) - 0.5f)); }
                *(f32x4*)(Dc + (size_t)(m0 + rbase + mi * 16) * 512 + col) = o;
            }
        }
    }
};
struct EpiAK {
    bf16_t* Kb; const bf16_t* KKb; bf16_t* Bb; const float* a0; const float* k_a; int m0; int n0;
    template <int NI> __device__ __forceinline__ void operator()(const f32x4 (&acc)[4][NI], int rbase, int cbase) const {
#pragma unroll
        for (int ni = 0; ni < NI; ++ni) {
            const int col = n0 + cbase + ni * 16;
            const f32x4 a0v = *(const f32x4*)(a0 + col), kav = *(const f32x4*)(k_a + col);
#pragma unroll
            for (int mi = 0; mi < 4; ++mi) {
                const size_t off = (size_t)(m0 + rbase + mi * 16) * 512 + col;
                const u32x2 kr = *(const u32x2*)(Kb + off), kkr = *(const u32x2*)(KKb + off);
                const float kf[4] = {bflo(kr.x), bfhi(kr.x), bflo(kr.y), bfhi(kr.y)}, kkf[4] = {bflo(kkr.x), bfhi(kkr.x), bflo(kkr.y), bfhi(kkr.y)};
                float k2[4], bb[4];
#pragma unroll
                for (int j = 0; j < 4; ++j) { const float a = sigmoidf_(a0v[j] + acc[mi][ni][j]); k2[j] = kf[j] * (1.f + (a - 1.f) * kav[j]); bb[j] = kkf[j] * a; }
                u32x2 v; v.x = pk2(k2[0], k2[1]); v.y = pk2(k2[2], k2[3]); *(u32x2*)(Kb + off) = v;
                v.x = pk2(bb[0], bb[1]); v.y = pk2(bb[2], bb[3]); *(u32x2*)(Bb + off) = v;
            }
        }
    }
};

namespace pg8 {
#define PG8_LAS __attribute__((address_space(3)))
constexpr int BM = 256, BK = 64, HALF = 128, HTB = HALF * BK * 2, STAGE_BYTES = 8 * HTB, NXCD = 8, WGM = 8;
__host__ __device__ __forceinline__ int lds_byte(int r, int c) { const int st = (r >> 4) * 2 + (c >> 5), rr = r & 15, cc = c & 31, ob = rr * 64 + cc * 2; return st * 1024 + (ob ^ (((ob >> 9) & 1) << 5)); }
__host__ __device__ __forceinline__ void stage_rc(int b, int& R, int& C) { const int st = b / 1024, sb = b % 1024, swz = sb ^ (((sb >> 9) & 1) << 5); R = (st >> 1) * 16 + swz / 64; C = (st & 1) * 32 + (swz % 64) / 2; }
__host__ __device__ __forceinline__ int perm32(int rho) { const int n = rho >> 4, i = rho & 15; return 8 * (i >> 2) + 4 * n + (i & 3); }
struct Unit { int pm, pn; };
struct Gemm { const bf16_t* A; const bf16_t* Bt; int M, N, K; };
struct StaticOrder {
    int nM, nN, nwg, G, c;
    __host__ __device__ void init(int M, int N, int G_, int c_) { nM = M / BM; nN = N / BM; nwg = nM * nN; G = G_; c = c_; }
    __host__ __device__ bool next(int i, Unit& u) const {
        const long L = (long)i * G + c; if (L >= nwg) return false;
        int wgid = (int)L; { const int q = nwg / NXCD, r = nwg % NXCD, xcd = wgid % NXCD, off = wgid / NXCD; wgid = (xcd < r ? xcd * (q + 1) : r * (q + 1) + (xcd - r) * q) + off; }
        const int nig = WGM * nN, gid = wgid / nig, fm = gid * WGM, gsz = (nM - fm) < WGM ? (nM - fm) : WGM;
        u.pm = fm + ((wgid % nig) % gsz); u.pn = (wgid % nig) / gsz; return true;
    }
    __device__ __forceinline__ void a_ready(const Unit&) const {}
    __device__ __forceinline__ void done(const Unit&) const {}
};
struct EpiStoreP {
    static constexpr bool PERM = true, AFTER_DRAIN = false;
    bf16_t* O; int ldc;
    __device__ __forceinline__ void operator()(const f32x4 (&acc)[2][2][4][2], const Unit& u, int wr, int wc, int fr, int fq) const {
        const int row0 = u.pm * BM + wr * 64 + fr, col0 = u.pn * BM + wc * 32 + 8 * fq;
#pragma unroll
        for (int ai = 0; ai < 2; ++ai)
#pragma unroll
            for (int m = 0; m < 4; ++m) { bf16_t* rowp = O + (size_t)(row0 + ai * HALF + m * 16) * ldc + col0;
#pragma unroll
                for (int bj = 0; bj < 2; ++bj) { const f32x4 v0 = acc[ai][bj][m][0], v1 = acc[ai][bj][m][1];
                    u32x4 w; w.x = pk2(v0[0], v0[1]); w.y = pk2(v0[2], v0[3]); w.z = pk2(v1[0], v1[1]); w.w = pk2(v1[2], v1[3]);
                    *(u32x4*)(rowp + bj * HALF) = w; } }
    }
};
template <class Epi, class Sched>
__device__ __forceinline__ void gemm_phase(int wv, PG8_LAS unsigned char* lds, const Gemm g, const Sched& S, const Epi& E) {
    const int tid = ltid(wv), wid = __builtin_amdgcn_readfirstlane(tid >> 6), lane = tid & 63, wr = wid >> 2, wc = wid & 3, fr = lane & 15, fq = lane >> 4;
    const int K = g.K, nt = K / BK;
    unsigned voffA[2], voffB[2];
#pragma unroll
    for (int i = 0; i < 2; ++i) { int R, C; stage_rc(tid * 16 + i * 8192, R, C); const int Rb = Epi::PERM ? ((R & ~31) + perm32(R & 31)) : R;
        voffA[i] = (unsigned)(R * K + C) * 2u; voffB[i] = (unsigned)(Rb * K + C) * 2u; }
    const size_t kstep = (size_t)(BK * 2);
    const size_t hstep = (size_t)HALF * K * 2;
    const size_t tstep = 2 * hstep;
    const unsigned ldsw = (unsigned)wid * 1024u;
    const int aoff = lds_byte(wr * 64 + fr, fq * 8), boff = lds_byte(wc * 32 + fr, fq * 8);
#define PG8_SA(b, h) (((b) * 2 + (h)) * HTB)
#define PG8_SB(b, h) ((4 + (b) * 2 + (h)) * HTB)
#define PG8_STAGE(bufoff, gbase, voff) do { _Pragma("unroll") for (int _i = 0; _i < 2; ++_i) \
        __builtin_amdgcn_global_load_lds((const unsigned*)((const char*)(gbase) + (voff)[_i]), (PG8_LAS unsigned*)(lds + (bufoff) + ldsw + _i * 8192), 16, 0, 0); } while (0)
#define PG8_LDA(dst, b, h) do { _Pragma("unroll") for (int m = 0; m < 4; ++m) _Pragma("unroll") for (int k = 0; k < 2; ++k) dst[m][k] = *(const PG8_LAS bf16x8*)(lds + PG8_SA(b, h) + aoff + m * 2048 + k * 1024); } while (0)
#define PG8_LDB(dst, b, h) do { _Pragma("unroll") for (int n = 0; n < 2; ++n) _Pragma("unroll") for (int k = 0; k < 2; ++k) dst[n][k] = *(const PG8_LAS bf16x8*)(lds + PG8_SB(b, h) + boff + n * 2048 + k * 1024); } while (0)
#define PG8_MMA(ai, bj, At, Bt) do { __builtin_amdgcn_s_setprio(1); _Pragma("unroll") for (int m = 0; m < 4; ++m) _Pragma("unroll") for (int n = 0; n < 2; ++n) _Pragma("unroll") for (int k = 0; k < 2; ++k) \
        acc[ai][bj][m][n] = __builtin_amdgcn_mfma_f32_16x16x32_bf16(Bt[n][k], At[m][k], acc[ai][bj][m][n], 0, 0, 0); __builtin_amdgcn_s_setprio(0); } while (0)
#define PG8_WAIT_V(n) asm volatile("s_waitcnt vmcnt(" #n ")" ::: "memory")
#define PG8_WAIT_L(n) asm volatile("s_waitcnt lgkmcnt(" #n ")" ::: "memory")
#define PG8_BAR __builtin_amdgcn_s_barrier()
#define PG8_SCHED __builtin_amdgcn_sched_barrier(0)
    Unit cur, nxt; int ui = 0;
    if (!S.next(0, cur)) return;
    f32x4 acc[2][2][4][2];
#pragma unroll
    for (int a = 0; a < 2; ++a)
#pragma unroll
        for (int b = 0; b < 2; ++b)
#pragma unroll
            for (int m = 0; m < 4; ++m)
#pragma unroll
                for (int n = 0; n < 2; ++n) acc[a][b][m][n] = (f32x4){0.f, 0.f, 0.f, 0.f};
    bf16x8 At[4][2], B0[2][2], B1[2][2];
    const char* cA = (const char*)g.A + (size_t)cur.pm * tstep; const char* cB = (const char*)g.Bt + (size_t)cur.pn * tstep;
    S.a_ready(cur);
    PG8_STAGE(PG8_SB(0, 0), cB, voffB); PG8_STAGE(PG8_SA(0, 0), cA, voffA); PG8_STAGE(PG8_SB(0, 1), cB + hstep, voffB); PG8_STAGE(PG8_SA(0, 1), cA + hstep, voffA);
    if (wr == 1) PG8_BAR;
    PG8_WAIT_V(4); PG8_BAR;
    PG8_STAGE(PG8_SB(1, 0), cB + kstep, voffB); PG8_STAGE(PG8_SA(1, 0), cA + kstep, voffA); PG8_STAGE(PG8_SB(1, 1), cB + hstep + kstep, voffB);
    PG8_WAIT_V(6); PG8_BAR;
    for (;;) {
        const bool has_next = S.next(ui + 1, nxt);
        const char* nA = has_next ? (const char*)g.A + (size_t)nxt.pm * tstep : cA; const char* nB = has_next ? (const char*)g.Bt + (size_t)nxt.pn * tstep : cB;
        for (int t = 0; t < nt; t += 2) {
            const bool last = (t == nt - 2);
            const char* a1 = cA + (size_t)(t + 1) * kstep;
            const char* a2 = last ? nA : cA + (size_t)(t + 2) * kstep; const char* b2 = last ? nB : cB + (size_t)(t + 2) * kstep;
            const char* a3 = a2 + kstep; const char* b3 = b2 + kstep;
            if (last && has_next) S.a_ready(nxt);
            PG8_LDB(B0, 0, 0); PG8_SCHED; PG8_LDA(At, 0, 0); PG8_STAGE(PG8_SA(1, 1), a1 + hstep, voffA);
            PG8_WAIT_L(8); PG8_BAR; PG8_WAIT_L(0); PG8_MMA(0, 0, At, B0); PG8_BAR; PG8_SCHED;
            PG8_LDB(B1, 0, 1); PG8_STAGE(PG8_SB(0, 0), b2, voffB);
            PG8_BAR; PG8_WAIT_L(0); PG8_MMA(0, 1, At, B1); PG8_BAR;
            PG8_LDA(At, 0, 1); PG8_STAGE(PG8_SA(0, 0), a2, voffA);
            PG8_BAR; PG8_WAIT_L(0); PG8_MMA(1, 0, At, B0); PG8_BAR; PG8_SCHED;
            PG8_STAGE(PG8_SB(0, 1), b2 + hstep, voffB);
            PG8_WAIT_V(6); PG8_BAR; PG8_MMA(1, 1, At, B1); PG8_BAR;
            PG8_LDB(B0, 1, 0); PG8_SCHED; PG8_LDA(At, 1, 0); PG8_STAGE(PG8_SA(0, 1), a2 + hstep, voffA);
            PG8_WAIT_L(8); PG8_BAR; PG8_WAIT_L(0); PG8_MMA(0, 0, At, B0); PG8_BAR; PG8_SCHED;
            PG8_LDB(B1, 1, 1); PG8_STAGE(PG8_SB(1, 0), b3, voffB);
            PG8_BAR; PG8_WAIT_L(0); PG8_MMA(0, 1, At, B1); PG8_BAR;
            PG8_LDA(At, 1, 1); PG8_STAGE(PG8_SA(1, 0), a3, voffA);
            PG8_BAR; PG8_WAIT_L(0); PG8_MMA(1, 0, At, B0); PG8_BAR; PG8_SCHED;
            PG8_STAGE(PG8_SB(1, 1), b3 + hstep, voffB);
            PG8_WAIT_V(6); PG8_BAR; PG8_MMA(1, 1, At, B1); PG8_BAR;
        }
            if constexpr (!Epi::AFTER_DRAIN) { E(acc, cur, wr, wc, fr, fq); S.done(cur); }
            if (!has_next) break;
#pragma unroll
        for (int a = 0; a < 2; ++a)
#pragma unroll
            for (int b = 0; b < 2; ++b)
#pragma unroll
                for (int m = 0; m < 4; ++m)
#pragma unroll
                    for (int n = 0; n < 2; ++n) acc[a][b][m][n] = (f32x4){0.f, 0.f, 0.f, 0.f};
        cur = nxt; cA = nA; cB = nB; ++ui;
    }
    PG8_WAIT_V(0);
    if (wr == 0) PG8_BAR;
    PG8_BAR;
    if constexpr (Epi::AFTER_DRAIN) { E.fused(acc, cur, wr, wc, fr, fq, lds, wid, lane); S.done(cur); }
#undef PG8_SA
#undef PG8_SB
#undef PG8_STAGE
#undef PG8_LDA
#undef PG8_LDB
#undef PG8_MMA
#undef PG8_WAIT_V
#undef PG8_WAIT_L
#undef PG8_BAR
#undef PG8_SCHED
}
struct UnitG { int pm, pn; const char* bbase; const PG8_LAS int* ltab; int cnt; int e; };
struct MoeOrder {
    const PG8_LAS int* tstart; const PG8_LAS int* tcnt; const PG8_LAS int* ltabs; const int* lists; const char* bt; size_t estride; int ncol, shift, G, c;
    __device__ __forceinline__ bool next(int i, UnitG& u) const {
        const int t = i * G + c; if (t >= tstart[32] * ncol) return false;
        const int tm = t / ncol; int e = 0;
#pragma unroll 1
        while (tstart[e + 1] <= tm) ++e;
        e = __builtin_amdgcn_readfirstlane(e);
        const int ts = __builtin_amdgcn_readfirstlane(tstart[e]), tc = __builtin_amdgcn_readfirstlane(tcnt[e]);
        u.pm = tm - ts; u.pn = t - tm * ncol; u.bbase = bt + (size_t)e * estride; u.e = e; u.cnt = tc - u.pm * BM; u.ltab = ltabs + i * BM;
        return true;
    }
    __device__ __forceinline__ void a_ready(const UnitG&) const {}
    __device__ __forceinline__ void done(const UnitG&) const {}
};
struct EpiSwiGLUG {
    static constexpr bool PERM = false, AFTER_DRAIN = false;
    bf16_t* H;
    __device__ __forceinline__ void operator()(const f32x4 (&acc)[2][2][4][2], const UnitG& u, int wr, int wc, int fr, int fq) const {
#pragma unroll
        for (int ai = 0; ai < 2; ++ai)
#pragma unroll
            for (int m = 0; m < 4; ++m) { const int r = ai * HALF + wr * 64 + m * 16 + fr;
                if (r < u.cnt) { bf16_t* rowp = H + (size_t)u.ltab[r] * DEXP + ((u.pn * BM + wc * 32) >> 1) + 4 * fq;
#pragma unroll
                    for (int bj = 0; bj < 2; ++bj) { const f32x4 gt = acc[ai][bj][m][0], up = acc[ai][bj][m][1];
                        u32x2 w; w.x = pk2(siluf_(gt[0]) * up[0], siluf_(gt[1]) * up[1]); w.y = pk2(siluf_(gt[2]) * up[2], siluf_(gt[3]) * up[3]);
                        *(u32x2*)(rowp + bj * (HALF / 2)) = w; } } }
    }
};
struct EpiScatterG {
    static constexpr bool PERM = true, AFTER_DRAIN = false;
    bf16_t* O;
    __device__ __forceinline__ void operator()(const f32x4 (&acc)[2][2][4][2], const UnitG& u, int wr, int wc, int fr, int fq) const {
#pragma unroll
        for (int ai = 0; ai < 2; ++ai)
#pragma unroll
            for (int m = 0; m < 4; ++m) { const int r = ai * HALF + wr * 64 + m * 16 + fr;
                if (r < u.cnt) { bf16_t* rowp = O + (size_t)u.ltab[r] * D + u.pn * BM + wc * 32 + 8 * fq;
#pragma unroll
                    for (int bj = 0; bj < 2; ++bj) { const f32x4 v0 = acc[ai][bj][m][0], v1 = acc[ai][bj][m][1];
                        u32x4 w; w.x = pk2(v0[0], v0[1]); w.y = pk2(v0[2], v0[3]); w.z = pk2(v1[0], v1[1]); w.w = pk2(v1[2], v1[3]);
                        *(u32x4*)(rowp + bj * HALF) = w; } } }
    }
};
template <class Epi, class Sched>
__device__ __forceinline__ void gemm_phase_g(int wv, PG8_LAS unsigned char* lds, const Gemm g, const Sched& S, const Epi& E) {
    const int tid = ltid(wv), wid = __builtin_amdgcn_readfirstlane(tid >> 6), lane = tid & 63, wr = wid >> 2, wc = wid & 3, fr = lane & 15, fq = lane >> 4;
    const int K = g.K, nt = K / BK;
    unsigned voffB[2];
#pragma unroll
    for (int i = 0; i < 2; ++i) { int R, C; stage_rc(tid * 16 + i * 8192, R, C); const int Rb = Epi::PERM ? ((R & ~31) + perm32(R & 31)) : R;
        voffB[i] = (unsigned)(Rb * K + C) * 2u; }
    const unsigned rowb = (unsigned)K * 2u;
#define PG8_AOFFS(u, dst) do { const int _t = ltid(wv); _Pragma("unroll") for (int _i = 0; _i < 2; ++_i) { int _R, _C; stage_rc(_t * 16 + _i * 8192, _R, _C); \
        _Pragma("unroll") for (int _h = 0; _h < 2; ++_h) dst[_h][_i] = (unsigned)((u).ltab[_h * HALF + _R] >> S.shift) * rowb + (unsigned)(_C * 2); } } while (0)
#define PG8_STAGE_A(bufoff, AO, koff) do { _Pragma("unroll") for (int _i = 0; _i < 2; ++_i) \
        __builtin_amdgcn_global_load_lds((const unsigned*)((const char*)g.A + (size_t)(AO)[_i] + (size_t)(koff)), (PG8_LAS unsigned*)(lds + (bufoff) + ldsw + _i * 8192), 16, 0, 0); } while (0)
    const size_t kstep = (size_t)(BK * 2);
    const size_t hstep = (size_t)HALF * K * 2;
    const size_t tstep = 2 * hstep;
    const unsigned ldsw = (unsigned)wid * 1024u;
    const int aoff = lds_byte(wr * 64 + fr, fq * 8), boff = lds_byte(wc * 32 + fr, fq * 8);
#define PG8_SA(b, h) (((b) * 2 + (h)) * HTB)
#define PG8_SB(b, h) ((4 + (b) * 2 + (h)) * HTB)
#define PG8_STAGE(bufoff, gbase, voff) do { _Pragma("unroll") for (int _i = 0; _i < 2; ++_i) \
        __builtin_amdgcn_global_load_lds((const unsigned*)((const char*)(gbase) + (voff)[_i]), (PG8_LAS unsigned*)(lds + (bufoff) + ldsw + _i * 8192), 16, 0, 0); } while (0)
#define PG8_LDA(dst, b, h) do { _Pragma("unroll") for (int m = 0; m < 4; ++m) _Pragma("unroll") for (int k = 0; k < 2; ++k) dst[m][k] = *(const PG8_LAS bf16x8*)(lds + PG8_SA(b, h) + aoff + m * 2048 + k * 1024); } while (0)
#define PG8_LDB(dst, b, h) do { _Pragma("unroll") for (int n = 0; n < 2; ++n) _Pragma("unroll") for (int k = 0; k < 2; ++k) dst[n][k] = *(const PG8_LAS bf16x8*)(lds + PG8_SB(b, h) + boff + n * 2048 + k * 1024); } while (0)
#define PG8_MMA(ai, bj, At, Bt) do { __builtin_amdgcn_s_setprio(1); _Pragma("unroll") for (int m = 0; m < 4; ++m) _Pragma("unroll") for (int n = 0; n < 2; ++n) _Pragma("unroll") for (int k = 0; k < 2; ++k) \
        acc[ai][bj][m][n] = __builtin_amdgcn_mfma_f32_16x16x32_bf16(Bt[n][k], At[m][k], acc[ai][bj][m][n], 0, 0, 0); __builtin_amdgcn_s_setprio(0); } while (0)
#define PG8_WAIT_V(n) asm volatile("s_waitcnt vmcnt(" #n ")" ::: "memory")
#define PG8_WAIT_L(n) asm volatile("s_waitcnt lgkmcnt(" #n ")" ::: "memory")
#define PG8_BAR __builtin_amdgcn_s_barrier()
#define PG8_SCHED __builtin_amdgcn_sched_barrier(0)
    UnitG cur, nxt; int ui = 0;
    if (!S.next(0, cur)) return;
    f32x4 acc[2][2][4][2];
#pragma unroll
    for (int a = 0; a < 2; ++a)
#pragma unroll
        for (int b = 0; b < 2; ++b)
#pragma unroll
            for (int m = 0; m < 4; ++m)
#pragma unroll
                for (int n = 0; n < 2; ++n) acc[a][b][m][n] = (f32x4){0.f, 0.f, 0.f, 0.f};
    bf16x8 At[4][2], B0[2][2], B1[2][2];
    unsigned ca[2][2]; PG8_AOFFS(cur, ca); const char* cB = cur.bbase + (size_t)cur.pn * tstep;
    S.a_ready(cur);
    PG8_STAGE(PG8_SB(0, 0), cB, voffB); PG8_STAGE_A(PG8_SA(0, 0), ca[0], 0); PG8_STAGE(PG8_SB(0, 1), cB + hstep, voffB); PG8_STAGE_A(PG8_SA(0, 1), ca[1], 0);
    if (wr == 1) PG8_BAR;
    PG8_WAIT_V(4); PG8_BAR;
    PG8_STAGE(PG8_SB(1, 0), cB + kstep, voffB); PG8_STAGE_A(PG8_SA(1, 0), ca[0], kstep); PG8_STAGE(PG8_SB(1, 1), cB + hstep + kstep, voffB);
    PG8_WAIT_V(6); PG8_BAR;
    for (;;) {
        const bool has_next = S.next(ui + 1, nxt);
        const char* nB = has_next ? nxt.bbase + (size_t)nxt.pn * tstep : cB;
        for (int t = 0; t < nt; t += 2) {
            const bool last = (t == nt - 2);
            const size_t k1 = (size_t)(t + 1) * kstep, k2 = last ? 0 : (size_t)(t + 2) * kstep;
            unsigned a2o[2][2];
            if (last && has_next) PG8_AOFFS(nxt, a2o); else { a2o[0][0] = ca[0][0]; a2o[0][1] = ca[0][1]; a2o[1][0] = ca[1][0]; a2o[1][1] = ca[1][1]; }
            const char* b2 = last ? nB : cB + (size_t)(t + 2) * kstep; const char* b3 = b2 + kstep;
            if (last && has_next) S.a_ready(nxt);
            PG8_LDB(B0, 0, 0); PG8_SCHED; PG8_LDA(At, 0, 0); PG8_STAGE_A(PG8_SA(1, 1), ca[1], k1);
            PG8_WAIT_L(8); PG8_BAR; PG8_WAIT_L(0); PG8_MMA(0, 0, At, B0); PG8_BAR; PG8_SCHED;
            PG8_LDB(B1, 0, 1); PG8_STAGE(PG8_SB(0, 0), b2, voffB);
            PG8_BAR; PG8_WAIT_L(0); PG8_MMA(0, 1, At, B1); PG8_BAR;
            PG8_LDA(At, 0, 1); PG8_STAGE_A(PG8_SA(0, 0), a2o[0], k2);
            PG8_BAR; PG8_WAIT_L(0); PG8_MMA(1, 0, At, B0); PG8_BAR; PG8_SCHED;
            PG8_STAGE(PG8_SB(0, 1), b2 + hstep, voffB);
            PG8_WAIT_V(6); PG8_BAR; PG8_MMA(1, 1, At, B1); PG8_BAR;
            PG8_LDB(B0, 1, 0); PG8_SCHED; PG8_LDA(At, 1, 0); PG8_STAGE_A(PG8_SA(0, 1), a2o[1], k2);
            PG8_WAIT_L(8); PG8_BAR; PG8_WAIT_L(0); PG8_MMA(0, 0, At, B0); PG8_BAR; PG8_SCHED;
            PG8_LDB(B1, 1, 1); PG8_STAGE(PG8_SB(1, 0), b3, voffB);
            PG8_BAR; PG8_WAIT_L(0); PG8_MMA(0, 1, At, B1); PG8_BAR;
            PG8_LDA(At, 1, 1); PG8_STAGE_A(PG8_SA(1, 0), a2o[0], k2 + kstep);
            PG8_BAR; PG8_WAIT_L(0); PG8_MMA(1, 0, At, B0); PG8_BAR; PG8_SCHED;
            PG8_STAGE(PG8_SB(1, 1), b3 + hstep, voffB);
            PG8_WAIT_V(6); PG8_BAR; PG8_MMA(1, 1, At, B1); PG8_BAR;
            if (last) { ca[0][0] = a2o[0][0]; ca[0][1] = a2o[0][1]; ca[1][0] = a2o[1][0]; ca[1][1] = a2o[1][1]; }
        }
            if constexpr (!Epi::AFTER_DRAIN) { E(acc, cur, wr, wc, fr, fq); S.done(cur); }
            if (!has_next) break;
#pragma unroll
        for (int a = 0; a < 2; ++a)
#pragma unroll
            for (int b = 0; b < 2; ++b)
#pragma unroll
                for (int m = 0; m < 4; ++m)
#pragma unroll
                    for (int n = 0; n < 2; ++n) acc[a][b][m][n] = (f32x4){0.f, 0.f, 0.f, 0.f};
        cur = nxt; cB = nB; ++ui;
    }
    PG8_WAIT_V(0);
    if (wr == 0) PG8_BAR;
    PG8_BAR;
    if constexpr (Epi::AFTER_DRAIN) { E.fused(acc, cur, wr, wc, fr, fq, lds, wid, lane); S.done(cur); }
#undef PG8_SA
#undef PG8_AOFFS
#undef PG8_STAGE_A
#undef PG8_SB
#undef PG8_STAGE
#undef PG8_LDA
#undef PG8_LDB
#undef PG8_MMA
#undef PG8_WAIT_V
#undef PG8_WAIT_L
#undef PG8_BAR
#undef PG8_SCHED
}
}

__device__ __forceinline__ void transpose_item(const float* __restrict__ W, int K, int N, bf16_t* __restrict__ WT, int mode, LAS float* scr, int item, int lane) {
    const int nblk = N / 32, kb = item / nblk, nb = item % nblk, k0 = 64 * kb, n0 = 32 * nb;
    {
        const float* wp = W + (size_t)(k0 + (lane >> 5)) * N + n0 + (lane & 31);
        float t[32];
#pragma unroll
        for (int i = 0; i < 32; ++i) t[i] = wp[(size_t)(2 * i) * N];
#pragma unroll
        for (int i = 0; i < 32; ++i) scr[(2 * i + (lane >> 5)) * 33 + (lane & 31)] = t[i];
    }
    asm volatile("s_waitcnt lgkmcnt(0)" ::: "memory");
    const int c = lane & 7;
#pragma unroll
    for (int j = 0; j < 4; ++j) {
        const int nl = (lane >> 3) + 8 * j; const LAS float* s = scr + (8 * c) * 33 + nl;
        u32x4 o; o.x = pk2(s[0 * 33], s[1 * 33]); o.y = pk2(s[2 * 33], s[3 * 33]); o.z = pk2(s[4 * 33], s[5 * 33]); o.w = pk2(s[6 * 33], s[7 * 33]);
        const int n = n0 + nl;
        const int nd = mode == 0 ? n : (32 * (n >> 4) + (n & 15) + (mode == 2 ? 16 : 0));
        *(u32x4*)(WT + (size_t)nd * K + k0 + 8 * c) = o;
    }
    asm volatile("s_waitcnt lgkmcnt(0)" ::: "memory");
}

constexpr int EXC_IG = 16 * 16, EXC_IDN = 8 * 32, EXC_PER = 2 * EXC_IG + EXC_IDN, EXC_ITEMS = NEXP * EXC_PER;
__device__ __forceinline__ int exc_s0(int layer) { return (layer & 1) ? 8192 : 10240; }
__device__ __forceinline__ int exc_s1(int layer) { return layer == DEPTH - 1 ? 0 : 7168; }
__device__ __forceinline__ void expconv_items(const CAS Params& P, int layer, LAS char* lds, int lo, int hi, int worker, int nworkers, int wid, int lane) {
    LAS float* scr = (LAS float*)(lds + wid * 8448);
    bf16_t* gu = (bf16_t*)(P.ws + WS_EXPGU); bf16_t* dw = (bf16_t*)(P.ws + WS_EXPD);
    for (int it = lo + worker; it < hi; it += nworkers) {
        const int e = it / EXC_PER; int r = it % EXC_PER;
        const size_t eo = (size_t)(layer * NEXP + e);
        if (r < EXC_IG) { transpose_item(P.exp_w_gate + eo * D * DEXP, D, DEXP, gu + (size_t)e * 1024 * 1024, 1, scr, r, lane); continue; } r -= EXC_IG;
        if (r < EXC_IG) { transpose_item(P.exp_w_up + eo * D * DEXP, D, DEXP, gu + (size_t)e * 1024 * 1024, 2, scr, r, lane); continue; } r -= EXC_IG;
        transpose_item(P.exp_w_down + eo * DEXP * D, DEXP, D, dw + (size_t)e * 1024 * 512, 0, scr, r, lane);
    }
}
__device__ __forceinline__ void expconv_tail(int wv, const CAS Params& P, int layer, LAS char* lds, int nwg, int lo, int hi) {
    const int G = gridDim.x, rem = nwg % G;
    if (rem != 0 && (int)blockIdx.x >= rem && lo < hi) {
        const int tid = ltid(wv);
        __syncthreads();
        expconv_items(P, layer, lds, lo, hi, ((int)blockIdx.x - rem) * 8 + (tid >> 6), (G - rem) * 8, tid >> 6, tid & 63);
    }
}

__device__ __forceinline__ void phase_prologue0(int wv, KP Pk, LAS char* lds) {
    asm volatile("" : "+s"(Pk));
    const CAS Params& P = *Pk;
    const int tid = ltid(wv), lane = tid & 63, wid = tid >> 6;
    const int gw = blockIdx.x * 8 + wid, NGW = gridDim.x * 8;
    LAS float* scr = (LAS float*)(lds + wid * 8448);
    bf16_t* winT = (bf16_t*)(P.ws + WS_WINT);
    bf16_t* woutT = (bf16_t*)(P.ws + WS_WOUTT);
    bf16_t* loraT = (bf16_t*)(P.ws + WS_LORAT);
    constexpr int I_EV = 16 * (P_EVEN / 32), I_OD = 16 * (P_ODD / 32), I_O = 16 * 32, I_L64 = 16, I_L128 = 32;
    constexpr int I_LORA = 3 * I_L64 + I_L128;
    constexpr int NIT = 2 * I_EV + 2 * I_OD + 4 * I_O + 2 * I_LORA;
    for (int it = gw; it < NIT; it += NGW) {
        int r = it;
        if (r < 2 * I_EV) { const int i = r / I_EV; transpose_item(P.ev_w_in + (size_t)i * D * P_EVEN, D, P_EVEN, winT + (i ? WINT_L2 : WINT_L0), 0, scr, r % I_EV, lane); continue; } r -= 2 * I_EV;
        if (r < 2 * I_OD) { const int i = r / I_OD; transpose_item(P.od_w_in + (size_t)i * D * P_ODD, D, P_ODD, winT + (i ? WINT_L3 : WINT_L1), 0, scr, r % I_OD, lane); continue; } r -= 2 * I_OD;
        if (r < 4 * I_O) { const int l = r / I_O; const float* src = (l & 1) ? P.od_w_out + (size_t)(l >> 1) * D * D : P.ev_w_out + (size_t)(l >> 1) * D * D;
            transpose_item(src, D, D, woutT + (size_t)l * D * D, 0, scr, r % I_O, lane); continue; } r -= 4 * I_O;
        { const int i = r / I_LORA; int q = r % I_LORA; bf16_t* dst = loraT + (size_t)i * LORA_PER;
          if (q < I_L64) { transpose_item(P.rw_w2 + (size_t)(i * 2 + 0) * 64 * 512, 64, 512, dst, 0, scr, q, lane); continue; } q -= I_L64;
          if (q < I_L64) { transpose_item(P.rw_w2 + (size_t)(i * 2 + 1) * 64 * 512, 64, 512, dst + 512 * 64, 0, scr, q, lane); continue; } q -= I_L64;
          if (q < I_L64) { transpose_item(P.rw_a2 + (size_t)i * 64 * 512, 64, 512, dst + 2 * 512 * 64, 0, scr, q, lane); continue; } q -= I_L64;
          transpose_item(P.rw_g2 + (size_t)i * 128 * 512, 128, 512, dst + 3 * 512 * 64, 0, scr, q, lane); }
    }
    {
        const int gt = blockIdx.x * NT + tid, NG = gridDim.x * NT;
        constexpr int PADE = (LDP_EVEN - P_EVEN) * D / 8, PADO = (LDP_ODD - P_ODD) * D / 8;
        for (int i = gt; i < 2 * PADE + 2 * PADO; i += NG) {
            int r = i; bf16_t* dst;
            if (r < 2 * PADE) { const int l = r / PADE; dst = winT + (l ? WINT_L2 : WINT_L0) + (size_t)P_EVEN * D + (size_t)(r % PADE) * 8; }
            else { r -= 2 * PADE; const int l = r / PADO; dst = winT + (l ? WINT_L3 : WINT_L1) + (size_t)P_ODD * D + (size_t)(r % PADO) * 8; }
            *(u32x4*)dst = (u32x4){0u, 0u, 0u, 0u};
        }
    }
    {
        const int gt = blockIdx.x * NT + tid, NG = gridDim.x * NT;
        float* lb = (float*)(P.ws + WS_LB);
        for (int ch = gt; ch < 512; ch += NG) {
            float lg[4], mx = -1e30f;
#pragma unroll
            for (int l = 0; l < 4; ++l) { lg[l] = P.hg_lb_logits[l * 512 + ch]; mx = fmaxf(mx, lg[l]); }
            float e[4], s = 0.f;
#pragma unroll
            for (int l = 0; l < 4; ++l) { e[l] = __expf(lg[l] - mx); s += e[l]; }
            float cum = 0.f;
#pragma unroll
            for (int l = 0; l < 4; ++l) { if (l > 0) cum += e[l] / s; lb[l * 512 + ch] = cum; }
        }
    }
    __syncthreads();
    {
        LAS float* sc = (LAS float*)lds;
        LAS float* red = (LAS float*)(lds + 5 * 1024 * 4);
        for (int i = tid; i < 5 * D; i += NT) { const int m = i >> 10, k = i & 1023; const float v = m < 4 ? P.c[m * D + k] : P.c_ctx[k]; sc[i] = siluf_(v); }
        __syncthreads();
        float* modv = (float*)(P.ws + WS_MODV);
        for (int cb = blockIdx.x; cb < 4 * 6144 / 96; cb += gridDim.x) {
            const int l = (cb * 96) / 6144, j0 = (cb * 96) % 6144;
            const int cg = tid % 24, kg = tid / 24;
            if (tid < 384) {
                const float* w = P.mod_w + (size_t)l * D * 6144 + (size_t)(kg * 64) * 6144 + j0 + 4 * cg;
                f32x4 a[5];
#pragma unroll
                for (int m = 0; m < 5; ++m) a[m] = (f32x4){0.f, 0.f, 0.f, 0.f};
#pragma unroll 1
                for (int k0 = 0; k0 < 64; k0 += 16) {
                    f32x4 wv4[16];
#pragma unroll
                    for (int u = 0; u < 16; ++u) wv4[u] = *(const f32x4*)(w + (size_t)(k0 + u) * 6144);
#pragma unroll
                    for (int u = 0; u < 16; ++u)
#pragma unroll
                        for (int m = 0; m < 5; ++m) a[m] += wv4[u] * sc[m * 1024 + kg * 64 + k0 + u];
                }
#pragma unroll
                for (int m = 0; m < 5; ++m) *(LAS f32x4*)(red + ((kg * 5 + m) * 96 + 4 * cg)) = a[m];
            }
            __syncthreads();
            if (tid < 480) {
                const int m = tid / 96, c = tid % 96;
                float sum = 0.f;
#pragma unroll
                for (int g = 0; g < 16; ++g) sum += red[(g * 5 + m) * 96 + c];
                modv[(size_t)(l * 5 + m) * 6144 + j0 + c] = sum + P.mod_b[l * 6144 + j0 + c];
            }
            __syncthreads();
        }
    }
}

__device__ __forceinline__ void phase_prologue1(int wv, KP Pk) {
    asm volatile("" : "+s"(Pk));
    const CAS Params& P = *Pk;
    const int tid = ltid(wv), lane = tid & 63, wid = tid >> 6;
    bf16_t* act = (bf16_t*)(P.ws + WS_ACT);
    f32x4 nv[4];
    auto fetch = [&](int rr) {
        const float* src = rr < NCTX ? P.ctx + (size_t)rr * D : P.x + (size_t)(rr - NCTX) * D;
#pragma unroll
        for (int i = 0; i < 4; ++i) nv[i] = *(const f32x4*)(src + 4 * lane + 256 * i);
    };
    const int stride = gridDim.x * 8;
    int r = blockIdx.x * 8 + wid;
    if (r < NROWS) fetch(r);
    for (; r < NROWS; r += stride) {
        const int m = row_mod(r);
        const f32x4 cv[4] = {nv[0], nv[1], nv[2], nv[3]};
        if (r + stride < NROWS) fetch(r + stride);
        const float* sh = modvec(P.ws, 0, m, 0); const float* sc = modvec(P.ws, 0, m, 1);
#pragma unroll
        for (int i = 0; i < 4; ++i) {
            const int c = 4 * lane + 256 * i;
            const f32x4 v = cv[i], s1 = *(const f32x4*)(sc + c), h1 = *(const f32x4*)(sh + c);
            u32x2 o; o.x = pk2(v[0] * (1.f + s1[0]) + h1[0], v[1] * (1.f + s1[1]) + h1[1]); o.y = pk2(v[2] * (1.f + s1[2]) + h1[2], v[3] * (1.f + s1[3]) + h1[3]);
            *(u32x2*)(act + (size_t)r * D + c) = o;
        }
    }
}

__device__ __forceinline__ void phase_inproj(int wv, KP Pk, int layer, LAS char* lds) {
    asm volatile("" : "+s"(Pk));
    const CAS Params& P = *Pk;
    const int odd = layer & 1, ldp = odd ? LDP_ODD : LDP_EVEN;
    const size_t woff = layer == 0 ? WINT_L0 : layer == 1 ? WINT_L1 : layer == 2 ? WINT_L2 : WINT_L3;
    pg8::Gemm g{(const bf16_t*)(P.ws + WS_ACT), (const bf16_t*)(P.ws + WS_WINT) + woff, NROWS, ldp, D};
    pg8::StaticOrder S; S.init(NROWS, ldp, (int)gridDim.x, (int)blockIdx.x);
    pg8::EpiStoreP E{(bf16_t*)(P.ws + WS_P), ldp};
    pg8::gemm_phase(wv, (PG8_LAS unsigned char*)lds, g, S, E);
    expconv_tail(wv, P, layer, lds, (NROWS / 256) * (ldp / 256), 0, exc_s0(layer));
}
__device__ __forceinline__ void phase_outproj(int wv, KP Pk, int layer, LAS char* lds) {
    asm volatile("" : "+s"(Pk));
    const CAS Params& P = *Pk;
    const int r0 = (layer == DEPTH - 1) ? NCTX : 0;
    pg8::Gemm g{(const bf16_t*)(P.ws + WS_FEAT) + (size_t)r0 * D, (const bf16_t*)(P.ws + WS_WOUTT) + (size_t)layer * D * D, NROWS - r0, D, D};
    pg8::StaticOrder S; S.init(NROWS - r0, D, (int)gridDim.x, (int)blockIdx.x);
    pg8::EpiStoreP E{(bf16_t*)(P.ws + WS_YO) + (size_t)r0 * D, D};
    pg8::gemm_phase(wv, (PG8_LAS unsigned char*)lds, g, S, E);
    expconv_tail(wv, P, layer, lds, ((NROWS - r0) / 256) * (D / 256), exc_s0(layer), exc_s0(layer) + exc_s1(layer));
}
__device__ __forceinline__ void phase_prep2(int wv, KP Pk, int layer, LAS char* lds) {
    asm volatile("" : "+s"(Pk));
    const CAS Params& P = *Pk;
    const int i = layer >> 1;
    const bf16_t* la = (const bf16_t*)(P.ws + WS_LA);
    const bf16_t* lt = (const bf16_t*)(P.ws + WS_LORAT) + (size_t)i * LORA_PER;
    constexpr int MT = NROWS / G_BM, NTL = 512 / G_BN;
    const int ntiles = 4 * MT * NTL;
    for (int t = blockIdx.x; t < ntiles; t += gridDim.x) {
        const int which = t / (MT * NTL), r = t % (MT * NTL), mt = r / NTL, nt = r % NTL;
        RowLinear rs{mt * G_BM};
        if (which < 2) {
            EpiDecay epi{(float*)(P.ws + WS_RWDEC) + (size_t)which * NROWS * 512, P.rw_w0 + (size_t)(i * 2 + which) * 512, mt * G_BM, nt * G_BN};
            gemm_tile(wv, la + which * 64, 320, rs, lt + (size_t)which * 512 * 64, 64, nt * G_BN, 64, epi, lds);
        } else if (which == 2) {
            EpiAK epi{(bf16_t*)(P.ws + WS_RWK), (const bf16_t*)(P.ws + WS_RWKK), (bf16_t*)(P.ws + WS_RWB), P.rw_a0 + i * 512, P.rw_k_a + i * 512, mt * G_BM, nt * G_BN};
            gemm_tile(wv, la + 128, 320, rs, lt + (size_t)2 * 512 * 64, 64, nt * G_BN, 64, epi, lds);
        } else {
            EpiStoreBf16 epi{(bf16_t*)(P.ws + WS_RWG), 512, mt * G_BM, nt * G_BN, 512};
            gemm_tile(wv, la + 192, 320, rs, lt + (size_t)3 * 512 * 64, 128, nt * G_BN, 128, epi, lds);
        }
    }
}
__device__ __forceinline__ void moe_tiles(int wv, const unsigned char* ws, int layer, LAS int* tstart, LAS int* tcnt) {
    const int tid = ltid(wv);
    if (tid < 64) {
        const int* cnt = (const int*)(ws + WS_CNT) + layer * 32 * CNT_STRIDE;
        const int c = tid < NEXP ? cnt[tid * CNT_STRIDE] : 0;
        int incl = (c + G_BM - 1) / G_BM;
#pragma unroll
        for (int o = 1; o < 32; o <<= 1) { const int t = __shfl_up(incl, o); if (tid >= o) incl += t; }
        if (tid < NEXP) { tcnt[tid] = c; tstart[tid] = incl - (c + G_BM - 1) / G_BM; }
        if (tid == NEXP - 1) tstart[NEXP] = incl;
    }
    __syncthreads();
}
__device__ __forceinline__ void phase_moe1(int wv, KP Pk, int layer, LAS char* lds) {
    asm volatile("" : "+s"(Pk));
    const CAS Params& P = *Pk;
    LAS int* tstart = (LAS int*)(lds + pg8::STAGE_BYTES); LAS int* tcnt = tstart + 40;
    moe_tiles(wv, P.ws, layer, tstart, tcnt);
    pg8::Gemm g{(const bf16_t*)(P.ws + WS_ACT), (const bf16_t*)(P.ws + WS_EXPGU), 0, 1024, D};
    LAS int* ltabs = tstart + 128;
    pg8::MoeOrder S{tstart, tcnt, ltabs, (const int*)(P.ws + WS_LIST), (const char*)(P.ws + WS_EXPGU), (size_t)1024 * 1024 * 2, 4, 1, (int)gridDim.x, (int)blockIdx.x};
    pg8::EpiSwiGLUG E{(bf16_t*)(P.ws + WS_HID)};
    for (int i = 0; i < 8; ++i) {
        pg8::UnitG u; if (!S.next(i, u)) break;
        const int tl = ltid(wv);
        const int* ul = (const int*)(P.ws + WS_LIST) + (size_t)u.e * LISTCAP + u.pm * pg8::BM;
        if (tl < pg8::BM) ltabs[i * pg8::BM + tl] = ul[tl < u.cnt ? tl : 0];
    }
    __syncthreads();
    pg8::gemm_phase_g(wv, (PG8_LAS unsigned char*)lds, g, S, E);
    __syncthreads();
}
__device__ __forceinline__ void phase_moe2(int wv, KP Pk, int layer, LAS char* lds) {
    asm volatile("" : "+s"(Pk));
    const CAS Params& P = *Pk;
    LAS int* tstart = (LAS int*)(lds + pg8::STAGE_BYTES); LAS int* tcnt = tstart + 40;
    moe_tiles(wv, P.ws, layer, tstart, tcnt);
    pg8::Gemm g{(const bf16_t*)(P.ws + WS_HID), (const bf16_t*)(P.ws + WS_EXPD), 0, 1024, DEXP};
    LAS int* ltabs = tstart + 128;
    pg8::MoeOrder S{tstart, tcnt, ltabs, (const int*)(P.ws + WS_LIST), (const char*)(P.ws + WS_EXPD), (size_t)1024 * 512 * 2, 4, 0, (int)gridDim.x, (int)blockIdx.x};
    pg8::EpiScatterG E{(bf16_t*)(P.ws + WS_YP)};
    for (int i = 0; i < 8; ++i) {
        pg8::UnitG u; if (!S.next(i, u)) break;
        const int tl = ltid(wv);
        const int* ul = (const int*)(P.ws + WS_LIST) + (size_t)u.e * LISTCAP + u.pm * pg8::BM;
        if (tl < pg8::BM) ltabs[i * pg8::BM + tl] = ul[tl < u.cnt ? tl : 0];
    }
    __syncthreads();
    pg8::gemm_phase_g(wv, (PG8_LAS unsigned char*)lds, g, S, E);
    __syncthreads();
}

constexpr int NCHUNK = NSTEPS / TCH;

constexpr int SSD_F = 32 + 64 + 64;
constexpr int SSD_BUF = TCH * SSD_F + 3 * TCH;

constexpr int ML_F = 64 + 64 + 32;
constexpr int ML_BUF = TCH * ML_F + 4 * TCH;

constexpr int HG_F = 128 + 128 + 32;
constexpr int HG_BUF = TCH * HG_F + TCH;

constexpr int RW_F = 5 * 64 + 32;
constexpr int RW_BUF = TCH * RW_F + TCH;
__device__ __forceinline__ void scan_rwkv(int wv, KP Pk, int layer, int unit, LAS char* lds) {
    asm volatile("" : "+s"(Pk));
    const CAS Params& P = *Pk;
    const int tid = ltid(wv);
    const int seq = unit >> 1, half = unit & 1, b = seq >> 4, h = (seq >> 1) & 7, dir = seq & 1;
    LAS float* bufs = (LAS float*)lds;
    bf16_t* Y = (bf16_t*)(P.ws + (dir ? WS_YB : WS_YF));
    const float* dec = (const float*)(P.ws + WS_RWDEC) + (size_t)dir * NROWS * 512;
    int tj[4], tg_[4]; bool tv[4]; const unsigned char* tbase[4]; int tlds[4];
#pragma unroll
    for (int s = 0; s < 4; ++s) {
        const int task = tid + NT * s; tv[s] = task < TCH * 52; tj[s] = task / 52; tg_[s] = task % 52;
        const int g = tg_[s];
        if (g < 8)       { tbase[s] = P.ws + WS_RWR  + (size_t)(h * 64 + 8 * g) * 2;              tlds[s] = 256 + 8 * g; }
        else if (g < 16) { tbase[s] = P.ws + WS_RWK  + (size_t)(h * 64 + 8 * (g - 8)) * 2;        tlds[s] = 192 + 8 * (g - 8); }
        else if (g < 24) { tbase[s] = P.ws + WS_RWKK + (size_t)(h * 64 + 8 * (g - 16)) * 2;       tlds[s] = 64 + 8 * (g - 16); }
        else if (g < 32) { tbase[s] = P.ws + WS_RWB  + (size_t)(h * 64 + 8 * (g - 24)) * 2;       tlds[s] = 128 + 8 * (g - 24); }
        else if (g < 36) { tbase[s] = P.ws + WS_RWV  + (size_t)(h * 64 + half * 32 + 8 * (g - 32)) * 2; tlds[s] = 320 + 8 * (g - 32); }
        else             { tbase[s] = (const unsigned char*)(dec + h * 64 + 4 * (g - 36));        tlds[s] = 4 * (g - 36); }
    }
    u32x4 rc[4]; int rrow = 0;
    auto load = [&](int c) {
#pragma unroll
        for (int s = 0; s < 4; ++s) {
            rc[s] = (u32x4){0u, 0u, 0u, 0u};
            if (tv[s]) { const int row = scan_row(c * TCH + tj[s], b, dir, 1); rc[s] = *(const u32x4*)(tbase[s] + (size_t)row * (tg_[s] < 36 ? 1024 : 2048)); }
        }
        if (tid < TCH) rrow = scan_row(c * TCH + tid, b, dir, 1);
    };
    auto store = [&](int c) {
        LAS float* buf = bufs + (c & 1) * RW_BUF;
#pragma unroll
        for (int s = 0; s < 4; ++s) {
            if (tv[s]) {
                LAS float* dst = buf + tj[s] * RW_F + tlds[s];
                const int g = tg_[s];
                if (g >= 36) { *(LAS u32x4*)dst = rc[s]; }
                else {
                    float f[8]; unpack8(rc[s], f);
                    const float sg = (g >= 16 && g < 24) ? -1.f : 1.f;
                    *(LAS f32x4*)dst = (f32x4){sg * f[0], sg * f[1], sg * f[2], sg * f[3]}; *(LAS f32x4*)(dst + 4) = (f32x4){sg * f[4], sg * f[5], sg * f[6], sg * f[7]};
                }
            }
        }
        if (tid < TCH) ((LAS int*)buf)[TCH * RW_F + tid] = rrow;
    };
    const int vrow = tid >> 4, q = tid & 15;
    f32x2 S01 = {0.f, 0.f}, S23 = {0.f, 0.f};
    LAS float* ypw = bufs + 2 * RW_BUF + (tid >> 6) * (2 * 16 * 68);
    int prow = -1, gpar = 0;
    load(0); store(0); __syncthreads();
    for (int c = 0; c < NCHUNK; ++c) {
        if (c + 1 < NCHUNK) load(c + 1);
        LAS float* buf = bufs + (c & 1) * RW_BUF;
        {
            const LAS float* wp = buf + 4 * q;
            const LAS float* vp = buf + 320 + vrow;
            f32x4 w4 = *(const LAS f32x4*)wp, a4 = *(const LAS f32x4*)(wp + 64), b4 = *(const LAS f32x4*)(wp + 128), k4 = *(const LAS f32x4*)(wp + 192), r4 = *(const LAS f32x4*)(wp + 256); float vr = vp[0];
#pragma unroll 1
            for (int jh = 0; jh < 2; ++jh) {
                const LAS float* rp = ypw + (gpar ^ 1) * (16 * 68) + q * 68 + ((tid >> 4) & 3) * 16;
                const f32x4 p0 = *(const LAS f32x4*)rp, p1 = *(const LAS f32x4*)(rp + 4), p2 = *(const LAS f32x4*)(rp + 8), p3 = *(const LAS f32x4*)(rp + 12);
                LAS float* wpz = ypw + gpar * (16 * 68) + (tid & 63);
#pragma unroll
                for (int j = 0; j < 16; ++j) {
                    const int jj = jh * 16 + j;
                    const f32x4 wc = w4, ac = a4, bc = b4, kc = k4, rc = r4; const float vv = vr;
                    if (j < 15 || jh == 0) {
                        const LAS float* np = wp + (jj + 1) * RW_F;
                        w4 = *(const LAS f32x4*)np; a4 = *(const LAS f32x4*)(np + 64); b4 = *(const LAS f32x4*)(np + 128); k4 = *(const LAS f32x4*)(np + 192); r4 = *(const LAS f32x4*)(np + 256); vr = vp[(jj + 1) * RW_F];
                    }
                    const f32x2 a01 = {ac[0], ac[1]}, a23 = {ac[2], ac[3]}, w01 = {wc[0], wc[1]}, w23 = {wc[2], wc[3]}, b01 = {bc[0], bc[1]}, b23 = {bc[2], bc[3]};
                    const f32x2 k01 = {kc[0], kc[1]}, k23 = {kc[2], kc[3]}, r01 = {rc[0], rc[1]}, r23 = {rc[2], rc[3]}, vv2 = {vv, vv};
                    f32x2 t = S01 * a01; t = S23 * a23 + t;
                    const f32x2 u01 = S01 * w01 + vv2 * k01, u23 = S23 * w23 + vv2 * k23;
                    const float sa = allreduce16(t.x + t.y);
                    const f32x2 sa2 = {sa, sa};
                    S01 = sa2 * b01 + u01; S23 = sa2 * b23 + u23;
                    f32x2 yv = S01 * r01; yv = S23 * r23 + yv;
                    wpz[j * 68] = yv.x + yv.y;
                }
                if (prow >= 0) {
                    const f32x4 t = (p0 + p1) + (p2 + p3);
                    Y[(size_t)prow * D + 512 + h * 64 + half * 32 + vrow] = f2bf((t[0] + t[1]) + (t[2] + t[3]));
                }
                prow = ((const LAS int*)buf)[TCH * RW_F + jh * 16 + q];
                gpar ^= 1;
            }
        }
        if (c + 1 < NCHUNK) store(c + 1);
        __syncthreads();
    }
    {
        const LAS float* rp = ypw + (gpar ^ 1) * (16 * 68) + q * 68 + ((tid >> 4) & 3) * 16;
        const f32x4 t = (*(const LAS f32x4*)rp + *(const LAS f32x4*)(rp + 4)) + (*(const LAS f32x4*)(rp + 8) + *(const LAS f32x4*)(rp + 12));
        Y[(size_t)prow * D + 512 + h * 64 + half * 32 + vrow] = f2bf((t[0] + t[1]) + (t[2] + t[3]));
    }
}

constexpr size_t WS_EXBC = WS_RWR;
constexpr size_t WS_EQK = WS_EXBC + (size_t)NROWS * 768 * 2;
constexpr size_t WS_EGT = WS_EQK + (size_t)NROWS * 512 * 2;
static_assert(WS_EGT + (size_t)NROWS * 32 * 4 <= WS_LA, "even-layer prepare buffers must fit in the RWKV region");

__device__ __forceinline__ void phase_prep_even(int wv, KP Pk, int layer) {
    asm volatile("" : "+s"(Pk));
    const CAS Params& P = *Pk;
    const int tid = ltid(wv), lane = tid & 63, wid = tid >> 6, i_ = layer >> 1;
    const bf16_t* Pb = (const bf16_t*)(P.ws + WS_P);
    bf16_t* XBC = (bf16_t*)(P.ws + WS_EXBC); bf16_t* QK = (bf16_t*)(P.ws + WS_EQK); float* GT = (float*)(P.ws + WS_EGT);
    float cw0[4][8], cw1[4][8], cwq[4][8];
#pragma unroll
    for (int e = 0; e < 8; ++e) {
#pragma unroll
        for (int t = 0; t < 3; ++t) {
            cw0[t][e] = P.ssd_conv_w[(size_t)(i_ * 3 + t) * 768 + 8 * lane + e];
            cw1[t][e] = P.ssd_conv_w[(size_t)(i_ * 3 + t) * 768 + 512 + 8 * (lane & 31) + e];
            cwq[t][e] = P.ml_conv_w[(size_t)(i_ * 3 + t) * 512 + 8 * lane + e];
        }
        cw0[3][e] = P.ssd_conv_b[i_ * 768 + 8 * lane + e]; cw1[3][e] = P.ssd_conv_b[i_ * 768 + 512 + 8 * (lane & 31) + e]; cwq[3][e] = P.ml_conv_b[i_ * 512 + 8 * lane + e];
    }
    float gbias = 0.f;
    if (lane < 16) gbias = P.ssd_dt_bias[i_ * 16 + lane]; else if (lane < 24) gbias = P.ml_i_bias[i_ * 8 + lane - 16]; else if (lane < 32) gbias = P.ml_f_bias[i_ * 8 + lane - 24];
    const float qscl = lane < 32 ? 0.125f : 1.f;
    const u32x4 zero = (u32x4){0u, 0u, 0u, 0u};
    u32x4 nA[3], nB[3], nC[3]; bf16_t ng = 0;
    auto fetch = [&](int rr) {
        int t, len; row_seg(rr, t, len);
        const bf16_t* pr = Pb + (size_t)rr * LDP_EVEN;
        const bool hp = t > 0, hn = t < len - 1;
        { const int col = 512 + 8 * lane; nA[0] = *(const u32x4*)(pr + col); nA[1] = hp ? *(const u32x4*)(pr - LDP_EVEN + col) : zero; nA[2] = hn ? *(const u32x4*)(pr + LDP_EVEN + col) : zero; }
        if (lane < 32) { const int col = 1024 + 8 * lane; nB[0] = *(const u32x4*)(pr + col); nB[1] = hp ? *(const u32x4*)(pr - LDP_EVEN + col) : zero; nB[2] = hn ? *(const u32x4*)(pr + LDP_EVEN + col) : zero; }
        { const int col = 1296 + 8 * lane; nC[0] = *(const u32x4*)(pr + col); nC[1] = hp ? *(const u32x4*)(pr - LDP_EVEN + col) : zero; nC[2] = hn ? *(const u32x4*)(pr + LDP_EVEN + col) : zero; }
        if (lane < 32) ng = pr[lane < 16 ? 1280 + lane : 2832 + (lane - 16)];
    };
    nB[0] = nB[1] = nB[2] = zero;
    const int stride = gridDim.x * 8;
    int r = blockIdx.x * 8 + wid;
    if (r < NROWS) fetch(r);
    for (; r < NROWS; r += stride) {
        const u32x4 cA0 = nA[0], cA1 = nA[1], cA2 = nA[2], cB0 = nB[0], cB1 = nB[1], cB2 = nB[2], cC0 = nC[0], cC1 = nC[1], cC2 = nC[2]; const bf16_t cg = ng;
        if (r + stride < NROWS) fetch(r + stride);
        float fc[8], fp[8], fn[8], o[8];
        {
            unpack8(cA0, fc); unpack8(cA1, fp); unpack8(cA2, fn);
#pragma unroll
            for (int e = 0; e < 8; ++e) o[e] = siluf_(cw0[0][e] * fp[e] + cw0[1][e] * fc[e] + cw0[2][e] * fn[e] + cw0[3][e]);
            *(u32x4*)(XBC + (size_t)r * 768 + 8 * lane) = pack8(o);
        }
        if (lane < 32) {
            unpack8(cB0, fc); unpack8(cB1, fp); unpack8(cB2, fn);
#pragma unroll
            for (int e = 0; e < 8; ++e) o[e] = siluf_(cw1[0][e] * fp[e] + cw1[1][e] * fc[e] + cw1[2][e] * fn[e] + cw1[3][e]);
            *(u32x4*)(XBC + (size_t)r * 768 + 512 + 8 * lane) = pack8(o);
        }
        {
            unpack8(cC0, fc); unpack8(cC1, fp); unpack8(cC2, fn);
#pragma unroll
            for (int e = 0; e < 8; ++e) o[e] = qscl * siluf_(cwq[0][e] * fp[e] + cwq[1][e] * fc[e] + cwq[2][e] * fn[e] + cwq[3][e]);
            *(u32x4*)(QK + (size_t)r * 512 + 8 * lane) = pack8(o);
        }
        if (lane < 32) {
            const float x = bf2f(cg) + gbias;
            GT[(size_t)r * 32 + lane] = lane < 16 ? softplusf_(x) : lane < 24 ? x : logsigmoidf_(x);
        }
    }
}

constexpr int CL = 64, NCH64 = NSTEPS / CL, LDT = 72, LDTB = LDT * 2;
__device__ __forceinline__ bf16x8 ldfrag(const LAS char* tile, int ldb, int row0, int k0, int lane) {
    return *(const LAS bf16x8*)(tile + (row0 + (lane & 15)) * ldb + (k0 + 8 * (lane >> 4)) * 2);
}
constexpr int LDTS = 160;
__device__ __forceinline__ int swz_off(int row, int byteoff) { return row * LDTS + (byteoff ^ (((row >> 3) & 7) << 4)); }
__device__ __forceinline__ bf16x8 ldfrag_sw(const LAS char* tile, int row0, int k0, int lane) {
    const int row = row0 + (lane & 15);
    return *(const LAS bf16x8*)(tile + swz_off(row, (k0 + 8 * (lane >> 4)) * 2));
}
__device__ __forceinline__ void st4bf(LAS char* p, const f32x4& v) { u32x2 o; o.x = pk2(v[0], v[1]); o.y = pk2(v[2], v[3]); *(LAS u32x2*)p = o; }

constexpr int SS_BT = 0, SS_CT = SS_BT + 64 * LDTB, SS_BDT = SS_CT + 64 * LDTB, SS_XT = SS_BDT + 64 * LDTB, SS_CUM = SS_XT + 32 * LDTB, SS_DTV = SS_CUM + 256, SS_ROWS = SS_DTV + 256, SS_STG = SS_ROWS + 256;
constexpr int SS_M = 2 * SS_STG, SS_HB = SS_M + 64 * LDTB, SS_END = SS_HB + 32 * LDTB;
static_assert(SS_END <= LDS_BYTES - 16, "SSD LDS map");

constexpr int MS_QT = 0, MS_KT = MS_QT + 64 * LDTB, MS_KET = MS_KT + 64 * LDTB, MS_VT = MS_KET + 64 * LDTB, MS_SC = MS_VT + 32 * LDTB;
constexpr int MS_STG = MS_SC + 8 * 256;
constexpr int MS_W = 2 * MS_STG, MS_CB = MS_W + 64 * LDTB, MS_ONE = MS_CB + 32 * LDTB, MS_NV = MS_ONE + 16 * LDTB, MS_QN = MS_NV + 256, MS_END = MS_QN + 256;
static_assert(MS_END <= LDS_BYTES - 16, "mLSTM LDS map");

constexpr size_t WS_XSS = WS_EGT + al256((size_t)NROWS * 32 * 4);
constexpr size_t XSS_BYTES = (size_t)64 * NCH64 * 64 * 64 * 2;
constexpr size_t WS_XSD = WS_XSS + XSS_BYTES;
constexpr size_t WS_XMC = WS_XSD + al256((size_t)64 * NCH64 * 4);
constexpr size_t XMC_BYTES = (size_t)32 * NCH64 * 128 * 64 * 2;
constexpr size_t WS_XMN = WS_XMC + XMC_BYTES;
constexpr size_t WS_XMS = WS_XMN + (size_t)32 * NCH64 * 64 * 4;
constexpr size_t WS_XMT = WS_XMS + al256((size_t)32 * NCH64 * 4 * 4);
constexpr size_t WS_XEND = WS_XMT + (size_t)32 * NCH64 * 3 * 64 * 4;
static_assert(WS_XEND <= WS_END, "even-layer chunk-state buffers must fit in the RWKV region");
constexpr int NSSD_ITEMS = 64 * NCH64, NML_ITEMS = 32 * NCH64;

template <int CTRL, int RM, int BM> __device__ __forceinline__ float dppx(float old, float v) {
    return __builtin_bit_cast(float, __builtin_amdgcn_update_dpp(__builtin_bit_cast(int, old), __builtin_bit_cast(int, v), CTRL, RM, BM, false));
}
__device__ __forceinline__ float wave_cumsum(float v, int) {
    float t = v;
    t += dppx<0x111, 0xf, 0xf>(0.f, v); t += dppx<0x112, 0xf, 0xf>(0.f, v); t += dppx<0x113, 0xf, 0xf>(0.f, v);
    { const float u = dppx<0x114, 0xf, 0xe>(0.f, t); t += u; }
    { const float u = dppx<0x118, 0xf, 0xc>(0.f, t); t += u; }
    { const float u = dppx<0x142, 0xa, 0xf>(0.f, t); t += u; }
    { const float u = dppx<0x143, 0xc, 0xf>(0.f, t); t += u; }
    return t;
}
__device__ __forceinline__ float wave_cummax(float v, int) {
    const float ninf = -__builtin_huge_valf();
    float t = v;
    t = fmaxf(t, dppx<0x111, 0xf, 0xf>(ninf, v)); t = fmaxf(t, dppx<0x112, 0xf, 0xf>(ninf, v)); t = fmaxf(t, dppx<0x113, 0xf, 0xf>(ninf, v));
    { const float u = dppx<0x114, 0xf, 0xe>(ninf, t); t = fmaxf(t, u); }
    { const float u = dppx<0x118, 0xf, 0xc>(ninf, t); t = fmaxf(t, u); }
    { const float u = dppx<0x142, 0xa, 0xf>(ninf, t); t = fmaxf(t, u); }
    { const float u = dppx<0x143, 0xc, 0xf>(ninf, t); t = fmaxf(t, u); }
    return t;
}
__device__ __forceinline__ float wave_max(float v) {
    const float t = wave_cummax(v, 0);
    return __builtin_bit_cast(float, __builtin_amdgcn_readlane(__builtin_bit_cast(int, t), 63));
}

constexpr int X1S_BDT = 0, X1S_XT = X1S_BDT + 64 * LDTS, X1S_CUM = X1S_XT + 64 * LDTS, X1S_DTV = X1S_CUM + 256, X1S_END = X1S_DTV + 256;
constexpr int X1M_KET = 0, X1M_VT = X1M_KET + 64 * LDTS, X1M_ONE = X1M_VT + 128 * LDTS, X1M_EE = X1M_ONE + 16 * LDTB, X1M_END = X1M_EE + 256;
__device__ __forceinline__ void phase_ex1(int wv, KP Pk, int layer, LAS char* lds) {
    asm volatile("" : "+s"(Pk));
    const CAS Params& P = *Pk;
    const int tid = ltid(wv), lane = tid & 63, wid = tid >> 6, q = lane >> 4, r16 = lane & 15, i_ = layer >> 1;
    const bf16_t* XBC = (const bf16_t*)(P.ws + WS_EXBC); const bf16_t* QK = (const bf16_t*)(P.ws + WS_EQK); const bf16_t* Pb = (const bf16_t*)(P.ws + WS_P);
    const float* GT = (const float*)(P.ws + WS_EGT);
    {
        bf16_t* Hst = (bf16_t*)(P.ws + WS_XSS); float* Dst = (float*)(P.ws + WS_XSD);
        u32x4 rc[2]; float rdt = 0.f;
        auto geom = [&](int it, int& b, int& h, int& dir, int& c) { const int sq = it / NCH64; c = it - sq * NCH64; b = sq >> 4; h = (sq >> 1) & 7; dir = sq & 1; };
        auto load = [&](int it) {
            int b, h, dir, c; geom(it, b, h, dir, c);
            int tl = tid; asm volatile("" : "+v"(tl));
#pragma unroll
            for (int s = 0; s < 2; ++s) {
                const int task = tl + NT * s, j = task >> 4, g = task & 15;
                const int row = scan_row(c * CL + j, b, dir, 0);
                rc[s] = *(const u32x4*)(XBC + (size_t)row * 768 + (g < 8 ? h * 64 + 8 * g : 512 + (h >> 2) * 64 + 8 * (g - 8)));
            }
            if (tl < CL) { const int row = scan_row(c * CL + tl, b, dir, 0); rdt = GT[(size_t)row * 32 + dir * 8 + h]; }
        };
        int it = blockIdx.x;
        if (it < NSSD_ITEMS) load(it);
        for (; it < NSSD_ITEMS; it += gridDim.x) {
            int b, h, dir, c; geom(it, b, h, dir, c);
            const float aco = -__expf(P.ssd_a_log[(i_ * 2 + dir) * 8 + h]);
            if (tid < CL) {
                const float cum = wave_cumsum(rdt * aco, lane);
                ((LAS float*)(lds + X1S_CUM))[tid] = cum; ((LAS float*)(lds + X1S_DTV))[tid] = rdt;
            }
            __syncthreads();
            {
                const LAS float* cum = (const LAS float*)(lds + X1S_CUM);
                const float cumL = cum[CL - 1];
                int tl = tid; asm volatile("" : "+v"(tl));
#pragma unroll
                for (int s = 0; s < 2; ++s) {
                    const int task = tl + NT * s, j = task >> 4, g = task & 15;
                    float f[8]; unpack8(rc[s], f);
                    if (g < 8) {
                        const float dt = ((const LAS float*)(lds + X1S_DTV))[j];
#pragma unroll
                        for (int e = 0; e < 8; ++e) *(LAS bf16_t*)(lds + X1S_XT + swz_off(8 * g + e, j * 2)) = f2bf(f[e] * dt);
                    } else {
                        const float sc = __expf(cumL - cum[j]);
#pragma unroll
                        for (int e = 0; e < 8; ++e) *(LAS bf16_t*)(lds + X1S_BDT + swz_off(8 * (g - 8) + e, j * 2)) = f2bf(f[e] * sc);
                    }
                }
                if (tid == 0) Dst[it] = __expf(cumL);
            }
            if (it + (int)gridDim.x < NSSD_ITEMS) load(it + gridDim.x);
            __syncthreads();
            {
                const int pt = wid >> 1;
#pragma unroll
                for (int u = 0; u < 2; ++u) {
                    const int nt = (wid & 1) * 2 + u;
                    f32x4 sa = (f32x4){0.f, 0.f, 0.f, 0.f};
#pragma unroll
                    for (int k0 = 0; k0 < 64; k0 += 32) sa = __builtin_amdgcn_mfma_f32_16x16x32_bf16(ldfrag_sw(lds + X1S_BDT, nt * 16, k0, lane), ldfrag_sw(lds + X1S_XT, pt * 16, k0, lane), sa, 0, 0, 0);
                    u32x2 o; o.x = pk2(sa[0], sa[1]); o.y = pk2(sa[2], sa[3]);
                    *(u32x2*)(Hst + ((size_t)it * 64 + pt * 16 + r16) * 64 + nt * 16 + 4 * q) = o;
                }
            }
            __syncthreads();
        }
    }
    {
        bf16_t* Cst = (bf16_t*)(P.ws + WS_XMC); float* Nst = (float*)(P.ws + WS_XMN); float* Sst = (float*)(P.ws + WS_XMS); float* Tst = (float*)(P.ws + WS_XMT);
        for (int i = tid; i < 16 * LDTB / 4; i += NT) ((LAS unsigned*)(lds + X1M_ONE))[i] = 0x3f803f80u;
        u32x4 rc[3]; float rli = 0.f, rlf = 0.f;
        auto geom = [&](int it, int& b, int& h, int& dir, int& c) { const int sq = it / NCH64; c = it - sq * NCH64; b = sq >> 3; h = (sq >> 1) & 3; dir = sq & 1; };
        auto load = [&](int it) {
            int b, h, dir, c; geom(it, b, h, dir, c);
            int tl = tid; asm volatile("" : "+v"(tl));
#pragma unroll
            for (int s = 0; s < 3; ++s) {
                const int task = tl + NT * s, j = task / 24, g = task - 24 * j;
                const int row = scan_row(c * CL + j, b, dir, 0);
                rc[s] = g < 8 ? *(const u32x4*)(QK + (size_t)row * 512 + 256 + h * 64 + 8 * g) : *(const u32x4*)(Pb + (size_t)row * LDP_EVEN + 1808 + h * 128 + 8 * (g - 8));
            }
            if (tl < CL) { const int row = scan_row(c * CL + tl, b, dir, 0); rli = GT[(size_t)row * 32 + 16 + dir * 4 + h]; rlf = GT[(size_t)row * 32 + 24 + dir * 4 + h]; }
        };
        int it = blockIdx.x;
        if (it < NML_ITEMS) load(it);
        __syncthreads();
        for (; it < NML_ITEMS; it += gridDim.x) {
            if (tid < CL) {
                const float fcum = wave_cumsum(rlf, lane);
                const float ftot = __builtin_bit_cast(float, __builtin_amdgcn_readlane(__builtin_bit_cast(int, fcum), 63));
                const float g = rli - fcum, pm = wave_cummax(g, lane);
                const float wend = ftot + g, mloc = wave_max(wend);
                ((LAS float*)(lds + X1M_EE))[tid] = __expf(wend - mloc);
                float* tp = Tst + (size_t)it * 192;
                tp[tid] = fcum; tp[64 + tid] = g; tp[128 + tid] = pm;
                if (tid == 0) { Sst[(size_t)it * 4 + 0] = ftot; Sst[(size_t)it * 4 + 1] = mloc; }
            }
            __syncthreads();
            {
                const LAS float* ee = (const LAS float*)(lds + X1M_EE);
                int tl = tid; asm volatile("" : "+v"(tl));
#pragma unroll
                for (int s = 0; s < 3; ++s) {
                    const int task = tl + NT * s, j = task / 24, g = task - 24 * j;
                    if (g < 8) {
                        float f[8]; unpack8(rc[s], f);
                        const float e1 = ee[j];
#pragma unroll
                        for (int e = 0; e < 8; ++e) *(LAS bf16_t*)(lds + X1M_KET + swz_off(8 * g + e, j * 2)) = f2bf(f[e] * e1);
                    } else {
                        const int v0 = 8 * (g - 8);
#pragma unroll
                        for (int e = 0; e < 8; ++e) { const unsigned wv = rc[s][e >> 1]; *(LAS bf16_t*)(lds + X1M_VT + swz_off(v0 + e, j * 2)) = (bf16_t)((e & 1) ? (wv >> 16) : (wv & 0xffffu)); }
                    }
                }
            }
            if (it + (int)gridDim.x < NML_ITEMS) load(it + gridDim.x);
            __syncthreads();
            {
                const bf16x8 vf0 = ldfrag_sw(lds + X1M_VT, wid * 16, 0, lane), vf1 = ldfrag_sw(lds + X1M_VT, wid * 16, 32, lane);
#pragma unroll
                for (int kt = 0; kt < 4; ++kt) {
                    f32x4 sa = __builtin_amdgcn_mfma_f32_16x16x32_bf16(ldfrag_sw(lds + X1M_KET, kt * 16, 0, lane), vf0, (f32x4){0.f, 0.f, 0.f, 0.f}, 0, 0, 0);
                    sa = __builtin_amdgcn_mfma_f32_16x16x32_bf16(ldfrag_sw(lds + X1M_KET, kt * 16, 32, lane), vf1, sa, 0, 0, 0);
                    u32x2 o; o.x = pk2(sa[0], sa[1]); o.y = pk2(sa[2], sa[3]);
                    *(u32x2*)(Cst + ((size_t)it * 128 + wid * 16 + r16) * 64 + kt * 16 + 4 * q) = o;
                }
                if (wid < 4) {
                    f32x4 na = __builtin_amdgcn_mfma_f32_16x16x32_bf16(ldfrag_sw(lds + X1M_KET, wid * 16, 0, lane), ldfrag(lds + X1M_ONE, LDTB, 0, 0, lane), (f32x4){0.f, 0.f, 0.f, 0.f}, 0, 0, 0);
                    na = __builtin_amdgcn_mfma_f32_16x16x32_bf16(ldfrag_sw(lds + X1M_KET, wid * 16, 32, lane), ldfrag(lds + X1M_ONE, LDTB, 0, 32, lane), na, 0, 0, 0);
                    if (r16 == 0) *(f32x4*)(Nst + (size_t)it * 64 + wid * 16 + 4 * q) = na;
                }
            }
            __syncthreads();
        }
    }
}

constexpr int EX2_UB = 12;
static_assert(NCH64 % EX2_UB == 0, "EX2 batches");
__device__ __forceinline__ void phase_ex2(int wv, KP Pk, int layer) {
    asm volatile("" : "+s"(Pk));
    const CAS Params& P = *Pk;
    const int tid = ltid(wv);
    (void)layer;
    if (blockIdx.x < 128) {
        const int gt = blockIdx.x * NT + tid, sq = gt >> 10, rem = gt & 1023;
        bf16_t* Hst = (bf16_t*)(P.ws + WS_XSS) + (size_t)sq * NCH64 * 4096 + rem * 4;
        const float* Dst = (const float*)(P.ws + WS_XSD) + sq * NCH64;
        float h0 = 0.f, h1 = 0.f, h2 = 0.f, h3 = 0.f;
#pragma unroll 1
        for (int c0 = 0; c0 < NCH64; c0 += EX2_UB) {
            u32x2 loc[EX2_UB]; float dd[EX2_UB];
            bf16_t* hp = Hst + (size_t)c0 * 4096;
#pragma unroll
            for (int u = 0; u < EX2_UB; ++u) { loc[u] = *(const u32x2*)(hp + (size_t)u * 4096); dd[u] = Dst[c0 + u]; }
#pragma unroll
            for (int u = 0; u < EX2_UB; ++u) {
                u32x2 o; o.x = pk2(h0, h1); o.y = pk2(h2, h3);
                *(u32x2*)(hp + (size_t)u * 4096) = o;
                const float d = dd[u];
                h0 = d * h0 + bflo(loc[u].x); h1 = d * h1 + bfhi(loc[u].x); h2 = d * h2 + bflo(loc[u].y); h3 = d * h3 + bfhi(loc[u].y);
            }
        }
    } else if (blockIdx.x < 256) {
        const int gt = (blockIdx.x - 128) * NT + tid, sq = gt >> 11, rem = gt & 2047;
        bf16_t* Cst = (bf16_t*)(P.ws + WS_XMC) + (size_t)sq * NCH64 * 8192 + rem * 4;
        float* Nst = (float*)(P.ws + WS_XMN) + (size_t)sq * NCH64 * 64 + (rem & 15) * 4;
        float* Sst = (float*)(P.ws + WS_XMS) + (size_t)sq * NCH64 * 4;
        const bool own_n = rem < 16, own_m = rem == 0;
        float c0_ = 0.f, c1 = 0.f, c2 = 0.f, c3 = 0.f, m = -1e30f;
        f32x4 nn = (f32x4){0.f, 0.f, 0.f, 0.f};
#pragma unroll 1
        for (int cb = 0; cb < NCH64; cb += EX2_UB) {
            u32x2 loc[EX2_UB]; float ft[EX2_UB], ml[EX2_UB]; f32x4 nl[EX2_UB];
            bf16_t* cp = Cst + (size_t)cb * 8192; float* np = Nst + (size_t)cb * 64; float* sp_ = Sst + cb * 4;
#pragma unroll
            for (int u = 0; u < EX2_UB; ++u) {
                loc[u] = *(const u32x2*)(cp + (size_t)u * 8192); ft[u] = sp_[u * 4 + 0]; ml[u] = sp_[u * 4 + 1];
                nl[u] = (f32x4){0.f, 0.f, 0.f, 0.f};
                if (own_n) nl[u] = *(const f32x4*)(np + (size_t)u * 64);
            }
#pragma unroll
            for (int u = 0; u < EX2_UB; ++u) {
                const float ftot = ft[u], mloc = ml[u];
                const float mnew = fmaxf(ftot + m, mloc), sp = __expf(ftot + m - mnew), sl = __expf(mloc - mnew);
                u32x2 o; o.x = pk2(c0_, c1); o.y = pk2(c2, c3);
                *(u32x2*)(cp + (size_t)u * 8192) = o;
                c0_ = sp * c0_ + sl * bflo(loc[u].x); c1 = sp * c1 + sl * bfhi(loc[u].x); c2 = sp * c2 + sl * bflo(loc[u].y); c3 = sp * c3 + sl * bfhi(loc[u].y);
                if (own_n) { *(f32x4*)(np + (size_t)u * 64) = nn; nn = nn * sp + nl[u] * sl; }
                if (own_m) sp_[u * 4 + 2] = m;
                m = mnew;
            }
        }
    }
}

constexpr int X3S_BT = 0, X3S_CT = X3S_BT + 64 * LDTB, X3S_XT = X3S_CT + 64 * LDTB, X3S_HB = X3S_XT + 64 * LDTS, X3S_M = X3S_HB + 64 * LDTB, X3S_CUM = X3S_M + 64 * LDTB, X3S_DTV = X3S_CUM + 256, X3S_ROWS = X3S_DTV + 256, X3S_END = X3S_ROWS + 256;
constexpr int X3M_QT = 0, X3M_KT = X3M_QT + 64 * LDTB, X3M_VT = X3M_KT + 64 * LDTB, X3M_CB = X3M_VT + 128 * LDTS, X3M_W = X3M_CB + 128 * LDTB, X3M_ONE = X3M_W + 64 * LDTB, X3M_NB = X3M_ONE + 16 * LDTB,
              X3M_SC = X3M_NB + 16 * LDTB, X3M_END = X3M_SC + 6 * 256;
static_assert(X3M_END <= LDS_BYTES - 16 && X3S_END <= LDS_BYTES - 16, "EX3 LDS maps");
__device__ __forceinline__ void phase_ex3(int wv, KP Pk, int layer, LAS char* lds) {
    asm volatile("" : "+s"(Pk));
    const CAS Params& P = *Pk;
    const int tid = ltid(wv), lane = tid & 63, wid = tid >> 6, q = lane >> 4, r16 = lane & 15, i_ = layer >> 1;
    const bf16_t* XBC = (const bf16_t*)(P.ws + WS_EXBC); const bf16_t* QK = (const bf16_t*)(P.ws + WS_EQK); const bf16_t* Pb = (const bf16_t*)(P.ws + WS_P);
    const float* GT = (const float*)(P.ws + WS_EGT);
    {
        const bf16_t* Hst = (const bf16_t*)(P.ws + WS_XSS);
        u32x4 rc[3], rh; float rdt = 0.f; int rrow = 0;
        auto geom = [&](int it, int& b, int& h, int& dir, int& c) { const int sq = it / NCH64; c = it - sq * NCH64; b = sq >> 4; h = (sq >> 1) & 7; dir = sq & 1; };
        auto load = [&](int it) {
            int b, h, dir, c; geom(it, b, h, dir, c);
            int tl = tid; asm volatile("" : "+v"(tl));
#pragma unroll
            for (int s = 0; s < 3; ++s) {
                const int task = tl + NT * s, j = task / 24, g = task - 24 * j;
                const int row = scan_row(c * CL + j, b, dir, 0);
                rc[s] = *(const u32x4*)(XBC + (size_t)row * 768 + (g < 8 ? h * 64 + 8 * g : g < 16 ? 512 + (h >> 2) * 64 + 8 * (g - 8) : 640 + (h >> 2) * 64 + 8 * (g - 16)));
            }
            rh = *(const u32x4*)(Hst + (size_t)it * 4096 + tl * 8);
            if (tl < CL) { rrow = scan_row(c * CL + tl, b, dir, 0); rdt = GT[(size_t)rrow * 32 + dir * 8 + h]; }
        };
        int it = blockIdx.x;
        if (it < NSSD_ITEMS) load(it);
        __syncthreads();
        for (; it < NSSD_ITEMS; it += gridDim.x) {
            int b, h, dir, c; geom(it, b, h, dir, c);
            bf16_t* Y = (bf16_t*)(P.ws + (dir ? WS_YB : WS_YF));
            const float aco = -__expf(P.ssd_a_log[(i_ * 2 + dir) * 8 + h]);
            if (tid < CL) {
                const float cum = wave_cumsum(rdt * aco, lane);
                ((LAS float*)(lds + X3S_CUM))[tid] = cum; ((LAS float*)(lds + X3S_DTV))[tid] = rdt; ((LAS int*)(lds + X3S_ROWS))[tid] = rrow;
            }
            __syncthreads();
            {
                int tl = tid; asm volatile("" : "+v"(tl));
#pragma unroll
                for (int s = 0; s < 3; ++s) {
                    const int task = tl + NT * s, j = task / 24, g = task - 24 * j;
                    if (g < 8) {
                        float f[8]; unpack8(rc[s], f);
                        const float dt = ((const LAS float*)(lds + X3S_DTV))[j];
#pragma unroll
                        for (int e = 0; e < 8; ++e) *(LAS bf16_t*)(lds + X3S_XT + swz_off(8 * g + e, j * 2)) = f2bf(f[e] * dt);
                    } else if (g < 16) *(LAS u32x4*)(lds + X3S_BT + j * LDTB + 8 * (g - 8) * 2) = rc[s];
                    else *(LAS u32x4*)(lds + X3S_CT + j * LDTB + 8 * (g - 16) * 2) = rc[s];
                }
                *(LAS u32x4*)(lds + X3S_HB + (tl >> 3) * LDTB + (tl & 7) * 16) = rh;
            }
            if (it + (int)gridDim.x < NSSD_ITEMS) load(it + gridDim.x);
            __syncthreads();
            const LAS float* cum = (const LAS float*)(lds + X3S_CUM);
            {
                const int lt = wid >> 1;
#pragma unroll
                for (int u = 0; u < 2; ++u) {
                    const int st = (wid & 1) * 2 + u;
                    f32x4 acc = (f32x4){0.f, 0.f, 0.f, 0.f};
                    if (st <= lt) {
#pragma unroll
                        for (int k0 = 0; k0 < 64; k0 += 32) acc = __builtin_amdgcn_mfma_f32_16x16x32_bf16(ldfrag(lds + X3S_BT, LDTB, st * 16, k0, lane), ldfrag(lds + X3S_CT, LDTB, lt * 16, k0, lane), acc, 0, 0, 0);
                        const int l = lt * 16 + r16, s0 = st * 16 + 4 * q;
                        const float cl = cum[l]; const f32x4 cs = *(const LAS f32x4*)(cum + s0);
#pragma unroll
                        for (int j = 0; j < 4; ++j) acc[j] = (s0 + j <= l) ? acc[j] * __expf(cl - cs[j]) : 0.f;
                    }
                    st4bf(lds + X3S_M + (lt * 16 + r16) * LDTB + (st * 16 + 4 * q) * 2, acc);
                }
            }
            __syncthreads();
            {
                const int lt = wid >> 1, l = lt * 16 + r16;
                const float el = __expf(cum[l]);
                const int row = ((const LAS int*)(lds + X3S_ROWS))[l];
                const bf16x8 mf0 = ldfrag(lds + X3S_M, LDTB, lt * 16, 0, lane), mf1 = ldfrag(lds + X3S_M, LDTB, lt * 16, 32, lane);
                const bf16x8 cf0 = ldfrag(lds + X3S_CT, LDTB, lt * 16, 0, lane), cf1 = ldfrag(lds + X3S_CT, LDTB, lt * 16, 32, lane);
#pragma unroll
                for (int u = 0; u < 2; ++u) {
                    const int pt = (wid & 1) * 2 + u;
                    f32x4 ya = __builtin_amdgcn_mfma_f32_16x16x32_bf16(ldfrag_sw(lds + X3S_XT, pt * 16, 0, lane), mf0, (f32x4){0.f, 0.f, 0.f, 0.f}, 0, 0, 0);
                    ya = __builtin_amdgcn_mfma_f32_16x16x32_bf16(ldfrag_sw(lds + X3S_XT, pt * 16, 32, lane), mf1, ya, 0, 0, 0);
                    f32x4 oa = __builtin_amdgcn_mfma_f32_16x16x32_bf16(ldfrag(lds + X3S_HB, LDTB, pt * 16, 0, lane), cf0, (f32x4){0.f, 0.f, 0.f, 0.f}, 0, 0, 0);
                    oa = __builtin_amdgcn_mfma_f32_16x16x32_bf16(ldfrag(lds + X3S_HB, LDTB, pt * 16, 32, lane), cf1, oa, 0, 0, 0);
                    u32x2 o; o.x = pk2(ya[0] + el * oa[0], ya[1] + el * oa[1]); o.y = pk2(ya[2] + el * oa[2], ya[3] + el * oa[3]);
                    *(u32x2*)(Y + (size_t)row * D + h * 64 + pt * 16 + 4 * q) = o;
                }
            }
            __syncthreads();
        }
    }
    {
        const bf16_t* Cst = (const bf16_t*)(P.ws + WS_XMC); const float* Nst = (const float*)(P.ws + WS_XMN); const float* Sst = (const float*)(P.ws + WS_XMS); const float* Tst = (const float*)(P.ws + WS_XMT);
        for (int i = tid; i < 16 * LDTB / 4; i += NT) ((LAS unsigned*)(lds + X3M_ONE))[i] = 0x3f803f80u;
        u32x4 rc[4], rcb[2]; float rfc = 0.f, rg = 0.f, rpm = 0.f, rmp = 0.f, rn = 0.f; int rrow = 0;
        auto geom = [&](int it, int& b, int& h, int& dir, int& c) { const int sq = it / NCH64; c = it - sq * NCH64; b = sq >> 3; h = (sq >> 1) & 3; dir = sq & 1; };
        auto load = [&](int it) {
            int b, h, dir, c; geom(it, b, h, dir, c);
            int tl = tid; asm volatile("" : "+v"(tl));
#pragma unroll
            for (int s = 0; s < 4; ++s) {
                const int task = tl + NT * s, j = task >> 5, g = task & 31;
                const int row = scan_row(c * CL + j, b, dir, 0);
                rc[s] = g < 16 ? *(const u32x4*)(QK + (size_t)row * 512 + (g < 8 ? h * 64 + 8 * g : 256 + h * 64 + 8 * (g - 8))) : *(const u32x4*)(Pb + (size_t)row * LDP_EVEN + 1808 + h * 128 + 8 * (g - 16));
            }
#pragma unroll
            for (int s = 0; s < 2; ++s) rcb[s] = *(const u32x4*)(Cst + (size_t)it * 8192 + (tl + NT * s) * 8);
            if (tl < CL) {
                rrow = scan_row(c * CL + tl, b, dir, 0);
                const float* tp = Tst + (size_t)it * 192;
                rfc = tp[tl]; rg = tp[64 + tl]; rpm = tp[128 + tl]; rmp = Sst[(size_t)it * 4 + 2]; rn = Nst[(size_t)it * 64 + tl];
            }
        };
        int it = blockIdx.x;
        if (it < NML_ITEMS) load(it);
        __syncthreads();
        for (; it < NML_ITEMS; it += gridDim.x) {
            int b, h, dir, c; geom(it, b, h, dir, c);
            bf16_t* Y = (bf16_t*)(P.ws + (dir ? WS_YB : WS_YF));
            LAS float* sc = (LAS float*)(lds + X3M_SC);
            {
                int tl = tid; asm volatile("" : "+v"(tl));
#pragma unroll
                for (int s = 0; s < 4; ++s) {
                    const int task = tl + NT * s, j = task >> 5, g = task & 31;
                    if (g < 8) *(LAS u32x4*)(lds + X3M_QT + j * LDTB + 8 * g * 2) = rc[s];
                    else if (g < 16) *(LAS u32x4*)(lds + X3M_KT + j * LDTB + 8 * (g - 8) * 2) = rc[s];
                    else {
                        const int v0 = 8 * (g - 16);
#pragma unroll
                        for (int e = 0; e < 8; ++e) { const unsigned wv = rc[s][e >> 1]; *(LAS bf16_t*)(lds + X3M_VT + swz_off(v0 + e, j * 2)) = (bf16_t)((e & 1) ? (wv >> 16) : (wv & 0xffffu)); }
                    }
                }
#pragma unroll
                for (int s = 0; s < 2; ++s) { const int ch = tl + NT * s; *(LAS u32x4*)(lds + X3M_CB + (ch >> 3) * LDTB + (ch & 7) * 16) = rcb[s]; }
                if (tl < CL) {
                    const float linter = rfc + rmp, mrow = fmaxf(rfc + rpm, linter);
                    sc[tl] = rfc - mrow; sc[64 + tl] = rg; sc[128 + tl] = __expf(linter - mrow); sc[192 + tl] = __expf(-mrow); ((LAS int*)sc)[256 + tl] = rrow;
                    const bf16_t nb = f2bf(rn);
#pragma unroll
                    for (int r = 0; r < 16; ++r) *(LAS bf16_t*)(lds + X3M_NB + r * LDTB + tl * 2) = nb;
                }
            }
            if (it + (int)gridDim.x < NML_ITEMS) load(it + gridDim.x);
            __syncthreads();
            {
                const int lt = wid >> 1;
#pragma unroll
                for (int u = 0; u < 2; ++u) {
                    const int st = (wid & 1) * 2 + u;
                    f32x4 acc = (f32x4){0.f, 0.f, 0.f, 0.f};
                    if (st <= lt) {
#pragma unroll
                        for (int k0 = 0; k0 < 64; k0 += 32) acc = __builtin_amdgcn_mfma_f32_16x16x32_bf16(ldfrag(lds + X3M_KT, LDTB, st * 16, k0, lane), ldfrag(lds + X3M_QT, LDTB, lt * 16, k0, lane), acc, 0, 0, 0);
                        const int l = lt * 16 + r16, s0 = st * 16 + 4 * q;
                        const float rt = sc[l]; const f32x4 gs = *(const LAS f32x4*)(sc + 64 + s0);
#pragma unroll
                        for (int j = 0; j < 4; ++j) acc[j] = (s0 + j <= l) ? acc[j] * __expf(rt + gs[j]) : 0.f;
                    }
                    st4bf(lds + X3M_W + (lt * 16 + r16) * LDTB + (st * 16 + 4 * q) * 2, acc);
                }
            }
            __syncthreads();
            {
                const int lt = wid >> 1, l = lt * 16 + r16;
                const bf16x8 wf0 = ldfrag(lds + X3M_W, LDTB, lt * 16, 0, lane), wf1 = ldfrag(lds + X3M_W, LDTB, lt * 16, 32, lane);
                const bf16x8 qf0 = ldfrag(lds + X3M_QT, LDTB, lt * 16, 0, lane), qf1 = ldfrag(lds + X3M_QT, LDTB, lt * 16, 32, lane);
                f32x4 da = __builtin_amdgcn_mfma_f32_16x16x32_bf16(ldfrag(lds + X3M_ONE, LDTB, 0, 0, lane), wf0, (f32x4){0.f, 0.f, 0.f, 0.f}, 0, 0, 0);
                da = __builtin_amdgcn_mfma_f32_16x16x32_bf16(ldfrag(lds + X3M_ONE, LDTB, 0, 32, lane), wf1, da, 0, 0, 0);
                f32x4 qn = __builtin_amdgcn_mfma_f32_16x16x32_bf16(ldfrag(lds + X3M_NB, LDTB, 0, 0, lane), qf0, (f32x4){0.f, 0.f, 0.f, 0.f}, 0, 0, 0);
                qn = __builtin_amdgcn_mfma_f32_16x16x32_bf16(ldfrag(lds + X3M_NB, LDTB, 0, 32, lane), qf1, qn, 0, 0, 0);
                const float inter = sc[128 + l], emr = sc[192 + l];
                const float inv = __builtin_amdgcn_rcpf(fmaxf(fabsf(da[0] + inter * qn[0]), emr));
                const int row = ((const LAS int*)sc)[256 + l];
#pragma unroll
                for (int u = 0; u < 4; ++u) {
                    const int vt = (wid & 1) * 4 + u;
                    f32x4 na = __builtin_amdgcn_mfma_f32_16x16x32_bf16(ldfrag_sw(lds + X3M_VT, vt * 16, 0, lane), wf0, (f32x4){0.f, 0.f, 0.f, 0.f}, 0, 0, 0);
                    na = __builtin_amdgcn_mfma_f32_16x16x32_bf16(ldfrag_sw(lds + X3M_VT, vt * 16, 32, lane), wf1, na, 0, 0, 0);
                    f32x4 ca = __builtin_amdgcn_mfma_f32_16x16x32_bf16(ldfrag(lds + X3M_CB, LDTB, vt * 16, 0, lane), qf0, (f32x4){0.f, 0.f, 0.f, 0.f}, 0, 0, 0);
                    ca = __builtin_amdgcn_mfma_f32_16x16x32_bf16(ldfrag(lds + X3M_CB, LDTB, vt * 16, 32, lane), qf1, ca, 0, 0, 0);
                    u32x2 o; o.x = pk2((na[0] + inter * ca[0]) * inv, (na[1] + inter * ca[1]) * inv); o.y = pk2((na[2] + inter * ca[2]) * inv, (na[3] + inter * ca[3]) * inv);
                    *(u32x2*)(Y + (size_t)row * D + 512 + h * 128 + vt * 16 + 4 * q) = o;
                }
            }
            __syncthreads();
        }
    }
}

constexpr int HC_RAWF = 0;
constexpr int HC_RAWQ = HC_RAWF + 64 * 128 * 4;
constexpr int HC_SUB = HC_RAWQ + 64 * 128 * 2;
constexpr int HL_QD = 136 * 2;
constexpr int HL_T = 24 * 2;
constexpr int HS_QI = 0, HS_KO = HS_QI + 16 * HL_QD, HS_KET = HS_KO + 16 * HL_QD, HS_ATT = HS_KET + 128 * HL_T, HS_VT = HS_ATT + 16 * HL_T, HS_DEC = HS_VT + 32 * HL_T, HS_SIZE = HS_DEC + 512;
constexpr int HC_SB = HC_SUB + 4 * HS_SIZE;
constexpr int HC_ROWS = HC_SB + 2 * 32 * HL_QD, HC_CST = HC_ROWS + 256, HC_END = HC_CST + 1024;
static_assert(HC_END <= LDS_BYTES - 16, "HGRN2 LDS map");
static_assert(HS_SIZE % 16 == 0 && HC_SB % 16 == 0, "alignment");
__device__ __forceinline__ bf16x8 ldfrag16(const LAS char* tile, int ldb, int row0, int lane) {
    bf16x8 v = *(const LAS bf16x8*)(tile + (row0 + (lane & 15)) * ldb + ((lane >> 4) & 1) * 16);
    if (lane >= 32) v = (bf16x8){0, 0, 0, 0, 0, 0, 0, 0};
    return v;
}
__device__ __forceinline__ void scan_hgrn_c(int wv, KP Pk, int layer, int unit, LAS char* lds) {
    asm volatile("" : "+s"(Pk));
    const CAS Params& P = *Pk;
    const int tid = ltid(wv), lane = tid & 63, wid = tid >> 6, q = lane >> 4, r16 = lane & 15, i_ = layer >> 1;
    const int seq = unit >> 2, quarter = unit & 3, b = seq >> 3, h = (seq >> 1) & 3, dir = seq & 1;
    const bf16_t* Pb = (const bf16_t*)(P.ws + WS_P);
    bf16_t* Y = (bf16_t*)(P.ws + (dir ? WS_YB : WS_YF));
    LAS float* cst = (LAS float*)(lds + HC_CST);
    if (tid < 128) cst[tid] = ((const float*)(P.ws + WS_LB))[layer * 512 + h * 128 + tid];
    else if (tid < 256) cst[tid] = P.hg_f_bias[(size_t)(i_ * 2 + dir) * 512 + h * 128 + tid - 128];
    for (int i = tid; i < 2 * 32 * HL_QD / 4; i += NT) ((LAS unsigned*)(lds + HC_SB))[i] = 0u;
    int tj[5], tg_[5], tcol[5]; bool tv[5];
#pragma unroll
    for (int s = 0; s < 5; ++s) {
        const int task = tid + NT * s; tv[s] = task < 64 * 36; tj[s] = task / 36; tg_[s] = task % 36;
        const int g = tg_[s];
        tcol[s] = g < 16 ? (512 + dir * 512 + h * 128 + 8 * g) : g < 32 ? (h * 128 + 8 * (g - 16)) : (1536 + h * 128 + quarter * 32 + 8 * (g - 32));
    }
    u32x4 rc[5]; int rrow = 0;
    auto load = [&](int c) {
#pragma unroll
        for (int s = 0; s < 5; ++s) {
            rc[s] = (u32x4){0u, 0u, 0u, 0u};
            if (tv[s]) { const int row = scan_row(c * 64 + tj[s], b, dir, 1); rc[s] = *(const u32x4*)(Pb + (size_t)row * LDP_ODD + tcol[s]); }
        }
        if (tid < 64) rrow = scan_row(c * 64 + tid, b, dir, 1);
    };
    auto storeA = [&]() {
#pragma unroll
        for (int s = 0; s < 5; ++s) {
            if (tv[s]) {
                float f[8]; unpack8(rc[s], f);
                const int j = tj[s], g = tg_[s];
                if (g < 16) {
                    float o[8];
#pragma unroll
                    for (int e = 0; e < 8; ++e) { const float lbv = cst[8 * g + e]; o[e] = lbv + (1.f - lbv) * sigmoidf_(f[e] + cst[128 + 8 * g + e]); }
                    LAS float* dst = (LAS float*)(lds + HC_RAWF) + j * 128 + 8 * g;
                    *(LAS f32x4*)dst = (f32x4){o[0], o[1], o[2], o[3]}; *(LAS f32x4*)(dst + 4) = (f32x4){o[4], o[5], o[6], o[7]};
                } else if (g < 32) {
                    float o[8];
#pragma unroll
                    for (int e = 0; e < 8; ++e) o[e] = siluf_(f[e]);
                    *(LAS u32x4*)(lds + HC_RAWQ + (j * 128 + 8 * (g - 16)) * 2) = pack8(o);
                } else {
                    const int v0 = 8 * (g - 32);
                    LAS char* vt = lds + HC_SUB + (j >> 4) * HS_SIZE + HS_VT;
#pragma unroll
                    for (int e = 0; e < 8; ++e) { const unsigned wv = rc[s][e >> 1]; *(LAS bf16_t*)(vt + (v0 + e) * HL_T + (j & 15) * 2) = (bf16_t)((e & 1) ? (wv >> 16) : (wv & 0xffffu)); }
                }
            }
        }
        if (tid < 64) ((LAS int*)(lds + HC_ROWS))[tid] = rrow;
    };
    auto storeB = [&]() {
        const int d = tid & 127, sb = tid >> 7;
        LAS char* st = lds + HC_SUB + sb * HS_SIZE;
        const LAS float* rf = (const LAS float*)(lds + HC_RAWF) + (sb * 16) * 128 + d;
        const LAS bf16_t* rq = (const LAS bf16_t*)(lds + HC_RAWQ) + (sb * 16) * 128 + d;
        float lam = 0.f, lams[16], kfs[16];
#pragma unroll
        for (int t = 0; t < 16; ++t) {
            const float f = rf[t * 128];
            lam += __logf(f);
            const float kf = 1.f - f;
            lams[t] = lam; kfs[t] = kf;
            *(LAS bf16_t*)(st + HS_QI + t * HL_QD + d * 2) = f2bf(bf2f(rq[t * 128]) * __expf(lam));
            *(LAS bf16_t*)(st + HS_KO + t * HL_QD + d * 2) = f2bf(kf * __expf(-lam));
        }
        float ke[16];
#pragma unroll
        for (int t = 0; t < 16; ++t) ke[t] = kfs[t] * __expf(lam - lams[t]);
        *(LAS u32x4*)(st + HS_KET + d * HL_T) = pack8(ke); *(LAS u32x4*)(st + HS_KET + d * HL_T + 16) = pack8(ke + 8);
        ((LAS float*)(st + HS_DEC))[d] = __expf(lam);
    };
    f32x4 sacc[2];
    sacc[0] = sacc[1] = (f32x4){0.f, 0.f, 0.f, 0.f};
    __syncthreads();
    load(0);
    for (int c = 0; c < NSTEPS / 64; ++c) {
        storeA();
        __syncthreads();
        storeB();
        if (c + 1 < NSTEPS / 64) load(c + 1);
        __syncthreads();
        if (wid < 4) {
            LAS char* st = lds + HC_SUB + wid * HS_SIZE;
            f32x4 acc = (f32x4){0.f, 0.f, 0.f, 0.f};
#pragma unroll
            for (int k0 = 0; k0 < 128; k0 += 32) acc = __builtin_amdgcn_mfma_f32_16x16x32_bf16(ldfrag(st + HS_KO, HL_QD, 0, k0, lane), ldfrag(st + HS_QI, HL_QD, 0, k0, lane), acc, 0, 0, 0);
#pragma unroll
            for (int j = 0; j < 4; ++j) acc[j] = (4 * q + j <= r16) ? acc[j] : 0.f;
            st4bf(st + HS_ATT + r16 * HL_T + 4 * q * 2, acc);
        }
        __syncthreads();
#pragma unroll 1
        for (int sb = 0; sb < 4; ++sb) {
            LAS char* st = lds + HC_SUB + sb * HS_SIZE;
            const LAS char* sbr = lds + HC_SB + (sb & 1) * 32 * HL_QD;
            LAS char* sbw = lds + HC_SB + ((sb + 1) & 1) * 32 * HL_QD;
            if (wid < 2) {
                f32x4 ya = __builtin_amdgcn_mfma_f32_16x16x32_bf16(ldfrag16(st + HS_VT, HL_T, wid * 16, lane), ldfrag16(st + HS_ATT, HL_T, 0, lane), (f32x4){0.f, 0.f, 0.f, 0.f}, 0, 0, 0);
#pragma unroll
                for (int k0 = 0; k0 < 128; k0 += 32) ya = __builtin_amdgcn_mfma_f32_16x16x32_bf16(ldfrag(sbr, HL_QD, wid * 16, k0, lane), ldfrag(st + HS_QI, HL_QD, 0, k0, lane), ya, 0, 0, 0);
                const int row = ((const LAS int*)(lds + HC_ROWS))[sb * 16 + r16];
                u32x2 o; o.x = pk2(ya[0], ya[1]); o.y = pk2(ya[2], ya[3]);
                *(u32x2*)(Y + (size_t)row * D + h * 128 + quarter * 32 + wid * 16 + 4 * q) = o;
            }
            {
                const int vt = wid >> 2;
                const bf16x8 vf = ldfrag16(st + HS_VT, HL_T, vt * 16, lane);
#pragma unroll
                for (int u = 0; u < 2; ++u) {
                    const int dt = (wid & 3) * 2 + u;
                    const f32x4 a = __builtin_amdgcn_mfma_f32_16x16x32_bf16(ldfrag16(st + HS_KET, HL_T, dt * 16, lane), vf, (f32x4){0.f, 0.f, 0.f, 0.f}, 0, 0, 0);
                    const f32x4 dc = *(const LAS f32x4*)((const LAS float*)(st + HS_DEC) + dt * 16 + 4 * q);
#pragma unroll
                    for (int j = 0; j < 4; ++j) sacc[u][j] = sacc[u][j] * dc[j] + a[j];
                    st4bf(sbw + (vt * 16 + r16) * HL_QD + (dt * 16 + 4 * q) * 2, sacc[u]);
                }
            }
            __syncthreads();
        }
    }
}

constexpr int RC_RAWW = 0;
constexpr int RC_RAWA = RC_RAWW + 64 * 64 * 4;
constexpr int RC_RAWB = RC_RAWA + 64 * 64 * 2, RC_RAWK = RC_RAWB + 64 * 64 * 2, RC_RAWR = RC_RAWK + 64 * 64 * 2;
constexpr int RC_SUB = RC_RAWR + 64 * 64 * 2;
constexpr int RL_C = 72 * 2, RL_32 = 40 * 2, RL_16 = 24 * 2;
constexpr int RS_AT = 0, RS_RT = RS_AT + 16 * RL_C, RS_KT = RS_RT + 16 * RL_C, RS_BT = RS_KT + 16 * RL_C, RS_KBH = RS_BT + 16 * RL_C, RS_AAK = RS_KBH + 64 * RL_32,
              RS_ARKB = RS_AAK + 16 * RL_16, RS_T = RS_ARKB + 16 * RL_32, RS_AABF = RS_T + 16 * RL_16, RS_GL = RS_AABF + 16 * 16 * 4, RS_VU = RS_GL + 256, RS_SIZE = RS_VU + 32 * RL_32;
constexpr int RC_SB = RC_SUB + 4 * RS_SIZE;
constexpr int RC_RHT = RC_SB + 32 * RL_C;
constexpr int RC_ROWS = RC_RHT + 32 * RL_16, RC_END = RC_ROWS + 256;
static_assert(RC_END <= LDS_BYTES - 16, "RWKV LDS map");
static_assert(RS_SIZE % 16 == 0 && RC_SB % 16 == 0 && RC_RHT % 16 == 0, "alignment");

__device__ __forceinline__ float allreduce8(float v) {
    v += dppmov<0xB1>(v); v += dppmov<0x4E>(v); v += dppmov<0x141>(v);
    return v;
}

__device__ __forceinline__ void phase_prep1(int wv, KP Pk, int layer) {
    asm volatile("" : "+s"(Pk));
    const CAS Params& P = *Pk;
    const int tid = ltid(wv), lane = tid & 63, wid = tid >> 6, i_ = layer >> 1;
    const bf16_t* Pb = (const bf16_t*)(P.ws + WS_P);
    bf16_t* R = (bf16_t*)(P.ws + WS_RWR); bf16_t* K = (bf16_t*)(P.ws + WS_RWK); bf16_t* V = (bf16_t*)(P.ws + WS_RWV); bf16_t* KK = (bf16_t*)(P.ws + WS_RWKK);
    bf16_t* LA = (bf16_t*)(P.ws + WS_LA);
    const float* mu = P.rw_mu + (size_t)i_ * 1856;
    float mur[8], muv[8], muk[8], mul_[8], kkw[8];
#pragma unroll
    for (int e = 0; e < 8; ++e) { mur[e] = mu[8 * lane + e]; muv[e] = mu[1024 + 8 * lane + e]; muk[e] = mu[512 + 8 * lane + e]; mul_[e] = lane < 40 ? mu[1536 + 8 * lane + e] : 0.f; kkw[e] = P.rw_k_k[i_ * 512 + 8 * lane + e]; }
    u32x4 nq[4][3]; float nmp = 0.f, nmn = 0.f;
    auto fetch = [&](int r) {
        int rprev = -1, rnext = -1;
        if (r < NCTX) { const int t = r & 255; if (t > 0) rprev = r - 1; if (t < CTXL - 1) rnext = r + 1; }
        else {
            const int bs = (r - NCTX) >> 13, s = (r - NCTX) & 8191, sg = ((s & 63) << 7) + (s >> 6);
            if (sg > 0) { const int g2 = sg - 1; rprev = NCTX + bs * SEQ + ((g2 & 127) << 6) + (g2 >> 7); }
            if (sg < SEQ - 1) { const int g2 = sg + 1; rnext = NCTX + bs * SEQ + ((g2 & 127) << 6) + (g2 >> 7); }
        }
        const bf16_t* pc = Pb + (size_t)r * LDP_ODD + 2560;
        const bf16_t* pp = Pb + (size_t)(rprev < 0 ? r : rprev) * LDP_ODD + 2560;
        const bf16_t* pn = Pb + (size_t)(rnext < 0 ? r : rnext) * LDP_ODD + 2560;
        nmp = rprev < 0 ? 0.f : 0.5f; nmn = rnext < 0 ? 0.f : 0.5f;
#pragma unroll
        for (int gq = 0; gq < 4; ++gq) {
            const int col = (gq == 0 ? 0 : gq == 1 ? 1024 : gq == 2 ? 512 : 1536) + 8 * lane;
            if (gq < 3 || lane < 40) { nq[gq][0] = *(const u32x4*)(pc + col); nq[gq][1] = *(const u32x4*)(pp + col); nq[gq][2] = *(const u32x4*)(pn + col); }
        }
    };
    nq[3][0] = nq[3][1] = nq[3][2] = (u32x4){0u, 0u, 0u, 0u};
    const int stride = gridDim.x * 8;
    int r = blockIdx.x * 8 + wid;
    if (r < NROWS) fetch(r);
    for (; r < NROWS; r += stride) {
        u32x4 cq[4][3];
#pragma unroll
        for (int gq = 0; gq < 4; ++gq)
#pragma unroll
            for (int k = 0; k < 3; ++k) cq[gq][k] = nq[gq][k];
        const float mp = nmp, mn = nmn;
        if (r + stride < NROWS) fetch(r + stride);
        auto mix8 = [&](const u32x4 (&c)[3], const float* muc, float* o) {
            float fc[8], fp[8], fn[8];
            unpack8(c[0], fc); unpack8(c[1], fp); unpack8(c[2], fn);
#pragma unroll
            for (int e = 0; e < 8; ++e) o[e] = fc[e] + muc[e] * (mp * fp[e] + mn * fn[e] - fc[e]);
        };
        float o[8];
        mix8(cq[0], mur, o); *(u32x4*)(R + (size_t)r * 512 + 8 * lane) = pack8(o);
        mix8(cq[1], muv, o); *(u32x4*)(V + (size_t)r * 512 + 8 * lane) = pack8(o);
        mix8(cq[2], muk, o); *(u32x4*)(K + (size_t)r * 512 + 8 * lane) = pack8(o);
        {
            float kk[8], ss = 0.f;
#pragma unroll
            for (int e = 0; e < 8; ++e) { kk[e] = o[e] * kkw[e]; ss += kk[e] * kk[e]; }
            ss = group_sum<8>(ss);
            const float rn = rsqrtf(fmaxf(ss, 1e-12f));
#pragma unroll
            for (int e = 0; e < 8; ++e) kk[e] *= rn;
            *(u32x4*)(KK + (size_t)r * 512 + 8 * lane) = pack8(kk);
        }
        if (lane < 40) {
            mix8(cq[3], mul_, o);
            if (lane < 16) {
#pragma unroll
                for (int e = 0; e < 8; ++e) o[e] = tanh_fast(o[e]);
            } else if (lane >= 24) {
#pragma unroll
                for (int e = 0; e < 8; ++e) o[e] = sigmoidf_(o[e]);
            }
            *(u32x4*)(LA + (size_t)r * 320 + 8 * lane) = pack8(o);
        }
    }
}

__device__ __forceinline__ void phase_out_even(int wv, KP Pk, int layer) {
    asm volatile("" : "+s"(Pk));
    const CAS Params& P = *Pk;
    const int tid = ltid(wv), lane = tid & 63, wid = tid >> 6, i_ = layer >> 1;
    const bf16_t* Pb = (const bf16_t*)(P.ws + WS_P);
    const bf16_t* Yf = (const bf16_t*)(P.ws + WS_YF); const bf16_t* Yb = (const bf16_t*)(P.ws + WS_YB);
    bf16_t* feat = (bf16_t*)(P.ws + WS_FEAT);
    const int r0 = (layer == DEPTH - 1) ? NCTX : 0;
    const bf16_t* XBC = (const bf16_t*)(P.ws + WS_EXBC);
    float nwa[8], nwb[8];
#pragma unroll
    for (int e = 0; e < 8; ++e) { nwa[e] = P.ssd_norm_w[i_ * 512 + 8 * lane + e]; nwb[e] = P.ml_norm_w[i_ * 512 + 8 * lane + e]; }
    const float dsk = P.ssd_d[i_ * 8 + (lane >> 3)];
    u32x4 n0, n1, n2, n3, n4, n5, n6;
    auto fetch = [&](int rr) {
        const bf16_t* pr = Pb + (size_t)rr * LDP_EVEN;
        n0 = *(const u32x4*)(Yf + (size_t)rr * D + 8 * lane); n1 = *(const u32x4*)(Yb + (size_t)rr * D + 8 * lane);
        n2 = *(const u32x4*)(XBC + (size_t)rr * 768 + 8 * lane); n3 = *(const u32x4*)(pr + 8 * lane);
        n4 = *(const u32x4*)(Yf + (size_t)rr * D + 512 + 8 * lane); n5 = *(const u32x4*)(Yb + (size_t)rr * D + 512 + 8 * lane); n6 = *(const u32x4*)(pr + 2320 + 8 * lane);
    };
    const int stride = gridDim.x * 8;
    int r = r0 + blockIdx.x * 8 + wid;
    if (r < NROWS) fetch(r);
    for (; r < NROWS; r += stride) {
        const u32x4 c0 = n0, c1 = n1, c2 = n2, c3 = n3, c4 = n4, c5 = n5, c6 = n6;
        if (r + stride < NROWS) fetch(r + stride);
        float y[8];
        {
            float a[8], bb[8], xsv[8], z[8];
            unpack8(c0, a); unpack8(c1, bb);
            unpack8(c2, xsv); unpack8(c3, z);
            float ss = 0.f;
#pragma unroll
            for (int e = 0; e < 8; ++e) {
                y[e] = (a[e] + bb[e] + dsk * xsv[e]) * siluf_(z[e]); ss += y[e] * y[e];
            }
            ss = wave_sum(ss);
            const float rn = rsqrtf(ss * (1.f / 512.f) + 1e-6f);
#pragma unroll
            for (int e = 0; e < 8; ++e) y[e] = y[e] * rn * nwa[e];
            *(u32x4*)(feat + (size_t)r * D + 8 * lane) = pack8(y);
        }
        {
            float a[8], bb[8], o[8];
            unpack8(c4, a); unpack8(c5, bb);
            unpack8(c6, o);
            float s = 0.f;
#pragma unroll
            for (int e = 0; e < 8; ++e) { y[e] = a[e] + bb[e]; s += y[e]; }
            const float mean = group_sum<16>(s) * (1.f / 128.f);
            float ss = 0.f;
#pragma unroll
            for (int e = 0; e < 8; ++e) { y[e] -= mean; ss += y[e] * y[e]; }
            const float rn = rsqrtf(group_sum<16>(ss) * (1.f / 128.f) + 1e-6f);
#pragma unroll
            for (int e = 0; e < 8; ++e) y[e] = sigmoidf_(o[e]) * (y[e] * rn) * nwb[e];
            *(u32x4*)(feat + (size_t)r * D + 512 + 8 * lane) = pack8(y);
        }
    }
}
__device__ __forceinline__ void phase_out_odd(int wv, KP Pk, int layer) {
    asm volatile("" : "+s"(Pk));
    const CAS Params& P = *Pk;
    const int tid = ltid(wv), lane = tid & 63, wid = tid >> 6, i_ = layer >> 1;
    const bf16_t* Pb = (const bf16_t*)(P.ws + WS_P);
    const bf16_t* Yf = (const bf16_t*)(P.ws + WS_YF); const bf16_t* Yb = (const bf16_t*)(P.ws + WS_YB);
    const bf16_t* R = (const bf16_t*)(P.ws + WS_RWR); const bf16_t* K = (const bf16_t*)(P.ws + WS_RWK); const bf16_t* V = (const bf16_t*)(P.ws + WS_RWV); const bf16_t* G = (const bf16_t*)(P.ws + WS_RWG);
    bf16_t* feat = (bf16_t*)(P.ws + WS_FEAT);
    const int r0 = (layer == DEPTH - 1) ? NCTX : 0;
    float nwc[8], rk[8], lw[8], lbv[8];
#pragma unroll
    for (int e = 0; e < 8; ++e) {
        nwc[e] = P.hg_norm_w[i_ * 512 + 8 * lane + e]; rk[e] = P.rw_r_k[i_ * 512 + 8 * lane + e];
        lw[e] = P.rw_ln_w[i_ * 512 + 8 * lane + e]; lbv[e] = P.rw_ln_b[i_ * 512 + 8 * lane + e];
    }
    u32x4 n0, n1, n2, n3, n4, n5, n6, n7, n8;
    auto fetch = [&](int rr) {
        n0 = *(const u32x4*)(Yf + (size_t)rr * D + 8 * lane); n1 = *(const u32x4*)(Yb + (size_t)rr * D + 8 * lane); n2 = *(const u32x4*)(Pb + (size_t)rr * LDP_ODD + 2048 + 8 * lane);
        n3 = *(const u32x4*)(Yf + (size_t)rr * D + 512 + 8 * lane); n4 = *(const u32x4*)(Yb + (size_t)rr * D + 512 + 8 * lane);
        n5 = *(const u32x4*)(R + (size_t)rr * 512 + 8 * lane); n6 = *(const u32x4*)(K + (size_t)rr * 512 + 8 * lane);
        n7 = *(const u32x4*)(V + (size_t)rr * 512 + 8 * lane); n8 = *(const u32x4*)(G + (size_t)rr * 512 + 8 * lane);
    };
    const int stride = gridDim.x * 8;
    int r = r0 + blockIdx.x * 8 + wid;
    if (r < NROWS) fetch(r);
    for (; r < NROWS; r += stride) {
        const u32x4 c0 = n0, c1 = n1, c2 = n2, c3 = n3, c4 = n4, c5 = n5, c6 = n6, c7 = n7, c8 = n8;
        if (r + stride < NROWS) fetch(r + stride);
        float y[8];
        {
            float a[8], bb[8], g[8];
            unpack8(c0, a); unpack8(c1, bb);
            unpack8(c2, g);
            float ss = 0.f;
#pragma unroll
            for (int e = 0; e < 8; ++e) { y[e] = a[e] + bb[e]; ss += y[e] * y[e]; }
            const float rn = rsqrtf(group_sum<16>(ss) * (1.f / 128.f) + 1e-6f);
#pragma unroll
            for (int e = 0; e < 8; ++e) y[e] = y[e] * rn * nwc[e] * siluf_(g[e]);
            *(u32x4*)(feat + (size_t)r * D + 8 * lane) = pack8(y);
        }
        {
            float a[8], bb[8], rr[8], kk[8], vv[8], g[8];
            unpack8(c3, a); unpack8(c4, bb);
            unpack8(c5, rr); unpack8(c6, kk);
            unpack8(c7, vv); unpack8(c8, g);
            float s = 0.f, bs = 0.f;
#pragma unroll
            for (int e = 0; e < 8; ++e) { y[e] = a[e] + bb[e]; s += y[e]; bs += rr[e] * kk[e] * rk[e]; }
            const float mean = group_sum<8>(s) * (1.f / 64.f); bs = group_sum<8>(bs);
            float ss = 0.f;
#pragma unroll
            for (int e = 0; e < 8; ++e) { y[e] -= mean; ss += y[e] * y[e]; }
            const float rn = rsqrtf(group_sum<8>(ss) * (1.f / 64.f) + 64e-5f);
#pragma unroll
            for (int e = 0; e < 8; ++e) y[e] = (y[e] * rn * lw[e] + lbv[e] + bs * vv[e]) * g[e];
            *(u32x4*)(feat + (size_t)r * D + 512 + 8 * lane) = pack8(y);
        }
    }
}

#ifndef MK_DOUBLE
#define MK_DOUBLE 0
#endif
#define REP(bit, body) do { body; if (MK_DOUBLE & (bit)) { body; } } while (0)
__device__ __forceinline__ void phase_expconv(int wv, KP Pk, int layer, LAS char* lds) {
    asm volatile("" : "+s"(Pk));
    const CAS Params& P = *Pk;
    const int tid = ltid(wv);
    if (layer & 1) return;
    expconv_items(P, layer, lds, exc_s0(layer) + exc_s1(layer), EXC_ITEMS, (int)blockIdx.x * 8 + (tid >> 6), (int)gridDim.x * 8, tid >> 6, tid & 63);
}
__device__ __forceinline__ void expconv_after_scan(int wv, KP Pk, int layer, LAS char* lds) {
    asm volatile("" : "+s"(Pk));
    const CAS Params& P = *Pk;
    const int tid = ltid(wv);
    __syncthreads();
    expconv_items(P, layer, lds, exc_s0(layer) + exc_s1(layer), EXC_ITEMS, (int)blockIdx.x * 8 + (tid >> 6), 128 * 8, tid >> 6, tid & 63);
}
constexpr int L1_AST = 1028;
constexpr int L1_PST = 33;
constexpr int L1_A = 0, L1_PART = L1_A + 16 * L1_AST * 4, L1_SM = L1_PART + 8 * 16 * L1_PST * 4, L1_END = L1_SM + (64 + 2 * 144 + 32) * 4;
static_assert(L1_END <= LDS_BYTES - 16, "LN1 LDS map");
__device__ __forceinline__ void phase_ln1(int wv, KP Pk, int layer, LAS char* lds, bool dry = false) {
    asm volatile("" : "+s"(Pk));
    const CAS Params& P = *Pk;
    const int tid = ltid(wv), lane = tid & 63;
    if (!dry) REP(8, phase_expconv(wv, Pk, layer, lds));
    __syncthreads();
    LAS float* At = (LAS float*)(lds + L1_A);
    LAS float* part = (LAS float*)(lds + L1_PART);
    LAS int* lcnt = (LAS int*)(lds + L1_SM);
    LAS int* lbase = lcnt + 32;
    LAS int* asg = lcnt + 64;
    LAS float* rbias = (LAS float*)(asg + 2 * 144);
    if (tid < 32) { lcnt[tid] = 0; rbias[tid] = P.router_bias[tid]; }
    float breg[8][4][2];
    {
        const float* rw = P.router_w + (size_t)(128 * wv + 4 * (lane >> 4)) * NEXP + (lane & 15);
#pragma unroll
        for (int j = 0; j < 8; ++j)
#pragma unroll
            for (int i = 0; i < 4; ++i) { breg[j][i][0] = rw[(16 * j + i) * NEXP]; breg[j][i][1] = rw[(16 * j + i) * NEXP + 16]; }
    }
    __syncthreads();
    const bf16_t* yo = (const bf16_t*)(P.ws + WS_YO);
    bf16_t* act = (bf16_t*)(P.ws + (dry ? WS_FEAT : WS_ACT));
    bf16_t* xcb = (bf16_t*)(P.ws + WS_XC); bf16_t* xob = (bf16_t*)P.out;
    const bool lastl = (layer == DEPTH - 1);
    int* cnt = (int*)(P.ws + WS_CNT) + layer * 32 * CNT_STRIDE;
    int* list = (int*)(P.ws + WS_LIST);
    float* wts = (float*)(P.ws + WS_WTS);
    const float* lg = P.ln_g + (size_t)(layer * 2 + 0) * D; const float* lb = P.ln_b + (size_t)(layer * 2 + 0) * D;
    const int r0 = (layer == DEPTH - 1) ? NCTX : 0, ntiles = (NROWS - r0) / 16, G = gridDim.x;
    f32x4 g1v[4], s2c[4], h2c[4];
#pragma unroll
    for (int i = 0; i < 4; ++i) g1v[i] = s2c[i] = h2c[i] = (f32x4){0.f, 0.f, 0.f, 0.f};
    int mcur = -1;
    f32x4 nx[2][4]; u32x2 nyo[2][4];
    auto fetch = [&](int s, int rr) {
        if (layer == 0) {
            const float* xq = rr < NCTX ? P.ctx + (size_t)rr * D : P.x + (size_t)(rr - NCTX) * D;
#pragma unroll
            for (int i = 0; i < 4; ++i) nx[s][i] = *(const f32x4*)(xq + 4 * lane + 256 * i);
        } else {
            const bf16_t* xq = rr < NCTX ? xcb + (size_t)rr * D : xob + (size_t)(rr - NCTX) * D;
#pragma unroll
            for (int i = 0; i < 4; ++i) { const u32x2 t = *(const u32x2*)(xq + 4 * lane + 256 * i); nx[s][i] = (f32x4){__uint_as_float(t.x), __uint_as_float(t.y), 0.f, 0.f}; }
        }
#pragma unroll
        for (int i = 0; i < 4; ++i) { const int c = 4 * lane + 256 * i; nyo[s][i] = *(const u32x2*)(yo + (size_t)rr * D + c); }
    };
    int tile = blockIdx.x;
    if (tile < ntiles) { fetch(0, r0 + tile * 16 + 2 * wv); fetch(1, r0 + tile * 16 + 2 * wv + 1); }
    for (int it = 0; tile < ntiles; ++it, tile += G) {
        const int rb = r0 + tile * 16 + 2 * wv;
        const int m = row_mod(rb);
        if (m != mcur) {
            mcur = m;
            const float* g1 = modvec(P.ws, layer, m, 2); const float* sh2 = modvec(P.ws, layer, m, 3); const float* sc2 = modvec(P.ws, layer, m, 4);
#pragma unroll
            for (int i = 0; i < 4; ++i) { const int c = 4 * lane + 256 * i; g1v[i] = *(const f32x4*)(g1 + c); s2c[i] = *(const f32x4*)(sc2 + c); h2c[i] = *(const f32x4*)(sh2 + c); }
        }
#pragma unroll
        for (int s = 0; s < 2; ++s) {
            const int r = rb + s;
            bf16_t* xr = dry ? (bf16_t*)(P.ws + WS_YF) + (size_t)r * D : lastl ? (bf16_t*)(P.ws + WS_FEAT) + (size_t)r * D : r < NCTX ? xcb + (size_t)r * D : xob + (size_t)(r - NCTX) * D;
            f32x4 v[4]; float sm = 0.f;
#pragma unroll
            for (int i = 0; i < 4; ++i) {
                f32x4 xv = nx[s][i]; const f32x4 gv = g1v[i]; const u32x2 yv = nyo[s][i];
                if (layer != 0) { const unsigned b0 = __float_as_uint(xv[0]), b1 = __float_as_uint(xv[1]); xv = (f32x4){bflo(b0), bfhi(b0), bflo(b1), bfhi(b1)}; }
                v[i][0] = ALPHA * xv[0] + gv[0] * bflo(yv.x); v[i][1] = ALPHA * xv[1] + gv[1] * bfhi(yv.x);
                v[i][2] = ALPHA * xv[2] + gv[2] * bflo(yv.y); v[i][3] = ALPHA * xv[3] + gv[3] * bfhi(yv.y);
                sm += (v[i][0] + v[i][1]) + (v[i][2] + v[i][3]);
            }
            if (tile + G < ntiles) fetch(s, r + G * 16);
            const float mean = wave_sum(sm) * (1.f / D);
            float s2 = 0.f;
#pragma unroll
            for (int i = 0; i < 4; ++i) { v[i] = v[i] - mean; s2 += (v[i][0] * v[i][0] + v[i][1] * v[i][1]) + (v[i][2] * v[i][2] + v[i][3] * v[i][3]); }
            const float rstd = rsqrtf(wave_sum(s2) * (1.f / D) + 1e-5f);
            LAS float* arow = At + (2 * wv + s) * L1_AST;
#pragma unroll
            for (int i = 0; i < 4; ++i) {
                const int c = 4 * lane + 256 * i;
                const f32x4 gg = *(const f32x4*)(lg + c), bb = *(const f32x4*)(lb + c), s2v = s2c[i], h2v = h2c[i];
                f32x4 xn, hv;
#pragma unroll
                for (int j = 0; j < 4; ++j) { xn[j] = v[i][j] * rstd * gg[j] + bb[j]; hv[j] = xn[j] * (1.f + s2v[j]) + h2v[j]; }
                { u32x2 ox; ox.x = pk2(xn[0], xn[1]); ox.y = pk2(xn[2], xn[3]); *(u32x2*)(xr + c) = ox; }
                u32x2 o; o.x = pk2(hv[0], hv[1]); o.y = pk2(hv[2], hv[3]); *(u32x2*)(act + (size_t)r * D + c) = o;
                *(LAS f32x4*)(arow + c) = hv;
            }
        }
        __syncthreads();
        {
            f32x4 ra0 = (f32x4){0.f, 0.f, 0.f, 0.f}, ra1 = ra0;
            const LAS float* ap = At + (lane & 15) * L1_AST + 128 * wv + 4 * (lane >> 4);
#pragma unroll
            for (int j = 0; j < 8; ++j) {
                const f32x4 a4 = *(const LAS f32x4*)(ap + 16 * j);
#pragma unroll
                for (int i = 0; i < 4; ++i) {
                    ra0 = __builtin_amdgcn_mfma_f32_16x16x4f32(a4[i], breg[j][i][0], ra0, 0, 0, 0);
                    ra1 = __builtin_amdgcn_mfma_f32_16x16x4f32(a4[i], breg[j][i][1], ra1, 0, 0, 0);
                }
            }
            LAS float* pw = part + wv * 16 * L1_PST + (4 * (lane >> 4)) * L1_PST + (lane & 15);
#pragma unroll
            for (int j = 0; j < 4; ++j) { pw[j * L1_PST] = ra0[j]; pw[j * L1_PST + 16] = ra1[j]; }
        }
        __syncthreads();
        {
            const int half = lane >> 5, e = lane & 31;
            const LAS float* pp = part + (2 * wv + half) * L1_PST + e;
            float sc_ = 0.f;
#pragma unroll
            for (int k = 0; k < 8; ++k) sc_ += pp[k * 16 * L1_PST];
            const float sg = sigmoidf_(sc_), vb = sg + rbias[e];
            float bv[4], sv[4];
            bv[0] = dppmov<0x00>(vb); bv[1] = dppmov<0x55>(vb); bv[2] = dppmov<0xAA>(vb); bv[3] = dppmov<0xFF>(vb);
            sv[0] = dppmov<0x00>(sg); sv[1] = dppmov<0x55>(sg); sv[2] = dppmov<0xAA>(sg); sv[3] = dppmov<0xFF>(sg);
            float m1 = -1e30f, m2 = -1e30f;
#pragma unroll
            for (int k = 0; k < 4; ++k) { const float vsc = bv[k]; if (vsc > m1) { m2 = m1; m1 = vsc; } else if (vsc > m2) m2 = vsc; }
            float best = m1 + m2; int bg = e >> 2;
#pragma unroll
            for (int msk = 4; msk <= 16; msk <<= 1) {
                const float ob = __shfl_xor(best, msk); const int og = __shfl_xor(bg, msk);
                const bool take = (ob > best) || (ob == best && og < bg);
                best = take ? ob : best; bg = take ? og : bg;
            }
            int i1 = 0; float b1 = bv[0];
#pragma unroll
            for (int k = 1; k < 4; ++k) if (bv[k] > b1) { b1 = bv[k]; i1 = k; }
            int i2 = -1; float b2 = -1e30f;
#pragma unroll
            for (int k = 0; k < 4; ++k) if (k != i1 && bv[k] > b2) { b2 = bv[k]; i2 = k; }
            float s1 = sv[0], s2s = sv[0];
#pragma unroll
            for (int k = 1; k < 4; ++k) { if (i1 == k) s1 = sv[k]; if (i2 == k) s2s = sv[k]; }
            if (e == 4 * bg && !dry) {
                const int r = rb + half;
                const int e0 = bg * 4 + i1, e1 = bg * 4 + i2;
                const float inv = 1.f / (s1 + s2s);
                const int li = it * 16 + 2 * wv + half;
                const int p0 = __hip_atomic_fetch_add(&lcnt[e0], 1, __ATOMIC_RELAXED, __HIP_MEMORY_SCOPE_WORKGROUP);
                const int p1 = __hip_atomic_fetch_add(&lcnt[e1], 1, __ATOMIC_RELAXED, __HIP_MEMORY_SCOPE_WORKGROUP);
                asg[2 * li] = (e0 << 16) | p0; asg[2 * li + 1] = (e1 << 16) | p1;
                wts[2 * r] = s1 * inv; wts[2 * r + 1] = s2s * inv;
            }
        }
    }
    __syncthreads();
    if (dry) return;
    if (tid < 32) lbase[tid] = atomicAdd(&cnt[tid * CNT_STRIDE], lcnt[tid]);
    __syncthreads();
    for (int idx = tid; idx < 2 * 144; idx += NT) {
        const int li = idx >> 1, k = idx & 1, t = (li >> 4) * G + blockIdx.x;
        if (t < ntiles) { const int r = r0 + t * 16 + (li & 15); const int v = asg[idx], e = v >> 16, lp = v & 0xffff; list[(size_t)e * LISTCAP + lbase[e] + lp] = 2 * r + k; }
    }
}

__device__ __forceinline__ void phase_ln2(int wv, KP Pk, int layer, bool dry = false) {
    asm volatile("" : "+s"(Pk));
    const CAS Params& P = *Pk;
    const int tid = ltid(wv), lane = tid & 63, wid = tid >> 6;
    const bf16_t* yp = (const bf16_t*)(P.ws + WS_YP);
    const float* wts = (const float*)(P.ws + WS_WTS);
    bf16_t* act = (bf16_t*)(P.ws + (dry ? WS_FEAT : WS_ACT));
    bf16_t* xcb = (bf16_t*)(P.ws + WS_XC); bf16_t* xob = (bf16_t*)P.out;
    const float* lg = P.ln_g + (size_t)(layer * 2 + 1) * D; const float* lb = P.ln_b + (size_t)(layer * 2 + 1) * D;
    const bool last = (layer == DEPTH - 1);
    const int r0 = last ? NCTX : 0, stride = gridDim.x * 8;
    f32x4 cg[4], cb[4], g2v[4], s1v[4], h1v[4];
#pragma unroll
    for (int i = 0; i < 4; ++i) { cg[i] = *(const f32x4*)(lg + 4 * lane + 256 * i); cb[i] = *(const f32x4*)(lb + 4 * lane + 256 * i); g2v[i] = s1v[i] = h1v[i] = (f32x4){0.f, 0.f, 0.f, 0.f}; }
    int mcur = -1;
    u32x2 nx[4]; u32x2 ny0[4], ny1[4]; float nw0 = 0.f, nw1 = 0.f;
    auto fetch = [&](int r) {
        const bf16_t* xr = last ? (const bf16_t*)(P.ws + WS_FEAT) + (size_t)r * D : r < NCTX ? xcb + (size_t)r * D : xob + (size_t)(r - NCTX) * D;
#pragma unroll
        for (int i = 0; i < 4; ++i) {
            const int c = 4 * lane + 256 * i;
            nx[i] = *(const u32x2*)(xr + c); ny0[i] = *(const u32x2*)(yp + (size_t)(2 * r) * D + c); ny1[i] = *(const u32x2*)(yp + (size_t)(2 * r + 1) * D + c);
        }
        nw0 = wts[2 * r]; nw1 = wts[2 * r + 1];
    };
    int r = r0 + blockIdx.x * 8 + wid;
    if (r < NROWS) fetch(r);
    for (; r < NROWS; r += stride) {
        const int m = row_mod(r);
        if (m != mcur) {
            mcur = m;
            const float* g2 = modvec(P.ws, layer, m, 5); const float* sh1 = last ? lg : modvec(P.ws, layer + 1, m, 0); const float* sc1 = last ? lg : modvec(P.ws, layer + 1, m, 1);
#pragma unroll
            for (int i = 0; i < 4; ++i) { const int c = 4 * lane + 256 * i; g2v[i] = *(const f32x4*)(g2 + c); s1v[i] = *(const f32x4*)(sc1 + c); h1v[i] = *(const f32x4*)(sh1 + c); }
        }
        f32x4 v[4]; float s = 0.f;
        const float w0 = nw0, w1 = nw1;
#pragma unroll
        for (int i = 0; i < 4; ++i) {
            const f32x4 xv = (f32x4){bflo(nx[i].x), bfhi(nx[i].x), bflo(nx[i].y), bfhi(nx[i].y)}, gv = g2v[i]; const u32x2 y0 = ny0[i], y1 = ny1[i];
            v[i][0] = ALPHA * xv[0] + gv[0] * (w0 * bflo(y0.x) + w1 * bflo(y1.x)); v[i][1] = ALPHA * xv[1] + gv[1] * (w0 * bfhi(y0.x) + w1 * bfhi(y1.x));
            v[i][2] = ALPHA * xv[2] + gv[2] * (w0 * bflo(y0.y) + w1 * bflo(y1.y)); v[i][3] = ALPHA * xv[3] + gv[3] * (w0 * bfhi(y0.y) + w1 * bfhi(y1.y));
            s += (v[i][0] + v[i][1]) + (v[i][2] + v[i][3]);
        }
        if (r + stride < NROWS) fetch(r + stride);
        const float mean = wave_sum(s) * (1.f / D);
        float s2 = 0.f;
#pragma unroll
        for (int i = 0; i < 4; ++i) { v[i] = v[i] - mean; s2 += (v[i][0] * v[i][0] + v[i][1] * v[i][1]) + (v[i][2] * v[i][2] + v[i][3] * v[i][3]); }
        const float rstd = rsqrtf(wave_sum(s2) * (1.f / D) + 1e-5f);
#pragma unroll
        for (int i = 0; i < 4; ++i) {
            const int c = 4 * lane + 256 * i;
            f32x4 xn;
#pragma unroll
            for (int j = 0; j < 4; ++j) xn[j] = v[i][j] * rstd * cg[i][j] + cb[i][j];
            if (dry) *(f32x4*)((float*)(P.ws + WS_YF) + (size_t)r * D + c) = xn;
            else if (last) *(f32x4*)(P.out + (size_t)(r - NCTX) * D + c) = xn;
            else { u32x2 ox; ox.x = pk2(xn[0], xn[1]); ox.y = pk2(xn[2], xn[3]); *(u32x2*)((r < NCTX ? xcb + (size_t)r * D : xob + (size_t)(r - NCTX) * D) + c) = ox; }
            if (!last) {
                u32x2 o; o.x = pk2(xn[0] * (1.f + s1v[i][0]) + h1v[i][0], xn[1] * (1.f + s1v[i][1]) + h1v[i][1]); o.y = pk2(xn[2] * (1.f + s1v[i][2]) + h1v[i][2], xn[3] * (1.f + s1v[i][3]) + h1v[i][3]);
                *(u32x2*)(act + (size_t)r * D + c) = o;
            }
        }
    }
}

constexpr int NPHASE = 2 + 11 * DEPTH;
__global__ void __launch_bounds__(NT, 2) fwd_kernel(Params P) {
    extern __shared__ __attribute__((aligned(16))) char lds_raw[];
    LAS char* lds = (LAS char*)lds_raw;
    volatile LAS unsigned* xbw = (volatile LAS unsigned*)(lds + LDS_BYTES - 16);
    KP Pk = (KP)__builtin_amdgcn_kernarg_segment_ptr();
    const int wv = __builtin_amdgcn_readfirstlane((int)(threadIdx.x >> 6));
    const bool multi = (P.ph_hi - P.ph_lo) > 1;
    XcdBarrier bar; bar.bar = (unsigned*)(P.ws + WS_BAR); bar.x = 0; bar.st = xbw;
    if (multi) {
        if (ltid(wv) == 0) { xbw[0] = 0u; xbw[1] = 0u; xbw[2] = 0u; xbw[3] = 0u; }
        __syncthreads();
        bar = xcd_barrier_post(wv, (unsigned*)(P.ws + WS_BAR), xbw);
    }
#define PHASE(id, body) do { if (P.ph_lo <= (id) && (id) < P.ph_hi) { body; if ((id) + 1 < P.ph_hi) xcd_barrier(wv, bar); if (MK_DOUBLE & 2048) xcd_barrier(wv, bar); } } while (0)
    PHASE(0, REP(16, phase_prologue0(wv, Pk, lds)));
    PHASE(1, REP(16, phase_prologue1(wv, Pk)));
    for (int l = 0; l < DEPTH; ++l) {
        const int pb = 2 + 11 * l, odd = l & 1;
        PHASE(pb + 0, REP(1, phase_inproj(wv, Pk, l, lds)));
        if (odd) {
            PHASE(pb + 1, REP(4, phase_prep1(wv, Pk, l)));
            PHASE(pb + 2, phase_prep2(wv, Pk, l, lds));
            PHASE(pb + 3, REP(32, { if (blockIdx.x < 128) { REP(64, scan_hgrn_c(wv, Pk, l, blockIdx.x, lds)); expconv_after_scan(wv, Pk, l, lds); } else if (blockIdx.x < 256) REP(128, scan_rwkv(wv, Pk, l, blockIdx.x - 128, lds)); }));
            PHASE(pb + 5, REP(4, phase_out_odd(wv, Pk, l)));
        } else {
            PHASE(pb + 1, REP(4, phase_prep_even(wv, Pk, l)));
            PHASE(pb + 2, REP(2, phase_ex1(wv, Pk, l, lds)));
            PHASE(pb + 3, phase_ex2(wv, Pk, l));
            PHASE(pb + 4, REP(2, phase_ex3(wv, Pk, l, lds)));
            PHASE(pb + 5, REP(4, phase_out_even(wv, Pk, l)));
        }
        PHASE(pb + 6, REP(256, phase_outproj(wv, Pk, l, lds)));
        PHASE(pb + 7, { if (MK_DOUBLE & 4096) phase_ln1(wv, Pk, l, lds, true); phase_ln1(wv, Pk, l, lds); });
        PHASE(pb + 8, REP(512, phase_moe1(wv, Pk, l, lds)));
        PHASE(pb + 9, REP(1024, phase_moe2(wv, Pk, l, lds)));
        PHASE(pb + 10, { if (MK_DOUBLE & 8192) phase_ln2(wv, Pk, l, true); phase_ln2(wv, Pk, l); });
    }
#undef PHASE
}


#ifndef MK_STOP
#define MK_STOP NPHASE
#endif
#ifndef MK_DUMP
#define MK_DUMP 0
#endif
#ifndef MK_DUMP_N
#define MK_DUMP_N (1u << 30)
#endif
#ifndef MK_DUMP_LD
#define MK_DUMP_LD 1024
#endif
#ifndef MK_DUMP_C0
#define MK_DUMP_C0 0
#endif
__global__ void diff_kernel(const bf16_t* a, const bf16_t* b, float* out, size_t n) {
    for (size_t i = (size_t)blockIdx.x * blockDim.x + threadIdx.x; i < n; i += (size_t)gridDim.x * blockDim.x) out[i] = 1e6f * (bf2f(a[i]) - bf2f(b[i]));
}
__global__ void dump_kernel(const bf16_t* src, float* out, size_t n) {
    for (size_t i = (size_t)blockIdx.x * blockDim.x + threadIdx.x; i < n; i += (size_t)gridDim.x * blockDim.x) out[i] = i < (size_t)MK_DUMP_N ? bf2f(src[(i >> 10) * MK_DUMP_LD + MK_DUMP_C0 + (i & 1023)]) : 0.f;
}
extern "C" void kernel_launch(void* const* d_in, const int* in_sizes, int n_in, void* d_out, int out_size, void* d_ws, size_t ws_size, hipStream_t stream) {
    static int ready = 0;
    if (ready == 0) {
        ready = 1;
        if (n_in != 42 || out_size != NB * SEQ * D || ws_size < WS_END) { fprintf(stderr, "kernel_launch: unexpected shapes (n_in %d out %d ws %zu need %zu)\n", n_in, out_size, ws_size, (size_t)WS_END); ready = -1; }
        if (hipFuncSetAttribute((const void*)fwd_kernel, hipFuncAttributeMaxDynamicSharedMemorySize, LDS_BYTES) != hipSuccess) { fprintf(stderr, "kernel_launch: hipFuncSetAttribute failed\n"); ready = -1; }
    }
    if (ready < 0) return;
    (void)in_sizes;
    hipMemsetAsync((char*)d_ws + WS_BAR, 0, WS_ZERO_BYTES, stream);
    Params p;
    memset(&p, 0, sizeof(p));
    const float** fp = (const float**)&p;
    for (int i = 0; i < 42; ++i) fp[i] = (const float*)d_in[i];
    p.out = (float*)d_out; p.ws = (unsigned char*)d_ws;
#if MK_PER_PHASE
    for (int ph = 0; ph < MK_STOP; ++ph) {
        const int local = ph < 2 ? -1 : (ph - 2) % 11, layer = ph < 2 ? 0 : (ph - 2) / 11;
        if (local == 4 && (layer & 1)) continue;
        p.ph_lo = ph; p.ph_hi = ph + 1;
        hipLaunchKernelGGL(fwd_kernel, dim3(256), dim3(NT), LDS_BYTES, stream, p);
    }
#ifdef MK_DIFF
    p.ph_lo = 7; p.ph_hi = 8; p.dbg = 1;
    hipLaunchKernelGGL(fwd_kernel, dim3(256), dim3(NT), LDS_BYTES, stream, p);
    hipLaunchKernelGGL(diff_kernel, dim3(1024), dim3(256), 0, stream, (const bf16_t*)((unsigned char*)d_ws + WS_YO), (const bf16_t*)((unsigned char*)d_ws + WS_HID), (float*)d_out, (size_t)NB * SEQ * D);
#else
    if (MK_DUMP) hipLaunchKernelGGL(dump_kernel, dim3(1024), dim3(256), 0, stream, (const bf16_t*)((unsigned char*)d_ws + (size_t)MK_DUMP), (float*)d_out, (size_t)NB * SEQ * D);
#endif
#else
    p.ph_lo = 0; p.ph_hi = NPHASE;
    hipLaunchKernelGGL(fwd_kernel, dim3(256), dim3(NT), LDS_BYTES, stream, p);
#endif
}
```

```cpp
#include <hip/hip_runtime.h>
#include <stdint.h>
#include <stdio.h>
#include <string.h>

#ifndef MK_PER_PHASE
#define MK_PER_PHASE 0
#endif

typedef unsigned short bf16_t;
typedef short bf16x8 __attribute__((ext_vector_type(8)));
typedef float f32x4 __attribute__((ext_vector_type(4)));
typedef unsigned u32x4 __attribute__((ext_vector_type(4)));
typedef unsigned u32x2 __attribute__((ext_vector_type(2)));
#define LAS __attribute__((address_space(3)))
#define CAS __attribute__((address_space(4)))

constexpr int D = 1024, NB = 4, SEQ = 8192, CTXL = 256, DEPTH = 4;
constexpr int NCTX = NB * CTXL;
constexpr int NROWS = NCTX + NB * SEQ;
constexpr int P_EVEN = 2848, P_ODD = 4416, LDP_EVEN = 3072, LDP_ODD = 4608;
constexpr int NEXP = 32, DEXP = 512, LISTCAP = NROWS;
constexpr float ALPHA = 1.681792830507429f;
constexpr int NT = 512;
constexpr int TCH = 32;
constexpr int NSTEPS = CTXL + SEQ;
constexpr int LDS_BYTES = 160 * 1024;

constexpr size_t al256(size_t x) { return (x + 255) & ~(size_t)255; }
constexpr size_t WS_BAR = 0;
constexpr size_t WS_CNT = 16384;
constexpr int CNT_STRIDE = 64;
constexpr size_t WS_ZERO_BYTES = 16384 + (size_t)4 * 32 * CNT_STRIDE * 4;
constexpr size_t WS_MODV = al256(WS_ZERO_BYTES);
constexpr size_t WS_LB = WS_MODV + al256((size_t)4 * 5 * 6144 * 4);
constexpr size_t WS_XC = WS_LB + al256(4 * 512 * 4);
constexpr size_t WS_WTS = WS_XC + (size_t)NCTX * D * 4;
constexpr size_t WS_LIST = WS_WTS + al256((size_t)2 * NROWS * 4);
constexpr size_t WS_WINT = WS_LIST + al256((size_t)NEXP * LISTCAP * 4);
constexpr size_t WINT_L0 = 0, WINT_L1 = (size_t)LDP_EVEN * D, WINT_L2 = WINT_L1 + (size_t)LDP_ODD * D, WINT_L3 = WINT_L2 + (size_t)LDP_EVEN * D, WINT_END = WINT_L3 + (size_t)LDP_ODD * D;
constexpr size_t WS_WOUTT = WS_WINT + WINT_END * 2;
constexpr size_t WS_LORAT = WS_WOUTT + (size_t)4 * D * D * 2;
constexpr size_t LORA_PER = (size_t)512 * 320;
constexpr size_t WS_EXPGU = WS_LORAT + al256(2 * LORA_PER * 2);
constexpr size_t WS_EXPD = WS_EXPGU + (size_t)NEXP * 1024 * 1024 * 2;
constexpr size_t WS_ACT = WS_EXPD + (size_t)NEXP * 1024 * 512 * 2;
constexpr size_t ROWB = (size_t)NROWS * D * 2;
constexpr size_t WS_FEAT = WS_ACT + ROWB;
constexpr size_t WS_YF = WS_FEAT + ROWB;
constexpr size_t WS_YB = WS_YF + ROWB;
constexpr size_t WS_P = WS_YB + ROWB;
constexpr size_t P_BYTES = (size_t)NROWS * LDP_ODD * 2;
constexpr size_t WS_YO = WS_P;
constexpr size_t WS_HID = WS_P + ROWB;
constexpr size_t WS_YP = WS_HID + ROWB;
static_assert(WS_YP + 2 * ROWB <= WS_P + P_BYTES, "MoE buffers must fit in the P region");
constexpr size_t HALFB = (size_t)NROWS * 512 * 2;
constexpr size_t WS_RWR = WS_P + P_BYTES;
constexpr size_t WS_RWK = WS_RWR + HALFB;
constexpr size_t WS_RWV = WS_RWK + HALFB;
constexpr size_t WS_RWKK = WS_RWV + HALFB;
constexpr size_t WS_RWB = WS_RWKK + HALFB;
constexpr size_t WS_RWG = WS_RWB + HALFB;
constexpr size_t WS_RWDEC = WS_RWG + HALFB;
constexpr size_t WS_LA = WS_RWDEC + (size_t)2 * NROWS * 512 * 4;
constexpr size_t WS_END = WS_LA + (size_t)NROWS * 320 * 2;
static_assert(WS_END <= (size_t)280602384 * 4, "workspace map exceeds the guaranteed ws_size");

struct Params {
    const float *x, *c, *ctx, *c_ctx, *mod_w, *mod_b, *ln_g, *ln_b;
    const float *ev_w_in, *ev_w_out, *ssd_conv_w, *ssd_conv_b, *ssd_dt_bias, *ssd_a_log, *ssd_d, *ssd_norm_w;
    const float *ml_conv_w, *ml_conv_b, *ml_i_bias, *ml_f_bias, *ml_norm_w;
    const float *od_w_in, *od_w_out, *hg_lb_logits, *hg_f_bias, *hg_norm_w;
    const float *rw_mu, *rw_w0, *rw_w2, *rw_a0, *rw_a2, *rw_g2, *rw_k_k, *rw_k_a, *rw_r_k, *rw_ln_w, *rw_ln_b;
    const float *router_w, *router_bias, *exp_w_gate, *exp_w_up, *exp_w_down;
    float* out;
    unsigned char* ws;
    int ph_lo, ph_hi, dbg, pad_;
};
typedef const CAS Params* KP;

__device__ __forceinline__ int ltid(int wv) { int l; asm volatile("v_mbcnt_lo_u32_b32 %0, -1, 0\n\tv_mbcnt_hi_u32_b32 %0, -1, %0" : "=v"(l)); return wv * 64 + l; }
__device__ __forceinline__ float bf2f(bf16_t h) { return __uint_as_float(((unsigned)h) << 16); }
__device__ __forceinline__ float bflo(unsigned u) { return __uint_as_float(u << 16); }
__device__ __forceinline__ float bfhi(unsigned u) { return __uint_as_float(u & 0xffff0000u); }
typedef __bf16 bf16v2_t __attribute__((ext_vector_type(2)));
typedef float f32x2 __attribute__((ext_vector_type(2)));
__device__ __forceinline__ unsigned pk2(float lo, float hi) { const f32x2 v = {lo, hi}; return __builtin_bit_cast(unsigned, __builtin_convertvector(v, bf16v2_t)); }
__device__ __forceinline__ bf16_t f2bf(float f) { return (bf16_t)(pk2(f, 0.f) & 0xffffu); }
__device__ __forceinline__ void unpack8(const u32x4& u, float* f) {
    f[0] = bflo(u.x); f[1] = bfhi(u.x); f[2] = bflo(u.y); f[3] = bfhi(u.y); f[4] = bflo(u.z); f[5] = bfhi(u.z); f[6] = bflo(u.w); f[7] = bfhi(u.w);
}
__device__ __forceinline__ u32x4 pack8(const float* f) { u32x4 u; u.x = pk2(f[0], f[1]); u.y = pk2(f[2], f[3]); u.z = pk2(f[4], f[5]); u.w = pk2(f[6], f[7]); return u; }
__device__ __forceinline__ float sigmoidf_(float x) { return __builtin_amdgcn_rcpf(1.f + __expf(-x)); }
__device__ __forceinline__ float siluf_(float x) { return x * __builtin_amdgcn_rcpf(1.f + __expf(-x)); }
__device__ __forceinline__ float softplus_fast(float x) { return x > 20.f ? x : __logf(1.f + __expf(x)); }
__device__ __forceinline__ float tanh_fast(float x) { return 1.f - 2.f * __builtin_amdgcn_rcpf(1.f + __expf(2.f * x)); }
__device__ __forceinline__ float softplusf_(float x) { return x > 20.f ? x : __logf(1.f + __expf(x)); }
__device__ __forceinline__ float logsigmoidf_(float x) { return fminf(x, 0.f) - __logf(1.f + __expf(-fabsf(x))); }
template <int CTRL> __device__ __forceinline__ float dppmov(float v) {
    return __builtin_bit_cast(float, __builtin_amdgcn_update_dpp(0, __builtin_bit_cast(int, v), CTRL, 0xf, 0xf, true));
}
__device__ __forceinline__ float allreduce16(float v) {
    v += dppmov<0xB1>(v);
    v += dppmov<0x4E>(v);
    v += dppmov<0x141>(v);
    v += dppmov<0x140>(v);
    return v;
}
__device__ __forceinline__ float allreduce8_(float v) { v += dppmov<0xB1>(v); v += dppmov<0x4E>(v); v += dppmov<0x141>(v); return v; }
__device__ __forceinline__ float wave_sum(float v) {
    v = allreduce16(v);
    const float r0 = __builtin_bit_cast(float, __builtin_amdgcn_readlane(__builtin_bit_cast(int, v), 0)), r1 = __builtin_bit_cast(float, __builtin_amdgcn_readlane(__builtin_bit_cast(int, v), 16));
    const float r2 = __builtin_bit_cast(float, __builtin_amdgcn_readlane(__builtin_bit_cast(int, v), 32)), r3 = __builtin_bit_cast(float, __builtin_amdgcn_readlane(__builtin_bit_cast(int, v), 48));
    return (r0 + r1) + (r2 + r3);
}
template <int W> __device__ __forceinline__ float group_sum(float v) {
    if (W == 8) return allreduce8_(v);
    return allreduce16(v);
}

#define XB_TMO      128
#define XB_XCNT(j)  (256  + 64 * (j))
#define XB_XSUB(j)  (1280 + 64 * (j))
#define XB_XGEN(j)  (2304 + 64 * (j))
#define XB_TOP      3328
#define XB_TOPGEN   3392
#define XCD_BAR_WORDS 3456
#define XB_SPIN_CAP (1u << 22)
__device__ __forceinline__ unsigned xb_ld(unsigned* p)              { return __hip_atomic_load(p, __ATOMIC_RELAXED, __HIP_MEMORY_SCOPE_AGENT); }
__device__ __forceinline__ unsigned xb_add(unsigned* p, unsigned v) { return __hip_atomic_fetch_add(p, v, __ATOMIC_RELAXED, __HIP_MEMORY_SCOPE_AGENT); }
__device__ __forceinline__ unsigned xb_xcc_id() { return (unsigned)__builtin_amdgcn_s_getreg((3 << 11) | 20) & 0xFu; }
#define XB_SPIN(cond, bar) do { unsigned _sp = 0; while (cond) { __builtin_amdgcn_s_sleep(1); \
    if ((++_sp & 255u) == 0u) { if (xb_ld(&(bar)[XB_TMO])) break; if (_sp > XB_SPIN_CAP) { atomicAdd(&(bar)[XB_TMO], 1u); break; } } } } while (0)
struct XcdBarrier { unsigned* bar; unsigned x; volatile LAS unsigned* st; };
__device__ __forceinline__ XcdBarrier xcd_barrier_post(int wv, unsigned* bar, volatile LAS unsigned* st) {
    XcdBarrier b; b.bar = bar; b.x = xb_xcc_id(); b.st = st;
    if (ltid(wv) == 0) (void)xb_add(&bar[XB_XCNT(b.x)], 1u);
    return b;
}
__device__ __forceinline__ void xcd_barrier_complete(unsigned* bar, unsigned x, unsigned& nloc, unsigned& nx) {
    const unsigned G = gridDim.x * gridDim.y * gridDim.z;
    unsigned sum, cnt, mine, sp = 0u;
    for (;;) {
        sum = 0u; cnt = 0u; mine = 0u;
#pragma unroll
        for (unsigned j = 0; j < 16; ++j) { const unsigned c = xb_ld(&bar[XB_XCNT(j)]); sum += c; cnt += (c > 0u) ? 1u : 0u; mine = (j == x) ? c : mine; }
        if (sum == G) break;
        __builtin_amdgcn_s_sleep(1);
        if ((++sp & 255u) == 0u) { if (xb_ld(&bar[XB_TMO])) break; if (sp > XB_SPIN_CAP) { atomicAdd(&bar[XB_TMO], 1u); break; } }
    }
    nloc = mine > 0u ? mine : 1u; nx = cnt > 0u ? cnt : 1u;
}
__device__ __forceinline__ void xcd_barrier(int wv, const XcdBarrier& b) {
    asm volatile("s_waitcnt vmcnt(0)" ::: "memory");
    __syncthreads();
    if (ltid(wv) == 0) {
        unsigned* bar = b.bar;
        asm volatile("" : "+s"(bar));
        __builtin_amdgcn_s_waitcnt(0);
        unsigned nloc = b.st[0], nx = b.st[1];
        if (nloc == 0u) { xcd_barrier_complete(bar, b.x, nloc, nx); b.st[0] = nloc; b.st[1] = nx; }
        const unsigned old = xb_add(&bar[XB_XSUB(b.x)], 1u);
        const unsigned gen = old / nloc;
        if (old + 1u == (gen + 1u) * nloc) {
            __builtin_amdgcn_fence(__ATOMIC_RELEASE, "agent");
            asm volatile("s_waitcnt vmcnt(0)" ::: "memory");
            const unsigned og = xb_add(&bar[XB_TOP], 1u);
            const unsigned tg = og / nx;
            if (og + 1u == (tg + 1u) * nx) xb_add(&bar[XB_TOPGEN], 1u);
            else XB_SPIN(xb_ld(&bar[XB_TOPGEN]) == tg, bar);
            __builtin_amdgcn_fence(__ATOMIC_ACQUIRE, "agent");
            xb_add(&bar[XB_XGEN(b.x)], 1u);
            asm volatile("s_waitcnt vmcnt(0)" ::: "memory");
        } else {
            XB_SPIN(xb_ld(&bar[XB_XGEN(b.x)]) == gen, bar);
            __builtin_amdgcn_fence(__ATOMIC_ACQUIRE, "agent");
            asm volatile("s_waitcnt vmcnt(0)" ::: "memory");
        }
    }
    __syncthreads();
}

__device__ __forceinline__ int row_mod(int r) { return r < NCTX ? 4 : ((r - NCTX) >> 13); }
__device__ __forceinline__ void row_seg(int r, int& t, int& len) { if (r < NCTX) { t = r & 255; len = CTXL; } else { t = (r - NCTX) & 8191; len = SEQ; } }
__device__ __forceinline__ int scan_row(int tg, int b, int dir, int odd) {
    if (tg < CTXL) { const int t = dir ? (CTXL - 1 - tg) : tg; return b * CTXL + t; }
    int sg = tg - CTXL; if (dir) sg = SEQ - 1 - sg;
    const int s = odd ? (((sg & 127) << 6) + (sg >> 7)) : sg;
    return NCTX + b * SEQ + s;
}
__device__ __forceinline__ const float* modvec(const unsigned char* ws, int layer, int m, int which) {
    return (const float*)(ws + WS_MODV) + ((size_t)(layer * 5 + m) * 6 + which) * D;
}

constexpr int G_BM = 256, G_BN = 128, G_BK = 64;
constexpr int G_ABYTES = G_BM * G_BK * 2, G_BBYTES = G_BN * G_BK * 2, G_BUF = G_ABYTES + G_BBYTES;
__device__ __forceinline__ int swz(int o) { return o ^ (((o >> 9) & 1) << 5); }

template <class RowSrc, class Epi>
__device__ __forceinline__ void gemm_tile(int wv, const bf16_t* __restrict__ A, int lda, const RowSrc& rs, const bf16_t* __restrict__ Bt, int ldb, int n0, int K, const Epi& epi, LAS char* lds) {
    const int tid = ltid(wv), lane = tid & 63, wid = tid >> 6, wm = wid >> 1, wn = wid & 1;
    const bf16_t* ap[4]; int aoff[4];
#pragma unroll
    for (int i = 0; i < 4; ++i) {
        const int c = tid + NT * i, row = c >> 3, kc = c & 7;
        ap[i] = A + (size_t)rs.src(row) * lda + kc * 8;
        aoff[i] = ((row >> 4) * 2 + (kc >> 2)) * 1024 + swz((row & 15) * 64 + (kc & 3) * 16);
    }
    const bf16_t* bp[2]; int boff[2];
#pragma unroll
    for (int i = 0; i < 2; ++i) {
        const int c = tid + NT * i, row = c >> 3, kc = c & 7;
        bp[i] = Bt + (size_t)(n0 + row) * ldb + kc * 8;
        boff[i] = G_ABYTES + ((row >> 4) * 2 + (kc >> 2)) * 1024 + swz((row & 15) * 64 + (kc & 3) * 16);
    }
    f32x4 acc[4][4];
#pragma unroll
    for (int i = 0; i < 4; ++i)
#pragma unroll
        for (int j = 0; j < 4; ++j) acc[i][j] = (f32x4){0.f, 0.f, 0.f, 0.f};
    u32x4 ra[2][4], rb[2][2];
    const int KT = K / G_BK;
    const int fragoff = swz((lane & 15) * 64 + (lane >> 4) * 16);
#define G_LOAD(set, kt_) do { _Pragma("unroll") for (int i = 0; i < 4; ++i) ra[set][i] = *(const u32x4*)(ap[i] + (kt_) * G_BK); \
                              _Pragma("unroll") for (int i = 0; i < 2; ++i) rb[set][i] = *(const u32x4*)(bp[i] + (kt_) * G_BK); } while (0)
#define G_STORE(set, buf) do { _Pragma("unroll") for (int i = 0; i < 4; ++i) *(LAS u32x4*)((buf) + aoff[i]) = ra[set][i]; \
                               _Pragma("unroll") for (int i = 0; i < 2; ++i) *(LAS u32x4*)((buf) + boff[i]) = rb[set][i]; } while (0)
#define G_COMPUTE(cur) do { bf16x8 af[2][4], bfr[2][4]; \
        _Pragma("unroll") for (int ks = 0; ks < 2; ++ks) { \
            _Pragma("unroll") for (int ni = 0; ni < 4; ++ni) bfr[ks][ni] = *(LAS bf16x8*)((cur) + G_ABYTES + ((wn * 4 + ni) * 2 + ks) * 1024 + fragoff); \
            _Pragma("unroll") for (int mi = 0; mi < 4; ++mi) af[ks][mi] = *(LAS bf16x8*)((cur) + ((wm * 4 + mi) * 2 + ks) * 1024 + fragoff); } \
        __builtin_amdgcn_sched_barrier(0); \
        _Pragma("unroll") for (int ks = 0; ks < 2; ++ks) _Pragma("unroll") for (int mi = 0; mi < 4; ++mi) _Pragma("unroll") for (int ni = 0; ni < 4; ++ni) \
            acc[mi][ni] = __builtin_amdgcn_mfma_f32_16x16x32_bf16(bfr[ks][ni], af[ks][mi], acc[mi][ni], 0, 0, 0); \
        __builtin_amdgcn_sched_barrier(0); } while (0)
    G_LOAD(0, 0);
    G_STORE(0, lds);
    if (KT > 1) G_LOAD(0, 1);
    if (KT > 2) G_LOAD(1, 2);
    __syncthreads();
    for (int kt = 0; kt < KT; kt += 2) {
        G_COMPUTE(lds);
        if (kt + 1 < KT) G_STORE(0, lds + G_BUF);
        if (kt + 3 < KT) G_LOAD(0, kt + 3);
        __syncthreads();
        if (kt + 1 < KT) {
            G_COMPUTE(lds + G_BUF);
            if (kt + 2 < KT) G_STORE(1, lds);
            if (kt + 4 < KT) G_LOAD(1, kt + 4);
            __syncthreads();
        }
    }
#undef G_LOAD
#undef G_STORE
#undef G_COMPUTE
    epi(acc, wm * 64 + (lane & 15), wn * 64 + 4 * (lane >> 4));
}

constexpr int G2_BN = 256, G2_BBYTES = G2_BN * G_BK * 2, G2_BUF = G_ABYTES + G2_BBYTES;

struct RowLinear { int m0; __device__ __forceinline__ int src(int r) const { return m0 + r; } };
struct RowList {
    const int* list; int cnt; int shift;
    __device__ __forceinline__ int src(int r) const { const int a = list[r < cnt ? r : 0]; return a >> shift; }
};
struct EpiStoreBf16 {
    bf16_t* C; int ldc; int m0; int n0; int N;
    template <int NI> __device__ __forceinline__ void operator()(const f32x4 (&acc)[4][NI], int rbase, int cbase) const {
#pragma unroll
        for (int mi = 0; mi < 4; ++mi) {
            bf16_t* rowp = C + (size_t)(m0 + rbase + mi * 16) * ldc + n0 + cbase;
#pragma unroll
            for (int ni = 0; ni < NI; ++ni) {
                if (n0 + cbase + ni * 16 < N) { u32x2 v; v.x = pk2(acc[mi][ni][0], acc[mi][ni][1]); v.y = pk2(acc[mi][ni][2], acc[mi][ni][3]); *(u32x2*)(rowp + ni * 16) = v; }
            }
        }
    }
};
struct EpiSwiGLU {
    bf16_t* H; const int* list; int cnt; int n0;
    template <int NI> __device__ __forceinline__ void operator()(const f32x4 (&acc)[4][NI], int rbase, int cbase) const {
#pragma unroll
        for (int mi = 0; mi < 4; ++mi) {
            const int r = rbase + mi * 16;
            if (r < cnt) {
                const int a = list[r];
                const int wnb = cbase & ~63, q4 = cbase & 63;
                bf16_t* rowp = H + (size_t)a * DEXP + ((n0 + wnb) >> 1) + q4;
#pragma unroll
                for (int q = 0; q < NI / 2; ++q) {
                    float o[4];
#pragma unroll
                    for (int j = 0; j < 4; ++j) o[j] = siluf_(acc[mi][2 * q][j]) * acc[mi][2 * q + 1][j];
                    u32x2 v; v.x = pk2(o[0], o[1]); v.y = pk2(o[2], o[3]); *(u32x2*)(rowp + q * 16) = v;
                }
            }
        }
    }
};
struct EpiScatterBf16 {
    bf16_t* C; const int* list; int cnt; int n0;
    template <int NI> __device__ __forceinline__ void operator()(const f32x4 (&acc)[4][NI], int rbase, int cbase) const {
#pragma unroll
        for (int mi = 0; mi < 4; ++mi) {
            const int r = rbase + mi * 16;
            if (r < cnt) {
                bf16_t* rowp = C + (size_t)list[r] * D + n0 + cbase;
#pragma unroll
                for (int ni = 0; ni < NI; ++ni) { u32x2 v; v.x = pk2(acc[mi][ni][0], acc[mi][ni][1]); v.y = pk2(acc[mi][ni][2], acc[mi][ni][3]); *(u32x2*)(rowp + ni * 16) = v; }
            }
        }
    }
};
struct EpiDecay {
    float* Dc; const float* w0; int m0; int n0;
    template <int NI> __device__ __forceinline__ void operator()(const f32x4 (&acc)[4][NI], int rbase, int cbase) const {
#pragma unroll
        for (int ni = 0; ni < NI; ++ni) {
            const int col = n0 + cbase + ni * 16;
            const f32x4 w0v = *(const f32x4*)(w0 + col);
#pragma unroll
            for (int mi = 0; mi < 4; ++mi) {
                f32x4 o;
#pragma unroll
                for (int j = 0; j < 4; ++j) { const float w = w0v[j] + acc[mi][ni][j]; o[j] = __expf(-__expf(-softplus_fast(-w) - 0.5f)); }
                *(f32x4*)(Dc + (size_t)(m0 + rbase + mi * 16) * 512 + col) = o;
            }
        }
    }
};
struct EpiAK {
    bf16_t* Kb; const bf16_t* KKb; bf16_t* Bb; const float* a0; const float* k_a; int m0; int n0;
    template <int NI> __device__ __forceinline__ void operator()(const f32x4 (&acc)[4][NI], int rbase, int cbase) const {
#pragma unroll
        for (int ni = 0; ni < NI; ++ni) {
            const int col = n0 + cbase + ni * 16;
            const f32x4 a0v = *(const f32x4*)(a0 + col), kav = *(const f32x4*)(k_a + col);
#pragma unroll
            for (int mi = 0; mi < 4; ++mi) {
                const size_t off = (size_t)(m0 + rbase + mi * 16) * 512 + col;
                const u32x2 kr = *(const u32x2*)(Kb + off), kkr = *(const u32x2*)(KKb + off);
                const float kf[4] = {bflo(kr.x), bfhi(kr.x), bflo(kr.y), bfhi(kr.y)}, kkf[4] = {bflo(kkr.x), bfhi(kkr.x), bflo(kkr.y), bfhi(kkr.y)};
                float k2[4], bb[4];
#pragma unroll
                for (int j = 0; j < 4; ++j) { const float a = sigmoidf_(a0v[j] + acc[mi][ni][j]); k2[j] = kf[j] * (1.f + (a - 1.f) * kav[j]); bb[j] = kkf[j] * a; }
                u32x2 v; v.x = pk2(k2[0], k2[1]); v.y = pk2(k2[2], k2[3]); *(u32x2*)(Kb + off) = v;
                v.x = pk2(bb[0], bb[1]); v.y = pk2(bb[2], bb[3]); *(u32x2*)(Bb + off) = v;
            }
        }
    }
};

namespace pg8 {
#define PG8_LAS __attribute__((address_space(3)))
constexpr int BM = 256, BK = 64, HALF = 128, HTB = HALF * BK * 2, STAGE_BYTES = 8 * HTB, NXCD = 8, WGM = 8;
__host__ __device__ __forceinline__ int lds_byte(int r, int c) { const int st = (r >> 4) * 2 + (c >> 5), rr = r & 15, cc = c & 31, ob = rr * 64 + cc * 2; return st * 1024 + (ob ^ (((ob >> 9) & 1) << 5)); }
__host__ __device__ __forceinline__ void stage_rc(int b, int& R, int& C) { const int st = b / 1024, sb = b % 1024, swz = sb ^ (((sb >> 9) & 1) << 5); R = (st >> 1) * 16 + swz / 64; C = (st & 1) * 32 + (swz % 64) / 2; }
__host__ __device__ __forceinline__ int perm32(int rho) { const int n = rho >> 4, i = rho & 15; return 8 * (i >> 2) + 4 * n + (i & 3); }
struct Unit { int pm, pn; };
struct Gemm { const bf16_t* A; const bf16_t* Bt; int M, N, K; };
struct StaticOrder {
    int nM, nN, nwg, G, c;
    __host__ __device__ void init(int M, int N, int G_, int c_) { nM = M / BM; nN = N / BM; nwg = nM * nN; G = G_; c = c_; }
    __host__ __device__ bool next(int i, Unit& u) const {
        const long L = (long)i * G + c; if (L >= nwg) return false;
        int wgid = (int)L; { const int q = nwg / NXCD, r = nwg % NXCD, xcd = wgid % NXCD, off = wgid / NXCD; wgid = (xcd < r ? xcd * (q + 1) : r * (q + 1) + (xcd - r) * q) + off; }
        const int nig = WGM * nN, gid = wgid / nig, fm = gid * WGM, gsz = (nM - fm) < WGM ? (nM - fm) : WGM;
        u.pm = fm + ((wgid % nig) % gsz); u.pn = (wgid % nig) / gsz; return true;
    }
    __device__ __forceinline__ void a_ready(const Unit&) const {}
    __device__ __forceinline__ void done(const Unit&) const {}
};
struct EpiStoreP {
    static constexpr bool PERM = true, AFTER_DRAIN = false;
    bf16_t* O; int ldc;
    __device__ __forceinline__ void operator()(const f32x4 (&acc)[2][2][4][2], const Unit& u, int wr, int wc, int fr, int fq) const {
        const int row0 = u.pm * BM + wr * 64 + fr, col0 = u.pn * BM + wc * 32 + 8 * fq;
#pragma unroll
        for (int ai = 0; ai < 2; ++ai)
#pragma unroll
            for (int m = 0; m < 4; ++m) { bf16_t* rowp = O + (size_t)(row0 + ai * HALF + m * 16) * ldc + col0;
#pragma unroll
                for (int bj = 0; bj < 2; ++bj) { const f32x4 v0 = acc[ai][bj][m][0], v1 = acc[ai][bj][m][1];
                    u32x4 w; w.x = pk2(v0[0], v0[1]); w.y = pk2(v0[2], v0[3]); w.z = pk2(v1[0], v1[1]); w.w = pk2(v1[2], v1[3]);
                    *(u32x4*)(rowp + bj * HALF) = w; } }
    }
};
template <class Epi, class Sched>
__device__ __forceinline__ void gemm_phase(int wv, PG8_LAS unsigned char* lds, const Gemm g, const Sched& S, const Epi& E) {
    const int tid = ltid(wv), wid = __builtin_amdgcn_readfirstlane(tid >> 6), lane = tid & 63, wr = wid >> 2, wc = wid & 3, fr = lane & 15, fq = lane >> 4;
    const int K = g.K, nt = K / BK;
    unsigned voffA[2], voffB[2];
#pragma unroll
    for (int i = 0; i < 2; ++i) { int R, C; stage_rc(tid * 16 + i * 8192, R, C); const int Rb = Epi::PERM ? ((R & ~31) + perm32(R & 31)) : R;
        voffA[i] = (unsigned)(R * K + C) * 2u; voffB[i] = (unsigned)(Rb * K + C) * 2u; }
    const size_t kstep = (size_t)(BK * 2);
    const size_t hstep = (size_t)HALF * K * 2;
    const size_t tstep = 2 * hstep;
    const unsigned ldsw = (unsigned)wid * 1024u;
    const int aoff = lds_byte(wr * 64 + fr, fq * 8), boff = lds_byte(wc * 32 + fr, fq * 8);
#define PG8_SA(b, h) (((b) * 2 + (h)) * HTB)
#define PG8_SB(b, h) ((4 + (b) * 2 + (h)) * HTB)
#define PG8_STAGE(bufoff, gbase, voff) do { _Pragma("unroll") for (int _i = 0; _i < 2; ++_i) \
        __builtin_amdgcn_global_load_lds((const unsigned*)((const char*)(gbase) + (voff)[_i]), (PG8_LAS unsigned*)(lds + (bufoff) + ldsw + _i * 8192), 16, 0, 0); } while (0)
#define PG8_LDA(dst, b, h) do { _Pragma("unroll") for (int m = 0; m < 4; ++m) _Pragma("unroll") for (int k = 0; k < 2; ++k) dst[m][k] = *(const PG8_LAS bf16x8*)(lds + PG8_SA(b, h) + aoff + m * 2048 + k * 1024); } while (0)
#define PG8_LDB(dst, b, h) do { _Pragma("unroll") for (int n = 0; n < 2; ++n) _Pragma("unroll") for (int k = 0; k < 2; ++k) dst[n][k] = *(const PG8_LAS bf16x8*)(lds + PG8_SB(b, h) + boff + n * 2048 + k * 1024); } while (0)
#define PG8_MMA(ai, bj, At, Bt) do { __builtin_amdgcn_s_setprio(1); _Pragma("unroll") for (int m = 0; m < 4; ++m) _Pragma("unroll") for (int n = 0; n < 2; ++n) _Pragma("unroll") for (int k = 0; k < 2; ++k) \
        acc[ai][bj][m][n] = __builtin_amdgcn_mfma_f32_16x16x32_bf16(Bt[n][k], At[m][k], acc[ai][bj][m][n], 0, 0, 0); __builtin_amdgcn_s_setprio(0); } while (0)
#define PG8_WAIT_V(n) asm volatile("s_waitcnt vmcnt(" #n ")" ::: "memory")
#define PG8_WAIT_L(n) asm volatile("s_waitcnt lgkmcnt(" #n ")" ::: "memory")
#define PG8_BAR __builtin_amdgcn_s_barrier()
#define PG8_SCHED __builtin_amdgcn_sched_barrier(0)
    Unit cur, nxt; int ui = 0;
    if (!S.next(0, cur)) return;
    f32x4 acc[2][2][4][2];
#pragma unroll
    for (int a = 0; a < 2; ++a)
#pragma unroll
        for (int b = 0; b < 2; ++b)
#pragma unroll
            for (int m = 0; m < 4; ++m)
#pragma unroll
                for (int n = 0; n < 2; ++n) acc[a][b][m][n] = (f32x4){0.f, 0.f, 0.f, 0.f};
    bf16x8 At[4][2], B0[2][2], B1[2][2];
    const char* cA = (const char*)g.A + (size_t)cur.pm * tstep; const char* cB = (const char*)g.Bt + (size_t)cur.pn * tstep;
    S.a_ready(cur);
    PG8_STAGE(PG8_SB(0, 0), cB, voffB); PG8_STAGE(PG8_SA(0, 0), cA, voffA); PG8_STAGE(PG8_SB(0, 1), cB + hstep, voffB); PG8_STAGE(PG8_SA(0, 1), cA + hstep, voffA);
    if (wr == 1) PG8_BAR;
    PG8_WAIT_V(4); PG8_BAR;
    PG8_STAGE(PG8_SB(1, 0), cB + kstep, voffB); PG8_STAGE(PG8_SA(1, 0), cA + kstep, voffA); PG8_STAGE(PG8_SB(1, 1), cB + hstep + kstep, voffB);
    PG8_WAIT_V(6); PG8_BAR;
    for (;;) {
        const bool has_next = S.next(ui + 1, nxt);
        const char* nA = has_next ? (const char*)g.A + (size_t)nxt.pm * tstep : cA; const char* nB = has_next ? (const char*)g.Bt + (size_t)nxt.pn * tstep : cB;
        for (int t = 0; t < nt; t += 2) {
            const bool last = (t == nt - 2);
            const char* a1 = cA + (size_t)(t + 1) * kstep;
            const char* a2 = last ? nA : cA + (size_t)(t + 2) * kstep; const char* b2 = last ? nB : cB + (size_t)(t + 2) * kstep;
            const char* a3 = a2 + kstep; const char* b3 = b2 + kstep;
            if (last && has_next) S.a_ready(nxt);
            PG8_LDB(B0, 0, 0); PG8_SCHED; PG8_LDA(At, 0, 0); PG8_STAGE(PG8_SA(1, 1), a1 + hstep, voffA);
            PG8_WAIT_L(8); PG8_BAR; PG8_WAIT_L(0); PG8_MMA(0, 0, At, B0); PG8_BAR; PG8_SCHED;
            PG8_LDB(B1, 0, 1); PG8_STAGE(PG8_SB(0, 0), b2, voffB);
            PG8_BAR; PG8_WAIT_L(0); PG8_MMA(0, 1, At, B1); PG8_BAR;
            PG8_LDA(At, 0, 1); PG8_STAGE(PG8_SA(0, 0), a2, voffA);
            PG8_BAR; PG8_WAIT_L(0); PG8_MMA(1, 0, At, B0); PG8_BAR; PG8_SCHED;
            PG8_STAGE(PG8_SB(0, 1), b2 + hstep, voffB);
            PG8_WAIT_V(6); PG8_BAR; PG8_MMA(1, 1, At, B1); PG8_BAR;
            PG8_LDB(B0, 1, 0); PG8_SCHED; PG8_LDA(At, 1, 0); PG8_STAGE(PG8_SA(0, 1), a2 + hstep, voffA);
            PG8_WAIT_L(8); PG8_BAR; PG8_WAIT_L(0); PG8_MMA(0, 0, At, B0); PG8_BAR; PG8_SCHED;
            PG8_LDB(B1, 1, 1); PG8_STAGE(PG8_SB(1, 0), b3, voffB);
            PG8_BAR; PG8_WAIT_L(0); PG8_MMA(0, 1, At, B1); PG8_BAR;
            PG8_LDA(At, 1, 1); PG8_STAGE(PG8_SA(1, 0), a3, voffA);
            PG8_BAR; PG8_WAIT_L(0); PG8_MMA(1, 0, At, B0); PG8_BAR; PG8_SCHED;
            PG8_STAGE(PG8_SB(1, 1), b3 + hstep, voffB);
            PG8_WAIT_V(6); PG8_BAR; PG8_MMA(1, 1, At, B1); PG8_BAR;
        }
            if constexpr (!Epi::AFTER_DRAIN) { E(acc, cur, wr, wc, fr, fq); S.done(cur); }
            if (!has_next) break;
#pragma unroll
        for (int a = 0; a < 2; ++a)
#pragma unroll
            for (int b = 0; b < 2; ++b)
#pragma unroll
                for (int m = 0; m < 4; ++m)
#pragma unroll
                    for (int n = 0; n < 2; ++n) acc[a][b][m][n] = (f32x4){0.f, 0.f, 0.f, 0.f};
        cur = nxt; cA = nA; cB = nB; ++ui;
    }
    PG8_WAIT_V(0);
    if (wr == 0) PG8_BAR;
    PG8_BAR;
    if constexpr (Epi::AFTER_DRAIN) { E.fused(acc, cur, wr, wc, fr, fq, lds, wid, lane); S.done(cur); }
#undef PG8_SA
#undef PG8_SB
#undef PG8_STAGE
#undef PG8_LDA
#undef PG8_LDB
#undef PG8_MMA
#undef PG8_WAIT_V
#undef PG8_WAIT_L
#undef PG8_BAR
#undef PG8_SCHED
}
struct UnitG { int pm, pn; const char* bbase; const PG8_LAS int* ltab; int cnt; int e; };
struct MoeOrder {
    const PG8_LAS int* tstart; const PG8_LAS int* tcnt; const PG8_LAS int* ltabs; const int* lists; const char* bt; size_t estride; int ncol, shift, G, c;
    __device__ __forceinline__ bool next(int i, UnitG& u) const {
        const int t = i * G + c; if (t >= tstart[32] * ncol) return false;
        const int tm = t / ncol; int e = 0;
#pragma unroll 1
        while (tstart[e + 1] <= tm) ++e;
        e = __builtin_amdgcn_readfirstlane(e);
        const int ts = __builtin_amdgcn_readfirstlane(tstart[e]), tc = __builtin_amdgcn_readfirstlane(tcnt[e]);
        u.pm = tm - ts; u.pn = t - tm * ncol; u.bbase = bt + (size_t)e * estride; u.e = e; u.cnt = tc - u.pm * BM; u.ltab = ltabs + i * BM;
        return true;
    }
    __device__ __forceinline__ void a_ready(const UnitG&) const {}
    __device__ __forceinline__ void done(const UnitG&) const {}
};
struct EpiSwiGLUG {
    static constexpr bool PERM = false, AFTER_DRAIN = false;
    bf16_t* H;
    __device__ __forceinline__ void operator()(const f32x4 (&acc)[2][2][4][2], const UnitG& u, int wr, int wc, int fr, int fq) const {
#pragma unroll
        for (int ai = 0; ai < 2; ++ai)
#pragma unroll
            for (int m = 0; m < 4; ++m) { const int r = ai * HALF + wr * 64 + m * 16 + fr;
                if (r < u.cnt) { bf16_t* rowp = H + (size_t)u.ltab[r] * DEXP + ((u.pn * BM + wc * 32) >> 1) + 4 * fq;
#pragma unroll
                    for (int bj = 0; bj < 2; ++bj) { const f32x4 gt = acc[ai][bj][m][0], up = acc[ai][bj][m][1];
                        u32x2 w; w.x = pk2(siluf_(gt[0]) * up[0], siluf_(gt[1]) * up[1]); w.y = pk2(siluf_(gt[2]) * up[2], siluf_(gt[3]) * up[3]);
                        *(u32x2*)(rowp + bj * (HALF / 2)) = w; } } }
    }
};
struct EpiScatterG {
    static constexpr bool PERM = true, AFTER_DRAIN = false;
    bf16_t* O;
    __device__ __forceinline__ void operator()(const f32x4 (&acc)[2][2][4][2], const UnitG& u, int wr, int wc, int fr, int fq) const {
#pragma unroll
        for (int ai = 0; ai < 2; ++ai)
#pragma unroll
            for (int m = 0; m < 4; ++m) { const int r = ai * HALF + wr * 64 + m * 16 + fr;
                if (r < u.cnt) { bf16_t* rowp = O + (size_t)u.ltab[r] * D + u.pn * BM + wc * 32 + 8 * fq;
#pragma unroll
                    for (int bj = 0; bj < 2; ++bj) { const f32x4 v0 = acc[ai][bj][m][0], v1 = acc[ai][bj][m][1];
                        u32x4 w; w.x = pk2(v0[0], v0[1]); w.y = pk2(v0[2], v0[3]); w.z = pk2(v1[0], v1[1]); w.w = pk2(v1[2], v1[3]);
                        *(u32x4*)(rowp + bj * HALF) = w; } } }
    }
};
template <class Epi, class Sched>
__device__ __forceinline__ void gemm_phase_g(int wv, PG8_LAS unsigned char* lds, const Gemm g, const Sched& S, const Epi& E) {
    const int tid = ltid(wv), wid = __builtin_amdgcn_readfirstlane(tid >> 6), lane = tid & 63, wr = wid >> 2, wc = wid & 3, fr = lane & 15, fq = lane >> 4;
    const int K = g.K, nt = K / BK;
    unsigned voffB[2];
#pragma unroll
    for (int i = 0; i < 2; ++i) { int R, C; stage_rc(tid * 16 + i * 8192, R, C); const int Rb = Epi::PERM ? ((R & ~31) + perm32(R & 31)) : R;
        voffB[i] = (unsigned)(Rb * K + C) * 2u; }
    const unsigned rowb = (unsigned)K * 2u;
#define PG8_AOFFS(u, dst) do { const int _t = ltid(wv); _Pragma("unroll") for (int _i = 0; _i < 2; ++_i) { int _R, _C; stage_rc(_t * 16 + _i * 8192, _R, _C); \
        _Pragma("unroll") for (int _h = 0; _h < 2; ++_h) dst[_h][_i] = (unsigned)((u).ltab[_h * HALF + _R] >> S.shift) * rowb + (unsigned)(_C * 2); } } while (0)
#define PG8_STAGE_A(bufoff, AO, koff) do { _Pragma("unroll") for (int _i = 0; _i < 2; ++_i) \
        __builtin_amdgcn_global_load_lds((const unsigned*)((const char*)g.A + (size_t)(AO)[_i] + (size_t)(koff)), (PG8_LAS unsigned*)(lds + (bufoff) + ldsw + _i * 8192), 16, 0, 0); } while (0)
    const size_t kstep = (size_t)(BK * 2);
    const size_t hstep = (size_t)HALF * K * 2;
    const size_t tstep = 2 * hstep;
    const unsigned ldsw = (unsigned)wid * 1024u;
    const int aoff = lds_byte(wr * 64 + fr, fq * 8), boff = lds_byte(wc * 32 + fr, fq * 8);
#define PG8_SA(b, h) (((b) * 2 + (h)) * HTB)
#define PG8_SB(b, h) ((4 + (b) * 2 + (h)) * HTB)
#define PG8_STAGE(bufoff, gbase, voff) do { _Pragma("unroll") for (int _i = 0; _i < 2; ++_i) \
        __builtin_amdgcn_global_load_lds((const unsigned*)((const char*)(gbase) + (voff)[_i]), (PG8_LAS unsigned*)(lds + (bufoff) + ldsw + _i * 8192), 16, 0, 0); } while (0)
#define PG8_LDA(dst, b, h) do { _Pragma("unroll") for (int m = 0; m < 4; ++m) _Pragma("unroll") for (int k = 0; k < 2; ++k) dst[m][k] = *(const PG8_LAS bf16x8*)(lds + PG8_SA(b, h) + aoff + m * 2048 + k * 1024); } while (0)
#define PG8_LDB(dst, b, h) do { _Pragma("unroll") for (int n = 0; n < 2; ++n) _Pragma("unroll") for (int k = 0; k < 2; ++k) dst[n][k] = *(const PG8_LAS bf16x8*)(lds + PG8_SB(b, h) + boff + n * 2048 + k * 1024); } while (0)
#define PG8_MMA(ai, bj, At, Bt) do { __builtin_amdgcn_s_setprio(1); _Pragma("unroll") for (int m = 0; m < 4; ++m) _Pragma("unroll") for (int n = 0; n < 2; ++n) _Pragma("unroll") for (int k = 0; k < 2; ++k) \
        acc[ai][bj][m][n] = __builtin_amdgcn_mfma_f32_16x16x32_bf16(Bt[n][k], At[m][k], acc[ai][bj][m][n], 0, 0, 0); __builtin_amdgcn_s_setprio(0); } while (0)
#define PG8_WAIT_V(n) asm volatile("s_waitcnt vmcnt(" #n ")" ::: "memory")
#define PG8_WAIT_L(n) asm volatile("s_waitcnt lgkmcnt(" #n ")" ::: "memory")
#define PG8_BAR __builtin_amdgcn_s_barrier()
#define PG8_SCHED __builtin_amdgcn_sched_barrier(0)
    UnitG cur, nxt; int ui = 0;
    if (!S.next(0, cur)) return;
    f32x4 acc[2][2][4][2];
#pragma unroll
    for (int a = 0; a < 2; ++a)
#pragma unroll
        for (int b = 0; b < 2; ++b)
#pragma unroll
            for (int m = 0; m < 4; ++m)
#pragma unroll
                for (int n = 0; n < 2; ++n) acc[a][b][m][n] = (f32x4){0.f, 0.f, 0.f, 0.f};
    bf16x8 At[4][2], B0[2][2], B1[2][2];
    unsigned ca[2][2]; PG8_AOFFS(cur, ca); const char* cB = cur.bbase + (size_t)cur.pn * tstep;
    S.a_ready(cur);
    PG8_STAGE(PG8_SB(0, 0), cB, voffB); PG8_STAGE_A(PG8_SA(0, 0), ca[0], 0); PG8_STAGE(PG8_SB(0, 1), cB + hstep, voffB); PG8_STAGE_A(PG8_SA(0, 1), ca[1], 0);
    if (wr == 1) PG8_BAR;
    PG8_WAIT_V(4); PG8_BAR;
    PG8_STAGE(PG8_SB(1, 0), cB + kstep, voffB); PG8_STAGE_A(PG8_SA(1, 0), ca[0], kstep); PG8_STAGE(PG8_SB(1, 1), cB + hstep + kstep, voffB);
    PG8_WAIT_V(6); PG8_BAR;
    for (;;) {
        const bool has_next = S.next(ui + 1, nxt);
        const char* nB = has_next ? nxt.bbase + (size_t)nxt.pn * tstep : cB;
        for (int t = 0; t < nt; t += 2) {
            const bool last = (t == nt - 2);
            const size_t k1 = (size_t)(t + 1) * kstep, k2 = last ? 0 : (size_t)(t + 2) * kstep;
            unsigned a2o[2][2];
            if (last && has_next) PG8_AOFFS(nxt, a2o); else { a2o[0][0] = ca[0][0]; a2o[0][1] = ca[0][1]; a2o[1][0] = ca[1][0]; a2o[1][1] = ca[1][1]; }
            const char* b2 = last ? nB : cB + (size_t)(t + 2) * kstep; const char* b3 = b2 + kstep;
            if (last && has_next) S.a_ready(nxt);
            PG8_LDB(B0, 0, 0); PG8_SCHED; PG8_LDA(At, 0, 0); PG8_STAGE_A(PG8_SA(1, 1), ca[1], k1);
            PG8_WAIT_L(8); PG8_BAR; PG8_WAIT_L(0); PG8_MMA(0, 0, At, B0); PG8_BAR; PG8_SCHED;
            PG8_LDB(B1, 0, 1); PG8_STAGE(PG8_SB(0, 0), b2, voffB);
            PG8_BAR; PG8_WAIT_L(0); PG8_MMA(0, 1, At, B1); PG8_BAR;
            PG8_LDA(At, 0, 1); PG8_STAGE_A(PG8_SA(0, 0), a2o[0], k2);
            PG8_BAR; PG8_WAIT_L(0); PG8_MMA(1, 0, At, B0); PG8_BAR; PG8_SCHED;
            PG8_STAGE(PG8_SB(0, 1), b2 + hstep, voffB);
            PG8_WAIT_V(6); PG8_BAR; PG8_MMA(1, 1, At, B1); PG8_BAR;
            PG8_LDB(B0, 1, 0); PG8_SCHED; PG8_LDA(At, 1, 0); PG8_STAGE_A(PG8_SA(0, 1), a2o[1], k2);
            PG8_WAIT_L(8); PG8_BAR; PG8_WAIT_L(0); PG8_MMA(0, 0, At, B0); PG8_BAR; PG8_SCHED;
            PG8_LDB(B1, 1, 1); PG8_STAGE(PG8_SB(1, 0), b3, voffB);
            PG8_BAR; PG8_WAIT_L(0); PG8_MMA(0, 1, At, B1); PG8_BAR;
            PG8_LDA(At, 1, 1); PG8_STAGE_A(PG8_SA(1, 0), a2o[0], k2 + kstep);
            PG8_BAR; PG8_WAIT_L(0); PG8_MMA(1, 0, At, B0); PG8_BAR; PG8_SCHED;
            PG8_STAGE(PG8_SB(1, 1), b3 + hstep, voffB);
            PG8_WAIT_V(6); PG8_BAR; PG8_MMA(1, 1, At, B1); PG8_BAR;
            if (last) { ca[0][0] = a2o[0][0]; ca[0][1] = a2o[0][1]; ca[1][0] = a2o[1][0]; ca[1][1] = a2o[1][1]; }
        }
            if constexpr (!Epi::AFTER_DRAIN) { E(acc, cur, wr, wc, fr, fq); S.done(cur); }
            if (!has_next) break;
#pragma unroll
        for (int a = 0; a < 2; ++a)
#pragma unroll
            for (int b = 0; b < 2; ++b)
#pragma unroll
                for (int m = 0; m < 4; ++m)
#pragma unroll
                    for (int n = 0; n < 2; ++n) acc[a][b][m][n] = (f32x4){0.f, 0.f, 0.f, 0.f};
        cur = nxt; cB = nB; ++ui;
    }
    PG8_WAIT_V(0);
    if (wr == 0) PG8_BAR;
    PG8_BAR;
    if constexpr (Epi::AFTER_DRAIN) { E.fused(acc, cur, wr, wc, fr, fq, lds, wid, lane); S.done(cur); }
#undef PG8_SA
#undef PG8_AOFFS
#undef PG8_STAGE_A
#undef PG8_SB
#undef PG8_STAGE
#undef PG8_LDA
#undef PG8_LDB
#undef PG8_MMA
#undef PG8_WAIT_V
#undef PG8_WAIT_L
#undef PG8_BAR
#undef PG8_SCHED
}
}

__device__ __forceinline__ void transpose_item(const float* __restrict__ W, int K, int N, bf16_t* __restrict__ WT, int mode, LAS float* scr, int item, int lane) {
    const int nblk = N / 32, kb = item / nblk, nb = item % nblk, k0 = 64 * kb, n0 = 32 * nb;
    {
        const float* wp = W + (size_t)(k0 + (lane >> 5)) * N + n0 + (lane & 31);
        float t[32];
#pragma unroll
        for (int i = 0; i < 32; ++i) t[i] = wp[(size_t)(2 * i) * N];
#pragma unroll
        for (int i = 0; i < 32; ++i) scr[(2 * i + (lane >> 5)) * 33 + (lane & 31)] = t[i];
    }
    asm volatile("s_waitcnt lgkmcnt(0)" ::: "memory");
    const int c = lane & 7;
#pragma unroll
    for (int j = 0; j < 4; ++j) {
        const int nl = (lane >> 3) + 8 * j; const LAS float* s = scr + (8 * c) * 33 + nl;
        u32x4 o; o.x = pk2(s[0 * 33], s[1 * 33]); o.y = pk2(s[2 * 33], s[3 * 33]); o.z = pk2(s[4 * 33], s[5 * 33]); o.w = pk2(s[6 * 33], s[7 * 33]);
        const int n = n0 + nl;
        const int nd = mode == 0 ? n : (32 * (n >> 4) + (n & 15) + (mode == 2 ? 16 : 0));
        *(u32x4*)(WT + (size_t)nd * K + k0 + 8 * c) = o;
    }
    asm volatile("s_waitcnt lgkmcnt(0)" ::: "memory");
}

constexpr int EXC_IG = 16 * 16, EXC_IDN = 8 * 32, EXC_PER = 2 * EXC_IG + EXC_IDN, EXC_ITEMS = NEXP * EXC_PER;
__device__ __forceinline__ int exc_s0(int layer) { return (layer & 1) ? 8192 : 10240; }
__device__ __forceinline__ int exc_s1(int layer) { return layer == DEPTH - 1 ? 0 : 7168; }
__device__ __forceinline__ void expconv_items(const CAS Params& P, int layer, LAS char* lds, int lo, int hi, int worker, int nworkers, int wid, int lane) {
    LAS float* scr = (LAS float*)(lds + wid * 8448);
    bf16_t* gu = (bf16_t*)(P.ws + WS_EXPGU); bf16_t* dw = (bf16_t*)(P.ws + WS_EXPD);
    for (int it = lo + worker; it < hi; it += nworkers) {
        const int e = it / EXC_PER; int r = it % EXC_PER;
        const size_t eo = (size_t)(layer * NEXP + e);
        if (r < EXC_IG) { transpose_item(P.exp_w_gate + eo * D * DEXP, D, DEXP, gu + (size_t)e * 1024 * 1024, 1, scr, r, lane); continue; } r -= EXC_IG;
        if (r < EXC_IG) { transpose_item(P.exp_w_up + eo * D * DEXP, D, DEXP, gu + (size_t)e * 1024 * 1024, 2, scr, r, lane); continue; } r -= EXC_IG;
        transpose_item(P.exp_w_down + eo * DEXP * D, DEXP, D, dw + (size_t)e * 1024 * 512, 0, scr, r, lane);
    }
}
__device__ __forceinline__ void expconv_tail(int wv, const CAS Params& P, int layer, LAS char* lds, int nwg, int lo, int hi) {
    const int G = gridDim.x, rem = nwg % G;
    if (rem != 0 && (int)blockIdx.x >= rem && lo < hi) {
        const int tid = ltid(wv);
        __syncthreads();
        expconv_items(P, layer, lds, lo, hi, ((int)blockIdx.x - rem) * 8 + (tid >> 6), (G - rem) * 8, tid >> 6, tid & 63);
    }
}

__device__ __forceinline__ void phase_prologue0(int wv, KP Pk, LAS char* lds) {
    asm volatile("" : "+s"(Pk));
    const CAS Params& P = *Pk;
    const int tid = ltid(wv), lane = tid & 63, wid = tid >> 6;
    const int gw = blockIdx.x * 8 + wid, NGW = gridDim.x * 8;
    LAS float* scr = (LAS float*)(lds + wid * 8448);
    bf16_t* winT = (bf16_t*)(P.ws + WS_WINT);
    bf16_t* woutT = (bf16_t*)(P.ws + WS_WOUTT);
    bf16_t* loraT = (bf16_t*)(P.ws + WS_LORAT);
    constexpr int I_EV = 16 * (P_EVEN / 32), I_OD = 16 * (P_ODD / 32), I_O = 16 * 32, I_L64 = 16, I_L128 = 32;
    constexpr int I_LORA = 3 * I_L64 + I_L128;
    constexpr int NIT = 2 * I_EV + 2 * I_OD + 4 * I_O + 2 * I_LORA;
    for (int it = gw; it < NIT; it += NGW) {
        int r = it;
        if (r < 2 * I_EV) { const int i = r / I_EV; transpose_item(P.ev_w_in + (size_t)i * D * P_EVEN, D, P_EVEN, winT + (i ? WINT_L2 : WINT_L0), 0, scr, r % I_EV, lane); continue; } r -= 2 * I_EV;
        if (r < 2 * I_OD) { const int i = r / I_OD; transpose_item(P.od_w_in + (size_t)i * D * P_ODD, D, P_ODD, winT + (i ? WINT_L3 : WINT_L1), 0, scr, r % I_OD, lane); continue; } r -= 2 * I_OD;
        if (r < 4 * I_O) { const int l = r / I_O; const float* src = (l & 1) ? P.od_w_out + (size_t)(l >> 1) * D * D : P.ev_w_out + (size_t)(l >> 1) * D * D;
            transpose_item(src, D, D, woutT + (size_t)l * D * D, 0, scr, r % I_O, lane); continue; } r -= 4 * I_O;
        { const int i = r / I_LORA; int q = r % I_LORA; bf16_t* dst = loraT + (size_t)i * LORA_PER;
          if (q < I_L64) { transpose_item(P.rw_w2 + (size_t)(i * 2 + 0) * 64 * 512, 64, 512, dst, 0, scr, q, lane); continue; } q -= I_L64;
          if (q < I_L64) { transpose_item(P.rw_w2 + (size_t)(i * 2 + 1) * 64 * 512, 64, 512, dst + 512 * 64, 0, scr, q, lane); continue; } q -= I_L64;
          if (q < I_L64) { transpose_item(P.rw_a2 + (size_t)i * 64 * 512, 64, 512, dst + 2 * 512 * 64, 0, scr, q, lane); continue; } q -= I_L64;
          transpose_item(P.rw_g2 + (size_t)i * 128 * 512, 128, 512, dst + 3 * 512 * 64, 0, scr, q, lane); }
    }
    {
        const int gt = blockIdx.x * NT + tid, NG = gridDim.x * NT;
        constexpr int PADE = (LDP_EVEN - P_EVEN) * D / 8, PADO = (LDP_ODD - P_ODD) * D / 8;
        for (int i = gt; i < 2 * PADE + 2 * PADO; i += NG) {
            int r = i; bf16_t* dst;
            if (r < 2 * PADE) { const int l = r / PADE; dst = winT + (l ? WINT_L2 : WINT_L0) + (size_t)P_EVEN * D + (size_t)(r % PADE) * 8; }
            else { r -= 2 * PADE; const int l = r / PADO; dst = winT + (l ? WINT_L3 : WINT_L1) + (size_t)P_ODD * D + (size_t)(r % PADO) * 8; }
            *(u32x4*)dst = (u32x4){0u, 0u, 0u, 0u};
        }
    }
    {
        const int gt = blockIdx.x * NT + tid, NG = gridDim.x * NT;
        float* lb = (float*)(P.ws + WS_LB);
        for (int ch = gt; ch < 512; ch += NG) {
            float lg[4], mx = -1e30f;
#pragma unroll
            for (int l = 0; l < 4; ++l) { lg[l] = P.hg_lb_logits[l * 512 + ch]; mx = fmaxf(mx, lg[l]); }
            float e[4], s = 0.f;
#pragma unroll
            for (int l = 0; l < 4; ++l) { e[l] = __expf(lg[l] - mx); s += e[l]; }
            float cum = 0.f;
#pragma unroll
            for (int l = 0; l < 4; ++l) { if (l > 0) cum += e[l] / s; lb[l * 512 + ch] = cum; }
        }
    }
    __syncthreads();
    {
        LAS float* sc = (LAS float*)lds;
        LAS float* red = (LAS float*)(lds + 5 * 1024 * 4);
        for (int i = tid; i < 5 * D; i += NT) { const int m = i >> 10, k = i & 1023; const float v = m < 4 ? P.c[m * D + k] : P.c_ctx[k]; sc[i] = siluf_(v); }
        __syncthreads();
        float* modv = (float*)(P.ws + WS_MODV);
        for (int cb = blockIdx.x; cb < 4 * 6144 / 96; cb += gridDim.x) {
            const int l = (cb * 96) / 6144, j0 = (cb * 96) % 6144;
            const int cg = tid % 24, kg = tid / 24;
            if (tid < 384) {
                const float* w = P.mod_w + (size_t)l * D * 6144 + (size_t)(kg * 64) * 6144 + j0 + 4 * cg;
                f32x4 a[5];
#pragma unroll
                for (int m = 0; m < 5; ++m) a[m] = (f32x4){0.f, 0.f, 0.f, 0.f};
#pragma unroll 1
                for (int k0 = 0; k0 < 64; k0 += 16) {
                    f32x4 wv4[16];
#pragma unroll
                    for (int u = 0; u < 16; ++u) wv4[u] = *(const f32x4*)(w + (size_t)(k0 + u) * 6144);
#pragma unroll
                    for (int u = 0; u < 16; ++u)
#pragma unroll
                        for (int m = 0; m < 5; ++m) a[m] += wv4[u] * sc[m * 1024 + kg * 64 + k0 + u];
                }
#pragma unroll
                for (int m = 0; m < 5; ++m) *(LAS f32x4*)(red + ((kg * 5 + m) * 96 + 4 * cg)) = a[m];
            }
            __syncthreads();
            if (tid < 480) {
                const int m = tid / 96, c = tid % 96;
                float sum = 0.f;
#pragma unroll
                for (int g = 0; g < 16; ++g) sum += red[(g * 5 + m) * 96 + c];
                modv[(size_t)(l * 5 + m) * 6144 + j0 + c] = sum + P.mod_b[l * 6144 + j0 + c];
            }
            __syncthreads();
        }
    }
}

__device__ __forceinline__ void phase_prologue1(int wv, KP Pk) {
    asm volatile("" : "+s"(Pk));
    const CAS Params& P = *Pk;
    const int tid = ltid(wv), lane = tid & 63, wid = tid >> 6;
    bf16_t* act = (bf16_t*)(P.ws + WS_ACT);
    f32x4 nv[4];
    auto fetch = [&](int rr) {
        const float* src = rr < NCTX ? P.ctx + (size_t)rr * D : P.x + (size_t)(rr - NCTX) * D;
#pragma unroll
        for (int i = 0; i < 4; ++i) nv[i] = *(const f32x4*)(src + 4 * lane + 256 * i);
    };
    const int stride = gridDim.x * 8;
    int r = blockIdx.x * 8 + wid;
    if (r < NROWS) fetch(r);
    for (; r < NROWS; r += stride) {
        const int m = row_mod(r);
        const f32x4 cv[4] = {nv[0], nv[1], nv[2], nv[3]};
        if (r + stride < NROWS) fetch(r + stride);
        const float* sh = modvec(P.ws, 0, m, 0); const float* sc = modvec(P.ws, 0, m, 1);
#pragma unroll
        for (int i = 0; i < 4; ++i) {
            const int c = 4 * lane + 256 * i;
            const f32x4 v = cv[i], s1 = *(const f32x4*)(sc + c), h1 = *(const f32x4*)(sh + c);
            u32x2 o; o.x = pk2(v[0] * (1.f + s1[0]) + h1[0], v[1] * (1.f + s1[1]) + h1[1]); o.y = pk2(v[2] * (1.f + s1[2]) + h1[2], v[3] * (1.f + s1[3]) + h1[3]);
            *(u32x2*)(act + (size_t)r * D + c) = o;
        }
    }
}

__device__ __forceinline__ void phase_inproj(int wv, KP Pk, int layer, LAS char* lds) {
    asm volatile("" : "+s"(Pk));
    const CAS Params& P = *Pk;
    const int odd = layer & 1, ldp = odd ? LDP_ODD : LDP_EVEN;
    const size_t woff = layer == 0 ? WINT_L0 : layer == 1 ? WINT_L1 : layer == 2 ? WINT_L2 : WINT_L3;
    pg8::Gemm g{(const bf16_t*)(P.ws + WS_ACT), (const bf16_t*)(P.ws + WS_WINT) + woff, NROWS, ldp, D};
    pg8::StaticOrder S; S.init(NROWS, ldp, (int)gridDim.x, (int)blockIdx.x);
    pg8::EpiStoreP E{(bf16_t*)(P.ws + WS_P), ldp};
    pg8::gemm_phase(wv, (PG8_LAS unsigned char*)lds, g, S, E);
    expconv_tail(wv, P, layer, lds, (NROWS / 256) * (ldp / 256), 0, exc_s0(layer));
}
__device__ __forceinline__ void phase_outproj(int wv, KP Pk, int layer, LAS char* lds) {
    asm volatile("" : "+s"(Pk));
    const CAS Params& P = *Pk;
    const int r0 = (layer == DEPTH - 1) ? NCTX : 0;
    pg8::Gemm g{(const bf16_t*)(P.ws + WS_FEAT) + (size_t)r0 * D, (const bf16_t*)(P.ws + WS_WOUTT) + (size_t)layer * D * D, NROWS - r0, D, D};
    pg8::StaticOrder S; S.init(NROWS - r0, D, (int)gridDim.x, (int)blockIdx.x);
    pg8::EpiStoreP E{(bf16_t*)(P.ws + WS_YO) + (size_t)r0 * D, D};
    pg8::gemm_phase(wv, (PG8_LAS unsigned char*)lds, g, S, E);
    expconv_tail(wv, P, layer, lds, ((NROWS - r0) / 256) * (D / 256), exc_s0(layer), exc_s0(layer) + exc_s1(layer));
}
__device__ __forceinline__ void phase_prep2(int wv, KP Pk, int layer, LAS char* lds) {
    asm volatile("" : "+s"(Pk));
    const CAS Params& P = *Pk;
    const int i = layer >> 1;
    const bf16_t* la = (const bf16_t*)(P.ws + WS_LA);
    const bf16_t* lt = (const bf16_t*)(P.ws + WS_LORAT) + (size_t)i * LORA_PER;
    constexpr int MT = NROWS / G_BM, NTL = 512 / G_BN;
    const int ntiles = 4 * MT * NTL;
    for (int t = blockIdx.x; t < ntiles; t += gridDim.x) {
        const int which = t / (MT * NTL), r = t % (MT * NTL), mt = r / NTL, nt = r % NTL;
        RowLinear rs{mt * G_BM};
        if (which < 2) {
            EpiDecay epi{(float*)(P.ws + WS_RWDEC) + (size_t)which * NROWS * 512, P.rw_w0 + (size_t)(i * 2 + which) * 512, mt * G_BM, nt * G_BN};
            gemm_tile(wv, la + which * 64, 320, rs, lt + (size_t)which * 512 * 64, 64, nt * G_BN, 64, epi, lds);
        } else if (which == 2) {
            EpiAK epi{(bf16_t*)(P.ws + WS_RWK), (const bf16_t*)(P.ws + WS_RWKK), (bf16_t*)(P.ws + WS_RWB), P.rw_a0 + i * 512, P.rw_k_a + i * 512, mt * G_BM, nt * G_BN};
            gemm_tile(wv, la + 128, 320, rs, lt + (size_t)2 * 512 * 64, 64, nt * G_BN, 64, epi, lds);
        } else {
            EpiStoreBf16 epi{(bf16_t*)(P.ws + WS_RWG), 512, mt * G_BM, nt * G_BN, 512};
            gemm_tile(wv, la + 192, 320, rs, lt + (size_t)3 * 512 * 64, 128, nt * G_BN, 128, epi, lds);
        }
    }
}
__device__ __forceinline__ void moe_tiles(int wv, const unsigned char* ws, int layer, LAS int* tstart, LAS int* tcnt) {
    const int tid = ltid(wv);
    if (tid < 64) {
        const int* cnt = (const int*)(ws + WS_CNT) + layer * 32 * CNT_STRIDE;
        const int c = tid < NEXP ? cnt[tid * CNT_STRIDE] : 0;
        int incl = (c + G_BM - 1) / G_BM;
#pragma unroll
        for (int o = 1; o < 32; o <<= 1) { const int t = __shfl_up(incl, o); if (tid >= o) incl += t; }
        if (tid < NEXP) { tcnt[tid] = c; tstart[tid] = incl - (c + G_BM - 1) / G_BM; }
        if (tid == NEXP - 1) tstart[NEXP] = incl;
    }
    __syncthreads();
}
__device__ __forceinline__ void phase_moe1(int wv, KP Pk, int layer, LAS char* lds) {
    asm volatile("" : "+s"(Pk));
    const CAS Params& P = *Pk;
    LAS int* tstart = (LAS int*)(lds + pg8::STAGE_BYTES); LAS int* tcnt = tstart + 40;
    moe_tiles(wv, P.ws, layer, tstart, tcnt);
    pg8::Gemm g{(const bf16_t*)(P.ws + WS_ACT), (const bf16_t*)(P.ws + WS_EXPGU), 0, 1024, D};
    LAS int* ltabs = tstart + 128;
    pg8::MoeOrder S{tstart, tcnt, ltabs, (const int*)(P.ws + WS_LIST), (const char*)(P.ws + WS_EXPGU), (size_t)1024 * 1024 * 2, 4, 1, (int)gridDim.x, (int)blockIdx.x};
    pg8::EpiSwiGLUG E{(bf16_t*)(P.ws + WS_HID)};
    for (int i = 0; i < 8; ++i) {
        pg8::UnitG u; if (!S.next(i, u)) break;
        const int tl = ltid(wv);
        const int* ul = (const int*)(P.ws + WS_LIST) + (size_t)u.e * LISTCAP + u.pm * pg8::BM;
        if (tl < pg8::BM) ltabs[i * pg8::BM + tl] = ul[tl < u.cnt ? tl : 0];
    }
    __syncthreads();
    pg8::gemm_phase_g(wv, (PG8_LAS unsigned char*)lds, g, S, E);
    __syncthreads();
}
__device__ __forceinline__ void phase_moe2(int wv, KP Pk, int layer, LAS char* lds) {
    asm volatile("" : "+s"(Pk));
    const CAS Params& P = *Pk;
    LAS int* tstart = (LAS int*)(lds + pg8::STAGE_BYTES); LAS int* tcnt = tstart + 40;
    moe_tiles(wv, P.ws, layer, tstart, tcnt);
    pg8::Gemm g{(const bf16_t*)(P.ws + WS_HID), (const bf16_t*)(P.ws + WS_EXPD), 0, 1024, DEXP};
    LAS int* ltabs = tstart + 128;
    pg8::MoeOrder S{tstart, tcnt, ltabs, (const int*)(P.ws + WS_LIST), (const char*)(P.ws + WS_EXPD), (size_t)1024 * 512 * 2, 4, 0, (int)gridDim.x, (int)blockIdx.x};
    pg8::EpiScatterG E{(bf16_t*)(P.ws + WS_YP)};
    for (int i = 0; i < 8; ++i) {
        pg8::UnitG u; if (!S.next(i, u)) break;
        const int tl = ltid(wv);
        const int* ul = (const int*)(P.ws + WS_LIST) + (size_t)u.e * LISTCAP + u.pm * pg8::BM;
        if (tl < pg8::BM) ltabs[i * pg8::BM + tl] = ul[tl < u.cnt ? tl : 0];
    }
    __syncthreads();
    pg8::gemm_phase_g(wv, (PG8_LAS unsigned char*)lds, g, S, E);
    __syncthreads();
}

constexpr int NCHUNK = NSTEPS / TCH;

constexpr int SSD_F = 32 + 64 + 64;
constexpr int SSD_BUF = TCH * SSD_F + 3 * TCH;

constexpr int ML_F = 64 + 64 + 32;
constexpr int ML_BUF = TCH * ML_F + 4 * TCH;

constexpr int HG_F = 128 + 128 + 32;
constexpr int HG_BUF = TCH * HG_F + TCH;

constexpr int RW_F = 5 * 64 + 32;
constexpr int RW_BUF = TCH * RW_F + TCH;
__device__ __forceinline__ void scan_rwkv(int wv, KP Pk, int layer, int unit, LAS char* lds) {
    asm volatile("" : "+s"(Pk));
    const CAS Params& P = *Pk;
    const int tid = ltid(wv);
    const int seq = unit >> 1, half = unit & 1, b = seq >> 4, h = (seq >> 1) & 7, dir = seq & 1;
    LAS float* bufs = (LAS float*)lds;
    bf16_t* Y = (bf16_t*)(P.ws + (dir ? WS_YB : WS_YF));
    const float* dec = (const float*)(P.ws + WS_RWDEC) + (size_t)dir * NROWS * 512;
    int tj[4], tg_[4]; bool tv[4]; const unsigned char* tbase[4]; int tlds[4];
#pragma unroll
    for (int s = 0; s < 4; ++s) {
        const int task = tid + NT * s; tv[s] = task < TCH * 52; tj[s] = task / 52; tg_[s] = task % 52;
        const int g = tg_[s];
        if (g < 8)       { tbase[s] = P.ws + WS_RWR  + (size_t)(h * 64 + 8 * g) * 2;              tlds[s] = 256 + 8 * g; }
        else if (g < 16) { tbase[s] = P.ws + WS_RWK  + (size_t)(h * 64 + 8 * (g - 8)) * 2;        tlds[s] = 192 + 8 * (g - 8); }
        else if (g < 24) { tbase[s] = P.ws + WS_RWKK + (size_t)(h * 64 + 8 * (g - 16)) * 2;       tlds[s] = 64 + 8 * (g - 16); }
        else if (g < 32) { tbase[s] = P.ws + WS_RWB  + (size_t)(h * 64 + 8 * (g - 24)) * 2;       tlds[s] = 128 + 8 * (g - 24); }
        else if (g < 36) { tbase[s] = P.ws + WS_RWV  + (size_t)(h * 64 + half * 32 + 8 * (g - 32)) * 2; tlds[s] = 320 + 8 * (g - 32); }
        else             { tbase[s] = (const unsigned char*)(dec + h * 64 + 4 * (g - 36));        tlds[s] = 4 * (g - 36); }
    }
    u32x4 rc[4]; int rrow = 0;
    auto load = [&](int c) {
#pragma unroll
        for (int s = 0; s < 4; ++s) {
            rc[s] = (u32x4){0u, 0u, 0u, 0u};
            if (tv[s]) { const int row = scan_row(c * TCH + tj[s], b, dir, 1); rc[s] = *(const u32x4*)(tbase[s] + (size_t)row * (tg_[s] < 36 ? 1024 : 2048)); }
        }
        if (tid < TCH) rrow = scan_row(c * TCH + tid, b, dir, 1);
    };
    auto store = [&](int c) {
        LAS float* buf = bufs + (c & 1) * RW_BUF;
#pragma unroll
        for (int s = 0; s < 4; ++s) {
            if (tv[s]) {
                LAS float* dst = buf + tj[s] * RW_F + tlds[s];
                const int g = tg_[s];
                if (g >= 36) { *(LAS u32x4*)dst = rc[s]; }
                else {
                    float f[8]; unpack8(rc[s], f);
                    const float sg = (g >= 16 && g < 24) ? -1.f : 1.f;
                    *(LAS f32x4*)dst = (f32x4){sg * f[0], sg * f[1], sg * f[2], sg * f[3]}; *(LAS f32x4*)(dst + 4) = (f32x4){sg * f[4], sg * f[5], sg * f[6], sg * f[7]};
                }
            }
        }
        if (tid < TCH) ((LAS int*)buf)[TCH * RW_F + tid] = rrow;
    };
    const int vrow = tid >> 4, q = tid & 15;
    f32x2 S01 = {0.f, 0.f}, S23 = {0.f, 0.f};
    LAS float* ypw = bufs + 2 * RW_BUF + (tid >> 6) * (2 * 16 * 68);
    int prow = -1, gpar = 0;
    load(0); store(0); __syncthreads();
    for (int c = 0; c < NCHUNK; ++c) {
        if (c + 1 < NCHUNK) load(c + 1);
        LAS float* buf = bufs + (c & 1) * RW_BUF;
        {
            const LAS float* wp = buf + 4 * q;
            const LAS float* vp = buf + 320 + vrow;
            f32x4 w4 = *(const LAS f32x4*)wp, a4 = *(const LAS f32x4*)(wp + 64), b4 = *(const LAS f32x4*)(wp + 128), k4 = *(const LAS f32x4*)(wp + 192), r4 = *(const LAS f32x4*)(wp + 256); float vr = vp[0];
#pragma unroll 1
            for (int jh = 0; jh < 2; ++jh) {
                const LAS float* rp = ypw + (gpar ^ 1) * (16 * 68) + q * 68 + ((tid >> 4) & 3) * 16;
                const f32x4 p0 = *(const LAS f32x4*)rp, p1 = *(const LAS f32x4*)(rp + 4), p2 = *(const LAS f32x4*)(rp + 8), p3 = *(const LAS f32x4*)(rp + 12);
                LAS float* wpz = ypw + gpar * (16 * 68) + (tid & 63);
#pragma unroll
                for (int j = 0; j < 16; ++j) {
                    const int jj = jh * 16 + j;
                    const f32x4 wc = w4, ac = a4, bc = b4, kc = k4, rc = r4; const float vv = vr;
                    if (j < 15 || jh == 0) {
                        const LAS float* np = wp + (jj + 1) * RW_F;
                        w4 = *(const LAS f32x4*)np; a4 = *(const LAS f32x4*)(np + 64); b4 = *(const LAS f32x4*)(np + 128); k4 = *(const LAS f32x4*)(np + 192); r4 = *(const LAS f32x4*)(np + 256); vr = vp[(jj + 1) * RW_F];
                    }
                    const f32x2 a01 = {ac[0], ac[1]}, a23 = {ac[2], ac[3]}, w01 = {wc[0], wc[1]}, w23 = {wc[2], wc[3]}, b01 = {bc[0], bc[1]}, b23 = {bc[2], bc[3]};
                    const f32x2 k01 = {kc[0], kc[1]}, k23 = {kc[2], kc[3]}, r01 = {rc[0], rc[1]}, r23 = {rc[2], rc[3]}, vv2 = {vv, vv};
                    f32x2 t = S01 * a01; t = S23 * a23 + t;
                    const f32x2 u01 = S01 * w01 + vv2 * k01, u23 = S23 * w23 + vv2 * k23;
                    const float sa = allreduce16(t.x + t.y);
                    const f32x2 sa2 = {sa, sa};
                    S01 = sa2 * b01 + u01; S23 = sa2 * b23 + u23;
                    f32x2 yv = S01 * r01; yv = S23 * r23 + yv;
                    wpz[j * 68] = yv.x + yv.y;
                }
                if (prow >= 0) {
                    const f32x4 t = (p0 + p1) + (p2 + p3);
                    Y[(size_t)prow * D + 512 + h * 64 + half * 32 + vrow] = f2bf((t[0] + t[1]) + (t[2] + t[3]));
                }
                prow = ((const LAS int*)buf)[TCH * RW_F + jh * 16 + q];
                gpar ^= 1;
            }
        }
        if (c + 1 < NCHUNK) store(c + 1);
        __syncthreads();
    }
    {
        const LAS float* rp = ypw + (gpar ^ 1) * (16 * 68) + q * 68 + ((tid >> 4) & 3) * 16;
        const f32x4 t = (*(const LAS f32x4*)rp + *(const LAS f32x4*)(rp + 4)) + (*(const LAS f32x4*)(rp + 8) + *(const LAS f32x4*)(rp + 12));
        Y[(size_t)prow * D + 512 + h * 64 + half * 32 + vrow] = f2bf((t[0] + t[1]) + (t[2] + t[3]));
    }
}

__device__ __forceinline__ void scan_rwkv_b(int wv, KP Pk, int layer, int unit, LAS char* lds) {
    asm volatile("" : "+s"(Pk));
    const CAS Params& P = *Pk;
    const int tid = ltid(wv);
    const int seq = unit >> 1, half = unit & 1, b = seq >> 4, h = (seq >> 1) & 7, dir = seq & 1;
    LAS float* bufs = (LAS float*)lds;
    bf16_t* Y = (bf16_t*)(P.ws + (dir ? WS_YB : WS_YF));
    const float* dec = (const float*)(P.ws + WS_RWDEC) + (size_t)dir * NROWS * 512;
    int tj[4], tg_[4]; bool tv[4]; const unsigned char* tbase[4]; int tlds[4];
#pragma unroll
    for (int s = 0; s < 4; ++s) {
        const int task = tid + NT * s; tv[s] = task < TCH * 52; tj[s] = task / 52; tg_[s] = task % 52;
        const int g = tg_[s];
        if (g < 8)       { tbase[s] = P.ws + WS_RWR  + (size_t)(h * 64 + 8 * g) * 2;              tlds[s] = 256 + 8 * g; }
        else if (g < 16) { tbase[s] = P.ws + WS_RWK  + (size_t)(h * 64 + 8 * (g - 8)) * 2;        tlds[s] = 192 + 8 * (g - 8); }
        else if (g < 24) { tbase[s] = P.ws + WS_RWKK + (size_t)(h * 64 + 8 * (g - 16)) * 2;       tlds[s] = 64 + 8 * (g - 16); }
        else if (g < 32) { tbase[s] = P.ws + WS_RWB  + (size_t)(h * 64 + 8 * (g - 24)) * 2;       tlds[s] = 128 + 8 * (g - 24); }
        else if (g < 36) { tbase[s] = P.ws + WS_RWV  + (size_t)(h * 64 + half * 32 + 8 * (g - 32)) * 2; tlds[s] = 320 + 8 * (g - 32); }
        else             { tbase[s] = (const unsigned char*)(dec + h * 64 + 4 * (g - 36));        tlds[s] = 4 * (g - 36); }
    }
    u32x4 rc[4]; int rrow = 0;
    auto load = [&](int c) {
#pragma unroll
        for (int s = 0; s < 4; ++s) {
            rc[s] = (u32x4){0u, 0u, 0u, 0u};
            if (tv[s]) { const int row = scan_row(c * TCH + tj[s], b, dir, 1); rc[s] = *(const u32x4*)(tbase[s] + (size_t)row * (tg_[s] < 36 ? 1024 : 2048)); }
        }
        if (tid < TCH) rrow = scan_row(c * TCH + tid, b, dir, 1);
    };
    auto store = [&](int c) {
        LAS float* buf = bufs + (c & 1) * RW_BUF;
#pragma unroll
        for (int s = 0; s < 4; ++s) {
            if (tv[s]) {
                LAS float* dst = buf + tj[s] * RW_F + tlds[s];
                const int g = tg_[s];
                if (g >= 36) { *(LAS u32x4*)dst = rc[s]; }
                else {
                    float f[8]; unpack8(rc[s], f);
                    const float sg = (g >= 16 && g < 24) ? -1.f : 1.f;
                    *(LAS f32x4*)dst = (f32x4){sg * f[0], sg * f[1], sg * f[2], sg * f[3]}; *(LAS f32x4*)(dst + 4) = (f32x4){sg * f[4], sg * f[5], sg * f[6], sg * f[7]};
                }
            }
        }
        if (tid < TCH) ((LAS int*)buf)[TCH * RW_F + tid] = rrow;
    };
    const int q = tid & 15, vr = (tid >> 4) & 3, rowA = 8 * wv + vr, rowB = rowA + 4;
    f32x2 A01 = {0.f, 0.f}, A23 = {0.f, 0.f}, B01 = {0.f, 0.f}, B23 = {0.f, 0.f};
    LAS float* ypw = bufs + 2 * RW_BUF + (wv & 3) * (2 * 16 * 132);
    int prow = -1, gpar = 0;
    load(0); store(0); __syncthreads();
    for (int c = 0; c < NCHUNK; ++c) {
        if (c + 1 < NCHUNK) load(c + 1);
        LAS float* buf = bufs + (c & 1) * RW_BUF;
        if (wv < 4) {
            const LAS float* wp = buf + 4 * q;
            const LAS float* vpA = buf + 320 + rowA; const LAS float* vpB = buf + 320 + rowB;
            f32x4 w4 = *(const LAS f32x4*)wp, a4 = *(const LAS f32x4*)(wp + 64), b4 = *(const LAS f32x4*)(wp + 128), k4 = *(const LAS f32x4*)(wp + 192), r4 = *(const LAS f32x4*)(wp + 256); float vrA = vpA[0], vrB = vpB[0];
#pragma unroll 1
            for (int jh = 0; jh < 2; ++jh) {
                const LAS float* rp = ypw + (gpar ^ 1) * (16 * 132) + q * 132 + vr * 16;
                const f32x4 pa0 = *(const LAS f32x4*)rp, pa1 = *(const LAS f32x4*)(rp + 4), pa2 = *(const LAS f32x4*)(rp + 8), pa3 = *(const LAS f32x4*)(rp + 12);
                const f32x4 pb0 = *(const LAS f32x4*)(rp + 64), pb1 = *(const LAS f32x4*)(rp + 68), pb2 = *(const LAS f32x4*)(rp + 72), pb3 = *(const LAS f32x4*)(rp + 76);
                LAS float* wpz = ypw + gpar * (16 * 132) + (tid & 63);
#pragma unroll
                for (int j = 0; j < 16; ++j) {
                    const int jj = jh * 16 + j;
                    const f32x4 wc = w4, ac = a4, bc = b4, kc = k4, rc = r4; const float vvA = vrA, vvB = vrB;
                    if (j < 15 || jh == 0) {
                        const LAS float* np = wp + (jj + 1) * RW_F;
                        w4 = *(const LAS f32x4*)np; a4 = *(const LAS f32x4*)(np + 64); b4 = *(const LAS f32x4*)(np + 128); k4 = *(const LAS f32x4*)(np + 192); r4 = *(const LAS f32x4*)(np + 256);
                        vrA = vpA[(jj + 1) * RW_F]; vrB = vpB[(jj + 1) * RW_F];
                    }
                    const f32x2 a01 = {ac[0], ac[1]}, a23 = {ac[2], ac[3]}, w01 = {wc[0], wc[1]}, w23 = {wc[2], wc[3]}, b01 = {bc[0], bc[1]}, b23 = {bc[2], bc[3]};
                    const f32x2 k01 = {kc[0], kc[1]}, k23 = {kc[2], kc[3]}, r01 = {rc[0], rc[1]}, r23 = {rc[2], rc[3]}, va2 = {vvA, vvA}, vb2 = {vvB, vvB};
                    f32x2 tA = A01 * a01; tA = A23 * a23 + tA;
                    f32x2 tB = B01 * a01; tB = B23 * a23 + tB;
                    const f32x2 uA01 = A01 * w01 + va2 * k01, uA23 = A23 * w23 + va2 * k23, uB01 = B01 * w01 + vb2 * k01, uB23 = B23 * w23 + vb2 * k23;
                    const float saA = allreduce16(tA.x + tA.y), saB = allreduce16(tB.x + tB.y);
                    const f32x2 sA2 = {saA, saA}, sB2 = {saB, saB};
                    A01 = sA2 * b01 + uA01; A23 = sA2 * b23 + uA23; B01 = sB2 * b01 + uB01; B23 = sB2 * b23 + uB23;
                    f32x2 yA = A01 * r01; yA = A23 * r23 + yA;
                    f32x2 yB = B01 * r01; yB = B23 * r23 + yB;
                    wpz[j * 132] = yA.x + yA.y; wpz[j * 132 + 64] = yB.x + yB.y;
                }
                if (prow >= 0) {
                    const f32x4 ta = (pa0 + pa1) + (pa2 + pa3), tb = (pb0 + pb1) + (pb2 + pb3);
                    bf16_t* yo = Y + (size_t)prow * D + 512 + h * 64 + half * 32;
                    yo[rowA] = f2bf((ta[0] + ta[1]) + (ta[2] + ta[3])); yo[rowB] = f2bf((tb[0] + tb[1]) + (tb[2] + tb[3]));
                }
                prow = ((const LAS int*)buf)[TCH * RW_F + jh * 16 + q];
                gpar ^= 1;
            }
        }
        if (c + 1 < NCHUNK) store(c + 1);
        __syncthreads();
    }
    if (wv < 4) {
        const LAS float* rp = ypw + (gpar ^ 1) * (16 * 132) + q * 132 + vr * 16;
        const f32x4 ta = (*(const LAS f32x4*)rp + *(const LAS f32x4*)(rp + 4)) + (*(const LAS f32x4*)(rp + 8) + *(const LAS f32x4*)(rp + 12));
        const f32x4 tb = (*(const LAS f32x4*)(rp + 64) + *(const LAS f32x4*)(rp + 68)) + (*(const LAS f32x4*)(rp + 72) + *(const LAS f32x4*)(rp + 76));
        bf16_t* yo = Y + (size_t)prow * D + 512 + h * 64 + half * 32;
        yo[rowA] = f2bf((ta[0] + ta[1]) + (ta[2] + ta[3])); yo[rowB] = f2bf((tb[0] + tb[1]) + (tb[2] + tb[3]));
    }
}

constexpr size_t WS_EXBC = WS_RWR;
constexpr size_t WS_EQK = WS_EXBC + (size_t)NROWS * 768 * 2;
constexpr size_t WS_EGT = WS_EQK + (size_t)NROWS * 512 * 2;
static_assert(WS_EGT + (size_t)NROWS * 32 * 4 <= WS_LA, "even-layer prepare buffers must fit in the RWKV region");

__device__ __forceinline__ void phase_prep_even(int wv, KP Pk, int layer) {
    asm volatile("" : "+s"(Pk));
    const CAS Params& P = *Pk;
    const int tid = ltid(wv), lane = tid & 63, wid = tid >> 6, i_ = layer >> 1;
    const bf16_t* Pb = (const bf16_t*)(P.ws + WS_P);
    bf16_t* XBC = (bf16_t*)(P.ws + WS_EXBC); bf16_t* QK = (bf16_t*)(P.ws + WS_EQK); float* GT = (float*)(P.ws + WS_EGT);
    float cw0[4][8], cw1[4][8], cwq[4][8];
#pragma unroll
    for (int e = 0; e < 8; ++e) {
#pragma unroll
        for (int t = 0; t < 3; ++t) {
            cw0[t][e] = P.ssd_conv_w[(size_t)(i_ * 3 + t) * 768 + 8 * lane + e];
            cw1[t][e] = P.ssd_conv_w[(size_t)(i_ * 3 + t) * 768 + 512 + 8 * (lane & 31) + e];
            cwq[t][e] = P.ml_conv_w[(size_t)(i_ * 3 + t) * 512 + 8 * lane + e];
        }
        cw0[3][e] = P.ssd_conv_b[i_ * 768 + 8 * lane + e]; cw1[3][e] = P.ssd_conv_b[i_ * 768 + 512 + 8 * (lane & 31) + e]; cwq[3][e] = P.ml_conv_b[i_ * 512 + 8 * lane + e];
    }
    float gbias = 0.f;
    if (lane < 16) gbias = P.ssd_dt_bias[i_ * 16 + lane]; else if (lane < 24) gbias = P.ml_i_bias[i_ * 8 + lane - 16]; else if (lane < 32) gbias = P.ml_f_bias[i_ * 8 + lane - 24];
    const float qscl = lane < 32 ? 0.125f : 1.f;
    const u32x4 zero = (u32x4){0u, 0u, 0u, 0u};
    u32x4 nA[3], nB[3], nC[3]; bf16_t ng = 0;
    auto fetch = [&](int rr) {
        int t, len; row_seg(rr, t, len);
        const bf16_t* pr = Pb + (size_t)rr * LDP_EVEN;
        const bool hp = t > 0, hn = t < len - 1;
        { const int col = 512 + 8 * lane; nA[0] = *(const u32x4*)(pr + col); nA[1] = hp ? *(const u32x4*)(pr - LDP_EVEN + col) : zero; nA[2] = hn ? *(const u32x4*)(pr + LDP_EVEN + col) : zero; }
        if (lane < 32) { const int col = 1024 + 8 * lane; nB[0] = *(const u32x4*)(pr + col); nB[1] = hp ? *(const u32x4*)(pr - LDP_EVEN + col) : zero; nB[2] = hn ? *(const u32x4*)(pr + LDP_EVEN + col) : zero; }
        { const int col = 1296 + 8 * lane; nC[0] = *(const u32x4*)(pr + col); nC[1] = hp ? *(const u32x4*)(pr - LDP_EVEN + col) : zero; nC[2] = hn ? *(const u32x4*)(pr + LDP_EVEN + col) : zero; }
        if (lane < 32) ng = pr[lane < 16 ? 1280 + lane : 2832 + (lane - 16)];
    };
    nB[0] = nB[1] = nB[2] = zero;
    const int stride = gridDim.x * 8;
    int r = blockIdx.x * 8 + wid;
    if (r < NROWS) fetch(r);
    for (; r < NROWS; r += stride) {
        const u32x4 cA0 = nA[0], cA1 = nA[1], cA2 = nA[2], cB0 = nB[0], cB1 = nB[1], cB2 = nB[2], cC0 = nC[0], cC1 = nC[1], cC2 = nC[2]; const bf16_t cg = ng;
        if (r + stride < NROWS) fetch(r + stride);
        float fc[8], fp[8], fn[8], o[8];
        {
            unpack8(cA0, fc); unpack8(cA1, fp); unpack8(cA2, fn);
#pragma unroll
            for (int e = 0; e < 8; ++e) o[e] = siluf_(cw0[0][e] * fp[e] + cw0[1][e] * fc[e] + cw0[2][e] * fn[e] + cw0[3][e]);
            *(u32x4*)(XBC + (size_t)r * 768 + 8 * lane) = pack8(o);
        }
        if (lane < 32) {
            unpack8(cB0, fc); unpack8(cB1, fp); unpack8(cB2, fn);
#pragma unroll
            for (int e = 0; e < 8; ++e) o[e] = siluf_(cw1[0][e] * fp[e] + cw1[1][e] * fc[e] + cw1[2][e] * fn[e] + cw1[3][e]);
            *(u32x4*)(XBC + (size_t)r * 768 + 512 + 8 * lane) = pack8(o);
        }
        {
            unpack8(cC0, fc); unpack8(cC1, fp); unpack8(cC2, fn);
#pragma unroll
            for (int e = 0; e < 8; ++e) o[e] = qscl * siluf_(cwq[0][e] * fp[e] + cwq[1][e] * fc[e] + cwq[2][e] * fn[e] + cwq[3][e]);
            *(u32x4*)(QK + (size_t)r * 512 + 8 * lane) = pack8(o);
        }
        if (lane < 32) {
            const float x = bf2f(cg) + gbias;
            GT[(size_t)r * 32 + lane] = lane < 16 ? softplusf_(x) : lane < 24 ? x : logsigmoidf_(x);
        }
    }
}

constexpr int CL = 64, NCH64 = NSTEPS / CL, LDT = 72, LDTB = LDT * 2;
__device__ __forceinline__ bf16x8 ldfrag(const LAS char* tile, int ldb, int row0, int k0, int lane) {
    return *(const LAS bf16x8*)(tile + (row0 + (lane & 15)) * ldb + (k0 + 8 * (lane >> 4)) * 2);
}
constexpr int LDTS = 160;
__device__ __forceinline__ int swz_off(int row, int byteoff) { return row * LDTS + (byteoff ^ (((row >> 3) & 7) << 4)); }
__device__ __forceinline__ bf16x8 ldfrag_sw(const LAS char* tile, int row0, int k0, int lane) {
    const int row = row0 + (lane & 15);
    return *(const LAS bf16x8*)(tile + swz_off(row, (k0 + 8 * (lane >> 4)) * 2));
}
__device__ __forceinline__ void st4bf(LAS char* p, const f32x4& v) { u32x2 o; o.x = pk2(v[0], v[1]); o.y = pk2(v[2], v[3]); *(LAS u32x2*)p = o; }

constexpr int SS_BT = 0, SS_CT = SS_BT + 64 * LDTB, SS_BDT = SS_CT + 64 * LDTB, SS_XT = SS_BDT + 64 * LDTB, SS_CUM = SS_XT + 32 * LDTB, SS_DTV = SS_CUM + 256, SS_ROWS = SS_DTV + 256, SS_STG = SS_ROWS + 256;
constexpr int SS_M = 2 * SS_STG, SS_HB = SS_M + 64 * LDTB, SS_END = SS_HB + 32 * LDTB;
static_assert(SS_END <= LDS_BYTES - 16, "SSD LDS map");

constexpr int MS_QT = 0, MS_KT = MS_QT + 64 * LDTB, MS_KET = MS_KT + 64 * LDTB, MS_VT = MS_KET + 64 * LDTB, MS_SC = MS_VT + 32 * LDTB;
constexpr int MS_STG = MS_SC + 8 * 256;
constexpr int MS_W = 2 * MS_STG, MS_CB = MS_W + 64 * LDTB, MS_ONE = MS_CB + 32 * LDTB, MS_NV = MS_ONE + 16 * LDTB, MS_QN = MS_NV + 256, MS_END = MS_QN + 256;
static_assert(MS_END <= LDS_BYTES - 16, "mLSTM LDS map");

constexpr size_t WS_XSS = WS_EGT + al256((size_t)NROWS * 32 * 4);
constexpr size_t XSS_BYTES = (size_t)64 * NCH64 * 64 * 64 * 2;
constexpr size_t WS_XSD = WS_XSS + XSS_BYTES;
constexpr size_t WS_XMC = WS_XSD + al256((size_t)64 * NCH64 * 4);
constexpr size_t XMC_BYTES = (size_t)32 * NCH64 * 128 * 64 * 2;
constexpr size_t WS_XMN = WS_XMC + XMC_BYTES;
constexpr size_t WS_XMS = WS_XMN + (size_t)32 * NCH64 * 64 * 4;
constexpr size_t WS_XMT = WS_XMS + al256((size_t)32 * NCH64 * 4 * 4);
constexpr size_t WS_XEND = WS_XMT + (size_t)32 * NCH64 * 3 * 64 * 4;
static_assert(WS_XEND <= WS_END, "even-layer chunk-state buffers must fit in the RWKV region");
constexpr int NSSD_ITEMS = 64 * NCH64, NML_ITEMS = 32 * NCH64;

template <int CTRL, int RM, int BM> __device__ __forceinline__ float dppx(float old, float v) {
    return __builtin_bit_cast(float, __builtin_amdgcn_update_dpp(__builtin_bit_cast(int, old), __builtin_bit_cast(int, v), CTRL, RM, BM, false));
}
__device__ __forceinline__ float wave_cumsum(float v, int) {
    float t = v;
    t += dppx<0x111, 0xf, 0xf>(0.f, v); t += dppx<0x112, 0xf, 0xf>(0.f, v); t += dppx<0x113, 0xf, 0xf>(0.f, v);
    { const float u = dppx<0x114, 0xf, 0xe>(0.f, t); t += u; }
    { const float u = dppx<0x118, 0xf, 0xc>(0.f, t); t += u; }
    { const float u = dppx<0x142, 0xa, 0xf>(0.f, t); t += u; }
    { const float u = dppx<0x143, 0xc, 0xf>(0.f, t); t += u; }
    return t;
}
__device__ __forceinline__ float wave_cummax(float v, int) {
    const float ninf = -__builtin_huge_valf();
    float t = v;
    t = fmaxf(t, dppx<0x111, 0xf, 0xf>(ninf, v)); t = fmaxf(t, dppx<0x112, 0xf, 0xf>(ninf, v)); t = fmaxf(t, dppx<0x113, 0xf, 0xf>(ninf, v));
    { const float u = dppx<0x114, 0xf, 0xe>(ninf, t); t = fmaxf(t, u); }
    { const float u = dppx<0x118, 0xf, 0xc>(ninf, t); t = fmaxf(t, u); }
    { const float u = dppx<0x142, 0xa, 0xf>(ninf, t); t = fmaxf(t, u); }
    { const float u = dppx<0x143, 0xc, 0xf>(ninf, t); t = fmaxf(t, u); }
    return t;
}
__device__ __forceinline__ float wave_max(float v) {
    const float t = wave_cummax(v, 0);
    return __builtin_bit_cast(float, __builtin_amdgcn_readlane(__builtin_bit_cast(int, t), 63));
}

constexpr int X1S_BDT = 0, X1S_XT = X1S_BDT + 64 * LDTS, X1S_CUM = X1S_XT + 64 * LDTS, X1S_DTV = X1S_CUM + 256, X1S_END = X1S_DTV + 256;
constexpr int X1M_KET = 0, X1M_VT = X1M_KET + 64 * LDTS, X1M_ONE = X1M_VT + 128 * LDTS, X1M_EE = X1M_ONE + 16 * LDTB, X1M_END = X1M_EE + 256;
__device__ __forceinline__ void phase_ex1(int wv, KP Pk, int layer, LAS char* lds) {
    asm volatile("" : "+s"(Pk));
    const CAS Params& P = *Pk;
    const int tid = ltid(wv), lane = tid & 63, wid = tid >> 6, q = lane >> 4, r16 = lane & 15, i_ = layer >> 1;
    const bf16_t* XBC = (const bf16_t*)(P.ws + WS_EXBC); const bf16_t* QK = (const bf16_t*)(P.ws + WS_EQK); const bf16_t* Pb = (const bf16_t*)(P.ws + WS_P);
    const float* GT = (const float*)(P.ws + WS_EGT);
    {
        bf16_t* Hst = (bf16_t*)(P.ws + WS_XSS); float* Dst = (float*)(P.ws + WS_XSD);
        u32x4 rc[2]; float rdt = 0.f;
        auto geom = [&](int it, int& b, int& h, int& dir, int& c) { const int sq = it / NCH64; c = it - sq * NCH64; b = sq >> 4; h = (sq >> 1) & 7; dir = sq & 1; };
        auto load = [&](int it) {
            int b, h, dir, c; geom(it, b, h, dir, c);
            int tl = tid; asm volatile("" : "+v"(tl));
#pragma unroll
            for (int s = 0; s < 2; ++s) {
                const int task = tl + NT * s, j = task >> 4, g = task & 15;
                const int row = scan_row(c * CL + j, b, dir, 0);
                rc[s] = *(const u32x4*)(XBC + (size_t)row * 768 + (g < 8 ? h * 64 + 8 * g : 512 + (h >> 2) * 64 + 8 * (g - 8)));
            }
            if (tl < CL) { const int row = scan_row(c * CL + tl, b, dir, 0); rdt = GT[(size_t)row * 32 + dir * 8 + h]; }
        };
        int it = blockIdx.x;
        if (it < NSSD_ITEMS) load(it);
        for (; it < NSSD_ITEMS; it += gridDim.x) {
            int b, h, dir, c; geom(it, b, h, dir, c);
            const float aco = -__expf(P.ssd_a_log[(i_ * 2 + dir) * 8 + h]);
            if (tid < CL) {
                const float cum = wave_cumsum(rdt * aco, lane);
                ((LAS float*)(lds + X1S_CUM))[tid] = cum; ((LAS float*)(lds + X1S_DTV))[tid] = rdt;
            }
            __syncthreads();
            {
                const LAS float* cum = (const LAS float*)(lds + X1S_CUM);
                const float cumL = cum[CL - 1];
                int tl = tid; asm volatile("" : "+v"(tl));
#pragma unroll
                for (int s = 0; s < 2; ++s) {
                    const int task = tl + NT * s, j = task >> 4, g = task & 15;
                    float f[8]; unpack8(rc[s], f);
                    if (g < 8) {
                        const float dt = ((const LAS float*)(lds + X1S_DTV))[j];
#pragma unroll
                        for (int e = 0; e < 8; ++e) *(LAS bf16_t*)(lds + X1S_XT + swz_off(8 * g + e, j * 2)) = f2bf(f[e] * dt);
                    } else {
                        const float sc = __expf(cumL - cum[j]);
#pragma unroll
                        for (int e = 0; e < 8; ++e) *(LAS bf16_t*)(lds + X1S_BDT + swz_off(8 * (g - 8) + e, j * 2)) = f2bf(f[e] * sc);
                    }
                }
                if (tid == 0) Dst[it] = __expf(cumL);
            }
            if (it + (int)gridDim.x < NSSD_ITEMS) load(it + gridDim.x);
            __syncthreads();
            {
                const int pt = wid >> 1;
#pragma unroll
                for (int u = 0; u < 2; ++u) {
                    const int nt = (wid & 1) * 2 + u;
                    f32x4 sa = (f32x4){0.f, 0.f, 0.f, 0.f};
#pragma unroll
                    for (int k0 = 0; k0 < 64; k0 += 32) sa = __builtin_amdgcn_mfma_f32_16x16x32_bf16(ldfrag_sw(lds + X1S_BDT, nt * 16, k0, lane), ldfrag_sw(lds + X1S_XT, pt * 16, k0, lane), sa, 0, 0, 0);
                    u32x2 o; o.x = pk2(sa[0], sa[1]); o.y = pk2(sa[2], sa[3]);
                    *(u32x2*)(Hst + ((size_t)it * 64 + pt * 16 + r16) * 64 + nt * 16 + 4 * q) = o;
                }
            }
            __syncthreads();
        }
    }
    {
        bf16_t* Cst = (bf16_t*)(P.ws + WS_XMC); float* Nst = (float*)(P.ws + WS_XMN); float* Sst = (float*)(P.ws + WS_XMS); float* Tst = (float*)(P.ws + WS_XMT);
        for (int i = tid; i < 16 * LDTB / 4; i += NT) ((LAS unsigned*)(lds + X1M_ONE))[i] = 0x3f803f80u;
        u32x4 rc[3]; float rli = 0.f, rlf = 0.f;
        auto geom = [&](int it, int& b, int& h, int& dir, int& c) { const int sq = it / NCH64; c = it - sq * NCH64; b = sq >> 3; h = (sq >> 1) & 3; dir = sq & 1; };
        auto load = [&](int it) {
            int b, h, dir, c; geom(it, b, h, dir, c);
            int tl = tid; asm volatile("" : "+v"(tl));
#pragma unroll
            for (int s = 0; s < 3; ++s) {
                const int task = tl + NT * s, j = task / 24, g = task - 24 * j;
                const int row = scan_row(c * CL + j, b, dir, 0);
                rc[s] = g < 8 ? *(const u32x4*)(QK + (size_t)row * 512 + 256 + h * 64 + 8 * g) : *(const u32x4*)(Pb + (size_t)row * LDP_EVEN + 1808 + h * 128 + 8 * (g - 8));
            }
            if (tl < CL) { const int row = scan_row(c * CL + tl, b, dir, 0); rli = GT[(size_t)row * 32 + 16 + dir * 4 + h]; rlf = GT[(size_t)row * 32 + 24 + dir * 4 + h]; }
        };
        int it = blockIdx.x;
        if (it < NML_ITEMS) load(it);
        __syncthreads();
        for (; it < NML_ITEMS; it += gridDim.x) {
            if (tid < CL) {
                const float fcum = wave_cumsum(rlf, lane);
                const float ftot = __builtin_bit_cast(float, __builtin_amdgcn_readlane(__builtin_bit_cast(int, fcum), 63));
                const float g = rli - fcum, pm = wave_cummax(g, lane);
                const float wend = ftot + g, mloc = wave_max(wend);
                ((LAS float*)(lds + X1M_EE))[tid] = __expf(wend - mloc);
                float* tp = Tst + (size_t)it * 192;
                tp[tid] = fcum; tp[64 + tid] = g; tp[128 + tid] = pm;
                if (tid == 0) { Sst[(size_t)it * 4 + 0] = ftot; Sst[(size_t)it * 4 + 1] = mloc; }
            }
            __syncthreads();
            {
                const LAS float* ee = (const LAS float*)(lds + X1M_EE);
                int tl = tid; asm volatile("" : "+v"(tl));
#pragma unroll
                for (int s = 0; s < 3; ++s) {
                    const int task = tl + NT * s, j = task / 24, g = task - 24 * j;
                    if (g < 8) {
                        float f[8]; unpack8(rc[s], f);
                        const float e1 = ee[j];
#pragma unroll
                        for (int e = 0; e < 8; ++e) *(LAS bf16_t*)(lds + X1M_KET + swz_off(8 * g + e, j * 2)) = f2bf(f[e] * e1);
                    } else {
                        const int v0 = 8 * (g - 8);
#pragma unroll
                        for (int e = 0; e < 8; ++e) { const unsigned wv = rc[s][e >> 1]; *(LAS bf16_t*)(lds + X1M_VT + swz_off(v0 + e, j * 2)) = (bf16_t)((e & 1) ? (wv >> 16) : (wv & 0xffffu)); }
                    }
                }
            }
            if (it + (int)gridDim.x < NML_ITEMS) load(it + gridDim.x);
            __syncthreads();
            {
                const bf16x8 vf0 = ldfrag_sw(lds + X1M_VT, wid * 16, 0, lane), vf1 = ldfrag_sw(lds + X1M_VT, wid * 16, 32, lane);
#pragma unroll
                for (int kt = 0; kt < 4; ++kt) {
                    f32x4 sa = __builtin_amdgcn_mfma_f32_16x16x32_bf16(ldfrag_sw(lds + X1M_KET, kt * 16, 0, lane), vf0, (f32x4){0.f, 0.f, 0.f, 0.f}, 0, 0, 0);
                    sa = __builtin_amdgcn_mfma_f32_16x16x32_bf16(ldfrag_sw(lds + X1M_KET, kt * 16, 32, lane), vf1, sa, 0, 0, 0);
                    u32x2 o; o.x = pk2(sa[0], sa[1]); o.y = pk2(sa[2], sa[3]);
                    *(u32x2*)(Cst + ((size_t)it * 128 + wid * 16 + r16) * 64 + kt * 16 + 4 * q) = o;
                }
                if (wid < 4) {
                    f32x4 na = __builtin_amdgcn_mfma_f32_16x16x32_bf16(ldfrag_sw(lds + X1M_KET, wid * 16, 0, lane), ldfrag(lds + X1M_ONE, LDTB, 0, 0, lane), (f32x4){0.f, 0.f, 0.f, 0.f}, 0, 0, 0);
                    na = __builtin_amdgcn_mfma_f32_16x16x32_bf16(ldfrag_sw(lds + X1M_KET, wid * 16, 32, lane), ldfrag(lds + X1M_ONE, LDTB, 0, 32, lane), na, 0, 0, 0);
                    if (r16 == 0) *(f32x4*)(Nst + (size_t)it * 64 + wid * 16 + 4 * q) = na;
                }
            }
            __syncthreads();
        }
    }
}

constexpr int EX2_UB = 12;
static_assert(NCH64 % EX2_UB == 0, "EX2 batches");
__device__ __forceinline__ void phase_ex2(int wv, KP Pk, int layer) {
    asm volatile("" : "+s"(Pk));
    const CAS Params& P = *Pk;
    const int tid = ltid(wv);
    (void)layer;
    if (blockIdx.x < 128) {
        const int gt = blockIdx.x * NT + tid, sq = gt >> 10, rem = gt & 1023;
        bf16_t* Hst = (bf16_t*)(P.ws + WS_XSS) + (size_t)sq * NCH64 * 4096 + rem * 4;
        const float* Dst = (const float*)(P.ws + WS_XSD) + sq * NCH64;
        float h0 = 0.f, h1 = 0.f, h2 = 0.f, h3 = 0.f;
#pragma unroll 1
        for (int c0 = 0; c0 < NCH64; c0 += EX2_UB) {
            u32x2 loc[EX2_UB]; float dd[EX2_UB];
            bf16_t* hp = Hst + (size_t)c0 * 4096;
#pragma unroll
            for (int u = 0; u < EX2_UB; ++u) { loc[u] = *(const u32x2*)(hp + (size_t)u * 4096); dd[u] = Dst[c0 + u]; }
#pragma unroll
            for (int u = 0; u < EX2_UB; ++u) {
                u32x2 o; o.x = pk2(h0, h1); o.y = pk2(h2, h3);
                *(u32x2*)(hp + (size_t)u * 4096) = o;
                const float d = dd[u];
                h0 = d * h0 + bflo(loc[u].x); h1 = d * h1 + bfhi(loc[u].x); h2 = d * h2 + bflo(loc[u].y); h3 = d * h3 + bfhi(loc[u].y);
            }
        }
    } else if (blockIdx.x < 256) {
        const int gt = (blockIdx.x - 128) * NT + tid, sq = gt >> 11, rem = gt & 2047;
        bf16_t* Cst = (bf16_t*)(P.ws + WS_XMC) + (size_t)sq * NCH64 * 8192 + rem * 4;
        float* Nst = (float*)(P.ws + WS_XMN) + (size_t)sq * NCH64 * 64 + (rem & 15) * 4;
        float* Sst = (float*)(P.ws + WS_XMS) + (size_t)sq * NCH64 * 4;
        const bool own_n = rem < 16, own_m = rem == 0;
        float c0_ = 0.f, c1 = 0.f, c2 = 0.f, c3 = 0.f, m = -1e30f;
        f32x4 nn = (f32x4){0.f, 0.f, 0.f, 0.f};
#pragma unroll 1
        for (int cb = 0; cb < NCH64; cb += EX2_UB) {
            u32x2 loc[EX2_UB]; float ft[EX2_UB], ml[EX2_UB]; f32x4 nl[EX2_UB];
            bf16_t* cp = Cst + (size_t)cb * 8192; float* np = Nst + (size_t)cb * 64; float* sp_ = Sst + cb * 4;
#pragma unroll
            for (int u = 0; u < EX2_UB; ++u) {
                loc[u] = *(const u32x2*)(cp + (size_t)u * 8192); ft[u] = sp_[u * 4 + 0]; ml[u] = sp_[u * 4 + 1];
                nl[u] = (f32x4){0.f, 0.f, 0.f, 0.f};
                if (own_n) nl[u] = *(const f32x4*)(np + (size_t)u * 64);
            }
#pragma unroll
            for (int u = 0; u < EX2_UB; ++u) {
                const float ftot = ft[u], mloc = ml[u];
                const float mnew = fmaxf(ftot + m, mloc), sp = __expf(ftot + m - mnew), sl = __expf(mloc - mnew);
                u32x2 o; o.x = pk2(c0_, c1); o.y = pk2(c2, c3);
                *(u32x2*)(cp + (size_t)u * 8192) = o;
                c0_ = sp * c0_ + sl * bflo(loc[u].x); c1 = sp * c1 + sl * bfhi(loc[u].x); c2 = sp * c2 + sl * bflo(loc[u].y); c3 = sp * c3 + sl * bfhi(loc[u].y);
                if (own_n) { *(f32x4*)(np + (size_t)u * 64) = nn; nn = nn * sp + nl[u] * sl; }
                if (own_m) sp_[u * 4 + 2] = m;
                m = mnew;
            }
        }
    }
}

constexpr int X3S_BT = 0, X3S_CT = X3S_BT + 64 * LDTB, X3S_XT = X3S_CT + 64 * LDTB, X3S_HB = X3S_XT + 64 * LDTS, X3S_M = X3S_HB + 64 * LDTB, X3S_CUM = X3S_M + 64 * LDTB, X3S_DTV = X3S_CUM + 256, X3S_ROWS = X3S_DTV + 256, X3S_END = X3S_ROWS + 256;
constexpr int X3M_QT = 0, X3M_KT = X3M_QT + 64 * LDTB, X3M_VT = X3M_KT + 64 * LDTB, X3M_CB = X3M_VT + 128 * LDTS, X3M_W = X3M_CB + 128 * LDTB, X3M_ONE = X3M_W + 64 * LDTB, X3M_NB = X3M_ONE + 16 * LDTB,
              X3M_SC = X3M_NB + 16 * LDTB, X3M_END = X3M_SC + 6 * 256;
static_assert(X3M_END <= LDS_BYTES - 16 && X3S_END <= LDS_BYTES - 16, "EX3 LDS maps");
__device__ __forceinline__ void phase_ex3(int wv, KP Pk, int layer, LAS char* lds) {
    asm volatile("" : "+s"(Pk));
    const CAS Params& P = *Pk;
    const int tid = ltid(wv), lane = tid & 63, wid = tid >> 6, q = lane >> 4, r16 = lane & 15, i_ = layer >> 1;
    const bf16_t* XBC = (const bf16_t*)(P.ws + WS_EXBC); const bf16_t* QK = (const bf16_t*)(P.ws + WS_EQK); const bf16_t* Pb = (const bf16_t*)(P.ws + WS_P);
    const float* GT = (const float*)(P.ws + WS_EGT);
    {
        const bf16_t* Hst = (const bf16_t*)(P.ws + WS_XSS);
        u32x4 rc[3], rh; float rdt = 0.f; int rrow = 0;
        auto geom = [&](int it, int& b, int& h, int& dir, int& c) { const int sq = it / NCH64; c = it - sq * NCH64; b = sq >> 4; h = (sq >> 1) & 7; dir = sq & 1; };
        auto load = [&](int it) {
            int b, h, dir, c; geom(it, b, h, dir, c);
            int tl = tid; asm volatile("" : "+v"(tl));
#pragma unroll
            for (int s = 0; s < 3; ++s) {
                const int task = tl + NT * s, j = task / 24, g = task - 24 * j;
                const int row = scan_row(c * CL + j, b, dir, 0);
                rc[s] = *(const u32x4*)(XBC + (size_t)row * 768 + (g < 8 ? h * 64 + 8 * g : g < 16 ? 512 + (h >> 2) * 64 + 8 * (g - 8) : 640 + (h >> 2) * 64 + 8 * (g - 16)));
            }
            rh = *(const u32x4*)(Hst + (size_t)it * 4096 + tl * 8);
            if (tl < CL) { rrow = scan_row(c * CL + tl, b, dir, 0); rdt = GT[(size_t)rrow * 32 + dir * 8 + h]; }
        };
        int it = blockIdx.x;
        if (it < NSSD_ITEMS) load(it);
        __syncthreads();
        for (; it < NSSD_ITEMS; it += gridDim.x) {
            int b, h, dir, c; geom(it, b, h, dir, c);
            bf16_t* Y = (bf16_t*)(P.ws + (dir ? WS_YB : WS_YF));
            const float aco = -__expf(P.ssd_a_log[(i_ * 2 + dir) * 8 + h]);
            if (tid < CL) {
                const float cum = wave_cumsum(rdt * aco, lane);
                ((LAS float*)(lds + X3S_CUM))[tid] = cum; ((LAS float*)(lds + X3S_DTV))[tid] = rdt; ((LAS int*)(lds + X3S_ROWS))[tid] = rrow;
            }
            __syncthreads();
            {
                int tl = tid; asm volatile("" : "+v"(tl));
#pragma unroll
                for (int s = 0; s < 3; ++s) {
                    const int task = tl + NT * s, j = task / 24, g = task - 24 * j;
                    if (g < 8) {
                        float f[8]; unpack8(rc[s], f);
                        const float dt = ((const LAS float*)(lds + X3S_DTV))[j];
#pragma unroll
                        for (int e = 0; e < 8; ++e) *(LAS bf16_t*)(lds + X3S_XT + swz_off(8 * g + e, j * 2)) = f2bf(f[e] * dt);
                    } else if (g < 16) *(LAS u32x4*)(lds + X3S_BT + j * LDTB + 8 * (g - 8) * 2) = rc[s];
                    else *(LAS u32x4*)(lds + X3S_CT + j * LDTB + 8 * (g - 16) * 2) = rc[s];
                }
                *(LAS u32x4*)(lds + X3S_HB + (tl >> 3) * LDTB + (tl & 7) * 16) = rh;
            }
            if (it + (int)gridDim.x < NSSD_ITEMS) load(it + gridDim.x);
            __syncthreads();
            const LAS float* cum = (const LAS float*)(lds + X3S_CUM);
            {
                const int lt = wid >> 1;
#pragma unroll
                for (int u = 0; u < 2; ++u) {
                    const int st = (wid & 1) * 2 + u;
                    f32x4 acc = (f32x4){0.f, 0.f, 0.f, 0.f};
                    if (st <= lt) {
#pragma unroll
                        for (int k0 = 0; k0 < 64; k0 += 32) acc = __builtin_amdgcn_mfma_f32_16x16x32_bf16(ldfrag(lds + X3S_BT, LDTB, st * 16, k0, lane), ldfrag(lds + X3S_CT, LDTB, lt * 16, k0, lane), acc, 0, 0, 0);
                        const int l = lt * 16 + r16, s0 = st * 16 + 4 * q;
                        const float cl = cum[l]; const f32x4 cs = *(const LAS f32x4*)(cum + s0);
#pragma unroll
                        for (int j = 0; j < 4; ++j) acc[j] = (s0 + j <= l) ? acc[j] * __expf(cl - cs[j]) : 0.f;
                    }
                    st4bf(lds + X3S_M + (lt * 16 + r16) * LDTB + (st * 16 + 4 * q) * 2, acc);
                }
            }
            __syncthreads();
            {
                const int lt = wid >> 1, l = lt * 16 + r16;
                const float el = __expf(cum[l]);
                const int row = ((const LAS int*)(lds + X3S_ROWS))[l];
                const bf16x8 mf0 = ldfrag(lds + X3S_M, LDTB, lt * 16, 0, lane), mf1 = ldfrag(lds + X3S_M, LDTB, lt * 16, 32, lane);
                const bf16x8 cf0 = ldfrag(lds + X3S_CT, LDTB, lt * 16, 0, lane), cf1 = ldfrag(lds + X3S_CT, LDTB, lt * 16, 32, lane);
#pragma unroll
                for (int u = 0; u < 2; ++u) {
                    const int pt = (wid & 1) * 2 + u;
                    f32x4 ya = __builtin_amdgcn_mfma_f32_16x16x32_bf16(ldfrag_sw(lds + X3S_XT, pt * 16, 0, lane), mf0, (f32x4){0.f, 0.f, 0.f, 0.f}, 0, 0, 0);
                    ya = __builtin_amdgcn_mfma_f32_16x16x32_bf16(ldfrag_sw(lds + X3S_XT, pt * 16, 32, lane), mf1, ya, 0, 0, 0);
                    f32x4 oa = __builtin_amdgcn_mfma_f32_16x16x32_bf16(ldfrag(lds + X3S_HB, LDTB, pt * 16, 0, lane), cf0, (f32x4){0.f, 0.f, 0.f, 0.f}, 0, 0, 0);
                    oa = __builtin_amdgcn_mfma_f32_16x16x32_bf16(ldfrag(lds + X3S_HB, LDTB, pt * 16, 32, lane), cf1, oa, 0, 0, 0);
                    u32x2 o; o.x = pk2(ya[0] + el * oa[0], ya[1] + el * oa[1]); o.y = pk2(ya[2] + el * oa[2], ya[3] + el * oa[3]);
                    *(u32x2*)(Y + (size_t)row * D + h * 64 + pt * 16 + 4 * q) = o;
                }
            }
            __syncthreads();
        }
    }
    {
        const bf16_t* Cst = (const bf16_t*)(P.ws + WS_XMC); const float* Nst = (const float*)(P.ws + WS_XMN); const float* Sst = (const float*)(P.ws + WS_XMS); const float* Tst = (const float*)(P.ws + WS_XMT);
        for (int i = tid; i < 16 * LDTB / 4; i += NT) ((LAS unsigned*)(lds + X3M_ONE))[i] = 0x3f803f80u;
        u32x4 rc[4], rcb[2]; float rfc = 0.f, rg = 0.f, rpm = 0.f, rmp = 0.f, rn = 0.f; int rrow = 0;
        auto geom = [&](int it, int& b, int& h, int& dir, int& c) { const int sq = it / NCH64; c = it - sq * NCH64; b = sq >> 3; h = (sq >> 1) & 3; dir = sq & 1; };
        auto load = [&](int it) {
            int b, h, dir, c; geom(it, b, h, dir, c);
            int tl = tid; asm volatile("" : "+v"(tl));
#pragma unroll
            for (int s = 0; s < 4; ++s) {
                const int task = tl + NT * s, j = task >> 5, g = task & 31;
                const int row = scan_row(c * CL + j, b, dir, 0);
                rc[s] = g < 16 ? *(const u32x4*)(QK + (size_t)row * 512 + (g < 8 ? h * 64 + 8 * g : 256 + h * 64 + 8 * (g - 8))) : *(const u32x4*)(Pb + (size_t)row * LDP_EVEN + 1808 + h * 128 + 8 * (g - 16));
            }
#pragma unroll
            for (int s = 0; s < 2; ++s) rcb[s] = *(const u32x4*)(Cst + (size_t)it * 8192 + (tl + NT * s) * 8);
            if (tl < CL) {
                rrow = scan_row(c * CL + tl, b, dir, 0);
                const float* tp = Tst + (size_t)it * 192;
                rfc = tp[tl]; rg = tp[64 + tl]; rpm = tp[128 + tl]; rmp = Sst[(size_t)it * 4 + 2]; rn = Nst[(size_t)it * 64 + tl];
            }
        };
        int it = blockIdx.x;
        if (it < NML_ITEMS) load(it);
        __syncthreads();
        for (; it < NML_ITEMS; it += gridDim.x) {
            int b, h, dir, c; geom(it, b, h, dir, c);
            bf16_t* Y = (bf16_t*)(P.ws + (dir ? WS_YB : WS_YF));
            LAS float* sc = (LAS float*)(lds + X3M_SC);
            {
                int tl = tid; asm volatile("" : "+v"(tl));
#pragma unroll
                for (int s = 0; s < 4; ++s) {
                    const int task = tl + NT * s, j = task >> 5, g = task & 31;
                    if (g < 8) *(LAS u32x4*)(lds + X3M_QT + j * LDTB + 8 * g * 2) = rc[s];
                    else if (g < 16) *(LAS u32x4*)(lds + X3M_KT + j * LDTB + 8 * (g - 8) * 2) = rc[s];
                    else {
                        const int v0 = 8 * (g - 16);
#pragma unroll
                        for (int e = 0; e < 8; ++e) { const unsigned wv = rc[s][e >> 1]; *(LAS bf16_t*)(lds + X3M_VT + swz_off(v0 + e, j * 2)) = (bf16_t)((e & 1) ? (wv >> 16) : (wv & 0xffffu)); }
                    }
                }
#pragma unroll
                for (int s = 0; s < 2; ++s) { const int ch = tl + NT * s; *(LAS u32x4*)(lds + X3M_CB + (ch >> 3) * LDTB + (ch & 7) * 16) = rcb[s]; }
                if (tl < CL) {
                    const float linter = rfc + rmp, mrow = fmaxf(rfc + rpm, linter);
                    sc[tl] = rfc - mrow; sc[64 + tl] = rg; sc[128 + tl] = __expf(linter - mrow); sc[192 + tl] = __expf(-mrow); ((LAS int*)sc)[256 + tl] = rrow;
                    const bf16_t nb = f2bf(rn);
#pragma unroll
                    for (int r = 0; r < 16; ++r) *(LAS bf16_t*)(lds + X3M_NB + r * LDTB + tl * 2) = nb;
                }
            }
            if (it + (int)gridDim.x < NML_ITEMS) load(it + gridDim.x);
            __syncthreads();
            {
                const int lt = wid >> 1;
#pragma unroll
                for (int u = 0; u < 2; ++u) {
                    const int st = (wid & 1) * 2 + u;
                    f32x4 acc = (f32x4){0.f, 0.f, 0.f, 0.f};
                    if (st <= lt) {
#pragma unroll
                        for (int k0 = 0; k0 < 64; k0 += 32) acc = __builtin_amdgcn_mfma_f32_16x16x32_bf16(ldfrag(lds + X3M_KT, LDTB, st * 16, k0, lane), ldfrag(lds + X3M_QT, LDTB, lt * 16, k0, lane), acc, 0, 0, 0);
                        const int l = lt * 16 + r16, s0 = st * 16 + 4 * q;
                        const float rt = sc[l]; const f32x4 gs = *(const LAS f32x4*)(sc + 64 + s0);
#pragma unroll
                        for (int j = 0; j < 4; ++j) acc[j] = (s0 + j <= l) ? acc[j] * __expf(rt + gs[j]) : 0.f;
                    }
                    st4bf(lds + X3M_W + (lt * 16 + r16) * LDTB + (st * 16 + 4 * q) * 2, acc);
                }
            }
            __syncthreads();
            {
                const int lt = wid >> 1, l = lt * 16 + r16;
                const bf16x8 wf0 = ldfrag(lds + X3M_W, LDTB, lt * 16, 0, lane), wf1 = ldfrag(lds + X3M_W, LDTB, lt * 16, 32, lane);
                const bf16x8 qf0 = ldfrag(lds + X3M_QT, LDTB, lt * 16, 0, lane), qf1 = ldfrag(lds + X3M_QT, LDTB, lt * 16, 32, lane);
                f32x4 da = __builtin_amdgcn_mfma_f32_16x16x32_bf16(ldfrag(lds + X3M_ONE, LDTB, 0, 0, lane), wf0, (f32x4){0.f, 0.f, 0.f, 0.f}, 0, 0, 0);
                da = __builtin_amdgcn_mfma_f32_16x16x32_bf16(ldfrag(lds + X3M_ONE, LDTB, 0, 32, lane), wf1, da, 0, 0, 0);
                f32x4 qn = __builtin_amdgcn_mfma_f32_16x16x32_bf16(ldfrag(lds + X3M_NB, LDTB, 0, 0, lane), qf0, (f32x4){0.f, 0.f, 0.f, 0.f}, 0, 0, 0);
                qn = __builtin_amdgcn_mfma_f32_16x16x32_bf16(ldfrag(lds + X3M_NB, LDTB, 0, 32, lane), qf1, qn, 0, 0, 0);
                const float inter = sc[128 + l], emr = sc[192 + l];
                const float inv = __builtin_amdgcn_rcpf(fmaxf(fabsf(da[0] + inter * qn[0]), emr));
                const int row = ((const LAS int*)sc)[256 + l];
#pragma unroll
                for (int u = 0; u < 4; ++u) {
                    const int vt = (wid & 1) * 4 + u;
                    f32x4 na = __builtin_amdgcn_mfma_f32_16x16x32_bf16(ldfrag_sw(lds + X3M_VT, vt * 16, 0, lane), wf0, (f32x4){0.f, 0.f, 0.f, 0.f}, 0, 0, 0);
                    na = __builtin_amdgcn_mfma_f32_16x16x32_bf16(ldfrag_sw(lds + X3M_VT, vt * 16, 32, lane), wf1, na, 0, 0, 0);
                    f32x4 ca = __builtin_amdgcn_mfma_f32_16x16x32_bf16(ldfrag(lds + X3M_CB, LDTB, vt * 16, 0, lane), qf0, (f32x4){0.f, 0.f, 0.f, 0.f}, 0, 0, 0);
                    ca = __builtin_amdgcn_mfma_f32_16x16x32_bf16(ldfrag(lds + X3M_CB, LDTB, vt * 16, 32, lane), qf1, ca, 0, 0, 0);
                    u32x2 o; o.x = pk2((na[0] + inter * ca[0]) * inv, (na[1] + inter * ca[1]) * inv); o.y = pk2((na[2] + inter * ca[2]) * inv, (na[3] + inter * ca[3]) * inv);
                    *(u32x2*)(Y + (size_t)row * D + 512 + h * 128 + vt * 16 + 4 * q) = o;
                }
            }
            __syncthreads();
        }
    }
}

constexpr int HC_RAWF = 0;
constexpr int HC_RAWQ = HC_RAWF + 64 * 128 * 4;
constexpr int HC_SUB = HC_RAWQ + 64 * 128 * 2;
constexpr int HL_QD = 136 * 2;
constexpr int HL_T = 24 * 2;
constexpr int HS_QI = 0, HS_KO = HS_QI + 16 * HL_QD, HS_KET = HS_KO + 16 * HL_QD, HS_ATT = HS_KET + 128 * HL_T, HS_VT = HS_ATT + 16 * HL_T, HS_DEC = HS_VT + 32 * HL_T, HS_SIZE = HS_DEC + 512;
constexpr int HC_SB = HC_SUB + 4 * HS_SIZE;
constexpr int HC_ROWS = HC_SB + 2 * 32 * HL_QD, HC_CST = HC_ROWS + 256, HC_END = HC_CST + 1024;
static_assert(HC_END <= LDS_BYTES - 16, "HGRN2 LDS map");
static_assert(HS_SIZE % 16 == 0 && HC_SB % 16 == 0, "alignment");
__device__ __forceinline__ bf16x8 ldfrag16(const LAS char* tile, int ldb, int row0, int lane) {
    bf16x8 v = *(const LAS bf16x8*)(tile + (row0 + (lane & 15)) * ldb + ((lane >> 4) & 1) * 16);
    if (lane >= 32) v = (bf16x8){0, 0, 0, 0, 0, 0, 0, 0};
    return v;
}
__device__ __forceinline__ void scan_hgrn_c(int wv, KP Pk, int layer, int unit, LAS char* lds) {
    asm volatile("" : "+s"(Pk));
    const CAS Params& P = *Pk;
    const int tid = ltid(wv), lane = tid & 63, wid = tid >> 6, q = lane >> 4, r16 = lane & 15, i_ = layer >> 1;
    const int seq = unit >> 2, quarter = unit & 3, b = seq >> 3, h = (seq >> 1) & 3, dir = seq & 1;
    const bf16_t* Pb = (const bf16_t*)(P.ws + WS_P);
    bf16_t* Y = (bf16_t*)(P.ws + (dir ? WS_YB : WS_YF));
    LAS float* cst = (LAS float*)(lds + HC_CST);
    if (tid < 128) cst[tid] = ((const float*)(P.ws + WS_LB))[layer * 512 + h * 128 + tid];
    else if (tid < 256) cst[tid] = P.hg_f_bias[(size_t)(i_ * 2 + dir) * 512 + h * 128 + tid - 128];
    for (int i = tid; i < 2 * 32 * HL_QD / 4; i += NT) ((LAS unsigned*)(lds + HC_SB))[i] = 0u;
    int tj[5], tg_[5], tcol[5]; bool tv[5];
#pragma unroll
    for (int s = 0; s < 5; ++s) {
        const int task = tid + NT * s; tv[s] = task < 64 * 36; tj[s] = task / 36; tg_[s] = task % 36;
        const int g = tg_[s];
        tcol[s] = g < 16 ? (512 + dir * 512 + h * 128 + 8 * g) : g < 32 ? (h * 128 + 8 * (g - 16)) : (1536 + h * 128 + quarter * 32 + 8 * (g - 32));
    }
    u32x4 rc[5]; int rrow = 0;
    auto load = [&](int c) {
#pragma unroll
        for (int s = 0; s < 5; ++s) {
            rc[s] = (u32x4){0u, 0u, 0u, 0u};
            if (tv[s]) { const int row = scan_row(c * 64 + tj[s], b, dir, 1); rc[s] = *(const u32x4*)(Pb + (size_t)row * LDP_ODD + tcol[s]); }
        }
        if (tid < 64) rrow = scan_row(c * 64 + tid, b, dir, 1);
    };
    auto storeA = [&]() {
#pragma unroll
        for (int s = 0; s < 5; ++s) {
            if (tv[s]) {
                float f[8]; unpack8(rc[s], f);
                const int j = tj[s], g = tg_[s];
                if (g < 16) {
                    float o[8];
#pragma unroll
                    for (int e = 0; e < 8; ++e) { const float lbv = cst[8 * g + e]; o[e] = lbv + (1.f - lbv) * sigmoidf_(f[e] + cst[128 + 8 * g + e]); }
                    LAS float* dst = (LAS float*)(lds + HC_RAWF) + j * 128 + 8 * g;
                    *(LAS f32x4*)dst = (f32x4){o[0], o[1], o[2], o[3]}; *(LAS f32x4*)(dst + 4) = (f32x4){o[4], o[5], o[6], o[7]};
                } else if (g < 32) {
                    float o[8];
#pragma unroll
                    for (int e = 0; e < 8; ++e) o[e] = siluf_(f[e]);
                    *(LAS u32x4*)(lds + HC_RAWQ + (j * 128 + 8 * (g - 16)) * 2) = pack8(o);
                } else {
                    const int v0 = 8 * (g - 32);
                    LAS char* vt = lds + HC_SUB + (j >> 4) * HS_SIZE + HS_VT;
#pragma unroll
                    for (int e = 0; e < 8; ++e) { const unsigned wv = rc[s][e >> 1]; *(LAS bf16_t*)(vt + (v0 + e) * HL_T + (j & 15) * 2) = (bf16_t)((e & 1) ? (wv >> 16) : (wv & 0xffffu)); }
                }
            }
        }
        if (tid < 64) ((LAS int*)(lds + HC_ROWS))[tid] = rrow;
    };
    auto storeB = [&]() {
        const int d = tid & 127, sb = tid >> 7;
        LAS char* st = lds + HC_SUB + sb * HS_SIZE;
        const LAS float* rf = (const LAS float*)(lds + HC_RAWF) + (sb * 16) * 128 + d;
        const LAS bf16_t* rq = (const LAS bf16_t*)(lds + HC_RAWQ) + (sb * 16) * 128 + d;
        float lam = 0.f, lams[16], kfs[16];
#pragma unroll
        for (int t = 0; t < 16; ++t) {
            const float f = rf[t * 128];
            lam += __logf(f);
            const float kf = 1.f - f;
            lams[t] = lam; kfs[t] = kf;
            *(LAS bf16_t*)(st + HS_QI + t * HL_QD + d * 2) = f2bf(bf2f(rq[t * 128]) * __expf(lam));
            *(LAS bf16_t*)(st + HS_KO + t * HL_QD + d * 2) = f2bf(kf * __expf(-lam));
        }
        float ke[16];
#pragma unroll
        for (int t = 0; t < 16; ++t) ke[t] = kfs[t] * __expf(lam - lams[t]);
        *(LAS u32x4*)(st + HS_KET + d * HL_T) = pack8(ke); *(LAS u32x4*)(st + HS_KET + d * HL_T + 16) = pack8(ke + 8);
        ((LAS float*)(st + HS_DEC))[d] = __expf(lam);
    };
    f32x4 sacc[2];
    sacc[0] = sacc[1] = (f32x4){0.f, 0.f, 0.f, 0.f};
    __syncthreads();
    load(0);
    for (int c = 0; c < NSTEPS / 64; ++c) {
        storeA();
        __syncthreads();
        storeB();
        if (c + 1 < NSTEPS / 64) load(c + 1);
        __syncthreads();
        if (wid < 4) {
            LAS char* st = lds + HC_SUB + wid * HS_SIZE;
            f32x4 acc = (f32x4){0.f, 0.f, 0.f, 0.f};
#pragma unroll
            for (int k0 = 0; k0 < 128; k0 += 32) acc = __builtin_amdgcn_mfma_f32_16x16x32_bf16(ldfrag(st + HS_KO, HL_QD, 0, k0, lane), ldfrag(st + HS_QI, HL_QD, 0, k0, lane), acc, 0, 0, 0);
#pragma unroll
            for (int j = 0; j < 4; ++j) acc[j] = (4 * q + j <= r16) ? acc[j] : 0.f;
            st4bf(st + HS_ATT + r16 * HL_T + 4 * q * 2, acc);
        }
        __syncthreads();
#pragma unroll 1
        for (int sb = 0; sb < 4; ++sb) {
            LAS char* st = lds + HC_SUB + sb * HS_SIZE;
            const LAS char* sbr = lds + HC_SB + (sb & 1) * 32 * HL_QD;
            LAS char* sbw = lds + HC_SB + ((sb + 1) & 1) * 32 * HL_QD;
            if (wid < 2) {
                f32x4 ya = __builtin_amdgcn_mfma_f32_16x16x32_bf16(ldfrag16(st + HS_VT, HL_T, wid * 16, lane), ldfrag16(st + HS_ATT, HL_T, 0, lane), (f32x4){0.f, 0.f, 0.f, 0.f}, 0, 0, 0);
#pragma unroll
                for (int k0 = 0; k0 < 128; k0 += 32) ya = __builtin_amdgcn_mfma_f32_16x16x32_bf16(ldfrag(sbr, HL_QD, wid * 16, k0, lane), ldfrag(st + HS_QI, HL_QD, 0, k0, lane), ya, 0, 0, 0);
                const int row = ((const LAS int*)(lds + HC_ROWS))[sb * 16 + r16];
                u32x2 o; o.x = pk2(ya[0], ya[1]); o.y = pk2(ya[2], ya[3]);
                *(u32x2*)(Y + (size_t)row * D + h * 128 + quarter * 32 + wid * 16 + 4 * q) = o;
            }
            {
                const int vt = wid >> 2;
                const bf16x8 vf = ldfrag16(st + HS_VT, HL_T, vt * 16, lane);
#pragma unroll
                for (int u = 0; u < 2; ++u) {
                    const int dt = (wid & 3) * 2 + u;
                    const f32x4 a = __builtin_amdgcn_mfma_f32_16x16x32_bf16(ldfrag16(st + HS_KET, HL_T, dt * 16, lane), vf, (f32x4){0.f, 0.f, 0.f, 0.f}, 0, 0, 0);
                    const f32x4 dc = *(const LAS f32x4*)((const LAS float*)(st + HS_DEC) + dt * 16 + 4 * q);
#pragma unroll
                    for (int j = 0; j < 4; ++j) sacc[u][j] = sacc[u][j] * dc[j] + a[j];
                    st4bf(sbw + (vt * 16 + r16) * HL_QD + (dt * 16 + 4 * q) * 2, sacc[u]);
                }
            }
            __syncthreads();
        }
    }
}

constexpr int RC_RAWW = 0;
constexpr int RC_RAWA = RC_RAWW + 64 * 64 * 4;
constexpr int RC_RAWB = RC_RAWA + 64 * 64 * 2, RC_RAWK = RC_RAWB + 64 * 64 * 2, RC_RAWR = RC_RAWK + 64 * 64 * 2;
constexpr int RC_SUB = RC_RAWR + 64 * 64 * 2;
constexpr int RL_C = 72 * 2, RL_32 = 40 * 2, RL_16 = 24 * 2;
constexpr int RS_AT = 0, RS_RT = RS_AT + 16 * RL_C, RS_KT = RS_RT + 16 * RL_C, RS_BT = RS_KT + 16 * RL_C, RS_KBH = RS_BT + 16 * RL_C, RS_AAK = RS_KBH + 64 * RL_32,
              RS_ARKB = RS_AAK + 16 * RL_16, RS_T = RS_ARKB + 16 * RL_32, RS_AABF = RS_T + 16 * RL_16, RS_GL = RS_AABF + 16 * 16 * 4, RS_VU = RS_GL + 256, RS_SIZE = RS_VU + 32 * RL_32;
constexpr int RC_SB = RC_SUB + 4 * RS_SIZE;
constexpr int RC_RHT = RC_SB + 32 * RL_C;
constexpr int RC_ROWS = RC_RHT + 32 * RL_16, RC_END = RC_ROWS + 256;
static_assert(RC_END <= LDS_BYTES - 16, "RWKV LDS map");
static_assert(RS_SIZE % 16 == 0 && RC_SB % 16 == 0 && RC_RHT % 16 == 0, "alignment");

__device__ __forceinline__ float allreduce8(float v) {
    v += dppmov<0xB1>(v); v += dppmov<0x4E>(v); v += dppmov<0x141>(v);
    return v;
}

__device__ __forceinline__ void phase_prep1(int wv, KP Pk, int layer) {
    asm volatile("" : "+s"(Pk));
    const CAS Params& P = *Pk;
    const int tid = ltid(wv), lane = tid & 63, wid = tid >> 6, i_ = layer >> 1;
    const bf16_t* Pb = (const bf16_t*)(P.ws + WS_P);
    bf16_t* R = (bf16_t*)(P.ws + WS_RWR); bf16_t* K = (bf16_t*)(P.ws + WS_RWK); bf16_t* V = (bf16_t*)(P.ws + WS_RWV); bf16_t* KK = (bf16_t*)(P.ws + WS_RWKK);
    bf16_t* LA = (bf16_t*)(P.ws + WS_LA);
    const float* mu = P.rw_mu + (size_t)i_ * 1856;
    float mur[8], muv[8], muk[8], mul_[8], kkw[8];
#pragma unroll
    for (int e = 0; e < 8; ++e) { mur[e] = mu[8 * lane + e]; muv[e] = mu[1024 + 8 * lane + e]; muk[e] = mu[512 + 8 * lane + e]; mul_[e] = lane < 40 ? mu[1536 + 8 * lane + e] : 0.f; kkw[e] = P.rw_k_k[i_ * 512 + 8 * lane + e]; }
    u32x4 nq[4][3]; float nmp = 0.f, nmn = 0.f;
    auto fetch = [&](int r) {
        int rprev = -1, rnext = -1;
        if (r < NCTX) { const int t = r & 255; if (t > 0) rprev = r - 1; if (t < CTXL - 1) rnext = r + 1; }
        else {
            const int bs = (r - NCTX) >> 13, s = (r - NCTX) & 8191, sg = ((s & 63) << 7) + (s >> 6);
            if (sg > 0) { const int g2 = sg - 1; rprev = NCTX + bs * SEQ + ((g2 & 127) << 6) + (g2 >> 7); }
            if (sg < SEQ - 1) { const int g2 = sg + 1; rnext = NCTX + bs * SEQ + ((g2 & 127) << 6) + (g2 >> 7); }
        }
        const bf16_t* pc = Pb + (size_t)r * LDP_ODD + 2560;
        const bf16_t* pp = Pb + (size_t)(rprev < 0 ? r : rprev) * LDP_ODD + 2560;
        const bf16_t* pn = Pb + (size_t)(rnext < 0 ? r : rnext) * LDP_ODD + 2560;
        nmp = rprev < 0 ? 0.f : 0.5f; nmn = rnext < 0 ? 0.f : 0.5f;
#pragma unroll
        for (int gq = 0; gq < 4; ++gq) {
            const int col = (gq == 0 ? 0 : gq == 1 ? 1024 : gq == 2 ? 512 : 1536) + 8 * lane;
            if (gq < 3 || lane < 40) { nq[gq][0] = *(const u32x4*)(pc + col); nq[gq][1] = *(const u32x4*)(pp + col); nq[gq][2] = *(const u32x4*)(pn + col); }
        }
    };
    nq[3][0] = nq[3][1] = nq[3][2] = (u32x4){0u, 0u, 0u, 0u};
    const int stride = gridDim.x * 8;
    int r = blockIdx.x * 8 + wid;
    if (r < NROWS) fetch(r);
    for (; r < NROWS; r += stride) {
        u32x4 cq[4][3];
#pragma unroll
        for (int gq = 0; gq < 4; ++gq)
#pragma unroll
            for (int k = 0; k < 3; ++k) cq[gq][k] = nq[gq][k];
        const float mp = nmp, mn = nmn;
        if (r + stride < NROWS) fetch(r + stride);
        auto mix8 = [&](const u32x4 (&c)[3], const float* muc, float* o) {
            float fc[8], fp[8], fn[8];
            unpack8(c[0], fc); unpack8(c[1], fp); unpack8(c[2], fn);
#pragma unroll
            for (int e = 0; e < 8; ++e) o[e] = fc[e] + muc[e] * (mp * fp[e] + mn * fn[e] - fc[e]);
        };
        float o[8];
        mix8(cq[0], mur, o); *(u32x4*)(R + (size_t)r * 512 + 8 * lane) = pack8(o);
        mix8(cq[1], muv, o); *(u32x4*)(V + (size_t)r * 512 + 8 * lane) = pack8(o);
        mix8(cq[2], muk, o); *(u32x4*)(K + (size_t)r * 512 + 8 * lane) = pack8(o);
        {
            float kk[8], ss = 0.f;
#pragma unroll
            for (int e = 0; e < 8; ++e) { kk[e] = o[e] * kkw[e]; ss += kk[e] * kk[e]; }
            ss = group_sum<8>(ss);
            const float rn = rsqrtf(fmaxf(ss, 1e-12f));
#pragma unroll
            for (int e = 0; e < 8; ++e) kk[e] *= rn;
            *(u32x4*)(KK + (size_t)r * 512 + 8 * lane) = pack8(kk);
        }
        if (lane < 40) {
            mix8(cq[3], mul_, o);
            if (lane < 16) {
#pragma unroll
                for (int e = 0; e < 8; ++e) o[e] = tanh_fast(o[e]);
            } else if (lane >= 24) {
#pragma unroll
                for (int e = 0; e < 8; ++e) o[e] = sigmoidf_(o[e]);
            }
            *(u32x4*)(LA + (size_t)r * 320 + 8 * lane) = pack8(o);
        }
    }
}

__device__ __forceinline__ void phase_out_even(int wv, KP Pk, int layer) {
    asm volatile("" : "+s"(Pk));
    const CAS Params& P = *Pk;
    const int tid = ltid(wv), lane = tid & 63, wid = tid >> 6, i_ = layer >> 1;
    const bf16_t* Pb = (const bf16_t*)(P.ws + WS_P);
    const bf16_t* Yf = (const bf16_t*)(P.ws + WS_YF); const bf16_t* Yb = (const bf16_t*)(P.ws + WS_YB);
    bf16_t* feat = (bf16_t*)(P.ws + WS_FEAT);
    const int r0 = (layer == DEPTH - 1) ? NCTX : 0;
    const bf16_t* XBC = (const bf16_t*)(P.ws + WS_EXBC);
    float nwa[8], nwb[8];
#pragma unroll
    for (int e = 0; e < 8; ++e) { nwa[e] = P.ssd_norm_w[i_ * 512 + 8 * lane + e]; nwb[e] = P.ml_norm_w[i_ * 512 + 8 * lane + e]; }
    const float dsk = P.ssd_d[i_ * 8 + (lane >> 3)];
    u32x4 n0, n1, n2, n3, n4, n5, n6;
    auto fetch = [&](int rr) {
        const bf16_t* pr = Pb + (size_t)rr * LDP_EVEN;
        n0 = *(const u32x4*)(Yf + (size_t)rr * D + 8 * lane); n1 = *(const u32x4*)(Yb + (size_t)rr * D + 8 * lane);
        n2 = *(const u32x4*)(XBC + (size_t)rr * 768 + 8 * lane); n3 = *(const u32x4*)(pr + 8 * lane);
        n4 = *(const u32x4*)(Yf + (size_t)rr * D + 512 + 8 * lane); n5 = *(const u32x4*)(Yb + (size_t)rr * D + 512 + 8 * lane); n6 = *(const u32x4*)(pr + 2320 + 8 * lane);
    };
    const int stride = gridDim.x * 8;
    int r = r0 + blockIdx.x * 8 + wid;
    if (r < NROWS) fetch(r);
    for (; r < NROWS; r += stride) {
        const u32x4 c0 = n0, c1 = n1, c2 = n2, c3 = n3, c4 = n4, c5 = n5, c6 = n6;
        if (r + stride < NROWS) fetch(r + stride);
        float y[8];
        {
            float a[8], bb[8], xsv[8], z[8];
            unpack8(c0, a); unpack8(c1, bb);
            unpack8(c2, xsv); unpack8(c3, z);
            float ss = 0.f;
#pragma unroll
            for (int e = 0; e < 8; ++e) {
                y[e] = (a[e] + bb[e] + dsk * xsv[e]) * siluf_(z[e]); ss += y[e] * y[e];
            }
            ss = wave_sum(ss);
            const float rn = rsqrtf(ss * (1.f / 512.f) + 1e-6f);
#pragma unroll
            for (int e = 0; e < 8; ++e) y[e] = y[e] * rn * nwa[e];
            *(u32x4*)(feat + (size_t)r * D + 8 * lane) = pack8(y);
        }
        {
            float a[8], bb[8], o[8];
            unpack8(c4, a); unpack8(c5, bb);
            unpack8(c6, o);
            float s = 0.f;
#pragma unroll
            for (int e = 0; e < 8; ++e) { y[e] = a[e] + bb[e]; s += y[e]; }
            const float mean = group_sum<16>(s) * (1.f / 128.f);
            float ss = 0.f;
#pragma unroll
            for (int e = 0; e < 8; ++e) { y[e] -= mean; ss += y[e] * y[e]; }
            const float rn = rsqrtf(group_sum<16>(ss) * (1.f / 128.f) + 1e-6f);
#pragma unroll
            for (int e = 0; e < 8; ++e) y[e] = sigmoidf_(o[e]) * (y[e] * rn) * nwb[e];
            *(u32x4*)(feat + (size_t)r * D + 512 + 8 * lane) = pack8(y);
        }
    }
}
__device__ __forceinline__ void phase_out_odd(int wv, KP Pk, int layer) {
    asm volatile("" : "+s"(Pk));
    const CAS Params& P = *Pk;
    const int tid = ltid(wv), lane = tid & 63, wid = tid >> 6, i_ = layer >> 1;
    const bf16_t* Pb = (const bf16_t*)(P.ws + WS_P);
    const bf16_t* Yf = (const bf16_t*)(P.ws + WS_YF); const bf16_t* Yb = (const bf16_t*)(P.ws + WS_YB);
    const bf16_t* R = (const bf16_t*)(P.ws + WS_RWR); const bf16_t* K = (const bf16_t*)(P.ws + WS_RWK); const bf16_t* V = (const bf16_t*)(P.ws + WS_RWV); const bf16_t* G = (const bf16_t*)(P.ws + WS_RWG);
    bf16_t* feat = (bf16_t*)(P.ws + WS_FEAT);
    const int r0 = (layer == DEPTH - 1) ? NCTX : 0;
    float nwc[8], rk[8], lw[8], lbv[8];
#pragma unroll
    for (int e = 0; e < 8; ++e) {
        nwc[e] = P.hg_norm_w[i_ * 512 + 8 * lane + e]; rk[e] = P.rw_r_k[i_ * 512 + 8 * lane + e];
        lw[e] = P.rw_ln_w[i_ * 512 + 8 * lane + e]; lbv[e] = P.rw_ln_b[i_ * 512 + 8 * lane + e];
    }
    u32x4 n0, n1, n2, n3, n4, n5, n6, n7, n8;
    auto fetch = [&](int rr) {
        n0 = *(const u32x4*)(Yf + (size_t)rr * D + 8 * lane); n1 = *(const u32x4*)(Yb + (size_t)rr * D + 8 * lane); n2 = *(const u32x4*)(Pb + (size_t)rr * LDP_ODD + 2048 + 8 * lane);
        n3 = *(const u32x4*)(Yf + (size_t)rr * D + 512 + 8 * lane); n4 = *(const u32x4*)(Yb + (size_t)rr * D + 512 + 8 * lane);
        n5 = *(const u32x4*)(R + (size_t)rr * 512 + 8 * lane); n6 = *(const u32x4*)(K + (size_t)rr * 512 + 8 * lane);
        n7 = *(const u32x4*)(V + (size_t)rr * 512 + 8 * lane); n8 = *(const u32x4*)(G + (size_t)rr * 512 + 8 * lane);
    };
    const int stride = gridDim.x * 8;
    int r = r0 + blockIdx.x * 8 + wid;
    if (r < NROWS) fetch(r);
    for (; r < NROWS; r += stride) {
        const u32x4 c0 = n0, c1 = n1, c2 = n2, c3 = n3, c4 = n4, c5 = n5, c6 = n6, c7 = n7, c8 = n8;
        if (r + stride < NROWS) fetch(r + stride);
        float y[8];
        {
            float a[8], bb[8], g[8];
            unpack8(c0, a); unpack8(c1, bb);
            unpack8(c2, g);
            float ss = 0.f;
#pragma unroll
            for (int e = 0; e < 8; ++e) { y[e] = a[e] + bb[e]; ss += y[e] * y[e]; }
            const float rn = rsqrtf(group_sum<16>(ss) * (1.f / 128.f) + 1e-6f);
#pragma unroll
            for (int e = 0; e < 8; ++e) y[e] = y[e] * rn * nwc[e] * siluf_(g[e]);
            *(u32x4*)(feat + (size_t)r * D + 8 * lane) = pack8(y);
        }
        {
            float a[8], bb[8], rr[8], kk[8], vv[8], g[8];
            unpack8(c3, a); unpack8(c4, bb);
            unpack8(c5, rr); unpack8(c6, kk);
            unpack8(c7, vv); unpack8(c8, g);
            float s = 0.f, bs = 0.f;
#pragma unroll
            for (int e = 0; e < 8; ++e) { y[e] = a[e] + bb[e]; s += y[e]; bs += rr[e] * kk[e] * rk[e]; }
            const float mean = group_sum<8>(s) * (1.f / 64.f); bs = group_sum<8>(bs);
            float ss = 0.f;
#pragma unroll
            for (int e = 0; e < 8; ++e) { y[e] -= mean; ss += y[e] * y[e]; }
            const float rn = rsqrtf(group_sum<8>(ss) * (1.f / 64.f) + 64e-5f);
#pragma unroll
            for (int e = 0; e < 8; ++e) y[e] = (y[e] * rn * lw[e] + lbv[e] + bs * vv[e]) * g[e];
            *(u32x4*)(feat + (size_t)r * D + 512 + 8 * lane) = pack8(y);
        }
    }
}

#ifndef MK_DOUBLE
#define MK_DOUBLE 0
#endif
#define REP(bit, body) do { body; if (MK_DOUBLE & (bit)) { body; } } while (0)
__device__ __forceinline__ void phase_expconv(int wv, KP Pk, int layer, LAS char* lds) {
    asm volatile("" : "+s"(Pk));
    const CAS Params& P = *Pk;
    const int tid = ltid(wv);
    if (layer & 1) return;
    expconv_items(P, layer, lds, exc_s0(layer) + exc_s1(layer), EXC_ITEMS, (int)blockIdx.x * 8 + (tid >> 6), (int)gridDim.x * 8, tid >> 6, tid & 63);
}
__device__ __forceinline__ void expconv_after_scan(int wv, KP Pk, int layer, LAS char* lds) {
    asm volatile("" : "+s"(Pk));
    const CAS Params& P = *Pk;
    const int tid = ltid(wv);
    __syncthreads();
    expconv_items(P, layer, lds, exc_s0(layer) + exc_s1(layer), EXC_ITEMS, (int)blockIdx.x * 8 + (tid >> 6), 128 * 8, tid >> 6, tid & 63);
}
constexpr int L1_AST = 1028;
constexpr int L1_PST = 33;
constexpr int L1_A = 0, L1_PART = L1_A + 16 * L1_AST * 4, L1_SM = L1_PART + 8 * 16 * L1_PST * 4, L1_END = L1_SM + (64 + 2 * 144 + 32) * 4;
static_assert(L1_END <= LDS_BYTES - 16, "LN1 LDS map");
__device__ __forceinline__ void phase_ln1(int wv, KP Pk, int layer, LAS char* lds, bool dry = false) {
    asm volatile("" : "+s"(Pk));
    const CAS Params& P = *Pk;
    const int tid = ltid(wv), lane = tid & 63;
    if (!dry) REP(8, phase_expconv(wv, Pk, layer, lds));
    __syncthreads();
    LAS float* At = (LAS float*)(lds + L1_A);
    LAS float* part = (LAS float*)(lds + L1_PART);
    LAS int* lcnt = (LAS int*)(lds + L1_SM);
    LAS int* lbase = lcnt + 32;
    LAS int* asg = lcnt + 64;
    LAS float* rbias = (LAS float*)(asg + 2 * 144);
    if (tid < 32) { lcnt[tid] = 0; rbias[tid] = P.router_bias[tid]; }
    float breg[8][4][2];
    {
        const float* rw = P.router_w + (size_t)(128 * wv + 4 * (lane >> 4)) * NEXP + (lane & 15);
#pragma unroll
        for (int j = 0; j < 8; ++j)
#pragma unroll
            for (int i = 0; i < 4; ++i) { breg[j][i][0] = rw[(16 * j + i) * NEXP]; breg[j][i][1] = rw[(16 * j + i) * NEXP + 16]; }
    }
    __syncthreads();
    const bf16_t* yo = (const bf16_t*)(P.ws + WS_YO);
    bf16_t* act = (bf16_t*)(P.ws + (dry ? WS_FEAT : WS_ACT));
    bf16_t* xcb = (bf16_t*)(P.ws + WS_XC); bf16_t* xob = (bf16_t*)P.out;
    const bool lastl = (layer == DEPTH - 1);
    int* cnt = (int*)(P.ws + WS_CNT) + layer * 32 * CNT_STRIDE;
    int* list = (int*)(P.ws + WS_LIST);
    float* wts = (float*)(P.ws + WS_WTS);
    const float* lg = P.ln_g + (size_t)(layer * 2 + 0) * D; const float* lb = P.ln_b + (size_t)(layer * 2 + 0) * D;
    const int r0 = (layer == DEPTH - 1) ? NCTX : 0, ntiles = (NROWS - r0) / 16, G = gridDim.x;
    f32x4 g1v[4], s2c[4], h2c[4];
#pragma unroll
    for (int i = 0; i < 4; ++i) g1v[i] = s2c[i] = h2c[i] = (f32x4){0.f, 0.f, 0.f, 0.f};
    int mcur = -1;
    f32x4 nx[2][4]; u32x2 nyo[2][4];
    auto fetch = [&](int s, int rr) {
        if (layer == 0) {
            const float* xq = rr < NCTX ? P.ctx + (size_t)rr * D : P.x + (size_t)(rr - NCTX) * D;
#pragma unroll
            for (int i = 0; i < 4; ++i) nx[s][i] = *(const f32x4*)(xq + 4 * lane + 256 * i);
        } else {
            const bf16_t* xq = rr < NCTX ? xcb + (size_t)rr * D : xob + (size_t)(rr - NCTX) * D;
#pragma unroll
            for (int i = 0; i < 4; ++i) { const u32x2 t = *(const u32x2*)(xq + 4 * lane + 256 * i); nx[s][i] = (f32x4){__uint_as_float(t.x), __uint_as_float(t.y), 0.f, 0.f}; }
        }
#pragma unroll
        for (int i = 0; i < 4; ++i) { const int c = 4 * lane + 256 * i; nyo[s][i] = *(const u32x2*)(yo + (size_t)rr * D + c); }
    };
    int tile = blockIdx.x;
    if (tile < ntiles) { fetch(0, r0 + tile * 16 + 2 * wv); fetch(1, r0 + tile * 16 + 2 * wv + 1); }
    for (int it = 0; tile < ntiles; ++it, tile += G) {
        const int rb = r0 + tile * 16 + 2 * wv;
        const int m = row_mod(rb);
        if (m != mcur) {
            mcur = m;
            const float* g1 = modvec(P.ws, layer, m, 2); const float* sh2 = modvec(P.ws, layer, m, 3); const float* sc2 = modvec(P.ws, layer, m, 4);
#pragma unroll
            for (int i = 0; i < 4; ++i) { const int c = 4 * lane + 256 * i; g1v[i] = *(const f32x4*)(g1 + c); s2c[i] = *(const f32x4*)(sc2 + c); h2c[i] = *(const f32x4*)(sh2 + c); }
        }
#pragma unroll
        for (int s = 0; s < 2; ++s) {
            const int r = rb + s;
            bf16_t* xr = dry ? (bf16_t*)(P.ws + WS_YF) + (size_t)r * D : lastl ? (bf16_t*)(P.ws + WS_FEAT) + (size_t)r * D : r < NCTX ? xcb + (size_t)r * D : xob + (size_t)(r - NCTX) * D;
            f32x4 v[4]; float sm = 0.f;
#pragma unroll
            for (int i = 0; i < 4; ++i) {
                f32x4 xv = nx[s][i]; const f32x4 gv = g1v[i]; const u32x2 yv = nyo[s][i];
                if (layer != 0) { const unsigned b0 = __float_as_uint(xv[0]), b1 = __float_as_uint(xv[1]); xv = (f32x4){bflo(b0), bfhi(b0), bflo(b1), bfhi(b1)}; }
                v[i][0] = ALPHA * xv[0] + gv[0] * bflo(yv.x); v[i][1] = ALPHA * xv[1] + gv[1] * bfhi(yv.x);
                v[i][2] = ALPHA * xv[2] + gv[2] * bflo(yv.y); v[i][3] = ALPHA * xv[3] + gv[3] * bfhi(yv.y);
                sm += (v[i][0] + v[i][1]) + (v[i][2] + v[i][3]);
            }
            if (tile + G < ntiles) fetch(s, r + G * 16);
            const float mean = wave_sum(sm) * (1.f / D);
            float s2 = 0.f;
#pragma unroll
            for (int i = 0; i < 4; ++i) { v[i] = v[i] - mean; s2 += (v[i][0] * v[i][0] + v[i][1] * v[i][1]) + (v[i][2] * v[i][2] + v[i][3] * v[i][3]); }
            const float rstd = rsqrtf(wave_sum(s2) * (1.f / D) + 1e-5f);
            LAS float* arow = At + (2 * wv + s) * L1_AST;
#pragma unroll
            for (int i = 0; i < 4; ++i) {
                const int c = 4 * lane + 256 * i;
                const f32x4 gg = *(const f32x4*)(lg + c), bb = *(const f32x4*)(lb + c), s2v = s2c[i], h2v = h2c[i];
                f32x4 xn, hv;
#pragma unroll
                for (int j = 0; j < 4; ++j) { xn[j] = v[i][j] * rstd * gg[j] + bb[j]; hv[j] = xn[j] * (1.f + s2v[j]) + h2v[j]; }
                { u32x2 ox; ox.x = pk2(xn[0], xn[1]); ox.y = pk2(xn[2], xn[3]); *(u32x2*)(xr + c) = ox; }
                u32x2 o; o.x = pk2(hv[0], hv[1]); o.y = pk2(hv[2], hv[3]); *(u32x2*)(act + (size_t)r * D + c) = o;
                *(LAS f32x4*)(arow + c) = hv;
            }
        }
        __syncthreads();
        {
            f32x4 ra0 = (f32x4){0.f, 0.f, 0.f, 0.f}, ra1 = ra0;
            const LAS float* ap = At + (lane & 15) * L1_AST + 128 * wv + 4 * (lane >> 4);
#pragma unroll
            for (int j = 0; j < 8; ++j) {
                const f32x4 a4 = *(const LAS f32x4*)(ap + 16 * j);
#pragma unroll
                for (int i = 0; i < 4; ++i) {
                    ra0 = __builtin_amdgcn_mfma_f32_16x16x4f32(a4[i], breg[j][i][0], ra0, 0, 0, 0);
                    ra1 = __builtin_amdgcn_mfma_f32_16x16x4f32(a4[i], breg[j][i][1], ra1, 0, 0, 0);
                }
            }
            LAS float* pw = part + wv * 16 * L1_PST + (4 * (lane >> 4)) * L1_PST + (lane & 15);
#pragma unroll
            for (int j = 0; j < 4; ++j) { pw[j * L1_PST] = ra0[j]; pw[j * L1_PST + 16] = ra1[j]; }
        }
        __syncthreads();
        {
            const int half = lane >> 5, e = lane & 31;
            const LAS float* pp = part + (2 * wv + half) * L1_PST + e;
            float sc_ = 0.f;
#pragma unroll
            for (int k = 0; k < 8; ++k) sc_ += pp[k * 16 * L1_PST];
            const float sg = sigmoidf_(sc_), vb = sg + rbias[e];
            float bv[4], sv[4];
            bv[0] = dppmov<0x00>(vb); bv[1] = dppmov<0x55>(vb); bv[2] = dppmov<0xAA>(vb); bv[3] = dppmov<0xFF>(vb);
            sv[0] = dppmov<0x00>(sg); sv[1] = dppmov<0x55>(sg); sv[2] = dppmov<0xAA>(sg); sv[3] = dppmov<0xFF>(sg);
            float m1 = -1e30f, m2 = -1e30f;
#pragma unroll
            for (int k = 0; k < 4; ++k) { const float vsc = bv[k]; if (vsc > m1) { m2 = m1; m1 = vsc; } else if (vsc > m2) m2 = vsc; }
            float best = m1 + m2; int bg = e >> 2;
#pragma unroll
            for (int msk = 4; msk <= 16; msk <<= 1) {
                const float ob = __shfl_xor(best, msk); const int og = __shfl_xor(bg, msk);
                const bool take = (ob > best) || (ob == best && og < bg);
                best = take ? ob : best; bg = take ? og : bg;
            }
            int i1 = 0; float b1 = bv[0];
#pragma unroll
            for (int k = 1; k < 4; ++k) if (bv[k] > b1) { b1 = bv[k]; i1 = k; }
            int i2 = -1; float b2 = -1e30f;
#pragma unroll
            for (int k = 0; k < 4; ++k) if (k != i1 && bv[k] > b2) { b2 = bv[k]; i2 = k; }
            float s1 = sv[0], s2s = sv[0];
#pragma unroll
            for (int k = 1; k < 4; ++k) { if (i1 == k) s1 = sv[k]; if (i2 == k) s2s = sv[k]; }
            if (e == 4 * bg && !dry) {
                const int r = rb + half;
                const int e0 = bg * 4 + i1, e1 = bg * 4 + i2;
                const float inv = 1.f / (s1 + s2s);
                const int li = it * 16 + 2 * wv + half;
                const int p0 = __hip_atomic_fetch_add(&lcnt[e0], 1, __ATOMIC_RELAXED, __HIP_MEMORY_SCOPE_WORKGROUP);
                const int p1 = __hip_atomic_fetch_add(&lcnt[e1], 1, __ATOMIC_RELAXED, __HIP_MEMORY_SCOPE_WORKGROUP);
                asg[2 * li] = (e0 << 16) | p0; asg[2 * li + 1] = (e1 << 16) | p1;
                wts[2 * r] = s1 * inv; wts[2 * r + 1] = s2s * inv;
            }
        }
    }
    __syncthreads();
    if (dry) return;
    if (tid < 32) lbase[tid] = atomicAdd(&cnt[tid * CNT_STRIDE], lcnt[tid]);
    __syncthreads();
    for (int idx = tid; idx < 2 * 144; idx += NT) {
        const int li = idx >> 1, k = idx & 1, t = (li >> 4) * G + blockIdx.x;
        if (t < ntiles) { const int r = r0 + t * 16 + (li & 15); const int v = asg[idx], e = v >> 16, lp = v & 0xffff; list[(size_t)e * LISTCAP + lbase[e] + lp] = 2 * r + k; }
    }
}

__device__ __forceinline__ void phase_ln2(int wv, KP Pk, int layer, bool dry = false) {
    asm volatile("" : "+s"(Pk));
    const CAS Params& P = *Pk;
    const int tid = ltid(wv), lane = tid & 63, wid = tid >> 6;
    const bf16_t* yp = (const bf16_t*)(P.ws + WS_YP);
    const float* wts = (const float*)(P.ws + WS_WTS);
    bf16_t* act = (bf16_t*)(P.ws + (dry ? WS_FEAT : WS_ACT));
    bf16_t* xcb = (bf16_t*)(P.ws + WS_XC); bf16_t* xob = (bf16_t*)P.out;
    const float* lg = P.ln_g + (size_t)(layer * 2 + 1) * D; const float* lb = P.ln_b + (size_t)(layer * 2 + 1) * D;
    const bool last = (layer == DEPTH - 1);
    const int r0 = last ? NCTX : 0, stride = gridDim.x * 8;
    f32x4 cg[4], cb[4], g2v[4], s1v[4], h1v[4];
#pragma unroll
    for (int i = 0; i < 4; ++i) { cg[i] = *(const f32x4*)(lg + 4 * lane + 256 * i); cb[i] = *(const f32x4*)(lb + 4 * lane + 256 * i); g2v[i] = s1v[i] = h1v[i] = (f32x4){0.f, 0.f, 0.f, 0.f}; }
    int mcur = -1;
    u32x2 nx[4]; u32x2 ny0[4], ny1[4]; float nw0 = 0.f, nw1 = 0.f;
    auto fetch = [&](int r) {
        const bf16_t* xr = last ? (const bf16_t*)(P.ws + WS_FEAT) + (size_t)r * D : r < NCTX ? xcb + (size_t)r * D : xob + (size_t)(r - NCTX) * D;
#pragma unroll
        for (int i = 0; i < 4; ++i) {
            const int c = 4 * lane + 256 * i;
            nx[i] = *(const u32x2*)(xr + c); ny0[i] = *(const u32x2*)(yp + (size_t)(2 * r) * D + c); ny1[i] = *(const u32x2*)(yp + (size_t)(2 * r + 1) * D + c);
        }
        nw0 = wts[2 * r]; nw1 = wts[2 * r + 1];
    };
    int r = r0 + blockIdx.x * 8 + wid;
    if (r < NROWS) fetch(r);
    for (; r < NROWS; r += stride) {
        const int m = row_mod(r);
        if (m != mcur) {
            mcur = m;
            const float* g2 = modvec(P.ws, layer, m, 5); const float* sh1 = last ? lg : modvec(P.ws, layer + 1, m, 0); const float* sc1 = last ? lg : modvec(P.ws, layer + 1, m, 1);
#pragma unroll
            for (int i = 0; i < 4; ++i) { const int c = 4 * lane + 256 * i; g2v[i] = *(const f32x4*)(g2 + c); s1v[i] = *(const f32x4*)(sc1 + c); h1v[i] = *(const f32x4*)(sh1 + c); }
        }
        f32x4 v[4]; float s = 0.f;
        const float w0 = nw0, w1 = nw1;
#pragma unroll
        for (int i = 0; i < 4; ++i) {
            const f32x4 xv = (f32x4){bflo(nx[i].x), bfhi(nx[i].x), bflo(nx[i].y), bfhi(nx[i].y)}, gv = g2v[i]; const u32x2 y0 = ny0[i], y1 = ny1[i];
            v[i][0] = ALPHA * xv[0] + gv[0] * (w0 * bflo(y0.x) + w1 * bflo(y1.x)); v[i][1] = ALPHA * xv[1] + gv[1] * (w0 * bfhi(y0.x) + w1 * bfhi(y1.x));
            v[i][2] = ALPHA * xv[2] + gv[2] * (w0 * bflo(y0.y) + w1 * bflo(y1.y)); v[i][3] = ALPHA * xv[3] + gv[3] * (w0 * bfhi(y0.y) + w1 * bfhi(y1.y));
            s += (v[i][0] + v[i][1]) + (v[i][2] + v[i][3]);
        }
        if (r + stride < NROWS) fetch(r + stride);
        const float mean = wave_sum(s) * (1.f / D);
        float s2 = 0.f;
#pragma unroll
        for (int i = 0; i < 4; ++i) { v[i] = v[i] - mean; s2 += (v[i][0] * v[i][0] + v[i][1] * v[i][1]) + (v[i][2] * v[i][2] + v[i][3] * v[i][3]); }
        const float rstd = rsqrtf(wave_sum(s2) * (1.f / D) + 1e-5f);
#pragma unroll
        for (int i = 0; i < 4; ++i) {
            const int c = 4 * lane + 256 * i;
            f32x4 xn;
#pragma unroll
            for (int j = 0; j < 4; ++j) xn[j] = v[i][j] * rstd * cg[i][j] + cb[i][j];
            if (dry) *(f32x4*)((float*)(P.ws + WS_YF) + (size_t)r * D + c) = xn;
            else if (last) *(f32x4*)(P.out + (size_t)(r - NCTX) * D + c) = xn;
            else { u32x2 ox; ox.x = pk2(xn[0], xn[1]); ox.y = pk2(xn[2], xn[3]); *(u32x2*)((r < NCTX ? xcb + (size_t)r * D : xob + (size_t)(r - NCTX) * D) + c) = ox; }
            if (!last) {
                u32x2 o; o.x = pk2(xn[0] * (1.f + s1v[i][0]) + h1v[i][0], xn[1] * (1.f + s1v[i][1]) + h1v[i][1]); o.y = pk2(xn[2] * (1.f + s1v[i][2]) + h1v[i][2], xn[3] * (1.f + s1v[i][3]) + h1v[i][3]);
                *(u32x2*)(act + (size_t)r * D + c) = o;
            }
        }
    }
}

constexpr int NPHASE = 2 + 11 * DEPTH;
__global__ void __launch_bounds__(NT, 2) fwd_kernel(Params P) {
    extern __shared__ __attribute__((aligned(16))) char lds_raw[];
    LAS char* lds = (LAS char*)lds_raw;
    volatile LAS unsigned* xbw = (volatile LAS unsigned*)(lds + LDS_BYTES - 16);
    KP Pk = (KP)__builtin_amdgcn_kernarg_segment_ptr();
    const int wv = __builtin_amdgcn_readfirstlane((int)(threadIdx.x >> 6));
    const bool multi = (P.ph_hi - P.ph_lo) > 1;
    XcdBarrier bar; bar.bar = (unsigned*)(P.ws + WS_BAR); bar.x = 0; bar.st = xbw;
    if (multi) {
        if (ltid(wv) == 0) { xbw[0] = 0u; xbw[1] = 0u; xbw[2] = 0u; xbw[3] = 0u; }
        __syncthreads();
        bar = xcd_barrier_post(wv, (unsigned*)(P.ws + WS_BAR), xbw);
    }
#define PHASE(id, body) do { if (P.ph_lo <= (id) && (id) < P.ph_hi) { body; if ((id) + 1 < P.ph_hi) xcd_barrier(wv, bar); if (MK_DOUBLE & 2048) xcd_barrier(wv, bar); } } while (0)
    PHASE(0, REP(16, phase_prologue0(wv, Pk, lds)));
    PHASE(1, REP(16, phase_prologue1(wv, Pk)));
    for (int l = 0; l < DEPTH; ++l) {
        const int pb = 2 + 11 * l, odd = l & 1;
        PHASE(pb + 0, REP(1, phase_inproj(wv, Pk, l, lds)));
        if (odd) {
            PHASE(pb + 1, REP(4, phase_prep1(wv, Pk, l)));
            PHASE(pb + 2, phase_prep2(wv, Pk, l, lds));
            PHASE(pb + 3, REP(32, { if (blockIdx.x < 128) { REP(64, scan_hgrn_c(wv, Pk, l, blockIdx.x, lds)); expconv_after_scan(wv, Pk, l, lds); } else if (blockIdx.x < 256) REP(128, scan_rwkv_b(wv, Pk, l, blockIdx.x - 128, lds)); }));
            PHASE(pb + 5, REP(4, phase_out_odd(wv, Pk, l)));
        } else {
            PHASE(pb + 1, REP(4, phase_prep_even(wv, Pk, l)));
            PHASE(pb + 2, REP(2, phase_ex1(wv, Pk, l, lds)));
            PHASE(pb + 3, phase_ex2(wv, Pk, l));
            PHASE(pb + 4, REP(2, phase_ex3(wv, Pk, l, lds)));
            PHASE(pb + 5, REP(4, phase_out_even(wv, Pk, l)));
        }
        PHASE(pb + 6, REP(256, phase_outproj(wv, Pk, l, lds)));
        PHASE(pb + 7, { if (MK_DOUBLE & 4096) phase_ln1(wv, Pk, l, lds, true); phase_ln1(wv, Pk, l, lds); });
        PHASE(pb + 8, REP(512, phase_moe1(wv, Pk, l, lds)));
        PHASE(pb + 9, REP(1024, phase_moe2(wv, Pk, l, lds)));
        PHASE(pb + 10, { if (MK_DOUBLE & 8192) phase_ln2(wv, Pk, l, true); phase_ln2(wv, Pk, l); });
    }
#undef PHASE
}


#ifndef MK_STOP
#define MK_STOP NPHASE
#endif
#ifndef MK_DUMP
#define MK_DUMP 0
#endif
#ifndef MK_DUMP_N
#define MK_DUMP_N (1u << 30)
#endif
#ifndef MK_DUMP_LD
#define MK_DUMP_LD 1024
#endif
#ifndef MK_DUMP_C0
#define MK_DUMP_C0 0
#endif
__global__ void diff_kernel(const bf16_t* a, const bf16_t* b, float* out, size_t n) {
    for (size_t i = (size_t)blockIdx.x * blockDim.x + threadIdx.x; i < n; i += (size_t)gridDim.x * blockDim.x) out[i] = 1e6f * (bf2f(a[i]) - bf2f(b[i]));
}
__global__ void dump_kernel(const bf16_t* src, float* out, size_t n) {
    for (size_t i = (size_t)blockIdx.x * blockDim.x + threadIdx.x; i < n; i += (size_t)gridDim.x * blockDim.x) out[i] = i < (size_t)MK_DUMP_N ? bf2f(src[(i >> 10) * MK_DUMP_LD + MK_DUMP_C0 + (i & 1023)]) : 0.f;
}
extern "C" void kernel_launch(void* const* d_in, const int* in_sizes, int n_in, void* d_out, int out_size, void* d_ws, size_t ws_size, hipStream_t stream) {
    static int ready = 0;
    if (ready == 0) {
        ready = 1;
        if (n_in != 42 || out_size != NB * SEQ * D || ws_size < WS_END) { fprintf(stderr, "kernel_launch: unexpected shapes (n_in %d out %d ws %zu need %zu)\n", n_in, out_size, ws_size, (size_t)WS_END); ready = -1; }
        if (hipFuncSetAttribute((const void*)fwd_kernel, hipFuncAttributeMaxDynamicSharedMemorySize, LDS_BYTES) != hipSuccess) { fprintf(stderr, "kernel_launch: hipFuncSetAttribute failed\n"); ready = -1; }
    }
    if (ready < 0) return;
    (void)in_sizes;
    hipMemsetAsync((char*)d_ws + WS_BAR, 0, WS_ZERO_BYTES, stream);
    Params p;
    memset(&p, 0, sizeof(p));
    const float** fp = (const float**)&p;
    for (int i = 0; i < 42; ++i) fp[i] = (const float*)d_in[i];
    p.out = (float*)d_out; p.ws = (unsigned char*)d_ws;
#if MK_PER_PHASE
    for (int ph = 0; ph < MK_STOP; ++ph) {
        const int local = ph < 2 ? -1 : (ph - 2) % 11, layer = ph < 2 ? 0 : (ph - 2) / 11;
        if (local == 4 && (layer & 1)) continue;
        p.ph_lo = ph; p.ph_hi = ph + 1;
        hipLaunchKernelGGL(fwd_kernel, dim3(256), dim3(NT), LDS_BYTES, stream, p);
    }
#ifdef MK_DIFF
    p.ph_lo = 7; p.ph_hi = 8; p.dbg = 1;
    hipLaunchKernelGGL(fwd_kernel, dim3(256), dim3(NT), LDS_BYTES, stream, p);
    hipLaunchKernelGGL(diff_kernel, dim3(1024), dim3(256), 0, stream, (const bf16_t*)((unsigned char*)d_ws + WS_YO), (const bf16_t*)((unsigned char*)d_ws + WS_HID), (float*)d_out, (size_t)NB * SEQ * D);
#else
    if (MK_DUMP) hipLaunchKernelGGL(dump_kernel, dim3(1024), dim3(256), 0, stream, (const bf16_t*)((unsigned char*)d_ws + (size_t)MK_DUMP), (float*)d_out, (size_t)NB * SEQ * D);
#endif
#else
    p.ph_lo = 0; p.ph_hi = NPHASE;
    hipLaunchKernelGGL(fwd_kernel, dim3(256), dim3(NT), LDS_BYTES, stream, p);
#endif
}
```

```cpp
#include <hip/hip_runtime.h>
#include <stdint.h>
#include <stdio.h>
#include <string.h>

#ifndef MK_PER_PHASE
#define MK_PER_PHASE 0
#endif

typedef unsigned short bf16_t;
typedef short bf16x8 __attribute__((ext_vector_type(8)));
typedef float f32x4 __attribute__((ext_vector_type(4)));
typedef unsigned u32x4 __attribute__((ext_vector_type(4)));
typedef unsigned u32x2 __attribute__((ext_vector_type(2)));
#define LAS __attribute__((address_space(3)))
#define CAS __attribute__((address_space(4)))

constexpr int D = 1024, NB = 4, SEQ = 8192, CTXL = 256, DEPTH = 4;
constexpr int NCTX = NB * CTXL;
constexpr int NROWS = NCTX + NB * SEQ;
constexpr int P_EVEN = 2848, P_ODD = 4416, LDP_EVEN = 3072, LDP_ODD = 4608;
constexpr int NEXP = 32, DEXP = 512, LISTCAP = NROWS;
constexpr float ALPHA = 1.681792830507429f;
constexpr int NT = 512;
constexpr int TCH = 32;
constexpr int NSTEPS = CTXL + SEQ;
constexpr int LDS_BYTES = 160 * 1024;

constexpr size_t al256(size_t x) { return (x + 255) & ~(size_t)255; }
constexpr size_t WS_BAR = 0;
constexpr size_t WS_CNT = 16384;
constexpr int CNT_STRIDE = 64;
constexpr size_t WS_ZERO_BYTES = 16384 + (size_t)4 * 32 * CNT_STRIDE * 4;
constexpr size_t WS_MODV = al256(WS_ZERO_BYTES);
constexpr size_t WS_LB = WS_MODV + al256((size_t)4 * 5 * 6144 * 4);
constexpr size_t WS_XC = WS_LB + al256(4 * 512 * 4);
constexpr size_t WS_WTS = WS_XC + (size_t)NCTX * D * 4;
constexpr size_t WS_LIST = WS_WTS + al256((size_t)2 * NROWS * 4);
constexpr size_t WS_WINT = WS_LIST + al256((size_t)NEXP * LISTCAP * 4);
constexpr size_t WINT_L0 = 0, WINT_L1 = (size_t)LDP_EVEN * D, WINT_L2 = WINT_L1 + (size_t)LDP_ODD * D, WINT_L3 = WINT_L2 + (size_t)LDP_EVEN * D, WINT_END = WINT_L3 + (size_t)LDP_ODD * D;
constexpr size_t WS_WOUTT = WS_WINT + WINT_END * 2;
constexpr size_t WS_LORAT = WS_WOUTT + (size_t)4 * D * D * 2;
constexpr size_t LORA_PER = (size_t)512 * 320;
constexpr size_t WS_EXPGU = WS_LORAT + al256(2 * LORA_PER * 2);
constexpr size_t WS_EXPD = WS_EXPGU + (size_t)NEXP * 1024 * 1024 * 2;
constexpr size_t WS_ACT = WS_EXPD + (size_t)NEXP * 1024 * 512 * 2;
constexpr size_t ROWB = (size_t)NROWS * D * 2;
constexpr size_t WS_FEAT = WS_ACT + ROWB;
constexpr size_t WS_YF = WS_FEAT + ROWB;
constexpr size_t WS_YB = WS_YF + ROWB;
constexpr size_t WS_P = WS_YB + ROWB;
constexpr size_t P_BYTES = (size_t)NROWS * LDP_ODD * 2;
constexpr size_t WS_YO = WS_P;
constexpr size_t WS_HID = WS_P + ROWB;
constexpr size_t WS_YP = WS_HID + ROWB;
static_assert(WS_YP + 2 * ROWB <= WS_P + P_BYTES, "MoE buffers must fit in the P region");
constexpr size_t HALFB = (size_t)NROWS * 512 * 2;
constexpr size_t WS_RWR = WS_P + P_BYTES;
constexpr size_t WS_RWK = WS_RWR + HALFB;
constexpr size_t WS_RWV = WS_RWK + HALFB;
constexpr size_t WS_RWKK = WS_RWV + HALFB;
constexpr size_t WS_RWB = WS_RWKK + HALFB;
constexpr size_t WS_RWG = WS_RWB + HALFB;
constexpr size_t WS_RWDEC = WS_RWG + HALFB;
constexpr size_t WS_LA = WS_RWDEC + (size_t)2 * NROWS * 512 * 4;
constexpr size_t WS_END = WS_LA + (size_t)NROWS * 320 * 2;
static_assert(WS_END <= (size_t)280602384 * 4, "workspace map exceeds the guaranteed ws_size");

struct Params {
    const float *x, *c, *ctx, *c_ctx, *mod_w, *mod_b, *ln_g, *ln_b;
    const float *ev_w_in, *ev_w_out, *ssd_conv_w, *ssd_conv_b, *ssd_dt_bias, *ssd_a_log, *ssd_d, *ssd_norm_w;
    const float *ml_conv_w, *ml_conv_b, *ml_i_bias, *ml_f_bias, *ml_norm_w;
    const float *od_w_in, *od_w_out, *hg_lb_logits, *hg_f_bias, *hg_norm_w;
    const float *rw_mu, *rw_w0, *rw_w2, *rw_a0, *rw_a2, *rw_g2, *rw_k_k, *rw_k_a, *rw_r_k, *rw_ln_w, *rw_ln_b;
    const float *router_w, *router_bias, *exp_w_gate, *exp_w_up, *exp_w_down;
    float* out;
    unsigned char* ws;
    int ph_lo, ph_hi, dbg, pad_;
};
typedef const CAS Params* KP;

__device__ __forceinline__ int ltid(int wv) { int l; asm volatile("v_mbcnt_lo_u32_b32 %0, -1, 0\n\tv_mbcnt_hi_u32_b32 %0, -1, %0" : "=v"(l)); return wv * 64 + l; }
__device__ __forceinline__ float bf2f(bf16_t h) { return __uint_as_float(((unsigned)h) << 16); }
__device__ __forceinline__ float bflo(unsigned u) { return __uint_as_float(u << 16); }
__device__ __forceinline__ float bfhi(unsigned u) { return __uint_as_float(u & 0xffff0000u); }
typedef __bf16 bf16v2_t __attribute__((ext_vector_type(2)));
typedef float f32x2 __attribute__((ext_vector_type(2)));
__device__ __forceinline__ unsigned pk2(float lo, float hi) { const f32x2 v = {lo, hi}; return __builtin_bit_cast(unsigned, __builtin_convertvector(v, bf16v2_t)); }
__device__ __forceinline__ bf16_t f2bf(float f) { return (bf16_t)(pk2(f, 0.f) & 0xffffu); }
__device__ __forceinline__ void unpack8(const u32x4& u, float* f) {
    f[0] = bflo(u.x); f[1] = bfhi(u.x); f[2] = bflo(u.y); f[3] = bfhi(u.y); f[4] = bflo(u.z); f[5] = bfhi(u.z); f[6] = bflo(u.w); f[7] = bfhi(u.w);
}
__device__ __forceinline__ u32x4 pack8(const float* f) { u32x4 u; u.x = pk2(f[0], f[1]); u.y = pk2(f[2], f[3]); u.z = pk2(f[4], f[5]); u.w = pk2(f[6], f[7]); return u; }
__device__ __forceinline__ float sigmoidf_(float x) { return __builtin_amdgcn_rcpf(1.f + __expf(-x)); }
__device__ __forceinline__ float siluf_(float x) { return x * __builtin_amdgcn_rcpf(1.f + __expf(-x)); }
__device__ __forceinline__ float softplus_fast(float x) { return x > 20.f ? x : __logf(1.f + __expf(x)); }
__device__ __forceinline__ float tanh_fast(float x) { return 1.f - 2.f * __builtin_amdgcn_rcpf(1.f + __expf(2.f * x)); }
__device__ __forceinline__ float softplusf_(float x) { return x > 20.f ? x : __logf(1.f + __expf(x)); }
__device__ __forceinline__ float logsigmoidf_(float x) { return fminf(x, 0.f) - __logf(1.f + __expf(-fabsf(x))); }
template <int CTRL> __device__ __forceinline__ float dppmov(float v) {
    return __builtin_bit_cast(float, __builtin_amdgcn_update_dpp(0, __builtin_bit_cast(int, v), CTRL, 0xf, 0xf, true));
}
__device__ __forceinline__ float allreduce16(float v) {
    v += dppmov<0xB1>(v);
    v += dppmov<0x4E>(v);
    v += dppmov<0x141>(v);
    v += dppmov<0x140>(v);
    return v;
}
__device__ __forceinline__ float allreduce8_(float v) { v += dppmov<0xB1>(v); v += dppmov<0x4E>(v); v += dppmov<0x141>(v); return v; }
__device__ __forceinline__ float wave_sum(float v) {
    v = allreduce16(v);
    const float r0 = __builtin_bit_cast(float, __builtin_amdgcn_readlane(__builtin_bit_cast(int, v), 0)), r1 = __builtin_bit_cast(float, __builtin_amdgcn_readlane(__builtin_bit_cast(int, v), 16));
    const float r2 = __builtin_bit_cast(float, __builtin_amdgcn_readlane(__builtin_bit_cast(int, v), 32)), r3 = __builtin_bit_cast(float, __builtin_amdgcn_readlane(__builtin_bit_cast(int, v), 48));
    return (r0 + r1) + (r2 + r3);
}
template <int W> __device__ __forceinline__ float group_sum(float v) {
    if (W == 8) return allreduce8_(v);
    return allreduce16(v);
}

#define XB_TMO      128
#define XB_XCNT(j)  (256  + 64 * (j))
#define XB_XSUB(j)  (1280 + 64 * (j))
#define XB_XGEN(j)  (2304 + 64 * (j))
#define XB_TOP      3328
#define XB_TOPGEN   3392
#define XCD_BAR_WORDS 3456
#define XB_SPIN_CAP (1u << 22)
__device__ __forceinline__ unsigned xb_ld(unsigned* p)              { return __hip_atomic_load(p, __ATOMIC_RELAXED, __HIP_MEMORY_SCOPE_AGENT); }
__device__ __forceinline__ unsigned xb_add(unsigned* p, unsigned v) { return __hip_atomic_fetch_add(p, v, __ATOMIC_RELAXED, __HIP_MEMORY_SCOPE_AGENT); }
__device__ __forceinline__ unsigned xb_xcc_id() { return (unsigned)__builtin_amdgcn_s_getreg((3 << 11) | 20) & 0xFu; }
#define XB_SPIN(cond, bar) do { unsigned _sp = 0; while (cond) { __builtin_amdgcn_s_sleep(1); \
    if ((++_sp & 255u) == 0u) { if (xb_ld(&(bar)[XB_TMO])) break; if (_sp > XB_SPIN_CAP) { atomicAdd(&(bar)[XB_TMO], 1u); break; } } } } while (0)
struct XcdBarrier { unsigned* bar; unsigned x; volatile LAS unsigned* st; };
__device__ __forceinline__ XcdBarrier xcd_barrier_post(int wv, unsigned* bar, volatile LAS unsigned* st) {
    XcdBarrier b; b.bar = bar; b.x = xb_xcc_id(); b.st = st;
    if (ltid(wv) == 0) (void)xb_add(&bar[XB_XCNT(b.x)], 1u);
    return b;
}
__device__ __forceinline__ void xcd_barrier_complete(unsigned* bar, unsigned x, unsigned& nloc, unsigned& nx) {
    const unsigned G = gridDim.x * gridDim.y * gridDim.z;
    unsigned sum, cnt, mine, sp = 0u;
    for (;;) {
        sum = 0u; cnt = 0u; mine = 0u;
#pragma unroll
        for (unsigned j = 0; j < 16; ++j) { const unsigned c = xb_ld(&bar[XB_XCNT(j)]); sum += c; cnt += (c > 0u) ? 1u : 0u; mine = (j == x) ? c : mine; }
        if (sum == G) break;
        __builtin_amdgcn_s_sleep(1);
        if ((++sp & 255u) == 0u) { if (xb_ld(&bar[XB_TMO])) break; if (sp > XB_SPIN_CAP) { atomicAdd(&bar[XB_TMO], 1u); break; } }
    }
    nloc = mine > 0u ? mine : 1u; nx = cnt > 0u ? cnt : 1u;
}
__device__ __forceinline__ void xcd_barrier(int wv, const XcdBarrier& b) {
    asm volatile("s_waitcnt vmcnt(0)" ::: "memory");
    __syncthreads();
    if (ltid(wv) == 0) {
        unsigned* bar = b.bar;
        asm volatile("" : "+s"(bar));
        __builtin_amdgcn_s_waitcnt(0);
        unsigned nloc = b.st[0], nx = b.st[1];
        if (nloc == 0u) { xcd_barrier_complete(bar, b.x, nloc, nx); b.st[0] = nloc; b.st[1] = nx; }
        const unsigned old = xb_add(&bar[XB_XSUB(b.x)], 1u);
        const unsigned gen = old / nloc;
        if (old + 1u == (gen + 1u) * nloc) {
            __builtin_amdgcn_fence(__ATOMIC_RELEASE, "agent");
            asm volatile("s_waitcnt vmcnt(0)" ::: "memory");
            const unsigned og = xb_add(&bar[XB_TOP], 1u);
            const unsigned tg = og / nx;
            if (og + 1u == (tg + 1u) * nx) xb_add(&bar[XB_TOPGEN], 1u);
            else XB_SPIN(xb_ld(&bar[XB_TOPGEN]) == tg, bar);
            __builtin_amdgcn_fence(__ATOMIC_ACQUIRE, "agent");
            xb_add(&bar[XB_XGEN(b.x)], 1u);
            asm volatile("s_waitcnt vmcnt(0)" ::: "memory");
        } else {
            XB_SPIN(xb_ld(&bar[XB_XGEN(b.x)]) == gen, bar);
            __builtin_amdgcn_fence(__ATOMIC_ACQUIRE, "agent");
            asm volatile("s_waitcnt vmcnt(0)" ::: "memory");
        }
    }
    __syncthreads();
}

__device__ __forceinline__ int row_mod(int r) { return r < NCTX ? 4 : ((r - NCTX) >> 13); }
__device__ __forceinline__ void row_seg(int r, int& t, int& len) { if (r < NCTX) { t = r & 255; len = CTXL; } else { t = (r - NCTX) & 8191; len = SEQ; } }
__device__ __forceinline__ int scan_row(int tg, int b, int dir, int odd) {
    if (tg < CTXL) { const int t = dir ? (CTXL - 1 - tg) : tg; return b * CTXL + t; }
    int sg = tg - CTXL; if (dir) sg = SEQ - 1 - sg;
    const int s = odd ? (((sg & 127) << 6) + (sg >> 7)) : sg;
    return NCTX + b * SEQ + s;
}
__device__ __forceinline__ const float* modvec(const unsigned char* ws, int layer, int m, int which) {
    return (const float*)(ws + WS_MODV) + ((size_t)(layer * 5 + m) * 6 + which) * D;
}

constexpr int G_BM = 256, G_BN = 128, G_BK = 64;
constexpr int G_ABYTES = G_BM * G_BK * 2, G_BBYTES = G_BN * G_BK * 2, G_BUF = G_ABYTES + G_BBYTES;
__device__ __forceinline__ int swz(int o) { return o ^ (((o >> 9) & 1) << 5); }

template <class RowSrc, class Epi>
__device__ __forceinline__ void gemm_tile(int wv, const bf16_t* __restrict__ A, int lda, const RowSrc& rs, const bf16_t* __restrict__ Bt, int ldb, int n0, int K, const Epi& epi, LAS char* lds) {
    const int tid = ltid(wv), lane = tid & 63, wid = tid >> 6, wm = wid >> 1, wn = wid & 1;
    const bf16_t* ap[4]; int aoff[4];
#pragma unroll
    for (int i = 0; i < 4; ++i) {
        const int c = tid + NT * i, row = c >> 3, kc = c & 7;
        ap[i] = A + (size_t)rs.src(row) * lda + kc * 8;
        aoff[i] = ((row >> 4) * 2 + (kc >> 2)) * 1024 + swz((row & 15) * 64 + (kc & 3) * 16);
    }
    const bf16_t* bp[2]; int boff[2];
#pragma unroll
    for (int i = 0; i < 2; ++i) {
        const int c = tid + NT * i, row = c >> 3, kc = c & 7;
        bp[i] = Bt + (size_t)(n0 + row) * ldb + kc * 8;
        boff[i] = G_ABYTES + ((row >> 4) * 2 + (kc >> 2)) * 1024 + swz((row & 15) * 64 + (kc & 3) * 16);
    }
    f32x4 acc[4][4];
#pragma unroll
    for (int i = 0; i < 4; ++i)
#pragma unroll
        for (int j = 0; j < 4; ++j) acc[i][j] = (f32x4){0.f, 0.f, 0.f, 0.f};
    u32x4 ra[2][4], rb[2][2];
    const int KT = K / G_BK;
    const int fragoff = swz((lane & 15) * 64 + (lane >> 4) * 16);
#define G_LOAD(set, kt_) do { _Pragma("unroll") for (int i = 0; i < 4; ++i) ra[set][i] = *(const u32x4*)(ap[i] + (kt_) * G_BK); \
                              _Pragma("unroll") for (int i = 0; i < 2; ++i) rb[set][i] = *(const u32x4*)(bp[i] + (kt_) * G_BK); } while (0)
#define G_STORE(set, buf) do { _Pragma("unroll") for (int i = 0; i < 4; ++i) *(LAS u32x4*)((buf) + aoff[i]) = ra[set][i]; \
                               _Pragma("unroll") for (int i = 0; i < 2; ++i) *(LAS u32x4*)((buf) + boff[i]) = rb[set][i]; } while (0)
#define G_COMPUTE(cur) do { bf16x8 af[2][4], bfr[2][4]; \
        _Pragma("unroll") for (int ks = 0; ks < 2; ++ks) { \
            _Pragma("unroll") for (int ni = 0; ni < 4; ++ni) bfr[ks][ni] = *(LAS bf16x8*)((cur) + G_ABYTES + ((wn * 4 + ni) * 2 + ks) * 1024 + fragoff); \
            _Pragma("unroll") for (int mi = 0; mi < 4; ++mi) af[ks][mi] = *(LAS bf16x8*)((cur) + ((wm * 4 + mi) * 2 + ks) * 1024 + fragoff); } \
        __builtin_amdgcn_sched_barrier(0); \
        _Pragma("unroll") for (int ks = 0; ks < 2; ++ks) _Pragma("unroll") for (int mi = 0; mi < 4; ++mi) _Pragma("unroll") for (int ni = 0; ni < 4; ++ni) \
            acc[mi][ni] = __builtin_amdgcn_mfma_f32_16x16x32_bf16(bfr[ks][ni], af[ks][mi], acc[mi][ni], 0, 0, 0); \
        __builtin_amdgcn_sched_barrier(0); } while (0)
    G_LOAD(0, 0);
    G_STORE(0, lds);
    if (KT > 1) G_LOAD(0, 1);
    if (KT > 2) G_LOAD(1, 2);
    __syncthreads();
    for (int kt = 0; kt < KT; kt += 2) {
        G_COMPUTE(lds);
        if (kt + 1 < KT) G_STORE(0, lds + G_BUF);
        if (kt + 3 < KT) G_LOAD(0, kt + 3);
        __syncthreads();
        if (kt + 1 < KT) {
            G_COMPUTE(lds + G_BUF);
            if (kt + 2 < KT) G_STORE(1, lds);
            if (kt + 4 < KT) G_LOAD(1, kt + 4);
            __syncthreads();
        }
    }
#undef G_LOAD
#undef G_STORE
#undef G_COMPUTE
    epi(acc, wm * 64 + (lane & 15), wn * 64 + 4 * (lane >> 4));
}

constexpr int G2_BN = 256, G2_BBYTES = G2_BN * G_BK * 2, G2_BUF = G_ABYTES + G2_BBYTES;

struct RowLinear { int m0; __device__ __forceinline__ int src(int r) const { return m0 + r; } };
struct RowList {
    const int* list; int cnt; int shift;
    __device__ __forceinline__ int src(int r) const { const int a = list[r < cnt ? r : 0]; return a >> shift; }
};
struct EpiStoreBf16 {
    bf16_t* C; int ldc; int m0; int n0; int N;
    template <int NI> __device__ __forceinline__ void operator()(const f32x4 (&acc)[4][NI], int rbase, int cbase) const {
#pragma unroll
        for (int mi = 0; mi < 4; ++mi) {
            bf16_t* rowp = C + (size_t)(m0 + rbase + mi * 16) * ldc + n0 + cbase;
#pragma unroll
            for (int ni = 0; ni < NI; ++ni) {
                if (n0 + cbase + ni * 16 < N) { u32x2 v; v.x = pk2(acc[mi][ni][0], acc[mi][ni][1]); v.y = pk2(acc[mi][ni][2], acc[mi][ni][3]); *(u32x2*)(rowp + ni * 16) = v; }
            }
        }
    }
};
struct EpiSwiGLU {
    bf16_t* H; const int* list; int cnt; int n0;
    template <int NI> __device__ __forceinline__ void operator()(const f32x4 (&acc)[4][NI], int rbase, int cbase) const {
#pragma unroll
        for (int mi = 0; mi < 4; ++mi) {
            const int r = rbase + mi * 16;
            if (r < cnt) {
                const int a = list[r];
                const int wnb = cbase & ~63, q4 = cbase & 63;
                bf16_t* rowp = H + (size_t)a * DEXP + ((n0 + wnb) >> 1) + q4;
#pragma unroll
                for (int q = 0; q < NI / 2; ++q) {
                    float o[4];
#pragma unroll
                    for (int j = 0; j < 4; ++j) o[j] = siluf_(acc[mi][2 * q][j]) * acc[mi][2 * q + 1][j];
                    u32x2 v; v.x = pk2(o[0], o[1]); v.y = pk2(o[2], o[3]); *(u32x2*)(rowp + q * 16) = v;
                }
            }
        }
    }
};
struct EpiScatterBf16 {
    bf16_t* C; const int* list; int cnt; int n0;
    template <int NI> __device__ __forceinline__ void operator()(const f32x4 (&acc)[4][NI], int rbase, int cbase) const {
#pragma unroll
        for (int mi = 0; mi < 4; ++mi) {
            const int r = rbase + mi * 16;
            if (r < cnt) {
                bf16_t* rowp = C + (size_t)list[r] * D + n0 + cbase;
#pragma unroll
                for (int ni = 0; ni < NI; ++ni) { u32x2 v; v.x = pk2(acc[mi][ni][0], acc[mi][ni][1]); v.y = pk2(acc[mi][ni][2], acc[mi][ni][3]); *(u32x2*)(rowp + ni * 16) = v; }
            }
        }
    }
};
struct EpiDecay {
    float* Dc; const float* w0; int m0; int n0;
    template <int NI> __device__ __forceinline__ void operator()(const f32x4 (&acc)[4][NI], int rbase, int cbase) const {
#pragma unroll
        for (int ni = 0; ni < NI; ++ni) {
            const int col = n0 + cbase + ni * 16;
            const f32x4 w0v = *(const f32x4*)(w0 + col);
#pragma unroll
            for (int mi = 0; mi < 4; ++mi) {
                f32x4 o;
#pragma unroll
                for (int j = 0; j < 4; ++j) { const float w = w0v[j] + acc[mi][ni][j]; o[j] = __expf(-__expf(-softplus_fast(-w) - 0.5f)); }
                *(f32x4*)(Dc + (size_t)(m0 + rbase + mi * 16) * 512 + col) = o;
            }
        }
    }
};
struct EpiAK {
    bf16_t* Kb; const bf16_t* KKb; bf16_t* Bb; const float* a0; const float* k_a; int m0; int n0;
    template <int NI> __device__ __forceinline__ void operator()(const f32x4 (&acc)[4][NI], int rbase, int cbase) const {
#pragma unroll
        for (int ni = 0; ni < NI; ++ni) {
            const int col = n0 + cbase + ni * 16;
            const f32x4 a0v = *(const f32x4*)(a0 + col), kav = *(const f32x4*)(k_a + col);
#pragma unroll
            for (int mi = 0; mi < 4; ++mi) {
                const size_t off = (size_t)(m0 + rbase + mi * 16) * 512 + col;
                const u32x2 kr = *(const u32x2*)(Kb + off), kkr = *(const u32x2*)(KKb + off);
                const float kf[4] = {bflo(kr.x), bfhi(kr.x), bflo(kr.y), bfhi(kr.y)}, kkf[4] = {bflo(kkr.x), bfhi(kkr.x), bflo(kkr.y), bfhi(kkr.y)};
                float k2[4], bb[4];
#pragma unroll
                for (int j = 0; j < 4; ++j) { const float a = sigmoidf_(a0v[j] + acc[mi][ni][j]); k2[j] = kf[j] * (1.f + (a - 1.f) * kav[j]); bb[j] = kkf[j] * a; }
                u32x2 v; v.x = pk2(k2[0], k2[1]); v.y = pk2(k2[2], k2[3]); *(u32x2*)(Kb + off) = v;
                v.x = pk2(bb[0], bb[1]); v.y = pk2(bb[2], bb[3]); *(u32x2*)(Bb + off) = v;
            }
        }
    }
};

namespace pg8 {
#define PG8_LAS __attribute__((address_space(3)))
constexpr int BM = 256, BK = 64, HALF = 128, HTB = HALF * BK * 2, STAGE_BYTES = 8 * HTB, NXCD = 8, WGM = 8;
__host__ __device__ __forceinline__ int lds_byte(int r, int c) { const int st = (r >> 4) * 2 + (c >> 5), rr = r & 15, cc = c & 31, ob = rr * 64 + cc * 2; return st * 1024 + (ob ^ (((ob >> 9) & 1) << 5)); }
__host__ __device__ __forceinline__ void stage_rc(int b, int& R, int& C) { const int st = b / 1024, sb = b % 1024, swz = sb ^ (((sb >> 9) & 1) << 5); R = (st >> 1) * 16 + swz / 64; C = (st & 1) * 32 + (swz % 64) / 2; }
__host__ __device__ __forceinline__ int perm32(int rho) { const int n = rho >> 4, i = rho & 15; return 8 * (i >> 2) + 4 * n + (i & 3); }
struct Unit { int pm, pn; };
struct Gemm { const bf16_t* A; const bf16_t* Bt; int M, N, K; };
struct StaticOrder {
    int nM, nN, nwg, G, c;
    __host__ __device__ void init(int M, int N, int G_, int c_) { nM = M / BM; nN = N / BM; nwg = nM * nN; G = G_; c = c_; }
    __host__ __device__ bool next(int i, Unit& u) const {
        const long L = (long)i * G + c; if (L >= nwg) return false;
        int wgid = (int)L; { const int q = nwg / NXCD, r = nwg % NXCD, xcd = wgid % NXCD, off = wgid / NXCD; wgid = (xcd < r ? xcd * (q + 1) : r * (q + 1) + (xcd - r) * q) + off; }
        const int nig = WGM * nN, gid = wgid / nig, fm = gid * WGM, gsz = (nM - fm) < WGM ? (nM - fm) : WGM;
        u.pm = fm + ((wgid % nig) % gsz); u.pn = (wgid % nig) / gsz; return true;
    }
    __device__ __forceinline__ void a_ready(const Unit&) const {}
    __device__ __forceinline__ void done(const Unit&) const {}
};
struct EpiStoreP {
    static constexpr bool PERM = true, AFTER_DRAIN = false;
    bf16_t* O; int ldc;
    __device__ __forceinline__ void operator()(const f32x4 (&acc)[2][2][4][2], const Unit& u, int wr, int wc, int fr, int fq) const {
        const int row0 = u.pm * BM + wr * 64 + fr, col0 = u.pn * BM + wc * 32 + 8 * fq;
#pragma unroll
        for (int ai = 0; ai < 2; ++ai)
#pragma unroll
            for (int m = 0; m < 4; ++m) { bf16_t* rowp = O + (size_t)(row0 + ai * HALF + m * 16) * ldc + col0;
#pragma unroll
                for (int bj = 0; bj < 2; ++bj) { const f32x4 v0 = acc[ai][bj][m][0], v1 = acc[ai][bj][m][1];
                    u32x4 w; w.x = pk2(v0[0], v0[1]); w.y = pk2(v0[2], v0[3]); w.z = pk2(v1[0], v1[1]); w.w = pk2(v1[2], v1[3]);
                    *(u32x4*)(rowp + bj * HALF) = w; } }
    }
};
template <class Epi, class Sched>
__device__ __forceinline__ void gemm_phase(int wv, PG8_LAS unsigned char* lds, const Gemm g, const Sched& S, const Epi& E) {
    const int tid = ltid(wv), wid = __builtin_amdgcn_readfirstlane(tid >> 6), lane = tid & 63, wr = wid >> 2, wc = wid & 3, fr = lane & 15, fq = lane >> 4;
    const int K = g.K, nt = K / BK;
    unsigned voffA[2], voffB[2];
#pragma unroll
    for (int i = 0; i < 2; ++i) { int R, C; stage_rc(tid * 16 + i * 8192, R, C); const int Rb = Epi::PERM ? ((R & ~31) + perm32(R & 31)) : R;
        voffA[i] = (unsigned)(R * K + C) * 2u; voffB[i] = (unsigned)(Rb * K + C) * 2u; }
    const size_t kstep = (size_t)(BK * 2);
    const size_t hstep = (size_t)HALF * K * 2;
    const size_t tstep = 2 * hstep;
    const unsigned ldsw = (unsigned)wid * 1024u;
    const int aoff = lds_byte(wr * 64 + fr, fq * 8), boff = lds_byte(wc * 32 + fr, fq * 8);
#define PG8_SA(b, h) (((b) * 2 + (h)) * HTB)
#define PG8_SB(b, h) ((4 + (b) * 2 + (h)) * HTB)
#define PG8_STAGE(bufoff, gbase, voff) do { _Pragma("unroll") for (int _i = 0; _i < 2; ++_i) \
        __builtin_amdgcn_global_load_lds((const unsigned*)((const char*)(gbase) + (voff)[_i]), (PG8_LAS unsigned*)(lds + (bufoff) + ldsw + _i * 8192), 16, 0, 0); } while (0)
#define PG8_LDA(dst, b, h) do { _Pragma("unroll") for (int m = 0; m < 4; ++m) _Pragma("unroll") for (int k = 0; k < 2; ++k) dst[m][k] = *(const PG8_LAS bf16x8*)(lds + PG8_SA(b, h) + aoff + m * 2048 + k * 1024); } while (0)
#define PG8_LDB(dst, b, h) do { _Pragma("unroll") for (int n = 0; n < 2; ++n) _Pragma("unroll") for (int k = 0; k < 2; ++k) dst[n][k] = *(const PG8_LAS bf16x8*)(lds + PG8_SB(b, h) + boff + n * 2048 + k * 1024); } while (0)
#define PG8_MMA(ai, bj, At, Bt) do { __builtin_amdgcn_s_setprio(1); _Pragma("unroll") for (int m = 0; m < 4; ++m) _Pragma("unroll") for (int n = 0; n < 2; ++n) _Pragma("unroll") for (int k = 0; k < 2; ++k) \
        acc[ai][bj][m][n] = __builtin_amdgcn_mfma_f32_16x16x32_bf16(Bt[n][k], At[m][k], acc[ai][bj][m][n], 0, 0, 0); __builtin_amdgcn_s_setprio(0); } while (0)
#define PG8_WAIT_V(n) asm volatile("s_waitcnt vmcnt(" #n ")" ::: "memory")
#define PG8_WAIT_L(n) asm volatile("s_waitcnt lgkmcnt(" #n ")" ::: "memory")
#define PG8_BAR __builtin_amdgcn_s_barrier()
#define PG8_SCHED __builtin_amdgcn_sched_barrier(0)
    Unit cur, nxt; int ui = 0;
    if (!S.next(0, cur)) return;
    f32x4 acc[2][2][4][2];
#pragma unroll
    for (int a = 0; a < 2; ++a)
#pragma unroll
        for (int b = 0; b < 2; ++b)
#pragma unroll
            for (int m = 0; m < 4; ++m)
#pragma unroll
                for (int n = 0; n < 2; ++n) acc[a][b][m][n] = (f32x4){0.f, 0.f, 0.f, 0.f};
    bf16x8 At[4][2], B0[2][2], B1[2][2];
    const char* cA = (const char*)g.A + (size_t)cur.pm * tstep; const char* cB = (const char*)g.Bt + (size_t)cur.pn * tstep;
    S.a_ready(cur);
    PG8_STAGE(PG8_SB(0, 0), cB, voffB); PG8_STAGE(PG8_SA(0, 0), cA, voffA); PG8_STAGE(PG8_SB(0, 1), cB + hstep, voffB); PG8_STAGE(PG8_SA(0, 1), cA + hstep, voffA);
    if (wr == 1) PG8_BAR;
    PG8_WAIT_V(4); PG8_BAR;
    PG8_STAGE(PG8_SB(1, 0), cB + kstep, voffB); PG8_STAGE(PG8_SA(1, 0), cA + kstep, voffA); PG8_STAGE(PG8_SB(1, 1), cB + hstep + kstep, voffB);
    PG8_WAIT_V(6); PG8_BAR;
    for (;;) {
        const bool has_next = S.next(ui + 1, nxt);
        const char* nA = has_next ? (const char*)g.A + (size_t)nxt.pm * tstep : cA; const char* nB = has_next ? (const char*)g.Bt + (size_t)nxt.pn * tstep : cB;
        for (int t = 0; t < nt; t += 2) {
            const bool last = (t == nt - 2);
            const char* a1 = cA + (size_t)(t + 1) * kstep;
            const char* a2 = last ? nA : cA + (size_t)(t + 2) * kstep; const char* b2 = last ? nB : cB + (size_t)(t + 2) * kstep;
            const char* a3 = a2 + kstep; const char* b3 = b2 + kstep;
            if (last && has_next) S.a_ready(nxt);
            PG8_LDB(B0, 0, 0); PG8_SCHED; PG8_LDA(At, 0, 0); PG8_STAGE(PG8_SA(1, 1), a1 + hstep, voffA);
            PG8_WAIT_L(8); PG8_BAR; PG8_WAIT_L(0); PG8_MMA(0, 0, At, B0); PG8_BAR; PG8_SCHED;
            PG8_LDB(B1, 0, 1); PG8_STAGE(PG8_SB(0, 0), b2, voffB);
            PG8_BAR; PG8_WAIT_L(0); PG8_MMA(0, 1, At, B1); PG8_BAR;
            PG8_LDA(At, 0, 1); PG8_STAGE(PG8_SA(0, 0), a2, voffA);
            PG8_BAR; PG8_WAIT_L(0); PG8_MMA(1, 0, At, B0); PG8_BAR; PG8_SCHED;
            PG8_STAGE(PG8_SB(0, 1), b2 + hstep, voffB);
            PG8_WAIT_V(6); PG8_BAR; PG8_MMA(1, 1, At, B1); PG8_BAR;
            PG8_LDB(B0, 1, 0); PG8_SCHED; PG8_LDA(At, 1, 0); PG8_STAGE(PG8_SA(0, 1), a2 + hstep, voffA);
            PG8_WAIT_L(8); PG8_BAR; PG8_WAIT_L(0); PG8_MMA(0, 0, At, B0); PG8_BAR; PG8_SCHED;
            PG8_LDB(B1, 1, 1); PG8_STAGE(PG8_SB(1, 0), b3, voffB);
            PG8_BAR; PG8_WAIT_L(0); PG8_MMA(0, 1, At, B1); PG8_BAR;
            PG8_LDA(At, 1, 1); PG8_STAGE(PG8_SA(1, 0), a3, voffA);
            PG8_BAR; PG8_WAIT_L(0); PG8_MMA(1, 0, At, B0); PG8_BAR; PG8_SCHED;
            PG8_STAGE(PG8_SB(1, 1), b3 + hstep, voffB);
            PG8_WAIT_V(6); PG8_BAR; PG8_MMA(1, 1, At, B1); PG8_BAR;
        }
            if constexpr (!Epi::AFTER_DRAIN) { E(acc, cur, wr, wc, fr, fq); S.done(cur); }
            if (!has_next) break;
#pragma unroll
        for (int a = 0; a < 2; ++a)
#pragma unroll
            for (int b = 0; b < 2; ++b)
#pragma unroll
                for (int m = 0; m < 4; ++m)
#pragma unroll
                    for (int n = 0; n < 2; ++n) acc[a][b][m][n] = (f32x4){0.f, 0.f, 0.f, 0.f};
        cur = nxt; cA = nA; cB = nB; ++ui;
    }
    PG8_WAIT_V(0);
    if (wr == 0) PG8_BAR;
    PG8_BAR;
    if constexpr (Epi::AFTER_DRAIN) { E.fused(acc, cur, wr, wc, fr, fq, lds, wid, lane); S.done(cur); }
#undef PG8_SA
#undef PG8_SB
#undef PG8_STAGE
#undef PG8_LDA
#undef PG8_LDB
#undef PG8_MMA
#undef PG8_WAIT_V
#undef PG8_WAIT_L
#undef PG8_BAR
#undef PG8_SCHED
}
struct UnitG { int pm, pn; const char* bbase; const PG8_LAS int* ltab; int cnt; int e; };
struct MoeOrder {
    const PG8_LAS int* tstart; const PG8_LAS int* tcnt; const PG8_LAS int* ltabs; const int* lists; const char* bt; size_t estride; int ncol, shift, G, c;
    __device__ __forceinline__ bool next(int i, UnitG& u) const {
        const int t = i * G + c; if (t >= tstart[32] * ncol) return false;
        const int tm = t / ncol; int e = 0;
#pragma unroll 1
        while (tstart[e + 1] <= tm) ++e;
        e = __builtin_amdgcn_readfirstlane(e);
        const int ts = __builtin_amdgcn_readfirstlane(tstart[e]), tc = __builtin_amdgcn_readfirstlane(tcnt[e]);
        u.pm = tm - ts; u.pn = t - tm * ncol; u.bbase = bt + (size_t)e * estride; u.e = e; u.cnt = tc - u.pm * BM; u.ltab = ltabs + i * BM;
        return true;
    }
    __device__ __forceinline__ void a_ready(const UnitG&) const {}
    __device__ __forceinline__ void done(const UnitG&) const {}
};
struct EpiSwiGLUG {
    static constexpr bool PERM = false, AFTER_DRAIN = false;
    bf16_t* H;
    __device__ __forceinline__ void operator()(const f32x4 (&acc)[2][2][4][2], const UnitG& u, int wr, int wc, int fr, int fq) const {
#pragma unroll
        for (int ai = 0; ai < 2; ++ai)
#pragma unroll
            for (int m = 0; m < 4; ++m) { const int r = ai * HALF + wr * 64 + m * 16 + fr;
                if (r < u.cnt) { bf16_t* rowp = H + (size_t)u.ltab[r] * DEXP + ((u.pn * BM + wc * 32) >> 1) + 4 * fq;
#pragma unroll
                    for (int bj = 0; bj < 2; ++bj) { const f32x4 gt = acc[ai][bj][m][0], up = acc[ai][bj][m][1];
                        u32x2 w; w.x = pk2(siluf_(gt[0]) * up[0], siluf_(gt[1]) * up[1]); w.y = pk2(siluf_(gt[2]) * up[2], siluf_(gt[3]) * up[3]);
                        *(u32x2*)(rowp + bj * (HALF / 2)) = w; } } }
    }
};
struct EpiScatterG {
    static constexpr bool PERM = true, AFTER_DRAIN = false;
    bf16_t* O;
    __device__ __forceinline__ void operator()(const f32x4 (&acc)[2][2][4][2], const UnitG& u, int wr, int wc, int fr, int fq) const {
#pragma unroll
        for (int ai = 0; ai < 2; ++ai)
#pragma unroll
            for (int m = 0; m < 4; ++m) { const int r = ai * HALF + wr * 64 + m * 16 + fr;
                if (r < u.cnt) { bf16_t* rowp = O + (size_t)u.ltab[r] * D + u.pn * BM + wc * 32 + 8 * fq;
#pragma unroll
                    for (int bj = 0; bj < 2; ++bj) { const f32x4 v0 = acc[ai][bj][m][0], v1 = acc[ai][bj][m][1];
                        u32x4 w; w.x = pk2(v0[0], v0[1]); w.y = pk2(v0[2], v0[3]); w.z = pk2(v1[0], v1[1]); w.w = pk2(v1[2], v1[3]);
                        *(u32x4*)(rowp + bj * HALF) = w; } } }
    }
};
template <class Epi, class Sched>
__device__ __forceinline__ void gemm_phase_g(int wv, PG8_LAS unsigned char* lds, const Gemm g, const Sched& S, const Epi& E) {
    const int tid = ltid(wv), wid = __builtin_amdgcn_readfirstlane(tid >> 6), lane = tid & 63, wr = wid >> 2, wc = wid & 3, fr = lane & 15, fq = lane >> 4;
    const int K = g.K, nt = K / BK;
    unsigned voffB[2];
#pragma unroll
    for (int i = 0; i < 2; ++i) { int R, C; stage_rc(tid * 16 + i * 8192, R, C); const int Rb = Epi::PERM ? ((R & ~31) + perm32(R & 31)) : R;
        voffB[i] = (unsigned)(Rb * K + C) * 2u; }
    const unsigned rowb = (unsigned)K * 2u;
#define PG8_AOFFS(u, dst) do { const int _t = ltid(wv); _Pragma("unroll") for (int _i = 0; _i < 2; ++_i) { int _R, _C; stage_rc(_t * 16 + _i * 8192, _R, _C); \
        _Pragma("unroll") for (int _h = 0; _h < 2; ++_h) dst[_h][_i] = (unsigned)((u).ltab[_h * HALF + _R] >> S.shift) * rowb + (unsigned)(_C * 2); } } while (0)
#define PG8_STAGE_A(bufoff, AO, koff) do { _Pragma("unroll") for (int _i = 0; _i < 2; ++_i) \
        __builtin_amdgcn_global_load_lds((const unsigned*)((const char*)g.A + (size_t)(AO)[_i] + (size_t)(koff)), (PG8_LAS unsigned*)(lds + (bufoff) + ldsw + _i * 8192), 16, 0, 0); } while (0)
    const size_t kstep = (size_t)(BK * 2);
    const size_t hstep = (size_t)HALF * K * 2;
    const size_t tstep = 2 * hstep;
    const unsigned ldsw = (unsigned)wid * 1024u;
    const int aoff = lds_byte(wr * 64 + fr, fq * 8), boff = lds_byte(wc * 32 + fr, fq * 8);
#define PG8_SA(b, h) (((b) * 2 + (h)) * HTB)
#define PG8_SB(b, h) ((4 + (b) * 2 + (h)) * HTB)
#define PG8_STAGE(bufoff, gbase, voff) do { _Pragma("unroll") for (int _i = 0; _i < 2; ++_i) \
        __builtin_amdgcn_global_load_lds((const unsigned*)((const char*)(gbase) + (voff)[_i]), (PG8_LAS unsigned*)(lds + (bufoff) + ldsw + _i * 8192), 16, 0, 0); } while (0)
#define PG8_LDA(dst, b, h) do { _Pragma("unroll") for (int m = 0; m < 4; ++m) _Pragma("unroll") for (int k = 0; k < 2; ++k) dst[m][k] = *(const PG8_LAS bf16x8*)(lds + PG8_SA(b, h) + aoff + m * 2048 + k * 1024); } while (0)
#define PG8_LDB(dst, b, h) do { _Pragma("unroll") for (int n = 0; n < 2; ++n) _Pragma("unroll") for (int k = 0; k < 2; ++k) dst[n][k] = *(const PG8_LAS bf16x8*)(lds + PG8_SB(b, h) + boff + n * 2048 + k * 1024); } while (0)
#define PG8_MMA(ai, bj, At, Bt) do { __builtin_amdgcn_s_setprio(1); _Pragma("unroll") for (int m = 0; m < 4; ++m) _Pragma("unroll") for (int n = 0; n < 2; ++n) _Pragma("unroll") for (int k = 0; k < 2; ++k) \
        acc[ai][bj][m][n] = __builtin_amdgcn_mfma_f32_16x16x32_bf16(Bt[n][k], At[m][k], acc[ai][bj][m][n], 0, 0, 0); __builtin_amdgcn_s_setprio(0); } while (0)
#define PG8_WAIT_V(n) asm volatile("s_waitcnt vmcnt(" #n ")" ::: "memory")
#define PG8_WAIT_L(n) asm volatile("s_waitcnt lgkmcnt(" #n ")" ::: "memory")
#define PG8_BAR __builtin_amdgcn_s_barrier()
#define PG8_SCHED __builtin_amdgcn_sched_barrier(0)
    UnitG cur, nxt; int ui = 0;
    if (!S.next(0, cur)) return;
    f32x4 acc[2][2][4][2];
#pragma unroll
    for (int a = 0; a < 2; ++a)
#pragma unroll
        for (int b = 0; b < 2; ++b)
#pragma unroll
            for (int m = 0; m < 4; ++m)
#pragma unroll
                for (int n = 0; n < 2; ++n) acc[a][b][m][n] = (f32x4){0.f, 0.f, 0.f, 0.f};
    bf16x8 At[4][2], B0[2][2], B1[2][2];
    unsigned ca[2][2]; PG8_AOFFS(cur, ca); const char* cB = cur.bbase + (size_t)cur.pn * tstep;
    S.a_ready(cur);
    PG8_STAGE(PG8_SB(0, 0), cB, voffB); PG8_STAGE_A(PG8_SA(0, 0), ca[0], 0); PG8_STAGE(PG8_SB(0, 1), cB + hstep, voffB); PG8_STAGE_A(PG8_SA(0, 1), ca[1], 0);
    if (wr == 1) PG8_BAR;
    PG8_WAIT_V(4); PG8_BAR;
    PG8_STAGE(PG8_SB(1, 0), cB + kstep, voffB); PG8_STAGE_A(PG8_SA(1, 0), ca[0], kstep); PG8_STAGE(PG8_SB(1, 1), cB + hstep + kstep, voffB);
    PG8_WAIT_V(6); PG8_BAR;
    for (;;) {
        const bool has_next = S.next(ui + 1, nxt);
        const char* nB = has_next ? nxt.bbase + (size_t)nxt.pn * tstep : cB;
        for (int t = 0; t < nt; t += 2) {
            const bool last = (t == nt - 2);
            const size_t k1 = (size_t)(t + 1) * kstep, k2 = last ? 0 : (size_t)(t + 2) * kstep;
            unsigned a2o[2][2];
            if (last && has_next) PG8_AOFFS(nxt, a2o); else { a2o[0][0] = ca[0][0]; a2o[0][1] = ca[0][1]; a2o[1][0] = ca[1][0]; a2o[1][1] = ca[1][1]; }
            const char* b2 = last ? nB : cB + (size_t)(t + 2) * kstep; const char* b3 = b2 + kstep;
            if (last && has_next) S.a_ready(nxt);
            PG8_LDB(B0, 0, 0); PG8_SCHED; PG8_LDA(At, 0, 0); PG8_STAGE_A(PG8_SA(1, 1), ca[1], k1);
            PG8_WAIT_L(8); PG8_BAR; PG8_WAIT_L(0); PG8_MMA(0, 0, At, B0); PG8_BAR; PG8_SCHED;
            PG8_LDB(B1, 0, 1); PG8_STAGE(PG8_SB(0, 0), b2, voffB);
            PG8_BAR; PG8_WAIT_L(0); PG8_MMA(0, 1, At, B1); PG8_BAR;
            PG8_LDA(At, 0, 1); PG8_STAGE_A(PG8_SA(0, 0), a2o[0], k2);
            PG8_BAR; PG8_WAIT_L(0); PG8_MMA(1, 0, At, B0); PG8_BAR; PG8_SCHED;
            PG8_STAGE(PG8_SB(0, 1), b2 + hstep, voffB);
            PG8_WAIT_V(6); PG8_BAR; PG8_MMA(1, 1, At, B1); PG8_BAR;
            PG8_LDB(B0, 1, 0); PG8_SCHED; PG8_LDA(At, 1, 0); PG8_STAGE_A(PG8_SA(0, 1), a2o[1], k2);
            PG8_WAIT_L(8); PG8_BAR; PG8_WAIT_L(0); PG8_MMA(0, 0, At, B0); PG8_BAR; PG8_SCHED;
            PG8_LDB(B1, 1, 1); PG8_STAGE(PG8_SB(1, 0), b3, voffB);
            PG8_BAR; PG8_WAIT_L(0); PG8_MMA(0, 1, At, B1); PG8_BAR;
            PG8_LDA(At, 1, 1); PG8_STAGE_A(PG8_SA(1, 0), a2o[0], k2 + kstep);
            PG8_BAR; PG8_WAIT_L(0); PG8_MMA(1, 0, At, B0); PG8_BAR; PG8_SCHED;
            PG8_STAGE(PG8_SB(1, 1), b3 + hstep, voffB);
            PG8_WAIT_V(6); PG8_BAR; PG8_MMA(1, 1, At, B1); PG8_BAR;
            if (last) { ca[0][0] = a2o[0][0]; ca[0][1] = a2o[0][1]; ca[1][0] = a2o[1][0]; ca[1][1] = a2o[1][1]; }
        }
            if constexpr (!Epi::AFTER_DRAIN) { E(acc, cur, wr, wc, fr, fq); S.done(cur); }
            if (!has_next) break;
#pragma unroll
        for (int a = 0; a < 2; ++a)
#pragma unroll
            for (int b = 0; b < 2; ++b)
#pragma unroll
                for (int m = 0; m < 4; ++m)
#pragma unroll
                    for (int n = 0; n < 2; ++n) acc[a][b][m][n] = (f32x4){0.f, 0.f, 0.f, 0.f};
        cur = nxt; cB = nB; ++ui;
    }
    PG8_WAIT_V(0);
    if (wr == 0) PG8_BAR;
    PG8_BAR;
    if constexpr (Epi::AFTER_DRAIN) { E.fused(acc, cur, wr, wc, fr, fq, lds, wid, lane); S.done(cur); }
#undef PG8_SA
#undef PG8_AOFFS
#undef PG8_STAGE_A
#undef PG8_SB
#undef PG8_STAGE
#undef PG8_LDA
#undef PG8_LDB
#undef PG8_MMA
#undef PG8_WAIT_V
#undef PG8_WAIT_L
#undef PG8_BAR
#undef PG8_SCHED
}
}

__device__ __forceinline__ void transpose_item(const float* __restrict__ W, int K, int N, bf16_t* __restrict__ WT, int mode, LAS float* scr, int item, int lane) {
    const int nblk = N / 32, kb = item / nblk, nb = item % nblk, k0 = 64 * kb, n0 = 32 * nb;
    {
        const float* wp = W + (size_t)(k0 + (lane >> 5)) * N + n0 + (lane & 31);
        float t[32];
#pragma unroll
        for (int i = 0; i < 32; ++i) t[i] = wp[(size_t)(2 * i) * N];
#pragma unroll
        for (int i = 0; i < 32; ++i) scr[(2 * i + (lane >> 5)) * 33 + (lane & 31)] = t[i];
    }
    asm volatile("s_waitcnt lgkmcnt(0)" ::: "memory");
    const int c = lane & 7;
#pragma unroll
    for (int j = 0; j < 4; ++j) {
        const int nl = (lane >> 3) + 8 * j; const LAS float* s = scr + (8 * c) * 33 + nl;
        u32x4 o; o.x = pk2(s[0 * 33], s[1 * 33]); o.y = pk2(s[2 * 33], s[3 * 33]); o.z = pk2(s[4 * 33], s[5 * 33]); o.w = pk2(s[6 * 33], s[7 * 33]);
        const int n = n0 + nl;
        const int nd = mode == 0 ? n : (32 * (n >> 4) + (n & 15) + (mode == 2 ? 16 : 0));
        *(u32x4*)(WT + (size_t)nd * K + k0 + 8 * c) = o;
    }
    asm volatile("s_waitcnt lgkmcnt(0)" ::: "memory");
}

constexpr int EXC_IG = 16 * 16, EXC_IDN = 8 * 32, EXC_PER = 2 * EXC_IG + EXC_IDN, EXC_ITEMS = NEXP * EXC_PER;
__device__ __forceinline__ int exc_s0(int layer) { return (layer & 1) ? 8192 : 10240; }
__device__ __forceinline__ int exc_s1(int layer) { return layer == DEPTH - 1 ? 0 : 7168; }
__device__ __forceinline__ void expconv_items(const CAS Params& P, int layer, LAS char* lds, int lo, int hi, int worker, int nworkers, int wid, int lane) {
    LAS float* scr = (LAS float*)(lds + wid * 8448);
    bf16_t* gu = (bf16_t*)(P.ws + WS_EXPGU); bf16_t* dw = (bf16_t*)(P.ws + WS_EXPD);
    for (int it = lo + worker; it < hi; it += nworkers) {
        const int e = it / EXC_PER; int r = it % EXC_PER;
        const size_t eo = (size_t)(layer * NEXP + e);
        if (r < EXC_IG) { transpose_item(P.exp_w_gate + eo * D * DEXP, D, DEXP, gu + (size_t)e * 1024 * 1024, 1, scr, r, lane); continue; } r -= EXC_IG;
        if (r < EXC_IG) { transpose_item(P.exp_w_up + eo * D * DEXP, D, DEXP, gu + (size_t)e * 1024 * 1024, 2, scr, r, lane); continue; } r -= EXC_IG;
        transpose_item(P.exp_w_down + eo * DEXP * D, DEXP, D, dw + (size_t)e * 1024 * 512, 0, scr, r, lane);
    }
}
__device__ __forceinline__ void expconv_tail(int wv, const CAS Params& P, int layer, LAS char* lds, int nwg, int lo, int hi) {
    const int G = gridDim.x, rem = nwg % G;
    if (rem != 0 && (int)blockIdx.x >= rem && lo < hi) {
        const int tid = ltid(wv);
        __syncthreads();
        expconv_items(P, layer, lds, lo, hi, ((int)blockIdx.x - rem) * 8 + (tid >> 6), (G - rem) * 8, tid >> 6, tid & 63);
    }
}

__device__ __forceinline__ void phase_prologue0(int wv, KP Pk, LAS char* lds) {
    asm volatile("" : "+s"(Pk));
    const CAS Params& P = *Pk;
    const int tid = ltid(wv), lane = tid & 63, wid = tid >> 6;
    const int gw = blockIdx.x * 8 + wid, NGW = gridDim.x * 8;
    LAS float* scr = (LAS float*)(lds + wid * 8448);
    bf16_t* winT = (bf16_t*)(P.ws + WS_WINT);
    bf16_t* woutT = (bf16_t*)(P.ws + WS_WOUTT);
    bf16_t* loraT = (bf16_t*)(P.ws + WS_LORAT);
    constexpr int I_EV = 16 * (P_EVEN / 32), I_OD = 16 * (P_ODD / 32), I_O = 16 * 32, I_L64 = 16, I_L128 = 32;
    constexpr int I_LORA = 3 * I_L64 + I_L128;
    constexpr int NIT = 2 * I_EV + 2 * I_OD + 4 * I_O + 2 * I_LORA;
    for (int it = gw; it < NIT; it += NGW) {
        int r = it;
        if (r < 2 * I_EV) { const int i = r / I_EV; transpose_item(P.ev_w_in + (size_t)i * D * P_EVEN, D, P_EVEN, winT + (i ? WINT_L2 : WINT_L0), 0, scr, r % I_EV, lane); continue; } r -= 2 * I_EV;
        if (r < 2 * I_OD) { const int i = r / I_OD; transpose_item(P.od_w_in + (size_t)i * D * P_ODD, D, P_ODD, winT + (i ? WINT_L3 : WINT_L1), 0, scr, r % I_OD, lane); continue; } r -= 2 * I_OD;
        if (r < 4 * I_O) { const int l = r / I_O; const float* src = (l & 1) ? P.od_w_out + (size_t)(l >> 1) * D * D : P.ev_w_out + (size_t)(l >> 1) * D * D;
            transpose_item(src, D, D, woutT + (size_t)l * D * D, 0, scr, r % I_O, lane); continue; } r -= 4 * I_O;
        { const int i = r / I_LORA; int q = r % I_LORA; bf16_t* dst = loraT + (size_t)i * LORA_PER;
          if (q < I_L64) { transpose_item(P.rw_w2 + (size_t)(i * 2 + 0) * 64 * 512, 64, 512, dst, 0, scr, q, lane); continue; } q -= I_L64;
          if (q < I_L64) { transpose_item(P.rw_w2 + (size_t)(i * 2 + 1) * 64 * 512, 64, 512, dst + 512 * 64, 0, scr, q, lane); continue; } q -= I_L64;
          if (q < I_L64) { transpose_item(P.rw_a2 + (size_t)i * 64 * 512, 64, 512, dst + 2 * 512 * 64, 0, scr, q, lane); continue; } q -= I_L64;
          transpose_item(P.rw_g2 + (size_t)i * 128 * 512, 128, 512, dst + 3 * 512 * 64, 0, scr, q, lane); }
    }
    {
        const int gt = blockIdx.x * NT + tid, NG = gridDim.x * NT;
        constexpr int PADE = (LDP_EVEN - P_EVEN) * D / 8, PADO = (LDP_ODD - P_ODD) * D / 8;
        for (int i = gt; i < 2 * PADE + 2 * PADO; i += NG) {
            int r = i; bf16_t* dst;
            if (r < 2 * PADE) { const int l = r / PADE; dst = winT + (l ? WINT_L2 : WINT_L0) + (size_t)P_EVEN * D + (size_t)(r % PADE) * 8; }
            else { r -= 2 * PADE; const int l = r / PADO; dst = winT + (l ? WINT_L3 : WINT_L1) + (size_t)P_ODD * D + (size_t)(r % PADO) * 8; }
            *(u32x4*)dst = (u32x4){0u, 0u, 0u, 0u};
        }
    }
    {
        const int gt = blockIdx.x * NT + tid, NG = gridDim.x * NT;
        float* lb = (float*)(P.ws + WS_LB);
        for (int ch = gt; ch < 512; ch += NG) {
            float lg[4], mx = -1e30f;
#pragma unroll
            for (int l = 0; l < 4; ++l) { lg[l] = P.hg_lb_logits[l * 512 + ch]; mx = fmaxf(mx, lg[l]); }
            float e[4], s = 0.f;
#pragma unroll
            for (int l = 0; l < 4; ++l) { e[l] = __expf(lg[l] - mx); s += e[l]; }
            float cum = 0.f;
#pragma unroll
            for (int l = 0; l < 4; ++l) { if (l > 0) cum += e[l] / s; lb[l * 512 + ch] = cum; }
        }
    }
    __syncthreads();
    {
        LAS float* sc = (LAS float*)lds;
        LAS float* red = (LAS float*)(lds + 5 * 1024 * 4);
        for (int i = tid; i < 5 * D; i += NT) { const int m = i >> 10, k = i & 1023; const float v = m < 4 ? P.c[m * D + k] : P.c_ctx[k]; sc[i] = siluf_(v); }
        __syncthreads();
        float* modv = (float*)(P.ws + WS_MODV);
        for (int cb = blockIdx.x; cb < 4 * 6144 / 96; cb += gridDim.x) {
            const int l = (cb * 96) / 6144, j0 = (cb * 96) % 6144;
            const int cg = tid % 24, kg = tid / 24;
            if (tid < 384) {
                const float* w = P.mod_w + (size_t)l * D * 6144 + (size_t)(kg * 64) * 6144 + j0 + 4 * cg;
                f32x4 a[5];
#pragma unroll
                for (int m = 0; m < 5; ++m) a[m] = (f32x4){0.f, 0.f, 0.f, 0.f};
#pragma unroll 1
                for (int k0 = 0; k0 < 64; k0 += 16) {
                    f32x4 wv4[16];
#pragma unroll
                    for (int u = 0; u < 16; ++u) wv4[u] = *(const f32x4*)(w + (size_t)(k0 + u) * 6144);
#pragma unroll
                    for (int u = 0; u < 16; ++u)
#pragma unroll
                        for (int m = 0; m < 5; ++m) a[m] += wv4[u] * sc[m * 1024 + kg * 64 + k0 + u];
                }
#pragma unroll
                for (int m = 0; m < 5; ++m) *(LAS f32x4*)(red + ((kg * 5 + m) * 96 + 4 * cg)) = a[m];
            }
            __syncthreads();
            if (tid < 480) {
                const int m = tid / 96, c = tid % 96;
                float sum = 0.f;
#pragma unroll
                for (int g = 0; g < 16; ++g) sum += red[(g * 5 + m) * 96 + c];
                modv[(size_t)(l * 5 + m) * 6144 + j0 + c] = sum + P.mod_b[l * 6144 + j0 + c];
            }
            __syncthreads();
        }
    }
}

__device__ __forceinline__ void phase_prologue1(int wv, KP Pk) {
    asm volatile("" : "+s"(Pk));
    const CAS Params& P = *Pk;
    const int tid = ltid(wv), lane = tid & 63, wid = tid >> 6;
    bf16_t* act = (bf16_t*)(P.ws + WS_ACT);
    f32x4 nv[4];
    auto fetch = [&](int rr) {
        const float* src = rr < NCTX ? P.ctx + (size_t)rr * D : P.x + (size_t)(rr - NCTX) * D;
#pragma unroll
        for (int i = 0; i < 4; ++i) nv[i] = *(const f32x4*)(src + 4 * lane + 256 * i);
    };
    const int stride = gridDim.x * 8;
    int r = blockIdx.x * 8 + wid;
    if (r < NROWS) fetch(r);
    for (; r < NROWS; r += stride) {
        const int m = row_mod(r);
        const f32x4 cv[4] = {nv[0], nv[1], nv[2], nv[3]};
        if (r + stride < NROWS) fetch(r + stride);
        const float* sh = modvec(P.ws, 0, m, 0); const float* sc = modvec(P.ws, 0, m, 1);
#pragma unroll
        for (int i = 0; i < 4; ++i) {
            const int c = 4 * lane + 256 * i;
            const f32x4 v = cv[i], s1 = *(const f32x4*)(sc + c), h1 = *(const f32x4*)(sh + c);
            u32x2 o; o.x = pk2(v[0] * (1.f + s1[0]) + h1[0], v[1] * (1.f + s1[1]) + h1[1]); o.y = pk2(v[2] * (1.f + s1[2]) + h1[2], v[3] * (1.f + s1[3]) + h1[3]);
            *(u32x2*)(act + (size_t)r * D + c) = o;
        }
    }
}

__device__ __forceinline__ void phase_inproj(int wv, KP Pk, int layer, LAS char* lds) {
    asm volatile("" : "+s"(Pk));
    const CAS Params& P = *Pk;
    const int odd = layer & 1, ldp = odd ? LDP_ODD : LDP_EVEN;
    const size_t woff = layer == 0 ? WINT_L0 : layer == 1 ? WINT_L1 : layer == 2 ? WINT_L2 : WINT_L3;
    pg8::Gemm g{(const bf16_t*)(P.ws + WS_ACT), (const bf16_t*)(P.ws + WS_WINT) + woff, NROWS, ldp, D};
    pg8::StaticOrder S; S.init(NROWS, ldp, (int)gridDim.x, (int)blockIdx.x);
    pg8::EpiStoreP E{(bf16_t*)(P.ws + WS_P), ldp};
    pg8::gemm_phase(wv, (PG8_LAS unsigned char*)lds, g, S, E);
    expconv_tail(wv, P, layer, lds, (NROWS / 256) * (ldp / 256), 0, exc_s0(layer));
}
__device__ __forceinline__ void phase_outproj(int wv, KP Pk, int layer, LAS char* lds) {
    asm volatile("" : "+s"(Pk));
    const CAS Params& P = *Pk;
    const int r0 = (layer == DEPTH - 1) ? NCTX : 0;
    pg8::Gemm g{(const bf16_t*)(P.ws + WS_FEAT) + (size_t)r0 * D, (const bf16_t*)(P.ws + WS_WOUTT) + (size_t)layer * D * D, NROWS - r0, D, D};
    pg8::StaticOrder S; S.init(NROWS - r0, D, (int)gridDim.x, (int)blockIdx.x);
    pg8::EpiStoreP E{(bf16_t*)(P.ws + WS_YO) + (size_t)r0 * D, D};
    pg8::gemm_phase(wv, (PG8_LAS unsigned char*)lds, g, S, E);
    expconv_tail(wv, P, layer, lds, ((NROWS - r0) / 256) * (D / 256), exc_s0(layer), exc_s0(layer) + exc_s1(layer));
}
__device__ __forceinline__ void phase_prep2(int wv, KP Pk, int layer, LAS char* lds) {
    asm volatile("" : "+s"(Pk));
    const CAS Params& P = *Pk;
    const int i = layer >> 1;
    const bf16_t* la = (const bf16_t*)(P.ws + WS_LA);
    const bf16_t* lt = (const bf16_t*)(P.ws + WS_LORAT) + (size_t)i * LORA_PER;
    constexpr int MT = NROWS / G_BM, NTL = 512 / G_BN;
    const int ntiles = 4 * MT * NTL;
    for (int t = blockIdx.x; t < ntiles; t += gridDim.x) {
        const int which = t / (MT * NTL), r = t % (MT * NTL), mt = r / NTL, nt = r % NTL;
        RowLinear rs{mt * G_BM};
        if (which < 2) {
            EpiDecay epi{(float*)(P.ws + WS_RWDEC) + (size_t)which * NROWS * 512, P.rw_w0 + (size_t)(i * 2 + which) * 512, mt * G_BM, nt * G_BN};
            gemm_tile(wv, la + which * 64, 320, rs, lt + (size_t)which * 512 * 64, 64, nt * G_BN, 64, epi, lds);
        } else if (which == 2) {
            EpiAK epi{(bf16_t*)(P.ws + WS_RWK), (const bf16_t*)(P.ws + WS_RWKK), (bf16_t*)(P.ws + WS_RWB), P.rw_a0 + i * 512, P.rw_k_a + i * 512, mt * G_BM, nt * G_BN};
            gemm_tile(wv, la + 128, 320, rs, lt + (size_t)2 * 512 * 64, 64, nt * G_BN, 64, epi, lds);
        } else {
            EpiStoreBf16 epi{(bf16_t*)(P.ws + WS_RWG), 512, mt * G_BM, nt * G_BN, 512};
            gemm_tile(wv, la + 192, 320, rs, lt + (size_t)3 * 512 * 64, 128, nt * G_BN, 128, epi, lds);
        }
    }
}
__device__ __forceinline__ void moe_tiles(int wv, const unsigned char* ws, int layer, LAS int* tstart, LAS int* tcnt) {
    const int tid = ltid(wv);
    if (tid < 64) {
        const int* cnt = (const int*)(ws + WS_CNT) + layer * 32 * CNT_STRIDE;
        const int c = tid < NEXP ? cnt[tid * CNT_STRIDE] : 0;
        int incl = (c + G_BM - 1) / G_BM;
#pragma unroll
        for (int o = 1; o < 32; o <<= 1) { const int t = __shfl_up(incl, o); if (tid >= o) incl += t; }
        if (tid < NEXP) { tcnt[tid] = c; tstart[tid] = incl - (c + G_BM - 1) / G_BM; }
        if (tid == NEXP - 1) tstart[NEXP] = incl;
    }
    __syncthreads();
}
__device__ __forceinline__ void phase_moe1(int wv, KP Pk, int layer, LAS char* lds) {
    asm volatile("" : "+s"(Pk));
    const CAS Params& P = *Pk;
    LAS int* tstart = (LAS int*)(lds + pg8::STAGE_BYTES); LAS int* tcnt = tstart + 40;
    moe_tiles(wv, P.ws, layer, tstart, tcnt);
    pg8::Gemm g{(const bf16_t*)(P.ws + WS_ACT), (const bf16_t*)(P.ws + WS_EXPGU), 0, 1024, D};
    LAS int* ltabs = tstart + 128;
    pg8::MoeOrder S{tstart, tcnt, ltabs, (const int*)(P.ws + WS_LIST), (const char*)(P.ws + WS_EXPGU), (size_t)1024 * 1024 * 2, 4, 1, (int)gridDim.x, (int)blockIdx.x};
    pg8::EpiSwiGLUG E{(bf16_t*)(P.ws + WS_HID)};
    for (int i = 0; i < 8; ++i) {
        pg8::UnitG u; if (!S.next(i, u)) break;
        const int tl = ltid(wv);
        const int* ul = (const int*)(P.ws + WS_LIST) + (size_t)u.e * LISTCAP + u.pm * pg8::BM;
        if (tl < pg8::BM) ltabs[i * pg8::BM + tl] = ul[tl < u.cnt ? tl : 0];
    }
    __syncthreads();
    pg8::gemm_phase_g(wv, (PG8_LAS unsigned char*)lds, g, S, E);
    __syncthreads();
}
__device__ __forceinline__ void phase_moe2(int wv, KP Pk, int layer, LAS char* lds) {
    asm volatile("" : "+s"(Pk));
    const CAS Params& P = *Pk;
    LAS int* tstart = (LAS int*)(lds + pg8::STAGE_BYTES); LAS int* tcnt = tstart + 40;
    moe_tiles(wv, P.ws, layer, tstart, tcnt);
    pg8::Gemm g{(const bf16_t*)(P.ws + WS_HID), (const bf16_t*)(P.ws + WS_EXPD), 0, 1024, DEXP};
    LAS int* ltabs = tstart + 128;
    pg8::MoeOrder S{tstart, tcnt, ltabs, (const int*)(P.ws + WS_LIST), (const char*)(P.ws + WS_EXPD), (size_t)1024 * 512 * 2, 4, 0, (int)gridDim.x, (int)blockIdx.x};
    pg8::EpiScatterG E{(bf16_t*)(P.ws + WS_YP)};
    for (int i = 0; i < 8; ++i) {
        pg8::UnitG u; if (!S.next(i, u)) break;
        const int tl = ltid(wv);
        const int* ul = (const int*)(P.ws + WS_LIST) + (size_t)u.e * LISTCAP + u.pm * pg8::BM;
        if (tl < pg8::BM) ltabs[i * pg8::BM + tl] = ul[tl < u.cnt ? tl : 0];
    }
    __syncthreads();
    pg8::gemm_phase_g(wv, (PG8_LAS unsigned char*)lds, g, S, E);
    __syncthreads();
}

constexpr int NCHUNK = NSTEPS / TCH;

constexpr int SSD_F = 32 + 64 + 64;
constexpr int SSD_BUF = TCH * SSD_F + 3 * TCH;

constexpr int ML_F = 64 + 64 + 32;
constexpr int ML_BUF = TCH * ML_F + 4 * TCH;

constexpr int HG_F = 128 + 128 + 32;
constexpr int HG_BUF = TCH * HG_F + TCH;

constexpr int RW_F = 5 * 64 + 32;
constexpr int RW_BUF = TCH * RW_F + TCH;
__device__ __forceinline__ void scan_rwkv(int wv, KP Pk, int layer, int unit, LAS char* lds) {
    asm volatile("" : "+s"(Pk));
    const CAS Params& P = *Pk;
    const int tid = ltid(wv);
    const int seq = unit >> 1, half = unit & 1, b = seq >> 4, h = (seq >> 1) & 7, dir = seq & 1;
    LAS float* bufs = (LAS float*)lds;
    bf16_t* Y = (bf16_t*)(P.ws + (dir ? WS_YB : WS_YF));
    const float* dec = (const float*)(P.ws + WS_RWDEC) + (size_t)dir * NROWS * 512;
    int tj[4], tg_[4]; bool tv[4]; const unsigned char* tbase[4]; int tlds[4];
#pragma unroll
    for (int s = 0; s < 4; ++s) {
        const int task = tid + NT * s; tv[s] = task < TCH * 52; tj[s] = task / 52; tg_[s] = task % 52;
        const int g = tg_[s];
        if (g < 8)       { tbase[s] = P.ws + WS_RWR  + (size_t)(h * 64 + 8 * g) * 2;              tlds[s] = 256 + 8 * g; }
        else if (g < 16) { tbase[s] = P.ws + WS_RWK  + (size_t)(h * 64 + 8 * (g - 8)) * 2;        tlds[s] = 192 + 8 * (g - 8); }
        else if (g < 24) { tbase[s] = P.ws + WS_RWKK + (size_t)(h * 64 + 8 * (g - 16)) * 2;       tlds[s] = 64 + 8 * (g - 16); }
        else if (g < 32) { tbase[s] = P.ws + WS_RWB  + (size_t)(h * 64 + 8 * (g - 24)) * 2;       tlds[s] = 128 + 8 * (g - 24); }
        else if (g < 36) { tbase[s] = P.ws + WS_RWV  + (size_t)(h * 64 + half * 32 + 8 * (g - 32)) * 2; tlds[s] = 320 + 8 * (g - 32); }
        else             { tbase[s] = (const unsigned char*)(dec + h * 64 + 4 * (g - 36));        tlds[s] = 4 * (g - 36); }
    }
    u32x4 rc[4]; int rrow = 0;
    auto load = [&](int c) {
#pragma unroll
        for (int s = 0; s < 4; ++s) {
            rc[s] = (u32x4){0u, 0u, 0u, 0u};
            if (tv[s]) { const int row = scan_row(c * TCH + tj[s], b, dir, 1); rc[s] = *(const u32x4*)(tbase[s] + (size_t)row * (tg_[s] < 36 ? 1024 : 2048)); }
        }
        if (tid < TCH) rrow = scan_row(c * TCH + tid, b, dir, 1);
    };
    auto store = [&](int c) {
        LAS float* buf = bufs + (c & 1) * RW_BUF;
#pragma unroll
        for (int s = 0; s < 4; ++s) {
            if (tv[s]) {
                LAS float* dst = buf + tj[s] * RW_F + tlds[s];
                const int g = tg_[s];
                if (g >= 36) { *(LAS u32x4*)dst = rc[s]; }
                else {
                    float f[8]; unpack8(rc[s], f);
                    const float sg = (g >= 16 && g < 24) ? -1.f : 1.f;
                    *(LAS f32x4*)dst = (f32x4){sg * f[0], sg * f[1], sg * f[2], sg * f[3]}; *(LAS f32x4*)(dst + 4) = (f32x4){sg * f[4], sg * f[5], sg * f[6], sg * f[7]};
                }
            }
        }
        if (tid < TCH) ((LAS int*)buf)[TCH * RW_F + tid] = rrow;
    };
    const int vrow = tid >> 4, q = tid & 15;
    f32x2 S01 = {0.f, 0.f}, S23 = {0.f, 0.f};
    LAS float* ypw = bufs + 2 * RW_BUF + (tid >> 6) * (2 * 16 * 68);
    int prow = -1, gpar = 0;
    load(0); store(0); __syncthreads();
    for (int c = 0; c < NCHUNK; ++c) {
        if (c + 1 < NCHUNK) load(c + 1);
        LAS float* buf = bufs + (c & 1) * RW_BUF;
        {
            const LAS float* wp = buf + 4 * q;
            const LAS float* vp = buf + 320 + vrow;
            f32x4 w4 = *(const LAS f32x4*)wp, a4 = *(const LAS f32x4*)(wp + 64), b4 = *(const LAS f32x4*)(wp + 128), k4 = *(const LAS f32x4*)(wp + 192), r4 = *(const LAS f32x4*)(wp + 256); float vr = vp[0];
#pragma unroll 1
            for (int jh = 0; jh < 2; ++jh) {
                const LAS float* rp = ypw + (gpar ^ 1) * (16 * 68) + q * 68 + ((tid >> 4) & 3) * 16;
                const f32x4 p0 = *(const LAS f32x4*)rp, p1 = *(const LAS f32x4*)(rp + 4), p2 = *(const LAS f32x4*)(rp + 8), p3 = *(const LAS f32x4*)(rp + 12);
                LAS float* wpz = ypw + gpar * (16 * 68) + (tid & 63);
#pragma unroll
                for (int j = 0; j < 16; ++j) {
                    const int jj = jh * 16 + j;
                    const f32x4 wc = w4, ac = a4, bc = b4, kc = k4, rc = r4; const float vv = vr;
                    if (j < 15 || jh == 0) {
                        const LAS float* np = wp + (jj + 1) * RW_F;
                        w4 = *(const LAS f32x4*)np; a4 = *(const LAS f32x4*)(np + 64); b4 = *(const LAS f32x4*)(np + 128); k4 = *(const LAS f32x4*)(np + 192); r4 = *(const LAS f32x4*)(np + 256); vr = vp[(jj + 1) * RW_F];
                    }
                    const f32x2 a01 = {ac[0], ac[1]}, a23 = {ac[2], ac[3]}, w01 = {wc[0], wc[1]}, w23 = {wc[2], wc[3]}, b01 = {bc[0], bc[1]}, b23 = {bc[2], bc[3]};
                    const f32x2 k01 = {kc[0], kc[1]}, k23 = {kc[2], kc[3]}, r01 = {rc[0], rc[1]}, r23 = {rc[2], rc[3]}, vv2 = {vv, vv};
                    f32x2 t = S01 * a01; t = S23 * a23 + t;
                    const f32x2 u01 = S01 * w01 + vv2 * k01, u23 = S23 * w23 + vv2 * k23;
                    const float sa = allreduce16(t.x + t.y);
                    const f32x2 sa2 = {sa, sa};
                    S01 = sa2 * b01 + u01; S23 = sa2 * b23 + u23;
                    f32x2 yv = S01 * r01; yv = S23 * r23 + yv;
                    wpz[j * 68] = yv.x + yv.y;
                }
                if (prow >= 0) {
                    const f32x4 t = (p0 + p1) + (p2 + p3);
                    Y[(size_t)prow * D + 512 + h * 64 + half * 32 + vrow] = f2bf((t[0] + t[1]) + (t[2] + t[3]));
                }
                prow = ((const LAS int*)buf)[TCH * RW_F + jh * 16 + q];
                gpar ^= 1;
            }
        }
        if (c + 1 < NCHUNK) store(c + 1);
        __syncthreads();
    }
    {
        const LAS float* rp = ypw + (gpar ^ 1) * (16 * 68) + q * 68 + ((tid >> 4) & 3) * 16;
        const f32x4 t = (*(const LAS f32x4*)rp + *(const LAS f32x4*)(rp + 4)) + (*(const LAS f32x4*)(rp + 8) + *(const LAS f32x4*)(rp + 12));
        Y[(size_t)prow * D + 512 + h * 64 + half * 32 + vrow] = f2bf((t[0] + t[1]) + (t[2] + t[3]));
    }
}

__device__ __forceinline__ void scan_rwkv_b(int wv, KP Pk, int layer, int unit, LAS char* lds) {
    asm volatile("" : "+s"(Pk));
    const CAS Params& P = *Pk;
    const int tid = ltid(wv);
    const int seq = unit >> 1, half = unit & 1, b = seq >> 4, h = (seq >> 1) & 7, dir = seq & 1;
    LAS float* bufs = (LAS float*)lds;
    bf16_t* Y = (bf16_t*)(P.ws + (dir ? WS_YB : WS_YF));
    const float* dec = (const float*)(P.ws + WS_RWDEC) + (size_t)dir * NROWS * 512;
    constexpr int NS = 7;
    const int stid = tid - 256;
    int tj[NS], tg_[NS]; bool tv[NS]; const unsigned char* tbase[NS]; int tlds[NS];
#pragma unroll
    for (int s = 0; s < NS; ++s) {
        const int task = stid + 256 * s; tv[s] = stid >= 0 && task < TCH * 52; tj[s] = task / 52; tg_[s] = task % 52;
        const int g = tg_[s];
        if (g < 8)       { tbase[s] = P.ws + WS_RWR  + (size_t)(h * 64 + 8 * g) * 2;              tlds[s] = 256 + 8 * g; }
        else if (g < 16) { tbase[s] = P.ws + WS_RWK  + (size_t)(h * 64 + 8 * (g - 8)) * 2;        tlds[s] = 192 + 8 * (g - 8); }
        else if (g < 24) { tbase[s] = P.ws + WS_RWKK + (size_t)(h * 64 + 8 * (g - 16)) * 2;       tlds[s] = 64 + 8 * (g - 16); }
        else if (g < 32) { tbase[s] = P.ws + WS_RWB  + (size_t)(h * 64 + 8 * (g - 24)) * 2;       tlds[s] = 128 + 8 * (g - 24); }
        else if (g < 36) { tbase[s] = P.ws + WS_RWV  + (size_t)(h * 64 + half * 32 + 8 * (g - 32)) * 2; tlds[s] = 320 + 8 * (g - 32); }
        else             { tbase[s] = (const unsigned char*)(dec + h * 64 + 4 * (g - 36));        tlds[s] = 4 * (g - 36); }
    }
    u32x4 rc[NS]; int rrow = 0;
    auto load = [&](int c) {
#pragma unroll
        for (int s = 0; s < NS; ++s) {
            rc[s] = (u32x4){0u, 0u, 0u, 0u};
            if (tv[s]) { const int row = scan_row(c * TCH + tj[s], b, dir, 1); rc[s] = *(const u32x4*)(tbase[s] + (size_t)row * (tg_[s] < 36 ? 1024 : 2048)); }
        }
        if (stid >= 0 && stid < TCH) rrow = scan_row(c * TCH + stid, b, dir, 1);
    };
    auto store = [&](int c) {
        LAS float* buf = bufs + (c & 1) * RW_BUF;
#pragma unroll
        for (int s = 0; s < NS; ++s) {
            if (tv[s]) {
                LAS float* dst = buf + tj[s] * RW_F + tlds[s];
                const int g = tg_[s];
                if (g >= 36) { *(LAS u32x4*)dst = rc[s]; }
                else {
                    float f[8]; unpack8(rc[s], f);
                    const float sg = (g >= 16 && g < 24) ? -1.f : 1.f;
                    *(LAS f32x4*)dst = (f32x4){sg * f[0], sg * f[1], sg * f[2], sg * f[3]}; *(LAS f32x4*)(dst + 4) = (f32x4){sg * f[4], sg * f[5], sg * f[6], sg * f[7]};
                }
            }
        }
        if (stid >= 0 && stid < TCH) ((LAS int*)buf)[TCH * RW_F + stid] = rrow;
    };
    const int q = tid & 15, vr = (tid >> 4) & 3, rowA = 8 * wv + vr, rowB = rowA + 4;
    f32x2 A01 = {0.f, 0.f}, A23 = {0.f, 0.f}, B01 = {0.f, 0.f}, B23 = {0.f, 0.f};
    LAS float* ypw = bufs + 2 * RW_BUF + (wv & 3) * (2 * 16 * 132);
    int prow = -1, gpar = 0;
    if (wv >= 4) { load(0); store(0); }
    __syncthreads();
    for (int c = 0; c < NCHUNK; ++c) {
        if (wv >= 4 && c + 1 < NCHUNK) load(c + 1);
        LAS float* buf = bufs + (c & 1) * RW_BUF;
        if (wv < 4) {
            const LAS float* wp = buf + 4 * q;
            const LAS float* vpA = buf + 320 + rowA; const LAS float* vpB = buf + 320 + rowB;
            f32x4 w4 = *(const LAS f32x4*)wp, a4 = *(const LAS f32x4*)(wp + 64), b4 = *(const LAS f32x4*)(wp + 128), k4 = *(const LAS f32x4*)(wp + 192), r4 = *(const LAS f32x4*)(wp + 256); float vrA = vpA[0], vrB = vpB[0];
#pragma unroll 1
            for (int jh = 0; jh < 2; ++jh) {
                const LAS float* rp = ypw + (gpar ^ 1) * (16 * 132) + q * 132 + vr * 16;
                const f32x4 pa0 = *(const LAS f32x4*)rp, pa1 = *(const LAS f32x4*)(rp + 4), pa2 = *(const LAS f32x4*)(rp + 8), pa3 = *(const LAS f32x4*)(rp + 12);
                const f32x4 pb0 = *(const LAS f32x4*)(rp + 64), pb1 = *(const LAS f32x4*)(rp + 68), pb2 = *(const LAS f32x4*)(rp + 72), pb3 = *(const LAS f32x4*)(rp + 76);
                LAS float* wpz = ypw + gpar * (16 * 132) + (tid & 63);
#pragma unroll
                for (int j = 0; j < 16; ++j) {
                    const int jj = jh * 16 + j;
                    const f32x4 wc = w4, ac = a4, bc = b4, kc = k4, rc = r4; const float vvA = vrA, vvB = vrB;
                    if (j < 15 || jh == 0) {
                        const LAS float* np = wp + (jj + 1) * RW_F;
                        w4 = *(const LAS f32x4*)np; a4 = *(const LAS f32x4*)(np + 64); b4 = *(const LAS f32x4*)(np + 128); k4 = *(const LAS f32x4*)(np + 192); r4 = *(const LAS f32x4*)(np + 256);
                        vrA = vpA[(jj + 1) * RW_F]; vrB = vpB[(jj + 1) * RW_F];
                    }
                    const f32x2 a01 = {ac[0], ac[1]}, a23 = {ac[2], ac[3]}, w01 = {wc[0], wc[1]}, w23 = {wc[2], wc[3]}, b01 = {bc[0], bc[1]}, b23 = {bc[2], bc[3]};
                    const f32x2 k01 = {kc[0], kc[1]}, k23 = {kc[2], kc[3]}, r01 = {rc[0], rc[1]}, r23 = {rc[2], rc[3]}, va2 = {vvA, vvA}, vb2 = {vvB, vvB};
                    f32x2 tA = A01 * a01; tA = A23 * a23 + tA;
                    f32x2 tB = B01 * a01; tB = B23 * a23 + tB;
                    const f32x2 uA01 = A01 * w01 + va2 * k01, uA23 = A23 * w23 + va2 * k23, uB01 = B01 * w01 + vb2 * k01, uB23 = B23 * w23 + vb2 * k23;
                    const float saA = allreduce16(tA.x + tA.y), saB = allreduce16(tB.x + tB.y);
                    const f32x2 sA2 = {saA, saA}, sB2 = {saB, saB};
                    A01 = sA2 * b01 + uA01; A23 = sA2 * b23 + uA23; B01 = sB2 * b01 + uB01; B23 = sB2 * b23 + uB23;
                    f32x2 yA = A01 * r01; yA = A23 * r23 + yA;
                    f32x2 yB = B01 * r01; yB = B23 * r23 + yB;
                    wpz[j * 132] = yA.x + yA.y; wpz[j * 132 + 64] = yB.x + yB.y;
                }
                if (prow >= 0) {
                    const f32x4 ta = (pa0 + pa1) + (pa2 + pa3), tb = (pb0 + pb1) + (pb2 + pb3);
                    bf16_t* yo = Y + (size_t)prow * D + 512 + h * 64 + half * 32;
                    yo[rowA] = f2bf((ta[0] + ta[1]) + (ta[2] + ta[3])); yo[rowB] = f2bf((tb[0] + tb[1]) + (tb[2] + tb[3]));
                }
                prow = ((const LAS int*)buf)[TCH * RW_F + jh * 16 + q];
                gpar ^= 1;
            }
        }
        if (wv >= 4 && c + 1 < NCHUNK) store(c + 1);
        __syncthreads();
    }
    if (wv < 4) {
        const LAS float* rp = ypw + (gpar ^ 1) * (16 * 132) + q * 132 + vr * 16;
        const f32x4 ta = (*(const LAS f32x4*)rp + *(const LAS f32x4*)(rp + 4)) + (*(const LAS f32x4*)(rp + 8) + *(const LAS f32x4*)(rp + 12));
        const f32x4 tb = (*(const LAS f32x4*)(rp + 64) + *(const LAS f32x4*)(rp + 68)) + (*(const LAS f32x4*)(rp + 72) + *(const LAS f32x4*)(rp + 76));
        bf16_t* yo = Y + (size_t)prow * D + 512 + h * 64 + half * 32;
        yo[rowA] = f2bf((ta[0] + ta[1]) + (ta[2] + ta[3])); yo[rowB] = f2bf((tb[0] + tb[1]) + (tb[2] + tb[3]));
    }
}

constexpr size_t WS_EXBC = WS_RWR;
constexpr size_t WS_EQK = WS_EXBC + (size_t)NROWS * 768 * 2;
constexpr size_t WS_EGT = WS_EQK + (size_t)NROWS * 512 * 2;
static_assert(WS_EGT + (size_t)NROWS * 32 * 4 <= WS_LA, "even-layer prepare buffers must fit in the RWKV region");

__device__ __forceinline__ void phase_prep_even(int wv, KP Pk, int layer) {
    asm volatile("" : "+s"(Pk));
    const CAS Params& P = *Pk;
    const int tid = ltid(wv), lane = tid & 63, wid = tid >> 6, i_ = layer >> 1;
    const bf16_t* Pb = (const bf16_t*)(P.ws + WS_P);
    bf16_t* XBC = (bf16_t*)(P.ws + WS_EXBC); bf16_t* QK = (bf16_t*)(P.ws + WS_EQK); float* GT = (float*)(P.ws + WS_EGT);
    float cw0[4][8], cw1[4][8], cwq[4][8];
#pragma unroll
    for (int e = 0; e < 8; ++e) {
#pragma unroll
        for (int t = 0; t < 3; ++t) {
            cw0[t][e] = P.ssd_conv_w[(size_t)(i_ * 3 + t) * 768 + 8 * lane + e];
            cw1[t][e] = P.ssd_conv_w[(size_t)(i_ * 3 + t) * 768 + 512 + 8 * (lane & 31) + e];
            cwq[t][e] = P.ml_conv_w[(size_t)(i_ * 3 + t) * 512 + 8 * lane + e];
        }
        cw0[3][e] = P.ssd_conv_b[i_ * 768 + 8 * lane + e]; cw1[3][e] = P.ssd_conv_b[i_ * 768 + 512 + 8 * (lane & 31) + e]; cwq[3][e] = P.ml_conv_b[i_ * 512 + 8 * lane + e];
    }
    float gbias = 0.f;
    if (lane < 16) gbias = P.ssd_dt_bias[i_ * 16 + lane]; else if (lane < 24) gbias = P.ml_i_bias[i_ * 8 + lane - 16]; else if (lane < 32) gbias = P.ml_f_bias[i_ * 8 + lane - 24];
    const float qscl = lane < 32 ? 0.125f : 1.f;
    const u32x4 zero = (u32x4){0u, 0u, 0u, 0u};
    u32x4 nA[3], nB[3], nC[3]; bf16_t ng = 0;
    auto fetch = [&](int rr) {
        int t, len; row_seg(rr, t, len);
        const bf16_t* pr = Pb + (size_t)rr * LDP_EVEN;
        const bool hp = t > 0, hn = t < len - 1;
        { const int col = 512 + 8 * lane; nA[0] = *(const u32x4*)(pr + col); nA[1] = hp ? *(const u32x4*)(pr - LDP_EVEN + col) : zero; nA[2] = hn ? *(const u32x4*)(pr + LDP_EVEN + col) : zero; }
        if (lane < 32) { const int col = 1024 + 8 * lane; nB[0] = *(const u32x4*)(pr + col); nB[1] = hp ? *(const u32x4*)(pr - LDP_EVEN + col) : zero; nB[2] = hn ? *(const u32x4*)(pr + LDP_EVEN + col) : zero; }
        { const int col = 1296 + 8 * lane; nC[0] = *(const u32x4*)(pr + col); nC[1] = hp ? *(const u32x4*)(pr - LDP_EVEN + col) : zero; nC[2] = hn ? *(const u32x4*)(pr + LDP_EVEN + col) : zero; }
        if (lane < 32) ng = pr[lane < 16 ? 1280 + lane : 2832 + (lane - 16)];
    };
    nB[0] = nB[1] = nB[2] = zero;
    const int stride = gridDim.x * 8;
    int r = blockIdx.x * 8 + wid;
    if (r < NROWS) fetch(r);
    for (; r < NROWS; r += stride) {
        const u32x4 cA0 = nA[0], cA1 = nA[1], cA2 = nA[2], cB0 = nB[0], cB1 = nB[1], cB2 = nB[2], cC0 = nC[0], cC1 = nC[1], cC2 = nC[2]; const bf16_t cg = ng;
        if (r + stride < NROWS) fetch(r + stride);
        float fc[8], fp[8], fn[8], o[8];
        {
            unpack8(cA0, fc); unpack8(cA1, fp); unpack8(cA2, fn);
#pragma unroll
            for (int e = 0; e < 8; ++e) o[e] = siluf_(cw0[0][e] * fp[e] + cw0[1][e] * fc[e] + cw0[2][e] * fn[e] + cw0[3][e]);
            *(u32x4*)(XBC + (size_t)r * 768 + 8 * lane) = pack8(o);
        }
        if (lane < 32) {
            unpack8(cB0, fc); unpack8(cB1, fp); unpack8(cB2, fn);
#pragma unroll
            for (int e = 0; e < 8; ++e) o[e] = siluf_(cw1[0][e] * fp[e] + cw1[1][e] * fc[e] + cw1[2][e] * fn[e] + cw1[3][e]);
            *(u32x4*)(XBC + (size_t)r * 768 + 512 + 8 * lane) = pack8(o);
        }
        {
            unpack8(cC0, fc); unpack8(cC1, fp); unpack8(cC2, fn);
#pragma unroll
            for (int e = 0; e < 8; ++e) o[e] = qscl * siluf_(cwq[0][e] * fp[e] + cwq[1][e] * fc[e] + cwq[2][e] * fn[e] + cwq[3][e]);
            *(u32x4*)(QK + (size_t)r * 512 + 8 * lane) = pack8(o);
        }
        if (lane < 32) {
            const float x = bf2f(cg) + gbias;
            GT[(size_t)r * 32 + lane] = lane < 16 ? softplusf_(x) : lane < 24 ? x : logsigmoidf_(x);
        }
    }
}

constexpr int CL = 64, NCH64 = NSTEPS / CL, LDT = 72, LDTB = LDT * 2;
__device__ __forceinline__ bf16x8 ldfrag(const LAS char* tile, int ldb, int row0, int k0, int lane) {
    return *(const LAS bf16x8*)(tile + (row0 + (lane & 15)) * ldb + (k0 + 8 * (lane >> 4)) * 2);
}
constexpr int LDTS = 160;
typedef short s16x4 __attribute__((ext_vector_type(4)));
constexpr int LDV = 272;
__device__ __forceinline__ bf16x8 ldfrag_tr(const LAS char* tile, int rowb, int c0, int k0, int lane) {
    const int i = lane & 15;
    const LAS char* p = tile + (k0 + 8 * (lane >> 4) + (i >> 2)) * rowb + (c0 + 4 * (i & 3)) * 2;
    const s16x4 lo = __builtin_amdgcn_ds_read_tr16_b64_v4i16((LAS s16x4*)p);
    const s16x4 hi = __builtin_amdgcn_ds_read_tr16_b64_v4i16((LAS s16x4*)(p + 4 * rowb));
    return (bf16x8){lo[0], lo[1], lo[2], lo[3], hi[0], hi[1], hi[2], hi[3]};
}
__device__ __forceinline__ int swz_off(int row, int byteoff) { return row * LDTS + (byteoff ^ (((row >> 3) & 7) << 4)); }
__device__ __forceinline__ bf16x8 ldfrag_sw(const LAS char* tile, int row0, int k0, int lane) {
    const int row = row0 + (lane & 15);
    return *(const LAS bf16x8*)(tile + swz_off(row, (k0 + 8 * (lane >> 4)) * 2));
}
__device__ __forceinline__ void st4bf(LAS char* p, const f32x4& v) { u32x2 o; o.x = pk2(v[0], v[1]); o.y = pk2(v[2], v[3]); *(LAS u32x2*)p = o; }

constexpr int SS_BT = 0, SS_CT = SS_BT + 64 * LDTB, SS_BDT = SS_CT + 64 * LDTB, SS_XT = SS_BDT + 64 * LDTB, SS_CUM = SS_XT + 32 * LDTB, SS_DTV = SS_CUM + 256, SS_ROWS = SS_DTV + 256, SS_STG = SS_ROWS + 256;
constexpr int SS_M = 2 * SS_STG, SS_HB = SS_M + 64 * LDTB, SS_END = SS_HB + 32 * LDTB;
static_assert(SS_END <= LDS_BYTES - 16, "SSD LDS map");

constexpr int MS_QT = 0, MS_KT = MS_QT + 64 * LDTB, MS_KET = MS_KT + 64 * LDTB, MS_VT = MS_KET + 64 * LDTB, MS_SC = MS_VT + 32 * LDTB;
constexpr int MS_STG = MS_SC + 8 * 256;
constexpr int MS_W = 2 * MS_STG, MS_CB = MS_W + 64 * LDTB, MS_ONE = MS_CB + 32 * LDTB, MS_NV = MS_ONE + 16 * LDTB, MS_QN = MS_NV + 256, MS_END = MS_QN + 256;
static_assert(MS_END <= LDS_BYTES - 16, "mLSTM LDS map");

constexpr size_t WS_XSS = WS_EGT + al256((size_t)NROWS * 32 * 4);
constexpr size_t XSS_BYTES = (size_t)64 * NCH64 * 64 * 64 * 2;
constexpr size_t WS_XSD = WS_XSS + XSS_BYTES;
constexpr size_t WS_XMC = WS_XSD + al256((size_t)64 * NCH64 * 4);
constexpr size_t XMC_BYTES = (size_t)32 * NCH64 * 128 * 64 * 2;
constexpr size_t WS_XMN = WS_XMC + XMC_BYTES;
constexpr size_t WS_XMS = WS_XMN + (size_t)32 * NCH64 * 64 * 4;
constexpr size_t WS_XMT = WS_XMS + al256((size_t)32 * NCH64 * 4 * 4);
constexpr size_t WS_XEND = WS_XMT + (size_t)32 * NCH64 * 3 * 64 * 4;
static_assert(WS_XEND <= WS_END, "even-layer chunk-state buffers must fit in the RWKV region");
constexpr int NSSD_ITEMS = 64 * NCH64, NML_ITEMS = 32 * NCH64;

template <int CTRL, int RM, int BM> __device__ __forceinline__ float dppx(float old, float v) {
    return __builtin_bit_cast(float, __builtin_amdgcn_update_dpp(__builtin_bit_cast(int, old), __builtin_bit_cast(int, v), CTRL, RM, BM, false));
}
__device__ __forceinline__ float wave_cumsum(float v, int) {
    float t = v;
    t += dppx<0x111, 0xf, 0xf>(0.f, v); t += dppx<0x112, 0xf, 0xf>(0.f, v); t += dppx<0x113, 0xf, 0xf>(0.f, v);
    { const float u = dppx<0x114, 0xf, 0xe>(0.f, t); t += u; }
    { const float u = dppx<0x118, 0xf, 0xc>(0.f, t); t += u; }
    { const float u = dppx<0x142, 0xa, 0xf>(0.f, t); t += u; }
    { const float u = dppx<0x143, 0xc, 0xf>(0.f, t); t += u; }
    return t;
}
__device__ __forceinline__ float wave_cummax(float v, int) {
    const float ninf = -__builtin_huge_valf();
    float t = v;
    t = fmaxf(t, dppx<0x111, 0xf, 0xf>(ninf, v)); t = fmaxf(t, dppx<0x112, 0xf, 0xf>(ninf, v)); t = fmaxf(t, dppx<0x113, 0xf, 0xf>(ninf, v));
    { const float u = dppx<0x114, 0xf, 0xe>(ninf, t); t = fmaxf(t, u); }
    { const float u = dppx<0x118, 0xf, 0xc>(ninf, t); t = fmaxf(t, u); }
    { const float u = dppx<0x142, 0xa, 0xf>(ninf, t); t = fmaxf(t, u); }
    { const float u = dppx<0x143, 0xc, 0xf>(ninf, t); t = fmaxf(t, u); }
    return t;
}
__device__ __forceinline__ float wave_max(float v) {
    const float t = wave_cummax(v, 0);
    return __builtin_bit_cast(float, __builtin_amdgcn_readlane(__builtin_bit_cast(int, t), 63));
}

constexpr int X1S_BDT = 0, X1S_XT = X1S_BDT + 64 * LDTB, X1S_CUM = X1S_XT + 64 * LDTB, X1S_DTV = X1S_CUM + 256, X1S_END = X1S_DTV + 256;
constexpr int X1M_KET = 0, X1M_VT = X1M_KET + 64 * LDTB, X1M_ONE = X1M_VT + 64 * LDV, X1M_EE = X1M_ONE + 16 * LDTB, X1M_END = X1M_EE + 256;
__device__ __forceinline__ void phase_ex1(int wv, KP Pk, int layer, LAS char* lds) {
    asm volatile("" : "+s"(Pk));
    const CAS Params& P = *Pk;
    const int tid = ltid(wv), lane = tid & 63, wid = tid >> 6, q = lane >> 4, r16 = lane & 15, i_ = layer >> 1;
    const bf16_t* XBC = (const bf16_t*)(P.ws + WS_EXBC); const bf16_t* QK = (const bf16_t*)(P.ws + WS_EQK); const bf16_t* Pb = (const bf16_t*)(P.ws + WS_P);
    const float* GT = (const float*)(P.ws + WS_EGT);
    {
        bf16_t* Hst = (bf16_t*)(P.ws + WS_XSS); float* Dst = (float*)(P.ws + WS_XSD);
        struct Set { u32x4 rc[2]; float rdt; }; Set SA, SB; SA.rdt = SB.rdt = 0.f;
        auto geom = [&](int it, int& b, int& h, int& dir, int& c) { const int sq = it / NCH64; c = it - sq * NCH64; b = sq >> 4; h = (sq >> 1) & 7; dir = sq & 1; };
        auto load = [&](int it, Set& S) {
            int b, h, dir, c; geom(it, b, h, dir, c);
            int tl = tid; asm volatile("" : "+v"(tl));
#pragma unroll
            for (int s = 0; s < 2; ++s) {
                const int task = tl + NT * s, j = task >> 4, g = task & 15;
                const int row = scan_row(c * CL + j, b, dir, 0);
                S.rc[s] = *(const u32x4*)(XBC + (size_t)row * 768 + (g < 8 ? h * 64 + 8 * g : 512 + (h >> 2) * 64 + 8 * (g - 8)));
            }
            if (tl < CL) { const int row = scan_row(c * CL + tl, b, dir, 0); S.rdt = GT[(size_t)row * 32 + dir * 8 + h]; }
        };
        auto item = [&](int it, Set& S, int nxt) {
            int b, h, dir, c; geom(it, b, h, dir, c);
            const float aco = -__expf(P.ssd_a_log[(i_ * 2 + dir) * 8 + h]);
            if (tid < CL) {
                const float cum = wave_cumsum(S.rdt * aco, lane);
                ((LAS float*)(lds + X1S_CUM))[tid] = cum; ((LAS float*)(lds + X1S_DTV))[tid] = S.rdt;
            }
            __syncthreads();
            {
                const LAS float* cum = (const LAS float*)(lds + X1S_CUM);
                const float cumL = cum[CL - 1];
                int tl = tid; asm volatile("" : "+v"(tl));
#pragma unroll
                for (int s = 0; s < 2; ++s) {
                    const int task = tl + NT * s, j = task >> 4, g = task & 15;
                    float f[8]; unpack8(S.rc[s], f);
                    if (g < 8) {
                        const float dt = ((const LAS float*)(lds + X1S_DTV))[j];
#pragma unroll
                        for (int e = 0; e < 8; ++e) f[e] *= dt;
                        *(LAS u32x4*)(lds + X1S_XT + j * LDTB + 16 * g) = pack8(f);
                    } else {
                        const float sc = __expf(cumL - cum[j]);
#pragma unroll
                        for (int e = 0; e < 8; ++e) f[e] *= sc;
                        *(LAS u32x4*)(lds + X1S_BDT + j * LDTB + 16 * (g - 8)) = pack8(f);
                    }
                }
                if (tid == 0) Dst[it] = __expf(cumL);
            }
            if (nxt < NSSD_ITEMS) load(nxt, S);
            __syncthreads();
            {
                const int pt = wid >> 1;
#pragma unroll
                for (int u = 0; u < 2; ++u) {
                    const int nt = (wid & 1) * 2 + u;
                    f32x4 sa = (f32x4){0.f, 0.f, 0.f, 0.f};
#pragma unroll
                    for (int k0 = 0; k0 < 64; k0 += 32) sa = __builtin_amdgcn_mfma_f32_16x16x32_bf16(ldfrag_tr(lds + X1S_BDT, LDTB, nt * 16, k0, lane), ldfrag_tr(lds + X1S_XT, LDTB, pt * 16, k0, lane), sa, 0, 0, 0);
                    u32x2 o; o.x = pk2(sa[0], sa[1]); o.y = pk2(sa[2], sa[3]);
                    *(u32x2*)(Hst + ((size_t)it * 64 + pt * 16 + r16) * 64 + nt * 16 + 4 * q) = o;
                }
            }
            __syncthreads();
        };
        {
            const int G = gridDim.x; int it = blockIdx.x;
            if (it < NSSD_ITEMS) load(it, SA);
            if (it + G < NSSD_ITEMS) load(it + G, SB);
            for (; it < NSSD_ITEMS; it += 2 * G) {
                item(it, SA, it + 2 * G);
                if (it + G < NSSD_ITEMS) item(it + G, SB, it + 3 * G);
            }
        }
    }
    {
        bf16_t* Cst = (bf16_t*)(P.ws + WS_XMC); float* Nst = (float*)(P.ws + WS_XMN); float* Sst = (float*)(P.ws + WS_XMS); float* Tst = (float*)(P.ws + WS_XMT);
        for (int i = tid; i < 16 * LDTB / 4; i += NT) ((LAS unsigned*)(lds + X1M_ONE))[i] = 0x3f803f80u;
        struct Set { u32x4 rc[3]; float rli, rlf; }; Set SA, SB; SA.rli = SA.rlf = SB.rli = SB.rlf = 0.f;
        auto geom = [&](int it, int& b, int& h, int& dir, int& c) { const int sq = it / NCH64; c = it - sq * NCH64; b = sq >> 3; h = (sq >> 1) & 3; dir = sq & 1; };
        auto load = [&](int it, Set& S) {
            int b, h, dir, c; geom(it, b, h, dir, c);
            int tl = tid; asm volatile("" : "+v"(tl));
#pragma unroll
            for (int s = 0; s < 3; ++s) {
                const int task = tl + NT * s, j = task / 24, g = task - 24 * j;
                const int row = scan_row(c * CL + j, b, dir, 0);
                S.rc[s] = g < 8 ? *(const u32x4*)(QK + (size_t)row * 512 + 256 + h * 64 + 8 * g) : *(const u32x4*)(Pb + (size_t)row * LDP_EVEN + 1808 + h * 128 + 8 * (g - 8));
            }
            if (tl < CL) { const int row = scan_row(c * CL + tl, b, dir, 0); S.rli = GT[(size_t)row * 32 + 16 + dir * 4 + h]; S.rlf = GT[(size_t)row * 32 + 24 + dir * 4 + h]; }
        };
        auto item = [&](int it, Set& S, int nxt) {
            if (tid < CL) {
                const float fcum = wave_cumsum(S.rlf, lane);
                const float ftot = __builtin_bit_cast(float, __builtin_amdgcn_readlane(__builtin_bit_cast(int, fcum), 63));
                const float g = S.rli - fcum, pm = wave_cummax(g, lane);
                const float wend = ftot + g, mloc = wave_max(wend);
                ((LAS float*)(lds + X1M_EE))[tid] = __expf(wend - mloc);
                float* tp = Tst + (size_t)it * 192;
                tp[tid] = fcum; tp[64 + tid] = g; tp[128 + tid] = pm;
                if (tid == 0) { Sst[(size_t)it * 4 + 0] = ftot; Sst[(size_t)it * 4 + 1] = mloc; }
            }
            __syncthreads();
            {
                const LAS float* ee = (const LAS float*)(lds + X1M_EE);
                int tl = tid; asm volatile("" : "+v"(tl));
#pragma unroll
                for (int s = 0; s < 3; ++s) {
                    const int task = tl + NT * s, j = task / 24, g = task - 24 * j;
                    if (g < 8) {
                        float f[8]; unpack8(S.rc[s], f);
                        const float e1 = ee[j];
#pragma unroll
                        for (int e = 0; e < 8; ++e) f[e] *= e1;
                        *(LAS u32x4*)(lds + X1M_KET + j * LDTB + 16 * g) = pack8(f);
                    } else {
                        const int v0 = 8 * (g - 8);
#pragma unroll
                        for (int e = 0; e < 1; ++e) *(LAS u32x4*)(lds + X1M_VT + j * LDV + v0 * 2) = S.rc[s];
                    }
                }
            }
            if (nxt < NML_ITEMS) load(nxt, S);
            __syncthreads();
            {
                const bf16x8 vf0 = ldfrag_tr(lds + X1M_VT, LDV, wid * 16, 0, lane), vf1 = ldfrag_tr(lds + X1M_VT, LDV, wid * 16, 32, lane);
#pragma unroll
                for (int kt = 0; kt < 4; ++kt) {
                    f32x4 sa = __builtin_amdgcn_mfma_f32_16x16x32_bf16(ldfrag_tr(lds + X1M_KET, LDTB, kt * 16, 0, lane), vf0, (f32x4){0.f, 0.f, 0.f, 0.f}, 0, 0, 0);
                    sa = __builtin_amdgcn_mfma_f32_16x16x32_bf16(ldfrag_tr(lds + X1M_KET, LDTB, kt * 16, 32, lane), vf1, sa, 0, 0, 0);
                    u32x2 o; o.x = pk2(sa[0], sa[1]); o.y = pk2(sa[2], sa[3]);
                    *(u32x2*)(Cst + ((size_t)it * 128 + wid * 16 + r16) * 64 + kt * 16 + 4 * q) = o;
                }
                if (wid < 4) {
                    f32x4 na = __builtin_amdgcn_mfma_f32_16x16x32_bf16(ldfrag_tr(lds + X1M_KET, LDTB, wid * 16, 0, lane), ldfrag(lds + X1M_ONE, LDTB, 0, 0, lane), (f32x4){0.f, 0.f, 0.f, 0.f}, 0, 0, 0);
                    na = __builtin_amdgcn_mfma_f32_16x16x32_bf16(ldfrag_tr(lds + X1M_KET, LDTB, wid * 16, 32, lane), ldfrag(lds + X1M_ONE, LDTB, 0, 32, lane), na, 0, 0, 0);
                    if (r16 == 0) *(f32x4*)(Nst + (size_t)it * 64 + wid * 16 + 4 * q) = na;
                }
            }
            __syncthreads();
        };
        {
            const int G = gridDim.x; int it = blockIdx.x;
            if (it < NML_ITEMS) load(it, SA);
            if (it + G < NML_ITEMS) load(it + G, SB);
            __syncthreads();
            for (; it < NML_ITEMS; it += 2 * G) {
                item(it, SA, it + 2 * G);
                if (it + G < NML_ITEMS) item(it + G, SB, it + 3 * G);
            }
        }
    }
}

constexpr int EX2_UB = 12;
static_assert(NCH64 % EX2_UB == 0, "EX2 batches");
__device__ __forceinline__ void phase_ex2(int wv, KP Pk, int layer) {
    asm volatile("" : "+s"(Pk));
    const CAS Params& P = *Pk;
    const int tid = ltid(wv);
    (void)layer;
    if (blockIdx.x < 128) {
        const int gt = blockIdx.x * NT + tid, sq = gt >> 10, rem = gt & 1023;
        bf16_t* Hst = (bf16_t*)(P.ws + WS_XSS) + (size_t)sq * NCH64 * 4096 + rem * 4;
        const float* Dst = (const float*)(P.ws + WS_XSD) + sq * NCH64;
        float h0 = 0.f, h1 = 0.f, h2 = 0.f, h3 = 0.f;
#pragma unroll 1
        for (int c0 = 0; c0 < NCH64; c0 += EX2_UB) {
            u32x2 loc[EX2_UB]; float dd[EX2_UB];
            bf16_t* hp = Hst + (size_t)c0 * 4096;
#pragma unroll
            for (int u = 0; u < EX2_UB; ++u) { loc[u] = *(const u32x2*)(hp + (size_t)u * 4096); dd[u] = Dst[c0 + u]; }
#pragma unroll
            for (int u = 0; u < EX2_UB; ++u) {
                u32x2 o; o.x = pk2(h0, h1); o.y = pk2(h2, h3);
                *(u32x2*)(hp + (size_t)u * 4096) = o;
                const float d = dd[u];
                h0 = d * h0 + bflo(loc[u].x); h1 = d * h1 + bfhi(loc[u].x); h2 = d * h2 + bflo(loc[u].y); h3 = d * h3 + bfhi(loc[u].y);
            }
        }
    } else if (blockIdx.x < 256) {
        const int gt = (blockIdx.x - 128) * NT + tid, sq = gt >> 11, rem = gt & 2047;
        bf16_t* Cst = (bf16_t*)(P.ws + WS_XMC) + (size_t)sq * NCH64 * 8192 + rem * 4;
        float* Nst = (float*)(P.ws + WS_XMN) + (size_t)sq * NCH64 * 64 + (rem & 15) * 4;
        float* Sst = (float*)(P.ws + WS_XMS) + (size_t)sq * NCH64 * 4;
        const bool own_n = rem < 16, own_m = rem == 0;
        float c0_ = 0.f, c1 = 0.f, c2 = 0.f, c3 = 0.f, m = -1e30f;
        f32x4 nn = (f32x4){0.f, 0.f, 0.f, 0.f};
#pragma unroll 1
        for (int cb = 0; cb < NCH64; cb += EX2_UB) {
            u32x2 loc[EX2_UB]; float ft[EX2_UB], ml[EX2_UB]; f32x4 nl[EX2_UB];
            bf16_t* cp = Cst + (size_t)cb * 8192; float* np = Nst + (size_t)cb * 64; float* sp_ = Sst + cb * 4;
#pragma unroll
            for (int u = 0; u < EX2_UB; ++u) {
                loc[u] = *(const u32x2*)(cp + (size_t)u * 8192); ft[u] = sp_[u * 4 + 0]; ml[u] = sp_[u * 4 + 1];
                nl[u] = (f32x4){0.f, 0.f, 0.f, 0.f};
                if (own_n) nl[u] = *(const f32x4*)(np + (size_t)u * 64);
            }
#pragma unroll
            for (int u = 0; u < EX2_UB; ++u) {
                const float ftot = ft[u], mloc = ml[u];
                const float mnew = fmaxf(ftot + m, mloc), sp = __expf(ftot + m - mnew), sl = __expf(mloc - mnew);
                u32x2 o; o.x = pk2(c0_, c1); o.y = pk2(c2, c3);
                *(u32x2*)(cp + (size_t)u * 8192) = o;
                c0_ = sp * c0_ + sl * bflo(loc[u].x); c1 = sp * c1 + sl * bfhi(loc[u].x); c2 = sp * c2 + sl * bflo(loc[u].y); c3 = sp * c3 + sl * bfhi(loc[u].y);
                if (own_n) { *(f32x4*)(np + (size_t)u * 64) = nn; nn = nn * sp + nl[u] * sl; }
                if (own_m) sp_[u * 4 + 2] = m;
                m = mnew;
            }
        }
    }
}

constexpr int X3S_BT = 0, X3S_CT = X3S_BT + 64 * LDTB, X3S_XT = X3S_CT + 64 * LDTB, X3S_HB = X3S_XT + 64 * LDTB, X3S_M = X3S_HB + 64 * LDTB, X3S_CUM = X3S_M + 64 * LDTB, X3S_DTV = X3S_CUM + 256, X3S_ROWS = X3S_DTV + 256, X3S_END = X3S_ROWS + 256;
constexpr int X3M_QT = 0, X3M_KT = X3M_QT + 64 * LDTB, X3M_VT = X3M_KT + 64 * LDTB, X3M_CB = X3M_VT + 64 * LDV, X3M_W = X3M_CB + 128 * LDTB, X3M_ONE = X3M_W + 64 * LDTB, X3M_NB = X3M_ONE + 16 * LDTB,
              X3M_SC = X3M_NB + 16 * LDTB, X3M_END = X3M_SC + 6 * 256;
static_assert(X3M_END <= LDS_BYTES - 16 && X3S_END <= LDS_BYTES - 16, "EX3 LDS maps");
__device__ __forceinline__ void phase_ex3(int wv, KP Pk, int layer, LAS char* lds) {
    asm volatile("" : "+s"(Pk));
    const CAS Params& P = *Pk;
    const int tid = ltid(wv), lane = tid & 63, wid = tid >> 6, q = lane >> 4, r16 = lane & 15, i_ = layer >> 1;
    const bf16_t* XBC = (const bf16_t*)(P.ws + WS_EXBC); const bf16_t* QK = (const bf16_t*)(P.ws + WS_EQK); const bf16_t* Pb = (const bf16_t*)(P.ws + WS_P);
    const float* GT = (const float*)(P.ws + WS_EGT);
    {
        const bf16_t* Hst = (const bf16_t*)(P.ws + WS_XSS);
        struct Set { u32x4 rc[3], rh; float rdt; int rrow; }; Set SA, SB; SA.rdt = SB.rdt = 0.f; SA.rrow = SB.rrow = 0;
        auto geom = [&](int it, int& b, int& h, int& dir, int& c) { const int sq = it / NCH64; c = it - sq * NCH64; b = sq >> 4; h = (sq >> 1) & 7; dir = sq & 1; };
        auto load = [&](int it, Set& S) {
            int b, h, dir, c; geom(it, b, h, dir, c);
            int tl = tid; asm volatile("" : "+v"(tl));
#pragma unroll
            for (int s = 0; s < 3; ++s) {
                const int task = tl + NT * s, j = task / 24, g = task - 24 * j;
                const int row = scan_row(c * CL + j, b, dir, 0);
                S.rc[s] = *(const u32x4*)(XBC + (size_t)row * 768 + (g < 8 ? h * 64 + 8 * g : g < 16 ? 512 + (h >> 2) * 64 + 8 * (g - 8) : 640 + (h >> 2) * 64 + 8 * (g - 16)));
            }
            S.rh = *(const u32x4*)(Hst + (size_t)it * 4096 + tl * 8);
            if (tl < CL) { S.rrow = scan_row(c * CL + tl, b, dir, 0); S.rdt = GT[(size_t)S.rrow * 32 + dir * 8 + h]; }
        };
        auto item = [&](int it, Set& S, int nxt) {
            int b, h, dir, c; geom(it, b, h, dir, c);
            bf16_t* Y = (bf16_t*)(P.ws + (dir ? WS_YB : WS_YF));
            const float aco = -__expf(P.ssd_a_log[(i_ * 2 + dir) * 8 + h]);
            if (tid < CL) {
                const float cum = wave_cumsum(S.rdt * aco, lane);
                ((LAS float*)(lds + X3S_CUM))[tid] = cum; ((LAS float*)(lds + X3S_DTV))[tid] = S.rdt; ((LAS int*)(lds + X3S_ROWS))[tid] = S.rrow;
            }
            __syncthreads();
            {
                int tl = tid; asm volatile("" : "+v"(tl));
#pragma unroll
                for (int s = 0; s < 3; ++s) {
                    const int task = tl + NT * s, j = task / 24, g = task - 24 * j;
                    if (g < 8) {
                        float f[8]; unpack8(S.rc[s], f);
                        const float dt = ((const LAS float*)(lds + X3S_DTV))[j];
#pragma unroll
                        for (int e = 0; e < 8; ++e) f[e] *= dt;
                        *(LAS u32x4*)(lds + X3S_XT + j * LDTB + 16 * g) = pack8(f);
                    } else if (g < 16) *(LAS u32x4*)(lds + X3S_BT + j * LDTB + 8 * (g - 8) * 2) = S.rc[s];
                    else *(LAS u32x4*)(lds + X3S_CT + j * LDTB + 8 * (g - 16) * 2) = S.rc[s];
                }
                *(LAS u32x4*)(lds + X3S_HB + (tl >> 3) * LDTB + (tl & 7) * 16) = S.rh;
            }
            if (nxt < NSSD_ITEMS) load(nxt, S);
            __syncthreads();
            const LAS float* cum = (const LAS float*)(lds + X3S_CUM);
            {
                const int lt = wid >> 1;
#pragma unroll
                for (int u = 0; u < 2; ++u) {
                    const int st = (wid & 1) * 2 + u;
                    f32x4 acc = (f32x4){0.f, 0.f, 0.f, 0.f};
                    if (st <= lt) {
#pragma unroll
                        for (int k0 = 0; k0 < 64; k0 += 32) acc = __builtin_amdgcn_mfma_f32_16x16x32_bf16(ldfrag(lds + X3S_BT, LDTB, st * 16, k0, lane), ldfrag(lds + X3S_CT, LDTB, lt * 16, k0, lane), acc, 0, 0, 0);
                        const int l = lt * 16 + r16, s0 = st * 16 + 4 * q;
                        const float cl = cum[l]; const f32x4 cs = *(const LAS f32x4*)(cum + s0);
#pragma unroll
                        for (int j = 0; j < 4; ++j) acc[j] = (s0 + j <= l) ? acc[j] * __expf(cl - cs[j]) : 0.f;
                    }
                    st4bf(lds + X3S_M + (lt * 16 + r16) * LDTB + (st * 16 + 4 * q) * 2, acc);
                }
            }
            __syncthreads();
            {
                const int lt = wid >> 1, l = lt * 16 + r16;
                const float el = __expf(cum[l]);
                const int row = ((const LAS int*)(lds + X3S_ROWS))[l];
                const bf16x8 mf0 = ldfrag(lds + X3S_M, LDTB, lt * 16, 0, lane), mf1 = ldfrag(lds + X3S_M, LDTB, lt * 16, 32, lane);
                const bf16x8 cf0 = ldfrag(lds + X3S_CT, LDTB, lt * 16, 0, lane), cf1 = ldfrag(lds + X3S_CT, LDTB, lt * 16, 32, lane);
#pragma unroll
                for (int u = 0; u < 2; ++u) {
                    const int pt = (wid & 1) * 2 + u;
                    f32x4 ya = __builtin_amdgcn_mfma_f32_16x16x32_bf16(ldfrag_tr(lds + X3S_XT, LDTB, pt * 16, 0, lane), mf0, (f32x4){0.f, 0.f, 0.f, 0.f}, 0, 0, 0);
                    ya = __builtin_amdgcn_mfma_f32_16x16x32_bf16(ldfrag_tr(lds + X3S_XT, LDTB, pt * 16, 32, lane), mf1, ya, 0, 0, 0);
                    f32x4 oa = __builtin_amdgcn_mfma_f32_16x16x32_bf16(ldfrag(lds + X3S_HB, LDTB, pt * 16, 0, lane), cf0, (f32x4){0.f, 0.f, 0.f, 0.f}, 0, 0, 0);
                    oa = __builtin_amdgcn_mfma_f32_16x16x32_bf16(ldfrag(lds + X3S_HB, LDTB, pt * 16, 32, lane), cf1, oa, 0, 0, 0);
                    u32x2 o; o.x = pk2(ya[0] + el * oa[0], ya[1] + el * oa[1]); o.y = pk2(ya[2] + el * oa[2], ya[3] + el * oa[3]);
                    *(u32x2*)(Y + (size_t)row * D + h * 64 + pt * 16 + 4 * q) = o;
                }
            }
            __syncthreads();
        };
        {
            const int G = gridDim.x; int it = blockIdx.x;
            if (it < NSSD_ITEMS) load(it, SA);
            if (it + G < NSSD_ITEMS) load(it + G, SB);
            __syncthreads();
            for (; it < NSSD_ITEMS; it += 2 * G) {
                item(it, SA, it + 2 * G);
                if (it + G < NSSD_ITEMS) item(it + G, SB, it + 3 * G);
            }
        }
    }
    {
        const bf16_t* Cst = (const bf16_t*)(P.ws + WS_XMC); const float* Nst = (const float*)(P.ws + WS_XMN); const float* Sst = (const float*)(P.ws + WS_XMS); const float* Tst = (const float*)(P.ws + WS_XMT);
        for (int i = tid; i < 16 * LDTB / 4; i += NT) ((LAS unsigned*)(lds + X3M_ONE))[i] = 0x3f803f80u;
        struct Set { u32x4 rc[4], rcb[2]; float rfc, rg, rpm, rmp, rn; int rrow; }; Set SA, SB; SA.rfc = SA.rg = SA.rpm = SA.rmp = SA.rn = SB.rfc = SB.rg = SB.rpm = SB.rmp = SB.rn = 0.f; SA.rrow = SB.rrow = 0;
        auto geom = [&](int it, int& b, int& h, int& dir, int& c) { const int sq = it / NCH64; c = it - sq * NCH64; b = sq >> 3; h = (sq >> 1) & 3; dir = sq & 1; };
        auto load = [&](int it, Set& S) {
            int b, h, dir, c; geom(it, b, h, dir, c);
            int tl = tid; asm volatile("" : "+v"(tl));
#pragma unroll
            for (int s = 0; s < 4; ++s) {
                const int task = tl + NT * s, j = task >> 5, g = task & 31;
                const int row = scan_row(c * CL + j, b, dir, 0);
                S.rc[s] = g < 16 ? *(const u32x4*)(QK + (size_t)row * 512 + (g < 8 ? h * 64 + 8 * g : 256 + h * 64 + 8 * (g - 8))) : *(const u32x4*)(Pb + (size_t)row * LDP_EVEN + 1808 + h * 128 + 8 * (g - 16));
            }
#pragma unroll
            for (int s = 0; s < 2; ++s) S.rcb[s] = *(const u32x4*)(Cst + (size_t)it * 8192 + (tl + NT * s) * 8);
            if (tl < CL) {
                S.rrow = scan_row(c * CL + tl, b, dir, 0);
                const float* tp = Tst + (size_t)it * 192;
                S.rfc = tp[tl]; S.rg = tp[64 + tl]; S.rpm = tp[128 + tl]; S.rmp = Sst[(size_t)it * 4 + 2]; S.rn = Nst[(size_t)it * 64 + tl];
            }
        };
        auto item = [&](int it, Set& S, int nxt) {
            int b, h, dir, c; geom(it, b, h, dir, c);
            bf16_t* Y = (bf16_t*)(P.ws + (dir ? WS_YB : WS_YF));
            LAS float* sc = (LAS float*)(lds + X3M_SC);
            {
                int tl = tid; asm volatile("" : "+v"(tl));
#pragma unroll
                for (int s = 0; s < 4; ++s) {
                    const int task = tl + NT * s, j = task >> 5, g = task & 31;
                    if (g < 8) *(LAS u32x4*)(lds + X3M_QT + j * LDTB + 8 * g * 2) = S.rc[s];
                    else if (g < 16) *(LAS u32x4*)(lds + X3M_KT + j * LDTB + 8 * (g - 8) * 2) = S.rc[s];
                    else {
                        const int v0 = 8 * (g - 16);
#pragma unroll
                        for (int e = 0; e < 1; ++e) *(LAS u32x4*)(lds + X3M_VT + j * LDV + v0 * 2) = S.rc[s];
                    }
                }
#pragma unroll
                for (int s = 0; s < 2; ++s) { const int ch = tl + NT * s; *(LAS u32x4*)(lds + X3M_CB + (ch >> 3) * LDTB + (ch & 7) * 16) = S.rcb[s]; }
                if (tl < CL) {
                    const float linter = S.rfc + S.rmp, mrow = fmaxf(S.rfc + S.rpm, linter);
                    sc[tl] = S.rfc - mrow; sc[64 + tl] = S.rg; sc[128 + tl] = __expf(linter - mrow); sc[192 + tl] = __expf(-mrow); ((LAS int*)sc)[256 + tl] = S.rrow;
                    const bf16_t nb = f2bf(S.rn);
#pragma unroll
                    for (int r = 0; r < 16; ++r) *(LAS bf16_t*)(lds + X3M_NB + r * LDTB + tl * 2) = nb;
                }
            }
            if (nxt < NML_ITEMS) load(nxt, S);
            __syncthreads();
            {
                const int lt = wid >> 1;
#pragma unroll
                for (int u = 0; u < 2; ++u) {
                    const int st = (wid & 1) * 2 + u;
                    f32x4 acc = (f32x4){0.f, 0.f, 0.f, 0.f};
                    if (st <= lt) {
#pragma unroll
                        for (int k0 = 0; k0 < 64; k0 += 32) acc = __builtin_amdgcn_mfma_f32_16x16x32_bf16(ldfrag(lds + X3M_KT, LDTB, st * 16, k0, lane), ldfrag(lds + X3M_QT, LDTB, lt * 16, k0, lane), acc, 0, 0, 0);
                        const int l = lt * 16 + r16, s0 = st * 16 + 4 * q;
                        const float rt = sc[l]; const f32x4 gs = *(const LAS f32x4*)(sc + 64 + s0);
#pragma unroll
                        for (int j = 0; j < 4; ++j) acc[j] = (s0 + j <= l) ? acc[j] * __expf(rt + gs[j]) : 0.f;
                    }
                    st4bf(lds + X3M_W + (lt * 16 + r16) * LDTB + (st * 16 + 4 * q) * 2, acc);
                }
            }
            __syncthreads();
            {
                const int lt = wid >> 1, l = lt * 16 + r16;
                const bf16x8 wf0 = ldfrag(lds + X3M_W, LDTB, lt * 16, 0, lane), wf1 = ldfrag(lds + X3M_W, LDTB, lt * 16, 32, lane);
                const bf16x8 qf0 = ldfrag(lds + X3M_QT, LDTB, lt * 16, 0, lane), qf1 = ldfrag(lds + X3M_QT, LDTB, lt * 16, 32, lane);
                f32x4 da = __builtin_amdgcn_mfma_f32_16x16x32_bf16(ldfrag(lds + X3M_ONE, LDTB, 0, 0, lane), wf0, (f32x4){0.f, 0.f, 0.f, 0.f}, 0, 0, 0);
                da = __builtin_amdgcn_mfma_f32_16x16x32_bf16(ldfrag(lds + X3M_ONE, LDTB, 0, 32, lane), wf1, da, 0, 0, 0);
                f32x4 qn = __builtin_amdgcn_mfma_f32_16x16x32_bf16(ldfrag(lds + X3M_NB, LDTB, 0, 0, lane), qf0, (f32x4){0.f, 0.f, 0.f, 0.f}, 0, 0, 0);
                qn = __builtin_amdgcn_mfma_f32_16x16x32_bf16(ldfrag(lds + X3M_NB, LDTB, 0, 32, lane), qf1, qn, 0, 0, 0);
                const float inter = sc[128 + l], emr = sc[192 + l];
                const float inv = __builtin_amdgcn_rcpf(fmaxf(fabsf(da[0] + inter * qn[0]), emr));
                const int row = ((const LAS int*)sc)[256 + l];
#pragma unroll
                for (int u = 0; u < 4; ++u) {
                    const int vt = (wid & 1) * 4 + u;
                    f32x4 na = __builtin_amdgcn_mfma_f32_16x16x32_bf16(ldfrag_tr(lds + X3M_VT, LDV, vt * 16, 0, lane), wf0, (f32x4){0.f, 0.f, 0.f, 0.f}, 0, 0, 0);
                    na = __builtin_amdgcn_mfma_f32_16x16x32_bf16(ldfrag_tr(lds + X3M_VT, LDV, vt * 16, 32, lane), wf1, na, 0, 0, 0);
                    f32x4 ca = __builtin_amdgcn_mfma_f32_16x16x32_bf16(ldfrag(lds + X3M_CB, LDTB, vt * 16, 0, lane), qf0, (f32x4){0.f, 0.f, 0.f, 0.f}, 0, 0, 0);
                    ca = __builtin_amdgcn_mfma_f32_16x16x32_bf16(ldfrag(lds + X3M_CB, LDTB, vt * 16, 32, lane), qf1, ca, 0, 0, 0);
                    u32x2 o; o.x = pk2((na[0] + inter * ca[0]) * inv, (na[1] + inter * ca[1]) * inv); o.y = pk2((na[2] + inter * ca[2]) * inv, (na[3] + inter * ca[3]) * inv);
                    *(u32x2*)(Y + (size_t)row * D + 512 + h * 128 + vt * 16 + 4 * q) = o;
                }
            }
            __syncthreads();
        };
        {
            const int G = gridDim.x; int it = blockIdx.x;
            if (it < NML_ITEMS) load(it, SA);
            if (it + G < NML_ITEMS) load(it + G, SB);
            __syncthreads();
            for (; it < NML_ITEMS; it += 2 * G) {
                item(it, SA, it + 2 * G);
                if (it + G < NML_ITEMS) item(it + G, SB, it + 3 * G);
            }
        }
    }
}

constexpr int HC_RAWF = 0;
constexpr int HC_RAWQ = HC_RAWF + 64 * 128 * 4;
constexpr int HC_SUB = HC_RAWQ + 64 * 128 * 2;
constexpr int HL_QD = 136 * 2;
constexpr int HL_T = 24 * 2;
constexpr int HS_QI = 0, HS_KO = HS_QI + 16 * HL_QD, HS_KET = HS_KO + 16 * HL_QD, HS_ATT = HS_KET + 128 * HL_T, HS_VT = HS_ATT + 16 * HL_T, HS_DEC = HS_VT + 32 * HL_T, HS_SIZE = HS_DEC + 512;
constexpr int HC_SB = HC_SUB + 4 * HS_SIZE;
constexpr int HC_ROWS = HC_SB + 2 * 32 * HL_QD, HC_CST = HC_ROWS + 256, HC_END = HC_CST + 1024;
static_assert(HC_END <= LDS_BYTES - 16, "HGRN2 LDS map");
static_assert(HS_SIZE % 16 == 0 && HC_SB % 16 == 0, "alignment");
__device__ __forceinline__ bf16x8 ldfrag16(const LAS char* tile, int ldb, int row0, int lane) {
    bf16x8 v = *(const LAS bf16x8*)(tile + (row0 + (lane & 15)) * ldb + ((lane >> 4) & 1) * 16);
    if (lane >= 32) v = (bf16x8){0, 0, 0, 0, 0, 0, 0, 0};
    return v;
}
__device__ __forceinline__ void scan_hgrn_c(int wv, KP Pk, int layer, int unit, LAS char* lds) {
    asm volatile("" : "+s"(Pk));
    const CAS Params& P = *Pk;
    const int tid = ltid(wv), lane = tid & 63, wid = tid >> 6, q = lane >> 4, r16 = lane & 15, i_ = layer >> 1;
    const int seq = unit >> 2, quarter = unit & 3, b = seq >> 3, h = (seq >> 1) & 3, dir = seq & 1;
    const bf16_t* Pb = (const bf16_t*)(P.ws + WS_P);
    bf16_t* Y = (bf16_t*)(P.ws + (dir ? WS_YB : WS_YF));
    LAS float* cst = (LAS float*)(lds + HC_CST);
    if (tid < 128) cst[tid] = ((const float*)(P.ws + WS_LB))[layer * 512 + h * 128 + tid];
    else if (tid < 256) cst[tid] = P.hg_f_bias[(size_t)(i_ * 2 + dir) * 512 + h * 128 + tid - 128];
    for (int i = tid; i < 2 * 32 * HL_QD / 4; i += NT) ((LAS unsigned*)(lds + HC_SB))[i] = 0u;
    int tj[5], tg_[5], tcol[5]; bool tv[5];
#pragma unroll
    for (int s = 0; s < 5; ++s) {
        const int task = tid + NT * s; tv[s] = task < 64 * 36; tj[s] = task / 36; tg_[s] = task % 36;
        const int g = tg_[s];
        tcol[s] = g < 16 ? (512 + dir * 512 + h * 128 + 8 * g) : g < 32 ? (h * 128 + 8 * (g - 16)) : (1536 + h * 128 + quarter * 32 + 8 * (g - 32));
    }
    u32x4 rc[5]; int rrow = 0;
    auto load = [&](int c) {
#pragma unroll
        for (int s = 0; s < 5; ++s) {
            rc[s] = (u32x4){0u, 0u, 0u, 0u};
            if (tv[s]) { const int row = scan_row(c * 64 + tj[s], b, dir, 1); rc[s] = *(const u32x4*)(Pb + (size_t)row * LDP_ODD + tcol[s]); }
        }
        if (tid < 64) rrow = scan_row(c * 64 + tid, b, dir, 1);
    };
    auto storeA = [&]() {
#pragma unroll
        for (int s = 0; s < 5; ++s) {
            if (tv[s]) {
                float f[8]; unpack8(rc[s], f);
                const int j = tj[s], g = tg_[s];
                if (g < 16) {
                    float o[8];
#pragma unroll
                    for (int e = 0; e < 8; ++e) { const float lbv = cst[8 * g + e]; o[e] = lbv + (1.f - lbv) * sigmoidf_(f[e] + cst[128 + 8 * g + e]); }
                    LAS float* dst = (LAS float*)(lds + HC_RAWF) + j * 128 + 8 * g;
                    *(LAS f32x4*)dst = (f32x4){o[0], o[1], o[2], o[3]}; *(LAS f32x4*)(dst + 4) = (f32x4){o[4], o[5], o[6], o[7]};
                } else if (g < 32) {
                    float o[8];
#pragma unroll
                    for (int e = 0; e < 8; ++e) o[e] = siluf_(f[e]);
                    *(LAS u32x4*)(lds + HC_RAWQ + (j * 128 + 8 * (g - 16)) * 2) = pack8(o);
                } else {
                    const int v0 = 8 * (g - 32);
                    LAS char* vt = lds + HC_SUB + (j >> 4) * HS_SIZE + HS_VT;
#pragma unroll
                    for (int e = 0; e < 8; ++e) { const unsigned wv = rc[s][e >> 1]; *(LAS bf16_t*)(vt + (v0 + e) * HL_T + (j & 15) * 2) = (bf16_t)((e & 1) ? (wv >> 16) : (wv & 0xffffu)); }
                }
            }
        }
        if (tid < 64) ((LAS int*)(lds + HC_ROWS))[tid] = rrow;
    };
    auto storeB = [&]() {
        const int d = tid & 127, sb = tid >> 7;
        LAS char* st = lds + HC_SUB + sb * HS_SIZE;
        const LAS float* rf = (const LAS float*)(lds + HC_RAWF) + (sb * 16) * 128 + d;
        const LAS bf16_t* rq = (const LAS bf16_t*)(lds + HC_RAWQ) + (sb * 16) * 128 + d;
        float lam = 0.f, lams[16], kfs[16];
#pragma unroll
        for (int t = 0; t < 16; ++t) {
            const float f = rf[t * 128];
            lam += __logf(f);
            const float kf = 1.f - f;
            lams[t] = lam; kfs[t] = kf;
            *(LAS bf16_t*)(st + HS_QI + t * HL_QD + d * 2) = f2bf(bf2f(rq[t * 128]) * __expf(lam));
            *(LAS bf16_t*)(st + HS_KO + t * HL_QD + d * 2) = f2bf(kf * __expf(-lam));
        }
        float ke[16];
#pragma unroll
        for (int t = 0; t < 16; ++t) ke[t] = kfs[t] * __expf(lam - lams[t]);
        *(LAS u32x4*)(st + HS_KET + d * HL_T) = pack8(ke); *(LAS u32x4*)(st + HS_KET + d * HL_T + 16) = pack8(ke + 8);
        ((LAS float*)(st + HS_DEC))[d] = __expf(lam);
    };
    f32x4 sacc[2];
    sacc[0] = sacc[1] = (f32x4){0.f, 0.f, 0.f, 0.f};
    __syncthreads();
    load(0);
    for (int c = 0; c < NSTEPS / 64; ++c) {
        storeA();
        __syncthreads();
        storeB();
        if (c + 1 < NSTEPS / 64) load(c + 1);
        __syncthreads();
        if (wid < 4) {
            LAS char* st = lds + HC_SUB + wid * HS_SIZE;
            f32x4 acc = (f32x4){0.f, 0.f, 0.f, 0.f};
#pragma unroll
            for (int k0 = 0; k0 < 128; k0 += 32) acc = __builtin_amdgcn_mfma_f32_16x16x32_bf16(ldfrag(st + HS_KO, HL_QD, 0, k0, lane), ldfrag(st + HS_QI, HL_QD, 0, k0, lane), acc, 0, 0, 0);
#pragma unroll
            for (int j = 0; j < 4; ++j) acc[j] = (4 * q + j <= r16) ? acc[j] : 0.f;
            st4bf(st + HS_ATT + r16 * HL_T + 4 * q * 2, acc);
        }
        __syncthreads();
#pragma unroll 1
        for (int sb = 0; sb < 4; ++sb) {
            LAS char* st = lds + HC_SUB + sb * HS_SIZE;
            const LAS char* sbr = lds + HC_SB + (sb & 1) * 32 * HL_QD;
            LAS char* sbw = lds + HC_SB + ((sb + 1) & 1) * 32 * HL_QD;
            if (wid < 2) {
                f32x4 ya = __builtin_amdgcn_mfma_f32_16x16x32_bf16(ldfrag16(st + HS_VT, HL_T, wid * 16, lane), ldfrag16(st + HS_ATT, HL_T, 0, lane), (f32x4){0.f, 0.f, 0.f, 0.f}, 0, 0, 0);
#pragma unroll
                for (int k0 = 0; k0 < 128; k0 += 32) ya = __builtin_amdgcn_mfma_f32_16x16x32_bf16(ldfrag(sbr, HL_QD, wid * 16, k0, lane), ldfrag(st + HS_QI, HL_QD, 0, k0, lane), ya, 0, 0, 0);
                const int row = ((const LAS int*)(lds + HC_ROWS))[sb * 16 + r16];
                u32x2 o; o.x = pk2(ya[0], ya[1]); o.y = pk2(ya[2], ya[3]);
                *(u32x2*)(Y + (size_t)row * D + h * 128 + quarter * 32 + wid * 16 + 4 * q) = o;
            }
            {
                const int vt = wid >> 2;
                const bf16x8 vf = ldfrag16(st + HS_VT, HL_T, vt * 16, lane);
#pragma unroll
                for (int u = 0; u < 2; ++u) {
                    const int dt = (wid & 3) * 2 + u;
                    const f32x4 a = __builtin_amdgcn_mfma_f32_16x16x32_bf16(ldfrag16(st + HS_KET, HL_T, dt * 16, lane), vf, (f32x4){0.f, 0.f, 0.f, 0.f}, 0, 0, 0);
                    const f32x4 dc = *(const LAS f32x4*)((const LAS float*)(st + HS_DEC) + dt * 16 + 4 * q);
#pragma unroll
                    for (int j = 0; j < 4; ++j) sacc[u][j] = sacc[u][j] * dc[j] + a[j];
                    st4bf(sbw + (vt * 16 + r16) * HL_QD + (dt * 16 + 4 * q) * 2, sacc[u]);
                }
            }
            __syncthreads();
        }
    }
}

constexpr int RC_RAWW = 0;
constexpr int RC_RAWA = RC_RAWW + 64 * 64 * 4;
constexpr int RC_RAWB = RC_RAWA + 64 * 64 * 2, RC_RAWK = RC_RAWB + 64 * 64 * 2, RC_RAWR = RC_RAWK + 64 * 64 * 2;
constexpr int RC_SUB = RC_RAWR + 64 * 64 * 2;
constexpr int RL_C = 72 * 2, RL_32 = 40 * 2, RL_16 = 24 * 2;
constexpr int RS_AT = 0, RS_RT = RS_AT + 16 * RL_C, RS_KT = RS_RT + 16 * RL_C, RS_BT = RS_KT + 16 * RL_C, RS_KBH = RS_BT + 16 * RL_C, RS_AAK = RS_KBH + 64 * RL_32,
              RS_ARKB = RS_AAK + 16 * RL_16, RS_T = RS_ARKB + 16 * RL_32, RS_AABF = RS_T + 16 * RL_16, RS_GL = RS_AABF + 16 * 16 * 4, RS_VU = RS_GL + 256, RS_SIZE = RS_VU + 32 * RL_32;
constexpr int RC_SB = RC_SUB + 4 * RS_SIZE;
constexpr int RC_RHT = RC_SB + 32 * RL_C;
constexpr int RC_ROWS = RC_RHT + 32 * RL_16, RC_END = RC_ROWS + 256;
static_assert(RC_END <= LDS_BYTES - 16, "RWKV LDS map");
static_assert(RS_SIZE % 16 == 0 && RC_SB % 16 == 0 && RC_RHT % 16 == 0, "alignment");

__device__ __forceinline__ float allreduce8(float v) {
    v += dppmov<0xB1>(v); v += dppmov<0x4E>(v); v += dppmov<0x141>(v);
    return v;
}

__device__ __forceinline__ void phase_prep1(int wv, KP Pk, int layer) {
    asm volatile("" : "+s"(Pk));
    const CAS Params& P = *Pk;
    const int tid = ltid(wv), lane = tid & 63, wid = tid >> 6, i_ = layer >> 1;
    const bf16_t* Pb = (const bf16_t*)(P.ws + WS_P);
    bf16_t* R = (bf16_t*)(P.ws + WS_RWR); bf16_t* K = (bf16_t*)(P.ws + WS_RWK); bf16_t* V = (bf16_t*)(P.ws + WS_RWV); bf16_t* KK = (bf16_t*)(P.ws + WS_RWKK);
    bf16_t* LA = (bf16_t*)(P.ws + WS_LA);
    const float* mu = P.rw_mu + (size_t)i_ * 1856;
    float mur[8], muv[8], muk[8], mul_[8], kkw[8];
#pragma unroll
    for (int e = 0; e < 8; ++e) { mur[e] = mu[8 * lane + e]; muv[e] = mu[1024 + 8 * lane + e]; muk[e] = mu[512 + 8 * lane + e]; mul_[e] = lane < 40 ? mu[1536 + 8 * lane + e] : 0.f; kkw[e] = P.rw_k_k[i_ * 512 + 8 * lane + e]; }
    u32x4 nq[4][3]; float nmp = 0.f, nmn = 0.f;
    auto fetch = [&](int r) {
        int rprev = -1, rnext = -1;
        if (r < NCTX) { const int t = r & 255; if (t > 0) rprev = r - 1; if (t < CTXL - 1) rnext = r + 1; }
        else {
            const int bs = (r - NCTX) >> 13, s = (r - NCTX) & 8191, sg = ((s & 63) << 7) + (s >> 6);
            if (sg > 0) { const int g2 = sg - 1; rprev = NCTX + bs * SEQ + ((g2 & 127) << 6) + (g2 >> 7); }
            if (sg < SEQ - 1) { const int g2 = sg + 1; rnext = NCTX + bs * SEQ + ((g2 & 127) << 6) + (g2 >> 7); }
        }
        const bf16_t* pc = Pb + (size_t)r * LDP_ODD + 2560;
        const bf16_t* pp = Pb + (size_t)(rprev < 0 ? r : rprev) * LDP_ODD + 2560;
        const bf16_t* pn = Pb + (size_t)(rnext < 0 ? r : rnext) * LDP_ODD + 2560;
        nmp = rprev < 0 ? 0.f : 0.5f; nmn = rnext < 0 ? 0.f : 0.5f;
#pragma unroll
        for (int gq = 0; gq < 4; ++gq) {
            const int col = (gq == 0 ? 0 : gq == 1 ? 1024 : gq == 2 ? 512 : 1536) + 8 * lane;
            if (gq < 3 || lane < 40) { nq[gq][0] = *(const u32x4*)(pc + col); nq[gq][1] = *(const u32x4*)(pp + col); nq[gq][2] = *(const u32x4*)(pn + col); }
        }
    };
    nq[3][0] = nq[3][1] = nq[3][2] = (u32x4){0u, 0u, 0u, 0u};
    const int stride = gridDim.x * 8;
    int r = blockIdx.x * 8 + wid;
    if (r < NROWS) fetch(r);
    for (; r < NROWS; r += stride) {
        u32x4 cq[4][3];
#pragma unroll
        for (int gq = 0; gq < 4; ++gq)
#pragma unroll
            for (int k = 0; k < 3; ++k) cq[gq][k] = nq[gq][k];
        const float mp = nmp, mn = nmn;
        if (r + stride < NROWS) fetch(r + stride);
        auto mix8 = [&](const u32x4 (&c)[3], const float* muc, float* o) {
            float fc[8], fp[8], fn[8];
            unpack8(c[0], fc); unpack8(c[1], fp); unpack8(c[2], fn);
#pragma unroll
            for (int e = 0; e < 8; ++e) o[e] = fc[e] + muc[e] * (mp * fp[e] + mn * fn[e] - fc[e]);
        };
        float o[8];
        mix8(cq[0], mur, o); *(u32x4*)(R + (size_t)r * 512 + 8 * lane) = pack8(o);
        mix8(cq[1], muv, o); *(u32x4*)(V + (size_t)r * 512 + 8 * lane) = pack8(o);
        mix8(cq[2], muk, o); *(u32x4*)(K + (size_t)r * 512 + 8 * lane) = pack8(o);
        {
            float kk[8], ss = 0.f;
#pragma unroll
            for (int e = 0; e < 8; ++e) { kk[e] = o[e] * kkw[e]; ss += kk[e] * kk[e]; }
            ss = group_sum<8>(ss);
            const float rn = rsqrtf(fmaxf(ss, 1e-12f));
#pragma unroll
            for (int e = 0; e < 8; ++e) kk[e] *= rn;
            *(u32x4*)(KK + (size_t)r * 512 + 8 * lane) = pack8(kk);
        }
        if (lane < 40) {
            mix8(cq[3], mul_, o);
            if (lane < 16) {
#pragma unroll
                for (int e = 0; e < 8; ++e) o[e] = tanh_fast(o[e]);
            } else if (lane >= 24) {
#pragma unroll
                for (int e = 0; e < 8; ++e) o[e] = sigmoidf_(o[e]);
            }
            *(u32x4*)(LA + (size_t)r * 320 + 8 * lane) = pack8(o);
        }
    }
}

__device__ __forceinline__ void phase_out_even(int wv, KP Pk, int layer) {
    asm volatile("" : "+s"(Pk));
    const CAS Params& P = *Pk;
    const int tid = ltid(wv), lane = tid & 63, wid = tid >> 6, i_ = layer >> 1;
    const bf16_t* Pb = (const bf16_t*)(P.ws + WS_P);
    const bf16_t* Yf = (const bf16_t*)(P.ws + WS_YF); const bf16_t* Yb = (const bf16_t*)(P.ws + WS_YB);
    bf16_t* feat = (bf16_t*)(P.ws + WS_FEAT);
    const int r0 = (layer == DEPTH - 1) ? NCTX : 0;
    const bf16_t* XBC = (const bf16_t*)(P.ws + WS_EXBC);
    float nwa[8], nwb[8];
#pragma unroll
    for (int e = 0; e < 8; ++e) { nwa[e] = P.ssd_norm_w[i_ * 512 + 8 * lane + e]; nwb[e] = P.ml_norm_w[i_ * 512 + 8 * lane + e]; }
    const float dsk = P.ssd_d[i_ * 8 + (lane >> 3)];
    u32x4 n0, n1, n2, n3, n4, n5, n6;
    auto fetch = [&](int rr) {
        const bf16_t* pr = Pb + (size_t)rr * LDP_EVEN;
        n0 = *(const u32x4*)(Yf + (size_t)rr * D + 8 * lane); n1 = *(const u32x4*)(Yb + (size_t)rr * D + 8 * lane);
        n2 = *(const u32x4*)(XBC + (size_t)rr * 768 + 8 * lane); n3 = *(const u32x4*)(pr + 8 * lane);
        n4 = *(const u32x4*)(Yf + (size_t)rr * D + 512 + 8 * lane); n5 = *(const u32x4*)(Yb + (size_t)rr * D + 512 + 8 * lane); n6 = *(const u32x4*)(pr + 2320 + 8 * lane);
    };
    const int stride = gridDim.x * 8;
    int r = r0 + blockIdx.x * 8 + wid;
    if (r < NROWS) fetch(r);
    for (; r < NROWS; r += stride) {
        const u32x4 c0 = n0, c1 = n1, c2 = n2, c3 = n3, c4 = n4, c5 = n5, c6 = n6;
        if (r + stride < NROWS) fetch(r + stride);
        float y[8];
        {
            float a[8], bb[8], xsv[8], z[8];
            unpack8(c0, a); unpack8(c1, bb);
            unpack8(c2, xsv); unpack8(c3, z);
            float ss = 0.f;
#pragma unroll
            for (int e = 0; e < 8; ++e) {
                y[e] = (a[e] + bb[e] + dsk * xsv[e]) * siluf_(z[e]); ss += y[e] * y[e];
            }
            ss = wave_sum(ss);
            const float rn = rsqrtf(ss * (1.f / 512.f) + 1e-6f);
#pragma unroll
            for (int e = 0; e < 8; ++e) y[e] = y[e] * rn * nwa[e];
            *(u32x4*)(feat + (size_t)r * D + 8 * lane) = pack8(y);
        }
        {
            float a[8], bb[8], o[8];
            unpack8(c4, a); unpack8(c5, bb);
            unpack8(c6, o);
            float s = 0.f;
#pragma unroll
            for (int e = 0; e < 8; ++e) { y[e] = a[e] + bb[e]; s += y[e]; }
            const float mean = group_sum<16>(s) * (1.f / 128.f);
            float ss = 0.f;
#pragma unroll
            for (int e = 0; e < 8; ++e) { y[e] -= mean; ss += y[e] * y[e]; }
            const float rn = rsqrtf(group_sum<16>(ss) * (1.f / 128.f) + 1e-6f);
#pragma unroll
            for (int e = 0; e < 8; ++e) y[e] = sigmoidf_(o[e]) * (y[e] * rn) * nwb[e];
            *(u32x4*)(feat + (size_t)r * D + 512 + 8 * lane) = pack8(y);
        }
    }
}
__device__ __forceinline__ void phase_out_odd(int wv, KP Pk, int layer) {
    asm volatile("" : "+s"(Pk));
    const CAS Params& P = *Pk;
    const int tid = ltid(wv), lane = tid & 63, wid = tid >> 6, i_ = layer >> 1;
    const bf16_t* Pb = (const bf16_t*)(P.ws + WS_P);
    const bf16_t* Yf = (const bf16_t*)(P.ws + WS_YF); const bf16_t* Yb = (const bf16_t*)(P.ws + WS_YB);
    const bf16_t* R = (const bf16_t*)(P.ws + WS_RWR); const bf16_t* K = (const bf16_t*)(P.ws + WS_RWK); const bf16_t* V = (const bf16_t*)(P.ws + WS_RWV); const bf16_t* G = (const bf16_t*)(P.ws + WS_RWG);
    bf16_t* feat = (bf16_t*)(P.ws + WS_FEAT);
    const int r0 = (layer == DEPTH - 1) ? NCTX : 0;
    float nwc[8], rk[8], lw[8], lbv[8];
#pragma unroll
    for (int e = 0; e < 8; ++e) {
        nwc[e] = P.hg_norm_w[i_ * 512 + 8 * lane + e]; rk[e] = P.rw_r_k[i_ * 512 + 8 * lane + e];
        lw[e] = P.rw_ln_w[i_ * 512 + 8 * lane + e]; lbv[e] = P.rw_ln_b[i_ * 512 + 8 * lane + e];
    }
    u32x4 n0, n1, n2, n3, n4, n5, n6, n7, n8;
    auto fetch = [&](int rr) {
        n0 = *(const u32x4*)(Yf + (size_t)rr * D + 8 * lane); n1 = *(const u32x4*)(Yb + (size_t)rr * D + 8 * lane); n2 = *(const u32x4*)(Pb + (size_t)rr * LDP_ODD + 2048 + 8 * lane);
        n3 = *(const u32x4*)(Yf + (size_t)rr * D + 512 + 8 * lane); n4 = *(const u32x4*)(Yb + (size_t)rr * D + 512 + 8 * lane);
        n5 = *(const u32x4*)(R + (size_t)rr * 512 + 8 * lane); n6 = *(const u32x4*)(K + (size_t)rr * 512 + 8 * lane);
        n7 = *(const u32x4*)(V + (size_t)rr * 512 + 8 * lane); n8 = *(const u32x4*)(G + (size_t)rr * 512 + 8 * lane);
    };
    const int stride = gridDim.x * 8;
    int r = r0 + blockIdx.x * 8 + wid;
    if (r < NROWS) fetch(r);
    for (; r < NROWS; r += stride) {
        const u32x4 c0 = n0, c1 = n1, c2 = n2, c3 = n3, c4 = n4, c5 = n5, c6 = n6, c7 = n7, c8 = n8;
        if (r + stride < NROWS) fetch(r + stride);
        float y[8];
        {
            float a[8], bb[8], g[8];
            unpack8(c0, a); unpack8(c1, bb);
            unpack8(c2, g);
            float ss = 0.f;
#pragma unroll
            for (int e = 0; e < 8; ++e) { y[e] = a[e] + bb[e]; ss += y[e] * y[e]; }
            const float rn = rsqrtf(group_sum<16>(ss) * (1.f / 128.f) + 1e-6f);
#pragma unroll
            for (int e = 0; e < 8; ++e) y[e] = y[e] * rn * nwc[e] * siluf_(g[e]);
            *(u32x4*)(feat + (size_t)r * D + 8 * lane) = pack8(y);
        }
        {
            float a[8], bb[8], rr[8], kk[8], vv[8], g[8];
            unpack8(c3, a); unpack8(c4, bb);
            unpack8(c5, rr); unpack8(c6, kk);
            unpack8(c7, vv); unpack8(c8, g);
            float s = 0.f, bs = 0.f;
#pragma unroll
            for (int e = 0; e < 8; ++e) { y[e] = a[e] + bb[e]; s += y[e]; bs += rr[e] * kk[e] * rk[e]; }
            const float mean = group_sum<8>(s) * (1.f / 64.f); bs = group_sum<8>(bs);
            float ss = 0.f;
#pragma unroll
            for (int e = 0; e < 8; ++e) { y[e] -= mean; ss += y[e] * y[e]; }
            const float rn = rsqrtf(group_sum<8>(ss) * (1.f / 64.f) + 64e-5f);
#pragma unroll
            for (int e = 0; e < 8; ++e) y[e] = (y[e] * rn * lw[e] + lbv[e] + bs * vv[e]) * g[e];
            *(u32x4*)(feat + (size_t)r * D + 512 + 8 * lane) = pack8(y);
        }
    }
}

#ifndef MK_DOUBLE
#define MK_DOUBLE 0
#endif
#define REP(bit, body) do { body; if (MK_DOUBLE & (bit)) { body; } } while (0)
__device__ __forceinline__ void phase_expconv(int wv, KP Pk, int layer, LAS char* lds) {
    asm volatile("" : "+s"(Pk));
    const CAS Params& P = *Pk;
    const int tid = ltid(wv);
    if (layer & 1) return;
    expconv_items(P, layer, lds, exc_s0(layer) + exc_s1(layer), EXC_ITEMS, (int)blockIdx.x * 8 + (tid >> 6), (int)gridDim.x * 8, tid >> 6, tid & 63);
}
__device__ __forceinline__ void expconv_after_scan(int wv, KP Pk, int layer, LAS char* lds) {
    asm volatile("" : "+s"(Pk));
    const CAS Params& P = *Pk;
    const int tid = ltid(wv);
    __syncthreads();
    expconv_items(P, layer, lds, exc_s0(layer) + exc_s1(layer), EXC_ITEMS, (int)blockIdx.x * 8 + (tid >> 6), 128 * 8, tid >> 6, tid & 63);
}
constexpr int L1_AST = 1028;
constexpr int L1_PST = 33;
constexpr int L1_A = 0, L1_PART = L1_A + 16 * L1_AST * 4, L1_SM = L1_PART + 8 * 16 * L1_PST * 4, L1_END = L1_SM + (64 + 2 * 144 + 32) * 4;
static_assert(L1_END <= LDS_BYTES - 16, "LN1 LDS map");
__device__ __forceinline__ void phase_ln1(int wv, KP Pk, int layer, LAS char* lds, bool dry = false) {
    asm volatile("" : "+s"(Pk));
    const CAS Params& P = *Pk;
    const int tid = ltid(wv), lane = tid & 63;
    if (!dry) REP(8, phase_expconv(wv, Pk, layer, lds));
    __syncthreads();
    LAS float* At = (LAS float*)(lds + L1_A);
    LAS float* part = (LAS float*)(lds + L1_PART);
    LAS int* lcnt = (LAS int*)(lds + L1_SM);
    LAS int* lbase = lcnt + 32;
    LAS int* asg = lcnt + 64;
    LAS float* rbias = (LAS float*)(asg + 2 * 144);
    if (tid < 32) { lcnt[tid] = 0; rbias[tid] = P.router_bias[tid]; }
    float breg[8][4][2];
    {
        const float* rw = P.router_w + (size_t)(128 * wv + 4 * (lane >> 4)) * NEXP + (lane & 15);
#pragma unroll
        for (int j = 0; j < 8; ++j)
#pragma unroll
            for (int i = 0; i < 4; ++i) { breg[j][i][0] = rw[(16 * j + i) * NEXP]; breg[j][i][1] = rw[(16 * j + i) * NEXP + 16]; }
    }
    __syncthreads();
    const bf16_t* yo = (const bf16_t*)(P.ws + WS_YO);
    bf16_t* act = (bf16_t*)(P.ws + (dry ? WS_FEAT : WS_ACT));
    bf16_t* xcb = (bf16_t*)(P.ws + WS_XC); bf16_t* xob = (bf16_t*)P.out;
    const bool lastl = (layer == DEPTH - 1);
    int* cnt = (int*)(P.ws + WS_CNT) + layer * 32 * CNT_STRIDE;
    int* list = (int*)(P.ws + WS_LIST);
    float* wts = (float*)(P.ws + WS_WTS);
    const float* lg = P.ln_g + (size_t)(layer * 2 + 0) * D; const float* lb = P.ln_b + (size_t)(layer * 2 + 0) * D;
    const int r0 = (layer == DEPTH - 1) ? NCTX : 0, ntiles = (NROWS - r0) / 16, G = gridDim.x;
    f32x4 g1v[4], s2c[4], h2c[4];
#pragma unroll
    for (int i = 0; i < 4; ++i) g1v[i] = s2c[i] = h2c[i] = (f32x4){0.f, 0.f, 0.f, 0.f};
    int mcur = -1;
    f32x4 nx[2][4]; u32x2 nyo[2][4];
    auto fetch = [&](int s, int rr) {
        if (layer == 0) {
            const float* xq = rr < NCTX ? P.ctx + (size_t)rr * D : P.x + (size_t)(rr - NCTX) * D;
#pragma unroll
            for (int i = 0; i < 4; ++i) nx[s][i] = *(const f32x4*)(xq + 4 * lane + 256 * i);
        } else {
            const bf16_t* xq = rr < NCTX ? xcb + (size_t)rr * D : xob + (size_t)(rr - NCTX) * D;
#pragma unroll
            for (int i = 0; i < 4; ++i) { const u32x2 t = *(const u32x2*)(xq + 4 * lane + 256 * i); nx[s][i] = (f32x4){__uint_as_float(t.x), __uint_as_float(t.y), 0.f, 0.f}; }
        }
#pragma unroll
        for (int i = 0; i < 4; ++i) { const int c = 4 * lane + 256 * i; nyo[s][i] = *(const u32x2*)(yo + (size_t)rr * D + c); }
    };
    int tile = blockIdx.x;
    if (tile < ntiles) { fetch(0, r0 + tile * 16 + 2 * wv); fetch(1, r0 + tile * 16 + 2 * wv + 1); }
    for (int it = 0; tile < ntiles; ++it, tile += G) {
        const int rb = r0 + tile * 16 + 2 * wv;
        const int m = row_mod(rb);
        if (m != mcur) {
            mcur = m;
            const float* g1 = modvec(P.ws, layer, m, 2); const float* sh2 = modvec(P.ws, layer, m, 3); const float* sc2 = modvec(P.ws, layer, m, 4);
#pragma unroll
            for (int i = 0; i < 4; ++i) { const int c = 4 * lane + 256 * i; g1v[i] = *(const f32x4*)(g1 + c); s2c[i] = *(const f32x4*)(sc2 + c); h2c[i] = *(const f32x4*)(sh2 + c); }
        }
#pragma unroll
        for (int s = 0; s < 2; ++s) {
            const int r = rb + s;
            bf16_t* xr = dry ? (bf16_t*)(P.ws + WS_YF) + (size_t)r * D : lastl ? (bf16_t*)(P.ws + WS_FEAT) + (size_t)r * D : r < NCTX ? xcb + (size_t)r * D : xob + (size_t)(r - NCTX) * D;
            f32x4 v[4]; float sm = 0.f;
#pragma unroll
            for (int i = 0; i < 4; ++i) {
                f32x4 xv = nx[s][i]; const f32x4 gv = g1v[i]; const u32x2 yv = nyo[s][i];
                if (layer != 0) { const unsigned b0 = __float_as_uint(xv[0]), b1 = __float_as_uint(xv[1]); xv = (f32x4){bflo(b0), bfhi(b0), bflo(b1), bfhi(b1)}; }
                v[i][0] = ALPHA * xv[0] + gv[0] * bflo(yv.x); v[i][1] = ALPHA * xv[1] + gv[1] * bfhi(yv.x);
                v[i][2] = ALPHA * xv[2] + gv[2] * bflo(yv.y); v[i][3] = ALPHA * xv[3] + gv[3] * bfhi(yv.y);
                sm += (v[i][0] + v[i][1]) + (v[i][2] + v[i][3]);
            }
            if (tile + G < ntiles) fetch(s, r + G * 16);
            const float mean = wave_sum(sm) * (1.f / D);
            float s2 = 0.f;
#pragma unroll
            for (int i = 0; i < 4; ++i) { v[i] = v[i] - mean; s2 += (v[i][0] * v[i][0] + v[i][1] * v[i][1]) + (v[i][2] * v[i][2] + v[i][3] * v[i][3]); }
            const float rstd = rsqrtf(wave_sum(s2) * (1.f / D) + 1e-5f);
            LAS float* arow = At + (2 * wv + s) * L1_AST;
#pragma unroll
            for (int i = 0; i < 4; ++i) {
                const int c = 4 * lane + 256 * i;
                const f32x4 gg = *(const f32x4*)(lg + c), bb = *(const f32x4*)(lb + c), s2v = s2c[i], h2v = h2c[i];
                f32x4 xn, hv;
#pragma unroll
                for (int j = 0; j < 4; ++j) { xn[j] = v[i][j] * rstd * gg[j] + bb[j]; hv[j] = xn[j] * (1.f + s2v[j]) + h2v[j]; }
                { u32x2 ox; ox.x = pk2(xn[0], xn[1]); ox.y = pk2(xn[2], xn[3]); *(u32x2*)(xr + c) = ox; }
                u32x2 o; o.x = pk2(hv[0], hv[1]); o.y = pk2(hv[2], hv[3]); *(u32x2*)(act + (size_t)r * D + c) = o;
                *(LAS f32x4*)(arow + c) = hv;
            }
        }
        __syncthreads();
        {
            f32x4 ra0 = (f32x4){0.f, 0.f, 0.f, 0.f}, ra1 = ra0;
            const LAS float* ap = At + (lane & 15) * L1_AST + 128 * wv + 4 * (lane >> 4);
#pragma unroll
            for (int j = 0; j < 8; ++j) {
                const f32x4 a4 = *(const LAS f32x4*)(ap + 16 * j);
#pragma unroll
                for (int i = 0; i < 4; ++i) {
                    ra0 = __builtin_amdgcn_mfma_f32_16x16x4f32(a4[i], breg[j][i][0], ra0, 0, 0, 0);
                    ra1 = __builtin_amdgcn_mfma_f32_16x16x4f32(a4[i], breg[j][i][1], ra1, 0, 0, 0);
                }
            }
            LAS float* pw = part + wv * 16 * L1_PST + (4 * (lane >> 4)) * L1_PST + (lane & 15);
#pragma unroll
            for (int j = 0; j < 4; ++j) { pw[j * L1_PST] = ra0[j]; pw[j * L1_PST + 16] = ra1[j]; }
        }
        __syncthreads();
        {
            const int half = lane >> 5, e = lane & 31;
            const LAS float* pp = part + (2 * wv + half) * L1_PST + e;
            float sc_ = 0.f;
#pragma unroll
            for (int k = 0; k < 8; ++k) sc_ += pp[k * 16 * L1_PST];
            const float sg = sigmoidf_(sc_), vb = sg + rbias[e];
            float bv[4], sv[4];
            bv[0] = dppmov<0x00>(vb); bv[1] = dppmov<0x55>(vb); bv[2] = dppmov<0xAA>(vb); bv[3] = dppmov<0xFF>(vb);
            sv[0] = dppmov<0x00>(sg); sv[1] = dppmov<0x55>(sg); sv[2] = dppmov<0xAA>(sg); sv[3] = dppmov<0xFF>(sg);
            float m1 = -1e30f, m2 = -1e30f;
#pragma unroll
            for (int k = 0; k < 4; ++k) { const float vsc = bv[k]; if (vsc > m1) { m2 = m1; m1 = vsc; } else if (vsc > m2) m2 = vsc; }
            float best = m1 + m2; int bg = e >> 2;
#pragma unroll
            for (int msk = 4; msk <= 16; msk <<= 1) {
                const float ob = __shfl_xor(best, msk); const int og = __shfl_xor(bg, msk);
                const bool take = (ob > best) || (ob == best && og < bg);
                best = take ? ob : best; bg = take ? og : bg;
            }
            int i1 = 0; float b1 = bv[0];
#pragma unroll
            for (int k = 1; k < 4; ++k) if (bv[k] > b1) { b1 = bv[k]; i1 = k; }
            int i2 = -1; float b2 = -1e30f;
#pragma unroll
            for (int k = 0; k < 4; ++k) if (k != i1 && bv[k] > b2) { b2 = bv[k]; i2 = k; }
            float s1 = sv[0], s2s = sv[0];
#pragma unroll
            for (int k = 1; k < 4; ++k) { if (i1 == k) s1 = sv[k]; if (i2 == k) s2s = sv[k]; }
            if (e == 4 * bg && !dry) {
                const int r = rb + half;
                const int e0 = bg * 4 + i1, e1 = bg * 4 + i2;
                const float inv = 1.f / (s1 + s2s);
                const int li = it * 16 + 2 * wv + half;
                const int p0 = __hip_atomic_fetch_add(&lcnt[e0], 1, __ATOMIC_RELAXED, __HIP_MEMORY_SCOPE_WORKGROUP);
                const int p1 = __hip_atomic_fetch_add(&lcnt[e1], 1, __ATOMIC_RELAXED, __HIP_MEMORY_SCOPE_WORKGROUP);
                asg[2 * li] = (e0 << 16) | p0; asg[2 * li + 1] = (e1 << 16) | p1;
                wts[2 * r] = s1 * inv; wts[2 * r + 1] = s2s * inv;
            }
        }
    }
    __syncthreads();
    if (dry) return;
    if (tid < 32) lbase[tid] = atomicAdd(&cnt[tid * CNT_STRIDE], lcnt[tid]);
    __syncthreads();
    for (int idx = tid; idx < 2 * 144; idx += NT) {
        const int li = idx >> 1, k = idx & 1, t = (li >> 4) * G + blockIdx.x;
        if (t < ntiles) { const int r = r0 + t * 16 + (li & 15); const int v = asg[idx], e = v >> 16, lp = v & 0xffff; list[(size_t)e * LISTCAP + lbase[e] + lp] = 2 * r + k; }
    }
}

__device__ __forceinline__ void phase_ln2(int wv, KP Pk, int layer, bool dry = false) {
    asm volatile("" : "+s"(Pk));
    const CAS Params& P = *Pk;
    const int tid = ltid(wv), lane = tid & 63, wid = tid >> 6;
    const bf16_t* yp = (const bf16_t*)(P.ws + WS_YP);
    const float* wts = (const float*)(P.ws + WS_WTS);
    bf16_t* act = (bf16_t*)(P.ws + (dry ? WS_FEAT : WS_ACT));
    bf16_t* xcb = (bf16_t*)(P.ws + WS_XC); bf16_t* xob = (bf16_t*)P.out;
    const float* lg = P.ln_g + (size_t)(layer * 2 + 1) * D; const float* lb = P.ln_b + (size_t)(layer * 2 + 1) * D;
    const bool last = (layer == DEPTH - 1);
    const int r0 = last ? NCTX : 0, stride = gridDim.x * 8;
    f32x4 cg[4], cb[4], g2v[4], s1v[4], h1v[4];
#pragma unroll
    for (int i = 0; i < 4; ++i) { cg[i] = *(const f32x4*)(lg + 4 * lane + 256 * i); cb[i] = *(const f32x4*)(lb + 4 * lane + 256 * i); g2v[i] = s1v[i] = h1v[i] = (f32x4){0.f, 0.f, 0.f, 0.f}; }
    int mcur = -1;
    u32x2 nx[4]; u32x2 ny0[4], ny1[4]; float nw0 = 0.f, nw1 = 0.f;
    auto fetch = [&](int r) {
        const bf16_t* xr = last ? (const bf16_t*)(P.ws + WS_FEAT) + (size_t)r * D : r < NCTX ? xcb + (size_t)r * D : xob + (size_t)(r - NCTX) * D;
#pragma unroll
        for (int i = 0; i < 4; ++i) {
            const int c = 4 * lane + 256 * i;
            nx[i] = *(const u32x2*)(xr + c); ny0[i] = *(const u32x2*)(yp + (size_t)(2 * r) * D + c); ny1[i] = *(const u32x2*)(yp + (size_t)(2 * r + 1) * D + c);
        }
        nw0 = wts[2 * r]; nw1 = wts[2 * r + 1];
    };
    int r = r0 + blockIdx.x * 8 + wid;
    if (r < NROWS) fetch(r);
    for (; r < NROWS; r += stride) {
        const int m = row_mod(r);
        if (m != mcur) {
            mcur = m;
            const float* g2 = modvec(P.ws, layer, m, 5); const float* sh1 = last ? lg : modvec(P.ws, layer + 1, m, 0); const float* sc1 = last ? lg : modvec(P.ws, layer + 1, m, 1);
#pragma unroll
            for (int i = 0; i < 4; ++i) { const int c = 4 * lane + 256 * i; g2v[i] = *(const f32x4*)(g2 + c); s1v[i] = *(const f32x4*)(sc1 + c); h1v[i] = *(const f32x4*)(sh1 + c); }
        }
        f32x4 v[4]; float s = 0.f;
        const float w0 = nw0, w1 = nw1;
#pragma unroll
        for (int i = 0; i < 4; ++i) {
            const f32x4 xv = (f32x4){bflo(nx[i].x), bfhi(nx[i].x), bflo(nx[i].y), bfhi(nx[i].y)}, gv = g2v[i]; const u32x2 y0 = ny0[i], y1 = ny1[i];
            v[i][0] = ALPHA * xv[0] + gv[0] * (w0 * bflo(y0.x) + w1 * bflo(y1.x)); v[i][1] = ALPHA * xv[1] + gv[1] * (w0 * bfhi(y0.x) + w1 * bfhi(y1.x));
            v[i][2] = ALPHA * xv[2] + gv[2] * (w0 * bflo(y0.y) + w1 * bflo(y1.y)); v[i][3] = ALPHA * xv[3] + gv[3] * (w0 * bfhi(y0.y) + w1 * bfhi(y1.y));
            s += (v[i][0] + v[i][1]) + (v[i][2] + v[i][3]);
        }
        if (r + stride < NROWS) fetch(r + stride);
        const float mean = wave_sum(s) * (1.f / D);
        float s2 = 0.f;
#pragma unroll
        for (int i = 0; i < 4; ++i) { v[i] = v[i] - mean; s2 += (v[i][0] * v[i][0] + v[i][1] * v[i][1]) + (v[i][2] * v[i][2] + v[i][3] * v[i][3]); }
        const float rstd = rsqrtf(wave_sum(s2) * (1.f / D) + 1e-5f);
#pragma unroll
        for (int i = 0; i < 4; ++i) {
            const int c = 4 * lane + 256 * i;
            f32x4 xn;
#pragma unroll
            for (int j = 0; j < 4; ++j) xn[j] = v[i][j] * rstd * cg[i][j] + cb[i][j];
            if (dry) *(f32x4*)((float*)(P.ws + WS_YF) + (size_t)r * D + c) = xn;
            else if (last) *(f32x4*)(P.out + (size_t)(r - NCTX) * D + c) = xn;
            else { u32x2 ox; ox.x = pk2(xn[0], xn[1]); ox.y = pk2(xn[2], xn[3]); *(u32x2*)((r < NCTX ? xcb + (size_t)r * D : xob + (size_t)(r - NCTX) * D) + c) = ox; }
            if (!last) {
                u32x2 o; o.x = pk2(xn[0] * (1.f + s1v[i][0]) + h1v[i][0], xn[1] * (1.f + s1v[i][1]) + h1v[i][1]); o.y = pk2(xn[2] * (1.f + s1v[i][2]) + h1v[i][2], xn[3] * (1.f + s1v[i][3]) + h1v[i][3]);
                *(u32x2*)(act + (size_t)r * D + c) = o;
            }
        }
    }
}

constexpr int NPHASE = 2 + 11 * DEPTH;
__global__ void __launch_bounds__(NT, 2) fwd_kernel(Params P) {
    extern __shared__ __attribute__((aligned(16))) char lds_raw[];
    LAS char* lds = (LAS char*)lds_raw;
    volatile LAS unsigned* xbw = (volatile LAS unsigned*)(lds + LDS_BYTES - 16);
    KP Pk = (KP)__builtin_amdgcn_kernarg_segment_ptr();
    const int wv = __builtin_amdgcn_readfirstlane((int)(threadIdx.x >> 6));
    const bool multi = (P.ph_hi - P.ph_lo) > 1;
    XcdBarrier bar; bar.bar = (unsigned*)(P.ws + WS_BAR); bar.x = 0; bar.st = xbw;
    if (multi) {
        if (ltid(wv) == 0) { xbw[0] = 0u; xbw[1] = 0u; xbw[2] = 0u; xbw[3] = 0u; }
        __syncthreads();
        bar = xcd_barrier_post(wv, (unsigned*)(P.ws + WS_BAR), xbw);
    }
#define PHASE(id, body) do { if (P.ph_lo <= (id) && (id) < P.ph_hi) { body; if ((id) + 1 < P.ph_hi) xcd_barrier(wv, bar); if (MK_DOUBLE & 2048) xcd_barrier(wv, bar); } } while (0)
    PHASE(0, REP(16, phase_prologue0(wv, Pk, lds)));
    PHASE(1, REP(16, phase_prologue1(wv, Pk)));
    for (int l = 0; l < DEPTH; ++l) {
        const int pb = 2 + 11 * l, odd = l & 1;
        PHASE(pb + 0, REP(1, phase_inproj(wv, Pk, l, lds)));
        if (odd) {
            PHASE(pb + 1, REP(4, phase_prep1(wv, Pk, l)));
            PHASE(pb + 2, phase_prep2(wv, Pk, l, lds));
            PHASE(pb + 3, REP(32, { if (blockIdx.x < 128) { REP(64, scan_hgrn_c(wv, Pk, l, blockIdx.x, lds)); expconv_after_scan(wv, Pk, l, lds); } else if (blockIdx.x < 256) REP(128, scan_rwkv_b(wv, Pk, l, blockIdx.x - 128, lds)); }));
            PHASE(pb + 5, REP(4, phase_out_odd(wv, Pk, l)));
        } else {
            PHASE(pb + 1, REP(4, phase_prep_even(wv, Pk, l)));
            PHASE(pb + 2, REP(2, phase_ex1(wv, Pk, l, lds)));
            PHASE(pb + 3, phase_ex2(wv, Pk, l));
            PHASE(pb + 4, REP(2, phase_ex3(wv, Pk, l, lds)));
            PHASE(pb + 5, REP(4, phase_out_even(wv, Pk, l)));
        }
        PHASE(pb + 6, REP(256, phase_outproj(wv, Pk, l, lds)));
        PHASE(pb + 7, { if (MK_DOUBLE & 4096) phase_ln1(wv, Pk, l, lds, true); phase_ln1(wv, Pk, l, lds); });
        PHASE(pb + 8, REP(512, phase_moe1(wv, Pk, l, lds)));
        PHASE(pb + 9, REP(1024, phase_moe2(wv, Pk, l, lds)));
        PHASE(pb + 10, { if (MK_DOUBLE & 8192) phase_ln2(wv, Pk, l, true); phase_ln2(wv, Pk, l); });
    }
#undef PHASE
}


#ifndef MK_STOP
#define MK_STOP NPHASE
#endif
#ifndef MK_DUMP
#define MK_DUMP 0
#endif
#ifndef MK_DUMP_N
#define MK_DUMP_N (1u << 30)
#endif
#ifndef MK_DUMP_LD
#define MK_DUMP_LD 1024
#endif
#ifndef MK_DUMP_C0
#define MK_DUMP_C0 0
#endif
__global__ void diff_kernel(const bf16_t* a, const bf16_t* b, float* out, size_t n) {
    for (size_t i = (size_t)blockIdx.x * blockDim.x + threadIdx.x; i < n; i += (size_t)gridDim.x * blockDim.x) out[i] = 1e6f * (bf2f(a[i]) - bf2f(b[i]));
}
__global__ void dump_kernel(const bf16_t* src, float* out, size_t n) {
    for (size_t i = (size_t)blockIdx.x * blockDim.x + threadIdx.x; i < n; i += (size_t)gridDim.x * blockDim.x) out[i] = i < (size_t)MK_DUMP_N ? bf2f(src[(i >> 10) * MK_DUMP_LD + MK_DUMP_C0 + (i & 1023)]) : 0.f;
}
extern "C" void kernel_launch(void* const* d_in, const int* in_sizes, int n_in, void* d_out, int out_size, void* d_ws, size_t ws_size, hipStream_t stream) {
    static int ready = 0;
    if (ready == 0) {
        ready = 1;
        if (n_in != 42 || out_size != NB * SEQ * D || ws_size < WS_END) { fprintf(stderr, "kernel_launch: unexpected shapes (n_in %d out %d ws %zu need %zu)\n", n_in, out_size, ws_size, (size_t)WS_END); ready = -1; }
        if (hipFuncSetAttribute((const void*)fwd_kernel, hipFuncAttributeMaxDynamicSharedMemorySize, LDS_BYTES) != hipSuccess) { fprintf(stderr, "kernel_launch: hipFuncSetAttribute failed\n"); ready = -1; }
    }
    if (ready < 0) return;
    (void)in_sizes;
    hipMemsetAsync((char*)d_ws + WS_BAR, 0, WS_ZERO_BYTES, stream);
    Params p;
    memset(&p, 0, sizeof(p));
    const float** fp = (const float**)&p;
    for (int i = 0; i < 42; ++i) fp[i] = (const float*)d_in[i];
    p.out = (float*)d_out; p.ws = (unsigned char*)d_ws;
#if MK_PER_PHASE
    for (int ph = 0; ph < MK_STOP; ++ph) {
        const int local = ph < 2 ? -1 : (ph - 2) % 11, layer = ph < 2 ? 0 : (ph - 2) / 11;
        if (local == 4 && (layer & 1)) continue;
        p.ph_lo = ph; p.ph_hi = ph + 1;
        hipLaunchKernelGGL(fwd_kernel, dim3(256), dim3(NT), LDS_BYTES, stream, p);
    }
#ifdef MK_DIFF
    p.ph_lo = 7; p.ph_hi = 8; p.dbg = 1;
    hipLaunchKernelGGL(fwd_kernel, dim3(256), dim3(NT), LDS_BYTES, stream, p);
    hipLaunchKernelGGL(diff_kernel, dim3(1024), dim3(256), 0, stream, (const bf16_t*)((unsigned char*)d_ws + WS_YO), (const bf16_t*)((unsigned char*)d_ws + WS_HID), (float*)d_out, (size_t)NB * SEQ * D);
#else
    if (MK_DUMP) hipLaunchKernelGGL(dump_kernel, dim3(1024), dim3(256), 0, stream, (const bf16_t*)((unsigned char*)d_ws + (size_t)MK_DUMP), (float*)d_out, (size_t)NB * SEQ * D);
#endif
#else
    p.ph_lo = 0; p.ph_hi = NPHASE;
    hipLaunchKernelGGL(fwd_kernel, dim3(256), dim3(NT), LDS_BYTES, stream, p);
#endif
}
```

```cpp
#include <hip/hip_runtime.h>
#include <stdint.h>
#include <stdio.h>
#include <string.h>

#ifndef MK_PER_PHASE
#define MK_PER_PHASE 0
#endif

typedef unsigned short bf16_t;
typedef short bf16x8 __attribute__((ext_vector_type(8)));
typedef float f32x4 __attribute__((ext_vector_type(4)));
typedef unsigned u32x4 __attribute__((ext_vector_type(4)));
typedef unsigned u32x2 __attribute__((ext_vector_type(2)));
#define LAS __attribute__((address_space(3)))
#define CAS __attribute__((address_space(4)))

constexpr int D = 1024, NB = 4, SEQ = 8192, CTXL = 256, DEPTH = 4;
constexpr int NCTX = NB * CTXL;
constexpr int NROWS = NCTX + NB * SEQ;
constexpr int P_EVEN = 2848, P_ODD = 4416, LDP_EVEN = 3072, LDP_ODD = 4608;
constexpr int NEXP = 32, DEXP = 512, LISTCAP = NROWS;
constexpr float ALPHA = 1.681792830507429f;
constexpr int NT = 512;
constexpr int TCH = 32;
constexpr int NSTEPS = CTXL + SEQ;
constexpr int LDS_BYTES = 160 * 1024;

constexpr size_t al256(size_t x) { return (x + 255) & ~(size_t)255; }
constexpr size_t WS_BAR = 0;
constexpr size_t WS_CNT = 16384;
constexpr int CNT_STRIDE = 64;
constexpr size_t WS_ZERO_BYTES = 16384 + (size_t)4 * 32 * CNT_STRIDE * 4;
constexpr size_t WS_MODV = al256(WS_ZERO_BYTES);
constexpr size_t WS_LB = WS_MODV + al256((size_t)4 * 5 * 6144 * 4);
constexpr size_t WS_XC = WS_LB + al256(4 * 512 * 4);
constexpr size_t WS_WTS = WS_XC + (size_t)NCTX * D * 4;
constexpr size_t WS_LIST = WS_WTS + al256((size_t)2 * NROWS * 4);
constexpr size_t WS_WINT = WS_LIST + al256((size_t)NEXP * LISTCAP * 4);
constexpr size_t WINT_L0 = 0, WINT_L1 = (size_t)LDP_EVEN * D, WINT_L2 = WINT_L1 + (size_t)LDP_ODD * D, WINT_L3 = WINT_L2 + (size_t)LDP_EVEN * D, WINT_END = WINT_L3 + (size_t)LDP_ODD * D;
constexpr size_t WS_WOUTT = WS_WINT + WINT_END * 2;
constexpr size_t WS_LORAT = WS_WOUTT + (size_t)4 * D * D * 2;
constexpr size_t LORA_PER = (size_t)512 * 320;
constexpr size_t WS_EXPGU = WS_LORAT + al256(2 * LORA_PER * 2);
constexpr size_t WS_EXPD = WS_EXPGU + (size_t)NEXP * 1024 * 1024 * 2;
constexpr size_t WS_ACT = WS_EXPD + (size_t)NEXP * 1024 * 512 * 2;
constexpr size_t ROWB = (size_t)NROWS * D * 2;
constexpr size_t WS_FEAT = WS_ACT + ROWB;
constexpr size_t WS_YF = WS_FEAT + ROWB;
constexpr size_t WS_YB = WS_YF + ROWB;
constexpr size_t WS_P = WS_YB + ROWB;
constexpr size_t P_BYTES = (size_t)NROWS * LDP_ODD * 2;
constexpr size_t WS_YO = WS_P;
constexpr size_t WS_HID = WS_P + ROWB;
constexpr size_t WS_YP = WS_HID + ROWB;
static_assert(WS_YP + 2 * ROWB <= WS_P + P_BYTES, "MoE buffers must fit in the P region");
constexpr size_t HALFB = (size_t)NROWS * 512 * 2;
constexpr size_t WS_RWR = WS_P + P_BYTES;
constexpr size_t WS_RWK = WS_RWR + HALFB;
constexpr size_t WS_RWV = WS_RWK + HALFB;
constexpr size_t WS_RWKK = WS_RWV + HALFB;
constexpr size_t WS_RWB = WS_RWKK + HALFB;
constexpr size_t WS_RWG = WS_RWB + HALFB;
constexpr size_t WS_RWDEC = WS_RWG + HALFB;
constexpr size_t WS_LA = WS_RWDEC + (size_t)2 * NROWS * 512 * 4;
constexpr size_t WS_END = WS_LA + (size_t)NROWS * 320 * 2;
static_assert(WS_END <= (size_t)280602384 * 4, "workspace map exceeds the guaranteed ws_size");

struct Params {
    const float *x, *c, *ctx, *c_ctx, *mod_w, *mod_b, *ln_g, *ln_b;
    const float *ev_w_in, *ev_w_out, *ssd_conv_w, *ssd_conv_b, *ssd_dt_bias, *ssd_a_log, *ssd_d, *ssd_norm_w;
    const float *ml_conv_w, *ml_conv_b, *ml_i_bias, *ml_f_bias, *ml_norm_w;
    const float *od_w_in, *od_w_out, *hg_lb_logits, *hg_f_bias, *hg_norm_w;
    const float *rw_mu, *rw_w0, *rw_w2, *rw_a0, *rw_a2, *rw_g2, *rw_k_k, *rw_k_a, *rw_r_k, *rw_ln_w, *rw_ln_b;
    const float *router_w, *router_bias, *exp_w_gate, *exp_w_up, *exp_w_down;
    float* out;
    unsigned char* ws;
    int ph_lo, ph_hi, dbg, pad_;
};
typedef const CAS Params* KP;

__device__ __forceinline__ int ltid(int wv) { int l; asm volatile("v_mbcnt_lo_u32_b32 %0, -1, 0\n\tv_mbcnt_hi_u32_b32 %0, -1, %0" : "=v"(l)); return wv * 64 + l; }
__device__ __forceinline__ float bf2f(bf16_t h) { return __uint_as_float(((unsigned)h) << 16); }
__device__ __forceinline__ float bflo(unsigned u) { return __uint_as_float(u << 16); }
__device__ __forceinline__ float bfhi(unsigned u) { return __uint_as_float(u & 0xffff0000u); }
typedef __bf16 bf16v2_t __attribute__((ext_vector_type(2)));
typedef float f32x2 __attribute__((ext_vector_type(2)));
__device__ __forceinline__ unsigned pk2(float lo, float hi) { const f32x2 v = {lo, hi}; return __builtin_bit_cast(unsigned, __builtin_convertvector(v, bf16v2_t)); }
__device__ __forceinline__ bf16_t f2bf(float f) { return (bf16_t)(pk2(f, 0.f) & 0xffffu); }
__device__ __forceinline__ void unpack8(const u32x4& u, float* f) {
    f[0] = bflo(u.x); f[1] = bfhi(u.x); f[2] = bflo(u.y); f[3] = bfhi(u.y); f[4] = bflo(u.z); f[5] = bfhi(u.z); f[6] = bflo(u.w); f[7] = bfhi(u.w);
}
__device__ __forceinline__ u32x4 pack8(const float* f) { u32x4 u; u.x = pk2(f[0], f[1]); u.y = pk2(f[2], f[3]); u.z = pk2(f[4], f[5]); u.w = pk2(f[6], f[7]); return u; }
__device__ __forceinline__ float sigmoidf_(float x) { return __builtin_amdgcn_rcpf(1.f + __expf(-x)); }
__device__ __forceinline__ float siluf_(float x) { return x * __builtin_amdgcn_rcpf(1.f + __expf(-x)); }
__device__ __forceinline__ float softplus_fast(float x) { return x > 20.f ? x : __logf(1.f + __expf(x)); }
__device__ __forceinline__ float tanh_fast(float x) { return 1.f - 2.f * __builtin_amdgcn_rcpf(1.f + __expf(2.f * x)); }
__device__ __forceinline__ float softplusf_(float x) { return x > 20.f ? x : __logf(1.f + __expf(x)); }
__device__ __forceinline__ float logsigmoidf_(float x) { return fminf(x, 0.f) - __logf(1.f + __expf(-fabsf(x))); }
template <int CTRL> __device__ __forceinline__ float dppmov(float v) {
    return __builtin_bit_cast(float, __builtin_amdgcn_update_dpp(0, __builtin_bit_cast(int, v), CTRL, 0xf, 0xf, true));
}
__device__ __forceinline__ float allreduce16(float v) {
    v += dppmov<0xB1>(v);
    v += dppmov<0x4E>(v);
    v += dppmov<0x141>(v);
    v += dppmov<0x140>(v);
    return v;
}
__device__ __forceinline__ float allreduce8_(float v) { v += dppmov<0xB1>(v); v += dppmov<0x4E>(v); v += dppmov<0x141>(v); return v; }
__device__ __forceinline__ float wave_sum(float v) {
    v = allreduce16(v);
    const float r0 = __builtin_bit_cast(float, __builtin_amdgcn_readlane(__builtin_bit_cast(int, v), 0)), r1 = __builtin_bit_cast(float, __builtin_amdgcn_readlane(__builtin_bit_cast(int, v), 16));
    const float r2 = __builtin_bit_cast(float, __builtin_amdgcn_readlane(__builtin_bit_cast(int, v), 32)), r3 = __builtin_bit_cast(float, __builtin_amdgcn_readlane(__builtin_bit_cast(int, v), 48));
    return (r0 + r1) + (r2 + r3);
}
template <int W> __device__ __forceinline__ float group_sum(float v) {
    if (W == 8) return allreduce8_(v);
    return allreduce16(v);
}

#define XB_TMO      128
#define XB_XCNT(j)  (256  + 64 * (j))
#define XB_XSUB(j)  (1280 + 64 * (j))
#define XB_XGEN(j)  (2304 + 64 * (j))
#define XB_TOP      3328
#define XB_TOPGEN   3392
#define XCD_BAR_WORDS 3456
#define XB_SPIN_CAP (1u << 22)
__device__ __forceinline__ unsigned xb_ld(unsigned* p)              { return __hip_atomic_load(p, __ATOMIC_RELAXED, __HIP_MEMORY_SCOPE_AGENT); }
__device__ __forceinline__ unsigned xb_add(unsigned* p, unsigned v) { return __hip_atomic_fetch_add(p, v, __ATOMIC_RELAXED, __HIP_MEMORY_SCOPE_AGENT); }
__device__ __forceinline__ unsigned xb_xcc_id() { return (unsigned)__builtin_amdgcn_s_getreg((3 << 11) | 20) & 0xFu; }
#define XB_SPIN(cond, bar) do { unsigned _sp = 0; while (cond) { __builtin_amdgcn_s_sleep(1); \
    if ((++_sp & 255u) == 0u) { if (xb_ld(&(bar)[XB_TMO])) break; if (_sp > XB_SPIN_CAP) { atomicAdd(&(bar)[XB_TMO], 1u); break; } } } } while (0)
struct XcdBarrier { unsigned* bar; unsigned x; volatile LAS unsigned* st; };
__device__ __forceinline__ XcdBarrier xcd_barrier_post(int wv, unsigned* bar, volatile LAS unsigned* st) {
    XcdBarrier b; b.bar = bar; b.x = xb_xcc_id(); b.st = st;
    if (ltid(wv) == 0) (void)xb_add(&bar[XB_XCNT(b.x)], 1u);
    return b;
}
__device__ __forceinline__ void xcd_barrier_complete(unsigned* bar, unsigned x, unsigned& nloc, unsigned& nx) {
    const unsigned G = gridDim.x * gridDim.y * gridDim.z;
    unsigned sum, cnt, mine, sp = 0u;
    for (;;) {
        sum = 0u; cnt = 0u; mine = 0u;
#pragma unroll
        for (unsigned j = 0; j < 16; ++j) { const unsigned c = xb_ld(&bar[XB_XCNT(j)]); sum += c; cnt += (c > 0u) ? 1u : 0u; mine = (j == x) ? c : mine; }
        if (sum == G) break;
        __builtin_amdgcn_s_sleep(1);
        if ((++sp & 255u) == 0u) { if (xb_ld(&bar[XB_TMO])) break; if (sp > XB_SPIN_CAP) { atomicAdd(&bar[XB_TMO], 1u); break; } }
    }
    nloc = mine > 0u ? mine : 1u; nx = cnt > 0u ? cnt : 1u;
}
__device__ __forceinline__ void xcd_barrier(int wv, const XcdBarrier& b) {
    asm volatile("s_waitcnt vmcnt(0)" ::: "memory");
    __syncthreads();
    if (ltid(wv) == 0) {
        unsigned* bar = b.bar;
        asm volatile("" : "+s"(bar));
        __builtin_amdgcn_s_waitcnt(0);
        unsigned nloc = b.st[0], nx = b.st[1];
        if (nloc == 0u) { xcd_barrier_complete(bar, b.x, nloc, nx); b.st[0] = nloc; b.st[1] = nx; }
        const unsigned old = xb_add(&bar[XB_XSUB(b.x)], 1u);
        const unsigned gen = old / nloc;
        if (old + 1u == (gen + 1u) * nloc) {
            __builtin_amdgcn_fence(__ATOMIC_RELEASE, "agent");
            asm volatile("s_waitcnt vmcnt(0)" ::: "memory");
            const unsigned og = xb_add(&bar[XB_TOP], 1u);
            const unsigned tg = og / nx;
            if (og + 1u == (tg + 1u) * nx) xb_add(&bar[XB_TOPGEN], 1u);
            else XB_SPIN(xb_ld(&bar[XB_TOPGEN]) == tg, bar);
            __builtin_amdgcn_fence(__ATOMIC_ACQUIRE, "agent");
            xb_add(&bar[XB_XGEN(b.x)], 1u);
            asm volatile("s_waitcnt vmcnt(0)" ::: "memory");
        } else {
            XB_SPIN(xb_ld(&bar[XB_XGEN(b.x)]) == gen, bar);
            __builtin_amdgcn_fence(__ATOMIC_ACQUIRE, "agent");
            asm volatile("s_waitcnt vmcnt(0)" ::: "memory");
        }
    }
    __syncthreads();
}

__device__ __forceinline__ int row_mod(int r) { return r < NCTX ? 4 : ((r - NCTX) >> 13); }
__device__ __forceinline__ void row_seg(int r, int& t, int& len) { if (r < NCTX) { t = r & 255; len = CTXL; } else { t = (r - NCTX) & 8191; len = SEQ; } }
__device__ __forceinline__ int scan_row(int tg, int b, int dir, int odd) {
    if (tg < CTXL) { const int t = dir ? (CTXL - 1 - tg) : tg; return b * CTXL + t; }
    int sg = tg - CTXL; if (dir) sg = SEQ - 1 - sg;
    const int s = odd ? (((sg & 127) << 6) + (sg >> 7)) : sg;
    return NCTX + b * SEQ + s;
}
__device__ __forceinline__ const float* modvec(const unsigned char* ws, int layer, int m, int which) {
    return (const float*)(ws + WS_MODV) + ((size_t)(layer * 5 + m) * 6 + which) * D;
}

constexpr int G_BM = 256, G_BN = 128, G_BK = 64;
constexpr int G_ABYTES = G_BM * G_BK * 2, G_BBYTES = G_BN * G_BK * 2, G_BUF = G_ABYTES + G_BBYTES;
__device__ __forceinline__ int swz(int o) { return o ^ (((o >> 9) & 1) << 5); }

template <class RowSrc, class Epi>
__device__ __forceinline__ void gemm_tile(int wv, const bf16_t* __restrict__ A, int lda, const RowSrc& rs, const bf16_t* __restrict__ Bt, int ldb, int n0, int K, const Epi& epi, LAS char* lds) {
    const int tid = ltid(wv), lane = tid & 63, wid = tid >> 6, wm = wid >> 1, wn = wid & 1;
    const bf16_t* ap[4]; int aoff[4];
#pragma unroll
    for (int i = 0; i < 4; ++i) {
        const int c = tid + NT * i, row = c >> 3, kc = c & 7;
        ap[i] = A + (size_t)rs.src(row) * lda + kc * 8;
        aoff[i] = ((row >> 4) * 2 + (kc >> 2)) * 1024 + swz((row & 15) * 64 + (kc & 3) * 16);
    }
    const bf16_t* bp[2]; int boff[2];
#pragma unroll
    for (int i = 0; i < 2; ++i) {
        const int c = tid + NT * i, row = c >> 3, kc = c & 7;
        bp[i] = Bt + (size_t)(n0 + row) * ldb + kc * 8;
        boff[i] = G_ABYTES + ((row >> 4) * 2 + (kc >> 2)) * 1024 + swz((row & 15) * 64 + (kc & 3) * 16);
    }
    f32x4 acc[4][4];
#pragma unroll
    for (int i = 0; i < 4; ++i)
#pragma unroll
        for (int j = 0; j < 4; ++j) acc[i][j] = (f32x4){0.f, 0.f, 0.f, 0.f};
    u32x4 ra[2][4], rb[2][2];
    const int KT = K / G_BK;
    const int fragoff = swz((lane & 15) * 64 + (lane >> 4) * 16);
#define G_LOAD(set, kt_) do { _Pragma("unroll") for (int i = 0; i < 4; ++i) ra[set][i] = *(const u32x4*)(ap[i] + (kt_) * G_BK); \
                              _Pragma("unroll") for (int i = 0; i < 2; ++i) rb[set][i] = *(const u32x4*)(bp[i] + (kt_) * G_BK); } while (0)
#define G_STORE(set, buf) do { _Pragma("unroll") for (int i = 0; i < 4; ++i) *(LAS u32x4*)((buf) + aoff[i]) = ra[set][i]; \
                               _Pragma("unroll") for (int i = 0; i < 2; ++i) *(LAS u32x4*)((buf) + boff[i]) = rb[set][i]; } while (0)
#define G_COMPUTE(cur) do { bf16x8 af[2][4], bfr[2][4]; \
        _Pragma("unroll") for (int ks = 0; ks < 2; ++ks) { \
            _Pragma("unroll") for (int ni = 0; ni < 4; ++ni) bfr[ks][ni] = *(LAS bf16x8*)((cur) + G_ABYTES + ((wn * 4 + ni) * 2 + ks) * 1024 + fragoff); \
            _Pragma("unroll") for (int mi = 0; mi < 4; ++mi) af[ks][mi] = *(LAS bf16x8*)((cur) + ((wm * 4 + mi) * 2 + ks) * 1024 + fragoff); } \
        __builtin_amdgcn_sched_barrier(0); \
        _Pragma("unroll") for (int ks = 0; ks < 2; ++ks) _Pragma("unroll") for (int mi = 0; mi < 4; ++mi) _Pragma("unroll") for (int ni = 0; ni < 4; ++ni) \
            acc[mi][ni] = __builtin_amdgcn_mfma_f32_16x16x32_bf16(bfr[ks][ni], af[ks][mi], acc[mi][ni], 0, 0, 0); \
        __builtin_amdgcn_sched_barrier(0); } while (0)
    G_LOAD(0, 0);
    G_STORE(0, lds);
    if (KT > 1) G_LOAD(0, 1);
    if (KT > 2) G_LOAD(1, 2);
    __syncthreads();
    for (int kt = 0; kt < KT; kt += 2) {
        G_COMPUTE(lds);
        if (kt + 1 < KT) G_STORE(0, lds + G_BUF);
        if (kt + 3 < KT) G_LOAD(0, kt + 3);
        __syncthreads();
        if (kt + 1 < KT) {
            G_COMPUTE(lds + G_BUF);
            if (kt + 2 < KT) G_STORE(1, lds);
            if (kt + 4 < KT) G_LOAD(1, kt + 4);
            __syncthreads();
        }
    }
#undef G_LOAD
#undef G_STORE
#undef G_COMPUTE
    epi(acc, wm * 64 + (lane & 15), wn * 64 + 4 * (lane >> 4));
}

constexpr int G2_BN = 256, G2_BBYTES = G2_BN * G_BK * 2, G2_BUF = G_ABYTES + G2_BBYTES;

struct RowLinear { int m0; __device__ __forceinline__ int src(int r) const { return m0 + r; } };
struct RowList {
    const int* list; int cnt; int shift;
    __device__ __forceinline__ int src(int r) const { const int a = list[r < cnt ? r : 0]; return a >> shift; }
};
struct EpiStoreBf16 {
    bf16_t* C; int ldc; int m0; int n0; int N;
    template <int NI> __device__ __forceinline__ void operator()(const f32x4 (&acc)[4][NI], int rbase, int cbase) const {
#pragma unroll
        for (int mi = 0; mi < 4; ++mi) {
            bf16_t* rowp = C + (size_t)(m0 + rbase + mi * 16) * ldc + n0 + cbase;
#pragma unroll
            for (int ni = 0; ni < NI; ++ni) {
                if (n0 + cbase + ni * 16 < N) { u32x2 v; v.x = pk2(acc[mi][ni][0], acc[mi][ni][1]); v.y = pk2(acc[mi][ni][2], acc[mi][ni][3]); *(u32x2*)(rowp + ni * 16) = v; }
            }
        }
    }
};
struct EpiSwiGLU {
    bf16_t* H; const int* list; int cnt; int n0;
    template <int NI> __device__ __forceinline__ void operator()(const f32x4 (&acc)[4][NI], int rbase, int cbase) const {
#pragma unroll
        for (int mi = 0; mi < 4; ++mi) {
            const int r = rbase + mi * 16;
            if (r < cnt) {
                const int a = list[r];
                const int wnb = cbase & ~63, q4 = cbase & 63;
                bf16_t* rowp = H + (size_t)a * DEXP + ((n0 + wnb) >> 1) + q4;
#pragma unroll
                for (int q = 0; q < NI / 2; ++q) {
                    float o[4];
#pragma unroll
                    for (int j = 0; j < 4; ++j) o[j] = siluf_(acc[mi][2 * q][j]) * acc[mi][2 * q + 1][j];
                    u32x2 v; v.x = pk2(o[0], o[1]); v.y = pk2(o[2], o[3]); *(u32x2*)(rowp + q * 16) = v;
                }
            }
        }
    }
};
struct EpiScatterBf16 {
    bf16_t* C; const int* list; int cnt; int n0;
    template <int NI> __device__ __forceinline__ void operator()(const f32x4 (&acc)[4][NI], int rbase, int cbase) const {
#pragma unroll
        for (int mi = 0; mi < 4; ++mi) {
            const int r = rbase + mi * 16;
            if (r < cnt) {
                bf16_t* rowp = C + (size_t)list[r] * D + n0 + cbase;
#pragma unroll
                for (int ni = 0; ni < NI; ++ni) { u32x2 v; v.x = pk2(acc[mi][ni][0], acc[mi][ni][1]); v.y = pk2(acc[mi][ni][2], acc[mi][ni][3]); *(u32x2*)(rowp + ni * 16) = v; }
            }
        }
    }
};
struct EpiDecay {
    float* Dc; const float* w0; int m0; int n0;
    template <int NI> __device__ __forceinline__ void operator()(const f32x4 (&acc)[4][NI], int rbase, int cbase) const {
#pragma unroll
        for (int ni = 0; ni < NI; ++ni) {
            const int col = n0 + cbase + ni * 16;
            const f32x4 w0v = *(const f32x4*)(w0 + col);
#pragma unroll
            for (int mi = 0; mi < 4; ++mi) {
                f32x4 o;
#pragma unroll
                for (int j = 0; j < 4; ++j) { const float w = w0v[j] + acc[mi][ni][j]; o[j] = __expf(-__expf(-softplus_fast(-w) - 0.5f)); }
                *(f32x4*)(Dc + (size_t)(m0 + rbase + mi * 16) * 512 + col) = o;
            }
        }
    }
};
struct EpiAK {
    bf16_t* Kb; const bf16_t* KKb; bf16_t* Bb; const float* a0; const float* k_a; int m0; int n0;
    template <int NI> __device__ __forceinline__ void operator()(const f32x4 (&acc)[4][NI], int rbase, int cbase) const {
#pragma unroll
        for (int ni = 0; ni < NI; ++ni) {
            const int col = n0 + cbase + ni * 16;
            const f32x4 a0v = *(const f32x4*)(a0 + col), kav = *(const f32x4*)(k_a + col);
#pragma unroll
            for (int mi = 0; mi < 4; ++mi) {
                const size_t off = (size_t)(m0 + rbase + mi * 16) * 512 + col;
                const u32x2 kr = *(const u32x2*)(Kb + off), kkr = *(const u32x2*)(KKb + off);
                const float kf[4] = {bflo(kr.x), bfhi(kr.x), bflo(kr.y), bfhi(kr.y)}, kkf[4] = {bflo(kkr.x), bfhi(kkr.x), bflo(kkr.y), bfhi(kkr.y)};
                float k2[4], bb[4];
#pragma unroll
                for (int j = 0; j < 4; ++j) { const float a = sigmoidf_(a0v[j] + acc[mi][ni][j]); k2[j] = kf[j] * (1.f + (a - 1.f) * kav[j]); bb[j] = kkf[j] * a; }
                u32x2 v; v.x = pk2(k2[0], k2[1]); v.y = pk2(k2[2], k2[3]); *(u32x2*)(Kb + off) = v;
                v.x = pk2(bb[0], bb[1]); v.y = pk2(bb[2], bb[3]); *(u32x2*)(Bb + off) = v;
            }
        }
    }
};

namespace pg8 {
#define PG8_LAS __attribute__((address_space(3)))
constexpr int BM = 256, BK = 64, HALF = 128, HTB = HALF * BK * 2, STAGE_BYTES = 8 * HTB, NXCD = 8, WGM = 8;
__host__ __device__ __forceinline__ int lds_byte(int r, int c) { const int st = (r >> 4) * 2 + (c >> 5), rr = r & 15, cc = c & 31, ob = rr * 64 + cc * 2; return st * 1024 + (ob ^ (((ob >> 9) & 1) << 5)); }
__host__ __device__ __forceinline__ void stage_rc(int b, int& R, int& C) { const int st = b / 1024, sb = b % 1024, swz = sb ^ (((sb >> 9) & 1) << 5); R = (st >> 1) * 16 + swz / 64; C = (st & 1) * 32 + (swz % 64) / 2; }
__host__ __device__ __forceinline__ int perm32(int rho) { const int n = rho >> 4, i = rho & 15; return 8 * (i >> 2) + 4 * n + (i & 3); }
struct Unit { int pm, pn; };
struct Gemm { const bf16_t* A; const bf16_t* Bt; int M, N, K; };
struct StaticOrder {
    int nM, nN, nwg, G, c;
    __host__ __device__ void init(int M, int N, int G_, int c_) { nM = M / BM; nN = N / BM; nwg = nM * nN; G = G_; c = c_; }
    __host__ __device__ bool next(int i, Unit& u) const {
        const long L = (long)i * G + c; if (L >= nwg) return false;
        int wgid = (int)L; { const int q = nwg / NXCD, r = nwg % NXCD, xcd = wgid % NXCD, off = wgid / NXCD; wgid = (xcd < r ? xcd * (q + 1) : r * (q + 1) + (xcd - r) * q) + off; }
        const int nig = WGM * nN, gid = wgid / nig, fm = gid * WGM, gsz = (nM - fm) < WGM ? (nM - fm) : WGM;
        u.pm = fm + ((wgid % nig) % gsz); u.pn = (wgid % nig) / gsz; return true;
    }
    __device__ __forceinline__ void a_ready(const Unit&) const {}
    __device__ __forceinline__ void done(const Unit&) const {}
};
struct EpiStoreP {
    static constexpr bool PERM = true, AFTER_DRAIN = false;
    bf16_t* O; int ldc;
    __device__ __forceinline__ void operator()(const f32x4 (&acc)[2][2][4][2], const Unit& u, int wr, int wc, int fr, int fq) const {
        const int row0 = u.pm * BM + wr * 64 + fr, col0 = u.pn * BM + wc * 32 + 8 * fq;
#pragma unroll
        for (int ai = 0; ai < 2; ++ai)
#pragma unroll
            for (int m = 0; m < 4; ++m) { bf16_t* rowp = O + (size_t)(row0 + ai * HALF + m * 16) * ldc + col0;
#pragma unroll
                for (int bj = 0; bj < 2; ++bj) { const f32x4 v0 = acc[ai][bj][m][0], v1 = acc[ai][bj][m][1];
                    u32x4 w; w.x = pk2(v0[0], v0[1]); w.y = pk2(v0[2], v0[3]); w.z = pk2(v1[0], v1[1]); w.w = pk2(v1[2], v1[3]);
                    *(u32x4*)(rowp + bj * HALF) = w; } }
    }
};
template <class Epi, class Sched>
__device__ __forceinline__ void gemm_phase(int wv, PG8_LAS unsigned char* lds, const Gemm g, const Sched& S, const Epi& E) {
    const int tid = ltid(wv), wid = __builtin_amdgcn_readfirstlane(tid >> 6), lane = tid & 63, wr = wid >> 2, wc = wid & 3, fr = lane & 15, fq = lane >> 4;
    const int K = g.K, nt = K / BK;
    unsigned voffA[2], voffB[2];
#pragma unroll
    for (int i = 0; i < 2; ++i) { int R, C; stage_rc(tid * 16 + i * 8192, R, C); const int Rb = Epi::PERM ? ((R & ~31) + perm32(R & 31)) : R;
        voffA[i] = (unsigned)(R * K + C) * 2u; voffB[i] = (unsigned)(Rb * K + C) * 2u; }
    const size_t kstep = (size_t)(BK * 2);
    const size_t hstep = (size_t)HALF * K * 2;
    const size_t tstep = 2 * hstep;
    const unsigned ldsw = (unsigned)wid * 1024u;
    const int aoff = lds_byte(wr * 64 + fr, fq * 8), boff = lds_byte(wc * 32 + fr, fq * 8);
#define PG8_SA(b, h) (((b) * 2 + (h)) * HTB)
#define PG8_SB(b, h) ((4 + (b) * 2 + (h)) * HTB)
#define PG8_STAGE(bufoff, gbase, voff) do { _Pragma("unroll") for (int _i = 0; _i < 2; ++_i) \
        __builtin_amdgcn_global_load_lds((const unsigned*)((const char*)(gbase) + (voff)[_i]), (PG8_LAS unsigned*)(lds + (bufoff) + ldsw + _i * 8192), 16, 0, 0); } while (0)
#define PG8_LDA(dst, b, h) do { _Pragma("unroll") for (int m = 0; m < 4; ++m) _Pragma("unroll") for (int k = 0; k < 2; ++k) dst[m][k] = *(const PG8_LAS bf16x8*)(lds + PG8_SA(b, h) + aoff + m * 2048 + k * 1024); } while (0)
#define PG8_LDB(dst, b, h) do { _Pragma("unroll") for (int n = 0; n < 2; ++n) _Pragma("unroll") for (int k = 0; k < 2; ++k) dst[n][k] = *(const PG8_LAS bf16x8*)(lds + PG8_SB(b, h) + boff + n * 2048 + k * 1024); } while (0)
#define PG8_MMA(ai, bj, At, Bt) do { __builtin_amdgcn_s_setprio(1); _Pragma("unroll") for (int m = 0; m < 4; ++m) _Pragma("unroll") for (int n = 0; n < 2; ++n) _Pragma("unroll") for (int k = 0; k < 2; ++k) \
        acc[ai][bj][m][n] = __builtin_amdgcn_mfma_f32_16x16x32_bf16(Bt[n][k], At[m][k], acc[ai][bj][m][n], 0, 0, 0); __builtin_amdgcn_s_setprio(0); } while (0)
#define PG8_WAIT_V(n) asm volatile("s_waitcnt vmcnt(" #n ")" ::: "memory")
#define PG8_WAIT_L(n) asm volatile("s_waitcnt lgkmcnt(" #n ")" ::: "memory")
#define PG8_BAR __builtin_amdgcn_s_barrier()
#define PG8_SCHED __builtin_amdgcn_sched_barrier(0)
    Unit cur, nxt; int ui = 0;
    if (!S.next(0, cur)) return;
    f32x4 acc[2][2][4][2];
#pragma unroll
    for (int a = 0; a < 2; ++a)
#pragma unroll
        for (int b = 0; b < 2; ++b)
#pragma unroll
            for (int m = 0; m < 4; ++m)
#pragma unroll
                for (int n = 0; n < 2; ++n) acc[a][b][m][n] = (f32x4){0.f, 0.f, 0.f, 0.f};
    bf16x8 At[4][2], B0[2][2], B1[2][2];
    const char* cA = (const char*)g.A + (size_t)cur.pm * tstep; const char* cB = (const char*)g.Bt + (size_t)cur.pn * tstep;
    S.a_ready(cur);
    PG8_STAGE(PG8_SB(0, 0), cB, voffB); PG8_STAGE(PG8_SA(0, 0), cA, voffA); PG8_STAGE(PG8_SB(0, 1), cB + hstep, voffB); PG8_STAGE(PG8_SA(0, 1), cA + hstep, voffA);
    if (wr == 1) PG8_BAR;
    PG8_WAIT_V(4); PG8_BAR;
    PG8_STAGE(PG8_SB(1, 0), cB + kstep, voffB); PG8_STAGE(PG8_SA(1, 0), cA + kstep, voffA); PG8_STAGE(PG8_SB(1, 1), cB + hstep + kstep, voffB);
    PG8_WAIT_V(6); PG8_BAR;
    for (;;) {
        const bool has_next = S.next(ui + 1, nxt);
        const char* nA = has_next ? (const char*)g.A + (size_t)nxt.pm * tstep : cA; const char* nB = has_next ? (const char*)g.Bt + (size_t)nxt.pn * tstep : cB;
        for (int t = 0; t < nt; t += 2) {
            const bool last = (t == nt - 2);
            const char* a1 = cA + (size_t)(t + 1) * kstep;
            const char* a2 = last ? nA : cA + (size_t)(t + 2) * kstep; const char* b2 = last ? nB : cB + (size_t)(t + 2) * kstep;
            const char* a3 = a2 + kstep; const char* b3 = b2 + kstep;
            if (last && has_next) S.a_ready(nxt);
            PG8_LDB(B0, 0, 0); PG8_SCHED; PG8_LDA(At, 0, 0); PG8_STAGE(PG8_SA(1, 1), a1 + hstep, voffA);
            PG8_WAIT_L(8); PG8_BAR; PG8_WAIT_L(0); PG8_MMA(0, 0, At, B0); PG8_BAR; PG8_SCHED;
            PG8_LDB(B1, 0, 1); PG8_STAGE(PG8_SB(0, 0), b2, voffB);
            PG8_BAR; PG8_WAIT_L(0); PG8_MMA(0, 1, At, B1); PG8_BAR;
            PG8_LDA(At, 0, 1); PG8_STAGE(PG8_SA(0, 0), a2, voffA);
            PG8_BAR; PG8_WAIT_L(0); PG8_MMA(1, 0, At, B0); PG8_BAR; PG8_SCHED;
            PG8_STAGE(PG8_SB(0, 1), b2 + hstep, voffB);
            PG8_WAIT_V(6); PG8_BAR; PG8_MMA(1, 1, At, B1); PG8_BAR;
            PG8_LDB(B0, 1, 0); PG8_SCHED; PG8_LDA(At, 1, 0); PG8_STAGE(PG8_SA(0, 1), a2 + hstep, voffA);
            PG8_WAIT_L(8); PG8_BAR; PG8_WAIT_L(0); PG8_MMA(0, 0, At, B0); PG8_BAR; PG8_SCHED;
            PG8_LDB(B1, 1, 1); PG8_STAGE(PG8_SB(1, 0), b3, voffB);
            PG8_BAR; PG8_WAIT_L(0); PG8_MMA(0, 1, At, B1); PG8_BAR;
            PG8_LDA(At, 1, 1); PG8_STAGE(PG8_SA(1, 0), a3, voffA);
            PG8_BAR; PG8_WAIT_L(0); PG8_MMA(1, 0, At, B0); PG8_BAR; PG8_SCHED;
            PG8_STAGE(PG8_SB(1, 1), b3 + hstep, voffB);
            PG8_WAIT_V(6); PG8_BAR; PG8_MMA(1, 1, At, B1); PG8_BAR;
        }
            if constexpr (!Epi::AFTER_DRAIN) { E(acc, cur, wr, wc, fr, fq); S.done(cur); }
            if (!has_next) break;
#pragma unroll
        for (int a = 0; a < 2; ++a)
#pragma unroll
            for (int b = 0; b < 2; ++b)
#pragma unroll
                for (int m = 0; m < 4; ++m)
#pragma unroll
                    for (int n = 0; n < 2; ++n) acc[a][b][m][n] = (f32x4){0.f, 0.f, 0.f, 0.f};
        cur = nxt; cA = nA; cB = nB; ++ui;
    }
    PG8_WAIT_V(0);
    if (wr == 0) PG8_BAR;
    PG8_BAR;
    if constexpr (Epi::AFTER_DRAIN) { E.fused(acc, cur, wr, wc, fr, fq, lds, wid, lane); S.done(cur); }
#undef PG8_SA
#undef PG8_SB
#undef PG8_STAGE
#undef PG8_LDA
#undef PG8_LDB
#undef PG8_MMA
#undef PG8_WAIT_V
#undef PG8_WAIT_L
#undef PG8_BAR
#undef PG8_SCHED
}
struct UnitG { int pm, pn; const char* bbase; const PG8_LAS int* ltab; int cnt; int e; };
struct MoeOrder {
    const PG8_LAS int* tstart; const PG8_LAS int* tcnt; const PG8_LAS int* ltabs; const int* lists; const char* bt; size_t estride; int ncol, shift, G, c;
    __device__ __forceinline__ bool next(int i, UnitG& u) const {
        const int t = i * G + c; if (t >= tstart[32] * ncol) return false;
        const int tm = t / ncol; int e = 0;
#pragma unroll 1
        while (tstart[e + 1] <= tm) ++e;
        e = __builtin_amdgcn_readfirstlane(e);
        const int ts = __builtin_amdgcn_readfirstlane(tstart[e]), tc = __builtin_amdgcn_readfirstlane(tcnt[e]);
        u.pm = tm - ts; u.pn = t - tm * ncol; u.bbase = bt + (size_t)e * estride; u.e = e; u.cnt = tc - u.pm * BM; u.ltab = ltabs + i * BM;
        return true;
    }
    __device__ __forceinline__ void a_ready(const UnitG&) const {}
    __device__ __forceinline__ void done(const UnitG&) const {}
};
struct EpiSwiGLUG {
    static constexpr bool PERM = false, AFTER_DRAIN = false;
    bf16_t* H;
    __device__ __forceinline__ void operator()(const f32x4 (&acc)[2][2][4][2], const UnitG& u, int wr, int wc, int fr, int fq) const {
#pragma unroll
        for (int ai = 0; ai < 2; ++ai)
#pragma unroll
            for (int m = 0; m < 4; ++m) { const int r = ai * HALF + wr * 64 + m * 16 + fr;
                if (r < u.cnt) { bf16_t* rowp = H + (size_t)u.ltab[r] * DEXP + ((u.pn * BM + wc * 32) >> 1) + 4 * fq;
#pragma unroll
                    for (int bj = 0; bj < 2; ++bj) { const f32x4 gt = acc[ai][bj][m][0], up = acc[ai][bj][m][1];
                        u32x2 w; w.x = pk2(siluf_(gt[0]) * up[0], siluf_(gt[1]) * up[1]); w.y = pk2(siluf_(gt[2]) * up[2], siluf_(gt[3]) * up[3]);
                        *(u32x2*)(rowp + bj * (HALF / 2)) = w; } } }
    }
};
struct EpiScatterG {
    static constexpr bool PERM = true, AFTER_DRAIN = false;
    bf16_t* O;
    __device__ __forceinline__ void operator()(const f32x4 (&acc)[2][2][4][2], const UnitG& u, int wr, int wc, int fr, int fq) const {
#pragma unroll
        for (int ai = 0; ai < 2; ++ai)
#pragma unroll
            for (int m = 0; m < 4; ++m) { const int r = ai * HALF + wr * 64 + m * 16 + fr;
                if (r < u.cnt) { bf16_t* rowp = O + (size_t)u.ltab[r] * D + u.pn * BM + wc * 32 + 8 * fq;
#pragma unroll
                    for (int bj = 0; bj < 2; ++bj) { const f32x4 v0 = acc[ai][bj][m][0], v1 = acc[ai][bj][m][1];
                        u32x4 w; w.x = pk2(v0[0], v0[1]); w.y = pk2(v0[2], v0[3]); w.z = pk2(v1[0], v1[1]); w.w = pk2(v1[2], v1[3]);
                        *(u32x4*)(rowp + bj * HALF) = w; } } }
    }
};
template <class Epi, class Sched>
__device__ __forceinline__ void gemm_phase_g(int wv, PG8_LAS unsigned char* lds, const Gemm g, const Sched& S, const Epi& E) {
    const int tid = ltid(wv), wid = __builtin_amdgcn_readfirstlane(tid >> 6), lane = tid & 63, wr = wid >> 2, wc = wid & 3, fr = lane & 15, fq = lane >> 4;
    const int K = g.K, nt = K / BK;
    unsigned voffB[2];
#pragma unroll
    for (int i = 0; i < 2; ++i) { int R, C; stage_rc(tid * 16 + i * 8192, R, C); const int Rb = Epi::PERM ? ((R & ~31) + perm32(R & 31)) : R;
        voffB[i] = (unsigned)(Rb * K + C) * 2u; }
    const unsigned rowb = (unsigned)K * 2u;
#define PG8_AOFFS(u, dst) do { const int _t = ltid(wv); _Pragma("unroll") for (int _i = 0; _i < 2; ++_i) { int _R, _C; stage_rc(_t * 16 + _i * 8192, _R, _C); \
        _Pragma("unroll") for (int _h = 0; _h < 2; ++_h) dst[_h][_i] = (unsigned)((u).ltab[_h * HALF + _R] >> S.shift) * rowb + (unsigned)(_C * 2); } } while (0)
#define PG8_STAGE_A(bufoff, AO, koff) do { _Pragma("unroll") for (int _i = 0; _i < 2; ++_i) \
        __builtin_amdgcn_global_load_lds((const unsigned*)((const char*)g.A + (size_t)(AO)[_i] + (size_t)(koff)), (PG8_LAS unsigned*)(lds + (bufoff) + ldsw + _i * 8192), 16, 0, 0); } while (0)
    const size_t kstep = (size_t)(BK * 2);
    const size_t hstep = (size_t)HALF * K * 2;
    const size_t tstep = 2 * hstep;
    const unsigned ldsw = (unsigned)wid * 1024u;
    const int aoff = lds_byte(wr * 64 + fr, fq * 8), boff = lds_byte(wc * 32 + fr, fq * 8);
#define PG8_SA(b, h) (((b) * 2 + (h)) * HTB)
#define PG8_SB(b, h) ((4 + (b) * 2 + (h)) * HTB)
#define PG8_STAGE(bufoff, gbase, voff) do { _Pragma("unroll") for (int _i = 0; _i < 2; ++_i) \
        __builtin_amdgcn_global_load_lds((const unsigned*)((const char*)(gbase) + (voff)[_i]), (PG8_LAS unsigned*)(lds + (bufoff) + ldsw + _i * 8192), 16, 0, 0); } while (0)
#define PG8_LDA(dst, b, h) do { _Pragma("unroll") for (int m = 0; m < 4; ++m) _Pragma("unroll") for (int k = 0; k < 2; ++k) dst[m][k] = *(const PG8_LAS bf16x8*)(lds + PG8_SA(b, h) + aoff + m * 2048 + k * 1024); } while (0)
#define PG8_LDB(dst, b, h) do { _Pragma("unroll") for (int n = 0; n < 2; ++n) _Pragma("unroll") for (int k = 0; k < 2; ++k) dst[n][k] = *(const PG8_LAS bf16x8*)(lds + PG8_SB(b, h) + boff + n * 2048 + k * 1024); } while (0)
#define PG8_MMA(ai, bj, At, Bt) do { __builtin_amdgcn_s_setprio(1); _Pragma("unroll") for (int m = 0; m < 4; ++m) _Pragma("unroll") for (int n = 0; n < 2; ++n) _Pragma("unroll") for (int k = 0; k < 2; ++k) \
        acc[ai][bj][m][n] = __builtin_amdgcn_mfma_f32_16x16x32_bf16(Bt[n][k], At[m][k], acc[ai][bj][m][n], 0, 0, 0); __builtin_amdgcn_s_setprio(0); } while (0)
#define PG8_WAIT_V(n) asm volatile("s_waitcnt vmcnt(" #n ")" ::: "memory")
#define PG8_WAIT_L(n) asm volatile("s_waitcnt lgkmcnt(" #n ")" ::: "memory")
#define PG8_BAR __builtin_amdgcn_s_barrier()
#define PG8_SCHED __builtin_amdgcn_sched_barrier(0)
    UnitG cur, nxt; int ui = 0;
    if (!S.next(0, cur)) return;
    f32x4 acc[2][2][4][2];
#pragma unroll
    for (int a = 0; a < 2; ++a)
#pragma unroll
        for (int b = 0; b < 2; ++b)
#pragma unroll
            for (int m = 0; m < 4; ++m)
#pragma unroll
                for (int n = 0; n < 2; ++n) acc[a][b][m][n] = (f32x4){0.f, 0.f, 0.f, 0.f};
    bf16x8 At[4][2], B0[2][2], B1[2][2];
    unsigned ca[2][2]; PG8_AOFFS(cur, ca); const char* cB = cur.bbase + (size_t)cur.pn * tstep;
    S.a_ready(cur);
    PG8_STAGE(PG8_SB(0, 0), cB, voffB); PG8_STAGE_A(PG8_SA(0, 0), ca[0], 0); PG8_STAGE(PG8_SB(0, 1), cB + hstep, voffB); PG8_STAGE_A(PG8_SA(0, 1), ca[1], 0);
    if (wr == 1) PG8_BAR;
    PG8_WAIT_V(4); PG8_BAR;
    PG8_STAGE(PG8_SB(1, 0), cB + kstep, voffB); PG8_STAGE_A(PG8_SA(1, 0), ca[0], kstep); PG8_STAGE(PG8_SB(1, 1), cB + hstep + kstep, voffB);
    PG8_WAIT_V(6); PG8_BAR;
    for (;;) {
        const bool has_next = S.next(ui + 1, nxt);
        const char* nB = has_next ? nxt.bbase + (size_t)nxt.pn * tstep : cB;
        for (int t = 0; t < nt; t += 2) {
            const bool last = (t == nt - 2);
            const size_t k1 = (size_t)(t + 1) * kstep, k2 = last ? 0 : (size_t)(t + 2) * kstep;
            unsigned a2o[2][2];
            if (last && has_next) PG8_AOFFS(nxt, a2o); else { a2o[0][0] = ca[0][0]; a2o[0][1] = ca[0][1]; a2o[1][0] = ca[1][0]; a2o[1][1] = ca[1][1]; }
            const char* b2 = last ? nB : cB + (size_t)(t + 2) * kstep; const char* b3 = b2 + kstep;
            if (last && has_next) S.a_ready(nxt);
            PG8_LDB(B0, 0, 0); PG8_SCHED; PG8_LDA(At, 0, 0); PG8_STAGE_A(PG8_SA(1, 1), ca[1], k1);
            PG8_WAIT_L(8); PG8_BAR; PG8_WAIT_L(0); PG8_MMA(0, 0, At, B0); PG8_BAR; PG8_SCHED;
            PG8_LDB(B1, 0, 1); PG8_STAGE(PG8_SB(0, 0), b2, voffB);
            PG8_BAR; PG8_WAIT_L(0); PG8_MMA(0, 1, At, B1); PG8_BAR;
            PG8_LDA(At, 0, 1); PG8_STAGE_A(PG8_SA(0, 0), a2o[0], k2);
            PG8_BAR; PG8_WAIT_L(0); PG8_MMA(1, 0, At, B0); PG8_BAR; PG8_SCHED;
            PG8_STAGE(PG8_SB(0, 1), b2 + hstep, voffB);
            PG8_WAIT_V(6); PG8_BAR; PG8_MMA(1, 1, At, B1); PG8_BAR;
            PG8_LDB(B0, 1, 0); PG8_SCHED; PG8_LDA(At, 1, 0); PG8_STAGE_A(PG8_SA(0, 1), a2o[1], k2);
            PG8_WAIT_L(8); PG8_BAR; PG8_WAIT_L(0); PG8_MMA(0, 0, At, B0); PG8_BAR; PG8_SCHED;
            PG8_LDB(B1, 1, 1); PG8_STAGE(PG8_SB(1, 0), b3, voffB);
            PG8_BAR; PG8_WAIT_L(0); PG8_MMA(0, 1, At, B1); PG8_BAR;
            PG8_LDA(At, 1, 1); PG8_STAGE_A(PG8_SA(1, 0), a2o[0], k2 + kstep);
            PG8_BAR; PG8_WAIT_L(0); PG8_MMA(1, 0, At, B0); PG8_BAR; PG8_SCHED;
            PG8_STAGE(PG8_SB(1, 1), b3 + hstep, voffB);
            PG8_WAIT_V(6); PG8_BAR; PG8_MMA(1, 1, At, B1); PG8_BAR;
            if (last) { ca[0][0] = a2o[0][0]; ca[0][1] = a2o[0][1]; ca[1][0] = a2o[1][0]; ca[1][1] = a2o[1][1]; }
        }
            if constexpr (!Epi::AFTER_DRAIN) { E(acc, cur, wr, wc, fr, fq); S.done(cur); }
            if (!has_next) break;
#pragma unroll
        for (int a = 0; a < 2; ++a)
#pragma unroll
            for (int b = 0; b < 2; ++b)
#pragma unroll
                for (int m = 0; m < 4; ++m)
#pragma unroll
                    for (int n = 0; n < 2; ++n) acc[a][b][m][n] = (f32x4){0.f, 0.f, 0.f, 0.f};
        cur = nxt; cB = nB; ++ui;
    }
    PG8_WAIT_V(0);
    if (wr == 0) PG8_BAR;
    PG8_BAR;
    if constexpr (Epi::AFTER_DRAIN) { E.fused(acc, cur, wr, wc, fr, fq, lds, wid, lane); S.done(cur); }
#undef PG8_SA
#undef PG8_AOFFS
#undef PG8_STAGE_A
#undef PG8_SB
#undef PG8_STAGE
#undef PG8_LDA
#undef PG8_LDB
#undef PG8_MMA
#undef PG8_WAIT_V
#undef PG8_WAIT_L
#undef PG8_BAR
#undef PG8_SCHED
}
}

__device__ __forceinline__ void transpose_item(const float* __restrict__ W, int K, int N, bf16_t* __restrict__ WT, int mode, LAS float* scr, int item, int lane) {
    const int nblk = N / 32, kb = item / nblk, nb = item % nblk, k0 = 64 * kb, n0 = 32 * nb;
    {
        const float* wp = W + (size_t)(k0 + (lane >> 5)) * N + n0 + (lane & 31);
        float t[32];
#pragma unroll
        for (int i = 0; i < 32; ++i) t[i] = wp[(size_t)(2 * i) * N];
#pragma unroll
        for (int i = 0; i < 32; ++i) scr[(2 * i + (lane >> 5)) * 33 + (lane & 31)] = t[i];
    }
    asm volatile("s_waitcnt lgkmcnt(0)" ::: "memory");
    const int c = lane & 7;
#pragma unroll
    for (int j = 0; j < 4; ++j) {
        const int nl = (lane >> 3) + 8 * j; const LAS float* s = scr + (8 * c) * 33 + nl;
        u32x4 o; o.x = pk2(s[0 * 33], s[1 * 33]); o.y = pk2(s[2 * 33], s[3 * 33]); o.z = pk2(s[4 * 33], s[5 * 33]); o.w = pk2(s[6 * 33], s[7 * 33]);
        const int n = n0 + nl;
        const int nd = mode == 0 ? n : (32 * (n >> 4) + (n & 15) + (mode == 2 ? 16 : 0));
        *(u32x4*)(WT + (size_t)nd * K + k0 + 8 * c) = o;
    }
    asm volatile("s_waitcnt lgkmcnt(0)" ::: "memory");
}

constexpr int EXC_IG = 16 * 16, EXC_IDN = 8 * 32, EXC_PER = 2 * EXC_IG + EXC_IDN, EXC_ITEMS = NEXP * EXC_PER;
__device__ __forceinline__ int exc_s0(int layer) { return (layer & 1) ? 8192 : 10240; }
__device__ __forceinline__ int exc_s1(int layer) { return layer == DEPTH - 1 ? 0 : 7168; }
__device__ __forceinline__ void expconv_items(const CAS Params& P, int layer, LAS char* lds, int lo, int hi, int worker, int nworkers, int wid, int lane) {
    LAS float* scr = (LAS float*)(lds + wid * 8448);
    bf16_t* gu = (bf16_t*)(P.ws + WS_EXPGU); bf16_t* dw = (bf16_t*)(P.ws + WS_EXPD);
    for (int it = lo + worker; it < hi; it += nworkers) {
        const int e = it / EXC_PER; int r = it % EXC_PER;
        const size_t eo = (size_t)(layer * NEXP + e);
        if (r < EXC_IG) { transpose_item(P.exp_w_gate + eo * D * DEXP, D, DEXP, gu + (size_t)e * 1024 * 1024, 1, scr, r, lane); continue; } r -= EXC_IG;
        if (r < EXC_IG) { transpose_item(P.exp_w_up + eo * D * DEXP, D, DEXP, gu + (size_t)e * 1024 * 1024, 2, scr, r, lane); continue; } r -= EXC_IG;
        transpose_item(P.exp_w_down + eo * DEXP * D, DEXP, D, dw + (size_t)e * 1024 * 512, 0, scr, r, lane);
    }
}
__device__ __forceinline__ void expconv_tail(int wv, const CAS Params& P, int layer, LAS char* lds, int nwg, int lo, int hi) {
    const int G = gridDim.x, rem = nwg % G;
    if (rem != 0 && (int)blockIdx.x >= rem && lo < hi) {
        const int tid = ltid(wv);
        __syncthreads();
        expconv_items(P, layer, lds, lo, hi, ((int)blockIdx.x - rem) * 8 + (tid >> 6), (G - rem) * 8, tid >> 6, tid & 63);
    }
}

__device__ __forceinline__ void phase_prologue0(int wv, KP Pk, LAS char* lds) {
    asm volatile("" : "+s"(Pk));
    const CAS Params& P = *Pk;
    const int tid = ltid(wv), lane = tid & 63, wid = tid >> 6;
    const int gw = blockIdx.x * 8 + wid, NGW = gridDim.x * 8;
    LAS float* scr = (LAS float*)(lds + wid * 8448);
    bf16_t* winT = (bf16_t*)(P.ws + WS_WINT);
    bf16_t* woutT = (bf16_t*)(P.ws + WS_WOUTT);
    bf16_t* loraT = (bf16_t*)(P.ws + WS_LORAT);
    constexpr int I_EV = 16 * (P_EVEN / 32), I_OD = 16 * (P_ODD / 32), I_O = 16 * 32, I_L64 = 16, I_L128 = 32;
    constexpr int I_LORA = 3 * I_L64 + I_L128;
    constexpr int NIT = 2 * I_EV + 2 * I_OD + 4 * I_O + 2 * I_LORA;
    for (int it = gw; it < NIT; it += NGW) {
        int r = it;
        if (r < 2 * I_EV) { const int i = r / I_EV; transpose_item(P.ev_w_in + (size_t)i * D * P_EVEN, D, P_EVEN, winT + (i ? WINT_L2 : WINT_L0), 0, scr, r % I_EV, lane); continue; } r -= 2 * I_EV;
        if (r < 2 * I_OD) { const int i = r / I_OD; transpose_item(P.od_w_in + (size_t)i * D * P_ODD, D, P_ODD, winT + (i ? WINT_L3 : WINT_L1), 0, scr, r % I_OD, lane); continue; } r -= 2 * I_OD;
        if (r < 4 * I_O) { const int l = r / I_O; const float* src = (l & 1) ? P.od_w_out + (size_t)(l >> 1) * D * D : P.ev_w_out + (size_t)(l >> 1) * D * D;
            transpose_item(src, D, D, woutT + (size_t)l * D * D, 0, scr, r % I_O, lane); continue; } r -= 4 * I_O;
        { const int i = r / I_LORA; int q = r % I_LORA; bf16_t* dst = loraT + (size_t)i * LORA_PER;
          if (q < I_L64) { transpose_item(P.rw_w2 + (size_t)(i * 2 + 0) * 64 * 512, 64, 512, dst, 0, scr, q, lane); continue; } q -= I_L64;
          if (q < I_L64) { transpose_item(P.rw_w2 + (size_t)(i * 2 + 1) * 64 * 512, 64, 512, dst + 512 * 64, 0, scr, q, lane); continue; } q -= I_L64;
          if (q < I_L64) { transpose_item(P.rw_a2 + (size_t)i * 64 * 512, 64, 512, dst + 2 * 512 * 64, 0, scr, q, lane); continue; } q -= I_L64;
          transpose_item(P.rw_g2 + (size_t)i * 128 * 512, 128, 512, dst + 3 * 512 * 64, 0, scr, q, lane); }
    }
    {
        const int gt = blockIdx.x * NT + tid, NG = gridDim.x * NT;
        constexpr int PADE = (LDP_EVEN - P_EVEN) * D / 8, PADO = (LDP_ODD - P_ODD) * D / 8;
        for (int i = gt; i < 2 * PADE + 2 * PADO; i += NG) {
            int r = i; bf16_t* dst;
            if (r < 2 * PADE) { const int l = r / PADE; dst = winT + (l ? WINT_L2 : WINT_L0) + (size_t)P_EVEN * D + (size_t)(r % PADE) * 8; }
            else { r -= 2 * PADE; const int l = r / PADO; dst = winT + (l ? WINT_L3 : WINT_L1) + (size_t)P_ODD * D + (size_t)(r % PADO) * 8; }
            *(u32x4*)dst = (u32x4){0u, 0u, 0u, 0u};
        }
    }
    {
        const int gt = blockIdx.x * NT + tid, NG = gridDim.x * NT;
        float* lb = (float*)(P.ws + WS_LB);
        for (int ch = gt; ch < 512; ch += NG) {
            float lg[4], mx = -1e30f;
#pragma unroll
            for (int l = 0; l < 4; ++l) { lg[l] = P.hg_lb_logits[l * 512 + ch]; mx = fmaxf(mx, lg[l]); }
            float e[4], s = 0.f;
#pragma unroll
            for (int l = 0; l < 4; ++l) { e[l] = __expf(lg[l] - mx); s += e[l]; }
            float cum = 0.f;
#pragma unroll
            for (int l = 0; l < 4; ++l) { if (l > 0) cum += e[l] / s; lb[l * 512 + ch] = cum; }
        }
    }
    __syncthreads();
    {
        LAS float* sc = (LAS float*)lds;
        LAS float* red = (LAS float*)(lds + 5 * 1024 * 4);
        for (int i = tid; i < 5 * D; i += NT) { const int m = i >> 10, k = i & 1023; const float v = m < 4 ? P.c[m * D + k] : P.c_ctx[k]; sc[i] = siluf_(v); }
        __syncthreads();
        float* modv = (float*)(P.ws + WS_MODV);
        for (int cb = blockIdx.x; cb < 4 * 6144 / 96; cb += gridDim.x) {
            const int l = (cb * 96) / 6144, j0 = (cb * 96) % 6144;
            const int cg = tid % 24, kg = tid / 24;
            if (tid < 384) {
                const float* w = P.mod_w + (size_t)l * D * 6144 + (size_t)(kg * 64) * 6144 + j0 + 4 * cg;
                f32x4 a[5];
#pragma unroll
                for (int m = 0; m < 5; ++m) a[m] = (f32x4){0.f, 0.f, 0.f, 0.f};
#pragma unroll 1
                for (int k0 = 0; k0 < 64; k0 += 16) {
                    f32x4 wv4[16];
#pragma unroll
                    for (int u = 0; u < 16; ++u) wv4[u] = *(const f32x4*)(w + (size_t)(k0 + u) * 6144);
#pragma unroll
                    for (int u = 0; u < 16; ++u)
#pragma unroll
                        for (int m = 0; m < 5; ++m) a[m] += wv4[u] * sc[m * 1024 + kg * 64 + k0 + u];
                }
#pragma unroll
                for (int m = 0; m < 5; ++m) *(LAS f32x4*)(red + ((kg * 5 + m) * 96 + 4 * cg)) = a[m];
            }
            __syncthreads();
            if (tid < 480) {
                const int m = tid / 96, c = tid % 96;
                float sum = 0.f;
#pragma unroll
                for (int g = 0; g < 16; ++g) sum += red[(g * 5 + m) * 96 + c];
                modv[(size_t)(l * 5 + m) * 6144 + j0 + c] = sum + P.mod_b[l * 6144 + j0 + c];
            }
            __syncthreads();
        }
    }
}

__device__ __forceinline__ void phase_prologue1(int wv, KP Pk) {
    asm volatile("" : "+s"(Pk));
    const CAS Params& P = *Pk;
    const int tid = ltid(wv), lane = tid & 63, wid = tid >> 6;
    bf16_t* act = (bf16_t*)(P.ws + WS_ACT);
    f32x4 nv[4];
    auto fetch = [&](int rr) {
        const float* src = rr < NCTX ? P.ctx + (size_t)rr * D : P.x + (size_t)(rr - NCTX) * D;
#pragma unroll
        for (int i = 0; i < 4; ++i) nv[i] = *(const f32x4*)(src + 4 * lane + 256 * i);
    };
    const int stride = gridDim.x * 8;
    int r = blockIdx.x * 8 + wid;
    if (r < NROWS) fetch(r);
    for (; r < NROWS; r += stride) {
        const int m = row_mod(r);
        const f32x4 cv[4] = {nv[0], nv[1], nv[2], nv[3]};
        if (r + stride < NROWS) fetch(r + stride);
        const float* sh = modvec(P.ws, 0, m, 0); const float* sc = modvec(P.ws, 0, m, 1);
#pragma unroll
        for (int i = 0; i < 4; ++i) {
            const int c = 4 * lane + 256 * i;
            const f32x4 v = cv[i], s1 = *(const f32x4*)(sc + c), h1 = *(const f32x4*)(sh + c);
            u32x2 o; o.x = pk2(v[0] * (1.f + s1[0]) + h1[0], v[1] * (1.f + s1[1]) + h1[1]); o.y = pk2(v[2] * (1.f + s1[2]) + h1[2], v[3] * (1.f + s1[3]) + h1[3]);
            *(u32x2*)(act + (size_t)r * D + c) = o;
        }
    }
}

__device__ __forceinline__ void phase_inproj(int wv, KP Pk, int layer, LAS char* lds) {
    asm volatile("" : "+s"(Pk));
    const CAS Params& P = *Pk;
    const int odd = layer & 1, ldp = odd ? LDP_ODD : LDP_EVEN;
    const size_t woff = layer == 0 ? WINT_L0 : layer == 1 ? WINT_L1 : layer == 2 ? WINT_L2 : WINT_L3;
    pg8::Gemm g{(const bf16_t*)(P.ws + WS_ACT), (const bf16_t*)(P.ws + WS_WINT) + woff, NROWS, ldp, D};
    pg8::StaticOrder S; S.init(NROWS, ldp, (int)gridDim.x, (int)blockIdx.x);
    pg8::EpiStoreP E{(bf16_t*)(P.ws + WS_P), ldp};
    pg8::gemm_phase(wv, (PG8_LAS unsigned char*)lds, g, S, E);
    expconv_tail(wv, P, layer, lds, (NROWS / 256) * (ldp / 256), 0, exc_s0(layer));
}
__device__ __forceinline__ void phase_outproj(int wv, KP Pk, int layer, LAS char* lds) {
    asm volatile("" : "+s"(Pk));
    const CAS Params& P = *Pk;
    const int r0 = (layer == DEPTH - 1) ? NCTX : 0;
    pg8::Gemm g{(const bf16_t*)(P.ws + WS_FEAT) + (size_t)r0 * D, (const bf16_t*)(P.ws + WS_WOUTT) + (size_t)layer * D * D, NROWS - r0, D, D};
    pg8::StaticOrder S; S.init(NROWS - r0, D, (int)gridDim.x, (int)blockIdx.x);
    pg8::EpiStoreP E{(bf16_t*)(P.ws + WS_YO) + (size_t)r0 * D, D};
    pg8::gemm_phase(wv, (PG8_LAS unsigned char*)lds, g, S, E);
    expconv_tail(wv, P, layer, lds, ((NROWS - r0) / 256) * (D / 256), exc_s0(layer), exc_s0(layer) + exc_s1(layer));
}
__device__ __forceinline__ void phase_prep2(int wv, KP Pk, int layer, LAS char* lds) {
    asm volatile("" : "+s"(Pk));
    const CAS Params& P = *Pk;
    const int i = layer >> 1;
    const bf16_t* la = (const bf16_t*)(P.ws + WS_LA);
    const bf16_t* lt = (const bf16_t*)(P.ws + WS_LORAT) + (size_t)i * LORA_PER;
    constexpr int MT = NROWS / G_BM, NTL = 512 / G_BN;
    const int ntiles = 4 * MT * NTL;
    for (int t = blockIdx.x; t < ntiles; t += gridDim.x) {
        const int which = t / (MT * NTL), r = t % (MT * NTL), mt = r / NTL, nt = r % NTL;
        RowLinear rs{mt * G_BM};
        if (which < 2) {
            EpiDecay epi{(float*)(P.ws + WS_RWDEC) + (size_t)which * NROWS * 512, P.rw_w0 + (size_t)(i * 2 + which) * 512, mt * G_BM, nt * G_BN};
            gemm_tile(wv, la + which * 64, 320, rs, lt + (size_t)which * 512 * 64, 64, nt * G_BN, 64, epi, lds);
        } else if (which == 2) {
            EpiAK epi{(bf16_t*)(P.ws + WS_RWK), (const bf16_t*)(P.ws + WS_RWKK), (bf16_t*)(P.ws + WS_RWB), P.rw_a0 + i * 512, P.rw_k_a + i * 512, mt * G_BM, nt * G_BN};
            gemm_tile(wv, la + 128, 320, rs, lt + (size_t)2 * 512 * 64, 64, nt * G_BN, 64, epi, lds);
        } else {
            EpiStoreBf16 epi{(bf16_t*)(P.ws + WS_RWG), 512, mt * G_BM, nt * G_BN, 512};
            gemm_tile(wv, la + 192, 320, rs, lt + (size_t)3 * 512 * 64, 128, nt * G_BN, 128, epi, lds);
        }
    }
}
__device__ __forceinline__ void moe_tiles(int wv, const unsigned char* ws, int layer, LAS int* tstart, LAS int* tcnt) {
    const int tid = ltid(wv);
    if (tid < 64) {
        const int* cnt = (const int*)(ws + WS_CNT) + layer * 32 * CNT_STRIDE;
        const int c = tid < NEXP ? cnt[tid * CNT_STRIDE] : 0;
        int incl = (c + G_BM - 1) / G_BM;
#pragma unroll
        for (int o = 1; o < 32; o <<= 1) { const int t = __shfl_up(incl, o); if (tid >= o) incl += t; }
        if (tid < NEXP) { tcnt[tid] = c; tstart[tid] = incl - (c + G_BM - 1) / G_BM; }
        if (tid == NEXP - 1) tstart[NEXP] = incl;
    }
    __syncthreads();
}
__device__ __forceinline__ void phase_moe1(int wv, KP Pk, int layer, LAS char* lds) {
    asm volatile("" : "+s"(Pk));
    const CAS Params& P = *Pk;
    LAS int* tstart = (LAS int*)(lds + pg8::STAGE_BYTES); LAS int* tcnt = tstart + 40;
    moe_tiles(wv, P.ws, layer, tstart, tcnt);
    pg8::Gemm g{(const bf16_t*)(P.ws + WS_ACT), (const bf16_t*)(P.ws + WS_EXPGU), 0, 1024, D};
    LAS int* ltabs = tstart + 128;
    pg8::MoeOrder S{tstart, tcnt, ltabs, (const int*)(P.ws + WS_LIST), (const char*)(P.ws + WS_EXPGU), (size_t)1024 * 1024 * 2, 4, 1, (int)gridDim.x, (int)blockIdx.x};
    pg8::EpiSwiGLUG E{(bf16_t*)(P.ws + WS_HID)};
    for (int i = 0; i < 8; ++i) {
        pg8::UnitG u; if (!S.next(i, u)) break;
        const int tl = ltid(wv);
        const int* ul = (const int*)(P.ws + WS_LIST) + (size_t)u.e * LISTCAP + u.pm * pg8::BM;
        if (tl < pg8::BM) ltabs[i * pg8::BM + tl] = ul[tl < u.cnt ? tl : 0];
    }
    __syncthreads();
    pg8::gemm_phase_g(wv, (PG8_LAS unsigned char*)lds, g, S, E);
    __syncthreads();
}
__device__ __forceinline__ void phase_moe2(int wv, KP Pk, int layer, LAS char* lds) {
    asm volatile("" : "+s"(Pk));
    const CAS Params& P = *Pk;
    LAS int* tstart = (LAS int*)(lds + pg8::STAGE_BYTES); LAS int* tcnt = tstart + 40;
    moe_tiles(wv, P.ws, layer, tstart, tcnt);
    pg8::Gemm g{(const bf16_t*)(P.ws + WS_HID), (const bf16_t*)(P.ws + WS_EXPD), 0, 1024, DEXP};
    LAS int* ltabs = tstart + 128;
    pg8::MoeOrder S{tstart, tcnt, ltabs, (const int*)(P.ws + WS_LIST), (const char*)(P.ws + WS_EXPD), (size_t)1024 * 512 * 2, 4, 0, (int)gridDim.x, (int)blockIdx.x};
    pg8::EpiScatterG E{(bf16_t*)(P.ws + WS_YP)};
    for (int i = 0; i < 8; ++i) {
        pg8::UnitG u; if (!S.next(i, u)) break;
        const int tl = ltid(wv);
        const int* ul = (const int*)(P.ws + WS_LIST) + (size_t)u.e * LISTCAP + u.pm * pg8::BM;
        if (tl < pg8::BM) ltabs[i * pg8::BM + tl] = ul[tl < u.cnt ? tl : 0];
    }
    __syncthreads();
    pg8::gemm_phase_g(wv, (PG8_LAS unsigned char*)lds, g, S, E);
    __syncthreads();
}

constexpr int NCHUNK = NSTEPS / TCH;

constexpr int SSD_F = 32 + 64 + 64;
constexpr int SSD_BUF = TCH * SSD_F + 3 * TCH;

constexpr int ML_F = 64 + 64 + 32;
constexpr int ML_BUF = TCH * ML_F + 4 * TCH;

constexpr int HG_F = 128 + 128 + 32;
constexpr int HG_BUF = TCH * HG_F + TCH;

constexpr int RW_F = 5 * 64 + 32;
constexpr int RW_BUF = TCH * RW_F + TCH;
__device__ __forceinline__ void scan_rwkv(int wv, KP Pk, int layer, int unit, LAS char* lds) {
    asm volatile("" : "+s"(Pk));
    const CAS Params& P = *Pk;
    const int tid = ltid(wv);
    const int seq = unit >> 1, half = unit & 1, b = seq >> 4, h = (seq >> 1) & 7, dir = seq & 1;
    LAS float* bufs = (LAS float*)lds;
    bf16_t* Y = (bf16_t*)(P.ws + (dir ? WS_YB : WS_YF));
    const float* dec = (const float*)(P.ws + WS_RWDEC) + (size_t)dir * NROWS * 512;
    int tj[4], tg_[4]; bool tv[4]; const unsigned char* tbase[4]; int tlds[4];
#pragma unroll
    for (int s = 0; s < 4; ++s) {
        const int task = tid + NT * s; tv[s] = task < TCH * 52; tj[s] = task / 52; tg_[s] = task % 52;
        const int g = tg_[s];
        if (g < 8)       { tbase[s] = P.ws + WS_RWR  + (size_t)(h * 64 + 8 * g) * 2;              tlds[s] = 256 + 8 * g; }
        else if (g < 16) { tbase[s] = P.ws + WS_RWK  + (size_t)(h * 64 + 8 * (g - 8)) * 2;        tlds[s] = 192 + 8 * (g - 8); }
        else if (g < 24) { tbase[s] = P.ws + WS_RWKK + (size_t)(h * 64 + 8 * (g - 16)) * 2;       tlds[s] = 64 + 8 * (g - 16); }
        else if (g < 32) { tbase[s] = P.ws + WS_RWB  + (size_t)(h * 64 + 8 * (g - 24)) * 2;       tlds[s] = 128 + 8 * (g - 24); }
        else if (g < 36) { tbase[s] = P.ws + WS_RWV  + (size_t)(h * 64 + half * 32 + 8 * (g - 32)) * 2; tlds[s] = 320 + 8 * (g - 32); }
        else             { tbase[s] = (const unsigned char*)(dec + h * 64 + 4 * (g - 36));        tlds[s] = 4 * (g - 36); }
    }
    u32x4 rc[4]; int rrow = 0;
    auto load = [&](int c) {
#pragma unroll
        for (int s = 0; s < 4; ++s) {
            rc[s] = (u32x4){0u, 0u, 0u, 0u};
            if (tv[s]) { const int row = scan_row(c * TCH + tj[s], b, dir, 1); rc[s] = *(const u32x4*)(tbase[s] + (size_t)row * (tg_[s] < 36 ? 1024 : 2048)); }
        }
        if (tid < TCH) rrow = scan_row(c * TCH + tid, b, dir, 1);
    };
    auto store = [&](int c) {
        LAS float* buf = bufs + (c & 1) * RW_BUF;
#pragma unroll
        for (int s = 0; s < 4; ++s) {
            if (tv[s]) {
                LAS float* dst = buf + tj[s] * RW_F + tlds[s];
                const int g = tg_[s];
                if (g >= 36) { *(LAS u32x4*)dst = rc[s]; }
                else {
                    float f[8]; unpack8(rc[s], f);
                    const float sg = (g >= 16 && g < 24) ? -1.f : 1.f;
                    *(LAS f32x4*)dst = (f32x4){sg * f[0], sg * f[1], sg * f[2], sg * f[3]}; *(LAS f32x4*)(dst + 4) = (f32x4){sg * f[4], sg * f[5], sg * f[6], sg * f[7]};
                }
            }
        }
        if (tid < TCH) ((LAS int*)buf)[TCH * RW_F + tid] = rrow;
    };
    const int vrow = tid >> 4, q = tid & 15;
    f32x2 S01 = {0.f, 0.f}, S23 = {0.f, 0.f};
    LAS float* ypw = bufs + 2 * RW_BUF + (tid >> 6) * (2 * 16 * 68);
    int prow = -1, gpar = 0;
    load(0); store(0); __syncthreads();
    for (int c = 0; c < NCHUNK; ++c) {
        if (c + 1 < NCHUNK) load(c + 1);
        LAS float* buf = bufs + (c & 1) * RW_BUF;
        {
            const LAS float* wp = buf + 4 * q;
            const LAS float* vp = buf + 320 + vrow;
            f32x4 w4 = *(const LAS f32x4*)wp, a4 = *(const LAS f32x4*)(wp + 64), b4 = *(const LAS f32x4*)(wp + 128), k4 = *(const LAS f32x4*)(wp + 192), r4 = *(const LAS f32x4*)(wp + 256); float vr = vp[0];
#pragma unroll 1
            for (int jh = 0; jh < 2; ++jh) {
                const LAS float* rp = ypw + (gpar ^ 1) * (16 * 68) + q * 68 + ((tid >> 4) & 3) * 16;
                const f32x4 p0 = *(const LAS f32x4*)rp, p1 = *(const LAS f32x4*)(rp + 4), p2 = *(const LAS f32x4*)(rp + 8), p3 = *(const LAS f32x4*)(rp + 12);
                LAS float* wpz = ypw + gpar * (16 * 68) + (tid & 63);
#pragma unroll
                for (int j = 0; j < 16; ++j) {
                    const int jj = jh * 16 + j;
                    const f32x4 wc = w4, ac = a4, bc = b4, kc = k4, rc = r4; const float vv = vr;
                    if (j < 15 || jh == 0) {
                        const LAS float* np = wp + (jj + 1) * RW_F;
                        w4 = *(const LAS f32x4*)np; a4 = *(const LAS f32x4*)(np + 64); b4 = *(const LAS f32x4*)(np + 128); k4 = *(const LAS f32x4*)(np + 192); r4 = *(const LAS f32x4*)(np + 256); vr = vp[(jj + 1) * RW_F];
                    }
                    const f32x2 a01 = {ac[0], ac[1]}, a23 = {ac[2], ac[3]}, w01 = {wc[0], wc[1]}, w23 = {wc[2], wc[3]}, b01 = {bc[0], bc[1]}, b23 = {bc[2], bc[3]};
                    const f32x2 k01 = {kc[0], kc[1]}, k23 = {kc[2], kc[3]}, r01 = {rc[0], rc[1]}, r23 = {rc[2], rc[3]}, vv2 = {vv, vv};
                    f32x2 t = S01 * a01; t = S23 * a23 + t;
                    const f32x2 u01 = S01 * w01 + vv2 * k01, u23 = S23 * w23 + vv2 * k23;
                    const float sa = allreduce16(t.x + t.y);
                    const f32x2 sa2 = {sa, sa};
                    S01 = sa2 * b01 + u01; S23 = sa2 * b23 + u23;
                    f32x2 yv = S01 * r01; yv = S23 * r23 + yv;
                    wpz[j * 68] = yv.x + yv.y;
                }
                if (prow >= 0) {
                    const f32x4 t = (p0 + p1) + (p2 + p3);
                    Y[(size_t)prow * D + 512 + h * 64 + half * 32 + vrow] = f2bf((t[0] + t[1]) + (t[2] + t[3]));
                }
                prow = ((const LAS int*)buf)[TCH * RW_F + jh * 16 + q];
                gpar ^= 1;
            }
        }
        if (c + 1 < NCHUNK) store(c + 1);
        __syncthreads();
    }
    {
        const LAS float* rp = ypw + (gpar ^ 1) * (16 * 68) + q * 68 + ((tid >> 4) & 3) * 16;
        const f32x4 t = (*(const LAS f32x4*)rp + *(const LAS f32x4*)(rp + 4)) + (*(const LAS f32x4*)(rp + 8) + *(const LAS f32x4*)(rp + 12));
        Y[(size_t)prow * D + 512 + h * 64 + half * 32 + vrow] = f2bf((t[0] + t[1]) + (t[2] + t[3]));
    }
}

__device__ __forceinline__ void scan_rwkv_b(int wv, KP Pk, int layer, int unit, LAS char* lds) {
    asm volatile("" : "+s"(Pk));
    const CAS Params& P = *Pk;
    const int tid = ltid(wv);
    const int seq = unit >> 1, half = unit & 1, b = seq >> 4, h = (seq >> 1) & 7, dir = seq & 1;
    LAS float* bufs = (LAS float*)lds;
    bf16_t* Y = (bf16_t*)(P.ws + (dir ? WS_YB : WS_YF));
    const float* dec = (const float*)(P.ws + WS_RWDEC) + (size_t)dir * NROWS * 512;
    constexpr int NS = 7;
    const int stid = tid - 256;
    int tj[NS], tg_[NS]; bool tv[NS]; const unsigned char* tbase[NS]; int tlds[NS];
#pragma unroll
    for (int s = 0; s < NS; ++s) {
        const int task = stid + 256 * s; tv[s] = stid >= 0 && task < TCH * 52; tj[s] = task / 52; tg_[s] = task % 52;
        const int g = tg_[s];
        if (g < 8)       { tbase[s] = P.ws + WS_RWR  + (size_t)(h * 64 + 8 * g) * 2;              tlds[s] = 256 + 8 * g; }
        else if (g < 16) { tbase[s] = P.ws + WS_RWK  + (size_t)(h * 64 + 8 * (g - 8)) * 2;        tlds[s] = 192 + 8 * (g - 8); }
        else if (g < 24) { tbase[s] = P.ws + WS_RWKK + (size_t)(h * 64 + 8 * (g - 16)) * 2;       tlds[s] = 64 + 8 * (g - 16); }
        else if (g < 32) { tbase[s] = P.ws + WS_RWB  + (size_t)(h * 64 + 8 * (g - 24)) * 2;       tlds[s] = 128 + 8 * (g - 24); }
        else if (g < 36) { tbase[s] = P.ws + WS_RWV  + (size_t)(h * 64 + half * 32 + 8 * (g - 32)) * 2; tlds[s] = 320 + 8 * (g - 32); }
        else             { tbase[s] = (const unsigned char*)(dec + h * 64 + 4 * (g - 36));        tlds[s] = 4 * (g - 36); }
    }
    u32x4 rc[NS]; int rrow = 0;
    auto load = [&](int c) {
#pragma unroll
        for (int s = 0; s < NS; ++s) {
            rc[s] = (u32x4){0u, 0u, 0u, 0u};
            if (tv[s]) { const int row = scan_row(c * TCH + tj[s], b, dir, 1); rc[s] = *(const u32x4*)(tbase[s] + (size_t)row * (tg_[s] < 36 ? 1024 : 2048)); }
        }
        if (stid >= 0 && stid < TCH) rrow = scan_row(c * TCH + stid, b, dir, 1);
    };
    auto store = [&](int c) {
        LAS float* buf = bufs + (c & 1) * RW_BUF;
#pragma unroll
        for (int s = 0; s < NS; ++s) {
            if (tv[s]) {
                LAS float* dst = buf + tj[s] * RW_F + tlds[s];
                const int g = tg_[s];
                if (g >= 36) { *(LAS u32x4*)dst = rc[s]; }
                else {
                    float f[8]; unpack8(rc[s], f);
                    const float sg = (g >= 16 && g < 24) ? -1.f : 1.f;
                    *(LAS f32x4*)dst = (f32x4){sg * f[0], sg * f[1], sg * f[2], sg * f[3]}; *(LAS f32x4*)(dst + 4) = (f32x4){sg * f[4], sg * f[5], sg * f[6], sg * f[7]};
                }
            }
        }
        if (stid >= 0 && stid < TCH) ((LAS int*)buf)[TCH * RW_F + stid] = rrow;
    };
    const int q = tid & 15, vr = (tid >> 4) & 3, rowA = 8 * wv + vr, rowB = rowA + 4;
    f32x2 A01 = {0.f, 0.f}, A23 = {0.f, 0.f}, B01 = {0.f, 0.f}, B23 = {0.f, 0.f};
    LAS float* ypw = bufs + 2 * RW_BUF + (wv & 3) * (2 * 16 * 132);
    int prow = -1, gpar = 0;
    if (wv >= 4) { load(0); store(0); }
    __syncthreads();
    for (int c = 0; c < NCHUNK; ++c) {
        if (wv >= 4 && c + 1 < NCHUNK) load(c + 1);
        LAS float* buf = bufs + (c & 1) * RW_BUF;
        if (wv < 4) {
            const LAS float* wp = buf + 4 * q;
            const LAS float* vpA = buf + 320 + rowA; const LAS float* vpB = buf + 320 + rowB;
            f32x4 w4 = *(const LAS f32x4*)wp, a4 = *(const LAS f32x4*)(wp + 64), b4 = *(const LAS f32x4*)(wp + 128), k4 = *(const LAS f32x4*)(wp + 192), r4 = *(const LAS f32x4*)(wp + 256); float vrA = vpA[0], vrB = vpB[0];
#pragma unroll 1
            for (int jh = 0; jh < 2; ++jh) {
                const LAS float* rp = ypw + (gpar ^ 1) * (16 * 132) + q * 132 + vr * 16;
                const f32x4 pa0 = *(const LAS f32x4*)rp, pa1 = *(const LAS f32x4*)(rp + 4), pa2 = *(const LAS f32x4*)(rp + 8), pa3 = *(const LAS f32x4*)(rp + 12);
                const f32x4 pb0 = *(const LAS f32x4*)(rp + 64), pb1 = *(const LAS f32x4*)(rp + 68), pb2 = *(const LAS f32x4*)(rp + 72), pb3 = *(const LAS f32x4*)(rp + 76);
                LAS float* wpz = ypw + gpar * (16 * 132) + (tid & 63);
#pragma unroll
                for (int j = 0; j < 16; ++j) {
                    const int jj = jh * 16 + j;
                    const f32x4 wc = w4, ac = a4, bc = b4, kc = k4, rc = r4; const float vvA = vrA, vvB = vrB;
                    if (j < 15 || jh == 0) {
                        const LAS float* np = wp + (jj + 1) * RW_F;
                        w4 = *(const LAS f32x4*)np; a4 = *(const LAS f32x4*)(np + 64); b4 = *(const LAS f32x4*)(np + 128); k4 = *(const LAS f32x4*)(np + 192); r4 = *(const LAS f32x4*)(np + 256);
                        vrA = vpA[(jj + 1) * RW_F]; vrB = vpB[(jj + 1) * RW_F];
                    }
                    const f32x2 a01 = {ac[0], ac[1]}, a23 = {ac[2], ac[3]}, w01 = {wc[0], wc[1]}, w23 = {wc[2], wc[3]}, b01 = {bc[0], bc[1]}, b23 = {bc[2], bc[3]};
                    const f32x2 k01 = {kc[0], kc[1]}, k23 = {kc[2], kc[3]}, r01 = {rc[0], rc[1]}, r23 = {rc[2], rc[3]}, va2 = {vvA, vvA}, vb2 = {vvB, vvB};
                    f32x2 tA = A01 * a01; tA = A23 * a23 + tA;
                    f32x2 tB = B01 * a01; tB = B23 * a23 + tB;
                    const f32x2 uA01 = A01 * w01 + va2 * k01, uA23 = A23 * w23 + va2 * k23, uB01 = B01 * w01 + vb2 * k01, uB23 = B23 * w23 + vb2 * k23;
                    const float saA = allreduce16(tA.x + tA.y), saB = allreduce16(tB.x + tB.y);
                    const f32x2 sA2 = {saA, saA}, sB2 = {saB, saB};
                    A01 = sA2 * b01 + uA01; A23 = sA2 * b23 + uA23; B01 = sB2 * b01 + uB01; B23 = sB2 * b23 + uB23;
                    f32x2 yA = A01 * r01; yA = A23 * r23 + yA;
                    f32x2 yB = B01 * r01; yB = B23 * r23 + yB;
                    wpz[j * 132] = yA.x + yA.y; wpz[j * 132 + 64] = yB.x + yB.y;
                }
                if (prow >= 0) {
                    const f32x4 ta = (pa0 + pa1) + (pa2 + pa3), tb = (pb0 + pb1) + (pb2 + pb3);
                    bf16_t* yo = Y + (size_t)prow * D + 512 + h * 64 + half * 32;
                    yo[rowA] = f2bf((ta[0] + ta[1]) + (ta[2] + ta[3])); yo[rowB] = f2bf((tb[0] + tb[1]) + (tb[2] + tb[3]));
                }
                prow = ((const LAS int*)buf)[TCH * RW_F + jh * 16 + q];
                gpar ^= 1;
            }
        }
        if (wv >= 4 && c + 1 < NCHUNK) store(c + 1);
        __syncthreads();
    }
    if (wv < 4) {
        const LAS float* rp = ypw + (gpar ^ 1) * (16 * 132) + q * 132 + vr * 16;
        const f32x4 ta = (*(const LAS f32x4*)rp + *(const LAS f32x4*)(rp + 4)) + (*(const LAS f32x4*)(rp + 8) + *(const LAS f32x4*)(rp + 12));
        const f32x4 tb = (*(const LAS f32x4*)(rp + 64) + *(const LAS f32x4*)(rp + 68)) + (*(const LAS f32x4*)(rp + 72) + *(const LAS f32x4*)(rp + 76));
        bf16_t* yo = Y + (size_t)prow * D + 512 + h * 64 + half * 32;
        yo[rowA] = f2bf((ta[0] + ta[1]) + (ta[2] + ta[3])); yo[rowB] = f2bf((tb[0] + tb[1]) + (tb[2] + tb[3]));
    }
}

constexpr size_t WS_EXBC = WS_RWR;
constexpr size_t WS_EQK = WS_EXBC + (size_t)NROWS * 768 * 2;
constexpr size_t WS_EGT = WS_EQK + (size_t)NROWS * 512 * 2;
static_assert(WS_EGT + (size_t)NROWS * 32 * 4 <= WS_LA, "even-layer prepare buffers must fit in the RWKV region");

__device__ __forceinline__ void phase_prep_even(int wv, KP Pk, int layer) {
    asm volatile("" : "+s"(Pk));
    const CAS Params& P = *Pk;
    const int tid = ltid(wv), lane = tid & 63, wid = tid >> 6, i_ = layer >> 1;
    const bf16_t* Pb = (const bf16_t*)(P.ws + WS_P);
    bf16_t* XBC = (bf16_t*)(P.ws + WS_EXBC); bf16_t* QK = (bf16_t*)(P.ws + WS_EQK); float* GT = (float*)(P.ws + WS_EGT);
    float cw0[4][8], cw1[4][8], cwq[4][8];
#pragma unroll
    for (int e = 0; e < 8; ++e) {
#pragma unroll
        for (int t = 0; t < 3; ++t) {
            cw0[t][e] = P.ssd_conv_w[(size_t)(i_ * 3 + t) * 768 + 8 * lane + e];
            cw1[t][e] = P.ssd_conv_w[(size_t)(i_ * 3 + t) * 768 + 512 + 8 * (lane & 31) + e];
            cwq[t][e] = P.ml_conv_w[(size_t)(i_ * 3 + t) * 512 + 8 * lane + e];
        }
        cw0[3][e] = P.ssd_conv_b[i_ * 768 + 8 * lane + e]; cw1[3][e] = P.ssd_conv_b[i_ * 768 + 512 + 8 * (lane & 31) + e]; cwq[3][e] = P.ml_conv_b[i_ * 512 + 8 * lane + e];
    }
    float gbias = 0.f;
    if (lane < 16) gbias = P.ssd_dt_bias[i_ * 16 + lane]; else if (lane < 24) gbias = P.ml_i_bias[i_ * 8 + lane - 16]; else if (lane < 32) gbias = P.ml_f_bias[i_ * 8 + lane - 24];
    const float qscl = lane < 32 ? 0.125f : 1.f;
    const u32x4 zero = (u32x4){0u, 0u, 0u, 0u};
    u32x4 nA[3], nB[3], nC[3]; bf16_t ng = 0;
    auto fetch = [&](int rr) {
        int t, len; row_seg(rr, t, len);
        const bf16_t* pr = Pb + (size_t)rr * LDP_EVEN;
        const bool hp = t > 0, hn = t < len - 1;
        { const int col = 512 + 8 * lane; nA[0] = *(const u32x4*)(pr + col); nA[1] = hp ? *(const u32x4*)(pr - LDP_EVEN + col) : zero; nA[2] = hn ? *(const u32x4*)(pr + LDP_EVEN + col) : zero; }
        if (lane < 32) { const int col = 1024 + 8 * lane; nB[0] = *(const u32x4*)(pr + col); nB[1] = hp ? *(const u32x4*)(pr - LDP_EVEN + col) : zero; nB[2] = hn ? *(const u32x4*)(pr + LDP_EVEN + col) : zero; }
        { const int col = 1296 + 8 * lane; nC[0] = *(const u32x4*)(pr + col); nC[1] = hp ? *(const u32x4*)(pr - LDP_EVEN + col) : zero; nC[2] = hn ? *(const u32x4*)(pr + LDP_EVEN + col) : zero; }
        if (lane < 32) ng = pr[lane < 16 ? 1280 + lane : 2832 + (lane - 16)];
    };
    nB[0] = nB[1] = nB[2] = zero;
    const int stride = gridDim.x * 8;
    int r = blockIdx.x * 8 + wid;
    if (r < NROWS) fetch(r);
    for (; r < NROWS; r += stride) {
        const u32x4 cA0 = nA[0], cA1 = nA[1], cA2 = nA[2], cB0 = nB[0], cB1 = nB[1], cB2 = nB[2], cC0 = nC[0], cC1 = nC[1], cC2 = nC[2]; const bf16_t cg = ng;
        if (r + stride < NROWS) fetch(r + stride);
        float fc[8], fp[8], fn[8], o[8];
        {
            unpack8(cA0, fc); unpack8(cA1, fp); unpack8(cA2, fn);
#pragma unroll
            for (int e = 0; e < 8; ++e) o[e] = siluf_(cw0[0][e] * fp[e] + cw0[1][e] * fc[e] + cw0[2][e] * fn[e] + cw0[3][e]);
            *(u32x4*)(XBC + (size_t)r * 768 + 8 * lane) = pack8(o);
        }
        if (lane < 32) {
            unpack8(cB0, fc); unpack8(cB1, fp); unpack8(cB2, fn);
#pragma unroll
            for (int e = 0; e < 8; ++e) o[e] = siluf_(cw1[0][e] * fp[e] + cw1[1][e] * fc[e] + cw1[2][e] * fn[e] + cw1[3][e]);
            *(u32x4*)(XBC + (size_t)r * 768 + 512 + 8 * lane) = pack8(o);
        }
        {
            unpack8(cC0, fc); unpack8(cC1, fp); unpack8(cC2, fn);
#pragma unroll
            for (int e = 0; e < 8; ++e) o[e] = qscl * siluf_(cwq[0][e] * fp[e] + cwq[1][e] * fc[e] + cwq[2][e] * fn[e] + cwq[3][e]);
            *(u32x4*)(QK + (size_t)r * 512 + 8 * lane) = pack8(o);
        }
        if (lane < 32) {
            const float x = bf2f(cg) + gbias;
            GT[(size_t)r * 32 + lane] = lane < 16 ? softplusf_(x) : lane < 24 ? x : logsigmoidf_(x);
        }
    }
}

constexpr int CL = 64, NCH64 = NSTEPS / CL, LDT = 72, LDTB = LDT * 2;
__device__ __forceinline__ bf16x8 ldfrag(const LAS char* tile, int ldb, int row0, int k0, int lane) {
    return *(const LAS bf16x8*)(tile + (row0 + (lane & 15)) * ldb + (k0 + 8 * (lane >> 4)) * 2);
}
constexpr int LDTS = 160;
typedef short s16x4 __attribute__((ext_vector_type(4)));
constexpr int LDV = 272;
__device__ __forceinline__ bf16x8 ldfrag_tr(const LAS char* tile, int rowb, int c0, int k0, int lane) {
    const int i = lane & 15;
    const LAS char* p = tile + (k0 + 8 * (lane >> 4) + (i >> 2)) * rowb + (c0 + 4 * (i & 3)) * 2;
    const s16x4 lo = __builtin_amdgcn_ds_read_tr16_b64_v4i16((LAS s16x4*)p);
    const s16x4 hi = __builtin_amdgcn_ds_read_tr16_b64_v4i16((LAS s16x4*)(p + 4 * rowb));
    return (bf16x8){lo[0], lo[1], lo[2], lo[3], hi[0], hi[1], hi[2], hi[3]};
}
__device__ __forceinline__ int swz_off(int row, int byteoff) { return row * LDTS + (byteoff ^ (((row >> 3) & 7) << 4)); }
__device__ __forceinline__ bf16x8 ldfrag_sw(const LAS char* tile, int row0, int k0, int lane) {
    const int row = row0 + (lane & 15);
    return *(const LAS bf16x8*)(tile + swz_off(row, (k0 + 8 * (lane >> 4)) * 2));
}
__device__ __forceinline__ void st4bf(LAS char* p, const f32x4& v) { u32x2 o; o.x = pk2(v[0], v[1]); o.y = pk2(v[2], v[3]); *(LAS u32x2*)p = o; }

constexpr int SS_BT = 0, SS_CT = SS_BT + 64 * LDTB, SS_BDT = SS_CT + 64 * LDTB, SS_XT = SS_BDT + 64 * LDTB, SS_CUM = SS_XT + 32 * LDTB, SS_DTV = SS_CUM + 256, SS_ROWS = SS_DTV + 256, SS_STG = SS_ROWS + 256;
constexpr int SS_M = 2 * SS_STG, SS_HB = SS_M + 64 * LDTB, SS_END = SS_HB + 32 * LDTB;
static_assert(SS_END <= LDS_BYTES - 16, "SSD LDS map");

constexpr int MS_QT = 0, MS_KT = MS_QT + 64 * LDTB, MS_KET = MS_KT + 64 * LDTB, MS_VT = MS_KET + 64 * LDTB, MS_SC = MS_VT + 32 * LDTB;
constexpr int MS_STG = MS_SC + 8 * 256;
constexpr int MS_W = 2 * MS_STG, MS_CB = MS_W + 64 * LDTB, MS_ONE = MS_CB + 32 * LDTB, MS_NV = MS_ONE + 16 * LDTB, MS_QN = MS_NV + 256, MS_END = MS_QN + 256;
static_assert(MS_END <= LDS_BYTES - 16, "mLSTM LDS map");

constexpr size_t WS_XSS = WS_EGT + al256((size_t)NROWS * 32 * 4);
constexpr size_t XSS_BYTES = (size_t)64 * NCH64 * 64 * 64 * 2;
constexpr size_t WS_XSD = WS_XSS + XSS_BYTES;
constexpr size_t WS_XMC = WS_XSD + al256((size_t)64 * NCH64 * 4);
constexpr size_t XMC_BYTES = (size_t)32 * NCH64 * 128 * 64 * 2;
constexpr size_t WS_XMN = WS_XMC + XMC_BYTES;
constexpr size_t WS_XMS = WS_XMN + (size_t)32 * NCH64 * 64 * 4;
constexpr size_t WS_XMT = WS_XMS + al256((size_t)32 * NCH64 * 4 * 4);
constexpr size_t WS_XEND = WS_XMT + (size_t)32 * NCH64 * 3 * 64 * 4;
static_assert(WS_XEND <= WS_END, "even-layer chunk-state buffers must fit in the RWKV region");
constexpr int NSSD_ITEMS = 64 * NCH64, NML_ITEMS = 32 * NCH64;

template <int CTRL, int RM, int BM> __device__ __forceinline__ float dppx(float old, float v) {
    return __builtin_bit_cast(float, __builtin_amdgcn_update_dpp(__builtin_bit_cast(int, old), __builtin_bit_cast(int, v), CTRL, RM, BM, false));
}
__device__ __forceinline__ float wave_cumsum(float v, int) {
    float t = v;
    t += dppx<0x111, 0xf, 0xf>(0.f, v); t += dppx<0x112, 0xf, 0xf>(0.f, v); t += dppx<0x113, 0xf, 0xf>(0.f, v);
    { const float u = dppx<0x114, 0xf, 0xe>(0.f, t); t += u; }
    { const float u = dppx<0x118, 0xf, 0xc>(0.f, t); t += u; }
    { const float u = dppx<0x142, 0xa, 0xf>(0.f, t); t += u; }
    { const float u = dppx<0x143, 0xc, 0xf>(0.f, t); t += u; }
    return t;
}
__device__ __forceinline__ float wave_cummax(float v, int) {
    const float ninf = -__builtin_huge_valf();
    float t = v;
    t = fmaxf(t, dppx<0x111, 0xf, 0xf>(ninf, v)); t = fmaxf(t, dppx<0x112, 0xf, 0xf>(ninf, v)); t = fmaxf(t, dppx<0x113, 0xf, 0xf>(ninf, v));
    { const float u = dppx<0x114, 0xf, 0xe>(ninf, t); t = fmaxf(t, u); }
    { const float u = dppx<0x118, 0xf, 0xc>(ninf, t); t = fmaxf(t, u); }
    { const float u = dppx<0x142, 0xa, 0xf>(ninf, t); t = fmaxf(t, u); }
    { const float u = dppx<0x143, 0xc, 0xf>(ninf, t); t = fmaxf(t, u); }
    return t;
}
__device__ __forceinline__ float wave_max(float v) {
    const float t = wave_cummax(v, 0);
    return __builtin_bit_cast(float, __builtin_amdgcn_readlane(__builtin_bit_cast(int, t), 63));
}

constexpr int X1S_BDT = 0, X1S_XT = X1S_BDT + 64 * LDTB, X1S_CUM = X1S_XT + 64 * LDTB, X1S_DTV = X1S_CUM + 256, X1S_END = X1S_DTV + 256;
constexpr int X1M_KET = 0, X1M_VT = X1M_KET + 64 * LDTB, X1M_ONE = X1M_VT + 64 * LDV, X1M_EE = X1M_ONE + 16 * LDTB, X1M_END = X1M_EE + 256;
__device__ __forceinline__ void phase_ex1(int wv, KP Pk, int layer, LAS char* lds) {
    asm volatile("" : "+s"(Pk));
    const CAS Params& P = *Pk;
    const int tid = ltid(wv), lane = tid & 63, wid = tid >> 6, q = lane >> 4, r16 = lane & 15, i_ = layer >> 1;
    const bf16_t* XBC = (const bf16_t*)(P.ws + WS_EXBC); const bf16_t* QK = (const bf16_t*)(P.ws + WS_EQK); const bf16_t* Pb = (const bf16_t*)(P.ws + WS_P);
    const float* GT = (const float*)(P.ws + WS_EGT);
    {
        bf16_t* Hst = (bf16_t*)(P.ws + WS_XSS); float* Dst = (float*)(P.ws + WS_XSD);
        struct Set { u32x4 rc[2]; float rdt; }; Set SA, SB; SA.rdt = SB.rdt = 0.f;
        auto geom = [&](int it, int& b, int& h, int& dir, int& c) { const int sq = it / NCH64; c = it - sq * NCH64; b = sq >> 4; h = (sq >> 1) & 7; dir = sq & 1; };
        auto load = [&](int it, Set& S) {
            int b, h, dir, c; geom(it, b, h, dir, c);
            int tl = tid; asm volatile("" : "+v"(tl));
#pragma unroll
            for (int s = 0; s < 2; ++s) {
                const int task = tl + NT * s, j = task >> 4, g = task & 15;
                const int row = scan_row(c * CL + j, b, dir, 0);
                S.rc[s] = *(const u32x4*)(XBC + (size_t)row * 768 + (g < 8 ? h * 64 + 8 * g : 512 + (h >> 2) * 64 + 8 * (g - 8)));
            }
            if (tl < CL) { const int row = scan_row(c * CL + tl, b, dir, 0); S.rdt = GT[(size_t)row * 32 + dir * 8 + h]; }
        };
        auto item = [&](int it, Set& S, int nxt) {
            int b, h, dir, c; geom(it, b, h, dir, c);
            const float aco = -__expf(P.ssd_a_log[(i_ * 2 + dir) * 8 + h]);
            if (tid < CL) {
                const float cum = wave_cumsum(S.rdt * aco, lane);
                ((LAS float*)(lds + X1S_CUM))[tid] = cum; ((LAS float*)(lds + X1S_DTV))[tid] = S.rdt;
            }
            __syncthreads();
            {
                const LAS float* cum = (const LAS float*)(lds + X1S_CUM);
                const float cumL = cum[CL - 1];
                int tl = tid; asm volatile("" : "+v"(tl));
#pragma unroll
                for (int s = 0; s < 2; ++s) {
                    const int task = tl + NT * s, j = task >> 4, g = task & 15;
                    float f[8]; unpack8(S.rc[s], f);
                    if (g < 8) {
                        const float dt = ((const LAS float*)(lds + X1S_DTV))[j];
#pragma unroll
                        for (int e = 0; e < 8; ++e) f[e] *= dt;
                        *(LAS u32x4*)(lds + X1S_XT + j * LDTB + 16 * g) = pack8(f);
                    } else {
                        const float sc = __expf(cumL - cum[j]);
#pragma unroll
                        for (int e = 0; e < 8; ++e) f[e] *= sc;
                        *(LAS u32x4*)(lds + X1S_BDT + j * LDTB + 16 * (g - 8)) = pack8(f);
                    }
                }
                if (tid == 0) Dst[it] = __expf(cumL);
            }
            if (nxt < NSSD_ITEMS) load(nxt, S);
            __syncthreads();
            {
                const int pt = wid >> 1;
#pragma unroll
                for (int u = 0; u < 2; ++u) {
                    const int nt = (wid & 1) * 2 + u;
                    f32x4 sa = (f32x4){0.f, 0.f, 0.f, 0.f};
#pragma unroll
                    for (int k0 = 0; k0 < 64; k0 += 32) sa = __builtin_amdgcn_mfma_f32_16x16x32_bf16(ldfrag_tr(lds + X1S_BDT, LDTB, nt * 16, k0, lane), ldfrag_tr(lds + X1S_XT, LDTB, pt * 16, k0, lane), sa, 0, 0, 0);
                    u32x2 o; o.x = pk2(sa[0], sa[1]); o.y = pk2(sa[2], sa[3]);
                    *(u32x2*)(Hst + ((size_t)it * 64 + pt * 16 + r16) * 64 + nt * 16 + 4 * q) = o;
                }
            }
            __syncthreads();
        };
        {
            const int G = gridDim.x; int it = blockIdx.x;
            if (it < NSSD_ITEMS) load(it, SA);
            if (it + G < NSSD_ITEMS) load(it + G, SB);
            for (; it < NSSD_ITEMS; it += 2 * G) {
                item(it, SA, it + 2 * G);
                if (it + G < NSSD_ITEMS) item(it + G, SB, it + 3 * G);
            }
        }
    }
    {
        bf16_t* Cst = (bf16_t*)(P.ws + WS_XMC); float* Nst = (float*)(P.ws + WS_XMN); float* Sst = (float*)(P.ws + WS_XMS); float* Tst = (float*)(P.ws + WS_XMT);
        for (int i = tid; i < 16 * LDTB / 4; i += NT) ((LAS unsigned*)(lds + X1M_ONE))[i] = 0x3f803f80u;
        struct Set { u32x4 rc[3]; float rli, rlf; }; Set SA, SB; SA.rli = SA.rlf = SB.rli = SB.rlf = 0.f;
        auto geom = [&](int it, int& b, int& h, int& dir, int& c) { const int sq = it / NCH64; c = it - sq * NCH64; b = sq >> 3; h = (sq >> 1) & 3; dir = sq & 1; };
        auto load = [&](int it, Set& S) {
            int b, h, dir, c; geom(it, b, h, dir, c);
            int tl = tid; asm volatile("" : "+v"(tl));
#pragma unroll
            for (int s = 0; s < 3; ++s) {
                const int task = tl + NT * s, j = task / 24, g = task - 24 * j;
                const int row = scan_row(c * CL + j, b, dir, 0);
                S.rc[s] = g < 8 ? *(const u32x4*)(QK + (size_t)row * 512 + 256 + h * 64 + 8 * g) : *(const u32x4*)(Pb + (size_t)row * LDP_EVEN + 1808 + h * 128 + 8 * (g - 8));
            }
            if (tl < CL) { const int row = scan_row(c * CL + tl, b, dir, 0); S.rli = GT[(size_t)row * 32 + 16 + dir * 4 + h]; S.rlf = GT[(size_t)row * 32 + 24 + dir * 4 + h]; }
        };
        auto item = [&](int it, Set& S, int nxt) {
            if (tid < CL) {
                const float fcum = wave_cumsum(S.rlf, lane);
                const float ftot = __builtin_bit_cast(float, __builtin_amdgcn_readlane(__builtin_bit_cast(int, fcum), 63));
                const float g = S.rli - fcum, pm = wave_cummax(g, lane);
                const float wend = ftot + g, mloc = wave_max(wend);
                ((LAS float*)(lds + X1M_EE))[tid] = __expf(wend - mloc);
                float* tp = Tst + (size_t)it * 192;
                tp[tid] = fcum; tp[64 + tid] = g; tp[128 + tid] = pm;
                if (tid == 0) { Sst[(size_t)it * 4 + 0] = ftot; Sst[(size_t)it * 4 + 1] = mloc; }
            }
            __syncthreads();
            {
                const LAS float* ee = (const LAS float*)(lds + X1M_EE);
                int tl = tid; asm volatile("" : "+v"(tl));
#pragma unroll
                for (int s = 0; s < 3; ++s) {
                    const int task = tl + NT * s, j = task / 24, g = task - 24 * j;
                    if (g < 8) {
                        float f[8]; unpack8(S.rc[s], f);
                        const float e1 = ee[j];
#pragma unroll
                        for (int e = 0; e < 8; ++e) f[e] *= e1;
                        *(LAS u32x4*)(lds + X1M_KET + j * LDTB + 16 * g) = pack8(f);
                    } else {
                        const int v0 = 8 * (g - 8);
#pragma unroll
                        for (int e = 0; e < 1; ++e) *(LAS u32x4*)(lds + X1M_VT + j * LDV + v0 * 2) = S.rc[s];
                    }
                }
            }
            if (nxt < NML_ITEMS) load(nxt, S);
            __syncthreads();
            {
                const bf16x8 vf0 = ldfrag_tr(lds + X1M_VT, LDV, wid * 16, 0, lane), vf1 = ldfrag_tr(lds + X1M_VT, LDV, wid * 16, 32, lane);
#pragma unroll
                for (int kt = 0; kt < 4; ++kt) {
                    f32x4 sa = __builtin_amdgcn_mfma_f32_16x16x32_bf16(ldfrag_tr(lds + X1M_KET, LDTB, kt * 16, 0, lane), vf0, (f32x4){0.f, 0.f, 0.f, 0.f}, 0, 0, 0);
                    sa = __builtin_amdgcn_mfma_f32_16x16x32_bf16(ldfrag_tr(lds + X1M_KET, LDTB, kt * 16, 32, lane), vf1, sa, 0, 0, 0);
                    u32x2 o; o.x = pk2(sa[0], sa[1]); o.y = pk2(sa[2], sa[3]);
                    *(u32x2*)(Cst + ((size_t)it * 128 + wid * 16 + r16) * 64 + kt * 16 + 4 * q) = o;
                }
                if (wid < 4) {
                    f32x4 na = __builtin_amdgcn_mfma_f32_16x16x32_bf16(ldfrag_tr(lds + X1M_KET, LDTB, wid * 16, 0, lane), ldfrag(lds + X1M_ONE, LDTB, 0, 0, lane), (f32x4){0.f, 0.f, 0.f, 0.f}, 0, 0, 0);
                    na = __builtin_amdgcn_mfma_f32_16x16x32_bf16(ldfrag_tr(lds + X1M_KET, LDTB, wid * 16, 32, lane), ldfrag(lds + X1M_ONE, LDTB, 0, 32, lane), na, 0, 0, 0);
                    if (r16 == 0) *(f32x4*)(Nst + (size_t)it * 64 + wid * 16 + 4 * q) = na;
                }
            }
            __syncthreads();
        };
        {
            const int G = gridDim.x; int it = blockIdx.x;
            if (it < NML_ITEMS) load(it, SA);
            if (it + G < NML_ITEMS) load(it + G, SB);
            __syncthreads();
            for (; it < NML_ITEMS; it += 2 * G) {
                item(it, SA, it + 2 * G);
                if (it + G < NML_ITEMS) item(it + G, SB, it + 3 * G);
            }
        }
    }
}

constexpr int EX2_UB = 12;
static_assert(NCH64 % EX2_UB == 0, "EX2 batches");
__device__ __forceinline__ void phase_ex2(int wv, KP Pk, int layer) {
    asm volatile("" : "+s"(Pk));
    const CAS Params& P = *Pk;
    const int tid = ltid(wv);
    (void)layer;
    if (blockIdx.x < 128) {
        const int gt = blockIdx.x * NT + tid, sq = gt >> 10, rem = gt & 1023;
        bf16_t* Hst = (bf16_t*)(P.ws + WS_XSS) + (size_t)sq * NCH64 * 4096 + rem * 4;
        const float* Dst = (const float*)(P.ws + WS_XSD) + sq * NCH64;
        float h0 = 0.f, h1 = 0.f, h2 = 0.f, h3 = 0.f;
#pragma unroll 1
        for (int c0 = 0; c0 < NCH64; c0 += EX2_UB) {
            u32x2 loc[EX2_UB]; float dd[EX2_UB];
            bf16_t* hp = Hst + (size_t)c0 * 4096;
#pragma unroll
            for (int u = 0; u < EX2_UB; ++u) { loc[u] = *(const u32x2*)(hp + (size_t)u * 4096); dd[u] = Dst[c0 + u]; }
#pragma unroll
            for (int u = 0; u < EX2_UB; ++u) {
                u32x2 o; o.x = pk2(h0, h1); o.y = pk2(h2, h3);
                *(u32x2*)(hp + (size_t)u * 4096) = o;
                const float d = dd[u];
                h0 = d * h0 + bflo(loc[u].x); h1 = d * h1 + bfhi(loc[u].x); h2 = d * h2 + bflo(loc[u].y); h3 = d * h3 + bfhi(loc[u].y);
            }
        }
    } else if (blockIdx.x < 256) {
        const int gt = (blockIdx.x - 128) * NT + tid, sq = gt >> 11, rem = gt & 2047;
        bf16_t* Cst = (bf16_t*)(P.ws + WS_XMC) + (size_t)sq * NCH64 * 8192 + rem * 4;
        float* Nst = (float*)(P.ws + WS_XMN) + (size_t)sq * NCH64 * 64 + (rem & 15) * 4;
        float* Sst = (float*)(P.ws + WS_XMS) + (size_t)sq * NCH64 * 4;
        const bool own_n = rem < 16, own_m = rem == 0;
        float c0_ = 0.f, c1 = 0.f, c2 = 0.f, c3 = 0.f, m = -1e30f;
        f32x4 nn = (f32x4){0.f, 0.f, 0.f, 0.f};
#pragma unroll 1
        for (int cb = 0; cb < NCH64; cb += EX2_UB) {
            u32x2 loc[EX2_UB]; float ft[EX2_UB], ml[EX2_UB]; f32x4 nl[EX2_UB];
            bf16_t* cp = Cst + (size_t)cb * 8192; float* np = Nst + (size_t)cb * 64; float* sp_ = Sst + cb * 4;
#pragma unroll
            for (int u = 0; u < EX2_UB; ++u) {
                loc[u] = *(const u32x2*)(cp + (size_t)u * 8192); ft[u] = sp_[u * 4 + 0]; ml[u] = sp_[u * 4 + 1];
                nl[u] = (f32x4){0.f, 0.f, 0.f, 0.f};
                if (own_n) nl[u] = *(const f32x4*)(np + (size_t)u * 64);
            }
#pragma unroll
            for (int u = 0; u < EX2_UB; ++u) {
                const float ftot = ft[u], mloc = ml[u];
                const float mnew = fmaxf(ftot + m, mloc), sp = __expf(ftot + m - mnew), sl = __expf(mloc - mnew);
                u32x2 o; o.x = pk2(c0_, c1); o.y = pk2(c2, c3);
                *(u32x2*)(cp + (size_t)u * 8192) = o;
                c0_ = sp * c0_ + sl * bflo(loc[u].x); c1 = sp * c1 + sl * bfhi(loc[u].x); c2 = sp * c2 + sl * bflo(loc[u].y); c3 = sp * c3 + sl * bfhi(loc[u].y);
                if (own_n) { *(f32x4*)(np + (size_t)u * 64) = nn; nn = nn * sp + nl[u] * sl; }
                if (own_m) sp_[u * 4 + 2] = m;
                m = mnew;
            }
        }
    }
}

constexpr int X3S_BT = 0, X3S_CT = X3S_BT + 64 * LDTB, X3S_XT = X3S_CT + 64 * LDTB, X3S_HB = X3S_XT + 64 * LDTB, X3S_M = X3S_HB + 64 * LDTB, X3S_CUM = X3S_M + 64 * LDTB, X3S_DTV = X3S_CUM + 256, X3S_ROWS = X3S_DTV + 256, X3S_END = X3S_ROWS + 256;
constexpr int X3M_QT = 0, X3M_KT = X3M_QT + 64 * LDTB, X3M_VT = X3M_KT + 64 * LDTB, X3M_CB = X3M_VT + 64 * LDV, X3M_W = X3M_CB + 128 * LDTB, X3M_ONE = X3M_W + 64 * LDTB, X3M_NB = X3M_ONE + 16 * LDTB,
              X3M_SC = X3M_NB + 16 * LDTB, X3M_END = X3M_SC + 6 * 256;
static_assert(X3M_END <= LDS_BYTES - 16 && X3S_END <= LDS_BYTES - 16, "EX3 LDS maps");
__device__ __forceinline__ void phase_ex3(int wv, KP Pk, int layer, LAS char* lds) {
    asm volatile("" : "+s"(Pk));
    const CAS Params& P = *Pk;
    const int tid = ltid(wv), lane = tid & 63, wid = tid >> 6, q = lane >> 4, r16 = lane & 15, i_ = layer >> 1;
    const bf16_t* XBC = (const bf16_t*)(P.ws + WS_EXBC); const bf16_t* QK = (const bf16_t*)(P.ws + WS_EQK); const bf16_t* Pb = (const bf16_t*)(P.ws + WS_P);
    const float* GT = (const float*)(P.ws + WS_EGT);
    {
        const bf16_t* Hst = (const bf16_t*)(P.ws + WS_XSS);
        struct Set { u32x4 rc[3], rh; float rdt; int rrow; }; Set SA, SB; SA.rdt = SB.rdt = 0.f; SA.rrow = SB.rrow = 0;
        auto geom = [&](int it, int& b, int& h, int& dir, int& c) { const int sq = it / NCH64; c = it - sq * NCH64; b = sq >> 4; h = (sq >> 1) & 7; dir = sq & 1; };
        auto load = [&](int it, Set& S) {
            int b, h, dir, c; geom(it, b, h, dir, c);
            int tl = tid; asm volatile("" : "+v"(tl));
#pragma unroll
            for (int s = 0; s < 3; ++s) {
                const int task = tl + NT * s, j = task / 24, g = task - 24 * j;
                const int row = scan_row(c * CL + j, b, dir, 0);
                S.rc[s] = *(const u32x4*)(XBC + (size_t)row * 768 + (g < 8 ? h * 64 + 8 * g : g < 16 ? 512 + (h >> 2) * 64 + 8 * (g - 8) : 640 + (h >> 2) * 64 + 8 * (g - 16)));
            }
            S.rh = *(const u32x4*)(Hst + (size_t)it * 4096 + tl * 8);
            if (tl < CL) { S.rrow = scan_row(c * CL + tl, b, dir, 0); S.rdt = GT[(size_t)S.rrow * 32 + dir * 8 + h]; }
        };
        auto item = [&](int it, Set& S, int nxt) {
            int b, h, dir, c; geom(it, b, h, dir, c);
            bf16_t* Y = (bf16_t*)(P.ws + (dir ? WS_YB : WS_YF));
            const float aco = -__expf(P.ssd_a_log[(i_ * 2 + dir) * 8 + h]);
            if (tid < CL) {
                const float cum = wave_cumsum(S.rdt * aco, lane);
                ((LAS float*)(lds + X3S_CUM))[tid] = cum; ((LAS float*)(lds + X3S_DTV))[tid] = S.rdt; ((LAS int*)(lds + X3S_ROWS))[tid] = S.rrow;
            }
            __syncthreads();
            {
                int tl = tid; asm volatile("" : "+v"(tl));
#pragma unroll
                for (int s = 0; s < 3; ++s) {
                    const int task = tl + NT * s, j = task / 24, g = task - 24 * j;
                    if (g < 8) {
                        float f[8]; unpack8(S.rc[s], f);
                        const float dt = ((const LAS float*)(lds + X3S_DTV))[j];
#pragma unroll
                        for (int e = 0; e < 8; ++e) f[e] *= dt;
                        *(LAS u32x4*)(lds + X3S_XT + j * LDTB + 16 * g) = pack8(f);
                    } else if (g < 16) *(LAS u32x4*)(lds + X3S_BT + j * LDTB + 8 * (g - 8) * 2) = S.rc[s];
                    else *(LAS u32x4*)(lds + X3S_CT + j * LDTB + 8 * (g - 16) * 2) = S.rc[s];
                }
                *(LAS u32x4*)(lds + X3S_HB + (tl >> 3) * LDTB + (tl & 7) * 16) = S.rh;
            }
            if (nxt < NSSD_ITEMS) load(nxt, S);
            __syncthreads();
            const LAS float* cum = (const LAS float*)(lds + X3S_CUM);
            {
                const int lt = wid >> 1;
#pragma unroll
                for (int u = 0; u < 2; ++u) {
                    const int st = (wid & 1) * 2 + u;
                    f32x4 acc = (f32x4){0.f, 0.f, 0.f, 0.f};
                    if (st <= lt) {
#pragma unroll
                        for (int k0 = 0; k0 < 64; k0 += 32) acc = __builtin_amdgcn_mfma_f32_16x16x32_bf16(ldfrag(lds + X3S_BT, LDTB, st * 16, k0, lane), ldfrag(lds + X3S_CT, LDTB, lt * 16, k0, lane), acc, 0, 0, 0);
                        const int l = lt * 16 + r16, s0 = st * 16 + 4 * q;
                        const float cl = cum[l]; const f32x4 cs = *(const LAS f32x4*)(cum + s0);
#pragma unroll
                        for (int j = 0; j < 4; ++j) acc[j] = (s0 + j <= l) ? acc[j] * __expf(cl - cs[j]) : 0.f;
                    }
                    st4bf(lds + X3S_M + (lt * 16 + r16) * LDTB + (st * 16 + 4 * q) * 2, acc);
                }
            }
            __syncthreads();
            {
                const int lt = wid >> 1, l = lt * 16 + r16;
                const float el = __expf(cum[l]);
                const int row = ((const LAS int*)(lds + X3S_ROWS))[l];
                const bf16x8 mf0 = ldfrag(lds + X3S_M, LDTB, lt * 16, 0, lane), mf1 = ldfrag(lds + X3S_M, LDTB, lt * 16, 32, lane);
                const bf16x8 cf0 = ldfrag(lds + X3S_CT, LDTB, lt * 16, 0, lane), cf1 = ldfrag(lds + X3S_CT, LDTB, lt * 16, 32, lane);
#pragma unroll
                for (int u = 0; u < 2; ++u) {
                    const int pt = (wid & 1) * 2 + u;
                    f32x4 ya = __builtin_amdgcn_mfma_f32_16x16x32_bf16(ldfrag_tr(lds + X3S_XT, LDTB, pt * 16, 0, lane), mf0, (f32x4){0.f, 0.f, 0.f, 0.f}, 0, 0, 0);
                    ya = __builtin_amdgcn_mfma_f32_16x16x32_bf16(ldfrag_tr(lds + X3S_XT, LDTB, pt * 16, 32, lane), mf1, ya, 0, 0, 0);
                    f32x4 oa = __builtin_amdgcn_mfma_f32_16x16x32_bf16(ldfrag(lds + X3S_HB, LDTB, pt * 16, 0, lane), cf0, (f32x4){0.f, 0.f, 0.f, 0.f}, 0, 0, 0);
                    oa = __builtin_amdgcn_mfma_f32_16x16x32_bf16(ldfrag(lds + X3S_HB, LDTB, pt * 16, 32, lane), cf1, oa, 0, 0, 0);
                    u32x2 o; o.x = pk2(ya[0] + el * oa[0], ya[1] + el * oa[1]); o.y = pk2(ya[2] + el * oa[2], ya[3] + el * oa[3]);
                    *(u32x2*)(Y + (size_t)row * D + h * 64 + pt * 16 + 4 * q) = o;
                }
            }
            __syncthreads();
        };
        {
            const int G = gridDim.x; int it = blockIdx.x;
            if (it < NSSD_ITEMS) load(it, SA);
            if (it + G < NSSD_ITEMS) load(it + G, SB);
            __syncthreads();
            for (; it < NSSD_ITEMS; it += 2 * G) {
                item(it, SA, it + 2 * G);
                if (it + G < NSSD_ITEMS) item(it + G, SB, it + 3 * G);
            }
        }
    }
    {
        const bf16_t* Cst = (const bf16_t*)(P.ws + WS_XMC); const float* Nst = (const float*)(P.ws + WS_XMN); const float* Sst = (const float*)(P.ws + WS_XMS); const float* Tst = (const float*)(P.ws + WS_XMT);
        for (int i = tid; i < 16 * LDTB / 4; i += NT) ((LAS unsigned*)(lds + X3M_ONE))[i] = 0x3f803f80u;
        struct Set { u32x4 rc[4], rcb[2]; float rfc, rg, rpm, rmp, rn; int rrow; }; Set SA, SB; SA.rfc = SA.rg = SA.rpm = SA.rmp = SA.rn = SB.rfc = SB.rg = SB.rpm = SB.rmp = SB.rn = 0.f; SA.rrow = SB.rrow = 0;
        auto geom = [&](int it, int& b, int& h, int& dir, int& c) { const int sq = it / NCH64; c = it - sq * NCH64; b = sq >> 3; h = (sq >> 1) & 3; dir = sq & 1; };
        auto load = [&](int it, Set& S) {
            int b, h, dir, c; geom(it, b, h, dir, c);
            int tl = tid; asm volatile("" : "+v"(tl));
#pragma unroll
            for (int s = 0; s < 4; ++s) {
                const int task = tl + NT * s, j = task >> 5, g = task & 31;
                const int row = scan_row(c * CL + j, b, dir, 0);
                S.rc[s] = g < 16 ? *(const u32x4*)(QK + (size_t)row * 512 + (g < 8 ? h * 64 + 8 * g : 256 + h * 64 + 8 * (g - 8))) : *(const u32x4*)(Pb + (size_t)row * LDP_EVEN + 1808 + h * 128 + 8 * (g - 16));
            }
#pragma unroll
            for (int s = 0; s < 2; ++s) S.rcb[s] = *(const u32x4*)(Cst + (size_t)it * 8192 + (tl + NT * s) * 8);
            if (tl < CL) {
                S.rrow = scan_row(c * CL + tl, b, dir, 0);
                const float* tp = Tst + (size_t)it * 192;
                S.rfc = tp[tl]; S.rg = tp[64 + tl]; S.rpm = tp[128 + tl]; S.rmp = Sst[(size_t)it * 4 + 2]; S.rn = Nst[(size_t)it * 64 + tl];
            }
        };
        auto item = [&](int it, Set& S, int nxt) {
            int b, h, dir, c; geom(it, b, h, dir, c);
            bf16_t* Y = (bf16_t*)(P.ws + (dir ? WS_YB : WS_YF));
            LAS float* sc = (LAS float*)(lds + X3M_SC);
            {
                int tl = tid; asm volatile("" : "+v"(tl));
#pragma unroll
                for (int s = 0; s < 4; ++s) {
                    const int task = tl + NT * s, j = task >> 5, g = task & 31;
                    if (g < 8) *(LAS u32x4*)(lds + X3M_QT + j * LDTB + 8 * g * 2) = S.rc[s];
                    else if (g < 16) *(LAS u32x4*)(lds + X3M_KT + j * LDTB + 8 * (g - 8) * 2) = S.rc[s];
                    else {
                        const int v0 = 8 * (g - 16);
#pragma unroll
                        for (int e = 0; e < 1; ++e) *(LAS u32x4*)(lds + X3M_VT + j * LDV + v0 * 2) = S.rc[s];
                    }
                }
#pragma unroll
                for (int s = 0; s < 2; ++s) { const int ch = tl + NT * s; *(LAS u32x4*)(lds + X3M_CB + (ch >> 3) * LDTB + (ch & 7) * 16) = S.rcb[s]; }
                if (tl < CL) {
                    const float linter = S.rfc + S.rmp, mrow = fmaxf(S.rfc + S.rpm, linter);
                    sc[tl] = S.rfc - mrow; sc[64 + tl] = S.rg; sc[128 + tl] = __expf(linter - mrow); sc[192 + tl] = __expf(-mrow); ((LAS int*)sc)[256 + tl] = S.rrow;
                    const bf16_t nb = f2bf(S.rn);
#pragma unroll
                    for (int r = 0; r < 16; ++r) *(LAS bf16_t*)(lds + X3M_NB + r * LDTB + tl * 2) = nb;
                }
            }
            if (nxt < NML_ITEMS) load(nxt, S);
            __syncthreads();
            {
                const int lt = wid >> 1;
#pragma unroll
                for (int u = 0; u < 2; ++u) {
                    const int st = (wid & 1) * 2 + u;
                    f32x4 acc = (f32x4){0.f, 0.f, 0.f, 0.f};
                    if (st <= lt) {
#pragma unroll
                        for (int k0 = 0; k0 < 64; k0 += 32) acc = __builtin_amdgcn_mfma_f32_16x16x32_bf16(ldfrag(lds + X3M_KT, LDTB, st * 16, k0, lane), ldfrag(lds + X3M_QT, LDTB, lt * 16, k0, lane), acc, 0, 0, 0);
                        const int l = lt * 16 + r16, s0 = st * 16 + 4 * q;
                        const float rt = sc[l]; const f32x4 gs = *(const LAS f32x4*)(sc + 64 + s0);
#pragma unroll
                        for (int j = 0; j < 4; ++j) acc[j] = (s0 + j <= l) ? acc[j] * __expf(rt + gs[j]) : 0.f;
                    }
                    st4bf(lds + X3M_W + (lt * 16 + r16) * LDTB + (st * 16 + 4 * q) * 2, acc);
                }
            }
            __syncthreads();
            {
                const int lt = wid >> 1, l = lt * 16 + r16;
                const bf16x8 wf0 = ldfrag(lds + X3M_W, LDTB, lt * 16, 0, lane), wf1 = ldfrag(lds + X3M_W, LDTB, lt * 16, 32, lane);
                const bf16x8 qf0 = ldfrag(lds + X3M_QT, LDTB, lt * 16, 0, lane), qf1 = ldfrag(lds + X3M_QT, LDTB, lt * 16, 32, lane);
                f32x4 da = __builtin_amdgcn_mfma_f32_16x16x32_bf16(ldfrag(lds + X3M_ONE, LDTB, 0, 0, lane), wf0, (f32x4){0.f, 0.f, 0.f, 0.f}, 0, 0, 0);
                da = __builtin_amdgcn_mfma_f32_16x16x32_bf16(ldfrag(lds + X3M_ONE, LDTB, 0, 32, lane), wf1, da, 0, 0, 0);
                f32x4 qn = __builtin_amdgcn_mfma_f32_16x16x32_bf16(ldfrag(lds + X3M_NB, LDTB, 0, 0, lane), qf0, (f32x4){0.f, 0.f, 0.f, 0.f}, 0, 0, 0);
                qn = __builtin_amdgcn_mfma_f32_16x16x32_bf16(ldfrag(lds + X3M_NB, LDTB, 0, 32, lane), qf1, qn, 0, 0, 0);
                const float inter = sc[128 + l], emr = sc[192 + l];
                const float inv = __builtin_amdgcn_rcpf(fmaxf(fabsf(da[0] + inter * qn[0]), emr));
                const int row = ((const LAS int*)sc)[256 + l];
#pragma unroll
                for (int u = 0; u < 4; ++u) {
                    const int vt = (wid & 1) * 4 + u;
                    f32x4 na = __builtin_amdgcn_mfma_f32_16x16x32_bf16(ldfrag_tr(lds + X3M_VT, LDV, vt * 16, 0, lane), wf0, (f32x4){0.f, 0.f, 0.f, 0.f}, 0, 0, 0);
                    na = __builtin_amdgcn_mfma_f32_16x16x32_bf16(ldfrag_tr(lds + X3M_VT, LDV, vt * 16, 32, lane), wf1, na, 0, 0, 0);
                    f32x4 ca = __builtin_amdgcn_mfma_f32_16x16x32_bf16(ldfrag(lds + X3M_CB, LDTB, vt * 16, 0, lane), qf0, (f32x4){0.f, 0.f, 0.f, 0.f}, 0, 0, 0);
                    ca = __builtin_amdgcn_mfma_f32_16x16x32_bf16(ldfrag(lds + X3M_CB, LDTB, vt * 16, 32, lane), qf1, ca, 0, 0, 0);
                    u32x2 o; o.x = pk2((na[0] + inter * ca[0]) * inv, (na[1] + inter * ca[1]) * inv); o.y = pk2((na[2] + inter * ca[2]) * inv, (na[3] + inter * ca[3]) * inv);
                    *(u32x2*)(Y + (size_t)row * D + 512 + h * 128 + vt * 16 + 4 * q) = o;
                }
            }
            __syncthreads();
        };
        {
            const int G = gridDim.x; int it = blockIdx.x;
            if (it < NML_ITEMS) load(it, SA);
            if (it + G < NML_ITEMS) load(it + G, SB);
            __syncthreads();
            for (; it < NML_ITEMS; it += 2 * G) {
                item(it, SA, it + 2 * G);
                if (it + G < NML_ITEMS) item(it + G, SB, it + 3 * G);
            }
        }
    }
}

constexpr int HC_RAWF = 0;
constexpr int HC_RAWQ = HC_RAWF + 64 * 128 * 4;
constexpr int HC_SUB = HC_RAWQ + 64 * 128 * 2;
constexpr int HL_QD = 136 * 2;
constexpr int HL_T = 24 * 2;
constexpr int HS_QI = 0, HS_KO = HS_QI + 16 * HL_QD, HS_KET = HS_KO + 16 * HL_QD, HS_ATT = HS_KET + 128 * HL_T, HS_VT = HS_ATT + 16 * HL_T, HS_DEC = HS_VT + 32 * HL_T, HS_SIZE = HS_DEC + 512;
constexpr int HC_SB = HC_SUB + 4 * HS_SIZE;
constexpr int HC_ROWS = HC_SB + 2 * 32 * HL_QD, HC_CST = HC_ROWS + 256, HC_END = HC_CST + 1024;
static_assert(HC_END <= LDS_BYTES - 16, "HGRN2 LDS map");
static_assert(HS_SIZE % 16 == 0 && HC_SB % 16 == 0, "alignment");
__device__ __forceinline__ bf16x8 ldfrag16(const LAS char* tile, int ldb, int row0, int lane) {
    bf16x8 v = *(const LAS bf16x8*)(tile + (row0 + (lane & 15)) * ldb + ((lane >> 4) & 1) * 16);
    if (lane >= 32) v = (bf16x8){0, 0, 0, 0, 0, 0, 0, 0};
    return v;
}
__device__ __forceinline__ void scan_hgrn_c(int wv, KP Pk, int layer, int unit, LAS char* lds) {
    asm volatile("" : "+s"(Pk));
    const CAS Params& P = *Pk;
    const int tid = ltid(wv), lane = tid & 63, wid = tid >> 6, q = lane >> 4, r16 = lane & 15, i_ = layer >> 1;
    const int seq = unit >> 2, quarter = unit & 3, b = seq >> 3, h = (seq >> 1) & 3, dir = seq & 1;
    const bf16_t* Pb = (const bf16_t*)(P.ws + WS_P);
    bf16_t* Y = (bf16_t*)(P.ws + (dir ? WS_YB : WS_YF));
    LAS float* cst = (LAS float*)(lds + HC_CST);
    if (tid < 128) cst[tid] = ((const float*)(P.ws + WS_LB))[layer * 512 + h * 128 + tid];
    else if (tid < 256) cst[tid] = P.hg_f_bias[(size_t)(i_ * 2 + dir) * 512 + h * 128 + tid - 128];
    for (int i = tid; i < 2 * 32 * HL_QD / 4; i += NT) ((LAS unsigned*)(lds + HC_SB))[i] = 0u;
    int tj[5], tg_[5], tcol[5]; bool tv[5];
#pragma unroll
    for (int s = 0; s < 5; ++s) {
        const int task = tid + NT * s; tv[s] = task < 64 * 36; tj[s] = task / 36; tg_[s] = task % 36;
        const int g = tg_[s];
        tcol[s] = g < 16 ? (512 + dir * 512 + h * 128 + 8 * g) : g < 32 ? (h * 128 + 8 * (g - 16)) : (1536 + h * 128 + quarter * 32 + 8 * (g - 32));
    }
    u32x4 rc[5]; int rrow = 0;
    auto load = [&](int c) {
#pragma unroll
        for (int s = 0; s < 5; ++s) {
            rc[s] = (u32x4){0u, 0u, 0u, 0u};
            if (tv[s]) { const int row = scan_row(c * 64 + tj[s], b, dir, 1); rc[s] = *(const u32x4*)(Pb + (size_t)row * LDP_ODD + tcol[s]); }
        }
        if (tid < 64) rrow = scan_row(c * 64 + tid, b, dir, 1);
    };
    auto storeA = [&]() {
#pragma unroll
        for (int s = 0; s < 5; ++s) {
            if (tv[s]) {
                float f[8]; unpack8(rc[s], f);
                const int j = tj[s], g = tg_[s];
                if (g < 16) {
                    float o[8];
#pragma unroll
                    for (int e = 0; e < 8; ++e) { const float lbv = cst[8 * g + e]; o[e] = lbv + (1.f - lbv) * sigmoidf_(f[e] + cst[128 + 8 * g + e]); }
                    LAS float* dst = (LAS float*)(lds + HC_RAWF) + j * 128 + 8 * g;
                    *(LAS f32x4*)dst = (f32x4){o[0], o[1], o[2], o[3]}; *(LAS f32x4*)(dst + 4) = (f32x4){o[4], o[5], o[6], o[7]};
                } else if (g < 32) {
                    float o[8];
#pragma unroll
                    for (int e = 0; e < 8; ++e) o[e] = siluf_(f[e]);
                    *(LAS u32x4*)(lds + HC_RAWQ + (j * 128 + 8 * (g - 16)) * 2) = pack8(o);
                } else {
                    const int v0 = 8 * (g - 32);
                    LAS char* vt = lds + HC_SUB + (j >> 4) * HS_SIZE + HS_VT;
#pragma unroll
                    for (int e = 0; e < 8; ++e) { const unsigned wv = rc[s][e >> 1]; *(LAS bf16_t*)(vt + (v0 + e) * HL_T + (j & 15) * 2) = (bf16_t)((e & 1) ? (wv >> 16) : (wv & 0xffffu)); }
                }
            }
        }
        if (tid < 64) ((LAS int*)(lds + HC_ROWS))[tid] = rrow;
    };
    auto storeB = [&]() {
        const int d = tid & 127, sb = tid >> 7;
        LAS char* st = lds + HC_SUB + sb * HS_SIZE;
        const LAS float* rf = (const LAS float*)(lds + HC_RAWF) + (sb * 16) * 128 + d;
        const LAS bf16_t* rq = (const LAS bf16_t*)(lds + HC_RAWQ) + (sb * 16) * 128 + d;
        float E = 1.f, einv[16], kfs[16];
#pragma unroll
        for (int t = 0; t < 16; ++t) {
            const float f = rf[t * 128];
            E *= f;
            const float kf = 1.f - f, ei = __builtin_amdgcn_rcpf(E);
            einv[t] = ei; kfs[t] = kf;
            *(LAS bf16_t*)(st + HS_QI + t * HL_QD + d * 2) = f2bf(bf2f(rq[t * 128]) * E);
            *(LAS bf16_t*)(st + HS_KO + t * HL_QD + d * 2) = f2bf(kf * ei);
        }
        float ke[16];
#pragma unroll
        for (int t = 0; t < 16; ++t) ke[t] = kfs[t] * (E * einv[t]);
        *(LAS u32x4*)(st + HS_KET + d * HL_T) = pack8(ke); *(LAS u32x4*)(st + HS_KET + d * HL_T + 16) = pack8(ke + 8);
        ((LAS float*)(st + HS_DEC))[d] = E;
    };
    f32x4 sacc[2];
    sacc[0] = sacc[1] = (f32x4){0.f, 0.f, 0.f, 0.f};
    __syncthreads();
    load(0);
    for (int c = 0; c < NSTEPS / 64; ++c) {
        storeA();
        __syncthreads();
        storeB();
        if (c + 1 < NSTEPS / 64) load(c + 1);
        __syncthreads();
        if (wid < 4) {
            LAS char* st = lds + HC_SUB + wid * HS_SIZE;
            f32x4 acc = (f32x4){0.f, 0.f, 0.f, 0.f};
#pragma unroll
            for (int k0 = 0; k0 < 128; k0 += 32) acc = __builtin_amdgcn_mfma_f32_16x16x32_bf16(ldfrag(st + HS_KO, HL_QD, 0, k0, lane), ldfrag(st + HS_QI, HL_QD, 0, k0, lane), acc, 0, 0, 0);
#pragma unroll
            for (int j = 0; j < 4; ++j) acc[j] = (4 * q + j <= r16) ? acc[j] : 0.f;
            st4bf(st + HS_ATT + r16 * HL_T + 4 * q * 2, acc);
        }
        __syncthreads();
#pragma unroll 1
        for (int sb = 0; sb < 4; ++sb) {
            LAS char* st = lds + HC_SUB + sb * HS_SIZE;
            const LAS char* sbr = lds + HC_SB + (sb & 1) * 32 * HL_QD;
            LAS char* sbw = lds + HC_SB + ((sb + 1) & 1) * 32 * HL_QD;
            if (wid < 2) {
                f32x4 ya = __builtin_amdgcn_mfma_f32_16x16x32_bf16(ldfrag16(st + HS_VT, HL_T, wid * 16, lane), ldfrag16(st + HS_ATT, HL_T, 0, lane), (f32x4){0.f, 0.f, 0.f, 0.f}, 0, 0, 0);
#pragma unroll
                for (int k0 = 0; k0 < 128; k0 += 32) ya = __builtin_amdgcn_mfma_f32_16x16x32_bf16(ldfrag(sbr, HL_QD, wid * 16, k0, lane), ldfrag(st + HS_QI, HL_QD, 0, k0, lane), ya, 0, 0, 0);
                const int row = ((const LAS int*)(lds + HC_ROWS))[sb * 16 + r16];
                u32x2 o; o.x = pk2(ya[0], ya[1]); o.y = pk2(ya[2], ya[3]);
                *(u32x2*)(Y + (size_t)row * D + h * 128 + quarter * 32 + wid * 16 + 4 * q) = o;
            }
            {
                const int vt = wid >> 2;
                const bf16x8 vf = ldfrag16(st + HS_VT, HL_T, vt * 16, lane);
#pragma unroll
                for (int u = 0; u < 2; ++u) {
                    const int dt = (wid & 3) * 2 + u;
                    const f32x4 a = __builtin_amdgcn_mfma_f32_16x16x32_bf16(ldfrag16(st + HS_KET, HL_T, dt * 16, lane), vf, (f32x4){0.f, 0.f, 0.f, 0.f}, 0, 0, 0);
                    const f32x4 dc = *(const LAS f32x4*)((const LAS float*)(st + HS_DEC) + dt * 16 + 4 * q);
#pragma unroll
                    for (int j = 0; j < 4; ++j) sacc[u][j] = sacc[u][j] * dc[j] + a[j];
                    st4bf(sbw + (vt * 16 + r16) * HL_QD + (dt * 16 + 4 * q) * 2, sacc[u]);
                }
            }
            __syncthreads();
        }
    }
}

constexpr int RC_RAWW = 0;
constexpr int RC_RAWA = RC_RAWW + 64 * 64 * 4;
constexpr int RC_RAWB = RC_RAWA + 64 * 64 * 2, RC_RAWK = RC_RAWB + 64 * 64 * 2, RC_RAWR = RC_RAWK + 64 * 64 * 2;
constexpr int RC_SUB = RC_RAWR + 64 * 64 * 2;
constexpr int RL_C = 72 * 2, RL_32 = 40 * 2, RL_16 = 24 * 2;
constexpr int RS_AT = 0, RS_RT = RS_AT + 16 * RL_C, RS_KT = RS_RT + 16 * RL_C, RS_BT = RS_KT + 16 * RL_C, RS_KBH = RS_BT + 16 * RL_C, RS_AAK = RS_KBH + 64 * RL_32,
              RS_ARKB = RS_AAK + 16 * RL_16, RS_T = RS_ARKB + 16 * RL_32, RS_AABF = RS_T + 16 * RL_16, RS_GL = RS_AABF + 16 * 16 * 4, RS_VU = RS_GL + 256, RS_SIZE = RS_VU + 32 * RL_32;
constexpr int RC_SB = RC_SUB + 4 * RS_SIZE;
constexpr int RC_RHT = RC_SB + 32 * RL_C;
constexpr int RC_ROWS = RC_RHT + 32 * RL_16, RC_END = RC_ROWS + 256;
static_assert(RC_END <= LDS_BYTES - 16, "RWKV LDS map");
static_assert(RS_SIZE % 16 == 0 && RC_SB % 16 == 0 && RC_RHT % 16 == 0, "alignment");

__device__ __forceinline__ float allreduce8(float v) {
    v += dppmov<0xB1>(v); v += dppmov<0x4E>(v); v += dppmov<0x141>(v);
    return v;
}

__device__ __forceinline__ void phase_prep1(int wv, KP Pk, int layer) {
    asm volatile("" : "+s"(Pk));
    const CAS Params& P = *Pk;
    const int tid = ltid(wv), lane = tid & 63, wid = tid >> 6, i_ = layer >> 1;
    const bf16_t* Pb = (const bf16_t*)(P.ws + WS_P);
    bf16_t* R = (bf16_t*)(P.ws + WS_RWR); bf16_t* K = (bf16_t*)(P.ws + WS_RWK); bf16_t* V = (bf16_t*)(P.ws + WS_RWV); bf16_t* KK = (bf16_t*)(P.ws + WS_RWKK);
    bf16_t* LA = (bf16_t*)(P.ws + WS_LA);
    const float* mu = P.rw_mu + (size_t)i_ * 1856;
    float mur[8], muv[8], muk[8], mul_[8], kkw[8];
#pragma unroll
    for (int e = 0; e < 8; ++e) { mur[e] = mu[8 * lane + e]; muv[e] = mu[1024 + 8 * lane + e]; muk[e] = mu[512 + 8 * lane + e]; mul_[e] = lane < 40 ? mu[1536 + 8 * lane + e] : 0.f; kkw[e] = P.rw_k_k[i_ * 512 + 8 * lane + e]; }
    u32x4 nq[4][3]; float nmp = 0.f, nmn = 0.f;
    auto fetch = [&](int r) {
        int rprev = -1, rnext = -1;
        if (r < NCTX) { const int t = r & 255; if (t > 0) rprev = r - 1; if (t < CTXL - 1) rnext = r + 1; }
        else {
            const int bs = (r - NCTX) >> 13, s = (r - NCTX) & 8191, sg = ((s & 63) << 7) + (s >> 6);
            if (sg > 0) { const int g2 = sg - 1; rprev = NCTX + bs * SEQ + ((g2 & 127) << 6) + (g2 >> 7); }
            if (sg < SEQ - 1) { const int g2 = sg + 1; rnext = NCTX + bs * SEQ + ((g2 & 127) << 6) + (g2 >> 7); }
        }
        const bf16_t* pc = Pb + (size_t)r * LDP_ODD + 2560;
        const bf16_t* pp = Pb + (size_t)(rprev < 0 ? r : rprev) * LDP_ODD + 2560;
        const bf16_t* pn = Pb + (size_t)(rnext < 0 ? r : rnext) * LDP_ODD + 2560;
        nmp = rprev < 0 ? 0.f : 0.5f; nmn = rnext < 0 ? 0.f : 0.5f;
#pragma unroll
        for (int gq = 0; gq < 4; ++gq) {
            const int col = (gq == 0 ? 0 : gq == 1 ? 1024 : gq == 2 ? 512 : 1536) + 8 * lane;
            if (gq < 3 || lane < 40) { nq[gq][0] = *(const u32x4*)(pc + col); nq[gq][1] = *(const u32x4*)(pp + col); nq[gq][2] = *(const u32x4*)(pn + col); }
        }
    };
    nq[3][0] = nq[3][1] = nq[3][2] = (u32x4){0u, 0u, 0u, 0u};
    const int stride = gridDim.x * 8;
    int r = blockIdx.x * 8 + wid;
    if (r < NROWS) fetch(r);
    for (; r < NROWS; r += stride) {
        u32x4 cq[4][3];
#pragma unroll
        for (int gq = 0; gq < 4; ++gq)
#pragma unroll
            for (int k = 0; k < 3; ++k) cq[gq][k] = nq[gq][k];
        const float mp = nmp, mn = nmn;
        if (r + stride < NROWS) fetch(r + stride);
        auto mix8 = [&](const u32x4 (&c)[3], const float* muc, float* o) {
            float fc[8], fp[8], fn[8];
            unpack8(c[0], fc); unpack8(c[1], fp); unpack8(c[2], fn);
#pragma unroll
            for (int e = 0; e < 8; ++e) o[e] = fc[e] + muc[e] * (mp * fp[e] + mn * fn[e] - fc[e]);
        };
        float o[8];
        mix8(cq[0], mur, o); *(u32x4*)(R + (size_t)r * 512 + 8 * lane) = pack8(o);
        mix8(cq[1], muv, o); *(u32x4*)(V + (size_t)r * 512 + 8 * lane) = pack8(o);
        mix8(cq[2], muk, o); *(u32x4*)(K + (size_t)r * 512 + 8 * lane) = pack8(o);
        {
            float kk[8], ss = 0.f;
#pragma unroll
            for (int e = 0; e < 8; ++e) { kk[e] = o[e] * kkw[e]; ss += kk[e] * kk[e]; }
            ss = group_sum<8>(ss);
            const float rn = rsqrtf(fmaxf(ss, 1e-12f));
#pragma unroll
            for (int e = 0; e < 8; ++e) kk[e] *= rn;
            *(u32x4*)(KK + (size_t)r * 512 + 8 * lane) = pack8(kk);
        }
        if (lane < 40) {
            mix8(cq[3], mul_, o);
            if (lane < 16) {
#pragma unroll
                for (int e = 0; e < 8; ++e) o[e] = tanh_fast(o[e]);
            } else if (lane >= 24) {
#pragma unroll
                for (int e = 0; e < 8; ++e) o[e] = sigmoidf_(o[e]);
            }
            *(u32x4*)(LA + (size_t)r * 320 + 8 * lane) = pack8(o);
        }
    }
}

__device__ __forceinline__ void phase_out_even(int wv, KP Pk, int layer) {
    asm volatile("" : "+s"(Pk));
    const CAS Params& P = *Pk;
    const int tid = ltid(wv), lane = tid & 63, wid = tid >> 6, i_ = layer >> 1;
    const bf16_t* Pb = (const bf16_t*)(P.ws + WS_P);
    const bf16_t* Yf = (const bf16_t*)(P.ws + WS_YF); const bf16_t* Yb = (const bf16_t*)(P.ws + WS_YB);
    bf16_t* feat = (bf16_t*)(P.ws + WS_FEAT);
    const int r0 = (layer == DEPTH - 1) ? NCTX : 0;
    const bf16_t* XBC = (const bf16_t*)(P.ws + WS_EXBC);
    float nwa[8], nwb[8];
#pragma unroll
    for (int e = 0; e < 8; ++e) { nwa[e] = P.ssd_norm_w[i_ * 512 + 8 * lane + e]; nwb[e] = P.ml_norm_w[i_ * 512 + 8 * lane + e]; }
    const float dsk = P.ssd_d[i_ * 8 + (lane >> 3)];
    u32x4 n0, n1, n2, n3, n4, n5, n6;
    auto fetch = [&](int rr) {
        const bf16_t* pr = Pb + (size_t)rr * LDP_EVEN;
        n0 = *(const u32x4*)(Yf + (size_t)rr * D + 8 * lane); n1 = *(const u32x4*)(Yb + (size_t)rr * D + 8 * lane);
        n2 = *(const u32x4*)(XBC + (size_t)rr * 768 + 8 * lane); n3 = *(const u32x4*)(pr + 8 * lane);
        n4 = *(const u32x4*)(Yf + (size_t)rr * D + 512 + 8 * lane); n5 = *(const u32x4*)(Yb + (size_t)rr * D + 512 + 8 * lane); n6 = *(const u32x4*)(pr + 2320 + 8 * lane);
    };
    const int stride = gridDim.x * 8;
    int r = r0 + blockIdx.x * 8 + wid;
    if (r < NROWS) fetch(r);
    for (; r < NROWS; r += stride) {
        const u32x4 c0 = n0, c1 = n1, c2 = n2, c3 = n3, c4 = n4, c5 = n5, c6 = n6;
        if (r + stride < NROWS) fetch(r + stride);
        float y[8];
        {
            float a[8], bb[8], xsv[8], z[8];
            unpack8(c0, a); unpack8(c1, bb);
            unpack8(c2, xsv); unpack8(c3, z);
            float ss = 0.f;
#pragma unroll
            for (int e = 0; e < 8; ++e) {
                y[e] = (a[e] + bb[e] + dsk * xsv[e]) * siluf_(z[e]); ss += y[e] * y[e];
            }
            ss = wave_sum(ss);
            const float rn = rsqrtf(ss * (1.f / 512.f) + 1e-6f);
#pragma unroll
            for (int e = 0; e < 8; ++e) y[e] = y[e] * rn * nwa[e];
            *(u32x4*)(feat + (size_t)r * D + 8 * lane) = pack8(y);
        }
        {
            float a[8], bb[8], o[8];
            unpack8(c4, a); unpack8(c5, bb);
            unpack8(c6, o);
            float s = 0.f;
#pragma unroll
            for (int e = 0; e < 8; ++e) { y[e] = a[e] + bb[e]; s += y[e]; }
            const float mean = group_sum<16>(s) * (1.f / 128.f);
            float ss = 0.f;
#pragma unroll
            for (int e = 0; e < 8; ++e) { y[e] -= mean; ss += y[e] * y[e]; }
            const float rn = rsqrtf(group_sum<16>(ss) * (1.f / 128.f) + 1e-6f);
#pragma unroll
            for (int e = 0; e < 8; ++e) y[e] = sigmoidf_(o[e]) * (y[e] * rn) * nwb[e];
            *(u32x4*)(feat + (size_t)r * D + 512 + 8 * lane) = pack8(y);
        }
    }
}
__device__ __forceinline__ void phase_out_odd(int wv, KP Pk, int layer) {
    asm volatile("" : "+s"(Pk));
    const CAS Params& P = *Pk;
    const int tid = ltid(wv), lane = tid & 63, wid = tid >> 6, i_ = layer >> 1;
    const bf16_t* Pb = (const bf16_t*)(P.ws + WS_P);
    const bf16_t* Yf = (const bf16_t*)(P.ws + WS_YF); const bf16_t* Yb = (const bf16_t*)(P.ws + WS_YB);
    const bf16_t* R = (const bf16_t*)(P.ws + WS_RWR); const bf16_t* K = (const bf16_t*)(P.ws + WS_RWK); const bf16_t* V = (const bf16_t*)(P.ws + WS_RWV); const bf16_t* G = (const bf16_t*)(P.ws + WS_RWG);
    bf16_t* feat = (bf16_t*)(P.ws + WS_FEAT);
    const int r0 = (layer == DEPTH - 1) ? NCTX : 0;
    float nwc[8], rk[8], lw[8], lbv[8];
#pragma unroll
    for (int e = 0; e < 8; ++e) {
        nwc[e] = P.hg_norm_w[i_ * 512 + 8 * lane + e]; rk[e] = P.rw_r_k[i_ * 512 + 8 * lane + e];
        lw[e] = P.rw_ln_w[i_ * 512 + 8 * lane + e]; lbv[e] = P.rw_ln_b[i_ * 512 + 8 * lane + e];
    }
    u32x4 n0, n1, n2, n3, n4, n5, n6, n7, n8;
    auto fetch = [&](int rr) {
        n0 = *(const u32x4*)(Yf + (size_t)rr * D + 8 * lane); n1 = *(const u32x4*)(Yb + (size_t)rr * D + 8 * lane); n2 = *(const u32x4*)(Pb + (size_t)rr * LDP_ODD + 2048 + 8 * lane);
        n3 = *(const u32x4*)(Yf + (size_t)rr * D + 512 + 8 * lane); n4 = *(const u32x4*)(Yb + (size_t)rr * D + 512 + 8 * lane);
        n5 = *(const u32x4*)(R + (size_t)rr * 512 + 8 * lane); n6 = *(const u32x4*)(K + (size_t)rr * 512 + 8 * lane);
        n7 = *(const u32x4*)(V + (size_t)rr * 512 + 8 * lane); n8 = *(const u32x4*)(G + (size_t)rr * 512 + 8 * lane);
    };
    const int stride = gridDim.x * 8;
    int r = r0 + blockIdx.x * 8 + wid;
    if (r < NROWS) fetch(r);
    for (; r < NROWS; r += stride) {
        const u32x4 c0 = n0, c1 = n1, c2 = n2, c3 = n3, c4 = n4, c5 = n5, c6 = n6, c7 = n7, c8 = n8;
        if (r + stride < NROWS) fetch(r + stride);
        float y[8];
        {
            float a[8], bb[8], g[8];
            unpack8(c0, a); unpack8(c1, bb);
            unpack8(c2, g);
            float ss = 0.f;
#pragma unroll
            for (int e = 0; e < 8; ++e) { y[e] = a[e] + bb[e]; ss += y[e] * y[e]; }
            const float rn = rsqrtf(group_sum<16>(ss) * (1.f / 128.f) + 1e-6f);
#pragma unroll
            for (int e = 0; e < 8; ++e) y[e] = y[e] * rn * nwc[e] * siluf_(g[e]);
            *(u32x4*)(feat + (size_t)r * D + 8 * lane) = pack8(y);
        }
        {
            float a[8], bb[8], rr[8], kk[8], vv[8], g[8];
            unpack8(c3, a); unpack8(c4, bb);
            unpack8(c5, rr); unpack8(c6, kk);
            unpack8(c7, vv); unpack8(c8, g);
            float s = 0.f, bs = 0.f;
#pragma unroll
            for (int e = 0; e < 8; ++e) { y[e] = a[e] + bb[e]; s += y[e]; bs += rr[e] * kk[e] * rk[e]; }
            const float mean = group_sum<8>(s) * (1.f / 64.f); bs = group_sum<8>(bs);
            float ss = 0.f;
#pragma unroll
            for (int e = 0; e < 8; ++e) { y[e] -= mean; ss += y[e] * y[e]; }
            const float rn = rsqrtf(group_sum<8>(ss) * (1.f / 64.f) + 64e-5f);
#pragma unroll
            for (int e = 0; e < 8; ++e) y[e] = (y[e] * rn * lw[e] + lbv[e] + bs * vv[e]) * g[e];
            *(u32x4*)(feat + (size_t)r * D + 512 + 8 * lane) = pack8(y);
        }
    }
}

#ifndef MK_DOUBLE
#define MK_DOUBLE 0
#endif
#define REP(bit, body) do { body; if (MK_DOUBLE & (bit)) { body; } } while (0)
__device__ __forceinline__ void phase_expconv(int wv, KP Pk, int layer, LAS char* lds) {
    asm volatile("" : "+s"(Pk));
    const CAS Params& P = *Pk;
    const int tid = ltid(wv);
    if (layer & 1) return;
    expconv_items(P, layer, lds, exc_s0(layer) + exc_s1(layer), EXC_ITEMS, (int)blockIdx.x * 8 + (tid >> 6), (int)gridDim.x * 8, tid >> 6, tid & 63);
}
__device__ __forceinline__ void expconv_after_scan(int wv, KP Pk, int layer, LAS char* lds) {
    asm volatile("" : "+s"(Pk));
    const CAS Params& P = *Pk;
    const int tid = ltid(wv);
    __syncthreads();
    expconv_items(P, layer, lds, exc_s0(layer) + exc_s1(layer), EXC_ITEMS, (int)blockIdx.x * 8 + (tid >> 6), 128 * 8, tid >> 6, tid & 63);
}
constexpr int L1_AST = 1028;
constexpr int L1_PST = 33;
constexpr int L1_A = 0, L1_PART = L1_A + 16 * L1_AST * 4, L1_SM = L1_PART + 8 * 16 * L1_PST * 4, L1_END = L1_SM + (64 + 2 * 144 + 32) * 4;
static_assert(L1_END <= LDS_BYTES - 16, "LN1 LDS map");
__device__ __forceinline__ void phase_ln1(int wv, KP Pk, int layer, LAS char* lds, bool dry = false) {
    asm volatile("" : "+s"(Pk));
    const CAS Params& P = *Pk;
    const int tid = ltid(wv), lane = tid & 63;
    if (!dry) REP(8, phase_expconv(wv, Pk, layer, lds));
    __syncthreads();
    LAS float* At = (LAS float*)(lds + L1_A);
    LAS float* part = (LAS float*)(lds + L1_PART);
    LAS int* lcnt = (LAS int*)(lds + L1_SM);
    LAS int* lbase = lcnt + 32;
    LAS int* asg = lcnt + 64;
    LAS float* rbias = (LAS float*)(asg + 2 * 144);
    if (tid < 32) { lcnt[tid] = 0; rbias[tid] = P.router_bias[tid]; }
    float breg[8][4][2];
    {
        const float* rw = P.router_w + (size_t)(128 * wv + 4 * (lane >> 4)) * NEXP + (lane & 15);
#pragma unroll
        for (int j = 0; j < 8; ++j)
#pragma unroll
            for (int i = 0; i < 4; ++i) { breg[j][i][0] = rw[(16 * j + i) * NEXP]; breg[j][i][1] = rw[(16 * j + i) * NEXP + 16]; }
    }
    __syncthreads();
    const bf16_t* yo = (const bf16_t*)(P.ws + WS_YO);
    bf16_t* act = (bf16_t*)(P.ws + (dry ? WS_FEAT : WS_ACT));
    bf16_t* xcb = (bf16_t*)(P.ws + WS_XC); bf16_t* xob = (bf16_t*)P.out;
    const bool lastl = (layer == DEPTH - 1);
    int* cnt = (int*)(P.ws + WS_CNT) + layer * 32 * CNT_STRIDE;
    int* list = (int*)(P.ws + WS_LIST);
    float* wts = (float*)(P.ws + WS_WTS);
    const float* lg = P.ln_g + (size_t)(layer * 2 + 0) * D; const float* lb = P.ln_b + (size_t)(layer * 2 + 0) * D;
    const int r0 = (layer == DEPTH - 1) ? NCTX : 0, ntiles = (NROWS - r0) / 16, G = gridDim.x;
    f32x4 g1v[4], s2c[4], h2c[4];
#pragma unroll
    for (int i = 0; i < 4; ++i) g1v[i] = s2c[i] = h2c[i] = (f32x4){0.f, 0.f, 0.f, 0.f};
    int mcur = -1;
    f32x4 nx[2][4]; u32x2 nyo[2][4];
    auto fetch = [&](int s, int rr) {
        if (layer == 0) {
            const float* xq = rr < NCTX ? P.ctx + (size_t)rr * D : P.x + (size_t)(rr - NCTX) * D;
#pragma unroll
            for (int i = 0; i < 4; ++i) nx[s][i] = *(const f32x4*)(xq + 4 * lane + 256 * i);
        } else {
            const bf16_t* xq = rr < NCTX ? xcb + (size_t)rr * D : xob + (size_t)(rr - NCTX) * D;
#pragma unroll
            for (int i = 0; i < 4; ++i) { const u32x2 t = *(const u32x2*)(xq + 4 * lane + 256 * i); nx[s][i] = (f32x4){__uint_as_float(t.x), __uint_as_float(t.y), 0.f, 0.f}; }
        }
#pragma unroll
        for (int i = 0; i < 4; ++i) { const int c = 4 * lane + 256 * i; nyo[s][i] = *(const u32x2*)(yo + (size_t)rr * D + c); }
    };
    int tile = blockIdx.x;
    if (tile < ntiles) { fetch(0, r0 + tile * 16 + 2 * wv); fetch(1, r0 + tile * 16 + 2 * wv + 1); }
    for (int it = 0; tile < ntiles; ++it, tile += G) {
        const int rb = r0 + tile * 16 + 2 * wv;
        const int m = row_mod(rb);
        if (m != mcur) {
            mcur = m;
            const float* g1 = modvec(P.ws, layer, m, 2); const float* sh2 = modvec(P.ws, layer, m, 3); const float* sc2 = modvec(P.ws, layer, m, 4);
#pragma unroll
            for (int i = 0; i < 4; ++i) { const int c = 4 * lane + 256 * i; g1v[i] = *(const f32x4*)(g1 + c); s2c[i] = *(const f32x4*)(sc2 + c); h2c[i] = *(const f32x4*)(sh2 + c); }
        }
#pragma unroll
        for (int s = 0; s < 2; ++s) {
            const int r = rb + s;
            bf16_t* xr = dry ? (bf16_t*)(P.ws + WS_YF) + (size_t)r * D : lastl ? (bf16_t*)(P.ws + WS_FEAT) + (size_t)r * D : r < NCTX ? xcb + (size_t)r * D : xob + (size_t)(r - NCTX) * D;
            f32x4 v[4]; float sm = 0.f;
#pragma unroll
            for (int i = 0; i < 4; ++i) {
                f32x4 xv = nx[s][i]; const f32x4 gv = g1v[i]; const u32x2 yv = nyo[s][i];
                if (layer != 0) { const unsigned b0 = __float_as_uint(xv[0]), b1 = __float_as_uint(xv[1]); xv = (f32x4){bflo(b0), bfhi(b0), bflo(b1), bfhi(b1)}; }
                v[i][0] = ALPHA * xv[0] + gv[0] * bflo(yv.x); v[i][1] = ALPHA * xv[1] + gv[1] * bfhi(yv.x);
                v[i][2] = ALPHA * xv[2] + gv[2] * bflo(yv.y); v[i][3] = ALPHA * xv[3] + gv[3] * bfhi(yv.y);
                sm += (v[i][0] + v[i][1]) + (v[i][2] + v[i][3]);
            }
            if (tile + G < ntiles) fetch(s, r + G * 16);
            const float mean = wave_sum(sm) * (1.f / D);
            float s2 = 0.f;
#pragma unroll
            for (int i = 0; i < 4; ++i) { v[i] = v[i] - mean; s2 += (v[i][0] * v[i][0] + v[i][1] * v[i][1]) + (v[i][2] * v[i][2] + v[i][3] * v[i][3]); }
            const float rstd = rsqrtf(wave_sum(s2) * (1.f / D) + 1e-5f);
            LAS float* arow = At + (2 * wv + s) * L1_AST;
#pragma unroll
            for (int i = 0; i < 4; ++i) {
                const int c = 4 * lane + 256 * i;
                const f32x4 gg = *(const f32x4*)(lg + c), bb = *(const f32x4*)(lb + c), s2v = s2c[i], h2v = h2c[i];
                f32x4 xn, hv;
#pragma unroll
                for (int j = 0; j < 4; ++j) { xn[j] = v[i][j] * rstd * gg[j] + bb[j]; hv[j] = xn[j] * (1.f + s2v[j]) + h2v[j]; }
                { u32x2 ox; ox.x = pk2(xn[0], xn[1]); ox.y = pk2(xn[2], xn[3]); *(u32x2*)(xr + c) = ox; }
                u32x2 o; o.x = pk2(hv[0], hv[1]); o.y = pk2(hv[2], hv[3]); *(u32x2*)(act + (size_t)r * D + c) = o;
                *(LAS f32x4*)(arow + c) = hv;
            }
        }
        __syncthreads();
        {
            f32x4 ra0 = (f32x4){0.f, 0.f, 0.f, 0.f}, ra1 = ra0;
            const LAS float* ap = At + (lane & 15) * L1_AST + 128 * wv + 4 * (lane >> 4);
#pragma unroll
            for (int j = 0; j < 8; ++j) {
                const f32x4 a4 = *(const LAS f32x4*)(ap + 16 * j);
#pragma unroll
                for (int i = 0; i < 4; ++i) {
                    ra0 = __builtin_amdgcn_mfma_f32_16x16x4f32(a4[i], breg[j][i][0], ra0, 0, 0, 0);
                    ra1 = __builtin_amdgcn_mfma_f32_16x16x4f32(a4[i], breg[j][i][1], ra1, 0, 0, 0);
                }
            }
            LAS float* pw = part + wv * 16 * L1_PST + (4 * (lane >> 4)) * L1_PST + (lane & 15);
#pragma unroll
            for (int j = 0; j < 4; ++j) { pw[j * L1_PST] = ra0[j]; pw[j * L1_PST + 16] = ra1[j]; }
        }
        __syncthreads();
        {
            const int half = lane >> 5, e = lane & 31;
            const LAS float* pp = part + (2 * wv + half) * L1_PST + e;
            float sc_ = 0.f;
#pragma unroll
            for (int k = 0; k < 8; ++k) sc_ += pp[k * 16 * L1_PST];
            const float sg = sigmoidf_(sc_), vb = sg + rbias[e];
            float bv[4], sv[4];
            bv[0] = dppmov<0x00>(vb); bv[1] = dppmov<0x55>(vb); bv[2] = dppmov<0xAA>(vb); bv[3] = dppmov<0xFF>(vb);
            sv[0] = dppmov<0x00>(sg); sv[1] = dppmov<0x55>(sg); sv[2] = dppmov<0xAA>(sg); sv[3] = dppmov<0xFF>(sg);
            float m1 = -1e30f, m2 = -1e30f;
#pragma unroll
            for (int k = 0; k < 4; ++k) { const float vsc = bv[k]; if (vsc > m1) { m2 = m1; m1 = vsc; } else if (vsc > m2) m2 = vsc; }
            float best = m1 + m2; int bg = e >> 2;
#pragma unroll
            for (int msk = 4; msk <= 16; msk <<= 1) {
                const float ob = __shfl_xor(best, msk); const int og = __shfl_xor(bg, msk);
                const bool take = (ob > best) || (ob == best && og < bg);
                best = take ? ob : best; bg = take ? og : bg;
            }
            int i1 = 0; float b1 = bv[0];
#pragma unroll
            for (int k = 1; k < 4; ++k) if (bv[k] > b1) { b1 = bv[k]; i1 = k; }
            int i2 = -1; float b2 = -1e30f;
#pragma unroll
            for (int k = 0; k < 4; ++k) if (k != i1 && bv[k] > b2) { b2 = bv[k]; i2 = k; }
            float s1 = sv[0], s2s = sv[0];
#pragma unroll
            for (int k = 1; k < 4; ++k) { if (i1 == k) s1 = sv[k]; if (i2 == k) s2s = sv[k]; }
            if (e == 4 * bg && !dry) {
                const int r = rb + half;
                const int e0 = bg * 4 + i1, e1 = bg * 4 + i2;
                const float inv = 1.f / (s1 + s2s);
                const int li = it * 16 + 2 * wv + half;
                const int p0 = __hip_atomic_fetch_add(&lcnt[e0], 1, __ATOMIC_RELAXED, __HIP_MEMORY_SCOPE_WORKGROUP);
                const int p1 = __hip_atomic_fetch_add(&lcnt[e1], 1, __ATOMIC_RELAXED, __HIP_MEMORY_SCOPE_WORKGROUP);
                asg[2 * li] = (e0 << 16) | p0; asg[2 * li + 1] = (e1 << 16) | p1;
                wts[2 * r] = s1 * inv; wts[2 * r + 1] = s2s * inv;
            }
        }
    }
    __syncthreads();
    if (dry) return;
    if (tid < 32) lbase[tid] = atomicAdd(&cnt[tid * CNT_STRIDE], lcnt[tid]);
    __syncthreads();
    for (int idx = tid; idx < 2 * 144; idx += NT) {
        const int li = idx >> 1, k = idx & 1, t = (li >> 4) * G + blockIdx.x;
        if (t < ntiles) { const int r = r0 + t * 16 + (li & 15); const int v = asg[idx], e = v >> 16, lp = v & 0xffff; list[(size_t)e * LISTCAP + lbase[e] + lp] = 2 * r + k; }
    }
}

__device__ __forceinline__ void phase_ln2(int wv, KP Pk, int layer, bool dry = false) {
    asm volatile("" : "+s"(Pk));
    const CAS Params& P = *Pk;
    const int tid = ltid(wv), lane = tid & 63, wid = tid >> 6;
    const bf16_t* yp = (const bf16_t*)(P.ws + WS_YP);
    const float* wts = (const float*)(P.ws + WS_WTS);
    bf16_t* act = (bf16_t*)(P.ws + (dry ? WS_FEAT : WS_ACT));
    bf16_t* xcb = (bf16_t*)(P.ws + WS_XC); bf16_t* xob = (bf16_t*)P.out;
    const float* lg = P.ln_g + (size_t)(layer * 2 + 1) * D; const float* lb = P.ln_b + (size_t)(layer * 2 + 1) * D;
    const bool last = (layer == DEPTH - 1);
    const int r0 = last ? NCTX : 0, stride = gridDim.x * 8;
    f32x4 cg[4], cb[4], g2v[4], s1v[4], h1v[4];
#pragma unroll
    for (int i = 0; i < 4; ++i) { cg[i] = *(const f32x4*)(lg + 4 * lane + 256 * i); cb[i] = *(const f32x4*)(lb + 4 * lane + 256 * i); g2v[i] = s1v[i] = h1v[i] = (f32x4){0.f, 0.f, 0.f, 0.f}; }
    int mcur = -1;
    u32x2 nx[4]; u32x2 ny0[4], ny1[4]; float nw0 = 0.f, nw1 = 0.f;
    auto fetch = [&](int r) {
        const bf16_t* xr = last ? (const bf16_t*)(P.ws + WS_FEAT) + (size_t)r * D : r < NCTX ? xcb + (size_t)r * D : xob + (size_t)(r - NCTX) * D;
#pragma unroll
        for (int i = 0; i < 4; ++i) {
            const int c = 4 * lane + 256 * i;
            nx[i] = *(const u32x2*)(xr + c); ny0[i] = *(const u32x2*)(yp + (size_t)(2 * r) * D + c); ny1[i] = *(const u32x2*)(yp + (size_t)(2 * r + 1) * D + c);
        }
        nw0 = wts[2 * r]; nw1 = wts[2 * r + 1];
    };
    int r = r0 + blockIdx.x * 8 + wid;
    if (r < NROWS) fetch(r);
    for (; r < NROWS; r += stride) {
        const int m = row_mod(r);
        if (m != mcur) {
            mcur = m;
            const float* g2 = modvec(P.ws, layer, m, 5); const float* sh1 = last ? lg : modvec(P.ws, layer + 1, m, 0); const float* sc1 = last ? lg : modvec(P.ws, layer + 1, m, 1);
#pragma unroll
            for (int i = 0; i < 4; ++i) { const int c = 4 * lane + 256 * i; g2v[i] = *(const f32x4*)(g2 + c); s1v[i] = *(const f32x4*)(sc1 + c); h1v[i] = *(const f32x4*)(sh1 + c); }
        }
        f32x4 v[4]; float s = 0.f;
        const float w0 = nw0, w1 = nw1;
#pragma unroll
        for (int i = 0; i < 4; ++i) {
            const f32x4 xv = (f32x4){bflo(nx[i].x), bfhi(nx[i].x), bflo(nx[i].y), bfhi(nx[i].y)}, gv = g2v[i]; const u32x2 y0 = ny0[i], y1 = ny1[i];
            v[i][0] = ALPHA * xv[0] + gv[0] * (w0 * bflo(y0.x) + w1 * bflo(y1.x)); v[i][1] = ALPHA * xv[1] + gv[1] * (w0 * bfhi(y0.x) + w1 * bfhi(y1.x));
            v[i][2] = ALPHA * xv[2] + gv[2] * (w0 * bflo(y0.y) + w1 * bflo(y1.y)); v[i][3] = ALPHA * xv[3] + gv[3] * (w0 * bfhi(y0.y) + w1 * bfhi(y1.y));
            s += (v[i][0] + v[i][1]) + (v[i][2] + v[i][3]);
        }
        if (r + stride < NROWS) fetch(r + stride);
        const float mean = wave_sum(s) * (1.f / D);
        float s2 = 0.f;
#pragma unroll
        for (int i = 0; i < 4; ++i) { v[i] = v[i] - mean; s2 += (v[i][0] * v[i][0] + v[i][1] * v[i][1]) + (v[i][2] * v[i][2] + v[i][3] * v[i][3]); }
        const float rstd = rsqrtf(wave_sum(s2) * (1.f / D) + 1e-5f);
#pragma unroll
        for (int i = 0; i < 4; ++i) {
            const int c = 4 * lane + 256 * i;
            f32x4 xn;
#pragma unroll
            for (int j = 0; j < 4; ++j) xn[j] = v[i][j] * rstd * cg[i][j] + cb[i][j];
            if (dry) *(f32x4*)((float*)(P.ws + WS_YF) + (size_t)r * D + c) = xn;
            else if (last) *(f32x4*)(P.out + (size_t)(r - NCTX) * D + c) = xn;
            else { u32x2 ox; ox.x = pk2(xn[0], xn[1]); ox.y = pk2(xn[2], xn[3]); *(u32x2*)((r < NCTX ? xcb + (size_t)r * D : xob + (size_t)(r - NCTX) * D) + c) = ox; }
            if (!last) {
                u32x2 o; o.x = pk2(xn[0] * (1.f + s1v[i][0]) + h1v[i][0], xn[1] * (1.f + s1v[i][1]) + h1v[i][1]); o.y = pk2(xn[2] * (1.f + s1v[i][2]) + h1v[i][2], xn[3] * (1.f + s1v[i][3]) + h1v[i][3]);
                *(u32x2*)(act + (size_t)r * D + c) = o;
            }
        }
    }
}

constexpr int NPHASE = 2 + 11 * DEPTH;
__global__ void __launch_bounds__(NT, 2) fwd_kernel(Params P) {
    extern __shared__ __attribute__((aligned(16))) char lds_raw[];
    LAS char* lds = (LAS char*)lds_raw;
    volatile LAS unsigned* xbw = (volatile LAS unsigned*)(lds + LDS_BYTES - 16);
    KP Pk = (KP)__builtin_amdgcn_kernarg_segment_ptr();
    const int wv = __builtin_amdgcn_readfirstlane((int)(threadIdx.x >> 6));
    const bool multi = (P.ph_hi - P.ph_lo) > 1;
    XcdBarrier bar; bar.bar = (unsigned*)(P.ws + WS_BAR); bar.x = 0; bar.st = xbw;
    if (multi) {
        if (ltid(wv) == 0) { xbw[0] = 0u; xbw[1] = 0u; xbw[2] = 0u; xbw[3] = 0u; }
        __syncthreads();
        bar = xcd_barrier_post(wv, (unsigned*)(P.ws + WS_BAR), xbw);
    }
#define PHASE(id, body) do { if (P.ph_lo <= (id) && (id) < P.ph_hi) { body; if ((id) + 1 < P.ph_hi) xcd_barrier(wv, bar); if (MK_DOUBLE & 2048) xcd_barrier(wv, bar); } } while (0)
    PHASE(0, REP(16, phase_prologue0(wv, Pk, lds)));
    PHASE(1, REP(16, phase_prologue1(wv, Pk)));
    for (int l = 0; l < DEPTH; ++l) {
        const int pb = 2 + 11 * l, odd = l & 1;
        PHASE(pb + 0, REP(1, phase_inproj(wv, Pk, l, lds)));
        if (odd) {
            PHASE(pb + 1, REP(4, phase_prep1(wv, Pk, l)));
            PHASE(pb + 2, phase_prep2(wv, Pk, l, lds));
            PHASE(pb + 3, REP(32, { if (blockIdx.x < 128) { REP(64, scan_hgrn_c(wv, Pk, l, blockIdx.x, lds)); expconv_after_scan(wv, Pk, l, lds); } else if (blockIdx.x < 256) REP(128, scan_rwkv_b(wv, Pk, l, blockIdx.x - 128, lds)); }));
            PHASE(pb + 5, REP(4, phase_out_odd(wv, Pk, l)));
        } else {
            PHASE(pb + 1, REP(4, phase_prep_even(wv, Pk, l)));
            PHASE(pb + 2, REP(2, phase_ex1(wv, Pk, l, lds)));
            PHASE(pb + 3, phase_ex2(wv, Pk, l));
            PHASE(pb + 4, REP(2, phase_ex3(wv, Pk, l, lds)));
            PHASE(pb + 5, REP(4, phase_out_even(wv, Pk, l)));
        }
        PHASE(pb + 6, REP(256, phase_outproj(wv, Pk, l, lds)));
        PHASE(pb + 7, { if (MK_DOUBLE & 4096) phase_ln1(wv, Pk, l, lds, true); phase_ln1(wv, Pk, l, lds); });
        PHASE(pb + 8, REP(512, phase_moe1(wv, Pk, l, lds)));
        PHASE(pb + 9, REP(1024, phase_moe2(wv, Pk, l, lds)));
        PHASE(pb + 10, { if (MK_DOUBLE & 8192) phase_ln2(wv, Pk, l, true); phase_ln2(wv, Pk, l); });
    }
#undef PHASE
}


#ifndef MK_STOP
#define MK_STOP NPHASE
#endif
#ifndef MK_DUMP
#define MK_DUMP 0
#endif
#ifndef MK_DUMP_N
#define MK_DUMP_N (1u << 30)
#endif
#ifndef MK_DUMP_LD
#define MK_DUMP_LD 1024
#endif
#ifndef MK_DUMP_C0
#define MK_DUMP_C0 0
#endif
__global__ void diff_kernel(const bf16_t* a, const bf16_t* b, float* out, size_t n) {
    for (size_t i = (size_t)blockIdx.x * blockDim.x + threadIdx.x; i < n; i += (size_t)gridDim.x * blockDim.x) out[i] = 1e6f * (bf2f(a[i]) - bf2f(b[i]));
}
__global__ void dump_kernel(const bf16_t* src, float* out, size_t n) {
    for (size_t i = (size_t)blockIdx.x * blockDim.x + threadIdx.x; i < n; i += (size_t)gridDim.x * blockDim.x) out[i] = i < (size_t)MK_DUMP_N ? bf2f(src[(i >> 10) * MK_DUMP_LD + MK_DUMP_C0 + (i & 1023)]) : 0.f;
}
extern "C" void kernel_launch(void* const* d_in, const int* in_sizes, int n_in, void* d_out, int out_size, void* d_ws, size_t ws_size, hipStream_t stream) {
    static int ready = 0;
    if (ready == 0) {
        ready = 1;
        if (n_in != 42 || out_size != NB * SEQ * D || ws_size < WS_END) { fprintf(stderr, "kernel_launch: unexpected shapes (n_in %d out %d ws %zu need %zu)\n", n_in, out_size, ws_size, (size_t)WS_END); ready = -1; }
        if (hipFuncSetAttribute((const void*)fwd_kernel, hipFuncAttributeMaxDynamicSharedMemorySize, LDS_BYTES) != hipSuccess) { fprintf(stderr, "kernel_launch: hipFuncSetAttribute failed\n"); ready = -1; }
    }
    if (ready < 0) return;
    (void)in_sizes;
    hipMemsetAsync((char*)d_ws + WS_BAR, 0, WS_ZERO_BYTES, stream);
    Params p;
    memset(&p, 0, sizeof(p));
    const float** fp = (const float**)&p;
    for (int i = 0; i < 42; ++i) fp[i] = (const float*)d_in[i];
    p.out = (float*)d_out; p.ws = (unsigned char*)d_ws;
#if MK_PER_PHASE
    for (int ph = 0; ph < MK_STOP; ++ph) {
        const int local = ph < 2 ? -1 : (ph - 2) % 11, layer = ph < 2 ? 0 : (ph - 2) / 11;
        if (local == 4 && (layer & 1)) continue;
        p.ph_lo = ph; p.ph_hi = ph + 1;
        hipLaunchKernelGGL(fwd_kernel, dim3(256), dim3(NT), LDS_BYTES, stream, p);
    }
#ifdef MK_DIFF
    p.ph_lo = 7; p.ph_hi = 8; p.dbg = 1;
    hipLaunchKernelGGL(fwd_kernel, dim3(256), dim3(NT), LDS_BYTES, stream, p);
    hipLaunchKernelGGL(diff_kernel, dim3(1024), dim3(256), 0, stream, (const bf16_t*)((unsigned char*)d_ws + WS_YO), (const bf16_t*)((unsigned char*)d_ws + WS_HID), (float*)d_out, (size_t)NB * SEQ * D);
#else
    if (MK_DUMP) hipLaunchKernelGGL(dump_kernel, dim3(1024), dim3(256), 0, stream, (const bf16_t*)((unsigned char*)d_ws + (size_t)MK_DUMP), (float*)d_out, (size_t)NB * SEQ * D);
#endif
#else
    p.ph_lo = 0; p.ph_hi = NPHASE;
    hipLaunchKernelGGL(fwd_kernel, dim3(256), dim3(NT), LDS_BYTES, stream, p);
#endif
}
```

```cpp
#include <hip/hip_runtime.h>
#include <stdint.h>
#include <stdio.h>
#include <string.h>

#ifndef MK_PER_PHASE
#define MK_PER_PHASE 0
#endif

typedef unsigned short bf16_t;
typedef short bf16x8 __attribute__((ext_vector_type(8)));
typedef float f32x4 __attribute__((ext_vector_type(4)));
typedef unsigned u32x4 __attribute__((ext_vector_type(4)));
typedef unsigned u32x2 __attribute__((ext_vector_type(2)));
#define LAS __attribute__((address_space(3)))
#define CAS __attribute__((address_space(4)))

constexpr int D = 1024, NB = 4, SEQ = 8192, CTXL = 256, DEPTH = 4;
constexpr int NCTX = NB * CTXL;
constexpr int NROWS = NCTX + NB * SEQ;
constexpr int P_EVEN = 2848, P_ODD = 4416, LDP_EVEN = 3072, LDP_ODD = 4608;
constexpr int NEXP = 32, DEXP = 512, LISTCAP = NROWS;
constexpr float ALPHA = 1.681792830507429f;
constexpr int NT = 512;
constexpr int TCH = 32;
constexpr int NSTEPS = CTXL + SEQ;
constexpr int LDS_BYTES = 160 * 1024;

constexpr size_t al256(size_t x) { return (x + 255) & ~(size_t)255; }
constexpr size_t WS_BAR = 0;
constexpr size_t WS_CNT = 16384;
constexpr int CNT_STRIDE = 64;
constexpr size_t WS_ZERO_BYTES = 16384 + (size_t)4 * 32 * CNT_STRIDE * 4;
constexpr size_t WS_MODV = al256(WS_ZERO_BYTES);
constexpr size_t WS_LB = WS_MODV + al256((size_t)4 * 5 * 6144 * 4);
constexpr size_t WS_XC = WS_LB + al256(4 * 512 * 4);
constexpr size_t WS_WTS = WS_XC + (size_t)NCTX * D * 4;
constexpr size_t WS_LIST = WS_WTS + al256((size_t)2 * NROWS * 4);
constexpr size_t WS_WINT = WS_LIST + al256((size_t)NEXP * LISTCAP * 4);
constexpr size_t WINT_L0 = 0, WINT_L1 = (size_t)LDP_EVEN * D, WINT_L2 = WINT_L1 + (size_t)LDP_ODD * D, WINT_L3 = WINT_L2 + (size_t)LDP_EVEN * D, WINT_END = WINT_L3 + (size_t)LDP_ODD * D;
constexpr size_t WS_WOUTT = WS_WINT + WINT_END * 2;
constexpr size_t WS_LORAT = WS_WOUTT + (size_t)4 * D * D * 2;
constexpr size_t LORA_PER = (size_t)512 * 320;
constexpr size_t WS_EXPGU = WS_LORAT + al256(2 * LORA_PER * 2);
constexpr size_t WS_EXPD = WS_EXPGU + (size_t)NEXP * 1024 * 1024 * 2;
constexpr size_t WS_ACT = WS_EXPD + (size_t)NEXP * 1024 * 512 * 2;
constexpr size_t ROWB = (size_t)NROWS * D * 2;
constexpr size_t WS_FEAT = WS_ACT + ROWB;
constexpr size_t WS_YF = WS_FEAT + ROWB;
constexpr size_t WS_YB = WS_YF + ROWB;
constexpr size_t WS_P = WS_YB + ROWB;
constexpr size_t P_BYTES = (size_t)NROWS * LDP_ODD * 2;
constexpr size_t WS_YO = WS_P;
constexpr size_t WS_HID = WS_P + ROWB;
constexpr size_t WS_YP = WS_HID + ROWB;
static_assert(WS_YP + 2 * ROWB <= WS_P + P_BYTES, "MoE buffers must fit in the P region");
constexpr size_t HALFB = (size_t)NROWS * 512 * 2;
constexpr size_t WS_RWR = WS_P + P_BYTES;
constexpr size_t WS_RWK = WS_RWR + HALFB;
constexpr size_t WS_RWV = WS_RWK + HALFB;
constexpr size_t WS_RWKK = WS_RWV + HALFB;
constexpr size_t WS_RWB = WS_RWKK + HALFB;
constexpr size_t WS_RWG = WS_RWB + HALFB;
constexpr size_t WS_RWDEC = WS_RWG + HALFB;
constexpr size_t WS_LA = WS_RWDEC + (size_t)2 * NROWS * 512 * 4;
constexpr size_t WS_END = WS_LA + (size_t)NROWS * 320 * 2;
static_assert(WS_END <= (size_t)280602384 * 4, "workspace map exceeds the guaranteed ws_size");

struct Params {
    const float *x, *c, *ctx, *c_ctx, *mod_w, *mod_b, *ln_g, *ln_b;
    const float *ev_w_in, *ev_w_out, *ssd_conv_w, *ssd_conv_b, *ssd_dt_bias, *ssd_a_log, *ssd_d, *ssd_norm_w;
    const float *ml_conv_w, *ml_conv_b, *ml_i_bias, *ml_f_bias, *ml_norm_w;
    const float *od_w_in, *od_w_out, *hg_lb_logits, *hg_f_bias, *hg_norm_w;
    const float *rw_mu, *rw_w0, *rw_w2, *rw_a0, *rw_a2, *rw_g2, *rw_k_k, *rw_k_a, *rw_r_k, *rw_ln_w, *rw_ln_b;
    const float *router_w, *router_bias, *exp_w_gate, *exp_w_up, *exp_w_down;
    float* out;
    unsigned char* ws;
    int ph_lo, ph_hi, dbg, pad_;
};
typedef const CAS Params* KP;

__device__ __forceinline__ int ltid(int wv) { int l; asm volatile("v_mbcnt_lo_u32_b32 %0, -1, 0\n\tv_mbcnt_hi_u32_b32 %0, -1, %0" : "=v"(l)); return wv * 64 + l; }
__device__ __forceinline__ float bf2f(bf16_t h) { return __uint_as_float(((unsigned)h) << 16); }
__device__ __forceinline__ float bflo(unsigned u) { return __uint_as_float(u << 16); }
__device__ __forceinline__ float bfhi(unsigned u) { return __uint_as_float(u & 0xffff0000u); }
typedef __bf16 bf16v2_t __attribute__((ext_vector_type(2)));
typedef float f32x2 __attribute__((ext_vector_type(2)));
__device__ __forceinline__ unsigned pk2(float lo, float hi) { const f32x2 v = {lo, hi}; return __builtin_bit_cast(unsigned, __builtin_convertvector(v, bf16v2_t)); }
__device__ __forceinline__ bf16_t f2bf(float f) { return (bf16_t)(pk2(f, 0.f) & 0xffffu); }
__device__ __forceinline__ void unpack8(const u32x4& u, float* f) {
    f[0] = bflo(u.x); f[1] = bfhi(u.x); f[2] = bflo(u.y); f[3] = bfhi(u.y); f[4] = bflo(u.z); f[5] = bfhi(u.z); f[6] = bflo(u.w); f[7] = bfhi(u.w);
}
__device__ __forceinline__ u32x4 pack8(const float* f) { u32x4 u; u.x = pk2(f[0], f[1]); u.y = pk2(f[2], f[3]); u.z = pk2(f[4], f[5]); u.w = pk2(f[6], f[7]); return u; }
__device__ __forceinline__ float sigmoidf_(float x) { return __builtin_amdgcn_rcpf(1.f + __expf(-x)); }
__device__ __forceinline__ float siluf_(float x) { return x * __builtin_amdgcn_rcpf(1.f + __expf(-x)); }
__device__ __forceinline__ float softplus_fast(float x) { return x > 20.f ? x : __logf(1.f + __expf(x)); }
__device__ __forceinline__ float tanh_fast(float x) { return 1.f - 2.f * __builtin_amdgcn_rcpf(1.f + __expf(2.f * x)); }
__device__ __forceinline__ float softplusf_(float x) { return x > 20.f ? x : __logf(1.f + __expf(x)); }
__device__ __forceinline__ float logsigmoidf_(float x) { return fminf(x, 0.f) - __logf(1.f + __expf(-fabsf(x))); }
template <int CTRL> __device__ __forceinline__ float dppmov(float v) {
    return __builtin_bit_cast(float, __builtin_amdgcn_update_dpp(0, __builtin_bit_cast(int, v), CTRL, 0xf, 0xf, true));
}
__device__ __forceinline__ float allreduce16(float v) {
    v += dppmov<0xB1>(v);
    v += dppmov<0x4E>(v);
    v += dppmov<0x141>(v);
    v += dppmov<0x140>(v);
    return v;
}
__device__ __forceinline__ float allreduce8_(float v) { v += dppmov<0xB1>(v); v += dppmov<0x4E>(v); v += dppmov<0x141>(v); return v; }
__device__ __forceinline__ float wave_sum(float v) {
    v = allreduce16(v);
    const float r0 = __builtin_bit_cast(float, __builtin_amdgcn_readlane(__builtin_bit_cast(int, v), 0)), r1 = __builtin_bit_cast(float, __builtin_amdgcn_readlane(__builtin_bit_cast(int, v), 16));
    const float r2 = __builtin_bit_cast(float, __builtin_amdgcn_readlane(__builtin_bit_cast(int, v), 32)), r3 = __builtin_bit_cast(float, __builtin_amdgcn_readlane(__builtin_bit_cast(int, v), 48));
    return (r0 + r1) + (r2 + r3);
}
template <int W> __device__ __forceinline__ float group_sum(float v) {
    if (W == 8) return allreduce8_(v);
    return allreduce16(v);
}

#define XB_TMO      128
#define XB_XCNT(j)  (256  + 64 * (j))
#define XB_XSUB(j)  (1280 + 64 * (j))
#define XB_XGEN(j)  (2304 + 64 * (j))
#define XB_TOP      3328
#define XB_TOPGEN   3392
#define XCD_BAR_WORDS 3456
#define XB_SPIN_CAP (1u << 22)
__device__ __forceinline__ unsigned xb_ld(unsigned* p)              { return __hip_atomic_load(p, __ATOMIC_RELAXED, __HIP_MEMORY_SCOPE_AGENT); }
__device__ __forceinline__ unsigned xb_add(unsigned* p, unsigned v) { return __hip_atomic_fetch_add(p, v, __ATOMIC_RELAXED, __HIP_MEMORY_SCOPE_AGENT); }
__device__ __forceinline__ unsigned xb_xcc_id() { return (unsigned)__builtin_amdgcn_s_getreg((3 << 11) | 20) & 0xFu; }
#define XB_SPIN(cond, bar) do { unsigned _sp = 0; while (cond) { __builtin_amdgcn_s_sleep(1); \
    if ((++_sp & 255u) == 0u) { if (xb_ld(&(bar)[XB_TMO])) break; if (_sp > XB_SPIN_CAP) { atomicAdd(&(bar)[XB_TMO], 1u); break; } } } } while (0)
struct XcdBarrier { unsigned* bar; unsigned x; volatile LAS unsigned* st; };
__device__ __forceinline__ XcdBarrier xcd_barrier_post(int wv, unsigned* bar, volatile LAS unsigned* st) {
    XcdBarrier b; b.bar = bar; b.x = xb_xcc_id(); b.st = st;
    if (ltid(wv) == 0) (void)xb_add(&bar[XB_XCNT(b.x)], 1u);
    return b;
}
__device__ __forceinline__ void xcd_barrier_complete(unsigned* bar, unsigned x, unsigned& nloc, unsigned& nx) {
    const unsigned G = gridDim.x * gridDim.y * gridDim.z;
    unsigned sum, cnt, mine, sp = 0u;
    for (;;) {
        sum = 0u; cnt = 0u; mine = 0u;
#pragma unroll
        for (unsigned j = 0; j < 16; ++j) { const unsigned c = xb_ld(&bar[XB_XCNT(j)]); sum += c; cnt += (c > 0u) ? 1u : 0u; mine = (j == x) ? c : mine; }
        if (sum == G) break;
        __builtin_amdgcn_s_sleep(1);
        if ((++sp & 255u) == 0u) { if (xb_ld(&bar[XB_TMO])) break; if (sp > XB_SPIN_CAP) { atomicAdd(&bar[XB_TMO], 1u); break; } }
    }
    nloc = mine > 0u ? mine : 1u; nx = cnt > 0u ? cnt : 1u;
}
__device__ __forceinline__ void xcd_barrier(int wv, const XcdBarrier& b) {
    asm volatile("s_waitcnt vmcnt(0)" ::: "memory");
    __syncthreads();
    if (ltid(wv) == 0) {
        unsigned* bar = b.bar;
        asm volatile("" : "+s"(bar));
        __builtin_amdgcn_s_waitcnt(0);
        unsigned nloc = b.st[0], nx = b.st[1];
        if (nloc == 0u) { xcd_barrier_complete(bar, b.x, nloc, nx); b.st[0] = nloc; b.st[1] = nx; }
        const unsigned old = xb_add(&bar[XB_XSUB(b.x)], 1u);
        const unsigned gen = old / nloc;
        if (old + 1u == (gen + 1u) * nloc) {
            __builtin_amdgcn_fence(__ATOMIC_RELEASE, "agent");
            asm volatile("s_waitcnt vmcnt(0)" ::: "memory");
            const unsigned og = xb_add(&bar[XB_TOP], 1u);
            const unsigned tg = og / nx;
            if (og + 1u == (tg + 1u) * nx) xb_add(&bar[XB_TOPGEN], 1u);
            else XB_SPIN(xb_ld(&bar[XB_TOPGEN]) == tg, bar);
            __builtin_amdgcn_fence(__ATOMIC_ACQUIRE, "agent");
            xb_add(&bar[XB_XGEN(b.x)], 1u);
            asm volatile("s_waitcnt vmcnt(0)" ::: "memory");
        } else {
            XB_SPIN(xb_ld(&bar[XB_XGEN(b.x)]) == gen, bar);
            __builtin_amdgcn_fence(__ATOMIC_ACQUIRE, "agent");
            asm volatile("s_waitcnt vmcnt(0)" ::: "memory");
        }
    }
    __syncthreads();
}

__device__ __forceinline__ int row_mod(int r) { return r < NCTX ? 4 : ((r - NCTX) >> 13); }
__device__ __forceinline__ void row_seg(int r, int& t, int& len) { if (r < NCTX) { t = r & 255; len = CTXL; } else { t = (r - NCTX) & 8191; len = SEQ; } }
__device__ __forceinline__ int scan_row(int tg, int b, int dir, int odd) {
    if (tg < CTXL) { const int t = dir ? (CTXL - 1 - tg) : tg; return b * CTXL + t; }
    int sg = tg - CTXL; if (dir) sg = SEQ - 1 - sg;
    const int s = odd ? (((sg & 127) << 6) + (sg >> 7)) : sg;
    return NCTX + b * SEQ + s;
}
__device__ __forceinline__ const float* modvec(const unsigned char* ws, int layer, int m, int which) {
    return (const float*)(ws + WS_MODV) + ((size_t)(layer * 5 + m) * 6 + which) * D;
}

constexpr int G_BM = 256, G_BN = 128, G_BK = 64;
constexpr int G_ABYTES = G_BM * G_BK * 2, G_BBYTES = G_BN * G_BK * 2, G_BUF = G_ABYTES + G_BBYTES;
__device__ __forceinline__ int swz(int o) { return o ^ (((o >> 9) & 1) << 5); }

template <class RowSrc, class Epi>
__device__ __forceinline__ void gemm_tile(int wv, const bf16_t* __restrict__ A, int lda, const RowSrc& rs, const bf16_t* __restrict__ Bt, int ldb, int n0, int K, const Epi& epi, LAS char* lds) {
    const int tid = ltid(wv), lane = tid & 63, wid = tid >> 6, wm = wid >> 1, wn = wid & 1;
    const bf16_t* ap[4]; int aoff[4];
#pragma unroll
    for (int i = 0; i < 4; ++i) {
        const int c = tid + NT * i, row = c >> 3, kc = c & 7;
        ap[i] = A + (size_t)rs.src(row) * lda + kc * 8;
        aoff[i] = ((row >> 4) * 2 + (kc >> 2)) * 1024 + swz((row & 15) * 64 + (kc & 3) * 16);
    }
    const bf16_t* bp[2]; int boff[2];
#pragma unroll
    for (int i = 0; i < 2; ++i) {
        const int c = tid + NT * i, row = c >> 3, kc = c & 7;
        bp[i] = Bt + (size_t)(n0 + row) * ldb + kc * 8;
        boff[i] = G_ABYTES + ((row >> 4) * 2 + (kc >> 2)) * 1024 + swz((row & 15) * 64 + (kc & 3) * 16);
    }
    f32x4 acc[4][4];
#pragma unroll
    for (int i = 0; i < 4; ++i)
#pragma unroll
        for (int j = 0; j < 4; ++j) acc[i][j] = (f32x4){0.f, 0.f, 0.f, 0.f};
    u32x4 ra[2][4], rb[2][2];
    const int KT = K / G_BK;
    const int fragoff = swz((lane & 15) * 64 + (lane >> 4) * 16);
#define G_LOAD(set, kt_) do { _Pragma("unroll") for (int i = 0; i < 4; ++i) ra[set][i] = *(const u32x4*)(ap[i] + (kt_) * G_BK); \
                              _Pragma("unroll") for (int i = 0; i < 2; ++i) rb[set][i] = *(const u32x4*)(bp[i] + (kt_) * G_BK); } while (0)
#define G_STORE(set, buf) do { _Pragma("unroll") for (int i = 0; i < 4; ++i) *(LAS u32x4*)((buf) + aoff[i]) = ra[set][i]; \
                               _Pragma("unroll") for (int i = 0; i < 2; ++i) *(LAS u32x4*)((buf) + boff[i]) = rb[set][i]; } while (0)
#define G_COMPUTE(cur) do { bf16x8 af[2][4], bfr[2][4]; \
        _Pragma("unroll") for (int ks = 0; ks < 2; ++ks) { \
            _Pragma("unroll") for (int ni = 0; ni < 4; ++ni) bfr[ks][ni] = *(LAS bf16x8*)((cur) + G_ABYTES + ((wn * 4 + ni) * 2 + ks) * 1024 + fragoff); \
            _Pragma("unroll") for (int mi = 0; mi < 4; ++mi) af[ks][mi] = *(LAS bf16x8*)((cur) + ((wm * 4 + mi) * 2 + ks) * 1024 + fragoff); } \
        __builtin_amdgcn_sched_barrier(0); \
        _Pragma("unroll") for (int ks = 0; ks < 2; ++ks) _Pragma("unroll") for (int mi = 0; mi < 4; ++mi) _Pragma("unroll") for (int ni = 0; ni < 4; ++ni) \
            acc[mi][ni] = __builtin_amdgcn_mfma_f32_16x16x32_bf16(bfr[ks][ni], af[ks][mi], acc[mi][ni], 0, 0, 0); \
        __builtin_amdgcn_sched_barrier(0); } while (0)
    G_LOAD(0, 0);
    G_STORE(0, lds);
    if (KT > 1) G_LOAD(0, 1);
    if (KT > 2) G_LOAD(1, 2);
    __syncthreads();
    for (int kt = 0; kt < KT; kt += 2) {
        G_COMPUTE(lds);
        if (kt + 1 < KT) G_STORE(0, lds + G_BUF);
        if (kt + 3 < KT) G_LOAD(0, kt + 3);
        __syncthreads();
        if (kt + 1 < KT) {
            G_COMPUTE(lds + G_BUF);
            if (kt + 2 < KT) G_STORE(1, lds);
            if (kt + 4 < KT) G_LOAD(1, kt + 4);
            __syncthreads();
        }
    }
#undef G_LOAD
#undef G_STORE
#undef G_COMPUTE
    epi(acc, wm * 64 + (lane & 15), wn * 64 + 4 * (lane >> 4));
}

constexpr int G2_BN = 256, G2_BBYTES = G2_BN * G_BK * 2, G2_BUF = G_ABYTES + G2_BBYTES;

struct RowLinear { int m0; __device__ __forceinline__ int src(int r) const { return m0 + r; } };
struct EpiStoreBf16 {
    bf16_t* C; int ldc; int m0; int n0; int N;
    template <int NI> __device__ __forceinline__ void operator()(const f32x4 (&acc)[4][NI], int rbase, int cbase) const {
#pragma unroll
        for (int mi = 0; mi < 4; ++mi) {
            bf16_t* rowp = C + (size_t)(m0 + rbase + mi * 16) * ldc + n0 + cbase;
#pragma unroll
            for (int ni = 0; ni < NI; ++ni) {
                if (n0 + cbase + ni * 16 < N) { u32x2 v; v.x = pk2(acc[mi][ni][0], acc[mi][ni][1]); v.y = pk2(acc[mi][ni][2], acc[mi][ni][3]); *(u32x2*)(rowp + ni * 16) = v; }
            }
        }
    }
};
struct EpiDecay {
    float* Dc; const float* w0; int m0; int n0;
    template <int NI> __device__ __forceinline__ void operator()(const f32x4 (&acc)[4][NI], int rbase, int cbase) const {
#pragma unroll
        for (int ni = 0; ni < NI; ++ni) {
            const int col = n0 + cbase + ni * 16;
            const f32x4 w0v = *(const f32x4*)(w0 + col);
#pragma unroll
            for (int mi = 0; mi < 4; ++mi) {
                f32x4 o;
#pragma unroll
                for (int j = 0; j < 4; ++j) { const float w = w0v[j] + acc[mi][ni][j]; o[j] = __expf(-__expf(-softplus_fast(-w) - 0.5f)); }
                *(f32x4*)(Dc + (size_t)(m0 + rbase + mi * 16) * 512 + col) = o;
            }
        }
    }
};
struct EpiAK {
    bf16_t* Kb; const bf16_t* KKb; bf16_t* Bb; const float* a0; const float* k_a; int m0; int n0;
    template <int NI> __device__ __forceinline__ void operator()(const f32x4 (&acc)[4][NI], int rbase, int cbase) const {
#pragma unroll
        for (int ni = 0; ni < NI; ++ni) {
            const int col = n0 + cbase + ni * 16;
            const f32x4 a0v = *(const f32x4*)(a0 + col), kav = *(const f32x4*)(k_a + col);
#pragma unroll
            for (int mi = 0; mi < 4; ++mi) {
                const size_t off = (size_t)(m0 + rbase + mi * 16) * 512 + col;
                const u32x2 kr = *(const u32x2*)(Kb + off), kkr = *(const u32x2*)(KKb + off);
                const float kf[4] = {bflo(kr.x), bfhi(kr.x), bflo(kr.y), bfhi(kr.y)}, kkf[4] = {bflo(kkr.x), bfhi(kkr.x), bflo(kkr.y), bfhi(kkr.y)};
                float k2[4], bb[4];
#pragma unroll
                for (int j = 0; j < 4; ++j) { const float a = sigmoidf_(a0v[j] + acc[mi][ni][j]); k2[j] = kf[j] * (1.f + (a - 1.f) * kav[j]); bb[j] = kkf[j] * a; }
                u32x2 v; v.x = pk2(k2[0], k2[1]); v.y = pk2(k2[2], k2[3]); *(u32x2*)(Kb + off) = v;
                v.x = pk2(bb[0], bb[1]); v.y = pk2(bb[2], bb[3]); *(u32x2*)(Bb + off) = v;
            }
        }
    }
};

namespace pg8 {
#define PG8_LAS __attribute__((address_space(3)))
constexpr int BM = 256, BK = 64, HALF = 128, HTB = HALF * BK * 2, STAGE_BYTES = 8 * HTB, NXCD = 8, WGM = 8;
__host__ __device__ __forceinline__ int lds_byte(int r, int c) { const int st = (r >> 4) * 2 + (c >> 5), rr = r & 15, cc = c & 31, ob = rr * 64 + cc * 2; return st * 1024 + (ob ^ (((ob >> 9) & 1) << 5)); }
__host__ __device__ __forceinline__ void stage_rc(int b, int& R, int& C) { const int st = b / 1024, sb = b % 1024, swz = sb ^ (((sb >> 9) & 1) << 5); R = (st >> 1) * 16 + swz / 64; C = (st & 1) * 32 + (swz % 64) / 2; }
__host__ __device__ __forceinline__ int perm32(int rho) { const int n = rho >> 4, i = rho & 15; return 8 * (i >> 2) + 4 * n + (i & 3); }
struct Unit { int pm, pn; };
struct Gemm { const bf16_t* A; const bf16_t* Bt; int M, N, K; };
struct StaticOrder {
    int nM, nN, nwg, G, c;
    __host__ __device__ void init(int M, int N, int G_, int c_) { nM = M / BM; nN = N / BM; nwg = nM * nN; G = G_; c = c_; }
    __host__ __device__ bool next(int i, Unit& u) const {
        const long L = (long)i * G + c; if (L >= nwg) return false;
        int wgid = (int)L; { const int q = nwg / NXCD, r = nwg % NXCD, xcd = wgid % NXCD, off = wgid / NXCD; wgid = (xcd < r ? xcd * (q + 1) : r * (q + 1) + (xcd - r) * q) + off; }
        const int nig = WGM * nN, gid = wgid / nig, fm = gid * WGM, gsz = (nM - fm) < WGM ? (nM - fm) : WGM;
        u.pm = fm + ((wgid % nig) % gsz); u.pn = (wgid % nig) / gsz; return true;
    }
    __device__ __forceinline__ void a_ready(const Unit&) const {}
    __device__ __forceinline__ void done(const Unit&) const {}
};
struct EpiStoreP {
    static constexpr bool PERM = true, AFTER_DRAIN = false;
    bf16_t* O; int ldc;
    __device__ __forceinline__ void operator()(const f32x4 (&acc)[2][2][4][2], const Unit& u, int wr, int wc, int fr, int fq) const {
        const int row0 = u.pm * BM + wr * 64 + fr, col0 = u.pn * BM + wc * 32 + 8 * fq;
#pragma unroll
        for (int ai = 0; ai < 2; ++ai)
#pragma unroll
            for (int m = 0; m < 4; ++m) { bf16_t* rowp = O + (size_t)(row0 + ai * HALF + m * 16) * ldc + col0;
#pragma unroll
                for (int bj = 0; bj < 2; ++bj) { const f32x4 v0 = acc[ai][bj][m][0], v1 = acc[ai][bj][m][1];
                    u32x4 w; w.x = pk2(v0[0], v0[1]); w.y = pk2(v0[2], v0[3]); w.z = pk2(v1[0], v1[1]); w.w = pk2(v1[2], v1[3]);
                    *(u32x4*)(rowp + bj * HALF) = w; } }
    }
};
template <class Epi, class Sched>
__device__ __forceinline__ void gemm_phase(int wv, PG8_LAS unsigned char* lds, const Gemm g, const Sched& S, const Epi& E) {
    const int tid = ltid(wv), wid = __builtin_amdgcn_readfirstlane(tid >> 6), lane = tid & 63, wr = wid >> 2, wc = wid & 3, fr = lane & 15, fq = lane >> 4;
    const int K = g.K, nt = K / BK;
    unsigned voffA[2], voffB[2];
#pragma unroll
    for (int i = 0; i < 2; ++i) { int R, C; stage_rc(tid * 16 + i * 8192, R, C); const int Rb = Epi::PERM ? ((R & ~31) + perm32(R & 31)) : R;
        voffA[i] = (unsigned)(R * K + C) * 2u; voffB[i] = (unsigned)(Rb * K + C) * 2u; }
    const size_t kstep = (size_t)(BK * 2);
    const size_t hstep = (size_t)HALF * K * 2;
    const size_t tstep = 2 * hstep;
    const unsigned ldsw = (unsigned)wid * 1024u;
    const int aoff = lds_byte(wr * 64 + fr, fq * 8), boff = lds_byte(wc * 32 + fr, fq * 8);
#define PG8_SA(b, h) (((b) * 2 + (h)) * HTB)
#define PG8_SB(b, h) ((4 + (b) * 2 + (h)) * HTB)
#define PG8_STAGE(bufoff, gbase, voff) do { _Pragma("unroll") for (int _i = 0; _i < 2; ++_i) \
        __builtin_amdgcn_global_load_lds((const unsigned*)((const char*)(gbase) + (voff)[_i]), (PG8_LAS unsigned*)(lds + (bufoff) + ldsw + _i * 8192), 16, 0, 0); } while (0)
#define PG8_LDA(dst, b, h) do { _Pragma("unroll") for (int m = 0; m < 4; ++m) _Pragma("unroll") for (int k = 0; k < 2; ++k) dst[m][k] = *(const PG8_LAS bf16x8*)(lds + PG8_SA(b, h) + aoff + m * 2048 + k * 1024); } while (0)
#define PG8_LDB(dst, b, h) do { _Pragma("unroll") for (int n = 0; n < 2; ++n) _Pragma("unroll") for (int k = 0; k < 2; ++k) dst[n][k] = *(const PG8_LAS bf16x8*)(lds + PG8_SB(b, h) + boff + n * 2048 + k * 1024); } while (0)
#define PG8_MMA(ai, bj, At, Bt) do { __builtin_amdgcn_s_setprio(1); _Pragma("unroll") for (int m = 0; m < 4; ++m) _Pragma("unroll") for (int n = 0; n < 2; ++n) _Pragma("unroll") for (int k = 0; k < 2; ++k) \
        acc[ai][bj][m][n] = __builtin_amdgcn_mfma_f32_16x16x32_bf16(Bt[n][k], At[m][k], acc[ai][bj][m][n], 0, 0, 0); __builtin_amdgcn_s_setprio(0); } while (0)
#define PG8_WAIT_V(n) asm volatile("s_waitcnt vmcnt(" #n ")" ::: "memory")
#define PG8_WAIT_L(n) asm volatile("s_waitcnt lgkmcnt(" #n ")" ::: "memory")
#define PG8_BAR __builtin_amdgcn_s_barrier()
#define PG8_SCHED __builtin_amdgcn_sched_barrier(0)
    Unit cur, nxt; int ui = 0;
    if (!S.next(0, cur)) return;
    f32x4 acc[2][2][4][2];
#pragma unroll
    for (int a = 0; a < 2; ++a)
#pragma unroll
        for (int b = 0; b < 2; ++b)
#pragma unroll
            for (int m = 0; m < 4; ++m)
#pragma unroll
                for (int n = 0; n < 2; ++n) acc[a][b][m][n] = (f32x4){0.f, 0.f, 0.f, 0.f};
    bf16x8 At[4][2], B0[2][2], B1[2][2];
    const char* cA = (const char*)g.A + (size_t)cur.pm * tstep; const char* cB = (const char*)g.Bt + (size_t)cur.pn * tstep;
    S.a_ready(cur);
    PG8_STAGE(PG8_SB(0, 0), cB, voffB); PG8_STAGE(PG8_SA(0, 0), cA, voffA); PG8_STAGE(PG8_SB(0, 1), cB + hstep, voffB); PG8_STAGE(PG8_SA(0, 1), cA + hstep, voffA);
    if (wr == 1) PG8_BAR;
    PG8_WAIT_V(4); PG8_BAR;
    PG8_STAGE(PG8_SB(1, 0), cB + kstep, voffB); PG8_STAGE(PG8_SA(1, 0), cA + kstep, voffA); PG8_STAGE(PG8_SB(1, 1), cB + hstep + kstep, voffB);
    PG8_WAIT_V(6); PG8_BAR;
    for (;;) {
        const bool has_next = S.next(ui + 1, nxt);
        const char* nA = has_next ? (const char*)g.A + (size_t)nxt.pm * tstep : cA; const char* nB = has_next ? (const char*)g.Bt + (size_t)nxt.pn * tstep : cB;
        for (int t = 0; t < nt; t += 2) {
            const bool last = (t == nt - 2);
            const char* a1 = cA + (size_t)(t + 1) * kstep;
            const char* a2 = last ? nA : cA + (size_t)(t + 2) * kstep; const char* b2 = last ? nB : cB + (size_t)(t + 2) * kstep;
            const char* a3 = a2 + kstep; const char* b3 = b2 + kstep;
            if (last && has_next) S.a_ready(nxt);
            PG8_LDB(B0, 0, 0); PG8_SCHED; PG8_LDA(At, 0, 0); PG8_STAGE(PG8_SA(1, 1), a1 + hstep, voffA);
            PG8_WAIT_L(8); PG8_BAR; PG8_WAIT_L(0); PG8_MMA(0, 0, At, B0); PG8_BAR; PG8_SCHED;
            PG8_LDB(B1, 0, 1); PG8_STAGE(PG8_SB(0, 0), b2, voffB);
            PG8_BAR; PG8_WAIT_L(0); PG8_MMA(0, 1, At, B1); PG8_BAR;
            PG8_LDA(At, 0, 1); PG8_STAGE(PG8_SA(0, 0), a2, voffA);
            PG8_BAR; PG8_WAIT_L(0); PG8_MMA(1, 0, At, B0); PG8_BAR; PG8_SCHED;
            PG8_STAGE(PG8_SB(0, 1), b2 + hstep, voffB);
            PG8_WAIT_V(6); PG8_BAR; PG8_MMA(1, 1, At, B1); PG8_BAR;
            PG8_LDB(B0, 1, 0); PG8_SCHED; PG8_LDA(At, 1, 0); PG8_STAGE(PG8_SA(0, 1), a2 + hstep, voffA);
            PG8_WAIT_L(8); PG8_BAR; PG8_WAIT_L(0); PG8_MMA(0, 0, At, B0); PG8_BAR; PG8_SCHED;
            PG8_LDB(B1, 1, 1); PG8_STAGE(PG8_SB(1, 0), b3, voffB);
            PG8_BAR; PG8_WAIT_L(0); PG8_MMA(0, 1, At, B1); PG8_BAR;
            PG8_LDA(At, 1, 1); PG8_STAGE(PG8_SA(1, 0), a3, voffA);
            PG8_BAR; PG8_WAIT_L(0); PG8_MMA(1, 0, At, B0); PG8_BAR; PG8_SCHED;
            PG8_STAGE(PG8_SB(1, 1), b3 + hstep, voffB);
            PG8_WAIT_V(6); PG8_BAR; PG8_MMA(1, 1, At, B1); PG8_BAR;
        }
            if constexpr (!Epi::AFTER_DRAIN) { E(acc, cur, wr, wc, fr, fq); S.done(cur); }
            if (!has_next) break;
#pragma unroll
        for (int a = 0; a < 2; ++a)
#pragma unroll
            for (int b = 0; b < 2; ++b)
#pragma unroll
                for (int m = 0; m < 4; ++m)
#pragma unroll
                    for (int n = 0; n < 2; ++n) acc[a][b][m][n] = (f32x4){0.f, 0.f, 0.f, 0.f};
        cur = nxt; cA = nA; cB = nB; ++ui;
    }
    PG8_WAIT_V(0);
    if (wr == 0) PG8_BAR;
    PG8_BAR;
    if constexpr (Epi::AFTER_DRAIN) { E.fused(acc, cur, wr, wc, fr, fq, lds, wid, lane); S.done(cur); }
#undef PG8_SA
#undef PG8_SB
#undef PG8_STAGE
#undef PG8_LDA
#undef PG8_LDB
#undef PG8_MMA
#undef PG8_WAIT_V
#undef PG8_WAIT_L
#undef PG8_BAR
#undef PG8_SCHED
}
struct UnitG { int pm, pn; const char* bbase; const PG8_LAS int* ltab; int cnt; int e; };
struct MoeOrder {
    const PG8_LAS int* tstart; const PG8_LAS int* tcnt; const PG8_LAS int* ltabs; const int* lists; const char* bt; size_t estride; int ncol, shift, G, c;
    __device__ __forceinline__ bool next(int i, UnitG& u) const {
        const int t = i * G + c; if (t >= tstart[32] * ncol) return false;
        const int tm = t / ncol; int e = 0;
#pragma unroll 1
        while (tstart[e + 1] <= tm) ++e;
        e = __builtin_amdgcn_readfirstlane(e);
        const int ts = __builtin_amdgcn_readfirstlane(tstart[e]), tc = __builtin_amdgcn_readfirstlane(tcnt[e]);
        u.pm = tm - ts; u.pn = t - tm * ncol; u.bbase = bt + (size_t)e * estride; u.e = e; u.cnt = tc - u.pm * BM; u.ltab = ltabs + i * BM;
        return true;
    }
    __device__ __forceinline__ void a_ready(const UnitG&) const {}
    __device__ __forceinline__ void done(const UnitG&) const {}
};
struct EpiSwiGLUG {
    static constexpr bool PERM = false, AFTER_DRAIN = false;
    bf16_t* H;
    __device__ __forceinline__ void operator()(const f32x4 (&acc)[2][2][4][2], const UnitG& u, int wr, int wc, int fr, int fq) const {
#pragma unroll
        for (int ai = 0; ai < 2; ++ai)
#pragma unroll
            for (int m = 0; m < 4; ++m) { const int r = ai * HALF + wr * 64 + m * 16 + fr;
                if (r < u.cnt) { bf16_t* rowp = H + (size_t)u.ltab[r] * DEXP + ((u.pn * BM + wc * 32) >> 1) + 4 * fq;
#pragma unroll
                    for (int bj = 0; bj < 2; ++bj) { const f32x4 gt = acc[ai][bj][m][0], up = acc[ai][bj][m][1];
                        u32x2 w; w.x = pk2(siluf_(gt[0]) * up[0], siluf_(gt[1]) * up[1]); w.y = pk2(siluf_(gt[2]) * up[2], siluf_(gt[3]) * up[3]);
                        *(u32x2*)(rowp + bj * (HALF / 2)) = w; } } }
    }
};
struct EpiScatterG {
    static constexpr bool PERM = true, AFTER_DRAIN = false;
    bf16_t* O;
    __device__ __forceinline__ void operator()(const f32x4 (&acc)[2][2][4][2], const UnitG& u, int wr, int wc, int fr, int fq) const {
#pragma unroll
        for (int ai = 0; ai < 2; ++ai)
#pragma unroll
            for (int m = 0; m < 4; ++m) { const int r = ai * HALF + wr * 64 + m * 16 + fr;
                if (r < u.cnt) { bf16_t* rowp = O + (size_t)u.ltab[r] * D + u.pn * BM + wc * 32 + 8 * fq;
#pragma unroll
                    for (int bj = 0; bj < 2; ++bj) { const f32x4 v0 = acc[ai][bj][m][0], v1 = acc[ai][bj][m][1];
                        u32x4 w; w.x = pk2(v0[0], v0[1]); w.y = pk2(v0[2], v0[3]); w.z = pk2(v1[0], v1[1]); w.w = pk2(v1[2], v1[3]);
                        *(u32x4*)(rowp + bj * HALF) = w; } } }
    }
};
template <class Epi, class Sched>
__device__ __forceinline__ void gemm_phase_g(int wv, PG8_LAS unsigned char* lds, const Gemm g, const Sched& S, const Epi& E) {
    const int tid = ltid(wv), wid = __builtin_amdgcn_readfirstlane(tid >> 6), lane = tid & 63, wr = wid >> 2, wc = wid & 3, fr = lane & 15, fq = lane >> 4;
    const int K = g.K, nt = K / BK;
    unsigned voffB[2];
#pragma unroll
    for (int i = 0; i < 2; ++i) { int R, C; stage_rc(tid * 16 + i * 8192, R, C); const int Rb = Epi::PERM ? ((R & ~31) + perm32(R & 31)) : R;
        voffB[i] = (unsigned)(Rb * K + C) * 2u; }
    const unsigned rowb = (unsigned)K * 2u;
#define PG8_AOFFS(u, dst) do { const int _t = ltid(wv); _Pragma("unroll") for (int _i = 0; _i < 2; ++_i) { int _R, _C; stage_rc(_t * 16 + _i * 8192, _R, _C); \
        _Pragma("unroll") for (int _h = 0; _h < 2; ++_h) dst[_h][_i] = (unsigned)((u).ltab[_h * HALF + _R] >> S.shift) * rowb + (unsigned)(_C * 2); } } while (0)
#define PG8_STAGE_A(bufoff, AO, koff) do { _Pragma("unroll") for (int _i = 0; _i < 2; ++_i) \
        __builtin_amdgcn_global_load_lds((const unsigned*)((const char*)g.A + (size_t)(AO)[_i] + (size_t)(koff)), (PG8_LAS unsigned*)(lds + (bufoff) + ldsw + _i * 8192), 16, 0, 0); } while (0)
    const size_t kstep = (size_t)(BK * 2);
    const size_t hstep = (size_t)HALF * K * 2;
    const size_t tstep = 2 * hstep;
    const unsigned ldsw = (unsigned)wid * 1024u;
    const int aoff = lds_byte(wr * 64 + fr, fq * 8), boff = lds_byte(wc * 32 + fr, fq * 8);
#define PG8_SA(b, h) (((b) * 2 + (h)) * HTB)
#define PG8_SB(b, h) ((4 + (b) * 2 + (h)) * HTB)
#define PG8_STAGE(bufoff, gbase, voff) do { _Pragma("unroll") for (int _i = 0; _i < 2; ++_i) \
        __builtin_amdgcn_global_load_lds((const unsigned*)((const char*)(gbase) + (voff)[_i]), (PG8_LAS unsigned*)(lds + (bufoff) + ldsw + _i * 8192), 16, 0, 0); } while (0)
#define PG8_LDA(dst, b, h) do { _Pragma("unroll") for (int m = 0; m < 4; ++m) _Pragma("unroll") for (int k = 0; k < 2; ++k) dst[m][k] = *(const PG8_LAS bf16x8*)(lds + PG8_SA(b, h) + aoff + m * 2048 + k * 1024); } while (0)
#define PG8_LDB(dst, b, h) do { _Pragma("unroll") for (int n = 0; n < 2; ++n) _Pragma("unroll") for (int k = 0; k < 2; ++k) dst[n][k] = *(const PG8_LAS bf16x8*)(lds + PG8_SB(b, h) + boff + n * 2048 + k * 1024); } while (0)
#define PG8_MMA(ai, bj, At, Bt) do { __builtin_amdgcn_s_setprio(1); _Pragma("unroll") for (int m = 0; m < 4; ++m) _Pragma("unroll") for (int n = 0; n < 2; ++n) _Pragma("unroll") for (int k = 0; k < 2; ++k) \
        acc[ai][bj][m][n] = __builtin_amdgcn_mfma_f32_16x16x32_bf16(Bt[n][k], At[m][k], acc[ai][bj][m][n], 0, 0, 0); __builtin_amdgcn_s_setprio(0); } while (0)
#define PG8_WAIT_V(n) asm volatile("s_waitcnt vmcnt(" #n ")" ::: "memory")
#define PG8_WAIT_L(n) asm volatile("s_waitcnt lgkmcnt(" #n ")" ::: "memory")
#define PG8_BAR __builtin_amdgcn_s_barrier()
#define PG8_SCHED __builtin_amdgcn_sched_barrier(0)
    UnitG cur, nxt; int ui = 0;
    if (!S.next(0, cur)) return;
    f32x4 acc[2][2][4][2];
#pragma unroll
    for (int a = 0; a < 2; ++a)
#pragma unroll
        for (int b = 0; b < 2; ++b)
#pragma unroll
            for (int m = 0; m < 4; ++m)
#pragma unroll
                for (int n = 0; n < 2; ++n) acc[a][b][m][n] = (f32x4){0.f, 0.f, 0.f, 0.f};
    bf16x8 At[4][2], B0[2][2], B1[2][2];
    unsigned ca[2][2]; PG8_AOFFS(cur, ca); const char* cB = cur.bbase + (size_t)cur.pn * tstep;
    S.a_ready(cur);
    PG8_STAGE(PG8_SB(0, 0), cB, voffB); PG8_STAGE_A(PG8_SA(0, 0), ca[0], 0); PG8_STAGE(PG8_SB(0, 1), cB + hstep, voffB); PG8_STAGE_A(PG8_SA(0, 1), ca[1], 0);
    if (wr == 1) PG8_BAR;
    PG8_WAIT_V(4); PG8_BAR;
    PG8_STAGE(PG8_SB(1, 0), cB + kstep, voffB); PG8_STAGE_A(PG8_SA(1, 0), ca[0], kstep); PG8_STAGE(PG8_SB(1, 1), cB + hstep + kstep, voffB);
    PG8_WAIT_V(6); PG8_BAR;
    for (;;) {
        const bool has_next = S.next(ui + 1, nxt);
        const char* nB = has_next ? nxt.bbase + (size_t)nxt.pn * tstep : cB;
        for (int t = 0; t < nt; t += 2) {
            const bool last = (t == nt - 2);
            const size_t k1 = (size_t)(t + 1) * kstep, k2 = last ? 0 : (size_t)(t + 2) * kstep;
            unsigned a2o[2][2];
            if (last && has_next) PG8_AOFFS(nxt, a2o); else { a2o[0][0] = ca[0][0]; a2o[0][1] = ca[0][1]; a2o[1][0] = ca[1][0]; a2o[1][1] = ca[1][1]; }
            const char* b2 = last ? nB : cB + (size_t)(t + 2) * kstep; const char* b3 = b2 + kstep;
            if (last && has_next) S.a_ready(nxt);
            PG8_LDB(B0, 0, 0); PG8_SCHED; PG8_LDA(At, 0, 0); PG8_STAGE_A(PG8_SA(1, 1), ca[1], k1);
            PG8_WAIT_L(8); PG8_BAR; PG8_WAIT_L(0); PG8_MMA(0, 0, At, B0); PG8_BAR; PG8_SCHED;
            PG8_LDB(B1, 0, 1); PG8_STAGE(PG8_SB(0, 0), b2, voffB);
            PG8_BAR; PG8_WAIT_L(0); PG8_MMA(0, 1, At, B1); PG8_BAR;
            PG8_LDA(At, 0, 1); PG8_STAGE_A(PG8_SA(0, 0), a2o[0], k2);
            PG8_BAR; PG8_WAIT_L(0); PG8_MMA(1, 0, At, B0); PG8_BAR; PG8_SCHED;
            PG8_STAGE(PG8_SB(0, 1), b2 + hstep, voffB);
            PG8_WAIT_V(6); PG8_BAR; PG8_MMA(1, 1, At, B1); PG8_BAR;
            PG8_LDB(B0, 1, 0); PG8_SCHED; PG8_LDA(At, 1, 0); PG8_STAGE_A(PG8_SA(0, 1), a2o[1], k2);
            PG8_WAIT_L(8); PG8_BAR; PG8_WAIT_L(0); PG8_MMA(0, 0, At, B0); PG8_BAR; PG8_SCHED;
            PG8_LDB(B1, 1, 1); PG8_STAGE(PG8_SB(1, 0), b3, voffB);
            PG8_BAR; PG8_WAIT_L(0); PG8_MMA(0, 1, At, B1); PG8_BAR;
            PG8_LDA(At, 1, 1); PG8_STAGE_A(PG8_SA(1, 0), a2o[0], k2 + kstep);
            PG8_BAR; PG8_WAIT_L(0); PG8_MMA(1, 0, At, B0); PG8_BAR; PG8_SCHED;
            PG8_STAGE(PG8_SB(1, 1), b3 + hstep, voffB);
            PG8_WAIT_V(6); PG8_BAR; PG8_MMA(1, 1, At, B1); PG8_BAR;
            if (last) { ca[0][0] = a2o[0][0]; ca[0][1] = a2o[0][1]; ca[1][0] = a2o[1][0]; ca[1][1] = a2o[1][1]; }
        }
            if constexpr (!Epi::AFTER_DRAIN) { E(acc, cur, wr, wc, fr, fq); S.done(cur); }
            if (!has_next) break;
#pragma unroll
        for (int a = 0; a < 2; ++a)
#pragma unroll
            for (int b = 0; b < 2; ++b)
#pragma unroll
                for (int m = 0; m < 4; ++m)
#pragma unroll
                    for (int n = 0; n < 2; ++n) acc[a][b][m][n] = (f32x4){0.f, 0.f, 0.f, 0.f};
        cur = nxt; cB = nB; ++ui;
    }
    PG8_WAIT_V(0);
    if (wr == 0) PG8_BAR;
    PG8_BAR;
    if constexpr (Epi::AFTER_DRAIN) { E.fused(acc, cur, wr, wc, fr, fq, lds, wid, lane); S.done(cur); }
#undef PG8_SA
#undef PG8_AOFFS
#undef PG8_STAGE_A
#undef PG8_SB
#undef PG8_STAGE
#undef PG8_LDA
#undef PG8_LDB
#undef PG8_MMA
#undef PG8_WAIT_V
#undef PG8_WAIT_L
#undef PG8_BAR
#undef PG8_SCHED
}
}

__device__ __forceinline__ void transpose_item(const float* __restrict__ W, int K, int N, bf16_t* __restrict__ WT, int mode, LAS float* scr, int item, int lane) {
    const int nblk = N / 32, kb = item / nblk, nb = item % nblk, k0 = 64 * kb, n0 = 32 * nb;
    {
        const float* wp = W + (size_t)(k0 + (lane >> 5)) * N + n0 + (lane & 31);
        float t[32];
#pragma unroll
        for (int i = 0; i < 32; ++i) t[i] = wp[(size_t)(2 * i) * N];
#pragma unroll
        for (int i = 0; i < 32; ++i) scr[(2 * i + (lane >> 5)) * 33 + (lane & 31)] = t[i];
    }
    asm volatile("s_waitcnt lgkmcnt(0)" ::: "memory");
    const int c = lane & 7;
#pragma unroll
    for (int j = 0; j < 4; ++j) {
        const int nl = (lane >> 3) + 8 * j; const LAS float* s = scr + (8 * c) * 33 + nl;
        u32x4 o; o.x = pk2(s[0 * 33], s[1 * 33]); o.y = pk2(s[2 * 33], s[3 * 33]); o.z = pk2(s[4 * 33], s[5 * 33]); o.w = pk2(s[6 * 33], s[7 * 33]);
        const int n = n0 + nl;
        const int nd = mode == 0 ? n : (32 * (n >> 4) + (n & 15) + (mode == 2 ? 16 : 0));
        *(u32x4*)(WT + (size_t)nd * K + k0 + 8 * c) = o;
    }
    asm volatile("s_waitcnt lgkmcnt(0)" ::: "memory");
}

constexpr int EXC_IG = 16 * 16, EXC_IDN = 8 * 32, EXC_PER = 2 * EXC_IG + EXC_IDN, EXC_ITEMS = NEXP * EXC_PER;
__device__ __forceinline__ int exc_s0(int layer) { return (layer & 1) ? 8192 : 10240; }
__device__ __forceinline__ int exc_s1(int layer) { return layer == DEPTH - 1 ? 0 : 7168; }
__device__ __forceinline__ void expconv_items(const CAS Params& P, int layer, LAS char* lds, int lo, int hi, int worker, int nworkers, int wid, int lane) {
    LAS float* scr = (LAS float*)(lds + wid * 8448);
    bf16_t* gu = (bf16_t*)(P.ws + WS_EXPGU); bf16_t* dw = (bf16_t*)(P.ws + WS_EXPD);
    for (int it = lo + worker; it < hi; it += nworkers) {
        const int e = it / EXC_PER; int r = it % EXC_PER;
        const size_t eo = (size_t)(layer * NEXP + e);
        if (r < EXC_IG) { transpose_item(P.exp_w_gate + eo * D * DEXP, D, DEXP, gu + (size_t)e * 1024 * 1024, 1, scr, r, lane); continue; } r -= EXC_IG;
        if (r < EXC_IG) { transpose_item(P.exp_w_up + eo * D * DEXP, D, DEXP, gu + (size_t)e * 1024 * 1024, 2, scr, r, lane); continue; } r -= EXC_IG;
        transpose_item(P.exp_w_down + eo * DEXP * D, DEXP, D, dw + (size_t)e * 1024 * 512, 0, scr, r, lane);
    }
}
__device__ __forceinline__ void expconv_tail(int wv, const CAS Params& P, int layer, LAS char* lds, int nwg, int lo, int hi) {
    const int G = gridDim.x, rem = nwg % G;
    if (rem != 0 && (int)blockIdx.x >= rem && lo < hi) {
        const int tid = ltid(wv);
        __syncthreads();
        expconv_items(P, layer, lds, lo, hi, ((int)blockIdx.x - rem) * 8 + (tid >> 6), (G - rem) * 8, tid >> 6, tid & 63);
    }
}

__device__ __forceinline__ void phase_prologue0(int wv, KP Pk, LAS char* lds) {
    asm volatile("" : "+s"(Pk));
    const CAS Params& P = *Pk;
    const int tid = ltid(wv), lane = tid & 63, wid = tid >> 6;
    const int gw = blockIdx.x * 8 + wid, NGW = gridDim.x * 8;
    LAS float* scr = (LAS float*)(lds + wid * 8448);
    bf16_t* winT = (bf16_t*)(P.ws + WS_WINT);
    bf16_t* woutT = (bf16_t*)(P.ws + WS_WOUTT);
    bf16_t* loraT = (bf16_t*)(P.ws + WS_LORAT);
    constexpr int I_EV = 16 * (P_EVEN / 32), I_OD = 16 * (P_ODD / 32), I_O = 16 * 32, I_L64 = 16, I_L128 = 32;
    constexpr int I_LORA = 3 * I_L64 + I_L128;
    constexpr int NIT = 2 * I_EV + 2 * I_OD + 4 * I_O + 2 * I_LORA;
    for (int it = gw; it < NIT; it += NGW) {
        int r = it;
        if (r < 2 * I_EV) { const int i = r / I_EV; transpose_item(P.ev_w_in + (size_t)i * D * P_EVEN, D, P_EVEN, winT + (i ? WINT_L2 : WINT_L0), 0, scr, r % I_EV, lane); continue; } r -= 2 * I_EV;
        if (r < 2 * I_OD) { const int i = r / I_OD; transpose_item(P.od_w_in + (size_t)i * D * P_ODD, D, P_ODD, winT + (i ? WINT_L3 : WINT_L1), 0, scr, r % I_OD, lane); continue; } r -= 2 * I_OD;
        if (r < 4 * I_O) { const int l = r / I_O; const float* src = (l & 1) ? P.od_w_out + (size_t)(l >> 1) * D * D : P.ev_w_out + (size_t)(l >> 1) * D * D;
            transpose_item(src, D, D, woutT + (size_t)l * D * D, 0, scr, r % I_O, lane); continue; } r -= 4 * I_O;
        { const int i = r / I_LORA; int q = r % I_LORA; bf16_t* dst = loraT + (size_t)i * LORA_PER;
          if (q < I_L64) { transpose_item(P.rw_w2 + (size_t)(i * 2 + 0) * 64 * 512, 64, 512, dst, 0, scr, q, lane); continue; } q -= I_L64;
          if (q < I_L64) { transpose_item(P.rw_w2 + (size_t)(i * 2 + 1) * 64 * 512, 64, 512, dst + 512 * 64, 0, scr, q, lane); continue; } q -= I_L64;
          if (q < I_L64) { transpose_item(P.rw_a2 + (size_t)i * 64 * 512, 64, 512, dst + 2 * 512 * 64, 0, scr, q, lane); continue; } q -= I_L64;
          transpose_item(P.rw_g2 + (size_t)i * 128 * 512, 128, 512, dst + 3 * 512 * 64, 0, scr, q, lane); }
    }
    {
        const int gt = blockIdx.x * NT + tid, NG = gridDim.x * NT;
        constexpr int PADE = (LDP_EVEN - P_EVEN) * D / 8, PADO = (LDP_ODD - P_ODD) * D / 8;
        for (int i = gt; i < 2 * PADE + 2 * PADO; i += NG) {
            int r = i; bf16_t* dst;
            if (r < 2 * PADE) { const int l = r / PADE; dst = winT + (l ? WINT_L2 : WINT_L0) + (size_t)P_EVEN * D + (size_t)(r % PADE) * 8; }
            else { r -= 2 * PADE; const int l = r / PADO; dst = winT + (l ? WINT_L3 : WINT_L1) + (size_t)P_ODD * D + (size_t)(r % PADO) * 8; }
            *(u32x4*)dst = (u32x4){0u, 0u, 0u, 0u};
        }
    }
    {
        const int gt = blockIdx.x * NT + tid, NG = gridDim.x * NT;
        float* lb = (float*)(P.ws + WS_LB);
        for (int ch = gt; ch < 512; ch += NG) {
            float lg[4], mx = -1e30f;
#pragma unroll
            for (int l = 0; l < 4; ++l) { lg[l] = P.hg_lb_logits[l * 512 + ch]; mx = fmaxf(mx, lg[l]); }
            float e[4], s = 0.f;
#pragma unroll
            for (int l = 0; l < 4; ++l) { e[l] = __expf(lg[l] - mx); s += e[l]; }
            float cum = 0.f;
#pragma unroll
            for (int l = 0; l < 4; ++l) { if (l > 0) cum += e[l] / s; lb[l * 512 + ch] = cum; }
        }
    }
    __syncthreads();
    {
        LAS float* sc = (LAS float*)lds;
        LAS float* red = (LAS float*)(lds + 5 * 1024 * 4);
        for (int i = tid; i < 5 * D; i += NT) { const int m = i >> 10, k = i & 1023; const float v = m < 4 ? P.c[m * D + k] : P.c_ctx[k]; sc[i] = siluf_(v); }
        __syncthreads();
        float* modv = (float*)(P.ws + WS_MODV);
        for (int cb = blockIdx.x; cb < 4 * 6144 / 96; cb += gridDim.x) {
            const int l = (cb * 96) / 6144, j0 = (cb * 96) % 6144;
            const int cg = tid % 24, kg = tid / 24;
            if (tid < 384) {
                const float* w = P.mod_w + (size_t)l * D * 6144 + (size_t)(kg * 64) * 6144 + j0 + 4 * cg;
                f32x4 a[5];
#pragma unroll
                for (int m = 0; m < 5; ++m) a[m] = (f32x4){0.f, 0.f, 0.f, 0.f};
#pragma unroll 1
                for (int k0 = 0; k0 < 64; k0 += 16) {
                    f32x4 wv4[16];
#pragma unroll
                    for (int u = 0; u < 16; ++u) wv4[u] = *(const f32x4*)(w + (size_t)(k0 + u) * 6144);
#pragma unroll
                    for (int u = 0; u < 16; ++u)
#pragma unroll
                        for (int m = 0; m < 5; ++m) a[m] += wv4[u] * sc[m * 1024 + kg * 64 + k0 + u];
                }
#pragma unroll
                for (int m = 0; m < 5; ++m) *(LAS f32x4*)(red + ((kg * 5 + m) * 96 + 4 * cg)) = a[m];
            }
            __syncthreads();
            if (tid < 480) {
                const int m = tid / 96, c = tid % 96;
                float sum = 0.f;
#pragma unroll
                for (int g = 0; g < 16; ++g) sum += red[(g * 5 + m) * 96 + c];
                modv[(size_t)(l * 5 + m) * 6144 + j0 + c] = sum + P.mod_b[l * 6144 + j0 + c];
            }
            __syncthreads();
        }
    }
}

__device__ __forceinline__ void phase_prologue1(int wv, KP Pk) {
    asm volatile("" : "+s"(Pk));
    const CAS Params& P = *Pk;
    const int tid = ltid(wv), lane = tid & 63, wid = tid >> 6;
    bf16_t* act = (bf16_t*)(P.ws + WS_ACT);
    f32x4 nv[4];
    auto fetch = [&](int rr) {
        const float* src = rr < NCTX ? P.ctx + (size_t)rr * D : P.x + (size_t)(rr - NCTX) * D;
#pragma unroll
        for (int i = 0; i < 4; ++i) nv[i] = *(const f32x4*)(src + 4 * lane + 256 * i);
    };
    const int stride = gridDim.x * 8;
    int r = blockIdx.x * 8 + wid;
    if (r < NROWS) fetch(r);
    for (; r < NROWS; r += stride) {
        const int m = row_mod(r);
        const f32x4 cv[4] = {nv[0], nv[1], nv[2], nv[3]};
        if (r + stride < NROWS) fetch(r + stride);
        const float* sh = modvec(P.ws, 0, m, 0); const float* sc = modvec(P.ws, 0, m, 1);
#pragma unroll
        for (int i = 0; i < 4; ++i) {
            const int c = 4 * lane + 256 * i;
            const f32x4 v = cv[i], s1 = *(const f32x4*)(sc + c), h1 = *(const f32x4*)(sh + c);
            u32x2 o; o.x = pk2(v[0] * (1.f + s1[0]) + h1[0], v[1] * (1.f + s1[1]) + h1[1]); o.y = pk2(v[2] * (1.f + s1[2]) + h1[2], v[3] * (1.f + s1[3]) + h1[3]);
            *(u32x2*)(act + (size_t)r * D + c) = o;
        }
    }
}

__device__ __forceinline__ void phase_inproj(int wv, KP Pk, int layer, LAS char* lds) {
    asm volatile("" : "+s"(Pk));
    const CAS Params& P = *Pk;
    const int odd = layer & 1, ldp = odd ? LDP_ODD : LDP_EVEN;
    const size_t woff = layer == 0 ? WINT_L0 : layer == 1 ? WINT_L1 : layer == 2 ? WINT_L2 : WINT_L3;
    pg8::Gemm g{(const bf16_t*)(P.ws + WS_ACT), (const bf16_t*)(P.ws + WS_WINT) + woff, NROWS, ldp, D};
    pg8::StaticOrder S; S.init(NROWS, ldp, (int)gridDim.x, (int)blockIdx.x);
    pg8::EpiStoreP E{(bf16_t*)(P.ws + WS_P), ldp};
    pg8::gemm_phase(wv, (PG8_LAS unsigned char*)lds, g, S, E);
    expconv_tail(wv, P, layer, lds, (NROWS / 256) * (ldp / 256), 0, exc_s0(layer));
}
__device__ __forceinline__ void phase_outproj(int wv, KP Pk, int layer, LAS char* lds) {
    asm volatile("" : "+s"(Pk));
    const CAS Params& P = *Pk;
    const int r0 = (layer == DEPTH - 1) ? NCTX : 0;
    pg8::Gemm g{(const bf16_t*)(P.ws + WS_FEAT) + (size_t)r0 * D, (const bf16_t*)(P.ws + WS_WOUTT) + (size_t)layer * D * D, NROWS - r0, D, D};
    pg8::StaticOrder S; S.init(NROWS - r0, D, (int)gridDim.x, (int)blockIdx.x);
    pg8::EpiStoreP E{(bf16_t*)(P.ws + WS_YO) + (size_t)r0 * D, D};
    pg8::gemm_phase(wv, (PG8_LAS unsigned char*)lds, g, S, E);
    expconv_tail(wv, P, layer, lds, ((NROWS - r0) / 256) * (D / 256), exc_s0(layer), exc_s0(layer) + exc_s1(layer));
}
__device__ __forceinline__ void phase_prep2(int wv, KP Pk, int layer, LAS char* lds) {
    asm volatile("" : "+s"(Pk));
    const CAS Params& P = *Pk;
    const int i = layer >> 1;
    const bf16_t* la = (const bf16_t*)(P.ws + WS_LA);
    const bf16_t* lt = (const bf16_t*)(P.ws + WS_LORAT) + (size_t)i * LORA_PER;
    constexpr int MT = NROWS / G_BM, NTL = 512 / G_BN;
    const int ntiles = 4 * MT * NTL;
    for (int t = blockIdx.x; t < ntiles; t += gridDim.x) {
        const int which = t / (MT * NTL), r = t % (MT * NTL), mt = r / NTL, nt = r % NTL;
        RowLinear rs{mt * G_BM};
        if (which < 2) {
            EpiDecay epi{(float*)(P.ws + WS_RWDEC) + (size_t)which * NROWS * 512, P.rw_w0 + (size_t)(i * 2 + which) * 512, mt * G_BM, nt * G_BN};
            gemm_tile(wv, la + which * 64, 320, rs, lt + (size_t)which * 512 * 64, 64, nt * G_BN, 64, epi, lds);
        } else if (which == 2) {
            EpiAK epi{(bf16_t*)(P.ws + WS_RWK), (const bf16_t*)(P.ws + WS_RWKK), (bf16_t*)(P.ws + WS_RWB), P.rw_a0 + i * 512, P.rw_k_a + i * 512, mt * G_BM, nt * G_BN};
            gemm_tile(wv, la + 128, 320, rs, lt + (size_t)2 * 512 * 64, 64, nt * G_BN, 64, epi, lds);
        } else {
            EpiStoreBf16 epi{(bf16_t*)(P.ws + WS_RWG), 512, mt * G_BM, nt * G_BN, 512};
            gemm_tile(wv, la + 192, 320, rs, lt + (size_t)3 * 512 * 64, 128, nt * G_BN, 128, epi, lds);
        }
    }
}
__device__ __forceinline__ void moe_tiles(int wv, const unsigned char* ws, int layer, LAS int* tstart, LAS int* tcnt) {
    const int tid = ltid(wv);
    if (tid < 64) {
        const int* cnt = (const int*)(ws + WS_CNT) + layer * 32 * CNT_STRIDE;
        const int c = tid < NEXP ? cnt[tid * CNT_STRIDE] : 0;
        int incl = (c + G_BM - 1) / G_BM;
#pragma unroll
        for (int o = 1; o < 32; o <<= 1) { const int t = __shfl_up(incl, o); if (tid >= o) incl += t; }
        if (tid < NEXP) { tcnt[tid] = c; tstart[tid] = incl - (c + G_BM - 1) / G_BM; }
        if (tid == NEXP - 1) tstart[NEXP] = incl;
    }
    __syncthreads();
}
__device__ __forceinline__ void phase_moe1(int wv, KP Pk, int layer, LAS char* lds) {
    asm volatile("" : "+s"(Pk));
    const CAS Params& P = *Pk;
    LAS int* tstart = (LAS int*)(lds + pg8::STAGE_BYTES); LAS int* tcnt = tstart + 40;
    moe_tiles(wv, P.ws, layer, tstart, tcnt);
    pg8::Gemm g{(const bf16_t*)(P.ws + WS_ACT), (const bf16_t*)(P.ws + WS_EXPGU), 0, 1024, D};
    LAS int* ltabs = tstart + 128;
    pg8::MoeOrder S{tstart, tcnt, ltabs, (const int*)(P.ws + WS_LIST), (const char*)(P.ws + WS_EXPGU), (size_t)1024 * 1024 * 2, 4, 1, (int)gridDim.x, (int)blockIdx.x};
    pg8::EpiSwiGLUG E{(bf16_t*)(P.ws + WS_HID)};
    for (int i = 0; i < 8; ++i) {
        pg8::UnitG u; if (!S.next(i, u)) break;
        const int tl = ltid(wv);
        const int* ul = (const int*)(P.ws + WS_LIST) + (size_t)u.e * LISTCAP + u.pm * pg8::BM;
        if (tl < pg8::BM) ltabs[i * pg8::BM + tl] = ul[tl < u.cnt ? tl : 0];
    }
    __syncthreads();
    pg8::gemm_phase_g(wv, (PG8_LAS unsigned char*)lds, g, S, E);
    __syncthreads();
}
__device__ __forceinline__ void phase_moe2(int wv, KP Pk, int layer, LAS char* lds) {
    asm volatile("" : "+s"(Pk));
    const CAS Params& P = *Pk;
    LAS int* tstart = (LAS int*)(lds + pg8::STAGE_BYTES); LAS int* tcnt = tstart + 40;
    moe_tiles(wv, P.ws, layer, tstart, tcnt);
    pg8::Gemm g{(const bf16_t*)(P.ws + WS_HID), (const bf16_t*)(P.ws + WS_EXPD), 0, 1024, DEXP};
    LAS int* ltabs = tstart + 128;
    pg8::MoeOrder S{tstart, tcnt, ltabs, (const int*)(P.ws + WS_LIST), (const char*)(P.ws + WS_EXPD), (size_t)1024 * 512 * 2, 4, 0, (int)gridDim.x, (int)blockIdx.x};
    pg8::EpiScatterG E{(bf16_t*)(P.ws + WS_YP)};
    for (int i = 0; i < 8; ++i) {
        pg8::UnitG u; if (!S.next(i, u)) break;
        const int tl = ltid(wv);
        const int* ul = (const int*)(P.ws + WS_LIST) + (size_t)u.e * LISTCAP + u.pm * pg8::BM;
        if (tl < pg8::BM) ltabs[i * pg8::BM + tl] = ul[tl < u.cnt ? tl : 0];
    }
    __syncthreads();
    pg8::gemm_phase_g(wv, (PG8_LAS unsigned char*)lds, g, S, E);
    __syncthreads();
}

constexpr int NCHUNK = NSTEPS / TCH;

constexpr int SSD_F = 32 + 64 + 64;
constexpr int SSD_BUF = TCH * SSD_F + 3 * TCH;

constexpr int ML_F = 64 + 64 + 32;
constexpr int ML_BUF = TCH * ML_F + 4 * TCH;

constexpr int HG_F = 128 + 128 + 32;
constexpr int HG_BUF = TCH * HG_F + TCH;

constexpr int RW_F = 5 * 64 + 32;
constexpr int RW_BUF = TCH * RW_F + TCH;
__device__ __forceinline__ void scan_rwkv_b(int wv, KP Pk, int layer, int unit, LAS char* lds) {
    asm volatile("" : "+s"(Pk));
    const CAS Params& P = *Pk;
    const int tid = ltid(wv);
    const int seq = unit >> 1, half = unit & 1, b = seq >> 4, h = (seq >> 1) & 7, dir = seq & 1;
    LAS float* bufs = (LAS float*)lds;
    bf16_t* Y = (bf16_t*)(P.ws + (dir ? WS_YB : WS_YF));
    const float* dec = (const float*)(P.ws + WS_RWDEC) + (size_t)dir * NROWS * 512;
    constexpr int NS = 7;
    const int stid = tid - 256;
    int tj[NS], tg_[NS]; bool tv[NS]; const unsigned char* tbase[NS]; int tlds[NS];
#pragma unroll
    for (int s = 0; s < NS; ++s) {
        const int task = stid + 256 * s; tv[s] = stid >= 0 && task < TCH * 52; tj[s] = task / 52; tg_[s] = task % 52;
        const int g = tg_[s];
        if (g < 8)       { tbase[s] = P.ws + WS_RWR  + (size_t)(h * 64 + 8 * g) * 2;              tlds[s] = 256 + 8 * g; }
        else if (g < 16) { tbase[s] = P.ws + WS_RWK  + (size_t)(h * 64 + 8 * (g - 8)) * 2;        tlds[s] = 192 + 8 * (g - 8); }
        else if (g < 24) { tbase[s] = P.ws + WS_RWKK + (size_t)(h * 64 + 8 * (g - 16)) * 2;       tlds[s] = 64 + 8 * (g - 16); }
        else if (g < 32) { tbase[s] = P.ws + WS_RWB  + (size_t)(h * 64 + 8 * (g - 24)) * 2;       tlds[s] = 128 + 8 * (g - 24); }
        else if (g < 36) { tbase[s] = P.ws + WS_RWV  + (size_t)(h * 64 + half * 32 + 8 * (g - 32)) * 2; tlds[s] = 320 + 8 * (g - 32); }
        else             { tbase[s] = (const unsigned char*)(dec + h * 64 + 4 * (g - 36));        tlds[s] = 4 * (g - 36); }
    }
    u32x4 rc[NS]; int rrow = 0;
    auto load = [&](int c) {
#pragma unroll
        for (int s = 0; s < NS; ++s) {
            rc[s] = (u32x4){0u, 0u, 0u, 0u};
            if (tv[s]) { const int row = scan_row(c * TCH + tj[s], b, dir, 1); rc[s] = *(const u32x4*)(tbase[s] + (size_t)row * (tg_[s] < 36 ? 1024 : 2048)); }
        }
        if (stid >= 0 && stid < TCH) rrow = scan_row(c * TCH + stid, b, dir, 1);
    };
    auto store = [&](int c) {
        LAS float* buf = bufs + (c & 1) * RW_BUF;
#pragma unroll
        for (int s = 0; s < NS; ++s) {
            if (tv[s]) {
                LAS float* dst = buf + tj[s] * RW_F + tlds[s];
                const int g = tg_[s];
                if (g >= 36) { *(LAS u32x4*)dst = rc[s]; }
                else {
                    float f[8]; unpack8(rc[s], f);
                    const float sg = (g >= 16 && g < 24) ? -1.f : 1.f;
                    *(LAS f32x4*)dst = (f32x4){sg * f[0], sg * f[1], sg * f[2], sg * f[3]}; *(LAS f32x4*)(dst + 4) = (f32x4){sg * f[4], sg * f[5], sg * f[6], sg * f[7]};
                }
            }
        }
        if (stid >= 0 && stid < TCH) ((LAS int*)buf)[TCH * RW_F + stid] = rrow;
    };
    const int q = tid & 15, vr = (tid >> 4) & 3, rowA = 8 * wv + vr, rowB = rowA + 4;
    f32x2 A01 = {0.f, 0.f}, A23 = {0.f, 0.f}, B01 = {0.f, 0.f}, B23 = {0.f, 0.f};
    LAS float* ypw = bufs + 2 * RW_BUF + (wv & 3) * (2 * 16 * 132);
    int prow = -1, gpar = 0;
    if (wv >= 4) { load(0); store(0); }
    __syncthreads();
    for (int c = 0; c < NCHUNK; ++c) {
        if (wv >= 4 && c + 1 < NCHUNK) load(c + 1);
        LAS float* buf = bufs + (c & 1) * RW_BUF;
        if (wv < 4) {
            const LAS float* wp = buf + 4 * q;
            const LAS float* vpA = buf + 320 + rowA; const LAS float* vpB = buf + 320 + rowB;
            f32x4 w4 = *(const LAS f32x4*)wp, a4 = *(const LAS f32x4*)(wp + 64), b4 = *(const LAS f32x4*)(wp + 128), k4 = *(const LAS f32x4*)(wp + 192), r4 = *(const LAS f32x4*)(wp + 256); float vrA = vpA[0], vrB = vpB[0];
#pragma unroll 1
            for (int jh = 0; jh < 2; ++jh) {
                const LAS float* rp = ypw + (gpar ^ 1) * (16 * 132) + q * 132 + vr * 16;
                const f32x4 pa0 = *(const LAS f32x4*)rp, pa1 = *(const LAS f32x4*)(rp + 4), pa2 = *(const LAS f32x4*)(rp + 8), pa3 = *(const LAS f32x4*)(rp + 12);
                const f32x4 pb0 = *(const LAS f32x4*)(rp + 64), pb1 = *(const LAS f32x4*)(rp + 68), pb2 = *(const LAS f32x4*)(rp + 72), pb3 = *(const LAS f32x4*)(rp + 76);
                LAS float* wpz = ypw + gpar * (16 * 132) + (tid & 63);
#pragma unroll
                for (int j = 0; j < 16; ++j) {
                    const int jj = jh * 16 + j;
                    const f32x4 wc = w4, ac = a4, bc = b4, kc = k4, rc = r4; const float vvA = vrA, vvB = vrB;
                    if (j < 15 || jh == 0) {
                        const LAS float* np = wp + (jj + 1) * RW_F;
                        w4 = *(const LAS f32x4*)np; a4 = *(const LAS f32x4*)(np + 64); b4 = *(const LAS f32x4*)(np + 128); k4 = *(const LAS f32x4*)(np + 192); r4 = *(const LAS f32x4*)(np + 256);
                        vrA = vpA[(jj + 1) * RW_F]; vrB = vpB[(jj + 1) * RW_F];
                    }
                    const f32x2 a01 = {ac[0], ac[1]}, a23 = {ac[2], ac[3]}, w01 = {wc[0], wc[1]}, w23 = {wc[2], wc[3]}, b01 = {bc[0], bc[1]}, b23 = {bc[2], bc[3]};
                    const f32x2 k01 = {kc[0], kc[1]}, k23 = {kc[2], kc[3]}, r01 = {rc[0], rc[1]}, r23 = {rc[2], rc[3]}, va2 = {vvA, vvA}, vb2 = {vvB, vvB};
                    f32x2 tA = A01 * a01; tA = A23 * a23 + tA;
                    f32x2 tB = B01 * a01; tB = B23 * a23 + tB;
                    const f32x2 uA01 = A01 * w01 + va2 * k01, uA23 = A23 * w23 + va2 * k23, uB01 = B01 * w01 + vb2 * k01, uB23 = B23 * w23 + vb2 * k23;
                    const float saA = allreduce16(tA.x + tA.y), saB = allreduce16(tB.x + tB.y);
                    const f32x2 sA2 = {saA, saA}, sB2 = {saB, saB};
                    A01 = sA2 * b01 + uA01; A23 = sA2 * b23 + uA23; B01 = sB2 * b01 + uB01; B23 = sB2 * b23 + uB23;
                    f32x2 yA = A01 * r01; yA = A23 * r23 + yA;
                    f32x2 yB = B01 * r01; yB = B23 * r23 + yB;
                    wpz[j * 132] = yA.x + yA.y; wpz[j * 132 + 64] = yB.x + yB.y;
                }
                if (prow >= 0) {
                    const f32x4 ta = (pa0 + pa1) + (pa2 + pa3), tb = (pb0 + pb1) + (pb2 + pb3);
                    bf16_t* yo = Y + (size_t)prow * D + 512 + h * 64 + half * 32;
                    yo[rowA] = f2bf((ta[0] + ta[1]) + (ta[2] + ta[3])); yo[rowB] = f2bf((tb[0] + tb[1]) + (tb[2] + tb[3]));
                }
                prow = ((const LAS int*)buf)[TCH * RW_F + jh * 16 + q];
                gpar ^= 1;
            }
        }
        if (wv >= 4 && c + 1 < NCHUNK) store(c + 1);
        __syncthreads();
    }
    if (wv < 4) {
        const LAS float* rp = ypw + (gpar ^ 1) * (16 * 132) + q * 132 + vr * 16;
        const f32x4 ta = (*(const LAS f32x4*)rp + *(const LAS f32x4*)(rp + 4)) + (*(const LAS f32x4*)(rp + 8) + *(const LAS f32x4*)(rp + 12));
        const f32x4 tb = (*(const LAS f32x4*)(rp + 64) + *(const LAS f32x4*)(rp + 68)) + (*(const LAS f32x4*)(rp + 72) + *(const LAS f32x4*)(rp + 76));
        bf16_t* yo = Y + (size_t)prow * D + 512 + h * 64 + half * 32;
        yo[rowA] = f2bf((ta[0] + ta[1]) + (ta[2] + ta[3])); yo[rowB] = f2bf((tb[0] + tb[1]) + (tb[2] + tb[3]));
    }
}

constexpr size_t WS_EXBC = WS_RWR;
constexpr size_t WS_EQK = WS_EXBC + (size_t)NROWS * 768 * 2;
constexpr size_t WS_EGT = WS_EQK + (size_t)NROWS * 512 * 2;
static_assert(WS_EGT + (size_t)NROWS * 32 * 4 <= WS_LA, "even-layer prepare buffers must fit in the RWKV region");

__device__ __forceinline__ void phase_prep_even(int wv, KP Pk, int layer) {
    asm volatile("" : "+s"(Pk));
    const CAS Params& P = *Pk;
    const int tid = ltid(wv), lane = tid & 63, wid = tid >> 6, i_ = layer >> 1;
    const bf16_t* Pb = (const bf16_t*)(P.ws + WS_P);
    bf16_t* XBC = (bf16_t*)(P.ws + WS_EXBC); bf16_t* QK = (bf16_t*)(P.ws + WS_EQK); float* GT = (float*)(P.ws + WS_EGT);
    float cw0[4][8], cw1[4][8], cwq[4][8];
#pragma unroll
    for (int e = 0; e < 8; ++e) {
#pragma unroll
        for (int t = 0; t < 3; ++t) {
            cw0[t][e] = P.ssd_conv_w[(size_t)(i_ * 3 + t) * 768 + 8 * lane + e];
            cw1[t][e] = P.ssd_conv_w[(size_t)(i_ * 3 + t) * 768 + 512 + 8 * (lane & 31) + e];
            cwq[t][e] = P.ml_conv_w[(size_t)(i_ * 3 + t) * 512 + 8 * lane + e];
        }
        cw0[3][e] = P.ssd_conv_b[i_ * 768 + 8 * lane + e]; cw1[3][e] = P.ssd_conv_b[i_ * 768 + 512 + 8 * (lane & 31) + e]; cwq[3][e] = P.ml_conv_b[i_ * 512 + 8 * lane + e];
    }
    float gbias = 0.f;
    if (lane < 16) gbias = P.ssd_dt_bias[i_ * 16 + lane]; else if (lane < 24) gbias = P.ml_i_bias[i_ * 8 + lane - 16]; else if (lane < 32) gbias = P.ml_f_bias[i_ * 8 + lane - 24];
    const float qscl = lane < 32 ? 0.125f : 1.f;
    const u32x4 zero = (u32x4){0u, 0u, 0u, 0u};
    u32x4 nA[3], nB[3], nC[3]; bf16_t ng = 0;
    auto fetch = [&](int rr) {
        int t, len; row_seg(rr, t, len);
        const bf16_t* pr = Pb + (size_t)rr * LDP_EVEN;
        const bool hp = t > 0, hn = t < len - 1;
        { const int col = 512 + 8 * lane; nA[0] = *(const u32x4*)(pr + col); nA[1] = hp ? *(const u32x4*)(pr - LDP_EVEN + col) : zero; nA[2] = hn ? *(const u32x4*)(pr + LDP_EVEN + col) : zero; }
        if (lane < 32) { const int col = 1024 + 8 * lane; nB[0] = *(const u32x4*)(pr + col); nB[1] = hp ? *(const u32x4*)(pr - LDP_EVEN + col) : zero; nB[2] = hn ? *(const u32x4*)(pr + LDP_EVEN + col) : zero; }
        { const int col = 1296 + 8 * lane; nC[0] = *(const u32x4*)(pr + col); nC[1] = hp ? *(const u32x4*)(pr - LDP_EVEN + col) : zero; nC[2] = hn ? *(const u32x4*)(pr + LDP_EVEN + col) : zero; }
        if (lane < 32) ng = pr[lane < 16 ? 1280 + lane : 2832 + (lane - 16)];
    };
    nB[0] = nB[1] = nB[2] = zero;
    const int stride = gridDim.x * 8;
    int r = blockIdx.x * 8 + wid;
    if (r < NROWS) fetch(r);
    for (; r < NROWS; r += stride) {
        const u32x4 cA0 = nA[0], cA1 = nA[1], cA2 = nA[2], cB0 = nB[0], cB1 = nB[1], cB2 = nB[2], cC0 = nC[0], cC1 = nC[1], cC2 = nC[2]; const bf16_t cg = ng;
        if (r + stride < NROWS) fetch(r + stride);
        float fc[8], fp[8], fn[8], o[8];
        {
            unpack8(cA0, fc); unpack8(cA1, fp); unpack8(cA2, fn);
#pragma unroll
            for (int e = 0; e < 8; ++e) o[e] = siluf_(cw0[0][e] * fp[e] + cw0[1][e] * fc[e] + cw0[2][e] * fn[e] + cw0[3][e]);
            *(u32x4*)(XBC + (size_t)r * 768 + 8 * lane) = pack8(o);
        }
        if (lane < 32) {
            unpack8(cB0, fc); unpack8(cB1, fp); unpack8(cB2, fn);
#pragma unroll
            for (int e = 0; e < 8; ++e) o[e] = siluf_(cw1[0][e] * fp[e] + cw1[1][e] * fc[e] + cw1[2][e] * fn[e] + cw1[3][e]);
            *(u32x4*)(XBC + (size_t)r * 768 + 512 + 8 * lane) = pack8(o);
        }
        {
            unpack8(cC0, fc); unpack8(cC1, fp); unpack8(cC2, fn);
#pragma unroll
            for (int e = 0; e < 8; ++e) o[e] = qscl * siluf_(cwq[0][e] * fp[e] + cwq[1][e] * fc[e] + cwq[2][e] * fn[e] + cwq[3][e]);
            *(u32x4*)(QK + (size_t)r * 512 + 8 * lane) = pack8(o);
        }
        if (lane < 32) {
            const float x = bf2f(cg) + gbias;
            GT[(size_t)r * 32 + lane] = lane < 16 ? softplusf_(x) : lane < 24 ? x : logsigmoidf_(x);
        }
    }
}

constexpr int CL = 64, NCH64 = NSTEPS / CL, LDT = 72, LDTB = LDT * 2;
__device__ __forceinline__ bf16x8 ldfrag(const LAS char* tile, int ldb, int row0, int k0, int lane) {
    return *(const LAS bf16x8*)(tile + (row0 + (lane & 15)) * ldb + (k0 + 8 * (lane >> 4)) * 2);
}
typedef short s16x4 __attribute__((ext_vector_type(4)));
constexpr int LDV = 272;
__device__ __forceinline__ bf16x8 ldfrag_tr(const LAS char* tile, int rowb, int c0, int k0, int lane) {
    const int i = lane & 15;
    const LAS char* p = tile + (k0 + 8 * (lane >> 4) + (i >> 2)) * rowb + (c0 + 4 * (i & 3)) * 2;
    const s16x4 lo = __builtin_amdgcn_ds_read_tr16_b64_v4i16((LAS s16x4*)p);
    const s16x4 hi = __builtin_amdgcn_ds_read_tr16_b64_v4i16((LAS s16x4*)(p + 4 * rowb));
    return (bf16x8){lo[0], lo[1], lo[2], lo[3], hi[0], hi[1], hi[2], hi[3]};
}
__device__ __forceinline__ void st4bf(LAS char* p, const f32x4& v) { u32x2 o; o.x = pk2(v[0], v[1]); o.y = pk2(v[2], v[3]); *(LAS u32x2*)p = o; }

constexpr int SS_BT = 0, SS_CT = SS_BT + 64 * LDTB, SS_BDT = SS_CT + 64 * LDTB, SS_XT = SS_BDT + 64 * LDTB, SS_CUM = SS_XT + 32 * LDTB, SS_DTV = SS_CUM + 256, SS_ROWS = SS_DTV + 256, SS_STG = SS_ROWS + 256;
constexpr int SS_M = 2 * SS_STG, SS_HB = SS_M + 64 * LDTB, SS_END = SS_HB + 32 * LDTB;
static_assert(SS_END <= LDS_BYTES - 16, "SSD LDS map");

constexpr int MS_QT = 0, MS_KT = MS_QT + 64 * LDTB, MS_KET = MS_KT + 64 * LDTB, MS_VT = MS_KET + 64 * LDTB, MS_SC = MS_VT + 32 * LDTB;
constexpr int MS_STG = MS_SC + 8 * 256;
constexpr int MS_W = 2 * MS_STG, MS_CB = MS_W + 64 * LDTB, MS_ONE = MS_CB + 32 * LDTB, MS_NV = MS_ONE + 16 * LDTB, MS_QN = MS_NV + 256, MS_END = MS_QN + 256;
static_assert(MS_END <= LDS_BYTES - 16, "mLSTM LDS map");

constexpr size_t WS_XSS = WS_EGT + al256((size_t)NROWS * 32 * 4);
constexpr size_t XSS_BYTES = (size_t)64 * NCH64 * 64 * 64 * 2;
constexpr size_t WS_XSD = WS_XSS + XSS_BYTES;
constexpr size_t WS_XMC = WS_XSD + al256((size_t)64 * NCH64 * 4);
constexpr size_t XMC_BYTES = (size_t)32 * NCH64 * 128 * 64 * 2;
constexpr size_t WS_XMN = WS_XMC + XMC_BYTES;
constexpr size_t WS_XMS = WS_XMN + (size_t)32 * NCH64 * 64 * 4;
constexpr size_t WS_XMT = WS_XMS + al256((size_t)32 * NCH64 * 4 * 4);
constexpr size_t WS_XEND = WS_XMT + (size_t)32 * NCH64 * 3 * 64 * 4;
static_assert(WS_XEND <= WS_END, "even-layer chunk-state buffers must fit in the RWKV region");
constexpr int NSSD_ITEMS = 64 * NCH64, NML_ITEMS = 32 * NCH64;

template <int CTRL, int RM, int BM> __device__ __forceinline__ float dppx(float old, float v) {
    return __builtin_bit_cast(float, __builtin_amdgcn_update_dpp(__builtin_bit_cast(int, old), __builtin_bit_cast(int, v), CTRL, RM, BM, false));
}
__device__ __forceinline__ float wave_cumsum(float v, int) {
    float t = v;
    t += dppx<0x111, 0xf, 0xf>(0.f, v); t += dppx<0x112, 0xf, 0xf>(0.f, v); t += dppx<0x113, 0xf, 0xf>(0.f, v);
    { const float u = dppx<0x114, 0xf, 0xe>(0.f, t); t += u; }
    { const float u = dppx<0x118, 0xf, 0xc>(0.f, t); t += u; }
    { const float u = dppx<0x142, 0xa, 0xf>(0.f, t); t += u; }
    { const float u = dppx<0x143, 0xc, 0xf>(0.f, t); t += u; }
    return t;
}
__device__ __forceinline__ float wave_cummax(float v, int) {
    const float ninf = -__builtin_huge_valf();
    float t = v;
    t = fmaxf(t, dppx<0x111, 0xf, 0xf>(ninf, v)); t = fmaxf(t, dppx<0x112, 0xf, 0xf>(ninf, v)); t = fmaxf(t, dppx<0x113, 0xf, 0xf>(ninf, v));
    { const float u = dppx<0x114, 0xf, 0xe>(ninf, t); t = fmaxf(t, u); }
    { const float u = dppx<0x118, 0xf, 0xc>(ninf, t); t = fmaxf(t, u); }
    { const float u = dppx<0x142, 0xa, 0xf>(ninf, t); t = fmaxf(t, u); }
    { const float u = dppx<0x143, 0xc, 0xf>(ninf, t); t = fmaxf(t, u); }
    return t;
}
__device__ __forceinline__ float wave_max(float v) {
    const float t = wave_cummax(v, 0);
    return __builtin_bit_cast(float, __builtin_amdgcn_readlane(__builtin_bit_cast(int, t), 63));
}

constexpr int X1S_BDT = 0, X1S_XT = X1S_BDT + 64 * LDTB, X1S_CUM = X1S_XT + 64 * LDTB, X1S_DTV = X1S_CUM + 256, X1S_END = X1S_DTV + 256;
constexpr int X1M_KET = 0, X1M_VT = X1M_KET + 64 * LDTB, X1M_ONE = X1M_VT + 64 * LDV, X1M_EE = X1M_ONE + 16 * LDTB, X1M_END = X1M_EE + 256;
__device__ __forceinline__ void phase_ex1(int wv, KP Pk, int layer, LAS char* lds) {
    asm volatile("" : "+s"(Pk));
    const CAS Params& P = *Pk;
    const int tid = ltid(wv), lane = tid & 63, wid = tid >> 6, q = lane >> 4, r16 = lane & 15, i_ = layer >> 1;
    const bf16_t* XBC = (const bf16_t*)(P.ws + WS_EXBC); const bf16_t* QK = (const bf16_t*)(P.ws + WS_EQK); const bf16_t* Pb = (const bf16_t*)(P.ws + WS_P);
    const float* GT = (const float*)(P.ws + WS_EGT);
    {
        bf16_t* Hst = (bf16_t*)(P.ws + WS_XSS); float* Dst = (float*)(P.ws + WS_XSD);
        struct Set { u32x4 rc[2]; float rdt; }; Set SA, SB; SA.rdt = SB.rdt = 0.f;
        auto geom = [&](int it, int& b, int& h, int& dir, int& c) { const int sq = it / NCH64; c = it - sq * NCH64; b = sq >> 4; h = (sq >> 1) & 7; dir = sq & 1; };
        auto load = [&](int it, Set& S) {
            int b, h, dir, c; geom(it, b, h, dir, c);
            int tl = tid; asm volatile("" : "+v"(tl));
#pragma unroll
            for (int s = 0; s < 2; ++s) {
                const int task = tl + NT * s, j = task >> 4, g = task & 15;
                const int row = scan_row(c * CL + j, b, dir, 0);
                S.rc[s] = *(const u32x4*)(XBC + (size_t)row * 768 + (g < 8 ? h * 64 + 8 * g : 512 + (h >> 2) * 64 + 8 * (g - 8)));
            }
            if (tl < CL) { const int row = scan_row(c * CL + tl, b, dir, 0); S.rdt = GT[(size_t)row * 32 + dir * 8 + h]; }
        };
        auto item = [&](int it, Set& S, int nxt) {
            int b, h, dir, c; geom(it, b, h, dir, c);
            const float aco = -__expf(P.ssd_a_log[(i_ * 2 + dir) * 8 + h]);
            if (tid < CL) {
                const float cum = wave_cumsum(S.rdt * aco, lane);
                ((LAS float*)(lds + X1S_CUM))[tid] = cum; ((LAS float*)(lds + X1S_DTV))[tid] = S.rdt;
            }
            __syncthreads();
            {
                const LAS float* cum = (const LAS float*)(lds + X1S_CUM);
                const float cumL = cum[CL - 1];
                int tl = tid; asm volatile("" : "+v"(tl));
#pragma unroll
                for (int s = 0; s < 2; ++s) {
                    const int task = tl + NT * s, j = task >> 4, g = task & 15;
                    float f[8]; unpack8(S.rc[s], f);
                    if (g < 8) {
                        const float dt = ((const LAS float*)(lds + X1S_DTV))[j];
#pragma unroll
                        for (int e = 0; e < 8; ++e) f[e] *= dt;
                        *(LAS u32x4*)(lds + X1S_XT + j * LDTB + 16 * g) = pack8(f);
                    } else {
                        const float sc = __expf(cumL - cum[j]);
#pragma unroll
                        for (int e = 0; e < 8; ++e) f[e] *= sc;
                        *(LAS u32x4*)(lds + X1S_BDT + j * LDTB + 16 * (g - 8)) = pack8(f);
                    }
                }
                if (tid == 0) Dst[it] = __expf(cumL);
            }
            if (nxt < NSSD_ITEMS) load(nxt, S);
            __syncthreads();
            {
                const int pt = wid >> 1;
#pragma unroll
                for (int u = 0; u < 2; ++u) {
                    const int nt = (wid & 1) * 2 + u;
                    f32x4 sa = (f32x4){0.f, 0.f, 0.f, 0.f};
#pragma unroll
                    for (int k0 = 0; k0 < 64; k0 += 32) sa = __builtin_amdgcn_mfma_f32_16x16x32_bf16(ldfrag_tr(lds + X1S_BDT, LDTB, nt * 16, k0, lane), ldfrag_tr(lds + X1S_XT, LDTB, pt * 16, k0, lane), sa, 0, 0, 0);
                    u32x2 o; o.x = pk2(sa[0], sa[1]); o.y = pk2(sa[2], sa[3]);
                    *(u32x2*)(Hst + ((size_t)it * 64 + pt * 16 + r16) * 64 + nt * 16 + 4 * q) = o;
                }
            }
            __syncthreads();
        };
        {
            const int G = gridDim.x; int it = blockIdx.x;
            if (it < NSSD_ITEMS) load(it, SA);
            if (it + G < NSSD_ITEMS) load(it + G, SB);
            for (; it < NSSD_ITEMS; it += 2 * G) {
                item(it, SA, it + 2 * G);
                if (it + G < NSSD_ITEMS) item(it + G, SB, it + 3 * G);
            }
        }
    }
    {
        bf16_t* Cst = (bf16_t*)(P.ws + WS_XMC); float* Nst = (float*)(P.ws + WS_XMN); float* Sst = (float*)(P.ws + WS_XMS); float* Tst = (float*)(P.ws + WS_XMT);
        for (int i = tid; i < 16 * LDTB / 4; i += NT) ((LAS unsigned*)(lds + X1M_ONE))[i] = 0x3f803f80u;
        struct Set { u32x4 rc[3]; float rli, rlf; }; Set SA, SB; SA.rli = SA.rlf = SB.rli = SB.rlf = 0.f;
        auto geom = [&](int it, int& b, int& h, int& dir, int& c) { const int sq = it / NCH64; c = it - sq * NCH64; b = sq >> 3; h = (sq >> 1) & 3; dir = sq & 1; };
        auto load = [&](int it, Set& S) {
            int b, h, dir, c; geom(it, b, h, dir, c);
            int tl = tid; asm volatile("" : "+v"(tl));
#pragma unroll
            for (int s = 0; s < 3; ++s) {
                const int task = tl + NT * s, j = task / 24, g = task - 24 * j;
                const int row = scan_row(c * CL + j, b, dir, 0);
                S.rc[s] = g < 8 ? *(const u32x4*)(QK + (size_t)row * 512 + 256 + h * 64 + 8 * g) : *(const u32x4*)(Pb + (size_t)row * LDP_EVEN + 1808 + h * 128 + 8 * (g - 8));
            }
            if (tl < CL) { const int row = scan_row(c * CL + tl, b, dir, 0); S.rli = GT[(size_t)row * 32 + 16 + dir * 4 + h]; S.rlf = GT[(size_t)row * 32 + 24 + dir * 4 + h]; }
        };
        auto item = [&](int it, Set& S, int nxt) {
            if (tid < CL) {
                const float fcum = wave_cumsum(S.rlf, lane);
                const float ftot = __builtin_bit_cast(float, __builtin_amdgcn_readlane(__builtin_bit_cast(int, fcum), 63));
                const float g = S.rli - fcum, pm = wave_cummax(g, lane);
                const float wend = ftot + g, mloc = wave_max(wend);
                ((LAS float*)(lds + X1M_EE))[tid] = __expf(wend - mloc);
                float* tp = Tst + (size_t)it * 192;
                tp[tid] = fcum; tp[64 + tid] = g; tp[128 + tid] = pm;
                if (tid == 0) { Sst[(size_t)it * 4 + 0] = ftot; Sst[(size_t)it * 4 + 1] = mloc; }
            }
            __syncthreads();
            {
                const LAS float* ee = (const LAS float*)(lds + X1M_EE);
                int tl = tid; asm volatile("" : "+v"(tl));
#pragma unroll
                for (int s = 0; s < 3; ++s) {
                    const int task = tl + NT * s, j = task / 24, g = task - 24 * j;
                    if (g < 8) {
                        float f[8]; unpack8(S.rc[s], f);
                        const float e1 = ee[j];
#pragma unroll
                        for (int e = 0; e < 8; ++e) f[e] *= e1;
                        *(LAS u32x4*)(lds + X1M_KET + j * LDTB + 16 * g) = pack8(f);
                    } else {
                        const int v0 = 8 * (g - 8);
#pragma unroll
                        for (int e = 0; e < 1; ++e) *(LAS u32x4*)(lds + X1M_VT + j * LDV + v0 * 2) = S.rc[s];
                    }
                }
            }
            if (nxt < NML_ITEMS) load(nxt, S);
            __syncthreads();
            {
                const bf16x8 vf0 = ldfrag_tr(lds + X1M_VT, LDV, wid * 16, 0, lane), vf1 = ldfrag_tr(lds + X1M_VT, LDV, wid * 16, 32, lane);
#pragma unroll
                for (int kt = 0; kt < 4; ++kt) {
                    f32x4 sa = __builtin_amdgcn_mfma_f32_16x16x32_bf16(ldfrag_tr(lds + X1M_KET, LDTB, kt * 16, 0, lane), vf0, (f32x4){0.f, 0.f, 0.f, 0.f}, 0, 0, 0);
                    sa = __builtin_amdgcn_mfma_f32_16x16x32_bf16(ldfrag_tr(lds + X1M_KET, LDTB, kt * 16, 32, lane), vf1, sa, 0, 0, 0);
                    u32x2 o; o.x = pk2(sa[0], sa[1]); o.y = pk2(sa[2], sa[3]);
                    *(u32x2*)(Cst + ((size_t)it * 128 + wid * 16 + r16) * 64 + kt * 16 + 4 * q) = o;
                }
                if (wid < 4) {
                    f32x4 na = __builtin_amdgcn_mfma_f32_16x16x32_bf16(ldfrag_tr(lds + X1M_KET, LDTB, wid * 16, 0, lane), ldfrag(lds + X1M_ONE, LDTB, 0, 0, lane), (f32x4){0.f, 0.f, 0.f, 0.f}, 0, 0, 0);
                    na = __builtin_amdgcn_mfma_f32_16x16x32_bf16(ldfrag_tr(lds + X1M_KET, LDTB, wid * 16, 32, lane), ldfrag(lds + X1M_ONE, LDTB, 0, 32, lane), na, 0, 0, 0);
                    if (r16 == 0) *(f32x4*)(Nst + (size_t)it * 64 + wid * 16 + 4 * q) = na;
                }
            }
            __syncthreads();
        };
        {
            const int G = gridDim.x; int it = blockIdx.x;
            if (it < NML_ITEMS) load(it, SA);
            if (it + G < NML_ITEMS) load(it + G, SB);
            __syncthreads();
            for (; it < NML_ITEMS; it += 2 * G) {
                item(it, SA, it + 2 * G);
                if (it + G < NML_ITEMS) item(it + G, SB, it + 3 * G);
            }
        }
    }
}

constexpr int EX2_UB = 12;
static_assert(NCH64 % EX2_UB == 0, "EX2 batches");
__device__ __forceinline__ void phase_ex2(int wv, KP Pk, int layer) {
    asm volatile("" : "+s"(Pk));
    const CAS Params& P = *Pk;
    const int tid = ltid(wv);
    (void)layer;
    if (blockIdx.x < 128) {
        const int gt = blockIdx.x * NT + tid, sq = gt >> 10, rem = gt & 1023;
        bf16_t* Hst = (bf16_t*)(P.ws + WS_XSS) + (size_t)sq * NCH64 * 4096 + rem * 4;
        const float* Dst = (const float*)(P.ws + WS_XSD) + sq * NCH64;
        float h0 = 0.f, h1 = 0.f, h2 = 0.f, h3 = 0.f;
#pragma unroll 1
        for (int c0 = 0; c0 < NCH64; c0 += EX2_UB) {
            u32x2 loc[EX2_UB]; float dd[EX2_UB];
            bf16_t* hp = Hst + (size_t)c0 * 4096;
#pragma unroll
            for (int u = 0; u < EX2_UB; ++u) { loc[u] = *(const u32x2*)(hp + (size_t)u * 4096); dd[u] = Dst[c0 + u]; }
#pragma unroll
            for (int u = 0; u < EX2_UB; ++u) {
                u32x2 o; o.x = pk2(h0, h1); o.y = pk2(h2, h3);
                *(u32x2*)(hp + (size_t)u * 4096) = o;
                const float d = dd[u];
                h0 = d * h0 + bflo(loc[u].x); h1 = d * h1 + bfhi(loc[u].x); h2 = d * h2 + bflo(loc[u].y); h3 = d * h3 + bfhi(loc[u].y);
            }
        }
    } else if (blockIdx.x < 256) {
        const int gt = (blockIdx.x - 128) * NT + tid, sq = gt >> 11, rem = gt & 2047;
        bf16_t* Cst = (bf16_t*)(P.ws + WS_XMC) + (size_t)sq * NCH64 * 8192 + rem * 4;
        float* Nst = (float*)(P.ws + WS_XMN) + (size_t)sq * NCH64 * 64 + (rem & 15) * 4;
        float* Sst = (float*)(P.ws + WS_XMS) + (size_t)sq * NCH64 * 4;
        const bool own_n = rem < 16, own_m = rem == 0;
        float c0_ = 0.f, c1 = 0.f, c2 = 0.f, c3 = 0.f, m = -1e30f;
        f32x4 nn = (f32x4){0.f, 0.f, 0.f, 0.f};
#pragma unroll 1
        for (int cb = 0; cb < NCH64; cb += EX2_UB) {
            u32x2 loc[EX2_UB]; float ft[EX2_UB], ml[EX2_UB]; f32x4 nl[EX2_UB];
            bf16_t* cp = Cst + (size_t)cb * 8192; float* np = Nst + (size_t)cb * 64; float* sp_ = Sst + cb * 4;
#pragma unroll
            for (int u = 0; u < EX2_UB; ++u) {
                loc[u] = *(const u32x2*)(cp + (size_t)u * 8192); ft[u] = sp_[u * 4 + 0]; ml[u] = sp_[u * 4 + 1];
                nl[u] = (f32x4){0.f, 0.f, 0.f, 0.f};
                if (own_n) nl[u] = *(const f32x4*)(np + (size_t)u * 64);
            }
#pragma unroll
            for (int u = 0; u < EX2_UB; ++u) {
                const float ftot = ft[u], mloc = ml[u];
                const float mnew = fmaxf(ftot + m, mloc), sp = __expf(ftot + m - mnew), sl = __expf(mloc - mnew);
                u32x2 o; o.x = pk2(c0_, c1); o.y = pk2(c2, c3);
                *(u32x2*)(cp + (size_t)u * 8192) = o;
                c0_ = sp * c0_ + sl * bflo(loc[u].x); c1 = sp * c1 + sl * bfhi(loc[u].x); c2 = sp * c2 + sl * bflo(loc[u].y); c3 = sp * c3 + sl * bfhi(loc[u].y);
                if (own_n) { *(f32x4*)(np + (size_t)u * 64) = nn; nn = nn * sp + nl[u] * sl; }
                if (own_m) sp_[u * 4 + 2] = m;
                m = mnew;
            }
        }
    }
}

constexpr int X3S_BT = 0, X3S_CT = X3S_BT + 64 * LDTB, X3S_XT = X3S_CT + 64 * LDTB, X3S_HB = X3S_XT + 64 * LDTB, X3S_M = X3S_HB + 64 * LDTB, X3S_CUM = X3S_M + 64 * LDTB, X3S_DTV = X3S_CUM + 256, X3S_ROWS = X3S_DTV + 256, X3S_END = X3S_ROWS + 256;
constexpr int X3M_QT = 0, X3M_KT = X3M_QT + 64 * LDTB, X3M_VT = X3M_KT + 64 * LDTB, X3M_CB = X3M_VT + 64 * LDV, X3M_W = X3M_CB + 128 * LDTB, X3M_ONE = X3M_W + 64 * LDTB, X3M_NB = X3M_ONE + 16 * LDTB,
              X3M_SC = X3M_NB + 16 * LDTB, X3M_END = X3M_SC + 6 * 256;
static_assert(X3M_END <= LDS_BYTES - 16 && X3S_END <= LDS_BYTES - 16, "EX3 LDS maps");
__device__ __forceinline__ void phase_ex3(int wv, KP Pk, int layer, LAS char* lds) {
    asm volatile("" : "+s"(Pk));
    const CAS Params& P = *Pk;
    const int tid = ltid(wv), lane = tid & 63, wid = tid >> 6, q = lane >> 4, r16 = lane & 15, i_ = layer >> 1;
    const bf16_t* XBC = (const bf16_t*)(P.ws + WS_EXBC); const bf16_t* QK = (const bf16_t*)(P.ws + WS_EQK); const bf16_t* Pb = (const bf16_t*)(P.ws + WS_P);
    const float* GT = (const float*)(P.ws + WS_EGT);
    {
        const bf16_t* Hst = (const bf16_t*)(P.ws + WS_XSS);
        struct Set { u32x4 rc[3], rh; float rdt; int rrow; }; Set SA, SB; SA.rdt = SB.rdt = 0.f; SA.rrow = SB.rrow = 0;
        auto geom = [&](int it, int& b, int& h, int& dir, int& c) { const int sq = it / NCH64; c = it - sq * NCH64; b = sq >> 4; h = (sq >> 1) & 7; dir = sq & 1; };
        auto load = [&](int it, Set& S) {
            int b, h, dir, c; geom(it, b, h, dir, c);
            int tl = tid; asm volatile("" : "+v"(tl));
#pragma unroll
            for (int s = 0; s < 3; ++s) {
                const int task = tl + NT * s, j = task / 24, g = task - 24 * j;
                const int row = scan_row(c * CL + j, b, dir, 0);
                S.rc[s] = *(const u32x4*)(XBC + (size_t)row * 768 + (g < 8 ? h * 64 + 8 * g : g < 16 ? 512 + (h >> 2) * 64 + 8 * (g - 8) : 640 + (h >> 2) * 64 + 8 * (g - 16)));
            }
            S.rh = *(const u32x4*)(Hst + (size_t)it * 4096 + tl * 8);
            if (tl < CL) { S.rrow = scan_row(c * CL + tl, b, dir, 0); S.rdt = GT[(size_t)S.rrow * 32 + dir * 8 + h]; }
        };
        auto item = [&](int it, Set& S, int nxt) {
            int b, h, dir, c; geom(it, b, h, dir, c);
            bf16_t* Y = (bf16_t*)(P.ws + (dir ? WS_YB : WS_YF));
            const float aco = -__expf(P.ssd_a_log[(i_ * 2 + dir) * 8 + h]);
            if (tid < CL) {
                const float cum = wave_cumsum(S.rdt * aco, lane);
                ((LAS float*)(lds + X3S_CUM))[tid] = cum; ((LAS float*)(lds + X3S_DTV))[tid] = S.rdt; ((LAS int*)(lds + X3S_ROWS))[tid] = S.rrow;
            }
            __syncthreads();
            {
                int tl = tid; asm volatile("" : "+v"(tl));
#pragma unroll
                for (int s = 0; s < 3; ++s) {
                    const int task = tl + NT * s, j = task / 24, g = task - 24 * j;
                    if (g < 8) {
                        float f[8]; unpack8(S.rc[s], f);
                        const float dt = ((const LAS float*)(lds + X3S_DTV))[j];
#pragma unroll
                        for (int e = 0; e < 8; ++e) f[e] *= dt;
                        *(LAS u32x4*)(lds + X3S_XT + j * LDTB + 16 * g) = pack8(f);
                    } else if (g < 16) *(LAS u32x4*)(lds + X3S_BT + j * LDTB + 8 * (g - 8) * 2) = S.rc[s];
                    else *(LAS u32x4*)(lds + X3S_CT + j * LDTB + 8 * (g - 16) * 2) = S.rc[s];
                }
                *(LAS u32x4*)(lds + X3S_HB + (tl >> 3) * LDTB + (tl & 7) * 16) = S.rh;
            }
            if (nxt < NSSD_ITEMS) load(nxt, S);
            __syncthreads();
            const LAS float* cum = (const LAS float*)(lds + X3S_CUM);
            {
                const int lt = wid >> 1;
#pragma unroll
                for (int u = 0; u < 2; ++u) {
                    const int st = (wid & 1) * 2 + u;
                    f32x4 acc = (f32x4){0.f, 0.f, 0.f, 0.f};
                    if (st <= lt) {
#pragma unroll
                        for (int k0 = 0; k0 < 64; k0 += 32) acc = __builtin_amdgcn_mfma_f32_16x16x32_bf16(ldfrag(lds + X3S_BT, LDTB, st * 16, k0, lane), ldfrag(lds + X3S_CT, LDTB, lt * 16, k0, lane), acc, 0, 0, 0);
                        const int l = lt * 16 + r16, s0 = st * 16 + 4 * q;
                        const float cl = cum[l]; const f32x4 cs = *(const LAS f32x4*)(cum + s0);
#pragma unroll
                        for (int j = 0; j < 4; ++j) acc[j] = (s0 + j <= l) ? acc[j] * __expf(cl - cs[j]) : 0.f;
                    }
                    st4bf(lds + X3S_M + (lt * 16 + r16) * LDTB + (st * 16 + 4 * q) * 2, acc);
                }
            }
            __syncthreads();
            {
                const int lt = wid >> 1, l = lt * 16 + r16;
                const float el = __expf(cum[l]);
                const int row = ((const LAS int*)(lds + X3S_ROWS))[l];
                const bf16x8 mf0 = ldfrag(lds + X3S_M, LDTB, lt * 16, 0, lane), mf1 = ldfrag(lds + X3S_M, LDTB, lt * 16, 32, lane);
                const bf16x8 cf0 = ldfrag(lds + X3S_CT, LDTB, lt * 16, 0, lane), cf1 = ldfrag(lds + X3S_CT, LDTB, lt * 16, 32, lane);
#pragma unroll
                for (int u = 0; u < 2; ++u) {
                    const int pt = (wid & 1) * 2 + u;
                    f32x4 ya = __builtin_amdgcn_mfma_f32_16x16x32_bf16(ldfrag_tr(lds + X3S_XT, LDTB, pt * 16, 0, lane), mf0, (f32x4){0.f, 0.f, 0.f, 0.f}, 0, 0, 0);
                    ya = __builtin_amdgcn_mfma_f32_16x16x32_bf16(ldfrag_tr(lds + X3S_XT, LDTB, pt * 16, 32, lane), mf1, ya, 0, 0, 0);
                    f32x4 oa = __builtin_amdgcn_mfma_f32_16x16x32_bf16(ldfrag(lds + X3S_HB, LDTB, pt * 16, 0, lane), cf0, (f32x4){0.f, 0.f, 0.f, 0.f}, 0, 0, 0);
                    oa = __builtin_amdgcn_mfma_f32_16x16x32_bf16(ldfrag(lds + X3S_HB, LDTB, pt * 16, 32, lane), cf1, oa, 0, 0, 0);
                    u32x2 o; o.x = pk2(ya[0] + el * oa[0], ya[1] + el * oa[1]); o.y = pk2(ya[2] + el * oa[2], ya[3] + el * oa[3]);
                    *(u32x2*)(Y + (size_t)row * D + h * 64 + pt * 16 + 4 * q) = o;
                }
            }
            __syncthreads();
        };
        {
            const int G = gridDim.x; int it = blockIdx.x;
            if (it < NSSD_ITEMS) load(it, SA);
            if (it + G < NSSD_ITEMS) load(it + G, SB);
            __syncthreads();
            for (; it < NSSD_ITEMS; it += 2 * G) {
                item(it, SA, it + 2 * G);
                if (it + G < NSSD_ITEMS) item(it + G, SB, it + 3 * G);
            }
        }
    }
    {
        const bf16_t* Cst = (const bf16_t*)(P.ws + WS_XMC); const float* Nst = (const float*)(P.ws + WS_XMN); const float* Sst = (const float*)(P.ws + WS_XMS); const float* Tst = (const float*)(P.ws + WS_XMT);
        for (int i = tid; i < 16 * LDTB / 4; i += NT) ((LAS unsigned*)(lds + X3M_ONE))[i] = 0x3f803f80u;
        struct Set { u32x4 rc[4], rcb[2]; float rfc, rg, rpm, rmp, rn; int rrow; }; Set SA, SB; SA.rfc = SA.rg = SA.rpm = SA.rmp = SA.rn = SB.rfc = SB.rg = SB.rpm = SB.rmp = SB.rn = 0.f; SA.rrow = SB.rrow = 0;
        auto geom = [&](int it, int& b, int& h, int& dir, int& c) { const int sq = it / NCH64; c = it - sq * NCH64; b = sq >> 3; h = (sq >> 1) & 3; dir = sq & 1; };
        auto load = [&](int it, Set& S) {
            int b, h, dir, c; geom(it, b, h, dir, c);
            int tl = tid; asm volatile("" : "+v"(tl));
#pragma unroll
            for (int s = 0; s < 4; ++s) {
                const int task = tl + NT * s, j = task >> 5, g = task & 31;
                const int row = scan_row(c * CL + j, b, dir, 0);
                S.rc[s] = g < 16 ? *(const u32x4*)(QK + (size_t)row * 512 + (g < 8 ? h * 64 + 8 * g : 256 + h * 64 + 8 * (g - 8))) : *(const u32x4*)(Pb + (size_t)row * LDP_EVEN + 1808 + h * 128 + 8 * (g - 16));
            }
#pragma unroll
            for (int s = 0; s < 2; ++s) S.rcb[s] = *(const u32x4*)(Cst + (size_t)it * 8192 + (tl + NT * s) * 8);
            if (tl < CL) {
                S.rrow = scan_row(c * CL + tl, b, dir, 0);
                const float* tp = Tst + (size_t)it * 192;
                S.rfc = tp[tl]; S.rg = tp[64 + tl]; S.rpm = tp[128 + tl]; S.rmp = Sst[(size_t)it * 4 + 2]; S.rn = Nst[(size_t)it * 64 + tl];
            }
        };
        auto item = [&](int it, Set& S, int nxt) {
            int b, h, dir, c; geom(it, b, h, dir, c);
            bf16_t* Y = (bf16_t*)(P.ws + (dir ? WS_YB : WS_YF));
            LAS float* sc = (LAS float*)(lds + X3M_SC);
            {
                int tl = tid; asm volatile("" : "+v"(tl));
#pragma unroll
                for (int s = 0; s < 4; ++s) {
                    const int task = tl + NT * s, j = task >> 5, g = task & 31;
                    if (g < 8) *(LAS u32x4*)(lds + X3M_QT + j * LDTB + 8 * g * 2) = S.rc[s];
                    else if (g < 16) *(LAS u32x4*)(lds + X3M_KT + j * LDTB + 8 * (g - 8) * 2) = S.rc[s];
                    else {
                        const int v0 = 8 * (g - 16);
#pragma unroll
                        for (int e = 0; e < 1; ++e) *(LAS u32x4*)(lds + X3M_VT + j * LDV + v0 * 2) = S.rc[s];
                    }
                }
#pragma unroll
                for (int s = 0; s < 2; ++s) { const int ch = tl + NT * s; *(LAS u32x4*)(lds + X3M_CB + (ch >> 3) * LDTB + (ch & 7) * 16) = S.rcb[s]; }
                if (tl < CL) {
                    const float linter = S.rfc + S.rmp, mrow = fmaxf(S.rfc + S.rpm, linter);
                    sc[tl] = S.rfc - mrow; sc[64 + tl] = S.rg; sc[128 + tl] = __expf(linter - mrow); sc[192 + tl] = __expf(-mrow); ((LAS int*)sc)[256 + tl] = S.rrow;
                    const bf16_t nb = f2bf(S.rn);
#pragma unroll
                    for (int r = 0; r < 16; ++r) *(LAS bf16_t*)(lds + X3M_NB + r * LDTB + tl * 2) = nb;
                }
            }
            if (nxt < NML_ITEMS) load(nxt, S);
            __syncthreads();
            {
                const int lt = wid >> 1;
#pragma unroll
                for (int u = 0; u < 2; ++u) {
                    const int st = (wid & 1) * 2 + u;
                    f32x4 acc = (f32x4){0.f, 0.f, 0.f, 0.f};
                    if (st <= lt) {
#pragma unroll
                        for (int k0 = 0; k0 < 64; k0 += 32) acc = __builtin_amdgcn_mfma_f32_16x16x32_bf16(ldfrag(lds + X3M_KT, LDTB, st * 16, k0, lane), ldfrag(lds + X3M_QT, LDTB, lt * 16, k0, lane), acc, 0, 0, 0);
                        const int l = lt * 16 + r16, s0 = st * 16 + 4 * q;
                        const float rt = sc[l]; const f32x4 gs = *(const LAS f32x4*)(sc + 64 + s0);
#pragma unroll
                        for (int j = 0; j < 4; ++j) acc[j] = (s0 + j <= l) ? acc[j] * __expf(rt + gs[j]) : 0.f;
                    }
                    st4bf(lds + X3M_W + (lt * 16 + r16) * LDTB + (st * 16 + 4 * q) * 2, acc);
                }
            }
            __syncthreads();
            {
                const int lt = wid >> 1, l = lt * 16 + r16;
                const bf16x8 wf0 = ldfrag(lds + X3M_W, LDTB, lt * 16, 0, lane), wf1 = ldfrag(lds + X3M_W, LDTB, lt * 16, 32, lane);
                const bf16x8 qf0 = ldfrag(lds + X3M_QT, LDTB, lt * 16, 0, lane), qf1 = ldfrag(lds + X3M_QT, LDTB, lt * 16, 32, lane);
                f32x4 da = __builtin_amdgcn_mfma_f32_16x16x32_bf16(ldfrag(lds + X3M_ONE, LDTB, 0, 0, lane), wf0, (f32x4){0.f, 0.f, 0.f, 0.f}, 0, 0, 0);
                da = __builtin_amdgcn_mfma_f32_16x16x32_bf16(ldfrag(lds + X3M_ONE, LDTB, 0, 32, lane), wf1, da, 0, 0, 0);
                f32x4 qn = __builtin_amdgcn_mfma_f32_16x16x32_bf16(ldfrag(lds + X3M_NB, LDTB, 0, 0, lane), qf0, (f32x4){0.f, 0.f, 0.f, 0.f}, 0, 0, 0);
                qn = __builtin_amdgcn_mfma_f32_16x16x32_bf16(ldfrag(lds + X3M_NB, LDTB, 0, 32, lane), qf1, qn, 0, 0, 0);
                const float inter = sc[128 + l], emr = sc[192 + l];
                const float inv = __builtin_amdgcn_rcpf(fmaxf(fabsf(da[0] + inter * qn[0]), emr));
                const int row = ((const LAS int*)sc)[256 + l];
#pragma unroll
                for (int u = 0; u < 4; ++u) {
                    const int vt = (wid & 1) * 4 + u;
                    f32x4 na = __builtin_amdgcn_mfma_f32_16x16x32_bf16(ldfrag_tr(lds + X3M_VT, LDV, vt * 16, 0, lane), wf0, (f32x4){0.f, 0.f, 0.f, 0.f}, 0, 0, 0);
                    na = __builtin_amdgcn_mfma_f32_16x16x32_bf16(ldfrag_tr(lds + X3M_VT, LDV, vt * 16, 32, lane), wf1, na, 0, 0, 0);
                    f32x4 ca = __builtin_amdgcn_mfma_f32_16x16x32_bf16(ldfrag(lds + X3M_CB, LDTB, vt * 16, 0, lane), qf0, (f32x4){0.f, 0.f, 0.f, 0.f}, 0, 0, 0);
                    ca = __builtin_amdgcn_mfma_f32_16x16x32_bf16(ldfrag(lds + X3M_CB, LDTB, vt * 16, 32, lane), qf1, ca, 0, 0, 0);
                    u32x2 o; o.x = pk2((na[0] + inter * ca[0]) * inv, (na[1] + inter * ca[1]) * inv); o.y = pk2((na[2] + inter * ca[2]) * inv, (na[3] + inter * ca[3]) * inv);
                    *(u32x2*)(Y + (size_t)row * D + 512 + h * 128 + vt * 16 + 4 * q) = o;
                }
            }
            __syncthreads();
        };
        {
            const int G = gridDim.x; int it = blockIdx.x;
            if (it < NML_ITEMS) load(it, SA);
            if (it + G < NML_ITEMS) load(it + G, SB);
            __syncthreads();
            for (; it < NML_ITEMS; it += 2 * G) {
                item(it, SA, it + 2 * G);
                if (it + G < NML_ITEMS) item(it + G, SB, it + 3 * G);
            }
        }
    }
}

constexpr int HC_RAWF = 0;
constexpr int HC_RAWQ = HC_RAWF + 64 * 128 * 4;
constexpr int HC_SUB = HC_RAWQ + 64 * 128 * 2;
constexpr int HL_QD = 136 * 2;
constexpr int HL_T = 24 * 2;
constexpr int HS_QI = 0, HS_KO = HS_QI + 16 * HL_QD, HS_KET = HS_KO + 16 * HL_QD, HS_ATT = HS_KET + 128 * HL_T, HS_VT = HS_ATT + 16 * HL_T, HS_DEC = HS_VT + 32 * HL_T, HS_SIZE = HS_DEC + 512;
constexpr int HC_SB = HC_SUB + 4 * HS_SIZE;
constexpr int HC_ROWS = HC_SB + 2 * 32 * HL_QD, HC_CST = HC_ROWS + 256, HC_END = HC_CST + 1024;
static_assert(HC_END <= LDS_BYTES - 16, "HGRN2 LDS map");
static_assert(HS_SIZE % 16 == 0 && HC_SB % 16 == 0, "alignment");
__device__ __forceinline__ bf16x8 ldfrag16(const LAS char* tile, int ldb, int row0, int lane) {
    bf16x8 v = *(const LAS bf16x8*)(tile + (row0 + (lane & 15)) * ldb + ((lane >> 4) & 1) * 16);
    if (lane >= 32) v = (bf16x8){0, 0, 0, 0, 0, 0, 0, 0};
    return v;
}
__device__ __forceinline__ void scan_hgrn_c(int wv, KP Pk, int layer, int unit, LAS char* lds) {
    asm volatile("" : "+s"(Pk));
    const CAS Params& P = *Pk;
    const int tid = ltid(wv), lane = tid & 63, wid = tid >> 6, q = lane >> 4, r16 = lane & 15, i_ = layer >> 1;
    const int seq = unit >> 2, quarter = unit & 3, b = seq >> 3, h = (seq >> 1) & 3, dir = seq & 1;
    const bf16_t* Pb = (const bf16_t*)(P.ws + WS_P);
    bf16_t* Y = (bf16_t*)(P.ws + (dir ? WS_YB : WS_YF));
    LAS float* cst = (LAS float*)(lds + HC_CST);
    if (tid < 128) cst[tid] = ((const float*)(P.ws + WS_LB))[layer * 512 + h * 128 + tid];
    else if (tid < 256) cst[tid] = P.hg_f_bias[(size_t)(i_ * 2 + dir) * 512 + h * 128 + tid - 128];
    for (int i = tid; i < 2 * 32 * HL_QD / 4; i += NT) ((LAS unsigned*)(lds + HC_SB))[i] = 0u;
    int tj[5], tg_[5], tcol[5]; bool tv[5];
#pragma unroll
    for (int s = 0; s < 5; ++s) {
        const int task = tid + NT * s; tv[s] = task < 64 * 36; tj[s] = task / 36; tg_[s] = task % 36;
        const int g = tg_[s];
        tcol[s] = g < 16 ? (512 + dir * 512 + h * 128 + 8 * g) : g < 32 ? (h * 128 + 8 * (g - 16)) : (1536 + h * 128 + quarter * 32 + 8 * (g - 32));
    }
    u32x4 rc[5]; int rrow = 0;
    auto load = [&](int c) {
#pragma unroll
        for (int s = 0; s < 5; ++s) {
            rc[s] = (u32x4){0u, 0u, 0u, 0u};
            if (tv[s]) { const int row = scan_row(c * 64 + tj[s], b, dir, 1); rc[s] = *(const u32x4*)(Pb + (size_t)row * LDP_ODD + tcol[s]); }
        }
        if (tid < 64) rrow = scan_row(c * 64 + tid, b, dir, 1);
    };
    auto storeA = [&]() {
#pragma unroll
        for (int s = 0; s < 5; ++s) {
            if (tv[s]) {
                float f[8]; unpack8(rc[s], f);
                const int j = tj[s], g = tg_[s];
                if (g < 16) {
                    float o[8];
#pragma unroll
                    for (int e = 0; e < 8; ++e) { const float lbv = cst[8 * g + e]; o[e] = lbv + (1.f - lbv) * sigmoidf_(f[e] + cst[128 + 8 * g + e]); }
                    LAS float* dst = (LAS float*)(lds + HC_RAWF) + j * 128 + 8 * g;
                    *(LAS f32x4*)dst = (f32x4){o[0], o[1], o[2], o[3]}; *(LAS f32x4*)(dst + 4) = (f32x4){o[4], o[5], o[6], o[7]};
                } else if (g < 32) {
                    float o[8];
#pragma unroll
                    for (int e = 0; e < 8; ++e) o[e] = siluf_(f[e]);
                    *(LAS u32x4*)(lds + HC_RAWQ + (j * 128 + 8 * (g - 16)) * 2) = pack8(o);
                } else {
                    const int v0 = 8 * (g - 32);
                    LAS char* vt = lds + HC_SUB + (j >> 4) * HS_SIZE + HS_VT;
#pragma unroll
                    for (int e = 0; e < 8; ++e) { const unsigned wv = rc[s][e >> 1]; *(LAS bf16_t*)(vt + (v0 + e) * HL_T + (j & 15) * 2) = (bf16_t)((e & 1) ? (wv >> 16) : (wv & 0xffffu)); }
                }
            }
        }
        if (tid < 64) ((LAS int*)(lds + HC_ROWS))[tid] = rrow;
    };
    auto storeB = [&]() {
        const int d = tid & 127, sb = tid >> 7;
        LAS char* st = lds + HC_SUB + sb * HS_SIZE;
        const LAS float* rf = (const LAS float*)(lds + HC_RAWF) + (sb * 16) * 128 + d;
        const LAS bf16_t* rq = (const LAS bf16_t*)(lds + HC_RAWQ) + (sb * 16) * 128 + d;
        float E = 1.f, einv[16], kfs[16];
#pragma unroll
        for (int t = 0; t < 16; ++t) {
            const float f = rf[t * 128];
            E *= f;
            const float kf = 1.f - f, ei = __builtin_amdgcn_rcpf(E);
            einv[t] = ei; kfs[t] = kf;
            *(LAS bf16_t*)(st + HS_QI + t * HL_QD + d * 2) = f2bf(bf2f(rq[t * 128]) * E);
            *(LAS bf16_t*)(st + HS_KO + t * HL_QD + d * 2) = f2bf(kf * ei);
        }
        float ke[16];
#pragma unroll
        for (int t = 0; t < 16; ++t) ke[t] = kfs[t] * (E * einv[t]);
        *(LAS u32x4*)(st + HS_KET + d * HL_T) = pack8(ke); *(LAS u32x4*)(st + HS_KET + d * HL_T + 16) = pack8(ke + 8);
        ((LAS float*)(st + HS_DEC))[d] = E;
    };
    f32x4 sacc[2];
    sacc[0] = sacc[1] = (f32x4){0.f, 0.f, 0.f, 0.f};
    __syncthreads();
    load(0);
    for (int c = 0; c < NSTEPS / 64; ++c) {
        storeA();
        __syncthreads();
        storeB();
        if (c + 1 < NSTEPS / 64) load(c + 1);
        __syncthreads();
        if (wid < 4) {
            LAS char* st = lds + HC_SUB + wid * HS_SIZE;
            f32x4 acc = (f32x4){0.f, 0.f, 0.f, 0.f};
#pragma unroll
            for (int k0 = 0; k0 < 128; k0 += 32) acc = __builtin_amdgcn_mfma_f32_16x16x32_bf16(ldfrag(st + HS_KO, HL_QD, 0, k0, lane), ldfrag(st + HS_QI, HL_QD, 0, k0, lane), acc, 0, 0, 0);
#pragma unroll
            for (int j = 0; j < 4; ++j) acc[j] = (4 * q + j <= r16) ? acc[j] : 0.f;
            st4bf(st + HS_ATT + r16 * HL_T + 4 * q * 2, acc);
        }
        __syncthreads();
#pragma unroll 1
        for (int sb = 0; sb < 4; ++sb) {
            LAS char* st = lds + HC_SUB + sb * HS_SIZE;
            const LAS char* sbr = lds + HC_SB + (sb & 1) * 32 * HL_QD;
            LAS char* sbw = lds + HC_SB + ((sb + 1) & 1) * 32 * HL_QD;
            if (wid < 2) {
                f32x4 ya = __builtin_amdgcn_mfma_f32_16x16x32_bf16(ldfrag16(st + HS_VT, HL_T, wid * 16, lane), ldfrag16(st + HS_ATT, HL_T, 0, lane), (f32x4){0.f, 0.f, 0.f, 0.f}, 0, 0, 0);
#pragma unroll
                for (int k0 = 0; k0 < 128; k0 += 32) ya = __builtin_amdgcn_mfma_f32_16x16x32_bf16(ldfrag(sbr, HL_QD, wid * 16, k0, lane), ldfrag(st + HS_QI, HL_QD, 0, k0, lane), ya, 0, 0, 0);
                const int row = ((const LAS int*)(lds + HC_ROWS))[sb * 16 + r16];
                u32x2 o; o.x = pk2(ya[0], ya[1]); o.y = pk2(ya[2], ya[3]);
                *(u32x2*)(Y + (size_t)row * D + h * 128 + quarter * 32 + wid * 16 + 4 * q) = o;
            }
            {
                const int vt = wid >> 2;
                const bf16x8 vf = ldfrag16(st + HS_VT, HL_T, vt * 16, lane);
#pragma unroll
                for (int u = 0; u < 2; ++u) {
                    const int dt = (wid & 3) * 2 + u;
                    const f32x4 a = __builtin_amdgcn_mfma_f32_16x16x32_bf16(ldfrag16(st + HS_KET, HL_T, dt * 16, lane), vf, (f32x4){0.f, 0.f, 0.f, 0.f}, 0, 0, 0);
                    const f32x4 dc = *(const LAS f32x4*)((const LAS float*)(st + HS_DEC) + dt * 16 + 4 * q);
#pragma unroll
                    for (int j = 0; j < 4; ++j) sacc[u][j] = sacc[u][j] * dc[j] + a[j];
                    st4bf(sbw + (vt * 16 + r16) * HL_QD + (dt * 16 + 4 * q) * 2, sacc[u]);
                }
            }
            __syncthreads();
        }
    }
}

constexpr int RC_RAWW = 0;
constexpr int RC_RAWA = RC_RAWW + 64 * 64 * 4;
constexpr int RC_RAWB = RC_RAWA + 64 * 64 * 2, RC_RAWK = RC_RAWB + 64 * 64 * 2, RC_RAWR = RC_RAWK + 64 * 64 * 2;
constexpr int RC_SUB = RC_RAWR + 64 * 64 * 2;
constexpr int RL_C = 72 * 2, RL_32 = 40 * 2, RL_16 = 24 * 2;
constexpr int RS_AT = 0, RS_RT = RS_AT + 16 * RL_C, RS_KT = RS_RT + 16 * RL_C, RS_BT = RS_KT + 16 * RL_C, RS_KBH = RS_BT + 16 * RL_C, RS_AAK = RS_KBH + 64 * RL_32,
              RS_ARKB = RS_AAK + 16 * RL_16, RS_T = RS_ARKB + 16 * RL_32, RS_AABF = RS_T + 16 * RL_16, RS_GL = RS_AABF + 16 * 16 * 4, RS_VU = RS_GL + 256, RS_SIZE = RS_VU + 32 * RL_32;
constexpr int RC_SB = RC_SUB + 4 * RS_SIZE;
constexpr int RC_RHT = RC_SB + 32 * RL_C;
constexpr int RC_ROWS = RC_RHT + 32 * RL_16, RC_END = RC_ROWS + 256;
static_assert(RC_END <= LDS_BYTES - 16, "RWKV LDS map");
static_assert(RS_SIZE % 16 == 0 && RC_SB % 16 == 0 && RC_RHT % 16 == 0, "alignment");


__device__ __forceinline__ void phase_prep1(int wv, KP Pk, int layer) {
    asm volatile("" : "+s"(Pk));
    const CAS Params& P = *Pk;
    const int tid = ltid(wv), lane = tid & 63, wid = tid >> 6, i_ = layer >> 1;
    const bf16_t* Pb = (const bf16_t*)(P.ws + WS_P);
    bf16_t* R = (bf16_t*)(P.ws + WS_RWR); bf16_t* K = (bf16_t*)(P.ws + WS_RWK); bf16_t* V = (bf16_t*)(P.ws + WS_RWV); bf16_t* KK = (bf16_t*)(P.ws + WS_RWKK);
    bf16_t* LA = (bf16_t*)(P.ws + WS_LA);
    const float* mu = P.rw_mu + (size_t)i_ * 1856;
    float mur[8], muv[8], muk[8], mul_[8], kkw[8];
#pragma unroll
    for (int e = 0; e < 8; ++e) { mur[e] = mu[8 * lane + e]; muv[e] = mu[1024 + 8 * lane + e]; muk[e] = mu[512 + 8 * lane + e]; mul_[e] = lane < 40 ? mu[1536 + 8 * lane + e] : 0.f; kkw[e] = P.rw_k_k[i_ * 512 + 8 * lane + e]; }
    u32x4 nq[4][3]; float nmp = 0.f, nmn = 0.f;
    auto fetch = [&](int r) {
        int rprev = -1, rnext = -1;
        if (r < NCTX) { const int t = r & 255; if (t > 0) rprev = r - 1; if (t < CTXL - 1) rnext = r + 1; }
        else {
            const int bs = (r - NCTX) >> 13, s = (r - NCTX) & 8191, sg = ((s & 63) << 7) + (s >> 6);
            if (sg > 0) { const int g2 = sg - 1; rprev = NCTX + bs * SEQ + ((g2 & 127) << 6) + (g2 >> 7); }
            if (sg < SEQ - 1) { const int g2 = sg + 1; rnext = NCTX + bs * SEQ + ((g2 & 127) << 6) + (g2 >> 7); }
        }
        const bf16_t* pc = Pb + (size_t)r * LDP_ODD + 2560;
        const bf16_t* pp = Pb + (size_t)(rprev < 0 ? r : rprev) * LDP_ODD + 2560;
        const bf16_t* pn = Pb + (size_t)(rnext < 0 ? r : rnext) * LDP_ODD + 2560;
        nmp = rprev < 0 ? 0.f : 0.5f; nmn = rnext < 0 ? 0.f : 0.5f;
#pragma unroll
        for (int gq = 0; gq < 4; ++gq) {
            const int col = (gq == 0 ? 0 : gq == 1 ? 1024 : gq == 2 ? 512 : 1536) + 8 * lane;
            if (gq < 3 || lane < 40) { nq[gq][0] = *(const u32x4*)(pc + col); nq[gq][1] = *(const u32x4*)(pp + col); nq[gq][2] = *(const u32x4*)(pn + col); }
        }
    };
    nq[3][0] = nq[3][1] = nq[3][2] = (u32x4){0u, 0u, 0u, 0u};
    const int stride = gridDim.x * 8;
    int r = blockIdx.x * 8 + wid;
    if (r < NROWS) fetch(r);
    for (; r < NROWS; r += stride) {
        u32x4 cq[4][3];
#pragma unroll
        for (int gq = 0; gq < 4; ++gq)
#pragma unroll
            for (int k = 0; k < 3; ++k) cq[gq][k] = nq[gq][k];
        const float mp = nmp, mn = nmn;
        if (r + stride < NROWS) fetch(r + stride);
        auto mix8 = [&](const u32x4 (&c)[3], const float* muc, float* o) {
            float fc[8], fp[8], fn[8];
            unpack8(c[0], fc); unpack8(c[1], fp); unpack8(c[2], fn);
#pragma unroll
            for (int e = 0; e < 8; ++e) o[e] = fc[e] + muc[e] * (mp * fp[e] + mn * fn[e] - fc[e]);
        };
        float o[8];
        mix8(cq[0], mur, o); *(u32x4*)(R + (size_t)r * 512 + 8 * lane) = pack8(o);
        mix8(cq[1], muv, o); *(u32x4*)(V + (size_t)r * 512 + 8 * lane) = pack8(o);
        mix8(cq[2], muk, o); *(u32x4*)(K + (size_t)r * 512 + 8 * lane) = pack8(o);
        {
            float kk[8], ss = 0.f;
#pragma unroll
            for (int e = 0; e < 8; ++e) { kk[e] = o[e] * kkw[e]; ss += kk[e] * kk[e]; }
            ss = group_sum<8>(ss);
            const float rn = rsqrtf(fmaxf(ss, 1e-12f));
#pragma unroll
            for (int e = 0; e < 8; ++e) kk[e] *= rn;
            *(u32x4*)(KK + (size_t)r * 512 + 8 * lane) = pack8(kk);
        }
        if (lane < 40) {
            mix8(cq[3], mul_, o);
            if (lane < 16) {
#pragma unroll
                for (int e = 0; e < 8; ++e) o[e] = tanh_fast(o[e]);
            } else if (lane >= 24) {
#pragma unroll
                for (int e = 0; e < 8; ++e) o[e] = sigmoidf_(o[e]);
            }
            *(u32x4*)(LA + (size_t)r * 320 + 8 * lane) = pack8(o);
        }
    }
}

__device__ __forceinline__ void phase_out_even(int wv, KP Pk, int layer) {
    asm volatile("" : "+s"(Pk));
    const CAS Params& P = *Pk;
    const int tid = ltid(wv), lane = tid & 63, wid = tid >> 6, i_ = layer >> 1;
    const bf16_t* Pb = (const bf16_t*)(P.ws + WS_P);
    const bf16_t* Yf = (const bf16_t*)(P.ws + WS_YF); const bf16_t* Yb = (const bf16_t*)(P.ws + WS_YB);
    bf16_t* feat = (bf16_t*)(P.ws + WS_FEAT);
    const int r0 = (layer == DEPTH - 1) ? NCTX : 0;
    const bf16_t* XBC = (const bf16_t*)(P.ws + WS_EXBC);
    float nwa[8], nwb[8];
#pragma unroll
    for (int e = 0; e < 8; ++e) { nwa[e] = P.ssd_norm_w[i_ * 512 + 8 * lane + e]; nwb[e] = P.ml_norm_w[i_ * 512 + 8 * lane + e]; }
    const float dsk = P.ssd_d[i_ * 8 + (lane >> 3)];
    u32x4 n0, n1, n2, n3, n4, n5, n6;
    auto fetch = [&](int rr) {
        const bf16_t* pr = Pb + (size_t)rr * LDP_EVEN;
        n0 = *(const u32x4*)(Yf + (size_t)rr * D + 8 * lane); n1 = *(const u32x4*)(Yb + (size_t)rr * D + 8 * lane);
        n2 = *(const u32x4*)(XBC + (size_t)rr * 768 + 8 * lane); n3 = *(const u32x4*)(pr + 8 * lane);
        n4 = *(const u32x4*)(Yf + (size_t)rr * D + 512 + 8 * lane); n5 = *(const u32x4*)(Yb + (size_t)rr * D + 512 + 8 * lane); n6 = *(const u32x4*)(pr + 2320 + 8 * lane);
    };
    const int stride = gridDim.x * 8;
    int r = r0 + blockIdx.x * 8 + wid;
    if (r < NROWS) fetch(r);
    for (; r < NROWS; r += stride) {
        const u32x4 c0 = n0, c1 = n1, c2 = n2, c3 = n3, c4 = n4, c5 = n5, c6 = n6;
        if (r + stride < NROWS) fetch(r + stride);
        float y[8];
        {
            float a[8], bb[8], xsv[8], z[8];
            unpack8(c0, a); unpack8(c1, bb);
            unpack8(c2, xsv); unpack8(c3, z);
            float ss = 0.f;
#pragma unroll
            for (int e = 0; e < 8; ++e) {
                y[e] = (a[e] + bb[e] + dsk * xsv[e]) * siluf_(z[e]); ss += y[e] * y[e];
            }
            ss = wave_sum(ss);
            const float rn = rsqrtf(ss * (1.f / 512.f) + 1e-6f);
#pragma unroll
            for (int e = 0; e < 8; ++e) y[e] = y[e] * rn * nwa[e];
            *(u32x4*)(feat + (size_t)r * D + 8 * lane) = pack8(y);
        }
        {
            float a[8], bb[8], o[8];
            unpack8(c4, a); unpack8(c5, bb);
            unpack8(c6, o);
            float s = 0.f;
#pragma unroll
            for (int e = 0; e < 8; ++e) { y[e] = a[e] + bb[e]; s += y[e]; }
            const float mean = group_sum<16>(s) * (1.f / 128.f);
            float ss = 0.f;
#pragma unroll
            for (int e = 0; e < 8; ++e) { y[e] -= mean; ss += y[e] * y[e]; }
            const float rn = rsqrtf(group_sum<16>(ss) * (1.f / 128.f) + 1e-6f);
#pragma unroll
            for (int e = 0; e < 8; ++e) y[e] = sigmoidf_(o[e]) * (y[e] * rn) * nwb[e];
            *(u32x4*)(feat + (size_t)r * D + 512 + 8 * lane) = pack8(y);
        }
    }
}
__device__ __forceinline__ void phase_out_odd(int wv, KP Pk, int layer) {
    asm volatile("" : "+s"(Pk));
    const CAS Params& P = *Pk;
    const int tid = ltid(wv), lane = tid & 63, wid = tid >> 6, i_ = layer >> 1;
    const bf16_t* Pb = (const bf16_t*)(P.ws + WS_P);
    const bf16_t* Yf = (const bf16_t*)(P.ws + WS_YF); const bf16_t* Yb = (const bf16_t*)(P.ws + WS_YB);
    const bf16_t* R = (const bf16_t*)(P.ws + WS_RWR); const bf16_t* K = (const bf16_t*)(P.ws + WS_RWK); const bf16_t* V = (const bf16_t*)(P.ws + WS_RWV); const bf16_t* G = (const bf16_t*)(P.ws + WS_RWG);
    bf16_t* feat = (bf16_t*)(P.ws + WS_FEAT);
    const int r0 = (layer == DEPTH - 1) ? NCTX : 0;
    float nwc[8], rk[8], lw[8], lbv[8];
#pragma unroll
    for (int e = 0; e < 8; ++e) {
        nwc[e] = P.hg_norm_w[i_ * 512 + 8 * lane + e]; rk[e] = P.rw_r_k[i_ * 512 + 8 * lane + e];
        lw[e] = P.rw_ln_w[i_ * 512 + 8 * lane + e]; lbv[e] = P.rw_ln_b[i_ * 512 + 8 * lane + e];
    }
    u32x4 n0, n1, n2, n3, n4, n5, n6, n7, n8;
    auto fetch = [&](int rr) {
        n0 = *(const u32x4*)(Yf + (size_t)rr * D + 8 * lane); n1 = *(const u32x4*)(Yb + (size_t)rr * D + 8 * lane); n2 = *(const u32x4*)(Pb + (size_t)rr * LDP_ODD + 2048 + 8 * lane);
        n3 = *(const u32x4*)(Yf + (size_t)rr * D + 512 + 8 * lane); n4 = *(const u32x4*)(Yb + (size_t)rr * D + 512 + 8 * lane);
        n5 = *(const u32x4*)(R + (size_t)rr * 512 + 8 * lane); n6 = *(const u32x4*)(K + (size_t)rr * 512 + 8 * lane);
        n7 = *(const u32x4*)(V + (size_t)rr * 512 + 8 * lane); n8 = *(const u32x4*)(G + (size_t)rr * 512 + 8 * lane);
    };
    const int stride = gridDim.x * 8;
    int r = r0 + blockIdx.x * 8 + wid;
    if (r < NROWS) fetch(r);
    for (; r < NROWS; r += stride) {
        const u32x4 c0 = n0, c1 = n1, c2 = n2, c3 = n3, c4 = n4, c5 = n5, c6 = n6, c7 = n7, c8 = n8;
        if (r + stride < NROWS) fetch(r + stride);
        float y[8];
        {
            float a[8], bb[8], g[8];
            unpack8(c0, a); unpack8(c1, bb);
            unpack8(c2, g);
            float ss = 0.f;
#pragma unroll
            for (int e = 0; e < 8; ++e) { y[e] = a[e] + bb[e]; ss += y[e] * y[e]; }
            const float rn = rsqrtf(group_sum<16>(ss) * (1.f / 128.f) + 1e-6f);
#pragma unroll
            for (int e = 0; e < 8; ++e) y[e] = y[e] * rn * nwc[e] * siluf_(g[e]);
            *(u32x4*)(feat + (size_t)r * D + 8 * lane) = pack8(y);
        }
        {
            float a[8], bb[8], rr[8], kk[8], vv[8], g[8];
            unpack8(c3, a); unpack8(c4, bb);
            unpack8(c5, rr); unpack8(c6, kk);
            unpack8(c7, vv); unpack8(c8, g);
            float s = 0.f, bs = 0.f;
#pragma unroll
            for (int e = 0; e < 8; ++e) { y[e] = a[e] + bb[e]; s += y[e]; bs += rr[e] * kk[e] * rk[e]; }
            const float mean = group_sum<8>(s) * (1.f / 64.f); bs = group_sum<8>(bs);
            float ss = 0.f;
#pragma unroll
            for (int e = 0; e < 8; ++e) { y[e] -= mean; ss += y[e] * y[e]; }
            const float rn = rsqrtf(group_sum<8>(ss) * (1.f / 64.f) + 64e-5f);
#pragma unroll
            for (int e = 0; e < 8; ++e) y[e] = (y[e] * rn * lw[e] + lbv[e] + bs * vv[e]) * g[e];
            *(u32x4*)(feat + (size_t)r * D + 512 + 8 * lane) = pack8(y);
        }
    }
}

#ifndef MK_DOUBLE
#define MK_DOUBLE 0
#endif
#define REP(bit, body) do { body; if (MK_DOUBLE & (bit)) { body; } } while (0)
__device__ __forceinline__ void phase_expconv(int wv, KP Pk, int layer, LAS char* lds) {
    asm volatile("" : "+s"(Pk));
    const CAS Params& P = *Pk;
    const int tid = ltid(wv);
    if (layer & 1) return;
    expconv_items(P, layer, lds, exc_s0(layer) + exc_s1(layer), EXC_ITEMS, (int)blockIdx.x * 8 + (tid >> 6), (int)gridDim.x * 8, tid >> 6, tid & 63);
}
__device__ __forceinline__ void expconv_after_scan(int wv, KP Pk, int layer, LAS char* lds) {
    asm volatile("" : "+s"(Pk));
    const CAS Params& P = *Pk;
    const int tid = ltid(wv);
    __syncthreads();
    expconv_items(P, layer, lds, exc_s0(layer) + exc_s1(layer), EXC_ITEMS, (int)blockIdx.x * 8 + (tid >> 6), 128 * 8, tid >> 6, tid & 63);
}
constexpr int L1_AST = 1028;
constexpr int L1_PST = 33;
constexpr int L1_A = 0, L1_PART = L1_A + 16 * L1_AST * 4, L1_SM = L1_PART + 8 * 16 * L1_PST * 4, L1_END = L1_SM + (64 + 2 * 144 + 32) * 4;
static_assert(L1_END <= LDS_BYTES - 16, "LN1 LDS map");
__device__ __forceinline__ void phase_ln1(int wv, KP Pk, int layer, LAS char* lds, bool dry = false) {
    asm volatile("" : "+s"(Pk));
    const CAS Params& P = *Pk;
    const int tid = ltid(wv), lane = tid & 63;
    if (!dry) REP(8, phase_expconv(wv, Pk, layer, lds));
    __syncthreads();
    LAS float* At = (LAS float*)(lds + L1_A);
    LAS float* part = (LAS float*)(lds + L1_PART);
    LAS int* lcnt = (LAS int*)(lds + L1_SM);
    LAS int* lbase = lcnt + 32;
    LAS int* asg = lcnt + 64;
    LAS float* rbias = (LAS float*)(asg + 2 * 144);
    if (tid < 32) { lcnt[tid] = 0; rbias[tid] = P.router_bias[tid]; }
    float breg[8][4][2];
    {
        const float* rw = P.router_w + (size_t)(128 * wv + 4 * (lane >> 4)) * NEXP + (lane & 15);
#pragma unroll
        for (int j = 0; j < 8; ++j)
#pragma unroll
            for (int i = 0; i < 4; ++i) { breg[j][i][0] = rw[(16 * j + i) * NEXP]; breg[j][i][1] = rw[(16 * j + i) * NEXP + 16]; }
    }
    __syncthreads();
    const bf16_t* yo = (const bf16_t*)(P.ws + WS_YO);
    bf16_t* act = (bf16_t*)(P.ws + (dry ? WS_FEAT : WS_ACT));
    bf16_t* xcb = (bf16_t*)(P.ws + WS_XC); bf16_t* xob = (bf16_t*)P.out;
    const bool lastl = (layer == DEPTH - 1);
    int* cnt = (int*)(P.ws + WS_CNT) + layer * 32 * CNT_STRIDE;
    int* list = (int*)(P.ws + WS_LIST);
    float* wts = (float*)(P.ws + WS_WTS);
    const float* lg = P.ln_g + (size_t)(layer * 2 + 0) * D; const float* lb = P.ln_b + (size_t)(layer * 2 + 0) * D;
    const int r0 = (layer == DEPTH - 1) ? NCTX : 0, ntiles = (NROWS - r0) / 16, G = gridDim.x;
    f32x4 g1v[4], s2c[4], h2c[4];
#pragma unroll
    for (int i = 0; i < 4; ++i) g1v[i] = s2c[i] = h2c[i] = (f32x4){0.f, 0.f, 0.f, 0.f};
    int mcur = -1;
    f32x4 nx[2][4]; u32x2 nyo[2][4];
    auto fetch = [&](int s, int rr) {
        if (layer == 0) {
            const float* xq = rr < NCTX ? P.ctx + (size_t)rr * D : P.x + (size_t)(rr - NCTX) * D;
#pragma unroll
            for (int i = 0; i < 4; ++i) nx[s][i] = *(const f32x4*)(xq + 4 * lane + 256 * i);
        } else {
            const bf16_t* xq = rr < NCTX ? xcb + (size_t)rr * D : xob + (size_t)(rr - NCTX) * D;
#pragma unroll
            for (int i = 0; i < 4; ++i) { const u32x2 t = *(const u32x2*)(xq + 4 * lane + 256 * i); nx[s][i] = (f32x4){__uint_as_float(t.x), __uint_as_float(t.y), 0.f, 0.f}; }
        }
#pragma unroll
        for (int i = 0; i < 4; ++i) { const int c = 4 * lane + 256 * i; nyo[s][i] = *(const u32x2*)(yo + (size_t)rr * D + c); }
    };
    int tile = blockIdx.x;
    if (tile < ntiles) { fetch(0, r0 + tile * 16 + 2 * wv); fetch(1, r0 + tile * 16 + 2 * wv + 1); }
    for (int it = 0; tile < ntiles; ++it, tile += G) {
        const int rb = r0 + tile * 16 + 2 * wv;
        const int m = row_mod(rb);
        if (m != mcur) {
            mcur = m;
            const float* g1 = modvec(P.ws, layer, m, 2); const float* sh2 = modvec(P.ws, layer, m, 3); const float* sc2 = modvec(P.ws, layer, m, 4);
#pragma unroll
            for (int i = 0; i < 4; ++i) { const int c = 4 * lane + 256 * i; g1v[i] = *(const f32x4*)(g1 + c); s2c[i] = *(const f32x4*)(sc2 + c); h2c[i] = *(const f32x4*)(sh2 + c); }
        }
#pragma unroll
        for (int s = 0; s < 2; ++s) {
            const int r = rb + s;
            bf16_t* xr = dry ? (bf16_t*)(P.ws + WS_YF) + (size_t)r * D : lastl ? (bf16_t*)(P.ws + WS_FEAT) + (size_t)r * D : r < NCTX ? xcb + (size_t)r * D : xob + (size_t)(r - NCTX) * D;
            f32x4 v[4]; float sm = 0.f;
#pragma unroll
            for (int i = 0; i < 4; ++i) {
                f32x4 xv = nx[s][i]; const f32x4 gv = g1v[i]; const u32x2 yv = nyo[s][i];
                if (layer != 0) { const unsigned b0 = __float_as_uint(xv[0]), b1 = __float_as_uint(xv[1]); xv = (f32x4){bflo(b0), bfhi(b0), bflo(b1), bfhi(b1)}; }
                v[i][0] = ALPHA * xv[0] + gv[0] * bflo(yv.x); v[i][1] = ALPHA * xv[1] + gv[1] * bfhi(yv.x);
                v[i][2] = ALPHA * xv[2] + gv[2] * bflo(yv.y); v[i][3] = ALPHA * xv[3] + gv[3] * bfhi(yv.y);
                sm += (v[i][0] + v[i][1]) + (v[i][2] + v[i][3]);
            }
            if (tile + G < ntiles) fetch(s, r + G * 16);
            const float mean = wave_sum(sm) * (1.f / D);
            float s2 = 0.f;
#pragma unroll
            for (int i = 0; i < 4; ++i) { v[i] = v[i] - mean; s2 += (v[i][0] * v[i][0] + v[i][1] * v[i][1]) + (v[i][2] * v[i][2] + v[i][3] * v[i][3]); }
            const float rstd = rsqrtf(wave_sum(s2) * (1.f / D) + 1e-5f);
            LAS float* arow = At + (2 * wv + s) * L1_AST;
#pragma unroll
            for (int i = 0; i < 4; ++i) {
                const int c = 4 * lane + 256 * i;
                const f32x4 gg = *(const f32x4*)(lg + c), bb = *(const f32x4*)(lb + c), s2v = s2c[i], h2v = h2c[i];
                f32x4 xn, hv;
#pragma unroll
                for (int j = 0; j < 4; ++j) { xn[j] = v[i][j] * rstd * gg[j] + bb[j]; hv[j] = xn[j] * (1.f + s2v[j]) + h2v[j]; }
                { u32x2 ox; ox.x = pk2(xn[0], xn[1]); ox.y = pk2(xn[2], xn[3]); *(u32x2*)(xr + c) = ox; }
                u32x2 o; o.x = pk2(hv[0], hv[1]); o.y = pk2(hv[2], hv[3]); *(u32x2*)(act + (size_t)r * D + c) = o;
                *(LAS f32x4*)(arow + c) = hv;
            }
        }
        __syncthreads();
        {
            f32x4 ra0 = (f32x4){0.f, 0.f, 0.f, 0.f}, ra1 = ra0;
            const LAS float* ap = At + (lane & 15) * L1_AST + 128 * wv + 4 * (lane >> 4);
#pragma unroll
            for (int j = 0; j < 8; ++j) {
                const f32x4 a4 = *(const LAS f32x4*)(ap + 16 * j);
#pragma unroll
                for (int i = 0; i < 4; ++i) {
                    ra0 = __builtin_amdgcn_mfma_f32_16x16x4f32(a4[i], breg[j][i][0], ra0, 0, 0, 0);
                    ra1 = __builtin_amdgcn_mfma_f32_16x16x4f32(a4[i], breg[j][i][1], ra1, 0, 0, 0);
                }
            }
            LAS float* pw = part + wv * 16 * L1_PST + (4 * (lane >> 4)) * L1_PST + (lane & 15);
#pragma unroll
            for (int j = 0; j < 4; ++j) { pw[j * L1_PST] = ra0[j]; pw[j * L1_PST + 16] = ra1[j]; }
        }
        __syncthreads();
        {
            const int half = lane >> 5, e = lane & 31;
            const LAS float* pp = part + (2 * wv + half) * L1_PST + e;
            float sc_ = 0.f;
#pragma unroll
            for (int k = 0; k < 8; ++k) sc_ += pp[k * 16 * L1_PST];
            const float sg = sigmoidf_(sc_), vb = sg + rbias[e];
            float bv[4], sv[4];
            bv[0] = dppmov<0x00>(vb); bv[1] = dppmov<0x55>(vb); bv[2] = dppmov<0xAA>(vb); bv[3] = dppmov<0xFF>(vb);
            sv[0] = dppmov<0x00>(sg); sv[1] = dppmov<0x55>(sg); sv[2] = dppmov<0xAA>(sg); sv[3] = dppmov<0xFF>(sg);
            float m1 = -1e30f, m2 = -1e30f;
#pragma unroll
            for (int k = 0; k < 4; ++k) { const float vsc = bv[k]; if (vsc > m1) { m2 = m1; m1 = vsc; } else if (vsc > m2) m2 = vsc; }
            float best = m1 + m2; int bg = e >> 2;
#pragma unroll
            for (int msk = 4; msk <= 16; msk <<= 1) {
                const float ob = __shfl_xor(best, msk); const int og = __shfl_xor(bg, msk);
                const bool take = (ob > best) || (ob == best && og < bg);
                best = take ? ob : best; bg = take ? og : bg;
            }
            int i1 = 0; float b1 = bv[0];
#pragma unroll
            for (int k = 1; k < 4; ++k) if (bv[k] > b1) { b1 = bv[k]; i1 = k; }
            int i2 = -1; float b2 = -1e30f;
#pragma unroll
            for (int k = 0; k < 4; ++k) if (k != i1 && bv[k] > b2) { b2 = bv[k]; i2 = k; }
            float s1 = sv[0], s2s = sv[0];
#pragma unroll
            for (int k = 1; k < 4; ++k) { if (i1 == k) s1 = sv[k]; if (i2 == k) s2s = sv[k]; }
            if (e == 4 * bg && !dry) {
                const int r = rb + half;
                const int e0 = bg * 4 + i1, e1 = bg * 4 + i2;
                const float inv = 1.f / (s1 + s2s);
                const int li = it * 16 + 2 * wv + half;
                const int p0 = __hip_atomic_fetch_add(&lcnt[e0], 1, __ATOMIC_RELAXED, __HIP_MEMORY_SCOPE_WORKGROUP);
                const int p1 = __hip_atomic_fetch_add(&lcnt[e1], 1, __ATOMIC_RELAXED, __HIP_MEMORY_SCOPE_WORKGROUP);
                asg[2 * li] = (e0 << 16) | p0; asg[2 * li + 1] = (e1 << 16) | p1;
                wts[2 * r] = s1 * inv; wts[2 * r + 1] = s2s * inv;
            }
        }
    }
    __syncthreads();
    if (dry) return;
    if (tid < 32) lbase[tid] = atomicAdd(&cnt[tid * CNT_STRIDE], lcnt[tid]);
    __syncthreads();
    for (int idx = tid; idx < 2 * 144; idx += NT) {
        const int li = idx >> 1, k = idx & 1, t = (li >> 4) * G + blockIdx.x;
        if (t < ntiles) { const int r = r0 + t * 16 + (li & 15); const int v = asg[idx], e = v >> 16, lp = v & 0xffff; list[(size_t)e * LISTCAP + lbase[e] + lp] = 2 * r + k; }
    }
}

__device__ __forceinline__ void phase_ln2(int wv, KP Pk, int layer, bool dry = false) {
    asm volatile("" : "+s"(Pk));
    const CAS Params& P = *Pk;
    const int tid = ltid(wv), lane = tid & 63, wid = tid >> 6;
    const bf16_t* yp = (const bf16_t*)(P.ws + WS_YP);
    const float* wts = (const float*)(P.ws + WS_WTS);
    bf16_t* act = (bf16_t*)(P.ws + (dry ? WS_FEAT : WS_ACT));
    bf16_t* xcb = (bf16_t*)(P.ws + WS_XC); bf16_t* xob = (bf16_t*)P.out;
    const float* lg = P.ln_g + (size_t)(layer * 2 + 1) * D; const float* lb = P.ln_b + (size_t)(layer * 2 + 1) * D;
    const bool last = (layer == DEPTH - 1);
    const int r0 = last ? NCTX : 0, stride = gridDim.x * 8;
    f32x4 cg[4], cb[4], g2v[4], s1v[4], h1v[4];
#pragma unroll
    for (int i = 0; i < 4; ++i) { cg[i] = *(const f32x4*)(lg + 4 * lane + 256 * i); cb[i] = *(const f32x4*)(lb + 4 * lane + 256 * i); g2v[i] = s1v[i] = h1v[i] = (f32x4){0.f, 0.f, 0.f, 0.f}; }
    int mcur = -1;
    u32x2 nx[4]; u32x2 ny0[4], ny1[4]; float nw0 = 0.f, nw1 = 0.f;
    auto fetch = [&](int r) {
        const bf16_t* xr = last ? (const bf16_t*)(P.ws + WS_FEAT) + (size_t)r * D : r < NCTX ? xcb + (size_t)r * D : xob + (size_t)(r - NCTX) * D;
#pragma unroll
        for (int i = 0; i < 4; ++i) {
            const int c = 4 * lane + 256 * i;
            nx[i] = *(const u32x2*)(xr + c); ny0[i] = *(const u32x2*)(yp + (size_t)(2 * r) * D + c); ny1[i] = *(const u32x2*)(yp + (size_t)(2 * r + 1) * D + c);
        }
        nw0 = wts[2 * r]; nw1 = wts[2 * r + 1];
    };
    int r = r0 + blockIdx.x * 8 + wid;
    if (r < NROWS) fetch(r);
    for (; r < NROWS; r += stride) {
        const int m = row_mod(r);
        if (m != mcur) {
            mcur = m;
            const float* g2 = modvec(P.ws, layer, m, 5); const float* sh1 = last ? lg : modvec(P.ws, layer + 1, m, 0); const float* sc1 = last ? lg : modvec(P.ws, layer + 1, m, 1);
#pragma unroll
            for (int i = 0; i < 4; ++i) { const int c = 4 * lane + 256 * i; g2v[i] = *(const f32x4*)(g2 + c); s1v[i] = *(const f32x4*)(sc1 + c); h1v[i] = *(const f32x4*)(sh1 + c); }
        }
        f32x4 v[4]; float s = 0.f;
        const float w0 = nw0, w1 = nw1;
#pragma unroll
        for (int i = 0; i < 4; ++i) {
            const f32x4 xv = (f32x4){bflo(nx[i].x), bfhi(nx[i].x), bflo(nx[i].y), bfhi(nx[i].y)}, gv = g2v[i]; const u32x2 y0 = ny0[i], y1 = ny1[i];
            v[i][0] = ALPHA * xv[0] + gv[0] * (w0 * bflo(y0.x) + w1 * bflo(y1.x)); v[i][1] = ALPHA * xv[1] + gv[1] * (w0 * bfhi(y0.x) + w1 * bfhi(y1.x));
            v[i][2] = ALPHA * xv[2] + gv[2] * (w0 * bflo(y0.y) + w1 * bflo(y1.y)); v[i][3] = ALPHA * xv[3] + gv[3] * (w0 * bfhi(y0.y) + w1 * bfhi(y1.y));
            s += (v[i][0] + v[i][1]) + (v[i][2] + v[i][3]);
        }
        if (r + stride < NROWS) fetch(r + stride);
        const float mean = wave_sum(s) * (1.f / D);
        float s2 = 0.f;
#pragma unroll
        for (int i = 0; i < 4; ++i) { v[i] = v[i] - mean; s2 += (v[i][0] * v[i][0] + v[i][1] * v[i][1]) + (v[i][2] * v[i][2] + v[i][3] * v[i][3]); }
        const float rstd = rsqrtf(wave_sum(s2) * (1.f / D) + 1e-5f);
#pragma unroll
        for (int i = 0; i < 4; ++i) {
            const int c = 4 * lane + 256 * i;
            f32x4 xn;
#pragma unroll
            for (int j = 0; j < 4; ++j) xn[j] = v[i][j] * rstd * cg[i][j] + cb[i][j];
            if (dry) *(f32x4*)((float*)(P.ws + WS_YF) + (size_t)r * D + c) = xn;
            else if (last) *(f32x4*)(P.out + (size_t)(r - NCTX) * D + c) = xn;
            else { u32x2 ox; ox.x = pk2(xn[0], xn[1]); ox.y = pk2(xn[2], xn[3]); *(u32x2*)((r < NCTX ? xcb + (size_t)r * D : xob + (size_t)(r - NCTX) * D) + c) = ox; }
            if (!last) {
                u32x2 o; o.x = pk2(xn[0] * (1.f + s1v[i][0]) + h1v[i][0], xn[1] * (1.f + s1v[i][1]) + h1v[i][1]); o.y = pk2(xn[2] * (1.f + s1v[i][2]) + h1v[i][2], xn[3] * (1.f + s1v[i][3]) + h1v[i][3]);
                *(u32x2*)(act + (size_t)r * D + c) = o;
            }
        }
    }
}

constexpr int NPHASE = 2 + 11 * DEPTH;
__global__ void __launch_bounds__(NT, 2) fwd_kernel(Params P) {
    extern __shared__ __attribute__((aligned(16))) char lds_raw[];
    LAS char* lds = (LAS char*)lds_raw;
    volatile LAS unsigned* xbw = (volatile LAS unsigned*)(lds + LDS_BYTES - 16);
    KP Pk = (KP)__builtin_amdgcn_kernarg_segment_ptr();
    const int wv = __builtin_amdgcn_readfirstlane((int)(threadIdx.x >> 6));
    const bool multi = (P.ph_hi - P.ph_lo) > 1;
    XcdBarrier bar; bar.bar = (unsigned*)(P.ws + WS_BAR); bar.x = 0; bar.st = xbw;
    if (multi) {
        if (ltid(wv) == 0) { xbw[0] = 0u; xbw[1] = 0u; xbw[2] = 0u; xbw[3] = 0u; }
        __syncthreads();
        bar = xcd_barrier_post(wv, (unsigned*)(P.ws + WS_BAR), xbw);
    }
#define PHASE(id, body) do { if (P.ph_lo <= (id) && (id) < P.ph_hi) { body; if ((id) + 1 < P.ph_hi) xcd_barrier(wv, bar); if (MK_DOUBLE & 2048) xcd_barrier(wv, bar); } } while (0)
    PHASE(0, REP(16, phase_prologue0(wv, Pk, lds)));
    PHASE(1, REP(16, phase_prologue1(wv, Pk)));
    for (int l = 0; l < DEPTH; ++l) {
        const int pb = 2 + 11 * l, odd = l & 1;
        PHASE(pb + 0, REP(1, phase_inproj(wv, Pk, l, lds)));
        if (odd) {
            PHASE(pb + 1, REP(4, phase_prep1(wv, Pk, l)));
            PHASE(pb + 2, phase_prep2(wv, Pk, l, lds));
            PHASE(pb + 3, REP(32, { if (blockIdx.x < 128) { REP(64, scan_hgrn_c(wv, Pk, l, blockIdx.x, lds)); expconv_after_scan(wv, Pk, l, lds); } else if (blockIdx.x < 256) REP(128, scan_rwkv_b(wv, Pk, l, blockIdx.x - 128, lds)); }));
            PHASE(pb + 5, REP(4, phase_out_odd(wv, Pk, l)));
        } else {
            PHASE(pb + 1, REP(4, phase_prep_even(wv, Pk, l)));
            PHASE(pb + 2, REP(2, phase_ex1(wv, Pk, l, lds)));
            PHASE(pb + 3, phase_ex2(wv, Pk, l));
            PHASE(pb + 4, REP(2, phase_ex3(wv, Pk, l, lds)));
            PHASE(pb + 5, REP(4, phase_out_even(wv, Pk, l)));
        }
        PHASE(pb + 6, REP(256, phase_outproj(wv, Pk, l, lds)));
        PHASE(pb + 7, { if (MK_DOUBLE & 4096) phase_ln1(wv, Pk, l, lds, true); phase_ln1(wv, Pk, l, lds); });
        PHASE(pb + 8, REP(512, phase_moe1(wv, Pk, l, lds)));
        PHASE(pb + 9, REP(1024, phase_moe2(wv, Pk, l, lds)));
        PHASE(pb + 10, { if (MK_DOUBLE & 8192) phase_ln2(wv, Pk, l, true); phase_ln2(wv, Pk, l); });
    }
#undef PHASE
}


#ifndef MK_STOP
#define MK_STOP NPHASE
#endif
#ifndef MK_DUMP
#define MK_DUMP 0
#endif
#ifndef MK_DUMP_N
#define MK_DUMP_N (1u << 30)
#endif
#ifndef MK_DUMP_LD
#define MK_DUMP_LD 1024
#endif
#ifndef MK_DUMP_C0
#define MK_DUMP_C0 0
#endif
__global__ void diff_kernel(const bf16_t* a, const bf16_t* b, float* out, size_t n) {
    for (size_t i = (size_t)blockIdx.x * blockDim.x + threadIdx.x; i < n; i += (size_t)gridDim.x * blockDim.x) out[i] = 1e6f * (bf2f(a[i]) - bf2f(b[i]));
}
__global__ void dump_kernel(const bf16_t* src, float* out, size_t n) {
    for (size_t i = (size_t)blockIdx.x * blockDim.x + threadIdx.x; i < n; i += (size_t)gridDim.x * blockDim.x) out[i] = i < (size_t)MK_DUMP_N ? bf2f(src[(i >> 10) * MK_DUMP_LD + MK_DUMP_C0 + (i & 1023)]) : 0.f;
}
extern "C" void kernel_launch(void* const* d_in, const int* in_sizes, int n_in, void* d_out, int out_size, void* d_ws, size_t ws_size, hipStream_t stream) {
    static int ready = 0;
    if (ready == 0) {
        ready = 1;
        if (n_in != 42 || out_size != NB * SEQ * D || ws_size < WS_END) { fprintf(stderr, "kernel_launch: unexpected shapes (n_in %d out %d ws %zu need %zu)\n", n_in, out_size, ws_size, (size_t)WS_END); ready = -1; }
        if (hipFuncSetAttribute((const void*)fwd_kernel, hipFuncAttributeMaxDynamicSharedMemorySize, LDS_BYTES) != hipSuccess) { fprintf(stderr, "kernel_launch: hipFuncSetAttribute failed\n"); ready = -1; }
    }
    if (ready < 0) return;
    (void)in_sizes;
    hipMemsetAsync((char*)d_ws + WS_BAR, 0, WS_ZERO_BYTES, stream);
    Params p;
    memset(&p, 0, sizeof(p));
    const float** fp = (const float**)&p;
    for (int i = 0; i < 42; ++i) fp[i] = (const float*)d_in[i];
    p.out = (float*)d_out; p.ws = (unsigned char*)d_ws;
#if MK_PER_PHASE
    for (int ph = 0; ph < MK_STOP; ++ph) {
        const int local = ph < 2 ? -1 : (ph - 2) % 11, layer = ph < 2 ? 0 : (ph - 2) / 11;
        if (local == 4 && (layer & 1)) continue;
        p.ph_lo = ph; p.ph_hi = ph + 1;
        hipLaunchKernelGGL(fwd_kernel, dim3(256), dim3(NT), LDS_BYTES, stream, p);
    }
#ifdef MK_DIFF
    p.ph_lo = 7; p.ph_hi = 8; p.dbg = 1;
    hipLaunchKernelGGL(fwd_kernel, dim3(256), dim3(NT), LDS_BYTES, stream, p);
    hipLaunchKernelGGL(diff_kernel, dim3(1024), dim3(256), 0, stream, (const bf16_t*)((unsigned char*)d_ws + WS_YO), (const bf16_t*)((unsigned char*)d_ws + WS_HID), (float*)d_out, (size_t)NB * SEQ * D);
#else
    if (MK_DUMP) hipLaunchKernelGGL(dump_kernel, dim3(1024), dim3(256), 0, stream, (const bf16_t*)((unsigned char*)d_ws + (size_t)MK_DUMP), (float*)d_out, (size_t)NB * SEQ * D);
#endif
#else
    p.ph_lo = 0; p.ph_hi = NPHASE;
    hipLaunchKernelGGL(fwd_kernel, dim3(256), dim3(NT), LDS_BYTES, stream, p);
#endif
}
```

```cpp
#include <hip/hip_runtime.h>
#include <stdint.h>
#include <stdio.h>
#include <string.h>

#ifndef MK_PER_PHASE
#define MK_PER_PHASE 0
#endif

typedef unsigned short bf16_t;
typedef short bf16x8 __attribute__((ext_vector_type(8)));
typedef float f32x4 __attribute__((ext_vector_type(4)));
typedef unsigned u32x4 __attribute__((ext_vector_type(4)));
typedef unsigned u32x2 __attribute__((ext_vector_type(2)));
#define LAS __attribute__((address_space(3)))
#define CAS __attribute__((address_space(4)))

constexpr int D = 1024, NB = 4, SEQ = 8192, CTXL = 256, DEPTH = 4;
constexpr int NCTX = NB * CTXL;
constexpr int NROWS = NCTX + NB * SEQ;
constexpr int P_EVEN = 2848, P_ODD = 4416, LDP_EVEN = 3072, LDP_ODD = 4608;
constexpr int NEXP = 32, DEXP = 512, LISTCAP = NROWS;
constexpr float ALPHA = 1.681792830507429f;
constexpr int NT = 512;
constexpr int TCH = 32;
constexpr int NSTEPS = CTXL + SEQ;
constexpr int LDS_BYTES = 160 * 1024;

constexpr size_t al256(size_t x) { return (x + 255) & ~(size_t)255; }
constexpr size_t WS_BAR = 0;
constexpr size_t WS_CNT = 16384;
constexpr int CNT_STRIDE = 64;
constexpr size_t WS_ZERO_BYTES = 16384 + (size_t)4 * 32 * CNT_STRIDE * 4;
constexpr size_t WS_MODV = al256(WS_ZERO_BYTES);
constexpr size_t WS_LB = WS_MODV + al256((size_t)4 * 5 * 6144 * 4);
constexpr size_t WS_XC = WS_LB + al256(4 * 512 * 4);
constexpr size_t WS_WTS = WS_XC + (size_t)NCTX * D * 4;
constexpr size_t WS_LIST = WS_WTS + al256((size_t)2 * NROWS * 4);
constexpr size_t WS_WINT = WS_LIST + al256((size_t)NEXP * LISTCAP * 4);
constexpr size_t WINT_L0 = 0, WINT_L1 = (size_t)LDP_EVEN * D, WINT_L2 = WINT_L1 + (size_t)LDP_ODD * D, WINT_L3 = WINT_L2 + (size_t)LDP_EVEN * D, WINT_END = WINT_L3 + (size_t)LDP_ODD * D;
constexpr size_t WS_WOUTT = WS_WINT + WINT_END * 2;
constexpr size_t WS_LORAT = WS_WOUTT + (size_t)4 * D * D * 2;
constexpr size_t LORA_PER = (size_t)512 * 320;
constexpr size_t WS_EXPGU = WS_LORAT + al256(2 * LORA_PER * 2);
constexpr size_t WS_EXPD = WS_EXPGU + (size_t)NEXP * 1024 * 1024 * 2;
constexpr size_t WS_ACT = WS_EXPD + (size_t)NEXP * 1024 * 512 * 2;
constexpr size_t ROWB = (size_t)NROWS * D * 2;
constexpr size_t WS_FEAT = WS_ACT + ROWB;
constexpr size_t WS_YF = WS_FEAT + ROWB;
constexpr size_t WS_YB = WS_YF + ROWB;
constexpr size_t WS_P = WS_YB + ROWB;
constexpr size_t P_BYTES = (size_t)NROWS * LDP_ODD * 2;
constexpr size_t WS_YO = WS_P;
constexpr size_t WS_HID = WS_P + ROWB;
constexpr size_t WS_YP = WS_HID + ROWB;
static_assert(WS_YP + 2 * ROWB <= WS_P + P_BYTES, "MoE buffers must fit in the P region");
constexpr size_t HALFB = (size_t)NROWS * 512 * 2;
constexpr size_t WS_RWR = WS_P + P_BYTES;
constexpr size_t WS_RWK = WS_RWR + HALFB;
constexpr size_t WS_RWV = WS_RWK + HALFB;
constexpr size_t WS_RWKK = WS_RWV + HALFB;
constexpr size_t WS_RWB = WS_RWKK + HALFB;
constexpr size_t WS_RWG = WS_RWB + HALFB;
constexpr size_t WS_RWDEC = WS_RWG + HALFB;
constexpr size_t WS_LA = WS_RWDEC + (size_t)2 * NROWS * 512 * 4;
constexpr size_t WS_END = WS_LA + (size_t)NROWS * 320 * 2;
static_assert(WS_END <= (size_t)280602384 * 4, "workspace map exceeds the guaranteed ws_size");

struct Params {
    const float *x, *c, *ctx, *c_ctx, *mod_w, *mod_b, *ln_g, *ln_b;
    const float *ev_w_in, *ev_w_out, *ssd_conv_w, *ssd_conv_b, *ssd_dt_bias, *ssd_a_log, *ssd_d, *ssd_norm_w;
    const float *ml_conv_w, *ml_conv_b, *ml_i_bias, *ml_f_bias, *ml_norm_w;
    const float *od_w_in, *od_w_out, *hg_lb_logits, *hg_f_bias, *hg_norm_w;
    const float *rw_mu, *rw_w0, *rw_w2, *rw_a0, *rw_a2, *rw_g2, *rw_k_k, *rw_k_a, *rw_r_k, *rw_ln_w, *rw_ln_b;
    const float *router_w, *router_bias, *exp_w_gate, *exp_w_up, *exp_w_down;
    float* out;
    unsigned char* ws;
    int ph_lo, ph_hi, dbg, pad_;
};
typedef const CAS Params* KP;

__device__ __forceinline__ int ltid(int wv) { int l; asm volatile("v_mbcnt_lo_u32_b32 %0, -1, 0\n\tv_mbcnt_hi_u32_b32 %0, -1, %0" : "=v"(l)); return wv * 64 + l; }
__device__ __forceinline__ float bf2f(bf16_t h) { return __uint_as_float(((unsigned)h) << 16); }
__device__ __forceinline__ float bflo(unsigned u) { return __uint_as_float(u << 16); }
__device__ __forceinline__ float bfhi(unsigned u) { return __uint_as_float(u & 0xffff0000u); }
typedef __bf16 bf16v2_t __attribute__((ext_vector_type(2)));
typedef float f32x2 __attribute__((ext_vector_type(2)));
__device__ __forceinline__ unsigned pk2(float lo, float hi) { const f32x2 v = {lo, hi}; return __builtin_bit_cast(unsigned, __builtin_convertvector(v, bf16v2_t)); }
__device__ __forceinline__ bf16_t f2bf(float f) { return (bf16_t)(pk2(f, 0.f) & 0xffffu); }
__device__ __forceinline__ void unpack8(const u32x4& u, float* f) {
    f[0] = bflo(u.x); f[1] = bfhi(u.x); f[2] = bflo(u.y); f[3] = bfhi(u.y); f[4] = bflo(u.z); f[5] = bfhi(u.z); f[6] = bflo(u.w); f[7] = bfhi(u.w);
}
__device__ __forceinline__ u32x4 pack8(const float* f) { u32x4 u; u.x = pk2(f[0], f[1]); u.y = pk2(f[2], f[3]); u.z = pk2(f[4], f[5]); u.w = pk2(f[6], f[7]); return u; }
__device__ __forceinline__ float sigmoidf_(float x) { return __builtin_amdgcn_rcpf(1.f + __expf(-x)); }
__device__ __forceinline__ float siluf_(float x) { return x * __builtin_amdgcn_rcpf(1.f + __expf(-x)); }
__device__ __forceinline__ float softplus_fast(float x) { return x > 20.f ? x : __logf(1.f + __expf(x)); }
__device__ __forceinline__ float tanh_fast(float x) { return 1.f - 2.f * __builtin_amdgcn_rcpf(1.f + __expf(2.f * x)); }
__device__ __forceinline__ float softplusf_(float x) { return x > 20.f ? x : __logf(1.f + __expf(x)); }
__device__ __forceinline__ float logsigmoidf_(float x) { return fminf(x, 0.f) - __logf(1.f + __expf(-fabsf(x))); }
template <int CTRL> __device__ __forceinline__ float dppmov(float v) {
    return __builtin_bit_cast(float, __builtin_amdgcn_update_dpp(0, __builtin_bit_cast(int, v), CTRL, 0xf, 0xf, true));
}
__device__ __forceinline__ float allreduce16(float v) {
    v += dppmov<0xB1>(v);
    v += dppmov<0x4E>(v);
    v += dppmov<0x141>(v);
    v += dppmov<0x140>(v);
    return v;
}
__device__ __forceinline__ float allreduce8_(float v) { v += dppmov<0xB1>(v); v += dppmov<0x4E>(v); v += dppmov<0x141>(v); return v; }
__device__ __forceinline__ float wave_sum(float v) {
    v = allreduce16(v);
    const float r0 = __builtin_bit_cast(float, __builtin_amdgcn_readlane(__builtin_bit_cast(int, v), 0)), r1 = __builtin_bit_cast(float, __builtin_amdgcn_readlane(__builtin_bit_cast(int, v), 16));
    const float r2 = __builtin_bit_cast(float, __builtin_amdgcn_readlane(__builtin_bit_cast(int, v), 32)), r3 = __builtin_bit_cast(float, __builtin_amdgcn_readlane(__builtin_bit_cast(int, v), 48));
    return (r0 + r1) + (r2 + r3);
}
template <int W> __device__ __forceinline__ float group_sum(float v) {
    if (W == 8) return allreduce8_(v);
    return allreduce16(v);
}

#define XB_TMO      128
#define XB_XCNT(j)  (256  + 64 * (j))
#define XB_XSUB(j)  (1280 + 64 * (j))
#define XB_XGEN(j)  (2304 + 64 * (j))
#define XB_TOP      3328
#define XB_TOPGEN   3392
#define XCD_BAR_WORDS 3456
#define XB_SPIN_CAP (1u << 22)
__device__ __forceinline__ unsigned xb_ld(unsigned* p)              { return __hip_atomic_load(p, __ATOMIC_RELAXED, __HIP_MEMORY_SCOPE_AGENT); }
__device__ __forceinline__ unsigned xb_add(unsigned* p, unsigned v) { return __hip_atomic_fetch_add(p, v, __ATOMIC_RELAXED, __HIP_MEMORY_SCOPE_AGENT); }
__device__ __forceinline__ unsigned xb_xcc_id() { return (unsigned)__builtin_amdgcn_s_getreg((3 << 11) | 20) & 0xFu; }
#define XB_SPIN(cond, bar) do { unsigned _sp = 0; while (cond) { __builtin_amdgcn_s_sleep(1); \
    if ((++_sp & 255u) == 0u) { if (xb_ld(&(bar)[XB_TMO])) break; if (_sp > XB_SPIN_CAP) { atomicAdd(&(bar)[XB_TMO], 1u); break; } } } } while (0)
struct XcdBarrier { unsigned* bar; unsigned x; volatile LAS unsigned* st; };
__device__ __forceinline__ XcdBarrier xcd_barrier_post(int wv, unsigned* bar, volatile LAS unsigned* st) {
    XcdBarrier b; b.bar = bar; b.x = xb_xcc_id(); b.st = st;
    if (ltid(wv) == 0) (void)xb_add(&bar[XB_XCNT(b.x)], 1u);
    return b;
}
__device__ __forceinline__ void xcd_barrier_complete(unsigned* bar, unsigned x, unsigned& nloc, unsigned& nx) {
    const unsigned G = gridDim.x * gridDim.y * gridDim.z;
    unsigned sum, cnt, mine, sp = 0u;
    for (;;) {
        sum = 0u; cnt = 0u; mine = 0u;
#pragma unroll
        for (unsigned j = 0; j < 16; ++j) { const unsigned c = xb_ld(&bar[XB_XCNT(j)]); sum += c; cnt += (c > 0u) ? 1u : 0u; mine = (j == x) ? c : mine; }
        if (sum == G) break;
        __builtin_amdgcn_s_sleep(1);
        if ((++sp & 255u) == 0u) { if (xb_ld(&bar[XB_TMO])) break; if (sp > XB_SPIN_CAP) { atomicAdd(&bar[XB_TMO], 1u); break; } }
    }
    nloc = mine > 0u ? mine : 1u; nx = cnt > 0u ? cnt : 1u;
}
__device__ __forceinline__ void xcd_barrier(int wv, const XcdBarrier& b) {
    asm volatile("s_waitcnt vmcnt(0)" ::: "memory");
    __syncthreads();
    if (ltid(wv) == 0) {
        unsigned* bar = b.bar;
        asm volatile("" : "+s"(bar));
        __builtin_amdgcn_s_waitcnt(0);
        unsigned nloc = b.st[0], nx = b.st[1];
        if (nloc == 0u) { xcd_barrier_complete(bar, b.x, nloc, nx); b.st[0] = nloc; b.st[1] = nx; }
        const unsigned old = xb_add(&bar[XB_XSUB(b.x)], 1u);
        const unsigned gen = old / nloc;
        if (old + 1u == (gen + 1u) * nloc) {
            __builtin_amdgcn_fence(__ATOMIC_RELEASE, "agent");
            asm volatile("s_waitcnt vmcnt(0)" ::: "memory");
            const unsigned og = xb_add(&bar[XB_TOP], 1u);
            const unsigned tg = og / nx;
            if (og + 1u == (tg + 1u) * nx) xb_add(&bar[XB_TOPGEN], 1u);
            else XB_SPIN(xb_ld(&bar[XB_TOPGEN]) == tg, bar);
            __builtin_amdgcn_fence(__ATOMIC_ACQUIRE, "agent");
            xb_add(&bar[XB_XGEN(b.x)], 1u);
            asm volatile("s_waitcnt vmcnt(0)" ::: "memory");
        } else {
            XB_SPIN(xb_ld(&bar[XB_XGEN(b.x)]) == gen, bar);
            __builtin_amdgcn_fence(__ATOMIC_ACQUIRE, "agent");
            asm volatile("s_waitcnt vmcnt(0)" ::: "memory");
        }
    }
    __syncthreads();
}

__device__ __forceinline__ int row_mod(int r) { return r < NCTX ? 4 : ((r - NCTX) >> 13); }
__device__ __forceinline__ void row_seg(int r, int& t, int& len) { if (r < NCTX) { t = r & 255; len = CTXL; } else { t = (r - NCTX) & 8191; len = SEQ; } }
__device__ __forceinline__ int scan_row(int tg, int b, int dir, int odd) {
    if (tg < CTXL) { const int t = dir ? (CTXL - 1 - tg) : tg; return b * CTXL + t; }
    int sg = tg - CTXL; if (dir) sg = SEQ - 1 - sg;
    const int s = odd ? (((sg & 127) << 6) + (sg >> 7)) : sg;
    return NCTX + b * SEQ + s;
}
__device__ __forceinline__ const float* modvec(const unsigned char* ws, int layer, int m, int which) {
    return (const float*)(ws + WS_MODV) + ((size_t)(layer * 5 + m) * 6 + which) * D;
}

constexpr int G_BM = 256, G_BN = 128, G_BK = 64;
constexpr int G_ABYTES = G_BM * G_BK * 2, G_BBYTES = G_BN * G_BK * 2, G_BUF = G_ABYTES + G_BBYTES;
__device__ __forceinline__ int swz(int o) { return o ^ (((o >> 9) & 1) << 5); }

template <class RowSrc, class Epi>
__device__ __forceinline__ void gemm_tile(int wv, const bf16_t* __restrict__ A, int lda, const RowSrc& rs, const bf16_t* __restrict__ Bt, int ldb, int n0, int K, const Epi& epi, LAS char* lds) {
    const int tid = ltid(wv), lane = tid & 63, wid = tid >> 6, wm = wid >> 1, wn = wid & 1;
    const bf16_t* ap[4]; int aoff[4];
#pragma unroll
    for (int i = 0; i < 4; ++i) {
        const int c = tid + NT * i, row = c >> 3, kc = c & 7;
        ap[i] = A + (size_t)rs.src(row) * lda + kc * 8;
        aoff[i] = ((row >> 4) * 2 + (kc >> 2)) * 1024 + swz((row & 15) * 64 + (kc & 3) * 16);
    }
    const bf16_t* bp[2]; int boff[2];
#pragma unroll
    for (int i = 0; i < 2; ++i) {
        const int c = tid + NT * i, row = c >> 3, kc = c & 7;
        bp[i] = Bt + (size_t)(n0 + row) * ldb + kc * 8;
        boff[i] = G_ABYTES + ((row >> 4) * 2 + (kc >> 2)) * 1024 + swz((row & 15) * 64 + (kc & 3) * 16);
    }
    f32x4 acc[4][4];
#pragma unroll
    for (int i = 0; i < 4; ++i)
#pragma unroll
        for (int j = 0; j < 4; ++j) acc[i][j] = (f32x4){0.f, 0.f, 0.f, 0.f};
    u32x4 ra[2][4], rb[2][2];
    const int KT = K / G_BK;
    const int fragoff = swz((lane & 15) * 64 + (lane >> 4) * 16);
#define G_LOAD(set, kt_) do { _Pragma("unroll") for (int i = 0; i < 4; ++i) ra[set][i] = *(const u32x4*)(ap[i] + (kt_) * G_BK); \
                              _Pragma("unroll") for (int i = 0; i < 2; ++i) rb[set][i] = *(const u32x4*)(bp[i] + (kt_) * G_BK); } while (0)
#define G_STORE(set, buf) do { _Pragma("unroll") for (int i = 0; i < 4; ++i) *(LAS u32x4*)((buf) + aoff[i]) = ra[set][i]; \
                               _Pragma("unroll") for (int i = 0; i < 2; ++i) *(LAS u32x4*)((buf) + boff[i]) = rb[set][i]; } while (0)
#define G_COMPUTE(cur) do { bf16x8 af[2][4], bfr[2][4]; \
        _Pragma("unroll") for (int ks = 0; ks < 2; ++ks) { \
            _Pragma("unroll") for (int ni = 0; ni < 4; ++ni) bfr[ks][ni] = *(LAS bf16x8*)((cur) + G_ABYTES + ((wn * 4 + ni) * 2 + ks) * 1024 + fragoff); \
            _Pragma("unroll") for (int mi = 0; mi < 4; ++mi) af[ks][mi] = *(LAS bf16x8*)((cur) + ((wm * 4 + mi) * 2 + ks) * 1024 + fragoff); } \
        __builtin_amdgcn_sched_barrier(0); \
        _Pragma("unroll") for (int ks = 0; ks < 2; ++ks) _Pragma("unroll") for (int mi = 0; mi < 4; ++mi) _Pragma("unroll") for (int ni = 0; ni < 4; ++ni) \
            acc[mi][ni] = __builtin_amdgcn_mfma_f32_16x16x32_bf16(bfr[ks][ni], af[ks][mi], acc[mi][ni], 0, 0, 0); \
        __builtin_amdgcn_sched_barrier(0); } while (0)
    G_LOAD(0, 0);
    G_STORE(0, lds);
    if (KT > 1) G_LOAD(0, 1);
    if (KT > 2) G_LOAD(1, 2);
    __syncthreads();
    for (int kt = 0; kt < KT; kt += 2) {
        G_COMPUTE(lds);
        if (kt + 1 < KT) G_STORE(0, lds + G_BUF);
        if (kt + 3 < KT) G_LOAD(0, kt + 3);
        __syncthreads();
        if (kt + 1 < KT) {
            G_COMPUTE(lds + G_BUF);
            if (kt + 2 < KT) G_STORE(1, lds);
            if (kt + 4 < KT) G_LOAD(1, kt + 4);
            __syncthreads();
        }
    }
#undef G_LOAD
#undef G_STORE
#undef G_COMPUTE
    epi(acc, wm * 64 + (lane & 15), wn * 64 + 4 * (lane >> 4));
}

constexpr int G2_BN = 256, G2_BBYTES = G2_BN * G_BK * 2, G2_BUF = G_ABYTES + G2_BBYTES;

struct RowLinear { int m0; __device__ __forceinline__ int src(int r) const { return m0 + r; } };
struct EpiStoreBf16 {
    bf16_t* C; int ldc; int m0; int n0; int N;
    template <int NI> __device__ __forceinline__ void operator()(const f32x4 (&acc)[4][NI], int rbase, int cbase) const {
#pragma unroll
        for (int mi = 0; mi < 4; ++mi) {
            bf16_t* rowp = C + (size_t)(m0 + rbase + mi * 16) * ldc + n0 + cbase;
#pragma unroll
            for (int ni = 0; ni < NI; ++ni) {
                if (n0 + cbase + ni * 16 < N) { u32x2 v; v.x = pk2(acc[mi][ni][0], acc[mi][ni][1]); v.y = pk2(acc[mi][ni][2], acc[mi][ni][3]); *(u32x2*)(rowp + ni * 16) = v; }
            }
        }
    }
};
struct EpiDecay {
    bf16_t* Dc; const float* w0; int m0; int n0;
    template <int NI> __device__ __forceinline__ void operator()(const f32x4 (&acc)[4][NI], int rbase, int cbase) const {
#pragma unroll
        for (int ni = 0; ni < NI; ++ni) {
            const int col = n0 + cbase + ni * 16;
            const f32x4 w0v = *(const f32x4*)(w0 + col);
#pragma unroll
            for (int mi = 0; mi < 4; ++mi) {
                f32x4 o;
#pragma unroll
                for (int j = 0; j < 4; ++j) { const float w = w0v[j] + acc[mi][ni][j]; o[j] = __expf(-softplus_fast(-w) - 0.5f); }
                u32x2 ob; ob.x = pk2(o[0], o[1]); ob.y = pk2(o[2], o[3]);
                *(u32x2*)(Dc + (size_t)(m0 + rbase + mi * 16) * 512 + col) = ob;
            }
        }
    }
};
struct EpiAK {
    bf16_t* Kb; const bf16_t* KKb; bf16_t* Bb; const float* a0; const float* k_a; int m0; int n0;
    template <int NI> __device__ __forceinline__ void operator()(const f32x4 (&acc)[4][NI], int rbase, int cbase) const {
#pragma unroll
        for (int ni = 0; ni < NI; ++ni) {
            const int col = n0 + cbase + ni * 16;
            const f32x4 a0v = *(const f32x4*)(a0 + col), kav = *(const f32x4*)(k_a + col);
#pragma unroll
            for (int mi = 0; mi < 4; ++mi) {
                const size_t off = (size_t)(m0 + rbase + mi * 16) * 512 + col;
                const u32x2 kr = *(const u32x2*)(Kb + off), kkr = *(const u32x2*)(KKb + off);
                const float kf[4] = {bflo(kr.x), bfhi(kr.x), bflo(kr.y), bfhi(kr.y)}, kkf[4] = {bflo(kkr.x), bfhi(kkr.x), bflo(kkr.y), bfhi(kkr.y)};
                float k2[4], bb[4];
#pragma unroll
                for (int j = 0; j < 4; ++j) { const float a = sigmoidf_(a0v[j] + acc[mi][ni][j]); k2[j] = kf[j] * (1.f + (a - 1.f) * kav[j]); bb[j] = kkf[j] * a; }
                u32x2 v; v.x = pk2(k2[0], k2[1]); v.y = pk2(k2[2], k2[3]); *(u32x2*)(Kb + off) = v;
                v.x = pk2(bb[0], bb[1]); v.y = pk2(bb[2], bb[3]); *(u32x2*)(Bb + off) = v;
            }
        }
    }
};

namespace pg8 {
#define PG8_LAS __attribute__((address_space(3)))
constexpr int BM = 256, BK = 64, HALF = 128, HTB = HALF * BK * 2, STAGE_BYTES = 8 * HTB, NXCD = 8, WGM = 8;
__host__ __device__ __forceinline__ int lds_byte(int r, int c) { const int st = (r >> 4) * 2 + (c >> 5), rr = r & 15, cc = c & 31, ob = rr * 64 + cc * 2; return st * 1024 + (ob ^ (((ob >> 9) & 1) << 5)); }
__host__ __device__ __forceinline__ void stage_rc(int b, int& R, int& C) { const int st = b / 1024, sb = b % 1024, swz = sb ^ (((sb >> 9) & 1) << 5); R = (st >> 1) * 16 + swz / 64; C = (st & 1) * 32 + (swz % 64) / 2; }
__host__ __device__ __forceinline__ int perm32(int rho) { const int n = rho >> 4, i = rho & 15; return 8 * (i >> 2) + 4 * n + (i & 3); }
struct Unit { int pm, pn; };
struct Gemm { const bf16_t* A; const bf16_t* Bt; int M, N, K; };
struct StaticOrder {
    int nM, nN, nwg, G, c;
    __host__ __device__ void init(int M, int N, int G_, int c_) { nM = M / BM; nN = N / BM; nwg = nM * nN; G = G_; c = c_; }
    __host__ __device__ bool next(int i, Unit& u) const {
        const long L = (long)i * G + c; if (L >= nwg) return false;
        int wgid = (int)L; { const int q = nwg / NXCD, r = nwg % NXCD, xcd = wgid % NXCD, off = wgid / NXCD; wgid = (xcd < r ? xcd * (q + 1) : r * (q + 1) + (xcd - r) * q) + off; }
        const int nig = WGM * nN, gid = wgid / nig, fm = gid * WGM, gsz = (nM - fm) < WGM ? (nM - fm) : WGM;
        u.pm = fm + ((wgid % nig) % gsz); u.pn = (wgid % nig) / gsz; return true;
    }
    __device__ __forceinline__ void a_ready(const Unit&) const {}
    __device__ __forceinline__ void done(const Unit&) const {}
};
struct EpiStoreP {
    static constexpr bool PERM = true, AFTER_DRAIN = false;
    bf16_t* O; int ldc;
    __device__ __forceinline__ void operator()(const f32x4 (&acc)[2][2][4][2], const Unit& u, int wr, int wc, int fr, int fq) const {
        const int row0 = u.pm * BM + wr * 64 + fr, col0 = u.pn * BM + wc * 32 + 8 * fq;
#pragma unroll
        for (int ai = 0; ai < 2; ++ai)
#pragma unroll
            for (int m = 0; m < 4; ++m) { bf16_t* rowp = O + (size_t)(row0 + ai * HALF + m * 16) * ldc + col0;
#pragma unroll
                for (int bj = 0; bj < 2; ++bj) { const f32x4 v0 = acc[ai][bj][m][0], v1 = acc[ai][bj][m][1];
                    u32x4 w; w.x = pk2(v0[0], v0[1]); w.y = pk2(v0[2], v0[3]); w.z = pk2(v1[0], v1[1]); w.w = pk2(v1[2], v1[3]);
                    *(u32x4*)(rowp + bj * HALF) = w; } }
    }
};
template <class Epi, class Sched>
__device__ __forceinline__ void gemm_phase(int wv, PG8_LAS unsigned char* lds, const Gemm g, const Sched& S, const Epi& E) {
    const int tid = ltid(wv), wid = __builtin_amdgcn_readfirstlane(tid >> 6), lane = tid & 63, wr = wid >> 2, wc = wid & 3, fr = lane & 15, fq = lane >> 4;
    const int K = g.K, nt = K / BK;
    unsigned voffA[2], voffB[2];
#pragma unroll
    for (int i = 0; i < 2; ++i) { int R, C; stage_rc(tid * 16 + i * 8192, R, C); const int Rb = Epi::PERM ? ((R & ~31) + perm32(R & 31)) : R;
        voffA[i] = (unsigned)(R * K + C) * 2u; voffB[i] = (unsigned)(Rb * K + C) * 2u; }
    const size_t kstep = (size_t)(BK * 2);
    const size_t hstep = (size_t)HALF * K * 2;
    const size_t tstep = 2 * hstep;
    const unsigned ldsw = (unsigned)wid * 1024u;
    const int aoff = lds_byte(wr * 64 + fr, fq * 8), boff = lds_byte(wc * 32 + fr, fq * 8);
#define PG8_SA(b, h) (((b) * 2 + (h)) * HTB)
#define PG8_SB(b, h) ((4 + (b) * 2 + (h)) * HTB)
#define PG8_STAGE(bufoff, gbase, voff) do { _Pragma("unroll") for (int _i = 0; _i < 2; ++_i) \
        __builtin_amdgcn_global_load_lds((const unsigned*)((const char*)(gbase) + (voff)[_i]), (PG8_LAS unsigned*)(lds + (bufoff) + ldsw + _i * 8192), 16, 0, 0); } while (0)
#define PG8_LDA(dst, b, h) do { _Pragma("unroll") for (int m = 0; m < 4; ++m) _Pragma("unroll") for (int k = 0; k < 2; ++k) dst[m][k] = *(const PG8_LAS bf16x8*)(lds + PG8_SA(b, h) + aoff + m * 2048 + k * 1024); } while (0)
#define PG8_LDB(dst, b, h) do { _Pragma("unroll") for (int n = 0; n < 2; ++n) _Pragma("unroll") for (int k = 0; k < 2; ++k) dst[n][k] = *(const PG8_LAS bf16x8*)(lds + PG8_SB(b, h) + boff + n * 2048 + k * 1024); } while (0)
#define PG8_MMA(ai, bj, At, Bt) do { __builtin_amdgcn_s_setprio(1); _Pragma("unroll") for (int m = 0; m < 4; ++m) _Pragma("unroll") for (int n = 0; n < 2; ++n) _Pragma("unroll") for (int k = 0; k < 2; ++k) \
        acc[ai][bj][m][n] = __builtin_amdgcn_mfma_f32_16x16x32_bf16(Bt[n][k], At[m][k], acc[ai][bj][m][n], 0, 0, 0); __builtin_amdgcn_s_setprio(0); } while (0)
#define PG8_WAIT_V(n) asm volatile("s_waitcnt vmcnt(" #n ")" ::: "memory")
#define PG8_WAIT_L(n) asm volatile("s_waitcnt lgkmcnt(" #n ")" ::: "memory")
#define PG8_BAR __builtin_amdgcn_s_barrier()
#define PG8_SCHED __builtin_amdgcn_sched_barrier(0)
    Unit cur, nxt; int ui = 0;
    if (!S.next(0, cur)) return;
    f32x4 acc[2][2][4][2];
#pragma unroll
    for (int a = 0; a < 2; ++a)
#pragma unroll
        for (int b = 0; b < 2; ++b)
#pragma unroll
            for (int m = 0; m < 4; ++m)
#pragma unroll
                for (int n = 0; n < 2; ++n) acc[a][b][m][n] = (f32x4){0.f, 0.f, 0.f, 0.f};
    bf16x8 At[4][2], B0[2][2], B1[2][2];
    const char* cA = (const char*)g.A + (size_t)cur.pm * tstep; const char* cB = (const char*)g.Bt + (size_t)cur.pn * tstep;
    S.a_ready(cur);
    PG8_STAGE(PG8_SB(0, 0), cB, voffB); PG8_STAGE(PG8_SA(0, 0), cA, voffA); PG8_STAGE(PG8_SB(0, 1), cB + hstep, voffB); PG8_STAGE(PG8_SA(0, 1), cA + hstep, voffA);
    if (wr == 1) PG8_BAR;
    PG8_WAIT_V(4); PG8_BAR;
    PG8_STAGE(PG8_SB(1, 0), cB + kstep, voffB); PG8_STAGE(PG8_SA(1, 0), cA + kstep, voffA); PG8_STAGE(PG8_SB(1, 1), cB + hstep + kstep, voffB);
    PG8_WAIT_V(6); PG8_BAR;
    for (;;) {
        const bool has_next = S.next(ui + 1, nxt);
        const char* nA = has_next ? (const char*)g.A + (size_t)nxt.pm * tstep : cA; const char* nB = has_next ? (const char*)g.Bt + (size_t)nxt.pn * tstep : cB;
        for (int t = 0; t < nt; t += 2) {
            const bool last = (t == nt - 2);
            const char* a1 = cA + (size_t)(t + 1) * kstep;
            const char* a2 = last ? nA : cA + (size_t)(t + 2) * kstep; const char* b2 = last ? nB : cB + (size_t)(t + 2) * kstep;
            const char* a3 = a2 + kstep; const char* b3 = b2 + kstep;
            if (last && has_next) S.a_ready(nxt);
            PG8_LDB(B0, 0, 0); PG8_SCHED; PG8_LDA(At, 0, 0); PG8_STAGE(PG8_SA(1, 1), a1 + hstep, voffA);
            PG8_WAIT_L(8); PG8_BAR; PG8_WAIT_L(0); PG8_MMA(0, 0, At, B0); PG8_BAR; PG8_SCHED;
            PG8_LDB(B1, 0, 1); PG8_STAGE(PG8_SB(0, 0), b2, voffB);
            PG8_BAR; PG8_WAIT_L(0); PG8_MMA(0, 1, At, B1); PG8_BAR;
            PG8_LDA(At, 0, 1); PG8_STAGE(PG8_SA(0, 0), a2, voffA);
            PG8_BAR; PG8_WAIT_L(0); PG8_MMA(1, 0, At, B0); PG8_BAR; PG8_SCHED;
            PG8_STAGE(PG8_SB(0, 1), b2 + hstep, voffB);
            PG8_WAIT_V(6); PG8_BAR; PG8_MMA(1, 1, At, B1); PG8_BAR;
            PG8_LDB(B0, 1, 0); PG8_SCHED; PG8_LDA(At, 1, 0); PG8_STAGE(PG8_SA(0, 1), a2 + hstep, voffA);
            PG8_WAIT_L(8); PG8_BAR; PG8_WAIT_L(0); PG8_MMA(0, 0, At, B0); PG8_BAR; PG8_SCHED;
            PG8_LDB(B1, 1, 1); PG8_STAGE(PG8_SB(1, 0), b3, voffB);
            PG8_BAR; PG8_WAIT_L(0); PG8_MMA(0, 1, At, B1); PG8_BAR;
            PG8_LDA(At, 1, 1); PG8_STAGE(PG8_SA(1, 0), a3, voffA);
            PG8_BAR; PG8_WAIT_L(0); PG8_MMA(1, 0, At, B0); PG8_BAR; PG8_SCHED;
            PG8_STAGE(PG8_SB(1, 1), b3 + hstep, voffB);
            PG8_WAIT_V(6); PG8_BAR; PG8_MMA(1, 1, At, B1); PG8_BAR;
        }
            if constexpr (!Epi::AFTER_DRAIN) { E(acc, cur, wr, wc, fr, fq); S.done(cur); }
            if (!has_next) break;
#pragma unroll
        for (int a = 0; a < 2; ++a)
#pragma unroll
            for (int b = 0; b < 2; ++b)
#pragma unroll
                for (int m = 0; m < 4; ++m)
#pragma unroll
                    for (int n = 0; n < 2; ++n) acc[a][b][m][n] = (f32x4){0.f, 0.f, 0.f, 0.f};
        cur = nxt; cA = nA; cB = nB; ++ui;
    }
    PG8_WAIT_V(0);
    if (wr == 0) PG8_BAR;
    PG8_BAR;
    if constexpr (Epi::AFTER_DRAIN) { E.fused(acc, cur, wr, wc, fr, fq, lds, wid, lane); S.done(cur); }
#undef PG8_SA
#undef PG8_SB
#undef PG8_STAGE
#undef PG8_LDA
#undef PG8_LDB
#undef PG8_MMA
#undef PG8_WAIT_V
#undef PG8_WAIT_L
#undef PG8_BAR
#undef PG8_SCHED
}
struct UnitG { int pm, pn; const char* bbase; const PG8_LAS int* ltab; int cnt; int e; };
struct MoeOrder {
    const PG8_LAS int* tstart; const PG8_LAS int* tcnt; const PG8_LAS int* ltabs; const int* lists; const char* bt; size_t estride; int ncol, shift, G, c;
    __device__ __forceinline__ bool next(int i, UnitG& u) const {
        const int t = i * G + c; if (t >= tstart[32] * ncol) return false;
        const int tm = t / ncol; int e = 0;
#pragma unroll 1
        while (tstart[e + 1] <= tm) ++e;
        e = __builtin_amdgcn_readfirstlane(e);
        const int ts = __builtin_amdgcn_readfirstlane(tstart[e]), tc = __builtin_amdgcn_readfirstlane(tcnt[e]);
        u.pm = tm - ts; u.pn = t - tm * ncol; u.bbase = bt + (size_t)e * estride; u.e = e; u.cnt = tc - u.pm * BM; u.ltab = ltabs + i * BM;
        return true;
    }
    __device__ __forceinline__ void a_ready(const UnitG&) const {}
    __device__ __forceinline__ void done(const UnitG&) const {}
};
struct EpiSwiGLUG {
    static constexpr bool PERM = false, AFTER_DRAIN = false;
    bf16_t* H;
    __device__ __forceinline__ void operator()(const f32x4 (&acc)[2][2][4][2], const UnitG& u, int wr, int wc, int fr, int fq) const {
#pragma unroll
        for (int ai = 0; ai < 2; ++ai)
#pragma unroll
            for (int m = 0; m < 4; ++m) { const int r = ai * HALF + wr * 64 + m * 16 + fr;
                if (r < u.cnt) { bf16_t* rowp = H + (size_t)u.ltab[r] * DEXP + ((u.pn * BM + wc * 32) >> 1) + 4 * fq;
#pragma unroll
                    for (int bj = 0; bj < 2; ++bj) { const f32x4 gt = acc[ai][bj][m][0], up = acc[ai][bj][m][1];
                        u32x2 w; w.x = pk2(siluf_(gt[0]) * up[0], siluf_(gt[1]) * up[1]); w.y = pk2(siluf_(gt[2]) * up[2], siluf_(gt[3]) * up[3]);
                        *(u32x2*)(rowp + bj * (HALF / 2)) = w; } } }
    }
};
struct EpiScatterG {
    static constexpr bool PERM = true, AFTER_DRAIN = false;
    bf16_t* O;
    __device__ __forceinline__ void operator()(const f32x4 (&acc)[2][2][4][2], const UnitG& u, int wr, int wc, int fr, int fq) const {
#pragma unroll
        for (int ai = 0; ai < 2; ++ai)
#pragma unroll
            for (int m = 0; m < 4; ++m) { const int r = ai * HALF + wr * 64 + m * 16 + fr;
                if (r < u.cnt) { bf16_t* rowp = O + (size_t)u.ltab[r] * D + u.pn * BM + wc * 32 + 8 * fq;
#pragma unroll
                    for (int bj = 0; bj < 2; ++bj) { const f32x4 v0 = acc[ai][bj][m][0], v1 = acc[ai][bj][m][1];
                        u32x4 w; w.x = pk2(v0[0], v0[1]); w.y = pk2(v0[2], v0[3]); w.z = pk2(v1[0], v1[1]); w.w = pk2(v1[2], v1[3]);
                        *(u32x4*)(rowp + bj * HALF) = w; } } }
    }
};
template <class Epi, class Sched>
__device__ __forceinline__ void gemm_phase_g(int wv, PG8_LAS unsigned char* lds, const Gemm g, const Sched& S, const Epi& E) {
    const int tid = ltid(wv), wid = __builtin_amdgcn_readfirstlane(tid >> 6), lane = tid & 63, wr = wid >> 2, wc = wid & 3, fr = lane & 15, fq = lane >> 4;
    const int K = g.K, nt = K / BK;
    unsigned voffB[2];
#pragma unroll
    for (int i = 0; i < 2; ++i) { int R, C; stage_rc(tid * 16 + i * 8192, R, C); const int Rb = Epi::PERM ? ((R & ~31) + perm32(R & 31)) : R;
        voffB[i] = (unsigned)(Rb * K + C) * 2u; }
    const unsigned rowb = (unsigned)K * 2u;
#define PG8_AOFFS(u, dst) do { const int _t = ltid(wv); _Pragma("unroll") for (int _i = 0; _i < 2; ++_i) { int _R, _C; stage_rc(_t * 16 + _i * 8192, _R, _C); \
        _Pragma("unroll") for (int _h = 0; _h < 2; ++_h) dst[_h][_i] = (unsigned)((u).ltab[_h * HALF + _R] >> S.shift) * rowb + (unsigned)(_C * 2); } } while (0)
#define PG8_STAGE_A(bufoff, AO, koff) do { _Pragma("unroll") for (int _i = 0; _i < 2; ++_i) \
        __builtin_amdgcn_global_load_lds((const unsigned*)((const char*)g.A + (size_t)(AO)[_i] + (size_t)(koff)), (PG8_LAS unsigned*)(lds + (bufoff) + ldsw + _i * 8192), 16, 0, 0); } while (0)
    const size_t kstep = (size_t)(BK * 2);
    const size_t hstep = (size_t)HALF * K * 2;
    const size_t tstep = 2 * hstep;
    const unsigned ldsw = (unsigned)wid * 1024u;
    const int aoff = lds_byte(wr * 64 + fr, fq * 8), boff = lds_byte(wc * 32 + fr, fq * 8);
#define PG8_SA(b, h) (((b) * 2 + (h)) * HTB)
#define PG8_SB(b, h) ((4 + (b) * 2 + (h)) * HTB)
#define PG8_STAGE(bufoff, gbase, voff) do { _Pragma("unroll") for (int _i = 0; _i < 2; ++_i) \
        __builtin_amdgcn_global_load_lds((const unsigned*)((const char*)(gbase) + (voff)[_i]), (PG8_LAS unsigned*)(lds + (bufoff) + ldsw + _i * 8192), 16, 0, 0); } while (0)
#define PG8_LDA(dst, b, h) do { _Pragma("unroll") for (int m = 0; m < 4; ++m) _Pragma("unroll") for (int k = 0; k < 2; ++k) dst[m][k] = *(const PG8_LAS bf16x8*)(lds + PG8_SA(b, h) + aoff + m * 2048 + k * 1024); } while (0)
#define PG8_LDB(dst, b, h) do { _Pragma("unroll") for (int n = 0; n < 2; ++n) _Pragma("unroll") for (int k = 0; k < 2; ++k) dst[n][k] = *(const PG8_LAS bf16x8*)(lds + PG8_SB(b, h) + boff + n * 2048 + k * 1024); } while (0)
#define PG8_MMA(ai, bj, At, Bt) do { __builtin_amdgcn_s_setprio(1); _Pragma("unroll") for (int m = 0; m < 4; ++m) _Pragma("unroll") for (int n = 0; n < 2; ++n) _Pragma("unroll") for (int k = 0; k < 2; ++k) \
        acc[ai][bj][m][n] = __builtin_amdgcn_mfma_f32_16x16x32_bf16(Bt[n][k], At[m][k], acc[ai][bj][m][n], 0, 0, 0); __builtin_amdgcn_s_setprio(0); } while (0)
#define PG8_WAIT_V(n) asm volatile("s_waitcnt vmcnt(" #n ")" ::: "memory")
#define PG8_WAIT_L(n) asm volatile("s_waitcnt lgkmcnt(" #n ")" ::: "memory")
#define PG8_BAR __builtin_amdgcn_s_barrier()
#define PG8_SCHED __builtin_amdgcn_sched_barrier(0)
    UnitG cur, nxt; int ui = 0;
    if (!S.next(0, cur)) return;
    f32x4 acc[2][2][4][2];
#pragma unroll
    for (int a = 0; a < 2; ++a)
#pragma unroll
        for (int b = 0; b < 2; ++b)
#pragma unroll
            for (int m = 0; m < 4; ++m)
#pragma unroll
                for (int n = 0; n < 2; ++n) acc[a][b][m][n] = (f32x4){0.f, 0.f, 0.f, 0.f};
    bf16x8 At[4][2], B0[2][2], B1[2][2];
    unsigned ca[2][2]; PG8_AOFFS(cur, ca); const char* cB = cur.bbase + (size_t)cur.pn * tstep;
    S.a_ready(cur);
    PG8_STAGE(PG8_SB(0, 0), cB, voffB); PG8_STAGE_A(PG8_SA(0, 0), ca[0], 0); PG8_STAGE(PG8_SB(0, 1), cB + hstep, voffB); PG8_STAGE_A(PG8_SA(0, 1), ca[1], 0);
    if (wr == 1) PG8_BAR;
    PG8_WAIT_V(4); PG8_BAR;
    PG8_STAGE(PG8_SB(1, 0), cB + kstep, voffB); PG8_STAGE_A(PG8_SA(1, 0), ca[0], kstep); PG8_STAGE(PG8_SB(1, 1), cB + hstep + kstep, voffB);
    PG8_WAIT_V(6); PG8_BAR;
    for (;;) {
        const bool has_next = S.next(ui + 1, nxt);
        const char* nB = has_next ? nxt.bbase + (size_t)nxt.pn * tstep : cB;
        for (int t = 0; t < nt; t += 2) {
            const bool last = (t == nt - 2);
            const size_t k1 = (size_t)(t + 1) * kstep, k2 = last ? 0 : (size_t)(t + 2) * kstep;
            unsigned a2o[2][2];
            if (last && has_next) PG8_AOFFS(nxt, a2o); else { a2o[0][0] = ca[0][0]; a2o[0][1] = ca[0][1]; a2o[1][0] = ca[1][0]; a2o[1][1] = ca[1][1]; }
            const char* b2 = last ? nB : cB + (size_t)(t + 2) * kstep; const char* b3 = b2 + kstep;
            if (last && has_next) S.a_ready(nxt);
            PG8_LDB(B0, 0, 0); PG8_SCHED; PG8_LDA(At, 0, 0); PG8_STAGE_A(PG8_SA(1, 1), ca[1], k1);
            PG8_WAIT_L(8); PG8_BAR; PG8_WAIT_L(0); PG8_MMA(0, 0, At, B0); PG8_BAR; PG8_SCHED;
            PG8_LDB(B1, 0, 1); PG8_STAGE(PG8_SB(0, 0), b2, voffB);
            PG8_BAR; PG8_WAIT_L(0); PG8_MMA(0, 1, At, B1); PG8_BAR;
            PG8_LDA(At, 0, 1); PG8_STAGE_A(PG8_SA(0, 0), a2o[0], k2);
            PG8_BAR; PG8_WAIT_L(0); PG8_MMA(1, 0, At, B0); PG8_BAR; PG8_SCHED;
            PG8_STAGE(PG8_SB(0, 1), b2 + hstep, voffB);
            PG8_WAIT_V(6); PG8_BAR; PG8_MMA(1, 1, At, B1); PG8_BAR;
            PG8_LDB(B0, 1, 0); PG8_SCHED; PG8_LDA(At, 1, 0); PG8_STAGE_A(PG8_SA(0, 1), a2o[1], k2);
            PG8_WAIT_L(8); PG8_BAR; PG8_WAIT_L(0); PG8_MMA(0, 0, At, B0); PG8_BAR; PG8_SCHED;
            PG8_LDB(B1, 1, 1); PG8_STAGE(PG8_SB(1, 0), b3, voffB);
            PG8_BAR; PG8_WAIT_L(0); PG8_MMA(0, 1, At, B1); PG8_BAR;
            PG8_LDA(At, 1, 1); PG8_STAGE_A(PG8_SA(1, 0), a2o[0], k2 + kstep);
            PG8_BAR; PG8_WAIT_L(0); PG8_MMA(1, 0, At, B0); PG8_BAR; PG8_SCHED;
            PG8_STAGE(PG8_SB(1, 1), b3 + hstep, voffB);
            PG8_WAIT_V(6); PG8_BAR; PG8_MMA(1, 1, At, B1); PG8_BAR;
            if (last) { ca[0][0] = a2o[0][0]; ca[0][1] = a2o[0][1]; ca[1][0] = a2o[1][0]; ca[1][1] = a2o[1][1]; }
        }
            if constexpr (!Epi::AFTER_DRAIN) { E(acc, cur, wr, wc, fr, fq); S.done(cur); }
            if (!has_next) break;
#pragma unroll
        for (int a = 0; a < 2; ++a)
#pragma unroll
            for (int b = 0; b < 2; ++b)
#pragma unroll
                for (int m = 0; m < 4; ++m)
#pragma unroll
                    for (int n = 0; n < 2; ++n) acc[a][b][m][n] = (f32x4){0.f, 0.f, 0.f, 0.f};
        cur = nxt; cB = nB; ++ui;
    }
    PG8_WAIT_V(0);
    if (wr == 0) PG8_BAR;
    PG8_BAR;
    if constexpr (Epi::AFTER_DRAIN) { E.fused(acc, cur, wr, wc, fr, fq, lds, wid, lane); S.done(cur); }
#undef PG8_SA
#undef PG8_AOFFS
#undef PG8_STAGE_A
#undef PG8_SB
#undef PG8_STAGE
#undef PG8_LDA
#undef PG8_LDB
#undef PG8_MMA
#undef PG8_WAIT_V
#undef PG8_WAIT_L
#undef PG8_BAR
#undef PG8_SCHED
}
}

__device__ __forceinline__ void transpose_item(const float* __restrict__ W, int K, int N, bf16_t* __restrict__ WT, int mode, LAS float* scr, int item, int lane) {
    const int nblk = N / 32, kb = item / nblk, nb = item % nblk, k0 = 64 * kb, n0 = 32 * nb;
    {
        const float* wp = W + (size_t)(k0 + (lane >> 5)) * N + n0 + (lane & 31);
        float t[32];
#pragma unroll
        for (int i = 0; i < 32; ++i) t[i] = wp[(size_t)(2 * i) * N];
#pragma unroll
        for (int i = 0; i < 32; ++i) scr[(2 * i + (lane >> 5)) * 33 + (lane & 31)] = t[i];
    }
    asm volatile("s_waitcnt lgkmcnt(0)" ::: "memory");
    const int c = lane & 7;
#pragma unroll
    for (int j = 0; j < 4; ++j) {
        const int nl = (lane >> 3) + 8 * j; const LAS float* s = scr + (8 * c) * 33 + nl;
        u32x4 o; o.x = pk2(s[0 * 33], s[1 * 33]); o.y = pk2(s[2 * 33], s[3 * 33]); o.z = pk2(s[4 * 33], s[5 * 33]); o.w = pk2(s[6 * 33], s[7 * 33]);
        const int n = n0 + nl;
        const int nd = mode == 0 ? n : (32 * (n >> 4) + (n & 15) + (mode == 2 ? 16 : 0));
        *(u32x4*)(WT + (size_t)nd * K + k0 + 8 * c) = o;
    }
    asm volatile("s_waitcnt lgkmcnt(0)" ::: "memory");
}

constexpr int EXC_IG = 16 * 16, EXC_IDN = 8 * 32, EXC_PER = 2 * EXC_IG + EXC_IDN, EXC_ITEMS = NEXP * EXC_PER;
__device__ __forceinline__ int exc_s0(int layer) { return (layer & 1) ? 8192 : 10240; }
__device__ __forceinline__ int exc_s1(int layer) { return layer == DEPTH - 1 ? 0 : 7168; }
__device__ __forceinline__ void expconv_items(const CAS Params& P, int layer, LAS char* lds, int lo, int hi, int worker, int nworkers, int wid, int lane) {
    LAS float* scr = (LAS float*)(lds + wid * 8448);
    bf16_t* gu = (bf16_t*)(P.ws + WS_EXPGU); bf16_t* dw = (bf16_t*)(P.ws + WS_EXPD);
    for (int it = lo + worker; it < hi; it += nworkers) {
        const int e = it / EXC_PER; int r = it % EXC_PER;
        const size_t eo = (size_t)(layer * NEXP + e);
        if (r < EXC_IG) { transpose_item(P.exp_w_gate + eo * D * DEXP, D, DEXP, gu + (size_t)e * 1024 * 1024, 1, scr, r, lane); continue; } r -= EXC_IG;
        if (r < EXC_IG) { transpose_item(P.exp_w_up + eo * D * DEXP, D, DEXP, gu + (size_t)e * 1024 * 1024, 2, scr, r, lane); continue; } r -= EXC_IG;
        transpose_item(P.exp_w_down + eo * DEXP * D, DEXP, D, dw + (size_t)e * 1024 * 512, 0, scr, r, lane);
    }
}
__device__ __forceinline__ void expconv_tail(int wv, const CAS Params& P, int layer, LAS char* lds, int nwg, int lo, int hi) {
    const int G = gridDim.x, rem = nwg % G;
    if (rem != 0 && (int)blockIdx.x >= rem && lo < hi) {
        const int tid = ltid(wv);
        __syncthreads();
        expconv_items(P, layer, lds, lo, hi, ((int)blockIdx.x - rem) * 8 + (tid >> 6), (G - rem) * 8, tid >> 6, tid & 63);
    }
}

__device__ __forceinline__ void phase_prologue0(int wv, KP Pk, LAS char* lds) {
    asm volatile("" : "+s"(Pk));
    const CAS Params& P = *Pk;
    const int tid = ltid(wv), lane = tid & 63, wid = tid >> 6;
    const int gw = blockIdx.x * 8 + wid, NGW = gridDim.x * 8;
    LAS float* scr = (LAS float*)(lds + wid * 8448);
    bf16_t* winT = (bf16_t*)(P.ws + WS_WINT);
    bf16_t* woutT = (bf16_t*)(P.ws + WS_WOUTT);
    bf16_t* loraT = (bf16_t*)(P.ws + WS_LORAT);
    constexpr int I_EV = 16 * (P_EVEN / 32), I_OD = 16 * (P_ODD / 32), I_O = 16 * 32, I_L64 = 16, I_L128 = 32;
    constexpr int I_LORA = 3 * I_L64 + I_L128;
    constexpr int NIT = 2 * I_EV + 2 * I_OD + 4 * I_O + 2 * I_LORA;
    for (int it = gw; it < NIT; it += NGW) {
        int r = it;
        if (r < 2 * I_EV) { const int i = r / I_EV; transpose_item(P.ev_w_in + (size_t)i * D * P_EVEN, D, P_EVEN, winT + (i ? WINT_L2 : WINT_L0), 0, scr, r % I_EV, lane); continue; } r -= 2 * I_EV;
        if (r < 2 * I_OD) { const int i = r / I_OD; transpose_item(P.od_w_in + (size_t)i * D * P_ODD, D, P_ODD, winT + (i ? WINT_L3 : WINT_L1), 0, scr, r % I_OD, lane); continue; } r -= 2 * I_OD;
        if (r < 4 * I_O) { const int l = r / I_O; const float* src = (l & 1) ? P.od_w_out + (size_t)(l >> 1) * D * D : P.ev_w_out + (size_t)(l >> 1) * D * D;
            transpose_item(src, D, D, woutT + (size_t)l * D * D, 0, scr, r % I_O, lane); continue; } r -= 4 * I_O;
        { const int i = r / I_LORA; int q = r % I_LORA; bf16_t* dst = loraT + (size_t)i * LORA_PER;
          if (q < I_L64) { transpose_item(P.rw_w2 + (size_t)(i * 2 + 0) * 64 * 512, 64, 512, dst, 0, scr, q, lane); continue; } q -= I_L64;
          if (q < I_L64) { transpose_item(P.rw_w2 + (size_t)(i * 2 + 1) * 64 * 512, 64, 512, dst + 512 * 64, 0, scr, q, lane); continue; } q -= I_L64;
          if (q < I_L64) { transpose_item(P.rw_a2 + (size_t)i * 64 * 512, 64, 512, dst + 2 * 512 * 64, 0, scr, q, lane); continue; } q -= I_L64;
          transpose_item(P.rw_g2 + (size_t)i * 128 * 512, 128, 512, dst + 3 * 512 * 64, 0, scr, q, lane); }
    }
    {
        const int gt = blockIdx.x * NT + tid, NG = gridDim.x * NT;
        constexpr int PADE = (LDP_EVEN - P_EVEN) * D / 8, PADO = (LDP_ODD - P_ODD) * D / 8;
        for (int i = gt; i < 2 * PADE + 2 * PADO; i += NG) {
            int r = i; bf16_t* dst;
            if (r < 2 * PADE) { const int l = r / PADE; dst = winT + (l ? WINT_L2 : WINT_L0) + (size_t)P_EVEN * D + (size_t)(r % PADE) * 8; }
            else { r -= 2 * PADE; const int l = r / PADO; dst = winT + (l ? WINT_L3 : WINT_L1) + (size_t)P_ODD * D + (size_t)(r % PADO) * 8; }
            *(u32x4*)dst = (u32x4){0u, 0u, 0u, 0u};
        }
    }
    {
        const int gt = blockIdx.x * NT + tid, NG = gridDim.x * NT;
        float* lb = (float*)(P.ws + WS_LB);
        for (int ch = gt; ch < 512; ch += NG) {
            float lg[4], mx = -1e30f;
#pragma unroll
            for (int l = 0; l < 4; ++l) { lg[l] = P.hg_lb_logits[l * 512 + ch]; mx = fmaxf(mx, lg[l]); }
            float e[4], s = 0.f;
#pragma unroll
            for (int l = 0; l < 4; ++l) { e[l] = __expf(lg[l] - mx); s += e[l]; }
            float cum = 0.f;
#pragma unroll
            for (int l = 0; l < 4; ++l) { if (l > 0) cum += e[l] / s; lb[l * 512 + ch] = cum; }
        }
    }
    __syncthreads();
    {
        LAS float* sc = (LAS float*)lds;
        LAS float* red = (LAS float*)(lds + 5 * 1024 * 4);
        for (int i = tid; i < 5 * D; i += NT) { const int m = i >> 10, k = i & 1023; const float v = m < 4 ? P.c[m * D + k] : P.c_ctx[k]; sc[i] = siluf_(v); }
        __syncthreads();
        float* modv = (float*)(P.ws + WS_MODV);
        for (int cb = blockIdx.x; cb < 4 * 6144 / 96; cb += gridDim.x) {
            const int l = (cb * 96) / 6144, j0 = (cb * 96) % 6144;
            const int cg = tid % 24, kg = tid / 24;
            if (tid < 384) {
                const float* w = P.mod_w + (size_t)l * D * 6144 + (size_t)(kg * 64) * 6144 + j0 + 4 * cg;
                f32x4 a[5];
#pragma unroll
                for (int m = 0; m < 5; ++m) a[m] = (f32x4){0.f, 0.f, 0.f, 0.f};
#pragma unroll 1
                for (int k0 = 0; k0 < 64; k0 += 16) {
                    f32x4 wv4[16];
#pragma unroll
                    for (int u = 0; u < 16; ++u) wv4[u] = *(const f32x4*)(w + (size_t)(k0 + u) * 6144);
#pragma unroll
                    for (int u = 0; u < 16; ++u)
#pragma unroll
                        for (int m = 0; m < 5; ++m) a[m] += wv4[u] * sc[m * 1024 + kg * 64 + k0 + u];
                }
#pragma unroll
                for (int m = 0; m < 5; ++m) *(LAS f32x4*)(red + ((kg * 5 + m) * 96 + 4 * cg)) = a[m];
            }
            __syncthreads();
            if (tid < 480) {
                const int m = tid / 96, c = tid % 96;
                float sum = 0.f;
#pragma unroll
                for (int g = 0; g < 16; ++g) sum += red[(g * 5 + m) * 96 + c];
                modv[(size_t)(l * 5 + m) * 6144 + j0 + c] = sum + P.mod_b[l * 6144 + j0 + c];
            }
            __syncthreads();
        }
    }
}

__device__ __forceinline__ void phase_prologue1(int wv, KP Pk) {
    asm volatile("" : "+s"(Pk));
    const CAS Params& P = *Pk;
    const int tid = ltid(wv), lane = tid & 63, wid = tid >> 6;
    bf16_t* act = (bf16_t*)(P.ws + WS_ACT);
    f32x4 nv[4];
    auto fetch = [&](int rr) {
        const float* src = rr < NCTX ? P.ctx + (size_t)rr * D : P.x + (size_t)(rr - NCTX) * D;
#pragma unroll
        for (int i = 0; i < 4; ++i) nv[i] = *(const f32x4*)(src + 4 * lane + 256 * i);
    };
    const int stride = gridDim.x * 8;
    int r = blockIdx.x * 8 + wid;
    if (r < NROWS) fetch(r);
    for (; r < NROWS; r += stride) {
        const int m = row_mod(r);
        const f32x4 cv[4] = {nv[0], nv[1], nv[2], nv[3]};
        if (r + stride < NROWS) fetch(r + stride);
        const float* sh = modvec(P.ws, 0, m, 0); const float* sc = modvec(P.ws, 0, m, 1);
#pragma unroll
        for (int i = 0; i < 4; ++i) {
            const int c = 4 * lane + 256 * i;
            const f32x4 v = cv[i], s1 = *(const f32x4*)(sc + c), h1 = *(const f32x4*)(sh + c);
            u32x2 o; o.x = pk2(v[0] * (1.f + s1[0]) + h1[0], v[1] * (1.f + s1[1]) + h1[1]); o.y = pk2(v[2] * (1.f + s1[2]) + h1[2], v[3] * (1.f + s1[3]) + h1[3]);
            *(u32x2*)(act + (size_t)r * D + c) = o;
        }
    }
}

__device__ __forceinline__ void phase_inproj(int wv, KP Pk, int layer, LAS char* lds) {
    asm volatile("" : "+s"(Pk));
    const CAS Params& P = *Pk;
    const int odd = layer & 1, ldp = odd ? LDP_ODD : LDP_EVEN;
    const size_t woff = layer == 0 ? WINT_L0 : layer == 1 ? WINT_L1 : layer == 2 ? WINT_L2 : WINT_L3;
    pg8::Gemm g{(const bf16_t*)(P.ws + WS_ACT), (const bf16_t*)(P.ws + WS_WINT) + woff, NROWS, ldp, D};
    pg8::StaticOrder S; S.init(NROWS, ldp, (int)gridDim.x, (int)blockIdx.x);
    pg8::EpiStoreP E{(bf16_t*)(P.ws + WS_P), ldp};
    pg8::gemm_phase(wv, (PG8_LAS unsigned char*)lds, g, S, E);
    expconv_tail(wv, P, layer, lds, (NROWS / 256) * (ldp / 256), 0, exc_s0(layer));
}
__device__ __forceinline__ void phase_outproj(int wv, KP Pk, int layer, LAS char* lds) {
    asm volatile("" : "+s"(Pk));
    const CAS Params& P = *Pk;
    const int r0 = (layer == DEPTH - 1) ? NCTX : 0;
    pg8::Gemm g{(const bf16_t*)(P.ws + WS_FEAT) + (size_t)r0 * D, (const bf16_t*)(P.ws + WS_WOUTT) + (size_t)layer * D * D, NROWS - r0, D, D};
    pg8::StaticOrder S; S.init(NROWS - r0, D, (int)gridDim.x, (int)blockIdx.x);
    pg8::EpiStoreP E{(bf16_t*)(P.ws + WS_YO) + (size_t)r0 * D, D};
    pg8::gemm_phase(wv, (PG8_LAS unsigned char*)lds, g, S, E);
    expconv_tail(wv, P, layer, lds, ((NROWS - r0) / 256) * (D / 256), exc_s0(layer), exc_s0(layer) + exc_s1(layer));
}
__device__ __forceinline__ void phase_prep2(int wv, KP Pk, int layer, LAS char* lds) {
    asm volatile("" : "+s"(Pk));
    const CAS Params& P = *Pk;
    const int i = layer >> 1;
    const bf16_t* la = (const bf16_t*)(P.ws + WS_LA);
    const bf16_t* lt = (const bf16_t*)(P.ws + WS_LORAT) + (size_t)i * LORA_PER;
    constexpr int MT = NROWS / G_BM, NTL = 512 / G_BN;
    const int ntiles = 4 * MT * NTL;
    for (int t = blockIdx.x; t < ntiles; t += gridDim.x) {
        const int which = t / (MT * NTL), r = t % (MT * NTL), mt = r / NTL, nt = r % NTL;
        RowLinear rs{mt * G_BM};
        if (which < 2) {
            EpiDecay epi{(bf16_t*)(P.ws + WS_RWDEC) + (size_t)which * NROWS * 512, P.rw_w0 + (size_t)(i * 2 + which) * 512, mt * G_BM, nt * G_BN};
            gemm_tile(wv, la + which * 64, 320, rs, lt + (size_t)which * 512 * 64, 64, nt * G_BN, 64, epi, lds);
        } else if (which == 2) {
            EpiAK epi{(bf16_t*)(P.ws + WS_RWK), (const bf16_t*)(P.ws + WS_RWKK), (bf16_t*)(P.ws + WS_RWB), P.rw_a0 + i * 512, P.rw_k_a + i * 512, mt * G_BM, nt * G_BN};
            gemm_tile(wv, la + 128, 320, rs, lt + (size_t)2 * 512 * 64, 64, nt * G_BN, 64, epi, lds);
        } else {
            EpiStoreBf16 epi{(bf16_t*)(P.ws + WS_RWG), 512, mt * G_BM, nt * G_BN, 512};
            gemm_tile(wv, la + 192, 320, rs, lt + (size_t)3 * 512 * 64, 128, nt * G_BN, 128, epi, lds);
        }
    }
}
__device__ __forceinline__ void moe_tiles(int wv, const unsigned char* ws, int layer, LAS int* tstart, LAS int* tcnt) {
    const int tid = ltid(wv);
    if (tid < 64) {
        const int* cnt = (const int*)(ws + WS_CNT) + layer * 32 * CNT_STRIDE;
        const int c = tid < NEXP ? cnt[tid * CNT_STRIDE] : 0;
        int incl = (c + G_BM - 1) / G_BM;
#pragma unroll
        for (int o = 1; o < 32; o <<= 1) { const int t = __shfl_up(incl, o); if (tid >= o) incl += t; }
        if (tid < NEXP) { tcnt[tid] = c; tstart[tid] = incl - (c + G_BM - 1) / G_BM; }
        if (tid == NEXP - 1) tstart[NEXP] = incl;
    }
    __syncthreads();
}
__device__ __forceinline__ void phase_moe1(int wv, KP Pk, int layer, LAS char* lds) {
    asm volatile("" : "+s"(Pk));
    const CAS Params& P = *Pk;
    LAS int* tstart = (LAS int*)(lds + pg8::STAGE_BYTES); LAS int* tcnt = tstart + 40;
    moe_tiles(wv, P.ws, layer, tstart, tcnt);
    pg8::Gemm g{(const bf16_t*)(P.ws + WS_ACT), (const bf16_t*)(P.ws + WS_EXPGU), 0, 1024, D};
    LAS int* ltabs = tstart + 128;
    pg8::MoeOrder S{tstart, tcnt, ltabs, (const int*)(P.ws + WS_LIST), (const char*)(P.ws + WS_EXPGU), (size_t)1024 * 1024 * 2, 4, 1, (int)gridDim.x, (int)blockIdx.x};
    pg8::EpiSwiGLUG E{(bf16_t*)(P.ws + WS_HID)};
    for (int i = 0; i < 8; ++i) {
        pg8::UnitG u; if (!S.next(i, u)) break;
        const int tl = ltid(wv);
        const int* ul = (const int*)(P.ws + WS_LIST) + (size_t)u.e * LISTCAP + u.pm * pg8::BM;
        if (tl < pg8::BM) ltabs[i * pg8::BM + tl] = ul[tl < u.cnt ? tl : 0];
    }
    __syncthreads();
    pg8::gemm_phase_g(wv, (PG8_LAS unsigned char*)lds, g, S, E);
    __syncthreads();
}
__device__ __forceinline__ void phase_moe2(int wv, KP Pk, int layer, LAS char* lds) {
    asm volatile("" : "+s"(Pk));
    const CAS Params& P = *Pk;
    LAS int* tstart = (LAS int*)(lds + pg8::STAGE_BYTES); LAS int* tcnt = tstart + 40;
    moe_tiles(wv, P.ws, layer, tstart, tcnt);
    pg8::Gemm g{(const bf16_t*)(P.ws + WS_HID), (const bf16_t*)(P.ws + WS_EXPD), 0, 1024, DEXP};
    LAS int* ltabs = tstart + 128;
    pg8::MoeOrder S{tstart, tcnt, ltabs, (const int*)(P.ws + WS_LIST), (const char*)(P.ws + WS_EXPD), (size_t)1024 * 512 * 2, 4, 0, (int)gridDim.x, (int)blockIdx.x};
    pg8::EpiScatterG E{(bf16_t*)(P.ws + WS_YP)};
    for (int i = 0; i < 8; ++i) {
        pg8::UnitG u; if (!S.next(i, u)) break;
        const int tl = ltid(wv);
        const int* ul = (const int*)(P.ws + WS_LIST) + (size_t)u.e * LISTCAP + u.pm * pg8::BM;
        if (tl < pg8::BM) ltabs[i * pg8::BM + tl] = ul[tl < u.cnt ? tl : 0];
    }
    __syncthreads();
    pg8::gemm_phase_g(wv, (PG8_LAS unsigned char*)lds, g, S, E);
    __syncthreads();
}

constexpr int NCHUNK = NSTEPS / TCH;

constexpr int SSD_F = 32 + 64 + 64;
constexpr int SSD_BUF = TCH * SSD_F + 3 * TCH;

constexpr int ML_F = 64 + 64 + 32;
constexpr int ML_BUF = TCH * ML_F + 4 * TCH;

constexpr int HG_F = 128 + 128 + 32;
constexpr int HG_BUF = TCH * HG_F + TCH;

constexpr int RW_F = 5 * 64 + 32;
constexpr int RW_BUF = TCH * RW_F + TCH;
__device__ __forceinline__ void scan_rwkv_b(int wv, KP Pk, int layer, int unit, LAS char* lds) {
    asm volatile("" : "+s"(Pk));
    const CAS Params& P = *Pk;
    const int tid = ltid(wv);
    const int seq = unit >> 1, half = unit & 1, b = seq >> 4, h = (seq >> 1) & 7, dir = seq & 1;
    LAS float* bufs = (LAS float*)lds;
    bf16_t* Y = (bf16_t*)(P.ws + (dir ? WS_YB : WS_YF));
    const bf16_t* dec = (const bf16_t*)(P.ws + WS_RWDEC) + (size_t)dir * NROWS * 512;
    constexpr int NS = 6, NG = 44;
    const int stid = tid - 256;
    int tj[NS], tg_[NS]; bool tv[NS]; const unsigned char* tbase[NS]; int tlds[NS];
#pragma unroll
    for (int s = 0; s < NS; ++s) {
        const int task = stid + 256 * s; tv[s] = stid >= 0 && task < TCH * NG; tj[s] = task / NG; tg_[s] = task % NG;
        const int g = tg_[s];
        if (g < 8)       { tbase[s] = P.ws + WS_RWR  + (size_t)(h * 64 + 8 * g) * 2;              tlds[s] = 256 + 8 * g; }
        else if (g < 16) { tbase[s] = P.ws + WS_RWK  + (size_t)(h * 64 + 8 * (g - 8)) * 2;        tlds[s] = 192 + 8 * (g - 8); }
        else if (g < 24) { tbase[s] = P.ws + WS_RWKK + (size_t)(h * 64 + 8 * (g - 16)) * 2;       tlds[s] = 64 + 8 * (g - 16); }
        else if (g < 32) { tbase[s] = P.ws + WS_RWB  + (size_t)(h * 64 + 8 * (g - 24)) * 2;       tlds[s] = 128 + 8 * (g - 24); }
        else if (g < 36) { tbase[s] = P.ws + WS_RWV  + (size_t)(h * 64 + half * 32 + 8 * (g - 32)) * 2; tlds[s] = 320 + 8 * (g - 32); }
        else             { tbase[s] = (const unsigned char*)(dec + h * 64 + 8 * (g - 36));        tlds[s] = 8 * (g - 36); }
    }
    u32x4 rc[NS]; int rrow = 0;
    auto load = [&](int c) {
#pragma unroll
        for (int s = 0; s < NS; ++s) {
            rc[s] = (u32x4){0u, 0u, 0u, 0u};
            if (tv[s]) { const int row = scan_row(c * TCH + tj[s], b, dir, 1); rc[s] = *(const u32x4*)(tbase[s] + (size_t)row * 1024); }
        }
        if (stid >= 0 && stid < TCH) rrow = scan_row(c * TCH + stid, b, dir, 1);
    };
    auto store = [&](int c) {
        LAS float* buf = bufs + (c & 1) * RW_BUF;
#pragma unroll
        for (int s = 0; s < NS; ++s) {
            if (tv[s]) {
                LAS float* dst = buf + tj[s] * RW_F + tlds[s];
                const int g = tg_[s];
                if (g >= 36) {
                    float f[8]; unpack8(rc[s], f);
                    *(LAS f32x4*)dst = (f32x4){__expf(-f[0]), __expf(-f[1]), __expf(-f[2]), __expf(-f[3])}; *(LAS f32x4*)(dst + 4) = (f32x4){__expf(-f[4]), __expf(-f[5]), __expf(-f[6]), __expf(-f[7])};
                } else {
                    float f[8]; unpack8(rc[s], f);
                    const float sg = (g >= 16 && g < 24) ? -1.f : 1.f;
                    *(LAS f32x4*)dst = (f32x4){sg * f[0], sg * f[1], sg * f[2], sg * f[3]}; *(LAS f32x4*)(dst + 4) = (f32x4){sg * f[4], sg * f[5], sg * f[6], sg * f[7]};
                }
            }
        }
        if (stid >= 0 && stid < TCH) ((LAS int*)buf)[TCH * RW_F + stid] = rrow;
    };
    const int q = tid & 15, vr = (tid >> 4) & 3, rowA = 8 * wv + vr, rowB = rowA + 4;
    f32x2 A01 = {0.f, 0.f}, A23 = {0.f, 0.f}, B01 = {0.f, 0.f}, B23 = {0.f, 0.f};
    LAS float* ypw = bufs + 2 * RW_BUF + (wv & 3) * (2 * 16 * 132);
    int prow = -1, gpar = 0;
    if (wv >= 4) { load(0); store(0); }
    __syncthreads();
    for (int c = 0; c < NCHUNK; ++c) {
        if (wv >= 4 && c + 1 < NCHUNK) load(c + 1);
        LAS float* buf = bufs + (c & 1) * RW_BUF;
        if (wv < 4) {
            const LAS float* wp = buf + 4 * q;
            const LAS float* vpA = buf + 320 + rowA; const LAS float* vpB = buf + 320 + rowB;
            f32x4 w4 = *(const LAS f32x4*)wp, a4 = *(const LAS f32x4*)(wp + 64), b4 = *(const LAS f32x4*)(wp + 128), k4 = *(const LAS f32x4*)(wp + 192), r4 = *(const LAS f32x4*)(wp + 256); float vrA = vpA[0], vrB = vpB[0];
#pragma unroll 1
            for (int jh = 0; jh < 2; ++jh) {
                const LAS float* rp = ypw + (gpar ^ 1) * (16 * 132) + q * 132 + vr * 16;
                const f32x4 pa0 = *(const LAS f32x4*)rp, pa1 = *(const LAS f32x4*)(rp + 4), pa2 = *(const LAS f32x4*)(rp + 8), pa3 = *(const LAS f32x4*)(rp + 12);
                const f32x4 pb0 = *(const LAS f32x4*)(rp + 64), pb1 = *(const LAS f32x4*)(rp + 68), pb2 = *(const LAS f32x4*)(rp + 72), pb3 = *(const LAS f32x4*)(rp + 76);
                LAS float* wpz = ypw + gpar * (16 * 132) + (tid & 63);
#pragma unroll
                for (int j = 0; j < 16; ++j) {
                    const int jj = jh * 16 + j;
                    const f32x4 wc = w4, ac = a4, bc = b4, kc = k4, rc = r4; const float vvA = vrA, vvB = vrB;
                    if (j < 15 || jh == 0) {
                        const LAS float* np = wp + (jj + 1) * RW_F;
                        w4 = *(const LAS f32x4*)np; a4 = *(const LAS f32x4*)(np + 64); b4 = *(const LAS f32x4*)(np + 128); k4 = *(const LAS f32x4*)(np + 192); r4 = *(const LAS f32x4*)(np + 256);
                        vrA = vpA[(jj + 1) * RW_F]; vrB = vpB[(jj + 1) * RW_F];
                    }
                    const f32x2 a01 = {ac[0], ac[1]}, a23 = {ac[2], ac[3]}, w01 = {wc[0], wc[1]}, w23 = {wc[2], wc[3]}, b01 = {bc[0], bc[1]}, b23 = {bc[2], bc[3]};
                    const f32x2 k01 = {kc[0], kc[1]}, k23 = {kc[2], kc[3]}, r01 = {rc[0], rc[1]}, r23 = {rc[2], rc[3]}, va2 = {vvA, vvA}, vb2 = {vvB, vvB};
                    f32x2 tA = A01 * a01; tA = A23 * a23 + tA;
                    f32x2 tB = B01 * a01; tB = B23 * a23 + tB;
                    const f32x2 uA01 = A01 * w01 + va2 * k01, uA23 = A23 * w23 + va2 * k23, uB01 = B01 * w01 + vb2 * k01, uB23 = B23 * w23 + vb2 * k23;
                    const float saA = allreduce16(tA.x + tA.y), saB = allreduce16(tB.x + tB.y);
                    const f32x2 sA2 = {saA, saA}, sB2 = {saB, saB};
                    A01 = sA2 * b01 + uA01; A23 = sA2 * b23 + uA23; B01 = sB2 * b01 + uB01; B23 = sB2 * b23 + uB23;
                    f32x2 yA = A01 * r01; yA = A23 * r23 + yA;
                    f32x2 yB = B01 * r01; yB = B23 * r23 + yB;
                    wpz[j * 132] = yA.x + yA.y; wpz[j * 132 + 64] = yB.x + yB.y;
                }
                if (prow >= 0) {
                    const f32x4 ta = (pa0 + pa1) + (pa2 + pa3), tb = (pb0 + pb1) + (pb2 + pb3);
                    bf16_t* yo = Y + (size_t)prow * D + 512 + h * 64 + half * 32;
                    yo[rowA] = f2bf((ta[0] + ta[1]) + (ta[2] + ta[3])); yo[rowB] = f2bf((tb[0] + tb[1]) + (tb[2] + tb[3]));
                }
                prow = ((const LAS int*)buf)[TCH * RW_F + jh * 16 + q];
                gpar ^= 1;
            }
        }
        if (wv >= 4 && c + 1 < NCHUNK) store(c + 1);
        __syncthreads();
    }
    if (wv < 4) {
        const LAS float* rp = ypw + (gpar ^ 1) * (16 * 132) + q * 132 + vr * 16;
        const f32x4 ta = (*(const LAS f32x4*)rp + *(const LAS f32x4*)(rp + 4)) + (*(const LAS f32x4*)(rp + 8) + *(const LAS f32x4*)(rp + 12));
        const f32x4 tb = (*(const LAS f32x4*)(rp + 64) + *(const LAS f32x4*)(rp + 68)) + (*(const LAS f32x4*)(rp + 72) + *(const LAS f32x4*)(rp + 76));
        bf16_t* yo = Y + (size_t)prow * D + 512 + h * 64 + half * 32;
        yo[rowA] = f2bf((ta[0] + ta[1]) + (ta[2] + ta[3])); yo[rowB] = f2bf((tb[0] + tb[1]) + (tb[2] + tb[3]));
    }
}

constexpr size_t WS_EXBC = WS_RWR;
constexpr size_t WS_EQK = WS_EXBC + (size_t)NROWS * 768 * 2;
constexpr size_t WS_EGT = WS_EQK + (size_t)NROWS * 512 * 2;
static_assert(WS_EGT + (size_t)NROWS * 32 * 4 <= WS_LA, "even-layer prepare buffers must fit in the RWKV region");

__device__ __forceinline__ void phase_prep_even(int wv, KP Pk, int layer) {
    asm volatile("" : "+s"(Pk));
    const CAS Params& P = *Pk;
    const int tid = ltid(wv), lane = tid & 63, wid = tid >> 6, i_ = layer >> 1;
    const bf16_t* Pb = (const bf16_t*)(P.ws + WS_P);
    bf16_t* XBC = (bf16_t*)(P.ws + WS_EXBC); bf16_t* QK = (bf16_t*)(P.ws + WS_EQK); float* GT = (float*)(P.ws + WS_EGT);
    float cw0[4][8], cw1[4][8], cwq[4][8];
#pragma unroll
    for (int e = 0; e < 8; ++e) {
#pragma unroll
        for (int t = 0; t < 3; ++t) {
            cw0[t][e] = P.ssd_conv_w[(size_t)(i_ * 3 + t) * 768 + 8 * lane + e];
            cw1[t][e] = P.ssd_conv_w[(size_t)(i_ * 3 + t) * 768 + 512 + 8 * (lane & 31) + e];
            cwq[t][e] = P.ml_conv_w[(size_t)(i_ * 3 + t) * 512 + 8 * lane + e];
        }
        cw0[3][e] = P.ssd_conv_b[i_ * 768 + 8 * lane + e]; cw1[3][e] = P.ssd_conv_b[i_ * 768 + 512 + 8 * (lane & 31) + e]; cwq[3][e] = P.ml_conv_b[i_ * 512 + 8 * lane + e];
    }
    float gbias = 0.f;
    if (lane < 16) gbias = P.ssd_dt_bias[i_ * 16 + lane]; else if (lane < 24) gbias = P.ml_i_bias[i_ * 8 + lane - 16]; else if (lane < 32) gbias = P.ml_f_bias[i_ * 8 + lane - 24];
    const float qscl = lane < 32 ? 0.125f : 1.f;
    const u32x4 zero = (u32x4){0u, 0u, 0u, 0u};
    u32x4 nA[3], nB[3], nC[3]; bf16_t ng = 0;
    auto fetch = [&](int rr) {
        int t, len; row_seg(rr, t, len);
        const bf16_t* pr = Pb + (size_t)rr * LDP_EVEN;
        const bool hp = t > 0, hn = t < len - 1;
        { const int col = 512 + 8 * lane; nA[0] = *(const u32x4*)(pr + col); nA[1] = hp ? *(const u32x4*)(pr - LDP_EVEN + col) : zero; nA[2] = hn ? *(const u32x4*)(pr + LDP_EVEN + col) : zero; }
        if (lane < 32) { const int col = 1024 + 8 * lane; nB[0] = *(const u32x4*)(pr + col); nB[1] = hp ? *(const u32x4*)(pr - LDP_EVEN + col) : zero; nB[2] = hn ? *(const u32x4*)(pr + LDP_EVEN + col) : zero; }
        { const int col = 1296 + 8 * lane; nC[0] = *(const u32x4*)(pr + col); nC[1] = hp ? *(const u32x4*)(pr - LDP_EVEN + col) : zero; nC[2] = hn ? *(const u32x4*)(pr + LDP_EVEN + col) : zero; }
        if (lane < 32) ng = pr[lane < 16 ? 1280 + lane : 2832 + (lane - 16)];
    };
    nB[0] = nB[1] = nB[2] = zero;
    const int stride = gridDim.x * 8;
    int r = blockIdx.x * 8 + wid;
    if (r < NROWS) fetch(r);
    for (; r < NROWS; r += stride) {
        const u32x4 cA0 = nA[0], cA1 = nA[1], cA2 = nA[2], cB0 = nB[0], cB1 = nB[1], cB2 = nB[2], cC0 = nC[0], cC1 = nC[1], cC2 = nC[2]; const bf16_t cg = ng;
        if (r + stride < NROWS) fetch(r + stride);
        float fc[8], fp[8], fn[8], o[8];
        {
            unpack8(cA0, fc); unpack8(cA1, fp); unpack8(cA2, fn);
#pragma unroll
            for (int e = 0; e < 8; ++e) o[e] = siluf_(cw0[0][e] * fp[e] + cw0[1][e] * fc[e] + cw0[2][e] * fn[e] + cw0[3][e]);
            *(u32x4*)(XBC + (size_t)r * 768 + 8 * lane) = pack8(o);
        }
        if (lane < 32) {
            unpack8(cB0, fc); unpack8(cB1, fp); unpack8(cB2, fn);
#pragma unroll
            for (int e = 0; e < 8; ++e) o[e] = siluf_(cw1[0][e] * fp[e] + cw1[1][e] * fc[e] + cw1[2][e] * fn[e] + cw1[3][e]);
            *(u32x4*)(XBC + (size_t)r * 768 + 512 + 8 * lane) = pack8(o);
        }
        {
            unpack8(cC0, fc); unpack8(cC1, fp); unpack8(cC2, fn);
#pragma unroll
            for (int e = 0; e < 8; ++e) o[e] = qscl * siluf_(cwq[0][e] * fp[e] + cwq[1][e] * fc[e] + cwq[2][e] * fn[e] + cwq[3][e]);
            *(u32x4*)(QK + (size_t)r * 512 + 8 * lane) = pack8(o);
        }
        if (lane < 32) {
            const float x = bf2f(cg) + gbias;
            GT[(size_t)r * 32 + lane] = lane < 16 ? softplusf_(x) : lane < 24 ? x : logsigmoidf_(x);
        }
    }
}

constexpr int CL = 64, NCH64 = NSTEPS / CL, LDT = 72, LDTB = LDT * 2;
__device__ __forceinline__ bf16x8 ldfrag(const LAS char* tile, int ldb, int row0, int k0, int lane) {
    return *(const LAS bf16x8*)(tile + (row0 + (lane & 15)) * ldb + (k0 + 8 * (lane >> 4)) * 2);
}
typedef short s16x4 __attribute__((ext_vector_type(4)));
constexpr int LDV = 272;
__device__ __forceinline__ bf16x8 ldfrag_tr(const LAS char* tile, int rowb, int c0, int k0, int lane) {
    const int i = lane & 15;
    const LAS char* p = tile + (k0 + 8 * (lane >> 4) + (i >> 2)) * rowb + (c0 + 4 * (i & 3)) * 2;
    const s16x4 lo = __builtin_amdgcn_ds_read_tr16_b64_v4i16((LAS s16x4*)p);
    const s16x4 hi = __builtin_amdgcn_ds_read_tr16_b64_v4i16((LAS s16x4*)(p + 4 * rowb));
    return (bf16x8){lo[0], lo[1], lo[2], lo[3], hi[0], hi[1], hi[2], hi[3]};
}
__device__ __forceinline__ void st4bf(LAS char* p, const f32x4& v) { u32x2 o; o.x = pk2(v[0], v[1]); o.y = pk2(v[2], v[3]); *(LAS u32x2*)p = o; }

constexpr int SS_BT = 0, SS_CT = SS_BT + 64 * LDTB, SS_BDT = SS_CT + 64 * LDTB, SS_XT = SS_BDT + 64 * LDTB, SS_CUM = SS_XT + 32 * LDTB, SS_DTV = SS_CUM + 256, SS_ROWS = SS_DTV + 256, SS_STG = SS_ROWS + 256;
constexpr int SS_M = 2 * SS_STG, SS_HB = SS_M + 64 * LDTB, SS_END = SS_HB + 32 * LDTB;
static_assert(SS_END <= LDS_BYTES - 16, "SSD LDS map");

constexpr int MS_QT = 0, MS_KT = MS_QT + 64 * LDTB, MS_KET = MS_KT + 64 * LDTB, MS_VT = MS_KET + 64 * LDTB, MS_SC = MS_VT + 32 * LDTB;
constexpr int MS_STG = MS_SC + 8 * 256;
constexpr int MS_W = 2 * MS_STG, MS_CB = MS_W + 64 * LDTB, MS_ONE = MS_CB + 32 * LDTB, MS_NV = MS_ONE + 16 * LDTB, MS_QN = MS_NV + 256, MS_END = MS_QN + 256;
static_assert(MS_END <= LDS_BYTES - 16, "mLSTM LDS map");

constexpr size_t WS_XSS = WS_EGT + al256((size_t)NROWS * 32 * 4);
constexpr size_t XSS_BYTES = (size_t)64 * NCH64 * 64 * 64 * 2;
constexpr size_t WS_XSD = WS_XSS + XSS_BYTES;
constexpr size_t WS_XMC = WS_XSD + al256((size_t)64 * NCH64 * 4);
constexpr size_t XMC_BYTES = (size_t)32 * NCH64 * 128 * 64 * 2;
constexpr size_t WS_XMN = WS_XMC + XMC_BYTES;
constexpr size_t WS_XMS = WS_XMN + (size_t)32 * NCH64 * 64 * 4;
constexpr size_t WS_XMT = WS_XMS + al256((size_t)32 * NCH64 * 4 * 4);
constexpr size_t WS_XEND = WS_XMT + (size_t)32 * NCH64 * 3 * 64 * 4;
static_assert(WS_XEND <= WS_END, "even-layer chunk-state buffers must fit in the RWKV region");
constexpr int NSSD_ITEMS = 64 * NCH64, NML_ITEMS = 32 * NCH64;

template <int CTRL, int RM, int BM> __device__ __forceinline__ float dppx(float old, float v) {
    return __builtin_bit_cast(float, __builtin_amdgcn_update_dpp(__builtin_bit_cast(int, old), __builtin_bit_cast(int, v), CTRL, RM, BM, false));
}
__device__ __forceinline__ float wave_cumsum(float v, int) {
    float t = v;
    t += dppx<0x111, 0xf, 0xf>(0.f, v); t += dppx<0x112, 0xf, 0xf>(0.f, v); t += dppx<0x113, 0xf, 0xf>(0.f, v);
    { const float u = dppx<0x114, 0xf, 0xe>(0.f, t); t += u; }
    { const float u = dppx<0x118, 0xf, 0xc>(0.f, t); t += u; }
    { const float u = dppx<0x142, 0xa, 0xf>(0.f, t); t += u; }
    { const float u = dppx<0x143, 0xc, 0xf>(0.f, t); t += u; }
    return t;
}
__device__ __forceinline__ float wave_cummax(float v, int) {
    const float ninf = -__builtin_huge_valf();
    float t = v;
    t = fmaxf(t, dppx<0x111, 0xf, 0xf>(ninf, v)); t = fmaxf(t, dppx<0x112, 0xf, 0xf>(ninf, v)); t = fmaxf(t, dppx<0x113, 0xf, 0xf>(ninf, v));
    { const float u = dppx<0x114, 0xf, 0xe>(ninf, t); t = fmaxf(t, u); }
    { const float u = dppx<0x118, 0xf, 0xc>(ninf, t); t = fmaxf(t, u); }
    { const float u = dppx<0x142, 0xa, 0xf>(ninf, t); t = fmaxf(t, u); }
    { const float u = dppx<0x143, 0xc, 0xf>(ninf, t); t = fmaxf(t, u); }
    return t;
}
__device__ __forceinline__ float wave_max(float v) {
    const float t = wave_cummax(v, 0);
    return __builtin_bit_cast(float, __builtin_amdgcn_readlane(__builtin_bit_cast(int, t), 63));
}

constexpr int X1S_BDT = 0, X1S_XT = X1S_BDT + 64 * LDTB, X1S_CUM = X1S_XT + 64 * LDTB, X1S_DTV = X1S_CUM + 256, X1S_END = X1S_DTV + 256;
constexpr int X1M_KET = 0, X1M_VT = X1M_KET + 64 * LDTB, X1M_ONE = X1M_VT + 64 * LDV, X1M_EE = X1M_ONE + 16 * LDTB, X1M_END = X1M_EE + 256;
__device__ __forceinline__ void phase_ex1(int wv, KP Pk, int layer, LAS char* lds) {
    asm volatile("" : "+s"(Pk));
    const CAS Params& P = *Pk;
    const int tid = ltid(wv), lane = tid & 63, wid = tid >> 6, q = lane >> 4, r16 = lane & 15, i_ = layer >> 1;
    const bf16_t* XBC = (const bf16_t*)(P.ws + WS_EXBC); const bf16_t* QK = (const bf16_t*)(P.ws + WS_EQK); const bf16_t* Pb = (const bf16_t*)(P.ws + WS_P);
    const float* GT = (const float*)(P.ws + WS_EGT);
    {
        bf16_t* Hst = (bf16_t*)(P.ws + WS_XSS); float* Dst = (float*)(P.ws + WS_XSD);
        struct Set { u32x4 rc[2]; float rdt; }; Set SA, SB; SA.rdt = SB.rdt = 0.f;
        auto geom = [&](int it, int& b, int& h, int& dir, int& c) { const int sq = it / NCH64; c = it - sq * NCH64; b = sq >> 4; h = (sq >> 1) & 7; dir = sq & 1; };
        auto load = [&](int it, Set& S) {
            int b, h, dir, c; geom(it, b, h, dir, c);
            int tl = tid; asm volatile("" : "+v"(tl));
#pragma unroll
            for (int s = 0; s < 2; ++s) {
                const int task = tl + NT * s, j = task >> 4, g = task & 15;
                const int row = scan_row(c * CL + j, b, dir, 0);
                S.rc[s] = *(const u32x4*)(XBC + (size_t)row * 768 + (g < 8 ? h * 64 + 8 * g : 512 + (h >> 2) * 64 + 8 * (g - 8)));
            }
            if (tl < CL) { const int row = scan_row(c * CL + tl, b, dir, 0); S.rdt = GT[(size_t)row * 32 + dir * 8 + h]; }
        };
        auto item = [&](int it, Set& S, int nxt) {
            int b, h, dir, c; geom(it, b, h, dir, c);
            const float aco = -__expf(P.ssd_a_log[(i_ * 2 + dir) * 8 + h]);
            if (tid < CL) {
                const float cum = wave_cumsum(S.rdt * aco, lane);
                ((LAS float*)(lds + X1S_CUM))[tid] = cum; ((LAS float*)(lds + X1S_DTV))[tid] = S.rdt;
            }
            __syncthreads();
            {
                const LAS float* cum = (const LAS float*)(lds + X1S_CUM);
                const float cumL = cum[CL - 1];
                int tl = tid; asm volatile("" : "+v"(tl));
#pragma unroll
                for (int s = 0; s < 2; ++s) {
                    const int task = tl + NT * s, j = task >> 4, g = task & 15;
                    float f[8]; unpack8(S.rc[s], f);
                    if (g < 8) {
                        const float dt = ((const LAS float*)(lds + X1S_DTV))[j];
#pragma unroll
                        for (int e = 0; e < 8; ++e) f[e] *= dt;
                        *(LAS u32x4*)(lds + X1S_XT + j * LDTB + 16 * g) = pack8(f);
                    } else {
                        const float sc = __expf(cumL - cum[j]);
#pragma unroll
                        for (int e = 0; e < 8; ++e) f[e] *= sc;
                        *(LAS u32x4*)(lds + X1S_BDT + j * LDTB + 16 * (g - 8)) = pack8(f);
                    }
                }
                if (tid == 0) Dst[it] = __expf(cumL);
            }
            if (nxt < NSSD_ITEMS) load(nxt, S);
            __syncthreads();
            {
                const int pt = wid >> 1;
#pragma unroll
                for (int u = 0; u < 2; ++u) {
                    const int nt = (wid & 1) * 2 + u;
                    f32x4 sa = (f32x4){0.f, 0.f, 0.f, 0.f};
#pragma unroll
                    for (int k0 = 0; k0 < 64; k0 += 32) sa = __builtin_amdgcn_mfma_f32_16x16x32_bf16(ldfrag_tr(lds + X1S_BDT, LDTB, nt * 16, k0, lane), ldfrag_tr(lds + X1S_XT, LDTB, pt * 16, k0, lane), sa, 0, 0, 0);
                    u32x2 o; o.x = pk2(sa[0], sa[1]); o.y = pk2(sa[2], sa[3]);
                    *(u32x2*)(Hst + ((size_t)it * 64 + pt * 16 + r16) * 64 + nt * 16 + 4 * q) = o;
                }
            }
            __syncthreads();
        };
        {
            const int G = gridDim.x; int it = blockIdx.x;
            if (it < NSSD_ITEMS) load(it, SA);
            if (it + G < NSSD_ITEMS) load(it + G, SB);
            for (; it < NSSD_ITEMS; it += 2 * G) {
                item(it, SA, it + 2 * G);
                if (it + G < NSSD_ITEMS) item(it + G, SB, it + 3 * G);
            }
        }
    }
    {
        bf16_t* Cst = (bf16_t*)(P.ws + WS_XMC); float* Nst = (float*)(P.ws + WS_XMN); float* Sst = (float*)(P.ws + WS_XMS); float* Tst = (float*)(P.ws + WS_XMT);
        for (int i = tid; i < 16 * LDTB / 4; i += NT) ((LAS unsigned*)(lds + X1M_ONE))[i] = 0x3f803f80u;
        struct Set { u32x4 rc[3]; float rli, rlf; }; Set SA, SB; SA.rli = SA.rlf = SB.rli = SB.rlf = 0.f;
        auto geom = [&](int it, int& b, int& h, int& dir, int& c) { const int sq = it / NCH64; c = it - sq * NCH64; b = sq >> 3; h = (sq >> 1) & 3; dir = sq & 1; };
        auto load = [&](int it, Set& S) {
            int b, h, dir, c; geom(it, b, h, dir, c);
            int tl = tid; asm volatile("" : "+v"(tl));
#pragma unroll
            for (int s = 0; s < 3; ++s) {
                const int task = tl + NT * s, j = task / 24, g = task - 24 * j;
                const int row = scan_row(c * CL + j, b, dir, 0);
                S.rc[s] = g < 8 ? *(const u32x4*)(QK + (size_t)row * 512 + 256 + h * 64 + 8 * g) : *(const u32x4*)(Pb + (size_t)row * LDP_EVEN + 1808 + h * 128 + 8 * (g - 8));
            }
            if (tl < CL) { const int row = scan_row(c * CL + tl, b, dir, 0); S.rli = GT[(size_t)row * 32 + 16 + dir * 4 + h]; S.rlf = GT[(size_t)row * 32 + 24 + dir * 4 + h]; }
        };
        auto item = [&](int it, Set& S, int nxt) {
            if (tid < CL) {
                const float fcum = wave_cumsum(S.rlf, lane);
                const float ftot = __builtin_bit_cast(float, __builtin_amdgcn_readlane(__builtin_bit_cast(int, fcum), 63));
                const float g = S.rli - fcum, pm = wave_cummax(g, lane);
                const float wend = ftot + g, mloc = wave_max(wend);
                ((LAS float*)(lds + X1M_EE))[tid] = __expf(wend - mloc);
                float* tp = Tst + (size_t)it * 192;
                tp[tid] = fcum; tp[64 + tid] = g; tp[128 + tid] = pm;
                if (tid == 0) { Sst[(size_t)it * 4 + 0] = ftot; Sst[(size_t)it * 4 + 1] = mloc; }
            }
            __syncthreads();
            {
                const LAS float* ee = (const LAS float*)(lds + X1M_EE);
                int tl = tid; asm volatile("" : "+v"(tl));
#pragma unroll
                for (int s = 0; s < 3; ++s) {
                    const int task = tl + NT * s, j = task / 24, g = task - 24 * j;
                    if (g < 8) {
                        float f[8]; unpack8(S.rc[s], f);
                        const float e1 = ee[j];
#pragma unroll
                        for (int e = 0; e < 8; ++e) f[e] *= e1;
                        *(LAS u32x4*)(lds + X1M_KET + j * LDTB + 16 * g) = pack8(f);
                    } else {
                        const int v0 = 8 * (g - 8);
#pragma unroll
                        for (int e = 0; e < 1; ++e) *(LAS u32x4*)(lds + X1M_VT + j * LDV + v0 * 2) = S.rc[s];
                    }
                }
            }
            if (nxt < NML_ITEMS) load(nxt, S);
            __syncthreads();
            {
                const bf16x8 vf0 = ldfrag_tr(lds + X1M_VT, LDV, wid * 16, 0, lane), vf1 = ldfrag_tr(lds + X1M_VT, LDV, wid * 16, 32, lane);
#pragma unroll
                for (int kt = 0; kt < 4; ++kt) {
                    f32x4 sa = __builtin_amdgcn_mfma_f32_16x16x32_bf16(ldfrag_tr(lds + X1M_KET, LDTB, kt * 16, 0, lane), vf0, (f32x4){0.f, 0.f, 0.f, 0.f}, 0, 0, 0);
                    sa = __builtin_amdgcn_mfma_f32_16x16x32_bf16(ldfrag_tr(lds + X1M_KET, LDTB, kt * 16, 32, lane), vf1, sa, 0, 0, 0);
                    u32x2 o; o.x = pk2(sa[0], sa[1]); o.y = pk2(sa[2], sa[3]);
                    *(u32x2*)(Cst + ((size_t)it * 128 + wid * 16 + r16) * 64 + kt * 16 + 4 * q) = o;
                }
                if (wid < 4) {
                    f32x4 na = __builtin_amdgcn_mfma_f32_16x16x32_bf16(ldfrag_tr(lds + X1M_KET, LDTB, wid * 16, 0, lane), ldfrag(lds + X1M_ONE, LDTB, 0, 0, lane), (f32x4){0.f, 0.f, 0.f, 0.f}, 0, 0, 0);
                    na = __builtin_amdgcn_mfma_f32_16x16x32_bf16(ldfrag_tr(lds + X1M_KET, LDTB, wid * 16, 32, lane), ldfrag(lds + X1M_ONE, LDTB, 0, 32, lane), na, 0, 0, 0);
                    if (r16 == 0) *(f32x4*)(Nst + (size_t)it * 64 + wid * 16 + 4 * q) = na;
                }
            }
            __syncthreads();
        };
        {
            const int G = gridDim.x; int it = blockIdx.x;
            if (it < NML_ITEMS) load(it, SA);
            if (it + G < NML_ITEMS) load(it + G, SB);
            __syncthreads();
            for (; it < NML_ITEMS; it += 2 * G) {
                item(it, SA, it + 2 * G);
                if (it + G < NML_ITEMS) item(it + G, SB, it + 3 * G);
            }
        }
    }
}

constexpr int EX2_UB = 12;
static_assert(NCH64 % EX2_UB == 0, "EX2 batches");
__device__ __forceinline__ void phase_ex2(int wv, KP Pk, int layer) {
    asm volatile("" : "+s"(Pk));
    const CAS Params& P = *Pk;
    const int tid = ltid(wv);
    (void)layer;
    if (blockIdx.x < 128) {
        const int gt = blockIdx.x * NT + tid, sq = gt >> 10, rem = gt & 1023;
        bf16_t* Hst = (bf16_t*)(P.ws + WS_XSS) + (size_t)sq * NCH64 * 4096 + rem * 4;
        const float* Dst = (const float*)(P.ws + WS_XSD) + sq * NCH64;
        float h0 = 0.f, h1 = 0.f, h2 = 0.f, h3 = 0.f;
#pragma unroll 1
        for (int c0 = 0; c0 < NCH64; c0 += EX2_UB) {
            u32x2 loc[EX2_UB]; float dd[EX2_UB];
            bf16_t* hp = Hst + (size_t)c0 * 4096;
#pragma unroll
            for (int u = 0; u < EX2_UB; ++u) { loc[u] = *(const u32x2*)(hp + (size_t)u * 4096); dd[u] = Dst[c0 + u]; }
#pragma unroll
            for (int u = 0; u < EX2_UB; ++u) {
                u32x2 o; o.x = pk2(h0, h1); o.y = pk2(h2, h3);
                *(u32x2*)(hp + (size_t)u * 4096) = o;
                const float d = dd[u];
                h0 = d * h0 + bflo(loc[u].x); h1 = d * h1 + bfhi(loc[u].x); h2 = d * h2 + bflo(loc[u].y); h3 = d * h3 + bfhi(loc[u].y);
            }
        }
    } else if (blockIdx.x < 256) {
        const int gt = (blockIdx.x - 128) * NT + tid, sq = gt >> 11, rem = gt & 2047;
        bf16_t* Cst = (bf16_t*)(P.ws + WS_XMC) + (size_t)sq * NCH64 * 8192 + rem * 4;
        float* Nst = (float*)(P.ws + WS_XMN) + (size_t)sq * NCH64 * 64 + (rem & 15) * 4;
        float* Sst = (float*)(P.ws + WS_XMS) + (size_t)sq * NCH64 * 4;
        const bool own_n = rem < 16, own_m = rem == 0;
        float c0_ = 0.f, c1 = 0.f, c2 = 0.f, c3 = 0.f, m = -1e30f;
        f32x4 nn = (f32x4){0.f, 0.f, 0.f, 0.f};
#pragma unroll 1
        for (int cb = 0; cb < NCH64; cb += EX2_UB) {
            u32x2 loc[EX2_UB]; float ft[EX2_UB], ml[EX2_UB]; f32x4 nl[EX2_UB];
            bf16_t* cp = Cst + (size_t)cb * 8192; float* np = Nst + (size_t)cb * 64; float* sp_ = Sst + cb * 4;
#pragma unroll
            for (int u = 0; u < EX2_UB; ++u) {
                loc[u] = *(const u32x2*)(cp + (size_t)u * 8192); ft[u] = sp_[u * 4 + 0]; ml[u] = sp_[u * 4 + 1];
                nl[u] = (f32x4){0.f, 0.f, 0.f, 0.f};
                if (own_n) nl[u] = *(const f32x4*)(np + (size_t)u * 64);
            }
#pragma unroll
            for (int u = 0; u < EX2_UB; ++u) {
                const float ftot = ft[u], mloc = ml[u];
                const float mnew = fmaxf(ftot + m, mloc), sp = __expf(ftot + m - mnew), sl = __expf(mloc - mnew);
                u32x2 o; o.x = pk2(c0_, c1); o.y = pk2(c2, c3);
                *(u32x2*)(cp + (size_t)u * 8192) = o;
                c0_ = sp * c0_ + sl * bflo(loc[u].x); c1 = sp * c1 + sl * bfhi(loc[u].x); c2 = sp * c2 + sl * bflo(loc[u].y); c3 = sp * c3 + sl * bfhi(loc[u].y);
                if (own_n) { *(f32x4*)(np + (size_t)u * 64) = nn; nn = nn * sp + nl[u] * sl; }
                if (own_m) sp_[u * 4 + 2] = m;
                m = mnew;
            }
        }
    }
}

constexpr int X3S_BT = 0, X3S_CT = X3S_BT + 64 * LDTB, X3S_XT = X3S_CT + 64 * LDTB, X3S_HB = X3S_XT + 64 * LDTB, X3S_M = X3S_HB + 64 * LDTB, X3S_CUM = X3S_M + 64 * LDTB, X3S_DTV = X3S_CUM + 256, X3S_ROWS = X3S_DTV + 256, X3S_END = X3S_ROWS + 256;
constexpr int X3M_QT = 0, X3M_KT = X3M_QT + 64 * LDTB, X3M_VT = X3M_KT + 64 * LDTB, X3M_CB = X3M_VT + 64 * LDV, X3M_W = X3M_CB + 128 * LDTB, X3M_ONE = X3M_W + 64 * LDTB, X3M_NB = X3M_ONE + 16 * LDTB,
              X3M_SC = X3M_NB + 16 * LDTB, X3M_END = X3M_SC + 6 * 256;
static_assert(X3M_END <= LDS_BYTES - 16 && X3S_END <= LDS_BYTES - 16, "EX3 LDS maps");
__device__ __forceinline__ void phase_ex3(int wv, KP Pk, int layer, LAS char* lds) {
    asm volatile("" : "+s"(Pk));
    const CAS Params& P = *Pk;
    const int tid = ltid(wv), lane = tid & 63, wid = tid >> 6, q = lane >> 4, r16 = lane & 15, i_ = layer >> 1;
    const bf16_t* XBC = (const bf16_t*)(P.ws + WS_EXBC); const bf16_t* QK = (const bf16_t*)(P.ws + WS_EQK); const bf16_t* Pb = (const bf16_t*)(P.ws + WS_P);
    const float* GT = (const float*)(P.ws + WS_EGT);
    {
        const bf16_t* Hst = (const bf16_t*)(P.ws + WS_XSS);
        struct Set { u32x4 rc[3], rh; float rdt; int rrow; }; Set SA, SB; SA.rdt = SB.rdt = 0.f; SA.rrow = SB.rrow = 0;
        auto geom = [&](int it, int& b, int& h, int& dir, int& c) { const int sq = it / NCH64; c = it - sq * NCH64; b = sq >> 4; h = (sq >> 1) & 7; dir = sq & 1; };
        auto load = [&](int it, Set& S) {
            int b, h, dir, c; geom(it, b, h, dir, c);
            int tl = tid; asm volatile("" : "+v"(tl));
#pragma unroll
            for (int s = 0; s < 3; ++s) {
                const int task = tl + NT * s, j = task / 24, g = task - 24 * j;
                const int row = scan_row(c * CL + j, b, dir, 0);
                S.rc[s] = *(const u32x4*)(XBC + (size_t)row * 768 + (g < 8 ? h * 64 + 8 * g : g < 16 ? 512 + (h >> 2) * 64 + 8 * (g - 8) : 640 + (h >> 2) * 64 + 8 * (g - 16)));
            }
            S.rh = *(const u32x4*)(Hst + (size_t)it * 4096 + tl * 8);
            if (tl < CL) { S.rrow = scan_row(c * CL + tl, b, dir, 0); S.rdt = GT[(size_t)S.rrow * 32 + dir * 8 + h]; }
        };
        auto item = [&](int it, Set& S, int nxt) {
            int b, h, dir, c; geom(it, b, h, dir, c);
            bf16_t* Y = (bf16_t*)(P.ws + (dir ? WS_YB : WS_YF));
            const float aco = -__expf(P.ssd_a_log[(i_ * 2 + dir) * 8 + h]);
            if (tid < CL) {
                const float cum = wave_cumsum(S.rdt * aco, lane);
                ((LAS float*)(lds + X3S_CUM))[tid] = cum; ((LAS float*)(lds + X3S_DTV))[tid] = S.rdt; ((LAS int*)(lds + X3S_ROWS))[tid] = S.rrow;
            }
            __syncthreads();
            {
                int tl = tid; asm volatile("" : "+v"(tl));
#pragma unroll
                for (int s = 0; s < 3; ++s) {
                    const int task = tl + NT * s, j = task / 24, g = task - 24 * j;
                    if (g < 8) {
                        float f[8]; unpack8(S.rc[s], f);
                        const float dt = ((const LAS float*)(lds + X3S_DTV))[j];
#pragma unroll
                        for (int e = 0; e < 8; ++e) f[e] *= dt;
                        *(LAS u32x4*)(lds + X3S_XT + j * LDTB + 16 * g) = pack8(f);
                    } else if (g < 16) *(LAS u32x4*)(lds + X3S_BT + j * LDTB + 8 * (g - 8) * 2) = S.rc[s];
                    else *(LAS u32x4*)(lds + X3S_CT + j * LDTB + 8 * (g - 16) * 2) = S.rc[s];
                }
                *(LAS u32x4*)(lds + X3S_HB + (tl >> 3) * LDTB + (tl & 7) * 16) = S.rh;
            }
            if (nxt < NSSD_ITEMS) load(nxt, S);
            __syncthreads();
            const LAS float* cum = (const LAS float*)(lds + X3S_CUM);
            {
                const int lt = wid >> 1;
#pragma unroll
                for (int u = 0; u < 2; ++u) {
                    const int st = (wid & 1) * 2 + u;
                    f32x4 acc = (f32x4){0.f, 0.f, 0.f, 0.f};
                    if (st <= lt) {
#pragma unroll
                        for (int k0 = 0; k0 < 64; k0 += 32) acc = __builtin_amdgcn_mfma_f32_16x16x32_bf16(ldfrag(lds + X3S_BT, LDTB, st * 16, k0, lane), ldfrag(lds + X3S_CT, LDTB, lt * 16, k0, lane), acc, 0, 0, 0);
                        const int l = lt * 16 + r16, s0 = st * 16 + 4 * q;
                        const float cl = cum[l]; const f32x4 cs = *(const LAS f32x4*)(cum + s0);
#pragma unroll
                        for (int j = 0; j < 4; ++j) acc[j] = (s0 + j <= l) ? acc[j] * __expf(cl - cs[j]) : 0.f;
                    }
                    st4bf(lds + X3S_M + (lt * 16 + r16) * LDTB + (st * 16 + 4 * q) * 2, acc);
                }
            }
            __syncthreads();
            {
                const int lt = wid >> 1, l = lt * 16 + r16;
                const float el = __expf(cum[l]);
                const int row = ((const LAS int*)(lds + X3S_ROWS))[l];
                const bf16x8 mf0 = ldfrag(lds + X3S_M, LDTB, lt * 16, 0, lane), mf1 = ldfrag(lds + X3S_M, LDTB, lt * 16, 32, lane);
                const bf16x8 cf0 = ldfrag(lds + X3S_CT, LDTB, lt * 16, 0, lane), cf1 = ldfrag(lds + X3S_CT, LDTB, lt * 16, 32, lane);
#pragma unroll
                for (int u = 0; u < 2; ++u) {
                    const int pt = (wid & 1) * 2 + u;
                    f32x4 ya = __builtin_amdgcn_mfma_f32_16x16x32_bf16(ldfrag_tr(lds + X3S_XT, LDTB, pt * 16, 0, lane), mf0, (f32x4){0.f, 0.f, 0.f, 0.f}, 0, 0, 0);
                    ya = __builtin_amdgcn_mfma_f32_16x16x32_bf16(ldfrag_tr(lds + X3S_XT, LDTB, pt * 16, 32, lane), mf1, ya, 0, 0, 0);
                    f32x4 oa = __builtin_amdgcn_mfma_f32_16x16x32_bf16(ldfrag(lds + X3S_HB, LDTB, pt * 16, 0, lane), cf0, (f32x4){0.f, 0.f, 0.f, 0.f}, 0, 0, 0);
                    oa = __builtin_amdgcn_mfma_f32_16x16x32_bf16(ldfrag(lds + X3S_HB, LDTB, pt * 16, 32, lane), cf1, oa, 0, 0, 0);
                    u32x2 o; o.x = pk2(ya[0] + el * oa[0], ya[1] + el * oa[1]); o.y = pk2(ya[2] + el * oa[2], ya[3] + el * oa[3]);
                    *(u32x2*)(Y + (size_t)row * D + h * 64 + pt * 16 + 4 * q) = o;
                }
            }
            __syncthreads();
        };
        {
            const int G = gridDim.x; int it = blockIdx.x;
            if (it < NSSD_ITEMS) load(it, SA);
            if (it + G < NSSD_ITEMS) load(it + G, SB);
            __syncthreads();
            for (; it < NSSD_ITEMS; it += 2 * G) {
                item(it, SA, it + 2 * G);
                if (it + G < NSSD_ITEMS) item(it + G, SB, it + 3 * G);
            }
        }
    }
    {
        const bf16_t* Cst = (const bf16_t*)(P.ws + WS_XMC); const float* Nst = (const float*)(P.ws + WS_XMN); const float* Sst = (const float*)(P.ws + WS_XMS); const float* Tst = (const float*)(P.ws + WS_XMT);
        for (int i = tid; i < 16 * LDTB / 4; i += NT) ((LAS unsigned*)(lds + X3M_ONE))[i] = 0x3f803f80u;
        struct Set { u32x4 rc[4], rcb[2]; float rfc, rg, rpm, rmp, rn; int rrow; }; Set SA, SB; SA.rfc = SA.rg = SA.rpm = SA.rmp = SA.rn = SB.rfc = SB.rg = SB.rpm = SB.rmp = SB.rn = 0.f; SA.rrow = SB.rrow = 0;
        auto geom = [&](int it, int& b, int& h, int& dir, int& c) { const int sq = it / NCH64; c = it - sq * NCH64; b = sq >> 3; h = (sq >> 1) & 3; dir = sq & 1; };
        auto load = [&](int it, Set& S) {
            int b, h, dir, c; geom(it, b, h, dir, c);
            int tl = tid; asm volatile("" : "+v"(tl));
#pragma unroll
            for (int s = 0; s < 4; ++s) {
                const int task = tl + NT * s, j = task >> 5, g = task & 31;
                const int row = scan_row(c * CL + j, b, dir, 0);
                S.rc[s] = g < 16 ? *(const u32x4*)(QK + (size_t)row * 512 + (g < 8 ? h * 64 + 8 * g : 256 + h * 64 + 8 * (g - 8))) : *(const u32x4*)(Pb + (size_t)row * LDP_EVEN + 1808 + h * 128 + 8 * (g - 16));
            }
#pragma unroll
            for (int s = 0; s < 2; ++s) S.rcb[s] = *(const u32x4*)(Cst + (size_t)it * 8192 + (tl + NT * s) * 8);
            if (tl < CL) {
                S.rrow = scan_row(c * CL + tl, b, dir, 0);
                const float* tp = Tst + (size_t)it * 192;
                S.rfc = tp[tl]; S.rg = tp[64 + tl]; S.rpm = tp[128 + tl]; S.rmp = Sst[(size_t)it * 4 + 2]; S.rn = Nst[(size_t)it * 64 + tl];
            }
        };
        auto item = [&](int it, Set& S, int nxt) {
            int b, h, dir, c; geom(it, b, h, dir, c);
            bf16_t* Y = (bf16_t*)(P.ws + (dir ? WS_YB : WS_YF));
            LAS float* sc = (LAS float*)(lds + X3M_SC);
            {
                int tl = tid; asm volatile("" : "+v"(tl));
#pragma unroll
                for (int s = 0; s < 4; ++s) {
                    const int task = tl + NT * s, j = task >> 5, g = task & 31;
                    if (g < 8) *(LAS u32x4*)(lds + X3M_QT + j * LDTB + 8 * g * 2) = S.rc[s];
                    else if (g < 16) *(LAS u32x4*)(lds + X3M_KT + j * LDTB + 8 * (g - 8) * 2) = S.rc[s];
                    else {
                        const int v0 = 8 * (g - 16);
#pragma unroll
                        for (int e = 0; e < 1; ++e) *(LAS u32x4*)(lds + X3M_VT + j * LDV + v0 * 2) = S.rc[s];
                    }
                }
#pragma unroll
                for (int s = 0; s < 2; ++s) { const int ch = tl + NT * s; *(LAS u32x4*)(lds + X3M_CB + (ch >> 3) * LDTB + (ch & 7) * 16) = S.rcb[s]; }
                if (tl < CL) {
                    const float linter = S.rfc + S.rmp, mrow = fmaxf(S.rfc + S.rpm, linter);
                    sc[tl] = S.rfc - mrow; sc[64 + tl] = S.rg; sc[128 + tl] = __expf(linter - mrow); sc[192 + tl] = __expf(-mrow); ((LAS int*)sc)[256 + tl] = S.rrow;
                    const bf16_t nb = f2bf(S.rn);
#pragma unroll
                    for (int r = 0; r < 16; ++r) *(LAS bf16_t*)(lds + X3M_NB + r * LDTB + tl * 2) = nb;
                }
            }
            if (nxt < NML_ITEMS) load(nxt, S);
            __syncthreads();
            {
                const int lt = wid >> 1;
#pragma unroll
                for (int u = 0; u < 2; ++u) {
                    const int st = (wid & 1) * 2 + u;
                    f32x4 acc = (f32x4){0.f, 0.f, 0.f, 0.f};
                    if (st <= lt) {
#pragma unroll
                        for (int k0 = 0; k0 < 64; k0 += 32) acc = __builtin_amdgcn_mfma_f32_16x16x32_bf16(ldfrag(lds + X3M_KT, LDTB, st * 16, k0, lane), ldfrag(lds + X3M_QT, LDTB, lt * 16, k0, lane), acc, 0, 0, 0);
                        const int l = lt * 16 + r16, s0 = st * 16 + 4 * q;
                        const float rt = sc[l]; const f32x4 gs = *(const LAS f32x4*)(sc + 64 + s0);
#pragma unroll
                        for (int j = 0; j < 4; ++j) acc[j] = (s0 + j <= l) ? acc[j] * __expf(rt + gs[j]) : 0.f;
                    }
                    st4bf(lds + X3M_W + (lt * 16 + r16) * LDTB + (st * 16 + 4 * q) * 2, acc);
                }
            }
            __syncthreads();
            {
                const int lt = wid >> 1, l = lt * 16 + r16;
                const bf16x8 wf0 = ldfrag(lds + X3M_W, LDTB, lt * 16, 0, lane), wf1 = ldfrag(lds + X3M_W, LDTB, lt * 16, 32, lane);
                const bf16x8 qf0 = ldfrag(lds + X3M_QT, LDTB, lt * 16, 0, lane), qf1 = ldfrag(lds + X3M_QT, LDTB, lt * 16, 32, lane);
                f32x4 da = __builtin_amdgcn_mfma_f32_16x16x32_bf16(ldfrag(lds + X3M_ONE, LDTB, 0, 0, lane), wf0, (f32x4){0.f, 0.f, 0.f, 0.f}, 0, 0, 0);
                da = __builtin_amdgcn_mfma_f32_16x16x32_bf16(ldfrag(lds + X3M_ONE, LDTB, 0, 32, lane), wf1, da, 0, 0, 0);
                f32x4 qn = __builtin_amdgcn_mfma_f32_16x16x32_bf16(ldfrag(lds + X3M_NB, LDTB, 0, 0, lane), qf0, (f32x4){0.f, 0.f, 0.f, 0.f}, 0, 0, 0);
                qn = __builtin_amdgcn_mfma_f32_16x16x32_bf16(ldfrag(lds + X3M_NB, LDTB, 0, 32, lane), qf1, qn, 0, 0, 0);
                const float inter = sc[128 + l], emr = sc[192 + l];
                const float inv = __builtin_amdgcn_rcpf(fmaxf(fabsf(da[0] + inter * qn[0]), emr));
                const int row = ((const LAS int*)sc)[256 + l];
#pragma unroll
                for (int u = 0; u < 4; ++u) {
                    const int vt = (wid & 1) * 4 + u;
                    f32x4 na = __builtin_amdgcn_mfma_f32_16x16x32_bf16(ldfrag_tr(lds + X3M_VT, LDV, vt * 16, 0, lane), wf0, (f32x4){0.f, 0.f, 0.f, 0.f}, 0, 0, 0);
                    na = __builtin_amdgcn_mfma_f32_16x16x32_bf16(ldfrag_tr(lds + X3M_VT, LDV, vt * 16, 32, lane), wf1, na, 0, 0, 0);
                    f32x4 ca = __builtin_amdgcn_mfma_f32_16x16x32_bf16(ldfrag(lds + X3M_CB, LDTB, vt * 16, 0, lane), qf0, (f32x4){0.f, 0.f, 0.f, 0.f}, 0, 0, 0);
                    ca = __builtin_amdgcn_mfma_f32_16x16x32_bf16(ldfrag(lds + X3M_CB, LDTB, vt * 16, 32, lane), qf1, ca, 0, 0, 0);
                    u32x2 o; o.x = pk2((na[0] + inter * ca[0]) * inv, (na[1] + inter * ca[1]) * inv); o.y = pk2((na[2] + inter * ca[2]) * inv, (na[3] + inter * ca[3]) * inv);
                    *(u32x2*)(Y + (size_t)row * D + 512 + h * 128 + vt * 16 + 4 * q) = o;
                }
            }
            __syncthreads();
        };
        {
            const int G = gridDim.x; int it = blockIdx.x;
            if (it < NML_ITEMS) load(it, SA);
            if (it + G < NML_ITEMS) load(it + G, SB);
            __syncthreads();
            for (; it < NML_ITEMS; it += 2 * G) {
                item(it, SA, it + 2 * G);
                if (it + G < NML_ITEMS) item(it + G, SB, it + 3 * G);
            }
        }
    }
}

constexpr int HC_RAWF = 0;
constexpr int HC_RAWQ = HC_RAWF + 64 * 128 * 4;
constexpr int HC_SUB = HC_RAWQ + 64 * 128 * 2;
constexpr int HL_QD = 136 * 2;
constexpr int HL_T = 24 * 2;
constexpr int HS_QI = 0, HS_KO = HS_QI + 16 * HL_QD, HS_KET = HS_KO + 16 * HL_QD, HS_ATT = HS_KET + 128 * HL_T, HS_VT = HS_ATT + 16 * HL_T, HS_DEC = HS_VT + 32 * HL_T, HS_SIZE = HS_DEC + 512;
constexpr int HC_SB = HC_SUB + 4 * HS_SIZE;
constexpr int HC_ROWS = HC_SB + 2 * 32 * HL_QD, HC_CST = HC_ROWS + 256, HC_END = HC_CST + 1024;
static_assert(HC_END <= LDS_BYTES - 16, "HGRN2 LDS map");
static_assert(HS_SIZE % 16 == 0 && HC_SB % 16 == 0, "alignment");
__device__ __forceinline__ bf16x8 ldfrag16(const LAS char* tile, int ldb, int row0, int lane) {
    bf16x8 v = *(const LAS bf16x8*)(tile + (row0 + (lane & 15)) * ldb + ((lane >> 4) & 1) * 16);
    if (lane >= 32) v = (bf16x8){0, 0, 0, 0, 0, 0, 0, 0};
    return v;
}
__device__ __forceinline__ void scan_hgrn_c(int wv, KP Pk, int layer, int unit, LAS char* lds) {
    asm volatile("" : "+s"(Pk));
    const CAS Params& P = *Pk;
    const int tid = ltid(wv), lane = tid & 63, wid = tid >> 6, q = lane >> 4, r16 = lane & 15, i_ = layer >> 1;
    const int seq = unit >> 2, quarter = unit & 3, b = seq >> 3, h = (seq >> 1) & 3, dir = seq & 1;
    const bf16_t* Pb = (const bf16_t*)(P.ws + WS_P);
    bf16_t* Y = (bf16_t*)(P.ws + (dir ? WS_YB : WS_YF));
    LAS float* cst = (LAS float*)(lds + HC_CST);
    if (tid < 128) cst[tid] = ((const float*)(P.ws + WS_LB))[layer * 512 + h * 128 + tid];
    else if (tid < 256) cst[tid] = P.hg_f_bias[(size_t)(i_ * 2 + dir) * 512 + h * 128 + tid - 128];
    for (int i = tid; i < 2 * 32 * HL_QD / 4; i += NT) ((LAS unsigned*)(lds + HC_SB))[i] = 0u;
    int tj[5], tg_[5], tcol[5]; bool tv[5];
#pragma unroll
    for (int s = 0; s < 5; ++s) {
        const int task = tid + NT * s; tv[s] = task < 64 * 36; tj[s] = task / 36; tg_[s] = task % 36;
        const int g = tg_[s];
        tcol[s] = g < 16 ? (512 + dir * 512 + h * 128 + 8 * g) : g < 32 ? (h * 128 + 8 * (g - 16)) : (1536 + h * 128 + quarter * 32 + 8 * (g - 32));
    }
    u32x4 rc[5]; int rrow = 0;
    auto load = [&](int c) {
#pragma unroll
        for (int s = 0; s < 5; ++s) {
            rc[s] = (u32x4){0u, 0u, 0u, 0u};
            if (tv[s]) { const int row = scan_row(c * 64 + tj[s], b, dir, 1); rc[s] = *(const u32x4*)(Pb + (size_t)row * LDP_ODD + tcol[s]); }
        }
        if (tid < 64) rrow = scan_row(c * 64 + tid, b, dir, 1);
    };
    auto storeA = [&]() {
#pragma unroll
        for (int s = 0; s < 5; ++s) {
            if (tv[s]) {
                float f[8]; unpack8(rc[s], f);
                const int j = tj[s], g = tg_[s];
                if (g < 16) {
                    float o[8];
#pragma unroll
                    for (int e = 0; e < 8; ++e) { const float lbv = cst[8 * g + e]; o[e] = lbv + (1.f - lbv) * sigmoidf_(f[e] + cst[128 + 8 * g + e]); }
                    LAS float* dst = (LAS float*)(lds + HC_RAWF) + j * 128 + 8 * g;
                    *(LAS f32x4*)dst = (f32x4){o[0], o[1], o[2], o[3]}; *(LAS f32x4*)(dst + 4) = (f32x4){o[4], o[5], o[6], o[7]};
                } else if (g < 32) {
                    float o[8];
#pragma unroll
                    for (int e = 0; e < 8; ++e) o[e] = siluf_(f[e]);
                    *(LAS u32x4*)(lds + HC_RAWQ + (j * 128 + 8 * (g - 16)) * 2) = pack8(o);
                } else {
                    const int v0 = 8 * (g - 32);
                    LAS char* vt = lds + HC_SUB + (j >> 4) * HS_SIZE + HS_VT;
#pragma unroll
                    for (int e = 0; e < 8; ++e) { const unsigned wv = rc[s][e >> 1]; *(LAS bf16_t*)(vt + (v0 + e) * HL_T + (j & 15) * 2) = (bf16_t)((e & 1) ? (wv >> 16) : (wv & 0xffffu)); }
                }
            }
        }
        if (tid < 64) ((LAS int*)(lds + HC_ROWS))[tid] = rrow;
    };
    auto storeB = [&]() {
        const int d = tid & 127, sb = tid >> 7;
        LAS char* st = lds + HC_SUB + sb * HS_SIZE;
        const LAS float* rf = (const LAS float*)(lds + HC_RAWF) + (sb * 16) * 128 + d;
        const LAS bf16_t* rq = (const LAS bf16_t*)(lds + HC_RAWQ) + (sb * 16) * 128 + d;
        float E = 1.f, einv[16], kfs[16];
#pragma unroll
        for (int t = 0; t < 16; ++t) {
            const float f = rf[t * 128];
            E *= f;
            const float kf = 1.f - f, ei = __builtin_amdgcn_rcpf(E);
            einv[t] = ei; kfs[t] = kf;
            *(LAS bf16_t*)(st + HS_QI + t * HL_QD + d * 2) = f2bf(bf2f(rq[t * 128]) * E);
            *(LAS bf16_t*)(st + HS_KO + t * HL_QD + d * 2) = f2bf(kf * ei);
        }
        float ke[16];
#pragma unroll
        for (int t = 0; t < 16; ++t) ke[t] = kfs[t] * (E * einv[t]);
        *(LAS u32x4*)(st + HS_KET + d * HL_T) = pack8(ke); *(LAS u32x4*)(st + HS_KET + d * HL_T + 16) = pack8(ke + 8);
        ((LAS float*)(st + HS_DEC))[d] = E;
    };
    f32x4 sacc[2];
    sacc[0] = sacc[1] = (f32x4){0.f, 0.f, 0.f, 0.f};
    __syncthreads();
    load(0);
    for (int c = 0; c < NSTEPS / 64; ++c) {
        storeA();
        __syncthreads();
        storeB();
        if (c + 1 < NSTEPS / 64) load(c + 1);
        __syncthreads();
        if (wid < 4) {
            LAS char* st = lds + HC_SUB + wid * HS_SIZE;
            f32x4 acc = (f32x4){0.f, 0.f, 0.f, 0.f};
#pragma unroll
            for (int k0 = 0; k0 < 128; k0 += 32) acc = __builtin_amdgcn_mfma_f32_16x16x32_bf16(ldfrag(st + HS_KO, HL_QD, 0, k0, lane), ldfrag(st + HS_QI, HL_QD, 0, k0, lane), acc, 0, 0, 0);
#pragma unroll
            for (int j = 0; j < 4; ++j) acc[j] = (4 * q + j <= r16) ? acc[j] : 0.f;
            st4bf(st + HS_ATT + r16 * HL_T + 4 * q * 2, acc);
        }
        __syncthreads();
#pragma unroll 1
        for (int sb = 0; sb < 4; ++sb) {
            LAS char* st = lds + HC_SUB + sb * HS_SIZE;
            const LAS char* sbr = lds + HC_SB + (sb & 1) * 32 * HL_QD;
            LAS char* sbw = lds + HC_SB + ((sb + 1) & 1) * 32 * HL_QD;
            if (wid < 2) {
                f32x4 ya = __builtin_amdgcn_mfma_f32_16x16x32_bf16(ldfrag16(st + HS_VT, HL_T, wid * 16, lane), ldfrag16(st + HS_ATT, HL_T, 0, lane), (f32x4){0.f, 0.f, 0.f, 0.f}, 0, 0, 0);
#pragma unroll
                for (int k0 = 0; k0 < 128; k0 += 32) ya = __builtin_amdgcn_mfma_f32_16x16x32_bf16(ldfrag(sbr, HL_QD, wid * 16, k0, lane), ldfrag(st + HS_QI, HL_QD, 0, k0, lane), ya, 0, 0, 0);
                const int row = ((const LAS int*)(lds + HC_ROWS))[sb * 16 + r16];
                u32x2 o; o.x = pk2(ya[0], ya[1]); o.y = pk2(ya[2], ya[3]);
                *(u32x2*)(Y + (size_t)row * D + h * 128 + quarter * 32 + wid * 16 + 4 * q) = o;
            }
            {
                const int vt = wid >> 2;
                const bf16x8 vf = ldfrag16(st + HS_VT, HL_T, vt * 16, lane);
#pragma unroll
                for (int u = 0; u < 2; ++u) {
                    const int dt = (wid & 3) * 2 + u;
                    const f32x4 a = __builtin_amdgcn_mfma_f32_16x16x32_bf16(ldfrag16(st + HS_KET, HL_T, dt * 16, lane), vf, (f32x4){0.f, 0.f, 0.f, 0.f}, 0, 0, 0);
                    const f32x4 dc = *(const LAS f32x4*)((const LAS float*)(st + HS_DEC) + dt * 16 + 4 * q);
#pragma unroll
                    for (int j = 0; j < 4; ++j) sacc[u][j] = sacc[u][j] * dc[j] + a[j];
                    st4bf(sbw + (vt * 16 + r16) * HL_QD + (dt * 16 + 4 * q) * 2, sacc[u]);
                }
            }
            __syncthreads();
        }
    }
}

constexpr int RC_RAWW = 0;
constexpr int RC_RAWA = RC_RAWW + 64 * 64 * 4;
constexpr int RC_RAWB = RC_RAWA + 64 * 64 * 2, RC_RAWK = RC_RAWB + 64 * 64 * 2, RC_RAWR = RC_RAWK + 64 * 64 * 2;
constexpr int RC_SUB = RC_RAWR + 64 * 64 * 2;
constexpr int RL_C = 72 * 2, RL_32 = 40 * 2, RL_16 = 24 * 2;
constexpr int RS_AT = 0, RS_RT = RS_AT + 16 * RL_C, RS_KT = RS_RT + 16 * RL_C, RS_BT = RS_KT + 16 * RL_C, RS_KBH = RS_BT + 16 * RL_C, RS_AAK = RS_KBH + 64 * RL_32,
              RS_ARKB = RS_AAK + 16 * RL_16, RS_T = RS_ARKB + 16 * RL_32, RS_AABF = RS_T + 16 * RL_16, RS_GL = RS_AABF + 16 * 16 * 4, RS_VU = RS_GL + 256, RS_SIZE = RS_VU + 32 * RL_32;
constexpr int RC_SB = RC_SUB + 4 * RS_SIZE;
constexpr int RC_RHT = RC_SB + 32 * RL_C;
constexpr int RC_ROWS = RC_RHT + 32 * RL_16, RC_END = RC_ROWS + 256;
static_assert(RC_END <= LDS_BYTES - 16, "RWKV LDS map");
static_assert(RS_SIZE % 16 == 0 && RC_SB % 16 == 0 && RC_RHT % 16 == 0, "alignment");


__device__ __forceinline__ void phase_prep1(int wv, KP Pk, int layer) {
    asm volatile("" : "+s"(Pk));
    const CAS Params& P = *Pk;
    const int tid = ltid(wv), lane = tid & 63, wid = tid >> 6, i_ = layer >> 1;
    const bf16_t* Pb = (const bf16_t*)(P.ws + WS_P);
    bf16_t* R = (bf16_t*)(P.ws + WS_RWR); bf16_t* K = (bf16_t*)(P.ws + WS_RWK); bf16_t* V = (bf16_t*)(P.ws + WS_RWV); bf16_t* KK = (bf16_t*)(P.ws + WS_RWKK);
    bf16_t* LA = (bf16_t*)(P.ws + WS_LA);
    const float* mu = P.rw_mu + (size_t)i_ * 1856;
    float mur[8], muv[8], muk[8], mul_[8], kkw[8];
#pragma unroll
    for (int e = 0; e < 8; ++e) { mur[e] = mu[8 * lane + e]; muv[e] = mu[1024 + 8 * lane + e]; muk[e] = mu[512 + 8 * lane + e]; mul_[e] = lane < 40 ? mu[1536 + 8 * lane + e] : 0.f; kkw[e] = P.rw_k_k[i_ * 512 + 8 * lane + e]; }
    u32x4 nq[4][3]; float nmp = 0.f, nmn = 0.f;
    auto fetch = [&](int r) {
        int rprev = -1, rnext = -1;
        if (r < NCTX) { const int t = r & 255; if (t > 0) rprev = r - 1; if (t < CTXL - 1) rnext = r + 1; }
        else {
            const int bs = (r - NCTX) >> 13, s = (r - NCTX) & 8191, sg = ((s & 63) << 7) + (s >> 6);
            if (sg > 0) { const int g2 = sg - 1; rprev = NCTX + bs * SEQ + ((g2 & 127) << 6) + (g2 >> 7); }
            if (sg < SEQ - 1) { const int g2 = sg + 1; rnext = NCTX + bs * SEQ + ((g2 & 127) << 6) + (g2 >> 7); }
        }
        const bf16_t* pc = Pb + (size_t)r * LDP_ODD + 2560;
        const bf16_t* pp = Pb + (size_t)(rprev < 0 ? r : rprev) * LDP_ODD + 2560;
        const bf16_t* pn = Pb + (size_t)(rnext < 0 ? r : rnext) * LDP_ODD + 2560;
        nmp = rprev < 0 ? 0.f : 0.5f; nmn = rnext < 0 ? 0.f : 0.5f;
#pragma unroll
        for (int gq = 0; gq < 4; ++gq) {
            const int col = (gq == 0 ? 0 : gq == 1 ? 1024 : gq == 2 ? 512 : 1536) + 8 * lane;
            if (gq < 3 || lane < 40) { nq[gq][0] = *(const u32x4*)(pc + col); nq[gq][1] = *(const u32x4*)(pp + col); nq[gq][2] = *(const u32x4*)(pn + col); }
        }
    };
    nq[3][0] = nq[3][1] = nq[3][2] = (u32x4){0u, 0u, 0u, 0u};
    const int stride = gridDim.x * 8;
    int r = blockIdx.x * 8 + wid;
    if (r < NROWS) fetch(r);
    for (; r < NROWS; r += stride) {
        u32x4 cq[4][3];
#pragma unroll
        for (int gq = 0; gq < 4; ++gq)
#pragma unroll
            for (int k = 0; k < 3; ++k) cq[gq][k] = nq[gq][k];
        const float mp = nmp, mn = nmn;
        if (r + stride < NROWS) fetch(r + stride);
        auto mix8 = [&](const u32x4 (&c)[3], const float* muc, float* o) {
            float fc[8], fp[8], fn[8];
            unpack8(c[0], fc); unpack8(c[1], fp); unpack8(c[2], fn);
#pragma unroll
            for (int e = 0; e < 8; ++e) o[e] = fc[e] + muc[e] * (mp * fp[e] + mn * fn[e] - fc[e]);
        };
        float o[8];
        mix8(cq[0], mur, o); *(u32x4*)(R + (size_t)r * 512 + 8 * lane) = pack8(o);
        mix8(cq[1], muv, o); *(u32x4*)(V + (size_t)r * 512 + 8 * lane) = pack8(o);
        mix8(cq[2], muk, o); *(u32x4*)(K + (size_t)r * 512 + 8 * lane) = pack8(o);
        {
            float kk[8], ss = 0.f;
#pragma unroll
            for (int e = 0; e < 8; ++e) { kk[e] = o[e] * kkw[e]; ss += kk[e] * kk[e]; }
            ss = group_sum<8>(ss);
            const float rn = rsqrtf(fmaxf(ss, 1e-12f));
#pragma unroll
            for (int e = 0; e < 8; ++e) kk[e] *= rn;
            *(u32x4*)(KK + (size_t)r * 512 + 8 * lane) = pack8(kk);
        }
        if (lane < 40) {
            mix8(cq[3], mul_, o);
            if (lane < 16) {
#pragma unroll
                for (int e = 0; e < 8; ++e) o[e] = tanh_fast(o[e]);
            } else if (lane >= 24) {
#pragma unroll
                for (int e = 0; e < 8; ++e) o[e] = sigmoidf_(o[e]);
            }
            *(u32x4*)(LA + (size_t)r * 320 + 8 * lane) = pack8(o);
        }
    }
}

__device__ __forceinline__ void phase_out_even(int wv, KP Pk, int layer) {
    asm volatile("" : "+s"(Pk));
    const CAS Params& P = *Pk;
    const int tid = ltid(wv), lane = tid & 63, wid = tid >> 6, i_ = layer >> 1;
    const bf16_t* Pb = (const bf16_t*)(P.ws + WS_P);
    const bf16_t* Yf = (const bf16_t*)(P.ws + WS_YF); const bf16_t* Yb = (const bf16_t*)(P.ws + WS_YB);
    bf16_t* feat = (bf16_t*)(P.ws + WS_FEAT);
    const int r0 = (layer == DEPTH - 1) ? NCTX : 0;
    const bf16_t* XBC = (const bf16_t*)(P.ws + WS_EXBC);
    float nwa[8], nwb[8];
#pragma unroll
    for (int e = 0; e < 8; ++e) { nwa[e] = P.ssd_norm_w[i_ * 512 + 8 * lane + e]; nwb[e] = P.ml_norm_w[i_ * 512 + 8 * lane + e]; }
    const float dsk = P.ssd_d[i_ * 8 + (lane >> 3)];
    u32x4 n0, n1, n2, n3, n4, n5, n6;
    auto fetch = [&](int rr) {
        const bf16_t* pr = Pb + (size_t)rr * LDP_EVEN;
        n0 = *(const u32x4*)(Yf + (size_t)rr * D + 8 * lane); n1 = *(const u32x4*)(Yb + (size_t)rr * D + 8 * lane);
        n2 = *(const u32x4*)(XBC + (size_t)rr * 768 + 8 * lane); n3 = *(const u32x4*)(pr + 8 * lane);
        n4 = *(const u32x4*)(Yf + (size_t)rr * D + 512 + 8 * lane); n5 = *(const u32x4*)(Yb + (size_t)rr * D + 512 + 8 * lane); n6 = *(const u32x4*)(pr + 2320 + 8 * lane);
    };
    const int stride = gridDim.x * 8;
    int r = r0 + blockIdx.x * 8 + wid;
    if (r < NROWS) fetch(r);
    for (; r < NROWS; r += stride) {
        const u32x4 c0 = n0, c1 = n1, c2 = n2, c3 = n3, c4 = n4, c5 = n5, c6 = n6;
        if (r + stride < NROWS) fetch(r + stride);
        float y[8];
        {
            float a[8], bb[8], xsv[8], z[8];
            unpack8(c0, a); unpack8(c1, bb);
            unpack8(c2, xsv); unpack8(c3, z);
            float ss = 0.f;
#pragma unroll
            for (int e = 0; e < 8; ++e) {
                y[e] = (a[e] + bb[e] + dsk * xsv[e]) * siluf_(z[e]); ss += y[e] * y[e];
            }
            ss = wave_sum(ss);
            const float rn = rsqrtf(ss * (1.f / 512.f) + 1e-6f);
#pragma unroll
            for (int e = 0; e < 8; ++e) y[e] = y[e] * rn * nwa[e];
            *(u32x4*)(feat + (size_t)r * D + 8 * lane) = pack8(y);
        }
        {
            float a[8], bb[8], o[8];
            unpack8(c4, a); unpack8(c5, bb);
            unpack8(c6, o);
            float s = 0.f;
#pragma unroll
            for (int e = 0; e < 8; ++e) { y[e] = a[e] + bb[e]; s += y[e]; }
            const float mean = group_sum<16>(s) * (1.f / 128.f);
            float ss = 0.f;
#pragma unroll
            for (int e = 0; e < 8; ++e) { y[e] -= mean; ss += y[e] * y[e]; }
            const float rn = rsqrtf(group_sum<16>(ss) * (1.f / 128.f) + 1e-6f);
#pragma unroll
            for (int e = 0; e < 8; ++e) y[e] = sigmoidf_(o[e]) * (y[e] * rn) * nwb[e];
            *(u32x4*)(feat + (size_t)r * D + 512 + 8 * lane) = pack8(y);
        }
    }
}
__device__ __forceinline__ void phase_out_odd(int wv, KP Pk, int layer) {
    asm volatile("" : "+s"(Pk));
    const CAS Params& P = *Pk;
    const int tid = ltid(wv), lane = tid & 63, wid = tid >> 6, i_ = layer >> 1;
    const bf16_t* Pb = (const bf16_t*)(P.ws + WS_P);
    const bf16_t* Yf = (const bf16_t*)(P.ws + WS_YF); const bf16_t* Yb = (const bf16_t*)(P.ws + WS_YB);
    const bf16_t* R = (const bf16_t*)(P.ws + WS_RWR); const bf16_t* K = (const bf16_t*)(P.ws + WS_RWK); const bf16_t* V = (const bf16_t*)(P.ws + WS_RWV); const bf16_t* G = (const bf16_t*)(P.ws + WS_RWG);
    bf16_t* feat = (bf16_t*)(P.ws + WS_FEAT);
    const int r0 = (layer == DEPTH - 1) ? NCTX : 0;
    float nwc[8], rk[8], lw[8], lbv[8];
#pragma unroll
    for (int e = 0; e < 8; ++e) {
        nwc[e] = P.hg_norm_w[i_ * 512 + 8 * lane + e]; rk[e] = P.rw_r_k[i_ * 512 + 8 * lane + e];
        lw[e] = P.rw_ln_w[i_ * 512 + 8 * lane + e]; lbv[e] = P.rw_ln_b[i_ * 512 + 8 * lane + e];
    }
    u32x4 n0, n1, n2, n3, n4, n5, n6, n7, n8;
    auto fetch = [&](int rr) {
        n0 = *(const u32x4*)(Yf + (size_t)rr * D + 8 * lane); n1 = *(const u32x4*)(Yb + (size_t)rr * D + 8 * lane); n2 = *(const u32x4*)(Pb + (size_t)rr * LDP_ODD + 2048 + 8 * lane);
        n3 = *(const u32x4*)(Yf + (size_t)rr * D + 512 + 8 * lane); n4 = *(const u32x4*)(Yb + (size_t)rr * D + 512 + 8 * lane);
        n5 = *(const u32x4*)(R + (size_t)rr * 512 + 8 * lane); n6 = *(const u32x4*)(K + (size_t)rr * 512 + 8 * lane);
        n7 = *(const u32x4*)(V + (size_t)rr * 512 + 8 * lane); n8 = *(const u32x4*)(G + (size_t)rr * 512 + 8 * lane);
    };
    const int stride = gridDim.x * 8;
    int r = r0 + blockIdx.x * 8 + wid;
    if (r < NROWS) fetch(r);
    for (; r < NROWS; r += stride) {
        const u32x4 c0 = n0, c1 = n1, c2 = n2, c3 = n3, c4 = n4, c5 = n5, c6 = n6, c7 = n7, c8 = n8;
        if (r + stride < NROWS) fetch(r + stride);
        float y[8];
        {
            float a[8], bb[8], g[8];
            unpack8(c0, a); unpack8(c1, bb);
            unpack8(c2, g);
            float ss = 0.f;
#pragma unroll
            for (int e = 0; e < 8; ++e) { y[e] = a[e] + bb[e]; ss += y[e] * y[e]; }
            const float rn = rsqrtf(group_sum<16>(ss) * (1.f / 128.f) + 1e-6f);
#pragma unroll
            for (int e = 0; e < 8; ++e) y[e] = y[e] * rn * nwc[e] * siluf_(g[e]);
            *(u32x4*)(feat + (size_t)r * D + 8 * lane) = pack8(y);
        }
        {
            float a[8], bb[8], rr[8], kk[8], vv[8], g[8];
            unpack8(c3, a); unpack8(c4, bb);
            unpack8(c5, rr); unpack8(c6, kk);
            unpack8(c7, vv); unpack8(c8, g);
            float s = 0.f, bs = 0.f;
#pragma unroll
            for (int e = 0; e < 8; ++e) { y[e] = a[e] + bb[e]; s += y[e]; bs += rr[e] * kk[e] * rk[e]; }
            const float mean = group_sum<8>(s) * (1.f / 64.f); bs = group_sum<8>(bs);
            float ss = 0.f;
#pragma unroll
            for (int e = 0; e < 8; ++e) { y[e] -= mean; ss += y[e] * y[e]; }
            const float rn = rsqrtf(group_sum<8>(ss) * (1.f / 64.f) + 64e-5f);
#pragma unroll
            for (int e = 0; e < 8; ++e) y[e] = (y[e] * rn * lw[e] + lbv[e] + bs * vv[e]) * g[e];
            *(u32x4*)(feat + (size_t)r * D + 512 + 8 * lane) = pack8(y);
        }
    }
}

#ifndef MK_DOUBLE
#define MK_DOUBLE 0
#endif
#define REP(bit, body) do { body; if (MK_DOUBLE & (bit)) { body; } } while (0)
__device__ __forceinline__ void phase_expconv(int wv, KP Pk, int layer, LAS char* lds) {
    asm volatile("" : "+s"(Pk));
    const CAS Params& P = *Pk;
    const int tid = ltid(wv);
    if (layer & 1) return;
    expconv_items(P, layer, lds, exc_s0(layer) + exc_s1(layer), EXC_ITEMS, (int)blockIdx.x * 8 + (tid >> 6), (int)gridDim.x * 8, tid >> 6, tid & 63);
}
__device__ __forceinline__ void expconv_after_scan(int wv, KP Pk, int layer, LAS char* lds) {
    asm volatile("" : "+s"(Pk));
    const CAS Params& P = *Pk;
    const int tid = ltid(wv);
    __syncthreads();
    expconv_items(P, layer, lds, exc_s0(layer) + exc_s1(layer), EXC_ITEMS, (int)blockIdx.x * 8 + (tid >> 6), 128 * 8, tid >> 6, tid & 63);
}
constexpr int L1_AST = 1028;
constexpr int L1_PST = 33;
constexpr int L1_A = 0, L1_PART = L1_A + 16 * L1_AST * 4, L1_SM = L1_PART + 8 * 16 * L1_PST * 4, L1_END = L1_SM + (64 + 2 * 144 + 32) * 4;
static_assert(L1_END <= LDS_BYTES - 16, "LN1 LDS map");
__device__ __forceinline__ void phase_ln1(int wv, KP Pk, int layer, LAS char* lds, bool dry = false) {
    asm volatile("" : "+s"(Pk));
    const CAS Params& P = *Pk;
    const int tid = ltid(wv), lane = tid & 63;
    if (!dry) REP(8, phase_expconv(wv, Pk, layer, lds));
    __syncthreads();
    LAS float* At = (LAS float*)(lds + L1_A);
    LAS float* part = (LAS float*)(lds + L1_PART);
    LAS int* lcnt = (LAS int*)(lds + L1_SM);
    LAS int* lbase = lcnt + 32;
    LAS int* asg = lcnt + 64;
    LAS float* rbias = (LAS float*)(asg + 2 * 144);
    if (tid < 32) { lcnt[tid] = 0; rbias[tid] = P.router_bias[tid]; }
    float breg[8][4][2];
    {
        const float* rw = P.router_w + (size_t)(128 * wv + 4 * (lane >> 4)) * NEXP + (lane & 15);
#pragma unroll
        for (int j = 0; j < 8; ++j)
#pragma unroll
            for (int i = 0; i < 4; ++i) { breg[j][i][0] = rw[(16 * j + i) * NEXP]; breg[j][i][1] = rw[(16 * j + i) * NEXP + 16]; }
    }
    __syncthreads();
    const bf16_t* yo = (const bf16_t*)(P.ws + WS_YO);
    bf16_t* act = (bf16_t*)(P.ws + (dry ? WS_FEAT : WS_ACT));
    bf16_t* xcb = (bf16_t*)(P.ws + WS_XC); bf16_t* xob = (bf16_t*)P.out;
    const bool lastl = (layer == DEPTH - 1);
    int* cnt = (int*)(P.ws + WS_CNT) + layer * 32 * CNT_STRIDE;
    int* list = (int*)(P.ws + WS_LIST);
    float* wts = (float*)(P.ws + WS_WTS);
    const float* lg = P.ln_g + (size_t)(layer * 2 + 0) * D; const float* lb = P.ln_b + (size_t)(layer * 2 + 0) * D;
    const int r0 = (layer == DEPTH - 1) ? NCTX : 0, ntiles = (NROWS - r0) / 16, G = gridDim.x;
    f32x4 g1v[4], s2c[4], h2c[4];
#pragma unroll
    for (int i = 0; i < 4; ++i) g1v[i] = s2c[i] = h2c[i] = (f32x4){0.f, 0.f, 0.f, 0.f};
    int mcur = -1;
    f32x4 nx[2][4]; u32x2 nyo[2][4];
    auto fetch = [&](int s, int rr) {
        if (layer == 0) {
            const float* xq = rr < NCTX ? P.ctx + (size_t)rr * D : P.x + (size_t)(rr - NCTX) * D;
#pragma unroll
            for (int i = 0; i < 4; ++i) nx[s][i] = *(const f32x4*)(xq + 4 * lane + 256 * i);
        } else {
            const bf16_t* xq = rr < NCTX ? xcb + (size_t)rr * D : xob + (size_t)(rr - NCTX) * D;
#pragma unroll
            for (int i = 0; i < 4; ++i) { const u32x2 t = *(const u32x2*)(xq + 4 * lane + 256 * i); nx[s][i] = (f32x4){__uint_as_float(t.x), __uint_as_float(t.y), 0.f, 0.f}; }
        }
#pragma unroll
        for (int i = 0; i < 4; ++i) { const int c = 4 * lane + 256 * i; nyo[s][i] = *(const u32x2*)(yo + (size_t)rr * D + c); }
    };
    int tile = blockIdx.x;
    if (tile < ntiles) { fetch(0, r0 + tile * 16 + 2 * wv); fetch(1, r0 + tile * 16 + 2 * wv + 1); }
    for (int it = 0; tile < ntiles; ++it, tile += G) {
        const int rb = r0 + tile * 16 + 2 * wv;
        const int m = row_mod(rb);
        if (m != mcur) {
            mcur = m;
            const float* g1 = modvec(P.ws, layer, m, 2); const float* sh2 = modvec(P.ws, layer, m, 3); const float* sc2 = modvec(P.ws, layer, m, 4);
#pragma unroll
            for (int i = 0; i < 4; ++i) { const int c = 4 * lane + 256 * i; g1v[i] = *(const f32x4*)(g1 + c); s2c[i] = *(const f32x4*)(sc2 + c); h2c[i] = *(const f32x4*)(sh2 + c); }
        }
#pragma unroll
        for (int s = 0; s < 2; ++s) {
            const int r = rb + s;
            bf16_t* xr = dry ? (bf16_t*)(P.ws + WS_YF) + (size_t)r * D : lastl ? (bf16_t*)(P.ws + WS_FEAT) + (size_t)r * D : r < NCTX ? xcb + (size_t)r * D : xob + (size_t)(r - NCTX) * D;
            f32x4 v[4]; float sm = 0.f;
#pragma unroll
            for (int i = 0; i < 4; ++i) {
                f32x4 xv = nx[s][i]; const f32x4 gv = g1v[i]; const u32x2 yv = nyo[s][i];
                if (layer != 0) { const unsigned b0 = __float_as_uint(xv[0]), b1 = __float_as_uint(xv[1]); xv = (f32x4){bflo(b0), bfhi(b0), bflo(b1), bfhi(b1)}; }
                v[i][0] = ALPHA * xv[0] + gv[0] * bflo(yv.x); v[i][1] = ALPHA * xv[1] + gv[1] * bfhi(yv.x);
                v[i][2] = ALPHA * xv[2] + gv[2] * bflo(yv.y); v[i][3] = ALPHA * xv[3] + gv[3] * bfhi(yv.y);
                sm += (v[i][0] + v[i][1]) + (v[i][2] + v[i][3]);
            }
            if (tile + G < ntiles) fetch(s, r + G * 16);
            const float mean = wave_sum(sm) * (1.f / D);
            float s2 = 0.f;
#pragma unroll
            for (int i = 0; i < 4; ++i) { v[i] = v[i] - mean; s2 += (v[i][0] * v[i][0] + v[i][1] * v[i][1]) + (v[i][2] * v[i][2] + v[i][3] * v[i][3]); }
            const float rstd = rsqrtf(wave_sum(s2) * (1.f / D) + 1e-5f);
            LAS float* arow = At + (2 * wv + s) * L1_AST;
#pragma unroll
            for (int i = 0; i < 4; ++i) {
                const int c = 4 * lane + 256 * i;
                const f32x4 gg = *(const f32x4*)(lg + c), bb = *(const f32x4*)(lb + c), s2v = s2c[i], h2v = h2c[i];
                f32x4 xn, hv;
#pragma unroll
                for (int j = 0; j < 4; ++j) { xn[j] = v[i][j] * rstd * gg[j] + bb[j]; hv[j] = xn[j] * (1.f + s2v[j]) + h2v[j]; }
                { u32x2 ox; ox.x = pk2(xn[0], xn[1]); ox.y = pk2(xn[2], xn[3]); *(u32x2*)(xr + c) = ox; }
                u32x2 o; o.x = pk2(hv[0], hv[1]); o.y = pk2(hv[2], hv[3]); *(u32x2*)(act + (size_t)r * D + c) = o;
                *(LAS f32x4*)(arow + c) = hv;
            }
        }
        __syncthreads();
        {
            f32x4 ra0 = (f32x4){0.f, 0.f, 0.f, 0.f}, ra1 = ra0;
            const LAS float* ap = At + (lane & 15) * L1_AST + 128 * wv + 4 * (lane >> 4);
#pragma unroll
            for (int j = 0; j < 8; ++j) {
                const f32x4 a4 = *(const LAS f32x4*)(ap + 16 * j);
#pragma unroll
                for (int i = 0; i < 4; ++i) {
                    ra0 = __builtin_amdgcn_mfma_f32_16x16x4f32(a4[i], breg[j][i][0], ra0, 0, 0, 0);
                    ra1 = __builtin_amdgcn_mfma_f32_16x16x4f32(a4[i], breg[j][i][1], ra1, 0, 0, 0);
                }
            }
            LAS float* pw = part + wv * 16 * L1_PST + (4 * (lane >> 4)) * L1_PST + (lane & 15);
#pragma unroll
            for (int j = 0; j < 4; ++j) { pw[j * L1_PST] = ra0[j]; pw[j * L1_PST + 16] = ra1[j]; }
        }
        __syncthreads();
        {
            const int half = lane >> 5, e = lane & 31;
            const LAS float* pp = part + (2 * wv + half) * L1_PST + e;
            float sc_ = 0.f;
#pragma unroll
            for (int k = 0; k < 8; ++k) sc_ += pp[k * 16 * L1_PST];
            const float sg = sigmoidf_(sc_), vb = sg + rbias[e];
            float bv[4], sv[4];
            bv[0] = dppmov<0x00>(vb); bv[1] = dppmov<0x55>(vb); bv[2] = dppmov<0xAA>(vb); bv[3] = dppmov<0xFF>(vb);
            sv[0] = dppmov<0x00>(sg); sv[1] = dppmov<0x55>(sg); sv[2] = dppmov<0xAA>(sg); sv[3] = dppmov<0xFF>(sg);
            float m1 = -1e30f, m2 = -1e30f;
#pragma unroll
            for (int k = 0; k < 4; ++k) { const float vsc = bv[k]; if (vsc > m1) { m2 = m1; m1 = vsc; } else if (vsc > m2) m2 = vsc; }
            float best = m1 + m2; int bg = e >> 2;
#pragma unroll
            for (int msk = 4; msk <= 16; msk <<= 1) {
                const float ob = __shfl_xor(best, msk); const int og = __shfl_xor(bg, msk);
                const bool take = (ob > best) || (ob == best && og < bg);
                best = take ? ob : best; bg = take ? og : bg;
            }
            int i1 = 0; float b1 = bv[0];
#pragma unroll
            for (int k = 1; k < 4; ++k) if (bv[k] > b1) { b1 = bv[k]; i1 = k; }
            int i2 = -1; float b2 = -1e30f;
#pragma unroll
            for (int k = 0; k < 4; ++k) if (k != i1 && bv[k] > b2) { b2 = bv[k]; i2 = k; }
            float s1 = sv[0], s2s = sv[0];
#pragma unroll
            for (int k = 1; k < 4; ++k) { if (i1 == k) s1 = sv[k]; if (i2 == k) s2s = sv[k]; }
            if (e == 4 * bg && !dry) {
                const int r = rb + half;
                const int e0 = bg * 4 + i1, e1 = bg * 4 + i2;
                const float inv = 1.f / (s1 + s2s);
                const int li = it * 16 + 2 * wv + half;
                const int p0 = __hip_atomic_fetch_add(&lcnt[e0], 1, __ATOMIC_RELAXED, __HIP_MEMORY_SCOPE_WORKGROUP);
                const int p1 = __hip_atomic_fetch_add(&lcnt[e1], 1, __ATOMIC_RELAXED, __HIP_MEMORY_SCOPE_WORKGROUP);
                asg[2 * li] = (e0 << 16) | p0; asg[2 * li + 1] = (e1 << 16) | p1;
                wts[2 * r] = s1 * inv; wts[2 * r + 1] = s2s * inv;
            }
        }
    }
    __syncthreads();
    if (dry) return;
    if (tid < 32) lbase[tid] = atomicAdd(&cnt[tid * CNT_STRIDE], lcnt[tid]);
    __syncthreads();
    for (int idx = tid; idx < 2 * 144; idx += NT) {
        const int li = idx >> 1, k = idx & 1, t = (li >> 4) * G + blockIdx.x;
        if (t < ntiles) { const int r = r0 + t * 16 + (li & 15); const int v = asg[idx], e = v >> 16, lp = v & 0xffff; list[(size_t)e * LISTCAP + lbase[e] + lp] = 2 * r + k; }
    }
}

__device__ __forceinline__ void phase_ln2(int wv, KP Pk, int layer, bool dry = false) {
    asm volatile("" : "+s"(Pk));
    const CAS Params& P = *Pk;
    const int tid = ltid(wv), lane = tid & 63, wid = tid >> 6;
    const bf16_t* yp = (const bf16_t*)(P.ws + WS_YP);
    const float* wts = (const float*)(P.ws + WS_WTS);
    bf16_t* act = (bf16_t*)(P.ws + (dry ? WS_FEAT : WS_ACT));
    bf16_t* xcb = (bf16_t*)(P.ws + WS_XC); bf16_t* xob = (bf16_t*)P.out;
    const float* lg = P.ln_g + (size_t)(layer * 2 + 1) * D; const float* lb = P.ln_b + (size_t)(layer * 2 + 1) * D;
    const bool last = (layer == DEPTH - 1);
    const int r0 = last ? NCTX : 0, stride = gridDim.x * 8;
    f32x4 cg[4], cb[4], g2v[4], s1v[4], h1v[4];
#pragma unroll
    for (int i = 0; i < 4; ++i) { cg[i] = *(const f32x4*)(lg + 4 * lane + 256 * i); cb[i] = *(const f32x4*)(lb + 4 * lane + 256 * i); g2v[i] = s1v[i] = h1v[i] = (f32x4){0.f, 0.f, 0.f, 0.f}; }
    int mcur = -1;
    u32x2 nx[4]; u32x2 ny0[4], ny1[4]; float nw0 = 0.f, nw1 = 0.f;
    auto fetch = [&](int r) {
        const bf16_t* xr = last ? (const bf16_t*)(P.ws + WS_FEAT) + (size_t)r * D : r < NCTX ? xcb + (size_t)r * D : xob + (size_t)(r - NCTX) * D;
#pragma unroll
        for (int i = 0; i < 4; ++i) {
            const int c = 4 * lane + 256 * i;
            nx[i] = *(const u32x2*)(xr + c); ny0[i] = *(const u32x2*)(yp + (size_t)(2 * r) * D + c); ny1[i] = *(const u32x2*)(yp + (size_t)(2 * r + 1) * D + c);
        }
        nw0 = wts[2 * r]; nw1 = wts[2 * r + 1];
    };
    int r = r0 + blockIdx.x * 8 + wid;
    if (r < NROWS) fetch(r);
    for (; r < NROWS; r += stride) {
        const int m = row_mod(r);
        if (m != mcur) {
            mcur = m;
            const float* g2 = modvec(P.ws, layer, m, 5); const float* sh1 = last ? lg : modvec(P.ws, layer + 1, m, 0); const float* sc1 = last ? lg : modvec(P.ws, layer + 1, m, 1);
#pragma unroll
            for (int i = 0; i < 4; ++i) { const int c = 4 * lane + 256 * i; g2v[i] = *(const f32x4*)(g2 + c); s1v[i] = *(const f32x4*)(sc1 + c); h1v[i] = *(const f32x4*)(sh1 + c); }
        }
        f32x4 v[4]; float s = 0.f;
        const float w0 = nw0, w1 = nw1;
#pragma unroll
        for (int i = 0; i < 4; ++i) {
            const f32x4 xv = (f32x4){bflo(nx[i].x), bfhi(nx[i].x), bflo(nx[i].y), bfhi(nx[i].y)}, gv = g2v[i]; const u32x2 y0 = ny0[i], y1 = ny1[i];
            v[i][0] = ALPHA * xv[0] + gv[0] * (w0 * bflo(y0.x) + w1 * bflo(y1.x)); v[i][1] = ALPHA * xv[1] + gv[1] * (w0 * bfhi(y0.x) + w1 * bfhi(y1.x));
            v[i][2] = ALPHA * xv[2] + gv[2] * (w0 * bflo(y0.y) + w1 * bflo(y1.y)); v[i][3] = ALPHA * xv[3] + gv[3] * (w0 * bfhi(y0.y) + w1 * bfhi(y1.y));
            s += (v[i][0] + v[i][1]) + (v[i][2] + v[i][3]);
        }
        if (r + stride < NROWS) fetch(r + stride);
        const float mean = wave_sum(s) * (1.f / D);
        float s2 = 0.f;
#pragma unroll
        for (int i = 0; i < 4; ++i) { v[i] = v[i] - mean; s2 += (v[i][0] * v[i][0] + v[i][1] * v[i][1]) + (v[i][2] * v[i][2] + v[i][3] * v[i][3]); }
        const float rstd = rsqrtf(wave_sum(s2) * (1.f / D) + 1e-5f);
#pragma unroll
        for (int i = 0; i < 4; ++i) {
            const int c = 4 * lane + 256 * i;
            f32x4 xn;
#pragma unroll
            for (int j = 0; j < 4; ++j) xn[j] = v[i][j] * rstd * cg[i][j] + cb[i][j];
            if (dry) *(f32x4*)((float*)(P.ws + WS_YF) + (size_t)r * D + c) = xn;
            else if (last) *(f32x4*)(P.out + (size_t)(r - NCTX) * D + c) = xn;
            else { u32x2 ox; ox.x = pk2(xn[0], xn[1]); ox.y = pk2(xn[2], xn[3]); *(u32x2*)((r < NCTX ? xcb + (size_t)r * D : xob + (size_t)(r - NCTX) * D) + c) = ox; }
            if (!last) {
                u32x2 o; o.x = pk2(xn[0] * (1.f + s1v[i][0]) + h1v[i][0], xn[1] * (1.f + s1v[i][1]) + h1v[i][1]); o.y = pk2(xn[2] * (1.f + s1v[i][2]) + h1v[i][2], xn[3] * (1.f + s1v[i][3]) + h1v[i][3]);
                *(u32x2*)(act + (size_t)r * D + c) = o;
            }
        }
    }
}

constexpr int NPHASE = 2 + 11 * DEPTH;
__global__ void __launch_bounds__(NT, 2) fwd_kernel(Params P) {
    extern __shared__ __attribute__((aligned(16))) char lds_raw[];
    LAS char* lds = (LAS char*)lds_raw;
    volatile LAS unsigned* xbw = (volatile LAS unsigned*)(lds + LDS_BYTES - 16);
    KP Pk = (KP)__builtin_amdgcn_kernarg_segment_ptr();
    const int wv = __builtin_amdgcn_readfirstlane((int)(threadIdx.x >> 6));
    const bool multi = (P.ph_hi - P.ph_lo) > 1;
    XcdBarrier bar; bar.bar = (unsigned*)(P.ws + WS_BAR); bar.x = 0; bar.st = xbw;
    if (multi) {
        if (ltid(wv) == 0) { xbw[0] = 0u; xbw[1] = 0u; xbw[2] = 0u; xbw[3] = 0u; }
        __syncthreads();
        bar = xcd_barrier_post(wv, (unsigned*)(P.ws + WS_BAR), xbw);
    }
#define PHASE(id, body) do { if (P.ph_lo <= (id) && (id) < P.ph_hi) { body; if ((id) + 1 < P.ph_hi) xcd_barrier(wv, bar); if (MK_DOUBLE & 2048) xcd_barrier(wv, bar); } } while (0)
    PHASE(0, REP(16, phase_prologue0(wv, Pk, lds)));
    PHASE(1, REP(16, phase_prologue1(wv, Pk)));
    for (int l = 0; l < DEPTH; ++l) {
        const int pb = 2 + 11 * l, odd = l & 1;
        PHASE(pb + 0, REP(1, phase_inproj(wv, Pk, l, lds)));
        if (odd) {
            PHASE(pb + 1, REP(4, phase_prep1(wv, Pk, l)));
            PHASE(pb + 2, phase_prep2(wv, Pk, l, lds));
            PHASE(pb + 3, REP(32, { if (blockIdx.x < 128) { REP(64, scan_hgrn_c(wv, Pk, l, blockIdx.x, lds)); expconv_after_scan(wv, Pk, l, lds); } else if (blockIdx.x < 256) REP(128, scan_rwkv_b(wv, Pk, l, blockIdx.x - 128, lds)); }));
            PHASE(pb + 5, REP(4, phase_out_odd(wv, Pk, l)));
        } else {
            PHASE(pb + 1, REP(4, phase_prep_even(wv, Pk, l)));
            PHASE(pb + 2, REP(2, phase_ex1(wv, Pk, l, lds)));
            PHASE(pb + 3, phase_ex2(wv, Pk, l));
            PHASE(pb + 4, REP(2, phase_ex3(wv, Pk, l, lds)));
            PHASE(pb + 5, REP(4, phase_out_even(wv, Pk, l)));
        }
        PHASE(pb + 6, REP(256, phase_outproj(wv, Pk, l, lds)));
        PHASE(pb + 7, { if (MK_DOUBLE & 4096) phase_ln1(wv, Pk, l, lds, true); phase_ln1(wv, Pk, l, lds); });
        PHASE(pb + 8, REP(512, phase_moe1(wv, Pk, l, lds)));
        PHASE(pb + 9, REP(1024, phase_moe2(wv, Pk, l, lds)));
        PHASE(pb + 10, { if (MK_DOUBLE & 8192) phase_ln2(wv, Pk, l, true); phase_ln2(wv, Pk, l); });
    }
#undef PHASE
}


#ifndef MK_STOP
#define MK_STOP NPHASE
#endif
#ifndef MK_DUMP
#define MK_DUMP 0
#endif
#ifndef MK_DUMP_N
#define MK_DUMP_N (1u << 30)
#endif
#ifndef MK_DUMP_LD
#define MK_DUMP_LD 1024
#endif
#ifndef MK_DUMP_C0
#define MK_DUMP_C0 0
#endif
__global__ void diff_kernel(const bf16_t* a, const bf16_t* b, float* out, size_t n) {
    for (size_t i = (size_t)blockIdx.x * blockDim.x + threadIdx.x; i < n; i += (size_t)gridDim.x * blockDim.x) out[i] = 1e6f * (bf2f(a[i]) - bf2f(b[i]));
}
__global__ void dump_kernel(const bf16_t* src, float* out, size_t n) {
    for (size_t i = (size_t)blockIdx.x * blockDim.x + threadIdx.x; i < n; i += (size_t)gridDim.x * blockDim.x) out[i] = i < (size_t)MK_DUMP_N ? bf2f(src[(i >> 10) * MK_DUMP_LD + MK_DUMP_C0 + (i & 1023)]) : 0.f;
}
extern "C" void kernel_launch(void* const* d_in, const int* in_sizes, int n_in, void* d_out, int out_size, void* d_ws, size_t ws_size, hipStream_t stream) {
    static int ready = 0;
    if (ready == 0) {
        ready = 1;
        if (n_in != 42 || out_size != NB * SEQ * D || ws_size < WS_END) { fprintf(stderr, "kernel_launch: unexpected shapes (n_in %d out %d ws %zu need %zu)\n", n_in, out_size, ws_size, (size_t)WS_END); ready = -1; }
        if (hipFuncSetAttribute((const void*)fwd_kernel, hipFuncAttributeMaxDynamicSharedMemorySize, LDS_BYTES) != hipSuccess) { fprintf(stderr, "kernel_launch: hipFuncSetAttribute failed\n"); ready = -1; }
    }
    if (ready < 0) return;
    (void)in_sizes;
    hipMemsetAsync((char*)d_ws + WS_BAR, 0, WS_ZERO_BYTES, stream);
    Params p;
    memset(&p, 0, sizeof(p));
    const float** fp = (const float**)&p;
    for (int i = 0; i < 42; ++i) fp[i] = (const float*)d_in[i];
    p.out = (float*)d_out; p.ws = (unsigned char*)d_ws;
#if MK_PER_PHASE
    for (int ph = 0; ph < MK_STOP; ++ph) {
        const int local = ph < 2 ? -1 : (ph - 2) % 11, layer = ph < 2 ? 0 : (ph - 2) / 11;
        if (local == 4 && (layer & 1)) continue;
        p.ph_lo = ph; p.ph_hi = ph + 1;
        hipLaunchKernelGGL(fwd_kernel, dim3(256), dim3(NT), LDS_BYTES, stream, p);
    }
#ifdef MK_DIFF
    p.ph_lo = 7; p.ph_hi = 8; p.dbg = 1;
    hipLaunchKernelGGL(fwd_kernel, dim3(256), dim3(NT), LDS_BYTES, stream, p);
    hipLaunchKernelGGL(diff_kernel, dim3(1024), dim3(256), 0, stream, (const bf16_t*)((unsigned char*)d_ws + WS_YO), (const bf16_t*)((unsigned char*)d_ws + WS_HID), (float*)d_out, (size_t)NB * SEQ * D);
#else
    if (MK_DUMP) hipLaunchKernelGGL(dump_kernel, dim3(1024), dim3(256), 0, stream, (const bf16_t*)((unsigned char*)d_ws + (size_t)MK_DUMP), (float*)d_out, (size_t)NB * SEQ * D);
#endif
#else
    p.ph_lo = 0; p.ph_hi = NPHASE;
    hipLaunchKernelGGL(fwd_kernel, dim3(256), dim3(NT), LDS_BYTES, stream, p);
#endif
}
```

```cpp
#include <hip/hip_runtime.h>
#include <stdint.h>
#include <stdio.h>
#include <string.h>

#ifndef MK_PER_PHASE
#define MK_PER_PHASE 0
#endif

typedef unsigned short bf16_t;
typedef short bf16x8 __attribute__((ext_vector_type(8)));
typedef float f32x4 __attribute__((ext_vector_type(4)));
typedef unsigned u32x4 __attribute__((ext_vector_type(4)));
typedef unsigned u32x2 __attribute__((ext_vector_type(2)));
#define LAS __attribute__((address_space(3)))
#define CAS __attribute__((address_space(4)))

constexpr int D = 1024, NB = 4, SEQ = 8192, CTXL = 256, DEPTH = 4;
constexpr int NCTX = NB * CTXL;
constexpr int NROWS = NCTX + NB * SEQ;
constexpr int P_EVEN = 2848, P_ODD = 4416, LDP_EVEN = 3072, LDP_ODD = 4608;
constexpr int NEXP = 32, DEXP = 512, LISTCAP = NROWS;
constexpr float ALPHA = 1.681792830507429f;
constexpr int NT = 512;
constexpr int TCH = 32;
constexpr int NSTEPS = CTXL + SEQ;
constexpr int LDS_BYTES = 160 * 1024;

constexpr size_t al256(size_t x) { return (x + 255) & ~(size_t)255; }
constexpr size_t WS_BAR = 0;
constexpr size_t WS_CNT = 16384;
constexpr int CNT_STRIDE = 64;
constexpr size_t WS_ZERO_BYTES = 16384 + (size_t)4 * 32 * CNT_STRIDE * 4;
constexpr size_t WS_MODV = al256(WS_ZERO_BYTES);
constexpr size_t WS_LB = WS_MODV + al256((size_t)4 * 5 * 6144 * 4);
constexpr size_t WS_XC = WS_LB + al256(4 * 512 * 4);
constexpr size_t WS_WTS = WS_XC + (size_t)NCTX * D * 4;
constexpr size_t WS_LIST = WS_WTS + al256((size_t)2 * NROWS * 4);
constexpr size_t WS_WINT = WS_LIST + al256((size_t)NEXP * LISTCAP * 4);
constexpr size_t WINT_L0 = 0, WINT_L1 = (size_t)LDP_EVEN * D, WINT_L2 = WINT_L1 + (size_t)LDP_ODD * D, WINT_L3 = WINT_L2 + (size_t)LDP_EVEN * D, WINT_END = WINT_L3 + (size_t)LDP_ODD * D;
constexpr size_t WS_WOUTT = WS_WINT + WINT_END * 2;
constexpr size_t WS_LORAT = WS_WOUTT + (size_t)4 * D * D * 2;
constexpr size_t LORA_PER = (size_t)512 * 320;
constexpr size_t WS_EXPGU = WS_LORAT + al256(2 * LORA_PER * 2);
constexpr size_t WS_EXPD = WS_EXPGU + (size_t)NEXP * 1024 * 1024 * 2;
constexpr size_t WS_ACT = WS_EXPD + (size_t)NEXP * 1024 * 512 * 2;
constexpr size_t ROWB = (size_t)NROWS * D * 2;
constexpr size_t WS_FEAT = WS_ACT + ROWB;
constexpr size_t WS_YF = WS_FEAT + ROWB;
constexpr size_t WS_YB = WS_YF + ROWB;
constexpr size_t WS_P = WS_YB + ROWB;
constexpr size_t P_BYTES = (size_t)NROWS * LDP_ODD * 2;
constexpr size_t WS_YO = WS_P;
constexpr size_t WS_HID = WS_P + ROWB;
constexpr size_t WS_YP = WS_HID + ROWB;
static_assert(WS_YP + 2 * ROWB <= WS_P + P_BYTES, "MoE buffers must fit in the P region");
constexpr size_t HALFB = (size_t)NROWS * 512 * 2;
constexpr size_t WS_RWR = WS_P + P_BYTES;
constexpr size_t WS_RWK = WS_RWR + HALFB;
constexpr size_t WS_RWV = WS_RWK + HALFB;
constexpr size_t WS_RWKK = WS_RWV + HALFB;
constexpr size_t WS_RWB = WS_RWKK + HALFB;
constexpr size_t WS_RWG = WS_RWB + HALFB;
constexpr size_t WS_RWDEC = WS_RWG + HALFB;
constexpr size_t WS_LA = WS_RWDEC + (size_t)2 * NROWS * 512 * 4;
constexpr size_t WS_END = WS_LA + (size_t)NROWS * 320 * 2;
static_assert(WS_END <= (size_t)280602384 * 4, "workspace map exceeds the guaranteed ws_size");

struct Params {
    const float *x, *c, *ctx, *c_ctx, *mod_w, *mod_b, *ln_g, *ln_b;
    const float *ev_w_in, *ev_w_out, *ssd_conv_w, *ssd_conv_b, *ssd_dt_bias, *ssd_a_log, *ssd_d, *ssd_norm_w;
    const float *ml_conv_w, *ml_conv_b, *ml_i_bias, *ml_f_bias, *ml_norm_w;
    const float *od_w_in, *od_w_out, *hg_lb_logits, *hg_f_bias, *hg_norm_w;
    const float *rw_mu, *rw_w0, *rw_w2, *rw_a0, *rw_a2, *rw_g2, *rw_k_k, *rw_k_a, *rw_r_k, *rw_ln_w, *rw_ln_b;
    const float *router_w, *router_bias, *exp_w_gate, *exp_w_up, *exp_w_down;
    float* out;
    unsigned char* ws;
    int ph_lo, ph_hi, dbg, pad_;
};
typedef const CAS Params* KP;

__device__ __forceinline__ int ltid(int wv) { int l; asm volatile("v_mbcnt_lo_u32_b32 %0, -1, 0\n\tv_mbcnt_hi_u32_b32 %0, -1, %0" : "=v"(l)); return wv * 64 + l; }
__device__ __forceinline__ float bf2f(bf16_t h) { return __uint_as_float(((unsigned)h) << 16); }
__device__ __forceinline__ float bflo(unsigned u) { return __uint_as_float(u << 16); }
__device__ __forceinline__ float bfhi(unsigned u) { return __uint_as_float(u & 0xffff0000u); }
typedef __bf16 bf16v2_t __attribute__((ext_vector_type(2)));
typedef float f32x2 __attribute__((ext_vector_type(2)));
__device__ __forceinline__ unsigned pk2(float lo, float hi) { const f32x2 v = {lo, hi}; return __builtin_bit_cast(unsigned, __builtin_convertvector(v, bf16v2_t)); }
__device__ __forceinline__ bf16_t f2bf(float f) { return (bf16_t)(pk2(f, 0.f) & 0xffffu); }
__device__ __forceinline__ void unpack8(const u32x4& u, float* f) {
    f[0] = bflo(u.x); f[1] = bfhi(u.x); f[2] = bflo(u.y); f[3] = bfhi(u.y); f[4] = bflo(u.z); f[5] = bfhi(u.z); f[6] = bflo(u.w); f[7] = bfhi(u.w);
}
__device__ __forceinline__ u32x4 pack8(const float* f) { u32x4 u; u.x = pk2(f[0], f[1]); u.y = pk2(f[2], f[3]); u.z = pk2(f[4], f[5]); u.w = pk2(f[6], f[7]); return u; }
__device__ __forceinline__ float sigmoidf_(float x) { return __builtin_amdgcn_rcpf(1.f + __expf(-x)); }
__device__ __forceinline__ float siluf_(float x) { return x * __builtin_amdgcn_rcpf(1.f + __expf(-x)); }
__device__ __forceinline__ float softplus_fast(float x) { return x > 20.f ? x : __logf(1.f + __expf(x)); }
__device__ __forceinline__ float tanh_fast(float x) { return 1.f - 2.f * __builtin_amdgcn_rcpf(1.f + __expf(2.f * x)); }
__device__ __forceinline__ float softplusf_(float x) { return x > 20.f ? x : __logf(1.f + __expf(x)); }
__device__ __forceinline__ float logsigmoidf_(float x) { return fminf(x, 0.f) - __logf(1.f + __expf(-fabsf(x))); }
template <int CTRL> __device__ __forceinline__ float dppmov(float v) {
    return __builtin_bit_cast(float, __builtin_amdgcn_update_dpp(0, __builtin_bit_cast(int, v), CTRL, 0xf, 0xf, true));
}
__device__ __forceinline__ float allreduce16(float v) {
    v += dppmov<0xB1>(v);
    v += dppmov<0x4E>(v);
    v += dppmov<0x141>(v);
    v += dppmov<0x140>(v);
    return v;
}
__device__ __forceinline__ float allreduce8_(float v) { v += dppmov<0xB1>(v); v += dppmov<0x4E>(v); v += dppmov<0x141>(v); return v; }
__device__ __forceinline__ float wave_sum(float v) {
    v = allreduce16(v);
    const float r0 = __builtin_bit_cast(float, __builtin_amdgcn_readlane(__builtin_bit_cast(int, v), 0)), r1 = __builtin_bit_cast(float, __builtin_amdgcn_readlane(__builtin_bit_cast(int, v), 16));
    const float r2 = __builtin_bit_cast(float, __builtin_amdgcn_readlane(__builtin_bit_cast(int, v), 32)), r3 = __builtin_bit_cast(float, __builtin_amdgcn_readlane(__builtin_bit_cast(int, v), 48));
    return (r0 + r1) + (r2 + r3);
}
template <int W> __device__ __forceinline__ float group_sum(float v) {
    if (W == 8) return allreduce8_(v);
    return allreduce16(v);
}

#define XB_TMO      128
#define XB_XCNT(j)  (256  + 64 * (j))
#define XB_XSUB(j)  (1280 + 64 * (j))
#define XB_XGEN(j)  (2304 + 64 * (j))
#define XB_TOP      3328
#define XB_TOPGEN   3392
#define XCD_BAR_WORDS 3456
#define XB_SPIN_CAP (1u << 22)
__device__ __forceinline__ unsigned xb_ld(unsigned* p)              { return __hip_atomic_load(p, __ATOMIC_RELAXED, __HIP_MEMORY_SCOPE_AGENT); }
__device__ __forceinline__ unsigned xb_add(unsigned* p, unsigned v) { return __hip_atomic_fetch_add(p, v, __ATOMIC_RELAXED, __HIP_MEMORY_SCOPE_AGENT); }
__device__ __forceinline__ unsigned xb_xcc_id() { return (unsigned)__builtin_amdgcn_s_getreg((3 << 11) | 20) & 0xFu; }
#define XB_SPIN(cond, bar) do { unsigned _sp = 0; while (cond) { __builtin_amdgcn_s_sleep(1); \
    if ((++_sp & 255u) == 0u) { if (xb_ld(&(bar)[XB_TMO])) break; if (_sp > XB_SPIN_CAP) { atomicAdd(&(bar)[XB_TMO], 1u); break; } } } } while (0)
struct XcdBarrier { unsigned* bar; unsigned x; volatile LAS unsigned* st; };
__device__ __forceinline__ XcdBarrier xcd_barrier_post(int wv, unsigned* bar, volatile LAS unsigned* st) {
    XcdBarrier b; b.bar = bar; b.x = xb_xcc_id(); b.st = st;
    if (ltid(wv) == 0) (void)xb_add(&bar[XB_XCNT(b.x)], 1u);
    return b;
}
__device__ __forceinline__ void xcd_barrier_complete(unsigned* bar, unsigned x, unsigned& nloc, unsigned& nx) {
    const unsigned G = gridDim.x * gridDim.y * gridDim.z;
    unsigned sum, cnt, mine, sp = 0u;
    for (;;) {
        sum = 0u; cnt = 0u; mine = 0u;
#pragma unroll
        for (unsigned j = 0; j < 16; ++j) { const unsigned c = xb_ld(&bar[XB_XCNT(j)]); sum += c; cnt += (c > 0u) ? 1u : 0u; mine = (j == x) ? c : mine; }
        if (sum == G) break;
        __builtin_amdgcn_s_sleep(1);
        if ((++sp & 255u) == 0u) { if (xb_ld(&bar[XB_TMO])) break; if (sp > XB_SPIN_CAP) { atomicAdd(&bar[XB_TMO], 1u); break; } }
    }
    nloc = mine > 0u ? mine : 1u; nx = cnt > 0u ? cnt : 1u;
}
__device__ __forceinline__ void xcd_barrier(int wv, const XcdBarrier& b) {
    asm volatile("s_waitcnt vmcnt(0)" ::: "memory");
    __syncthreads();
    if (ltid(wv) == 0) {
        unsigned* bar = b.bar;
        asm volatile("" : "+s"(bar));
        __builtin_amdgcn_s_waitcnt(0);
        unsigned nloc = b.st[0], nx = b.st[1];
        if (nloc == 0u) { xcd_barrier_complete(bar, b.x, nloc, nx); b.st[0] = nloc; b.st[1] = nx; }
        const unsigned old = xb_add(&bar[XB_XSUB(b.x)], 1u);
        const unsigned gen = old / nloc;
        if (old + 1u == (gen + 1u) * nloc) {
            __builtin_amdgcn_fence(__ATOMIC_RELEASE, "agent");
            asm volatile("s_waitcnt vmcnt(0)" ::: "memory");
            const unsigned og = xb_add(&bar[XB_TOP], 1u);
            const unsigned tg = og / nx;
            if (og + 1u == (tg + 1u) * nx) xb_add(&bar[XB_TOPGEN], 1u);
            else XB_SPIN(xb_ld(&bar[XB_TOPGEN]) == tg, bar);
            __builtin_amdgcn_fence(__ATOMIC_ACQUIRE, "agent");
            xb_add(&bar[XB_XGEN(b.x)], 1u);
            asm volatile("s_waitcnt vmcnt(0)" ::: "memory");
        } else {
            XB_SPIN(xb_ld(&bar[XB_XGEN(b.x)]) == gen, bar);
            __builtin_amdgcn_fence(__ATOMIC_ACQUIRE, "agent");
            asm volatile("s_waitcnt vmcnt(0)" ::: "memory");
        }
    }
    __syncthreads();
}

__device__ __forceinline__ int row_mod(int r) { return r < NCTX ? 4 : ((r - NCTX) >> 13); }
__device__ __forceinline__ void row_seg(int r, int& t, int& len) { if (r < NCTX) { t = r & 255; len = CTXL; } else { t = (r - NCTX) & 8191; len = SEQ; } }
__device__ __forceinline__ int scan_row(int tg, int b, int dir, int odd) {
    if (tg < CTXL) { const int t = dir ? (CTXL - 1 - tg) : tg; return b * CTXL + t; }
    int sg = tg - CTXL; if (dir) sg = SEQ - 1 - sg;
    const int s = odd ? (((sg & 127) << 6) + (sg >> 7)) : sg;
    return NCTX + b * SEQ + s;
}
__device__ __forceinline__ const float* modvec(const unsigned char* ws, int layer, int m, int which) {
    return (const float*)(ws + WS_MODV) + ((size_t)(layer * 5 + m) * 6 + which) * D;
}

constexpr int G_BM = 256, G_BN = 128, G_BK = 64;
constexpr int G_ABYTES = G_BM * G_BK * 2, G_BBYTES = G_BN * G_BK * 2, G_BUF = G_ABYTES + G_BBYTES;
__device__ __forceinline__ int swz(int o) { return o ^ (((o >> 9) & 1) << 5); }

template <class RowSrc, class Epi>
__device__ __forceinline__ void gemm_tile(int wv, const bf16_t* __restrict__ A, int lda, const RowSrc& rs, const bf16_t* __restrict__ Bt, int ldb, int n0, int K, const Epi& epi, LAS char* lds) {
    const int tid = ltid(wv), lane = tid & 63, wid = tid >> 6, wm = wid >> 1, wn = wid & 1;
    const bf16_t* ap[4]; int aoff[4];
#pragma unroll
    for (int i = 0; i < 4; ++i) {
        const int c = tid + NT * i, row = c >> 3, kc = c & 7;
        ap[i] = A + (size_t)rs.src(row) * lda + kc * 8;
        aoff[i] = ((row >> 4) * 2 + (kc >> 2)) * 1024 + swz((row & 15) * 64 + (kc & 3) * 16);
    }
    const bf16_t* bp[2]; int boff[2];
#pragma unroll
    for (int i = 0; i < 2; ++i) {
        const int c = tid + NT * i, row = c >> 3, kc = c & 7;
        bp[i] = Bt + (size_t)(n0 + row) * ldb + kc * 8;
        boff[i] = G_ABYTES + ((row >> 4) * 2 + (kc >> 2)) * 1024 + swz((row & 15) * 64 + (kc & 3) * 16);
    }
    f32x4 acc[4][4];
#pragma unroll
    for (int i = 0; i < 4; ++i)
#pragma unroll
        for (int j = 0; j < 4; ++j) acc[i][j] = (f32x4){0.f, 0.f, 0.f, 0.f};
    u32x4 ra[2][4], rb[2][2];
    const int KT = K / G_BK;
    const int fragoff = swz((lane & 15) * 64 + (lane >> 4) * 16);
#define G_LOAD(set, kt_) do { _Pragma("unroll") for (int i = 0; i < 4; ++i) ra[set][i] = *(const u32x4*)(ap[i] + (kt_) * G_BK); \
                              _Pragma("unroll") for (int i = 0; i < 2; ++i) rb[set][i] = *(const u32x4*)(bp[i] + (kt_) * G_BK); } while (0)
#define G_STORE(set, buf) do { _Pragma("unroll") for (int i = 0; i < 4; ++i) *(LAS u32x4*)((buf) + aoff[i]) = ra[set][i]; \
                               _Pragma("unroll") for (int i = 0; i < 2; ++i) *(LAS u32x4*)((buf) + boff[i]) = rb[set][i]; } while (0)
#define G_COMPUTE(cur) do { bf16x8 af[2][4], bfr[2][4]; \
        _Pragma("unroll") for (int ks = 0; ks < 2; ++ks) { \
            _Pragma("unroll") for (int ni = 0; ni < 4; ++ni) bfr[ks][ni] = *(LAS bf16x8*)((cur) + G_ABYTES + ((wn * 4 + ni) * 2 + ks) * 1024 + fragoff); \
            _Pragma("unroll") for (int mi = 0; mi < 4; ++mi) af[ks][mi] = *(LAS bf16x8*)((cur) + ((wm * 4 + mi) * 2 + ks) * 1024 + fragoff); } \
        __builtin_amdgcn_sched_barrier(0); \
        _Pragma("unroll") for (int ks = 0; ks < 2; ++ks) _Pragma("unroll") for (int mi = 0; mi < 4; ++mi) _Pragma("unroll") for (int ni = 0; ni < 4; ++ni) \
            acc[mi][ni] = __builtin_amdgcn_mfma_f32_16x16x32_bf16(bfr[ks][ni], af[ks][mi], acc[mi][ni], 0, 0, 0); \
        __builtin_amdgcn_sched_barrier(0); } while (0)
    G_LOAD(0, 0);
    G_STORE(0, lds);
    if (KT > 1) G_LOAD(0, 1);
    if (KT > 2) G_LOAD(1, 2);
    __syncthreads();
    for (int kt = 0; kt < KT; kt += 2) {
        G_COMPUTE(lds);
        if (kt + 1 < KT) G_STORE(0, lds + G_BUF);
        if (kt + 3 < KT) G_LOAD(0, kt + 3);
        __syncthreads();
        if (kt + 1 < KT) {
            G_COMPUTE(lds + G_BUF);
            if (kt + 2 < KT) G_STORE(1, lds);
            if (kt + 4 < KT) G_LOAD(1, kt + 4);
            __syncthreads();
        }
    }
#undef G_LOAD
#undef G_STORE
#undef G_COMPUTE
    epi(acc, wm * 64 + (lane & 15), wn * 64 + 4 * (lane >> 4));
}

constexpr int G2_BN = 256, G2_BBYTES = G2_BN * G_BK * 2, G2_BUF = G_ABYTES + G2_BBYTES;

struct RowLinear { int m0; __device__ __forceinline__ int src(int r) const { return m0 + r; } };
struct EpiStoreBf16 {
    bf16_t* C; int ldc; int m0; int n0; int N;
    template <int NI> __device__ __forceinline__ void operator()(const f32x4 (&acc)[4][NI], int rbase, int cbase) const {
#pragma unroll
        for (int mi = 0; mi < 4; ++mi) {
            bf16_t* rowp = C + (size_t)(m0 + rbase + mi * 16) * ldc + n0 + cbase;
#pragma unroll
            for (int ni = 0; ni < NI; ++ni) {
                if (n0 + cbase + ni * 16 < N) { u32x2 v; v.x = pk2(acc[mi][ni][0], acc[mi][ni][1]); v.y = pk2(acc[mi][ni][2], acc[mi][ni][3]); *(u32x2*)(rowp + ni * 16) = v; }
            }
        }
    }
};
struct EpiDecay {
    bf16_t* Dc; const float* w0; int m0; int n0;
    template <int NI> __device__ __forceinline__ void operator()(const f32x4 (&acc)[4][NI], int rbase, int cbase) const {
#pragma unroll
        for (int ni = 0; ni < NI; ++ni) {
            const int col = n0 + cbase + ni * 16;
            const f32x4 w0v = *(const f32x4*)(w0 + col);
#pragma unroll
            for (int mi = 0; mi < 4; ++mi) {
                f32x4 o;
#pragma unroll
                for (int j = 0; j < 4; ++j) { const float w = w0v[j] + acc[mi][ni][j]; o[j] = __expf(-softplus_fast(-w) - 0.5f); }
                u32x2 ob; ob.x = pk2(o[0], o[1]); ob.y = pk2(o[2], o[3]);
                *(u32x2*)(Dc + (size_t)(m0 + rbase + mi * 16) * 512 + col) = ob;
            }
        }
    }
};
struct EpiAK {
    bf16_t* Kb; const bf16_t* KKb; bf16_t* Bb; const float* a0; const float* k_a; int m0; int n0;
    template <int NI> __device__ __forceinline__ void operator()(const f32x4 (&acc)[4][NI], int rbase, int cbase) const {
#pragma unroll
        for (int ni = 0; ni < NI; ++ni) {
            const int col = n0 + cbase + ni * 16;
            const f32x4 a0v = *(const f32x4*)(a0 + col), kav = *(const f32x4*)(k_a + col);
#pragma unroll
            for (int mi = 0; mi < 4; ++mi) {
                const size_t off = (size_t)(m0 + rbase + mi * 16) * 512 + col;
                const u32x2 kr = *(const u32x2*)(Kb + off), kkr = *(const u32x2*)(KKb + off);
                const float kf[4] = {bflo(kr.x), bfhi(kr.x), bflo(kr.y), bfhi(kr.y)}, kkf[4] = {bflo(kkr.x), bfhi(kkr.x), bflo(kkr.y), bfhi(kkr.y)};
                float k2[4], bb[4];
#pragma unroll
                for (int j = 0; j < 4; ++j) { const float a = sigmoidf_(a0v[j] + acc[mi][ni][j]); k2[j] = kf[j] * (1.f + (a - 1.f) * kav[j]); bb[j] = kkf[j] * a; }
                u32x2 v; v.x = pk2(k2[0], k2[1]); v.y = pk2(k2[2], k2[3]); *(u32x2*)(Kb + off) = v;
                v.x = pk2(bb[0], bb[1]); v.y = pk2(bb[2], bb[3]); *(u32x2*)(Bb + off) = v;
            }
        }
    }
};

namespace pg8 {
#define PG8_LAS __attribute__((address_space(3)))
constexpr int BM = 256, BK = 64, HALF = 128, HTB = HALF * BK * 2, STAGE_BYTES = 8 * HTB, NXCD = 8, WGM = 8;
__host__ __device__ __forceinline__ int lds_byte(int r, int c) { const int st = (r >> 4) * 2 + (c >> 5), rr = r & 15, cc = c & 31, ob = rr * 64 + cc * 2; return st * 1024 + (ob ^ (((ob >> 9) & 1) << 5)); }
__host__ __device__ __forceinline__ void stage_rc(int b, int& R, int& C) { const int st = b / 1024, sb = b % 1024, swz = sb ^ (((sb >> 9) & 1) << 5); R = (st >> 1) * 16 + swz / 64; C = (st & 1) * 32 + (swz % 64) / 2; }
__host__ __device__ __forceinline__ int perm32(int rho) { const int n = rho >> 4, i = rho & 15; return 8 * (i >> 2) + 4 * n + (i & 3); }
struct Unit { int pm, pn; };
struct Gemm { const bf16_t* A; const bf16_t* Bt; int M, N, K; };
struct StaticOrder {
    int nM, nN, nwg, G, c;
    __host__ __device__ void init(int M, int N, int G_, int c_) { nM = M / BM; nN = N / BM; nwg = nM * nN; G = G_; c = c_; }
    __host__ __device__ bool next(int i, Unit& u) const {
        const long L = (long)i * G + c; if (L >= nwg) return false;
        int wgid = (int)L; { const int q = nwg / NXCD, r = nwg % NXCD, xcd = wgid % NXCD, off = wgid / NXCD; wgid = (xcd < r ? xcd * (q + 1) : r * (q + 1) + (xcd - r) * q) + off; }
        const int nig = WGM * nN, gid = wgid / nig, fm = gid * WGM, gsz = (nM - fm) < WGM ? (nM - fm) : WGM;
        u.pm = fm + ((wgid % nig) % gsz); u.pn = (wgid % nig) / gsz; return true;
    }
    __device__ __forceinline__ void a_ready(const Unit&) const {}
    __device__ __forceinline__ void done(const Unit&) const {}
};
struct EpiStoreP {
    static constexpr bool PERM = true, AFTER_DRAIN = false;
    bf16_t* O; int ldc;
    __device__ __forceinline__ void operator()(const f32x4 (&acc)[2][2][4][2], const Unit& u, int wr, int wc, int fr, int fq) const {
        const int row0 = u.pm * BM + wr * 64 + fr, col0 = u.pn * BM + wc * 32 + 8 * fq;
#pragma unroll
        for (int ai = 0; ai < 2; ++ai)
#pragma unroll
            for (int m = 0; m < 4; ++m) { bf16_t* rowp = O + (size_t)(row0 + ai * HALF + m * 16) * ldc + col0;
#pragma unroll
                for (int bj = 0; bj < 2; ++bj) { const f32x4 v0 = acc[ai][bj][m][0], v1 = acc[ai][bj][m][1];
                    u32x4 w; w.x = pk2(v0[0], v0[1]); w.y = pk2(v0[2], v0[3]); w.z = pk2(v1[0], v1[1]); w.w = pk2(v1[2], v1[3]);
                    *(u32x4*)(rowp + bj * HALF) = w; } }
    }
};
template <class Epi, class Sched>
__device__ __forceinline__ void gemm_phase(int wv, PG8_LAS unsigned char* lds, const Gemm g, const Sched& S, const Epi& E) {
    const int tid = ltid(wv), wid = __builtin_amdgcn_readfirstlane(tid >> 6), lane = tid & 63, wr = wid >> 2, wc = wid & 3, fr = lane & 15, fq = lane >> 4;
    const int K = g.K, nt = K / BK;
    unsigned voffA[2], voffB[2];
#pragma unroll
    for (int i = 0; i < 2; ++i) { int R, C; stage_rc(tid * 16 + i * 8192, R, C); const int Rb = Epi::PERM ? ((R & ~31) + perm32(R & 31)) : R;
        voffA[i] = (unsigned)(R * K + C) * 2u; voffB[i] = (unsigned)(Rb * K + C) * 2u; }
    const size_t kstep = (size_t)(BK * 2);
    const size_t hstep = (size_t)HALF * K * 2;
    const size_t tstep = 2 * hstep;
    const unsigned ldsw = (unsigned)wid * 1024u;
    const int aoff = lds_byte(wr * 64 + fr, fq * 8), boff = lds_byte(wc * 32 + fr, fq * 8);
#define PG8_SA(b, h) (((b) * 2 + (h)) * HTB)
#define PG8_SB(b, h) ((4 + (b) * 2 + (h)) * HTB)
#define PG8_STAGE(bufoff, gbase, voff) do { _Pragma("unroll") for (int _i = 0; _i < 2; ++_i) \
        __builtin_amdgcn_global_load_lds((const unsigned*)((const char*)(gbase) + (voff)[_i]), (PG8_LAS unsigned*)(lds + (bufoff) + ldsw + _i * 8192), 16, 0, 0); } while (0)
#define PG8_LDA(dst, b, h) do { _Pragma("unroll") for (int m = 0; m < 4; ++m) _Pragma("unroll") for (int k = 0; k < 2; ++k) dst[m][k] = *(const PG8_LAS bf16x8*)(lds + PG8_SA(b, h) + aoff + m * 2048 + k * 1024); } while (0)
#define PG8_LDB(dst, b, h) do { _Pragma("unroll") for (int n = 0; n < 2; ++n) _Pragma("unroll") for (int k = 0; k < 2; ++k) dst[n][k] = *(const PG8_LAS bf16x8*)(lds + PG8_SB(b, h) + boff + n * 2048 + k * 1024); } while (0)
#define PG8_MMA(ai, bj, At, Bt) do { __builtin_amdgcn_s_setprio(1); _Pragma("unroll") for (int m = 0; m < 4; ++m) _Pragma("unroll") for (int n = 0; n < 2; ++n) _Pragma("unroll") for (int k = 0; k < 2; ++k) \
        acc[ai][bj][m][n] = __builtin_amdgcn_mfma_f32_16x16x32_bf16(Bt[n][k], At[m][k], acc[ai][bj][m][n], 0, 0, 0); __builtin_amdgcn_s_setprio(0); } while (0)
#define PG8_WAIT_V(n) asm volatile("s_waitcnt vmcnt(" #n ")" ::: "memory")
#define PG8_WAIT_L(n) asm volatile("s_waitcnt lgkmcnt(" #n ")" ::: "memory")
#define PG8_BAR __builtin_amdgcn_s_barrier()
#define PG8_SCHED __builtin_amdgcn_sched_barrier(0)
    Unit cur, nxt; int ui = 0;
    if (!S.next(0, cur)) return;
    f32x4 acc[2][2][4][2];
#pragma unroll
    for (int a = 0; a < 2; ++a)
#pragma unroll
        for (int b = 0; b < 2; ++b)
#pragma unroll
            for (int m = 0; m < 4; ++m)
#pragma unroll
                for (int n = 0; n < 2; ++n) acc[a][b][m][n] = (f32x4){0.f, 0.f, 0.f, 0.f};
    bf16x8 At[4][2], B0[2][2], B1[2][2];
    const char* cA = (const char*)g.A + (size_t)cur.pm * tstep; const char* cB = (const char*)g.Bt + (size_t)cur.pn * tstep;
    S.a_ready(cur);
    PG8_STAGE(PG8_SB(0, 0), cB, voffB); PG8_STAGE(PG8_SA(0, 0), cA, voffA); PG8_STAGE(PG8_SB(0, 1), cB + hstep, voffB); PG8_STAGE(PG8_SA(0, 1), cA + hstep, voffA);
    if (wr == 1) PG8_BAR;
    PG8_WAIT_V(4); PG8_BAR;
    PG8_STAGE(PG8_SB(1, 0), cB + kstep, voffB); PG8_STAGE(PG8_SA(1, 0), cA + kstep, voffA); PG8_STAGE(PG8_SB(1, 1), cB + hstep + kstep, voffB);
    PG8_WAIT_V(6); PG8_BAR;
    for (;;) {
        const bool has_next = S.next(ui + 1, nxt);
        const char* nA = has_next ? (const char*)g.A + (size_t)nxt.pm * tstep : cA; const char* nB = has_next ? (const char*)g.Bt + (size_t)nxt.pn * tstep : cB;
        for (int t = 0; t < nt; t += 2) {
            const bool last = (t == nt - 2);
            const char* a1 = cA + (size_t)(t + 1) * kstep;
            const char* a2 = last ? nA : cA + (size_t)(t + 2) * kstep; const char* b2 = last ? nB : cB + (size_t)(t + 2) * kstep;
            const char* a3 = a2 + kstep; const char* b3 = b2 + kstep;
            if (last && has_next) S.a_ready(nxt);
            PG8_LDB(B0, 0, 0); PG8_SCHED; PG8_LDA(At, 0, 0); PG8_STAGE(PG8_SA(1, 1), a1 + hstep, voffA);
            PG8_WAIT_L(8); PG8_BAR; PG8_WAIT_L(0); PG8_MMA(0, 0, At, B0); PG8_BAR; PG8_SCHED;
            PG8_LDB(B1, 0, 1); PG8_STAGE(PG8_SB(0, 0), b2, voffB);
            PG8_BAR; PG8_WAIT_L(0); PG8_MMA(0, 1, At, B1); PG8_BAR;
            PG8_LDA(At, 0, 1); PG8_STAGE(PG8_SA(0, 0), a2, voffA);
            PG8_BAR; PG8_WAIT_L(0); PG8_MMA(1, 0, At, B0); PG8_BAR; PG8_SCHED;
            PG8_STAGE(PG8_SB(0, 1), b2 + hstep, voffB);
            PG8_WAIT_V(6); PG8_BAR; PG8_MMA(1, 1, At, B1); PG8_BAR;
            PG8_LDB(B0, 1, 0); PG8_SCHED; PG8_LDA(At, 1, 0); PG8_STAGE(PG8_SA(0, 1), a2 + hstep, voffA);
            PG8_WAIT_L(8); PG8_BAR; PG8_WAIT_L(0); PG8_MMA(0, 0, At, B0); PG8_BAR; PG8_SCHED;
            PG8_LDB(B1, 1, 1); PG8_STAGE(PG8_SB(1, 0), b3, voffB);
            PG8_BAR; PG8_WAIT_L(0); PG8_MMA(0, 1, At, B1); PG8_BAR;
            PG8_LDA(At, 1, 1); PG8_STAGE(PG8_SA(1, 0), a3, voffA);
            PG8_BAR; PG8_WAIT_L(0); PG8_MMA(1, 0, At, B0); PG8_BAR; PG8_SCHED;
            PG8_STAGE(PG8_SB(1, 1), b3 + hstep, voffB);
            PG8_WAIT_V(6); PG8_BAR; PG8_MMA(1, 1, At, B1); PG8_BAR;
        }
            if constexpr (!Epi::AFTER_DRAIN) { E(acc, cur, wr, wc, fr, fq); S.done(cur); }
            if (!has_next) break;
#pragma unroll
        for (int a = 0; a < 2; ++a)
#pragma unroll
            for (int b = 0; b < 2; ++b)
#pragma unroll
                for (int m = 0; m < 4; ++m)
#pragma unroll
                    for (int n = 0; n < 2; ++n) acc[a][b][m][n] = (f32x4){0.f, 0.f, 0.f, 0.f};
        cur = nxt; cA = nA; cB = nB; ++ui;
    }
    PG8_WAIT_V(0);
    if (wr == 0) PG8_BAR;
    PG8_BAR;
    if constexpr (Epi::AFTER_DRAIN) { E.fused(acc, cur, wr, wc, fr, fq, lds, wid, lane); S.done(cur); }
#undef PG8_SA
#undef PG8_SB
#undef PG8_STAGE
#undef PG8_LDA
#undef PG8_LDB
#undef PG8_MMA
#undef PG8_WAIT_V
#undef PG8_WAIT_L
#undef PG8_BAR
#undef PG8_SCHED
}
struct UnitG { int pm, pn; const char* bbase; const PG8_LAS int* ltab; int cnt; int e; };
struct MoeOrder {
    const PG8_LAS int* tstart; const PG8_LAS int* tcnt; const PG8_LAS int* ltabs; const int* lists; const char* bt; size_t estride; int ncol, shift, G, c;
    __device__ __forceinline__ bool next(int i, UnitG& u) const {
        const int t = i * G + c; if (t >= tstart[32] * ncol) return false;
        const int tm = t / ncol; int e = 0;
#pragma unroll 1
        while (tstart[e + 1] <= tm) ++e;
        e = __builtin_amdgcn_readfirstlane(e);
        const int ts = __builtin_amdgcn_readfirstlane(tstart[e]), tc = __builtin_amdgcn_readfirstlane(tcnt[e]);
        u.pm = tm - ts; u.pn = t - tm * ncol; u.bbase = bt + (size_t)e * estride; u.e = e; u.cnt = tc - u.pm * BM; u.ltab = ltabs + i * BM;
        return true;
    }
    __device__ __forceinline__ void a_ready(const UnitG&) const {}
    __device__ __forceinline__ void done(const UnitG&) const {}
};
struct EpiSwiGLUG {
    static constexpr bool PERM = false, AFTER_DRAIN = false;
    bf16_t* H;
    __device__ __forceinline__ void operator()(const f32x4 (&acc)[2][2][4][2], const UnitG& u, int wr, int wc, int fr, int fq) const {
#pragma unroll
        for (int ai = 0; ai < 2; ++ai)
#pragma unroll
            for (int m = 0; m < 4; ++m) { const int r = ai * HALF + wr * 64 + m * 16 + fr;
                if (r < u.cnt) { bf16_t* rowp = H + (size_t)u.ltab[r] * DEXP + ((u.pn * BM + wc * 32) >> 1) + 4 * fq;
#pragma unroll
                    for (int bj = 0; bj < 2; ++bj) { const f32x4 gt = acc[ai][bj][m][0], up = acc[ai][bj][m][1];
                        u32x2 w; w.x = pk2(siluf_(gt[0]) * up[0], siluf_(gt[1]) * up[1]); w.y = pk2(siluf_(gt[2]) * up[2], siluf_(gt[3]) * up[3]);
                        *(u32x2*)(rowp + bj * (HALF / 2)) = w; } } }
    }
};
struct EpiScatterG {
    static constexpr bool PERM = true, AFTER_DRAIN = false;
    bf16_t* O;
    __device__ __forceinline__ void operator()(const f32x4 (&acc)[2][2][4][2], const UnitG& u, int wr, int wc, int fr, int fq) const {
#pragma unroll
        for (int ai = 0; ai < 2; ++ai)
#pragma unroll
            for (int m = 0; m < 4; ++m) { const int r = ai * HALF + wr * 64 + m * 16 + fr;
                if (r < u.cnt) { bf16_t* rowp = O + (size_t)u.ltab[r] * D + u.pn * BM + wc * 32 + 8 * fq;
#pragma unroll
                    for (int bj = 0; bj < 2; ++bj) { const f32x4 v0 = acc[ai][bj][m][0], v1 = acc[ai][bj][m][1];
                        u32x4 w; w.x = pk2(v0[0], v0[1]); w.y = pk2(v0[2], v0[3]); w.z = pk2(v1[0], v1[1]); w.w = pk2(v1[2], v1[3]);
                        *(u32x4*)(rowp + bj * HALF) = w; } } }
    }
};
template <class Epi, class Sched>
__device__ __forceinline__ void gemm_phase_g(int wv, PG8_LAS unsigned char* lds, const Gemm g, const Sched& S, const Epi& E) {
    const int tid = ltid(wv), wid = __builtin_amdgcn_readfirstlane(tid >> 6), lane = tid & 63, wr = wid >> 2, wc = wid & 3, fr = lane & 15, fq = lane >> 4;
    const int K = g.K, nt = K / BK;
    unsigned voffB[2];
#pragma unroll
    for (int i = 0; i < 2; ++i) { int R, C; stage_rc(tid * 16 + i * 8192, R, C); const int Rb = Epi::PERM ? ((R & ~31) + perm32(R & 31)) : R;
        voffB[i] = (unsigned)(Rb * K + C) * 2u; }
    const unsigned rowb = (unsigned)K * 2u;
#define PG8_AOFFS(u, dst) do { const int _t = ltid(wv); _Pragma("unroll") for (int _i = 0; _i < 2; ++_i) { int _R, _C; stage_rc(_t * 16 + _i * 8192, _R, _C); \
        _Pragma("unroll") for (int _h = 0; _h < 2; ++_h) dst[_h][_i] = (unsigned)((u).ltab[_h * HALF + _R] >> S.shift) * rowb + (unsigned)(_C * 2); } } while (0)
#define PG8_STAGE_A(bufoff, AO, koff) do { _Pragma("unroll") for (int _i = 0; _i < 2; ++_i) \
        __builtin_amdgcn_global_load_lds((const unsigned*)((const char*)g.A + (size_t)(AO)[_i] + (size_t)(koff)), (PG8_LAS unsigned*)(lds + (bufoff) + ldsw + _i * 8192), 16, 0, 0); } while (0)
    const size_t kstep = (size_t)(BK * 2);
    const size_t hstep = (size_t)HALF * K * 2;
    const size_t tstep = 2 * hstep;
    const unsigned ldsw = (unsigned)wid * 1024u;
    const int aoff = lds_byte(wr * 64 + fr, fq * 8), boff = lds_byte(wc * 32 + fr, fq * 8);
#define PG8_SA(b, h) (((b) * 2 + (h)) * HTB)
#define PG8_SB(b, h) ((4 + (b) * 2 + (h)) * HTB)
#define PG8_STAGE(bufoff, gbase, voff) do { _Pragma("unroll") for (int _i = 0; _i < 2; ++_i) \
        __builtin_amdgcn_global_load_lds((const unsigned*)((const char*)(gbase) + (voff)[_i]), (PG8_LAS unsigned*)(lds + (bufoff) + ldsw + _i * 8192), 16, 0, 0); } while (0)
#define PG8_LDA(dst, b, h) do { _Pragma("unroll") for (int m = 0; m < 4; ++m) _Pragma("unroll") for (int k = 0; k < 2; ++k) dst[m][k] = *(const PG8_LAS bf16x8*)(lds + PG8_SA(b, h) + aoff + m * 2048 + k * 1024); } while (0)
#define PG8_LDB(dst, b, h) do { _Pragma("unroll") for (int n = 0; n < 2; ++n) _Pragma("unroll") for (int k = 0; k < 2; ++k) dst[n][k] = *(const PG8_LAS bf16x8*)(lds + PG8_SB(b, h) + boff + n * 2048 + k * 1024); } while (0)
#define PG8_MMA(ai, bj, At, Bt) do { __builtin_amdgcn_s_setprio(1); _Pragma("unroll") for (int m = 0; m < 4; ++m) _Pragma("unroll") for (int n = 0; n < 2; ++n) _Pragma("unroll") for (int k = 0; k < 2; ++k) \
        acc[ai][bj][m][n] = __builtin_amdgcn_mfma_f32_16x16x32_bf16(Bt[n][k], At[m][k], acc[ai][bj][m][n], 0, 0, 0); __builtin_amdgcn_s_setprio(0); } while (0)
#define PG8_WAIT_V(n) asm volatile("s_waitcnt vmcnt(" #n ")" ::: "memory")
#define PG8_WAIT_L(n) asm volatile("s_waitcnt lgkmcnt(" #n ")" ::: "memory")
#define PG8_BAR __builtin_amdgcn_s_barrier()
#define PG8_SCHED __builtin_amdgcn_sched_barrier(0)
    UnitG cur, nxt; int ui = 0;
    if (!S.next(0, cur)) return;
    f32x4 acc[2][2][4][2];
#pragma unroll
    for (int a = 0; a < 2; ++a)
#pragma unroll
        for (int b = 0; b < 2; ++b)
#pragma unroll
            for (int m = 0; m < 4; ++m)
#pragma unroll
                for (int n = 0; n < 2; ++n) acc[a][b][m][n] = (f32x4){0.f, 0.f, 0.f, 0.f};
    bf16x8 At[4][2], B0[2][2], B1[2][2];
    unsigned ca[2][2]; PG8_AOFFS(cur, ca); const char* cB = cur.bbase + (size_t)cur.pn * tstep;
    S.a_ready(cur);
    PG8_STAGE(PG8_SB(0, 0), cB, voffB); PG8_STAGE_A(PG8_SA(0, 0), ca[0], 0); PG8_STAGE(PG8_SB(0, 1), cB + hstep, voffB); PG8_STAGE_A(PG8_SA(0, 1), ca[1], 0);
    if (wr == 1) PG8_BAR;
    PG8_WAIT_V(4); PG8_BAR;
    PG8_STAGE(PG8_SB(1, 0), cB + kstep, voffB); PG8_STAGE_A(PG8_SA(1, 0), ca[0], kstep); PG8_STAGE(PG8_SB(1, 1), cB + hstep + kstep, voffB);
    PG8_WAIT_V(6); PG8_BAR;
    for (;;) {
        const bool has_next = S.next(ui + 1, nxt);
        const char* nB = has_next ? nxt.bbase + (size_t)nxt.pn * tstep : cB;
        for (int t = 0; t < nt; t += 2) {
            const bool last = (t == nt - 2);
            const size_t k1 = (size_t)(t + 1) * kstep, k2 = last ? 0 : (size_t)(t + 2) * kstep;
            unsigned a2o[2][2];
            if (last && has_next) PG8_AOFFS(nxt, a2o); else { a2o[0][0] = ca[0][0]; a2o[0][1] = ca[0][1]; a2o[1][0] = ca[1][0]; a2o[1][1] = ca[1][1]; }
            const char* b2 = last ? nB : cB + (size_t)(t + 2) * kstep; const char* b3 = b2 + kstep;
            if (last && has_next) S.a_ready(nxt);
            PG8_LDB(B0, 0, 0); PG8_SCHED; PG8_LDA(At, 0, 0); PG8_STAGE_A(PG8_SA(1, 1), ca[1], k1);
            PG8_WAIT_L(8); PG8_BAR; PG8_WAIT_L(0); PG8_MMA(0, 0, At, B0); PG8_BAR; PG8_SCHED;
            PG8_LDB(B1, 0, 1); PG8_STAGE(PG8_SB(0, 0), b2, voffB);
            PG8_BAR; PG8_WAIT_L(0); PG8_MMA(0, 1, At, B1); PG8_BAR;
            PG8_LDA(At, 0, 1); PG8_STAGE_A(PG8_SA(0, 0), a2o[0], k2);
            PG8_BAR; PG8_WAIT_L(0); PG8_MMA(1, 0, At, B0); PG8_BAR; PG8_SCHED;
            PG8_STAGE(PG8_SB(0, 1), b2 + hstep, voffB);
            PG8_WAIT_V(6); PG8_BAR; PG8_MMA(1, 1, At, B1); PG8_BAR;
            PG8_LDB(B0, 1, 0); PG8_SCHED; PG8_LDA(At, 1, 0); PG8_STAGE_A(PG8_SA(0, 1), a2o[1], k2);
            PG8_WAIT_L(8); PG8_BAR; PG8_WAIT_L(0); PG8_MMA(0, 0, At, B0); PG8_BAR; PG8_SCHED;
            PG8_LDB(B1, 1, 1); PG8_STAGE(PG8_SB(1, 0), b3, voffB);
            PG8_BAR; PG8_WAIT_L(0); PG8_MMA(0, 1, At, B1); PG8_BAR;
            PG8_LDA(At, 1, 1); PG8_STAGE_A(PG8_SA(1, 0), a2o[0], k2 + kstep);
            PG8_BAR; PG8_WAIT_L(0); PG8_MMA(1, 0, At, B0); PG8_BAR; PG8_SCHED;
            PG8_STAGE(PG8_SB(1, 1), b3 + hstep, voffB);
            PG8_WAIT_V(6); PG8_BAR; PG8_MMA(1, 1, At, B1); PG8_BAR;
            if (last) { ca[0][0] = a2o[0][0]; ca[0][1] = a2o[0][1]; ca[1][0] = a2o[1][0]; ca[1][1] = a2o[1][1]; }
        }
            if constexpr (!Epi::AFTER_DRAIN) { E(acc, cur, wr, wc, fr, fq); S.done(cur); }
            if (!has_next) break;
#pragma unroll
        for (int a = 0; a < 2; ++a)
#pragma unroll
            for (int b = 0; b < 2; ++b)
#pragma unroll
                for (int m = 0; m < 4; ++m)
#pragma unroll
                    for (int n = 0; n < 2; ++n) acc[a][b][m][n] = (f32x4){0.f, 0.f, 0.f, 0.f};
        cur = nxt; cB = nB; ++ui;
    }
    PG8_WAIT_V(0);
    if (wr == 0) PG8_BAR;
    PG8_BAR;
    if constexpr (Epi::AFTER_DRAIN) { E.fused(acc, cur, wr, wc, fr, fq, lds, wid, lane); S.done(cur); }
#undef PG8_SA
#undef PG8_AOFFS
#undef PG8_STAGE_A
#undef PG8_SB
#undef PG8_STAGE
#undef PG8_LDA
#undef PG8_LDB
#undef PG8_MMA
#undef PG8_WAIT_V
#undef PG8_WAIT_L
#undef PG8_BAR
#undef PG8_SCHED
}
}

__device__ __forceinline__ void transpose_item(const float* __restrict__ W, int K, int N, bf16_t* __restrict__ WT, int mode, LAS float* scr, int item, int lane) {
    const int nblk = N / 32, kb = item / nblk, nb = item % nblk, k0 = 64 * kb, n0 = 32 * nb;
    {
        const float* wp = W + (size_t)(k0 + (lane >> 5)) * N + n0 + (lane & 31);
        float t[32];
#pragma unroll
        for (int i = 0; i < 32; ++i) t[i] = wp[(size_t)(2 * i) * N];
#pragma unroll
        for (int i = 0; i < 32; ++i) scr[(2 * i + (lane >> 5)) * 33 + (lane & 31)] = t[i];
    }
    asm volatile("s_waitcnt lgkmcnt(0)" ::: "memory");
    const int c = lane & 7;
#pragma unroll
    for (int j = 0; j < 4; ++j) {
        const int nl = (lane >> 3) + 8 * j; const LAS float* s = scr + (8 * c) * 33 + nl;
        u32x4 o; o.x = pk2(s[0 * 33], s[1 * 33]); o.y = pk2(s[2 * 33], s[3 * 33]); o.z = pk2(s[4 * 33], s[5 * 33]); o.w = pk2(s[6 * 33], s[7 * 33]);
        const int n = n0 + nl;
        const int nd = mode == 0 ? n : (32 * (n >> 4) + (n & 15) + (mode == 2 ? 16 : 0));
        *(u32x4*)(WT + (size_t)nd * K + k0 + 8 * c) = o;
    }
    asm volatile("s_waitcnt lgkmcnt(0)" ::: "memory");
}

constexpr int EXC_IG = 16 * 16, EXC_IDN = 8 * 32, EXC_PER = 2 * EXC_IG + EXC_IDN, EXC_ITEMS = NEXP * EXC_PER;
__device__ __forceinline__ int exc_s0(int layer) { return (layer & 1) ? 8192 : 10240; }
__device__ __forceinline__ int exc_s1(int layer) { return (layer & 1) ? 0 : 7168; }
__device__ __forceinline__ void expconv_items(const CAS Params& P, int layer, LAS char* lds, int lo, int hi, int worker, int nworkers, int wid, int lane) {
    LAS float* scr = (LAS float*)(lds + wid * 8448);
    bf16_t* gu = (bf16_t*)(P.ws + WS_EXPGU); bf16_t* dw = (bf16_t*)(P.ws + WS_EXPD);
    for (int it = lo + worker; it < hi; it += nworkers) {
        const int e = it / EXC_PER; int r = it % EXC_PER;
        const size_t eo = (size_t)(layer * NEXP + e);
        if (r < EXC_IG) { transpose_item(P.exp_w_gate + eo * D * DEXP, D, DEXP, gu + (size_t)e * 1024 * 1024, 1, scr, r, lane); continue; } r -= EXC_IG;
        if (r < EXC_IG) { transpose_item(P.exp_w_up + eo * D * DEXP, D, DEXP, gu + (size_t)e * 1024 * 1024, 2, scr, r, lane); continue; } r -= EXC_IG;
        transpose_item(P.exp_w_down + eo * DEXP * D, DEXP, D, dw + (size_t)e * 1024 * 512, 0, scr, r, lane);
    }
}
__device__ __forceinline__ void expconv_tail(int wv, const CAS Params& P, int layer, LAS char* lds, int nwg, int lo, int hi) {
    const int G = gridDim.x, rem = nwg % G;
    if (rem != 0 && (int)blockIdx.x >= rem && lo < hi) {
        const int tid = ltid(wv);
        __syncthreads();
        expconv_items(P, layer, lds, lo, hi, ((int)blockIdx.x - rem) * 8 + (tid >> 6), (G - rem) * 8, tid >> 6, tid & 63);
    }
}

__device__ __forceinline__ void phase_prologue0(int wv, KP Pk, LAS char* lds) {
    asm volatile("" : "+s"(Pk));
    const CAS Params& P = *Pk;
    const int tid = ltid(wv), lane = tid & 63, wid = tid >> 6;
    const int gw = blockIdx.x * 8 + wid, NGW = gridDim.x * 8;
    LAS float* scr = (LAS float*)(lds + wid * 8448);
    bf16_t* winT = (bf16_t*)(P.ws + WS_WINT);
    bf16_t* woutT = (bf16_t*)(P.ws + WS_WOUTT);
    bf16_t* loraT = (bf16_t*)(P.ws + WS_LORAT);
    constexpr int I_EV = 16 * (P_EVEN / 32), I_OD = 16 * (P_ODD / 32), I_O = 16 * 32, I_L64 = 16, I_L128 = 32;
    constexpr int I_LORA = 3 * I_L64 + I_L128;
    constexpr int NIT = 2 * I_EV + 2 * I_OD + 4 * I_O + 2 * I_LORA;
    for (int it = gw; it < NIT; it += NGW) {
        int r = it;
        if (r < 2 * I_EV) { const int i = r / I_EV; transpose_item(P.ev_w_in + (size_t)i * D * P_EVEN, D, P_EVEN, winT + (i ? WINT_L2 : WINT_L0), 0, scr, r % I_EV, lane); continue; } r -= 2 * I_EV;
        if (r < 2 * I_OD) { const int i = r / I_OD; transpose_item(P.od_w_in + (size_t)i * D * P_ODD, D, P_ODD, winT + (i ? WINT_L3 : WINT_L1), 0, scr, r % I_OD, lane); continue; } r -= 2 * I_OD;
        if (r < 4 * I_O) { const int l = r / I_O; const float* src = (l & 1) ? P.od_w_out + (size_t)(l >> 1) * D * D : P.ev_w_out + (size_t)(l >> 1) * D * D;
            transpose_item(src, D, D, woutT + (size_t)l * D * D, 0, scr, r % I_O, lane); continue; } r -= 4 * I_O;
        { const int i = r / I_LORA; int q = r % I_LORA; bf16_t* dst = loraT + (size_t)i * LORA_PER;
          if (q < I_L64) { transpose_item(P.rw_w2 + (size_t)(i * 2 + 0) * 64 * 512, 64, 512, dst, 0, scr, q, lane); continue; } q -= I_L64;
          if (q < I_L64) { transpose_item(P.rw_w2 + (size_t)(i * 2 + 1) * 64 * 512, 64, 512, dst + 512 * 64, 0, scr, q, lane); continue; } q -= I_L64;
          if (q < I_L64) { transpose_item(P.rw_a2 + (size_t)i * 64 * 512, 64, 512, dst + 2 * 512 * 64, 0, scr, q, lane); continue; } q -= I_L64;
          transpose_item(P.rw_g2 + (size_t)i * 128 * 512, 128, 512, dst + 3 * 512 * 64, 0, scr, q, lane); }
    }
    {
        const int gt = blockIdx.x * NT + tid, NG = gridDim.x * NT;
        constexpr int PADE = (LDP_EVEN - P_EVEN) * D / 8, PADO = (LDP_ODD - P_ODD) * D / 8;
        for (int i = gt; i < 2 * PADE + 2 * PADO; i += NG) {
            int r = i; bf16_t* dst;
            if (r < 2 * PADE) { const int l = r / PADE; dst = winT + (l ? WINT_L2 : WINT_L0) + (size_t)P_EVEN * D + (size_t)(r % PADE) * 8; }
            else { r -= 2 * PADE; const int l = r / PADO; dst = winT + (l ? WINT_L3 : WINT_L1) + (size_t)P_ODD * D + (size_t)(r % PADO) * 8; }
            *(u32x4*)dst = (u32x4){0u, 0u, 0u, 0u};
        }
    }
    {
        const int gt = blockIdx.x * NT + tid, NG = gridDim.x * NT;
        float* lb = (float*)(P.ws + WS_LB);
        for (int ch = gt; ch < 512; ch += NG) {
            float lg[4], mx = -1e30f;
#pragma unroll
            for (int l = 0; l < 4; ++l) { lg[l] = P.hg_lb_logits[l * 512 + ch]; mx = fmaxf(mx, lg[l]); }
            float e[4], s = 0.f;
#pragma unroll
            for (int l = 0; l < 4; ++l) { e[l] = __expf(lg[l] - mx); s += e[l]; }
            float cum = 0.f;
#pragma unroll
            for (int l = 0; l < 4; ++l) { if (l > 0) cum += e[l] / s; lb[l * 512 + ch] = cum; }
        }
    }
    __syncthreads();
    {
        LAS float* sc = (LAS float*)lds;
        LAS float* red = (LAS float*)(lds + 5 * 1024 * 4);
        for (int i = tid; i < 5 * D; i += NT) { const int m = i >> 10, k = i & 1023; const float v = m < 4 ? P.c[m * D + k] : P.c_ctx[k]; sc[i] = siluf_(v); }
        __syncthreads();
        float* modv = (float*)(P.ws + WS_MODV);
        for (int cb = blockIdx.x; cb < 4 * 6144 / 96; cb += gridDim.x) {
            const int l = (cb * 96) / 6144, j0 = (cb * 96) % 6144;
            const int cg = tid % 24, kg = tid / 24;
            if (tid < 384) {
                const float* w = P.mod_w + (size_t)l * D * 6144 + (size_t)(kg * 64) * 6144 + j0 + 4 * cg;
                f32x4 a[5];
#pragma unroll
                for (int m = 0; m < 5; ++m) a[m] = (f32x4){0.f, 0.f, 0.f, 0.f};
#pragma unroll 1
                for (int k0 = 0; k0 < 64; k0 += 16) {
                    f32x4 wv4[16];
#pragma unroll
                    for (int u = 0; u < 16; ++u) wv4[u] = *(const f32x4*)(w + (size_t)(k0 + u) * 6144);
#pragma unroll
                    for (int u = 0; u < 16; ++u)
#pragma unroll
                        for (int m = 0; m < 5; ++m) a[m] += wv4[u] * sc[m * 1024 + kg * 64 + k0 + u];
                }
#pragma unroll
                for (int m = 0; m < 5; ++m) *(LAS f32x4*)(red + ((kg * 5 + m) * 96 + 4 * cg)) = a[m];
            }
            __syncthreads();
            if (tid < 480) {
                const int m = tid / 96, c = tid % 96;
                float sum = 0.f;
#pragma unroll
                for (int g = 0; g < 16; ++g) sum += red[(g * 5 + m) * 96 + c];
                modv[(size_t)(l * 5 + m) * 6144 + j0 + c] = sum + P.mod_b[l * 6144 + j0 + c];
            }
            __syncthreads();
        }
    }
}

__device__ __forceinline__ void phase_prologue1(int wv, KP Pk) {
    asm volatile("" : "+s"(Pk));
    const CAS Params& P = *Pk;
    const int tid = ltid(wv), lane = tid & 63, wid = tid >> 6;
    bf16_t* act = (bf16_t*)(P.ws + WS_ACT);
    f32x4 nv[4];
    auto fetch = [&](int rr) {
        const float* src = rr < NCTX ? P.ctx + (size_t)rr * D : P.x + (size_t)(rr - NCTX) * D;
#pragma unroll
        for (int i = 0; i < 4; ++i) nv[i] = *(const f32x4*)(src + 4 * lane + 256 * i);
    };
    const int stride = gridDim.x * 8;
    int r = blockIdx.x * 8 + wid;
    if (r < NROWS) fetch(r);
    for (; r < NROWS; r += stride) {
        const int m = row_mod(r);
        const f32x4 cv[4] = {nv[0], nv[1], nv[2], nv[3]};
        if (r + stride < NROWS) fetch(r + stride);
        const float* sh = modvec(P.ws, 0, m, 0); const float* sc = modvec(P.ws, 0, m, 1);
#pragma unroll
        for (int i = 0; i < 4; ++i) {
            const int c = 4 * lane + 256 * i;
            const f32x4 v = cv[i], s1 = *(const f32x4*)(sc + c), h1 = *(const f32x4*)(sh + c);
            u32x2 o; o.x = pk2(v[0] * (1.f + s1[0]) + h1[0], v[1] * (1.f + s1[1]) + h1[1]); o.y = pk2(v[2] * (1.f + s1[2]) + h1[2], v[3] * (1.f + s1[3]) + h1[3]);
            *(u32x2*)(act + (size_t)r * D + c) = o;
        }
    }
}

__device__ __forceinline__ void phase_inproj(int wv, KP Pk, int layer, LAS char* lds) {
    asm volatile("" : "+s"(Pk));
    const CAS Params& P = *Pk;
    const int odd = layer & 1, ldp = odd ? LDP_ODD : LDP_EVEN;
    const size_t woff = layer == 0 ? WINT_L0 : layer == 1 ? WINT_L1 : layer == 2 ? WINT_L2 : WINT_L3;
    pg8::Gemm g{(const bf16_t*)(P.ws + WS_ACT), (const bf16_t*)(P.ws + WS_WINT) + woff, NROWS, ldp, D};
    pg8::StaticOrder S; S.init(NROWS, ldp, (int)gridDim.x, (int)blockIdx.x);
    pg8::EpiStoreP E{(bf16_t*)(P.ws + WS_P), ldp};
    pg8::gemm_phase(wv, (PG8_LAS unsigned char*)lds, g, S, E);
    expconv_tail(wv, P, layer, lds, (NROWS / 256) * (ldp / 256), 0, exc_s0(layer));
}
__device__ __forceinline__ void phase_outproj(int wv, KP Pk, int layer, LAS char* lds) {
    asm volatile("" : "+s"(Pk));
    const CAS Params& P = *Pk;
    const int r0 = (layer == DEPTH - 1) ? NCTX : 0;
    pg8::Gemm g{(const bf16_t*)(P.ws + WS_FEAT) + (size_t)r0 * D, (const bf16_t*)(P.ws + WS_WOUTT) + (size_t)layer * D * D, NROWS - r0, D, D};
    pg8::StaticOrder S; S.init(NROWS - r0, D, (int)gridDim.x, (int)blockIdx.x);
    pg8::EpiStoreP E{(bf16_t*)(P.ws + WS_YO) + (size_t)r0 * D, D};
    pg8::gemm_phase(wv, (PG8_LAS unsigned char*)lds, g, S, E);
    expconv_tail(wv, P, layer, lds, ((NROWS - r0) / 256) * (D / 256), exc_s0(layer), exc_s0(layer) + exc_s1(layer));
}
__device__ __forceinline__ void phase_prep2(int wv, KP Pk, int layer, LAS char* lds) {
    asm volatile("" : "+s"(Pk));
    const CAS Params& P = *Pk;
    const int i = layer >> 1;
    const bf16_t* la = (const bf16_t*)(P.ws + WS_LA);
    const bf16_t* lt = (const bf16_t*)(P.ws + WS_LORAT) + (size_t)i * LORA_PER;
    constexpr int MT = NROWS / G_BM, NTL = 512 / G_BN;
    const int ntiles = 4 * MT * NTL;
    for (int t = blockIdx.x; t < ntiles; t += gridDim.x) {
        const int which = t / (MT * NTL), r = t % (MT * NTL), mt = r / NTL, nt = r % NTL;
        RowLinear rs{mt * G_BM};
        if (which < 2) {
            EpiDecay epi{(bf16_t*)(P.ws + WS_RWDEC) + (size_t)which * NROWS * 512, P.rw_w0 + (size_t)(i * 2 + which) * 512, mt * G_BM, nt * G_BN};
            gemm_tile(wv, la + which * 64, 320, rs, lt + (size_t)which * 512 * 64, 64, nt * G_BN, 64, epi, lds);
        } else if (which == 2) {
            EpiAK epi{(bf16_t*)(P.ws + WS_RWK), (const bf16_t*)(P.ws + WS_RWKK), (bf16_t*)(P.ws + WS_RWB), P.rw_a0 + i * 512, P.rw_k_a + i * 512, mt * G_BM, nt * G_BN};
            gemm_tile(wv, la + 128, 320, rs, lt + (size_t)2 * 512 * 64, 64, nt * G_BN, 64, epi, lds);
        } else {
            EpiStoreBf16 epi{(bf16_t*)(P.ws + WS_RWG), 512, mt * G_BM, nt * G_BN, 512};
            gemm_tile(wv, la + 192, 320, rs, lt + (size_t)3 * 512 * 64, 128, nt * G_BN, 128, epi, lds);
        }
    }
}
__device__ __forceinline__ void moe_tiles(int wv, const unsigned char* ws, int layer, LAS int* tstart, LAS int* tcnt) {
    const int tid = ltid(wv);
    if (tid < 64) {
        const int* cnt = (const int*)(ws + WS_CNT) + layer * 32 * CNT_STRIDE;
        const int c = tid < NEXP ? cnt[tid * CNT_STRIDE] : 0;
        int incl = (c + G_BM - 1) / G_BM;
#pragma unroll
        for (int o = 1; o < 32; o <<= 1) { const int t = __shfl_up(incl, o); if (tid >= o) incl += t; }
        if (tid < NEXP) { tcnt[tid] = c; tstart[tid] = incl - (c + G_BM - 1) / G_BM; }
        if (tid == NEXP - 1) tstart[NEXP] = incl;
    }
    __syncthreads();
}
__device__ __forceinline__ void phase_moe1(int wv, KP Pk, int layer, LAS char* lds) {
    asm volatile("" : "+s"(Pk));
    const CAS Params& P = *Pk;
    LAS int* tstart = (LAS int*)(lds + pg8::STAGE_BYTES); LAS int* tcnt = tstart + 40;
    moe_tiles(wv, P.ws, layer, tstart, tcnt);
    pg8::Gemm g{(const bf16_t*)(P.ws + WS_ACT), (const bf16_t*)(P.ws + WS_EXPGU), 0, 1024, D};
    LAS int* ltabs = tstart + 128;
    pg8::MoeOrder S{tstart, tcnt, ltabs, (const int*)(P.ws + WS_LIST), (const char*)(P.ws + WS_EXPGU), (size_t)1024 * 1024 * 2, 4, 1, (int)gridDim.x, (int)blockIdx.x};
    pg8::EpiSwiGLUG E{(bf16_t*)(P.ws + WS_HID)};
    for (int i = 0; i < 8; ++i) {
        pg8::UnitG u; if (!S.next(i, u)) break;
        const int tl = ltid(wv);
        const int* ul = (const int*)(P.ws + WS_LIST) + (size_t)u.e * LISTCAP + u.pm * pg8::BM;
        if (tl < pg8::BM) ltabs[i * pg8::BM + tl] = ul[tl < u.cnt ? tl : 0];
    }
    __syncthreads();
    pg8::gemm_phase_g(wv, (PG8_LAS unsigned char*)lds, g, S, E);
    __syncthreads();
}
__device__ __forceinline__ void phase_moe2(int wv, KP Pk, int layer, LAS char* lds) {
    asm volatile("" : "+s"(Pk));
    const CAS Params& P = *Pk;
    LAS int* tstart = (LAS int*)(lds + pg8::STAGE_BYTES); LAS int* tcnt = tstart + 40;
    moe_tiles(wv, P.ws, layer, tstart, tcnt);
    pg8::Gemm g{(const bf16_t*)(P.ws + WS_HID), (const bf16_t*)(P.ws + WS_EXPD), 0, 1024, DEXP};
    LAS int* ltabs = tstart + 128;
    pg8::MoeOrder S{tstart, tcnt, ltabs, (const int*)(P.ws + WS_LIST), (const char*)(P.ws + WS_EXPD), (size_t)1024 * 512 * 2, 4, 0, (int)gridDim.x, (int)blockIdx.x};
    pg8::EpiScatterG E{(bf16_t*)(P.ws + WS_YP)};
    for (int i = 0; i < 8; ++i) {
        pg8::UnitG u; if (!S.next(i, u)) break;
        const int tl = ltid(wv);
        const int* ul = (const int*)(P.ws + WS_LIST) + (size_t)u.e * LISTCAP + u.pm * pg8::BM;
        if (tl < pg8::BM) ltabs[i * pg8::BM + tl] = ul[tl < u.cnt ? tl : 0];
    }
    __syncthreads();
    pg8::gemm_phase_g(wv, (PG8_LAS unsigned char*)lds, g, S, E);
    __syncthreads();
}

constexpr int NCHUNK = NSTEPS / TCH;

constexpr int SSD_F = 32 + 64 + 64;
constexpr int SSD_BUF = TCH * SSD_F + 3 * TCH;

constexpr int ML_F = 64 + 64 + 32;
constexpr int ML_BUF = TCH * ML_F + 4 * TCH;

constexpr int HG_F = 128 + 128 + 32;
constexpr int HG_BUF = TCH * HG_F + TCH;

constexpr int RW_F = 5 * 64 + 32;
constexpr int RW_BUF = TCH * RW_F + TCH;
__device__ __forceinline__ void scan_rwkv_b(int wv, KP Pk, int layer, int unit, LAS char* lds) {
    asm volatile("" : "+s"(Pk));
    const CAS Params& P = *Pk;
    const int tid = ltid(wv);
    const int seq = unit >> 1, half = unit & 1, b = seq >> 4, h = (seq >> 1) & 7, dir = seq & 1;
    LAS float* bufs = (LAS float*)lds;
    bf16_t* Y = (bf16_t*)(P.ws + (dir ? WS_YB : WS_YF));
    const bf16_t* dec = (const bf16_t*)(P.ws + WS_RWDEC) + (size_t)dir * NROWS * 512;
    constexpr int NS = 6, NG = 44;
    const int stid = tid - 256;
    int tj[NS], tg_[NS]; bool tv[NS]; const unsigned char* tbase[NS]; int tlds[NS];
#pragma unroll
    for (int s = 0; s < NS; ++s) {
        const int task = stid + 256 * s; tv[s] = stid >= 0 && task < TCH * NG; tj[s] = task / NG; tg_[s] = task % NG;
        const int g = tg_[s];
        if (g < 8)       { tbase[s] = P.ws + WS_RWR  + (size_t)(h * 64 + 8 * g) * 2;              tlds[s] = 256 + 8 * g; }
        else if (g < 16) { tbase[s] = P.ws + WS_RWK  + (size_t)(h * 64 + 8 * (g - 8)) * 2;        tlds[s] = 192 + 8 * (g - 8); }
        else if (g < 24) { tbase[s] = P.ws + WS_RWKK + (size_t)(h * 64 + 8 * (g - 16)) * 2;       tlds[s] = 64 + 8 * (g - 16); }
        else if (g < 32) { tbase[s] = P.ws + WS_RWB  + (size_t)(h * 64 + 8 * (g - 24)) * 2;       tlds[s] = 128 + 8 * (g - 24); }
        else if (g < 36) { tbase[s] = P.ws + WS_RWV  + (size_t)(h * 64 + half * 32 + 8 * (g - 32)) * 2; tlds[s] = 320 + 8 * (g - 32); }
        else             { tbase[s] = (const unsigned char*)(dec + h * 64 + 8 * (g - 36));        tlds[s] = 8 * (g - 36); }
    }
    u32x4 rc[NS]; int rrow = 0;
    auto load = [&](int c) {
#pragma unroll
        for (int s = 0; s < NS; ++s) {
            rc[s] = (u32x4){0u, 0u, 0u, 0u};
            if (tv[s]) { const int row = scan_row(c * TCH + tj[s], b, dir, 1); rc[s] = *(const u32x4*)(tbase[s] + (size_t)row * 1024); }
        }
        if (stid >= 0 && stid < TCH) rrow = scan_row(c * TCH + stid, b, dir, 1);
    };
    auto store = [&](int c) {
        LAS float* buf = bufs + (c & 1) * RW_BUF;
#pragma unroll
        for (int s = 0; s < NS; ++s) {
            if (tv[s]) {
                LAS float* dst = buf + tj[s] * RW_F + tlds[s];
                const int g = tg_[s];
                if (g >= 36) {
                    float f[8]; unpack8(rc[s], f);
                    *(LAS f32x4*)dst = (f32x4){__expf(-f[0]), __expf(-f[1]), __expf(-f[2]), __expf(-f[3])}; *(LAS f32x4*)(dst + 4) = (f32x4){__expf(-f[4]), __expf(-f[5]), __expf(-f[6]), __expf(-f[7])};
                } else {
                    float f[8]; unpack8(rc[s], f);
                    const float sg = (g >= 16 && g < 24) ? -1.f : 1.f;
                    *(LAS f32x4*)dst = (f32x4){sg * f[0], sg * f[1], sg * f[2], sg * f[3]}; *(LAS f32x4*)(dst + 4) = (f32x4){sg * f[4], sg * f[5], sg * f[6], sg * f[7]};
                }
            }
        }
        if (stid >= 0 && stid < TCH) ((LAS int*)buf)[TCH * RW_F + stid] = rrow;
    };
    const int q = tid & 15, vr = (tid >> 4) & 3, rowA = 8 * wv + vr, rowB = rowA + 4;
    f32x2 A01 = {0.f, 0.f}, A23 = {0.f, 0.f}, B01 = {0.f, 0.f}, B23 = {0.f, 0.f};
    LAS float* ypw = bufs + 2 * RW_BUF + (wv & 3) * (2 * 16 * 132);
    int prow = -1, gpar = 0;
    if (wv >= 4) { load(0); store(0); }
    __syncthreads();
    for (int c = 0; c < NCHUNK; ++c) {
        if (wv >= 4 && c + 1 < NCHUNK) load(c + 1);
        LAS float* buf = bufs + (c & 1) * RW_BUF;
        if (wv < 4) {
            const LAS float* wp = buf + 4 * q;
            const LAS float* vpA = buf + 320 + rowA; const LAS float* vpB = buf + 320 + rowB;
            f32x4 w4 = *(const LAS f32x4*)wp, a4 = *(const LAS f32x4*)(wp + 64), b4 = *(const LAS f32x4*)(wp + 128), k4 = *(const LAS f32x4*)(wp + 192), r4 = *(const LAS f32x4*)(wp + 256); float vrA = vpA[0], vrB = vpB[0];
#pragma unroll 1
            for (int jh = 0; jh < 2; ++jh) {
                const LAS float* rp = ypw + (gpar ^ 1) * (16 * 132) + q * 132 + vr * 16;
                const f32x4 pa0 = *(const LAS f32x4*)rp, pa1 = *(const LAS f32x4*)(rp + 4), pa2 = *(const LAS f32x4*)(rp + 8), pa3 = *(const LAS f32x4*)(rp + 12);
                const f32x4 pb0 = *(const LAS f32x4*)(rp + 64), pb1 = *(const LAS f32x4*)(rp + 68), pb2 = *(const LAS f32x4*)(rp + 72), pb3 = *(const LAS f32x4*)(rp + 76);
                LAS float* wpz = ypw + gpar * (16 * 132) + (tid & 63);
#pragma unroll
                for (int j = 0; j < 16; ++j) {
                    const int jj = jh * 16 + j;
                    const f32x4 wc = w4, ac = a4, bc = b4, kc = k4, rc = r4; const float vvA = vrA, vvB = vrB;
                    if (j < 15 || jh == 0) {
                        const LAS float* np = wp + (jj + 1) * RW_F;
                        w4 = *(const LAS f32x4*)np; a4 = *(const LAS f32x4*)(np + 64); b4 = *(const LAS f32x4*)(np + 128); k4 = *(const LAS f32x4*)(np + 192); r4 = *(const LAS f32x4*)(np + 256);
                        vrA = vpA[(jj + 1) * RW_F]; vrB = vpB[(jj + 1) * RW_F];
                    }
                    const f32x2 a01 = {ac[0], ac[1]}, a23 = {ac[2], ac[3]}, w01 = {wc[0], wc[1]}, w23 = {wc[2], wc[3]}, b01 = {bc[0], bc[1]}, b23 = {bc[2], bc[3]};
                    const f32x2 k01 = {kc[0], kc[1]}, k23 = {kc[2], kc[3]}, r01 = {rc[0], rc[1]}, r23 = {rc[2], rc[3]}, va2 = {vvA, vvA}, vb2 = {vvB, vvB};
                    f32x2 tA = A01 * a01; tA = A23 * a23 + tA;
                    f32x2 tB = B01 * a01; tB = B23 * a23 + tB;
                    const f32x2 uA01 = A01 * w01 + va2 * k01, uA23 = A23 * w23 + va2 * k23, uB01 = B01 * w01 + vb2 * k01, uB23 = B23 * w23 + vb2 * k23;
                    const float saA = allreduce16(tA.x + tA.y), saB = allreduce16(tB.x + tB.y);
                    const f32x2 sA2 = {saA, saA}, sB2 = {saB, saB};
                    A01 = sA2 * b01 + uA01; A23 = sA2 * b23 + uA23; B01 = sB2 * b01 + uB01; B23 = sB2 * b23 + uB23;
                    f32x2 yA = A01 * r01; yA = A23 * r23 + yA;
                    f32x2 yB = B01 * r01; yB = B23 * r23 + yB;
                    wpz[j * 132] = yA.x + yA.y; wpz[j * 132 + 64] = yB.x + yB.y;
                }
                if (prow >= 0) {
                    const f32x4 ta = (pa0 + pa1) + (pa2 + pa3), tb = (pb0 + pb1) + (pb2 + pb3);
                    bf16_t* yo = Y + (size_t)prow * D + 512 + h * 64 + half * 32;
                    yo[rowA] = f2bf((ta[0] + ta[1]) + (ta[2] + ta[3])); yo[rowB] = f2bf((tb[0] + tb[1]) + (tb[2] + tb[3]));
                }
                prow = ((const LAS int*)buf)[TCH * RW_F + jh * 16 + q];
                gpar ^= 1;
            }
        }
        if (wv >= 4 && c + 1 < NCHUNK) store(c + 1);
        __syncthreads();
    }
    if (wv < 4) {
        const LAS float* rp = ypw + (gpar ^ 1) * (16 * 132) + q * 132 + vr * 16;
        const f32x4 ta = (*(const LAS f32x4*)rp + *(const LAS f32x4*)(rp + 4)) + (*(const LAS f32x4*)(rp + 8) + *(const LAS f32x4*)(rp + 12));
        const f32x4 tb = (*(const LAS f32x4*)(rp + 64) + *(const LAS f32x4*)(rp + 68)) + (*(const LAS f32x4*)(rp + 72) + *(const LAS f32x4*)(rp + 76));
        bf16_t* yo = Y + (size_t)prow * D + 512 + h * 64 + half * 32;
        yo[rowA] = f2bf((ta[0] + ta[1]) + (ta[2] + ta[3])); yo[rowB] = f2bf((tb[0] + tb[1]) + (tb[2] + tb[3]));
    }
}

constexpr size_t WS_EXBC = WS_RWR;
constexpr size_t WS_EQK = WS_EXBC + (size_t)NROWS * 768 * 2;
constexpr size_t WS_EGT = WS_EQK + (size_t)NROWS * 512 * 2;
static_assert(WS_EGT + (size_t)NROWS * 32 * 4 <= WS_LA, "even-layer prepare buffers must fit in the RWKV region");

__device__ __forceinline__ void phase_prep_even(int wv, KP Pk, int layer) {
    asm volatile("" : "+s"(Pk));
    const CAS Params& P = *Pk;
    const int tid = ltid(wv), lane = tid & 63, wid = tid >> 6, i_ = layer >> 1;
    const bf16_t* Pb = (const bf16_t*)(P.ws + WS_P);
    bf16_t* XBC = (bf16_t*)(P.ws + WS_EXBC); bf16_t* QK = (bf16_t*)(P.ws + WS_EQK); float* GT = (float*)(P.ws + WS_EGT);
    float cw0[4][8], cw1[4][8], cwq[4][8];
#pragma unroll
    for (int e = 0; e < 8; ++e) {
#pragma unroll
        for (int t = 0; t < 3; ++t) {
            cw0[t][e] = P.ssd_conv_w[(size_t)(i_ * 3 + t) * 768 + 8 * lane + e];
            cw1[t][e] = P.ssd_conv_w[(size_t)(i_ * 3 + t) * 768 + 512 + 8 * (lane & 31) + e];
            cwq[t][e] = P.ml_conv_w[(size_t)(i_ * 3 + t) * 512 + 8 * lane + e];
        }
        cw0[3][e] = P.ssd_conv_b[i_ * 768 + 8 * lane + e]; cw1[3][e] = P.ssd_conv_b[i_ * 768 + 512 + 8 * (lane & 31) + e]; cwq[3][e] = P.ml_conv_b[i_ * 512 + 8 * lane + e];
    }
    float gbias = 0.f;
    if (lane < 16) gbias = P.ssd_dt_bias[i_ * 16 + lane]; else if (lane < 24) gbias = P.ml_i_bias[i_ * 8 + lane - 16]; else if (lane < 32) gbias = P.ml_f_bias[i_ * 8 + lane - 24];
    const float qscl = lane < 32 ? 0.125f : 1.f;
    const u32x4 zero = (u32x4){0u, 0u, 0u, 0u};
    u32x4 nA[3], nB[3], nC[3]; bf16_t ng = 0;
    auto fetch = [&](int rr) {
        int t, len; row_seg(rr, t, len);
        const bf16_t* pr = Pb + (size_t)rr * LDP_EVEN;
        const bool hp = t > 0, hn = t < len - 1;
        { const int col = 512 + 8 * lane; nA[0] = *(const u32x4*)(pr + col); nA[1] = hp ? *(const u32x4*)(pr - LDP_EVEN + col) : zero; nA[2] = hn ? *(const u32x4*)(pr + LDP_EVEN + col) : zero; }
        if (lane < 32) { const int col = 1024 + 8 * lane; nB[0] = *(const u32x4*)(pr + col); nB[1] = hp ? *(const u32x4*)(pr - LDP_EVEN + col) : zero; nB[2] = hn ? *(const u32x4*)(pr + LDP_EVEN + col) : zero; }
        { const int col = 1296 + 8 * lane; nC[0] = *(const u32x4*)(pr + col); nC[1] = hp ? *(const u32x4*)(pr - LDP_EVEN + col) : zero; nC[2] = hn ? *(const u32x4*)(pr + LDP_EVEN + col) : zero; }
        if (lane < 32) ng = pr[lane < 16 ? 1280 + lane : 2832 + (lane - 16)];
    };
    nB[0] = nB[1] = nB[2] = zero;
    const int stride = gridDim.x * 8;
    int r = blockIdx.x * 8 + wid;
    if (r < NROWS) fetch(r);
    for (; r < NROWS; r += stride) {
        const u32x4 cA0 = nA[0], cA1 = nA[1], cA2 = nA[2], cB0 = nB[0], cB1 = nB[1], cB2 = nB[2], cC0 = nC[0], cC1 = nC[1], cC2 = nC[2]; const bf16_t cg = ng;
        if (r + stride < NROWS) fetch(r + stride);
        float fc[8], fp[8], fn[8], o[8];
        {
            unpack8(cA0, fc); unpack8(cA1, fp); unpack8(cA2, fn);
#pragma unroll
            for (int e = 0; e < 8; ++e) o[e] = siluf_(cw0[0][e] * fp[e] + cw0[1][e] * fc[e] + cw0[2][e] * fn[e] + cw0[3][e]);
            *(u32x4*)(XBC + (size_t)r * 768 + 8 * lane) = pack8(o);
        }
        if (lane < 32) {
            unpack8(cB0, fc); unpack8(cB1, fp); unpack8(cB2, fn);
#pragma unroll
            for (int e = 0; e < 8; ++e) o[e] = siluf_(cw1[0][e] * fp[e] + cw1[1][e] * fc[e] + cw1[2][e] * fn[e] + cw1[3][e]);
            *(u32x4*)(XBC + (size_t)r * 768 + 512 + 8 * lane) = pack8(o);
        }
        {
            unpack8(cC0, fc); unpack8(cC1, fp); unpack8(cC2, fn);
#pragma unroll
            for (int e = 0; e < 8; ++e) o[e] = qscl * siluf_(cwq[0][e] * fp[e] + cwq[1][e] * fc[e] + cwq[2][e] * fn[e] + cwq[3][e]);
            *(u32x4*)(QK + (size_t)r * 512 + 8 * lane) = pack8(o);
        }
        if (lane < 32) {
            const float x = bf2f(cg) + gbias;
            GT[(size_t)r * 32 + lane] = lane < 16 ? softplusf_(x) : lane < 24 ? x : logsigmoidf_(x);
        }
    }
}

constexpr int CL = 64, NCH64 = NSTEPS / CL, LDT = 72, LDTB = LDT * 2;
__device__ __forceinline__ bf16x8 ldfrag(const LAS char* tile, int ldb, int row0, int k0, int lane) {
    return *(const LAS bf16x8*)(tile + (row0 + (lane & 15)) * ldb + (k0 + 8 * (lane >> 4)) * 2);
}
typedef short s16x4 __attribute__((ext_vector_type(4)));
constexpr int LDV = 272;
__device__ __forceinline__ bf16x8 ldfrag_tr(const LAS char* tile, int rowb, int c0, int k0, int lane) {
    const int i = lane & 15;
    const LAS char* p = tile + (k0 + 8 * (lane >> 4) + (i >> 2)) * rowb + (c0 + 4 * (i & 3)) * 2;
    const s16x4 lo = __builtin_amdgcn_ds_read_tr16_b64_v4i16((LAS s16x4*)p);
    const s16x4 hi = __builtin_amdgcn_ds_read_tr16_b64_v4i16((LAS s16x4*)(p + 4 * rowb));
    return (bf16x8){lo[0], lo[1], lo[2], lo[3], hi[0], hi[1], hi[2], hi[3]};
}
__device__ __forceinline__ void st4bf(LAS char* p, const f32x4& v) { u32x2 o; o.x = pk2(v[0], v[1]); o.y = pk2(v[2], v[3]); *(LAS u32x2*)p = o; }

constexpr int SS_BT = 0, SS_CT = SS_BT + 64 * LDTB, SS_BDT = SS_CT + 64 * LDTB, SS_XT = SS_BDT + 64 * LDTB, SS_CUM = SS_XT + 32 * LDTB, SS_DTV = SS_CUM + 256, SS_ROWS = SS_DTV + 256, SS_STG = SS_ROWS + 256;
constexpr int SS_M = 2 * SS_STG, SS_HB = SS_M + 64 * LDTB, SS_END = SS_HB + 32 * LDTB;
static_assert(SS_END <= LDS_BYTES - 16, "SSD LDS map");

constexpr int MS_QT = 0, MS_KT = MS_QT + 64 * LDTB, MS_KET = MS_KT + 64 * LDTB, MS_VT = MS_KET + 64 * LDTB, MS_SC = MS_VT + 32 * LDTB;
constexpr int MS_STG = MS_SC + 8 * 256;
constexpr int MS_W = 2 * MS_STG, MS_CB = MS_W + 64 * LDTB, MS_ONE = MS_CB + 32 * LDTB, MS_NV = MS_ONE + 16 * LDTB, MS_QN = MS_NV + 256, MS_END = MS_QN + 256;
static_assert(MS_END <= LDS_BYTES - 16, "mLSTM LDS map");

constexpr size_t WS_XSS = WS_EGT + al256((size_t)NROWS * 32 * 4);
constexpr size_t XSS_BYTES = (size_t)64 * NCH64 * 64 * 64 * 2;
constexpr size_t WS_XSD = WS_XSS + XSS_BYTES;
constexpr size_t WS_XMC = WS_XSD + al256((size_t)64 * NCH64 * 4);
constexpr size_t XMC_BYTES = (size_t)32 * NCH64 * 128 * 64 * 2;
constexpr size_t WS_XMN = WS_XMC + XMC_BYTES;
constexpr size_t WS_XMS = WS_XMN + (size_t)32 * NCH64 * 64 * 4;
constexpr size_t WS_XMT = WS_XMS + al256((size_t)32 * NCH64 * 4 * 4);
constexpr size_t WS_XEND = WS_XMT + (size_t)32 * NCH64 * 3 * 64 * 4;
static_assert(WS_XEND <= WS_END, "even-layer chunk-state buffers must fit in the RWKV region");
constexpr int NSSD_ITEMS = 64 * NCH64, NML_ITEMS = 32 * NCH64;

template <int CTRL, int RM, int BM> __device__ __forceinline__ float dppx(float old, float v) {
    return __builtin_bit_cast(float, __builtin_amdgcn_update_dpp(__builtin_bit_cast(int, old), __builtin_bit_cast(int, v), CTRL, RM, BM, false));
}
__device__ __forceinline__ float wave_cumsum(float v, int) {
    float t = v;
    t += dppx<0x111, 0xf, 0xf>(0.f, v); t += dppx<0x112, 0xf, 0xf>(0.f, v); t += dppx<0x113, 0xf, 0xf>(0.f, v);
    { const float u = dppx<0x114, 0xf, 0xe>(0.f, t); t += u; }
    { const float u = dppx<0x118, 0xf, 0xc>(0.f, t); t += u; }
    { const float u = dppx<0x142, 0xa, 0xf>(0.f, t); t += u; }
    { const float u = dppx<0x143, 0xc, 0xf>(0.f, t); t += u; }
    return t;
}
__device__ __forceinline__ float wave_cummax(float v, int) {
    const float ninf = -__builtin_huge_valf();
    float t = v;
    t = fmaxf(t, dppx<0x111, 0xf, 0xf>(ninf, v)); t = fmaxf(t, dppx<0x112, 0xf, 0xf>(ninf, v)); t = fmaxf(t, dppx<0x113, 0xf, 0xf>(ninf, v));
    { const float u = dppx<0x114, 0xf, 0xe>(ninf, t); t = fmaxf(t, u); }
    { const float u = dppx<0x118, 0xf, 0xc>(ninf, t); t = fmaxf(t, u); }
    { const float u = dppx<0x142, 0xa, 0xf>(ninf, t); t = fmaxf(t, u); }
    { const float u = dppx<0x143, 0xc, 0xf>(ninf, t); t = fmaxf(t, u); }
    return t;
}
__device__ __forceinline__ float wave_max(float v) {
    const float t = wave_cummax(v, 0);
    return __builtin_bit_cast(float, __builtin_amdgcn_readlane(__builtin_bit_cast(int, t), 63));
}

constexpr int X1S_BDT = 0, X1S_XT = X1S_BDT + 64 * LDTB, X1S_CUM = X1S_XT + 64 * LDTB, X1S_DTV = X1S_CUM + 256, X1S_END = X1S_DTV + 256;
constexpr int X1M_KET = 0, X1M_VT = X1M_KET + 64 * LDTB, X1M_ONE = X1M_VT + 64 * LDV, X1M_EE = X1M_ONE + 16 * LDTB, X1M_END = X1M_EE + 256;
__device__ __forceinline__ void phase_ex1(int wv, KP Pk, int layer, LAS char* lds) {
    asm volatile("" : "+s"(Pk));
    const CAS Params& P = *Pk;
    const int tid = ltid(wv), lane = tid & 63, wid = tid >> 6, q = lane >> 4, r16 = lane & 15, i_ = layer >> 1;
    const bf16_t* XBC = (const bf16_t*)(P.ws + WS_EXBC); const bf16_t* QK = (const bf16_t*)(P.ws + WS_EQK); const bf16_t* Pb = (const bf16_t*)(P.ws + WS_P);
    const float* GT = (const float*)(P.ws + WS_EGT);
    {
        bf16_t* Hst = (bf16_t*)(P.ws + WS_XSS); float* Dst = (float*)(P.ws + WS_XSD);
        struct Set { u32x4 rc[2]; float rdt; }; Set SA, SB; SA.rdt = SB.rdt = 0.f;
        auto geom = [&](int it, int& b, int& h, int& dir, int& c) { const int sq = it / NCH64; c = it - sq * NCH64; b = sq >> 4; h = (sq >> 1) & 7; dir = sq & 1; };
        auto load = [&](int it, Set& S) {
            int b, h, dir, c; geom(it, b, h, dir, c);
            int tl = tid; asm volatile("" : "+v"(tl));
#pragma unroll
            for (int s = 0; s < 2; ++s) {
                const int task = tl + NT * s, j = task >> 4, g = task & 15;
                const int row = scan_row(c * CL + j, b, dir, 0);
                S.rc[s] = *(const u32x4*)(XBC + (size_t)row * 768 + (g < 8 ? h * 64 + 8 * g : 512 + (h >> 2) * 64 + 8 * (g - 8)));
            }
            if (tl < CL) { const int row = scan_row(c * CL + tl, b, dir, 0); S.rdt = GT[(size_t)row * 32 + dir * 8 + h]; }
        };
        auto item = [&](int it, Set& S, int nxt) {
            int b, h, dir, c; geom(it, b, h, dir, c);
            const float aco = -__expf(P.ssd_a_log[(i_ * 2 + dir) * 8 + h]);
            if (tid < CL) {
                const float cum = wave_cumsum(S.rdt * aco, lane);
                ((LAS float*)(lds + X1S_CUM))[tid] = cum; ((LAS float*)(lds + X1S_DTV))[tid] = S.rdt;
            }
            __syncthreads();
            {
                const LAS float* cum = (const LAS float*)(lds + X1S_CUM);
                const float cumL = cum[CL - 1];
                int tl = tid; asm volatile("" : "+v"(tl));
#pragma unroll
                for (int s = 0; s < 2; ++s) {
                    const int task = tl + NT * s, j = task >> 4, g = task & 15;
                    float f[8]; unpack8(S.rc[s], f);
                    if (g < 8) {
                        const float dt = ((const LAS float*)(lds + X1S_DTV))[j];
#pragma unroll
                        for (int e = 0; e < 8; ++e) f[e] *= dt;
                        *(LAS u32x4*)(lds + X1S_XT + j * LDTB + 16 * g) = pack8(f);
                    } else {
                        const float sc = __expf(cumL - cum[j]);
#pragma unroll
                        for (int e = 0; e < 8; ++e) f[e] *= sc;
                        *(LAS u32x4*)(lds + X1S_BDT + j * LDTB + 16 * (g - 8)) = pack8(f);
                    }
                }
                if (tid == 0) Dst[it] = __expf(cumL);
            }
            if (nxt < NSSD_ITEMS) load(nxt, S);
            __syncthreads();
            {
                const int pt = wid >> 1;
#pragma unroll
                for (int u = 0; u < 2; ++u) {
                    const int nt = (wid & 1) * 2 + u;
                    f32x4 sa = (f32x4){0.f, 0.f, 0.f, 0.f};
#pragma unroll
                    for (int k0 = 0; k0 < 64; k0 += 32) sa = __builtin_amdgcn_mfma_f32_16x16x32_bf16(ldfrag_tr(lds + X1S_BDT, LDTB, nt * 16, k0, lane), ldfrag_tr(lds + X1S_XT, LDTB, pt * 16, k0, lane), sa, 0, 0, 0);
                    u32x2 o; o.x = pk2(sa[0], sa[1]); o.y = pk2(sa[2], sa[3]);
                    *(u32x2*)(Hst + ((size_t)it * 64 + pt * 16 + r16) * 64 + nt * 16 + 4 * q) = o;
                }
            }
            __syncthreads();
        };
        {
            const int G = gridDim.x; int it = blockIdx.x;
            if (it < NSSD_ITEMS) load(it, SA);
            if (it + G < NSSD_ITEMS) load(it + G, SB);
            for (; it < NSSD_ITEMS; it += 2 * G) {
                item(it, SA, it + 2 * G);
                if (it + G < NSSD_ITEMS) item(it + G, SB, it + 3 * G);
            }
        }
    }
    {
        bf16_t* Cst = (bf16_t*)(P.ws + WS_XMC); float* Nst = (float*)(P.ws + WS_XMN); float* Sst = (float*)(P.ws + WS_XMS); float* Tst = (float*)(P.ws + WS_XMT);
        for (int i = tid; i < 16 * LDTB / 4; i += NT) ((LAS unsigned*)(lds + X1M_ONE))[i] = 0x3f803f80u;
        struct Set { u32x4 rc[3]; float rli, rlf; }; Set SA, SB; SA.rli = SA.rlf = SB.rli = SB.rlf = 0.f;
        auto geom = [&](int it, int& b, int& h, int& dir, int& c) { const int sq = it / NCH64; c = it - sq * NCH64; b = sq >> 3; h = (sq >> 1) & 3; dir = sq & 1; };
        auto load = [&](int it, Set& S) {
            int b, h, dir, c; geom(it, b, h, dir, c);
            int tl = tid; asm volatile("" : "+v"(tl));
#pragma unroll
            for (int s = 0; s < 3; ++s) {
                const int task = tl + NT * s, j = task / 24, g = task - 24 * j;
                const int row = scan_row(c * CL + j, b, dir, 0);
                S.rc[s] = g < 8 ? *(const u32x4*)(QK + (size_t)row * 512 + 256 + h * 64 + 8 * g) : *(const u32x4*)(Pb + (size_t)row * LDP_EVEN + 1808 + h * 128 + 8 * (g - 8));
            }
            if (tl < CL) { const int row = scan_row(c * CL + tl, b, dir, 0); S.rli = GT[(size_t)row * 32 + 16 + dir * 4 + h]; S.rlf = GT[(size_t)row * 32 + 24 + dir * 4 + h]; }
        };
        auto item = [&](int it, Set& S, int nxt) {
            if (tid < CL) {
                const float fcum = wave_cumsum(S.rlf, lane);
                const float ftot = __builtin_bit_cast(float, __builtin_amdgcn_readlane(__builtin_bit_cast(int, fcum), 63));
                const float g = S.rli - fcum, pm = wave_cummax(g, lane);
                const float wend = ftot + g, mloc = wave_max(wend);
                ((LAS float*)(lds + X1M_EE))[tid] = __expf(wend - mloc);
                float* tp = Tst + (size_t)it * 192;
                tp[tid] = fcum; tp[64 + tid] = g; tp[128 + tid] = pm;
                if (tid == 0) { Sst[(size_t)it * 4 + 0] = ftot; Sst[(size_t)it * 4 + 1] = mloc; }
            }
            __syncthreads();
            {
                const LAS float* ee = (const LAS float*)(lds + X1M_EE);
                int tl = tid; asm volatile("" : "+v"(tl));
#pragma unroll
                for (int s = 0; s < 3; ++s) {
                    const int task = tl + NT * s, j = task / 24, g = task - 24 * j;
                    if (g < 8) {
                        float f[8]; unpack8(S.rc[s], f);
                        const float e1 = ee[j];
#pragma unroll
                        for (int e = 0; e < 8; ++e) f[e] *= e1;
                        *(LAS u32x4*)(lds + X1M_KET + j * LDTB + 16 * g) = pack8(f);
                    } else {
                        const int v0 = 8 * (g - 8);
#pragma unroll
                        for (int e = 0; e < 1; ++e) *(LAS u32x4*)(lds + X1M_VT + j * LDV + v0 * 2) = S.rc[s];
                    }
                }
            }
            if (nxt < NML_ITEMS) load(nxt, S);
            __syncthreads();
            {
                const bf16x8 vf0 = ldfrag_tr(lds + X1M_VT, LDV, wid * 16, 0, lane), vf1 = ldfrag_tr(lds + X1M_VT, LDV, wid * 16, 32, lane);
#pragma unroll
                for (int kt = 0; kt < 4; ++kt) {
                    f32x4 sa = __builtin_amdgcn_mfma_f32_16x16x32_bf16(ldfrag_tr(lds + X1M_KET, LDTB, kt * 16, 0, lane), vf0, (f32x4){0.f, 0.f, 0.f, 0.f}, 0, 0, 0);
                    sa = __builtin_amdgcn_mfma_f32_16x16x32_bf16(ldfrag_tr(lds + X1M_KET, LDTB, kt * 16, 32, lane), vf1, sa, 0, 0, 0);
                    u32x2 o; o.x = pk2(sa[0], sa[1]); o.y = pk2(sa[2], sa[3]);
                    *(u32x2*)(Cst + ((size_t)it * 128 + wid * 16 + r16) * 64 + kt * 16 + 4 * q) = o;
                }
                if (wid < 4) {
                    f32x4 na = __builtin_amdgcn_mfma_f32_16x16x32_bf16(ldfrag_tr(lds + X1M_KET, LDTB, wid * 16, 0, lane), ldfrag(lds + X1M_ONE, LDTB, 0, 0, lane), (f32x4){0.f, 0.f, 0.f, 0.f}, 0, 0, 0);
                    na = __builtin_amdgcn_mfma_f32_16x16x32_bf16(ldfrag_tr(lds + X1M_KET, LDTB, wid * 16, 32, lane), ldfrag(lds + X1M_ONE, LDTB, 0, 32, lane), na, 0, 0, 0);
                    if (r16 == 0) *(f32x4*)(Nst + (size_t)it * 64 + wid * 16 + 4 * q) = na;
                }
            }
            __syncthreads();
        };
        {
            const int G = gridDim.x; int it = blockIdx.x;
            if (it < NML_ITEMS) load(it, SA);
            if (it + G < NML_ITEMS) load(it + G, SB);
            __syncthreads();
            for (; it < NML_ITEMS; it += 2 * G) {
                item(it, SA, it + 2 * G);
                if (it + G < NML_ITEMS) item(it + G, SB, it + 3 * G);
            }
        }
    }
}

constexpr int EX2_UB = 12;
static_assert(NCH64 % EX2_UB == 0, "EX2 batches");
__device__ __forceinline__ void phase_ex2(int wv, KP Pk, int layer) {
    asm volatile("" : "+s"(Pk));
    const CAS Params& P = *Pk;
    const int tid = ltid(wv);
    (void)layer;
    if (blockIdx.x < 128) {
        const int gt = blockIdx.x * NT + tid, sq = gt >> 10, rem = gt & 1023;
        bf16_t* Hst = (bf16_t*)(P.ws + WS_XSS) + (size_t)sq * NCH64 * 4096 + rem * 4;
        const float* Dst = (const float*)(P.ws + WS_XSD) + sq * NCH64;
        float h0 = 0.f, h1 = 0.f, h2 = 0.f, h3 = 0.f;
#pragma unroll 1
        for (int c0 = 0; c0 < NCH64; c0 += EX2_UB) {
            u32x2 loc[EX2_UB]; float dd[EX2_UB];
            bf16_t* hp = Hst + (size_t)c0 * 4096;
#pragma unroll
            for (int u = 0; u < EX2_UB; ++u) { loc[u] = *(const u32x2*)(hp + (size_t)u * 4096); dd[u] = Dst[c0 + u]; }
#pragma unroll
            for (int u = 0; u < EX2_UB; ++u) {
                u32x2 o; o.x = pk2(h0, h1); o.y = pk2(h2, h3);
                *(u32x2*)(hp + (size_t)u * 4096) = o;
                const float d = dd[u];
                h0 = d * h0 + bflo(loc[u].x); h1 = d * h1 + bfhi(loc[u].x); h2 = d * h2 + bflo(loc[u].y); h3 = d * h3 + bfhi(loc[u].y);
            }
        }
    } else if (blockIdx.x < 256) {
        const int gt = (blockIdx.x - 128) * NT + tid, sq = gt >> 11, rem = gt & 2047;
        bf16_t* Cst = (bf16_t*)(P.ws + WS_XMC) + (size_t)sq * NCH64 * 8192 + rem * 4;
        float* Nst = (float*)(P.ws + WS_XMN) + (size_t)sq * NCH64 * 64 + (rem & 15) * 4;
        float* Sst = (float*)(P.ws + WS_XMS) + (size_t)sq * NCH64 * 4;
        const bool own_n = rem < 16, own_m = rem == 0;
        float c0_ = 0.f, c1 = 0.f, c2 = 0.f, c3 = 0.f, m = -1e30f;
        f32x4 nn = (f32x4){0.f, 0.f, 0.f, 0.f};
#pragma unroll 1
        for (int cb = 0; cb < NCH64; cb += EX2_UB) {
            u32x2 loc[EX2_UB]; float ft[EX2_UB], ml[EX2_UB]; f32x4 nl[EX2_UB];
            bf16_t* cp = Cst + (size_t)cb * 8192; float* np = Nst + (size_t)cb * 64; float* sp_ = Sst + cb * 4;
#pragma unroll
            for (int u = 0; u < EX2_UB; ++u) {
                loc[u] = *(const u32x2*)(cp + (size_t)u * 8192); ft[u] = sp_[u * 4 + 0]; ml[u] = sp_[u * 4 + 1];
                nl[u] = (f32x4){0.f, 0.f, 0.f, 0.f};
                if (own_n) nl[u] = *(const f32x4*)(np + (size_t)u * 64);
            }
#pragma unroll
            for (int u = 0; u < EX2_UB; ++u) {
                const float ftot = ft[u], mloc = ml[u];
                const float mnew = fmaxf(ftot + m, mloc), sp = __expf(ftot + m - mnew), sl = __expf(mloc - mnew);
                u32x2 o; o.x = pk2(c0_, c1); o.y = pk2(c2, c3);
                *(u32x2*)(cp + (size_t)u * 8192) = o;
                c0_ = sp * c0_ + sl * bflo(loc[u].x); c1 = sp * c1 + sl * bfhi(loc[u].x); c2 = sp * c2 + sl * bflo(loc[u].y); c3 = sp * c3 + sl * bfhi(loc[u].y);
                if (own_n) { *(f32x4*)(np + (size_t)u * 64) = nn; nn = nn * sp + nl[u] * sl; }
                if (own_m) sp_[u * 4 + 2] = m;
                m = mnew;
            }
        }
    }
}

constexpr int X3S_BT = 0, X3S_CT = X3S_BT + 64 * LDTB, X3S_XT = X3S_CT + 64 * LDTB, X3S_HB = X3S_XT + 64 * LDTB, X3S_M = X3S_HB + 64 * LDTB, X3S_CUM = X3S_M + 64 * LDTB, X3S_DTV = X3S_CUM + 256, X3S_ROWS = X3S_DTV + 256, X3S_END = X3S_ROWS + 256;
constexpr int X3M_QT = 0, X3M_KT = X3M_QT + 64 * LDTB, X3M_VT = X3M_KT + 64 * LDTB, X3M_CB = X3M_VT + 64 * LDV, X3M_W = X3M_CB + 128 * LDTB, X3M_ONE = X3M_W + 64 * LDTB, X3M_NB = X3M_ONE + 16 * LDTB,
              X3M_SC = X3M_NB + 16 * LDTB, X3M_END = X3M_SC + 6 * 256;
static_assert(X3M_END <= LDS_BYTES - 16 && X3S_END <= LDS_BYTES - 16, "EX3 LDS maps");
__device__ __forceinline__ void phase_ex3(int wv, KP Pk, int layer, LAS char* lds) {
    asm volatile("" : "+s"(Pk));
    const CAS Params& P = *Pk;
    const int tid = ltid(wv), lane = tid & 63, wid = tid >> 6, q = lane >> 4, r16 = lane & 15, i_ = layer >> 1;
    const bf16_t* XBC = (const bf16_t*)(P.ws + WS_EXBC); const bf16_t* QK = (const bf16_t*)(P.ws + WS_EQK); const bf16_t* Pb = (const bf16_t*)(P.ws + WS_P);
    const float* GT = (const float*)(P.ws + WS_EGT);
    {
        const bf16_t* Hst = (const bf16_t*)(P.ws + WS_XSS);
        struct Set { u32x4 rc[3], rh; float rdt; int rrow; }; Set SA, SB; SA.rdt = SB.rdt = 0.f; SA.rrow = SB.rrow = 0;
        auto geom = [&](int it, int& b, int& h, int& dir, int& c) { const int sq = it / NCH64; c = it - sq * NCH64; b = sq >> 4; h = (sq >> 1) & 7; dir = sq & 1; };
        auto load = [&](int it, Set& S) {
            int b, h, dir, c; geom(it, b, h, dir, c);
            int tl = tid; asm volatile("" : "+v"(tl));
#pragma unroll
            for (int s = 0; s < 3; ++s) {
                const int task = tl + NT * s, j = task / 24, g = task - 24 * j;
                const int row = scan_row(c * CL + j, b, dir, 0);
                S.rc[s] = *(const u32x4*)(XBC + (size_t)row * 768 + (g < 8 ? h * 64 + 8 * g : g < 16 ? 512 + (h >> 2) * 64 + 8 * (g - 8) : 640 + (h >> 2) * 64 + 8 * (g - 16)));
            }
            S.rh = *(const u32x4*)(Hst + (size_t)it * 4096 + tl * 8);
            if (tl < CL) { S.rrow = scan_row(c * CL + tl, b, dir, 0); S.rdt = GT[(size_t)S.rrow * 32 + dir * 8 + h]; }
        };
        auto item = [&](int it, Set& S, int nxt) {
            int b, h, dir, c; geom(it, b, h, dir, c);
            bf16_t* Y = (bf16_t*)(P.ws + (dir ? WS_YB : WS_YF));
            const float aco = -__expf(P.ssd_a_log[(i_ * 2 + dir) * 8 + h]);
            if (tid < CL) {
                const float cum = wave_cumsum(S.rdt * aco, lane);
                ((LAS float*)(lds + X3S_CUM))[tid] = cum; ((LAS float*)(lds + X3S_DTV))[tid] = S.rdt; ((LAS int*)(lds + X3S_ROWS))[tid] = S.rrow;
            }
            __syncthreads();
            {
                int tl = tid; asm volatile("" : "+v"(tl));
#pragma unroll
                for (int s = 0; s < 3; ++s) {
                    const int task = tl + NT * s, j = task / 24, g = task - 24 * j;
                    if (g < 8) {
                        float f[8]; unpack8(S.rc[s], f);
                        const float dt = ((const LAS float*)(lds + X3S_DTV))[j];
#pragma unroll
                        for (int e = 0; e < 8; ++e) f[e] *= dt;
                        *(LAS u32x4*)(lds + X3S_XT + j * LDTB + 16 * g) = pack8(f);
                    } else if (g < 16) *(LAS u32x4*)(lds + X3S_BT + j * LDTB + 8 * (g - 8) * 2) = S.rc[s];
                    else *(LAS u32x4*)(lds + X3S_CT + j * LDTB + 8 * (g - 16) * 2) = S.rc[s];
                }
                *(LAS u32x4*)(lds + X3S_HB + (tl >> 3) * LDTB + (tl & 7) * 16) = S.rh;
            }
            if (nxt < NSSD_ITEMS) load(nxt, S);
            __syncthreads();
            const LAS float* cum = (const LAS float*)(lds + X3S_CUM);
            {
                const int lt = wid >> 1;
#pragma unroll
                for (int u = 0; u < 2; ++u) {
                    const int st = (wid & 1) * 2 + u;
                    f32x4 acc = (f32x4){0.f, 0.f, 0.f, 0.f};
                    if (st <= lt) {
#pragma unroll
                        for (int k0 = 0; k0 < 64; k0 += 32) acc = __builtin_amdgcn_mfma_f32_16x16x32_bf16(ldfrag(lds + X3S_BT, LDTB, st * 16, k0, lane), ldfrag(lds + X3S_CT, LDTB, lt * 16, k0, lane), acc, 0, 0, 0);
                        const int l = lt * 16 + r16, s0 = st * 16 + 4 * q;
                        const float cl = cum[l]; const f32x4 cs = *(const LAS f32x4*)(cum + s0);
#pragma unroll
                        for (int j = 0; j < 4; ++j) acc[j] = (s0 + j <= l) ? acc[j] * __expf(cl - cs[j]) : 0.f;
                    }
                    st4bf(lds + X3S_M + (lt * 16 + r16) * LDTB + (st * 16 + 4 * q) * 2, acc);
                }
            }
            __syncthreads();
            {
                const int lt = wid >> 1, l = lt * 16 + r16;
                const float el = __expf(cum[l]);
                const int row = ((const LAS int*)(lds + X3S_ROWS))[l];
                const bf16x8 mf0 = ldfrag(lds + X3S_M, LDTB, lt * 16, 0, lane), mf1 = ldfrag(lds + X3S_M, LDTB, lt * 16, 32, lane);
                const bf16x8 cf0 = ldfrag(lds + X3S_CT, LDTB, lt * 16, 0, lane), cf1 = ldfrag(lds + X3S_CT, LDTB, lt * 16, 32, lane);
#pragma unroll
                for (int u = 0; u < 2; ++u) {
                    const int pt = (wid & 1) * 2 + u;
                    f32x4 ya = __builtin_amdgcn_mfma_f32_16x16x32_bf16(ldfrag_tr(lds + X3S_XT, LDTB, pt * 16, 0, lane), mf0, (f32x4){0.f, 0.f, 0.f, 0.f}, 0, 0, 0);
                    ya = __builtin_amdgcn_mfma_f32_16x16x32_bf16(ldfrag_tr(lds + X3S_XT, LDTB, pt * 16, 32, lane), mf1, ya, 0, 0, 0);
                    f32x4 oa = __builtin_amdgcn_mfma_f32_16x16x32_bf16(ldfrag(lds + X3S_HB, LDTB, pt * 16, 0, lane), cf0, (f32x4){0.f, 0.f, 0.f, 0.f}, 0, 0, 0);
                    oa = __builtin_amdgcn_mfma_f32_16x16x32_bf16(ldfrag(lds + X3S_HB, LDTB, pt * 16, 32, lane), cf1, oa, 0, 0, 0);
                    u32x2 o; o.x = pk2(ya[0] + el * oa[0], ya[1] + el * oa[1]); o.y = pk2(ya[2] + el * oa[2], ya[3] + el * oa[3]);
                    *(u32x2*)(Y + (size_t)row * D + h * 64 + pt * 16 + 4 * q) = o;
                }
            }
            __syncthreads();
        };
        {
            const int G = gridDim.x; int it = blockIdx.x;
            if (it < NSSD_ITEMS) load(it, SA);
            if (it + G < NSSD_ITEMS) load(it + G, SB);
            __syncthreads();
            for (; it < NSSD_ITEMS; it += 2 * G) {
                item(it, SA, it + 2 * G);
                if (it + G < NSSD_ITEMS) item(it + G, SB, it + 3 * G);
            }
        }
    }
    {
        const bf16_t* Cst = (const bf16_t*)(P.ws + WS_XMC); const float* Nst = (const float*)(P.ws + WS_XMN); const float* Sst = (const float*)(P.ws + WS_XMS); const float* Tst = (const float*)(P.ws + WS_XMT);
        for (int i = tid; i < 16 * LDTB / 4; i += NT) ((LAS unsigned*)(lds + X3M_ONE))[i] = 0x3f803f80u;
        struct Set { u32x4 rc[4], rcb[2]; float rfc, rg, rpm, rmp, rn; int rrow; }; Set SA, SB; SA.rfc = SA.rg = SA.rpm = SA.rmp = SA.rn = SB.rfc = SB.rg = SB.rpm = SB.rmp = SB.rn = 0.f; SA.rrow = SB.rrow = 0;
        auto geom = [&](int it, int& b, int& h, int& dir, int& c) { const int sq = it / NCH64; c = it - sq * NCH64; b = sq >> 3; h = (sq >> 1) & 3; dir = sq & 1; };
        auto load = [&](int it, Set& S) {
            int b, h, dir, c; geom(it, b, h, dir, c);
            int tl = tid; asm volatile("" : "+v"(tl));
#pragma unroll
            for (int s = 0; s < 4; ++s) {
                const int task = tl + NT * s, j = task >> 5, g = task & 31;
                const int row = scan_row(c * CL + j, b, dir, 0);
                S.rc[s] = g < 16 ? *(const u32x4*)(QK + (size_t)row * 512 + (g < 8 ? h * 64 + 8 * g : 256 + h * 64 + 8 * (g - 8))) : *(const u32x4*)(Pb + (size_t)row * LDP_EVEN + 1808 + h * 128 + 8 * (g - 16));
            }
#pragma unroll
            for (int s = 0; s < 2; ++s) S.rcb[s] = *(const u32x4*)(Cst + (size_t)it * 8192 + (tl + NT * s) * 8);
            if (tl < CL) {
                S.rrow = scan_row(c * CL + tl, b, dir, 0);
                const float* tp = Tst + (size_t)it * 192;
                S.rfc = tp[tl]; S.rg = tp[64 + tl]; S.rpm = tp[128 + tl]; S.rmp = Sst[(size_t)it * 4 + 2]; S.rn = Nst[(size_t)it * 64 + tl];
            }
        };
        auto item = [&](int it, Set& S, int nxt) {
            int b, h, dir, c; geom(it, b, h, dir, c);
            bf16_t* Y = (bf16_t*)(P.ws + (dir ? WS_YB : WS_YF));
            LAS float* sc = (LAS float*)(lds + X3M_SC);
            {
                int tl = tid; asm volatile("" : "+v"(tl));
#pragma unroll
                for (int s = 0; s < 4; ++s) {
                    const int task = tl + NT * s, j = task >> 5, g = task & 31;
                    if (g < 8) *(LAS u32x4*)(lds + X3M_QT + j * LDTB + 8 * g * 2) = S.rc[s];
                    else if (g < 16) *(LAS u32x4*)(lds + X3M_KT + j * LDTB + 8 * (g - 8) * 2) = S.rc[s];
                    else {
                        const int v0 = 8 * (g - 16);
#pragma unroll
                        for (int e = 0; e < 1; ++e) *(LAS u32x4*)(lds + X3M_VT + j * LDV + v0 * 2) = S.rc[s];
                    }
                }
#pragma unroll
                for (int s = 0; s < 2; ++s) { const int ch = tl + NT * s; *(LAS u32x4*)(lds + X3M_CB + (ch >> 3) * LDTB + (ch & 7) * 16) = S.rcb[s]; }
                if (tl < CL) {
                    const float linter = S.rfc + S.rmp, mrow = fmaxf(S.rfc + S.rpm, linter);
                    sc[tl] = S.rfc - mrow; sc[64 + tl] = S.rg; sc[128 + tl] = __expf(linter - mrow); sc[192 + tl] = __expf(-mrow); ((LAS int*)sc)[256 + tl] = S.rrow;
                    const bf16_t nb = f2bf(S.rn);
#pragma unroll
                    for (int r = 0; r < 16; ++r) *(LAS bf16_t*)(lds + X3M_NB + r * LDTB + tl * 2) = nb;
                }
            }
            if (nxt < NML_ITEMS) load(nxt, S);
            __syncthreads();
            {
                const int lt = wid >> 1;
#pragma unroll
                for (int u = 0; u < 2; ++u) {
                    const int st = (wid & 1) * 2 + u;
                    f32x4 acc = (f32x4){0.f, 0.f, 0.f, 0.f};
                    if (st <= lt) {
#pragma unroll
                        for (int k0 = 0; k0 < 64; k0 += 32) acc = __builtin_amdgcn_mfma_f32_16x16x32_bf16(ldfrag(lds + X3M_KT, LDTB, st * 16, k0, lane), ldfrag(lds + X3M_QT, LDTB, lt * 16, k0, lane), acc, 0, 0, 0);
                        const int l = lt * 16 + r16, s0 = st * 16 + 4 * q;
                        const float rt = sc[l]; const f32x4 gs = *(const LAS f32x4*)(sc + 64 + s0);
#pragma unroll
                        for (int j = 0; j < 4; ++j) acc[j] = (s0 + j <= l) ? acc[j] * __expf(rt + gs[j]) : 0.f;
                    }
                    st4bf(lds + X3M_W + (lt * 16 + r16) * LDTB + (st * 16 + 4 * q) * 2, acc);
                }
            }
            __syncthreads();
            {
                const int lt = wid >> 1, l = lt * 16 + r16;
                const bf16x8 wf0 = ldfrag(lds + X3M_W, LDTB, lt * 16, 0, lane), wf1 = ldfrag(lds + X3M_W, LDTB, lt * 16, 32, lane);
                const bf16x8 qf0 = ldfrag(lds + X3M_QT, LDTB, lt * 16, 0, lane), qf1 = ldfrag(lds + X3M_QT, LDTB, lt * 16, 32, lane);
                f32x4 da = __builtin_amdgcn_mfma_f32_16x16x32_bf16(ldfrag(lds + X3M_ONE, LDTB, 0, 0, lane), wf0, (f32x4){0.f, 0.f, 0.f, 0.f}, 0, 0, 0);
                da = __builtin_amdgcn_mfma_f32_16x16x32_bf16(ldfrag(lds + X3M_ONE, LDTB, 0, 32, lane), wf1, da, 0, 0, 0);
                f32x4 qn = __builtin_amdgcn_mfma_f32_16x16x32_bf16(ldfrag(lds + X3M_NB, LDTB, 0, 0, lane), qf0, (f32x4){0.f, 0.f, 0.f, 0.f}, 0, 0, 0);
                qn = __builtin_amdgcn_mfma_f32_16x16x32_bf16(ldfrag(lds + X3M_NB, LDTB, 0, 32, lane), qf1, qn, 0, 0, 0);
                const float inter = sc[128 + l], emr = sc[192 + l];
                const float inv = __builtin_amdgcn_rcpf(fmaxf(fabsf(da[0] + inter * qn[0]), emr));
                const int row = ((const LAS int*)sc)[256 + l];
#pragma unroll
                for (int u = 0; u < 4; ++u) {
                    const int vt = (wid & 1) * 4 + u;
                    f32x4 na = __builtin_amdgcn_mfma_f32_16x16x32_bf16(ldfrag_tr(lds + X3M_VT, LDV, vt * 16, 0, lane), wf0, (f32x4){0.f, 0.f, 0.f, 0.f}, 0, 0, 0);
                    na = __builtin_amdgcn_mfma_f32_16x16x32_bf16(ldfrag_tr(lds + X3M_VT, LDV, vt * 16, 32, lane), wf1, na, 0, 0, 0);
                    f32x4 ca = __builtin_amdgcn_mfma_f32_16x16x32_bf16(ldfrag(lds + X3M_CB, LDTB, vt * 16, 0, lane), qf0, (f32x4){0.f, 0.f, 0.f, 0.f}, 0, 0, 0);
                    ca = __builtin_amdgcn_mfma_f32_16x16x32_bf16(ldfrag(lds + X3M_CB, LDTB, vt * 16, 32, lane), qf1, ca, 0, 0, 0);
                    u32x2 o; o.x = pk2((na[0] + inter * ca[0]) * inv, (na[1] + inter * ca[1]) * inv); o.y = pk2((na[2] + inter * ca[2]) * inv, (na[3] + inter * ca[3]) * inv);
                    *(u32x2*)(Y + (size_t)row * D + 512 + h * 128 + vt * 16 + 4 * q) = o;
                }
            }
            __syncthreads();
        };
        {
            const int G = gridDim.x; int it = blockIdx.x;
            if (it < NML_ITEMS) load(it, SA);
            if (it + G < NML_ITEMS) load(it + G, SB);
            __syncthreads();
            for (; it < NML_ITEMS; it += 2 * G) {
                item(it, SA, it + 2 * G);
                if (it + G < NML_ITEMS) item(it + G, SB, it + 3 * G);
            }
        }
    }
}

constexpr int HC_RAWF = 0;
constexpr int HC_RAWQ = HC_RAWF + 64 * 128 * 4;
constexpr int HC_SUB = HC_RAWQ + 64 * 128 * 2;
constexpr int HL_QD = 136 * 2;
constexpr int HL_T = 24 * 2;
constexpr int HS_QI = 0, HS_KO = HS_QI + 16 * HL_QD, HS_KET = HS_KO + 16 * HL_QD, HS_ATT = HS_KET + 128 * HL_T, HS_VT = HS_ATT + 16 * HL_T, HS_DEC = HS_VT + 32 * HL_T, HS_SIZE = HS_DEC + 512;
constexpr int HC_SB = HC_SUB + 4 * HS_SIZE;
constexpr int HC_ROWS = HC_SB + 2 * 32 * HL_QD, HC_CST = HC_ROWS + 256, HC_END = HC_CST + 1024;
static_assert(HC_END <= LDS_BYTES - 16, "HGRN2 LDS map");
static_assert(HS_SIZE % 16 == 0 && HC_SB % 16 == 0, "alignment");
__device__ __forceinline__ bf16x8 ldfrag16(const LAS char* tile, int ldb, int row0, int lane) {
    bf16x8 v = *(const LAS bf16x8*)(tile + (row0 + (lane & 15)) * ldb + ((lane >> 4) & 1) * 16);
    if (lane >= 32) v = (bf16x8){0, 0, 0, 0, 0, 0, 0, 0};
    return v;
}
__device__ __forceinline__ void scan_hgrn_c(int wv, KP Pk, int layer, int unit, LAS char* lds) {
    asm volatile("" : "+s"(Pk));
    const CAS Params& P = *Pk;
    const int tid = ltid(wv), lane = tid & 63, wid = tid >> 6, q = lane >> 4, r16 = lane & 15, i_ = layer >> 1;
    const int seq = unit >> 2, quarter = unit & 3, b = seq >> 3, h = (seq >> 1) & 3, dir = seq & 1;
    const bf16_t* Pb = (const bf16_t*)(P.ws + WS_P);
    bf16_t* Y = (bf16_t*)(P.ws + (dir ? WS_YB : WS_YF));
    LAS float* cst = (LAS float*)(lds + HC_CST);
    if (tid < 128) cst[tid] = ((const float*)(P.ws + WS_LB))[layer * 512 + h * 128 + tid];
    else if (tid < 256) cst[tid] = P.hg_f_bias[(size_t)(i_ * 2 + dir) * 512 + h * 128 + tid - 128];
    for (int i = tid; i < 2 * 32 * HL_QD / 4; i += NT) ((LAS unsigned*)(lds + HC_SB))[i] = 0u;
    int tj[5], tg_[5], tcol[5]; bool tv[5];
#pragma unroll
    for (int s = 0; s < 5; ++s) {
        const int task = tid + NT * s; tv[s] = task < 64 * 36; tj[s] = task / 36; tg_[s] = task % 36;
        const int g = tg_[s];
        tcol[s] = g < 16 ? (512 + dir * 512 + h * 128 + 8 * g) : g < 32 ? (h * 128 + 8 * (g - 16)) : (1536 + h * 128 + quarter * 32 + 8 * (g - 32));
    }
    u32x4 rc[5]; int rrow = 0;
    auto load = [&](int c) {
#pragma unroll
        for (int s = 0; s < 5; ++s) {
            rc[s] = (u32x4){0u, 0u, 0u, 0u};
            if (tv[s]) { const int row = scan_row(c * 64 + tj[s], b, dir, 1); rc[s] = *(const u32x4*)(Pb + (size_t)row * LDP_ODD + tcol[s]); }
        }
        if (tid < 64) rrow = scan_row(c * 64 + tid, b, dir, 1);
    };
    auto storeA = [&]() {
#pragma unroll
        for (int s = 0; s < 5; ++s) {
            if (tv[s]) {
                float f[8]; unpack8(rc[s], f);
                const int j = tj[s], g = tg_[s];
                if (g < 16) {
                    float o[8];
#pragma unroll
                    for (int e = 0; e < 8; ++e) { const float lbv = cst[8 * g + e]; o[e] = lbv + (1.f - lbv) * sigmoidf_(f[e] + cst[128 + 8 * g + e]); }
                    LAS float* dst = (LAS float*)(lds + HC_RAWF) + j * 128 + 8 * g;
                    *(LAS f32x4*)dst = (f32x4){o[0], o[1], o[2], o[3]}; *(LAS f32x4*)(dst + 4) = (f32x4){o[4], o[5], o[6], o[7]};
                } else if (g < 32) {
                    float o[8];
#pragma unroll
                    for (int e = 0; e < 8; ++e) o[e] = siluf_(f[e]);
                    *(LAS u32x4*)(lds + HC_RAWQ + (j * 128 + 8 * (g - 16)) * 2) = pack8(o);
                } else {
                    const int v0 = 8 * (g - 32);
                    LAS char* vt = lds + HC_SUB + (j >> 4) * HS_SIZE + HS_VT;
#pragma unroll
                    for (int e = 0; e < 8; ++e) { const unsigned wv = rc[s][e >> 1]; *(LAS bf16_t*)(vt + (v0 + e) * HL_T + (j & 15) * 2) = (bf16_t)((e & 1) ? (wv >> 16) : (wv & 0xffffu)); }
                }
            }
        }
        if (tid < 64) ((LAS int*)(lds + HC_ROWS))[tid] = rrow;
    };
    auto storeB = [&]() {
        const int d = tid & 127, sb = tid >> 7;
        LAS char* st = lds + HC_SUB + sb * HS_SIZE;
        const LAS float* rf = (const LAS float*)(lds + HC_RAWF) + (sb * 16) * 128 + d;
        const LAS bf16_t* rq = (const LAS bf16_t*)(lds + HC_RAWQ) + (sb * 16) * 128 + d;
        float E = 1.f, einv[16], kfs[16];
#pragma unroll
        for (int t = 0; t < 16; ++t) {
            const float f = rf[t * 128];
            E *= f;
            const float kf = 1.f - f, ei = __builtin_amdgcn_rcpf(E);
            einv[t] = ei; kfs[t] = kf;
            *(LAS bf16_t*)(st + HS_QI + t * HL_QD + d * 2) = f2bf(bf2f(rq[t * 128]) * E);
            *(LAS bf16_t*)(st + HS_KO + t * HL_QD + d * 2) = f2bf(kf * ei);
        }
        float ke[16];
#pragma unroll
        for (int t = 0; t < 16; ++t) ke[t] = kfs[t] * (E * einv[t]);
        *(LAS u32x4*)(st + HS_KET + d * HL_T) = pack8(ke); *(LAS u32x4*)(st + HS_KET + d * HL_T + 16) = pack8(ke + 8);
        ((LAS float*)(st + HS_DEC))[d] = E;
    };
    f32x4 sacc[2];
    sacc[0] = sacc[1] = (f32x4){0.f, 0.f, 0.f, 0.f};
    __syncthreads();
    load(0);
    for (int c = 0; c < NSTEPS / 64; ++c) {
        storeA();
        __syncthreads();
        storeB();
        if (c + 1 < NSTEPS / 64) load(c + 1);
        __syncthreads();
        if (wid < 4) {
            LAS char* st = lds + HC_SUB + wid * HS_SIZE;
            f32x4 acc = (f32x4){0.f, 0.f, 0.f, 0.f};
#pragma unroll
            for (int k0 = 0; k0 < 128; k0 += 32) acc = __builtin_amdgcn_mfma_f32_16x16x32_bf16(ldfrag(st + HS_KO, HL_QD, 0, k0, lane), ldfrag(st + HS_QI, HL_QD, 0, k0, lane), acc, 0, 0, 0);
#pragma unroll
            for (int j = 0; j < 4; ++j) acc[j] = (4 * q + j <= r16) ? acc[j] : 0.f;
            st4bf(st + HS_ATT + r16 * HL_T + 4 * q * 2, acc);
        }
        __syncthreads();
#pragma unroll 1
        for (int sb = 0; sb < 4; ++sb) {
            LAS char* st = lds + HC_SUB + sb * HS_SIZE;
            const LAS char* sbr = lds + HC_SB + (sb & 1) * 32 * HL_QD;
            LAS char* sbw = lds + HC_SB + ((sb + 1) & 1) * 32 * HL_QD;
            if (wid < 2) {
                f32x4 ya = __builtin_amdgcn_mfma_f32_16x16x32_bf16(ldfrag16(st + HS_VT, HL_T, wid * 16, lane), ldfrag16(st + HS_ATT, HL_T, 0, lane), (f32x4){0.f, 0.f, 0.f, 0.f}, 0, 0, 0);
#pragma unroll
                for (int k0 = 0; k0 < 128; k0 += 32) ya = __builtin_amdgcn_mfma_f32_16x16x32_bf16(ldfrag(sbr, HL_QD, wid * 16, k0, lane), ldfrag(st + HS_QI, HL_QD, 0, k0, lane), ya, 0, 0, 0);
                const int row = ((const LAS int*)(lds + HC_ROWS))[sb * 16 + r16];
                u32x2 o; o.x = pk2(ya[0], ya[1]); o.y = pk2(ya[2], ya[3]);
                *(u32x2*)(Y + (size_t)row * D + h * 128 + quarter * 32 + wid * 16 + 4 * q) = o;
            }
            {
                const int vt = wid >> 2;
                const bf16x8 vf = ldfrag16(st + HS_VT, HL_T, vt * 16, lane);
#pragma unroll
                for (int u = 0; u < 2; ++u) {
                    const int dt = (wid & 3) * 2 + u;
                    const f32x4 a = __builtin_amdgcn_mfma_f32_16x16x32_bf16(ldfrag16(st + HS_KET, HL_T, dt * 16, lane), vf, (f32x4){0.f, 0.f, 0.f, 0.f}, 0, 0, 0);
                    const f32x4 dc = *(const LAS f32x4*)((const LAS float*)(st + HS_DEC) + dt * 16 + 4 * q);
#pragma unroll
                    for (int j = 0; j < 4; ++j) sacc[u][j] = sacc[u][j] * dc[j] + a[j];
                    st4bf(sbw + (vt * 16 + r16) * HL_QD + (dt * 16 + 4 * q) * 2, sacc[u]);
                }
            }
            __syncthreads();
        }
    }
}

constexpr int RC_RAWW = 0;
constexpr int RC_RAWA = RC_RAWW + 64 * 64 * 4;
constexpr int RC_RAWB = RC_RAWA + 64 * 64 * 2, RC_RAWK = RC_RAWB + 64 * 64 * 2, RC_RAWR = RC_RAWK + 64 * 64 * 2;
constexpr int RC_SUB = RC_RAWR + 64 * 64 * 2;
constexpr int RL_C = 72 * 2, RL_32 = 40 * 2, RL_16 = 24 * 2;
constexpr int RS_AT = 0, RS_RT = RS_AT + 16 * RL_C, RS_KT = RS_RT + 16 * RL_C, RS_BT = RS_KT + 16 * RL_C, RS_KBH = RS_BT + 16 * RL_C, RS_AAK = RS_KBH + 64 * RL_32,
              RS_ARKB = RS_AAK + 16 * RL_16, RS_T = RS_ARKB + 16 * RL_32, RS_AABF = RS_T + 16 * RL_16, RS_GL = RS_AABF + 16 * 16 * 4, RS_VU = RS_GL + 256, RS_SIZE = RS_VU + 32 * RL_32;
constexpr int RC_SB = RC_SUB + 4 * RS_SIZE;
constexpr int RC_RHT = RC_SB + 32 * RL_C;
constexpr int RC_ROWS = RC_RHT + 32 * RL_16, RC_END = RC_ROWS + 256;
static_assert(RC_END <= LDS_BYTES - 16, "RWKV LDS map");
static_assert(RS_SIZE % 16 == 0 && RC_SB % 16 == 0 && RC_RHT % 16 == 0, "alignment");


__device__ __forceinline__ void phase_prep1(int wv, KP Pk, int layer) {
    asm volatile("" : "+s"(Pk));
    const CAS Params& P = *Pk;
    const int tid = ltid(wv), lane = tid & 63, wid = tid >> 6, i_ = layer >> 1;
    const bf16_t* Pb = (const bf16_t*)(P.ws + WS_P);
    bf16_t* R = (bf16_t*)(P.ws + WS_RWR); bf16_t* K = (bf16_t*)(P.ws + WS_RWK); bf16_t* V = (bf16_t*)(P.ws + WS_RWV); bf16_t* KK = (bf16_t*)(P.ws + WS_RWKK);
    bf16_t* LA = (bf16_t*)(P.ws + WS_LA);
    const float* mu = P.rw_mu + (size_t)i_ * 1856;
    float mur[8], muv[8], muk[8], mul_[8], kkw[8];
#pragma unroll
    for (int e = 0; e < 8; ++e) { mur[e] = mu[8 * lane + e]; muv[e] = mu[1024 + 8 * lane + e]; muk[e] = mu[512 + 8 * lane + e]; mul_[e] = lane < 40 ? mu[1536 + 8 * lane + e] : 0.f; kkw[e] = P.rw_k_k[i_ * 512 + 8 * lane + e]; }
    u32x4 nq[4][3]; float nmp = 0.f, nmn = 0.f;
    auto fetch = [&](int r) {
        int rprev = -1, rnext = -1;
        if (r < NCTX) { const int t = r & 255; if (t > 0) rprev = r - 1; if (t < CTXL - 1) rnext = r + 1; }
        else {
            const int bs = (r - NCTX) >> 13, s = (r - NCTX) & 8191, sg = ((s & 63) << 7) + (s >> 6);
            if (sg > 0) { const int g2 = sg - 1; rprev = NCTX + bs * SEQ + ((g2 & 127) << 6) + (g2 >> 7); }
            if (sg < SEQ - 1) { const int g2 = sg + 1; rnext = NCTX + bs * SEQ + ((g2 & 127) << 6) + (g2 >> 7); }
        }
        const bf16_t* pc = Pb + (size_t)r * LDP_ODD + 2560;
        const bf16_t* pp = Pb + (size_t)(rprev < 0 ? r : rprev) * LDP_ODD + 2560;
        const bf16_t* pn = Pb + (size_t)(rnext < 0 ? r : rnext) * LDP_ODD + 2560;
        nmp = rprev < 0 ? 0.f : 0.5f; nmn = rnext < 0 ? 0.f : 0.5f;
#pragma unroll
        for (int gq = 0; gq < 4; ++gq) {
            const int col = (gq == 0 ? 0 : gq == 1 ? 1024 : gq == 2 ? 512 : 1536) + 8 * lane;
            if (gq < 3 || lane < 40) { nq[gq][0] = *(const u32x4*)(pc + col); nq[gq][1] = *(const u32x4*)(pp + col); nq[gq][2] = *(const u32x4*)(pn + col); }
        }
    };
    nq[3][0] = nq[3][1] = nq[3][2] = (u32x4){0u, 0u, 0u, 0u};
    const int stride = gridDim.x * 8;
    int r = blockIdx.x * 8 + wid;
    if (r < NROWS) fetch(r);
    for (; r < NROWS; r += stride) {
        u32x4 cq[4][3];
#pragma unroll
        for (int gq = 0; gq < 4; ++gq)
#pragma unroll
            for (int k = 0; k < 3; ++k) cq[gq][k] = nq[gq][k];
        const float mp = nmp, mn = nmn;
        if (r + stride < NROWS) fetch(r + stride);
        auto mix8 = [&](const u32x4 (&c)[3], const float* muc, float* o) {
            float fc[8], fp[8], fn[8];
            unpack8(c[0], fc); unpack8(c[1], fp); unpack8(c[2], fn);
#pragma unroll
            for (int e = 0; e < 8; ++e) o[e] = fc[e] + muc[e] * (mp * fp[e] + mn * fn[e] - fc[e]);
        };
        float o[8];
        mix8(cq[0], mur, o); *(u32x4*)(R + (size_t)r * 512 + 8 * lane) = pack8(o);
        mix8(cq[1], muv, o); *(u32x4*)(V + (size_t)r * 512 + 8 * lane) = pack8(o);
        mix8(cq[2], muk, o); *(u32x4*)(K + (size_t)r * 512 + 8 * lane) = pack8(o);
        {
            float kk[8], ss = 0.f;
#pragma unroll
            for (int e = 0; e < 8; ++e) { kk[e] = o[e] * kkw[e]; ss += kk[e] * kk[e]; }
            ss = group_sum<8>(ss);
            const float rn = rsqrtf(fmaxf(ss, 1e-12f));
#pragma unroll
            for (int e = 0; e < 8; ++e) kk[e] *= rn;
            *(u32x4*)(KK + (size_t)r * 512 + 8 * lane) = pack8(kk);
        }
        if (lane < 40) {
            mix8(cq[3], mul_, o);
            if (lane < 16) {
#pragma unroll
                for (int e = 0; e < 8; ++e) o[e] = tanh_fast(o[e]);
            } else if (lane >= 24) {
#pragma unroll
                for (int e = 0; e < 8; ++e) o[e] = sigmoidf_(o[e]);
            }
            *(u32x4*)(LA + (size_t)r * 320 + 8 * lane) = pack8(o);
        }
    }
}

__device__ __forceinline__ void phase_out_even(int wv, KP Pk, int layer) {
    asm volatile("" : "+s"(Pk));
    const CAS Params& P = *Pk;
    const int tid = ltid(wv), lane = tid & 63, wid = tid >> 6, i_ = layer >> 1;
    const bf16_t* Pb = (const bf16_t*)(P.ws + WS_P);
    const bf16_t* Yf = (const bf16_t*)(P.ws + WS_YF); const bf16_t* Yb = (const bf16_t*)(P.ws + WS_YB);
    bf16_t* feat = (bf16_t*)(P.ws + WS_FEAT);
    const int r0 = (layer == DEPTH - 1) ? NCTX : 0;
    const bf16_t* XBC = (const bf16_t*)(P.ws + WS_EXBC);
    float nwa[8], nwb[8];
#pragma unroll
    for (int e = 0; e < 8; ++e) { nwa[e] = P.ssd_norm_w[i_ * 512 + 8 * lane + e]; nwb[e] = P.ml_norm_w[i_ * 512 + 8 * lane + e]; }
    const float dsk = P.ssd_d[i_ * 8 + (lane >> 3)];
    u32x4 n0, n1, n2, n3, n4, n5, n6;
    auto fetch = [&](int rr) {
        const bf16_t* pr = Pb + (size_t)rr * LDP_EVEN;
        n0 = *(const u32x4*)(Yf + (size_t)rr * D + 8 * lane); n1 = *(const u32x4*)(Yb + (size_t)rr * D + 8 * lane);
        n2 = *(const u32x4*)(XBC + (size_t)rr * 768 + 8 * lane); n3 = *(const u32x4*)(pr + 8 * lane);
        n4 = *(const u32x4*)(Yf + (size_t)rr * D + 512 + 8 * lane); n5 = *(const u32x4*)(Yb + (size_t)rr * D + 512 + 8 * lane); n6 = *(const u32x4*)(pr + 2320 + 8 * lane);
    };
    const int stride = gridDim.x * 8;
    int r = r0 + blockIdx.x * 8 + wid;
    if (r < NROWS) fetch(r);
    for (; r < NROWS; r += stride) {
        const u32x4 c0 = n0, c1 = n1, c2 = n2, c3 = n3, c4 = n4, c5 = n5, c6 = n6;
        if (r + stride < NROWS) fetch(r + stride);
        float y[8];
        {
            float a[8], bb[8], xsv[8], z[8];
            unpack8(c0, a); unpack8(c1, bb);
            unpack8(c2, xsv); unpack8(c3, z);
            float ss = 0.f;
#pragma unroll
            for (int e = 0; e < 8; ++e) {
                y[e] = (a[e] + bb[e] + dsk * xsv[e]) * siluf_(z[e]); ss += y[e] * y[e];
            }
            ss = wave_sum(ss);
            const float rn = rsqrtf(ss * (1.f / 512.f) + 1e-6f);
#pragma unroll
            for (int e = 0; e < 8; ++e) y[e] = y[e] * rn * nwa[e];
            *(u32x4*)(feat + (size_t)r * D + 8 * lane) = pack8(y);
        }
        {
            float a[8], bb[8], o[8];
            unpack8(c4, a); unpack8(c5, bb);
            unpack8(c6, o);
            float s = 0.f;
#pragma unroll
            for (int e = 0; e < 8; ++e) { y[e] = a[e] + bb[e]; s += y[e]; }
            const float mean = group_sum<16>(s) * (1.f / 128.f);
            float ss = 0.f;
#pragma unroll
            for (int e = 0; e < 8; ++e) { y[e] -= mean; ss += y[e] * y[e]; }
            const float rn = rsqrtf(group_sum<16>(ss) * (1.f / 128.f) + 1e-6f);
#pragma unroll
            for (int e = 0; e < 8; ++e) y[e] = sigmoidf_(o[e]) * (y[e] * rn) * nwb[e];
            *(u32x4*)(feat + (size_t)r * D + 512 + 8 * lane) = pack8(y);
        }
    }
}
__device__ __forceinline__ void phase_out_odd(int wv, KP Pk, int layer) {
    asm volatile("" : "+s"(Pk));
    const CAS Params& P = *Pk;
    const int tid = ltid(wv), lane = tid & 63, wid = tid >> 6, i_ = layer >> 1;
    const bf16_t* Pb = (const bf16_t*)(P.ws + WS_P);
    const bf16_t* Yf = (const bf16_t*)(P.ws + WS_YF); const bf16_t* Yb = (const bf16_t*)(P.ws + WS_YB);
    const bf16_t* R = (const bf16_t*)(P.ws + WS_RWR); const bf16_t* K = (const bf16_t*)(P.ws + WS_RWK); const bf16_t* V = (const bf16_t*)(P.ws + WS_RWV); const bf16_t* G = (const bf16_t*)(P.ws + WS_RWG);
    bf16_t* feat = (bf16_t*)(P.ws + WS_FEAT);
    const int r0 = (layer == DEPTH - 1) ? NCTX : 0;
    float nwc[8], rk[8], lw[8], lbv[8];
#pragma unroll
    for (int e = 0; e < 8; ++e) {
        nwc[e] = P.hg_norm_w[i_ * 512 + 8 * lane + e]; rk[e] = P.rw_r_k[i_ * 512 + 8 * lane + e];
        lw[e] = P.rw_ln_w[i_ * 512 + 8 * lane + e]; lbv[e] = P.rw_ln_b[i_ * 512 + 8 * lane + e];
    }
    u32x4 n0, n1, n2, n3, n4, n5, n6, n7, n8;
    auto fetch = [&](int rr) {
        n0 = *(const u32x4*)(Yf + (size_t)rr * D + 8 * lane); n1 = *(const u32x4*)(Yb + (size_t)rr * D + 8 * lane); n2 = *(const u32x4*)(Pb + (size_t)rr * LDP_ODD + 2048 + 8 * lane);
        n3 = *(const u32x4*)(Yf + (size_t)rr * D + 512 + 8 * lane); n4 = *(const u32x4*)(Yb + (size_t)rr * D + 512 + 8 * lane);
        n5 = *(const u32x4*)(R + (size_t)rr * 512 + 8 * lane); n6 = *(const u32x4*)(K + (size_t)rr * 512 + 8 * lane);
        n7 = *(const u32x4*)(V + (size_t)rr * 512 + 8 * lane); n8 = *(const u32x4*)(G + (size_t)rr * 512 + 8 * lane);
    };
    const int stride = gridDim.x * 8;
    int r = r0 + blockIdx.x * 8 + wid;
    if (r < NROWS) fetch(r);
    for (; r < NROWS; r += stride) {
        const u32x4 c0 = n0, c1 = n1, c2 = n2, c3 = n3, c4 = n4, c5 = n5, c6 = n6, c7 = n7, c8 = n8;
        if (r + stride < NROWS) fetch(r + stride);
        float y[8];
        {
            float a[8], bb[8], g[8];
            unpack8(c0, a); unpack8(c1, bb);
            unpack8(c2, g);
            float ss = 0.f;
#pragma unroll
            for (int e = 0; e < 8; ++e) { y[e] = a[e] + bb[e]; ss += y[e] * y[e]; }
            const float rn = rsqrtf(group_sum<16>(ss) * (1.f / 128.f) + 1e-6f);
#pragma unroll
            for (int e = 0; e < 8; ++e) y[e] = y[e] * rn * nwc[e] * siluf_(g[e]);
            *(u32x4*)(feat + (size_t)r * D + 8 * lane) = pack8(y);
        }
        {
            float a[8], bb[8], rr[8], kk[8], vv[8], g[8];
            unpack8(c3, a); unpack8(c4, bb);
            unpack8(c5, rr); unpack8(c6, kk);
            unpack8(c7, vv); unpack8(c8, g);
            float s = 0.f, bs = 0.f;
#pragma unroll
            for (int e = 0; e < 8; ++e) { y[e] = a[e] + bb[e]; s += y[e]; bs += rr[e] * kk[e] * rk[e]; }
            const float mean = group_sum<8>(s) * (1.f / 64.f); bs = group_sum<8>(bs);
            float ss = 0.f;
#pragma unroll
            for (int e = 0; e < 8; ++e) { y[e] -= mean; ss += y[e] * y[e]; }
            const float rn = rsqrtf(group_sum<8>(ss) * (1.f / 64.f) + 64e-5f);
#pragma unroll
            for (int e = 0; e < 8; ++e) y[e] = (y[e] * rn * lw[e] + lbv[e] + bs * vv[e]) * g[e];
            *(u32x4*)(feat + (size_t)r * D + 512 + 8 * lane) = pack8(y);
        }
    }
}

#ifndef MK_DOUBLE
#define MK_DOUBLE 0
#endif
#define REP(bit, body) do { body; if (MK_DOUBLE & (bit)) { body; } } while (0)
__device__ __forceinline__ void phase_expconv(int wv, KP Pk, int layer, LAS char* lds) {
    asm volatile("" : "+s"(Pk));
    const CAS Params& P = *Pk;
    const int tid = ltid(wv);
    if (layer & 1) return;
    expconv_items(P, layer, lds, exc_s0(layer) + exc_s1(layer), EXC_ITEMS, (int)blockIdx.x * 8 + (tid >> 6), (int)gridDim.x * 8, tid >> 6, tid & 63);
}
__device__ __forceinline__ void expconv_after_scan(int wv, KP Pk, int layer, LAS char* lds) {
    asm volatile("" : "+s"(Pk));
    const CAS Params& P = *Pk;
    const int tid = ltid(wv);
    __syncthreads();
    expconv_items(P, layer, lds, exc_s0(layer) + exc_s1(layer), EXC_ITEMS, (int)blockIdx.x * 8 + (tid >> 6), 128 * 8, tid >> 6, tid & 63);
}
constexpr int L1_AST = 1028;
constexpr int L1_PST = 33;
constexpr int L1_A = 0, L1_PART = L1_A + 16 * L1_AST * 4, L1_SM = L1_PART + 8 * 16 * L1_PST * 4, L1_END = L1_SM + (64 + 2 * 144 + 32) * 4;
static_assert(L1_END <= LDS_BYTES - 16, "LN1 LDS map");
__device__ __forceinline__ void phase_ln1(int wv, KP Pk, int layer, LAS char* lds, bool dry = false) {
    asm volatile("" : "+s"(Pk));
    const CAS Params& P = *Pk;
    const int tid = ltid(wv), lane = tid & 63;
    if (!dry) REP(8, phase_expconv(wv, Pk, layer, lds));
    __syncthreads();
    LAS float* At = (LAS float*)(lds + L1_A);
    LAS float* part = (LAS float*)(lds + L1_PART);
    LAS int* lcnt = (LAS int*)(lds + L1_SM);
    LAS int* lbase = lcnt + 32;
    LAS int* asg = lcnt + 64;
    LAS float* rbias = (LAS float*)(asg + 2 * 144);
    if (tid < 32) { lcnt[tid] = 0; rbias[tid] = P.router_bias[tid]; }
    float breg[8][4][2];
    {
        const float* rw = P.router_w + (size_t)(128 * wv + 4 * (lane >> 4)) * NEXP + (lane & 15);
#pragma unroll
        for (int j = 0; j < 8; ++j)
#pragma unroll
            for (int i = 0; i < 4; ++i) { breg[j][i][0] = rw[(16 * j + i) * NEXP]; breg[j][i][1] = rw[(16 * j + i) * NEXP + 16]; }
    }
    __syncthreads();
    const bf16_t* yo = (const bf16_t*)(P.ws + WS_YO);
    bf16_t* act = (bf16_t*)(P.ws + (dry ? WS_FEAT : WS_ACT));
    bf16_t* xcb = (bf16_t*)(P.ws + WS_XC); bf16_t* xob = (bf16_t*)P.out;
    const bool lastl = (layer == DEPTH - 1);
    int* cnt = (int*)(P.ws + WS_CNT) + layer * 32 * CNT_STRIDE;
    int* list = (int*)(P.ws + WS_LIST);
    float* wts = (float*)(P.ws + WS_WTS);
    const float* lg = P.ln_g + (size_t)(layer * 2 + 0) * D; const float* lb = P.ln_b + (size_t)(layer * 2 + 0) * D;
    const int r0 = (layer == DEPTH - 1) ? NCTX : 0, ntiles = (NROWS - r0) / 16, G = gridDim.x;
    f32x4 g1v[4], s2c[4], h2c[4];
#pragma unroll
    for (int i = 0; i < 4; ++i) g1v[i] = s2c[i] = h2c[i] = (f32x4){0.f, 0.f, 0.f, 0.f};
    int mcur = -1;
    f32x4 nx[2][4]; u32x2 nyo[2][4];
    auto fetch = [&](int s, int rr) {
        if (layer == 0) {
            const float* xq = rr < NCTX ? P.ctx + (size_t)rr * D : P.x + (size_t)(rr - NCTX) * D;
#pragma unroll
            for (int i = 0; i < 4; ++i) nx[s][i] = *(const f32x4*)(xq + 4 * lane + 256 * i);
        } else {
            const bf16_t* xq = rr < NCTX ? xcb + (size_t)rr * D : xob + (size_t)(rr - NCTX) * D;
#pragma unroll
            for (int i = 0; i < 4; ++i) { const u32x2 t = *(const u32x2*)(xq + 4 * lane + 256 * i); nx[s][i] = (f32x4){__uint_as_float(t.x), __uint_as_float(t.y), 0.f, 0.f}; }
        }
#pragma unroll
        for (int i = 0; i < 4; ++i) { const int c = 4 * lane + 256 * i; nyo[s][i] = *(const u32x2*)(yo + (size_t)rr * D + c); }
    };
    int tile = blockIdx.x;
    if (tile < ntiles) { fetch(0, r0 + tile * 16 + 2 * wv); fetch(1, r0 + tile * 16 + 2 * wv + 1); }
    for (int it = 0; tile < ntiles; ++it, tile += G) {
        const int rb = r0 + tile * 16 + 2 * wv;
        const int m = row_mod(rb);
        if (m != mcur) {
            mcur = m;
            const float* g1 = modvec(P.ws, layer, m, 2); const float* sh2 = modvec(P.ws, layer, m, 3); const float* sc2 = modvec(P.ws, layer, m, 4);
#pragma unroll
            for (int i = 0; i < 4; ++i) { const int c = 4 * lane + 256 * i; g1v[i] = *(const f32x4*)(g1 + c); s2c[i] = *(const f32x4*)(sc2 + c); h2c[i] = *(const f32x4*)(sh2 + c); }
        }
#pragma unroll
        for (int s = 0; s < 2; ++s) {
            const int r = rb + s;
            bf16_t* xr = dry ? (bf16_t*)(P.ws + WS_YF) + (size_t)r * D : lastl ? (bf16_t*)(P.ws + WS_FEAT) + (size_t)r * D : r < NCTX ? xcb + (size_t)r * D : xob + (size_t)(r - NCTX) * D;
            f32x4 v[4]; float sm = 0.f;
#pragma unroll
            for (int i = 0; i < 4; ++i) {
                f32x4 xv = nx[s][i]; const f32x4 gv = g1v[i]; const u32x2 yv = nyo[s][i];
                if (layer != 0) { const unsigned b0 = __float_as_uint(xv[0]), b1 = __float_as_uint(xv[1]); xv = (f32x4){bflo(b0), bfhi(b0), bflo(b1), bfhi(b1)}; }
                v[i][0] = ALPHA * xv[0] + gv[0] * bflo(yv.x); v[i][1] = ALPHA * xv[1] + gv[1] * bfhi(yv.x);
                v[i][2] = ALPHA * xv[2] + gv[2] * bflo(yv.y); v[i][3] = ALPHA * xv[3] + gv[3] * bfhi(yv.y);
                sm += (v[i][0] + v[i][1]) + (v[i][2] + v[i][3]);
            }
            if (tile + G < ntiles) fetch(s, r + G * 16);
            const float mean = wave_sum(sm) * (1.f / D);
            float s2 = 0.f;
#pragma unroll
            for (int i = 0; i < 4; ++i) { v[i] = v[i] - mean; s2 += (v[i][0] * v[i][0] + v[i][1] * v[i][1]) + (v[i][2] * v[i][2] + v[i][3] * v[i][3]); }
            const float rstd = rsqrtf(wave_sum(s2) * (1.f / D) + 1e-5f);
            LAS float* arow = At + (2 * wv + s) * L1_AST;
#pragma unroll
            for (int i = 0; i < 4; ++i) {
                const int c = 4 * lane + 256 * i;
                const f32x4 gg = *(const f32x4*)(lg + c), bb = *(const f32x4*)(lb + c), s2v = s2c[i], h2v = h2c[i];
                f32x4 xn, hv;
#pragma unroll
                for (int j = 0; j < 4; ++j) { xn[j] = v[i][j] * rstd * gg[j] + bb[j]; hv[j] = xn[j] * (1.f + s2v[j]) + h2v[j]; }
                { u32x2 ox; ox.x = pk2(xn[0], xn[1]); ox.y = pk2(xn[2], xn[3]); *(u32x2*)(xr + c) = ox; }
                u32x2 o; o.x = pk2(hv[0], hv[1]); o.y = pk2(hv[2], hv[3]); *(u32x2*)(act + (size_t)r * D + c) = o;
                *(LAS f32x4*)(arow + c) = hv;
            }
        }
        __syncthreads();
        {
            f32x4 ra0 = (f32x4){0.f, 0.f, 0.f, 0.f}, ra1 = ra0;
            const LAS float* ap = At + (lane & 15) * L1_AST + 128 * wv + 4 * (lane >> 4);
#pragma unroll
            for (int j = 0; j < 8; ++j) {
                const f32x4 a4 = *(const LAS f32x4*)(ap + 16 * j);
#pragma unroll
                for (int i = 0; i < 4; ++i) {
                    ra0 = __builtin_amdgcn_mfma_f32_16x16x4f32(a4[i], breg[j][i][0], ra0, 0, 0, 0);
                    ra1 = __builtin_amdgcn_mfma_f32_16x16x4f32(a4[i], breg[j][i][1], ra1, 0, 0, 0);
                }
            }
            LAS float* pw = part + wv * 16 * L1_PST + (4 * (lane >> 4)) * L1_PST + (lane & 15);
#pragma unroll
            for (int j = 0; j < 4; ++j) { pw[j * L1_PST] = ra0[j]; pw[j * L1_PST + 16] = ra1[j]; }
        }
        __syncthreads();
        {
            const int half = lane >> 5, e = lane & 31;
            const LAS float* pp = part + (2 * wv + half) * L1_PST + e;
            float sc_ = 0.f;
#pragma unroll
            for (int k = 0; k < 8; ++k) sc_ += pp[k * 16 * L1_PST];
            const float sg = sigmoidf_(sc_), vb = sg + rbias[e];
            float bv[4], sv[4];
            bv[0] = dppmov<0x00>(vb); bv[1] = dppmov<0x55>(vb); bv[2] = dppmov<0xAA>(vb); bv[3] = dppmov<0xFF>(vb);
            sv[0] = dppmov<0x00>(sg); sv[1] = dppmov<0x55>(sg); sv[2] = dppmov<0xAA>(sg); sv[3] = dppmov<0xFF>(sg);
            float m1 = -1e30f, m2 = -1e30f;
#pragma unroll
            for (int k = 0; k < 4; ++k) { const float vsc = bv[k]; if (vsc > m1) { m2 = m1; m1 = vsc; } else if (vsc > m2) m2 = vsc; }
            float best = m1 + m2; int bg = e >> 2;
#pragma unroll
            for (int msk = 4; msk <= 16; msk <<= 1) {
                const float ob = __shfl_xor(best, msk); const int og = __shfl_xor(bg, msk);
                const bool take = (ob > best) || (ob == best && og < bg);
                best = take ? ob : best; bg = take ? og : bg;
            }
            int i1 = 0; float b1 = bv[0];
#pragma unroll
            for (int k = 1; k < 4; ++k) if (bv[k] > b1) { b1 = bv[k]; i1 = k; }
            int i2 = -1; float b2 = -1e30f;
#pragma unroll
            for (int k = 0; k < 4; ++k) if (k != i1 && bv[k] > b2) { b2 = bv[k]; i2 = k; }
            float s1 = sv[0], s2s = sv[0];
#pragma unroll
            for (int k = 1; k < 4; ++k) { if (i1 == k) s1 = sv[k]; if (i2 == k) s2s = sv[k]; }
            if (e == 4 * bg && !dry) {
                const int r = rb + half;
                const int e0 = bg * 4 + i1, e1 = bg * 4 + i2;
                const float inv = 1.f / (s1 + s2s);
                const int li = it * 16 + 2 * wv + half;
                const int p0 = __hip_atomic_fetch_add(&lcnt[e0], 1, __ATOMIC_RELAXED, __HIP_MEMORY_SCOPE_WORKGROUP);
                const int p1 = __hip_atomic_fetch_add(&lcnt[e1], 1, __ATOMIC_RELAXED, __HIP_MEMORY_SCOPE_WORKGROUP);
                asg[2 * li] = (e0 << 16) | p0; asg[2 * li + 1] = (e1 << 16) | p1;
                wts[2 * r] = s1 * inv; wts[2 * r + 1] = s2s * inv;
            }
        }
    }
    __syncthreads();
    if (dry) return;
    if (tid < 32) lbase[tid] = atomicAdd(&cnt[tid * CNT_STRIDE], lcnt[tid]);
    __syncthreads();
    for (int idx = tid; idx < 2 * 144; idx += NT) {
        const int li = idx >> 1, k = idx & 1, t = (li >> 4) * G + blockIdx.x;
        if (t < ntiles) { const int r = r0 + t * 16 + (li & 15); const int v = asg[idx], e = v >> 16, lp = v & 0xffff; list[(size_t)e * LISTCAP + lbase[e] + lp] = 2 * r + k; }
    }
}

__device__ __forceinline__ void phase_ln2(int wv, KP Pk, int layer, bool dry = false) {
    asm volatile("" : "+s"(Pk));
    const CAS Params& P = *Pk;
    const int tid = ltid(wv), lane = tid & 63, wid = tid >> 6;
    const bf16_t* yp = (const bf16_t*)(P.ws + WS_YP);
    const float* wts = (const float*)(P.ws + WS_WTS);
    bf16_t* act = (bf16_t*)(P.ws + (dry ? WS_FEAT : WS_ACT));
    bf16_t* xcb = (bf16_t*)(P.ws + WS_XC); bf16_t* xob = (bf16_t*)P.out;
    const float* lg = P.ln_g + (size_t)(layer * 2 + 1) * D; const float* lb = P.ln_b + (size_t)(layer * 2 + 1) * D;
    const bool last = (layer == DEPTH - 1);
    const int r0 = last ? NCTX : 0, stride = gridDim.x * 8;
    f32x4 cg[4], cb[4], g2v[4], s1v[4], h1v[4];
#pragma unroll
    for (int i = 0; i < 4; ++i) { cg[i] = *(const f32x4*)(lg + 4 * lane + 256 * i); cb[i] = *(const f32x4*)(lb + 4 * lane + 256 * i); g2v[i] = s1v[i] = h1v[i] = (f32x4){0.f, 0.f, 0.f, 0.f}; }
    int mcur = -1;
    u32x2 nx[4]; u32x2 ny0[4], ny1[4]; float nw0 = 0.f, nw1 = 0.f;
    auto fetch = [&](int r) {
        const bf16_t* xr = last ? (const bf16_t*)(P.ws + WS_FEAT) + (size_t)r * D : r < NCTX ? xcb + (size_t)r * D : xob + (size_t)(r - NCTX) * D;
#pragma unroll
        for (int i = 0; i < 4; ++i) {
            const int c = 4 * lane + 256 * i;
            nx[i] = *(const u32x2*)(xr + c); ny0[i] = *(const u32x2*)(yp + (size_t)(2 * r) * D + c); ny1[i] = *(const u32x2*)(yp + (size_t)(2 * r + 1) * D + c);
        }
        nw0 = wts[2 * r]; nw1 = wts[2 * r + 1];
    };
    int r = r0 + blockIdx.x * 8 + wid;
    if (r < NROWS) fetch(r);
    for (; r < NROWS; r += stride) {
        const int m = row_mod(r);
        if (m != mcur) {
            mcur = m;
            const float* g2 = modvec(P.ws, layer, m, 5); const float* sh1 = last ? lg : modvec(P.ws, layer + 1, m, 0); const float* sc1 = last ? lg : modvec(P.ws, layer + 1, m, 1);
#pragma unroll
            for (int i = 0; i < 4; ++i) { const int c = 4 * lane + 256 * i; g2v[i] = *(const f32x4*)(g2 + c); s1v[i] = *(const f32x4*)(sc1 + c); h1v[i] = *(const f32x4*)(sh1 + c); }
        }
        f32x4 v[4]; float s = 0.f;
        const float w0 = nw0, w1 = nw1;
#pragma unroll
        for (int i = 0; i < 4; ++i) {
            const f32x4 xv = (f32x4){bflo(nx[i].x), bfhi(nx[i].x), bflo(nx[i].y), bfhi(nx[i].y)}, gv = g2v[i]; const u32x2 y0 = ny0[i], y1 = ny1[i];
            v[i][0] = ALPHA * xv[0] + gv[0] * (w0 * bflo(y0.x) + w1 * bflo(y1.x)); v[i][1] = ALPHA * xv[1] + gv[1] * (w0 * bfhi(y0.x) + w1 * bfhi(y1.x));
            v[i][2] = ALPHA * xv[2] + gv[2] * (w0 * bflo(y0.y) + w1 * bflo(y1.y)); v[i][3] = ALPHA * xv[3] + gv[3] * (w0 * bfhi(y0.y) + w1 * bfhi(y1.y));
            s += (v[i][0] + v[i][1]) + (v[i][2] + v[i][3]);
        }
        if (r + stride < NROWS) fetch(r + stride);
        const float mean = wave_sum(s) * (1.f / D);
        float s2 = 0.f;
#pragma unroll
        for (int i = 0; i < 4; ++i) { v[i] = v[i] - mean; s2 += (v[i][0] * v[i][0] + v[i][1] * v[i][1]) + (v[i][2] * v[i][2] + v[i][3] * v[i][3]); }
        const float rstd = rsqrtf(wave_sum(s2) * (1.f / D) + 1e-5f);
#pragma unroll
        for (int i = 0; i < 4; ++i) {
            const int c = 4 * lane + 256 * i;
            f32x4 xn;
#pragma unroll
            for (int j = 0; j < 4; ++j) xn[j] = v[i][j] * rstd * cg[i][j] + cb[i][j];
            if (dry) *(f32x4*)((float*)(P.ws + WS_YF) + (size_t)r * D + c) = xn;
            else if (last) *(f32x4*)(P.out + (size_t)(r - NCTX) * D + c) = xn;
            else { u32x2 ox; ox.x = pk2(xn[0], xn[1]); ox.y = pk2(xn[2], xn[3]); *(u32x2*)((r < NCTX ? xcb + (size_t)r * D : xob + (size_t)(r - NCTX) * D) + c) = ox; }
            if (!last) {
                u32x2 o; o.x = pk2(xn[0] * (1.f + s1v[i][0]) + h1v[i][0], xn[1] * (1.f + s1v[i][1]) + h1v[i][1]); o.y = pk2(xn[2] * (1.f + s1v[i][2]) + h1v[i][2], xn[3] * (1.f + s1v[i][3]) + h1v[i][3]);
                *(u32x2*)(act + (size_t)r * D + c) = o;
            }
        }
    }
}

constexpr int NPHASE = 2 + 11 * DEPTH;
__global__ void __launch_bounds__(NT, 2) fwd_kernel(Params P) {
    extern __shared__ __attribute__((aligned(16))) char lds_raw[];
    LAS char* lds = (LAS char*)lds_raw;
    volatile LAS unsigned* xbw = (volatile LAS unsigned*)(lds + LDS_BYTES - 16);
    KP Pk = (KP)__builtin_amdgcn_kernarg_segment_ptr();
    const int wv = __builtin_amdgcn_readfirstlane((int)(threadIdx.x >> 6));
    const bool multi = (P.ph_hi - P.ph_lo) > 1;
    XcdBarrier bar; bar.bar = (unsigned*)(P.ws + WS_BAR); bar.x = 0; bar.st = xbw;
    if (multi) {
        if (ltid(wv) == 0) { xbw[0] = 0u; xbw[1] = 0u; xbw[2] = 0u; xbw[3] = 0u; }
        __syncthreads();
        bar = xcd_barrier_post(wv, (unsigned*)(P.ws + WS_BAR), xbw);
    }
#define PHASE(id, body) do { if (P.ph_lo <= (id) && (id) < P.ph_hi) { body; if ((id) + 1 < P.ph_hi) xcd_barrier(wv, bar); if (MK_DOUBLE & 2048) xcd_barrier(wv, bar); } } while (0)
    PHASE(0, REP(16, phase_prologue0(wv, Pk, lds)));
    PHASE(1, REP(16, phase_prologue1(wv, Pk)));
    for (int l = 0; l < DEPTH; ++l) {
        const int pb = 2 + 11 * l, odd = l & 1;
        PHASE(pb + 0, REP(1, phase_inproj(wv, Pk, l, lds)));
        if (odd) {
            PHASE(pb + 1, REP(4, phase_prep1(wv, Pk, l)));
            PHASE(pb + 2, phase_prep2(wv, Pk, l, lds));
            PHASE(pb + 3, REP(32, { if (blockIdx.x < 128) { REP(64, scan_hgrn_c(wv, Pk, l, blockIdx.x, lds)); expconv_after_scan(wv, Pk, l, lds); } else if (blockIdx.x < 256) REP(128, scan_rwkv_b(wv, Pk, l, blockIdx.x - 128, lds)); }));
            PHASE(pb + 5, REP(4, phase_out_odd(wv, Pk, l)));
        } else {
            PHASE(pb + 1, REP(4, phase_prep_even(wv, Pk, l)));
            PHASE(pb + 2, REP(2, phase_ex1(wv, Pk, l, lds)));
            PHASE(pb + 3, phase_ex2(wv, Pk, l));
            PHASE(pb + 4, REP(2, phase_ex3(wv, Pk, l, lds)));
            PHASE(pb + 5, REP(4, phase_out_even(wv, Pk, l)));
        }
        PHASE(pb + 6, REP(256, phase_outproj(wv, Pk, l, lds)));
        PHASE(pb + 7, { if (MK_DOUBLE & 4096) phase_ln1(wv, Pk, l, lds, true); phase_ln1(wv, Pk, l, lds); });
        PHASE(pb + 8, REP(512, phase_moe1(wv, Pk, l, lds)));
        PHASE(pb + 9, REP(1024, phase_moe2(wv, Pk, l, lds)));
        PHASE(pb + 10, { if (MK_DOUBLE & 8192) phase_ln2(wv, Pk, l, true); phase_ln2(wv, Pk, l); });
    }
#undef PHASE
}


#ifndef MK_STOP
#define MK_STOP NPHASE
#endif
#ifndef MK_DUMP
#define MK_DUMP 0
#endif
#ifndef MK_DUMP_N
#define MK_DUMP_N (1u << 30)
#endif
#ifndef MK_DUMP_LD
#define MK_DUMP_LD 1024
#endif
#ifndef MK_DUMP_C0
#define MK_DUMP_C0 0
#endif
__global__ void diff_kernel(const bf16_t* a, const bf16_t* b, float* out, size_t n) {
    for (size_t i = (size_t)blockIdx.x * blockDim.x + threadIdx.x; i < n; i += (size_t)gridDim.x * blockDim.x) out[i] = 1e6f * (bf2f(a[i]) - bf2f(b[i]));
}
__global__ void dump_kernel(const bf16_t* src, float* out, size_t n) {
    for (size_t i = (size_t)blockIdx.x * blockDim.x + threadIdx.x; i < n; i += (size_t)gridDim.x * blockDim.x) out[i] = i < (size_t)MK_DUMP_N ? bf2f(src[(i >> 10) * MK_DUMP_LD + MK_DUMP_C0 + (i & 1023)]) : 0.f;
}
extern "C" void kernel_launch(void* const* d_in, const int* in_sizes, int n_in, void* d_out, int out_size, void* d_ws, size_t ws_size, hipStream_t stream) {
    static int ready = 0;
    if (ready == 0) {
        ready = 1;
        if (n_in != 42 || out_size != NB * SEQ * D || ws_size < WS_END) { fprintf(stderr, "kernel_launch: unexpected shapes (n_in %d out %d ws %zu need %zu)\n", n_in, out_size, ws_size, (size_t)WS_END); ready = -1; }
        if (hipFuncSetAttribute((const void*)fwd_kernel, hipFuncAttributeMaxDynamicSharedMemorySize, LDS_BYTES) != hipSuccess) { fprintf(stderr, "kernel_launch: hipFuncSetAttribute failed\n"); ready = -1; }
    }
    if (ready < 0) return;
    (void)in_sizes;
    hipMemsetAsync((char*)d_ws + WS_BAR, 0, WS_ZERO_BYTES, stream);
    Params p;
    memset(&p, 0, sizeof(p));
    const float** fp = (const float**)&p;
    for (int i = 0; i < 42; ++i) fp[i] = (const float*)d_in[i];
    p.out = (float*)d_out; p.ws = (unsigned char*)d_ws;
#if MK_PER_PHASE
    for (int ph = 0; ph < MK_STOP; ++ph) {
        const int local = ph < 2 ? -1 : (ph - 2) % 11, layer = ph < 2 ? 0 : (ph - 2) / 11;
        if (local == 4 && (layer & 1)) continue;
        p.ph_lo = ph; p.ph_hi = ph + 1;
        hipLaunchKernelGGL(fwd_kernel, dim3(256), dim3(NT), LDS_BYTES, stream, p);
    }
#ifdef MK_DIFF
    p.ph_lo = 7; p.ph_hi = 8; p.dbg = 1;
    hipLaunchKernelGGL(fwd_kernel, dim3(256), dim3(NT), LDS_BYTES, stream, p);
    hipLaunchKernelGGL(diff_kernel, dim3(1024), dim3(256), 0, stream, (const bf16_t*)((unsigned char*)d_ws + WS_YO), (const bf16_t*)((unsigned char*)d_ws + WS_HID), (float*)d_out, (size_t)NB * SEQ * D);
#else
    if (MK_DUMP) hipLaunchKernelGGL(dump_kernel, dim3(1024), dim3(256), 0, stream, (const bf16_t*)((unsigned char*)d_ws + (size_t)MK_DUMP), (float*)d_out, (size_t)NB * SEQ * D);
#endif
#else
    p.ph_lo = 0; p.ph_hi = NPHASE;
    hipLaunchKernelGGL(fwd_kernel, dim3(256), dim3(NT), LDS_BYTES, stream, p);
#endif
}
```

```cpp
#include <hip/hip_runtime.h>
#include <stdint.h>
#include <stdio.h>
#include <string.h>

#ifndef MK_PER_PHASE
#define MK_PER_PHASE 0
#endif

typedef unsigned short bf16_t;
typedef short bf16x8 __attribute__((ext_vector_type(8)));
typedef float f32x4 __attribute__((ext_vector_type(4)));
typedef unsigned u32x4 __attribute__((ext_vector_type(4)));
typedef unsigned u32x2 __attribute__((ext_vector_type(2)));
#define LAS __attribute__((address_space(3)))
#define CAS __attribute__((address_space(4)))

constexpr int D = 1024, NB = 4, SEQ = 8192, CTXL = 256, DEPTH = 4;
constexpr int NCTX = NB * CTXL;
constexpr int NROWS = NCTX + NB * SEQ;
constexpr int P_EVEN = 2848, P_ODD = 4416, LDP_EVEN = 3072, LDP_ODD = 4608;
constexpr int NEXP = 32, DEXP = 512, LISTCAP = NROWS;
constexpr float ALPHA = 1.681792830507429f;
constexpr int NT = 512;
constexpr int TCH = 32;
constexpr int NSTEPS = CTXL + SEQ;
constexpr int LDS_BYTES = 160 * 1024;

constexpr size_t al256(size_t x) { return (x + 255) & ~(size_t)255; }
constexpr size_t WS_BAR = 0;
constexpr size_t WS_CNT = 16384;
constexpr int CNT_STRIDE = 64;
constexpr size_t WS_ZERO_BYTES = 16384 + (size_t)4 * 32 * CNT_STRIDE * 4;
constexpr size_t WS_MODV = al256(WS_ZERO_BYTES);
constexpr size_t WS_LB = WS_MODV + al256((size_t)4 * 5 * 6144 * 4);
constexpr size_t WS_XC = WS_LB + al256(4 * 512 * 4);
constexpr size_t WS_WTS = WS_XC + (size_t)NCTX * D * 4;
constexpr size_t WS_LIST = WS_WTS + al256((size_t)2 * NROWS * 4);
constexpr size_t WS_WINT = WS_LIST + al256((size_t)NEXP * LISTCAP * 4);
constexpr size_t WINT_L0 = 0, WINT_L1 = (size_t)LDP_EVEN * D, WINT_L2 = WINT_L1 + (size_t)LDP_ODD * D, WINT_L3 = WINT_L2 + (size_t)LDP_EVEN * D, WINT_END = WINT_L3 + (size_t)LDP_ODD * D;
constexpr size_t WS_WOUTT = WS_WINT + WINT_END * 2;
constexpr size_t WS_LORAT = WS_WOUTT + (size_t)4 * D * D * 2;
constexpr size_t LORA_PER = (size_t)512 * 320;
constexpr size_t WS_EXPGU = WS_LORAT + al256(2 * LORA_PER * 2);
constexpr size_t WS_EXPD = WS_EXPGU + (size_t)NEXP * 1024 * 1024 * 2;
constexpr size_t WS_ACT = WS_EXPD + (size_t)NEXP * 1024 * 512 * 2;
constexpr size_t ROWB = (size_t)NROWS * D * 2;
constexpr size_t WS_FEAT = WS_ACT + ROWB;
constexpr size_t WS_YF = WS_FEAT + ROWB;
constexpr size_t WS_YB = WS_YF + ROWB;
constexpr size_t WS_P = WS_YB + ROWB;
constexpr size_t P_BYTES = (size_t)NROWS * LDP_ODD * 2;
constexpr size_t WS_YO = WS_P;
constexpr size_t WS_HID = WS_P + ROWB;
constexpr size_t WS_YP = WS_HID + ROWB;
static_assert(WS_YP + 2 * ROWB <= WS_P + P_BYTES, "MoE buffers must fit in the P region");
constexpr size_t HALFB = (size_t)NROWS * 512 * 2;
constexpr size_t WS_RWR = WS_P + P_BYTES;
constexpr size_t WS_RWK = WS_RWR + HALFB;
constexpr size_t WS_RWV = WS_RWK + HALFB;
constexpr size_t WS_RWKK = WS_RWV + HALFB;
constexpr size_t WS_RWB = WS_RWKK + HALFB;
constexpr size_t WS_RWG = WS_RWB + HALFB;
constexpr size_t WS_RWDEC = WS_RWG + HALFB;
constexpr size_t WS_LA = WS_RWDEC + (size_t)2 * NROWS * 512 * 4;
constexpr size_t WS_END = WS_LA + (size_t)NROWS * 320 * 2;
static_assert(WS_END <= (size_t)280602384 * 4, "workspace map exceeds the guaranteed ws_size");

struct Params {
    const float *x, *c, *ctx, *c_ctx, *mod_w, *mod_b, *ln_g, *ln_b;
    const float *ev_w_in, *ev_w_out, *ssd_conv_w, *ssd_conv_b, *ssd_dt_bias, *ssd_a_log, *ssd_d, *ssd_norm_w;
    const float *ml_conv_w, *ml_conv_b, *ml_i_bias, *ml_f_bias, *ml_norm_w;
    const float *od_w_in, *od_w_out, *hg_lb_logits, *hg_f_bias, *hg_norm_w;
    const float *rw_mu, *rw_w0, *rw_w2, *rw_a0, *rw_a2, *rw_g2, *rw_k_k, *rw_k_a, *rw_r_k, *rw_ln_w, *rw_ln_b;
    const float *router_w, *router_bias, *exp_w_gate, *exp_w_up, *exp_w_down;
    float* out;
    unsigned char* ws;
    int ph_lo, ph_hi, dbg, pad_;
};
typedef const CAS Params* KP;

__device__ __forceinline__ int ltid(int wv) { int l; asm volatile("v_mbcnt_lo_u32_b32 %0, -1, 0\n\tv_mbcnt_hi_u32_b32 %0, -1, %0" : "=v"(l)); return wv * 64 + l; }
__device__ __forceinline__ float bf2f(bf16_t h) { return __uint_as_float(((unsigned)h) << 16); }
__device__ __forceinline__ float bflo(unsigned u) { return __uint_as_float(u << 16); }
__device__ __forceinline__ float bfhi(unsigned u) { return __uint_as_float(u & 0xffff0000u); }
typedef __bf16 bf16v2_t __attribute__((ext_vector_type(2)));
typedef float f32x2 __attribute__((ext_vector_type(2)));
__device__ __forceinline__ unsigned pk2(float lo, float hi) { const f32x2 v = {lo, hi}; return __builtin_bit_cast(unsigned, __builtin_convertvector(v, bf16v2_t)); }
__device__ __forceinline__ bf16_t f2bf(float f) { return (bf16_t)(pk2(f, 0.f) & 0xffffu); }
__device__ __forceinline__ void unpack8(const u32x4& u, float* f) {
    f[0] = bflo(u.x); f[1] = bfhi(u.x); f[2] = bflo(u.y); f[3] = bfhi(u.y); f[4] = bflo(u.z); f[5] = bfhi(u.z); f[6] = bflo(u.w); f[7] = bfhi(u.w);
}
__device__ __forceinline__ u32x4 pack8(const float* f) { u32x4 u; u.x = pk2(f[0], f[1]); u.y = pk2(f[2], f[3]); u.z = pk2(f[4], f[5]); u.w = pk2(f[6], f[7]); return u; }
__device__ __forceinline__ float sigmoidf_(float x) { return __builtin_amdgcn_rcpf(1.f + __expf(-x)); }
__device__ __forceinline__ float siluf_(float x) { return x * __builtin_amdgcn_rcpf(1.f + __expf(-x)); }
__device__ __forceinline__ float softplus_fast(float x) { return x > 20.f ? x : __logf(1.f + __expf(x)); }
__device__ __forceinline__ float tanh_fast(float x) { return 1.f - 2.f * __builtin_amdgcn_rcpf(1.f + __expf(2.f * x)); }
__device__ __forceinline__ float softplusf_(float x) { return x > 20.f ? x : __logf(1.f + __expf(x)); }
__device__ __forceinline__ float logsigmoidf_(float x) { return fminf(x, 0.f) - __logf(1.f + __expf(-fabsf(x))); }
template <int CTRL> __device__ __forceinline__ float dppmov(float v) {
    return __builtin_bit_cast(float, __builtin_amdgcn_update_dpp(0, __builtin_bit_cast(int, v), CTRL, 0xf, 0xf, true));
}
__device__ __forceinline__ float allreduce16(float v) {
    v += dppmov<0xB1>(v);
    v += dppmov<0x4E>(v);
    v += dppmov<0x141>(v);
    v += dppmov<0x140>(v);
    return v;
}
__device__ __forceinline__ float allreduce8_(float v) { v += dppmov<0xB1>(v); v += dppmov<0x4E>(v); v += dppmov<0x141>(v); return v; }
__device__ __forceinline__ float wave_sum(float v) {
    v = allreduce16(v);
    const float r0 = __builtin_bit_cast(float, __builtin_amdgcn_readlane(__builtin_bit_cast(int, v), 0)), r1 = __builtin_bit_cast(float, __builtin_amdgcn_readlane(__builtin_bit_cast(int, v), 16));
    const float r2 = __builtin_bit_cast(float, __builtin_amdgcn_readlane(__builtin_bit_cast(int, v), 32)), r3 = __builtin_bit_cast(float, __builtin_amdgcn_readlane(__builtin_bit_cast(int, v), 48));
    return (r0 + r1) + (r2 + r3);
}
template <int W> __device__ __forceinline__ float group_sum(float v) {
    if (W == 8) return allreduce8_(v);
    return allreduce16(v);
}

#define XB_TMO      128
#define XB_XCNT(j)  (256  + 64 * (j))
#define XB_XSUB(j)  (1280 + 64 * (j))
#define XB_XGEN(j)  (2304 + 64 * (j))
#define XB_TOP      3328
#define XB_TOPGEN   3392
#define XCD_BAR_WORDS 3456
#define XB_SPIN_CAP (1u << 22)
__device__ __forceinline__ unsigned xb_ld(unsigned* p)              { return __hip_atomic_load(p, __ATOMIC_RELAXED, __HIP_MEMORY_SCOPE_AGENT); }
__device__ __forceinline__ unsigned xb_add(unsigned* p, unsigned v) { return __hip_atomic_fetch_add(p, v, __ATOMIC_RELAXED, __HIP_MEMORY_SCOPE_AGENT); }
__device__ __forceinline__ unsigned xb_xcc_id() { return (unsigned)__builtin_amdgcn_s_getreg((3 << 11) | 20) & 0xFu; }
#define XB_SPIN(cond, bar) do { unsigned _sp = 0; while (cond) { __builtin_amdgcn_s_sleep(1); \
    if ((++_sp & 255u) == 0u) { if (xb_ld(&(bar)[XB_TMO])) break; if (_sp > XB_SPIN_CAP) { atomicAdd(&(bar)[XB_TMO], 1u); break; } } } } while (0)
struct XcdBarrier { unsigned* bar; unsigned x; volatile LAS unsigned* st; };
__device__ __forceinline__ XcdBarrier xcd_barrier_post(int wv, unsigned* bar, volatile LAS unsigned* st) {
    XcdBarrier b; b.bar = bar; b.x = xb_xcc_id(); b.st = st;
    if (ltid(wv) == 0) (void)xb_add(&bar[XB_XCNT(b.x)], 1u);
    return b;
}
__device__ __forceinline__ void xcd_barrier_complete(unsigned* bar, unsigned x, unsigned& nloc, unsigned& nx) {
    const unsigned G = gridDim.x * gridDim.y * gridDim.z;
    unsigned sum, cnt, mine, sp = 0u;
    for (;;) {
        sum = 0u; cnt = 0u; mine = 0u;
#pragma unroll
        for (unsigned j = 0; j < 16; ++j) { const unsigned c = xb_ld(&bar[XB_XCNT(j)]); sum += c; cnt += (c > 0u) ? 1u : 0u; mine = (j == x) ? c : mine; }
        if (sum == G) break;
        __builtin_amdgcn_s_sleep(1);
        if ((++sp & 255u) == 0u) { if (xb_ld(&bar[XB_TMO])) break; if (sp > XB_SPIN_CAP) { atomicAdd(&bar[XB_TMO], 1u); break; } }
    }
    nloc = mine > 0u ? mine : 1u; nx = cnt > 0u ? cnt : 1u;
}
__device__ __forceinline__ void xcd_barrier(int wv, const XcdBarrier& b) {
    asm volatile("s_waitcnt vmcnt(0)" ::: "memory");
    __syncthreads();
    if (ltid(wv) == 0) {
        unsigned* bar = b.bar;
        asm volatile("" : "+s"(bar));
        __builtin_amdgcn_s_waitcnt(0);
        unsigned nloc = b.st[0], nx = b.st[1];
        if (nloc == 0u) { xcd_barrier_complete(bar, b.x, nloc, nx); b.st[0] = nloc; b.st[1] = nx; }
        const unsigned old = xb_add(&bar[XB_XSUB(b.x)], 1u);
        const unsigned gen = old / nloc;
        if (old + 1u == (gen + 1u) * nloc) {
            __builtin_amdgcn_fence(__ATOMIC_RELEASE, "agent");
            asm volatile("s_waitcnt vmcnt(0)" ::: "memory");
            const unsigned og = xb_add(&bar[XB_TOP], 1u);
            const unsigned tg = og / nx;
            if (og + 1u == (tg + 1u) * nx) xb_add(&bar[XB_TOPGEN], 1u);
            else XB_SPIN(xb_ld(&bar[XB_TOPGEN]) == tg, bar);
            __builtin_amdgcn_fence(__ATOMIC_ACQUIRE, "agent");
            xb_add(&bar[XB_XGEN(b.x)], 1u);
            asm volatile("s_waitcnt vmcnt(0)" ::: "memory");
        } else {
            XB_SPIN(xb_ld(&bar[XB_XGEN(b.x)]) == gen, bar);
            __builtin_amdgcn_fence(__ATOMIC_ACQUIRE, "agent");
            asm volatile("s_waitcnt vmcnt(0)" ::: "memory");
        }
    }
    __syncthreads();
}

__device__ __forceinline__ int row_mod(int r) { return r < NCTX ? 4 : ((r - NCTX) >> 13); }
__device__ __forceinline__ void row_seg(int r, int& t, int& len) { if (r < NCTX) { t = r & 255; len = CTXL; } else { t = (r - NCTX) & 8191; len = SEQ; } }
__device__ __forceinline__ int scan_row(int tg, int b, int dir, int odd) {
    if (tg < CTXL) { const int t = dir ? (CTXL - 1 - tg) : tg; return b * CTXL + t; }
    int sg = tg - CTXL; if (dir) sg = SEQ - 1 - sg;
    const int s = odd ? (((sg & 127) << 6) + (sg >> 7)) : sg;
    return NCTX + b * SEQ + s;
}
__device__ __forceinline__ const float* modvec(const unsigned char* ws, int layer, int m, int which) {
    return (const float*)(ws + WS_MODV) + ((size_t)(layer * 5 + m) * 6 + which) * D;
}

constexpr int G_BM = 256, G_BN = 128, G_BK = 64;
constexpr int G_ABYTES = G_BM * G_BK * 2, G_BBYTES = G_BN * G_BK * 2, G_BUF = G_ABYTES + G_BBYTES;
__device__ __forceinline__ int swz(int o) { return o ^ (((o >> 9) & 1) << 5); }

template <class RowSrc, class Epi>
__device__ __forceinline__ void gemm_tile(int wv, const bf16_t* __restrict__ A, int lda, const RowSrc& rs, const bf16_t* __restrict__ Bt, int ldb, int n0, int K, const Epi& epi, LAS char* lds) {
    const int tid = ltid(wv), lane = tid & 63, wid = tid >> 6, wm = wid >> 1, wn = wid & 1;
    const bf16_t* ap[4]; int aoff[4];
#pragma unroll
    for (int i = 0; i < 4; ++i) {
        const int c = tid + NT * i, row = c >> 3, kc = c & 7;
        ap[i] = A + (size_t)rs.src(row) * lda + kc * 8;
        aoff[i] = ((row >> 4) * 2 + (kc >> 2)) * 1024 + swz((row & 15) * 64 + (kc & 3) * 16);
    }
    const bf16_t* bp[2]; int boff[2];
#pragma unroll
    for (int i = 0; i < 2; ++i) {
        const int c = tid + NT * i, row = c >> 3, kc = c & 7;
        const int rho = row & 31, prow = (row & ~31) + 8 * ((rho & 15) >> 2) + 4 * (rho >> 4) + (rho & 3);
        bp[i] = Bt + (size_t)(n0 + prow) * ldb + kc * 8;
        boff[i] = G_ABYTES + ((row >> 4) * 2 + (kc >> 2)) * 1024 + swz((row & 15) * 64 + (kc & 3) * 16);
    }
    f32x4 acc[4][4];
#pragma unroll
    for (int i = 0; i < 4; ++i)
#pragma unroll
        for (int j = 0; j < 4; ++j) acc[i][j] = (f32x4){0.f, 0.f, 0.f, 0.f};
    u32x4 ra[2][4], rb[2][2];
    const int KT = K / G_BK;
    const int fragoff = swz((lane & 15) * 64 + (lane >> 4) * 16);
#define G_LOAD(set, kt_) do { _Pragma("unroll") for (int i = 0; i < 4; ++i) ra[set][i] = *(const u32x4*)(ap[i] + (kt_) * G_BK); \
                              _Pragma("unroll") for (int i = 0; i < 2; ++i) rb[set][i] = *(const u32x4*)(bp[i] + (kt_) * G_BK); } while (0)
#define G_STORE(set, buf) do { _Pragma("unroll") for (int i = 0; i < 4; ++i) *(LAS u32x4*)((buf) + aoff[i]) = ra[set][i]; \
                               _Pragma("unroll") for (int i = 0; i < 2; ++i) *(LAS u32x4*)((buf) + boff[i]) = rb[set][i]; } while (0)
#define G_COMPUTE(cur) do { bf16x8 af[2][4], bfr[2][4]; \
        _Pragma("unroll") for (int ks = 0; ks < 2; ++ks) { \
            _Pragma("unroll") for (int ni = 0; ni < 4; ++ni) bfr[ks][ni] = *(LAS bf16x8*)((cur) + G_ABYTES + ((wn * 4 + ni) * 2 + ks) * 1024 + fragoff); \
            _Pragma("unroll") for (int mi = 0; mi < 4; ++mi) af[ks][mi] = *(LAS bf16x8*)((cur) + ((wm * 4 + mi) * 2 + ks) * 1024 + fragoff); } \
        __builtin_amdgcn_sched_barrier(0); \
        _Pragma("unroll") for (int ks = 0; ks < 2; ++ks) _Pragma("unroll") for (int mi = 0; mi < 4; ++mi) _Pragma("unroll") for (int ni = 0; ni < 4; ++ni) \
            acc[mi][ni] = __builtin_amdgcn_mfma_f32_16x16x32_bf16(bfr[ks][ni], af[ks][mi], acc[mi][ni], 0, 0, 0); \
        __builtin_amdgcn_sched_barrier(0); } while (0)
    G_LOAD(0, 0);
    G_STORE(0, lds);
    if (KT > 1) G_LOAD(0, 1);
    if (KT > 2) G_LOAD(1, 2);
    __syncthreads();
    for (int kt = 0; kt < KT; kt += 2) {
        G_COMPUTE(lds);
        if (kt + 1 < KT) G_STORE(0, lds + G_BUF);
        if (kt + 3 < KT) G_LOAD(0, kt + 3);
        __syncthreads();
        if (kt + 1 < KT) {
            G_COMPUTE(lds + G_BUF);
            if (kt + 2 < KT) G_STORE(1, lds);
            if (kt + 4 < KT) G_LOAD(1, kt + 4);
            __syncthreads();
        }
    }
#undef G_LOAD
#undef G_STORE
#undef G_COMPUTE
    epi(acc, wm * 64 + (lane & 15), wn * 64 + 8 * (lane >> 4));
}

constexpr int G2_BN = 256, G2_BBYTES = G2_BN * G_BK * 2, G2_BUF = G_ABYTES + G2_BBYTES;

struct RowLinear { int m0; __device__ __forceinline__ int src(int r) const { return m0 + r; } };
struct EpiStoreBf16 {
    bf16_t* C; int ldc; int m0; int n0; int N;
    template <int NI> __device__ __forceinline__ void operator()(const f32x4 (&acc)[4][NI], int rbase, int cbase) const {
#pragma unroll
        for (int mi = 0; mi < 4; ++mi) {
            bf16_t* rowp = C + (size_t)(m0 + rbase + mi * 16) * ldc + n0 + cbase;
#pragma unroll
            for (int g = 0; g < NI / 2; ++g) {
                const f32x4 v0 = acc[mi][2 * g], v1 = acc[mi][2 * g + 1];
                u32x4 v; v.x = pk2(v0[0], v0[1]); v.y = pk2(v0[2], v0[3]); v.z = pk2(v1[0], v1[1]); v.w = pk2(v1[2], v1[3]);
                *(u32x4*)(rowp + 32 * g) = v;
            }
        }
    }
};
struct EpiDecay {
    bf16_t* Dc; const float* w0; int m0; int n0;
    template <int NI> __device__ __forceinline__ void operator()(const f32x4 (&acc)[4][NI], int rbase, int cbase) const {
#pragma unroll
        for (int g = 0; g < NI / 2; ++g) {
            const int col = n0 + cbase + 32 * g;
            const f32x4 wa = *(const f32x4*)(w0 + col), wb = *(const f32x4*)(w0 + col + 4);
#pragma unroll
            for (int mi = 0; mi < 4; ++mi) {
                float o[8];
#pragma unroll
                for (int j = 0; j < 4; ++j) { o[j] = __expf(-softplus_fast(-(wa[j] + acc[mi][2 * g][j])) - 0.5f); o[4 + j] = __expf(-softplus_fast(-(wb[j] + acc[mi][2 * g + 1][j])) - 0.5f); }
                *(u32x4*)(Dc + (size_t)(m0 + rbase + mi * 16) * 512 + col) = pack8(o);
            }
        }
    }
};
struct EpiAK {
    bf16_t* Kb; const bf16_t* KKb; bf16_t* Bb; const float* a0; const float* k_a; int m0; int n0;
    template <int NI> __device__ __forceinline__ void operator()(const f32x4 (&acc)[4][NI], int rbase, int cbase) const {
#pragma unroll
        for (int g = 0; g < NI / 2; ++g) {
            const int col = n0 + cbase + 32 * g;
            const f32x4 a0a = *(const f32x4*)(a0 + col), a0b = *(const f32x4*)(a0 + col + 4), kaa = *(const f32x4*)(k_a + col), kab = *(const f32x4*)(k_a + col + 4);
            u32x4 kr[4], kkr[4];
#pragma unroll
            for (int mi = 0; mi < 4; ++mi) { const size_t off = (size_t)(m0 + rbase + mi * 16) * 512 + col; kr[mi] = *(const u32x4*)(Kb + off); kkr[mi] = *(const u32x4*)(KKb + off); }
#pragma unroll
            for (int mi = 0; mi < 4; ++mi) {
                const size_t off = (size_t)(m0 + rbase + mi * 16) * 512 + col;
                float kf[8], kkf[8], k2[8], bb[8];
                unpack8(kr[mi], kf); unpack8(kkr[mi], kkf);
#pragma unroll
                for (int j = 0; j < 4; ++j) {
                    const float aa = sigmoidf_(a0a[j] + acc[mi][2 * g][j]), ab = sigmoidf_(a0b[j] + acc[mi][2 * g + 1][j]);
                    k2[j] = kf[j] * (1.f + (aa - 1.f) * kaa[j]); bb[j] = kkf[j] * aa;
                    k2[4 + j] = kf[4 + j] * (1.f + (ab - 1.f) * kab[j]); bb[4 + j] = kkf[4 + j] * ab;
                }
                *(u32x4*)(Kb + off) = pack8(k2);
                *(u32x4*)(Bb + off) = pack8(bb);
            }
        }
    }
};
namespace pg8 {
#define PG8_LAS __attribute__((address_space(3)))
constexpr int BM = 256, BK = 64, HALF = 128, HTB = HALF * BK * 2, STAGE_BYTES = 8 * HTB, NXCD = 8, WGM = 8;
__host__ __device__ __forceinline__ int lds_byte(int r, int c) { const int st = (r >> 4) * 2 + (c >> 5), rr = r & 15, cc = c & 31, ob = rr * 64 + cc * 2; return st * 1024 + (ob ^ (((ob >> 9) & 1) << 5)); }
__host__ __device__ __forceinline__ void stage_rc(int b, int& R, int& C) { const int st = b / 1024, sb = b % 1024, swz = sb ^ (((sb >> 9) & 1) << 5); R = (st >> 1) * 16 + swz / 64; C = (st & 1) * 32 + (swz % 64) / 2; }
__host__ __device__ __forceinline__ int perm32(int rho) { const int n = rho >> 4, i = rho & 15; return 8 * (i >> 2) + 4 * n + (i & 3); }
struct Unit { int pm, pn; };
struct Gemm { const bf16_t* A; const bf16_t* Bt; int M, N, K; };
struct StaticOrder {
    int nM, nN, nwg, G, c;
    __host__ __device__ void init(int M, int N, int G_, int c_) { nM = M / BM; nN = N / BM; nwg = nM * nN; G = G_; c = c_; }
    __host__ __device__ bool next(int i, Unit& u) const {
        const long L = (long)i * G + c; if (L >= nwg) return false;
        int wgid = (int)L; { const int q = nwg / NXCD, r = nwg % NXCD, xcd = wgid % NXCD, off = wgid / NXCD; wgid = (xcd < r ? xcd * (q + 1) : r * (q + 1) + (xcd - r) * q) + off; }
        const int nig = WGM * nN, gid = wgid / nig, fm = gid * WGM, gsz = (nM - fm) < WGM ? (nM - fm) : WGM;
        u.pm = fm + ((wgid % nig) % gsz); u.pn = (wgid % nig) / gsz; return true;
    }
    __device__ __forceinline__ void a_ready(const Unit&) const {}
    __device__ __forceinline__ void done(const Unit&) const {}
};
struct EpiStoreP {
    static constexpr bool PERM = true, AFTER_DRAIN = false;
    bf16_t* O; int ldc;
    __device__ __forceinline__ void operator()(const f32x4 (&acc)[2][2][4][2], const Unit& u, int wr, int wc, int fr, int fq) const {
        const int row0 = u.pm * BM + wr * 64 + fr, col0 = u.pn * BM + wc * 32 + 8 * fq;
#pragma unroll
        for (int ai = 0; ai < 2; ++ai)
#pragma unroll
            for (int m = 0; m < 4; ++m) { bf16_t* rowp = O + (size_t)(row0 + ai * HALF + m * 16) * ldc + col0;
#pragma unroll
                for (int bj = 0; bj < 2; ++bj) { const f32x4 v0 = acc[ai][bj][m][0], v1 = acc[ai][bj][m][1];
                    u32x4 w; w.x = pk2(v0[0], v0[1]); w.y = pk2(v0[2], v0[3]); w.z = pk2(v1[0], v1[1]); w.w = pk2(v1[2], v1[3]);
                    *(u32x4*)(rowp + bj * HALF) = w; } }
    }
};
template <class Epi, class Sched>
__device__ __forceinline__ void gemm_phase(int wv, PG8_LAS unsigned char* lds, const Gemm g, const Sched& S, const Epi& E) {
    const int tid = ltid(wv), wid = __builtin_amdgcn_readfirstlane(tid >> 6), lane = tid & 63, wr = wid >> 2, wc = wid & 3, fr = lane & 15, fq = lane >> 4;
    const int K = g.K, nt = K / BK;
    unsigned voffA[2], voffB[2];
#pragma unroll
    for (int i = 0; i < 2; ++i) { int R, C; stage_rc(tid * 16 + i * 8192, R, C); const int Rb = Epi::PERM ? ((R & ~31) + perm32(R & 31)) : R;
        voffA[i] = (unsigned)(R * K + C) * 2u; voffB[i] = (unsigned)(Rb * K + C) * 2u; }
    const size_t kstep = (size_t)(BK * 2);
    const size_t hstep = (size_t)HALF * K * 2;
    const size_t tstep = 2 * hstep;
    const unsigned ldsw = (unsigned)wid * 1024u;
    const int aoff = lds_byte(wr * 64 + fr, fq * 8), boff = lds_byte(wc * 32 + fr, fq * 8);
#define PG8_SA(b, h) (((b) * 2 + (h)) * HTB)
#define PG8_SB(b, h) ((4 + (b) * 2 + (h)) * HTB)
#define PG8_STAGE(bufoff, gbase, voff) do { _Pragma("unroll") for (int _i = 0; _i < 2; ++_i) \
        __builtin_amdgcn_global_load_lds((const unsigned*)((const char*)(gbase) + (voff)[_i]), (PG8_LAS unsigned*)(lds + (bufoff) + ldsw + _i * 8192), 16, 0, 0); } while (0)
#define PG8_LDA(dst, b, h) do { _Pragma("unroll") for (int m = 0; m < 4; ++m) _Pragma("unroll") for (int k = 0; k < 2; ++k) dst[m][k] = *(const PG8_LAS bf16x8*)(lds + PG8_SA(b, h) + aoff + m * 2048 + k * 1024); } while (0)
#define PG8_LDB(dst, b, h) do { _Pragma("unroll") for (int n = 0; n < 2; ++n) _Pragma("unroll") for (int k = 0; k < 2; ++k) dst[n][k] = *(const PG8_LAS bf16x8*)(lds + PG8_SB(b, h) + boff + n * 2048 + k * 1024); } while (0)
#define PG8_MMA(ai, bj, At, Bt) do { __builtin_amdgcn_s_setprio(1); _Pragma("unroll") for (int m = 0; m < 4; ++m) _Pragma("unroll") for (int n = 0; n < 2; ++n) _Pragma("unroll") for (int k = 0; k < 2; ++k) \
        acc[ai][bj][m][n] = __builtin_amdgcn_mfma_f32_16x16x32_bf16(Bt[n][k], At[m][k], acc[ai][bj][m][n], 0, 0, 0); __builtin_amdgcn_s_setprio(0); } while (0)
#define PG8_WAIT_V(n) asm volatile("s_waitcnt vmcnt(" #n ")" ::: "memory")
#define PG8_WAIT_L(n) asm volatile("s_waitcnt lgkmcnt(" #n ")" ::: "memory")
#define PG8_BAR __builtin_amdgcn_s_barrier()
#define PG8_SCHED __builtin_amdgcn_sched_barrier(0)
    Unit cur, nxt; int ui = 0;
    if (!S.next(0, cur)) return;
    f32x4 acc[2][2][4][2];
#pragma unroll
    for (int a = 0; a < 2; ++a)
#pragma unroll
        for (int b = 0; b < 2; ++b)
#pragma unroll
            for (int m = 0; m < 4; ++m)
#pragma unroll
                for (int n = 0; n < 2; ++n) acc[a][b][m][n] = (f32x4){0.f, 0.f, 0.f, 0.f};
    bf16x8 At[4][2], B0[2][2], B1[2][2];
    const char* cA = (const char*)g.A + (size_t)cur.pm * tstep; const char* cB = (const char*)g.Bt + (size_t)cur.pn * tstep;
    S.a_ready(cur);
    PG8_STAGE(PG8_SB(0, 0), cB, voffB); PG8_STAGE(PG8_SA(0, 0), cA, voffA); PG8_STAGE(PG8_SB(0, 1), cB + hstep, voffB); PG8_STAGE(PG8_SA(0, 1), cA + hstep, voffA);
    if (wr == 1) PG8_BAR;
    PG8_WAIT_V(4); PG8_BAR;
    PG8_STAGE(PG8_SB(1, 0), cB + kstep, voffB); PG8_STAGE(PG8_SA(1, 0), cA + kstep, voffA); PG8_STAGE(PG8_SB(1, 1), cB + hstep + kstep, voffB);
    PG8_WAIT_V(6); PG8_BAR;
    for (;;) {
        const bool has_next = S.next(ui + 1, nxt);
        const char* nA = has_next ? (const char*)g.A + (size_t)nxt.pm * tstep : cA; const char* nB = has_next ? (const char*)g.Bt + (size_t)nxt.pn * tstep : cB;
        for (int t = 0; t < nt; t += 2) {
            const bool last = (t == nt - 2);
            const char* a1 = cA + (size_t)(t + 1) * kstep;
            const char* a2 = last ? nA : cA + (size_t)(t + 2) * kstep; const char* b2 = last ? nB : cB + (size_t)(t + 2) * kstep;
            const char* a3 = a2 + kstep; const char* b3 = b2 + kstep;
            if (last && has_next) S.a_ready(nxt);
            PG8_LDB(B0, 0, 0); PG8_SCHED; PG8_LDA(At, 0, 0); PG8_STAGE(PG8_SA(1, 1), a1 + hstep, voffA);
            PG8_WAIT_L(8); PG8_BAR; PG8_WAIT_L(0); PG8_MMA(0, 0, At, B0); PG8_BAR; PG8_SCHED;
            PG8_LDB(B1, 0, 1); PG8_STAGE(PG8_SB(0, 0), b2, voffB);
            PG8_BAR; PG8_WAIT_L(0); PG8_MMA(0, 1, At, B1); PG8_BAR;
            PG8_LDA(At, 0, 1); PG8_STAGE(PG8_SA(0, 0), a2, voffA);
            PG8_BAR; PG8_WAIT_L(0); PG8_MMA(1, 0, At, B0); PG8_BAR; PG8_SCHED;
            PG8_STAGE(PG8_SB(0, 1), b2 + hstep, voffB);
            PG8_WAIT_V(6); PG8_BAR; PG8_MMA(1, 1, At, B1); PG8_BAR;
            PG8_LDB(B0, 1, 0); PG8_SCHED; PG8_LDA(At, 1, 0); PG8_STAGE(PG8_SA(0, 1), a2 + hstep, voffA);
            PG8_WAIT_L(8); PG8_BAR; PG8_WAIT_L(0); PG8_MMA(0, 0, At, B0); PG8_BAR; PG8_SCHED;
            PG8_LDB(B1, 1, 1); PG8_STAGE(PG8_SB(1, 0), b3, voffB);
            PG8_BAR; PG8_WAIT_L(0); PG8_MMA(0, 1, At, B1); PG8_BAR;
            PG8_LDA(At, 1, 1); PG8_STAGE(PG8_SA(1, 0), a3, voffA);
            PG8_BAR; PG8_WAIT_L(0); PG8_MMA(1, 0, At, B0); PG8_BAR; PG8_SCHED;
            PG8_STAGE(PG8_SB(1, 1), b3 + hstep, voffB);
            PG8_WAIT_V(6); PG8_BAR; PG8_MMA(1, 1, At, B1); PG8_BAR;
        }
            if constexpr (!Epi::AFTER_DRAIN) { E(acc, cur, wr, wc, fr, fq); S.done(cur); }
            if (!has_next) break;
#pragma unroll
        for (int a = 0; a < 2; ++a)
#pragma unroll
            for (int b = 0; b < 2; ++b)
#pragma unroll
                for (int m = 0; m < 4; ++m)
#pragma unroll
                    for (int n = 0; n < 2; ++n) acc[a][b][m][n] = (f32x4){0.f, 0.f, 0.f, 0.f};
        cur = nxt; cA = nA; cB = nB; ++ui;
    }
    PG8_WAIT_V(0);
    if (wr == 0) PG8_BAR;
    PG8_BAR;
    if constexpr (Epi::AFTER_DRAIN) { E.fused(acc, cur, wr, wc, fr, fq, lds, wid, lane); S.done(cur); }
#undef PG8_SA
#undef PG8_SB
#undef PG8_STAGE
#undef PG8_LDA
#undef PG8_LDB
#undef PG8_MMA
#undef PG8_WAIT_V
#undef PG8_WAIT_L
#undef PG8_BAR
#undef PG8_SCHED
}
struct UnitG { int pm, pn; const char* bbase; const PG8_LAS int* ltab; int cnt; int e; };
struct MoeOrder {
    const PG8_LAS int* tstart; const PG8_LAS int* tcnt; const PG8_LAS int* ltabs; const int* lists; const char* bt; size_t estride; int ncol, shift, G, c;
    __device__ __forceinline__ bool next(int i, UnitG& u) const {
        const int t = i * G + c; if (t >= tstart[32] * ncol) return false;
        const int tm = t / ncol; int e = 0;
#pragma unroll 1
        while (tstart[e + 1] <= tm) ++e;
        e = __builtin_amdgcn_readfirstlane(e);
        const int ts = __builtin_amdgcn_readfirstlane(tstart[e]), tc = __builtin_amdgcn_readfirstlane(tcnt[e]);
        u.pm = tm - ts; u.pn = t - tm * ncol; u.bbase = bt + (size_t)e * estride; u.e = e; u.cnt = tc - u.pm * BM; u.ltab = ltabs + i * BM;
        return true;
    }
    __device__ __forceinline__ void a_ready(const UnitG&) const {}
    __device__ __forceinline__ void done(const UnitG&) const {}
};
struct EpiSwiGLUG {
    static constexpr bool PERM = false, AFTER_DRAIN = false;
    bf16_t* H;
    __device__ __forceinline__ void operator()(const f32x4 (&acc)[2][2][4][2], const UnitG& u, int wr, int wc, int fr, int fq) const {
#pragma unroll
        for (int ai = 0; ai < 2; ++ai)
#pragma unroll
            for (int m = 0; m < 4; ++m) { const int r = ai * HALF + wr * 64 + m * 16 + fr;
                if (r < u.cnt) { bf16_t* rowp = H + (size_t)u.ltab[r] * DEXP + ((u.pn * BM + wc * 32) >> 1) + 4 * fq;
#pragma unroll
                    for (int bj = 0; bj < 2; ++bj) { const f32x4 gt = acc[ai][bj][m][0], up = acc[ai][bj][m][1];
                        u32x2 w; w.x = pk2(siluf_(gt[0]) * up[0], siluf_(gt[1]) * up[1]); w.y = pk2(siluf_(gt[2]) * up[2], siluf_(gt[3]) * up[3]);
                        *(u32x2*)(rowp + bj * (HALF / 2)) = w; } } }
    }
};
struct EpiScatterG {
    static constexpr bool PERM = true, AFTER_DRAIN = false;
    bf16_t* O;
    __device__ __forceinline__ void operator()(const f32x4 (&acc)[2][2][4][2], const UnitG& u, int wr, int wc, int fr, int fq) const {
#pragma unroll
        for (int ai = 0; ai < 2; ++ai)
#pragma unroll
            for (int m = 0; m < 4; ++m) { const int r = ai * HALF + wr * 64 + m * 16 + fr;
                if (r < u.cnt) { bf16_t* rowp = O + (size_t)u.ltab[r] * D + u.pn * BM + wc * 32 + 8 * fq;
#pragma unroll
                    for (int bj = 0; bj < 2; ++bj) { const f32x4 v0 = acc[ai][bj][m][0], v1 = acc[ai][bj][m][1];
                        u32x4 w; w.x = pk2(v0[0], v0[1]); w.y = pk2(v0[2], v0[3]); w.z = pk2(v1[0], v1[1]); w.w = pk2(v1[2], v1[3]);
                        *(u32x4*)(rowp + bj * HALF) = w; } } }
    }
};
template <class Epi, class Sched>
__device__ __forceinline__ void gemm_phase_g(int wv, PG8_LAS unsigned char* lds, const Gemm g, const Sched& S, const Epi& E) {
    const int tid = ltid(wv), wid = __builtin_amdgcn_readfirstlane(tid >> 6), lane = tid & 63, wr = wid >> 2, wc = wid & 3, fr = lane & 15, fq = lane >> 4;
    const int K = g.K, nt = K / BK;
    unsigned voffB[2];
#pragma unroll
    for (int i = 0; i < 2; ++i) { int R, C; stage_rc(tid * 16 + i * 8192, R, C); const int Rb = Epi::PERM ? ((R & ~31) + perm32(R & 31)) : R;
        voffB[i] = (unsigned)(Rb * K + C) * 2u; }
    const unsigned rowb = (unsigned)K * 2u;
#define PG8_AOFFS(u, dst) do { const int _t = ltid(wv); _Pragma("unroll") for (int _i = 0; _i < 2; ++_i) { int _R, _C; stage_rc(_t * 16 + _i * 8192, _R, _C); \
        _Pragma("unroll") for (int _h = 0; _h < 2; ++_h) dst[_h][_i] = (unsigned)((u).ltab[_h * HALF + _R] >> S.shift) * rowb + (unsigned)(_C * 2); } } while (0)
#define PG8_STAGE_A(bufoff, AO, koff) do { _Pragma("unroll") for (int _i = 0; _i < 2; ++_i) \
        __builtin_amdgcn_global_load_lds((const unsigned*)((const char*)g.A + (size_t)(AO)[_i] + (size_t)(koff)), (PG8_LAS unsigned*)(lds + (bufoff) + ldsw + _i * 8192), 16, 0, 0); } while (0)
    const size_t kstep = (size_t)(BK * 2);
    const size_t hstep = (size_t)HALF * K * 2;
    const size_t tstep = 2 * hstep;
    const unsigned ldsw = (unsigned)wid * 1024u;
    const int aoff = lds_byte(wr * 64 + fr, fq * 8), boff = lds_byte(wc * 32 + fr, fq * 8);
#define PG8_SA(b, h) (((b) * 2 + (h)) * HTB)
#define PG8_SB(b, h) ((4 + (b) * 2 + (h)) * HTB)
#define PG8_STAGE(bufoff, gbase, voff) do { _Pragma("unroll") for (int _i = 0; _i < 2; ++_i) \
        __builtin_amdgcn_global_load_lds((const unsigned*)((const char*)(gbase) + (voff)[_i]), (PG8_LAS unsigned*)(lds + (bufoff) + ldsw + _i * 8192), 16, 0, 0); } while (0)
#define PG8_LDA(dst, b, h) do { _Pragma("unroll") for (int m = 0; m < 4; ++m) _Pragma("unroll") for (int k = 0; k < 2; ++k) dst[m][k] = *(const PG8_LAS bf16x8*)(lds + PG8_SA(b, h) + aoff + m * 2048 + k * 1024); } while (0)
#define PG8_LDB(dst, b, h) do { _Pragma("unroll") for (int n = 0; n < 2; ++n) _Pragma("unroll") for (int k = 0; k < 2; ++k) dst[n][k] = *(const PG8_LAS bf16x8*)(lds + PG8_SB(b, h) + boff + n * 2048 + k * 1024); } while (0)
#define PG8_MMA(ai, bj, At, Bt) do { __builtin_amdgcn_s_setprio(1); _Pragma("unroll") for (int m = 0; m < 4; ++m) _Pragma("unroll") for (int n = 0; n < 2; ++n) _Pragma("unroll") for (int k = 0; k < 2; ++k) \
        acc[ai][bj][m][n] = __builtin_amdgcn_mfma_f32_16x16x32_bf16(Bt[n][k], At[m][k], acc[ai][bj][m][n], 0, 0, 0); __builtin_amdgcn_s_setprio(0); } while (0)
#define PG8_WAIT_V(n) asm volatile("s_waitcnt vmcnt(" #n ")" ::: "memory")
#define PG8_WAIT_L(n) asm volatile("s_waitcnt lgkmcnt(" #n ")" ::: "memory")
#define PG8_BAR __builtin_amdgcn_s_barrier()
#define PG8_SCHED __builtin_amdgcn_sched_barrier(0)
    UnitG cur, nxt; int ui = 0;
    if (!S.next(0, cur)) return;
    f32x4 acc[2][2][4][2];
#pragma unroll
    for (int a = 0; a < 2; ++a)
#pragma unroll
        for (int b = 0; b < 2; ++b)
#pragma unroll
            for (int m = 0; m < 4; ++m)
#pragma unroll
                for (int n = 0; n < 2; ++n) acc[a][b][m][n] = (f32x4){0.f, 0.f, 0.f, 0.f};
    bf16x8 At[4][2], B0[2][2], B1[2][2];
    unsigned ca[2][2]; PG8_AOFFS(cur, ca); const char* cB = cur.bbase + (size_t)cur.pn * tstep;
    S.a_ready(cur);
    PG8_STAGE(PG8_SB(0, 0), cB, voffB); PG8_STAGE_A(PG8_SA(0, 0), ca[0], 0); PG8_STAGE(PG8_SB(0, 1), cB + hstep, voffB); PG8_STAGE_A(PG8_SA(0, 1), ca[1], 0);
    if (wr == 1) PG8_BAR;
    PG8_WAIT_V(4); PG8_BAR;
    PG8_STAGE(PG8_SB(1, 0), cB + kstep, voffB); PG8_STAGE_A(PG8_SA(1, 0), ca[0], kstep); PG8_STAGE(PG8_SB(1, 1), cB + hstep + kstep, voffB);
    PG8_WAIT_V(6); PG8_BAR;
    for (;;) {
        const bool has_next = S.next(ui + 1, nxt);
        const char* nB = has_next ? nxt.bbase + (size_t)nxt.pn * tstep : cB;
        for (int t = 0; t < nt; t += 2) {
            const bool last = (t == nt - 2);
            const size_t k1 = (size_t)(t + 1) * kstep, k2 = last ? 0 : (size_t)(t + 2) * kstep;
            unsigned a2o[2][2];
            if (last && has_next) PG8_AOFFS(nxt, a2o); else { a2o[0][0] = ca[0][0]; a2o[0][1] = ca[0][1]; a2o[1][0] = ca[1][0]; a2o[1][1] = ca[1][1]; }
            const char* b2 = last ? nB : cB + (size_t)(t + 2) * kstep; const char* b3 = b2 + kstep;
            if (last && has_next) S.a_ready(nxt);
            PG8_LDB(B0, 0, 0); PG8_SCHED; PG8_LDA(At, 0, 0); PG8_STAGE_A(PG8_SA(1, 1), ca[1], k1);
            PG8_WAIT_L(8); PG8_BAR; PG8_WAIT_L(0); PG8_MMA(0, 0, At, B0); PG8_BAR; PG8_SCHED;
            PG8_LDB(B1, 0, 1); PG8_STAGE(PG8_SB(0, 0), b2, voffB);
            PG8_BAR; PG8_WAIT_L(0); PG8_MMA(0, 1, At, B1); PG8_BAR;
            PG8_LDA(At, 0, 1); PG8_STAGE_A(PG8_SA(0, 0), a2o[0], k2);
            PG8_BAR; PG8_WAIT_L(0); PG8_MMA(1, 0, At, B0); PG8_BAR; PG8_SCHED;
            PG8_STAGE(PG8_SB(0, 1), b2 + hstep, voffB);
            PG8_WAIT_V(6); PG8_BAR; PG8_MMA(1, 1, At, B1); PG8_BAR;
            PG8_LDB(B0, 1, 0); PG8_SCHED; PG8_LDA(At, 1, 0); PG8_STAGE_A(PG8_SA(0, 1), a2o[1], k2);
            PG8_WAIT_L(8); PG8_BAR; PG8_WAIT_L(0); PG8_MMA(0, 0, At, B0); PG8_BAR; PG8_SCHED;
            PG8_LDB(B1, 1, 1); PG8_STAGE(PG8_SB(1, 0), b3, voffB);
            PG8_BAR; PG8_WAIT_L(0); PG8_MMA(0, 1, At, B1); PG8_BAR;
            PG8_LDA(At, 1, 1); PG8_STAGE_A(PG8_SA(1, 0), a2o[0], k2 + kstep);
            PG8_BAR; PG8_WAIT_L(0); PG8_MMA(1, 0, At, B0); PG8_BAR; PG8_SCHED;
            PG8_STAGE(PG8_SB(1, 1), b3 + hstep, voffB);
            PG8_WAIT_V(6); PG8_BAR; PG8_MMA(1, 1, At, B1); PG8_BAR;
            if (last) { ca[0][0] = a2o[0][0]; ca[0][1] = a2o[0][1]; ca[1][0] = a2o[1][0]; ca[1][1] = a2o[1][1]; }
        }
            if constexpr (!Epi::AFTER_DRAIN) { E(acc, cur, wr, wc, fr, fq); S.done(cur); }
            if (!has_next) break;
#pragma unroll
        for (int a = 0; a < 2; ++a)
#pragma unroll
            for (int b = 0; b < 2; ++b)
#pragma unroll
                for (int m = 0; m < 4; ++m)
#pragma unroll
                    for (int n = 0; n < 2; ++n) acc[a][b][m][n] = (f32x4){0.f, 0.f, 0.f, 0.f};
        cur = nxt; cB = nB; ++ui;
    }
    PG8_WAIT_V(0);
    if (wr == 0) PG8_BAR;
    PG8_BAR;
    if constexpr (Epi::AFTER_DRAIN) { E.fused(acc, cur, wr, wc, fr, fq, lds, wid, lane); S.done(cur); }
#undef PG8_SA
#undef PG8_AOFFS
#undef PG8_STAGE_A
#undef PG8_SB
#undef PG8_STAGE
#undef PG8_LDA
#undef PG8_LDB
#undef PG8_MMA
#undef PG8_WAIT_V
#undef PG8_WAIT_L
#undef PG8_BAR
#undef PG8_SCHED
}
}

__device__ __forceinline__ void transpose_item(const float* __restrict__ W, int K, int N, bf16_t* __restrict__ WT, int mode, LAS float* scr, int item, int lane) {
    const int nblk = N / 32, kb = item / nblk, nb = item % nblk, k0 = 64 * kb, n0 = 32 * nb;
    {
        const float* wp = W + (size_t)(k0 + (lane >> 5)) * N + n0 + (lane & 31);
        float t[32];
#pragma unroll
        for (int i = 0; i < 32; ++i) t[i] = wp[(size_t)(2 * i) * N];
#pragma unroll
        for (int i = 0; i < 32; ++i) scr[(2 * i + (lane >> 5)) * 33 + (lane & 31)] = t[i];
    }
    asm volatile("s_waitcnt lgkmcnt(0)" ::: "memory");
    const int c = lane & 7;
#pragma unroll
    for (int j = 0; j < 4; ++j) {
        const int nl = (lane >> 3) + 8 * j; const LAS float* s = scr + (8 * c) * 33 + nl;
        u32x4 o; o.x = pk2(s[0 * 33], s[1 * 33]); o.y = pk2(s[2 * 33], s[3 * 33]); o.z = pk2(s[4 * 33], s[5 * 33]); o.w = pk2(s[6 * 33], s[7 * 33]);
        const int n = n0 + nl;
        const int nd = mode == 0 ? n : (32 * (n >> 4) + (n & 15) + (mode == 2 ? 16 : 0));
        *(u32x4*)(WT + (size_t)nd * K + k0 + 8 * c) = o;
    }
    asm volatile("s_waitcnt lgkmcnt(0)" ::: "memory");
}

constexpr int EXC_IG = 16 * 16, EXC_IDN = 8 * 32, EXC_PER = 2 * EXC_IG + EXC_IDN, EXC_ITEMS = NEXP * EXC_PER;
__device__ __forceinline__ int exc_s0(int layer) { return (layer & 1) ? 8192 : 10240; }
__device__ __forceinline__ int exc_s1(int layer) { return (layer & 1) ? 0 : 7168; }
__device__ __forceinline__ void expconv_items(const CAS Params& P, int layer, LAS char* lds, int lo, int hi, int worker, int nworkers, int wid, int lane) {
    LAS float* scr = (LAS float*)(lds + wid * 8448);
    bf16_t* gu = (bf16_t*)(P.ws + WS_EXPGU); bf16_t* dw = (bf16_t*)(P.ws + WS_EXPD);
    for (int it = lo + worker; it < hi; it += nworkers) {
        const int e = it / EXC_PER; int r = it % EXC_PER;
        const size_t eo = (size_t)(layer * NEXP + e);
        if (r < EXC_IG) { transpose_item(P.exp_w_gate + eo * D * DEXP, D, DEXP, gu + (size_t)e * 1024 * 1024, 1, scr, r, lane); continue; } r -= EXC_IG;
        if (r < EXC_IG) { transpose_item(P.exp_w_up + eo * D * DEXP, D, DEXP, gu + (size_t)e * 1024 * 1024, 2, scr, r, lane); continue; } r -= EXC_IG;
        transpose_item(P.exp_w_down + eo * DEXP * D, DEXP, D, dw + (size_t)e * 1024 * 512, 0, scr, r, lane);
    }
}
__device__ __forceinline__ void expconv_tail(int wv, const CAS Params& P, int layer, LAS char* lds, int nwg, int lo, int hi) {
    const int G = gridDim.x, rem = nwg % G;
    if (rem != 0 && (int)blockIdx.x >= rem && lo < hi) {
        const int tid = ltid(wv);
        __syncthreads();
        expconv_items(P, layer, lds, lo, hi, ((int)blockIdx.x - rem) * 8 + (tid >> 6), (G - rem) * 8, tid >> 6, tid & 63);
    }
}

__device__ __forceinline__ void phase_prologue0(int wv, KP Pk, LAS char* lds) {
    asm volatile("" : "+s"(Pk));
    const CAS Params& P = *Pk;
    const int tid = ltid(wv), lane = tid & 63, wid = tid >> 6;
    const int gw = blockIdx.x * 8 + wid, NGW = gridDim.x * 8;
    LAS float* scr = (LAS float*)(lds + wid * 8448);
    bf16_t* winT = (bf16_t*)(P.ws + WS_WINT);
    bf16_t* woutT = (bf16_t*)(P.ws + WS_WOUTT);
    bf16_t* loraT = (bf16_t*)(P.ws + WS_LORAT);
    constexpr int I_EV = 16 * (P_EVEN / 32), I_OD = 16 * (P_ODD / 32), I_O = 16 * 32, I_L64 = 16, I_L128 = 32;
    constexpr int I_LORA = 3 * I_L64 + I_L128;
    constexpr int NIT = 2 * I_EV + 2 * I_OD + 4 * I_O + 2 * I_LORA;
    for (int it = gw; it < NIT; it += NGW) {
        int r = it;
        if (r < 2 * I_EV) { const int i = r / I_EV; transpose_item(P.ev_w_in + (size_t)i * D * P_EVEN, D, P_EVEN, winT + (i ? WINT_L2 : WINT_L0), 0, scr, r % I_EV, lane); continue; } r -= 2 * I_EV;
        if (r < 2 * I_OD) { const int i = r / I_OD; transpose_item(P.od_w_in + (size_t)i * D * P_ODD, D, P_ODD, winT + (i ? WINT_L3 : WINT_L1), 0, scr, r % I_OD, lane); continue; } r -= 2 * I_OD;
        if (r < 4 * I_O) { const int l = r / I_O; const float* src = (l & 1) ? P.od_w_out + (size_t)(l >> 1) * D * D : P.ev_w_out + (size_t)(l >> 1) * D * D;
            transpose_item(src, D, D, woutT + (size_t)l * D * D, 0, scr, r % I_O, lane); continue; } r -= 4 * I_O;
        { const int i = r / I_LORA; int q = r % I_LORA; bf16_t* dst = loraT + (size_t)i * LORA_PER;
          if (q < I_L64) { transpose_item(P.rw_w2 + (size_t)(i * 2 + 0) * 64 * 512, 64, 512, dst, 0, scr, q, lane); continue; } q -= I_L64;
          if (q < I_L64) { transpose_item(P.rw_w2 + (size_t)(i * 2 + 1) * 64 * 512, 64, 512, dst + 512 * 64, 0, scr, q, lane); continue; } q -= I_L64;
          if (q < I_L64) { transpose_item(P.rw_a2 + (size_t)i * 64 * 512, 64, 512, dst + 2 * 512 * 64, 0, scr, q, lane); continue; } q -= I_L64;
          transpose_item(P.rw_g2 + (size_t)i * 128 * 512, 128, 512, dst + 3 * 512 * 64, 0, scr, q, lane); }
    }
    {
        const int gt = blockIdx.x * NT + tid, NG = gridDim.x * NT;
        constexpr int PADE = (LDP_EVEN - P_EVEN) * D / 8, PADO = (LDP_ODD - P_ODD) * D / 8;
        for (int i = gt; i < 2 * PADE + 2 * PADO; i += NG) {
            int r = i; bf16_t* dst;
            if (r < 2 * PADE) { const int l = r / PADE; dst = winT + (l ? WINT_L2 : WINT_L0) + (size_t)P_EVEN * D + (size_t)(r % PADE) * 8; }
            else { r -= 2 * PADE; const int l = r / PADO; dst = winT + (l ? WINT_L3 : WINT_L1) + (size_t)P_ODD * D + (size_t)(r % PADO) * 8; }
            *(u32x4*)dst = (u32x4){0u, 0u, 0u, 0u};
        }
    }
    {
        const int gt = blockIdx.x * NT + tid, NG = gridDim.x * NT;
        float* lb = (float*)(P.ws + WS_LB);
        for (int ch = gt; ch < 512; ch += NG) {
            float lg[4], mx = -1e30f;
#pragma unroll
            for (int l = 0; l < 4; ++l) { lg[l] = P.hg_lb_logits[l * 512 + ch]; mx = fmaxf(mx, lg[l]); }
            float e[4], s = 0.f;
#pragma unroll
            for (int l = 0; l < 4; ++l) { e[l] = __expf(lg[l] - mx); s += e[l]; }
            float cum = 0.f;
#pragma unroll
            for (int l = 0; l < 4; ++l) { if (l > 0) cum += e[l] / s; lb[l * 512 + ch] = cum; }
        }
    }
    __syncthreads();
    {
        LAS float* sc = (LAS float*)lds;
        LAS float* red = (LAS float*)(lds + 5 * 1024 * 4);
        for (int i = tid; i < 5 * D; i += NT) { const int m = i >> 10, k = i & 1023; const float v = m < 4 ? P.c[m * D + k] : P.c_ctx[k]; sc[i] = siluf_(v); }
        __syncthreads();
        float* modv = (float*)(P.ws + WS_MODV);
        for (int cb = blockIdx.x; cb < 4 * 6144 / 96; cb += gridDim.x) {
            const int l = (cb * 96) / 6144, j0 = (cb * 96) % 6144;
            const int cg = tid % 24, kg = tid / 24;
            if (tid < 384) {
                const float* w = P.mod_w + (size_t)l * D * 6144 + (size_t)(kg * 64) * 6144 + j0 + 4 * cg;
                f32x4 a[5];
#pragma unroll
                for (int m = 0; m < 5; ++m) a[m] = (f32x4){0.f, 0.f, 0.f, 0.f};
#pragma unroll 1
                for (int k0 = 0; k0 < 64; k0 += 16) {
                    f32x4 wv4[16];
#pragma unroll
                    for (int u = 0; u < 16; ++u) wv4[u] = *(const f32x4*)(w + (size_t)(k0 + u) * 6144);
#pragma unroll
                    for (int u = 0; u < 16; ++u)
#pragma unroll
                        for (int m = 0; m < 5; ++m) a[m] += wv4[u] * sc[m * 1024 + kg * 64 + k0 + u];
                }
#pragma unroll
                for (int m = 0; m < 5; ++m) *(LAS f32x4*)(red + ((kg * 5 + m) * 96 + 4 * cg)) = a[m];
            }
            __syncthreads();
            if (tid < 480) {
                const int m = tid / 96, c = tid % 96;
                float sum = 0.f;
#pragma unroll
                for (int g = 0; g < 16; ++g) sum += red[(g * 5 + m) * 96 + c];
                modv[(size_t)(l * 5 + m) * 6144 + j0 + c] = sum + P.mod_b[l * 6144 + j0 + c];
            }
            __syncthreads();
        }
    }
}

__device__ __forceinline__ void phase_prologue1(int wv, KP Pk) {
    asm volatile("" : "+s"(Pk));
    const CAS Params& P = *Pk;
    const int tid = ltid(wv), lane = tid & 63, wid = tid >> 6;
    bf16_t* act = (bf16_t*)(P.ws + WS_ACT);
    f32x4 nv[4];
    auto fetch = [&](int rr) {
        const float* src = rr < NCTX ? P.ctx + (size_t)rr * D : P.x + (size_t)(rr - NCTX) * D;
#pragma unroll
        for (int i = 0; i < 4; ++i) nv[i] = *(const f32x4*)(src + 4 * lane + 256 * i);
    };
    const int stride = gridDim.x * 8;
    int r = blockIdx.x * 8 + wid;
    if (r < NROWS) fetch(r);
    for (; r < NROWS; r += stride) {
        const int m = row_mod(r);
        const f32x4 cv[4] = {nv[0], nv[1], nv[2], nv[3]};
        if (r + stride < NROWS) fetch(r + stride);
        const float* sh = modvec(P.ws, 0, m, 0); const float* sc = modvec(P.ws, 0, m, 1);
#pragma unroll
        for (int i = 0; i < 4; ++i) {
            const int c = 4 * lane + 256 * i;
            const f32x4 v = cv[i], s1 = *(const f32x4*)(sc + c), h1 = *(const f32x4*)(sh + c);
            u32x2 o; o.x = pk2(v[0] * (1.f + s1[0]) + h1[0], v[1] * (1.f + s1[1]) + h1[1]); o.y = pk2(v[2] * (1.f + s1[2]) + h1[2], v[3] * (1.f + s1[3]) + h1[3]);
            *(u32x2*)(act + (size_t)r * D + c) = o;
        }
    }
}

__device__ __forceinline__ void phase_inproj(int wv, KP Pk, int layer, LAS char* lds) {
    asm volatile("" : "+s"(Pk));
    const CAS Params& P = *Pk;
    const int odd = layer & 1, ldp = odd ? LDP_ODD : LDP_EVEN;
    const size_t woff = layer == 0 ? WINT_L0 : layer == 1 ? WINT_L1 : layer == 2 ? WINT_L2 : WINT_L3;
    pg8::Gemm g{(const bf16_t*)(P.ws + WS_ACT), (const bf16_t*)(P.ws + WS_WINT) + woff, NROWS, ldp, D};
    pg8::StaticOrder S; S.init(NROWS, ldp, (int)gridDim.x, (int)blockIdx.x);
    pg8::EpiStoreP E{(bf16_t*)(P.ws + WS_P), ldp};
    pg8::gemm_phase(wv, (PG8_LAS unsigned char*)lds, g, S, E);
    expconv_tail(wv, P, layer, lds, (NROWS / 256) * (ldp / 256), 0, exc_s0(layer));
}
__device__ __forceinline__ void phase_outproj(int wv, KP Pk, int layer, LAS char* lds) {
    asm volatile("" : "+s"(Pk));
    const CAS Params& P = *Pk;
    const int r0 = (layer == DEPTH - 1) ? NCTX : 0;
    pg8::Gemm g{(const bf16_t*)(P.ws + WS_FEAT) + (size_t)r0 * D, (const bf16_t*)(P.ws + WS_WOUTT) + (size_t)layer * D * D, NROWS - r0, D, D};
    pg8::StaticOrder S; S.init(NROWS - r0, D, (int)gridDim.x, (int)blockIdx.x);
    pg8::EpiStoreP E{(bf16_t*)(P.ws + WS_YO) + (size_t)r0 * D, D};
    pg8::gemm_phase(wv, (PG8_LAS unsigned char*)lds, g, S, E);
    expconv_tail(wv, P, layer, lds, ((NROWS - r0) / 256) * (D / 256), exc_s0(layer), exc_s0(layer) + exc_s1(layer));
}
__device__ __forceinline__ void phase_prep2(int wv, KP Pk, int layer, LAS char* lds) {
    asm volatile("" : "+s"(Pk));
    const CAS Params& P = *Pk;
    const int i = layer >> 1;
    const bf16_t* la = (const bf16_t*)(P.ws + WS_LA);
    const bf16_t* lt = (const bf16_t*)(P.ws + WS_LORAT) + (size_t)i * LORA_PER;
    constexpr int MT = NROWS / G_BM, NTL = 512 / G_BN;
    const int ntiles = 4 * MT * NTL;
    for (int t = blockIdx.x; t < ntiles; t += gridDim.x) {
        const int which = t / (MT * NTL), r = t % (MT * NTL), mt = r / NTL, nt = r % NTL;
        RowLinear rs{mt * G_BM};
        if (which < 2) {
            EpiDecay epi{(bf16_t*)(P.ws + WS_RWDEC) + (size_t)which * NROWS * 512, P.rw_w0 + (size_t)(i * 2 + which) * 512, mt * G_BM, nt * G_BN};
            gemm_tile(wv, la + which * 64, 320, rs, lt + (size_t)which * 512 * 64, 64, nt * G_BN, 64, epi, lds);
        } else if (which == 2) {
            EpiAK epi{(bf16_t*)(P.ws + WS_RWK), (const bf16_t*)(P.ws + WS_RWKK), (bf16_t*)(P.ws + WS_RWB), P.rw_a0 + i * 512, P.rw_k_a + i * 512, mt * G_BM, nt * G_BN};
            gemm_tile(wv, la + 128, 320, rs, lt + (size_t)2 * 512 * 64, 64, nt * G_BN, 64, epi, lds);
        } else {
            EpiStoreBf16 epi{(bf16_t*)(P.ws + WS_RWG), 512, mt * G_BM, nt * G_BN, 512};
            gemm_tile(wv, la + 192, 320, rs, lt + (size_t)3 * 512 * 64, 128, nt * G_BN, 128, epi, lds);
        }
    }
}
__device__ __forceinline__ void moe_tiles(int wv, const unsigned char* ws, int layer, LAS int* tstart, LAS int* tcnt) {
    const int tid = ltid(wv);
    if (tid < 64) {
        const int* cnt = (const int*)(ws + WS_CNT) + layer * 32 * CNT_STRIDE;
        const int c = tid < NEXP ? cnt[tid * CNT_STRIDE] : 0;
        int incl = (c + G_BM - 1) / G_BM;
#pragma unroll
        for (int o = 1; o < 32; o <<= 1) { const int t = __shfl_up(incl, o); if (tid >= o) incl += t; }
        if (tid < NEXP) { tcnt[tid] = c; tstart[tid] = incl - (c + G_BM - 1) / G_BM; }
        if (tid == NEXP - 1) tstart[NEXP] = incl;
    }
    __syncthreads();
}
__device__ __forceinline__ void phase_moe1(int wv, KP Pk, int layer, LAS char* lds) {
    asm volatile("" : "+s"(Pk));
    const CAS Params& P = *Pk;
    LAS int* tstart = (LAS int*)(lds + pg8::STAGE_BYTES); LAS int* tcnt = tstart + 40;
    moe_tiles(wv, P.ws, layer, tstart, tcnt);
    pg8::Gemm g{(const bf16_t*)(P.ws + WS_ACT), (const bf16_t*)(P.ws + WS_EXPGU), 0, 1024, D};
    LAS int* ltabs = tstart + 128;
    pg8::MoeOrder S{tstart, tcnt, ltabs, (const int*)(P.ws + WS_LIST), (const char*)(P.ws + WS_EXPGU), (size_t)1024 * 1024 * 2, 4, 1, (int)gridDim.x, (int)blockIdx.x};
    pg8::EpiSwiGLUG E{(bf16_t*)(P.ws + WS_HID)};
    for (int i = 0; i < 8; ++i) {
        pg8::UnitG u; if (!S.next(i, u)) break;
        const int tl = ltid(wv);
        const int* ul = (const int*)(P.ws + WS_LIST) + (size_t)u.e * LISTCAP + u.pm * pg8::BM;
        if (tl < pg8::BM) ltabs[i * pg8::BM + tl] = ul[tl < u.cnt ? tl : 0];
    }
    __syncthreads();
    pg8::gemm_phase_g(wv, (PG8_LAS unsigned char*)lds, g, S, E);
    __syncthreads();
}
__device__ __forceinline__ void phase_moe2(int wv, KP Pk, int layer, LAS char* lds) {
    asm volatile("" : "+s"(Pk));
    const CAS Params& P = *Pk;
    LAS int* tstart = (LAS int*)(lds + pg8::STAGE_BYTES); LAS int* tcnt = tstart + 40;
    moe_tiles(wv, P.ws, layer, tstart, tcnt);
    pg8::Gemm g{(const bf16_t*)(P.ws + WS_HID), (const bf16_t*)(P.ws + WS_EXPD), 0, 1024, DEXP};
    LAS int* ltabs = tstart + 128;
    pg8::MoeOrder S{tstart, tcnt, ltabs, (const int*)(P.ws + WS_LIST), (const char*)(P.ws + WS_EXPD), (size_t)1024 * 512 * 2, 4, 0, (int)gridDim.x, (int)blockIdx.x};
    pg8::EpiScatterG E{(bf16_t*)(P.ws + WS_YP)};
    for (int i = 0; i < 8; ++i) {
        pg8::UnitG u; if (!S.next(i, u)) break;
        const int tl = ltid(wv);
        const int* ul = (const int*)(P.ws + WS_LIST) + (size_t)u.e * LISTCAP + u.pm * pg8::BM;
        if (tl < pg8::BM) ltabs[i * pg8::BM + tl] = ul[tl < u.cnt ? tl : 0];
    }
    __syncthreads();
    pg8::gemm_phase_g(wv, (PG8_LAS unsigned char*)lds, g, S, E);
    __syncthreads();
}

constexpr int NCHUNK = NSTEPS / TCH;

constexpr int SSD_F = 32 + 64 + 64;
constexpr int SSD_BUF = TCH * SSD_F + 3 * TCH;

constexpr int ML_F = 64 + 64 + 32;
constexpr int ML_BUF = TCH * ML_F + 4 * TCH;

constexpr int HG_F = 128 + 128 + 32;
constexpr int HG_BUF = TCH * HG_F + TCH;

constexpr int RW_F = 5 * 64 + 32;
constexpr int RW_BUF = TCH * RW_F + TCH;
__device__ __forceinline__ void scan_rwkv_b(int wv, KP Pk, int layer, int unit, LAS char* lds) {
    asm volatile("" : "+s"(Pk));
    const CAS Params& P = *Pk;
    const int tid = ltid(wv);
    const int seq = unit >> 1, half = unit & 1, b = seq >> 4, h = (seq >> 1) & 7, dir = seq & 1;
    LAS float* bufs = (LAS float*)lds;
    bf16_t* Y = (bf16_t*)(P.ws + (dir ? WS_YB : WS_YF));
    const bf16_t* dec = (const bf16_t*)(P.ws + WS_RWDEC) + (size_t)dir * NROWS * 512;
    constexpr int NS = 6, NG = 44;
    const int stid = tid - 256;
    int tj[NS], tg_[NS]; bool tv[NS]; const unsigned char* tbase[NS]; int tlds[NS];
#pragma unroll
    for (int s = 0; s < NS; ++s) {
        const int task = stid + 256 * s; tv[s] = stid >= 0 && task < TCH * NG; tj[s] = task / NG; tg_[s] = task % NG;
        const int g = tg_[s];
        if (g < 8)       { tbase[s] = P.ws + WS_RWR  + (size_t)(h * 64 + 8 * g) * 2;              tlds[s] = 256 + 8 * g; }
        else if (g < 16) { tbase[s] = P.ws + WS_RWK  + (size_t)(h * 64 + 8 * (g - 8)) * 2;        tlds[s] = 192 + 8 * (g - 8); }
        else if (g < 24) { tbase[s] = P.ws + WS_RWKK + (size_t)(h * 64 + 8 * (g - 16)) * 2;       tlds[s] = 64 + 8 * (g - 16); }
        else if (g < 32) { tbase[s] = P.ws + WS_RWB  + (size_t)(h * 64 + 8 * (g - 24)) * 2;       tlds[s] = 128 + 8 * (g - 24); }
        else if (g < 36) { tbase[s] = P.ws + WS_RWV  + (size_t)(h * 64 + half * 32 + 8 * (g - 32)) * 2; tlds[s] = 320 + 8 * (g - 32); }
        else             { tbase[s] = (const unsigned char*)(dec + h * 64 + 8 * (g - 36));        tlds[s] = 8 * (g - 36); }
    }
    u32x4 rc[NS]; int rrow = 0;
    auto load = [&](int c) {
#pragma unroll
        for (int s = 0; s < NS; ++s) {
            rc[s] = (u32x4){0u, 0u, 0u, 0u};
            if (tv[s]) { const int row = scan_row(c * TCH + tj[s], b, dir, 1); rc[s] = *(const u32x4*)(tbase[s] + (size_t)row * 1024); }
        }
        if (stid >= 0 && stid < TCH) rrow = scan_row(c * TCH + stid, b, dir, 1);
    };
    auto store = [&](int c) {
        LAS float* buf = bufs + (c & 1) * RW_BUF;
#pragma unroll
        for (int s = 0; s < NS; ++s) {
            if (tv[s]) {
                LAS float* dst = buf + tj[s] * RW_F + tlds[s];
                const int g = tg_[s];
                if (g >= 36) {
                    float f[8]; unpack8(rc[s], f);
                    *(LAS f32x4*)dst = (f32x4){__expf(-f[0]), __expf(-f[1]), __expf(-f[2]), __expf(-f[3])}; *(LAS f32x4*)(dst + 4) = (f32x4){__expf(-f[4]), __expf(-f[5]), __expf(-f[6]), __expf(-f[7])};
                } else {
                    float f[8]; unpack8(rc[s], f);
                    const float sg = (g >= 16 && g < 24) ? -1.f : 1.f;
                    *(LAS f32x4*)dst = (f32x4){sg * f[0], sg * f[1], sg * f[2], sg * f[3]}; *(LAS f32x4*)(dst + 4) = (f32x4){sg * f[4], sg * f[5], sg * f[6], sg * f[7]};
                }
            }
        }
        if (stid >= 0 && stid < TCH) ((LAS int*)buf)[TCH * RW_F + stid] = rrow;
    };
    const int q = tid & 15, vr = (tid >> 4) & 3, rowA = 8 * wv + vr, rowB = rowA + 4;
    f32x2 A01 = {0.f, 0.f}, A23 = {0.f, 0.f}, B01 = {0.f, 0.f}, B23 = {0.f, 0.f};
    LAS float* ypw = bufs + 2 * RW_BUF + (wv & 3) * (2 * 16 * 132);
    int prow = -1, gpar = 0;
    if (wv >= 4) { load(0); store(0); }
    __syncthreads();
    for (int c = 0; c < NCHUNK; ++c) {
        if (wv >= 4 && c + 1 < NCHUNK) load(c + 1);
        LAS float* buf = bufs + (c & 1) * RW_BUF;
        if (wv < 4) {
            const LAS float* wp = buf + 4 * q;
            const LAS float* vpA = buf + 320 + rowA; const LAS float* vpB = buf + 320 + rowB;
            f32x4 w4 = *(const LAS f32x4*)wp, a4 = *(const LAS f32x4*)(wp + 64), b4 = *(const LAS f32x4*)(wp + 128), k4 = *(const LAS f32x4*)(wp + 192), r4 = *(const LAS f32x4*)(wp + 256); float vrA = vpA[0], vrB = vpB[0];
#pragma unroll 1
            for (int jh = 0; jh < 2; ++jh) {
                const LAS float* rp = ypw + (gpar ^ 1) * (16 * 132) + q * 132 + vr * 16;
                const f32x4 pa0 = *(const LAS f32x4*)rp, pa1 = *(const LAS f32x4*)(rp + 4), pa2 = *(const LAS f32x4*)(rp + 8), pa3 = *(const LAS f32x4*)(rp + 12);
                const f32x4 pb0 = *(const LAS f32x4*)(rp + 64), pb1 = *(const LAS f32x4*)(rp + 68), pb2 = *(const LAS f32x4*)(rp + 72), pb3 = *(const LAS f32x4*)(rp + 76);
                LAS float* wpz = ypw + gpar * (16 * 132) + (tid & 63);
#pragma unroll
                for (int j = 0; j < 16; ++j) {
                    const int jj = jh * 16 + j;
                    const f32x4 wc = w4, ac = a4, bc = b4, kc = k4, rc = r4; const float vvA = vrA, vvB = vrB;
                    if (j < 15 || jh == 0) {
                        const LAS float* np = wp + (jj + 1) * RW_F;
                        w4 = *(const LAS f32x4*)np; a4 = *(const LAS f32x4*)(np + 64); b4 = *(const LAS f32x4*)(np + 128); k4 = *(const LAS f32x4*)(np + 192); r4 = *(const LAS f32x4*)(np + 256);
                        vrA = vpA[(jj + 1) * RW_F]; vrB = vpB[(jj + 1) * RW_F];
                    }
                    const f32x2 a01 = {ac[0], ac[1]}, a23 = {ac[2], ac[3]}, w01 = {wc[0], wc[1]}, w23 = {wc[2], wc[3]}, b01 = {bc[0], bc[1]}, b23 = {bc[2], bc[3]};
                    const f32x2 k01 = {kc[0], kc[1]}, k23 = {kc[2], kc[3]}, r01 = {rc[0], rc[1]}, r23 = {rc[2], rc[3]}, va2 = {vvA, vvA}, vb2 = {vvB, vvB};
                    f32x2 tA = A01 * a01; tA = A23 * a23 + tA;
                    f32x2 tB = B01 * a01; tB = B23 * a23 + tB;
                    const f32x2 uA01 = A01 * w01 + va2 * k01, uA23 = A23 * w23 + va2 * k23, uB01 = B01 * w01 + vb2 * k01, uB23 = B23 * w23 + vb2 * k23;
                    const float saA = allreduce16(tA.x + tA.y), saB = allreduce16(tB.x + tB.y);
                    const f32x2 sA2 = {saA, saA}, sB2 = {saB, saB};
                    A01 = sA2 * b01 + uA01; A23 = sA2 * b23 + uA23; B01 = sB2 * b01 + uB01; B23 = sB2 * b23 + uB23;
                    f32x2 yA = A01 * r01; yA = A23 * r23 + yA;
                    f32x2 yB = B01 * r01; yB = B23 * r23 + yB;
                    wpz[j * 132] = yA.x + yA.y; wpz[j * 132 + 64] = yB.x + yB.y;
                }
                if (prow >= 0) {
                    const f32x4 ta = (pa0 + pa1) + (pa2 + pa3), tb = (pb0 + pb1) + (pb2 + pb3);
                    bf16_t* yo = Y + (size_t)prow * D + 512 + h * 64 + half * 32;
                    yo[rowA] = f2bf((ta[0] + ta[1]) + (ta[2] + ta[3])); yo[rowB] = f2bf((tb[0] + tb[1]) + (tb[2] + tb[3]));
                }
                prow = ((const LAS int*)buf)[TCH * RW_F + jh * 16 + q];
                gpar ^= 1;
            }
        }
        if (wv >= 4 && c + 1 < NCHUNK) store(c + 1);
        __syncthreads();
    }
    if (wv < 4) {
        const LAS float* rp = ypw + (gpar ^ 1) * (16 * 132) + q * 132 + vr * 16;
        const f32x4 ta = (*(const LAS f32x4*)rp + *(const LAS f32x4*)(rp + 4)) + (*(const LAS f32x4*)(rp + 8) + *(const LAS f32x4*)(rp + 12));
        const f32x4 tb = (*(const LAS f32x4*)(rp + 64) + *(const LAS f32x4*)(rp + 68)) + (*(const LAS f32x4*)(rp + 72) + *(const LAS f32x4*)(rp + 76));
        bf16_t* yo = Y + (size_t)prow * D + 512 + h * 64 + half * 32;
        yo[rowA] = f2bf((ta[0] + ta[1]) + (ta[2] + ta[3])); yo[rowB] = f2bf((tb[0] + tb[1]) + (tb[2] + tb[3]));
    }
}

constexpr size_t WS_EXBC = WS_RWR;
constexpr size_t WS_EQK = WS_EXBC + (size_t)NROWS * 768 * 2;
constexpr size_t WS_EGT = WS_EQK + (size_t)NROWS * 512 * 2;
static_assert(WS_EGT + (size_t)NROWS * 32 * 4 <= WS_LA, "even-layer prepare buffers must fit in the RWKV region");

__device__ __forceinline__ void phase_prep_even(int wv, KP Pk, int layer) {
    asm volatile("" : "+s"(Pk));
    const CAS Params& P = *Pk;
    const int tid = ltid(wv), lane = tid & 63, wid = tid >> 6, i_ = layer >> 1;
    const bf16_t* Pb = (const bf16_t*)(P.ws + WS_P);
    bf16_t* XBC = (bf16_t*)(P.ws + WS_EXBC); bf16_t* QK = (bf16_t*)(P.ws + WS_EQK); float* GT = (float*)(P.ws + WS_EGT);
    float cw0[4][8], cw1[4][8], cwq[4][8];
#pragma unroll
    for (int e = 0; e < 8; ++e) {
#pragma unroll
        for (int t = 0; t < 3; ++t) {
            cw0[t][e] = P.ssd_conv_w[(size_t)(i_ * 3 + t) * 768 + 8 * lane + e];
            cw1[t][e] = P.ssd_conv_w[(size_t)(i_ * 3 + t) * 768 + 512 + 8 * (lane & 31) + e];
            cwq[t][e] = P.ml_conv_w[(size_t)(i_ * 3 + t) * 512 + 8 * lane + e];
        }
        cw0[3][e] = P.ssd_conv_b[i_ * 768 + 8 * lane + e]; cw1[3][e] = P.ssd_conv_b[i_ * 768 + 512 + 8 * (lane & 31) + e]; cwq[3][e] = P.ml_conv_b[i_ * 512 + 8 * lane + e];
    }
    float gbias = 0.f;
    if (lane < 16) gbias = P.ssd_dt_bias[i_ * 16 + lane]; else if (lane < 24) gbias = P.ml_i_bias[i_ * 8 + lane - 16]; else if (lane < 32) gbias = P.ml_f_bias[i_ * 8 + lane - 24];
    const float qscl = lane < 32 ? 0.125f : 1.f;
    const u32x4 zero = (u32x4){0u, 0u, 0u, 0u};
    u32x4 nA[3], nB[3], nC[3]; bf16_t ng = 0;
    auto fetch = [&](int rr) {
        int t, len; row_seg(rr, t, len);
        const bf16_t* pr = Pb + (size_t)rr * LDP_EVEN;
        const bool hp = t > 0, hn = t < len - 1;
        { const int col = 512 + 8 * lane; nA[0] = *(const u32x4*)(pr + col); nA[1] = hp ? *(const u32x4*)(pr - LDP_EVEN + col) : zero; nA[2] = hn ? *(const u32x4*)(pr + LDP_EVEN + col) : zero; }
        if (lane < 32) { const int col = 1024 + 8 * lane; nB[0] = *(const u32x4*)(pr + col); nB[1] = hp ? *(const u32x4*)(pr - LDP_EVEN + col) : zero; nB[2] = hn ? *(const u32x4*)(pr + LDP_EVEN + col) : zero; }
        { const int col = 1296 + 8 * lane; nC[0] = *(const u32x4*)(pr + col); nC[1] = hp ? *(const u32x4*)(pr - LDP_EVEN + col) : zero; nC[2] = hn ? *(const u32x4*)(pr + LDP_EVEN + col) : zero; }
        if (lane < 32) ng = pr[lane < 16 ? 1280 + lane : 2832 + (lane - 16)];
    };
    nB[0] = nB[1] = nB[2] = zero;
    const int stride = gridDim.x * 8;
    int r = blockIdx.x * 8 + wid;
    if (r < NROWS) fetch(r);
    for (; r < NROWS; r += stride) {
        const u32x4 cA0 = nA[0], cA1 = nA[1], cA2 = nA[2], cB0 = nB[0], cB1 = nB[1], cB2 = nB[2], cC0 = nC[0], cC1 = nC[1], cC2 = nC[2]; const bf16_t cg = ng;
        if (r + stride < NROWS) fetch(r + stride);
        float fc[8], fp[8], fn[8], o[8];
        {
            unpack8(cA0, fc); unpack8(cA1, fp); unpack8(cA2, fn);
#pragma unroll
            for (int e = 0; e < 8; ++e) o[e] = siluf_(cw0[0][e] * fp[e] + cw0[1][e] * fc[e] + cw0[2][e] * fn[e] + cw0[3][e]);
            *(u32x4*)(XBC + (size_t)r * 768 + 8 * lane) = pack8(o);
        }
        if (lane < 32) {
            unpack8(cB0, fc); unpack8(cB1, fp); unpack8(cB2, fn);
#pragma unroll
            for (int e = 0; e < 8; ++e) o[e] = siluf_(cw1[0][e] * fp[e] + cw1[1][e] * fc[e] + cw1[2][e] * fn[e] + cw1[3][e]);
            *(u32x4*)(XBC + (size_t)r * 768 + 512 + 8 * lane) = pack8(o);
        }
        {
            unpack8(cC0, fc); unpack8(cC1, fp); unpack8(cC2, fn);
#pragma unroll
            for (int e = 0; e < 8; ++e) o[e] = qscl * siluf_(cwq[0][e] * fp[e] + cwq[1][e] * fc[e] + cwq[2][e] * fn[e] + cwq[3][e]);
            *(u32x4*)(QK + (size_t)r * 512 + 8 * lane) = pack8(o);
        }
        if (lane < 32) {
            const float x = bf2f(cg) + gbias;
            GT[(size_t)r * 32 + lane] = lane < 16 ? softplusf_(x) : lane < 24 ? x : logsigmoidf_(x);
        }
    }
}

constexpr int CL = 64, NCH64 = NSTEPS / CL, LDT = 72, LDTB = LDT * 2;
__device__ __forceinline__ bf16x8 ldfrag(const LAS char* tile, int ldb, int row0, int k0, int lane) {
    return *(const LAS bf16x8*)(tile + (row0 + (lane & 15)) * ldb + (k0 + 8 * (lane >> 4)) * 2);
}
typedef short s16x4 __attribute__((ext_vector_type(4)));
constexpr int LDV = 272;
__device__ __forceinline__ bf16x8 ldfrag_tr(const LAS char* tile, int rowb, int c0, int k0, int lane) {
    const int i = lane & 15;
    const LAS char* p = tile + (k0 + 8 * (lane >> 4) + (i >> 2)) * rowb + (c0 + 4 * (i & 3)) * 2;
    const s16x4 lo = __builtin_amdgcn_ds_read_tr16_b64_v4i16((LAS s16x4*)p);
    const s16x4 hi = __builtin_amdgcn_ds_read_tr16_b64_v4i16((LAS s16x4*)(p + 4 * rowb));
    return (bf16x8){lo[0], lo[1], lo[2], lo[3], hi[0], hi[1], hi[2], hi[3]};
}
__device__ __forceinline__ void st4bf(LAS char* p, const f32x4& v) { u32x2 o; o.x = pk2(v[0], v[1]); o.y = pk2(v[2], v[3]); *(LAS u32x2*)p = o; }

constexpr int SS_BT = 0, SS_CT = SS_BT + 64 * LDTB, SS_BDT = SS_CT + 64 * LDTB, SS_XT = SS_BDT + 64 * LDTB, SS_CUM = SS_XT + 32 * LDTB, SS_DTV = SS_CUM + 256, SS_ROWS = SS_DTV + 256, SS_STG = SS_ROWS + 256;
constexpr int SS_M = 2 * SS_STG, SS_HB = SS_M + 64 * LDTB, SS_END = SS_HB + 32 * LDTB;
static_assert(SS_END <= LDS_BYTES - 16, "SSD LDS map");

constexpr int MS_QT = 0, MS_KT = MS_QT + 64 * LDTB, MS_KET = MS_KT + 64 * LDTB, MS_VT = MS_KET + 64 * LDTB, MS_SC = MS_VT + 32 * LDTB;
constexpr int MS_STG = MS_SC + 8 * 256;
constexpr int MS_W = 2 * MS_STG, MS_CB = MS_W + 64 * LDTB, MS_ONE = MS_CB + 32 * LDTB, MS_NV = MS_ONE + 16 * LDTB, MS_QN = MS_NV + 256, MS_END = MS_QN + 256;
static_assert(MS_END <= LDS_BYTES - 16, "mLSTM LDS map");

constexpr size_t WS_XSS = WS_EGT + al256((size_t)NROWS * 32 * 4);
constexpr size_t XSS_BYTES = (size_t)64 * NCH64 * 64 * 64 * 2;
constexpr size_t WS_XSD = WS_XSS + XSS_BYTES;
constexpr size_t WS_XMC = WS_XSD + al256((size_t)64 * NCH64 * 4);
constexpr size_t XMC_BYTES = (size_t)32 * NCH64 * 128 * 64 * 2;
constexpr size_t WS_XMN = WS_XMC + XMC_BYTES;
constexpr size_t WS_XMS = WS_XMN + (size_t)32 * NCH64 * 64 * 4;
constexpr size_t WS_XMT = WS_XMS + al256((size_t)32 * NCH64 * 4 * 4);
constexpr size_t WS_XEND = WS_XMT + (size_t)32 * NCH64 * 3 * 64 * 4;
static_assert(WS_XEND <= WS_END, "even-layer chunk-state buffers must fit in the RWKV region");
constexpr int NSSD_ITEMS = 64 * NCH64, NML_ITEMS = 32 * NCH64;

template <int CTRL, int RM, int BM> __device__ __forceinline__ float dppx(float old, float v) {
    return __builtin_bit_cast(float, __builtin_amdgcn_update_dpp(__builtin_bit_cast(int, old), __builtin_bit_cast(int, v), CTRL, RM, BM, false));
}
__device__ __forceinline__ float wave_cumsum(float v, int) {
    float t = v;
    t += dppx<0x111, 0xf, 0xf>(0.f, v); t += dppx<0x112, 0xf, 0xf>(0.f, v); t += dppx<0x113, 0xf, 0xf>(0.f, v);
    { const float u = dppx<0x114, 0xf, 0xe>(0.f, t); t += u; }
    { const float u = dppx<0x118, 0xf, 0xc>(0.f, t); t += u; }
    { const float u = dppx<0x142, 0xa, 0xf>(0.f, t); t += u; }
    { const float u = dppx<0x143, 0xc, 0xf>(0.f, t); t += u; }
    return t;
}
__device__ __forceinline__ float wave_cummax(float v, int) {
    const float ninf = -__builtin_huge_valf();
    float t = v;
    t = fmaxf(t, dppx<0x111, 0xf, 0xf>(ninf, v)); t = fmaxf(t, dppx<0x112, 0xf, 0xf>(ninf, v)); t = fmaxf(t, dppx<0x113, 0xf, 0xf>(ninf, v));
    { const float u = dppx<0x114, 0xf, 0xe>(ninf, t); t = fmaxf(t, u); }
    { const float u = dppx<0x118, 0xf, 0xc>(ninf, t); t = fmaxf(t, u); }
    { const float u = dppx<0x142, 0xa, 0xf>(ninf, t); t = fmaxf(t, u); }
    { const float u = dppx<0x143, 0xc, 0xf>(ninf, t); t = fmaxf(t, u); }
    return t;
}
__device__ __forceinline__ float wave_max(float v) {
    const float t = wave_cummax(v, 0);
    return __builtin_bit_cast(float, __builtin_amdgcn_readlane(__builtin_bit_cast(int, t), 63));
}

constexpr int X1S_BDT = 0, X1S_XT = X1S_BDT + 64 * LDTB, X1S_CUM = X1S_XT + 64 * LDTB, X1S_DTV = X1S_CUM + 256, X1S_END = X1S_DTV + 256;
constexpr int X1M_KET = 0, X1M_VT = X1M_KET + 64 * LDTB, X1M_ONE = X1M_VT + 64 * LDV, X1M_EE = X1M_ONE + 16 * LDTB, X1M_END = X1M_EE + 256;
__device__ __forceinline__ void phase_ex1(int wv, KP Pk, int layer, LAS char* lds) {
    asm volatile("" : "+s"(Pk));
    const CAS Params& P = *Pk;
    const int tid = ltid(wv), lane = tid & 63, wid = tid >> 6, q = lane >> 4, r16 = lane & 15, i_ = layer >> 1;
    const bf16_t* XBC = (const bf16_t*)(P.ws + WS_EXBC); const bf16_t* QK = (const bf16_t*)(P.ws + WS_EQK); const bf16_t* Pb = (const bf16_t*)(P.ws + WS_P);
    const float* GT = (const float*)(P.ws + WS_EGT);
    {
        bf16_t* Hst = (bf16_t*)(P.ws + WS_XSS); float* Dst = (float*)(P.ws + WS_XSD);
        struct Set { u32x4 rc[2]; float rdt; }; Set SA, SB; SA.rdt = SB.rdt = 0.f;
        auto geom = [&](int it, int& b, int& h, int& dir, int& c) { const int sq = it / NCH64; c = it - sq * NCH64; b = sq >> 4; h = (sq >> 1) & 7; dir = sq & 1; };
        auto load = [&](int it, Set& S) {
            int b, h, dir, c; geom(it, b, h, dir, c);
            int tl = tid; asm volatile("" : "+v"(tl));
#pragma unroll
            for (int s = 0; s < 2; ++s) {
                const int task = tl + NT * s, j = task >> 4, g = task & 15;
                const int row = scan_row(c * CL + j, b, dir, 0);
                S.rc[s] = *(const u32x4*)(XBC + (size_t)row * 768 + (g < 8 ? h * 64 + 8 * g : 512 + (h >> 2) * 64 + 8 * (g - 8)));
            }
            if (tl < CL) { const int row = scan_row(c * CL + tl, b, dir, 0); S.rdt = GT[(size_t)row * 32 + dir * 8 + h]; }
        };
        auto item = [&](int it, Set& S, int nxt) {
            int b, h, dir, c; geom(it, b, h, dir, c);
            const float aco = -__expf(P.ssd_a_log[(i_ * 2 + dir) * 8 + h]);
            if (tid < CL) {
                const float cum = wave_cumsum(S.rdt * aco, lane);
                ((LAS float*)(lds + X1S_CUM))[tid] = cum; ((LAS float*)(lds + X1S_DTV))[tid] = S.rdt;
            }
            __syncthreads();
            {
                const LAS float* cum = (const LAS float*)(lds + X1S_CUM);
                const float cumL = cum[CL - 1];
                int tl = tid; asm volatile("" : "+v"(tl));
#pragma unroll
                for (int s = 0; s < 2; ++s) {
                    const int task = tl + NT * s, j = task >> 4, g = task & 15;
                    float f[8]; unpack8(S.rc[s], f);
                    if (g < 8) {
                        const float dt = ((const LAS float*)(lds + X1S_DTV))[j];
#pragma unroll
                        for (int e = 0; e < 8; ++e) f[e] *= dt;
                        *(LAS u32x4*)(lds + X1S_XT + j * LDTB + 16 * g) = pack8(f);
                    } else {
                        const float sc = __expf(cumL - cum[j]);
#pragma unroll
                        for (int e = 0; e < 8; ++e) f[e] *= sc;
                        *(LAS u32x4*)(lds + X1S_BDT + j * LDTB + 16 * (g - 8)) = pack8(f);
                    }
                }
                if (tid == 0) Dst[it] = __expf(cumL);
            }
            if (nxt < NSSD_ITEMS) load(nxt, S);
            __syncthreads();
            {
                const int pt = wid >> 1;
#pragma unroll
                for (int u = 0; u < 2; ++u) {
                    const int nt = (wid & 1) * 2 + u;
                    f32x4 sa = (f32x4){0.f, 0.f, 0.f, 0.f};
#pragma unroll
                    for (int k0 = 0; k0 < 64; k0 += 32) sa = __builtin_amdgcn_mfma_f32_16x16x32_bf16(ldfrag_tr(lds + X1S_BDT, LDTB, nt * 16, k0, lane), ldfrag_tr(lds + X1S_XT, LDTB, pt * 16, k0, lane), sa, 0, 0, 0);
                    u32x2 o; o.x = pk2(sa[0], sa[1]); o.y = pk2(sa[2], sa[3]);
                    *(u32x2*)(Hst + ((size_t)it * 64 + pt * 16 + r16) * 64 + nt * 16 + 4 * q) = o;
                }
            }
            __syncthreads();
        };
        {
            const int G = gridDim.x; int it = blockIdx.x;
            if (it < NSSD_ITEMS) load(it, SA);
            if (it + G < NSSD_ITEMS) load(it + G, SB);
            for (; it < NSSD_ITEMS; it += 2 * G) {
                item(it, SA, it + 2 * G);
                if (it + G < NSSD_ITEMS) item(it + G, SB, it + 3 * G);
            }
        }
    }
    {
        bf16_t* Cst = (bf16_t*)(P.ws + WS_XMC); float* Nst = (float*)(P.ws + WS_XMN); float* Sst = (float*)(P.ws + WS_XMS); float* Tst = (float*)(P.ws + WS_XMT);
        for (int i = tid; i < 16 * LDTB / 4; i += NT) ((LAS unsigned*)(lds + X1M_ONE))[i] = 0x3f803f80u;
        struct Set { u32x4 rc[3]; float rli, rlf; }; Set SA, SB; SA.rli = SA.rlf = SB.rli = SB.rlf = 0.f;
        auto geom = [&](int it, int& b, int& h, int& dir, int& c) { const int sq = it / NCH64; c = it - sq * NCH64; b = sq >> 3; h = (sq >> 1) & 3; dir = sq & 1; };
        auto load = [&](int it, Set& S) {
            int b, h, dir, c; geom(it, b, h, dir, c);
            int tl = tid; asm volatile("" : "+v"(tl));
#pragma unroll
            for (int s = 0; s < 3; ++s) {
                const int task = tl + NT * s, j = task / 24, g = task - 24 * j;
                const int row = scan_row(c * CL + j, b, dir, 0);
                S.rc[s] = g < 8 ? *(const u32x4*)(QK + (size_t)row * 512 + 256 + h * 64 + 8 * g) : *(const u32x4*)(Pb + (size_t)row * LDP_EVEN + 1808 + h * 128 + 8 * (g - 8));
            }
            if (tl < CL) { const int row = scan_row(c * CL + tl, b, dir, 0); S.rli = GT[(size_t)row * 32 + 16 + dir * 4 + h]; S.rlf = GT[(size_t)row * 32 + 24 + dir * 4 + h]; }
        };
        auto item = [&](int it, Set& S, int nxt) {
            if (tid < CL) {
                const float fcum = wave_cumsum(S.rlf, lane);
                const float ftot = __builtin_bit_cast(float, __builtin_amdgcn_readlane(__builtin_bit_cast(int, fcum), 63));
                const float g = S.rli - fcum, pm = wave_cummax(g, lane);
                const float wend = ftot + g, mloc = wave_max(wend);
                ((LAS float*)(lds + X1M_EE))[tid] = __expf(wend - mloc);
                float* tp = Tst + (size_t)it * 192;
                tp[tid] = fcum; tp[64 + tid] = g; tp[128 + tid] = pm;
                if (tid == 0) { Sst[(size_t)it * 4 + 0] = ftot; Sst[(size_t)it * 4 + 1] = mloc; }
            }
            __syncthreads();
            {
                const LAS float* ee = (const LAS float*)(lds + X1M_EE);
                int tl = tid; asm volatile("" : "+v"(tl));
#pragma unroll
                for (int s = 0; s < 3; ++s) {
                    const int task = tl + NT * s, j = task / 24, g = task - 24 * j;
                    if (g < 8) {
                        float f[8]; unpack8(S.rc[s], f);
                        const float e1 = ee[j];
#pragma unroll
                        for (int e = 0; e < 8; ++e) f[e] *= e1;
                        *(LAS u32x4*)(lds + X1M_KET + j * LDTB + 16 * g) = pack8(f);
                    } else {
                        const int v0 = 8 * (g - 8);
#pragma unroll
                        for (int e = 0; e < 1; ++e) *(LAS u32x4*)(lds + X1M_VT + j * LDV + v0 * 2) = S.rc[s];
                    }
                }
            }
            if (nxt < NML_ITEMS) load(nxt, S);
            __syncthreads();
            {
                const bf16x8 vf0 = ldfrag_tr(lds + X1M_VT, LDV, wid * 16, 0, lane), vf1 = ldfrag_tr(lds + X1M_VT, LDV, wid * 16, 32, lane);
#pragma unroll
                for (int kt = 0; kt < 4; ++kt) {
                    f32x4 sa = __builtin_amdgcn_mfma_f32_16x16x32_bf16(ldfrag_tr(lds + X1M_KET, LDTB, kt * 16, 0, lane), vf0, (f32x4){0.f, 0.f, 0.f, 0.f}, 0, 0, 0);
                    sa = __builtin_amdgcn_mfma_f32_16x16x32_bf16(ldfrag_tr(lds + X1M_KET, LDTB, kt * 16, 32, lane), vf1, sa, 0, 0, 0);
                    u32x2 o; o.x = pk2(sa[0], sa[1]); o.y = pk2(sa[2], sa[3]);
                    *(u32x2*)(Cst + ((size_t)it * 128 + wid * 16 + r16) * 64 + kt * 16 + 4 * q) = o;
                }
                if (wid < 4) {
                    f32x4 na = __builtin_amdgcn_mfma_f32_16x16x32_bf16(ldfrag_tr(lds + X1M_KET, LDTB, wid * 16, 0, lane), ldfrag(lds + X1M_ONE, LDTB, 0, 0, lane), (f32x4){0.f, 0.f, 0.f, 0.f}, 0, 0, 0);
                    na = __builtin_amdgcn_mfma_f32_16x16x32_bf16(ldfrag_tr(lds + X1M_KET, LDTB, wid * 16, 32, lane), ldfrag(lds + X1M_ONE, LDTB, 0, 32, lane), na, 0, 0, 0);
                    if (r16 == 0) *(f32x4*)(Nst + (size_t)it * 64 + wid * 16 + 4 * q) = na;
                }
            }
            __syncthreads();
        };
        {
            const int G = gridDim.x; int it = blockIdx.x;
            if (it < NML_ITEMS) load(it, SA);
            if (it + G < NML_ITEMS) load(it + G, SB);
            __syncthreads();
            for (; it < NML_ITEMS; it += 2 * G) {
                item(it, SA, it + 2 * G);
                if (it + G < NML_ITEMS) item(it + G, SB, it + 3 * G);
            }
        }
    }
}

constexpr int EX2_UB = 12;
static_assert(NCH64 % EX2_UB == 0, "EX2 batches");
__device__ __forceinline__ void phase_ex2(int wv, KP Pk, int layer) {
    asm volatile("" : "+s"(Pk));
    const CAS Params& P = *Pk;
    const int tid = ltid(wv);
    (void)layer;
    if (blockIdx.x < 128) {
        const int gt = blockIdx.x * NT + tid, sq = gt >> 10, rem = gt & 1023;
        bf16_t* Hst = (bf16_t*)(P.ws + WS_XSS) + (size_t)sq * NCH64 * 4096 + rem * 4;
        const float* Dst = (const float*)(P.ws + WS_XSD) + sq * NCH64;
        float h0 = 0.f, h1 = 0.f, h2 = 0.f, h3 = 0.f;
#pragma unroll 1
        for (int c0 = 0; c0 < NCH64; c0 += EX2_UB) {
            u32x2 loc[EX2_UB]; float dd[EX2_UB];
            bf16_t* hp = Hst + (size_t)c0 * 4096;
#pragma unroll
            for (int u = 0; u < EX2_UB; ++u) { loc[u] = *(const u32x2*)(hp + (size_t)u * 4096); dd[u] = Dst[c0 + u]; }
#pragma unroll
            for (int u = 0; u < EX2_UB; ++u) {
                u32x2 o; o.x = pk2(h0, h1); o.y = pk2(h2, h3);
                *(u32x2*)(hp + (size_t)u * 4096) = o;
                const float d = dd[u];
                h0 = d * h0 + bflo(loc[u].x); h1 = d * h1 + bfhi(loc[u].x); h2 = d * h2 + bflo(loc[u].y); h3 = d * h3 + bfhi(loc[u].y);
            }
        }
    } else if (blockIdx.x < 256) {
        const int gt = (blockIdx.x - 128) * NT + tid, sq = gt >> 11, rem = gt & 2047;
        bf16_t* Cst = (bf16_t*)(P.ws + WS_XMC) + (size_t)sq * NCH64 * 8192 + rem * 4;
        float* Nst = (float*)(P.ws + WS_XMN) + (size_t)sq * NCH64 * 64 + (rem & 15) * 4;
        float* Sst = (float*)(P.ws + WS_XMS) + (size_t)sq * NCH64 * 4;
        const bool own_n = rem < 16, own_m = rem == 0;
        float c0_ = 0.f, c1 = 0.f, c2 = 0.f, c3 = 0.f, m = -1e30f;
        f32x4 nn = (f32x4){0.f, 0.f, 0.f, 0.f};
#pragma unroll 1
        for (int cb = 0; cb < NCH64; cb += EX2_UB) {
            u32x2 loc[EX2_UB]; float ft[EX2_UB], ml[EX2_UB]; f32x4 nl[EX2_UB];
            bf16_t* cp = Cst + (size_t)cb * 8192; float* np = Nst + (size_t)cb * 64; float* sp_ = Sst + cb * 4;
#pragma unroll
            for (int u = 0; u < EX2_UB; ++u) {
                loc[u] = *(const u32x2*)(cp + (size_t)u * 8192); ft[u] = sp_[u * 4 + 0]; ml[u] = sp_[u * 4 + 1];
                nl[u] = (f32x4){0.f, 0.f, 0.f, 0.f};
                if (own_n) nl[u] = *(const f32x4*)(np + (size_t)u * 64);
            }
#pragma unroll
            for (int u = 0; u < EX2_UB; ++u) {
                const float ftot = ft[u], mloc = ml[u];
                const float mnew = fmaxf(ftot + m, mloc), sp = __expf(ftot + m - mnew), sl = __expf(mloc - mnew);
                u32x2 o; o.x = pk2(c0_, c1); o.y = pk2(c2, c3);
                *(u32x2*)(cp + (size_t)u * 8192) = o;
                c0_ = sp * c0_ + sl * bflo(loc[u].x); c1 = sp * c1 + sl * bfhi(loc[u].x); c2 = sp * c2 + sl * bflo(loc[u].y); c3 = sp * c3 + sl * bfhi(loc[u].y);
                if (own_n) { *(f32x4*)(np + (size_t)u * 64) = nn; nn = nn * sp + nl[u] * sl; }
                if (own_m) sp_[u * 4 + 2] = m;
                m = mnew;
            }
        }
    }
}

constexpr int X3S_BT = 0, X3S_CT = X3S_BT + 64 * LDTB, X3S_XT = X3S_CT + 64 * LDTB, X3S_HB = X3S_XT + 64 * LDTB, X3S_M = X3S_HB + 64 * LDTB, X3S_CUM = X3S_M + 64 * LDTB, X3S_DTV = X3S_CUM + 256, X3S_ROWS = X3S_DTV + 256, X3S_END = X3S_ROWS + 256;
constexpr int X3M_QT = 0, X3M_KT = X3M_QT + 64 * LDTB, X3M_VT = X3M_KT + 64 * LDTB, X3M_CB = X3M_VT + 64 * LDV, X3M_W = X3M_CB + 128 * LDTB, X3M_ONE = X3M_W + 64 * LDTB, X3M_NB = X3M_ONE + 16 * LDTB,
              X3M_SC = X3M_NB + 16 * LDTB, X3M_END = X3M_SC + 6 * 256;
static_assert(X3M_END <= LDS_BYTES - 16 && X3S_END <= LDS_BYTES - 16, "EX3 LDS maps");
__device__ __forceinline__ void phase_ex3(int wv, KP Pk, int layer, LAS char* lds) {
    asm volatile("" : "+s"(Pk));
    const CAS Params& P = *Pk;
    const int tid = ltid(wv), lane = tid & 63, wid = tid >> 6, q = lane >> 4, r16 = lane & 15, i_ = layer >> 1;
    const bf16_t* XBC = (const bf16_t*)(P.ws + WS_EXBC); const bf16_t* QK = (const bf16_t*)(P.ws + WS_EQK); const bf16_t* Pb = (const bf16_t*)(P.ws + WS_P);
    const float* GT = (const float*)(P.ws + WS_EGT);
    {
        const bf16_t* Hst = (const bf16_t*)(P.ws + WS_XSS);
        struct Set { u32x4 rc[3], rh; float rdt; int rrow; }; Set SA, SB; SA.rdt = SB.rdt = 0.f; SA.rrow = SB.rrow = 0;
        auto geom = [&](int it, int& b, int& h, int& dir, int& c) { const int sq = it / NCH64; c = it - sq * NCH64; b = sq >> 4; h = (sq >> 1) & 7; dir = sq & 1; };
        auto load = [&](int it, Set& S) {
            int b, h, dir, c; geom(it, b, h, dir, c);
            int tl = tid; asm volatile("" : "+v"(tl));
#pragma unroll
            for (int s = 0; s < 3; ++s) {
                const int task = tl + NT * s, j = task / 24, g = task - 24 * j;
                const int row = scan_row(c * CL + j, b, dir, 0);
                S.rc[s] = *(const u32x4*)(XBC + (size_t)row * 768 + (g < 8 ? h * 64 + 8 * g : g < 16 ? 512 + (h >> 2) * 64 + 8 * (g - 8) : 640 + (h >> 2) * 64 + 8 * (g - 16)));
            }
            S.rh = *(const u32x4*)(Hst + (size_t)it * 4096 + tl * 8);
            if (tl < CL) { S.rrow = scan_row(c * CL + tl, b, dir, 0); S.rdt = GT[(size_t)S.rrow * 32 + dir * 8 + h]; }
        };
        auto item = [&](int it, Set& S, int nxt) {
            int b, h, dir, c; geom(it, b, h, dir, c);
            bf16_t* Y = (bf16_t*)(P.ws + (dir ? WS_YB : WS_YF));
            const float aco = -__expf(P.ssd_a_log[(i_ * 2 + dir) * 8 + h]);
            if (tid < CL) {
                const float cum = wave_cumsum(S.rdt * aco, lane);
                ((LAS float*)(lds + X3S_CUM))[tid] = cum; ((LAS float*)(lds + X3S_DTV))[tid] = S.rdt; ((LAS int*)(lds + X3S_ROWS))[tid] = S.rrow;
            }
            __syncthreads();
            {
                int tl = tid; asm volatile("" : "+v"(tl));
#pragma unroll
                for (int s = 0; s < 3; ++s) {
                    const int task = tl + NT * s, j = task / 24, g = task - 24 * j;
                    if (g < 8) {
                        float f[8]; unpack8(S.rc[s], f);
                        const float dt = ((const LAS float*)(lds + X3S_DTV))[j];
#pragma unroll
                        for (int e = 0; e < 8; ++e) f[e] *= dt;
                        *(LAS u32x4*)(lds + X3S_XT + j * LDTB + 16 * g) = pack8(f);
                    } else if (g < 16) *(LAS u32x4*)(lds + X3S_BT + j * LDTB + 8 * (g - 8) * 2) = S.rc[s];
                    else *(LAS u32x4*)(lds + X3S_CT + j * LDTB + 8 * (g - 16) * 2) = S.rc[s];
                }
                *(LAS u32x4*)(lds + X3S_HB + (tl >> 3) * LDTB + (tl & 7) * 16) = S.rh;
            }
            if (nxt < NSSD_ITEMS) load(nxt, S);
            __syncthreads();
            const LAS float* cum = (const LAS float*)(lds + X3S_CUM);
            {
                const int lt = wid >> 1;
#pragma unroll
                for (int u = 0; u < 2; ++u) {
                    const int st = (wid & 1) * 2 + u;
                    f32x4 acc = (f32x4){0.f, 0.f, 0.f, 0.f};
                    if (st <= lt) {
#pragma unroll
                        for (int k0 = 0; k0 < 64; k0 += 32) acc = __builtin_amdgcn_mfma_f32_16x16x32_bf16(ldfrag(lds + X3S_BT, LDTB, st * 16, k0, lane), ldfrag(lds + X3S_CT, LDTB, lt * 16, k0, lane), acc, 0, 0, 0);
                        const int l = lt * 16 + r16, s0 = st * 16 + 4 * q;
                        const float cl = cum[l]; const f32x4 cs = *(const LAS f32x4*)(cum + s0);
#pragma unroll
                        for (int j = 0; j < 4; ++j) acc[j] = (s0 + j <= l) ? acc[j] * __expf(cl - cs[j]) : 0.f;
                    }
                    st4bf(lds + X3S_M + (lt * 16 + r16) * LDTB + (st * 16 + 4 * q) * 2, acc);
                }
            }
            __syncthreads();
            {
                const int lt = wid >> 1, l = lt * 16 + r16;
                const float el = __expf(cum[l]);
                const int row = ((const LAS int*)(lds + X3S_ROWS))[l];
                const bf16x8 mf0 = ldfrag(lds + X3S_M, LDTB, lt * 16, 0, lane), mf1 = ldfrag(lds + X3S_M, LDTB, lt * 16, 32, lane);
                const bf16x8 cf0 = ldfrag(lds + X3S_CT, LDTB, lt * 16, 0, lane), cf1 = ldfrag(lds + X3S_CT, LDTB, lt * 16, 32, lane);
#pragma unroll
                for (int u = 0; u < 2; ++u) {
                    const int pt = (wid & 1) * 2 + u;
                    f32x4 ya = __builtin_amdgcn_mfma_f32_16x16x32_bf16(ldfrag_tr(lds + X3S_XT, LDTB, pt * 16, 0, lane), mf0, (f32x4){0.f, 0.f, 0.f, 0.f}, 0, 0, 0);
                    ya = __builtin_amdgcn_mfma_f32_16x16x32_bf16(ldfrag_tr(lds + X3S_XT, LDTB, pt * 16, 32, lane), mf1, ya, 0, 0, 0);
                    f32x4 oa = __builtin_amdgcn_mfma_f32_16x16x32_bf16(ldfrag(lds + X3S_HB, LDTB, pt * 16, 0, lane), cf0, (f32x4){0.f, 0.f, 0.f, 0.f}, 0, 0, 0);
                    oa = __builtin_amdgcn_mfma_f32_16x16x32_bf16(ldfrag(lds + X3S_HB, LDTB, pt * 16, 32, lane), cf1, oa, 0, 0, 0);
                    u32x2 o; o.x = pk2(ya[0] + el * oa[0], ya[1] + el * oa[1]); o.y = pk2(ya[2] + el * oa[2], ya[3] + el * oa[3]);
                    *(u32x2*)(Y + (size_t)row * D + h * 64 + pt * 16 + 4 * q) = o;
                }
            }
            __syncthreads();
        };
        {
            const int G = gridDim.x; int it = blockIdx.x;
            if (it < NSSD_ITEMS) load(it, SA);
            if (it + G < NSSD_ITEMS) load(it + G, SB);
            __syncthreads();
            for (; it < NSSD_ITEMS; it += 2 * G) {
                item(it, SA, it + 2 * G);
                if (it + G < NSSD_ITEMS) item(it + G, SB, it + 3 * G);
            }
        }
    }
    {
        const bf16_t* Cst = (const bf16_t*)(P.ws + WS_XMC); const float* Nst = (const float*)(P.ws + WS_XMN); const float* Sst = (const float*)(P.ws + WS_XMS); const float* Tst = (const float*)(P.ws + WS_XMT);
        for (int i = tid; i < 16 * LDTB / 4; i += NT) ((LAS unsigned*)(lds + X3M_ONE))[i] = 0x3f803f80u;
        struct Set { u32x4 rc[4], rcb[2]; float rfc, rg, rpm, rmp, rn; int rrow; }; Set SA, SB; SA.rfc = SA.rg = SA.rpm = SA.rmp = SA.rn = SB.rfc = SB.rg = SB.rpm = SB.rmp = SB.rn = 0.f; SA.rrow = SB.rrow = 0;
        auto geom = [&](int it, int& b, int& h, int& dir, int& c) { const int sq = it / NCH64; c = it - sq * NCH64; b = sq >> 3; h = (sq >> 1) & 3; dir = sq & 1; };
        auto load = [&](int it, Set& S) {
            int b, h, dir, c; geom(it, b, h, dir, c);
            int tl = tid; asm volatile("" : "+v"(tl));
#pragma unroll
            for (int s = 0; s < 4; ++s) {
                const int task = tl + NT * s, j = task >> 5, g = task & 31;
                const int row = scan_row(c * CL + j, b, dir, 0);
                S.rc[s] = g < 16 ? *(const u32x4*)(QK + (size_t)row * 512 + (g < 8 ? h * 64 + 8 * g : 256 + h * 64 + 8 * (g - 8))) : *(const u32x4*)(Pb + (size_t)row * LDP_EVEN + 1808 + h * 128 + 8 * (g - 16));
            }
#pragma unroll
            for (int s = 0; s < 2; ++s) S.rcb[s] = *(const u32x4*)(Cst + (size_t)it * 8192 + (tl + NT * s) * 8);
            if (tl < CL) {
                S.rrow = scan_row(c * CL + tl, b, dir, 0);
                const float* tp = Tst + (size_t)it * 192;
                S.rfc = tp[tl]; S.rg = tp[64 + tl]; S.rpm = tp[128 + tl]; S.rmp = Sst[(size_t)it * 4 + 2]; S.rn = Nst[(size_t)it * 64 + tl];
            }
        };
        auto item = [&](int it, Set& S, int nxt) {
            int b, h, dir, c; geom(it, b, h, dir, c);
            bf16_t* Y = (bf16_t*)(P.ws + (dir ? WS_YB : WS_YF));
            LAS float* sc = (LAS float*)(lds + X3M_SC);
            {
                int tl = tid; asm volatile("" : "+v"(tl));
#pragma unroll
                for (int s = 0; s < 4; ++s) {
                    const int task = tl + NT * s, j = task >> 5, g = task & 31;
                    if (g < 8) *(LAS u32x4*)(lds + X3M_QT + j * LDTB + 8 * g * 2) = S.rc[s];
                    else if (g < 16) *(LAS u32x4*)(lds + X3M_KT + j * LDTB + 8 * (g - 8) * 2) = S.rc[s];
                    else {
                        const int v0 = 8 * (g - 16);
#pragma unroll
                        for (int e = 0; e < 1; ++e) *(LAS u32x4*)(lds + X3M_VT + j * LDV + v0 * 2) = S.rc[s];
                    }
                }
#pragma unroll
                for (int s = 0; s < 2; ++s) { const int ch = tl + NT * s; *(LAS u32x4*)(lds + X3M_CB + (ch >> 3) * LDTB + (ch & 7) * 16) = S.rcb[s]; }
                if (tl < CL) {
                    const float linter = S.rfc + S.rmp, mrow = fmaxf(S.rfc + S.rpm, linter);
                    sc[tl] = S.rfc - mrow; sc[64 + tl] = S.rg; sc[128 + tl] = __expf(linter - mrow); sc[192 + tl] = __expf(-mrow); ((LAS int*)sc)[256 + tl] = S.rrow;
                    const bf16_t nb = f2bf(S.rn);
#pragma unroll
                    for (int r = 0; r < 16; ++r) *(LAS bf16_t*)(lds + X3M_NB + r * LDTB + tl * 2) = nb;
                }
            }
            if (nxt < NML_ITEMS) load(nxt, S);
            __syncthreads();
            {
                const int lt = wid >> 1;
#pragma unroll
                for (int u = 0; u < 2; ++u) {
                    const int st = (wid & 1) * 2 + u;
                    f32x4 acc = (f32x4){0.f, 0.f, 0.f, 0.f};
                    if (st <= lt) {
#pragma unroll
                        for (int k0 = 0; k0 < 64; k0 += 32) acc = __builtin_amdgcn_mfma_f32_16x16x32_bf16(ldfrag(lds + X3M_KT, LDTB, st * 16, k0, lane), ldfrag(lds + X3M_QT, LDTB, lt * 16, k0, lane), acc, 0, 0, 0);
                        const int l = lt * 16 + r16, s0 = st * 16 + 4 * q;
                        const float rt = sc[l]; const f32x4 gs = *(const LAS f32x4*)(sc + 64 + s0);
#pragma unroll
                        for (int j = 0; j < 4; ++j) acc[j] = (s0 + j <= l) ? acc[j] * __expf(rt + gs[j]) : 0.f;
                    }
                    st4bf(lds + X3M_W + (lt * 16 + r16) * LDTB + (st * 16 + 4 * q) * 2, acc);
                }
            }
            __syncthreads();
            {
                const int lt = wid >> 1, l = lt * 16 + r16;
                const bf16x8 wf0 = ldfrag(lds + X3M_W, LDTB, lt * 16, 0, lane), wf1 = ldfrag(lds + X3M_W, LDTB, lt * 16, 32, lane);
                const bf16x8 qf0 = ldfrag(lds + X3M_QT, LDTB, lt * 16, 0, lane), qf1 = ldfrag(lds + X3M_QT, LDTB, lt * 16, 32, lane);
                f32x4 da = __builtin_amdgcn_mfma_f32_16x16x32_bf16(ldfrag(lds + X3M_ONE, LDTB, 0, 0, lane), wf0, (f32x4){0.f, 0.f, 0.f, 0.f}, 0, 0, 0);
                da = __builtin_amdgcn_mfma_f32_16x16x32_bf16(ldfrag(lds + X3M_ONE, LDTB, 0, 32, lane), wf1, da, 0, 0, 0);
                f32x4 qn = __builtin_amdgcn_mfma_f32_16x16x32_bf16(ldfrag(lds + X3M_NB, LDTB, 0, 0, lane), qf0, (f32x4){0.f, 0.f, 0.f, 0.f}, 0, 0, 0);
                qn = __builtin_amdgcn_mfma_f32_16x16x32_bf16(ldfrag(lds + X3M_NB, LDTB, 0, 32, lane), qf1, qn, 0, 0, 0);
                const float inter = sc[128 + l], emr = sc[192 + l];
                const float inv = __builtin_amdgcn_rcpf(fmaxf(fabsf(da[0] + inter * qn[0]), emr));
                const int row = ((const LAS int*)sc)[256 + l];
#pragma unroll
                for (int u = 0; u < 4; ++u) {
                    const int vt = (wid & 1) * 4 + u;
                    f32x4 na = __builtin_amdgcn_mfma_f32_16x16x32_bf16(ldfrag_tr(lds + X3M_VT, LDV, vt * 16, 0, lane), wf0, (f32x4){0.f, 0.f, 0.f, 0.f}, 0, 0, 0);
                    na = __builtin_amdgcn_mfma_f32_16x16x32_bf16(ldfrag_tr(lds + X3M_VT, LDV, vt * 16, 32, lane), wf1, na, 0, 0, 0);
                    f32x4 ca = __builtin_amdgcn_mfma_f32_16x16x32_bf16(ldfrag(lds + X3M_CB, LDTB, vt * 16, 0, lane), qf0, (f32x4){0.f, 0.f, 0.f, 0.f}, 0, 0, 0);
                    ca = __builtin_amdgcn_mfma_f32_16x16x32_bf16(ldfrag(lds + X3M_CB, LDTB, vt * 16, 32, lane), qf1, ca, 0, 0, 0);
                    u32x2 o; o.x = pk2((na[0] + inter * ca[0]) * inv, (na[1] + inter * ca[1]) * inv); o.y = pk2((na[2] + inter * ca[2]) * inv, (na[3] + inter * ca[3]) * inv);
                    *(u32x2*)(Y + (size_t)row * D + 512 + h * 128 + vt * 16 + 4 * q) = o;
                }
            }
            __syncthreads();
        };
        {
            const int G = gridDim.x; int it = blockIdx.x;
            if (it < NML_ITEMS) load(it, SA);
            if (it + G < NML_ITEMS) load(it + G, SB);
            __syncthreads();
            for (; it < NML_ITEMS; it += 2 * G) {
                item(it, SA, it + 2 * G);
                if (it + G < NML_ITEMS) item(it + G, SB, it + 3 * G);
            }
        }
    }
}

constexpr int HC_RAWF = 0;
constexpr int HC_RAWQ = HC_RAWF + 64 * 128 * 4;
constexpr int HC_SUB = HC_RAWQ + 64 * 128 * 2;
constexpr int HL_QD = 136 * 2;
constexpr int HL_T = 24 * 2;
constexpr int HS_QI = 0, HS_KO = HS_QI + 16 * HL_QD, HS_KET = HS_KO + 16 * HL_QD, HS_ATT = HS_KET + 128 * HL_T, HS_VT = HS_ATT + 16 * HL_T, HS_DEC = HS_VT + 32 * HL_T, HS_SIZE = HS_DEC + 512;
constexpr int HC_SB = HC_SUB + 4 * HS_SIZE;
constexpr int HC_ROWS = HC_SB + 2 * 32 * HL_QD, HC_CST = HC_ROWS + 256, HC_END = HC_CST + 1024;
static_assert(HC_END <= LDS_BYTES - 16, "HGRN2 LDS map");
static_assert(HS_SIZE % 16 == 0 && HC_SB % 16 == 0, "alignment");
__device__ __forceinline__ bf16x8 ldfrag16(const LAS char* tile, int ldb, int row0, int lane) {
    bf16x8 v = *(const LAS bf16x8*)(tile + (row0 + (lane & 15)) * ldb + ((lane >> 4) & 1) * 16);
    if (lane >= 32) v = (bf16x8){0, 0, 0, 0, 0, 0, 0, 0};
    return v;
}
__device__ __forceinline__ void scan_hgrn_c(int wv, KP Pk, int layer, int unit, LAS char* lds) {
    asm volatile("" : "+s"(Pk));
    const CAS Params& P = *Pk;
    const int tid = ltid(wv), lane = tid & 63, wid = tid >> 6, q = lane >> 4, r16 = lane & 15, i_ = layer >> 1;
    const int seq = unit >> 2, quarter = unit & 3, b = seq >> 3, h = (seq >> 1) & 3, dir = seq & 1;
    const bf16_t* Pb = (const bf16_t*)(P.ws + WS_P);
    bf16_t* Y = (bf16_t*)(P.ws + (dir ? WS_YB : WS_YF));
    LAS float* cst = (LAS float*)(lds + HC_CST);
    if (tid < 128) cst[tid] = ((const float*)(P.ws + WS_LB))[layer * 512 + h * 128 + tid];
    else if (tid < 256) cst[tid] = P.hg_f_bias[(size_t)(i_ * 2 + dir) * 512 + h * 128 + tid - 128];
    for (int i = tid; i < 2 * 32 * HL_QD / 4; i += NT) ((LAS unsigned*)(lds + HC_SB))[i] = 0u;
    int tj[5], tg_[5], tcol[5]; bool tv[5];
#pragma unroll
    for (int s = 0; s < 5; ++s) {
        const int task = tid + NT * s; tv[s] = task < 64 * 36; tj[s] = task / 36; tg_[s] = task % 36;
        const int g = tg_[s];
        tcol[s] = g < 16 ? (512 + dir * 512 + h * 128 + 8 * g) : g < 32 ? (h * 128 + 8 * (g - 16)) : (1536 + h * 128 + quarter * 32 + 8 * (g - 32));
    }
    u32x4 rc[5]; int rrow = 0;
    auto load = [&](int c) {
#pragma unroll
        for (int s = 0; s < 5; ++s) {
            rc[s] = (u32x4){0u, 0u, 0u, 0u};
            if (tv[s]) { const int row = scan_row(c * 64 + tj[s], b, dir, 1); rc[s] = *(const u32x4*)(Pb + (size_t)row * LDP_ODD + tcol[s]); }
        }
        if (tid < 64) rrow = scan_row(c * 64 + tid, b, dir, 1);
    };
    auto storeA = [&]() {
#pragma unroll
        for (int s = 0; s < 5; ++s) {
            if (tv[s]) {
                float f[8]; unpack8(rc[s], f);
                const int j = tj[s], g = tg_[s];
                if (g < 16) {
                    float o[8];
#pragma unroll
                    for (int e = 0; e < 8; ++e) { const float lbv = cst[8 * g + e]; o[e] = lbv + (1.f - lbv) * sigmoidf_(f[e] + cst[128 + 8 * g + e]); }
                    LAS float* dst = (LAS float*)(lds + HC_RAWF) + j * 128 + 8 * g;
                    *(LAS f32x4*)dst = (f32x4){o[0], o[1], o[2], o[3]}; *(LAS f32x4*)(dst + 4) = (f32x4){o[4], o[5], o[6], o[7]};
                } else if (g < 32) {
                    float o[8];
#pragma unroll
                    for (int e = 0; e < 8; ++e) o[e] = siluf_(f[e]);
                    *(LAS u32x4*)(lds + HC_RAWQ + (j * 128 + 8 * (g - 16)) * 2) = pack8(o);
                } else {
                    const int v0 = 8 * (g - 32);
                    LAS char* vt = lds + HC_SUB + (j >> 4) * HS_SIZE + HS_VT;
#pragma unroll
                    for (int e = 0; e < 8; ++e) { const unsigned wv = rc[s][e >> 1]; *(LAS bf16_t*)(vt + (v0 + e) * HL_T + (j & 15) * 2) = (bf16_t)((e & 1) ? (wv >> 16) : (wv & 0xffffu)); }
                }
            }
        }
        if (tid < 64) ((LAS int*)(lds + HC_ROWS))[tid] = rrow;
    };
    auto storeB = [&]() {
        const int d = tid & 127, sb = tid >> 7;
        LAS char* st = lds + HC_SUB + sb * HS_SIZE;
        const LAS float* rf = (const LAS float*)(lds + HC_RAWF) + (sb * 16) * 128 + d;
        const LAS bf16_t* rq = (const LAS bf16_t*)(lds + HC_RAWQ) + (sb * 16) * 128 + d;
        float E = 1.f, einv[16], kfs[16];
#pragma unroll
        for (int t = 0; t < 16; ++t) {
            const float f = rf[t * 128];
            E *= f;
            const float kf = 1.f - f, ei = __builtin_amdgcn_rcpf(E);
            einv[t] = ei; kfs[t] = kf;
            *(LAS bf16_t*)(st + HS_QI + t * HL_QD + d * 2) = f2bf(bf2f(rq[t * 128]) * E);
            *(LAS bf16_t*)(st + HS_KO + t * HL_QD + d * 2) = f2bf(kf * ei);
        }
        float ke[16];
#pragma unroll
        for (int t = 0; t < 16; ++t) ke[t] = kfs[t] * (E * einv[t]);
        *(LAS u32x4*)(st + HS_KET + d * HL_T) = pack8(ke); *(LAS u32x4*)(st + HS_KET + d * HL_T + 16) = pack8(ke + 8);
        ((LAS float*)(st + HS_DEC))[d] = E;
    };
    f32x4 sacc[2];
    sacc[0] = sacc[1] = (f32x4){0.f, 0.f, 0.f, 0.f};
    __syncthreads();
    load(0);
    for (int c = 0; c < NSTEPS / 64; ++c) {
        storeA();
        __syncthreads();
        storeB();
        if (c + 1 < NSTEPS / 64) load(c + 1);
        __syncthreads();
        if (wid < 4) {
            LAS char* st = lds + HC_SUB + wid * HS_SIZE;
            f32x4 acc = (f32x4){0.f, 0.f, 0.f, 0.f};
#pragma unroll
            for (int k0 = 0; k0 < 128; k0 += 32) acc = __builtin_amdgcn_mfma_f32_16x16x32_bf16(ldfrag(st + HS_KO, HL_QD, 0, k0, lane), ldfrag(st + HS_QI, HL_QD, 0, k0, lane), acc, 0, 0, 0);
#pragma unroll
            for (int j = 0; j < 4; ++j) acc[j] = (4 * q + j <= r16) ? acc[j] : 0.f;
            st4bf(st + HS_ATT + r16 * HL_T + 4 * q * 2, acc);
        }
        __syncthreads();
#pragma unroll 1
        for (int sb = 0; sb < 4; ++sb) {
            LAS char* st = lds + HC_SUB + sb * HS_SIZE;
            const LAS char* sbr = lds + HC_SB + (sb & 1) * 32 * HL_QD;
            LAS char* sbw = lds + HC_SB + ((sb + 1) & 1) * 32 * HL_QD;
            if (wid < 2) {
                f32x4 ya = __builtin_amdgcn_mfma_f32_16x16x32_bf16(ldfrag16(st + HS_VT, HL_T, wid * 16, lane), ldfrag16(st + HS_ATT, HL_T, 0, lane), (f32x4){0.f, 0.f, 0.f, 0.f}, 0, 0, 0);
#pragma unroll
                for (int k0 = 0; k0 < 128; k0 += 32) ya = __builtin_amdgcn_mfma_f32_16x16x32_bf16(ldfrag(sbr, HL_QD, wid * 16, k0, lane), ldfrag(st + HS_QI, HL_QD, 0, k0, lane), ya, 0, 0, 0);
                const int row = ((const LAS int*)(lds + HC_ROWS))[sb * 16 + r16];
                u32x2 o; o.x = pk2(ya[0], ya[1]); o.y = pk2(ya[2], ya[3]);
                *(u32x2*)(Y + (size_t)row * D + h * 128 + quarter * 32 + wid * 16 + 4 * q) = o;
            }
            {
                const int vt = wid >> 2;
                const bf16x8 vf = ldfrag16(st + HS_VT, HL_T, vt * 16, lane);
#pragma unroll
                for (int u = 0; u < 2; ++u) {
                    const int dt = (wid & 3) * 2 + u;
                    const f32x4 a = __builtin_amdgcn_mfma_f32_16x16x32_bf16(ldfrag16(st + HS_KET, HL_T, dt * 16, lane), vf, (f32x4){0.f, 0.f, 0.f, 0.f}, 0, 0, 0);
                    const f32x4 dc = *(const LAS f32x4*)((const LAS float*)(st + HS_DEC) + dt * 16 + 4 * q);
#pragma unroll
                    for (int j = 0; j < 4; ++j) sacc[u][j] = sacc[u][j] * dc[j] + a[j];
                    st4bf(sbw + (vt * 16 + r16) * HL_QD + (dt * 16 + 4 * q) * 2, sacc[u]);
                }
            }
            __syncthreads();
        }
    }
}

constexpr int RC_RAWW = 0;
constexpr int RC_RAWA = RC_RAWW + 64 * 64 * 4;
constexpr int RC_RAWB = RC_RAWA + 64 * 64 * 2, RC_RAWK = RC_RAWB + 64 * 64 * 2, RC_RAWR = RC_RAWK + 64 * 64 * 2;
constexpr int RC_SUB = RC_RAWR + 64 * 64 * 2;
constexpr int RL_C = 72 * 2, RL_32 = 40 * 2, RL_16 = 24 * 2;
constexpr int RS_AT = 0, RS_RT = RS_AT + 16 * RL_C, RS_KT = RS_RT + 16 * RL_C, RS_BT = RS_KT + 16 * RL_C, RS_KBH = RS_BT + 16 * RL_C, RS_AAK = RS_KBH + 64 * RL_32,
              RS_ARKB = RS_AAK + 16 * RL_16, RS_T = RS_ARKB + 16 * RL_32, RS_AABF = RS_T + 16 * RL_16, RS_GL = RS_AABF + 16 * 16 * 4, RS_VU = RS_GL + 256, RS_SIZE = RS_VU + 32 * RL_32;
constexpr int RC_SB = RC_SUB + 4 * RS_SIZE;
constexpr int RC_RHT = RC_SB + 32 * RL_C;
constexpr int RC_ROWS = RC_RHT + 32 * RL_16, RC_END = RC_ROWS + 256;
static_assert(RC_END <= LDS_BYTES - 16, "RWKV LDS map");
static_assert(RS_SIZE % 16 == 0 && RC_SB % 16 == 0 && RC_RHT % 16 == 0, "alignment");


__device__ __forceinline__ void phase_prep1(int wv, KP Pk, int layer) {
    asm volatile("" : "+s"(Pk));
    const CAS Params& P = *Pk;
    const int tid = ltid(wv), lane = tid & 63, wid = tid >> 6, i_ = layer >> 1;
    const bf16_t* Pb = (const bf16_t*)(P.ws + WS_P);
    bf16_t* R = (bf16_t*)(P.ws + WS_RWR); bf16_t* K = (bf16_t*)(P.ws + WS_RWK); bf16_t* V = (bf16_t*)(P.ws + WS_RWV); bf16_t* KK = (bf16_t*)(P.ws + WS_RWKK);
    bf16_t* LA = (bf16_t*)(P.ws + WS_LA);
    const float* mu = P.rw_mu + (size_t)i_ * 1856;
    float mur[8], muv[8], muk[8], mul_[8], kkw[8];
#pragma unroll
    for (int e = 0; e < 8; ++e) { mur[e] = mu[8 * lane + e]; muv[e] = mu[1024 + 8 * lane + e]; muk[e] = mu[512 + 8 * lane + e]; mul_[e] = lane < 40 ? mu[1536 + 8 * lane + e] : 0.f; kkw[e] = P.rw_k_k[i_ * 512 + 8 * lane + e]; }
    u32x4 nq[4][3]; float nmp = 0.f, nmn = 0.f;
    auto fetch = [&](int r) {
        int rprev = -1, rnext = -1;
        if (r < NCTX) { const int t = r & 255; if (t > 0) rprev = r - 1; if (t < CTXL - 1) rnext = r + 1; }
        else {
            const int bs = (r - NCTX) >> 13, s = (r - NCTX) & 8191, sg = ((s & 63) << 7) + (s >> 6);
            if (sg > 0) { const int g2 = sg - 1; rprev = NCTX + bs * SEQ + ((g2 & 127) << 6) + (g2 >> 7); }
            if (sg < SEQ - 1) { const int g2 = sg + 1; rnext = NCTX + bs * SEQ + ((g2 & 127) << 6) + (g2 >> 7); }
        }
        const bf16_t* pc = Pb + (size_t)r * LDP_ODD + 2560;
        const bf16_t* pp = Pb + (size_t)(rprev < 0 ? r : rprev) * LDP_ODD + 2560;
        const bf16_t* pn = Pb + (size_t)(rnext < 0 ? r : rnext) * LDP_ODD + 2560;
        nmp = rprev < 0 ? 0.f : 0.5f; nmn = rnext < 0 ? 0.f : 0.5f;
#pragma unroll
        for (int gq = 0; gq < 4; ++gq) {
            const int col = (gq == 0 ? 0 : gq == 1 ? 1024 : gq == 2 ? 512 : 1536) + 8 * lane;
            if (gq < 3 || lane < 40) { nq[gq][0] = *(const u32x4*)(pc + col); nq[gq][1] = *(const u32x4*)(pp + col); nq[gq][2] = *(const u32x4*)(pn + col); }
        }
    };
    nq[3][0] = nq[3][1] = nq[3][2] = (u32x4){0u, 0u, 0u, 0u};
    const int stride = gridDim.x * 8;
    int r = blockIdx.x * 8 + wid;
    if (r < NROWS) fetch(r);
    for (; r < NROWS; r += stride) {
        u32x4 cq[4][3];
#pragma unroll
        for (int gq = 0; gq < 4; ++gq)
#pragma unroll
            for (int k = 0; k < 3; ++k) cq[gq][k] = nq[gq][k];
        const float mp = nmp, mn = nmn;
        if (r + stride < NROWS) fetch(r + stride);
        auto mix8 = [&](const u32x4 (&c)[3], const float* muc, float* o) {
            float fc[8], fp[8], fn[8];
            unpack8(c[0], fc); unpack8(c[1], fp); unpack8(c[2], fn);
#pragma unroll
            for (int e = 0; e < 8; ++e) o[e] = fc[e] + muc[e] * (mp * fp[e] + mn * fn[e] - fc[e]);
        };
        float o[8];
        mix8(cq[0], mur, o); *(u32x4*)(R + (size_t)r * 512 + 8 * lane) = pack8(o);
        mix8(cq[1], muv, o); *(u32x4*)(V + (size_t)r * 512 + 8 * lane) = pack8(o);
        mix8(cq[2], muk, o); *(u32x4*)(K + (size_t)r * 512 + 8 * lane) = pack8(o);
        {
            float kk[8], ss = 0.f;
#pragma unroll
            for (int e = 0; e < 8; ++e) { kk[e] = o[e] * kkw[e]; ss += kk[e] * kk[e]; }
            ss = group_sum<8>(ss);
            const float rn = rsqrtf(fmaxf(ss, 1e-12f));
#pragma unroll
            for (int e = 0; e < 8; ++e) kk[e] *= rn;
            *(u32x4*)(KK + (size_t)r * 512 + 8 * lane) = pack8(kk);
        }
        if (lane < 40) {
            mix8(cq[3], mul_, o);
            if (lane < 16) {
#pragma unroll
                for (int e = 0; e < 8; ++e) o[e] = tanh_fast(o[e]);
            } else if (lane >= 24) {
#pragma unroll
                for (int e = 0; e < 8; ++e) o[e] = sigmoidf_(o[e]);
            }
            *(u32x4*)(LA + (size_t)r * 320 + 8 * lane) = pack8(o);
        }
    }
}

__device__ __forceinline__ void phase_out_even(int wv, KP Pk, int layer) {
    asm volatile("" : "+s"(Pk));
    const CAS Params& P = *Pk;
    const int tid = ltid(wv), lane = tid & 63, wid = tid >> 6, i_ = layer >> 1;
    const bf16_t* Pb = (const bf16_t*)(P.ws + WS_P);
    const bf16_t* Yf = (const bf16_t*)(P.ws + WS_YF); const bf16_t* Yb = (const bf16_t*)(P.ws + WS_YB);
    bf16_t* feat = (bf16_t*)(P.ws + WS_FEAT);
    const int r0 = (layer == DEPTH - 1) ? NCTX : 0;
    const bf16_t* XBC = (const bf16_t*)(P.ws + WS_EXBC);
    float nwa[8], nwb[8];
#pragma unroll
    for (int e = 0; e < 8; ++e) { nwa[e] = P.ssd_norm_w[i_ * 512 + 8 * lane + e]; nwb[e] = P.ml_norm_w[i_ * 512 + 8 * lane + e]; }
    const float dsk = P.ssd_d[i_ * 8 + (lane >> 3)];
    u32x4 n0, n1, n2, n3, n4, n5, n6;
    auto fetch = [&](int rr) {
        const bf16_t* pr = Pb + (size_t)rr * LDP_EVEN;
        n0 = *(const u32x4*)(Yf + (size_t)rr * D + 8 * lane); n1 = *(const u32x4*)(Yb + (size_t)rr * D + 8 * lane);
        n2 = *(const u32x4*)(XBC + (size_t)rr * 768 + 8 * lane); n3 = *(const u32x4*)(pr + 8 * lane);
        n4 = *(const u32x4*)(Yf + (size_t)rr * D + 512 + 8 * lane); n5 = *(const u32x4*)(Yb + (size_t)rr * D + 512 + 8 * lane); n6 = *(const u32x4*)(pr + 2320 + 8 * lane);
    };
    const int stride = gridDim.x * 8;
    int r = r0 + blockIdx.x * 8 + wid;
    if (r < NROWS) fetch(r);
    for (; r < NROWS; r += stride) {
        const u32x4 c0 = n0, c1 = n1, c2 = n2, c3 = n3, c4 = n4, c5 = n5, c6 = n6;
        if (r + stride < NROWS) fetch(r + stride);
        float y[8];
        {
            float a[8], bb[8], xsv[8], z[8];
            unpack8(c0, a); unpack8(c1, bb);
            unpack8(c2, xsv); unpack8(c3, z);
            float ss = 0.f;
#pragma unroll
            for (int e = 0; e < 8; ++e) {
                y[e] = (a[e] + bb[e] + dsk * xsv[e]) * siluf_(z[e]); ss += y[e] * y[e];
            }
            ss = wave_sum(ss);
            const float rn = rsqrtf(ss * (1.f / 512.f) + 1e-6f);
#pragma unroll
            for (int e = 0; e < 8; ++e) y[e] = y[e] * rn * nwa[e];
            *(u32x4*)(feat + (size_t)r * D + 8 * lane) = pack8(y);
        }
        {
            float a[8], bb[8], o[8];
            unpack8(c4, a); unpack8(c5, bb);
            unpack8(c6, o);
            float s = 0.f;
#pragma unroll
            for (int e = 0; e < 8; ++e) { y[e] = a[e] + bb[e]; s += y[e]; }
            const float mean = group_sum<16>(s) * (1.f / 128.f);
            float ss = 0.f;
#pragma unroll
            for (int e = 0; e < 8; ++e) { y[e] -= mean; ss += y[e] * y[e]; }
            const float rn = rsqrtf(group_sum<16>(ss) * (1.f / 128.f) + 1e-6f);
#pragma unroll
            for (int e = 0; e < 8; ++e) y[e] = sigmoidf_(o[e]) * (y[e] * rn) * nwb[e];
            *(u32x4*)(feat + (size_t)r * D + 512 + 8 * lane) = pack8(y);
        }
    }
}
__device__ __forceinline__ void phase_out_odd(int wv, KP Pk, int layer) {
    asm volatile("" : "+s"(Pk));
    const CAS Params& P = *Pk;
    const int tid = ltid(wv), lane = tid & 63, wid = tid >> 6, i_ = layer >> 1;
    const bf16_t* Pb = (const bf16_t*)(P.ws + WS_P);
    const bf16_t* Yf = (const bf16_t*)(P.ws + WS_YF); const bf16_t* Yb = (const bf16_t*)(P.ws + WS_YB);
    const bf16_t* R = (const bf16_t*)(P.ws + WS_RWR); const bf16_t* K = (const bf16_t*)(P.ws + WS_RWK); const bf16_t* V = (const bf16_t*)(P.ws + WS_RWV); const bf16_t* G = (const bf16_t*)(P.ws + WS_RWG);
    bf16_t* feat = (bf16_t*)(P.ws + WS_FEAT);
    const int r0 = (layer == DEPTH - 1) ? NCTX : 0;
    float nwc[8], rk[8], lw[8], lbv[8];
#pragma unroll
    for (int e = 0; e < 8; ++e) {
        nwc[e] = P.hg_norm_w[i_ * 512 + 8 * lane + e]; rk[e] = P.rw_r_k[i_ * 512 + 8 * lane + e];
        lw[e] = P.rw_ln_w[i_ * 512 + 8 * lane + e]; lbv[e] = P.rw_ln_b[i_ * 512 + 8 * lane + e];
    }
    u32x4 n0, n1, n2, n3, n4, n5, n6, n7, n8;
    auto fetch = [&](int rr) {
        n0 = *(const u32x4*)(Yf + (size_t)rr * D + 8 * lane); n1 = *(const u32x4*)(Yb + (size_t)rr * D + 8 * lane); n2 = *(const u32x4*)(Pb + (size_t)rr * LDP_ODD + 2048 + 8 * lane);
        n3 = *(const u32x4*)(Yf + (size_t)rr * D + 512 + 8 * lane); n4 = *(const u32x4*)(Yb + (size_t)rr * D + 512 + 8 * lane);
        n5 = *(const u32x4*)(R + (size_t)rr * 512 + 8 * lane); n6 = *(const u32x4*)(K + (size_t)rr * 512 + 8 * lane);
        n7 = *(const u32x4*)(V + (size_t)rr * 512 + 8 * lane); n8 = *(const u32x4*)(G + (size_t)rr * 512 + 8 * lane);
    };
    const int stride = gridDim.x * 8;
    int r = r0 + blockIdx.x * 8 + wid;
    if (r < NROWS) fetch(r);
    for (; r < NROWS; r += stride) {
        const u32x4 c0 = n0, c1 = n1, c2 = n2, c3 = n3, c4 = n4, c5 = n5, c6 = n6, c7 = n7, c8 = n8;
        if (r + stride < NROWS) fetch(r + stride);
        float y[8];
        {
            float a[8], bb[8], g[8];
            unpack8(c0, a); unpack8(c1, bb);
            unpack8(c2, g);
            float ss = 0.f;
#pragma unroll
            for (int e = 0; e < 8; ++e) { y[e] = a[e] + bb[e]; ss += y[e] * y[e]; }
            const float rn = rsqrtf(group_sum<16>(ss) * (1.f / 128.f) + 1e-6f);
#pragma unroll
            for (int e = 0; e < 8; ++e) y[e] = y[e] * rn * nwc[e] * siluf_(g[e]);
            *(u32x4*)(feat + (size_t)r * D + 8 * lane) = pack8(y);
        }
        {
            float a[8], bb[8], rr[8], kk[8], vv[8], g[8];
            unpack8(c3, a); unpack8(c4, bb);
            unpack8(c5, rr); unpack8(c6, kk);
            unpack8(c7, vv); unpack8(c8, g);
            float s = 0.f, bs = 0.f;
#pragma unroll
            for (int e = 0; e < 8; ++e) { y[e] = a[e] + bb[e]; s += y[e]; bs += rr[e] * kk[e] * rk[e]; }
            const float mean = group_sum<8>(s) * (1.f / 64.f); bs = group_sum<8>(bs);
            float ss = 0.f;
#pragma unroll
            for (int e = 0; e < 8; ++e) { y[e] -= mean; ss += y[e] * y[e]; }
            const float rn = rsqrtf(group_sum<8>(ss) * (1.f / 64.f) + 64e-5f);
#pragma unroll
            for (int e = 0; e < 8; ++e) y[e] = (y[e] * rn * lw[e] + lbv[e] + bs * vv[e]) * g[e];
            *(u32x4*)(feat + (size_t)r * D + 512 + 8 * lane) = pack8(y);
        }
    }
}

#ifndef MK_DOUBLE
#define MK_DOUBLE 0
#endif
#define REP(bit, body) do { body; if (MK_DOUBLE & (bit)) { body; } } while (0)
__device__ __forceinline__ void phase_expconv(int wv, KP Pk, int layer, LAS char* lds) {
    asm volatile("" : "+s"(Pk));
    const CAS Params& P = *Pk;
    const int tid = ltid(wv);
    if (layer & 1) return;
    expconv_items(P, layer, lds, exc_s0(layer) + exc_s1(layer), EXC_ITEMS, (int)blockIdx.x * 8 + (tid >> 6), (int)gridDim.x * 8, tid >> 6, tid & 63);
}
__device__ __forceinline__ void expconv_after_scan(int wv, KP Pk, int layer, LAS char* lds) {
    asm volatile("" : "+s"(Pk));
    const CAS Params& P = *Pk;
    const int tid = ltid(wv);
    __syncthreads();
    expconv_items(P, layer, lds, exc_s0(layer) + exc_s1(layer), EXC_ITEMS, (int)blockIdx.x * 8 + (tid >> 6), 128 * 8, tid >> 6, tid & 63);
}
constexpr int L1_AST = 1028;
constexpr int L1_PST = 33;
constexpr int L1_A = 0, L1_PART = L1_A + 16 * L1_AST * 4, L1_SM = L1_PART + 8 * 16 * L1_PST * 4, L1_END = L1_SM + (64 + 2 * 144 + 32) * 4;
static_assert(L1_END <= LDS_BYTES - 16, "LN1 LDS map");
__device__ __forceinline__ void phase_ln1(int wv, KP Pk, int layer, LAS char* lds, bool dry = false) {
    asm volatile("" : "+s"(Pk));
    const CAS Params& P = *Pk;
    const int tid = ltid(wv), lane = tid & 63;
    if (!dry) REP(8, phase_expconv(wv, Pk, layer, lds));
    __syncthreads();
    LAS float* At = (LAS float*)(lds + L1_A);
    LAS float* part = (LAS float*)(lds + L1_PART);
    LAS int* lcnt = (LAS int*)(lds + L1_SM);
    LAS int* lbase = lcnt + 32;
    LAS int* asg = lcnt + 64;
    LAS float* rbias = (LAS float*)(asg + 2 * 144);
    if (tid < 32) { lcnt[tid] = 0; rbias[tid] = P.router_bias[tid]; }
    float breg[8][4][2];
    {
        const float* rw = P.router_w + (size_t)(128 * wv + 4 * (lane >> 4)) * NEXP + (lane & 15);
#pragma unroll
        for (int j = 0; j < 8; ++j)
#pragma unroll
            for (int i = 0; i < 4; ++i) { breg[j][i][0] = rw[(16 * j + i) * NEXP]; breg[j][i][1] = rw[(16 * j + i) * NEXP + 16]; }
    }
    __syncthreads();
    const bf16_t* yo = (const bf16_t*)(P.ws + WS_YO);
    bf16_t* act = (bf16_t*)(P.ws + (dry ? WS_FEAT : WS_ACT));
    bf16_t* xcb = (bf16_t*)(P.ws + WS_XC); bf16_t* xob = (bf16_t*)P.out;
    const bool lastl = (layer == DEPTH - 1);
    int* cnt = (int*)(P.ws + WS_CNT) + layer * 32 * CNT_STRIDE;
    int* list = (int*)(P.ws + WS_LIST);
    float* wts = (float*)(P.ws + WS_WTS);
    const float* lg = P.ln_g + (size_t)(layer * 2 + 0) * D; const float* lb = P.ln_b + (size_t)(layer * 2 + 0) * D;
    const int r0 = (layer == DEPTH - 1) ? NCTX : 0, ntiles = (NROWS - r0) / 16, G = gridDim.x;
    f32x4 g1v[4], s2c[4], h2c[4];
#pragma unroll
    for (int i = 0; i < 4; ++i) g1v[i] = s2c[i] = h2c[i] = (f32x4){0.f, 0.f, 0.f, 0.f};
    int mcur = -1;
    f32x4 nx[2][4]; u32x2 nyo[2][4];
    auto fetch = [&](int s, int rr) {
        if (layer == 0) {
            const float* xq = rr < NCTX ? P.ctx + (size_t)rr * D : P.x + (size_t)(rr - NCTX) * D;
#pragma unroll
            for (int i = 0; i < 4; ++i) nx[s][i] = *(const f32x4*)(xq + 4 * lane + 256 * i);
        } else {
            const bf16_t* xq = rr < NCTX ? xcb + (size_t)rr * D : xob + (size_t)(rr - NCTX) * D;
#pragma unroll
            for (int i = 0; i < 4; ++i) { const u32x2 t = *(const u32x2*)(xq + 4 * lane + 256 * i); nx[s][i] = (f32x4){__uint_as_float(t.x), __uint_as_float(t.y), 0.f, 0.f}; }
        }
#pragma unroll
        for (int i = 0; i < 4; ++i) { const int c = 4 * lane + 256 * i; nyo[s][i] = *(const u32x2*)(yo + (size_t)rr * D + c); }
    };
    int tile = blockIdx.x;
    if (tile < ntiles) { fetch(0, r0 + tile * 16 + 2 * wv); fetch(1, r0 + tile * 16 + 2 * wv + 1); }
    for (int it = 0; tile < ntiles; ++it, tile += G) {
        const int rb = r0 + tile * 16 + 2 * wv;
        const int m = row_mod(rb);
        if (m != mcur) {
            mcur = m;
            const float* g1 = modvec(P.ws, layer, m, 2); const float* sh2 = modvec(P.ws, layer, m, 3); const float* sc2 = modvec(P.ws, layer, m, 4);
#pragma unroll
            for (int i = 0; i < 4; ++i) { const int c = 4 * lane + 256 * i; g1v[i] = *(const f32x4*)(g1 + c); s2c[i] = *(const f32x4*)(sc2 + c); h2c[i] = *(const f32x4*)(sh2 + c); }
        }
#pragma unroll
        for (int s = 0; s < 2; ++s) {
            const int r = rb + s;
            bf16_t* xr = dry ? (bf16_t*)(P.ws + WS_YF) + (size_t)r * D : lastl ? (bf16_t*)(P.ws + WS_FEAT) + (size_t)r * D : r < NCTX ? xcb + (size_t)r * D : xob + (size_t)(r - NCTX) * D;
            f32x4 v[4]; float sm = 0.f;
#pragma unroll
            for (int i = 0; i < 4; ++i) {
                f32x4 xv = nx[s][i]; const f32x4 gv = g1v[i]; const u32x2 yv = nyo[s][i];
                if (layer != 0) { const unsigned b0 = __float_as_uint(xv[0]), b1 = __float_as_uint(xv[1]); xv = (f32x4){bflo(b0), bfhi(b0), bflo(b1), bfhi(b1)}; }
                v[i][0] = ALPHA * xv[0] + gv[0] * bflo(yv.x); v[i][1] = ALPHA * xv[1] + gv[1] * bfhi(yv.x);
                v[i][2] = ALPHA * xv[2] + gv[2] * bflo(yv.y); v[i][3] = ALPHA * xv[3] + gv[3] * bfhi(yv.y);
                sm += (v[i][0] + v[i][1]) + (v[i][2] + v[i][3]);
            }
            if (tile + G < ntiles) fetch(s, r + G * 16);
            const float mean = wave_sum(sm) * (1.f / D);
            float s2 = 0.f;
#pragma unroll
            for (int i = 0; i < 4; ++i) { v[i] = v[i] - mean; s2 += (v[i][0] * v[i][0] + v[i][1] * v[i][1]) + (v[i][2] * v[i][2] + v[i][3] * v[i][3]); }
            const float rstd = rsqrtf(wave_sum(s2) * (1.f / D) + 1e-5f);
            LAS float* arow = At + (2 * wv + s) * L1_AST;
#pragma unroll
            for (int i = 0; i < 4; ++i) {
                const int c = 4 * lane + 256 * i;
                const f32x4 gg = *(const f32x4*)(lg + c), bb = *(const f32x4*)(lb + c), s2v = s2c[i], h2v = h2c[i];
                f32x4 xn, hv;
#pragma unroll
                for (int j = 0; j < 4; ++j) { xn[j] = v[i][j] * rstd * gg[j] + bb[j]; hv[j] = xn[j] * (1.f + s2v[j]) + h2v[j]; }
                { u32x2 ox; ox.x = pk2(xn[0], xn[1]); ox.y = pk2(xn[2], xn[3]); *(u32x2*)(xr + c) = ox; }
                u32x2 o; o.x = pk2(hv[0], hv[1]); o.y = pk2(hv[2], hv[3]); *(u32x2*)(act + (size_t)r * D + c) = o;
                *(LAS f32x4*)(arow + c) = hv;
            }
        }
        __syncthreads();
        {
            f32x4 ra0 = (f32x4){0.f, 0.f, 0.f, 0.f}, ra1 = ra0;
            const LAS float* ap = At + (lane & 15) * L1_AST + 128 * wv + 4 * (lane >> 4);
#pragma unroll
            for (int j = 0; j < 8; ++j) {
                const f32x4 a4 = *(const LAS f32x4*)(ap + 16 * j);
#pragma unroll
                for (int i = 0; i < 4; ++i) {
                    ra0 = __builtin_amdgcn_mfma_f32_16x16x4f32(a4[i], breg[j][i][0], ra0, 0, 0, 0);
                    ra1 = __builtin_amdgcn_mfma_f32_16x16x4f32(a4[i], breg[j][i][1], ra1, 0, 0, 0);
                }
            }
            LAS float* pw = part + wv * 16 * L1_PST + (4 * (lane >> 4)) * L1_PST + (lane & 15);
#pragma unroll
            for (int j = 0; j < 4; ++j) { pw[j * L1_PST] = ra0[j]; pw[j * L1_PST + 16] = ra1[j]; }
        }
        __syncthreads();
        {
            const int half = lane >> 5, e = lane & 31;
            const LAS float* pp = part + (2 * wv + half) * L1_PST + e;
            float sc_ = 0.f;
#pragma unroll
            for (int k = 0; k < 8; ++k) sc_ += pp[k * 16 * L1_PST];
            const float sg = sigmoidf_(sc_), vb = sg + rbias[e];
            float bv[4], sv[4];
            bv[0] = dppmov<0x00>(vb); bv[1] = dppmov<0x55>(vb); bv[2] = dppmov<0xAA>(vb); bv[3] = dppmov<0xFF>(vb);
            sv[0] = dppmov<0x00>(sg); sv[1] = dppmov<0x55>(sg); sv[2] = dppmov<0xAA>(sg); sv[3] = dppmov<0xFF>(sg);
            float m1 = -1e30f, m2 = -1e30f;
#pragma unroll
            for (int k = 0; k < 4; ++k) { const float vsc = bv[k]; if (vsc > m1) { m2 = m1; m1 = vsc; } else if (vsc > m2) m2 = vsc; }
            float best = m1 + m2; int bg = e >> 2;
#pragma unroll
            for (int msk = 4; msk <= 16; msk <<= 1) {
                const float ob = __shfl_xor(best, msk); const int og = __shfl_xor(bg, msk);
                const bool take = (ob > best) || (ob == best && og < bg);
                best = take ? ob : best; bg = take ? og : bg;
            }
            int i1 = 0; float b1 = bv[0];
#pragma unroll
            for (int k = 1; k < 4; ++k) if (bv[k] > b1) { b1 = bv[k]; i1 = k; }
            int i2 = -1; float b2 = -1e30f;
#pragma unroll
            for (int k = 0; k < 4; ++k) if (k != i1 && bv[k] > b2) { b2 = bv[k]; i2 = k; }
            float s1 = sv[0], s2s = sv[0];
#pragma unroll
            for (int k = 1; k < 4; ++k) { if (i1 == k) s1 = sv[k]; if (i2 == k) s2s = sv[k]; }
            if (e == 4 * bg && !dry) {
                const int r = rb + half;
                const int e0 = bg * 4 + i1, e1 = bg * 4 + i2;
                const float inv = 1.f / (s1 + s2s);
                const int li = it * 16 + 2 * wv + half;
                const int p0 = __hip_atomic_fetch_add(&lcnt[e0], 1, __ATOMIC_RELAXED, __HIP_MEMORY_SCOPE_WORKGROUP);
                const int p1 = __hip_atomic_fetch_add(&lcnt[e1], 1, __ATOMIC_RELAXED, __HIP_MEMORY_SCOPE_WORKGROUP);
                asg[2 * li] = (e0 << 16) | p0; asg[2 * li + 1] = (e1 << 16) | p1;
                wts[2 * r] = s1 * inv; wts[2 * r + 1] = s2s * inv;
            }
        }
    }
    __syncthreads();
    if (dry) return;
    if (tid < 32) lbase[tid] = atomicAdd(&cnt[tid * CNT_STRIDE], lcnt[tid]);
    __syncthreads();
    for (int idx = tid; idx < 2 * 144; idx += NT) {
        const int li = idx >> 1, k = idx & 1, t = (li >> 4) * G + blockIdx.x;
        if (t < ntiles) { const int r = r0 + t * 16 + (li & 15); const int v = asg[idx], e = v >> 16, lp = v & 0xffff; list[(size_t)e * LISTCAP + lbase[e] + lp] = 2 * r + k; }
    }
}

__device__ __forceinline__ void phase_ln2(int wv, KP Pk, int layer, bool dry = false) {
    asm volatile("" : "+s"(Pk));
    const CAS Params& P = *Pk;
    const int tid = ltid(wv), lane = tid & 63, wid = tid >> 6;
    const bf16_t* yp = (const bf16_t*)(P.ws + WS_YP);
    const float* wts = (const float*)(P.ws + WS_WTS);
    bf16_t* act = (bf16_t*)(P.ws + (dry ? WS_FEAT : WS_ACT));
    bf16_t* xcb = (bf16_t*)(P.ws + WS_XC); bf16_t* xob = (bf16_t*)P.out;
    const float* lg = P.ln_g + (size_t)(layer * 2 + 1) * D; const float* lb = P.ln_b + (size_t)(layer * 2 + 1) * D;
    const bool last = (layer == DEPTH - 1);
    const int r0 = last ? NCTX : 0, stride = gridDim.x * 8;
    f32x4 cg[4], cb[4], g2v[4], s1v[4], h1v[4];
#pragma unroll
    for (int i = 0; i < 4; ++i) { cg[i] = *(const f32x4*)(lg + 4 * lane + 256 * i); cb[i] = *(const f32x4*)(lb + 4 * lane + 256 * i); g2v[i] = s1v[i] = h1v[i] = (f32x4){0.f, 0.f, 0.f, 0.f}; }
    int mcur = -1;
    u32x2 nx[4]; u32x2 ny0[4], ny1[4]; float nw0 = 0.f, nw1 = 0.f;
    auto fetch = [&](int r) {
        const bf16_t* xr = last ? (const bf16_t*)(P.ws + WS_FEAT) + (size_t)r * D : r < NCTX ? xcb + (size_t)r * D : xob + (size_t)(r - NCTX) * D;
#pragma unroll
        for (int i = 0; i < 4; ++i) {
            const int c = 4 * lane + 256 * i;
            nx[i] = *(const u32x2*)(xr + c); ny0[i] = *(const u32x2*)(yp + (size_t)(2 * r) * D + c); ny1[i] = *(const u32x2*)(yp + (size_t)(2 * r + 1) * D + c);
        }
        nw0 = wts[2 * r]; nw1 = wts[2 * r + 1];
    };
    int r = r0 + blockIdx.x * 8 + wid;
    if (r < NROWS) fetch(r);
    for (; r < NROWS; r += stride) {
        const int m = row_mod(r);
        if (m != mcur) {
            mcur = m;
            const float* g2 = modvec(P.ws, layer, m, 5); const float* sh1 = last ? lg : modvec(P.ws, layer + 1, m, 0); const float* sc1 = last ? lg : modvec(P.ws, layer + 1, m, 1);
#pragma unroll
            for (int i = 0; i < 4; ++i) { const int c = 4 * lane + 256 * i; g2v[i] = *(const f32x4*)(g2 + c); s1v[i] = *(const f32x4*)(sc1 + c); h1v[i] = *(const f32x4*)(sh1 + c); }
        }
        f32x4 v[4]; float s = 0.f;
        const float w0 = nw0, w1 = nw1;
#pragma unroll
        for (int i = 0; i < 4; ++i) {
            const f32x4 xv = (f32x4){bflo(nx[i].x), bfhi(nx[i].x), bflo(nx[i].y), bfhi(nx[i].y)}, gv = g2v[i]; const u32x2 y0 = ny0[i], y1 = ny1[i];
            v[i][0] = ALPHA * xv[0] + gv[0] * (w0 * bflo(y0.x) + w1 * bflo(y1.x)); v[i][1] = ALPHA * xv[1] + gv[1] * (w0 * bfhi(y0.x) + w1 * bfhi(y1.x));
            v[i][2] = ALPHA * xv[2] + gv[2] * (w0 * bflo(y0.y) + w1 * bflo(y1.y)); v[i][3] = ALPHA * xv[3] + gv[3] * (w0 * bfhi(y0.y) + w1 * bfhi(y1.y));
            s += (v[i][0] + v[i][1]) + (v[i][2] + v[i][3]);
        }
        if (r + stride < NROWS) fetch(r + stride);
        const float mean = wave_sum(s) * (1.f / D);
        float s2 = 0.f;
#pragma unroll
        for (int i = 0; i < 4; ++i) { v[i] = v[i] - mean; s2 += (v[i][0] * v[i][0] + v[i][1] * v[i][1]) + (v[i][2] * v[i][2] + v[i][3] * v[i][3]); }
        const float rstd = rsqrtf(wave_sum(s2) * (1.f / D) + 1e-5f);
#pragma unroll
        for (int i = 0; i < 4; ++i) {
            const int c = 4 * lane + 256 * i;
            f32x4 xn;
#pragma unroll
            for (int j = 0; j < 4; ++j) xn[j] = v[i][j] * rstd * cg[i][j] + cb[i][j];
            if (dry) *(f32x4*)((float*)(P.ws + WS_YF) + (size_t)r * D + c) = xn;
            else if (last) *(f32x4*)(P.out + (size_t)(r - NCTX) * D + c) = xn;
            else { u32x2 ox; ox.x = pk2(xn[0], xn[1]); ox.y = pk2(xn[2], xn[3]); *(u32x2*)((r < NCTX ? xcb + (size_t)r * D : xob + (size_t)(r - NCTX) * D) + c) = ox; }
            if (!last) {
                u32x2 o; o.x = pk2(xn[0] * (1.f + s1v[i][0]) + h1v[i][0], xn[1] * (1.f + s1v[i][1]) + h1v[i][1]); o.y = pk2(xn[2] * (1.f + s1v[i][2]) + h1v[i][2], xn[3] * (1.f + s1v[i][3]) + h1v[i][3]);
                *(u32x2*)(act + (size_t)r * D + c) = o;
            }
        }
    }
}

constexpr int NPHASE = 2 + 11 * DEPTH;
__global__ void __launch_bounds__(NT, 2) fwd_kernel(Params P) {
    extern __shared__ __attribute__((aligned(16))) char lds_raw[];
    LAS char* lds = (LAS char*)lds_raw;
    volatile LAS unsigned* xbw = (volatile LAS unsigned*)(lds + LDS_BYTES - 16);
    KP Pk = (KP)__builtin_amdgcn_kernarg_segment_ptr();
    const int wv = __builtin_amdgcn_readfirstlane((int)(threadIdx.x >> 6));
    const bool multi = (P.ph_hi - P.ph_lo) > 1;
    XcdBarrier bar; bar.bar = (unsigned*)(P.ws + WS_BAR); bar.x = 0; bar.st = xbw;
    if (multi) {
        if (ltid(wv) == 0) { xbw[0] = 0u; xbw[1] = 0u; xbw[2] = 0u; xbw[3] = 0u; }
        __syncthreads();
        bar = xcd_barrier_post(wv, (unsigned*)(P.ws + WS_BAR), xbw);
    }
#define PHASE(id, body) do { if (P.ph_lo <= (id) && (id) < P.ph_hi) { body; if ((id) + 1 < P.ph_hi) xcd_barrier(wv, bar); if (MK_DOUBLE & 2048) xcd_barrier(wv, bar); } } while (0)
    PHASE(0, REP(16, phase_prologue0(wv, Pk, lds)));
    PHASE(1, REP(16, phase_prologue1(wv, Pk)));
    for (int l = 0; l < DEPTH; ++l) {
        const int pb = 2 + 11 * l, odd = l & 1;
        PHASE(pb + 0, REP(1, phase_inproj(wv, Pk, l, lds)));
        if (odd) {
            PHASE(pb + 1, REP(4, phase_prep1(wv, Pk, l)));
            PHASE(pb + 2, phase_prep2(wv, Pk, l, lds));
            PHASE(pb + 3, REP(32, { if (blockIdx.x < 128) { REP(64, scan_hgrn_c(wv, Pk, l, blockIdx.x, lds)); expconv_after_scan(wv, Pk, l, lds); } else if (blockIdx.x < 256) REP(128, scan_rwkv_b(wv, Pk, l, blockIdx.x - 128, lds)); }));
            PHASE(pb + 5, REP(4, phase_out_odd(wv, Pk, l)));
        } else {
            PHASE(pb + 1, REP(4, phase_prep_even(wv, Pk, l)));
            PHASE(pb + 2, REP(2, phase_ex1(wv, Pk, l, lds)));
            PHASE(pb + 3, phase_ex2(wv, Pk, l));
            PHASE(pb + 4, REP(2, phase_ex3(wv, Pk, l, lds)));
            PHASE(pb + 5, REP(4, phase_out_even(wv, Pk, l)));
        }
        PHASE(pb + 6, REP(256, phase_outproj(wv, Pk, l, lds)));
        PHASE(pb + 7, { if (MK_DOUBLE & 4096) phase_ln1(wv, Pk, l, lds, true); phase_ln1(wv, Pk, l, lds); });
        PHASE(pb + 8, REP(512, phase_moe1(wv, Pk, l, lds)));
        PHASE(pb + 9, REP(1024, phase_moe2(wv, Pk, l, lds)));
        PHASE(pb + 10, { if (MK_DOUBLE & 8192) phase_ln2(wv, Pk, l, true); phase_ln2(wv, Pk, l); });
    }
#undef PHASE
}


#ifndef MK_STOP
#define MK_STOP NPHASE
#endif
#ifndef MK_DUMP
#define MK_DUMP 0
#endif
#ifndef MK_DUMP_N
#define MK_DUMP_N (1u << 30)
#endif
#ifndef MK_DUMP_LD
#define MK_DUMP_LD 1024
#endif
#ifndef MK_DUMP_C0
#define MK_DUMP_C0 0
#endif
__global__ void diff_kernel(const bf16_t* a, const bf16_t* b, float* out, size_t n) {
    for (size_t i = (size_t)blockIdx.x * blockDim.x + threadIdx.x; i < n; i += (size_t)gridDim.x * blockDim.x) out[i] = 1e6f * (bf2f(a[i]) - bf2f(b[i]));
}
__global__ void dump_kernel(const bf16_t* src, float* out, size_t n) {
    for (size_t i = (size_t)blockIdx.x * blockDim.x + threadIdx.x; i < n; i += (size_t)gridDim.x * blockDim.x) out[i] = i < (size_t)MK_DUMP_N ? bf2f(src[(i >> 10) * MK_DUMP_LD + MK_DUMP_C0 + (i & 1023)]) : 0.f;
}
extern "C" void kernel_launch(void* const* d_in, const int* in_sizes, int n_in, void* d_out, int out_size, void* d_ws, size_t ws_size, hipStream_t stream) {
    static int ready = 0;
    if (ready == 0) {
        ready = 1;
        if (n_in != 42 || out_size != NB * SEQ * D || ws_size < WS_END) { fprintf(stderr, "kernel_launch: unexpected shapes (n_in %d out %d ws %zu need %zu)\n", n_in, out_size, ws_size, (size_t)WS_END); ready = -1; }
        if (hipFuncSetAttribute((const void*)fwd_kernel, hipFuncAttributeMaxDynamicSharedMemorySize, LDS_BYTES) != hipSuccess) { fprintf(stderr, "kernel_launch: hipFuncSetAttribute failed\n"); ready = -1; }
    }
    if (ready < 0) return;
    (void)in_sizes;
    hipMemsetAsync((char*)d_ws + WS_BAR, 0, WS_ZERO_BYTES, stream);
    Params p;
    memset(&p, 0, sizeof(p));
    const float** fp = (const float**)&p;
    for (int i = 0; i < 42; ++i) fp[i] = (const float*)d_in[i];
    p.out = (float*)d_out; p.ws = (unsigned char*)d_ws;
#if MK_PER_PHASE
    for (int ph = 0; ph < MK_STOP; ++ph) {
        const int local = ph < 2 ? -1 : (ph - 2) % 11, layer = ph < 2 ? 0 : (ph - 2) / 11;
        if (local == 4 && (layer & 1)) continue;
        p.ph_lo = ph; p.ph_hi = ph + 1;
        hipLaunchKernelGGL(fwd_kernel, dim3(256), dim3(NT), LDS_BYTES, stream, p);
    }
#ifdef MK_DIFF
    p.ph_lo = 7; p.ph_hi = 8; p.dbg = 1;
    hipLaunchKernelGGL(fwd_kernel, dim3(256), dim3(NT), LDS_BYTES, stream, p);
    hipLaunchKernelGGL(diff_kernel, dim3(1024), dim3(256), 0, stream, (const bf16_t*)((unsigned char*)d_ws + WS_YO), (const bf16_t*)((unsigned char*)d_ws + WS_HID), (float*)d_out, (size_t)NB * SEQ * D);
#else
    if (MK_DUMP) hipLaunchKernelGGL(dump_kernel, dim3(1024), dim3(256), 0, stream, (const bf16_t*)((unsigned char*)d_ws + (size_t)MK_DUMP), (float*)d_out, (size_t)NB * SEQ * D);
#endif
#else
    p.ph_lo = 0; p.ph_hi = NPHASE;
    hipLaunchKernelGGL(fwd_kernel, dim3(256), dim3(NT), LDS_BYTES, stream, p);
#endif
}
```
